# Optimizing an MI355X kernel written in HIP

```python
import math
import jax, jax.numpy as jnp
from jax import lax
import numpy as np


D_MODEL = 1024
BATCH = 32
SEQ = 2048
DEPTH = 1

CHUNK = 64
A_HEADS = 8
A_LATENT = 128
IDX_HEADS = 8
IDX_DIM = 64
TOPK_KEYS_MAX = 256
A_QBLOCK = 64
REL_BUCKETS = 32
REL_MAX_DIST = 128
SSM_D_INNER = 1024
SSM_HEADDIM = 64
SSM_HEADS = SSM_D_INNER // SSM_HEADDIM
SSM_GROUPS = 4
SSM_STATE = 128
SSM_CONV = 4
SSM_CONV_DIM = SSM_D_INNER + 2 * SSM_GROUPS * SSM_STATE
DT_MIN = 0.001
DT_MAX = 0.1
N_EXPERTS = 32
TOPK_EXPERTS = 4
D_FF_EXPERT = D_MODEL
SWIGLU_LIMIT = 7.0
SWIGLU_ALPHA = 1.702
MOE_BLOCK = 256
DEEPNORM_ALPHA = (2.0 * DEPTH) ** 0.25
DEEPNORM_BETA = (8.0 * DEPTH) ** -0.25
LN_EPS = 1e-5
IN_SPLITS = (A_HEADS * A_LATENT, A_LATENT, IDX_HEADS * IDX_DIM, IDX_DIM, IDX_HEADS,
             SSM_D_INNER, SSM_CONV_DIM, SSM_HEADS, D_MODEL, D_MODEL)
D_IN_PROJ = sum(IN_SPLITS)

kernel_name = "hybrid_dsa_ssd_moe_streaming_block"


def layer_norm(x, eps=LN_EPS):
    x32 = x.astype(jnp.float32)
    mu = jnp.mean(x32, -1, keepdims=True)
    var = jnp.mean(jnp.square(x32 - mu), -1, keepdims=True)
    return ((x32 - mu) * lax.rsqrt(var + eps)).astype(x.dtype)


def rms_norm(x, w, eps=LN_EPS):
    x32 = x.astype(jnp.float32)
    y = x32 * lax.rsqrt(jnp.mean(jnp.square(x32), -1, keepdims=True) + eps)
    return y.astype(x.dtype) * w


def t5_bucket(rel):
    half = REL_BUCKETS // 2
    max_exact = half // 2
    ret = (rel > 0).astype(jnp.int32) * half
    n = jnp.abs(rel)
    nf = jnp.maximum(n, 1).astype(jnp.float32)
    large = max_exact + (jnp.log(nf / max_exact) / math.log(REL_MAX_DIST / max_exact)
                         * (half - max_exact)).astype(jnp.int32)
    large = jnp.minimum(large, half - 1)
    return ret + jnp.where(n < max_exact, n, large)


def sparse_indexed_attention(q, kv, iq, ik, iw, rel_bias):
    bsz, seq = kv.shape[0], kv.shape[1]
    n_sel = min(TOPK_KEYS_MAX, seq // 4)
    n_blk = seq // A_QBLOCK
    key_chunk = jnp.arange(seq, dtype=jnp.int32) // CHUNK
    q_pos = jnp.arange(seq, dtype=jnp.int32).reshape(n_blk, A_QBLOCK)

    def blocks(a):
        return jnp.swapaxes(a.reshape(bsz, n_blk, A_QBLOCK, *a.shape[2:]), 0, 1)

    gather_keys = jax.vmap(lambda a, i: a[i])

    def one_block(args):
        qb, iqb, iwb, pos = args
        q_chunk = pos // CHUNK
        idx = jnp.einsum('bqhd,bsd->bqhs', iqb, ik) * IDX_DIM ** -0.5
        score = jnp.einsum('bqhs,bqh->bqs', jax.nn.relu(idx), iwb).astype(jnp.float32)
        admissible = key_chunk[None, :] <= q_chunk[:, None]
        score = jnp.where(admissible[None], score, -jnp.inf)
        _, sel = lax.top_k(score, n_sel)
        kv_sel = gather_keys(kv, sel)
        logits = jnp.einsum('bqhc,bqkc->bqhk', qb, kv_sel).astype(jnp.float32) * A_LATENT ** -0.5
        bias = rel_bias[t5_bucket(sel - pos[None, :, None])].astype(jnp.float32)
        logits = logits + jnp.transpose(bias, (0, 1, 3, 2))
        valid = (sel // CHUNK) <= q_chunk[None, :, None]
        logits = jnp.where(valid[:, :, None, :], logits, -jnp.inf)
        probs = jax.nn.softmax(logits, axis=-1).astype(kv.dtype)
        return jnp.einsum('bqhk,bqkc->bqhc', probs, kv_sel)

    out = lax.map(one_block, (blocks(q), blocks(iq), blocks(iw), q_pos))
    return jnp.swapaxes(out, 0, 1).reshape(bsz, seq, A_HEADS * A_LATENT)


def segsum(a):
    t = a.shape[-1]
    cs = jnp.cumsum(a, axis=-1)
    d = cs[..., :, None] - cs[..., None, :]
    return jnp.where(jnp.tril(jnp.ones((t, t), dtype=bool)), d, -jnp.inf)


def ssd_mixer(z, xbc, dt_raw, conv_w, conv_b, dt_bias, a_log, d_skip, norm_w):
    bsz, seq = xbc.shape[0], xbc.shape[1]
    n_ch = seq // CHUNK
    hpg = SSM_HEADS // SSM_GROUPS
    xbc = lax.conv_general_dilated(xbc, conv_w[:, None, :], window_strides=(1,),
                                   padding=((SSM_CONV - 1, 0),),
                                   dimension_numbers=('NWC', 'WIO', 'NWC'),
                                   feature_group_count=SSM_CONV_DIM) + conv_b
    xbc = jax.nn.silu(xbc)
    xs, bm, cm = jnp.split(xbc, [SSM_D_INNER, SSM_D_INNER + SSM_GROUPS * SSM_STATE], axis=-1)
    xs = xs.reshape(bsz, n_ch, CHUNK, SSM_GROUPS, hpg, SSM_HEADDIM)
    bm = bm.reshape(bsz, n_ch, CHUNK, SSM_GROUPS, SSM_STATE)
    cm = cm.reshape(bsz, n_ch, CHUNK, SSM_GROUPS, SSM_STATE)
    dt = jax.nn.softplus((dt_raw + dt_bias).astype(jnp.float32))
    a = -jnp.exp(a_log.astype(jnp.float32))
    dt = dt.reshape(bsz, n_ch, CHUNK, SSM_GROUPS, hpg)
    a_dt = jnp.transpose(dt * a.reshape(SSM_GROUPS, hpg), (0, 3, 4, 1, 2))
    xdt = xs * dt[..., None]
    a_cs = jnp.cumsum(a_dt, axis=-1)
    lmat = jnp.exp(segsum(a_dt))
    cb = jnp.einsum('bclgn,bcsgn->bcgls', cm, bm)
    y_diag = jnp.einsum('bcgls,bgrcls,bcsgrp->bclgrp', cb, lmat, xdt)
    decay_states = jnp.exp(a_cs[..., -1:] - a_cs)
    states = jnp.einsum('bclgn,bgrcl,bclgrp->bcgrpn', bm, decay_states, xdt)
    chunk_decay = jnp.exp(a_cs[..., -1])

    def step(h, inp):
        st, dec = inp
        return h * dec[..., None, None] + st, h

    h0 = jnp.zeros((bsz, SSM_GROUPS, hpg, SSM_HEADDIM, SSM_STATE), states.dtype)
    _, prev = lax.scan(step, h0, (jnp.swapaxes(states, 0, 1), jnp.moveaxis(chunk_decay, -1, 0)))
    prev = jnp.swapaxes(prev, 0, 1)
    y_off = jnp.einsum('bclgn,bcgrpn,bgrcl->bclgrp', cm, prev, jnp.exp(a_cs))
    y = y_diag + y_off + xs * d_skip.reshape(SSM_GROUPS, hpg)[:, :, None]
    y = y.reshape(bsz, seq, SSM_D_INNER) * jax.nn.silu(z)
    yg = y.reshape(bsz, seq, SSM_GROUPS, SSM_D_INNER // SSM_GROUPS).astype(jnp.float32)
    yg = yg * lax.rsqrt(jnp.mean(jnp.square(yg), -1, keepdims=True) + LN_EPS)
    return yg.reshape(bsz, seq, SSM_D_INNER).astype(z.dtype) * norm_w


def moe_ffn(u, w_router, b_router, w1, b1, w2, b2):
    bsz, seq, d = u.shape
    n_tok = bsz * seq
    n_asg = n_tok * TOPK_EXPERTS
    xt = u.reshape(n_tok, d)
    logits = (xt @ w_router + b_router).astype(jnp.float32)
    top_val, top_idx = lax.top_k(logits, TOPK_EXPERTS)
    gates = jax.nn.softmax(top_val, axis=-1).astype(u.dtype)
    e_flat = top_idx.reshape(n_asg)
    tok_flat = jnp.arange(n_asg, dtype=jnp.int32) // TOPK_EXPERTS
    g_flat = gates.reshape(n_asg)
    order = jnp.argsort(e_flat)
    e_sorted = e_flat[order]
    counts = jax.ops.segment_sum(jnp.ones((n_asg,), jnp.int32), e_flat, num_segments=N_EXPERTS)
    starts = jnp.cumsum(counts) - counts
    padded = (counts + MOE_BLOCK - 1) // MOE_BLOCK * MOE_BLOCK
    pends = jnp.cumsum(padded)
    pstarts = pends - padded
    dest = pstarts[e_sorted] + jnp.arange(n_asg, dtype=jnp.int32) - starts[e_sorted]
    n_blocks = n_asg // MOE_BLOCK + N_EXPERTS
    n_slots = n_blocks * MOE_BLOCK
    slot_tok = jnp.zeros((n_slots,), jnp.int32).at[dest].set(tok_flat[order])
    slot_gate = jnp.zeros((n_slots,), u.dtype).at[dest].set(g_flat[order])
    block_start = jnp.arange(n_blocks, dtype=jnp.int32) * MOE_BLOCK
    block_expert = jnp.minimum(jnp.sum(block_start[:, None] >= pends[None, :], axis=1), N_EXPERTS - 1)

    def expert_block(acc, inp):
        tok, g, e = inp
        h = xt[tok] @ w1[e] + b1[e]
        gate, up = h[:, :D_FF_EXPERT], h[:, D_FF_EXPERT:]
        gate = jnp.minimum(gate, SWIGLU_LIMIT)
        up = jnp.clip(up, -SWIGLU_LIMIT, SWIGLU_LIMIT)
        act = (up + 1.0) * gate * jax.nn.sigmoid(SWIGLU_ALPHA * gate)
        y = act @ w2[e] + b2[e]
        return acc.at[tok].add(y * g[:, None]), None

    acc, _ = lax.scan(expert_block, jnp.zeros((n_tok, d), xt.dtype),
                      (slot_tok.reshape(n_blocks, MOE_BLOCK), slot_gate.reshape(n_blocks, MOE_BLOCK),
                       block_expert))
    return acc.reshape(bsz, seq, d)


def setup_inputs(seed: int = 0) -> dict:
    key = jax.random.key(seed)
    ks = jax.random.split(key, 28)

    def nrm(k, shape, scale):
        return jax.random.normal(k, shape, jnp.float32) * scale

    u_dt = jax.random.uniform(ks[11], (DEPTH, SSM_HEADS), jnp.float32)
    dt0 = jnp.exp(u_dt * (math.log(DT_MAX) - math.log(DT_MIN)) + math.log(DT_MIN))
    return {
        'x': nrm(ks[0], (BATCH, SEQ, D_MODEL), 1.0),
        'c': nrm(ks[1], (BATCH, D_MODEL), 1.0),
        'w_mod': nrm(ks[2], (DEPTH, D_MODEL, 6 * D_MODEL), 0.5 * D_MODEL ** -0.5),
        'b_mod': nrm(ks[3], (DEPTH, 6 * D_MODEL), 0.02),
        'w_in': nrm(ks[4], (DEPTH, D_MODEL, D_IN_PROJ), D_MODEL ** -0.5),
        'kv_norm_w': 1.0 + nrm(ks[5], (DEPTH, A_LATENT), 0.1),
        'idx_k_norm_w': 1.0 + nrm(ks[6], (DEPTH, IDX_DIM), 0.1),
        'idx_k_norm_b': nrm(ks[7], (DEPTH, IDX_DIM), 0.02),
        'rel_bias': nrm(ks[8], (REL_BUCKETS, A_HEADS), 0.5),
        'conv_w': nrm(ks[9], (DEPTH, SSM_CONV, SSM_CONV_DIM), SSM_CONV ** -0.5),
        'conv_b': nrm(ks[10], (DEPTH, SSM_CONV_DIM), 0.02),
        'dt_bias': dt0 + jnp.log(-jnp.expm1(-dt0)),
        'a_log': jnp.log(jax.random.uniform(ks[12], (DEPTH, SSM_HEADS), jnp.float32, 1.0, 16.0)),
        'd_skip': 1.0 + nrm(ks[13], (DEPTH, SSM_HEADS), 0.1),
        'ssm_norm_w': 1.0 + nrm(ks[14], (DEPTH, SSM_D_INNER), 0.1),
        'w_proj_a': nrm(ks[15], (DEPTH, A_HEADS * A_LATENT, D_MODEL), (A_HEADS * A_LATENT) ** -0.5),
        'w_proj_b': nrm(ks[16], (DEPTH, SSM_D_INNER, D_MODEL), SSM_D_INNER ** -0.5),
        'w_out': nrm(ks[17], (DEPTH, D_MODEL, D_MODEL), DEEPNORM_BETA * D_MODEL ** -0.5),
        'ln1_g': 1.0 + nrm(ks[18], (DEPTH, D_MODEL), 0.1),
        'ln1_b': nrm(ks[19], (DEPTH, D_MODEL), 0.02),
        'w_router': nrm(ks[20], (DEPTH, D_MODEL, N_EXPERTS), D_MODEL ** -0.5),
        'b_router': nrm(ks[21], (DEPTH, N_EXPERTS), 0.01),
        'w1': nrm(ks[22], (DEPTH, N_EXPERTS, D_MODEL, 2 * D_FF_EXPERT), D_MODEL ** -0.5),
        'b1': nrm(ks[23], (DEPTH, N_EXPERTS, 2 * D_FF_EXPERT), 0.02),
        'w2': nrm(ks[24], (DEPTH, N_EXPERTS, D_FF_EXPERT, D_MODEL), DEEPNORM_BETA * D_FF_EXPERT ** -0.5),
        'b2': nrm(ks[25], (DEPTH, N_EXPERTS, D_MODEL), 0.02),
        'ln2_g': 1.0 + nrm(ks[26], (DEPTH, D_MODEL), 0.1),
        'ln2_b': nrm(ks[27], (DEPTH, D_MODEL), 0.02),
    }


def reference(x, c, w_mod, b_mod, w_in, kv_norm_w, idx_k_norm_w, idx_k_norm_b, rel_bias,
              conv_w, conv_b, dt_bias, a_log, d_skip, ssm_norm_w, w_proj_a, w_proj_b, w_out,
              ln1_g, ln1_b, w_router, b_router, w1, b1, w2, b2, ln2_g, ln2_b):
    bsz, seq, _ = x.shape
    split_at = np.cumsum(IN_SPLITS)[:-1].tolist()
    for l in range(DEPTH):
        mod = jax.nn.silu(c) @ w_mod[l] + b_mod[l]
        shift1, scale1, gate1, shift2, scale2, gate2 = [m[:, None, :] for m in jnp.split(mod, 6, axis=-1)]
        u = layer_norm(x) * (1.0 + scale1) + shift1
        proj = u @ w_in[l]
        q_a, kv_a, iq, ik, iw, z, xbc, dt_raw, g_a, g_b = jnp.split(proj, split_at, axis=-1)
        q_a = q_a.reshape(bsz, seq, A_HEADS, A_LATENT)
        kv_a = rms_norm(kv_a, kv_norm_w[l])
        iq = iq.reshape(bsz, seq, IDX_HEADS, IDX_DIM)
        ik = layer_norm(ik) * idx_k_norm_w[l] + idx_k_norm_b[l]
        iw = iw * IDX_HEADS ** -0.5
        o_a = sparse_indexed_attention(q_a, kv_a, iq, ik, iw, rel_bias)
        o_b = ssd_mixer(z, xbc, dt_raw, conv_w[l], conv_b[l], dt_bias[l], a_log[l],
                        d_skip[l], ssm_norm_w[l])
        merged = jax.nn.sigmoid(g_a) * (o_a @ w_proj_a[l]) + jax.nn.sigmoid(g_b) * (o_b @ w_proj_b[l])
        x = layer_norm(DEEPNORM_ALPHA * x + gate1 * (merged @ w_out[l])) * ln1_g[l] + ln1_b[l]
        u2 = layer_norm(x) * (1.0 + scale2) + shift2
        y = moe_ffn(u2, w_router[l], b_router[l], w1[l], b1[l], w2[l], b2[l])
        x = layer_norm(DEEPNORM_ALPHA * x + gate2 * y) * ln2_g[l] + ln2_b[l]
    return x
```

```cpp
#include <hip/hip_runtime.h>
#include <cstdio>
#include <cstdint>

#ifndef MK_ONE
#define MK_ONE 1
#endif
#ifndef MK_PH_HI
#define MK_PH_HI 99
#endif

#define LAS __attribute__((address_space(3)))
#define GAS __attribute__((address_space(1)))
typedef unsigned short bf16_t;
typedef short bf16x8 __attribute__((ext_vector_type(8)));
typedef short s16x4 __attribute__((ext_vector_type(4)));
typedef float f32x2 __attribute__((ext_vector_type(2)));
typedef float f32x4 __attribute__((ext_vector_type(4)));
typedef float f32x16 __attribute__((ext_vector_type(16)));
typedef unsigned u32x2 __attribute__((ext_vector_type(2)));
typedef unsigned u32x4 __attribute__((ext_vector_type(4)));
typedef unsigned long long u64;

constexpr int NB = 32, SEQ = 2048, D = 1024, NTOK = NB * SEQ;
constexpr int NWAVES = 8, NTHR = 512;
constexpr int NPROJ = 6912;
constexpr int NEXP = 32, HALF_TOK = NTOK / 2, REG_CAP = HALF_TOK;
constexpr int ACT_ROWS = HALF_TOK * 4 + NEXP * 256;
constexpr float LN_EPS = 1e-5f;
constexpr float DN_ALPHA = 1.189207115002721f;
constexpr float LOG2E = 1.4426950408889634f;

constexpr size_t MiB = 1u << 20;
constexpr size_t WS_CTL = 0, CTL_ZERO_BYTES = 1 * MiB;
constexpr size_t WS_MOD = 1 * MiB;
constexpr size_t WS_BIAST = 1 * MiB + 800 * 1024;
constexpr size_t WS_WIN = 2 * MiB;
constexpr size_t WS_WPA = 16 * MiB, WS_WPB = 18 * MiB, WS_WOUT = 20 * MiB;
constexpr size_t WS_W1 = 24 * MiB;
constexpr size_t WS_W2 = 152 * MiB;
constexpr size_t WS_Q = 216 * MiB;
constexpr size_t WS_Z = 344 * MiB;
constexpr size_t WS_XBC = 472 * MiB;
constexpr size_t WS_GA = 728 * MiB, WS_GB = 856 * MiB;
constexpr size_t WS_U2 = 216 * MiB;
constexpr size_t WS_REG = 344 * MiB;
constexpr size_t WS_ACT = 360 * MiB;
constexpr size_t WS_YB = 632 * MiB;
constexpr size_t WS_END = 888 * MiB;
constexpr size_t OUT_U = 0, OUT_MISC = 128 * MiB, OUT_IQ = 192 * MiB;
constexpr size_t OUT_KV = 0, OUT_IK = 16 * MiB, OUT_IW = 24 * MiB, OUT_DT = 26 * MiB, OUT_MASK = 32 * MiB, OUT_OA = 64 * MiB;
constexpr int CW_BAR = 4096, CW_CNT = 16384;

constexpr int LDS_BYTES = 160 * 1024;
constexpr int LDS_AUX = 131072;
constexpr int LDS_MISC = LDS_BYTES - 256;

#define LDS_WAIT() asm volatile("s_waitcnt lgkmcnt(0)" ::: "memory")
#define VM_WAIT() asm volatile("s_waitcnt vmcnt(0)" ::: "memory")
#define SBAR() __builtin_amdgcn_sched_barrier(0)
__device__ __forceinline__ unsigned cvt_pk_bf16(float lo, float hi) { unsigned r; asm volatile("v_cvt_pk_bf16_f32 %0, %1, %2" : "=v"(r) : "v"(lo), "v"(hi)); return r; }
__device__ __forceinline__ float bflo(unsigned w) { return __uint_as_float(w << 16); }
__device__ __forceinline__ float bfhi(unsigned w) { return __uint_as_float(w & 0xffff0000u); }
__device__ __forceinline__ u32x4 pack8(f32x4 a, f32x4 b) { u32x4 w; w.x = cvt_pk_bf16(a[0], a[1]); w.y = cvt_pk_bf16(a[2], a[3]); w.z = cvt_pk_bf16(b[0], b[1]); w.w = cvt_pk_bf16(b[2], b[3]); return w; }
__device__ __forceinline__ void unpack8(u32x4 w, f32x4& a, f32x4& b) { a[0] = bflo(w.x); a[1] = bfhi(w.x); a[2] = bflo(w.y); a[3] = bfhi(w.y); b[0] = bflo(w.z); b[1] = bfhi(w.z); b[2] = bflo(w.w); b[3] = bfhi(w.w); }
__device__ __forceinline__ float wave_sum(float v) {
#pragma unroll
    for (int o = 1; o < 64; o <<= 1) v += __shfl_xor(v, o);
    return v;
}
__device__ __forceinline__ float fast_rcp(float x) { return __builtin_amdgcn_rcpf(x); }
__device__ __forceinline__ float sigmoid_f(float x) { return fast_rcp(1.0f + __expf(-x)); }
__device__ __forceinline__ float silu_f(float x) { return x * sigmoid_f(x); }

#define XB_TMO      128
#define XB_XCNT(j)  (256  + 64 * (j))
#define XB_XSUB(j)  (1280 + 64 * (j))
#define XB_XGEN(j)  (2304 + 64 * (j))
#define XB_TOP      3328
#define XB_TOPGEN   3392
#define XCD_BAR_WORDS 3456
#define XB_SPIN_CAP (1u << 18)
__device__ __forceinline__ unsigned xb_ld(unsigned* p)              { return __hip_atomic_load(p, __ATOMIC_RELAXED, __HIP_MEMORY_SCOPE_AGENT); }
__device__ __forceinline__ unsigned xb_add(unsigned* p, unsigned v) { return __hip_atomic_fetch_add(p, v, __ATOMIC_RELAXED, __HIP_MEMORY_SCOPE_AGENT); }
__device__ __forceinline__ unsigned xb_xcc_id() { return (unsigned)__builtin_amdgcn_s_getreg((3 << 11) | 20) & 0xFu; }
#define XB_SPIN(cond, bar) do { unsigned _sp = 0; while (cond) { __builtin_amdgcn_s_sleep(1); \
    if ((++_sp & 255u) == 0u) { if (xb_ld(&(bar)[XB_TMO])) break; if (_sp > XB_SPIN_CAP) { atomicAdd(&(bar)[XB_TMO], 1u); break; } } } } while (0)
struct XcdBarrier { unsigned* bar; unsigned x; volatile LAS unsigned* st; };
__device__ __forceinline__ XcdBarrier xcd_barrier_post(unsigned* bar, volatile LAS unsigned* st) {
    XcdBarrier b; b.bar = bar; b.x = xb_xcc_id(); b.st = st;
    if (threadIdx.x == 0) (void)xb_add(&bar[XB_XCNT(b.x)], 1u);
    return b;
}
__device__ __forceinline__ void xcd_barrier_complete(unsigned* bar, unsigned x, unsigned& nloc, unsigned& nx) {
    const unsigned G = gridDim.x * gridDim.y * gridDim.z;
    unsigned sum, cnt, mine, sp = 0u;
    for (;;) {
        sum = 0u; cnt = 0u;
#pragma nounroll
        for (unsigned j = 0; j < 16; ++j) { const unsigned c = xb_ld(&bar[XB_XCNT(j)]); sum += c; cnt += (c > 0u) ? 1u : 0u; }
        if (sum == G) break;
        __builtin_amdgcn_s_sleep(1);
        if ((++sp & 255u) == 0u) { if (xb_ld(&bar[XB_TMO])) break; if (sp > XB_SPIN_CAP) { atomicAdd(&bar[XB_TMO], 1u); break; } }
    }
    mine = xb_ld(&bar[XB_XCNT(x)]);
    nloc = mine > 0u ? mine : 1u; nx = cnt > 0u ? cnt : 1u;
}
__device__ __forceinline__ void xcd_barrier(const XcdBarrier& b) {
    asm volatile("s_waitcnt vmcnt(0)" ::: "memory");
    __syncthreads();
    if (threadIdx.x == 0) {
        unsigned* bar = b.bar;
        __builtin_amdgcn_s_waitcnt(0);
        unsigned nloc = b.st[0], nx = b.st[1];
        if (nloc == 0u) { xcd_barrier_complete(bar, b.x, nloc, nx); b.st[0] = nloc; b.st[1] = nx; }
        const unsigned old = xb_add(&bar[XB_XSUB(b.x)], 1u);
        const unsigned gen = old / nloc;
        if (old + 1u == (gen + 1u) * nloc) {
            __builtin_amdgcn_fence(__ATOMIC_RELEASE, "agent");
            asm volatile("s_waitcnt vmcnt(0)" ::: "memory");
            const unsigned og = xb_add(&bar[XB_TOP], 1u);
            const unsigned tg = og / nx;
            if (og + 1u == (tg + 1u) * nx) xb_add(&bar[XB_TOPGEN], 1u);
            else XB_SPIN(xb_ld(&bar[XB_TOPGEN]) == tg, bar);
            __builtin_amdgcn_fence(__ATOMIC_ACQUIRE, "agent");
            xb_add(&bar[XB_XGEN(b.x)], 1u);
            asm volatile("s_waitcnt vmcnt(0)" ::: "memory");
        } else {
            XB_SPIN(xb_ld(&bar[XB_XGEN(b.x)]) == gen, bar);
            __builtin_amdgcn_fence(__ATOMIC_ACQUIRE, "agent");
            asm volatile("s_waitcnt vmcnt(0)" ::: "memory");
        }
    }
    __syncthreads();
}

namespace pg8 {
constexpr int BM = 256, BK = 64, HALF = 128, HTB = HALF * BK * 2, STAGE_BYTES = 8 * HTB, NXCD = 8, WGM = 8, KD = 1024;
__host__ __device__ __forceinline__ int lds_byte(int r, int c) { const int st = (r >> 4) * 2 + (c >> 5), rr = r & 15, cc = c & 31, ob = rr * 64 + cc * 2; return st * 1024 + (ob ^ (((ob >> 9) & 1) << 5)); }
__host__ __device__ __forceinline__ void stage_rc(int b, int& R, int& C) { const int st = b / 1024, sb = b % 1024, swz = sb ^ (((sb >> 9) & 1) << 5); R = (st >> 1) * 16 + swz / 64; C = (st & 1) * 32 + (swz % 64) / 2; }
__host__ __device__ __forceinline__ int perm32(int rho) { const int n = rho >> 4, i = rho & 15; return 8 * (i >> 2) + 4 * n + (i & 3); }
struct Unit { int pm, pn, ex; };
struct StaticOrder {
    int nM, nN, nwg, G, c;
    __device__ void init(int M, int N, int G_, int c_) { nM = M / BM; nN = N / BM; nwg = nM * nN; G = G_; c = c_; }
    __device__ bool next(int i, Unit& u) const {
        const long L = (long)i * G + c; if (L >= nwg) return false;
        int wgid = (int)L; { const int q = nwg / NXCD, r = nwg % NXCD, xcd = wgid % NXCD, off = wgid / NXCD; wgid = (xcd < r ? xcd * (q + 1) : r * (q + 1) + (xcd - r) * q) + off; }
        const int nig = WGM * nN, gid = wgid / nig, fm = gid * WGM, gsz = (nM - fm) < WGM ? (nM - fm) : WGM;
        u.pm = fm + ((wgid % nig) % gsz); u.pn = (wgid % nig) / gsz; u.ex = 0; return true;
    }
};
template <class Epi, class Sched, bool GATHER>
__device__ __forceinline__ void gemm_phase(LAS unsigned char* lds, const Sched& S, const Epi& E) {
    int tid = threadIdx.x; asm volatile("" : "+v"(tid));
    const int wid = __builtin_amdgcn_readfirstlane(tid >> 6), lane = tid & 63, wr = wid >> 2, wc = wid & 3, fr = lane & 15, fq = lane >> 4;
    constexpr int K = KD, nt = K / BK;
    unsigned voffA[2], voffB[2]; int Rr[2], Cc[2];
#pragma unroll
    for (int i = 0; i < 2; ++i) { int R, C; stage_rc(tid * 16 + i * 8192, R, C); const int Rb = Epi::PERM ? ((R & ~31) + perm32(R & 31)) : R;
        voffA[i] = (unsigned)(R * K + C) * 2u; voffB[i] = (unsigned)(Rb * K + C) * 2u; Rr[i] = R; Cc[i] = C; }
    constexpr size_t kstep = (size_t)(BK * 2);
    constexpr size_t hstep = (size_t)HALF * K * 2;
    const unsigned ldsw = (unsigned)wid * 1024u;
    const int aoff = lds_byte(wr * 64 + fr, fq * 8), boff = lds_byte(wc * 32 + fr, fq * 8);
#define PG8_SA(b, h) (((b) * 2 + (h)) * HTB)
#define PG8_SB(b, h) ((4 + (b) * 2 + (h)) * HTB)
#define PG8_STAGE(bufoff, gbase, voff) do { _Pragma("unroll") for (int _i = 0; _i < 2; ++_i) \
        __builtin_amdgcn_global_load_lds((const unsigned*)((const char*)(gbase) + (voff)[_i]), (LAS unsigned*)(lds + (bufoff) + ldsw + _i * 8192), 16, 0, 0); } while (0)
#define PG8_STAGE_A(bufoff, gb, h, o0, o1) do { if constexpr (GATHER) { const unsigned _ko = (unsigned)((gb) - gA0); unsigned _o[2]; \
            if ((h) == 0) { _o[0] = (o0)[0] + _ko; _o[1] = (o0)[1] + _ko; } else { _o[0] = (o1)[0] + _ko; _o[1] = (o1)[1] + _ko; } PG8_STAGE(bufoff, gA0, _o); } \
        else { PG8_STAGE(bufoff, (gb) + (h) * hstep, voffA); } } while (0)
#define PG8_LDA(dst, b, h) do { _Pragma("unroll") for (int m = 0; m < 4; ++m) _Pragma("unroll") for (int k = 0; k < 2; ++k) dst[m][k] = *(const LAS bf16x8*)(lds + PG8_SA(b, h) + aoff + m * 2048 + k * 1024); } while (0)
#define PG8_LDB(dst, b, h) do { _Pragma("unroll") for (int n = 0; n < 2; ++n) _Pragma("unroll") for (int k = 0; k < 2; ++k) dst[n][k] = *(const LAS bf16x8*)(lds + PG8_SB(b, h) + boff + n * 2048 + k * 1024); } while (0)
#define PG8_MMA(ai, bj, At, Bt) do { __builtin_amdgcn_s_setprio(1); _Pragma("unroll") for (int m = 0; m < 4; ++m) _Pragma("unroll") for (int n = 0; n < 2; ++n) _Pragma("unroll") for (int k = 0; k < 2; ++k) \
        acc[ai][bj][m][n] = __builtin_amdgcn_mfma_f32_16x16x32_bf16(Bt[n][k], At[m][k], acc[ai][bj][m][n], 0, 0, 0); __builtin_amdgcn_s_setprio(0); } while (0)
#define PG8_WAIT_V(n) asm volatile("s_waitcnt vmcnt(" #n ")" ::: "memory")
#define PG8_WAIT_L(n) asm volatile("s_waitcnt lgkmcnt(" #n ")" ::: "memory")
#define PG8_BAR __builtin_amdgcn_s_barrier()
#define PG8_SCHED __builtin_amdgcn_sched_barrier(0)
    Unit cur, nxt; int ui = 0;
    if (!S.next(0, cur)) return;
    f32x4 acc[2][2][4][2];
#pragma unroll
    for (int a = 0; a < 2; ++a)
#pragma unroll
        for (int b = 0; b < 2; ++b)
#pragma unroll
            for (int m = 0; m < 4; ++m)
#pragma unroll
                for (int n = 0; n < 2; ++n) acc[a][b][m][n] = (f32x4){0.f, 0.f, 0.f, 0.f};
    bf16x8 At[4][2], B0[2][2], B1[2][2];
    const char* cA = S.a_base(cur); const char* cB = S.b_base(cur);
    const char* const gA0 = cA;
    unsigned cv0[2] = {0u, 0u}, cv1[2] = {0u, 0u}, nv0[2] = {0u, 0u}, nv1[2] = {0u, 0u};
    if constexpr (GATHER) S.a_offs(cur, Rr, Cc, cv0, cv1);
    PG8_STAGE(PG8_SB(0, 0), cB, voffB); PG8_STAGE_A(PG8_SA(0, 0), cA, 0, cv0, cv1); PG8_STAGE(PG8_SB(0, 1), cB + hstep, voffB); PG8_STAGE_A(PG8_SA(0, 1), cA, 1, cv0, cv1);
    if (wr == 1) PG8_BAR;
    PG8_WAIT_V(4); PG8_BAR;
    PG8_STAGE(PG8_SB(1, 0), cB + kstep, voffB); PG8_STAGE_A(PG8_SA(1, 0), cA + kstep, 0, cv0, cv1); PG8_STAGE(PG8_SB(1, 1), cB + hstep + kstep, voffB);
    PG8_WAIT_V(6); PG8_BAR;
    for (;;) {
        const bool has_next = S.next(ui + 1, nxt);
        const char* nA = has_next ? S.a_base(nxt) : cA; const char* nB = has_next ? S.b_base(nxt) : cB;
        if constexpr (GATHER) { if (has_next) S.a_offs(nxt, Rr, Cc, nv0, nv1); else { nv0[0] = cv0[0]; nv0[1] = cv0[1]; nv1[0] = cv1[0]; nv1[1] = cv1[1]; } }
        for (int t = 0; t < nt; t += 2) {
            const bool last = (t == nt - 2);
            const char* a1 = cA + (size_t)(t + 1) * kstep;
            const char* a2 = last ? nA : cA + (size_t)(t + 2) * kstep; const char* b2 = last ? nB : cB + (size_t)(t + 2) * kstep;
            const char* a3 = a2 + kstep; const char* b3 = b2 + kstep;
            unsigned s0[2], s1[2];
            if constexpr (GATHER) { s0[0] = last ? nv0[0] : cv0[0]; s0[1] = last ? nv0[1] : cv0[1]; s1[0] = last ? nv1[0] : cv1[0]; s1[1] = last ? nv1[1] : cv1[1]; } else { s0[0] = s0[1] = s1[0] = s1[1] = 0u; }
            PG8_LDB(B0, 0, 0); PG8_SCHED; PG8_LDA(At, 0, 0); PG8_STAGE_A(PG8_SA(1, 1), a1, 1, cv0, cv1);
            PG8_WAIT_L(8); PG8_BAR; PG8_WAIT_L(0); PG8_MMA(0, 0, At, B0); PG8_BAR; PG8_SCHED;
            PG8_LDB(B1, 0, 1); PG8_STAGE(PG8_SB(0, 0), b2, voffB);
            PG8_BAR; PG8_WAIT_L(0); PG8_MMA(0, 1, At, B1); PG8_BAR;
            PG8_LDA(At, 0, 1); PG8_STAGE_A(PG8_SA(0, 0), a2, 0, s0, s1);
            PG8_BAR; PG8_WAIT_L(0); PG8_MMA(1, 0, At, B0); PG8_BAR; PG8_SCHED;
            PG8_STAGE(PG8_SB(0, 1), b2 + hstep, voffB);
            PG8_WAIT_V(6); PG8_BAR; PG8_MMA(1, 1, At, B1); PG8_BAR;
            PG8_LDB(B0, 1, 0); PG8_SCHED; PG8_LDA(At, 1, 0); PG8_STAGE_A(PG8_SA(0, 1), a2, 1, s0, s1);
            PG8_WAIT_L(8); PG8_BAR; PG8_WAIT_L(0); PG8_MMA(0, 0, At, B0); PG8_BAR; PG8_SCHED;
            PG8_LDB(B1, 1, 1); PG8_STAGE(PG8_SB(1, 0), b3, voffB);
            PG8_BAR; PG8_WAIT_L(0); PG8_MMA(0, 1, At, B1); PG8_BAR;
            PG8_LDA(At, 1, 1); PG8_STAGE_A(PG8_SA(1, 0), a3, 0, s0, s1);
            PG8_BAR; PG8_WAIT_L(0); PG8_MMA(1, 0, At, B0); PG8_BAR; PG8_SCHED;
            PG8_STAGE(PG8_SB(1, 1), b3 + hstep, voffB);
            PG8_WAIT_V(6); PG8_BAR; PG8_MMA(1, 1, At, B1); PG8_BAR;
        }
        E(acc, cur, wr, wc, fr, fq);
        if (!has_next) break;
#pragma unroll
        for (int a = 0; a < 2; ++a)
#pragma unroll
            for (int b = 0; b < 2; ++b)
#pragma unroll
                for (int m = 0; m < 4; ++m)
#pragma unroll
                    for (int n = 0; n < 2; ++n) acc[a][b][m][n] = (f32x4){0.f, 0.f, 0.f, 0.f};
        cur = nxt; cA = nA; cB = nB; ++ui;
        if constexpr (GATHER) { cv0[0] = nv0[0]; cv0[1] = nv0[1]; cv1[0] = nv1[0]; cv1[1] = nv1[1]; }
    }
    PG8_WAIT_V(0);
    if (wr == 0) PG8_BAR;
    PG8_BAR;
#undef PG8_SA
#undef PG8_SB
#undef PG8_STAGE
#undef PG8_STAGE_A
#undef PG8_LDA
#undef PG8_LDB
#undef PG8_MMA
#undef PG8_WAIT_V
#undef PG8_WAIT_L
#undef PG8_BAR
#undef PG8_SCHED
}
}
using pg8::Unit;
typedef f32x4 AccT[2][2][4][2];

struct Args { const float* in[28]; float* out; unsigned char* ws; int ph_lo, ph_hi, pad0, pad1; };
struct Frame {
    LAS unsigned char* lds;
    int tid, lane, wave, G, bid;
    const struct Args* a;
    unsigned char* ws; unsigned char* outb;
};
struct SchedPlain {
    pg8::StaticOrder o; const char* A; const char* Bt;
    __device__ __forceinline__ bool next(int i, Unit& u) const { return o.next(i, u); }
    __device__ __forceinline__ const char* a_base(const Unit& u) const { return A + (size_t)u.pm * (256 * 2048); }
    __device__ __forceinline__ const char* b_base(const Unit& u) const { return Bt + (size_t)u.pn * (256 * 2048); }
    __device__ __forceinline__ void a_offs(const Unit&, const int*, const int*, unsigned (&)[2], unsigned (&)[2]) const {}
};

struct EpiProj {
    static constexpr bool PERM = true;
    bf16_t *Q, *IQ, *Z, *XBC, *GA, *GB; float* MISC;
    __device__ __forceinline__ void operator()(const AccT& acc, const Unit& u, int wr, int wc, int fr, int fq) const {
        const int pn = u.pn, row0 = u.pm * 256 + wr * 64 + fr, c8 = wc * 32 + 8 * fq;
        if (pn == 6) {
#pragma unroll
            for (int ai = 0; ai < 2; ++ai)
#pragma unroll
                for (int m = 0; m < 4; ++m) { float* rp = MISC + (size_t)(row0 + ai * 128 + m * 16) * 256 + c8;
#pragma unroll
                    for (int bj = 0; bj < 2; ++bj) { *(f32x4*)(rp + bj * 128) = acc[ai][bj][m][0]; *(f32x4*)(rp + bj * 128 + 4) = acc[ai][bj][m][1]; } }
            return;
        }
        bf16_t* base; int ldc, colt, act = 0;
        if (pn < 4) { base = Q; ldc = 1024; colt = pn * 256; }
        else if (pn < 6) { base = IQ; ldc = 512; colt = (pn - 4) * 256; }
        else if (pn < 11) { base = Z; ldc = 1024; colt = (pn - 7) * 256; act = 1; }
        else if (pn < 19) { base = XBC; ldc = 2048; colt = (pn - 11) * 256; }
        else if (pn < 23) { base = GA; ldc = 1024; colt = (pn - 19) * 256; act = 2; }
        else { base = GB; ldc = 1024; colt = (pn - 23) * 256; act = 2; }
#pragma unroll
        for (int ai = 0; ai < 2; ++ai)
#pragma unroll
            for (int m = 0; m < 4; ++m) { bf16_t* rp = base + (size_t)(row0 + ai * 128 + m * 16) * ldc + colt + c8;
#pragma unroll
                for (int bj = 0; bj < 2; ++bj) { f32x4 v0 = acc[ai][bj][m][0], v1 = acc[ai][bj][m][1];
                    if (act == 1) {
#pragma unroll
                        for (int j = 0; j < 4; ++j) { v0[j] = silu_f(v0[j]); v1[j] = silu_f(v1[j]); } }
                    if (act == 2) {
#pragma unroll
                        for (int j = 0; j < 4; ++j) { v0[j] = sigmoid_f(v0[j]); v1[j] = sigmoid_f(v1[j]); } }
                    *(u32x4*)(rp + bj * 128) = pack8(v0, v1); } }
    }
};
template <int MODE> struct EpiGate {
    static constexpr bool PERM = true;
    const bf16_t* Gt; const bf16_t* T; bf16_t* O;
    __device__ __forceinline__ void operator()(const AccT& acc, const Unit& u, int wr, int wc, int fr, int fq) const {
        const int row0 = u.pm * 256 + wr * 64 + fr, c8 = u.pn * 256 + wc * 32 + 8 * fq;
#pragma unroll
        for (int ai = 0; ai < 2; ++ai)
#pragma unroll
            for (int m = 0; m < 4; ++m) { const size_t off = (size_t)(row0 + ai * 128 + m * 16) * 1024 + c8;
#pragma unroll
                for (int bj = 0; bj < 2; ++bj) { f32x4 g0, g1; unpack8(*(const u32x4*)(Gt + off + bj * 128), g0, g1);
                    f32x4 v0 = g0 * acc[ai][bj][m][0], v1 = g1 * acc[ai][bj][m][1];
                    if (MODE == 1) { f32x4 t0, t1; unpack8(*(const u32x4*)(T + off + bj * 128), t0, t1); v0 += t0; v1 += t1; }
                    *(u32x4*)(O + off + bj * 128) = pack8(v0, v1); } }
    }
};
struct EpiOut {
    static constexpr bool PERM = false;
    const float* x; const float* mod; float* V;
    __device__ __forceinline__ void operator()(const AccT& acc, const Unit& u, int wr, int wc, int fr, int fq) const {
        const int row0 = u.pm * 256 + wr * 64 + fr, col0 = u.pn * 256 + wc * 32 + 4 * fq;
        const float* g1 = mod + (size_t)(u.pm >> 3) * 6144 + 2048 + col0;
        f32x4 gv[2][2];
#pragma unroll
        for (int bj = 0; bj < 2; ++bj)
#pragma unroll
            for (int n = 0; n < 2; ++n) gv[bj][n] = *(const f32x4*)(g1 + bj * 128 + n * 16);
#pragma unroll
        for (int ai = 0; ai < 2; ++ai)
#pragma unroll
            for (int m = 0; m < 4; ++m) { const size_t off = (size_t)(row0 + ai * 128 + m * 16) * 1024 + col0;
#pragma unroll
                for (int bj = 0; bj < 2; ++bj)
#pragma unroll
                    for (int n = 0; n < 2; ++n) { const f32x4 xv = *(const f32x4*)(x + off + bj * 128 + n * 16);
                        *(f32x4*)(V + off + bj * 128 + n * 16) = xv * DN_ALPHA + gv[bj][n] * acc[ai][bj][m][n]; } }
    }
};

struct MoeTab { LAS unsigned* cnt; LAS unsigned* tb; LAS unsigned char* te; int ntiles; };
__device__ __forceinline__ MoeTab moe_tables(Frame& F, int hf) {
    MoeTab T; T.cnt = (LAS unsigned*)(F.lds + LDS_AUX); T.tb = (LAS unsigned*)(F.lds + LDS_AUX + 256); T.te = (LAS unsigned char*)(F.lds + LDS_AUX + 512);
    const unsigned* CNT = (const unsigned*)(F.ws + WS_CTL) + CW_CNT;
    __syncthreads();
    if (F.tid < 32) { unsigned c = __hip_atomic_load(CNT + 64 * (hf * 32 + F.tid), __ATOMIC_RELAXED, __HIP_MEMORY_SCOPE_AGENT); if (c > (unsigned)REG_CAP) c = REG_CAP; T.cnt[F.tid] = c; }
    __syncthreads();
    if (F.tid == 0) { unsigned s = 0;
#pragma nounroll
        for (int e = 0; e < 32; ++e) { T.tb[e] = s; const unsigned n = (T.cnt[e] + 255u) >> 8;
#pragma nounroll
            for (unsigned t = 0; t < n; ++t) T.te[s + t] = (unsigned char)e;
            s += n; }
        T.tb[32] = s; }
    __syncthreads();
    T.ntiles = __builtin_amdgcn_readfirstlane((int)T.tb[32]);
    return T;
}
template <int NJ, bool GATHER> struct SchedMoe {
    MoeTab T; int G, c, hf; const char* A; const char* Bt; const u32x2* REG;
    __device__ __forceinline__ bool next(int i, Unit& u) const {
        const int L = i * G + c; if (L >= T.ntiles * NJ) return false;
        u.pm = L / NJ; u.pn = L % NJ; u.ex = __builtin_amdgcn_readfirstlane((int)T.te[u.pm]); return true;
    }
    __device__ __forceinline__ const char* a_base(const Unit& u) const { return GATHER ? A : A + (size_t)u.pm * (256 * 2048); }
    __device__ __forceinline__ const char* b_base(const Unit& u) const { return Bt + ((size_t)u.ex * (NJ * 256) + (size_t)u.pn * 256) * 2048; }
    __device__ __forceinline__ void a_offs(const Unit& u, const int* R, const int* C, unsigned (&o0)[2], unsigned (&o1)[2]) const {
        const unsigned cnt = __builtin_amdgcn_readfirstlane(T.cnt[u.ex]), pos0 = ((unsigned)u.pm - (unsigned)__builtin_amdgcn_readfirstlane(T.tb[u.ex])) * 256u; const u32x2* rg = REG + ((size_t)hf * 32 + u.ex) * REG_CAP;
#pragma unroll
        for (int i = 0; i < 2; ++i) {
            const unsigned p0 = pos0 + (unsigned)R[i], p1 = p0 + 128u;
            unsigned t0 = 0u, t1 = 0u;
            if (p0 < cnt) t0 = (unsigned)hf * HALF_TOK + (rg[p0].x >> 2);
            if (p1 < cnt) t1 = (unsigned)hf * HALF_TOK + (rg[p1].x >> 2);
            o0[i] = t0 * 2048u + (unsigned)C[i] * 2u; o1[i] = t1 * 2048u + (unsigned)C[i] * 2u;
        }
    }
};
struct EpiMoe1 {
    static constexpr bool PERM = true;
    const float* b1; bf16_t* ACT;
    __device__ __forceinline__ void operator()(const AccT& acc, const Unit& u, int wr, int wc, int fr, int fq) const {
        const int row0 = u.pm * 256 + wr * 64 + fr, c8 = u.pn * 128 + wc * 32 + 8 * fq;
        const float* bg = b1 + (size_t)u.ex * 2048 + c8;
        const f32x4 bg0 = *(const f32x4*)bg, bg1 = *(const f32x4*)(bg + 4), bu0 = *(const f32x4*)(bg + 1024), bu1 = *(const f32x4*)(bg + 1028);
#pragma unroll
        for (int ai = 0; ai < 2; ++ai)
#pragma unroll
            for (int m = 0; m < 4; ++m) {
                f32x4 g0 = acc[ai][0][m][0] + bg0, g1 = acc[ai][0][m][1] + bg1, u0 = acc[ai][1][m][0] + bu0, u1 = acc[ai][1][m][1] + bu1, a0, a1;
#pragma unroll
                for (int j = 0; j < 4; ++j) {
                    float g = fminf(g0[j], 7.0f), up = fminf(fmaxf(u0[j], -7.0f), 7.0f); a0[j] = (up + 1.0f) * g * sigmoid_f(1.702f * g);
                    g = fminf(g1[j], 7.0f); up = fminf(fmaxf(u1[j], -7.0f), 7.0f); a1[j] = (up + 1.0f) * g * sigmoid_f(1.702f * g); }
                *(u32x4*)(ACT + (size_t)(row0 + ai * 128 + m * 16) * 1024 + c8) = pack8(a0, a1); }
    }
};
struct EpiMoe2 {
    static constexpr bool PERM = true;
    const float* b2; bf16_t* YB; const u32x2* REG; MoeTab T; int hf;
    __device__ __forceinline__ void operator()(const AccT& acc, const Unit& u, int wr, int wc, int fr, int fq) const {
        const int c8 = u.pn * 256 + wc * 32 + 8 * fq;
        const unsigned cnt = __builtin_amdgcn_readfirstlane(T.cnt[u.ex]), pos0 = ((unsigned)u.pm - (unsigned)__builtin_amdgcn_readfirstlane(T.tb[u.ex])) * 256u + (unsigned)(wr * 64 + fr); const u32x2* rg = REG + ((size_t)hf * 32 + u.ex) * REG_CAP;
        const float* bb = b2 + (size_t)u.ex * 1024 + c8;
        f32x4 bv[2][2];
#pragma unroll
        for (int bj = 0; bj < 2; ++bj) { bv[bj][0] = *(const f32x4*)(bb + bj * 128); bv[bj][1] = *(const f32x4*)(bb + bj * 128 + 4); }
#pragma unroll
        for (int ai = 0; ai < 2; ++ai)
#pragma unroll
            for (int m = 0; m < 4; ++m) { const unsigned p = pos0 + (unsigned)(ai * 128 + m * 16);
                if (p < cnt) { const u32x2 en = rg[p]; const float g = __uint_as_float(en.y); bf16_t* rp = YB + (size_t)en.x * 1024 + c8;
#pragma unroll
                    for (int bj = 0; bj < 2; ++bj) *(u32x4*)(rp + bj * 128) = pack8((acc[ai][bj][m][0] + bv[bj][0]) * g, (acc[ai][bj][m][1] + bv[bj][1]) * g); } }
    }
};

struct MapIdent { __device__ __forceinline__ int operator()(int n) const { return n; } };
struct MapWin { __device__ __forceinline__ int operator()(int n) const {
    if (n < 1024) return n;
    if (n < 1536) return 1152 + (n - 1024);
    if (n < 1792) { const int c = n - 1536; if (c < 128) return 1024 + c; if (c < 192) return 1664 + (c - 128); if (c < 200) return 1728 + (c - 192); if (c < 216) return 4808 + (c - 200); return -1; }
    if (n < 2816) return 1736 + (n - 1792);
    if (n < 4864) return 2760 + (n - 2816);
    if (n < 5888) return 4824 + (n - 4864);
    return 5848 + (n - 5888); } };
struct MapW1 { __device__ __forceinline__ int operator()(int r) const { const int j = r >> 8, rr = r & 255; return (rr >> 7) * 1024 + j * 128 + (rr & 127); } };
template <class Map> __device__ __forceinline__ void transpose_item(const float* W, int K, int N, bf16_t* WT, const Map& map, LAS float* scr, int kb, int nb, int lane, const float* rowscale) {
    const int k0 = 64 * kb, n0 = 32 * nb; const int src = map(n0 + (lane & 31));
#pragma unroll 8
    for (int i = 0; i < 32; ++i) { const int kk = 2 * i + (lane >> 5); float v = 0.f; if (src >= 0) v = W[(size_t)(k0 + kk) * N + src]; if (rowscale) v *= rowscale[k0 + kk]; scr[kk * 33 + (lane & 31)] = v; }
    LDS_WAIT(); asm volatile("" ::: "memory");
    const int c = lane & 7;
#pragma unroll
    for (int j = 0; j < 4; ++j) { const int n = (lane >> 3) + 8 * j; const LAS float* s = scr + (8 * c) * 33 + n;
        u32x4 o; o.x = cvt_pk_bf16(s[0 * 33], s[1 * 33]); o.y = cvt_pk_bf16(s[2 * 33], s[3 * 33]); o.z = cvt_pk_bf16(s[4 * 33], s[5 * 33]); o.w = cvt_pk_bf16(s[6 * 33], s[7 * 33]);
        *(u32x4*)(WT + (size_t)(n0 + n) * K + k0 + 8 * c) = o; }
    LDS_WAIT(); asm volatile("" ::: "memory");
}
__device__ __forceinline__ void ph_prologue(Frame& F) {
    const float* c_in = F.a->in[1]; const float* w_mod = F.a->in[2]; const float* b_mod = F.a->in[3];
    float* MOD = (float*)(F.ws + WS_MOD);
    for (int item = F.bid; item < 48; item += F.G) {
        LAS float* SC = (LAS float*)F.lds;
        __syncthreads();
        for (int i = F.tid; i < 32768; i += NTHR) { const int b = i >> 10, k = i & 1023; SC[k * 32 + b] = silu_f(c_in[i]); }
        __syncthreads();
        const int col = item * 128 + (F.tid >> 2), kq = F.tid & 3;
        float a[32];
#pragma unroll
        for (int b = 0; b < 32; ++b) a[b] = 0.f;
        for (int kk = 0; kk < 256; ++kk) { const int k = kq * 256 + kk; const float w = w_mod[(size_t)k * 6144 + col];
#pragma unroll
            for (int b4 = 0; b4 < 8; ++b4) { const f32x4 s = *(const LAS f32x4*)(SC + k * 32 + b4 * 4); a[b4 * 4 + 0] += w * s[0]; a[b4 * 4 + 1] += w * s[1]; a[b4 * 4 + 2] += w * s[2]; a[b4 * 4 + 3] += w * s[3]; } }
#pragma unroll
        for (int b = 0; b < 32; ++b) { a[b] += __shfl_xor(a[b], 1); a[b] += __shfl_xor(a[b], 2); }
        if (kq == 0) { const float bm = b_mod[col];
#pragma unroll
            for (int b = 0; b < 32; ++b) MOD[(size_t)b * 6144 + col] = a[b] + bm; }
        __syncthreads();
    }
    if (F.bid == (F.G > 48 ? 48 : 0)) {
        float* BT = (float*)(F.ws + WS_BIAST); const float* rel_bias = F.a->in[8];
        for (int i = F.tid; i < 249 * 8; i += NTHR) { const int idx = i >> 3, h = i & 7, rel = idx - 185; const int n = rel < 0 ? -rel : rel;
            const float nf = (float)(n > 1 ? n : 1); int large = 8 + (int)(logf(nf / 8.0f) / 2.7725887f * 8.0f); if (large > 15) large = 15;
            const int bucket = (rel > 0 ? 16 : 0) + (n < 8 ? n : large);
            BT[i] = rel_bias[bucket * 8 + h] * LOG2E; }
    }
    LAS float* scr = (LAS float*)(F.lds + F.wave * 16384);
    __syncthreads();
    const int gw = F.bid * NWAVES + F.wave, NGW = F.G * NWAVES;
    constexpr int I_WIN = 16 * (NPROJ / 32), I_SQ = 16 * 32, I_W1E = 16 * 64, I_W2E = 16 * 32;
    constexpr int NITEMS = I_WIN + 3 * I_SQ + 32 * I_W1E + 32 * I_W2E;
    for (int it = gw; it < NITEMS; it += NGW) {
        int r = it;
        if (r < I_WIN) { transpose_item(F.a->in[4], 1024, 6872, (bf16_t*)(F.ws + WS_WIN), MapWin(), scr, r / (NPROJ / 32), r % (NPROJ / 32), F.lane, nullptr); continue; } r -= I_WIN;
        if (r < I_SQ) { transpose_item(F.a->in[15], 1024, 1024, (bf16_t*)(F.ws + WS_WPA), MapIdent(), scr, r / 32, r % 32, F.lane, nullptr); continue; } r -= I_SQ;
        if (r < I_SQ) { transpose_item(F.a->in[16], 1024, 1024, (bf16_t*)(F.ws + WS_WPB), MapIdent(), scr, r / 32, r % 32, F.lane, F.a->in[14]); continue; } r -= I_SQ;
        if (r < I_SQ) { transpose_item(F.a->in[17], 1024, 1024, (bf16_t*)(F.ws + WS_WOUT), MapIdent(), scr, r / 32, r % 32, F.lane, nullptr); continue; } r -= I_SQ;
        if (r < 32 * I_W1E) { const int e = r / I_W1E, q = r % I_W1E; transpose_item(F.a->in[22] + (size_t)e * 1024 * 2048, 1024, 2048, (bf16_t*)(F.ws + WS_W1) + (size_t)e * 2048 * 1024, MapW1(), scr, q / 64, q % 64, F.lane, nullptr); continue; } r -= 32 * I_W1E;
        { const int e = r / I_W2E, q = r % I_W2E; transpose_item(F.a->in[24] + (size_t)e * 1024 * 1024, 1024, 1024, (bf16_t*)(F.ws + WS_W2) + (size_t)e * 1024 * 1024, MapIdent(), scr, q / 32, q % 32, F.lane, nullptr); }
    }
}

__device__ __forceinline__ void ph_ln1(Frame& F) {
    const float* x = F.a->in[0]; const float* MOD = (const float*)(F.ws + WS_MOD); bf16_t* U = (bf16_t*)(F.outb + OUT_U);
    const int gw = F.bid * NWAVES + F.wave, NGW = F.G * NWAVES;
    for (int m = gw; m < NTOK; m += NGW) {
        const f32x4* xr = (const f32x4*)(x + (size_t)m * D) + F.lane; const float* md = MOD + (size_t)(m >> 11) * 6144;
        f32x4 v[4]; float s = 0.f;
#pragma unroll
        for (int j = 0; j < 4; ++j) { v[j] = xr[64 * j]; s += (v[j][0] + v[j][1]) + (v[j][2] + v[j][3]); }
        const float mean = wave_sum(s) * (1.f / D); float s2 = 0.f;
#pragma unroll
        for (int j = 0; j < 4; ++j) { v[j] = v[j] - mean; s2 += (v[j][0] * v[j][0] + v[j][1] * v[j][1]) + (v[j][2] * v[j][2] + v[j][3] * v[j][3]); }
        const float rstd = 1.f / sqrtf(wave_sum(s2) * (1.f / D) + LN_EPS);
        u32x2* o8 = (u32x2*)(U + (size_t)m * D) + F.lane;
#pragma unroll
        for (int j = 0; j < 4; ++j) { const f32x4 sh = *((const f32x4*)md + F.lane + 64 * j), sc = *((const f32x4*)(md + 1024) + F.lane + 64 * j);
            const f32x4 r = v[j] * rstd * (sc + 1.0f) + sh; u32x2 w; w.x = cvt_pk_bf16(r[0], r[1]); w.y = cvt_pk_bf16(r[2], r[3]); o8[64 * j] = w; }
    }
}

__device__ __forceinline__ void ph_misc(Frame& F) {
    const float* MISC = (const float*)(F.outb + OUT_MISC);
    bf16_t* KV = (bf16_t*)(F.outb + OUT_KV); bf16_t* IK = (bf16_t*)(F.outb + OUT_IK); float* IW = (float*)(F.outb + OUT_IW); float* DT = (float*)(F.outb + OUT_DT);
    const float* kvw = F.a->in[5]; const float* ikw = F.a->in[6]; const float* ikb = F.a->in[7]; const float* dtb = F.a->in[11];
    const int gw = F.bid * NWAVES + F.wave, NGW = F.G * NWAVES, l = F.lane;
    for (int m = gw; m < NTOK; m += NGW) {
        const f32x4 v = *((const f32x4*)(MISC + (size_t)m * 256) + l);
        const float sq = v[0] * v[0] + v[1] * v[1] + v[2] * v[2] + v[3] * v[3], sm = (v[0] + v[1]) + (v[2] + v[3]);
        const float kvss = wave_sum(l < 32 ? sq : 0.f);
        const float iks = wave_sum((l >= 32 && l < 48) ? sm : 0.f);
        const float ikmean = iks * (1.f / 64.f);
        const f32x4 dv = v - ikmean;
        const float ikq = wave_sum((l >= 32 && l < 48) ? (dv[0] * dv[0] + dv[1] * dv[1] + dv[2] * dv[2] + dv[3] * dv[3]) : 0.f);
        if (l < 32) { const float r = 1.f / sqrtf(kvss * (1.f / 128.f) + LN_EPS); const f32x4 w = *((const f32x4*)kvw + l); const f32x4 o = v * r * w;
            u32x2 pk; pk.x = cvt_pk_bf16(o[0], o[1]); pk.y = cvt_pk_bf16(o[2], o[3]); *((u32x2*)(KV + (size_t)m * 128) + l) = pk; }
        else if (l < 48) { const float r = 1.f / sqrtf(ikq * (1.f / 64.f) + LN_EPS); const f32x4 w = *((const f32x4*)ikw + (l - 32)), bb = *((const f32x4*)ikb + (l - 32)); const f32x4 o = dv * r * w + bb;
            u32x2 pk; pk.x = cvt_pk_bf16(o[0], o[1]); pk.y = cvt_pk_bf16(o[2], o[3]); *((u32x2*)(IK + (size_t)m * 64) + (l - 32)) = pk; }
        else if (l < 50) { *((f32x4*)(IW + (size_t)m * 8) + (l - 48)) = v * 0.35355339059327373f; }
        else if (l < 54) { const f32x4 bb = *((const f32x4*)dtb + (l - 50)); f32x4 o;
#pragma unroll
            for (int j = 0; j < 4; ++j) { const float t = v[j] + bb[j]; o[j] = t > 20.f ? t : log1pf(__expf(t)); }
            *((f32x4*)(DT + (size_t)m * 16) + (l - 50)) = o; }
    }
}

__device__ __forceinline__ unsigned sortable_key(float s) { const unsigned u = __float_as_uint(s + 0.0f); return (u & 0x80000000u) ? ~u : (u | 0x80000000u); }
template <int NKB> struct KeyRow { unsigned k[NKB]; };
__device__ __forceinline__ u64 low_bits_keep(u64 m, int t) { u64 out = 0; while (t-- > 0 && m) { const u64 b = m & (0 - m); out |= b; m ^= b; } return out; }
__device__ __forceinline__ void topk_select_write(const unsigned (&key)[32], int nkb, u64* mrow, int lane) {
    unsigned T = 0u; bool exact = false;
    for (int bit = 31; bit >= 0; --bit) {
        const unsigned cand = T | (1u << bit); int cnt = 0;
#pragma unroll
        for (int j = 0; j < 32; ++j) if (j < nkb) cnt += __builtin_popcountll(__ballot(key[j] >= cand));
        if (cnt >= 256) T = cand;
        if (cnt == 256) { exact = true; break; }
    }
    u64 mine = 0ull;
    if (exact) {
#pragma unroll
        for (int j = 0; j < 32; ++j) if (j < nkb) { const u64 m = __ballot(key[j] >= T); if (lane == j) mine = m; }
    } else {
        int cgt = 0;
#pragma unroll
        for (int j = 0; j < 32; ++j) if (j < nkb) cgt += __builtin_popcountll(__ballot(key[j] > T));
        int rem = 256 - cgt;
#pragma unroll
        for (int j = 0; j < 32; ++j) if (j < nkb) { const u64 gt = __ballot(key[j] > T), eq = __ballot(key[j] == T); const int ne = __builtin_popcountll(eq);
            u64 m = gt; if (rem >= ne) { m |= eq; rem -= ne; } else if (rem > 0) { m |= low_bits_keep(eq, rem); rem = 0; }
            if (lane == j) mine = m; }
    }
    if (lane < nkb) mrow[lane] = mine;
}
__device__ __forceinline__ void ph_index(Frame& F) {
    const bf16_t* IQ = (const bf16_t*)(F.outb + OUT_IQ); const bf16_t* IK = (const bf16_t*)(F.outb + OUT_IK); const float* IW = (const float*)(F.outb + OUT_IW);
    u64* MASK = (u64*)(F.outb + OUT_MASK);
    const int gw = F.bid * NWAVES + F.wave, NGW = F.G * NWAVES, lane = F.lane, r32 = lane & 31, hi = lane >> 5;
    for (int item = gw; item < NTOK / 4; item += NGW) {
        const int tok0 = item * 4, b = tok0 >> 11, pos0 = tok0 & 2047, nkb = (pos0 >> 6) + 1;
        u64* mrow = MASK + (size_t)tok0 * 32;
        if (nkb <= 4) {
#pragma unroll
            for (int q = 0; q < 4; ++q) if (lane < nkb) mrow[q * 32 + lane] = ~0ull;
            continue;
        }
        bf16x8 af[4];
        { const bf16_t* ap = IQ + (size_t)(tok0 + (r32 >> 3)) * 512 + (r32 & 7) * 64 + hi * 8;
#pragma unroll
          for (int ks = 0; ks < 4; ++ks) af[ks] = *(const bf16x8*)(ap + ks * 16); }
        f32x4 iwv[4];
#pragma unroll
        for (int q = 0; q < 4; ++q) iwv[q] = *(const f32x4*)(IW + (size_t)(tok0 + q) * 8 + 4 * hi);
        unsigned key[4][32];
        const bf16_t* kb0 = IK + (size_t)(b * SEQ + r32) * 64 + hi * 8;
#pragma unroll
        for (int j = 0; j < 32; ++j) {
            if (j < nkb) {
                const bf16_t* kp = kb0 + (size_t)j * 64 * 64;
                bf16x8 bA[4], bB[4];
#pragma unroll
                for (int ks = 0; ks < 4; ++ks) { bA[ks] = *(const bf16x8*)(kp + ks * 16); bB[ks] = *(const bf16x8*)(kp + 32 * 64 + ks * 16); }
                f32x16 cA = {}, cB = {};
#pragma unroll
                for (int ks = 0; ks < 4; ++ks) { cA = __builtin_amdgcn_mfma_f32_32x32x16_bf16(af[ks], bA[ks], cA, 0, 0, 0); cB = __builtin_amdgcn_mfma_f32_32x32x16_bf16(af[ks], bB[ks], cB, 0, 0, 0); }
#pragma unroll
                for (int q = 0; q < 4; ++q) {
                    float pA = 0.f, pB = 0.f;
#pragma unroll
                    for (int t = 0; t < 4; ++t) { pA += fmaxf(cA[4 * q + t], 0.f) * iwv[q][t]; pB += fmaxf(cB[4 * q + t], 0.f) * iwv[q][t]; }
                    auto rr = __builtin_amdgcn_permlane32_swap(__float_as_uint(pA), __float_as_uint(pB), false, false);
                    key[q][j] = sortable_key(__uint_as_float(rr[0]) + __uint_as_float(rr[1]));
                }
            } else {
#pragma unroll
                for (int q = 0; q < 4; ++q) key[q][j] = 0u;
            }
        }
#pragma unroll
        for (int q = 0; q < 4; ++q) topk_select_write(key[q], nkb, mrow + q * 32, lane);
    }
}

namespace att {
constexpr int KVBLK = 64;
constexpr int SHM_V = KVBLK * 128 * 2, SHM_K = SHM_V;
constexpr int OFF_V = 0, OFF_K = 2 * SHM_V, OFF_WS = 2 * SHM_V + 2 * SHM_K, OFF_BT = OFF_WS + NWAVES * 64 * 4;
#define KSWZ(row, colB) ((row) * 256 + ((colB) ^ (((row) & 7) << 4)))
__device__ __forceinline__ int crow(int r, int hi) { return (r & 3) + 8 * (r >> 2) + 4 * hi; }
__device__ __forceinline__ int v_st(int k, int c) { const int kk = (k & ~0xC) | ((k & 4) << 1) | ((k & 8) >> 1); return ((kk >> 3) * 4 + (c >> 5)) * 512 + ((kk & 7) * 32 + (c & 31)) * 2; }
__device__ __forceinline__ int v_rd_base(int lane) { return ((lane & 3) << 3) | (((lane >> 2) & 3) << 6) | (((lane >> 4) & 1) << 5) | (((lane >> 5) & 1) << 8); }
constexpr int v_rd_off(int d0, int ks, int half) { return d0 * 512 + ks * 4096 + half * 2048; }
template <int OFF> __device__ __forceinline__ s16x4 tr_read(int vb) { s16x4 r; asm volatile("ds_read_b64_tr_b16 %0, %1 offset:%2" : "=&v"(r) : "v"(vb), "i"(OFF) : "memory"); return r; }
template <int D0> __device__ __forceinline__ void pv_one(f32x16& od, int vb, bf16x8 pa0, bf16x8 pa1, bf16x8 pa2, bf16x8 pa3) {
    const s16x4 l0 = tr_read<v_rd_off(D0, 0, 0)>(vb), h0 = tr_read<v_rd_off(D0, 0, 1)>(vb), l1 = tr_read<v_rd_off(D0, 1, 0)>(vb), h1 = tr_read<v_rd_off(D0, 1, 1)>(vb);
    const s16x4 l2 = tr_read<v_rd_off(D0, 2, 0)>(vb), h2 = tr_read<v_rd_off(D0, 2, 1)>(vb), l3 = tr_read<v_rd_off(D0, 3, 0)>(vb), h3 = tr_read<v_rd_off(D0, 3, 1)>(vb);
    asm volatile("s_waitcnt lgkmcnt(0)" ::: "memory"); SBAR();
#define PK(L, H) (bf16x8){L[0], L[1], L[2], L[3], H[0], H[1], H[2], H[3]}
    od = __builtin_amdgcn_mfma_f32_32x32x16_bf16(pa0, PK(l0, h0), od, 0, 0, 0);
    od = __builtin_amdgcn_mfma_f32_32x32x16_bf16(pa1, PK(l1, h1), od, 0, 0, 0);
    od = __builtin_amdgcn_mfma_f32_32x32x16_bf16(pa2, PK(l2, h2), od, 0, 0, 0);
    od = __builtin_amdgcn_mfma_f32_32x32x16_bf16(pa3, PK(l3, h3), od, 0, 0, 0);
#undef PK
}
__device__ __forceinline__ void qkt(f32x16& p0, f32x16& p1, const char* Ks, const bf16x8* qr, int r32, int hi) {
    p0 = f32x16{}; p1 = f32x16{};
    int rv = r32; asm volatile("" : "+v"(rv));
    const char* kb = Ks + rv * 256; const int swz = ((rv & 7) << 4) ^ (hi * 16);
#pragma unroll
    for (int d0 = 0; d0 < 8; ++d0) { const char* ka = kb + ((d0 * 32) ^ swz);
        const bf16x8 b0 = *reinterpret_cast<const bf16x8*>(ka);
        const bf16x8 b1 = *reinterpret_cast<const bf16x8*>(ka + 8192);
        p0 = __builtin_amdgcn_mfma_f32_32x32x16_bf16(b0, qr[d0], p0, 0, 0, 0);
        p1 = __builtin_amdgcn_mfma_f32_32x32x16_bf16(b1, qr[d0], p1, 0, 0, 0); }
}
__device__ __forceinline__ void attn_item(Frame& F, int b, int q0, char* lds) {
    const bf16_t* Q = (const bf16_t*)(F.ws + WS_Q); const bf16_t* KV = (const bf16_t*)(F.outb + OUT_KV); const u64* MASK = (const u64*)(F.outb + OUT_MASK);
    bf16_t* OA = (bf16_t*)(F.outb + OUT_OA);
    const int tid = F.tid, wid = F.wave, lane = F.lane, r32 = lane & 31, hi = lane >> 5;
    char* V_lds = lds + OFF_V; char* K_lds = lds + OFF_K;
    float* wsl = (float*)(lds + OFF_WS) + wid * 64; float* li_l = wsl; float* al_l = wsl + 32;
    const float* btab = (const float*)(lds + OFF_BT);
    constexpr float C = 0.088388347648318440f * LOG2E;
    float m_reg = -1e30f, l_reg = 0.f; f32x16 o[4] = {}; bf16x8 qr[8];
    const size_t tokq = (size_t)b * SEQ + q0 + r32;
    { const bf16_t* Qw = Q + tokq * 1024 + wid * 128 + hi * 8;
#pragma unroll
      for (int d0 = 0; d0 < 8; ++d0) qr[d0] = *(const bf16x8*)(Qw + d0 * 16); }
    const u64* mq = MASK + tokq * 32;
    const int sr = tid >> 4, sc = (tid & 15) * 8;
    const int vb0 = (int)(uintptr_t)V_lds + v_rd_base(lane);
    const bf16_t* Kb = KV + (size_t)b * SEQ * 128;
    const int NT = (q0 >> 6) + 1;
    const float bfar = btab[wid];
    bf16x8 s0, s1;
#define SLOAD(k0) do { s0 = *(const bf16x8*)(Kb + (size_t)((k0) + sr) * 128 + sc); s1 = *(const bf16x8*)(Kb + (size_t)((k0) + 32 + sr) * 128 + sc); } while (0)
#define SWRITE(bf) do { int srv = sr; asm volatile("" : "+v"(srv)); const int kc = sc * 2; const int v0a = v_st(srv, sc), k0a = KSWZ(srv, kc); \
        *(bf16x8*)(V_lds + (bf) * SHM_V + v0a) = s0; *(bf16x8*)(V_lds + (bf) * SHM_V + v0a + 8192) = s1; \
        *(bf16x8*)(K_lds + (bf) * SHM_K + k0a) = s0; *(bf16x8*)(K_lds + (bf) * SHM_K + k0a + 8192) = s1; } while (0)
    __syncthreads();
    SLOAD(0); VM_WAIT(); SWRITE(0); __syncthreads();
    for (int j = 0; j < NT; ++j) {
        const int bf = j & 1;
        if (j + 1 < NT) SLOAD((j + 1) * KVBLK);
        const u64 mw = mq[j];
        f32x16 p0, p1;
        qkt(p0, p1, K_lds + bf * SHM_K, qr, r32, hi);
        const unsigned w0 = (unsigned)(mw >> (4 * hi)), w1 = (unsigned)(mw >> (32 + 4 * hi));
        const int relmax = j * KVBLK + 63 - q0;
        if (relmax <= -91) {
#pragma unroll
            for (int r = 0; r < 16; ++r) { const int cb = (r & 3) + 8 * (r >> 2);
                const float t0 = fmaf(p0[r], C, bfar), t1 = fmaf(p1[r], C, bfar); p0[r] = ((w0 >> cb) & 1u) ? t0 : -1e30f; p1[r] = ((w1 >> cb) & 1u) ? t1 : -1e30f; }
        } else {
            const float* bp = btab + (j * KVBLK + 4 * hi - (q0 + r32) + 185) * 8 + wid;
#pragma unroll
            for (int r4 = 0; r4 < 4; ++r4) {
#pragma unroll
                for (int rr = 0; rr < 4; ++rr) { const int r = r4 * 4 + rr; const int cb = (r & 3) + 8 * (r >> 2);
                    const float bv0 = bp[cb * 8], bv1 = bp[(cb + 32) * 8]; const float t0 = fmaf(p0[r], C, bv0), t1 = fmaf(p1[r], C, bv1);
                    p0[r] = ((w0 >> cb) & 1u) ? t0 : -1e30f; p1[r] = ((w1 >> cb) & 1u) ? t1 : -1e30f; }
                SBAR(); }
        }
        float pmax = p0[0];
#pragma unroll
        for (int r = 1; r < 16; ++r) pmax = fmaxf(pmax, p0[r]);
#pragma unroll
        for (int r = 0; r < 16; ++r) pmax = fmaxf(pmax, p1[r]);
        { auto rr = __builtin_amdgcn_permlane32_swap(__float_as_uint(pmax), __float_as_uint(pmax), false, false); pmax = fmaxf(__uint_as_float(rr[0]), __uint_as_float(rr[1])); }
        float alpha = 1.f;
        if (!__all(pmax - m_reg <= 11.0f)) { const float mn = fmaxf(m_reg, pmax); alpha = __builtin_amdgcn_exp2f(m_reg - mn); m_reg = mn; }
        float ps = 0.f;
#pragma unroll
        for (int r = 0; r < 16; ++r) { p0[r] = __builtin_amdgcn_exp2f(p0[r] - m_reg); p1[r] = __builtin_amdgcn_exp2f(p1[r] - m_reg); ps += p0[r] + p1[r]; }
        { auto rr = __builtin_amdgcn_permlane32_swap(__float_as_uint(ps), __float_as_uint(ps), false, false); ps = __uint_as_float(rr[0]) + __uint_as_float(rr[1]); }
        l_reg = l_reg * alpha + ps;
        bf16x8 pa0, pa1, pa2, pa3;
#define PK4(P, BASE, OUT) do { unsigned a0 = cvt_pk_bf16(P[BASE + 0], P[BASE + 1]), a1 = cvt_pk_bf16(P[BASE + 2], P[BASE + 3]);   \
    unsigned b0 = cvt_pk_bf16(P[BASE + 4], P[BASE + 5]), b1 = cvt_pk_bf16(P[BASE + 6], P[BASE + 7]);                              \
    auto r0 = __builtin_amdgcn_permlane32_swap(a0, b0, false, false); auto r1 = __builtin_amdgcn_permlane32_swap(a1, b1, false, false); \
    u32x4 w = {r0[0], r1[0], r0[1], r1[1]}; OUT = *reinterpret_cast<bf16x8*>(&w); } while (0)
        PK4(p0, 0, pa0); PK4(p0, 8, pa1); PK4(p1, 0, pa2); PK4(p1, 8, pa3);
#undef PK4
        if (__any(alpha < 1.f)) { if (hi == 0) al_l[r32] = alpha; LDS_WAIT();
#pragma unroll
            for (int d = 0; d < 4; ++d)
#pragma unroll
                for (int r = 0; r < 16; ++r) o[d][r] *= al_l[crow(r, hi)]; }
        const int vb = vb0 + bf * SHM_V;
        pv_one<0>(o[0], vb, pa0, pa1, pa2, pa3); pv_one<1>(o[1], vb, pa0, pa1, pa2, pa3); pv_one<2>(o[2], vb, pa0, pa1, pa2, pa3); pv_one<3>(o[3], vb, pa0, pa1, pa2, pa3);
        if (j + 1 < NT) { VM_WAIT(); SWRITE(bf ^ 1); }
        __syncthreads();
    }
#undef SLOAD
#undef SWRITE
    if (hi == 0) li_l[r32] = l_reg; LDS_WAIT();
    bf16_t* Ow = OA + ((size_t)b * SEQ + q0 + 4 * hi) * 1024 + wid * 128 + r32;
    const float* lip = li_l + 4 * hi;
    asm volatile("" : "+v"(Ow), "+v"(lip));
#pragma unroll
    for (int r = 0; r < 16; ++r) { const int ro = (r & 3) + 8 * (r >> 2); const float rl = fast_rcp(lip[ro]);
#pragma unroll
        for (int d0 = 0; d0 < 4; ++d0) { const float v = o[d0][r] * rl; Ow[ro * 1024 + d0 * 32] = (bf16_t)(cvt_pk_bf16(v, v) & 0xffffu); }
        if ((r & 3) == 3) SBAR(); }
}
}
__device__ __forceinline__ void ph_attn(Frame& F) {
    char* lds = (char*)(unsigned char*)F.lds;
    { float* bt = (float*)(lds + att::OFF_BT); const float* BT = (const float*)(F.ws + WS_BIAST); __syncthreads(); for (int i = F.tid; i < 249 * 8; i += NTHR) bt[i] = BT[i]; __syncthreads(); }
    for (int pr = F.bid; pr < NB * 32; pr += F.G) {
        const int b = pr >> 5, qb = pr & 31;
#pragma nounroll
        for (int hh = 0; hh < 2; ++hh) att::attn_item(F, b, (hh ? qb : 63 - qb) * 32, lds);
    }
}

namespace ssd {
constexpr int OFF_CS = 0, CS_ST = 272;
constexpr int OFF_BS = OFF_CS + 64 * CS_ST;
constexpr int OFF_BT = OFF_BS + 64 * CS_ST, T_ST = 144;
constexpr int OFF_XT = OFF_BT + 128 * T_ST;
constexpr int OFF_XW = OFF_XT + 64 * T_ST;
constexpr int OFF_XS = OFF_XW + 64 * T_ST;
constexpr int OFF_MT = OFF_XS + 64 * T_ST;
constexpr int OFF_HS = OFF_MT + 64 * T_ST;
constexpr int OFF_END = OFF_HS + 64 * CS_ST;
static_assert(OFF_END + 5 * 320 * 4 <= 131072, "ssd lds");
__device__ __forceinline__ f32x4 mfma16(bf16x8 a, bf16x8 b, f32x4 c) { return __builtin_amdgcn_mfma_f32_16x16x32_bf16(a, b, c, 0, 0, 0); }
__device__ __forceinline__ bf16x8 ldfrag(const char* base, int stride, int row, int k0) { return *(const bf16x8*)(base + row * stride + k0 * 2); }
}
__device__ __forceinline__ void ph_ssd(Frame& F) {
    using namespace ssd;
    char* lds = (char*)(unsigned char*)F.lds;
    const bf16_t* XBC = (const bf16_t*)(F.ws + WS_XBC); const bf16_t* ZS = (const bf16_t*)(F.ws + WS_Z); const float* DT = (const float*)(F.outb + OUT_DT);
    bf16_t* YG = (bf16_t*)(F.ws + WS_Q);
    const float* conv_w = F.a->in[9]; const float* conv_b = F.a->in[10]; const float* a_log = F.a->in[12]; const float* d_skip = F.a->in[13];
    const int tid = F.tid, wid = F.wave, lane = F.lane, fr = lane & 15, fq = lane >> 4;
    const bool stager = tid < 320; const int so = tid % 40, tg = tid / 40;
    for (int item = F.bid; item < NB * 16; item += F.G) {
        const int b = item >> 4, h = item & 15, g = h >> 2;
        const float aneg = -__expf(a_log[h]), dsk = d_skip[h];
        const int ch0 = so < 8 ? h * 64 + so * 8 : (so < 24 ? 1024 + g * 128 + (so - 8) * 8 : 1536 + g * 128 + (so - 24) * 8);
        float* CWL = (float*)(lds + OFF_END);
        __syncthreads();
        if (stager) {
#pragma unroll
            for (int j = 0; j < 4; ++j) { *(f32x4*)(CWL + j * 320 + so * 8) = *(const f32x4*)(conv_w + (size_t)j * 2048 + ch0); *(f32x4*)(CWL + j * 320 + so * 8 + 4) = *(const f32x4*)(conv_w + (size_t)j * 2048 + ch0 + 4); }
            *(f32x4*)(CWL + 4 * 320 + so * 8) = *(const f32x4*)(conv_b + ch0); *(f32x4*)(CWL + 4 * 320 + so * 8 + 4) = *(const f32x4*)(conv_b + ch0 + 4);
        }
        f32x4 hst[4];
#pragma unroll
        for (int t = 0; t < 4; ++t) hst[t] = (f32x4){0.f, 0.f, 0.f, 0.f};
        __syncthreads();
        for (int i = tid; i < 64 * CS_ST / 4; i += NTHR) ((unsigned*)(lds + OFF_HS))[i] = 0u;
        u32x4 raw[11];
        const size_t tokb = (size_t)b * SEQ;
#define SSD_LOAD(c) do { if (stager) { _Pragma("unroll") for (int i = 0; i < 11; ++i) { const int t = (c) * 64 + tg * 8 - 3 + i; \
            raw[i] = (t >= 0) ? *(const u32x4*)(XBC + (tokb + t) * 2048 + ch0) : (u32x4){0u, 0u, 0u, 0u}; } } } while (0)
        SSD_LOAD(0);
        for (int c = 0; c < 32; ++c) {
            const float dtl = DT[(tokb + c * 64 + lane) * 16 + h];
            float acs = dtl * aneg;
#pragma unroll
            for (int o = 1; o < 64; o <<= 1) { const float t = __shfl_up(acs, o); if (lane >= o) acs += t; }
            const float alast = __shfl(acs, 63);
            float dtv[8], dec[8];
#pragma unroll
            for (int t = 0; t < 8; ++t) { dtv[t] = __shfl(dtl, (tg * 8 + t) & 63); dec[t] = __expf(alast - __shfl(acs, (tg * 8 + t) & 63)); }
            if (stager) {
#pragma unroll
                for (int hq = 0; hq < 2; ++hq) {
                    float xin[11][4];
#pragma unroll
                    for (int i = 0; i < 11; ++i) { const unsigned wa = hq ? raw[i].z : raw[i].x, wb = hq ? raw[i].w : raw[i].y; xin[i][0] = bflo(wa); xin[i][1] = bfhi(wa); xin[i][2] = bflo(wb); xin[i][3] = bfhi(wb); }
                    float outv[8][4];
                    { f32x4 cwv[4]; const f32x4 cbq = *(const f32x4*)(CWL + 4 * 320 + so * 8 + hq * 4);
#pragma unroll
                      for (int j = 0; j < 4; ++j) cwv[j] = *(const f32x4*)(CWL + j * 320 + so * 8 + hq * 4);
#pragma unroll
                      for (int t = 0; t < 8; ++t)
#pragma unroll
                        for (int e = 0; e < 4; ++e) { float sacc = cbq[e];
#pragma unroll
                            for (int j = 0; j < 4; ++j) sacc += cwv[j][e] * xin[t + j][e];
                            outv[t][e] = silu_f(sacc); } }
                    if (so < 8) {
#pragma unroll
                        for (int e = 0; e < 4; ++e) { const int p = so * 8 + hq * 4 + e;
                            f32x4 x0, x1, d0, d1, w0, w1;
#pragma unroll
                            for (int t = 0; t < 4; ++t) { x0[t] = outv[t][e]; x1[t] = outv[4 + t][e]; d0[t] = x0[t] * dtv[t]; d1[t] = x1[t] * dtv[4 + t]; w0[t] = d0[t] * dec[t]; w1[t] = d1[t] * dec[4 + t]; }
                            *(u32x4*)(lds + OFF_XS + p * T_ST + tg * 16) = pack8(x0, x1);
                            *(u32x4*)(lds + OFF_XT + p * T_ST + tg * 16) = pack8(d0, d1);
                            *(u32x4*)(lds + OFF_XW + p * T_ST + tg * 16) = pack8(w0, w1); }
                    } else {
                        const bool isB = so < 24; const int n0 = (isB ? (so - 8) : (so - 24)) * 8 + hq * 4;
                        char* nat = lds + (isB ? OFF_BS : OFF_CS);
#pragma unroll
                        for (int t = 0; t < 8; ++t) { u32x2 w; w.x = cvt_pk_bf16(outv[t][0], outv[t][1]); w.y = cvt_pk_bf16(outv[t][2], outv[t][3]);
                            *(u32x2*)(nat + (tg * 8 + t) * CS_ST + n0 * 2) = w; }
                        if (isB) {
#pragma unroll
                            for (int e = 0; e < 4; ++e) { f32x4 a, bq;
#pragma unroll
                                for (int t = 0; t < 4; ++t) { a[t] = outv[t][e]; bq[t] = outv[4 + t][e]; }
                                *(u32x4*)(lds + OFF_BT + (n0 + e) * T_ST + tg * 16) = pack8(a, bq); }
                        }
                    }
                }
            }
            if (c + 1 < 32) SSD_LOAD(c + 1);
            __syncthreads();
#pragma unroll
            for (int t2 = 0; t2 < 2; ++t2) {
                const int tile = 2 * wid + t2, sb = tile >> 2, lb = tile & 3;
                f32x4 d = (f32x4){0.f, 0.f, 0.f, 0.f};
                if (sb <= lb) {
#pragma unroll
                    for (int ks = 0; ks < 4; ++ks) d = mfma16(ldfrag(lds + OFF_BS, CS_ST, sb * 16 + fr, ks * 32 + fq * 8), ldfrag(lds + OFF_CS, CS_ST, lb * 16 + fr, ks * 32 + fq * 8), d);
                    const int l = lb * 16 + fr; const float al = __shfl(acs, l);
                    f32x4 as;
#pragma unroll
                    for (int r = 0; r < 4; ++r) as[r] = __shfl(acs, sb * 16 + 4 * fq + r);
#pragma unroll
                    for (int r = 0; r < 4; ++r) { const int s = sb * 16 + 4 * fq + r; d[r] = (s <= l) ? d[r] * __expf(al - as[r]) : 0.f; }
                }
                u32x2 w; w.x = cvt_pk_bf16(d[0], d[1]); w.y = cvt_pk_bf16(d[2], d[3]);
                *(u32x2*)(lds + OFF_MT + (lb * 16 + fr) * T_ST + (sb * 16 + 4 * fq) * 2) = w;
            }
            f32x4 yacc[2];
#pragma unroll
            for (int t2 = 0; t2 < 2; ++t2) {
                const int tile = 2 * wid + t2, pb = tile >> 2, lb = tile & 3;
                f32x4 d = (f32x4){0.f, 0.f, 0.f, 0.f};
#pragma unroll
                for (int ks = 0; ks < 4; ++ks) d = mfma16(ldfrag(lds + OFF_HS, CS_ST, pb * 16 + fr, ks * 32 + fq * 8), ldfrag(lds + OFF_CS, CS_ST, lb * 16 + fr, ks * 32 + fq * 8), d);
                const float el = __expf(__shfl(acs, lb * 16 + fr));
                yacc[t2] = d * el;
            }
            __syncthreads();
#pragma unroll
            for (int t2 = 0; t2 < 2; ++t2) {
                const int tile = 2 * wid + t2, pb = tile >> 2, lb = tile & 3;
                f32x4 d = yacc[t2];
#pragma unroll
                for (int ks = 0; ks < 2; ++ks) d = mfma16(ldfrag(lds + OFF_XT, T_ST, pb * 16 + fr, ks * 32 + fq * 8), ldfrag(lds + OFF_MT, T_ST, lb * 16 + fr, ks * 32 + fq * 8), d);
                const int l = lb * 16 + fr, p0 = pb * 16 + 4 * fq; const size_t tok = tokb + c * 64 + l;
                const u32x2 zz = *(const u32x2*)(ZS + tok * 1024 + h * 64 + p0);
                const float z0 = bflo(zz.x), z1 = bfhi(zz.x), z2 = bflo(zz.y), z3 = bfhi(zz.y);
                float xs[4];
#pragma unroll
                for (int r = 0; r < 4; ++r) xs[r] = bflo((unsigned)*(const bf16_t*)(lds + OFF_XS + (p0 + r) * T_ST + l * 2));
                u32x2 w; w.x = cvt_pk_bf16((d[0] + xs[0] * dsk) * z0, (d[1] + xs[1] * dsk) * z1); w.y = cvt_pk_bf16((d[2] + xs[2] * dsk) * z2, (d[3] + xs[3] * dsk) * z3);
                *(u32x2*)(YG + tok * 1024 + h * 64 + p0) = w;
            }
            { const float dc = __expf(alast);
#pragma unroll
              for (int t = 0; t < 4; ++t) { f32x4 d = hst[t] * dc;
#pragma unroll
                  for (int ks = 0; ks < 2; ++ks) d = mfma16(ldfrag(lds + OFF_BT, T_ST, wid * 16 + fr, ks * 32 + fq * 8), ldfrag(lds + OFF_XW, T_ST, t * 16 + fr, ks * 32 + fq * 8), d);
                  hst[t] = d;
                  u32x2 w; w.x = cvt_pk_bf16(d[0], d[1]); w.y = cvt_pk_bf16(d[2], d[3]);
                  *(u32x2*)(lds + OFF_HS + (t * 16 + fr) * CS_ST + (wid * 16 + 4 * fq) * 2) = w; } }
            __syncthreads();
        }
#undef SSD_LOAD
    }
}

__device__ __forceinline__ void ph_gnorm(Frame& F) {
    bf16_t* YG = (bf16_t*)(F.ws + WS_Q);
    const int gw = F.bid * NWAVES + F.wave, NGW = F.G * NWAVES;
    for (int m = gw; m < NTOK; m += NGW) {
        u32x2* rp = (u32x2*)(YG + (size_t)m * D) + F.lane;
#pragma unroll
        for (int j = 0; j < 4; ++j) { const u32x2 w = rp[64 * j]; const float a = bflo(w.x), b = bfhi(w.x), c = bflo(w.y), d = bfhi(w.y);
            const float ss = wave_sum(a * a + b * b + c * c + d * d); const float r = 1.f / sqrtf(ss * (1.f / 256.f) + LN_EPS);
            u32x2 o; o.x = cvt_pk_bf16(a * r, b * r); o.y = cvt_pk_bf16(c * r, d * r); rp[64 * j] = o; }
    }
}

__device__ __forceinline__ void ph_router(Frame& F) {
    float* X1 = (float*)F.outb; bf16_t* U2 = (bf16_t*)(F.ws + WS_U2); const float* MOD = (const float*)(F.ws + WS_MOD);
    const float* ln1g = F.a->in[18]; const float* ln1b = F.a->in[19]; const float* w_router = F.a->in[20]; const float* b_router = F.a->in[21];
    u32x2* REG = (u32x2*)(F.ws + WS_REG); unsigned* CNT = (unsigned*)(F.ws + WS_CTL) + CW_CNT;
    LAS float* WRT = (LAS float*)F.lds;
    LAS unsigned* lcnt = (LAS unsigned*)(F.lds + LDS_AUX); LAS unsigned* lbase = lcnt + 32; LAS unsigned* ent = lcnt + 64;
    const int tid = F.tid, lane = F.lane, wid = F.wave;
    __syncthreads();
    for (int i = tid; i < 32768; i += NTHR) { const int c = i >> 5, e = i & 31; WRT[e * 1024 + c] = w_router[i]; }
    __syncthreads();
    for (int batch = F.bid; batch < NTOK / 256; batch += F.G) {
        const int hf = batch >> 7;
        if (tid < 32) lcnt[tid] = 0u;
        __syncthreads();
        for (int ti = 0; ti < 32; ++ti) {
            const int tl = wid * 32 + ti, m = batch * 256 + tl; const float* md = MOD + (size_t)(m >> 11) * 6144;
            f32x4* xr = (f32x4*)(X1 + (size_t)m * D) + lane;
            f32x4 v[4]; float s = 0.f;
#pragma unroll
            for (int j = 0; j < 4; ++j) { v[j] = xr[64 * j]; s += (v[j][0] + v[j][1]) + (v[j][2] + v[j][3]); }
            float mean = wave_sum(s) * (1.f / D), s2 = 0.f;
#pragma unroll
            for (int j = 0; j < 4; ++j) { v[j] = v[j] - mean; s2 += (v[j][0] * v[j][0] + v[j][1] * v[j][1]) + (v[j][2] * v[j][2] + v[j][3] * v[j][3]); }
            float rstd = 1.f / sqrtf(wave_sum(s2) * (1.f / D) + LN_EPS);
            s = 0.f;
#pragma unroll
            for (int j = 0; j < 4; ++j) { const f32x4 g = *((const f32x4*)ln1g + lane + 64 * j), bb = *((const f32x4*)ln1b + lane + 64 * j); v[j] = v[j] * rstd * g + bb; xr[64 * j] = v[j]; s += (v[j][0] + v[j][1]) + (v[j][2] + v[j][3]); }
            mean = wave_sum(s) * (1.f / D); s2 = 0.f;
#pragma unroll
            for (int j = 0; j < 4; ++j) { v[j] = v[j] - mean; s2 += (v[j][0] * v[j][0] + v[j][1] * v[j][1]) + (v[j][2] * v[j][2] + v[j][3] * v[j][3]); }
            rstd = 1.f / sqrtf(wave_sum(s2) * (1.f / D) + LN_EPS);
            u32x2* o8 = (u32x2*)(U2 + (size_t)m * D) + lane;
#pragma unroll
            for (int j = 0; j < 4; ++j) { const f32x4 sh = *((const f32x4*)(md + 3072) + lane + 64 * j), sc = *((const f32x4*)(md + 4096) + lane + 64 * j);
                v[j] = v[j] * rstd * (sc + 1.0f) + sh; u32x2 w; w.x = cvt_pk_bf16(v[j][0], v[j][1]); w.y = cvt_pk_bf16(v[j][2], v[j][3]); o8[64 * j] = w; }
            float part[32];
#pragma unroll
            for (int e = 0; e < 32; ++e) { float a = 0.f;
#pragma unroll
                for (int j = 0; j < 4; ++j) { const f32x4 w = *((const LAS f32x4*)(WRT + e * 1024) + lane + 64 * j); a += (v[j][0] * w[0] + v[j][1] * w[1]) + (v[j][2] * w[2] + v[j][3] * w[3]); }
                part[e] = a; }
#pragma unroll
            for (int i = 0; i < 16; ++i) { const bool up = (lane & 32) != 0; const float keep = up ? part[i + 16] : part[i], send = up ? part[i] : part[i + 16]; part[i] = keep + __shfl_xor(send, 32); }
#pragma unroll
            for (int i = 0; i < 8; ++i) { const bool up = (lane & 16) != 0; const float keep = up ? part[i + 8] : part[i], send = up ? part[i] : part[i + 8]; part[i] = keep + __shfl_xor(send, 16); }
#pragma unroll
            for (int i = 0; i < 4; ++i) { const bool up = (lane & 8) != 0; const float keep = up ? part[i + 4] : part[i], send = up ? part[i] : part[i + 4]; part[i] = keep + __shfl_xor(send, 8); }
#pragma unroll
            for (int i = 0; i < 2; ++i) { const bool up = (lane & 4) != 0; const float keep = up ? part[i + 2] : part[i], send = up ? part[i] : part[i + 2]; part[i] = keep + __shfl_xor(send, 4); }
            { const bool up = (lane & 2) != 0; const float keep = up ? part[1] : part[0], send = up ? part[0] : part[1]; part[0] = keep + __shfl_xor(send, 2); }
            const int myexp = lane >> 1;
            float logit = part[0] + __shfl_xor(part[0], 1) + b_router[myexp];
            float tv[4]; int tix[4];
#pragma unroll
            for (int k = 0; k < 4; ++k) { float bv = logit; int bi = myexp;
#pragma unroll
                for (int o = 1; o < 64; o <<= 1) { const float ov = __shfl_xor(bv, o); const int oi = __shfl_xor(bi, o); if (ov > bv || (ov == bv && oi < bi)) { bv = ov; bi = oi; } }
                tv[k] = bv; tix[k] = bi; if (myexp == bi) logit = -INFINITY; }
            const float e1 = __expf(tv[1] - tv[0]), e2 = __expf(tv[2] - tv[0]), e3 = __expf(tv[3] - tv[0]); const float inv = 1.f / (1.f + e1 + e2 + e3);
            if (lane < 4) { const int ee = lane == 0 ? tix[0] : (lane == 1 ? tix[1] : (lane == 2 ? tix[2] : tix[3])); const float gg = (lane == 0 ? 1.f : (lane == 1 ? e1 : (lane == 2 ? e2 : e3))) * inv;
                const unsigned lp = atomicAdd((unsigned*)&lcnt[ee], 1u);
                LAS unsigned* en = ent + (tl * 4 + lane) * 3; en[0] = (unsigned)ee; en[1] = lp; en[2] = __float_as_uint(gg); }
        }
        __syncthreads();
        if (tid < 32) lbase[tid] = __hip_atomic_fetch_add(CNT + 64 * (hf * 32 + tid), lcnt[tid], __ATOMIC_RELAXED, __HIP_MEMORY_SCOPE_AGENT);
        __syncthreads();
        for (int i = tid; i < 1024; i += NTHR) { const LAS unsigned* en = ent + i * 3; const unsigned ee = en[0], pos = lbase[ee] + en[1];
            const unsigned tokl = (unsigned)(batch * 256 + (i >> 2)) - (unsigned)hf * HALF_TOK;
            u32x2 w; w.x = tokl * 4u + (unsigned)(i & 3); w.y = en[2];
            if (pos < (unsigned)REG_CAP) REG[((size_t)hf * 32 + ee) * REG_CAP + pos] = w; }
        __syncthreads();
    }
}

__device__ __forceinline__ void ph_final(Frame& F, int hf) {
    float* X1 = (float*)F.outb; const bf16_t* YB = (const bf16_t*)(F.ws + WS_YB); const float* MOD = (const float*)(F.ws + WS_MOD);
    const float* g2 = F.a->in[26]; const float* b2 = F.a->in[27];
    const int gw = F.bid * NWAVES + F.wave, NGW = F.G * NWAVES, lane = F.lane;
    for (int tl = gw; tl < HALF_TOK; tl += NGW) {
        const int m = hf * HALF_TOK + tl; const float* md = MOD + (size_t)(m >> 11) * 6144 + 5120;
        f32x4* xr = (f32x4*)(X1 + (size_t)m * D) + lane; const u32x2* yr = (const u32x2*)(YB + (size_t)tl * 4 * D) + lane;
        f32x4 v[4]; float s = 0.f;
#pragma unroll
        for (int j = 0; j < 4; ++j) { f32x4 y = (f32x4){0.f, 0.f, 0.f, 0.f};
#pragma unroll
            for (int k = 0; k < 4; ++k) { const u32x2 w = yr[k * 256 + 64 * j]; y[0] += bflo(w.x); y[1] += bfhi(w.x); y[2] += bflo(w.y); y[3] += bfhi(w.y); }
            const f32x4 gt = *((const f32x4*)md + lane + 64 * j);
            v[j] = xr[64 * j] * DN_ALPHA + gt * y; s += (v[j][0] + v[j][1]) + (v[j][2] + v[j][3]); }
        const float mean = wave_sum(s) * (1.f / D); float s2 = 0.f;
#pragma unroll
        for (int j = 0; j < 4; ++j) { v[j] = v[j] - mean; s2 += (v[j][0] * v[j][0] + v[j][1] * v[j][1]) + (v[j][2] * v[j][2] + v[j][3] * v[j][3]); }
        const float rstd = 1.f / sqrtf(wave_sum(s2) * (1.f / D) + LN_EPS);
#pragma unroll
        for (int j = 0; j < 4; ++j) { const f32x4 g = *((const f32x4*)g2 + lane + 64 * j), bb = *((const f32x4*)b2 + lane + 64 * j); xr[64 * j] = v[j] * rstd * g + bb; }
    }
}

constexpr int NPHASE = 17;
__global__ void __launch_bounds__(NTHR, 2) fwd(Args args) {
    extern __shared__ __attribute__((aligned(16))) unsigned char lds_raw[];
    Frame F;
    F.lds = (LAS unsigned char*)lds_raw;
    F.tid = threadIdx.x; F.lane = F.tid & 63; F.wave = __builtin_amdgcn_readfirstlane(F.tid >> 6); F.G = gridDim.x; F.bid = blockIdx.x;
    F.a = &args;
    F.ws = args.ws; F.outb = (unsigned char*)args.out;
    volatile LAS unsigned* MISCW = (volatile LAS unsigned*)(F.lds + LDS_MISC);
    if (F.tid < 64) MISCW[F.tid] = 0u;
    __syncthreads();
    XcdBarrier bar; bar.bar = (unsigned*)(F.ws + WS_CTL) + CW_BAR; bar.x = 0; bar.st = nullptr;
#if MK_ONE
    bar = xcd_barrier_post((unsigned*)(F.ws + WS_CTL) + CW_BAR, MISCW + 8);
#define GRID_BAR() xcd_barrier(bar)
#else
#define GRID_BAR() do { } while (0)
#endif
    const int lo = args.ph_lo, hi = args.ph_hi;
#ifndef PHM
#define PHM 0xFFFFFFFFu
#endif
#define IN(k) (((PHM >> (k)) & 1u) && lo <= (k) && (k) < hi)
#define SEAM(k) do { if (IN((k) + 1)) GRID_BAR(); } while (0)

    if (IN(0)) { ph_prologue(F); SEAM(0); }
    if (IN(1)) { ph_ln1(F); SEAM(1); }
    if (IN(2)) {
        SchedPlain S; S.o.init(NTOK, NPROJ, F.G, F.bid); S.A = (const char*)(F.outb + OUT_U); S.Bt = (const char*)(F.ws + WS_WIN);
        EpiProj E{(bf16_t*)(F.ws + WS_Q), (bf16_t*)(F.outb + OUT_IQ), (bf16_t*)(F.ws + WS_Z), (bf16_t*)(F.ws + WS_XBC), (bf16_t*)(F.ws + WS_GA), (bf16_t*)(F.ws + WS_GB), (float*)(F.outb + OUT_MISC)};
        pg8::gemm_phase<EpiProj, SchedPlain, false>(F.lds, S, E);
        SEAM(2);
    }
    if (IN(3)) { ph_misc(F); SEAM(3); }
    if (IN(4)) { ph_index(F); SEAM(4); }
    if (IN(5)) { ph_attn(F); SEAM(5); }
    if (IN(6)) { ph_ssd(F); SEAM(6); }
    if (IN(7)) { ph_gnorm(F); SEAM(7); }
    if (IN(8)) {
        SchedPlain S; S.o.init(NTOK, 1024, F.G, F.bid); S.A = (const char*)(F.outb + OUT_OA); S.Bt = (const char*)(F.ws + WS_WPA);
        EpiGate<0> E{(const bf16_t*)(F.ws + WS_GA), nullptr, (bf16_t*)(F.ws + WS_Z)};
        pg8::gemm_phase<EpiGate<0>, SchedPlain, false>(F.lds, S, E);
        SEAM(8);
    }
    if (IN(9)) {
        SchedPlain S; S.o.init(NTOK, 1024, F.G, F.bid); S.A = (const char*)(F.ws + WS_Q); S.Bt = (const char*)(F.ws + WS_WPB);
        EpiGate<1> E{(const bf16_t*)(F.ws + WS_GB), (const bf16_t*)(F.ws + WS_Z), (bf16_t*)(F.ws + WS_XBC)};
        pg8::gemm_phase<EpiGate<1>, SchedPlain, false>(F.lds, S, E);
        SEAM(9);
    }
    if (IN(10)) {
        SchedPlain S; S.o.init(NTOK, 1024, F.G, F.bid); S.A = (const char*)(F.ws + WS_XBC); S.Bt = (const char*)(F.ws + WS_WOUT);
        EpiOut E{F.a->in[0], (const float*)(F.ws + WS_MOD), (float*)F.outb};
        pg8::gemm_phase<EpiOut, SchedPlain, false>(F.lds, S, E);
        SEAM(10);
    }
    if (IN(11)) { ph_router(F); SEAM(11); }
#pragma unroll
    for (int hf = 0; hf < 2; ++hf) {
        const int p0 = 12 + hf * 2;
        if (IN(p0)) {
            if (hf == 1) ph_final(F, 0);
            MoeTab T = moe_tables(F, hf);
            SchedMoe<8, true> S{T, F.G, F.bid, hf, (const char*)(F.ws + WS_U2), (const char*)(F.ws + WS_W1), (const u32x2*)(F.ws + WS_REG)};
            EpiMoe1 E{F.a->in[23], (bf16_t*)(F.ws + WS_ACT)};
            pg8::gemm_phase<EpiMoe1, SchedMoe<8, true>, true>(F.lds, S, E);
            SEAM(p0);
        }
        if (IN(p0 + 1)) {
            MoeTab T = moe_tables(F, hf);
            SchedMoe<4, false> S{T, F.G, F.bid, hf, (const char*)(F.ws + WS_ACT), (const char*)(F.ws + WS_W2), (const u32x2*)(F.ws + WS_REG)};
            EpiMoe2 E{F.a->in[25], (bf16_t*)(F.ws + WS_YB), (const u32x2*)(F.ws + WS_REG), T, hf};
            pg8::gemm_phase<EpiMoe2, SchedMoe<4, false>, false>(F.lds, S, E);
            SEAM(p0 + 1);
        }
    }
    if (IN(16)) { ph_final(F, 1); }
#undef IN
#undef SEAM
}

extern "C" void kernel_launch(void* const* d_in, const int* in_sizes, int n_in, void* d_out, int out_size, void* d_ws, size_t ws_size, hipStream_t stream) {
    static int grid = 0;
    if (grid == 0) {
        if (n_in != 28 || in_sizes[0] != NTOK * D || out_size != NTOK * D || ws_size < WS_END) { fprintf(stderr, "kernel_launch: shape mismatch (n_in %d, in0 %d, out %d, ws %zu)\n", n_in, n_in > 0 ? in_sizes[0] : -1, out_size, ws_size); grid = -1; return; }
        int dev = 0, cus = 0, per_cu = 0;
        if (hipGetDevice(&dev) != hipSuccess || hipDeviceGetAttribute(&cus, hipDeviceAttributeMultiprocessorCount, dev) != hipSuccess) { grid = -1; return; }
        if (hipFuncSetAttribute((const void*)fwd, hipFuncAttributeMaxDynamicSharedMemorySize, LDS_BYTES) != hipSuccess) { fprintf(stderr, "kernel_launch: hipFuncSetAttribute failed\n"); grid = -1; return; }
        if (hipOccupancyMaxActiveBlocksPerMultiprocessor(&per_cu, (const void*)fwd, NTHR, LDS_BYTES) != hipSuccess || per_cu < 1) fprintf(stderr, "kernel_launch: occupancy query reports %d\n", per_cu);
        (void)hipGetLastError();
        grid = cus;
    }
    if (grid < 0) return;
    if (hipMemsetAsync((char*)d_ws + WS_CTL, 0, CTL_ZERO_BYTES, stream) != hipSuccess) { fprintf(stderr, "kernel_launch: memset failed\n"); return; }
    Args a{};
    for (int i = 0; i < 28; ++i) a.in[i] = (const float*)d_in[i];
    a.out = (float*)d_out; a.ws = (unsigned char*)d_ws;
    const int nph = NPHASE < MK_PH_HI ? NPHASE : MK_PH_HI;
#if MK_ONE
    a.ph_lo = 0; a.ph_hi = nph;
    hipLaunchKernelGGL(fwd, dim3(grid), dim3(NTHR), LDS_BYTES, stream, a);
#else
    for (int p = 0; p < nph; ++p) { a.ph_lo = p; a.ph_hi = p + 1; hipLaunchKernelGGL(fwd, dim3(grid), dim3(NTHR), LDS_BYTES, stream, a); }
#endif
    const hipError_t le = hipPeekAtLastError();
    if (le != hipSuccess) fprintf(stderr, "kernel_launch: launch failed: %s\n", hipGetErrorName(le));
}
```

```cpp
#include <hip/hip_runtime.h>
#include <cstdio>
#include <cstdint>

#ifndef MK_ONE
#define MK_ONE 1
#endif
#ifndef DBG_NO_ATTN
#define DBG_NO_ATTN 0
#endif
#ifndef DBG_ATTN_ZERO
#define DBG_ATTN_ZERO 0
#endif
#ifndef DBG_IQ_TRUNC
#define DBG_IQ_TRUNC 0
#endif
#ifndef DBG_ROUTER_BF16
#define DBG_ROUTER_BF16 0
#endif
#ifndef DBG_CHECK
#define DBG_CHECK 0
#endif
#ifndef DBG_SKIP_BODY
#define DBG_SKIP_BODY 0
#endif
#ifndef DBG_SUB
#define DBG_SUB 0
#endif
#ifndef DBG_SSD_SYNC
#define DBG_SSD_SYNC 0
#endif
#ifndef DBG_HYP
#define DBG_HYP 0
#endif
#ifndef DBG_NO_SSD
#define DBG_NO_SSD 0
#endif
#ifndef DBG_NO_MOE
#define DBG_NO_MOE 0
#endif
#ifndef MK_PH_HI
#define MK_PH_HI 99
#endif

#define LAS __attribute__((address_space(3)))
#define GAS __attribute__((address_space(1)))
typedef unsigned short bf16_t;
typedef short bf16x8 __attribute__((ext_vector_type(8)));
typedef short s16x4 __attribute__((ext_vector_type(4)));
typedef float f32x2 __attribute__((ext_vector_type(2)));
typedef float f32x4 __attribute__((ext_vector_type(4)));
typedef float f32x16 __attribute__((ext_vector_type(16)));
typedef unsigned u32x2 __attribute__((ext_vector_type(2)));
typedef unsigned u32x4 __attribute__((ext_vector_type(4)));
typedef unsigned long long u64;

constexpr int NB = 32, SEQ = 2048, D = 1024, NTOK = NB * SEQ;
constexpr int NWAVES = 8, NTHR = 512;
constexpr int NPROJ = 6912;
constexpr int NEXP = 32, HALF_TOK = NTOK / 2, REG_CAP = HALF_TOK;
constexpr int ACT_ROWS = HALF_TOK * 4 + NEXP * 256;
constexpr float LN_EPS = 1e-5f;
constexpr float DN_ALPHA = 1.189207115002721f;
constexpr float LOG2E = 1.4426950408889634f;

constexpr size_t MiB = 1u << 20;
constexpr size_t WS_CTL = 0, CTL_ZERO_BYTES = 1 * MiB;
constexpr size_t WS_MOD = 1 * MiB;
constexpr size_t WS_BIAST = 1 * MiB + 800 * 1024;
constexpr size_t WS_WIN = 2 * MiB;
constexpr size_t WS_WPA = 16 * MiB, WS_WPB = 18 * MiB, WS_WOUT = 20 * MiB;
constexpr size_t WS_W1 = 24 * MiB;
constexpr size_t WS_W2 = 152 * MiB;
constexpr size_t WS_Q = 216 * MiB;
constexpr size_t WS_Z = 344 * MiB;
constexpr size_t WS_XBC = 472 * MiB;
constexpr size_t WS_GA = 728 * MiB, WS_GB = 856 * MiB;
constexpr size_t WS_U2 = 216 * MiB;
constexpr size_t WS_REG = 344 * MiB;
constexpr size_t WS_ACT = 360 * MiB;
constexpr size_t WS_YB = 632 * MiB;
constexpr size_t WS_END = 888 * MiB;
constexpr size_t WS_DBG = 888 * MiB;
constexpr size_t OUT_U = 0, OUT_MISC = 128 * MiB, OUT_IQ = 192 * MiB;
constexpr size_t OUT_KV = 0, OUT_IK = 16 * MiB, OUT_IW = 24 * MiB, OUT_DT = 26 * MiB, OUT_MASK = 32 * MiB, OUT_OA = 64 * MiB;
constexpr int CW_BAR = 4096, CW_CNT = 16384, CW_DBG = 24576;

constexpr int LDS_BYTES = 160 * 1024;
constexpr int LDS_AUX = 131072;
constexpr int LDS_MISC = LDS_BYTES - 256;

#define LDS_WAIT() asm volatile("s_waitcnt lgkmcnt(0)" ::: "memory")
#define VM_WAIT() asm volatile("s_waitcnt vmcnt(0)" ::: "memory")
#define SBAR() __builtin_amdgcn_sched_barrier(0)
typedef __bf16 bf16x2_t __attribute__((ext_vector_type(2)));
__device__ __forceinline__ unsigned cvt_pk_bf16(float lo, float hi) { f32x2 f = {lo, hi}; bf16x2_t v = __builtin_convertvector(f, bf16x2_t); return __builtin_bit_cast(unsigned, v); }
__device__ __forceinline__ float bflo(unsigned w) { return __uint_as_float(w << 16); }
__device__ __forceinline__ float bfhi(unsigned w) { return __uint_as_float(w & 0xffff0000u); }
__device__ __forceinline__ u32x4 pack8(f32x4 a, f32x4 b) { u32x4 w; w.x = cvt_pk_bf16(a[0], a[1]); w.y = cvt_pk_bf16(a[2], a[3]); w.z = cvt_pk_bf16(b[0], b[1]); w.w = cvt_pk_bf16(b[2], b[3]); return w; }
__device__ __forceinline__ void unpack8(u32x4 w, f32x4& a, f32x4& b) { a[0] = bflo(w.x); a[1] = bfhi(w.x); a[2] = bflo(w.y); a[3] = bfhi(w.y); b[0] = bflo(w.z); b[1] = bfhi(w.z); b[2] = bflo(w.w); b[3] = bfhi(w.w); }
__device__ __forceinline__ float wave_sum(float v) {
#pragma unroll
    for (int o = 1; o < 64; o <<= 1) v += __shfl_xor(v, o);
    return v;
}
__device__ __forceinline__ float fast_rcp(float x) { return __builtin_amdgcn_rcpf(x); }
__device__ __forceinline__ float sigmoid_f(float x) { return fast_rcp(1.0f + __expf(-x)); }
__device__ __forceinline__ float silu_f(float x) { return x * sigmoid_f(x); }

#define XB_TMO      128
#define XB_XCNT(j)  (256  + 64 * (j))
#define XB_XSUB(j)  (1280 + 64 * (j))
#define XB_XGEN(j)  (2304 + 64 * (j))
#define XB_TOP      3328
#define XB_TOPGEN   3392
#define XCD_BAR_WORDS 3456
#define XB_SPIN_CAP (1u << 18)
__device__ __forceinline__ unsigned xb_ld(unsigned* p)              { return __hip_atomic_load(p, __ATOMIC_RELAXED, __HIP_MEMORY_SCOPE_AGENT); }
__device__ __forceinline__ unsigned xb_add(unsigned* p, unsigned v) { return __hip_atomic_fetch_add(p, v, __ATOMIC_RELAXED, __HIP_MEMORY_SCOPE_AGENT); }
__device__ __forceinline__ unsigned xb_xcc_id() { return (unsigned)__builtin_amdgcn_s_getreg((3 << 11) | 20) & 0xFu; }
#define XB_SPIN(cond, bar) do { unsigned _sp = 0; while (cond) { __builtin_amdgcn_s_sleep(1); \
    if ((++_sp & 255u) == 0u) { if (xb_ld(&(bar)[XB_TMO])) break; if (_sp > XB_SPIN_CAP) { atomicAdd(&(bar)[XB_TMO], 1u); break; } } } } while (0)
struct XcdBarrier { unsigned* bar; unsigned x; volatile LAS unsigned* st; };
__device__ __forceinline__ XcdBarrier xcd_barrier_post(unsigned* bar, volatile LAS unsigned* st) {
    XcdBarrier b; b.bar = bar; b.x = xb_xcc_id(); b.st = st;
    if (threadIdx.x == 0) (void)xb_add(&bar[XB_XCNT(b.x)], 1u);
    return b;
}
__device__ __forceinline__ void xcd_barrier_complete(unsigned* bar, unsigned x, unsigned& nloc, unsigned& nx) {
    const unsigned G = gridDim.x * gridDim.y * gridDim.z;
    unsigned sum, cnt, mine, sp = 0u;
    for (;;) {
        sum = 0u; cnt = 0u;
#pragma nounroll
        for (unsigned j = 0; j < 16; ++j) { const unsigned c = xb_ld(&bar[XB_XCNT(j)]); sum += c; cnt += (c > 0u) ? 1u : 0u; }
        if (sum == G) break;
        __builtin_amdgcn_s_sleep(1);
        if ((++sp & 255u) == 0u) { if (xb_ld(&bar[XB_TMO])) break; if (sp > XB_SPIN_CAP) { atomicAdd(&bar[XB_TMO], 1u); break; } }
    }
    mine = xb_ld(&bar[XB_XCNT(x)]);
    nloc = mine > 0u ? mine : 1u; nx = cnt > 0u ? cnt : 1u;
}
__device__ __forceinline__ void xcd_barrier(const XcdBarrier& b) {
    asm volatile("s_waitcnt vmcnt(0)" ::: "memory");
    __syncthreads();
    if (threadIdx.x == 0) {
        unsigned* bar = b.bar;
        __builtin_amdgcn_s_waitcnt(0);
        unsigned nloc = b.st[0], nx = b.st[1];
        if (nloc == 0u) { xcd_barrier_complete(bar, b.x, nloc, nx); b.st[0] = nloc; b.st[1] = nx; }
        const unsigned old = xb_add(&bar[XB_XSUB(b.x)], 1u);
        const unsigned gen = old / nloc;
        if (old + 1u == (gen + 1u) * nloc) {
            __builtin_amdgcn_fence(__ATOMIC_RELEASE, "agent");
            asm volatile("s_waitcnt vmcnt(0)" ::: "memory");
            const unsigned og = xb_add(&bar[XB_TOP], 1u);
            const unsigned tg = og / nx;
            if (og + 1u == (tg + 1u) * nx) xb_add(&bar[XB_TOPGEN], 1u);
            else XB_SPIN(xb_ld(&bar[XB_TOPGEN]) == tg, bar);
            __builtin_amdgcn_fence(__ATOMIC_ACQUIRE, "agent");
            xb_add(&bar[XB_XGEN(b.x)], 1u);
            asm volatile("s_waitcnt vmcnt(0)" ::: "memory");
        } else {
            XB_SPIN(xb_ld(&bar[XB_XGEN(b.x)]) == gen, bar);
            __builtin_amdgcn_fence(__ATOMIC_ACQUIRE, "agent");
            asm volatile("s_waitcnt vmcnt(0)" ::: "memory");
        }
    }
    __syncthreads();
}

namespace pg8 {
constexpr int BM = 256, BK = 64, HALF = 128, HTB = HALF * BK * 2, STAGE_BYTES = 8 * HTB, NXCD = 8, WGM = 8, KD = 1024;
__host__ __device__ __forceinline__ int lds_byte(int r, int c) { const int st = (r >> 4) * 2 + (c >> 5), rr = r & 15, cc = c & 31, ob = rr * 64 + cc * 2; return st * 1024 + (ob ^ (((ob >> 9) & 1) << 5)); }
__host__ __device__ __forceinline__ void stage_rc(int b, int& R, int& C) { const int st = b / 1024, sb = b % 1024, swz = sb ^ (((sb >> 9) & 1) << 5); R = (st >> 1) * 16 + swz / 64; C = (st & 1) * 32 + (swz % 64) / 2; }
__host__ __device__ __forceinline__ int perm32(int rho) { const int n = rho >> 4, i = rho & 15; return 8 * (i >> 2) + 4 * n + (i & 3); }
struct Unit { int pm, pn, ex; };
struct StaticOrder {
    int nM, nN, nwg, G, c;
    __device__ void init(int M, int N, int G_, int c_) { nM = M / BM; nN = N / BM; nwg = nM * nN; G = G_; c = c_; }
    __device__ bool next(int i, Unit& u) const {
        const long L = (long)i * G + c; if (L >= nwg) return false;
        int wgid = (int)L; { const int q = nwg / NXCD, r = nwg % NXCD, xcd = wgid % NXCD, off = wgid / NXCD; wgid = (xcd < r ? xcd * (q + 1) : r * (q + 1) + (xcd - r) * q) + off; }
        const int nig = WGM * nN, gid = wgid / nig, fm = gid * WGM, gsz = (nM - fm) < WGM ? (nM - fm) : WGM;
        u.pm = fm + ((wgid % nig) % gsz); u.pn = (wgid % nig) / gsz; u.ex = 0; return true;
    }
};
template <class Epi, class Sched, bool GATHER>
__device__ __forceinline__ void gemm_phase(LAS unsigned char* lds, const Sched& S, const Epi& E) {
    int tid = threadIdx.x; asm volatile("" : "+v"(tid));
    const int wid = __builtin_amdgcn_readfirstlane(tid >> 6), lane = tid & 63, wr = wid >> 2, wc = wid & 3, fr = lane & 15, fq = lane >> 4;
    constexpr int K = KD, nt = K / BK;
    unsigned voffA[2], voffB[2]; int Rr[2], Cc[2];
#pragma unroll
    for (int i = 0; i < 2; ++i) { int R, C; stage_rc(tid * 16 + i * 8192, R, C); const int Rb = Epi::PERM ? ((R & ~31) + perm32(R & 31)) : R;
        voffA[i] = (unsigned)(R * K + C) * 2u; voffB[i] = (unsigned)(Rb * K + C) * 2u; Rr[i] = R; Cc[i] = C; }
    constexpr size_t kstep = (size_t)(BK * 2);
    constexpr size_t hstep = (size_t)HALF * K * 2;
    const unsigned ldsw = (unsigned)wid * 1024u;
    const int aoff = lds_byte(wr * 64 + fr, fq * 8), boff = lds_byte(wc * 32 + fr, fq * 8);
#define PG8_SA(b, h) (((b) * 2 + (h)) * HTB)
#define PG8_SB(b, h) ((4 + (b) * 2 + (h)) * HTB)
#define PG8_STAGE(bufoff, gbase, voff) do { _Pragma("unroll") for (int _i = 0; _i < 2; ++_i) \
        __builtin_amdgcn_global_load_lds((const unsigned*)((const char*)(gbase) + (voff)[_i]), (LAS unsigned*)(lds + (bufoff) + ldsw + _i * 8192), 16, 0, 0); } while (0)
#define PG8_STAGE_A(bufoff, gb, h, o0, o1) do { if constexpr (GATHER) { const unsigned _ko = (unsigned)((gb) - gA0); unsigned _o[2]; \
            if ((h) == 0) { _o[0] = (o0)[0] + _ko; _o[1] = (o0)[1] + _ko; } else { _o[0] = (o1)[0] + _ko; _o[1] = (o1)[1] + _ko; } PG8_STAGE(bufoff, gA0, _o); } \
        else { PG8_STAGE(bufoff, (gb) + (h) * hstep, voffA); } } while (0)
#define PG8_LDA(dst, b, h) do { _Pragma("unroll") for (int m = 0; m < 4; ++m) _Pragma("unroll") for (int k = 0; k < 2; ++k) dst[m][k] = *(const LAS bf16x8*)(lds + PG8_SA(b, h) + aoff + m * 2048 + k * 1024); } while (0)
#define PG8_LDB(dst, b, h) do { _Pragma("unroll") for (int n = 0; n < 2; ++n) _Pragma("unroll") for (int k = 0; k < 2; ++k) dst[n][k] = *(const LAS bf16x8*)(lds + PG8_SB(b, h) + boff + n * 2048 + k * 1024); } while (0)
#define PG8_MMA(ai, bj, At, Bt) do { __builtin_amdgcn_s_setprio(1); _Pragma("unroll") for (int m = 0; m < 4; ++m) _Pragma("unroll") for (int n = 0; n < 2; ++n) _Pragma("unroll") for (int k = 0; k < 2; ++k) \
        acc[ai][bj][m][n] = __builtin_amdgcn_mfma_f32_16x16x32_bf16(Bt[n][k], At[m][k], acc[ai][bj][m][n], 0, 0, 0); __builtin_amdgcn_s_setprio(0); } while (0)
#define PG8_WAIT_V(n) asm volatile("s_waitcnt vmcnt(" #n ")" ::: "memory")
#define PG8_WAIT_L(n) asm volatile("s_waitcnt lgkmcnt(" #n ")" ::: "memory")
#define PG8_BAR __builtin_amdgcn_s_barrier()
#define PG8_SCHED __builtin_amdgcn_sched_barrier(0)
    Unit cur, nxt; int ui = 0;
    if (!S.next(0, cur)) return;
    f32x4 acc[2][2][4][2];
#pragma unroll
    for (int a = 0; a < 2; ++a)
#pragma unroll
        for (int b = 0; b < 2; ++b)
#pragma unroll
            for (int m = 0; m < 4; ++m)
#pragma unroll
                for (int n = 0; n < 2; ++n) acc[a][b][m][n] = (f32x4){0.f, 0.f, 0.f, 0.f};
    bf16x8 At[4][2], B0[2][2], B1[2][2];
    const char* cA = S.a_base(cur); const char* cB = S.b_base(cur);
    const char* const gA0 = cA;
    unsigned cv0[2] = {0u, 0u}, cv1[2] = {0u, 0u}, nv0[2] = {0u, 0u}, nv1[2] = {0u, 0u};
    if constexpr (GATHER) S.a_offs(cur, Rr, Cc, cv0, cv1);
    PG8_STAGE(PG8_SB(0, 0), cB, voffB); PG8_STAGE_A(PG8_SA(0, 0), cA, 0, cv0, cv1); PG8_STAGE(PG8_SB(0, 1), cB + hstep, voffB); PG8_STAGE_A(PG8_SA(0, 1), cA, 1, cv0, cv1);
    if (wr == 1) PG8_BAR;
    PG8_WAIT_V(4); PG8_BAR;
    PG8_STAGE(PG8_SB(1, 0), cB + kstep, voffB); PG8_STAGE_A(PG8_SA(1, 0), cA + kstep, 0, cv0, cv1); PG8_STAGE(PG8_SB(1, 1), cB + hstep + kstep, voffB);
    PG8_WAIT_V(6); PG8_BAR;
    for (;;) {
        const bool has_next = S.next(ui + 1, nxt);
        const char* nA = has_next ? S.a_base(nxt) : cA; const char* nB = has_next ? S.b_base(nxt) : cB;
        if constexpr (GATHER) { if (has_next) S.a_offs(nxt, Rr, Cc, nv0, nv1); else { nv0[0] = cv0[0]; nv0[1] = cv0[1]; nv1[0] = cv1[0]; nv1[1] = cv1[1]; } }
        for (int t = 0; t < nt; t += 2) {
            const bool last = (t == nt - 2);
            const char* a1 = cA + (size_t)(t + 1) * kstep;
            const char* a2 = last ? nA : cA + (size_t)(t + 2) * kstep; const char* b2 = last ? nB : cB + (size_t)(t + 2) * kstep;
            const char* a3 = a2 + kstep; const char* b3 = b2 + kstep;
            unsigned s0[2], s1[2];
            if constexpr (GATHER) { s0[0] = last ? nv0[0] : cv0[0]; s0[1] = last ? nv0[1] : cv0[1]; s1[0] = last ? nv1[0] : cv1[0]; s1[1] = last ? nv1[1] : cv1[1]; } else { s0[0] = s0[1] = s1[0] = s1[1] = 0u; }
            PG8_LDB(B0, 0, 0); PG8_SCHED; PG8_LDA(At, 0, 0); PG8_STAGE_A(PG8_SA(1, 1), a1, 1, cv0, cv1);
            PG8_WAIT_L(8); PG8_BAR; PG8_WAIT_L(0); PG8_MMA(0, 0, At, B0); PG8_BAR; PG8_SCHED;
            PG8_LDB(B1, 0, 1); PG8_STAGE(PG8_SB(0, 0), b2, voffB);
            PG8_BAR; PG8_WAIT_L(0); PG8_MMA(0, 1, At, B1); PG8_BAR;
            PG8_LDA(At, 0, 1); PG8_STAGE_A(PG8_SA(0, 0), a2, 0, s0, s1);
            PG8_BAR; PG8_WAIT_L(0); PG8_MMA(1, 0, At, B0); PG8_BAR; PG8_SCHED;
            PG8_STAGE(PG8_SB(0, 1), b2 + hstep, voffB);
            PG8_WAIT_V(6); PG8_BAR; PG8_MMA(1, 1, At, B1); PG8_BAR;
            PG8_LDB(B0, 1, 0); PG8_SCHED; PG8_LDA(At, 1, 0); PG8_STAGE_A(PG8_SA(0, 1), a2, 1, s0, s1);
            PG8_WAIT_L(8); PG8_BAR; PG8_WAIT_L(0); PG8_MMA(0, 0, At, B0); PG8_BAR; PG8_SCHED;
            PG8_LDB(B1, 1, 1); PG8_STAGE(PG8_SB(1, 0), b3, voffB);
            PG8_BAR; PG8_WAIT_L(0); PG8_MMA(0, 1, At, B1); PG8_BAR;
            PG8_LDA(At, 1, 1); PG8_STAGE_A(PG8_SA(1, 0), a3, 0, s0, s1);
            PG8_BAR; PG8_WAIT_L(0); PG8_MMA(1, 0, At, B0); PG8_BAR; PG8_SCHED;
            PG8_STAGE(PG8_SB(1, 1), b3 + hstep, voffB);
            PG8_WAIT_V(6); PG8_BAR; PG8_MMA(1, 1, At, B1); PG8_BAR;
        }
        E(acc, cur, wr, wc, fr, fq);
        if (!has_next) break;
#pragma unroll
        for (int a = 0; a < 2; ++a)
#pragma unroll
            for (int b = 0; b < 2; ++b)
#pragma unroll
                for (int m = 0; m < 4; ++m)
#pragma unroll
                    for (int n = 0; n < 2; ++n) acc[a][b][m][n] = (f32x4){0.f, 0.f, 0.f, 0.f};
        cur = nxt; cA = nA; cB = nB; ++ui;
        if constexpr (GATHER) { cv0[0] = nv0[0]; cv0[1] = nv0[1]; cv1[0] = nv1[0]; cv1[1] = nv1[1]; }
    }
    PG8_WAIT_V(0);
    if (wr == 0) PG8_BAR;
    PG8_BAR;
#undef PG8_SA
#undef PG8_SB
#undef PG8_STAGE
#undef PG8_STAGE_A
#undef PG8_LDA
#undef PG8_LDB
#undef PG8_MMA
#undef PG8_WAIT_V
#undef PG8_WAIT_L
#undef PG8_BAR
#undef PG8_SCHED
}
}
using pg8::Unit;
typedef f32x4 AccT[2][2][4][2];

struct Args { const float* in[28]; float* out; unsigned char* ws; int ph_lo, ph_hi, pad0, pad1; };
struct Frame {
    LAS unsigned char* lds;
    int tid, lane, wave, G, bid;
    const struct Args* a;
    unsigned char* ws; unsigned char* outb;
};
struct SchedPlain {
    pg8::StaticOrder o; const char* A; const char* Bt;
    __device__ __forceinline__ bool next(int i, Unit& u) const { return o.next(i, u); }
    __device__ __forceinline__ const char* a_base(const Unit& u) const { return A + (size_t)u.pm * (256 * 2048); }
    __device__ __forceinline__ const char* b_base(const Unit& u) const { return Bt + (size_t)u.pn * (256 * 2048); }
    __device__ __forceinline__ void a_offs(const Unit&, const int*, const int*, unsigned (&)[2], unsigned (&)[2]) const {}
};

struct EpiProj {
    static constexpr bool PERM = true;
    bf16_t *Q, *IQ, *Z, *XBC, *GA, *GB; float* MISC;
    __device__ __forceinline__ void operator()(const AccT& acc, const Unit& u, int wr, int wc, int fr, int fq) const {
        const int pn = u.pn, row0 = u.pm * 256 + wr * 64 + fr, c8 = wc * 32 + 8 * fq;
        if (pn == 6) {
#pragma unroll
            for (int ai = 0; ai < 2; ++ai)
#pragma unroll
                for (int m = 0; m < 4; ++m) { float* rp = MISC + (size_t)(row0 + ai * 128 + m * 16) * 256 + c8;
#pragma unroll
                    for (int bj = 0; bj < 2; ++bj) { *(f32x4*)(rp + bj * 128) = acc[ai][bj][m][0]; *(f32x4*)(rp + bj * 128 + 4) = acc[ai][bj][m][1]; } }
            return;
        }
        bf16_t* base; int ldc, colt, act = 0;
        if (pn < 4) { base = Q; ldc = 1024; colt = pn * 256; }
        else if (pn < 6) { base = IQ; ldc = 512; colt = (pn - 4) * 256; }
        else if (pn < 11) { base = Z; ldc = 1024; colt = (pn - 7) * 256; act = 1; }
        else if (pn < 19) { base = XBC; ldc = 2048; colt = (pn - 11) * 256; }
        else if (pn < 23) { base = GA; ldc = 1024; colt = (pn - 19) * 256; act = 2; }
        else { base = GB; ldc = 1024; colt = (pn - 23) * 256; act = 2; }
#pragma unroll
        for (int ai = 0; ai < 2; ++ai)
#pragma unroll
            for (int m = 0; m < 4; ++m) { bf16_t* rp = base + (size_t)(row0 + ai * 128 + m * 16) * ldc + colt + c8;
#pragma unroll
                for (int bj = 0; bj < 2; ++bj) { f32x4 v0 = acc[ai][bj][m][0], v1 = acc[ai][bj][m][1];
                    if (act == 1) {
#pragma unroll
                        for (int j = 0; j < 4; ++j) { v0[j] = silu_f(v0[j]); v1[j] = silu_f(v1[j]); } }
                    if (act == 2) {
#pragma unroll
                        for (int j = 0; j < 4; ++j) { v0[j] = sigmoid_f(v0[j]); v1[j] = sigmoid_f(v1[j]); } }
                    u32x4 pk = pack8(v0, v1); if (DBG_IQ_TRUNC && (pn == 4 || pn == 5)) { pk.x &= 0xfff8fff8u; pk.y &= 0xfff8fff8u; pk.z &= 0xfff8fff8u; pk.w &= 0xfff8fff8u; }
                    *(u32x4*)(rp + bj * 128) = pk; } }
    }
};
template <int MODE> struct EpiGate {
    static constexpr bool PERM = true;
    const bf16_t* Gt; const bf16_t* T; bf16_t* O;
    __device__ __forceinline__ void operator()(const AccT& acc, const Unit& u, int wr, int wc, int fr, int fq) const {
        const int row0 = u.pm * 256 + wr * 64 + fr, c8 = u.pn * 256 + wc * 32 + 8 * fq;
#pragma unroll
        for (int ai = 0; ai < 2; ++ai)
#pragma unroll
            for (int m = 0; m < 4; ++m) { const size_t off = (size_t)(row0 + ai * 128 + m * 16) * 1024 + c8;
#pragma unroll
                for (int bj = 0; bj < 2; ++bj) { f32x4 g0, g1; unpack8(*(const u32x4*)(Gt + off + bj * 128), g0, g1);
                    f32x4 v0 = g0 * acc[ai][bj][m][0], v1 = g1 * acc[ai][bj][m][1];
                    if ((MODE == 0 && DBG_NO_ATTN) || (MODE == 1 && DBG_NO_SSD)) { v0 = (f32x4){0.f, 0.f, 0.f, 0.f}; v1 = v0; }
                    if (MODE == 1) { f32x4 t0, t1; unpack8(*(const u32x4*)(T + off + bj * 128), t0, t1); v0 += t0; v1 += t1; }
                    *(u32x4*)(O + off + bj * 128) = pack8(v0, v1); } }
    }
};
struct EpiOut {
    static constexpr bool PERM = false;
    const float* x; const float* mod; float* V;
    __device__ __forceinline__ void operator()(const AccT& acc, const Unit& u, int wr, int wc, int fr, int fq) const {
        const int row0 = u.pm * 256 + wr * 64 + fr, col0 = u.pn * 256 + wc * 32 + 4 * fq;
        const float* g1 = mod + (size_t)(u.pm >> 3) * 6144 + 2048 + col0;
        f32x4 gv[2][2];
#pragma unroll
        for (int bj = 0; bj < 2; ++bj)
#pragma unroll
            for (int n = 0; n < 2; ++n) gv[bj][n] = *(const f32x4*)(g1 + bj * 128 + n * 16);
#pragma unroll
        for (int ai = 0; ai < 2; ++ai)
#pragma unroll
            for (int m = 0; m < 4; ++m) { const size_t off = (size_t)(row0 + ai * 128 + m * 16) * 1024 + col0;
#pragma unroll
                for (int bj = 0; bj < 2; ++bj)
#pragma unroll
                    for (int n = 0; n < 2; ++n) { const f32x4 xv = *(const f32x4*)(x + off + bj * 128 + n * 16);
                        *(f32x4*)(V + off + bj * 128 + n * 16) = xv * DN_ALPHA + gv[bj][n] * acc[ai][bj][m][n]; } }
    }
};

struct MoeTab { LAS unsigned* cnt; LAS unsigned* tb; LAS unsigned char* te; int ntiles; };
__device__ __forceinline__ MoeTab moe_tables(Frame& F, int hf) {
    MoeTab T; T.cnt = (LAS unsigned*)(F.lds + LDS_AUX); T.tb = (LAS unsigned*)(F.lds + LDS_AUX + 256); T.te = (LAS unsigned char*)(F.lds + LDS_AUX + 512);
    const unsigned* CNT = (const unsigned*)(F.ws + WS_CTL) + CW_CNT;
    __syncthreads();
    if (F.tid < 32) { unsigned c = __hip_atomic_load(CNT + 64 * (hf * 32 + F.tid), __ATOMIC_RELAXED, __HIP_MEMORY_SCOPE_AGENT); if (c > (unsigned)REG_CAP) c = REG_CAP; T.cnt[F.tid] = c; }
    __syncthreads();
    if (F.tid == 0) { unsigned s = 0;
#pragma nounroll
        for (int e = 0; e < 32; ++e) { T.tb[e] = s; const unsigned n = (T.cnt[e] + 255u) >> 8;
#pragma nounroll
            for (unsigned t = 0; t < n; ++t) T.te[s + t] = (unsigned char)e;
            s += n; }
        T.tb[32] = s; }
    __syncthreads();
    T.ntiles = __builtin_amdgcn_readfirstlane((int)T.tb[32]);
    return T;
}
template <int NJ, bool GATHER> struct SchedMoe {
    MoeTab T; int G, c, hf; const char* A; const char* Bt; const u32x2* REG;
    __device__ __forceinline__ bool next(int i, Unit& u) const {
        const int L = i * G + c; if (L >= T.ntiles * NJ) return false;
        u.pm = L / NJ; u.pn = L % NJ; u.ex = __builtin_amdgcn_readfirstlane((int)T.te[u.pm]); return true;
    }
    __device__ __forceinline__ const char* a_base(const Unit& u) const { return GATHER ? A : A + (size_t)u.pm * (256 * 2048); }
    __device__ __forceinline__ const char* b_base(const Unit& u) const { return Bt + ((size_t)u.ex * (NJ * 256) + (size_t)u.pn * 256) * 2048; }
    __device__ __forceinline__ void a_offs(const Unit& u, const int* R, const int* C, unsigned (&o0)[2], unsigned (&o1)[2]) const {
        const unsigned cnt = __builtin_amdgcn_readfirstlane(T.cnt[u.ex]), pos0 = ((unsigned)u.pm - (unsigned)__builtin_amdgcn_readfirstlane(T.tb[u.ex])) * 256u; const u32x2* rg = REG + ((size_t)hf * 32 + u.ex) * REG_CAP;
#pragma unroll
        for (int i = 0; i < 2; ++i) {
            const unsigned p0 = pos0 + (unsigned)R[i], p1 = p0 + 128u;
            unsigned t0 = 0u, t1 = 0u;
            if (p0 < cnt) t0 = (unsigned)hf * HALF_TOK + (rg[p0].x >> 2);
            if (p1 < cnt) t1 = (unsigned)hf * HALF_TOK + (rg[p1].x >> 2);
            o0[i] = t0 * 2048u + (unsigned)C[i] * 2u; o1[i] = t1 * 2048u + (unsigned)C[i] * 2u;
        }
    }
};
struct EpiMoe1 {
    static constexpr bool PERM = true;
    const float* b1; bf16_t* ACT;
    __device__ __forceinline__ void operator()(const AccT& acc, const Unit& u, int wr, int wc, int fr, int fq) const {
        const int row0 = u.pm * 256 + wr * 64 + fr, c8 = u.pn * 128 + wc * 32 + 8 * fq;
        const float* bg = b1 + (size_t)u.ex * 2048 + c8;
        const f32x4 bg0 = *(const f32x4*)bg, bg1 = *(const f32x4*)(bg + 4), bu0 = *(const f32x4*)(bg + 1024), bu1 = *(const f32x4*)(bg + 1028);
#pragma unroll
        for (int ai = 0; ai < 2; ++ai)
#pragma unroll
            for (int m = 0; m < 4; ++m) {
                f32x4 g0 = acc[ai][0][m][0] + bg0, g1 = acc[ai][0][m][1] + bg1, u0 = acc[ai][1][m][0] + bu0, u1 = acc[ai][1][m][1] + bu1, a0, a1;
#pragma unroll
                for (int j = 0; j < 4; ++j) {
                    float g = fminf(g0[j], 7.0f), up = fminf(fmaxf(u0[j], -7.0f), 7.0f); a0[j] = (up + 1.0f) * g * sigmoid_f(1.702f * g);
                    g = fminf(g1[j], 7.0f); up = fminf(fmaxf(u1[j], -7.0f), 7.0f); a1[j] = (up + 1.0f) * g * sigmoid_f(1.702f * g); }
                *(u32x4*)(ACT + (size_t)(row0 + ai * 128 + m * 16) * 1024 + c8) = pack8(a0, a1); }
    }
};
struct EpiMoe2 {
    static constexpr bool PERM = true;
    const float* b2; bf16_t* YB; const u32x2* REG; MoeTab T; int hf;
    __device__ __forceinline__ void operator()(const AccT& acc, const Unit& u, int wr, int wc, int fr, int fq) const {
        const int c8 = u.pn * 256 + wc * 32 + 8 * fq;
        const unsigned cnt = __builtin_amdgcn_readfirstlane(T.cnt[u.ex]), pos0 = ((unsigned)u.pm - (unsigned)__builtin_amdgcn_readfirstlane(T.tb[u.ex])) * 256u + (unsigned)(wr * 64 + fr); const u32x2* rg = REG + ((size_t)hf * 32 + u.ex) * REG_CAP;
        const float* bb = b2 + (size_t)u.ex * 1024 + c8;
        f32x4 bv[2][2];
#pragma unroll
        for (int bj = 0; bj < 2; ++bj) { bv[bj][0] = *(const f32x4*)(bb + bj * 128); bv[bj][1] = *(const f32x4*)(bb + bj * 128 + 4); }
#pragma unroll
        for (int ai = 0; ai < 2; ++ai)
#pragma unroll
            for (int m = 0; m < 4; ++m) { const unsigned p = pos0 + (unsigned)(ai * 128 + m * 16);
                if (p < cnt) { const u32x2 en = rg[p]; const float g = __uint_as_float(en.y); bf16_t* rp = YB + (size_t)en.x * 1024 + c8;
#pragma unroll
                    for (int bj = 0; bj < 2; ++bj) *(u32x4*)(rp + bj * 128) = pack8((acc[ai][bj][m][0] + bv[bj][0]) * g, (acc[ai][bj][m][1] + bv[bj][1]) * g); } }
    }
};

struct MapIdent { __device__ __forceinline__ int operator()(int n) const { return n; } };
struct MapWin { __device__ __forceinline__ int operator()(int n) const {
    if (n < 1024) return n;
    if (n < 1536) return 1152 + (n - 1024);
    if (n < 1792) { const int c = n - 1536; if (c < 128) return 1024 + c; if (c < 192) return 1664 + (c - 128); if (c < 200) return 1728 + (c - 192); if (c < 216) return 4808 + (c - 200); return -1; }
    if (n < 2816) return 1736 + (n - 1792);
    if (n < 4864) return 2760 + (n - 2816);
    if (n < 5888) return 4824 + (n - 4864);
    return 5848 + (n - 5888); } };
struct MapW1 { __device__ __forceinline__ int operator()(int r) const { const int j = r >> 8, rr = r & 255; return (rr >> 7) * 1024 + j * 128 + (rr & 127); } };
template <class Map> __device__ __forceinline__ void transpose_item(const float* W, int K, int N, bf16_t* WT, const Map& map, LAS float* scr, int kb, int nb, int lane, const float* rowscale) {
    const int k0 = 64 * kb, n0 = 32 * nb; const int src = map(n0 + (lane & 31));
#pragma unroll 8
    for (int i = 0; i < 32; ++i) { const int kk = 2 * i + (lane >> 5); float v = 0.f; if (src >= 0) v = W[(size_t)(k0 + kk) * N + src]; if (rowscale) v *= rowscale[k0 + kk]; scr[kk * 33 + (lane & 31)] = v; }
    LDS_WAIT(); asm volatile("" ::: "memory");
    const int c = lane & 7;
#pragma unroll
    for (int j = 0; j < 4; ++j) { const int n = (lane >> 3) + 8 * j; const LAS float* s = scr + (8 * c) * 33 + n;
        u32x4 o; o.x = cvt_pk_bf16(s[0 * 33], s[1 * 33]); o.y = cvt_pk_bf16(s[2 * 33], s[3 * 33]); o.z = cvt_pk_bf16(s[4 * 33], s[5 * 33]); o.w = cvt_pk_bf16(s[6 * 33], s[7 * 33]);
        *(u32x4*)(WT + (size_t)(n0 + n) * K + k0 + 8 * c) = o; }
    LDS_WAIT(); asm volatile("" ::: "memory");
}
__device__ __forceinline__ void ph_prologue(Frame& F) {
    const float* c_in = F.a->in[1]; const float* w_mod = F.a->in[2]; const float* b_mod = F.a->in[3];
    float* MOD = (float*)(F.ws + WS_MOD);
    for (int item = F.bid; item < 48; item += F.G) {
        LAS float* SC = (LAS float*)F.lds;
        __syncthreads();
        for (int i = F.tid; i < 32768; i += NTHR) { const int b = i >> 10, k = i & 1023; SC[k * 32 + b] = silu_f(c_in[i]); }
        __syncthreads();
        const int col = item * 128 + (F.tid >> 2), kq = F.tid & 3;
        float a[32];
#pragma unroll
        for (int b = 0; b < 32; ++b) a[b] = 0.f;
        for (int kk = 0; kk < 256; ++kk) { const int k = kq * 256 + kk; const float w = w_mod[(size_t)k * 6144 + col];
#pragma unroll
            for (int b4 = 0; b4 < 8; ++b4) { const f32x4 s = *(const LAS f32x4*)(SC + k * 32 + b4 * 4); a[b4 * 4 + 0] += w * s[0]; a[b4 * 4 + 1] += w * s[1]; a[b4 * 4 + 2] += w * s[2]; a[b4 * 4 + 3] += w * s[3]; } }
#pragma unroll
        for (int b = 0; b < 32; ++b) { a[b] += __shfl_xor(a[b], 1); a[b] += __shfl_xor(a[b], 2); }
        if (kq == 0) { const float bm = b_mod[col];
#pragma unroll
            for (int b = 0; b < 32; ++b) MOD[(size_t)b * 6144 + col] = a[b] + bm; }
        __syncthreads();
    }
    if (F.bid == (F.G > 48 ? 48 : 0)) {
        float* BT = (float*)(F.ws + WS_BIAST); const float* rel_bias = F.a->in[8];
        for (int i = F.tid; i < 249 * 8; i += NTHR) { const int idx = i >> 3, h = i & 7, rel = idx - 185; const int n = rel < 0 ? -rel : rel;
            const float nf = (float)(n > 1 ? n : 1); int large = 8 + (int)(logf(nf / 8.0f) / 2.7725887f * 8.0f); if (large > 15) large = 15;
            const int bucket = (rel > 0 ? 16 : 0) + (n < 8 ? n : large);
            BT[i] = rel_bias[bucket * 8 + h] * LOG2E; }
    }
    LAS float* scr = (LAS float*)(F.lds + F.wave * 16384);
    __syncthreads();
    const int gw = F.bid * NWAVES + F.wave, NGW = F.G * NWAVES;
    constexpr int I_WIN = 16 * (NPROJ / 32), I_SQ = 16 * 32, I_W1E = 16 * 64, I_W2E = 16 * 32;
    constexpr int NITEMS = I_WIN + 3 * I_SQ + 32 * I_W1E + 32 * I_W2E;
    for (int it = gw; it < NITEMS; it += NGW) {
        int r = it;
        if (r < I_WIN) { transpose_item(F.a->in[4], 1024, 6872, (bf16_t*)(F.ws + WS_WIN), MapWin(), scr, r / (NPROJ / 32), r % (NPROJ / 32), F.lane, nullptr); continue; } r -= I_WIN;
        if (r < I_SQ) { transpose_item(F.a->in[15], 1024, 1024, (bf16_t*)(F.ws + WS_WPA), MapIdent(), scr, r / 32, r % 32, F.lane, nullptr); continue; } r -= I_SQ;
        if (r < I_SQ) { transpose_item(F.a->in[16], 1024, 1024, (bf16_t*)(F.ws + WS_WPB), MapIdent(), scr, r / 32, r % 32, F.lane, F.a->in[14]); continue; } r -= I_SQ;
        if (r < I_SQ) { transpose_item(F.a->in[17], 1024, 1024, (bf16_t*)(F.ws + WS_WOUT), MapIdent(), scr, r / 32, r % 32, F.lane, nullptr); continue; } r -= I_SQ;
        if (r < 32 * I_W1E) { const int e = r / I_W1E, q = r % I_W1E; transpose_item(F.a->in[22] + (size_t)e * 1024 * 2048, 1024, 2048, (bf16_t*)(F.ws + WS_W1) + (size_t)e * 2048 * 1024, MapW1(), scr, q / 64, q % 64, F.lane, nullptr); continue; } r -= 32 * I_W1E;
        { const int e = r / I_W2E, q = r % I_W2E; transpose_item(F.a->in[24] + (size_t)e * 1024 * 1024, 1024, 1024, (bf16_t*)(F.ws + WS_W2) + (size_t)e * 1024 * 1024, MapIdent(), scr, q / 32, q % 32, F.lane, nullptr); }
    }
}

__device__ __forceinline__ void ph_ln1(Frame& F) {
    const float* x = F.a->in[0]; const float* MOD = (const float*)(F.ws + WS_MOD); bf16_t* U = (bf16_t*)(F.outb + OUT_U);
    const int gw = F.bid * NWAVES + F.wave, NGW = F.G * NWAVES;
    for (int m = gw; m < NTOK; m += NGW) {
        const f32x4* xr = (const f32x4*)(x + (size_t)m * D) + F.lane; const float* md = MOD + (size_t)(m >> 11) * 6144;
        f32x4 v[4]; float s = 0.f;
#pragma unroll
        for (int j = 0; j < 4; ++j) { v[j] = xr[64 * j]; s += (v[j][0] + v[j][1]) + (v[j][2] + v[j][3]); }
        const float mean = wave_sum(s) * (1.f / D); float s2 = 0.f;
#pragma unroll
        for (int j = 0; j < 4; ++j) { v[j] = v[j] - mean; s2 += (v[j][0] * v[j][0] + v[j][1] * v[j][1]) + (v[j][2] * v[j][2] + v[j][3] * v[j][3]); }
        const float rstd = 1.f / sqrtf(wave_sum(s2) * (1.f / D) + LN_EPS);
        u32x2* o8 = (u32x2*)(U + (size_t)m * D) + F.lane;
#pragma unroll
        for (int j = 0; j < 4; ++j) { const f32x4 sh = *((const f32x4*)md + F.lane + 64 * j), sc = *((const f32x4*)(md + 1024) + F.lane + 64 * j);
            const f32x4 r = v[j] * rstd * (sc + 1.0f) + sh; u32x2 w; w.x = cvt_pk_bf16(r[0], r[1]); w.y = cvt_pk_bf16(r[2], r[3]); o8[64 * j] = w; }
    }
}

__device__ __forceinline__ void ph_misc(Frame& F) {
    const float* MISC = (const float*)(F.outb + OUT_MISC);
    bf16_t* KV = (bf16_t*)(F.outb + OUT_KV); bf16_t* IK = (bf16_t*)(F.outb + OUT_IK); float* IW = (float*)(F.outb + OUT_IW); float* DT = (float*)(F.outb + OUT_DT);
    const float* kvw = F.a->in[5]; const float* ikw = F.a->in[6]; const float* ikb = F.a->in[7]; const float* dtb = F.a->in[11];
    const int gw = F.bid * NWAVES + F.wave, NGW = F.G * NWAVES, l = F.lane;
    for (int m = gw; m < NTOK; m += NGW) {
        const f32x4 v = *((const f32x4*)(MISC + (size_t)m * 256) + l);
        const float sq = v[0] * v[0] + v[1] * v[1] + v[2] * v[2] + v[3] * v[3], sm = (v[0] + v[1]) + (v[2] + v[3]);
        const float kvss = wave_sum(l < 32 ? sq : 0.f);
        const float iks = wave_sum((l >= 32 && l < 48) ? sm : 0.f);
        const float ikmean = iks * (1.f / 64.f);
        const f32x4 dv = v - ikmean;
        const float ikq = wave_sum((l >= 32 && l < 48) ? (dv[0] * dv[0] + dv[1] * dv[1] + dv[2] * dv[2] + dv[3] * dv[3]) : 0.f);
        if (l < 32) { const float r = 1.f / sqrtf(kvss * (1.f / 128.f) + LN_EPS); const f32x4 w = *((const f32x4*)kvw + l); const f32x4 o = v * r * w;
            u32x2 pk; pk.x = cvt_pk_bf16(o[0], o[1]); pk.y = cvt_pk_bf16(o[2], o[3]); *((u32x2*)(KV + (size_t)m * 128) + l) = pk; }
        else if (l < 48) { const float r = 1.f / sqrtf(ikq * (1.f / 64.f) + LN_EPS); const f32x4 w = *((const f32x4*)ikw + (l - 32)), bb = *((const f32x4*)ikb + (l - 32)); const f32x4 o = dv * r * w + bb;
            u32x2 pk; pk.x = cvt_pk_bf16(o[0], o[1]); pk.y = cvt_pk_bf16(o[2], o[3]); *((u32x2*)(IK + (size_t)m * 64) + (l - 32)) = pk; }
        else if (l < 50) { *((f32x4*)(IW + (size_t)m * 8) + (l - 48)) = v * 0.35355339059327373f; }
        else if (l < 54) { const f32x4 bb = *((const f32x4*)dtb + (l - 50)); f32x4 o;
#pragma unroll
            for (int j = 0; j < 4; ++j) { const float t = v[j] + bb[j]; o[j] = t > 20.f ? t : log1pf(__expf(t)); }
            *((f32x4*)(DT + (size_t)m * 16) + (l - 50)) = o; }
    }
}

__device__ __forceinline__ unsigned sortable_key(float s) { const unsigned u = __float_as_uint(s + 0.0f); return (u & 0x80000000u) ? ~u : (u | 0x80000000u); }
template <int NKB> struct KeyRow { unsigned k[NKB]; };
__device__ __forceinline__ u64 low_bits_keep(u64 m, int t) { u64 out = 0; while (t-- > 0 && m) { const u64 b = m & (0 - m); out |= b; m ^= b; } return out; }
__device__ __forceinline__ void topk_select_write(const unsigned (&key)[32], int nkb, u64* mrow, int lane) {
    unsigned T = 0u; bool exact = false;
    for (int bit = 31; bit >= 0; --bit) {
        const unsigned cand = T | (1u << bit); int cnt = 0;
#pragma unroll
        for (int j = 0; j < 32; ++j) if (j < nkb) cnt += __builtin_popcountll(__ballot(key[j] >= cand));
        if (cnt >= 256) T = cand;
        if (cnt == 256) { exact = true; break; }
    }
    u64 mine = 0ull;
    if (exact) {
#pragma unroll
        for (int j = 0; j < 32; ++j) if (j < nkb) { const u64 m = __ballot(key[j] >= T); if (lane == j) mine = m; }
    } else {
        int cgt = 0;
#pragma unroll
        for (int j = 0; j < 32; ++j) if (j < nkb) cgt += __builtin_popcountll(__ballot(key[j] > T));
        int rem = 256 - cgt;
#pragma unroll
        for (int j = 0; j < 32; ++j) if (j < nkb) { const u64 gt = __ballot(key[j] > T), eq = __ballot(key[j] == T); const int ne = __builtin_popcountll(eq);
            u64 m = gt; if (rem >= ne) { m |= eq; rem -= ne; } else if (rem > 0) { m |= low_bits_keep(eq, rem); rem = 0; }
            if (lane == j) mine = m; }
    }
    if (lane < nkb) mrow[lane] = mine;
}
__device__ __forceinline__ void ph_index(Frame& F) {
    const bf16_t* IQ = (const bf16_t*)(F.outb + OUT_IQ); const bf16_t* IK = (const bf16_t*)(F.outb + OUT_IK); const float* IW = (const float*)(F.outb + OUT_IW);
    u64* MASK = (u64*)(F.outb + OUT_MASK);
    const int gw = F.bid * NWAVES + F.wave, NGW = F.G * NWAVES, lane = F.lane, r32 = lane & 31, hi = lane >> 5;
    for (int item = gw; item < NTOK / 4; item += NGW) {
        const int tok0 = item * 4, b = tok0 >> 11, pos0 = tok0 & 2047, nkb = (pos0 >> 6) + 1;
        u64* mrow = MASK + (size_t)tok0 * 32;
        if (nkb <= 4) {
#pragma unroll
            for (int q = 0; q < 4; ++q) if (lane < nkb) mrow[q * 32 + lane] = ~0ull;
            continue;
        }
        bf16x8 af[4];
        { const bf16_t* ap = IQ + (size_t)(tok0 + (r32 >> 3)) * 512 + (r32 & 7) * 64 + hi * 8;
#pragma unroll
          for (int ks = 0; ks < 4; ++ks) af[ks] = *(const bf16x8*)(ap + ks * 16); }
        f32x4 iwv[4];
#pragma unroll
        for (int q = 0; q < 4; ++q) iwv[q] = *(const f32x4*)(IW + (size_t)(tok0 + q) * 8 + 4 * hi);
        unsigned key[4][32];
        const bf16_t* kb0 = IK + (size_t)(b * SEQ + r32) * 64 + hi * 8;
#pragma unroll
        for (int j = 0; j < 32; ++j) {
            if (j < nkb) {
                const bf16_t* kp = kb0 + (size_t)j * 64 * 64;
                bf16x8 bA[4], bB[4];
#pragma unroll
                for (int ks = 0; ks < 4; ++ks) { bA[ks] = *(const bf16x8*)(kp + ks * 16); bB[ks] = *(const bf16x8*)(kp + 32 * 64 + ks * 16); }
                f32x16 cA = {}, cB = {};
#pragma unroll
                for (int ks = 0; ks < 4; ++ks) { cA = __builtin_amdgcn_mfma_f32_32x32x16_bf16(af[ks], bA[ks], cA, 0, 0, 0); cB = __builtin_amdgcn_mfma_f32_32x32x16_bf16(af[ks], bB[ks], cB, 0, 0, 0); }
#pragma unroll
                for (int q = 0; q < 4; ++q) {
                    float pA = 0.f, pB = 0.f;
#pragma unroll
                    for (int t = 0; t < 4; ++t) { pA += fmaxf(cA[4 * q + t], 0.f) * iwv[q][t]; pB += fmaxf(cB[4 * q + t], 0.f) * iwv[q][t]; }
                    auto rr = __builtin_amdgcn_permlane32_swap(__float_as_uint(pA), __float_as_uint(pB), false, false);
                    key[q][j] = sortable_key(__uint_as_float(rr[0]) + __uint_as_float(rr[1]));
                }
            } else {
#pragma unroll
                for (int q = 0; q < 4; ++q) key[q][j] = 0u;
            }
        }
#pragma unroll
        for (int q = 0; q < 4; ++q) topk_select_write(key[q], nkb, mrow + q * 32, lane);
    }
}

namespace att {
constexpr int KVBLK = 64;
constexpr int SHM_V = KVBLK * 128 * 2, SHM_K = SHM_V;
constexpr int OFF_V = 0, OFF_K = 2 * SHM_V, OFF_WS = 2 * SHM_V + 2 * SHM_K, OFF_BT = OFF_WS + NWAVES * 64 * 4;
#define KSWZ(row, colB) ((row) * 256 + ((colB) ^ (((row) & 7) << 4)))
__device__ __forceinline__ int crow(int r, int hi) { return (r & 3) + 8 * (r >> 2) + 4 * hi; }
__device__ __forceinline__ int v_st(int k, int c) { const int kk = (k & ~0xC) | ((k & 4) << 1) | ((k & 8) >> 1); return ((kk >> 3) * 4 + (c >> 5)) * 512 + ((kk & 7) * 32 + (c & 31)) * 2; }
__device__ __forceinline__ int v_rd_base(int lane) { return ((lane & 3) << 3) | (((lane >> 2) & 3) << 6) | (((lane >> 4) & 1) << 5) | (((lane >> 5) & 1) << 8); }
constexpr int v_rd_off(int d0, int ks, int half) { return d0 * 512 + ks * 4096 + half * 2048; }
template <int OFF> __device__ __forceinline__ s16x4 tr_read(int vb) { s16x4 r; asm volatile("ds_read_b64_tr_b16 %0, %1 offset:%2" : "=&v"(r) : "v"(vb), "i"(OFF) : "memory"); return r; }
template <int D0> __device__ __forceinline__ void pv_one(f32x16& od, int vb, bf16x8 pa0, bf16x8 pa1, bf16x8 pa2, bf16x8 pa3) {
    const s16x4 l0 = tr_read<v_rd_off(D0, 0, 0)>(vb), h0 = tr_read<v_rd_off(D0, 0, 1)>(vb), l1 = tr_read<v_rd_off(D0, 1, 0)>(vb), h1 = tr_read<v_rd_off(D0, 1, 1)>(vb);
    const s16x4 l2 = tr_read<v_rd_off(D0, 2, 0)>(vb), h2 = tr_read<v_rd_off(D0, 2, 1)>(vb), l3 = tr_read<v_rd_off(D0, 3, 0)>(vb), h3 = tr_read<v_rd_off(D0, 3, 1)>(vb);
    asm volatile("s_waitcnt lgkmcnt(0)" ::: "memory"); SBAR();
#define PK(L, H) (bf16x8){L[0], L[1], L[2], L[3], H[0], H[1], H[2], H[3]}
    od = __builtin_amdgcn_mfma_f32_32x32x16_bf16(pa0, PK(l0, h0), od, 0, 0, 0);
    od = __builtin_amdgcn_mfma_f32_32x32x16_bf16(pa1, PK(l1, h1), od, 0, 0, 0);
    od = __builtin_amdgcn_mfma_f32_32x32x16_bf16(pa2, PK(l2, h2), od, 0, 0, 0);
    od = __builtin_amdgcn_mfma_f32_32x32x16_bf16(pa3, PK(l3, h3), od, 0, 0, 0);
#undef PK
}
__device__ __forceinline__ void qkt(f32x16& p0, f32x16& p1, const char* Ks, const bf16x8* qr, int r32, int hi) {
    p0 = f32x16{}; p1 = f32x16{};
    int rv = r32; asm volatile("" : "+v"(rv));
    const char* kb = Ks + rv * 256; const int swz = ((rv & 7) << 4) ^ (hi * 16);
#pragma unroll
    for (int d0 = 0; d0 < 8; ++d0) { const char* ka = kb + ((d0 * 32) ^ swz);
        const bf16x8 b0 = *reinterpret_cast<const bf16x8*>(ka);
        const bf16x8 b1 = *reinterpret_cast<const bf16x8*>(ka + 8192);
        p0 = __builtin_amdgcn_mfma_f32_32x32x16_bf16(b0, qr[d0], p0, 0, 0, 0);
        p1 = __builtin_amdgcn_mfma_f32_32x32x16_bf16(b1, qr[d0], p1, 0, 0, 0); }
}
__device__ __forceinline__ void attn_item(Frame& F, int b, int q0, char* lds) {
    const bf16_t* Q = (const bf16_t*)(F.ws + WS_Q); const bf16_t* KV = (const bf16_t*)(F.outb + OUT_KV); const u64* MASK = (const u64*)(F.outb + OUT_MASK);
    bf16_t* OA = (bf16_t*)(F.outb + OUT_OA);
    const int tid = F.tid, wid = F.wave, lane = F.lane, r32 = lane & 31, hi = lane >> 5;
    char* V_lds = lds + OFF_V; char* K_lds = lds + OFF_K;
    float* wsl = (float*)(lds + OFF_WS) + wid * 64; float* li_l = wsl; float* al_l = wsl + 32;
    const float* btab = (const float*)(lds + OFF_BT);
    constexpr float C = 0.088388347648318440f * LOG2E;
    float m_reg = -1e30f, l_reg = 0.f; f32x16 o[4] = {}; bf16x8 qr[8];
    const size_t tokq = (size_t)b * SEQ + q0 + r32;
    { const bf16_t* Qw = Q + tokq * 1024 + wid * 128 + hi * 8;
#pragma unroll
      for (int d0 = 0; d0 < 8; ++d0) qr[d0] = *(const bf16x8*)(Qw + d0 * 16); }
    const u64* mq = MASK + tokq * 32;
    const int sr = tid >> 4, sc = (tid & 15) * 8;
    const int vb0 = (int)(uintptr_t)V_lds + v_rd_base(lane);
    const bf16_t* Kb = KV + (size_t)b * SEQ * 128;
    const int NT = (q0 >> 6) + 1;
    const float bfar = btab[wid];
    bf16x8 s0, s1;
#define SLOAD(k0) do { s0 = *(const bf16x8*)(Kb + (size_t)((k0) + sr) * 128 + sc); s1 = *(const bf16x8*)(Kb + (size_t)((k0) + 32 + sr) * 128 + sc); } while (0)
#define SWRITE(bf) do { int srv = sr; asm volatile("" : "+v"(srv)); const int kc = sc * 2; const int v0a = v_st(srv, sc), k0a = KSWZ(srv, kc); \
        *(bf16x8*)(V_lds + (bf) * SHM_V + v0a) = s0; *(bf16x8*)(V_lds + (bf) * SHM_V + v0a + 8192) = s1; \
        *(bf16x8*)(K_lds + (bf) * SHM_K + k0a) = s0; *(bf16x8*)(K_lds + (bf) * SHM_K + k0a + 8192) = s1; } while (0)
    __syncthreads();
    SLOAD(0); VM_WAIT(); SWRITE(0); __syncthreads();
    for (int j = 0; j < NT; ++j) {
        const int bf = j & 1;
        if (j + 1 < NT) SLOAD((j + 1) * KVBLK);
        const u64 mw = mq[j];
        f32x16 p0, p1;
        qkt(p0, p1, K_lds + bf * SHM_K, qr, r32, hi);
        const unsigned w0 = (unsigned)(mw >> (4 * hi)), w1 = (unsigned)(mw >> (32 + 4 * hi));
        const int relmax = j * KVBLK + 63 - q0;
        if (relmax <= -91) {
#pragma unroll
            for (int r = 0; r < 16; ++r) { const int cb = (r & 3) + 8 * (r >> 2);
                const float t0 = fmaf(p0[r], C, bfar), t1 = fmaf(p1[r], C, bfar); p0[r] = ((w0 >> cb) & 1u) ? t0 : -1e30f; p1[r] = ((w1 >> cb) & 1u) ? t1 : -1e30f; }
        } else {
            const float* bp = btab + (j * KVBLK + 4 * hi - (q0 + r32) + 185) * 8 + wid;
#pragma unroll
            for (int r4 = 0; r4 < 4; ++r4) {
#pragma unroll
                for (int rr = 0; rr < 4; ++rr) { const int r = r4 * 4 + rr; const int cb = (r & 3) + 8 * (r >> 2);
                    const float bv0 = bp[cb * 8], bv1 = bp[(cb + 32) * 8]; const float t0 = fmaf(p0[r], C, bv0), t1 = fmaf(p1[r], C, bv1);
                    p0[r] = ((w0 >> cb) & 1u) ? t0 : -1e30f; p1[r] = ((w1 >> cb) & 1u) ? t1 : -1e30f; }
                SBAR(); }
        }
        float pmax = p0[0];
#pragma unroll
        for (int r = 1; r < 16; ++r) pmax = fmaxf(pmax, p0[r]);
#pragma unroll
        for (int r = 0; r < 16; ++r) pmax = fmaxf(pmax, p1[r]);
        { auto rr = __builtin_amdgcn_permlane32_swap(__float_as_uint(pmax), __float_as_uint(pmax), false, false); pmax = fmaxf(__uint_as_float(rr[0]), __uint_as_float(rr[1])); }
        float alpha = 1.f;
        if (!__all(pmax - m_reg <= 11.0f)) { const float mn = fmaxf(m_reg, pmax); alpha = __builtin_amdgcn_exp2f(m_reg - mn); m_reg = mn; }
        float ps = 0.f;
#pragma unroll
        for (int r = 0; r < 16; ++r) { p0[r] = __builtin_amdgcn_exp2f(p0[r] - m_reg); p1[r] = __builtin_amdgcn_exp2f(p1[r] - m_reg); ps += p0[r] + p1[r]; }
        { auto rr = __builtin_amdgcn_permlane32_swap(__float_as_uint(ps), __float_as_uint(ps), false, false); ps = __uint_as_float(rr[0]) + __uint_as_float(rr[1]); }
        l_reg = l_reg * alpha + ps;
        bf16x8 pa0, pa1, pa2, pa3;
#define PK4(P, BASE, OUT) do { unsigned a0 = cvt_pk_bf16(P[BASE + 0], P[BASE + 1]), a1 = cvt_pk_bf16(P[BASE + 2], P[BASE + 3]);   \
    unsigned b0 = cvt_pk_bf16(P[BASE + 4], P[BASE + 5]), b1 = cvt_pk_bf16(P[BASE + 6], P[BASE + 7]);                              \
    auto r0 = __builtin_amdgcn_permlane32_swap(a0, b0, false, false); auto r1 = __builtin_amdgcn_permlane32_swap(a1, b1, false, false); \
    u32x4 w = {r0[0], r1[0], r0[1], r1[1]}; OUT = *reinterpret_cast<bf16x8*>(&w); } while (0)
        PK4(p0, 0, pa0); PK4(p0, 8, pa1); PK4(p1, 0, pa2); PK4(p1, 8, pa3);
#undef PK4
        if (__any(alpha < 1.f)) { if (hi == 0) al_l[r32] = alpha; LDS_WAIT();
#pragma unroll
            for (int d = 0; d < 4; ++d)
#pragma unroll
                for (int r = 0; r < 16; ++r) o[d][r] *= al_l[crow(r, hi)]; }
        const int vb = vb0 + bf * SHM_V;
        pv_one<0>(o[0], vb, pa0, pa1, pa2, pa3); pv_one<1>(o[1], vb, pa0, pa1, pa2, pa3); pv_one<2>(o[2], vb, pa0, pa1, pa2, pa3); pv_one<3>(o[3], vb, pa0, pa1, pa2, pa3);
        if (j + 1 < NT) { VM_WAIT(); SWRITE(bf ^ 1); }
        __syncthreads();
    }
#undef SLOAD
#undef SWRITE
    if (hi == 0) li_l[r32] = l_reg; LDS_WAIT();
    bf16_t* Ow = OA + ((size_t)b * SEQ + q0 + 4 * hi) * 1024 + wid * 128 + r32;
    const float* lip = li_l + 4 * hi;
    asm volatile("" : "+v"(Ow), "+v"(lip));
#pragma unroll
    for (int r = 0; r < 16; ++r) { const int ro = (r & 3) + 8 * (r >> 2); const float rl = fast_rcp(lip[ro]);
#pragma unroll
        for (int d0 = 0; d0 < 4; ++d0) { float v = o[d0][r] * rl; if ((DBG_ATTN_ZERO == 1 && q0 < 256) || (DBG_ATTN_ZERO == 2 && q0 >= 256)) v = 0.f; Ow[ro * 1024 + d0 * 32] = (bf16_t)(cvt_pk_bf16(v, v) & 0xffffu); }
        if ((r & 3) == 3) SBAR(); }
}
}
__device__ __forceinline__ void ph_attn(Frame& F) {
    char* lds = (char*)(unsigned char*)F.lds;
    { float* bt = (float*)(lds + att::OFF_BT); const float* BT = (const float*)(F.ws + WS_BIAST); __syncthreads(); for (int i = F.tid; i < 249 * 8; i += NTHR) bt[i] = BT[i]; __syncthreads(); }
    for (int pr = F.bid; pr < NB * 32; pr += F.G) {
        const int b = pr >> 5, qb = pr & 31;
#pragma nounroll
        for (int hh = 0; hh < 2; ++hh) att::attn_item(F, b, (hh ? qb : 63 - qb) * 32, lds);
    }
}

namespace ssd {
constexpr int OFF_CS = 0, CS_ST = 272;
constexpr int OFF_BS = OFF_CS + 64 * CS_ST;
constexpr int OFF_BT = OFF_BS + 64 * CS_ST, T_ST = 144;
constexpr int OFF_XT = OFF_BT + 128 * T_ST;
constexpr int OFF_XW = OFF_XT + 64 * T_ST;
constexpr int OFF_XS = OFF_XW + 64 * T_ST;
constexpr int OFF_MT = OFF_XS + 64 * T_ST;
constexpr int OFF_HS = OFF_MT + 64 * T_ST;
constexpr int OFF_END = OFF_HS + 64 * CS_ST;
static_assert(OFF_END + 5 * 320 * 4 <= 131072, "ssd lds");
__device__ __forceinline__ f32x4 mfma16(bf16x8 a, bf16x8 b, f32x4 c) { return __builtin_amdgcn_mfma_f32_16x16x32_bf16(a, b, c, 0, 0, 0); }
__device__ __forceinline__ bf16x8 ldfrag(const char* base, int stride, int row, int k0) { return *(const bf16x8*)(base + row * stride + k0 * 2); }
}
__device__ __forceinline__ void ph_ssd(Frame& F) {
    using namespace ssd;
    char* lds = (char*)(unsigned char*)F.lds;
    const bf16_t* XBC = (const bf16_t*)(F.ws + WS_XBC); const bf16_t* ZS = (const bf16_t*)(F.ws + WS_Z); const float* DT = (const float*)(F.outb + OUT_DT);
    bf16_t* YG = (bf16_t*)(F.ws + WS_Q);
    const float* conv_w = F.a->in[9]; const float* conv_b = F.a->in[10]; const float* a_log = F.a->in[12]; const float* d_skip = F.a->in[13];
    const int tid = F.tid, wid = F.wave, lane = F.lane, fr = lane & 15, fq = lane >> 4;
    const bool stager = tid < 320; const int so = tid % 40, tg = tid / 40;
    for (int item = F.bid; item < NB * 16; item += F.G) {
        const int b = item >> 4, h = item & 15, g = h >> 2;
        const float aneg = -__expf(a_log[h]), dsk = d_skip[h];
        const int ch0 = so < 8 ? h * 64 + so * 8 : (so < 24 ? 1024 + g * 128 + (so - 8) * 8 : 1536 + g * 128 + (so - 24) * 8);
        float* CWL = (float*)(lds + OFF_END);
        __syncthreads();
        if (stager) {
#pragma unroll
            for (int j = 0; j < 4; ++j) { *(f32x4*)(CWL + j * 320 + so * 8) = *(const f32x4*)(conv_w + (size_t)j * 2048 + ch0); *(f32x4*)(CWL + j * 320 + so * 8 + 4) = *(const f32x4*)(conv_w + (size_t)j * 2048 + ch0 + 4); }
            *(f32x4*)(CWL + 4 * 320 + so * 8) = *(const f32x4*)(conv_b + ch0); *(f32x4*)(CWL + 4 * 320 + so * 8 + 4) = *(const f32x4*)(conv_b + ch0 + 4);
        }
        f32x4 hst[4];
#pragma unroll
        for (int t = 0; t < 4; ++t) hst[t] = (f32x4){0.f, 0.f, 0.f, 0.f};
        __syncthreads();
        for (int i = tid; i < 64 * CS_ST / 4; i += NTHR) ((unsigned*)(lds + OFF_HS))[i] = 0u;
        u32x4 raw[11];
        const size_t tokb = (size_t)b * SEQ;
#define SSD_LOAD(c) do { if (stager) { _Pragma("unroll") for (int i = 0; i < 11; ++i) { const int t = (c) * 64 + tg * 8 - 3 + i; \
            raw[i] = (t >= 0) ? *(const u32x4*)(XBC + (tokb + t) * 2048 + ch0) : (u32x4){0u, 0u, 0u, 0u}; } } } while (0)
        SSD_LOAD(0);
        for (int c = 0; c < 32; ++c) {
            const float dtl = DT[(tokb + c * 64 + lane) * 16 + h];
            float acs = dtl * aneg;
#pragma unroll
            for (int o = 1; o < 64; o <<= 1) { const float t = __shfl_up(acs, o); if (lane >= o) acs += t; }
            const float alast = __shfl(acs, 63);
            if (DBG_SSD_SYNC) __syncthreads();
            float dtv[8], dec[8];
#pragma unroll
            for (int t = 0; t < 8; ++t) { dtv[t] = __shfl(dtl, (tg * 8 + t) & 63); dec[t] = __expf(alast - __shfl(acs, (tg * 8 + t) & 63)); }
            if (stager) {
#pragma unroll
                for (int hq = 0; hq < 2; ++hq) {
                    float xin[11][4];
#pragma unroll
                    for (int i = 0; i < 11; ++i) { const unsigned wa = hq ? raw[i].z : raw[i].x, wb = hq ? raw[i].w : raw[i].y; xin[i][0] = bflo(wa); xin[i][1] = bfhi(wa); xin[i][2] = bflo(wb); xin[i][3] = bfhi(wb); }
                    float outv[8][4];
                    { f32x4 cwv[4]; const f32x4 cbq = *(const f32x4*)(CWL + 4 * 320 + so * 8 + hq * 4);
#pragma unroll
                      for (int j = 0; j < 4; ++j) cwv[j] = *(const f32x4*)(CWL + j * 320 + so * 8 + hq * 4);
#pragma unroll
                      for (int t = 0; t < 8; ++t)
#pragma unroll
                        for (int e = 0; e < 4; ++e) { float sacc = cbq[e];
#pragma unroll
                            for (int j = 0; j < 4; ++j) sacc += cwv[j][e] * xin[t + j][e];
                            outv[t][e] = silu_f(sacc); } }
                    if (so < 8) {
#pragma unroll
                        for (int e = 0; e < 4; ++e) { const int p = so * 8 + hq * 4 + e;
                            f32x4 x0, x1, d0, d1, w0, w1;
#pragma unroll
                            for (int t = 0; t < 4; ++t) { x0[t] = outv[t][e]; x1[t] = outv[4 + t][e]; d0[t] = x0[t] * dtv[t]; d1[t] = x1[t] * dtv[4 + t]; w0[t] = d0[t] * dec[t]; w1[t] = d1[t] * dec[4 + t]; }
                            *(u32x4*)(lds + OFF_XS + p * T_ST + tg * 16) = pack8(x0, x1);
                            *(u32x4*)(lds + OFF_XT + p * T_ST + tg * 16) = pack8(d0, d1);
                            *(u32x4*)(lds + OFF_XW + p * T_ST + tg * 16) = pack8(w0, w1); }
                    } else {
                        const bool isB = so < 24; const int n0 = (isB ? (so - 8) : (so - 24)) * 8 + hq * 4;
                        char* nat = lds + (isB ? OFF_BS : OFF_CS);
#pragma unroll
                        for (int t = 0; t < 8; ++t) { u32x2 w; w.x = cvt_pk_bf16(outv[t][0], outv[t][1]); w.y = cvt_pk_bf16(outv[t][2], outv[t][3]);
                            *(u32x2*)(nat + (tg * 8 + t) * CS_ST + n0 * 2) = w; }
                        if (isB) {
#pragma unroll
                            for (int e = 0; e < 4; ++e) { f32x4 a, bq;
#pragma unroll
                                for (int t = 0; t < 4; ++t) { a[t] = outv[t][e]; bq[t] = outv[4 + t][e]; }
                                *(u32x4*)(lds + OFF_BT + (n0 + e) * T_ST + tg * 16) = pack8(a, bq); }
                        }
                    }
                }
            }
            if (c + 1 < 32) SSD_LOAD(c + 1);
            __syncthreads();
#pragma unroll
            for (int t2 = 0; t2 < 2; ++t2) {
                const int tile = 2 * wid + t2, sb = tile >> 2, lb = tile & 3;
                f32x4 d = (f32x4){0.f, 0.f, 0.f, 0.f};
                if (sb <= lb) {
#pragma unroll
                    for (int ks = 0; ks < 4; ++ks) d = mfma16(ldfrag(lds + OFF_BS, CS_ST, sb * 16 + fr, ks * 32 + fq * 8), ldfrag(lds + OFF_CS, CS_ST, lb * 16 + fr, ks * 32 + fq * 8), d);
                    const int l = lb * 16 + fr; const float al = __shfl(acs, l);
                    f32x4 as;
#pragma unroll
                    for (int r = 0; r < 4; ++r) as[r] = __shfl(acs, sb * 16 + 4 * fq + r);
#pragma unroll
                    for (int r = 0; r < 4; ++r) { const int s = sb * 16 + 4 * fq + r; d[r] = (s <= l) ? d[r] * __expf(al - as[r]) : 0.f; }
                }
                u32x2 w; w.x = cvt_pk_bf16(d[0], d[1]); w.y = cvt_pk_bf16(d[2], d[3]);
                *(u32x2*)(lds + OFF_MT + (lb * 16 + fr) * T_ST + (sb * 16 + 4 * fq) * 2) = w;
            }
            if (DBG_SSD_SYNC) __syncthreads();
            f32x4 yacc[2];
#pragma unroll
            for (int t2 = 0; t2 < 2; ++t2) {
                const int tile = 2 * wid + t2, pb = tile >> 2, lb = tile & 3;
                f32x4 d = (f32x4){0.f, 0.f, 0.f, 0.f};
#pragma unroll
                for (int ks = 0; ks < 4; ++ks) d = mfma16(ldfrag(lds + OFF_HS, CS_ST, pb * 16 + fr, ks * 32 + fq * 8), ldfrag(lds + OFF_CS, CS_ST, lb * 16 + fr, ks * 32 + fq * 8), d);
                const float el = __expf(__shfl(acs, lb * 16 + fr));
                yacc[t2] = d * el;
            }
            __syncthreads();
#pragma unroll
            for (int t2 = 0; t2 < 2; ++t2) {
                const int tile = 2 * wid + t2, pb = tile >> 2, lb = tile & 3;
                f32x4 d = yacc[t2];
#pragma unroll
                for (int ks = 0; ks < 2; ++ks) d = mfma16(ldfrag(lds + OFF_XT, T_ST, pb * 16 + fr, ks * 32 + fq * 8), ldfrag(lds + OFF_MT, T_ST, lb * 16 + fr, ks * 32 + fq * 8), d);
                const int l = lb * 16 + fr, p0 = pb * 16 + 4 * fq; const size_t tok = tokb + c * 64 + l;
                const u32x2 zz = *(const u32x2*)(ZS + tok * 1024 + h * 64 + p0);
                const float z0 = bflo(zz.x), z1 = bfhi(zz.x), z2 = bflo(zz.y), z3 = bfhi(zz.y);
                float xs[4];
#pragma unroll
                for (int r = 0; r < 4; ++r) xs[r] = bflo((unsigned)*(const bf16_t*)(lds + OFF_XS + (p0 + r) * T_ST + l * 2));
                u32x2 w; w.x = cvt_pk_bf16((d[0] + xs[0] * dsk) * z0, (d[1] + xs[1] * dsk) * z1); w.y = cvt_pk_bf16((d[2] + xs[2] * dsk) * z2, (d[3] + xs[3] * dsk) * z3);
                *(u32x2*)(YG + tok * 1024 + h * 64 + p0) = w;
            }
            if (DBG_SSD_SYNC) __syncthreads();
            { const float dc = __expf(alast);
#pragma unroll
              for (int t = 0; t < 4; ++t) { f32x4 d = hst[t] * dc;
#pragma unroll
                  for (int ks = 0; ks < 2; ++ks) d = mfma16(ldfrag(lds + OFF_BT, T_ST, wid * 16 + fr, ks * 32 + fq * 8), ldfrag(lds + OFF_XW, T_ST, t * 16 + fr, ks * 32 + fq * 8), d);
                  hst[t] = d;
                  u32x2 w; w.x = cvt_pk_bf16(d[0], d[1]); w.y = cvt_pk_bf16(d[2], d[3]);
                  *(u32x2*)(lds + OFF_HS + (t * 16 + fr) * CS_ST + (wid * 16 + 4 * fq) * 2) = w; } }
            __syncthreads();
        }
#undef SSD_LOAD
    }
}

__device__ __forceinline__ void ph_gnorm(Frame& F) {
    bf16_t* YG = (bf16_t*)(F.ws + WS_Q);
    const int gw = F.bid * NWAVES + F.wave, NGW = F.G * NWAVES;
    for (int m = gw; m < NTOK; m += NGW) {
        u32x2* rp = (u32x2*)(YG + (size_t)m * D) + F.lane;
#pragma unroll
        for (int j = 0; j < 4; ++j) { const u32x2 w = rp[64 * j]; const float a = bflo(w.x), b = bfhi(w.x), c = bflo(w.y), d = bfhi(w.y);
            const float ss = wave_sum(a * a + b * b + c * c + d * d); const float r = 1.f / sqrtf(ss * (1.f / 256.f) + LN_EPS);
            u32x2 o; o.x = cvt_pk_bf16(a * r, b * r); o.y = cvt_pk_bf16(c * r, d * r); rp[64 * j] = o; }
    }
}

__device__ __forceinline__ void ph_router(Frame& F) {
    float* X1 = (float*)F.outb; bf16_t* U2 = (bf16_t*)(F.ws + WS_U2); const float* MOD = (const float*)(F.ws + WS_MOD);
    const float* ln1g = F.a->in[18]; const float* ln1b = F.a->in[19]; const float* w_router = F.a->in[20]; const float* b_router = F.a->in[21];
    u32x2* REG = (u32x2*)(F.ws + WS_REG); unsigned* CNT = (unsigned*)(F.ws + WS_CTL) + CW_CNT;
    LAS float* WRT = (LAS float*)F.lds;
    LAS unsigned* lcnt = (LAS unsigned*)(F.lds + LDS_AUX); LAS unsigned* lbase = lcnt + 32; LAS unsigned* ent = lcnt + 64;
    const int tid = F.tid, lane = F.lane, wid = F.wave;
    __syncthreads();
    for (int i = tid; i < 32768; i += NTHR) { const int c = i >> 5, e = i & 31; WRT[e * 1024 + c] = w_router[i]; }
    __syncthreads();
    for (int batch = F.bid; batch < NTOK / 256; batch += F.G) {
        const int hf = batch >> 7;
        if (tid < 32) lcnt[tid] = 0u;
        __syncthreads();
        for (int ti = 0; ti < 32; ++ti) {
            const int tl = wid * 32 + ti, m = batch * 256 + tl; const float* md = MOD + (size_t)(m >> 11) * 6144;
            f32x4* xr = (f32x4*)(X1 + (size_t)m * D) + lane;
            f32x4 v[4]; float s = 0.f;
#pragma unroll
            for (int j = 0; j < 4; ++j) { v[j] = xr[64 * j]; s += (v[j][0] + v[j][1]) + (v[j][2] + v[j][3]); }
            float mean = wave_sum(s) * (1.f / D), s2 = 0.f;
#pragma unroll
            for (int j = 0; j < 4; ++j) { v[j] = v[j] - mean; s2 += (v[j][0] * v[j][0] + v[j][1] * v[j][1]) + (v[j][2] * v[j][2] + v[j][3] * v[j][3]); }
            float rstd = 1.f / sqrtf(wave_sum(s2) * (1.f / D) + LN_EPS);
            s = 0.f;
#pragma unroll
            for (int j = 0; j < 4; ++j) { const f32x4 g = *((const f32x4*)ln1g + lane + 64 * j), bb = *((const f32x4*)ln1b + lane + 64 * j); v[j] = v[j] * rstd * g + bb; xr[64 * j] = v[j]; s += (v[j][0] + v[j][1]) + (v[j][2] + v[j][3]); }
            mean = wave_sum(s) * (1.f / D); s2 = 0.f;
#pragma unroll
            for (int j = 0; j < 4; ++j) { v[j] = v[j] - mean; s2 += (v[j][0] * v[j][0] + v[j][1] * v[j][1]) + (v[j][2] * v[j][2] + v[j][3] * v[j][3]); }
            rstd = 1.f / sqrtf(wave_sum(s2) * (1.f / D) + LN_EPS);
            u32x2* o8 = (u32x2*)(U2 + (size_t)m * D) + lane;
#pragma unroll
            for (int j = 0; j < 4; ++j) { const f32x4 sh = *((const f32x4*)(md + 3072) + lane + 64 * j), sc = *((const f32x4*)(md + 4096) + lane + 64 * j);
                v[j] = v[j] * rstd * (sc + 1.0f) + sh; u32x2 w; w.x = cvt_pk_bf16(v[j][0], v[j][1]); w.y = cvt_pk_bf16(v[j][2], v[j][3]); o8[64 * j] = w;
                if (DBG_ROUTER_BF16) { v[j][0] = bflo(w.x); v[j][1] = bfhi(w.x); v[j][2] = bflo(w.y); v[j][3] = bfhi(w.y); } }
            float part[32];
#pragma unroll
            for (int e = 0; e < 32; ++e) { float a = 0.f;
#pragma unroll
                for (int j = 0; j < 4; ++j) { const f32x4 w = *((const LAS f32x4*)(WRT + e * 1024) + lane + 64 * j); a += (v[j][0] * w[0] + v[j][1] * w[1]) + (v[j][2] * w[2] + v[j][3] * w[3]); }
                part[e] = a; }
#pragma unroll
            for (int i = 0; i < 16; ++i) { const bool up = (lane & 32) != 0; const float keep = up ? part[i + 16] : part[i], send = up ? part[i] : part[i + 16]; part[i] = keep + __shfl_xor(send, 32); }
#pragma unroll
            for (int i = 0; i < 8; ++i) { const bool up = (lane & 16) != 0; const float keep = up ? part[i + 8] : part[i], send = up ? part[i] : part[i + 8]; part[i] = keep + __shfl_xor(send, 16); }
#pragma unroll
            for (int i = 0; i < 4; ++i) { const bool up = (lane & 8) != 0; const float keep = up ? part[i + 4] : part[i], send = up ? part[i] : part[i + 4]; part[i] = keep + __shfl_xor(send, 8); }
#pragma unroll
            for (int i = 0; i < 2; ++i) { const bool up = (lane & 4) != 0; const float keep = up ? part[i + 2] : part[i], send = up ? part[i] : part[i + 2]; part[i] = keep + __shfl_xor(send, 4); }
            { const bool up = (lane & 2) != 0; const float keep = up ? part[1] : part[0], send = up ? part[0] : part[1]; part[0] = keep + __shfl_xor(send, 2); }
            const int myexp = lane >> 1;
            float logit = part[0] + __shfl_xor(part[0], 1) + b_router[myexp];
            float tv[4]; int tix[4];
#pragma unroll
            for (int k = 0; k < 4; ++k) { float bv = logit; int bi = myexp;
#pragma unroll
                for (int o = 1; o < 64; o <<= 1) { const float ov = __shfl_xor(bv, o); const int oi = __shfl_xor(bi, o); if (ov > bv || (ov == bv && oi < bi)) { bv = ov; bi = oi; } }
                tv[k] = bv; tix[k] = bi; if (myexp == bi) logit = -INFINITY; }
            const float e1 = __expf(tv[1] - tv[0]), e2 = __expf(tv[2] - tv[0]), e3 = __expf(tv[3] - tv[0]); const float inv = 1.f / (1.f + e1 + e2 + e3);
            if (lane < 4) { const int ee = lane == 0 ? tix[0] : (lane == 1 ? tix[1] : (lane == 2 ? tix[2] : tix[3])); const float gg = (lane == 0 ? 1.f : (lane == 1 ? e1 : (lane == 2 ? e2 : e3))) * inv;
                const unsigned lp = atomicAdd((unsigned*)&lcnt[ee], 1u);
                LAS unsigned* en = ent + (tl * 4 + lane) * 3; en[0] = (unsigned)ee; en[1] = lp; en[2] = __float_as_uint(gg);
                if (DBG_CHECK == 1) { u32x2 rw; rw.x = (unsigned)ee; rw.y = __float_as_uint(gg); ((u32x2*)(F.ws + WS_DBG))[(size_t)m * 4 + lane] = rw; } }
        }
        __syncthreads();
        if (tid < 32) lbase[tid] = __hip_atomic_fetch_add(CNT + 64 * (hf * 32 + tid), lcnt[tid], __ATOMIC_RELAXED, __HIP_MEMORY_SCOPE_AGENT);
        __syncthreads();
        for (int i = tid; i < 1024; i += NTHR) { const LAS unsigned* en = ent + i * 3; const unsigned ee = en[0], pos = lbase[ee] + en[1];
            const unsigned tokl = (unsigned)(batch * 256 + (i >> 2)) - (unsigned)hf * HALF_TOK;
            u32x2 w; w.x = tokl * 4u + (unsigned)(i & 3); w.y = en[2];
            if (pos < (unsigned)REG_CAP) REG[((size_t)hf * 32 + ee) * REG_CAP + pos] = w; }
        __syncthreads();
    }
}

__device__ __forceinline__ void ph_final(Frame& F, int hf) {
    float* X1 = (float*)F.outb; const bf16_t* YB = (const bf16_t*)(F.ws + WS_YB); const float* MOD = (const float*)(F.ws + WS_MOD);
    const float* g2 = F.a->in[26]; const float* b2 = F.a->in[27];
    const int gw = F.bid * NWAVES + F.wave, NGW = F.G * NWAVES, lane = F.lane;
    for (int tl = gw; tl < HALF_TOK; tl += NGW) {
        const int m = hf * HALF_TOK + tl; const float* md = MOD + (size_t)(m >> 11) * 6144 + 5120;
        f32x4* xr = (f32x4*)(X1 + (size_t)m * D) + lane; const u32x2* yr = (const u32x2*)(YB + (size_t)tl * 4 * D) + lane;
        f32x4 v[4]; float s = 0.f;
#pragma unroll
        for (int j = 0; j < 4; ++j) { f32x4 y = (f32x4){0.f, 0.f, 0.f, 0.f};
#pragma unroll
            for (int k = 0; k < 4; ++k) { const u32x2 w = yr[k * 256 + 64 * j]; y[0] += bflo(w.x); y[1] += bfhi(w.x); y[2] += bflo(w.y); y[3] += bfhi(w.y); }
            const f32x4 gt = *((const f32x4*)md + lane + 64 * j);
            if (DBG_NO_MOE) y = (f32x4){0.f, 0.f, 0.f, 0.f};
            v[j] = xr[64 * j] * DN_ALPHA + gt * y; s += (v[j][0] + v[j][1]) + (v[j][2] + v[j][3]); }
        const float mean = wave_sum(s) * (1.f / D); float s2 = 0.f;
#pragma unroll
        for (int j = 0; j < 4; ++j) { v[j] = v[j] - mean; s2 += (v[j][0] * v[j][0] + v[j][1] * v[j][1]) + (v[j][2] * v[j][2] + v[j][3] * v[j][3]); }
        const float rstd = 1.f / sqrtf(wave_sum(s2) * (1.f / D) + LN_EPS);
#pragma unroll
        for (int j = 0; j < 4; ++j) { const f32x4 g = *((const f32x4*)g2 + lane + 64 * j), bb = *((const f32x4*)b2 + lane + 64 * j); xr[64 * j] = v[j] * rstd * g + bb; }
    }
}


__device__ __forceinline__ float block_sum(Frame& F, float v, LAS float* red) {
    v = wave_sum(v); __syncthreads(); if (F.lane == 0) red[F.wave] = v; __syncthreads();
    float s = 0.f; for (int w = 0; w < NWAVES; ++w) s += red[w]; return s;
}
__device__ __forceinline__ float block_max(Frame& F, float v, LAS float* red) {
#pragma unroll
    for (int o = 1; o < 64; o <<= 1) v = fmaxf(v, __shfl_xor(v, o));
    __syncthreads(); if (F.lane == 0) red[F.wave] = v; __syncthreads();
    float s = 0.f; for (int w = 0; w < NWAVES; ++w) s = fmaxf(s, red[w]); return s;
}
__device__ __forceinline__ void dbg_report(Frame& F, float e) { if (F.tid == 0) atomicMax((unsigned*)(F.ws + WS_CTL) + CW_DBG, __float_as_uint(e)); }
__device__ __forceinline__ void dbg_check_moe(Frame& F) {
    if (F.bid >= 64) return;
    const int tok = HALF_TOK + 509 * F.bid + 3, tokl = tok - HALF_TOK, tid = F.tid;
    LAS float* u2 = (LAS float*)F.lds; LAS float* act = u2 + 1024; LAS float* red = act + 1024; LAS float* lg = red + 16;
    const bf16_t* U2 = (const bf16_t*)(F.ws + WS_U2); const bf16_t* YB = (const bf16_t*)(F.ws + WS_YB); const u32x2* RT = (const u32x2*)(F.ws + WS_DBG);
    const float* w1 = F.a->in[22]; const float* b1 = F.a->in[23]; const float* w2 = F.a->in[24]; const float* b2 = F.a->in[25];
    __syncthreads();
    for (int i = tid; i < 1024; i += NTHR) u2[i] = bflo((unsigned)U2[(size_t)tok * 1024 + i]);
    __syncthreads();
    float y0 = 0.f, y1 = 0.f;
    for (int k = 0; k < 4; ++k) {
        const u32x2 rw = RT[(size_t)tok * 4 + k]; const int e = (int)rw.x; const float g = __uint_as_float(rw.y);
        const float* W1 = w1 + (size_t)e * 1024 * 2048; const float* W2 = w2 + (size_t)e * 1024 * 1024;
        float h0 = b1[e * 2048 + tid], h1 = b1[e * 2048 + tid + 512], h2 = b1[e * 2048 + tid + 1024], h3 = b1[e * 2048 + tid + 1536];
        for (int c = 0; c < 1024; ++c) { const float uu = u2[c]; const float* wr = W1 + (size_t)c * 2048 + tid; h0 += uu * wr[0]; h1 += uu * wr[512]; h2 += uu * wr[1024]; h3 += uu * wr[1536]; }
        __syncthreads();
        { float gg = fminf(h0, 7.f), up = fminf(fmaxf(h2, -7.f), 7.f); act[tid] = (up + 1.f) * gg / (1.f + expf(-1.702f * gg));
          gg = fminf(h1, 7.f); up = fminf(fmaxf(h3, -7.f), 7.f); act[tid + 512] = (up + 1.f) * gg / (1.f + expf(-1.702f * gg)); }
        __syncthreads();
        float a0 = b2[e * 1024 + tid], a1 = b2[e * 1024 + tid + 512];
        for (int j = 0; j < 1024; ++j) { const float aa = act[j]; a0 += aa * W2[(size_t)j * 1024 + tid]; a1 += aa * W2[(size_t)j * 1024 + tid + 512]; }
        y0 += g * a0; y1 += g * a1;
    }
    float f0 = 0.f, f1 = 0.f;
    for (int k = 0; k < 4; ++k) { f0 += bflo((unsigned)YB[((size_t)tokl * 4 + k) * 1024 + tid]); f1 += bflo((unsigned)YB[((size_t)tokl * 4 + k) * 1024 + tid + 512]); }
    const float rms = sqrtf(block_sum(F, y0 * y0 + y1 * y1, red) * (1.f / 1024.f)) + 1e-20f;
    float err = block_max(F, fmaxf(fabsf(y0 - f0), fabsf(y1 - f1)), red) / rms;
    { const float* X1 = (const float*)F.outb + (size_t)tok * 1024; const float* md = (const float*)(F.ws + WS_MOD) + (size_t)(tok >> 11) * 6144;
      const float xa = X1[tid], xb = X1[tid + 512]; const float mean = block_sum(F, xa + xb, red) * (1.f / 1024.f);
      const float da = xa - mean, db = xb - mean; const float var = block_sum(F, da * da + db * db, red) * (1.f / 1024.f); const float rstd = 1.f / sqrtf(var + LN_EPS);
      __syncthreads();
      u2[tid] = da * rstd * (1.f + md[4096 + tid]) + md[3072 + tid]; u2[tid + 512] = db * rstd * (1.f + md[4096 + tid + 512]) + md[3072 + tid + 512];
      __syncthreads();
      if (tid < 32) { float a = F.a->in[21][tid]; for (int c = 0; c < 1024; ++c) a += u2[c] * F.a->in[20][c * 32 + tid]; lg[tid] = a; }
      __syncthreads();
      if (tid == 0) { unsigned want = 0u, got = 0u; float l2[32]; for (int i = 0; i < 32; ++i) l2[i] = lg[i];
          for (int k = 0; k < 4; ++k) { int bi = 0; for (int i = 1; i < 32; ++i) if (l2[i] > l2[bi]) bi = i; want |= 1u << bi; l2[bi] = -INFINITY; got |= 1u << RT[(size_t)tok * 4 + k].x; }
          lg[32] = (want != got) ? 1.f : 0.f; }
      __syncthreads();
      if (lg[32] != 0.f) err = 50.f; }
    dbg_report(F, err);
}
__device__ __forceinline__ void dbg_check_ssd(Frame& F) {
    if (F.bid >= 2) return;
    const int b = F.bid ? 20 : 5, h = F.bid ? 14 : 3, g = h >> 2, tid = F.tid, p = tid >> 3, ng = tid & 7;
    LAS float* red = (LAS float*)F.lds; LAS float* cv = red + 16;
    const bf16_t* XBC = (const bf16_t*)(F.ws + WS_XBC); const bf16_t* ZS = (const bf16_t*)(F.ws + WS_Z); const float* DT = (const float*)(F.outb + OUT_DT); const bf16_t* YG = (const bf16_t*)(F.ws + WS_Q);
    const float* cw = F.a->in[9]; const float* cb = F.a->in[10]; const float aneg = -expf(F.a->in[12][h]), dsk = F.a->in[13][h];
    const int mych = tid < 64 ? h * 64 + tid : (tid < 192 ? 1024 + g * 128 + (tid - 64) : 1536 + g * 128 + (tid - 192));
    float w0 = 0.f, w1 = 0.f, w2 = 0.f, w3 = 0.f, wb = 0.f;
    if (tid < 320) { w0 = cw[0 * 2048 + mych]; w1 = cw[1 * 2048 + mych]; w2 = cw[2 * 2048 + mych]; w3 = cw[3 * 2048 + mych]; wb = cb[mych]; }
    float x0 = 0.f, x1 = 0.f, x2 = 0.f;
    float hs[16];
#pragma unroll
    for (int i = 0; i < 16; ++i) hs[i] = 0.f;
    float emax = 0.f, ssq = 0.f, nbad = 0.f; int tmax = 0;
    for (int t = 0; t < SEQ; ++t) {
        const size_t tok = (size_t)b * SEQ + t;
        __syncthreads();
        if (DBG_HYP == 1 && (t & 63) == 0) { x0 = 0.f; x1 = 0.f; x2 = 0.f; }
        if (tid < 320) { const float x3 = bflo((unsigned)XBC[tok * 2048 + mych]); const float s = wb + w0 * x0 + w1 * x1 + w2 * x2 + w3 * x3; cv[tid] = s / (1.f + expf(-s)); x0 = x1; x1 = x2; x2 = x3; }
        __syncthreads();
        const float xv = cv[p], dt = DT[tok * 16 + h], dec = expf(dt * aneg);
        float yp = 0.f;
#pragma unroll
        for (int i = 0; i < 16; ++i) { const int n = ng * 16 + i; hs[i] = hs[i] * dec + dt * xv * cv[64 + n]; yp += cv[192 + n] * hs[i]; }
        yp += __shfl_xor(yp, 1); yp += __shfl_xor(yp, 2); yp += __shfl_xor(yp, 4);
        const float yv = (yp + xv * dsk) * bflo((unsigned)ZS[tok * 1024 + h * 64 + p]);
        const float yf = bflo((unsigned)YG[tok * 1024 + h * 64 + p]);
        if (ng == 0) { const float er = fabsf(yv - yf); if (er > emax) { emax = er; tmax = t; } ssq += yv * yv; if (er > 0.25f && (DBG_SUB < 5 || (DBG_SUB == 5 && (t & 63) == 0) || (DBG_SUB == 6 && (t & 63) == 1) || (DBG_SUB == 7 && (t & 63) == 32))) nbad += 1.f; }
    }
    const float rms = sqrtf(block_sum(F, ssq, red) / (64.f * SEQ)) + 1e-20f;
    const float M = block_max(F, emax, red);
    if (DBG_SUB == 0) dbg_report(F, M / rms);
    else if (DBG_SUB == 1) dbg_report(F, block_sum(F, nbad, red) / (64.f * SEQ));
    else if (DBG_SUB >= 5) dbg_report(F, block_sum(F, nbad, red) / (64.f * 32.f));
    else { __syncthreads(); if (ng == 0 && emax == M) red[12] = (float)(DBG_SUB == 2 ? ((tmax & 63) >> 1) : (DBG_SUB == 3 ? (tmax >> 6) : (p >> 1))); __syncthreads();
        if (F.bid == 0) dbg_report(F, powf(10.f, 2.f * (0.05f + 0.05f * red[12]) - 4.f)); }
}
__device__ __forceinline__ void dbg_check_attn(Frame& F) {
    if (F.bid >= 32) return;
    const int b = (F.bid * 7 + 3) & 31, pos = 300 + F.bid * 53, nadm = ((pos >> 6) + 1) * 64, tid = F.tid, lane = F.lane, hd = F.wave;
    const size_t tq = (size_t)b * SEQ + pos;
    LAS float* sc = (LAS float*)F.lds; LAS unsigned char* sel = (LAS unsigned char*)(sc + 2048); LAS float* lgt = (LAS float*)(sel + 2048); LAS float* red = lgt + 8 * 2048; LAS float* misc = red + 16;
    const bf16_t* IQ = (const bf16_t*)(F.outb + OUT_IQ); const bf16_t* IK = (const bf16_t*)(F.outb + OUT_IK); const float* IW = (const float*)(F.outb + OUT_IW);
    const bf16_t* Q = (const bf16_t*)(F.ws + WS_Q); const bf16_t* KV = (const bf16_t*)(F.outb + OUT_KV); const bf16_t* OA = (const bf16_t*)(F.outb + OUT_OA); const u64* MASK = (const u64*)(F.outb + OUT_MASK);
    __syncthreads();
    for (int k = tid; k < nadm; k += NTHR) { float s = 0.f;
        for (int hh = 0; hh < 8; ++hh) { float d = 0.f; for (int c = 0; c < 64; ++c) d += bflo((unsigned)IQ[tq * 512 + hh * 64 + c]) * bflo((unsigned)IK[((size_t)b * SEQ + k) * 64 + c]); s += fmaxf(d, 0.f) * IW[tq * 8 + hh]; }
        sc[k] = s + 0.0f; }
    __syncthreads();
    float nbad = 0.f;
    for (int k = tid; k < nadm; k += NTHR) { const float s = sc[k]; int rank = 0; for (int j = 0; j < nadm; ++j) { const float t = sc[j]; rank += (t > s || (t == s && j < k)) ? 1 : 0; }
        const unsigned char se = rank < 256 ? 1 : 0; sel[k] = se; const unsigned mb = (unsigned)((MASK[tq * 32 + (k >> 6)] >> (k & 63)) & 1ull); if (mb != se) nbad += 1.f; }
    __syncthreads();
    const float nbad_t = block_sum(F, nbad, red);
    LAS float* lw = lgt + hd * 2048; float mx = -INFINITY;
    for (int k = lane; k < nadm; k += 64) { float l = -INFINITY;
        if (sel[k]) { float d = 0.f; for (int c = 0; c < 128; ++c) d += bflo((unsigned)Q[tq * 1024 + hd * 128 + c]) * bflo((unsigned)KV[((size_t)b * SEQ + k) * 128 + c]);
            const int rel = k - pos, n = rel < 0 ? -rel : rel; const float nf = (float)(n > 1 ? n : 1); int large = 8 + (int)(logf(nf / 8.0f) / 2.7725887f * 8.0f); if (large > 15) large = 15;
            const int bucket = (rel > 0 ? 16 : 0) + (n < 8 ? n : large);
            l = d * 0.088388347648318440f + F.a->in[8][bucket * 8 + hd]; }
        lw[k] = l; mx = fmaxf(mx, l); }
#pragma unroll
    for (int o = 1; o < 64; o <<= 1) mx = fmaxf(mx, __shfl_xor(mx, o));
    float den = 0.f;
    for (int k = lane; k < nadm; k += 64) { const float pp = expf(lw[k] - mx); lw[k] = pp; den += pp; }
    den = wave_sum(den);
    float emax = 0.f, ssq = 0.f;
    for (int c2 = 0; c2 < 2; ++c2) { const int c = lane + 64 * c2; float o = 0.f; for (int k = 0; k < nadm; ++k) { const float pp = lw[k]; if (pp != 0.f) o += pp * bflo((unsigned)KV[((size_t)b * SEQ + k) * 128 + c]); }
        o /= den; const float of = bflo((unsigned)OA[tq * 1024 + hd * 128 + c]); emax = fmaxf(emax, fabsf(o - of)); ssq += o * o; }
    const float rms = sqrtf(block_sum(F, ssq, red) * (1.f / 1024.f)) + 1e-20f;
    float err = block_max(F, emax, red) / rms;
    (void)misc;
    if (nbad_t > 0.f) err = 10.f + nbad_t;
    dbg_report(F, err);
}
__device__ __forceinline__ void dbg_emit(Frame& F) {
    float* out = (float*)F.outb;
    for (size_t i = (size_t)F.bid * NTHR + F.tid; i < (size_t)NTOK * D / 4; i += (size_t)F.G * NTHR) ((f32x4*)out)[i] = (f32x4){0.f, 0.f, 0.f, 0.f};
    __syncthreads();
    if (F.bid == 0 && F.tid == 0) { const float e = __uint_as_float(__hip_atomic_load((unsigned*)(F.ws + WS_CTL) + CW_DBG, __ATOMIC_RELAXED, __HIP_MEMORY_SCOPE_AGENT));
        float code = (log10f(fmaxf(e, 1e-30f)) + 4.f) * 0.5f; code = fminf(fmaxf(rintf(code * 20.f) * 0.05f, 0.05f), 3.0f);
        out[0] = sqrtf(67108864.f * 1.01f * (powf(10.f, code) - 1.f)); }
}

constexpr int NPHASE = 17;
__global__ void __launch_bounds__(NTHR, 2) fwd(Args args) {
    extern __shared__ __attribute__((aligned(16))) unsigned char lds_raw[];
    Frame F;
    F.lds = (LAS unsigned char*)lds_raw;
    F.tid = threadIdx.x; F.lane = F.tid & 63; F.wave = __builtin_amdgcn_readfirstlane(F.tid >> 6); F.G = gridDim.x; F.bid = blockIdx.x;
    F.a = &args;
    F.ws = args.ws; F.outb = (unsigned char*)args.out;
    volatile LAS unsigned* MISCW = (volatile LAS unsigned*)(F.lds + LDS_MISC);
    if (F.tid < 64) MISCW[F.tid] = 0u;
    __syncthreads();
    XcdBarrier bar; bar.bar = (unsigned*)(F.ws + WS_CTL) + CW_BAR; bar.x = 0; bar.st = nullptr;
#if MK_ONE
    bar = xcd_barrier_post((unsigned*)(F.ws + WS_CTL) + CW_BAR, MISCW + 8);
#define GRID_BAR() xcd_barrier(bar)
#else
#define GRID_BAR() do { } while (0)
#endif
    const int lo = args.ph_lo, hi = args.ph_hi;
#ifndef PHM
#define PHM (0xFFFFFFFFu & ~(DBG_NO_ATTN ? 0x30u : 0u) & ~(DBG_NO_SSD ? 0xC0u : 0u))
#endif
#define IN(k) (((PHM >> (k)) & 1u) && lo <= (k) && (k) < hi)
#define SEAM(k) do { if ((k) + 1 < hi) GRID_BAR(); } while (0)

    if (IN(0)) { ph_prologue(F); SEAM(0); }
    if (IN(1)) { ph_ln1(F); SEAM(1); }
    if (IN(2)) {
        SchedPlain S; S.o.init(NTOK, NPROJ, F.G, F.bid); S.A = (const char*)(F.outb + OUT_U); S.Bt = (const char*)(F.ws + WS_WIN);
        EpiProj E{(bf16_t*)(F.ws + WS_Q), (bf16_t*)(F.outb + OUT_IQ), (bf16_t*)(F.ws + WS_Z), (bf16_t*)(F.ws + WS_XBC), (bf16_t*)(F.ws + WS_GA), (bf16_t*)(F.ws + WS_GB), (float*)(F.outb + OUT_MISC)};
        pg8::gemm_phase<EpiProj, SchedPlain, false>(F.lds, S, E);
        SEAM(2);
    }
    if (IN(3)) { ph_misc(F); SEAM(3); }
    if (IN(4)) { ph_index(F); SEAM(4); }
    if (IN(5)) { ph_attn(F); SEAM(5); if (DBG_CHECK == 3) { dbg_check_attn(F); GRID_BAR(); } }
    if (IN(6)) { ph_ssd(F); SEAM(6); if (DBG_CHECK == 2) { dbg_check_ssd(F); GRID_BAR(); } }
    if (IN(7)) { ph_gnorm(F); SEAM(7); }
    if (IN(8)) {
        SchedPlain S; S.o.init(NTOK, 1024, F.G, F.bid); S.A = (const char*)(F.outb + OUT_OA); S.Bt = (const char*)(F.ws + WS_WPA);
        EpiGate<0> E{(const bf16_t*)(F.ws + WS_GA), nullptr, (bf16_t*)(F.ws + WS_Z)};
        pg8::gemm_phase<EpiGate<0>, SchedPlain, false>(F.lds, S, E);
        SEAM(8);
    }
    if (IN(9)) {
        SchedPlain S; S.o.init(NTOK, 1024, F.G, F.bid); S.A = (const char*)(F.ws + WS_Q); S.Bt = (const char*)(F.ws + WS_WPB);
        EpiGate<1> E{(const bf16_t*)(F.ws + WS_GB), (const bf16_t*)(F.ws + WS_Z), (bf16_t*)(F.ws + WS_XBC)};
        pg8::gemm_phase<EpiGate<1>, SchedPlain, false>(F.lds, S, E);
        SEAM(9);
    }
    if (IN(10)) {
        SchedPlain S; S.o.init(NTOK, 1024, F.G, F.bid); S.A = (const char*)(F.ws + WS_XBC); S.Bt = (const char*)(F.ws + WS_WOUT);
        EpiOut E{F.a->in[0], (const float*)(F.ws + WS_MOD), (float*)F.outb};
        pg8::gemm_phase<EpiOut, SchedPlain, false>(F.lds, S, E);
        SEAM(10);
    }
    if (IN(11)) { ph_router(F); SEAM(11); }
#pragma unroll
    for (int hf = 0; hf < 2; ++hf) {
        const int p0 = 12 + hf * 2;
        if (IN(p0)) {
            if (hf == 1) ph_final(F, 0);
            MoeTab T = moe_tables(F, hf);
            SchedMoe<8, true> S{T, F.G, F.bid, hf, (const char*)(F.ws + WS_U2), (const char*)(F.ws + WS_W1), (const u32x2*)(F.ws + WS_REG)};
            EpiMoe1 E{F.a->in[23], (bf16_t*)(F.ws + WS_ACT)};
            pg8::gemm_phase<EpiMoe1, SchedMoe<8, true>, true>(F.lds, S, E);
            SEAM(p0);
        }
        if (IN(p0 + 1)) {
            MoeTab T = moe_tables(F, hf);
            SchedMoe<4, false> S{T, F.G, F.bid, hf, (const char*)(F.ws + WS_ACT), (const char*)(F.ws + WS_W2), (const u32x2*)(F.ws + WS_REG)};
            EpiMoe2 E{F.a->in[25], (bf16_t*)(F.ws + WS_YB), (const u32x2*)(F.ws + WS_REG), T, hf};
            pg8::gemm_phase<EpiMoe2, SchedMoe<4, false>, false>(F.lds, S, E);
            SEAM(p0 + 1);
            if (DBG_CHECK == 1 && hf == 1) { dbg_check_moe(F); GRID_BAR(); }
        }
    }
    if (IN(16)) { ph_final(F, 1); }
    if (DBG_CHECK) { GRID_BAR(); dbg_emit(F); }
#undef IN
#undef SEAM
}

extern "C" void kernel_launch(void* const* d_in, const int* in_sizes, int n_in, void* d_out, int out_size, void* d_ws, size_t ws_size, hipStream_t stream) {
    static int grid = 0;
    if (grid == 0) {
        if (n_in != 28 || in_sizes[0] != NTOK * D || out_size != NTOK * D || ws_size < WS_END) { fprintf(stderr, "kernel_launch: shape mismatch (n_in %d, in0 %d, out %d, ws %zu)\n", n_in, n_in > 0 ? in_sizes[0] : -1, out_size, ws_size); grid = -1; return; }
        int dev = 0, cus = 0, per_cu = 0;
        if (hipGetDevice(&dev) != hipSuccess || hipDeviceGetAttribute(&cus, hipDeviceAttributeMultiprocessorCount, dev) != hipSuccess) { grid = -1; return; }
        if (hipFuncSetAttribute((const void*)fwd, hipFuncAttributeMaxDynamicSharedMemorySize, LDS_BYTES) != hipSuccess) { fprintf(stderr, "kernel_launch: hipFuncSetAttribute failed\n"); grid = -1; return; }
        if (hipOccupancyMaxActiveBlocksPerMultiprocessor(&per_cu, (const void*)fwd, NTHR, LDS_BYTES) != hipSuccess || per_cu < 1) fprintf(stderr, "kernel_launch: occupancy query reports %d\n", per_cu);
        (void)hipGetLastError();
        grid = cus;
    }
    if (grid < 0) return;
    if (hipMemsetAsync((char*)d_ws + WS_CTL, 0, CTL_ZERO_BYTES, stream) != hipSuccess) { fprintf(stderr, "kernel_launch: memset failed\n"); return; }
    Args a{};
    for (int i = 0; i < 28; ++i) a.in[i] = (const float*)d_in[i];
    a.out = (float*)d_out; a.ws = (unsigned char*)d_ws;
    const int nph = NPHASE < MK_PH_HI ? NPHASE : MK_PH_HI;
#if MK_ONE
    a.ph_lo = 0; a.ph_hi = nph;
    hipLaunchKernelGGL(fwd, dim3(grid), dim3(NTHR), LDS_BYTES, stream, a);
#else
    for (int p = 0; p < nph; ++p) { a.ph_lo = p; a.ph_hi = p + 1; hipLaunchKernelGGL(fwd, dim3(grid), dim3(NTHR), LDS_BYTES, stream, a); }
#endif
    const hipError_t le = hipPeekAtLastError();
    if (le != hipSuccess) fprintf(stderr, "kernel_launch: launch failed: %s\n", hipGetErrorName(le));
}
```

```cpp
#include <hip/hip_runtime.h>
#include <cstdio>
#include <cstdint>

#ifndef MK_ONE
#define MK_ONE 1
#endif
#ifndef DBG_NO_ATTN
#define DBG_NO_ATTN 0
#endif
#ifndef DBG_ATTN_ZERO
#define DBG_ATTN_ZERO 0
#endif
#ifndef DBG_IQ_TRUNC
#define DBG_IQ_TRUNC 0
#endif
#ifndef DBG_ROUTER_BF16
#define DBG_ROUTER_BF16 0
#endif
#ifndef DBG_CHECK
#define DBG_CHECK 0
#endif
#ifndef DBG_SKIP_BODY
#define DBG_SKIP_BODY 0
#endif
#ifndef DBG_SUB
#define DBG_SUB 0
#endif
#ifndef DBG_SSD_SYNC
#define DBG_SSD_SYNC 0
#endif
#ifndef DBG_HYP
#define DBG_HYP 0
#endif
#ifndef DBG_TWICE
#define DBG_TWICE 0u
#endif
#ifndef DBG_NO_SSD
#define DBG_NO_SSD 0
#endif
#ifndef DBG_NO_MOE
#define DBG_NO_MOE 0
#endif
#ifndef MK_PH_HI
#define MK_PH_HI 99
#endif

#define LAS __attribute__((address_space(3)))
#define GAS __attribute__((address_space(1)))
typedef unsigned short bf16_t;
typedef short bf16x8 __attribute__((ext_vector_type(8)));
typedef short s16x4 __attribute__((ext_vector_type(4)));
typedef float f32x2 __attribute__((ext_vector_type(2)));
typedef float f32x4 __attribute__((ext_vector_type(4)));
typedef float f32x16 __attribute__((ext_vector_type(16)));
typedef unsigned u32x2 __attribute__((ext_vector_type(2)));
typedef unsigned u32x4 __attribute__((ext_vector_type(4)));
typedef unsigned long long u64;

constexpr int NB = 32, SEQ = 2048, D = 1024, NTOK = NB * SEQ;
constexpr int NWAVES = 8, NTHR = 512;
constexpr int NPROJ = 6912;
constexpr int NEXP = 32, HALF_TOK = NTOK / 2, REG_CAP = HALF_TOK;
constexpr int ACT_ROWS = HALF_TOK * 4 + NEXP * 256;
constexpr float LN_EPS = 1e-5f;
constexpr float DN_ALPHA = 1.189207115002721f;
constexpr float LOG2E = 1.4426950408889634f;

constexpr size_t MiB = 1u << 20;
constexpr size_t WS_CTL = 0, CTL_ZERO_BYTES = 1 * MiB;
constexpr size_t WS_MOD = 1 * MiB;
constexpr size_t WS_BIAST = 1 * MiB + 800 * 1024;
constexpr size_t WS_WIN = 2 * MiB;
constexpr size_t WS_WPA = 16 * MiB, WS_WPB = 18 * MiB, WS_WOUT = 20 * MiB;
constexpr size_t WS_W1 = 24 * MiB;
constexpr size_t WS_W2 = 152 * MiB;
constexpr size_t WS_Q = 216 * MiB;
constexpr size_t WS_Z = 344 * MiB;
constexpr size_t WS_XBC = 472 * MiB;
constexpr size_t WS_GA = 728 * MiB, WS_GB = 856 * MiB;
constexpr size_t WS_U2 = 216 * MiB;
constexpr size_t WS_REG = 344 * MiB;
constexpr size_t WS_ACT = 360 * MiB;
constexpr size_t WS_YB = 632 * MiB;
constexpr size_t WS_END = 888 * MiB;
constexpr size_t WS_DBG = 888 * MiB;
constexpr size_t OUT_U = 0, OUT_MISC = 128 * MiB, OUT_IQ = 192 * MiB;
constexpr size_t OUT_KV = 0, OUT_IK = 16 * MiB, OUT_IW = 24 * MiB, OUT_DT = 26 * MiB, OUT_MASK = 32 * MiB, OUT_OA = 64 * MiB;
constexpr int CW_BAR = 4096, CW_CNT = 16384, CW_DBG = 24576;

constexpr int LDS_BYTES = 160 * 1024;
constexpr int LDS_AUX = 131072;
constexpr int LDS_MISC = LDS_BYTES - 256;

#define LDS_WAIT() asm volatile("s_waitcnt lgkmcnt(0)" ::: "memory")
#define VM_WAIT() asm volatile("s_waitcnt vmcnt(0)" ::: "memory")
#define SBAR() __builtin_amdgcn_sched_barrier(0)
typedef __bf16 bf16x2_t __attribute__((ext_vector_type(2)));
__device__ __forceinline__ unsigned cvt_pk_bf16(float lo, float hi) { f32x2 f = {lo, hi}; bf16x2_t v = __builtin_convertvector(f, bf16x2_t); return __builtin_bit_cast(unsigned, v); }
__device__ __forceinline__ float bflo(unsigned w) { return __uint_as_float(w << 16); }
__device__ __forceinline__ float bfhi(unsigned w) { return __uint_as_float(w & 0xffff0000u); }
__device__ __forceinline__ u32x4 pack8(f32x4 a, f32x4 b) { u32x4 w; w.x = cvt_pk_bf16(a[0], a[1]); w.y = cvt_pk_bf16(a[2], a[3]); w.z = cvt_pk_bf16(b[0], b[1]); w.w = cvt_pk_bf16(b[2], b[3]); return w; }
__device__ __forceinline__ void unpack8(u32x4 w, f32x4& a, f32x4& b) { a[0] = bflo(w.x); a[1] = bfhi(w.x); a[2] = bflo(w.y); a[3] = bfhi(w.y); b[0] = bflo(w.z); b[1] = bfhi(w.z); b[2] = bflo(w.w); b[3] = bfhi(w.w); }
__device__ __forceinline__ float wave_sum(float v) {
#pragma unroll
    for (int o = 1; o < 64; o <<= 1) v += __shfl_xor(v, o);
    return v;
}
__device__ __forceinline__ float fast_rcp(float x) { return __builtin_amdgcn_rcpf(x); }
__device__ __forceinline__ float sigmoid_f(float x) { return fast_rcp(1.0f + __expf(-x)); }
__device__ __forceinline__ float silu_f(float x) { return x * sigmoid_f(x); }

#define XB_TMO      128
#define XB_XCNT(j)  (256  + 64 * (j))
#define XB_XSUB(j)  (1280 + 64 * (j))
#define XB_XGEN(j)  (2304 + 64 * (j))
#define XB_TOP      3328
#define XB_TOPGEN   3392
#define XCD_BAR_WORDS 3456
#define XB_SPIN_CAP (1u << 18)
__device__ __forceinline__ unsigned xb_ld(unsigned* p)              { return __hip_atomic_load(p, __ATOMIC_RELAXED, __HIP_MEMORY_SCOPE_AGENT); }
__device__ __forceinline__ unsigned xb_add(unsigned* p, unsigned v) { return __hip_atomic_fetch_add(p, v, __ATOMIC_RELAXED, __HIP_MEMORY_SCOPE_AGENT); }
__device__ __forceinline__ unsigned xb_xcc_id() { return (unsigned)__builtin_amdgcn_s_getreg((3 << 11) | 20) & 0xFu; }
#define XB_SPIN(cond, bar) do { unsigned _sp = 0; while (cond) { __builtin_amdgcn_s_sleep(1); \
    if ((++_sp & 255u) == 0u) { if (xb_ld(&(bar)[XB_TMO])) break; if (_sp > XB_SPIN_CAP) { atomicAdd(&(bar)[XB_TMO], 1u); break; } } } } while (0)
struct XcdBarrier { unsigned* bar; unsigned x; volatile LAS unsigned* st; };
__device__ __forceinline__ XcdBarrier xcd_barrier_post(unsigned* bar, volatile LAS unsigned* st) {
    XcdBarrier b; b.bar = bar; b.x = xb_xcc_id(); b.st = st;
    if (threadIdx.x == 0) (void)xb_add(&bar[XB_XCNT(b.x)], 1u);
    return b;
}
__device__ __forceinline__ void xcd_barrier_complete(unsigned* bar, unsigned x, unsigned& nloc, unsigned& nx) {
    const unsigned G = gridDim.x * gridDim.y * gridDim.z;
    unsigned sum, cnt, mine, sp = 0u;
    for (;;) {
        sum = 0u; cnt = 0u;
#pragma nounroll
        for (unsigned j = 0; j < 16; ++j) { const unsigned c = xb_ld(&bar[XB_XCNT(j)]); sum += c; cnt += (c > 0u) ? 1u : 0u; }
        if (sum == G) break;
        __builtin_amdgcn_s_sleep(1);
        if ((++sp & 255u) == 0u) { if (xb_ld(&bar[XB_TMO])) break; if (sp > XB_SPIN_CAP) { atomicAdd(&bar[XB_TMO], 1u); break; } }
    }
    mine = xb_ld(&bar[XB_XCNT(x)]);
    nloc = mine > 0u ? mine : 1u; nx = cnt > 0u ? cnt : 1u;
}
__device__ __forceinline__ void xcd_barrier(const XcdBarrier& b) {
    asm volatile("s_waitcnt vmcnt(0)" ::: "memory");
    __syncthreads();
    if (threadIdx.x == 0) {
        unsigned* bar = b.bar;
        __builtin_amdgcn_s_waitcnt(0);
        unsigned nloc = b.st[0], nx = b.st[1];
        if (nloc == 0u) { xcd_barrier_complete(bar, b.x, nloc, nx); b.st[0] = nloc; b.st[1] = nx; }
        const unsigned old = xb_add(&bar[XB_XSUB(b.x)], 1u);
        const unsigned gen = old / nloc;
        if (old + 1u == (gen + 1u) * nloc) {
            __builtin_amdgcn_fence(__ATOMIC_RELEASE, "agent");
            asm volatile("s_waitcnt vmcnt(0)" ::: "memory");
            const unsigned og = xb_add(&bar[XB_TOP], 1u);
            const unsigned tg = og / nx;
            if (og + 1u == (tg + 1u) * nx) xb_add(&bar[XB_TOPGEN], 1u);
            else XB_SPIN(xb_ld(&bar[XB_TOPGEN]) == tg, bar);
            __builtin_amdgcn_fence(__ATOMIC_ACQUIRE, "agent");
            xb_add(&bar[XB_XGEN(b.x)], 1u);
            asm volatile("s_waitcnt vmcnt(0)" ::: "memory");
        } else {
            XB_SPIN(xb_ld(&bar[XB_XGEN(b.x)]) == gen, bar);
            __builtin_amdgcn_fence(__ATOMIC_ACQUIRE, "agent");
            asm volatile("s_waitcnt vmcnt(0)" ::: "memory");
        }
    }
    __syncthreads();
}

namespace pg8 {
constexpr int BM = 256, BK = 64, HALF = 128, HTB = HALF * BK * 2, STAGE_BYTES = 8 * HTB, NXCD = 8, WGM = 8, KD = 1024;
__host__ __device__ __forceinline__ int lds_byte(int r, int c) { const int st = (r >> 4) * 2 + (c >> 5), rr = r & 15, cc = c & 31, ob = rr * 64 + cc * 2; return st * 1024 + (ob ^ (((ob >> 9) & 1) << 5)); }
__host__ __device__ __forceinline__ void stage_rc(int b, int& R, int& C) { const int st = b / 1024, sb = b % 1024, swz = sb ^ (((sb >> 9) & 1) << 5); R = (st >> 1) * 16 + swz / 64; C = (st & 1) * 32 + (swz % 64) / 2; }
__host__ __device__ __forceinline__ int perm32(int rho) { const int n = rho >> 4, i = rho & 15; return 8 * (i >> 2) + 4 * n + (i & 3); }
struct Unit { int pm, pn, ex; };
struct StaticOrder {
    int nM, nN, nwg, G, c;
    __device__ void init(int M, int N, int G_, int c_) { nM = M / BM; nN = N / BM; nwg = nM * nN; G = G_; c = c_; }
    __device__ bool next(int i, Unit& u) const {
        const long L = (long)i * G + c; if (L >= nwg) return false;
        int wgid = (int)L; { const int q = nwg / NXCD, r = nwg % NXCD, xcd = wgid % NXCD, off = wgid / NXCD; wgid = (xcd < r ? xcd * (q + 1) : r * (q + 1) + (xcd - r) * q) + off; }
        const int nig = WGM * nN, gid = wgid / nig, fm = gid * WGM, gsz = (nM - fm) < WGM ? (nM - fm) : WGM;
        u.pm = fm + ((wgid % nig) % gsz); u.pn = (wgid % nig) / gsz; u.ex = 0; return true;
    }
};
template <class Epi, class Sched, bool GATHER>
__device__ __forceinline__ void gemm_phase(LAS unsigned char* lds, const Sched& S, const Epi& E) {
    int tid = threadIdx.x; asm volatile("" : "+v"(tid));
    const int wid = __builtin_amdgcn_readfirstlane(tid >> 6), lane = tid & 63, wr = wid >> 2, wc = wid & 3, fr = lane & 15, fq = lane >> 4;
    constexpr int K = KD, nt = K / BK;
    unsigned voffA[2], voffB[2]; int Rr[2], Cc[2];
#pragma unroll
    for (int i = 0; i < 2; ++i) { int R, C; stage_rc(tid * 16 + i * 8192, R, C); const int Rb = Epi::PERM ? ((R & ~31) + perm32(R & 31)) : R;
        voffA[i] = (unsigned)(R * K + C) * 2u; voffB[i] = (unsigned)(Rb * K + C) * 2u; Rr[i] = R; Cc[i] = C; }
    constexpr size_t kstep = (size_t)(BK * 2);
    constexpr size_t hstep = (size_t)HALF * K * 2;
    const unsigned ldsw = (unsigned)wid * 1024u;
    const int aoff = lds_byte(wr * 64 + fr, fq * 8), boff = lds_byte(wc * 32 + fr, fq * 8);
#define PG8_SA(b, h) (((b) * 2 + (h)) * HTB)
#define PG8_SB(b, h) ((4 + (b) * 2 + (h)) * HTB)
#define PG8_STAGE(bufoff, gbase, voff) do { _Pragma("unroll") for (int _i = 0; _i < 2; ++_i) \
        __builtin_amdgcn_global_load_lds((const unsigned*)((const char*)(gbase) + (voff)[_i]), (LAS unsigned*)(lds + (bufoff) + ldsw + _i * 8192), 16, 0, 0); } while (0)
#define PG8_STAGE_A(bufoff, gb, h, o0, o1) do { if constexpr (GATHER) { const unsigned _ko = (unsigned)((gb) - gA0); unsigned _o[2]; \
            if ((h) == 0) { _o[0] = (o0)[0] + _ko; _o[1] = (o0)[1] + _ko; } else { _o[0] = (o1)[0] + _ko; _o[1] = (o1)[1] + _ko; } PG8_STAGE(bufoff, gA0, _o); } \
        else { PG8_STAGE(bufoff, (gb) + (h) * hstep, voffA); } } while (0)
#define PG8_LDA(dst, b, h) do { _Pragma("unroll") for (int m = 0; m < 4; ++m) _Pragma("unroll") for (int k = 0; k < 2; ++k) dst[m][k] = *(const LAS bf16x8*)(lds + PG8_SA(b, h) + aoff + m * 2048 + k * 1024); } while (0)
#define PG8_LDB(dst, b, h) do { _Pragma("unroll") for (int n = 0; n < 2; ++n) _Pragma("unroll") for (int k = 0; k < 2; ++k) dst[n][k] = *(const LAS bf16x8*)(lds + PG8_SB(b, h) + boff + n * 2048 + k * 1024); } while (0)
#define PG8_MMA(ai, bj, At, Bt) do { __builtin_amdgcn_s_setprio(1); _Pragma("unroll") for (int m = 0; m < 4; ++m) _Pragma("unroll") for (int n = 0; n < 2; ++n) _Pragma("unroll") for (int k = 0; k < 2; ++k) \
        acc[ai][bj][m][n] = __builtin_amdgcn_mfma_f32_16x16x32_bf16(Bt[n][k], At[m][k], acc[ai][bj][m][n], 0, 0, 0); __builtin_amdgcn_s_setprio(0); } while (0)
#define PG8_WAIT_V(n) asm volatile("s_waitcnt vmcnt(" #n ")" ::: "memory")
#define PG8_WAIT_L(n) asm volatile("s_waitcnt lgkmcnt(" #n ")" ::: "memory")
#define PG8_BAR __builtin_amdgcn_s_barrier()
#define PG8_SCHED __builtin_amdgcn_sched_barrier(0)
    Unit cur, nxt; int ui = 0;
    if (!S.next(0, cur)) return;
    f32x4 acc[2][2][4][2];
#pragma unroll
    for (int a = 0; a < 2; ++a)
#pragma unroll
        for (int b = 0; b < 2; ++b)
#pragma unroll
            for (int m = 0; m < 4; ++m)
#pragma unroll
                for (int n = 0; n < 2; ++n) acc[a][b][m][n] = (f32x4){0.f, 0.f, 0.f, 0.f};
    bf16x8 At[4][2], B0[2][2], B1[2][2];
    const char* cA = S.a_base(cur); const char* cB = S.b_base(cur);
    const char* const gA0 = cA;
    unsigned cv0[2] = {0u, 0u}, cv1[2] = {0u, 0u}, nv0[2] = {0u, 0u}, nv1[2] = {0u, 0u};
    if constexpr (GATHER) S.a_offs(cur, Rr, Cc, cv0, cv1);
    PG8_STAGE(PG8_SB(0, 0), cB, voffB); PG8_STAGE_A(PG8_SA(0, 0), cA, 0, cv0, cv1); PG8_STAGE(PG8_SB(0, 1), cB + hstep, voffB); PG8_STAGE_A(PG8_SA(0, 1), cA, 1, cv0, cv1);
    if (wr == 1) PG8_BAR;
    PG8_WAIT_V(4); PG8_BAR;
    PG8_STAGE(PG8_SB(1, 0), cB + kstep, voffB); PG8_STAGE_A(PG8_SA(1, 0), cA + kstep, 0, cv0, cv1); PG8_STAGE(PG8_SB(1, 1), cB + hstep + kstep, voffB);
    PG8_WAIT_V(6); PG8_BAR;
    for (;;) {
        const bool has_next = S.next(ui + 1, nxt);
        const char* nA = has_next ? S.a_base(nxt) : cA; const char* nB = has_next ? S.b_base(nxt) : cB;
        if constexpr (GATHER) { if (has_next) S.a_offs(nxt, Rr, Cc, nv0, nv1); else { nv0[0] = cv0[0]; nv0[1] = cv0[1]; nv1[0] = cv1[0]; nv1[1] = cv1[1]; } }
        for (int t = 0; t < nt; t += 2) {
            const bool last = (t == nt - 2);
            const char* a1 = cA + (size_t)(t + 1) * kstep;
            const char* a2 = last ? nA : cA + (size_t)(t + 2) * kstep; const char* b2 = last ? nB : cB + (size_t)(t + 2) * kstep;
            const char* a3 = a2 + kstep; const char* b3 = b2 + kstep;
            unsigned s0[2], s1[2];
            if constexpr (GATHER) { s0[0] = last ? nv0[0] : cv0[0]; s0[1] = last ? nv0[1] : cv0[1]; s1[0] = last ? nv1[0] : cv1[0]; s1[1] = last ? nv1[1] : cv1[1]; } else { s0[0] = s0[1] = s1[0] = s1[1] = 0u; }
            PG8_LDB(B0, 0, 0); PG8_SCHED; PG8_LDA(At, 0, 0); PG8_STAGE_A(PG8_SA(1, 1), a1, 1, cv0, cv1);
            PG8_WAIT_L(8); PG8_BAR; PG8_WAIT_L(0); PG8_MMA(0, 0, At, B0); PG8_BAR; PG8_SCHED;
            PG8_LDB(B1, 0, 1); PG8_STAGE(PG8_SB(0, 0), b2, voffB);
            PG8_BAR; PG8_WAIT_L(0); PG8_MMA(0, 1, At, B1); PG8_BAR;
            PG8_LDA(At, 0, 1); PG8_STAGE_A(PG8_SA(0, 0), a2, 0, s0, s1);
            PG8_BAR; PG8_WAIT_L(0); PG8_MMA(1, 0, At, B0); PG8_BAR; PG8_SCHED;
            PG8_STAGE(PG8_SB(0, 1), b2 + hstep, voffB);
            PG8_WAIT_V(6); PG8_BAR; PG8_MMA(1, 1, At, B1); PG8_BAR;
            PG8_LDB(B0, 1, 0); PG8_SCHED; PG8_LDA(At, 1, 0); PG8_STAGE_A(PG8_SA(0, 1), a2, 1, s0, s1);
            PG8_WAIT_L(8); PG8_BAR; PG8_WAIT_L(0); PG8_MMA(0, 0, At, B0); PG8_BAR; PG8_SCHED;
            PG8_LDB(B1, 1, 1); PG8_STAGE(PG8_SB(1, 0), b3, voffB);
            PG8_BAR; PG8_WAIT_L(0); PG8_MMA(0, 1, At, B1); PG8_BAR;
            PG8_LDA(At, 1, 1); PG8_STAGE_A(PG8_SA(1, 0), a3, 0, s0, s1);
            PG8_BAR; PG8_WAIT_L(0); PG8_MMA(1, 0, At, B0); PG8_BAR; PG8_SCHED;
            PG8_STAGE(PG8_SB(1, 1), b3 + hstep, voffB);
            PG8_WAIT_V(6); PG8_BAR; PG8_MMA(1, 1, At, B1); PG8_BAR;
        }
        E(acc, cur, wr, wc, fr, fq);
        if (!has_next) break;
#pragma unroll
        for (int a = 0; a < 2; ++a)
#pragma unroll
            for (int b = 0; b < 2; ++b)
#pragma unroll
                for (int m = 0; m < 4; ++m)
#pragma unroll
                    for (int n = 0; n < 2; ++n) acc[a][b][m][n] = (f32x4){0.f, 0.f, 0.f, 0.f};
        cur = nxt; cA = nA; cB = nB; ++ui;
        if constexpr (GATHER) { cv0[0] = nv0[0]; cv0[1] = nv0[1]; cv1[0] = nv1[0]; cv1[1] = nv1[1]; }
    }
    PG8_WAIT_V(0);
    if (wr == 0) PG8_BAR;
    PG8_BAR;
#undef PG8_SA
#undef PG8_SB
#undef PG8_STAGE
#undef PG8_STAGE_A
#undef PG8_LDA
#undef PG8_LDB
#undef PG8_MMA
#undef PG8_WAIT_V
#undef PG8_WAIT_L
#undef PG8_BAR
#undef PG8_SCHED
}
}
using pg8::Unit;
typedef f32x4 AccT[2][2][4][2];

struct Args { const float* in[28]; float* out; unsigned char* ws; int ph_lo, ph_hi, pad0, pad1; };
struct Frame {
    LAS unsigned char* lds;
    int tid, lane, wave, G, bid;
    const struct Args* a;
    unsigned char* ws; unsigned char* outb;
};
struct SchedPlain {
    pg8::StaticOrder o; const char* A; const char* Bt;
    __device__ __forceinline__ bool next(int i, Unit& u) const { return o.next(i, u); }
    __device__ __forceinline__ const char* a_base(const Unit& u) const { return A + (size_t)u.pm * (256 * 2048); }
    __device__ __forceinline__ const char* b_base(const Unit& u) const { return Bt + (size_t)u.pn * (256 * 2048); }
    __device__ __forceinline__ void a_offs(const Unit&, const int*, const int*, unsigned (&)[2], unsigned (&)[2]) const {}
};

struct EpiProj {
    static constexpr bool PERM = true;
    bf16_t *Q, *IQ, *Z, *XBC, *GA, *GB; float* MISC;
    __device__ __forceinline__ void operator()(const AccT& acc, const Unit& u, int wr, int wc, int fr, int fq) const {
        const int pn = u.pn, row0 = u.pm * 256 + wr * 64 + fr, c8 = wc * 32 + 8 * fq;
        if (pn == 6) {
#pragma unroll
            for (int ai = 0; ai < 2; ++ai)
#pragma unroll
                for (int m = 0; m < 4; ++m) { float* rp = MISC + (size_t)(row0 + ai * 128 + m * 16) * 256 + c8;
#pragma unroll
                    for (int bj = 0; bj < 2; ++bj) { *(f32x4*)(rp + bj * 128) = acc[ai][bj][m][0]; *(f32x4*)(rp + bj * 128 + 4) = acc[ai][bj][m][1]; } }
            return;
        }
        bf16_t* base; int ldc, colt, act = 0;
        if (pn < 4) { base = Q; ldc = 1024; colt = pn * 256; }
        else if (pn < 6) { base = IQ; ldc = 512; colt = (pn - 4) * 256; }
        else if (pn < 11) { base = Z; ldc = 1024; colt = (pn - 7) * 256; act = 1; }
        else if (pn < 19) { base = XBC; ldc = 2048; colt = (pn - 11) * 256; }
        else if (pn < 23) { base = GA; ldc = 1024; colt = (pn - 19) * 256; act = 2; }
        else { base = GB; ldc = 1024; colt = (pn - 23) * 256; act = 2; }
#pragma unroll
        for (int ai = 0; ai < 2; ++ai)
#pragma unroll
            for (int m = 0; m < 4; ++m) { bf16_t* rp = base + (size_t)(row0 + ai * 128 + m * 16) * ldc + colt + c8;
#pragma unroll
                for (int bj = 0; bj < 2; ++bj) { f32x4 v0 = acc[ai][bj][m][0], v1 = acc[ai][bj][m][1];
                    if (act == 1) {
#pragma unroll
                        for (int j = 0; j < 4; ++j) { v0[j] = silu_f(v0[j]); v1[j] = silu_f(v1[j]); } }
                    if (act == 2) {
#pragma unroll
                        for (int j = 0; j < 4; ++j) { v0[j] = sigmoid_f(v0[j]); v1[j] = sigmoid_f(v1[j]); } }
                    u32x4 pk = pack8(v0, v1); if (DBG_IQ_TRUNC && (pn == 4 || pn == 5)) { pk.x &= 0xfff8fff8u; pk.y &= 0xfff8fff8u; pk.z &= 0xfff8fff8u; pk.w &= 0xfff8fff8u; }
                    *(u32x4*)(rp + bj * 128) = pk; } }
    }
};
template <int MODE> struct EpiGate {
    static constexpr bool PERM = true;
    const bf16_t* Gt; const bf16_t* T; bf16_t* O;
    __device__ __forceinline__ void operator()(const AccT& acc, const Unit& u, int wr, int wc, int fr, int fq) const {
        const int row0 = u.pm * 256 + wr * 64 + fr, c8 = u.pn * 256 + wc * 32 + 8 * fq;
#pragma unroll
        for (int ai = 0; ai < 2; ++ai)
#pragma unroll
            for (int m = 0; m < 4; ++m) { const size_t off = (size_t)(row0 + ai * 128 + m * 16) * 1024 + c8;
#pragma unroll
                for (int bj = 0; bj < 2; ++bj) { f32x4 g0, g1; unpack8(*(const u32x4*)(Gt + off + bj * 128), g0, g1);
                    f32x4 v0 = g0 * acc[ai][bj][m][0], v1 = g1 * acc[ai][bj][m][1];
                    if ((MODE == 0 && DBG_NO_ATTN) || (MODE == 1 && DBG_NO_SSD)) { v0 = (f32x4){0.f, 0.f, 0.f, 0.f}; v1 = v0; }
                    if (MODE == 1) { f32x4 t0, t1; unpack8(*(const u32x4*)(T + off + bj * 128), t0, t1); v0 += t0; v1 += t1; }
                    *(u32x4*)(O + off + bj * 128) = pack8(v0, v1); } }
    }
};
struct EpiOut {
    static constexpr bool PERM = false;
    const float* x; const float* mod; float* V;
    __device__ __forceinline__ void operator()(const AccT& acc, const Unit& u, int wr, int wc, int fr, int fq) const {
        const int row0 = u.pm * 256 + wr * 64 + fr, col0 = u.pn * 256 + wc * 32 + 4 * fq;
        const float* g1 = mod + (size_t)(u.pm >> 3) * 6144 + 2048 + col0;
        f32x4 gv[2][2];
#pragma unroll
        for (int bj = 0; bj < 2; ++bj)
#pragma unroll
            for (int n = 0; n < 2; ++n) gv[bj][n] = *(const f32x4*)(g1 + bj * 128 + n * 16);
#pragma unroll
        for (int ai = 0; ai < 2; ++ai)
#pragma unroll
            for (int m = 0; m < 4; ++m) { const size_t off = (size_t)(row0 + ai * 128 + m * 16) * 1024 + col0;
#pragma unroll
                for (int bj = 0; bj < 2; ++bj)
#pragma unroll
                    for (int n = 0; n < 2; ++n) { const f32x4 xv = *(const f32x4*)(x + off + bj * 128 + n * 16);
                        *(f32x4*)(V + off + bj * 128 + n * 16) = xv * DN_ALPHA + gv[bj][n] * acc[ai][bj][m][n]; } }
    }
};

struct MoeTab { LAS unsigned* cnt; LAS unsigned* tb; LAS unsigned char* te; int ntiles; };
__device__ __forceinline__ MoeTab moe_tables(Frame& F, int hf) {
    MoeTab T; T.cnt = (LAS unsigned*)(F.lds + LDS_AUX); T.tb = (LAS unsigned*)(F.lds + LDS_AUX + 256); T.te = (LAS unsigned char*)(F.lds + LDS_AUX + 512);
    const unsigned* CNT = (const unsigned*)(F.ws + WS_CTL) + CW_CNT;
    __syncthreads();
    if (F.tid < 32) { unsigned c = __hip_atomic_load(CNT + 64 * (hf * 32 + F.tid), __ATOMIC_RELAXED, __HIP_MEMORY_SCOPE_AGENT); if (c > (unsigned)REG_CAP) c = REG_CAP; T.cnt[F.tid] = c; }
    __syncthreads();
    if (F.tid == 0) { unsigned s = 0;
#pragma nounroll
        for (int e = 0; e < 32; ++e) { T.tb[e] = s; const unsigned n = (T.cnt[e] + 255u) >> 8;
#pragma nounroll
            for (unsigned t = 0; t < n; ++t) T.te[s + t] = (unsigned char)e;
            s += n; }
        T.tb[32] = s; }
    __syncthreads();
    T.ntiles = __builtin_amdgcn_readfirstlane((int)T.tb[32]);
    return T;
}
template <int NJ, bool GATHER> struct SchedMoe {
    MoeTab T; int G, c, hf; const char* A; const char* Bt; const u32x2* REG;
    __device__ __forceinline__ bool next(int i, Unit& u) const {
        const int L = i * G + c; if (L >= T.ntiles * NJ) return false;
        u.pm = L / NJ; u.pn = L % NJ; u.ex = __builtin_amdgcn_readfirstlane((int)T.te[u.pm]); return true;
    }
    __device__ __forceinline__ const char* a_base(const Unit& u) const { return GATHER ? A : A + (size_t)u.pm * (256 * 2048); }
    __device__ __forceinline__ const char* b_base(const Unit& u) const { return Bt + ((size_t)u.ex * (NJ * 256) + (size_t)u.pn * 256) * 2048; }
    __device__ __forceinline__ void a_offs(const Unit& u, const int* R, const int* C, unsigned (&o0)[2], unsigned (&o1)[2]) const {
        const unsigned cnt = __builtin_amdgcn_readfirstlane(T.cnt[u.ex]), pos0 = ((unsigned)u.pm - (unsigned)__builtin_amdgcn_readfirstlane(T.tb[u.ex])) * 256u; const u32x2* rg = REG + ((size_t)hf * 32 + u.ex) * REG_CAP;
#pragma unroll
        for (int i = 0; i < 2; ++i) {
            const unsigned p0 = pos0 + (unsigned)R[i], p1 = p0 + 128u;
            unsigned t0 = 0u, t1 = 0u;
            if (p0 < cnt) t0 = (unsigned)hf * HALF_TOK + (rg[p0].x >> 2);
            if (p1 < cnt) t1 = (unsigned)hf * HALF_TOK + (rg[p1].x >> 2);
            o0[i] = t0 * 2048u + (unsigned)C[i] * 2u; o1[i] = t1 * 2048u + (unsigned)C[i] * 2u;
        }
    }
};
struct EpiMoe1 {
    static constexpr bool PERM = true;
    const float* b1; bf16_t* ACT;
    __device__ __forceinline__ void operator()(const AccT& acc, const Unit& u, int wr, int wc, int fr, int fq) const {
        const int row0 = u.pm * 256 + wr * 64 + fr, c8 = u.pn * 128 + wc * 32 + 8 * fq;
        const float* bg = b1 + (size_t)u.ex * 2048 + c8;
        const f32x4 bg0 = *(const f32x4*)bg, bg1 = *(const f32x4*)(bg + 4), bu0 = *(const f32x4*)(bg + 1024), bu1 = *(const f32x4*)(bg + 1028);
#pragma unroll
        for (int ai = 0; ai < 2; ++ai)
#pragma unroll
            for (int m = 0; m < 4; ++m) {
                f32x4 g0 = acc[ai][0][m][0] + bg0, g1 = acc[ai][0][m][1] + bg1, u0 = acc[ai][1][m][0] + bu0, u1 = acc[ai][1][m][1] + bu1, a0, a1;
#pragma unroll
                for (int j = 0; j < 4; ++j) {
                    float g = fminf(g0[j], 7.0f), up = fminf(fmaxf(u0[j], -7.0f), 7.0f); a0[j] = (up + 1.0f) * g * sigmoid_f(1.702f * g);
                    g = fminf(g1[j], 7.0f); up = fminf(fmaxf(u1[j], -7.0f), 7.0f); a1[j] = (up + 1.0f) * g * sigmoid_f(1.702f * g); }
                *(u32x4*)(ACT + (size_t)(row0 + ai * 128 + m * 16) * 1024 + c8) = pack8(a0, a1); }
    }
};
struct EpiMoe2 {
    static constexpr bool PERM = true;
    const float* b2; bf16_t* YB; const u32x2* REG; MoeTab T; int hf;
    __device__ __forceinline__ void operator()(const AccT& acc, const Unit& u, int wr, int wc, int fr, int fq) const {
        const int c8 = u.pn * 256 + wc * 32 + 8 * fq;
        const unsigned cnt = __builtin_amdgcn_readfirstlane(T.cnt[u.ex]), pos0 = ((unsigned)u.pm - (unsigned)__builtin_amdgcn_readfirstlane(T.tb[u.ex])) * 256u + (unsigned)(wr * 64 + fr); const u32x2* rg = REG + ((size_t)hf * 32 + u.ex) * REG_CAP;
        const float* bb = b2 + (size_t)u.ex * 1024 + c8;
        f32x4 bv[2][2];
#pragma unroll
        for (int bj = 0; bj < 2; ++bj) { bv[bj][0] = *(const f32x4*)(bb + bj * 128); bv[bj][1] = *(const f32x4*)(bb + bj * 128 + 4); }
#pragma unroll
        for (int ai = 0; ai < 2; ++ai)
#pragma unroll
            for (int m = 0; m < 4; ++m) { const unsigned p = pos0 + (unsigned)(ai * 128 + m * 16);
                if (p < cnt) { const u32x2 en = rg[p]; const float g = __uint_as_float(en.y); bf16_t* rp = YB + (size_t)en.x * 1024 + c8;
#pragma unroll
                    for (int bj = 0; bj < 2; ++bj) *(u32x4*)(rp + bj * 128) = pack8((acc[ai][bj][m][0] + bv[bj][0]) * g, (acc[ai][bj][m][1] + bv[bj][1]) * g); } }
    }
};

struct MapIdent { __device__ __forceinline__ int operator()(int n) const { return n; } };
struct MapWin { __device__ __forceinline__ int operator()(int n) const {
    if (n < 1024) return n;
    if (n < 1536) return 1152 + (n - 1024);
    if (n < 1792) { const int c = n - 1536; if (c < 128) return 1024 + c; if (c < 192) return 1664 + (c - 128); if (c < 200) return 1728 + (c - 192); if (c < 216) return 4808 + (c - 200); return -1; }
    if (n < 2816) return 1736 + (n - 1792);
    if (n < 4864) return 2760 + (n - 2816);
    if (n < 5888) return 4824 + (n - 4864);
    return 5848 + (n - 5888); } };
struct MapW1 { __device__ __forceinline__ int operator()(int r) const { const int j = r >> 8, rr = r & 255; return (rr >> 7) * 1024 + j * 128 + (rr & 127); } };
template <class Map> __device__ __forceinline__ void transpose_item(const float* W, int K, int N, bf16_t* WT, const Map& map, LAS float* scr, int kb, int nb, int lane, const float* rowscale) {
    const int k0 = 64 * kb, n0 = 32 * nb; const int src = map(n0 + (lane & 31));
#pragma unroll 8
    for (int i = 0; i < 32; ++i) { const int kk = 2 * i + (lane >> 5); float v = 0.f; if (src >= 0) v = W[(size_t)(k0 + kk) * N + src]; if (rowscale) v *= rowscale[k0 + kk]; scr[kk * 33 + (lane & 31)] = v; }
    LDS_WAIT(); asm volatile("" ::: "memory");
    const int c = lane & 7;
#pragma unroll
    for (int j = 0; j < 4; ++j) { const int n = (lane >> 3) + 8 * j; const LAS float* s = scr + (8 * c) * 33 + n;
        u32x4 o; o.x = cvt_pk_bf16(s[0 * 33], s[1 * 33]); o.y = cvt_pk_bf16(s[2 * 33], s[3 * 33]); o.z = cvt_pk_bf16(s[4 * 33], s[5 * 33]); o.w = cvt_pk_bf16(s[6 * 33], s[7 * 33]);
        *(u32x4*)(WT + (size_t)(n0 + n) * K + k0 + 8 * c) = o; }
    LDS_WAIT(); asm volatile("" ::: "memory");
}
__device__ __forceinline__ void ph_prologue(Frame& F) {
    const float* c_in = F.a->in[1]; const float* w_mod = F.a->in[2]; const float* b_mod = F.a->in[3];
    float* MOD = (float*)(F.ws + WS_MOD);
    for (int item = F.bid; item < 48; item += F.G) {
        LAS float* SC = (LAS float*)F.lds;
        __syncthreads();
        for (int i = F.tid; i < 32768; i += NTHR) { const int b = i >> 10, k = i & 1023; SC[k * 32 + b] = silu_f(c_in[i]); }
        __syncthreads();
        const int col = item * 128 + (F.tid >> 2), kq = F.tid & 3;
        float a[32];
#pragma unroll
        for (int b = 0; b < 32; ++b) a[b] = 0.f;
        for (int kk = 0; kk < 256; ++kk) { const int k = kq * 256 + kk; const float w = w_mod[(size_t)k * 6144 + col];
#pragma unroll
            for (int b4 = 0; b4 < 8; ++b4) { const f32x4 s = *(const LAS f32x4*)(SC + k * 32 + b4 * 4); a[b4 * 4 + 0] += w * s[0]; a[b4 * 4 + 1] += w * s[1]; a[b4 * 4 + 2] += w * s[2]; a[b4 * 4 + 3] += w * s[3]; } }
#pragma unroll
        for (int b = 0; b < 32; ++b) { a[b] += __shfl_xor(a[b], 1); a[b] += __shfl_xor(a[b], 2); }
        if (kq == 0) { const float bm = b_mod[col];
#pragma unroll
            for (int b = 0; b < 32; ++b) MOD[(size_t)b * 6144 + col] = a[b] + bm; }
        __syncthreads();
    }
    if (F.bid == (F.G > 48 ? 48 : 0)) {
        float* BT = (float*)(F.ws + WS_BIAST); const float* rel_bias = F.a->in[8];
        for (int i = F.tid; i < 249 * 8; i += NTHR) { const int idx = i >> 3, h = i & 7, rel = idx - 185; const int n = rel < 0 ? -rel : rel;
            const float nf = (float)(n > 1 ? n : 1); int large = 8 + (int)(logf(nf / 8.0f) / 2.7725887f * 8.0f); if (large > 15) large = 15;
            const int bucket = (rel > 0 ? 16 : 0) + (n < 8 ? n : large);
            BT[i] = rel_bias[bucket * 8 + h] * LOG2E; }
    }
    LAS float* scr = (LAS float*)(F.lds + F.wave * 16384);
    __syncthreads();
    const int gw = F.bid * NWAVES + F.wave, NGW = F.G * NWAVES;
    constexpr int I_WIN = 16 * (NPROJ / 32), I_SQ = 16 * 32, I_W1E = 16 * 64, I_W2E = 16 * 32;
    constexpr int NITEMS = I_WIN + 3 * I_SQ + 32 * I_W1E + 32 * I_W2E;
    for (int it = gw; it < NITEMS; it += NGW) {
        int r = it;
        if (r < I_WIN) { transpose_item(F.a->in[4], 1024, 6872, (bf16_t*)(F.ws + WS_WIN), MapWin(), scr, r / (NPROJ / 32), r % (NPROJ / 32), F.lane, nullptr); continue; } r -= I_WIN;
        if (r < I_SQ) { transpose_item(F.a->in[15], 1024, 1024, (bf16_t*)(F.ws + WS_WPA), MapIdent(), scr, r / 32, r % 32, F.lane, nullptr); continue; } r -= I_SQ;
        if (r < I_SQ) { transpose_item(F.a->in[16], 1024, 1024, (bf16_t*)(F.ws + WS_WPB), MapIdent(), scr, r / 32, r % 32, F.lane, F.a->in[14]); continue; } r -= I_SQ;
        if (r < I_SQ) { transpose_item(F.a->in[17], 1024, 1024, (bf16_t*)(F.ws + WS_WOUT), MapIdent(), scr, r / 32, r % 32, F.lane, nullptr); continue; } r -= I_SQ;
        if (r < 32 * I_W1E) { const int e = r / I_W1E, q = r % I_W1E; transpose_item(F.a->in[22] + (size_t)e * 1024 * 2048, 1024, 2048, (bf16_t*)(F.ws + WS_W1) + (size_t)e * 2048 * 1024, MapW1(), scr, q / 64, q % 64, F.lane, nullptr); continue; } r -= 32 * I_W1E;
        { const int e = r / I_W2E, q = r % I_W2E; transpose_item(F.a->in[24] + (size_t)e * 1024 * 1024, 1024, 1024, (bf16_t*)(F.ws + WS_W2) + (size_t)e * 1024 * 1024, MapIdent(), scr, q / 32, q % 32, F.lane, nullptr); }
    }
}

__device__ __forceinline__ void ph_ln1(Frame& F) {
    const float* x = F.a->in[0]; const float* MOD = (const float*)(F.ws + WS_MOD); bf16_t* U = (bf16_t*)(F.outb + OUT_U);
    const int gw = F.bid * NWAVES + F.wave, NGW = F.G * NWAVES;
    for (int m = gw; m < NTOK; m += NGW) {
        const f32x4* xr = (const f32x4*)(x + (size_t)m * D) + F.lane; const float* md = MOD + (size_t)(m >> 11) * 6144;
        f32x4 v[4]; float s = 0.f;
#pragma unroll
        for (int j = 0; j < 4; ++j) { v[j] = xr[64 * j]; s += (v[j][0] + v[j][1]) + (v[j][2] + v[j][3]); }
        const float mean = wave_sum(s) * (1.f / D); float s2 = 0.f;
#pragma unroll
        for (int j = 0; j < 4; ++j) { v[j] = v[j] - mean; s2 += (v[j][0] * v[j][0] + v[j][1] * v[j][1]) + (v[j][2] * v[j][2] + v[j][3] * v[j][3]); }
        const float rstd = 1.f / sqrtf(wave_sum(s2) * (1.f / D) + LN_EPS);
        u32x2* o8 = (u32x2*)(U + (size_t)m * D) + F.lane;
#pragma unroll
        for (int j = 0; j < 4; ++j) { const f32x4 sh = *((const f32x4*)md + F.lane + 64 * j), sc = *((const f32x4*)(md + 1024) + F.lane + 64 * j);
            const f32x4 r = v[j] * rstd * (sc + 1.0f) + sh; u32x2 w; w.x = cvt_pk_bf16(r[0], r[1]); w.y = cvt_pk_bf16(r[2], r[3]); o8[64 * j] = w; }
    }
}

__device__ __forceinline__ void ph_misc(Frame& F) {
    const float* MISC = (const float*)(F.outb + OUT_MISC);
    bf16_t* KV = (bf16_t*)(F.outb + OUT_KV); bf16_t* IK = (bf16_t*)(F.outb + OUT_IK); float* IW = (float*)(F.outb + OUT_IW); float* DT = (float*)(F.outb + OUT_DT);
    const float* kvw = F.a->in[5]; const float* ikw = F.a->in[6]; const float* ikb = F.a->in[7]; const float* dtb = F.a->in[11];
    const int gw = F.bid * NWAVES + F.wave, NGW = F.G * NWAVES, l = F.lane;
    for (int m = gw; m < NTOK; m += NGW) {
        const f32x4 v = *((const f32x4*)(MISC + (size_t)m * 256) + l);
        const float sq = v[0] * v[0] + v[1] * v[1] + v[2] * v[2] + v[3] * v[3], sm = (v[0] + v[1]) + (v[2] + v[3]);
        const float kvss = wave_sum(l < 32 ? sq : 0.f);
        const float iks = wave_sum((l >= 32 && l < 48) ? sm : 0.f);
        const float ikmean = iks * (1.f / 64.f);
        const f32x4 dv = v - ikmean;
        const float ikq = wave_sum((l >= 32 && l < 48) ? (dv[0] * dv[0] + dv[1] * dv[1] + dv[2] * dv[2] + dv[3] * dv[3]) : 0.f);
        if (l < 32) { const float r = 1.f / sqrtf(kvss * (1.f / 128.f) + LN_EPS); const f32x4 w = *((const f32x4*)kvw + l); const f32x4 o = v * r * w;
            u32x2 pk; pk.x = cvt_pk_bf16(o[0], o[1]); pk.y = cvt_pk_bf16(o[2], o[3]); *((u32x2*)(KV + (size_t)m * 128) + l) = pk; }
        else if (l < 48) { const float r = 1.f / sqrtf(ikq * (1.f / 64.f) + LN_EPS); const f32x4 w = *((const f32x4*)ikw + (l - 32)), bb = *((const f32x4*)ikb + (l - 32)); const f32x4 o = dv * r * w + bb;
            u32x2 pk; pk.x = cvt_pk_bf16(o[0], o[1]); pk.y = cvt_pk_bf16(o[2], o[3]); *((u32x2*)(IK + (size_t)m * 64) + (l - 32)) = pk; }
        else if (l < 50) { *((f32x4*)(IW + (size_t)m * 8) + (l - 48)) = v * 0.35355339059327373f; }
        else if (l < 54) { const f32x4 bb = *((const f32x4*)dtb + (l - 50)); f32x4 o;
#pragma unroll
            for (int j = 0; j < 4; ++j) { const float t = v[j] + bb[j]; o[j] = t > 20.f ? t : log1pf(__expf(t)); }
            *((f32x4*)(DT + (size_t)m * 16) + (l - 50)) = o; }
    }
}

__device__ __forceinline__ unsigned sortable_key(float s) { const unsigned u = __float_as_uint(s + 0.0f); return (u & 0x80000000u) ? ~u : (u | 0x80000000u); }
template <int NKB> struct KeyRow { unsigned k[NKB]; };
__device__ __forceinline__ u64 low_bits_keep(u64 m, int t) { u64 out = 0; while (t-- > 0 && m) { const u64 b = m & (0 - m); out |= b; m ^= b; } return out; }
namespace idx { constexpr int KST = 144, KBUF = 64 * KST; }
__device__ __forceinline__ unsigned low_bits_keep32(unsigned m, int t) { unsigned out = 0; while (t-- > 0 && m) { const unsigned b = m & (0u - m); out |= b; m ^= b; } return out; }
template <int NG> __device__ __forceinline__ void topk2_select_write(const unsigned (&key)[64], int nkb, u64* mrow, int lane) {
    constexpr int NR = NG * 16;
    unsigned T0 = 0u, T1 = 0u; bool ex0 = false, ex1 = false;
#pragma nounroll
    for (int bit = 31; bit >= 0; --bit) {
        const unsigned c0 = ex0 ? T0 : (T0 | (1u << bit)), c1 = ex1 ? T1 : (T1 | (1u << bit)); const unsigned candv = lane < 32 ? c0 : c1;
        unsigned cl = 0u;
#pragma unroll
        for (int m = 0; m < NR; ++m) cl += (key[m] >= candv) ? 1u : 0u;
        cl += __shfl_xor(cl, 1); cl += __shfl_xor(cl, 2); cl += __shfl_xor(cl, 4); cl += __shfl_xor(cl, 8); cl += __shfl_xor(cl, 16);
        const int n0 = __builtin_amdgcn_readlane((int)cl, 0), n1 = __builtin_amdgcn_readlane((int)cl, 32);
        if (!ex0) { if (n0 >= 256) T0 = c0; if (n0 == 256) ex0 = true; }
        if (!ex1) { if (n1 >= 256) T1 = c1; if (n1 == 256) ex1 = true; }
        if (ex0 && ex1) break;
    }
    const unsigned Tv = lane < 32 ? T0 : T1;
    if (ex0 && ex1) {
        unsigned mlo = 0u, mhi = 0u;
#pragma unroll
        for (int j = 0; j < NR / 2; ++j) {
            const u64 b0 = __ballot(key[2 * j] >= Tv), b1 = __ballot(key[2 * j + 1] >= Tv);
            mlo = (lane == j) ? (unsigned)b0 : mlo; mhi = (lane == j) ? (unsigned)b1 : mhi;
            mlo = (lane == 32 + j) ? (unsigned)(b0 >> 32) : mlo; mhi = (lane == 32 + j) ? (unsigned)(b1 >> 32) : mhi;
            if ((j & 3) == 3) SBAR();
        }
        const int jl = lane & 31;
        if (jl < nkb) mrow[(lane >> 5) * 32 + jl] = (u64)mlo | ((u64)mhi << 32);
        return;
    }
    int rem0 = 1 << 30, rem1 = 1 << 30;
    { int g0 = 0, g1 = 0;
#pragma unroll
        for (int m = 0; m < NR; ++m) { const u64 mk = __ballot(key[m] > Tv); g0 += __builtin_popcount((unsigned)mk); g1 += __builtin_popcount((unsigned)(mk >> 32)); if ((m & 7) == 7) SBAR(); }
        if (!ex0) rem0 = 256 - g0; if (!ex1) rem1 = 256 - g1; }
    u64 mine = 0ull;
#pragma nounroll
    for (int jq = 0; jq < NR / 8; ++jq) {
#pragma unroll
        for (int jj = 0; jj < 4; ++jj) { const int j = jq * 4 + jj;
            unsigned w0[2], w1[2];
#pragma unroll
            for (int hh = 0; hh < 2; ++hh) { unsigned kv = 0u;
#pragma unroll
                for (int m = 0; m < NR; ++m) if ((m >> 3) == 0) {}
#pragma unroll
                for (int m = 0; m < NR; ++m) kv = (m == 2 * j + hh) ? key[m] : kv;
                const u64 gt = __ballot(kv > Tv), eq = __ballot(kv == Tv);
                { const unsigned e = (unsigned)eq, g = (unsigned)gt; const int ne = __builtin_popcount(e); unsigned sel = g; if (rem0 >= ne) { sel |= e; rem0 -= ne; } else if (rem0 > 0) { sel |= low_bits_keep32(e, rem0); rem0 = 0; } w0[hh] = sel; }
                { const unsigned e = (unsigned)(eq >> 32), g = (unsigned)(gt >> 32); const int ne = __builtin_popcount(e); unsigned sel = g; if (rem1 >= ne) { sel |= e; rem1 -= ne; } else if (rem1 > 0) { sel |= low_bits_keep32(e, rem1); rem1 = 0; } w1[hh] = sel; } }
            const u64 q0w = (u64)w0[0] | ((u64)w0[1] << 32), q1w = (u64)w1[0] | ((u64)w1[1] << 32);
            if (lane == j) mine = q0w; if (lane == 32 + j) mine = q1w; }
    }
    const int jl = lane & 31;
    if (jl < nkb) mrow[(lane >> 5) * 32 + jl] = mine;
}
template <int J0> __device__ __forceinline__ void index_scores8(unsigned (&key)[64], const bf16x8 (&af)[2], const f32x4& iw4, const bf16_t* kvsrc, char* lds, int nkb, u32x4 (&stg)[8], int tid) {
    const int lane = tid & 63, sub = lane & 15, kg = lane >> 4;
#pragma unroll
    for (int jj = 0; jj < 8; ++jj) {
        const int j = J0 + jj;
        if (j < nkb) {
            if (j + 1 < nkb) *(u32x4*)(lds + ((j + 1) & 1) * idx::KBUF + (tid >> 3) * idx::KST + (tid & 7) * 16) = stg[(jj + 1) & 7];
            if (j + 8 < nkb) stg[jj] = *(const u32x4*)(kvsrc + (size_t)(j + 8) * 64 * 64);
            const char* kb = lds + (j & 1) * idx::KBUF + sub * idx::KST + kg * 16;
#pragma unroll
            for (int pr = 0; pr < 2; ++pr) {
                f32x4 dA = (f32x4){0.f, 0.f, 0.f, 0.f}, dB = dA;
#pragma unroll
                for (int ks = 0; ks < 2; ++ks) {
                    const bf16x8 fA = *(const bf16x8*)(kb + (pr * 32) * idx::KST + ks * 64), fB = *(const bf16x8*)(kb + (pr * 32 + 16) * idx::KST + ks * 64);
                    dA = __builtin_amdgcn_mfma_f32_16x16x32_bf16(af[ks], fA, dA, 0, 0, 0); dB = __builtin_amdgcn_mfma_f32_16x16x32_bf16(af[ks], fB, dB, 0, 0, 0); }
                float pA = 0.f, pB = 0.f;
#pragma unroll
                for (int r = 0; r < 4; ++r) { pA += fmaxf(dA[r], 0.f) * iw4[r]; pB += fmaxf(dB[r], 0.f) * iw4[r]; }
                auto rr = __builtin_amdgcn_permlane16_swap(__float_as_uint(pA), __float_as_uint(pB), false, false);
                key[2 * j + pr] = sortable_key(__uint_as_float(rr[0]) + __uint_as_float(rr[1]));
            }
            __syncthreads();
        }
    }
}
__device__ __forceinline__ void ph_index(Frame& F) {
    const bf16_t* IQ = (const bf16_t*)(F.outb + OUT_IQ); const bf16_t* IK = (const bf16_t*)(F.outb + OUT_IK); const float* IW = (const float*)(F.outb + OUT_IW);
    u64* MASK = (u64*)(F.outb + OUT_MASK);
    char* lds = (char*)(unsigned char*)F.lds;
    const int tid = F.tid, lane = F.lane, sub = lane & 15, kg = lane >> 4;
    for (int item = F.bid; item < NTOK / 16; item += F.G) {
        const int tokw = (((item & 255) >> 3) << 11) + (((item & 7) + 8 * (item >> 8)) << 4) + F.wave * 2, b = tokw >> 11, pos0 = tokw & 2047, nkb = (pos0 >> 6) + 1;
        u64* mrow = MASK + (size_t)tokw * 32;
        if (nkb <= 4) { if ((lane & 31) < nkb) mrow[(lane >> 5) * 32 + (lane & 31)] = ~0ull; continue; }
        bf16x8 af[2];
        { const bf16_t* ap = IQ + (size_t)(tokw + (sub >> 3)) * 512 + (sub & 7) * 64 + kg * 8;
#pragma unroll
          for (int ks = 0; ks < 2; ++ks) af[ks] = *(const bf16x8*)(ap + ks * 32); }
        const f32x4 iw4 = *(const f32x4*)(IW + (size_t)(tokw + (lane >> 5)) * 8 + 4 * (kg & 1));
        unsigned key[64];
#pragma unroll
        for (int m = 0; m < 64; ++m) key[m] = 0u;
        const bf16_t* kvsrc = IK + ((size_t)b * SEQ + (tid >> 3)) * 64 + (tid & 7) * 8;
        u32x4 stg[8];
#pragma unroll
        for (int i = 0; i < 8; ++i) stg[i] = (i < nkb) ? *(const u32x4*)(kvsrc + (size_t)i * 64 * 64) : (u32x4){0u, 0u, 0u, 0u};
        __syncthreads();
        *(u32x4*)(lds + (tid >> 3) * idx::KST + (tid & 7) * 16) = stg[0];
        __syncthreads();
        const int ng = (nkb + 7) >> 3;
        index_scores8<0>(key, af, iw4, kvsrc, lds, nkb, stg, tid);
        if (ng > 1) index_scores8<8>(key, af, iw4, kvsrc, lds, nkb, stg, tid);
        if (ng > 2) index_scores8<16>(key, af, iw4, kvsrc, lds, nkb, stg, tid);
        if (ng > 3) index_scores8<24>(key, af, iw4, kvsrc, lds, nkb, stg, tid);
        if (ng == 1) topk2_select_write<1>(key, nkb, mrow, lane);
        else if (ng == 2) topk2_select_write<2>(key, nkb, mrow, lane);
        else if (ng == 3) topk2_select_write<3>(key, nkb, mrow, lane);
        else topk2_select_write<4>(key, nkb, mrow, lane);
    }
}

namespace att {
constexpr int KVBLK = 64;
constexpr int SHM_V = KVBLK * 128 * 2, SHM_K = SHM_V;
constexpr int OFF_V = 0, OFF_K = 2 * SHM_V, OFF_WS = 2 * SHM_V + 2 * SHM_K, OFF_BT = OFF_WS + NWAVES * 64 * 4;
#define KSWZ(row, colB) ((row) * 256 + ((colB) ^ (((row) & 7) << 4)))
__device__ __forceinline__ int crow(int r, int hi) { return (r & 3) + 8 * (r >> 2) + 4 * hi; }
__device__ __forceinline__ int v_st(int k, int c) { const int kk = (k & ~0xC) | ((k & 4) << 1) | ((k & 8) >> 1); return ((kk >> 3) * 4 + (c >> 5)) * 512 + ((kk & 7) * 32 + (c & 31)) * 2; }
__device__ __forceinline__ int v_rd_base(int lane) { return ((lane & 3) << 3) | (((lane >> 2) & 3) << 6) | (((lane >> 4) & 1) << 5) | (((lane >> 5) & 1) << 8); }
constexpr int v_rd_off(int d0, int ks, int half) { return d0 * 512 + ks * 4096 + half * 2048; }
template <int OFF> __device__ __forceinline__ s16x4 tr_read(int vb) { s16x4 r; asm volatile("ds_read_b64_tr_b16 %0, %1 offset:%2" : "=&v"(r) : "v"(vb), "i"(OFF) : "memory"); return r; }
template <int D0> __device__ __forceinline__ void pv_one(f32x16& od, int vb, bf16x8 pa0, bf16x8 pa1, bf16x8 pa2, bf16x8 pa3) {
    const s16x4 l0 = tr_read<v_rd_off(D0, 0, 0)>(vb), h0 = tr_read<v_rd_off(D0, 0, 1)>(vb), l1 = tr_read<v_rd_off(D0, 1, 0)>(vb), h1 = tr_read<v_rd_off(D0, 1, 1)>(vb);
    const s16x4 l2 = tr_read<v_rd_off(D0, 2, 0)>(vb), h2 = tr_read<v_rd_off(D0, 2, 1)>(vb), l3 = tr_read<v_rd_off(D0, 3, 0)>(vb), h3 = tr_read<v_rd_off(D0, 3, 1)>(vb);
    asm volatile("s_waitcnt lgkmcnt(0)" ::: "memory"); SBAR();
#define PK(L, H) (bf16x8){L[0], L[1], L[2], L[3], H[0], H[1], H[2], H[3]}
    od = __builtin_amdgcn_mfma_f32_32x32x16_bf16(pa0, PK(l0, h0), od, 0, 0, 0);
    od = __builtin_amdgcn_mfma_f32_32x32x16_bf16(pa1, PK(l1, h1), od, 0, 0, 0);
    od = __builtin_amdgcn_mfma_f32_32x32x16_bf16(pa2, PK(l2, h2), od, 0, 0, 0);
    od = __builtin_amdgcn_mfma_f32_32x32x16_bf16(pa3, PK(l3, h3), od, 0, 0, 0);
#undef PK
}
__device__ __forceinline__ void qkt(f32x16& p0, f32x16& p1, const char* Ks, const bf16x8* qr, int r32, int hi) {
    p0 = f32x16{}; p1 = f32x16{};
    int rv = r32; asm volatile("" : "+v"(rv));
    const char* kb = Ks + rv * 256; const int swz = ((rv & 7) << 4) ^ (hi * 16);
#pragma unroll
    for (int d0 = 0; d0 < 8; ++d0) { const char* ka = kb + ((d0 * 32) ^ swz);
        const bf16x8 b0 = *reinterpret_cast<const bf16x8*>(ka);
        const bf16x8 b1 = *reinterpret_cast<const bf16x8*>(ka + 8192);
        p0 = __builtin_amdgcn_mfma_f32_32x32x16_bf16(b0, qr[d0], p0, 0, 0, 0);
        p1 = __builtin_amdgcn_mfma_f32_32x32x16_bf16(b1, qr[d0], p1, 0, 0, 0); }
}
__device__ __forceinline__ void attn_item(Frame& F, int b, int q0, char* lds) {
    const bf16_t* Q = (const bf16_t*)(F.ws + WS_Q); const bf16_t* KV = (const bf16_t*)(F.outb + OUT_KV); const u64* MASK = (const u64*)(F.outb + OUT_MASK);
    bf16_t* OA = (bf16_t*)(F.outb + OUT_OA);
    const int tid = F.tid, wid = F.wave, lane = F.lane, r32 = lane & 31, hi = lane >> 5;
    char* V_lds = lds + OFF_V; char* K_lds = lds + OFF_K;
    float* wsl = (float*)(lds + OFF_WS) + wid * 64; float* li_l = wsl; float* al_l = wsl + 32;
    const float* btab = (const float*)(lds + OFF_BT);
    constexpr float C = 0.088388347648318440f * LOG2E;
    float m_reg = -1e30f, l_reg = 0.f; f32x16 o[4] = {}; bf16x8 qr[8];
    const size_t tokq = (size_t)b * SEQ + q0 + r32;
    { const bf16_t* Qw = Q + tokq * 1024 + wid * 128 + hi * 8;
#pragma unroll
      for (int d0 = 0; d0 < 8; ++d0) qr[d0] = *(const bf16x8*)(Qw + d0 * 16); }
    const u64* mq = MASK + tokq * 32;
    const int sr = tid >> 4, sc = (tid & 15) * 8;
    const int vb0 = (int)(uintptr_t)V_lds + v_rd_base(lane);
    const bf16_t* Kb = KV + (size_t)b * SEQ * 128;
    const int NT = (q0 >> 6) + 1;
    const float bfar = btab[wid];
    bf16x8 s0, s1;
#define SLOAD(k0) do { s0 = *(const bf16x8*)(Kb + (size_t)((k0) + sr) * 128 + sc); s1 = *(const bf16x8*)(Kb + (size_t)((k0) + 32 + sr) * 128 + sc); } while (0)
#define SWRITE(bf) do { int srv = sr; asm volatile("" : "+v"(srv)); const int kc = sc * 2; const int v0a = v_st(srv, sc), k0a = KSWZ(srv, kc); \
        *(bf16x8*)(V_lds + (bf) * SHM_V + v0a) = s0; *(bf16x8*)(V_lds + (bf) * SHM_V + v0a + 8192) = s1; \
        *(bf16x8*)(K_lds + (bf) * SHM_K + k0a) = s0; *(bf16x8*)(K_lds + (bf) * SHM_K + k0a + 8192) = s1; } while (0)
    __syncthreads();
    SLOAD(0); VM_WAIT(); SWRITE(0); __syncthreads();
    for (int j = 0; j < NT; ++j) {
        const int bf = j & 1;
        if (j + 1 < NT) SLOAD((j + 1) * KVBLK);
        const u64 mw = mq[j];
        f32x16 p0, p1;
        qkt(p0, p1, K_lds + bf * SHM_K, qr, r32, hi);
        const unsigned w0 = (unsigned)(mw >> (4 * hi)), w1 = (unsigned)(mw >> (32 + 4 * hi));
        const int relmax = j * KVBLK + 63 - q0;
        if (relmax <= -91) {
#pragma unroll
            for (int r = 0; r < 16; ++r) { const int cb = (r & 3) + 8 * (r >> 2);
                const float t0 = fmaf(p0[r], C, bfar), t1 = fmaf(p1[r], C, bfar); p0[r] = ((w0 >> cb) & 1u) ? t0 : -1e30f; p1[r] = ((w1 >> cb) & 1u) ? t1 : -1e30f; }
        } else {
            const float* bp = btab + (j * KVBLK + 4 * hi - (q0 + r32) + 185) * 8 + wid;
#pragma unroll
            for (int r4 = 0; r4 < 4; ++r4) {
#pragma unroll
                for (int rr = 0; rr < 4; ++rr) { const int r = r4 * 4 + rr; const int cb = (r & 3) + 8 * (r >> 2);
                    const float bv0 = bp[cb * 8], bv1 = bp[(cb + 32) * 8]; const float t0 = fmaf(p0[r], C, bv0), t1 = fmaf(p1[r], C, bv1);
                    p0[r] = ((w0 >> cb) & 1u) ? t0 : -1e30f; p1[r] = ((w1 >> cb) & 1u) ? t1 : -1e30f; }
                SBAR(); }
        }
        float pmax = p0[0];
#pragma unroll
        for (int r = 1; r < 16; ++r) pmax = fmaxf(pmax, p0[r]);
#pragma unroll
        for (int r = 0; r < 16; ++r) pmax = fmaxf(pmax, p1[r]);
        { auto rr = __builtin_amdgcn_permlane32_swap(__float_as_uint(pmax), __float_as_uint(pmax), false, false); pmax = fmaxf(__uint_as_float(rr[0]), __uint_as_float(rr[1])); }
        float alpha = 1.f;
        if (!__all(pmax - m_reg <= 11.0f)) { const float mn = fmaxf(m_reg, pmax); alpha = __builtin_amdgcn_exp2f(m_reg - mn); m_reg = mn; }
        float ps = 0.f;
#pragma unroll
        for (int r = 0; r < 16; ++r) { p0[r] = __builtin_amdgcn_exp2f(p0[r] - m_reg); p1[r] = __builtin_amdgcn_exp2f(p1[r] - m_reg); ps += p0[r] + p1[r]; }
        { auto rr = __builtin_amdgcn_permlane32_swap(__float_as_uint(ps), __float_as_uint(ps), false, false); ps = __uint_as_float(rr[0]) + __uint_as_float(rr[1]); }
        l_reg = l_reg * alpha + ps;
        bf16x8 pa0, pa1, pa2, pa3;
#define PK4(P, BASE, OUT) do { unsigned a0 = cvt_pk_bf16(P[BASE + 0], P[BASE + 1]), a1 = cvt_pk_bf16(P[BASE + 2], P[BASE + 3]);   \
    unsigned b0 = cvt_pk_bf16(P[BASE + 4], P[BASE + 5]), b1 = cvt_pk_bf16(P[BASE + 6], P[BASE + 7]);                              \
    auto r0 = __builtin_amdgcn_permlane32_swap(a0, b0, false, false); auto r1 = __builtin_amdgcn_permlane32_swap(a1, b1, false, false); \
    u32x4 w = {r0[0], r1[0], r0[1], r1[1]}; OUT = *reinterpret_cast<bf16x8*>(&w); } while (0)
        PK4(p0, 0, pa0); PK4(p0, 8, pa1); PK4(p1, 0, pa2); PK4(p1, 8, pa3);
#undef PK4
        if (__any(alpha < 1.f)) { if (hi == 0) al_l[r32] = alpha; LDS_WAIT();
#pragma unroll
            for (int d = 0; d < 4; ++d)
#pragma unroll
                for (int r = 0; r < 16; ++r) o[d][r] *= al_l[crow(r, hi)]; }
        const int vb = vb0 + bf * SHM_V;
        pv_one<0>(o[0], vb, pa0, pa1, pa2, pa3); pv_one<1>(o[1], vb, pa0, pa1, pa2, pa3); pv_one<2>(o[2], vb, pa0, pa1, pa2, pa3); pv_one<3>(o[3], vb, pa0, pa1, pa2, pa3);
        if (j + 1 < NT) { VM_WAIT(); SWRITE(bf ^ 1); }
        __syncthreads();
    }
#undef SLOAD
#undef SWRITE
    if (hi == 0) li_l[r32] = l_reg; LDS_WAIT();
    bf16_t* Ow = OA + ((size_t)b * SEQ + q0 + 4 * hi) * 1024 + wid * 128 + r32;
    const float* lip = li_l + 4 * hi;
    asm volatile("" : "+v"(Ow), "+v"(lip));
#pragma unroll
    for (int r = 0; r < 16; ++r) { const int ro = (r & 3) + 8 * (r >> 2); const float rl = fast_rcp(lip[ro]);
#pragma unroll
        for (int d0 = 0; d0 < 4; ++d0) { float v = o[d0][r] * rl; if ((DBG_ATTN_ZERO == 1 && q0 < 256) || (DBG_ATTN_ZERO == 2 && q0 >= 256)) v = 0.f; Ow[ro * 1024 + d0 * 32] = (bf16_t)(cvt_pk_bf16(v, v) & 0xffffu); }
        if ((r & 3) == 3) SBAR(); }
}
}
__device__ __forceinline__ void ph_attn(Frame& F) {
    char* lds = (char*)(unsigned char*)F.lds;
    { float* bt = (float*)(lds + att::OFF_BT); const float* BT = (const float*)(F.ws + WS_BIAST); __syncthreads(); for (int i = F.tid; i < 249 * 8; i += NTHR) bt[i] = BT[i]; __syncthreads(); }
    for (int pr = F.bid; pr < NB * 32; pr += F.G) {
        const int b = pr >> 5, qb = pr & 31;
#pragma nounroll
        for (int hh = 0; hh < 2; ++hh) att::attn_item(F, b, (hh ? qb : 63 - qb) * 32, lds);
    }
}

namespace ssd {
constexpr int OFF_CS = 0, CS_ST = 272;
constexpr int OFF_BS = OFF_CS + 64 * CS_ST;
constexpr int OFF_BT = OFF_BS + 64 * CS_ST, T_ST = 144;
constexpr int OFF_XT = OFF_BT + 128 * T_ST;
constexpr int OFF_XW = OFF_XT + 64 * T_ST;
constexpr int OFF_XS = OFF_XW + 64 * T_ST;
constexpr int OFF_MT = OFF_XS + 64 * T_ST;
constexpr int OFF_HS = OFF_MT + 64 * T_ST;
constexpr int OFF_END = OFF_HS + 64 * CS_ST;
static_assert(OFF_END + 5 * 320 * 4 <= 131072, "ssd lds");
__device__ __forceinline__ f32x4 mfma16(bf16x8 a, bf16x8 b, f32x4 c) { return __builtin_amdgcn_mfma_f32_16x16x32_bf16(a, b, c, 0, 0, 0); }
__device__ __forceinline__ bf16x8 ldfrag(const char* base, int stride, int row, int k0) { return *(const bf16x8*)(base + row * stride + k0 * 2); }
}
__device__ __forceinline__ void ph_ssd(Frame& F) {
    using namespace ssd;
    char* lds = (char*)(unsigned char*)F.lds;
    const bf16_t* XBC = (const bf16_t*)(F.ws + WS_XBC); const bf16_t* ZS = (const bf16_t*)(F.ws + WS_Z); const float* DT = (const float*)(F.outb + OUT_DT);
    bf16_t* YG = (bf16_t*)(F.ws + WS_Q);
    const float* conv_w = F.a->in[9]; const float* conv_b = F.a->in[10]; const float* a_log = F.a->in[12]; const float* d_skip = F.a->in[13];
    const int tid = F.tid, wid = F.wave, lane = F.lane, fr = lane & 15, fq = lane >> 4;
    const bool stager = tid < 320; const int so = tid % 40, tg = tid / 40;
    for (int item = F.bid; item < NB * 16; item += F.G) {
        const int b = item >> 4, h = item & 15, g = h >> 2;
        const float aneg = -__expf(a_log[h]), dsk = d_skip[h];
        const int ch0 = so < 8 ? h * 64 + so * 8 : (so < 24 ? 1024 + g * 128 + (so - 8) * 8 : 1536 + g * 128 + (so - 24) * 8);
        float* CWL = (float*)(lds + OFF_END);
        __syncthreads();
        if (stager) {
#pragma unroll
            for (int j = 0; j < 4; ++j) { *(f32x4*)(CWL + j * 320 + so * 8) = *(const f32x4*)(conv_w + (size_t)j * 2048 + ch0); *(f32x4*)(CWL + j * 320 + so * 8 + 4) = *(const f32x4*)(conv_w + (size_t)j * 2048 + ch0 + 4); }
            *(f32x4*)(CWL + 4 * 320 + so * 8) = *(const f32x4*)(conv_b + ch0); *(f32x4*)(CWL + 4 * 320 + so * 8 + 4) = *(const f32x4*)(conv_b + ch0 + 4);
        }
        f32x4 hst[4];
#pragma unroll
        for (int t = 0; t < 4; ++t) hst[t] = (f32x4){0.f, 0.f, 0.f, 0.f};
        __syncthreads();
        for (int i = tid; i < 64 * CS_ST / 4; i += NTHR) ((unsigned*)(lds + OFF_HS))[i] = 0u;
        u32x4 raw[11];
        const size_t tokb = (size_t)b * SEQ;
#define SSD_LOAD(c) do { if (stager) { _Pragma("unroll") for (int i = 0; i < 11; ++i) { const int t = (c) * 64 + tg * 8 - 3 + i; \
            raw[i] = (t >= 0) ? *(const u32x4*)(XBC + (tokb + t) * 2048 + ch0) : (u32x4){0u, 0u, 0u, 0u}; } } } while (0)
        SSD_LOAD(0);
        for (int c = 0; c < 32; ++c) {
            const float dtl = DT[(tokb + c * 64 + lane) * 16 + h];
            float acs = dtl * aneg;
#pragma unroll
            for (int o = 1; o < 64; o <<= 1) { const float t = __shfl_up(acs, o); if (lane >= o) acs += t; }
            const float alast = __shfl(acs, 63);
            if (DBG_SSD_SYNC) __syncthreads();
            float dtv[8], dec[8];
#pragma unroll
            for (int t = 0; t < 8; ++t) { dtv[t] = __shfl(dtl, (tg * 8 + t) & 63); dec[t] = __expf(alast - __shfl(acs, (tg * 8 + t) & 63)); }
            if (stager) {
#pragma unroll
                for (int hq = 0; hq < 2; ++hq) {
                    float xin[11][4];
#pragma unroll
                    for (int i = 0; i < 11; ++i) { const unsigned wa = hq ? raw[i].z : raw[i].x, wb = hq ? raw[i].w : raw[i].y; xin[i][0] = bflo(wa); xin[i][1] = bfhi(wa); xin[i][2] = bflo(wb); xin[i][3] = bfhi(wb); }
                    float outv[8][4];
                    { f32x4 cwv[4]; const f32x4 cbq = *(const f32x4*)(CWL + 4 * 320 + so * 8 + hq * 4);
#pragma unroll
                      for (int j = 0; j < 4; ++j) cwv[j] = *(const f32x4*)(CWL + j * 320 + so * 8 + hq * 4);
#pragma unroll
                      for (int t = 0; t < 8; ++t)
#pragma unroll
                        for (int e = 0; e < 4; ++e) { float sacc = cbq[e];
#pragma unroll
                            for (int j = 0; j < 4; ++j) sacc += cwv[j][e] * xin[t + j][e];
                            outv[t][e] = silu_f(sacc); } }
                    if (so < 8) {
#pragma unroll
                        for (int e = 0; e < 4; ++e) { const int p = so * 8 + hq * 4 + e;
                            f32x4 x0, x1, d0, d1, w0, w1;
#pragma unroll
                            for (int t = 0; t < 4; ++t) { x0[t] = outv[t][e]; x1[t] = outv[4 + t][e]; d0[t] = x0[t] * dtv[t]; d1[t] = x1[t] * dtv[4 + t]; w0[t] = d0[t] * dec[t]; w1[t] = d1[t] * dec[4 + t]; }
                            *(u32x4*)(lds + OFF_XS + p * T_ST + tg * 16) = pack8(x0, x1);
                            *(u32x4*)(lds + OFF_XT + p * T_ST + tg * 16) = pack8(d0, d1);
                            *(u32x4*)(lds + OFF_XW + p * T_ST + tg * 16) = pack8(w0, w1); }
                    } else {
                        const bool isB = so < 24; const int n0 = (isB ? (so - 8) : (so - 24)) * 8 + hq * 4;
                        char* nat = lds + (isB ? OFF_BS : OFF_CS);
#pragma unroll
                        for (int t = 0; t < 8; ++t) { u32x2 w; w.x = cvt_pk_bf16(outv[t][0], outv[t][1]); w.y = cvt_pk_bf16(outv[t][2], outv[t][3]);
                            *(u32x2*)(nat + (tg * 8 + t) * CS_ST + n0 * 2) = w; }
                        if (isB) {
#pragma unroll
                            for (int e = 0; e < 4; ++e) { f32x4 a, bq;
#pragma unroll
                                for (int t = 0; t < 4; ++t) { a[t] = outv[t][e]; bq[t] = outv[4 + t][e]; }
                                *(u32x4*)(lds + OFF_BT + (n0 + e) * T_ST + tg * 16) = pack8(a, bq); }
                        }
                    }
                }
            }
            if (c + 1 < 32) SSD_LOAD(c + 1);
            __syncthreads();
#pragma unroll
            for (int t2 = 0; t2 < 2; ++t2) {
                const int tile = 2 * wid + t2, sb = tile >> 2, lb = tile & 3;
                f32x4 d = (f32x4){0.f, 0.f, 0.f, 0.f};
                if (sb <= lb) {
#pragma unroll
                    for (int ks = 0; ks < 4; ++ks) d = mfma16(ldfrag(lds + OFF_BS, CS_ST, sb * 16 + fr, ks * 32 + fq * 8), ldfrag(lds + OFF_CS, CS_ST, lb * 16 + fr, ks * 32 + fq * 8), d);
                    const int l = lb * 16 + fr; const float al = __shfl(acs, l);
                    f32x4 as;
#pragma unroll
                    for (int r = 0; r < 4; ++r) as[r] = __shfl(acs, sb * 16 + 4 * fq + r);
#pragma unroll
                    for (int r = 0; r < 4; ++r) { const int s = sb * 16 + 4 * fq + r; d[r] = (s <= l) ? d[r] * __expf(al - as[r]) : 0.f; }
                }
                u32x2 w; w.x = cvt_pk_bf16(d[0], d[1]); w.y = cvt_pk_bf16(d[2], d[3]);
                *(u32x2*)(lds + OFF_MT + (lb * 16 + fr) * T_ST + (sb * 16 + 4 * fq) * 2) = w;
            }
            if (DBG_SSD_SYNC) __syncthreads();
            f32x4 yacc[2];
#pragma unroll
            for (int t2 = 0; t2 < 2; ++t2) {
                const int tile = 2 * wid + t2, pb = tile >> 2, lb = tile & 3;
                f32x4 d = (f32x4){0.f, 0.f, 0.f, 0.f};
#pragma unroll
                for (int ks = 0; ks < 4; ++ks) d = mfma16(ldfrag(lds + OFF_HS, CS_ST, pb * 16 + fr, ks * 32 + fq * 8), ldfrag(lds + OFF_CS, CS_ST, lb * 16 + fr, ks * 32 + fq * 8), d);
                const float el = __expf(__shfl(acs, lb * 16 + fr));
                yacc[t2] = d * el;
            }
            __syncthreads();
#pragma unroll
            for (int t2 = 0; t2 < 2; ++t2) {
                const int tile = 2 * wid + t2, pb = tile >> 2, lb = tile & 3;
                f32x4 d = yacc[t2];
#pragma unroll
                for (int ks = 0; ks < 2; ++ks) d = mfma16(ldfrag(lds + OFF_XT, T_ST, pb * 16 + fr, ks * 32 + fq * 8), ldfrag(lds + OFF_MT, T_ST, lb * 16 + fr, ks * 32 + fq * 8), d);
                const int l = lb * 16 + fr, p0 = pb * 16 + 4 * fq; const size_t tok = tokb + c * 64 + l;
                const u32x2 zz = *(const u32x2*)(ZS + tok * 1024 + h * 64 + p0);
                const float z0 = bflo(zz.x), z1 = bfhi(zz.x), z2 = bflo(zz.y), z3 = bfhi(zz.y);
                float xs[4];
#pragma unroll
                for (int r = 0; r < 4; ++r) xs[r] = bflo((unsigned)*(const bf16_t*)(lds + OFF_XS + (p0 + r) * T_ST + l * 2));
                u32x2 w; w.x = cvt_pk_bf16((d[0] + xs[0] * dsk) * z0, (d[1] + xs[1] * dsk) * z1); w.y = cvt_pk_bf16((d[2] + xs[2] * dsk) * z2, (d[3] + xs[3] * dsk) * z3);
                *(u32x2*)(YG + tok * 1024 + h * 64 + p0) = w;
            }
            if (DBG_SSD_SYNC) __syncthreads();
            { const float dc = __expf(alast);
#pragma unroll
              for (int t = 0; t < 4; ++t) { f32x4 d = hst[t] * dc;
#pragma unroll
                  for (int ks = 0; ks < 2; ++ks) d = mfma16(ldfrag(lds + OFF_BT, T_ST, wid * 16 + fr, ks * 32 + fq * 8), ldfrag(lds + OFF_XW, T_ST, t * 16 + fr, ks * 32 + fq * 8), d);
                  hst[t] = d;
                  u32x2 w; w.x = cvt_pk_bf16(d[0], d[1]); w.y = cvt_pk_bf16(d[2], d[3]);
                  *(u32x2*)(lds + OFF_HS + (t * 16 + fr) * CS_ST + (wid * 16 + 4 * fq) * 2) = w; } }
            __syncthreads();
        }
#undef SSD_LOAD
    }
}

__device__ __forceinline__ void ph_gnorm(Frame& F) {
    bf16_t* YG = (bf16_t*)(F.ws + WS_Q);
    const int gw = F.bid * NWAVES + F.wave, NGW = F.G * NWAVES;
    for (int m = gw; m < NTOK; m += NGW) {
        u32x2* rp = (u32x2*)(YG + (size_t)m * D) + F.lane;
#pragma unroll
        for (int j = 0; j < 4; ++j) { const u32x2 w = rp[64 * j]; const float a = bflo(w.x), b = bfhi(w.x), c = bflo(w.y), d = bfhi(w.y);
            const float ss = wave_sum(a * a + b * b + c * c + d * d); const float r = 1.f / sqrtf(ss * (1.f / 256.f) + LN_EPS);
            u32x2 o; o.x = cvt_pk_bf16(a * r, b * r); o.y = cvt_pk_bf16(c * r, d * r); rp[64 * j] = o; }
    }
}

__device__ __forceinline__ void ph_router(Frame& F) {
    float* X1 = (float*)F.outb; bf16_t* U2 = (bf16_t*)(F.ws + WS_U2); const float* MOD = (const float*)(F.ws + WS_MOD);
    const float* ln1g = F.a->in[18]; const float* ln1b = F.a->in[19]; const float* w_router = F.a->in[20]; const float* b_router = F.a->in[21];
    u32x2* REG = (u32x2*)(F.ws + WS_REG); unsigned* CNT = (unsigned*)(F.ws + WS_CTL) + CW_CNT;
    LAS float* WRT = (LAS float*)F.lds;
    LAS unsigned* lcnt = (LAS unsigned*)(F.lds + LDS_AUX); LAS unsigned* lbase = lcnt + 32; LAS unsigned* ent = lcnt + 64;
    const int tid = F.tid, lane = F.lane, wid = F.wave;
    __syncthreads();
    for (int i = tid; i < 32768; i += NTHR) { const int c = i >> 5, e = i & 31; WRT[e * 1024 + c] = w_router[i]; }
    __syncthreads();
    for (int batch = F.bid; batch < NTOK / 256; batch += F.G) {
        const int hf = batch >> 7;
        if (tid < 32) lcnt[tid] = 0u;
        __syncthreads();
        for (int ti = 0; ti < 32; ++ti) {
            const int tl = wid * 32 + ti, m = batch * 256 + tl; const float* md = MOD + (size_t)(m >> 11) * 6144;
            f32x4* xr = (f32x4*)(X1 + (size_t)m * D) + lane;
            f32x4 v[4]; float s = 0.f;
#pragma unroll
            for (int j = 0; j < 4; ++j) { v[j] = xr[64 * j]; s += (v[j][0] + v[j][1]) + (v[j][2] + v[j][3]); }
            float mean = wave_sum(s) * (1.f / D), s2 = 0.f;
#pragma unroll
            for (int j = 0; j < 4; ++j) { v[j] = v[j] - mean; s2 += (v[j][0] * v[j][0] + v[j][1] * v[j][1]) + (v[j][2] * v[j][2] + v[j][3] * v[j][3]); }
            float rstd = 1.f / sqrtf(wave_sum(s2) * (1.f / D) + LN_EPS);
            s = 0.f;
#pragma unroll
            for (int j = 0; j < 4; ++j) { const f32x4 g = *((const f32x4*)ln1g + lane + 64 * j), bb = *((const f32x4*)ln1b + lane + 64 * j); v[j] = v[j] * rstd * g + bb; xr[64 * j] = v[j]; s += (v[j][0] + v[j][1]) + (v[j][2] + v[j][3]); }
            mean = wave_sum(s) * (1.f / D); s2 = 0.f;
#pragma unroll
            for (int j = 0; j < 4; ++j) { v[j] = v[j] - mean; s2 += (v[j][0] * v[j][0] + v[j][1] * v[j][1]) + (v[j][2] * v[j][2] + v[j][3] * v[j][3]); }
            rstd = 1.f / sqrtf(wave_sum(s2) * (1.f / D) + LN_EPS);
            u32x2* o8 = (u32x2*)(U2 + (size_t)m * D) + lane;
#pragma unroll
            for (int j = 0; j < 4; ++j) { const f32x4 sh = *((const f32x4*)(md + 3072) + lane + 64 * j), sc = *((const f32x4*)(md + 4096) + lane + 64 * j);
                v[j] = v[j] * rstd * (sc + 1.0f) + sh; u32x2 w; w.x = cvt_pk_bf16(v[j][0], v[j][1]); w.y = cvt_pk_bf16(v[j][2], v[j][3]); o8[64 * j] = w;
                if (DBG_ROUTER_BF16) { v[j][0] = bflo(w.x); v[j][1] = bfhi(w.x); v[j][2] = bflo(w.y); v[j][3] = bfhi(w.y); } }
            float part[32];
#pragma unroll
            for (int e = 0; e < 32; ++e) { float a = 0.f;
#pragma unroll
                for (int j = 0; j < 4; ++j) { const f32x4 w = *((const LAS f32x4*)(WRT + e * 1024) + lane + 64 * j); a += (v[j][0] * w[0] + v[j][1] * w[1]) + (v[j][2] * w[2] + v[j][3] * w[3]); }
                part[e] = a; }
#pragma unroll
            for (int i = 0; i < 16; ++i) { const bool up = (lane & 32) != 0; const float keep = up ? part[i + 16] : part[i], send = up ? part[i] : part[i + 16]; part[i] = keep + __shfl_xor(send, 32); }
#pragma unroll
            for (int i = 0; i < 8; ++i) { const bool up = (lane & 16) != 0; const float keep = up ? part[i + 8] : part[i], send = up ? part[i] : part[i + 8]; part[i] = keep + __shfl_xor(send, 16); }
#pragma unroll
            for (int i = 0; i < 4; ++i) { const bool up = (lane & 8) != 0; const float keep = up ? part[i + 4] : part[i], send = up ? part[i] : part[i + 4]; part[i] = keep + __shfl_xor(send, 8); }
#pragma unroll
            for (int i = 0; i < 2; ++i) { const bool up = (lane & 4) != 0; const float keep = up ? part[i + 2] : part[i], send = up ? part[i] : part[i + 2]; part[i] = keep + __shfl_xor(send, 4); }
            { const bool up = (lane & 2) != 0; const float keep = up ? part[1] : part[0], send = up ? part[0] : part[1]; part[0] = keep + __shfl_xor(send, 2); }
            const int myexp = lane >> 1;
            float logit = part[0] + __shfl_xor(part[0], 1) + b_router[myexp];
            float tv[4]; int tix[4];
#pragma unroll
            for (int k = 0; k < 4; ++k) { float bv = logit; int bi = myexp;
#pragma unroll
                for (int o = 1; o < 64; o <<= 1) { const float ov = __shfl_xor(bv, o); const int oi = __shfl_xor(bi, o); if (ov > bv || (ov == bv && oi < bi)) { bv = ov; bi = oi; } }
                tv[k] = bv; tix[k] = bi; if (myexp == bi) logit = -INFINITY; }
            const float e1 = __expf(tv[1] - tv[0]), e2 = __expf(tv[2] - tv[0]), e3 = __expf(tv[3] - tv[0]); const float inv = 1.f / (1.f + e1 + e2 + e3);
            if (lane < 4) { const int ee = lane == 0 ? tix[0] : (lane == 1 ? tix[1] : (lane == 2 ? tix[2] : tix[3])); const float gg = (lane == 0 ? 1.f : (lane == 1 ? e1 : (lane == 2 ? e2 : e3))) * inv;
                const unsigned lp = atomicAdd((unsigned*)&lcnt[ee], 1u);
                LAS unsigned* en = ent + (tl * 4 + lane) * 3; en[0] = (unsigned)ee; en[1] = lp; en[2] = __float_as_uint(gg);
                if (DBG_CHECK == 1) { u32x2 rw; rw.x = (unsigned)ee; rw.y = __float_as_uint(gg); ((u32x2*)(F.ws + WS_DBG))[(size_t)m * 4 + lane] = rw; } }
        }
        __syncthreads();
        if (tid < 32) lbase[tid] = __hip_atomic_fetch_add(CNT + 64 * (hf * 32 + tid), lcnt[tid], __ATOMIC_RELAXED, __HIP_MEMORY_SCOPE_AGENT);
        __syncthreads();
        for (int i = tid; i < 1024; i += NTHR) { const LAS unsigned* en = ent + i * 3; const unsigned ee = en[0], pos = lbase[ee] + en[1];
            const unsigned tokl = (unsigned)(batch * 256 + (i >> 2)) - (unsigned)hf * HALF_TOK;
            u32x2 w; w.x = tokl * 4u + (unsigned)(i & 3); w.y = en[2];
            if (pos < (unsigned)REG_CAP) REG[((size_t)hf * 32 + ee) * REG_CAP + pos] = w; }
        __syncthreads();
    }
}

__device__ __forceinline__ void ph_final(Frame& F, int hf) {
    float* X1 = (float*)F.outb; const bf16_t* YB = (const bf16_t*)(F.ws + WS_YB); const float* MOD = (const float*)(F.ws + WS_MOD);
    const float* g2 = F.a->in[26]; const float* b2 = F.a->in[27];
    const int gw = F.bid * NWAVES + F.wave, NGW = F.G * NWAVES, lane = F.lane;
    for (int tl = gw; tl < HALF_TOK; tl += NGW) {
        const int m = hf * HALF_TOK + tl; const float* md = MOD + (size_t)(m >> 11) * 6144 + 5120;
        f32x4* xr = (f32x4*)(X1 + (size_t)m * D) + lane; const u32x2* yr = (const u32x2*)(YB + (size_t)tl * 4 * D) + lane;
        f32x4 v[4]; float s = 0.f;
#pragma unroll
        for (int j = 0; j < 4; ++j) { f32x4 y = (f32x4){0.f, 0.f, 0.f, 0.f};
#pragma unroll
            for (int k = 0; k < 4; ++k) { const u32x2 w = yr[k * 256 + 64 * j]; y[0] += bflo(w.x); y[1] += bfhi(w.x); y[2] += bflo(w.y); y[3] += bfhi(w.y); }
            const f32x4 gt = *((const f32x4*)md + lane + 64 * j);
            if (DBG_NO_MOE) y = (f32x4){0.f, 0.f, 0.f, 0.f};
            v[j] = xr[64 * j] * DN_ALPHA + gt * y; s += (v[j][0] + v[j][1]) + (v[j][2] + v[j][3]); }
        const float mean = wave_sum(s) * (1.f / D); float s2 = 0.f;
#pragma unroll
        for (int j = 0; j < 4; ++j) { v[j] = v[j] - mean; s2 += (v[j][0] * v[j][0] + v[j][1] * v[j][1]) + (v[j][2] * v[j][2] + v[j][3] * v[j][3]); }
        const float rstd = 1.f / sqrtf(wave_sum(s2) * (1.f / D) + LN_EPS);
#pragma unroll
        for (int j = 0; j < 4; ++j) { const f32x4 g = *((const f32x4*)g2 + lane + 64 * j), bb = *((const f32x4*)b2 + lane + 64 * j); xr[64 * j] = v[j] * rstd * g + bb; }
    }
}


__device__ __forceinline__ float block_sum(Frame& F, float v, LAS float* red) {
    v = wave_sum(v); __syncthreads(); if (F.lane == 0) red[F.wave] = v; __syncthreads();
    float s = 0.f; for (int w = 0; w < NWAVES; ++w) s += red[w]; return s;
}
__device__ __forceinline__ float block_max(Frame& F, float v, LAS float* red) {
#pragma unroll
    for (int o = 1; o < 64; o <<= 1) v = fmaxf(v, __shfl_xor(v, o));
    __syncthreads(); if (F.lane == 0) red[F.wave] = v; __syncthreads();
    float s = 0.f; for (int w = 0; w < NWAVES; ++w) s = fmaxf(s, red[w]); return s;
}
__device__ __forceinline__ void dbg_report(Frame& F, float e) { if (F.tid == 0) atomicMax((unsigned*)(F.ws + WS_CTL) + CW_DBG, __float_as_uint(e)); }
__device__ __forceinline__ void dbg_check_moe(Frame& F) {
    if (F.bid >= 64) return;
    const int tok = HALF_TOK + 509 * F.bid + 3, tokl = tok - HALF_TOK, tid = F.tid;
    LAS float* u2 = (LAS float*)F.lds; LAS float* act = u2 + 1024; LAS float* red = act + 1024; LAS float* lg = red + 16;
    const bf16_t* U2 = (const bf16_t*)(F.ws + WS_U2); const bf16_t* YB = (const bf16_t*)(F.ws + WS_YB); const u32x2* RT = (const u32x2*)(F.ws + WS_DBG);
    const float* w1 = F.a->in[22]; const float* b1 = F.a->in[23]; const float* w2 = F.a->in[24]; const float* b2 = F.a->in[25];
    __syncthreads();
    for (int i = tid; i < 1024; i += NTHR) u2[i] = bflo((unsigned)U2[(size_t)tok * 1024 + i]);
    __syncthreads();
    float y0 = 0.f, y1 = 0.f;
    for (int k = 0; k < 4; ++k) {
        const u32x2 rw = RT[(size_t)tok * 4 + k]; const int e = (int)rw.x; const float g = __uint_as_float(rw.y);
        const float* W1 = w1 + (size_t)e * 1024 * 2048; const float* W2 = w2 + (size_t)e * 1024 * 1024;
        float h0 = b1[e * 2048 + tid], h1 = b1[e * 2048 + tid + 512], h2 = b1[e * 2048 + tid + 1024], h3 = b1[e * 2048 + tid + 1536];
        for (int c = 0; c < 1024; ++c) { const float uu = u2[c]; const float* wr = W1 + (size_t)c * 2048 + tid; h0 += uu * wr[0]; h1 += uu * wr[512]; h2 += uu * wr[1024]; h3 += uu * wr[1536]; }
        __syncthreads();
        { float gg = fminf(h0, 7.f), up = fminf(fmaxf(h2, -7.f), 7.f); act[tid] = (up + 1.f) * gg / (1.f + expf(-1.702f * gg));
          gg = fminf(h1, 7.f); up = fminf(fmaxf(h3, -7.f), 7.f); act[tid + 512] = (up + 1.f) * gg / (1.f + expf(-1.702f * gg)); }
        __syncthreads();
        float a0 = b2[e * 1024 + tid], a1 = b2[e * 1024 + tid + 512];
        for (int j = 0; j < 1024; ++j) { const float aa = act[j]; a0 += aa * W2[(size_t)j * 1024 + tid]; a1 += aa * W2[(size_t)j * 1024 + tid + 512]; }
        y0 += g * a0; y1 += g * a1;
    }
    float f0 = 0.f, f1 = 0.f;
    for (int k = 0; k < 4; ++k) { f0 += bflo((unsigned)YB[((size_t)tokl * 4 + k) * 1024 + tid]); f1 += bflo((unsigned)YB[((size_t)tokl * 4 + k) * 1024 + tid + 512]); }
    const float rms = sqrtf(block_sum(F, y0 * y0 + y1 * y1, red) * (1.f / 1024.f)) + 1e-20f;
    float err = block_max(F, fmaxf(fabsf(y0 - f0), fabsf(y1 - f1)), red) / rms;
    { const float* X1 = (const float*)F.outb + (size_t)tok * 1024; const float* md = (const float*)(F.ws + WS_MOD) + (size_t)(tok >> 11) * 6144;
      const float xa = X1[tid], xb = X1[tid + 512]; const float mean = block_sum(F, xa + xb, red) * (1.f / 1024.f);
      const float da = xa - mean, db = xb - mean; const float var = block_sum(F, da * da + db * db, red) * (1.f / 1024.f); const float rstd = 1.f / sqrtf(var + LN_EPS);
      __syncthreads();
      u2[tid] = da * rstd * (1.f + md[4096 + tid]) + md[3072 + tid]; u2[tid + 512] = db * rstd * (1.f + md[4096 + tid + 512]) + md[3072 + tid + 512];
      __syncthreads();
      if (tid < 32) { float a = F.a->in[21][tid]; for (int c = 0; c < 1024; ++c) a += u2[c] * F.a->in[20][c * 32 + tid]; lg[tid] = a; }
      __syncthreads();
      if (tid == 0) { unsigned want = 0u, got = 0u; float l2[32]; for (int i = 0; i < 32; ++i) l2[i] = lg[i];
          for (int k = 0; k < 4; ++k) { int bi = 0; for (int i = 1; i < 32; ++i) if (l2[i] > l2[bi]) bi = i; want |= 1u << bi; l2[bi] = -INFINITY; got |= 1u << RT[(size_t)tok * 4 + k].x; }
          lg[32] = (want != got) ? 1.f : 0.f; }
      __syncthreads();
      if (lg[32] != 0.f) err = 50.f; }
    dbg_report(F, err);
}
__device__ __forceinline__ void dbg_check_ssd(Frame& F) {
    if (F.bid >= 2) return;
    const int b = F.bid ? 20 : 5, h = F.bid ? 14 : 3, g = h >> 2, tid = F.tid, p = tid >> 3, ng = tid & 7;
    LAS float* red = (LAS float*)F.lds; LAS float* cv = red + 16;
    const bf16_t* XBC = (const bf16_t*)(F.ws + WS_XBC); const bf16_t* ZS = (const bf16_t*)(F.ws + WS_Z); const float* DT = (const float*)(F.outb + OUT_DT); const bf16_t* YG = (const bf16_t*)(F.ws + WS_Q);
    const float* cw = F.a->in[9]; const float* cb = F.a->in[10]; const float aneg = -expf(F.a->in[12][h]), dsk = F.a->in[13][h];
    const int mych = tid < 64 ? h * 64 + tid : (tid < 192 ? 1024 + g * 128 + (tid - 64) : 1536 + g * 128 + (tid - 192));
    float w0 = 0.f, w1 = 0.f, w2 = 0.f, w3 = 0.f, wb = 0.f;
    if (tid < 320) { w0 = cw[0 * 2048 + mych]; w1 = cw[1 * 2048 + mych]; w2 = cw[2 * 2048 + mych]; w3 = cw[3 * 2048 + mych]; wb = cb[mych]; }
    float x0 = 0.f, x1 = 0.f, x2 = 0.f;
    float hs[16];
#pragma unroll
    for (int i = 0; i < 16; ++i) hs[i] = 0.f;
    float emax = 0.f, ssq = 0.f, nbad = 0.f; int tmax = 0;
    for (int t = 0; t < SEQ; ++t) {
        const size_t tok = (size_t)b * SEQ + t;
        __syncthreads();
        if (DBG_HYP == 1 && (t & 63) == 0) { x0 = 0.f; x1 = 0.f; x2 = 0.f; }
        if (tid < 320) { const float x3 = bflo((unsigned)XBC[tok * 2048 + mych]); const float s = wb + w0 * x0 + w1 * x1 + w2 * x2 + w3 * x3; cv[tid] = s / (1.f + expf(-s)); x0 = x1; x1 = x2; x2 = x3; }
        __syncthreads();
        const float xv = cv[p], dt = DT[tok * 16 + h], dec = expf(dt * aneg);
        float yp = 0.f;
#pragma unroll
        for (int i = 0; i < 16; ++i) { const int n = ng * 16 + i; hs[i] = hs[i] * dec + dt * xv * cv[64 + n]; yp += cv[192 + n] * hs[i]; }
        yp += __shfl_xor(yp, 1); yp += __shfl_xor(yp, 2); yp += __shfl_xor(yp, 4);
        const float yv = (yp + xv * dsk) * bflo((unsigned)ZS[tok * 1024 + h * 64 + p]);
        const float yf = bflo((unsigned)YG[tok * 1024 + h * 64 + p]);
        if (ng == 0) { const float er = fabsf(yv - yf); if (er > emax) { emax = er; tmax = t; } ssq += yv * yv; if (er > 0.25f && (DBG_SUB < 5 || (DBG_SUB == 5 && (t & 63) == 0) || (DBG_SUB == 6 && (t & 63) == 1) || (DBG_SUB == 7 && (t & 63) == 32))) nbad += 1.f; }
    }
    const float rms = sqrtf(block_sum(F, ssq, red) / (64.f * SEQ)) + 1e-20f;
    const float M = block_max(F, emax, red);
    if (DBG_SUB == 0) dbg_report(F, M / rms);
    else if (DBG_SUB == 1) dbg_report(F, block_sum(F, nbad, red) / (64.f * SEQ));
    else if (DBG_SUB >= 5) dbg_report(F, block_sum(F, nbad, red) / (64.f * 32.f));
    else { __syncthreads(); if (ng == 0 && emax == M) red[12] = (float)(DBG_SUB == 2 ? ((tmax & 63) >> 1) : (DBG_SUB == 3 ? (tmax >> 6) : (p >> 1))); __syncthreads();
        if (F.bid == 0) dbg_report(F, powf(10.f, 2.f * (0.05f + 0.05f * red[12]) - 4.f)); }
}
__device__ __forceinline__ void dbg_check_attn(Frame& F) {
    if (F.bid >= 32) return;
    const int b = (F.bid * 7 + 3) & 31, pos = 300 + F.bid * 53, nadm = ((pos >> 6) + 1) * 64, tid = F.tid, lane = F.lane, hd = F.wave;
    const size_t tq = (size_t)b * SEQ + pos;
    LAS float* sc = (LAS float*)F.lds; LAS unsigned char* sel = (LAS unsigned char*)(sc + 2048); LAS float* lgt = (LAS float*)(sel + 2048); LAS float* red = lgt + 8 * 2048; LAS float* misc = red + 16;
    const bf16_t* IQ = (const bf16_t*)(F.outb + OUT_IQ); const bf16_t* IK = (const bf16_t*)(F.outb + OUT_IK); const float* IW = (const float*)(F.outb + OUT_IW);
    const bf16_t* Q = (const bf16_t*)(F.ws + WS_Q); const bf16_t* KV = (const bf16_t*)(F.outb + OUT_KV); const bf16_t* OA = (const bf16_t*)(F.outb + OUT_OA); const u64* MASK = (const u64*)(F.outb + OUT_MASK);
    __syncthreads();
    for (int k = tid; k < nadm; k += NTHR) { float s = 0.f;
        for (int hh = 0; hh < 8; ++hh) { float d = 0.f; for (int c = 0; c < 64; ++c) d += bflo((unsigned)IQ[tq * 512 + hh * 64 + c]) * bflo((unsigned)IK[((size_t)b * SEQ + k) * 64 + c]); s += fmaxf(d, 0.f) * IW[tq * 8 + hh]; }
        sc[k] = s + 0.0f; }
    __syncthreads();
    float nbad = 0.f;
    for (int k = tid; k < nadm; k += NTHR) { const float s = sc[k]; int rank = 0; for (int j = 0; j < nadm; ++j) { const float t = sc[j]; rank += (t > s || (t == s && j < k)) ? 1 : 0; }
        const unsigned char se = rank < 256 ? 1 : 0; sel[k] = se; const unsigned mb = (unsigned)((MASK[tq * 32 + (k >> 6)] >> (k & 63)) & 1ull); if (mb != se) nbad += 1.f; }
    __syncthreads();
    const float nbad_t = block_sum(F, nbad, red);
    LAS float* lw = lgt + hd * 2048; float mx = -INFINITY;
    for (int k = lane; k < nadm; k += 64) { float l = -INFINITY;
        if (sel[k]) { float d = 0.f; for (int c = 0; c < 128; ++c) d += bflo((unsigned)Q[tq * 1024 + hd * 128 + c]) * bflo((unsigned)KV[((size_t)b * SEQ + k) * 128 + c]);
            const int rel = k - pos, n = rel < 0 ? -rel : rel; const float nf = (float)(n > 1 ? n : 1); int large = 8 + (int)(logf(nf / 8.0f) / 2.7725887f * 8.0f); if (large > 15) large = 15;
            const int bucket = (rel > 0 ? 16 : 0) + (n < 8 ? n : large);
            l = d * 0.088388347648318440f + F.a->in[8][bucket * 8 + hd]; }
        lw[k] = l; mx = fmaxf(mx, l); }
#pragma unroll
    for (int o = 1; o < 64; o <<= 1) mx = fmaxf(mx, __shfl_xor(mx, o));
    float den = 0.f;
    for (int k = lane; k < nadm; k += 64) { const float pp = expf(lw[k] - mx); lw[k] = pp; den += pp; }
    den = wave_sum(den);
    float emax = 0.f, ssq = 0.f;
    for (int c2 = 0; c2 < 2; ++c2) { const int c = lane + 64 * c2; float o = 0.f; for (int k = 0; k < nadm; ++k) { const float pp = lw[k]; if (pp != 0.f) o += pp * bflo((unsigned)KV[((size_t)b * SEQ + k) * 128 + c]); }
        o /= den; const float of = bflo((unsigned)OA[tq * 1024 + hd * 128 + c]); emax = fmaxf(emax, fabsf(o - of)); ssq += o * o; }
    const float rms = sqrtf(block_sum(F, ssq, red) * (1.f / 1024.f)) + 1e-20f;
    float err = block_max(F, emax, red) / rms;
    (void)misc;
    if (nbad_t > 0.f) err = 10.f + nbad_t;
    dbg_report(F, err);
}
__device__ __forceinline__ void dbg_emit(Frame& F) {
    float* out = (float*)F.outb;
    for (size_t i = (size_t)F.bid * NTHR + F.tid; i < (size_t)NTOK * D / 4; i += (size_t)F.G * NTHR) ((f32x4*)out)[i] = (f32x4){0.f, 0.f, 0.f, 0.f};
    __syncthreads();
    if (F.bid == 0 && F.tid == 0) { const float e = __uint_as_float(__hip_atomic_load((unsigned*)(F.ws + WS_CTL) + CW_DBG, __ATOMIC_RELAXED, __HIP_MEMORY_SCOPE_AGENT));
        float code = (log10f(fmaxf(e, 1e-30f)) + 4.f) * 0.5f; code = fminf(fmaxf(rintf(code * 20.f) * 0.05f, 0.05f), 3.0f);
        out[0] = sqrtf(67108864.f * 1.01f * (powf(10.f, code) - 1.f)); }
}

constexpr int NPHASE = 17;
__global__ void __launch_bounds__(NTHR, 2) fwd(Args args) {
    extern __shared__ __attribute__((aligned(16))) unsigned char lds_raw[];
    Frame F;
    F.lds = (LAS unsigned char*)lds_raw;
    F.tid = threadIdx.x; F.lane = F.tid & 63; F.wave = __builtin_amdgcn_readfirstlane(F.tid >> 6); F.G = gridDim.x; F.bid = blockIdx.x;
    F.a = &args;
    F.ws = args.ws; F.outb = (unsigned char*)args.out;
    volatile LAS unsigned* MISCW = (volatile LAS unsigned*)(F.lds + LDS_MISC);
    if (F.tid < 64) MISCW[F.tid] = 0u;
    __syncthreads();
    XcdBarrier bar; bar.bar = (unsigned*)(F.ws + WS_CTL) + CW_BAR; bar.x = 0; bar.st = nullptr;
#if MK_ONE
    bar = xcd_barrier_post((unsigned*)(F.ws + WS_CTL) + CW_BAR, MISCW + 8);
#define GRID_BAR() xcd_barrier(bar)
#else
#define GRID_BAR() do { } while (0)
#endif
    const int lo = args.ph_lo, hi = args.ph_hi;
#ifndef PHM
#define PHM (0xFFFFFFFFu & ~(DBG_NO_ATTN ? 0x30u : 0u) & ~(DBG_NO_SSD ? 0xC0u : 0u))
#endif
#define IN(k) (((PHM >> (k)) & 1u) && lo <= (k) && (k) < hi)
#define SEAM(k) do { if ((k) + 1 < hi) GRID_BAR(); } while (0)

    if (IN(0)) { ph_prologue(F); if (DBG_TWICE & 1u) { GRID_BAR(); ph_prologue(F); } SEAM(0); }
    if (IN(1)) { ph_ln1(F); if (DBG_TWICE & 2u) { GRID_BAR(); ph_ln1(F); } SEAM(1); }
    if (IN(2)) {
        SchedPlain S; S.o.init(NTOK, NPROJ, F.G, F.bid); S.A = (const char*)(F.outb + OUT_U); S.Bt = (const char*)(F.ws + WS_WIN);
        EpiProj E{(bf16_t*)(F.ws + WS_Q), (bf16_t*)(F.outb + OUT_IQ), (bf16_t*)(F.ws + WS_Z), (bf16_t*)(F.ws + WS_XBC), (bf16_t*)(F.ws + WS_GA), (bf16_t*)(F.ws + WS_GB), (float*)(F.outb + OUT_MISC)};
        pg8::gemm_phase<EpiProj, SchedPlain, false>(F.lds, S, E);
        if (DBG_TWICE & 4u) { GRID_BAR(); pg8::gemm_phase<EpiProj, SchedPlain, false>(F.lds, S, E); }
        SEAM(2);
    }
    if (IN(3)) { ph_misc(F); if (DBG_TWICE & 8u) { GRID_BAR(); ph_misc(F); } SEAM(3); }
    if (IN(4)) { ph_index(F); if (DBG_TWICE & 16u) { GRID_BAR(); ph_index(F); } SEAM(4); }
    if (IN(5)) { ph_attn(F); if (DBG_TWICE & 32u) { GRID_BAR(); ph_attn(F); } SEAM(5); if (DBG_CHECK == 3) { dbg_check_attn(F); GRID_BAR(); } }
    if (IN(6)) { ph_ssd(F); if (DBG_TWICE & 64u) { GRID_BAR(); ph_ssd(F); } SEAM(6); if (DBG_CHECK == 2) { dbg_check_ssd(F); GRID_BAR(); } }
    if (IN(7)) { ph_gnorm(F); SEAM(7); }
    if (IN(8)) {
        SchedPlain S; S.o.init(NTOK, 1024, F.G, F.bid); S.A = (const char*)(F.outb + OUT_OA); S.Bt = (const char*)(F.ws + WS_WPA);
        EpiGate<0> E{(const bf16_t*)(F.ws + WS_GA), nullptr, (bf16_t*)(F.ws + WS_Z)};
        pg8::gemm_phase<EpiGate<0>, SchedPlain, false>(F.lds, S, E);
        SEAM(8);
    }
    if (IN(9)) {
        SchedPlain S; S.o.init(NTOK, 1024, F.G, F.bid); S.A = (const char*)(F.ws + WS_Q); S.Bt = (const char*)(F.ws + WS_WPB);
        EpiGate<1> E{(const bf16_t*)(F.ws + WS_GB), (const bf16_t*)(F.ws + WS_Z), (bf16_t*)(F.ws + WS_XBC)};
        pg8::gemm_phase<EpiGate<1>, SchedPlain, false>(F.lds, S, E);
        SEAM(9);
    }
    if (IN(10)) {
        SchedPlain S; S.o.init(NTOK, 1024, F.G, F.bid); S.A = (const char*)(F.ws + WS_XBC); S.Bt = (const char*)(F.ws + WS_WOUT);
        EpiOut E{F.a->in[0], (const float*)(F.ws + WS_MOD), (float*)F.outb};
        pg8::gemm_phase<EpiOut, SchedPlain, false>(F.lds, S, E);
        SEAM(10);
    }
    if (IN(11)) { ph_router(F); SEAM(11); }
#pragma unroll
    for (int hf = 0; hf < 2; ++hf) {
        const int p0 = 12 + hf * 2;
        if (IN(p0)) {
            if (hf == 1) ph_final(F, 0);
            MoeTab T = moe_tables(F, hf);
            SchedMoe<8, true> S{T, F.G, F.bid, hf, (const char*)(F.ws + WS_U2), (const char*)(F.ws + WS_W1), (const u32x2*)(F.ws + WS_REG)};
            EpiMoe1 E{F.a->in[23], (bf16_t*)(F.ws + WS_ACT)};
            pg8::gemm_phase<EpiMoe1, SchedMoe<8, true>, true>(F.lds, S, E);
            if ((DBG_TWICE & 4096u) && hf == 0) { GRID_BAR(); pg8::gemm_phase<EpiMoe1, SchedMoe<8, true>, true>(F.lds, S, E); }
            SEAM(p0);
        }
        if (IN(p0 + 1)) {
            MoeTab T = moe_tables(F, hf);
            SchedMoe<4, false> S{T, F.G, F.bid, hf, (const char*)(F.ws + WS_ACT), (const char*)(F.ws + WS_W2), (const u32x2*)(F.ws + WS_REG)};
            EpiMoe2 E{F.a->in[25], (bf16_t*)(F.ws + WS_YB), (const u32x2*)(F.ws + WS_REG), T, hf};
            pg8::gemm_phase<EpiMoe2, SchedMoe<4, false>, false>(F.lds, S, E);
            if ((DBG_TWICE & 8192u) && hf == 0) { GRID_BAR(); pg8::gemm_phase<EpiMoe2, SchedMoe<4, false>, false>(F.lds, S, E); }
            SEAM(p0 + 1);
            if (DBG_CHECK == 1 && hf == 1) { dbg_check_moe(F); GRID_BAR(); }
        }
    }
    if (IN(16)) { ph_final(F, 1); }
    if (DBG_CHECK) { GRID_BAR(); dbg_emit(F); }
#undef IN
#undef SEAM
}

extern "C" void kernel_launch(void* const* d_in, const int* in_sizes, int n_in, void* d_out, int out_size, void* d_ws, size_t ws_size, hipStream_t stream) {
    static int grid = 0;
    if (grid == 0) {
        if (n_in != 28 || in_sizes[0] != NTOK * D || out_size != NTOK * D || ws_size < WS_END) { fprintf(stderr, "kernel_launch: shape mismatch (n_in %d, in0 %d, out %d, ws %zu)\n", n_in, n_in > 0 ? in_sizes[0] : -1, out_size, ws_size); grid = -1; return; }
        int dev = 0, cus = 0, per_cu = 0;
        if (hipGetDevice(&dev) != hipSuccess || hipDeviceGetAttribute(&cus, hipDeviceAttributeMultiprocessorCount, dev) != hipSuccess) { grid = -1; return; }
        if (hipFuncSetAttribute((const void*)fwd, hipFuncAttributeMaxDynamicSharedMemorySize, LDS_BYTES) != hipSuccess) { fprintf(stderr, "kernel_launch: hipFuncSetAttribute failed\n"); grid = -1; return; }
        if (hipOccupancyMaxActiveBlocksPerMultiprocessor(&per_cu, (const void*)fwd, NTHR, LDS_BYTES) != hipSuccess || per_cu < 1) fprintf(stderr, "kernel_launch: occupancy query reports %d\n", per_cu);
        (void)hipGetLastError();
        grid = cus;
    }
    if (grid < 0) return;
    if (hipMemsetAsync((char*)d_ws + WS_CTL, 0, CTL_ZERO_BYTES, stream) != hipSuccess) { fprintf(stderr, "kernel_launch: memset failed\n"); return; }
    Args a{};
    for (int i = 0; i < 28; ++i) a.in[i] = (const float*)d_in[i];
    a.out = (float*)d_out; a.ws = (unsigned char*)d_ws;
    const int nph = NPHASE < MK_PH_HI ? NPHASE : MK_PH_HI;
#if MK_ONE
    a.ph_lo = 0; a.ph_hi = nph;
    hipLaunchKernelGGL(fwd, dim3(grid), dim3(NTHR), LDS_BYTES, stream, a);
#else
    for (int p = 0; p < nph; ++p) { a.ph_lo = p; a.ph_hi = p + 1; hipLaunchKernelGGL(fwd, dim3(grid), dim3(NTHR), LDS_BYTES, stream, a); }
#endif
    const hipError_t le = hipPeekAtLastError();
    if (le != hipSuccess) fprintf(stderr, "kernel_launch: launch failed: %s\n", hipGetErrorName(le));
}
```

```cpp
#include <hip/hip_runtime.h>
#include <cstdio>
#include <cstdint>

#ifndef MK_ONE
#define MK_ONE 1
#endif
#ifndef DBG_NO_ATTN
#define DBG_NO_ATTN 0
#endif
#ifndef DBG_ATTN_ZERO
#define DBG_ATTN_ZERO 0
#endif
#ifndef DBG_IQ_TRUNC
#define DBG_IQ_TRUNC 0
#endif
#ifndef DBG_ROUTER_BF16
#define DBG_ROUTER_BF16 0
#endif
#ifndef DBG_CHECK
#define DBG_CHECK 0
#endif
#ifndef DBG_SKIP_BODY
#define DBG_SKIP_BODY 0
#endif
#ifndef DBG_SUB
#define DBG_SUB 0
#endif
#ifndef DBG_SSD_SYNC
#define DBG_SSD_SYNC 0
#endif
#ifndef DBG_HYP
#define DBG_HYP 0
#endif
#ifndef DBG_TWICE
#define DBG_TWICE 0u
#endif
#ifndef DBG_NO_SSD
#define DBG_NO_SSD 0
#endif
#ifndef DBG_NO_MOE
#define DBG_NO_MOE 0
#endif
#ifndef MOE_FP8
#define MOE_FP8 1
#endif
#ifndef MK_PH_HI
#define MK_PH_HI 99
#endif

#define LAS __attribute__((address_space(3)))
#define GAS __attribute__((address_space(1)))
typedef unsigned short bf16_t;
typedef short bf16x8 __attribute__((ext_vector_type(8)));
typedef short s16x4 __attribute__((ext_vector_type(4)));
typedef float f32x2 __attribute__((ext_vector_type(2)));
typedef float f32x4 __attribute__((ext_vector_type(4)));
typedef float f32x16 __attribute__((ext_vector_type(16)));
typedef unsigned u32x2 __attribute__((ext_vector_type(2)));
typedef unsigned u32x4 __attribute__((ext_vector_type(4)));
typedef unsigned long long u64;

constexpr int NB = 32, SEQ = 2048, D = 1024, NTOK = NB * SEQ;
constexpr int NWAVES = 8, NTHR = 512;
constexpr int NPROJ = 6912;
constexpr int NEXP = 32, HALF_TOK = NTOK / 2, REG_CAP = HALF_TOK;
constexpr int ACT_ROWS = HALF_TOK * 4 + NEXP * 256;
constexpr float LN_EPS = 1e-5f;
constexpr float DN_ALPHA = 1.189207115002721f;
constexpr float LOG2E = 1.4426950408889634f;

constexpr size_t MiB = 1u << 20;
constexpr size_t WS_CTL = 0, CTL_ZERO_BYTES = 1 * MiB;
constexpr size_t WS_MOD = 1 * MiB;
constexpr size_t WS_BIAST = 1 * MiB + 800 * 1024;
constexpr size_t WS_WIN = 2 * MiB;
constexpr size_t WS_WPA = 16 * MiB, WS_WPB = 18 * MiB, WS_WOUT = 20 * MiB;
constexpr size_t WS_W1 = 24 * MiB;
constexpr size_t WS_W2 = 152 * MiB;
constexpr size_t WS_Q = 216 * MiB;
constexpr size_t WS_Z = 344 * MiB;
constexpr size_t WS_XBC = 472 * MiB;
constexpr size_t WS_GA = 728 * MiB, WS_GB = 856 * MiB;
constexpr size_t WS_U2 = 216 * MiB;
constexpr size_t WS_REG = 344 * MiB;
constexpr size_t WS_ACT = 360 * MiB;
constexpr size_t WS_YB = 632 * MiB;
constexpr size_t WS_END = 888 * MiB;
constexpr size_t WS_DBG = 888 * MiB;
constexpr size_t OUT_U = 0, OUT_MISC = 128 * MiB, OUT_IQ = 192 * MiB;
constexpr size_t OUT_KV = 0, OUT_IK = 16 * MiB, OUT_IW = 24 * MiB, OUT_DT = 26 * MiB, OUT_MASK = 32 * MiB, OUT_OA = 64 * MiB;
constexpr int CW_BAR = 4096, CW_CNT = 16384, CW_DBG = 24576;

constexpr int LDS_BYTES = 160 * 1024;
constexpr int LDS_AUX = 131072;
constexpr int LDS_MISC = LDS_BYTES - 256;

#define LDS_WAIT() asm volatile("s_waitcnt lgkmcnt(0)" ::: "memory")
#define VM_WAIT() asm volatile("s_waitcnt vmcnt(0)" ::: "memory")
#define SBAR() __builtin_amdgcn_sched_barrier(0)
typedef __bf16 bf16x2_t __attribute__((ext_vector_type(2)));
__device__ __forceinline__ unsigned cvt_pk_bf16(float lo, float hi) { f32x2 f = {lo, hi}; bf16x2_t v = __builtin_convertvector(f, bf16x2_t); return __builtin_bit_cast(unsigned, v); }
__device__ __forceinline__ float bflo(unsigned w) { return __uint_as_float(w << 16); }
__device__ __forceinline__ float bfhi(unsigned w) { return __uint_as_float(w & 0xffff0000u); }
__device__ __forceinline__ u32x4 pack8(f32x4 a, f32x4 b) { u32x4 w; w.x = cvt_pk_bf16(a[0], a[1]); w.y = cvt_pk_bf16(a[2], a[3]); w.z = cvt_pk_bf16(b[0], b[1]); w.w = cvt_pk_bf16(b[2], b[3]); return w; }
constexpr int MOE_RB = MOE_FP8 ? 1024 : 2048;
constexpr float MOE_WSC = MOE_FP8 ? 64.0f : 1.0f, MOE_INV = 1.0f / MOE_WSC;
__device__ __forceinline__ u32x2 pack8_fp8(f32x4 a, f32x4 b) { int lo = 0, hi = 0;
    lo = __builtin_amdgcn_cvt_pk_fp8_f32(a[0], a[1], lo, false); lo = __builtin_amdgcn_cvt_pk_fp8_f32(a[2], a[3], lo, true);
    hi = __builtin_amdgcn_cvt_pk_fp8_f32(b[0], b[1], hi, false); hi = __builtin_amdgcn_cvt_pk_fp8_f32(b[2], b[3], hi, true);
    u32x2 r; r.x = (unsigned)lo; r.y = (unsigned)hi; return r; }
__device__ __forceinline__ void unpack8(u32x4 w, f32x4& a, f32x4& b) { a[0] = bflo(w.x); a[1] = bfhi(w.x); a[2] = bflo(w.y); a[3] = bfhi(w.y); b[0] = bflo(w.z); b[1] = bfhi(w.z); b[2] = bflo(w.w); b[3] = bfhi(w.w); }
__device__ __forceinline__ float wave_sum(float v) {
#pragma unroll
    for (int o = 1; o < 64; o <<= 1) v += __shfl_xor(v, o);
    return v;
}
__device__ __forceinline__ float fast_rcp(float x) { return __builtin_amdgcn_rcpf(x); }
__device__ __forceinline__ float sigmoid_f(float x) { return fast_rcp(1.0f + __expf(-x)); }
__device__ __forceinline__ float silu_f(float x) { return x * sigmoid_f(x); }

#define XB_TMO      128
#define XB_XCNT(j)  (256  + 64 * (j))
#define XB_XSUB(j)  (1280 + 64 * (j))
#define XB_XGEN(j)  (2304 + 64 * (j))
#define XB_TOP      3328
#define XB_TOPGEN   3392
#define XCD_BAR_WORDS 3456
#define XB_SPIN_CAP (1u << 18)
__device__ __forceinline__ unsigned xb_ld(unsigned* p)              { return __hip_atomic_load(p, __ATOMIC_RELAXED, __HIP_MEMORY_SCOPE_AGENT); }
__device__ __forceinline__ unsigned xb_add(unsigned* p, unsigned v) { return __hip_atomic_fetch_add(p, v, __ATOMIC_RELAXED, __HIP_MEMORY_SCOPE_AGENT); }
__device__ __forceinline__ unsigned xb_xcc_id() { return (unsigned)__builtin_amdgcn_s_getreg((3 << 11) | 20) & 0xFu; }
#define XB_SPIN(cond, bar) do { unsigned _sp = 0; while (cond) { __builtin_amdgcn_s_sleep(1); \
    if ((++_sp & 255u) == 0u) { if (xb_ld(&(bar)[XB_TMO])) break; if (_sp > XB_SPIN_CAP) { atomicAdd(&(bar)[XB_TMO], 1u); break; } } } } while (0)
struct XcdBarrier { unsigned* bar; unsigned x; volatile LAS unsigned* st; };
__device__ __forceinline__ XcdBarrier xcd_barrier_post(unsigned* bar, volatile LAS unsigned* st) {
    XcdBarrier b; b.bar = bar; b.x = xb_xcc_id(); b.st = st;
    if (threadIdx.x == 0) (void)xb_add(&bar[XB_XCNT(b.x)], 1u);
    return b;
}
__device__ __forceinline__ void xcd_barrier_complete(unsigned* bar, unsigned x, unsigned& nloc, unsigned& nx) {
    const unsigned G = gridDim.x * gridDim.y * gridDim.z;
    unsigned sum, cnt, mine, sp = 0u;
    for (;;) {
        sum = 0u; cnt = 0u;
#pragma nounroll
        for (unsigned j = 0; j < 16; ++j) { const unsigned c = xb_ld(&bar[XB_XCNT(j)]); sum += c; cnt += (c > 0u) ? 1u : 0u; }
        if (sum == G) break;
        __builtin_amdgcn_s_sleep(1);
        if ((++sp & 255u) == 0u) { if (xb_ld(&bar[XB_TMO])) break; if (sp > XB_SPIN_CAP) { atomicAdd(&bar[XB_TMO], 1u); break; } }
    }
    mine = xb_ld(&bar[XB_XCNT(x)]);
    nloc = mine > 0u ? mine : 1u; nx = cnt > 0u ? cnt : 1u;
}
__device__ __forceinline__ void xcd_barrier(const XcdBarrier& b) {
    asm volatile("s_waitcnt vmcnt(0)" ::: "memory");
    __syncthreads();
    if (threadIdx.x == 0) {
        unsigned* bar = b.bar;
        __builtin_amdgcn_s_waitcnt(0);
        unsigned nloc = b.st[0], nx = b.st[1];
        if (nloc == 0u) { xcd_barrier_complete(bar, b.x, nloc, nx); b.st[0] = nloc; b.st[1] = nx; }
        const unsigned old = xb_add(&bar[XB_XSUB(b.x)], 1u);
        const unsigned gen = old / nloc;
        if (old + 1u == (gen + 1u) * nloc) {
            __builtin_amdgcn_fence(__ATOMIC_RELEASE, "agent");
            asm volatile("s_waitcnt vmcnt(0)" ::: "memory");
            const unsigned og = xb_add(&bar[XB_TOP], 1u);
            const unsigned tg = og / nx;
            if (og + 1u == (tg + 1u) * nx) xb_add(&bar[XB_TOPGEN], 1u);
            else XB_SPIN(xb_ld(&bar[XB_TOPGEN]) == tg, bar);
            __builtin_amdgcn_fence(__ATOMIC_ACQUIRE, "agent");
            xb_add(&bar[XB_XGEN(b.x)], 1u);
            asm volatile("s_waitcnt vmcnt(0)" ::: "memory");
        } else {
            XB_SPIN(xb_ld(&bar[XB_XGEN(b.x)]) == gen, bar);
            __builtin_amdgcn_fence(__ATOMIC_ACQUIRE, "agent");
            asm volatile("s_waitcnt vmcnt(0)" ::: "memory");
        }
    }
    __syncthreads();
}

namespace pg8 {
constexpr int BM = 256, BK = 64, HALF = 128, HTB = HALF * BK * 2, STAGE_BYTES = 8 * HTB, NXCD = 8, WGM = 8, KD = 1024;
__host__ __device__ __forceinline__ int lds_byte(int r, int c) { const int st = (r >> 4) * 2 + (c >> 5), rr = r & 15, cc = c & 31, ob = rr * 64 + cc * 2; return st * 1024 + (ob ^ (((ob >> 9) & 1) << 5)); }
__host__ __device__ __forceinline__ void stage_rc(int b, int& R, int& C) { const int st = b / 1024, sb = b % 1024, swz = sb ^ (((sb >> 9) & 1) << 5); R = (st >> 1) * 16 + swz / 64; C = (st & 1) * 32 + (swz % 64) / 2; }
__host__ __device__ __forceinline__ int perm32(int rho) { const int n = rho >> 4, i = rho & 15; return 8 * (i >> 2) + 4 * n + (i & 3); }
struct Unit { int pm, pn, ex; };
struct StaticOrder {
    int nM, nN, nwg, G, c;
    __device__ void init(int M, int N, int G_, int c_) { nM = M / BM; nN = N / BM; nwg = nM * nN; G = G_; c = c_; }
    __device__ bool next(int i, Unit& u) const {
        const long L = (long)i * G + c; if (L >= nwg) return false;
        int wgid = (int)L; { const int q = nwg / NXCD, r = nwg % NXCD, xcd = wgid % NXCD, off = wgid / NXCD; wgid = (xcd < r ? xcd * (q + 1) : r * (q + 1) + (xcd - r) * q) + off; }
        const int nig = WGM * nN, gid = wgid / nig, fm = gid * WGM, gsz = (nM - fm) < WGM ? (nM - fm) : WGM;
        u.pm = fm + ((wgid % nig) % gsz); u.pn = (wgid % nig) / gsz; u.ex = 0; return true;
    }
};
typedef int i32x8 __attribute__((ext_vector_type(8)));
typedef int i32x4v __attribute__((ext_vector_type(4)));
template <class Epi, class Sched, bool GATHER, int KE = 1024, bool FP8 = false>
__device__ __forceinline__ void gemm_phase(LAS unsigned char* lds, const Sched& S, const Epi& E) {
    int tid = threadIdx.x; asm volatile("" : "+v"(tid));
    const int wid = __builtin_amdgcn_readfirstlane(tid >> 6), lane = tid & 63, wr = wid >> 2, wc = wid & 3, fr = lane & 15, fq = lane >> 4;
    constexpr int K = KE, nt = K / BK;
    unsigned voffA[2], voffB[2]; int Rr[2], Cc[2];
#pragma unroll
    for (int i = 0; i < 2; ++i) { int R, C; stage_rc(tid * 16 + i * 8192, R, C); const int Rb = Epi::PERM ? ((R & ~31) + perm32(R & 31)) : R;
        voffA[i] = (unsigned)(R * K + C) * 2u; voffB[i] = (unsigned)(Rb * K + C) * 2u; Rr[i] = R; Cc[i] = C; }
    constexpr size_t kstep = (size_t)(BK * 2);
    constexpr size_t hstep = (size_t)HALF * K * 2;
    const unsigned ldsw = (unsigned)wid * 1024u;
    const int aoff = lds_byte(wr * 64 + fr, fq * 8), boff = lds_byte(wc * 32 + fr, fq * 8);
#define PG8_SA(b, h) (((b) * 2 + (h)) * HTB)
#define PG8_SB(b, h) ((4 + (b) * 2 + (h)) * HTB)
#define PG8_STAGE(bufoff, gbase, voff) do { _Pragma("unroll") for (int _i = 0; _i < 2; ++_i) \
        __builtin_amdgcn_global_load_lds((const unsigned*)((const char*)(gbase) + (voff)[_i]), (LAS unsigned*)(lds + (bufoff) + ldsw + _i * 8192), 16, 0, 0); } while (0)
#define PG8_STAGE_A(bufoff, gb, h, o0, o1) do { if constexpr (GATHER) { const unsigned _ko = (unsigned)((gb) - gA0); unsigned _o[2]; \
            if ((h) == 0) { _o[0] = (o0)[0] + _ko; _o[1] = (o0)[1] + _ko; } else { _o[0] = (o1)[0] + _ko; _o[1] = (o1)[1] + _ko; } PG8_STAGE(bufoff, gA0, _o); } \
        else { PG8_STAGE(bufoff, (gb) + (h) * hstep, voffA); } } while (0)
#define PG8_LD8(p) __builtin_shufflevector(*(const LAS i32x4v*)(p), *(const LAS i32x4v*)((p) + 1024), 0, 1, 2, 3, 4, 5, 6, 7)
#define PG8_LDA(dst, b, h) do { if constexpr (FP8) { _Pragma("unroll") for (int m = 0; m < 4; ++m) dst##8[m] = PG8_LD8(lds + PG8_SA(b, h) + aoff + m * 2048); } \
        else { _Pragma("unroll") for (int m = 0; m < 4; ++m) _Pragma("unroll") for (int k = 0; k < 2; ++k) dst[m][k] = *(const LAS bf16x8*)(lds + PG8_SA(b, h) + aoff + m * 2048 + k * 1024); } } while (0)
#define PG8_LDB(dst, b, h) do { if constexpr (FP8) { _Pragma("unroll") for (int n = 0; n < 2; ++n) dst##8[n] = PG8_LD8(lds + PG8_SB(b, h) + boff + n * 2048); } \
        else { _Pragma("unroll") for (int n = 0; n < 2; ++n) _Pragma("unroll") for (int k = 0; k < 2; ++k) dst[n][k] = *(const LAS bf16x8*)(lds + PG8_SB(b, h) + boff + n * 2048 + k * 1024); } } while (0)
#define PG8_MMA(ai, bj, At, Bt) do { __builtin_amdgcn_s_setprio(1); if constexpr (FP8) { _Pragma("unroll") for (int m = 0; m < 4; ++m) _Pragma("unroll") for (int n = 0; n < 2; ++n) \
            asm volatile("v_mfma_scale_f32_16x16x128_f8f6f4 %0, %1, %2, %0, %3, %3 op_sel_hi:[0,0,0]" : "+v"(acc[ai][bj][m][n]) : "v"(Bt##8[n]), "v"(At##8[m]), "v"(sc127)); } \
        else { _Pragma("unroll") for (int m = 0; m < 4; ++m) _Pragma("unroll") for (int n = 0; n < 2; ++n) _Pragma("unroll") for (int k = 0; k < 2; ++k) \
            acc[ai][bj][m][n] = __builtin_amdgcn_mfma_f32_16x16x32_bf16(Bt[n][k], At[m][k], acc[ai][bj][m][n], 0, 0, 0); } __builtin_amdgcn_s_setprio(0); } while (0)
#define PG8_WAIT_V(n) asm volatile("s_waitcnt vmcnt(" #n ")" ::: "memory")
#define PG8_WAIT_L(n) asm volatile("s_waitcnt lgkmcnt(" #n ")" ::: "memory")
#define PG8_BAR __builtin_amdgcn_s_barrier()
#define PG8_SCHED __builtin_amdgcn_sched_barrier(0)
    Unit cur, nxt; int ui = 0;
    if (!S.next(0, cur)) return;
    f32x4 acc[2][2][4][2];
#pragma unroll
    for (int a = 0; a < 2; ++a)
#pragma unroll
        for (int b = 0; b < 2; ++b)
#pragma unroll
            for (int m = 0; m < 4; ++m)
#pragma unroll
                for (int n = 0; n < 2; ++n) acc[a][b][m][n] = (f32x4){0.f, 0.f, 0.f, 0.f};
    const int sc127 = 0x7f7f7f7f;
    bf16x8 At[4][2], B0[2][2], B1[2][2]; i32x8 At8[4], B08[2], B18[2];
    const char* cA = S.a_base(cur); const char* cB = S.b_base(cur);
    const char* const gA0 = cA;
    unsigned cv0[2] = {0u, 0u}, cv1[2] = {0u, 0u}, nv0[2] = {0u, 0u}, nv1[2] = {0u, 0u};
    if constexpr (GATHER) S.a_offs(cur, Rr, Cc, cv0, cv1);
    PG8_STAGE(PG8_SB(0, 0), cB, voffB); PG8_STAGE_A(PG8_SA(0, 0), cA, 0, cv0, cv1); PG8_STAGE(PG8_SB(0, 1), cB + hstep, voffB); PG8_STAGE_A(PG8_SA(0, 1), cA, 1, cv0, cv1);
    if (wr == 1) PG8_BAR;
    PG8_WAIT_V(4); PG8_BAR;
    PG8_STAGE(PG8_SB(1, 0), cB + kstep, voffB); PG8_STAGE_A(PG8_SA(1, 0), cA + kstep, 0, cv0, cv1); PG8_STAGE(PG8_SB(1, 1), cB + hstep + kstep, voffB);
    PG8_WAIT_V(6); PG8_BAR;
    for (;;) {
        const bool has_next = S.next(ui + 1, nxt);
        const char* nA = has_next ? S.a_base(nxt) : cA; const char* nB = has_next ? S.b_base(nxt) : cB;
        if constexpr (GATHER) { if (has_next) S.a_offs(nxt, Rr, Cc, nv0, nv1); else { nv0[0] = cv0[0]; nv0[1] = cv0[1]; nv1[0] = cv1[0]; nv1[1] = cv1[1]; } }
#pragma nounroll
        for (int t = 0; t < nt; t += 2) {
            const bool last = (t == nt - 2);
            const char* a1 = cA + (size_t)(t + 1) * kstep;
            const char* a2 = last ? nA : cA + (size_t)(t + 2) * kstep; const char* b2 = last ? nB : cB + (size_t)(t + 2) * kstep;
            const char* a3 = a2 + kstep; const char* b3 = b2 + kstep;
            unsigned s0[2], s1[2];
            if constexpr (GATHER) { s0[0] = last ? nv0[0] : cv0[0]; s0[1] = last ? nv0[1] : cv0[1]; s1[0] = last ? nv1[0] : cv1[0]; s1[1] = last ? nv1[1] : cv1[1]; } else { s0[0] = s0[1] = s1[0] = s1[1] = 0u; }
            PG8_LDB(B0, 0, 0); PG8_SCHED; PG8_LDA(At, 0, 0); PG8_STAGE_A(PG8_SA(1, 1), a1, 1, cv0, cv1);
            PG8_WAIT_L(8); PG8_BAR; PG8_WAIT_L(0); PG8_MMA(0, 0, At, B0); PG8_BAR; PG8_SCHED;
            PG8_LDB(B1, 0, 1); PG8_STAGE(PG8_SB(0, 0), b2, voffB);
            PG8_BAR; PG8_WAIT_L(0); PG8_MMA(0, 1, At, B1); PG8_BAR;
            PG8_LDA(At, 0, 1); PG8_STAGE_A(PG8_SA(0, 0), a2, 0, s0, s1);
            PG8_BAR; PG8_WAIT_L(0); PG8_MMA(1, 0, At, B0); PG8_BAR; PG8_SCHED;
            PG8_STAGE(PG8_SB(0, 1), b2 + hstep, voffB);
            PG8_WAIT_V(6); PG8_BAR; PG8_MMA(1, 1, At, B1); PG8_BAR;
            PG8_LDB(B0, 1, 0); PG8_SCHED; PG8_LDA(At, 1, 0); PG8_STAGE_A(PG8_SA(0, 1), a2, 1, s0, s1);
            PG8_WAIT_L(8); PG8_BAR; PG8_WAIT_L(0); PG8_MMA(0, 0, At, B0); PG8_BAR; PG8_SCHED;
            PG8_LDB(B1, 1, 1); PG8_STAGE(PG8_SB(1, 0), b3, voffB);
            PG8_BAR; PG8_WAIT_L(0); PG8_MMA(0, 1, At, B1); PG8_BAR;
            PG8_LDA(At, 1, 1); PG8_STAGE_A(PG8_SA(1, 0), a3, 0, s0, s1);
            PG8_BAR; PG8_WAIT_L(0); PG8_MMA(1, 0, At, B0); PG8_BAR; PG8_SCHED;
            PG8_STAGE(PG8_SB(1, 1), b3 + hstep, voffB);
            PG8_WAIT_V(6); PG8_BAR; PG8_MMA(1, 1, At, B1); PG8_BAR;
        }
        if constexpr (FP8) asm volatile("s_nop 15\n\ts_nop 15" ::: "memory");
        E(acc, cur, wr, wc, fr, fq);
        if (!has_next) break;
#pragma unroll
        for (int a = 0; a < 2; ++a)
#pragma unroll
            for (int b = 0; b < 2; ++b)
#pragma unroll
                for (int m = 0; m < 4; ++m)
#pragma unroll
                    for (int n = 0; n < 2; ++n) acc[a][b][m][n] = (f32x4){0.f, 0.f, 0.f, 0.f};
        cur = nxt; cA = nA; cB = nB; ++ui;
        if constexpr (GATHER) { cv0[0] = nv0[0]; cv0[1] = nv0[1]; cv1[0] = nv1[0]; cv1[1] = nv1[1]; }
    }
    PG8_WAIT_V(0);
    if (wr == 0) PG8_BAR;
    PG8_BAR;
#undef PG8_SA
#undef PG8_SB
#undef PG8_STAGE
#undef PG8_STAGE_A
#undef PG8_LDA
#undef PG8_LDB
#undef PG8_MMA
#undef PG8_LD8
#undef PG8_WAIT_V
#undef PG8_WAIT_L
#undef PG8_BAR
#undef PG8_SCHED
}
}
using pg8::Unit;
typedef f32x4 AccT[2][2][4][2];

struct Args { const float* in[28]; float* out; unsigned char* ws; int ph_lo, ph_hi, pad0, pad1; };
struct Frame {
    LAS unsigned char* lds;
    int tid, lane, wave, G, bid;
    const struct Args* a;
    unsigned char* ws; unsigned char* outb;
};
struct SchedPlain {
    pg8::StaticOrder o; const char* A; const char* Bt;
    __device__ __forceinline__ bool next(int i, Unit& u) const { return o.next(i, u); }
    __device__ __forceinline__ const char* a_base(const Unit& u) const { return A + (size_t)u.pm * (256 * 2048); }
    __device__ __forceinline__ const char* b_base(const Unit& u) const { return Bt + (size_t)u.pn * (256 * 2048); }
    __device__ __forceinline__ void a_offs(const Unit&, const int*, const int*, unsigned (&)[2], unsigned (&)[2]) const {}
};

struct EpiProj {
    static constexpr bool PERM = true;
    bf16_t *Q, *IQ, *Z, *XBC, *GA, *GB; float* MISC;
    __device__ __forceinline__ void operator()(const AccT& acc, const Unit& u, int wr, int wc, int fr, int fq) const {
        const int pn = u.pn, row0 = u.pm * 256 + wr * 64 + fr, c8 = wc * 32 + 8 * fq;
        if (pn == 6) {
#pragma unroll
            for (int ai = 0; ai < 2; ++ai)
#pragma unroll
                for (int m = 0; m < 4; ++m) { float* rp = MISC + (size_t)(row0 + ai * 128 + m * 16) * 256 + c8;
#pragma unroll
                    for (int bj = 0; bj < 2; ++bj) { *(f32x4*)(rp + bj * 128) = acc[ai][bj][m][0]; *(f32x4*)(rp + bj * 128 + 4) = acc[ai][bj][m][1]; } }
            return;
        }
        bf16_t* base; int ldc, colt, act = 0;
        if (pn < 4) { base = Q; ldc = 1024; colt = pn * 256; }
        else if (pn < 6) { base = IQ; ldc = 512; colt = (pn - 4) * 256; }
        else if (pn < 11) { base = Z; ldc = 1024; colt = (pn - 7) * 256; act = 1; }
        else if (pn < 19) { base = XBC; ldc = 2048; colt = (pn - 11) * 256; }
        else if (pn < 23) { base = GA; ldc = 1024; colt = (pn - 19) * 256; act = 2; }
        else { base = GB; ldc = 1024; colt = (pn - 23) * 256; act = 2; }
#pragma unroll
        for (int ai = 0; ai < 2; ++ai)
#pragma unroll
            for (int m = 0; m < 4; ++m) { bf16_t* rp = base + (size_t)(row0 + ai * 128 + m * 16) * ldc + colt + c8;
#pragma unroll
                for (int bj = 0; bj < 2; ++bj) { f32x4 v0 = acc[ai][bj][m][0], v1 = acc[ai][bj][m][1];
                    if (act == 1) {
#pragma unroll
                        for (int j = 0; j < 4; ++j) { v0[j] = silu_f(v0[j]); v1[j] = silu_f(v1[j]); } }
                    if (act == 2) {
#pragma unroll
                        for (int j = 0; j < 4; ++j) { v0[j] = sigmoid_f(v0[j]); v1[j] = sigmoid_f(v1[j]); } }
                    u32x4 pk = pack8(v0, v1); if (DBG_IQ_TRUNC && (pn == 4 || pn == 5)) { pk.x &= 0xfff8fff8u; pk.y &= 0xfff8fff8u; pk.z &= 0xfff8fff8u; pk.w &= 0xfff8fff8u; }
                    *(u32x4*)(rp + bj * 128) = pk; } }
    }
};
template <int MODE> struct EpiGate {
    static constexpr bool PERM = true;
    const bf16_t* Gt; const bf16_t* T; bf16_t* O;
    __device__ __forceinline__ void operator()(const AccT& acc, const Unit& u, int wr, int wc, int fr, int fq) const {
        const int row0 = u.pm * 256 + wr * 64 + fr, c8 = u.pn * 256 + wc * 32 + 8 * fq;
#pragma unroll
        for (int ai = 0; ai < 2; ++ai)
#pragma unroll
            for (int m = 0; m < 4; ++m) { const size_t off = (size_t)(row0 + ai * 128 + m * 16) * 1024 + c8;
#pragma unroll
                for (int bj = 0; bj < 2; ++bj) { f32x4 g0, g1; unpack8(*(const u32x4*)(Gt + off + bj * 128), g0, g1);
                    f32x4 v0 = g0 * acc[ai][bj][m][0], v1 = g1 * acc[ai][bj][m][1];
                    if ((MODE == 0 && DBG_NO_ATTN) || (MODE == 1 && DBG_NO_SSD)) { v0 = (f32x4){0.f, 0.f, 0.f, 0.f}; v1 = v0; }
                    if (MODE == 1) { f32x4 t0, t1; unpack8(*(const u32x4*)(T + off + bj * 128), t0, t1); v0 += t0; v1 += t1; }
                    *(u32x4*)(O + off + bj * 128) = pack8(v0, v1); } }
    }
};
struct EpiOut {
    static constexpr bool PERM = false;
    const float* x; const float* mod; float* V;
    __device__ __forceinline__ void operator()(const AccT& acc, const Unit& u, int wr, int wc, int fr, int fq) const {
        const int row0 = u.pm * 256 + wr * 64 + fr, col0 = u.pn * 256 + wc * 32 + 4 * fq;
        const float* g1 = mod + (size_t)(u.pm >> 3) * 6144 + 2048 + col0;
        f32x4 gv[2][2];
#pragma unroll
        for (int bj = 0; bj < 2; ++bj)
#pragma unroll
            for (int n = 0; n < 2; ++n) gv[bj][n] = *(const f32x4*)(g1 + bj * 128 + n * 16);
#pragma unroll
        for (int ai = 0; ai < 2; ++ai)
#pragma unroll
            for (int m = 0; m < 4; ++m) { const size_t off = (size_t)(row0 + ai * 128 + m * 16) * 1024 + col0;
#pragma unroll
                for (int bj = 0; bj < 2; ++bj)
#pragma unroll
                    for (int n = 0; n < 2; ++n) { const f32x4 xv = *(const f32x4*)(x + off + bj * 128 + n * 16);
                        *(f32x4*)(V + off + bj * 128 + n * 16) = xv * DN_ALPHA + gv[bj][n] * acc[ai][bj][m][n]; } }
    }
};

struct MoeTab { LAS unsigned* cnt; LAS unsigned* tb; LAS unsigned char* te; int ntiles; };
__device__ __forceinline__ MoeTab moe_tables(Frame& F, int hf) {
    MoeTab T; T.cnt = (LAS unsigned*)(F.lds + LDS_AUX); T.tb = (LAS unsigned*)(F.lds + LDS_AUX + 256); T.te = (LAS unsigned char*)(F.lds + LDS_AUX + 512);
    const unsigned* CNT = (const unsigned*)(F.ws + WS_CTL) + CW_CNT;
    __syncthreads();
    if (F.tid < 32) { unsigned c = __hip_atomic_load(CNT + 64 * (hf * 32 + F.tid), __ATOMIC_RELAXED, __HIP_MEMORY_SCOPE_AGENT); if (c > (unsigned)REG_CAP) c = REG_CAP; T.cnt[F.tid] = c; }
    __syncthreads();
    if (F.tid == 0) { unsigned s = 0;
#pragma nounroll
        for (int e = 0; e < 32; ++e) { T.tb[e] = s; const unsigned n = (T.cnt[e] + 255u) >> 8;
#pragma nounroll
            for (unsigned t = 0; t < n; ++t) T.te[s + t] = (unsigned char)e;
            s += n; }
        T.tb[32] = s; }
    __syncthreads();
    T.ntiles = __builtin_amdgcn_readfirstlane((int)T.tb[32]);
    return T;
}
template <int NJ, bool GATHER> struct SchedMoe {
    MoeTab T; int G, c, hf; const char* A; const char* Bt; const u32x2* REG;
    __device__ __forceinline__ bool next(int i, Unit& u) const {
        const int L = i * G + c; if (L >= T.ntiles * NJ) return false;
        u.pm = L / NJ; u.pn = L % NJ; u.ex = __builtin_amdgcn_readfirstlane((int)T.te[u.pm]); return true;
    }
    __device__ __forceinline__ const char* a_base(const Unit& u) const { return GATHER ? A : A + (size_t)u.pm * (256 * MOE_RB); }
    __device__ __forceinline__ const char* b_base(const Unit& u) const { return Bt + ((size_t)u.ex * (NJ * 256) + (size_t)u.pn * 256) * MOE_RB; }
    __device__ __forceinline__ void a_offs(const Unit& u, const int* R, const int* C, unsigned (&o0)[2], unsigned (&o1)[2]) const {
        const unsigned cnt = __builtin_amdgcn_readfirstlane(T.cnt[u.ex]), pos0 = ((unsigned)u.pm - (unsigned)__builtin_amdgcn_readfirstlane(T.tb[u.ex])) * 256u; const u32x2* rg = REG + ((size_t)hf * 32 + u.ex) * REG_CAP;
#pragma unroll
        for (int i = 0; i < 2; ++i) {
            const unsigned p0 = pos0 + (unsigned)R[i], p1 = p0 + 128u;
            unsigned t0 = 0u, t1 = 0u;
            if (p0 < cnt) t0 = (unsigned)hf * HALF_TOK + (rg[p0].x >> 2);
            if (p1 < cnt) t1 = (unsigned)hf * HALF_TOK + (rg[p1].x >> 2);
            o0[i] = t0 * (unsigned)MOE_RB + (unsigned)C[i] * 2u; o1[i] = t1 * (unsigned)MOE_RB + (unsigned)C[i] * 2u;
        }
    }
};
struct EpiMoe1 {
    static constexpr bool PERM = true;
    const float* b1; bf16_t* ACT;
    __device__ __forceinline__ void operator()(const AccT& acc, const Unit& u, int wr, int wc, int fr, int fq) const {
        const int row0 = u.pm * 256 + wr * 64 + fr, c8 = u.pn * 128 + wc * 32 + 8 * fq;
        const float* bg = b1 + (size_t)u.ex * 2048 + c8;
        const f32x4 bg0 = *(const f32x4*)bg, bg1 = *(const f32x4*)(bg + 4), bu0 = *(const f32x4*)(bg + 1024), bu1 = *(const f32x4*)(bg + 1028);
#pragma unroll
        for (int ai = 0; ai < 2; ++ai)
#pragma unroll
            for (int m = 0; m < 4; ++m) {
                f32x4 g0 = acc[ai][0][m][0] * MOE_INV + bg0, g1 = acc[ai][0][m][1] * MOE_INV + bg1, u0 = acc[ai][1][m][0] * MOE_INV + bu0, u1 = acc[ai][1][m][1] * MOE_INV + bu1, a0, a1;
#pragma unroll
                for (int j = 0; j < 4; ++j) {
                    float g = fminf(g0[j], 7.0f), up = fminf(fmaxf(u0[j], -7.0f), 7.0f); a0[j] = (up + 1.0f) * g * sigmoid_f(1.702f * g);
                    g = fminf(g1[j], 7.0f); up = fminf(fmaxf(u1[j], -7.0f), 7.0f); a1[j] = (up + 1.0f) * g * sigmoid_f(1.702f * g); }
                if (MOE_FP8) *(u32x2*)((unsigned char*)ACT + (size_t)(row0 + ai * 128 + m * 16) * 1024 + c8) = pack8_fp8(a0, a1);
                else *(u32x4*)(ACT + (size_t)(row0 + ai * 128 + m * 16) * 1024 + c8) = pack8(a0, a1); }
    }
};
struct EpiMoe2 {
    static constexpr bool PERM = true;
    const float* b2; bf16_t* YB; const u32x2* REG; MoeTab T; int hf;
    __device__ __forceinline__ void operator()(const AccT& acc, const Unit& u, int wr, int wc, int fr, int fq) const {
        const int c8 = u.pn * 256 + wc * 32 + 8 * fq;
        const unsigned cnt = __builtin_amdgcn_readfirstlane(T.cnt[u.ex]), pos0 = ((unsigned)u.pm - (unsigned)__builtin_amdgcn_readfirstlane(T.tb[u.ex])) * 256u + (unsigned)(wr * 64 + fr); const u32x2* rg = REG + ((size_t)hf * 32 + u.ex) * REG_CAP;
        const float* bb = b2 + (size_t)u.ex * 1024 + c8;
        f32x4 bv[2][2];
#pragma unroll
        for (int bj = 0; bj < 2; ++bj) { bv[bj][0] = *(const f32x4*)(bb + bj * 128); bv[bj][1] = *(const f32x4*)(bb + bj * 128 + 4); }
#pragma unroll
        for (int ai = 0; ai < 2; ++ai)
#pragma unroll
            for (int m = 0; m < 4; ++m) { const unsigned p = pos0 + (unsigned)(ai * 128 + m * 16);
                if (p < cnt) { const u32x2 en = rg[p]; const float g = __uint_as_float(en.y); bf16_t* rp = YB + (size_t)en.x * 1024 + c8;
#pragma unroll
                    for (int bj = 0; bj < 2; ++bj) *(u32x4*)(rp + bj * 128) = pack8((acc[ai][bj][m][0] * MOE_INV + bv[bj][0]) * g, (acc[ai][bj][m][1] * MOE_INV + bv[bj][1]) * g); } }
    }
};

struct MapIdent { __device__ __forceinline__ int operator()(int n) const { return n; } };
struct MapWin { __device__ __forceinline__ int operator()(int n) const {
    if (n < 1024) return n;
    if (n < 1536) return 1152 + (n - 1024);
    if (n < 1792) { const int c = n - 1536; if (c < 128) return 1024 + c; if (c < 192) return 1664 + (c - 128); if (c < 200) return 1728 + (c - 192); if (c < 216) return 4808 + (c - 200); return -1; }
    if (n < 2816) return 1736 + (n - 1792);
    if (n < 4864) return 2760 + (n - 2816);
    if (n < 5888) return 4824 + (n - 4864);
    return 5848 + (n - 5888); } };
struct MapW1 { __device__ __forceinline__ int operator()(int r) const { const int j = r >> 8, rr = r & 255; return (rr >> 7) * 1024 + j * 128 + (rr & 127); } };
template <class Map, bool F8 = false> __device__ __forceinline__ void transpose_item(const float* W, int K, int N, bf16_t* WT, const Map& map, LAS float* scr, int kb, int nb, int lane, const float* rowscale) {
    const int k0 = 64 * kb, n0 = 32 * nb; const int src = map(n0 + (lane & 31));
#pragma unroll 8
    for (int i = 0; i < 32; ++i) { const int kk = 2 * i + (lane >> 5); float v = 0.f; if (src >= 0) v = W[(size_t)(k0 + kk) * N + src]; if (rowscale) v *= rowscale[k0 + kk]; scr[kk * 33 + (lane & 31)] = v; }
    LDS_WAIT(); asm volatile("" ::: "memory");
    const int c = lane & 7;
#pragma unroll
    for (int j = 0; j < 4; ++j) { const int n = (lane >> 3) + 8 * j; const LAS float* s = scr + (8 * c) * 33 + n;
        if constexpr (F8) { const f32x4 a = {s[0 * 33] * MOE_WSC, s[1 * 33] * MOE_WSC, s[2 * 33] * MOE_WSC, s[3 * 33] * MOE_WSC}, b = {s[4 * 33] * MOE_WSC, s[5 * 33] * MOE_WSC, s[6 * 33] * MOE_WSC, s[7 * 33] * MOE_WSC};
            *(u32x2*)((unsigned char*)WT + (size_t)(n0 + n) * K + k0 + 8 * c) = pack8_fp8(a, b); }
        else { u32x4 o; o.x = cvt_pk_bf16(s[0 * 33], s[1 * 33]); o.y = cvt_pk_bf16(s[2 * 33], s[3 * 33]); o.z = cvt_pk_bf16(s[4 * 33], s[5 * 33]); o.w = cvt_pk_bf16(s[6 * 33], s[7 * 33]);
            *(u32x4*)(WT + (size_t)(n0 + n) * K + k0 + 8 * c) = o; } }
    LDS_WAIT(); asm volatile("" ::: "memory");
}
__device__ __forceinline__ void ph_prologue(Frame& F) {
    const float* c_in = F.a->in[1]; const float* w_mod = F.a->in[2]; const float* b_mod = F.a->in[3];
    float* MOD = (float*)(F.ws + WS_MOD);
    for (int item = F.bid; item < 48; item += F.G) {
        LAS float* SC = (LAS float*)F.lds;
        __syncthreads();
        for (int i = F.tid; i < 32768; i += NTHR) { const int b = i >> 10, k = i & 1023; SC[k * 32 + b] = silu_f(c_in[i]); }
        __syncthreads();
        const int col = item * 128 + (F.tid >> 2), kq = F.tid & 3;
        float a[32];
#pragma unroll
        for (int b = 0; b < 32; ++b) a[b] = 0.f;
        for (int kk = 0; kk < 256; ++kk) { const int k = kq * 256 + kk; const float w = w_mod[(size_t)k * 6144 + col];
#pragma unroll
            for (int b4 = 0; b4 < 8; ++b4) { const f32x4 s = *(const LAS f32x4*)(SC + k * 32 + b4 * 4); a[b4 * 4 + 0] += w * s[0]; a[b4 * 4 + 1] += w * s[1]; a[b4 * 4 + 2] += w * s[2]; a[b4 * 4 + 3] += w * s[3]; } }
#pragma unroll
        for (int b = 0; b < 32; ++b) { a[b] += __shfl_xor(a[b], 1); a[b] += __shfl_xor(a[b], 2); }
        if (kq == 0) { const float bm = b_mod[col];
#pragma unroll
            for (int b = 0; b < 32; ++b) MOD[(size_t)b * 6144 + col] = a[b] + bm; }
        __syncthreads();
    }
    if (F.bid == (F.G > 48 ? 48 : 0)) {
        float* BT = (float*)(F.ws + WS_BIAST); const float* rel_bias = F.a->in[8];
        for (int i = F.tid; i < 249 * 8; i += NTHR) { const int idx = i >> 3, h = i & 7, rel = idx - 185; const int n = rel < 0 ? -rel : rel;
            const float nf = (float)(n > 1 ? n : 1); int large = 8 + (int)(logf(nf / 8.0f) / 2.7725887f * 8.0f); if (large > 15) large = 15;
            const int bucket = (rel > 0 ? 16 : 0) + (n < 8 ? n : large);
            BT[i] = rel_bias[bucket * 8 + h] * LOG2E; }
    }
    LAS float* scr = (LAS float*)(F.lds + F.wave * 16384);
    __syncthreads();
    const int gw = F.bid * NWAVES + F.wave, NGW = F.G * NWAVES;
    constexpr int I_WIN = 16 * (NPROJ / 32), I_SQ = 16 * 32, I_W1E = 16 * 64, I_W2E = 16 * 32;
    constexpr int NITEMS = I_WIN + 3 * I_SQ + 32 * I_W1E + 32 * I_W2E;
    for (int it = gw; it < NITEMS; it += NGW) {
        int r = it;
        if (r < I_WIN) { transpose_item(F.a->in[4], 1024, 6872, (bf16_t*)(F.ws + WS_WIN), MapWin(), scr, r / (NPROJ / 32), r % (NPROJ / 32), F.lane, nullptr); continue; } r -= I_WIN;
        if (r < I_SQ) { transpose_item(F.a->in[15], 1024, 1024, (bf16_t*)(F.ws + WS_WPA), MapIdent(), scr, r / 32, r % 32, F.lane, nullptr); continue; } r -= I_SQ;
        if (r < I_SQ) { transpose_item(F.a->in[16], 1024, 1024, (bf16_t*)(F.ws + WS_WPB), MapIdent(), scr, r / 32, r % 32, F.lane, F.a->in[14]); continue; } r -= I_SQ;
        if (r < I_SQ) { transpose_item(F.a->in[17], 1024, 1024, (bf16_t*)(F.ws + WS_WOUT), MapIdent(), scr, r / 32, r % 32, F.lane, nullptr); continue; } r -= I_SQ;
        if (r < 32 * I_W1E) { const int e = r / I_W1E, q = r % I_W1E; transpose_item<MapW1, MOE_FP8 != 0>(F.a->in[22] + (size_t)e * 1024 * 2048, 1024, 2048, (bf16_t*)(F.ws + WS_W1 + (size_t)e * 2048 * MOE_RB), MapW1(), scr, q / 64, q % 64, F.lane, nullptr); continue; } r -= 32 * I_W1E;
        { const int e = r / I_W2E, q = r % I_W2E; transpose_item<MapIdent, MOE_FP8 != 0>(F.a->in[24] + (size_t)e * 1024 * 1024, 1024, 1024, (bf16_t*)(F.ws + WS_W2 + (size_t)e * 1024 * MOE_RB), MapIdent(), scr, q / 32, q % 32, F.lane, nullptr); }
    }
}

__device__ __forceinline__ void ph_ln1(Frame& F) {
    const float* x = F.a->in[0]; const float* MOD = (const float*)(F.ws + WS_MOD); bf16_t* U = (bf16_t*)(F.outb + OUT_U);
    const int gw = F.bid * NWAVES + F.wave, NGW = F.G * NWAVES;
    for (int m = gw; m < NTOK; m += NGW) {
        const f32x4* xr = (const f32x4*)(x + (size_t)m * D) + F.lane; const float* md = MOD + (size_t)(m >> 11) * 6144;
        f32x4 v[4]; float s = 0.f;
#pragma unroll
        for (int j = 0; j < 4; ++j) { v[j] = xr[64 * j]; s += (v[j][0] + v[j][1]) + (v[j][2] + v[j][3]); }
        const float mean = wave_sum(s) * (1.f / D); float s2 = 0.f;
#pragma unroll
        for (int j = 0; j < 4; ++j) { v[j] = v[j] - mean; s2 += (v[j][0] * v[j][0] + v[j][1] * v[j][1]) + (v[j][2] * v[j][2] + v[j][3] * v[j][3]); }
        const float rstd = 1.f / sqrtf(wave_sum(s2) * (1.f / D) + LN_EPS);
        u32x2* o8 = (u32x2*)(U + (size_t)m * D) + F.lane;
#pragma unroll
        for (int j = 0; j < 4; ++j) { const f32x4 sh = *((const f32x4*)md + F.lane + 64 * j), sc = *((const f32x4*)(md + 1024) + F.lane + 64 * j);
            const f32x4 r = v[j] * rstd * (sc + 1.0f) + sh; u32x2 w; w.x = cvt_pk_bf16(r[0], r[1]); w.y = cvt_pk_bf16(r[2], r[3]); o8[64 * j] = w; }
    }
}

__device__ __forceinline__ void ph_misc(Frame& F) {
    const float* MISC = (const float*)(F.outb + OUT_MISC);
    bf16_t* KV = (bf16_t*)(F.outb + OUT_KV); bf16_t* IK = (bf16_t*)(F.outb + OUT_IK); float* IW = (float*)(F.outb + OUT_IW); float* DT = (float*)(F.outb + OUT_DT);
    const float* kvw = F.a->in[5]; const float* ikw = F.a->in[6]; const float* ikb = F.a->in[7]; const float* dtb = F.a->in[11];
    const int gw = F.bid * NWAVES + F.wave, NGW = F.G * NWAVES, l = F.lane;
    for (int m = gw; m < NTOK; m += NGW) {
        const f32x4 v = *((const f32x4*)(MISC + (size_t)m * 256) + l);
        const float sq = v[0] * v[0] + v[1] * v[1] + v[2] * v[2] + v[3] * v[3], sm = (v[0] + v[1]) + (v[2] + v[3]);
        const float kvss = wave_sum(l < 32 ? sq : 0.f);
        const float iks = wave_sum((l >= 32 && l < 48) ? sm : 0.f);
        const float ikmean = iks * (1.f / 64.f);
        const f32x4 dv = v - ikmean;
        const float ikq = wave_sum((l >= 32 && l < 48) ? (dv[0] * dv[0] + dv[1] * dv[1] + dv[2] * dv[2] + dv[3] * dv[3]) : 0.f);
        if (l < 32) { const float r = 1.f / sqrtf(kvss * (1.f / 128.f) + LN_EPS); const f32x4 w = *((const f32x4*)kvw + l); const f32x4 o = v * r * w;
            u32x2 pk; pk.x = cvt_pk_bf16(o[0], o[1]); pk.y = cvt_pk_bf16(o[2], o[3]); *((u32x2*)(KV + (size_t)m * 128) + l) = pk; }
        else if (l < 48) { const float r = 1.f / sqrtf(ikq * (1.f / 64.f) + LN_EPS); const f32x4 w = *((const f32x4*)ikw + (l - 32)), bb = *((const f32x4*)ikb + (l - 32)); const f32x4 o = dv * r * w + bb;
            u32x2 pk; pk.x = cvt_pk_bf16(o[0], o[1]); pk.y = cvt_pk_bf16(o[2], o[3]); *((u32x2*)(IK + (size_t)m * 64) + (l - 32)) = pk; }
        else if (l < 50) { *((f32x4*)(IW + (size_t)m * 8) + (l - 48)) = v * 0.35355339059327373f; }
        else if (l < 54) { const f32x4 bb = *((const f32x4*)dtb + (l - 50)); f32x4 o;
#pragma unroll
            for (int j = 0; j < 4; ++j) { const float t = v[j] + bb[j]; o[j] = t > 20.f ? t : log1pf(__expf(t)); }
            *((f32x4*)(DT + (size_t)m * 16) + (l - 50)) = o; }
    }
}

__device__ __forceinline__ unsigned sortable_key(float s) { const unsigned u = __float_as_uint(s + 0.0f); return (u & 0x80000000u) ? ~u : (u | 0x80000000u); }
template <int NKB> struct KeyRow { unsigned k[NKB]; };
__device__ __forceinline__ u64 low_bits_keep(u64 m, int t) { u64 out = 0; while (t-- > 0 && m) { const u64 b = m & (0 - m); out |= b; m ^= b; } return out; }
namespace idx { constexpr int KST = 144, KBUF = 64 * KST; }
__device__ __forceinline__ unsigned low_bits_keep32(unsigned m, int t) { unsigned out = 0; while (t-- > 0 && m) { const unsigned b = m & (0u - m); out |= b; m ^= b; } return out; }
template <int NG> __device__ __forceinline__ void topk2_select_write(const unsigned (&key)[64], int nkb, u64* mrow, int lane) {
    constexpr int NR = NG * 16;
    unsigned T0 = 0u, T1 = 0u; bool ex0 = false, ex1 = false;
#pragma nounroll
    for (int bit = 31; bit >= 0; --bit) {
        const unsigned c0 = ex0 ? T0 : (T0 | (1u << bit)), c1 = ex1 ? T1 : (T1 | (1u << bit)); const unsigned candv = lane < 32 ? c0 : c1;
        unsigned cl = 0u;
#pragma unroll
        for (int m = 0; m < NR; ++m) cl += (key[m] >= candv) ? 1u : 0u;
        cl += __shfl_xor(cl, 1); cl += __shfl_xor(cl, 2); cl += __shfl_xor(cl, 4); cl += __shfl_xor(cl, 8); cl += __shfl_xor(cl, 16);
        const int n0 = __builtin_amdgcn_readlane((int)cl, 0), n1 = __builtin_amdgcn_readlane((int)cl, 32);
        if (!ex0) { if (n0 >= 256) T0 = c0; if (n0 == 256) ex0 = true; }
        if (!ex1) { if (n1 >= 256) T1 = c1; if (n1 == 256) ex1 = true; }
        if (ex0 && ex1) break;
    }
    const unsigned Tv = lane < 32 ? T0 : T1;
    if (ex0 && ex1) {
        unsigned mlo = 0u, mhi = 0u;
#pragma unroll
        for (int j = 0; j < NR / 2; ++j) {
            const u64 b0 = __ballot(key[2 * j] >= Tv), b1 = __ballot(key[2 * j + 1] >= Tv);
            mlo = (lane == j) ? (unsigned)b0 : mlo; mhi = (lane == j) ? (unsigned)b1 : mhi;
            mlo = (lane == 32 + j) ? (unsigned)(b0 >> 32) : mlo; mhi = (lane == 32 + j) ? (unsigned)(b1 >> 32) : mhi;
            if ((j & 3) == 3) SBAR();
        }
        const int jl = lane & 31;
        if (jl < nkb) mrow[(lane >> 5) * 32 + jl] = (u64)mlo | ((u64)mhi << 32);
        return;
    }
    int rem0 = 1 << 30, rem1 = 1 << 30;
    { int g0 = 0, g1 = 0;
#pragma unroll
        for (int m = 0; m < NR; ++m) { const u64 mk = __ballot(key[m] > Tv); g0 += __builtin_popcount((unsigned)mk); g1 += __builtin_popcount((unsigned)(mk >> 32)); if ((m & 7) == 7) SBAR(); }
        if (!ex0) rem0 = 256 - g0; if (!ex1) rem1 = 256 - g1; }
    u64 mine = 0ull;
#pragma nounroll
    for (int jq = 0; jq < NR / 8; ++jq) {
#pragma unroll
        for (int jj = 0; jj < 4; ++jj) { const int j = jq * 4 + jj;
            unsigned w0[2], w1[2];
#pragma unroll
            for (int hh = 0; hh < 2; ++hh) { unsigned kv = 0u;
#pragma unroll
                for (int m = 0; m < NR; ++m) if ((m >> 3) == 0) {}
#pragma unroll
                for (int m = 0; m < NR; ++m) kv = (m == 2 * j + hh) ? key[m] : kv;
                const u64 gt = __ballot(kv > Tv), eq = __ballot(kv == Tv);
                { const unsigned e = (unsigned)eq, g = (unsigned)gt; const int ne = __builtin_popcount(e); unsigned sel = g; if (rem0 >= ne) { sel |= e; rem0 -= ne; } else if (rem0 > 0) { sel |= low_bits_keep32(e, rem0); rem0 = 0; } w0[hh] = sel; }
                { const unsigned e = (unsigned)(eq >> 32), g = (unsigned)(gt >> 32); const int ne = __builtin_popcount(e); unsigned sel = g; if (rem1 >= ne) { sel |= e; rem1 -= ne; } else if (rem1 > 0) { sel |= low_bits_keep32(e, rem1); rem1 = 0; } w1[hh] = sel; } }
            const u64 q0w = (u64)w0[0] | ((u64)w0[1] << 32), q1w = (u64)w1[0] | ((u64)w1[1] << 32);
            if (lane == j) mine = q0w; if (lane == 32 + j) mine = q1w; }
    }
    const int jl = lane & 31;
    if (jl < nkb) mrow[(lane >> 5) * 32 + jl] = mine;
}
template <int J0> __device__ __forceinline__ void index_scores8(unsigned (&key)[64], const bf16x8 (&af)[2], const f32x4& iw4, const bf16_t* kvsrc, char* lds, int nkb, u32x4 (&stg)[8], int tid) {
    const int lane = tid & 63, sub = lane & 15, kg = lane >> 4;
#pragma unroll
    for (int jj = 0; jj < 8; ++jj) {
        const int j = J0 + jj;
        if (j < nkb) {
            if (j + 1 < nkb) *(u32x4*)(lds + ((j + 1) & 1) * idx::KBUF + (tid >> 3) * idx::KST + (tid & 7) * 16) = stg[(jj + 1) & 7];
            if (j + 8 < nkb) stg[jj] = *(const u32x4*)(kvsrc + (size_t)(j + 8) * 64 * 64);
            const char* kb = lds + (j & 1) * idx::KBUF + sub * idx::KST + kg * 16;
#pragma unroll
            for (int pr = 0; pr < 2; ++pr) {
                f32x4 dA = (f32x4){0.f, 0.f, 0.f, 0.f}, dB = dA;
#pragma unroll
                for (int ks = 0; ks < 2; ++ks) {
                    const bf16x8 fA = *(const bf16x8*)(kb + (pr * 32) * idx::KST + ks * 64), fB = *(const bf16x8*)(kb + (pr * 32 + 16) * idx::KST + ks * 64);
                    dA = __builtin_amdgcn_mfma_f32_16x16x32_bf16(af[ks], fA, dA, 0, 0, 0); dB = __builtin_amdgcn_mfma_f32_16x16x32_bf16(af[ks], fB, dB, 0, 0, 0); }
                float pA = 0.f, pB = 0.f;
#pragma unroll
                for (int r = 0; r < 4; ++r) { pA += fmaxf(dA[r], 0.f) * iw4[r]; pB += fmaxf(dB[r], 0.f) * iw4[r]; }
                auto rr = __builtin_amdgcn_permlane16_swap(__float_as_uint(pA), __float_as_uint(pB), false, false);
                key[2 * j + pr] = sortable_key(__uint_as_float(rr[0]) + __uint_as_float(rr[1]));
            }
            __syncthreads();
        }
    }
}
__device__ __forceinline__ void ph_index(Frame& F) {
    const bf16_t* IQ = (const bf16_t*)(F.outb + OUT_IQ); const bf16_t* IK = (const bf16_t*)(F.outb + OUT_IK); const float* IW = (const float*)(F.outb + OUT_IW);
    u64* MASK = (u64*)(F.outb + OUT_MASK);
    char* lds = (char*)(unsigned char*)F.lds;
    const int tid = F.tid, lane = F.lane, sub = lane & 15, kg = lane >> 4;
    for (int item = F.bid; item < NTOK / 16; item += F.G) {
        const int tokw = (((item & 255) >> 3) << 11) + (((item & 7) + 8 * (item >> 8)) << 4) + F.wave * 2, b = tokw >> 11, pos0 = tokw & 2047, nkb = (pos0 >> 6) + 1;
        u64* mrow = MASK + (size_t)tokw * 32;
        if (nkb <= 4) { if ((lane & 31) < nkb) mrow[(lane >> 5) * 32 + (lane & 31)] = ~0ull; continue; }
        bf16x8 af[2];
        { const bf16_t* ap = IQ + (size_t)(tokw + (sub >> 3)) * 512 + (sub & 7) * 64 + kg * 8;
#pragma unroll
          for (int ks = 0; ks < 2; ++ks) af[ks] = *(const bf16x8*)(ap + ks * 32); }
        const f32x4 iw4 = *(const f32x4*)(IW + (size_t)(tokw + (lane >> 5)) * 8 + 4 * (kg & 1));
        unsigned key[64];
#pragma unroll
        for (int m = 0; m < 64; ++m) key[m] = 0u;
        const bf16_t* kvsrc = IK + ((size_t)b * SEQ + (tid >> 3)) * 64 + (tid & 7) * 8;
        u32x4 stg[8];
#pragma unroll
        for (int i = 0; i < 8; ++i) stg[i] = (i < nkb) ? *(const u32x4*)(kvsrc + (size_t)i * 64 * 64) : (u32x4){0u, 0u, 0u, 0u};
        __syncthreads();
        *(u32x4*)(lds + (tid >> 3) * idx::KST + (tid & 7) * 16) = stg[0];
        __syncthreads();
        const int ng = (nkb + 7) >> 3;
        index_scores8<0>(key, af, iw4, kvsrc, lds, nkb, stg, tid);
        if (ng > 1) index_scores8<8>(key, af, iw4, kvsrc, lds, nkb, stg, tid);
        if (ng > 2) index_scores8<16>(key, af, iw4, kvsrc, lds, nkb, stg, tid);
        if (ng > 3) index_scores8<24>(key, af, iw4, kvsrc, lds, nkb, stg, tid);
        if (ng == 1) topk2_select_write<1>(key, nkb, mrow, lane);
        else if (ng == 2) topk2_select_write<2>(key, nkb, mrow, lane);
        else if (ng == 3) topk2_select_write<3>(key, nkb, mrow, lane);
        else topk2_select_write<4>(key, nkb, mrow, lane);
    }
}

namespace att {
constexpr int KVBLK = 64;
constexpr int SHM_V = KVBLK * 128 * 2, SHM_K = SHM_V;
constexpr int OFF_V = 0, OFF_K = 2 * SHM_V, OFF_WS = 2 * SHM_V + 2 * SHM_K, OFF_BT = OFF_WS + NWAVES * 64 * 4;
#define KSWZ(row, colB) ((row) * 256 + ((colB) ^ (((row) & 7) << 4)))
__device__ __forceinline__ int crow(int r, int hi) { return (r & 3) + 8 * (r >> 2) + 4 * hi; }
__device__ __forceinline__ int v_st(int k, int c) { const int kk = (k & ~0xC) | ((k & 4) << 1) | ((k & 8) >> 1); return ((kk >> 3) * 4 + (c >> 5)) * 512 + ((kk & 7) * 32 + (c & 31)) * 2; }
__device__ __forceinline__ int v_rd_base(int lane) { return ((lane & 3) << 3) | (((lane >> 2) & 3) << 6) | (((lane >> 4) & 1) << 5) | (((lane >> 5) & 1) << 8); }
constexpr int v_rd_off(int d0, int ks, int half) { return d0 * 512 + ks * 4096 + half * 2048; }
template <int OFF> __device__ __forceinline__ s16x4 tr_read(int vb) { s16x4 r; asm volatile("ds_read_b64_tr_b16 %0, %1 offset:%2" : "=&v"(r) : "v"(vb), "i"(OFF) : "memory"); return r; }
template <int D0> __device__ __forceinline__ void pv_one(f32x16& od, int vb, bf16x8 pa0, bf16x8 pa1, bf16x8 pa2, bf16x8 pa3) {
    const s16x4 l0 = tr_read<v_rd_off(D0, 0, 0)>(vb), h0 = tr_read<v_rd_off(D0, 0, 1)>(vb), l1 = tr_read<v_rd_off(D0, 1, 0)>(vb), h1 = tr_read<v_rd_off(D0, 1, 1)>(vb);
    const s16x4 l2 = tr_read<v_rd_off(D0, 2, 0)>(vb), h2 = tr_read<v_rd_off(D0, 2, 1)>(vb), l3 = tr_read<v_rd_off(D0, 3, 0)>(vb), h3 = tr_read<v_rd_off(D0, 3, 1)>(vb);
    asm volatile("s_waitcnt lgkmcnt(0)" ::: "memory"); SBAR();
#define PK(L, H) (bf16x8){L[0], L[1], L[2], L[3], H[0], H[1], H[2], H[3]}
    od = __builtin_amdgcn_mfma_f32_32x32x16_bf16(pa0, PK(l0, h0), od, 0, 0, 0);
    od = __builtin_amdgcn_mfma_f32_32x32x16_bf16(pa1, PK(l1, h1), od, 0, 0, 0);
    od = __builtin_amdgcn_mfma_f32_32x32x16_bf16(pa2, PK(l2, h2), od, 0, 0, 0);
    od = __builtin_amdgcn_mfma_f32_32x32x16_bf16(pa3, PK(l3, h3), od, 0, 0, 0);
#undef PK
}
__device__ __forceinline__ void qkt(f32x16& p0, f32x16& p1, const char* Ks, const bf16x8* qr, int r32, int hi) {
    p0 = f32x16{}; p1 = f32x16{};
    int rv = r32; asm volatile("" : "+v"(rv));
    const char* kb = Ks + rv * 256; const int swz = ((rv & 7) << 4) ^ (hi * 16);
#pragma unroll
    for (int d0 = 0; d0 < 8; ++d0) { const char* ka = kb + ((d0 * 32) ^ swz);
        const bf16x8 b0 = *reinterpret_cast<const bf16x8*>(ka);
        const bf16x8 b1 = *reinterpret_cast<const bf16x8*>(ka + 8192);
        p0 = __builtin_amdgcn_mfma_f32_32x32x16_bf16(b0, qr[d0], p0, 0, 0, 0);
        p1 = __builtin_amdgcn_mfma_f32_32x32x16_bf16(b1, qr[d0], p1, 0, 0, 0); }
}
__device__ __forceinline__ void attn_item(Frame& F, int b, int q0, char* lds) {
    const bf16_t* Q = (const bf16_t*)(F.ws + WS_Q); const bf16_t* KV = (const bf16_t*)(F.outb + OUT_KV); const u64* MASK = (const u64*)(F.outb + OUT_MASK);
    bf16_t* OA = (bf16_t*)(F.outb + OUT_OA);
    const int tid = F.tid, wid = F.wave, lane = F.lane, r32 = lane & 31, hi = lane >> 5;
    char* V_lds = lds + OFF_V; char* K_lds = lds + OFF_K;
    float* wsl = (float*)(lds + OFF_WS) + wid * 64; float* li_l = wsl; float* al_l = wsl + 32;
    const float* btab = (const float*)(lds + OFF_BT);
    constexpr float C = 0.088388347648318440f * LOG2E;
    float m_reg = -1e30f, l_reg = 0.f; f32x16 o[4] = {}; bf16x8 qr[8];
    const size_t tokq = (size_t)b * SEQ + q0 + r32;
    { const bf16_t* Qw = Q + tokq * 1024 + wid * 128 + hi * 8;
#pragma unroll
      for (int d0 = 0; d0 < 8; ++d0) qr[d0] = *(const bf16x8*)(Qw + d0 * 16); }
    const u64* mq = MASK + tokq * 32;
    const int sr = tid >> 4, sc = (tid & 15) * 8;
    const int vb0 = (int)(uintptr_t)V_lds + v_rd_base(lane);
    const bf16_t* Kb = KV + (size_t)b * SEQ * 128;
    const int NT = (q0 >> 6) + 1;
    const float bfar = btab[wid];
    bf16x8 s0, s1;
#define SLOAD(k0) do { s0 = *(const bf16x8*)(Kb + (size_t)((k0) + sr) * 128 + sc); s1 = *(const bf16x8*)(Kb + (size_t)((k0) + 32 + sr) * 128 + sc); } while (0)
#define SWRITE(bf) do { int srv = sr; asm volatile("" : "+v"(srv)); const int kc = sc * 2; const int v0a = v_st(srv, sc), k0a = KSWZ(srv, kc); \
        *(bf16x8*)(V_lds + (bf) * SHM_V + v0a) = s0; *(bf16x8*)(V_lds + (bf) * SHM_V + v0a + 8192) = s1; \
        *(bf16x8*)(K_lds + (bf) * SHM_K + k0a) = s0; *(bf16x8*)(K_lds + (bf) * SHM_K + k0a + 8192) = s1; } while (0)
    __syncthreads();
    SLOAD(0); VM_WAIT(); SWRITE(0); __syncthreads();
    for (int j = 0; j < NT; ++j) {
        const int bf = j & 1;
        if (j + 1 < NT) SLOAD((j + 1) * KVBLK);
        const u64 mw = mq[j];
        f32x16 p0, p1;
        qkt(p0, p1, K_lds + bf * SHM_K, qr, r32, hi);
        const unsigned w0 = (unsigned)(mw >> (4 * hi)), w1 = (unsigned)(mw >> (32 + 4 * hi));
        const int relmax = j * KVBLK + 63 - q0;
        if (relmax <= -91) {
#pragma unroll
            for (int r = 0; r < 16; ++r) { const int cb = (r & 3) + 8 * (r >> 2);
                const float t0 = fmaf(p0[r], C, bfar), t1 = fmaf(p1[r], C, bfar); p0[r] = ((w0 >> cb) & 1u) ? t0 : -1e30f; p1[r] = ((w1 >> cb) & 1u) ? t1 : -1e30f; }
        } else {
            const float* bp = btab + (j * KVBLK + 4 * hi - (q0 + r32) + 185) * 8 + wid;
#pragma unroll
            for (int r4 = 0; r4 < 4; ++r4) {
#pragma unroll
                for (int rr = 0; rr < 4; ++rr) { const int r = r4 * 4 + rr; const int cb = (r & 3) + 8 * (r >> 2);
                    const float bv0 = bp[cb * 8], bv1 = bp[(cb + 32) * 8]; const float t0 = fmaf(p0[r], C, bv0), t1 = fmaf(p1[r], C, bv1);
                    p0[r] = ((w0 >> cb) & 1u) ? t0 : -1e30f; p1[r] = ((w1 >> cb) & 1u) ? t1 : -1e30f; }
                SBAR(); }
        }
        float pmax = p0[0];
#pragma unroll
        for (int r = 1; r < 16; ++r) pmax = fmaxf(pmax, p0[r]);
#pragma unroll
        for (int r = 0; r < 16; ++r) pmax = fmaxf(pmax, p1[r]);
        { auto rr = __builtin_amdgcn_permlane32_swap(__float_as_uint(pmax), __float_as_uint(pmax), false, false); pmax = fmaxf(__uint_as_float(rr[0]), __uint_as_float(rr[1])); }
        float alpha = 1.f;
        if (!__all(pmax - m_reg <= 11.0f)) { const float mn = fmaxf(m_reg, pmax); alpha = __builtin_amdgcn_exp2f(m_reg - mn); m_reg = mn; }
        float ps = 0.f;
#pragma unroll
        for (int r = 0; r < 16; ++r) { p0[r] = __builtin_amdgcn_exp2f(p0[r] - m_reg); p1[r] = __builtin_amdgcn_exp2f(p1[r] - m_reg); ps += p0[r] + p1[r]; }
        { auto rr = __builtin_amdgcn_permlane32_swap(__float_as_uint(ps), __float_as_uint(ps), false, false); ps = __uint_as_float(rr[0]) + __uint_as_float(rr[1]); }
        l_reg = l_reg * alpha + ps;
        bf16x8 pa0, pa1, pa2, pa3;
#define PK4(P, BASE, OUT) do { unsigned a0 = cvt_pk_bf16(P[BASE + 0], P[BASE + 1]), a1 = cvt_pk_bf16(P[BASE + 2], P[BASE + 3]);   \
    unsigned b0 = cvt_pk_bf16(P[BASE + 4], P[BASE + 5]), b1 = cvt_pk_bf16(P[BASE + 6], P[BASE + 7]);                              \
    auto r0 = __builtin_amdgcn_permlane32_swap(a0, b0, false, false); auto r1 = __builtin_amdgcn_permlane32_swap(a1, b1, false, false); \
    u32x4 w = {r0[0], r1[0], r0[1], r1[1]}; OUT = *reinterpret_cast<bf16x8*>(&w); } while (0)
        PK4(p0, 0, pa0); PK4(p0, 8, pa1); PK4(p1, 0, pa2); PK4(p1, 8, pa3);
#undef PK4
        if (__any(alpha < 1.f)) { if (hi == 0) al_l[r32] = alpha; LDS_WAIT();
#pragma unroll
            for (int d = 0; d < 4; ++d)
#pragma unroll
                for (int r = 0; r < 16; ++r) o[d][r] *= al_l[crow(r, hi)]; }
        const int vb = vb0 + bf * SHM_V;
        pv_one<0>(o[0], vb, pa0, pa1, pa2, pa3); pv_one<1>(o[1], vb, pa0, pa1, pa2, pa3); pv_one<2>(o[2], vb, pa0, pa1, pa2, pa3); pv_one<3>(o[3], vb, pa0, pa1, pa2, pa3);
        if (j + 1 < NT) { VM_WAIT(); SWRITE(bf ^ 1); }
        __syncthreads();
    }
#undef SLOAD
#undef SWRITE
    if (hi == 0) li_l[r32] = l_reg; LDS_WAIT();
    bf16_t* Ow = OA + ((size_t)b * SEQ + q0 + 4 * hi) * 1024 + wid * 128 + r32;
    const float* lip = li_l + 4 * hi;
    asm volatile("" : "+v"(Ow), "+v"(lip));
#pragma unroll
    for (int r = 0; r < 16; ++r) { const int ro = (r & 3) + 8 * (r >> 2); const float rl = fast_rcp(lip[ro]);
#pragma unroll
        for (int d0 = 0; d0 < 4; ++d0) { float v = o[d0][r] * rl; if ((DBG_ATTN_ZERO == 1 && q0 < 256) || (DBG_ATTN_ZERO == 2 && q0 >= 256)) v = 0.f; Ow[ro * 1024 + d0 * 32] = (bf16_t)(cvt_pk_bf16(v, v) & 0xffffu); }
        if ((r & 3) == 3) SBAR(); }
}
}
__device__ __forceinline__ void ph_attn(Frame& F) {
    char* lds = (char*)(unsigned char*)F.lds;
    { float* bt = (float*)(lds + att::OFF_BT); const float* BT = (const float*)(F.ws + WS_BIAST); __syncthreads(); for (int i = F.tid; i < 249 * 8; i += NTHR) bt[i] = BT[i]; __syncthreads(); }
    for (int pr = F.bid; pr < NB * 32; pr += F.G) {
        const int b = pr >> 5, qb = pr & 31;
#pragma nounroll
        for (int hh = 0; hh < 2; ++hh) att::attn_item(F, b, (hh ? qb : 63 - qb) * 32, lds);
    }
}

namespace ssd {
constexpr int OFF_CS = 0, CS_ST = 272;
constexpr int OFF_BS = OFF_CS + 64 * CS_ST;
constexpr int OFF_BT = OFF_BS + 64 * CS_ST, T_ST = 144;
constexpr int OFF_XT = OFF_BT + 128 * T_ST;
constexpr int OFF_XW = OFF_XT + 64 * T_ST;
constexpr int OFF_XS = OFF_XW + 64 * T_ST;
constexpr int OFF_MT = OFF_XS + 64 * T_ST;
constexpr int OFF_HS = OFF_MT + 64 * T_ST;
constexpr int OFF_END = OFF_HS + 64 * CS_ST;
static_assert(OFF_END + 5 * 320 * 4 <= 131072, "ssd lds");
__device__ __forceinline__ f32x4 mfma16(bf16x8 a, bf16x8 b, f32x4 c) { return __builtin_amdgcn_mfma_f32_16x16x32_bf16(a, b, c, 0, 0, 0); }
__device__ __forceinline__ bf16x8 ldfrag(const char* base, int stride, int row, int k0) { return *(const bf16x8*)(base + row * stride + k0 * 2); }
}
__device__ __forceinline__ void ph_ssd(Frame& F) {
    using namespace ssd;
    char* lds = (char*)(unsigned char*)F.lds;
    const bf16_t* XBC = (const bf16_t*)(F.ws + WS_XBC); const bf16_t* ZS = (const bf16_t*)(F.ws + WS_Z); const float* DT = (const float*)(F.outb + OUT_DT);
    bf16_t* YG = (bf16_t*)(F.ws + WS_Q);
    const float* conv_w = F.a->in[9]; const float* conv_b = F.a->in[10]; const float* a_log = F.a->in[12]; const float* d_skip = F.a->in[13];
    const int tid = F.tid, wid = F.wave, lane = F.lane, fr = lane & 15, fq = lane >> 4;
    const bool stager = tid < 320; const int so = tid % 40, tg = tid / 40;
    for (int item = F.bid; item < NB * 16; item += F.G) {
        const int b = item >> 4, h = item & 15, g = h >> 2;
        const float aneg = -__expf(a_log[h]), dsk = d_skip[h];
        const int ch0 = so < 8 ? h * 64 + so * 8 : (so < 24 ? 1024 + g * 128 + (so - 8) * 8 : 1536 + g * 128 + (so - 24) * 8);
        float* CWL = (float*)(lds + OFF_END);
        __syncthreads();
        if (stager) {
#pragma unroll
            for (int j = 0; j < 4; ++j) { *(f32x4*)(CWL + j * 320 + so * 8) = *(const f32x4*)(conv_w + (size_t)j * 2048 + ch0); *(f32x4*)(CWL + j * 320 + so * 8 + 4) = *(const f32x4*)(conv_w + (size_t)j * 2048 + ch0 + 4); }
            *(f32x4*)(CWL + 4 * 320 + so * 8) = *(const f32x4*)(conv_b + ch0); *(f32x4*)(CWL + 4 * 320 + so * 8 + 4) = *(const f32x4*)(conv_b + ch0 + 4);
        }
        f32x4 hst[4];
#pragma unroll
        for (int t = 0; t < 4; ++t) hst[t] = (f32x4){0.f, 0.f, 0.f, 0.f};
        __syncthreads();
        for (int i = tid; i < 64 * CS_ST / 4; i += NTHR) ((unsigned*)(lds + OFF_HS))[i] = 0u;
        u32x4 raw[11];
        const size_t tokb = (size_t)b * SEQ;
#define SSD_LOAD(c) do { if (stager) { _Pragma("unroll") for (int i = 0; i < 11; ++i) { const int t = (c) * 64 + tg * 8 - 3 + i; \
            raw[i] = (t >= 0) ? *(const u32x4*)(XBC + (tokb + t) * 2048 + ch0) : (u32x4){0u, 0u, 0u, 0u}; } } } while (0)
        SSD_LOAD(0);
        for (int c = 0; c < 32; ++c) {
            const float dtl = DT[(tokb + c * 64 + lane) * 16 + h];
            float acs = dtl * aneg;
#pragma unroll
            for (int o = 1; o < 64; o <<= 1) { const float t = __shfl_up(acs, o); if (lane >= o) acs += t; }
            const float alast = __shfl(acs, 63);
            if (DBG_SSD_SYNC) __syncthreads();
            float dtv[8], dec[8];
#pragma unroll
            for (int t = 0; t < 8; ++t) { dtv[t] = __shfl(dtl, (tg * 8 + t) & 63); dec[t] = __expf(alast - __shfl(acs, (tg * 8 + t) & 63)); }
            if (stager) {
#pragma unroll
                for (int hq = 0; hq < 2; ++hq) {
                    float xin[11][4];
#pragma unroll
                    for (int i = 0; i < 11; ++i) { const unsigned wa = hq ? raw[i].z : raw[i].x, wb = hq ? raw[i].w : raw[i].y; xin[i][0] = bflo(wa); xin[i][1] = bfhi(wa); xin[i][2] = bflo(wb); xin[i][3] = bfhi(wb); }
                    float outv[8][4];
                    { f32x4 cwv[4]; const f32x4 cbq = *(const f32x4*)(CWL + 4 * 320 + so * 8 + hq * 4);
#pragma unroll
                      for (int j = 0; j < 4; ++j) cwv[j] = *(const f32x4*)(CWL + j * 320 + so * 8 + hq * 4);
#pragma unroll
                      for (int t = 0; t < 8; ++t)
#pragma unroll
                        for (int e = 0; e < 4; ++e) { float sacc = cbq[e];
#pragma unroll
                            for (int j = 0; j < 4; ++j) sacc += cwv[j][e] * xin[t + j][e];
                            outv[t][e] = silu_f(sacc); } }
                    if (so < 8) {
#pragma unroll
                        for (int e = 0; e < 4; ++e) { const int p = so * 8 + hq * 4 + e;
                            f32x4 x0, x1, d0, d1, w0, w1;
#pragma unroll
                            for (int t = 0; t < 4; ++t) { x0[t] = outv[t][e]; x1[t] = outv[4 + t][e]; d0[t] = x0[t] * dtv[t]; d1[t] = x1[t] * dtv[4 + t]; w0[t] = d0[t] * dec[t]; w1[t] = d1[t] * dec[4 + t]; }
                            *(u32x4*)(lds + OFF_XS + p * T_ST + tg * 16) = pack8(x0, x1);
                            *(u32x4*)(lds + OFF_XT + p * T_ST + tg * 16) = pack8(d0, d1);
                            *(u32x4*)(lds + OFF_XW + p * T_ST + tg * 16) = pack8(w0, w1); }
                    } else {
                        const bool isB = so < 24; const int n0 = (isB ? (so - 8) : (so - 24)) * 8 + hq * 4;
                        char* nat = lds + (isB ? OFF_BS : OFF_CS);
#pragma unroll
                        for (int t = 0; t < 8; ++t) { u32x2 w; w.x = cvt_pk_bf16(outv[t][0], outv[t][1]); w.y = cvt_pk_bf16(outv[t][2], outv[t][3]);
                            *(u32x2*)(nat + (tg * 8 + t) * CS_ST + n0 * 2) = w; }
                        if (isB) {
#pragma unroll
                            for (int e = 0; e < 4; ++e) { f32x4 a, bq;
#pragma unroll
                                for (int t = 0; t < 4; ++t) { a[t] = outv[t][e]; bq[t] = outv[4 + t][e]; }
                                *(u32x4*)(lds + OFF_BT + (n0 + e) * T_ST + tg * 16) = pack8(a, bq); }
                        }
                    }
                }
            }
            if (c + 1 < 32) SSD_LOAD(c + 1);
            __syncthreads();
#pragma unroll
            for (int t2 = 0; t2 < 2; ++t2) {
                const int tile = 2 * wid + t2, sb = tile >> 2, lb = tile & 3;
                f32x4 d = (f32x4){0.f, 0.f, 0.f, 0.f};
                if (sb <= lb) {
#pragma unroll
                    for (int ks = 0; ks < 4; ++ks) d = mfma16(ldfrag(lds + OFF_BS, CS_ST, sb * 16 + fr, ks * 32 + fq * 8), ldfrag(lds + OFF_CS, CS_ST, lb * 16 + fr, ks * 32 + fq * 8), d);
                    const int l = lb * 16 + fr; const float al = __shfl(acs, l);
                    f32x4 as;
#pragma unroll
                    for (int r = 0; r < 4; ++r) as[r] = __shfl(acs, sb * 16 + 4 * fq + r);
#pragma unroll
                    for (int r = 0; r < 4; ++r) { const int s = sb * 16 + 4 * fq + r; d[r] = (s <= l) ? d[r] * __expf(al - as[r]) : 0.f; }
                }
                u32x2 w; w.x = cvt_pk_bf16(d[0], d[1]); w.y = cvt_pk_bf16(d[2], d[3]);
                *(u32x2*)(lds + OFF_MT + (lb * 16 + fr) * T_ST + (sb * 16 + 4 * fq) * 2) = w;
            }
            if (DBG_SSD_SYNC) __syncthreads();
            f32x4 yacc[2];
#pragma unroll
            for (int t2 = 0; t2 < 2; ++t2) {
                const int tile = 2 * wid + t2, pb = tile >> 2, lb = tile & 3;
                f32x4 d = (f32x4){0.f, 0.f, 0.f, 0.f};
#pragma unroll
                for (int ks = 0; ks < 4; ++ks) d = mfma16(ldfrag(lds + OFF_HS, CS_ST, pb * 16 + fr, ks * 32 + fq * 8), ldfrag(lds + OFF_CS, CS_ST, lb * 16 + fr, ks * 32 + fq * 8), d);
                const float el = __expf(__shfl(acs, lb * 16 + fr));
                yacc[t2] = d * el;
            }
            __syncthreads();
#pragma unroll
            for (int t2 = 0; t2 < 2; ++t2) {
                const int tile = 2 * wid + t2, pb = tile >> 2, lb = tile & 3;
                f32x4 d = yacc[t2];
#pragma unroll
                for (int ks = 0; ks < 2; ++ks) d = mfma16(ldfrag(lds + OFF_XT, T_ST, pb * 16 + fr, ks * 32 + fq * 8), ldfrag(lds + OFF_MT, T_ST, lb * 16 + fr, ks * 32 + fq * 8), d);
                const int l = lb * 16 + fr, p0 = pb * 16 + 4 * fq; const size_t tok = tokb + c * 64 + l;
                const u32x2 zz = *(const u32x2*)(ZS + tok * 1024 + h * 64 + p0);
                const float z0 = bflo(zz.x), z1 = bfhi(zz.x), z2 = bflo(zz.y), z3 = bfhi(zz.y);
                float xs[4];
#pragma unroll
                for (int r = 0; r < 4; ++r) xs[r] = bflo((unsigned)*(const bf16_t*)(lds + OFF_XS + (p0 + r) * T_ST + l * 2));
                u32x2 w; w.x = cvt_pk_bf16((d[0] + xs[0] * dsk) * z0, (d[1] + xs[1] * dsk) * z1); w.y = cvt_pk_bf16((d[2] + xs[2] * dsk) * z2, (d[3] + xs[3] * dsk) * z3);
                *(u32x2*)(YG + tok * 1024 + h * 64 + p0) = w;
            }
            if (DBG_SSD_SYNC) __syncthreads();
            { const float dc = __expf(alast);
#pragma unroll
              for (int t = 0; t < 4; ++t) { f32x4 d = hst[t] * dc;
#pragma unroll
                  for (int ks = 0; ks < 2; ++ks) d = mfma16(ldfrag(lds + OFF_BT, T_ST, wid * 16 + fr, ks * 32 + fq * 8), ldfrag(lds + OFF_XW, T_ST, t * 16 + fr, ks * 32 + fq * 8), d);
                  hst[t] = d;
                  u32x2 w; w.x = cvt_pk_bf16(d[0], d[1]); w.y = cvt_pk_bf16(d[2], d[3]);
                  *(u32x2*)(lds + OFF_HS + (t * 16 + fr) * CS_ST + (wid * 16 + 4 * fq) * 2) = w; } }
            __syncthreads();
        }
#undef SSD_LOAD
    }
}

__device__ __forceinline__ void ph_gnorm(Frame& F) {
    bf16_t* YG = (bf16_t*)(F.ws + WS_Q);
    const int gw = F.bid * NWAVES + F.wave, NGW = F.G * NWAVES;
    for (int m = gw; m < NTOK; m += NGW) {
        u32x2* rp = (u32x2*)(YG + (size_t)m * D) + F.lane;
#pragma unroll
        for (int j = 0; j < 4; ++j) { const u32x2 w = rp[64 * j]; const float a = bflo(w.x), b = bfhi(w.x), c = bflo(w.y), d = bfhi(w.y);
            const float ss = wave_sum(a * a + b * b + c * c + d * d); const float r = 1.f / sqrtf(ss * (1.f / 256.f) + LN_EPS);
            u32x2 o; o.x = cvt_pk_bf16(a * r, b * r); o.y = cvt_pk_bf16(c * r, d * r); rp[64 * j] = o; }
    }
}

__device__ __forceinline__ void ph_router(Frame& F) {
    float* X1 = (float*)F.outb; bf16_t* U2 = (bf16_t*)(F.ws + WS_U2); const float* MOD = (const float*)(F.ws + WS_MOD);
    const float* ln1g = F.a->in[18]; const float* ln1b = F.a->in[19]; const float* w_router = F.a->in[20]; const float* b_router = F.a->in[21];
    u32x2* REG = (u32x2*)(F.ws + WS_REG); unsigned* CNT = (unsigned*)(F.ws + WS_CTL) + CW_CNT;
    LAS float* WRT = (LAS float*)F.lds;
    LAS unsigned* lcnt = (LAS unsigned*)(F.lds + LDS_AUX); LAS unsigned* lbase = lcnt + 32; LAS unsigned* ent = lcnt + 64;
    const int tid = F.tid, lane = F.lane, wid = F.wave;
    __syncthreads();
    for (int i = tid; i < 32768; i += NTHR) { const int c = i >> 5, e = i & 31; WRT[e * 1024 + c] = w_router[i]; }
    __syncthreads();
    for (int batch = F.bid; batch < NTOK / 256; batch += F.G) {
        const int hf = batch >> 7;
        if (tid < 32) lcnt[tid] = 0u;
        __syncthreads();
        for (int ti = 0; ti < 32; ++ti) {
            const int tl = wid * 32 + ti, m = batch * 256 + tl; const float* md = MOD + (size_t)(m >> 11) * 6144;
            f32x4* xr = (f32x4*)(X1 + (size_t)m * D) + lane;
            f32x4 v[4]; float s = 0.f;
#pragma unroll
            for (int j = 0; j < 4; ++j) { v[j] = xr[64 * j]; s += (v[j][0] + v[j][1]) + (v[j][2] + v[j][3]); }
            float mean = wave_sum(s) * (1.f / D), s2 = 0.f;
#pragma unroll
            for (int j = 0; j < 4; ++j) { v[j] = v[j] - mean; s2 += (v[j][0] * v[j][0] + v[j][1] * v[j][1]) + (v[j][2] * v[j][2] + v[j][3] * v[j][3]); }
            float rstd = 1.f / sqrtf(wave_sum(s2) * (1.f / D) + LN_EPS);
            s = 0.f;
#pragma unroll
            for (int j = 0; j < 4; ++j) { const f32x4 g = *((const f32x4*)ln1g + lane + 64 * j), bb = *((const f32x4*)ln1b + lane + 64 * j); v[j] = v[j] * rstd * g + bb; xr[64 * j] = v[j]; s += (v[j][0] + v[j][1]) + (v[j][2] + v[j][3]); }
            mean = wave_sum(s) * (1.f / D); s2 = 0.f;
#pragma unroll
            for (int j = 0; j < 4; ++j) { v[j] = v[j] - mean; s2 += (v[j][0] * v[j][0] + v[j][1] * v[j][1]) + (v[j][2] * v[j][2] + v[j][3] * v[j][3]); }
            rstd = 1.f / sqrtf(wave_sum(s2) * (1.f / D) + LN_EPS);
            u32x2* o8 = (u32x2*)(U2 + (size_t)m * D) + lane;
#pragma unroll
            for (int j = 0; j < 4; ++j) { const f32x4 sh = *((const f32x4*)(md + 3072) + lane + 64 * j), sc = *((const f32x4*)(md + 4096) + lane + 64 * j);
                v[j] = v[j] * rstd * (sc + 1.0f) + sh; u32x2 w; w.x = cvt_pk_bf16(v[j][0], v[j][1]); w.y = cvt_pk_bf16(v[j][2], v[j][3]);
                if (MOE_FP8) { int pk = 0; pk = __builtin_amdgcn_cvt_pk_fp8_f32(v[j][0], v[j][1], pk, false); pk = __builtin_amdgcn_cvt_pk_fp8_f32(v[j][2], v[j][3], pk, true); ((unsigned*)((unsigned char*)U2 + (size_t)m * D))[lane + 64 * j] = (unsigned)pk; }
                else o8[64 * j] = w;
                if (DBG_ROUTER_BF16) { v[j][0] = bflo(w.x); v[j][1] = bfhi(w.x); v[j][2] = bflo(w.y); v[j][3] = bfhi(w.y); } }
            float part[32];
#pragma unroll
            for (int e = 0; e < 32; ++e) { float a = 0.f;
#pragma unroll
                for (int j = 0; j < 4; ++j) { const f32x4 w = *((const LAS f32x4*)(WRT + e * 1024) + lane + 64 * j); a += (v[j][0] * w[0] + v[j][1] * w[1]) + (v[j][2] * w[2] + v[j][3] * w[3]); }
                part[e] = a; }
#pragma unroll
            for (int i = 0; i < 16; ++i) { const bool up = (lane & 32) != 0; const float keep = up ? part[i + 16] : part[i], send = up ? part[i] : part[i + 16]; part[i] = keep + __shfl_xor(send, 32); }
#pragma unroll
            for (int i = 0; i < 8; ++i) { const bool up = (lane & 16) != 0; const float keep = up ? part[i + 8] : part[i], send = up ? part[i] : part[i + 8]; part[i] = keep + __shfl_xor(send, 16); }
#pragma unroll
            for (int i = 0; i < 4; ++i) { const bool up = (lane & 8) != 0; const float keep = up ? part[i + 4] : part[i], send = up ? part[i] : part[i + 4]; part[i] = keep + __shfl_xor(send, 8); }
#pragma unroll
            for (int i = 0; i < 2; ++i) { const bool up = (lane & 4) != 0; const float keep = up ? part[i + 2] : part[i], send = up ? part[i] : part[i + 2]; part[i] = keep + __shfl_xor(send, 4); }
            { const bool up = (lane & 2) != 0; const float keep = up ? part[1] : part[0], send = up ? part[0] : part[1]; part[0] = keep + __shfl_xor(send, 2); }
            const int myexp = lane >> 1;
            float logit = part[0] + __shfl_xor(part[0], 1) + b_router[myexp];
            float tv[4]; int tix[4];
#pragma unroll
            for (int k = 0; k < 4; ++k) { float bv = logit; int bi = myexp;
#pragma unroll
                for (int o = 1; o < 64; o <<= 1) { const float ov = __shfl_xor(bv, o); const int oi = __shfl_xor(bi, o); if (ov > bv || (ov == bv && oi < bi)) { bv = ov; bi = oi; } }
                tv[k] = bv; tix[k] = bi; if (myexp == bi) logit = -INFINITY; }
            const float e1 = __expf(tv[1] - tv[0]), e2 = __expf(tv[2] - tv[0]), e3 = __expf(tv[3] - tv[0]); const float inv = 1.f / (1.f + e1 + e2 + e3);
            if (lane < 4) { const int ee = lane == 0 ? tix[0] : (lane == 1 ? tix[1] : (lane == 2 ? tix[2] : tix[3])); const float gg = (lane == 0 ? 1.f : (lane == 1 ? e1 : (lane == 2 ? e2 : e3))) * inv;
                const unsigned lp = atomicAdd((unsigned*)&lcnt[ee], 1u);
                LAS unsigned* en = ent + (tl * 4 + lane) * 3; en[0] = (unsigned)ee; en[1] = lp; en[2] = __float_as_uint(gg);
                if (DBG_CHECK == 1) { u32x2 rw; rw.x = (unsigned)ee; rw.y = __float_as_uint(gg); ((u32x2*)(F.ws + WS_DBG))[(size_t)m * 4 + lane] = rw; } }
        }
        __syncthreads();
        if (tid < 32) lbase[tid] = __hip_atomic_fetch_add(CNT + 64 * (hf * 32 + tid), lcnt[tid], __ATOMIC_RELAXED, __HIP_MEMORY_SCOPE_AGENT);
        __syncthreads();
        for (int i = tid; i < 1024; i += NTHR) { const LAS unsigned* en = ent + i * 3; const unsigned ee = en[0], pos = lbase[ee] + en[1];
            const unsigned tokl = (unsigned)(batch * 256 + (i >> 2)) - (unsigned)hf * HALF_TOK;
            u32x2 w; w.x = tokl * 4u + (unsigned)(i & 3); w.y = en[2];
            if (pos < (unsigned)REG_CAP) REG[((size_t)hf * 32 + ee) * REG_CAP + pos] = w; }
        __syncthreads();
    }
}

__device__ __forceinline__ void ph_final(Frame& F, int hf) {
    float* X1 = (float*)F.outb; const bf16_t* YB = (const bf16_t*)(F.ws + WS_YB); const float* MOD = (const float*)(F.ws + WS_MOD);
    const float* g2 = F.a->in[26]; const float* b2 = F.a->in[27];
    const int gw = F.bid * NWAVES + F.wave, NGW = F.G * NWAVES, lane = F.lane;
    for (int tl = gw; tl < HALF_TOK; tl += NGW) {
        const int m = hf * HALF_TOK + tl; const float* md = MOD + (size_t)(m >> 11) * 6144 + 5120;
        f32x4* xr = (f32x4*)(X1 + (size_t)m * D) + lane; const u32x2* yr = (const u32x2*)(YB + (size_t)tl * 4 * D) + lane;
        f32x4 v[4]; float s = 0.f;
#pragma unroll
        for (int j = 0; j < 4; ++j) { f32x4 y = (f32x4){0.f, 0.f, 0.f, 0.f};
#pragma unroll
            for (int k = 0; k < 4; ++k) { const u32x2 w = yr[k * 256 + 64 * j]; y[0] += bflo(w.x); y[1] += bfhi(w.x); y[2] += bflo(w.y); y[3] += bfhi(w.y); }
            const f32x4 gt = *((const f32x4*)md + lane + 64 * j);
            if (DBG_NO_MOE) y = (f32x4){0.f, 0.f, 0.f, 0.f};
            v[j] = xr[64 * j] * DN_ALPHA + gt * y; s += (v[j][0] + v[j][1]) + (v[j][2] + v[j][3]); }
        const float mean = wave_sum(s) * (1.f / D); float s2 = 0.f;
#pragma unroll
        for (int j = 0; j < 4; ++j) { v[j] = v[j] - mean; s2 += (v[j][0] * v[j][0] + v[j][1] * v[j][1]) + (v[j][2] * v[j][2] + v[j][3] * v[j][3]); }
        const float rstd = 1.f / sqrtf(wave_sum(s2) * (1.f / D) + LN_EPS);
#pragma unroll
        for (int j = 0; j < 4; ++j) { const f32x4 g = *((const f32x4*)g2 + lane + 64 * j), bb = *((const f32x4*)b2 + lane + 64 * j); xr[64 * j] = v[j] * rstd * g + bb; }
    }
}


__device__ __forceinline__ float block_sum(Frame& F, float v, LAS float* red) {
    v = wave_sum(v); __syncthreads(); if (F.lane == 0) red[F.wave] = v; __syncthreads();
    float s = 0.f; for (int w = 0; w < NWAVES; ++w) s += red[w]; return s;
}
__device__ __forceinline__ float block_max(Frame& F, float v, LAS float* red) {
#pragma unroll
    for (int o = 1; o < 64; o <<= 1) v = fmaxf(v, __shfl_xor(v, o));
    __syncthreads(); if (F.lane == 0) red[F.wave] = v; __syncthreads();
    float s = 0.f; for (int w = 0; w < NWAVES; ++w) s = fmaxf(s, red[w]); return s;
}
__device__ __forceinline__ void dbg_report(Frame& F, float e) { if (F.tid == 0) atomicMax((unsigned*)(F.ws + WS_CTL) + CW_DBG, __float_as_uint(e)); }
__device__ __forceinline__ void dbg_check_moe(Frame& F) {
    if (F.bid >= 64) return;
    const int tok = HALF_TOK + 509 * F.bid + 3, tokl = tok - HALF_TOK, tid = F.tid;
    LAS float* u2 = (LAS float*)F.lds; LAS float* act = u2 + 1024; LAS float* red = act + 1024; LAS float* lg = red + 16;
    const bf16_t* U2 = (const bf16_t*)(F.ws + WS_U2); const bf16_t* YB = (const bf16_t*)(F.ws + WS_YB); const u32x2* RT = (const u32x2*)(F.ws + WS_DBG);
    const float* w1 = F.a->in[22]; const float* b1 = F.a->in[23]; const float* w2 = F.a->in[24]; const float* b2 = F.a->in[25];
    __syncthreads();
    for (int i = tid; i < 1024; i += NTHR) u2[i] = bflo((unsigned)U2[(size_t)tok * 1024 + i]);
    __syncthreads();
    float y0 = 0.f, y1 = 0.f;
    for (int k = 0; k < 4; ++k) {
        const u32x2 rw = RT[(size_t)tok * 4 + k]; const int e = (int)rw.x; const float g = __uint_as_float(rw.y);
        const float* W1 = w1 + (size_t)e * 1024 * 2048; const float* W2 = w2 + (size_t)e * 1024 * 1024;
        float h0 = b1[e * 2048 + tid], h1 = b1[e * 2048 + tid + 512], h2 = b1[e * 2048 + tid + 1024], h3 = b1[e * 2048 + tid + 1536];
        for (int c = 0; c < 1024; ++c) { const float uu = u2[c]; const float* wr = W1 + (size_t)c * 2048 + tid; h0 += uu * wr[0]; h1 += uu * wr[512]; h2 += uu * wr[1024]; h3 += uu * wr[1536]; }
        __syncthreads();
        { float gg = fminf(h0, 7.f), up = fminf(fmaxf(h2, -7.f), 7.f); act[tid] = (up + 1.f) * gg / (1.f + expf(-1.702f * gg));
          gg = fminf(h1, 7.f); up = fminf(fmaxf(h3, -7.f), 7.f); act[tid + 512] = (up + 1.f) * gg / (1.f + expf(-1.702f * gg)); }
        __syncthreads();
        float a0 = b2[e * 1024 + tid], a1 = b2[e * 1024 + tid + 512];
        for (int j = 0; j < 1024; ++j) { const float aa = act[j]; a0 += aa * W2[(size_t)j * 1024 + tid]; a1 += aa * W2[(size_t)j * 1024 + tid + 512]; }
        y0 += g * a0; y1 += g * a1;
    }
    float f0 = 0.f, f1 = 0.f;
    for (int k = 0; k < 4; ++k) { f0 += bflo((unsigned)YB[((size_t)tokl * 4 + k) * 1024 + tid]); f1 += bflo((unsigned)YB[((size_t)tokl * 4 + k) * 1024 + tid + 512]); }
    const float rms = sqrtf(block_sum(F, y0 * y0 + y1 * y1, red) * (1.f / 1024.f)) + 1e-20f;
    float err = block_max(F, fmaxf(fabsf(y0 - f0), fabsf(y1 - f1)), red) / rms;
    { const float* X1 = (const float*)F.outb + (size_t)tok * 1024; const float* md = (const float*)(F.ws + WS_MOD) + (size_t)(tok >> 11) * 6144;
      const float xa = X1[tid], xb = X1[tid + 512]; const float mean = block_sum(F, xa + xb, red) * (1.f / 1024.f);
      const float da = xa - mean, db = xb - mean; const float var = block_sum(F, da * da + db * db, red) * (1.f / 1024.f); const float rstd = 1.f / sqrtf(var + LN_EPS);
      __syncthreads();
      u2[tid] = da * rstd * (1.f + md[4096 + tid]) + md[3072 + tid]; u2[tid + 512] = db * rstd * (1.f + md[4096 + tid + 512]) + md[3072 + tid + 512];
      __syncthreads();
      if (tid < 32) { float a = F.a->in[21][tid]; for (int c = 0; c < 1024; ++c) a += u2[c] * F.a->in[20][c * 32 + tid]; lg[tid] = a; }
      __syncthreads();
      if (tid == 0) { unsigned want = 0u, got = 0u; float l2[32]; for (int i = 0; i < 32; ++i) l2[i] = lg[i];
          for (int k = 0; k < 4; ++k) { int bi = 0; for (int i = 1; i < 32; ++i) if (l2[i] > l2[bi]) bi = i; want |= 1u << bi; l2[bi] = -INFINITY; got |= 1u << RT[(size_t)tok * 4 + k].x; }
          lg[32] = (want != got) ? 1.f : 0.f; }
      __syncthreads();
      if (lg[32] != 0.f) err = 50.f; }
    dbg_report(F, err);
}
__device__ __forceinline__ void dbg_check_ssd(Frame& F) {
    if (F.bid >= 2) return;
    const int b = F.bid ? 20 : 5, h = F.bid ? 14 : 3, g = h >> 2, tid = F.tid, p = tid >> 3, ng = tid & 7;
    LAS float* red = (LAS float*)F.lds; LAS float* cv = red + 16;
    const bf16_t* XBC = (const bf16_t*)(F.ws + WS_XBC); const bf16_t* ZS = (const bf16_t*)(F.ws + WS_Z); const float* DT = (const float*)(F.outb + OUT_DT); const bf16_t* YG = (const bf16_t*)(F.ws + WS_Q);
    const float* cw = F.a->in[9]; const float* cb = F.a->in[10]; const float aneg = -expf(F.a->in[12][h]), dsk = F.a->in[13][h];
    const int mych = tid < 64 ? h * 64 + tid : (tid < 192 ? 1024 + g * 128 + (tid - 64) : 1536 + g * 128 + (tid - 192));
    float w0 = 0.f, w1 = 0.f, w2 = 0.f, w3 = 0.f, wb = 0.f;
    if (tid < 320) { w0 = cw[0 * 2048 + mych]; w1 = cw[1 * 2048 + mych]; w2 = cw[2 * 2048 + mych]; w3 = cw[3 * 2048 + mych]; wb = cb[mych]; }
    float x0 = 0.f, x1 = 0.f, x2 = 0.f;
    float hs[16];
#pragma unroll
    for (int i = 0; i < 16; ++i) hs[i] = 0.f;
    float emax = 0.f, ssq = 0.f, nbad = 0.f; int tmax = 0;
    for (int t = 0; t < SEQ; ++t) {
        const size_t tok = (size_t)b * SEQ + t;
        __syncthreads();
        if (DBG_HYP == 1 && (t & 63) == 0) { x0 = 0.f; x1 = 0.f; x2 = 0.f; }
        if (tid < 320) { const float x3 = bflo((unsigned)XBC[tok * 2048 + mych]); const float s = wb + w0 * x0 + w1 * x1 + w2 * x2 + w3 * x3; cv[tid] = s / (1.f + expf(-s)); x0 = x1; x1 = x2; x2 = x3; }
        __syncthreads();
        const float xv = cv[p], dt = DT[tok * 16 + h], dec = expf(dt * aneg);
        float yp = 0.f;
#pragma unroll
        for (int i = 0; i < 16; ++i) { const int n = ng * 16 + i; hs[i] = hs[i] * dec + dt * xv * cv[64 + n]; yp += cv[192 + n] * hs[i]; }
        yp += __shfl_xor(yp, 1); yp += __shfl_xor(yp, 2); yp += __shfl_xor(yp, 4);
        const float yv = (yp + xv * dsk) * bflo((unsigned)ZS[tok * 1024 + h * 64 + p]);
        const float yf = bflo((unsigned)YG[tok * 1024 + h * 64 + p]);
        if (ng == 0) { const float er = fabsf(yv - yf); if (er > emax) { emax = er; tmax = t; } ssq += yv * yv; if (er > 0.25f && (DBG_SUB < 5 || (DBG_SUB == 5 && (t & 63) == 0) || (DBG_SUB == 6 && (t & 63) == 1) || (DBG_SUB == 7 && (t & 63) == 32))) nbad += 1.f; }
    }
    const float rms = sqrtf(block_sum(F, ssq, red) / (64.f * SEQ)) + 1e-20f;
    const float M = block_max(F, emax, red);
    if (DBG_SUB == 0) dbg_report(F, M / rms);
    else if (DBG_SUB == 1) dbg_report(F, block_sum(F, nbad, red) / (64.f * SEQ));
    else if (DBG_SUB >= 5) dbg_report(F, block_sum(F, nbad, red) / (64.f * 32.f));
    else { __syncthreads(); if (ng == 0 && emax == M) red[12] = (float)(DBG_SUB == 2 ? ((tmax & 63) >> 1) : (DBG_SUB == 3 ? (tmax >> 6) : (p >> 1))); __syncthreads();
        if (F.bid == 0) dbg_report(F, powf(10.f, 2.f * (0.05f + 0.05f * red[12]) - 4.f)); }
}
__device__ __forceinline__ void dbg_check_attn(Frame& F) {
    if (F.bid >= 32) return;
    const int b = (F.bid * 7 + 3) & 31, pos = 300 + F.bid * 53, nadm = ((pos >> 6) + 1) * 64, tid = F.tid, lane = F.lane, hd = F.wave;
    const size_t tq = (size_t)b * SEQ + pos;
    LAS float* sc = (LAS float*)F.lds; LAS unsigned char* sel = (LAS unsigned char*)(sc + 2048); LAS float* lgt = (LAS float*)(sel + 2048); LAS float* red = lgt + 8 * 2048; LAS float* misc = red + 16;
    const bf16_t* IQ = (const bf16_t*)(F.outb + OUT_IQ); const bf16_t* IK = (const bf16_t*)(F.outb + OUT_IK); const float* IW = (const float*)(F.outb + OUT_IW);
    const bf16_t* Q = (const bf16_t*)(F.ws + WS_Q); const bf16_t* KV = (const bf16_t*)(F.outb + OUT_KV); const bf16_t* OA = (const bf16_t*)(F.outb + OUT_OA); const u64* MASK = (const u64*)(F.outb + OUT_MASK);
    __syncthreads();
    for (int k = tid; k < nadm; k += NTHR) { float s = 0.f;
        for (int hh = 0; hh < 8; ++hh) { float d = 0.f; for (int c = 0; c < 64; ++c) d += bflo((unsigned)IQ[tq * 512 + hh * 64 + c]) * bflo((unsigned)IK[((size_t)b * SEQ + k) * 64 + c]); s += fmaxf(d, 0.f) * IW[tq * 8 + hh]; }
        sc[k] = s + 0.0f; }
    __syncthreads();
    float nbad = 0.f;
    for (int k = tid; k < nadm; k += NTHR) { const float s = sc[k]; int rank = 0; for (int j = 0; j < nadm; ++j) { const float t = sc[j]; rank += (t > s || (t == s && j < k)) ? 1 : 0; }
        const unsigned char se = rank < 256 ? 1 : 0; sel[k] = se; const unsigned mb = (unsigned)((MASK[tq * 32 + (k >> 6)] >> (k & 63)) & 1ull); if (mb != se) nbad += 1.f; }
    __syncthreads();
    const float nbad_t = block_sum(F, nbad, red);
    LAS float* lw = lgt + hd * 2048; float mx = -INFINITY;
    for (int k = lane; k < nadm; k += 64) { float l = -INFINITY;
        if (sel[k]) { float d = 0.f; for (int c = 0; c < 128; ++c) d += bflo((unsigned)Q[tq * 1024 + hd * 128 + c]) * bflo((unsigned)KV[((size_t)b * SEQ + k) * 128 + c]);
            const int rel = k - pos, n = rel < 0 ? -rel : rel; const float nf = (float)(n > 1 ? n : 1); int large = 8 + (int)(logf(nf / 8.0f) / 2.7725887f * 8.0f); if (large > 15) large = 15;
            const int bucket = (rel > 0 ? 16 : 0) + (n < 8 ? n : large);
            l = d * 0.088388347648318440f + F.a->in[8][bucket * 8 + hd]; }
        lw[k] = l; mx = fmaxf(mx, l); }
#pragma unroll
    for (int o = 1; o < 64; o <<= 1) mx = fmaxf(mx, __shfl_xor(mx, o));
    float den = 0.f;
    for (int k = lane; k < nadm; k += 64) { const float pp = expf(lw[k] - mx); lw[k] = pp; den += pp; }
    den = wave_sum(den);
    float emax = 0.f, ssq = 0.f;
    for (int c2 = 0; c2 < 2; ++c2) { const int c = lane + 64 * c2; float o = 0.f; for (int k = 0; k < nadm; ++k) { const float pp = lw[k]; if (pp != 0.f) o += pp * bflo((unsigned)KV[((size_t)b * SEQ + k) * 128 + c]); }
        o /= den; const float of = bflo((unsigned)OA[tq * 1024 + hd * 128 + c]); emax = fmaxf(emax, fabsf(o - of)); ssq += o * o; }
    const float rms = sqrtf(block_sum(F, ssq, red) * (1.f / 1024.f)) + 1e-20f;
    float err = block_max(F, emax, red) / rms;
    (void)misc;
    if (nbad_t > 0.f) err = 10.f + nbad_t;
    dbg_report(F, err);
}
__device__ __forceinline__ void dbg_emit(Frame& F) {
    float* out = (float*)F.outb;
    for (size_t i = (size_t)F.bid * NTHR + F.tid; i < (size_t)NTOK * D / 4; i += (size_t)F.G * NTHR) ((f32x4*)out)[i] = (f32x4){0.f, 0.f, 0.f, 0.f};
    __syncthreads();
    if (F.bid == 0 && F.tid == 0) { const float e = __uint_as_float(__hip_atomic_load((unsigned*)(F.ws + WS_CTL) + CW_DBG, __ATOMIC_RELAXED, __HIP_MEMORY_SCOPE_AGENT));
        float code = (log10f(fmaxf(e, 1e-30f)) + 4.f) * 0.5f; code = fminf(fmaxf(rintf(code * 20.f) * 0.05f, 0.05f), 3.0f);
        out[0] = sqrtf(67108864.f * 1.01f * (powf(10.f, code) - 1.f)); }
}

constexpr int NPHASE = 17;
__global__ void __launch_bounds__(NTHR, 2) fwd(Args args) {
    extern __shared__ __attribute__((aligned(16))) unsigned char lds_raw[];
    Frame F;
    F.lds = (LAS unsigned char*)lds_raw;
    F.tid = threadIdx.x; F.lane = F.tid & 63; F.wave = __builtin_amdgcn_readfirstlane(F.tid >> 6); F.G = gridDim.x; F.bid = blockIdx.x;
    F.a = &args;
    F.ws = args.ws; F.outb = (unsigned char*)args.out;
    volatile LAS unsigned* MISCW = (volatile LAS unsigned*)(F.lds + LDS_MISC);
    if (F.tid < 64) MISCW[F.tid] = 0u;
    __syncthreads();
    XcdBarrier bar; bar.bar = (unsigned*)(F.ws + WS_CTL) + CW_BAR; bar.x = 0; bar.st = nullptr;
#if MK_ONE
    bar = xcd_barrier_post((unsigned*)(F.ws + WS_CTL) + CW_BAR, MISCW + 8);
#define GRID_BAR() xcd_barrier(bar)
#else
#define GRID_BAR() do { } while (0)
#endif
    const int lo = args.ph_lo, hi = args.ph_hi;
#ifndef PHM
#define PHM (0xFFFFFFFFu & ~(DBG_NO_ATTN ? 0x30u : 0u) & ~(DBG_NO_SSD ? 0xC0u : 0u))
#endif
#define IN(k) (((PHM >> (k)) & 1u) && lo <= (k) && (k) < hi)
#define SEAM(k) do { if ((k) + 1 < hi) GRID_BAR(); } while (0)

    if (IN(0)) { ph_prologue(F); if (DBG_TWICE & 1u) { GRID_BAR(); ph_prologue(F); } SEAM(0); }
    if (IN(1)) { ph_ln1(F); if (DBG_TWICE & 2u) { GRID_BAR(); ph_ln1(F); } SEAM(1); }
    if (IN(2)) {
        SchedPlain S; S.o.init(NTOK, NPROJ, F.G, F.bid); S.A = (const char*)(F.outb + OUT_U); S.Bt = (const char*)(F.ws + WS_WIN);
        EpiProj E{(bf16_t*)(F.ws + WS_Q), (bf16_t*)(F.outb + OUT_IQ), (bf16_t*)(F.ws + WS_Z), (bf16_t*)(F.ws + WS_XBC), (bf16_t*)(F.ws + WS_GA), (bf16_t*)(F.ws + WS_GB), (float*)(F.outb + OUT_MISC)};
        pg8::gemm_phase<EpiProj, SchedPlain, false>(F.lds, S, E);
        if (DBG_TWICE & 4u) { GRID_BAR(); pg8::gemm_phase<EpiProj, SchedPlain, false>(F.lds, S, E); }
        SEAM(2);
    }
    if (IN(3)) { ph_misc(F); if (DBG_TWICE & 8u) { GRID_BAR(); ph_misc(F); } SEAM(3); }
    if (IN(4)) { ph_index(F); if (DBG_TWICE & 16u) { GRID_BAR(); ph_index(F); } SEAM(4); }
    if (IN(5)) { ph_attn(F); if (DBG_TWICE & 32u) { GRID_BAR(); ph_attn(F); } SEAM(5); if (DBG_CHECK == 3) { dbg_check_attn(F); GRID_BAR(); } }
    if (IN(6)) { ph_ssd(F); if (DBG_TWICE & 64u) { GRID_BAR(); ph_ssd(F); } SEAM(6); if (DBG_CHECK == 2) { dbg_check_ssd(F); GRID_BAR(); } }
    if (IN(7)) { ph_gnorm(F); SEAM(7); }
    if (IN(8)) {
        SchedPlain S; S.o.init(NTOK, 1024, F.G, F.bid); S.A = (const char*)(F.outb + OUT_OA); S.Bt = (const char*)(F.ws + WS_WPA);
        EpiGate<0> E{(const bf16_t*)(F.ws + WS_GA), nullptr, (bf16_t*)(F.ws + WS_Z)};
        pg8::gemm_phase<EpiGate<0>, SchedPlain, false>(F.lds, S, E);
        SEAM(8);
    }
    if (IN(9)) {
        SchedPlain S; S.o.init(NTOK, 1024, F.G, F.bid); S.A = (const char*)(F.ws + WS_Q); S.Bt = (const char*)(F.ws + WS_WPB);
        EpiGate<1> E{(const bf16_t*)(F.ws + WS_GB), (const bf16_t*)(F.ws + WS_Z), (bf16_t*)(F.ws + WS_XBC)};
        pg8::gemm_phase<EpiGate<1>, SchedPlain, false>(F.lds, S, E);
        SEAM(9);
    }
    if (IN(10)) {
        SchedPlain S; S.o.init(NTOK, 1024, F.G, F.bid); S.A = (const char*)(F.ws + WS_XBC); S.Bt = (const char*)(F.ws + WS_WOUT);
        EpiOut E{F.a->in[0], (const float*)(F.ws + WS_MOD), (float*)F.outb};
        pg8::gemm_phase<EpiOut, SchedPlain, false>(F.lds, S, E);
        SEAM(10);
    }
    if (IN(11)) { ph_router(F); SEAM(11); }
#pragma unroll
    for (int hf = 0; hf < 2; ++hf) {
        const int p0 = 12 + hf * 2;
        if (IN(p0)) {
            if (hf == 1) ph_final(F, 0);
            MoeTab T = moe_tables(F, hf);
            SchedMoe<8, true> S{T, F.G, F.bid, hf, (const char*)(F.ws + WS_U2), (const char*)(F.ws + WS_W1), (const u32x2*)(F.ws + WS_REG)};
            EpiMoe1 E{F.a->in[23], (bf16_t*)(F.ws + WS_ACT)};
            pg8::gemm_phase<EpiMoe1, SchedMoe<8, true>, true, MOE_RB / 2, MOE_FP8 != 0>(F.lds, S, E);
            if ((DBG_TWICE & 4096u) && hf == 0) { GRID_BAR(); pg8::gemm_phase<EpiMoe1, SchedMoe<8, true>, true, MOE_RB / 2, MOE_FP8 != 0>(F.lds, S, E); }
            SEAM(p0);
        }
        if (IN(p0 + 1)) {
            MoeTab T = moe_tables(F, hf);
            SchedMoe<4, false> S{T, F.G, F.bid, hf, (const char*)(F.ws + WS_ACT), (const char*)(F.ws + WS_W2), (const u32x2*)(F.ws + WS_REG)};
            EpiMoe2 E{F.a->in[25], (bf16_t*)(F.ws + WS_YB), (const u32x2*)(F.ws + WS_REG), T, hf};
            pg8::gemm_phase<EpiMoe2, SchedMoe<4, false>, false, MOE_RB / 2, MOE_FP8 != 0>(F.lds, S, E);
            if ((DBG_TWICE & 8192u) && hf == 0) { GRID_BAR(); pg8::gemm_phase<EpiMoe2, SchedMoe<4, false>, false, MOE_RB / 2, MOE_FP8 != 0>(F.lds, S, E); }
            SEAM(p0 + 1);
            if (DBG_CHECK == 1 && hf == 1) { dbg_check_moe(F); GRID_BAR(); }
        }
    }
    if (IN(16)) { ph_final(F, 1); }
    if (DBG_CHECK) { GRID_BAR(); dbg_emit(F); }
#undef IN
#undef SEAM
}

extern "C" void kernel_launch(void* const* d_in, const int* in_sizes, int n_in, void* d_out, int out_size, void* d_ws, size_t ws_size, hipStream_t stream) {
    static int grid = 0;
    if (grid == 0) {
        if (n_in != 28 || in_sizes[0] != NTOK * D || out_size != NTOK * D || ws_size < WS_END) { fprintf(stderr, "kernel_launch: shape mismatch (n_in %d, in0 %d, out %d, ws %zu)\n", n_in, n_in > 0 ? in_sizes[0] : -1, out_size, ws_size); grid = -1; return; }
        int dev = 0, cus = 0, per_cu = 0;
        if (hipGetDevice(&dev) != hipSuccess || hipDeviceGetAttribute(&cus, hipDeviceAttributeMultiprocessorCount, dev) != hipSuccess) { grid = -1; return; }
        if (hipFuncSetAttribute((const void*)fwd, hipFuncAttributeMaxDynamicSharedMemorySize, LDS_BYTES) != hipSuccess) { fprintf(stderr, "kernel_launch: hipFuncSetAttribute failed\n"); grid = -1; return; }
        if (hipOccupancyMaxActiveBlocksPerMultiprocessor(&per_cu, (const void*)fwd, NTHR, LDS_BYTES) != hipSuccess || per_cu < 1) fprintf(stderr, "kernel_launch: occupancy query reports %d\n", per_cu);
        (void)hipGetLastError();
        grid = cus;
    }
    if (grid < 0) return;
    if (hipMemsetAsync((char*)d_ws + WS_CTL, 0, CTL_ZERO_BYTES, stream) != hipSuccess) { fprintf(stderr, "kernel_launch: memset failed\n"); return; }
    Args a{};
    for (int i = 0; i < 28; ++i) a.in[i] = (const float*)d_in[i];
    a.out = (float*)d_out; a.ws = (unsigned char*)d_ws;
    const int nph = NPHASE < MK_PH_HI ? NPHASE : MK_PH_HI;
#if MK_ONE
    a.ph_lo = 0; a.ph_hi = nph;
    hipLaunchKernelGGL(fwd, dim3(grid), dim3(NTHR), LDS_BYTES, stream, a);
#else
    for (int p = 0; p < nph; ++p) { a.ph_lo = p; a.ph_hi = p + 1; hipLaunchKernelGGL(fwd, dim3(grid), dim3(NTHR), LDS_BYTES, stream, a); }
#endif
    const hipError_t le = hipPeekAtLastError();
    if (le != hipSuccess) fprintf(stderr, "kernel_launch: launch failed: %s\n", hipGetErrorName(le));
}
```

```cpp
#include <hip/hip_runtime.h>
#include <cstdio>
#include <cstdint>

#ifndef MK_ONE
#define MK_ONE 1
#endif
#ifndef DBG_NO_ATTN
#define DBG_NO_ATTN 0
#endif
#ifndef DBG_ATTN_ZERO
#define DBG_ATTN_ZERO 0
#endif
#ifndef DBG_IQ_TRUNC
#define DBG_IQ_TRUNC 0
#endif
#ifndef DBG_ROUTER_BF16
#define DBG_ROUTER_BF16 0
#endif
#ifndef DBG_CHECK
#define DBG_CHECK 0
#endif
#ifndef DBG_SKIP_BODY
#define DBG_SKIP_BODY 0
#endif
#ifndef DBG_SUB
#define DBG_SUB 0
#endif
#ifndef DBG_SSD_SYNC
#define DBG_SSD_SYNC 0
#endif
#ifndef DBG_HYP
#define DBG_HYP 0
#endif
#ifndef DBG_TWICE
#define DBG_TWICE 0u
#endif
#ifndef DBG_NO_SSD
#define DBG_NO_SSD 0
#endif
#ifndef DBG_NO_MOE
#define DBG_NO_MOE 0
#endif
#ifndef MOE_FP8
#define MOE_FP8 1
#endif
#ifndef MK_PH_HI
#define MK_PH_HI 99
#endif

#define LAS __attribute__((address_space(3)))
#define GAS __attribute__((address_space(1)))
typedef unsigned short bf16_t;
typedef short bf16x8 __attribute__((ext_vector_type(8)));
typedef short s16x4 __attribute__((ext_vector_type(4)));
typedef float f32x2 __attribute__((ext_vector_type(2)));
typedef float f32x4 __attribute__((ext_vector_type(4)));
typedef float f32x16 __attribute__((ext_vector_type(16)));
typedef unsigned u32x2 __attribute__((ext_vector_type(2)));
typedef unsigned u32x4 __attribute__((ext_vector_type(4)));
typedef unsigned long long u64;

constexpr int NB = 32, SEQ = 2048, D = 1024, NTOK = NB * SEQ;
constexpr int NWAVES = 8, NTHR = 512;
constexpr int NPROJ = 6912;
constexpr int NEXP = 32, HALF_TOK = NTOK / 2, REG_CAP = HALF_TOK;
constexpr int ACT_ROWS = HALF_TOK * 4 + NEXP * 256;
constexpr float LN_EPS = 1e-5f;
constexpr float DN_ALPHA = 1.189207115002721f;
constexpr float LOG2E = 1.4426950408889634f;

constexpr size_t MiB = 1u << 20;
constexpr size_t WS_CTL = 0, CTL_ZERO_BYTES = 1 * MiB;
constexpr size_t WS_MOD = 1 * MiB;
constexpr size_t WS_BIAST = 1 * MiB + 800 * 1024;
constexpr size_t WS_WIN = 2 * MiB;
constexpr size_t WS_WPA = 16 * MiB, WS_WPB = 18 * MiB, WS_WOUT = 20 * MiB;
constexpr size_t WS_W1 = 24 * MiB;
constexpr size_t WS_W2 = 152 * MiB;
constexpr size_t WS_Q = 216 * MiB;
constexpr size_t WS_Z = 344 * MiB;
constexpr size_t WS_XBC = 472 * MiB;
constexpr size_t WS_GA = 728 * MiB, WS_GB = 856 * MiB;
constexpr size_t WS_U2 = 216 * MiB;
constexpr size_t WS_REG = 344 * MiB;
constexpr size_t WS_ACT = 360 * MiB;
constexpr size_t WS_YB = 632 * MiB;
constexpr size_t WS_END = 888 * MiB;
constexpr size_t WS_DBG = 888 * MiB;
constexpr size_t OUT_U = 0, OUT_MISC = 128 * MiB, OUT_IQ = 192 * MiB;
constexpr size_t OUT_KV = 0, OUT_IK = 16 * MiB, OUT_IW = 24 * MiB, OUT_DT = 26 * MiB, OUT_MASK = 32 * MiB, OUT_OA = 64 * MiB;
constexpr int CW_BAR = 4096, CW_CNT = 16384, CW_DBG = 24576;

constexpr int LDS_BYTES = 160 * 1024;
constexpr int LDS_AUX = 131072;
constexpr int LDS_MISC = LDS_BYTES - 256;

#define LDS_WAIT() asm volatile("s_waitcnt lgkmcnt(0)" ::: "memory")
#define VM_WAIT() asm volatile("s_waitcnt vmcnt(0)" ::: "memory")
#define SBAR() __builtin_amdgcn_sched_barrier(0)
typedef __bf16 bf16x2_t __attribute__((ext_vector_type(2)));
__device__ __forceinline__ unsigned cvt_pk_bf16(float lo, float hi) { f32x2 f = {lo, hi}; bf16x2_t v = __builtin_convertvector(f, bf16x2_t); return __builtin_bit_cast(unsigned, v); }
__device__ __forceinline__ float bflo(unsigned w) { return __uint_as_float(w << 16); }
__device__ __forceinline__ float bfhi(unsigned w) { return __uint_as_float(w & 0xffff0000u); }
__device__ __forceinline__ u32x4 pack8(f32x4 a, f32x4 b) { u32x4 w; w.x = cvt_pk_bf16(a[0], a[1]); w.y = cvt_pk_bf16(a[2], a[3]); w.z = cvt_pk_bf16(b[0], b[1]); w.w = cvt_pk_bf16(b[2], b[3]); return w; }
constexpr int MOE_RB = MOE_FP8 ? 1024 : 2048;
constexpr float MOE_WSC = MOE_FP8 ? 64.0f : 1.0f, MOE_INV = 1.0f / MOE_WSC;
__device__ __forceinline__ u32x2 pack8_fp8(f32x4 a, f32x4 b) { int lo = 0, hi = 0;
    lo = __builtin_amdgcn_cvt_pk_fp8_f32(a[0], a[1], lo, false); lo = __builtin_amdgcn_cvt_pk_fp8_f32(a[2], a[3], lo, true);
    hi = __builtin_amdgcn_cvt_pk_fp8_f32(b[0], b[1], hi, false); hi = __builtin_amdgcn_cvt_pk_fp8_f32(b[2], b[3], hi, true);
    u32x2 r; r.x = (unsigned)lo; r.y = (unsigned)hi; return r; }
__device__ __forceinline__ void unpack8(u32x4 w, f32x4& a, f32x4& b) { a[0] = bflo(w.x); a[1] = bfhi(w.x); a[2] = bflo(w.y); a[3] = bfhi(w.y); b[0] = bflo(w.z); b[1] = bfhi(w.z); b[2] = bflo(w.w); b[3] = bfhi(w.w); }
__device__ __forceinline__ float wave_sum(float v) {
#pragma unroll
    for (int o = 1; o < 64; o <<= 1) v += __shfl_xor(v, o);
    return v;
}
__device__ __forceinline__ float fast_rcp(float x) { return __builtin_amdgcn_rcpf(x); }
__device__ __forceinline__ float sigmoid_f(float x) { return fast_rcp(1.0f + __expf(-x)); }
__device__ __forceinline__ float silu_f(float x) { return x * sigmoid_f(x); }

#define XB_TMO      128
#define XB_XCNT(j)  (256  + 64 * (j))
#define XB_XSUB(j)  (1280 + 64 * (j))
#define XB_XGEN(j)  (2304 + 64 * (j))
#define XB_TOP      3328
#define XB_TOPGEN   3392
#define XCD_BAR_WORDS 3456
#define XB_SPIN_CAP (1u << 18)
__device__ __forceinline__ unsigned xb_ld(unsigned* p)              { return __hip_atomic_load(p, __ATOMIC_RELAXED, __HIP_MEMORY_SCOPE_AGENT); }
__device__ __forceinline__ unsigned xb_add(unsigned* p, unsigned v) { return __hip_atomic_fetch_add(p, v, __ATOMIC_RELAXED, __HIP_MEMORY_SCOPE_AGENT); }
__device__ __forceinline__ unsigned xb_xcc_id() { return (unsigned)__builtin_amdgcn_s_getreg((3 << 11) | 20) & 0xFu; }
#define XB_SPIN(cond, bar) do { unsigned _sp = 0; while (cond) { __builtin_amdgcn_s_sleep(1); \
    if ((++_sp & 255u) == 0u) { if (xb_ld(&(bar)[XB_TMO])) break; if (_sp > XB_SPIN_CAP) { atomicAdd(&(bar)[XB_TMO], 1u); break; } } } } while (0)
struct XcdBarrier { unsigned* bar; unsigned x; volatile LAS unsigned* st; };
__device__ __forceinline__ XcdBarrier xcd_barrier_post(unsigned* bar, volatile LAS unsigned* st) {
    XcdBarrier b; b.bar = bar; b.x = xb_xcc_id(); b.st = st;
    if (threadIdx.x == 0) (void)xb_add(&bar[XB_XCNT(b.x)], 1u);
    return b;
}
__device__ __forceinline__ void xcd_barrier_complete(unsigned* bar, unsigned x, unsigned& nloc, unsigned& nx) {
    const unsigned G = gridDim.x * gridDim.y * gridDim.z;
    unsigned sum, cnt, mine, sp = 0u;
    for (;;) {
        sum = 0u; cnt = 0u;
#pragma nounroll
        for (unsigned j = 0; j < 16; ++j) { const unsigned c = xb_ld(&bar[XB_XCNT(j)]); sum += c; cnt += (c > 0u) ? 1u : 0u; }
        if (sum == G) break;
        __builtin_amdgcn_s_sleep(1);
        if ((++sp & 255u) == 0u) { if (xb_ld(&bar[XB_TMO])) break; if (sp > XB_SPIN_CAP) { atomicAdd(&bar[XB_TMO], 1u); break; } }
    }
    mine = xb_ld(&bar[XB_XCNT(x)]);
    nloc = mine > 0u ? mine : 1u; nx = cnt > 0u ? cnt : 1u;
}
__device__ __forceinline__ void xcd_barrier(const XcdBarrier& b) {
    asm volatile("s_waitcnt vmcnt(0)" ::: "memory");
    __syncthreads();
    if (threadIdx.x == 0) {
        unsigned* bar = b.bar;
        __builtin_amdgcn_s_waitcnt(0);
        unsigned nloc = b.st[0], nx = b.st[1];
        if (nloc == 0u) { xcd_barrier_complete(bar, b.x, nloc, nx); b.st[0] = nloc; b.st[1] = nx; }
        const unsigned old = xb_add(&bar[XB_XSUB(b.x)], 1u);
        const unsigned gen = old / nloc;
        if (old + 1u == (gen + 1u) * nloc) {
            __builtin_amdgcn_fence(__ATOMIC_RELEASE, "agent");
            asm volatile("s_waitcnt vmcnt(0)" ::: "memory");
            const unsigned og = xb_add(&bar[XB_TOP], 1u);
            const unsigned tg = og / nx;
            if (og + 1u == (tg + 1u) * nx) xb_add(&bar[XB_TOPGEN], 1u);
            else XB_SPIN(xb_ld(&bar[XB_TOPGEN]) == tg, bar);
            __builtin_amdgcn_fence(__ATOMIC_ACQUIRE, "agent");
            xb_add(&bar[XB_XGEN(b.x)], 1u);
            asm volatile("s_waitcnt vmcnt(0)" ::: "memory");
        } else {
            XB_SPIN(xb_ld(&bar[XB_XGEN(b.x)]) == gen, bar);
            __builtin_amdgcn_fence(__ATOMIC_ACQUIRE, "agent");
            asm volatile("s_waitcnt vmcnt(0)" ::: "memory");
        }
    }
    __syncthreads();
}

namespace pg8 {
constexpr int BM = 256, BK = 64, HALF = 128, HTB = HALF * BK * 2, STAGE_BYTES = 8 * HTB, NXCD = 8, WGM = 8, KD = 1024;
__host__ __device__ __forceinline__ int lds_byte(int r, int c) { const int st = (r >> 4) * 2 + (c >> 5), rr = r & 15, cc = c & 31, ob = rr * 64 + cc * 2; return st * 1024 + (ob ^ (((ob >> 9) & 1) << 5)); }
__host__ __device__ __forceinline__ void stage_rc(int b, int& R, int& C) { const int st = b / 1024, sb = b % 1024, swz = sb ^ (((sb >> 9) & 1) << 5); R = (st >> 1) * 16 + swz / 64; C = (st & 1) * 32 + (swz % 64) / 2; }
__host__ __device__ __forceinline__ int perm32(int rho) { const int n = rho >> 4, i = rho & 15; return 8 * (i >> 2) + 4 * n + (i & 3); }
struct Unit { int pm, pn, ex; };
struct StaticOrder {
    int nM, nN, nwg, G, c;
    __device__ void init(int M, int N, int G_, int c_) { nM = M / BM; nN = N / BM; nwg = nM * nN; G = G_; c = c_; }
    __device__ bool next(int i, Unit& u) const {
        const long L = (long)i * G + c; if (L >= nwg) return false;
        int wgid = (int)L; { const int q = nwg / NXCD, r = nwg % NXCD, xcd = wgid % NXCD, off = wgid / NXCD; wgid = (xcd < r ? xcd * (q + 1) : r * (q + 1) + (xcd - r) * q) + off; }
        const int nig = WGM * nN, gid = wgid / nig, fm = gid * WGM, gsz = (nM - fm) < WGM ? (nM - fm) : WGM;
        u.pm = fm + ((wgid % nig) % gsz); u.pn = (wgid % nig) / gsz; u.ex = 0; return true;
    }
};
typedef int i32x8 __attribute__((ext_vector_type(8)));
typedef int i32x4v __attribute__((ext_vector_type(4)));
template <class Epi, class Sched, bool GATHER, int KE = 1024, bool FP8 = false>
__device__ __forceinline__ void gemm_phase(LAS unsigned char* lds, const Sched& S, const Epi& E) {
    int tid = threadIdx.x; asm volatile("" : "+v"(tid));
    const int wid = __builtin_amdgcn_readfirstlane(tid >> 6), lane = tid & 63, wr = wid >> 2, wc = wid & 3, fr = lane & 15, fq = lane >> 4;
    constexpr int K = KE, nt = K / BK;
    unsigned voffA[2], voffB[2]; int Rr[2], Cc[2];
#pragma unroll
    for (int i = 0; i < 2; ++i) { int R, C; stage_rc(tid * 16 + i * 8192, R, C); const int Rb = Epi::PERM ? ((R & ~31) + perm32(R & 31)) : R;
        voffA[i] = (unsigned)(R * K + C) * 2u; voffB[i] = (unsigned)(Rb * K + C) * 2u; Rr[i] = R; Cc[i] = C; }
    constexpr size_t kstep = (size_t)(BK * 2);
    constexpr size_t hstep = (size_t)HALF * K * 2;
    const unsigned ldsw = (unsigned)wid * 1024u;
    const int aoff = lds_byte(wr * 64 + fr, fq * 8), boff = lds_byte(wc * 32 + fr, fq * 8);
#define PG8_SA(b, h) (((b) * 2 + (h)) * HTB)
#define PG8_SB(b, h) ((4 + (b) * 2 + (h)) * HTB)
#define PG8_STAGE(bufoff, gbase, voff) do { _Pragma("unroll") for (int _i = 0; _i < 2; ++_i) \
        __builtin_amdgcn_global_load_lds((const unsigned*)((const char*)(gbase) + (voff)[_i]), (LAS unsigned*)(lds + (bufoff) + ldsw + _i * 8192), 16, 0, 0); } while (0)
#define PG8_STAGE_A(bufoff, gb, h, o0, o1) do { if constexpr (GATHER) { const unsigned _ko = (unsigned)((gb) - gA0); unsigned _o[2]; \
            if ((h) == 0) { _o[0] = (o0)[0] + _ko; _o[1] = (o0)[1] + _ko; } else { _o[0] = (o1)[0] + _ko; _o[1] = (o1)[1] + _ko; } PG8_STAGE(bufoff, gA0, _o); } \
        else { PG8_STAGE(bufoff, (gb) + (h) * hstep, voffA); } } while (0)
#define PG8_LD8(p) __builtin_shufflevector(*(const LAS i32x4v*)(p), *(const LAS i32x4v*)((p) + 1024), 0, 1, 2, 3, 4, 5, 6, 7)
#define PG8_LDA(dst, b, h) do { if constexpr (FP8) { _Pragma("unroll") for (int m = 0; m < 4; ++m) dst##8[m] = PG8_LD8(lds + PG8_SA(b, h) + aoff + m * 2048); } \
        else { _Pragma("unroll") for (int m = 0; m < 4; ++m) _Pragma("unroll") for (int k = 0; k < 2; ++k) dst[m][k] = *(const LAS bf16x8*)(lds + PG8_SA(b, h) + aoff + m * 2048 + k * 1024); } } while (0)
#define PG8_LDB(dst, b, h) do { if constexpr (FP8) { _Pragma("unroll") for (int n = 0; n < 2; ++n) dst##8[n] = PG8_LD8(lds + PG8_SB(b, h) + boff + n * 2048); } \
        else { _Pragma("unroll") for (int n = 0; n < 2; ++n) _Pragma("unroll") for (int k = 0; k < 2; ++k) dst[n][k] = *(const LAS bf16x8*)(lds + PG8_SB(b, h) + boff + n * 2048 + k * 1024); } } while (0)
#define PG8_MMA(ai, bj, At, Bt) do { __builtin_amdgcn_s_setprio(1); if constexpr (FP8) { _Pragma("unroll") for (int m = 0; m < 4; ++m) _Pragma("unroll") for (int n = 0; n < 2; ++n) \
            asm volatile("v_mfma_scale_f32_16x16x128_f8f6f4 %0, %1, %2, %0, %3, %3 op_sel_hi:[0,0,0]" : "+v"(acc[ai][bj][m][n]) : "v"(Bt##8[n]), "v"(At##8[m]), "v"(sc127)); } \
        else { _Pragma("unroll") for (int m = 0; m < 4; ++m) _Pragma("unroll") for (int n = 0; n < 2; ++n) _Pragma("unroll") for (int k = 0; k < 2; ++k) \
            acc[ai][bj][m][n] = __builtin_amdgcn_mfma_f32_16x16x32_bf16(Bt[n][k], At[m][k], acc[ai][bj][m][n], 0, 0, 0); } __builtin_amdgcn_s_setprio(0); } while (0)
#define PG8_WAIT_V(n) asm volatile("s_waitcnt vmcnt(" #n ")" ::: "memory")
#define PG8_WAIT_L(n) asm volatile("s_waitcnt lgkmcnt(" #n ")" ::: "memory")
#define PG8_BAR __builtin_amdgcn_s_barrier()
#define PG8_SCHED __builtin_amdgcn_sched_barrier(0)
    Unit cur, nxt; int ui = 0;
    if (!S.next(0, cur)) return;
    f32x4 acc[2][2][4][2];
#pragma unroll
    for (int a = 0; a < 2; ++a)
#pragma unroll
        for (int b = 0; b < 2; ++b)
#pragma unroll
            for (int m = 0; m < 4; ++m)
#pragma unroll
                for (int n = 0; n < 2; ++n) acc[a][b][m][n] = (f32x4){0.f, 0.f, 0.f, 0.f};
    const int sc127 = 0x7f7f7f7f;
    bf16x8 At[4][2], B0[2][2], B1[2][2]; i32x8 At8[4], B08[2], B18[2];
    const char* cA = S.a_base(cur); const char* cB = S.b_base(cur);
    const char* const gA0 = cA;
    unsigned cv0[2] = {0u, 0u}, cv1[2] = {0u, 0u}, nv0[2] = {0u, 0u}, nv1[2] = {0u, 0u};
    if constexpr (GATHER) S.a_offs(cur, Rr, Cc, cv0, cv1);
    PG8_STAGE(PG8_SB(0, 0), cB, voffB); PG8_STAGE_A(PG8_SA(0, 0), cA, 0, cv0, cv1); PG8_STAGE(PG8_SB(0, 1), cB + hstep, voffB); PG8_STAGE_A(PG8_SA(0, 1), cA, 1, cv0, cv1);
    if (wr == 1) PG8_BAR;
    PG8_WAIT_V(4); PG8_BAR;
    PG8_STAGE(PG8_SB(1, 0), cB + kstep, voffB); PG8_STAGE_A(PG8_SA(1, 0), cA + kstep, 0, cv0, cv1); PG8_STAGE(PG8_SB(1, 1), cB + hstep + kstep, voffB);
    PG8_WAIT_V(6); PG8_BAR;
    for (;;) {
        const bool has_next = S.next(ui + 1, nxt);
        const char* nA = has_next ? S.a_base(nxt) : cA; const char* nB = has_next ? S.b_base(nxt) : cB;
        if constexpr (GATHER) { if (has_next) S.a_offs(nxt, Rr, Cc, nv0, nv1); else { nv0[0] = cv0[0]; nv0[1] = cv0[1]; nv1[0] = cv1[0]; nv1[1] = cv1[1]; } }
#pragma nounroll
        for (int t = 0; t < nt; t += 2) {
            const bool last = (t == nt - 2);
            const char* a1 = cA + (size_t)(t + 1) * kstep;
            const char* a2 = last ? nA : cA + (size_t)(t + 2) * kstep; const char* b2 = last ? nB : cB + (size_t)(t + 2) * kstep;
            const char* a3 = a2 + kstep; const char* b3 = b2 + kstep;
            unsigned s0[2], s1[2];
            if constexpr (GATHER) { s0[0] = last ? nv0[0] : cv0[0]; s0[1] = last ? nv0[1] : cv0[1]; s1[0] = last ? nv1[0] : cv1[0]; s1[1] = last ? nv1[1] : cv1[1]; } else { s0[0] = s0[1] = s1[0] = s1[1] = 0u; }
            PG8_LDB(B0, 0, 0); PG8_SCHED; PG8_LDA(At, 0, 0); PG8_STAGE_A(PG8_SA(1, 1), a1, 1, cv0, cv1);
            PG8_WAIT_L(8); PG8_BAR; PG8_WAIT_L(0); PG8_MMA(0, 0, At, B0); PG8_BAR; PG8_SCHED;
            PG8_LDB(B1, 0, 1); PG8_STAGE(PG8_SB(0, 0), b2, voffB);
            PG8_BAR; PG8_WAIT_L(0); PG8_MMA(0, 1, At, B1); PG8_BAR;
            PG8_LDA(At, 0, 1); PG8_STAGE_A(PG8_SA(0, 0), a2, 0, s0, s1);
            PG8_BAR; PG8_WAIT_L(0); PG8_MMA(1, 0, At, B0); PG8_BAR; PG8_SCHED;
            PG8_STAGE(PG8_SB(0, 1), b2 + hstep, voffB);
            PG8_WAIT_V(6); PG8_BAR; PG8_MMA(1, 1, At, B1); PG8_BAR;
            PG8_LDB(B0, 1, 0); PG8_SCHED; PG8_LDA(At, 1, 0); PG8_STAGE_A(PG8_SA(0, 1), a2, 1, s0, s1);
            PG8_WAIT_L(8); PG8_BAR; PG8_WAIT_L(0); PG8_MMA(0, 0, At, B0); PG8_BAR; PG8_SCHED;
            PG8_LDB(B1, 1, 1); PG8_STAGE(PG8_SB(1, 0), b3, voffB);
            PG8_BAR; PG8_WAIT_L(0); PG8_MMA(0, 1, At, B1); PG8_BAR;
            PG8_LDA(At, 1, 1); PG8_STAGE_A(PG8_SA(1, 0), a3, 0, s0, s1);
            PG8_BAR; PG8_WAIT_L(0); PG8_MMA(1, 0, At, B0); PG8_BAR; PG8_SCHED;
            PG8_STAGE(PG8_SB(1, 1), b3 + hstep, voffB);
            PG8_WAIT_V(6); PG8_BAR; PG8_MMA(1, 1, At, B1); PG8_BAR;
        }
        if constexpr (FP8) asm volatile("s_nop 15\n\ts_nop 15" ::: "memory");
        E(acc, cur, wr, wc, fr, fq);
        if (!has_next) break;
#pragma unroll
        for (int a = 0; a < 2; ++a)
#pragma unroll
            for (int b = 0; b < 2; ++b)
#pragma unroll
                for (int m = 0; m < 4; ++m)
#pragma unroll
                    for (int n = 0; n < 2; ++n) acc[a][b][m][n] = (f32x4){0.f, 0.f, 0.f, 0.f};
        cur = nxt; cA = nA; cB = nB; ++ui;
        if constexpr (GATHER) { cv0[0] = nv0[0]; cv0[1] = nv0[1]; cv1[0] = nv1[0]; cv1[1] = nv1[1]; }
    }
    PG8_WAIT_V(0);
    if (wr == 0) PG8_BAR;
    PG8_BAR;
#undef PG8_SA
#undef PG8_SB
#undef PG8_STAGE
#undef PG8_STAGE_A
#undef PG8_LDA
#undef PG8_LDB
#undef PG8_MMA
#undef PG8_LD8
#undef PG8_WAIT_V
#undef PG8_WAIT_L
#undef PG8_BAR
#undef PG8_SCHED
}
}
using pg8::Unit;
typedef f32x4 AccT[2][2][4][2];

struct Args { const float* in[28]; float* out; unsigned char* ws; int ph_lo, ph_hi, pad0, pad1; };
struct Frame {
    LAS unsigned char* lds;
    int tid, lane, wave, G, bid;
    const struct Args* a;
    unsigned char* ws; unsigned char* outb;
};
struct SchedPlain {
    pg8::StaticOrder o; const char* A; const char* Bt;
    __device__ __forceinline__ bool next(int i, Unit& u) const { return o.next(i, u); }
    __device__ __forceinline__ const char* a_base(const Unit& u) const { return A + (size_t)u.pm * (256 * 2048); }
    __device__ __forceinline__ const char* b_base(const Unit& u) const { return Bt + (size_t)u.pn * (256 * 2048); }
    __device__ __forceinline__ void a_offs(const Unit&, const int*, const int*, unsigned (&)[2], unsigned (&)[2]) const {}
};

struct EpiProj {
    static constexpr bool PERM = true;
    bf16_t *Q, *IQ, *Z, *XBC, *GA, *GB; float* MISC;
    __device__ __forceinline__ void operator()(const AccT& acc, const Unit& u, int wr, int wc, int fr, int fq) const {
        const int pn = u.pn, row0 = u.pm * 256 + wr * 64 + fr, c8 = wc * 32 + 8 * fq;
        if (pn == 6) {
#pragma unroll
            for (int ai = 0; ai < 2; ++ai)
#pragma unroll
                for (int m = 0; m < 4; ++m) { float* rp = MISC + (size_t)(row0 + ai * 128 + m * 16) * 256 + c8;
#pragma unroll
                    for (int bj = 0; bj < 2; ++bj) { *(f32x4*)(rp + bj * 128) = acc[ai][bj][m][0]; *(f32x4*)(rp + bj * 128 + 4) = acc[ai][bj][m][1]; } }
            return;
        }
        bf16_t* base; int ldc, colt, act = 0;
        if (pn < 4) { base = Q; ldc = 1024; colt = pn * 256; }
        else if (pn < 6) { base = IQ; ldc = 512; colt = (pn - 4) * 256; }
        else if (pn < 11) { base = Z; ldc = 1024; colt = (pn - 7) * 256; act = 1; }
        else if (pn < 19) { base = XBC; ldc = 2048; colt = (pn - 11) * 256; }
        else if (pn < 23) { base = GA; ldc = 1024; colt = (pn - 19) * 256; act = 2; }
        else { base = GB; ldc = 1024; colt = (pn - 23) * 256; act = 2; }
#pragma unroll
        for (int ai = 0; ai < 2; ++ai)
#pragma unroll
            for (int m = 0; m < 4; ++m) { bf16_t* rp = base + (size_t)(row0 + ai * 128 + m * 16) * ldc + colt + c8;
#pragma unroll
                for (int bj = 0; bj < 2; ++bj) { f32x4 v0 = acc[ai][bj][m][0], v1 = acc[ai][bj][m][1];
                    if (act == 1) {
#pragma unroll
                        for (int j = 0; j < 4; ++j) { v0[j] = silu_f(v0[j]); v1[j] = silu_f(v1[j]); } }
                    if (act == 2) {
#pragma unroll
                        for (int j = 0; j < 4; ++j) { v0[j] = sigmoid_f(v0[j]); v1[j] = sigmoid_f(v1[j]); } }
                    u32x4 pk = pack8(v0, v1); if (DBG_IQ_TRUNC && (pn == 4 || pn == 5)) { pk.x &= 0xfff8fff8u; pk.y &= 0xfff8fff8u; pk.z &= 0xfff8fff8u; pk.w &= 0xfff8fff8u; }
                    *(u32x4*)(rp + bj * 128) = pk; } }
    }
};
template <int MODE> struct EpiGate {
    static constexpr bool PERM = true;
    const bf16_t* Gt; const bf16_t* T; bf16_t* O;
    __device__ __forceinline__ void operator()(const AccT& acc, const Unit& u, int wr, int wc, int fr, int fq) const {
        const int row0 = u.pm * 256 + wr * 64 + fr, c8 = u.pn * 256 + wc * 32 + 8 * fq;
#pragma unroll
        for (int ai = 0; ai < 2; ++ai)
#pragma unroll
            for (int m = 0; m < 4; ++m) { const size_t off = (size_t)(row0 + ai * 128 + m * 16) * 1024 + c8;
#pragma unroll
                for (int bj = 0; bj < 2; ++bj) { f32x4 g0, g1; unpack8(*(const u32x4*)(Gt + off + bj * 128), g0, g1);
                    f32x4 v0 = g0 * acc[ai][bj][m][0], v1 = g1 * acc[ai][bj][m][1];
                    if ((MODE == 0 && DBG_NO_ATTN) || (MODE == 1 && DBG_NO_SSD)) { v0 = (f32x4){0.f, 0.f, 0.f, 0.f}; v1 = v0; }
                    if (MODE == 1) { f32x4 t0, t1; unpack8(*(const u32x4*)(T + off + bj * 128), t0, t1); v0 += t0; v1 += t1; }
                    *(u32x4*)(O + off + bj * 128) = pack8(v0, v1); } }
    }
};
struct EpiOut {
    static constexpr bool PERM = false;
    const float* x; const float* mod; float* V;
    __device__ __forceinline__ void operator()(const AccT& acc, const Unit& u, int wr, int wc, int fr, int fq) const {
        const int row0 = u.pm * 256 + wr * 64 + fr, col0 = u.pn * 256 + wc * 32 + 4 * fq;
        const float* g1 = mod + (size_t)(u.pm >> 3) * 6144 + 2048 + col0;
        f32x4 gv[2][2];
#pragma unroll
        for (int bj = 0; bj < 2; ++bj)
#pragma unroll
            for (int n = 0; n < 2; ++n) gv[bj][n] = *(const f32x4*)(g1 + bj * 128 + n * 16);
#pragma unroll
        for (int ai = 0; ai < 2; ++ai)
#pragma unroll
            for (int m = 0; m < 4; ++m) { const size_t off = (size_t)(row0 + ai * 128 + m * 16) * 1024 + col0;
#pragma unroll
                for (int bj = 0; bj < 2; ++bj)
#pragma unroll
                    for (int n = 0; n < 2; ++n) { const f32x4 xv = *(const f32x4*)(x + off + bj * 128 + n * 16);
                        *(f32x4*)(V + off + bj * 128 + n * 16) = xv * DN_ALPHA + gv[bj][n] * acc[ai][bj][m][n]; } }
    }
};

struct MoeTab { LAS unsigned* cnt; LAS unsigned* tb; LAS unsigned char* te; int ntiles; };
__device__ __forceinline__ MoeTab moe_tables(Frame& F, int hf) {
    MoeTab T; T.cnt = (LAS unsigned*)(F.lds + LDS_AUX); T.tb = (LAS unsigned*)(F.lds + LDS_AUX + 256); T.te = (LAS unsigned char*)(F.lds + LDS_AUX + 512);
    const unsigned* CNT = (const unsigned*)(F.ws + WS_CTL) + CW_CNT;
    __syncthreads();
    if (F.tid < 32) { unsigned c = __hip_atomic_load(CNT + 64 * (hf * 32 + F.tid), __ATOMIC_RELAXED, __HIP_MEMORY_SCOPE_AGENT); if (c > (unsigned)REG_CAP) c = REG_CAP; T.cnt[F.tid] = c; }
    __syncthreads();
    if (F.tid == 0) { unsigned s = 0;
#pragma nounroll
        for (int e = 0; e < 32; ++e) { T.tb[e] = s; const unsigned n = (T.cnt[e] + 255u) >> 8;
#pragma nounroll
            for (unsigned t = 0; t < n; ++t) T.te[s + t] = (unsigned char)e;
            s += n; }
        T.tb[32] = s; }
    __syncthreads();
    T.ntiles = __builtin_amdgcn_readfirstlane((int)T.tb[32]);
    return T;
}
template <int NJ, bool GATHER> struct SchedMoe {
    MoeTab T; int G, c, hf; const char* A; const char* Bt; const u32x2* REG;
    __device__ __forceinline__ bool next(int i, Unit& u) const {
        const int L = i * G + c; if (L >= T.ntiles * NJ) return false;
        u.pm = L / NJ; u.pn = L % NJ; u.ex = __builtin_amdgcn_readfirstlane((int)T.te[u.pm]); return true;
    }
    __device__ __forceinline__ const char* a_base(const Unit& u) const { return GATHER ? A : A + (size_t)u.pm * (256 * MOE_RB); }
    __device__ __forceinline__ const char* b_base(const Unit& u) const { return Bt + ((size_t)u.ex * (NJ * 256) + (size_t)u.pn * 256) * MOE_RB; }
    __device__ __forceinline__ void a_offs(const Unit& u, const int* R, const int* C, unsigned (&o0)[2], unsigned (&o1)[2]) const {
        const unsigned cnt = __builtin_amdgcn_readfirstlane(T.cnt[u.ex]), pos0 = ((unsigned)u.pm - (unsigned)__builtin_amdgcn_readfirstlane(T.tb[u.ex])) * 256u; const u32x2* rg = REG + ((size_t)hf * 32 + u.ex) * REG_CAP;
#pragma unroll
        for (int i = 0; i < 2; ++i) {
            const unsigned p0 = pos0 + (unsigned)R[i], p1 = p0 + 128u;
            unsigned t0 = 0u, t1 = 0u;
            if (p0 < cnt) t0 = (unsigned)hf * HALF_TOK + (rg[p0].x >> 2);
            if (p1 < cnt) t1 = (unsigned)hf * HALF_TOK + (rg[p1].x >> 2);
            o0[i] = t0 * (unsigned)MOE_RB + (unsigned)C[i] * 2u; o1[i] = t1 * (unsigned)MOE_RB + (unsigned)C[i] * 2u;
        }
    }
};
struct EpiMoe1 {
    static constexpr bool PERM = true;
    const float* b1; bf16_t* ACT;
    __device__ __forceinline__ void operator()(const AccT& acc, const Unit& u, int wr, int wc, int fr, int fq) const {
        const int row0 = u.pm * 256 + wr * 64 + fr, c8 = u.pn * 128 + wc * 32 + 8 * fq;
        const float* bg = b1 + (size_t)u.ex * 2048 + c8;
        const f32x4 bg0 = *(const f32x4*)bg, bg1 = *(const f32x4*)(bg + 4), bu0 = *(const f32x4*)(bg + 1024), bu1 = *(const f32x4*)(bg + 1028);
#pragma unroll
        for (int ai = 0; ai < 2; ++ai)
#pragma unroll
            for (int m = 0; m < 4; ++m) {
                f32x4 g0 = acc[ai][0][m][0] * MOE_INV + bg0, g1 = acc[ai][0][m][1] * MOE_INV + bg1, u0 = acc[ai][1][m][0] * MOE_INV + bu0, u1 = acc[ai][1][m][1] * MOE_INV + bu1, a0, a1;
#pragma unroll
                for (int j = 0; j < 4; ++j) {
                    float g = fminf(g0[j], 7.0f), up = fminf(fmaxf(u0[j], -7.0f), 7.0f); a0[j] = (up + 1.0f) * g * sigmoid_f(1.702f * g);
                    g = fminf(g1[j], 7.0f); up = fminf(fmaxf(u1[j], -7.0f), 7.0f); a1[j] = (up + 1.0f) * g * sigmoid_f(1.702f * g); }
                if (MOE_FP8) *(u32x2*)((unsigned char*)ACT + (size_t)(row0 + ai * 128 + m * 16) * 1024 + c8) = pack8_fp8(a0, a1);
                else *(u32x4*)(ACT + (size_t)(row0 + ai * 128 + m * 16) * 1024 + c8) = pack8(a0, a1); }
    }
};
struct EpiMoe2 {
    static constexpr bool PERM = true;
    const float* b2; bf16_t* YB; const u32x2* REG; MoeTab T; int hf;
    __device__ __forceinline__ void operator()(const AccT& acc, const Unit& u, int wr, int wc, int fr, int fq) const {
        const int c8 = u.pn * 256 + wc * 32 + 8 * fq;
        const unsigned cnt = __builtin_amdgcn_readfirstlane(T.cnt[u.ex]), pos0 = ((unsigned)u.pm - (unsigned)__builtin_amdgcn_readfirstlane(T.tb[u.ex])) * 256u + (unsigned)(wr * 64 + fr); const u32x2* rg = REG + ((size_t)hf * 32 + u.ex) * REG_CAP;
        const float* bb = b2 + (size_t)u.ex * 1024 + c8;
        f32x4 bv[2][2];
#pragma unroll
        for (int bj = 0; bj < 2; ++bj) { bv[bj][0] = *(const f32x4*)(bb + bj * 128); bv[bj][1] = *(const f32x4*)(bb + bj * 128 + 4); }
#pragma unroll
        for (int ai = 0; ai < 2; ++ai)
#pragma unroll
            for (int m = 0; m < 4; ++m) { const unsigned p = pos0 + (unsigned)(ai * 128 + m * 16);
                if (p < cnt) { const u32x2 en = rg[p]; const float g = __uint_as_float(en.y); bf16_t* rp = YB + (size_t)en.x * 1024 + c8;
#pragma unroll
                    for (int bj = 0; bj < 2; ++bj) *(u32x4*)(rp + bj * 128) = pack8((acc[ai][bj][m][0] * MOE_INV + bv[bj][0]) * g, (acc[ai][bj][m][1] * MOE_INV + bv[bj][1]) * g); } }
    }
};

struct MapIdent { __device__ __forceinline__ int operator()(int n) const { return n; } };
struct MapWin { __device__ __forceinline__ int operator()(int n) const {
    if (n < 1024) return n;
    if (n < 1536) return 1152 + (n - 1024);
    if (n < 1792) { const int c = n - 1536; if (c < 128) return 1024 + c; if (c < 192) return 1664 + (c - 128); if (c < 200) return 1728 + (c - 192); if (c < 216) return 4808 + (c - 200); return -1; }
    if (n < 2816) return 1736 + (n - 1792);
    if (n < 4864) return 2760 + (n - 2816);
    if (n < 5888) return 4824 + (n - 4864);
    return 5848 + (n - 5888); } };
struct MapW1 { __device__ __forceinline__ int operator()(int r) const { const int j = r >> 8, rr = r & 255; return (rr >> 7) * 1024 + j * 128 + (rr & 127); } };
template <class Map, bool F8 = false> __device__ __forceinline__ void transpose_item(const float* W, int K, int N, bf16_t* WT, const Map& map, LAS float* scr, int kb, int nb, int lane, const float* rowscale) {
    const int k0 = 64 * kb, n0 = 32 * nb; const int src = map(n0 + (lane & 31));
#pragma unroll 8
    for (int i = 0; i < 32; ++i) { const int kk = 2 * i + (lane >> 5); float v = 0.f; if (src >= 0) v = W[(size_t)(k0 + kk) * N + src]; if (rowscale) v *= rowscale[k0 + kk]; scr[kk * 33 + (lane & 31)] = v; }
    LDS_WAIT(); asm volatile("" ::: "memory");
    const int c = lane & 7;
#pragma unroll
    for (int j = 0; j < 4; ++j) { const int n = (lane >> 3) + 8 * j; const LAS float* s = scr + (8 * c) * 33 + n;
        if constexpr (F8) { const f32x4 a = {s[0 * 33] * MOE_WSC, s[1 * 33] * MOE_WSC, s[2 * 33] * MOE_WSC, s[3 * 33] * MOE_WSC}, b = {s[4 * 33] * MOE_WSC, s[5 * 33] * MOE_WSC, s[6 * 33] * MOE_WSC, s[7 * 33] * MOE_WSC};
            *(u32x2*)((unsigned char*)WT + (size_t)(n0 + n) * K + k0 + 8 * c) = pack8_fp8(a, b); }
        else { u32x4 o; o.x = cvt_pk_bf16(s[0 * 33], s[1 * 33]); o.y = cvt_pk_bf16(s[2 * 33], s[3 * 33]); o.z = cvt_pk_bf16(s[4 * 33], s[5 * 33]); o.w = cvt_pk_bf16(s[6 * 33], s[7 * 33]);
            *(u32x4*)(WT + (size_t)(n0 + n) * K + k0 + 8 * c) = o; } }
    LDS_WAIT(); asm volatile("" ::: "memory");
}
__device__ __forceinline__ void ph_prologue(Frame& F) {
    const float* c_in = F.a->in[1]; const float* w_mod = F.a->in[2]; const float* b_mod = F.a->in[3];
    float* MOD = (float*)(F.ws + WS_MOD);
    for (int item = F.bid; item < 48; item += F.G) {
        LAS float* SC = (LAS float*)F.lds;
        __syncthreads();
        for (int i = F.tid; i < 32768; i += NTHR) { const int b = i >> 10, k = i & 1023; SC[k * 32 + b] = silu_f(c_in[i]); }
        __syncthreads();
        const int col = item * 128 + (F.tid >> 2), kq = F.tid & 3;
        float a[32];
#pragma unroll
        for (int b = 0; b < 32; ++b) a[b] = 0.f;
        for (int kk = 0; kk < 256; ++kk) { const int k = kq * 256 + kk; const float w = w_mod[(size_t)k * 6144 + col];
#pragma unroll
            for (int b4 = 0; b4 < 8; ++b4) { const f32x4 s = *(const LAS f32x4*)(SC + k * 32 + b4 * 4); a[b4 * 4 + 0] += w * s[0]; a[b4 * 4 + 1] += w * s[1]; a[b4 * 4 + 2] += w * s[2]; a[b4 * 4 + 3] += w * s[3]; } }
#pragma unroll
        for (int b = 0; b < 32; ++b) { a[b] += __shfl_xor(a[b], 1); a[b] += __shfl_xor(a[b], 2); }
        if (kq == 0) { const float bm = b_mod[col];
#pragma unroll
            for (int b = 0; b < 32; ++b) MOD[(size_t)b * 6144 + col] = a[b] + bm; }
        __syncthreads();
    }
    if (F.bid == (F.G > 48 ? 48 : 0)) {
        float* BT = (float*)(F.ws + WS_BIAST); const float* rel_bias = F.a->in[8];
        for (int i = F.tid; i < 249 * 8; i += NTHR) { const int idx = i >> 3, h = i & 7, rel = idx - 185; const int n = rel < 0 ? -rel : rel;
            const float nf = (float)(n > 1 ? n : 1); int large = 8 + (int)(logf(nf / 8.0f) / 2.7725887f * 8.0f); if (large > 15) large = 15;
            const int bucket = (rel > 0 ? 16 : 0) + (n < 8 ? n : large);
            BT[i] = rel_bias[bucket * 8 + h] * LOG2E; }
    }
    LAS float* scr = (LAS float*)(F.lds + F.wave * 16384);
    __syncthreads();
    const int gw = F.bid * NWAVES + F.wave, NGW = F.G * NWAVES;
    constexpr int I_WIN = 16 * (NPROJ / 32), I_SQ = 16 * 32, I_W1E = 16 * 64, I_W2E = 16 * 32;
    constexpr int NITEMS = I_WIN + 3 * I_SQ + 32 * I_W1E + 32 * I_W2E;
    for (int it = gw; it < NITEMS; it += NGW) {
        int r = it;
        if (r < I_WIN) { transpose_item(F.a->in[4], 1024, 6872, (bf16_t*)(F.ws + WS_WIN), MapWin(), scr, r / (NPROJ / 32), r % (NPROJ / 32), F.lane, nullptr); continue; } r -= I_WIN;
        if (r < I_SQ) { transpose_item(F.a->in[15], 1024, 1024, (bf16_t*)(F.ws + WS_WPA), MapIdent(), scr, r / 32, r % 32, F.lane, nullptr); continue; } r -= I_SQ;
        if (r < I_SQ) { transpose_item(F.a->in[16], 1024, 1024, (bf16_t*)(F.ws + WS_WPB), MapIdent(), scr, r / 32, r % 32, F.lane, F.a->in[14]); continue; } r -= I_SQ;
        if (r < I_SQ) { transpose_item(F.a->in[17], 1024, 1024, (bf16_t*)(F.ws + WS_WOUT), MapIdent(), scr, r / 32, r % 32, F.lane, nullptr); continue; } r -= I_SQ;
        if (r < 32 * I_W1E) { const int e = r / I_W1E, q = r % I_W1E; transpose_item<MapW1, MOE_FP8 != 0>(F.a->in[22] + (size_t)e * 1024 * 2048, 1024, 2048, (bf16_t*)(F.ws + WS_W1 + (size_t)e * 2048 * MOE_RB), MapW1(), scr, q / 64, q % 64, F.lane, nullptr); continue; } r -= 32 * I_W1E;
        { const int e = r / I_W2E, q = r % I_W2E; transpose_item<MapIdent, MOE_FP8 != 0>(F.a->in[24] + (size_t)e * 1024 * 1024, 1024, 1024, (bf16_t*)(F.ws + WS_W2 + (size_t)e * 1024 * MOE_RB), MapIdent(), scr, q / 32, q % 32, F.lane, nullptr); }
    }
}

__device__ __forceinline__ void ph_ln1(Frame& F) {
    const float* x = F.a->in[0]; const float* MOD = (const float*)(F.ws + WS_MOD); bf16_t* U = (bf16_t*)(F.outb + OUT_U);
    const int gw = F.bid * NWAVES + F.wave, NGW = F.G * NWAVES;
    constexpr int RB = 4;
    for (int m0 = gw; m0 < NTOK; m0 += NGW * RB) {
        f32x4 v[RB][4];
#pragma unroll
        for (int r = 0; r < RB; ++r) { const f32x4* xr = (const f32x4*)(x + (size_t)(m0 + r * NGW) * D) + F.lane;
#pragma unroll
            for (int j = 0; j < 4; ++j) v[r][j] = xr[64 * j]; }
#pragma unroll
        for (int r = 0; r < RB; ++r) { const int m = m0 + r * NGW; const float* md = MOD + (size_t)(m >> 11) * 6144;
            float s = 0.f;
#pragma unroll
            for (int j = 0; j < 4; ++j) s += (v[r][j][0] + v[r][j][1]) + (v[r][j][2] + v[r][j][3]);
            const float mean = wave_sum(s) * (1.f / D); float s2 = 0.f;
#pragma unroll
            for (int j = 0; j < 4; ++j) { v[r][j] = v[r][j] - mean; s2 += (v[r][j][0] * v[r][j][0] + v[r][j][1] * v[r][j][1]) + (v[r][j][2] * v[r][j][2] + v[r][j][3] * v[r][j][3]); }
            const float rstd = 1.f / sqrtf(wave_sum(s2) * (1.f / D) + LN_EPS);
            u32x2* o8 = (u32x2*)(U + (size_t)m * D) + F.lane;
#pragma unroll
            for (int j = 0; j < 4; ++j) { const f32x4 sh = *((const f32x4*)md + F.lane + 64 * j), sc = *((const f32x4*)(md + 1024) + F.lane + 64 * j);
                const f32x4 rr = v[r][j] * rstd * (sc + 1.0f) + sh; u32x2 w; w.x = cvt_pk_bf16(rr[0], rr[1]); w.y = cvt_pk_bf16(rr[2], rr[3]); o8[64 * j] = w; } }
    }
}

__device__ __forceinline__ void ph_misc(Frame& F) {
    const float* MISC = (const float*)(F.outb + OUT_MISC);
    bf16_t* KV = (bf16_t*)(F.outb + OUT_KV); bf16_t* IK = (bf16_t*)(F.outb + OUT_IK); float* IW = (float*)(F.outb + OUT_IW); float* DT = (float*)(F.outb + OUT_DT);
    const float* kvw = F.a->in[5]; const float* ikw = F.a->in[6]; const float* ikb = F.a->in[7]; const float* dtb = F.a->in[11];
    const int gw = F.bid * NWAVES + F.wave, NGW = F.G * NWAVES, l = F.lane;
    for (int m0 = gw; m0 < NTOK; m0 += NGW * 4) {
      f32x4 vv[4];
#pragma unroll
      for (int r = 0; r < 4; ++r) vv[r] = *((const f32x4*)(MISC + (size_t)(m0 + r * NGW) * 256) + l);
#pragma unroll
      for (int r = 0; r < 4; ++r) { const int m = m0 + r * NGW;
        const f32x4 v = vv[r];
        const float sq = v[0] * v[0] + v[1] * v[1] + v[2] * v[2] + v[3] * v[3], sm = (v[0] + v[1]) + (v[2] + v[3]);
        const float kvss = wave_sum(l < 32 ? sq : 0.f);
        const float iks = wave_sum((l >= 32 && l < 48) ? sm : 0.f);
        const float ikmean = iks * (1.f / 64.f);
        const f32x4 dv = v - ikmean;
        const float ikq = wave_sum((l >= 32 && l < 48) ? (dv[0] * dv[0] + dv[1] * dv[1] + dv[2] * dv[2] + dv[3] * dv[3]) : 0.f);
        if (l < 32) { const float r = 1.f / sqrtf(kvss * (1.f / 128.f) + LN_EPS); const f32x4 w = *((const f32x4*)kvw + l); const f32x4 o = v * r * w;
            u32x2 pk; pk.x = cvt_pk_bf16(o[0], o[1]); pk.y = cvt_pk_bf16(o[2], o[3]); *((u32x2*)(KV + (size_t)m * 128) + l) = pk; }
        else if (l < 48) { const float r = 1.f / sqrtf(ikq * (1.f / 64.f) + LN_EPS); const f32x4 w = *((const f32x4*)ikw + (l - 32)), bb = *((const f32x4*)ikb + (l - 32)); const f32x4 o = dv * r * w + bb;
            u32x2 pk; pk.x = cvt_pk_bf16(o[0], o[1]); pk.y = cvt_pk_bf16(o[2], o[3]); *((u32x2*)(IK + (size_t)m * 64) + (l - 32)) = pk; }
        else if (l < 50) { *((f32x4*)(IW + (size_t)m * 8) + (l - 48)) = v * 0.35355339059327373f; }
        else if (l < 54) { const f32x4 bb = *((const f32x4*)dtb + (l - 50)); f32x4 o;
#pragma unroll
            for (int j = 0; j < 4; ++j) { const float t = v[j] + bb[j]; o[j] = t > 20.f ? t : log1pf(__expf(t)); }
            *((f32x4*)(DT + (size_t)m * 16) + (l - 50)) = o; }
      }
    }
}

__device__ __forceinline__ unsigned sortable_key(float s) { const unsigned u = __float_as_uint(s + 0.0f); return (u & 0x80000000u) ? ~u : (u | 0x80000000u); }
template <int NKB> struct KeyRow { unsigned k[NKB]; };
__device__ __forceinline__ u64 low_bits_keep(u64 m, int t) { u64 out = 0; while (t-- > 0 && m) { const u64 b = m & (0 - m); out |= b; m ^= b; } return out; }
namespace idx { constexpr int KST = 144, KBUF = 64 * KST; }
__device__ __forceinline__ unsigned low_bits_keep32(unsigned m, int t) { unsigned out = 0; while (t-- > 0 && m) { const unsigned b = m & (0u - m); out |= b; m ^= b; } return out; }
template <int NG> __device__ __forceinline__ void topk2_select_write(const unsigned (&key)[64], int nkb, u64* mrow, int lane) {
    constexpr int NR = NG * 16;
    unsigned T0 = 0u, T1 = 0u; bool ex0 = false, ex1 = false;
#pragma nounroll
    for (int bit = 31; bit >= 0; --bit) {
        const unsigned c0 = ex0 ? T0 : (T0 | (1u << bit)), c1 = ex1 ? T1 : (T1 | (1u << bit)); const unsigned candv = lane < 32 ? c0 : c1;
        unsigned cl = 0u;
#pragma unroll
        for (int m = 0; m < NR; ++m) cl += (key[m] >= candv) ? 1u : 0u;
        cl += __shfl_xor(cl, 1); cl += __shfl_xor(cl, 2); cl += __shfl_xor(cl, 4); cl += __shfl_xor(cl, 8); cl += __shfl_xor(cl, 16);
        const int n0 = __builtin_amdgcn_readlane((int)cl, 0), n1 = __builtin_amdgcn_readlane((int)cl, 32);
        if (!ex0) { if (n0 >= 256) T0 = c0; if (n0 == 256) ex0 = true; }
        if (!ex1) { if (n1 >= 256) T1 = c1; if (n1 == 256) ex1 = true; }
        if (ex0 && ex1) break;
    }
    const unsigned Tv = lane < 32 ? T0 : T1;
    if (ex0 && ex1) {
        unsigned mlo = 0u, mhi = 0u;
#pragma unroll
        for (int j = 0; j < NR / 2; ++j) {
            const u64 b0 = __ballot(key[2 * j] >= Tv), b1 = __ballot(key[2 * j + 1] >= Tv);
            mlo = (lane == j) ? (unsigned)b0 : mlo; mhi = (lane == j) ? (unsigned)b1 : mhi;
            mlo = (lane == 32 + j) ? (unsigned)(b0 >> 32) : mlo; mhi = (lane == 32 + j) ? (unsigned)(b1 >> 32) : mhi;
            if ((j & 3) == 3) SBAR();
        }
        const int jl = lane & 31;
        if (jl < nkb) mrow[(lane >> 5) * 32 + jl] = (u64)mlo | ((u64)mhi << 32);
        return;
    }
    int rem0 = 1 << 30, rem1 = 1 << 30;
    { int g0 = 0, g1 = 0;
#pragma unroll
        for (int m = 0; m < NR; ++m) { const u64 mk = __ballot(key[m] > Tv); g0 += __builtin_popcount((unsigned)mk); g1 += __builtin_popcount((unsigned)(mk >> 32)); if ((m & 7) == 7) SBAR(); }
        if (!ex0) rem0 = 256 - g0; if (!ex1) rem1 = 256 - g1; }
    u64 mine = 0ull;
#pragma nounroll
    for (int jq = 0; jq < NR / 8; ++jq) {
#pragma unroll
        for (int jj = 0; jj < 4; ++jj) { const int j = jq * 4 + jj;
            unsigned w0[2], w1[2];
#pragma unroll
            for (int hh = 0; hh < 2; ++hh) { unsigned kv = 0u;
#pragma unroll
                for (int m = 0; m < NR; ++m) if ((m >> 3) == 0) {}
#pragma unroll
                for (int m = 0; m < NR; ++m) kv = (m == 2 * j + hh) ? key[m] : kv;
                const u64 gt = __ballot(kv > Tv), eq = __ballot(kv == Tv);
                { const unsigned e = (unsigned)eq, g = (unsigned)gt; const int ne = __builtin_popcount(e); unsigned sel = g; if (rem0 >= ne) { sel |= e; rem0 -= ne; } else if (rem0 > 0) { sel |= low_bits_keep32(e, rem0); rem0 = 0; } w0[hh] = sel; }
                { const unsigned e = (unsigned)(eq >> 32), g = (unsigned)(gt >> 32); const int ne = __builtin_popcount(e); unsigned sel = g; if (rem1 >= ne) { sel |= e; rem1 -= ne; } else if (rem1 > 0) { sel |= low_bits_keep32(e, rem1); rem1 = 0; } w1[hh] = sel; } }
            const u64 q0w = (u64)w0[0] | ((u64)w0[1] << 32), q1w = (u64)w1[0] | ((u64)w1[1] << 32);
            if (lane == j) mine = q0w; if (lane == 32 + j) mine = q1w; }
    }
    const int jl = lane & 31;
    if (jl < nkb) mrow[(lane >> 5) * 32 + jl] = mine;
}
template <int J0> __device__ __forceinline__ void index_scores8(unsigned (&key)[64], const bf16x8 (&af)[2], const f32x4& iw4, const bf16_t* kvsrc, char* lds, int nkb, u32x4 (&stg)[8], int tid) {
    const int lane = tid & 63, sub = lane & 15, kg = lane >> 4;
#pragma unroll
    for (int jj = 0; jj < 8; ++jj) {
        const int j = J0 + jj;
        if (j < nkb) {
            if (j + 1 < nkb) *(u32x4*)(lds + ((j + 1) & 1) * idx::KBUF + (tid >> 3) * idx::KST + (tid & 7) * 16) = stg[(jj + 1) & 7];
            if (j + 8 < nkb) stg[jj] = *(const u32x4*)(kvsrc + (size_t)(j + 8) * 64 * 64);
            const char* kb = lds + (j & 1) * idx::KBUF + sub * idx::KST + kg * 16;
#pragma unroll
            for (int pr = 0; pr < 2; ++pr) {
                f32x4 dA = (f32x4){0.f, 0.f, 0.f, 0.f}, dB = dA;
#pragma unroll
                for (int ks = 0; ks < 2; ++ks) {
                    const bf16x8 fA = *(const bf16x8*)(kb + (pr * 32) * idx::KST + ks * 64), fB = *(const bf16x8*)(kb + (pr * 32 + 16) * idx::KST + ks * 64);
                    dA = __builtin_amdgcn_mfma_f32_16x16x32_bf16(af[ks], fA, dA, 0, 0, 0); dB = __builtin_amdgcn_mfma_f32_16x16x32_bf16(af[ks], fB, dB, 0, 0, 0); }
                float pA = 0.f, pB = 0.f;
#pragma unroll
                for (int r = 0; r < 4; ++r) { pA += fmaxf(dA[r], 0.f) * iw4[r]; pB += fmaxf(dB[r], 0.f) * iw4[r]; }
                auto rr = __builtin_amdgcn_permlane16_swap(__float_as_uint(pA), __float_as_uint(pB), false, false);
                key[2 * j + pr] = sortable_key(__uint_as_float(rr[0]) + __uint_as_float(rr[1]));
            }
            __syncthreads();
        }
    }
}
__device__ __forceinline__ void ph_index(Frame& F) {
    const bf16_t* IQ = (const bf16_t*)(F.outb + OUT_IQ); const bf16_t* IK = (const bf16_t*)(F.outb + OUT_IK); const float* IW = (const float*)(F.outb + OUT_IW);
    u64* MASK = (u64*)(F.outb + OUT_MASK);
    char* lds = (char*)(unsigned char*)F.lds;
    const int tid = F.tid, lane = F.lane, sub = lane & 15, kg = lane >> 4;
    for (int item = F.bid; item < NTOK / 16; item += F.G) {
        const int tokw = (((item & 255) >> 3) << 11) + (((item & 7) + 8 * (item >> 8)) << 4) + F.wave * 2, b = tokw >> 11, pos0 = tokw & 2047, nkb = (pos0 >> 6) + 1;
        u64* mrow = MASK + (size_t)tokw * 32;
        if (nkb <= 4) { if ((lane & 31) < nkb) mrow[(lane >> 5) * 32 + (lane & 31)] = ~0ull; continue; }
        bf16x8 af[2];
        { const bf16_t* ap = IQ + (size_t)(tokw + (sub >> 3)) * 512 + (sub & 7) * 64 + kg * 8;
#pragma unroll
          for (int ks = 0; ks < 2; ++ks) af[ks] = *(const bf16x8*)(ap + ks * 32); }
        const f32x4 iw4 = *(const f32x4*)(IW + (size_t)(tokw + (lane >> 5)) * 8 + 4 * (kg & 1));
        unsigned key[64];
#pragma unroll
        for (int m = 0; m < 64; ++m) key[m] = 0u;
        const bf16_t* kvsrc = IK + ((size_t)b * SEQ + (tid >> 3)) * 64 + (tid & 7) * 8;
        u32x4 stg[8];
#pragma unroll
        for (int i = 0; i < 8; ++i) stg[i] = (i < nkb) ? *(const u32x4*)(kvsrc + (size_t)i * 64 * 64) : (u32x4){0u, 0u, 0u, 0u};
        __syncthreads();
        *(u32x4*)(lds + (tid >> 3) * idx::KST + (tid & 7) * 16) = stg[0];
        __syncthreads();
        const int ng = (nkb + 7) >> 3;
        index_scores8<0>(key, af, iw4, kvsrc, lds, nkb, stg, tid);
        if (ng > 1) index_scores8<8>(key, af, iw4, kvsrc, lds, nkb, stg, tid);
        if (ng > 2) index_scores8<16>(key, af, iw4, kvsrc, lds, nkb, stg, tid);
        if (ng > 3) index_scores8<24>(key, af, iw4, kvsrc, lds, nkb, stg, tid);
        if (ng == 1) topk2_select_write<1>(key, nkb, mrow, lane);
        else if (ng == 2) topk2_select_write<2>(key, nkb, mrow, lane);
        else if (ng == 3) topk2_select_write<3>(key, nkb, mrow, lane);
        else topk2_select_write<4>(key, nkb, mrow, lane);
    }
}

namespace att {
constexpr int KVBLK = 64;
constexpr int SHM_V = KVBLK * 128 * 2, SHM_K = SHM_V;
constexpr int OFF_V = 0, OFF_K = 2 * SHM_V, OFF_WS = 2 * SHM_V + 2 * SHM_K, OFF_BT = OFF_WS + NWAVES * 64 * 4;
#define KSWZ(row, colB) ((row) * 256 + ((colB) ^ (((row) & 7) << 4)))
__device__ __forceinline__ int crow(int r, int hi) { return (r & 3) + 8 * (r >> 2) + 4 * hi; }
__device__ __forceinline__ int v_st(int k, int c) { const int kk = (k & ~0xC) | ((k & 4) << 1) | ((k & 8) >> 1); return ((kk >> 3) * 4 + (c >> 5)) * 512 + ((kk & 7) * 32 + (c & 31)) * 2; }
__device__ __forceinline__ int v_rd_base(int lane) { return ((lane & 3) << 3) | (((lane >> 2) & 3) << 6) | (((lane >> 4) & 1) << 5) | (((lane >> 5) & 1) << 8); }
constexpr int v_rd_off(int d0, int ks, int half) { return d0 * 512 + ks * 4096 + half * 2048; }
template <int OFF> __device__ __forceinline__ s16x4 tr_read(int vb) { s16x4 r; asm volatile("ds_read_b64_tr_b16 %0, %1 offset:%2" : "=&v"(r) : "v"(vb), "i"(OFF) : "memory"); return r; }
template <int D0> __device__ __forceinline__ void pv_one(f32x16& od, int vb, bf16x8 pa0, bf16x8 pa1, bf16x8 pa2, bf16x8 pa3) {
    const s16x4 l0 = tr_read<v_rd_off(D0, 0, 0)>(vb), h0 = tr_read<v_rd_off(D0, 0, 1)>(vb), l1 = tr_read<v_rd_off(D0, 1, 0)>(vb), h1 = tr_read<v_rd_off(D0, 1, 1)>(vb);
    const s16x4 l2 = tr_read<v_rd_off(D0, 2, 0)>(vb), h2 = tr_read<v_rd_off(D0, 2, 1)>(vb), l3 = tr_read<v_rd_off(D0, 3, 0)>(vb), h3 = tr_read<v_rd_off(D0, 3, 1)>(vb);
    asm volatile("s_waitcnt lgkmcnt(0)" ::: "memory"); SBAR();
#define PK(L, H) (bf16x8){L[0], L[1], L[2], L[3], H[0], H[1], H[2], H[3]}
    od = __builtin_amdgcn_mfma_f32_32x32x16_bf16(pa0, PK(l0, h0), od, 0, 0, 0);
    od = __builtin_amdgcn_mfma_f32_32x32x16_bf16(pa1, PK(l1, h1), od, 0, 0, 0);
    od = __builtin_amdgcn_mfma_f32_32x32x16_bf16(pa2, PK(l2, h2), od, 0, 0, 0);
    od = __builtin_amdgcn_mfma_f32_32x32x16_bf16(pa3, PK(l3, h3), od, 0, 0, 0);
#undef PK
}
__device__ __forceinline__ void qkt(f32x16& p0, f32x16& p1, const char* Ks, const bf16x8* qr, int r32, int hi) {
    p0 = f32x16{}; p1 = f32x16{};
    int rv = r32; asm volatile("" : "+v"(rv));
    const char* kb = Ks + rv * 256; const int swz = ((rv & 7) << 4) ^ (hi * 16);
#pragma unroll
    for (int d0 = 0; d0 < 8; ++d0) { const char* ka = kb + ((d0 * 32) ^ swz);
        const bf16x8 b0 = *reinterpret_cast<const bf16x8*>(ka);
        const bf16x8 b1 = *reinterpret_cast<const bf16x8*>(ka + 8192);
        p0 = __builtin_amdgcn_mfma_f32_32x32x16_bf16(b0, qr[d0], p0, 0, 0, 0);
        p1 = __builtin_amdgcn_mfma_f32_32x32x16_bf16(b1, qr[d0], p1, 0, 0, 0); }
}
__device__ __forceinline__ void attn_item(Frame& F, int b, int q0, char* lds) {
    const bf16_t* Q = (const bf16_t*)(F.ws + WS_Q); const bf16_t* KV = (const bf16_t*)(F.outb + OUT_KV); const u64* MASK = (const u64*)(F.outb + OUT_MASK);
    bf16_t* OA = (bf16_t*)(F.outb + OUT_OA);
    const int tid = F.tid, wid = F.wave, lane = F.lane, r32 = lane & 31, hi = lane >> 5;
    char* V_lds = lds + OFF_V; char* K_lds = lds + OFF_K;
    float* wsl = (float*)(lds + OFF_WS) + wid * 64; float* li_l = wsl; float* al_l = wsl + 32;
    const float* btab = (const float*)(lds + OFF_BT);
    constexpr float C = 0.088388347648318440f * LOG2E;
    float m_reg = -1e30f, l_reg = 0.f; f32x16 o[4] = {}; bf16x8 qr[8];
    const size_t tokq = (size_t)b * SEQ + q0 + r32;
    { const bf16_t* Qw = Q + tokq * 1024 + wid * 128 + hi * 8;
#pragma unroll
      for (int d0 = 0; d0 < 8; ++d0) qr[d0] = *(const bf16x8*)(Qw + d0 * 16); }
    const u64* mq = MASK + tokq * 32;
    const int sr = tid >> 4, sc = (tid & 15) * 8;
    const int vb0 = (int)(uintptr_t)V_lds + v_rd_base(lane);
    const bf16_t* Kb = KV + (size_t)b * SEQ * 128;
    const int NT = (q0 >> 6) + 1;
    const float bfar = btab[wid];
    bf16x8 s0, s1;
#define SLOAD(k0) do { s0 = *(const bf16x8*)(Kb + (size_t)((k0) + sr) * 128 + sc); s1 = *(const bf16x8*)(Kb + (size_t)((k0) + 32 + sr) * 128 + sc); } while (0)
#define SWRITE(bf) do { int srv = sr; asm volatile("" : "+v"(srv)); const int kc = sc * 2; const int v0a = v_st(srv, sc), k0a = KSWZ(srv, kc); \
        *(bf16x8*)(V_lds + (bf) * SHM_V + v0a) = s0; *(bf16x8*)(V_lds + (bf) * SHM_V + v0a + 8192) = s1; \
        *(bf16x8*)(K_lds + (bf) * SHM_K + k0a) = s0; *(bf16x8*)(K_lds + (bf) * SHM_K + k0a + 8192) = s1; } while (0)
    __syncthreads();
    SLOAD(0); VM_WAIT(); SWRITE(0); __syncthreads();
    for (int j = 0; j < NT; ++j) {
        const int bf = j & 1;
        if (j + 1 < NT) SLOAD((j + 1) * KVBLK);
        const u64 mw = mq[j];
        f32x16 p0, p1;
        qkt(p0, p1, K_lds + bf * SHM_K, qr, r32, hi);
        const unsigned w0 = (unsigned)(mw >> (4 * hi)), w1 = (unsigned)(mw >> (32 + 4 * hi));
        const int relmax = j * KVBLK + 63 - q0;
        if (relmax <= -91) {
#pragma unroll
            for (int r = 0; r < 16; ++r) { const int cb = (r & 3) + 8 * (r >> 2);
                const float t0 = fmaf(p0[r], C, bfar), t1 = fmaf(p1[r], C, bfar); p0[r] = ((w0 >> cb) & 1u) ? t0 : -1e30f; p1[r] = ((w1 >> cb) & 1u) ? t1 : -1e30f; }
        } else {
            const float* bp = btab + (j * KVBLK + 4 * hi - (q0 + r32) + 185) * 8 + wid;
#pragma unroll
            for (int r4 = 0; r4 < 4; ++r4) {
#pragma unroll
                for (int rr = 0; rr < 4; ++rr) { const int r = r4 * 4 + rr; const int cb = (r & 3) + 8 * (r >> 2);
                    const float bv0 = bp[cb * 8], bv1 = bp[(cb + 32) * 8]; const float t0 = fmaf(p0[r], C, bv0), t1 = fmaf(p1[r], C, bv1);
                    p0[r] = ((w0 >> cb) & 1u) ? t0 : -1e30f; p1[r] = ((w1 >> cb) & 1u) ? t1 : -1e30f; }
                SBAR(); }
        }
        float pmax = p0[0];
#pragma unroll
        for (int r = 1; r < 16; ++r) pmax = fmaxf(pmax, p0[r]);
#pragma unroll
        for (int r = 0; r < 16; ++r) pmax = fmaxf(pmax, p1[r]);
        { auto rr = __builtin_amdgcn_permlane32_swap(__float_as_uint(pmax), __float_as_uint(pmax), false, false); pmax = fmaxf(__uint_as_float(rr[0]), __uint_as_float(rr[1])); }
        float alpha = 1.f;
        if (!__all(pmax - m_reg <= 11.0f)) { const float mn = fmaxf(m_reg, pmax); alpha = __builtin_amdgcn_exp2f(m_reg - mn); m_reg = mn; }
        float ps = 0.f;
#pragma unroll
        for (int r = 0; r < 16; ++r) { p0[r] = __builtin_amdgcn_exp2f(p0[r] - m_reg); p1[r] = __builtin_amdgcn_exp2f(p1[r] - m_reg); ps += p0[r] + p1[r]; }
        { auto rr = __builtin_amdgcn_permlane32_swap(__float_as_uint(ps), __float_as_uint(ps), false, false); ps = __uint_as_float(rr[0]) + __uint_as_float(rr[1]); }
        l_reg = l_reg * alpha + ps;
        bf16x8 pa0, pa1, pa2, pa3;
#define PK4(P, BASE, OUT) do { unsigned a0 = cvt_pk_bf16(P[BASE + 0], P[BASE + 1]), a1 = cvt_pk_bf16(P[BASE + 2], P[BASE + 3]);   \
    unsigned b0 = cvt_pk_bf16(P[BASE + 4], P[BASE + 5]), b1 = cvt_pk_bf16(P[BASE + 6], P[BASE + 7]);                              \
    auto r0 = __builtin_amdgcn_permlane32_swap(a0, b0, false, false); auto r1 = __builtin_amdgcn_permlane32_swap(a1, b1, false, false); \
    u32x4 w = {r0[0], r1[0], r0[1], r1[1]}; OUT = *reinterpret_cast<bf16x8*>(&w); } while (0)
        PK4(p0, 0, pa0); PK4(p0, 8, pa1); PK4(p1, 0, pa2); PK4(p1, 8, pa3);
#undef PK4
        if (__any(alpha < 1.f)) { if (hi == 0) al_l[r32] = alpha; LDS_WAIT();
#pragma unroll
            for (int d = 0; d < 4; ++d)
#pragma unroll
                for (int r = 0; r < 16; ++r) o[d][r] *= al_l[crow(r, hi)]; }
        const int vb = vb0 + bf * SHM_V;
        pv_one<0>(o[0], vb, pa0, pa1, pa2, pa3); pv_one<1>(o[1], vb, pa0, pa1, pa2, pa3); pv_one<2>(o[2], vb, pa0, pa1, pa2, pa3); pv_one<3>(o[3], vb, pa0, pa1, pa2, pa3);
        if (j + 1 < NT) { VM_WAIT(); SWRITE(bf ^ 1); }
        __syncthreads();
    }
#undef SLOAD
#undef SWRITE
    if (hi == 0) li_l[r32] = l_reg; LDS_WAIT();
    bf16_t* Ow = OA + ((size_t)b * SEQ + q0 + 4 * hi) * 1024 + wid * 128 + r32;
    const float* lip = li_l + 4 * hi;
    asm volatile("" : "+v"(Ow), "+v"(lip));
#pragma unroll
    for (int r = 0; r < 16; ++r) { const int ro = (r & 3) + 8 * (r >> 2); const float rl = fast_rcp(lip[ro]);
#pragma unroll
        for (int d0 = 0; d0 < 4; ++d0) { float v = o[d0][r] * rl; if ((DBG_ATTN_ZERO == 1 && q0 < 256) || (DBG_ATTN_ZERO == 2 && q0 >= 256)) v = 0.f; Ow[ro * 1024 + d0 * 32] = (bf16_t)(cvt_pk_bf16(v, v) & 0xffffu); }
        if ((r & 3) == 3) SBAR(); }
}
}
__device__ __forceinline__ void ph_attn(Frame& F) {
    char* lds = (char*)(unsigned char*)F.lds;
    { float* bt = (float*)(lds + att::OFF_BT); const float* BT = (const float*)(F.ws + WS_BIAST); __syncthreads(); for (int i = F.tid; i < 249 * 8; i += NTHR) bt[i] = BT[i]; __syncthreads(); }
    for (int pr = F.bid; pr < NB * 32; pr += F.G) {
        const int b = pr >> 5, qb = pr & 31;
#pragma nounroll
        for (int hh = 0; hh < 2; ++hh) att::attn_item(F, b, (hh ? qb : 63 - qb) * 32, lds);
    }
}

namespace ssd {
constexpr int OFF_CS = 0, CS_ST = 272;
constexpr int OFF_BS = OFF_CS + 64 * CS_ST;
constexpr int OFF_BT = OFF_BS + 64 * CS_ST, T_ST = 144;
constexpr int OFF_XT = OFF_BT + 128 * T_ST;
constexpr int OFF_XW = OFF_XT + 64 * T_ST;
constexpr int OFF_XS = OFF_XW + 64 * T_ST;
constexpr int OFF_MT = OFF_XS + 64 * T_ST;
constexpr int OFF_HS = OFF_MT + 64 * T_ST;
constexpr int OFF_END = OFF_HS + 64 * CS_ST;
static_assert(OFF_END + 5 * 320 * 4 <= 131072, "ssd lds");
__device__ __forceinline__ f32x4 mfma16(bf16x8 a, bf16x8 b, f32x4 c) { return __builtin_amdgcn_mfma_f32_16x16x32_bf16(a, b, c, 0, 0, 0); }
__device__ __forceinline__ bf16x8 ldfrag(const char* base, int stride, int row, int k0) { return *(const bf16x8*)(base + row * stride + k0 * 2); }
}
__device__ __forceinline__ void ph_ssd(Frame& F) {
    using namespace ssd;
    char* lds = (char*)(unsigned char*)F.lds;
    const bf16_t* XBC = (const bf16_t*)(F.ws + WS_XBC); const bf16_t* ZS = (const bf16_t*)(F.ws + WS_Z); const float* DT = (const float*)(F.outb + OUT_DT);
    bf16_t* YG = (bf16_t*)(F.ws + WS_Q);
    const float* conv_w = F.a->in[9]; const float* conv_b = F.a->in[10]; const float* a_log = F.a->in[12]; const float* d_skip = F.a->in[13];
    const int tid = F.tid, wid = F.wave, lane = F.lane, fr = lane & 15, fq = lane >> 4;
    const bool stager = tid < 320; const int so = tid % 40, tg = tid / 40;
    for (int item = F.bid; item < NB * 16; item += F.G) {
        const int b = item >> 4, h = item & 15, g = h >> 2;
        const float aneg = -__expf(a_log[h]), dsk = d_skip[h];
        const int ch0 = so < 8 ? h * 64 + so * 8 : (so < 24 ? 1024 + g * 128 + (so - 8) * 8 : 1536 + g * 128 + (so - 24) * 8);
        float* CWL = (float*)(lds + OFF_END);
        __syncthreads();
        if (stager) {
#pragma unroll
            for (int j = 0; j < 4; ++j) { *(f32x4*)(CWL + j * 320 + so * 8) = *(const f32x4*)(conv_w + (size_t)j * 2048 + ch0); *(f32x4*)(CWL + j * 320 + so * 8 + 4) = *(const f32x4*)(conv_w + (size_t)j * 2048 + ch0 + 4); }
            *(f32x4*)(CWL + 4 * 320 + so * 8) = *(const f32x4*)(conv_b + ch0); *(f32x4*)(CWL + 4 * 320 + so * 8 + 4) = *(const f32x4*)(conv_b + ch0 + 4);
        }
        f32x4 hst[4];
#pragma unroll
        for (int t = 0; t < 4; ++t) hst[t] = (f32x4){0.f, 0.f, 0.f, 0.f};
        __syncthreads();
        for (int i = tid; i < 64 * CS_ST / 4; i += NTHR) ((unsigned*)(lds + OFF_HS))[i] = 0u;
        u32x4 raw[11];
        const size_t tokb = (size_t)b * SEQ;
#define SSD_LOAD(c) do { if (stager) { _Pragma("unroll") for (int i = 0; i < 11; ++i) { const int t = (c) * 64 + tg * 8 - 3 + i; \
            raw[i] = (t >= 0) ? *(const u32x4*)(XBC + (tokb + t) * 2048 + ch0) : (u32x4){0u, 0u, 0u, 0u}; } } } while (0)
        SSD_LOAD(0);
        for (int c = 0; c < 32; ++c) {
            const float dtl = DT[(tokb + c * 64 + lane) * 16 + h];
            float acs = dtl * aneg;
#pragma unroll
            for (int o = 1; o < 64; o <<= 1) { const float t = __shfl_up(acs, o); if (lane >= o) acs += t; }
            const float alast = __shfl(acs, 63);
            if (DBG_SSD_SYNC) __syncthreads();
            float dtv[8], dec[8];
#pragma unroll
            for (int t = 0; t < 8; ++t) { dtv[t] = __shfl(dtl, (tg * 8 + t) & 63); dec[t] = __expf(alast - __shfl(acs, (tg * 8 + t) & 63)); }
            if (stager) {
#pragma unroll
                for (int hq = 0; hq < 2; ++hq) {
                    float xin[11][4];
#pragma unroll
                    for (int i = 0; i < 11; ++i) { const unsigned wa = hq ? raw[i].z : raw[i].x, wb = hq ? raw[i].w : raw[i].y; xin[i][0] = bflo(wa); xin[i][1] = bfhi(wa); xin[i][2] = bflo(wb); xin[i][3] = bfhi(wb); }
                    float outv[8][4];
                    { f32x4 cwv[4]; const f32x4 cbq = *(const f32x4*)(CWL + 4 * 320 + so * 8 + hq * 4);
#pragma unroll
                      for (int j = 0; j < 4; ++j) cwv[j] = *(const f32x4*)(CWL + j * 320 + so * 8 + hq * 4);
#pragma unroll
                      for (int t = 0; t < 8; ++t)
#pragma unroll
                        for (int e = 0; e < 4; ++e) { float sacc = cbq[e];
#pragma unroll
                            for (int j = 0; j < 4; ++j) sacc += cwv[j][e] * xin[t + j][e];
                            outv[t][e] = silu_f(sacc); } }
                    if (so < 8) {
#pragma unroll
                        for (int e = 0; e < 4; ++e) { const int p = so * 8 + hq * 4 + e;
                            f32x4 x0, x1, d0, d1, w0, w1;
#pragma unroll
                            for (int t = 0; t < 4; ++t) { x0[t] = outv[t][e]; x1[t] = outv[4 + t][e]; d0[t] = x0[t] * dtv[t]; d1[t] = x1[t] * dtv[4 + t]; w0[t] = d0[t] * dec[t]; w1[t] = d1[t] * dec[4 + t]; }
                            *(u32x4*)(lds + OFF_XS + p * T_ST + tg * 16) = pack8(x0, x1);
                            *(u32x4*)(lds + OFF_XT + p * T_ST + tg * 16) = pack8(d0, d1);
                            *(u32x4*)(lds + OFF_XW + p * T_ST + tg * 16) = pack8(w0, w1); }
                    } else {
                        const bool isB = so < 24; const int n0 = (isB ? (so - 8) : (so - 24)) * 8 + hq * 4;
                        char* nat = lds + (isB ? OFF_BS : OFF_CS);
#pragma unroll
                        for (int t = 0; t < 8; ++t) { u32x2 w; w.x = cvt_pk_bf16(outv[t][0], outv[t][1]); w.y = cvt_pk_bf16(outv[t][2], outv[t][3]);
                            *(u32x2*)(nat + (tg * 8 + t) * CS_ST + n0 * 2) = w; }
                        if (isB) {
#pragma unroll
                            for (int e = 0; e < 4; ++e) { f32x4 a, bq;
#pragma unroll
                                for (int t = 0; t < 4; ++t) { a[t] = outv[t][e]; bq[t] = outv[4 + t][e]; }
                                *(u32x4*)(lds + OFF_BT + (n0 + e) * T_ST + tg * 16) = pack8(a, bq); }
                        }
                    }
                }
            }
            if (c + 1 < 32) SSD_LOAD(c + 1);
            __syncthreads();
#pragma unroll
            for (int t2 = 0; t2 < 2; ++t2) {
                const int tile = 2 * wid + t2, sb = tile >> 2, lb = tile & 3;
                f32x4 d = (f32x4){0.f, 0.f, 0.f, 0.f};
                if (sb <= lb) {
#pragma unroll
                    for (int ks = 0; ks < 4; ++ks) d = mfma16(ldfrag(lds + OFF_BS, CS_ST, sb * 16 + fr, ks * 32 + fq * 8), ldfrag(lds + OFF_CS, CS_ST, lb * 16 + fr, ks * 32 + fq * 8), d);
                    const int l = lb * 16 + fr; const float al = __shfl(acs, l);
                    f32x4 as;
#pragma unroll
                    for (int r = 0; r < 4; ++r) as[r] = __shfl(acs, sb * 16 + 4 * fq + r);
#pragma unroll
                    for (int r = 0; r < 4; ++r) { const int s = sb * 16 + 4 * fq + r; d[r] = (s <= l) ? d[r] * __expf(al - as[r]) : 0.f; }
                }
                u32x2 w; w.x = cvt_pk_bf16(d[0], d[1]); w.y = cvt_pk_bf16(d[2], d[3]);
                *(u32x2*)(lds + OFF_MT + (lb * 16 + fr) * T_ST + (sb * 16 + 4 * fq) * 2) = w;
            }
            if (DBG_SSD_SYNC) __syncthreads();
            f32x4 yacc[2];
#pragma unroll
            for (int t2 = 0; t2 < 2; ++t2) {
                const int tile = 2 * wid + t2, pb = tile >> 2, lb = tile & 3;
                f32x4 d = (f32x4){0.f, 0.f, 0.f, 0.f};
#pragma unroll
                for (int ks = 0; ks < 4; ++ks) d = mfma16(ldfrag(lds + OFF_HS, CS_ST, pb * 16 + fr, ks * 32 + fq * 8), ldfrag(lds + OFF_CS, CS_ST, lb * 16 + fr, ks * 32 + fq * 8), d);
                const float el = __expf(__shfl(acs, lb * 16 + fr));
                yacc[t2] = d * el;
            }
            __syncthreads();
#pragma unroll
            for (int t2 = 0; t2 < 2; ++t2) {
                const int tile = 2 * wid + t2, pb = tile >> 2, lb = tile & 3;
                f32x4 d = yacc[t2];
#pragma unroll
                for (int ks = 0; ks < 2; ++ks) d = mfma16(ldfrag(lds + OFF_XT, T_ST, pb * 16 + fr, ks * 32 + fq * 8), ldfrag(lds + OFF_MT, T_ST, lb * 16 + fr, ks * 32 + fq * 8), d);
                const int l = lb * 16 + fr, p0 = pb * 16 + 4 * fq; const size_t tok = tokb + c * 64 + l;
                const u32x2 zz = *(const u32x2*)(ZS + tok * 1024 + h * 64 + p0);
                const float z0 = bflo(zz.x), z1 = bfhi(zz.x), z2 = bflo(zz.y), z3 = bfhi(zz.y);
                float xs[4];
#pragma unroll
                for (int r = 0; r < 4; ++r) xs[r] = bflo((unsigned)*(const bf16_t*)(lds + OFF_XS + (p0 + r) * T_ST + l * 2));
                u32x2 w; w.x = cvt_pk_bf16((d[0] + xs[0] * dsk) * z0, (d[1] + xs[1] * dsk) * z1); w.y = cvt_pk_bf16((d[2] + xs[2] * dsk) * z2, (d[3] + xs[3] * dsk) * z3);
                *(u32x2*)(YG + tok * 1024 + h * 64 + p0) = w;
            }
            if (DBG_SSD_SYNC) __syncthreads();
            { const float dc = __expf(alast);
#pragma unroll
              for (int t = 0; t < 4; ++t) { f32x4 d = hst[t] * dc;
#pragma unroll
                  for (int ks = 0; ks < 2; ++ks) d = mfma16(ldfrag(lds + OFF_BT, T_ST, wid * 16 + fr, ks * 32 + fq * 8), ldfrag(lds + OFF_XW, T_ST, t * 16 + fr, ks * 32 + fq * 8), d);
                  hst[t] = d;
                  u32x2 w; w.x = cvt_pk_bf16(d[0], d[1]); w.y = cvt_pk_bf16(d[2], d[3]);
                  *(u32x2*)(lds + OFF_HS + (t * 16 + fr) * CS_ST + (wid * 16 + 4 * fq) * 2) = w; } }
            __syncthreads();
        }
#undef SSD_LOAD
    }
}

__device__ __forceinline__ void ph_gnorm(Frame& F) {
    bf16_t* YG = (bf16_t*)(F.ws + WS_Q);
    const int gw = F.bid * NWAVES + F.wave, NGW = F.G * NWAVES;
    for (int m = gw; m < NTOK; m += NGW) {
        u32x2* rp = (u32x2*)(YG + (size_t)m * D) + F.lane;
#pragma unroll
        for (int j = 0; j < 4; ++j) { const u32x2 w = rp[64 * j]; const float a = bflo(w.x), b = bfhi(w.x), c = bflo(w.y), d = bfhi(w.y);
            const float ss = wave_sum(a * a + b * b + c * c + d * d); const float r = 1.f / sqrtf(ss * (1.f / 256.f) + LN_EPS);
            u32x2 o; o.x = cvt_pk_bf16(a * r, b * r); o.y = cvt_pk_bf16(c * r, d * r); rp[64 * j] = o; }
    }
}

template <bool DRY = false> __device__ __forceinline__ void ph_router(Frame& F) {
    float* X1 = (float*)F.outb; bf16_t* U2 = (bf16_t*)(F.ws + WS_U2); const float* MOD = (const float*)(F.ws + WS_MOD);
    const float* ln1g = F.a->in[18]; const float* ln1b = F.a->in[19]; const float* w_router = F.a->in[20]; const float* b_router = F.a->in[21];
    u32x2* REG = (u32x2*)(F.ws + WS_REG); unsigned* CNT = (unsigned*)(F.ws + WS_CTL) + CW_CNT;
    constexpr int TST = 2064;
    LAS unsigned char* THI = F.lds; LAS unsigned char* TLO = F.lds + 16 * TST; LAS float* PART = (LAS float*)(F.lds + 32 * TST);
    LAS unsigned* lcnt = (LAS unsigned*)(F.lds + LDS_AUX); LAS unsigned* lbase = lcnt + 32; LAS unsigned* ent = lcnt + 64;
    const int tid = F.tid, lane = F.lane, wid = F.wave, fr = lane & 15, fq = lane >> 4;
    bf16x8 whi[4][2], wlo[4][2];
#pragma unroll
    for (int ks = 0; ks < 4; ++ks)
#pragma unroll
        for (int ct = 0; ct < 2; ++ct) { float wv[8];
#pragma unroll
            for (int i = 0; i < 8; ++i) wv[i] = w_router[(size_t)(128 * wid + 32 * ks + 8 * fq + i) * 32 + ct * 16 + fr];
            u32x4 h, l2;
#pragma unroll
            for (int i = 0; i < 4; ++i) { const unsigned hp = cvt_pk_bf16(wv[2 * i], wv[2 * i + 1]); const float r0 = wv[2 * i] - bflo(hp), r1 = wv[2 * i + 1] - bfhi(hp); h[i] = hp; l2[i] = cvt_pk_bf16(r0, r1); }
            whi[ks][ct] = __builtin_bit_cast(bf16x8, h); wlo[ks][ct] = __builtin_bit_cast(bf16x8, l2); }
    const float brl = b_router[lane & 31];
    for (int batch = F.bid; batch < NTOK / 256; batch += F.G) {
        const int hf = batch >> 7;
        __syncthreads();
        if (tid < 32) lcnt[tid] = 0u;
        for (int grp = 0; grp < 16; ++grp) {
#pragma unroll
            for (int tt = 0; tt < 2; ++tt) {
                const int tg16 = 2 * wid + tt, m = batch * 256 + grp * 16 + tg16; const float* md = MOD + (size_t)(m >> 11) * 6144;
                f32x4* xr = (f32x4*)(X1 + (size_t)m * D) + lane;
                f32x4 v[4]; float s = 0.f;
#pragma unroll
                for (int j = 0; j < 4; ++j) { v[j] = xr[64 * j]; s += (v[j][0] + v[j][1]) + (v[j][2] + v[j][3]); }
                float mean = wave_sum(s) * (1.f / D), s2 = 0.f;
#pragma unroll
                for (int j = 0; j < 4; ++j) { v[j] = v[j] - mean; s2 += (v[j][0] * v[j][0] + v[j][1] * v[j][1]) + (v[j][2] * v[j][2] + v[j][3] * v[j][3]); }
                float rstd = 1.f / sqrtf(wave_sum(s2) * (1.f / D) + LN_EPS);
                s = 0.f;
#pragma unroll
                for (int j = 0; j < 4; ++j) { const f32x4 g = *((const f32x4*)ln1g + lane + 64 * j), bb = *((const f32x4*)ln1b + lane + 64 * j); v[j] = v[j] * rstd * g + bb; if (!DRY) xr[64 * j] = v[j]; s += (v[j][0] + v[j][1]) + (v[j][2] + v[j][3]); }
                mean = wave_sum(s) * (1.f / D); s2 = 0.f;
#pragma unroll
                for (int j = 0; j < 4; ++j) { v[j] = v[j] - mean; s2 += (v[j][0] * v[j][0] + v[j][1] * v[j][1]) + (v[j][2] * v[j][2] + v[j][3] * v[j][3]); }
                rstd = 1.f / sqrtf(wave_sum(s2) * (1.f / D) + LN_EPS);
                u32x2* o8 = (u32x2*)(U2 + (size_t)m * D) + lane;
#pragma unroll
                for (int j = 0; j < 4; ++j) { const f32x4 sh = *((const f32x4*)(md + 3072) + lane + 64 * j), sc = *((const f32x4*)(md + 4096) + lane + 64 * j);
                    v[j] = v[j] * rstd * (sc + 1.0f) + sh; u32x2 w; w.x = cvt_pk_bf16(v[j][0], v[j][1]); w.y = cvt_pk_bf16(v[j][2], v[j][3]);
                    if (DRY) { if (w.x == 0x12345678u) o8[64 * j] = w; }
                    else if (MOE_FP8) { int pk = 0; pk = __builtin_amdgcn_cvt_pk_fp8_f32(v[j][0], v[j][1], pk, false); pk = __builtin_amdgcn_cvt_pk_fp8_f32(v[j][2], v[j][3], pk, true); ((unsigned*)((unsigned char*)U2 + (size_t)m * D))[lane + 64 * j] = (unsigned)pk; }
                    else o8[64 * j] = w;
                    u32x2 lo; lo.x = cvt_pk_bf16(v[j][0] - bflo(w.x), v[j][1] - bfhi(w.x)); lo.y = cvt_pk_bf16(v[j][2] - bflo(w.y), v[j][3] - bfhi(w.y));
                    *(LAS u32x2*)(THI + tg16 * TST + (4 * lane + 256 * j) * 2) = w; *(LAS u32x2*)(TLO + tg16 * TST + (4 * lane + 256 * j) * 2) = lo; }
            }
            __syncthreads();
            { f32x4 a0 = (f32x4){0.f, 0.f, 0.f, 0.f}, a1 = a0;
#pragma unroll
              for (int ks = 0; ks < 4; ++ks) { const int cb = (128 * wid + 32 * ks + 8 * fq) * 2;
                  const bf16x8 th = *(const LAS bf16x8*)(THI + fr * TST + cb), tl = *(const LAS bf16x8*)(TLO + fr * TST + cb);
                  a0 = __builtin_amdgcn_mfma_f32_16x16x32_bf16(whi[ks][0], th, a0, 0, 0, 0); a1 = __builtin_amdgcn_mfma_f32_16x16x32_bf16(whi[ks][1], th, a1, 0, 0, 0);
                  a0 = __builtin_amdgcn_mfma_f32_16x16x32_bf16(wlo[ks][0], th, a0, 0, 0, 0); a1 = __builtin_amdgcn_mfma_f32_16x16x32_bf16(wlo[ks][1], th, a1, 0, 0, 0);
                  a0 = __builtin_amdgcn_mfma_f32_16x16x32_bf16(whi[ks][0], tl, a0, 0, 0, 0); a1 = __builtin_amdgcn_mfma_f32_16x16x32_bf16(whi[ks][1], tl, a1, 0, 0, 0); }
              *(LAS f32x4*)(PART + (wid * 16 + fr) * 32 + 4 * fq) = a0; *(LAS f32x4*)(PART + (wid * 16 + fr) * 32 + 16 + 4 * fq) = a1; }
            __syncthreads();
            { const int tg16 = 2 * wid + (lane >> 5), tl = grp * 16 + tg16, myexp = lane & 31;
              float logit = brl;
#pragma unroll
              for (int w8 = 0; w8 < 8; ++w8) logit += PART[(w8 * 16 + tg16) * 32 + myexp];
              float tv[4]; int tix[4];
#pragma unroll
              for (int k = 0; k < 4; ++k) { float bv = logit; int bi = myexp;
#pragma unroll
                  for (int o = 1; o < 32; o <<= 1) { const float ov = __shfl_xor(bv, o); const int oi = __shfl_xor(bi, o); if (ov > bv || (ov == bv && oi < bi)) { bv = ov; bi = oi; } }
                  tv[k] = bv; tix[k] = bi; if (myexp == bi) logit = -INFINITY; }
              const float e1 = __expf(tv[1] - tv[0]), e2 = __expf(tv[2] - tv[0]), e3 = __expf(tv[3] - tv[0]); const float inv = 1.f / (1.f + e1 + e2 + e3);
              if (myexp < 4) { const int ee = myexp == 0 ? tix[0] : (myexp == 1 ? tix[1] : (myexp == 2 ? tix[2] : tix[3])); const float gg = (myexp == 0 ? 1.f : (myexp == 1 ? e1 : (myexp == 2 ? e2 : e3))) * inv;
                  const unsigned lp = atomicAdd((unsigned*)&lcnt[ee], 1u);
                  LAS unsigned* en = ent + (tl * 4 + myexp) * 3; en[0] = (unsigned)ee; en[1] = lp; en[2] = __float_as_uint(gg);
                  if (DBG_CHECK == 1) { u32x2 rw; rw.x = (unsigned)ee; rw.y = __float_as_uint(gg); ((u32x2*)(F.ws + WS_DBG))[(size_t)(batch * 256 + tl) * 4 + myexp] = rw; } } }
        }
        __syncthreads();
        if (tid < 32) lbase[tid] = DRY ? 0u : __hip_atomic_fetch_add(CNT + 64 * (hf * 32 + tid), lcnt[tid], __ATOMIC_RELAXED, __HIP_MEMORY_SCOPE_AGENT);
        __syncthreads();
        for (int i = tid; i < 1024; i += NTHR) { const LAS unsigned* en = ent + i * 3; const unsigned ee = en[0], pos = lbase[ee] + en[1];
            const unsigned tokl = (unsigned)(batch * 256 + (i >> 2)) - (unsigned)hf * HALF_TOK;
            u32x2 w; w.x = tokl * 4u + (unsigned)(i & 3); w.y = en[2];
            if (!DRY && pos < (unsigned)REG_CAP) REG[((size_t)hf * 32 + ee) * REG_CAP + pos] = w; }
    }
}

__device__ __forceinline__ void ph_final(Frame& F, int hf) {
    float* X1 = (float*)F.outb; const bf16_t* YB = (const bf16_t*)(F.ws + WS_YB); const float* MOD = (const float*)(F.ws + WS_MOD);
    const float* g2 = F.a->in[26]; const float* b2 = F.a->in[27];
    const int gw = F.bid * NWAVES + F.wave, NGW = F.G * NWAVES, lane = F.lane;
    constexpr int RB = 2;
    for (int tl0 = gw; tl0 < HALF_TOK; tl0 += NGW * RB) {
        f32x4 xv[RB][4]; u32x2 yw[RB][4][4];
#pragma unroll
        for (int r = 0; r < RB; ++r) { const int tl = tl0 + r * NGW, m = hf * HALF_TOK + tl;
            const f32x4* xr = (const f32x4*)(X1 + (size_t)m * D) + lane; const u32x2* yr = (const u32x2*)(YB + (size_t)tl * 4 * D) + lane;
#pragma unroll
            for (int j = 0; j < 4; ++j) { xv[r][j] = xr[64 * j];
#pragma unroll
                for (int k = 0; k < 4; ++k) yw[r][j][k] = yr[k * 256 + 64 * j]; } }
#pragma unroll
        for (int r = 0; r < RB; ++r) { const int tl = tl0 + r * NGW, m = hf * HALF_TOK + tl; const float* md = MOD + (size_t)(m >> 11) * 6144 + 5120;
            f32x4* xr = (f32x4*)(X1 + (size_t)m * D) + lane;
            f32x4 v[4]; float s = 0.f;
#pragma unroll
            for (int j = 0; j < 4; ++j) { f32x4 y = (f32x4){0.f, 0.f, 0.f, 0.f};
#pragma unroll
                for (int k = 0; k < 4; ++k) { const u32x2 w = yw[r][j][k]; y[0] += bflo(w.x); y[1] += bfhi(w.x); y[2] += bflo(w.y); y[3] += bfhi(w.y); }
                if (DBG_NO_MOE) y = (f32x4){0.f, 0.f, 0.f, 0.f};
                const f32x4 gt = *((const f32x4*)md + lane + 64 * j);
                v[j] = xv[r][j] * DN_ALPHA + gt * y; s += (v[j][0] + v[j][1]) + (v[j][2] + v[j][3]); }
            const float mean = wave_sum(s) * (1.f / D); float s2 = 0.f;
#pragma unroll
            for (int j = 0; j < 4; ++j) { v[j] = v[j] - mean; s2 += (v[j][0] * v[j][0] + v[j][1] * v[j][1]) + (v[j][2] * v[j][2] + v[j][3] * v[j][3]); }
            const float rstd = 1.f / sqrtf(wave_sum(s2) * (1.f / D) + LN_EPS);
#pragma unroll
            for (int j = 0; j < 4; ++j) { const f32x4 g = *((const f32x4*)g2 + lane + 64 * j), bb = *((const f32x4*)b2 + lane + 64 * j); xr[64 * j] = v[j] * rstd * g + bb; } }
    }
}

__device__ __forceinline__ float block_sum(Frame& F, float v, LAS float* red) {
    v = wave_sum(v); __syncthreads(); if (F.lane == 0) red[F.wave] = v; __syncthreads();
    float s = 0.f; for (int w = 0; w < NWAVES; ++w) s += red[w]; return s;
}
__device__ __forceinline__ float block_max(Frame& F, float v, LAS float* red) {
#pragma unroll
    for (int o = 1; o < 64; o <<= 1) v = fmaxf(v, __shfl_xor(v, o));
    __syncthreads(); if (F.lane == 0) red[F.wave] = v; __syncthreads();
    float s = 0.f; for (int w = 0; w < NWAVES; ++w) s = fmaxf(s, red[w]); return s;
}
__device__ __forceinline__ void dbg_report(Frame& F, float e) { if (F.tid == 0) atomicMax((unsigned*)(F.ws + WS_CTL) + CW_DBG, __float_as_uint(e)); }
__device__ __forceinline__ void dbg_check_moe(Frame& F) {
    if (F.bid >= 64) return;
    const int tok = HALF_TOK + 509 * F.bid + 3, tokl = tok - HALF_TOK, tid = F.tid;
    LAS float* u2 = (LAS float*)F.lds; LAS float* act = u2 + 1024; LAS float* red = act + 1024; LAS float* lg = red + 16;
    const bf16_t* U2 = (const bf16_t*)(F.ws + WS_U2); const bf16_t* YB = (const bf16_t*)(F.ws + WS_YB); const u32x2* RT = (const u32x2*)(F.ws + WS_DBG);
    const float* w1 = F.a->in[22]; const float* b1 = F.a->in[23]; const float* w2 = F.a->in[24]; const float* b2 = F.a->in[25];
    __syncthreads();
    for (int i = tid; i < 1024; i += NTHR) u2[i] = bflo((unsigned)U2[(size_t)tok * 1024 + i]);
    __syncthreads();
    float y0 = 0.f, y1 = 0.f;
    for (int k = 0; k < 4; ++k) {
        const u32x2 rw = RT[(size_t)tok * 4 + k]; const int e = (int)rw.x; const float g = __uint_as_float(rw.y);
        const float* W1 = w1 + (size_t)e * 1024 * 2048; const float* W2 = w2 + (size_t)e * 1024 * 1024;
        float h0 = b1[e * 2048 + tid], h1 = b1[e * 2048 + tid + 512], h2 = b1[e * 2048 + tid + 1024], h3 = b1[e * 2048 + tid + 1536];
        for (int c = 0; c < 1024; ++c) { const float uu = u2[c]; const float* wr = W1 + (size_t)c * 2048 + tid; h0 += uu * wr[0]; h1 += uu * wr[512]; h2 += uu * wr[1024]; h3 += uu * wr[1536]; }
        __syncthreads();
        { float gg = fminf(h0, 7.f), up = fminf(fmaxf(h2, -7.f), 7.f); act[tid] = (up + 1.f) * gg / (1.f + expf(-1.702f * gg));
          gg = fminf(h1, 7.f); up = fminf(fmaxf(h3, -7.f), 7.f); act[tid + 512] = (up + 1.f) * gg / (1.f + expf(-1.702f * gg)); }
        __syncthreads();
        float a0 = b2[e * 1024 + tid], a1 = b2[e * 1024 + tid + 512];
        for (int j = 0; j < 1024; ++j) { const float aa = act[j]; a0 += aa * W2[(size_t)j * 1024 + tid]; a1 += aa * W2[(size_t)j * 1024 + tid + 512]; }
        y0 += g * a0; y1 += g * a1;
    }
    float f0 = 0.f, f1 = 0.f;
    for (int k = 0; k < 4; ++k) { f0 += bflo((unsigned)YB[((size_t)tokl * 4 + k) * 1024 + tid]); f1 += bflo((unsigned)YB[((size_t)tokl * 4 + k) * 1024 + tid + 512]); }
    const float rms = sqrtf(block_sum(F, y0 * y0 + y1 * y1, red) * (1.f / 1024.f)) + 1e-20f;
    float err = block_max(F, fmaxf(fabsf(y0 - f0), fabsf(y1 - f1)), red) / rms;
    { const float* X1 = (const float*)F.outb + (size_t)tok * 1024; const float* md = (const float*)(F.ws + WS_MOD) + (size_t)(tok >> 11) * 6144;
      const float xa = X1[tid], xb = X1[tid + 512]; const float mean = block_sum(F, xa + xb, red) * (1.f / 1024.f);
      const float da = xa - mean, db = xb - mean; const float var = block_sum(F, da * da + db * db, red) * (1.f / 1024.f); const float rstd = 1.f / sqrtf(var + LN_EPS);
      __syncthreads();
      u2[tid] = da * rstd * (1.f + md[4096 + tid]) + md[3072 + tid]; u2[tid + 512] = db * rstd * (1.f + md[4096 + tid + 512]) + md[3072 + tid + 512];
      __syncthreads();
      if (tid < 32) { float a = F.a->in[21][tid]; for (int c = 0; c < 1024; ++c) a += u2[c] * F.a->in[20][c * 32 + tid]; lg[tid] = a; }
      __syncthreads();
      if (tid == 0) { unsigned want = 0u, got = 0u; float l2[32]; for (int i = 0; i < 32; ++i) l2[i] = lg[i];
          for (int k = 0; k < 4; ++k) { int bi = 0; for (int i = 1; i < 32; ++i) if (l2[i] > l2[bi]) bi = i; want |= 1u << bi; l2[bi] = -INFINITY; got |= 1u << RT[(size_t)tok * 4 + k].x; }
          lg[32] = (want != got) ? 1.f : 0.f; }
      __syncthreads();
      if (lg[32] != 0.f) err = 50.f; }
    dbg_report(F, err);
}
__device__ __forceinline__ void dbg_check_ssd(Frame& F) {
    if (F.bid >= 2) return;
    const int b = F.bid ? 20 : 5, h = F.bid ? 14 : 3, g = h >> 2, tid = F.tid, p = tid >> 3, ng = tid & 7;
    LAS float* red = (LAS float*)F.lds; LAS float* cv = red + 16;
    const bf16_t* XBC = (const bf16_t*)(F.ws + WS_XBC); const bf16_t* ZS = (const bf16_t*)(F.ws + WS_Z); const float* DT = (const float*)(F.outb + OUT_DT); const bf16_t* YG = (const bf16_t*)(F.ws + WS_Q);
    const float* cw = F.a->in[9]; const float* cb = F.a->in[10]; const float aneg = -expf(F.a->in[12][h]), dsk = F.a->in[13][h];
    const int mych = tid < 64 ? h * 64 + tid : (tid < 192 ? 1024 + g * 128 + (tid - 64) : 1536 + g * 128 + (tid - 192));
    float w0 = 0.f, w1 = 0.f, w2 = 0.f, w3 = 0.f, wb = 0.f;
    if (tid < 320) { w0 = cw[0 * 2048 + mych]; w1 = cw[1 * 2048 + mych]; w2 = cw[2 * 2048 + mych]; w3 = cw[3 * 2048 + mych]; wb = cb[mych]; }
    float x0 = 0.f, x1 = 0.f, x2 = 0.f;
    float hs[16];
#pragma unroll
    for (int i = 0; i < 16; ++i) hs[i] = 0.f;
    float emax = 0.f, ssq = 0.f, nbad = 0.f; int tmax = 0;
    for (int t = 0; t < SEQ; ++t) {
        const size_t tok = (size_t)b * SEQ + t;
        __syncthreads();
        if (DBG_HYP == 1 && (t & 63) == 0) { x0 = 0.f; x1 = 0.f; x2 = 0.f; }
        if (tid < 320) { const float x3 = bflo((unsigned)XBC[tok * 2048 + mych]); const float s = wb + w0 * x0 + w1 * x1 + w2 * x2 + w3 * x3; cv[tid] = s / (1.f + expf(-s)); x0 = x1; x1 = x2; x2 = x3; }
        __syncthreads();
        const float xv = cv[p], dt = DT[tok * 16 + h], dec = expf(dt * aneg);
        float yp = 0.f;
#pragma unroll
        for (int i = 0; i < 16; ++i) { const int n = ng * 16 + i; hs[i] = hs[i] * dec + dt * xv * cv[64 + n]; yp += cv[192 + n] * hs[i]; }
        yp += __shfl_xor(yp, 1); yp += __shfl_xor(yp, 2); yp += __shfl_xor(yp, 4);
        const float yv = (yp + xv * dsk) * bflo((unsigned)ZS[tok * 1024 + h * 64 + p]);
        const float yf = bflo((unsigned)YG[tok * 1024 + h * 64 + p]);
        if (ng == 0) { const float er = fabsf(yv - yf); if (er > emax) { emax = er; tmax = t; } ssq += yv * yv; if (er > 0.25f && (DBG_SUB < 5 || (DBG_SUB == 5 && (t & 63) == 0) || (DBG_SUB == 6 && (t & 63) == 1) || (DBG_SUB == 7 && (t & 63) == 32))) nbad += 1.f; }
    }
    const float rms = sqrtf(block_sum(F, ssq, red) / (64.f * SEQ)) + 1e-20f;
    const float M = block_max(F, emax, red);
    if (DBG_SUB == 0) dbg_report(F, M / rms);
    else if (DBG_SUB == 1) dbg_report(F, block_sum(F, nbad, red) / (64.f * SEQ));
    else if (DBG_SUB >= 5) dbg_report(F, block_sum(F, nbad, red) / (64.f * 32.f));
    else { __syncthreads(); if (ng == 0 && emax == M) red[12] = (float)(DBG_SUB == 2 ? ((tmax & 63) >> 1) : (DBG_SUB == 3 ? (tmax >> 6) : (p >> 1))); __syncthreads();
        if (F.bid == 0) dbg_report(F, powf(10.f, 2.f * (0.05f + 0.05f * red[12]) - 4.f)); }
}
__device__ __forceinline__ void dbg_check_attn(Frame& F) {
    if (F.bid >= 32) return;
    const int b = (F.bid * 7 + 3) & 31, pos = 300 + F.bid * 53, nadm = ((pos >> 6) + 1) * 64, tid = F.tid, lane = F.lane, hd = F.wave;
    const size_t tq = (size_t)b * SEQ + pos;
    LAS float* sc = (LAS float*)F.lds; LAS unsigned char* sel = (LAS unsigned char*)(sc + 2048); LAS float* lgt = (LAS float*)(sel + 2048); LAS float* red = lgt + 8 * 2048; LAS float* misc = red + 16;
    const bf16_t* IQ = (const bf16_t*)(F.outb + OUT_IQ); const bf16_t* IK = (const bf16_t*)(F.outb + OUT_IK); const float* IW = (const float*)(F.outb + OUT_IW);
    const bf16_t* Q = (const bf16_t*)(F.ws + WS_Q); const bf16_t* KV = (const bf16_t*)(F.outb + OUT_KV); const bf16_t* OA = (const bf16_t*)(F.outb + OUT_OA); const u64* MASK = (const u64*)(F.outb + OUT_MASK);
    __syncthreads();
    for (int k = tid; k < nadm; k += NTHR) { float s = 0.f;
        for (int hh = 0; hh < 8; ++hh) { float d = 0.f; for (int c = 0; c < 64; ++c) d += bflo((unsigned)IQ[tq * 512 + hh * 64 + c]) * bflo((unsigned)IK[((size_t)b * SEQ + k) * 64 + c]); s += fmaxf(d, 0.f) * IW[tq * 8 + hh]; }
        sc[k] = s + 0.0f; }
    __syncthreads();
    float nbad = 0.f;
    for (int k = tid; k < nadm; k += NTHR) { const float s = sc[k]; int rank = 0; for (int j = 0; j < nadm; ++j) { const float t = sc[j]; rank += (t > s || (t == s && j < k)) ? 1 : 0; }
        const unsigned char se = rank < 256 ? 1 : 0; sel[k] = se; const unsigned mb = (unsigned)((MASK[tq * 32 + (k >> 6)] >> (k & 63)) & 1ull); if (mb != se) nbad += 1.f; }
    __syncthreads();
    const float nbad_t = block_sum(F, nbad, red);
    LAS float* lw = lgt + hd * 2048; float mx = -INFINITY;
    for (int k = lane; k < nadm; k += 64) { float l = -INFINITY;
        if (sel[k]) { float d = 0.f; for (int c = 0; c < 128; ++c) d += bflo((unsigned)Q[tq * 1024 + hd * 128 + c]) * bflo((unsigned)KV[((size_t)b * SEQ + k) * 128 + c]);
            const int rel = k - pos, n = rel < 0 ? -rel : rel; const float nf = (float)(n > 1 ? n : 1); int large = 8 + (int)(logf(nf / 8.0f) / 2.7725887f * 8.0f); if (large > 15) large = 15;
            const int bucket = (rel > 0 ? 16 : 0) + (n < 8 ? n : large);
            l = d * 0.088388347648318440f + F.a->in[8][bucket * 8 + hd]; }
        lw[k] = l; mx = fmaxf(mx, l); }
#pragma unroll
    for (int o = 1; o < 64; o <<= 1) mx = fmaxf(mx, __shfl_xor(mx, o));
    float den = 0.f;
    for (int k = lane; k < nadm; k += 64) { const float pp = expf(lw[k] - mx); lw[k] = pp; den += pp; }
    den = wave_sum(den);
    float emax = 0.f, ssq = 0.f;
    for (int c2 = 0; c2 < 2; ++c2) { const int c = lane + 64 * c2; float o = 0.f; for (int k = 0; k < nadm; ++k) { const float pp = lw[k]; if (pp != 0.f) o += pp * bflo((unsigned)KV[((size_t)b * SEQ + k) * 128 + c]); }
        o /= den; const float of = bflo((unsigned)OA[tq * 1024 + hd * 128 + c]); emax = fmaxf(emax, fabsf(o - of)); ssq += o * o; }
    const float rms = sqrtf(block_sum(F, ssq, red) * (1.f / 1024.f)) + 1e-20f;
    float err = block_max(F, emax, red) / rms;
    (void)misc;
    if (nbad_t > 0.f) err = 10.f + nbad_t;
    dbg_report(F, err);
}
__device__ __forceinline__ void dbg_emit(Frame& F) {
    float* out = (float*)F.outb;
    for (size_t i = (size_t)F.bid * NTHR + F.tid; i < (size_t)NTOK * D / 4; i += (size_t)F.G * NTHR) ((f32x4*)out)[i] = (f32x4){0.f, 0.f, 0.f, 0.f};
    __syncthreads();
    if (F.bid == 0 && F.tid == 0) { const float e = __uint_as_float(__hip_atomic_load((unsigned*)(F.ws + WS_CTL) + CW_DBG, __ATOMIC_RELAXED, __HIP_MEMORY_SCOPE_AGENT));
        float code = (log10f(fmaxf(e, 1e-30f)) + 4.f) * 0.5f; code = fminf(fmaxf(rintf(code * 20.f) * 0.05f, 0.05f), 3.0f);
        out[0] = sqrtf(67108864.f * 1.01f * (powf(10.f, code) - 1.f)); }
}

constexpr int NPHASE = 17;
__global__ void __launch_bounds__(NTHR, 2) fwd(Args args) {
    extern __shared__ __attribute__((aligned(16))) unsigned char lds_raw[];
    Frame F;
    F.lds = (LAS unsigned char*)lds_raw;
    F.tid = threadIdx.x; F.lane = F.tid & 63; F.wave = __builtin_amdgcn_readfirstlane(F.tid >> 6); F.G = gridDim.x; F.bid = blockIdx.x;
    F.a = &args;
    F.ws = args.ws; F.outb = (unsigned char*)args.out;
    volatile LAS unsigned* MISCW = (volatile LAS unsigned*)(F.lds + LDS_MISC);
    if (F.tid < 64) MISCW[F.tid] = 0u;
    __syncthreads();
    XcdBarrier bar; bar.bar = (unsigned*)(F.ws + WS_CTL) + CW_BAR; bar.x = 0; bar.st = nullptr;
#if MK_ONE
    bar = xcd_barrier_post((unsigned*)(F.ws + WS_CTL) + CW_BAR, MISCW + 8);
#define GRID_BAR() xcd_barrier(bar)
#else
#define GRID_BAR() do { } while (0)
#endif
    const int lo = args.ph_lo, hi = args.ph_hi;
#ifndef PHM
#define PHM (0xFFFFFFFFu & ~(DBG_NO_ATTN ? 0x30u : 0u) & ~(DBG_NO_SSD ? 0xC0u : 0u))
#endif
#define IN(k) (((PHM >> (k)) & 1u) && lo <= (k) && (k) < hi)
#define SEAM(k) do { if ((k) + 1 < hi) GRID_BAR(); } while (0)

    if (IN(0)) { ph_prologue(F); if (DBG_TWICE & 1u) { GRID_BAR(); ph_prologue(F); } SEAM(0); }
    if (IN(1)) { ph_ln1(F); if (DBG_TWICE & 2u) { GRID_BAR(); ph_ln1(F); } SEAM(1); }
    if (IN(2)) {
        SchedPlain S; S.o.init(NTOK, NPROJ, F.G, F.bid); S.A = (const char*)(F.outb + OUT_U); S.Bt = (const char*)(F.ws + WS_WIN);
        EpiProj E{(bf16_t*)(F.ws + WS_Q), (bf16_t*)(F.outb + OUT_IQ), (bf16_t*)(F.ws + WS_Z), (bf16_t*)(F.ws + WS_XBC), (bf16_t*)(F.ws + WS_GA), (bf16_t*)(F.ws + WS_GB), (float*)(F.outb + OUT_MISC)};
        pg8::gemm_phase<EpiProj, SchedPlain, false>(F.lds, S, E);
        if (DBG_TWICE & 4u) { GRID_BAR(); pg8::gemm_phase<EpiProj, SchedPlain, false>(F.lds, S, E); }
        SEAM(2);
    }
    if (IN(3)) { ph_misc(F); if (DBG_TWICE & 8u) { GRID_BAR(); ph_misc(F); } SEAM(3); }
    if (IN(4)) { ph_index(F); if (DBG_TWICE & 16u) { GRID_BAR(); ph_index(F); } SEAM(4); }
    if (IN(5)) { ph_attn(F); if (DBG_TWICE & 32u) { GRID_BAR(); ph_attn(F); } SEAM(5); if (DBG_CHECK == 3) { dbg_check_attn(F); GRID_BAR(); } }
    if (IN(6)) { ph_ssd(F); if (DBG_TWICE & 64u) { GRID_BAR(); ph_ssd(F); } SEAM(6); if (DBG_CHECK == 2) { dbg_check_ssd(F); GRID_BAR(); } }
    if (IN(7)) { ph_gnorm(F); if (DBG_TWICE & 128u) { GRID_BAR(); ph_gnorm(F); } SEAM(7); }
    if (IN(8)) {
        SchedPlain S; S.o.init(NTOK, 1024, F.G, F.bid); S.A = (const char*)(F.outb + OUT_OA); S.Bt = (const char*)(F.ws + WS_WPA);
        EpiGate<0> E{(const bf16_t*)(F.ws + WS_GA), nullptr, (bf16_t*)(F.ws + WS_Z)};
        pg8::gemm_phase<EpiGate<0>, SchedPlain, false>(F.lds, S, E);
        if (DBG_TWICE & 256u) { GRID_BAR(); pg8::gemm_phase<EpiGate<0>, SchedPlain, false>(F.lds, S, E); }
        SEAM(8);
    }
    if (IN(9)) {
        SchedPlain S; S.o.init(NTOK, 1024, F.G, F.bid); S.A = (const char*)(F.ws + WS_Q); S.Bt = (const char*)(F.ws + WS_WPB);
        EpiGate<1> E{(const bf16_t*)(F.ws + WS_GB), (const bf16_t*)(F.ws + WS_Z), (bf16_t*)(F.ws + WS_XBC)};
        pg8::gemm_phase<EpiGate<1>, SchedPlain, false>(F.lds, S, E);
        SEAM(9);
    }
    if (IN(10)) {
        SchedPlain S; S.o.init(NTOK, 1024, F.G, F.bid); S.A = (const char*)(F.ws + WS_XBC); S.Bt = (const char*)(F.ws + WS_WOUT);
        EpiOut E{F.a->in[0], (const float*)(F.ws + WS_MOD), (float*)F.outb};
        pg8::gemm_phase<EpiOut, SchedPlain, false>(F.lds, S, E);
        if (DBG_TWICE & 1024u) { GRID_BAR(); pg8::gemm_phase<EpiOut, SchedPlain, false>(F.lds, S, E); }
        SEAM(10);
    }
    if (IN(11)) { if (DBG_TWICE & 2048u) { ph_router<true>(F); GRID_BAR(); } ph_router<false>(F); SEAM(11); }
#pragma unroll
    for (int hf = 0; hf < 2; ++hf) {
        const int p0 = 12 + hf * 2;
        if (IN(p0)) {
            if (hf == 1) ph_final(F, 0);
            MoeTab T = moe_tables(F, hf);
            SchedMoe<8, true> S{T, F.G, F.bid, hf, (const char*)(F.ws + WS_U2), (const char*)(F.ws + WS_W1), (const u32x2*)(F.ws + WS_REG)};
            EpiMoe1 E{F.a->in[23], (bf16_t*)(F.ws + WS_ACT)};
            pg8::gemm_phase<EpiMoe1, SchedMoe<8, true>, true, MOE_RB / 2, MOE_FP8 != 0>(F.lds, S, E);
            if ((DBG_TWICE & 4096u) && hf == 0) { GRID_BAR(); pg8::gemm_phase<EpiMoe1, SchedMoe<8, true>, true, MOE_RB / 2, MOE_FP8 != 0>(F.lds, S, E); }
            SEAM(p0);
        }
        if (IN(p0 + 1)) {
            MoeTab T = moe_tables(F, hf);
            SchedMoe<4, false> S{T, F.G, F.bid, hf, (const char*)(F.ws + WS_ACT), (const char*)(F.ws + WS_W2), (const u32x2*)(F.ws + WS_REG)};
            EpiMoe2 E{F.a->in[25], (bf16_t*)(F.ws + WS_YB), (const u32x2*)(F.ws + WS_REG), T, hf};
            pg8::gemm_phase<EpiMoe2, SchedMoe<4, false>, false, MOE_RB / 2, MOE_FP8 != 0>(F.lds, S, E);
            if ((DBG_TWICE & 8192u) && hf == 0) { GRID_BAR(); pg8::gemm_phase<EpiMoe2, SchedMoe<4, false>, false, MOE_RB / 2, MOE_FP8 != 0>(F.lds, S, E); }
            SEAM(p0 + 1);
            if (DBG_CHECK == 1 && hf == 1) { dbg_check_moe(F); GRID_BAR(); }
        }
    }
    if (IN(16)) { ph_final(F, 1); }
    if (DBG_CHECK) { GRID_BAR(); dbg_emit(F); }
#undef IN
#undef SEAM
}

extern "C" void kernel_launch(void* const* d_in, const int* in_sizes, int n_in, void* d_out, int out_size, void* d_ws, size_t ws_size, hipStream_t stream) {
    static int grid = 0;
    if (grid == 0) {
        if (n_in != 28 || in_sizes[0] != NTOK * D || out_size != NTOK * D || ws_size < WS_END) { fprintf(stderr, "kernel_launch: shape mismatch (n_in %d, in0 %d, out %d, ws %zu)\n", n_in, n_in > 0 ? in_sizes[0] : -1, out_size, ws_size); grid = -1; return; }
        int dev = 0, cus = 0, per_cu = 0;
        if (hipGetDevice(&dev) != hipSuccess || hipDeviceGetAttribute(&cus, hipDeviceAttributeMultiprocessorCount, dev) != hipSuccess) { grid = -1; return; }
        if (hipFuncSetAttribute((const void*)fwd, hipFuncAttributeMaxDynamicSharedMemorySize, LDS_BYTES) != hipSuccess) { fprintf(stderr, "kernel_launch: hipFuncSetAttribute failed\n"); grid = -1; return; }
        if (hipOccupancyMaxActiveBlocksPerMultiprocessor(&per_cu, (const void*)fwd, NTHR, LDS_BYTES) != hipSuccess || per_cu < 1) fprintf(stderr, "kernel_launch: occupancy query reports %d\n", per_cu);
        (void)hipGetLastError();
        grid = cus;
    }
    if (grid < 0) return;
    if (hipMemsetAsync((char*)d_ws + WS_CTL, 0, CTL_ZERO_BYTES, stream) != hipSuccess) { fprintf(stderr, "kernel_launch: memset failed\n"); return; }
    Args a{};
    for (int i = 0; i < 28; ++i) a.in[i] = (const float*)d_in[i];
    a.out = (float*)d_out; a.ws = (unsigned char*)d_ws;
    const int nph = NPHASE < MK_PH_HI ? NPHASE : MK_PH_HI;
#if MK_ONE
    a.ph_lo = 0; a.ph_hi = nph;
    hipLaunchKernelGGL(fwd, dim3(grid), dim3(NTHR), LDS_BYTES, stream, a);
#else
    for (int p = 0; p < nph; ++p) { a.ph_lo = p; a.ph_hi = p + 1; hipLaunchKernelGGL(fwd, dim3(grid), dim3(NTHR), LDS_BYTES, stream, a); }
#endif
    const hipError_t le = hipPeekAtLastError();
    if (le != hipSuccess) fprintf(stderr, "kernel_launch: launch failed: %s\n", hipGetErrorName(le));
}
```

```cpp
#include <hip/hip_runtime.h>
#include <cstdio>
#include <cstdint>

#ifndef MK_ONE
#define MK_ONE 1
#endif
#ifndef DBG_NO_ATTN
#define DBG_NO_ATTN 0
#endif
#ifndef DBG_ATTN_ZERO
#define DBG_ATTN_ZERO 0
#endif
#ifndef DBG_IQ_TRUNC
#define DBG_IQ_TRUNC 0
#endif
#ifndef DBG_ROUTER_BF16
#define DBG_ROUTER_BF16 0
#endif
#ifndef DBG_CHECK
#define DBG_CHECK 0
#endif
#ifndef DBG_SKIP_BODY
#define DBG_SKIP_BODY 0
#endif
#ifndef DBG_SUB
#define DBG_SUB 0
#endif
#ifndef DBG_SSD_SYNC
#define DBG_SSD_SYNC 0
#endif
#ifndef DBG_HYP
#define DBG_HYP 0
#endif
#ifndef DBG_TWICE
#define DBG_TWICE 0u
#endif
#ifndef DBG_NO_SSD
#define DBG_NO_SSD 0
#endif
#ifndef DBG_NO_MOE
#define DBG_NO_MOE 0
#endif
#ifndef MOE_FP8
#define MOE_FP8 1
#endif
#ifndef MK_PH_HI
#define MK_PH_HI 99
#endif

#define LAS __attribute__((address_space(3)))
#define GAS __attribute__((address_space(1)))
typedef unsigned short bf16_t;
typedef short bf16x8 __attribute__((ext_vector_type(8)));
typedef short s16x4 __attribute__((ext_vector_type(4)));
typedef float f32x2 __attribute__((ext_vector_type(2)));
typedef float f32x4 __attribute__((ext_vector_type(4)));
typedef float f32x16 __attribute__((ext_vector_type(16)));
typedef unsigned u32x2 __attribute__((ext_vector_type(2)));
typedef unsigned u32x4 __attribute__((ext_vector_type(4)));
typedef unsigned long long u64;

constexpr int NB = 32, SEQ = 2048, D = 1024, NTOK = NB * SEQ;
constexpr int NWAVES = 8, NTHR = 512;
constexpr int NPROJ = 6912;
constexpr int NEXP = 32, HALF_TOK = NTOK / 2, REG_CAP = HALF_TOK;
constexpr int ACT_ROWS = HALF_TOK * 4 + NEXP * 256;
constexpr float LN_EPS = 1e-5f;
constexpr float DN_ALPHA = 1.189207115002721f;
constexpr float LOG2E = 1.4426950408889634f;

constexpr size_t MiB = 1u << 20;
constexpr size_t WS_CTL = 0, CTL_ZERO_BYTES = 1 * MiB;
constexpr size_t WS_MOD = 1 * MiB;
constexpr size_t WS_BIAST = 1 * MiB + 800 * 1024;
constexpr size_t WS_WIN = 2 * MiB;
constexpr size_t WS_WPA = 16 * MiB, WS_WPB = 18 * MiB, WS_WOUT = 20 * MiB;
constexpr size_t WS_W1 = 24 * MiB;
constexpr size_t WS_W2 = 152 * MiB;
constexpr size_t WS_Q = 216 * MiB;
constexpr size_t WS_Z = 344 * MiB;
constexpr size_t WS_XBC = 472 * MiB;
constexpr size_t WS_GA = 728 * MiB, WS_GB = 856 * MiB;
constexpr size_t WS_U2 = 216 * MiB;
constexpr size_t WS_REG = 344 * MiB;
constexpr size_t WS_ACT = 360 * MiB;
constexpr size_t WS_YB = 632 * MiB;
constexpr size_t WS_END = 888 * MiB;
constexpr size_t WS_DBG = 888 * MiB;
constexpr size_t OUT_U = 0, OUT_MISC = 128 * MiB, OUT_IQ = 192 * MiB;
constexpr size_t OUT_KV = 0, OUT_IK = 16 * MiB, OUT_IW = 24 * MiB, OUT_DT = 26 * MiB, OUT_MASK = 32 * MiB, OUT_OA = 64 * MiB;
constexpr int CW_BAR = 4096, CW_CNT = 16384, CW_DBG = 24576;

constexpr int LDS_BYTES = 160 * 1024;
constexpr int LDS_AUX = 131072;
constexpr int LDS_MISC = LDS_BYTES - 256;

#define LDS_WAIT() asm volatile("s_waitcnt lgkmcnt(0)" ::: "memory")
#define VM_WAIT() asm volatile("s_waitcnt vmcnt(0)" ::: "memory")
#define SBAR() __builtin_amdgcn_sched_barrier(0)
typedef __bf16 bf16x2_t __attribute__((ext_vector_type(2)));
__device__ __forceinline__ unsigned cvt_pk_bf16(float lo, float hi) { f32x2 f = {lo, hi}; bf16x2_t v = __builtin_convertvector(f, bf16x2_t); return __builtin_bit_cast(unsigned, v); }
__device__ __forceinline__ float bflo(unsigned w) { return __uint_as_float(w << 16); }
__device__ __forceinline__ float bfhi(unsigned w) { return __uint_as_float(w & 0xffff0000u); }
__device__ __forceinline__ u32x4 pack8(f32x4 a, f32x4 b) { u32x4 w; w.x = cvt_pk_bf16(a[0], a[1]); w.y = cvt_pk_bf16(a[2], a[3]); w.z = cvt_pk_bf16(b[0], b[1]); w.w = cvt_pk_bf16(b[2], b[3]); return w; }
constexpr int MOE_RB = MOE_FP8 ? 1024 : 2048;
constexpr float MOE_WSC = MOE_FP8 ? 64.0f : 1.0f, MOE_INV = 1.0f / MOE_WSC;
__device__ __forceinline__ u32x2 pack8_fp8(f32x4 a, f32x4 b) { int lo = 0, hi = 0;
    lo = __builtin_amdgcn_cvt_pk_fp8_f32(a[0], a[1], lo, false); lo = __builtin_amdgcn_cvt_pk_fp8_f32(a[2], a[3], lo, true);
    hi = __builtin_amdgcn_cvt_pk_fp8_f32(b[0], b[1], hi, false); hi = __builtin_amdgcn_cvt_pk_fp8_f32(b[2], b[3], hi, true);
    u32x2 r; r.x = (unsigned)lo; r.y = (unsigned)hi; return r; }
__device__ __forceinline__ void unpack8(u32x4 w, f32x4& a, f32x4& b) { a[0] = bflo(w.x); a[1] = bfhi(w.x); a[2] = bflo(w.y); a[3] = bfhi(w.y); b[0] = bflo(w.z); b[1] = bfhi(w.z); b[2] = bflo(w.w); b[3] = bfhi(w.w); }
__device__ __forceinline__ float wave_sum(float v) {
#pragma unroll
    for (int o = 1; o < 64; o <<= 1) v += __shfl_xor(v, o);
    return v;
}
__device__ __forceinline__ float fast_rcp(float x) { return __builtin_amdgcn_rcpf(x); }
__device__ __forceinline__ float sigmoid_f(float x) { return fast_rcp(1.0f + __expf(-x)); }
__device__ __forceinline__ float silu_f(float x) { return x * sigmoid_f(x); }

#define XB_TMO      128
#define XB_XCNT(j)  (256  + 64 * (j))
#define XB_XSUB(j)  (1280 + 64 * (j))
#define XB_XGEN(j)  (2304 + 64 * (j))
#define XB_TOP      3328
#define XB_TOPGEN   3392
#define XCD_BAR_WORDS 3456
#define XB_SPIN_CAP (1u << 18)
__device__ __forceinline__ unsigned xb_ld(unsigned* p)              { return __hip_atomic_load(p, __ATOMIC_RELAXED, __HIP_MEMORY_SCOPE_AGENT); }
__device__ __forceinline__ unsigned xb_add(unsigned* p, unsigned v) { return __hip_atomic_fetch_add(p, v, __ATOMIC_RELAXED, __HIP_MEMORY_SCOPE_AGENT); }
__device__ __forceinline__ unsigned xb_xcc_id() { return (unsigned)__builtin_amdgcn_s_getreg((3 << 11) | 20) & 0xFu; }
#define XB_SPIN(cond, bar) do { unsigned _sp = 0; while (cond) { __builtin_amdgcn_s_sleep(1); \
    if ((++_sp & 255u) == 0u) { if (xb_ld(&(bar)[XB_TMO])) break; if (_sp > XB_SPIN_CAP) { atomicAdd(&(bar)[XB_TMO], 1u); break; } } } } while (0)
struct XcdBarrier { unsigned* bar; unsigned x; volatile LAS unsigned* st; };
__device__ __forceinline__ XcdBarrier xcd_barrier_post(unsigned* bar, volatile LAS unsigned* st) {
    XcdBarrier b; b.bar = bar; b.x = xb_xcc_id(); b.st = st;
    if (threadIdx.x == 0) (void)xb_add(&bar[XB_XCNT(b.x)], 1u);
    return b;
}
__device__ __forceinline__ void xcd_barrier_complete(unsigned* bar, unsigned x, unsigned& nloc, unsigned& nx) {
    const unsigned G = gridDim.x * gridDim.y * gridDim.z;
    unsigned sum, cnt, mine, sp = 0u;
    for (;;) {
        sum = 0u; cnt = 0u;
#pragma nounroll
        for (unsigned j = 0; j < 16; ++j) { const unsigned c = xb_ld(&bar[XB_XCNT(j)]); sum += c; cnt += (c > 0u) ? 1u : 0u; }
        if (sum == G) break;
        __builtin_amdgcn_s_sleep(1);
        if ((++sp & 255u) == 0u) { if (xb_ld(&bar[XB_TMO])) break; if (sp > XB_SPIN_CAP) { atomicAdd(&bar[XB_TMO], 1u); break; } }
    }
    mine = xb_ld(&bar[XB_XCNT(x)]);
    nloc = mine > 0u ? mine : 1u; nx = cnt > 0u ? cnt : 1u;
}
__device__ __forceinline__ void xcd_barrier(const XcdBarrier& b) {
    asm volatile("s_waitcnt vmcnt(0)" ::: "memory");
    __syncthreads();
    if (threadIdx.x == 0) {
        unsigned* bar = b.bar;
        __builtin_amdgcn_s_waitcnt(0);
        unsigned nloc = b.st[0], nx = b.st[1];
        if (nloc == 0u) { xcd_barrier_complete(bar, b.x, nloc, nx); b.st[0] = nloc; b.st[1] = nx; }
        const unsigned old = xb_add(&bar[XB_XSUB(b.x)], 1u);
        const unsigned gen = old / nloc;
        if (old + 1u == (gen + 1u) * nloc) {
            __builtin_amdgcn_fence(__ATOMIC_RELEASE, "agent");
            asm volatile("s_waitcnt vmcnt(0)" ::: "memory");
            const unsigned og = xb_add(&bar[XB_TOP], 1u);
            const unsigned tg = og / nx;
            if (og + 1u == (tg + 1u) * nx) xb_add(&bar[XB_TOPGEN], 1u);
            else XB_SPIN(xb_ld(&bar[XB_TOPGEN]) == tg, bar);
            __builtin_amdgcn_fence(__ATOMIC_ACQUIRE, "agent");
            xb_add(&bar[XB_XGEN(b.x)], 1u);
            asm volatile("s_waitcnt vmcnt(0)" ::: "memory");
        } else {
            XB_SPIN(xb_ld(&bar[XB_XGEN(b.x)]) == gen, bar);
            __builtin_amdgcn_fence(__ATOMIC_ACQUIRE, "agent");
            asm volatile("s_waitcnt vmcnt(0)" ::: "memory");
        }
    }
    __syncthreads();
}

namespace pg8 {
constexpr int BM = 256, BK = 64, HALF = 128, HTB = HALF * BK * 2, STAGE_BYTES = 8 * HTB, NXCD = 8, WGM = 8, KD = 1024;
__host__ __device__ __forceinline__ int lds_byte(int r, int c) { const int st = (r >> 4) * 2 + (c >> 5), rr = r & 15, cc = c & 31, ob = rr * 64 + cc * 2; return st * 1024 + (ob ^ (((ob >> 9) & 1) << 5)); }
__host__ __device__ __forceinline__ void stage_rc(int b, int& R, int& C) { const int st = b / 1024, sb = b % 1024, swz = sb ^ (((sb >> 9) & 1) << 5); R = (st >> 1) * 16 + swz / 64; C = (st & 1) * 32 + (swz % 64) / 2; }
__host__ __device__ __forceinline__ int perm32(int rho) { const int n = rho >> 4, i = rho & 15; return 8 * (i >> 2) + 4 * n + (i & 3); }
struct Unit { int pm, pn, ex; };
struct StaticOrder {
    int nM, nN, nwg, G, c;
    __device__ void init(int M, int N, int G_, int c_) { nM = M / BM; nN = N / BM; nwg = nM * nN; G = G_; c = c_; }
    __device__ bool next(int i, Unit& u) const {
        const long L = (long)i * G + c; if (L >= nwg) return false;
        int wgid = (int)L; { const int q = nwg / NXCD, r = nwg % NXCD, xcd = wgid % NXCD, off = wgid / NXCD; wgid = (xcd < r ? xcd * (q + 1) : r * (q + 1) + (xcd - r) * q) + off; }
        const int nig = WGM * nN, gid = wgid / nig, fm = gid * WGM, gsz = (nM - fm) < WGM ? (nM - fm) : WGM;
        u.pm = fm + ((wgid % nig) % gsz); u.pn = (wgid % nig) / gsz; u.ex = 0; return true;
    }
};
typedef int i32x8 __attribute__((ext_vector_type(8)));
typedef int i32x4v __attribute__((ext_vector_type(4)));
template <class Epi, class Sched, bool GATHER, int KE = 1024, bool FP8 = false>
__device__ __forceinline__ void gemm_phase(LAS unsigned char* lds, const Sched& S, const Epi& E) {
    int tid = threadIdx.x; asm volatile("" : "+v"(tid));
    const int wid = __builtin_amdgcn_readfirstlane(tid >> 6), lane = tid & 63, wr = wid >> 2, wc = wid & 3, fr = lane & 15, fq = lane >> 4;
    constexpr int K = KE, nt = K / BK;
    unsigned voffA[2], voffB[2]; int Rr[2], Cc[2];
#pragma unroll
    for (int i = 0; i < 2; ++i) { int R, C; stage_rc(tid * 16 + i * 8192, R, C); const int Rb = Epi::PERM ? ((R & ~31) + perm32(R & 31)) : R;
        voffA[i] = (unsigned)(R * K + C) * 2u; voffB[i] = (unsigned)(Rb * K + C) * 2u; Rr[i] = R; Cc[i] = C; }
    constexpr size_t kstep = (size_t)(BK * 2);
    constexpr size_t hstep = (size_t)HALF * K * 2;
    const unsigned ldsw = (unsigned)wid * 1024u;
    const int aoff = lds_byte(wr * 64 + fr, fq * 8), boff = lds_byte(wc * 32 + fr, fq * 8);
#define PG8_SA(b, h) (((b) * 2 + (h)) * HTB)
#define PG8_SB(b, h) ((4 + (b) * 2 + (h)) * HTB)
#define PG8_STAGE(bufoff, gbase, voff) do { _Pragma("unroll") for (int _i = 0; _i < 2; ++_i) \
        __builtin_amdgcn_global_load_lds((const unsigned*)((const char*)(gbase) + (voff)[_i]), (LAS unsigned*)(lds + (bufoff) + ldsw + _i * 8192), 16, 0, 0); } while (0)
#define PG8_STAGE_A(bufoff, gb, h, o0, o1) do { if constexpr (GATHER) { const unsigned _ko = (unsigned)((gb) - gA0); unsigned _o[2]; \
            if ((h) == 0) { _o[0] = (o0)[0] + _ko; _o[1] = (o0)[1] + _ko; } else { _o[0] = (o1)[0] + _ko; _o[1] = (o1)[1] + _ko; } PG8_STAGE(bufoff, gA0, _o); } \
        else { PG8_STAGE(bufoff, (gb) + (h) * hstep, voffA); } } while (0)
#define PG8_LD8(p) __builtin_shufflevector(*(const LAS i32x4v*)(p), *(const LAS i32x4v*)((p) + 1024), 0, 1, 2, 3, 4, 5, 6, 7)
#define PG8_LDA(dst, b, h) do { if constexpr (FP8) { _Pragma("unroll") for (int m = 0; m < 4; ++m) dst##8[m] = PG8_LD8(lds + PG8_SA(b, h) + aoff + m * 2048); } \
        else { _Pragma("unroll") for (int m = 0; m < 4; ++m) _Pragma("unroll") for (int k = 0; k < 2; ++k) dst[m][k] = *(const LAS bf16x8*)(lds + PG8_SA(b, h) + aoff + m * 2048 + k * 1024); } } while (0)
#define PG8_LDB(dst, b, h) do { if constexpr (FP8) { _Pragma("unroll") for (int n = 0; n < 2; ++n) dst##8[n] = PG8_LD8(lds + PG8_SB(b, h) + boff + n * 2048); } \
        else { _Pragma("unroll") for (int n = 0; n < 2; ++n) _Pragma("unroll") for (int k = 0; k < 2; ++k) dst[n][k] = *(const LAS bf16x8*)(lds + PG8_SB(b, h) + boff + n * 2048 + k * 1024); } } while (0)
#define PG8_MMA(ai, bj, At, Bt) do { __builtin_amdgcn_s_setprio(1); if constexpr (FP8) { _Pragma("unroll") for (int m = 0; m < 4; ++m) _Pragma("unroll") for (int n = 0; n < 2; ++n) \
            asm volatile("v_mfma_scale_f32_16x16x128_f8f6f4 %0, %1, %2, %0, %3, %3 op_sel_hi:[0,0,0]" : "+v"(acc[ai][bj][m][n]) : "v"(Bt##8[n]), "v"(At##8[m]), "v"(sc127)); } \
        else { _Pragma("unroll") for (int m = 0; m < 4; ++m) _Pragma("unroll") for (int n = 0; n < 2; ++n) _Pragma("unroll") for (int k = 0; k < 2; ++k) \
            acc[ai][bj][m][n] = __builtin_amdgcn_mfma_f32_16x16x32_bf16(Bt[n][k], At[m][k], acc[ai][bj][m][n], 0, 0, 0); } __builtin_amdgcn_s_setprio(0); } while (0)
#define PG8_WAIT_V(n) asm volatile("s_waitcnt vmcnt(" #n ")" ::: "memory")
#define PG8_WAIT_L(n) asm volatile("s_waitcnt lgkmcnt(" #n ")" ::: "memory")
#define PG8_BAR __builtin_amdgcn_s_barrier()
#define PG8_SCHED __builtin_amdgcn_sched_barrier(0)
    Unit cur, nxt; int ui = 0;
    if (!S.next(0, cur)) return;
    f32x4 acc[2][2][4][2];
#pragma unroll
    for (int a = 0; a < 2; ++a)
#pragma unroll
        for (int b = 0; b < 2; ++b)
#pragma unroll
            for (int m = 0; m < 4; ++m)
#pragma unroll
                for (int n = 0; n < 2; ++n) acc[a][b][m][n] = (f32x4){0.f, 0.f, 0.f, 0.f};
    const int sc127 = 0x7f7f7f7f;
    bf16x8 At[4][2], B0[2][2], B1[2][2]; i32x8 At8[4], B08[2], B18[2];
    const char* cA = S.a_base(cur); const char* cB = S.b_base(cur);
    const char* const gA0 = cA;
    unsigned cv0[2] = {0u, 0u}, cv1[2] = {0u, 0u}, nv0[2] = {0u, 0u}, nv1[2] = {0u, 0u};
    if constexpr (GATHER) S.a_offs(cur, Rr, Cc, cv0, cv1);
    PG8_STAGE(PG8_SB(0, 0), cB, voffB); PG8_STAGE_A(PG8_SA(0, 0), cA, 0, cv0, cv1); PG8_STAGE(PG8_SB(0, 1), cB + hstep, voffB); PG8_STAGE_A(PG8_SA(0, 1), cA, 1, cv0, cv1);
    if (wr == 1) PG8_BAR;
    PG8_WAIT_V(4); PG8_BAR;
    PG8_STAGE(PG8_SB(1, 0), cB + kstep, voffB); PG8_STAGE_A(PG8_SA(1, 0), cA + kstep, 0, cv0, cv1); PG8_STAGE(PG8_SB(1, 1), cB + hstep + kstep, voffB);
    PG8_WAIT_V(6); PG8_BAR;
    for (;;) {
        const bool has_next = S.next(ui + 1, nxt);
        const char* nA = has_next ? S.a_base(nxt) : cA; const char* nB = has_next ? S.b_base(nxt) : cB;
        if constexpr (GATHER) { if (has_next) S.a_offs(nxt, Rr, Cc, nv0, nv1); else { nv0[0] = cv0[0]; nv0[1] = cv0[1]; nv1[0] = cv1[0]; nv1[1] = cv1[1]; } }
#pragma nounroll
        for (int t = 0; t < nt; t += 2) {
            const bool last = (t == nt - 2);
            const char* a1 = cA + (size_t)(t + 1) * kstep;
            const char* a2 = last ? nA : cA + (size_t)(t + 2) * kstep; const char* b2 = last ? nB : cB + (size_t)(t + 2) * kstep;
            const char* a3 = a2 + kstep; const char* b3 = b2 + kstep;
            unsigned s0[2], s1[2];
            if constexpr (GATHER) { s0[0] = last ? nv0[0] : cv0[0]; s0[1] = last ? nv0[1] : cv0[1]; s1[0] = last ? nv1[0] : cv1[0]; s1[1] = last ? nv1[1] : cv1[1]; } else { s0[0] = s0[1] = s1[0] = s1[1] = 0u; }
            PG8_LDB(B0, 0, 0); PG8_SCHED; PG8_LDA(At, 0, 0); PG8_STAGE_A(PG8_SA(1, 1), a1, 1, cv0, cv1);
            PG8_WAIT_L(8); PG8_BAR; PG8_WAIT_L(0); PG8_MMA(0, 0, At, B0); PG8_BAR; PG8_SCHED;
            PG8_LDB(B1, 0, 1); PG8_STAGE(PG8_SB(0, 0), b2, voffB);
            PG8_BAR; PG8_WAIT_L(0); PG8_MMA(0, 1, At, B1); PG8_BAR;
            PG8_LDA(At, 0, 1); PG8_STAGE_A(PG8_SA(0, 0), a2, 0, s0, s1);
            PG8_BAR; PG8_WAIT_L(0); PG8_MMA(1, 0, At, B0); PG8_BAR; PG8_SCHED;
            PG8_STAGE(PG8_SB(0, 1), b2 + hstep, voffB);
            PG8_WAIT_V(6); PG8_BAR; PG8_MMA(1, 1, At, B1); PG8_BAR;
            PG8_LDB(B0, 1, 0); PG8_SCHED; PG8_LDA(At, 1, 0); PG8_STAGE_A(PG8_SA(0, 1), a2, 1, s0, s1);
            PG8_WAIT_L(8); PG8_BAR; PG8_WAIT_L(0); PG8_MMA(0, 0, At, B0); PG8_BAR; PG8_SCHED;
            PG8_LDB(B1, 1, 1); PG8_STAGE(PG8_SB(1, 0), b3, voffB);
            PG8_BAR; PG8_WAIT_L(0); PG8_MMA(0, 1, At, B1); PG8_BAR;
            PG8_LDA(At, 1, 1); PG8_STAGE_A(PG8_SA(1, 0), a3, 0, s0, s1);
            PG8_BAR; PG8_WAIT_L(0); PG8_MMA(1, 0, At, B0); PG8_BAR; PG8_SCHED;
            PG8_STAGE(PG8_SB(1, 1), b3 + hstep, voffB);
            PG8_WAIT_V(6); PG8_BAR; PG8_MMA(1, 1, At, B1); PG8_BAR;
        }
        if constexpr (FP8) asm volatile("s_nop 15\n\ts_nop 15" ::: "memory");
        E(acc, cur, wr, wc, fr, fq);
        if (!has_next) break;
#pragma unroll
        for (int a = 0; a < 2; ++a)
#pragma unroll
            for (int b = 0; b < 2; ++b)
#pragma unroll
                for (int m = 0; m < 4; ++m)
#pragma unroll
                    for (int n = 0; n < 2; ++n) acc[a][b][m][n] = (f32x4){0.f, 0.f, 0.f, 0.f};
        cur = nxt; cA = nA; cB = nB; ++ui;
        if constexpr (GATHER) { cv0[0] = nv0[0]; cv0[1] = nv0[1]; cv1[0] = nv1[0]; cv1[1] = nv1[1]; }
    }
    PG8_WAIT_V(0);
    if (wr == 0) PG8_BAR;
    PG8_BAR;
#undef PG8_SA
#undef PG8_SB
#undef PG8_STAGE
#undef PG8_STAGE_A
#undef PG8_LDA
#undef PG8_LDB
#undef PG8_MMA
#undef PG8_LD8
#undef PG8_WAIT_V
#undef PG8_WAIT_L
#undef PG8_BAR
#undef PG8_SCHED
}
}
using pg8::Unit;
typedef f32x4 AccT[2][2][4][2];

struct Args { const float* in[28]; float* out; unsigned char* ws; int ph_lo, ph_hi, pad0, pad1; };
struct Frame {
    LAS unsigned char* lds;
    int tid, lane, wave, G, bid;
    const struct Args* a;
    unsigned char* ws; unsigned char* outb;
};
struct SchedPlain {
    pg8::StaticOrder o; const char* A; const char* Bt;
    __device__ __forceinline__ bool next(int i, Unit& u) const { return o.next(i, u); }
    __device__ __forceinline__ const char* a_base(const Unit& u) const { return A + (size_t)u.pm * (256 * 2048); }
    __device__ __forceinline__ const char* b_base(const Unit& u) const { return Bt + (size_t)u.pn * (256 * 2048); }
    __device__ __forceinline__ void a_offs(const Unit&, const int*, const int*, unsigned (&)[2], unsigned (&)[2]) const {}
};

struct EpiProj {
    static constexpr bool PERM = true;
    bf16_t *Q, *IQ, *Z, *XBC, *GA, *GB; float* MISC;
    __device__ __forceinline__ void operator()(const AccT& acc, const Unit& u, int wr, int wc, int fr, int fq) const {
        const int pn = u.pn, row0 = u.pm * 256 + wr * 64 + fr, c8 = wc * 32 + 8 * fq;
        if (pn == 6) {
#pragma unroll
            for (int ai = 0; ai < 2; ++ai)
#pragma unroll
                for (int m = 0; m < 4; ++m) { float* rp = MISC + (size_t)(row0 + ai * 128 + m * 16) * 256 + c8;
#pragma unroll
                    for (int bj = 0; bj < 2; ++bj) { *(f32x4*)(rp + bj * 128) = acc[ai][bj][m][0]; *(f32x4*)(rp + bj * 128 + 4) = acc[ai][bj][m][1]; } }
            return;
        }
        bf16_t* base; int ldc, colt, act = 0;
        if (pn < 4) { base = Q; ldc = 1024; colt = pn * 256; }
        else if (pn < 6) { base = IQ; ldc = 512; colt = (pn - 4) * 256; }
        else if (pn < 11) { base = Z; ldc = 1024; colt = (pn - 7) * 256; act = 1; }
        else if (pn < 19) { base = XBC; ldc = 2048; colt = (pn - 11) * 256; }
        else if (pn < 23) { base = GA; ldc = 1024; colt = (pn - 19) * 256; act = 2; }
        else { base = GB; ldc = 1024; colt = (pn - 23) * 256; act = 2; }
#pragma unroll
        for (int ai = 0; ai < 2; ++ai)
#pragma unroll
            for (int m = 0; m < 4; ++m) { bf16_t* rp = base + (size_t)(row0 + ai * 128 + m * 16) * ldc + colt + c8;
#pragma unroll
                for (int bj = 0; bj < 2; ++bj) { f32x4 v0 = acc[ai][bj][m][0], v1 = acc[ai][bj][m][1];
                    if (act == 1) {
#pragma unroll
                        for (int j = 0; j < 4; ++j) { v0[j] = silu_f(v0[j]); v1[j] = silu_f(v1[j]); } }
                    if (act == 2) {
#pragma unroll
                        for (int j = 0; j < 4; ++j) { v0[j] = sigmoid_f(v0[j]); v1[j] = sigmoid_f(v1[j]); } }
                    u32x4 pk = pack8(v0, v1); if (DBG_IQ_TRUNC && (pn == 4 || pn == 5)) { pk.x &= 0xfff8fff8u; pk.y &= 0xfff8fff8u; pk.z &= 0xfff8fff8u; pk.w &= 0xfff8fff8u; }
                    *(u32x4*)(rp + bj * 128) = pk; } }
    }
};
template <int MODE> struct EpiGate {
    static constexpr bool PERM = true;
    const bf16_t* Gt; const bf16_t* T; bf16_t* O;
    __device__ __forceinline__ void operator()(const AccT& acc, const Unit& u, int wr, int wc, int fr, int fq) const {
        const int row0 = u.pm * 256 + wr * 64 + fr, c8 = u.pn * 256 + wc * 32 + 8 * fq;
#pragma unroll
        for (int ai = 0; ai < 2; ++ai)
#pragma unroll
            for (int m = 0; m < 4; ++m) { const size_t off = (size_t)(row0 + ai * 128 + m * 16) * 1024 + c8;
#pragma unroll
                for (int bj = 0; bj < 2; ++bj) { f32x4 g0, g1; unpack8(*(const u32x4*)(Gt + off + bj * 128), g0, g1);
                    f32x4 v0 = g0 * acc[ai][bj][m][0], v1 = g1 * acc[ai][bj][m][1];
                    if ((MODE == 0 && DBG_NO_ATTN) || (MODE == 1 && DBG_NO_SSD)) { v0 = (f32x4){0.f, 0.f, 0.f, 0.f}; v1 = v0; }
                    if (MODE == 1) { f32x4 t0, t1; unpack8(*(const u32x4*)(T + off + bj * 128), t0, t1); v0 += t0; v1 += t1; }
                    *(u32x4*)(O + off + bj * 128) = pack8(v0, v1); } }
    }
};
struct EpiOut {
    static constexpr bool PERM = false;
    const float* x; const float* mod; float* V;
    __device__ __forceinline__ void operator()(const AccT& acc, const Unit& u, int wr, int wc, int fr, int fq) const {
        const int row0 = u.pm * 256 + wr * 64 + fr, col0 = u.pn * 256 + wc * 32 + 4 * fq;
        const float* g1 = mod + (size_t)(u.pm >> 3) * 6144 + 2048 + col0;
        f32x4 gv[2][2];
#pragma unroll
        for (int bj = 0; bj < 2; ++bj)
#pragma unroll
            for (int n = 0; n < 2; ++n) gv[bj][n] = *(const f32x4*)(g1 + bj * 128 + n * 16);
#pragma unroll
        for (int ai = 0; ai < 2; ++ai)
#pragma unroll
            for (int m = 0; m < 4; ++m) { const size_t off = (size_t)(row0 + ai * 128 + m * 16) * 1024 + col0;
#pragma unroll
                for (int bj = 0; bj < 2; ++bj)
#pragma unroll
                    for (int n = 0; n < 2; ++n) { const f32x4 xv = *(const f32x4*)(x + off + bj * 128 + n * 16);
                        *(f32x4*)(V + off + bj * 128 + n * 16) = xv * DN_ALPHA + gv[bj][n] * acc[ai][bj][m][n]; } }
    }
};

struct MoeTab { LAS unsigned* cnt; LAS unsigned* tb; LAS unsigned char* te; int ntiles; };
__device__ __forceinline__ MoeTab moe_tables(Frame& F, int hf) {
    MoeTab T; T.cnt = (LAS unsigned*)(F.lds + LDS_AUX); T.tb = (LAS unsigned*)(F.lds + LDS_AUX + 256); T.te = (LAS unsigned char*)(F.lds + LDS_AUX + 512);
    const unsigned* CNT = (const unsigned*)(F.ws + WS_CTL) + CW_CNT;
    __syncthreads();
    if (F.tid < 32) { unsigned c = __hip_atomic_load(CNT + 64 * (hf * 32 + F.tid), __ATOMIC_RELAXED, __HIP_MEMORY_SCOPE_AGENT); if (c > (unsigned)REG_CAP) c = REG_CAP; T.cnt[F.tid] = c; }
    __syncthreads();
    if (F.tid == 0) { unsigned s = 0;
#pragma nounroll
        for (int e = 0; e < 32; ++e) { T.tb[e] = s; const unsigned n = (T.cnt[e] + 255u) >> 8;
#pragma nounroll
            for (unsigned t = 0; t < n; ++t) T.te[s + t] = (unsigned char)e;
            s += n; }
        T.tb[32] = s; }
    __syncthreads();
    T.ntiles = __builtin_amdgcn_readfirstlane((int)T.tb[32]);
    return T;
}
template <int NJ, bool GATHER> struct SchedMoe {
    MoeTab T; int G, c, hf; const char* A; const char* Bt; const u32x2* REG;
    __device__ __forceinline__ bool next(int i, Unit& u) const {
        const int L = i * G + c; if (L >= T.ntiles * NJ) return false;
        u.pm = L / NJ; u.pn = L % NJ; u.ex = __builtin_amdgcn_readfirstlane((int)T.te[u.pm]); return true;
    }
    __device__ __forceinline__ const char* a_base(const Unit& u) const { return GATHER ? A : A + (size_t)u.pm * (256 * MOE_RB); }
    __device__ __forceinline__ const char* b_base(const Unit& u) const { return Bt + ((size_t)u.ex * (NJ * 256) + (size_t)u.pn * 256) * MOE_RB; }
    __device__ __forceinline__ void a_offs(const Unit& u, const int* R, const int* C, unsigned (&o0)[2], unsigned (&o1)[2]) const {
        const unsigned cnt = __builtin_amdgcn_readfirstlane(T.cnt[u.ex]), pos0 = ((unsigned)u.pm - (unsigned)__builtin_amdgcn_readfirstlane(T.tb[u.ex])) * 256u; const u32x2* rg = REG + ((size_t)hf * 32 + u.ex) * REG_CAP;
#pragma unroll
        for (int i = 0; i < 2; ++i) {
            const unsigned p0 = pos0 + (unsigned)R[i], p1 = p0 + 128u;
            unsigned t0 = 0u, t1 = 0u;
            if (p0 < cnt) t0 = (unsigned)hf * HALF_TOK + (rg[p0].x >> 2);
            if (p1 < cnt) t1 = (unsigned)hf * HALF_TOK + (rg[p1].x >> 2);
            o0[i] = t0 * (unsigned)MOE_RB + (unsigned)C[i] * 2u; o1[i] = t1 * (unsigned)MOE_RB + (unsigned)C[i] * 2u;
        }
    }
};
struct EpiMoe1 {
    static constexpr bool PERM = true;
    const float* b1; bf16_t* ACT;
    __device__ __forceinline__ void operator()(const AccT& acc, const Unit& u, int wr, int wc, int fr, int fq) const {
        const int row0 = u.pm * 256 + wr * 64 + fr, c8 = u.pn * 128 + wc * 32 + 8 * fq;
        const float* bg = b1 + (size_t)u.ex * 2048 + c8;
        const f32x4 bg0 = *(const f32x4*)bg, bg1 = *(const f32x4*)(bg + 4), bu0 = *(const f32x4*)(bg + 1024), bu1 = *(const f32x4*)(bg + 1028);
#pragma unroll
        for (int ai = 0; ai < 2; ++ai)
#pragma unroll
            for (int m = 0; m < 4; ++m) {
                f32x4 g0 = acc[ai][0][m][0] * MOE_INV + bg0, g1 = acc[ai][0][m][1] * MOE_INV + bg1, u0 = acc[ai][1][m][0] * MOE_INV + bu0, u1 = acc[ai][1][m][1] * MOE_INV + bu1, a0, a1;
#pragma unroll
                for (int j = 0; j < 4; ++j) {
                    float g = fminf(g0[j], 7.0f), up = fminf(fmaxf(u0[j], -7.0f), 7.0f); a0[j] = (up + 1.0f) * g * sigmoid_f(1.702f * g);
                    g = fminf(g1[j], 7.0f); up = fminf(fmaxf(u1[j], -7.0f), 7.0f); a1[j] = (up + 1.0f) * g * sigmoid_f(1.702f * g); }
                if (MOE_FP8) *(u32x2*)((unsigned char*)ACT + (size_t)(row0 + ai * 128 + m * 16) * 1024 + c8) = pack8_fp8(a0, a1);
                else *(u32x4*)(ACT + (size_t)(row0 + ai * 128 + m * 16) * 1024 + c8) = pack8(a0, a1); }
    }
};
struct EpiMoe2 {
    static constexpr bool PERM = true;
    const float* b2; bf16_t* YB; const u32x2* REG; MoeTab T; int hf;
    __device__ __forceinline__ void operator()(const AccT& acc, const Unit& u, int wr, int wc, int fr, int fq) const {
        const int c8 = u.pn * 256 + wc * 32 + 8 * fq;
        const unsigned cnt = __builtin_amdgcn_readfirstlane(T.cnt[u.ex]), pos0 = ((unsigned)u.pm - (unsigned)__builtin_amdgcn_readfirstlane(T.tb[u.ex])) * 256u + (unsigned)(wr * 64 + fr); const u32x2* rg = REG + ((size_t)hf * 32 + u.ex) * REG_CAP;
        const float* bb = b2 + (size_t)u.ex * 1024 + c8;
        f32x4 bv[2][2];
#pragma unroll
        for (int bj = 0; bj < 2; ++bj) { bv[bj][0] = *(const f32x4*)(bb + bj * 128); bv[bj][1] = *(const f32x4*)(bb + bj * 128 + 4); }
#pragma unroll
        for (int ai = 0; ai < 2; ++ai)
#pragma unroll
            for (int m = 0; m < 4; ++m) { const unsigned p = pos0 + (unsigned)(ai * 128 + m * 16);
                if (p < cnt) { const u32x2 en = rg[p]; const float g = __uint_as_float(en.y); bf16_t* rp = YB + (size_t)en.x * 1024 + c8;
#pragma unroll
                    for (int bj = 0; bj < 2; ++bj) *(u32x4*)(rp + bj * 128) = pack8((acc[ai][bj][m][0] * MOE_INV + bv[bj][0]) * g, (acc[ai][bj][m][1] * MOE_INV + bv[bj][1]) * g); } }
    }
};

struct MapIdent { __device__ __forceinline__ int operator()(int n) const { return n; } };
struct MapWin { __device__ __forceinline__ int operator()(int n) const {
    if (n < 1024) return n;
    if (n < 1536) return 1152 + (n - 1024);
    if (n < 1792) { const int c = n - 1536; if (c < 128) return 1024 + c; if (c < 192) return 1664 + (c - 128); if (c < 200) return 1728 + (c - 192); if (c < 216) return 4808 + (c - 200); return -1; }
    if (n < 2816) return 1736 + (n - 1792);
    if (n < 4864) return 2760 + (n - 2816);
    if (n < 5888) return 4824 + (n - 4864);
    return 5848 + (n - 5888); } };
struct MapW1 { __device__ __forceinline__ int operator()(int r) const { const int j = r >> 8, rr = r & 255; return (rr >> 7) * 1024 + j * 128 + (rr & 127); } };
template <class Map, bool F8 = false> __device__ __forceinline__ void transpose_item(const float* W, int K, int N, bf16_t* WT, const Map& map, LAS float* scr, int kb, int nb, int lane, const float* rowscale) {
    const int k0 = 64 * kb, n0 = 64 * nb, q = lane & 15, kr = lane >> 4; const int src = map(n0 + 4 * q);
    f32x4 ld[16];
#pragma unroll
    for (int i = 0; i < 16; ++i) { const int kk = 4 * i + kr; ld[i] = (src >= 0) ? *(const f32x4*)(W + (size_t)(k0 + kk) * N + src) : (f32x4){0.f, 0.f, 0.f, 0.f}; }
#pragma unroll
    for (int i = 0; i < 16; ++i) { const int kk = 4 * i + kr; f32x4 v = ld[i]; if (rowscale) v = v * rowscale[k0 + kk]; LAS float* d = scr + kk * 65 + 4 * q; d[0] = v[0]; d[1] = v[1]; d[2] = v[2]; d[3] = v[3]; }
    LDS_WAIT(); asm volatile("" ::: "memory");
    const int c = lane & 7;
#pragma unroll
    for (int j = 0; j < 8; ++j) { const int n = (lane >> 3) + 8 * j; const LAS float* s = scr + (8 * c) * 65 + n;
        if constexpr (F8) { const f32x4 a = {s[0 * 65] * MOE_WSC, s[1 * 65] * MOE_WSC, s[2 * 65] * MOE_WSC, s[3 * 65] * MOE_WSC}, b = {s[4 * 65] * MOE_WSC, s[5 * 65] * MOE_WSC, s[6 * 65] * MOE_WSC, s[7 * 65] * MOE_WSC};
            *(u32x2*)((unsigned char*)WT + (size_t)(n0 + n) * K + k0 + 8 * c) = pack8_fp8(a, b); }
        else { u32x4 o; o.x = cvt_pk_bf16(s[0 * 65], s[1 * 65]); o.y = cvt_pk_bf16(s[2 * 65], s[3 * 65]); o.z = cvt_pk_bf16(s[4 * 65], s[5 * 65]); o.w = cvt_pk_bf16(s[6 * 65], s[7 * 65]);
            *(u32x4*)(WT + (size_t)(n0 + n) * K + k0 + 8 * c) = o; } }
    LDS_WAIT(); asm volatile("" ::: "memory");
}
__device__ __forceinline__ void ph_prologue(Frame& F) {
    const float* c_in = F.a->in[1]; const float* w_mod = F.a->in[2]; const float* b_mod = F.a->in[3];
    float* MOD = (float*)(F.ws + WS_MOD);
    for (int item = F.bid; item < 48; item += F.G) {
        LAS float* SC = (LAS float*)F.lds;
        __syncthreads();
        for (int i = F.tid; i < 32768; i += NTHR) { const int b = i >> 10, k = i & 1023; SC[k * 32 + b] = silu_f(c_in[i]); }
        __syncthreads();
        const int col = item * 128 + (F.tid >> 2), kq = F.tid & 3;
        float a[32];
#pragma unroll
        for (int b = 0; b < 32; ++b) a[b] = 0.f;
#pragma nounroll
        for (int kg = 0; kg < 256; kg += 16) {
            float wv[16];
#pragma unroll
            for (int u = 0; u < 16; ++u) wv[u] = w_mod[(size_t)(kq * 256 + kg + u) * 6144 + col];
#pragma unroll
            for (int u = 0; u < 16; ++u) { const int k = kq * 256 + kg + u; const float w = wv[u];
#pragma unroll
                for (int b4 = 0; b4 < 8; ++b4) { const f32x4 s = *(const LAS f32x4*)(SC + k * 32 + b4 * 4); a[b4 * 4 + 0] += w * s[0]; a[b4 * 4 + 1] += w * s[1]; a[b4 * 4 + 2] += w * s[2]; a[b4 * 4 + 3] += w * s[3]; } } }
#pragma unroll
        for (int b = 0; b < 32; ++b) { a[b] += __shfl_xor(a[b], 1); a[b] += __shfl_xor(a[b], 2); }
        if (kq == 0) { const float bm = b_mod[col];
#pragma unroll
            for (int b = 0; b < 32; ++b) MOD[(size_t)b * 6144 + col] = a[b] + bm; }
        __syncthreads();
    }
    if (F.bid == (F.G > 48 ? 48 : 0)) {
        float* BT = (float*)(F.ws + WS_BIAST); const float* rel_bias = F.a->in[8];
        for (int i = F.tid; i < 249 * 8; i += NTHR) { const int idx = i >> 3, h = i & 7, rel = idx - 185; const int n = rel < 0 ? -rel : rel;
            const float nf = (float)(n > 1 ? n : 1); int large = 8 + (int)(logf(nf / 8.0f) / 2.7725887f * 8.0f); if (large > 15) large = 15;
            const int bucket = (rel > 0 ? 16 : 0) + (n < 8 ? n : large);
            BT[i] = rel_bias[bucket * 8 + h] * LOG2E; }
    }
    LAS float* scr = (LAS float*)(F.lds + F.wave * 16640);
    __syncthreads();
    const int gw = F.bid * NWAVES + F.wave, NGW = F.G * NWAVES;
    constexpr int I_WIN = 16 * (NPROJ / 64), I_SQ = 16 * 16, I_W1E = 16 * 32, I_W2E = 16 * 16;
    constexpr int NITEMS = I_WIN + 3 * I_SQ + 32 * I_W1E + 32 * I_W2E;
    for (int it = gw; it < NITEMS; it += NGW) {
        int r = it;
        if (r < I_WIN) { transpose_item(F.a->in[4], 1024, 6872, (bf16_t*)(F.ws + WS_WIN), MapWin(), scr, r / (NPROJ / 64), r % (NPROJ / 64), F.lane, nullptr); continue; } r -= I_WIN;
        if (r < I_SQ) { transpose_item(F.a->in[15], 1024, 1024, (bf16_t*)(F.ws + WS_WPA), MapIdent(), scr, r / 16, r % 16, F.lane, nullptr); continue; } r -= I_SQ;
        if (r < I_SQ) { transpose_item(F.a->in[16], 1024, 1024, (bf16_t*)(F.ws + WS_WPB), MapIdent(), scr, r / 16, r % 16, F.lane, F.a->in[14]); continue; } r -= I_SQ;
        if (r < I_SQ) { transpose_item(F.a->in[17], 1024, 1024, (bf16_t*)(F.ws + WS_WOUT), MapIdent(), scr, r / 16, r % 16, F.lane, nullptr); continue; } r -= I_SQ;
        if (r < 32 * I_W1E) { const int e = r / I_W1E, q = r % I_W1E; transpose_item<MapW1, MOE_FP8 != 0>(F.a->in[22] + (size_t)e * 1024 * 2048, 1024, 2048, (bf16_t*)(F.ws + WS_W1 + (size_t)e * 2048 * MOE_RB), MapW1(), scr, q / 32, q % 32, F.lane, nullptr); continue; } r -= 32 * I_W1E;
        { const int e = r / I_W2E, q = r % I_W2E; transpose_item<MapIdent, MOE_FP8 != 0>(F.a->in[24] + (size_t)e * 1024 * 1024, 1024, 1024, (bf16_t*)(F.ws + WS_W2 + (size_t)e * 1024 * MOE_RB), MapIdent(), scr, q / 16, q % 16, F.lane, nullptr); }
    }
}

__device__ __forceinline__ void ph_ln1(Frame& F) {
    const float* x = F.a->in[0]; const float* MOD = (const float*)(F.ws + WS_MOD); bf16_t* U = (bf16_t*)(F.outb + OUT_U);
    const int gw = F.bid * NWAVES + F.wave, NGW = F.G * NWAVES;
    constexpr int RB = 4;
    for (int m0 = gw; m0 < NTOK; m0 += NGW * RB) {
        f32x4 v[RB][4];
#pragma unroll
        for (int r = 0; r < RB; ++r) { const f32x4* xr = (const f32x4*)(x + (size_t)(m0 + r * NGW) * D) + F.lane;
#pragma unroll
            for (int j = 0; j < 4; ++j) v[r][j] = xr[64 * j]; }
#pragma unroll
        for (int r = 0; r < RB; ++r) { const int m = m0 + r * NGW; const float* md = MOD + (size_t)(m >> 11) * 6144;
            float s = 0.f;
#pragma unroll
            for (int j = 0; j < 4; ++j) s += (v[r][j][0] + v[r][j][1]) + (v[r][j][2] + v[r][j][3]);
            const float mean = wave_sum(s) * (1.f / D); float s2 = 0.f;
#pragma unroll
            for (int j = 0; j < 4; ++j) { v[r][j] = v[r][j] - mean; s2 += (v[r][j][0] * v[r][j][0] + v[r][j][1] * v[r][j][1]) + (v[r][j][2] * v[r][j][2] + v[r][j][3] * v[r][j][3]); }
            const float rstd = 1.f / sqrtf(wave_sum(s2) * (1.f / D) + LN_EPS);
            u32x2* o8 = (u32x2*)(U + (size_t)m * D) + F.lane;
#pragma unroll
            for (int j = 0; j < 4; ++j) { const f32x4 sh = *((const f32x4*)md + F.lane + 64 * j), sc = *((const f32x4*)(md + 1024) + F.lane + 64 * j);
                const f32x4 rr = v[r][j] * rstd * (sc + 1.0f) + sh; u32x2 w; w.x = cvt_pk_bf16(rr[0], rr[1]); w.y = cvt_pk_bf16(rr[2], rr[3]); o8[64 * j] = w; } }
    }
}

__device__ __forceinline__ void ph_misc(Frame& F) {
    const float* MISC = (const float*)(F.outb + OUT_MISC);
    bf16_t* KV = (bf16_t*)(F.outb + OUT_KV); bf16_t* IK = (bf16_t*)(F.outb + OUT_IK); float* IW = (float*)(F.outb + OUT_IW); float* DT = (float*)(F.outb + OUT_DT);
    const float* kvw = F.a->in[5]; const float* ikw = F.a->in[6]; const float* ikb = F.a->in[7]; const float* dtb = F.a->in[11];
    const int gw = F.bid * NWAVES + F.wave, NGW = F.G * NWAVES, l = F.lane;
    for (int m0 = gw; m0 < NTOK; m0 += NGW * 4) {
      f32x4 vv[4];
#pragma unroll
      for (int r = 0; r < 4; ++r) vv[r] = *((const f32x4*)(MISC + (size_t)(m0 + r * NGW) * 256) + l);
#pragma unroll
      for (int r = 0; r < 4; ++r) { const int m = m0 + r * NGW;
        const f32x4 v = vv[r];
        const float sq = v[0] * v[0] + v[1] * v[1] + v[2] * v[2] + v[3] * v[3], sm = (v[0] + v[1]) + (v[2] + v[3]);
        const float kvss = wave_sum(l < 32 ? sq : 0.f);
        const float iks = wave_sum((l >= 32 && l < 48) ? sm : 0.f);
        const float ikmean = iks * (1.f / 64.f);
        const f32x4 dv = v - ikmean;
        const float ikq = wave_sum((l >= 32 && l < 48) ? (dv[0] * dv[0] + dv[1] * dv[1] + dv[2] * dv[2] + dv[3] * dv[3]) : 0.f);
        if (l < 32) { const float r = 1.f / sqrtf(kvss * (1.f / 128.f) + LN_EPS); const f32x4 w = *((const f32x4*)kvw + l); const f32x4 o = v * r * w;
            u32x2 pk; pk.x = cvt_pk_bf16(o[0], o[1]); pk.y = cvt_pk_bf16(o[2], o[3]); *((u32x2*)(KV + (size_t)m * 128) + l) = pk; }
        else if (l < 48) { const float r = 1.f / sqrtf(ikq * (1.f / 64.f) + LN_EPS); const f32x4 w = *((const f32x4*)ikw + (l - 32)), bb = *((const f32x4*)ikb + (l - 32)); const f32x4 o = dv * r * w + bb;
            u32x2 pk; pk.x = cvt_pk_bf16(o[0], o[1]); pk.y = cvt_pk_bf16(o[2], o[3]); *((u32x2*)(IK + (size_t)m * 64) + (l - 32)) = pk; }
        else if (l < 50) { *((f32x4*)(IW + (size_t)m * 8) + (l - 48)) = v * 0.35355339059327373f; }
        else if (l < 54) { const f32x4 bb = *((const f32x4*)dtb + (l - 50)); f32x4 o;
#pragma unroll
            for (int j = 0; j < 4; ++j) { const float t = v[j] + bb[j]; o[j] = t > 20.f ? t : log1pf(__expf(t)); }
            *((f32x4*)(DT + (size_t)m * 16) + (l - 50)) = o; }
      }
    }
}

__device__ __forceinline__ unsigned sortable_key(float s) { const unsigned u = __float_as_uint(s + 0.0f); return (u & 0x80000000u) ? ~u : (u | 0x80000000u); }
template <int NKB> struct KeyRow { unsigned k[NKB]; };
__device__ __forceinline__ u64 low_bits_keep(u64 m, int t) { u64 out = 0; while (t-- > 0 && m) { const u64 b = m & (0 - m); out |= b; m ^= b; } return out; }
namespace idx { constexpr int KST = 144, KBUF = 64 * KST; }
__device__ __forceinline__ unsigned low_bits_keep32(unsigned m, int t) { unsigned out = 0; while (t-- > 0 && m) { const unsigned b = m & (0u - m); out |= b; m ^= b; } return out; }
template <int NG> __device__ __forceinline__ void topk2_select_write(const unsigned (&key)[64], int nkb, u64* mrow, int lane) {
    constexpr int NR = NG * 16;
    unsigned T0 = 0u, T1 = 0u; bool ex0 = false, ex1 = false;
    unsigned lo0 = 0u, lo1 = 0u, hi0 = 0xFFFFFFFFu, hi1 = 0xFFFFFFFFu, st0, st1, p0, p1; bool fin0 = false, fin1 = false;
    { float sm = 0.f, sq = 0.f;
#pragma unroll
        for (int m = 0; m < 10; ++m) { const unsigned k = key[m]; const float f = __uint_as_float((k & 0x80000000u) ? (k ^ 0x80000000u) : ~k); sm += f; sq += f * f; }
#pragma unroll
        for (int o = 1; o < 32; o <<= 1) { sm += __shfl_xor(sm, o); sq += __shfl_xor(sq, o); }
        const float mu = sm * (1.f / 320.f), sd = sqrtf(fmaxf(sq * (1.f / 320.f) - mu * mu, 1e-20f));
        const float qq = 256.f / (64.f * (float)nkb), pp = qq < 0.5f ? qq : 1.f - qq, tt = sqrtf(-2.f * __logf(pp));
        float z = tt - (2.515517f + 0.802853f * tt + 0.010328f * tt * tt) / (1.f + 1.432788f * tt + 0.189269f * tt * tt + 0.001308f * tt * tt * tt); if (qq >= 0.5f) z = -z;
        const unsigned pe = sortable_key(mu + z * sd), pd = sortable_key(mu + z * sd + 0.125f * sd);
        unsigned stp = pd - pe; if (stp < 1024u) stp = 1024u;
        p0 = __builtin_amdgcn_readlane((int)pe, 0); p1 = __builtin_amdgcn_readlane((int)pe, 32); st0 = __builtin_amdgcn_readlane((int)stp, 0); st1 = __builtin_amdgcn_readlane((int)stp, 32); }
#pragma nounroll
    for (int it = 0; it < 80; ++it) {
        const unsigned candv = lane < 32 ? p0 : p1;
        unsigned cl = 0u;
#pragma unroll
        for (int m = 0; m < NR; ++m) cl += (key[m] >= candv) ? 1u : 0u;
        cl += __shfl_xor(cl, 1); cl += __shfl_xor(cl, 2); cl += __shfl_xor(cl, 4); cl += __shfl_xor(cl, 8); cl += __shfl_xor(cl, 16);
        const int n0 = __builtin_amdgcn_readlane((int)cl, 0), n1 = __builtin_amdgcn_readlane((int)cl, 32);
#define IDX_STEP(lo, hi, st, p, T, ex, fin, n) do { if (!fin) { \
            if (n == 256) { T = p; ex = true; fin = true; } \
            else { if (n > 256) lo = p; else hi = p; \
                if (hi - lo <= 1u) { T = lo; fin = true; } \
                else { unsigned c; if (hi == 0xFFFFFFFFu) { c = lo + st; if (c < lo) c = hi; st = st << 1; } else if (lo == 0u) { c = hi - st; if (c > hi) c = lo; st = st << 1; } else c = lo + ((hi - lo) >> 1); \
                    if (c <= lo || c >= hi) c = lo + ((hi - lo) >> 1); p = c; } } } } while (0)
        IDX_STEP(lo0, hi0, st0, p0, T0, ex0, fin0, n0);
        IDX_STEP(lo1, hi1, st1, p1, T1, ex1, fin1, n1);
#undef IDX_STEP
        if (fin0 && fin1) break;
    }
    const unsigned Tv = lane < 32 ? T0 : T1;
    if (ex0 && ex1) {
        unsigned mlo = 0u, mhi = 0u;
#pragma unroll
        for (int j = 0; j < NR / 2; ++j) {
            const u64 b0 = __ballot(key[2 * j] >= Tv), b1 = __ballot(key[2 * j + 1] >= Tv);
            asm volatile("s_nop 1\n\tv_writelane_b32 %0, %2, %6\n\tv_writelane_b32 %0, %3, %7\n\tv_writelane_b32 %1, %4, %6\n\tv_writelane_b32 %1, %5, %7"
                         : "+v"(mlo), "+v"(mhi) : "s"((unsigned)b0), "s"((unsigned)(b0 >> 32)), "s"((unsigned)b1), "s"((unsigned)(b1 >> 32)), "n"(j), "n"(32 + j));
            if ((j & 3) == 3) SBAR();
        }
        const int jl = lane & 31;
        if (jl < nkb) mrow[(lane >> 5) * 32 + jl] = (u64)mlo | ((u64)mhi << 32);
        return;
    }
    int rem0 = 1 << 30, rem1 = 1 << 30;
    { int g0 = 0, g1 = 0;
#pragma unroll
        for (int m = 0; m < NR; ++m) { const u64 mk = __ballot(key[m] > Tv); g0 += __builtin_popcount((unsigned)mk); g1 += __builtin_popcount((unsigned)(mk >> 32)); if ((m & 7) == 7) SBAR(); }
        if (!ex0) rem0 = 256 - g0; if (!ex1) rem1 = 256 - g1; }
    u64 mine = 0ull;
#pragma nounroll
    for (int jq = 0; jq < NR / 8; ++jq) {
#pragma unroll
        for (int jj = 0; jj < 4; ++jj) { const int j = jq * 4 + jj;
            unsigned w0[2], w1[2];
#pragma unroll
            for (int hh = 0; hh < 2; ++hh) { unsigned kv = 0u;
#pragma unroll
                for (int m = 0; m < NR; ++m) if ((m >> 3) == 0) {}
#pragma unroll
                for (int m = 0; m < NR; ++m) kv = (m == 2 * j + hh) ? key[m] : kv;
                const u64 gt = __ballot(kv > Tv), eq = __ballot(kv == Tv);
                { const unsigned e = (unsigned)eq, g = (unsigned)gt; const int ne = __builtin_popcount(e); unsigned sel = g; if (rem0 >= ne) { sel |= e; rem0 -= ne; } else if (rem0 > 0) { sel |= low_bits_keep32(e, rem0); rem0 = 0; } w0[hh] = sel; }
                { const unsigned e = (unsigned)(eq >> 32), g = (unsigned)(gt >> 32); const int ne = __builtin_popcount(e); unsigned sel = g; if (rem1 >= ne) { sel |= e; rem1 -= ne; } else if (rem1 > 0) { sel |= low_bits_keep32(e, rem1); rem1 = 0; } w1[hh] = sel; } }
            const u64 q0w = (u64)w0[0] | ((u64)w0[1] << 32), q1w = (u64)w1[0] | ((u64)w1[1] << 32);
            if (lane == j) mine = q0w; if (lane == 32 + j) mine = q1w; }
    }
    const int jl = lane & 31;
    if (jl < nkb) mrow[(lane >> 5) * 32 + jl] = mine;
}
template <int J0> __device__ __forceinline__ void index_scores8(unsigned (&key)[64], const bf16x8 (&af)[2], const f32x4& iw4, const bf16_t* kvsrc, char* lds, int nkb, u32x4 (&stg)[8], int tid) {
    const int lane = tid & 63, sub = lane & 15, kg = lane >> 4;
#pragma unroll
    for (int jj = 0; jj < 8; ++jj) {
        const int j = J0 + jj;
        if (j < nkb) {
            if (j + 1 < nkb) *(u32x4*)(lds + ((j + 1) & 1) * idx::KBUF + (tid >> 3) * idx::KST + (tid & 7) * 16) = stg[(jj + 1) & 7];
            if (j + 8 < nkb) stg[jj] = *(const u32x4*)(kvsrc + (size_t)(j + 8) * 64 * 64);
            const char* kb = lds + (j & 1) * idx::KBUF + sub * idx::KST + kg * 16;
#pragma unroll
            for (int pr = 0; pr < 2; ++pr) {
                f32x4 dA = (f32x4){0.f, 0.f, 0.f, 0.f}, dB = dA;
#pragma unroll
                for (int ks = 0; ks < 2; ++ks) {
                    const bf16x8 fA = *(const bf16x8*)(kb + (pr * 32) * idx::KST + ks * 64), fB = *(const bf16x8*)(kb + (pr * 32 + 16) * idx::KST + ks * 64);
                    dA = __builtin_amdgcn_mfma_f32_16x16x32_bf16(af[ks], fA, dA, 0, 0, 0); dB = __builtin_amdgcn_mfma_f32_16x16x32_bf16(af[ks], fB, dB, 0, 0, 0); }
                float pA = 0.f, pB = 0.f;
#pragma unroll
                for (int r = 0; r < 4; ++r) { pA += fmaxf(dA[r], 0.f) * iw4[r]; pB += fmaxf(dB[r], 0.f) * iw4[r]; }
                auto rr = __builtin_amdgcn_permlane16_swap(__float_as_uint(pA), __float_as_uint(pB), false, false);
                key[2 * j + pr] = sortable_key(__uint_as_float(rr[0]) + __uint_as_float(rr[1]));
            }
            __syncthreads();
        }
    }
}
__device__ __forceinline__ void ph_index(Frame& F) {
    const bf16_t* IQ = (const bf16_t*)(F.outb + OUT_IQ); const bf16_t* IK = (const bf16_t*)(F.outb + OUT_IK); const float* IW = (const float*)(F.outb + OUT_IW);
    u64* MASK = (u64*)(F.outb + OUT_MASK);
    char* lds = (char*)(unsigned char*)F.lds;
    const int tid = F.tid, lane = F.lane, sub = lane & 15, kg = lane >> 4;
    for (int item = F.bid; item < NTOK / 16; item += F.G) {
        const int tokw = (((item & 255) >> 3) << 11) + (((item & 7) + 8 * (item >> 8)) << 4) + F.wave * 2, b = tokw >> 11, pos0 = tokw & 2047, nkb = (pos0 >> 6) + 1;
        u64* mrow = MASK + (size_t)tokw * 32;
        if (nkb <= 4) { if ((lane & 31) < nkb) mrow[(lane >> 5) * 32 + (lane & 31)] = ~0ull; continue; }
        bf16x8 af[2];
        { const bf16_t* ap = IQ + (size_t)(tokw + (sub >> 3)) * 512 + (sub & 7) * 64 + kg * 8;
#pragma unroll
          for (int ks = 0; ks < 2; ++ks) af[ks] = *(const bf16x8*)(ap + ks * 32); }
        const f32x4 iw4 = *(const f32x4*)(IW + (size_t)(tokw + (lane >> 5)) * 8 + 4 * (kg & 1));
        unsigned key[64];
#pragma unroll
        for (int m = 0; m < 64; ++m) key[m] = 0u;
        const bf16_t* kvsrc = IK + ((size_t)b * SEQ + (tid >> 3)) * 64 + (tid & 7) * 8;
        u32x4 stg[8];
#pragma unroll
        for (int i = 0; i < 8; ++i) stg[i] = (i < nkb) ? *(const u32x4*)(kvsrc + (size_t)i * 64 * 64) : (u32x4){0u, 0u, 0u, 0u};
        __syncthreads();
        *(u32x4*)(lds + (tid >> 3) * idx::KST + (tid & 7) * 16) = stg[0];
        __syncthreads();
        const int ng = (nkb + 7) >> 3;
        index_scores8<0>(key, af, iw4, kvsrc, lds, nkb, stg, tid);
        if (ng > 1) index_scores8<8>(key, af, iw4, kvsrc, lds, nkb, stg, tid);
        if (ng > 2) index_scores8<16>(key, af, iw4, kvsrc, lds, nkb, stg, tid);
        if (ng > 3) index_scores8<24>(key, af, iw4, kvsrc, lds, nkb, stg, tid);
        if (ng == 1) topk2_select_write<1>(key, nkb, mrow, lane);
        else if (ng == 2) topk2_select_write<2>(key, nkb, mrow, lane);
        else if (ng == 3) topk2_select_write<3>(key, nkb, mrow, lane);
        else topk2_select_write<4>(key, nkb, mrow, lane);
    }
}

namespace att {
constexpr int KVBLK = 64;
constexpr int SHM_V = KVBLK * 128 * 2, SHM_K = SHM_V;
constexpr int OFF_V = 0, OFF_K = 2 * SHM_V, OFF_WS = 2 * SHM_V + 2 * SHM_K, OFF_BT = OFF_WS + NWAVES * 64 * 4;
#define KSWZ(row, colB) ((row) * 256 + ((colB) ^ (((row) & 7) << 4)))
__device__ __forceinline__ int crow(int r, int hi) { return (r & 3) + 8 * (r >> 2) + 4 * hi; }
__device__ __forceinline__ int v_st(int k, int c) { const int kk = (k & ~0xC) | ((k & 4) << 1) | ((k & 8) >> 1); return ((kk >> 3) * 4 + (c >> 5)) * 512 + ((kk & 7) * 32 + (c & 31)) * 2; }
__device__ __forceinline__ int v_rd_base(int lane) { return ((lane & 3) << 3) | (((lane >> 2) & 3) << 6) | (((lane >> 4) & 1) << 5) | (((lane >> 5) & 1) << 8); }
constexpr int v_rd_off(int d0, int ks, int half) { return d0 * 512 + ks * 4096 + half * 2048; }
template <int OFF> __device__ __forceinline__ s16x4 tr_read(int vb) { s16x4 r; asm volatile("ds_read_b64_tr_b16 %0, %1 offset:%2" : "=&v"(r) : "v"(vb), "i"(OFF) : "memory"); return r; }
template <int D0> __device__ __forceinline__ void pv_one(f32x16& od, int vb, bf16x8 pa0, bf16x8 pa1, bf16x8 pa2, bf16x8 pa3) {
    const s16x4 l0 = tr_read<v_rd_off(D0, 0, 0)>(vb), h0 = tr_read<v_rd_off(D0, 0, 1)>(vb), l1 = tr_read<v_rd_off(D0, 1, 0)>(vb), h1 = tr_read<v_rd_off(D0, 1, 1)>(vb);
    const s16x4 l2 = tr_read<v_rd_off(D0, 2, 0)>(vb), h2 = tr_read<v_rd_off(D0, 2, 1)>(vb), l3 = tr_read<v_rd_off(D0, 3, 0)>(vb), h3 = tr_read<v_rd_off(D0, 3, 1)>(vb);
    asm volatile("s_waitcnt lgkmcnt(0)" ::: "memory"); SBAR();
#define PK(L, H) (bf16x8){L[0], L[1], L[2], L[3], H[0], H[1], H[2], H[3]}
    od = __builtin_amdgcn_mfma_f32_32x32x16_bf16(pa0, PK(l0, h0), od, 0, 0, 0);
    od = __builtin_amdgcn_mfma_f32_32x32x16_bf16(pa1, PK(l1, h1), od, 0, 0, 0);
    od = __builtin_amdgcn_mfma_f32_32x32x16_bf16(pa2, PK(l2, h2), od, 0, 0, 0);
    od = __builtin_amdgcn_mfma_f32_32x32x16_bf16(pa3, PK(l3, h3), od, 0, 0, 0);
#undef PK
}
__device__ __forceinline__ void qkt(f32x16& p0, f32x16& p1, const char* Ks, const bf16x8* qr, int r32, int hi) {
    p0 = f32x16{}; p1 = f32x16{};
    int rv = r32; asm volatile("" : "+v"(rv));
    const char* kb = Ks + rv * 256; const int swz = ((rv & 7) << 4) ^ (hi * 16);
#pragma unroll
    for (int d0 = 0; d0 < 8; ++d0) { const char* ka = kb + ((d0 * 32) ^ swz);
        const bf16x8 b0 = *reinterpret_cast<const bf16x8*>(ka);
        const bf16x8 b1 = *reinterpret_cast<const bf16x8*>(ka + 8192);
        p0 = __builtin_amdgcn_mfma_f32_32x32x16_bf16(b0, qr[d0], p0, 0, 0, 0);
        p1 = __builtin_amdgcn_mfma_f32_32x32x16_bf16(b1, qr[d0], p1, 0, 0, 0); }
}
__device__ __forceinline__ void attn_item(Frame& F, int b, int q0, char* lds) {
    const bf16_t* Q = (const bf16_t*)(F.ws + WS_Q); const bf16_t* KV = (const bf16_t*)(F.outb + OUT_KV); const u64* MASK = (const u64*)(F.outb + OUT_MASK);
    bf16_t* OA = (bf16_t*)(F.outb + OUT_OA);
    const int tid = F.tid, wid = F.wave, lane = F.lane, r32 = lane & 31, hi = lane >> 5;
    char* V_lds = lds + OFF_V; char* K_lds = lds + OFF_K;
    float* wsl = (float*)(lds + OFF_WS) + wid * 64; float* li_l = wsl; float* al_l = wsl + 32;
    const float* btab = (const float*)(lds + OFF_BT);
    constexpr float C = 0.088388347648318440f * LOG2E;
    float m_reg = -1e30f, l_reg = 0.f; f32x16 o[4] = {}; bf16x8 qr[8];
    const size_t tokq = (size_t)b * SEQ + q0 + r32;
    { const bf16_t* Qw = Q + tokq * 1024 + wid * 128 + hi * 8;
#pragma unroll
      for (int d0 = 0; d0 < 8; ++d0) qr[d0] = *(const bf16x8*)(Qw + d0 * 16); }
    const u64* mq = MASK + tokq * 32;
    const int sr = tid >> 4, sc = (tid & 15) * 8;
    const int vb0 = (int)(uintptr_t)V_lds + v_rd_base(lane);
    const bf16_t* Kb = KV + (size_t)b * SEQ * 128;
    const int NT = (q0 >> 6) + 1;
    const float bfar = btab[wid];
    bf16x8 s0, s1;
#define SLOAD(k0) do { s0 = *(const bf16x8*)(Kb + (size_t)((k0) + sr) * 128 + sc); s1 = *(const bf16x8*)(Kb + (size_t)((k0) + 32 + sr) * 128 + sc); } while (0)
#define SWRITE(bf) do { int srv = sr; asm volatile("" : "+v"(srv)); const int kc = sc * 2; const int v0a = v_st(srv, sc), k0a = KSWZ(srv, kc); \
        *(bf16x8*)(V_lds + (bf) * SHM_V + v0a) = s0; *(bf16x8*)(V_lds + (bf) * SHM_V + v0a + 8192) = s1; \
        *(bf16x8*)(K_lds + (bf) * SHM_K + k0a) = s0; *(bf16x8*)(K_lds + (bf) * SHM_K + k0a + 8192) = s1; } while (0)
    __syncthreads();
    SLOAD(0); VM_WAIT(); SWRITE(0); __syncthreads();
    u64 mw_next = mq[0];
    for (int j = 0; j < NT; ++j) {
        const int bf = j & 1;
        if (j + 1 < NT) SLOAD((j + 1) * KVBLK);
        const u64 mw = mw_next; if (j + 1 < NT) mw_next = mq[j + 1];
        f32x16 p0, p1;
        qkt(p0, p1, K_lds + bf * SHM_K, qr, r32, hi);
        const unsigned w0 = (unsigned)(mw >> (4 * hi)), w1 = (unsigned)(mw >> (32 + 4 * hi));
        const int relmax = j * KVBLK + 63 - q0;
        if (relmax <= -91) {
#pragma unroll
            for (int r = 0; r < 16; ++r) { const int cb = (r & 3) + 8 * (r >> 2);
                const float t0 = fmaf(p0[r], C, bfar), t1 = fmaf(p1[r], C, bfar); p0[r] = ((w0 >> cb) & 1u) ? t0 : -1e30f; p1[r] = ((w1 >> cb) & 1u) ? t1 : -1e30f; }
        } else {
            const float* bp = btab + (j * KVBLK + 4 * hi - (q0 + r32) + 185) * 8 + wid;
#pragma unroll
            for (int r4 = 0; r4 < 4; ++r4) {
#pragma unroll
                for (int rr = 0; rr < 4; ++rr) { const int r = r4 * 4 + rr; const int cb = (r & 3) + 8 * (r >> 2);
                    const float bv0 = bp[cb * 8], bv1 = bp[(cb + 32) * 8]; const float t0 = fmaf(p0[r], C, bv0), t1 = fmaf(p1[r], C, bv1);
                    p0[r] = ((w0 >> cb) & 1u) ? t0 : -1e30f; p1[r] = ((w1 >> cb) & 1u) ? t1 : -1e30f; }
                SBAR(); }
        }
        float pmax = p0[0];
#pragma unroll
        for (int r = 1; r < 16; ++r) pmax = fmaxf(pmax, p0[r]);
#pragma unroll
        for (int r = 0; r < 16; ++r) pmax = fmaxf(pmax, p1[r]);
        { auto rr = __builtin_amdgcn_permlane32_swap(__float_as_uint(pmax), __float_as_uint(pmax), false, false); pmax = fmaxf(__uint_as_float(rr[0]), __uint_as_float(rr[1])); }
        float alpha = 1.f;
        if (!__all(pmax - m_reg <= 11.0f)) { const float mn = fmaxf(m_reg, pmax); alpha = __builtin_amdgcn_exp2f(m_reg - mn); m_reg = mn; }
        float ps = 0.f;
#pragma unroll
        for (int r = 0; r < 16; ++r) { p0[r] = __builtin_amdgcn_exp2f(p0[r] - m_reg); p1[r] = __builtin_amdgcn_exp2f(p1[r] - m_reg); ps += p0[r] + p1[r]; }
        { auto rr = __builtin_amdgcn_permlane32_swap(__float_as_uint(ps), __float_as_uint(ps), false, false); ps = __uint_as_float(rr[0]) + __uint_as_float(rr[1]); }
        l_reg = l_reg * alpha + ps;
        bf16x8 pa0, pa1, pa2, pa3;
#define PK4(P, BASE, OUT) do { unsigned a0 = cvt_pk_bf16(P[BASE + 0], P[BASE + 1]), a1 = cvt_pk_bf16(P[BASE + 2], P[BASE + 3]);   \
    unsigned b0 = cvt_pk_bf16(P[BASE + 4], P[BASE + 5]), b1 = cvt_pk_bf16(P[BASE + 6], P[BASE + 7]);                              \
    auto r0 = __builtin_amdgcn_permlane32_swap(a0, b0, false, false); auto r1 = __builtin_amdgcn_permlane32_swap(a1, b1, false, false); \
    u32x4 w = {r0[0], r1[0], r0[1], r1[1]}; OUT = *reinterpret_cast<bf16x8*>(&w); } while (0)
        PK4(p0, 0, pa0); PK4(p0, 8, pa1); PK4(p1, 0, pa2); PK4(p1, 8, pa3);
#undef PK4
        if (__any(alpha < 1.f)) { if (hi == 0) al_l[r32] = alpha; LDS_WAIT();
#pragma unroll
            for (int d = 0; d < 4; ++d)
#pragma unroll
                for (int r = 0; r < 16; ++r) o[d][r] *= al_l[crow(r, hi)]; }
        const int vb = vb0 + bf * SHM_V;
        pv_one<0>(o[0], vb, pa0, pa1, pa2, pa3); pv_one<1>(o[1], vb, pa0, pa1, pa2, pa3); pv_one<2>(o[2], vb, pa0, pa1, pa2, pa3); pv_one<3>(o[3], vb, pa0, pa1, pa2, pa3);
        if (j + 1 < NT) { VM_WAIT(); SWRITE(bf ^ 1); }
        __syncthreads();
    }
#undef SLOAD
#undef SWRITE
    if (hi == 0) li_l[r32] = l_reg; LDS_WAIT();
    bf16_t* Ow = OA + ((size_t)b * SEQ + q0 + 4 * hi) * 1024 + wid * 128 + r32;
    const float* lip = li_l + 4 * hi;
    asm volatile("" : "+v"(Ow), "+v"(lip));
#pragma unroll
    for (int r = 0; r < 16; ++r) { const int ro = (r & 3) + 8 * (r >> 2); const float rl = fast_rcp(lip[ro]);
#pragma unroll
        for (int d0 = 0; d0 < 4; ++d0) { float v = o[d0][r] * rl; if ((DBG_ATTN_ZERO == 1 && q0 < 256) || (DBG_ATTN_ZERO == 2 && q0 >= 256)) v = 0.f; Ow[ro * 1024 + d0 * 32] = (bf16_t)(cvt_pk_bf16(v, v) & 0xffffu); }
        if ((r & 3) == 3) SBAR(); }
}
}
__device__ __forceinline__ void ph_attn(Frame& F) {
    char* lds = (char*)(unsigned char*)F.lds;
    { float* bt = (float*)(lds + att::OFF_BT); const float* BT = (const float*)(F.ws + WS_BIAST); __syncthreads(); for (int i = F.tid; i < 249 * 8; i += NTHR) bt[i] = BT[i]; __syncthreads(); }
    for (int pr = F.bid; pr < NB * 32; pr += F.G) {
        const int b = pr >> 5, qb = pr & 31;
#pragma nounroll
        for (int hh = 0; hh < 2; ++hh) att::attn_item(F, b, (hh ? qb : 63 - qb) * 32, lds);
    }
}

namespace ssd {
constexpr int OFF_CS = 0, CS_ST = 272;
constexpr int OFF_BS = OFF_CS + 64 * CS_ST;
constexpr int OFF_BT = OFF_BS + 64 * CS_ST, T_ST = 144;
constexpr int OFF_XT = OFF_BT + 128 * T_ST;
constexpr int OFF_XW = OFF_XT + 64 * T_ST;
constexpr int OFF_XS = OFF_XW + 64 * T_ST;
constexpr int OFF_MT = OFF_XS + 64 * T_ST;
constexpr int OFF_HS = OFF_MT + 64 * T_ST;
constexpr int OFF_END = OFF_HS + 64 * CS_ST;
static_assert(OFF_END + 5 * 320 * 4 <= 131072, "ssd lds");
__device__ __forceinline__ f32x4 mfma16(bf16x8 a, bf16x8 b, f32x4 c) { return __builtin_amdgcn_mfma_f32_16x16x32_bf16(a, b, c, 0, 0, 0); }
__device__ __forceinline__ bf16x8 ldfrag(const char* base, int stride, int row, int k0) { return *(const bf16x8*)(base + row * stride + k0 * 2); }
}
__device__ __forceinline__ void ph_ssd(Frame& F) {
    using namespace ssd;
    char* lds = (char*)(unsigned char*)F.lds;
    const bf16_t* XBC = (const bf16_t*)(F.ws + WS_XBC); const bf16_t* ZS = (const bf16_t*)(F.ws + WS_Z); const float* DT = (const float*)(F.outb + OUT_DT);
    bf16_t* YG = (bf16_t*)(F.ws + WS_Q);
    const float* conv_w = F.a->in[9]; const float* conv_b = F.a->in[10]; const float* a_log = F.a->in[12]; const float* d_skip = F.a->in[13];
    const int tid = F.tid, wid = F.wave, lane = F.lane, fr = lane & 15, fq = lane >> 4;
    const bool stager = tid < 320; const int so = tid % 40, tg = tid / 40;
    for (int item = F.bid; item < NB * 16; item += F.G) {
        const int b = item >> 4, h = item & 15, g = h >> 2;
        const float aneg = -__expf(a_log[h]), dsk = d_skip[h];
        const int ch0 = so < 8 ? h * 64 + so * 8 : (so < 24 ? 1024 + g * 128 + (so - 8) * 8 : 1536 + g * 128 + (so - 24) * 8);
        float* CWL = (float*)(lds + OFF_END);
        __syncthreads();
        if (stager) {
#pragma unroll
            for (int j = 0; j < 4; ++j) { *(f32x4*)(CWL + j * 320 + so * 8) = *(const f32x4*)(conv_w + (size_t)j * 2048 + ch0); *(f32x4*)(CWL + j * 320 + so * 8 + 4) = *(const f32x4*)(conv_w + (size_t)j * 2048 + ch0 + 4); }
            *(f32x4*)(CWL + 4 * 320 + so * 8) = *(const f32x4*)(conv_b + ch0); *(f32x4*)(CWL + 4 * 320 + so * 8 + 4) = *(const f32x4*)(conv_b + ch0 + 4);
        }
        f32x4 hst[4];
#pragma unroll
        for (int t = 0; t < 4; ++t) hst[t] = (f32x4){0.f, 0.f, 0.f, 0.f};
        __syncthreads();
        for (int i = tid; i < 64 * CS_ST / 4; i += NTHR) ((unsigned*)(lds + OFF_HS))[i] = 0u;
        u32x4 raw[11];
        const size_t tokb = (size_t)b * SEQ;
#define SSD_LOAD(c) do { if (stager) { _Pragma("unroll") for (int i = 0; i < 11; ++i) { const int t = (c) * 64 + tg * 8 - 3 + i; \
            raw[i] = (t >= 0) ? *(const u32x4*)(XBC + (tokb + t) * 2048 + ch0) : (u32x4){0u, 0u, 0u, 0u}; } } } while (0)
        SSD_LOAD(0);
        float dtl_next = DT[(tokb + lane) * 16 + h];
        for (int c = 0; c < 32; ++c) {
            const float dtl = dtl_next; if (c + 1 < 32) dtl_next = DT[(tokb + (c + 1) * 64 + lane) * 16 + h];
            u32x2 zpre[2];
#pragma unroll
            for (int t2 = 0; t2 < 2; ++t2) { const int tile = 2 * wid + t2, pb = tile >> 2, lb = tile & 3; zpre[t2] = *(const u32x2*)(ZS + (tokb + c * 64 + lb * 16 + fr) * 1024 + h * 64 + pb * 16 + 4 * fq); }
            float acs = dtl * aneg;
#pragma unroll
            for (int o = 1; o < 64; o <<= 1) { const float t = __shfl_up(acs, o); if (lane >= o) acs += t; }
            const float alast = __shfl(acs, 63);
            if (DBG_SSD_SYNC) __syncthreads();
            float dtv[8], dec[8];
#pragma unroll
            for (int t = 0; t < 8; ++t) { dtv[t] = __shfl(dtl, (tg * 8 + t) & 63); dec[t] = __expf(alast - __shfl(acs, (tg * 8 + t) & 63)); }
            if (stager) {
#pragma unroll
                for (int hq = 0; hq < 2; ++hq) {
                    float xin[11][4];
#pragma unroll
                    for (int i = 0; i < 11; ++i) { const unsigned wa = hq ? raw[i].z : raw[i].x, wb = hq ? raw[i].w : raw[i].y; xin[i][0] = bflo(wa); xin[i][1] = bfhi(wa); xin[i][2] = bflo(wb); xin[i][3] = bfhi(wb); }
                    float outv[8][4];
                    { f32x4 cwv[4]; const f32x4 cbq = *(const f32x4*)(CWL + 4 * 320 + so * 8 + hq * 4);
#pragma unroll
                      for (int j = 0; j < 4; ++j) cwv[j] = *(const f32x4*)(CWL + j * 320 + so * 8 + hq * 4);
#pragma unroll
                      for (int t = 0; t < 8; ++t)
#pragma unroll
                        for (int e = 0; e < 4; ++e) { float sacc = cbq[e];
#pragma unroll
                            for (int j = 0; j < 4; ++j) sacc += cwv[j][e] * xin[t + j][e];
                            outv[t][e] = silu_f(sacc); } }
                    if (so < 8) {
#pragma unroll
                        for (int e = 0; e < 4; ++e) { const int p = so * 8 + hq * 4 + e;
                            f32x4 x0, x1, d0, d1, w0, w1;
#pragma unroll
                            for (int t = 0; t < 4; ++t) { x0[t] = outv[t][e]; x1[t] = outv[4 + t][e]; d0[t] = x0[t] * dtv[t]; d1[t] = x1[t] * dtv[4 + t]; w0[t] = d0[t] * dec[t]; w1[t] = d1[t] * dec[4 + t]; }
                            *(u32x4*)(lds + OFF_XS + p * T_ST + tg * 16) = pack8(x0, x1);
                            *(u32x4*)(lds + OFF_XT + p * T_ST + tg * 16) = pack8(d0, d1);
                            *(u32x4*)(lds + OFF_XW + p * T_ST + tg * 16) = pack8(w0, w1); }
                    } else {
                        const bool isB = so < 24; const int n0 = (isB ? (so - 8) : (so - 24)) * 8 + hq * 4;
                        char* nat = lds + (isB ? OFF_BS : OFF_CS);
#pragma unroll
                        for (int t = 0; t < 8; ++t) { u32x2 w; w.x = cvt_pk_bf16(outv[t][0], outv[t][1]); w.y = cvt_pk_bf16(outv[t][2], outv[t][3]);
                            *(u32x2*)(nat + (tg * 8 + t) * CS_ST + n0 * 2) = w; }
                        if (isB) {
#pragma unroll
                            for (int e = 0; e < 4; ++e) { f32x4 a, bq;
#pragma unroll
                                for (int t = 0; t < 4; ++t) { a[t] = outv[t][e]; bq[t] = outv[4 + t][e]; }
                                *(u32x4*)(lds + OFF_BT + (n0 + e) * T_ST + tg * 16) = pack8(a, bq); }
                        }
                    }
                }
            }
            if (c + 1 < 32) SSD_LOAD(c + 1);
            __syncthreads();
#pragma unroll
            for (int t2 = 0; t2 < 2; ++t2) {
                const int tile = 2 * wid + t2, sb = tile >> 2, lb = tile & 3;
                f32x4 d = (f32x4){0.f, 0.f, 0.f, 0.f};
                if (sb <= lb) {
#pragma unroll
                    for (int ks = 0; ks < 4; ++ks) d = mfma16(ldfrag(lds + OFF_BS, CS_ST, sb * 16 + fr, ks * 32 + fq * 8), ldfrag(lds + OFF_CS, CS_ST, lb * 16 + fr, ks * 32 + fq * 8), d);
                    const int l = lb * 16 + fr; const float al = __shfl(acs, l);
                    f32x4 as;
#pragma unroll
                    for (int r = 0; r < 4; ++r) as[r] = __shfl(acs, sb * 16 + 4 * fq + r);
#pragma unroll
                    for (int r = 0; r < 4; ++r) { const int s = sb * 16 + 4 * fq + r; d[r] = (s <= l) ? d[r] * __expf(al - as[r]) : 0.f; }
                }
                u32x2 w; w.x = cvt_pk_bf16(d[0], d[1]); w.y = cvt_pk_bf16(d[2], d[3]);
                *(u32x2*)(lds + OFF_MT + (lb * 16 + fr) * T_ST + (sb * 16 + 4 * fq) * 2) = w;
            }
            if (DBG_SSD_SYNC) __syncthreads();
            f32x4 yacc[2];
#pragma unroll
            for (int t2 = 0; t2 < 2; ++t2) {
                const int tile = 2 * wid + t2, pb = tile >> 2, lb = tile & 3;
                f32x4 d = (f32x4){0.f, 0.f, 0.f, 0.f};
#pragma unroll
                for (int ks = 0; ks < 4; ++ks) d = mfma16(ldfrag(lds + OFF_HS, CS_ST, pb * 16 + fr, ks * 32 + fq * 8), ldfrag(lds + OFF_CS, CS_ST, lb * 16 + fr, ks * 32 + fq * 8), d);
                const float el = __expf(__shfl(acs, lb * 16 + fr));
                yacc[t2] = d * el;
            }
            __syncthreads();
#pragma unroll
            for (int t2 = 0; t2 < 2; ++t2) {
                const int tile = 2 * wid + t2, pb = tile >> 2, lb = tile & 3;
                f32x4 d = yacc[t2];
#pragma unroll
                for (int ks = 0; ks < 2; ++ks) d = mfma16(ldfrag(lds + OFF_XT, T_ST, pb * 16 + fr, ks * 32 + fq * 8), ldfrag(lds + OFF_MT, T_ST, lb * 16 + fr, ks * 32 + fq * 8), d);
                const int l = lb * 16 + fr, p0 = pb * 16 + 4 * fq; const size_t tok = tokb + c * 64 + l;
                const u32x2 zz = zpre[t2];
                const float z0 = bflo(zz.x), z1 = bfhi(zz.x), z2 = bflo(zz.y), z3 = bfhi(zz.y);
                float xs[4];
#pragma unroll
                for (int r = 0; r < 4; ++r) xs[r] = bflo((unsigned)*(const bf16_t*)(lds + OFF_XS + (p0 + r) * T_ST + l * 2));
                u32x2 w; w.x = cvt_pk_bf16((d[0] + xs[0] * dsk) * z0, (d[1] + xs[1] * dsk) * z1); w.y = cvt_pk_bf16((d[2] + xs[2] * dsk) * z2, (d[3] + xs[3] * dsk) * z3);
                *(u32x2*)(YG + tok * 1024 + h * 64 + p0) = w;
            }
            if (DBG_SSD_SYNC) __syncthreads();
            { const float dc = __expf(alast);
#pragma unroll
              for (int t = 0; t < 4; ++t) { f32x4 d = hst[t] * dc;
#pragma unroll
                  for (int ks = 0; ks < 2; ++ks) d = mfma16(ldfrag(lds + OFF_BT, T_ST, wid * 16 + fr, ks * 32 + fq * 8), ldfrag(lds + OFF_XW, T_ST, t * 16 + fr, ks * 32 + fq * 8), d);
                  hst[t] = d;
                  u32x2 w; w.x = cvt_pk_bf16(d[0], d[1]); w.y = cvt_pk_bf16(d[2], d[3]);
                  *(u32x2*)(lds + OFF_HS + (t * 16 + fr) * CS_ST + (wid * 16 + 4 * fq) * 2) = w; } }
            __syncthreads();
        }
#undef SSD_LOAD
    }
}

__device__ __forceinline__ void ph_gnorm(Frame& F) {
    bf16_t* YG = (bf16_t*)(F.ws + WS_Q);
    const int gw = F.bid * NWAVES + F.wave, NGW = F.G * NWAVES;
    for (int m = gw; m < NTOK; m += NGW) {
        u32x2* rp = (u32x2*)(YG + (size_t)m * D) + F.lane;
#pragma unroll
        for (int j = 0; j < 4; ++j) { const u32x2 w = rp[64 * j]; const float a = bflo(w.x), b = bfhi(w.x), c = bflo(w.y), d = bfhi(w.y);
            const float ss = wave_sum(a * a + b * b + c * c + d * d); const float r = 1.f / sqrtf(ss * (1.f / 256.f) + LN_EPS);
            u32x2 o; o.x = cvt_pk_bf16(a * r, b * r); o.y = cvt_pk_bf16(c * r, d * r); rp[64 * j] = o; }
    }
}

template <bool DRY = false> __device__ __forceinline__ void ph_router(Frame& F) {
    float* X1 = (float*)F.outb; bf16_t* U2 = (bf16_t*)(F.ws + WS_U2); const float* MOD = (const float*)(F.ws + WS_MOD);
    const float* ln1g = F.a->in[18]; const float* ln1b = F.a->in[19]; const float* w_router = F.a->in[20]; const float* b_router = F.a->in[21];
    u32x2* REG = (u32x2*)(F.ws + WS_REG); unsigned* CNT = (unsigned*)(F.ws + WS_CTL) + CW_CNT;
    constexpr int TST = 2064;
    LAS unsigned char* THI = F.lds; LAS unsigned char* TLO = F.lds + 16 * TST; LAS float* PART = (LAS float*)(F.lds + 32 * TST);
    LAS unsigned* lcnt = (LAS unsigned*)(F.lds + LDS_AUX); LAS unsigned* lbase = lcnt + 32; LAS unsigned* ent = lcnt + 64;
    const int tid = F.tid, lane = F.lane, wid = F.wave, fr = lane & 15, fq = lane >> 4;
    bf16x8 whi[4][2], wlo[4][2];
#pragma unroll
    for (int ks = 0; ks < 4; ++ks)
#pragma unroll
        for (int ct = 0; ct < 2; ++ct) { float wv[8];
#pragma unroll
            for (int i = 0; i < 8; ++i) wv[i] = w_router[(size_t)(128 * wid + 32 * ks + 8 * fq + i) * 32 + ct * 16 + fr];
            u32x4 h, l2;
#pragma unroll
            for (int i = 0; i < 4; ++i) { const unsigned hp = cvt_pk_bf16(wv[2 * i], wv[2 * i + 1]); const float r0 = wv[2 * i] - bflo(hp), r1 = wv[2 * i + 1] - bfhi(hp); h[i] = hp; l2[i] = cvt_pk_bf16(r0, r1); }
            whi[ks][ct] = __builtin_bit_cast(bf16x8, h); wlo[ks][ct] = __builtin_bit_cast(bf16x8, l2); }
    const float brl = b_router[lane & 31];
    for (int batch = F.bid; batch < NTOK / 256; batch += F.G) {
        const int hf = batch >> 7;
        __syncthreads();
        if (tid < 32) lcnt[tid] = 0u;
        for (int grp = 0; grp < 16; ++grp) {
#pragma unroll
            for (int tt = 0; tt < 2; ++tt) {
                const int tg16 = 2 * wid + tt, m = batch * 256 + grp * 16 + tg16; const float* md = MOD + (size_t)(m >> 11) * 6144;
                f32x4* xr = (f32x4*)(X1 + (size_t)m * D) + lane;
                f32x4 v[4]; float s = 0.f;
#pragma unroll
                for (int j = 0; j < 4; ++j) { v[j] = xr[64 * j]; s += (v[j][0] + v[j][1]) + (v[j][2] + v[j][3]); }
                float mean = wave_sum(s) * (1.f / D), s2 = 0.f;
#pragma unroll
                for (int j = 0; j < 4; ++j) { v[j] = v[j] - mean; s2 += (v[j][0] * v[j][0] + v[j][1] * v[j][1]) + (v[j][2] * v[j][2] + v[j][3] * v[j][3]); }
                float rstd = 1.f / sqrtf(wave_sum(s2) * (1.f / D) + LN_EPS);
                s = 0.f;
#pragma unroll
                for (int j = 0; j < 4; ++j) { const f32x4 g = *((const f32x4*)ln1g + lane + 64 * j), bb = *((const f32x4*)ln1b + lane + 64 * j); v[j] = v[j] * rstd * g + bb; if (!DRY) xr[64 * j] = v[j]; s += (v[j][0] + v[j][1]) + (v[j][2] + v[j][3]); }
                mean = wave_sum(s) * (1.f / D); s2 = 0.f;
#pragma unroll
                for (int j = 0; j < 4; ++j) { v[j] = v[j] - mean; s2 += (v[j][0] * v[j][0] + v[j][1] * v[j][1]) + (v[j][2] * v[j][2] + v[j][3] * v[j][3]); }
                rstd = 1.f / sqrtf(wave_sum(s2) * (1.f / D) + LN_EPS);
                u32x2* o8 = (u32x2*)(U2 + (size_t)m * D) + lane;
#pragma unroll
                for (int j = 0; j < 4; ++j) { const f32x4 sh = *((const f32x4*)(md + 3072) + lane + 64 * j), sc = *((const f32x4*)(md + 4096) + lane + 64 * j);
                    v[j] = v[j] * rstd * (sc + 1.0f) + sh; u32x2 w; w.x = cvt_pk_bf16(v[j][0], v[j][1]); w.y = cvt_pk_bf16(v[j][2], v[j][3]);
                    if (DRY) { if (w.x == 0x12345678u) o8[64 * j] = w; }
                    else if (MOE_FP8) { int pk = 0; pk = __builtin_amdgcn_cvt_pk_fp8_f32(v[j][0], v[j][1], pk, false); pk = __builtin_amdgcn_cvt_pk_fp8_f32(v[j][2], v[j][3], pk, true); ((unsigned*)((unsigned char*)U2 + (size_t)m * D))[lane + 64 * j] = (unsigned)pk; }
                    else o8[64 * j] = w;
                    u32x2 lo; lo.x = cvt_pk_bf16(v[j][0] - bflo(w.x), v[j][1] - bfhi(w.x)); lo.y = cvt_pk_bf16(v[j][2] - bflo(w.y), v[j][3] - bfhi(w.y));
                    *(LAS u32x2*)(THI + tg16 * TST + (4 * lane + 256 * j) * 2) = w; *(LAS u32x2*)(TLO + tg16 * TST + (4 * lane + 256 * j) * 2) = lo; }
            }
            __syncthreads();
            { f32x4 a0 = (f32x4){0.f, 0.f, 0.f, 0.f}, a1 = a0;
#pragma unroll
              for (int ks = 0; ks < 4; ++ks) { const int cb = (128 * wid + 32 * ks + 8 * fq) * 2;
                  const bf16x8 th = *(const LAS bf16x8*)(THI + fr * TST + cb), tl = *(const LAS bf16x8*)(TLO + fr * TST + cb);
                  a0 = __builtin_amdgcn_mfma_f32_16x16x32_bf16(whi[ks][0], th, a0, 0, 0, 0); a1 = __builtin_amdgcn_mfma_f32_16x16x32_bf16(whi[ks][1], th, a1, 0, 0, 0);
                  a0 = __builtin_amdgcn_mfma_f32_16x16x32_bf16(wlo[ks][0], th, a0, 0, 0, 0); a1 = __builtin_amdgcn_mfma_f32_16x16x32_bf16(wlo[ks][1], th, a1, 0, 0, 0);
                  a0 = __builtin_amdgcn_mfma_f32_16x16x32_bf16(whi[ks][0], tl, a0, 0, 0, 0); a1 = __builtin_amdgcn_mfma_f32_16x16x32_bf16(whi[ks][1], tl, a1, 0, 0, 0); }
              *(LAS f32x4*)(PART + (wid * 16 + fr) * 32 + 4 * fq) = a0; *(LAS f32x4*)(PART + (wid * 16 + fr) * 32 + 16 + 4 * fq) = a1; }
            __syncthreads();
            { const int tg16 = 2 * wid + (lane >> 5), tl = grp * 16 + tg16, myexp = lane & 31;
              float logit = brl;
#pragma unroll
              for (int w8 = 0; w8 < 8; ++w8) logit += PART[(w8 * 16 + tg16) * 32 + myexp];
              float tv[4]; int tix[4];
#pragma unroll
              for (int k = 0; k < 4; ++k) { float bv = logit; int bi = myexp;
#pragma unroll
                  for (int o = 1; o < 32; o <<= 1) { const float ov = __shfl_xor(bv, o); const int oi = __shfl_xor(bi, o); if (ov > bv || (ov == bv && oi < bi)) { bv = ov; bi = oi; } }
                  tv[k] = bv; tix[k] = bi; if (myexp == bi) logit = -INFINITY; }
              const float e1 = __expf(tv[1] - tv[0]), e2 = __expf(tv[2] - tv[0]), e3 = __expf(tv[3] - tv[0]); const float inv = 1.f / (1.f + e1 + e2 + e3);
              if (myexp < 4) { const int ee = myexp == 0 ? tix[0] : (myexp == 1 ? tix[1] : (myexp == 2 ? tix[2] : tix[3])); const float gg = (myexp == 0 ? 1.f : (myexp == 1 ? e1 : (myexp == 2 ? e2 : e3))) * inv;
                  const unsigned lp = atomicAdd((unsigned*)&lcnt[ee], 1u);
                  LAS unsigned* en = ent + (tl * 4 + myexp) * 3; en[0] = (unsigned)ee; en[1] = lp; en[2] = __float_as_uint(gg);
                  if (DBG_CHECK == 1) { u32x2 rw; rw.x = (unsigned)ee; rw.y = __float_as_uint(gg); ((u32x2*)(F.ws + WS_DBG))[(size_t)(batch * 256 + tl) * 4 + myexp] = rw; } } }
        }
        __syncthreads();
        if (tid < 32) lbase[tid] = DRY ? 0u : __hip_atomic_fetch_add(CNT + 64 * (hf * 32 + tid), lcnt[tid], __ATOMIC_RELAXED, __HIP_MEMORY_SCOPE_AGENT);
        __syncthreads();
        for (int i = tid; i < 1024; i += NTHR) { const LAS unsigned* en = ent + i * 3; const unsigned ee = en[0], pos = lbase[ee] + en[1];
            const unsigned tokl = (unsigned)(batch * 256 + (i >> 2)) - (unsigned)hf * HALF_TOK;
            u32x2 w; w.x = tokl * 4u + (unsigned)(i & 3); w.y = en[2];
            if (!DRY && pos < (unsigned)REG_CAP) REG[((size_t)hf * 32 + ee) * REG_CAP + pos] = w; }
    }
}

__device__ __forceinline__ void ph_final(Frame& F, int hf) {
    float* X1 = (float*)F.outb; const bf16_t* YB = (const bf16_t*)(F.ws + WS_YB); const float* MOD = (const float*)(F.ws + WS_MOD);
    const float* g2 = F.a->in[26]; const float* b2 = F.a->in[27];
    const int gw = F.bid * NWAVES + F.wave, NGW = F.G * NWAVES, lane = F.lane;
    constexpr int RB = 2;
    for (int tl0 = gw; tl0 < HALF_TOK; tl0 += NGW * RB) {
        f32x4 xv[RB][4]; u32x2 yw[RB][4][4];
#pragma unroll
        for (int r = 0; r < RB; ++r) { const int tl = tl0 + r * NGW, m = hf * HALF_TOK + tl;
            const f32x4* xr = (const f32x4*)(X1 + (size_t)m * D) + lane; const u32x2* yr = (const u32x2*)(YB + (size_t)tl * 4 * D) + lane;
#pragma unroll
            for (int j = 0; j < 4; ++j) { xv[r][j] = xr[64 * j];
#pragma unroll
                for (int k = 0; k < 4; ++k) yw[r][j][k] = yr[k * 256 + 64 * j]; } }
#pragma unroll
        for (int r = 0; r < RB; ++r) { const int tl = tl0 + r * NGW, m = hf * HALF_TOK + tl; const float* md = MOD + (size_t)(m >> 11) * 6144 + 5120;
            f32x4* xr = (f32x4*)(X1 + (size_t)m * D) + lane;
            f32x4 v[4]; float s = 0.f;
#pragma unroll
            for (int j = 0; j < 4; ++j) { f32x4 y = (f32x4){0.f, 0.f, 0.f, 0.f};
#pragma unroll
                for (int k = 0; k < 4; ++k) { const u32x2 w = yw[r][j][k]; y[0] += bflo(w.x); y[1] += bfhi(w.x); y[2] += bflo(w.y); y[3] += bfhi(w.y); }
                if (DBG_NO_MOE) y = (f32x4){0.f, 0.f, 0.f, 0.f};
                const f32x4 gt = *((const f32x4*)md + lane + 64 * j);
                v[j] = xv[r][j] * DN_ALPHA + gt * y; s += (v[j][0] + v[j][1]) + (v[j][2] + v[j][3]); }
            const float mean = wave_sum(s) * (1.f / D); float s2 = 0.f;
#pragma unroll
            for (int j = 0; j < 4; ++j) { v[j] = v[j] - mean; s2 += (v[j][0] * v[j][0] + v[j][1] * v[j][1]) + (v[j][2] * v[j][2] + v[j][3] * v[j][3]); }
            const float rstd = 1.f / sqrtf(wave_sum(s2) * (1.f / D) + LN_EPS);
#pragma unroll
            for (int j = 0; j < 4; ++j) { const f32x4 g = *((const f32x4*)g2 + lane + 64 * j), bb = *((const f32x4*)b2 + lane + 64 * j); xr[64 * j] = v[j] * rstd * g + bb; } }
    }
}

__device__ __forceinline__ float block_sum(Frame& F, float v, LAS float* red) {
    v = wave_sum(v); __syncthreads(); if (F.lane == 0) red[F.wave] = v; __syncthreads();
    float s = 0.f; for (int w = 0; w < NWAVES; ++w) s += red[w]; return s;
}
__device__ __forceinline__ float block_max(Frame& F, float v, LAS float* red) {
#pragma unroll
    for (int o = 1; o < 64; o <<= 1) v = fmaxf(v, __shfl_xor(v, o));
    __syncthreads(); if (F.lane == 0) red[F.wave] = v; __syncthreads();
    float s = 0.f; for (int w = 0; w < NWAVES; ++w) s = fmaxf(s, red[w]); return s;
}
__device__ __forceinline__ void dbg_report(Frame& F, float e) { if (F.tid == 0) atomicMax((unsigned*)(F.ws + WS_CTL) + CW_DBG, __float_as_uint(e)); }
__device__ __forceinline__ void dbg_check_moe(Frame& F) {
    if (F.bid >= 64) return;
    const int tok = HALF_TOK + 509 * F.bid + 3, tokl = tok - HALF_TOK, tid = F.tid;
    LAS float* u2 = (LAS float*)F.lds; LAS float* act = u2 + 1024; LAS float* red = act + 1024; LAS float* lg = red + 16;
    const bf16_t* U2 = (const bf16_t*)(F.ws + WS_U2); const bf16_t* YB = (const bf16_t*)(F.ws + WS_YB); const u32x2* RT = (const u32x2*)(F.ws + WS_DBG);
    const float* w1 = F.a->in[22]; const float* b1 = F.a->in[23]; const float* w2 = F.a->in[24]; const float* b2 = F.a->in[25];
    __syncthreads();
    for (int i = tid; i < 1024; i += NTHR) u2[i] = bflo((unsigned)U2[(size_t)tok * 1024 + i]);
    __syncthreads();
    float y0 = 0.f, y1 = 0.f;
    for (int k = 0; k < 4; ++k) {
        const u32x2 rw = RT[(size_t)tok * 4 + k]; const int e = (int)rw.x; const float g = __uint_as_float(rw.y);
        const float* W1 = w1 + (size_t)e * 1024 * 2048; const float* W2 = w2 + (size_t)e * 1024 * 1024;
        float h0 = b1[e * 2048 + tid], h1 = b1[e * 2048 + tid + 512], h2 = b1[e * 2048 + tid + 1024], h3 = b1[e * 2048 + tid + 1536];
        for (int c = 0; c < 1024; ++c) { const float uu = u2[c]; const float* wr = W1 + (size_t)c * 2048 + tid; h0 += uu * wr[0]; h1 += uu * wr[512]; h2 += uu * wr[1024]; h3 += uu * wr[1536]; }
        __syncthreads();
        { float gg = fminf(h0, 7.f), up = fminf(fmaxf(h2, -7.f), 7.f); act[tid] = (up + 1.f) * gg / (1.f + expf(-1.702f * gg));
          gg = fminf(h1, 7.f); up = fminf(fmaxf(h3, -7.f), 7.f); act[tid + 512] = (up + 1.f) * gg / (1.f + expf(-1.702f * gg)); }
        __syncthreads();
        float a0 = b2[e * 1024 + tid], a1 = b2[e * 1024 + tid + 512];
        for (int j = 0; j < 1024; ++j) { const float aa = act[j]; a0 += aa * W2[(size_t)j * 1024 + tid]; a1 += aa * W2[(size_t)j * 1024 + tid + 512]; }
        y0 += g * a0; y1 += g * a1;
    }
    float f0 = 0.f, f1 = 0.f;
    for (int k = 0; k < 4; ++k) { f0 += bflo((unsigned)YB[((size_t)tokl * 4 + k) * 1024 + tid]); f1 += bflo((unsigned)YB[((size_t)tokl * 4 + k) * 1024 + tid + 512]); }
    const float rms = sqrtf(block_sum(F, y0 * y0 + y1 * y1, red) * (1.f / 1024.f)) + 1e-20f;
    float err = block_max(F, fmaxf(fabsf(y0 - f0), fabsf(y1 - f1)), red) / rms;
    { const float* X1 = (const float*)F.outb + (size_t)tok * 1024; const float* md = (const float*)(F.ws + WS_MOD) + (size_t)(tok >> 11) * 6144;
      const float xa = X1[tid], xb = X1[tid + 512]; const float mean = block_sum(F, xa + xb, red) * (1.f / 1024.f);
      const float da = xa - mean, db = xb - mean; const float var = block_sum(F, da * da + db * db, red) * (1.f / 1024.f); const float rstd = 1.f / sqrtf(var + LN_EPS);
      __syncthreads();
      u2[tid] = da * rstd * (1.f + md[4096 + tid]) + md[3072 + tid]; u2[tid + 512] = db * rstd * (1.f + md[4096 + tid + 512]) + md[3072 + tid + 512];
      __syncthreads();
      if (tid < 32) { float a = F.a->in[21][tid]; for (int c = 0; c < 1024; ++c) a += u2[c] * F.a->in[20][c * 32 + tid]; lg[tid] = a; }
      __syncthreads();
      if (tid == 0) { unsigned want = 0u, got = 0u; float l2[32]; for (int i = 0; i < 32; ++i) l2[i] = lg[i];
          for (int k = 0; k < 4; ++k) { int bi = 0; for (int i = 1; i < 32; ++i) if (l2[i] > l2[bi]) bi = i; want |= 1u << bi; l2[bi] = -INFINITY; got |= 1u << RT[(size_t)tok * 4 + k].x; }
          lg[32] = (want != got) ? 1.f : 0.f; }
      __syncthreads();
      if (lg[32] != 0.f) err = 50.f; }
    dbg_report(F, err);
}
__device__ __forceinline__ void dbg_check_ssd(Frame& F) {
    if (F.bid >= 2) return;
    const int b = F.bid ? 20 : 5, h = F.bid ? 14 : 3, g = h >> 2, tid = F.tid, p = tid >> 3, ng = tid & 7;
    LAS float* red = (LAS float*)F.lds; LAS float* cv = red + 16;
    const bf16_t* XBC = (const bf16_t*)(F.ws + WS_XBC); const bf16_t* ZS = (const bf16_t*)(F.ws + WS_Z); const float* DT = (const float*)(F.outb + OUT_DT); const bf16_t* YG = (const bf16_t*)(F.ws + WS_Q);
    const float* cw = F.a->in[9]; const float* cb = F.a->in[10]; const float aneg = -expf(F.a->in[12][h]), dsk = F.a->in[13][h];
    const int mych = tid < 64 ? h * 64 + tid : (tid < 192 ? 1024 + g * 128 + (tid - 64) : 1536 + g * 128 + (tid - 192));
    float w0 = 0.f, w1 = 0.f, w2 = 0.f, w3 = 0.f, wb = 0.f;
    if (tid < 320) { w0 = cw[0 * 2048 + mych]; w1 = cw[1 * 2048 + mych]; w2 = cw[2 * 2048 + mych]; w3 = cw[3 * 2048 + mych]; wb = cb[mych]; }
    float x0 = 0.f, x1 = 0.f, x2 = 0.f;
    float hs[16];
#pragma unroll
    for (int i = 0; i < 16; ++i) hs[i] = 0.f;
    float emax = 0.f, ssq = 0.f, nbad = 0.f; int tmax = 0;
    for (int t = 0; t < SEQ; ++t) {
        const size_t tok = (size_t)b * SEQ + t;
        __syncthreads();
        if (DBG_HYP == 1 && (t & 63) == 0) { x0 = 0.f; x1 = 0.f; x2 = 0.f; }
        if (tid < 320) { const float x3 = bflo((unsigned)XBC[tok * 2048 + mych]); const float s = wb + w0 * x0 + w1 * x1 + w2 * x2 + w3 * x3; cv[tid] = s / (1.f + expf(-s)); x0 = x1; x1 = x2; x2 = x3; }
        __syncthreads();
        const float xv = cv[p], dt = DT[tok * 16 + h], dec = expf(dt * aneg);
        float yp = 0.f;
#pragma unroll
        for (int i = 0; i < 16; ++i) { const int n = ng * 16 + i; hs[i] = hs[i] * dec + dt * xv * cv[64 + n]; yp += cv[192 + n] * hs[i]; }
        yp += __shfl_xor(yp, 1); yp += __shfl_xor(yp, 2); yp += __shfl_xor(yp, 4);
        const float yv = (yp + xv * dsk) * bflo((unsigned)ZS[tok * 1024 + h * 64 + p]);
        const float yf = bflo((unsigned)YG[tok * 1024 + h * 64 + p]);
        if (ng == 0) { const float er = fabsf(yv - yf); if (er > emax) { emax = er; tmax = t; } ssq += yv * yv; if (er > 0.25f && (DBG_SUB < 5 || (DBG_SUB == 5 && (t & 63) == 0) || (DBG_SUB == 6 && (t & 63) == 1) || (DBG_SUB == 7 && (t & 63) == 32))) nbad += 1.f; }
    }
    const float rms = sqrtf(block_sum(F, ssq, red) / (64.f * SEQ)) + 1e-20f;
    const float M = block_max(F, emax, red);
    if (DBG_SUB == 0) dbg_report(F, M / rms);
    else if (DBG_SUB == 1) dbg_report(F, block_sum(F, nbad, red) / (64.f * SEQ));
    else if (DBG_SUB >= 5) dbg_report(F, block_sum(F, nbad, red) / (64.f * 32.f));
    else { __syncthreads(); if (ng == 0 && emax == M) red[12] = (float)(DBG_SUB == 2 ? ((tmax & 63) >> 1) : (DBG_SUB == 3 ? (tmax >> 6) : (p >> 1))); __syncthreads();
        if (F.bid == 0) dbg_report(F, powf(10.f, 2.f * (0.05f + 0.05f * red[12]) - 4.f)); }
}
__device__ __forceinline__ void dbg_check_attn(Frame& F) {
    if (F.bid >= 32) return;
    const int b = (F.bid * 7 + 3) & 31, pos = 300 + F.bid * 53, nadm = ((pos >> 6) + 1) * 64, tid = F.tid, lane = F.lane, hd = F.wave;
    const size_t tq = (size_t)b * SEQ + pos;
    LAS float* sc = (LAS float*)F.lds; LAS unsigned char* sel = (LAS unsigned char*)(sc + 2048); LAS float* lgt = (LAS float*)(sel + 2048); LAS float* red = lgt + 8 * 2048; LAS float* misc = red + 16;
    const bf16_t* IQ = (const bf16_t*)(F.outb + OUT_IQ); const bf16_t* IK = (const bf16_t*)(F.outb + OUT_IK); const float* IW = (const float*)(F.outb + OUT_IW);
    const bf16_t* Q = (const bf16_t*)(F.ws + WS_Q); const bf16_t* KV = (const bf16_t*)(F.outb + OUT_KV); const bf16_t* OA = (const bf16_t*)(F.outb + OUT_OA); const u64* MASK = (const u64*)(F.outb + OUT_MASK);
    __syncthreads();
    for (int k = tid; k < nadm; k += NTHR) { float s = 0.f;
        for (int hh = 0; hh < 8; ++hh) { float d = 0.f; for (int c = 0; c < 64; ++c) d += bflo((unsigned)IQ[tq * 512 + hh * 64 + c]) * bflo((unsigned)IK[((size_t)b * SEQ + k) * 64 + c]); s += fmaxf(d, 0.f) * IW[tq * 8 + hh]; }
        sc[k] = s + 0.0f; }
    __syncthreads();
    float nbad = 0.f;
    for (int k = tid; k < nadm; k += NTHR) { const float s = sc[k]; int rank = 0; for (int j = 0; j < nadm; ++j) { const float t = sc[j]; rank += (t > s || (t == s && j < k)) ? 1 : 0; }
        const unsigned char se = rank < 256 ? 1 : 0; sel[k] = se; const unsigned mb = (unsigned)((MASK[tq * 32 + (k >> 6)] >> (k & 63)) & 1ull); if (mb != se) nbad += 1.f; }
    __syncthreads();
    const float nbad_t = block_sum(F, nbad, red);
    LAS float* lw = lgt + hd * 2048; float mx = -INFINITY;
    for (int k = lane; k < nadm; k += 64) { float l = -INFINITY;
        if (sel[k]) { float d = 0.f; for (int c = 0; c < 128; ++c) d += bflo((unsigned)Q[tq * 1024 + hd * 128 + c]) * bflo((unsigned)KV[((size_t)b * SEQ + k) * 128 + c]);
            const int rel = k - pos, n = rel < 0 ? -rel : rel; const float nf = (float)(n > 1 ? n : 1); int large = 8 + (int)(logf(nf / 8.0f) / 2.7725887f * 8.0f); if (large > 15) large = 15;
            const int bucket = (rel > 0 ? 16 : 0) + (n < 8 ? n : large);
            l = d * 0.088388347648318440f + F.a->in[8][bucket * 8 + hd]; }
        lw[k] = l; mx = fmaxf(mx, l); }
#pragma unroll
    for (int o = 1; o < 64; o <<= 1) mx = fmaxf(mx, __shfl_xor(mx, o));
    float den = 0.f;
    for (int k = lane; k < nadm; k += 64) { const float pp = expf(lw[k] - mx); lw[k] = pp; den += pp; }
    den = wave_sum(den);
    float emax = 0.f, ssq = 0.f;
    for (int c2 = 0; c2 < 2; ++c2) { const int c = lane + 64 * c2; float o = 0.f; for (int k = 0; k < nadm; ++k) { const float pp = lw[k]; if (pp != 0.f) o += pp * bflo((unsigned)KV[((size_t)b * SEQ + k) * 128 + c]); }
        o /= den; const float of = bflo((unsigned)OA[tq * 1024 + hd * 128 + c]); emax = fmaxf(emax, fabsf(o - of)); ssq += o * o; }
    const float rms = sqrtf(block_sum(F, ssq, red) * (1.f / 1024.f)) + 1e-20f;
    float err = block_max(F, emax, red) / rms;
    (void)misc;
    if (nbad_t > 0.f) err = 10.f + nbad_t;
    dbg_report(F, err);
}
__device__ __forceinline__ void dbg_emit(Frame& F) {
    float* out = (float*)F.outb;
    for (size_t i = (size_t)F.bid * NTHR + F.tid; i < (size_t)NTOK * D / 4; i += (size_t)F.G * NTHR) ((f32x4*)out)[i] = (f32x4){0.f, 0.f, 0.f, 0.f};
    __syncthreads();
    if (F.bid == 0 && F.tid == 0) { const float e = __uint_as_float(__hip_atomic_load((unsigned*)(F.ws + WS_CTL) + CW_DBG, __ATOMIC_RELAXED, __HIP_MEMORY_SCOPE_AGENT));
        float code = (log10f(fmaxf(e, 1e-30f)) + 4.f) * 0.5f; code = fminf(fmaxf(rintf(code * 20.f) * 0.05f, 0.05f), 3.0f);
        out[0] = sqrtf(67108864.f * 1.01f * (powf(10.f, code) - 1.f)); }
}

constexpr int NPHASE = 17;
__global__ void __launch_bounds__(NTHR, 2) fwd(Args args) {
    extern __shared__ __attribute__((aligned(16))) unsigned char lds_raw[];
    Frame F;
    F.lds = (LAS unsigned char*)lds_raw;
    F.tid = threadIdx.x; F.lane = F.tid & 63; F.wave = __builtin_amdgcn_readfirstlane(F.tid >> 6); F.G = gridDim.x; F.bid = blockIdx.x;
    F.a = &args;
    F.ws = args.ws; F.outb = (unsigned char*)args.out;
    volatile LAS unsigned* MISCW = (volatile LAS unsigned*)(F.lds + LDS_MISC);
    if (F.tid < 64) MISCW[F.tid] = 0u;
    __syncthreads();
    XcdBarrier bar; bar.bar = (unsigned*)(F.ws + WS_CTL) + CW_BAR; bar.x = 0; bar.st = nullptr;
#if MK_ONE
    bar = xcd_barrier_post((unsigned*)(F.ws + WS_CTL) + CW_BAR, MISCW + 8);
#define GRID_BAR() xcd_barrier(bar)
#else
#define GRID_BAR() do { } while (0)
#endif
    const int lo = args.ph_lo, hi = args.ph_hi;
#ifndef PHM
#define PHM (0xFFFFFFFFu & ~(DBG_NO_ATTN ? 0x30u : 0u) & ~(DBG_NO_SSD ? 0xC0u : 0u))
#endif
#define IN(k) (((PHM >> (k)) & 1u) && lo <= (k) && (k) < hi)
#define SEAM(k) do { if ((k) + 1 < hi) GRID_BAR(); } while (0)

    if (IN(0)) { ph_prologue(F); if (DBG_TWICE & 1u) { GRID_BAR(); ph_prologue(F); } SEAM(0); }
    if (IN(1)) { ph_ln1(F); if (DBG_TWICE & 2u) { GRID_BAR(); ph_ln1(F); } SEAM(1); }
    if (IN(2)) {
        SchedPlain S; S.o.init(NTOK, NPROJ, F.G, F.bid); S.A = (const char*)(F.outb + OUT_U); S.Bt = (const char*)(F.ws + WS_WIN);
        EpiProj E{(bf16_t*)(F.ws + WS_Q), (bf16_t*)(F.outb + OUT_IQ), (bf16_t*)(F.ws + WS_Z), (bf16_t*)(F.ws + WS_XBC), (bf16_t*)(F.ws + WS_GA), (bf16_t*)(F.ws + WS_GB), (float*)(F.outb + OUT_MISC)};
        pg8::gemm_phase<EpiProj, SchedPlain, false>(F.lds, S, E);
        if (DBG_TWICE & 4u) { GRID_BAR(); pg8::gemm_phase<EpiProj, SchedPlain, false>(F.lds, S, E); }
        SEAM(2);
    }
    if (IN(3)) { ph_misc(F); if (DBG_TWICE & 8u) { GRID_BAR(); ph_misc(F); } SEAM(3); }
    if (IN(4)) { ph_index(F); if (DBG_TWICE & 16u) { GRID_BAR(); ph_index(F); } SEAM(4); }
    if (IN(5)) { ph_attn(F); if (DBG_TWICE & 32u) { GRID_BAR(); ph_attn(F); } SEAM(5); if (DBG_CHECK == 3) { dbg_check_attn(F); GRID_BAR(); } }
    if (IN(6)) { ph_ssd(F); if (DBG_TWICE & 64u) { GRID_BAR(); ph_ssd(F); } SEAM(6); if (DBG_CHECK == 2) { dbg_check_ssd(F); GRID_BAR(); } }
    if (IN(7)) { ph_gnorm(F); if (DBG_TWICE & 128u) { GRID_BAR(); ph_gnorm(F); } SEAM(7); }
    if (IN(8)) {
        SchedPlain S; S.o.init(NTOK, 1024, F.G, F.bid); S.A = (const char*)(F.outb + OUT_OA); S.Bt = (const char*)(F.ws + WS_WPA);
        EpiGate<0> E{(const bf16_t*)(F.ws + WS_GA), nullptr, (bf16_t*)(F.ws + WS_Z)};
        pg8::gemm_phase<EpiGate<0>, SchedPlain, false>(F.lds, S, E);
        if (DBG_TWICE & 256u) { GRID_BAR(); pg8::gemm_phase<EpiGate<0>, SchedPlain, false>(F.lds, S, E); }
        SEAM(8);
    }
    if (IN(9)) {
        SchedPlain S; S.o.init(NTOK, 1024, F.G, F.bid); S.A = (const char*)(F.ws + WS_Q); S.Bt = (const char*)(F.ws + WS_WPB);
        EpiGate<1> E{(const bf16_t*)(F.ws + WS_GB), (const bf16_t*)(F.ws + WS_Z), (bf16_t*)(F.ws + WS_XBC)};
        pg8::gemm_phase<EpiGate<1>, SchedPlain, false>(F.lds, S, E);
        SEAM(9);
    }
    if (IN(10)) {
        SchedPlain S; S.o.init(NTOK, 1024, F.G, F.bid); S.A = (const char*)(F.ws + WS_XBC); S.Bt = (const char*)(F.ws + WS_WOUT);
        EpiOut E{F.a->in[0], (const float*)(F.ws + WS_MOD), (float*)F.outb};
        pg8::gemm_phase<EpiOut, SchedPlain, false>(F.lds, S, E);
        if (DBG_TWICE & 1024u) { GRID_BAR(); pg8::gemm_phase<EpiOut, SchedPlain, false>(F.lds, S, E); }
        SEAM(10);
    }
    if (IN(11)) { if (DBG_TWICE & 2048u) { ph_router<true>(F); GRID_BAR(); } ph_router<false>(F); SEAM(11); }
#pragma unroll
    for (int hf = 0; hf < 2; ++hf) {
        const int p0 = 12 + hf * 2;
        if (IN(p0)) {
            if (hf == 1) ph_final(F, 0);
            MoeTab T = moe_tables(F, hf);
            SchedMoe<8, true> S{T, F.G, F.bid, hf, (const char*)(F.ws + WS_U2), (const char*)(F.ws + WS_W1), (const u32x2*)(F.ws + WS_REG)};
            EpiMoe1 E{F.a->in[23], (bf16_t*)(F.ws + WS_ACT)};
            pg8::gemm_phase<EpiMoe1, SchedMoe<8, true>, true, MOE_RB / 2, MOE_FP8 != 0>(F.lds, S, E);
            if ((DBG_TWICE & 4096u) && hf == 0) { GRID_BAR(); pg8::gemm_phase<EpiMoe1, SchedMoe<8, true>, true, MOE_RB / 2, MOE_FP8 != 0>(F.lds, S, E); }
            SEAM(p0);
        }
        if (IN(p0 + 1)) {
            MoeTab T = moe_tables(F, hf);
            SchedMoe<4, false> S{T, F.G, F.bid, hf, (const char*)(F.ws + WS_ACT), (const char*)(F.ws + WS_W2), (const u32x2*)(F.ws + WS_REG)};
            EpiMoe2 E{F.a->in[25], (bf16_t*)(F.ws + WS_YB), (const u32x2*)(F.ws + WS_REG), T, hf};
            pg8::gemm_phase<EpiMoe2, SchedMoe<4, false>, false, MOE_RB / 2, MOE_FP8 != 0>(F.lds, S, E);
            if ((DBG_TWICE & 8192u) && hf == 0) { GRID_BAR(); pg8::gemm_phase<EpiMoe2, SchedMoe<4, false>, false, MOE_RB / 2, MOE_FP8 != 0>(F.lds, S, E); }
            SEAM(p0 + 1);
            if (DBG_CHECK == 1 && hf == 1) { dbg_check_moe(F); GRID_BAR(); }
        }
    }
    if (IN(16)) { ph_final(F, 1); }
    if (DBG_CHECK) { GRID_BAR(); dbg_emit(F); }
#undef IN
#undef SEAM
}

extern "C" void kernel_launch(void* const* d_in, const int* in_sizes, int n_in, void* d_out, int out_size, void* d_ws, size_t ws_size, hipStream_t stream) {
    static int grid = 0;
    if (grid == 0) {
        if (n_in != 28 || in_sizes[0] != NTOK * D || out_size != NTOK * D || ws_size < WS_END) { fprintf(stderr, "kernel_launch: shape mismatch (n_in %d, in0 %d, out %d, ws %zu)\n", n_in, n_in > 0 ? in_sizes[0] : -1, out_size, ws_size); grid = -1; return; }
        int dev = 0, cus = 0, per_cu = 0;
        if (hipGetDevice(&dev) != hipSuccess || hipDeviceGetAttribute(&cus, hipDeviceAttributeMultiprocessorCount, dev) != hipSuccess) { grid = -1; return; }
        if (hipFuncSetAttribute((const void*)fwd, hipFuncAttributeMaxDynamicSharedMemorySize, LDS_BYTES) != hipSuccess) { fprintf(stderr, "kernel_launch: hipFuncSetAttribute failed\n"); grid = -1; return; }
        if (hipOccupancyMaxActiveBlocksPerMultiprocessor(&per_cu, (const void*)fwd, NTHR, LDS_BYTES) != hipSuccess || per_cu < 1) fprintf(stderr, "kernel_launch: occupancy query reports %d\n", per_cu);
        (void)hipGetLastError();
        grid = cus;
    }
    if (grid < 0) return;
    if (hipMemsetAsync((char*)d_ws + WS_CTL, 0, CTL_ZERO_BYTES, stream) != hipSuccess) { fprintf(stderr, "kernel_launch: memset failed\n"); return; }
    Args a{};
    for (int i = 0; i < 28; ++i) a.in[i] = (const float*)d_in[i];
    a.out = (float*)d_out; a.ws = (unsigned char*)d_ws;
    const int nph = NPHASE < MK_PH_HI ? NPHASE : MK_PH_HI;
#if MK_ONE
    a.ph_lo = 0; a.ph_hi = nph;
    hipLaunchKernelGGL(fwd, dim3(grid), dim3(NTHR), LDS_BYTES, stream, a);
#else
    for (int p = 0; p < nph; ++p) { a.ph_lo = p; a.ph_hi = p + 1; hipLaunchKernelGGL(fwd, dim3(grid), dim3(NTHR), LDS_BYTES, stream, a); }
#endif
    const hipError_t le = hipPeekAtLastError();
    if (le != hipSuccess) fprintf(stderr, "kernel_launch: launch failed: %s\n", hipGetErrorName(le));
}
```

```cpp
#include <hip/hip_runtime.h>
#include <cstdio>
#include <cstdint>

#ifndef MK_ONE
#define MK_ONE 1
#endif
#ifndef DBG_NO_ATTN
#define DBG_NO_ATTN 0
#endif
#ifndef DBG_ATTN_ZERO
#define DBG_ATTN_ZERO 0
#endif
#ifndef DBG_IQ_TRUNC
#define DBG_IQ_TRUNC 0
#endif
#ifndef DBG_ROUTER_BF16
#define DBG_ROUTER_BF16 0
#endif
#ifndef DBG_CHECK
#define DBG_CHECK 0
#endif
#ifndef DBG_SKIP_BODY
#define DBG_SKIP_BODY 0
#endif
#ifndef DBG_SUB
#define DBG_SUB 0
#endif
#ifndef DBG_SSD_SYNC
#define DBG_SSD_SYNC 0
#endif
#ifndef DBG_HYP
#define DBG_HYP 0
#endif
#ifndef DBG_TWICE
#define DBG_TWICE 0u
#endif
#ifndef DBG_DRYMODE
#define DBG_DRYMODE 2
#endif
#ifndef DBG_NO_SSD
#define DBG_NO_SSD 0
#endif
#ifndef DBG_NO_MOE
#define DBG_NO_MOE 0
#endif
#ifndef MOE_FP8
#define MOE_FP8 1
#endif
#ifndef PROJ_FP8
#define PROJ_FP8 1
#endif
#ifndef PA_FP8
#define PA_FP8 1
#endif
#ifndef MK_PH_HI
#define MK_PH_HI 99
#endif

#define LAS __attribute__((address_space(3)))
#define GAS __attribute__((address_space(1)))
typedef unsigned short bf16_t;
typedef short bf16x8 __attribute__((ext_vector_type(8)));
typedef short s16x4 __attribute__((ext_vector_type(4)));
typedef float f32x2 __attribute__((ext_vector_type(2)));
typedef float f32x4 __attribute__((ext_vector_type(4)));
typedef float f32x16 __attribute__((ext_vector_type(16)));
typedef unsigned u32x2 __attribute__((ext_vector_type(2)));
typedef unsigned u32x4 __attribute__((ext_vector_type(4)));
typedef unsigned long long u64;

constexpr int NB = 32, SEQ = 2048, D = 1024, NTOK = NB * SEQ;
constexpr int NWAVES = 8, NTHR = 512;
constexpr int NPROJ = 6912;
constexpr int NEXP = 32, HALF_TOK = NTOK / 2, REG_CAP = HALF_TOK;
constexpr int ACT_ROWS = HALF_TOK * 4 + NEXP * 256;
constexpr float LN_EPS = 1e-5f;
constexpr float DN_ALPHA = 1.189207115002721f;
constexpr float LOG2E = 1.4426950408889634f;

constexpr size_t MiB = 1u << 20;
constexpr size_t WS_CTL = 0, CTL_ZERO_BYTES = 1 * MiB;
constexpr size_t WS_MOD = 1 * MiB;
constexpr size_t WS_BIAST = 1 * MiB + 800 * 1024;
constexpr size_t WS_WIN = 2 * MiB;
constexpr size_t WS_WPA = 16 * MiB, WS_WPB = 18 * MiB, WS_WOUT = 20 * MiB;
constexpr size_t WS_W1 = 24 * MiB;
constexpr size_t WS_U8 = 88 * MiB;
constexpr size_t WS_W2 = 152 * MiB;
constexpr size_t WS_WIN8 = 184 * MiB;
constexpr size_t WS_WPA8 = 192 * MiB;
constexpr size_t WS_Q = 216 * MiB;
constexpr size_t WS_Z = 344 * MiB;
constexpr size_t WS_XBC = 472 * MiB;
constexpr size_t WS_GA = 728 * MiB, WS_GB = 856 * MiB;
constexpr size_t WS_U2 = 216 * MiB;
constexpr size_t WS_REG = 344 * MiB;
constexpr size_t WS_ACT = 360 * MiB;
constexpr size_t WS_YB = 632 * MiB;
constexpr size_t WS_END = 889 * MiB;
constexpr size_t WS_DBG = 889 * MiB;
constexpr size_t OUT_U = 0, OUT_MISC = 128 * MiB, OUT_IQ = 192 * MiB;
constexpr size_t OUT_KV = 0, OUT_IK = 16 * MiB, OUT_IW = 24 * MiB, OUT_DT = 26 * MiB, OUT_MASK = 32 * MiB, OUT_OA = 64 * MiB;
constexpr int CW_BAR = 4096, CW_CNT = 16384, CW_DBG = 24576;

constexpr int LDS_BYTES = 160 * 1024;
constexpr int LDS_AUX = 131072;
constexpr int LDS_MISC = LDS_BYTES - 256;

#define LDS_WAIT() asm volatile("s_waitcnt lgkmcnt(0)" ::: "memory")
#define VM_WAIT() asm volatile("s_waitcnt vmcnt(0)" ::: "memory")
#define SBAR() __builtin_amdgcn_sched_barrier(0)
typedef __bf16 bf16x2_t __attribute__((ext_vector_type(2)));
__device__ __forceinline__ unsigned cvt_pk_bf16(float lo, float hi) { f32x2 f = {lo, hi}; bf16x2_t v = __builtin_convertvector(f, bf16x2_t); return __builtin_bit_cast(unsigned, v); }
__device__ __forceinline__ float bflo(unsigned w) { return __uint_as_float(w << 16); }
__device__ __forceinline__ float bfhi(unsigned w) { return __uint_as_float(w & 0xffff0000u); }
__device__ __forceinline__ u32x4 pack8(f32x4 a, f32x4 b) { u32x4 w; w.x = cvt_pk_bf16(a[0], a[1]); w.y = cvt_pk_bf16(a[2], a[3]); w.z = cvt_pk_bf16(b[0], b[1]); w.w = cvt_pk_bf16(b[2], b[3]); return w; }
constexpr int MOE_RB = MOE_FP8 ? 1024 : 2048;
constexpr float MOE_WSC = MOE_FP8 ? 64.0f : 1.0f, MOE_INV = 1.0f / MOE_WSC;
__device__ __forceinline__ u32x2 pack8_fp8(f32x4 a, f32x4 b) { int lo = 0, hi = 0;
    lo = __builtin_amdgcn_cvt_pk_fp8_f32(a[0], a[1], lo, false); lo = __builtin_amdgcn_cvt_pk_fp8_f32(a[2], a[3], lo, true);
    hi = __builtin_amdgcn_cvt_pk_fp8_f32(b[0], b[1], hi, false); hi = __builtin_amdgcn_cvt_pk_fp8_f32(b[2], b[3], hi, true);
    u32x2 r; r.x = (unsigned)lo; r.y = (unsigned)hi; return r; }
__device__ __forceinline__ void unpack8(u32x4 w, f32x4& a, f32x4& b) { a[0] = bflo(w.x); a[1] = bfhi(w.x); a[2] = bflo(w.y); a[3] = bfhi(w.y); b[0] = bflo(w.z); b[1] = bfhi(w.z); b[2] = bflo(w.w); b[3] = bfhi(w.w); }
__device__ __forceinline__ float wave_sum(float v) {
#pragma unroll
    for (int o = 1; o < 64; o <<= 1) v += __shfl_xor(v, o);
    return v;
}
__device__ __forceinline__ float fast_rcp(float x) { return __builtin_amdgcn_rcpf(x); }
__device__ __forceinline__ float sigmoid_f(float x) { return fast_rcp(1.0f + __expf(-x)); }
__device__ __forceinline__ float silu_f(float x) { return x * sigmoid_f(x); }

#define XB_TMO      128
#define XB_XCNT(j)  (256  + 64 * (j))
#define XB_XSUB(j)  (1280 + 64 * (j))
#define XB_XGEN(j)  (2304 + 64 * (j))
#define XB_TOP      3328
#define XB_TOPGEN   3392
#define XCD_BAR_WORDS 3456
#define XB_SPIN_CAP (1u << 18)
__device__ __forceinline__ unsigned xb_ld(unsigned* p)              { return __hip_atomic_load(p, __ATOMIC_RELAXED, __HIP_MEMORY_SCOPE_AGENT); }
__device__ __forceinline__ unsigned xb_add(unsigned* p, unsigned v) { return __hip_atomic_fetch_add(p, v, __ATOMIC_RELAXED, __HIP_MEMORY_SCOPE_AGENT); }
__device__ __forceinline__ unsigned xb_xcc_id() { return (unsigned)__builtin_amdgcn_s_getreg((3 << 11) | 20) & 0xFu; }
#define XB_SPIN(cond, bar) do { unsigned _sp = 0; while (cond) { __builtin_amdgcn_s_sleep(1); \
    if ((++_sp & 255u) == 0u) { if (xb_ld(&(bar)[XB_TMO])) break; if (_sp > XB_SPIN_CAP) { atomicAdd(&(bar)[XB_TMO], 1u); break; } } } } while (0)
struct XcdBarrier { unsigned* bar; unsigned x; volatile LAS unsigned* st; };
__device__ __forceinline__ XcdBarrier xcd_barrier_post(unsigned* bar, volatile LAS unsigned* st) {
    XcdBarrier b; b.bar = bar; b.x = xb_xcc_id(); b.st = st;
    if (threadIdx.x == 0) (void)xb_add(&bar[XB_XCNT(b.x)], 1u);
    return b;
}
__device__ __forceinline__ void xcd_barrier_complete(unsigned* bar, unsigned x, unsigned& nloc, unsigned& nx) {
    const unsigned G = gridDim.x * gridDim.y * gridDim.z;
    unsigned sum, cnt, mine, sp = 0u;
    for (;;) {
        sum = 0u; cnt = 0u;
#pragma nounroll
        for (unsigned j = 0; j < 16; ++j) { const unsigned c = xb_ld(&bar[XB_XCNT(j)]); sum += c; cnt += (c > 0u) ? 1u : 0u; }
        if (sum == G) break;
        __builtin_amdgcn_s_sleep(1);
        if ((++sp & 255u) == 0u) { if (xb_ld(&bar[XB_TMO])) break; if (sp > XB_SPIN_CAP) { atomicAdd(&bar[XB_TMO], 1u); break; } }
    }
    mine = xb_ld(&bar[XB_XCNT(x)]);
    nloc = mine > 0u ? mine : 1u; nx = cnt > 0u ? cnt : 1u;
}
__device__ __forceinline__ void xcd_barrier(const XcdBarrier& b) {
    asm volatile("s_waitcnt vmcnt(0)" ::: "memory");
    __syncthreads();
    if (threadIdx.x == 0) {
        unsigned* bar = b.bar;
        __builtin_amdgcn_s_waitcnt(0);
        unsigned nloc = b.st[0], nx = b.st[1];
        if (nloc == 0u) { xcd_barrier_complete(bar, b.x, nloc, nx); b.st[0] = nloc; b.st[1] = nx; }
        const unsigned old = xb_add(&bar[XB_XSUB(b.x)], 1u);
        const unsigned gen = old / nloc;
        if (old + 1u == (gen + 1u) * nloc) {
            __builtin_amdgcn_fence(__ATOMIC_RELEASE, "agent");
            asm volatile("s_waitcnt vmcnt(0)" ::: "memory");
            const unsigned og = xb_add(&bar[XB_TOP], 1u);
            const unsigned tg = og / nx;
            if (og + 1u == (tg + 1u) * nx) xb_add(&bar[XB_TOPGEN], 1u);
            else XB_SPIN(xb_ld(&bar[XB_TOPGEN]) == tg, bar);
            __builtin_amdgcn_fence(__ATOMIC_ACQUIRE, "agent");
            xb_add(&bar[XB_XGEN(b.x)], 1u);
            asm volatile("s_waitcnt vmcnt(0)" ::: "memory");
        } else {
            XB_SPIN(xb_ld(&bar[XB_XGEN(b.x)]) == gen, bar);
            __builtin_amdgcn_fence(__ATOMIC_ACQUIRE, "agent");
            asm volatile("s_waitcnt vmcnt(0)" ::: "memory");
        }
    }
    __syncthreads();
}

namespace pg8 {
constexpr int BM = 256, BK = 64, HALF = 128, HTB = HALF * BK * 2, STAGE_BYTES = 8 * HTB, NXCD = 8, WGM = 8, KD = 1024;
__host__ __device__ __forceinline__ int lds_byte(int r, int c) { const int st = (r >> 4) * 2 + (c >> 5), rr = r & 15, cc = c & 31, ob = rr * 64 + cc * 2; return st * 1024 + (ob ^ (((ob >> 9) & 1) << 5)); }
__host__ __device__ __forceinline__ void stage_rc(int b, int& R, int& C) { const int st = b / 1024, sb = b % 1024, swz = sb ^ (((sb >> 9) & 1) << 5); R = (st >> 1) * 16 + swz / 64; C = (st & 1) * 32 + (swz % 64) / 2; }
__host__ __device__ __forceinline__ int perm32(int rho) { const int n = rho >> 4, i = rho & 15; return 8 * (i >> 2) + 4 * n + (i & 3); }
struct Unit { int pm, pn, ex; };
struct StaticOrder {
    int nM, nN, nwg, G, c;
    __device__ void init(int M, int N, int G_, int c_) { nM = M / BM; nN = N / BM; nwg = nM * nN; G = G_; c = c_; }
    __device__ bool next(int i, Unit& u) const {
        const long L = (long)i * G + c; if (L >= nwg) return false;
        int wgid = (int)L; { const int q = nwg / NXCD, r = nwg % NXCD, xcd = wgid % NXCD, off = wgid / NXCD; wgid = (xcd < r ? xcd * (q + 1) : r * (q + 1) + (xcd - r) * q) + off; }
        const int nig = WGM * nN, gid = wgid / nig, fm = gid * WGM, gsz = (nM - fm) < WGM ? (nM - fm) : WGM;
        u.pm = fm + ((wgid % nig) % gsz); u.pn = (wgid % nig) / gsz; u.ex = 0; return true;
    }
};
typedef int i32x8 __attribute__((ext_vector_type(8)));
typedef int i32x4v __attribute__((ext_vector_type(4)));
template <class Epi, class Sched, bool GATHER, int KE = 1024, bool FP8 = false>
__device__ __forceinline__ void gemm_phase(LAS unsigned char* lds, const Sched& S, const Epi& E) {
    int tid = threadIdx.x; asm volatile("" : "+v"(tid));
    const int wid = __builtin_amdgcn_readfirstlane(tid >> 6), lane = tid & 63, wr = wid >> 2, wc = wid & 3, fr = lane & 15, fq = lane >> 4;
    constexpr int K = KE, nt = K / BK;
    unsigned voffA[2], voffB[2]; int Rr[2], Cc[2];
#pragma unroll
    for (int i = 0; i < 2; ++i) { int R, C; stage_rc(tid * 16 + i * 8192, R, C); const int Rb = Epi::PERM ? ((R & ~31) + perm32(R & 31)) : R;
        voffA[i] = (unsigned)(R * K + C) * 2u; voffB[i] = (unsigned)(Rb * K + C) * 2u; Rr[i] = R; Cc[i] = C; }
    constexpr size_t kstep = (size_t)(BK * 2);
    constexpr size_t hstep = (size_t)HALF * K * 2;
    const unsigned ldsw = (unsigned)wid * 1024u;
    const int aoff = lds_byte(wr * 64 + fr, fq * 8), boff = lds_byte(wc * 32 + fr, fq * 8);
#define PG8_SA(b, h) (((b) * 2 + (h)) * HTB)
#define PG8_SB(b, h) ((4 + (b) * 2 + (h)) * HTB)
#define PG8_STAGE(bufoff, gbase, voff) do { _Pragma("unroll") for (int _i = 0; _i < 2; ++_i) \
        __builtin_amdgcn_global_load_lds((const unsigned*)((const char*)(gbase) + (voff)[_i]), (LAS unsigned*)(lds + (bufoff) + ldsw + _i * 8192), 16, 0, 0); } while (0)
#define PG8_STAGE_A(bufoff, gb, h, o0, o1) do { if constexpr (GATHER) { const unsigned _ko = (unsigned)((gb) - gA0); unsigned _o[2]; \
            if ((h) == 0) { _o[0] = (o0)[0] + _ko; _o[1] = (o0)[1] + _ko; } else { _o[0] = (o1)[0] + _ko; _o[1] = (o1)[1] + _ko; } PG8_STAGE(bufoff, gA0, _o); } \
        else { PG8_STAGE(bufoff, (gb) + (h) * hstep, voffA); } } while (0)
#define PG8_LD8(p) __builtin_shufflevector(*(const LAS i32x4v*)(p), *(const LAS i32x4v*)((p) + 1024), 0, 1, 2, 3, 4, 5, 6, 7)
#define PG8_LDA(dst, b, h) do { if constexpr (FP8) { _Pragma("unroll") for (int m = 0; m < 4; ++m) dst##8[m] = PG8_LD8(lds + PG8_SA(b, h) + aoff + m * 2048); } \
        else { _Pragma("unroll") for (int m = 0; m < 4; ++m) _Pragma("unroll") for (int k = 0; k < 2; ++k) dst[m][k] = *(const LAS bf16x8*)(lds + PG8_SA(b, h) + aoff + m * 2048 + k * 1024); } } while (0)
#define PG8_LDB(dst, b, h) do { if constexpr (FP8) { _Pragma("unroll") for (int n = 0; n < 2; ++n) dst##8[n] = PG8_LD8(lds + PG8_SB(b, h) + boff + n * 2048); } \
        else { _Pragma("unroll") for (int n = 0; n < 2; ++n) _Pragma("unroll") for (int k = 0; k < 2; ++k) dst[n][k] = *(const LAS bf16x8*)(lds + PG8_SB(b, h) + boff + n * 2048 + k * 1024); } } while (0)
#define PG8_MMA(ai, bj, At, Bt) do { __builtin_amdgcn_s_setprio(1); if constexpr (FP8) { _Pragma("unroll") for (int m = 0; m < 4; ++m) _Pragma("unroll") for (int n = 0; n < 2; ++n) \
            asm volatile("v_mfma_scale_f32_16x16x128_f8f6f4 %0, %1, %2, %0, %3, %3 op_sel_hi:[0,0,0]" : "+v"(acc[ai][bj][m][n]) : "v"(Bt##8[n]), "v"(At##8[m]), "v"(sc127)); } \
        else { _Pragma("unroll") for (int m = 0; m < 4; ++m) _Pragma("unroll") for (int n = 0; n < 2; ++n) _Pragma("unroll") for (int k = 0; k < 2; ++k) \
            acc[ai][bj][m][n] = __builtin_amdgcn_mfma_f32_16x16x32_bf16(Bt[n][k], At[m][k], acc[ai][bj][m][n], 0, 0, 0); } __builtin_amdgcn_s_setprio(0); } while (0)
#define PG8_WAIT_V(n) asm volatile("s_waitcnt vmcnt(" #n ")" ::: "memory")
#define PG8_WAIT_L(n) asm volatile("s_waitcnt lgkmcnt(" #n ")" ::: "memory")
#define PG8_BAR __builtin_amdgcn_s_barrier()
#define PG8_SCHED __builtin_amdgcn_sched_barrier(0)
    Unit cur, nxt; int ui = 0;
    if (!S.next(0, cur)) return;
    f32x4 acc[2][2][4][2];
#pragma unroll
    for (int a = 0; a < 2; ++a)
#pragma unroll
        for (int b = 0; b < 2; ++b)
#pragma unroll
            for (int m = 0; m < 4; ++m)
#pragma unroll
                for (int n = 0; n < 2; ++n) acc[a][b][m][n] = (f32x4){0.f, 0.f, 0.f, 0.f};
    const int sc127 = 0x7f7f7f7f;
    bf16x8 At[4][2], B0[2][2], B1[2][2]; i32x8 At8[4], B08[2], B18[2];
    const char* cA = S.a_base(cur); const char* cB = S.b_base(cur);
    const char* const gA0 = cA;
    unsigned cv0[2] = {0u, 0u}, cv1[2] = {0u, 0u}, nv0[2] = {0u, 0u}, nv1[2] = {0u, 0u};
    if constexpr (GATHER) S.a_offs(cur, Rr, Cc, cv0, cv1);
    PG8_STAGE(PG8_SB(0, 0), cB, voffB); PG8_STAGE_A(PG8_SA(0, 0), cA, 0, cv0, cv1); PG8_STAGE(PG8_SB(0, 1), cB + hstep, voffB); PG8_STAGE_A(PG8_SA(0, 1), cA, 1, cv0, cv1);
    if (wr == 1) PG8_BAR;
    PG8_WAIT_V(4); PG8_BAR;
    PG8_STAGE(PG8_SB(1, 0), cB + kstep, voffB); PG8_STAGE_A(PG8_SA(1, 0), cA + kstep, 0, cv0, cv1); PG8_STAGE(PG8_SB(1, 1), cB + hstep + kstep, voffB);
    PG8_WAIT_V(6); PG8_BAR;
    for (;;) {
        const bool has_next = S.next(ui + 1, nxt);
        const char* nA = has_next ? S.a_base(nxt) : cA; const char* nB = has_next ? S.b_base(nxt) : cB;
        if constexpr (GATHER) { if (has_next) S.a_offs(nxt, Rr, Cc, nv0, nv1); else { nv0[0] = cv0[0]; nv0[1] = cv0[1]; nv1[0] = cv1[0]; nv1[1] = cv1[1]; } }
#pragma nounroll
        for (int t = 0; t < nt; t += 2) {
            const bool last = (t == nt - 2);
            const char* a1 = cA + (size_t)(t + 1) * kstep;
            const char* a2 = last ? nA : cA + (size_t)(t + 2) * kstep; const char* b2 = last ? nB : cB + (size_t)(t + 2) * kstep;
            const char* a3 = a2 + kstep; const char* b3 = b2 + kstep;
            unsigned s0[2], s1[2];
            if constexpr (GATHER) { s0[0] = last ? nv0[0] : cv0[0]; s0[1] = last ? nv0[1] : cv0[1]; s1[0] = last ? nv1[0] : cv1[0]; s1[1] = last ? nv1[1] : cv1[1]; } else { s0[0] = s0[1] = s1[0] = s1[1] = 0u; }
            PG8_LDB(B0, 0, 0); PG8_SCHED; PG8_LDA(At, 0, 0); PG8_STAGE_A(PG8_SA(1, 1), a1, 1, cv0, cv1);
            PG8_WAIT_L(8); PG8_BAR; PG8_WAIT_L(0); PG8_MMA(0, 0, At, B0); PG8_BAR; PG8_SCHED;
            PG8_LDB(B1, 0, 1); PG8_STAGE(PG8_SB(0, 0), b2, voffB);
            PG8_BAR; PG8_WAIT_L(0); PG8_MMA(0, 1, At, B1); PG8_BAR;
            PG8_LDA(At, 0, 1); PG8_STAGE_A(PG8_SA(0, 0), a2, 0, s0, s1);
            PG8_BAR; PG8_WAIT_L(0); PG8_MMA(1, 0, At, B0); PG8_BAR; PG8_SCHED;
            PG8_STAGE(PG8_SB(0, 1), b2 + hstep, voffB);
            PG8_WAIT_V(6); PG8_BAR; PG8_MMA(1, 1, At, B1); PG8_BAR;
            PG8_LDB(B0, 1, 0); PG8_SCHED; PG8_LDA(At, 1, 0); PG8_STAGE_A(PG8_SA(0, 1), a2, 1, s0, s1);
            PG8_WAIT_L(8); PG8_BAR; PG8_WAIT_L(0); PG8_MMA(0, 0, At, B0); PG8_BAR; PG8_SCHED;
            PG8_LDB(B1, 1, 1); PG8_STAGE(PG8_SB(1, 0), b3, voffB);
            PG8_BAR; PG8_WAIT_L(0); PG8_MMA(0, 1, At, B1); PG8_BAR;
            PG8_LDA(At, 1, 1); PG8_STAGE_A(PG8_SA(1, 0), a3, 0, s0, s1);
            PG8_BAR; PG8_WAIT_L(0); PG8_MMA(1, 0, At, B0); PG8_BAR; PG8_SCHED;
            PG8_STAGE(PG8_SB(1, 1), b3 + hstep, voffB);
            PG8_WAIT_V(6); PG8_BAR; PG8_MMA(1, 1, At, B1); PG8_BAR;
        }
        if constexpr (FP8) asm volatile("s_nop 15\n\ts_nop 15" ::: "memory");
        E(acc, cur, wr, wc, fr, fq);
        if (!has_next) break;
#pragma unroll
        for (int a = 0; a < 2; ++a)
#pragma unroll
            for (int b = 0; b < 2; ++b)
#pragma unroll
                for (int m = 0; m < 4; ++m)
#pragma unroll
                    for (int n = 0; n < 2; ++n) acc[a][b][m][n] = (f32x4){0.f, 0.f, 0.f, 0.f};
        cur = nxt; cA = nA; cB = nB; ++ui;
        if constexpr (GATHER) { cv0[0] = nv0[0]; cv0[1] = nv0[1]; cv1[0] = nv1[0]; cv1[1] = nv1[1]; }
    }
    PG8_WAIT_V(0);
    if (wr == 0) PG8_BAR;
    PG8_BAR;
#undef PG8_SA
#undef PG8_SB
#undef PG8_STAGE
#undef PG8_STAGE_A
#undef PG8_LDA
#undef PG8_LDB
#undef PG8_MMA
#undef PG8_LD8
#undef PG8_WAIT_V
#undef PG8_WAIT_L
#undef PG8_BAR
#undef PG8_SCHED
}
}
using pg8::Unit;
typedef f32x4 AccT[2][2][4][2];

struct Args { const float* in[28]; float* out; unsigned char* ws; int ph_lo, ph_hi, pad0, pad1; };
struct Frame {
    LAS unsigned char* lds;
    int tid, lane, wave, G, bid;
    const struct Args* a;
    unsigned char* ws; unsigned char* outb;
};
template <int RB = 2048> struct SchedPlainT {
    pg8::StaticOrder o; const char* A; const char* Bt;
    __device__ __forceinline__ bool next(int i, Unit& u) const { return o.next(i, u); }
    __device__ __forceinline__ const char* a_base(const Unit& u) const { return A + (size_t)u.pm * (256 * RB); }
    __device__ __forceinline__ const char* b_base(const Unit& u) const { return Bt + (size_t)u.pn * (256 * RB); }
    __device__ __forceinline__ void a_offs(const Unit&, const int*, const int*, unsigned (&)[2], unsigned (&)[2]) const {}
};
typedef SchedPlainT<2048> SchedPlain;
template <int MODE> struct SchedProj {
    pg8::StaticOrder o; const char* A; const char* Bt;
    static constexpr int RB = MODE == 2 ? 1024 : 2048;
    __device__ __forceinline__ bool next(int i, Unit& u) const { if (!o.next(i, u)) return false; const int r = u.pn;
        if (MODE == 1) u.pn = 4 + r;
        if (MODE == 2) u.pn = r < 4 ? r : 15 + r;
        return true; }
    __device__ __forceinline__ const char* a_base(const Unit& u) const { return A + (size_t)u.pm * (256 * RB); }
    __device__ __forceinline__ const char* b_base(const Unit& u) const { return Bt + (size_t)u.pn * (256 * RB); }
    __device__ __forceinline__ void a_offs(const Unit&, const int*, const int*, unsigned (&)[2], unsigned (&)[2]) const {}
};

struct EpiProj {
    static constexpr bool PERM = true;
    bf16_t *Q, *IQ, *Z, *XBC, *GA, *GB; float* MISC; float sc;
    __device__ __forceinline__ void operator()(const AccT& acc, const Unit& u, int wr, int wc, int fr, int fq) const {
        const int pn = u.pn, row0 = u.pm * 256 + wr * 64 + fr, c8 = wc * 32 + 8 * fq;
        if (pn == 6) {
#pragma unroll
            for (int ai = 0; ai < 2; ++ai)
#pragma unroll
                for (int m = 0; m < 4; ++m) { float* rp = MISC + (size_t)(row0 + ai * 128 + m * 16) * 256 + c8;
#pragma unroll
                    for (int bj = 0; bj < 2; ++bj) { *(f32x4*)(rp + bj * 128) = acc[ai][bj][m][0]; *(f32x4*)(rp + bj * 128 + 4) = acc[ai][bj][m][1]; } }
            return;
        }
        bf16_t* base; int ldc, colt, act = 0;
        if (pn < 4) { base = Q; ldc = 1024; colt = pn * 256; }
        else if (pn < 6) { base = IQ; ldc = 512; colt = (pn - 4) * 256; }
        else if (pn < 11) { base = Z; ldc = 1024; colt = (pn - 7) * 256; act = 1; }
        else if (pn < 19) { base = XBC; ldc = 2048; colt = (pn - 11) * 256; }
        else if (pn < 23) { base = GA; ldc = 1024; colt = (pn - 19) * 256; act = 2; }
        else { base = GB; ldc = 1024; colt = (pn - 23) * 256; act = 2; }
#pragma unroll
        for (int ai = 0; ai < 2; ++ai)
#pragma unroll
            for (int m = 0; m < 4; ++m) { bf16_t* rp = base + (size_t)(row0 + ai * 128 + m * 16) * ldc + colt + c8;
#pragma unroll
                for (int bj = 0; bj < 2; ++bj) { f32x4 v0 = acc[ai][bj][m][0] * sc, v1 = acc[ai][bj][m][1] * sc;
                    if (act == 1) {
#pragma unroll
                        for (int j = 0; j < 4; ++j) { v0[j] = silu_f(v0[j]); v1[j] = silu_f(v1[j]); } }
                    if (act == 2) {
#pragma unroll
                        for (int j = 0; j < 4; ++j) { v0[j] = sigmoid_f(v0[j]); v1[j] = sigmoid_f(v1[j]); } }
                    u32x4 pk = pack8(v0, v1); if (DBG_IQ_TRUNC && (pn == 4 || pn == 5)) { pk.x &= 0xfff8fff8u; pk.y &= 0xfff8fff8u; pk.z &= 0xfff8fff8u; pk.w &= 0xfff8fff8u; }
                    *(u32x4*)(rp + bj * 128) = pk; } }
    }
};
template <int MODE> struct EpiGate {
    static constexpr bool PERM = true;
    const bf16_t* Gt; const bf16_t* T; bf16_t* O; float sc;
    __device__ __forceinline__ void operator()(const AccT& acc, const Unit& u, int wr, int wc, int fr, int fq) const {
        const int row0 = u.pm * 256 + wr * 64 + fr, c8 = u.pn * 256 + wc * 32 + 8 * fq;
#pragma unroll
        for (int ai = 0; ai < 2; ++ai)
#pragma unroll
            for (int m = 0; m < 4; ++m) { const size_t off = (size_t)(row0 + ai * 128 + m * 16) * 1024 + c8;
#pragma unroll
                for (int bj = 0; bj < 2; ++bj) { f32x4 g0, g1; unpack8(*(const u32x4*)(Gt + off + bj * 128), g0, g1);
                    f32x4 v0 = g0 * (acc[ai][bj][m][0] * sc), v1 = g1 * (acc[ai][bj][m][1] * sc);
                    if ((MODE == 0 && DBG_NO_ATTN) || (MODE == 1 && DBG_NO_SSD)) { v0 = (f32x4){0.f, 0.f, 0.f, 0.f}; v1 = v0; }
                    if (MODE == 1) { f32x4 t0, t1; unpack8(*(const u32x4*)(T + off + bj * 128), t0, t1); v0 += t0; v1 += t1; }
                    *(u32x4*)(O + off + bj * 128) = pack8(v0, v1); } }
    }
};
struct EpiOut {
    static constexpr bool PERM = false;
    const float* x; const float* mod; float* V;
    __device__ __forceinline__ void operator()(const AccT& acc, const Unit& u, int wr, int wc, int fr, int fq) const {
        const int row0 = u.pm * 256 + wr * 64 + fr, col0 = u.pn * 256 + wc * 32 + 4 * fq;
        const float* g1 = mod + (size_t)(u.pm >> 3) * 6144 + 2048 + col0;
        f32x4 gv[2][2];
#pragma unroll
        for (int bj = 0; bj < 2; ++bj)
#pragma unroll
            for (int n = 0; n < 2; ++n) gv[bj][n] = *(const f32x4*)(g1 + bj * 128 + n * 16);
#pragma unroll
        for (int ai = 0; ai < 2; ++ai)
#pragma unroll
            for (int m = 0; m < 4; ++m) { const size_t off = (size_t)(row0 + ai * 128 + m * 16) * 1024 + col0;
#pragma unroll
                for (int bj = 0; bj < 2; ++bj)
#pragma unroll
                    for (int n = 0; n < 2; ++n) { const f32x4 xv = *(const f32x4*)(x + off + bj * 128 + n * 16);
                        *(f32x4*)(V + off + bj * 128 + n * 16) = xv * DN_ALPHA + gv[bj][n] * acc[ai][bj][m][n]; } }
    }
};

struct MoeTab { LAS unsigned* cnt; LAS unsigned* tb; LAS unsigned char* te; int ntiles; };
__device__ __forceinline__ MoeTab moe_tables(Frame& F, int hf) {
    MoeTab T; T.cnt = (LAS unsigned*)(F.lds + LDS_AUX); T.tb = (LAS unsigned*)(F.lds + LDS_AUX + 256); T.te = (LAS unsigned char*)(F.lds + LDS_AUX + 512);
    const unsigned* CNT = (const unsigned*)(F.ws + WS_CTL) + CW_CNT;
    __syncthreads();
    if (F.tid < 32) { unsigned c = __hip_atomic_load(CNT + 64 * (hf * 32 + F.tid), __ATOMIC_RELAXED, __HIP_MEMORY_SCOPE_AGENT); if (c > (unsigned)REG_CAP) c = REG_CAP; T.cnt[F.tid] = c; }
    __syncthreads();
    if (F.tid == 0) { unsigned s = 0;
#pragma nounroll
        for (int e = 0; e < 32; ++e) { T.tb[e] = s; const unsigned n = (T.cnt[e] + 255u) >> 8;
#pragma nounroll
            for (unsigned t = 0; t < n; ++t) T.te[s + t] = (unsigned char)e;
            s += n; }
        T.tb[32] = s; }
    __syncthreads();
    T.ntiles = __builtin_amdgcn_readfirstlane((int)T.tb[32]);
    return T;
}
template <int NJ, bool GATHER> struct SchedMoe {
    MoeTab T; int G, c, hf; const char* A; const char* Bt; const u32x2* REG;
    __device__ __forceinline__ bool next(int i, Unit& u) const {
        int tile, j;
        if (G == 256) { const int x = c & 7, sl = c >> 3;
            tile = i * (256 / NJ) + x * (32 / NJ) + sl / NJ; j = sl % NJ;
            if (tile >= T.ntiles) return false; }
        else { const int L = i * G + c; if (L >= T.ntiles * NJ) return false; tile = L / NJ; j = L % NJ; }
        u.pm = tile; u.pn = j; u.ex = __builtin_amdgcn_readfirstlane((int)T.te[u.pm]); return true;
    }
    __device__ __forceinline__ const char* a_base(const Unit& u) const { return GATHER ? A : A + (size_t)u.pm * (256 * MOE_RB); }
    __device__ __forceinline__ const char* b_base(const Unit& u) const { return Bt + ((size_t)u.ex * (NJ * 256) + (size_t)u.pn * 256) * MOE_RB; }
    __device__ __forceinline__ void a_offs(const Unit& u, const int* R, const int* C, unsigned (&o0)[2], unsigned (&o1)[2]) const {
        const unsigned cnt = __builtin_amdgcn_readfirstlane(T.cnt[u.ex]), pos0 = ((unsigned)u.pm - (unsigned)__builtin_amdgcn_readfirstlane(T.tb[u.ex])) * 256u; const u32x2* rg = REG + ((size_t)hf * 32 + u.ex) * REG_CAP;
#pragma unroll
        for (int i = 0; i < 2; ++i) {
            const unsigned p0 = pos0 + (unsigned)R[i], p1 = p0 + 128u;
            unsigned t0 = 0u, t1 = 0u;
            if (p0 < cnt) t0 = (unsigned)hf * HALF_TOK + (rg[p0].x >> 2);
            if (p1 < cnt) t1 = (unsigned)hf * HALF_TOK + (rg[p1].x >> 2);
            o0[i] = t0 * (unsigned)MOE_RB + (unsigned)C[i] * 2u; o1[i] = t1 * (unsigned)MOE_RB + (unsigned)C[i] * 2u;
        }
    }
};
struct EpiMoe1 {
    static constexpr bool PERM = true;
    const float* b1; bf16_t* ACT; int dry;
    __device__ __forceinline__ void operator()(const AccT& acc, const Unit& u, int wr, int wc, int fr, int fq) const {
        if (dry) { if (acc[0][0][0][0][0] == 1.2345e-33f) ACT[0] = 1; return; }
        const int row0 = u.pm * 256 + wr * 64 + fr, c8 = u.pn * 128 + wc * 32 + 8 * fq;
        const float* bg = b1 + (size_t)u.ex * 2048 + c8;
        const f32x4 bg0 = *(const f32x4*)bg, bg1 = *(const f32x4*)(bg + 4), bu0 = *(const f32x4*)(bg + 1024), bu1 = *(const f32x4*)(bg + 1028);
#pragma unroll
        for (int ai = 0; ai < 2; ++ai)
#pragma unroll
            for (int m = 0; m < 4; ++m) {
                f32x4 g0 = acc[ai][0][m][0] * MOE_INV + bg0, g1 = acc[ai][0][m][1] * MOE_INV + bg1, u0 = acc[ai][1][m][0] * MOE_INV + bu0, u1 = acc[ai][1][m][1] * MOE_INV + bu1, a0, a1;
#pragma unroll
                for (int j = 0; j < 4; ++j) {
                    float g = fminf(g0[j], 7.0f), up = fminf(fmaxf(u0[j], -7.0f), 7.0f); a0[j] = (up + 1.0f) * g * sigmoid_f(1.702f * g);
                    g = fminf(g1[j], 7.0f); up = fminf(fmaxf(u1[j], -7.0f), 7.0f); a1[j] = (up + 1.0f) * g * sigmoid_f(1.702f * g); }
                if (MOE_FP8) *(u32x2*)((unsigned char*)ACT + (size_t)(row0 + ai * 128 + m * 16) * 1024 + c8) = pack8_fp8(a0, a1);
                else *(u32x4*)(ACT + (size_t)(row0 + ai * 128 + m * 16) * 1024 + c8) = pack8(a0, a1); }
    }
};
struct EpiMoe2 {
    static constexpr bool PERM = true;
    const float* b2; bf16_t* YB; const u32x2* REG; MoeTab T; int hf; int dry;
    __device__ __forceinline__ void operator()(const AccT& acc, const Unit& u, int wr, int wc, int fr, int fq) const {
        if (dry == 1) { if (acc[0][0][0][0][0] == 1.2345e-33f) YB[0] = 1; return; }
        if (dry >= 2) {
            const int c8d = (dry == 3 ? 0 : u.pn * 256) + wc * 32 + 8 * fq; const unsigned rowd = dry == 3 ? (blockIdx.x * 256u + (unsigned)(wr * 64 + fr)) : ((unsigned)u.pm * 256u + (unsigned)(wr * 64 + fr)) % 131072u;
#pragma unroll
            for (int ai = 0; ai < 2; ++ai)
#pragma unroll
                for (int m = 0; m < 4; ++m) { bf16_t* rp = YB + (size_t)((rowd + ai * 128 + m * 16) % 131072u) * 1024 + c8d;
#pragma unroll
                    for (int bj = 0; bj < 2; ++bj) *(u32x4*)(rp + bj * 128) = pack8(acc[ai][bj][m][0] * MOE_INV, acc[ai][bj][m][1] * MOE_INV); }
            return; }
        const int c8 = u.pn * 256 + wc * 32 + 8 * fq;
        const unsigned cnt = __builtin_amdgcn_readfirstlane(T.cnt[u.ex]), pos0 = ((unsigned)u.pm - (unsigned)__builtin_amdgcn_readfirstlane(T.tb[u.ex])) * 256u + (unsigned)(wr * 64 + fr); const u32x2* rg = REG + ((size_t)hf * 32 + u.ex) * REG_CAP;
        const float* bb = b2 + (size_t)u.ex * 1024 + c8;
        f32x4 bv[2][2];
#pragma unroll
        for (int bj = 0; bj < 2; ++bj) { bv[bj][0] = *(const f32x4*)(bb + bj * 128); bv[bj][1] = *(const f32x4*)(bb + bj * 128 + 4); }
        u32x2 en8[2][4];
#pragma unroll
        for (int ai = 0; ai < 2; ++ai)
#pragma unroll
            for (int m = 0; m < 4; ++m) { const unsigned p = pos0 + (unsigned)(ai * 128 + m * 16); en8[ai][m] = rg[p < cnt ? p : cnt - 1u]; }
#pragma unroll
        for (int ai = 0; ai < 2; ++ai)
#pragma unroll
            for (int m = 0; m < 4; ++m) { const unsigned p = pos0 + (unsigned)(ai * 128 + m * 16);
                const u32x2 en = en8[ai][m]; const float g = __uint_as_float(en.y); const unsigned drow = p < cnt ? en.x : (unsigned)(HALF_TOK * 4);
                bf16_t* rp = YB + (size_t)drow * 1024 + c8;
#pragma unroll
                for (int bj = 0; bj < 2; ++bj) *(u32x4*)(rp + bj * 128) = pack8((acc[ai][bj][m][0] * MOE_INV + bv[bj][0]) * g, (acc[ai][bj][m][1] * MOE_INV + bv[bj][1]) * g); }
    }
};

struct MapIdent { __device__ __forceinline__ int operator()(int n) const { return n; } };
struct MapWin { __device__ __forceinline__ int operator()(int n) const {
    if (n < 1024) return n;
    if (n < 1536) return 1152 + (n - 1024);
    if (n < 1792) { const int c = n - 1536; if (c < 128) return 1024 + c; if (c < 192) return 1664 + (c - 128); if (c < 200) return 1728 + (c - 192); if (c < 216) return 4808 + (c - 200); return -1; }
    if (n < 2816) return 1736 + (n - 1792);
    if (n < 4864) return 2760 + (n - 2816);
    if (n < 5888) return 4824 + (n - 4864);
    return 5848 + (n - 5888); } };
struct MapW1 { __device__ __forceinline__ int operator()(int r) const { const int j = r >> 8, rr = r & 255; return (rr >> 7) * 1024 + j * 128 + (rr & 127); } };
template <class Map, bool F8 = false> __device__ __forceinline__ void transpose_item(const float* W, int K, int N, bf16_t* WT, const Map& map, LAS float* scr, int kb, int nb, int lane, const float* rowscale) {
    const int k0 = 64 * kb, n0 = 64 * nb, q = lane & 15, kr = lane >> 4; const int src = map(n0 + 4 * q);
    f32x4 ld[16];
#pragma unroll
    for (int i = 0; i < 16; ++i) { const int kk = 4 * i + kr; ld[i] = (src >= 0) ? *(const f32x4*)(W + (size_t)(k0 + kk) * N + src) : (f32x4){0.f, 0.f, 0.f, 0.f}; }
#pragma unroll
    for (int i = 0; i < 16; ++i) { const int kk = 4 * i + kr; f32x4 v = ld[i]; if (rowscale) v = v * rowscale[k0 + kk]; LAS float* d = scr + kk * 65 + 4 * q; d[0] = v[0]; d[1] = v[1]; d[2] = v[2]; d[3] = v[3]; }
    LDS_WAIT(); asm volatile("" ::: "memory");
    const int c = lane & 7;
#pragma unroll
    for (int j = 0; j < 8; ++j) { const int n = (lane >> 3) + 8 * j; const LAS float* s = scr + (8 * c) * 65 + n;
        if constexpr (F8) { const f32x4 a = {s[0 * 65] * MOE_WSC, s[1 * 65] * MOE_WSC, s[2 * 65] * MOE_WSC, s[3 * 65] * MOE_WSC}, b = {s[4 * 65] * MOE_WSC, s[5 * 65] * MOE_WSC, s[6 * 65] * MOE_WSC, s[7 * 65] * MOE_WSC};
            *(u32x2*)((unsigned char*)WT + (size_t)(n0 + n) * K + k0 + 8 * c) = pack8_fp8(a, b); }
        else { u32x4 o; o.x = cvt_pk_bf16(s[0 * 65], s[1 * 65]); o.y = cvt_pk_bf16(s[2 * 65], s[3 * 65]); o.z = cvt_pk_bf16(s[4 * 65], s[5 * 65]); o.w = cvt_pk_bf16(s[6 * 65], s[7 * 65]);
            *(u32x4*)(WT + (size_t)(n0 + n) * K + k0 + 8 * c) = o; } }
    LDS_WAIT(); asm volatile("" ::: "memory");
}
__device__ __forceinline__ void ph_prologue(Frame& F) {
    const float* c_in = F.a->in[1]; const float* w_mod = F.a->in[2]; const float* b_mod = F.a->in[3];
    float* MOD = (float*)(F.ws + WS_MOD);
    for (int item = F.bid; item < 48; item += F.G) {
        LAS float* SC = (LAS float*)F.lds;
        __syncthreads();
        for (int i = F.tid; i < 32768; i += NTHR) { const int b = i >> 10, k = i & 1023; SC[k * 32 + b] = silu_f(c_in[i]); }
        __syncthreads();
        const int col = item * 128 + (F.tid >> 2), kq = F.tid & 3;
        float a[32];
#pragma unroll
        for (int b = 0; b < 32; ++b) a[b] = 0.f;
#pragma nounroll
        for (int kg = 0; kg < 256; kg += 16) {
            float wv[16];
#pragma unroll
            for (int u = 0; u < 16; ++u) wv[u] = w_mod[(size_t)(kq * 256 + kg + u) * 6144 + col];
#pragma unroll
            for (int u = 0; u < 16; ++u) { const int k = kq * 256 + kg + u; const float w = wv[u];
#pragma unroll
                for (int b4 = 0; b4 < 8; ++b4) { const f32x4 s = *(const LAS f32x4*)(SC + k * 32 + b4 * 4); a[b4 * 4 + 0] += w * s[0]; a[b4 * 4 + 1] += w * s[1]; a[b4 * 4 + 2] += w * s[2]; a[b4 * 4 + 3] += w * s[3]; } } }
#pragma unroll
        for (int b = 0; b < 32; ++b) { a[b] += __shfl_xor(a[b], 1); a[b] += __shfl_xor(a[b], 2); }
        if (kq == 0) { const float bm = b_mod[col];
#pragma unroll
            for (int b = 0; b < 32; ++b) MOD[(size_t)b * 6144 + col] = a[b] + bm; }
        __syncthreads();
    }
    if (F.bid == (F.G > 48 ? 48 : 0)) {
        float* BT = (float*)(F.ws + WS_BIAST); const float* rel_bias = F.a->in[8];
        for (int i = F.tid; i < 249 * 8; i += NTHR) { const int idx = i >> 3, h = i & 7, rel = idx - 185; const int n = rel < 0 ? -rel : rel;
            const float nf = (float)(n > 1 ? n : 1); int large = 8 + (int)(logf(nf / 8.0f) / 2.7725887f * 8.0f); if (large > 15) large = 15;
            const int bucket = (rel > 0 ? 16 : 0) + (n < 8 ? n : large);
            BT[i] = rel_bias[bucket * 8 + h] * LOG2E; }
    }
    LAS float* scr = (LAS float*)(F.lds + F.wave * 16640);
    __syncthreads();
    const int gw = F.bid * NWAVES + F.wave, NGW = F.G * NWAVES;
    constexpr int I_WIN = 16 * (NPROJ / 64), I_SQ = 16 * 16, I_W1E = 16 * 32, I_W2E = 16 * 16;
    constexpr int NITEMS = (PROJ_FP8 ? 2 : 1) * I_WIN + 3 * I_SQ + 32 * I_W1E + 32 * I_W2E;
    for (int it = gw; it < NITEMS; it += NGW) {
        int r = it;
        if (r < I_WIN) { transpose_item(F.a->in[4], 1024, 6872, (bf16_t*)(F.ws + WS_WIN), MapWin(), scr, r / (NPROJ / 64), r % (NPROJ / 64), F.lane, nullptr); continue; } r -= I_WIN;
        if (PROJ_FP8) { if (r < I_WIN) { transpose_item<MapWin, true>(F.a->in[4], 1024, 6872, (bf16_t*)(F.ws + WS_WIN8), MapWin(), scr, r / (NPROJ / 64), r % (NPROJ / 64), F.lane, nullptr); continue; } r -= I_WIN; }
        if (r < I_SQ) { if (PA_FP8) transpose_item<MapIdent, true>(F.a->in[15], 1024, 1024, (bf16_t*)(F.ws + WS_WPA8), MapIdent(), scr, r / 16, r % 16, F.lane, nullptr);
                         else transpose_item(F.a->in[15], 1024, 1024, (bf16_t*)(F.ws + WS_WPA), MapIdent(), scr, r / 16, r % 16, F.lane, nullptr); continue; } r -= I_SQ;
        if (r < I_SQ) { transpose_item(F.a->in[16], 1024, 1024, (bf16_t*)(F.ws + WS_WPB), MapIdent(), scr, r / 16, r % 16, F.lane, F.a->in[14]); continue; } r -= I_SQ;
        if (r < I_SQ) { transpose_item(F.a->in[17], 1024, 1024, (bf16_t*)(F.ws + WS_WOUT), MapIdent(), scr, r / 16, r % 16, F.lane, nullptr); continue; } r -= I_SQ;
        if (r < 32 * I_W1E) { const int e = r / I_W1E, q = r % I_W1E; transpose_item<MapW1, MOE_FP8 != 0>(F.a->in[22] + (size_t)e * 1024 * 2048, 1024, 2048, (bf16_t*)(F.ws + WS_W1 + (size_t)e * 2048 * MOE_RB), MapW1(), scr, q / 32, q % 32, F.lane, nullptr); continue; } r -= 32 * I_W1E;
        { const int e = r / I_W2E, q = r % I_W2E; transpose_item<MapIdent, MOE_FP8 != 0>(F.a->in[24] + (size_t)e * 1024 * 1024, 1024, 1024, (bf16_t*)(F.ws + WS_W2 + (size_t)e * 1024 * MOE_RB), MapIdent(), scr, q / 16, q % 16, F.lane, nullptr); }
    }
}

__device__ __forceinline__ void ph_ln1(Frame& F) {
    const float* x = F.a->in[0]; const float* MOD = (const float*)(F.ws + WS_MOD); bf16_t* U = (bf16_t*)(F.outb + OUT_U);
    const int gw = F.bid * NWAVES + F.wave, NGW = F.G * NWAVES;
    constexpr int RB = 4;
    for (int m0 = gw; m0 < NTOK; m0 += NGW * RB) {
        f32x4 v[RB][4];
#pragma unroll
        for (int r = 0; r < RB; ++r) { const f32x4* xr = (const f32x4*)(x + (size_t)(m0 + r * NGW) * D) + F.lane;
#pragma unroll
            for (int j = 0; j < 4; ++j) v[r][j] = xr[64 * j]; }
#pragma unroll
        for (int r = 0; r < RB; ++r) { const int m = m0 + r * NGW; const float* md = MOD + (size_t)(m >> 11) * 6144;
            float s = 0.f;
#pragma unroll
            for (int j = 0; j < 4; ++j) s += (v[r][j][0] + v[r][j][1]) + (v[r][j][2] + v[r][j][3]);
            const float mean = wave_sum(s) * (1.f / D); float s2 = 0.f;
#pragma unroll
            for (int j = 0; j < 4; ++j) { v[r][j] = v[r][j] - mean; s2 += (v[r][j][0] * v[r][j][0] + v[r][j][1] * v[r][j][1]) + (v[r][j][2] * v[r][j][2] + v[r][j][3] * v[r][j][3]); }
            const float rstd = 1.f / sqrtf(wave_sum(s2) * (1.f / D) + LN_EPS);
            u32x2* o8 = (u32x2*)(U + (size_t)m * D) + F.lane;
#pragma unroll
            for (int j = 0; j < 4; ++j) { const f32x4 sh = *((const f32x4*)md + F.lane + 64 * j), sc = *((const f32x4*)(md + 1024) + F.lane + 64 * j);
                const f32x4 rr = v[r][j] * rstd * (sc + 1.0f) + sh; u32x2 w; w.x = cvt_pk_bf16(rr[0], rr[1]); w.y = cvt_pk_bf16(rr[2], rr[3]); o8[64 * j] = w;
                if (PROJ_FP8) { int pk = 0; pk = __builtin_amdgcn_cvt_pk_fp8_f32(rr[0], rr[1], pk, false); pk = __builtin_amdgcn_cvt_pk_fp8_f32(rr[2], rr[3], pk, true); ((unsigned*)(F.ws + WS_U8 + (size_t)m * D))[F.lane + 64 * j] = (unsigned)pk; } } }
    }
}

__device__ __forceinline__ void ph_misc(Frame& F) {
    const float* MISC = (const float*)(F.outb + OUT_MISC);
    bf16_t* KV = (bf16_t*)(F.outb + OUT_KV); bf16_t* IK = (bf16_t*)(F.outb + OUT_IK); float* IW = (float*)(F.outb + OUT_IW); float* DT = (float*)(F.outb + OUT_DT);
    const float* kvw = F.a->in[5]; const float* ikw = F.a->in[6]; const float* ikb = F.a->in[7]; const float* dtb = F.a->in[11];
    const int gw = F.bid * NWAVES + F.wave, NGW = F.G * NWAVES, l = F.lane;
    for (int m0 = gw; m0 < NTOK; m0 += NGW * 4) {
      f32x4 vv[4];
#pragma unroll
      for (int r = 0; r < 4; ++r) vv[r] = *((const f32x4*)(MISC + (size_t)(m0 + r * NGW) * 256) + l);
#pragma unroll
      for (int r = 0; r < 4; ++r) { const int m = m0 + r * NGW;
        const f32x4 v = vv[r];
        const float sq = v[0] * v[0] + v[1] * v[1] + v[2] * v[2] + v[3] * v[3], sm = (v[0] + v[1]) + (v[2] + v[3]);
        const float kvss = wave_sum(l < 32 ? sq : 0.f);
        const float iks = wave_sum((l >= 32 && l < 48) ? sm : 0.f);
        const float ikmean = iks * (1.f / 64.f);
        const f32x4 dv = v - ikmean;
        const float ikq = wave_sum((l >= 32 && l < 48) ? (dv[0] * dv[0] + dv[1] * dv[1] + dv[2] * dv[2] + dv[3] * dv[3]) : 0.f);
        if (l < 32) { const float r = 1.f / sqrtf(kvss * (1.f / 128.f) + LN_EPS); const f32x4 w = *((const f32x4*)kvw + l); const f32x4 o = v * r * w;
            u32x2 pk; pk.x = cvt_pk_bf16(o[0], o[1]); pk.y = cvt_pk_bf16(o[2], o[3]); *((u32x2*)(KV + (size_t)m * 128) + l) = pk; }
        else if (l < 48) { const float r = 1.f / sqrtf(ikq * (1.f / 64.f) + LN_EPS); const f32x4 w = *((const f32x4*)ikw + (l - 32)), bb = *((const f32x4*)ikb + (l - 32)); const f32x4 o = dv * r * w + bb;
            u32x2 pk; pk.x = cvt_pk_bf16(o[0], o[1]); pk.y = cvt_pk_bf16(o[2], o[3]); *((u32x2*)(IK + (size_t)m * 64) + (l - 32)) = pk; }
        else if (l < 50) { *((f32x4*)(IW + (size_t)m * 8) + (l - 48)) = v * 0.35355339059327373f; }
        else if (l < 54) { const f32x4 bb = *((const f32x4*)dtb + (l - 50)); f32x4 o;
#pragma unroll
            for (int j = 0; j < 4; ++j) { const float t = v[j] + bb[j]; o[j] = t > 20.f ? t : log1pf(__expf(t)); }
            *((f32x4*)(DT + (size_t)m * 16) + (l - 50)) = o; }
      }
    }
}

__device__ __forceinline__ unsigned sortable_key(float s) { const unsigned u = __float_as_uint(s + 0.0f); return (u & 0x80000000u) ? ~u : (u | 0x80000000u); }
template <int NKB> struct KeyRow { unsigned k[NKB]; };
__device__ __forceinline__ u64 low_bits_keep(u64 m, int t) { u64 out = 0; while (t-- > 0 && m) { const u64 b = m & (0 - m); out |= b; m ^= b; } return out; }
namespace idx { constexpr int KST = 144, KBUF = 64 * KST; }
__device__ __forceinline__ unsigned low_bits_keep32(unsigned m, int t) { unsigned out = 0; while (t-- > 0 && m) { const unsigned b = m & (0u - m); out |= b; m ^= b; } return out; }
template <int NG> __device__ __forceinline__ void topk2_select_write(const unsigned (&key)[64], int nkb, u64* mrow, int lane) {
    constexpr int NR = NG * 16;
    unsigned T0 = 0u, T1 = 0u; bool ex0 = false, ex1 = false;
    unsigned lo0 = 0u, lo1 = 0u, hi0 = 0xFFFFFFFFu, hi1 = 0xFFFFFFFFu, st0, st1, p0, p1; bool fin0 = false, fin1 = false;
    { float sm = 0.f, sq = 0.f;
#pragma unroll
        for (int m = 0; m < 10; ++m) { const unsigned k = key[m]; const float f = __uint_as_float((k & 0x80000000u) ? (k ^ 0x80000000u) : ~k); sm += f; sq += f * f; }
#pragma unroll
        for (int o = 1; o < 32; o <<= 1) { sm += __shfl_xor(sm, o); sq += __shfl_xor(sq, o); }
        const float mu = sm * (1.f / 320.f), sd = sqrtf(fmaxf(sq * (1.f / 320.f) - mu * mu, 1e-20f));
        const float qq = 256.f / (64.f * (float)nkb), pp = qq < 0.5f ? qq : 1.f - qq, tt = sqrtf(-2.f * __logf(pp));
        float z = tt - (2.515517f + 0.802853f * tt + 0.010328f * tt * tt) / (1.f + 1.432788f * tt + 0.189269f * tt * tt + 0.001308f * tt * tt * tt); if (qq >= 0.5f) z = -z;
        const unsigned pe = sortable_key(mu + z * sd), pd = sortable_key(mu + z * sd + 0.125f * sd);
        unsigned stp = pd - pe; if (stp < 1024u) stp = 1024u;
        p0 = __builtin_amdgcn_readlane((int)pe, 0); p1 = __builtin_amdgcn_readlane((int)pe, 32); st0 = __builtin_amdgcn_readlane((int)stp, 0); st1 = __builtin_amdgcn_readlane((int)stp, 32); }
#pragma nounroll
    for (int it = 0; it < 80; ++it) {
        const unsigned candv = lane < 32 ? p0 : p1;
        unsigned cl = 0u;
#pragma unroll
        for (int m = 0; m < NR; ++m) cl += (key[m] >= candv) ? 1u : 0u;
        cl += __shfl_xor(cl, 1); cl += __shfl_xor(cl, 2); cl += __shfl_xor(cl, 4); cl += __shfl_xor(cl, 8); cl += __shfl_xor(cl, 16);
        const int n0 = __builtin_amdgcn_readlane((int)cl, 0), n1 = __builtin_amdgcn_readlane((int)cl, 32);
#define IDX_STEP(lo, hi, st, p, T, ex, fin, n) do { if (!fin) { \
            if (n == 256) { T = p; ex = true; fin = true; } \
            else { if (n > 256) lo = p; else hi = p; \
                if (hi - lo <= 1u) { T = lo; fin = true; } \
                else { unsigned c; if (hi == 0xFFFFFFFFu) { c = lo + st; if (c < lo) c = hi; st = st << 1; } else if (lo == 0u) { c = hi - st; if (c > hi) c = lo; st = st << 1; } else c = lo + ((hi - lo) >> 1); \
                    if (c <= lo || c >= hi) c = lo + ((hi - lo) >> 1); p = c; } } } } while (0)
        IDX_STEP(lo0, hi0, st0, p0, T0, ex0, fin0, n0);
        IDX_STEP(lo1, hi1, st1, p1, T1, ex1, fin1, n1);
#undef IDX_STEP
        if (fin0 && fin1) break;
    }
    const unsigned Tv = lane < 32 ? T0 : T1;
    if (ex0 && ex1) {
        unsigned mlo = 0u, mhi = 0u;
#pragma unroll
        for (int j = 0; j < NR / 2; ++j) {
            const u64 b0 = __ballot(key[2 * j] >= Tv), b1 = __ballot(key[2 * j + 1] >= Tv);
            asm volatile("s_nop 1\n\tv_writelane_b32 %0, %2, %6\n\tv_writelane_b32 %0, %3, %7\n\tv_writelane_b32 %1, %4, %6\n\tv_writelane_b32 %1, %5, %7"
                         : "+v"(mlo), "+v"(mhi) : "s"((unsigned)b0), "s"((unsigned)(b0 >> 32)), "s"((unsigned)b1), "s"((unsigned)(b1 >> 32)), "n"(j), "n"(32 + j));
            if ((j & 3) == 3) SBAR();
        }
        const int jl = lane & 31;
        if (jl < nkb) mrow[(lane >> 5) * 32 + jl] = (u64)mlo | ((u64)mhi << 32);
        return;
    }
    int rem0 = 1 << 30, rem1 = 1 << 30;
    { int g0 = 0, g1 = 0;
#pragma unroll
        for (int m = 0; m < NR; ++m) { const u64 mk = __ballot(key[m] > Tv); g0 += __builtin_popcount((unsigned)mk); g1 += __builtin_popcount((unsigned)(mk >> 32)); if ((m & 7) == 7) SBAR(); }
        if (!ex0) rem0 = 256 - g0; if (!ex1) rem1 = 256 - g1; }
    u64 mine = 0ull;
#pragma nounroll
    for (int jq = 0; jq < NR / 8; ++jq) {
#pragma unroll
        for (int jj = 0; jj < 4; ++jj) { const int j = jq * 4 + jj;
            unsigned w0[2], w1[2];
#pragma unroll
            for (int hh = 0; hh < 2; ++hh) { unsigned kv = 0u;
#pragma unroll
                for (int m = 0; m < NR; ++m) if ((m >> 3) == 0) {}
#pragma unroll
                for (int m = 0; m < NR; ++m) kv = (m == 2 * j + hh) ? key[m] : kv;
                const u64 gt = __ballot(kv > Tv), eq = __ballot(kv == Tv);
                { const unsigned e = (unsigned)eq, g = (unsigned)gt; const int ne = __builtin_popcount(e); unsigned sel = g; if (rem0 >= ne) { sel |= e; rem0 -= ne; } else if (rem0 > 0) { sel |= low_bits_keep32(e, rem0); rem0 = 0; } w0[hh] = sel; }
                { const unsigned e = (unsigned)(eq >> 32), g = (unsigned)(gt >> 32); const int ne = __builtin_popcount(e); unsigned sel = g; if (rem1 >= ne) { sel |= e; rem1 -= ne; } else if (rem1 > 0) { sel |= low_bits_keep32(e, rem1); rem1 = 0; } w1[hh] = sel; } }
            const u64 q0w = (u64)w0[0] | ((u64)w0[1] << 32), q1w = (u64)w1[0] | ((u64)w1[1] << 32);
            if (lane == j) mine = q0w; if (lane == 32 + j) mine = q1w; }
    }
    const int jl = lane & 31;
    if (jl < nkb) mrow[(lane >> 5) * 32 + jl] = mine;
}
template <int J0> __device__ __forceinline__ void index_scores8(unsigned (&key)[64], const bf16x8 (&af)[2], const f32x4& iw4, const bf16_t* kvsrc, char* lds, int nkb, u32x4 (&stg)[8], int tid) {
    const int lane = tid & 63, sub = lane & 15, kg = lane >> 4;
#pragma unroll
    for (int jj = 0; jj < 8; ++jj) {
        const int j = J0 + jj;
        if (j < nkb) {
            if (j + 1 < nkb) *(u32x4*)(lds + ((j + 1) & 1) * idx::KBUF + (tid >> 3) * idx::KST + (tid & 7) * 16) = stg[(jj + 1) & 7];
            if (j + 8 < nkb) stg[jj] = *(const u32x4*)(kvsrc + (size_t)(j + 8) * 64 * 64);
            const char* kb = lds + (j & 1) * idx::KBUF + sub * idx::KST + kg * 16;
#pragma unroll
            for (int pr = 0; pr < 2; ++pr) {
                f32x4 dA = (f32x4){0.f, 0.f, 0.f, 0.f}, dB = dA;
#pragma unroll
                for (int ks = 0; ks < 2; ++ks) {
                    const bf16x8 fA = *(const bf16x8*)(kb + (pr * 32) * idx::KST + ks * 64), fB = *(const bf16x8*)(kb + (pr * 32 + 16) * idx::KST + ks * 64);
                    dA = __builtin_amdgcn_mfma_f32_16x16x32_bf16(af[ks], fA, dA, 0, 0, 0); dB = __builtin_amdgcn_mfma_f32_16x16x32_bf16(af[ks], fB, dB, 0, 0, 0); }
                float pA = 0.f, pB = 0.f;
#pragma unroll
                for (int r = 0; r < 4; ++r) { pA += fmaxf(dA[r], 0.f) * iw4[r]; pB += fmaxf(dB[r], 0.f) * iw4[r]; }
                auto rr = __builtin_amdgcn_permlane16_swap(__float_as_uint(pA), __float_as_uint(pB), false, false);
                key[2 * j + pr] = sortable_key(__uint_as_float(rr[0]) + __uint_as_float(rr[1]));
            }
            __syncthreads();
        }
    }
}
__device__ __forceinline__ void ph_index(Frame& F) {
    const bf16_t* IQ = (const bf16_t*)(F.outb + OUT_IQ); const bf16_t* IK = (const bf16_t*)(F.outb + OUT_IK); const float* IW = (const float*)(F.outb + OUT_IW);
    u64* MASK = (u64*)(F.outb + OUT_MASK);
    char* lds = (char*)(unsigned char*)F.lds;
    const int tid = F.tid, lane = F.lane, sub = lane & 15, kg = lane >> 4;
    for (int item = F.bid; item < NTOK / 16; item += F.G) {
        const int tokw = (((item & 255) >> 3) << 11) + (((item & 7) + 8 * (item >> 8)) << 4) + F.wave * 2, b = tokw >> 11, pos0 = tokw & 2047, nkb = (pos0 >> 6) + 1;
        u64* mrow = MASK + (size_t)tokw * 32;
        if (nkb <= 4) { if ((lane & 31) < nkb) mrow[(lane >> 5) * 32 + (lane & 31)] = ~0ull; continue; }
        bf16x8 af[2];
        { const bf16_t* ap = IQ + (size_t)(tokw + (sub >> 3)) * 512 + (sub & 7) * 64 + kg * 8;
#pragma unroll
          for (int ks = 0; ks < 2; ++ks) af[ks] = *(const bf16x8*)(ap + ks * 32); }
        const f32x4 iw4 = *(const f32x4*)(IW + (size_t)(tokw + (lane >> 5)) * 8 + 4 * (kg & 1));
        unsigned key[64];
#pragma unroll
        for (int m = 0; m < 64; ++m) key[m] = 0u;
        const bf16_t* kvsrc = IK + ((size_t)b * SEQ + (tid >> 3)) * 64 + (tid & 7) * 8;
        u32x4 stg[8];
#pragma unroll
        for (int i = 0; i < 8; ++i) stg[i] = (i < nkb) ? *(const u32x4*)(kvsrc + (size_t)i * 64 * 64) : (u32x4){0u, 0u, 0u, 0u};
        __syncthreads();
        *(u32x4*)(lds + (tid >> 3) * idx::KST + (tid & 7) * 16) = stg[0];
        __syncthreads();
        const int ng = (nkb + 7) >> 3;
        index_scores8<0>(key, af, iw4, kvsrc, lds, nkb, stg, tid);
        if (ng > 1) index_scores8<8>(key, af, iw4, kvsrc, lds, nkb, stg, tid);
        if (ng > 2) index_scores8<16>(key, af, iw4, kvsrc, lds, nkb, stg, tid);
        if (ng > 3) index_scores8<24>(key, af, iw4, kvsrc, lds, nkb, stg, tid);
        if (ng == 1) topk2_select_write<1>(key, nkb, mrow, lane);
        else if (ng == 2) topk2_select_write<2>(key, nkb, mrow, lane);
        else if (ng == 3) topk2_select_write<3>(key, nkb, mrow, lane);
        else topk2_select_write<4>(key, nkb, mrow, lane);
    }
}

namespace att {
constexpr int KVBLK = 64;
constexpr int SHM_V = KVBLK * 128 * 2, SHM_K = SHM_V;
constexpr int OFF_V = 0, OFF_K = 2 * SHM_V, OFF_WS = 2 * SHM_V + 2 * SHM_K, OFF_BT = OFF_WS + NWAVES * 64 * 4;
#define KSWZ(row, colB) ((row) * 256 + ((colB) ^ (((row) & 7) << 4)))
__device__ __forceinline__ int crow(int r, int hi) { return (r & 3) + 8 * (r >> 2) + 4 * hi; }
__device__ __forceinline__ int v_st(int k, int c) { const int kk = (k & ~0xC) | ((k & 4) << 1) | ((k & 8) >> 1); return ((kk >> 3) * 4 + (c >> 5)) * 512 + ((kk & 7) * 32 + (c & 31)) * 2; }
__device__ __forceinline__ int v_rd_base(int lane) { return ((lane & 3) << 3) | (((lane >> 2) & 3) << 6) | (((lane >> 4) & 1) << 5) | (((lane >> 5) & 1) << 8); }
constexpr int v_rd_off(int d0, int ks, int half) { return d0 * 512 + ks * 4096 + half * 2048; }
template <int OFF> __device__ __forceinline__ s16x4 tr_read(int vb) { s16x4 r; asm volatile("ds_read_b64_tr_b16 %0, %1 offset:%2" : "=&v"(r) : "v"(vb), "i"(OFF) : "memory"); return r; }
template <int D0> __device__ __forceinline__ void pv_one(f32x16& od, int vb, bf16x8 pa0, bf16x8 pa1, bf16x8 pa2, bf16x8 pa3) {
    const s16x4 l0 = tr_read<v_rd_off(D0, 0, 0)>(vb), h0 = tr_read<v_rd_off(D0, 0, 1)>(vb), l1 = tr_read<v_rd_off(D0, 1, 0)>(vb), h1 = tr_read<v_rd_off(D0, 1, 1)>(vb);
    const s16x4 l2 = tr_read<v_rd_off(D0, 2, 0)>(vb), h2 = tr_read<v_rd_off(D0, 2, 1)>(vb), l3 = tr_read<v_rd_off(D0, 3, 0)>(vb), h3 = tr_read<v_rd_off(D0, 3, 1)>(vb);
    asm volatile("s_waitcnt lgkmcnt(0)" ::: "memory"); SBAR();
#define PK(L, H) (bf16x8){L[0], L[1], L[2], L[3], H[0], H[1], H[2], H[3]}
    od = __builtin_amdgcn_mfma_f32_32x32x16_bf16(pa0, PK(l0, h0), od, 0, 0, 0);
    od = __builtin_amdgcn_mfma_f32_32x32x16_bf16(pa1, PK(l1, h1), od, 0, 0, 0);
    od = __builtin_amdgcn_mfma_f32_32x32x16_bf16(pa2, PK(l2, h2), od, 0, 0, 0);
    od = __builtin_amdgcn_mfma_f32_32x32x16_bf16(pa3, PK(l3, h3), od, 0, 0, 0);
#undef PK
}
__device__ __forceinline__ void qkt(f32x16& p0, f32x16& p1, const char* Ks, const bf16x8* qr, int r32, int hi) {
    p0 = f32x16{}; p1 = f32x16{};
    int rv = r32; asm volatile("" : "+v"(rv));
    const char* kb = Ks + rv * 256; const int swz = ((rv & 7) << 4) ^ (hi * 16);
#pragma unroll
    for (int d0 = 0; d0 < 8; ++d0) { const char* ka = kb + ((d0 * 32) ^ swz);
        const bf16x8 b0 = *reinterpret_cast<const bf16x8*>(ka);
        const bf16x8 b1 = *reinterpret_cast<const bf16x8*>(ka + 8192);
        p0 = __builtin_amdgcn_mfma_f32_32x32x16_bf16(b0, qr[d0], p0, 0, 0, 0);
        p1 = __builtin_amdgcn_mfma_f32_32x32x16_bf16(b1, qr[d0], p1, 0, 0, 0); }
}
__device__ __forceinline__ void attn_item(Frame& F, int b, int q0, char* lds) {
    const bf16_t* Q = (const bf16_t*)(F.ws + WS_Q); const bf16_t* KV = (const bf16_t*)(F.outb + OUT_KV); const u64* MASK = (const u64*)(F.outb + OUT_MASK);
    bf16_t* OA = (bf16_t*)(F.outb + OUT_OA);
    const int tid = F.tid, wid = F.wave, lane = F.lane, r32 = lane & 31, hi = lane >> 5;
    char* V_lds = lds + OFF_V; char* K_lds = lds + OFF_K;
    float* wsl = (float*)(lds + OFF_WS) + wid * 64; float* li_l = wsl; float* al_l = wsl + 32;
    const float* btab = (const float*)(lds + OFF_BT);
    constexpr float C = 0.088388347648318440f * LOG2E;
    float m_reg = -1e30f, l_reg = 0.f; f32x16 o[4] = {}; bf16x8 qr[8];
    const size_t tokq = (size_t)b * SEQ + q0 + r32;
    { const bf16_t* Qw = Q + tokq * 1024 + wid * 128 + hi * 8;
#pragma unroll
      for (int d0 = 0; d0 < 8; ++d0) qr[d0] = *(const bf16x8*)(Qw + d0 * 16); }
    const u64* mq = MASK + tokq * 32;
    const int sr = tid >> 4, sc = (tid & 15) * 8;
    const int vb0 = (int)(uintptr_t)V_lds + v_rd_base(lane);
    const bf16_t* Kb = KV + (size_t)b * SEQ * 128;
    const int NT = (q0 >> 6) + 1;
    const float bfar = btab[wid];
    bf16x8 s0, s1;
#define SLOAD(k0) do { s0 = *(const bf16x8*)(Kb + (size_t)((k0) + sr) * 128 + sc); s1 = *(const bf16x8*)(Kb + (size_t)((k0) + 32 + sr) * 128 + sc); } while (0)
#define SWRITE(bf) do { int srv = sr; asm volatile("" : "+v"(srv)); const int kc = sc * 2; const int v0a = v_st(srv, sc), k0a = KSWZ(srv, kc); \
        *(bf16x8*)(V_lds + (bf) * SHM_V + v0a) = s0; *(bf16x8*)(V_lds + (bf) * SHM_V + v0a + 8192) = s1; \
        *(bf16x8*)(K_lds + (bf) * SHM_K + k0a) = s0; *(bf16x8*)(K_lds + (bf) * SHM_K + k0a + 8192) = s1; } while (0)
    __syncthreads();
    SLOAD(0); VM_WAIT(); SWRITE(0); __syncthreads();
    u64 mw_next = mq[0];
    for (int j = 0; j < NT; ++j) {
        const int bf = j & 1;
        if (j + 1 < NT) SLOAD((j + 1) * KVBLK);
        const u64 mw = mw_next; if (j + 1 < NT) mw_next = mq[j + 1];
        f32x16 p0, p1;
        qkt(p0, p1, K_lds + bf * SHM_K, qr, r32, hi);
        const unsigned w0 = (unsigned)(mw >> (4 * hi)), w1 = (unsigned)(mw >> (32 + 4 * hi));
        const int relmax = j * KVBLK + 63 - q0;
        if (relmax <= -91) {
#pragma unroll
            for (int r = 0; r < 16; ++r) { const int cb = (r & 3) + 8 * (r >> 2);
                const float t0 = fmaf(p0[r], C, bfar), t1 = fmaf(p1[r], C, bfar); p0[r] = ((w0 >> cb) & 1u) ? t0 : -1e30f; p1[r] = ((w1 >> cb) & 1u) ? t1 : -1e30f; }
        } else {
            const float* bp = btab + (j * KVBLK + 4 * hi - (q0 + r32) + 185) * 8 + wid;
#pragma unroll
            for (int r4 = 0; r4 < 4; ++r4) {
#pragma unroll
                for (int rr = 0; rr < 4; ++rr) { const int r = r4 * 4 + rr; const int cb = (r & 3) + 8 * (r >> 2);
                    const float bv0 = bp[cb * 8], bv1 = bp[(cb + 32) * 8]; const float t0 = fmaf(p0[r], C, bv0), t1 = fmaf(p1[r], C, bv1);
                    p0[r] = ((w0 >> cb) & 1u) ? t0 : -1e30f; p1[r] = ((w1 >> cb) & 1u) ? t1 : -1e30f; }
                SBAR(); }
        }
        float pmax = p0[0];
#pragma unroll
        for (int r = 1; r < 16; ++r) pmax = fmaxf(pmax, p0[r]);
#pragma unroll
        for (int r = 0; r < 16; ++r) pmax = fmaxf(pmax, p1[r]);
        { auto rr = __builtin_amdgcn_permlane32_swap(__float_as_uint(pmax), __float_as_uint(pmax), false, false); pmax = fmaxf(__uint_as_float(rr[0]), __uint_as_float(rr[1])); }
        float alpha = 1.f;
        if (!__all(pmax - m_reg <= 11.0f)) { const float mn = fmaxf(m_reg, pmax); alpha = __builtin_amdgcn_exp2f(m_reg - mn); m_reg = mn; }
        float ps = 0.f;
#pragma unroll
        for (int r = 0; r < 16; ++r) { p0[r] = __builtin_amdgcn_exp2f(p0[r] - m_reg); p1[r] = __builtin_amdgcn_exp2f(p1[r] - m_reg); ps += p0[r] + p1[r]; }
        { auto rr = __builtin_amdgcn_permlane32_swap(__float_as_uint(ps), __float_as_uint(ps), false, false); ps = __uint_as_float(rr[0]) + __uint_as_float(rr[1]); }
        l_reg = l_reg * alpha + ps;
        bf16x8 pa0, pa1, pa2, pa3;
#define PK4(P, BASE, OUT) do { unsigned a0 = cvt_pk_bf16(P[BASE + 0], P[BASE + 1]), a1 = cvt_pk_bf16(P[BASE + 2], P[BASE + 3]);   \
    unsigned b0 = cvt_pk_bf16(P[BASE + 4], P[BASE + 5]), b1 = cvt_pk_bf16(P[BASE + 6], P[BASE + 7]);                              \
    auto r0 = __builtin_amdgcn_permlane32_swap(a0, b0, false, false); auto r1 = __builtin_amdgcn_permlane32_swap(a1, b1, false, false); \
    u32x4 w = {r0[0], r1[0], r0[1], r1[1]}; OUT = *reinterpret_cast<bf16x8*>(&w); } while (0)
        PK4(p0, 0, pa0); PK4(p0, 8, pa1); PK4(p1, 0, pa2); PK4(p1, 8, pa3);
#undef PK4
        if (__any(alpha < 1.f)) { if (hi == 0) al_l[r32] = alpha; LDS_WAIT();
#pragma unroll
            for (int d = 0; d < 4; ++d)
#pragma unroll
                for (int r = 0; r < 16; ++r) o[d][r] *= al_l[crow(r, hi)]; }
        const int vb = vb0 + bf * SHM_V;
        pv_one<0>(o[0], vb, pa0, pa1, pa2, pa3); pv_one<1>(o[1], vb, pa0, pa1, pa2, pa3); pv_one<2>(o[2], vb, pa0, pa1, pa2, pa3); pv_one<3>(o[3], vb, pa0, pa1, pa2, pa3);
        if (j + 1 < NT) { VM_WAIT(); SWRITE(bf ^ 1); }
        __syncthreads();
    }
#undef SLOAD
#undef SWRITE
    if (hi == 0) li_l[r32] = l_reg; LDS_WAIT();
    bf16_t* Ow = OA + ((size_t)b * SEQ + q0 + 4 * hi) * 1024 + wid * 128 + r32;
    const float* lip = li_l + 4 * hi;
    unsigned char* Ow8 = (unsigned char*)OA + ((size_t)b * SEQ + q0 + 4 * hi) * 1024 + wid * 128 + r32;
    asm volatile("" : "+v"(Ow), "+v"(lip), "+v"(Ow8));
#pragma unroll
    for (int r = 0; r < 16; ++r) { const int ro = (r & 3) + 8 * (r >> 2); const float rl = fast_rcp(lip[ro]);
#pragma unroll
        for (int d0 = 0; d0 < 4; ++d0) { float v = o[d0][r] * rl; if ((DBG_ATTN_ZERO == 1 && q0 < 256) || (DBG_ATTN_ZERO == 2 && q0 >= 256)) v = 0.f;
            if (PA_FP8) ((unsigned char*)Ow8)[ro * 1024 + d0 * 32] = (unsigned char)(__builtin_amdgcn_cvt_pk_fp8_f32(v, v, 0, false) & 0xff);
            else Ow[ro * 1024 + d0 * 32] = (bf16_t)(cvt_pk_bf16(v, v) & 0xffffu); }
        if ((r & 3) == 3) SBAR(); }
}
}
__device__ __forceinline__ void ph_attn(Frame& F) {
    char* lds = (char*)(unsigned char*)F.lds;
    { float* bt = (float*)(lds + att::OFF_BT); const float* BT = (const float*)(F.ws + WS_BIAST); __syncthreads(); for (int i = F.tid; i < 249 * 8; i += NTHR) bt[i] = BT[i]; __syncthreads(); }
    for (int pr = F.bid; pr < NB * 32; pr += F.G) {
        const int b = pr >> 5, qb = pr & 31;
#pragma nounroll
        for (int hh = 0; hh < 2; ++hh) att::attn_item(F, b, (hh ? qb : 63 - qb) * 32, lds);
    }
}

namespace ssd {
constexpr int OFF_CS = 0, CS_ST = 272;
constexpr int OFF_BS = OFF_CS + 64 * CS_ST;
constexpr int OFF_BT = OFF_BS + 64 * CS_ST, T_ST = 144;
constexpr int OFF_XT = OFF_BT + 128 * T_ST;
constexpr int OFF_XW = OFF_XT + 64 * T_ST;
constexpr int OFF_XS = OFF_XW + 64 * T_ST;
constexpr int OFF_MT = OFF_XS + 64 * T_ST;
constexpr int OFF_HS = OFF_MT + 64 * T_ST;
constexpr int OFF_END = OFF_HS + 64 * CS_ST;
static_assert(OFF_END + 5 * 320 * 4 <= 131072, "ssd lds");
__device__ __forceinline__ f32x4 mfma16(bf16x8 a, bf16x8 b, f32x4 c) { return __builtin_amdgcn_mfma_f32_16x16x32_bf16(a, b, c, 0, 0, 0); }
__device__ __forceinline__ bf16x8 ldfrag(const char* base, int stride, int row, int k0) { return *(const bf16x8*)(base + row * stride + k0 * 2); }
}
__device__ __forceinline__ void ph_ssd(Frame& F) {
    using namespace ssd;
    char* lds = (char*)(unsigned char*)F.lds;
    const bf16_t* XBC = (const bf16_t*)(F.ws + WS_XBC); const bf16_t* ZS = (const bf16_t*)(F.ws + WS_Z); const float* DT = (const float*)(F.outb + OUT_DT);
    bf16_t* YG = (bf16_t*)(F.ws + WS_Q);
    const float* conv_w = F.a->in[9]; const float* conv_b = F.a->in[10]; const float* a_log = F.a->in[12]; const float* d_skip = F.a->in[13];
    const int tid = F.tid, wid = F.wave, lane = F.lane, fr = lane & 15, fq = lane >> 4;
    const bool stager = tid < 320; const int so = tid % 40, tg = tid / 40;
    for (int item = F.bid; item < NB * 16; item += F.G) {
        const int b = item >> 4, h = item & 15, g = h >> 2;
        const float aneg = -__expf(a_log[h]), dsk = d_skip[h];
        const int ch0 = so < 8 ? h * 64 + so * 8 : (so < 24 ? 1024 + g * 128 + (so - 8) * 8 : 1536 + g * 128 + (so - 24) * 8);
        float* CWL = (float*)(lds + OFF_END);
        __syncthreads();
        if (stager) {
#pragma unroll
            for (int j = 0; j < 4; ++j) { *(f32x4*)(CWL + j * 320 + so * 8) = *(const f32x4*)(conv_w + (size_t)j * 2048 + ch0); *(f32x4*)(CWL + j * 320 + so * 8 + 4) = *(const f32x4*)(conv_w + (size_t)j * 2048 + ch0 + 4); }
            *(f32x4*)(CWL + 4 * 320 + so * 8) = *(const f32x4*)(conv_b + ch0); *(f32x4*)(CWL + 4 * 320 + so * 8 + 4) = *(const f32x4*)(conv_b + ch0 + 4);
        }
        f32x4 hst[4];
#pragma unroll
        for (int t = 0; t < 4; ++t) hst[t] = (f32x4){0.f, 0.f, 0.f, 0.f};
        __syncthreads();
        for (int i = tid; i < 64 * CS_ST / 4; i += NTHR) ((unsigned*)(lds + OFF_HS))[i] = 0u;
        u32x4 raw[11];
        const size_t tokb = (size_t)b * SEQ;
#define SSD_LOAD(c) do { if (stager) { _Pragma("unroll") for (int i = 0; i < 11; ++i) { const int t = (c) * 64 + tg * 8 - 3 + i; \
            raw[i] = (t >= 0) ? *(const u32x4*)(XBC + (tokb + t) * 2048 + ch0) : (u32x4){0u, 0u, 0u, 0u}; } } } while (0)
        SSD_LOAD(0);
        float dtl_next = DT[(tokb + lane) * 16 + h];
        for (int c = 0; c < 32; ++c) {
            const float dtl = dtl_next; if (c + 1 < 32) dtl_next = DT[(tokb + (c + 1) * 64 + lane) * 16 + h];
            u32x2 zpre[2];
#pragma unroll
            for (int t2 = 0; t2 < 2; ++t2) { const int tile = 2 * wid + t2, pb = tile >> 2, lb = tile & 3; zpre[t2] = *(const u32x2*)(ZS + (tokb + c * 64 + lb * 16 + fr) * 1024 + h * 64 + pb * 16 + 4 * fq); }
            float acs = dtl * aneg;
#pragma unroll
            for (int o = 1; o < 64; o <<= 1) { const float t = __shfl_up(acs, o); if (lane >= o) acs += t; }
            const float alast = __shfl(acs, 63);
            if (DBG_SSD_SYNC) __syncthreads();
            float dtv[8], dec[8];
#pragma unroll
            for (int t = 0; t < 8; ++t) { dtv[t] = __shfl(dtl, (tg * 8 + t) & 63); dec[t] = __expf(alast - __shfl(acs, (tg * 8 + t) & 63)); }
            if (stager) {
#pragma unroll
                for (int hq = 0; hq < 2; ++hq) {
                    float xin[11][4];
#pragma unroll
                    for (int i = 0; i < 11; ++i) { const unsigned wa = hq ? raw[i].z : raw[i].x, wb = hq ? raw[i].w : raw[i].y; xin[i][0] = bflo(wa); xin[i][1] = bfhi(wa); xin[i][2] = bflo(wb); xin[i][3] = bfhi(wb); }
                    float outv[8][4];
                    { f32x4 cwv[4]; const f32x4 cbq = *(const f32x4*)(CWL + 4 * 320 + so * 8 + hq * 4);
#pragma unroll
                      for (int j = 0; j < 4; ++j) cwv[j] = *(const f32x4*)(CWL + j * 320 + so * 8 + hq * 4);
#pragma unroll
                      for (int t = 0; t < 8; ++t)
#pragma unroll
                        for (int e = 0; e < 4; ++e) { float sacc = cbq[e];
#pragma unroll
                            for (int j = 0; j < 4; ++j) sacc += cwv[j][e] * xin[t + j][e];
                            outv[t][e] = silu_f(sacc); } }
                    if (so < 8) {
#pragma unroll
                        for (int e = 0; e < 4; ++e) { const int p = so * 8 + hq * 4 + e;
                            f32x4 x0, x1, d0, d1, w0, w1;
#pragma unroll
                            for (int t = 0; t < 4; ++t) { x0[t] = outv[t][e]; x1[t] = outv[4 + t][e]; d0[t] = x0[t] * dtv[t]; d1[t] = x1[t] * dtv[4 + t]; w0[t] = d0[t] * dec[t]; w1[t] = d1[t] * dec[4 + t]; }
                            *(u32x4*)(lds + OFF_XS + p * T_ST + tg * 16) = pack8(x0, x1);
                            *(u32x4*)(lds + OFF_XT + p * T_ST + tg * 16) = pack8(d0, d1);
                            *(u32x4*)(lds + OFF_XW + p * T_ST + tg * 16) = pack8(w0, w1); }
                    } else {
                        const bool isB = so < 24; const int n0 = (isB ? (so - 8) : (so - 24)) * 8 + hq * 4;
                        char* nat = lds + (isB ? OFF_BS : OFF_CS);
#pragma unroll
                        for (int t = 0; t < 8; ++t) { u32x2 w; w.x = cvt_pk_bf16(outv[t][0], outv[t][1]); w.y = cvt_pk_bf16(outv[t][2], outv[t][3]);
                            *(u32x2*)(nat + (tg * 8 + t) * CS_ST + n0 * 2) = w; }
                        if (isB) {
#pragma unroll
                            for (int e = 0; e < 4; ++e) { f32x4 a, bq;
#pragma unroll
                                for (int t = 0; t < 4; ++t) { a[t] = outv[t][e]; bq[t] = outv[4 + t][e]; }
                                *(u32x4*)(lds + OFF_BT + (n0 + e) * T_ST + tg * 16) = pack8(a, bq); }
                        }
                    }
                }
            }
            if (c + 1 < 32) SSD_LOAD(c + 1);
            __syncthreads();
#pragma unroll
            for (int t2 = 0; t2 < 2; ++t2) {
                const int tile = 2 * wid + t2, sb = tile >> 2, lb = tile & 3;
                f32x4 d = (f32x4){0.f, 0.f, 0.f, 0.f};
                if (sb <= lb) {
#pragma unroll
                    for (int ks = 0; ks < 4; ++ks) d = mfma16(ldfrag(lds + OFF_BS, CS_ST, sb * 16 + fr, ks * 32 + fq * 8), ldfrag(lds + OFF_CS, CS_ST, lb * 16 + fr, ks * 32 + fq * 8), d);
                    const int l = lb * 16 + fr; const float al = __shfl(acs, l);
                    f32x4 as;
#pragma unroll
                    for (int r = 0; r < 4; ++r) as[r] = __shfl(acs, sb * 16 + 4 * fq + r);
#pragma unroll
                    for (int r = 0; r < 4; ++r) { const int s = sb * 16 + 4 * fq + r; d[r] = (s <= l) ? d[r] * __expf(al - as[r]) : 0.f; }
                }
                u32x2 w; w.x = cvt_pk_bf16(d[0], d[1]); w.y = cvt_pk_bf16(d[2], d[3]);
                *(u32x2*)(lds + OFF_MT + (lb * 16 + fr) * T_ST + (sb * 16 + 4 * fq) * 2) = w;
            }
            if (DBG_SSD_SYNC) __syncthreads();
            f32x4 yacc[2];
#pragma unroll
            for (int t2 = 0; t2 < 2; ++t2) {
                const int tile = 2 * wid + t2, pb = tile >> 2, lb = tile & 3;
                f32x4 d = (f32x4){0.f, 0.f, 0.f, 0.f};
#pragma unroll
                for (int ks = 0; ks < 4; ++ks) d = mfma16(ldfrag(lds + OFF_HS, CS_ST, pb * 16 + fr, ks * 32 + fq * 8), ldfrag(lds + OFF_CS, CS_ST, lb * 16 + fr, ks * 32 + fq * 8), d);
                const float el = __expf(__shfl(acs, lb * 16 + fr));
                yacc[t2] = d * el;
            }
            __syncthreads();
#pragma unroll
            for (int t2 = 0; t2 < 2; ++t2) {
                const int tile = 2 * wid + t2, pb = tile >> 2, lb = tile & 3;
                f32x4 d = yacc[t2];
#pragma unroll
                for (int ks = 0; ks < 2; ++ks) d = mfma16(ldfrag(lds + OFF_XT, T_ST, pb * 16 + fr, ks * 32 + fq * 8), ldfrag(lds + OFF_MT, T_ST, lb * 16 + fr, ks * 32 + fq * 8), d);
                const int l = lb * 16 + fr, p0 = pb * 16 + 4 * fq; const size_t tok = tokb + c * 64 + l;
                const u32x2 zz = zpre[t2];
                const float z0 = bflo(zz.x), z1 = bfhi(zz.x), z2 = bflo(zz.y), z3 = bfhi(zz.y);
                float xs[4];
#pragma unroll
                for (int r = 0; r < 4; ++r) xs[r] = bflo((unsigned)*(const bf16_t*)(lds + OFF_XS + (p0 + r) * T_ST + l * 2));
                u32x2 w; w.x = cvt_pk_bf16((d[0] + xs[0] * dsk) * z0, (d[1] + xs[1] * dsk) * z1); w.y = cvt_pk_bf16((d[2] + xs[2] * dsk) * z2, (d[3] + xs[3] * dsk) * z3);
                *(u32x2*)(YG + tok * 1024 + h * 64 + p0) = w;
            }
            if (DBG_SSD_SYNC) __syncthreads();
            { const float dc = __expf(alast);
#pragma unroll
              for (int t = 0; t < 4; ++t) { f32x4 d = hst[t] * dc;
#pragma unroll
                  for (int ks = 0; ks < 2; ++ks) d = mfma16(ldfrag(lds + OFF_BT, T_ST, wid * 16 + fr, ks * 32 + fq * 8), ldfrag(lds + OFF_XW, T_ST, t * 16 + fr, ks * 32 + fq * 8), d);
                  hst[t] = d;
                  u32x2 w; w.x = cvt_pk_bf16(d[0], d[1]); w.y = cvt_pk_bf16(d[2], d[3]);
                  *(u32x2*)(lds + OFF_HS + (t * 16 + fr) * CS_ST + (wid * 16 + 4 * fq) * 2) = w; } }
            __syncthreads();
        }
#undef SSD_LOAD
    }
}

namespace ssd2 {
constexpr int CS_ST = 272, T_ST = 144;
constexpr int OFF_CS = 0, OFF_BS = 64 * CS_ST, OFF_BT = 2 * 64 * CS_ST, OFF_H0 = OFF_BT + 128 * T_ST;
constexpr int H_XS = 0, H_XW = 64 * T_ST, H_MT = 2 * 64 * T_ST, H_HS = 3 * 64 * T_ST, H_SZ = H_HS + 64 * CS_ST;
constexpr int OFF_CW = OFF_H0 + 2 * H_SZ;
static_assert(OFF_CW + 5 * 384 * 4 <= LDS_MISC, "ssd2 lds");
}
__device__ __forceinline__ void ph_ssd2(Frame& F) {
    using namespace ssd2; using ssd::mfma16; using ssd::ldfrag;
    char* lds = (char*)(unsigned char*)F.lds;
    const bf16_t* XBC = (const bf16_t*)(F.ws + WS_XBC); const bf16_t* ZS = (const bf16_t*)(F.ws + WS_Z); const float* DT = (const float*)(F.outb + OUT_DT);
    bf16_t* YG = (bf16_t*)(F.ws + WS_Q);
    const float* conv_w = F.a->in[9]; const float* conv_b = F.a->in[10]; const float* a_log = F.a->in[12]; const float* d_skip = F.a->in[13];
    const int tid = F.tid, wid = F.wave, lane = F.lane, fr = lane & 15, fq = lane >> 4;
    const bool stager = tid < 384; const int so = tid % 48, tg = tid / 48, shd = (so >> 3) & 1;
    for (int item = F.bid; item < NB * 8; item += F.G) {
        const int b = item >> 3, g = (item >> 1) & 3, h0 = g * 4 + (item & 1) * 2;
        const float aneg0 = -__expf(a_log[h0]), aneg1 = -__expf(a_log[h0 + 1]), dsk0 = d_skip[h0], dsk1 = d_skip[h0 + 1];
        const int ch0 = so < 16 ? (h0 + shd) * 64 + (so & 7) * 8 : (so < 32 ? 1024 + g * 128 + (so - 16) * 8 : 1536 + g * 128 + (so - 32) * 8);
        float* CWL = (float*)(lds + OFF_CW);
        __syncthreads();
        if (stager) {
#pragma unroll
            for (int j = 0; j < 4; ++j) { *(f32x4*)(CWL + j * 384 + so * 8) = *(const f32x4*)(conv_w + (size_t)j * 2048 + ch0); *(f32x4*)(CWL + j * 384 + so * 8 + 4) = *(const f32x4*)(conv_w + (size_t)j * 2048 + ch0 + 4); }
            *(f32x4*)(CWL + 4 * 384 + so * 8) = *(const f32x4*)(conv_b + ch0); *(f32x4*)(CWL + 4 * 384 + so * 8 + 4) = *(const f32x4*)(conv_b + ch0 + 4);
        }
        f32x4 hst[2][4];
#pragma unroll
        for (int hh = 0; hh < 2; ++hh)
#pragma unroll
            for (int t = 0; t < 4; ++t) hst[hh][t] = (f32x4){0.f, 0.f, 0.f, 0.f};
        for (int i = tid; i < 64 * CS_ST / 4; i += NTHR) { ((unsigned*)(lds + OFF_H0 + H_HS))[i] = 0u; ((unsigned*)(lds + OFF_H0 + H_SZ + H_HS))[i] = 0u; }
        u32x4 raw[11];
        const size_t tokb = (size_t)b * SEQ;
        const bf16_t* xrow = XBC + ((ptrdiff_t)tokb + tg * 8 - 3) * 2048 + ch0;
#define SSD_LOAD(c, xp, tgx) do { if (stager) { _Pragma("unroll") for (int i = 0; i < 11; ++i) { const int t = (c) * 64 + (tgx) * 8 - 3 + i; \
            raw[i] = (t >= 0) ? *(const u32x4*)((xp) + (ptrdiff_t)((c) * 64 + i) * 2048) : (u32x4){0u, 0u, 0u, 0u}; } } } while (0)
        SSD_LOAD(0, xrow, tg);
        f32x2 dtn = *(const f32x2*)(DT + (tokb + lane) * 16 + h0);
        for (int c = 0; c < 32; ++c) {
            int frl = fr, fql = fq, tgl = tg, sol = so; const bf16_t* xrl = xrow; asm volatile("" : "+v"(frl), "+v"(fql), "+v"(tgl), "+v"(sol), "+v"(xrl)); const int shdl = (sol >> 3) & 1;
            const float dtl0 = dtn[0], dtl1 = dtn[1]; if (c + 1 < 32) dtn = *(const f32x2*)(DT + (tokb + (c + 1) * 64 + lane) * 16 + h0);
            u32x2 zpre[2][2];
#pragma unroll
            for (int hh = 0; hh < 2; ++hh)
#pragma unroll
                for (int t2 = 0; t2 < 2; ++t2) { const int tile = 2 * wid + t2, pb = tile >> 2, lb = tile & 3; zpre[hh][t2] = *(const u32x2*)(ZS + (tokb + c * 64 + lb * 16 + frl) * 1024 + (h0 + hh) * 64 + pb * 16 + 4 * fql); }
            float acs0 = dtl0 * aneg0, acs1 = dtl1 * aneg1;
#pragma unroll
            for (int o = 1; o < 64; o <<= 1) { const float t0 = __shfl_up(acs0, o), t1 = __shfl_up(acs1, o); if (lane >= o) { acs0 += t0; acs1 += t1; } }
            const float alast0 = __shfl(acs0, 63), alast1 = __shfl(acs1, 63);
            float wdt[8];
#pragma unroll
            for (int t = 0; t < 8; ++t) { const int sl = (tgl * 8 + t) & 63; const float d0 = __shfl(dtl0, sl), d1 = __shfl(dtl1, sl), a0 = __shfl(acs0, sl), a1 = __shfl(acs1, sl);
                wdt[t] = (shdl ? d1 : d0) * __expf(shdl ? alast1 - a1 : alast0 - a0); }
            if (stager) {
#pragma unroll
                for (int cp = 0; cp < 4; ++cp) {
                    float xin[11][2];
#pragma unroll
                    for (int i = 0; i < 11; ++i) { const unsigned wa = cp == 0 ? raw[i].x : (cp == 1 ? raw[i].y : (cp == 2 ? raw[i].z : raw[i].w)); xin[i][0] = bflo(wa); xin[i][1] = bfhi(wa); }
                    float outv[8][2];
                    { f32x2 cwv[4]; const f32x2 cbq = *(const f32x2*)(CWL + 4 * 384 + sol * 8 + cp * 2);
#pragma unroll
                      for (int j = 0; j < 4; ++j) cwv[j] = *(const f32x2*)(CWL + j * 384 + sol * 8 + cp * 2);
#pragma unroll
                      for (int t = 0; t < 8; ++t)
#pragma unroll
                        for (int e = 0; e < 2; ++e) { float sacc = cbq[e];
#pragma unroll
                            for (int j = 0; j < 4; ++j) sacc += cwv[j][e] * xin[t + j][e];
                            outv[t][e] = silu_f(sacc); } }
                    if (sol < 16) {
                        char* hb = lds + OFF_H0 + shdl * H_SZ;
#pragma unroll
                        for (int e = 0; e < 2; ++e) { const int p = (sol & 7) * 8 + cp * 2 + e;
                            f32x4 x0, x1, w0, w1;
#pragma unroll
                            for (int t = 0; t < 4; ++t) { x0[t] = outv[t][e]; x1[t] = outv[4 + t][e]; w0[t] = x0[t] * wdt[t]; w1[t] = x1[t] * wdt[4 + t]; }
                            *(u32x4*)(hb + H_XS + p * T_ST + tgl * 16) = pack8(x0, x1);
                            *(u32x4*)(hb + H_XW + p * T_ST + tgl * 16) = pack8(w0, w1); }
                    } else {
                        const bool isB = sol < 32; const int n0 = (isB ? (sol - 16) : (sol - 32)) * 8 + cp * 2;
                        char* nat = lds + (isB ? OFF_BS : OFF_CS);
#pragma unroll
                        for (int t = 0; t < 8; ++t) *(unsigned*)(nat + (tgl * 8 + t) * CS_ST + n0 * 2) = cvt_pk_bf16(outv[t][0], outv[t][1]);
                        if (isB) {
#pragma unroll
                            for (int e = 0; e < 2; ++e) { f32x4 a, bq;
#pragma unroll
                                for (int t = 0; t < 4; ++t) { a[t] = outv[t][e]; bq[t] = outv[4 + t][e]; }
                                *(u32x4*)(lds + OFF_BT + (n0 + e) * T_ST + tgl * 16) = pack8(a, bq); }
                        }
                    }
                    SBAR();
                }
            }
            if (c + 1 < 32) SSD_LOAD(c + 1, xrl, tgl);
            __syncthreads();
#pragma unroll
            for (int t2 = 0; t2 < 2; ++t2) {
                const int tile = 2 * wid + t2, sb = tile >> 2, lb = tile & 3;
                f32x4 d = (f32x4){0.f, 0.f, 0.f, 0.f}, m0 = d, m1 = d;
                if (sb <= lb) {
#pragma unroll
                    for (int ks = 0; ks < 4; ++ks) d = mfma16(ldfrag(lds + OFF_BS, CS_ST, sb * 16 + frl, ks * 32 + fql * 8), ldfrag(lds + OFF_CS, CS_ST, lb * 16 + frl, ks * 32 + fql * 8), d);
                    const int l = lb * 16 + frl; const float al0 = __shfl(acs0, l), al1 = __shfl(acs1, l);
#pragma unroll
                    for (int r = 0; r < 4; ++r) { const int sidx = sb * 16 + 4 * fql + r; const float as0 = __shfl(acs0, sidx), as1 = __shfl(acs1, sidx), ds0 = __shfl(dtl0, sidx), ds1 = __shfl(dtl1, sidx);
                        m0[r] = (sidx <= l) ? d[r] * __expf(al0 - as0) * ds0 : 0.f; m1[r] = (sidx <= l) ? d[r] * __expf(al1 - as1) * ds1 : 0.f; }
                }
                u32x2 w; w.x = cvt_pk_bf16(m0[0], m0[1]); w.y = cvt_pk_bf16(m0[2], m0[3]);
                *(u32x2*)(lds + OFF_H0 + H_MT + (lb * 16 + frl) * T_ST + (sb * 16 + 4 * fql) * 2) = w;
                w.x = cvt_pk_bf16(m1[0], m1[1]); w.y = cvt_pk_bf16(m1[2], m1[3]);
                *(u32x2*)(lds + OFF_H0 + H_SZ + H_MT + (lb * 16 + frl) * T_ST + (sb * 16 + 4 * fql) * 2) = w;
            }
            f32x4 yacc[2][2];
#pragma unroll
            for (int hh = 0; hh < 2; ++hh)
#pragma unroll
                for (int t2 = 0; t2 < 2; ++t2) {
                    const int tile = 2 * wid + t2, pb = tile >> 2, lb = tile & 3; const char* hb = lds + OFF_H0 + hh * H_SZ;
                    f32x4 d = (f32x4){0.f, 0.f, 0.f, 0.f};
#pragma unroll
                    for (int ks = 0; ks < 4; ++ks) d = mfma16(ldfrag(hb + H_HS, CS_ST, pb * 16 + frl, ks * 32 + fql * 8), ldfrag(lds + OFF_CS, CS_ST, lb * 16 + frl, ks * 32 + fql * 8), d);
                    const float el = __expf(__shfl(hh ? acs1 : acs0, lb * 16 + frl));
                    yacc[hh][t2] = d * el;
                }
            __syncthreads();
#pragma unroll
            for (int hh = 0; hh < 2; ++hh)
#pragma unroll
                for (int t2 = 0; t2 < 2; ++t2) {
                    const int tile = 2 * wid + t2, pb = tile >> 2, lb = tile & 3; const char* hb = lds + OFF_H0 + hh * H_SZ;
                    f32x4 d = yacc[hh][t2];
#pragma unroll
                    for (int ks = 0; ks < 2; ++ks) d = mfma16(ldfrag(hb + H_XS, T_ST, pb * 16 + frl, ks * 32 + fql * 8), ldfrag(hb + H_MT, T_ST, lb * 16 + frl, ks * 32 + fql * 8), d);
                    const int l = lb * 16 + frl, p0 = pb * 16 + 4 * fql; const size_t tok = tokb + c * 64 + l; const float dsk = hh ? dsk1 : dsk0;
                    const u32x2 zz = zpre[hh][t2];
                    const float z0 = bflo(zz.x), z1 = bfhi(zz.x), z2 = bflo(zz.y), z3 = bfhi(zz.y);
                    float xs[4];
#pragma unroll
                    for (int r = 0; r < 4; ++r) xs[r] = bflo((unsigned)*(const bf16_t*)(hb + H_XS + (p0 + r) * T_ST + l * 2));
                    u32x2 w; w.x = cvt_pk_bf16((d[0] + xs[0] * dsk) * z0, (d[1] + xs[1] * dsk) * z1); w.y = cvt_pk_bf16((d[2] + xs[2] * dsk) * z2, (d[3] + xs[3] * dsk) * z3);
                    *(u32x2*)(YG + tok * 1024 + (h0 + hh) * 64 + p0) = w;
                }
#pragma unroll
            for (int hh = 0; hh < 2; ++hh) { const float dc = __expf(hh ? alast1 : alast0); char* hb = lds + OFF_H0 + hh * H_SZ;
#pragma unroll
                for (int t = 0; t < 4; ++t) { f32x4 d = hst[hh][t] * dc;
#pragma unroll
                    for (int ks = 0; ks < 2; ++ks) d = mfma16(ldfrag(lds + OFF_BT, T_ST, wid * 16 + frl, ks * 32 + fql * 8), ldfrag(hb + H_XW, T_ST, t * 16 + frl, ks * 32 + fql * 8), d);
                    hst[hh][t] = d;
                    u32x2 w; w.x = cvt_pk_bf16(d[0], d[1]); w.y = cvt_pk_bf16(d[2], d[3]);
                    *(u32x2*)(hb + H_HS + (t * 16 + frl) * CS_ST + (wid * 16 + 4 * fql) * 2) = w; } }
            __syncthreads();
        }
#undef SSD_LOAD
    }
}

__device__ __forceinline__ void ph_gnorm(Frame& F) {
    bf16_t* YG = (bf16_t*)(F.ws + WS_Q);
    const int gw = F.bid * NWAVES + F.wave, NGW = F.G * NWAVES;
    for (int m = gw; m < NTOK; m += NGW) {
        u32x2* rp = (u32x2*)(YG + (size_t)m * D) + F.lane;
#pragma unroll
        for (int j = 0; j < 4; ++j) { const u32x2 w = rp[64 * j]; const float a = bflo(w.x), b = bfhi(w.x), c = bflo(w.y), d = bfhi(w.y);
            const float ss = wave_sum(a * a + b * b + c * c + d * d); const float r = 1.f / sqrtf(ss * (1.f / 256.f) + LN_EPS);
            u32x2 o; o.x = cvt_pk_bf16(a * r, b * r); o.y = cvt_pk_bf16(c * r, d * r); rp[64 * j] = o; }
    }
}

template <bool DRY = false> __device__ __forceinline__ void ph_router(Frame& F) {
    float* X1 = (float*)F.outb; bf16_t* U2 = (bf16_t*)(F.ws + WS_U2); const float* MOD = (const float*)(F.ws + WS_MOD);
    const float* ln1g = F.a->in[18]; const float* ln1b = F.a->in[19]; const float* w_router = F.a->in[20]; const float* b_router = F.a->in[21];
    u32x2* REG = (u32x2*)(F.ws + WS_REG); unsigned* CNT = (unsigned*)(F.ws + WS_CTL) + CW_CNT;
    constexpr int TST = 2064;
    LAS unsigned char* THI = F.lds; LAS unsigned char* TLO = F.lds + 16 * TST; LAS float* PART = (LAS float*)(F.lds + 32 * TST);
    LAS unsigned* lcnt = (LAS unsigned*)(F.lds + LDS_AUX); LAS unsigned* lbase = lcnt + 32; LAS unsigned* ent = lcnt + 64;
    const int tid = F.tid, lane = F.lane, wid = F.wave, fr = lane & 15, fq = lane >> 4;
    bf16x8 whi[4][2], wlo[4][2];
#pragma unroll
    for (int ks = 0; ks < 4; ++ks)
#pragma unroll
        for (int ct = 0; ct < 2; ++ct) { float wv[8];
#pragma unroll
            for (int i = 0; i < 8; ++i) wv[i] = w_router[(size_t)(128 * wid + 32 * ks + 8 * fq + i) * 32 + ct * 16 + fr];
            u32x4 h, l2;
#pragma unroll
            for (int i = 0; i < 4; ++i) { const unsigned hp = cvt_pk_bf16(wv[2 * i], wv[2 * i + 1]); const float r0 = wv[2 * i] - bflo(hp), r1 = wv[2 * i + 1] - bfhi(hp); h[i] = hp; l2[i] = cvt_pk_bf16(r0, r1); }
            whi[ks][ct] = __builtin_bit_cast(bf16x8, h); wlo[ks][ct] = __builtin_bit_cast(bf16x8, l2); }
    const float brl = b_router[lane & 31];
    for (int batch = F.bid; batch < NTOK / 256; batch += F.G) {
        const int hf = batch >> 7;
        __syncthreads();
        if (tid < 32) lcnt[tid] = 0u;
        for (int grp = 0; grp < 16; ++grp) {
#pragma unroll
            for (int tt = 0; tt < 2; ++tt) {
                const int tg16 = 2 * wid + tt, m = batch * 256 + grp * 16 + tg16; const float* md = MOD + (size_t)(m >> 11) * 6144;
                f32x4* xr = (f32x4*)(X1 + (size_t)m * D) + lane;
                f32x4 v[4]; float s = 0.f;
#pragma unroll
                for (int j = 0; j < 4; ++j) { v[j] = xr[64 * j]; s += (v[j][0] + v[j][1]) + (v[j][2] + v[j][3]); }
                float mean = wave_sum(s) * (1.f / D), s2 = 0.f;
#pragma unroll
                for (int j = 0; j < 4; ++j) { v[j] = v[j] - mean; s2 += (v[j][0] * v[j][0] + v[j][1] * v[j][1]) + (v[j][2] * v[j][2] + v[j][3] * v[j][3]); }
                float rstd = 1.f / sqrtf(wave_sum(s2) * (1.f / D) + LN_EPS);
                s = 0.f;
#pragma unroll
                for (int j = 0; j < 4; ++j) { const f32x4 g = *((const f32x4*)ln1g + lane + 64 * j), bb = *((const f32x4*)ln1b + lane + 64 * j); v[j] = v[j] * rstd * g + bb; if (!DRY) xr[64 * j] = v[j]; s += (v[j][0] + v[j][1]) + (v[j][2] + v[j][3]); }
                mean = wave_sum(s) * (1.f / D); s2 = 0.f;
#pragma unroll
                for (int j = 0; j < 4; ++j) { v[j] = v[j] - mean; s2 += (v[j][0] * v[j][0] + v[j][1] * v[j][1]) + (v[j][2] * v[j][2] + v[j][3] * v[j][3]); }
                rstd = 1.f / sqrtf(wave_sum(s2) * (1.f / D) + LN_EPS);
                u32x2* o8 = (u32x2*)(U2 + (size_t)m * D) + lane;
#pragma unroll
                for (int j = 0; j < 4; ++j) { const f32x4 sh = *((const f32x4*)(md + 3072) + lane + 64 * j), sc = *((const f32x4*)(md + 4096) + lane + 64 * j);
                    v[j] = v[j] * rstd * (sc + 1.0f) + sh; u32x2 w; w.x = cvt_pk_bf16(v[j][0], v[j][1]); w.y = cvt_pk_bf16(v[j][2], v[j][3]);
                    if (DRY) { if (w.x == 0x12345678u) o8[64 * j] = w; }
                    else if (MOE_FP8) { int pk = 0; pk = __builtin_amdgcn_cvt_pk_fp8_f32(v[j][0], v[j][1], pk, false); pk = __builtin_amdgcn_cvt_pk_fp8_f32(v[j][2], v[j][3], pk, true); ((unsigned*)((unsigned char*)U2 + (size_t)m * D))[lane + 64 * j] = (unsigned)pk; }
                    else o8[64 * j] = w;
                    u32x2 lo; lo.x = cvt_pk_bf16(v[j][0] - bflo(w.x), v[j][1] - bfhi(w.x)); lo.y = cvt_pk_bf16(v[j][2] - bflo(w.y), v[j][3] - bfhi(w.y));
                    *(LAS u32x2*)(THI + tg16 * TST + (4 * lane + 256 * j) * 2) = w; *(LAS u32x2*)(TLO + tg16 * TST + (4 * lane + 256 * j) * 2) = lo; }
            }
            __syncthreads();
            { f32x4 a0 = (f32x4){0.f, 0.f, 0.f, 0.f}, a1 = a0;
#pragma unroll
              for (int ks = 0; ks < 4; ++ks) { const int cb = (128 * wid + 32 * ks + 8 * fq) * 2;
                  const bf16x8 th = *(const LAS bf16x8*)(THI + fr * TST + cb), tl = *(const LAS bf16x8*)(TLO + fr * TST + cb);
                  a0 = __builtin_amdgcn_mfma_f32_16x16x32_bf16(whi[ks][0], th, a0, 0, 0, 0); a1 = __builtin_amdgcn_mfma_f32_16x16x32_bf16(whi[ks][1], th, a1, 0, 0, 0);
                  a0 = __builtin_amdgcn_mfma_f32_16x16x32_bf16(wlo[ks][0], th, a0, 0, 0, 0); a1 = __builtin_amdgcn_mfma_f32_16x16x32_bf16(wlo[ks][1], th, a1, 0, 0, 0);
                  a0 = __builtin_amdgcn_mfma_f32_16x16x32_bf16(whi[ks][0], tl, a0, 0, 0, 0); a1 = __builtin_amdgcn_mfma_f32_16x16x32_bf16(whi[ks][1], tl, a1, 0, 0, 0); }
              *(LAS f32x4*)(PART + (wid * 16 + fr) * 32 + 4 * fq) = a0; *(LAS f32x4*)(PART + (wid * 16 + fr) * 32 + 16 + 4 * fq) = a1; }
            __syncthreads();
            { const int tg16 = 2 * wid + (lane >> 5), tl = grp * 16 + tg16, myexp = lane & 31;
              float logit = brl;
#pragma unroll
              for (int w8 = 0; w8 < 8; ++w8) logit += PART[(w8 * 16 + tg16) * 32 + myexp];
              float tv[4]; int tix[4];
#pragma unroll
              for (int k = 0; k < 4; ++k) { float bv = logit; int bi = myexp;
#pragma unroll
                  for (int o = 1; o < 32; o <<= 1) { const float ov = __shfl_xor(bv, o); const int oi = __shfl_xor(bi, o); if (ov > bv || (ov == bv && oi < bi)) { bv = ov; bi = oi; } }
                  tv[k] = bv; tix[k] = bi; if (myexp == bi) logit = -INFINITY; }
              const float e1 = __expf(tv[1] - tv[0]), e2 = __expf(tv[2] - tv[0]), e3 = __expf(tv[3] - tv[0]); const float inv = 1.f / (1.f + e1 + e2 + e3);
              if (myexp < 4) { const int ee = myexp == 0 ? tix[0] : (myexp == 1 ? tix[1] : (myexp == 2 ? tix[2] : tix[3])); const float gg = (myexp == 0 ? 1.f : (myexp == 1 ? e1 : (myexp == 2 ? e2 : e3))) * inv;
                  const unsigned lp = atomicAdd((unsigned*)&lcnt[ee], 1u);
                  LAS unsigned* en = ent + (tl * 4 + myexp) * 3; en[0] = (unsigned)ee; en[1] = lp; en[2] = __float_as_uint(gg);
                  if (DBG_CHECK == 1) { u32x2 rw; rw.x = (unsigned)ee; rw.y = __float_as_uint(gg); ((u32x2*)(F.ws + WS_DBG))[(size_t)(batch * 256 + tl) * 4 + myexp] = rw; } } }
        }
        __syncthreads();
        if (tid < 32) lbase[tid] = DRY ? 0u : __hip_atomic_fetch_add(CNT + 64 * (hf * 32 + tid), lcnt[tid], __ATOMIC_RELAXED, __HIP_MEMORY_SCOPE_AGENT);
        __syncthreads();
        for (int i = tid; i < 1024; i += NTHR) { const LAS unsigned* en = ent + i * 3; const unsigned ee = en[0], pos = lbase[ee] + en[1];
            const unsigned tokl = (unsigned)(batch * 256 + (i >> 2)) - (unsigned)hf * HALF_TOK;
            u32x2 w; w.x = tokl * 4u + (unsigned)(i & 3); w.y = en[2];
            if (!DRY && pos < (unsigned)REG_CAP) REG[((size_t)hf * 32 + ee) * REG_CAP + pos] = w; }
    }
}

template <bool DRY = false> __device__ __forceinline__ void ph_final(Frame& F, int hf) {
    float* X1 = (float*)F.outb; const bf16_t* YB = (const bf16_t*)(F.ws + WS_YB); const float* MOD = (const float*)(F.ws + WS_MOD);
    const float* g2 = F.a->in[26]; const float* b2 = F.a->in[27];
    const int gw = F.bid * NWAVES + F.wave, NGW = F.G * NWAVES, lane = F.lane;
    constexpr int RB = 2;
    for (int tl0 = gw; tl0 < HALF_TOK; tl0 += NGW * RB) {
        f32x4 xv[RB][4]; u32x2 yw[RB][4][4];
#pragma unroll
        for (int r = 0; r < RB; ++r) { const int tl = tl0 + r * NGW, m = hf * HALF_TOK + tl;
            const f32x4* xr = (const f32x4*)(X1 + (size_t)m * D) + lane; const u32x2* yr = (const u32x2*)(YB + (size_t)tl * 4 * D) + lane;
#pragma unroll
            for (int j = 0; j < 4; ++j) { xv[r][j] = xr[64 * j];
#pragma unroll
                for (int k = 0; k < 4; ++k) yw[r][j][k] = yr[k * 256 + 64 * j]; } }
#pragma unroll
        for (int r = 0; r < RB; ++r) { const int tl = tl0 + r * NGW, m = hf * HALF_TOK + tl; const float* md = MOD + (size_t)(m >> 11) * 6144 + 5120;
            f32x4* xr = (f32x4*)(X1 + (size_t)m * D) + lane;
            f32x4 v[4]; float s = 0.f;
#pragma unroll
            for (int j = 0; j < 4; ++j) { f32x4 y = (f32x4){0.f, 0.f, 0.f, 0.f};
#pragma unroll
                for (int k = 0; k < 4; ++k) { const u32x2 w = yw[r][j][k]; y[0] += bflo(w.x); y[1] += bfhi(w.x); y[2] += bflo(w.y); y[3] += bfhi(w.y); }
                if (DBG_NO_MOE) y = (f32x4){0.f, 0.f, 0.f, 0.f};
                const f32x4 gt = *((const f32x4*)md + lane + 64 * j);
                v[j] = xv[r][j] * DN_ALPHA + gt * y; s += (v[j][0] + v[j][1]) + (v[j][2] + v[j][3]); }
            const float mean = wave_sum(s) * (1.f / D); float s2 = 0.f;
#pragma unroll
            for (int j = 0; j < 4; ++j) { v[j] = v[j] - mean; s2 += (v[j][0] * v[j][0] + v[j][1] * v[j][1]) + (v[j][2] * v[j][2] + v[j][3] * v[j][3]); }
            const float rstd = 1.f / sqrtf(wave_sum(s2) * (1.f / D) + LN_EPS);
#pragma unroll
            for (int j = 0; j < 4; ++j) { const f32x4 g = *((const f32x4*)g2 + lane + 64 * j), bb = *((const f32x4*)b2 + lane + 64 * j); const f32x4 ov = v[j] * rstd * g + bb; if (!DRY || ov[0] == 1.2345e-33f) xr[64 * j] = ov; } }
    }
}

__device__ __forceinline__ float block_sum(Frame& F, float v, LAS float* red) {
    v = wave_sum(v); __syncthreads(); if (F.lane == 0) red[F.wave] = v; __syncthreads();
    float s = 0.f; for (int w = 0; w < NWAVES; ++w) s += red[w]; return s;
}
__device__ __forceinline__ float block_max(Frame& F, float v, LAS float* red) {
#pragma unroll
    for (int o = 1; o < 64; o <<= 1) v = fmaxf(v, __shfl_xor(v, o));
    __syncthreads(); if (F.lane == 0) red[F.wave] = v; __syncthreads();
    float s = 0.f; for (int w = 0; w < NWAVES; ++w) s = fmaxf(s, red[w]); return s;
}
__device__ __forceinline__ void dbg_report(Frame& F, float e) { if (F.tid == 0) atomicMax((unsigned*)(F.ws + WS_CTL) + CW_DBG, __float_as_uint(e)); }
__device__ __forceinline__ void dbg_check_moe(Frame& F) {
    if (F.bid >= 64) return;
    const int tok = HALF_TOK + 509 * F.bid + 3, tokl = tok - HALF_TOK, tid = F.tid;
    LAS float* u2 = (LAS float*)F.lds; LAS float* act = u2 + 1024; LAS float* red = act + 1024; LAS float* lg = red + 16;
    const bf16_t* U2 = (const bf16_t*)(F.ws + WS_U2); const bf16_t* YB = (const bf16_t*)(F.ws + WS_YB); const u32x2* RT = (const u32x2*)(F.ws + WS_DBG);
    const float* w1 = F.a->in[22]; const float* b1 = F.a->in[23]; const float* w2 = F.a->in[24]; const float* b2 = F.a->in[25];
    __syncthreads();
    for (int i = tid; i < 1024; i += NTHR) u2[i] = bflo((unsigned)U2[(size_t)tok * 1024 + i]);
    __syncthreads();
    float y0 = 0.f, y1 = 0.f;
    for (int k = 0; k < 4; ++k) {
        const u32x2 rw = RT[(size_t)tok * 4 + k]; const int e = (int)rw.x; const float g = __uint_as_float(rw.y);
        const float* W1 = w1 + (size_t)e * 1024 * 2048; const float* W2 = w2 + (size_t)e * 1024 * 1024;
        float h0 = b1[e * 2048 + tid], h1 = b1[e * 2048 + tid + 512], h2 = b1[e * 2048 + tid + 1024], h3 = b1[e * 2048 + tid + 1536];
        for (int c = 0; c < 1024; ++c) { const float uu = u2[c]; const float* wr = W1 + (size_t)c * 2048 + tid; h0 += uu * wr[0]; h1 += uu * wr[512]; h2 += uu * wr[1024]; h3 += uu * wr[1536]; }
        __syncthreads();
        { float gg = fminf(h0, 7.f), up = fminf(fmaxf(h2, -7.f), 7.f); act[tid] = (up + 1.f) * gg / (1.f + expf(-1.702f * gg));
          gg = fminf(h1, 7.f); up = fminf(fmaxf(h3, -7.f), 7.f); act[tid + 512] = (up + 1.f) * gg / (1.f + expf(-1.702f * gg)); }
        __syncthreads();
        float a0 = b2[e * 1024 + tid], a1 = b2[e * 1024 + tid + 512];
        for (int j = 0; j < 1024; ++j) { const float aa = act[j]; a0 += aa * W2[(size_t)j * 1024 + tid]; a1 += aa * W2[(size_t)j * 1024 + tid + 512]; }
        y0 += g * a0; y1 += g * a1;
    }
    float f0 = 0.f, f1 = 0.f;
    for (int k = 0; k < 4; ++k) { f0 += bflo((unsigned)YB[((size_t)tokl * 4 + k) * 1024 + tid]); f1 += bflo((unsigned)YB[((size_t)tokl * 4 + k) * 1024 + tid + 512]); }
    const float rms = sqrtf(block_sum(F, y0 * y0 + y1 * y1, red) * (1.f / 1024.f)) + 1e-20f;
    float err = block_max(F, fmaxf(fabsf(y0 - f0), fabsf(y1 - f1)), red) / rms;
    { const float* X1 = (const float*)F.outb + (size_t)tok * 1024; const float* md = (const float*)(F.ws + WS_MOD) + (size_t)(tok >> 11) * 6144;
      const float xa = X1[tid], xb = X1[tid + 512]; const float mean = block_sum(F, xa + xb, red) * (1.f / 1024.f);
      const float da = xa - mean, db = xb - mean; const float var = block_sum(F, da * da + db * db, red) * (1.f / 1024.f); const float rstd = 1.f / sqrtf(var + LN_EPS);
      __syncthreads();
      u2[tid] = da * rstd * (1.f + md[4096 + tid]) + md[3072 + tid]; u2[tid + 512] = db * rstd * (1.f + md[4096 + tid + 512]) + md[3072 + tid + 512];
      __syncthreads();
      if (tid < 32) { float a = F.a->in[21][tid]; for (int c = 0; c < 1024; ++c) a += u2[c] * F.a->in[20][c * 32 + tid]; lg[tid] = a; }
      __syncthreads();
      if (tid == 0) { unsigned want = 0u, got = 0u; float l2[32]; for (int i = 0; i < 32; ++i) l2[i] = lg[i];
          for (int k = 0; k < 4; ++k) { int bi = 0; for (int i = 1; i < 32; ++i) if (l2[i] > l2[bi]) bi = i; want |= 1u << bi; l2[bi] = -INFINITY; got |= 1u << RT[(size_t)tok * 4 + k].x; }
          lg[32] = (want != got) ? 1.f : 0.f; }
      __syncthreads();
      if (lg[32] != 0.f) err = 50.f; }
    dbg_report(F, err);
}
__device__ __forceinline__ void dbg_check_ssd(Frame& F) {
    if (F.bid >= 2) return;
    const int b = F.bid ? 20 : 5, h = F.bid ? 14 : 3, g = h >> 2, tid = F.tid, p = tid >> 3, ng = tid & 7;
    LAS float* red = (LAS float*)F.lds; LAS float* cv = red + 16;
    const bf16_t* XBC = (const bf16_t*)(F.ws + WS_XBC); const bf16_t* ZS = (const bf16_t*)(F.ws + WS_Z); const float* DT = (const float*)(F.outb + OUT_DT); const bf16_t* YG = (const bf16_t*)(F.ws + WS_Q);
    const float* cw = F.a->in[9]; const float* cb = F.a->in[10]; const float aneg = -expf(F.a->in[12][h]), dsk = F.a->in[13][h];
    const int mych = tid < 64 ? h * 64 + tid : (tid < 192 ? 1024 + g * 128 + (tid - 64) : 1536 + g * 128 + (tid - 192));
    float w0 = 0.f, w1 = 0.f, w2 = 0.f, w3 = 0.f, wb = 0.f;
    if (tid < 320) { w0 = cw[0 * 2048 + mych]; w1 = cw[1 * 2048 + mych]; w2 = cw[2 * 2048 + mych]; w3 = cw[3 * 2048 + mych]; wb = cb[mych]; }
    float x0 = 0.f, x1 = 0.f, x2 = 0.f;
    float hs[16];
#pragma unroll
    for (int i = 0; i < 16; ++i) hs[i] = 0.f;
    float emax = 0.f, ssq = 0.f, nbad = 0.f; int tmax = 0;
    for (int t = 0; t < SEQ; ++t) {
        const size_t tok = (size_t)b * SEQ + t;
        __syncthreads();
        if (DBG_HYP == 1 && (t & 63) == 0) { x0 = 0.f; x1 = 0.f; x2 = 0.f; }
        if (tid < 320) { const float x3 = bflo((unsigned)XBC[tok * 2048 + mych]); const float s = wb + w0 * x0 + w1 * x1 + w2 * x2 + w3 * x3; cv[tid] = s / (1.f + expf(-s)); x0 = x1; x1 = x2; x2 = x3; }
        __syncthreads();
        const float xv = cv[p], dt = DT[tok * 16 + h], dec = expf(dt * aneg);
        float yp = 0.f;
#pragma unroll
        for (int i = 0; i < 16; ++i) { const int n = ng * 16 + i; hs[i] = hs[i] * dec + dt * xv * cv[64 + n]; yp += cv[192 + n] * hs[i]; }
        yp += __shfl_xor(yp, 1); yp += __shfl_xor(yp, 2); yp += __shfl_xor(yp, 4);
        const float yv = (yp + xv * dsk) * bflo((unsigned)ZS[tok * 1024 + h * 64 + p]);
        const float yf = bflo((unsigned)YG[tok * 1024 + h * 64 + p]);
        if (ng == 0) { const float er = fabsf(yv - yf); if (er > emax) { emax = er; tmax = t; } ssq += yv * yv; if (er > 0.25f && (DBG_SUB < 5 || (DBG_SUB == 5 && (t & 63) == 0) || (DBG_SUB == 6 && (t & 63) == 1) || (DBG_SUB == 7 && (t & 63) == 32))) nbad += 1.f; }
    }
    const float rms = sqrtf(block_sum(F, ssq, red) / (64.f * SEQ)) + 1e-20f;
    const float M = block_max(F, emax, red);
    if (DBG_SUB == 0) dbg_report(F, M / rms);
    else if (DBG_SUB == 1) dbg_report(F, block_sum(F, nbad, red) / (64.f * SEQ));
    else if (DBG_SUB >= 5) dbg_report(F, block_sum(F, nbad, red) / (64.f * 32.f));
    else { __syncthreads(); if (ng == 0 && emax == M) red[12] = (float)(DBG_SUB == 2 ? ((tmax & 63) >> 1) : (DBG_SUB == 3 ? (tmax >> 6) : (p >> 1))); __syncthreads();
        if (F.bid == 0) dbg_report(F, powf(10.f, 2.f * (0.05f + 0.05f * red[12]) - 4.f)); }
}
__device__ __forceinline__ void dbg_check_attn(Frame& F) {
    if (F.bid >= 32) return;
    const int b = (F.bid * 7 + 3) & 31, pos = 300 + F.bid * 53, nadm = ((pos >> 6) + 1) * 64, tid = F.tid, lane = F.lane, hd = F.wave;
    const size_t tq = (size_t)b * SEQ + pos;
    LAS float* sc = (LAS float*)F.lds; LAS unsigned char* sel = (LAS unsigned char*)(sc + 2048); LAS float* lgt = (LAS float*)(sel + 2048); LAS float* red = lgt + 8 * 2048; LAS float* misc = red + 16;
    const bf16_t* IQ = (const bf16_t*)(F.outb + OUT_IQ); const bf16_t* IK = (const bf16_t*)(F.outb + OUT_IK); const float* IW = (const float*)(F.outb + OUT_IW);
    const bf16_t* Q = (const bf16_t*)(F.ws + WS_Q); const bf16_t* KV = (const bf16_t*)(F.outb + OUT_KV); const bf16_t* OA = (const bf16_t*)(F.outb + OUT_OA); const u64* MASK = (const u64*)(F.outb + OUT_MASK);
    __syncthreads();
    for (int k = tid; k < nadm; k += NTHR) { float s = 0.f;
        for (int hh = 0; hh < 8; ++hh) { float d = 0.f; for (int c = 0; c < 64; ++c) d += bflo((unsigned)IQ[tq * 512 + hh * 64 + c]) * bflo((unsigned)IK[((size_t)b * SEQ + k) * 64 + c]); s += fmaxf(d, 0.f) * IW[tq * 8 + hh]; }
        sc[k] = s + 0.0f; }
    __syncthreads();
    float nbad = 0.f;
    for (int k = tid; k < nadm; k += NTHR) { const float s = sc[k]; int rank = 0; for (int j = 0; j < nadm; ++j) { const float t = sc[j]; rank += (t > s || (t == s && j < k)) ? 1 : 0; }
        const unsigned char se = rank < 256 ? 1 : 0; sel[k] = se; const unsigned mb = (unsigned)((MASK[tq * 32 + (k >> 6)] >> (k & 63)) & 1ull); if (mb != se) nbad += 1.f; }
    __syncthreads();
    const float nbad_t = block_sum(F, nbad, red);
    LAS float* lw = lgt + hd * 2048; float mx = -INFINITY;
    for (int k = lane; k < nadm; k += 64) { float l = -INFINITY;
        if (sel[k]) { float d = 0.f; for (int c = 0; c < 128; ++c) d += bflo((unsigned)Q[tq * 1024 + hd * 128 + c]) * bflo((unsigned)KV[((size_t)b * SEQ + k) * 128 + c]);
            const int rel = k - pos, n = rel < 0 ? -rel : rel; const float nf = (float)(n > 1 ? n : 1); int large = 8 + (int)(logf(nf / 8.0f) / 2.7725887f * 8.0f); if (large > 15) large = 15;
            const int bucket = (rel > 0 ? 16 : 0) + (n < 8 ? n : large);
            l = d * 0.088388347648318440f + F.a->in[8][bucket * 8 + hd]; }
        lw[k] = l; mx = fmaxf(mx, l); }
#pragma unroll
    for (int o = 1; o < 64; o <<= 1) mx = fmaxf(mx, __shfl_xor(mx, o));
    float den = 0.f;
    for (int k = lane; k < nadm; k += 64) { const float pp = expf(lw[k] - mx); lw[k] = pp; den += pp; }
    den = wave_sum(den);
    float emax = 0.f, ssq = 0.f;
    for (int c2 = 0; c2 < 2; ++c2) { const int c = lane + 64 * c2; float o = 0.f; for (int k = 0; k < nadm; ++k) { const float pp = lw[k]; if (pp != 0.f) o += pp * bflo((unsigned)KV[((size_t)b * SEQ + k) * 128 + c]); }
        o /= den; const float of = bflo((unsigned)OA[tq * 1024 + hd * 128 + c]); emax = fmaxf(emax, fabsf(o - of)); ssq += o * o; }
    const float rms = sqrtf(block_sum(F, ssq, red) * (1.f / 1024.f)) + 1e-20f;
    float err = block_max(F, emax, red) / rms;
    (void)misc;
    if (nbad_t > 0.f) err = 10.f + nbad_t;
    dbg_report(F, err);
}
__device__ __forceinline__ void dbg_emit(Frame& F) {
    float* out = (float*)F.outb;
    for (size_t i = (size_t)F.bid * NTHR + F.tid; i < (size_t)NTOK * D / 4; i += (size_t)F.G * NTHR) ((f32x4*)out)[i] = (f32x4){0.f, 0.f, 0.f, 0.f};
    __syncthreads();
    if (F.bid == 0 && F.tid == 0) { const float e = __uint_as_float(__hip_atomic_load((unsigned*)(F.ws + WS_CTL) + CW_DBG, __ATOMIC_RELAXED, __HIP_MEMORY_SCOPE_AGENT));
        float code = (log10f(fmaxf(e, 1e-30f)) + 4.f) * 0.5f; code = fminf(fmaxf(rintf(code * 20.f) * 0.05f, 0.05f), 3.0f);
        out[0] = sqrtf(67108864.f * 1.01f * (powf(10.f, code) - 1.f)); }
}

constexpr int NPHASE = 17;
__global__ void __launch_bounds__(NTHR, 2) fwd(Args args) {
    extern __shared__ __attribute__((aligned(16))) unsigned char lds_raw[];
    Frame F;
    F.lds = (LAS unsigned char*)lds_raw;
    F.tid = threadIdx.x; F.lane = F.tid & 63; F.wave = __builtin_amdgcn_readfirstlane(F.tid >> 6); F.G = gridDim.x; F.bid = blockIdx.x;
    F.a = &args;
    F.ws = args.ws; F.outb = (unsigned char*)args.out;
    volatile LAS unsigned* MISCW = (volatile LAS unsigned*)(F.lds + LDS_MISC);
    if (F.tid < 64) MISCW[F.tid] = 0u;
    __syncthreads();
    XcdBarrier bar; bar.bar = (unsigned*)(F.ws + WS_CTL) + CW_BAR; bar.x = 0; bar.st = nullptr;
#if MK_ONE
    bar = xcd_barrier_post((unsigned*)(F.ws + WS_CTL) + CW_BAR, MISCW + 8);
#define GRID_BAR() xcd_barrier(bar)
#else
#define GRID_BAR() do { } while (0)
#endif
    const int lo = args.ph_lo, hi = args.ph_hi;
#ifndef PHM
#define PHM (0xFFFFFFFFu & ~(DBG_NO_ATTN ? 0x30u : 0u) & ~(DBG_NO_SSD ? 0xC0u : 0u))
#endif
#define IN(k) (((PHM >> (k)) & 1u) && lo <= (k) && (k) < hi)
#define SEAM(k) do { if ((k) + 1 < hi) GRID_BAR(); } while (0)

    if (IN(0)) { ph_prologue(F); if (DBG_TWICE & 1u) { GRID_BAR(); ph_prologue(F); } SEAM(0); }
    if (IN(1)) { ph_ln1(F); if (DBG_TWICE & 2u) { GRID_BAR(); ph_ln1(F); } SEAM(1); }
    if (IN(2)) {
        EpiProj E{(bf16_t*)(F.ws + WS_Q), (bf16_t*)(F.outb + OUT_IQ), (bf16_t*)(F.ws + WS_Z), (bf16_t*)(F.ws + WS_XBC), (bf16_t*)(F.ws + WS_GA), (bf16_t*)(F.ws + WS_GB), (float*)(F.outb + OUT_MISC), 1.0f};
#if PROJ_FP8
        { SchedProj<2> S; S.o.init(NTOK, 12 * 256, F.G, F.bid); S.A = (const char*)(F.ws + WS_U8); S.Bt = (const char*)(F.ws + WS_WIN8);
          EpiProj E8 = E; E8.sc = MOE_INV;
          pg8::gemm_phase<EpiProj, SchedProj<2>, false, 512, true>(F.lds, S, E8);
          if (DBG_TWICE & 32768u) { GRID_BAR(); pg8::gemm_phase<EpiProj, SchedProj<2>, false, 512, true>(F.lds, S, E8); } }
        { SchedProj<1> S; S.o.init(NTOK, 15 * 256, F.G, F.bid); S.A = (const char*)(F.outb + OUT_U); S.Bt = (const char*)(F.ws + WS_WIN);
          pg8::gemm_phase<EpiProj, SchedProj<1>, false>(F.lds, S, E);
          if (DBG_TWICE & 4u) { GRID_BAR(); pg8::gemm_phase<EpiProj, SchedProj<1>, false>(F.lds, S, E); } }
#else
        { SchedProj<0> S; S.o.init(NTOK, NPROJ, F.G, F.bid); S.A = (const char*)(F.outb + OUT_U); S.Bt = (const char*)(F.ws + WS_WIN);
          pg8::gemm_phase<EpiProj, SchedProj<0>, false>(F.lds, S, E);
          if (DBG_TWICE & 4u) { GRID_BAR(); pg8::gemm_phase<EpiProj, SchedProj<0>, false>(F.lds, S, E); } }
#endif
        SEAM(2);
    }
    if (IN(3)) { ph_misc(F); if (DBG_TWICE & 8u) { GRID_BAR(); ph_misc(F); } SEAM(3); }
    if (IN(4)) { ph_index(F); if (DBG_TWICE & 16u) { GRID_BAR(); ph_index(F); } SEAM(4); }
    if (IN(5)) { ph_attn(F); if (DBG_TWICE & 32u) { GRID_BAR(); ph_attn(F); } SEAM(5); if (DBG_CHECK == 3) { dbg_check_attn(F); GRID_BAR(); } }
    if (IN(6)) { ph_ssd2(F); if (DBG_TWICE & 64u) { GRID_BAR(); ph_ssd2(F); } SEAM(6); if (DBG_CHECK == 2) { dbg_check_ssd(F); GRID_BAR(); } }
    if (IN(7)) { ph_gnorm(F); if (DBG_TWICE & 128u) { GRID_BAR(); ph_gnorm(F); } SEAM(7); }
    if (IN(8)) {
#if PA_FP8
        SchedPlainT<1024> S; S.o.init(NTOK, 1024, F.G, F.bid); S.A = (const char*)(F.outb + OUT_OA); S.Bt = (const char*)(F.ws + WS_WPA8);
        EpiGate<0> E{(const bf16_t*)(F.ws + WS_GA), nullptr, (bf16_t*)(F.ws + WS_Z), MOE_INV};
        pg8::gemm_phase<EpiGate<0>, SchedPlainT<1024>, false, 512, true>(F.lds, S, E);
#else
        SchedPlain S; S.o.init(NTOK, 1024, F.G, F.bid); S.A = (const char*)(F.outb + OUT_OA); S.Bt = (const char*)(F.ws + WS_WPA);
        EpiGate<0> E{(const bf16_t*)(F.ws + WS_GA), nullptr, (bf16_t*)(F.ws + WS_Z), 1.0f};
        pg8::gemm_phase<EpiGate<0>, SchedPlain, false>(F.lds, S, E);
#endif
    }
    if (IN(9)) {
        SchedPlain S; S.o.init(NTOK, 1024, F.G, F.bid); S.A = (const char*)(F.ws + WS_Q); S.Bt = (const char*)(F.ws + WS_WPB);
        EpiGate<1> E{(const bf16_t*)(F.ws + WS_GB), (const bf16_t*)(F.ws + WS_Z), (bf16_t*)(F.ws + WS_XBC), 1.0f};
        pg8::gemm_phase<EpiGate<1>, SchedPlain, false>(F.lds, S, E);
        SEAM(9);
    }
    if (IN(10)) {
        SchedPlain S; S.o.init(NTOK, 1024, F.G, F.bid); S.A = (const char*)(F.ws + WS_XBC); S.Bt = (const char*)(F.ws + WS_WOUT);
        EpiOut E{F.a->in[0], (const float*)(F.ws + WS_MOD), (float*)F.outb};
        pg8::gemm_phase<EpiOut, SchedPlain, false>(F.lds, S, E);
        if (DBG_TWICE & 1024u) { GRID_BAR(); pg8::gemm_phase<EpiOut, SchedPlain, false>(F.lds, S, E); }
        SEAM(10);
    }
    if (IN(11)) { if (DBG_TWICE & 2048u) { ph_router<true>(F); GRID_BAR(); } ph_router<false>(F); SEAM(11); }
#pragma unroll
    for (int hf = 0; hf < 2; ++hf) {
        const int p0 = 12 + hf * 2;
        if (IN(p0)) {
            if (hf == 1) ph_final<false>(F, 0);
            MoeTab T = moe_tables(F, hf);
            SchedMoe<8, true> S{T, F.G, F.bid, hf, (const char*)(F.ws + WS_U2), (const char*)(F.ws + WS_W1), (const u32x2*)(F.ws + WS_REG)};
            EpiMoe1 E{F.a->in[23], (bf16_t*)(F.ws + WS_ACT), 0};
            pg8::gemm_phase<EpiMoe1, SchedMoe<8, true>, true, MOE_RB / 2, MOE_FP8 != 0>(F.lds, S, E);
            if ((DBG_TWICE & 4096u) && hf == 0) { GRID_BAR(); pg8::gemm_phase<EpiMoe1, SchedMoe<8, true>, true, MOE_RB / 2, MOE_FP8 != 0>(F.lds, S, E); }
            if ((DBG_TWICE & 16384u) && hf == 0) { GRID_BAR(); EpiMoe1 Ed = E; Ed.dry = 1; pg8::gemm_phase<EpiMoe1, SchedMoe<8, true>, true, MOE_RB / 2, MOE_FP8 != 0>(F.lds, S, Ed); }
            SEAM(p0);
        }
        if (IN(p0 + 1)) {
            MoeTab T = moe_tables(F, hf);
            SchedMoe<4, false> S{T, F.G, F.bid, hf, (const char*)(F.ws + WS_ACT), (const char*)(F.ws + WS_W2), (const u32x2*)(F.ws + WS_REG)};
            EpiMoe2 E{F.a->in[25], (bf16_t*)(F.ws + WS_YB), (const u32x2*)(F.ws + WS_REG), T, hf, 0};
            if ((DBG_TWICE & 262144u) && hf == 0) { EpiMoe2 Ed = E; Ed.dry = DBG_DRYMODE; pg8::gemm_phase<EpiMoe2, SchedMoe<4, false>, false, MOE_RB / 2, MOE_FP8 != 0>(F.lds, S, Ed); GRID_BAR(); }
            pg8::gemm_phase<EpiMoe2, SchedMoe<4, false>, false, MOE_RB / 2, MOE_FP8 != 0>(F.lds, S, E);
            if ((DBG_TWICE & 8192u) && hf == 0) { GRID_BAR(); pg8::gemm_phase<EpiMoe2, SchedMoe<4, false>, false, MOE_RB / 2, MOE_FP8 != 0>(F.lds, S, E); }
            if ((DBG_TWICE & 131072u) && hf == 0) { GRID_BAR(); EpiMoe2 Ed = E; Ed.dry = 1; pg8::gemm_phase<EpiMoe2, SchedMoe<4, false>, false, MOE_RB / 2, MOE_FP8 != 0>(F.lds, S, Ed); }
            SEAM(p0 + 1);
            if (DBG_CHECK == 1 && hf == 1) { dbg_check_moe(F); GRID_BAR(); }
        }
    }
    if (IN(16)) { if (DBG_TWICE & 65536u) { ph_final<true>(F, 1); GRID_BAR(); } ph_final(F, 1); }
    if (DBG_CHECK) { GRID_BAR(); dbg_emit(F); }
#undef IN
#undef SEAM
}

extern "C" void kernel_launch(void* const* d_in, const int* in_sizes, int n_in, void* d_out, int out_size, void* d_ws, size_t ws_size, hipStream_t stream) {
    static int grid = 0;
    if (grid == 0) {
        if (n_in != 28 || in_sizes[0] != NTOK * D || out_size != NTOK * D || ws_size < WS_END) { fprintf(stderr, "kernel_launch: shape mismatch (n_in %d, in0 %d, out %d, ws %zu)\n", n_in, n_in > 0 ? in_sizes[0] : -1, out_size, ws_size); grid = -1; return; }
        int dev = 0, cus = 0, per_cu = 0;
        if (hipGetDevice(&dev) != hipSuccess || hipDeviceGetAttribute(&cus, hipDeviceAttributeMultiprocessorCount, dev) != hipSuccess) { grid = -1; return; }
        if (hipFuncSetAttribute((const void*)fwd, hipFuncAttributeMaxDynamicSharedMemorySize, LDS_BYTES) != hipSuccess) { fprintf(stderr, "kernel_launch: hipFuncSetAttribute failed\n"); grid = -1; return; }
        if (hipOccupancyMaxActiveBlocksPerMultiprocessor(&per_cu, (const void*)fwd, NTHR, LDS_BYTES) != hipSuccess || per_cu < 1) fprintf(stderr, "kernel_launch: occupancy query reports %d\n", per_cu);
        (void)hipGetLastError();
        grid = cus;
    }
    if (grid < 0) return;
    if (hipMemsetAsync((char*)d_ws + WS_CTL, 0, CTL_ZERO_BYTES, stream) != hipSuccess) { fprintf(stderr, "kernel_launch: memset failed\n"); return; }
    Args a{};
    for (int i = 0; i < 28; ++i) a.in[i] = (const float*)d_in[i];
    a.out = (float*)d_out; a.ws = (unsigned char*)d_ws;
    const int nph = NPHASE < MK_PH_HI ? NPHASE : MK_PH_HI;
#if MK_ONE
    a.ph_lo = 0; a.ph_hi = nph;
    hipLaunchKernelGGL(fwd, dim3(grid), dim3(NTHR), LDS_BYTES, stream, a);
#else
    for (int p = 0; p < nph; ++p) { a.ph_lo = p; a.ph_hi = p + 1; hipLaunchKernelGGL(fwd, dim3(grid), dim3(NTHR), LDS_BYTES, stream, a); }
#endif
    const hipError_t le = hipPeekAtLastError();
    if (le != hipSuccess) fprintf(stderr, "kernel_launch: launch failed: %s\n", hipGetErrorName(le));
}
```

```cpp
#include <hip/hip_runtime.h>
#include <cstdio>
#include <cstdint>

#ifndef MK_ONE
#define MK_ONE 1
#endif
#ifndef DBG_NO_ATTN
#define DBG_NO_ATTN 0
#endif
#ifndef DBG_ATTN_ZERO
#define DBG_ATTN_ZERO 0
#endif
#ifndef DBG_IQ_TRUNC
#define DBG_IQ_TRUNC 0
#endif
#ifndef DBG_ROUTER_BF16
#define DBG_ROUTER_BF16 0
#endif
#ifndef DBG_CHECK
#define DBG_CHECK 0
#endif
#ifndef DBG_SKIP_BODY
#define DBG_SKIP_BODY 0
#endif
#ifndef DBG_SUB
#define DBG_SUB 0
#endif
#ifndef DBG_SSD_SYNC
#define DBG_SSD_SYNC 0
#endif
#ifndef DBG_HYP
#define DBG_HYP 0
#endif
#ifndef DBG_TWICE
#define DBG_TWICE 0u
#endif
#ifndef DBG_DRYMODE
#define DBG_DRYMODE 2
#endif
#ifndef DBG_NO_SSD
#define DBG_NO_SSD 0
#endif
#ifndef DBG_NO_MOE
#define DBG_NO_MOE 0
#endif
#ifndef MOE_FP8
#define MOE_FP8 1
#endif
#ifndef PROJ_FP8
#define PROJ_FP8 1
#endif
#ifndef PA_FP8
#define PA_FP8 1
#endif
#ifndef PB_FP8
#define PB_FP8 0
#endif
#ifndef ATT2
#define ATT2 1
#endif
#ifndef MK_PH_HI
#define MK_PH_HI 99
#endif

#define LAS __attribute__((address_space(3)))
#define GAS __attribute__((address_space(1)))
typedef unsigned short bf16_t;
typedef short bf16x8 __attribute__((ext_vector_type(8)));
typedef short s16x4 __attribute__((ext_vector_type(4)));
typedef float f32x2 __attribute__((ext_vector_type(2)));
typedef float f32x4 __attribute__((ext_vector_type(4)));
typedef float f32x16 __attribute__((ext_vector_type(16)));
typedef unsigned u32x2 __attribute__((ext_vector_type(2)));
typedef unsigned u32x4 __attribute__((ext_vector_type(4)));
typedef unsigned long long u64;

constexpr int NB = 32, SEQ = 2048, D = 1024, NTOK = NB * SEQ;
constexpr int NWAVES = 8, NTHR = 512;
constexpr int NPROJ = 6912;
constexpr int NEXP = 32, HALF_TOK = NTOK / 2, REG_CAP = HALF_TOK;
constexpr int ACT_ROWS = HALF_TOK * 4 + NEXP * 256;
constexpr float LN_EPS = 1e-5f;
constexpr float DN_ALPHA = 1.189207115002721f;
constexpr float LOG2E = 1.4426950408889634f;

constexpr size_t MiB = 1u << 20;
constexpr size_t WS_CTL = 0, CTL_ZERO_BYTES = 1 * MiB;
constexpr size_t WS_MOD = 1 * MiB;
constexpr size_t WS_BIAST = 1 * MiB + 800 * 1024;
constexpr size_t WS_WIN = 2 * MiB;
constexpr size_t WS_WPA = 16 * MiB, WS_WPB = 18 * MiB, WS_WOUT = 20 * MiB;
constexpr size_t WS_W1 = 24 * MiB;
constexpr size_t WS_U8 = 88 * MiB;
constexpr size_t WS_W2 = 152 * MiB;
constexpr size_t WS_WIN8 = 184 * MiB;
constexpr size_t WS_WPA8 = 192 * MiB;
constexpr size_t WS_WPB8 = 194 * MiB;
constexpr size_t OUT_OB8 = 192 * MiB;
constexpr size_t WS_Q = 216 * MiB;
constexpr size_t WS_Z = 344 * MiB;
constexpr size_t WS_XBC = 472 * MiB;
constexpr size_t WS_GA = 728 * MiB, WS_GB = 856 * MiB;
constexpr size_t WS_U2 = 216 * MiB;
constexpr size_t WS_REG = 344 * MiB;
constexpr size_t WS_ACT = 360 * MiB;
constexpr size_t WS_YB = 632 * MiB;
constexpr size_t WS_END = 889 * MiB;
constexpr size_t WS_DBG = 889 * MiB;
constexpr size_t OUT_U = 0, OUT_MISC = 128 * MiB, OUT_IQ = 192 * MiB;
constexpr size_t OUT_KV = 0, OUT_IK = 16 * MiB, OUT_IW = 24 * MiB, OUT_DT = 26 * MiB, OUT_MASK = 32 * MiB, OUT_OA = 64 * MiB;
constexpr int CW_BAR = 4096, CW_CNT = 16384, CW_DBG = 24576;

constexpr int LDS_BYTES = 160 * 1024;
constexpr int LDS_AUX = 131072;
constexpr int LDS_MISC = LDS_BYTES - 256;

#define LDS_WAIT() asm volatile("s_waitcnt lgkmcnt(0)" ::: "memory")
#define VM_WAIT() asm volatile("s_waitcnt vmcnt(0)" ::: "memory")
#define SBAR() __builtin_amdgcn_sched_barrier(0)
typedef __bf16 bf16x2_t __attribute__((ext_vector_type(2)));
__device__ __forceinline__ unsigned cvt_pk_bf16(float lo, float hi) { f32x2 f = {lo, hi}; bf16x2_t v = __builtin_convertvector(f, bf16x2_t); return __builtin_bit_cast(unsigned, v); }
__device__ __forceinline__ float bflo(unsigned w) { return __uint_as_float(w << 16); }
__device__ __forceinline__ float bfhi(unsigned w) { return __uint_as_float(w & 0xffff0000u); }
__device__ __forceinline__ u32x4 pack8(f32x4 a, f32x4 b) { u32x4 w; w.x = cvt_pk_bf16(a[0], a[1]); w.y = cvt_pk_bf16(a[2], a[3]); w.z = cvt_pk_bf16(b[0], b[1]); w.w = cvt_pk_bf16(b[2], b[3]); return w; }
constexpr int MOE_RB = MOE_FP8 ? 1024 : 2048;
constexpr float MOE_WSC = MOE_FP8 ? 64.0f : 1.0f, MOE_INV = 1.0f / MOE_WSC;
__device__ __forceinline__ u32x2 pack8_fp8(f32x4 a, f32x4 b) { int lo = 0, hi = 0;
    lo = __builtin_amdgcn_cvt_pk_fp8_f32(a[0], a[1], lo, false); lo = __builtin_amdgcn_cvt_pk_fp8_f32(a[2], a[3], lo, true);
    hi = __builtin_amdgcn_cvt_pk_fp8_f32(b[0], b[1], hi, false); hi = __builtin_amdgcn_cvt_pk_fp8_f32(b[2], b[3], hi, true);
    u32x2 r; r.x = (unsigned)lo; r.y = (unsigned)hi; return r; }
__device__ __forceinline__ void unpack8(u32x4 w, f32x4& a, f32x4& b) { a[0] = bflo(w.x); a[1] = bfhi(w.x); a[2] = bflo(w.y); a[3] = bfhi(w.y); b[0] = bflo(w.z); b[1] = bfhi(w.z); b[2] = bflo(w.w); b[3] = bfhi(w.w); }
__device__ __forceinline__ float wave_sum(float v) {
#pragma unroll
    for (int o = 1; o < 64; o <<= 1) v += __shfl_xor(v, o);
    return v;
}
__device__ __forceinline__ float fast_rcp(float x) { return __builtin_amdgcn_rcpf(x); }
__device__ __forceinline__ float sigmoid_f(float x) { return fast_rcp(1.0f + __expf(-x)); }
__device__ __forceinline__ float silu_f(float x) { return x * sigmoid_f(x); }

#define XB_TMO      128
#define XB_XCNT(j)  (256  + 64 * (j))
#define XB_XSUB(j)  (1280 + 64 * (j))
#define XB_XGEN(j)  (2304 + 64 * (j))
#define XB_TOP      3328
#define XB_TOPGEN   3392
#define XCD_BAR_WORDS 3456
#define XB_SPIN_CAP (1u << 18)
__device__ __forceinline__ unsigned xb_ld(unsigned* p)              { return __hip_atomic_load(p, __ATOMIC_RELAXED, __HIP_MEMORY_SCOPE_AGENT); }
__device__ __forceinline__ unsigned xb_add(unsigned* p, unsigned v) { return __hip_atomic_fetch_add(p, v, __ATOMIC_RELAXED, __HIP_MEMORY_SCOPE_AGENT); }
__device__ __forceinline__ unsigned xb_xcc_id() { return (unsigned)__builtin_amdgcn_s_getreg((3 << 11) | 20) & 0xFu; }
#define XB_SPIN(cond, bar) do { unsigned _sp = 0; while (cond) { __builtin_amdgcn_s_sleep(1); \
    if ((++_sp & 255u) == 0u) { if (xb_ld(&(bar)[XB_TMO])) break; if (_sp > XB_SPIN_CAP) { atomicAdd(&(bar)[XB_TMO], 1u); break; } } } } while (0)
struct XcdBarrier { unsigned* bar; unsigned x; volatile LAS unsigned* st; };
__device__ __forceinline__ XcdBarrier xcd_barrier_post(unsigned* bar, volatile LAS unsigned* st) {
    XcdBarrier b; b.bar = bar; b.x = xb_xcc_id(); b.st = st;
    if (threadIdx.x == 0) (void)xb_add(&bar[XB_XCNT(b.x)], 1u);
    return b;
}
__device__ __forceinline__ void xcd_barrier_complete(unsigned* bar, unsigned x, unsigned& nloc, unsigned& nx) {
    const unsigned G = gridDim.x * gridDim.y * gridDim.z;
    unsigned sum, cnt, mine, sp = 0u;
    for (;;) {
        sum = 0u; cnt = 0u;
#pragma nounroll
        for (unsigned j = 0; j < 16; ++j) { const unsigned c = xb_ld(&bar[XB_XCNT(j)]); sum += c; cnt += (c > 0u) ? 1u : 0u; }
        if (sum == G) break;
        __builtin_amdgcn_s_sleep(1);
        if ((++sp & 255u) == 0u) { if (xb_ld(&bar[XB_TMO])) break; if (sp > XB_SPIN_CAP) { atomicAdd(&bar[XB_TMO], 1u); break; } }
    }
    mine = xb_ld(&bar[XB_XCNT(x)]);
    nloc = mine > 0u ? mine : 1u; nx = cnt > 0u ? cnt : 1u;
}
__device__ __forceinline__ void xcd_barrier(const XcdBarrier& b) {
    asm volatile("s_waitcnt vmcnt(0)" ::: "memory");
    __syncthreads();
    if (threadIdx.x == 0) {
        unsigned* bar = b.bar;
        __builtin_amdgcn_s_waitcnt(0);
        unsigned nloc = b.st[0], nx = b.st[1];
        if (nloc == 0u) { xcd_barrier_complete(bar, b.x, nloc, nx); b.st[0] = nloc; b.st[1] = nx; }
        const unsigned old = xb_add(&bar[XB_XSUB(b.x)], 1u);
        const unsigned gen = old / nloc;
        if (old + 1u == (gen + 1u) * nloc) {
            __builtin_amdgcn_fence(__ATOMIC_RELEASE, "agent");
            asm volatile("s_waitcnt vmcnt(0)" ::: "memory");
            const unsigned og = xb_add(&bar[XB_TOP], 1u);
            const unsigned tg = og / nx;
            if (og + 1u == (tg + 1u) * nx) xb_add(&bar[XB_TOPGEN], 1u);
            else XB_SPIN(xb_ld(&bar[XB_TOPGEN]) == tg, bar);
            __builtin_amdgcn_fence(__ATOMIC_ACQUIRE, "agent");
            xb_add(&bar[XB_XGEN(b.x)], 1u);
            asm volatile("s_waitcnt vmcnt(0)" ::: "memory");
        } else {
            XB_SPIN(xb_ld(&bar[XB_XGEN(b.x)]) == gen, bar);
            __builtin_amdgcn_fence(__ATOMIC_ACQUIRE, "agent");
            asm volatile("s_waitcnt vmcnt(0)" ::: "memory");
        }
    }
    __syncthreads();
}

namespace pg8 {
constexpr int BM = 256, BK = 64, HALF = 128, HTB = HALF * BK * 2, STAGE_BYTES = 8 * HTB, NXCD = 8, WGM = 8, KD = 1024;
__host__ __device__ __forceinline__ int lds_byte(int r, int c) { const int st = (r >> 4) * 2 + (c >> 5), rr = r & 15, cc = c & 31, ob = rr * 64 + cc * 2; return st * 1024 + (ob ^ (((ob >> 9) & 1) << 5)); }
__host__ __device__ __forceinline__ void stage_rc(int b, int& R, int& C) { const int st = b / 1024, sb = b % 1024, swz = sb ^ (((sb >> 9) & 1) << 5); R = (st >> 1) * 16 + swz / 64; C = (st & 1) * 32 + (swz % 64) / 2; }
__host__ __device__ __forceinline__ int perm32(int rho) { const int n = rho >> 4, i = rho & 15; return 8 * (i >> 2) + 4 * n + (i & 3); }
struct Unit { int pm, pn, ex; };
struct StaticOrder {
    int nM, nN, nwg, G, c;
    __device__ void init(int M, int N, int G_, int c_) { nM = M / BM; nN = N / BM; nwg = nM * nN; G = G_; c = c_; }
    __device__ bool next(int i, Unit& u) const {
        const long L = (long)i * G + c; if (L >= nwg) return false;
        int wgid = (int)L; { const int q = nwg / NXCD, r = nwg % NXCD, xcd = wgid % NXCD, off = wgid / NXCD; wgid = (xcd < r ? xcd * (q + 1) : r * (q + 1) + (xcd - r) * q) + off; }
        const int nig = WGM * nN, gid = wgid / nig, fm = gid * WGM, gsz = (nM - fm) < WGM ? (nM - fm) : WGM;
        u.pm = fm + ((wgid % nig) % gsz); u.pn = (wgid % nig) / gsz; u.ex = 0; return true;
    }
};
typedef int i32x8 __attribute__((ext_vector_type(8)));
typedef int i32x4v __attribute__((ext_vector_type(4)));
template <class Epi, class Sched, bool GATHER, int KE = 1024, bool FP8 = false>
__device__ __forceinline__ void gemm_phase(LAS unsigned char* lds, const Sched& S, const Epi& E) {
    int tid = threadIdx.x; asm volatile("" : "+v"(tid));
    const int wid = __builtin_amdgcn_readfirstlane(tid >> 6), lane = tid & 63, wr = wid >> 2, wc = wid & 3, fr = lane & 15, fq = lane >> 4;
    constexpr int K = KE, nt = K / BK;
    unsigned voffA[2], voffB[2]; int Rr[2], Cc[2];
#pragma unroll
    for (int i = 0; i < 2; ++i) { int R, C; stage_rc(tid * 16 + i * 8192, R, C); const int Rb = Epi::PERM ? ((R & ~31) + perm32(R & 31)) : R;
        voffA[i] = (unsigned)(R * K + C) * 2u; voffB[i] = (unsigned)(Rb * K + C) * 2u; Rr[i] = R; Cc[i] = C; }
    constexpr size_t kstep = (size_t)(BK * 2);
    constexpr size_t hstep = (size_t)HALF * K * 2;
    const unsigned ldsw = (unsigned)wid * 1024u;
    const int aoff = lds_byte(wr * 64 + fr, fq * 8), boff = lds_byte(wc * 32 + fr, fq * 8);
#define PG8_SA(b, h) (((b) * 2 + (h)) * HTB)
#define PG8_SB(b, h) ((4 + (b) * 2 + (h)) * HTB)
#define PG8_STAGE(bufoff, gbase, voff) do { _Pragma("unroll") for (int _i = 0; _i < 2; ++_i) \
        __builtin_amdgcn_global_load_lds((const unsigned*)((const char*)(gbase) + (voff)[_i]), (LAS unsigned*)(lds + (bufoff) + ldsw + _i * 8192), 16, 0, 0); } while (0)
#define PG8_STAGE_A(bufoff, gb, h, o0, o1) do { if constexpr (GATHER) { const unsigned _ko = (unsigned)((gb) - gA0); unsigned _o[2]; \
            if ((h) == 0) { _o[0] = (o0)[0] + _ko; _o[1] = (o0)[1] + _ko; } else { _o[0] = (o1)[0] + _ko; _o[1] = (o1)[1] + _ko; } PG8_STAGE(bufoff, gA0, _o); } \
        else { PG8_STAGE(bufoff, (gb) + (h) * hstep, voffA); } } while (0)
#define PG8_LD8(p) __builtin_shufflevector(*(const LAS i32x4v*)(p), *(const LAS i32x4v*)((p) + 1024), 0, 1, 2, 3, 4, 5, 6, 7)
#define PG8_LDA(dst, b, h) do { if constexpr (FP8) { _Pragma("unroll") for (int m = 0; m < 4; ++m) dst##8[m] = PG8_LD8(lds + PG8_SA(b, h) + aoff + m * 2048); } \
        else { _Pragma("unroll") for (int m = 0; m < 4; ++m) _Pragma("unroll") for (int k = 0; k < 2; ++k) dst[m][k] = *(const LAS bf16x8*)(lds + PG8_SA(b, h) + aoff + m * 2048 + k * 1024); } } while (0)
#define PG8_LDB(dst, b, h) do { if constexpr (FP8) { _Pragma("unroll") for (int n = 0; n < 2; ++n) dst##8[n] = PG8_LD8(lds + PG8_SB(b, h) + boff + n * 2048); } \
        else { _Pragma("unroll") for (int n = 0; n < 2; ++n) _Pragma("unroll") for (int k = 0; k < 2; ++k) dst[n][k] = *(const LAS bf16x8*)(lds + PG8_SB(b, h) + boff + n * 2048 + k * 1024); } } while (0)
#define PG8_MMA(ai, bj, At, Bt) do { __builtin_amdgcn_s_setprio(1); if constexpr (FP8) { _Pragma("unroll") for (int m = 0; m < 4; ++m) _Pragma("unroll") for (int n = 0; n < 2; ++n) \
            asm volatile("v_mfma_scale_f32_16x16x128_f8f6f4 %0, %1, %2, %0, %3, %3 op_sel_hi:[0,0,0]" : "+v"(acc[ai][bj][m][n]) : "v"(Bt##8[n]), "v"(At##8[m]), "v"(sc127)); } \
        else { _Pragma("unroll") for (int m = 0; m < 4; ++m) _Pragma("unroll") for (int n = 0; n < 2; ++n) _Pragma("unroll") for (int k = 0; k < 2; ++k) \
            acc[ai][bj][m][n] = __builtin_amdgcn_mfma_f32_16x16x32_bf16(Bt[n][k], At[m][k], acc[ai][bj][m][n], 0, 0, 0); } __builtin_amdgcn_s_setprio(0); } while (0)
#define PG8_WAIT_V(n) asm volatile("s_waitcnt vmcnt(" #n ")" ::: "memory")
#define PG8_WAIT_L(n) asm volatile("s_waitcnt lgkmcnt(" #n ")" ::: "memory")
#define PG8_BAR __builtin_amdgcn_s_barrier()
#define PG8_SCHED __builtin_amdgcn_sched_barrier(0)
    Unit cur, nxt; int ui = 0;
    if (!S.next(0, cur)) return;
    f32x4 acc[2][2][4][2];
#pragma unroll
    for (int a = 0; a < 2; ++a)
#pragma unroll
        for (int b = 0; b < 2; ++b)
#pragma unroll
            for (int m = 0; m < 4; ++m)
#pragma unroll
                for (int n = 0; n < 2; ++n) acc[a][b][m][n] = (f32x4){0.f, 0.f, 0.f, 0.f};
    const int sc127 = 0x7f7f7f7f;
    bf16x8 At[4][2], B0[2][2], B1[2][2]; i32x8 At8[4], B08[2], B18[2];
    const char* cA = S.a_base(cur); const char* cB = S.b_base(cur);
    const char* const gA0 = cA;
    unsigned cv0[2] = {0u, 0u}, cv1[2] = {0u, 0u}, nv0[2] = {0u, 0u}, nv1[2] = {0u, 0u};
    if constexpr (GATHER) S.a_offs(cur, Rr, Cc, cv0, cv1);
    PG8_STAGE(PG8_SB(0, 0), cB, voffB); PG8_STAGE_A(PG8_SA(0, 0), cA, 0, cv0, cv1); PG8_STAGE(PG8_SB(0, 1), cB + hstep, voffB); PG8_STAGE_A(PG8_SA(0, 1), cA, 1, cv0, cv1);
    if (wr == 1) PG8_BAR;
    PG8_WAIT_V(4); PG8_BAR;
    PG8_STAGE(PG8_SB(1, 0), cB + kstep, voffB); PG8_STAGE_A(PG8_SA(1, 0), cA + kstep, 0, cv0, cv1); PG8_STAGE(PG8_SB(1, 1), cB + hstep + kstep, voffB);
    PG8_WAIT_V(6); PG8_BAR;
    for (;;) {
        const bool has_next = S.next(ui + 1, nxt);
        const char* nA = has_next ? S.a_base(nxt) : cA; const char* nB = has_next ? S.b_base(nxt) : cB;
        if constexpr (GATHER) { if (has_next) S.a_offs(nxt, Rr, Cc, nv0, nv1); else { nv0[0] = cv0[0]; nv0[1] = cv0[1]; nv1[0] = cv1[0]; nv1[1] = cv1[1]; } }
#pragma nounroll
        for (int t = 0; t < nt; t += 2) {
            const bool last = (t == nt - 2);
            const char* a1 = cA + (size_t)(t + 1) * kstep;
            const char* a2 = last ? nA : cA + (size_t)(t + 2) * kstep; const char* b2 = last ? nB : cB + (size_t)(t + 2) * kstep;
            const char* a3 = a2 + kstep; const char* b3 = b2 + kstep;
            unsigned s0[2], s1[2];
            if constexpr (GATHER) { s0[0] = last ? nv0[0] : cv0[0]; s0[1] = last ? nv0[1] : cv0[1]; s1[0] = last ? nv1[0] : cv1[0]; s1[1] = last ? nv1[1] : cv1[1]; } else { s0[0] = s0[1] = s1[0] = s1[1] = 0u; }
            PG8_LDB(B0, 0, 0); PG8_SCHED; PG8_LDA(At, 0, 0); PG8_STAGE_A(PG8_SA(1, 1), a1, 1, cv0, cv1);
            PG8_WAIT_L(8); PG8_BAR; PG8_WAIT_L(0); PG8_MMA(0, 0, At, B0); PG8_BAR; PG8_SCHED;
            PG8_LDB(B1, 0, 1); PG8_STAGE(PG8_SB(0, 0), b2, voffB);
            PG8_BAR; PG8_WAIT_L(0); PG8_MMA(0, 1, At, B1); PG8_BAR;
            PG8_LDA(At, 0, 1); PG8_STAGE_A(PG8_SA(0, 0), a2, 0, s0, s1);
            PG8_BAR; PG8_WAIT_L(0); PG8_MMA(1, 0, At, B0); PG8_BAR; PG8_SCHED;
            PG8_STAGE(PG8_SB(0, 1), b2 + hstep, voffB);
            PG8_WAIT_V(6); PG8_BAR; PG8_MMA(1, 1, At, B1); PG8_BAR;
            PG8_LDB(B0, 1, 0); PG8_SCHED; PG8_LDA(At, 1, 0); PG8_STAGE_A(PG8_SA(0, 1), a2, 1, s0, s1);
            PG8_WAIT_L(8); PG8_BAR; PG8_WAIT_L(0); PG8_MMA(0, 0, At, B0); PG8_BAR; PG8_SCHED;
            PG8_LDB(B1, 1, 1); PG8_STAGE(PG8_SB(1, 0), b3, voffB);
            PG8_BAR; PG8_WAIT_L(0); PG8_MMA(0, 1, At, B1); PG8_BAR;
            PG8_LDA(At, 1, 1); PG8_STAGE_A(PG8_SA(1, 0), a3, 0, s0, s1);
            PG8_BAR; PG8_WAIT_L(0); PG8_MMA(1, 0, At, B0); PG8_BAR; PG8_SCHED;
            PG8_STAGE(PG8_SB(1, 1), b3 + hstep, voffB);
            PG8_WAIT_V(6); PG8_BAR; PG8_MMA(1, 1, At, B1); PG8_BAR;
        }
        if constexpr (FP8) asm volatile("s_nop 15\n\ts_nop 15" ::: "memory");
        E(acc, cur, wr, wc, fr, fq);
        if (!has_next) break;
#pragma unroll
        for (int a = 0; a < 2; ++a)
#pragma unroll
            for (int b = 0; b < 2; ++b)
#pragma unroll
                for (int m = 0; m < 4; ++m)
#pragma unroll
                    for (int n = 0; n < 2; ++n) acc[a][b][m][n] = (f32x4){0.f, 0.f, 0.f, 0.f};
        cur = nxt; cA = nA; cB = nB; ++ui;
        if constexpr (GATHER) { cv0[0] = nv0[0]; cv0[1] = nv0[1]; cv1[0] = nv1[0]; cv1[1] = nv1[1]; }
    }
    PG8_WAIT_V(0);
    if (wr == 0) PG8_BAR;
    PG8_BAR;
#undef PG8_SA
#undef PG8_SB
#undef PG8_STAGE
#undef PG8_STAGE_A
#undef PG8_LDA
#undef PG8_LDB
#undef PG8_MMA
#undef PG8_LD8
#undef PG8_WAIT_V
#undef PG8_WAIT_L
#undef PG8_BAR
#undef PG8_SCHED
}
}
using pg8::Unit;
typedef f32x4 AccT[2][2][4][2];

struct Args { const float* in[28]; float* out; unsigned char* ws; int ph_lo, ph_hi, pad0, pad1; };
struct Frame {
    LAS unsigned char* lds;
    int tid, lane, wave, G, bid;
    const struct Args* a;
    unsigned char* ws; unsigned char* outb;
};
template <int RB = 2048> struct SchedPlainT {
    pg8::StaticOrder o; const char* A; const char* Bt;
    __device__ __forceinline__ bool next(int i, Unit& u) const { return o.next(i, u); }
    __device__ __forceinline__ const char* a_base(const Unit& u) const { return A + (size_t)u.pm * (256 * RB); }
    __device__ __forceinline__ const char* b_base(const Unit& u) const { return Bt + (size_t)u.pn * (256 * RB); }
    __device__ __forceinline__ void a_offs(const Unit&, const int*, const int*, unsigned (&)[2], unsigned (&)[2]) const {}
};
typedef SchedPlainT<2048> SchedPlain;
template <int MODE> struct SchedProj {
    pg8::StaticOrder o; const char* A; const char* Bt;
    static constexpr int RB = MODE == 2 ? 1024 : 2048;
    __device__ __forceinline__ bool next(int i, Unit& u) const { if (!o.next(i, u)) return false; const int r = u.pn;
        if (MODE == 1) u.pn = 4 + r;
        if (MODE == 2) u.pn = r < 4 ? r : 15 + r;
        return true; }
    __device__ __forceinline__ const char* a_base(const Unit& u) const { return A + (size_t)u.pm * (256 * RB); }
    __device__ __forceinline__ const char* b_base(const Unit& u) const { return Bt + (size_t)u.pn * (256 * RB); }
    __device__ __forceinline__ void a_offs(const Unit&, const int*, const int*, unsigned (&)[2], unsigned (&)[2]) const {}
};

struct EpiProj {
    static constexpr bool PERM = true;
    bf16_t *Q, *IQ, *Z, *XBC, *GA, *GB; float* MISC; float sc;
    __device__ __forceinline__ void operator()(const AccT& acc, const Unit& u, int wr, int wc, int fr, int fq) const {
        const int pn = u.pn, row0 = u.pm * 256 + wr * 64 + fr, c8 = wc * 32 + 8 * fq;
        if (pn == 6) {
#pragma unroll
            for (int ai = 0; ai < 2; ++ai)
#pragma unroll
                for (int m = 0; m < 4; ++m) { float* rp = MISC + (size_t)(row0 + ai * 128 + m * 16) * 256 + c8;
#pragma unroll
                    for (int bj = 0; bj < 2; ++bj) { *(f32x4*)(rp + bj * 128) = acc[ai][bj][m][0]; *(f32x4*)(rp + bj * 128 + 4) = acc[ai][bj][m][1]; } }
            return;
        }
        bf16_t* base; int ldc, colt, act = 0;
        if (pn < 4) { base = Q; ldc = 1024; colt = pn * 256; }
        else if (pn < 6) { base = IQ; ldc = 512; colt = (pn - 4) * 256; }
        else if (pn < 11) { base = Z; ldc = 1024; colt = (pn - 7) * 256; act = 1; }
        else if (pn < 19) { base = XBC; ldc = 2048; colt = (pn - 11) * 256; }
        else if (pn < 23) { base = GA; ldc = 1024; colt = (pn - 19) * 256; act = 2; }
        else { base = GB; ldc = 1024; colt = (pn - 23) * 256; act = 2; }
#pragma unroll
        for (int ai = 0; ai < 2; ++ai)
#pragma unroll
            for (int m = 0; m < 4; ++m) { bf16_t* rp = base + (size_t)(row0 + ai * 128 + m * 16) * ldc + colt + c8;
#pragma unroll
                for (int bj = 0; bj < 2; ++bj) { f32x4 v0 = acc[ai][bj][m][0] * sc, v1 = acc[ai][bj][m][1] * sc;
                    if (act == 1) {
#pragma unroll
                        for (int j = 0; j < 4; ++j) { v0[j] = silu_f(v0[j]); v1[j] = silu_f(v1[j]); } }
                    if (act == 2) {
#pragma unroll
                        for (int j = 0; j < 4; ++j) { v0[j] = sigmoid_f(v0[j]); v1[j] = sigmoid_f(v1[j]); } }
                    u32x4 pk = pack8(v0, v1); if (DBG_IQ_TRUNC && (pn == 4 || pn == 5)) { pk.x &= 0xfff8fff8u; pk.y &= 0xfff8fff8u; pk.z &= 0xfff8fff8u; pk.w &= 0xfff8fff8u; }
                    *(u32x4*)(rp + bj * 128) = pk; } }
    }
};
template <int MODE> struct EpiGate {
    static constexpr bool PERM = true;
    const bf16_t* Gt; const bf16_t* T; bf16_t* O; float sc;
    __device__ __forceinline__ void operator()(const AccT& acc, const Unit& u, int wr, int wc, int fr, int fq) const {
        const int row0 = u.pm * 256 + wr * 64 + fr, c8 = u.pn * 256 + wc * 32 + 8 * fq;
#pragma unroll
        for (int ai = 0; ai < 2; ++ai)
#pragma unroll
            for (int m = 0; m < 4; ++m) { const size_t off = (size_t)(row0 + ai * 128 + m * 16) * 1024 + c8;
#pragma unroll
                for (int bj = 0; bj < 2; ++bj) { f32x4 g0, g1; unpack8(*(const u32x4*)(Gt + off + bj * 128), g0, g1);
                    f32x4 v0 = g0 * (acc[ai][bj][m][0] * sc), v1 = g1 * (acc[ai][bj][m][1] * sc);
                    if ((MODE == 0 && DBG_NO_ATTN) || (MODE == 1 && DBG_NO_SSD)) { v0 = (f32x4){0.f, 0.f, 0.f, 0.f}; v1 = v0; }
                    if (MODE == 1) { f32x4 t0, t1; unpack8(*(const u32x4*)(T + off + bj * 128), t0, t1); v0 += t0; v1 += t1; }
                    *(u32x4*)(O + off + bj * 128) = pack8(v0, v1); } }
    }
};
struct EpiOut {
    static constexpr bool PERM = false;
    const float* x; const float* mod; float* V;
    __device__ __forceinline__ void operator()(const AccT& acc, const Unit& u, int wr, int wc, int fr, int fq) const {
        const int row0 = u.pm * 256 + wr * 64 + fr, col0 = u.pn * 256 + wc * 32 + 4 * fq;
        const float* g1 = mod + (size_t)(u.pm >> 3) * 6144 + 2048 + col0;
        f32x4 gv[2][2];
#pragma unroll
        for (int bj = 0; bj < 2; ++bj)
#pragma unroll
            for (int n = 0; n < 2; ++n) gv[bj][n] = *(const f32x4*)(g1 + bj * 128 + n * 16);
#pragma unroll
        for (int ai = 0; ai < 2; ++ai)
#pragma unroll
            for (int m = 0; m < 4; ++m) { const size_t off = (size_t)(row0 + ai * 128 + m * 16) * 1024 + col0;
#pragma unroll
                for (int bj = 0; bj < 2; ++bj)
#pragma unroll
                    for (int n = 0; n < 2; ++n) { const f32x4 xv = *(const f32x4*)(x + off + bj * 128 + n * 16);
                        *(f32x4*)(V + off + bj * 128 + n * 16) = xv * DN_ALPHA + gv[bj][n] * acc[ai][bj][m][n]; } }
    }
};

struct MoeTab { LAS unsigned* cnt; LAS unsigned* tb; LAS unsigned char* te; int ntiles; };
__device__ __forceinline__ MoeTab moe_tables(Frame& F, int hf) {
    MoeTab T; T.cnt = (LAS unsigned*)(F.lds + LDS_AUX); T.tb = (LAS unsigned*)(F.lds + LDS_AUX + 256); T.te = (LAS unsigned char*)(F.lds + LDS_AUX + 512);
    const unsigned* CNT = (const unsigned*)(F.ws + WS_CTL) + CW_CNT;
    __syncthreads();
    if (F.tid < 32) { unsigned c = __hip_atomic_load(CNT + 64 * (hf * 32 + F.tid), __ATOMIC_RELAXED, __HIP_MEMORY_SCOPE_AGENT); if (c > (unsigned)REG_CAP) c = REG_CAP; T.cnt[F.tid] = c; }
    __syncthreads();
    if (F.tid == 0) { unsigned s = 0;
#pragma nounroll
        for (int e = 0; e < 32; ++e) { T.tb[e] = s; const unsigned n = (T.cnt[e] + 255u) >> 8;
#pragma nounroll
            for (unsigned t = 0; t < n; ++t) T.te[s + t] = (unsigned char)e;
            s += n; }
        T.tb[32] = s; }
    __syncthreads();
    T.ntiles = __builtin_amdgcn_readfirstlane((int)T.tb[32]);
    return T;
}
template <int NJ, bool GATHER> struct SchedMoe {
    MoeTab T; int G, c, hf; const char* A; const char* Bt; const u32x2* REG;
    __device__ __forceinline__ bool next(int i, Unit& u) const {
        int tile, j;
        if (G == 256) { const int x = c & 7, sl = c >> 3;
            tile = i * (256 / NJ) + x * (32 / NJ) + sl / NJ; j = sl % NJ;
            if (tile >= T.ntiles) return false; }
        else { const int L = i * G + c; if (L >= T.ntiles * NJ) return false; tile = L / NJ; j = L % NJ; }
        u.pm = tile; u.pn = j; u.ex = __builtin_amdgcn_readfirstlane((int)T.te[u.pm]); return true;
    }
    __device__ __forceinline__ const char* a_base(const Unit& u) const { return GATHER ? A : A + (size_t)u.pm * (256 * MOE_RB); }
    __device__ __forceinline__ const char* b_base(const Unit& u) const { return Bt + ((size_t)u.ex * (NJ * 256) + (size_t)u.pn * 256) * MOE_RB; }
    __device__ __forceinline__ void a_offs(const Unit& u, const int* R, const int* C, unsigned (&o0)[2], unsigned (&o1)[2]) const {
        const unsigned cnt = __builtin_amdgcn_readfirstlane(T.cnt[u.ex]), pos0 = ((unsigned)u.pm - (unsigned)__builtin_amdgcn_readfirstlane(T.tb[u.ex])) * 256u; const u32x2* rg = REG + ((size_t)hf * 32 + u.ex) * REG_CAP;
#pragma unroll
        for (int i = 0; i < 2; ++i) {
            const unsigned p0 = pos0 + (unsigned)R[i], p1 = p0 + 128u;
            unsigned t0 = 0u, t1 = 0u;
            if (p0 < cnt) t0 = (unsigned)hf * HALF_TOK + (rg[p0].x >> 2);
            if (p1 < cnt) t1 = (unsigned)hf * HALF_TOK + (rg[p1].x >> 2);
            o0[i] = t0 * (unsigned)MOE_RB + (unsigned)C[i] * 2u; o1[i] = t1 * (unsigned)MOE_RB + (unsigned)C[i] * 2u;
        }
    }
};
struct EpiMoe1 {
    static constexpr bool PERM = true;
    const float* b1; bf16_t* ACT; int dry;
    __device__ __forceinline__ void operator()(const AccT& acc, const Unit& u, int wr, int wc, int fr, int fq) const {
        if (dry) { if (acc[0][0][0][0][0] == 1.2345e-33f) ACT[0] = 1; return; }
        const int row0 = u.pm * 256 + wr * 64 + fr, c8 = u.pn * 128 + wc * 32 + 8 * fq;
        const float* bg = b1 + (size_t)u.ex * 2048 + c8;
        const f32x4 bg0 = *(const f32x4*)bg, bg1 = *(const f32x4*)(bg + 4), bu0 = *(const f32x4*)(bg + 1024), bu1 = *(const f32x4*)(bg + 1028);
#pragma unroll
        for (int ai = 0; ai < 2; ++ai)
#pragma unroll
            for (int m = 0; m < 4; ++m) {
                f32x4 g0 = acc[ai][0][m][0] * MOE_INV + bg0, g1 = acc[ai][0][m][1] * MOE_INV + bg1, u0 = acc[ai][1][m][0] * MOE_INV + bu0, u1 = acc[ai][1][m][1] * MOE_INV + bu1, a0, a1;
#pragma unroll
                for (int j = 0; j < 4; ++j) {
                    float g = fminf(g0[j], 7.0f), up = fminf(fmaxf(u0[j], -7.0f), 7.0f); a0[j] = (up + 1.0f) * g * sigmoid_f(1.702f * g);
                    g = fminf(g1[j], 7.0f); up = fminf(fmaxf(u1[j], -7.0f), 7.0f); a1[j] = (up + 1.0f) * g * sigmoid_f(1.702f * g); }
                if (MOE_FP8) *(u32x2*)((unsigned char*)ACT + (size_t)(row0 + ai * 128 + m * 16) * 1024 + c8) = pack8_fp8(a0, a1);
                else *(u32x4*)(ACT + (size_t)(row0 + ai * 128 + m * 16) * 1024 + c8) = pack8(a0, a1); }
    }
};
struct EpiMoe2 {
    static constexpr bool PERM = true;
    const float* b2; bf16_t* YB; const u32x2* REG; MoeTab T; int hf; int dry;
    __device__ __forceinline__ void operator()(const AccT& acc, const Unit& u, int wr, int wc, int fr, int fq) const {
        if (dry == 1) { if (acc[0][0][0][0][0] == 1.2345e-33f) YB[0] = 1; return; }
        if (dry >= 2) {
            const int c8d = (dry == 3 ? 0 : u.pn * 256) + wc * 32 + 8 * fq; const unsigned rowd = dry == 3 ? (blockIdx.x * 256u + (unsigned)(wr * 64 + fr)) : ((unsigned)u.pm * 256u + (unsigned)(wr * 64 + fr)) % 131072u;
#pragma unroll
            for (int ai = 0; ai < 2; ++ai)
#pragma unroll
                for (int m = 0; m < 4; ++m) { bf16_t* rp = YB + (size_t)((rowd + ai * 128 + m * 16) % 131072u) * 1024 + c8d;
#pragma unroll
                    for (int bj = 0; bj < 2; ++bj) *(u32x4*)(rp + bj * 128) = pack8(acc[ai][bj][m][0] * MOE_INV, acc[ai][bj][m][1] * MOE_INV); }
            return; }
        const int c8 = u.pn * 256 + wc * 32 + 8 * fq;
        const unsigned cnt = __builtin_amdgcn_readfirstlane(T.cnt[u.ex]), pos0 = ((unsigned)u.pm - (unsigned)__builtin_amdgcn_readfirstlane(T.tb[u.ex])) * 256u + (unsigned)(wr * 64 + fr); const u32x2* rg = REG + ((size_t)hf * 32 + u.ex) * REG_CAP;
        const float* bb = b2 + (size_t)u.ex * 1024 + c8;
        f32x4 bv[2][2];
#pragma unroll
        for (int bj = 0; bj < 2; ++bj) { bv[bj][0] = *(const f32x4*)(bb + bj * 128); bv[bj][1] = *(const f32x4*)(bb + bj * 128 + 4); }
        u32x2 en8[2][4];
#pragma unroll
        for (int ai = 0; ai < 2; ++ai)
#pragma unroll
            for (int m = 0; m < 4; ++m) { const unsigned p = pos0 + (unsigned)(ai * 128 + m * 16); en8[ai][m] = rg[p < cnt ? p : cnt - 1u]; }
#pragma unroll
        for (int ai = 0; ai < 2; ++ai)
#pragma unroll
            for (int m = 0; m < 4; ++m) { const unsigned p = pos0 + (unsigned)(ai * 128 + m * 16);
                const u32x2 en = en8[ai][m]; const float g = __uint_as_float(en.y); const unsigned drow = p < cnt ? en.x : (unsigned)(HALF_TOK * 4);
                bf16_t* rp = YB + (size_t)drow * 1024 + c8;
#pragma unroll
                for (int bj = 0; bj < 2; ++bj) *(u32x4*)(rp + bj * 128) = pack8((acc[ai][bj][m][0] * MOE_INV + bv[bj][0]) * g, (acc[ai][bj][m][1] * MOE_INV + bv[bj][1]) * g); }
    }
};

struct MapIdent { __device__ __forceinline__ int operator()(int n) const { return n; } };
struct MapWin { __device__ __forceinline__ int operator()(int n) const {
    if (n < 1024) return n;
    if (n < 1536) return 1152 + (n - 1024);
    if (n < 1792) { const int c = n - 1536; if (c < 128) return 1024 + c; if (c < 192) return 1664 + (c - 128); if (c < 200) return 1728 + (c - 192); if (c < 216) return 4808 + (c - 200); return -1; }
    if (n < 2816) return 1736 + (n - 1792);
    if (n < 4864) return 2760 + (n - 2816);
    if (n < 5888) return 4824 + (n - 4864);
    return 5848 + (n - 5888); } };
struct MapW1 { __device__ __forceinline__ int operator()(int r) const { const int j = r >> 8, rr = r & 255; return (rr >> 7) * 1024 + j * 128 + (rr & 127); } };
template <class Map, bool F8 = false> __device__ __forceinline__ void transpose_item(const float* W, int K, int N, bf16_t* WT, const Map& map, LAS float* scr, int kb, int nb, int lane, const float* rowscale) {
    const int k0 = 64 * kb, n0 = 64 * nb, q = lane & 15, kr = lane >> 4; const int src = map(n0 + 4 * q);
    f32x4 ld[16];
#pragma unroll
    for (int i = 0; i < 16; ++i) { const int kk = 4 * i + kr; ld[i] = (src >= 0) ? *(const f32x4*)(W + (size_t)(k0 + kk) * N + src) : (f32x4){0.f, 0.f, 0.f, 0.f}; }
#pragma unroll
    for (int i = 0; i < 16; ++i) { const int kk = 4 * i + kr; f32x4 v = ld[i]; if (rowscale) v = v * rowscale[k0 + kk]; LAS float* d = scr + kk * 65 + 4 * q; d[0] = v[0]; d[1] = v[1]; d[2] = v[2]; d[3] = v[3]; }
    LDS_WAIT(); asm volatile("" ::: "memory");
    const int c = lane & 7;
#pragma unroll
    for (int j = 0; j < 8; ++j) { const int n = (lane >> 3) + 8 * j; const LAS float* s = scr + (8 * c) * 65 + n;
        if constexpr (F8) { const f32x4 a = {s[0 * 65] * MOE_WSC, s[1 * 65] * MOE_WSC, s[2 * 65] * MOE_WSC, s[3 * 65] * MOE_WSC}, b = {s[4 * 65] * MOE_WSC, s[5 * 65] * MOE_WSC, s[6 * 65] * MOE_WSC, s[7 * 65] * MOE_WSC};
            *(u32x2*)((unsigned char*)WT + (size_t)(n0 + n) * K + k0 + 8 * c) = pack8_fp8(a, b); }
        else { u32x4 o; o.x = cvt_pk_bf16(s[0 * 65], s[1 * 65]); o.y = cvt_pk_bf16(s[2 * 65], s[3 * 65]); o.z = cvt_pk_bf16(s[4 * 65], s[5 * 65]); o.w = cvt_pk_bf16(s[6 * 65], s[7 * 65]);
            *(u32x4*)(WT + (size_t)(n0 + n) * K + k0 + 8 * c) = o; } }
    LDS_WAIT(); asm volatile("" ::: "memory");
}
__device__ __forceinline__ void ph_prologue(Frame& F) {
    const float* c_in = F.a->in[1]; const float* w_mod = F.a->in[2]; const float* b_mod = F.a->in[3];
    float* MOD = (float*)(F.ws + WS_MOD);
    for (int item = F.bid; item < 48; item += F.G) {
        LAS float* SC = (LAS float*)F.lds;
        __syncthreads();
        for (int i = F.tid; i < 32768; i += NTHR) { const int b = i >> 10, k = i & 1023; SC[k * 32 + b] = silu_f(c_in[i]); }
        __syncthreads();
        const int col = item * 128 + (F.tid >> 2), kq = F.tid & 3;
        float a[32];
#pragma unroll
        for (int b = 0; b < 32; ++b) a[b] = 0.f;
#pragma nounroll
        for (int kg = 0; kg < 256; kg += 16) {
            float wv[16];
#pragma unroll
            for (int u = 0; u < 16; ++u) wv[u] = w_mod[(size_t)(kq * 256 + kg + u) * 6144 + col];
#pragma unroll
            for (int u = 0; u < 16; ++u) { const int k = kq * 256 + kg + u; const float w = wv[u];
#pragma unroll
                for (int b4 = 0; b4 < 8; ++b4) { const f32x4 s = *(const LAS f32x4*)(SC + k * 32 + b4 * 4); a[b4 * 4 + 0] += w * s[0]; a[b4 * 4 + 1] += w * s[1]; a[b4 * 4 + 2] += w * s[2]; a[b4 * 4 + 3] += w * s[3]; } } }
#pragma unroll
        for (int b = 0; b < 32; ++b) { a[b] += __shfl_xor(a[b], 1); a[b] += __shfl_xor(a[b], 2); }
        if (kq == 0) { const float bm = b_mod[col];
#pragma unroll
            for (int b = 0; b < 32; ++b) MOD[(size_t)b * 6144 + col] = a[b] + bm; }
        __syncthreads();
    }
    if (F.bid == (F.G > 48 ? 48 : 0)) {
        float* BT = (float*)(F.ws + WS_BIAST); const float* rel_bias = F.a->in[8];
        for (int i = F.tid; i < 249 * 8; i += NTHR) { const int idx = i >> 3, h = i & 7, rel = idx - 185; const int n = rel < 0 ? -rel : rel;
            const float nf = (float)(n > 1 ? n : 1); int large = 8 + (int)(logf(nf / 8.0f) / 2.7725887f * 8.0f); if (large > 15) large = 15;
            const int bucket = (rel > 0 ? 16 : 0) + (n < 8 ? n : large);
            BT[i] = rel_bias[bucket * 8 + h] * LOG2E; }
    }
    LAS float* scr = (LAS float*)(F.lds + F.wave * 16640);
    __syncthreads();
    const int gw = F.bid * NWAVES + F.wave, NGW = F.G * NWAVES;
    constexpr int I_WIN = 16 * (NPROJ / 64), I_SQ = 16 * 16, I_W1E = 16 * 32, I_W2E = 16 * 16;
    constexpr int NITEMS = (PROJ_FP8 ? 2 : 1) * I_WIN + 3 * I_SQ + 32 * I_W1E + 32 * I_W2E;
    for (int it = gw; it < NITEMS; it += NGW) {
        int r = it;
        if (r < I_WIN) { transpose_item(F.a->in[4], 1024, 6872, (bf16_t*)(F.ws + WS_WIN), MapWin(), scr, r / (NPROJ / 64), r % (NPROJ / 64), F.lane, nullptr); continue; } r -= I_WIN;
        if (PROJ_FP8) { if (r < I_WIN) { transpose_item<MapWin, true>(F.a->in[4], 1024, 6872, (bf16_t*)(F.ws + WS_WIN8), MapWin(), scr, r / (NPROJ / 64), r % (NPROJ / 64), F.lane, nullptr); continue; } r -= I_WIN; }
        if (r < I_SQ) { if (PA_FP8) transpose_item<MapIdent, true>(F.a->in[15], 1024, 1024, (bf16_t*)(F.ws + WS_WPA8), MapIdent(), scr, r / 16, r % 16, F.lane, nullptr);
                         else transpose_item(F.a->in[15], 1024, 1024, (bf16_t*)(F.ws + WS_WPA), MapIdent(), scr, r / 16, r % 16, F.lane, nullptr); continue; } r -= I_SQ;
        if (r < I_SQ) { if (PB_FP8) transpose_item<MapIdent, true>(F.a->in[16], 1024, 1024, (bf16_t*)(F.ws + WS_WPB8), MapIdent(), scr, r / 16, r % 16, F.lane, F.a->in[14]);
                         else transpose_item(F.a->in[16], 1024, 1024, (bf16_t*)(F.ws + WS_WPB), MapIdent(), scr, r / 16, r % 16, F.lane, F.a->in[14]); continue; } r -= I_SQ;
        if (r < I_SQ) { transpose_item(F.a->in[17], 1024, 1024, (bf16_t*)(F.ws + WS_WOUT), MapIdent(), scr, r / 16, r % 16, F.lane, nullptr); continue; } r -= I_SQ;
        if (r < 32 * I_W1E) { const int e = r / I_W1E, q = r % I_W1E; transpose_item<MapW1, MOE_FP8 != 0>(F.a->in[22] + (size_t)e * 1024 * 2048, 1024, 2048, (bf16_t*)(F.ws + WS_W1 + (size_t)e * 2048 * MOE_RB), MapW1(), scr, q / 32, q % 32, F.lane, nullptr); continue; } r -= 32 * I_W1E;
        { const int e = r / I_W2E, q = r % I_W2E; transpose_item<MapIdent, MOE_FP8 != 0>(F.a->in[24] + (size_t)e * 1024 * 1024, 1024, 1024, (bf16_t*)(F.ws + WS_W2 + (size_t)e * 1024 * MOE_RB), MapIdent(), scr, q / 16, q % 16, F.lane, nullptr); }
    }
}

__device__ __forceinline__ void ph_ln1(Frame& F) {
    const float* x = F.a->in[0]; const float* MOD = (const float*)(F.ws + WS_MOD); bf16_t* U = (bf16_t*)(F.outb + OUT_U);
    const int gw = F.bid * NWAVES + F.wave, NGW = F.G * NWAVES;
    constexpr int RB = 4;
    for (int m0 = gw; m0 < NTOK; m0 += NGW * RB) {
        f32x4 v[RB][4];
#pragma unroll
        for (int r = 0; r < RB; ++r) { const f32x4* xr = (const f32x4*)(x + (size_t)(m0 + r * NGW) * D) + F.lane;
#pragma unroll
            for (int j = 0; j < 4; ++j) v[r][j] = xr[64 * j]; }
#pragma unroll
        for (int r = 0; r < RB; ++r) { const int m = m0 + r * NGW; const float* md = MOD + (size_t)(m >> 11) * 6144;
            float s = 0.f;
#pragma unroll
            for (int j = 0; j < 4; ++j) s += (v[r][j][0] + v[r][j][1]) + (v[r][j][2] + v[r][j][3]);
            const float mean = wave_sum(s) * (1.f / D); float s2 = 0.f;
#pragma unroll
            for (int j = 0; j < 4; ++j) { v[r][j] = v[r][j] - mean; s2 += (v[r][j][0] * v[r][j][0] + v[r][j][1] * v[r][j][1]) + (v[r][j][2] * v[r][j][2] + v[r][j][3] * v[r][j][3]); }
            const float rstd = 1.f / sqrtf(wave_sum(s2) * (1.f / D) + LN_EPS);
            u32x2* o8 = (u32x2*)(U + (size_t)m * D) + F.lane;
#pragma unroll
            for (int j = 0; j < 4; ++j) { const f32x4 sh = *((const f32x4*)md + F.lane + 64 * j), sc = *((const f32x4*)(md + 1024) + F.lane + 64 * j);
                const f32x4 rr = v[r][j] * rstd * (sc + 1.0f) + sh; u32x2 w; w.x = cvt_pk_bf16(rr[0], rr[1]); w.y = cvt_pk_bf16(rr[2], rr[3]); o8[64 * j] = w;
                if (PROJ_FP8) { int pk = 0; pk = __builtin_amdgcn_cvt_pk_fp8_f32(rr[0], rr[1], pk, false); pk = __builtin_amdgcn_cvt_pk_fp8_f32(rr[2], rr[3], pk, true); ((unsigned*)(F.ws + WS_U8 + (size_t)m * D))[F.lane + 64 * j] = (unsigned)pk; } } }
    }
}

__device__ __forceinline__ void ph_misc(Frame& F) {
    const float* MISC = (const float*)(F.outb + OUT_MISC);
    bf16_t* KV = (bf16_t*)(F.outb + OUT_KV); bf16_t* IK = (bf16_t*)(F.outb + OUT_IK); float* IW = (float*)(F.outb + OUT_IW); float* DT = (float*)(F.outb + OUT_DT);
    const float* kvw = F.a->in[5]; const float* ikw = F.a->in[6]; const float* ikb = F.a->in[7]; const float* dtb = F.a->in[11];
    const int gw = F.bid * NWAVES + F.wave, NGW = F.G * NWAVES, l = F.lane;
    for (int m0 = gw; m0 < NTOK; m0 += NGW * 4) {
      f32x4 vv[4];
#pragma unroll
      for (int r = 0; r < 4; ++r) vv[r] = *((const f32x4*)(MISC + (size_t)(m0 + r * NGW) * 256) + l);
#pragma unroll
      for (int r = 0; r < 4; ++r) { const int m = m0 + r * NGW;
        const f32x4 v = vv[r];
        const float sq = v[0] * v[0] + v[1] * v[1] + v[2] * v[2] + v[3] * v[3], sm = (v[0] + v[1]) + (v[2] + v[3]);
        const float kvss = wave_sum(l < 32 ? sq : 0.f);
        const float iks = wave_sum((l >= 32 && l < 48) ? sm : 0.f);
        const float ikmean = iks * (1.f / 64.f);
        const f32x4 dv = v - ikmean;
        const float ikq = wave_sum((l >= 32 && l < 48) ? (dv[0] * dv[0] + dv[1] * dv[1] + dv[2] * dv[2] + dv[3] * dv[3]) : 0.f);
        if (l < 32) { const float r = 1.f / sqrtf(kvss * (1.f / 128.f) + LN_EPS); const f32x4 w = *((const f32x4*)kvw + l); const f32x4 o = v * r * w;
            u32x2 pk; pk.x = cvt_pk_bf16(o[0], o[1]); pk.y = cvt_pk_bf16(o[2], o[3]); *((u32x2*)(KV + (size_t)m * 128) + l) = pk; }
        else if (l < 48) { const float r = 1.f / sqrtf(ikq * (1.f / 64.f) + LN_EPS); const f32x4 w = *((const f32x4*)ikw + (l - 32)), bb = *((const f32x4*)ikb + (l - 32)); const f32x4 o = dv * r * w + bb;
            u32x2 pk; pk.x = cvt_pk_bf16(o[0], o[1]); pk.y = cvt_pk_bf16(o[2], o[3]); *((u32x2*)(IK + (size_t)m * 64) + (l - 32)) = pk; }
        else if (l < 50) { *((f32x4*)(IW + (size_t)m * 8) + (l - 48)) = v * 0.35355339059327373f; }
        else if (l < 54) { const f32x4 bb = *((const f32x4*)dtb + (l - 50)); f32x4 o;
#pragma unroll
            for (int j = 0; j < 4; ++j) { const float t = v[j] + bb[j]; o[j] = t > 20.f ? t : log1pf(__expf(t)); }
            *((f32x4*)(DT + (size_t)m * 16) + (l - 50)) = o; }
      }
    }
}

__device__ __forceinline__ unsigned sortable_key(float s) { const unsigned u = __float_as_uint(s + 0.0f); return (u & 0x80000000u) ? ~u : (u | 0x80000000u); }
template <int NKB> struct KeyRow { unsigned k[NKB]; };
__device__ __forceinline__ u64 low_bits_keep(u64 m, int t) { u64 out = 0; while (t-- > 0 && m) { const u64 b = m & (0 - m); out |= b; m ^= b; } return out; }
namespace idx { constexpr int KST = 144, KBUF = 64 * KST; }
__device__ __forceinline__ unsigned low_bits_keep32(unsigned m, int t) { unsigned out = 0; while (t-- > 0 && m) { const unsigned b = m & (0u - m); out |= b; m ^= b; } return out; }
template <int NG> __device__ __forceinline__ void topk2_select_write(const unsigned (&key)[64], int nkb, u64* mrow, int lane) {
    constexpr int NR = NG * 16;
    unsigned T0 = 0u, T1 = 0u; bool ex0 = false, ex1 = false;
    unsigned lo0 = 0u, lo1 = 0u, hi0 = 0xFFFFFFFFu, hi1 = 0xFFFFFFFFu, st0, st1, p0, p1; bool fin0 = false, fin1 = false;
    { float sm = 0.f, sq = 0.f;
#pragma unroll
        for (int m = 0; m < 10; ++m) { const unsigned k = key[m]; const float f = __uint_as_float((k & 0x80000000u) ? (k ^ 0x80000000u) : ~k); sm += f; sq += f * f; }
#pragma unroll
        for (int o = 1; o < 32; o <<= 1) { sm += __shfl_xor(sm, o); sq += __shfl_xor(sq, o); }
        const float mu = sm * (1.f / 320.f), sd = sqrtf(fmaxf(sq * (1.f / 320.f) - mu * mu, 1e-20f));
        const float qq = 256.f / (64.f * (float)nkb), pp = qq < 0.5f ? qq : 1.f - qq, tt = sqrtf(-2.f * __logf(pp));
        float z = tt - (2.515517f + 0.802853f * tt + 0.010328f * tt * tt) / (1.f + 1.432788f * tt + 0.189269f * tt * tt + 0.001308f * tt * tt * tt); if (qq >= 0.5f) z = -z;
        const unsigned pe = sortable_key(mu + z * sd), pd = sortable_key(mu + z * sd + 0.125f * sd);
        unsigned stp = pd - pe; if (stp < 1024u) stp = 1024u;
        p0 = __builtin_amdgcn_readlane((int)pe, 0); p1 = __builtin_amdgcn_readlane((int)pe, 32); st0 = __builtin_amdgcn_readlane((int)stp, 0); st1 = __builtin_amdgcn_readlane((int)stp, 32); }
#pragma nounroll
    for (int it = 0; it < 80; ++it) {
        const unsigned candv = lane < 32 ? p0 : p1;
        unsigned cl = 0u;
#pragma unroll
        for (int m = 0; m < NR; ++m) cl += (key[m] >= candv) ? 1u : 0u;
        cl += __shfl_xor(cl, 1); cl += __shfl_xor(cl, 2); cl += __shfl_xor(cl, 4); cl += __shfl_xor(cl, 8); cl += __shfl_xor(cl, 16);
        const int n0 = __builtin_amdgcn_readlane((int)cl, 0), n1 = __builtin_amdgcn_readlane((int)cl, 32);
#define IDX_STEP(lo, hi, st, p, T, ex, fin, n) do { if (!fin) { \
            if (n == 256) { T = p; ex = true; fin = true; } \
            else { if (n > 256) lo = p; else hi = p; \
                if (hi - lo <= 1u) { T = lo; fin = true; } \
                else { unsigned c; if (hi == 0xFFFFFFFFu) { c = lo + st; if (c < lo) c = hi; st = st << 1; } else if (lo == 0u) { c = hi - st; if (c > hi) c = lo; st = st << 1; } else c = lo + ((hi - lo) >> 1); \
                    if (c <= lo || c >= hi) c = lo + ((hi - lo) >> 1); p = c; } } } } while (0)
        IDX_STEP(lo0, hi0, st0, p0, T0, ex0, fin0, n0);
        IDX_STEP(lo1, hi1, st1, p1, T1, ex1, fin1, n1);
#undef IDX_STEP
        if (fin0 && fin1) break;
    }
    const unsigned Tv = lane < 32 ? T0 : T1;
    if (ex0 && ex1) {
        unsigned mlo = 0u, mhi = 0u;
#pragma unroll
        for (int j = 0; j < NR / 2; ++j) {
            const u64 b0 = __ballot(key[2 * j] >= Tv), b1 = __ballot(key[2 * j + 1] >= Tv);
            asm volatile("s_nop 1\n\tv_writelane_b32 %0, %2, %6\n\tv_writelane_b32 %0, %3, %7\n\tv_writelane_b32 %1, %4, %6\n\tv_writelane_b32 %1, %5, %7"
                         : "+v"(mlo), "+v"(mhi) : "s"((unsigned)b0), "s"((unsigned)(b0 >> 32)), "s"((unsigned)b1), "s"((unsigned)(b1 >> 32)), "n"(j), "n"(32 + j));
            if ((j & 3) == 3) SBAR();
        }
        const int jl = lane & 31;
        if (jl < nkb) mrow[(lane >> 5) * 32 + jl] = (u64)mlo | ((u64)mhi << 32);
        return;
    }
    int rem0 = 1 << 30, rem1 = 1 << 30;
    { int g0 = 0, g1 = 0;
#pragma unroll
        for (int m = 0; m < NR; ++m) { const u64 mk = __ballot(key[m] > Tv); g0 += __builtin_popcount((unsigned)mk); g1 += __builtin_popcount((unsigned)(mk >> 32)); if ((m & 7) == 7) SBAR(); }
        if (!ex0) rem0 = 256 - g0; if (!ex1) rem1 = 256 - g1; }
    u64 mine = 0ull;
#pragma nounroll
    for (int jq = 0; jq < NR / 8; ++jq) {
#pragma unroll
        for (int jj = 0; jj < 4; ++jj) { const int j = jq * 4 + jj;
            unsigned w0[2], w1[2];
#pragma unroll
            for (int hh = 0; hh < 2; ++hh) { unsigned kv = 0u;
#pragma unroll
                for (int m = 0; m < NR; ++m) if ((m >> 3) == 0) {}
#pragma unroll
                for (int m = 0; m < NR; ++m) kv = (m == 2 * j + hh) ? key[m] : kv;
                const u64 gt = __ballot(kv > Tv), eq = __ballot(kv == Tv);
                { const unsigned e = (unsigned)eq, g = (unsigned)gt; const int ne = __builtin_popcount(e); unsigned sel = g; if (rem0 >= ne) { sel |= e; rem0 -= ne; } else if (rem0 > 0) { sel |= low_bits_keep32(e, rem0); rem0 = 0; } w0[hh] = sel; }
                { const unsigned e = (unsigned)(eq >> 32), g = (unsigned)(gt >> 32); const int ne = __builtin_popcount(e); unsigned sel = g; if (rem1 >= ne) { sel |= e; rem1 -= ne; } else if (rem1 > 0) { sel |= low_bits_keep32(e, rem1); rem1 = 0; } w1[hh] = sel; } }
            const u64 q0w = (u64)w0[0] | ((u64)w0[1] << 32), q1w = (u64)w1[0] | ((u64)w1[1] << 32);
            if (lane == j) mine = q0w; if (lane == 32 + j) mine = q1w; }
    }
    const int jl = lane & 31;
    if (jl < nkb) mrow[(lane >> 5) * 32 + jl] = mine;
}
template <int J0> __device__ __forceinline__ void index_scores8(unsigned (&key)[64], const bf16x8 (&af)[2], const f32x4& iw4, const bf16_t* kvsrc, char* lds, int nkb, u32x4 (&stg)[8], int tid) {
    const int lane = tid & 63, sub = lane & 15, kg = lane >> 4;
#pragma unroll
    for (int jj = 0; jj < 8; ++jj) {
        const int j = J0 + jj;
        if (j < nkb) {
            if (j + 1 < nkb) *(u32x4*)(lds + ((j + 1) & 1) * idx::KBUF + (tid >> 3) * idx::KST + (tid & 7) * 16) = stg[(jj + 1) & 7];
            if (j + 8 < nkb) stg[jj] = *(const u32x4*)(kvsrc + (size_t)(j + 8) * 64 * 64);
            const char* kb = lds + (j & 1) * idx::KBUF + sub * idx::KST + kg * 16;
#pragma unroll
            for (int pr = 0; pr < 2; ++pr) {
                f32x4 dA = (f32x4){0.f, 0.f, 0.f, 0.f}, dB = dA;
#pragma unroll
                for (int ks = 0; ks < 2; ++ks) {
                    const bf16x8 fA = *(const bf16x8*)(kb + (pr * 32) * idx::KST + ks * 64), fB = *(const bf16x8*)(kb + (pr * 32 + 16) * idx::KST + ks * 64);
                    dA = __builtin_amdgcn_mfma_f32_16x16x32_bf16(af[ks], fA, dA, 0, 0, 0); dB = __builtin_amdgcn_mfma_f32_16x16x32_bf16(af[ks], fB, dB, 0, 0, 0); }
                float pA = 0.f, pB = 0.f;
#pragma unroll
                for (int r = 0; r < 4; ++r) { pA += fmaxf(dA[r], 0.f) * iw4[r]; pB += fmaxf(dB[r], 0.f) * iw4[r]; }
                auto rr = __builtin_amdgcn_permlane16_swap(__float_as_uint(pA), __float_as_uint(pB), false, false);
                key[2 * j + pr] = sortable_key(__uint_as_float(rr[0]) + __uint_as_float(rr[1]));
            }
            __syncthreads();
        }
    }
}
__device__ __forceinline__ void ph_index(Frame& F) {
    const bf16_t* IQ = (const bf16_t*)(F.outb + OUT_IQ); const bf16_t* IK = (const bf16_t*)(F.outb + OUT_IK); const float* IW = (const float*)(F.outb + OUT_IW);
    u64* MASK = (u64*)(F.outb + OUT_MASK);
    char* lds = (char*)(unsigned char*)F.lds;
    const int tid = F.tid, lane = F.lane, sub = lane & 15, kg = lane >> 4;
    for (int item = F.bid; item < NTOK / 16; item += F.G) {
        const int tokw = (((item & 255) >> 3) << 11) + (((item & 7) + 8 * (item >> 8)) << 4) + F.wave * 2, b = tokw >> 11, pos0 = tokw & 2047, nkb = (pos0 >> 6) + 1;
        u64* mrow = MASK + (size_t)tokw * 32;
        if (nkb <= 4) { if ((lane & 31) < nkb) mrow[(lane >> 5) * 32 + (lane & 31)] = ~0ull; continue; }
        bf16x8 af[2];
        { const bf16_t* ap = IQ + (size_t)(tokw + (sub >> 3)) * 512 + (sub & 7) * 64 + kg * 8;
#pragma unroll
          for (int ks = 0; ks < 2; ++ks) af[ks] = *(const bf16x8*)(ap + ks * 32); }
        const f32x4 iw4 = *(const f32x4*)(IW + (size_t)(tokw + (lane >> 5)) * 8 + 4 * (kg & 1));
        unsigned key[64];
#pragma unroll
        for (int m = 0; m < 64; ++m) key[m] = 0u;
        const bf16_t* kvsrc = IK + ((size_t)b * SEQ + (tid >> 3)) * 64 + (tid & 7) * 8;
        u32x4 stg[8];
#pragma unroll
        for (int i = 0; i < 8; ++i) stg[i] = (i < nkb) ? *(const u32x4*)(kvsrc + (size_t)i * 64 * 64) : (u32x4){0u, 0u, 0u, 0u};
        __syncthreads();
        *(u32x4*)(lds + (tid >> 3) * idx::KST + (tid & 7) * 16) = stg[0];
        __syncthreads();
        const int ng = (nkb + 7) >> 3;
        index_scores8<0>(key, af, iw4, kvsrc, lds, nkb, stg, tid);
        if (ng > 1) index_scores8<8>(key, af, iw4, kvsrc, lds, nkb, stg, tid);
        if (ng > 2) index_scores8<16>(key, af, iw4, kvsrc, lds, nkb, stg, tid);
        if (ng > 3) index_scores8<24>(key, af, iw4, kvsrc, lds, nkb, stg, tid);
        if (ng == 1) topk2_select_write<1>(key, nkb, mrow, lane);
        else if (ng == 2) topk2_select_write<2>(key, nkb, mrow, lane);
        else if (ng == 3) topk2_select_write<3>(key, nkb, mrow, lane);
        else topk2_select_write<4>(key, nkb, mrow, lane);
    }
}

namespace att {
constexpr int KVBLK = 64;
constexpr int SHM_V = KVBLK * 128 * 2, SHM_K = SHM_V;
constexpr int OFF_V = 0, OFF_K = 2 * SHM_V, OFF_WS = 2 * SHM_V + 2 * SHM_K, OFF_BT = OFF_WS + NWAVES * 64 * 4;
#define KSWZ(row, colB) ((row) * 256 + ((colB) ^ (((row) & 7) << 4)))
__device__ __forceinline__ int crow(int r, int hi) { return (r & 3) + 8 * (r >> 2) + 4 * hi; }
__device__ __forceinline__ int v_st(int k, int c) { const int kk = (k & ~0xC) | ((k & 4) << 1) | ((k & 8) >> 1); return ((kk >> 3) * 4 + (c >> 5)) * 512 + ((kk & 7) * 32 + (c & 31)) * 2; }
__device__ __forceinline__ int v_rd_base(int lane) { return ((lane & 3) << 3) | (((lane >> 2) & 3) << 6) | (((lane >> 4) & 1) << 5) | (((lane >> 5) & 1) << 8); }
constexpr int v_rd_off(int d0, int ks, int half) { return d0 * 512 + ks * 4096 + half * 2048; }
template <int OFF> __device__ __forceinline__ s16x4 tr_read(int vb) { s16x4 r; asm volatile("ds_read_b64_tr_b16 %0, %1 offset:%2" : "=&v"(r) : "v"(vb), "i"(OFF) : "memory"); return r; }
template <int D0> __device__ __forceinline__ void pv_one(f32x16& od, int vb, bf16x8 pa0, bf16x8 pa1, bf16x8 pa2, bf16x8 pa3) {
    const s16x4 l0 = tr_read<v_rd_off(D0, 0, 0)>(vb), h0 = tr_read<v_rd_off(D0, 0, 1)>(vb), l1 = tr_read<v_rd_off(D0, 1, 0)>(vb), h1 = tr_read<v_rd_off(D0, 1, 1)>(vb);
    const s16x4 l2 = tr_read<v_rd_off(D0, 2, 0)>(vb), h2 = tr_read<v_rd_off(D0, 2, 1)>(vb), l3 = tr_read<v_rd_off(D0, 3, 0)>(vb), h3 = tr_read<v_rd_off(D0, 3, 1)>(vb);
    asm volatile("s_waitcnt lgkmcnt(0)" ::: "memory"); SBAR();
#define PK(L, H) (bf16x8){L[0], L[1], L[2], L[3], H[0], H[1], H[2], H[3]}
    od = __builtin_amdgcn_mfma_f32_32x32x16_bf16(pa0, PK(l0, h0), od, 0, 0, 0);
    od = __builtin_amdgcn_mfma_f32_32x32x16_bf16(pa1, PK(l1, h1), od, 0, 0, 0);
    od = __builtin_amdgcn_mfma_f32_32x32x16_bf16(pa2, PK(l2, h2), od, 0, 0, 0);
    od = __builtin_amdgcn_mfma_f32_32x32x16_bf16(pa3, PK(l3, h3), od, 0, 0, 0);
#undef PK
}
__device__ __forceinline__ void qkt(f32x16& p0, f32x16& p1, const char* Ks, const bf16x8* qr, int r32, int hi) {
    p0 = f32x16{}; p1 = f32x16{};
    int rv = r32; asm volatile("" : "+v"(rv));
    const char* kb = Ks + rv * 256; const int swz = ((rv & 7) << 4) ^ (hi * 16);
#pragma unroll
    for (int d0 = 0; d0 < 8; ++d0) { const char* ka = kb + ((d0 * 32) ^ swz);
        const bf16x8 b0 = *reinterpret_cast<const bf16x8*>(ka);
        const bf16x8 b1 = *reinterpret_cast<const bf16x8*>(ka + 8192);
        p0 = __builtin_amdgcn_mfma_f32_32x32x16_bf16(b0, qr[d0], p0, 0, 0, 0);
        p1 = __builtin_amdgcn_mfma_f32_32x32x16_bf16(b1, qr[d0], p1, 0, 0, 0); }
}
__device__ __forceinline__ void attn_item(Frame& F, int b, int q0, char* lds) {
    const bf16_t* Q = (const bf16_t*)(F.ws + WS_Q); const bf16_t* KV = (const bf16_t*)(F.outb + OUT_KV); const u64* MASK = (const u64*)(F.outb + OUT_MASK);
    bf16_t* OA = (bf16_t*)(F.outb + OUT_OA);
    int tid = F.tid; asm volatile("" : "+v"(tid));
    const int wid = F.wave, lane = tid & 63, r32 = lane & 31, hi = lane >> 5;
    char* V_lds = lds + OFF_V; char* K_lds = lds + OFF_K;
    float* wsl = (float*)(lds + OFF_WS) + wid * 64; float* li_l = wsl; float* al_l = wsl + 32;
    const float* btab = (const float*)(lds + OFF_BT);
    constexpr float C = 0.088388347648318440f * LOG2E;
    float m_reg = -1e30f, l_reg = 0.f; f32x16 o[4] = {}; bf16x8 qr[8];
    const size_t tokq = (size_t)b * SEQ + q0 + r32;
    { const bf16_t* Qw = Q + tokq * 1024 + wid * 128 + hi * 8;
#pragma unroll
      for (int d0 = 0; d0 < 8; ++d0) qr[d0] = *(const bf16x8*)(Qw + d0 * 16); }
    const u64* mq = MASK + tokq * 32;
    const int sr = tid >> 4, sc = (tid & 15) * 8;
    const int vb0 = (int)(uintptr_t)V_lds + v_rd_base(lane);
    const bf16_t* Kb = KV + (size_t)b * SEQ * 128;
    const int NT = (q0 >> 6) + 1;
    const float bfar = btab[wid];
    bf16x8 s0, s1;
#define SLOAD(k0) do { s0 = *(const bf16x8*)(Kb + (size_t)((k0) + sr) * 128 + sc); s1 = *(const bf16x8*)(Kb + (size_t)((k0) + 32 + sr) * 128 + sc); } while (0)
#define SWRITE(bf) do { int srv = sr; asm volatile("" : "+v"(srv)); const int kc = sc * 2; const int v0a = v_st(srv, sc), k0a = KSWZ(srv, kc); \
        *(bf16x8*)(V_lds + (bf) * SHM_V + v0a) = s0; *(bf16x8*)(V_lds + (bf) * SHM_V + v0a + 8192) = s1; \
        *(bf16x8*)(K_lds + (bf) * SHM_K + k0a) = s0; *(bf16x8*)(K_lds + (bf) * SHM_K + k0a + 8192) = s1; } while (0)
    __syncthreads();
    SLOAD(0); VM_WAIT(); SWRITE(0); __syncthreads();
    u64 mw_next = mq[0];
    for (int j = 0; j < NT; ++j) {
        int lanel = lane; asm volatile("" : "+v"(lanel)); const int r32l = lanel & 31, hil = lanel >> 5;
        const int bf = j & 1;
        if (j + 1 < NT) SLOAD((j + 1) * KVBLK);
        const u64 mw = mw_next; if (j + 1 < NT) mw_next = mq[j + 1];
        f32x16 p0, p1;
        qkt(p0, p1, K_lds + bf * SHM_K, qr, r32l, hil);
        const unsigned w0 = (unsigned)(mw >> (4 * hil)), w1 = (unsigned)(mw >> (32 + 4 * hil));
        const int relmax = j * KVBLK + 63 - q0;
        float alpha = 1.f, ps = 0.f;
        if (relmax <= -91) {
            float pmax = p0[0];
#pragma unroll
            for (int r = 1; r < 16; ++r) pmax = fmaxf(pmax, p0[r]);
#pragma unroll
            for (int r = 0; r < 16; ++r) pmax = fmaxf(pmax, p1[r]);
            { auto rr = __builtin_amdgcn_permlane32_swap(__float_as_uint(pmax), __float_as_uint(pmax), false, false); pmax = fmaxf(__uint_as_float(rr[0]), __uint_as_float(rr[1])); }
            pmax = fmaf(pmax, C, bfar);
            if (!__all(pmax - m_reg <= 11.0f)) { const float mn = fmaxf(m_reg, pmax); alpha = __builtin_amdgcn_exp2f(m_reg - mn); m_reg = mn; }
            const float off = bfar - m_reg;
#pragma unroll
            for (int r = 0; r < 16; ++r) { const int cb = (r & 3) + 8 * (r >> 2);
                const float e0 = __builtin_amdgcn_exp2f(fmaf(p0[r], C, off)), e1 = __builtin_amdgcn_exp2f(fmaf(p1[r], C, off));
                p0[r] = __uint_as_float(__float_as_uint(e0) & (unsigned)__builtin_amdgcn_sbfe((int)w0, cb, 1)); p1[r] = __uint_as_float(__float_as_uint(e1) & (unsigned)__builtin_amdgcn_sbfe((int)w1, cb, 1)); ps += p0[r] + p1[r]; }
        } else {
            const float* bp = btab + (j * KVBLK + 4 * hil - (q0 + r32l) + 185) * 8 + wid;
#pragma unroll
            for (int r4 = 0; r4 < 4; ++r4) {
#pragma unroll
                for (int rr = 0; rr < 4; ++rr) { const int r = r4 * 4 + rr; const int cb = (r & 3) + 8 * (r >> 2); p0[r] = fmaf(p0[r], C, bp[cb * 8]); p1[r] = fmaf(p1[r], C, bp[(cb + 32) * 8]); }
                SBAR(); }
            float pmax = p0[0];
#pragma unroll
            for (int r = 1; r < 16; ++r) pmax = fmaxf(pmax, p0[r]);
#pragma unroll
            for (int r = 0; r < 16; ++r) pmax = fmaxf(pmax, p1[r]);
            { auto rr = __builtin_amdgcn_permlane32_swap(__float_as_uint(pmax), __float_as_uint(pmax), false, false); pmax = fmaxf(__uint_as_float(rr[0]), __uint_as_float(rr[1])); }
            if (!__all(pmax - m_reg <= 11.0f)) { const float mn = fmaxf(m_reg, pmax); alpha = __builtin_amdgcn_exp2f(m_reg - mn); m_reg = mn; }
#pragma unroll
            for (int r = 0; r < 16; ++r) { const int cb = (r & 3) + 8 * (r >> 2);
                const float e0 = __builtin_amdgcn_exp2f(p0[r] - m_reg), e1 = __builtin_amdgcn_exp2f(p1[r] - m_reg);
                p0[r] = __uint_as_float(__float_as_uint(e0) & (unsigned)__builtin_amdgcn_sbfe((int)w0, cb, 1)); p1[r] = __uint_as_float(__float_as_uint(e1) & (unsigned)__builtin_amdgcn_sbfe((int)w1, cb, 1)); ps += p0[r] + p1[r]; }
        }
        { auto rr = __builtin_amdgcn_permlane32_swap(__float_as_uint(ps), __float_as_uint(ps), false, false); ps = __uint_as_float(rr[0]) + __uint_as_float(rr[1]); }
        l_reg = l_reg * alpha + ps;
        bf16x8 pa0, pa1, pa2, pa3;
#define PK4(P, BASE, OUT) do { unsigned a0 = cvt_pk_bf16(P[BASE + 0], P[BASE + 1]), a1 = cvt_pk_bf16(P[BASE + 2], P[BASE + 3]);   \
    unsigned b0 = cvt_pk_bf16(P[BASE + 4], P[BASE + 5]), b1 = cvt_pk_bf16(P[BASE + 6], P[BASE + 7]);                              \
    auto r0 = __builtin_amdgcn_permlane32_swap(a0, b0, false, false); auto r1 = __builtin_amdgcn_permlane32_swap(a1, b1, false, false); \
    u32x4 w = {r0[0], r1[0], r0[1], r1[1]}; OUT = *reinterpret_cast<bf16x8*>(&w); } while (0)
        PK4(p0, 0, pa0); PK4(p0, 8, pa1); PK4(p1, 0, pa2); PK4(p1, 8, pa3);
#undef PK4
        if (__any(alpha < 1.f)) { if (hil == 0) al_l[r32l] = alpha; LDS_WAIT();
#pragma unroll
            for (int d = 0; d < 4; ++d)
#pragma unroll
                for (int r = 0; r < 16; ++r) o[d][r] *= al_l[crow(r, hil)]; }
        const int vb = (int)(uintptr_t)V_lds + v_rd_base(lanel) + bf * SHM_V;
        pv_one<0>(o[0], vb, pa0, pa1, pa2, pa3); pv_one<1>(o[1], vb, pa0, pa1, pa2, pa3); pv_one<2>(o[2], vb, pa0, pa1, pa2, pa3); pv_one<3>(o[3], vb, pa0, pa1, pa2, pa3);
        if (j + 1 < NT) { VM_WAIT(); SWRITE(bf ^ 1); }
        __syncthreads();
    }
#undef SLOAD
#undef SWRITE
    if (hi == 0) li_l[r32] = l_reg; LDS_WAIT();
    bf16_t* Ow = OA + ((size_t)b * SEQ + q0 + 4 * hi) * 1024 + wid * 128 + r32;
    const float* lip = li_l + 4 * hi;
    unsigned char* Ow8 = (unsigned char*)OA + ((size_t)b * SEQ + q0 + 4 * hi) * 1024 + wid * 128 + r32;
    asm volatile("" : "+v"(Ow), "+v"(lip), "+v"(Ow8));
#pragma unroll
    for (int r = 0; r < 16; ++r) { const int ro = (r & 3) + 8 * (r >> 2); if ((r & 3) == 0) asm volatile("" : "+v"(Ow), "+v"(Ow8), "+v"(lip)); const float rl = fast_rcp(lip[ro]);
#pragma unroll
        for (int d0 = 0; d0 < 4; ++d0) { float v = o[d0][r] * rl; if ((DBG_ATTN_ZERO == 1 && q0 < 256) || (DBG_ATTN_ZERO == 2 && q0 >= 256)) v = 0.f;
            if (PA_FP8) ((unsigned char*)Ow8)[ro * 1024 + d0 * 32] = (unsigned char)(__builtin_amdgcn_cvt_pk_fp8_f32(v, v, 0, false) & 0xff);
            else Ow[ro * 1024 + d0 * 32] = (bf16_t)(cvt_pk_bf16(v, v) & 0xffffu); }
        if ((r & 3) == 3) SBAR(); }
}
__device__ __forceinline__ void att2_partial(f32x16& p0, f32x16& p1, float& m_reg, float& alpha, unsigned w0, bool far, float bfar, const float* bp) {
    constexpr float C = 0.088388347648318440f * LOG2E;
    float off;
    if (far) {
        float pmax = p0[0];
#pragma unroll
        for (int r = 1; r < 16; ++r) pmax = fmaxf(pmax, p0[r]);
#pragma unroll
        for (int r = 0; r < 16; ++r) pmax = fmaxf(pmax, p1[r]);
        { auto rr = __builtin_amdgcn_permlane32_swap(__float_as_uint(pmax), __float_as_uint(pmax), false, false); pmax = fmaxf(__uint_as_float(rr[0]), __uint_as_float(rr[1])); }
        pmax = fmaf(pmax, C, bfar);
        if (__builtin_expect(__all(pmax - m_reg <= 11.0f), 1)) alpha = 1.f; else { const float mn = fmaxf(m_reg, pmax); alpha = __builtin_amdgcn_exp2f(m_reg - mn); m_reg = mn; }
        off = bfar - m_reg;
#pragma unroll
        for (int r = 0; r < 16; ++r) { p0[r] = fmaf(p0[r], C, off); p1[r] = fmaf(p1[r], C, off); }
    } else {
#pragma unroll
        for (int r4 = 0; r4 < 4; ++r4) {
#pragma unroll
            for (int rr = 0; rr < 4; ++rr) { const int r = r4 * 4 + rr; const int cb = (r & 3) + 8 * (r >> 2); p0[r] = fmaf(p0[r], C, bp[cb * 8]); p1[r] = fmaf(p1[r], C, bp[(cb + 32) * 8]); }
            SBAR(); }
        float pmax = p0[0];
#pragma unroll
        for (int r = 1; r < 16; ++r) pmax = fmaxf(pmax, p0[r]);
#pragma unroll
        for (int r = 0; r < 16; ++r) pmax = fmaxf(pmax, p1[r]);
        { auto rr = __builtin_amdgcn_permlane32_swap(__float_as_uint(pmax), __float_as_uint(pmax), false, false); pmax = fmaxf(__uint_as_float(rr[0]), __uint_as_float(rr[1])); }
        if (__builtin_expect(__all(pmax - m_reg <= 11.0f), 1)) alpha = 1.f; else { const float mn = fmaxf(m_reg, pmax); alpha = __builtin_amdgcn_exp2f(m_reg - mn); m_reg = mn; }
#pragma unroll
        for (int r = 0; r < 16; ++r) { p0[r] -= m_reg; p1[r] -= m_reg; }
    }
#pragma unroll
    for (int r = 0; r < 16; ++r) { const int cb = (r & 3) + 8 * (r >> 2); p0[r] = __uint_as_float(__float_as_uint(__builtin_amdgcn_exp2f(p0[r])) & (unsigned)__builtin_amdgcn_sbfe((int)w0, cb, 1)); }
}
__device__ __forceinline__ void att2_finish(f32x16& p0, f32x16& p1, float alpha, float& l_reg, unsigned w1, bf16x8& pa0, bf16x8& pa1, bf16x8& pa2, bf16x8& pa3) {
#pragma unroll
    for (int r = 0; r < 16; ++r) { const int cb = (r & 3) + 8 * (r >> 2); p1[r] = __uint_as_float(__float_as_uint(__builtin_amdgcn_exp2f(p1[r])) & (unsigned)__builtin_amdgcn_sbfe((int)w1, cb, 1)); }
    float ps = 0.f;
#pragma unroll
    for (int r = 0; r < 16; ++r) ps += p0[r];
#pragma unroll
    for (int r = 0; r < 16; ++r) ps += p1[r];
    { auto rr = __builtin_amdgcn_permlane32_swap(__float_as_uint(ps), __float_as_uint(ps), false, false); ps = __uint_as_float(rr[0]) + __uint_as_float(rr[1]); }
    l_reg = l_reg * alpha + ps;
#define PK4(P, BASE, OUT) do { unsigned a0 = cvt_pk_bf16(P[BASE + 0], P[BASE + 1]), a1 = cvt_pk_bf16(P[BASE + 2], P[BASE + 3]);   \
    unsigned b0 = cvt_pk_bf16(P[BASE + 4], P[BASE + 5]), b1 = cvt_pk_bf16(P[BASE + 6], P[BASE + 7]);                              \
    auto r0 = __builtin_amdgcn_permlane32_swap(a0, b0, false, false); auto r1 = __builtin_amdgcn_permlane32_swap(a1, b1, false, false); \
    u32x4 w = {r0[0], r1[0], r0[1], r1[1]}; OUT = *reinterpret_cast<bf16x8*>(&w); } while (0)
    PK4(p0, 0, pa0); PK4(p0, 8, pa1); PK4(p1, 0, pa2); PK4(p1, 8, pa3);
#undef PK4
}
__device__ __forceinline__ void attn_item2(Frame& F, int b, int q0, char* lds) {
    const bf16_t* Q = (const bf16_t*)(F.ws + WS_Q); const bf16_t* KV = (const bf16_t*)(F.outb + OUT_KV); const u64* MASK = (const u64*)(F.outb + OUT_MASK);
    bf16_t* OA = (bf16_t*)(F.outb + OUT_OA);
    int tid = F.tid; asm volatile("" : "+v"(tid));
    const int wid = F.wave, lane = tid & 63, r32 = lane & 31, hi = lane >> 5;
    char* V_lds = lds + OFF_V; char* K_lds = lds + OFF_K;
    float* wsl = (float*)(lds + OFF_WS) + wid * 64; float* li_l = wsl; float* al_l = wsl + 32;
    const float* btab = (const float*)(lds + OFF_BT);
    float m_reg = -1e30f, l_reg = 0.f; f32x16 o[4] = {}; bf16x8 qr[8];
    const size_t tokq = (size_t)b * SEQ + q0 + r32;
    { const bf16_t* Qw = Q + tokq * 1024 + wid * 128 + hi * 8;
#pragma unroll
      for (int d0 = 0; d0 < 8; ++d0) qr[d0] = *(const bf16x8*)(Qw + d0 * 16); }
    const u64* mq = MASK + tokq * 32;
    const int sr = tid >> 4, sc = (tid & 15) * 8;
    const bf16_t* Kb = KV + (size_t)b * SEQ * 128;
    const int NTr = (q0 >> 6) + 1, NT = (NTr + 1) & ~1;
    const float bfar = btab[wid];
    bf16x8 sA0, sA1, sB0, sB1;
#define SLD(s0_, s1_, k0) do { int srl = sr; asm volatile("" : "+v"(srl)); const bf16_t* kp_ = Kb + (size_t)((k0) + srl) * 128 + sc; s0_ = *(const bf16x8*)kp_; s1_ = *(const bf16x8*)(kp_ + 32 * 128); } while (0)
#define SWR(bf, s0_, s1_) do { int srv = sr; asm volatile("" : "+v"(srv)); const int kc = sc * 2; const int v0a = v_st(srv, sc), k0a = KSWZ(srv, kc); \
        *(bf16x8*)(V_lds + (bf) * SHM_V + v0a) = s0_; *(bf16x8*)(V_lds + (bf) * SHM_V + v0a + 8192) = s1_; \
        *(bf16x8*)(K_lds + (bf) * SHM_K + k0a) = s0_; *(bf16x8*)(K_lds + (bf) * SHM_K + k0a + 8192) = s1_; } while (0)
#define MWORD(j) ((j) < NTr ? mq[j] : 0ull)
#define RESC(a) do { if (__any((a) < 1.f)) { if (hi == 0) al_l[r32] = (a); LDS_WAIT(); \
        _Pragma("unroll") for (int d = 0; d < 4; ++d) _Pragma("unroll") for (int r = 0; r < 16; ++r) o[d][r] *= al_l[crow(r, hi)]; } } while (0)
#define PVALL(bf) do { int ll = lane; asm volatile("" : "+v"(ll)); const int vb = (int)(uintptr_t)V_lds + v_rd_base(ll) + (bf) * SHM_V; \
        pv_one<0>(o[0], vb, pa0, pa1, pa2, pa3); pv_one<1>(o[1], vb, pa0, pa1, pa2, pa3); pv_one<2>(o[2], vb, pa0, pa1, pa2, pa3); pv_one<3>(o[3], vb, pa0, pa1, pa2, pa3); } while (0)
#define ISFAR(jt) ((jt) * KVBLK + 63 - q0 <= -91 || (jt) >= NTr)
#define BPTR(jt) (btab + ((jt) * KVBLK + 4 * hi - (q0 + r32) + 185) * 8 + wid)
    f32x16 pA0, pA1, pB0, pB1; float alA, alB; bf16x8 pa0, pa1, pa2, pa3; u64 mwA, mwB;
    __syncthreads();
    SLD(sA0, sA1, 0); mwA = MWORD(0); VM_WAIT(); SWR(0, sA0, sA1); __syncthreads();
    qkt(pA0, pA1, K_lds, qr, r32, hi);
    att2_partial(pA0, pA1, m_reg, alA, (unsigned)(mwA >> (4 * hi)), ISFAR(0), bfar, BPTR(0));
    SLD(sB0, sB1, KVBLK); mwB = MWORD(1); if (2 < NT) SLD(sA0, sA1, 2 * KVBLK);
    SWR(1, sB0, sB1); __syncthreads();
    for (int j = 1; j + 1 < NT; j += 2) {
        SBAR(); qkt(pB0, pB1, K_lds + SHM_K, qr, r32, hi);
        att2_finish(pA0, pA1, alA, l_reg, (unsigned)(mwA >> (32 + 4 * hi)), pa0, pa1, pa2, pa3); SBAR();
        SLD(sB0, sB1, (j + 2) * KVBLK); mwA = MWORD(j + 1); SBAR();
        PVALL(0);
        att2_partial(pB0, pB1, m_reg, alB, (unsigned)(mwB >> (4 * hi)), ISFAR(j), bfar, BPTR(j));
        __syncthreads(); SWR(0, sA0, sA1);
        RESC(alB); __syncthreads();
        SBAR(); qkt(pA0, pA1, K_lds, qr, r32, hi);
        att2_finish(pB0, pB1, alB, l_reg, (unsigned)(mwB >> (32 + 4 * hi)), pa0, pa1, pa2, pa3); SBAR();
        if (j + 3 < NT) SLD(sA0, sA1, (j + 3) * KVBLK); mwB = MWORD(j + 2); SBAR();
        PVALL(1);
        att2_partial(pA0, pA1, m_reg, alA, (unsigned)(mwA >> (4 * hi)), ISFAR(j + 1), bfar, BPTR(j + 1));
        __syncthreads(); SWR(1, sB0, sB1);
        RESC(alA); __syncthreads();
    }
    SBAR(); qkt(pB0, pB1, K_lds + SHM_K, qr, r32, hi);
    att2_finish(pA0, pA1, alA, l_reg, (unsigned)(mwA >> (32 + 4 * hi)), pa0, pa1, pa2, pa3); SBAR();
    PVALL(0);
    att2_partial(pB0, pB1, m_reg, alB, (unsigned)(mwB >> (4 * hi)), ISFAR(NT - 1), bfar, BPTR(NT - 1));
    __syncthreads(); RESC(alB);
    att2_finish(pB0, pB1, alB, l_reg, (unsigned)(mwB >> (32 + 4 * hi)), pa0, pa1, pa2, pa3); SBAR();
    PVALL(1);
#undef SLD
#undef SWR
#undef MWORD
#undef RESC
#undef PVALL
#undef ISFAR
#undef BPTR
    if (hi == 0) li_l[r32] = l_reg; LDS_WAIT();
    bf16_t* Ow = OA + ((size_t)b * SEQ + q0 + 4 * hi) * 1024 + wid * 128 + r32;
    const float* lip = li_l + 4 * hi;
    unsigned char* Ow8 = (unsigned char*)OA + ((size_t)b * SEQ + q0 + 4 * hi) * 1024 + wid * 128 + r32;
    asm volatile("" : "+v"(Ow), "+v"(lip), "+v"(Ow8));
#pragma unroll
    for (int r = 0; r < 16; ++r) { const int ro = (r & 3) + 8 * (r >> 2); if ((r & 3) == 0) asm volatile("" : "+v"(Ow), "+v"(Ow8), "+v"(lip)); const float rl = fast_rcp(lip[ro]);
#pragma unroll
        for (int d0 = 0; d0 < 4; ++d0) { float v = o[d0][r] * rl;
            if (PA_FP8) ((unsigned char*)Ow8)[ro * 1024 + d0 * 32] = (unsigned char)(__builtin_amdgcn_cvt_pk_fp8_f32(v, v, 0, false) & 0xff);
            else Ow[ro * 1024 + d0 * 32] = (bf16_t)(cvt_pk_bf16(v, v) & 0xffffu); }
        if ((r & 3) == 3) SBAR(); }
}
}
__device__ __forceinline__ void ph_attn(Frame& F) {
    char* lds = (char*)(unsigned char*)F.lds;
    { float* bt = (float*)(lds + att::OFF_BT); const float* BT = (const float*)(F.ws + WS_BIAST); __syncthreads(); for (int i = F.tid; i < 249 * 8; i += NTHR) bt[i] = BT[i]; __syncthreads(); }
    for (int pr = F.bid; pr < NB * 32; pr += F.G) {
        const int b = pr >> 5, qb = pr & 31;
#pragma nounroll
        for (int hh = 0; hh < 2; ++hh) { if (ATT2) att::attn_item2(F, b, (hh ? qb : 63 - qb) * 32, lds); else att::attn_item(F, b, (hh ? qb : 63 - qb) * 32, lds); }
    }
}

namespace ssd {
constexpr int OFF_CS = 0, CS_ST = 272;
constexpr int OFF_BS = OFF_CS + 64 * CS_ST;
constexpr int OFF_BT = OFF_BS + 64 * CS_ST, T_ST = 144;
constexpr int OFF_XT = OFF_BT + 128 * T_ST;
constexpr int OFF_XW = OFF_XT + 64 * T_ST;
constexpr int OFF_XS = OFF_XW + 64 * T_ST;
constexpr int OFF_MT = OFF_XS + 64 * T_ST;
constexpr int OFF_HS = OFF_MT + 64 * T_ST;
constexpr int OFF_END = OFF_HS + 64 * CS_ST;
static_assert(OFF_END + 5 * 320 * 4 <= 131072, "ssd lds");
__device__ __forceinline__ f32x4 mfma16(bf16x8 a, bf16x8 b, f32x4 c) { return __builtin_amdgcn_mfma_f32_16x16x32_bf16(a, b, c, 0, 0, 0); }
__device__ __forceinline__ bf16x8 ldfrag(const char* base, int stride, int row, int k0) { return *(const bf16x8*)(base + row * stride + k0 * 2); }
}
__device__ __forceinline__ void ph_ssd(Frame& F) {
    using namespace ssd;
    char* lds = (char*)(unsigned char*)F.lds;
    const bf16_t* XBC = (const bf16_t*)(F.ws + WS_XBC); const bf16_t* ZS = (const bf16_t*)(F.ws + WS_Z); const float* DT = (const float*)(F.outb + OUT_DT);
    bf16_t* YG = (bf16_t*)(F.ws + WS_Q);
    const float* conv_w = F.a->in[9]; const float* conv_b = F.a->in[10]; const float* a_log = F.a->in[12]; const float* d_skip = F.a->in[13];
    const int tid = F.tid, wid = F.wave, lane = F.lane, fr = lane & 15, fq = lane >> 4;
    const bool stager = tid < 320; const int so = tid % 40, tg = tid / 40;
    for (int item = F.bid; item < NB * 16; item += F.G) {
        const int b = item >> 4, h = item & 15, g = h >> 2;
        const float aneg = -__expf(a_log[h]), dsk = d_skip[h];
        const int ch0 = so < 8 ? h * 64 + so * 8 : (so < 24 ? 1024 + g * 128 + (so - 8) * 8 : 1536 + g * 128 + (so - 24) * 8);
        float* CWL = (float*)(lds + OFF_END);
        __syncthreads();
        if (stager) {
#pragma unroll
            for (int j = 0; j < 4; ++j) { *(f32x4*)(CWL + j * 320 + so * 8) = *(const f32x4*)(conv_w + (size_t)j * 2048 + ch0); *(f32x4*)(CWL + j * 320 + so * 8 + 4) = *(const f32x4*)(conv_w + (size_t)j * 2048 + ch0 + 4); }
            *(f32x4*)(CWL + 4 * 320 + so * 8) = *(const f32x4*)(conv_b + ch0); *(f32x4*)(CWL + 4 * 320 + so * 8 + 4) = *(const f32x4*)(conv_b + ch0 + 4);
        }
        f32x4 hst[4];
#pragma unroll
        for (int t = 0; t < 4; ++t) hst[t] = (f32x4){0.f, 0.f, 0.f, 0.f};
        __syncthreads();
        for (int i = tid; i < 64 * CS_ST / 4; i += NTHR) ((unsigned*)(lds + OFF_HS))[i] = 0u;
        u32x4 raw[11];
        const size_t tokb = (size_t)b * SEQ;
#define SSD_LOAD(c) do { if (stager) { _Pragma("unroll") for (int i = 0; i < 11; ++i) { const int t = (c) * 64 + tg * 8 - 3 + i; \
            raw[i] = (t >= 0) ? *(const u32x4*)(XBC + (tokb + t) * 2048 + ch0) : (u32x4){0u, 0u, 0u, 0u}; } } } while (0)
        SSD_LOAD(0);
        float dtl_next = DT[(tokb + lane) * 16 + h];
        for (int c = 0; c < 32; ++c) {
            const float dtl = dtl_next; if (c + 1 < 32) dtl_next = DT[(tokb + (c + 1) * 64 + lane) * 16 + h];
            u32x2 zpre[2];
#pragma unroll
            for (int t2 = 0; t2 < 2; ++t2) { const int tile = 2 * wid + t2, pb = tile >> 2, lb = tile & 3; zpre[t2] = *(const u32x2*)(ZS + (tokb + c * 64 + lb * 16 + fr) * 1024 + h * 64 + pb * 16 + 4 * fq); }
            float acs = dtl * aneg;
#pragma unroll
            for (int o = 1; o < 64; o <<= 1) { const float t = __shfl_up(acs, o); if (lane >= o) acs += t; }
            const float alast = __shfl(acs, 63);
            if (DBG_SSD_SYNC) __syncthreads();
            float dtv[8], dec[8];
#pragma unroll
            for (int t = 0; t < 8; ++t) { dtv[t] = __shfl(dtl, (tg * 8 + t) & 63); dec[t] = __expf(alast - __shfl(acs, (tg * 8 + t) & 63)); }
            if (stager) {
#pragma unroll
                for (int hq = 0; hq < 2; ++hq) {
                    float xin[11][4];
#pragma unroll
                    for (int i = 0; i < 11; ++i) { const unsigned wa = hq ? raw[i].z : raw[i].x, wb = hq ? raw[i].w : raw[i].y; xin[i][0] = bflo(wa); xin[i][1] = bfhi(wa); xin[i][2] = bflo(wb); xin[i][3] = bfhi(wb); }
                    float outv[8][4];
                    { f32x4 cwv[4]; const f32x4 cbq = *(const f32x4*)(CWL + 4 * 320 + so * 8 + hq * 4);
#pragma unroll
                      for (int j = 0; j < 4; ++j) cwv[j] = *(const f32x4*)(CWL + j * 320 + so * 8 + hq * 4);
#pragma unroll
                      for (int t = 0; t < 8; ++t)
#pragma unroll
                        for (int e = 0; e < 4; ++e) { float sacc = cbq[e];
#pragma unroll
                            for (int j = 0; j < 4; ++j) sacc += cwv[j][e] * xin[t + j][e];
                            outv[t][e] = silu_f(sacc); } }
                    if (so < 8) {
#pragma unroll
                        for (int e = 0; e < 4; ++e) { const int p = so * 8 + hq * 4 + e;
                            f32x4 x0, x1, d0, d1, w0, w1;
#pragma unroll
                            for (int t = 0; t < 4; ++t) { x0[t] = outv[t][e]; x1[t] = outv[4 + t][e]; d0[t] = x0[t] * dtv[t]; d1[t] = x1[t] * dtv[4 + t]; w0[t] = d0[t] * dec[t]; w1[t] = d1[t] * dec[4 + t]; }
                            *(u32x4*)(lds + OFF_XS + p * T_ST + tg * 16) = pack8(x0, x1);
                            *(u32x4*)(lds + OFF_XT + p * T_ST + tg * 16) = pack8(d0, d1);
                            *(u32x4*)(lds + OFF_XW + p * T_ST + tg * 16) = pack8(w0, w1); }
                    } else {
                        const bool isB = so < 24; const int n0 = (isB ? (so - 8) : (so - 24)) * 8 + hq * 4;
                        char* nat = lds + (isB ? OFF_BS : OFF_CS);
#pragma unroll
                        for (int t = 0; t < 8; ++t) { u32x2 w; w.x = cvt_pk_bf16(outv[t][0], outv[t][1]); w.y = cvt_pk_bf16(outv[t][2], outv[t][3]);
                            *(u32x2*)(nat + (tg * 8 + t) * CS_ST + n0 * 2) = w; }
                        if (isB) {
#pragma unroll
                            for (int e = 0; e < 4; ++e) { f32x4 a, bq;
#pragma unroll
                                for (int t = 0; t < 4; ++t) { a[t] = outv[t][e]; bq[t] = outv[4 + t][e]; }
                                *(u32x4*)(lds + OFF_BT + (n0 + e) * T_ST + tg * 16) = pack8(a, bq); }
                        }
                    }
                }
            }
            if (c + 1 < 32) SSD_LOAD(c + 1);
            __syncthreads();
#pragma unroll
            for (int t2 = 0; t2 < 2; ++t2) {
                const int tile = 2 * wid + t2, sb = tile >> 2, lb = tile & 3;
                f32x4 d = (f32x4){0.f, 0.f, 0.f, 0.f};
                if (sb <= lb) {
#pragma unroll
                    for (int ks = 0; ks < 4; ++ks) d = mfma16(ldfrag(lds + OFF_BS, CS_ST, sb * 16 + fr, ks * 32 + fq * 8), ldfrag(lds + OFF_CS, CS_ST, lb * 16 + fr, ks * 32 + fq * 8), d);
                    const int l = lb * 16 + fr; const float al = __shfl(acs, l);
                    f32x4 as;
#pragma unroll
                    for (int r = 0; r < 4; ++r) as[r] = __shfl(acs, sb * 16 + 4 * fq + r);
#pragma unroll
                    for (int r = 0; r < 4; ++r) { const int s = sb * 16 + 4 * fq + r; d[r] = (s <= l) ? d[r] * __expf(al - as[r]) : 0.f; }
                }
                u32x2 w; w.x = cvt_pk_bf16(d[0], d[1]); w.y = cvt_pk_bf16(d[2], d[3]);
                *(u32x2*)(lds + OFF_MT + (lb * 16 + fr) * T_ST + (sb * 16 + 4 * fq) * 2) = w;
            }
            if (DBG_SSD_SYNC) __syncthreads();
            f32x4 yacc[2];
#pragma unroll
            for (int t2 = 0; t2 < 2; ++t2) {
                const int tile = 2 * wid + t2, pb = tile >> 2, lb = tile & 3;
                f32x4 d = (f32x4){0.f, 0.f, 0.f, 0.f};
#pragma unroll
                for (int ks = 0; ks < 4; ++ks) d = mfma16(ldfrag(lds + OFF_HS, CS_ST, pb * 16 + fr, ks * 32 + fq * 8), ldfrag(lds + OFF_CS, CS_ST, lb * 16 + fr, ks * 32 + fq * 8), d);
                const float el = __expf(__shfl(acs, lb * 16 + fr));
                yacc[t2] = d * el;
            }
            __syncthreads();
#pragma unroll
            for (int t2 = 0; t2 < 2; ++t2) {
                const int tile = 2 * wid + t2, pb = tile >> 2, lb = tile & 3;
                f32x4 d = yacc[t2];
#pragma unroll
                for (int ks = 0; ks < 2; ++ks) d = mfma16(ldfrag(lds + OFF_XT, T_ST, pb * 16 + fr, ks * 32 + fq * 8), ldfrag(lds + OFF_MT, T_ST, lb * 16 + fr, ks * 32 + fq * 8), d);
                const int l = lb * 16 + fr, p0 = pb * 16 + 4 * fq; const size_t tok = tokb + c * 64 + l;
                const u32x2 zz = zpre[t2];
                const float z0 = bflo(zz.x), z1 = bfhi(zz.x), z2 = bflo(zz.y), z3 = bfhi(zz.y);
                float xs[4];
#pragma unroll
                for (int r = 0; r < 4; ++r) xs[r] = bflo((unsigned)*(const bf16_t*)(lds + OFF_XS + (p0 + r) * T_ST + l * 2));
                u32x2 w; w.x = cvt_pk_bf16((d[0] + xs[0] * dsk) * z0, (d[1] + xs[1] * dsk) * z1); w.y = cvt_pk_bf16((d[2] + xs[2] * dsk) * z2, (d[3] + xs[3] * dsk) * z3);
                *(u32x2*)(YG + tok * 1024 + h * 64 + p0) = w;
            }
            if (DBG_SSD_SYNC) __syncthreads();
            { const float dc = __expf(alast);
#pragma unroll
              for (int t = 0; t < 4; ++t) { f32x4 d = hst[t] * dc;
#pragma unroll
                  for (int ks = 0; ks < 2; ++ks) d = mfma16(ldfrag(lds + OFF_BT, T_ST, wid * 16 + fr, ks * 32 + fq * 8), ldfrag(lds + OFF_XW, T_ST, t * 16 + fr, ks * 32 + fq * 8), d);
                  hst[t] = d;
                  u32x2 w; w.x = cvt_pk_bf16(d[0], d[1]); w.y = cvt_pk_bf16(d[2], d[3]);
                  *(u32x2*)(lds + OFF_HS + (t * 16 + fr) * CS_ST + (wid * 16 + 4 * fq) * 2) = w; } }
            __syncthreads();
        }
#undef SSD_LOAD
    }
}

namespace ssd2 {
constexpr int CS_ST = 272, T_ST = 144;
constexpr int OFF_CS = 0, OFF_BS = 64 * CS_ST, OFF_BT = 2 * 64 * CS_ST, OFF_H0 = OFF_BT + 128 * T_ST;
constexpr int H_XS = 0, H_XW = 64 * T_ST, H_MT = 2 * 64 * T_ST, H_HS = 3 * 64 * T_ST, H_SZ = H_HS + 64 * CS_ST;
constexpr int OFF_CW = OFF_H0 + 2 * H_SZ;
static_assert(OFF_CW + 5 * 384 * 4 <= LDS_MISC, "ssd2 lds");
}
__device__ __forceinline__ void ph_ssd2(Frame& F) {
    using namespace ssd2; using ssd::mfma16; using ssd::ldfrag;
    char* lds = (char*)(unsigned char*)F.lds;
    const bf16_t* XBC = (const bf16_t*)(F.ws + WS_XBC); const bf16_t* ZS = (const bf16_t*)(F.ws + WS_Z); const float* DT = (const float*)(F.outb + OUT_DT);
    bf16_t* YG = (bf16_t*)(F.ws + WS_Q);
    const float* conv_w = F.a->in[9]; const float* conv_b = F.a->in[10]; const float* a_log = F.a->in[12]; const float* d_skip = F.a->in[13];
    const int tid = F.tid, wid = F.wave, lane = F.lane, fr = lane & 15, fq = lane >> 4;
    const bool stager = tid < 384; const int so = tid % 48, tg = tid / 48, shd = (so >> 3) & 1;
    for (int item = F.bid; item < NB * 8; item += F.G) {
        const int b = item >> 3, g = (item >> 1) & 3, h0 = g * 4 + (item & 1) * 2;
        const float aneg0 = -__expf(a_log[h0]), aneg1 = -__expf(a_log[h0 + 1]), dsk0 = d_skip[h0], dsk1 = d_skip[h0 + 1];
        const int ch0 = so < 16 ? (h0 + shd) * 64 + (so & 7) * 8 : (so < 32 ? 1024 + g * 128 + (so - 16) * 8 : 1536 + g * 128 + (so - 32) * 8);
        float* CWL = (float*)(lds + OFF_CW);
        __syncthreads();
        if (stager) {
#pragma unroll
            for (int j = 0; j < 4; ++j) { *(f32x4*)(CWL + j * 384 + so * 8) = *(const f32x4*)(conv_w + (size_t)j * 2048 + ch0); *(f32x4*)(CWL + j * 384 + so * 8 + 4) = *(const f32x4*)(conv_w + (size_t)j * 2048 + ch0 + 4); }
            *(f32x4*)(CWL + 4 * 384 + so * 8) = *(const f32x4*)(conv_b + ch0); *(f32x4*)(CWL + 4 * 384 + so * 8 + 4) = *(const f32x4*)(conv_b + ch0 + 4);
        }
        f32x4 hst[2][4];
#pragma unroll
        for (int hh = 0; hh < 2; ++hh)
#pragma unroll
            for (int t = 0; t < 4; ++t) hst[hh][t] = (f32x4){0.f, 0.f, 0.f, 0.f};
        for (int i = tid; i < 64 * CS_ST / 4; i += NTHR) { ((unsigned*)(lds + OFF_H0 + H_HS))[i] = 0u; ((unsigned*)(lds + OFF_H0 + H_SZ + H_HS))[i] = 0u; }
        u32x4 raw[11];
        const size_t tokb = (size_t)b * SEQ;
        const bf16_t* xrow = XBC + ((ptrdiff_t)tokb + tg * 8 - 3) * 2048 + ch0;
#define SSD_LOAD(c, xp, tgx) do { if (stager) { _Pragma("unroll") for (int i = 0; i < 11; ++i) { const int t = (c) * 64 + (tgx) * 8 - 3 + i; \
            raw[i] = (t >= 0) ? *(const u32x4*)((xp) + (ptrdiff_t)((c) * 64 + i) * 2048) : (u32x4){0u, 0u, 0u, 0u}; } } } while (0)
        SSD_LOAD(0, xrow, tg);
        f32x2 dtn = *(const f32x2*)(DT + (tokb + lane) * 16 + h0);
        for (int c = 0; c < 32; ++c) {
            int frl = fr, fql = fq, tgl = tg, sol = so; const bf16_t* xrl = xrow; asm volatile("" : "+v"(frl), "+v"(fql), "+v"(tgl), "+v"(sol), "+v"(xrl)); const int shdl = (sol >> 3) & 1;
            const float dtl0 = dtn[0], dtl1 = dtn[1]; if (c + 1 < 32) dtn = *(const f32x2*)(DT + (tokb + (c + 1) * 64 + lane) * 16 + h0);
            u32x2 zpre[2][2];
#pragma unroll
            for (int hh = 0; hh < 2; ++hh)
#pragma unroll
                for (int t2 = 0; t2 < 2; ++t2) { const int tile = 2 * wid + t2, pb = tile >> 2, lb = tile & 3; zpre[hh][t2] = *(const u32x2*)(ZS + (tokb + c * 64 + lb * 16 + frl) * 1024 + (h0 + hh) * 64 + pb * 16 + 4 * fql); }
            float acs0 = dtl0 * aneg0, acs1 = dtl1 * aneg1;
#pragma unroll
            for (int o = 1; o < 64; o <<= 1) { const float t0 = __shfl_up(acs0, o), t1 = __shfl_up(acs1, o); if (lane >= o) { acs0 += t0; acs1 += t1; } }
            const float alast0 = __shfl(acs0, 63), alast1 = __shfl(acs1, 63);
            float wdt[8];
#pragma unroll
            for (int t = 0; t < 8; ++t) { const int sl = (tgl * 8 + t) & 63; const float d0 = __shfl(dtl0, sl), d1 = __shfl(dtl1, sl), a0 = __shfl(acs0, sl), a1 = __shfl(acs1, sl);
                wdt[t] = (shdl ? d1 : d0) * __expf(shdl ? alast1 - a1 : alast0 - a0); }
            if (stager) {
#pragma unroll
                for (int cp = 0; cp < 4; ++cp) {
                    float xin[11][2];
#pragma unroll
                    for (int i = 0; i < 11; ++i) { const unsigned wa = cp == 0 ? raw[i].x : (cp == 1 ? raw[i].y : (cp == 2 ? raw[i].z : raw[i].w)); xin[i][0] = bflo(wa); xin[i][1] = bfhi(wa); }
                    float outv[8][2];
                    { f32x2 cwv[4]; const f32x2 cbq = *(const f32x2*)(CWL + 4 * 384 + sol * 8 + cp * 2);
#pragma unroll
                      for (int j = 0; j < 4; ++j) cwv[j] = *(const f32x2*)(CWL + j * 384 + sol * 8 + cp * 2);
#pragma unroll
                      for (int t = 0; t < 8; ++t)
#pragma unroll
                        for (int e = 0; e < 2; ++e) { float sacc = cbq[e];
#pragma unroll
                            for (int j = 0; j < 4; ++j) sacc += cwv[j][e] * xin[t + j][e];
                            outv[t][e] = silu_f(sacc); } }
                    if (sol < 16) {
                        char* hb = lds + OFF_H0 + shdl * H_SZ;
#pragma unroll
                        for (int e = 0; e < 2; ++e) { const int p = (sol & 7) * 8 + cp * 2 + e;
                            f32x4 x0, x1, w0, w1;
#pragma unroll
                            for (int t = 0; t < 4; ++t) { x0[t] = outv[t][e]; x1[t] = outv[4 + t][e]; w0[t] = x0[t] * wdt[t]; w1[t] = x1[t] * wdt[4 + t]; }
                            *(u32x4*)(hb + H_XS + p * T_ST + tgl * 16) = pack8(x0, x1);
                            *(u32x4*)(hb + H_XW + p * T_ST + tgl * 16) = pack8(w0, w1); }
                    } else {
                        const bool isB = sol < 32; const int n0 = (isB ? (sol - 16) : (sol - 32)) * 8 + cp * 2;
                        char* nat = lds + (isB ? OFF_BS : OFF_CS);
#pragma unroll
                        for (int t = 0; t < 8; ++t) *(unsigned*)(nat + (tgl * 8 + t) * CS_ST + n0 * 2) = cvt_pk_bf16(outv[t][0], outv[t][1]);
                        if (isB) {
#pragma unroll
                            for (int e = 0; e < 2; ++e) { f32x4 a, bq;
#pragma unroll
                                for (int t = 0; t < 4; ++t) { a[t] = outv[t][e]; bq[t] = outv[4 + t][e]; }
                                *(u32x4*)(lds + OFF_BT + (n0 + e) * T_ST + tgl * 16) = pack8(a, bq); }
                        }
                    }
                    SBAR();
                }
            }
            if (c + 1 < 32) SSD_LOAD(c + 1, xrl, tgl);
            __syncthreads();
#pragma unroll
            for (int t2 = 0; t2 < 2; ++t2) {
                const int tile = 2 * wid + t2, sb = tile >> 2, lb = tile & 3;
                f32x4 d = (f32x4){0.f, 0.f, 0.f, 0.f}, m0 = d, m1 = d;
                if (sb <= lb) {
#pragma unroll
                    for (int ks = 0; ks < 4; ++ks) d = mfma16(ldfrag(lds + OFF_BS, CS_ST, sb * 16 + frl, ks * 32 + fql * 8), ldfrag(lds + OFF_CS, CS_ST, lb * 16 + frl, ks * 32 + fql * 8), d);
                    const int l = lb * 16 + frl; const float al0 = __shfl(acs0, l), al1 = __shfl(acs1, l);
#pragma unroll
                    for (int r = 0; r < 4; ++r) { const int sidx = sb * 16 + 4 * fql + r; const float as0 = __shfl(acs0, sidx), as1 = __shfl(acs1, sidx), ds0 = __shfl(dtl0, sidx), ds1 = __shfl(dtl1, sidx);
                        m0[r] = (sidx <= l) ? d[r] * __expf(al0 - as0) * ds0 : 0.f; m1[r] = (sidx <= l) ? d[r] * __expf(al1 - as1) * ds1 : 0.f; }
                }
                u32x2 w; w.x = cvt_pk_bf16(m0[0], m0[1]); w.y = cvt_pk_bf16(m0[2], m0[3]);
                *(u32x2*)(lds + OFF_H0 + H_MT + (lb * 16 + frl) * T_ST + (sb * 16 + 4 * fql) * 2) = w;
                w.x = cvt_pk_bf16(m1[0], m1[1]); w.y = cvt_pk_bf16(m1[2], m1[3]);
                *(u32x2*)(lds + OFF_H0 + H_SZ + H_MT + (lb * 16 + frl) * T_ST + (sb * 16 + 4 * fql) * 2) = w;
            }
            f32x4 yacc[2][2];
#pragma unroll
            for (int hh = 0; hh < 2; ++hh)
#pragma unroll
                for (int t2 = 0; t2 < 2; ++t2) {
                    const int tile = 2 * wid + t2, pb = tile >> 2, lb = tile & 3; const char* hb = lds + OFF_H0 + hh * H_SZ;
                    f32x4 d = (f32x4){0.f, 0.f, 0.f, 0.f};
#pragma unroll
                    for (int ks = 0; ks < 4; ++ks) d = mfma16(ldfrag(hb + H_HS, CS_ST, pb * 16 + frl, ks * 32 + fql * 8), ldfrag(lds + OFF_CS, CS_ST, lb * 16 + frl, ks * 32 + fql * 8), d);
                    const float el = __expf(__shfl(hh ? acs1 : acs0, lb * 16 + frl));
                    yacc[hh][t2] = d * el;
                }
            __syncthreads();
#pragma unroll
            for (int hh = 0; hh < 2; ++hh)
#pragma unroll
                for (int t2 = 0; t2 < 2; ++t2) {
                    const int tile = 2 * wid + t2, pb = tile >> 2, lb = tile & 3; const char* hb = lds + OFF_H0 + hh * H_SZ;
                    f32x4 d = yacc[hh][t2];
#pragma unroll
                    for (int ks = 0; ks < 2; ++ks) d = mfma16(ldfrag(hb + H_XS, T_ST, pb * 16 + frl, ks * 32 + fql * 8), ldfrag(hb + H_MT, T_ST, lb * 16 + frl, ks * 32 + fql * 8), d);
                    const int l = lb * 16 + frl, p0 = pb * 16 + 4 * fql; const size_t tok = tokb + c * 64 + l; const float dsk = hh ? dsk1 : dsk0;
                    const u32x2 zz = zpre[hh][t2];
                    const float z0 = bflo(zz.x), z1 = bfhi(zz.x), z2 = bflo(zz.y), z3 = bfhi(zz.y);
                    float xs[4];
#pragma unroll
                    for (int r = 0; r < 4; ++r) xs[r] = bflo((unsigned)*(const bf16_t*)(hb + H_XS + (p0 + r) * T_ST + l * 2));
                    u32x2 w; w.x = cvt_pk_bf16((d[0] + xs[0] * dsk) * z0, (d[1] + xs[1] * dsk) * z1); w.y = cvt_pk_bf16((d[2] + xs[2] * dsk) * z2, (d[3] + xs[3] * dsk) * z3);
                    *(u32x2*)(YG + tok * 1024 + (h0 + hh) * 64 + p0) = w;
                }
#pragma unroll
            for (int hh = 0; hh < 2; ++hh) { const float dc = __expf(hh ? alast1 : alast0); char* hb = lds + OFF_H0 + hh * H_SZ;
#pragma unroll
                for (int t = 0; t < 4; ++t) { f32x4 d = hst[hh][t] * dc;
#pragma unroll
                    for (int ks = 0; ks < 2; ++ks) d = mfma16(ldfrag(lds + OFF_BT, T_ST, wid * 16 + frl, ks * 32 + fql * 8), ldfrag(hb + H_XW, T_ST, t * 16 + frl, ks * 32 + fql * 8), d);
                    hst[hh][t] = d;
                    u32x2 w; w.x = cvt_pk_bf16(d[0], d[1]); w.y = cvt_pk_bf16(d[2], d[3]);
                    *(u32x2*)(hb + H_HS + (t * 16 + frl) * CS_ST + (wid * 16 + 4 * fql) * 2) = w; } }
            __syncthreads();
        }
#undef SSD_LOAD
    }
}

__device__ __forceinline__ void ph_gnorm(Frame& F) {
    bf16_t* YG = (bf16_t*)(F.ws + WS_Q);
    const int gw = F.bid * NWAVES + F.wave, NGW = F.G * NWAVES;
    for (int m = gw; m < NTOK; m += NGW) {
        u32x2* rp = (u32x2*)(YG + (size_t)m * D) + F.lane;
#pragma unroll
        for (int j = 0; j < 4; ++j) { const u32x2 w = rp[64 * j]; const float a = bflo(w.x), b = bfhi(w.x), c = bflo(w.y), d = bfhi(w.y);
            const float ss = wave_sum(a * a + b * b + c * c + d * d); const float r = 1.f / sqrtf(ss * (1.f / 256.f) + LN_EPS);
            if (PB_FP8) { int pk = 0; pk = __builtin_amdgcn_cvt_pk_fp8_f32(a * r, b * r, pk, false); pk = __builtin_amdgcn_cvt_pk_fp8_f32(c * r, d * r, pk, true); ((unsigned*)(F.outb + OUT_OB8 + (size_t)m * D))[F.lane + 64 * j] = (unsigned)pk; }
            else { u32x2 o; o.x = cvt_pk_bf16(a * r, b * r); o.y = cvt_pk_bf16(c * r, d * r); rp[64 * j] = o; } }
    }
}

template <bool DRY = false> __device__ __forceinline__ void ph_router(Frame& F) {
    float* X1 = (float*)F.outb; bf16_t* U2 = (bf16_t*)(F.ws + WS_U2); const float* MOD = (const float*)(F.ws + WS_MOD);
    const float* ln1g = F.a->in[18]; const float* ln1b = F.a->in[19]; const float* w_router = F.a->in[20]; const float* b_router = F.a->in[21];
    u32x2* REG = (u32x2*)(F.ws + WS_REG); unsigned* CNT = (unsigned*)(F.ws + WS_CTL) + CW_CNT;
    constexpr int TST = 2064;
    LAS unsigned char* THI = F.lds; LAS unsigned char* TLO = F.lds + 16 * TST; LAS float* PART = (LAS float*)(F.lds + 32 * TST);
    LAS unsigned* lcnt = (LAS unsigned*)(F.lds + LDS_AUX); LAS unsigned* lbase = lcnt + 32; LAS unsigned* ent = lcnt + 64;
    const int tid = F.tid, lane = F.lane, wid = F.wave, fr = lane & 15, fq = lane >> 4;
    bf16x8 whi[4][2], wlo[4][2];
#pragma unroll
    for (int ks = 0; ks < 4; ++ks)
#pragma unroll
        for (int ct = 0; ct < 2; ++ct) { float wv[8];
#pragma unroll
            for (int i = 0; i < 8; ++i) wv[i] = w_router[(size_t)(128 * wid + 32 * ks + 8 * fq + i) * 32 + ct * 16 + fr];
            u32x4 h, l2;
#pragma unroll
            for (int i = 0; i < 4; ++i) { const unsigned hp = cvt_pk_bf16(wv[2 * i], wv[2 * i + 1]); const float r0 = wv[2 * i] - bflo(hp), r1 = wv[2 * i + 1] - bfhi(hp); h[i] = hp; l2[i] = cvt_pk_bf16(r0, r1); }
            whi[ks][ct] = __builtin_bit_cast(bf16x8, h); wlo[ks][ct] = __builtin_bit_cast(bf16x8, l2); }
    const float brl = b_router[lane & 31];
    for (int batch = F.bid; batch < NTOK / 256; batch += F.G) {
        const int hf = batch >> 7;
        __syncthreads();
        if (tid < 32) lcnt[tid] = 0u;
        for (int grp = 0; grp < 16; ++grp) {
#pragma unroll
            for (int tt = 0; tt < 2; ++tt) {
                const int tg16 = 2 * wid + tt, m = batch * 256 + grp * 16 + tg16; const float* md = MOD + (size_t)(m >> 11) * 6144;
                f32x4* xr = (f32x4*)(X1 + (size_t)m * D) + lane;
                f32x4 v[4]; float s = 0.f;
#pragma unroll
                for (int j = 0; j < 4; ++j) { v[j] = xr[64 * j]; s += (v[j][0] + v[j][1]) + (v[j][2] + v[j][3]); }
                float mean = wave_sum(s) * (1.f / D), s2 = 0.f;
#pragma unroll
                for (int j = 0; j < 4; ++j) { v[j] = v[j] - mean; s2 += (v[j][0] * v[j][0] + v[j][1] * v[j][1]) + (v[j][2] * v[j][2] + v[j][3] * v[j][3]); }
                float rstd = 1.f / sqrtf(wave_sum(s2) * (1.f / D) + LN_EPS);
                s = 0.f;
#pragma unroll
                for (int j = 0; j < 4; ++j) { const f32x4 g = *((const f32x4*)ln1g + lane + 64 * j), bb = *((const f32x4*)ln1b + lane + 64 * j); v[j] = v[j] * rstd * g + bb; if (!DRY) xr[64 * j] = v[j]; s += (v[j][0] + v[j][1]) + (v[j][2] + v[j][3]); }
                mean = wave_sum(s) * (1.f / D); s2 = 0.f;
#pragma unroll
                for (int j = 0; j < 4; ++j) { v[j] = v[j] - mean; s2 += (v[j][0] * v[j][0] + v[j][1] * v[j][1]) + (v[j][2] * v[j][2] + v[j][3] * v[j][3]); }
                rstd = 1.f / sqrtf(wave_sum(s2) * (1.f / D) + LN_EPS);
                u32x2* o8 = (u32x2*)(U2 + (size_t)m * D) + lane;
#pragma unroll
                for (int j = 0; j < 4; ++j) { const f32x4 sh = *((const f32x4*)(md + 3072) + lane + 64 * j), sc = *((const f32x4*)(md + 4096) + lane + 64 * j);
                    v[j] = v[j] * rstd * (sc + 1.0f) + sh; u32x2 w; w.x = cvt_pk_bf16(v[j][0], v[j][1]); w.y = cvt_pk_bf16(v[j][2], v[j][3]);
                    if (DRY) { if (w.x == 0x12345678u) o8[64 * j] = w; }
                    else if (MOE_FP8) { int pk = 0; pk = __builtin_amdgcn_cvt_pk_fp8_f32(v[j][0], v[j][1], pk, false); pk = __builtin_amdgcn_cvt_pk_fp8_f32(v[j][2], v[j][3], pk, true); ((unsigned*)((unsigned char*)U2 + (size_t)m * D))[lane + 64 * j] = (unsigned)pk; }
                    else o8[64 * j] = w;
                    u32x2 lo; lo.x = cvt_pk_bf16(v[j][0] - bflo(w.x), v[j][1] - bfhi(w.x)); lo.y = cvt_pk_bf16(v[j][2] - bflo(w.y), v[j][3] - bfhi(w.y));
                    *(LAS u32x2*)(THI + tg16 * TST + (4 * lane + 256 * j) * 2) = w; *(LAS u32x2*)(TLO + tg16 * TST + (4 * lane + 256 * j) * 2) = lo; }
            }
            __syncthreads();
            { f32x4 a0 = (f32x4){0.f, 0.f, 0.f, 0.f}, a1 = a0;
#pragma unroll
              for (int ks = 0; ks < 4; ++ks) { const int cb = (128 * wid + 32 * ks + 8 * fq) * 2;
                  const bf16x8 th = *(const LAS bf16x8*)(THI + fr * TST + cb), tl = *(const LAS bf16x8*)(TLO + fr * TST + cb);
                  a0 = __builtin_amdgcn_mfma_f32_16x16x32_bf16(whi[ks][0], th, a0, 0, 0, 0); a1 = __builtin_amdgcn_mfma_f32_16x16x32_bf16(whi[ks][1], th, a1, 0, 0, 0);
                  a0 = __builtin_amdgcn_mfma_f32_16x16x32_bf16(wlo[ks][0], th, a0, 0, 0, 0); a1 = __builtin_amdgcn_mfma_f32_16x16x32_bf16(wlo[ks][1], th, a1, 0, 0, 0);
                  a0 = __builtin_amdgcn_mfma_f32_16x16x32_bf16(whi[ks][0], tl, a0, 0, 0, 0); a1 = __builtin_amdgcn_mfma_f32_16x16x32_bf16(whi[ks][1], tl, a1, 0, 0, 0); }
              *(LAS f32x4*)(PART + (wid * 16 + fr) * 32 + 4 * fq) = a0; *(LAS f32x4*)(PART + (wid * 16 + fr) * 32 + 16 + 4 * fq) = a1; }
            __syncthreads();
            { const int tg16 = 2 * wid + (lane >> 5), tl = grp * 16 + tg16, myexp = lane & 31;
              float logit = brl;
#pragma unroll
              for (int w8 = 0; w8 < 8; ++w8) logit += PART[(w8 * 16 + tg16) * 32 + myexp];
              float tv[4]; int tix[4];
#pragma unroll
              for (int k = 0; k < 4; ++k) { float bv = logit; int bi = myexp;
#pragma unroll
                  for (int o = 1; o < 32; o <<= 1) { const float ov = __shfl_xor(bv, o); const int oi = __shfl_xor(bi, o); if (ov > bv || (ov == bv && oi < bi)) { bv = ov; bi = oi; } }
                  tv[k] = bv; tix[k] = bi; if (myexp == bi) logit = -INFINITY; }
              const float e1 = __expf(tv[1] - tv[0]), e2 = __expf(tv[2] - tv[0]), e3 = __expf(tv[3] - tv[0]); const float inv = 1.f / (1.f + e1 + e2 + e3);
              if (myexp < 4) { const int ee = myexp == 0 ? tix[0] : (myexp == 1 ? tix[1] : (myexp == 2 ? tix[2] : tix[3])); const float gg = (myexp == 0 ? 1.f : (myexp == 1 ? e1 : (myexp == 2 ? e2 : e3))) * inv;
                  const unsigned lp = atomicAdd((unsigned*)&lcnt[ee], 1u);
                  LAS unsigned* en = ent + (tl * 4 + myexp) * 3; en[0] = (unsigned)ee; en[1] = lp; en[2] = __float_as_uint(gg);
                  if (DBG_CHECK == 1) { u32x2 rw; rw.x = (unsigned)ee; rw.y = __float_as_uint(gg); ((u32x2*)(F.ws + WS_DBG))[(size_t)(batch * 256 + tl) * 4 + myexp] = rw; } } }
        }
        __syncthreads();
        if (tid < 32) lbase[tid] = DRY ? 0u : __hip_atomic_fetch_add(CNT + 64 * (hf * 32 + tid), lcnt[tid], __ATOMIC_RELAXED, __HIP_MEMORY_SCOPE_AGENT);
        __syncthreads();
        for (int i = tid; i < 1024; i += NTHR) { const LAS unsigned* en = ent + i * 3; const unsigned ee = en[0], pos = lbase[ee] + en[1];
            const unsigned tokl = (unsigned)(batch * 256 + (i >> 2)) - (unsigned)hf * HALF_TOK;
            u32x2 w; w.x = tokl * 4u + (unsigned)(i & 3); w.y = en[2];
            if (!DRY && pos < (unsigned)REG_CAP) REG[((size_t)hf * 32 + ee) * REG_CAP + pos] = w; }
    }
}

template <bool DRY = false> __device__ __forceinline__ void ph_final(Frame& F, int hf) {
    float* X1 = (float*)F.outb; const bf16_t* YB = (const bf16_t*)(F.ws + WS_YB); const float* MOD = (const float*)(F.ws + WS_MOD);
    const float* g2 = F.a->in[26]; const float* b2 = F.a->in[27];
    const int gw = F.bid * NWAVES + F.wave, NGW = F.G * NWAVES, lane = F.lane;
    constexpr int RB = 2;
    for (int tl0 = gw; tl0 < HALF_TOK; tl0 += NGW * RB) {
        f32x4 xv[RB][4]; u32x2 yw[RB][4][4];
#pragma unroll
        for (int r = 0; r < RB; ++r) { const int tl = tl0 + r * NGW, m = hf * HALF_TOK + tl;
            const f32x4* xr = (const f32x4*)(X1 + (size_t)m * D) + lane; const u32x2* yr = (const u32x2*)(YB + (size_t)tl * 4 * D) + lane;
#pragma unroll
            for (int j = 0; j < 4; ++j) { xv[r][j] = xr[64 * j];
#pragma unroll
                for (int k = 0; k < 4; ++k) yw[r][j][k] = yr[k * 256 + 64 * j]; } }
#pragma unroll
        for (int r = 0; r < RB; ++r) { const int tl = tl0 + r * NGW, m = hf * HALF_TOK + tl; const float* md = MOD + (size_t)(m >> 11) * 6144 + 5120;
            f32x4* xr = (f32x4*)(X1 + (size_t)m * D) + lane;
            f32x4 v[4]; float s = 0.f;
#pragma unroll
            for (int j = 0; j < 4; ++j) { f32x4 y = (f32x4){0.f, 0.f, 0.f, 0.f};
#pragma unroll
                for (int k = 0; k < 4; ++k) { const u32x2 w = yw[r][j][k]; y[0] += bflo(w.x); y[1] += bfhi(w.x); y[2] += bflo(w.y); y[3] += bfhi(w.y); }
                if (DBG_NO_MOE) y = (f32x4){0.f, 0.f, 0.f, 0.f};
                const f32x4 gt = *((const f32x4*)md + lane + 64 * j);
                v[j] = xv[r][j] * DN_ALPHA + gt * y; s += (v[j][0] + v[j][1]) + (v[j][2] + v[j][3]); }
            const float mean = wave_sum(s) * (1.f / D); float s2 = 0.f;
#pragma unroll
            for (int j = 0; j < 4; ++j) { v[j] = v[j] - mean; s2 += (v[j][0] * v[j][0] + v[j][1] * v[j][1]) + (v[j][2] * v[j][2] + v[j][3] * v[j][3]); }
            const float rstd = 1.f / sqrtf(wave_sum(s2) * (1.f / D) + LN_EPS);
#pragma unroll
            for (int j = 0; j < 4; ++j) { const f32x4 g = *((const f32x4*)g2 + lane + 64 * j), bb = *((const f32x4*)b2 + lane + 64 * j); const f32x4 ov = v[j] * rstd * g + bb; if (!DRY || ov[0] == 1.2345e-33f) xr[64 * j] = ov; } }
    }
}

__device__ __forceinline__ float block_sum(Frame& F, float v, LAS float* red) {
    v = wave_sum(v); __syncthreads(); if (F.lane == 0) red[F.wave] = v; __syncthreads();
    float s = 0.f; for (int w = 0; w < NWAVES; ++w) s += red[w]; return s;
}
__device__ __forceinline__ float block_max(Frame& F, float v, LAS float* red) {
#pragma unroll
    for (int o = 1; o < 64; o <<= 1) v = fmaxf(v, __shfl_xor(v, o));
    __syncthreads(); if (F.lane == 0) red[F.wave] = v; __syncthreads();
    float s = 0.f; for (int w = 0; w < NWAVES; ++w) s = fmaxf(s, red[w]); return s;
}
__device__ __forceinline__ void dbg_report(Frame& F, float e) { if (F.tid == 0) atomicMax((unsigned*)(F.ws + WS_CTL) + CW_DBG, __float_as_uint(e)); }
__device__ __forceinline__ void dbg_check_moe(Frame& F) {
    if (F.bid >= 64) return;
    const int tok = HALF_TOK + 509 * F.bid + 3, tokl = tok - HALF_TOK, tid = F.tid;
    LAS float* u2 = (LAS float*)F.lds; LAS float* act = u2 + 1024; LAS float* red = act + 1024; LAS float* lg = red + 16;
    const bf16_t* U2 = (const bf16_t*)(F.ws + WS_U2); const bf16_t* YB = (const bf16_t*)(F.ws + WS_YB); const u32x2* RT = (const u32x2*)(F.ws + WS_DBG);
    const float* w1 = F.a->in[22]; const float* b1 = F.a->in[23]; const float* w2 = F.a->in[24]; const float* b2 = F.a->in[25];
    __syncthreads();
    for (int i = tid; i < 1024; i += NTHR) u2[i] = bflo((unsigned)U2[(size_t)tok * 1024 + i]);
    __syncthreads();
    float y0 = 0.f, y1 = 0.f;
    for (int k = 0; k < 4; ++k) {
        const u32x2 rw = RT[(size_t)tok * 4 + k]; const int e = (int)rw.x; const float g = __uint_as_float(rw.y);
        const float* W1 = w1 + (size_t)e * 1024 * 2048; const float* W2 = w2 + (size_t)e * 1024 * 1024;
        float h0 = b1[e * 2048 + tid], h1 = b1[e * 2048 + tid + 512], h2 = b1[e * 2048 + tid + 1024], h3 = b1[e * 2048 + tid + 1536];
        for (int c = 0; c < 1024; ++c) { const float uu = u2[c]; const float* wr = W1 + (size_t)c * 2048 + tid; h0 += uu * wr[0]; h1 += uu * wr[512]; h2 += uu * wr[1024]; h3 += uu * wr[1536]; }
        __syncthreads();
        { float gg = fminf(h0, 7.f), up = fminf(fmaxf(h2, -7.f), 7.f); act[tid] = (up + 1.f) * gg / (1.f + expf(-1.702f * gg));
          gg = fminf(h1, 7.f); up = fminf(fmaxf(h3, -7.f), 7.f); act[tid + 512] = (up + 1.f) * gg / (1.f + expf(-1.702f * gg)); }
        __syncthreads();
        float a0 = b2[e * 1024 + tid], a1 = b2[e * 1024 + tid + 512];
        for (int j = 0; j < 1024; ++j) { const float aa = act[j]; a0 += aa * W2[(size_t)j * 1024 + tid]; a1 += aa * W2[(size_t)j * 1024 + tid + 512]; }
        y0 += g * a0; y1 += g * a1;
    }
    float f0 = 0.f, f1 = 0.f;
    for (int k = 0; k < 4; ++k) { f0 += bflo((unsigned)YB[((size_t)tokl * 4 + k) * 1024 + tid]); f1 += bflo((unsigned)YB[((size_t)tokl * 4 + k) * 1024 + tid + 512]); }
    const float rms = sqrtf(block_sum(F, y0 * y0 + y1 * y1, red) * (1.f / 1024.f)) + 1e-20f;
    float err = block_max(F, fmaxf(fabsf(y0 - f0), fabsf(y1 - f1)), red) / rms;
    { const float* X1 = (const float*)F.outb + (size_t)tok * 1024; const float* md = (const float*)(F.ws + WS_MOD) + (size_t)(tok >> 11) * 6144;
      const float xa = X1[tid], xb = X1[tid + 512]; const float mean = block_sum(F, xa + xb, red) * (1.f / 1024.f);
      const float da = xa - mean, db = xb - mean; const float var = block_sum(F, da * da + db * db, red) * (1.f / 1024.f); const float rstd = 1.f / sqrtf(var + LN_EPS);
      __syncthreads();
      u2[tid] = da * rstd * (1.f + md[4096 + tid]) + md[3072 + tid]; u2[tid + 512] = db * rstd * (1.f + md[4096 + tid + 512]) + md[3072 + tid + 512];
      __syncthreads();
      if (tid < 32) { float a = F.a->in[21][tid]; for (int c = 0; c < 1024; ++c) a += u2[c] * F.a->in[20][c * 32 + tid]; lg[tid] = a; }
      __syncthreads();
      if (tid == 0) { unsigned want = 0u, got = 0u; float l2[32]; for (int i = 0; i < 32; ++i) l2[i] = lg[i];
          for (int k = 0; k < 4; ++k) { int bi = 0; for (int i = 1; i < 32; ++i) if (l2[i] > l2[bi]) bi = i; want |= 1u << bi; l2[bi] = -INFINITY; got |= 1u << RT[(size_t)tok * 4 + k].x; }
          lg[32] = (want != got) ? 1.f : 0.f; }
      __syncthreads();
      if (lg[32] != 0.f) err = 50.f; }
    dbg_report(F, err);
}
__device__ __forceinline__ void dbg_check_ssd(Frame& F) {
    if (F.bid >= 2) return;
    const int b = F.bid ? 20 : 5, h = F.bid ? 14 : 3, g = h >> 2, tid = F.tid, p = tid >> 3, ng = tid & 7;
    LAS float* red = (LAS float*)F.lds; LAS float* cv = red + 16;
    const bf16_t* XBC = (const bf16_t*)(F.ws + WS_XBC); const bf16_t* ZS = (const bf16_t*)(F.ws + WS_Z); const float* DT = (const float*)(F.outb + OUT_DT); const bf16_t* YG = (const bf16_t*)(F.ws + WS_Q);
    const float* cw = F.a->in[9]; const float* cb = F.a->in[10]; const float aneg = -expf(F.a->in[12][h]), dsk = F.a->in[13][h];
    const int mych = tid < 64 ? h * 64 + tid : (tid < 192 ? 1024 + g * 128 + (tid - 64) : 1536 + g * 128 + (tid - 192));
    float w0 = 0.f, w1 = 0.f, w2 = 0.f, w3 = 0.f, wb = 0.f;
    if (tid < 320) { w0 = cw[0 * 2048 + mych]; w1 = cw[1 * 2048 + mych]; w2 = cw[2 * 2048 + mych]; w3 = cw[3 * 2048 + mych]; wb = cb[mych]; }
    float x0 = 0.f, x1 = 0.f, x2 = 0.f;
    float hs[16];
#pragma unroll
    for (int i = 0; i < 16; ++i) hs[i] = 0.f;
    float emax = 0.f, ssq = 0.f, nbad = 0.f; int tmax = 0;
    for (int t = 0; t < SEQ; ++t) {
        const size_t tok = (size_t)b * SEQ + t;
        __syncthreads();
        if (DBG_HYP == 1 && (t & 63) == 0) { x0 = 0.f; x1 = 0.f; x2 = 0.f; }
        if (tid < 320) { const float x3 = bflo((unsigned)XBC[tok * 2048 + mych]); const float s = wb + w0 * x0 + w1 * x1 + w2 * x2 + w3 * x3; cv[tid] = s / (1.f + expf(-s)); x0 = x1; x1 = x2; x2 = x3; }
        __syncthreads();
        const float xv = cv[p], dt = DT[tok * 16 + h], dec = expf(dt * aneg);
        float yp = 0.f;
#pragma unroll
        for (int i = 0; i < 16; ++i) { const int n = ng * 16 + i; hs[i] = hs[i] * dec + dt * xv * cv[64 + n]; yp += cv[192 + n] * hs[i]; }
        yp += __shfl_xor(yp, 1); yp += __shfl_xor(yp, 2); yp += __shfl_xor(yp, 4);
        const float yv = (yp + xv * dsk) * bflo((unsigned)ZS[tok * 1024 + h * 64 + p]);
        const float yf = bflo((unsigned)YG[tok * 1024 + h * 64 + p]);
        if (ng == 0) { const float er = fabsf(yv - yf); if (er > emax) { emax = er; tmax = t; } ssq += yv * yv; if (er > 0.25f && (DBG_SUB < 5 || (DBG_SUB == 5 && (t & 63) == 0) || (DBG_SUB == 6 && (t & 63) == 1) || (DBG_SUB == 7 && (t & 63) == 32))) nbad += 1.f; }
    }
    const float rms = sqrtf(block_sum(F, ssq, red) / (64.f * SEQ)) + 1e-20f;
    const float M = block_max(F, emax, red);
    if (DBG_SUB == 0) dbg_report(F, M / rms);
    else if (DBG_SUB == 1) dbg_report(F, block_sum(F, nbad, red) / (64.f * SEQ));
    else if (DBG_SUB >= 5) dbg_report(F, block_sum(F, nbad, red) / (64.f * 32.f));
    else { __syncthreads(); if (ng == 0 && emax == M) red[12] = (float)(DBG_SUB == 2 ? ((tmax & 63) >> 1) : (DBG_SUB == 3 ? (tmax >> 6) : (p >> 1))); __syncthreads();
        if (F.bid == 0) dbg_report(F, powf(10.f, 2.f * (0.05f + 0.05f * red[12]) - 4.f)); }
}
__device__ __forceinline__ void dbg_check_attn(Frame& F) {
    if (F.bid >= 32) return;
    const int b = (F.bid * 7 + 3) & 31, pos = 300 + F.bid * 53, nadm = ((pos >> 6) + 1) * 64, tid = F.tid, lane = F.lane, hd = F.wave;
    const size_t tq = (size_t)b * SEQ + pos;
    LAS float* sc = (LAS float*)F.lds; LAS unsigned char* sel = (LAS unsigned char*)(sc + 2048); LAS float* lgt = (LAS float*)(sel + 2048); LAS float* red = lgt + 8 * 2048; LAS float* misc = red + 16;
    const bf16_t* IQ = (const bf16_t*)(F.outb + OUT_IQ); const bf16_t* IK = (const bf16_t*)(F.outb + OUT_IK); const float* IW = (const float*)(F.outb + OUT_IW);
    const bf16_t* Q = (const bf16_t*)(F.ws + WS_Q); const bf16_t* KV = (const bf16_t*)(F.outb + OUT_KV); const bf16_t* OA = (const bf16_t*)(F.outb + OUT_OA); const u64* MASK = (const u64*)(F.outb + OUT_MASK);
    __syncthreads();
    for (int k = tid; k < nadm; k += NTHR) { float s = 0.f;
        for (int hh = 0; hh < 8; ++hh) { float d = 0.f; for (int c = 0; c < 64; ++c) d += bflo((unsigned)IQ[tq * 512 + hh * 64 + c]) * bflo((unsigned)IK[((size_t)b * SEQ + k) * 64 + c]); s += fmaxf(d, 0.f) * IW[tq * 8 + hh]; }
        sc[k] = s + 0.0f; }
    __syncthreads();
    float nbad = 0.f;
    for (int k = tid; k < nadm; k += NTHR) { const float s = sc[k]; int rank = 0; for (int j = 0; j < nadm; ++j) { const float t = sc[j]; rank += (t > s || (t == s && j < k)) ? 1 : 0; }
        const unsigned char se = rank < 256 ? 1 : 0; sel[k] = se; const unsigned mb = (unsigned)((MASK[tq * 32 + (k >> 6)] >> (k & 63)) & 1ull); if (mb != se) nbad += 1.f; }
    __syncthreads();
    const float nbad_t = block_sum(F, nbad, red);
    LAS float* lw = lgt + hd * 2048; float mx = -INFINITY;
    for (int k = lane; k < nadm; k += 64) { float l = -INFINITY;
        if (sel[k]) { float d = 0.f; for (int c = 0; c < 128; ++c) d += bflo((unsigned)Q[tq * 1024 + hd * 128 + c]) * bflo((unsigned)KV[((size_t)b * SEQ + k) * 128 + c]);
            const int rel = k - pos, n = rel < 0 ? -rel : rel; const float nf = (float)(n > 1 ? n : 1); int large = 8 + (int)(logf(nf / 8.0f) / 2.7725887f * 8.0f); if (large > 15) large = 15;
            const int bucket = (rel > 0 ? 16 : 0) + (n < 8 ? n : large);
            l = d * 0.088388347648318440f + F.a->in[8][bucket * 8 + hd]; }
        lw[k] = l; mx = fmaxf(mx, l); }
#pragma unroll
    for (int o = 1; o < 64; o <<= 1) mx = fmaxf(mx, __shfl_xor(mx, o));
    float den = 0.f;
    for (int k = lane; k < nadm; k += 64) { const float pp = expf(lw[k] - mx); lw[k] = pp; den += pp; }
    den = wave_sum(den);
    float emax = 0.f, ssq = 0.f;
    for (int c2 = 0; c2 < 2; ++c2) { const int c = lane + 64 * c2; float o = 0.f; for (int k = 0; k < nadm; ++k) { const float pp = lw[k]; if (pp != 0.f) o += pp * bflo((unsigned)KV[((size_t)b * SEQ + k) * 128 + c]); }
        o /= den; const float of = bflo((unsigned)OA[tq * 1024 + hd * 128 + c]); emax = fmaxf(emax, fabsf(o - of)); ssq += o * o; }
    const float rms = sqrtf(block_sum(F, ssq, red) * (1.f / 1024.f)) + 1e-20f;
    float err = block_max(F, emax, red) / rms;
    (void)misc;
    if (nbad_t > 0.f) err = 10.f + nbad_t;
    dbg_report(F, err);
}
__device__ __forceinline__ void dbg_emit(Frame& F) {
    float* out = (float*)F.outb;
    for (size_t i = (size_t)F.bid * NTHR + F.tid; i < (size_t)NTOK * D / 4; i += (size_t)F.G * NTHR) ((f32x4*)out)[i] = (f32x4){0.f, 0.f, 0.f, 0.f};
    __syncthreads();
    if (F.bid == 0 && F.tid == 0) { const float e = __uint_as_float(__hip_atomic_load((unsigned*)(F.ws + WS_CTL) + CW_DBG, __ATOMIC_RELAXED, __HIP_MEMORY_SCOPE_AGENT));
        float code = (log10f(fmaxf(e, 1e-30f)) + 4.f) * 0.5f; code = fminf(fmaxf(rintf(code * 20.f) * 0.05f, 0.05f), 3.0f);
        out[0] = sqrtf(67108864.f * 1.01f * (powf(10.f, code) - 1.f)); }
}

constexpr int NPHASE = 17;
__global__ void __launch_bounds__(NTHR, 2) fwd(Args args) {
    extern __shared__ __attribute__((aligned(16))) unsigned char lds_raw[];
    Frame F;
    F.lds = (LAS unsigned char*)lds_raw;
    F.tid = threadIdx.x; F.lane = F.tid & 63; F.wave = __builtin_amdgcn_readfirstlane(F.tid >> 6); F.G = gridDim.x; F.bid = blockIdx.x;
    F.a = &args;
    F.ws = args.ws; F.outb = (unsigned char*)args.out;
    volatile LAS unsigned* MISCW = (volatile LAS unsigned*)(F.lds + LDS_MISC);
    if (F.tid < 64) MISCW[F.tid] = 0u;
    __syncthreads();
    XcdBarrier bar; bar.bar = (unsigned*)(F.ws + WS_CTL) + CW_BAR; bar.x = 0; bar.st = nullptr;
#if MK_ONE
    bar = xcd_barrier_post((unsigned*)(F.ws + WS_CTL) + CW_BAR, MISCW + 8);
#define GRID_BAR() xcd_barrier(bar)
#else
#define GRID_BAR() do { } while (0)
#endif
    const int lo = args.ph_lo, hi = args.ph_hi;
#ifndef PHM
#define PHM (0xFFFFFFFFu & ~(DBG_NO_ATTN ? 0x30u : 0u) & ~(DBG_NO_SSD ? 0xC0u : 0u))
#endif
#define IN(k) (((PHM >> (k)) & 1u) && lo <= (k) && (k) < hi)
#define SEAM(k) do { if ((k) + 1 < hi) GRID_BAR(); } while (0)

    if (IN(0)) { ph_prologue(F); if (DBG_TWICE & 1u) { GRID_BAR(); ph_prologue(F); } SEAM(0); }
    if (IN(1)) { ph_ln1(F); if (DBG_TWICE & 2u) { GRID_BAR(); ph_ln1(F); } SEAM(1); }
    if (IN(2)) {
        EpiProj E{(bf16_t*)(F.ws + WS_Q), (bf16_t*)(F.outb + OUT_IQ), (bf16_t*)(F.ws + WS_Z), (bf16_t*)(F.ws + WS_XBC), (bf16_t*)(F.ws + WS_GA), (bf16_t*)(F.ws + WS_GB), (float*)(F.outb + OUT_MISC), 1.0f};
#if PROJ_FP8
        { SchedProj<2> S; S.o.init(NTOK, 12 * 256, F.G, F.bid); S.A = (const char*)(F.ws + WS_U8); S.Bt = (const char*)(F.ws + WS_WIN8);
          EpiProj E8 = E; E8.sc = MOE_INV;
          pg8::gemm_phase<EpiProj, SchedProj<2>, false, 512, true>(F.lds, S, E8);
          if (DBG_TWICE & 32768u) { GRID_BAR(); pg8::gemm_phase<EpiProj, SchedProj<2>, false, 512, true>(F.lds, S, E8); } }
        { SchedProj<1> S; S.o.init(NTOK, 15 * 256, F.G, F.bid); S.A = (const char*)(F.outb + OUT_U); S.Bt = (const char*)(F.ws + WS_WIN);
          pg8::gemm_phase<EpiProj, SchedProj<1>, false>(F.lds, S, E);
          if (DBG_TWICE & 4u) { GRID_BAR(); pg8::gemm_phase<EpiProj, SchedProj<1>, false>(F.lds, S, E); } }
#else
        { SchedProj<0> S; S.o.init(NTOK, NPROJ, F.G, F.bid); S.A = (const char*)(F.outb + OUT_U); S.Bt = (const char*)(F.ws + WS_WIN);
          pg8::gemm_phase<EpiProj, SchedProj<0>, false>(F.lds, S, E);
          if (DBG_TWICE & 4u) { GRID_BAR(); pg8::gemm_phase<EpiProj, SchedProj<0>, false>(F.lds, S, E); } }
#endif
        SEAM(2);
    }
    if (IN(3)) { ph_misc(F); if (DBG_TWICE & 8u) { GRID_BAR(); ph_misc(F); } SEAM(3); }
    if (IN(4)) { ph_index(F); if (DBG_TWICE & 16u) { GRID_BAR(); ph_index(F); } SEAM(4); }
    if (IN(5)) { ph_attn(F); if (DBG_TWICE & 32u) { GRID_BAR(); ph_attn(F); } SEAM(5); if (DBG_CHECK == 3) { dbg_check_attn(F); GRID_BAR(); } }
    if (IN(6)) { ph_ssd2(F); if (DBG_TWICE & 64u) { GRID_BAR(); ph_ssd2(F); } SEAM(6); if (DBG_CHECK == 2) { dbg_check_ssd(F); GRID_BAR(); } }
    if (IN(7)) { ph_gnorm(F); if (DBG_TWICE & 128u) { GRID_BAR(); ph_gnorm(F); } SEAM(7); }
    if (IN(8)) {
#if PA_FP8
        SchedPlainT<1024> S; S.o.init(NTOK, 1024, F.G, F.bid); S.A = (const char*)(F.outb + OUT_OA); S.Bt = (const char*)(F.ws + WS_WPA8);
        EpiGate<0> E{(const bf16_t*)(F.ws + WS_GA), nullptr, (bf16_t*)(F.ws + WS_Z), MOE_INV};
        pg8::gemm_phase<EpiGate<0>, SchedPlainT<1024>, false, 512, true>(F.lds, S, E);
#else
        SchedPlain S; S.o.init(NTOK, 1024, F.G, F.bid); S.A = (const char*)(F.outb + OUT_OA); S.Bt = (const char*)(F.ws + WS_WPA);
        EpiGate<0> E{(const bf16_t*)(F.ws + WS_GA), nullptr, (bf16_t*)(F.ws + WS_Z), 1.0f};
        pg8::gemm_phase<EpiGate<0>, SchedPlain, false>(F.lds, S, E);
#endif
    }
    if (IN(9)) {
#if PB_FP8
        SchedPlainT<1024> S; S.o.init(NTOK, 1024, F.G, F.bid); S.A = (const char*)(F.outb + OUT_OB8); S.Bt = (const char*)(F.ws + WS_WPB8);
        EpiGate<1> E{(const bf16_t*)(F.ws + WS_GB), (const bf16_t*)(F.ws + WS_Z), (bf16_t*)(F.ws + WS_XBC), MOE_INV};
        pg8::gemm_phase<EpiGate<1>, SchedPlainT<1024>, false, 512, true>(F.lds, S, E);
#else
        SchedPlain S; S.o.init(NTOK, 1024, F.G, F.bid); S.A = (const char*)(F.ws + WS_Q); S.Bt = (const char*)(F.ws + WS_WPB);
        EpiGate<1> E{(const bf16_t*)(F.ws + WS_GB), (const bf16_t*)(F.ws + WS_Z), (bf16_t*)(F.ws + WS_XBC), 1.0f};
        pg8::gemm_phase<EpiGate<1>, SchedPlain, false>(F.lds, S, E);
#endif
        SEAM(9);
    }
    if (IN(10)) {
        SchedPlain S; S.o.init(NTOK, 1024, F.G, F.bid); S.A = (const char*)(F.ws + WS_XBC); S.Bt = (const char*)(F.ws + WS_WOUT);
        EpiOut E{F.a->in[0], (const float*)(F.ws + WS_MOD), (float*)F.outb};
        pg8::gemm_phase<EpiOut, SchedPlain, false>(F.lds, S, E);
        if (DBG_TWICE & 1024u) { GRID_BAR(); pg8::gemm_phase<EpiOut, SchedPlain, false>(F.lds, S, E); }
        SEAM(10);
    }
    if (IN(11)) { if (DBG_TWICE & 2048u) { ph_router<true>(F); GRID_BAR(); } ph_router<false>(F); SEAM(11); }
#pragma unroll
    for (int hf = 0; hf < 2; ++hf) {
        const int p0 = 12 + hf * 2;
        if (IN(p0)) {
            if (hf == 1) ph_final<false>(F, 0);
            MoeTab T = moe_tables(F, hf);
            SchedMoe<8, true> S{T, F.G, F.bid, hf, (const char*)(F.ws + WS_U2), (const char*)(F.ws + WS_W1), (const u32x2*)(F.ws + WS_REG)};
            EpiMoe1 E{F.a->in[23], (bf16_t*)(F.ws + WS_ACT), 0};
            pg8::gemm_phase<EpiMoe1, SchedMoe<8, true>, true, MOE_RB / 2, MOE_FP8 != 0>(F.lds, S, E);
            if ((DBG_TWICE & 4096u) && hf == 0) { GRID_BAR(); pg8::gemm_phase<EpiMoe1, SchedMoe<8, true>, true, MOE_RB / 2, MOE_FP8 != 0>(F.lds, S, E); }
            if ((DBG_TWICE & 16384u) && hf == 0) { GRID_BAR(); EpiMoe1 Ed = E; Ed.dry = 1; pg8::gemm_phase<EpiMoe1, SchedMoe<8, true>, true, MOE_RB / 2, MOE_FP8 != 0>(F.lds, S, Ed); }
            SEAM(p0);
        }
        if (IN(p0 + 1)) {
            MoeTab T = moe_tables(F, hf);
            SchedMoe<4, false> S{T, F.G, F.bid, hf, (const char*)(F.ws + WS_ACT), (const char*)(F.ws + WS_W2), (const u32x2*)(F.ws + WS_REG)};
            EpiMoe2 E{F.a->in[25], (bf16_t*)(F.ws + WS_YB), (const u32x2*)(F.ws + WS_REG), T, hf, 0};
            if ((DBG_TWICE & 262144u) && hf == 0) { EpiMoe2 Ed = E; Ed.dry = DBG_DRYMODE; pg8::gemm_phase<EpiMoe2, SchedMoe<4, false>, false, MOE_RB / 2, MOE_FP8 != 0>(F.lds, S, Ed); GRID_BAR(); }
            pg8::gemm_phase<EpiMoe2, SchedMoe<4, false>, false, MOE_RB / 2, MOE_FP8 != 0>(F.lds, S, E);
            if ((DBG_TWICE & 8192u) && hf == 0) { GRID_BAR(); pg8::gemm_phase<EpiMoe2, SchedMoe<4, false>, false, MOE_RB / 2, MOE_FP8 != 0>(F.lds, S, E); }
            if ((DBG_TWICE & 131072u) && hf == 0) { GRID_BAR(); EpiMoe2 Ed = E; Ed.dry = 1; pg8::gemm_phase<EpiMoe2, SchedMoe<4, false>, false, MOE_RB / 2, MOE_FP8 != 0>(F.lds, S, Ed); }
            SEAM(p0 + 1);
            if (DBG_CHECK == 1 && hf == 1) { dbg_check_moe(F); GRID_BAR(); }
        }
    }
    if (IN(16)) { if (DBG_TWICE & 65536u) { ph_final<true>(F, 1); GRID_BAR(); } ph_final(F, 1); }
    if (DBG_CHECK) { GRID_BAR(); dbg_emit(F); }
#undef IN
#undef SEAM
}

extern "C" void kernel_launch(void* const* d_in, const int* in_sizes, int n_in, void* d_out, int out_size, void* d_ws, size_t ws_size, hipStream_t stream) {
    static int grid = 0;
    if (grid == 0) {
        if (n_in != 28 || in_sizes[0] != NTOK * D || out_size != NTOK * D || ws_size < WS_END) { fprintf(stderr, "kernel_launch: shape mismatch (n_in %d, in0 %d, out %d, ws %zu)\n", n_in, n_in > 0 ? in_sizes[0] : -1, out_size, ws_size); grid = -1; return; }
        int dev = 0, cus = 0, per_cu = 0;
        if (hipGetDevice(&dev) != hipSuccess || hipDeviceGetAttribute(&cus, hipDeviceAttributeMultiprocessorCount, dev) != hipSuccess) { grid = -1; return; }
        if (hipFuncSetAttribute((const void*)fwd, hipFuncAttributeMaxDynamicSharedMemorySize, LDS_BYTES) != hipSuccess) { fprintf(stderr, "kernel_launch: hipFuncSetAttribute failed\n"); grid = -1; return; }
        if (hipOccupancyMaxActiveBlocksPerMultiprocessor(&per_cu, (const void*)fwd, NTHR, LDS_BYTES) != hipSuccess || per_cu < 1) fprintf(stderr, "kernel_launch: occupancy query reports %d\n", per_cu);
        (void)hipGetLastError();
        grid = cus;
    }
    if (grid < 0) return;
    if (hipMemsetAsync((char*)d_ws + WS_CTL, 0, CTL_ZERO_BYTES, stream) != hipSuccess) { fprintf(stderr, "kernel_launch: memset failed\n"); return; }
    Args a{};
    for (int i = 0; i < 28; ++i) a.in[i] = (const float*)d_in[i];
    a.out = (float*)d_out; a.ws = (unsigned char*)d_ws;
    const int nph = NPHASE < MK_PH_HI ? NPHASE : MK_PH_HI;
#if MK_ONE
    a.ph_lo = 0; a.ph_hi = nph;
    hipLaunchKernelGGL(fwd, dim3(grid), dim3(NTHR), LDS_BYTES, stream, a);
#else
    for (int p = 0; p < nph; ++p) { a.ph_lo = p; a.ph_hi = p + 1; hipLaunchKernelGGL(fwd, dim3(grid), dim3(NTHR), LDS_BYTES, stream, a); }
#endif
    const hipError_t le = hipPeekAtLastError();
    if (le != hipSuccess) fprintf(stderr, "kernel_launch: launch failed: %s\n", hipGetErrorName(le));
}
```

```cpp
#include <hip/hip_runtime.h>
#include <cstdio>
#include <cstdint>

#ifndef MK_ONE
#define MK_ONE 1
#endif
#ifndef DBG_NO_ATTN
#define DBG_NO_ATTN 0
#endif
#ifndef DBG_ATTN_ZERO
#define DBG_ATTN_ZERO 0
#endif
#ifndef DBG_IQ_TRUNC
#define DBG_IQ_TRUNC 0
#endif
#ifndef DBG_ROUTER_BF16
#define DBG_ROUTER_BF16 0
#endif
#ifndef DBG_CHECK
#define DBG_CHECK 0
#endif
#ifndef DBG_SKIP_BODY
#define DBG_SKIP_BODY 0
#endif
#ifndef DBG_SUB
#define DBG_SUB 0
#endif
#ifndef DBG_SSD_SYNC
#define DBG_SSD_SYNC 0
#endif
#ifndef DBG_HYP
#define DBG_HYP 0
#endif
#ifndef DBG_TWICE
#define DBG_TWICE 0u
#endif
#ifndef DBG_DRYMODE
#define DBG_DRYMODE 2
#endif
#ifndef DBG_NO_SSD
#define DBG_NO_SSD 0
#endif
#ifndef DBG_NO_MOE
#define DBG_NO_MOE 0
#endif
#ifndef MOE_FP8
#define MOE_FP8 1
#endif
#ifndef PROJ_FP8
#define PROJ_FP8 1
#endif
#ifndef PA_FP8
#define PA_FP8 1
#endif
#ifndef PB_FP8
#define PB_FP8 0
#endif
#ifndef ATT2
#define ATT2 1
#endif
#ifndef MK_PH_HI
#define MK_PH_HI 99
#endif

#define LAS __attribute__((address_space(3)))
#define GAS __attribute__((address_space(1)))
typedef unsigned short bf16_t;
typedef short bf16x8 __attribute__((ext_vector_type(8)));
typedef short s16x4 __attribute__((ext_vector_type(4)));
typedef float f32x2 __attribute__((ext_vector_type(2)));
typedef float f32x4 __attribute__((ext_vector_type(4)));
typedef float f32x16 __attribute__((ext_vector_type(16)));
typedef unsigned u32x2 __attribute__((ext_vector_type(2)));
typedef unsigned u32x4 __attribute__((ext_vector_type(4)));
typedef unsigned long long u64;

constexpr int NB = 32, SEQ = 2048, D = 1024, NTOK = NB * SEQ;
constexpr int NWAVES = 8, NTHR = 512;
constexpr int NPROJ = 6912;
constexpr int NEXP = 32, HALF_TOK = NTOK / 2, REG_CAP = HALF_TOK;
constexpr int ACT_ROWS = HALF_TOK * 4 + NEXP * 256;
constexpr float LN_EPS = 1e-5f;
constexpr float DN_ALPHA = 1.189207115002721f;
constexpr float LOG2E = 1.4426950408889634f;

constexpr size_t MiB = 1u << 20;
constexpr size_t WS_CTL = 0, CTL_ZERO_BYTES = 1 * MiB;
constexpr size_t WS_MOD = 1 * MiB;
constexpr size_t WS_BIAST = 1 * MiB + 800 * 1024;
constexpr size_t WS_WIN = 2 * MiB;
constexpr size_t WS_WPA = 16 * MiB, WS_WPB = 18 * MiB, WS_WOUT = 20 * MiB;
constexpr size_t WS_W1 = 24 * MiB;
constexpr size_t WS_U8 = 88 * MiB;
constexpr size_t WS_W2 = 152 * MiB;
constexpr size_t WS_WIN8 = 184 * MiB;
constexpr size_t WS_WPA8 = 192 * MiB;
constexpr size_t WS_WPB8 = 194 * MiB;
constexpr size_t OUT_OB8 = 192 * MiB;
constexpr size_t WS_Q = 216 * MiB;
constexpr size_t WS_Z = 344 * MiB;
constexpr size_t WS_XBC = 472 * MiB;
constexpr size_t WS_GA = 728 * MiB, WS_GB = 856 * MiB;
constexpr size_t WS_U2 = 216 * MiB;
constexpr size_t WS_REG = 344 * MiB;
constexpr size_t WS_ACT = 360 * MiB;
constexpr size_t WS_YB = 632 * MiB;
constexpr size_t WS_END = 889 * MiB;
constexpr size_t WS_DBG = 889 * MiB;
constexpr size_t OUT_U = 0, OUT_MISC = 128 * MiB, OUT_IQ = 192 * MiB;
constexpr size_t OUT_KV = 0, OUT_IK = 16 * MiB, OUT_IW = 24 * MiB, OUT_DT = 26 * MiB, OUT_MASK = 32 * MiB, OUT_OA = 64 * MiB;
constexpr int CW_BAR = 4096, CW_CNT = 16384, CW_DBG = 24576;

constexpr int LDS_BYTES = 160 * 1024;
constexpr int LDS_AUX = 131072;
constexpr int LDS_MISC = LDS_BYTES - 256;

#define LDS_WAIT() asm volatile("s_waitcnt lgkmcnt(0)" ::: "memory")
#define VM_WAIT() asm volatile("s_waitcnt vmcnt(0)" ::: "memory")
#define SBAR() __builtin_amdgcn_sched_barrier(0)
typedef __bf16 bf16x2_t __attribute__((ext_vector_type(2)));
__device__ __forceinline__ unsigned cvt_pk_bf16(float lo, float hi) { f32x2 f = {lo, hi}; bf16x2_t v = __builtin_convertvector(f, bf16x2_t); return __builtin_bit_cast(unsigned, v); }
__device__ __forceinline__ float bflo(unsigned w) { return __uint_as_float(w << 16); }
__device__ __forceinline__ float bfhi(unsigned w) { return __uint_as_float(w & 0xffff0000u); }
__device__ __forceinline__ u32x4 pack8(f32x4 a, f32x4 b) { u32x4 w; w.x = cvt_pk_bf16(a[0], a[1]); w.y = cvt_pk_bf16(a[2], a[3]); w.z = cvt_pk_bf16(b[0], b[1]); w.w = cvt_pk_bf16(b[2], b[3]); return w; }
constexpr int MOE_RB = MOE_FP8 ? 1024 : 2048;
constexpr float MOE_WSC = MOE_FP8 ? 64.0f : 1.0f, MOE_INV = 1.0f / MOE_WSC;
__device__ __forceinline__ u32x2 pack8_fp8(f32x4 a, f32x4 b) { int lo = 0, hi = 0;
    lo = __builtin_amdgcn_cvt_pk_fp8_f32(a[0], a[1], lo, false); lo = __builtin_amdgcn_cvt_pk_fp8_f32(a[2], a[3], lo, true);
    hi = __builtin_amdgcn_cvt_pk_fp8_f32(b[0], b[1], hi, false); hi = __builtin_amdgcn_cvt_pk_fp8_f32(b[2], b[3], hi, true);
    u32x2 r; r.x = (unsigned)lo; r.y = (unsigned)hi; return r; }
__device__ __forceinline__ void unpack8(u32x4 w, f32x4& a, f32x4& b) { a[0] = bflo(w.x); a[1] = bfhi(w.x); a[2] = bflo(w.y); a[3] = bfhi(w.y); b[0] = bflo(w.z); b[1] = bfhi(w.z); b[2] = bflo(w.w); b[3] = bfhi(w.w); }
__device__ __forceinline__ float wave_sum(float v) {
#pragma unroll
    for (int o = 1; o < 64; o <<= 1) v += __shfl_xor(v, o);
    return v;
}
__device__ __forceinline__ float fast_rcp(float x) { return __builtin_amdgcn_rcpf(x); }
__device__ __forceinline__ float sigmoid_f(float x) { return fast_rcp(1.0f + __expf(-x)); }
__device__ __forceinline__ float silu_f(float x) { return x * sigmoid_f(x); }

#define XB_TMO      128
#define XB_XCNT(j)  (256  + 64 * (j))
#define XB_XSUB(j)  (1280 + 64 * (j))
#define XB_XGEN(j)  (2304 + 64 * (j))
#define XB_TOP      3328
#define XB_TOPGEN   3392
#define XCD_BAR_WORDS 3456
#define XB_SPIN_CAP (1u << 18)
__device__ __forceinline__ unsigned xb_ld(unsigned* p)              { return __hip_atomic_load(p, __ATOMIC_RELAXED, __HIP_MEMORY_SCOPE_AGENT); }
__device__ __forceinline__ unsigned xb_add(unsigned* p, unsigned v) { return __hip_atomic_fetch_add(p, v, __ATOMIC_RELAXED, __HIP_MEMORY_SCOPE_AGENT); }
__device__ __forceinline__ unsigned xb_xcc_id() { return (unsigned)__builtin_amdgcn_s_getreg((3 << 11) | 20) & 0xFu; }
#define XB_SPIN(cond, bar) do { unsigned _sp = 0; while (cond) { __builtin_amdgcn_s_sleep(1); \
    if ((++_sp & 255u) == 0u) { if (xb_ld(&(bar)[XB_TMO])) break; if (_sp > XB_SPIN_CAP) { atomicAdd(&(bar)[XB_TMO], 1u); break; } } } } while (0)
struct XcdBarrier { unsigned* bar; unsigned x; volatile LAS unsigned* st; };
__device__ __forceinline__ XcdBarrier xcd_barrier_post(unsigned* bar, volatile LAS unsigned* st) {
    XcdBarrier b; b.bar = bar; b.x = xb_xcc_id(); b.st = st;
    if (threadIdx.x == 0) (void)xb_add(&bar[XB_XCNT(b.x)], 1u);
    return b;
}
__device__ __forceinline__ void xcd_barrier_complete(unsigned* bar, unsigned x, unsigned& nloc, unsigned& nx) {
    const unsigned G = gridDim.x * gridDim.y * gridDim.z;
    unsigned sum, cnt, mine, sp = 0u;
    for (;;) {
        sum = 0u; cnt = 0u;
#pragma nounroll
        for (unsigned j = 0; j < 16; ++j) { const unsigned c = xb_ld(&bar[XB_XCNT(j)]); sum += c; cnt += (c > 0u) ? 1u : 0u; }
        if (sum == G) break;
        __builtin_amdgcn_s_sleep(1);
        if ((++sp & 255u) == 0u) { if (xb_ld(&bar[XB_TMO])) break; if (sp > XB_SPIN_CAP) { atomicAdd(&bar[XB_TMO], 1u); break; } }
    }
    mine = xb_ld(&bar[XB_XCNT(x)]);
    nloc = mine > 0u ? mine : 1u; nx = cnt > 0u ? cnt : 1u;
}
__device__ __forceinline__ void xcd_barrier(const XcdBarrier& b) {
    asm volatile("s_waitcnt vmcnt(0)" ::: "memory");
    __syncthreads();
    if (threadIdx.x == 0) {
        unsigned* bar = b.bar;
        __builtin_amdgcn_s_waitcnt(0);
        unsigned nloc = b.st[0], nx = b.st[1];
        if (nloc == 0u) { xcd_barrier_complete(bar, b.x, nloc, nx); b.st[0] = nloc; b.st[1] = nx; }
        const unsigned old = xb_add(&bar[XB_XSUB(b.x)], 1u);
        const unsigned gen = old / nloc;
        if (old + 1u == (gen + 1u) * nloc) {
            __builtin_amdgcn_fence(__ATOMIC_RELEASE, "agent");
            asm volatile("s_waitcnt vmcnt(0)" ::: "memory");
            const unsigned og = xb_add(&bar[XB_TOP], 1u);
            const unsigned tg = og / nx;
            if (og + 1u == (tg + 1u) * nx) xb_add(&bar[XB_TOPGEN], 1u);
            else XB_SPIN(xb_ld(&bar[XB_TOPGEN]) == tg, bar);
            __builtin_amdgcn_fence(__ATOMIC_ACQUIRE, "agent");
            xb_add(&bar[XB_XGEN(b.x)], 1u);
            asm volatile("s_waitcnt vmcnt(0)" ::: "memory");
        } else {
            XB_SPIN(xb_ld(&bar[XB_XGEN(b.x)]) == gen, bar);
            __builtin_amdgcn_fence(__ATOMIC_ACQUIRE, "agent");
            asm volatile("s_waitcnt vmcnt(0)" ::: "memory");
        }
    }
    __syncthreads();
}

namespace pg8 {
constexpr int BM = 256, BK = 64, HALF = 128, HTB = HALF * BK * 2, STAGE_BYTES = 8 * HTB, NXCD = 8, WGM = 8, KD = 1024;
__host__ __device__ __forceinline__ int lds_byte(int r, int c) { const int st = (r >> 4) * 2 + (c >> 5), rr = r & 15, cc = c & 31, ob = rr * 64 + cc * 2; return st * 1024 + (ob ^ (((ob >> 9) & 1) << 5)); }
__host__ __device__ __forceinline__ void stage_rc(int b, int& R, int& C) { const int st = b / 1024, sb = b % 1024, swz = sb ^ (((sb >> 9) & 1) << 5); R = (st >> 1) * 16 + swz / 64; C = (st & 1) * 32 + (swz % 64) / 2; }
__host__ __device__ __forceinline__ int perm32(int rho) { const int n = rho >> 4, i = rho & 15; return 8 * (i >> 2) + 4 * n + (i & 3); }
struct Unit { int pm, pn, ex; };
struct StaticOrder {
    int nM, nN, nwg, G, c;
    __device__ void init(int M, int N, int G_, int c_) { nM = M / BM; nN = N / BM; nwg = nM * nN; G = G_; c = c_; }
    __device__ bool next(int i, Unit& u) const {
        const long L = (long)i * G + c; if (L >= nwg) return false;
        int wgid = (int)L; { const int q = nwg / NXCD, r = nwg % NXCD, xcd = wgid % NXCD, off = wgid / NXCD; wgid = (xcd < r ? xcd * (q + 1) : r * (q + 1) + (xcd - r) * q) + off; }
        const int nig = WGM * nN, gid = wgid / nig, fm = gid * WGM, gsz = (nM - fm) < WGM ? (nM - fm) : WGM;
        u.pm = fm + ((wgid % nig) % gsz); u.pn = (wgid % nig) / gsz; u.ex = 0; return true;
    }
};
typedef int i32x8 __attribute__((ext_vector_type(8)));
typedef int i32x4v __attribute__((ext_vector_type(4)));
template <class Epi, class Sched, bool GATHER, int KE = 1024, bool FP8 = false>
__device__ __forceinline__ void gemm_phase(LAS unsigned char* lds, const Sched& S, const Epi& E) {
    int tid = threadIdx.x; asm volatile("" : "+v"(tid));
    const int wid = __builtin_amdgcn_readfirstlane(tid >> 6), lane = tid & 63, wr = wid >> 2, wc = wid & 3, fr = lane & 15, fq = lane >> 4;
    constexpr int K = KE, nt = K / BK;
    unsigned voffA[2], voffB[2]; int Rr[2], Cc[2];
#pragma unroll
    for (int i = 0; i < 2; ++i) { int R, C; stage_rc(tid * 16 + i * 8192, R, C); const int Rb = Epi::PERM ? ((R & ~31) + perm32(R & 31)) : R;
        voffA[i] = (unsigned)(R * K + C) * 2u; voffB[i] = (unsigned)(Rb * K + C) * 2u; Rr[i] = R; Cc[i] = C; }
    constexpr size_t kstep = (size_t)(BK * 2);
    constexpr size_t hstep = (size_t)HALF * K * 2;
    const unsigned ldsw = (unsigned)wid * 1024u;
    const int aoff = lds_byte(wr * 64 + fr, fq * 8), boff = lds_byte(wc * 32 + fr, fq * 8);
#define PG8_SA(b, h) (((b) * 2 + (h)) * HTB)
#define PG8_SB(b, h) ((4 + (b) * 2 + (h)) * HTB)
#define PG8_STAGE(bufoff, gbase, voff) do { _Pragma("unroll") for (int _i = 0; _i < 2; ++_i) \
        __builtin_amdgcn_global_load_lds((const unsigned*)((const char*)(gbase) + (voff)[_i]), (LAS unsigned*)(lds + (bufoff) + ldsw + _i * 8192), 16, 0, 0); } while (0)
#define PG8_STAGE_A(bufoff, gb, h, o0, o1) do { if constexpr (GATHER) { const unsigned _ko = (unsigned)((gb) - gA0); unsigned _o[2]; \
            if ((h) == 0) { _o[0] = (o0)[0] + _ko; _o[1] = (o0)[1] + _ko; } else { _o[0] = (o1)[0] + _ko; _o[1] = (o1)[1] + _ko; } PG8_STAGE(bufoff, gA0, _o); } \
        else { PG8_STAGE(bufoff, (gb) + (h) * hstep, voffA); } } while (0)
#define PG8_LD8(p) __builtin_shufflevector(*(const LAS i32x4v*)(p), *(const LAS i32x4v*)((p) + 1024), 0, 1, 2, 3, 4, 5, 6, 7)
#define PG8_LDA(dst, b, h) do { if constexpr (FP8) { _Pragma("unroll") for (int m = 0; m < 4; ++m) dst##8[m] = PG8_LD8(lds + PG8_SA(b, h) + aoff + m * 2048); } \
        else { _Pragma("unroll") for (int m = 0; m < 4; ++m) _Pragma("unroll") for (int k = 0; k < 2; ++k) dst[m][k] = *(const LAS bf16x8*)(lds + PG8_SA(b, h) + aoff + m * 2048 + k * 1024); } } while (0)
#define PG8_LDB(dst, b, h) do { if constexpr (FP8) { _Pragma("unroll") for (int n = 0; n < 2; ++n) dst##8[n] = PG8_LD8(lds + PG8_SB(b, h) + boff + n * 2048); } \
        else { _Pragma("unroll") for (int n = 0; n < 2; ++n) _Pragma("unroll") for (int k = 0; k < 2; ++k) dst[n][k] = *(const LAS bf16x8*)(lds + PG8_SB(b, h) + boff + n * 2048 + k * 1024); } } while (0)
#define PG8_MMA(ai, bj, At, Bt) do { __builtin_amdgcn_s_setprio(1); if constexpr (FP8) { _Pragma("unroll") for (int m = 0; m < 4; ++m) _Pragma("unroll") for (int n = 0; n < 2; ++n) \
            asm volatile("v_mfma_scale_f32_16x16x128_f8f6f4 %0, %1, %2, %0, %3, %3 op_sel_hi:[0,0,0]" : "+v"(acc[ai][bj][m][n]) : "v"(Bt##8[n]), "v"(At##8[m]), "v"(sc127)); } \
        else { _Pragma("unroll") for (int m = 0; m < 4; ++m) _Pragma("unroll") for (int n = 0; n < 2; ++n) _Pragma("unroll") for (int k = 0; k < 2; ++k) \
            acc[ai][bj][m][n] = __builtin_amdgcn_mfma_f32_16x16x32_bf16(Bt[n][k], At[m][k], acc[ai][bj][m][n], 0, 0, 0); } __builtin_amdgcn_s_setprio(0); } while (0)
#define PG8_WAIT_V(n) asm volatile("s_waitcnt vmcnt(" #n ")" ::: "memory")
#define PG8_WAIT_L(n) asm volatile("s_waitcnt lgkmcnt(" #n ")" ::: "memory")
#define PG8_BAR __builtin_amdgcn_s_barrier()
#define PG8_SCHED __builtin_amdgcn_sched_barrier(0)
    Unit cur, nxt; int ui = 0;
    if (!S.next(0, cur)) return;
    f32x4 acc[2][2][4][2];
#pragma unroll
    for (int a = 0; a < 2; ++a)
#pragma unroll
        for (int b = 0; b < 2; ++b)
#pragma unroll
            for (int m = 0; m < 4; ++m)
#pragma unroll
                for (int n = 0; n < 2; ++n) acc[a][b][m][n] = (f32x4){0.f, 0.f, 0.f, 0.f};
    const int sc127 = 0x7f7f7f7f;
    bf16x8 At[4][2], B0[2][2], B1[2][2]; i32x8 At8[4], B08[2], B18[2];
    const char* cA = S.a_base(cur); const char* cB = S.b_base(cur);
    const char* const gA0 = cA;
    unsigned cv0[2] = {0u, 0u}, cv1[2] = {0u, 0u}, nv0[2] = {0u, 0u}, nv1[2] = {0u, 0u};
    if constexpr (GATHER) S.a_offs(cur, Rr, Cc, cv0, cv1);
    PG8_STAGE(PG8_SB(0, 0), cB, voffB); PG8_STAGE_A(PG8_SA(0, 0), cA, 0, cv0, cv1); PG8_STAGE(PG8_SB(0, 1), cB + hstep, voffB); PG8_STAGE_A(PG8_SA(0, 1), cA, 1, cv0, cv1);
    if (wr == 1) PG8_BAR;
    PG8_WAIT_V(4); PG8_BAR;
    PG8_STAGE(PG8_SB(1, 0), cB + kstep, voffB); PG8_STAGE_A(PG8_SA(1, 0), cA + kstep, 0, cv0, cv1); PG8_STAGE(PG8_SB(1, 1), cB + hstep + kstep, voffB);
    PG8_WAIT_V(6); PG8_BAR;
    for (;;) {
        const bool has_next = S.next(ui + 1, nxt);
        const char* nA = has_next ? S.a_base(nxt) : cA; const char* nB = has_next ? S.b_base(nxt) : cB;
        if constexpr (GATHER) { if (has_next) S.a_offs(nxt, Rr, Cc, nv0, nv1); else { nv0[0] = cv0[0]; nv0[1] = cv0[1]; nv1[0] = cv1[0]; nv1[1] = cv1[1]; } }
#pragma nounroll
        for (int t = 0; t < nt; t += 2) {
            const bool last = (t == nt - 2);
            const char* a1 = cA + (size_t)(t + 1) * kstep;
            const char* a2 = last ? nA : cA + (size_t)(t + 2) * kstep; const char* b2 = last ? nB : cB + (size_t)(t + 2) * kstep;
            const char* a3 = a2 + kstep; const char* b3 = b2 + kstep;
            unsigned s0[2], s1[2];
            if constexpr (GATHER) { s0[0] = last ? nv0[0] : cv0[0]; s0[1] = last ? nv0[1] : cv0[1]; s1[0] = last ? nv1[0] : cv1[0]; s1[1] = last ? nv1[1] : cv1[1]; } else { s0[0] = s0[1] = s1[0] = s1[1] = 0u; }
            PG8_LDB(B0, 0, 0); PG8_SCHED; PG8_LDA(At, 0, 0); PG8_STAGE_A(PG8_SA(1, 1), a1, 1, cv0, cv1);
            PG8_WAIT_L(8); PG8_BAR; PG8_WAIT_L(0); PG8_MMA(0, 0, At, B0); PG8_BAR; PG8_SCHED;
            PG8_LDB(B1, 0, 1); PG8_STAGE(PG8_SB(0, 0), b2, voffB);
            PG8_BAR; PG8_WAIT_L(0); PG8_MMA(0, 1, At, B1); PG8_BAR;
            PG8_LDA(At, 0, 1); PG8_STAGE_A(PG8_SA(0, 0), a2, 0, s0, s1);
            PG8_BAR; PG8_WAIT_L(0); PG8_MMA(1, 0, At, B0); PG8_BAR; PG8_SCHED;
            PG8_STAGE(PG8_SB(0, 1), b2 + hstep, voffB);
            PG8_WAIT_V(6); PG8_BAR; PG8_MMA(1, 1, At, B1); PG8_BAR;
            PG8_LDB(B0, 1, 0); PG8_SCHED; PG8_LDA(At, 1, 0); PG8_STAGE_A(PG8_SA(0, 1), a2, 1, s0, s1);
            PG8_WAIT_L(8); PG8_BAR; PG8_WAIT_L(0); PG8_MMA(0, 0, At, B0); PG8_BAR; PG8_SCHED;
            PG8_LDB(B1, 1, 1); PG8_STAGE(PG8_SB(1, 0), b3, voffB);
            PG8_BAR; PG8_WAIT_L(0); PG8_MMA(0, 1, At, B1); PG8_BAR;
            PG8_LDA(At, 1, 1); PG8_STAGE_A(PG8_SA(1, 0), a3, 0, s0, s1);
            PG8_BAR; PG8_WAIT_L(0); PG8_MMA(1, 0, At, B0); PG8_BAR; PG8_SCHED;
            PG8_STAGE(PG8_SB(1, 1), b3 + hstep, voffB);
            PG8_WAIT_V(6); PG8_BAR; PG8_MMA(1, 1, At, B1); PG8_BAR;
        }
        if constexpr (FP8) asm volatile("s_nop 15\n\ts_nop 15" ::: "memory");
        E(acc, cur, wr, wc, fr, fq);
        if (!has_next) break;
#pragma unroll
        for (int a = 0; a < 2; ++a)
#pragma unroll
            for (int b = 0; b < 2; ++b)
#pragma unroll
                for (int m = 0; m < 4; ++m)
#pragma unroll
                    for (int n = 0; n < 2; ++n) acc[a][b][m][n] = (f32x4){0.f, 0.f, 0.f, 0.f};
        cur = nxt; cA = nA; cB = nB; ++ui;
        if constexpr (GATHER) { cv0[0] = nv0[0]; cv0[1] = nv0[1]; cv1[0] = nv1[0]; cv1[1] = nv1[1]; }
    }
    PG8_WAIT_V(0);
    if (wr == 0) PG8_BAR;
    PG8_BAR;
#undef PG8_SA
#undef PG8_SB
#undef PG8_STAGE
#undef PG8_STAGE_A
#undef PG8_LDA
#undef PG8_LDB
#undef PG8_MMA
#undef PG8_LD8
#undef PG8_WAIT_V
#undef PG8_WAIT_L
#undef PG8_BAR
#undef PG8_SCHED
}
}
using pg8::Unit;
typedef f32x4 AccT[2][2][4][2];

struct Args { const float* in[28]; float* out; unsigned char* ws; int ph_lo, ph_hi, pad0, pad1; };
struct Frame {
    LAS unsigned char* lds;
    int tid, lane, wave, G, bid;
    const struct Args* a;
    unsigned char* ws; unsigned char* outb;
};
template <int RB = 2048> struct SchedPlainT {
    pg8::StaticOrder o; const char* A; const char* Bt;
    __device__ __forceinline__ bool next(int i, Unit& u) const { return o.next(i, u); }
    __device__ __forceinline__ const char* a_base(const Unit& u) const { return A + (size_t)u.pm * (256 * RB); }
    __device__ __forceinline__ const char* b_base(const Unit& u) const { return Bt + (size_t)u.pn * (256 * RB); }
    __device__ __forceinline__ void a_offs(const Unit&, const int*, const int*, unsigned (&)[2], unsigned (&)[2]) const {}
};
typedef SchedPlainT<2048> SchedPlain;
template <int MODE> struct SchedProj {
    pg8::StaticOrder o; const char* A; const char* Bt;
    static constexpr int RB = MODE == 2 ? 1024 : 2048;
    __device__ __forceinline__ bool next(int i, Unit& u) const { if (!o.next(i, u)) return false; const int r = u.pn;
        if (MODE == 1) u.pn = 4 + r;
        if (MODE == 2) u.pn = r < 4 ? r : 15 + r;
        return true; }
    __device__ __forceinline__ const char* a_base(const Unit& u) const { return A + (size_t)u.pm * (256 * RB); }
    __device__ __forceinline__ const char* b_base(const Unit& u) const { return Bt + (size_t)u.pn * (256 * RB); }
    __device__ __forceinline__ void a_offs(const Unit&, const int*, const int*, unsigned (&)[2], unsigned (&)[2]) const {}
};

struct EpiProj {
    static constexpr bool PERM = true;
    bf16_t *Q, *IQ, *Z, *XBC, *GA, *GB; float* MISC; float sc;
    __device__ __forceinline__ void operator()(const AccT& acc, const Unit& u, int wr, int wc, int fr, int fq) const {
        const int pn = u.pn, row0 = u.pm * 256 + wr * 64 + fr, c8 = wc * 32 + 8 * fq;
        if (pn == 6) {
#pragma unroll
            for (int ai = 0; ai < 2; ++ai)
#pragma unroll
                for (int m = 0; m < 4; ++m) { float* rp = MISC + (size_t)(row0 + ai * 128 + m * 16) * 256 + c8;
#pragma unroll
                    for (int bj = 0; bj < 2; ++bj) { *(f32x4*)(rp + bj * 128) = acc[ai][bj][m][0]; *(f32x4*)(rp + bj * 128 + 4) = acc[ai][bj][m][1]; } }
            return;
        }
        bf16_t* base; int ldc, colt, act = 0;
        if (pn < 4) { base = Q; ldc = 1024; colt = pn * 256; }
        else if (pn < 6) { base = IQ; ldc = 512; colt = (pn - 4) * 256; }
        else if (pn < 11) { base = Z; ldc = 1024; colt = (pn - 7) * 256; act = 1; }
        else if (pn < 19) { base = XBC; ldc = 2048; colt = (pn - 11) * 256; }
        else if (pn < 23) { base = GA; ldc = 1024; colt = (pn - 19) * 256; act = 2; }
        else { base = GB; ldc = 1024; colt = (pn - 23) * 256; act = 2; }
#pragma unroll
        for (int ai = 0; ai < 2; ++ai)
#pragma unroll
            for (int m = 0; m < 4; ++m) { bf16_t* rp = base + (size_t)(row0 + ai * 128 + m * 16) * ldc + colt + c8;
#pragma unroll
                for (int bj = 0; bj < 2; ++bj) { f32x4 v0 = acc[ai][bj][m][0] * sc, v1 = acc[ai][bj][m][1] * sc;
                    if (act == 1) {
#pragma unroll
                        for (int j = 0; j < 4; ++j) { v0[j] = silu_f(v0[j]); v1[j] = silu_f(v1[j]); } }
                    if (act == 2) {
#pragma unroll
                        for (int j = 0; j < 4; ++j) { v0[j] = sigmoid_f(v0[j]); v1[j] = sigmoid_f(v1[j]); } }
                    u32x4 pk = pack8(v0, v1); if (DBG_IQ_TRUNC && (pn == 4 || pn == 5)) { pk.x &= 0xfff8fff8u; pk.y &= 0xfff8fff8u; pk.z &= 0xfff8fff8u; pk.w &= 0xfff8fff8u; }
                    *(u32x4*)(rp + bj * 128) = pk; } }
    }
};
template <int MODE> struct EpiGate {
    static constexpr bool PERM = true;
    const bf16_t* Gt; const bf16_t* T; bf16_t* O; float sc;
    __device__ __forceinline__ void operator()(const AccT& acc, const Unit& u, int wr, int wc, int fr, int fq) const {
        const int row0 = u.pm * 256 + wr * 64 + fr, c8 = u.pn * 256 + wc * 32 + 8 * fq;
#pragma unroll
        for (int ai = 0; ai < 2; ++ai) {
            u32x4 gq[4][2], tq[4][2];
#pragma unroll
            for (int m = 0; m < 4; ++m) { const size_t off = (size_t)(row0 + ai * 128 + m * 16) * 1024 + c8;
#pragma unroll
                for (int bj = 0; bj < 2; ++bj) { gq[m][bj] = *(const u32x4*)(Gt + off + bj * 128); if (MODE == 1) tq[m][bj] = *(const u32x4*)(T + off + bj * 128); } }
            SBAR();
#pragma unroll
            for (int m = 0; m < 4; ++m) { const size_t off = (size_t)(row0 + ai * 128 + m * 16) * 1024 + c8;
#pragma unroll
                for (int bj = 0; bj < 2; ++bj) { f32x4 g0, g1; unpack8(gq[m][bj], g0, g1);
                    f32x4 v0 = g0 * (acc[ai][bj][m][0] * sc), v1 = g1 * (acc[ai][bj][m][1] * sc);
                    if ((MODE == 0 && DBG_NO_ATTN) || (MODE == 1 && DBG_NO_SSD)) { v0 = (f32x4){0.f, 0.f, 0.f, 0.f}; v1 = v0; }
                    if (MODE == 1) { f32x4 t0, t1; unpack8(tq[m][bj], t0, t1); v0 += t0; v1 += t1; }
                    *(u32x4*)(O + off + bj * 128) = pack8(v0, v1); } }
            SBAR();
        }
    }
};
struct EpiOut {
    static constexpr bool PERM = false;
    const float* x; const float* mod; float* V;
    __device__ __forceinline__ void operator()(const AccT& acc, const Unit& u, int wr, int wc, int fr, int fq) const {
        const int row0 = u.pm * 256 + wr * 64 + fr, col0 = u.pn * 256 + wc * 32 + 4 * fq;
        const float* g1 = mod + (size_t)(u.pm >> 3) * 6144 + 2048 + col0;
        f32x4 gv[2][2];
#pragma unroll
        for (int bj = 0; bj < 2; ++bj)
#pragma unroll
            for (int n = 0; n < 2; ++n) gv[bj][n] = *(const f32x4*)(g1 + bj * 128 + n * 16);
#pragma unroll
        for (int ai = 0; ai < 2; ++ai)
#pragma unroll
            for (int mp = 0; mp < 2; ++mp) {
                f32x4 xv[2][2][2];
#pragma unroll
                for (int mm = 0; mm < 2; ++mm) { const size_t off = (size_t)(row0 + ai * 128 + (2 * mp + mm) * 16) * 1024 + col0;
#pragma unroll
                    for (int bj = 0; bj < 2; ++bj)
#pragma unroll
                        for (int n = 0; n < 2; ++n) xv[mm][bj][n] = *(const f32x4*)(x + off + bj * 128 + n * 16); }
                SBAR();
#pragma unroll
                for (int mm = 0; mm < 2; ++mm) { const int m = 2 * mp + mm; const size_t off = (size_t)(row0 + ai * 128 + m * 16) * 1024 + col0;
#pragma unroll
                    for (int bj = 0; bj < 2; ++bj)
#pragma unroll
                        for (int n = 0; n < 2; ++n) *(f32x4*)(V + off + bj * 128 + n * 16) = xv[mm][bj][n] * DN_ALPHA + gv[bj][n] * acc[ai][bj][m][n]; }
                SBAR();
            }
    }
};

struct MoeTab { LAS unsigned* cnt; LAS unsigned* tb; LAS unsigned char* te; int ntiles; };
__device__ __forceinline__ MoeTab moe_tables(Frame& F, int hf) {
    MoeTab T; T.cnt = (LAS unsigned*)(F.lds + LDS_AUX); T.tb = (LAS unsigned*)(F.lds + LDS_AUX + 256); T.te = (LAS unsigned char*)(F.lds + LDS_AUX + 512);
    const unsigned* CNT = (const unsigned*)(F.ws + WS_CTL) + CW_CNT;
    __syncthreads();
    if (F.tid < 32) { unsigned c = __hip_atomic_load(CNT + 64 * (hf * 32 + F.tid), __ATOMIC_RELAXED, __HIP_MEMORY_SCOPE_AGENT); if (c > (unsigned)REG_CAP) c = REG_CAP; T.cnt[F.tid] = c; }
    __syncthreads();
    if (F.tid == 0) { unsigned s = 0;
#pragma nounroll
        for (int e = 0; e < 32; ++e) { T.tb[e] = s; const unsigned n = (T.cnt[e] + 255u) >> 8;
#pragma nounroll
            for (unsigned t = 0; t < n; ++t) T.te[s + t] = (unsigned char)e;
            s += n; }
        T.tb[32] = s; }
    __syncthreads();
    T.ntiles = __builtin_amdgcn_readfirstlane((int)T.tb[32]);
    return T;
}
template <int NJ, bool GATHER> struct SchedMoe {
    MoeTab T; int G, c, hf; const char* A; const char* Bt; const u32x2* REG;
    __device__ __forceinline__ bool next(int i, Unit& u) const {
        int tile, j;
        if (G == 256) { const int x = c & 7, sl = c >> 3;
            tile = i * (256 / NJ) + x * (32 / NJ) + sl / NJ; j = sl % NJ;
            if (tile >= T.ntiles) return false; }
        else { const int L = i * G + c; if (L >= T.ntiles * NJ) return false; tile = L / NJ; j = L % NJ; }
        u.pm = tile; u.pn = j; u.ex = __builtin_amdgcn_readfirstlane((int)T.te[u.pm]); return true;
    }
    __device__ __forceinline__ const char* a_base(const Unit& u) const { return GATHER ? A : A + (size_t)u.pm * (256 * MOE_RB); }
    __device__ __forceinline__ const char* b_base(const Unit& u) const { return Bt + ((size_t)u.ex * (NJ * 256) + (size_t)u.pn * 256) * MOE_RB; }
    __device__ __forceinline__ void a_offs(const Unit& u, const int* R, const int* C, unsigned (&o0)[2], unsigned (&o1)[2]) const {
        const unsigned cnt = __builtin_amdgcn_readfirstlane(T.cnt[u.ex]), pos0 = ((unsigned)u.pm - (unsigned)__builtin_amdgcn_readfirstlane(T.tb[u.ex])) * 256u; const u32x2* rg = REG + ((size_t)hf * 32 + u.ex) * REG_CAP;
#pragma unroll
        for (int i = 0; i < 2; ++i) {
            const unsigned p0 = pos0 + (unsigned)R[i], p1 = p0 + 128u;
            unsigned t0 = 0u, t1 = 0u;
            if (p0 < cnt) t0 = (unsigned)hf * HALF_TOK + (rg[p0].x >> 2);
            if (p1 < cnt) t1 = (unsigned)hf * HALF_TOK + (rg[p1].x >> 2);
            o0[i] = t0 * (unsigned)MOE_RB + (unsigned)C[i] * 2u; o1[i] = t1 * (unsigned)MOE_RB + (unsigned)C[i] * 2u;
        }
    }
};
struct EpiMoe1 {
    static constexpr bool PERM = true;
    const float* b1; bf16_t* ACT; int dry;
    __device__ __forceinline__ void operator()(const AccT& acc, const Unit& u, int wr, int wc, int fr, int fq) const {
        if (dry) { if (acc[0][0][0][0][0] == 1.2345e-33f) ACT[0] = 1; return; }
        const int row0 = u.pm * 256 + wr * 64 + fr, c8 = u.pn * 128 + wc * 32 + 8 * fq;
        const float* bg = b1 + (size_t)u.ex * 2048 + c8;
        const f32x4 bg0 = *(const f32x4*)bg, bg1 = *(const f32x4*)(bg + 4), bu0 = *(const f32x4*)(bg + 1024), bu1 = *(const f32x4*)(bg + 1028);
#pragma unroll
        for (int ai = 0; ai < 2; ++ai)
#pragma unroll
            for (int m = 0; m < 4; ++m) {
                f32x4 g0 = acc[ai][0][m][0] * MOE_INV + bg0, g1 = acc[ai][0][m][1] * MOE_INV + bg1, u0 = acc[ai][1][m][0] * MOE_INV + bu0, u1 = acc[ai][1][m][1] * MOE_INV + bu1, a0, a1;
#pragma unroll
                for (int j = 0; j < 4; ++j) {
                    float g = fminf(g0[j], 7.0f), up = fminf(fmaxf(u0[j], -7.0f), 7.0f); a0[j] = (up + 1.0f) * g * sigmoid_f(1.702f * g);
                    g = fminf(g1[j], 7.0f); up = fminf(fmaxf(u1[j], -7.0f), 7.0f); a1[j] = (up + 1.0f) * g * sigmoid_f(1.702f * g); }
                if (MOE_FP8) *(u32x2*)((unsigned char*)ACT + (size_t)(row0 + ai * 128 + m * 16) * 1024 + c8) = pack8_fp8(a0, a1);
                else *(u32x4*)(ACT + (size_t)(row0 + ai * 128 + m * 16) * 1024 + c8) = pack8(a0, a1); }
    }
};
struct EpiMoe2 {
    static constexpr bool PERM = true;
    const float* b2; bf16_t* YB; const u32x2* REG; MoeTab T; int hf; int dry;
    __device__ __forceinline__ void operator()(const AccT& acc, const Unit& u, int wr, int wc, int fr, int fq) const {
        if (dry == 1) { if (acc[0][0][0][0][0] == 1.2345e-33f) YB[0] = 1; return; }
        if (dry >= 2) {
            const int c8d = (dry == 3 ? 0 : u.pn * 256) + wc * 32 + 8 * fq; const unsigned rowd = dry == 3 ? (blockIdx.x * 256u + (unsigned)(wr * 64 + fr)) : ((unsigned)u.pm * 256u + (unsigned)(wr * 64 + fr)) % 131072u;
#pragma unroll
            for (int ai = 0; ai < 2; ++ai)
#pragma unroll
                for (int m = 0; m < 4; ++m) { bf16_t* rp = YB + (size_t)((rowd + ai * 128 + m * 16) % 131072u) * 1024 + c8d;
#pragma unroll
                    for (int bj = 0; bj < 2; ++bj) *(u32x4*)(rp + bj * 128) = pack8(acc[ai][bj][m][0] * MOE_INV, acc[ai][bj][m][1] * MOE_INV); }
            return; }
        const int c8 = u.pn * 256 + wc * 32 + 8 * fq;
        const unsigned cnt = __builtin_amdgcn_readfirstlane(T.cnt[u.ex]), pos0 = ((unsigned)u.pm - (unsigned)__builtin_amdgcn_readfirstlane(T.tb[u.ex])) * 256u + (unsigned)(wr * 64 + fr); const u32x2* rg = REG + ((size_t)hf * 32 + u.ex) * REG_CAP;
        const float* bb = b2 + (size_t)u.ex * 1024 + c8;
        f32x4 bv[2][2];
#pragma unroll
        for (int bj = 0; bj < 2; ++bj) { bv[bj][0] = *(const f32x4*)(bb + bj * 128); bv[bj][1] = *(const f32x4*)(bb + bj * 128 + 4); }
        u32x2 en8[2][4];
#pragma unroll
        for (int ai = 0; ai < 2; ++ai)
#pragma unroll
            for (int m = 0; m < 4; ++m) { const unsigned p = pos0 + (unsigned)(ai * 128 + m * 16); en8[ai][m] = rg[p < cnt ? p : cnt - 1u]; }
#pragma unroll
        for (int ai = 0; ai < 2; ++ai)
#pragma unroll
            for (int m = 0; m < 4; ++m) { const unsigned p = pos0 + (unsigned)(ai * 128 + m * 16);
                const u32x2 en = en8[ai][m]; const float g = __uint_as_float(en.y); const unsigned drow = p < cnt ? en.x : (unsigned)(HALF_TOK * 4);
                bf16_t* rp = YB + (size_t)drow * 1024 + c8;
#pragma unroll
                for (int bj = 0; bj < 2; ++bj) *(u32x4*)(rp + bj * 128) = pack8((acc[ai][bj][m][0] * MOE_INV + bv[bj][0]) * g, (acc[ai][bj][m][1] * MOE_INV + bv[bj][1]) * g); }
    }
};

struct MapIdent { __device__ __forceinline__ int operator()(int n) const { return n; } };
struct MapWin { __device__ __forceinline__ int operator()(int n) const {
    if (n < 1024) return n;
    if (n < 1536) return 1152 + (n - 1024);
    if (n < 1792) { const int c = n - 1536; if (c < 128) return 1024 + c; if (c < 192) return 1664 + (c - 128); if (c < 200) return 1728 + (c - 192); if (c < 216) return 4808 + (c - 200); return -1; }
    if (n < 2816) return 1736 + (n - 1792);
    if (n < 4864) return 2760 + (n - 2816);
    if (n < 5888) return 4824 + (n - 4864);
    return 5848 + (n - 5888); } };
struct MapW1 { __device__ __forceinline__ int operator()(int r) const { const int j = r >> 8, rr = r & 255; return (rr >> 7) * 1024 + j * 128 + (rr & 127); } };
template <class Map, bool F8 = false> __device__ __forceinline__ void transpose_item(const float* W, int K, int N, bf16_t* WT, const Map& map, LAS float* scr, int kb, int nb, int lane, const float* rowscale) {
    const int k0 = 64 * kb, n0 = 64 * nb, q = lane & 15, kr = lane >> 4; const int src = map(n0 + 4 * q);
    f32x4 ld[16];
#pragma unroll
    for (int i = 0; i < 16; ++i) { const int kk = 4 * i + kr; ld[i] = (src >= 0) ? *(const f32x4*)(W + (size_t)(k0 + kk) * N + src) : (f32x4){0.f, 0.f, 0.f, 0.f}; }
#pragma unroll
    for (int i = 0; i < 16; ++i) { const int kk = 4 * i + kr; f32x4 v = ld[i]; if (rowscale) v = v * rowscale[k0 + kk]; LAS float* d = scr + kk * 65 + 4 * q; d[0] = v[0]; d[1] = v[1]; d[2] = v[2]; d[3] = v[3]; }
    LDS_WAIT(); asm volatile("" ::: "memory");
    const int c = lane & 7;
#pragma unroll
    for (int j = 0; j < 8; ++j) { const int n = (lane >> 3) + 8 * j; const LAS float* s = scr + (8 * c) * 65 + n;
        if constexpr (F8) { const f32x4 a = {s[0 * 65] * MOE_WSC, s[1 * 65] * MOE_WSC, s[2 * 65] * MOE_WSC, s[3 * 65] * MOE_WSC}, b = {s[4 * 65] * MOE_WSC, s[5 * 65] * MOE_WSC, s[6 * 65] * MOE_WSC, s[7 * 65] * MOE_WSC};
            *(u32x2*)((unsigned char*)WT + (size_t)(n0 + n) * K + k0 + 8 * c) = pack8_fp8(a, b); }
        else { u32x4 o; o.x = cvt_pk_bf16(s[0 * 65], s[1 * 65]); o.y = cvt_pk_bf16(s[2 * 65], s[3 * 65]); o.z = cvt_pk_bf16(s[4 * 65], s[5 * 65]); o.w = cvt_pk_bf16(s[6 * 65], s[7 * 65]);
            *(u32x4*)(WT + (size_t)(n0 + n) * K + k0 + 8 * c) = o; } }
    LDS_WAIT(); asm volatile("" ::: "memory");
}
__device__ __forceinline__ void ph_prologue(Frame& F) {
    const float* c_in = F.a->in[1]; const float* w_mod = F.a->in[2]; const float* b_mod = F.a->in[3];
    float* MOD = (float*)(F.ws + WS_MOD);
    for (int item = F.bid; item < 48; item += F.G) {
        LAS float* SC = (LAS float*)F.lds;
        __syncthreads();
        for (int i = F.tid; i < 32768; i += NTHR) { const int b = i >> 10, k = i & 1023; SC[k * 32 + b] = silu_f(c_in[i]); }
        __syncthreads();
        const int col = item * 128 + (F.tid >> 2), kq = F.tid & 3;
        float a[32];
#pragma unroll
        for (int b = 0; b < 32; ++b) a[b] = 0.f;
#pragma nounroll
        for (int kg = 0; kg < 256; kg += 16) {
            float wv[16];
#pragma unroll
            for (int u = 0; u < 16; ++u) wv[u] = w_mod[(size_t)(kq * 256 + kg + u) * 6144 + col];
#pragma unroll
            for (int u = 0; u < 16; ++u) { const int k = kq * 256 + kg + u; const float w = wv[u];
#pragma unroll
                for (int b4 = 0; b4 < 8; ++b4) { const f32x4 s = *(const LAS f32x4*)(SC + k * 32 + b4 * 4); a[b4 * 4 + 0] += w * s[0]; a[b4 * 4 + 1] += w * s[1]; a[b4 * 4 + 2] += w * s[2]; a[b4 * 4 + 3] += w * s[3]; } } }
#pragma unroll
        for (int b = 0; b < 32; ++b) { a[b] += __shfl_xor(a[b], 1); a[b] += __shfl_xor(a[b], 2); }
        if (kq == 0) { const float bm = b_mod[col];
#pragma unroll
            for (int b = 0; b < 32; ++b) MOD[(size_t)b * 6144 + col] = a[b] + bm; }
        __syncthreads();
    }
    if (F.bid == (F.G > 48 ? 48 : 0)) {
        float* BT = (float*)(F.ws + WS_BIAST); const float* rel_bias = F.a->in[8];
        for (int i = F.tid; i < 249 * 8; i += NTHR) { const int idx = i >> 3, h = i & 7, rel = idx - 185; const int n = rel < 0 ? -rel : rel;
            const float nf = (float)(n > 1 ? n : 1); int large = 8 + (int)(logf(nf / 8.0f) / 2.7725887f * 8.0f); if (large > 15) large = 15;
            const int bucket = (rel > 0 ? 16 : 0) + (n < 8 ? n : large);
            BT[i] = rel_bias[bucket * 8 + h] * LOG2E; }
    }
    LAS float* scr = (LAS float*)(F.lds + F.wave * 16640);
    __syncthreads();
    const int gw = F.bid * NWAVES + F.wave, NGW = F.G * NWAVES;
    constexpr int I_WIN = 16 * (NPROJ / 64), I_SQ = 16 * 16, I_W1E = 16 * 32, I_W2E = 16 * 16;
    constexpr int NITEMS = (PROJ_FP8 ? 2 : 1) * I_WIN + 3 * I_SQ + 32 * I_W1E + 32 * I_W2E;
    for (int it = gw; it < NITEMS; it += NGW) {
        int r = it;
        if (r < I_WIN) { transpose_item(F.a->in[4], 1024, 6872, (bf16_t*)(F.ws + WS_WIN), MapWin(), scr, r / (NPROJ / 64), r % (NPROJ / 64), F.lane, nullptr); continue; } r -= I_WIN;
        if (PROJ_FP8) { if (r < I_WIN) { transpose_item<MapWin, true>(F.a->in[4], 1024, 6872, (bf16_t*)(F.ws + WS_WIN8), MapWin(), scr, r / (NPROJ / 64), r % (NPROJ / 64), F.lane, nullptr); continue; } r -= I_WIN; }
        if (r < I_SQ) { if (PA_FP8) transpose_item<MapIdent, true>(F.a->in[15], 1024, 1024, (bf16_t*)(F.ws + WS_WPA8), MapIdent(), scr, r / 16, r % 16, F.lane, nullptr);
                         else transpose_item(F.a->in[15], 1024, 1024, (bf16_t*)(F.ws + WS_WPA), MapIdent(), scr, r / 16, r % 16, F.lane, nullptr); continue; } r -= I_SQ;
        if (r < I_SQ) { if (PB_FP8) transpose_item<MapIdent, true>(F.a->in[16], 1024, 1024, (bf16_t*)(F.ws + WS_WPB8), MapIdent(), scr, r / 16, r % 16, F.lane, F.a->in[14]);
                         else transpose_item(F.a->in[16], 1024, 1024, (bf16_t*)(F.ws + WS_WPB), MapIdent(), scr, r / 16, r % 16, F.lane, F.a->in[14]); continue; } r -= I_SQ;
        if (r < I_SQ) { transpose_item(F.a->in[17], 1024, 1024, (bf16_t*)(F.ws + WS_WOUT), MapIdent(), scr, r / 16, r % 16, F.lane, nullptr); continue; } r -= I_SQ;
        if (r < 32 * I_W1E) { const int e = r / I_W1E, q = r % I_W1E; transpose_item<MapW1, MOE_FP8 != 0>(F.a->in[22] + (size_t)e * 1024 * 2048, 1024, 2048, (bf16_t*)(F.ws + WS_W1 + (size_t)e * 2048 * MOE_RB), MapW1(), scr, q / 32, q % 32, F.lane, nullptr); continue; } r -= 32 * I_W1E;
        { const int e = r / I_W2E, q = r % I_W2E; transpose_item<MapIdent, MOE_FP8 != 0>(F.a->in[24] + (size_t)e * 1024 * 1024, 1024, 1024, (bf16_t*)(F.ws + WS_W2 + (size_t)e * 1024 * MOE_RB), MapIdent(), scr, q / 16, q % 16, F.lane, nullptr); }
    }
}

__device__ __forceinline__ void ph_ln1(Frame& F) {
    const float* x = F.a->in[0]; const float* MOD = (const float*)(F.ws + WS_MOD); bf16_t* U = (bf16_t*)(F.outb + OUT_U);
    const int gw = F.bid * NWAVES + F.wave, NGW = F.G * NWAVES;
    constexpr int RB = 4;
    for (int m0 = gw; m0 < NTOK; m0 += NGW * RB) {
        f32x4 v[RB][4];
#pragma unroll
        for (int r = 0; r < RB; ++r) { const f32x4* xr = (const f32x4*)(x + (size_t)(m0 + r * NGW) * D) + F.lane;
#pragma unroll
            for (int j = 0; j < 4; ++j) v[r][j] = xr[64 * j]; }
#pragma unroll
        for (int r = 0; r < RB; ++r) { const int m = m0 + r * NGW; const float* md = MOD + (size_t)(m >> 11) * 6144;
            float s = 0.f;
#pragma unroll
            for (int j = 0; j < 4; ++j) s += (v[r][j][0] + v[r][j][1]) + (v[r][j][2] + v[r][j][3]);
            const float mean = wave_sum(s) * (1.f / D); float s2 = 0.f;
#pragma unroll
            for (int j = 0; j < 4; ++j) { v[r][j] = v[r][j] - mean; s2 += (v[r][j][0] * v[r][j][0] + v[r][j][1] * v[r][j][1]) + (v[r][j][2] * v[r][j][2] + v[r][j][3] * v[r][j][3]); }
            const float rstd = 1.f / sqrtf(wave_sum(s2) * (1.f / D) + LN_EPS);
            u32x2* o8 = (u32x2*)(U + (size_t)m * D) + F.lane;
#pragma unroll
            for (int j = 0; j < 4; ++j) { const f32x4 sh = *((const f32x4*)md + F.lane + 64 * j), sc = *((const f32x4*)(md + 1024) + F.lane + 64 * j);
                const f32x4 rr = v[r][j] * rstd * (sc + 1.0f) + sh; u32x2 w; w.x = cvt_pk_bf16(rr[0], rr[1]); w.y = cvt_pk_bf16(rr[2], rr[3]); o8[64 * j] = w;
                if (PROJ_FP8) { int pk = 0; pk = __builtin_amdgcn_cvt_pk_fp8_f32(rr[0], rr[1], pk, false); pk = __builtin_amdgcn_cvt_pk_fp8_f32(rr[2], rr[3], pk, true); ((unsigned*)(F.ws + WS_U8 + (size_t)m * D))[F.lane + 64 * j] = (unsigned)pk; } } }
    }
}

__device__ __forceinline__ void ph_misc(Frame& F) {
    const float* MISC = (const float*)(F.outb + OUT_MISC);
    bf16_t* KV = (bf16_t*)(F.outb + OUT_KV); bf16_t* IK = (bf16_t*)(F.outb + OUT_IK); float* IW = (float*)(F.outb + OUT_IW); float* DT = (float*)(F.outb + OUT_DT);
    const float* kvw = F.a->in[5]; const float* ikw = F.a->in[6]; const float* ikb = F.a->in[7]; const float* dtb = F.a->in[11];
    const int gw = F.bid * NWAVES + F.wave, NGW = F.G * NWAVES, l = F.lane;
    for (int m0 = gw; m0 < NTOK; m0 += NGW * 4) {
      f32x4 vv[4];
#pragma unroll
      for (int r = 0; r < 4; ++r) vv[r] = *((const f32x4*)(MISC + (size_t)(m0 + r * NGW) * 256) + l);
#pragma unroll
      for (int r = 0; r < 4; ++r) { const int m = m0 + r * NGW;
        const f32x4 v = vv[r];
        const float sq = v[0] * v[0] + v[1] * v[1] + v[2] * v[2] + v[3] * v[3], sm = (v[0] + v[1]) + (v[2] + v[3]);
        const float kvss = wave_sum(l < 32 ? sq : 0.f);
        const float iks = wave_sum((l >= 32 && l < 48) ? sm : 0.f);
        const float ikmean = iks * (1.f / 64.f);
        const f32x4 dv = v - ikmean;
        const float ikq = wave_sum((l >= 32 && l < 48) ? (dv[0] * dv[0] + dv[1] * dv[1] + dv[2] * dv[2] + dv[3] * dv[3]) : 0.f);
        if (l < 32) { const float r = 1.f / sqrtf(kvss * (1.f / 128.f) + LN_EPS); const f32x4 w = *((const f32x4*)kvw + l); const f32x4 o = v * r * w;
            u32x2 pk; pk.x = cvt_pk_bf16(o[0], o[1]); pk.y = cvt_pk_bf16(o[2], o[3]); *((u32x2*)(KV + (size_t)m * 128) + l) = pk; }
        else if (l < 48) { const float r = 1.f / sqrtf(ikq * (1.f / 64.f) + LN_EPS); const f32x4 w = *((const f32x4*)ikw + (l - 32)), bb = *((const f32x4*)ikb + (l - 32)); const f32x4 o = dv * r * w + bb;
            u32x2 pk; pk.x = cvt_pk_bf16(o[0], o[1]); pk.y = cvt_pk_bf16(o[2], o[3]); *((u32x2*)(IK + (size_t)m * 64) + (l - 32)) = pk; }
        else if (l < 50) { *((f32x4*)(IW + (size_t)m * 8) + (l - 48)) = v * 0.35355339059327373f; }
        else if (l < 54) { const f32x4 bb = *((const f32x4*)dtb + (l - 50)); f32x4 o;
#pragma unroll
            for (int j = 0; j < 4; ++j) { const float t = v[j] + bb[j]; o[j] = t > 20.f ? t : log1pf(__expf(t)); }
            *((f32x4*)(DT + (size_t)m * 16) + (l - 50)) = o; }
      }
    }
}

__device__ __forceinline__ unsigned sortable_key(float s) { const unsigned u = __float_as_uint(s + 0.0f); return (u & 0x80000000u) ? ~u : (u | 0x80000000u); }
template <int NKB> struct KeyRow { unsigned k[NKB]; };
__device__ __forceinline__ u64 low_bits_keep(u64 m, int t) { u64 out = 0; while (t-- > 0 && m) { const u64 b = m & (0 - m); out |= b; m ^= b; } return out; }
namespace idx { constexpr int KST = 144, KBUF = 64 * KST; }
__device__ __forceinline__ unsigned low_bits_keep32(unsigned m, int t) { unsigned out = 0; while (t-- > 0 && m) { const unsigned b = m & (0u - m); out |= b; m ^= b; } return out; }
template <int NG> __device__ __forceinline__ void topk2_select_write(const unsigned (&key)[64], int nkb, u64* mrow, int lane) {
    constexpr int NR = NG * 16;
    unsigned T0 = 0u, T1 = 0u; bool ex0 = false, ex1 = false;
    unsigned lo0 = 0u, lo1 = 0u, hi0 = 0xFFFFFFFFu, hi1 = 0xFFFFFFFFu, st0, st1, p0, p1; bool fin0 = false, fin1 = false;
    { float sm = 0.f, sq = 0.f;
#pragma unroll
        for (int m = 0; m < 10; ++m) { const unsigned k = key[m]; const float f = __uint_as_float((k & 0x80000000u) ? (k ^ 0x80000000u) : ~k); sm += f; sq += f * f; }
#pragma unroll
        for (int o = 1; o < 32; o <<= 1) { sm += __shfl_xor(sm, o); sq += __shfl_xor(sq, o); }
        const float mu = sm * (1.f / 320.f), sd = sqrtf(fmaxf(sq * (1.f / 320.f) - mu * mu, 1e-20f));
        const float qq = 256.f / (64.f * (float)nkb), pp = qq < 0.5f ? qq : 1.f - qq, tt = sqrtf(-2.f * __logf(pp));
        float z = tt - (2.515517f + 0.802853f * tt + 0.010328f * tt * tt) / (1.f + 1.432788f * tt + 0.189269f * tt * tt + 0.001308f * tt * tt * tt); if (qq >= 0.5f) z = -z;
        const unsigned pe = sortable_key(mu + z * sd), pd = sortable_key(mu + z * sd + 0.125f * sd);
        unsigned stp = pd - pe; if (stp < 1024u) stp = 1024u;
        p0 = __builtin_amdgcn_readlane((int)pe, 0); p1 = __builtin_amdgcn_readlane((int)pe, 32); st0 = __builtin_amdgcn_readlane((int)stp, 0); st1 = __builtin_amdgcn_readlane((int)stp, 32); }
#pragma nounroll
    for (int it = 0; it < 80; ++it) {
        const unsigned candv = lane < 32 ? p0 : p1;
        unsigned cl = 0u;
#pragma unroll
        for (int m = 0; m < NR; ++m) cl += (key[m] >= candv) ? 1u : 0u;
        cl += __shfl_xor(cl, 1); cl += __shfl_xor(cl, 2); cl += __shfl_xor(cl, 4); cl += __shfl_xor(cl, 8); cl += __shfl_xor(cl, 16);
        const int n0 = __builtin_amdgcn_readlane((int)cl, 0), n1 = __builtin_amdgcn_readlane((int)cl, 32);
#define IDX_STEP(lo, hi, st, p, T, ex, fin, n) do { if (!fin) { \
            if (n == 256) { T = p; ex = true; fin = true; } \
            else { if (n > 256) lo = p; else hi = p; \
                if (hi - lo <= 1u) { T = lo; fin = true; } \
                else { unsigned c; if (hi == 0xFFFFFFFFu) { c = lo + st; if (c < lo) c = hi; st = st << 1; } else if (lo == 0u) { c = hi - st; if (c > hi) c = lo; st = st << 1; } else c = lo + ((hi - lo) >> 1); \
                    if (c <= lo || c >= hi) c = lo + ((hi - lo) >> 1); p = c; } } } } while (0)
        IDX_STEP(lo0, hi0, st0, p0, T0, ex0, fin0, n0);
        IDX_STEP(lo1, hi1, st1, p1, T1, ex1, fin1, n1);
#undef IDX_STEP
        if (fin0 && fin1) break;
    }
    const unsigned Tv = lane < 32 ? T0 : T1;
    if (ex0 && ex1) {
        unsigned mlo = 0u, mhi = 0u;
#pragma unroll
        for (int j = 0; j < NR / 2; ++j) {
            const u64 b0 = __ballot(key[2 * j] >= Tv), b1 = __ballot(key[2 * j + 1] >= Tv);
            asm volatile("s_nop 1\n\tv_writelane_b32 %0, %2, %6\n\tv_writelane_b32 %0, %3, %7\n\tv_writelane_b32 %1, %4, %6\n\tv_writelane_b32 %1, %5, %7"
                         : "+v"(mlo), "+v"(mhi) : "s"((unsigned)b0), "s"((unsigned)(b0 >> 32)), "s"((unsigned)b1), "s"((unsigned)(b1 >> 32)), "n"(j), "n"(32 + j));
            if ((j & 3) == 3) SBAR();
        }
        const int jl = lane & 31;
        if (jl < nkb) mrow[(lane >> 5) * 32 + jl] = (u64)mlo | ((u64)mhi << 32);
        return;
    }
    int rem0 = 1 << 30, rem1 = 1 << 30;
    { int g0 = 0, g1 = 0;
#pragma unroll
        for (int m = 0; m < NR; ++m) { const u64 mk = __ballot(key[m] > Tv); g0 += __builtin_popcount((unsigned)mk); g1 += __builtin_popcount((unsigned)(mk >> 32)); if ((m & 7) == 7) SBAR(); }
        if (!ex0) rem0 = 256 - g0; if (!ex1) rem1 = 256 - g1; }
    u64 mine = 0ull;
#pragma nounroll
    for (int jq = 0; jq < NR / 8; ++jq) {
#pragma unroll
        for (int jj = 0; jj < 4; ++jj) { const int j = jq * 4 + jj;
            unsigned w0[2], w1[2];
#pragma unroll
            for (int hh = 0; hh < 2; ++hh) { unsigned kv = 0u;
#pragma unroll
                for (int m = 0; m < NR; ++m) if ((m >> 3) == 0) {}
#pragma unroll
                for (int m = 0; m < NR; ++m) kv = (m == 2 * j + hh) ? key[m] : kv;
                const u64 gt = __ballot(kv > Tv), eq = __ballot(kv == Tv);
                { const unsigned e = (unsigned)eq, g = (unsigned)gt; const int ne = __builtin_popcount(e); unsigned sel = g; if (rem0 >= ne) { sel |= e; rem0 -= ne; } else if (rem0 > 0) { sel |= low_bits_keep32(e, rem0); rem0 = 0; } w0[hh] = sel; }
                { const unsigned e = (unsigned)(eq >> 32), g = (unsigned)(gt >> 32); const int ne = __builtin_popcount(e); unsigned sel = g; if (rem1 >= ne) { sel |= e; rem1 -= ne; } else if (rem1 > 0) { sel |= low_bits_keep32(e, rem1); rem1 = 0; } w1[hh] = sel; } }
            const u64 q0w = (u64)w0[0] | ((u64)w0[1] << 32), q1w = (u64)w1[0] | ((u64)w1[1] << 32);
            if (lane == j) mine = q0w; if (lane == 32 + j) mine = q1w; }
    }
    const int jl = lane & 31;
    if (jl < nkb) mrow[(lane >> 5) * 32 + jl] = mine;
}
template <int J0> __device__ __forceinline__ void index_scores8(unsigned (&key)[64], const bf16x8 (&af)[2], const f32x4& iw4, const bf16_t* kvsrc, char* lds, int nkb, u32x4 (&stg)[8], int tid) {
    const int lane = tid & 63, sub = lane & 15, kg = lane >> 4;
#pragma unroll
    for (int jj = 0; jj < 8; ++jj) {
        const int j = J0 + jj;
        if (j < nkb) {
            if (j + 1 < nkb) *(u32x4*)(lds + ((j + 1) & 1) * idx::KBUF + (tid >> 3) * idx::KST + (tid & 7) * 16) = stg[(jj + 1) & 7];
            if (j + 8 < nkb) stg[jj] = *(const u32x4*)(kvsrc + (size_t)(j + 8) * 64 * 64);
            const char* kb = lds + (j & 1) * idx::KBUF + sub * idx::KST + kg * 16;
#pragma unroll
            for (int pr = 0; pr < 2; ++pr) {
                f32x4 dA = (f32x4){0.f, 0.f, 0.f, 0.f}, dB = dA;
#pragma unroll
                for (int ks = 0; ks < 2; ++ks) {
                    const bf16x8 fA = *(const bf16x8*)(kb + (pr * 32) * idx::KST + ks * 64), fB = *(const bf16x8*)(kb + (pr * 32 + 16) * idx::KST + ks * 64);
                    dA = __builtin_amdgcn_mfma_f32_16x16x32_bf16(af[ks], fA, dA, 0, 0, 0); dB = __builtin_amdgcn_mfma_f32_16x16x32_bf16(af[ks], fB, dB, 0, 0, 0); }
                float pA = 0.f, pB = 0.f;
#pragma unroll
                for (int r = 0; r < 4; ++r) { pA += fmaxf(dA[r], 0.f) * iw4[r]; pB += fmaxf(dB[r], 0.f) * iw4[r]; }
                auto rr = __builtin_amdgcn_permlane16_swap(__float_as_uint(pA), __float_as_uint(pB), false, false);
                key[2 * j + pr] = sortable_key(__uint_as_float(rr[0]) + __uint_as_float(rr[1]));
            }
            __syncthreads();
        }
    }
}
__device__ __forceinline__ void ph_index(Frame& F) {
    const bf16_t* IQ = (const bf16_t*)(F.outb + OUT_IQ); const bf16_t* IK = (const bf16_t*)(F.outb + OUT_IK); const float* IW = (const float*)(F.outb + OUT_IW);
    u64* MASK = (u64*)(F.outb + OUT_MASK);
    char* lds = (char*)(unsigned char*)F.lds;
    const int tid = F.tid, lane = F.lane, sub = lane & 15, kg = lane >> 4;
    for (int item = F.bid; item < NTOK / 16; item += F.G) {
        const int tokw = (((item & 255) >> 3) << 11) + (((item & 7) + 8 * (item >> 8)) << 4) + F.wave * 2, b = tokw >> 11, pos0 = tokw & 2047, nkb = (pos0 >> 6) + 1;
        u64* mrow = MASK + (size_t)tokw * 32;
        if (nkb <= 4) { if ((lane & 31) < nkb) mrow[(lane >> 5) * 32 + (lane & 31)] = ~0ull; continue; }
        bf16x8 af[2];
        { const bf16_t* ap = IQ + (size_t)(tokw + (sub >> 3)) * 512 + (sub & 7) * 64 + kg * 8;
#pragma unroll
          for (int ks = 0; ks < 2; ++ks) af[ks] = *(const bf16x8*)(ap + ks * 32); }
        const f32x4 iw4 = *(const f32x4*)(IW + (size_t)(tokw + (lane >> 5)) * 8 + 4 * (kg & 1));
        unsigned key[64];
#pragma unroll
        for (int m = 0; m < 64; ++m) key[m] = 0u;
        const bf16_t* kvsrc = IK + ((size_t)b * SEQ + (tid >> 3)) * 64 + (tid & 7) * 8;
        u32x4 stg[8];
#pragma unroll
        for (int i = 0; i < 8; ++i) stg[i] = (i < nkb) ? *(const u32x4*)(kvsrc + (size_t)i * 64 * 64) : (u32x4){0u, 0u, 0u, 0u};
        __syncthreads();
        *(u32x4*)(lds + (tid >> 3) * idx::KST + (tid & 7) * 16) = stg[0];
        __syncthreads();
        const int ng = (nkb + 7) >> 3;
        index_scores8<0>(key, af, iw4, kvsrc, lds, nkb, stg, tid);
        if (ng > 1) index_scores8<8>(key, af, iw4, kvsrc, lds, nkb, stg, tid);
        if (ng > 2) index_scores8<16>(key, af, iw4, kvsrc, lds, nkb, stg, tid);
        if (ng > 3) index_scores8<24>(key, af, iw4, kvsrc, lds, nkb, stg, tid);
        if (ng == 1) topk2_select_write<1>(key, nkb, mrow, lane);
        else if (ng == 2) topk2_select_write<2>(key, nkb, mrow, lane);
        else if (ng == 3) topk2_select_write<3>(key, nkb, mrow, lane);
        else topk2_select_write<4>(key, nkb, mrow, lane);
    }
}

namespace att {
constexpr int KVBLK = 64;
constexpr int SHM_V = KVBLK * 128 * 2, SHM_K = SHM_V;
constexpr int OFF_V = 0, OFF_K = 2 * SHM_V, OFF_WS = 2 * SHM_V + 2 * SHM_K, OFF_BT = OFF_WS + NWAVES * 64 * 4;
#define KSWZ(row, colB) ((row) * 256 + ((colB) ^ (((row) & 7) << 4)))
__device__ __forceinline__ int crow(int r, int hi) { return (r & 3) + 8 * (r >> 2) + 4 * hi; }
__device__ __forceinline__ int v_st(int k, int c) { const int kk = (k & ~0xC) | ((k & 4) << 1) | ((k & 8) >> 1); return ((kk >> 3) * 4 + (c >> 5)) * 512 + ((kk & 7) * 32 + (c & 31)) * 2; }
__device__ __forceinline__ int v_rd_base(int lane) { return ((lane & 3) << 3) | (((lane >> 2) & 3) << 6) | (((lane >> 4) & 1) << 5) | (((lane >> 5) & 1) << 8); }
constexpr int v_rd_off(int d0, int ks, int half) { return d0 * 512 + ks * 4096 + half * 2048; }
template <int OFF> __device__ __forceinline__ s16x4 tr_read(int vb) { s16x4 r; asm volatile("ds_read_b64_tr_b16 %0, %1 offset:%2" : "=&v"(r) : "v"(vb), "i"(OFF) : "memory"); return r; }
template <int D0> __device__ __forceinline__ void pv_one(f32x16& od, int vb, bf16x8 pa0, bf16x8 pa1, bf16x8 pa2, bf16x8 pa3) {
    const s16x4 l0 = tr_read<v_rd_off(D0, 0, 0)>(vb), h0 = tr_read<v_rd_off(D0, 0, 1)>(vb), l1 = tr_read<v_rd_off(D0, 1, 0)>(vb), h1 = tr_read<v_rd_off(D0, 1, 1)>(vb);
    const s16x4 l2 = tr_read<v_rd_off(D0, 2, 0)>(vb), h2 = tr_read<v_rd_off(D0, 2, 1)>(vb), l3 = tr_read<v_rd_off(D0, 3, 0)>(vb), h3 = tr_read<v_rd_off(D0, 3, 1)>(vb);
    asm volatile("s_waitcnt lgkmcnt(0)" ::: "memory"); SBAR();
#define PK(L, H) (bf16x8){L[0], L[1], L[2], L[3], H[0], H[1], H[2], H[3]}
    od = __builtin_amdgcn_mfma_f32_32x32x16_bf16(pa0, PK(l0, h0), od, 0, 0, 0);
    od = __builtin_amdgcn_mfma_f32_32x32x16_bf16(pa1, PK(l1, h1), od, 0, 0, 0);
    od = __builtin_amdgcn_mfma_f32_32x32x16_bf16(pa2, PK(l2, h2), od, 0, 0, 0);
    od = __builtin_amdgcn_mfma_f32_32x32x16_bf16(pa3, PK(l3, h3), od, 0, 0, 0);
#undef PK
}
__device__ __forceinline__ void qkt(f32x16& p0, f32x16& p1, const char* Ks, const bf16x8* qr, int r32, int hi) {
    p0 = f32x16{}; p1 = f32x16{};
    int rv = r32; asm volatile("" : "+v"(rv));
    const char* kb = Ks + rv * 256; const int swz = ((rv & 7) << 4) ^ (hi * 16);
#pragma unroll
    for (int d0 = 0; d0 < 8; ++d0) { const char* ka = kb + ((d0 * 32) ^ swz);
        const bf16x8 b0 = *reinterpret_cast<const bf16x8*>(ka);
        const bf16x8 b1 = *reinterpret_cast<const bf16x8*>(ka + 8192);
        p0 = __builtin_amdgcn_mfma_f32_32x32x16_bf16(b0, qr[d0], p0, 0, 0, 0);
        p1 = __builtin_amdgcn_mfma_f32_32x32x16_bf16(b1, qr[d0], p1, 0, 0, 0); }
}
__device__ __forceinline__ void attn_item(Frame& F, int b, int q0, char* lds) {
    const bf16_t* Q = (const bf16_t*)(F.ws + WS_Q); const bf16_t* KV = (const bf16_t*)(F.outb + OUT_KV); const u64* MASK = (const u64*)(F.outb + OUT_MASK);
    bf16_t* OA = (bf16_t*)(F.outb + OUT_OA);
    int tid = F.tid; asm volatile("" : "+v"(tid));
    const int wid = F.wave, lane = tid & 63, r32 = lane & 31, hi = lane >> 5;
    char* V_lds = lds + OFF_V; char* K_lds = lds + OFF_K;
    float* wsl = (float*)(lds + OFF_WS) + wid * 64; float* li_l = wsl; float* al_l = wsl + 32;
    const float* btab = (const float*)(lds + OFF_BT);
    constexpr float C = 0.088388347648318440f * LOG2E;
    float m_reg = -1e30f, l_reg = 0.f; f32x16 o[4] = {}; bf16x8 qr[8];
    const size_t tokq = (size_t)b * SEQ + q0 + r32;
    { const bf16_t* Qw = Q + tokq * 1024 + wid * 128 + hi * 8;
#pragma unroll
      for (int d0 = 0; d0 < 8; ++d0) qr[d0] = *(const bf16x8*)(Qw + d0 * 16); }
    const u64* mq = MASK + tokq * 32;
    const int sr = tid >> 4, sc = (tid & 15) * 8;
    const int vb0 = (int)(uintptr_t)V_lds + v_rd_base(lane);
    const bf16_t* Kb = KV + (size_t)b * SEQ * 128;
    const int NT = (q0 >> 6) + 1;
    const float bfar = btab[wid];
    bf16x8 s0, s1;
#define SLOAD(k0) do { s0 = *(const bf16x8*)(Kb + (size_t)((k0) + sr) * 128 + sc); s1 = *(const bf16x8*)(Kb + (size_t)((k0) + 32 + sr) * 128 + sc); } while (0)
#define SWRITE(bf) do { int srv = sr; asm volatile("" : "+v"(srv)); const int kc = sc * 2; const int v0a = v_st(srv, sc), k0a = KSWZ(srv, kc); \
        *(bf16x8*)(V_lds + (bf) * SHM_V + v0a) = s0; *(bf16x8*)(V_lds + (bf) * SHM_V + v0a + 8192) = s1; \
        *(bf16x8*)(K_lds + (bf) * SHM_K + k0a) = s0; *(bf16x8*)(K_lds + (bf) * SHM_K + k0a + 8192) = s1; } while (0)
    __syncthreads();
    SLOAD(0); VM_WAIT(); SWRITE(0); __syncthreads();
    u64 mw_next = mq[0];
    for (int j = 0; j < NT; ++j) {
        int lanel = lane; asm volatile("" : "+v"(lanel)); const int r32l = lanel & 31, hil = lanel >> 5;
        const int bf = j & 1;
        if (j + 1 < NT) SLOAD((j + 1) * KVBLK);
        const u64 mw = mw_next; if (j + 1 < NT) mw_next = mq[j + 1];
        f32x16 p0, p1;
        qkt(p0, p1, K_lds + bf * SHM_K, qr, r32l, hil);
        const unsigned w0 = (unsigned)(mw >> (4 * hil)), w1 = (unsigned)(mw >> (32 + 4 * hil));
        const int relmax = j * KVBLK + 63 - q0;
        float alpha = 1.f, ps = 0.f;
        if (relmax <= -91) {
            float pmax = p0[0];
#pragma unroll
            for (int r = 1; r < 16; ++r) pmax = fmaxf(pmax, p0[r]);
#pragma unroll
            for (int r = 0; r < 16; ++r) pmax = fmaxf(pmax, p1[r]);
            { auto rr = __builtin_amdgcn_permlane32_swap(__float_as_uint(pmax), __float_as_uint(pmax), false, false); pmax = fmaxf(__uint_as_float(rr[0]), __uint_as_float(rr[1])); }
            pmax = fmaf(pmax, C, bfar);
            if (!__all(pmax - m_reg <= 11.0f)) { const float mn = fmaxf(m_reg, pmax); alpha = __builtin_amdgcn_exp2f(m_reg - mn); m_reg = mn; }
            const float off = bfar - m_reg;
#pragma unroll
            for (int r = 0; r < 16; ++r) { const int cb = (r & 3) + 8 * (r >> 2);
                const float e0 = __builtin_amdgcn_exp2f(fmaf(p0[r], C, off)), e1 = __builtin_amdgcn_exp2f(fmaf(p1[r], C, off));
                p0[r] = __uint_as_float(__float_as_uint(e0) & (unsigned)__builtin_amdgcn_sbfe((int)w0, cb, 1)); p1[r] = __uint_as_float(__float_as_uint(e1) & (unsigned)__builtin_amdgcn_sbfe((int)w1, cb, 1)); ps += p0[r] + p1[r]; }
        } else {
            const float* bp = btab + (j * KVBLK + 4 * hil - (q0 + r32l) + 185) * 8 + wid;
#pragma unroll
            for (int r4 = 0; r4 < 4; ++r4) {
#pragma unroll
                for (int rr = 0; rr < 4; ++rr) { const int r = r4 * 4 + rr; const int cb = (r & 3) + 8 * (r >> 2); p0[r] = fmaf(p0[r], C, bp[cb * 8]); p1[r] = fmaf(p1[r], C, bp[(cb + 32) * 8]); }
                SBAR(); }
            float pmax = p0[0];
#pragma unroll
            for (int r = 1; r < 16; ++r) pmax = fmaxf(pmax, p0[r]);
#pragma unroll
            for (int r = 0; r < 16; ++r) pmax = fmaxf(pmax, p1[r]);
            { auto rr = __builtin_amdgcn_permlane32_swap(__float_as_uint(pmax), __float_as_uint(pmax), false, false); pmax = fmaxf(__uint_as_float(rr[0]), __uint_as_float(rr[1])); }
            if (!__all(pmax - m_reg <= 11.0f)) { const float mn = fmaxf(m_reg, pmax); alpha = __builtin_amdgcn_exp2f(m_reg - mn); m_reg = mn; }
#pragma unroll
            for (int r = 0; r < 16; ++r) { const int cb = (r & 3) + 8 * (r >> 2);
                const float e0 = __builtin_amdgcn_exp2f(p0[r] - m_reg), e1 = __builtin_amdgcn_exp2f(p1[r] - m_reg);
                p0[r] = __uint_as_float(__float_as_uint(e0) & (unsigned)__builtin_amdgcn_sbfe((int)w0, cb, 1)); p1[r] = __uint_as_float(__float_as_uint(e1) & (unsigned)__builtin_amdgcn_sbfe((int)w1, cb, 1)); ps += p0[r] + p1[r]; }
        }
        { auto rr = __builtin_amdgcn_permlane32_swap(__float_as_uint(ps), __float_as_uint(ps), false, false); ps = __uint_as_float(rr[0]) + __uint_as_float(rr[1]); }
        l_reg = l_reg * alpha + ps;
        bf16x8 pa0, pa1, pa2, pa3;
#define PK4(P, BASE, OUT) do { unsigned a0 = cvt_pk_bf16(P[BASE + 0], P[BASE + 1]), a1 = cvt_pk_bf16(P[BASE + 2], P[BASE + 3]);   \
    unsigned b0 = cvt_pk_bf16(P[BASE + 4], P[BASE + 5]), b1 = cvt_pk_bf16(P[BASE + 6], P[BASE + 7]);                              \
    auto r0 = __builtin_amdgcn_permlane32_swap(a0, b0, false, false); auto r1 = __builtin_amdgcn_permlane32_swap(a1, b1, false, false); \
    u32x4 w = {r0[0], r1[0], r0[1], r1[1]}; OUT = *reinterpret_cast<bf16x8*>(&w); } while (0)
        PK4(p0, 0, pa0); PK4(p0, 8, pa1); PK4(p1, 0, pa2); PK4(p1, 8, pa3);
#undef PK4
        if (__any(alpha < 1.f)) { if (hil == 0) al_l[r32l] = alpha; LDS_WAIT();
#pragma unroll
            for (int d = 0; d < 4; ++d)
#pragma unroll
                for (int r = 0; r < 16; ++r) o[d][r] *= al_l[crow(r, hil)]; }
        const int vb = (int)(uintptr_t)V_lds + v_rd_base(lanel) + bf * SHM_V;
        pv_one<0>(o[0], vb, pa0, pa1, pa2, pa3); pv_one<1>(o[1], vb, pa0, pa1, pa2, pa3); pv_one<2>(o[2], vb, pa0, pa1, pa2, pa3); pv_one<3>(o[3], vb, pa0, pa1, pa2, pa3);
        if (j + 1 < NT) { VM_WAIT(); SWRITE(bf ^ 1); }
        __syncthreads();
    }
#undef SLOAD
#undef SWRITE
    if (hi == 0) li_l[r32] = l_reg; LDS_WAIT();
    bf16_t* Ow = OA + ((size_t)b * SEQ + q0 + 4 * hi) * 1024 + wid * 128 + r32;
    const float* lip = li_l + 4 * hi;
    unsigned char* Ow8 = (unsigned char*)OA + ((size_t)b * SEQ + q0 + 4 * hi) * 1024 + wid * 128 + r32;
    asm volatile("" : "+v"(Ow), "+v"(lip), "+v"(Ow8));
#pragma unroll
    for (int r = 0; r < 16; ++r) { const int ro = (r & 3) + 8 * (r >> 2); if ((r & 3) == 0) asm volatile("" : "+v"(Ow), "+v"(Ow8), "+v"(lip)); const float rl = fast_rcp(lip[ro]);
#pragma unroll
        for (int d0 = 0; d0 < 4; ++d0) { float v = o[d0][r] * rl; if ((DBG_ATTN_ZERO == 1 && q0 < 256) || (DBG_ATTN_ZERO == 2 && q0 >= 256)) v = 0.f;
            if (PA_FP8) ((unsigned char*)Ow8)[ro * 1024 + d0 * 32] = (unsigned char)(__builtin_amdgcn_cvt_pk_fp8_f32(v, v, 0, false) & 0xff);
            else Ow[ro * 1024 + d0 * 32] = (bf16_t)(cvt_pk_bf16(v, v) & 0xffffu); }
        if ((r & 3) == 3) SBAR(); }
}
__device__ __forceinline__ void att2_partial(f32x16& p0, f32x16& p1, float& m_reg, float& alpha, unsigned w0, bool far, float bfar, const float* bp) {
    constexpr float C = 0.088388347648318440f * LOG2E;
    float off;
    if (far) {
        float pmax = p0[0];
#pragma unroll
        for (int r = 1; r < 16; ++r) pmax = fmaxf(pmax, p0[r]);
#pragma unroll
        for (int r = 0; r < 16; ++r) pmax = fmaxf(pmax, p1[r]);
        { auto rr = __builtin_amdgcn_permlane32_swap(__float_as_uint(pmax), __float_as_uint(pmax), false, false); pmax = fmaxf(__uint_as_float(rr[0]), __uint_as_float(rr[1])); }
        pmax = fmaf(pmax, C, bfar);
        if (__builtin_expect(__all(pmax - m_reg <= 11.0f), 1)) alpha = 1.f; else { const float mn = fmaxf(m_reg, pmax); alpha = __builtin_amdgcn_exp2f(m_reg - mn); m_reg = mn; }
        off = bfar - m_reg;
#pragma unroll
        for (int r = 0; r < 16; ++r) { p0[r] = fmaf(p0[r], C, off); p1[r] = fmaf(p1[r], C, off); }
    } else {
#pragma unroll
        for (int r4 = 0; r4 < 4; ++r4) {
#pragma unroll
            for (int rr = 0; rr < 4; ++rr) { const int r = r4 * 4 + rr; const int cb = (r & 3) + 8 * (r >> 2); p0[r] = fmaf(p0[r], C, bp[cb * 8]); p1[r] = fmaf(p1[r], C, bp[(cb + 32) * 8]); }
            SBAR(); }
        float pmax = p0[0];
#pragma unroll
        for (int r = 1; r < 16; ++r) pmax = fmaxf(pmax, p0[r]);
#pragma unroll
        for (int r = 0; r < 16; ++r) pmax = fmaxf(pmax, p1[r]);
        { auto rr = __builtin_amdgcn_permlane32_swap(__float_as_uint(pmax), __float_as_uint(pmax), false, false); pmax = fmaxf(__uint_as_float(rr[0]), __uint_as_float(rr[1])); }
        if (__builtin_expect(__all(pmax - m_reg <= 11.0f), 1)) alpha = 1.f; else { const float mn = fmaxf(m_reg, pmax); alpha = __builtin_amdgcn_exp2f(m_reg - mn); m_reg = mn; }
#pragma unroll
        for (int r = 0; r < 16; ++r) { p0[r] -= m_reg; p1[r] -= m_reg; }
    }
#pragma unroll
    for (int r = 0; r < 16; ++r) { const int cb = (r & 3) + 8 * (r >> 2); p0[r] = __uint_as_float(__float_as_uint(__builtin_amdgcn_exp2f(p0[r])) & (unsigned)__builtin_amdgcn_sbfe((int)w0, cb, 1)); }
}
__device__ __forceinline__ void att2_finish(f32x16& p0, f32x16& p1, float alpha, float& l_reg, unsigned w1, bf16x8& pa0, bf16x8& pa1, bf16x8& pa2, bf16x8& pa3) {
#pragma unroll
    for (int r = 0; r < 16; ++r) { const int cb = (r & 3) + 8 * (r >> 2); p1[r] = __uint_as_float(__float_as_uint(__builtin_amdgcn_exp2f(p1[r])) & (unsigned)__builtin_amdgcn_sbfe((int)w1, cb, 1)); }
    float ps = 0.f;
#pragma unroll
    for (int r = 0; r < 16; ++r) ps += p0[r];
#pragma unroll
    for (int r = 0; r < 16; ++r) ps += p1[r];
    { auto rr = __builtin_amdgcn_permlane32_swap(__float_as_uint(ps), __float_as_uint(ps), false, false); ps = __uint_as_float(rr[0]) + __uint_as_float(rr[1]); }
    l_reg = l_reg * alpha + ps;
#define PK4(P, BASE, OUT) do { unsigned a0 = cvt_pk_bf16(P[BASE + 0], P[BASE + 1]), a1 = cvt_pk_bf16(P[BASE + 2], P[BASE + 3]);   \
    unsigned b0 = cvt_pk_bf16(P[BASE + 4], P[BASE + 5]), b1 = cvt_pk_bf16(P[BASE + 6], P[BASE + 7]);                              \
    auto r0 = __builtin_amdgcn_permlane32_swap(a0, b0, false, false); auto r1 = __builtin_amdgcn_permlane32_swap(a1, b1, false, false); \
    u32x4 w = {r0[0], r1[0], r0[1], r1[1]}; OUT = *reinterpret_cast<bf16x8*>(&w); } while (0)
    PK4(p0, 0, pa0); PK4(p0, 8, pa1); PK4(p1, 0, pa2); PK4(p1, 8, pa3);
#undef PK4
}
__device__ __forceinline__ void attn_item2(Frame& F, int b, int q0, char* lds) {
    const bf16_t* Q = (const bf16_t*)(F.ws + WS_Q); const bf16_t* KV = (const bf16_t*)(F.outb + OUT_KV); const u64* MASK = (const u64*)(F.outb + OUT_MASK);
    bf16_t* OA = (bf16_t*)(F.outb + OUT_OA);
    int tid = F.tid; asm volatile("" : "+v"(tid));
    const int wid = F.wave, lane = tid & 63, r32 = lane & 31, hi = lane >> 5;
    char* V_lds = lds + OFF_V; char* K_lds = lds + OFF_K;
    float* wsl = (float*)(lds + OFF_WS) + wid * 64; float* li_l = wsl; float* al_l = wsl + 32;
    const float* btab = (const float*)(lds + OFF_BT);
    float m_reg = -1e30f, l_reg = 0.f; f32x16 o[4] = {}; bf16x8 qr[8];
    const size_t tokq = (size_t)b * SEQ + q0 + r32;
    { const bf16_t* Qw = Q + tokq * 1024 + wid * 128 + hi * 8;
#pragma unroll
      for (int d0 = 0; d0 < 8; ++d0) qr[d0] = *(const bf16x8*)(Qw + d0 * 16); }
    const u64* mq = MASK + tokq * 32;
    const int sr = tid >> 4, sc = (tid & 15) * 8;
    const bf16_t* Kb = KV + (size_t)b * SEQ * 128;
    const int NTr = (q0 >> 6) + 1, NT = (NTr + 1) & ~1;
    const float bfar = btab[wid];
    bf16x8 sA0, sA1, sB0, sB1;
#define SLD(s0_, s1_, k0) do { int srl = sr; asm volatile("" : "+v"(srl)); const bf16_t* kp_ = Kb + (size_t)((k0) + srl) * 128 + sc; s0_ = *(const bf16x8*)kp_; s1_ = *(const bf16x8*)(kp_ + 32 * 128); } while (0)
#define SWR(bf, s0_, s1_) do { int srv = sr; asm volatile("" : "+v"(srv)); const int kc = sc * 2; const int v0a = v_st(srv, sc), k0a = KSWZ(srv, kc); \
        *(bf16x8*)(V_lds + (bf) * SHM_V + v0a) = s0_; *(bf16x8*)(V_lds + (bf) * SHM_V + v0a + 8192) = s1_; \
        *(bf16x8*)(K_lds + (bf) * SHM_K + k0a) = s0_; *(bf16x8*)(K_lds + (bf) * SHM_K + k0a + 8192) = s1_; } while (0)
#define MWORD(j) ((j) < NTr ? mq[j] : 0ull)
#define RESC(a) do { if (__any((a) < 1.f)) { if (hi == 0) al_l[r32] = (a); LDS_WAIT(); \
        _Pragma("unroll") for (int d = 0; d < 4; ++d) _Pragma("unroll") for (int r = 0; r < 16; ++r) o[d][r] *= al_l[crow(r, hi)]; } } while (0)
#define PVALL(bf) do { int ll = lane; asm volatile("" : "+v"(ll)); const int vb = (int)(uintptr_t)V_lds + v_rd_base(ll) + (bf) * SHM_V; \
        pv_one<0>(o[0], vb, pa0, pa1, pa2, pa3); pv_one<1>(o[1], vb, pa0, pa1, pa2, pa3); pv_one<2>(o[2], vb, pa0, pa1, pa2, pa3); pv_one<3>(o[3], vb, pa0, pa1, pa2, pa3); } while (0)
#define ISFAR(jt) ((jt) * KVBLK + 63 - q0 <= -91 || (jt) >= NTr)
#define BPTR(jt) (btab + ((jt) * KVBLK + 4 * hi - (q0 + r32) + 185) * 8 + wid)
    f32x16 pA0, pA1, pB0, pB1; float alA, alB; bf16x8 pa0, pa1, pa2, pa3; u64 mwA, mwB;
    __syncthreads();
    SLD(sA0, sA1, 0); mwA = MWORD(0); VM_WAIT(); SWR(0, sA0, sA1); __syncthreads();
    qkt(pA0, pA1, K_lds, qr, r32, hi);
    att2_partial(pA0, pA1, m_reg, alA, (unsigned)(mwA >> (4 * hi)), ISFAR(0), bfar, BPTR(0));
    SLD(sB0, sB1, KVBLK); mwB = MWORD(1); if (2 < NT) SLD(sA0, sA1, 2 * KVBLK);
    SWR(1, sB0, sB1); __syncthreads();
    for (int j = 1; j + 1 < NT; j += 2) {
        SBAR(); qkt(pB0, pB1, K_lds + SHM_K, qr, r32, hi);
        att2_finish(pA0, pA1, alA, l_reg, (unsigned)(mwA >> (32 + 4 * hi)), pa0, pa1, pa2, pa3); SBAR();
        SLD(sB0, sB1, (j + 2) * KVBLK); mwA = MWORD(j + 1); SBAR();
        PVALL(0);
        att2_partial(pB0, pB1, m_reg, alB, (unsigned)(mwB >> (4 * hi)), ISFAR(j), bfar, BPTR(j));
        __syncthreads(); SWR(0, sA0, sA1);
        RESC(alB); __syncthreads();
        SBAR(); qkt(pA0, pA1, K_lds, qr, r32, hi);
        att2_finish(pB0, pB1, alB, l_reg, (unsigned)(mwB >> (32 + 4 * hi)), pa0, pa1, pa2, pa3); SBAR();
        if (j + 3 < NT) SLD(sA0, sA1, (j + 3) * KVBLK); mwB = MWORD(j + 2); SBAR();
        PVALL(1);
        att2_partial(pA0, pA1, m_reg, alA, (unsigned)(mwA >> (4 * hi)), ISFAR(j + 1), bfar, BPTR(j + 1));
        __syncthreads(); SWR(1, sB0, sB1);
        RESC(alA); __syncthreads();
    }
    SBAR(); qkt(pB0, pB1, K_lds + SHM_K, qr, r32, hi);
    att2_finish(pA0, pA1, alA, l_reg, (unsigned)(mwA >> (32 + 4 * hi)), pa0, pa1, pa2, pa3); SBAR();
    PVALL(0);
    att2_partial(pB0, pB1, m_reg, alB, (unsigned)(mwB >> (4 * hi)), ISFAR(NT - 1), bfar, BPTR(NT - 1));
    __syncthreads(); RESC(alB);
    att2_finish(pB0, pB1, alB, l_reg, (unsigned)(mwB >> (32 + 4 * hi)), pa0, pa1, pa2, pa3); SBAR();
    PVALL(1);
#undef SLD
#undef SWR
#undef MWORD
#undef RESC
#undef PVALL
#undef ISFAR
#undef BPTR
    if (hi == 0) li_l[r32] = l_reg; LDS_WAIT();
    bf16_t* Ow = OA + ((size_t)b * SEQ + q0 + 4 * hi) * 1024 + wid * 128 + r32;
    const float* lip = li_l + 4 * hi;
    unsigned char* Ow8 = (unsigned char*)OA + ((size_t)b * SEQ + q0 + 4 * hi) * 1024 + wid * 128 + r32;
    asm volatile("" : "+v"(Ow), "+v"(lip), "+v"(Ow8));
#pragma unroll
    for (int r = 0; r < 16; ++r) { const int ro = (r & 3) + 8 * (r >> 2); if ((r & 3) == 0) asm volatile("" : "+v"(Ow), "+v"(Ow8), "+v"(lip)); const float rl = fast_rcp(lip[ro]);
#pragma unroll
        for (int d0 = 0; d0 < 4; ++d0) { float v = o[d0][r] * rl;
            if (PA_FP8) ((unsigned char*)Ow8)[ro * 1024 + d0 * 32] = (unsigned char)(__builtin_amdgcn_cvt_pk_fp8_f32(v, v, 0, false) & 0xff);
            else Ow[ro * 1024 + d0 * 32] = (bf16_t)(cvt_pk_bf16(v, v) & 0xffffu); }
        if ((r & 3) == 3) SBAR(); }
}
}
__device__ __forceinline__ void ph_attn(Frame& F) {
    char* lds = (char*)(unsigned char*)F.lds;
    { float* bt = (float*)(lds + att::OFF_BT); const float* BT = (const float*)(F.ws + WS_BIAST); __syncthreads(); for (int i = F.tid; i < 249 * 8; i += NTHR) bt[i] = BT[i]; __syncthreads(); }
    for (int pr = F.bid; pr < NB * 32; pr += F.G) {
        const int b = pr >> 5, qb = pr & 31;
#pragma nounroll
        for (int hh = 0; hh < 2; ++hh) { if (ATT2) att::attn_item2(F, b, (hh ? qb : 63 - qb) * 32, lds); else att::attn_item(F, b, (hh ? qb : 63 - qb) * 32, lds); }
    }
}

namespace ssd {
constexpr int OFF_CS = 0, CS_ST = 272;
constexpr int OFF_BS = OFF_CS + 64 * CS_ST;
constexpr int OFF_BT = OFF_BS + 64 * CS_ST, T_ST = 144;
constexpr int OFF_XT = OFF_BT + 128 * T_ST;
constexpr int OFF_XW = OFF_XT + 64 * T_ST;
constexpr int OFF_XS = OFF_XW + 64 * T_ST;
constexpr int OFF_MT = OFF_XS + 64 * T_ST;
constexpr int OFF_HS = OFF_MT + 64 * T_ST;
constexpr int OFF_END = OFF_HS + 64 * CS_ST;
static_assert(OFF_END + 5 * 320 * 4 <= 131072, "ssd lds");
__device__ __forceinline__ f32x4 mfma16(bf16x8 a, bf16x8 b, f32x4 c) { return __builtin_amdgcn_mfma_f32_16x16x32_bf16(a, b, c, 0, 0, 0); }
__device__ __forceinline__ bf16x8 ldfrag(const char* base, int stride, int row, int k0) { return *(const bf16x8*)(base + row * stride + k0 * 2); }
}
__device__ __forceinline__ void ph_ssd(Frame& F) {
    using namespace ssd;
    char* lds = (char*)(unsigned char*)F.lds;
    const bf16_t* XBC = (const bf16_t*)(F.ws + WS_XBC); const bf16_t* ZS = (const bf16_t*)(F.ws + WS_Z); const float* DT = (const float*)(F.outb + OUT_DT);
    bf16_t* YG = (bf16_t*)(F.ws + WS_Q);
    const float* conv_w = F.a->in[9]; const float* conv_b = F.a->in[10]; const float* a_log = F.a->in[12]; const float* d_skip = F.a->in[13];
    const int tid = F.tid, wid = F.wave, lane = F.lane, fr = lane & 15, fq = lane >> 4;
    const bool stager = tid < 320; const int so = tid % 40, tg = tid / 40;
    for (int item = F.bid; item < NB * 16; item += F.G) {
        const int b = item >> 4, h = item & 15, g = h >> 2;
        const float aneg = -__expf(a_log[h]), dsk = d_skip[h];
        const int ch0 = so < 8 ? h * 64 + so * 8 : (so < 24 ? 1024 + g * 128 + (so - 8) * 8 : 1536 + g * 128 + (so - 24) * 8);
        float* CWL = (float*)(lds + OFF_END);
        __syncthreads();
        if (stager) {
#pragma unroll
            for (int j = 0; j < 4; ++j) { *(f32x4*)(CWL + j * 320 + so * 8) = *(const f32x4*)(conv_w + (size_t)j * 2048 + ch0); *(f32x4*)(CWL + j * 320 + so * 8 + 4) = *(const f32x4*)(conv_w + (size_t)j * 2048 + ch0 + 4); }
            *(f32x4*)(CWL + 4 * 320 + so * 8) = *(const f32x4*)(conv_b + ch0); *(f32x4*)(CWL + 4 * 320 + so * 8 + 4) = *(const f32x4*)(conv_b + ch0 + 4);
        }
        f32x4 hst[4];
#pragma unroll
        for (int t = 0; t < 4; ++t) hst[t] = (f32x4){0.f, 0.f, 0.f, 0.f};
        __syncthreads();
        for (int i = tid; i < 64 * CS_ST / 4; i += NTHR) ((unsigned*)(lds + OFF_HS))[i] = 0u;
        u32x4 raw[11];
        const size_t tokb = (size_t)b * SEQ;
#define SSD_LOAD(c) do { if (stager) { _Pragma("unroll") for (int i = 0; i < 11; ++i) { const int t = (c) * 64 + tg * 8 - 3 + i; \
            raw[i] = (t >= 0) ? *(const u32x4*)(XBC + (tokb + t) * 2048 + ch0) : (u32x4){0u, 0u, 0u, 0u}; } } } while (0)
        SSD_LOAD(0);
        float dtl_next = DT[(tokb + lane) * 16 + h];
        for (int c = 0; c < 32; ++c) {
            const float dtl = dtl_next; if (c + 1 < 32) dtl_next = DT[(tokb + (c + 1) * 64 + lane) * 16 + h];
            u32x2 zpre[2];
#pragma unroll
            for (int t2 = 0; t2 < 2; ++t2) { const int tile = 2 * wid + t2, pb = tile >> 2, lb = tile & 3; zpre[t2] = *(const u32x2*)(ZS + (tokb + c * 64 + lb * 16 + fr) * 1024 + h * 64 + pb * 16 + 4 * fq); }
            float acs = dtl * aneg;
#pragma unroll
            for (int o = 1; o < 64; o <<= 1) { const float t = __shfl_up(acs, o); if (lane >= o) acs += t; }
            const float alast = __shfl(acs, 63);
            if (DBG_SSD_SYNC) __syncthreads();
            float dtv[8], dec[8];
#pragma unroll
            for (int t = 0; t < 8; ++t) { dtv[t] = __shfl(dtl, (tg * 8 + t) & 63); dec[t] = __expf(alast - __shfl(acs, (tg * 8 + t) & 63)); }
            if (stager) {
#pragma unroll
                for (int hq = 0; hq < 2; ++hq) {
                    float xin[11][4];
#pragma unroll
                    for (int i = 0; i < 11; ++i) { const unsigned wa = hq ? raw[i].z : raw[i].x, wb = hq ? raw[i].w : raw[i].y; xin[i][0] = bflo(wa); xin[i][1] = bfhi(wa); xin[i][2] = bflo(wb); xin[i][3] = bfhi(wb); }
                    float outv[8][4];
                    { f32x4 cwv[4]; const f32x4 cbq = *(const f32x4*)(CWL + 4 * 320 + so * 8 + hq * 4);
#pragma unroll
                      for (int j = 0; j < 4; ++j) cwv[j] = *(const f32x4*)(CWL + j * 320 + so * 8 + hq * 4);
#pragma unroll
                      for (int t = 0; t < 8; ++t)
#pragma unroll
                        for (int e = 0; e < 4; ++e) { float sacc = cbq[e];
#pragma unroll
                            for (int j = 0; j < 4; ++j) sacc += cwv[j][e] * xin[t + j][e];
                            outv[t][e] = silu_f(sacc); } }
                    if (so < 8) {
#pragma unroll
                        for (int e = 0; e < 4; ++e) { const int p = so * 8 + hq * 4 + e;
                            f32x4 x0, x1, d0, d1, w0, w1;
#pragma unroll
                            for (int t = 0; t < 4; ++t) { x0[t] = outv[t][e]; x1[t] = outv[4 + t][e]; d0[t] = x0[t] * dtv[t]; d1[t] = x1[t] * dtv[4 + t]; w0[t] = d0[t] * dec[t]; w1[t] = d1[t] * dec[4 + t]; }
                            *(u32x4*)(lds + OFF_XS + p * T_ST + tg * 16) = pack8(x0, x1);
                            *(u32x4*)(lds + OFF_XT + p * T_ST + tg * 16) = pack8(d0, d1);
                            *(u32x4*)(lds + OFF_XW + p * T_ST + tg * 16) = pack8(w0, w1); }
                    } else {
                        const bool isB = so < 24; const int n0 = (isB ? (so - 8) : (so - 24)) * 8 + hq * 4;
                        char* nat = lds + (isB ? OFF_BS : OFF_CS);
#pragma unroll
                        for (int t = 0; t < 8; ++t) { u32x2 w; w.x = cvt_pk_bf16(outv[t][0], outv[t][1]); w.y = cvt_pk_bf16(outv[t][2], outv[t][3]);
                            *(u32x2*)(nat + (tg * 8 + t) * CS_ST + n0 * 2) = w; }
                        if (isB) {
#pragma unroll
                            for (int e = 0; e < 4; ++e) { f32x4 a, bq;
#pragma unroll
                                for (int t = 0; t < 4; ++t) { a[t] = outv[t][e]; bq[t] = outv[4 + t][e]; }
                                *(u32x4*)(lds + OFF_BT + (n0 + e) * T_ST + tg * 16) = pack8(a, bq); }
                        }
                    }
                }
            }
            if (c + 1 < 32) SSD_LOAD(c + 1);
            __syncthreads();
#pragma unroll
            for (int t2 = 0; t2 < 2; ++t2) {
                const int tile = 2 * wid + t2, sb = tile >> 2, lb = tile & 3;
                f32x4 d = (f32x4){0.f, 0.f, 0.f, 0.f};
                if (sb <= lb) {
#pragma unroll
                    for (int ks = 0; ks < 4; ++ks) d = mfma16(ldfrag(lds + OFF_BS, CS_ST, sb * 16 + fr, ks * 32 + fq * 8), ldfrag(lds + OFF_CS, CS_ST, lb * 16 + fr, ks * 32 + fq * 8), d);
                    const int l = lb * 16 + fr; const float al = __shfl(acs, l);
                    f32x4 as;
#pragma unroll
                    for (int r = 0; r < 4; ++r) as[r] = __shfl(acs, sb * 16 + 4 * fq + r);
#pragma unroll
                    for (int r = 0; r < 4; ++r) { const int s = sb * 16 + 4 * fq + r; d[r] = (s <= l) ? d[r] * __expf(al - as[r]) : 0.f; }
                }
                u32x2 w; w.x = cvt_pk_bf16(d[0], d[1]); w.y = cvt_pk_bf16(d[2], d[3]);
                *(u32x2*)(lds + OFF_MT + (lb * 16 + fr) * T_ST + (sb * 16 + 4 * fq) * 2) = w;
            }
            if (DBG_SSD_SYNC) __syncthreads();
            f32x4 yacc[2];
#pragma unroll
            for (int t2 = 0; t2 < 2; ++t2) {
                const int tile = 2 * wid + t2, pb = tile >> 2, lb = tile & 3;
                f32x4 d = (f32x4){0.f, 0.f, 0.f, 0.f};
#pragma unroll
                for (int ks = 0; ks < 4; ++ks) d = mfma16(ldfrag(lds + OFF_HS, CS_ST, pb * 16 + fr, ks * 32 + fq * 8), ldfrag(lds + OFF_CS, CS_ST, lb * 16 + fr, ks * 32 + fq * 8), d);
                const float el = __expf(__shfl(acs, lb * 16 + fr));
                yacc[t2] = d * el;
            }
            __syncthreads();
#pragma unroll
            for (int t2 = 0; t2 < 2; ++t2) {
                const int tile = 2 * wid + t2, pb = tile >> 2, lb = tile & 3;
                f32x4 d = yacc[t2];
#pragma unroll
                for (int ks = 0; ks < 2; ++ks) d = mfma16(ldfrag(lds + OFF_XT, T_ST, pb * 16 + fr, ks * 32 + fq * 8), ldfrag(lds + OFF_MT, T_ST, lb * 16 + fr, ks * 32 + fq * 8), d);
                const int l = lb * 16 + fr, p0 = pb * 16 + 4 * fq; const size_t tok = tokb + c * 64 + l;
                const u32x2 zz = zpre[t2];
                const float z0 = bflo(zz.x), z1 = bfhi(zz.x), z2 = bflo(zz.y), z3 = bfhi(zz.y);
                float xs[4];
#pragma unroll
                for (int r = 0; r < 4; ++r) xs[r] = bflo((unsigned)*(const bf16_t*)(lds + OFF_XS + (p0 + r) * T_ST + l * 2));
                u32x2 w; w.x = cvt_pk_bf16((d[0] + xs[0] * dsk) * z0, (d[1] + xs[1] * dsk) * z1); w.y = cvt_pk_bf16((d[2] + xs[2] * dsk) * z2, (d[3] + xs[3] * dsk) * z3);
                *(u32x2*)(YG + tok * 1024 + h * 64 + p0) = w;
            }
            if (DBG_SSD_SYNC) __syncthreads();
            { const float dc = __expf(alast);
#pragma unroll
              for (int t = 0; t < 4; ++t) { f32x4 d = hst[t] * dc;
#pragma unroll
                  for (int ks = 0; ks < 2; ++ks) d = mfma16(ldfrag(lds + OFF_BT, T_ST, wid * 16 + fr, ks * 32 + fq * 8), ldfrag(lds + OFF_XW, T_ST, t * 16 + fr, ks * 32 + fq * 8), d);
                  hst[t] = d;
                  u32x2 w; w.x = cvt_pk_bf16(d[0], d[1]); w.y = cvt_pk_bf16(d[2], d[3]);
                  *(u32x2*)(lds + OFF_HS + (t * 16 + fr) * CS_ST + (wid * 16 + 4 * fq) * 2) = w; } }
            __syncthreads();
        }
#undef SSD_LOAD
    }
}

namespace ssd2 {
constexpr int CS_ST = 272, T_ST = 144;
constexpr int OFF_CS = 0, OFF_BS = 64 * CS_ST, OFF_BT = 2 * 64 * CS_ST, OFF_H0 = OFF_BT + 128 * T_ST;
constexpr int H_XS = 0, H_XW = 64 * T_ST, H_MT = 2 * 64 * T_ST, H_HS = 3 * 64 * T_ST, H_SZ = H_HS + 64 * CS_ST;
constexpr int OFF_CW = OFF_H0 + 2 * H_SZ;
static_assert(OFF_CW + 5 * 384 * 4 <= LDS_MISC, "ssd2 lds");
}
__device__ __forceinline__ void ph_ssd2(Frame& F) {
    using namespace ssd2; using ssd::mfma16; using ssd::ldfrag;
    char* lds = (char*)(unsigned char*)F.lds;
    const bf16_t* XBC = (const bf16_t*)(F.ws + WS_XBC); const bf16_t* ZS = (const bf16_t*)(F.ws + WS_Z); const float* DT = (const float*)(F.outb + OUT_DT);
    bf16_t* YG = (bf16_t*)(F.ws + WS_Q);
    const float* conv_w = F.a->in[9]; const float* conv_b = F.a->in[10]; const float* a_log = F.a->in[12]; const float* d_skip = F.a->in[13];
    const int tid = F.tid, wid = F.wave, lane = F.lane, fr = lane & 15, fq = lane >> 4;
    const bool stager = tid < 384; const int so = tid % 48, tg = tid / 48, shd = (so >> 3) & 1;
    for (int item = F.bid; item < NB * 8; item += F.G) {
        const int b = item >> 3, g = (item >> 1) & 3, h0 = g * 4 + (item & 1) * 2;
        const float aneg0 = -__expf(a_log[h0]), aneg1 = -__expf(a_log[h0 + 1]), dsk0 = d_skip[h0], dsk1 = d_skip[h0 + 1];
        const int ch0 = so < 16 ? (h0 + shd) * 64 + (so & 7) * 8 : (so < 32 ? 1024 + g * 128 + (so - 16) * 8 : 1536 + g * 128 + (so - 32) * 8);
        float* CWL = (float*)(lds + OFF_CW);
        __syncthreads();
        if (stager) {
#pragma unroll
            for (int j = 0; j < 4; ++j) { *(f32x4*)(CWL + j * 384 + so * 8) = *(const f32x4*)(conv_w + (size_t)j * 2048 + ch0); *(f32x4*)(CWL + j * 384 + so * 8 + 4) = *(const f32x4*)(conv_w + (size_t)j * 2048 + ch0 + 4); }
            *(f32x4*)(CWL + 4 * 384 + so * 8) = *(const f32x4*)(conv_b + ch0); *(f32x4*)(CWL + 4 * 384 + so * 8 + 4) = *(const f32x4*)(conv_b + ch0 + 4);
        }
        f32x4 hst[2][4];
#pragma unroll
        for (int hh = 0; hh < 2; ++hh)
#pragma unroll
            for (int t = 0; t < 4; ++t) hst[hh][t] = (f32x4){0.f, 0.f, 0.f, 0.f};
        for (int i = tid; i < 64 * CS_ST / 4; i += NTHR) { ((unsigned*)(lds + OFF_H0 + H_HS))[i] = 0u; ((unsigned*)(lds + OFF_H0 + H_SZ + H_HS))[i] = 0u; }
        u32x4 raw[11];
        const size_t tokb = (size_t)b * SEQ;
        const bf16_t* xrow = XBC + ((ptrdiff_t)tokb + tg * 8 - 3) * 2048 + ch0;
#define SSD_LOAD(c, xp, tgx) do { if (stager) { _Pragma("unroll") for (int i = 0; i < 11; ++i) { const int t = (c) * 64 + (tgx) * 8 - 3 + i; \
            raw[i] = (t >= 0) ? *(const u32x4*)((xp) + (ptrdiff_t)((c) * 64 + i) * 2048) : (u32x4){0u, 0u, 0u, 0u}; } } } while (0)
        SSD_LOAD(0, xrow, tg);
        f32x2 dtn = *(const f32x2*)(DT + (tokb + lane) * 16 + h0);
        for (int c = 0; c < 32; ++c) {
            int frl = fr, fql = fq, tgl = tg, sol = so; const bf16_t* xrl = xrow; asm volatile("" : "+v"(frl), "+v"(fql), "+v"(tgl), "+v"(sol), "+v"(xrl)); const int shdl = (sol >> 3) & 1;
            const float dtl0 = dtn[0], dtl1 = dtn[1]; if (c + 1 < 32) dtn = *(const f32x2*)(DT + (tokb + (c + 1) * 64 + lane) * 16 + h0);
            u32x2 zpre[2][2];
#pragma unroll
            for (int hh = 0; hh < 2; ++hh)
#pragma unroll
                for (int t2 = 0; t2 < 2; ++t2) { const int tile = 2 * wid + t2, pb = tile >> 2, lb = tile & 3; zpre[hh][t2] = *(const u32x2*)(ZS + (tokb + c * 64 + lb * 16 + frl) * 1024 + (h0 + hh) * 64 + pb * 16 + 4 * fql); }
            float acs0 = dtl0 * aneg0, acs1 = dtl1 * aneg1;
#pragma unroll
            for (int o = 1; o < 64; o <<= 1) { const float t0 = __shfl_up(acs0, o), t1 = __shfl_up(acs1, o); if (lane >= o) { acs0 += t0; acs1 += t1; } }
            const float alast0 = __shfl(acs0, 63), alast1 = __shfl(acs1, 63);
            float wdt[8];
#pragma unroll
            for (int t = 0; t < 8; ++t) { const int sl = (tgl * 8 + t) & 63; const float d0 = __shfl(dtl0, sl), d1 = __shfl(dtl1, sl), a0 = __shfl(acs0, sl), a1 = __shfl(acs1, sl);
                wdt[t] = (shdl ? d1 : d0) * __expf(shdl ? alast1 - a1 : alast0 - a0); }
            if (stager) {
#pragma unroll
                for (int cp = 0; cp < 4; ++cp) {
                    float xin[11][2];
#pragma unroll
                    for (int i = 0; i < 11; ++i) { const unsigned wa = cp == 0 ? raw[i].x : (cp == 1 ? raw[i].y : (cp == 2 ? raw[i].z : raw[i].w)); xin[i][0] = bflo(wa); xin[i][1] = bfhi(wa); }
                    float outv[8][2];
                    { f32x2 cwv[4]; const f32x2 cbq = *(const f32x2*)(CWL + 4 * 384 + sol * 8 + cp * 2);
#pragma unroll
                      for (int j = 0; j < 4; ++j) cwv[j] = *(const f32x2*)(CWL + j * 384 + sol * 8 + cp * 2);
#pragma unroll
                      for (int t = 0; t < 8; ++t)
#pragma unroll
                        for (int e = 0; e < 2; ++e) { float sacc = cbq[e];
#pragma unroll
                            for (int j = 0; j < 4; ++j) sacc += cwv[j][e] * xin[t + j][e];
                            outv[t][e] = silu_f(sacc); } }
                    if (sol < 16) {
                        char* hb = lds + OFF_H0 + shdl * H_SZ;
#pragma unroll
                        for (int e = 0; e < 2; ++e) { const int p = (sol & 7) * 8 + cp * 2 + e;
                            f32x4 x0, x1, w0, w1;
#pragma unroll
                            for (int t = 0; t < 4; ++t) { x0[t] = outv[t][e]; x1[t] = outv[4 + t][e]; w0[t] = x0[t] * wdt[t]; w1[t] = x1[t] * wdt[4 + t]; }
                            *(u32x4*)(hb + H_XS + p * T_ST + tgl * 16) = pack8(x0, x1);
                            *(u32x4*)(hb + H_XW + p * T_ST + tgl * 16) = pack8(w0, w1); }
                    } else {
                        const bool isB = sol < 32; const int n0 = (isB ? (sol - 16) : (sol - 32)) * 8 + cp * 2;
                        char* nat = lds + (isB ? OFF_BS : OFF_CS);
#pragma unroll
                        for (int t = 0; t < 8; ++t) *(unsigned*)(nat + (tgl * 8 + t) * CS_ST + n0 * 2) = cvt_pk_bf16(outv[t][0], outv[t][1]);
                        if (isB) {
#pragma unroll
                            for (int e = 0; e < 2; ++e) { f32x4 a, bq;
#pragma unroll
                                for (int t = 0; t < 4; ++t) { a[t] = outv[t][e]; bq[t] = outv[4 + t][e]; }
                                *(u32x4*)(lds + OFF_BT + (n0 + e) * T_ST + tgl * 16) = pack8(a, bq); }
                        }
                    }
                    SBAR();
                }
            }
            if (c + 1 < 32) SSD_LOAD(c + 1, xrl, tgl);
            __syncthreads();
#pragma unroll
            for (int t2 = 0; t2 < 2; ++t2) {
                const int tile = 2 * wid + t2, sb = tile >> 2, lb = tile & 3;
                f32x4 d = (f32x4){0.f, 0.f, 0.f, 0.f}, m0 = d, m1 = d;
                if (sb <= lb) {
#pragma unroll
                    for (int ks = 0; ks < 4; ++ks) d = mfma16(ldfrag(lds + OFF_BS, CS_ST, sb * 16 + frl, ks * 32 + fql * 8), ldfrag(lds + OFF_CS, CS_ST, lb * 16 + frl, ks * 32 + fql * 8), d);
                    const int l = lb * 16 + frl; const float al0 = __shfl(acs0, l), al1 = __shfl(acs1, l);
#pragma unroll
                    for (int r = 0; r < 4; ++r) { const int sidx = sb * 16 + 4 * fql + r; const float as0 = __shfl(acs0, sidx), as1 = __shfl(acs1, sidx), ds0 = __shfl(dtl0, sidx), ds1 = __shfl(dtl1, sidx);
                        m0[r] = (sidx <= l) ? d[r] * __expf(al0 - as0) * ds0 : 0.f; m1[r] = (sidx <= l) ? d[r] * __expf(al1 - as1) * ds1 : 0.f; }
                }
                u32x2 w; w.x = cvt_pk_bf16(m0[0], m0[1]); w.y = cvt_pk_bf16(m0[2], m0[3]);
                *(u32x2*)(lds + OFF_H0 + H_MT + (lb * 16 + frl) * T_ST + (sb * 16 + 4 * fql) * 2) = w;
                w.x = cvt_pk_bf16(m1[0], m1[1]); w.y = cvt_pk_bf16(m1[2], m1[3]);
                *(u32x2*)(lds + OFF_H0 + H_SZ + H_MT + (lb * 16 + frl) * T_ST + (sb * 16 + 4 * fql) * 2) = w;
            }
            f32x4 yacc[2][2];
#pragma unroll
            for (int hh = 0; hh < 2; ++hh)
#pragma unroll
                for (int t2 = 0; t2 < 2; ++t2) {
                    const int tile = 2 * wid + t2, pb = tile >> 2, lb = tile & 3; const char* hb = lds + OFF_H0 + hh * H_SZ;
                    f32x4 d = (f32x4){0.f, 0.f, 0.f, 0.f};
#pragma unroll
                    for (int ks = 0; ks < 4; ++ks) d = mfma16(ldfrag(hb + H_HS, CS_ST, pb * 16 + frl, ks * 32 + fql * 8), ldfrag(lds + OFF_CS, CS_ST, lb * 16 + frl, ks * 32 + fql * 8), d);
                    const float el = __expf(__shfl(hh ? acs1 : acs0, lb * 16 + frl));
                    yacc[hh][t2] = d * el;
                }
            __syncthreads();
#pragma unroll
            for (int hh = 0; hh < 2; ++hh)
#pragma unroll
                for (int t2 = 0; t2 < 2; ++t2) {
                    const int tile = 2 * wid + t2, pb = tile >> 2, lb = tile & 3; const char* hb = lds + OFF_H0 + hh * H_SZ;
                    f32x4 d = yacc[hh][t2];
#pragma unroll
                    for (int ks = 0; ks < 2; ++ks) d = mfma16(ldfrag(hb + H_XS, T_ST, pb * 16 + frl, ks * 32 + fql * 8), ldfrag(hb + H_MT, T_ST, lb * 16 + frl, ks * 32 + fql * 8), d);
                    const int l = lb * 16 + frl, p0 = pb * 16 + 4 * fql; const size_t tok = tokb + c * 64 + l; const float dsk = hh ? dsk1 : dsk0;
                    const u32x2 zz = zpre[hh][t2];
                    const float z0 = bflo(zz.x), z1 = bfhi(zz.x), z2 = bflo(zz.y), z3 = bfhi(zz.y);
                    float xs[4];
#pragma unroll
                    for (int r = 0; r < 4; ++r) xs[r] = bflo((unsigned)*(const bf16_t*)(hb + H_XS + (p0 + r) * T_ST + l * 2));
                    u32x2 w; w.x = cvt_pk_bf16((d[0] + xs[0] * dsk) * z0, (d[1] + xs[1] * dsk) * z1); w.y = cvt_pk_bf16((d[2] + xs[2] * dsk) * z2, (d[3] + xs[3] * dsk) * z3);
                    *(u32x2*)(YG + tok * 1024 + (h0 + hh) * 64 + p0) = w;
                }
#pragma unroll
            for (int hh = 0; hh < 2; ++hh) { const float dc = __expf(hh ? alast1 : alast0); char* hb = lds + OFF_H0 + hh * H_SZ;
#pragma unroll
                for (int t = 0; t < 4; ++t) { f32x4 d = hst[hh][t] * dc;
#pragma unroll
                    for (int ks = 0; ks < 2; ++ks) d = mfma16(ldfrag(lds + OFF_BT, T_ST, wid * 16 + frl, ks * 32 + fql * 8), ldfrag(hb + H_XW, T_ST, t * 16 + frl, ks * 32 + fql * 8), d);
                    hst[hh][t] = d;
                    u32x2 w; w.x = cvt_pk_bf16(d[0], d[1]); w.y = cvt_pk_bf16(d[2], d[3]);
                    *(u32x2*)(hb + H_HS + (t * 16 + frl) * CS_ST + (wid * 16 + 4 * fql) * 2) = w; } }
            __syncthreads();
        }
#undef SSD_LOAD
    }
}

__device__ __forceinline__ void ph_gnorm(Frame& F) {
    bf16_t* YG = (bf16_t*)(F.ws + WS_Q);
    const int gw = F.bid * NWAVES + F.wave, NGW = F.G * NWAVES;
    for (int m = gw; m < NTOK; m += NGW) {
        u32x2* rp = (u32x2*)(YG + (size_t)m * D) + F.lane;
#pragma unroll
        for (int j = 0; j < 4; ++j) { const u32x2 w = rp[64 * j]; const float a = bflo(w.x), b = bfhi(w.x), c = bflo(w.y), d = bfhi(w.y);
            const float ss = wave_sum(a * a + b * b + c * c + d * d); const float r = 1.f / sqrtf(ss * (1.f / 256.f) + LN_EPS);
            if (PB_FP8) { int pk = 0; pk = __builtin_amdgcn_cvt_pk_fp8_f32(a * r, b * r, pk, false); pk = __builtin_amdgcn_cvt_pk_fp8_f32(c * r, d * r, pk, true); ((unsigned*)(F.outb + OUT_OB8 + (size_t)m * D))[F.lane + 64 * j] = (unsigned)pk; }
            else { u32x2 o; o.x = cvt_pk_bf16(a * r, b * r); o.y = cvt_pk_bf16(c * r, d * r); rp[64 * j] = o; } }
    }
}

template <bool DRY = false> __device__ __forceinline__ void ph_router(Frame& F) {
    float* X1 = (float*)F.outb; bf16_t* U2 = (bf16_t*)(F.ws + WS_U2); const float* MOD = (const float*)(F.ws + WS_MOD);
    const float* ln1g = F.a->in[18]; const float* ln1b = F.a->in[19]; const float* w_router = F.a->in[20]; const float* b_router = F.a->in[21];
    u32x2* REG = (u32x2*)(F.ws + WS_REG); unsigned* CNT = (unsigned*)(F.ws + WS_CTL) + CW_CNT;
    constexpr int TST = 2064;
    LAS unsigned char* THI = F.lds; LAS unsigned char* TLO = F.lds + 16 * TST; LAS float* PART = (LAS float*)(F.lds + 32 * TST);
    LAS unsigned* lcnt = (LAS unsigned*)(F.lds + LDS_AUX); LAS unsigned* lbase = lcnt + 32; LAS unsigned* ent = lcnt + 64;
    const int tid = F.tid, lane = F.lane, wid = F.wave, fr = lane & 15, fq = lane >> 4;
    bf16x8 whi[4][2], wlo[4][2];
#pragma unroll
    for (int ks = 0; ks < 4; ++ks)
#pragma unroll
        for (int ct = 0; ct < 2; ++ct) { float wv[8];
#pragma unroll
            for (int i = 0; i < 8; ++i) wv[i] = w_router[(size_t)(128 * wid + 32 * ks + 8 * fq + i) * 32 + ct * 16 + fr];
            u32x4 h, l2;
#pragma unroll
            for (int i = 0; i < 4; ++i) { const unsigned hp = cvt_pk_bf16(wv[2 * i], wv[2 * i + 1]); const float r0 = wv[2 * i] - bflo(hp), r1 = wv[2 * i + 1] - bfhi(hp); h[i] = hp; l2[i] = cvt_pk_bf16(r0, r1); }
            whi[ks][ct] = __builtin_bit_cast(bf16x8, h); wlo[ks][ct] = __builtin_bit_cast(bf16x8, l2); }
    const float brl = b_router[lane & 31];
    for (int batch = F.bid; batch < NTOK / 256; batch += F.G) {
        const int hf = batch >> 7;
        __syncthreads();
        if (tid < 32) lcnt[tid] = 0u;
        for (int grp = 0; grp < 16; ++grp) {
#pragma unroll
            for (int tt = 0; tt < 2; ++tt) {
                const int tg16 = 2 * wid + tt, m = batch * 256 + grp * 16 + tg16; const float* md = MOD + (size_t)(m >> 11) * 6144;
                f32x4* xr = (f32x4*)(X1 + (size_t)m * D) + lane;
                f32x4 v[4]; float s = 0.f;
#pragma unroll
                for (int j = 0; j < 4; ++j) { v[j] = xr[64 * j]; s += (v[j][0] + v[j][1]) + (v[j][2] + v[j][3]); }
                float mean = wave_sum(s) * (1.f / D), s2 = 0.f;
#pragma unroll
                for (int j = 0; j < 4; ++j) { v[j] = v[j] - mean; s2 += (v[j][0] * v[j][0] + v[j][1] * v[j][1]) + (v[j][2] * v[j][2] + v[j][3] * v[j][3]); }
                float rstd = 1.f / sqrtf(wave_sum(s2) * (1.f / D) + LN_EPS);
                s = 0.f;
#pragma unroll
                for (int j = 0; j < 4; ++j) { const f32x4 g = *((const f32x4*)ln1g + lane + 64 * j), bb = *((const f32x4*)ln1b + lane + 64 * j); v[j] = v[j] * rstd * g + bb; if (!DRY) xr[64 * j] = v[j]; s += (v[j][0] + v[j][1]) + (v[j][2] + v[j][3]); }
                mean = wave_sum(s) * (1.f / D); s2 = 0.f;
#pragma unroll
                for (int j = 0; j < 4; ++j) { v[j] = v[j] - mean; s2 += (v[j][0] * v[j][0] + v[j][1] * v[j][1]) + (v[j][2] * v[j][2] + v[j][3] * v[j][3]); }
                rstd = 1.f / sqrtf(wave_sum(s2) * (1.f / D) + LN_EPS);
                u32x2* o8 = (u32x2*)(U2 + (size_t)m * D) + lane;
#pragma unroll
                for (int j = 0; j < 4; ++j) { const f32x4 sh = *((const f32x4*)(md + 3072) + lane + 64 * j), sc = *((const f32x4*)(md + 4096) + lane + 64 * j);
                    v[j] = v[j] * rstd * (sc + 1.0f) + sh; u32x2 w; w.x = cvt_pk_bf16(v[j][0], v[j][1]); w.y = cvt_pk_bf16(v[j][2], v[j][3]);
                    if (DRY) { if (w.x == 0x12345678u) o8[64 * j] = w; }
                    else if (MOE_FP8) { int pk = 0; pk = __builtin_amdgcn_cvt_pk_fp8_f32(v[j][0], v[j][1], pk, false); pk = __builtin_amdgcn_cvt_pk_fp8_f32(v[j][2], v[j][3], pk, true); ((unsigned*)((unsigned char*)U2 + (size_t)m * D))[lane + 64 * j] = (unsigned)pk; }
                    else o8[64 * j] = w;
                    u32x2 lo; lo.x = cvt_pk_bf16(v[j][0] - bflo(w.x), v[j][1] - bfhi(w.x)); lo.y = cvt_pk_bf16(v[j][2] - bflo(w.y), v[j][3] - bfhi(w.y));
                    *(LAS u32x2*)(THI + tg16 * TST + (4 * lane + 256 * j) * 2) = w; *(LAS u32x2*)(TLO + tg16 * TST + (4 * lane + 256 * j) * 2) = lo; }
            }
            __syncthreads();
            { f32x4 a0 = (f32x4){0.f, 0.f, 0.f, 0.f}, a1 = a0;
#pragma unroll
              for (int ks = 0; ks < 4; ++ks) { const int cb = (128 * wid + 32 * ks + 8 * fq) * 2;
                  const bf16x8 th = *(const LAS bf16x8*)(THI + fr * TST + cb), tl = *(const LAS bf16x8*)(TLO + fr * TST + cb);
                  a0 = __builtin_amdgcn_mfma_f32_16x16x32_bf16(whi[ks][0], th, a0, 0, 0, 0); a1 = __builtin_amdgcn_mfma_f32_16x16x32_bf16(whi[ks][1], th, a1, 0, 0, 0);
                  a0 = __builtin_amdgcn_mfma_f32_16x16x32_bf16(wlo[ks][0], th, a0, 0, 0, 0); a1 = __builtin_amdgcn_mfma_f32_16x16x32_bf16(wlo[ks][1], th, a1, 0, 0, 0);
                  a0 = __builtin_amdgcn_mfma_f32_16x16x32_bf16(whi[ks][0], tl, a0, 0, 0, 0); a1 = __builtin_amdgcn_mfma_f32_16x16x32_bf16(whi[ks][1], tl, a1, 0, 0, 0); }
              *(LAS f32x4*)(PART + (wid * 16 + fr) * 32 + 4 * fq) = a0; *(LAS f32x4*)(PART + (wid * 16 + fr) * 32 + 16 + 4 * fq) = a1; }
            __syncthreads();
            { const int tg16 = 2 * wid + (lane >> 5), tl = grp * 16 + tg16, myexp = lane & 31;
              float logit = brl;
#pragma unroll
              for (int w8 = 0; w8 < 8; ++w8) logit += PART[(w8 * 16 + tg16) * 32 + myexp];
              float tv[4]; int tix[4];
#pragma unroll
              for (int k = 0; k < 4; ++k) { float bv = logit; int bi = myexp;
#pragma unroll
                  for (int o = 1; o < 32; o <<= 1) { const float ov = __shfl_xor(bv, o); const int oi = __shfl_xor(bi, o); if (ov > bv || (ov == bv && oi < bi)) { bv = ov; bi = oi; } }
                  tv[k] = bv; tix[k] = bi; if (myexp == bi) logit = -INFINITY; }
              const float e1 = __expf(tv[1] - tv[0]), e2 = __expf(tv[2] - tv[0]), e3 = __expf(tv[3] - tv[0]); const float inv = 1.f / (1.f + e1 + e2 + e3);
              if (myexp < 4) { const int ee = myexp == 0 ? tix[0] : (myexp == 1 ? tix[1] : (myexp == 2 ? tix[2] : tix[3])); const float gg = (myexp == 0 ? 1.f : (myexp == 1 ? e1 : (myexp == 2 ? e2 : e3))) * inv;
                  const unsigned lp = atomicAdd((unsigned*)&lcnt[ee], 1u);
                  LAS unsigned* en = ent + (tl * 4 + myexp) * 3; en[0] = (unsigned)ee; en[1] = lp; en[2] = __float_as_uint(gg);
                  if (DBG_CHECK == 1) { u32x2 rw; rw.x = (unsigned)ee; rw.y = __float_as_uint(gg); ((u32x2*)(F.ws + WS_DBG))[(size_t)(batch * 256 + tl) * 4 + myexp] = rw; } } }
        }
        __syncthreads();
        if (tid < 32) lbase[tid] = DRY ? 0u : __hip_atomic_fetch_add(CNT + 64 * (hf * 32 + tid), lcnt[tid], __ATOMIC_RELAXED, __HIP_MEMORY_SCOPE_AGENT);
        __syncthreads();
        for (int i = tid; i < 1024; i += NTHR) { const LAS unsigned* en = ent + i * 3; const unsigned ee = en[0], pos = lbase[ee] + en[1];
            const unsigned tokl = (unsigned)(batch * 256 + (i >> 2)) - (unsigned)hf * HALF_TOK;
            u32x2 w; w.x = tokl * 4u + (unsigned)(i & 3); w.y = en[2];
            if (!DRY && pos < (unsigned)REG_CAP) REG[((size_t)hf * 32 + ee) * REG_CAP + pos] = w; }
    }
}

template <bool DRY = false> __device__ __forceinline__ void ph_final(Frame& F, int hf) {
    float* X1 = (float*)F.outb; const bf16_t* YB = (const bf16_t*)(F.ws + WS_YB); const float* MOD = (const float*)(F.ws + WS_MOD);
    const float* g2 = F.a->in[26]; const float* b2 = F.a->in[27];
    const int gw = F.bid * NWAVES + F.wave, NGW = F.G * NWAVES, lane = F.lane;
    constexpr int RB = 2;
    for (int tl0 = gw; tl0 < HALF_TOK; tl0 += NGW * RB) {
        f32x4 xv[RB][4]; u32x2 yw[RB][4][4];
#pragma unroll
        for (int r = 0; r < RB; ++r) { const int tl = tl0 + r * NGW, m = hf * HALF_TOK + tl;
            const f32x4* xr = (const f32x4*)(X1 + (size_t)m * D) + lane; const u32x2* yr = (const u32x2*)(YB + (size_t)tl * 4 * D) + lane;
#pragma unroll
            for (int j = 0; j < 4; ++j) { xv[r][j] = xr[64 * j];
#pragma unroll
                for (int k = 0; k < 4; ++k) yw[r][j][k] = yr[k * 256 + 64 * j]; } }
#pragma unroll
        for (int r = 0; r < RB; ++r) { const int tl = tl0 + r * NGW, m = hf * HALF_TOK + tl; const float* md = MOD + (size_t)(m >> 11) * 6144 + 5120;
            f32x4* xr = (f32x4*)(X1 + (size_t)m * D) + lane;
            f32x4 v[4]; float s = 0.f;
#pragma unroll
            for (int j = 0; j < 4; ++j) { f32x4 y = (f32x4){0.f, 0.f, 0.f, 0.f};
#pragma unroll
                for (int k = 0; k < 4; ++k) { const u32x2 w = yw[r][j][k]; y[0] += bflo(w.x); y[1] += bfhi(w.x); y[2] += bflo(w.y); y[3] += bfhi(w.y); }
                if (DBG_NO_MOE) y = (f32x4){0.f, 0.f, 0.f, 0.f};
                const f32x4 gt = *((const f32x4*)md + lane + 64 * j);
                v[j] = xv[r][j] * DN_ALPHA + gt * y; s += (v[j][0] + v[j][1]) + (v[j][2] + v[j][3]); }
            const float mean = wave_sum(s) * (1.f / D); float s2 = 0.f;
#pragma unroll
            for (int j = 0; j < 4; ++j) { v[j] = v[j] - mean; s2 += (v[j][0] * v[j][0] + v[j][1] * v[j][1]) + (v[j][2] * v[j][2] + v[j][3] * v[j][3]); }
            const float rstd = 1.f / sqrtf(wave_sum(s2) * (1.f / D) + LN_EPS);
#pragma unroll
            for (int j = 0; j < 4; ++j) { const f32x4 g = *((const f32x4*)g2 + lane + 64 * j), bb = *((const f32x4*)b2 + lane + 64 * j); const f32x4 ov = v[j] * rstd * g + bb; if (!DRY || ov[0] == 1.2345e-33f) xr[64 * j] = ov; } }
    }
}

__device__ __forceinline__ float block_sum(Frame& F, float v, LAS float* red) {
    v = wave_sum(v); __syncthreads(); if (F.lane == 0) red[F.wave] = v; __syncthreads();
    float s = 0.f; for (int w = 0; w < NWAVES; ++w) s += red[w]; return s;
}
__device__ __forceinline__ float block_max(Frame& F, float v, LAS float* red) {
#pragma unroll
    for (int o = 1; o < 64; o <<= 1) v = fmaxf(v, __shfl_xor(v, o));
    __syncthreads(); if (F.lane == 0) red[F.wave] = v; __syncthreads();
    float s = 0.f; for (int w = 0; w < NWAVES; ++w) s = fmaxf(s, red[w]); return s;
}
__device__ __forceinline__ void dbg_report(Frame& F, float e) { if (F.tid == 0) atomicMax((unsigned*)(F.ws + WS_CTL) + CW_DBG, __float_as_uint(e)); }
__device__ __forceinline__ void dbg_check_moe(Frame& F) {
    if (F.bid >= 64) return;
    const int tok = HALF_TOK + 509 * F.bid + 3, tokl = tok - HALF_TOK, tid = F.tid;
    LAS float* u2 = (LAS float*)F.lds; LAS float* act = u2 + 1024; LAS float* red = act + 1024; LAS float* lg = red + 16;
    const bf16_t* U2 = (const bf16_t*)(F.ws + WS_U2); const bf16_t* YB = (const bf16_t*)(F.ws + WS_YB); const u32x2* RT = (const u32x2*)(F.ws + WS_DBG);
    const float* w1 = F.a->in[22]; const float* b1 = F.a->in[23]; const float* w2 = F.a->in[24]; const float* b2 = F.a->in[25];
    __syncthreads();
    for (int i = tid; i < 1024; i += NTHR) u2[i] = bflo((unsigned)U2[(size_t)tok * 1024 + i]);
    __syncthreads();
    float y0 = 0.f, y1 = 0.f;
    for (int k = 0; k < 4; ++k) {
        const u32x2 rw = RT[(size_t)tok * 4 + k]; const int e = (int)rw.x; const float g = __uint_as_float(rw.y);
        const float* W1 = w1 + (size_t)e * 1024 * 2048; const float* W2 = w2 + (size_t)e * 1024 * 1024;
        float h0 = b1[e * 2048 + tid], h1 = b1[e * 2048 + tid + 512], h2 = b1[e * 2048 + tid + 1024], h3 = b1[e * 2048 + tid + 1536];
        for (int c = 0; c < 1024; ++c) { const float uu = u2[c]; const float* wr = W1 + (size_t)c * 2048 + tid; h0 += uu * wr[0]; h1 += uu * wr[512]; h2 += uu * wr[1024]; h3 += uu * wr[1536]; }
        __syncthreads();
        { float gg = fminf(h0, 7.f), up = fminf(fmaxf(h2, -7.f), 7.f); act[tid] = (up + 1.f) * gg / (1.f + expf(-1.702f * gg));
          gg = fminf(h1, 7.f); up = fminf(fmaxf(h3, -7.f), 7.f); act[tid + 512] = (up + 1.f) * gg / (1.f + expf(-1.702f * gg)); }
        __syncthreads();
        float a0 = b2[e * 1024 + tid], a1 = b2[e * 1024 + tid + 512];
        for (int j = 0; j < 1024; ++j) { const float aa = act[j]; a0 += aa * W2[(size_t)j * 1024 + tid]; a1 += aa * W2[(size_t)j * 1024 + tid + 512]; }
        y0 += g * a0; y1 += g * a1;
    }
    float f0 = 0.f, f1 = 0.f;
    for (int k = 0; k < 4; ++k) { f0 += bflo((unsigned)YB[((size_t)tokl * 4 + k) * 1024 + tid]); f1 += bflo((unsigned)YB[((size_t)tokl * 4 + k) * 1024 + tid + 512]); }
    const float rms = sqrtf(block_sum(F, y0 * y0 + y1 * y1, red) * (1.f / 1024.f)) + 1e-20f;
    float err = block_max(F, fmaxf(fabsf(y0 - f0), fabsf(y1 - f1)), red) / rms;
    { const float* X1 = (const float*)F.outb + (size_t)tok * 1024; const float* md = (const float*)(F.ws + WS_MOD) + (size_t)(tok >> 11) * 6144;
      const float xa = X1[tid], xb = X1[tid + 512]; const float mean = block_sum(F, xa + xb, red) * (1.f / 1024.f);
      const float da = xa - mean, db = xb - mean; const float var = block_sum(F, da * da + db * db, red) * (1.f / 1024.f); const float rstd = 1.f / sqrtf(var + LN_EPS);
      __syncthreads();
      u2[tid] = da * rstd * (1.f + md[4096 + tid]) + md[3072 + tid]; u2[tid + 512] = db * rstd * (1.f + md[4096 + tid + 512]) + md[3072 + tid + 512];
      __syncthreads();
      if (tid < 32) { float a = F.a->in[21][tid]; for (int c = 0; c < 1024; ++c) a += u2[c] * F.a->in[20][c * 32 + tid]; lg[tid] = a; }
      __syncthreads();
      if (tid == 0) { unsigned want = 0u, got = 0u; float l2[32]; for (int i = 0; i < 32; ++i) l2[i] = lg[i];
          for (int k = 0; k < 4; ++k) { int bi = 0; for (int i = 1; i < 32; ++i) if (l2[i] > l2[bi]) bi = i; want |= 1u << bi; l2[bi] = -INFINITY; got |= 1u << RT[(size_t)tok * 4 + k].x; }
          lg[32] = (want != got) ? 1.f : 0.f; }
      __syncthreads();
      if (lg[32] != 0.f) err = 50.f; }
    dbg_report(F, err);
}
__device__ __forceinline__ void dbg_check_ssd(Frame& F) {
    if (F.bid >= 2) return;
    const int b = F.bid ? 20 : 5, h = F.bid ? 14 : 3, g = h >> 2, tid = F.tid, p = tid >> 3, ng = tid & 7;
    LAS float* red = (LAS float*)F.lds; LAS float* cv = red + 16;
    const bf16_t* XBC = (const bf16_t*)(F.ws + WS_XBC); const bf16_t* ZS = (const bf16_t*)(F.ws + WS_Z); const float* DT = (const float*)(F.outb + OUT_DT); const bf16_t* YG = (const bf16_t*)(F.ws + WS_Q);
    const float* cw = F.a->in[9]; const float* cb = F.a->in[10]; const float aneg = -expf(F.a->in[12][h]), dsk = F.a->in[13][h];
    const int mych = tid < 64 ? h * 64 + tid : (tid < 192 ? 1024 + g * 128 + (tid - 64) : 1536 + g * 128 + (tid - 192));
    float w0 = 0.f, w1 = 0.f, w2 = 0.f, w3 = 0.f, wb = 0.f;
    if (tid < 320) { w0 = cw[0 * 2048 + mych]; w1 = cw[1 * 2048 + mych]; w2 = cw[2 * 2048 + mych]; w3 = cw[3 * 2048 + mych]; wb = cb[mych]; }
    float x0 = 0.f, x1 = 0.f, x2 = 0.f;
    float hs[16];
#pragma unroll
    for (int i = 0; i < 16; ++i) hs[i] = 0.f;
    float emax = 0.f, ssq = 0.f, nbad = 0.f; int tmax = 0;
    for (int t = 0; t < SEQ; ++t) {
        const size_t tok = (size_t)b * SEQ + t;
        __syncthreads();
        if (DBG_HYP == 1 && (t & 63) == 0) { x0 = 0.f; x1 = 0.f; x2 = 0.f; }
        if (tid < 320) { const float x3 = bflo((unsigned)XBC[tok * 2048 + mych]); const float s = wb + w0 * x0 + w1 * x1 + w2 * x2 + w3 * x3; cv[tid] = s / (1.f + expf(-s)); x0 = x1; x1 = x2; x2 = x3; }
        __syncthreads();
        const float xv = cv[p], dt = DT[tok * 16 + h], dec = expf(dt * aneg);
        float yp = 0.f;
#pragma unroll
        for (int i = 0; i < 16; ++i) { const int n = ng * 16 + i; hs[i] = hs[i] * dec + dt * xv * cv[64 + n]; yp += cv[192 + n] * hs[i]; }
        yp += __shfl_xor(yp, 1); yp += __shfl_xor(yp, 2); yp += __shfl_xor(yp, 4);
        const float yv = (yp + xv * dsk) * bflo((unsigned)ZS[tok * 1024 + h * 64 + p]);
        const float yf = bflo((unsigned)YG[tok * 1024 + h * 64 + p]);
        if (ng == 0) { const float er = fabsf(yv - yf); if (er > emax) { emax = er; tmax = t; } ssq += yv * yv; if (er > 0.25f && (DBG_SUB < 5 || (DBG_SUB == 5 && (t & 63) == 0) || (DBG_SUB == 6 && (t & 63) == 1) || (DBG_SUB == 7 && (t & 63) == 32))) nbad += 1.f; }
    }
    const float rms = sqrtf(block_sum(F, ssq, red) / (64.f * SEQ)) + 1e-20f;
    const float M = block_max(F, emax, red);
    if (DBG_SUB == 0) dbg_report(F, M / rms);
    else if (DBG_SUB == 1) dbg_report(F, block_sum(F, nbad, red) / (64.f * SEQ));
    else if (DBG_SUB >= 5) dbg_report(F, block_sum(F, nbad, red) / (64.f * 32.f));
    else { __syncthreads(); if (ng == 0 && emax == M) red[12] = (float)(DBG_SUB == 2 ? ((tmax & 63) >> 1) : (DBG_SUB == 3 ? (tmax >> 6) : (p >> 1))); __syncthreads();
        if (F.bid == 0) dbg_report(F, powf(10.f, 2.f * (0.05f + 0.05f * red[12]) - 4.f)); }
}
__device__ __forceinline__ void dbg_check_attn(Frame& F) {
    if (F.bid >= 32) return;
    const int b = (F.bid * 7 + 3) & 31, pos = 300 + F.bid * 53, nadm = ((pos >> 6) + 1) * 64, tid = F.tid, lane = F.lane, hd = F.wave;
    const size_t tq = (size_t)b * SEQ + pos;
    LAS float* sc = (LAS float*)F.lds; LAS unsigned char* sel = (LAS unsigned char*)(sc + 2048); LAS float* lgt = (LAS float*)(sel + 2048); LAS float* red = lgt + 8 * 2048; LAS float* misc = red + 16;
    const bf16_t* IQ = (const bf16_t*)(F.outb + OUT_IQ); const bf16_t* IK = (const bf16_t*)(F.outb + OUT_IK); const float* IW = (const float*)(F.outb + OUT_IW);
    const bf16_t* Q = (const bf16_t*)(F.ws + WS_Q); const bf16_t* KV = (const bf16_t*)(F.outb + OUT_KV); const bf16_t* OA = (const bf16_t*)(F.outb + OUT_OA); const u64* MASK = (const u64*)(F.outb + OUT_MASK);
    __syncthreads();
    for (int k = tid; k < nadm; k += NTHR) { float s = 0.f;
        for (int hh = 0; hh < 8; ++hh) { float d = 0.f; for (int c = 0; c < 64; ++c) d += bflo((unsigned)IQ[tq * 512 + hh * 64 + c]) * bflo((unsigned)IK[((size_t)b * SEQ + k) * 64 + c]); s += fmaxf(d, 0.f) * IW[tq * 8 + hh]; }
        sc[k] = s + 0.0f; }
    __syncthreads();
    float nbad = 0.f;
    for (int k = tid; k < nadm; k += NTHR) { const float s = sc[k]; int rank = 0; for (int j = 0; j < nadm; ++j) { const float t = sc[j]; rank += (t > s || (t == s && j < k)) ? 1 : 0; }
        const unsigned char se = rank < 256 ? 1 : 0; sel[k] = se; const unsigned mb = (unsigned)((MASK[tq * 32 + (k >> 6)] >> (k & 63)) & 1ull); if (mb != se) nbad += 1.f; }
    __syncthreads();
    const float nbad_t = block_sum(F, nbad, red);
    LAS float* lw = lgt + hd * 2048; float mx = -INFINITY;
    for (int k = lane; k < nadm; k += 64) { float l = -INFINITY;
        if (sel[k]) { float d = 0.f; for (int c = 0; c < 128; ++c) d += bflo((unsigned)Q[tq * 1024 + hd * 128 + c]) * bflo((unsigned)KV[((size_t)b * SEQ + k) * 128 + c]);
            const int rel = k - pos, n = rel < 0 ? -rel : rel; const float nf = (float)(n > 1 ? n : 1); int large = 8 + (int)(logf(nf / 8.0f) / 2.7725887f * 8.0f); if (large > 15) large = 15;
            const int bucket = (rel > 0 ? 16 : 0) + (n < 8 ? n : large);
            l = d * 0.088388347648318440f + F.a->in[8][bucket * 8 + hd]; }
        lw[k] = l; mx = fmaxf(mx, l); }
#pragma unroll
    for (int o = 1; o < 64; o <<= 1) mx = fmaxf(mx, __shfl_xor(mx, o));
    float den = 0.f;
    for (int k = lane; k < nadm; k += 64) { const float pp = expf(lw[k] - mx); lw[k] = pp; den += pp; }
    den = wave_sum(den);
    float emax = 0.f, ssq = 0.f;
    for (int c2 = 0; c2 < 2; ++c2) { const int c = lane + 64 * c2; float o = 0.f; for (int k = 0; k < nadm; ++k) { const float pp = lw[k]; if (pp != 0.f) o += pp * bflo((unsigned)KV[((size_t)b * SEQ + k) * 128 + c]); }
        o /= den; const float of = bflo((unsigned)OA[tq * 1024 + hd * 128 + c]); emax = fmaxf(emax, fabsf(o - of)); ssq += o * o; }
    const float rms = sqrtf(block_sum(F, ssq, red) * (1.f / 1024.f)) + 1e-20f;
    float err = block_max(F, emax, red) / rms;
    (void)misc;
    if (nbad_t > 0.f) err = 10.f + nbad_t;
    dbg_report(F, err);
}
__device__ __forceinline__ void dbg_emit(Frame& F) {
    float* out = (float*)F.outb;
    for (size_t i = (size_t)F.bid * NTHR + F.tid; i < (size_t)NTOK * D / 4; i += (size_t)F.G * NTHR) ((f32x4*)out)[i] = (f32x4){0.f, 0.f, 0.f, 0.f};
    __syncthreads();
    if (F.bid == 0 && F.tid == 0) { const float e = __uint_as_float(__hip_atomic_load((unsigned*)(F.ws + WS_CTL) + CW_DBG, __ATOMIC_RELAXED, __HIP_MEMORY_SCOPE_AGENT));
        float code = (log10f(fmaxf(e, 1e-30f)) + 4.f) * 0.5f; code = fminf(fmaxf(rintf(code * 20.f) * 0.05f, 0.05f), 3.0f);
        out[0] = sqrtf(67108864.f * 1.01f * (powf(10.f, code) - 1.f)); }
}

constexpr int NPHASE = 17;
__global__ void __launch_bounds__(NTHR, 2) fwd(Args args) {
    extern __shared__ __attribute__((aligned(16))) unsigned char lds_raw[];
    Frame F;
    F.lds = (LAS unsigned char*)lds_raw;
    F.tid = threadIdx.x; F.lane = F.tid & 63; F.wave = __builtin_amdgcn_readfirstlane(F.tid >> 6); F.G = gridDim.x; F.bid = blockIdx.x;
    F.a = &args;
    F.ws = args.ws; F.outb = (unsigned char*)args.out;
    volatile LAS unsigned* MISCW = (volatile LAS unsigned*)(F.lds + LDS_MISC);
    if (F.tid < 64) MISCW[F.tid] = 0u;
    __syncthreads();
    XcdBarrier bar; bar.bar = (unsigned*)(F.ws + WS_CTL) + CW_BAR; bar.x = 0; bar.st = nullptr;
#if MK_ONE
    bar = xcd_barrier_post((unsigned*)(F.ws + WS_CTL) + CW_BAR, MISCW + 8);
#define GRID_BAR() xcd_barrier(bar)
#else
#define GRID_BAR() do { } while (0)
#endif
    const int lo = args.ph_lo, hi = args.ph_hi;
#ifndef PHM
#define PHM (0xFFFFFFFFu & ~(DBG_NO_ATTN ? 0x30u : 0u) & ~(DBG_NO_SSD ? 0xC0u : 0u))
#endif
#define IN(k) (((PHM >> (k)) & 1u) && lo <= (k) && (k) < hi)
#define SEAM(k) do { if ((k) + 1 < hi) GRID_BAR(); } while (0)

    if (IN(0)) { ph_prologue(F); if (DBG_TWICE & 1u) { GRID_BAR(); ph_prologue(F); } SEAM(0); }
    if (IN(1)) { ph_ln1(F); if (DBG_TWICE & 2u) { GRID_BAR(); ph_ln1(F); } SEAM(1); }
    if (IN(2)) {
        EpiProj E{(bf16_t*)(F.ws + WS_Q), (bf16_t*)(F.outb + OUT_IQ), (bf16_t*)(F.ws + WS_Z), (bf16_t*)(F.ws + WS_XBC), (bf16_t*)(F.ws + WS_GA), (bf16_t*)(F.ws + WS_GB), (float*)(F.outb + OUT_MISC), 1.0f};
#if PROJ_FP8
        { SchedProj<2> S; S.o.init(NTOK, 12 * 256, F.G, F.bid); S.A = (const char*)(F.ws + WS_U8); S.Bt = (const char*)(F.ws + WS_WIN8);
          EpiProj E8 = E; E8.sc = MOE_INV;
          pg8::gemm_phase<EpiProj, SchedProj<2>, false, 512, true>(F.lds, S, E8);
          if (DBG_TWICE & 32768u) { GRID_BAR(); pg8::gemm_phase<EpiProj, SchedProj<2>, false, 512, true>(F.lds, S, E8); } }
        { SchedProj<1> S; S.o.init(NTOK, 15 * 256, F.G, F.bid); S.A = (const char*)(F.outb + OUT_U); S.Bt = (const char*)(F.ws + WS_WIN);
          pg8::gemm_phase<EpiProj, SchedProj<1>, false>(F.lds, S, E);
          if (DBG_TWICE & 4u) { GRID_BAR(); pg8::gemm_phase<EpiProj, SchedProj<1>, false>(F.lds, S, E); } }
#else
        { SchedProj<0> S; S.o.init(NTOK, NPROJ, F.G, F.bid); S.A = (const char*)(F.outb + OUT_U); S.Bt = (const char*)(F.ws + WS_WIN);
          pg8::gemm_phase<EpiProj, SchedProj<0>, false>(F.lds, S, E);
          if (DBG_TWICE & 4u) { GRID_BAR(); pg8::gemm_phase<EpiProj, SchedProj<0>, false>(F.lds, S, E); } }
#endif
        SEAM(2);
    }
    if (IN(3)) { ph_misc(F); if (DBG_TWICE & 8u) { GRID_BAR(); ph_misc(F); } SEAM(3); }
    if (IN(4)) { ph_index(F); if (DBG_TWICE & 16u) { GRID_BAR(); ph_index(F); } SEAM(4); }
    if (IN(5)) { ph_attn(F); if (DBG_TWICE & 32u) { GRID_BAR(); ph_attn(F); } SEAM(5); if (DBG_CHECK == 3) { dbg_check_attn(F); GRID_BAR(); } }
    if (IN(6)) { ph_ssd2(F); if (DBG_TWICE & 64u) { GRID_BAR(); ph_ssd2(F); } SEAM(6); if (DBG_CHECK == 2) { dbg_check_ssd(F); GRID_BAR(); } }
    if (IN(7)) { ph_gnorm(F); if (DBG_TWICE & 128u) { GRID_BAR(); ph_gnorm(F); } SEAM(7); }
    if (IN(8)) {
#if PA_FP8
        SchedPlainT<1024> S; S.o.init(NTOK, 1024, F.G, F.bid); S.A = (const char*)(F.outb + OUT_OA); S.Bt = (const char*)(F.ws + WS_WPA8);
        EpiGate<0> E{(const bf16_t*)(F.ws + WS_GA), nullptr, (bf16_t*)(F.ws + WS_Z), MOE_INV};
        pg8::gemm_phase<EpiGate<0>, SchedPlainT<1024>, false, 512, true>(F.lds, S, E);
#else
        SchedPlain S; S.o.init(NTOK, 1024, F.G, F.bid); S.A = (const char*)(F.outb + OUT_OA); S.Bt = (const char*)(F.ws + WS_WPA);
        EpiGate<0> E{(const bf16_t*)(F.ws + WS_GA), nullptr, (bf16_t*)(F.ws + WS_Z), 1.0f};
        pg8::gemm_phase<EpiGate<0>, SchedPlain, false>(F.lds, S, E);
#endif
    }
    if (IN(9)) {
#if PB_FP8
        SchedPlainT<1024> S; S.o.init(NTOK, 1024, F.G, F.bid); S.A = (const char*)(F.outb + OUT_OB8); S.Bt = (const char*)(F.ws + WS_WPB8);
        EpiGate<1> E{(const bf16_t*)(F.ws + WS_GB), (const bf16_t*)(F.ws + WS_Z), (bf16_t*)(F.ws + WS_XBC), MOE_INV};
        pg8::gemm_phase<EpiGate<1>, SchedPlainT<1024>, false, 512, true>(F.lds, S, E);
#else
        SchedPlain S; S.o.init(NTOK, 1024, F.G, F.bid); S.A = (const char*)(F.ws + WS_Q); S.Bt = (const char*)(F.ws + WS_WPB);
        EpiGate<1> E{(const bf16_t*)(F.ws + WS_GB), (const bf16_t*)(F.ws + WS_Z), (bf16_t*)(F.ws + WS_XBC), 1.0f};
        pg8::gemm_phase<EpiGate<1>, SchedPlain, false>(F.lds, S, E);
#endif
        SEAM(9);
    }
    if (IN(10)) {
        SchedPlain S; S.o.init(NTOK, 1024, F.G, F.bid); S.A = (const char*)(F.ws + WS_XBC); S.Bt = (const char*)(F.ws + WS_WOUT);
        EpiOut E{F.a->in[0], (const float*)(F.ws + WS_MOD), (float*)F.outb};
        pg8::gemm_phase<EpiOut, SchedPlain, false>(F.lds, S, E);
        if (DBG_TWICE & 1024u) { GRID_BAR(); pg8::gemm_phase<EpiOut, SchedPlain, false>(F.lds, S, E); }
        SEAM(10);
    }
    if (IN(11)) { if (DBG_TWICE & 2048u) { ph_router<true>(F); GRID_BAR(); } ph_router<false>(F); SEAM(11); }
#pragma unroll
    for (int hf = 0; hf < 2; ++hf) {
        const int p0 = 12 + hf * 2;
        if (IN(p0)) {
            if (hf == 1) ph_final<false>(F, 0);
            MoeTab T = moe_tables(F, hf);
            SchedMoe<8, true> S{T, F.G, F.bid, hf, (const char*)(F.ws + WS_U2), (const char*)(F.ws + WS_W1), (const u32x2*)(F.ws + WS_REG)};
            EpiMoe1 E{F.a->in[23], (bf16_t*)(F.ws + WS_ACT), 0};
            pg8::gemm_phase<EpiMoe1, SchedMoe<8, true>, true, MOE_RB / 2, MOE_FP8 != 0>(F.lds, S, E);
            if ((DBG_TWICE & 4096u) && hf == 0) { GRID_BAR(); pg8::gemm_phase<EpiMoe1, SchedMoe<8, true>, true, MOE_RB / 2, MOE_FP8 != 0>(F.lds, S, E); }
            if ((DBG_TWICE & 16384u) && hf == 0) { GRID_BAR(); EpiMoe1 Ed = E; Ed.dry = 1; pg8::gemm_phase<EpiMoe1, SchedMoe<8, true>, true, MOE_RB / 2, MOE_FP8 != 0>(F.lds, S, Ed); }
            SEAM(p0);
        }
        if (IN(p0 + 1)) {
            MoeTab T = moe_tables(F, hf);
            SchedMoe<4, false> S{T, F.G, F.bid, hf, (const char*)(F.ws + WS_ACT), (const char*)(F.ws + WS_W2), (const u32x2*)(F.ws + WS_REG)};
            EpiMoe2 E{F.a->in[25], (bf16_t*)(F.ws + WS_YB), (const u32x2*)(F.ws + WS_REG), T, hf, 0};
            if ((DBG_TWICE & 262144u) && hf == 0) { EpiMoe2 Ed = E; Ed.dry = DBG_DRYMODE; pg8::gemm_phase<EpiMoe2, SchedMoe<4, false>, false, MOE_RB / 2, MOE_FP8 != 0>(F.lds, S, Ed); GRID_BAR(); }
            pg8::gemm_phase<EpiMoe2, SchedMoe<4, false>, false, MOE_RB / 2, MOE_FP8 != 0>(F.lds, S, E);
            if ((DBG_TWICE & 8192u) && hf == 0) { GRID_BAR(); pg8::gemm_phase<EpiMoe2, SchedMoe<4, false>, false, MOE_RB / 2, MOE_FP8 != 0>(F.lds, S, E); }
            if ((DBG_TWICE & 131072u) && hf == 0) { GRID_BAR(); EpiMoe2 Ed = E; Ed.dry = 1; pg8::gemm_phase<EpiMoe2, SchedMoe<4, false>, false, MOE_RB / 2, MOE_FP8 != 0>(F.lds, S, Ed); }
            SEAM(p0 + 1);
            if (DBG_CHECK == 1 && hf == 1) { dbg_check_moe(F); GRID_BAR(); }
        }
    }
    if (IN(16)) { if (DBG_TWICE & 65536u) { ph_final<true>(F, 1); GRID_BAR(); } ph_final(F, 1); }
    if (DBG_CHECK) { GRID_BAR(); dbg_emit(F); }
#undef IN
#undef SEAM
}

extern "C" void kernel_launch(void* const* d_in, const int* in_sizes, int n_in, void* d_out, int out_size, void* d_ws, size_t ws_size, hipStream_t stream) {
    static int grid = 0;
    if (grid == 0) {
        if (n_in != 28 || in_sizes[0] != NTOK * D || out_size != NTOK * D || ws_size < WS_END) { fprintf(stderr, "kernel_launch: shape mismatch (n_in %d, in0 %d, out %d, ws %zu)\n", n_in, n_in > 0 ? in_sizes[0] : -1, out_size, ws_size); grid = -1; return; }
        int dev = 0, cus = 0, per_cu = 0;
        if (hipGetDevice(&dev) != hipSuccess || hipDeviceGetAttribute(&cus, hipDeviceAttributeMultiprocessorCount, dev) != hipSuccess) { grid = -1; return; }
        if (hipFuncSetAttribute((const void*)fwd, hipFuncAttributeMaxDynamicSharedMemorySize, LDS_BYTES) != hipSuccess) { fprintf(stderr, "kernel_launch: hipFuncSetAttribute failed\n"); grid = -1; return; }
        if (hipOccupancyMaxActiveBlocksPerMultiprocessor(&per_cu, (const void*)fwd, NTHR, LDS_BYTES) != hipSuccess || per_cu < 1) fprintf(stderr, "kernel_launch: occupancy query reports %d\n", per_cu);
        (void)hipGetLastError();
        grid = cus;
    }
    if (grid < 0) return;
    if (hipMemsetAsync((char*)d_ws + WS_CTL, 0, CTL_ZERO_BYTES, stream) != hipSuccess) { fprintf(stderr, "kernel_launch: memset failed\n"); return; }
    Args a{};
    for (int i = 0; i < 28; ++i) a.in[i] = (const float*)d_in[i];
    a.out = (float*)d_out; a.ws = (unsigned char*)d_ws;
    const int nph = NPHASE < MK_PH_HI ? NPHASE : MK_PH_HI;
#if MK_ONE
    a.ph_lo = 0; a.ph_hi = nph;
    hipLaunchKernelGGL(fwd, dim3(grid), dim3(NTHR), LDS_BYTES, stream, a);
#else
    for (int p = 0; p < nph; ++p) { a.ph_lo = p; a.ph_hi = p + 1; hipLaunchKernelGGL(fwd, dim3(grid), dim3(NTHR), LDS_BYTES, stream, a); }
#endif
    const hipError_t le = hipPeekAtLastError();
    if (le != hipSuccess) fprintf(stderr, "kernel_launch: launch failed: %s\n", hipGetErrorName(le));
}
```

```cpp
#include <hip/hip_runtime.h>
#include <cstdio>
#include <cstdint>

#ifndef MK_ONE
#define MK_ONE 1
#endif
#ifndef DBG_NO_ATTN
#define DBG_NO_ATTN 0
#endif
#ifndef DBG_ATTN_ZERO
#define DBG_ATTN_ZERO 0
#endif
#ifndef DBG_IQ_TRUNC
#define DBG_IQ_TRUNC 0
#endif
#ifndef DBG_ROUTER_BF16
#define DBG_ROUTER_BF16 0
#endif
#ifndef DBG_CHECK
#define DBG_CHECK 0
#endif
#ifndef DBG_SKIP_BODY
#define DBG_SKIP_BODY 0
#endif
#ifndef DBG_SUB
#define DBG_SUB 0
#endif
#ifndef DBG_SSD_SYNC
#define DBG_SSD_SYNC 0
#endif
#ifndef DBG_HYP
#define DBG_HYP 0
#endif
#ifndef DBG_TWICE
#define DBG_TWICE 0u
#endif
#ifndef DBG_DRYMODE
#define DBG_DRYMODE 2
#endif
#ifndef DBG_NO_SSD
#define DBG_NO_SSD 0
#endif
#ifndef DBG_NO_MOE
#define DBG_NO_MOE 0
#endif
#ifndef MOE_FP8
#define MOE_FP8 1
#endif
#ifndef PROJ_FP8
#define PROJ_FP8 1
#endif
#ifndef PA_FP8
#define PA_FP8 1
#endif
#ifndef PB_FP8
#define PB_FP8 0
#endif
#ifndef ATT2
#define ATT2 1
#endif
#ifndef MK_PH_HI
#define MK_PH_HI 99
#endif

#define LAS __attribute__((address_space(3)))
#define GAS __attribute__((address_space(1)))
typedef unsigned short bf16_t;
typedef short bf16x8 __attribute__((ext_vector_type(8)));
typedef short s16x4 __attribute__((ext_vector_type(4)));
typedef float f32x2 __attribute__((ext_vector_type(2)));
typedef float f32x4 __attribute__((ext_vector_type(4)));
typedef float f32x16 __attribute__((ext_vector_type(16)));
typedef unsigned u32x2 __attribute__((ext_vector_type(2)));
typedef unsigned u32x4 __attribute__((ext_vector_type(4)));
typedef unsigned long long u64;

constexpr int NB = 32, SEQ = 2048, D = 1024, NTOK = NB * SEQ;
constexpr int NWAVES = 8, NTHR = 512;
constexpr int NPROJ = 6912;
constexpr int NEXP = 32, HALF_TOK = NTOK / 2, REG_CAP = HALF_TOK;
constexpr int ACT_ROWS = HALF_TOK * 4 + NEXP * 256;
constexpr float LN_EPS = 1e-5f;
constexpr float DN_ALPHA = 1.189207115002721f;
constexpr float LOG2E = 1.4426950408889634f;

constexpr size_t MiB = 1u << 20;
constexpr size_t WS_CTL = 0, CTL_ZERO_BYTES = 1 * MiB;
constexpr size_t WS_MOD = 1 * MiB;
constexpr size_t WS_BIAST = 1 * MiB + 800 * 1024;
constexpr size_t WS_WIN = 2 * MiB;
constexpr size_t WS_WPA = 16 * MiB, WS_WPB = 18 * MiB, WS_WOUT = 20 * MiB;
constexpr size_t WS_W1 = 24 * MiB;
constexpr size_t WS_U8 = 88 * MiB;
constexpr size_t WS_W2 = 152 * MiB;
constexpr size_t WS_WIN8 = 184 * MiB;
constexpr size_t WS_WPA8 = 192 * MiB;
constexpr size_t WS_WPB8 = 194 * MiB;
constexpr size_t OUT_OB8 = 192 * MiB;
constexpr size_t WS_Q = 216 * MiB;
constexpr size_t WS_Z = 344 * MiB;
constexpr size_t WS_XBC = 472 * MiB;
constexpr size_t WS_GA = 728 * MiB, WS_GB = 856 * MiB;
constexpr size_t WS_U2 = 216 * MiB;
constexpr size_t WS_REG = 344 * MiB;
constexpr size_t WS_ACT = 360 * MiB;
constexpr size_t WS_YB = 632 * MiB;
constexpr size_t WS_END = 889 * MiB;
constexpr size_t WS_DBG = 889 * MiB;
constexpr size_t OUT_U = 0, OUT_MISC = 128 * MiB, OUT_IQ = 192 * MiB;
constexpr size_t OUT_KV = 0, OUT_IK = 16 * MiB, OUT_IW = 24 * MiB, OUT_DT = 26 * MiB, OUT_MASK = 32 * MiB, OUT_OA = 64 * MiB;
constexpr int CW_BAR = 4096, CW_CNT = 16384, CW_DBG = 24576;

constexpr int LDS_BYTES = 160 * 1024;
constexpr int LDS_AUX = 131072;
constexpr int LDS_MISC = LDS_BYTES - 256;

#define LDS_WAIT() asm volatile("s_waitcnt lgkmcnt(0)" ::: "memory")
#define VM_WAIT() asm volatile("s_waitcnt vmcnt(0)" ::: "memory")
#define SBAR() __builtin_amdgcn_sched_barrier(0)
typedef __bf16 bf16x2_t __attribute__((ext_vector_type(2)));
__device__ __forceinline__ unsigned cvt_pk_bf16(float lo, float hi) { f32x2 f = {lo, hi}; bf16x2_t v = __builtin_convertvector(f, bf16x2_t); return __builtin_bit_cast(unsigned, v); }
__device__ __forceinline__ float bflo(unsigned w) { return __uint_as_float(w << 16); }
__device__ __forceinline__ float bfhi(unsigned w) { return __uint_as_float(w & 0xffff0000u); }
__device__ __forceinline__ u32x4 pack8(f32x4 a, f32x4 b) { u32x4 w; w.x = cvt_pk_bf16(a[0], a[1]); w.y = cvt_pk_bf16(a[2], a[3]); w.z = cvt_pk_bf16(b[0], b[1]); w.w = cvt_pk_bf16(b[2], b[3]); return w; }
constexpr int MOE_RB = MOE_FP8 ? 1024 : 2048;
constexpr float MOE_WSC = MOE_FP8 ? 64.0f : 1.0f, MOE_INV = 1.0f / MOE_WSC;
__device__ __forceinline__ u32x2 pack8_fp8(f32x4 a, f32x4 b) { int lo = 0, hi = 0;
    lo = __builtin_amdgcn_cvt_pk_fp8_f32(a[0], a[1], lo, false); lo = __builtin_amdgcn_cvt_pk_fp8_f32(a[2], a[3], lo, true);
    hi = __builtin_amdgcn_cvt_pk_fp8_f32(b[0], b[1], hi, false); hi = __builtin_amdgcn_cvt_pk_fp8_f32(b[2], b[3], hi, true);
    u32x2 r; r.x = (unsigned)lo; r.y = (unsigned)hi; return r; }
__device__ __forceinline__ void unpack8(u32x4 w, f32x4& a, f32x4& b) { a[0] = bflo(w.x); a[1] = bfhi(w.x); a[2] = bflo(w.y); a[3] = bfhi(w.y); b[0] = bflo(w.z); b[1] = bfhi(w.z); b[2] = bflo(w.w); b[3] = bfhi(w.w); }
__device__ __forceinline__ float wave_sum(float v) {
#pragma unroll
    for (int o = 1; o < 64; o <<= 1) v += __shfl_xor(v, o);
    return v;
}
__device__ __forceinline__ float fast_rcp(float x) { return __builtin_amdgcn_rcpf(x); }
__device__ __forceinline__ float sigmoid_f(float x) { return fast_rcp(1.0f + __expf(-x)); }
__device__ __forceinline__ float silu_f(float x) { return x * sigmoid_f(x); }

#define XB_TMO      128
#define XB_XCNT(j)  (256  + 64 * (j))
#define XB_XSUB(j)  (1280 + 64 * (j))
#define XB_XGEN(j)  (2304 + 64 * (j))
#define XB_TOP      3328
#define XB_TOPGEN   3392
#define XCD_BAR_WORDS 3456
#define XB_SPIN_CAP (1u << 18)
__device__ __forceinline__ unsigned xb_ld(unsigned* p)              { return __hip_atomic_load(p, __ATOMIC_RELAXED, __HIP_MEMORY_SCOPE_AGENT); }
__device__ __forceinline__ unsigned xb_add(unsigned* p, unsigned v) { return __hip_atomic_fetch_add(p, v, __ATOMIC_RELAXED, __HIP_MEMORY_SCOPE_AGENT); }
__device__ __forceinline__ unsigned xb_xcc_id() { return (unsigned)__builtin_amdgcn_s_getreg((3 << 11) | 20) & 0xFu; }
#define XB_SPIN(cond, bar) do { unsigned _sp = 0; while (cond) { __builtin_amdgcn_s_sleep(1); \
    if ((++_sp & 255u) == 0u) { if (xb_ld(&(bar)[XB_TMO])) break; if (_sp > XB_SPIN_CAP) { atomicAdd(&(bar)[XB_TMO], 1u); break; } } } } while (0)
struct XcdBarrier { unsigned* bar; unsigned x; volatile LAS unsigned* st; };
__device__ __forceinline__ XcdBarrier xcd_barrier_post(unsigned* bar, volatile LAS unsigned* st) {
    XcdBarrier b; b.bar = bar; b.x = xb_xcc_id(); b.st = st;
    if (threadIdx.x == 0) (void)xb_add(&bar[XB_XCNT(b.x)], 1u);
    return b;
}
__device__ __forceinline__ void xcd_barrier_complete(unsigned* bar, unsigned x, unsigned& nloc, unsigned& nx) {
    const unsigned G = gridDim.x * gridDim.y * gridDim.z;
    unsigned sum, cnt, mine, sp = 0u;
    for (;;) {
        sum = 0u; cnt = 0u;
#pragma nounroll
        for (unsigned j = 0; j < 16; ++j) { const unsigned c = xb_ld(&bar[XB_XCNT(j)]); sum += c; cnt += (c > 0u) ? 1u : 0u; }
        if (sum == G) break;
        __builtin_amdgcn_s_sleep(1);
        if ((++sp & 255u) == 0u) { if (xb_ld(&bar[XB_TMO])) break; if (sp > XB_SPIN_CAP) { atomicAdd(&bar[XB_TMO], 1u); break; } }
    }
    mine = xb_ld(&bar[XB_XCNT(x)]);
    nloc = mine > 0u ? mine : 1u; nx = cnt > 0u ? cnt : 1u;
}
__device__ __forceinline__ void xcd_barrier(const XcdBarrier& b) {
    asm volatile("s_waitcnt vmcnt(0)" ::: "memory");
    __syncthreads();
    if (threadIdx.x == 0) {
        unsigned* bar = b.bar;
        __builtin_amdgcn_s_waitcnt(0);
        unsigned nloc = b.st[0], nx = b.st[1];
        if (nloc == 0u) { xcd_barrier_complete(bar, b.x, nloc, nx); b.st[0] = nloc; b.st[1] = nx; }
        const unsigned old = xb_add(&bar[XB_XSUB(b.x)], 1u);
        const unsigned gen = old / nloc;
        if (old + 1u == (gen + 1u) * nloc) {
            __builtin_amdgcn_fence(__ATOMIC_RELEASE, "agent");
            asm volatile("s_waitcnt vmcnt(0)" ::: "memory");
            const unsigned og = xb_add(&bar[XB_TOP], 1u);
            const unsigned tg = og / nx;
            if (og + 1u == (tg + 1u) * nx) xb_add(&bar[XB_TOPGEN], 1u);
            else XB_SPIN(xb_ld(&bar[XB_TOPGEN]) == tg, bar);
            __builtin_amdgcn_fence(__ATOMIC_ACQUIRE, "agent");
            xb_add(&bar[XB_XGEN(b.x)], 1u);
            asm volatile("s_waitcnt vmcnt(0)" ::: "memory");
        } else {
            XB_SPIN(xb_ld(&bar[XB_XGEN(b.x)]) == gen, bar);
            __builtin_amdgcn_fence(__ATOMIC_ACQUIRE, "agent");
            asm volatile("s_waitcnt vmcnt(0)" ::: "memory");
        }
    }
    __syncthreads();
}

namespace pg8 {
constexpr int BM = 256, BK = 64, HALF = 128, HTB = HALF * BK * 2, STAGE_BYTES = 8 * HTB, NXCD = 8, WGM = 8, KD = 1024;
__host__ __device__ __forceinline__ int lds_byte(int r, int c) { const int st = (r >> 4) * 2 + (c >> 5), rr = r & 15, cc = c & 31, ob = rr * 64 + cc * 2; return st * 1024 + (ob ^ (((ob >> 9) & 1) << 5)); }
__host__ __device__ __forceinline__ void stage_rc(int b, int& R, int& C) { const int st = b / 1024, sb = b % 1024, swz = sb ^ (((sb >> 9) & 1) << 5); R = (st >> 1) * 16 + swz / 64; C = (st & 1) * 32 + (swz % 64) / 2; }
__host__ __device__ __forceinline__ int perm32(int rho) { const int n = rho >> 4, i = rho & 15; return 8 * (i >> 2) + 4 * n + (i & 3); }
struct Unit { int pm, pn, ex; };
struct StaticOrder {
    int nM, nN, nwg, G, c;
    __device__ void init(int M, int N, int G_, int c_) { nM = M / BM; nN = N / BM; nwg = nM * nN; G = G_; c = c_; }
    __device__ bool next(int i, Unit& u) const {
        const long L = (long)i * G + c; if (L >= nwg) return false;
        int wgid = (int)L; { const int q = nwg / NXCD, r = nwg % NXCD, xcd = wgid % NXCD, off = wgid / NXCD; wgid = (xcd < r ? xcd * (q + 1) : r * (q + 1) + (xcd - r) * q) + off; }
        const int nig = WGM * nN, gid = wgid / nig, fm = gid * WGM, gsz = (nM - fm) < WGM ? (nM - fm) : WGM;
        u.pm = fm + ((wgid % nig) % gsz); u.pn = (wgid % nig) / gsz; u.ex = 0; return true;
    }
};
typedef int i32x8 __attribute__((ext_vector_type(8)));
typedef int i32x4v __attribute__((ext_vector_type(4)));
template <class Epi, class Sched, bool GATHER, int KE = 1024, bool FP8 = false>
__device__ __forceinline__ void gemm_phase(LAS unsigned char* lds, const Sched& S, const Epi& E) {
    int tid = threadIdx.x; asm volatile("" : "+v"(tid));
    const int wid = __builtin_amdgcn_readfirstlane(tid >> 6), lane = tid & 63, wr = wid >> 2, wc = wid & 3, fr = lane & 15, fq = lane >> 4;
    constexpr int K = KE, nt = K / BK;
    unsigned voffA[2], voffB[2]; int Rr[2], Cc[2];
#pragma unroll
    for (int i = 0; i < 2; ++i) { int R, C; stage_rc(tid * 16 + i * 8192, R, C); const int Rb = Epi::PERM ? ((R & ~31) + perm32(R & 31)) : R;
        voffA[i] = (unsigned)(R * K + C) * 2u; voffB[i] = (unsigned)(Rb * K + C) * 2u; Rr[i] = R; Cc[i] = C; }
    constexpr size_t kstep = (size_t)(BK * 2);
    constexpr size_t hstep = (size_t)HALF * K * 2;
    const unsigned ldsw = (unsigned)wid * 1024u;
    const int aoff = lds_byte(wr * 64 + fr, fq * 8), boff = lds_byte(wc * 32 + fr, fq * 8);
#define PG8_SA(b, h) (((b) * 2 + (h)) * HTB)
#define PG8_SB(b, h) ((4 + (b) * 2 + (h)) * HTB)
#define PG8_STAGE(bufoff, gbase, voff) do { _Pragma("unroll") for (int _i = 0; _i < 2; ++_i) \
        __builtin_amdgcn_global_load_lds((const unsigned*)((const char*)(gbase) + (voff)[_i]), (LAS unsigned*)(lds + (bufoff) + ldsw + _i * 8192), 16, 0, 0); } while (0)
#define PG8_STAGE_A(bufoff, gb, h, o0, o1) do { if constexpr (GATHER) { const unsigned _ko = (unsigned)((gb) - gA0); unsigned _o[2]; \
            if ((h) == 0) { _o[0] = (o0)[0] + _ko; _o[1] = (o0)[1] + _ko; } else { _o[0] = (o1)[0] + _ko; _o[1] = (o1)[1] + _ko; } PG8_STAGE(bufoff, gA0, _o); } \
        else { PG8_STAGE(bufoff, (gb) + (h) * hstep, voffA); } } while (0)
#define PG8_LD8(p) __builtin_shufflevector(*(const LAS i32x4v*)(p), *(const LAS i32x4v*)((p) + 1024), 0, 1, 2, 3, 4, 5, 6, 7)
#define PG8_LDA(dst, b, h) do { if constexpr (FP8) { _Pragma("unroll") for (int m = 0; m < 4; ++m) dst##8[m] = PG8_LD8(lds + PG8_SA(b, h) + aoff + m * 2048); } \
        else { _Pragma("unroll") for (int m = 0; m < 4; ++m) _Pragma("unroll") for (int k = 0; k < 2; ++k) dst[m][k] = *(const LAS bf16x8*)(lds + PG8_SA(b, h) + aoff + m * 2048 + k * 1024); } } while (0)
#define PG8_LDB(dst, b, h) do { if constexpr (FP8) { _Pragma("unroll") for (int n = 0; n < 2; ++n) dst##8[n] = PG8_LD8(lds + PG8_SB(b, h) + boff + n * 2048); } \
        else { _Pragma("unroll") for (int n = 0; n < 2; ++n) _Pragma("unroll") for (int k = 0; k < 2; ++k) dst[n][k] = *(const LAS bf16x8*)(lds + PG8_SB(b, h) + boff + n * 2048 + k * 1024); } } while (0)
#define PG8_MMA(ai, bj, At, Bt) do { __builtin_amdgcn_s_setprio(1); if constexpr (FP8) { _Pragma("unroll") for (int m = 0; m < 4; ++m) _Pragma("unroll") for (int n = 0; n < 2; ++n) \
            asm volatile("v_mfma_scale_f32_16x16x128_f8f6f4 %0, %1, %2, %0, %3, %3 op_sel_hi:[0,0,0]" : "+v"(acc[ai][bj][m][n]) : "v"(Bt##8[n]), "v"(At##8[m]), "v"(sc127)); } \
        else { _Pragma("unroll") for (int m = 0; m < 4; ++m) _Pragma("unroll") for (int n = 0; n < 2; ++n) _Pragma("unroll") for (int k = 0; k < 2; ++k) \
            acc[ai][bj][m][n] = __builtin_amdgcn_mfma_f32_16x16x32_bf16(Bt[n][k], At[m][k], acc[ai][bj][m][n], 0, 0, 0); } __builtin_amdgcn_s_setprio(0); } while (0)
#define PG8_WAIT_V(n) asm volatile("s_waitcnt vmcnt(" #n ")" ::: "memory")
#define PG8_WAIT_L(n) asm volatile("s_waitcnt lgkmcnt(" #n ")" ::: "memory")
#define PG8_BAR __builtin_amdgcn_s_barrier()
#define PG8_SCHED __builtin_amdgcn_sched_barrier(0)
    Unit cur, nxt; int ui = 0;
    if (!S.next(0, cur)) return;
    f32x4 acc[2][2][4][2];
#pragma unroll
    for (int a = 0; a < 2; ++a)
#pragma unroll
        for (int b = 0; b < 2; ++b)
#pragma unroll
            for (int m = 0; m < 4; ++m)
#pragma unroll
                for (int n = 0; n < 2; ++n) acc[a][b][m][n] = (f32x4){0.f, 0.f, 0.f, 0.f};
    const int sc127 = 0x7f7f7f7f;
    bf16x8 At[4][2], B0[2][2], B1[2][2]; i32x8 At8[4], B08[2], B18[2];
    const char* cA = S.a_base(cur); const char* cB = S.b_base(cur);
    const char* const gA0 = cA;
    unsigned cv0[2] = {0u, 0u}, cv1[2] = {0u, 0u}, nv0[2] = {0u, 0u}, nv1[2] = {0u, 0u};
    if constexpr (GATHER) S.a_offs(cur, Rr, Cc, cv0, cv1);
    PG8_STAGE(PG8_SB(0, 0), cB, voffB); PG8_STAGE_A(PG8_SA(0, 0), cA, 0, cv0, cv1); PG8_STAGE(PG8_SB(0, 1), cB + hstep, voffB); PG8_STAGE_A(PG8_SA(0, 1), cA, 1, cv0, cv1);
    if (wr == 1) PG8_BAR;
    PG8_WAIT_V(4); PG8_BAR;
    PG8_STAGE(PG8_SB(1, 0), cB + kstep, voffB); PG8_STAGE_A(PG8_SA(1, 0), cA + kstep, 0, cv0, cv1); PG8_STAGE(PG8_SB(1, 1), cB + hstep + kstep, voffB);
    PG8_WAIT_V(6); PG8_BAR;
    for (;;) {
        const bool has_next = S.next(ui + 1, nxt);
        const char* nA = has_next ? S.a_base(nxt) : cA; const char* nB = has_next ? S.b_base(nxt) : cB;
        if constexpr (GATHER) { if (has_next) S.a_offs(nxt, Rr, Cc, nv0, nv1); else { nv0[0] = cv0[0]; nv0[1] = cv0[1]; nv1[0] = cv1[0]; nv1[1] = cv1[1]; } }
#pragma nounroll
        for (int t = 0; t < nt; t += 2) {
            const bool last = (t == nt - 2);
            const char* a1 = cA + (size_t)(t + 1) * kstep;
            const char* a2 = last ? nA : cA + (size_t)(t + 2) * kstep; const char* b2 = last ? nB : cB + (size_t)(t + 2) * kstep;
            const char* a3 = a2 + kstep; const char* b3 = b2 + kstep;
            unsigned s0[2], s1[2];
            if constexpr (GATHER) { s0[0] = last ? nv0[0] : cv0[0]; s0[1] = last ? nv0[1] : cv0[1]; s1[0] = last ? nv1[0] : cv1[0]; s1[1] = last ? nv1[1] : cv1[1]; } else { s0[0] = s0[1] = s1[0] = s1[1] = 0u; }
            PG8_LDB(B0, 0, 0); PG8_SCHED; PG8_LDA(At, 0, 0); PG8_STAGE_A(PG8_SA(1, 1), a1, 1, cv0, cv1);
            PG8_WAIT_L(8); PG8_BAR; PG8_WAIT_L(0); PG8_MMA(0, 0, At, B0); PG8_BAR; PG8_SCHED;
            PG8_LDB(B1, 0, 1); PG8_STAGE(PG8_SB(0, 0), b2, voffB);
            PG8_BAR; PG8_WAIT_L(0); PG8_MMA(0, 1, At, B1); PG8_BAR;
            PG8_LDA(At, 0, 1); PG8_STAGE_A(PG8_SA(0, 0), a2, 0, s0, s1);
            PG8_BAR; PG8_WAIT_L(0); PG8_MMA(1, 0, At, B0); PG8_BAR; PG8_SCHED;
            PG8_STAGE(PG8_SB(0, 1), b2 + hstep, voffB);
            PG8_WAIT_V(6); PG8_BAR; PG8_MMA(1, 1, At, B1); PG8_BAR;
            PG8_LDB(B0, 1, 0); PG8_SCHED; PG8_LDA(At, 1, 0); PG8_STAGE_A(PG8_SA(0, 1), a2, 1, s0, s1);
            PG8_WAIT_L(8); PG8_BAR; PG8_WAIT_L(0); PG8_MMA(0, 0, At, B0); PG8_BAR; PG8_SCHED;
            PG8_LDB(B1, 1, 1); PG8_STAGE(PG8_SB(1, 0), b3, voffB);
            PG8_BAR; PG8_WAIT_L(0); PG8_MMA(0, 1, At, B1); PG8_BAR;
            PG8_LDA(At, 1, 1); PG8_STAGE_A(PG8_SA(1, 0), a3, 0, s0, s1);
            PG8_BAR; PG8_WAIT_L(0); PG8_MMA(1, 0, At, B0); PG8_BAR; PG8_SCHED;
            PG8_STAGE(PG8_SB(1, 1), b3 + hstep, voffB);
            PG8_WAIT_V(6); PG8_BAR; PG8_MMA(1, 1, At, B1); PG8_BAR;
        }
        if constexpr (FP8) asm volatile("s_nop 15\n\ts_nop 15" ::: "memory");
        E(acc, cur, wr, wc, fr, fq);
        if (!has_next) break;
#pragma unroll
        for (int a = 0; a < 2; ++a)
#pragma unroll
            for (int b = 0; b < 2; ++b)
#pragma unroll
                for (int m = 0; m < 4; ++m)
#pragma unroll
                    for (int n = 0; n < 2; ++n) acc[a][b][m][n] = (f32x4){0.f, 0.f, 0.f, 0.f};
        cur = nxt; cA = nA; cB = nB; ++ui;
        if constexpr (GATHER) { cv0[0] = nv0[0]; cv0[1] = nv0[1]; cv1[0] = nv1[0]; cv1[1] = nv1[1]; }
    }
    PG8_WAIT_V(0);
    if (wr == 0) PG8_BAR;
    PG8_BAR;
#undef PG8_SA
#undef PG8_SB
#undef PG8_STAGE
#undef PG8_STAGE_A
#undef PG8_LDA
#undef PG8_LDB
#undef PG8_MMA
#undef PG8_LD8
#undef PG8_WAIT_V
#undef PG8_WAIT_L
#undef PG8_BAR
#undef PG8_SCHED
}
}
using pg8::Unit;
typedef f32x4 AccT[2][2][4][2];

struct Args { const float* in[28]; float* out; unsigned char* ws; int ph_lo, ph_hi, pad0, pad1; };
struct Frame {
    LAS unsigned char* lds;
    int tid, lane, wave, G, bid;
    const struct Args* a;
    unsigned char* ws; unsigned char* outb;
};
template <int RB = 2048> struct SchedPlainT {
    pg8::StaticOrder o; const char* A; const char* Bt;
    __device__ __forceinline__ bool next(int i, Unit& u) const { return o.next(i, u); }
    __device__ __forceinline__ const char* a_base(const Unit& u) const { return A + (size_t)u.pm * (256 * RB); }
    __device__ __forceinline__ const char* b_base(const Unit& u) const { return Bt + (size_t)u.pn * (256 * RB); }
    __device__ __forceinline__ void a_offs(const Unit&, const int*, const int*, unsigned (&)[2], unsigned (&)[2]) const {}
};
typedef SchedPlainT<2048> SchedPlain;
template <int MODE> struct SchedProj {
    pg8::StaticOrder o; const char* A; const char* Bt;
    static constexpr int RB = MODE == 2 ? 1024 : 2048;
    __device__ __forceinline__ bool next(int i, Unit& u) const { if (!o.next(i, u)) return false; const int r = u.pn;
        if (MODE == 1) u.pn = 4 + r;
        if (MODE == 2) u.pn = r < 4 ? r : 15 + r;
        return true; }
    __device__ __forceinline__ const char* a_base(const Unit& u) const { return A + (size_t)u.pm * (256 * RB); }
    __device__ __forceinline__ const char* b_base(const Unit& u) const { return Bt + (size_t)u.pn * (256 * RB); }
    __device__ __forceinline__ void a_offs(const Unit&, const int*, const int*, unsigned (&)[2], unsigned (&)[2]) const {}
};

struct EpiProj {
    static constexpr bool PERM = true;
    bf16_t *Q, *IQ, *Z, *XBC, *GA, *GB; float* MISC; float sc;
    __device__ __forceinline__ void operator()(const AccT& acc, const Unit& u, int wr, int wc, int fr, int fq) const {
        const int pn = u.pn, row0 = u.pm * 256 + wr * 64 + fr, c8 = wc * 32 + 8 * fq;
        if (pn == 6) {
#pragma unroll
            for (int ai = 0; ai < 2; ++ai)
#pragma unroll
                for (int m = 0; m < 4; ++m) { float* rp = MISC + (size_t)(row0 + ai * 128 + m * 16) * 256 + c8;
#pragma unroll
                    for (int bj = 0; bj < 2; ++bj) { *(f32x4*)(rp + bj * 128) = acc[ai][bj][m][0]; *(f32x4*)(rp + bj * 128 + 4) = acc[ai][bj][m][1]; } }
            return;
        }
        bf16_t* base; int ldc, colt, act = 0;
        if (pn < 4) { base = Q; ldc = 1024; colt = pn * 256; }
        else if (pn < 6) { base = IQ; ldc = 512; colt = (pn - 4) * 256; }
        else if (pn < 11) { base = Z; ldc = 1024; colt = (pn - 7) * 256; act = 1; }
        else if (pn < 19) { base = XBC; ldc = 2048; colt = (pn - 11) * 256; }
        else if (pn < 23) { base = GA; ldc = 1024; colt = (pn - 19) * 256; act = 2; }
        else { base = GB; ldc = 1024; colt = (pn - 23) * 256; act = 2; }
#pragma unroll
        for (int ai = 0; ai < 2; ++ai)
#pragma unroll
            for (int m = 0; m < 4; ++m) { bf16_t* rp = base + (size_t)(row0 + ai * 128 + m * 16) * ldc + colt + c8;
#pragma unroll
                for (int bj = 0; bj < 2; ++bj) { f32x4 v0 = acc[ai][bj][m][0] * sc, v1 = acc[ai][bj][m][1] * sc;
                    if (act == 1) {
#pragma unroll
                        for (int j = 0; j < 4; ++j) { v0[j] = silu_f(v0[j]); v1[j] = silu_f(v1[j]); } }
                    if (act == 2) {
#pragma unroll
                        for (int j = 0; j < 4; ++j) { v0[j] = sigmoid_f(v0[j]); v1[j] = sigmoid_f(v1[j]); } }
                    u32x4 pk = pack8(v0, v1); if (DBG_IQ_TRUNC && (pn == 4 || pn == 5)) { pk.x &= 0xfff8fff8u; pk.y &= 0xfff8fff8u; pk.z &= 0xfff8fff8u; pk.w &= 0xfff8fff8u; }
                    *(u32x4*)(rp + bj * 128) = pk; } }
    }
};
template <int MODE> struct EpiGate {
    static constexpr bool PERM = true;
    const bf16_t* Gt; const bf16_t* T; bf16_t* O; float sc;
    __device__ __forceinline__ void operator()(const AccT& acc, const Unit& u, int wr, int wc, int fr, int fq) const {
        const int row0 = u.pm * 256 + wr * 64 + fr, c8 = u.pn * 256 + wc * 32 + 8 * fq;
#pragma unroll
        for (int ai = 0; ai < 2; ++ai) {
            u32x4 gq[4][2], tq[4][2];
#pragma unroll
            for (int m = 0; m < 4; ++m) { const size_t off = (size_t)(row0 + ai * 128 + m * 16) * 1024 + c8;
#pragma unroll
                for (int bj = 0; bj < 2; ++bj) { gq[m][bj] = *(const u32x4*)(Gt + off + bj * 128); if (MODE == 1) tq[m][bj] = *(const u32x4*)(T + off + bj * 128); } }
            SBAR();
#pragma unroll
            for (int m = 0; m < 4; ++m) { const size_t off = (size_t)(row0 + ai * 128 + m * 16) * 1024 + c8;
#pragma unroll
                for (int bj = 0; bj < 2; ++bj) { f32x4 g0, g1; unpack8(gq[m][bj], g0, g1);
                    f32x4 v0 = g0 * (acc[ai][bj][m][0] * sc), v1 = g1 * (acc[ai][bj][m][1] * sc);
                    if ((MODE == 0 && DBG_NO_ATTN) || (MODE == 1 && DBG_NO_SSD)) { v0 = (f32x4){0.f, 0.f, 0.f, 0.f}; v1 = v0; }
                    if (MODE == 1) { f32x4 t0, t1; unpack8(tq[m][bj], t0, t1); v0 += t0; v1 += t1; }
                    *(u32x4*)(O + off + bj * 128) = pack8(v0, v1); } }
            SBAR();
        }
    }
};
struct EpiOut {
    static constexpr bool PERM = false;
    const float* x; const float* mod; float* V;
    __device__ __forceinline__ void operator()(const AccT& acc, const Unit& u, int wr, int wc, int fr, int fq) const {
        const int row0 = u.pm * 256 + wr * 64 + fr, col0 = u.pn * 256 + wc * 32 + 4 * fq;
        const float* g1 = mod + (size_t)(u.pm >> 3) * 6144 + 2048 + col0;
        f32x4 gv[2][2];
#pragma unroll
        for (int bj = 0; bj < 2; ++bj)
#pragma unroll
            for (int n = 0; n < 2; ++n) gv[bj][n] = *(const f32x4*)(g1 + bj * 128 + n * 16);
#pragma unroll
        for (int ai = 0; ai < 2; ++ai)
#pragma unroll
            for (int mp = 0; mp < 2; ++mp) {
                f32x4 xv[2][2][2];
#pragma unroll
                for (int mm = 0; mm < 2; ++mm) { const size_t off = (size_t)(row0 + ai * 128 + (2 * mp + mm) * 16) * 1024 + col0;
#pragma unroll
                    for (int bj = 0; bj < 2; ++bj)
#pragma unroll
                        for (int n = 0; n < 2; ++n) xv[mm][bj][n] = *(const f32x4*)(x + off + bj * 128 + n * 16); }
                SBAR();
#pragma unroll
                for (int mm = 0; mm < 2; ++mm) { const int m = 2 * mp + mm; const size_t off = (size_t)(row0 + ai * 128 + m * 16) * 1024 + col0;
#pragma unroll
                    for (int bj = 0; bj < 2; ++bj)
#pragma unroll
                        for (int n = 0; n < 2; ++n) *(f32x4*)(V + off + bj * 128 + n * 16) = xv[mm][bj][n] * DN_ALPHA + gv[bj][n] * acc[ai][bj][m][n]; }
                SBAR();
            }
    }
};

struct MoeTab { LAS unsigned* cnt; LAS unsigned* tb; LAS unsigned char* te; int ntiles; };
__device__ __forceinline__ MoeTab moe_tables(Frame& F, int hf) {
    MoeTab T; T.cnt = (LAS unsigned*)(F.lds + LDS_AUX); T.tb = (LAS unsigned*)(F.lds + LDS_AUX + 256); T.te = (LAS unsigned char*)(F.lds + LDS_AUX + 512);
    const unsigned* CNT = (const unsigned*)(F.ws + WS_CTL) + CW_CNT;
    __syncthreads();
    if (F.tid < 32) { unsigned c = __hip_atomic_load(CNT + 64 * (hf * 32 + F.tid), __ATOMIC_RELAXED, __HIP_MEMORY_SCOPE_AGENT); if (c > (unsigned)REG_CAP) c = REG_CAP; T.cnt[F.tid] = c; }
    __syncthreads();
    if (F.tid == 0) { unsigned s = 0;
#pragma nounroll
        for (int e = 0; e < 32; ++e) { T.tb[e] = s; const unsigned n = (T.cnt[e] + 255u) >> 8;
#pragma nounroll
            for (unsigned t = 0; t < n; ++t) T.te[s + t] = (unsigned char)e;
            s += n; }
        T.tb[32] = s; }
    __syncthreads();
    T.ntiles = __builtin_amdgcn_readfirstlane((int)T.tb[32]);
    return T;
}
template <int NJ, bool GATHER> struct SchedMoe {
    MoeTab T; int G, c, hf; const char* A; const char* Bt; const u32x2* REG;
    __device__ __forceinline__ bool next(int i, Unit& u) const {
        int tile, j;
        if (G == 256) { const int x = c & 7, sl = c >> 3;
            tile = i * (256 / NJ) + x * (32 / NJ) + sl / NJ; j = sl % NJ;
            if (tile >= T.ntiles) return false; }
        else { const int L = i * G + c; if (L >= T.ntiles * NJ) return false; tile = L / NJ; j = L % NJ; }
        u.pm = tile; u.pn = j; u.ex = __builtin_amdgcn_readfirstlane((int)T.te[u.pm]); return true;
    }
    __device__ __forceinline__ const char* a_base(const Unit& u) const { return GATHER ? A : A + (size_t)u.pm * (256 * MOE_RB); }
    __device__ __forceinline__ const char* b_base(const Unit& u) const { return Bt + ((size_t)u.ex * (NJ * 256) + (size_t)u.pn * 256) * MOE_RB; }
    __device__ __forceinline__ void a_offs(const Unit& u, const int* R, const int* C, unsigned (&o0)[2], unsigned (&o1)[2]) const {
        const unsigned cnt = __builtin_amdgcn_readfirstlane(T.cnt[u.ex]), pos0 = ((unsigned)u.pm - (unsigned)__builtin_amdgcn_readfirstlane(T.tb[u.ex])) * 256u; const u32x2* rg = REG + ((size_t)hf * 32 + u.ex) * REG_CAP;
#pragma unroll
        for (int i = 0; i < 2; ++i) {
            const unsigned p0 = pos0 + (unsigned)R[i], p1 = p0 + 128u;
            unsigned t0 = 0u, t1 = 0u;
            if (p0 < cnt) t0 = (unsigned)hf * HALF_TOK + (rg[p0].x >> 2);
            if (p1 < cnt) t1 = (unsigned)hf * HALF_TOK + (rg[p1].x >> 2);
            o0[i] = t0 * (unsigned)MOE_RB + (unsigned)C[i] * 2u; o1[i] = t1 * (unsigned)MOE_RB + (unsigned)C[i] * 2u;
        }
    }
};
struct EpiMoe1 {
    static constexpr bool PERM = true;
    const float* b1; bf16_t* ACT; int dry;
    __device__ __forceinline__ void operator()(const AccT& acc, const Unit& u, int wr, int wc, int fr, int fq) const {
        if (dry) { if (acc[0][0][0][0][0] == 1.2345e-33f) ACT[0] = 1; return; }
        const int row0 = u.pm * 256 + wr * 64 + fr, c8 = u.pn * 128 + wc * 32 + 8 * fq;
        const float* bg = b1 + (size_t)u.ex * 2048 + c8;
        const f32x4 bg0 = *(const f32x4*)bg, bg1 = *(const f32x4*)(bg + 4), bu0 = *(const f32x4*)(bg + 1024), bu1 = *(const f32x4*)(bg + 1028);
#pragma unroll
        for (int ai = 0; ai < 2; ++ai)
#pragma unroll
            for (int m = 0; m < 4; ++m) {
                f32x4 g0 = acc[ai][0][m][0] * MOE_INV + bg0, g1 = acc[ai][0][m][1] * MOE_INV + bg1, u0 = acc[ai][1][m][0] * MOE_INV + bu0, u1 = acc[ai][1][m][1] * MOE_INV + bu1, a0, a1;
#pragma unroll
                for (int j = 0; j < 4; ++j) {
                    float g = fminf(g0[j], 7.0f), up = fminf(fmaxf(u0[j], -7.0f), 7.0f); a0[j] = (up + 1.0f) * g * sigmoid_f(1.702f * g);
                    g = fminf(g1[j], 7.0f); up = fminf(fmaxf(u1[j], -7.0f), 7.0f); a1[j] = (up + 1.0f) * g * sigmoid_f(1.702f * g); }
                if (MOE_FP8) *(u32x2*)((unsigned char*)ACT + (size_t)(row0 + ai * 128 + m * 16) * 1024 + c8) = pack8_fp8(a0, a1);
                else *(u32x4*)(ACT + (size_t)(row0 + ai * 128 + m * 16) * 1024 + c8) = pack8(a0, a1); }
    }
};
struct EpiMoe2 {
    static constexpr bool PERM = true;
    const float* b2; bf16_t* YB; const u32x2* REG; MoeTab T; int hf; int dry;
    __device__ __forceinline__ void operator()(const AccT& acc, const Unit& u, int wr, int wc, int fr, int fq) const {
        if (dry == 1) { if (acc[0][0][0][0][0] == 1.2345e-33f) YB[0] = 1; return; }
        if (dry >= 2) {
            const int c8d = (dry == 3 ? 0 : u.pn * 256) + wc * 32 + 8 * fq; const unsigned rowd = dry == 3 ? (blockIdx.x * 256u + (unsigned)(wr * 64 + fr)) : ((unsigned)u.pm * 256u + (unsigned)(wr * 64 + fr)) % 131072u;
#pragma unroll
            for (int ai = 0; ai < 2; ++ai)
#pragma unroll
                for (int m = 0; m < 4; ++m) { bf16_t* rp = YB + (size_t)((rowd + ai * 128 + m * 16) % 131072u) * 1024 + c8d;
#pragma unroll
                    for (int bj = 0; bj < 2; ++bj) *(u32x4*)(rp + bj * 128) = pack8(acc[ai][bj][m][0] * MOE_INV, acc[ai][bj][m][1] * MOE_INV); }
            return; }
        const int c8 = u.pn * 256 + wc * 32 + 8 * fq;
        const unsigned cnt = __builtin_amdgcn_readfirstlane(T.cnt[u.ex]), pos0 = ((unsigned)u.pm - (unsigned)__builtin_amdgcn_readfirstlane(T.tb[u.ex])) * 256u + (unsigned)(wr * 64 + fr); const u32x2* rg = REG + ((size_t)hf * 32 + u.ex) * REG_CAP;
        const float* bb = b2 + (size_t)u.ex * 1024 + c8;
        f32x4 bv[2][2];
#pragma unroll
        for (int bj = 0; bj < 2; ++bj) { bv[bj][0] = *(const f32x4*)(bb + bj * 128); bv[bj][1] = *(const f32x4*)(bb + bj * 128 + 4); }
        u32x2 en8[2][4];
#pragma unroll
        for (int ai = 0; ai < 2; ++ai)
#pragma unroll
            for (int m = 0; m < 4; ++m) { const unsigned p = pos0 + (unsigned)(ai * 128 + m * 16); en8[ai][m] = rg[p < cnt ? p : cnt - 1u]; }
#pragma unroll
        for (int ai = 0; ai < 2; ++ai)
#pragma unroll
            for (int m = 0; m < 4; ++m) { const unsigned p = pos0 + (unsigned)(ai * 128 + m * 16);
                const u32x2 en = en8[ai][m]; const float g = __uint_as_float(en.y); const unsigned drow = p < cnt ? en.x : (unsigned)(HALF_TOK * 4);
                bf16_t* rp = YB + (size_t)drow * 1024 + c8;
#pragma unroll
                for (int bj = 0; bj < 2; ++bj) *(u32x4*)(rp + bj * 128) = pack8((acc[ai][bj][m][0] * MOE_INV + bv[bj][0]) * g, (acc[ai][bj][m][1] * MOE_INV + bv[bj][1]) * g); }
    }
};

struct MapIdent { __device__ __forceinline__ int operator()(int n) const { return n; } };
struct MapWin { __device__ __forceinline__ int operator()(int n) const {
    if (n < 1024) return n;
    if (n < 1536) return 1152 + (n - 1024);
    if (n < 1792) { const int c = n - 1536; if (c < 128) return 1024 + c; if (c < 192) return 1664 + (c - 128); if (c < 200) return 1728 + (c - 192); if (c < 216) return 4808 + (c - 200); return -1; }
    if (n < 2816) return 1736 + (n - 1792);
    if (n < 4864) return 2760 + (n - 2816);
    if (n < 5888) return 4824 + (n - 4864);
    return 5848 + (n - 5888); } };
struct MapW1 { __device__ __forceinline__ int operator()(int r) const { const int j = r >> 8, rr = r & 255; return (rr >> 7) * 1024 + j * 128 + (rr & 127); } };
template <class Map, bool F8 = false> __device__ __forceinline__ void transpose_item(const float* W, int K, int N, bf16_t* WT, const Map& map, LAS float* scr, int kb, int nb, int lane, const float* rowscale) {
    const int k0 = 64 * kb, n0 = 64 * nb, q = lane & 15, kr = lane >> 4; const int src = map(n0 + 4 * q);
    f32x4 ld[16];
#pragma unroll
    for (int i = 0; i < 16; ++i) { const int kk = 4 * i + kr; ld[i] = (src >= 0) ? *(const f32x4*)(W + (size_t)(k0 + kk) * N + src) : (f32x4){0.f, 0.f, 0.f, 0.f}; }
#pragma unroll
    for (int i = 0; i < 16; ++i) { const int kk = 4 * i + kr; f32x4 v = ld[i]; if (rowscale) v = v * rowscale[k0 + kk]; LAS float* d = scr + kk * 65 + 4 * q; d[0] = v[0]; d[1] = v[1]; d[2] = v[2]; d[3] = v[3]; }
    LDS_WAIT(); asm volatile("" ::: "memory");
    const int c = lane & 7;
#pragma unroll
    for (int j = 0; j < 8; ++j) { const int n = (lane >> 3) + 8 * j; const LAS float* s = scr + (8 * c) * 65 + n;
        if constexpr (F8) { const f32x4 a = {s[0 * 65] * MOE_WSC, s[1 * 65] * MOE_WSC, s[2 * 65] * MOE_WSC, s[3 * 65] * MOE_WSC}, b = {s[4 * 65] * MOE_WSC, s[5 * 65] * MOE_WSC, s[6 * 65] * MOE_WSC, s[7 * 65] * MOE_WSC};
            *(u32x2*)((unsigned char*)WT + (size_t)(n0 + n) * K + k0 + 8 * c) = pack8_fp8(a, b); }
        else { u32x4 o; o.x = cvt_pk_bf16(s[0 * 65], s[1 * 65]); o.y = cvt_pk_bf16(s[2 * 65], s[3 * 65]); o.z = cvt_pk_bf16(s[4 * 65], s[5 * 65]); o.w = cvt_pk_bf16(s[6 * 65], s[7 * 65]);
            *(u32x4*)(WT + (size_t)(n0 + n) * K + k0 + 8 * c) = o; } }
    LDS_WAIT(); asm volatile("" ::: "memory");
}
__device__ __forceinline__ void ph_prologue(Frame& F) {
    const float* c_in = F.a->in[1]; const float* w_mod = F.a->in[2]; const float* b_mod = F.a->in[3];
    float* MOD = (float*)(F.ws + WS_MOD);
    for (int item = F.bid; item < 48; item += F.G) {
        LAS float* SC = (LAS float*)F.lds;
        __syncthreads();
        for (int i = F.tid; i < 32768; i += NTHR) { const int b = i >> 10, k = i & 1023; SC[k * 32 + b] = silu_f(c_in[i]); }
        __syncthreads();
        const int col = item * 128 + (F.tid >> 2), kq = F.tid & 3;
        float a[32];
#pragma unroll
        for (int b = 0; b < 32; ++b) a[b] = 0.f;
#pragma nounroll
        for (int kg = 0; kg < 256; kg += 16) {
            float wv[16];
#pragma unroll
            for (int u = 0; u < 16; ++u) wv[u] = w_mod[(size_t)(kq * 256 + kg + u) * 6144 + col];
#pragma unroll
            for (int u = 0; u < 16; ++u) { const int k = kq * 256 + kg + u; const float w = wv[u];
#pragma unroll
                for (int b4 = 0; b4 < 8; ++b4) { const f32x4 s = *(const LAS f32x4*)(SC + k * 32 + b4 * 4); a[b4 * 4 + 0] += w * s[0]; a[b4 * 4 + 1] += w * s[1]; a[b4 * 4 + 2] += w * s[2]; a[b4 * 4 + 3] += w * s[3]; } } }
#pragma unroll
        for (int b = 0; b < 32; ++b) { a[b] += __shfl_xor(a[b], 1); a[b] += __shfl_xor(a[b], 2); }
        if (kq == 0) { const float bm = b_mod[col];
#pragma unroll
            for (int b = 0; b < 32; ++b) MOD[(size_t)b * 6144 + col] = a[b] + bm; }
        __syncthreads();
    }
    if (F.bid == (F.G > 48 ? 48 : 0)) {
        float* BT = (float*)(F.ws + WS_BIAST); const float* rel_bias = F.a->in[8];
        for (int i = F.tid; i < 249 * 8; i += NTHR) { const int idx = i >> 3, h = i & 7, rel = idx - 185; const int n = rel < 0 ? -rel : rel;
            const float nf = (float)(n > 1 ? n : 1); int large = 8 + (int)(logf(nf / 8.0f) / 2.7725887f * 8.0f); if (large > 15) large = 15;
            const int bucket = (rel > 0 ? 16 : 0) + (n < 8 ? n : large);
            BT[i] = rel_bias[bucket * 8 + h] * LOG2E; }
    }
    LAS float* scr = (LAS float*)(F.lds + F.wave * 16640);
    __syncthreads();
    const int gw = F.bid * NWAVES + F.wave, NGW = F.G * NWAVES;
    constexpr int I_WIN = 16 * (NPROJ / 64), I_SQ = 16 * 16, I_W1E = 16 * 32, I_W2E = 16 * 16;
    constexpr int NITEMS = (PROJ_FP8 ? 2 : 1) * I_WIN + 3 * I_SQ + 32 * I_W1E + 32 * I_W2E;
    for (int it = gw; it < NITEMS; it += NGW) {
        int r = it;
        if (r < I_WIN) { transpose_item(F.a->in[4], 1024, 6872, (bf16_t*)(F.ws + WS_WIN), MapWin(), scr, r / (NPROJ / 64), r % (NPROJ / 64), F.lane, nullptr); continue; } r -= I_WIN;
        if (PROJ_FP8) { if (r < I_WIN) { transpose_item<MapWin, true>(F.a->in[4], 1024, 6872, (bf16_t*)(F.ws + WS_WIN8), MapWin(), scr, r / (NPROJ / 64), r % (NPROJ / 64), F.lane, nullptr); continue; } r -= I_WIN; }
        if (r < I_SQ) { if (PA_FP8) transpose_item<MapIdent, true>(F.a->in[15], 1024, 1024, (bf16_t*)(F.ws + WS_WPA8), MapIdent(), scr, r / 16, r % 16, F.lane, nullptr);
                         else transpose_item(F.a->in[15], 1024, 1024, (bf16_t*)(F.ws + WS_WPA), MapIdent(), scr, r / 16, r % 16, F.lane, nullptr); continue; } r -= I_SQ;
        if (r < I_SQ) { if (PB_FP8) transpose_item<MapIdent, true>(F.a->in[16], 1024, 1024, (bf16_t*)(F.ws + WS_WPB8), MapIdent(), scr, r / 16, r % 16, F.lane, F.a->in[14]);
                         else transpose_item(F.a->in[16], 1024, 1024, (bf16_t*)(F.ws + WS_WPB), MapIdent(), scr, r / 16, r % 16, F.lane, F.a->in[14]); continue; } r -= I_SQ;
        if (r < I_SQ) { transpose_item(F.a->in[17], 1024, 1024, (bf16_t*)(F.ws + WS_WOUT), MapIdent(), scr, r / 16, r % 16, F.lane, nullptr); continue; } r -= I_SQ;
        if (r < 32 * I_W1E) { const int e = r / I_W1E, q = r % I_W1E; transpose_item<MapW1, MOE_FP8 != 0>(F.a->in[22] + (size_t)e * 1024 * 2048, 1024, 2048, (bf16_t*)(F.ws + WS_W1 + (size_t)e * 2048 * MOE_RB), MapW1(), scr, q / 32, q % 32, F.lane, nullptr); continue; } r -= 32 * I_W1E;
        { const int e = r / I_W2E, q = r % I_W2E; transpose_item<MapIdent, MOE_FP8 != 0>(F.a->in[24] + (size_t)e * 1024 * 1024, 1024, 1024, (bf16_t*)(F.ws + WS_W2 + (size_t)e * 1024 * MOE_RB), MapIdent(), scr, q / 16, q % 16, F.lane, nullptr); }
    }
}

__device__ __forceinline__ void ph_ln1(Frame& F) {
    const float* x = F.a->in[0]; const float* MOD = (const float*)(F.ws + WS_MOD); bf16_t* U = (bf16_t*)(F.outb + OUT_U);
    const int gw = F.bid * NWAVES + F.wave, NGW = F.G * NWAVES;
    constexpr int RB = 4;
    for (int m0 = gw; m0 < NTOK; m0 += NGW * RB) {
        f32x4 v[RB][4];
#pragma unroll
        for (int r = 0; r < RB; ++r) { const f32x4* xr = (const f32x4*)(x + (size_t)(m0 + r * NGW) * D) + F.lane;
#pragma unroll
            for (int j = 0; j < 4; ++j) v[r][j] = xr[64 * j]; }
#pragma unroll
        for (int r = 0; r < RB; ++r) { const int m = m0 + r * NGW; const float* md = MOD + (size_t)(m >> 11) * 6144;
            float s = 0.f;
#pragma unroll
            for (int j = 0; j < 4; ++j) s += (v[r][j][0] + v[r][j][1]) + (v[r][j][2] + v[r][j][3]);
            const float mean = wave_sum(s) * (1.f / D); float s2 = 0.f;
#pragma unroll
            for (int j = 0; j < 4; ++j) { v[r][j] = v[r][j] - mean; s2 += (v[r][j][0] * v[r][j][0] + v[r][j][1] * v[r][j][1]) + (v[r][j][2] * v[r][j][2] + v[r][j][3] * v[r][j][3]); }
            const float rstd = 1.f / sqrtf(wave_sum(s2) * (1.f / D) + LN_EPS);
            u32x2* o8 = (u32x2*)(U + (size_t)m * D) + F.lane;
#pragma unroll
            for (int j = 0; j < 4; ++j) { const f32x4 sh = *((const f32x4*)md + F.lane + 64 * j), sc = *((const f32x4*)(md + 1024) + F.lane + 64 * j);
                const f32x4 rr = v[r][j] * rstd * (sc + 1.0f) + sh; u32x2 w; w.x = cvt_pk_bf16(rr[0], rr[1]); w.y = cvt_pk_bf16(rr[2], rr[3]); o8[64 * j] = w;
                if (PROJ_FP8) { int pk = 0; pk = __builtin_amdgcn_cvt_pk_fp8_f32(rr[0], rr[1], pk, false); pk = __builtin_amdgcn_cvt_pk_fp8_f32(rr[2], rr[3], pk, true); ((unsigned*)(F.ws + WS_U8 + (size_t)m * D))[F.lane + 64 * j] = (unsigned)pk; } } }
    }
}

__device__ __forceinline__ void ph_misc(Frame& F) {
    const float* MISC = (const float*)(F.outb + OUT_MISC);
    bf16_t* KV = (bf16_t*)(F.outb + OUT_KV); bf16_t* IK = (bf16_t*)(F.outb + OUT_IK); float* IW = (float*)(F.outb + OUT_IW); float* DT = (float*)(F.outb + OUT_DT);
    const float* kvw = F.a->in[5]; const float* ikw = F.a->in[6]; const float* ikb = F.a->in[7]; const float* dtb = F.a->in[11];
    const int gw = F.bid * NWAVES + F.wave, NGW = F.G * NWAVES, l = F.lane;
    for (int m0 = gw; m0 < NTOK; m0 += NGW * 4) {
      f32x4 vv[4];
#pragma unroll
      for (int r = 0; r < 4; ++r) vv[r] = *((const f32x4*)(MISC + (size_t)(m0 + r * NGW) * 256) + l);
#pragma unroll
      for (int r = 0; r < 4; ++r) { const int m = m0 + r * NGW;
        const f32x4 v = vv[r];
        const float sq = v[0] * v[0] + v[1] * v[1] + v[2] * v[2] + v[3] * v[3], sm = (v[0] + v[1]) + (v[2] + v[3]);
        const float kvss = wave_sum(l < 32 ? sq : 0.f);
        const float iks = wave_sum((l >= 32 && l < 48) ? sm : 0.f);
        const float ikmean = iks * (1.f / 64.f);
        const f32x4 dv = v - ikmean;
        const float ikq = wave_sum((l >= 32 && l < 48) ? (dv[0] * dv[0] + dv[1] * dv[1] + dv[2] * dv[2] + dv[3] * dv[3]) : 0.f);
        if (l < 32) { const float r = 1.f / sqrtf(kvss * (1.f / 128.f) + LN_EPS); const f32x4 w = *((const f32x4*)kvw + l); const f32x4 o = v * r * w;
            u32x2 pk; pk.x = cvt_pk_bf16(o[0], o[1]); pk.y = cvt_pk_bf16(o[2], o[3]); *((u32x2*)(KV + (size_t)m * 128) + l) = pk; }
        else if (l < 48) { const float r = 1.f / sqrtf(ikq * (1.f / 64.f) + LN_EPS); const f32x4 w = *((const f32x4*)ikw + (l - 32)), bb = *((const f32x4*)ikb + (l - 32)); const f32x4 o = dv * r * w + bb;
            u32x2 pk; pk.x = cvt_pk_bf16(o[0], o[1]); pk.y = cvt_pk_bf16(o[2], o[3]); *((u32x2*)(IK + (size_t)m * 64) + (l - 32)) = pk; }
        else if (l < 50) { *((f32x4*)(IW + (size_t)m * 8) + (l - 48)) = v * 0.35355339059327373f; }
        else if (l < 54) { const f32x4 bb = *((const f32x4*)dtb + (l - 50)); f32x4 o;
#pragma unroll
            for (int j = 0; j < 4; ++j) { const float t = v[j] + bb[j]; o[j] = t > 20.f ? t : log1pf(__expf(t)); }
            *((f32x4*)(DT + (size_t)m * 16) + (l - 50)) = o; }
      }
    }
}

__device__ __forceinline__ unsigned sortable_key(float s) { const unsigned u = __float_as_uint(s + 0.0f); return (u & 0x80000000u) ? ~u : (u | 0x80000000u); }
template <int NKB> struct KeyRow { unsigned k[NKB]; };
__device__ __forceinline__ u64 low_bits_keep(u64 m, int t) { u64 out = 0; while (t-- > 0 && m) { const u64 b = m & (0 - m); out |= b; m ^= b; } return out; }
namespace idx { constexpr int KST = 144, KBUF = 64 * KST; }
__device__ __forceinline__ unsigned low_bits_keep32(unsigned m, int t) { unsigned out = 0; while (t-- > 0 && m) { const unsigned b = m & (0u - m); out |= b; m ^= b; } return out; }
template <int NG> __device__ __forceinline__ void topk2_select_write(const unsigned (&key)[64], int nkb, u64* mrow, int lane) {
    constexpr int NR = NG * 16;
    unsigned T0 = 0u, T1 = 0u; bool ex0 = false, ex1 = false;
    unsigned lo0 = 0u, lo1 = 0u, hi0 = 0xFFFFFFFFu, hi1 = 0xFFFFFFFFu, st0, st1, p0, p1; bool fin0 = false, fin1 = false;
    { float sm = 0.f, sq = 0.f;
#pragma unroll
        for (int m = 0; m < 10; ++m) { const unsigned k = key[m]; const float f = __uint_as_float((k & 0x80000000u) ? (k ^ 0x80000000u) : ~k); sm += f; sq += f * f; }
#pragma unroll
        for (int o = 1; o < 32; o <<= 1) { sm += __shfl_xor(sm, o); sq += __shfl_xor(sq, o); }
        const float mu = sm * (1.f / 320.f), sd = sqrtf(fmaxf(sq * (1.f / 320.f) - mu * mu, 1e-20f));
        const float qq = 256.f / (64.f * (float)nkb), pp = qq < 0.5f ? qq : 1.f - qq, tt = sqrtf(-2.f * __logf(pp));
        float z = tt - (2.515517f + 0.802853f * tt + 0.010328f * tt * tt) / (1.f + 1.432788f * tt + 0.189269f * tt * tt + 0.001308f * tt * tt * tt); if (qq >= 0.5f) z = -z;
        const unsigned pe = sortable_key(mu + z * sd), pd = sortable_key(mu + z * sd + 0.125f * sd);
        unsigned stp = pd - pe; if (stp < 1024u) stp = 1024u;
        p0 = __builtin_amdgcn_readlane((int)pe, 0); p1 = __builtin_amdgcn_readlane((int)pe, 32); st0 = __builtin_amdgcn_readlane((int)stp, 0); st1 = __builtin_amdgcn_readlane((int)stp, 32); }
#pragma nounroll
    for (int it = 0; it < 80; ++it) {
        const unsigned candv = lane < 32 ? p0 : p1;
        unsigned cl = 0u;
#pragma unroll
        for (int m = 0; m < NR; m += 4) { u64 s0, s1, s2, s3;
            asm("v_cmp_ge_u32_e64 %1, %5, %9\n\tv_cmp_ge_u32_e64 %2, %6, %9\n\tv_cmp_ge_u32_e64 %3, %7, %9\n\tv_cmp_ge_u32_e64 %4, %8, %9\n\t"
                "v_addc_co_u32_e64 %0, %1, 0, %0, %1\n\tv_addc_co_u32_e64 %0, %2, 0, %0, %2\n\tv_addc_co_u32_e64 %0, %3, 0, %0, %3\n\tv_addc_co_u32_e64 %0, %4, 0, %0, %4"
                : "+v"(cl), "=&s"(s0), "=&s"(s1), "=&s"(s2), "=&s"(s3) : "v"(key[m]), "v"(key[m + 1]), "v"(key[m + 2]), "v"(key[m + 3]), "v"(candv)); }
        cl += __shfl_xor(cl, 1); cl += __shfl_xor(cl, 2); cl += __shfl_xor(cl, 4); cl += __shfl_xor(cl, 8); cl += __shfl_xor(cl, 16);
        const int n0 = __builtin_amdgcn_readlane((int)cl, 0), n1 = __builtin_amdgcn_readlane((int)cl, 32);
#define IDX_STEP(lo, hi, st, p, T, ex, fin, n) do { if (!fin) { \
            if (n == 256) { T = p; ex = true; fin = true; } \
            else { if (n > 256) lo = p; else hi = p; \
                if (hi - lo <= 1u) { T = lo; fin = true; } \
                else { unsigned c; if (hi == 0xFFFFFFFFu) { c = lo + st; if (c < lo) c = hi; st = st << 1; } else if (lo == 0u) { c = hi - st; if (c > hi) c = lo; st = st << 1; } else c = lo + ((hi - lo) >> 1); \
                    if (c <= lo || c >= hi) c = lo + ((hi - lo) >> 1); p = c; } } } } while (0)
        IDX_STEP(lo0, hi0, st0, p0, T0, ex0, fin0, n0);
        IDX_STEP(lo1, hi1, st1, p1, T1, ex1, fin1, n1);
#undef IDX_STEP
        if (fin0 && fin1) break;
    }
    const unsigned Tv = lane < 32 ? T0 : T1;
    if (ex0 && ex1) {
        unsigned mlo = 0u, mhi = 0u;
#pragma unroll
        for (int j = 0; j < NR / 2; ++j) {
            const u64 b0 = __ballot(key[2 * j] >= Tv), b1 = __ballot(key[2 * j + 1] >= Tv);
            asm volatile("s_nop 1\n\tv_writelane_b32 %0, %2, %6\n\tv_writelane_b32 %0, %3, %7\n\tv_writelane_b32 %1, %4, %6\n\tv_writelane_b32 %1, %5, %7"
                         : "+v"(mlo), "+v"(mhi) : "s"((unsigned)b0), "s"((unsigned)(b0 >> 32)), "s"((unsigned)b1), "s"((unsigned)(b1 >> 32)), "n"(j), "n"(32 + j));
            if ((j & 3) == 3) SBAR();
        }
        const int jl = lane & 31;
        if (jl < nkb) mrow[(lane >> 5) * 32 + jl] = (u64)mlo | ((u64)mhi << 32);
        return;
    }
    int rem0 = 1 << 30, rem1 = 1 << 30;
    { int g0 = 0, g1 = 0;
#pragma unroll
        for (int m = 0; m < NR; ++m) { const u64 mk = __ballot(key[m] > Tv); g0 += __builtin_popcount((unsigned)mk); g1 += __builtin_popcount((unsigned)(mk >> 32)); if ((m & 7) == 7) SBAR(); }
        if (!ex0) rem0 = 256 - g0; if (!ex1) rem1 = 256 - g1; }
    u64 mine = 0ull;
#pragma nounroll
    for (int jq = 0; jq < NR / 8; ++jq) {
#pragma unroll
        for (int jj = 0; jj < 4; ++jj) { const int j = jq * 4 + jj;
            unsigned w0[2], w1[2];
#pragma unroll
            for (int hh = 0; hh < 2; ++hh) { unsigned kv = 0u;
#pragma unroll
                for (int m = 0; m < NR; ++m) if ((m >> 3) == 0) {}
#pragma unroll
                for (int m = 0; m < NR; ++m) kv = (m == 2 * j + hh) ? key[m] : kv;
                const u64 gt = __ballot(kv > Tv), eq = __ballot(kv == Tv);
                { const unsigned e = (unsigned)eq, g = (unsigned)gt; const int ne = __builtin_popcount(e); unsigned sel = g; if (rem0 >= ne) { sel |= e; rem0 -= ne; } else if (rem0 > 0) { sel |= low_bits_keep32(e, rem0); rem0 = 0; } w0[hh] = sel; }
                { const unsigned e = (unsigned)(eq >> 32), g = (unsigned)(gt >> 32); const int ne = __builtin_popcount(e); unsigned sel = g; if (rem1 >= ne) { sel |= e; rem1 -= ne; } else if (rem1 > 0) { sel |= low_bits_keep32(e, rem1); rem1 = 0; } w1[hh] = sel; } }
            const u64 q0w = (u64)w0[0] | ((u64)w0[1] << 32), q1w = (u64)w1[0] | ((u64)w1[1] << 32);
            if (lane == j) mine = q0w; if (lane == 32 + j) mine = q1w; }
    }
    const int jl = lane & 31;
    if (jl < nkb) mrow[(lane >> 5) * 32 + jl] = mine;
}
template <int J0> __device__ __forceinline__ void index_scores8(unsigned (&key)[64], const bf16x8 (&af)[2], const f32x4& iw4, const bf16_t* kvsrc, char* lds, int nkb, u32x4 (&stg)[8], int tid) {
    const int lane = tid & 63, sub = lane & 15, kg = lane >> 4;
#pragma unroll
    for (int jj = 0; jj < 8; ++jj) {
        const int j = J0 + jj;
        if (j < nkb) {
            if (j + 1 < nkb) *(u32x4*)(lds + ((j + 1) & 1) * idx::KBUF + (tid >> 3) * idx::KST + (tid & 7) * 16) = stg[(jj + 1) & 7];
            if (j + 8 < nkb) stg[jj] = *(const u32x4*)(kvsrc + (size_t)(j + 8) * 64 * 64);
            const char* kb = lds + (j & 1) * idx::KBUF + sub * idx::KST + kg * 16;
#pragma unroll
            for (int pr = 0; pr < 2; ++pr) {
                f32x4 dA = (f32x4){0.f, 0.f, 0.f, 0.f}, dB = dA;
#pragma unroll
                for (int ks = 0; ks < 2; ++ks) {
                    const bf16x8 fA = *(const bf16x8*)(kb + (pr * 32) * idx::KST + ks * 64), fB = *(const bf16x8*)(kb + (pr * 32 + 16) * idx::KST + ks * 64);
                    dA = __builtin_amdgcn_mfma_f32_16x16x32_bf16(af[ks], fA, dA, 0, 0, 0); dB = __builtin_amdgcn_mfma_f32_16x16x32_bf16(af[ks], fB, dB, 0, 0, 0); }
                float pA = 0.f, pB = 0.f;
#pragma unroll
                for (int r = 0; r < 4; ++r) { pA += fmaxf(dA[r], 0.f) * iw4[r]; pB += fmaxf(dB[r], 0.f) * iw4[r]; }
                auto rr = __builtin_amdgcn_permlane16_swap(__float_as_uint(pA), __float_as_uint(pB), false, false);
                key[2 * j + pr] = sortable_key(__uint_as_float(rr[0]) + __uint_as_float(rr[1]));
            }
            __syncthreads();
        }
    }
}
__device__ __forceinline__ void ph_index(Frame& F) {
    const bf16_t* IQ = (const bf16_t*)(F.outb + OUT_IQ); const bf16_t* IK = (const bf16_t*)(F.outb + OUT_IK); const float* IW = (const float*)(F.outb + OUT_IW);
    u64* MASK = (u64*)(F.outb + OUT_MASK);
    char* lds = (char*)(unsigned char*)F.lds;
    const int tid = F.tid, lane = F.lane, sub = lane & 15, kg = lane >> 4;
    for (int item = F.bid; item < NTOK / 16; item += F.G) {
        const int tokw = (((item & 255) >> 3) << 11) + (((item & 7) + 8 * (item >> 8)) << 4) + F.wave * 2, b = tokw >> 11, pos0 = tokw & 2047, nkb = (pos0 >> 6) + 1;
        u64* mrow = MASK + (size_t)tokw * 32;
        if (nkb <= 4) { if ((lane & 31) < nkb) mrow[(lane >> 5) * 32 + (lane & 31)] = ~0ull; continue; }
        bf16x8 af[2];
        { const bf16_t* ap = IQ + (size_t)(tokw + (sub >> 3)) * 512 + (sub & 7) * 64 + kg * 8;
#pragma unroll
          for (int ks = 0; ks < 2; ++ks) af[ks] = *(const bf16x8*)(ap + ks * 32); }
        const f32x4 iw4 = *(const f32x4*)(IW + (size_t)(tokw + (lane >> 5)) * 8 + 4 * (kg & 1));
        unsigned key[64];
#pragma unroll
        for (int m = 0; m < 64; ++m) key[m] = 0u;
        const bf16_t* kvsrc = IK + ((size_t)b * SEQ + (tid >> 3)) * 64 + (tid & 7) * 8;
        u32x4 stg[8];
#pragma unroll
        for (int i = 0; i < 8; ++i) stg[i] = (i < nkb) ? *(const u32x4*)(kvsrc + (size_t)i * 64 * 64) : (u32x4){0u, 0u, 0u, 0u};
        __syncthreads();
        *(u32x4*)(lds + (tid >> 3) * idx::KST + (tid & 7) * 16) = stg[0];
        __syncthreads();
        const int ng = (nkb + 7) >> 3;
        index_scores8<0>(key, af, iw4, kvsrc, lds, nkb, stg, tid);
        if (ng > 1) index_scores8<8>(key, af, iw4, kvsrc, lds, nkb, stg, tid);
        if (ng > 2) index_scores8<16>(key, af, iw4, kvsrc, lds, nkb, stg, tid);
        if (ng > 3) index_scores8<24>(key, af, iw4, kvsrc, lds, nkb, stg, tid);
        if (ng == 1) topk2_select_write<1>(key, nkb, mrow, lane);
        else if (ng == 2) topk2_select_write<2>(key, nkb, mrow, lane);
        else if (ng == 3) topk2_select_write<3>(key, nkb, mrow, lane);
        else topk2_select_write<4>(key, nkb, mrow, lane);
    }
}

namespace att {
constexpr int KVBLK = 64;
constexpr int SHM_V = KVBLK * 128 * 2, SHM_K = SHM_V;
constexpr int OFF_V = 0, OFF_K = 2 * SHM_V, OFF_WS = 2 * SHM_V + 2 * SHM_K, OFF_BT = OFF_WS + NWAVES * 64 * 4;
#define KSWZ(row, colB) ((row) * 256 + ((colB) ^ (((row) & 7) << 4)))
__device__ __forceinline__ int crow(int r, int hi) { return (r & 3) + 8 * (r >> 2) + 4 * hi; }
__device__ __forceinline__ int v_st(int k, int c) { const int kk = (k & ~0xC) | ((k & 4) << 1) | ((k & 8) >> 1); return ((kk >> 3) * 4 + (c >> 5)) * 512 + ((kk & 7) * 32 + (c & 31)) * 2; }
__device__ __forceinline__ int v_rd_base(int lane) { return ((lane & 3) << 3) | (((lane >> 2) & 3) << 6) | (((lane >> 4) & 1) << 5) | (((lane >> 5) & 1) << 8); }
constexpr int v_rd_off(int d0, int ks, int half) { return d0 * 512 + ks * 4096 + half * 2048; }
template <int OFF> __device__ __forceinline__ s16x4 tr_read(int vb) { s16x4 r; asm volatile("ds_read_b64_tr_b16 %0, %1 offset:%2" : "=&v"(r) : "v"(vb), "i"(OFF) : "memory"); return r; }
template <int D0> __device__ __forceinline__ void pv_one(f32x16& od, int vb, bf16x8 pa0, bf16x8 pa1, bf16x8 pa2, bf16x8 pa3) {
    const s16x4 l0 = tr_read<v_rd_off(D0, 0, 0)>(vb), h0 = tr_read<v_rd_off(D0, 0, 1)>(vb), l1 = tr_read<v_rd_off(D0, 1, 0)>(vb), h1 = tr_read<v_rd_off(D0, 1, 1)>(vb);
    const s16x4 l2 = tr_read<v_rd_off(D0, 2, 0)>(vb), h2 = tr_read<v_rd_off(D0, 2, 1)>(vb), l3 = tr_read<v_rd_off(D0, 3, 0)>(vb), h3 = tr_read<v_rd_off(D0, 3, 1)>(vb);
    asm volatile("s_waitcnt lgkmcnt(0)" ::: "memory"); SBAR();
#define PK(L, H) (bf16x8){L[0], L[1], L[2], L[3], H[0], H[1], H[2], H[3]}
    od = __builtin_amdgcn_mfma_f32_32x32x16_bf16(pa0, PK(l0, h0), od, 0, 0, 0);
    od = __builtin_amdgcn_mfma_f32_32x32x16_bf16(pa1, PK(l1, h1), od, 0, 0, 0);
    od = __builtin_amdgcn_mfma_f32_32x32x16_bf16(pa2, PK(l2, h2), od, 0, 0, 0);
    od = __builtin_amdgcn_mfma_f32_32x32x16_bf16(pa3, PK(l3, h3), od, 0, 0, 0);
#undef PK
}
__device__ __forceinline__ void qkt(f32x16& p0, f32x16& p1, const char* Ks, const bf16x8* qr, int r32, int hi) {
    p0 = f32x16{}; p1 = f32x16{};
    int rv = r32; asm volatile("" : "+v"(rv));
    const char* kb = Ks + rv * 256; const int swz = ((rv & 7) << 4) ^ (hi * 16);
#pragma unroll
    for (int d0 = 0; d0 < 8; ++d0) { const char* ka = kb + ((d0 * 32) ^ swz);
        const bf16x8 b0 = *reinterpret_cast<const bf16x8*>(ka);
        const bf16x8 b1 = *reinterpret_cast<const bf16x8*>(ka + 8192);
        p0 = __builtin_amdgcn_mfma_f32_32x32x16_bf16(b0, qr[d0], p0, 0, 0, 0);
        p1 = __builtin_amdgcn_mfma_f32_32x32x16_bf16(b1, qr[d0], p1, 0, 0, 0); }
}
__device__ __forceinline__ void attn_item(Frame& F, int b, int q0, char* lds) {
    const bf16_t* Q = (const bf16_t*)(F.ws + WS_Q); const bf16_t* KV = (const bf16_t*)(F.outb + OUT_KV); const u64* MASK = (const u64*)(F.outb + OUT_MASK);
    bf16_t* OA = (bf16_t*)(F.outb + OUT_OA);
    int tid = F.tid; asm volatile("" : "+v"(tid));
    const int wid = F.wave, lane = tid & 63, r32 = lane & 31, hi = lane >> 5;
    char* V_lds = lds + OFF_V; char* K_lds = lds + OFF_K;
    float* wsl = (float*)(lds + OFF_WS) + wid * 64; float* li_l = wsl; float* al_l = wsl + 32;
    const float* btab = (const float*)(lds + OFF_BT);
    constexpr float C = 0.088388347648318440f * LOG2E;
    float m_reg = -1e30f, l_reg = 0.f; f32x16 o[4] = {}; bf16x8 qr[8];
    const size_t tokq = (size_t)b * SEQ + q0 + r32;
    { const bf16_t* Qw = Q + tokq * 1024 + wid * 128 + hi * 8;
#pragma unroll
      for (int d0 = 0; d0 < 8; ++d0) qr[d0] = *(const bf16x8*)(Qw + d0 * 16); }
    const u64* mq = MASK + tokq * 32;
    const int sr = tid >> 4, sc = (tid & 15) * 8;
    const int vb0 = (int)(uintptr_t)V_lds + v_rd_base(lane);
    const bf16_t* Kb = KV + (size_t)b * SEQ * 128;
    const int NT = (q0 >> 6) + 1;
    const float bfar = btab[wid];
    bf16x8 s0, s1;
#define SLOAD(k0) do { s0 = *(const bf16x8*)(Kb + (size_t)((k0) + sr) * 128 + sc); s1 = *(const bf16x8*)(Kb + (size_t)((k0) + 32 + sr) * 128 + sc); } while (0)
#define SWRITE(bf) do { int srv = sr; asm volatile("" : "+v"(srv)); const int kc = sc * 2; const int v0a = v_st(srv, sc), k0a = KSWZ(srv, kc); \
        *(bf16x8*)(V_lds + (bf) * SHM_V + v0a) = s0; *(bf16x8*)(V_lds + (bf) * SHM_V + v0a + 8192) = s1; \
        *(bf16x8*)(K_lds + (bf) * SHM_K + k0a) = s0; *(bf16x8*)(K_lds + (bf) * SHM_K + k0a + 8192) = s1; } while (0)
    __syncthreads();
    SLOAD(0); VM_WAIT(); SWRITE(0); __syncthreads();
    u64 mw_next = mq[0];
    for (int j = 0; j < NT; ++j) {
        int lanel = lane; asm volatile("" : "+v"(lanel)); const int r32l = lanel & 31, hil = lanel >> 5;
        const int bf = j & 1;
        if (j + 1 < NT) SLOAD((j + 1) * KVBLK);
        const u64 mw = mw_next; if (j + 1 < NT) mw_next = mq[j + 1];
        f32x16 p0, p1;
        qkt(p0, p1, K_lds + bf * SHM_K, qr, r32l, hil);
        const unsigned w0 = (unsigned)(mw >> (4 * hil)), w1 = (unsigned)(mw >> (32 + 4 * hil));
        const int relmax = j * KVBLK + 63 - q0;
        float alpha = 1.f, ps = 0.f;
        if (relmax <= -91) {
            float pmax = p0[0];
#pragma unroll
            for (int r = 1; r < 16; ++r) pmax = fmaxf(pmax, p0[r]);
#pragma unroll
            for (int r = 0; r < 16; ++r) pmax = fmaxf(pmax, p1[r]);
            { auto rr = __builtin_amdgcn_permlane32_swap(__float_as_uint(pmax), __float_as_uint(pmax), false, false); pmax = fmaxf(__uint_as_float(rr[0]), __uint_as_float(rr[1])); }
            pmax = fmaf(pmax, C, bfar);
            if (!__all(pmax - m_reg <= 11.0f)) { const float mn = fmaxf(m_reg, pmax); alpha = __builtin_amdgcn_exp2f(m_reg - mn); m_reg = mn; }
            const float off = bfar - m_reg;
#pragma unroll
            for (int r = 0; r < 16; ++r) { const int cb = (r & 3) + 8 * (r >> 2);
                const float e0 = __builtin_amdgcn_exp2f(fmaf(p0[r], C, off)), e1 = __builtin_amdgcn_exp2f(fmaf(p1[r], C, off));
                p0[r] = __uint_as_float(__float_as_uint(e0) & (unsigned)__builtin_amdgcn_sbfe((int)w0, cb, 1)); p1[r] = __uint_as_float(__float_as_uint(e1) & (unsigned)__builtin_amdgcn_sbfe((int)w1, cb, 1)); ps += p0[r] + p1[r]; }
        } else {
            const float* bp = btab + (j * KVBLK + 4 * hil - (q0 + r32l) + 185) * 8 + wid;
#pragma unroll
            for (int r4 = 0; r4 < 4; ++r4) {
#pragma unroll
                for (int rr = 0; rr < 4; ++rr) { const int r = r4 * 4 + rr; const int cb = (r & 3) + 8 * (r >> 2); p0[r] = fmaf(p0[r], C, bp[cb * 8]); p1[r] = fmaf(p1[r], C, bp[(cb + 32) * 8]); }
                SBAR(); }
            float pmax = p0[0];
#pragma unroll
            for (int r = 1; r < 16; ++r) pmax = fmaxf(pmax, p0[r]);
#pragma unroll
            for (int r = 0; r < 16; ++r) pmax = fmaxf(pmax, p1[r]);
            { auto rr = __builtin_amdgcn_permlane32_swap(__float_as_uint(pmax), __float_as_uint(pmax), false, false); pmax = fmaxf(__uint_as_float(rr[0]), __uint_as_float(rr[1])); }
            if (!__all(pmax - m_reg <= 11.0f)) { const float mn = fmaxf(m_reg, pmax); alpha = __builtin_amdgcn_exp2f(m_reg - mn); m_reg = mn; }
#pragma unroll
            for (int r = 0; r < 16; ++r) { const int cb = (r & 3) + 8 * (r >> 2);
                const float e0 = __builtin_amdgcn_exp2f(p0[r] - m_reg), e1 = __builtin_amdgcn_exp2f(p1[r] - m_reg);
                p0[r] = __uint_as_float(__float_as_uint(e0) & (unsigned)__builtin_amdgcn_sbfe((int)w0, cb, 1)); p1[r] = __uint_as_float(__float_as_uint(e1) & (unsigned)__builtin_amdgcn_sbfe((int)w1, cb, 1)); ps += p0[r] + p1[r]; }
        }
        { auto rr = __builtin_amdgcn_permlane32_swap(__float_as_uint(ps), __float_as_uint(ps), false, false); ps = __uint_as_float(rr[0]) + __uint_as_float(rr[1]); }
        l_reg = l_reg * alpha + ps;
        bf16x8 pa0, pa1, pa2, pa3;
#define PK4(P, BASE, OUT) do { unsigned a0 = cvt_pk_bf16(P[BASE + 0], P[BASE + 1]), a1 = cvt_pk_bf16(P[BASE + 2], P[BASE + 3]);   \
    unsigned b0 = cvt_pk_bf16(P[BASE + 4], P[BASE + 5]), b1 = cvt_pk_bf16(P[BASE + 6], P[BASE + 7]);                              \
    auto r0 = __builtin_amdgcn_permlane32_swap(a0, b0, false, false); auto r1 = __builtin_amdgcn_permlane32_swap(a1, b1, false, false); \
    u32x4 w = {r0[0], r1[0], r0[1], r1[1]}; OUT = *reinterpret_cast<bf16x8*>(&w); } while (0)
        PK4(p0, 0, pa0); PK4(p0, 8, pa1); PK4(p1, 0, pa2); PK4(p1, 8, pa3);
#undef PK4
        if (__any(alpha < 1.f)) { if (hil == 0) al_l[r32l] = alpha; LDS_WAIT();
#pragma unroll
            for (int d = 0; d < 4; ++d)
#pragma unroll
                for (int r = 0; r < 16; ++r) o[d][r] *= al_l[crow(r, hil)]; }
        const int vb = (int)(uintptr_t)V_lds + v_rd_base(lanel) + bf * SHM_V;
        pv_one<0>(o[0], vb, pa0, pa1, pa2, pa3); pv_one<1>(o[1], vb, pa0, pa1, pa2, pa3); pv_one<2>(o[2], vb, pa0, pa1, pa2, pa3); pv_one<3>(o[3], vb, pa0, pa1, pa2, pa3);
        if (j + 1 < NT) { VM_WAIT(); SWRITE(bf ^ 1); }
        __syncthreads();
    }
#undef SLOAD
#undef SWRITE
    if (hi == 0) li_l[r32] = l_reg; LDS_WAIT();
    bf16_t* Ow = OA + ((size_t)b * SEQ + q0 + 4 * hi) * 1024 + wid * 128 + r32;
    const float* lip = li_l + 4 * hi;
    unsigned char* Ow8 = (unsigned char*)OA + ((size_t)b * SEQ + q0 + 4 * hi) * 1024 + wid * 128 + r32;
    asm volatile("" : "+v"(Ow), "+v"(lip), "+v"(Ow8));
#pragma unroll
    for (int r = 0; r < 16; ++r) { const int ro = (r & 3) + 8 * (r >> 2); if ((r & 3) == 0) asm volatile("" : "+v"(Ow), "+v"(Ow8), "+v"(lip)); const float rl = fast_rcp(lip[ro]);
#pragma unroll
        for (int d0 = 0; d0 < 4; ++d0) { float v = o[d0][r] * rl; if ((DBG_ATTN_ZERO == 1 && q0 < 256) || (DBG_ATTN_ZERO == 2 && q0 >= 256)) v = 0.f;
            if (PA_FP8) ((unsigned char*)Ow8)[ro * 1024 + d0 * 32] = (unsigned char)(__builtin_amdgcn_cvt_pk_fp8_f32(v, v, 0, false) & 0xff);
            else Ow[ro * 1024 + d0 * 32] = (bf16_t)(cvt_pk_bf16(v, v) & 0xffffu); }
        if ((r & 3) == 3) SBAR(); }
}
__device__ __forceinline__ void att2_partial(f32x16& p0, f32x16& p1, float& m_reg, float& alpha, unsigned w0, bool far, float bfar, const float* bp) {
    constexpr float C = 0.088388347648318440f * LOG2E;
    float off;
    if (far) {
        float pmax = p0[0];
#pragma unroll
        for (int r = 1; r < 16; ++r) pmax = fmaxf(pmax, p0[r]);
#pragma unroll
        for (int r = 0; r < 16; ++r) pmax = fmaxf(pmax, p1[r]);
        { auto rr = __builtin_amdgcn_permlane32_swap(__float_as_uint(pmax), __float_as_uint(pmax), false, false); pmax = fmaxf(__uint_as_float(rr[0]), __uint_as_float(rr[1])); }
        pmax = fmaf(pmax, C, bfar);
        if (__builtin_expect(__all(pmax - m_reg <= 11.0f), 1)) alpha = 1.f; else { const float mn = fmaxf(m_reg, pmax); alpha = __builtin_amdgcn_exp2f(m_reg - mn); m_reg = mn; }
        off = bfar - m_reg;
#pragma unroll
        for (int r = 0; r < 16; ++r) { p0[r] = fmaf(p0[r], C, off); p1[r] = fmaf(p1[r], C, off); }
    } else {
#pragma unroll
        for (int r4 = 0; r4 < 4; ++r4) {
#pragma unroll
            for (int rr = 0; rr < 4; ++rr) { const int r = r4 * 4 + rr; const int cb = (r & 3) + 8 * (r >> 2); p0[r] = fmaf(p0[r], C, bp[cb * 8]); p1[r] = fmaf(p1[r], C, bp[(cb + 32) * 8]); }
            SBAR(); }
        float pmax = p0[0];
#pragma unroll
        for (int r = 1; r < 16; ++r) pmax = fmaxf(pmax, p0[r]);
#pragma unroll
        for (int r = 0; r < 16; ++r) pmax = fmaxf(pmax, p1[r]);
        { auto rr = __builtin_amdgcn_permlane32_swap(__float_as_uint(pmax), __float_as_uint(pmax), false, false); pmax = fmaxf(__uint_as_float(rr[0]), __uint_as_float(rr[1])); }
        if (__builtin_expect(__all(pmax - m_reg <= 11.0f), 1)) alpha = 1.f; else { const float mn = fmaxf(m_reg, pmax); alpha = __builtin_amdgcn_exp2f(m_reg - mn); m_reg = mn; }
#pragma unroll
        for (int r = 0; r < 16; ++r) { p0[r] -= m_reg; p1[r] -= m_reg; }
    }
#pragma unroll
    for (int r = 0; r < 16; ++r) { const int cb = (r & 3) + 8 * (r >> 2); p0[r] = __uint_as_float(__float_as_uint(__builtin_amdgcn_exp2f(p0[r])) & (unsigned)__builtin_amdgcn_sbfe((int)w0, cb, 1)); }
}
__device__ __forceinline__ void att2_finish(f32x16& p0, f32x16& p1, float alpha, float& l_reg, unsigned w1, bf16x8& pa0, bf16x8& pa1, bf16x8& pa2, bf16x8& pa3) {
#pragma unroll
    for (int r = 0; r < 16; ++r) { const int cb = (r & 3) + 8 * (r >> 2); p1[r] = __uint_as_float(__float_as_uint(__builtin_amdgcn_exp2f(p1[r])) & (unsigned)__builtin_amdgcn_sbfe((int)w1, cb, 1)); }
    float ps = 0.f;
#pragma unroll
    for (int r = 0; r < 16; ++r) ps += p0[r];
#pragma unroll
    for (int r = 0; r < 16; ++r) ps += p1[r];
    { auto rr = __builtin_amdgcn_permlane32_swap(__float_as_uint(ps), __float_as_uint(ps), false, false); ps = __uint_as_float(rr[0]) + __uint_as_float(rr[1]); }
    l_reg = l_reg * alpha + ps;
#define PK4(P, BASE, OUT) do { unsigned a0 = cvt_pk_bf16(P[BASE + 0], P[BASE + 1]), a1 = cvt_pk_bf16(P[BASE + 2], P[BASE + 3]);   \
    unsigned b0 = cvt_pk_bf16(P[BASE + 4], P[BASE + 5]), b1 = cvt_pk_bf16(P[BASE + 6], P[BASE + 7]);                              \
    auto r0 = __builtin_amdgcn_permlane32_swap(a0, b0, false, false); auto r1 = __builtin_amdgcn_permlane32_swap(a1, b1, false, false); \
    u32x4 w = {r0[0], r1[0], r0[1], r1[1]}; OUT = *reinterpret_cast<bf16x8*>(&w); } while (0)
    PK4(p0, 0, pa0); PK4(p0, 8, pa1); PK4(p1, 0, pa2); PK4(p1, 8, pa3);
#undef PK4
}
__device__ __forceinline__ void attn_item2(Frame& F, int b, int q0, char* lds) {
    const bf16_t* Q = (const bf16_t*)(F.ws + WS_Q); const bf16_t* KV = (const bf16_t*)(F.outb + OUT_KV); const u64* MASK = (const u64*)(F.outb + OUT_MASK);
    bf16_t* OA = (bf16_t*)(F.outb + OUT_OA);
    int tid = F.tid; asm volatile("" : "+v"(tid));
    const int wid = F.wave, lane = tid & 63, r32 = lane & 31, hi = lane >> 5;
    char* V_lds = lds + OFF_V; char* K_lds = lds + OFF_K;
    float* wsl = (float*)(lds + OFF_WS) + wid * 64; float* li_l = wsl; float* al_l = wsl + 32;
    const float* btab = (const float*)(lds + OFF_BT);
    float m_reg = -1e30f, l_reg = 0.f; f32x16 o[4] = {}; bf16x8 qr[8];
    const size_t tokq = (size_t)b * SEQ + q0 + r32;
    { const bf16_t* Qw = Q + tokq * 1024 + wid * 128 + hi * 8;
#pragma unroll
      for (int d0 = 0; d0 < 8; ++d0) qr[d0] = *(const bf16x8*)(Qw + d0 * 16); }
    const u64* mq = MASK + tokq * 32;
    const int sr = tid >> 4, sc = (tid & 15) * 8;
    const bf16_t* Kb = KV + (size_t)b * SEQ * 128;
    const int NTr = (q0 >> 6) + 1, NT = (NTr + 1) & ~1;
    const float bfar = btab[wid];
    bf16x8 sA0, sA1, sB0, sB1;
#define SLD(s0_, s1_, k0) do { int srl = sr; asm volatile("" : "+v"(srl)); const bf16_t* kp_ = Kb + (size_t)((k0) + srl) * 128 + sc; s0_ = *(const bf16x8*)kp_; s1_ = *(const bf16x8*)(kp_ + 32 * 128); } while (0)
#define SWR(bf, s0_, s1_) do { int srv = sr; asm volatile("" : "+v"(srv)); const int kc = sc * 2; const int v0a = v_st(srv, sc), k0a = KSWZ(srv, kc); \
        *(bf16x8*)(V_lds + (bf) * SHM_V + v0a) = s0_; *(bf16x8*)(V_lds + (bf) * SHM_V + v0a + 8192) = s1_; \
        *(bf16x8*)(K_lds + (bf) * SHM_K + k0a) = s0_; *(bf16x8*)(K_lds + (bf) * SHM_K + k0a + 8192) = s1_; } while (0)
#define MWORD(j) ((j) < NTr ? mq[j] : 0ull)
#define RESC(a) do { if (__any((a) < 1.f)) { if (hi == 0) al_l[r32] = (a); LDS_WAIT(); \
        _Pragma("unroll") for (int d = 0; d < 4; ++d) _Pragma("unroll") for (int r = 0; r < 16; ++r) o[d][r] *= al_l[crow(r, hi)]; } } while (0)
#define PVALL(bf) do { int ll = lane; asm volatile("" : "+v"(ll)); const int vb = (int)(uintptr_t)V_lds + v_rd_base(ll) + (bf) * SHM_V; \
        pv_one<0>(o[0], vb, pa0, pa1, pa2, pa3); pv_one<1>(o[1], vb, pa0, pa1, pa2, pa3); pv_one<2>(o[2], vb, pa0, pa1, pa2, pa3); pv_one<3>(o[3], vb, pa0, pa1, pa2, pa3); } while (0)
#define ISFAR(jt) ((jt) * KVBLK + 63 - q0 <= -91 || (jt) >= NTr)
#define BPTR(jt) (btab + ((jt) * KVBLK + 4 * hi - (q0 + r32) + 185) * 8 + wid)
    f32x16 pA0, pA1, pB0, pB1; float alA, alB; bf16x8 pa0, pa1, pa2, pa3; u64 mwA, mwB;
    __syncthreads();
    SLD(sA0, sA1, 0); mwA = MWORD(0); VM_WAIT(); SWR(0, sA0, sA1); __syncthreads();
    qkt(pA0, pA1, K_lds, qr, r32, hi);
    att2_partial(pA0, pA1, m_reg, alA, (unsigned)(mwA >> (4 * hi)), ISFAR(0), bfar, BPTR(0));
    SLD(sB0, sB1, KVBLK); mwB = MWORD(1); if (2 < NT) SLD(sA0, sA1, 2 * KVBLK);
    SWR(1, sB0, sB1); __syncthreads();
    for (int j = 1; j + 1 < NT; j += 2) {
        SBAR(); qkt(pB0, pB1, K_lds + SHM_K, qr, r32, hi);
        att2_finish(pA0, pA1, alA, l_reg, (unsigned)(mwA >> (32 + 4 * hi)), pa0, pa1, pa2, pa3); SBAR();
        SLD(sB0, sB1, (j + 2) * KVBLK); mwA = MWORD(j + 1); SBAR();
        PVALL(0);
        att2_partial(pB0, pB1, m_reg, alB, (unsigned)(mwB >> (4 * hi)), ISFAR(j), bfar, BPTR(j));
        __syncthreads(); SWR(0, sA0, sA1);
        RESC(alB); __syncthreads();
        SBAR(); qkt(pA0, pA1, K_lds, qr, r32, hi);
        att2_finish(pB0, pB1, alB, l_reg, (unsigned)(mwB >> (32 + 4 * hi)), pa0, pa1, pa2, pa3); SBAR();
        if (j + 3 < NT) SLD(sA0, sA1, (j + 3) * KVBLK); mwB = MWORD(j + 2); SBAR();
        PVALL(1);
        att2_partial(pA0, pA1, m_reg, alA, (unsigned)(mwA >> (4 * hi)), ISFAR(j + 1), bfar, BPTR(j + 1));
        __syncthreads(); SWR(1, sB0, sB1);
        RESC(alA); __syncthreads();
    }
    SBAR(); qkt(pB0, pB1, K_lds + SHM_K, qr, r32, hi);
    att2_finish(pA0, pA1, alA, l_reg, (unsigned)(mwA >> (32 + 4 * hi)), pa0, pa1, pa2, pa3); SBAR();
    PVALL(0);
    att2_partial(pB0, pB1, m_reg, alB, (unsigned)(mwB >> (4 * hi)), ISFAR(NT - 1), bfar, BPTR(NT - 1));
    __syncthreads(); RESC(alB);
    att2_finish(pB0, pB1, alB, l_reg, (unsigned)(mwB >> (32 + 4 * hi)), pa0, pa1, pa2, pa3); SBAR();
    PVALL(1);
#undef SLD
#undef SWR
#undef MWORD
#undef RESC
#undef PVALL
#undef ISFAR
#undef BPTR
    if (hi == 0) li_l[r32] = l_reg; LDS_WAIT();
    bf16_t* Ow = OA + ((size_t)b * SEQ + q0 + 4 * hi) * 1024 + wid * 128 + r32;
    const float* lip = li_l + 4 * hi;
    unsigned char* Ow8 = (unsigned char*)OA + ((size_t)b * SEQ + q0 + 4 * hi) * 1024 + wid * 128 + r32;
    asm volatile("" : "+v"(Ow), "+v"(lip), "+v"(Ow8));
#pragma unroll
    for (int r = 0; r < 16; ++r) { const int ro = (r & 3) + 8 * (r >> 2); if ((r & 3) == 0) asm volatile("" : "+v"(Ow), "+v"(Ow8), "+v"(lip)); const float rl = fast_rcp(lip[ro]);
#pragma unroll
        for (int d0 = 0; d0 < 4; ++d0) { float v = o[d0][r] * rl;
            if (PA_FP8) ((unsigned char*)Ow8)[ro * 1024 + d0 * 32] = (unsigned char)(__builtin_amdgcn_cvt_pk_fp8_f32(v, v, 0, false) & 0xff);
            else Ow[ro * 1024 + d0 * 32] = (bf16_t)(cvt_pk_bf16(v, v) & 0xffffu); }
        if ((r & 3) == 3) SBAR(); }
}
}
__device__ __forceinline__ void ph_attn(Frame& F) {
    char* lds = (char*)(unsigned char*)F.lds;
    { float* bt = (float*)(lds + att::OFF_BT); const float* BT = (const float*)(F.ws + WS_BIAST); __syncthreads(); for (int i = F.tid; i < 249 * 8; i += NTHR) bt[i] = BT[i]; __syncthreads(); }
    for (int pr = F.bid; pr < NB * 32; pr += F.G) {
        const int b = pr >> 5, qb = pr & 31;
#pragma nounroll
        for (int hh = 0; hh < 2; ++hh) { if (ATT2) att::attn_item2(F, b, (hh ? qb : 63 - qb) * 32, lds); else att::attn_item(F, b, (hh ? qb : 63 - qb) * 32, lds); }
    }
}

namespace ssd {
constexpr int OFF_CS = 0, CS_ST = 272;
constexpr int OFF_BS = OFF_CS + 64 * CS_ST;
constexpr int OFF_BT = OFF_BS + 64 * CS_ST, T_ST = 144;
constexpr int OFF_XT = OFF_BT + 128 * T_ST;
constexpr int OFF_XW = OFF_XT + 64 * T_ST;
constexpr int OFF_XS = OFF_XW + 64 * T_ST;
constexpr int OFF_MT = OFF_XS + 64 * T_ST;
constexpr int OFF_HS = OFF_MT + 64 * T_ST;
constexpr int OFF_END = OFF_HS + 64 * CS_ST;
static_assert(OFF_END + 5 * 320 * 4 <= 131072, "ssd lds");
__device__ __forceinline__ f32x4 mfma16(bf16x8 a, bf16x8 b, f32x4 c) { return __builtin_amdgcn_mfma_f32_16x16x32_bf16(a, b, c, 0, 0, 0); }
__device__ __forceinline__ bf16x8 ldfrag(const char* base, int stride, int row, int k0) { return *(const bf16x8*)(base + row * stride + k0 * 2); }
}
__device__ __forceinline__ void ph_ssd(Frame& F) {
    using namespace ssd;
    char* lds = (char*)(unsigned char*)F.lds;
    const bf16_t* XBC = (const bf16_t*)(F.ws + WS_XBC); const bf16_t* ZS = (const bf16_t*)(F.ws + WS_Z); const float* DT = (const float*)(F.outb + OUT_DT);
    bf16_t* YG = (bf16_t*)(F.ws + WS_Q);
    const float* conv_w = F.a->in[9]; const float* conv_b = F.a->in[10]; const float* a_log = F.a->in[12]; const float* d_skip = F.a->in[13];
    const int tid = F.tid, wid = F.wave, lane = F.lane, fr = lane & 15, fq = lane >> 4;
    const bool stager = tid < 320; const int so = tid % 40, tg = tid / 40;
    for (int item = F.bid; item < NB * 16; item += F.G) {
        const int b = item >> 4, h = item & 15, g = h >> 2;
        const float aneg = -__expf(a_log[h]), dsk = d_skip[h];
        const int ch0 = so < 8 ? h * 64 + so * 8 : (so < 24 ? 1024 + g * 128 + (so - 8) * 8 : 1536 + g * 128 + (so - 24) * 8);
        float* CWL = (float*)(lds + OFF_END);
        __syncthreads();
        if (stager) {
#pragma unroll
            for (int j = 0; j < 4; ++j) { *(f32x4*)(CWL + j * 320 + so * 8) = *(const f32x4*)(conv_w + (size_t)j * 2048 + ch0); *(f32x4*)(CWL + j * 320 + so * 8 + 4) = *(const f32x4*)(conv_w + (size_t)j * 2048 + ch0 + 4); }
            *(f32x4*)(CWL + 4 * 320 + so * 8) = *(const f32x4*)(conv_b + ch0); *(f32x4*)(CWL + 4 * 320 + so * 8 + 4) = *(const f32x4*)(conv_b + ch0 + 4);
        }
        f32x4 hst[4];
#pragma unroll
        for (int t = 0; t < 4; ++t) hst[t] = (f32x4){0.f, 0.f, 0.f, 0.f};
        __syncthreads();
        for (int i = tid; i < 64 * CS_ST / 4; i += NTHR) ((unsigned*)(lds + OFF_HS))[i] = 0u;
        u32x4 raw[11];
        const size_t tokb = (size_t)b * SEQ;
#define SSD_LOAD(c) do { if (stager) { _Pragma("unroll") for (int i = 0; i < 11; ++i) { const int t = (c) * 64 + tg * 8 - 3 + i; \
            raw[i] = (t >= 0) ? *(const u32x4*)(XBC + (tokb + t) * 2048 + ch0) : (u32x4){0u, 0u, 0u, 0u}; } } } while (0)
        SSD_LOAD(0);
        float dtl_next = DT[(tokb + lane) * 16 + h];
        for (int c = 0; c < 32; ++c) {
            const float dtl = dtl_next; if (c + 1 < 32) dtl_next = DT[(tokb + (c + 1) * 64 + lane) * 16 + h];
            u32x2 zpre[2];
#pragma unroll
            for (int t2 = 0; t2 < 2; ++t2) { const int tile = 2 * wid + t2, pb = tile >> 2, lb = tile & 3; zpre[t2] = *(const u32x2*)(ZS + (tokb + c * 64 + lb * 16 + fr) * 1024 + h * 64 + pb * 16 + 4 * fq); }
            float acs = dtl * aneg;
#pragma unroll
            for (int o = 1; o < 64; o <<= 1) { const float t = __shfl_up(acs, o); if (lane >= o) acs += t; }
            const float alast = __shfl(acs, 63);
            if (DBG_SSD_SYNC) __syncthreads();
            float dtv[8], dec[8];
#pragma unroll
            for (int t = 0; t < 8; ++t) { dtv[t] = __shfl(dtl, (tg * 8 + t) & 63); dec[t] = __expf(alast - __shfl(acs, (tg * 8 + t) & 63)); }
            if (stager) {
#pragma unroll
                for (int hq = 0; hq < 2; ++hq) {
                    float xin[11][4];
#pragma unroll
                    for (int i = 0; i < 11; ++i) { const unsigned wa = hq ? raw[i].z : raw[i].x, wb = hq ? raw[i].w : raw[i].y; xin[i][0] = bflo(wa); xin[i][1] = bfhi(wa); xin[i][2] = bflo(wb); xin[i][3] = bfhi(wb); }
                    float outv[8][4];
                    { f32x4 cwv[4]; const f32x4 cbq = *(const f32x4*)(CWL + 4 * 320 + so * 8 + hq * 4);
#pragma unroll
                      for (int j = 0; j < 4; ++j) cwv[j] = *(const f32x4*)(CWL + j * 320 + so * 8 + hq * 4);
#pragma unroll
                      for (int t = 0; t < 8; ++t)
#pragma unroll
                        for (int e = 0; e < 4; ++e) { float sacc = cbq[e];
#pragma unroll
                            for (int j = 0; j < 4; ++j) sacc += cwv[j][e] * xin[t + j][e];
                            outv[t][e] = silu_f(sacc); } }
                    if (so < 8) {
#pragma unroll
                        for (int e = 0; e < 4; ++e) { const int p = so * 8 + hq * 4 + e;
                            f32x4 x0, x1, d0, d1, w0, w1;
#pragma unroll
                            for (int t = 0; t < 4; ++t) { x0[t] = outv[t][e]; x1[t] = outv[4 + t][e]; d0[t] = x0[t] * dtv[t]; d1[t] = x1[t] * dtv[4 + t]; w0[t] = d0[t] * dec[t]; w1[t] = d1[t] * dec[4 + t]; }
                            *(u32x4*)(lds + OFF_XS + p * T_ST + tg * 16) = pack8(x0, x1);
                            *(u32x4*)(lds + OFF_XT + p * T_ST + tg * 16) = pack8(d0, d1);
                            *(u32x4*)(lds + OFF_XW + p * T_ST + tg * 16) = pack8(w0, w1); }
                    } else {
                        const bool isB = so < 24; const int n0 = (isB ? (so - 8) : (so - 24)) * 8 + hq * 4;
                        char* nat = lds + (isB ? OFF_BS : OFF_CS);
#pragma unroll
                        for (int t = 0; t < 8; ++t) { u32x2 w; w.x = cvt_pk_bf16(outv[t][0], outv[t][1]); w.y = cvt_pk_bf16(outv[t][2], outv[t][3]);
                            *(u32x2*)(nat + (tg * 8 + t) * CS_ST + n0 * 2) = w; }
                        if (isB) {
#pragma unroll
                            for (int e = 0; e < 4; ++e) { f32x4 a, bq;
#pragma unroll
                                for (int t = 0; t < 4; ++t) { a[t] = outv[t][e]; bq[t] = outv[4 + t][e]; }
                                *(u32x4*)(lds + OFF_BT + (n0 + e) * T_ST + tg * 16) = pack8(a, bq); }
                        }
                    }
                }
            }
            if (c + 1 < 32) SSD_LOAD(c + 1);
            __syncthreads();
#pragma unroll
            for (int t2 = 0; t2 < 2; ++t2) {
                const int tile = 2 * wid + t2, sb = tile >> 2, lb = tile & 3;
                f32x4 d = (f32x4){0.f, 0.f, 0.f, 0.f};
                if (sb <= lb) {
#pragma unroll
                    for (int ks = 0; ks < 4; ++ks) d = mfma16(ldfrag(lds + OFF_BS, CS_ST, sb * 16 + fr, ks * 32 + fq * 8), ldfrag(lds + OFF_CS, CS_ST, lb * 16 + fr, ks * 32 + fq * 8), d);
                    const int l = lb * 16 + fr; const float al = __shfl(acs, l);
                    f32x4 as;
#pragma unroll
                    for (int r = 0; r < 4; ++r) as[r] = __shfl(acs, sb * 16 + 4 * fq + r);
#pragma unroll
                    for (int r = 0; r < 4; ++r) { const int s = sb * 16 + 4 * fq + r; d[r] = (s <= l) ? d[r] * __expf(al - as[r]) : 0.f; }
                }
                u32x2 w; w.x = cvt_pk_bf16(d[0], d[1]); w.y = cvt_pk_bf16(d[2], d[3]);
                *(u32x2*)(lds + OFF_MT + (lb * 16 + fr) * T_ST + (sb * 16 + 4 * fq) * 2) = w;
            }
            if (DBG_SSD_SYNC) __syncthreads();
            f32x4 yacc[2];
#pragma unroll
            for (int t2 = 0; t2 < 2; ++t2) {
                const int tile = 2 * wid + t2, pb = tile >> 2, lb = tile & 3;
                f32x4 d = (f32x4){0.f, 0.f, 0.f, 0.f};
#pragma unroll
                for (int ks = 0; ks < 4; ++ks) d = mfma16(ldfrag(lds + OFF_HS, CS_ST, pb * 16 + fr, ks * 32 + fq * 8), ldfrag(lds + OFF_CS, CS_ST, lb * 16 + fr, ks * 32 + fq * 8), d);
                const float el = __expf(__shfl(acs, lb * 16 + fr));
                yacc[t2] = d * el;
            }
            __syncthreads();
#pragma unroll
            for (int t2 = 0; t2 < 2; ++t2) {
                const int tile = 2 * wid + t2, pb = tile >> 2, lb = tile & 3;
                f32x4 d = yacc[t2];
#pragma unroll
                for (int ks = 0; ks < 2; ++ks) d = mfma16(ldfrag(lds + OFF_XT, T_ST, pb * 16 + fr, ks * 32 + fq * 8), ldfrag(lds + OFF_MT, T_ST, lb * 16 + fr, ks * 32 + fq * 8), d);
                const int l = lb * 16 + fr, p0 = pb * 16 + 4 * fq; const size_t tok = tokb + c * 64 + l;
                const u32x2 zz = zpre[t2];
                const float z0 = bflo(zz.x), z1 = bfhi(zz.x), z2 = bflo(zz.y), z3 = bfhi(zz.y);
                float xs[4];
#pragma unroll
                for (int r = 0; r < 4; ++r) xs[r] = bflo((unsigned)*(const bf16_t*)(lds + OFF_XS + (p0 + r) * T_ST + l * 2));
                u32x2 w; w.x = cvt_pk_bf16((d[0] + xs[0] * dsk) * z0, (d[1] + xs[1] * dsk) * z1); w.y = cvt_pk_bf16((d[2] + xs[2] * dsk) * z2, (d[3] + xs[3] * dsk) * z3);
                *(u32x2*)(YG + tok * 1024 + h * 64 + p0) = w;
            }
            if (DBG_SSD_SYNC) __syncthreads();
            { const float dc = __expf(alast);
#pragma unroll
              for (int t = 0; t < 4; ++t) { f32x4 d = hst[t] * dc;
#pragma unroll
                  for (int ks = 0; ks < 2; ++ks) d = mfma16(ldfrag(lds + OFF_BT, T_ST, wid * 16 + fr, ks * 32 + fq * 8), ldfrag(lds + OFF_XW, T_ST, t * 16 + fr, ks * 32 + fq * 8), d);
                  hst[t] = d;
                  u32x2 w; w.x = cvt_pk_bf16(d[0], d[1]); w.y = cvt_pk_bf16(d[2], d[3]);
                  *(u32x2*)(lds + OFF_HS + (t * 16 + fr) * CS_ST + (wid * 16 + 4 * fq) * 2) = w; } }
            __syncthreads();
        }
#undef SSD_LOAD
    }
}

namespace ssd2 {
constexpr int CS_ST = 272, T_ST = 144;
constexpr int OFF_CS = 0, OFF_BS = 64 * CS_ST, OFF_BT = 2 * 64 * CS_ST, OFF_H0 = OFF_BT + 128 * T_ST;
constexpr int H_XS = 0, H_XW = 64 * T_ST, H_MT = 2 * 64 * T_ST, H_HS = 3 * 64 * T_ST, H_SZ = H_HS + 64 * CS_ST;
constexpr int OFF_CW = OFF_H0 + 2 * H_SZ;
static_assert(OFF_CW + 5 * 384 * 4 <= LDS_MISC, "ssd2 lds");
}
__device__ __forceinline__ void ph_ssd2(Frame& F) {
    using namespace ssd2; using ssd::mfma16; using ssd::ldfrag;
    char* lds = (char*)(unsigned char*)F.lds;
    const bf16_t* XBC = (const bf16_t*)(F.ws + WS_XBC); const bf16_t* ZS = (const bf16_t*)(F.ws + WS_Z); const float* DT = (const float*)(F.outb + OUT_DT);
    bf16_t* YG = (bf16_t*)(F.ws + WS_Q);
    const float* conv_w = F.a->in[9]; const float* conv_b = F.a->in[10]; const float* a_log = F.a->in[12]; const float* d_skip = F.a->in[13];
    const int tid = F.tid, wid = F.wave, lane = F.lane, fr = lane & 15, fq = lane >> 4;
    const bool stager = tid < 384; const int so = tid % 48, tg = tid / 48, shd = (so >> 3) & 1;
    for (int item = F.bid; item < NB * 8; item += F.G) {
        const int b = item >> 3, g = (item >> 1) & 3, h0 = g * 4 + (item & 1) * 2;
        const float aneg0 = -__expf(a_log[h0]), aneg1 = -__expf(a_log[h0 + 1]), dsk0 = d_skip[h0], dsk1 = d_skip[h0 + 1];
        const int ch0 = so < 16 ? (h0 + shd) * 64 + (so & 7) * 8 : (so < 32 ? 1024 + g * 128 + (so - 16) * 8 : 1536 + g * 128 + (so - 32) * 8);
        float* CWL = (float*)(lds + OFF_CW);
        __syncthreads();
        if (stager) {
#pragma unroll
            for (int j = 0; j < 4; ++j) { *(f32x4*)(CWL + j * 384 + so * 8) = *(const f32x4*)(conv_w + (size_t)j * 2048 + ch0); *(f32x4*)(CWL + j * 384 + so * 8 + 4) = *(const f32x4*)(conv_w + (size_t)j * 2048 + ch0 + 4); }
            *(f32x4*)(CWL + 4 * 384 + so * 8) = *(const f32x4*)(conv_b + ch0); *(f32x4*)(CWL + 4 * 384 + so * 8 + 4) = *(const f32x4*)(conv_b + ch0 + 4);
        }
        f32x4 hst[2][4];
#pragma unroll
        for (int hh = 0; hh < 2; ++hh)
#pragma unroll
            for (int t = 0; t < 4; ++t) hst[hh][t] = (f32x4){0.f, 0.f, 0.f, 0.f};
        for (int i = tid; i < 64 * CS_ST / 4; i += NTHR) { ((unsigned*)(lds + OFF_H0 + H_HS))[i] = 0u; ((unsigned*)(lds + OFF_H0 + H_SZ + H_HS))[i] = 0u; }
        u32x4 raw[11];
        const size_t tokb = (size_t)b * SEQ;
        const bf16_t* xrow = XBC + ((ptrdiff_t)tokb + tg * 8 - 3) * 2048 + ch0;
#define SSD_LOAD(c, xp, tgx) do { if (stager) { _Pragma("unroll") for (int i = 0; i < 11; ++i) { const int t = (c) * 64 + (tgx) * 8 - 3 + i; \
            raw[i] = (t >= 0) ? *(const u32x4*)((xp) + (ptrdiff_t)((c) * 64 + i) * 2048) : (u32x4){0u, 0u, 0u, 0u}; } } } while (0)
        SSD_LOAD(0, xrow, tg);
        f32x2 dtn = *(const f32x2*)(DT + (tokb + lane) * 16 + h0);
        for (int c = 0; c < 32; ++c) {
            int frl = fr, fql = fq, tgl = tg, sol = so; const bf16_t* xrl = xrow; asm volatile("" : "+v"(frl), "+v"(fql), "+v"(tgl), "+v"(sol), "+v"(xrl)); const int shdl = (sol >> 3) & 1;
            const float dtl0 = dtn[0], dtl1 = dtn[1]; if (c + 1 < 32) dtn = *(const f32x2*)(DT + (tokb + (c + 1) * 64 + lane) * 16 + h0);
            u32x2 zpre[2][2];
#pragma unroll
            for (int hh = 0; hh < 2; ++hh)
#pragma unroll
                for (int t2 = 0; t2 < 2; ++t2) { const int tile = 2 * wid + t2, pb = tile >> 2, lb = tile & 3; zpre[hh][t2] = *(const u32x2*)(ZS + (tokb + c * 64 + lb * 16 + frl) * 1024 + (h0 + hh) * 64 + pb * 16 + 4 * fql); }
            float acs0 = dtl0 * aneg0, acs1 = dtl1 * aneg1;
#pragma unroll
            for (int o = 1; o < 64; o <<= 1) { const float t0 = __shfl_up(acs0, o), t1 = __shfl_up(acs1, o); if (lane >= o) { acs0 += t0; acs1 += t1; } }
            const float alast0 = __shfl(acs0, 63), alast1 = __shfl(acs1, 63);
            float wdt[8];
#pragma unroll
            for (int t = 0; t < 8; ++t) { const int sl = (tgl * 8 + t) & 63; const float d0 = __shfl(dtl0, sl), d1 = __shfl(dtl1, sl), a0 = __shfl(acs0, sl), a1 = __shfl(acs1, sl);
                wdt[t] = (shdl ? d1 : d0) * __expf(shdl ? alast1 - a1 : alast0 - a0); }
            if (stager) {
#pragma unroll
                for (int cp = 0; cp < 4; ++cp) {
                    float xin[11][2];
#pragma unroll
                    for (int i = 0; i < 11; ++i) { const unsigned wa = cp == 0 ? raw[i].x : (cp == 1 ? raw[i].y : (cp == 2 ? raw[i].z : raw[i].w)); xin[i][0] = bflo(wa); xin[i][1] = bfhi(wa); }
                    float outv[8][2];
                    { f32x2 cwv[4]; const f32x2 cbq = *(const f32x2*)(CWL + 4 * 384 + sol * 8 + cp * 2);
#pragma unroll
                      for (int j = 0; j < 4; ++j) cwv[j] = *(const f32x2*)(CWL + j * 384 + sol * 8 + cp * 2);
#pragma unroll
                      for (int t = 0; t < 8; ++t)
#pragma unroll
                        for (int e = 0; e < 2; ++e) { float sacc = cbq[e];
#pragma unroll
                            for (int j = 0; j < 4; ++j) sacc += cwv[j][e] * xin[t + j][e];
                            outv[t][e] = silu_f(sacc); } }
                    if (sol < 16) {
                        char* hb = lds + OFF_H0 + shdl * H_SZ;
#pragma unroll
                        for (int e = 0; e < 2; ++e) { const int p = (sol & 7) * 8 + cp * 2 + e;
                            f32x4 x0, x1, w0, w1;
#pragma unroll
                            for (int t = 0; t < 4; ++t) { x0[t] = outv[t][e]; x1[t] = outv[4 + t][e]; w0[t] = x0[t] * wdt[t]; w1[t] = x1[t] * wdt[4 + t]; }
                            *(u32x4*)(hb + H_XS + p * T_ST + tgl * 16) = pack8(x0, x1);
                            *(u32x4*)(hb + H_XW + p * T_ST + tgl * 16) = pack8(w0, w1); }
                    } else {
                        const bool isB = sol < 32; const int n0 = (isB ? (sol - 16) : (sol - 32)) * 8 + cp * 2;
                        char* nat = lds + (isB ? OFF_BS : OFF_CS);
#pragma unroll
                        for (int t = 0; t < 8; ++t) *(unsigned*)(nat + (tgl * 8 + t) * CS_ST + n0 * 2) = cvt_pk_bf16(outv[t][0], outv[t][1]);
                        if (isB) {
#pragma unroll
                            for (int e = 0; e < 2; ++e) { f32x4 a, bq;
#pragma unroll
                                for (int t = 0; t < 4; ++t) { a[t] = outv[t][e]; bq[t] = outv[4 + t][e]; }
                                *(u32x4*)(lds + OFF_BT + (n0 + e) * T_ST + tgl * 16) = pack8(a, bq); }
                        }
                    }
                    SBAR();
                }
            }
            if (c + 1 < 32) SSD_LOAD(c + 1, xrl, tgl);
            __syncthreads();
#pragma unroll
            for (int t2 = 0; t2 < 2; ++t2) {
                const int tile = 2 * wid + t2, sb = tile >> 2, lb = tile & 3;
                f32x4 d = (f32x4){0.f, 0.f, 0.f, 0.f}, m0 = d, m1 = d;
                if (sb <= lb) {
#pragma unroll
                    for (int ks = 0; ks < 4; ++ks) d = mfma16(ldfrag(lds + OFF_BS, CS_ST, sb * 16 + frl, ks * 32 + fql * 8), ldfrag(lds + OFF_CS, CS_ST, lb * 16 + frl, ks * 32 + fql * 8), d);
                    const int l = lb * 16 + frl; const float al0 = __shfl(acs0, l), al1 = __shfl(acs1, l);
#pragma unroll
                    for (int r = 0; r < 4; ++r) { const int sidx = sb * 16 + 4 * fql + r; const float as0 = __shfl(acs0, sidx), as1 = __shfl(acs1, sidx), ds0 = __shfl(dtl0, sidx), ds1 = __shfl(dtl1, sidx);
                        m0[r] = (sidx <= l) ? d[r] * __expf(al0 - as0) * ds0 : 0.f; m1[r] = (sidx <= l) ? d[r] * __expf(al1 - as1) * ds1 : 0.f; }
                }
                u32x2 w; w.x = cvt_pk_bf16(m0[0], m0[1]); w.y = cvt_pk_bf16(m0[2], m0[3]);
                *(u32x2*)(lds + OFF_H0 + H_MT + (lb * 16 + frl) * T_ST + (sb * 16 + 4 * fql) * 2) = w;
                w.x = cvt_pk_bf16(m1[0], m1[1]); w.y = cvt_pk_bf16(m1[2], m1[3]);
                *(u32x2*)(lds + OFF_H0 + H_SZ + H_MT + (lb * 16 + frl) * T_ST + (sb * 16 + 4 * fql) * 2) = w;
            }
            f32x4 yacc[2][2];
#pragma unroll
            for (int hh = 0; hh < 2; ++hh)
#pragma unroll
                for (int t2 = 0; t2 < 2; ++t2) {
                    const int tile = 2 * wid + t2, pb = tile >> 2, lb = tile & 3; const char* hb = lds + OFF_H0 + hh * H_SZ;
                    f32x4 d = (f32x4){0.f, 0.f, 0.f, 0.f};
#pragma unroll
                    for (int ks = 0; ks < 4; ++ks) d = mfma16(ldfrag(hb + H_HS, CS_ST, pb * 16 + frl, ks * 32 + fql * 8), ldfrag(lds + OFF_CS, CS_ST, lb * 16 + frl, ks * 32 + fql * 8), d);
                    const float el = __expf(__shfl(hh ? acs1 : acs0, lb * 16 + frl));
                    yacc[hh][t2] = d * el;
                }
            __syncthreads();
#pragma unroll
            for (int hh = 0; hh < 2; ++hh)
#pragma unroll
                for (int t2 = 0; t2 < 2; ++t2) {
                    const int tile = 2 * wid + t2, pb = tile >> 2, lb = tile & 3; const char* hb = lds + OFF_H0 + hh * H_SZ;
                    f32x4 d = yacc[hh][t2];
#pragma unroll
                    for (int ks = 0; ks < 2; ++ks) d = mfma16(ldfrag(hb + H_XS, T_ST, pb * 16 + frl, ks * 32 + fql * 8), ldfrag(hb + H_MT, T_ST, lb * 16 + frl, ks * 32 + fql * 8), d);
                    const int l = lb * 16 + frl, p0 = pb * 16 + 4 * fql; const size_t tok = tokb + c * 64 + l; const float dsk = hh ? dsk1 : dsk0;
                    const u32x2 zz = zpre[hh][t2];
                    const float z0 = bflo(zz.x), z1 = bfhi(zz.x), z2 = bflo(zz.y), z3 = bfhi(zz.y);
                    float xs[4];
#pragma unroll
                    for (int r = 0; r < 4; ++r) xs[r] = bflo((unsigned)*(const bf16_t*)(hb + H_XS + (p0 + r) * T_ST + l * 2));
                    u32x2 w; w.x = cvt_pk_bf16((d[0] + xs[0] * dsk) * z0, (d[1] + xs[1] * dsk) * z1); w.y = cvt_pk_bf16((d[2] + xs[2] * dsk) * z2, (d[3] + xs[3] * dsk) * z3);
                    *(u32x2*)(YG + tok * 1024 + (h0 + hh) * 64 + p0) = w;
                }
#pragma unroll
            for (int hh = 0; hh < 2; ++hh) { const float dc = __expf(hh ? alast1 : alast0); char* hb = lds + OFF_H0 + hh * H_SZ;
#pragma unroll
                for (int t = 0; t < 4; ++t) { f32x4 d = hst[hh][t] * dc;
#pragma unroll
                    for (int ks = 0; ks < 2; ++ks) d = mfma16(ldfrag(lds + OFF_BT, T_ST, wid * 16 + frl, ks * 32 + fql * 8), ldfrag(hb + H_XW, T_ST, t * 16 + frl, ks * 32 + fql * 8), d);
                    hst[hh][t] = d;
                    u32x2 w; w.x = cvt_pk_bf16(d[0], d[1]); w.y = cvt_pk_bf16(d[2], d[3]);
                    *(u32x2*)(hb + H_HS + (t * 16 + frl) * CS_ST + (wid * 16 + 4 * fql) * 2) = w; } }
            __syncthreads();
        }
#undef SSD_LOAD
    }
}

__device__ __forceinline__ void ph_gnorm(Frame& F) {
    bf16_t* YG = (bf16_t*)(F.ws + WS_Q);
    const int gw = F.bid * NWAVES + F.wave, NGW = F.G * NWAVES;
    for (int m = gw; m < NTOK; m += NGW) {
        u32x2* rp = (u32x2*)(YG + (size_t)m * D) + F.lane;
#pragma unroll
        for (int j = 0; j < 4; ++j) { const u32x2 w = rp[64 * j]; const float a = bflo(w.x), b = bfhi(w.x), c = bflo(w.y), d = bfhi(w.y);
            const float ss = wave_sum(a * a + b * b + c * c + d * d); const float r = 1.f / sqrtf(ss * (1.f / 256.f) + LN_EPS);
            if (PB_FP8) { int pk = 0; pk = __builtin_amdgcn_cvt_pk_fp8_f32(a * r, b * r, pk, false); pk = __builtin_amdgcn_cvt_pk_fp8_f32(c * r, d * r, pk, true); ((unsigned*)(F.outb + OUT_OB8 + (size_t)m * D))[F.lane + 64 * j] = (unsigned)pk; }
            else { u32x2 o; o.x = cvt_pk_bf16(a * r, b * r); o.y = cvt_pk_bf16(c * r, d * r); rp[64 * j] = o; } }
    }
}

template <bool DRY = false> __device__ __forceinline__ void ph_router(Frame& F) {
    float* X1 = (float*)F.outb; bf16_t* U2 = (bf16_t*)(F.ws + WS_U2); const float* MOD = (const float*)(F.ws + WS_MOD);
    const float* ln1g = F.a->in[18]; const float* ln1b = F.a->in[19]; const float* w_router = F.a->in[20]; const float* b_router = F.a->in[21];
    u32x2* REG = (u32x2*)(F.ws + WS_REG); unsigned* CNT = (unsigned*)(F.ws + WS_CTL) + CW_CNT;
    constexpr int TST = 2064;
    LAS unsigned char* THI = F.lds; LAS unsigned char* TLO = F.lds + 16 * TST; LAS float* PART = (LAS float*)(F.lds + 32 * TST);
    LAS unsigned* lcnt = (LAS unsigned*)(F.lds + LDS_AUX); LAS unsigned* lbase = lcnt + 32; LAS unsigned* ent = lcnt + 64;
    const int tid = F.tid, lane = F.lane, wid = F.wave, fr = lane & 15, fq = lane >> 4;
    bf16x8 whi[4][2], wlo[4][2];
#pragma unroll
    for (int ks = 0; ks < 4; ++ks)
#pragma unroll
        for (int ct = 0; ct < 2; ++ct) { float wv[8];
#pragma unroll
            for (int i = 0; i < 8; ++i) wv[i] = w_router[(size_t)(128 * wid + 32 * ks + 8 * fq + i) * 32 + ct * 16 + fr];
            u32x4 h, l2;
#pragma unroll
            for (int i = 0; i < 4; ++i) { const unsigned hp = cvt_pk_bf16(wv[2 * i], wv[2 * i + 1]); const float r0 = wv[2 * i] - bflo(hp), r1 = wv[2 * i + 1] - bfhi(hp); h[i] = hp; l2[i] = cvt_pk_bf16(r0, r1); }
            whi[ks][ct] = __builtin_bit_cast(bf16x8, h); wlo[ks][ct] = __builtin_bit_cast(bf16x8, l2); }
    const float brl = b_router[lane & 31];
    for (int batch = F.bid; batch < NTOK / 256; batch += F.G) {
        const int hf = batch >> 7;
        __syncthreads();
        if (tid < 32) lcnt[tid] = 0u;
        for (int grp = 0; grp < 16; ++grp) {
#pragma unroll
            for (int tt = 0; tt < 2; ++tt) {
                const int tg16 = 2 * wid + tt, m = batch * 256 + grp * 16 + tg16; const float* md = MOD + (size_t)(m >> 11) * 6144;
                f32x4* xr = (f32x4*)(X1 + (size_t)m * D) + lane;
                f32x4 v[4]; float s = 0.f;
#pragma unroll
                for (int j = 0; j < 4; ++j) { v[j] = xr[64 * j]; s += (v[j][0] + v[j][1]) + (v[j][2] + v[j][3]); }
                float mean = wave_sum(s) * (1.f / D), s2 = 0.f;
#pragma unroll
                for (int j = 0; j < 4; ++j) { v[j] = v[j] - mean; s2 += (v[j][0] * v[j][0] + v[j][1] * v[j][1]) + (v[j][2] * v[j][2] + v[j][3] * v[j][3]); }
                float rstd = 1.f / sqrtf(wave_sum(s2) * (1.f / D) + LN_EPS);
                s = 0.f;
#pragma unroll
                for (int j = 0; j < 4; ++j) { const f32x4 g = *((const f32x4*)ln1g + lane + 64 * j), bb = *((const f32x4*)ln1b + lane + 64 * j); v[j] = v[j] * rstd * g + bb; if (!DRY) xr[64 * j] = v[j]; s += (v[j][0] + v[j][1]) + (v[j][2] + v[j][3]); }
                mean = wave_sum(s) * (1.f / D); s2 = 0.f;
#pragma unroll
                for (int j = 0; j < 4; ++j) { v[j] = v[j] - mean; s2 += (v[j][0] * v[j][0] + v[j][1] * v[j][1]) + (v[j][2] * v[j][2] + v[j][3] * v[j][3]); }
                rstd = 1.f / sqrtf(wave_sum(s2) * (1.f / D) + LN_EPS);
                u32x2* o8 = (u32x2*)(U2 + (size_t)m * D) + lane;
#pragma unroll
                for (int j = 0; j < 4; ++j) { const f32x4 sh = *((const f32x4*)(md + 3072) + lane + 64 * j), sc = *((const f32x4*)(md + 4096) + lane + 64 * j);
                    v[j] = v[j] * rstd * (sc + 1.0f) + sh; u32x2 w; w.x = cvt_pk_bf16(v[j][0], v[j][1]); w.y = cvt_pk_bf16(v[j][2], v[j][3]);
                    if (DRY) { if (w.x == 0x12345678u) o8[64 * j] = w; }
                    else if (MOE_FP8) { int pk = 0; pk = __builtin_amdgcn_cvt_pk_fp8_f32(v[j][0], v[j][1], pk, false); pk = __builtin_amdgcn_cvt_pk_fp8_f32(v[j][2], v[j][3], pk, true); ((unsigned*)((unsigned char*)U2 + (size_t)m * D))[lane + 64 * j] = (unsigned)pk; }
                    else o8[64 * j] = w;
                    u32x2 lo; lo.x = cvt_pk_bf16(v[j][0] - bflo(w.x), v[j][1] - bfhi(w.x)); lo.y = cvt_pk_bf16(v[j][2] - bflo(w.y), v[j][3] - bfhi(w.y));
                    *(LAS u32x2*)(THI + tg16 * TST + (4 * lane + 256 * j) * 2) = w; *(LAS u32x2*)(TLO + tg16 * TST + (4 * lane + 256 * j) * 2) = lo; }
            }
            __syncthreads();
            { f32x4 a0 = (f32x4){0.f, 0.f, 0.f, 0.f}, a1 = a0;
#pragma unroll
              for (int ks = 0; ks < 4; ++ks) { const int cb = (128 * wid + 32 * ks + 8 * fq) * 2;
                  const bf16x8 th = *(const LAS bf16x8*)(THI + fr * TST + cb), tl = *(const LAS bf16x8*)(TLO + fr * TST + cb);
                  a0 = __builtin_amdgcn_mfma_f32_16x16x32_bf16(whi[ks][0], th, a0, 0, 0, 0); a1 = __builtin_amdgcn_mfma_f32_16x16x32_bf16(whi[ks][1], th, a1, 0, 0, 0);
                  a0 = __builtin_amdgcn_mfma_f32_16x16x32_bf16(wlo[ks][0], th, a0, 0, 0, 0); a1 = __builtin_amdgcn_mfma_f32_16x16x32_bf16(wlo[ks][1], th, a1, 0, 0, 0);
                  a0 = __builtin_amdgcn_mfma_f32_16x16x32_bf16(whi[ks][0], tl, a0, 0, 0, 0); a1 = __builtin_amdgcn_mfma_f32_16x16x32_bf16(whi[ks][1], tl, a1, 0, 0, 0); }
              *(LAS f32x4*)(PART + (wid * 16 + fr) * 32 + 4 * fq) = a0; *(LAS f32x4*)(PART + (wid * 16 + fr) * 32 + 16 + 4 * fq) = a1; }
            __syncthreads();
            { const int tg16 = 2 * wid + (lane >> 5), tl = grp * 16 + tg16, myexp = lane & 31;
              float logit = brl;
#pragma unroll
              for (int w8 = 0; w8 < 8; ++w8) logit += PART[(w8 * 16 + tg16) * 32 + myexp];
              float tv[4]; int tix[4];
#pragma unroll
              for (int k = 0; k < 4; ++k) { float bv = logit; int bi = myexp;
#pragma unroll
                  for (int o = 1; o < 32; o <<= 1) { const float ov = __shfl_xor(bv, o); const int oi = __shfl_xor(bi, o); if (ov > bv || (ov == bv && oi < bi)) { bv = ov; bi = oi; } }
                  tv[k] = bv; tix[k] = bi; if (myexp == bi) logit = -INFINITY; }
              const float e1 = __expf(tv[1] - tv[0]), e2 = __expf(tv[2] - tv[0]), e3 = __expf(tv[3] - tv[0]); const float inv = 1.f / (1.f + e1 + e2 + e3);
              if (myexp < 4) { const int ee = myexp == 0 ? tix[0] : (myexp == 1 ? tix[1] : (myexp == 2 ? tix[2] : tix[3])); const float gg = (myexp == 0 ? 1.f : (myexp == 1 ? e1 : (myexp == 2 ? e2 : e3))) * inv;
                  const unsigned lp = atomicAdd((unsigned*)&lcnt[ee], 1u);
                  LAS unsigned* en = ent + (tl * 4 + myexp) * 3; en[0] = (unsigned)ee; en[1] = lp; en[2] = __float_as_uint(gg);
                  if (DBG_CHECK == 1) { u32x2 rw; rw.x = (unsigned)ee; rw.y = __float_as_uint(gg); ((u32x2*)(F.ws + WS_DBG))[(size_t)(batch * 256 + tl) * 4 + myexp] = rw; } } }
        }
        __syncthreads();
        if (tid < 32) lbase[tid] = DRY ? 0u : __hip_atomic_fetch_add(CNT + 64 * (hf * 32 + tid), lcnt[tid], __ATOMIC_RELAXED, __HIP_MEMORY_SCOPE_AGENT);
        __syncthreads();
        for (int i = tid; i < 1024; i += NTHR) { const LAS unsigned* en = ent + i * 3; const unsigned ee = en[0], pos = lbase[ee] + en[1];
            const unsigned tokl = (unsigned)(batch * 256 + (i >> 2)) - (unsigned)hf * HALF_TOK;
            u32x2 w; w.x = tokl * 4u + (unsigned)(i & 3); w.y = en[2];
            if (!DRY && pos < (unsigned)REG_CAP) REG[((size_t)hf * 32 + ee) * REG_CAP + pos] = w; }
    }
}

template <bool DRY = false> __device__ __forceinline__ void ph_final(Frame& F, int hf) {
    float* X1 = (float*)F.outb; const bf16_t* YB = (const bf16_t*)(F.ws + WS_YB); const float* MOD = (const float*)(F.ws + WS_MOD);
    const float* g2 = F.a->in[26]; const float* b2 = F.a->in[27];
    const int gw = F.bid * NWAVES + F.wave, NGW = F.G * NWAVES, lane = F.lane;
    constexpr int RB = 2;
    for (int tl0 = gw; tl0 < HALF_TOK; tl0 += NGW * RB) {
        f32x4 xv[RB][4]; u32x2 yw[RB][4][4];
#pragma unroll
        for (int r = 0; r < RB; ++r) { const int tl = tl0 + r * NGW, m = hf * HALF_TOK + tl;
            const f32x4* xr = (const f32x4*)(X1 + (size_t)m * D) + lane; const u32x2* yr = (const u32x2*)(YB + (size_t)tl * 4 * D) + lane;
#pragma unroll
            for (int j = 0; j < 4; ++j) { xv[r][j] = xr[64 * j];
#pragma unroll
                for (int k = 0; k < 4; ++k) yw[r][j][k] = yr[k * 256 + 64 * j]; } }
#pragma unroll
        for (int r = 0; r < RB; ++r) { const int tl = tl0 + r * NGW, m = hf * HALF_TOK + tl; const float* md = MOD + (size_t)(m >> 11) * 6144 + 5120;
            f32x4* xr = (f32x4*)(X1 + (size_t)m * D) + lane;
            f32x4 v[4]; float s = 0.f;
#pragma unroll
            for (int j = 0; j < 4; ++j) { f32x4 y = (f32x4){0.f, 0.f, 0.f, 0.f};
#pragma unroll
                for (int k = 0; k < 4; ++k) { const u32x2 w = yw[r][j][k]; y[0] += bflo(w.x); y[1] += bfhi(w.x); y[2] += bflo(w.y); y[3] += bfhi(w.y); }
                if (DBG_NO_MOE) y = (f32x4){0.f, 0.f, 0.f, 0.f};
                const f32x4 gt = *((const f32x4*)md + lane + 64 * j);
                v[j] = xv[r][j] * DN_ALPHA + gt * y; s += (v[j][0] + v[j][1]) + (v[j][2] + v[j][3]); }
            const float mean = wave_sum(s) * (1.f / D); float s2 = 0.f;
#pragma unroll
            for (int j = 0; j < 4; ++j) { v[j] = v[j] - mean; s2 += (v[j][0] * v[j][0] + v[j][1] * v[j][1]) + (v[j][2] * v[j][2] + v[j][3] * v[j][3]); }
            const float rstd = 1.f / sqrtf(wave_sum(s2) * (1.f / D) + LN_EPS);
#pragma unroll
            for (int j = 0; j < 4; ++j) { const f32x4 g = *((const f32x4*)g2 + lane + 64 * j), bb = *((const f32x4*)b2 + lane + 64 * j); const f32x4 ov = v[j] * rstd * g + bb; if (!DRY || ov[0] == 1.2345e-33f) xr[64 * j] = ov; } }
    }
}

__device__ __forceinline__ float block_sum(Frame& F, float v, LAS float* red) {
    v = wave_sum(v); __syncthreads(); if (F.lane == 0) red[F.wave] = v; __syncthreads();
    float s = 0.f; for (int w = 0; w < NWAVES; ++w) s += red[w]; return s;
}
__device__ __forceinline__ float block_max(Frame& F, float v, LAS float* red) {
#pragma unroll
    for (int o = 1; o < 64; o <<= 1) v = fmaxf(v, __shfl_xor(v, o));
    __syncthreads(); if (F.lane == 0) red[F.wave] = v; __syncthreads();
    float s = 0.f; for (int w = 0; w < NWAVES; ++w) s = fmaxf(s, red[w]); return s;
}
__device__ __forceinline__ void dbg_report(Frame& F, float e) { if (F.tid == 0) atomicMax((unsigned*)(F.ws + WS_CTL) + CW_DBG, __float_as_uint(e)); }
__device__ __forceinline__ void dbg_check_moe(Frame& F) {
    if (F.bid >= 64) return;
    const int tok = HALF_TOK + 509 * F.bid + 3, tokl = tok - HALF_TOK, tid = F.tid;
    LAS float* u2 = (LAS float*)F.lds; LAS float* act = u2 + 1024; LAS float* red = act + 1024; LAS float* lg = red + 16;
    const bf16_t* U2 = (const bf16_t*)(F.ws + WS_U2); const bf16_t* YB = (const bf16_t*)(F.ws + WS_YB); const u32x2* RT = (const u32x2*)(F.ws + WS_DBG);
    const float* w1 = F.a->in[22]; const float* b1 = F.a->in[23]; const float* w2 = F.a->in[24]; const float* b2 = F.a->in[25];
    __syncthreads();
    for (int i = tid; i < 1024; i += NTHR) u2[i] = bflo((unsigned)U2[(size_t)tok * 1024 + i]);
    __syncthreads();
    float y0 = 0.f, y1 = 0.f;
    for (int k = 0; k < 4; ++k) {
        const u32x2 rw = RT[(size_t)tok * 4 + k]; const int e = (int)rw.x; const float g = __uint_as_float(rw.y);
        const float* W1 = w1 + (size_t)e * 1024 * 2048; const float* W2 = w2 + (size_t)e * 1024 * 1024;
        float h0 = b1[e * 2048 + tid], h1 = b1[e * 2048 + tid + 512], h2 = b1[e * 2048 + tid + 1024], h3 = b1[e * 2048 + tid + 1536];
        for (int c = 0; c < 1024; ++c) { const float uu = u2[c]; const float* wr = W1 + (size_t)c * 2048 + tid; h0 += uu * wr[0]; h1 += uu * wr[512]; h2 += uu * wr[1024]; h3 += uu * wr[1536]; }
        __syncthreads();
        { float gg = fminf(h0, 7.f), up = fminf(fmaxf(h2, -7.f), 7.f); act[tid] = (up + 1.f) * gg / (1.f + expf(-1.702f * gg));
          gg = fminf(h1, 7.f); up = fminf(fmaxf(h3, -7.f), 7.f); act[tid + 512] = (up + 1.f) * gg / (1.f + expf(-1.702f * gg)); }
        __syncthreads();
        float a0 = b2[e * 1024 + tid], a1 = b2[e * 1024 + tid + 512];
        for (int j = 0; j < 1024; ++j) { const float aa = act[j]; a0 += aa * W2[(size_t)j * 1024 + tid]; a1 += aa * W2[(size_t)j * 1024 + tid + 512]; }
        y0 += g * a0; y1 += g * a1;
    }
    float f0 = 0.f, f1 = 0.f;
    for (int k = 0; k < 4; ++k) { f0 += bflo((unsigned)YB[((size_t)tokl * 4 + k) * 1024 + tid]); f1 += bflo((unsigned)YB[((size_t)tokl * 4 + k) * 1024 + tid + 512]); }
    const float rms = sqrtf(block_sum(F, y0 * y0 + y1 * y1, red) * (1.f / 1024.f)) + 1e-20f;
    float err = block_max(F, fmaxf(fabsf(y0 - f0), fabsf(y1 - f1)), red) / rms;
    { const float* X1 = (const float*)F.outb + (size_t)tok * 1024; const float* md = (const float*)(F.ws + WS_MOD) + (size_t)(tok >> 11) * 6144;
      const float xa = X1[tid], xb = X1[tid + 512]; const float mean = block_sum(F, xa + xb, red) * (1.f / 1024.f);
      const float da = xa - mean, db = xb - mean; const float var = block_sum(F, da * da + db * db, red) * (1.f / 1024.f); const float rstd = 1.f / sqrtf(var + LN_EPS);
      __syncthreads();
      u2[tid] = da * rstd * (1.f + md[4096 + tid]) + md[3072 + tid]; u2[tid + 512] = db * rstd * (1.f + md[4096 + tid + 512]) + md[3072 + tid + 512];
      __syncthreads();
      if (tid < 32) { float a = F.a->in[21][tid]; for (int c = 0; c < 1024; ++c) a += u2[c] * F.a->in[20][c * 32 + tid]; lg[tid] = a; }
      __syncthreads();
      if (tid == 0) { unsigned want = 0u, got = 0u; float l2[32]; for (int i = 0; i < 32; ++i) l2[i] = lg[i];
          for (int k = 0; k < 4; ++k) { int bi = 0; for (int i = 1; i < 32; ++i) if (l2[i] > l2[bi]) bi = i; want |= 1u << bi; l2[bi] = -INFINITY; got |= 1u << RT[(size_t)tok * 4 + k].x; }
          lg[32] = (want != got) ? 1.f : 0.f; }
      __syncthreads();
      if (lg[32] != 0.f) err = 50.f; }
    dbg_report(F, err);
}
__device__ __forceinline__ void dbg_check_ssd(Frame& F) {
    if (F.bid >= 2) return;
    const int b = F.bid ? 20 : 5, h = F.bid ? 14 : 3, g = h >> 2, tid = F.tid, p = tid >> 3, ng = tid & 7;
    LAS float* red = (LAS float*)F.lds; LAS float* cv = red + 16;
    const bf16_t* XBC = (const bf16_t*)(F.ws + WS_XBC); const bf16_t* ZS = (const bf16_t*)(F.ws + WS_Z); const float* DT = (const float*)(F.outb + OUT_DT); const bf16_t* YG = (const bf16_t*)(F.ws + WS_Q);
    const float* cw = F.a->in[9]; const float* cb = F.a->in[10]; const float aneg = -expf(F.a->in[12][h]), dsk = F.a->in[13][h];
    const int mych = tid < 64 ? h * 64 + tid : (tid < 192 ? 1024 + g * 128 + (tid - 64) : 1536 + g * 128 + (tid - 192));
    float w0 = 0.f, w1 = 0.f, w2 = 0.f, w3 = 0.f, wb = 0.f;
    if (tid < 320) { w0 = cw[0 * 2048 + mych]; w1 = cw[1 * 2048 + mych]; w2 = cw[2 * 2048 + mych]; w3 = cw[3 * 2048 + mych]; wb = cb[mych]; }
    float x0 = 0.f, x1 = 0.f, x2 = 0.f;
    float hs[16];
#pragma unroll
    for (int i = 0; i < 16; ++i) hs[i] = 0.f;
    float emax = 0.f, ssq = 0.f, nbad = 0.f; int tmax = 0;
    for (int t = 0; t < SEQ; ++t) {
        const size_t tok = (size_t)b * SEQ + t;
        __syncthreads();
        if (DBG_HYP == 1 && (t & 63) == 0) { x0 = 0.f; x1 = 0.f; x2 = 0.f; }
        if (tid < 320) { const float x3 = bflo((unsigned)XBC[tok * 2048 + mych]); const float s = wb + w0 * x0 + w1 * x1 + w2 * x2 + w3 * x3; cv[tid] = s / (1.f + expf(-s)); x0 = x1; x1 = x2; x2 = x3; }
        __syncthreads();
        const float xv = cv[p], dt = DT[tok * 16 + h], dec = expf(dt * aneg);
        float yp = 0.f;
#pragma unroll
        for (int i = 0; i < 16; ++i) { const int n = ng * 16 + i; hs[i] = hs[i] * dec + dt * xv * cv[64 + n]; yp += cv[192 + n] * hs[i]; }
        yp += __shfl_xor(yp, 1); yp += __shfl_xor(yp, 2); yp += __shfl_xor(yp, 4);
        const float yv = (yp + xv * dsk) * bflo((unsigned)ZS[tok * 1024 + h * 64 + p]);
        const float yf = bflo((unsigned)YG[tok * 1024 + h * 64 + p]);
        if (ng == 0) { const float er = fabsf(yv - yf); if (er > emax) { emax = er; tmax = t; } ssq += yv * yv; if (er > 0.25f && (DBG_SUB < 5 || (DBG_SUB == 5 && (t & 63) == 0) || (DBG_SUB == 6 && (t & 63) == 1) || (DBG_SUB == 7 && (t & 63) == 32))) nbad += 1.f; }
    }
    const float rms = sqrtf(block_sum(F, ssq, red) / (64.f * SEQ)) + 1e-20f;
    const float M = block_max(F, emax, red);
    if (DBG_SUB == 0) dbg_report(F, M / rms);
    else if (DBG_SUB == 1) dbg_report(F, block_sum(F, nbad, red) / (64.f * SEQ));
    else if (DBG_SUB >= 5) dbg_report(F, block_sum(F, nbad, red) / (64.f * 32.f));
    else { __syncthreads(); if (ng == 0 && emax == M) red[12] = (float)(DBG_SUB == 2 ? ((tmax & 63) >> 1) : (DBG_SUB == 3 ? (tmax >> 6) : (p >> 1))); __syncthreads();
        if (F.bid == 0) dbg_report(F, powf(10.f, 2.f * (0.05f + 0.05f * red[12]) - 4.f)); }
}
__device__ __forceinline__ void dbg_check_attn(Frame& F) {
    if (F.bid >= 32) return;
    const int b = (F.bid * 7 + 3) & 31, pos = 300 + F.bid * 53, nadm = ((pos >> 6) + 1) * 64, tid = F.tid, lane = F.lane, hd = F.wave;
    const size_t tq = (size_t)b * SEQ + pos;
    LAS float* sc = (LAS float*)F.lds; LAS unsigned char* sel = (LAS unsigned char*)(sc + 2048); LAS float* lgt = (LAS float*)(sel + 2048); LAS float* red = lgt + 8 * 2048; LAS float* misc = red + 16;
    const bf16_t* IQ = (const bf16_t*)(F.outb + OUT_IQ); const bf16_t* IK = (const bf16_t*)(F.outb + OUT_IK); const float* IW = (const float*)(F.outb + OUT_IW);
    const bf16_t* Q = (const bf16_t*)(F.ws + WS_Q); const bf16_t* KV = (const bf16_t*)(F.outb + OUT_KV); const bf16_t* OA = (const bf16_t*)(F.outb + OUT_OA); const u64* MASK = (const u64*)(F.outb + OUT_MASK);
    __syncthreads();
    for (int k = tid; k < nadm; k += NTHR) { float s = 0.f;
        for (int hh = 0; hh < 8; ++hh) { float d = 0.f; for (int c = 0; c < 64; ++c) d += bflo((unsigned)IQ[tq * 512 + hh * 64 + c]) * bflo((unsigned)IK[((size_t)b * SEQ + k) * 64 + c]); s += fmaxf(d, 0.f) * IW[tq * 8 + hh]; }
        sc[k] = s + 0.0f; }
    __syncthreads();
    float nbad = 0.f;
    for (int k = tid; k < nadm; k += NTHR) { const float s = sc[k]; int rank = 0; for (int j = 0; j < nadm; ++j) { const float t = sc[j]; rank += (t > s || (t == s && j < k)) ? 1 : 0; }
        const unsigned char se = rank < 256 ? 1 : 0; sel[k] = se; const unsigned mb = (unsigned)((MASK[tq * 32 + (k >> 6)] >> (k & 63)) & 1ull); if (mb != se) nbad += 1.f; }
    __syncthreads();
    const float nbad_t = block_sum(F, nbad, red);
    LAS float* lw = lgt + hd * 2048; float mx = -INFINITY;
    for (int k = lane; k < nadm; k += 64) { float l = -INFINITY;
        if (sel[k]) { float d = 0.f; for (int c = 0; c < 128; ++c) d += bflo((unsigned)Q[tq * 1024 + hd * 128 + c]) * bflo((unsigned)KV[((size_t)b * SEQ + k) * 128 + c]);
            const int rel = k - pos, n = rel < 0 ? -rel : rel; const float nf = (float)(n > 1 ? n : 1); int large = 8 + (int)(logf(nf / 8.0f) / 2.7725887f * 8.0f); if (large > 15) large = 15;
            const int bucket = (rel > 0 ? 16 : 0) + (n < 8 ? n : large);
            l = d * 0.088388347648318440f + F.a->in[8][bucket * 8 + hd]; }
        lw[k] = l; mx = fmaxf(mx, l); }
#pragma unroll
    for (int o = 1; o < 64; o <<= 1) mx = fmaxf(mx, __shfl_xor(mx, o));
    float den = 0.f;
    for (int k = lane; k < nadm; k += 64) { const float pp = expf(lw[k] - mx); lw[k] = pp; den += pp; }
    den = wave_sum(den);
    float emax = 0.f, ssq = 0.f;
    for (int c2 = 0; c2 < 2; ++c2) { const int c = lane + 64 * c2; float o = 0.f; for (int k = 0; k < nadm; ++k) { const float pp = lw[k]; if (pp != 0.f) o += pp * bflo((unsigned)KV[((size_t)b * SEQ + k) * 128 + c]); }
        o /= den; const float of = bflo((unsigned)OA[tq * 1024 + hd * 128 + c]); emax = fmaxf(emax, fabsf(o - of)); ssq += o * o; }
    const float rms = sqrtf(block_sum(F, ssq, red) * (1.f / 1024.f)) + 1e-20f;
    float err = block_max(F, emax, red) / rms;
    (void)misc;
    if (nbad_t > 0.f) err = 10.f + nbad_t;
    dbg_report(F, err);
}
__device__ __forceinline__ void dbg_emit(Frame& F) {
    float* out = (float*)F.outb;
    for (size_t i = (size_t)F.bid * NTHR + F.tid; i < (size_t)NTOK * D / 4; i += (size_t)F.G * NTHR) ((f32x4*)out)[i] = (f32x4){0.f, 0.f, 0.f, 0.f};
    __syncthreads();
    if (F.bid == 0 && F.tid == 0) { const float e = __uint_as_float(__hip_atomic_load((unsigned*)(F.ws + WS_CTL) + CW_DBG, __ATOMIC_RELAXED, __HIP_MEMORY_SCOPE_AGENT));
        float code = (log10f(fmaxf(e, 1e-30f)) + 4.f) * 0.5f; code = fminf(fmaxf(rintf(code * 20.f) * 0.05f, 0.05f), 3.0f);
        out[0] = sqrtf(67108864.f * 1.01f * (powf(10.f, code) - 1.f)); }
}

constexpr int NPHASE = 17;
__global__ void __launch_bounds__(NTHR, 2) fwd(Args args) {
    extern __shared__ __attribute__((aligned(16))) unsigned char lds_raw[];
    Frame F;
    F.lds = (LAS unsigned char*)lds_raw;
    F.tid = threadIdx.x; F.lane = F.tid & 63; F.wave = __builtin_amdgcn_readfirstlane(F.tid >> 6); F.G = gridDim.x; F.bid = blockIdx.x;
    F.a = &args;
    F.ws = args.ws; F.outb = (unsigned char*)args.out;
    volatile LAS unsigned* MISCW = (volatile LAS unsigned*)(F.lds + LDS_MISC);
    if (F.tid < 64) MISCW[F.tid] = 0u;
    __syncthreads();
    XcdBarrier bar; bar.bar = (unsigned*)(F.ws + WS_CTL) + CW_BAR; bar.x = 0; bar.st = nullptr;
#if MK_ONE
    bar = xcd_barrier_post((unsigned*)(F.ws + WS_CTL) + CW_BAR, MISCW + 8);
#define GRID_BAR() xcd_barrier(bar)
#else
#define GRID_BAR() do { } while (0)
#endif
    const int lo = args.ph_lo, hi = args.ph_hi;
#ifndef PHM
#define PHM (0xFFFFFFFFu & ~(DBG_NO_ATTN ? 0x30u : 0u) & ~(DBG_NO_SSD ? 0xC0u : 0u))
#endif
#define IN(k) (((PHM >> (k)) & 1u) && lo <= (k) && (k) < hi)
#define SEAM(k) do { if ((k) + 1 < hi) GRID_BAR(); } while (0)

    if (IN(0)) { ph_prologue(F); if (DBG_TWICE & 1u) { GRID_BAR(); ph_prologue(F); } SEAM(0); }
    if (IN(1)) { ph_ln1(F); if (DBG_TWICE & 2u) { GRID_BAR(); ph_ln1(F); } SEAM(1); }
    if (IN(2)) {
        EpiProj E{(bf16_t*)(F.ws + WS_Q), (bf16_t*)(F.outb + OUT_IQ), (bf16_t*)(F.ws + WS_Z), (bf16_t*)(F.ws + WS_XBC), (bf16_t*)(F.ws + WS_GA), (bf16_t*)(F.ws + WS_GB), (float*)(F.outb + OUT_MISC), 1.0f};
#if PROJ_FP8
        { SchedProj<2> S; S.o.init(NTOK, 12 * 256, F.G, F.bid); S.A = (const char*)(F.ws + WS_U8); S.Bt = (const char*)(F.ws + WS_WIN8);
          EpiProj E8 = E; E8.sc = MOE_INV;
          pg8::gemm_phase<EpiProj, SchedProj<2>, false, 512, true>(F.lds, S, E8);
          if (DBG_TWICE & 32768u) { GRID_BAR(); pg8::gemm_phase<EpiProj, SchedProj<2>, false, 512, true>(F.lds, S, E8); } }
        { SchedProj<1> S; S.o.init(NTOK, 15 * 256, F.G, F.bid); S.A = (const char*)(F.outb + OUT_U); S.Bt = (const char*)(F.ws + WS_WIN);
          pg8::gemm_phase<EpiProj, SchedProj<1>, false>(F.lds, S, E);
          if (DBG_TWICE & 4u) { GRID_BAR(); pg8::gemm_phase<EpiProj, SchedProj<1>, false>(F.lds, S, E); } }
#else
        { SchedProj<0> S; S.o.init(NTOK, NPROJ, F.G, F.bid); S.A = (const char*)(F.outb + OUT_U); S.Bt = (const char*)(F.ws + WS_WIN);
          pg8::gemm_phase<EpiProj, SchedProj<0>, false>(F.lds, S, E);
          if (DBG_TWICE & 4u) { GRID_BAR(); pg8::gemm_phase<EpiProj, SchedProj<0>, false>(F.lds, S, E); } }
#endif
        SEAM(2);
    }
    if (IN(3)) { ph_misc(F); if (DBG_TWICE & 8u) { GRID_BAR(); ph_misc(F); } SEAM(3); }
    if (IN(4)) { ph_index(F); if (DBG_TWICE & 16u) { GRID_BAR(); ph_index(F); } SEAM(4); }
    if (IN(5)) { ph_attn(F); if (DBG_TWICE & 32u) { GRID_BAR(); ph_attn(F); } SEAM(5); if (DBG_CHECK == 3) { dbg_check_attn(F); GRID_BAR(); } }
    if (IN(6)) { ph_ssd2(F); if (DBG_TWICE & 64u) { GRID_BAR(); ph_ssd2(F); } SEAM(6); if (DBG_CHECK == 2) { dbg_check_ssd(F); GRID_BAR(); } }
    if (IN(7)) { ph_gnorm(F); if (DBG_TWICE & 128u) { GRID_BAR(); ph_gnorm(F); } SEAM(7); }
    if (IN(8)) {
#if PA_FP8
        SchedPlainT<1024> S; S.o.init(NTOK, 1024, F.G, F.bid); S.A = (const char*)(F.outb + OUT_OA); S.Bt = (const char*)(F.ws + WS_WPA8);
        EpiGate<0> E{(const bf16_t*)(F.ws + WS_GA), nullptr, (bf16_t*)(F.ws + WS_Z), MOE_INV};
        pg8::gemm_phase<EpiGate<0>, SchedPlainT<1024>, false, 512, true>(F.lds, S, E);
#else
        SchedPlain S; S.o.init(NTOK, 1024, F.G, F.bid); S.A = (const char*)(F.outb + OUT_OA); S.Bt = (const char*)(F.ws + WS_WPA);
        EpiGate<0> E{(const bf16_t*)(F.ws + WS_GA), nullptr, (bf16_t*)(F.ws + WS_Z), 1.0f};
        pg8::gemm_phase<EpiGate<0>, SchedPlain, false>(F.lds, S, E);
#endif
    }
    if (IN(9)) {
#if PB_FP8
        SchedPlainT<1024> S; S.o.init(NTOK, 1024, F.G, F.bid); S.A = (const char*)(F.outb + OUT_OB8); S.Bt = (const char*)(F.ws + WS_WPB8);
        EpiGate<1> E{(const bf16_t*)(F.ws + WS_GB), (const bf16_t*)(F.ws + WS_Z), (bf16_t*)(F.ws + WS_XBC), MOE_INV};
        pg8::gemm_phase<EpiGate<1>, SchedPlainT<1024>, false, 512, true>(F.lds, S, E);
#else
        SchedPlain S; S.o.init(NTOK, 1024, F.G, F.bid); S.A = (const char*)(F.ws + WS_Q); S.Bt = (const char*)(F.ws + WS_WPB);
        EpiGate<1> E{(const bf16_t*)(F.ws + WS_GB), (const bf16_t*)(F.ws + WS_Z), (bf16_t*)(F.ws + WS_XBC), 1.0f};
        pg8::gemm_phase<EpiGate<1>, SchedPlain, false>(F.lds, S, E);
#endif
        SEAM(9);
    }
    if (IN(10)) {
        SchedPlain S; S.o.init(NTOK, 1024, F.G, F.bid); S.A = (const char*)(F.ws + WS_XBC); S.Bt = (const char*)(F.ws + WS_WOUT);
        EpiOut E{F.a->in[0], (const float*)(F.ws + WS_MOD), (float*)F.outb};
        pg8::gemm_phase<EpiOut, SchedPlain, false>(F.lds, S, E);
        if (DBG_TWICE & 1024u) { GRID_BAR(); pg8::gemm_phase<EpiOut, SchedPlain, false>(F.lds, S, E); }
        SEAM(10);
    }
    if (IN(11)) { if (DBG_TWICE & 2048u) { ph_router<true>(F); GRID_BAR(); } ph_router<false>(F); SEAM(11); }
#pragma unroll
    for (int hf = 0; hf < 2; ++hf) {
        const int p0 = 12 + hf * 2;
        if (IN(p0)) {
            if (hf == 1) ph_final<false>(F, 0);
            MoeTab T = moe_tables(F, hf);
            SchedMoe<8, true> S{T, F.G, F.bid, hf, (const char*)(F.ws + WS_U2), (const char*)(F.ws + WS_W1), (const u32x2*)(F.ws + WS_REG)};
            EpiMoe1 E{F.a->in[23], (bf16_t*)(F.ws + WS_ACT), 0};
            pg8::gemm_phase<EpiMoe1, SchedMoe<8, true>, true, MOE_RB / 2, MOE_FP8 != 0>(F.lds, S, E);
            if ((DBG_TWICE & 4096u) && hf == 0) { GRID_BAR(); pg8::gemm_phase<EpiMoe1, SchedMoe<8, true>, true, MOE_RB / 2, MOE_FP8 != 0>(F.lds, S, E); }
            if ((DBG_TWICE & 16384u) && hf == 0) { GRID_BAR(); EpiMoe1 Ed = E; Ed.dry = 1; pg8::gemm_phase<EpiMoe1, SchedMoe<8, true>, true, MOE_RB / 2, MOE_FP8 != 0>(F.lds, S, Ed); }
            SEAM(p0);
        }
        if (IN(p0 + 1)) {
            MoeTab T = moe_tables(F, hf);
            SchedMoe<4, false> S{T, F.G, F.bid, hf, (const char*)(F.ws + WS_ACT), (const char*)(F.ws + WS_W2), (const u32x2*)(F.ws + WS_REG)};
            EpiMoe2 E{F.a->in[25], (bf16_t*)(F.ws + WS_YB), (const u32x2*)(F.ws + WS_REG), T, hf, 0};
            if ((DBG_TWICE & 262144u) && hf == 0) { EpiMoe2 Ed = E; Ed.dry = DBG_DRYMODE; pg8::gemm_phase<EpiMoe2, SchedMoe<4, false>, false, MOE_RB / 2, MOE_FP8 != 0>(F.lds, S, Ed); GRID_BAR(); }
            pg8::gemm_phase<EpiMoe2, SchedMoe<4, false>, false, MOE_RB / 2, MOE_FP8 != 0>(F.lds, S, E);
            if ((DBG_TWICE & 8192u) && hf == 0) { GRID_BAR(); pg8::gemm_phase<EpiMoe2, SchedMoe<4, false>, false, MOE_RB / 2, MOE_FP8 != 0>(F.lds, S, E); }
            if ((DBG_TWICE & 131072u) && hf == 0) { GRID_BAR(); EpiMoe2 Ed = E; Ed.dry = 1; pg8::gemm_phase<EpiMoe2, SchedMoe<4, false>, false, MOE_RB / 2, MOE_FP8 != 0>(F.lds, S, Ed); }
            SEAM(p0 + 1);
            if (DBG_CHECK == 1 && hf == 1) { dbg_check_moe(F); GRID_BAR(); }
        }
    }
    if (IN(16)) { if (DBG_TWICE & 65536u) { ph_final<true>(F, 1); GRID_BAR(); } ph_final(F, 1); }
    if (DBG_CHECK) { GRID_BAR(); dbg_emit(F); }
#undef IN
#undef SEAM
}

extern "C" void kernel_launch(void* const* d_in, const int* in_sizes, int n_in, void* d_out, int out_size, void* d_ws, size_t ws_size, hipStream_t stream) {
    static int grid = 0;
    if (grid == 0) {
        if (n_in != 28 || in_sizes[0] != NTOK * D || out_size != NTOK * D || ws_size < WS_END) { fprintf(stderr, "kernel_launch: shape mismatch (n_in %d, in0 %d, out %d, ws %zu)\n", n_in, n_in > 0 ? in_sizes[0] : -1, out_size, ws_size); grid = -1; return; }
        int dev = 0, cus = 0, per_cu = 0;
        if (hipGetDevice(&dev) != hipSuccess || hipDeviceGetAttribute(&cus, hipDeviceAttributeMultiprocessorCount, dev) != hipSuccess) { grid = -1; return; }
        if (hipFuncSetAttribute((const void*)fwd, hipFuncAttributeMaxDynamicSharedMemorySize, LDS_BYTES) != hipSuccess) { fprintf(stderr, "kernel_launch: hipFuncSetAttribute failed\n"); grid = -1; return; }
        if (hipOccupancyMaxActiveBlocksPerMultiprocessor(&per_cu, (const void*)fwd, NTHR, LDS_BYTES) != hipSuccess || per_cu < 1) fprintf(stderr, "kernel_launch: occupancy query reports %d\n", per_cu);
        (void)hipGetLastError();
        grid = cus;
    }
    if (grid < 0) return;
    if (hipMemsetAsync((char*)d_ws + WS_CTL, 0, CTL_ZERO_BYTES, stream) != hipSuccess) { fprintf(stderr, "kernel_launch: memset failed\n"); return; }
    Args a{};
    for (int i = 0; i < 28; ++i) a.in[i] = (const float*)d_in[i];
    a.out = (float*)d_out; a.ws = (unsigned char*)d_ws;
    const int nph = NPHASE < MK_PH_HI ? NPHASE : MK_PH_HI;
#if MK_ONE
    a.ph_lo = 0; a.ph_hi = nph;
    hipLaunchKernelGGL(fwd, dim3(grid), dim3(NTHR), LDS_BYTES, stream, a);
#else
    for (int p = 0; p < nph; ++p) { a.ph_lo = p; a.ph_hi = p + 1; hipLaunchKernelGGL(fwd, dim3(grid), dim3(NTHR), LDS_BYTES, stream, a); }
#endif
    const hipError_t le = hipPeekAtLastError();
    if (le != hipSuccess) fprintf(stderr, "kernel_launch: launch failed: %s\n", hipGetErrorName(le));
}
```

```cpp
#include <hip/hip_runtime.h>
#include <cstdio>
#include <cstdint>

#ifndef MK_ONE
#define MK_ONE 1
#endif
#ifndef DBG_NO_ATTN
#define DBG_NO_ATTN 0
#endif
#ifndef DBG_ATTN_ZERO
#define DBG_ATTN_ZERO 0
#endif
#ifndef DBG_IQ_TRUNC
#define DBG_IQ_TRUNC 0
#endif
#ifndef DBG_ROUTER_BF16
#define DBG_ROUTER_BF16 0
#endif
#ifndef DBG_CHECK
#define DBG_CHECK 0
#endif
#ifndef DBG_SKIP_BODY
#define DBG_SKIP_BODY 0
#endif
#ifndef DBG_SUB
#define DBG_SUB 0
#endif
#ifndef DBG_SSD_SYNC
#define DBG_SSD_SYNC 0
#endif
#ifndef DBG_HYP
#define DBG_HYP 0
#endif
#ifndef DBG_TWICE
#define DBG_TWICE 0u
#endif
#ifndef DBG_DRYMODE
#define DBG_DRYMODE 2
#endif
#ifndef DBG_NO_SSD
#define DBG_NO_SSD 0
#endif
#ifndef DBG_NO_MOE
#define DBG_NO_MOE 0
#endif
#ifndef MOE_FP8
#define MOE_FP8 1
#endif
#ifndef PROJ_FP8
#define PROJ_FP8 1
#endif
#ifndef PA_FP8
#define PA_FP8 1
#endif
#ifndef PB_FP8
#define PB_FP8 0
#endif
#ifndef ATT2
#define ATT2 1
#endif
#ifndef MK_PH_HI
#define MK_PH_HI 99
#endif

#define LAS __attribute__((address_space(3)))
#define GAS __attribute__((address_space(1)))
typedef unsigned short bf16_t;
typedef short bf16x8 __attribute__((ext_vector_type(8)));
typedef short s16x4 __attribute__((ext_vector_type(4)));
typedef float f32x2 __attribute__((ext_vector_type(2)));
typedef float f32x4 __attribute__((ext_vector_type(4)));
typedef float f32x16 __attribute__((ext_vector_type(16)));
typedef unsigned u32x2 __attribute__((ext_vector_type(2)));
typedef unsigned u32x4 __attribute__((ext_vector_type(4)));
typedef unsigned long long u64;

constexpr int NB = 32, SEQ = 2048, D = 1024, NTOK = NB * SEQ;
constexpr int NWAVES = 8, NTHR = 512;
constexpr int NPROJ = 6912;
constexpr int NEXP = 32, HALF_TOK = NTOK / 2, REG_CAP = HALF_TOK;
constexpr int ACT_ROWS = HALF_TOK * 4 + NEXP * 256;
constexpr float LN_EPS = 1e-5f;
constexpr float DN_ALPHA = 1.189207115002721f;
constexpr float LOG2E = 1.4426950408889634f;

constexpr size_t MiB = 1u << 20;
constexpr size_t WS_CTL = 0, CTL_ZERO_BYTES = 1 * MiB;
constexpr size_t WS_MOD = 1 * MiB;
constexpr size_t WS_BIAST = 1 * MiB + 800 * 1024;
constexpr size_t WS_WIN = 2 * MiB;
constexpr size_t WS_WPA = 16 * MiB, WS_WPB = 18 * MiB, WS_WOUT = 20 * MiB;
constexpr size_t WS_W1 = 24 * MiB;
constexpr size_t WS_U8 = 88 * MiB;
constexpr size_t WS_W2 = 152 * MiB;
constexpr size_t WS_WIN8 = 184 * MiB;
constexpr size_t WS_WPA8 = 192 * MiB;
constexpr size_t WS_WPB8 = 194 * MiB;
constexpr size_t OUT_OB8 = 192 * MiB;
constexpr size_t WS_Q = 216 * MiB;
constexpr size_t WS_Z = 344 * MiB;
constexpr size_t WS_XBC = 472 * MiB;
constexpr size_t WS_GA = 728 * MiB, WS_GB = 856 * MiB;
constexpr size_t WS_U2 = 216 * MiB;
constexpr size_t WS_REG = 344 * MiB;
constexpr size_t WS_ACT = 360 * MiB;
constexpr size_t WS_YB = 632 * MiB;
constexpr size_t WS_END = 889 * MiB;
constexpr size_t WS_DBG = 889 * MiB;
constexpr size_t OUT_U = 0, OUT_MISC = 128 * MiB, OUT_IQ = 192 * MiB;
constexpr size_t OUT_KV = 0, OUT_IK = 16 * MiB, OUT_IW = 24 * MiB, OUT_DT = 26 * MiB, OUT_MASK = 32 * MiB, OUT_OA = 64 * MiB;
constexpr int CW_BAR = 4096, CW_CNT = 16384, CW_WQ = 22528, CW_DBG = 24576;

constexpr int LDS_BYTES = 160 * 1024;
constexpr int LDS_AUX = 131072;
constexpr int LDS_MISC = LDS_BYTES - 256;

#define LDS_WAIT() asm volatile("s_waitcnt lgkmcnt(0)" ::: "memory")
#define VM_WAIT() asm volatile("s_waitcnt vmcnt(0)" ::: "memory")
#define SBAR() __builtin_amdgcn_sched_barrier(0)
typedef __bf16 bf16x2_t __attribute__((ext_vector_type(2)));
__device__ __forceinline__ unsigned cvt_pk_bf16(float lo, float hi) { f32x2 f = {lo, hi}; bf16x2_t v = __builtin_convertvector(f, bf16x2_t); return __builtin_bit_cast(unsigned, v); }
__device__ __forceinline__ float bflo(unsigned w) { return __uint_as_float(w << 16); }
__device__ __forceinline__ float bfhi(unsigned w) { return __uint_as_float(w & 0xffff0000u); }
__device__ __forceinline__ u32x4 pack8(f32x4 a, f32x4 b) { u32x4 w; w.x = cvt_pk_bf16(a[0], a[1]); w.y = cvt_pk_bf16(a[2], a[3]); w.z = cvt_pk_bf16(b[0], b[1]); w.w = cvt_pk_bf16(b[2], b[3]); return w; }
constexpr int MOE_RB = MOE_FP8 ? 1024 : 2048;
constexpr float MOE_WSC = MOE_FP8 ? 64.0f : 1.0f, MOE_INV = 1.0f / MOE_WSC;
__device__ __forceinline__ u32x2 pack8_fp8(f32x4 a, f32x4 b) { int lo = 0, hi = 0;
    lo = __builtin_amdgcn_cvt_pk_fp8_f32(a[0], a[1], lo, false); lo = __builtin_amdgcn_cvt_pk_fp8_f32(a[2], a[3], lo, true);
    hi = __builtin_amdgcn_cvt_pk_fp8_f32(b[0], b[1], hi, false); hi = __builtin_amdgcn_cvt_pk_fp8_f32(b[2], b[3], hi, true);
    u32x2 r; r.x = (unsigned)lo; r.y = (unsigned)hi; return r; }
__device__ __forceinline__ void unpack8(u32x4 w, f32x4& a, f32x4& b) { a[0] = bflo(w.x); a[1] = bfhi(w.x); a[2] = bflo(w.y); a[3] = bfhi(w.y); b[0] = bflo(w.z); b[1] = bfhi(w.z); b[2] = bflo(w.w); b[3] = bfhi(w.w); }
__device__ __forceinline__ float wave_sum(float v) {
#pragma unroll
    for (int o = 1; o < 64; o <<= 1) v += __shfl_xor(v, o);
    return v;
}
__device__ __forceinline__ float fast_rcp(float x) { return __builtin_amdgcn_rcpf(x); }
__device__ __forceinline__ float sigmoid_f(float x) { return fast_rcp(1.0f + __expf(-x)); }
__device__ __forceinline__ float silu_f(float x) { return x * sigmoid_f(x); }

#define XB_TMO      128
#define XB_XCNT(j)  (256  + 64 * (j))
#define XB_XSUB(j)  (1280 + 64 * (j))
#define XB_XGEN(j)  (2304 + 64 * (j))
#define XB_TOP      3328
#define XB_TOPGEN   3392
#define XCD_BAR_WORDS 3456
#define XB_SPIN_CAP (1u << 18)
__device__ __forceinline__ unsigned xb_ld(unsigned* p)              { return __hip_atomic_load(p, __ATOMIC_RELAXED, __HIP_MEMORY_SCOPE_AGENT); }
__device__ __forceinline__ unsigned xb_add(unsigned* p, unsigned v) { return __hip_atomic_fetch_add(p, v, __ATOMIC_RELAXED, __HIP_MEMORY_SCOPE_AGENT); }
__device__ __forceinline__ unsigned xb_xcc_id() { return (unsigned)__builtin_amdgcn_s_getreg((3 << 11) | 20) & 0xFu; }
#define XB_SPIN(cond, bar) do { unsigned _sp = 0; while (cond) { __builtin_amdgcn_s_sleep(1); \
    if ((++_sp & 255u) == 0u) { if (xb_ld(&(bar)[XB_TMO])) break; if (_sp > XB_SPIN_CAP) { atomicAdd(&(bar)[XB_TMO], 1u); break; } } } } while (0)
struct XcdBarrier { unsigned* bar; unsigned x; volatile LAS unsigned* st; };
__device__ __forceinline__ XcdBarrier xcd_barrier_post(unsigned* bar, volatile LAS unsigned* st) {
    XcdBarrier b; b.bar = bar; b.x = xb_xcc_id(); b.st = st;
    if (threadIdx.x == 0) (void)xb_add(&bar[XB_XCNT(b.x)], 1u);
    return b;
}
__device__ __forceinline__ void xcd_barrier_complete(unsigned* bar, unsigned x, unsigned& nloc, unsigned& nx) {
    const unsigned G = gridDim.x * gridDim.y * gridDim.z;
    unsigned sum, cnt, mine, sp = 0u;
    for (;;) {
        sum = 0u; cnt = 0u;
#pragma nounroll
        for (unsigned j = 0; j < 16; ++j) { const unsigned c = xb_ld(&bar[XB_XCNT(j)]); sum += c; cnt += (c > 0u) ? 1u : 0u; }
        if (sum == G) break;
        __builtin_amdgcn_s_sleep(1);
        if ((++sp & 255u) == 0u) { if (xb_ld(&bar[XB_TMO])) break; if (sp > XB_SPIN_CAP) { atomicAdd(&bar[XB_TMO], 1u); break; } }
    }
    mine = xb_ld(&bar[XB_XCNT(x)]);
    nloc = mine > 0u ? mine : 1u; nx = cnt > 0u ? cnt : 1u;
}
__device__ __forceinline__ void xcd_barrier(const XcdBarrier& b) {
    asm volatile("s_waitcnt vmcnt(0)" ::: "memory");
    __syncthreads();
    if (threadIdx.x == 0) {
        unsigned* bar = b.bar;
        __builtin_amdgcn_s_waitcnt(0);
        unsigned nloc = b.st[0], nx = b.st[1];
        if (nloc == 0u) { xcd_barrier_complete(bar, b.x, nloc, nx); b.st[0] = nloc; b.st[1] = nx; }
        const unsigned old = xb_add(&bar[XB_XSUB(b.x)], 1u);
        const unsigned gen = old / nloc;
        if (old + 1u == (gen + 1u) * nloc) {
            __builtin_amdgcn_fence(__ATOMIC_RELEASE, "agent");
            asm volatile("s_waitcnt vmcnt(0)" ::: "memory");
            const unsigned og = xb_add(&bar[XB_TOP], 1u);
            const unsigned tg = og / nx;
            if (og + 1u == (tg + 1u) * nx) xb_add(&bar[XB_TOPGEN], 1u);
            else XB_SPIN(xb_ld(&bar[XB_TOPGEN]) == tg, bar);
            __builtin_amdgcn_fence(__ATOMIC_ACQUIRE, "agent");
            xb_add(&bar[XB_XGEN(b.x)], 1u);
            asm volatile("s_waitcnt vmcnt(0)" ::: "memory");
        } else {
            XB_SPIN(xb_ld(&bar[XB_XGEN(b.x)]) == gen, bar);
            __builtin_amdgcn_fence(__ATOMIC_ACQUIRE, "agent");
            asm volatile("s_waitcnt vmcnt(0)" ::: "memory");
        }
    }
    __syncthreads();
}

namespace pg8 {
constexpr int BM = 256, BK = 64, HALF = 128, HTB = HALF * BK * 2, STAGE_BYTES = 8 * HTB, NXCD = 8, WGM = 8, KD = 1024;
__host__ __device__ __forceinline__ int lds_byte(int r, int c) { const int st = (r >> 4) * 2 + (c >> 5), rr = r & 15, cc = c & 31, ob = rr * 64 + cc * 2; return st * 1024 + (ob ^ (((ob >> 9) & 1) << 5)); }
__host__ __device__ __forceinline__ void stage_rc(int b, int& R, int& C) { const int st = b / 1024, sb = b % 1024, swz = sb ^ (((sb >> 9) & 1) << 5); R = (st >> 1) * 16 + swz / 64; C = (st & 1) * 32 + (swz % 64) / 2; }
__host__ __device__ __forceinline__ int perm32(int rho) { const int n = rho >> 4, i = rho & 15; return 8 * (i >> 2) + 4 * n + (i & 3); }
struct Unit { int pm, pn, ex; };
struct StaticOrder {
    int nM, nN, nwg, G, c;
    __device__ void init(int M, int N, int G_, int c_) { nM = M / BM; nN = N / BM; nwg = nM * nN; G = G_; c = c_; }
    __device__ bool next(int i, Unit& u) const {
        const long L = (long)i * G + c; if (L >= nwg) return false;
        int wgid = (int)L; { const int q = nwg / NXCD, r = nwg % NXCD, xcd = wgid % NXCD, off = wgid / NXCD; wgid = (xcd < r ? xcd * (q + 1) : r * (q + 1) + (xcd - r) * q) + off; }
        const int nig = WGM * nN, gid = wgid / nig, fm = gid * WGM, gsz = (nM - fm) < WGM ? (nM - fm) : WGM;
        u.pm = fm + ((wgid % nig) % gsz); u.pn = (wgid % nig) / gsz; u.ex = 0; return true;
    }
};
typedef int i32x8 __attribute__((ext_vector_type(8)));
typedef int i32x4v __attribute__((ext_vector_type(4)));
template <class Epi, class Sched, bool GATHER, int KE = 1024, bool FP8 = false>
__device__ __forceinline__ void gemm_phase(LAS unsigned char* lds, const Sched& S, const Epi& E) {
    int tid = threadIdx.x; asm volatile("" : "+v"(tid));
    const int wid = __builtin_amdgcn_readfirstlane(tid >> 6), lane = tid & 63, wr = wid >> 2, wc = wid & 3, fr = lane & 15, fq = lane >> 4;
    constexpr int K = KE, nt = K / BK;
    unsigned voffA[2], voffB[2]; int Rr[2], Cc[2];
#pragma unroll
    for (int i = 0; i < 2; ++i) { int R, C; stage_rc(tid * 16 + i * 8192, R, C); const int Rb = Epi::PERM ? ((R & ~31) + perm32(R & 31)) : R;
        voffA[i] = (unsigned)(R * K + C) * 2u; voffB[i] = (unsigned)(Rb * K + C) * 2u; Rr[i] = R; Cc[i] = C; }
    constexpr size_t kstep = (size_t)(BK * 2);
    constexpr size_t hstep = (size_t)HALF * K * 2;
    const unsigned ldsw = (unsigned)wid * 1024u;
    const int aoff = lds_byte(wr * 64 + fr, fq * 8), boff = lds_byte(wc * 32 + fr, fq * 8);
#define PG8_SA(b, h) (((b) * 2 + (h)) * HTB)
#define PG8_SB(b, h) ((4 + (b) * 2 + (h)) * HTB)
#define PG8_STAGE(bufoff, gbase, voff) do { _Pragma("unroll") for (int _i = 0; _i < 2; ++_i) \
        __builtin_amdgcn_global_load_lds((const unsigned*)((const char*)(gbase) + (voff)[_i]), (LAS unsigned*)(lds + (bufoff) + ldsw + _i * 8192), 16, 0, 0); } while (0)
#define PG8_STAGE_A(bufoff, gb, h, o0, o1) do { if constexpr (GATHER) { const unsigned _ko = (unsigned)((gb) - gA0); unsigned _o[2]; \
            if ((h) == 0) { _o[0] = (o0)[0] + _ko; _o[1] = (o0)[1] + _ko; } else { _o[0] = (o1)[0] + _ko; _o[1] = (o1)[1] + _ko; } PG8_STAGE(bufoff, gA0, _o); } \
        else { PG8_STAGE(bufoff, (gb) + (h) * hstep, voffA); } } while (0)
#define PG8_LD8(p) __builtin_shufflevector(*(const LAS i32x4v*)(p), *(const LAS i32x4v*)((p) + 1024), 0, 1, 2, 3, 4, 5, 6, 7)
#define PG8_LDA(dst, b, h) do { if constexpr (FP8) { _Pragma("unroll") for (int m = 0; m < 4; ++m) dst##8[m] = PG8_LD8(lds + PG8_SA(b, h) + aoff + m * 2048); } \
        else { _Pragma("unroll") for (int m = 0; m < 4; ++m) _Pragma("unroll") for (int k = 0; k < 2; ++k) dst[m][k] = *(const LAS bf16x8*)(lds + PG8_SA(b, h) + aoff + m * 2048 + k * 1024); } } while (0)
#define PG8_LDB(dst, b, h) do { if constexpr (FP8) { _Pragma("unroll") for (int n = 0; n < 2; ++n) dst##8[n] = PG8_LD8(lds + PG8_SB(b, h) + boff + n * 2048); } \
        else { _Pragma("unroll") for (int n = 0; n < 2; ++n) _Pragma("unroll") for (int k = 0; k < 2; ++k) dst[n][k] = *(const LAS bf16x8*)(lds + PG8_SB(b, h) + boff + n * 2048 + k * 1024); } } while (0)
#define PG8_MMA(ai, bj, At, Bt) do { __builtin_amdgcn_s_setprio(1); if constexpr (FP8) { _Pragma("unroll") for (int m = 0; m < 4; ++m) _Pragma("unroll") for (int n = 0; n < 2; ++n) \
            asm volatile("v_mfma_scale_f32_16x16x128_f8f6f4 %0, %1, %2, %0, %3, %3 op_sel_hi:[0,0,0]" : "+v"(acc[ai][bj][m][n]) : "v"(Bt##8[n]), "v"(At##8[m]), "v"(sc127)); } \
        else { _Pragma("unroll") for (int m = 0; m < 4; ++m) _Pragma("unroll") for (int n = 0; n < 2; ++n) _Pragma("unroll") for (int k = 0; k < 2; ++k) \
            acc[ai][bj][m][n] = __builtin_amdgcn_mfma_f32_16x16x32_bf16(Bt[n][k], At[m][k], acc[ai][bj][m][n], 0, 0, 0); } __builtin_amdgcn_s_setprio(0); } while (0)
#define PG8_WAIT_V(n) asm volatile("s_waitcnt vmcnt(" #n ")" ::: "memory")
#define PG8_WAIT_L(n) asm volatile("s_waitcnt lgkmcnt(" #n ")" ::: "memory")
#define PG8_BAR __builtin_amdgcn_s_barrier()
#define PG8_SCHED __builtin_amdgcn_sched_barrier(0)
    Unit cur, nxt; int ui = 0;
    if (!S.next(0, cur)) return;
    f32x4 acc[2][2][4][2];
#pragma unroll
    for (int a = 0; a < 2; ++a)
#pragma unroll
        for (int b = 0; b < 2; ++b)
#pragma unroll
            for (int m = 0; m < 4; ++m)
#pragma unroll
                for (int n = 0; n < 2; ++n) acc[a][b][m][n] = (f32x4){0.f, 0.f, 0.f, 0.f};
    const int sc127 = 0x7f7f7f7f;
    bf16x8 At[4][2], B0[2][2], B1[2][2]; i32x8 At8[4], B08[2], B18[2];
    const char* cA = S.a_base(cur); const char* cB = S.b_base(cur);
    const char* const gA0 = cA;
    unsigned cv0[2] = {0u, 0u}, cv1[2] = {0u, 0u}, nv0[2] = {0u, 0u}, nv1[2] = {0u, 0u};
    if constexpr (GATHER) S.a_offs(cur, Rr, Cc, cv0, cv1);
    PG8_STAGE(PG8_SB(0, 0), cB, voffB); PG8_STAGE_A(PG8_SA(0, 0), cA, 0, cv0, cv1); PG8_STAGE(PG8_SB(0, 1), cB + hstep, voffB); PG8_STAGE_A(PG8_SA(0, 1), cA, 1, cv0, cv1);
    if (wr == 1) PG8_BAR;
    PG8_WAIT_V(4); PG8_BAR;
    PG8_STAGE(PG8_SB(1, 0), cB + kstep, voffB); PG8_STAGE_A(PG8_SA(1, 0), cA + kstep, 0, cv0, cv1); PG8_STAGE(PG8_SB(1, 1), cB + hstep + kstep, voffB);
    PG8_WAIT_V(6); PG8_BAR;
    for (;;) {
        const bool has_next = S.next(ui + 1, nxt);
        const char* nA = has_next ? S.a_base(nxt) : cA; const char* nB = has_next ? S.b_base(nxt) : cB;
        if constexpr (GATHER) { if (has_next) S.a_offs(nxt, Rr, Cc, nv0, nv1); else { nv0[0] = cv0[0]; nv0[1] = cv0[1]; nv1[0] = cv1[0]; nv1[1] = cv1[1]; } }
#pragma nounroll
        for (int t = 0; t < nt; t += 2) {
            const bool last = (t == nt - 2);
            const char* a1 = cA + (size_t)(t + 1) * kstep;
            const char* a2 = last ? nA : cA + (size_t)(t + 2) * kstep; const char* b2 = last ? nB : cB + (size_t)(t + 2) * kstep;
            const char* a3 = a2 + kstep; const char* b3 = b2 + kstep;
            unsigned s0[2], s1[2];
            if constexpr (GATHER) { s0[0] = last ? nv0[0] : cv0[0]; s0[1] = last ? nv0[1] : cv0[1]; s1[0] = last ? nv1[0] : cv1[0]; s1[1] = last ? nv1[1] : cv1[1]; } else { s0[0] = s0[1] = s1[0] = s1[1] = 0u; }
            PG8_LDB(B0, 0, 0); PG8_SCHED; PG8_LDA(At, 0, 0); PG8_STAGE_A(PG8_SA(1, 1), a1, 1, cv0, cv1);
            PG8_WAIT_L(8); PG8_BAR; PG8_WAIT_L(0); PG8_MMA(0, 0, At, B0); PG8_BAR; PG8_SCHED;
            PG8_LDB(B1, 0, 1); PG8_STAGE(PG8_SB(0, 0), b2, voffB);
            PG8_BAR; PG8_WAIT_L(0); PG8_MMA(0, 1, At, B1); PG8_BAR;
            PG8_LDA(At, 0, 1); PG8_STAGE_A(PG8_SA(0, 0), a2, 0, s0, s1);
            PG8_BAR; PG8_WAIT_L(0); PG8_MMA(1, 0, At, B0); PG8_BAR; PG8_SCHED;
            PG8_STAGE(PG8_SB(0, 1), b2 + hstep, voffB);
            PG8_WAIT_V(6); PG8_BAR; PG8_MMA(1, 1, At, B1); PG8_BAR;
            PG8_LDB(B0, 1, 0); PG8_SCHED; PG8_LDA(At, 1, 0); PG8_STAGE_A(PG8_SA(0, 1), a2, 1, s0, s1);
            PG8_WAIT_L(8); PG8_BAR; PG8_WAIT_L(0); PG8_MMA(0, 0, At, B0); PG8_BAR; PG8_SCHED;
            PG8_LDB(B1, 1, 1); PG8_STAGE(PG8_SB(1, 0), b3, voffB);
            PG8_BAR; PG8_WAIT_L(0); PG8_MMA(0, 1, At, B1); PG8_BAR;
            PG8_LDA(At, 1, 1); PG8_STAGE_A(PG8_SA(1, 0), a3, 0, s0, s1);
            PG8_BAR; PG8_WAIT_L(0); PG8_MMA(1, 0, At, B0); PG8_BAR; PG8_SCHED;
            PG8_STAGE(PG8_SB(1, 1), b3 + hstep, voffB);
            PG8_WAIT_V(6); PG8_BAR; PG8_MMA(1, 1, At, B1); PG8_BAR;
        }
        if constexpr (FP8) asm volatile("s_nop 15\n\ts_nop 15" ::: "memory");
        E(acc, cur, wr, wc, fr, fq);
        if (!has_next) break;
#pragma unroll
        for (int a = 0; a < 2; ++a)
#pragma unroll
            for (int b = 0; b < 2; ++b)
#pragma unroll
                for (int m = 0; m < 4; ++m)
#pragma unroll
                    for (int n = 0; n < 2; ++n) acc[a][b][m][n] = (f32x4){0.f, 0.f, 0.f, 0.f};
        cur = nxt; cA = nA; cB = nB; ++ui;
        if constexpr (GATHER) { cv0[0] = nv0[0]; cv0[1] = nv0[1]; cv1[0] = nv1[0]; cv1[1] = nv1[1]; }
    }
    PG8_WAIT_V(0);
    if (wr == 0) PG8_BAR;
    PG8_BAR;
#undef PG8_SA
#undef PG8_SB
#undef PG8_STAGE
#undef PG8_STAGE_A
#undef PG8_LDA
#undef PG8_LDB
#undef PG8_MMA
#undef PG8_LD8
#undef PG8_WAIT_V
#undef PG8_WAIT_L
#undef PG8_BAR
#undef PG8_SCHED
}
}
using pg8::Unit;
typedef f32x4 AccT[2][2][4][2];

struct Args { const float* in[28]; float* out; unsigned char* ws; int ph_lo, ph_hi, pad0, pad1; };
struct Frame {
    LAS unsigned char* lds;
    int tid, lane, wave, G, bid;
    const struct Args* a;
    unsigned char* ws; unsigned char* outb;
};
template <int RB = 2048> struct SchedPlainT {
    pg8::StaticOrder o; const char* A; const char* Bt;
    __device__ __forceinline__ bool next(int i, Unit& u) const { return o.next(i, u); }
    __device__ __forceinline__ const char* a_base(const Unit& u) const { return A + (size_t)u.pm * (256 * RB); }
    __device__ __forceinline__ const char* b_base(const Unit& u) const { return Bt + (size_t)u.pn * (256 * RB); }
    __device__ __forceinline__ void a_offs(const Unit&, const int*, const int*, unsigned (&)[2], unsigned (&)[2]) const {}
};
typedef SchedPlainT<2048> SchedPlain;
template <int MODE> struct SchedProj {
    pg8::StaticOrder o; const char* A; const char* Bt;
    static constexpr int RB = MODE == 2 ? 1024 : 2048;
    __device__ __forceinline__ bool next(int i, Unit& u) const { if (!o.next(i, u)) return false; const int r = u.pn;
        if (MODE == 1) u.pn = 4 + r;
        if (MODE == 2) u.pn = r < 4 ? r : 15 + r;
        return true; }
    __device__ __forceinline__ const char* a_base(const Unit& u) const { return A + (size_t)u.pm * (256 * RB); }
    __device__ __forceinline__ const char* b_base(const Unit& u) const { return Bt + (size_t)u.pn * (256 * RB); }
    __device__ __forceinline__ void a_offs(const Unit&, const int*, const int*, unsigned (&)[2], unsigned (&)[2]) const {}
};

struct EpiProj {
    static constexpr bool PERM = true;
    bf16_t *Q, *IQ, *Z, *XBC, *GA, *GB; float* MISC; float sc;
    __device__ __forceinline__ void operator()(const AccT& acc, const Unit& u, int wr, int wc, int fr, int fq) const {
        const int pn = u.pn, row0 = u.pm * 256 + wr * 64 + fr, c8 = wc * 32 + 8 * fq;
        if (pn == 6) {
#pragma unroll
            for (int ai = 0; ai < 2; ++ai)
#pragma unroll
                for (int m = 0; m < 4; ++m) { float* rp = MISC + (size_t)(row0 + ai * 128 + m * 16) * 256 + c8;
#pragma unroll
                    for (int bj = 0; bj < 2; ++bj) { *(f32x4*)(rp + bj * 128) = acc[ai][bj][m][0]; *(f32x4*)(rp + bj * 128 + 4) = acc[ai][bj][m][1]; } }
            return;
        }
        bf16_t* base; int ldc, colt, act = 0;
        if (pn < 4) { base = Q; ldc = 1024; colt = pn * 256; }
        else if (pn < 6) { base = IQ; ldc = 512; colt = (pn - 4) * 256; }
        else if (pn < 11) { base = Z; ldc = 1024; colt = (pn - 7) * 256; act = 1; }
        else if (pn < 19) { base = XBC; ldc = 2048; colt = (pn - 11) * 256; }
        else if (pn < 23) { base = GA; ldc = 1024; colt = (pn - 19) * 256; act = 2; }
        else { base = GB; ldc = 1024; colt = (pn - 23) * 256; act = 2; }
#pragma unroll
        for (int ai = 0; ai < 2; ++ai)
#pragma unroll
            for (int m = 0; m < 4; ++m) { bf16_t* rp = base + (size_t)(row0 + ai * 128 + m * 16) * ldc + colt + c8;
#pragma unroll
                for (int bj = 0; bj < 2; ++bj) { f32x4 v0 = acc[ai][bj][m][0] * sc, v1 = acc[ai][bj][m][1] * sc;
                    if (act == 1) {
#pragma unroll
                        for (int j = 0; j < 4; ++j) { v0[j] = silu_f(v0[j]); v1[j] = silu_f(v1[j]); } }
                    if (act == 2) {
#pragma unroll
                        for (int j = 0; j < 4; ++j) { v0[j] = sigmoid_f(v0[j]); v1[j] = sigmoid_f(v1[j]); } }
                    u32x4 pk = pack8(v0, v1); if (DBG_IQ_TRUNC && (pn == 4 || pn == 5)) { pk.x &= 0xfff8fff8u; pk.y &= 0xfff8fff8u; pk.z &= 0xfff8fff8u; pk.w &= 0xfff8fff8u; }
                    *(u32x4*)(rp + bj * 128) = pk; } }
    }
};
template <int MODE> struct EpiGate {
    static constexpr bool PERM = true;
    const bf16_t* Gt; const bf16_t* T; bf16_t* O; float sc;
    __device__ __forceinline__ void operator()(const AccT& acc, const Unit& u, int wr, int wc, int fr, int fq) const {
        const int row0 = u.pm * 256 + wr * 64 + fr, c8 = u.pn * 256 + wc * 32 + 8 * fq;
#pragma unroll
        for (int ai = 0; ai < 2; ++ai) {
            u32x4 gq[4][2], tq[4][2];
#pragma unroll
            for (int m = 0; m < 4; ++m) { const size_t off = (size_t)(row0 + ai * 128 + m * 16) * 1024 + c8;
#pragma unroll
                for (int bj = 0; bj < 2; ++bj) { gq[m][bj] = *(const u32x4*)(Gt + off + bj * 128); if (MODE == 1) tq[m][bj] = *(const u32x4*)(T + off + bj * 128); } }
            SBAR();
#pragma unroll
            for (int m = 0; m < 4; ++m) { const size_t off = (size_t)(row0 + ai * 128 + m * 16) * 1024 + c8;
#pragma unroll
                for (int bj = 0; bj < 2; ++bj) { f32x4 g0, g1; unpack8(gq[m][bj], g0, g1);
                    f32x4 v0 = g0 * (acc[ai][bj][m][0] * sc), v1 = g1 * (acc[ai][bj][m][1] * sc);
                    if ((MODE == 0 && DBG_NO_ATTN) || (MODE == 1 && DBG_NO_SSD)) { v0 = (f32x4){0.f, 0.f, 0.f, 0.f}; v1 = v0; }
                    if (MODE == 1) { f32x4 t0, t1; unpack8(tq[m][bj], t0, t1); v0 += t0; v1 += t1; }
                    *(u32x4*)(O + off + bj * 128) = pack8(v0, v1); } }
            SBAR();
        }
    }
};
struct EpiOut {
    static constexpr bool PERM = false;
    const float* x; const float* mod; float* V;
    __device__ __forceinline__ void operator()(const AccT& acc, const Unit& u, int wr, int wc, int fr, int fq) const {
        const int row0 = u.pm * 256 + wr * 64 + fr, col0 = u.pn * 256 + wc * 32 + 4 * fq;
        const float* g1 = mod + (size_t)(u.pm >> 3) * 6144 + 2048 + col0;
        f32x4 gv[2][2];
#pragma unroll
        for (int bj = 0; bj < 2; ++bj)
#pragma unroll
            for (int n = 0; n < 2; ++n) gv[bj][n] = *(const f32x4*)(g1 + bj * 128 + n * 16);
#pragma unroll
        for (int ai = 0; ai < 2; ++ai)
#pragma unroll
            for (int mp = 0; mp < 2; ++mp) {
                f32x4 xv[2][2][2];
#pragma unroll
                for (int mm = 0; mm < 2; ++mm) { const size_t off = (size_t)(row0 + ai * 128 + (2 * mp + mm) * 16) * 1024 + col0;
#pragma unroll
                    for (int bj = 0; bj < 2; ++bj)
#pragma unroll
                        for (int n = 0; n < 2; ++n) xv[mm][bj][n] = *(const f32x4*)(x + off + bj * 128 + n * 16); }
                SBAR();
#pragma unroll
                for (int mm = 0; mm < 2; ++mm) { const int m = 2 * mp + mm; const size_t off = (size_t)(row0 + ai * 128 + m * 16) * 1024 + col0;
#pragma unroll
                    for (int bj = 0; bj < 2; ++bj)
#pragma unroll
                        for (int n = 0; n < 2; ++n) *(f32x4*)(V + off + bj * 128 + n * 16) = xv[mm][bj][n] * DN_ALPHA + gv[bj][n] * acc[ai][bj][m][n]; }
                SBAR();
            }
    }
};

struct MoeTab { LAS unsigned* cnt; LAS unsigned* tb; LAS unsigned char* te; int ntiles; };
__device__ __forceinline__ MoeTab moe_tables(Frame& F, int hf) {
    MoeTab T; T.cnt = (LAS unsigned*)(F.lds + LDS_AUX); T.tb = (LAS unsigned*)(F.lds + LDS_AUX + 256); T.te = (LAS unsigned char*)(F.lds + LDS_AUX + 512);
    const unsigned* CNT = (const unsigned*)(F.ws + WS_CTL) + CW_CNT;
    __syncthreads();
    if (F.tid < 32) { unsigned c = __hip_atomic_load(CNT + 64 * (hf * 32 + F.tid), __ATOMIC_RELAXED, __HIP_MEMORY_SCOPE_AGENT); if (c > (unsigned)REG_CAP) c = REG_CAP; T.cnt[F.tid] = c; }
    __syncthreads();
    if (F.tid == 0) { unsigned s = 0;
#pragma nounroll
        for (int e = 0; e < 32; ++e) { T.tb[e] = s; const unsigned n = (T.cnt[e] + 255u) >> 8;
#pragma nounroll
            for (unsigned t = 0; t < n; ++t) T.te[s + t] = (unsigned char)e;
            s += n; }
        T.tb[32] = s; }
    __syncthreads();
    T.ntiles = __builtin_amdgcn_readfirstlane((int)T.tb[32]);
    return T;
}
template <int NJ, bool GATHER> struct SchedMoe {
    MoeTab T; int G, c, hf; const char* A; const char* Bt; const u32x2* REG;
    __device__ __forceinline__ bool next(int i, Unit& u) const {
        int tile, j;
        if (G == 256) { const int x = c & 7, sl = c >> 3;
            tile = i * (256 / NJ) + x * (32 / NJ) + sl / NJ; j = sl % NJ;
            if (tile >= T.ntiles) return false; }
        else { const int L = i * G + c; if (L >= T.ntiles * NJ) return false; tile = L / NJ; j = L % NJ; }
        u.pm = tile; u.pn = j; u.ex = __builtin_amdgcn_readfirstlane((int)T.te[u.pm]); return true;
    }
    __device__ __forceinline__ const char* a_base(const Unit& u) const { return GATHER ? A : A + (size_t)u.pm * (256 * MOE_RB); }
    __device__ __forceinline__ const char* b_base(const Unit& u) const { return Bt + ((size_t)u.ex * (NJ * 256) + (size_t)u.pn * 256) * MOE_RB; }
    __device__ __forceinline__ void a_offs(const Unit& u, const int* R, const int* C, unsigned (&o0)[2], unsigned (&o1)[2]) const {
        const unsigned cnt = __builtin_amdgcn_readfirstlane(T.cnt[u.ex]), pos0 = ((unsigned)u.pm - (unsigned)__builtin_amdgcn_readfirstlane(T.tb[u.ex])) * 256u; const u32x2* rg = REG + ((size_t)hf * 32 + u.ex) * REG_CAP;
#pragma unroll
        for (int i = 0; i < 2; ++i) {
            const unsigned p0 = pos0 + (unsigned)R[i], p1 = p0 + 128u;
            unsigned t0 = 0u, t1 = 0u;
            if (p0 < cnt) t0 = (unsigned)hf * HALF_TOK + (rg[p0].x >> 2);
            if (p1 < cnt) t1 = (unsigned)hf * HALF_TOK + (rg[p1].x >> 2);
            o0[i] = t0 * (unsigned)MOE_RB + (unsigned)C[i] * 2u; o1[i] = t1 * (unsigned)MOE_RB + (unsigned)C[i] * 2u;
        }
    }
};
struct EpiMoe1 {
    static constexpr bool PERM = true;
    const float* b1; bf16_t* ACT; int dry;
    __device__ __forceinline__ void operator()(const AccT& acc, const Unit& u, int wr, int wc, int fr, int fq) const {
        if (dry) { if (acc[0][0][0][0][0] == 1.2345e-33f) ACT[0] = 1; return; }
        const int row0 = u.pm * 256 + wr * 64 + fr, c8 = u.pn * 128 + wc * 32 + 8 * fq;
        const float* bg = b1 + (size_t)u.ex * 2048 + c8;
        const f32x4 bg0 = *(const f32x4*)bg, bg1 = *(const f32x4*)(bg + 4), bu0 = *(const f32x4*)(bg + 1024), bu1 = *(const f32x4*)(bg + 1028);
#pragma unroll
        for (int ai = 0; ai < 2; ++ai)
#pragma unroll
            for (int m = 0; m < 4; ++m) {
                f32x4 g0 = acc[ai][0][m][0] * MOE_INV + bg0, g1 = acc[ai][0][m][1] * MOE_INV + bg1, u0 = acc[ai][1][m][0] * MOE_INV + bu0, u1 = acc[ai][1][m][1] * MOE_INV + bu1, a0, a1;
#pragma unroll
                for (int j = 0; j < 4; ++j) {
                    float g = fminf(g0[j], 7.0f), up = fminf(fmaxf(u0[j], -7.0f), 7.0f); a0[j] = (up + 1.0f) * g * sigmoid_f(1.702f * g);
                    g = fminf(g1[j], 7.0f); up = fminf(fmaxf(u1[j], -7.0f), 7.0f); a1[j] = (up + 1.0f) * g * sigmoid_f(1.702f * g); }
                if (MOE_FP8) *(u32x2*)((unsigned char*)ACT + (size_t)(row0 + ai * 128 + m * 16) * 1024 + c8) = pack8_fp8(a0, a1);
                else *(u32x4*)(ACT + (size_t)(row0 + ai * 128 + m * 16) * 1024 + c8) = pack8(a0, a1); }
    }
};
struct EpiMoe2 {
    static constexpr bool PERM = true;
    const float* b2; bf16_t* YB; const u32x2* REG; MoeTab T; int hf; int dry;
    __device__ __forceinline__ void operator()(const AccT& acc, const Unit& u, int wr, int wc, int fr, int fq) const {
        if (dry == 1) { if (acc[0][0][0][0][0] == 1.2345e-33f) YB[0] = 1; return; }
        if (dry >= 2) {
            const int c8d = (dry == 3 ? 0 : u.pn * 256) + wc * 32 + 8 * fq; const unsigned rowd = dry == 3 ? (blockIdx.x * 256u + (unsigned)(wr * 64 + fr)) : ((unsigned)u.pm * 256u + (unsigned)(wr * 64 + fr)) % 131072u;
#pragma unroll
            for (int ai = 0; ai < 2; ++ai)
#pragma unroll
                for (int m = 0; m < 4; ++m) { bf16_t* rp = YB + (size_t)((rowd + ai * 128 + m * 16) % 131072u) * 1024 + c8d;
#pragma unroll
                    for (int bj = 0; bj < 2; ++bj) *(u32x4*)(rp + bj * 128) = pack8(acc[ai][bj][m][0] * MOE_INV, acc[ai][bj][m][1] * MOE_INV); }
            return; }
        const int c8 = u.pn * 256 + wc * 32 + 8 * fq;
        const unsigned cnt = __builtin_amdgcn_readfirstlane(T.cnt[u.ex]), pos0 = ((unsigned)u.pm - (unsigned)__builtin_amdgcn_readfirstlane(T.tb[u.ex])) * 256u + (unsigned)(wr * 64 + fr); const u32x2* rg = REG + ((size_t)hf * 32 + u.ex) * REG_CAP;
        const float* bb = b2 + (size_t)u.ex * 1024 + c8;
        f32x4 bv[2][2];
#pragma unroll
        for (int bj = 0; bj < 2; ++bj) { bv[bj][0] = *(const f32x4*)(bb + bj * 128); bv[bj][1] = *(const f32x4*)(bb + bj * 128 + 4); }
        u32x2 en8[2][4];
#pragma unroll
        for (int ai = 0; ai < 2; ++ai)
#pragma unroll
            for (int m = 0; m < 4; ++m) { const unsigned p = pos0 + (unsigned)(ai * 128 + m * 16); en8[ai][m] = rg[p < cnt ? p : cnt - 1u]; }
#pragma unroll
        for (int ai = 0; ai < 2; ++ai)
#pragma unroll
            for (int m = 0; m < 4; ++m) { const unsigned p = pos0 + (unsigned)(ai * 128 + m * 16);
                const u32x2 en = en8[ai][m]; const float g = __uint_as_float(en.y); const unsigned drow = p < cnt ? en.x : (unsigned)(HALF_TOK * 4);
                bf16_t* rp = YB + (size_t)drow * 1024 + c8;
#pragma unroll
                for (int bj = 0; bj < 2; ++bj) *(u32x4*)(rp + bj * 128) = pack8((acc[ai][bj][m][0] * MOE_INV + bv[bj][0]) * g, (acc[ai][bj][m][1] * MOE_INV + bv[bj][1]) * g); }
    }
};

struct MapIdent { __device__ __forceinline__ int operator()(int n) const { return n; } };
struct MapWin { __device__ __forceinline__ int operator()(int n) const {
    if (n < 1024) return n;
    if (n < 1536) return 1152 + (n - 1024);
    if (n < 1792) { const int c = n - 1536; if (c < 128) return 1024 + c; if (c < 192) return 1664 + (c - 128); if (c < 200) return 1728 + (c - 192); if (c < 216) return 4808 + (c - 200); return -1; }
    if (n < 2816) return 1736 + (n - 1792);
    if (n < 4864) return 2760 + (n - 2816);
    if (n < 5888) return 4824 + (n - 4864);
    return 5848 + (n - 5888); } };
struct MapW1 { __device__ __forceinline__ int operator()(int r) const { const int j = r >> 8, rr = r & 255; return (rr >> 7) * 1024 + j * 128 + (rr & 127); } };
template <class Map, bool F8 = false> __device__ __forceinline__ void transpose_item(const float* W, int K, int N, bf16_t* WT, const Map& map, LAS float* scr, int kb, int nb, int lane, const float* rowscale) {
    const int k0 = 64 * kb, n0 = 64 * nb, q = lane & 15, kr = lane >> 4; const int src = map(n0 + 4 * q);
    f32x4 ld[16];
#pragma unroll
    for (int i = 0; i < 16; ++i) { const int kk = 4 * i + kr; ld[i] = (src >= 0) ? *(const f32x4*)(W + (size_t)(k0 + kk) * N + src) : (f32x4){0.f, 0.f, 0.f, 0.f}; }
#pragma unroll
    for (int i = 0; i < 16; ++i) { const int kk = 4 * i + kr; f32x4 v = ld[i]; if (rowscale) v = v * rowscale[k0 + kk]; LAS float* d = scr + kk * 65 + 4 * q; d[0] = v[0]; d[1] = v[1]; d[2] = v[2]; d[3] = v[3]; }
    LDS_WAIT(); asm volatile("" ::: "memory");
    const int c = lane & 7;
#pragma unroll
    for (int j = 0; j < 8; ++j) { const int n = (lane >> 3) + 8 * j; const LAS float* s = scr + (8 * c) * 65 + n;
        if constexpr (F8) { const f32x4 a = {s[0 * 65] * MOE_WSC, s[1 * 65] * MOE_WSC, s[2 * 65] * MOE_WSC, s[3 * 65] * MOE_WSC}, b = {s[4 * 65] * MOE_WSC, s[5 * 65] * MOE_WSC, s[6 * 65] * MOE_WSC, s[7 * 65] * MOE_WSC};
            *(u32x2*)((unsigned char*)WT + (size_t)(n0 + n) * K + k0 + 8 * c) = pack8_fp8(a, b); }
        else { u32x4 o; o.x = cvt_pk_bf16(s[0 * 65], s[1 * 65]); o.y = cvt_pk_bf16(s[2 * 65], s[3 * 65]); o.z = cvt_pk_bf16(s[4 * 65], s[5 * 65]); o.w = cvt_pk_bf16(s[6 * 65], s[7 * 65]);
            *(u32x4*)(WT + (size_t)(n0 + n) * K + k0 + 8 * c) = o; } }
    LDS_WAIT(); asm volatile("" ::: "memory");
}
struct TrItem { const float* W; const float* rowscale; unsigned char* WT; int N, src, k0, n0, f8; };
__device__ __forceinline__ TrItem tr_decode(Frame& F, int it) {
    constexpr int I_WIN = 16 * (NPROJ / 64), I_SQ = 16 * 16, I_W1E = 16 * 32, I_W2E = 16 * 16;
    TrItem d; d.rowscale = nullptr; int r = it, kb, nb; const int q4 = 4 * (F.lane & 15);
    if (r < (PROJ_FP8 ? 2 : 1) * I_WIN) { const int f8 = r >= I_WIN; if (f8) r -= I_WIN; kb = r / (NPROJ / 64); nb = r % (NPROJ / 64);
        d.W = F.a->in[4]; d.N = 6872; d.src = MapWin()(64 * nb + q4); d.WT = F.ws + (f8 ? WS_WIN8 : WS_WIN); d.f8 = f8; }
    else { r -= (PROJ_FP8 ? 2 : 1) * I_WIN;
        if (r < 3 * I_SQ) { const int w = r / I_SQ; r -= w * I_SQ; kb = r / 16; nb = r % 16; d.N = 1024; d.src = 64 * nb + q4;
            if (w == 0) { d.W = F.a->in[15]; d.WT = F.ws + (PA_FP8 ? WS_WPA8 : WS_WPA); d.f8 = PA_FP8; }
            else if (w == 1) { d.W = F.a->in[16]; d.WT = F.ws + (PB_FP8 ? WS_WPB8 : WS_WPB); d.f8 = PB_FP8; d.rowscale = F.a->in[14]; }
            else { d.W = F.a->in[17]; d.WT = F.ws + WS_WOUT; d.f8 = 0; } }
        else { r -= 3 * I_SQ;
            if (r < 32 * I_W1E) { const int e = r / I_W1E, q = r % I_W1E; kb = q / 32; nb = q % 32; d.W = F.a->in[22] + (size_t)e * 1024 * 2048; d.N = 2048; d.src = MapW1()(64 * nb + q4);
                d.WT = F.ws + WS_W1 + (size_t)e * 2048 * MOE_RB; d.f8 = MOE_FP8; }
            else { r -= 32 * I_W1E; const int e = r / I_W2E, q = r % I_W2E; kb = q / 16; nb = q % 16; d.W = F.a->in[24] + (size_t)e * 1024 * 1024; d.N = 1024; d.src = 64 * nb + q4;
                d.WT = F.ws + WS_W2 + (size_t)e * 1024 * MOE_RB; d.f8 = MOE_FP8; } } }
    d.k0 = 64 * kb; d.n0 = 64 * nb; return d; }
__device__ __forceinline__ void tr_load(const TrItem& d, f32x4 (&ld)[16], int lane) {
    const int kr = lane >> 4; const float* p = d.W + (size_t)(d.k0 + kr) * d.N + (d.src >= 0 ? d.src : 0);
#pragma unroll
    for (int i = 0; i < 16; ++i) ld[i] = *(const f32x4*)(p + (size_t)(4 * i) * d.N); }
__device__ __forceinline__ void tr_finish(const TrItem& d, f32x4 (&ld)[16], LAS float* scr, int lane) {
    const int q = lane & 15, kr = lane >> 4; const bool zero = d.src < 0;
#pragma unroll
    for (int i = 0; i < 16; ++i) { const int kk = 4 * i + kr; f32x4 v = ld[i]; if (zero) v = (f32x4){0.f, 0.f, 0.f, 0.f}; if (d.rowscale) v = v * d.rowscale[d.k0 + kk];
        LAS float* o = scr + kk * 65 + 4 * q; o[0] = v[0]; o[1] = v[1]; o[2] = v[2]; o[3] = v[3]; }
    LDS_WAIT(); asm volatile("" ::: "memory");
    const int c = lane & 7;
    if (d.f8) {
#pragma unroll
        for (int j = 0; j < 8; ++j) { const int n = (lane >> 3) + 8 * j; const LAS float* s = scr + (8 * c) * 65 + n;
            const f32x4 a = {s[0 * 65] * MOE_WSC, s[1 * 65] * MOE_WSC, s[2 * 65] * MOE_WSC, s[3 * 65] * MOE_WSC}, b = {s[4 * 65] * MOE_WSC, s[5 * 65] * MOE_WSC, s[6 * 65] * MOE_WSC, s[7 * 65] * MOE_WSC};
            *(u32x2*)((unsigned char*)d.WT + (size_t)(d.n0 + n) * 1024 + d.k0 + 8 * c) = pack8_fp8(a, b); } }
    else {
#pragma unroll
        for (int j = 0; j < 8; ++j) { const int n = (lane >> 3) + 8 * j; const LAS float* s = scr + (8 * c) * 65 + n;
            u32x4 o; o.x = cvt_pk_bf16(s[0 * 65], s[1 * 65]); o.y = cvt_pk_bf16(s[2 * 65], s[3 * 65]); o.z = cvt_pk_bf16(s[4 * 65], s[5 * 65]); o.w = cvt_pk_bf16(s[6 * 65], s[7 * 65]);
            *(u32x4*)((bf16_t*)d.WT + (size_t)(d.n0 + n) * 1024 + d.k0 + 8 * c) = o; } }
    LDS_WAIT(); asm volatile("" ::: "memory");
}
__device__ __forceinline__ void ph_prologue(Frame& F) {
    const float* c_in = F.a->in[1]; const float* w_mod = F.a->in[2]; const float* b_mod = F.a->in[3];
    float* MOD = (float*)(F.ws + WS_MOD);
    for (int item = F.bid; item < 192; item += F.G) {
        LAS float* SC = (LAS float*)F.lds;
        __syncthreads();
        for (int i = F.tid; i < 32768; i += NTHR) { const int b = i >> 10, k = i & 1023; SC[k * 36 + b] = silu_f(c_in[i]); }
        __syncthreads();
        const int col = item * 32 + (F.tid >> 4), kq = F.tid & 15;
        float a[32];
#pragma unroll
        for (int b = 0; b < 32; ++b) a[b] = 0.f;
#pragma nounroll
        for (int kg = 0; kg < 64; kg += 16) {
            float wv[16];
#pragma unroll
            for (int u = 0; u < 16; ++u) wv[u] = w_mod[(size_t)((kg + u) * 16 + kq) * 6144 + col];
#pragma unroll
            for (int u = 0; u < 16; ++u) { const int k = (kg + u) * 16 + kq; const float w = wv[u];
#pragma unroll
                for (int b4 = 0; b4 < 8; ++b4) { const f32x4 s = *(const LAS f32x4*)(SC + k * 36 + b4 * 4); a[b4 * 4 + 0] += w * s[0]; a[b4 * 4 + 1] += w * s[1]; a[b4 * 4 + 2] += w * s[2]; a[b4 * 4 + 3] += w * s[3]; } } }
#pragma unroll
        for (int b = 0; b < 32; ++b) { a[b] += __shfl_xor(a[b], 1); a[b] += __shfl_xor(a[b], 2); a[b] += __shfl_xor(a[b], 4); a[b] += __shfl_xor(a[b], 8); }
        { const float bm = b_mod[col];
#pragma unroll
            for (int b = 1; b < 16; ++b) { a[0] = (kq == b) ? a[b] : a[0]; a[16] = (kq == b) ? a[16 + b] : a[16]; }
            MOD[(size_t)kq * 6144 + col] = a[0] + bm; MOD[(size_t)(kq + 16) * 6144 + col] = a[16] + bm; }
        __syncthreads();
    }
    if (F.bid == (F.G > 192 ? 192 : 0)) {
        float* BT = (float*)(F.ws + WS_BIAST); const float* rel_bias = F.a->in[8];
        for (int i = F.tid; i < 249 * 8; i += NTHR) { const int idx = i >> 3, h = i & 7, rel = idx - 185; const int n = rel < 0 ? -rel : rel;
            const float nf = (float)(n > 1 ? n : 1); int large = 8 + (int)(logf(nf / 8.0f) / 2.7725887f * 8.0f); if (large > 15) large = 15;
            const int bucket = (rel > 0 ? 16 : 0) + (n < 8 ? n : large);
            BT[i] = rel_bias[bucket * 8 + h] * LOG2E; }
    }
    LAS float* scr = (LAS float*)(F.lds + F.wave * 16640);
    __syncthreads();
    const int gw = F.bid * NWAVES + F.wave, NGW = F.G * NWAVES;
    constexpr int I_WIN = 16 * (NPROJ / 64), I_SQ = 16 * 16, I_W1E = 16 * 32, I_W2E = 16 * 16;
    constexpr int NITEMS = (PROJ_FP8 ? 2 : 1) * I_WIN + 3 * I_SQ + 32 * I_W1E + 32 * I_W2E;
    TrItem d0, d1; f32x4 la[16], lb[16];
    int it = gw;
    if (it < NITEMS) { d0 = tr_decode(F, it); tr_load(d0, la, F.lane); }
    while (it < NITEMS) {
        const int i1 = it + NGW; const bool v1 = i1 < NITEMS;
        if (v1) { d1 = tr_decode(F, i1); tr_load(d1, lb, F.lane); }
        tr_finish(d0, la, scr, F.lane);
        if (!v1) break;
        const int i2 = i1 + NGW; const bool v2 = i2 < NITEMS;
        if (v2) { d0 = tr_decode(F, i2); tr_load(d0, la, F.lane); }
        tr_finish(d1, lb, scr, F.lane);
        it = i2;
    }
}

__device__ __forceinline__ void ph_ln1(Frame& F) {
    const float* x = F.a->in[0]; const float* MOD = (const float*)(F.ws + WS_MOD); bf16_t* U = (bf16_t*)(F.outb + OUT_U);
    const int gw = F.bid * NWAVES + F.wave, NGW = F.G * NWAVES;
    constexpr int RB = 4;
    for (int m0 = gw; m0 < NTOK; m0 += NGW * RB) {
        f32x4 v[RB][4];
#pragma unroll
        for (int r = 0; r < RB; ++r) { const f32x4* xr = (const f32x4*)(x + (size_t)(m0 + r * NGW) * D) + F.lane;
#pragma unroll
            for (int j = 0; j < 4; ++j) v[r][j] = xr[64 * j]; }
#pragma unroll
        for (int r = 0; r < RB; ++r) { const int m = m0 + r * NGW; const float* md = MOD + (size_t)(m >> 11) * 6144;
            float s = 0.f;
#pragma unroll
            for (int j = 0; j < 4; ++j) s += (v[r][j][0] + v[r][j][1]) + (v[r][j][2] + v[r][j][3]);
            const float mean = wave_sum(s) * (1.f / D); float s2 = 0.f;
#pragma unroll
            for (int j = 0; j < 4; ++j) { v[r][j] = v[r][j] - mean; s2 += (v[r][j][0] * v[r][j][0] + v[r][j][1] * v[r][j][1]) + (v[r][j][2] * v[r][j][2] + v[r][j][3] * v[r][j][3]); }
            const float rstd = 1.f / sqrtf(wave_sum(s2) * (1.f / D) + LN_EPS);
            u32x2* o8 = (u32x2*)(U + (size_t)m * D) + F.lane;
#pragma unroll
            for (int j = 0; j < 4; ++j) { const f32x4 sh = *((const f32x4*)md + F.lane + 64 * j), sc = *((const f32x4*)(md + 1024) + F.lane + 64 * j);
                const f32x4 rr = v[r][j] * rstd * (sc + 1.0f) + sh; u32x2 w; w.x = cvt_pk_bf16(rr[0], rr[1]); w.y = cvt_pk_bf16(rr[2], rr[3]); o8[64 * j] = w;
                if (PROJ_FP8) { int pk = 0; pk = __builtin_amdgcn_cvt_pk_fp8_f32(rr[0], rr[1], pk, false); pk = __builtin_amdgcn_cvt_pk_fp8_f32(rr[2], rr[3], pk, true); ((unsigned*)(F.ws + WS_U8 + (size_t)m * D))[F.lane + 64 * j] = (unsigned)pk; } } }
    }
}

__device__ __forceinline__ void ph_misc(Frame& F) {
    const float* MISC = (const float*)(F.outb + OUT_MISC);
    bf16_t* KV = (bf16_t*)(F.outb + OUT_KV); bf16_t* IK = (bf16_t*)(F.outb + OUT_IK); float* IW = (float*)(F.outb + OUT_IW); float* DT = (float*)(F.outb + OUT_DT);
    const float* kvw = F.a->in[5]; const float* ikw = F.a->in[6]; const float* ikb = F.a->in[7]; const float* dtb = F.a->in[11];
    const int gw = F.bid * NWAVES + F.wave, NGW = F.G * NWAVES, l = F.lane;
    for (int m0 = gw; m0 < NTOK; m0 += NGW * 4) {
      f32x4 vv[4];
#pragma unroll
      for (int r = 0; r < 4; ++r) vv[r] = *((const f32x4*)(MISC + (size_t)(m0 + r * NGW) * 256) + l);
#pragma unroll
      for (int r = 0; r < 4; ++r) { const int m = m0 + r * NGW;
        const f32x4 v = vv[r];
        const float sq = v[0] * v[0] + v[1] * v[1] + v[2] * v[2] + v[3] * v[3], sm = (v[0] + v[1]) + (v[2] + v[3]);
        const float kvss = wave_sum(l < 32 ? sq : 0.f);
        const float iks = wave_sum((l >= 32 && l < 48) ? sm : 0.f);
        const float ikmean = iks * (1.f / 64.f);
        const f32x4 dv = v - ikmean;
        const float ikq = wave_sum((l >= 32 && l < 48) ? (dv[0] * dv[0] + dv[1] * dv[1] + dv[2] * dv[2] + dv[3] * dv[3]) : 0.f);
        if (l < 32) { const float r = 1.f / sqrtf(kvss * (1.f / 128.f) + LN_EPS); const f32x4 w = *((const f32x4*)kvw + l); const f32x4 o = v * r * w;
            u32x2 pk; pk.x = cvt_pk_bf16(o[0], o[1]); pk.y = cvt_pk_bf16(o[2], o[3]); *((u32x2*)(KV + (size_t)m * 128) + l) = pk; }
        else if (l < 48) { const float r = 1.f / sqrtf(ikq * (1.f / 64.f) + LN_EPS); const f32x4 w = *((const f32x4*)ikw + (l - 32)), bb = *((const f32x4*)ikb + (l - 32)); const f32x4 o = dv * r * w + bb;
            u32x2 pk; pk.x = cvt_pk_bf16(o[0], o[1]); pk.y = cvt_pk_bf16(o[2], o[3]); *((u32x2*)(IK + (size_t)m * 64) + (l - 32)) = pk; }
        else if (l < 50) { *((f32x4*)(IW + (size_t)m * 8) + (l - 48)) = v * 0.35355339059327373f; }
        else if (l < 54) { const f32x4 bb = *((const f32x4*)dtb + (l - 50)); f32x4 o;
#pragma unroll
            for (int j = 0; j < 4; ++j) { const float t = v[j] + bb[j]; o[j] = t > 20.f ? t : log1pf(__expf(t)); }
            *((f32x4*)(DT + (size_t)m * 16) + (l - 50)) = o; }
      }
    }
}

__device__ __forceinline__ unsigned sortable_key(float s) { const unsigned u = __float_as_uint(s + 0.0f); return (u & 0x80000000u) ? ~u : (u | 0x80000000u); }
template <int NKB> struct KeyRow { unsigned k[NKB]; };
__device__ __forceinline__ u64 low_bits_keep(u64 m, int t) { u64 out = 0; while (t-- > 0 && m) { const u64 b = m & (0 - m); out |= b; m ^= b; } return out; }
namespace idx { constexpr int KST = 144, KBUF = 64 * KST; }
__device__ __forceinline__ unsigned low_bits_keep32(unsigned m, int t) { unsigned out = 0; while (t-- > 0 && m) { const unsigned b = m & (0u - m); out |= b; m ^= b; } return out; }
template <int NG> __device__ __forceinline__ void topk2_select_write(const unsigned (&key)[64], int nkb, u64* mrow, int lane) {
    constexpr int NR = NG * 16;
    unsigned T0 = 0u, T1 = 0u; bool ex0 = false, ex1 = false;
    unsigned lo0 = 0u, lo1 = 0u, hi0 = 0xFFFFFFFFu, hi1 = 0xFFFFFFFFu, st0, st1, p0, p1; bool fin0 = false, fin1 = false;
    { float sm = 0.f, sq = 0.f;
#pragma unroll
        for (int m = 0; m < 10; ++m) { const unsigned k = key[m]; const float f = __uint_as_float((k & 0x80000000u) ? (k ^ 0x80000000u) : ~k); sm += f; sq += f * f; }
#pragma unroll
        for (int o = 1; o < 32; o <<= 1) { sm += __shfl_xor(sm, o); sq += __shfl_xor(sq, o); }
        const float mu = sm * (1.f / 320.f), sd = sqrtf(fmaxf(sq * (1.f / 320.f) - mu * mu, 1e-20f));
        const float qq = 256.f / (64.f * (float)nkb), pp = qq < 0.5f ? qq : 1.f - qq, tt = sqrtf(-2.f * __logf(pp));
        float z = tt - (2.515517f + 0.802853f * tt + 0.010328f * tt * tt) / (1.f + 1.432788f * tt + 0.189269f * tt * tt + 0.001308f * tt * tt * tt); if (qq >= 0.5f) z = -z;
        const unsigned pe = sortable_key(mu + z * sd), pd = sortable_key(mu + z * sd + 0.125f * sd);
        unsigned stp = pd - pe; if (stp < 1024u) stp = 1024u;
        p0 = __builtin_amdgcn_readlane((int)pe, 0); p1 = __builtin_amdgcn_readlane((int)pe, 32); st0 = __builtin_amdgcn_readlane((int)stp, 0); st1 = __builtin_amdgcn_readlane((int)stp, 32); }
#pragma nounroll
    for (int it = 0; it < 80; ++it) {
        const unsigned candv = lane < 32 ? p0 : p1;
        unsigned cl = 0u;
#pragma unroll
        for (int m = 0; m < NR; m += 4) { u64 s0, s1, s2, s3;
            asm("v_cmp_ge_u32_e64 %1, %5, %9\n\tv_cmp_ge_u32_e64 %2, %6, %9\n\tv_cmp_ge_u32_e64 %3, %7, %9\n\tv_cmp_ge_u32_e64 %4, %8, %9\n\t"
                "v_addc_co_u32_e64 %0, %1, 0, %0, %1\n\tv_addc_co_u32_e64 %0, %2, 0, %0, %2\n\tv_addc_co_u32_e64 %0, %3, 0, %0, %3\n\tv_addc_co_u32_e64 %0, %4, 0, %0, %4"
                : "+v"(cl), "=&s"(s0), "=&s"(s1), "=&s"(s2), "=&s"(s3) : "v"(key[m]), "v"(key[m + 1]), "v"(key[m + 2]), "v"(key[m + 3]), "v"(candv)); }
        cl += __shfl_xor(cl, 1); cl += __shfl_xor(cl, 2); cl += __shfl_xor(cl, 4); cl += __shfl_xor(cl, 8); cl += __shfl_xor(cl, 16);
        const int n0 = __builtin_amdgcn_readlane((int)cl, 0), n1 = __builtin_amdgcn_readlane((int)cl, 32);
#define IDX_STEP(lo, hi, st, p, T, ex, fin, n) do { if (!fin) { \
            if (n == 256) { T = p; ex = true; fin = true; } \
            else { if (n > 256) lo = p; else hi = p; \
                if (hi - lo <= 1u) { T = lo; fin = true; } \
                else { unsigned c; if (hi == 0xFFFFFFFFu) { c = lo + st; if (c < lo) c = hi; st = st << 1; } else if (lo == 0u) { c = hi - st; if (c > hi) c = lo; st = st << 1; } else c = lo + ((hi - lo) >> 1); \
                    if (c <= lo || c >= hi) c = lo + ((hi - lo) >> 1); p = c; } } } } while (0)
        IDX_STEP(lo0, hi0, st0, p0, T0, ex0, fin0, n0);
        IDX_STEP(lo1, hi1, st1, p1, T1, ex1, fin1, n1);
#undef IDX_STEP
        if (fin0 && fin1) break;
    }
    const unsigned Tv = lane < 32 ? T0 : T1;
    if (ex0 && ex1) {
        unsigned mlo = 0u, mhi = 0u;
#pragma unroll
        for (int j = 0; j < NR / 2; ++j) {
            const u64 b0 = __ballot(key[2 * j] >= Tv), b1 = __ballot(key[2 * j + 1] >= Tv);
            asm volatile("s_nop 1\n\tv_writelane_b32 %0, %2, %6\n\tv_writelane_b32 %0, %3, %7\n\tv_writelane_b32 %1, %4, %6\n\tv_writelane_b32 %1, %5, %7"
                         : "+v"(mlo), "+v"(mhi) : "s"((unsigned)b0), "s"((unsigned)(b0 >> 32)), "s"((unsigned)b1), "s"((unsigned)(b1 >> 32)), "n"(j), "n"(32 + j));
            if ((j & 3) == 3) SBAR();
        }
        const int jl = lane & 31;
        if (jl < nkb) mrow[(lane >> 5) * 32 + jl] = (u64)mlo | ((u64)mhi << 32);
        return;
    }
    int rem0 = 1 << 30, rem1 = 1 << 30;
    { int g0 = 0, g1 = 0;
#pragma unroll
        for (int m = 0; m < NR; ++m) { const u64 mk = __ballot(key[m] > Tv); g0 += __builtin_popcount((unsigned)mk); g1 += __builtin_popcount((unsigned)(mk >> 32)); if ((m & 7) == 7) SBAR(); }
        if (!ex0) rem0 = 256 - g0; if (!ex1) rem1 = 256 - g1; }
    u64 mine = 0ull;
#pragma nounroll
    for (int jq = 0; jq < NR / 8; ++jq) {
#pragma unroll
        for (int jj = 0; jj < 4; ++jj) { const int j = jq * 4 + jj;
            unsigned w0[2], w1[2];
#pragma unroll
            for (int hh = 0; hh < 2; ++hh) { unsigned kv = 0u;
#pragma unroll
                for (int m = 0; m < NR; ++m) if ((m >> 3) == 0) {}
#pragma unroll
                for (int m = 0; m < NR; ++m) kv = (m == 2 * j + hh) ? key[m] : kv;
                const u64 gt = __ballot(kv > Tv), eq = __ballot(kv == Tv);
                { const unsigned e = (unsigned)eq, g = (unsigned)gt; const int ne = __builtin_popcount(e); unsigned sel = g; if (rem0 >= ne) { sel |= e; rem0 -= ne; } else if (rem0 > 0) { sel |= low_bits_keep32(e, rem0); rem0 = 0; } w0[hh] = sel; }
                { const unsigned e = (unsigned)(eq >> 32), g = (unsigned)(gt >> 32); const int ne = __builtin_popcount(e); unsigned sel = g; if (rem1 >= ne) { sel |= e; rem1 -= ne; } else if (rem1 > 0) { sel |= low_bits_keep32(e, rem1); rem1 = 0; } w1[hh] = sel; } }
            const u64 q0w = (u64)w0[0] | ((u64)w0[1] << 32), q1w = (u64)w1[0] | ((u64)w1[1] << 32);
            if (lane == j) mine = q0w; if (lane == 32 + j) mine = q1w; }
    }
    const int jl = lane & 31;
    if (jl < nkb) mrow[(lane >> 5) * 32 + jl] = mine;
}
template <int J0> __device__ __forceinline__ void index_scores8(unsigned (&key)[64], const bf16x8 (&af)[2], const f32x4& iw4, const bf16_t* kvsrc, char* lds, int nkb, u32x4 (&stg)[8], int tid) {
    const int lane = tid & 63, sub = lane & 15, kg = lane >> 4;
#pragma unroll
    for (int jj = 0; jj < 8; ++jj) {
        const int j = J0 + jj;
        if (j < nkb) {
            if (j + 1 < nkb) *(u32x4*)(lds + ((j + 1) & 1) * idx::KBUF + (tid >> 3) * idx::KST + (tid & 7) * 16) = stg[(jj + 1) & 7];
            if (j + 8 < nkb) stg[jj] = *(const u32x4*)(kvsrc + (size_t)(j + 8) * 64 * 64);
            const char* kb = lds + (j & 1) * idx::KBUF + sub * idx::KST + kg * 16;
#pragma unroll
            for (int pr = 0; pr < 2; ++pr) {
                f32x4 dA = (f32x4){0.f, 0.f, 0.f, 0.f}, dB = dA;
#pragma unroll
                for (int ks = 0; ks < 2; ++ks) {
                    const bf16x8 fA = *(const bf16x8*)(kb + (pr * 32) * idx::KST + ks * 64), fB = *(const bf16x8*)(kb + (pr * 32 + 16) * idx::KST + ks * 64);
                    dA = __builtin_amdgcn_mfma_f32_16x16x32_bf16(af[ks], fA, dA, 0, 0, 0); dB = __builtin_amdgcn_mfma_f32_16x16x32_bf16(af[ks], fB, dB, 0, 0, 0); }
                float pA = 0.f, pB = 0.f;
#pragma unroll
                for (int r = 0; r < 4; ++r) { pA += fmaxf(dA[r], 0.f) * iw4[r]; pB += fmaxf(dB[r], 0.f) * iw4[r]; }
                auto rr = __builtin_amdgcn_permlane16_swap(__float_as_uint(pA), __float_as_uint(pB), false, false);
                key[2 * j + pr] = sortable_key(__uint_as_float(rr[0]) + __uint_as_float(rr[1]));
            }
            __syncthreads();
        }
    }
}
__device__ __forceinline__ void ph_index(Frame& F) {
    const bf16_t* IQ = (const bf16_t*)(F.outb + OUT_IQ); const bf16_t* IK = (const bf16_t*)(F.outb + OUT_IK); const float* IW = (const float*)(F.outb + OUT_IW);
    u64* MASK = (u64*)(F.outb + OUT_MASK);
    char* lds = (char*)(unsigned char*)F.lds;
    const int tid = F.tid, lane = F.lane, sub = lane & 15, kg = lane >> 4;
    for (int item = F.bid; item < NTOK / 16; item += F.G) {
        const int tokw = (((item & 255) >> 3) << 11) + (((item & 7) + 8 * (item >> 8)) << 4) + F.wave * 2, b = tokw >> 11, pos0 = tokw & 2047, nkb = (pos0 >> 6) + 1;
        u64* mrow = MASK + (size_t)tokw * 32;
        if (nkb <= 4) { if ((lane & 31) < nkb) mrow[(lane >> 5) * 32 + (lane & 31)] = ~0ull; continue; }
        bf16x8 af[2];
        { const bf16_t* ap = IQ + (size_t)(tokw + (sub >> 3)) * 512 + (sub & 7) * 64 + kg * 8;
#pragma unroll
          for (int ks = 0; ks < 2; ++ks) af[ks] = *(const bf16x8*)(ap + ks * 32); }
        const f32x4 iw4 = *(const f32x4*)(IW + (size_t)(tokw + (lane >> 5)) * 8 + 4 * (kg & 1));
        unsigned key[64];
#pragma unroll
        for (int m = 0; m < 64; ++m) key[m] = 0u;
        const bf16_t* kvsrc = IK + ((size_t)b * SEQ + (tid >> 3)) * 64 + (tid & 7) * 8;
        u32x4 stg[8];
#pragma unroll
        for (int i = 0; i < 8; ++i) stg[i] = (i < nkb) ? *(const u32x4*)(kvsrc + (size_t)i * 64 * 64) : (u32x4){0u, 0u, 0u, 0u};
        __syncthreads();
        *(u32x4*)(lds + (tid >> 3) * idx::KST + (tid & 7) * 16) = stg[0];
        __syncthreads();
        const int ng = (nkb + 7) >> 3;
        index_scores8<0>(key, af, iw4, kvsrc, lds, nkb, stg, tid);
        if (ng > 1) index_scores8<8>(key, af, iw4, kvsrc, lds, nkb, stg, tid);
        if (ng > 2) index_scores8<16>(key, af, iw4, kvsrc, lds, nkb, stg, tid);
        if (ng > 3) index_scores8<24>(key, af, iw4, kvsrc, lds, nkb, stg, tid);
        if (ng == 1) topk2_select_write<1>(key, nkb, mrow, lane);
        else if (ng == 2) topk2_select_write<2>(key, nkb, mrow, lane);
        else if (ng == 3) topk2_select_write<3>(key, nkb, mrow, lane);
        else topk2_select_write<4>(key, nkb, mrow, lane);
    }
}

namespace att {
constexpr int KVBLK = 64;
constexpr int SHM_V = KVBLK * 128 * 2, SHM_K = SHM_V;
constexpr int OFF_V = 0, OFF_K = 2 * SHM_V, OFF_WS = 2 * SHM_V + 2 * SHM_K, OFF_BT = OFF_WS + NWAVES * 64 * 4;
#define KSWZ(row, colB) ((row) * 256 + ((colB) ^ (((row) & 7) << 4)))
__device__ __forceinline__ int crow(int r, int hi) { return (r & 3) + 8 * (r >> 2) + 4 * hi; }
__device__ __forceinline__ int v_st(int k, int c) { const int kk = (k & ~0xC) | ((k & 4) << 1) | ((k & 8) >> 1); return ((kk >> 3) * 4 + (c >> 5)) * 512 + ((kk & 7) * 32 + (c & 31)) * 2; }
__device__ __forceinline__ int v_rd_base(int lane) { return ((lane & 3) << 3) | (((lane >> 2) & 3) << 6) | (((lane >> 4) & 1) << 5) | (((lane >> 5) & 1) << 8); }
constexpr int v_rd_off(int d0, int ks, int half) { return d0 * 512 + ks * 4096 + half * 2048; }
template <int OFF> __device__ __forceinline__ s16x4 tr_read(int vb) { s16x4 r; asm volatile("ds_read_b64_tr_b16 %0, %1 offset:%2" : "=&v"(r) : "v"(vb), "i"(OFF) : "memory"); return r; }
template <int D0> __device__ __forceinline__ void pv_one(f32x16& od, int vb, bf16x8 pa0, bf16x8 pa1, bf16x8 pa2, bf16x8 pa3) {
    const s16x4 l0 = tr_read<v_rd_off(D0, 0, 0)>(vb), h0 = tr_read<v_rd_off(D0, 0, 1)>(vb), l1 = tr_read<v_rd_off(D0, 1, 0)>(vb), h1 = tr_read<v_rd_off(D0, 1, 1)>(vb);
    const s16x4 l2 = tr_read<v_rd_off(D0, 2, 0)>(vb), h2 = tr_read<v_rd_off(D0, 2, 1)>(vb), l3 = tr_read<v_rd_off(D0, 3, 0)>(vb), h3 = tr_read<v_rd_off(D0, 3, 1)>(vb);
    asm volatile("s_waitcnt lgkmcnt(0)" ::: "memory"); SBAR();
#define PK(L, H) (bf16x8){L[0], L[1], L[2], L[3], H[0], H[1], H[2], H[3]}
    od = __builtin_amdgcn_mfma_f32_32x32x16_bf16(pa0, PK(l0, h0), od, 0, 0, 0);
    od = __builtin_amdgcn_mfma_f32_32x32x16_bf16(pa1, PK(l1, h1), od, 0, 0, 0);
    od = __builtin_amdgcn_mfma_f32_32x32x16_bf16(pa2, PK(l2, h2), od, 0, 0, 0);
    od = __builtin_amdgcn_mfma_f32_32x32x16_bf16(pa3, PK(l3, h3), od, 0, 0, 0);
#undef PK
}
__device__ __forceinline__ void qkt(f32x16& p0, f32x16& p1, const char* Ks, const bf16x8* qr, int r32, int hi) {
    p0 = f32x16{}; p1 = f32x16{};
    int rv = r32; asm volatile("" : "+v"(rv));
    const char* kb = Ks + rv * 256; const int swz = ((rv & 7) << 4) ^ (hi * 16);
#pragma unroll
    for (int d0 = 0; d0 < 8; ++d0) { const char* ka = kb + ((d0 * 32) ^ swz);
        const bf16x8 b0 = *reinterpret_cast<const bf16x8*>(ka);
        const bf16x8 b1 = *reinterpret_cast<const bf16x8*>(ka + 8192);
        p0 = __builtin_amdgcn_mfma_f32_32x32x16_bf16(b0, qr[d0], p0, 0, 0, 0);
        p1 = __builtin_amdgcn_mfma_f32_32x32x16_bf16(b1, qr[d0], p1, 0, 0, 0); }
}
__device__ __forceinline__ void attn_item(Frame& F, int b, int q0, char* lds) {
    const bf16_t* Q = (const bf16_t*)(F.ws + WS_Q); const bf16_t* KV = (const bf16_t*)(F.outb + OUT_KV); const u64* MASK = (const u64*)(F.outb + OUT_MASK);
    bf16_t* OA = (bf16_t*)(F.outb + OUT_OA);
    int tid = F.tid; asm volatile("" : "+v"(tid));
    const int wid = F.wave, lane = tid & 63, r32 = lane & 31, hi = lane >> 5;
    char* V_lds = lds + OFF_V; char* K_lds = lds + OFF_K;
    float* wsl = (float*)(lds + OFF_WS) + wid * 64; float* li_l = wsl; float* al_l = wsl + 32;
    const float* btab = (const float*)(lds + OFF_BT);
    constexpr float C = 0.088388347648318440f * LOG2E;
    float m_reg = -1e30f, l_reg = 0.f; f32x16 o[4] = {}; bf16x8 qr[8];
    const size_t tokq = (size_t)b * SEQ + q0 + r32;
    { const bf16_t* Qw = Q + tokq * 1024 + wid * 128 + hi * 8;
#pragma unroll
      for (int d0 = 0; d0 < 8; ++d0) qr[d0] = *(const bf16x8*)(Qw + d0 * 16); }
    const u64* mq = MASK + tokq * 32;
    const int sr = tid >> 4, sc = (tid & 15) * 8;
    const int vb0 = (int)(uintptr_t)V_lds + v_rd_base(lane);
    const bf16_t* Kb = KV + (size_t)b * SEQ * 128;
    const int NT = (q0 >> 6) + 1;
    const float bfar = btab[wid];
    bf16x8 s0, s1;
#define SLOAD(k0) do { s0 = *(const bf16x8*)(Kb + (size_t)((k0) + sr) * 128 + sc); s1 = *(const bf16x8*)(Kb + (size_t)((k0) + 32 + sr) * 128 + sc); } while (0)
#define SWRITE(bf) do { int srv = sr; asm volatile("" : "+v"(srv)); const int kc = sc * 2; const int v0a = v_st(srv, sc), k0a = KSWZ(srv, kc); \
        *(bf16x8*)(V_lds + (bf) * SHM_V + v0a) = s0; *(bf16x8*)(V_lds + (bf) * SHM_V + v0a + 8192) = s1; \
        *(bf16x8*)(K_lds + (bf) * SHM_K + k0a) = s0; *(bf16x8*)(K_lds + (bf) * SHM_K + k0a + 8192) = s1; } while (0)
    __syncthreads();
    SLOAD(0); VM_WAIT(); SWRITE(0); __syncthreads();
    u64 mw_next = mq[0];
    for (int j = 0; j < NT; ++j) {
        int lanel = lane; asm volatile("" : "+v"(lanel)); const int r32l = lanel & 31, hil = lanel >> 5;
        const int bf = j & 1;
        if (j + 1 < NT) SLOAD((j + 1) * KVBLK);
        const u64 mw = mw_next; if (j + 1 < NT) mw_next = mq[j + 1];
        f32x16 p0, p1;
        qkt(p0, p1, K_lds + bf * SHM_K, qr, r32l, hil);
        const unsigned w0 = (unsigned)(mw >> (4 * hil)), w1 = (unsigned)(mw >> (32 + 4 * hil));
        const int relmax = j * KVBLK + 63 - q0;
        float alpha = 1.f, ps = 0.f;
        if (relmax <= -91) {
            float pmax = p0[0];
#pragma unroll
            for (int r = 1; r < 16; ++r) pmax = fmaxf(pmax, p0[r]);
#pragma unroll
            for (int r = 0; r < 16; ++r) pmax = fmaxf(pmax, p1[r]);
            { auto rr = __builtin_amdgcn_permlane32_swap(__float_as_uint(pmax), __float_as_uint(pmax), false, false); pmax = fmaxf(__uint_as_float(rr[0]), __uint_as_float(rr[1])); }
            pmax = fmaf(pmax, C, bfar);
            if (!__all(pmax - m_reg <= 11.0f)) { const float mn = fmaxf(m_reg, pmax); alpha = __builtin_amdgcn_exp2f(m_reg - mn); m_reg = mn; }
            const float off = bfar - m_reg;
#pragma unroll
            for (int r = 0; r < 16; ++r) { const int cb = (r & 3) + 8 * (r >> 2);
                const float e0 = __builtin_amdgcn_exp2f(fmaf(p0[r], C, off)), e1 = __builtin_amdgcn_exp2f(fmaf(p1[r], C, off));
                p0[r] = __uint_as_float(__float_as_uint(e0) & (unsigned)__builtin_amdgcn_sbfe((int)w0, cb, 1)); p1[r] = __uint_as_float(__float_as_uint(e1) & (unsigned)__builtin_amdgcn_sbfe((int)w1, cb, 1)); ps += p0[r] + p1[r]; }
        } else {
            const float* bp = btab + (j * KVBLK + 4 * hil - (q0 + r32l) + 185) * 8 + wid;
#pragma unroll
            for (int r4 = 0; r4 < 4; ++r4) {
#pragma unroll
                for (int rr = 0; rr < 4; ++rr) { const int r = r4 * 4 + rr; const int cb = (r & 3) + 8 * (r >> 2); p0[r] = fmaf(p0[r], C, bp[cb * 8]); p1[r] = fmaf(p1[r], C, bp[(cb + 32) * 8]); }
                SBAR(); }
            float pmax = p0[0];
#pragma unroll
            for (int r = 1; r < 16; ++r) pmax = fmaxf(pmax, p0[r]);
#pragma unroll
            for (int r = 0; r < 16; ++r) pmax = fmaxf(pmax, p1[r]);
            { auto rr = __builtin_amdgcn_permlane32_swap(__float_as_uint(pmax), __float_as_uint(pmax), false, false); pmax = fmaxf(__uint_as_float(rr[0]), __uint_as_float(rr[1])); }
            if (!__all(pmax - m_reg <= 11.0f)) { const float mn = fmaxf(m_reg, pmax); alpha = __builtin_amdgcn_exp2f(m_reg - mn); m_reg = mn; }
#pragma unroll
            for (int r = 0; r < 16; ++r) { const int cb = (r & 3) + 8 * (r >> 2);
                const float e0 = __builtin_amdgcn_exp2f(p0[r] - m_reg), e1 = __builtin_amdgcn_exp2f(p1[r] - m_reg);
                p0[r] = __uint_as_float(__float_as_uint(e0) & (unsigned)__builtin_amdgcn_sbfe((int)w0, cb, 1)); p1[r] = __uint_as_float(__float_as_uint(e1) & (unsigned)__builtin_amdgcn_sbfe((int)w1, cb, 1)); ps += p0[r] + p1[r]; }
        }
        { auto rr = __builtin_amdgcn_permlane32_swap(__float_as_uint(ps), __float_as_uint(ps), false, false); ps = __uint_as_float(rr[0]) + __uint_as_float(rr[1]); }
        l_reg = l_reg * alpha + ps;
        bf16x8 pa0, pa1, pa2, pa3;
#define PK4(P, BASE, OUT) do { unsigned a0 = cvt_pk_bf16(P[BASE + 0], P[BASE + 1]), a1 = cvt_pk_bf16(P[BASE + 2], P[BASE + 3]);   \
    unsigned b0 = cvt_pk_bf16(P[BASE + 4], P[BASE + 5]), b1 = cvt_pk_bf16(P[BASE + 6], P[BASE + 7]);                              \
    auto r0 = __builtin_amdgcn_permlane32_swap(a0, b0, false, false); auto r1 = __builtin_amdgcn_permlane32_swap(a1, b1, false, false); \
    u32x4 w = {r0[0], r1[0], r0[1], r1[1]}; OUT = *reinterpret_cast<bf16x8*>(&w); } while (0)
        PK4(p0, 0, pa0); PK4(p0, 8, pa1); PK4(p1, 0, pa2); PK4(p1, 8, pa3);
#undef PK4
        if (__any(alpha < 1.f)) { if (hil == 0) al_l[r32l] = alpha; LDS_WAIT();
#pragma unroll
            for (int d = 0; d < 4; ++d)
#pragma unroll
                for (int r = 0; r < 16; ++r) o[d][r] *= al_l[crow(r, hil)]; }
        const int vb = (int)(uintptr_t)V_lds + v_rd_base(lanel) + bf * SHM_V;
        pv_one<0>(o[0], vb, pa0, pa1, pa2, pa3); pv_one<1>(o[1], vb, pa0, pa1, pa2, pa3); pv_one<2>(o[2], vb, pa0, pa1, pa2, pa3); pv_one<3>(o[3], vb, pa0, pa1, pa2, pa3);
        if (j + 1 < NT) { VM_WAIT(); SWRITE(bf ^ 1); }
        __syncthreads();
    }
#undef SLOAD
#undef SWRITE
    if (hi == 0) li_l[r32] = l_reg; LDS_WAIT();
    bf16_t* Ow = OA + ((size_t)b * SEQ + q0 + 4 * hi) * 1024 + wid * 128 + r32;
    const float* lip = li_l + 4 * hi;
    unsigned char* Ow8 = (unsigned char*)OA + ((size_t)b * SEQ + q0 + 4 * hi) * 1024 + wid * 128 + r32;
    asm volatile("" : "+v"(Ow), "+v"(lip), "+v"(Ow8));
#pragma unroll
    for (int r = 0; r < 16; ++r) { const int ro = (r & 3) + 8 * (r >> 2); if ((r & 3) == 0) asm volatile("" : "+v"(Ow), "+v"(Ow8), "+v"(lip)); const float rl = fast_rcp(lip[ro]);
#pragma unroll
        for (int d0 = 0; d0 < 4; ++d0) { float v = o[d0][r] * rl; if ((DBG_ATTN_ZERO == 1 && q0 < 256) || (DBG_ATTN_ZERO == 2 && q0 >= 256)) v = 0.f;
            if (PA_FP8) ((unsigned char*)Ow8)[ro * 1024 + d0 * 32] = (unsigned char)(__builtin_amdgcn_cvt_pk_fp8_f32(v, v, 0, false) & 0xff);
            else Ow[ro * 1024 + d0 * 32] = (bf16_t)(cvt_pk_bf16(v, v) & 0xffffu); }
        if ((r & 3) == 3) SBAR(); }
}
__device__ __forceinline__ void att2_partial(f32x16& p0, f32x16& p1, float& m_reg, float& alpha, unsigned w0, bool far, float bfar, const float* bp) {
    constexpr float C = 0.088388347648318440f * LOG2E;
    float off;
    if (far) {
        float pmax = p0[0];
#pragma unroll
        for (int r = 1; r < 16; ++r) pmax = fmaxf(pmax, p0[r]);
#pragma unroll
        for (int r = 0; r < 16; ++r) pmax = fmaxf(pmax, p1[r]);
        { auto rr = __builtin_amdgcn_permlane32_swap(__float_as_uint(pmax), __float_as_uint(pmax), false, false); pmax = fmaxf(__uint_as_float(rr[0]), __uint_as_float(rr[1])); }
        pmax = fmaf(pmax, C, bfar);
        if (__builtin_expect(__all(pmax - m_reg <= 11.0f), 1)) alpha = 1.f; else { const float mn = fmaxf(m_reg, pmax); alpha = __builtin_amdgcn_exp2f(m_reg - mn); m_reg = mn; }
        off = bfar - m_reg;
#pragma unroll
        for (int r = 0; r < 16; ++r) { p0[r] = fmaf(p0[r], C, off); p1[r] = fmaf(p1[r], C, off); }
    } else {
#pragma unroll
        for (int r4 = 0; r4 < 4; ++r4) {
#pragma unroll
            for (int rr = 0; rr < 4; ++rr) { const int r = r4 * 4 + rr; const int cb = (r & 3) + 8 * (r >> 2); p0[r] = fmaf(p0[r], C, bp[cb * 8]); p1[r] = fmaf(p1[r], C, bp[(cb + 32) * 8]); }
            SBAR(); }
        float pmax = p0[0];
#pragma unroll
        for (int r = 1; r < 16; ++r) pmax = fmaxf(pmax, p0[r]);
#pragma unroll
        for (int r = 0; r < 16; ++r) pmax = fmaxf(pmax, p1[r]);
        { auto rr = __builtin_amdgcn_permlane32_swap(__float_as_uint(pmax), __float_as_uint(pmax), false, false); pmax = fmaxf(__uint_as_float(rr[0]), __uint_as_float(rr[1])); }
        if (__builtin_expect(__all(pmax - m_reg <= 11.0f), 1)) alpha = 1.f; else { const float mn = fmaxf(m_reg, pmax); alpha = __builtin_amdgcn_exp2f(m_reg - mn); m_reg = mn; }
#pragma unroll
        for (int r = 0; r < 16; ++r) { p0[r] -= m_reg; p1[r] -= m_reg; }
    }
#pragma unroll
    for (int r = 0; r < 16; ++r) { const int cb = (r & 3) + 8 * (r >> 2); p0[r] = __uint_as_float(__float_as_uint(__builtin_amdgcn_exp2f(p0[r])) & (unsigned)__builtin_amdgcn_sbfe((int)w0, cb, 1)); }
}
__device__ __forceinline__ void att2_finish(f32x16& p0, f32x16& p1, float alpha, float& l_reg, unsigned w1, bf16x8& pa0, bf16x8& pa1, bf16x8& pa2, bf16x8& pa3) {
#pragma unroll
    for (int r = 0; r < 16; ++r) { const int cb = (r & 3) + 8 * (r >> 2); p1[r] = __uint_as_float(__float_as_uint(__builtin_amdgcn_exp2f(p1[r])) & (unsigned)__builtin_amdgcn_sbfe((int)w1, cb, 1)); }
    float ps = 0.f;
#pragma unroll
    for (int r = 0; r < 16; ++r) ps += p0[r];
#pragma unroll
    for (int r = 0; r < 16; ++r) ps += p1[r];
    { auto rr = __builtin_amdgcn_permlane32_swap(__float_as_uint(ps), __float_as_uint(ps), false, false); ps = __uint_as_float(rr[0]) + __uint_as_float(rr[1]); }
    l_reg = l_reg * alpha + ps;
#define PK4(P, BASE, OUT) do { unsigned a0 = cvt_pk_bf16(P[BASE + 0], P[BASE + 1]), a1 = cvt_pk_bf16(P[BASE + 2], P[BASE + 3]);   \
    unsigned b0 = cvt_pk_bf16(P[BASE + 4], P[BASE + 5]), b1 = cvt_pk_bf16(P[BASE + 6], P[BASE + 7]);                              \
    auto r0 = __builtin_amdgcn_permlane32_swap(a0, b0, false, false); auto r1 = __builtin_amdgcn_permlane32_swap(a1, b1, false, false); \
    u32x4 w = {r0[0], r1[0], r0[1], r1[1]}; OUT = *reinterpret_cast<bf16x8*>(&w); } while (0)
    PK4(p0, 0, pa0); PK4(p0, 8, pa1); PK4(p1, 0, pa2); PK4(p1, 8, pa3);
#undef PK4
}
__device__ __forceinline__ void attn_item2(Frame& F, int b, int q0, char* lds) {
    const bf16_t* Q = (const bf16_t*)(F.ws + WS_Q); const bf16_t* KV = (const bf16_t*)(F.outb + OUT_KV); const u64* MASK = (const u64*)(F.outb + OUT_MASK);
    bf16_t* OA = (bf16_t*)(F.outb + OUT_OA);
    int tid = F.tid; asm volatile("" : "+v"(tid));
    const int wid = F.wave, lane = tid & 63, r32 = lane & 31, hi = lane >> 5;
    char* V_lds = lds + OFF_V; char* K_lds = lds + OFF_K;
    float* wsl = (float*)(lds + OFF_WS) + wid * 64; float* li_l = wsl; float* al_l = wsl + 32;
    const float* btab = (const float*)(lds + OFF_BT);
    float m_reg = -1e30f, l_reg = 0.f; f32x16 o[4] = {}; bf16x8 qr[8];
    const size_t tokq = (size_t)b * SEQ + q0 + r32;
    { const bf16_t* Qw = Q + tokq * 1024 + wid * 128 + hi * 8;
#pragma unroll
      for (int d0 = 0; d0 < 8; ++d0) qr[d0] = *(const bf16x8*)(Qw + d0 * 16); }
    const u64* mq = MASK + tokq * 32;
    const int sr = tid >> 4, sc = (tid & 15) * 8;
    const bf16_t* Kb = KV + (size_t)b * SEQ * 128;
    const int NTr = (q0 >> 6) + 1, NT = (NTr + 1) & ~1;
    const float bfar = btab[wid];
    bf16x8 sA0, sA1, sB0, sB1;
#define SLD(s0_, s1_, k0) do { int srl = sr; asm volatile("" : "+v"(srl)); const bf16_t* kp_ = Kb + (size_t)((k0) + srl) * 128 + sc; s0_ = *(const bf16x8*)kp_; s1_ = *(const bf16x8*)(kp_ + 32 * 128); } while (0)
#define SWR(bf, s0_, s1_) do { int srv = sr; asm volatile("" : "+v"(srv)); const int kc = sc * 2; const int v0a = v_st(srv, sc), k0a = KSWZ(srv, kc); \
        *(bf16x8*)(V_lds + (bf) * SHM_V + v0a) = s0_; *(bf16x8*)(V_lds + (bf) * SHM_V + v0a + 8192) = s1_; \
        *(bf16x8*)(K_lds + (bf) * SHM_K + k0a) = s0_; *(bf16x8*)(K_lds + (bf) * SHM_K + k0a + 8192) = s1_; } while (0)
#define MWORD(j) ((j) < NTr ? mq[j] : 0ull)
#define RESC(a) do { if (__any((a) < 1.f)) { if (hi == 0) al_l[r32] = (a); LDS_WAIT(); \
        _Pragma("unroll") for (int d = 0; d < 4; ++d) _Pragma("unroll") for (int r = 0; r < 16; ++r) o[d][r] *= al_l[crow(r, hi)]; } } while (0)
#define PVALL(bf) do { int ll = lane; asm volatile("" : "+v"(ll)); const int vb = (int)(uintptr_t)V_lds + v_rd_base(ll) + (bf) * SHM_V; \
        pv_one<0>(o[0], vb, pa0, pa1, pa2, pa3); pv_one<1>(o[1], vb, pa0, pa1, pa2, pa3); pv_one<2>(o[2], vb, pa0, pa1, pa2, pa3); pv_one<3>(o[3], vb, pa0, pa1, pa2, pa3); } while (0)
#define ISFAR(jt) ((jt) * KVBLK + 63 - q0 <= -91 || (jt) >= NTr)
#define BPTR(jt) (btab + ((jt) * KVBLK + 4 * hi - (q0 + r32) + 185) * 8 + wid)
    f32x16 pA0, pA1, pB0, pB1; float alA, alB; bf16x8 pa0, pa1, pa2, pa3; u64 mwA, mwB;
    __syncthreads();
    SLD(sA0, sA1, 0); mwA = MWORD(0); VM_WAIT(); SWR(0, sA0, sA1); __syncthreads();
    qkt(pA0, pA1, K_lds, qr, r32, hi);
    att2_partial(pA0, pA1, m_reg, alA, (unsigned)(mwA >> (4 * hi)), ISFAR(0), bfar, BPTR(0));
    SLD(sB0, sB1, KVBLK); mwB = MWORD(1); if (2 < NT) SLD(sA0, sA1, 2 * KVBLK);
    SWR(1, sB0, sB1); __syncthreads();
    for (int j = 1; j + 1 < NT; j += 2) {
        SBAR(); qkt(pB0, pB1, K_lds + SHM_K, qr, r32, hi);
        att2_finish(pA0, pA1, alA, l_reg, (unsigned)(mwA >> (32 + 4 * hi)), pa0, pa1, pa2, pa3); SBAR();
        SLD(sB0, sB1, (j + 2) * KVBLK); mwA = MWORD(j + 1); SBAR();
        PVALL(0);
        att2_partial(pB0, pB1, m_reg, alB, (unsigned)(mwB >> (4 * hi)), ISFAR(j), bfar, BPTR(j));
        __syncthreads(); SWR(0, sA0, sA1);
        RESC(alB); __syncthreads();
        SBAR(); qkt(pA0, pA1, K_lds, qr, r32, hi);
        att2_finish(pB0, pB1, alB, l_reg, (unsigned)(mwB >> (32 + 4 * hi)), pa0, pa1, pa2, pa3); SBAR();
        if (j + 3 < NT) SLD(sA0, sA1, (j + 3) * KVBLK); mwB = MWORD(j + 2); SBAR();
        PVALL(1);
        att2_partial(pA0, pA1, m_reg, alA, (unsigned)(mwA >> (4 * hi)), ISFAR(j + 1), bfar, BPTR(j + 1));
        __syncthreads(); SWR(1, sB0, sB1);
        RESC(alA); __syncthreads();
    }
    SBAR(); qkt(pB0, pB1, K_lds + SHM_K, qr, r32, hi);
    att2_finish(pA0, pA1, alA, l_reg, (unsigned)(mwA >> (32 + 4 * hi)), pa0, pa1, pa2, pa3); SBAR();
    PVALL(0);
    att2_partial(pB0, pB1, m_reg, alB, (unsigned)(mwB >> (4 * hi)), ISFAR(NT - 1), bfar, BPTR(NT - 1));
    __syncthreads(); RESC(alB);
    att2_finish(pB0, pB1, alB, l_reg, (unsigned)(mwB >> (32 + 4 * hi)), pa0, pa1, pa2, pa3); SBAR();
    PVALL(1);
#undef SLD
#undef SWR
#undef MWORD
#undef RESC
#undef PVALL
#undef ISFAR
#undef BPTR
    if (hi == 0) li_l[r32] = l_reg; LDS_WAIT();
    bf16_t* Ow = OA + ((size_t)b * SEQ + q0 + 4 * hi) * 1024 + wid * 128 + r32;
    const float* lip = li_l + 4 * hi;
    unsigned char* Ow8 = (unsigned char*)OA + ((size_t)b * SEQ + q0 + 4 * hi) * 1024 + wid * 128 + r32;
    asm volatile("" : "+v"(Ow), "+v"(lip), "+v"(Ow8));
#pragma unroll
    for (int r = 0; r < 16; ++r) { const int ro = (r & 3) + 8 * (r >> 2); if ((r & 3) == 0) asm volatile("" : "+v"(Ow), "+v"(Ow8), "+v"(lip)); const float rl = fast_rcp(lip[ro]);
#pragma unroll
        for (int d0 = 0; d0 < 4; ++d0) { float v = o[d0][r] * rl;
            if (PA_FP8) ((unsigned char*)Ow8)[ro * 1024 + d0 * 32] = (unsigned char)(__builtin_amdgcn_cvt_pk_fp8_f32(v, v, 0, false) & 0xff);
            else Ow[ro * 1024 + d0 * 32] = (bf16_t)(cvt_pk_bf16(v, v) & 0xffffu); }
        if ((r & 3) == 3) SBAR(); }
}
}
__device__ __forceinline__ void ph_attn(Frame& F) {
    char* lds = (char*)(unsigned char*)F.lds;
    { float* bt = (float*)(lds + att::OFF_BT); const float* BT = (const float*)(F.ws + WS_BIAST); __syncthreads(); for (int i = F.tid; i < 249 * 8; i += NTHR) bt[i] = BT[i]; __syncthreads(); }
    for (int pr = F.bid; pr < NB * 32; pr += F.G) {
        const int b = pr >> 5, qb = pr & 31;
#pragma nounroll
        for (int hh = 0; hh < 2; ++hh) { if (ATT2) att::attn_item2(F, b, (hh ? qb : 63 - qb) * 32, lds); else att::attn_item(F, b, (hh ? qb : 63 - qb) * 32, lds); }
    }
}

namespace ssd {
constexpr int OFF_CS = 0, CS_ST = 272;
constexpr int OFF_BS = OFF_CS + 64 * CS_ST;
constexpr int OFF_BT = OFF_BS + 64 * CS_ST, T_ST = 144;
constexpr int OFF_XT = OFF_BT + 128 * T_ST;
constexpr int OFF_XW = OFF_XT + 64 * T_ST;
constexpr int OFF_XS = OFF_XW + 64 * T_ST;
constexpr int OFF_MT = OFF_XS + 64 * T_ST;
constexpr int OFF_HS = OFF_MT + 64 * T_ST;
constexpr int OFF_END = OFF_HS + 64 * CS_ST;
static_assert(OFF_END + 5 * 320 * 4 <= 131072, "ssd lds");
__device__ __forceinline__ f32x4 mfma16(bf16x8 a, bf16x8 b, f32x4 c) { return __builtin_amdgcn_mfma_f32_16x16x32_bf16(a, b, c, 0, 0, 0); }
__device__ __forceinline__ bf16x8 ldfrag(const char* base, int stride, int row, int k0) { return *(const bf16x8*)(base + row * stride + k0 * 2); }
}
__device__ __forceinline__ void ph_ssd(Frame& F) {
    using namespace ssd;
    char* lds = (char*)(unsigned char*)F.lds;
    const bf16_t* XBC = (const bf16_t*)(F.ws + WS_XBC); const bf16_t* ZS = (const bf16_t*)(F.ws + WS_Z); const float* DT = (const float*)(F.outb + OUT_DT);
    bf16_t* YG = (bf16_t*)(F.ws + WS_Q);
    const float* conv_w = F.a->in[9]; const float* conv_b = F.a->in[10]; const float* a_log = F.a->in[12]; const float* d_skip = F.a->in[13];
    const int tid = F.tid, wid = F.wave, lane = F.lane, fr = lane & 15, fq = lane >> 4;
    const bool stager = tid < 320; const int so = tid % 40, tg = tid / 40;
    for (int item = F.bid; item < NB * 16; item += F.G) {
        const int b = item >> 4, h = item & 15, g = h >> 2;
        const float aneg = -__expf(a_log[h]), dsk = d_skip[h];
        const int ch0 = so < 8 ? h * 64 + so * 8 : (so < 24 ? 1024 + g * 128 + (so - 8) * 8 : 1536 + g * 128 + (so - 24) * 8);
        float* CWL = (float*)(lds + OFF_END);
        __syncthreads();
        if (stager) {
#pragma unroll
            for (int j = 0; j < 4; ++j) { *(f32x4*)(CWL + j * 320 + so * 8) = *(const f32x4*)(conv_w + (size_t)j * 2048 + ch0); *(f32x4*)(CWL + j * 320 + so * 8 + 4) = *(const f32x4*)(conv_w + (size_t)j * 2048 + ch0 + 4); }
            *(f32x4*)(CWL + 4 * 320 + so * 8) = *(const f32x4*)(conv_b + ch0); *(f32x4*)(CWL + 4 * 320 + so * 8 + 4) = *(const f32x4*)(conv_b + ch0 + 4);
        }
        f32x4 hst[4];
#pragma unroll
        for (int t = 0; t < 4; ++t) hst[t] = (f32x4){0.f, 0.f, 0.f, 0.f};
        __syncthreads();
        for (int i = tid; i < 64 * CS_ST / 4; i += NTHR) ((unsigned*)(lds + OFF_HS))[i] = 0u;
        u32x4 raw[11];
        const size_t tokb = (size_t)b * SEQ;
#define SSD_LOAD(c) do { if (stager) { _Pragma("unroll") for (int i = 0; i < 11; ++i) { const int t = (c) * 64 + tg * 8 - 3 + i; \
            raw[i] = (t >= 0) ? *(const u32x4*)(XBC + (tokb + t) * 2048 + ch0) : (u32x4){0u, 0u, 0u, 0u}; } } } while (0)
        SSD_LOAD(0);
        float dtl_next = DT[(tokb + lane) * 16 + h];
        for (int c = 0; c < 32; ++c) {
            const float dtl = dtl_next; if (c + 1 < 32) dtl_next = DT[(tokb + (c + 1) * 64 + lane) * 16 + h];
            u32x2 zpre[2];
#pragma unroll
            for (int t2 = 0; t2 < 2; ++t2) { const int tile = 2 * wid + t2, pb = tile >> 2, lb = tile & 3; zpre[t2] = *(const u32x2*)(ZS + (tokb + c * 64 + lb * 16 + fr) * 1024 + h * 64 + pb * 16 + 4 * fq); }
            float acs = dtl * aneg;
#pragma unroll
            for (int o = 1; o < 64; o <<= 1) { const float t = __shfl_up(acs, o); if (lane >= o) acs += t; }
            const float alast = __shfl(acs, 63);
            if (DBG_SSD_SYNC) __syncthreads();
            float dtv[8], dec[8];
#pragma unroll
            for (int t = 0; t < 8; ++t) { dtv[t] = __shfl(dtl, (tg * 8 + t) & 63); dec[t] = __expf(alast - __shfl(acs, (tg * 8 + t) & 63)); }
            if (stager) {
#pragma unroll
                for (int hq = 0; hq < 2; ++hq) {
                    float xin[11][4];
#pragma unroll
                    for (int i = 0; i < 11; ++i) { const unsigned wa = hq ? raw[i].z : raw[i].x, wb = hq ? raw[i].w : raw[i].y; xin[i][0] = bflo(wa); xin[i][1] = bfhi(wa); xin[i][2] = bflo(wb); xin[i][3] = bfhi(wb); }
                    float outv[8][4];
                    { f32x4 cwv[4]; const f32x4 cbq = *(const f32x4*)(CWL + 4 * 320 + so * 8 + hq * 4);
#pragma unroll
                      for (int j = 0; j < 4; ++j) cwv[j] = *(const f32x4*)(CWL + j * 320 + so * 8 + hq * 4);
#pragma unroll
                      for (int t = 0; t < 8; ++t)
#pragma unroll
                        for (int e = 0; e < 4; ++e) { float sacc = cbq[e];
#pragma unroll
                            for (int j = 0; j < 4; ++j) sacc += cwv[j][e] * xin[t + j][e];
                            outv[t][e] = silu_f(sacc); } }
                    if (so < 8) {
#pragma unroll
                        for (int e = 0; e < 4; ++e) { const int p = so * 8 + hq * 4 + e;
                            f32x4 x0, x1, d0, d1, w0, w1;
#pragma unroll
                            for (int t = 0; t < 4; ++t) { x0[t] = outv[t][e]; x1[t] = outv[4 + t][e]; d0[t] = x0[t] * dtv[t]; d1[t] = x1[t] * dtv[4 + t]; w0[t] = d0[t] * dec[t]; w1[t] = d1[t] * dec[4 + t]; }
                            *(u32x4*)(lds + OFF_XS + p * T_ST + tg * 16) = pack8(x0, x1);
                            *(u32x4*)(lds + OFF_XT + p * T_ST + tg * 16) = pack8(d0, d1);
                            *(u32x4*)(lds + OFF_XW + p * T_ST + tg * 16) = pack8(w0, w1); }
                    } else {
                        const bool isB = so < 24; const int n0 = (isB ? (so - 8) : (so - 24)) * 8 + hq * 4;
                        char* nat = lds + (isB ? OFF_BS : OFF_CS);
#pragma unroll
                        for (int t = 0; t < 8; ++t) { u32x2 w; w.x = cvt_pk_bf16(outv[t][0], outv[t][1]); w.y = cvt_pk_bf16(outv[t][2], outv[t][3]);
                            *(u32x2*)(nat + (tg * 8 + t) * CS_ST + n0 * 2) = w; }
                        if (isB) {
#pragma unroll
                            for (int e = 0; e < 4; ++e) { f32x4 a, bq;
#pragma unroll
                                for (int t = 0; t < 4; ++t) { a[t] = outv[t][e]; bq[t] = outv[4 + t][e]; }
                                *(u32x4*)(lds + OFF_BT + (n0 + e) * T_ST + tg * 16) = pack8(a, bq); }
                        }
                    }
                }
            }
            if (c + 1 < 32) SSD_LOAD(c + 1);
            __syncthreads();
#pragma unroll
            for (int t2 = 0; t2 < 2; ++t2) {
                const int tile = 2 * wid + t2, sb = tile >> 2, lb = tile & 3;
                f32x4 d = (f32x4){0.f, 0.f, 0.f, 0.f};
                if (sb <= lb) {
#pragma unroll
                    for (int ks = 0; ks < 4; ++ks) d = mfma16(ldfrag(lds + OFF_BS, CS_ST, sb * 16 + fr, ks * 32 + fq * 8), ldfrag(lds + OFF_CS, CS_ST, lb * 16 + fr, ks * 32 + fq * 8), d);
                    const int l = lb * 16 + fr; const float al = __shfl(acs, l);
                    f32x4 as;
#pragma unroll
                    for (int r = 0; r < 4; ++r) as[r] = __shfl(acs, sb * 16 + 4 * fq + r);
#pragma unroll
                    for (int r = 0; r < 4; ++r) { const int s = sb * 16 + 4 * fq + r; d[r] = (s <= l) ? d[r] * __expf(al - as[r]) : 0.f; }
                }
                u32x2 w; w.x = cvt_pk_bf16(d[0], d[1]); w.y = cvt_pk_bf16(d[2], d[3]);
                *(u32x2*)(lds + OFF_MT + (lb * 16 + fr) * T_ST + (sb * 16 + 4 * fq) * 2) = w;
            }
            if (DBG_SSD_SYNC) __syncthreads();
            f32x4 yacc[2];
#pragma unroll
            for (int t2 = 0; t2 < 2; ++t2) {
                const int tile = 2 * wid + t2, pb = tile >> 2, lb = tile & 3;
                f32x4 d = (f32x4){0.f, 0.f, 0.f, 0.f};
#pragma unroll
                for (int ks = 0; ks < 4; ++ks) d = mfma16(ldfrag(lds + OFF_HS, CS_ST, pb * 16 + fr, ks * 32 + fq * 8), ldfrag(lds + OFF_CS, CS_ST, lb * 16 + fr, ks * 32 + fq * 8), d);
                const float el = __expf(__shfl(acs, lb * 16 + fr));
                yacc[t2] = d * el;
            }
            __syncthreads();
#pragma unroll
            for (int t2 = 0; t2 < 2; ++t2) {
                const int tile = 2 * wid + t2, pb = tile >> 2, lb = tile & 3;
                f32x4 d = yacc[t2];
#pragma unroll
                for (int ks = 0; ks < 2; ++ks) d = mfma16(ldfrag(lds + OFF_XT, T_ST, pb * 16 + fr, ks * 32 + fq * 8), ldfrag(lds + OFF_MT, T_ST, lb * 16 + fr, ks * 32 + fq * 8), d);
                const int l = lb * 16 + fr, p0 = pb * 16 + 4 * fq; const size_t tok = tokb + c * 64 + l;
                const u32x2 zz = zpre[t2];
                const float z0 = bflo(zz.x), z1 = bfhi(zz.x), z2 = bflo(zz.y), z3 = bfhi(zz.y);
                float xs[4];
#pragma unroll
                for (int r = 0; r < 4; ++r) xs[r] = bflo((unsigned)*(const bf16_t*)(lds + OFF_XS + (p0 + r) * T_ST + l * 2));
                u32x2 w; w.x = cvt_pk_bf16((d[0] + xs[0] * dsk) * z0, (d[1] + xs[1] * dsk) * z1); w.y = cvt_pk_bf16((d[2] + xs[2] * dsk) * z2, (d[3] + xs[3] * dsk) * z3);
                *(u32x2*)(YG + tok * 1024 + h * 64 + p0) = w;
            }
            if (DBG_SSD_SYNC) __syncthreads();
            { const float dc = __expf(alast);
#pragma unroll
              for (int t = 0; t < 4; ++t) { f32x4 d = hst[t] * dc;
#pragma unroll
                  for (int ks = 0; ks < 2; ++ks) d = mfma16(ldfrag(lds + OFF_BT, T_ST, wid * 16 + fr, ks * 32 + fq * 8), ldfrag(lds + OFF_XW, T_ST, t * 16 + fr, ks * 32 + fq * 8), d);
                  hst[t] = d;
                  u32x2 w; w.x = cvt_pk_bf16(d[0], d[1]); w.y = cvt_pk_bf16(d[2], d[3]);
                  *(u32x2*)(lds + OFF_HS + (t * 16 + fr) * CS_ST + (wid * 16 + 4 * fq) * 2) = w; } }
            __syncthreads();
        }
#undef SSD_LOAD
    }
}

namespace ssd2 {
constexpr int CS_ST = 272, T_ST = 144;
constexpr int OFF_CS = 0, OFF_BS = 64 * CS_ST, OFF_BT = 2 * 64 * CS_ST, OFF_H0 = OFF_BT + 128 * T_ST;
constexpr int H_XS = 0, H_XW = 64 * T_ST, H_MT = 2 * 64 * T_ST, H_HS = 3 * 64 * T_ST, H_SZ = H_HS + 64 * CS_ST;
constexpr int OFF_CW = OFF_H0 + 2 * H_SZ;
static_assert(OFF_CW + 5 * 384 * 4 <= LDS_MISC, "ssd2 lds");
}
__device__ __forceinline__ void ph_ssd2(Frame& F) {
    using namespace ssd2; using ssd::mfma16; using ssd::ldfrag;
    char* lds = (char*)(unsigned char*)F.lds;
    const bf16_t* XBC = (const bf16_t*)(F.ws + WS_XBC); const bf16_t* ZS = (const bf16_t*)(F.ws + WS_Z); const float* DT = (const float*)(F.outb + OUT_DT);
    bf16_t* YG = (bf16_t*)(F.ws + WS_Q);
    const float* conv_w = F.a->in[9]; const float* conv_b = F.a->in[10]; const float* a_log = F.a->in[12]; const float* d_skip = F.a->in[13];
    const int tid = F.tid, wid = F.wave, lane = F.lane, fr = lane & 15, fq = lane >> 4;
    const bool stager = tid < 384; const int so = tid % 48, tg = tid / 48, shd = (so >> 3) & 1;
    for (int item = F.bid; item < NB * 8; item += F.G) {
        const int b = item >> 3, g = (item >> 1) & 3, h0 = g * 4 + (item & 1) * 2;
        const float aneg0 = -__expf(a_log[h0]), aneg1 = -__expf(a_log[h0 + 1]), dsk0 = d_skip[h0], dsk1 = d_skip[h0 + 1];
        const int ch0 = so < 16 ? (h0 + shd) * 64 + (so & 7) * 8 : (so < 32 ? 1024 + g * 128 + (so - 16) * 8 : 1536 + g * 128 + (so - 32) * 8);
        float* CWL = (float*)(lds + OFF_CW);
        __syncthreads();
        if (stager) {
#pragma unroll
            for (int j = 0; j < 4; ++j) { *(f32x4*)(CWL + j * 384 + so * 8) = *(const f32x4*)(conv_w + (size_t)j * 2048 + ch0); *(f32x4*)(CWL + j * 384 + so * 8 + 4) = *(const f32x4*)(conv_w + (size_t)j * 2048 + ch0 + 4); }
            *(f32x4*)(CWL + 4 * 384 + so * 8) = *(const f32x4*)(conv_b + ch0); *(f32x4*)(CWL + 4 * 384 + so * 8 + 4) = *(const f32x4*)(conv_b + ch0 + 4);
        }
        f32x4 hst[2][4];
#pragma unroll
        for (int hh = 0; hh < 2; ++hh)
#pragma unroll
            for (int t = 0; t < 4; ++t) hst[hh][t] = (f32x4){0.f, 0.f, 0.f, 0.f};
        for (int i = tid; i < 64 * CS_ST / 4; i += NTHR) { ((unsigned*)(lds + OFF_H0 + H_HS))[i] = 0u; ((unsigned*)(lds + OFF_H0 + H_SZ + H_HS))[i] = 0u; }
        u32x4 raw[11];
        const size_t tokb = (size_t)b * SEQ;
        const bf16_t* xrow = XBC + ((ptrdiff_t)tokb + tg * 8 - 3) * 2048 + ch0;
#define SSD_LOAD(c, xp, tgx) do { if (stager) { _Pragma("unroll") for (int i = 0; i < 11; ++i) { const int t = (c) * 64 + (tgx) * 8 - 3 + i; \
            raw[i] = (t >= 0) ? *(const u32x4*)((xp) + (ptrdiff_t)((c) * 64 + i) * 2048) : (u32x4){0u, 0u, 0u, 0u}; } } } while (0)
        SSD_LOAD(0, xrow, tg);
        f32x2 dtn = *(const f32x2*)(DT + (tokb + lane) * 16 + h0);
        for (int c = 0; c < 32; ++c) {
            int frl = fr, fql = fq, tgl = tg, sol = so; const bf16_t* xrl = xrow; asm volatile("" : "+v"(frl), "+v"(fql), "+v"(tgl), "+v"(sol), "+v"(xrl)); const int shdl = (sol >> 3) & 1;
            const float dtl0 = dtn[0], dtl1 = dtn[1]; if (c + 1 < 32) dtn = *(const f32x2*)(DT + (tokb + (c + 1) * 64 + lane) * 16 + h0);
            u32x2 zpre[2][2];
#pragma unroll
            for (int hh = 0; hh < 2; ++hh)
#pragma unroll
                for (int t2 = 0; t2 < 2; ++t2) { const int tile = 2 * wid + t2, pb = tile >> 2, lb = tile & 3; zpre[hh][t2] = *(const u32x2*)(ZS + (tokb + c * 64 + lb * 16 + frl) * 1024 + (h0 + hh) * 64 + pb * 16 + 4 * fql); }
            float acs0 = dtl0 * aneg0, acs1 = dtl1 * aneg1;
#pragma unroll
            for (int o = 1; o < 64; o <<= 1) { const float t0 = __shfl_up(acs0, o), t1 = __shfl_up(acs1, o); if (lane >= o) { acs0 += t0; acs1 += t1; } }
            const float alast0 = __shfl(acs0, 63), alast1 = __shfl(acs1, 63);
            float wdt[8];
#pragma unroll
            for (int t = 0; t < 8; ++t) { const int sl = (tgl * 8 + t) & 63; const float d0 = __shfl(dtl0, sl), d1 = __shfl(dtl1, sl), a0 = __shfl(acs0, sl), a1 = __shfl(acs1, sl);
                wdt[t] = (shdl ? d1 : d0) * __expf(shdl ? alast1 - a1 : alast0 - a0); }
            if (stager) {
#pragma unroll
                for (int cp = 0; cp < 4; ++cp) {
                    float xin[11][2];
#pragma unroll
                    for (int i = 0; i < 11; ++i) { const unsigned wa = cp == 0 ? raw[i].x : (cp == 1 ? raw[i].y : (cp == 2 ? raw[i].z : raw[i].w)); xin[i][0] = bflo(wa); xin[i][1] = bfhi(wa); }
                    float outv[8][2];
                    { f32x2 cwv[4]; const f32x2 cbq = *(const f32x2*)(CWL + 4 * 384 + sol * 8 + cp * 2);
#pragma unroll
                      for (int j = 0; j < 4; ++j) cwv[j] = *(const f32x2*)(CWL + j * 384 + sol * 8 + cp * 2);
#pragma unroll
                      for (int t = 0; t < 8; ++t)
#pragma unroll
                        for (int e = 0; e < 2; ++e) { float sacc = cbq[e];
#pragma unroll
                            for (int j = 0; j < 4; ++j) sacc += cwv[j][e] * xin[t + j][e];
                            outv[t][e] = silu_f(sacc); } }
                    if (sol < 16) {
                        char* hb = lds + OFF_H0 + shdl * H_SZ;
#pragma unroll
                        for (int e = 0; e < 2; ++e) { const int p = (sol & 7) * 8 + cp * 2 + e;
                            f32x4 x0, x1, w0, w1;
#pragma unroll
                            for (int t = 0; t < 4; ++t) { x0[t] = outv[t][e]; x1[t] = outv[4 + t][e]; w0[t] = x0[t] * wdt[t]; w1[t] = x1[t] * wdt[4 + t]; }
                            *(u32x4*)(hb + H_XS + p * T_ST + tgl * 16) = pack8(x0, x1);
                            *(u32x4*)(hb + H_XW + p * T_ST + tgl * 16) = pack8(w0, w1); }
                    } else {
                        const bool isB = sol < 32; const int n0 = (isB ? (sol - 16) : (sol - 32)) * 8 + cp * 2;
                        char* nat = lds + (isB ? OFF_BS : OFF_CS);
#pragma unroll
                        for (int t = 0; t < 8; ++t) *(unsigned*)(nat + (tgl * 8 + t) * CS_ST + n0 * 2) = cvt_pk_bf16(outv[t][0], outv[t][1]);
                        if (isB) {
#pragma unroll
                            for (int e = 0; e < 2; ++e) { f32x4 a, bq;
#pragma unroll
                                for (int t = 0; t < 4; ++t) { a[t] = outv[t][e]; bq[t] = outv[4 + t][e]; }
                                *(u32x4*)(lds + OFF_BT + (n0 + e) * T_ST + tgl * 16) = pack8(a, bq); }
                        }
                    }
                    SBAR();
                }
            }
            if (c + 1 < 32) SSD_LOAD(c + 1, xrl, tgl);
            __syncthreads();
#pragma unroll
            for (int t2 = 0; t2 < 2; ++t2) {
                const int tile = 2 * wid + t2, sb = tile >> 2, lb = tile & 3;
                f32x4 d = (f32x4){0.f, 0.f, 0.f, 0.f}, m0 = d, m1 = d;
                if (sb <= lb) {
#pragma unroll
                    for (int ks = 0; ks < 4; ++ks) d = mfma16(ldfrag(lds + OFF_BS, CS_ST, sb * 16 + frl, ks * 32 + fql * 8), ldfrag(lds + OFF_CS, CS_ST, lb * 16 + frl, ks * 32 + fql * 8), d);
                    const int l = lb * 16 + frl; const float al0 = __shfl(acs0, l), al1 = __shfl(acs1, l);
#pragma unroll
                    for (int r = 0; r < 4; ++r) { const int sidx = sb * 16 + 4 * fql + r; const float as0 = __shfl(acs0, sidx), as1 = __shfl(acs1, sidx), ds0 = __shfl(dtl0, sidx), ds1 = __shfl(dtl1, sidx);
                        m0[r] = (sidx <= l) ? d[r] * __expf(al0 - as0) * ds0 : 0.f; m1[r] = (sidx <= l) ? d[r] * __expf(al1 - as1) * ds1 : 0.f; }
                }
                u32x2 w; w.x = cvt_pk_bf16(m0[0], m0[1]); w.y = cvt_pk_bf16(m0[2], m0[3]);
                *(u32x2*)(lds + OFF_H0 + H_MT + (lb * 16 + frl) * T_ST + (sb * 16 + 4 * fql) * 2) = w;
                w.x = cvt_pk_bf16(m1[0], m1[1]); w.y = cvt_pk_bf16(m1[2], m1[3]);
                *(u32x2*)(lds + OFF_H0 + H_SZ + H_MT + (lb * 16 + frl) * T_ST + (sb * 16 + 4 * fql) * 2) = w;
            }
            f32x4 yacc[2][2];
#pragma unroll
            for (int hh = 0; hh < 2; ++hh)
#pragma unroll
                for (int t2 = 0; t2 < 2; ++t2) {
                    const int tile = 2 * wid + t2, pb = tile >> 2, lb = tile & 3; const char* hb = lds + OFF_H0 + hh * H_SZ;
                    f32x4 d = (f32x4){0.f, 0.f, 0.f, 0.f};
#pragma unroll
                    for (int ks = 0; ks < 4; ++ks) d = mfma16(ldfrag(hb + H_HS, CS_ST, pb * 16 + frl, ks * 32 + fql * 8), ldfrag(lds + OFF_CS, CS_ST, lb * 16 + frl, ks * 32 + fql * 8), d);
                    const float el = __expf(__shfl(hh ? acs1 : acs0, lb * 16 + frl));
                    yacc[hh][t2] = d * el;
                }
            __syncthreads();
#pragma unroll
            for (int hh = 0; hh < 2; ++hh)
#pragma unroll
                for (int t2 = 0; t2 < 2; ++t2) {
                    const int tile = 2 * wid + t2, pb = tile >> 2, lb = tile & 3; const char* hb = lds + OFF_H0 + hh * H_SZ;
                    f32x4 d = yacc[hh][t2];
#pragma unroll
                    for (int ks = 0; ks < 2; ++ks) d = mfma16(ldfrag(hb + H_XS, T_ST, pb * 16 + frl, ks * 32 + fql * 8), ldfrag(hb + H_MT, T_ST, lb * 16 + frl, ks * 32 + fql * 8), d);
                    const int l = lb * 16 + frl, p0 = pb * 16 + 4 * fql; const size_t tok = tokb + c * 64 + l; const float dsk = hh ? dsk1 : dsk0;
                    const u32x2 zz = zpre[hh][t2];
                    const float z0 = bflo(zz.x), z1 = bfhi(zz.x), z2 = bflo(zz.y), z3 = bfhi(zz.y);
                    float xs[4];
#pragma unroll
                    for (int r = 0; r < 4; ++r) xs[r] = bflo((unsigned)*(const bf16_t*)(hb + H_XS + (p0 + r) * T_ST + l * 2));
                    u32x2 w; w.x = cvt_pk_bf16((d[0] + xs[0] * dsk) * z0, (d[1] + xs[1] * dsk) * z1); w.y = cvt_pk_bf16((d[2] + xs[2] * dsk) * z2, (d[3] + xs[3] * dsk) * z3);
                    *(u32x2*)(YG + tok * 1024 + (h0 + hh) * 64 + p0) = w;
                }
#pragma unroll
            for (int hh = 0; hh < 2; ++hh) { const float dc = __expf(hh ? alast1 : alast0); char* hb = lds + OFF_H0 + hh * H_SZ;
#pragma unroll
                for (int t = 0; t < 4; ++t) { f32x4 d = hst[hh][t] * dc;
#pragma unroll
                    for (int ks = 0; ks < 2; ++ks) d = mfma16(ldfrag(lds + OFF_BT, T_ST, wid * 16 + frl, ks * 32 + fql * 8), ldfrag(hb + H_XW, T_ST, t * 16 + frl, ks * 32 + fql * 8), d);
                    hst[hh][t] = d;
                    u32x2 w; w.x = cvt_pk_bf16(d[0], d[1]); w.y = cvt_pk_bf16(d[2], d[3]);
                    *(u32x2*)(hb + H_HS + (t * 16 + frl) * CS_ST + (wid * 16 + 4 * fql) * 2) = w; } }
            __syncthreads();
        }
#undef SSD_LOAD
    }
}

__device__ __forceinline__ void ph_gnorm(Frame& F) {
    bf16_t* YG = (bf16_t*)(F.ws + WS_Q);
    const int gw = F.bid * NWAVES + F.wave, NGW = F.G * NWAVES;
    for (int m = gw; m < NTOK; m += NGW) {
        u32x2* rp = (u32x2*)(YG + (size_t)m * D) + F.lane;
#pragma unroll
        for (int j = 0; j < 4; ++j) { const u32x2 w = rp[64 * j]; const float a = bflo(w.x), b = bfhi(w.x), c = bflo(w.y), d = bfhi(w.y);
            const float ss = wave_sum(a * a + b * b + c * c + d * d); const float r = 1.f / sqrtf(ss * (1.f / 256.f) + LN_EPS);
            if (PB_FP8) { int pk = 0; pk = __builtin_amdgcn_cvt_pk_fp8_f32(a * r, b * r, pk, false); pk = __builtin_amdgcn_cvt_pk_fp8_f32(c * r, d * r, pk, true); ((unsigned*)(F.outb + OUT_OB8 + (size_t)m * D))[F.lane + 64 * j] = (unsigned)pk; }
            else { u32x2 o; o.x = cvt_pk_bf16(a * r, b * r); o.y = cvt_pk_bf16(c * r, d * r); rp[64 * j] = o; } }
    }
}

template <bool DRY = false> __device__ __forceinline__ void ph_router(Frame& F) {
    float* X1 = (float*)F.outb; bf16_t* U2 = (bf16_t*)(F.ws + WS_U2); const float* MOD = (const float*)(F.ws + WS_MOD);
    const float* ln1g = F.a->in[18]; const float* ln1b = F.a->in[19]; const float* w_router = F.a->in[20]; const float* b_router = F.a->in[21];
    u32x2* REG = (u32x2*)(F.ws + WS_REG); unsigned* CNT = (unsigned*)(F.ws + WS_CTL) + CW_CNT;
    constexpr int TST = 2064;
    LAS unsigned char* THI = F.lds; LAS unsigned char* TLO = F.lds + 16 * TST; LAS float* PART = (LAS float*)(F.lds + 32 * TST);
    LAS unsigned* lcnt = (LAS unsigned*)(F.lds + LDS_AUX); LAS unsigned* lbase = lcnt + 32; LAS unsigned* ent = lcnt + 64;
    const int tid = F.tid, lane = F.lane, wid = F.wave, fr = lane & 15, fq = lane >> 4;
    bf16x8 whi[4][2], wlo[4][2];
#pragma unroll
    for (int ks = 0; ks < 4; ++ks)
#pragma unroll
        for (int ct = 0; ct < 2; ++ct) { float wv[8];
#pragma unroll
            for (int i = 0; i < 8; ++i) wv[i] = w_router[(size_t)(128 * wid + 32 * ks + 8 * fq + i) * 32 + ct * 16 + fr];
            u32x4 h, l2;
#pragma unroll
            for (int i = 0; i < 4; ++i) { const unsigned hp = cvt_pk_bf16(wv[2 * i], wv[2 * i + 1]); const float r0 = wv[2 * i] - bflo(hp), r1 = wv[2 * i + 1] - bfhi(hp); h[i] = hp; l2[i] = cvt_pk_bf16(r0, r1); }
            whi[ks][ct] = __builtin_bit_cast(bf16x8, h); wlo[ks][ct] = __builtin_bit_cast(bf16x8, l2); }
    const float brl = b_router[lane & 31];
    for (int batch = F.bid; batch < NTOK / 256; batch += F.G) {
        const int hf = batch >> 7;
        __syncthreads();
        if (tid < 32) lcnt[tid] = 0u;
        for (int grp = 0; grp < 16; ++grp) {
#pragma unroll
            for (int tt = 0; tt < 2; ++tt) {
                const int tg16 = 2 * wid + tt, m = batch * 256 + grp * 16 + tg16; const float* md = MOD + (size_t)(m >> 11) * 6144;
                f32x4* xr = (f32x4*)(X1 + (size_t)m * D) + lane;
                f32x4 v[4]; float s = 0.f;
#pragma unroll
                for (int j = 0; j < 4; ++j) { v[j] = xr[64 * j]; s += (v[j][0] + v[j][1]) + (v[j][2] + v[j][3]); }
                float mean = wave_sum(s) * (1.f / D), s2 = 0.f;
#pragma unroll
                for (int j = 0; j < 4; ++j) { v[j] = v[j] - mean; s2 += (v[j][0] * v[j][0] + v[j][1] * v[j][1]) + (v[j][2] * v[j][2] + v[j][3] * v[j][3]); }
                float rstd = 1.f / sqrtf(wave_sum(s2) * (1.f / D) + LN_EPS);
                s = 0.f;
#pragma unroll
                for (int j = 0; j < 4; ++j) { const f32x4 g = *((const f32x4*)ln1g + lane + 64 * j), bb = *((const f32x4*)ln1b + lane + 64 * j); v[j] = v[j] * rstd * g + bb; if (!DRY) xr[64 * j] = v[j]; s += (v[j][0] + v[j][1]) + (v[j][2] + v[j][3]); }
                mean = wave_sum(s) * (1.f / D); s2 = 0.f;
#pragma unroll
                for (int j = 0; j < 4; ++j) { v[j] = v[j] - mean; s2 += (v[j][0] * v[j][0] + v[j][1] * v[j][1]) + (v[j][2] * v[j][2] + v[j][3] * v[j][3]); }
                rstd = 1.f / sqrtf(wave_sum(s2) * (1.f / D) + LN_EPS);
                u32x2* o8 = (u32x2*)(U2 + (size_t)m * D) + lane;
#pragma unroll
                for (int j = 0; j < 4; ++j) { const f32x4 sh = *((const f32x4*)(md + 3072) + lane + 64 * j), sc = *((const f32x4*)(md + 4096) + lane + 64 * j);
                    v[j] = v[j] * rstd * (sc + 1.0f) + sh; u32x2 w; w.x = cvt_pk_bf16(v[j][0], v[j][1]); w.y = cvt_pk_bf16(v[j][2], v[j][3]);
                    if (DRY) { if (w.x == 0x12345678u) o8[64 * j] = w; }
                    else if (MOE_FP8) { int pk = 0; pk = __builtin_amdgcn_cvt_pk_fp8_f32(v[j][0], v[j][1], pk, false); pk = __builtin_amdgcn_cvt_pk_fp8_f32(v[j][2], v[j][3], pk, true); ((unsigned*)((unsigned char*)U2 + (size_t)m * D))[lane + 64 * j] = (unsigned)pk; }
                    else o8[64 * j] = w;
                    u32x2 lo; lo.x = cvt_pk_bf16(v[j][0] - bflo(w.x), v[j][1] - bfhi(w.x)); lo.y = cvt_pk_bf16(v[j][2] - bflo(w.y), v[j][3] - bfhi(w.y));
                    *(LAS u32x2*)(THI + tg16 * TST + (4 * lane + 256 * j) * 2) = w; *(LAS u32x2*)(TLO + tg16 * TST + (4 * lane + 256 * j) * 2) = lo; }
            }
            __syncthreads();
            { f32x4 a0 = (f32x4){0.f, 0.f, 0.f, 0.f}, a1 = a0;
#pragma unroll
              for (int ks = 0; ks < 4; ++ks) { const int cb = (128 * wid + 32 * ks + 8 * fq) * 2;
                  const bf16x8 th = *(const LAS bf16x8*)(THI + fr * TST + cb), tl = *(const LAS bf16x8*)(TLO + fr * TST + cb);
                  a0 = __builtin_amdgcn_mfma_f32_16x16x32_bf16(whi[ks][0], th, a0, 0, 0, 0); a1 = __builtin_amdgcn_mfma_f32_16x16x32_bf16(whi[ks][1], th, a1, 0, 0, 0);
                  a0 = __builtin_amdgcn_mfma_f32_16x16x32_bf16(wlo[ks][0], th, a0, 0, 0, 0); a1 = __builtin_amdgcn_mfma_f32_16x16x32_bf16(wlo[ks][1], th, a1, 0, 0, 0);
                  a0 = __builtin_amdgcn_mfma_f32_16x16x32_bf16(whi[ks][0], tl, a0, 0, 0, 0); a1 = __builtin_amdgcn_mfma_f32_16x16x32_bf16(whi[ks][1], tl, a1, 0, 0, 0); }
              *(LAS f32x4*)(PART + (wid * 16 + fr) * 32 + 4 * fq) = a0; *(LAS f32x4*)(PART + (wid * 16 + fr) * 32 + 16 + 4 * fq) = a1; }
            __syncthreads();
            { const int tg16 = 2 * wid + (lane >> 5), tl = grp * 16 + tg16, myexp = lane & 31;
              float logit = brl;
#pragma unroll
              for (int w8 = 0; w8 < 8; ++w8) logit += PART[(w8 * 16 + tg16) * 32 + myexp];
              float tv[4]; int tix[4];
#pragma unroll
              for (int k = 0; k < 4; ++k) { float bv = logit; int bi = myexp;
#pragma unroll
                  for (int o = 1; o < 32; o <<= 1) { const float ov = __shfl_xor(bv, o); const int oi = __shfl_xor(bi, o); if (ov > bv || (ov == bv && oi < bi)) { bv = ov; bi = oi; } }
                  tv[k] = bv; tix[k] = bi; if (myexp == bi) logit = -INFINITY; }
              const float e1 = __expf(tv[1] - tv[0]), e2 = __expf(tv[2] - tv[0]), e3 = __expf(tv[3] - tv[0]); const float inv = 1.f / (1.f + e1 + e2 + e3);
              if (myexp < 4) { const int ee = myexp == 0 ? tix[0] : (myexp == 1 ? tix[1] : (myexp == 2 ? tix[2] : tix[3])); const float gg = (myexp == 0 ? 1.f : (myexp == 1 ? e1 : (myexp == 2 ? e2 : e3))) * inv;
                  const unsigned lp = atomicAdd((unsigned*)&lcnt[ee], 1u);
                  LAS unsigned* en = ent + (tl * 4 + myexp) * 3; en[0] = (unsigned)ee; en[1] = lp; en[2] = __float_as_uint(gg);
                  if (DBG_CHECK == 1) { u32x2 rw; rw.x = (unsigned)ee; rw.y = __float_as_uint(gg); ((u32x2*)(F.ws + WS_DBG))[(size_t)(batch * 256 + tl) * 4 + myexp] = rw; } } }
        }
        __syncthreads();
        if (tid < 32) lbase[tid] = DRY ? 0u : __hip_atomic_fetch_add(CNT + 64 * (hf * 32 + tid), lcnt[tid], __ATOMIC_RELAXED, __HIP_MEMORY_SCOPE_AGENT);
        __syncthreads();
        for (int i = tid; i < 1024; i += NTHR) { const LAS unsigned* en = ent + i * 3; const unsigned ee = en[0], pos = lbase[ee] + en[1];
            const unsigned tokl = (unsigned)(batch * 256 + (i >> 2)) - (unsigned)hf * HALF_TOK;
            u32x2 w; w.x = tokl * 4u + (unsigned)(i & 3); w.y = en[2];
            if (!DRY && pos < (unsigned)REG_CAP) REG[((size_t)hf * 32 + ee) * REG_CAP + pos] = w; }
    }
}

template <bool DRY = false> __device__ __forceinline__ void ph_final(Frame& F, int hf) {
    float* X1 = (float*)F.outb; const bf16_t* YB = (const bf16_t*)(F.ws + WS_YB); const float* MOD = (const float*)(F.ws + WS_MOD);
    const float* g2 = F.a->in[26]; const float* b2 = F.a->in[27];
    const int gw = F.bid * NWAVES + F.wave, NGW = F.G * NWAVES, lane = F.lane;
    constexpr int RB = 2;
    for (int tl0 = gw; tl0 < HALF_TOK; tl0 += NGW * RB) {
        f32x4 xv[RB][4]; u32x2 yw[RB][4][4];
#pragma unroll
        for (int r = 0; r < RB; ++r) { const int tl = tl0 + r * NGW, m = hf * HALF_TOK + tl;
            const f32x4* xr = (const f32x4*)(X1 + (size_t)m * D) + lane; const u32x2* yr = (const u32x2*)(YB + (size_t)tl * 4 * D) + lane;
#pragma unroll
            for (int j = 0; j < 4; ++j) { xv[r][j] = xr[64 * j];
#pragma unroll
                for (int k = 0; k < 4; ++k) yw[r][j][k] = yr[k * 256 + 64 * j]; } }
#pragma unroll
        for (int r = 0; r < RB; ++r) { const int tl = tl0 + r * NGW, m = hf * HALF_TOK + tl; const float* md = MOD + (size_t)(m >> 11) * 6144 + 5120;
            f32x4* xr = (f32x4*)(X1 + (size_t)m * D) + lane;
            f32x4 v[4]; float s = 0.f;
#pragma unroll
            for (int j = 0; j < 4; ++j) { f32x4 y = (f32x4){0.f, 0.f, 0.f, 0.f};
#pragma unroll
                for (int k = 0; k < 4; ++k) { const u32x2 w = yw[r][j][k]; y[0] += bflo(w.x); y[1] += bfhi(w.x); y[2] += bflo(w.y); y[3] += bfhi(w.y); }
                if (DBG_NO_MOE) y = (f32x4){0.f, 0.f, 0.f, 0.f};
                const f32x4 gt = *((const f32x4*)md + lane + 64 * j);
                v[j] = xv[r][j] * DN_ALPHA + gt * y; s += (v[j][0] + v[j][1]) + (v[j][2] + v[j][3]); }
            const float mean = wave_sum(s) * (1.f / D); float s2 = 0.f;
#pragma unroll
            for (int j = 0; j < 4; ++j) { v[j] = v[j] - mean; s2 += (v[j][0] * v[j][0] + v[j][1] * v[j][1]) + (v[j][2] * v[j][2] + v[j][3] * v[j][3]); }
            const float rstd = 1.f / sqrtf(wave_sum(s2) * (1.f / D) + LN_EPS);
#pragma unroll
            for (int j = 0; j < 4; ++j) { const f32x4 g = *((const f32x4*)g2 + lane + 64 * j), bb = *((const f32x4*)b2 + lane + 64 * j); const f32x4 ov = v[j] * rstd * g + bb; if (!DRY || ov[0] == 1.2345e-33f) xr[64 * j] = ov; } }
    }
}

__device__ __forceinline__ float block_sum(Frame& F, float v, LAS float* red) {
    v = wave_sum(v); __syncthreads(); if (F.lane == 0) red[F.wave] = v; __syncthreads();
    float s = 0.f; for (int w = 0; w < NWAVES; ++w) s += red[w]; return s;
}
__device__ __forceinline__ float block_max(Frame& F, float v, LAS float* red) {
#pragma unroll
    for (int o = 1; o < 64; o <<= 1) v = fmaxf(v, __shfl_xor(v, o));
    __syncthreads(); if (F.lane == 0) red[F.wave] = v; __syncthreads();
    float s = 0.f; for (int w = 0; w < NWAVES; ++w) s = fmaxf(s, red[w]); return s;
}
__device__ __forceinline__ void dbg_report(Frame& F, float e) { if (F.tid == 0) atomicMax((unsigned*)(F.ws + WS_CTL) + CW_DBG, __float_as_uint(e)); }
__device__ __forceinline__ void dbg_check_moe(Frame& F) {
    if (F.bid >= 64) return;
    const int tok = HALF_TOK + 509 * F.bid + 3, tokl = tok - HALF_TOK, tid = F.tid;
    LAS float* u2 = (LAS float*)F.lds; LAS float* act = u2 + 1024; LAS float* red = act + 1024; LAS float* lg = red + 16;
    const bf16_t* U2 = (const bf16_t*)(F.ws + WS_U2); const bf16_t* YB = (const bf16_t*)(F.ws + WS_YB); const u32x2* RT = (const u32x2*)(F.ws + WS_DBG);
    const float* w1 = F.a->in[22]; const float* b1 = F.a->in[23]; const float* w2 = F.a->in[24]; const float* b2 = F.a->in[25];
    __syncthreads();
    for (int i = tid; i < 1024; i += NTHR) u2[i] = bflo((unsigned)U2[(size_t)tok * 1024 + i]);
    __syncthreads();
    float y0 = 0.f, y1 = 0.f;
    for (int k = 0; k < 4; ++k) {
        const u32x2 rw = RT[(size_t)tok * 4 + k]; const int e = (int)rw.x; const float g = __uint_as_float(rw.y);
        const float* W1 = w1 + (size_t)e * 1024 * 2048; const float* W2 = w2 + (size_t)e * 1024 * 1024;
        float h0 = b1[e * 2048 + tid], h1 = b1[e * 2048 + tid + 512], h2 = b1[e * 2048 + tid + 1024], h3 = b1[e * 2048 + tid + 1536];
        for (int c = 0; c < 1024; ++c) { const float uu = u2[c]; const float* wr = W1 + (size_t)c * 2048 + tid; h0 += uu * wr[0]; h1 += uu * wr[512]; h2 += uu * wr[1024]; h3 += uu * wr[1536]; }
        __syncthreads();
        { float gg = fminf(h0, 7.f), up = fminf(fmaxf(h2, -7.f), 7.f); act[tid] = (up + 1.f) * gg / (1.f + expf(-1.702f * gg));
          gg = fminf(h1, 7.f); up = fminf(fmaxf(h3, -7.f), 7.f); act[tid + 512] = (up + 1.f) * gg / (1.f + expf(-1.702f * gg)); }
        __syncthreads();
        float a0 = b2[e * 1024 + tid], a1 = b2[e * 1024 + tid + 512];
        for (int j = 0; j < 1024; ++j) { const float aa = act[j]; a0 += aa * W2[(size_t)j * 1024 + tid]; a1 += aa * W2[(size_t)j * 1024 + tid + 512]; }
        y0 += g * a0; y1 += g * a1;
    }
    float f0 = 0.f, f1 = 0.f;
    for (int k = 0; k < 4; ++k) { f0 += bflo((unsigned)YB[((size_t)tokl * 4 + k) * 1024 + tid]); f1 += bflo((unsigned)YB[((size_t)tokl * 4 + k) * 1024 + tid + 512]); }
    const float rms = sqrtf(block_sum(F, y0 * y0 + y1 * y1, red) * (1.f / 1024.f)) + 1e-20f;
    float err = block_max(F, fmaxf(fabsf(y0 - f0), fabsf(y1 - f1)), red) / rms;
    { const float* X1 = (const float*)F.outb + (size_t)tok * 1024; const float* md = (const float*)(F.ws + WS_MOD) + (size_t)(tok >> 11) * 6144;
      const float xa = X1[tid], xb = X1[tid + 512]; const float mean = block_sum(F, xa + xb, red) * (1.f / 1024.f);
      const float da = xa - mean, db = xb - mean; const float var = block_sum(F, da * da + db * db, red) * (1.f / 1024.f); const float rstd = 1.f / sqrtf(var + LN_EPS);
      __syncthreads();
      u2[tid] = da * rstd * (1.f + md[4096 + tid]) + md[3072 + tid]; u2[tid + 512] = db * rstd * (1.f + md[4096 + tid + 512]) + md[3072 + tid + 512];
      __syncthreads();
      if (tid < 32) { float a = F.a->in[21][tid]; for (int c = 0; c < 1024; ++c) a += u2[c] * F.a->in[20][c * 32 + tid]; lg[tid] = a; }
      __syncthreads();
      if (tid == 0) { unsigned want = 0u, got = 0u; float l2[32]; for (int i = 0; i < 32; ++i) l2[i] = lg[i];
          for (int k = 0; k < 4; ++k) { int bi = 0; for (int i = 1; i < 32; ++i) if (l2[i] > l2[bi]) bi = i; want |= 1u << bi; l2[bi] = -INFINITY; got |= 1u << RT[(size_t)tok * 4 + k].x; }
          lg[32] = (want != got) ? 1.f : 0.f; }
      __syncthreads();
      if (lg[32] != 0.f) err = 50.f; }
    dbg_report(F, err);
}
__device__ __forceinline__ void dbg_check_ssd(Frame& F) {
    if (F.bid >= 2) return;
    const int b = F.bid ? 20 : 5, h = F.bid ? 14 : 3, g = h >> 2, tid = F.tid, p = tid >> 3, ng = tid & 7;
    LAS float* red = (LAS float*)F.lds; LAS float* cv = red + 16;
    const bf16_t* XBC = (const bf16_t*)(F.ws + WS_XBC); const bf16_t* ZS = (const bf16_t*)(F.ws + WS_Z); const float* DT = (const float*)(F.outb + OUT_DT); const bf16_t* YG = (const bf16_t*)(F.ws + WS_Q);
    const float* cw = F.a->in[9]; const float* cb = F.a->in[10]; const float aneg = -expf(F.a->in[12][h]), dsk = F.a->in[13][h];
    const int mych = tid < 64 ? h * 64 + tid : (tid < 192 ? 1024 + g * 128 + (tid - 64) : 1536 + g * 128 + (tid - 192));
    float w0 = 0.f, w1 = 0.f, w2 = 0.f, w3 = 0.f, wb = 0.f;
    if (tid < 320) { w0 = cw[0 * 2048 + mych]; w1 = cw[1 * 2048 + mych]; w2 = cw[2 * 2048 + mych]; w3 = cw[3 * 2048 + mych]; wb = cb[mych]; }
    float x0 = 0.f, x1 = 0.f, x2 = 0.f;
    float hs[16];
#pragma unroll
    for (int i = 0; i < 16; ++i) hs[i] = 0.f;
    float emax = 0.f, ssq = 0.f, nbad = 0.f; int tmax = 0;
    for (int t = 0; t < SEQ; ++t) {
        const size_t tok = (size_t)b * SEQ + t;
        __syncthreads();
        if (DBG_HYP == 1 && (t & 63) == 0) { x0 = 0.f; x1 = 0.f; x2 = 0.f; }
        if (tid < 320) { const float x3 = bflo((unsigned)XBC[tok * 2048 + mych]); const float s = wb + w0 * x0 + w1 * x1 + w2 * x2 + w3 * x3; cv[tid] = s / (1.f + expf(-s)); x0 = x1; x1 = x2; x2 = x3; }
        __syncthreads();
        const float xv = cv[p], dt = DT[tok * 16 + h], dec = expf(dt * aneg);
        float yp = 0.f;
#pragma unroll
        for (int i = 0; i < 16; ++i) { const int n = ng * 16 + i; hs[i] = hs[i] * dec + dt * xv * cv[64 + n]; yp += cv[192 + n] * hs[i]; }
        yp += __shfl_xor(yp, 1); yp += __shfl_xor(yp, 2); yp += __shfl_xor(yp, 4);
        const float yv = (yp + xv * dsk) * bflo((unsigned)ZS[tok * 1024 + h * 64 + p]);
        const float yf = bflo((unsigned)YG[tok * 1024 + h * 64 + p]);
        if (ng == 0) { const float er = fabsf(yv - yf); if (er > emax) { emax = er; tmax = t; } ssq += yv * yv; if (er > 0.25f && (DBG_SUB < 5 || (DBG_SUB == 5 && (t & 63) == 0) || (DBG_SUB == 6 && (t & 63) == 1) || (DBG_SUB == 7 && (t & 63) == 32))) nbad += 1.f; }
    }
    const float rms = sqrtf(block_sum(F, ssq, red) / (64.f * SEQ)) + 1e-20f;
    const float M = block_max(F, emax, red);
    if (DBG_SUB == 0) dbg_report(F, M / rms);
    else if (DBG_SUB == 1) dbg_report(F, block_sum(F, nbad, red) / (64.f * SEQ));
    else if (DBG_SUB >= 5) dbg_report(F, block_sum(F, nbad, red) / (64.f * 32.f));
    else { __syncthreads(); if (ng == 0 && emax == M) red[12] = (float)(DBG_SUB == 2 ? ((tmax & 63) >> 1) : (DBG_SUB == 3 ? (tmax >> 6) : (p >> 1))); __syncthreads();
        if (F.bid == 0) dbg_report(F, powf(10.f, 2.f * (0.05f + 0.05f * red[12]) - 4.f)); }
}
__device__ __forceinline__ void dbg_check_attn(Frame& F) {
    if (F.bid >= 32) return;
    const int b = (F.bid * 7 + 3) & 31, pos = 300 + F.bid * 53, nadm = ((pos >> 6) + 1) * 64, tid = F.tid, lane = F.lane, hd = F.wave;
    const size_t tq = (size_t)b * SEQ + pos;
    LAS float* sc = (LAS float*)F.lds; LAS unsigned char* sel = (LAS unsigned char*)(sc + 2048); LAS float* lgt = (LAS float*)(sel + 2048); LAS float* red = lgt + 8 * 2048; LAS float* misc = red + 16;
    const bf16_t* IQ = (const bf16_t*)(F.outb + OUT_IQ); const bf16_t* IK = (const bf16_t*)(F.outb + OUT_IK); const float* IW = (const float*)(F.outb + OUT_IW);
    const bf16_t* Q = (const bf16_t*)(F.ws + WS_Q); const bf16_t* KV = (const bf16_t*)(F.outb + OUT_KV); const bf16_t* OA = (const bf16_t*)(F.outb + OUT_OA); const u64* MASK = (const u64*)(F.outb + OUT_MASK);
    __syncthreads();
    for (int k = tid; k < nadm; k += NTHR) { float s = 0.f;
        for (int hh = 0; hh < 8; ++hh) { float d = 0.f; for (int c = 0; c < 64; ++c) d += bflo((unsigned)IQ[tq * 512 + hh * 64 + c]) * bflo((unsigned)IK[((size_t)b * SEQ + k) * 64 + c]); s += fmaxf(d, 0.f) * IW[tq * 8 + hh]; }
        sc[k] = s + 0.0f; }
    __syncthreads();
    float nbad = 0.f;
    for (int k = tid; k < nadm; k += NTHR) { const float s = sc[k]; int rank = 0; for (int j = 0; j < nadm; ++j) { const float t = sc[j]; rank += (t > s || (t == s && j < k)) ? 1 : 0; }
        const unsigned char se = rank < 256 ? 1 : 0; sel[k] = se; const unsigned mb = (unsigned)((MASK[tq * 32 + (k >> 6)] >> (k & 63)) & 1ull); if (mb != se) nbad += 1.f; }
    __syncthreads();
    const float nbad_t = block_sum(F, nbad, red);
    LAS float* lw = lgt + hd * 2048; float mx = -INFINITY;
    for (int k = lane; k < nadm; k += 64) { float l = -INFINITY;
        if (sel[k]) { float d = 0.f; for (int c = 0; c < 128; ++c) d += bflo((unsigned)Q[tq * 1024 + hd * 128 + c]) * bflo((unsigned)KV[((size_t)b * SEQ + k) * 128 + c]);
            const int rel = k - pos, n = rel < 0 ? -rel : rel; const float nf = (float)(n > 1 ? n : 1); int large = 8 + (int)(logf(nf / 8.0f) / 2.7725887f * 8.0f); if (large > 15) large = 15;
            const int bucket = (rel > 0 ? 16 : 0) + (n < 8 ? n : large);
            l = d * 0.088388347648318440f + F.a->in[8][bucket * 8 + hd]; }
        lw[k] = l; mx = fmaxf(mx, l); }
#pragma unroll
    for (int o = 1; o < 64; o <<= 1) mx = fmaxf(mx, __shfl_xor(mx, o));
    float den = 0.f;
    for (int k = lane; k < nadm; k += 64) { const float pp = expf(lw[k] - mx); lw[k] = pp; den += pp; }
    den = wave_sum(den);
    float emax = 0.f, ssq = 0.f;
    for (int c2 = 0; c2 < 2; ++c2) { const int c = lane + 64 * c2; float o = 0.f; for (int k = 0; k < nadm; ++k) { const float pp = lw[k]; if (pp != 0.f) o += pp * bflo((unsigned)KV[((size_t)b * SEQ + k) * 128 + c]); }
        o /= den; const float of = bflo((unsigned)OA[tq * 1024 + hd * 128 + c]); emax = fmaxf(emax, fabsf(o - of)); ssq += o * o; }
    const float rms = sqrtf(block_sum(F, ssq, red) * (1.f / 1024.f)) + 1e-20f;
    float err = block_max(F, emax, red) / rms;
    (void)misc;
    if (nbad_t > 0.f) err = 10.f + nbad_t;
    dbg_report(F, err);
}
__device__ __forceinline__ void dbg_emit(Frame& F) {
    float* out = (float*)F.outb;
    for (size_t i = (size_t)F.bid * NTHR + F.tid; i < (size_t)NTOK * D / 4; i += (size_t)F.G * NTHR) ((f32x4*)out)[i] = (f32x4){0.f, 0.f, 0.f, 0.f};
    __syncthreads();
    if (F.bid == 0 && F.tid == 0) { const float e = __uint_as_float(__hip_atomic_load((unsigned*)(F.ws + WS_CTL) + CW_DBG, __ATOMIC_RELAXED, __HIP_MEMORY_SCOPE_AGENT));
        float code = (log10f(fmaxf(e, 1e-30f)) + 4.f) * 0.5f; code = fminf(fmaxf(rintf(code * 20.f) * 0.05f, 0.05f), 3.0f);
        out[0] = sqrtf(67108864.f * 1.01f * (powf(10.f, code) - 1.f)); }
}

constexpr int NPHASE = 17;
__global__ void __launch_bounds__(NTHR, 2) fwd(Args args) {
    extern __shared__ __attribute__((aligned(16))) unsigned char lds_raw[];
    Frame F;
    F.lds = (LAS unsigned char*)lds_raw;
    F.tid = threadIdx.x; F.lane = F.tid & 63; F.wave = __builtin_amdgcn_readfirstlane(F.tid >> 6); F.G = gridDim.x; F.bid = blockIdx.x;
    F.a = &args;
    F.ws = args.ws; F.outb = (unsigned char*)args.out;
    volatile LAS unsigned* MISCW = (volatile LAS unsigned*)(F.lds + LDS_MISC);
    if (F.tid < 64) MISCW[F.tid] = 0u;
    __syncthreads();
    XcdBarrier bar; bar.bar = (unsigned*)(F.ws + WS_CTL) + CW_BAR; bar.x = 0; bar.st = nullptr;
#if MK_ONE
    bar = xcd_barrier_post((unsigned*)(F.ws + WS_CTL) + CW_BAR, MISCW + 8);
#define GRID_BAR() xcd_barrier(bar)
#else
#define GRID_BAR() do { } while (0)
#endif
    const int lo = args.ph_lo, hi = args.ph_hi;
#ifndef PHM
#define PHM (0xFFFFFFFFu & ~(DBG_NO_ATTN ? 0x30u : 0u) & ~(DBG_NO_SSD ? 0xC0u : 0u))
#endif
#define IN(k) (((PHM >> (k)) & 1u) && lo <= (k) && (k) < hi)
#define SEAM(k) do { if ((k) + 1 < hi) GRID_BAR(); } while (0)

    if (IN(0)) { ph_prologue(F); if (DBG_TWICE & 1u) { GRID_BAR(); ph_prologue(F); } SEAM(0); }
    if (IN(1)) { ph_ln1(F); if (DBG_TWICE & 2u) { GRID_BAR(); ph_ln1(F); } SEAM(1); }
    if (IN(2)) {
        EpiProj E{(bf16_t*)(F.ws + WS_Q), (bf16_t*)(F.outb + OUT_IQ), (bf16_t*)(F.ws + WS_Z), (bf16_t*)(F.ws + WS_XBC), (bf16_t*)(F.ws + WS_GA), (bf16_t*)(F.ws + WS_GB), (float*)(F.outb + OUT_MISC), 1.0f};
#if PROJ_FP8
        { SchedProj<2> S; S.o.init(NTOK, 12 * 256, F.G, F.bid); S.A = (const char*)(F.ws + WS_U8); S.Bt = (const char*)(F.ws + WS_WIN8);
          EpiProj E8 = E; E8.sc = MOE_INV;
          pg8::gemm_phase<EpiProj, SchedProj<2>, false, 512, true>(F.lds, S, E8);
          if (DBG_TWICE & 32768u) { GRID_BAR(); pg8::gemm_phase<EpiProj, SchedProj<2>, false, 512, true>(F.lds, S, E8); } }
        { SchedProj<1> S; S.o.init(NTOK, 15 * 256, F.G, F.bid); S.A = (const char*)(F.outb + OUT_U); S.Bt = (const char*)(F.ws + WS_WIN);
          pg8::gemm_phase<EpiProj, SchedProj<1>, false>(F.lds, S, E);
          if (DBG_TWICE & 4u) { GRID_BAR(); pg8::gemm_phase<EpiProj, SchedProj<1>, false>(F.lds, S, E); } }
#else
        { SchedProj<0> S; S.o.init(NTOK, NPROJ, F.G, F.bid); S.A = (const char*)(F.outb + OUT_U); S.Bt = (const char*)(F.ws + WS_WIN);
          pg8::gemm_phase<EpiProj, SchedProj<0>, false>(F.lds, S, E);
          if (DBG_TWICE & 4u) { GRID_BAR(); pg8::gemm_phase<EpiProj, SchedProj<0>, false>(F.lds, S, E); } }
#endif
        SEAM(2);
    }
    if (IN(3)) { ph_misc(F); if (DBG_TWICE & 8u) { GRID_BAR(); ph_misc(F); } SEAM(3); }
    if (IN(4)) { ph_index(F); if (DBG_TWICE & 16u) { GRID_BAR(); ph_index(F); } SEAM(4); }
    if (IN(5)) { ph_attn(F); if (DBG_TWICE & 32u) { GRID_BAR(); ph_attn(F); } SEAM(5); if (DBG_CHECK == 3) { dbg_check_attn(F); GRID_BAR(); } }
    if (IN(6)) { ph_ssd2(F); if (DBG_TWICE & 64u) { GRID_BAR(); ph_ssd2(F); } SEAM(6); if (DBG_CHECK == 2) { dbg_check_ssd(F); GRID_BAR(); } }
    if (IN(7)) { ph_gnorm(F); if (DBG_TWICE & 128u) { GRID_BAR(); ph_gnorm(F); } SEAM(7); }
    if (IN(8)) {
#if PA_FP8
        SchedPlainT<1024> S; S.o.init(NTOK, 1024, F.G, F.bid); S.A = (const char*)(F.outb + OUT_OA); S.Bt = (const char*)(F.ws + WS_WPA8);
        EpiGate<0> E{(const bf16_t*)(F.ws + WS_GA), nullptr, (bf16_t*)(F.ws + WS_Z), MOE_INV};
        pg8::gemm_phase<EpiGate<0>, SchedPlainT<1024>, false, 512, true>(F.lds, S, E);
#else
        SchedPlain S; S.o.init(NTOK, 1024, F.G, F.bid); S.A = (const char*)(F.outb + OUT_OA); S.Bt = (const char*)(F.ws + WS_WPA);
        EpiGate<0> E{(const bf16_t*)(F.ws + WS_GA), nullptr, (bf16_t*)(F.ws + WS_Z), 1.0f};
        pg8::gemm_phase<EpiGate<0>, SchedPlain, false>(F.lds, S, E);
#endif
    }
    if (IN(9)) {
#if PB_FP8
        SchedPlainT<1024> S; S.o.init(NTOK, 1024, F.G, F.bid); S.A = (const char*)(F.outb + OUT_OB8); S.Bt = (const char*)(F.ws + WS_WPB8);
        EpiGate<1> E{(const bf16_t*)(F.ws + WS_GB), (const bf16_t*)(F.ws + WS_Z), (bf16_t*)(F.ws + WS_XBC), MOE_INV};
        pg8::gemm_phase<EpiGate<1>, SchedPlainT<1024>, false, 512, true>(F.lds, S, E);
#else
        SchedPlain S; S.o.init(NTOK, 1024, F.G, F.bid); S.A = (const char*)(F.ws + WS_Q); S.Bt = (const char*)(F.ws + WS_WPB);
        EpiGate<1> E{(const bf16_t*)(F.ws + WS_GB), (const bf16_t*)(F.ws + WS_Z), (bf16_t*)(F.ws + WS_XBC), 1.0f};
        pg8::gemm_phase<EpiGate<1>, SchedPlain, false>(F.lds, S, E);
#endif
        SEAM(9);
    }
    if (IN(10)) {
        SchedPlain S; S.o.init(NTOK, 1024, F.G, F.bid); S.A = (const char*)(F.ws + WS_XBC); S.Bt = (const char*)(F.ws + WS_WOUT);
        EpiOut E{F.a->in[0], (const float*)(F.ws + WS_MOD), (float*)F.outb};
        pg8::gemm_phase<EpiOut, SchedPlain, false>(F.lds, S, E);
        if (DBG_TWICE & 1024u) { GRID_BAR(); pg8::gemm_phase<EpiOut, SchedPlain, false>(F.lds, S, E); }
        SEAM(10);
    }
    if (IN(11)) { if (DBG_TWICE & 2048u) { ph_router<true>(F); GRID_BAR(); } ph_router<false>(F); SEAM(11); }
#pragma unroll
    for (int hf = 0; hf < 2; ++hf) {
        const int p0 = 12 + hf * 2;
        if (IN(p0)) {
            if (hf == 1) ph_final<false>(F, 0);
            MoeTab T = moe_tables(F, hf);
            SchedMoe<8, true> S{T, F.G, F.bid, hf, (const char*)(F.ws + WS_U2), (const char*)(F.ws + WS_W1), (const u32x2*)(F.ws + WS_REG)};
            EpiMoe1 E{F.a->in[23], (bf16_t*)(F.ws + WS_ACT), 0};
            pg8::gemm_phase<EpiMoe1, SchedMoe<8, true>, true, MOE_RB / 2, MOE_FP8 != 0>(F.lds, S, E);
            if ((DBG_TWICE & 4096u) && hf == 0) { GRID_BAR(); pg8::gemm_phase<EpiMoe1, SchedMoe<8, true>, true, MOE_RB / 2, MOE_FP8 != 0>(F.lds, S, E); }
            if ((DBG_TWICE & 16384u) && hf == 0) { GRID_BAR(); EpiMoe1 Ed = E; Ed.dry = 1; pg8::gemm_phase<EpiMoe1, SchedMoe<8, true>, true, MOE_RB / 2, MOE_FP8 != 0>(F.lds, S, Ed); }
            SEAM(p0);
        }
        if (IN(p0 + 1)) {
            MoeTab T = moe_tables(F, hf);
            SchedMoe<4, false> S{T, F.G, F.bid, hf, (const char*)(F.ws + WS_ACT), (const char*)(F.ws + WS_W2), (const u32x2*)(F.ws + WS_REG)};
            EpiMoe2 E{F.a->in[25], (bf16_t*)(F.ws + WS_YB), (const u32x2*)(F.ws + WS_REG), T, hf, 0};
            if ((DBG_TWICE & 262144u) && hf == 0) { EpiMoe2 Ed = E; Ed.dry = DBG_DRYMODE; pg8::gemm_phase<EpiMoe2, SchedMoe<4, false>, false, MOE_RB / 2, MOE_FP8 != 0>(F.lds, S, Ed); GRID_BAR(); }
            pg8::gemm_phase<EpiMoe2, SchedMoe<4, false>, false, MOE_RB / 2, MOE_FP8 != 0>(F.lds, S, E);
            if ((DBG_TWICE & 8192u) && hf == 0) { GRID_BAR(); pg8::gemm_phase<EpiMoe2, SchedMoe<4, false>, false, MOE_RB / 2, MOE_FP8 != 0>(F.lds, S, E); }
            if ((DBG_TWICE & 131072u) && hf == 0) { GRID_BAR(); EpiMoe2 Ed = E; Ed.dry = 1; pg8::gemm_phase<EpiMoe2, SchedMoe<4, false>, false, MOE_RB / 2, MOE_FP8 != 0>(F.lds, S, Ed); }
            SEAM(p0 + 1);
            if (DBG_CHECK == 1 && hf == 1) { dbg_check_moe(F); GRID_BAR(); }
        }
    }
    if (IN(16)) { if (DBG_TWICE & 65536u) { ph_final<true>(F, 1); GRID_BAR(); } ph_final(F, 1); }
    if (DBG_CHECK) { GRID_BAR(); dbg_emit(F); }
#undef IN
#undef SEAM
}

extern "C" void kernel_launch(void* const* d_in, const int* in_sizes, int n_in, void* d_out, int out_size, void* d_ws, size_t ws_size, hipStream_t stream) {
    static int grid = 0;
    if (grid == 0) {
        if (n_in != 28 || in_sizes[0] != NTOK * D || out_size != NTOK * D || ws_size < WS_END) { fprintf(stderr, "kernel_launch: shape mismatch (n_in %d, in0 %d, out %d, ws %zu)\n", n_in, n_in > 0 ? in_sizes[0] : -1, out_size, ws_size); grid = -1; return; }
        int dev = 0, cus = 0, per_cu = 0;
        if (hipGetDevice(&dev) != hipSuccess || hipDeviceGetAttribute(&cus, hipDeviceAttributeMultiprocessorCount, dev) != hipSuccess) { grid = -1; return; }
        if (hipFuncSetAttribute((const void*)fwd, hipFuncAttributeMaxDynamicSharedMemorySize, LDS_BYTES) != hipSuccess) { fprintf(stderr, "kernel_launch: hipFuncSetAttribute failed\n"); grid = -1; return; }
        if (hipOccupancyMaxActiveBlocksPerMultiprocessor(&per_cu, (const void*)fwd, NTHR, LDS_BYTES) != hipSuccess || per_cu < 1) fprintf(stderr, "kernel_launch: occupancy query reports %d\n", per_cu);
        (void)hipGetLastError();
        grid = cus;
    }
    if (grid < 0) return;
    if (hipMemsetAsync((char*)d_ws + WS_CTL, 0, CTL_ZERO_BYTES, stream) != hipSuccess) { fprintf(stderr, "kernel_launch: memset failed\n"); return; }
    Args a{};
    for (int i = 0; i < 28; ++i) a.in[i] = (const float*)d_in[i];
    a.out = (float*)d_out; a.ws = (unsigned char*)d_ws;
    const int nph = NPHASE < MK_PH_HI ? NPHASE : MK_PH_HI;
#if MK_ONE
    a.ph_lo = 0; a.ph_hi = nph;
    hipLaunchKernelGGL(fwd, dim3(grid), dim3(NTHR), LDS_BYTES, stream, a);
#else
    for (int p = 0; p < nph; ++p) { a.ph_lo = p; a.ph_hi = p + 1; hipLaunchKernelGGL(fwd, dim3(grid), dim3(NTHR), LDS_BYTES, stream, a); }
#endif
    const hipError_t le = hipPeekAtLastError();
    if (le != hipSuccess) fprintf(stderr, "kernel_launch: launch failed: %s\n", hipGetErrorName(le));
}
```

```cpp
#include <hip/hip_runtime.h>
#include <cstdio>
#include <cstdint>

#ifndef MK_ONE
#define MK_ONE 1
#endif
#ifndef DBG_NO_ATTN
#define DBG_NO_ATTN 0
#endif
#ifndef DBG_ATTN_ZERO
#define DBG_ATTN_ZERO 0
#endif
#ifndef DBG_IQ_TRUNC
#define DBG_IQ_TRUNC 0
#endif
#ifndef DBG_ROUTER_BF16
#define DBG_ROUTER_BF16 0
#endif
#ifndef DBG_CHECK
#define DBG_CHECK 0
#endif
#ifndef DBG_SKIP_BODY
#define DBG_SKIP_BODY 0
#endif
#ifndef DBG_SUB
#define DBG_SUB 0
#endif
#ifndef DBG_SSD_SYNC
#define DBG_SSD_SYNC 0
#endif
#ifndef DBG_HYP
#define DBG_HYP 0
#endif
#ifndef DBG_TWICE
#define DBG_DRYPROJ 0
#define DBG_WALL 0
#define DBG_KCLK 0
#ifndef DBG_CLOCK
#define DBG_CLOCK 0
#endif
#define DBG_TWICE 0u
#endif
#ifndef DBG_DRYMODE
#define DBG_DRYMODE 2
#endif
#ifndef DBG_NO_SSD
#define DBG_NO_SSD 0
#endif
#ifndef DBG_NO_MOE
#define DBG_NO_MOE 0
#endif
#ifndef MOE_FP8
#define MOE_FP8 1
#endif
#ifndef PROJ_FP8
#define PROJ_FP8 1
#endif
#ifndef PA_FP8
#define PA_FP8 1
#endif
#ifndef PB_FP8
#define PB_FP8 0
#endif
#ifndef ATT2
#define ATT2 1
#endif
#ifndef MK_PH_HI
#define MK_PH_HI 99
#endif

#define LAS __attribute__((address_space(3)))
#define GAS __attribute__((address_space(1)))
typedef unsigned short bf16_t;
typedef short bf16x8 __attribute__((ext_vector_type(8)));
typedef short s16x4 __attribute__((ext_vector_type(4)));
typedef float f32x2 __attribute__((ext_vector_type(2)));
typedef float f32x4 __attribute__((ext_vector_type(4)));
typedef float f32x16 __attribute__((ext_vector_type(16)));
typedef unsigned u32x2 __attribute__((ext_vector_type(2)));
typedef unsigned u32x4 __attribute__((ext_vector_type(4)));
typedef unsigned long long u64;

constexpr int NB = 32, SEQ = 2048, D = 1024, NTOK = NB * SEQ;
constexpr int NWAVES = 8, NTHR = 512;
constexpr int NPROJ = 6912;
constexpr int NEXP = 32, HALF_TOK = NTOK / 2, REG_CAP = HALF_TOK;
constexpr int ACT_ROWS = HALF_TOK * 4 + NEXP * 256;
constexpr float LN_EPS = 1e-5f;
constexpr float DN_ALPHA = 1.189207115002721f;
constexpr float LOG2E = 1.4426950408889634f;

constexpr size_t MiB = 1u << 20;
constexpr size_t WS_CTL = 0, CTL_ZERO_BYTES = 1 * MiB;
constexpr size_t WS_MOD = 1 * MiB;
constexpr size_t WS_BIAST = 1 * MiB + 800 * 1024;
constexpr size_t WS_WIN = 2 * MiB;
constexpr size_t WS_WPA = 16 * MiB, WS_WPB = 18 * MiB, WS_WOUT = 20 * MiB;
constexpr size_t WS_W1 = 24 * MiB;
constexpr size_t WS_U8 = 88 * MiB;
constexpr size_t WS_W2 = 152 * MiB;
constexpr size_t WS_WIN8 = 184 * MiB;
constexpr size_t WS_WPA8 = 192 * MiB;
constexpr size_t WS_WPB8 = 194 * MiB;
constexpr size_t OUT_OB8 = 192 * MiB;
constexpr size_t WS_Q = 216 * MiB;
constexpr size_t WS_Z = 344 * MiB;
constexpr size_t WS_XBC = 472 * MiB;
constexpr size_t WS_GA = 728 * MiB, WS_GB = 856 * MiB;
constexpr size_t WS_U2 = 216 * MiB;
constexpr size_t WS_REG = 344 * MiB;
constexpr size_t WS_ACT = 360 * MiB;
constexpr size_t WS_YB = 632 * MiB;
constexpr size_t WS_END = 889 * MiB;
constexpr size_t WS_DBG = 889 * MiB;
constexpr size_t OUT_U = 0, OUT_MISC = 128 * MiB, OUT_IQ = 192 * MiB;
constexpr size_t OUT_KV = 0, OUT_IK = 16 * MiB, OUT_IW = 24 * MiB, OUT_DT = 26 * MiB, OUT_MASK = 32 * MiB, OUT_OA = 64 * MiB;
constexpr int CW_BAR = 4096, CW_CNT = 16384, CW_WQ = 22528, CW_DBG = 24576;

constexpr int LDS_BYTES = 160 * 1024;
constexpr int LDS_AUX = 131072;
constexpr int LDS_MISC = LDS_BYTES - 256;

#define LDS_WAIT() asm volatile("s_waitcnt lgkmcnt(0)" ::: "memory")
#define VM_WAIT() asm volatile("s_waitcnt vmcnt(0)" ::: "memory")
#define SBAR() __builtin_amdgcn_sched_barrier(0)
typedef __bf16 bf16x2_t __attribute__((ext_vector_type(2)));
__device__ __forceinline__ unsigned cvt_pk_bf16(float lo, float hi) { f32x2 f = {lo, hi}; bf16x2_t v = __builtin_convertvector(f, bf16x2_t); return __builtin_bit_cast(unsigned, v); }
__device__ __forceinline__ float bflo(unsigned w) { return __uint_as_float(w << 16); }
__device__ __forceinline__ float bfhi(unsigned w) { return __uint_as_float(w & 0xffff0000u); }
__device__ __forceinline__ u32x4 pack8(f32x4 a, f32x4 b) { u32x4 w; w.x = cvt_pk_bf16(a[0], a[1]); w.y = cvt_pk_bf16(a[2], a[3]); w.z = cvt_pk_bf16(b[0], b[1]); w.w = cvt_pk_bf16(b[2], b[3]); return w; }
constexpr int MOE_RB = MOE_FP8 ? 1024 : 2048;
constexpr float MOE_WSC = MOE_FP8 ? 64.0f : 1.0f, MOE_INV = 1.0f / MOE_WSC;
__device__ __forceinline__ u32x2 pack8_fp8(f32x4 a, f32x4 b) { int lo = 0, hi = 0;
    lo = __builtin_amdgcn_cvt_pk_fp8_f32(a[0], a[1], lo, false); lo = __builtin_amdgcn_cvt_pk_fp8_f32(a[2], a[3], lo, true);
    hi = __builtin_amdgcn_cvt_pk_fp8_f32(b[0], b[1], hi, false); hi = __builtin_amdgcn_cvt_pk_fp8_f32(b[2], b[3], hi, true);
    u32x2 r; r.x = (unsigned)lo; r.y = (unsigned)hi; return r; }
__device__ __forceinline__ void unpack8(u32x4 w, f32x4& a, f32x4& b) { a[0] = bflo(w.x); a[1] = bfhi(w.x); a[2] = bflo(w.y); a[3] = bfhi(w.y); b[0] = bflo(w.z); b[1] = bfhi(w.z); b[2] = bflo(w.w); b[3] = bfhi(w.w); }
__device__ __forceinline__ float wave_sum(float v) {
#pragma unroll
    for (int o = 1; o < 64; o <<= 1) v += __shfl_xor(v, o);
    return v;
}
__device__ __forceinline__ float fast_rcp(float x) { return __builtin_amdgcn_rcpf(x); }
__device__ __forceinline__ float sigmoid_f(float x) { return fast_rcp(1.0f + __expf(-x)); }
__device__ __forceinline__ float silu_f(float x) { return x * sigmoid_f(x); }

#define XB_TMO      128
#define XB_XCNT(j)  (256  + 64 * (j))
#define XB_XSUB(j)  (1280 + 64 * (j))
#define XB_XGEN(j)  (2304 + 64 * (j))
#define XB_TOP      3328
#define XB_TOPGEN   3392
#define XCD_BAR_WORDS 3456
#define XB_SPIN_CAP (1u << 18)
__device__ __forceinline__ unsigned xb_ld(unsigned* p)              { return __hip_atomic_load(p, __ATOMIC_RELAXED, __HIP_MEMORY_SCOPE_AGENT); }
__device__ __forceinline__ unsigned xb_add(unsigned* p, unsigned v) { return __hip_atomic_fetch_add(p, v, __ATOMIC_RELAXED, __HIP_MEMORY_SCOPE_AGENT); }
__device__ __forceinline__ unsigned xb_xcc_id() { return (unsigned)__builtin_amdgcn_s_getreg((3 << 11) | 20) & 0xFu; }
#define XB_SPIN(cond, bar) do { unsigned _sp = 0; while (cond) { __builtin_amdgcn_s_sleep(1); \
    if ((++_sp & 255u) == 0u) { if (xb_ld(&(bar)[XB_TMO])) break; if (_sp > XB_SPIN_CAP) { atomicAdd(&(bar)[XB_TMO], 1u); break; } } } } while (0)
struct XcdBarrier { unsigned* bar; unsigned x; volatile LAS unsigned* st; };
__device__ __forceinline__ XcdBarrier xcd_barrier_post(unsigned* bar, volatile LAS unsigned* st) {
    XcdBarrier b; b.bar = bar; b.x = xb_xcc_id(); b.st = st;
    if (threadIdx.x == 0) (void)xb_add(&bar[XB_XCNT(b.x)], 1u);
    return b;
}
__device__ __forceinline__ void xcd_barrier_complete(unsigned* bar, unsigned x, unsigned& nloc, unsigned& nx) {
    const unsigned G = gridDim.x * gridDim.y * gridDim.z;
    unsigned sum, cnt, mine, sp = 0u;
    for (;;) {
        sum = 0u; cnt = 0u;
#pragma nounroll
        for (unsigned j = 0; j < 16; ++j) { const unsigned c = xb_ld(&bar[XB_XCNT(j)]); sum += c; cnt += (c > 0u) ? 1u : 0u; }
        if (sum == G) break;
        __builtin_amdgcn_s_sleep(1);
        if ((++sp & 255u) == 0u) { if (xb_ld(&bar[XB_TMO])) break; if (sp > XB_SPIN_CAP) { atomicAdd(&bar[XB_TMO], 1u); break; } }
    }
    mine = xb_ld(&bar[XB_XCNT(x)]);
    nloc = mine > 0u ? mine : 1u; nx = cnt > 0u ? cnt : 1u;
}
__device__ __forceinline__ void xcd_barrier(const XcdBarrier& b) {
    asm volatile("s_waitcnt vmcnt(0)" ::: "memory");
    __syncthreads();
    if (threadIdx.x == 0) {
        unsigned* bar = b.bar;
        __builtin_amdgcn_s_waitcnt(0);
        unsigned nloc = b.st[0], nx = b.st[1];
        if (nloc == 0u) { xcd_barrier_complete(bar, b.x, nloc, nx); b.st[0] = nloc; b.st[1] = nx; }
        const unsigned old = xb_add(&bar[XB_XSUB(b.x)], 1u);
        const unsigned gen = old / nloc;
        if (old + 1u == (gen + 1u) * nloc) {
            __builtin_amdgcn_fence(__ATOMIC_RELEASE, "agent");
            asm volatile("s_waitcnt vmcnt(0)" ::: "memory");
            const unsigned og = xb_add(&bar[XB_TOP], 1u);
            const unsigned tg = og / nx;
            if (og + 1u == (tg + 1u) * nx) xb_add(&bar[XB_TOPGEN], 1u);
            else XB_SPIN(xb_ld(&bar[XB_TOPGEN]) == tg, bar);
            __builtin_amdgcn_fence(__ATOMIC_ACQUIRE, "agent");
            xb_add(&bar[XB_XGEN(b.x)], 1u);
            asm volatile("s_waitcnt vmcnt(0)" ::: "memory");
        } else {
            XB_SPIN(xb_ld(&bar[XB_XGEN(b.x)]) == gen, bar);
            __builtin_amdgcn_fence(__ATOMIC_ACQUIRE, "agent");
            asm volatile("s_waitcnt vmcnt(0)" ::: "memory");
        }
    }
    __syncthreads();
}

namespace pg8 {
constexpr int BM = 256, BK = 64, HALF = 128, HTB = HALF * BK * 2, STAGE_BYTES = 8 * HTB, NXCD = 8, WGM = 8, KD = 1024;
__host__ __device__ __forceinline__ int lds_byte(int r, int c) { const int st = (r >> 4) * 2 + (c >> 5), rr = r & 15, cc = c & 31, ob = rr * 64 + cc * 2; return st * 1024 + (ob ^ (((ob >> 9) & 1) << 5)); }
__host__ __device__ __forceinline__ void stage_rc(int b, int& R, int& C) { const int st = b / 1024, sb = b % 1024, swz = sb ^ (((sb >> 9) & 1) << 5); R = (st >> 1) * 16 + swz / 64; C = (st & 1) * 32 + (swz % 64) / 2; }
__host__ __device__ __forceinline__ int perm32(int rho) { const int n = rho >> 4, i = rho & 15; return 8 * (i >> 2) + 4 * n + (i & 3); }
struct Unit { int pm, pn, ex; };
struct StaticOrder {
    int nM, nN, nwg, G, c;
    __device__ void init(int M, int N, int G_, int c_) { nM = M / BM; nN = N / BM; nwg = nM * nN; G = G_; c = c_; }
    __device__ bool next(int i, Unit& u) const {
        const long L = (long)i * G + c; if (L >= nwg) return false;
        int wgid = (int)L; { const int q = nwg / NXCD, r = nwg % NXCD, xcd = wgid % NXCD, off = wgid / NXCD; wgid = (xcd < r ? xcd * (q + 1) : r * (q + 1) + (xcd - r) * q) + off; }
        const int nig = WGM * nN, gid = wgid / nig, fm = gid * WGM, gsz = (nM - fm) < WGM ? (nM - fm) : WGM;
        u.pm = fm + ((wgid % nig) % gsz); u.pn = (wgid % nig) / gsz; u.ex = 0; return true;
    }
};
typedef int i32x8 __attribute__((ext_vector_type(8)));
typedef int i32x4v __attribute__((ext_vector_type(4)));
template <class T> __device__ __forceinline__ auto dbgw_of(const T& s, int) -> decltype(s.dbgw) { return s.dbgw; }
template <class T> __device__ __forceinline__ unsigned* dbgw_of(const T&, long) { return nullptr; }
template <class Epi, class Sched, bool GATHER, int KE = 1024, bool FP8 = false>
__device__ __forceinline__ void gemm_phase(LAS unsigned char* lds, const Sched& S, const Epi& E) {
    int tid = threadIdx.x; asm volatile("" : "+v"(tid));
    const int wid = __builtin_amdgcn_readfirstlane(tid >> 6), lane = tid & 63, wr = wid >> 2, wc = wid & 3, fr = lane & 15, fq = lane >> 4;
    constexpr int K = KE, nt = K / BK;
    unsigned voffA[2], voffB[2]; int Rr[2], Cc[2];
#pragma unroll
    for (int i = 0; i < 2; ++i) { int R, C; stage_rc(tid * 16 + i * 8192, R, C); const int Rb = Epi::PERM ? ((R & ~31) + perm32(R & 31)) : R;
        voffA[i] = (unsigned)(R * K + C) * 2u; voffB[i] = (unsigned)(Rb * K + C) * 2u; Rr[i] = R; Cc[i] = C; }
    constexpr size_t kstep = (size_t)(BK * 2);
    constexpr size_t hstep = (size_t)HALF * K * 2;
    const unsigned ldsw = (unsigned)wid * 1024u;
    const int aoff = lds_byte(wr * 64 + fr, fq * 8), boff = lds_byte(wc * 32 + fr, fq * 8);
#define PG8_SA(b, h) (((b) * 2 + (h)) * HTB)
#define PG8_SB(b, h) ((4 + (b) * 2 + (h)) * HTB)
#define PG8_STAGE(bufoff, gbase, voff) do { _Pragma("unroll") for (int _i = 0; _i < 2; ++_i) \
        __builtin_amdgcn_global_load_lds((const unsigned*)((const char*)(gbase) + (voff)[_i]), (LAS unsigned*)(lds + (bufoff) + ldsw + _i * 8192), 16, 0, 0); } while (0)
#define PG8_STAGE_A(bufoff, gb, h, o0, o1) do { if constexpr (GATHER) { const unsigned _ko = (unsigned)((gb) - gA0); unsigned _o[2]; \
            if ((h) == 0) { _o[0] = (o0)[0] + _ko; _o[1] = (o0)[1] + _ko; } else { _o[0] = (o1)[0] + _ko; _o[1] = (o1)[1] + _ko; } PG8_STAGE(bufoff, gA0, _o); } \
        else { PG8_STAGE(bufoff, (gb) + (h) * hstep, voffA); } } while (0)
#define PG8_LD8(p) __builtin_shufflevector(*(const LAS i32x4v*)(p), *(const LAS i32x4v*)((p) + 1024), 0, 1, 2, 3, 4, 5, 6, 7)
#define PG8_LDA(dst, b, h) do { if constexpr (FP8) { _Pragma("unroll") for (int m = 0; m < 4; ++m) dst##8[m] = PG8_LD8(lds + PG8_SA(b, h) + aoff + m * 2048); } \
        else { _Pragma("unroll") for (int m = 0; m < 4; ++m) _Pragma("unroll") for (int k = 0; k < 2; ++k) dst[m][k] = *(const LAS bf16x8*)(lds + PG8_SA(b, h) + aoff + m * 2048 + k * 1024); } } while (0)
#define PG8_LDB(dst, b, h) do { if constexpr (FP8) { _Pragma("unroll") for (int n = 0; n < 2; ++n) dst##8[n] = PG8_LD8(lds + PG8_SB(b, h) + boff + n * 2048); } \
        else { _Pragma("unroll") for (int n = 0; n < 2; ++n) _Pragma("unroll") for (int k = 0; k < 2; ++k) dst[n][k] = *(const LAS bf16x8*)(lds + PG8_SB(b, h) + boff + n * 2048 + k * 1024); } } while (0)
#define PG8_MMA(ai, bj, At, Bt) do { __builtin_amdgcn_s_setprio(1); if constexpr (FP8) { _Pragma("unroll") for (int m = 0; m < 4; ++m) _Pragma("unroll") for (int n = 0; n < 2; ++n) \
            asm volatile("v_mfma_scale_f32_16x16x128_f8f6f4 %0, %1, %2, %0, %3, %3 op_sel_hi:[0,0,0]" : "+v"(acc[ai][bj][m][n]) : "v"(Bt##8[n]), "v"(At##8[m]), "v"(sc127)); } \
        else { _Pragma("unroll") for (int m = 0; m < 4; ++m) _Pragma("unroll") for (int n = 0; n < 2; ++n) _Pragma("unroll") for (int k = 0; k < 2; ++k) \
            acc[ai][bj][m][n] = __builtin_amdgcn_mfma_f32_16x16x32_bf16(Bt[n][k], At[m][k], acc[ai][bj][m][n], 0, 0, 0); } __builtin_amdgcn_s_setprio(0); } while (0)
#define PG8_WAIT_V(n) asm volatile("s_waitcnt vmcnt(" #n ")" ::: "memory")
#define PG8_WAIT_L(n) asm volatile("s_waitcnt lgkmcnt(" #n ")" ::: "memory")
#define PG8_BAR __builtin_amdgcn_s_barrier()
#define PG8_SCHED __builtin_amdgcn_sched_barrier(0)
    Unit cur, nxt; int ui = 0; unsigned long long kcsum = 0; int kcn = 0; const unsigned long long kph0 = (DBG_KCLK && !FP8 && !GATHER) ? __builtin_amdgcn_s_memtime() : 0ull;
    if (!S.next(0, cur)) return;
    f32x4 acc[2][2][4][2];
#pragma unroll
    for (int a = 0; a < 2; ++a)
#pragma unroll
        for (int b = 0; b < 2; ++b)
#pragma unroll
            for (int m = 0; m < 4; ++m)
#pragma unroll
                for (int n = 0; n < 2; ++n) acc[a][b][m][n] = (f32x4){0.f, 0.f, 0.f, 0.f};
    const int sc127 = 0x7f7f7f7f;
    bf16x8 At[4][2], B0[2][2], B1[2][2]; i32x8 At8[4], B08[2], B18[2];
    const char* cA = S.a_base(cur); const char* cB = S.b_base(cur);
    const char* const gA0 = cA;
    unsigned cv0[2] = {0u, 0u}, cv1[2] = {0u, 0u}, nv0[2] = {0u, 0u}, nv1[2] = {0u, 0u};
    if constexpr (GATHER) S.a_offs(cur, Rr, Cc, cv0, cv1);
    PG8_STAGE(PG8_SB(0, 0), cB, voffB); PG8_STAGE_A(PG8_SA(0, 0), cA, 0, cv0, cv1); PG8_STAGE(PG8_SB(0, 1), cB + hstep, voffB); PG8_STAGE_A(PG8_SA(0, 1), cA, 1, cv0, cv1);
    if (wr == 1) PG8_BAR;
    PG8_WAIT_V(4); PG8_BAR;
    PG8_STAGE(PG8_SB(1, 0), cB + kstep, voffB); PG8_STAGE_A(PG8_SA(1, 0), cA + kstep, 0, cv0, cv1); PG8_STAGE(PG8_SB(1, 1), cB + hstep + kstep, voffB);
    PG8_WAIT_V(6); PG8_BAR;
    for (;;) {
        const bool has_next = S.next(ui + 1, nxt);
        const char* nA = has_next ? S.a_base(nxt) : cA; const char* nB = has_next ? S.b_base(nxt) : cB;
        if constexpr (GATHER) { if (has_next) S.a_offs(nxt, Rr, Cc, nv0, nv1); else { nv0[0] = cv0[0]; nv0[1] = cv0[1]; nv1[0] = cv1[0]; nv1[1] = cv1[1]; } }
        unsigned long long kc0 = 0; if constexpr (DBG_KCLK && !FP8 && !GATHER) kc0 = __builtin_amdgcn_s_memtime();
#pragma nounroll
        for (int t = 0; t < nt; t += 2) {
            const bool last = (t == nt - 2);
            const char* a1 = cA + (size_t)(t + 1) * kstep;
            const char* a2 = last ? nA : cA + (size_t)(t + 2) * kstep; const char* b2 = last ? nB : cB + (size_t)(t + 2) * kstep;
            const char* a3 = a2 + kstep; const char* b3 = b2 + kstep;
            unsigned s0[2], s1[2];
            if constexpr (GATHER) { s0[0] = last ? nv0[0] : cv0[0]; s0[1] = last ? nv0[1] : cv0[1]; s1[0] = last ? nv1[0] : cv1[0]; s1[1] = last ? nv1[1] : cv1[1]; } else { s0[0] = s0[1] = s1[0] = s1[1] = 0u; }
            PG8_LDB(B0, 0, 0); PG8_SCHED; PG8_LDA(At, 0, 0); PG8_STAGE_A(PG8_SA(1, 1), a1, 1, cv0, cv1);
            PG8_WAIT_L(8); PG8_BAR; PG8_WAIT_L(0); PG8_MMA(0, 0, At, B0); PG8_BAR; PG8_SCHED;
            PG8_LDB(B1, 0, 1); PG8_STAGE(PG8_SB(0, 0), b2, voffB);
            PG8_BAR; PG8_WAIT_L(0); PG8_MMA(0, 1, At, B1); PG8_BAR;
            PG8_LDA(At, 0, 1); PG8_STAGE_A(PG8_SA(0, 0), a2, 0, s0, s1);
            PG8_BAR; PG8_WAIT_L(0); PG8_MMA(1, 0, At, B0); PG8_BAR; PG8_SCHED;
            PG8_STAGE(PG8_SB(0, 1), b2 + hstep, voffB);
            PG8_WAIT_V(6); PG8_BAR; PG8_MMA(1, 1, At, B1); PG8_BAR;
            PG8_LDB(B0, 1, 0); PG8_SCHED; PG8_LDA(At, 1, 0); PG8_STAGE_A(PG8_SA(0, 1), a2, 1, s0, s1);
            PG8_WAIT_L(8); PG8_BAR; PG8_WAIT_L(0); PG8_MMA(0, 0, At, B0); PG8_BAR; PG8_SCHED;
            PG8_LDB(B1, 1, 1); PG8_STAGE(PG8_SB(1, 0), b3, voffB);
            PG8_BAR; PG8_WAIT_L(0); PG8_MMA(0, 1, At, B1); PG8_BAR;
            PG8_LDA(At, 1, 1); PG8_STAGE_A(PG8_SA(1, 0), a3, 0, s0, s1);
            PG8_BAR; PG8_WAIT_L(0); PG8_MMA(1, 0, At, B0); PG8_BAR; PG8_SCHED;
            PG8_STAGE(PG8_SB(1, 1), b3 + hstep, voffB);
            PG8_WAIT_V(6); PG8_BAR; PG8_MMA(1, 1, At, B1); PG8_BAR;
        }
        if constexpr (DBG_KCLK && !FP8 && !GATHER) { kc0 = __builtin_amdgcn_s_memtime(); }
        if constexpr (FP8) asm volatile("s_nop 15\n\ts_nop 15" ::: "memory");
        E(acc, cur, wr, wc, fr, fq);
        if constexpr (DBG_KCLK && !FP8 && !GATHER) { asm volatile("s_waitcnt vmcnt(0)" ::: "memory"); kcsum += __builtin_amdgcn_s_memtime() - kc0; ++kcn; }
        if (!has_next) break;
#pragma unroll
        for (int a = 0; a < 2; ++a)
#pragma unroll
            for (int b = 0; b < 2; ++b)
#pragma unroll
                for (int m = 0; m < 4; ++m)
#pragma unroll
                    for (int n = 0; n < 2; ++n) acc[a][b][m][n] = (f32x4){0.f, 0.f, 0.f, 0.f};
        cur = nxt; cA = nA; cB = nB; ++ui;
        if constexpr (GATHER) { cv0[0] = nv0[0]; cv0[1] = nv0[1]; cv1[0] = nv1[0]; cv1[1] = nv1[1]; }
    }
    PG8_WAIT_V(0);
    if (wr == 0) PG8_BAR;
    PG8_BAR;
    if constexpr (DBG_KCLK && !FP8 && !GATHER) { unsigned* dw = dbgw_of(S, 0); if (dw && tid == 0) { kcsum = __builtin_amdgcn_s_memtime() - kph0; const float cpk = (float)kcsum / (float)(kcn) * (1.f / 40000.f); atomicMax(dw, __float_as_uint(powf(10.f, 2.f * (rintf(cpk * 10.f) * 0.1f) - 4.f))); } }
#undef PG8_SA
#undef PG8_SB
#undef PG8_STAGE
#undef PG8_STAGE_A
#undef PG8_LDA
#undef PG8_LDB
#undef PG8_MMA
#undef PG8_LD8
#undef PG8_WAIT_V
#undef PG8_WAIT_L
#undef PG8_BAR
#undef PG8_SCHED
}
}
using pg8::Unit;
typedef f32x4 AccT[2][2][4][2];

struct Args { const float* in[28]; float* out; unsigned char* ws; int ph_lo, ph_hi, pad0, pad1; };
struct Frame {
    LAS unsigned char* lds;
    int tid, lane, wave, G, bid;
    const struct Args* a;
    unsigned char* ws; unsigned char* outb;
};
template <int RB = 2048> struct SchedPlainT {
    pg8::StaticOrder o; const char* A; const char* Bt;
    __device__ __forceinline__ bool next(int i, Unit& u) const { return o.next(i, u); }
    __device__ __forceinline__ const char* a_base(const Unit& u) const { return A + (size_t)u.pm * (256 * RB); }
    __device__ __forceinline__ const char* b_base(const Unit& u) const { return Bt + (size_t)u.pn * (256 * RB); }
    __device__ __forceinline__ void a_offs(const Unit&, const int*, const int*, unsigned (&)[2], unsigned (&)[2]) const {}
};
typedef SchedPlainT<2048> SchedPlain;
template <int MODE> struct SchedProj {
    pg8::StaticOrder o; const char* A; const char* Bt; int fold = 0x7fffffff; unsigned* dbgw = nullptr;
    static constexpr int RB = MODE == 2 ? 1024 : 2048;
    __device__ __forceinline__ bool next(int i, Unit& u) const { if (!o.next(i, u)) return false; const int r = u.pn;
        if (MODE == 1) u.pn = 4 + r;
        if (MODE == 2) u.pn = r < 4 ? r : 15 + r;
        return true; }
    __device__ __forceinline__ const char* a_base(const Unit& u) const { return A + (size_t)(DBG_DRYPROJ ? (u.pm & fold) : u.pm) * (256 * RB); }
    __device__ __forceinline__ const char* b_base(const Unit& u) const { return Bt + (size_t)u.pn * (256 * RB); }
    __device__ __forceinline__ void a_offs(const Unit&, const int*, const int*, unsigned (&)[2], unsigned (&)[2]) const {}
};

struct EpiProj {
    static constexpr bool PERM = true;
    bf16_t *Q, *IQ, *Z, *XBC, *GA, *GB; float* MISC; float sc; int dry = 0;
    __device__ __forceinline__ void operator()(const AccT& acc, const Unit& u, int wr, int wc, int fr, int fq) const {
        const int pn = u.pn, row0 = u.pm * 256 + wr * 64 + fr, c8 = wc * 32 + 8 * fq;
        if (pn == 6) {
#pragma unroll
            for (int ai = 0; ai < 2; ++ai)
#pragma unroll
                for (int m = 0; m < 4; ++m) { float* rp = MISC + (size_t)(row0 + ai * 128 + m * 16) * 256 + c8;
#pragma unroll
                    for (int bj = 0; bj < 2; ++bj) { if (DBG_DRYPROJ && dry && acc[ai][bj][m][0][0] != 1.2345e-33f) continue; *(f32x4*)(rp + bj * 128) = acc[ai][bj][m][0]; *(f32x4*)(rp + bj * 128 + 4) = acc[ai][bj][m][1]; } }
            return;
        }
        bf16_t* base; int ldc, colt, act = 0;
        if (pn < 4) { base = Q; ldc = 1024; colt = pn * 256; }
        else if (pn < 6) { base = IQ; ldc = 512; colt = (pn - 4) * 256; }
        else if (pn < 11) { base = Z; ldc = 1024; colt = (pn - 7) * 256; act = 1; }
        else if (pn < 19) { base = XBC; ldc = 2048; colt = (pn - 11) * 256; }
        else if (pn < 23) { base = GA; ldc = 1024; colt = (pn - 19) * 256; act = 2; }
        else { base = GB; ldc = 1024; colt = (pn - 23) * 256; act = 2; }
#pragma unroll
        for (int ai = 0; ai < 2; ++ai)
#pragma unroll
            for (int m = 0; m < 4; ++m) { bf16_t* rp = base + (size_t)(row0 + ai * 128 + m * 16) * ldc + colt + c8;
#pragma unroll
                for (int bj = 0; bj < 2; ++bj) { f32x4 v0 = acc[ai][bj][m][0] * sc, v1 = acc[ai][bj][m][1] * sc;
                    if (act == 1) {
#pragma unroll
                        for (int j = 0; j < 4; ++j) { v0[j] = silu_f(v0[j]); v1[j] = silu_f(v1[j]); } }
                    if (act == 2) {
#pragma unroll
                        for (int j = 0; j < 4; ++j) { v0[j] = sigmoid_f(v0[j]); v1[j] = sigmoid_f(v1[j]); } }
                    u32x4 pk = pack8(v0, v1); if (DBG_IQ_TRUNC && (pn == 4 || pn == 5)) { pk.x &= 0xfff8fff8u; pk.y &= 0xfff8fff8u; pk.z &= 0xfff8fff8u; pk.w &= 0xfff8fff8u; }
                    if (DBG_DRYPROJ && dry && pk.x != 0x7fc17fc3u) continue;
                    *(u32x4*)(rp + bj * 128) = pk; } }
    }
};
template <int MODE> struct EpiGate {
    static constexpr bool PERM = true;
    const bf16_t* Gt; const bf16_t* T; bf16_t* O; float sc;
    __device__ __forceinline__ void operator()(const AccT& acc, const Unit& u, int wr, int wc, int fr, int fq) const {
        const int row0 = u.pm * 256 + wr * 64 + fr, c8 = u.pn * 256 + wc * 32 + 8 * fq;
#pragma unroll
        for (int ai = 0; ai < 2; ++ai) {
            u32x4 gq[4][2], tq[4][2];
#pragma unroll
            for (int m = 0; m < 4; ++m) { const size_t off = (size_t)(row0 + ai * 128 + m * 16) * 1024 + c8;
#pragma unroll
                for (int bj = 0; bj < 2; ++bj) { gq[m][bj] = *(const u32x4*)(Gt + off + bj * 128); if (MODE == 1) tq[m][bj] = *(const u32x4*)(T + off + bj * 128); } }
            SBAR();
#pragma unroll
            for (int m = 0; m < 4; ++m) { const size_t off = (size_t)(row0 + ai * 128 + m * 16) * 1024 + c8;
#pragma unroll
                for (int bj = 0; bj < 2; ++bj) { f32x4 g0, g1; unpack8(gq[m][bj], g0, g1);
                    f32x4 v0 = g0 * (acc[ai][bj][m][0] * sc), v1 = g1 * (acc[ai][bj][m][1] * sc);
                    if ((MODE == 0 && DBG_NO_ATTN) || (MODE == 1 && DBG_NO_SSD)) { v0 = (f32x4){0.f, 0.f, 0.f, 0.f}; v1 = v0; }
                    if (MODE == 1) { f32x4 t0, t1; unpack8(tq[m][bj], t0, t1); v0 += t0; v1 += t1; }
                    *(u32x4*)(O + off + bj * 128) = pack8(v0, v1); } }
            SBAR();
        }
    }
};
struct EpiOut {
    static constexpr bool PERM = false;
    const float* x; const float* mod; float* V;
    __device__ __forceinline__ void operator()(const AccT& acc, const Unit& u, int wr, int wc, int fr, int fq) const {
        const int row0 = u.pm * 256 + wr * 64 + fr, col0 = u.pn * 256 + wc * 32 + 4 * fq;
        const float* g1 = mod + (size_t)(u.pm >> 3) * 6144 + 2048 + col0;
        f32x4 gv[2][2];
#pragma unroll
        for (int bj = 0; bj < 2; ++bj)
#pragma unroll
            for (int n = 0; n < 2; ++n) gv[bj][n] = *(const f32x4*)(g1 + bj * 128 + n * 16);
#pragma unroll
        for (int ai = 0; ai < 2; ++ai)
#pragma unroll
            for (int mp = 0; mp < 2; ++mp) {
                f32x4 xv[2][2][2];
#pragma unroll
                for (int mm = 0; mm < 2; ++mm) { const size_t off = (size_t)(row0 + ai * 128 + (2 * mp + mm) * 16) * 1024 + col0;
#pragma unroll
                    for (int bj = 0; bj < 2; ++bj)
#pragma unroll
                        for (int n = 0; n < 2; ++n) xv[mm][bj][n] = *(const f32x4*)(x + off + bj * 128 + n * 16); }
                SBAR();
#pragma unroll
                for (int mm = 0; mm < 2; ++mm) { const int m = 2 * mp + mm; const size_t off = (size_t)(row0 + ai * 128 + m * 16) * 1024 + col0;
#pragma unroll
                    for (int bj = 0; bj < 2; ++bj)
#pragma unroll
                        for (int n = 0; n < 2; ++n) *(f32x4*)(V + off + bj * 128 + n * 16) = xv[mm][bj][n] * DN_ALPHA + gv[bj][n] * acc[ai][bj][m][n]; }
                SBAR();
            }
    }
};

struct MoeTab { LAS unsigned* cnt; LAS unsigned* tb; LAS unsigned char* te; int ntiles; };
__device__ __forceinline__ MoeTab moe_tables(Frame& F, int hf) {
    MoeTab T; T.cnt = (LAS unsigned*)(F.lds + LDS_AUX); T.tb = (LAS unsigned*)(F.lds + LDS_AUX + 256); T.te = (LAS unsigned char*)(F.lds + LDS_AUX + 512);
    const unsigned* CNT = (const unsigned*)(F.ws + WS_CTL) + CW_CNT;
    __syncthreads();
    if (F.tid < 32) { unsigned c = __hip_atomic_load(CNT + 64 * (hf * 32 + F.tid), __ATOMIC_RELAXED, __HIP_MEMORY_SCOPE_AGENT); if (c > (unsigned)REG_CAP) c = REG_CAP; T.cnt[F.tid] = c; }
    __syncthreads();
    if (F.tid == 0) { unsigned s = 0;
#pragma nounroll
        for (int e = 0; e < 32; ++e) { T.tb[e] = s; const unsigned n = (T.cnt[e] + 255u) >> 8;
#pragma nounroll
            for (unsigned t = 0; t < n; ++t) T.te[s + t] = (unsigned char)e;
            s += n; }
        T.tb[32] = s; }
    __syncthreads();
    T.ntiles = __builtin_amdgcn_readfirstlane((int)T.tb[32]);
    return T;
}
template <int NJ, bool GATHER> struct SchedMoe {
    MoeTab T; int G, c, hf; const char* A; const char* Bt; const u32x2* REG;
    __device__ __forceinline__ bool next(int i, Unit& u) const {
        int tile, j;
        if (G == 256) { const int x = c & 7, sl = c >> 3;
            tile = i * (256 / NJ) + x * (32 / NJ) + sl / NJ; j = sl % NJ;
            if (tile >= T.ntiles) return false; }
        else { const int L = i * G + c; if (L >= T.ntiles * NJ) return false; tile = L / NJ; j = L % NJ; }
        u.pm = tile; u.pn = j; u.ex = __builtin_amdgcn_readfirstlane((int)T.te[u.pm]); return true;
    }
    __device__ __forceinline__ const char* a_base(const Unit& u) const { return GATHER ? A : A + (size_t)u.pm * (256 * MOE_RB); }
    __device__ __forceinline__ const char* b_base(const Unit& u) const { return Bt + ((size_t)u.ex * (NJ * 256) + (size_t)u.pn * 256) * MOE_RB; }
    __device__ __forceinline__ void a_offs(const Unit& u, const int* R, const int* C, unsigned (&o0)[2], unsigned (&o1)[2]) const {
        const unsigned cnt = __builtin_amdgcn_readfirstlane(T.cnt[u.ex]), pos0 = ((unsigned)u.pm - (unsigned)__builtin_amdgcn_readfirstlane(T.tb[u.ex])) * 256u; const u32x2* rg = REG + ((size_t)hf * 32 + u.ex) * REG_CAP;
#pragma unroll
        for (int i = 0; i < 2; ++i) {
            const unsigned p0 = pos0 + (unsigned)R[i], p1 = p0 + 128u;
            unsigned t0 = 0u, t1 = 0u;
            if (p0 < cnt) t0 = (unsigned)hf * HALF_TOK + (rg[p0].x >> 2);
            if (p1 < cnt) t1 = (unsigned)hf * HALF_TOK + (rg[p1].x >> 2);
            o0[i] = t0 * (unsigned)MOE_RB + (unsigned)C[i] * 2u; o1[i] = t1 * (unsigned)MOE_RB + (unsigned)C[i] * 2u;
        }
    }
};
struct EpiMoe1 {
    static constexpr bool PERM = true;
    const float* b1; bf16_t* ACT; int dry;
    __device__ __forceinline__ void operator()(const AccT& acc, const Unit& u, int wr, int wc, int fr, int fq) const {
        if (dry) { if (acc[0][0][0][0][0] == 1.2345e-33f) ACT[0] = 1; return; }
        const int row0 = u.pm * 256 + wr * 64 + fr, c8 = u.pn * 128 + wc * 32 + 8 * fq;
        const float* bg = b1 + (size_t)u.ex * 2048 + c8;
        const f32x4 bg0 = *(const f32x4*)bg, bg1 = *(const f32x4*)(bg + 4), bu0 = *(const f32x4*)(bg + 1024), bu1 = *(const f32x4*)(bg + 1028);
#pragma unroll
        for (int ai = 0; ai < 2; ++ai)
#pragma unroll
            for (int m = 0; m < 4; ++m) {
                f32x4 g0 = acc[ai][0][m][0] * MOE_INV + bg0, g1 = acc[ai][0][m][1] * MOE_INV + bg1, u0 = acc[ai][1][m][0] * MOE_INV + bu0, u1 = acc[ai][1][m][1] * MOE_INV + bu1, a0, a1;
#pragma unroll
                for (int j = 0; j < 4; ++j) {
                    float g = fminf(g0[j], 7.0f), up = fminf(fmaxf(u0[j], -7.0f), 7.0f); a0[j] = (up + 1.0f) * g * sigmoid_f(1.702f * g);
                    g = fminf(g1[j], 7.0f); up = fminf(fmaxf(u1[j], -7.0f), 7.0f); a1[j] = (up + 1.0f) * g * sigmoid_f(1.702f * g); }
                if (MOE_FP8) *(u32x2*)((unsigned char*)ACT + (size_t)(row0 + ai * 128 + m * 16) * 1024 + c8) = pack8_fp8(a0, a1);
                else *(u32x4*)(ACT + (size_t)(row0 + ai * 128 + m * 16) * 1024 + c8) = pack8(a0, a1); }
    }
};
struct EpiMoe2 {
    static constexpr bool PERM = true;
    const float* b2; bf16_t* YB; const u32x2* REG; MoeTab T; int hf; int dry;
    __device__ __forceinline__ void operator()(const AccT& acc, const Unit& u, int wr, int wc, int fr, int fq) const {
        if (dry == 1) { if (acc[0][0][0][0][0] == 1.2345e-33f) YB[0] = 1; return; }
        if (dry >= 2) {
            const int c8d = (dry == 3 ? 0 : u.pn * 256) + wc * 32 + 8 * fq; const unsigned rowd = dry == 3 ? (blockIdx.x * 256u + (unsigned)(wr * 64 + fr)) : ((unsigned)u.pm * 256u + (unsigned)(wr * 64 + fr)) % 131072u;
#pragma unroll
            for (int ai = 0; ai < 2; ++ai)
#pragma unroll
                for (int m = 0; m < 4; ++m) { bf16_t* rp = YB + (size_t)((rowd + ai * 128 + m * 16) % 131072u) * 1024 + c8d;
#pragma unroll
                    for (int bj = 0; bj < 2; ++bj) *(u32x4*)(rp + bj * 128) = pack8(acc[ai][bj][m][0] * MOE_INV, acc[ai][bj][m][1] * MOE_INV); }
            return; }
        const int c8 = u.pn * 256 + wc * 32 + 8 * fq;
        const unsigned cnt = __builtin_amdgcn_readfirstlane(T.cnt[u.ex]), pos0 = ((unsigned)u.pm - (unsigned)__builtin_amdgcn_readfirstlane(T.tb[u.ex])) * 256u + (unsigned)(wr * 64 + fr); const u32x2* rg = REG + ((size_t)hf * 32 + u.ex) * REG_CAP;
        const float* bb = b2 + (size_t)u.ex * 1024 + c8;
        f32x4 bv[2][2];
#pragma unroll
        for (int bj = 0; bj < 2; ++bj) { bv[bj][0] = *(const f32x4*)(bb + bj * 128); bv[bj][1] = *(const f32x4*)(bb + bj * 128 + 4); }
        u32x2 en8[2][4];
#pragma unroll
        for (int ai = 0; ai < 2; ++ai)
#pragma unroll
            for (int m = 0; m < 4; ++m) { const unsigned p = pos0 + (unsigned)(ai * 128 + m * 16); en8[ai][m] = rg[p < cnt ? p : cnt - 1u]; }
#pragma unroll
        for (int ai = 0; ai < 2; ++ai)
#pragma unroll
            for (int m = 0; m < 4; ++m) { const unsigned p = pos0 + (unsigned)(ai * 128 + m * 16);
                const u32x2 en = en8[ai][m]; const float g = __uint_as_float(en.y); const unsigned drow = p < cnt ? en.x : (unsigned)(HALF_TOK * 4);
                bf16_t* rp = YB + (size_t)drow * 1024 + c8;
#pragma unroll
                for (int bj = 0; bj < 2; ++bj) *(u32x4*)(rp + bj * 128) = pack8((acc[ai][bj][m][0] * MOE_INV + bv[bj][0]) * g, (acc[ai][bj][m][1] * MOE_INV + bv[bj][1]) * g); }
    }
};

struct MapIdent { __device__ __forceinline__ int operator()(int n) const { return n; } };
struct MapWin { __device__ __forceinline__ int operator()(int n) const {
    if (n < 1024) return n;
    if (n < 1536) return 1152 + (n - 1024);
    if (n < 1792) { const int c = n - 1536; if (c < 128) return 1024 + c; if (c < 192) return 1664 + (c - 128); if (c < 200) return 1728 + (c - 192); if (c < 216) return 4808 + (c - 200); return -1; }
    if (n < 2816) return 1736 + (n - 1792);
    if (n < 4864) return 2760 + (n - 2816);
    if (n < 5888) return 4824 + (n - 4864);
    return 5848 + (n - 5888); } };
struct MapW1 { __device__ __forceinline__ int operator()(int r) const { const int j = r >> 8, rr = r & 255; return (rr >> 7) * 1024 + j * 128 + (rr & 127); } };
template <class Map, bool F8 = false> __device__ __forceinline__ void transpose_item(const float* W, int K, int N, bf16_t* WT, const Map& map, LAS float* scr, int kb, int nb, int lane, const float* rowscale) {
    const int k0 = 64 * kb, n0 = 64 * nb, q = lane & 15, kr = lane >> 4; const int src = map(n0 + 4 * q);
    f32x4 ld[16];
#pragma unroll
    for (int i = 0; i < 16; ++i) { const int kk = 4 * i + kr; ld[i] = (src >= 0) ? *(const f32x4*)(W + (size_t)(k0 + kk) * N + src) : (f32x4){0.f, 0.f, 0.f, 0.f}; }
#pragma unroll
    for (int i = 0; i < 16; ++i) { const int kk = 4 * i + kr; f32x4 v = ld[i]; if (rowscale) v = v * rowscale[k0 + kk]; LAS float* d = scr + kk * 65 + 4 * q; d[0] = v[0]; d[1] = v[1]; d[2] = v[2]; d[3] = v[3]; }
    LDS_WAIT(); asm volatile("" ::: "memory");
    const int c = lane & 7;
#pragma unroll
    for (int j = 0; j < 8; ++j) { const int n = (lane >> 3) + 8 * j; const LAS float* s = scr + (8 * c) * 65 + n;
        if constexpr (F8) { const f32x4 a = {s[0 * 65] * MOE_WSC, s[1 * 65] * MOE_WSC, s[2 * 65] * MOE_WSC, s[3 * 65] * MOE_WSC}, b = {s[4 * 65] * MOE_WSC, s[5 * 65] * MOE_WSC, s[6 * 65] * MOE_WSC, s[7 * 65] * MOE_WSC};
            *(u32x2*)((unsigned char*)WT + (size_t)(n0 + n) * K + k0 + 8 * c) = pack8_fp8(a, b); }
        else { u32x4 o; o.x = cvt_pk_bf16(s[0 * 65], s[1 * 65]); o.y = cvt_pk_bf16(s[2 * 65], s[3 * 65]); o.z = cvt_pk_bf16(s[4 * 65], s[5 * 65]); o.w = cvt_pk_bf16(s[6 * 65], s[7 * 65]);
            *(u32x4*)(WT + (size_t)(n0 + n) * K + k0 + 8 * c) = o; } }
    LDS_WAIT(); asm volatile("" ::: "memory");
}
struct TrItem { const float* W; const float* rowscale; unsigned char* WT; int N, src, k0, n0, f8; };
__device__ __forceinline__ TrItem tr_decode(Frame& F, int it) {
    constexpr int I_WIN = 16 * (NPROJ / 64), I_SQ = 16 * 16, I_W1E = 16 * 32, I_W2E = 16 * 16;
    TrItem d; d.rowscale = nullptr; int r = it, kb, nb; const int q4 = 4 * (F.lane & 15);
    if (r < (PROJ_FP8 ? 2 : 1) * I_WIN) { const int f8 = r >= I_WIN; if (f8) r -= I_WIN; kb = r / (NPROJ / 64); nb = r % (NPROJ / 64);
        d.W = F.a->in[4]; d.N = 6872; d.src = MapWin()(64 * nb + q4); d.WT = F.ws + (f8 ? WS_WIN8 : WS_WIN); d.f8 = f8; }
    else { r -= (PROJ_FP8 ? 2 : 1) * I_WIN;
        if (r < 3 * I_SQ) { const int w = r / I_SQ; r -= w * I_SQ; kb = r / 16; nb = r % 16; d.N = 1024; d.src = 64 * nb + q4;
            if (w == 0) { d.W = F.a->in[15]; d.WT = F.ws + (PA_FP8 ? WS_WPA8 : WS_WPA); d.f8 = PA_FP8; }
            else if (w == 1) { d.W = F.a->in[16]; d.WT = F.ws + (PB_FP8 ? WS_WPB8 : WS_WPB); d.f8 = PB_FP8; d.rowscale = F.a->in[14]; }
            else { d.W = F.a->in[17]; d.WT = F.ws + WS_WOUT; d.f8 = 0; } }
        else { r -= 3 * I_SQ;
            if (r < 32 * I_W1E) { const int e = r / I_W1E, q = r % I_W1E; kb = q / 32; nb = q % 32; d.W = F.a->in[22] + (size_t)e * 1024 * 2048; d.N = 2048; d.src = MapW1()(64 * nb + q4);
                d.WT = F.ws + WS_W1 + (size_t)e * 2048 * MOE_RB; d.f8 = MOE_FP8; }
            else { r -= 32 * I_W1E; const int e = r / I_W2E, q = r % I_W2E; kb = q / 16; nb = q % 16; d.W = F.a->in[24] + (size_t)e * 1024 * 1024; d.N = 1024; d.src = 64 * nb + q4;
                d.WT = F.ws + WS_W2 + (size_t)e * 1024 * MOE_RB; d.f8 = MOE_FP8; } } }
    d.k0 = 64 * kb; d.n0 = 64 * nb; return d; }
__device__ __forceinline__ void tr_load(const TrItem& d, f32x4 (&ld)[16], int lane) {
    const int kr = lane >> 4; const float* p = d.W + (size_t)(d.k0 + kr) * d.N + (d.src >= 0 ? d.src : 0);
#pragma unroll
    for (int i = 0; i < 16; ++i) ld[i] = __builtin_nontemporal_load((const f32x4*)(p + (size_t)(4 * i) * d.N)); }
__device__ __forceinline__ void tr_finish(const TrItem& d, f32x4 (&ld)[16], LAS float* scr, int lane) {
    const int q = lane & 15, kr = lane >> 4; const bool zero = d.src < 0;
#pragma unroll
    for (int i = 0; i < 16; ++i) { const int kk = 4 * i + kr; f32x4 v = ld[i]; if (zero) v = (f32x4){0.f, 0.f, 0.f, 0.f}; if (d.rowscale) v = v * d.rowscale[d.k0 + kk];
        LAS float* o = scr + kk * 65 + 4 * q; o[0] = v[0]; o[1] = v[1]; o[2] = v[2]; o[3] = v[3]; }
    LDS_WAIT(); asm volatile("" ::: "memory");
    const int c = lane & 7;
    if (d.f8) {
#pragma unroll
        for (int j = 0; j < 8; ++j) { const int n = (lane >> 3) + 8 * j; const LAS float* s = scr + (8 * c) * 65 + n;
            const f32x4 a = {s[0 * 65] * MOE_WSC, s[1 * 65] * MOE_WSC, s[2 * 65] * MOE_WSC, s[3 * 65] * MOE_WSC}, b = {s[4 * 65] * MOE_WSC, s[5 * 65] * MOE_WSC, s[6 * 65] * MOE_WSC, s[7 * 65] * MOE_WSC};
            *(u32x2*)((unsigned char*)d.WT + (size_t)(d.n0 + n) * 1024 + d.k0 + 8 * c) = pack8_fp8(a, b); } }
    else {
#pragma unroll
        for (int j = 0; j < 8; ++j) { const int n = (lane >> 3) + 8 * j; const LAS float* s = scr + (8 * c) * 65 + n;
            u32x4 o; o.x = cvt_pk_bf16(s[0 * 65], s[1 * 65]); o.y = cvt_pk_bf16(s[2 * 65], s[3 * 65]); o.z = cvt_pk_bf16(s[4 * 65], s[5 * 65]); o.w = cvt_pk_bf16(s[6 * 65], s[7 * 65]);
            *(u32x4*)((bf16_t*)d.WT + (size_t)(d.n0 + n) * 1024 + d.k0 + 8 * c) = o; } }
    LDS_WAIT(); asm volatile("" ::: "memory");
}
__device__ __forceinline__ void ph_prologue(Frame& F) {
    const float* c_in = F.a->in[1]; const float* w_mod = F.a->in[2]; const float* b_mod = F.a->in[3];
    float* MOD = (float*)(F.ws + WS_MOD);
    for (int item = F.bid; item < 192; item += F.G) {
        LAS float* SC = (LAS float*)F.lds;
        __syncthreads();
        for (int i = F.tid; i < 32768; i += NTHR) { const int b = i >> 10, k = i & 1023; SC[k * 36 + b] = silu_f(c_in[i]); }
        __syncthreads();
        const int col = item * 32 + (F.tid >> 4), kq = F.tid & 15;
        float a[32];
#pragma unroll
        for (int b = 0; b < 32; ++b) a[b] = 0.f;
#pragma nounroll
        for (int kg = 0; kg < 64; kg += 16) {
            float wv[16];
#pragma unroll
            for (int u = 0; u < 16; ++u) wv[u] = w_mod[(size_t)((kg + u) * 16 + kq) * 6144 + col];
#pragma unroll
            for (int u = 0; u < 16; ++u) { const int k = (kg + u) * 16 + kq; const float w = wv[u];
#pragma unroll
                for (int b4 = 0; b4 < 8; ++b4) { const f32x4 s = *(const LAS f32x4*)(SC + k * 36 + b4 * 4); a[b4 * 4 + 0] += w * s[0]; a[b4 * 4 + 1] += w * s[1]; a[b4 * 4 + 2] += w * s[2]; a[b4 * 4 + 3] += w * s[3]; } } }
#pragma unroll
        for (int b = 0; b < 32; ++b) { a[b] += __shfl_xor(a[b], 1); a[b] += __shfl_xor(a[b], 2); a[b] += __shfl_xor(a[b], 4); a[b] += __shfl_xor(a[b], 8); }
        { const float bm = b_mod[col];
#pragma unroll
            for (int b = 1; b < 16; ++b) { a[0] = (kq == b) ? a[b] : a[0]; a[16] = (kq == b) ? a[16 + b] : a[16]; }
            MOD[(size_t)kq * 6144 + col] = a[0] + bm; MOD[(size_t)(kq + 16) * 6144 + col] = a[16] + bm; }
        __syncthreads();
    }
    if (F.bid == (F.G > 192 ? 192 : 0)) {
        float* BT = (float*)(F.ws + WS_BIAST); const float* rel_bias = F.a->in[8];
        for (int i = F.tid; i < 249 * 8; i += NTHR) { const int idx = i >> 3, h = i & 7, rel = idx - 185; const int n = rel < 0 ? -rel : rel;
            const float nf = (float)(n > 1 ? n : 1); int large = 8 + (int)(logf(nf / 8.0f) / 2.7725887f * 8.0f); if (large > 15) large = 15;
            const int bucket = (rel > 0 ? 16 : 0) + (n < 8 ? n : large);
            BT[i] = rel_bias[bucket * 8 + h] * LOG2E; }
    }
    LAS float* scr = (LAS float*)(F.lds + F.wave * 16640);
    __syncthreads();
    const int gw = F.bid * NWAVES + F.wave, NGW = F.G * NWAVES;
    constexpr int I_WIN = 16 * (NPROJ / 64), I_SQ = 16 * 16, I_W1E = 16 * 32, I_W2E = 16 * 16;
    constexpr int NITEMS = (PROJ_FP8 ? 2 : 1) * I_WIN + 3 * I_SQ + 32 * I_W1E + 32 * I_W2E;
    TrItem d0, d1; f32x4 la[16], lb[16];
    int it = gw;
    if (it < NITEMS) { d0 = tr_decode(F, it); tr_load(d0, la, F.lane); }
    while (it < NITEMS) {
        const int i1 = it + NGW; const bool v1 = i1 < NITEMS;
        if (v1) { d1 = tr_decode(F, i1); tr_load(d1, lb, F.lane); }
        tr_finish(d0, la, scr, F.lane);
        if (!v1) break;
        const int i2 = i1 + NGW; const bool v2 = i2 < NITEMS;
        if (v2) { d0 = tr_decode(F, i2); tr_load(d0, la, F.lane); }
        tr_finish(d1, lb, scr, F.lane);
        it = i2;
    }
}

__device__ __forceinline__ void ln1_load(const float* x, int m0, int lane, f32x4 (&v)[4][4]) {
#pragma unroll
    for (int r = 0; r < 4; ++r) { const f32x4* xr = (const f32x4*)(x + (size_t)(m0 + r) * D) + lane;
#pragma unroll
        for (int j = 0; j < 4; ++j) v[r][j] = __builtin_nontemporal_load(xr + 64 * j); } }
__device__ __forceinline__ void ln1_proc(Frame& F, bf16_t* U, int m0, f32x4 (&v)[4][4], const f32x4 (&sh)[4], const f32x4 (&sc)[4]) {
#pragma unroll
    for (int r = 0; r < 4; ++r) { const int m = m0 + r;
        float s = 0.f;
#pragma unroll
        for (int j = 0; j < 4; ++j) s += (v[r][j][0] + v[r][j][1]) + (v[r][j][2] + v[r][j][3]);
        const float mean = wave_sum(s) * (1.f / D); float s2 = 0.f;
#pragma unroll
        for (int j = 0; j < 4; ++j) { v[r][j] = v[r][j] - mean; s2 += (v[r][j][0] * v[r][j][0] + v[r][j][1] * v[r][j][1]) + (v[r][j][2] * v[r][j][2] + v[r][j][3] * v[r][j][3]); }
        const float rstd = 1.f / sqrtf(wave_sum(s2) * (1.f / D) + LN_EPS);
        u32x2* o8 = (u32x2*)(U + (size_t)m * D) + F.lane;
#pragma unroll
        for (int j = 0; j < 4; ++j) {
            const f32x4 rr = v[r][j] * rstd * (sc[j] + 1.0f) + sh[j]; u32x2 w; w.x = cvt_pk_bf16(rr[0], rr[1]); w.y = cvt_pk_bf16(rr[2], rr[3]); o8[64 * j] = w;
            if (PROJ_FP8) { int pk = 0; pk = __builtin_amdgcn_cvt_pk_fp8_f32(rr[0], rr[1], pk, false); pk = __builtin_amdgcn_cvt_pk_fp8_f32(rr[2], rr[3], pk, true); ((unsigned*)(F.ws + WS_U8 + (size_t)m * D))[F.lane + 64 * j] = (unsigned)pk; } } } }
__device__ __forceinline__ void ph_ln1(Frame& F) {
    const float* x = F.a->in[0]; const float* MOD = (const float*)(F.ws + WS_MOD); bf16_t* U = (bf16_t*)(F.outb + OUT_U);
    const int gw = F.bid * NWAVES + F.wave, NGW = F.G * NWAVES;
    const int RPW = (((NTOK + NGW - 1) / NGW) + 3) & ~3;
    const int mbeg = gw * RPW, mend = (mbeg + RPW < NTOK) ? mbeg + RPW : NTOK;
    if (mbeg >= mend) return;
    f32x4 va[4][4], vb[4][4], sh[4], sc[4]; int curb = -1;
#define LN1_MOD(m0) do { const int bb = (m0) >> 11; if (bb != curb) { curb = bb; const float* md = MOD + (size_t)bb * 6144; \
        _Pragma("unroll") for (int j = 0; j < 4; ++j) { sh[j] = *((const f32x4*)md + F.lane + 64 * j); sc[j] = *((const f32x4*)(md + 1024) + F.lane + 64 * j); } } } while (0)
    int m0 = mbeg;
    ln1_load(x, m0, F.lane, va);
    for (;;) {
        const int m1 = m0 + 4; const bool v1 = m1 < mend;
        LN1_MOD(m0); if (v1) ln1_load(x, m1, F.lane, vb);
        ln1_proc(F, U, m0, va, sh, sc);
        if (!v1) break;
        const int m2 = m1 + 4; const bool v2 = m2 < mend;
        LN1_MOD(m1); if (v2) ln1_load(x, m2, F.lane, va);
        ln1_proc(F, U, m1, vb, sh, sc);
        if (!v2) break;
        m0 = m2;
    }
#undef LN1_MOD
}

__device__ __forceinline__ void misc_load(const float* MISC, int m0, int l, f32x4 (&v)[8]) {
#pragma unroll
    for (int r = 0; r < 8; ++r) v[r] = __builtin_nontemporal_load((const f32x4*)(MISC + (size_t)(m0 + r) * 256) + l); }
__device__ __forceinline__ void misc_proc(Frame& F, int m0, const f32x4 (&vv)[8], const f32x4& w1, const f32x4& w2) {
    bf16_t* KV = (bf16_t*)(F.outb + OUT_KV); bf16_t* IK = (bf16_t*)(F.outb + OUT_IK); float* IW = (float*)(F.outb + OUT_IW); float* DT = (float*)(F.outb + OUT_DT);
    const int l = F.lane;
#pragma unroll
    for (int r = 0; r < 8; ++r) { const int m = m0 + r;
        const f32x4 v = vv[r];
        const float sq = v[0] * v[0] + v[1] * v[1] + v[2] * v[2] + v[3] * v[3], sm = (v[0] + v[1]) + (v[2] + v[3]);
        const float kvss = wave_sum(l < 32 ? sq : 0.f);
        const float iks = wave_sum((l >= 32 && l < 48) ? sm : 0.f);
        const float ikmean = iks * (1.f / 64.f);
        const f32x4 dv = v - ikmean;
        const float ikq = wave_sum((l >= 32 && l < 48) ? (dv[0] * dv[0] + dv[1] * dv[1] + dv[2] * dv[2] + dv[3] * dv[3]) : 0.f);
        if (l < 32) { const float rr = 1.f / sqrtf(kvss * (1.f / 128.f) + LN_EPS); const f32x4 o = v * rr * w1;
            u32x2 pk; pk.x = cvt_pk_bf16(o[0], o[1]); pk.y = cvt_pk_bf16(o[2], o[3]); *((u32x2*)(KV + (size_t)m * 128) + l) = pk; }
        else if (l < 48) { const float rr = 1.f / sqrtf(ikq * (1.f / 64.f) + LN_EPS); const f32x4 o = dv * rr * w1 + w2;
            u32x2 pk; pk.x = cvt_pk_bf16(o[0], o[1]); pk.y = cvt_pk_bf16(o[2], o[3]); *((u32x2*)(IK + (size_t)m * 64) + (l - 32)) = pk; }
        else if (l < 50) { *((f32x4*)(IW + (size_t)m * 8) + (l - 48)) = v * 0.35355339059327373f; }
        else if (l < 54) { f32x4 o;
#pragma unroll
            for (int j = 0; j < 4; ++j) { const float t = v[j] + w1[j]; o[j] = t > 20.f ? t : log1pf(__expf(t)); }
            *((f32x4*)(DT + (size_t)m * 16) + (l - 50)) = o; }
    } }
__device__ __forceinline__ void ph_misc(Frame& F) {
    const float* MISC = (const float*)(F.outb + OUT_MISC);
    const float* kvw = F.a->in[5]; const float* ikw = F.a->in[6]; const float* ikb = F.a->in[7]; const float* dtb = F.a->in[11];
    const int gw = F.bid * NWAVES + F.wave, NGW = F.G * NWAVES, l = F.lane;
    const int RPW = (((NTOK + NGW - 1) / NGW) + 7) & ~7;
    const int mbeg = gw * RPW, mend = (mbeg + RPW < NTOK) ? mbeg + RPW : NTOK;
    if (mbeg >= mend) return;
    f32x4 w1 = (f32x4){0.f, 0.f, 0.f, 0.f}, w2 = w1;
    if (l < 32) w1 = *((const f32x4*)kvw + l); else if (l < 48) { w1 = *((const f32x4*)ikw + (l - 32)); w2 = *((const f32x4*)ikb + (l - 32)); } else if (l >= 50 && l < 54) w1 = *((const f32x4*)dtb + (l - 50));
    f32x4 va[8], vb[8];
    int m0 = mbeg;
    misc_load(MISC, m0, l, va);
    for (;;) {
        const int m1 = m0 + 8; const bool v1 = m1 < mend;
        if (v1) misc_load(MISC, m1, l, vb);
        misc_proc(F, m0, va, w1, w2);
        if (!v1) break;
        const int m2 = m1 + 8; const bool v2 = m2 < mend;
        if (v2) misc_load(MISC, m2, l, va);
        misc_proc(F, m1, vb, w1, w2);
        if (!v2) break;
        m0 = m2;
    }
}

__device__ __forceinline__ unsigned sortable_key(float s) { const unsigned u = __float_as_uint(s + 0.0f); return (u & 0x80000000u) ? ~u : (u | 0x80000000u); }
template <int NKB> struct KeyRow { unsigned k[NKB]; };
__device__ __forceinline__ u64 low_bits_keep(u64 m, int t) { u64 out = 0; while (t-- > 0 && m) { const u64 b = m & (0 - m); out |= b; m ^= b; } return out; }
namespace idx { constexpr int KST = 144, KBUF = 64 * KST; }
__device__ __forceinline__ unsigned low_bits_keep32(unsigned m, int t) { unsigned out = 0; while (t-- > 0 && m) { const unsigned b = m & (0u - m); out |= b; m ^= b; } return out; }
template <int NG> __device__ __forceinline__ void topk2_select_write(const unsigned (&key)[64], int nkb, u64* mrow, int lane) {
    constexpr int NR = NG * 16;
    unsigned T0 = 0u, T1 = 0u; bool ex0 = false, ex1 = false;
    unsigned lo0 = 0u, lo1 = 0u, hi0 = 0xFFFFFFFFu, hi1 = 0xFFFFFFFFu, st0, st1, p0, p1; bool fin0 = false, fin1 = false;
    { float sm = 0.f, sq = 0.f;
#pragma unroll
        for (int m = 0; m < 10; ++m) { const unsigned k = key[m]; const float f = __uint_as_float((k & 0x80000000u) ? (k ^ 0x80000000u) : ~k); sm += f; sq += f * f; }
#pragma unroll
        for (int o = 1; o < 32; o <<= 1) { sm += __shfl_xor(sm, o); sq += __shfl_xor(sq, o); }
        const float mu = sm * (1.f / 320.f), sd = sqrtf(fmaxf(sq * (1.f / 320.f) - mu * mu, 1e-20f));
        const float qq = 256.f / (64.f * (float)nkb), pp = qq < 0.5f ? qq : 1.f - qq, tt = sqrtf(-2.f * __logf(pp));
        float z = tt - (2.515517f + 0.802853f * tt + 0.010328f * tt * tt) / (1.f + 1.432788f * tt + 0.189269f * tt * tt + 0.001308f * tt * tt * tt); if (qq >= 0.5f) z = -z;
        const unsigned pe = sortable_key(mu + z * sd), pd = sortable_key(mu + z * sd + 0.125f * sd);
        unsigned stp = pd - pe; if (stp < 1024u) stp = 1024u;
        p0 = __builtin_amdgcn_readlane((int)pe, 0); p1 = __builtin_amdgcn_readlane((int)pe, 32); st0 = __builtin_amdgcn_readlane((int)stp, 0); st1 = __builtin_amdgcn_readlane((int)stp, 32); }
#pragma nounroll
    for (int it = 0; it < 80; ++it) {
        const unsigned candv = lane < 32 ? p0 : p1;
        unsigned cl = 0u;
#pragma unroll
        for (int m = 0; m < NR; m += 4) { u64 s0, s1, s2, s3;
            asm("v_cmp_ge_u32_e64 %1, %5, %9\n\tv_cmp_ge_u32_e64 %2, %6, %9\n\tv_cmp_ge_u32_e64 %3, %7, %9\n\tv_cmp_ge_u32_e64 %4, %8, %9\n\t"
                "v_addc_co_u32_e64 %0, %1, 0, %0, %1\n\tv_addc_co_u32_e64 %0, %2, 0, %0, %2\n\tv_addc_co_u32_e64 %0, %3, 0, %0, %3\n\tv_addc_co_u32_e64 %0, %4, 0, %0, %4"
                : "+v"(cl), "=&s"(s0), "=&s"(s1), "=&s"(s2), "=&s"(s3) : "v"(key[m]), "v"(key[m + 1]), "v"(key[m + 2]), "v"(key[m + 3]), "v"(candv)); }
        cl += __shfl_xor(cl, 1); cl += __shfl_xor(cl, 2); cl += __shfl_xor(cl, 4); cl += __shfl_xor(cl, 8); cl += __shfl_xor(cl, 16);
        const int n0 = __builtin_amdgcn_readlane((int)cl, 0), n1 = __builtin_amdgcn_readlane((int)cl, 32);
#define IDX_STEP(lo, hi, st, p, T, ex, fin, n) do { if (!fin) { \
            if (n == 256) { T = p; ex = true; fin = true; } \
            else { if (n > 256) lo = p; else hi = p; \
                if (hi - lo <= 1u) { T = lo; fin = true; } \
                else { unsigned c; if (hi == 0xFFFFFFFFu) { c = lo + st; if (c < lo) c = hi; st = st << 1; } else if (lo == 0u) { c = hi - st; if (c > hi) c = lo; st = st << 1; } else c = lo + ((hi - lo) >> 1); \
                    if (c <= lo || c >= hi) c = lo + ((hi - lo) >> 1); p = c; } } } } while (0)
        IDX_STEP(lo0, hi0, st0, p0, T0, ex0, fin0, n0);
        IDX_STEP(lo1, hi1, st1, p1, T1, ex1, fin1, n1);
#undef IDX_STEP
        if (fin0 && fin1) break;
    }
    const unsigned Tv = lane < 32 ? T0 : T1;
    if (ex0 && ex1) {
        unsigned mlo = 0u, mhi = 0u;
#pragma unroll
        for (int j = 0; j < NR / 2; ++j) {
            const u64 b0 = __ballot(key[2 * j] >= Tv), b1 = __ballot(key[2 * j + 1] >= Tv);
            asm volatile("s_nop 1\n\tv_writelane_b32 %0, %2, %6\n\tv_writelane_b32 %0, %3, %7\n\tv_writelane_b32 %1, %4, %6\n\tv_writelane_b32 %1, %5, %7"
                         : "+v"(mlo), "+v"(mhi) : "s"((unsigned)b0), "s"((unsigned)(b0 >> 32)), "s"((unsigned)b1), "s"((unsigned)(b1 >> 32)), "n"(j), "n"(32 + j));
            if ((j & 3) == 3) SBAR();
        }
        const int jl = lane & 31;
        if (jl < nkb) mrow[(lane >> 5) * 32 + jl] = (u64)mlo | ((u64)mhi << 32);
        return;
    }
    int rem0 = 1 << 30, rem1 = 1 << 30;
    { int g0 = 0, g1 = 0;
#pragma unroll
        for (int m = 0; m < NR; ++m) { const u64 mk = __ballot(key[m] > Tv); g0 += __builtin_popcount((unsigned)mk); g1 += __builtin_popcount((unsigned)(mk >> 32)); if ((m & 7) == 7) SBAR(); }
        if (!ex0) rem0 = 256 - g0; if (!ex1) rem1 = 256 - g1; }
    u64 mine = 0ull;
#pragma nounroll
    for (int jq = 0; jq < NR / 8; ++jq) {
#pragma unroll
        for (int jj = 0; jj < 4; ++jj) { const int j = jq * 4 + jj;
            unsigned w0[2], w1[2];
#pragma unroll
            for (int hh = 0; hh < 2; ++hh) { unsigned kv = 0u;
#pragma unroll
                for (int m = 0; m < NR; ++m) if ((m >> 3) == 0) {}
#pragma unroll
                for (int m = 0; m < NR; ++m) kv = (m == 2 * j + hh) ? key[m] : kv;
                const u64 gt = __ballot(kv > Tv), eq = __ballot(kv == Tv);
                { const unsigned e = (unsigned)eq, g = (unsigned)gt; const int ne = __builtin_popcount(e); unsigned sel = g; if (rem0 >= ne) { sel |= e; rem0 -= ne; } else if (rem0 > 0) { sel |= low_bits_keep32(e, rem0); rem0 = 0; } w0[hh] = sel; }
                { const unsigned e = (unsigned)(eq >> 32), g = (unsigned)(gt >> 32); const int ne = __builtin_popcount(e); unsigned sel = g; if (rem1 >= ne) { sel |= e; rem1 -= ne; } else if (rem1 > 0) { sel |= low_bits_keep32(e, rem1); rem1 = 0; } w1[hh] = sel; } }
            const u64 q0w = (u64)w0[0] | ((u64)w0[1] << 32), q1w = (u64)w1[0] | ((u64)w1[1] << 32);
            if (lane == j) mine = q0w; if (lane == 32 + j) mine = q1w; }
    }
    const int jl = lane & 31;
    if (jl < nkb) mrow[(lane >> 5) * 32 + jl] = mine;
}
template <int J0> __device__ __forceinline__ void index_scores8(unsigned (&key)[64], const bf16x8 (&af)[2], const f32x4& iw4, const bf16_t* kvsrc, char* lds, int nkb, u32x4 (&stg)[8], int tid) {
    const int lane = tid & 63, sub = lane & 15, kg = lane >> 4;
#pragma unroll
    for (int jj = 0; jj < 8; ++jj) {
        const int j = J0 + jj;
        if (j < nkb) {
            if (j + 1 < nkb) *(u32x4*)(lds + ((j + 1) & 1) * idx::KBUF + (tid >> 3) * idx::KST + (tid & 7) * 16) = stg[(jj + 1) & 7];
            if (j + 8 < nkb) stg[jj] = *(const u32x4*)(kvsrc + (size_t)(j + 8) * 64 * 64);
            const char* kb = lds + (j & 1) * idx::KBUF + sub * idx::KST + kg * 16;
#pragma unroll
            for (int pr = 0; pr < 2; ++pr) {
                f32x4 dA = (f32x4){0.f, 0.f, 0.f, 0.f}, dB = dA;
#pragma unroll
                for (int ks = 0; ks < 2; ++ks) {
                    const bf16x8 fA = *(const bf16x8*)(kb + (pr * 32) * idx::KST + ks * 64), fB = *(const bf16x8*)(kb + (pr * 32 + 16) * idx::KST + ks * 64);
                    dA = __builtin_amdgcn_mfma_f32_16x16x32_bf16(af[ks], fA, dA, 0, 0, 0); dB = __builtin_amdgcn_mfma_f32_16x16x32_bf16(af[ks], fB, dB, 0, 0, 0); }
                float pA = 0.f, pB = 0.f;
#pragma unroll
                for (int r = 0; r < 4; ++r) { pA += fmaxf(dA[r], 0.f) * iw4[r]; pB += fmaxf(dB[r], 0.f) * iw4[r]; }
                auto rr = __builtin_amdgcn_permlane16_swap(__float_as_uint(pA), __float_as_uint(pB), false, false);
                key[2 * j + pr] = sortable_key(__uint_as_float(rr[0]) + __uint_as_float(rr[1]));
            }
            __syncthreads();
        }
    }
}
__device__ __forceinline__ void ph_index(Frame& F) {
    const bf16_t* IQ = (const bf16_t*)(F.outb + OUT_IQ); const bf16_t* IK = (const bf16_t*)(F.outb + OUT_IK); const float* IW = (const float*)(F.outb + OUT_IW);
    u64* MASK = (u64*)(F.outb + OUT_MASK);
    char* lds = (char*)(unsigned char*)F.lds;
    const int tid = F.tid, lane = F.lane, sub = lane & 15, kg = lane >> 4;
    for (int item = F.bid; item < NTOK / 16; item += F.G) {
        const int tokw = (((item & 255) >> 3) << 11) + (((item & 7) + 8 * (item >> 8)) << 4) + F.wave * 2, b = tokw >> 11, pos0 = tokw & 2047, nkb = (pos0 >> 6) + 1;
        u64* mrow = MASK + (size_t)tokw * 32;
        if (nkb <= 4) { if ((lane & 31) < nkb) mrow[(lane >> 5) * 32 + (lane & 31)] = ~0ull; continue; }
        bf16x8 af[2];
        { const bf16_t* ap = IQ + (size_t)(tokw + (sub >> 3)) * 512 + (sub & 7) * 64 + kg * 8;
#pragma unroll
          for (int ks = 0; ks < 2; ++ks) af[ks] = *(const bf16x8*)(ap + ks * 32); }
        const f32x4 iw4 = *(const f32x4*)(IW + (size_t)(tokw + (lane >> 5)) * 8 + 4 * (kg & 1));
        unsigned key[64];
#pragma unroll
        for (int m = 0; m < 64; ++m) key[m] = 0u;
        const bf16_t* kvsrc = IK + ((size_t)b * SEQ + (tid >> 3)) * 64 + (tid & 7) * 8;
        u32x4 stg[8];
#pragma unroll
        for (int i = 0; i < 8; ++i) stg[i] = (i < nkb) ? *(const u32x4*)(kvsrc + (size_t)i * 64 * 64) : (u32x4){0u, 0u, 0u, 0u};
        __syncthreads();
        *(u32x4*)(lds + (tid >> 3) * idx::KST + (tid & 7) * 16) = stg[0];
        __syncthreads();
        const int ng = (nkb + 7) >> 3;
        index_scores8<0>(key, af, iw4, kvsrc, lds, nkb, stg, tid);
        if (ng > 1) index_scores8<8>(key, af, iw4, kvsrc, lds, nkb, stg, tid);
        if (ng > 2) index_scores8<16>(key, af, iw4, kvsrc, lds, nkb, stg, tid);
        if (ng > 3) index_scores8<24>(key, af, iw4, kvsrc, lds, nkb, stg, tid);
        if (ng == 1) topk2_select_write<1>(key, nkb, mrow, lane);
        else if (ng == 2) topk2_select_write<2>(key, nkb, mrow, lane);
        else if (ng == 3) topk2_select_write<3>(key, nkb, mrow, lane);
        else topk2_select_write<4>(key, nkb, mrow, lane);
    }
}

namespace att {
constexpr int KVBLK = 64;
constexpr int SHM_V = KVBLK * 128 * 2, SHM_K = SHM_V;
constexpr int OFF_V = 0, OFF_K = 2 * SHM_V, OFF_WS = 2 * SHM_V + 2 * SHM_K, OFF_BT = OFF_WS + NWAVES * 64 * 4;
#define KSWZ(row, colB) ((row) * 256 + ((colB) ^ (((row) & 7) << 4)))
__device__ __forceinline__ int crow(int r, int hi) { return (r & 3) + 8 * (r >> 2) + 4 * hi; }
__device__ __forceinline__ int v_st(int k, int c) { const int kk = (k & ~0xC) | ((k & 4) << 1) | ((k & 8) >> 1); return ((kk >> 3) * 4 + (c >> 5)) * 512 + ((kk & 7) * 32 + (c & 31)) * 2; }
__device__ __forceinline__ int v_rd_base(int lane) { return ((lane & 3) << 3) | (((lane >> 2) & 3) << 6) | (((lane >> 4) & 1) << 5) | (((lane >> 5) & 1) << 8); }
constexpr int v_rd_off(int d0, int ks, int half) { return d0 * 512 + ks * 4096 + half * 2048; }
template <int OFF> __device__ __forceinline__ s16x4 tr_read(int vb) { s16x4 r; asm volatile("ds_read_b64_tr_b16 %0, %1 offset:%2" : "=&v"(r) : "v"(vb), "i"(OFF) : "memory"); return r; }
template <int D0> __device__ __forceinline__ void pv_one(f32x16& od, int vb, bf16x8 pa0, bf16x8 pa1, bf16x8 pa2, bf16x8 pa3) {
    const s16x4 l0 = tr_read<v_rd_off(D0, 0, 0)>(vb), h0 = tr_read<v_rd_off(D0, 0, 1)>(vb), l1 = tr_read<v_rd_off(D0, 1, 0)>(vb), h1 = tr_read<v_rd_off(D0, 1, 1)>(vb);
    const s16x4 l2 = tr_read<v_rd_off(D0, 2, 0)>(vb), h2 = tr_read<v_rd_off(D0, 2, 1)>(vb), l3 = tr_read<v_rd_off(D0, 3, 0)>(vb), h3 = tr_read<v_rd_off(D0, 3, 1)>(vb);
    asm volatile("s_waitcnt lgkmcnt(0)" ::: "memory"); SBAR();
#define PK(L, H) (bf16x8){L[0], L[1], L[2], L[3], H[0], H[1], H[2], H[3]}
    od = __builtin_amdgcn_mfma_f32_32x32x16_bf16(pa0, PK(l0, h0), od, 0, 0, 0);
    od = __builtin_amdgcn_mfma_f32_32x32x16_bf16(pa1, PK(l1, h1), od, 0, 0, 0);
    od = __builtin_amdgcn_mfma_f32_32x32x16_bf16(pa2, PK(l2, h2), od, 0, 0, 0);
    od = __builtin_amdgcn_mfma_f32_32x32x16_bf16(pa3, PK(l3, h3), od, 0, 0, 0);
#undef PK
}
__device__ __forceinline__ void qkt(f32x16& p0, f32x16& p1, const char* Ks, const bf16x8* qr, int r32, int hi) {
    p0 = f32x16{}; p1 = f32x16{};
    int rv = r32; asm volatile("" : "+v"(rv));
    const char* kb = Ks + rv * 256; const int swz = ((rv & 7) << 4) ^ (hi * 16);
#pragma unroll
    for (int d0 = 0; d0 < 8; ++d0) { const char* ka = kb + ((d0 * 32) ^ swz);
        const bf16x8 b0 = *reinterpret_cast<const bf16x8*>(ka);
        const bf16x8 b1 = *reinterpret_cast<const bf16x8*>(ka + 8192);
        p0 = __builtin_amdgcn_mfma_f32_32x32x16_bf16(b0, qr[d0], p0, 0, 0, 0);
        p1 = __builtin_amdgcn_mfma_f32_32x32x16_bf16(b1, qr[d0], p1, 0, 0, 0); }
}
__device__ __forceinline__ void attn_item(Frame& F, int b, int q0, char* lds) {
    const bf16_t* Q = (const bf16_t*)(F.ws + WS_Q); const bf16_t* KV = (const bf16_t*)(F.outb + OUT_KV); const u64* MASK = (const u64*)(F.outb + OUT_MASK);
    bf16_t* OA = (bf16_t*)(F.outb + OUT_OA);
    int tid = F.tid; asm volatile("" : "+v"(tid));
    const int wid = F.wave, lane = tid & 63, r32 = lane & 31, hi = lane >> 5;
    char* V_lds = lds + OFF_V; char* K_lds = lds + OFF_K;
    float* wsl = (float*)(lds + OFF_WS) + wid * 64; float* li_l = wsl; float* al_l = wsl + 32;
    const float* btab = (const float*)(lds + OFF_BT);
    constexpr float C = 0.088388347648318440f * LOG2E;
    float m_reg = -1e30f, l_reg = 0.f; f32x16 o[4] = {}; bf16x8 qr[8];
    const size_t tokq = (size_t)b * SEQ + q0 + r32;
    { const bf16_t* Qw = Q + tokq * 1024 + wid * 128 + hi * 8;
#pragma unroll
      for (int d0 = 0; d0 < 8; ++d0) qr[d0] = *(const bf16x8*)(Qw + d0 * 16); }
    const u64* mq = MASK + tokq * 32;
    const int sr = tid >> 4, sc = (tid & 15) * 8;
    const int vb0 = (int)(uintptr_t)V_lds + v_rd_base(lane);
    const bf16_t* Kb = KV + (size_t)b * SEQ * 128;
    const int NT = (q0 >> 6) + 1;
    const float bfar = btab[wid];
    bf16x8 s0, s1;
#define SLOAD(k0) do { s0 = *(const bf16x8*)(Kb + (size_t)((k0) + sr) * 128 + sc); s1 = *(const bf16x8*)(Kb + (size_t)((k0) + 32 + sr) * 128 + sc); } while (0)
#define SWRITE(bf) do { int srv = sr; asm volatile("" : "+v"(srv)); const int kc = sc * 2; const int v0a = v_st(srv, sc), k0a = KSWZ(srv, kc); \
        *(bf16x8*)(V_lds + (bf) * SHM_V + v0a) = s0; *(bf16x8*)(V_lds + (bf) * SHM_V + v0a + 8192) = s1; \
        *(bf16x8*)(K_lds + (bf) * SHM_K + k0a) = s0; *(bf16x8*)(K_lds + (bf) * SHM_K + k0a + 8192) = s1; } while (0)
    __syncthreads();
    SLOAD(0); VM_WAIT(); SWRITE(0); __syncthreads();
    u64 mw_next = mq[0];
    for (int j = 0; j < NT; ++j) {
        int lanel = lane; asm volatile("" : "+v"(lanel)); const int r32l = lanel & 31, hil = lanel >> 5;
        const int bf = j & 1;
        if (j + 1 < NT) SLOAD((j + 1) * KVBLK);
        const u64 mw = mw_next; if (j + 1 < NT) mw_next = mq[j + 1];
        f32x16 p0, p1;
        qkt(p0, p1, K_lds + bf * SHM_K, qr, r32l, hil);
        const unsigned w0 = (unsigned)(mw >> (4 * hil)), w1 = (unsigned)(mw >> (32 + 4 * hil));
        const int relmax = j * KVBLK + 63 - q0;
        float alpha = 1.f, ps = 0.f;
        if (relmax <= -91) {
            float pmax = p0[0];
#pragma unroll
            for (int r = 1; r < 16; ++r) pmax = fmaxf(pmax, p0[r]);
#pragma unroll
            for (int r = 0; r < 16; ++r) pmax = fmaxf(pmax, p1[r]);
            { auto rr = __builtin_amdgcn_permlane32_swap(__float_as_uint(pmax), __float_as_uint(pmax), false, false); pmax = fmaxf(__uint_as_float(rr[0]), __uint_as_float(rr[1])); }
            pmax = fmaf(pmax, C, bfar);
            if (!__all(pmax - m_reg <= 11.0f)) { const float mn = fmaxf(m_reg, pmax); alpha = __builtin_amdgcn_exp2f(m_reg - mn); m_reg = mn; }
            const float off = bfar - m_reg;
#pragma unroll
            for (int r = 0; r < 16; ++r) { const int cb = (r & 3) + 8 * (r >> 2);
                const float e0 = __builtin_amdgcn_exp2f(fmaf(p0[r], C, off)), e1 = __builtin_amdgcn_exp2f(fmaf(p1[r], C, off));
                p0[r] = __uint_as_float(__float_as_uint(e0) & (unsigned)__builtin_amdgcn_sbfe((int)w0, cb, 1)); p1[r] = __uint_as_float(__float_as_uint(e1) & (unsigned)__builtin_amdgcn_sbfe((int)w1, cb, 1)); ps += p0[r] + p1[r]; }
        } else {
            const float* bp = btab + (j * KVBLK + 4 * hil - (q0 + r32l) + 185) * 8 + wid;
#pragma unroll
            for (int r4 = 0; r4 < 4; ++r4) {
#pragma unroll
                for (int rr = 0; rr < 4; ++rr) { const int r = r4 * 4 + rr; const int cb = (r & 3) + 8 * (r >> 2); p0[r] = fmaf(p0[r], C, bp[cb * 8]); p1[r] = fmaf(p1[r], C, bp[(cb + 32) * 8]); }
                SBAR(); }
            float pmax = p0[0];
#pragma unroll
            for (int r = 1; r < 16; ++r) pmax = fmaxf(pmax, p0[r]);
#pragma unroll
            for (int r = 0; r < 16; ++r) pmax = fmaxf(pmax, p1[r]);
            { auto rr = __builtin_amdgcn_permlane32_swap(__float_as_uint(pmax), __float_as_uint(pmax), false, false); pmax = fmaxf(__uint_as_float(rr[0]), __uint_as_float(rr[1])); }
            if (!__all(pmax - m_reg <= 11.0f)) { const float mn = fmaxf(m_reg, pmax); alpha = __builtin_amdgcn_exp2f(m_reg - mn); m_reg = mn; }
#pragma unroll
            for (int r = 0; r < 16; ++r) { const int cb = (r & 3) + 8 * (r >> 2);
                const float e0 = __builtin_amdgcn_exp2f(p0[r] - m_reg), e1 = __builtin_amdgcn_exp2f(p1[r] - m_reg);
                p0[r] = __uint_as_float(__float_as_uint(e0) & (unsigned)__builtin_amdgcn_sbfe((int)w0, cb, 1)); p1[r] = __uint_as_float(__float_as_uint(e1) & (unsigned)__builtin_amdgcn_sbfe((int)w1, cb, 1)); ps += p0[r] + p1[r]; }
        }
        { auto rr = __builtin_amdgcn_permlane32_swap(__float_as_uint(ps), __float_as_uint(ps), false, false); ps = __uint_as_float(rr[0]) + __uint_as_float(rr[1]); }
        l_reg = l_reg * alpha + ps;
        bf16x8 pa0, pa1, pa2, pa3;
#define PK4(P, BASE, OUT) do { unsigned a0 = cvt_pk_bf16(P[BASE + 0], P[BASE + 1]), a1 = cvt_pk_bf16(P[BASE + 2], P[BASE + 3]);   \
    unsigned b0 = cvt_pk_bf16(P[BASE + 4], P[BASE + 5]), b1 = cvt_pk_bf16(P[BASE + 6], P[BASE + 7]);                              \
    auto r0 = __builtin_amdgcn_permlane32_swap(a0, b0, false, false); auto r1 = __builtin_amdgcn_permlane32_swap(a1, b1, false, false); \
    u32x4 w = {r0[0], r1[0], r0[1], r1[1]}; OUT = *reinterpret_cast<bf16x8*>(&w); } while (0)
        PK4(p0, 0, pa0); PK4(p0, 8, pa1); PK4(p1, 0, pa2); PK4(p1, 8, pa3);
#undef PK4
        if (__any(alpha < 1.f)) { if (hil == 0) al_l[r32l] = alpha; LDS_WAIT();
#pragma unroll
            for (int d = 0; d < 4; ++d)
#pragma unroll
                for (int r = 0; r < 16; ++r) o[d][r] *= al_l[crow(r, hil)]; }
        const int vb = (int)(uintptr_t)V_lds + v_rd_base(lanel) + bf * SHM_V;
        pv_one<0>(o[0], vb, pa0, pa1, pa2, pa3); pv_one<1>(o[1], vb, pa0, pa1, pa2, pa3); pv_one<2>(o[2], vb, pa0, pa1, pa2, pa3); pv_one<3>(o[3], vb, pa0, pa1, pa2, pa3);
        if (j + 1 < NT) { VM_WAIT(); SWRITE(bf ^ 1); }
        __syncthreads();
    }
#undef SLOAD
#undef SWRITE
    if (hi == 0) li_l[r32] = l_reg; LDS_WAIT();
    bf16_t* Ow = OA + ((size_t)b * SEQ + q0 + 4 * hi) * 1024 + wid * 128 + r32;
    const float* lip = li_l + 4 * hi;
    unsigned char* Ow8 = (unsigned char*)OA + ((size_t)b * SEQ + q0 + 4 * hi) * 1024 + wid * 128 + r32;
    asm volatile("" : "+v"(Ow), "+v"(lip), "+v"(Ow8));
#pragma unroll
    for (int r = 0; r < 16; ++r) { const int ro = (r & 3) + 8 * (r >> 2); if ((r & 3) == 0) asm volatile("" : "+v"(Ow), "+v"(Ow8), "+v"(lip)); const float rl = fast_rcp(lip[ro]);
#pragma unroll
        for (int d0 = 0; d0 < 4; ++d0) { float v = o[d0][r] * rl; if ((DBG_ATTN_ZERO == 1 && q0 < 256) || (DBG_ATTN_ZERO == 2 && q0 >= 256)) v = 0.f;
            if (PA_FP8) ((unsigned char*)Ow8)[ro * 1024 + d0 * 32] = (unsigned char)(__builtin_amdgcn_cvt_pk_fp8_f32(v, v, 0, false) & 0xff);
            else Ow[ro * 1024 + d0 * 32] = (bf16_t)(cvt_pk_bf16(v, v) & 0xffffu); }
        if ((r & 3) == 3) SBAR(); }
}
__device__ __forceinline__ void att2_partial(f32x16& p0, f32x16& p1, float& m_reg, float& alpha, unsigned w0, bool far, float bfar, const float* bp) {
    constexpr float C = 0.088388347648318440f * LOG2E;
    float off;
    if (far) {
        float pmax = p0[0];
#pragma unroll
        for (int r = 1; r < 16; ++r) pmax = fmaxf(pmax, p0[r]);
#pragma unroll
        for (int r = 0; r < 16; ++r) pmax = fmaxf(pmax, p1[r]);
        { auto rr = __builtin_amdgcn_permlane32_swap(__float_as_uint(pmax), __float_as_uint(pmax), false, false); pmax = fmaxf(__uint_as_float(rr[0]), __uint_as_float(rr[1])); }
        pmax = fmaf(pmax, C, bfar);
        if (__builtin_expect(__all(pmax - m_reg <= 11.0f), 1)) alpha = 1.f; else { const float mn = fmaxf(m_reg, pmax); alpha = __builtin_amdgcn_exp2f(m_reg - mn); m_reg = mn; }
        off = bfar - m_reg;
#pragma unroll
        for (int r = 0; r < 16; ++r) { p0[r] = fmaf(p0[r], C, off); p1[r] = fmaf(p1[r], C, off); }
    } else {
#pragma unroll
        for (int r4 = 0; r4 < 4; ++r4) {
#pragma unroll
            for (int rr = 0; rr < 4; ++rr) { const int r = r4 * 4 + rr; const int cb = (r & 3) + 8 * (r >> 2); p0[r] = fmaf(p0[r], C, bp[cb * 8]); p1[r] = fmaf(p1[r], C, bp[(cb + 32) * 8]); }
            SBAR(); }
        float pmax = p0[0];
#pragma unroll
        for (int r = 1; r < 16; ++r) pmax = fmaxf(pmax, p0[r]);
#pragma unroll
        for (int r = 0; r < 16; ++r) pmax = fmaxf(pmax, p1[r]);
        { auto rr = __builtin_amdgcn_permlane32_swap(__float_as_uint(pmax), __float_as_uint(pmax), false, false); pmax = fmaxf(__uint_as_float(rr[0]), __uint_as_float(rr[1])); }
        if (__builtin_expect(__all(pmax - m_reg <= 11.0f), 1)) alpha = 1.f; else { const float mn = fmaxf(m_reg, pmax); alpha = __builtin_amdgcn_exp2f(m_reg - mn); m_reg = mn; }
#pragma unroll
        for (int r = 0; r < 16; ++r) { p0[r] -= m_reg; p1[r] -= m_reg; }
    }
#pragma unroll
    for (int r = 0; r < 16; ++r) { const int cb = (r & 3) + 8 * (r >> 2); p0[r] = __uint_as_float(__float_as_uint(__builtin_amdgcn_exp2f(p0[r])) & (unsigned)__builtin_amdgcn_sbfe((int)w0, cb, 1)); }
}
__device__ __forceinline__ void att2_finish(f32x16& p0, f32x16& p1, float alpha, float& l_reg, unsigned w1, bf16x8& pa0, bf16x8& pa1, bf16x8& pa2, bf16x8& pa3) {
#pragma unroll
    for (int r = 0; r < 16; ++r) { const int cb = (r & 3) + 8 * (r >> 2); p1[r] = __uint_as_float(__float_as_uint(__builtin_amdgcn_exp2f(p1[r])) & (unsigned)__builtin_amdgcn_sbfe((int)w1, cb, 1)); }
    float ps = 0.f;
#pragma unroll
    for (int r = 0; r < 16; ++r) ps += p0[r];
#pragma unroll
    for (int r = 0; r < 16; ++r) ps += p1[r];
    { auto rr = __builtin_amdgcn_permlane32_swap(__float_as_uint(ps), __float_as_uint(ps), false, false); ps = __uint_as_float(rr[0]) + __uint_as_float(rr[1]); }
    l_reg = l_reg * alpha + ps;
#define PK4(P, BASE, OUT) do { unsigned a0 = cvt_pk_bf16(P[BASE + 0], P[BASE + 1]), a1 = cvt_pk_bf16(P[BASE + 2], P[BASE + 3]);   \
    unsigned b0 = cvt_pk_bf16(P[BASE + 4], P[BASE + 5]), b1 = cvt_pk_bf16(P[BASE + 6], P[BASE + 7]);                              \
    auto r0 = __builtin_amdgcn_permlane32_swap(a0, b0, false, false); auto r1 = __builtin_amdgcn_permlane32_swap(a1, b1, false, false); \
    u32x4 w = {r0[0], r1[0], r0[1], r1[1]}; OUT = *reinterpret_cast<bf16x8*>(&w); } while (0)
    PK4(p0, 0, pa0); PK4(p0, 8, pa1); PK4(p1, 0, pa2); PK4(p1, 8, pa3);
#undef PK4
}
__device__ __forceinline__ void attn_item2(Frame& F, int b, int q0, char* lds) {
    const bf16_t* Q = (const bf16_t*)(F.ws + WS_Q); const bf16_t* KV = (const bf16_t*)(F.outb + OUT_KV); const u64* MASK = (const u64*)(F.outb + OUT_MASK);
    bf16_t* OA = (bf16_t*)(F.outb + OUT_OA);
    int tid = F.tid; asm volatile("" : "+v"(tid));
    const int wid = F.wave, lane = tid & 63, r32 = lane & 31, hi = lane >> 5;
    char* V_lds = lds + OFF_V; char* K_lds = lds + OFF_K;
    float* wsl = (float*)(lds + OFF_WS) + wid * 64; float* li_l = wsl; float* al_l = wsl + 32;
    const float* btab = (const float*)(lds + OFF_BT);
    float m_reg = -1e30f, l_reg = 0.f; f32x16 o[4] = {}; bf16x8 qr[8];
    const size_t tokq = (size_t)b * SEQ + q0 + r32;
    { const bf16_t* Qw = Q + tokq * 1024 + wid * 128 + hi * 8;
#pragma unroll
      for (int d0 = 0; d0 < 8; ++d0) qr[d0] = *(const bf16x8*)(Qw + d0 * 16); }
    const u64* mq = MASK + tokq * 32;
    const int sr = tid >> 4, sc = (tid & 15) * 8;
    const bf16_t* Kb = KV + (size_t)b * SEQ * 128;
    const int NTr = (q0 >> 6) + 1, NT = (NTr + 1) & ~1;
    const float bfar = btab[wid];
    bf16x8 sA0, sA1, sB0, sB1;
#define SLD(s0_, s1_, k0) do { int srl = sr; asm volatile("" : "+v"(srl)); const bf16_t* kp_ = Kb + (size_t)((k0) + srl) * 128 + sc; s0_ = *(const bf16x8*)kp_; s1_ = *(const bf16x8*)(kp_ + 32 * 128); } while (0)
#define SWR(bf, s0_, s1_) do { int srv = sr; asm volatile("" : "+v"(srv)); const int kc = sc * 2; const int v0a = v_st(srv, sc), k0a = KSWZ(srv, kc); \
        *(bf16x8*)(V_lds + (bf) * SHM_V + v0a) = s0_; *(bf16x8*)(V_lds + (bf) * SHM_V + v0a + 8192) = s1_; \
        *(bf16x8*)(K_lds + (bf) * SHM_K + k0a) = s0_; *(bf16x8*)(K_lds + (bf) * SHM_K + k0a + 8192) = s1_; } while (0)
#define MWORD(j) ((j) < NTr ? mq[j] : 0ull)
#define RESC(a) do { if (__any((a) < 1.f)) { if (hi == 0) al_l[r32] = (a); LDS_WAIT(); \
        _Pragma("unroll") for (int d = 0; d < 4; ++d) _Pragma("unroll") for (int r = 0; r < 16; ++r) o[d][r] *= al_l[crow(r, hi)]; } } while (0)
#define PVALL(bf) do { int ll = lane; asm volatile("" : "+v"(ll)); const int vb = (int)(uintptr_t)V_lds + v_rd_base(ll) + (bf) * SHM_V; \
        pv_one<0>(o[0], vb, pa0, pa1, pa2, pa3); pv_one<1>(o[1], vb, pa0, pa1, pa2, pa3); pv_one<2>(o[2], vb, pa0, pa1, pa2, pa3); pv_one<3>(o[3], vb, pa0, pa1, pa2, pa3); } while (0)
#define ISFAR(jt) ((jt) * KVBLK + 63 - q0 <= -91 || (jt) >= NTr)
#define BPTR(jt) (btab + ((jt) * KVBLK + 4 * hi - (q0 + r32) + 185) * 8 + wid)
    f32x16 pA0, pA1, pB0, pB1; float alA, alB; bf16x8 pa0, pa1, pa2, pa3; u64 mwA, mwB;
    __syncthreads();
    SLD(sA0, sA1, 0); mwA = MWORD(0); VM_WAIT(); SWR(0, sA0, sA1); __syncthreads();
    qkt(pA0, pA1, K_lds, qr, r32, hi);
    att2_partial(pA0, pA1, m_reg, alA, (unsigned)(mwA >> (4 * hi)), ISFAR(0), bfar, BPTR(0));
    SLD(sB0, sB1, KVBLK); mwB = MWORD(1); if (2 < NT) SLD(sA0, sA1, 2 * KVBLK);
    SWR(1, sB0, sB1); __syncthreads();
    for (int j = 1; j + 1 < NT; j += 2) {
        SBAR(); qkt(pB0, pB1, K_lds + SHM_K, qr, r32, hi);
        att2_finish(pA0, pA1, alA, l_reg, (unsigned)(mwA >> (32 + 4 * hi)), pa0, pa1, pa2, pa3); SBAR();
        SLD(sB0, sB1, (j + 2) * KVBLK); mwA = MWORD(j + 1); SBAR();
        PVALL(0);
        att2_partial(pB0, pB1, m_reg, alB, (unsigned)(mwB >> (4 * hi)), ISFAR(j), bfar, BPTR(j));
        __syncthreads(); SWR(0, sA0, sA1);
        RESC(alB); __syncthreads();
        SBAR(); qkt(pA0, pA1, K_lds, qr, r32, hi);
        att2_finish(pB0, pB1, alB, l_reg, (unsigned)(mwB >> (32 + 4 * hi)), pa0, pa1, pa2, pa3); SBAR();
        if (j + 3 < NT) SLD(sA0, sA1, (j + 3) * KVBLK); mwB = MWORD(j + 2); SBAR();
        PVALL(1);
        att2_partial(pA0, pA1, m_reg, alA, (unsigned)(mwA >> (4 * hi)), ISFAR(j + 1), bfar, BPTR(j + 1));
        __syncthreads(); SWR(1, sB0, sB1);
        RESC(alA); __syncthreads();
    }
    SBAR(); qkt(pB0, pB1, K_lds + SHM_K, qr, r32, hi);
    att2_finish(pA0, pA1, alA, l_reg, (unsigned)(mwA >> (32 + 4 * hi)), pa0, pa1, pa2, pa3); SBAR();
    PVALL(0);
    att2_partial(pB0, pB1, m_reg, alB, (unsigned)(mwB >> (4 * hi)), ISFAR(NT - 1), bfar, BPTR(NT - 1));
    __syncthreads(); RESC(alB);
    att2_finish(pB0, pB1, alB, l_reg, (unsigned)(mwB >> (32 + 4 * hi)), pa0, pa1, pa2, pa3); SBAR();
    PVALL(1);
#undef SLD
#undef SWR
#undef MWORD
#undef RESC
#undef PVALL
#undef ISFAR
#undef BPTR
    if (hi == 0) li_l[r32] = l_reg; LDS_WAIT();
    bf16_t* Ow = OA + ((size_t)b * SEQ + q0 + 4 * hi) * 1024 + wid * 128 + r32;
    const float* lip = li_l + 4 * hi;
    unsigned char* Ow8 = (unsigned char*)OA + ((size_t)b * SEQ + q0 + 4 * hi) * 1024 + wid * 128 + r32;
    asm volatile("" : "+v"(Ow), "+v"(lip), "+v"(Ow8));
#pragma unroll
    for (int r = 0; r < 16; ++r) { const int ro = (r & 3) + 8 * (r >> 2); if ((r & 3) == 0) asm volatile("" : "+v"(Ow), "+v"(Ow8), "+v"(lip)); const float rl = fast_rcp(lip[ro]);
#pragma unroll
        for (int d0 = 0; d0 < 4; ++d0) { float v = o[d0][r] * rl;
            if (PA_FP8) ((unsigned char*)Ow8)[ro * 1024 + d0 * 32] = (unsigned char)(__builtin_amdgcn_cvt_pk_fp8_f32(v, v, 0, false) & 0xff);
            else Ow[ro * 1024 + d0 * 32] = (bf16_t)(cvt_pk_bf16(v, v) & 0xffffu); }
        if ((r & 3) == 3) SBAR(); }
}
}
__device__ __forceinline__ void ph_attn(Frame& F) {
    char* lds = (char*)(unsigned char*)F.lds;
    { float* bt = (float*)(lds + att::OFF_BT); const float* BT = (const float*)(F.ws + WS_BIAST); __syncthreads(); for (int i = F.tid; i < 249 * 8; i += NTHR) bt[i] = BT[i]; __syncthreads(); }
    for (int pr = F.bid; pr < NB * 32; pr += F.G) {
        const int b = pr >> 5, qb = pr & 31;
#pragma nounroll
        for (int hh = 0; hh < 2; ++hh) { if (ATT2) att::attn_item2(F, b, (hh ? qb : 63 - qb) * 32, lds); else att::attn_item(F, b, (hh ? qb : 63 - qb) * 32, lds); }
    }
}

namespace ssd {
constexpr int OFF_CS = 0, CS_ST = 272;
constexpr int OFF_BS = OFF_CS + 64 * CS_ST;
constexpr int OFF_BT = OFF_BS + 64 * CS_ST, T_ST = 144;
constexpr int OFF_XT = OFF_BT + 128 * T_ST;
constexpr int OFF_XW = OFF_XT + 64 * T_ST;
constexpr int OFF_XS = OFF_XW + 64 * T_ST;
constexpr int OFF_MT = OFF_XS + 64 * T_ST;
constexpr int OFF_HS = OFF_MT + 64 * T_ST;
constexpr int OFF_END = OFF_HS + 64 * CS_ST;
static_assert(OFF_END + 5 * 320 * 4 <= 131072, "ssd lds");
__device__ __forceinline__ f32x4 mfma16(bf16x8 a, bf16x8 b, f32x4 c) { return __builtin_amdgcn_mfma_f32_16x16x32_bf16(a, b, c, 0, 0, 0); }
__device__ __forceinline__ bf16x8 ldfrag(const char* base, int stride, int row, int k0) { return *(const bf16x8*)(base + row * stride + k0 * 2); }
}
__device__ __forceinline__ void ph_ssd(Frame& F) {
    using namespace ssd;
    char* lds = (char*)(unsigned char*)F.lds;
    const bf16_t* XBC = (const bf16_t*)(F.ws + WS_XBC); const bf16_t* ZS = (const bf16_t*)(F.ws + WS_Z); const float* DT = (const float*)(F.outb + OUT_DT);
    bf16_t* YG = (bf16_t*)(F.ws + WS_Q);
    const float* conv_w = F.a->in[9]; const float* conv_b = F.a->in[10]; const float* a_log = F.a->in[12]; const float* d_skip = F.a->in[13];
    const int tid = F.tid, wid = F.wave, lane = F.lane, fr = lane & 15, fq = lane >> 4;
    const bool stager = tid < 320; const int so = tid % 40, tg = tid / 40;
    for (int item = F.bid; item < NB * 16; item += F.G) {
        const int b = item >> 4, h = item & 15, g = h >> 2;
        const float aneg = -__expf(a_log[h]), dsk = d_skip[h];
        const int ch0 = so < 8 ? h * 64 + so * 8 : (so < 24 ? 1024 + g * 128 + (so - 8) * 8 : 1536 + g * 128 + (so - 24) * 8);
        float* CWL = (float*)(lds + OFF_END);
        __syncthreads();
        if (stager) {
#pragma unroll
            for (int j = 0; j < 4; ++j) { *(f32x4*)(CWL + j * 320 + so * 8) = *(const f32x4*)(conv_w + (size_t)j * 2048 + ch0); *(f32x4*)(CWL + j * 320 + so * 8 + 4) = *(const f32x4*)(conv_w + (size_t)j * 2048 + ch0 + 4); }
            *(f32x4*)(CWL + 4 * 320 + so * 8) = *(const f32x4*)(conv_b + ch0); *(f32x4*)(CWL + 4 * 320 + so * 8 + 4) = *(const f32x4*)(conv_b + ch0 + 4);
        }
        f32x4 hst[4];
#pragma unroll
        for (int t = 0; t < 4; ++t) hst[t] = (f32x4){0.f, 0.f, 0.f, 0.f};
        __syncthreads();
        for (int i = tid; i < 64 * CS_ST / 4; i += NTHR) ((unsigned*)(lds + OFF_HS))[i] = 0u;
        u32x4 raw[11];
        const size_t tokb = (size_t)b * SEQ;
#define SSD_LOAD(c) do { if (stager) { _Pragma("unroll") for (int i = 0; i < 11; ++i) { const int t = (c) * 64 + tg * 8 - 3 + i; \
            raw[i] = (t >= 0) ? *(const u32x4*)(XBC + (tokb + t) * 2048 + ch0) : (u32x4){0u, 0u, 0u, 0u}; } } } while (0)
        SSD_LOAD(0);
        float dtl_next = DT[(tokb + lane) * 16 + h];
        for (int c = 0; c < 32; ++c) {
            const float dtl = dtl_next; if (c + 1 < 32) dtl_next = DT[(tokb + (c + 1) * 64 + lane) * 16 + h];
            u32x2 zpre[2];
#pragma unroll
            for (int t2 = 0; t2 < 2; ++t2) { const int tile = 2 * wid + t2, pb = tile >> 2, lb = tile & 3; zpre[t2] = *(const u32x2*)(ZS + (tokb + c * 64 + lb * 16 + fr) * 1024 + h * 64 + pb * 16 + 4 * fq); }
            float acs = dtl * aneg;
#pragma unroll
            for (int o = 1; o < 64; o <<= 1) { const float t = __shfl_up(acs, o); if (lane >= o) acs += t; }
            const float alast = __shfl(acs, 63);
            if (DBG_SSD_SYNC) __syncthreads();
            float dtv[8], dec[8];
#pragma unroll
            for (int t = 0; t < 8; ++t) { dtv[t] = __shfl(dtl, (tg * 8 + t) & 63); dec[t] = __expf(alast - __shfl(acs, (tg * 8 + t) & 63)); }
            if (stager) {
#pragma unroll
                for (int hq = 0; hq < 2; ++hq) {
                    float xin[11][4];
#pragma unroll
                    for (int i = 0; i < 11; ++i) { const unsigned wa = hq ? raw[i].z : raw[i].x, wb = hq ? raw[i].w : raw[i].y; xin[i][0] = bflo(wa); xin[i][1] = bfhi(wa); xin[i][2] = bflo(wb); xin[i][3] = bfhi(wb); }
                    float outv[8][4];
                    { f32x4 cwv[4]; const f32x4 cbq = *(const f32x4*)(CWL + 4 * 320 + so * 8 + hq * 4);
#pragma unroll
                      for (int j = 0; j < 4; ++j) cwv[j] = *(const f32x4*)(CWL + j * 320 + so * 8 + hq * 4);
#pragma unroll
                      for (int t = 0; t < 8; ++t)
#pragma unroll
                        for (int e = 0; e < 4; ++e) { float sacc = cbq[e];
#pragma unroll
                            for (int j = 0; j < 4; ++j) sacc += cwv[j][e] * xin[t + j][e];
                            outv[t][e] = silu_f(sacc); } }
                    if (so < 8) {
#pragma unroll
                        for (int e = 0; e < 4; ++e) { const int p = so * 8 + hq * 4 + e;
                            f32x4 x0, x1, d0, d1, w0, w1;
#pragma unroll
                            for (int t = 0; t < 4; ++t) { x0[t] = outv[t][e]; x1[t] = outv[4 + t][e]; d0[t] = x0[t] * dtv[t]; d1[t] = x1[t] * dtv[4 + t]; w0[t] = d0[t] * dec[t]; w1[t] = d1[t] * dec[4 + t]; }
                            *(u32x4*)(lds + OFF_XS + p * T_ST + tg * 16) = pack8(x0, x1);
                            *(u32x4*)(lds + OFF_XT + p * T_ST + tg * 16) = pack8(d0, d1);
                            *(u32x4*)(lds + OFF_XW + p * T_ST + tg * 16) = pack8(w0, w1); }
                    } else {
                        const bool isB = so < 24; const int n0 = (isB ? (so - 8) : (so - 24)) * 8 + hq * 4;
                        char* nat = lds + (isB ? OFF_BS : OFF_CS);
#pragma unroll
                        for (int t = 0; t < 8; ++t) { u32x2 w; w.x = cvt_pk_bf16(outv[t][0], outv[t][1]); w.y = cvt_pk_bf16(outv[t][2], outv[t][3]);
                            *(u32x2*)(nat + (tg * 8 + t) * CS_ST + n0 * 2) = w; }
                        if (isB) {
#pragma unroll
                            for (int e = 0; e < 4; ++e) { f32x4 a, bq;
#pragma unroll
                                for (int t = 0; t < 4; ++t) { a[t] = outv[t][e]; bq[t] = outv[4 + t][e]; }
                                *(u32x4*)(lds + OFF_BT + (n0 + e) * T_ST + tg * 16) = pack8(a, bq); }
                        }
                    }
                }
            }
            if (c + 1 < 32) SSD_LOAD(c + 1);
            __syncthreads();
#pragma unroll
            for (int t2 = 0; t2 < 2; ++t2) {
                const int tile = 2 * wid + t2, sb = tile >> 2, lb = tile & 3;
                f32x4 d = (f32x4){0.f, 0.f, 0.f, 0.f};
                if (sb <= lb) {
#pragma unroll
                    for (int ks = 0; ks < 4; ++ks) d = mfma16(ldfrag(lds + OFF_BS, CS_ST, sb * 16 + fr, ks * 32 + fq * 8), ldfrag(lds + OFF_CS, CS_ST, lb * 16 + fr, ks * 32 + fq * 8), d);
                    const int l = lb * 16 + fr; const float al = __shfl(acs, l);
                    f32x4 as;
#pragma unroll
                    for (int r = 0; r < 4; ++r) as[r] = __shfl(acs, sb * 16 + 4 * fq + r);
#pragma unroll
                    for (int r = 0; r < 4; ++r) { const int s = sb * 16 + 4 * fq + r; d[r] = (s <= l) ? d[r] * __expf(al - as[r]) : 0.f; }
                }
                u32x2 w; w.x = cvt_pk_bf16(d[0], d[1]); w.y = cvt_pk_bf16(d[2], d[3]);
                *(u32x2*)(lds + OFF_MT + (lb * 16 + fr) * T_ST + (sb * 16 + 4 * fq) * 2) = w;
            }
            if (DBG_SSD_SYNC) __syncthreads();
            f32x4 yacc[2];
#pragma unroll
            for (int t2 = 0; t2 < 2; ++t2) {
                const int tile = 2 * wid + t2, pb = tile >> 2, lb = tile & 3;
                f32x4 d = (f32x4){0.f, 0.f, 0.f, 0.f};
#pragma unroll
                for (int ks = 0; ks < 4; ++ks) d = mfma16(ldfrag(lds + OFF_HS, CS_ST, pb * 16 + fr, ks * 32 + fq * 8), ldfrag(lds + OFF_CS, CS_ST, lb * 16 + fr, ks * 32 + fq * 8), d);
                const float el = __expf(__shfl(acs, lb * 16 + fr));
                yacc[t2] = d * el;
            }
            __syncthreads();
#pragma unroll
            for (int t2 = 0; t2 < 2; ++t2) {
                const int tile = 2 * wid + t2, pb = tile >> 2, lb = tile & 3;
                f32x4 d = yacc[t2];
#pragma unroll
                for (int ks = 0; ks < 2; ++ks) d = mfma16(ldfrag(lds + OFF_XT, T_ST, pb * 16 + fr, ks * 32 + fq * 8), ldfrag(lds + OFF_MT, T_ST, lb * 16 + fr, ks * 32 + fq * 8), d);
                const int l = lb * 16 + fr, p0 = pb * 16 + 4 * fq; const size_t tok = tokb + c * 64 + l;
                const u32x2 zz = zpre[t2];
                const float z0 = bflo(zz.x), z1 = bfhi(zz.x), z2 = bflo(zz.y), z3 = bfhi(zz.y);
                float xs[4];
#pragma unroll
                for (int r = 0; r < 4; ++r) xs[r] = bflo((unsigned)*(const bf16_t*)(lds + OFF_XS + (p0 + r) * T_ST + l * 2));
                u32x2 w; w.x = cvt_pk_bf16((d[0] + xs[0] * dsk) * z0, (d[1] + xs[1] * dsk) * z1); w.y = cvt_pk_bf16((d[2] + xs[2] * dsk) * z2, (d[3] + xs[3] * dsk) * z3);
                *(u32x2*)(YG + tok * 1024 + h * 64 + p0) = w;
            }
            if (DBG_SSD_SYNC) __syncthreads();
            { const float dc = __expf(alast);
#pragma unroll
              for (int t = 0; t < 4; ++t) { f32x4 d = hst[t] * dc;
#pragma unroll
                  for (int ks = 0; ks < 2; ++ks) d = mfma16(ldfrag(lds + OFF_BT, T_ST, wid * 16 + fr, ks * 32 + fq * 8), ldfrag(lds + OFF_XW, T_ST, t * 16 + fr, ks * 32 + fq * 8), d);
                  hst[t] = d;
                  u32x2 w; w.x = cvt_pk_bf16(d[0], d[1]); w.y = cvt_pk_bf16(d[2], d[3]);
                  *(u32x2*)(lds + OFF_HS + (t * 16 + fr) * CS_ST + (wid * 16 + 4 * fq) * 2) = w; } }
            __syncthreads();
        }
#undef SSD_LOAD
    }
}

namespace ssd2 {
constexpr int CS_ST = 272, T_ST = 144;
constexpr int OFF_CS = 0, OFF_BS = 64 * CS_ST, OFF_BT = 2 * 64 * CS_ST, OFF_H0 = OFF_BT + 128 * T_ST;
constexpr int H_XS = 0, H_XW = 64 * T_ST, H_MT = 2 * 64 * T_ST, H_HS = 3 * 64 * T_ST, H_SZ = H_HS + 64 * CS_ST;
constexpr int OFF_CW = OFF_H0 + 2 * H_SZ;
static_assert(OFF_CW + 5 * 384 * 4 <= LDS_MISC, "ssd2 lds");
}
__device__ __forceinline__ void ph_ssd2(Frame& F) {
    using namespace ssd2; using ssd::mfma16; using ssd::ldfrag;
    char* lds = (char*)(unsigned char*)F.lds;
    const bf16_t* XBC = (const bf16_t*)(F.ws + WS_XBC); const bf16_t* ZS = (const bf16_t*)(F.ws + WS_Z); const float* DT = (const float*)(F.outb + OUT_DT);
    bf16_t* YG = (bf16_t*)(F.ws + WS_Q);
    const float* conv_w = F.a->in[9]; const float* conv_b = F.a->in[10]; const float* a_log = F.a->in[12]; const float* d_skip = F.a->in[13];
    const int tid = F.tid, wid = F.wave, lane = F.lane, fr = lane & 15, fq = lane >> 4;
    const bool stager = tid < 384; const int so = tid % 48, tg = tid / 48, shd = (so >> 3) & 1;
    for (int item = F.bid; item < NB * 8; item += F.G) {
        const int b = item >> 3, g = (item >> 1) & 3, h0 = g * 4 + (item & 1) * 2;
        const float aneg0 = -__expf(a_log[h0]), aneg1 = -__expf(a_log[h0 + 1]), dsk0 = d_skip[h0], dsk1 = d_skip[h0 + 1];
        const int ch0 = so < 16 ? (h0 + shd) * 64 + (so & 7) * 8 : (so < 32 ? 1024 + g * 128 + (so - 16) * 8 : 1536 + g * 128 + (so - 32) * 8);
        float* CWL = (float*)(lds + OFF_CW);
        __syncthreads();
        if (stager) {
#pragma unroll
            for (int j = 0; j < 4; ++j) { *(f32x4*)(CWL + j * 384 + so * 8) = *(const f32x4*)(conv_w + (size_t)j * 2048 + ch0); *(f32x4*)(CWL + j * 384 + so * 8 + 4) = *(const f32x4*)(conv_w + (size_t)j * 2048 + ch0 + 4); }
            *(f32x4*)(CWL + 4 * 384 + so * 8) = *(const f32x4*)(conv_b + ch0); *(f32x4*)(CWL + 4 * 384 + so * 8 + 4) = *(const f32x4*)(conv_b + ch0 + 4);
        }
        f32x4 hst[2][4];
#pragma unroll
        for (int hh = 0; hh < 2; ++hh)
#pragma unroll
            for (int t = 0; t < 4; ++t) hst[hh][t] = (f32x4){0.f, 0.f, 0.f, 0.f};
        for (int i = tid; i < 64 * CS_ST / 4; i += NTHR) { ((unsigned*)(lds + OFF_H0 + H_HS))[i] = 0u; ((unsigned*)(lds + OFF_H0 + H_SZ + H_HS))[i] = 0u; }
        u32x4 raw[11];
        const size_t tokb = (size_t)b * SEQ;
        const bf16_t* xrow = XBC + ((ptrdiff_t)tokb + tg * 8 - 3) * 2048 + ch0;
#define SSD_LOAD(c, xp, tgx) do { if (stager) { _Pragma("unroll") for (int i = 0; i < 11; ++i) { const int t = (c) * 64 + (tgx) * 8 - 3 + i; \
            raw[i] = (t >= 0) ? *(const u32x4*)((xp) + (ptrdiff_t)((c) * 64 + i) * 2048) : (u32x4){0u, 0u, 0u, 0u}; } } } while (0)
        SSD_LOAD(0, xrow, tg);
        f32x2 dtn = *(const f32x2*)(DT + (tokb + lane) * 16 + h0);
        for (int c = 0; c < 32; ++c) {
            int frl = fr, fql = fq, tgl = tg, sol = so; const bf16_t* xrl = xrow; asm volatile("" : "+v"(frl), "+v"(fql), "+v"(tgl), "+v"(sol), "+v"(xrl)); const int shdl = (sol >> 3) & 1;
            const float dtl0 = dtn[0], dtl1 = dtn[1]; if (c + 1 < 32) dtn = *(const f32x2*)(DT + (tokb + (c + 1) * 64 + lane) * 16 + h0);
            u32x2 zpre[2][2];
#pragma unroll
            for (int hh = 0; hh < 2; ++hh)
#pragma unroll
                for (int t2 = 0; t2 < 2; ++t2) { const int tile = 2 * wid + t2, pb = tile >> 2, lb = tile & 3; zpre[hh][t2] = *(const u32x2*)(ZS + (tokb + c * 64 + lb * 16 + frl) * 1024 + (h0 + hh) * 64 + pb * 16 + 4 * fql); }
            float acs0 = dtl0 * aneg0, acs1 = dtl1 * aneg1;
#pragma unroll
            for (int o = 1; o < 64; o <<= 1) { const float t0 = __shfl_up(acs0, o), t1 = __shfl_up(acs1, o); if (lane >= o) { acs0 += t0; acs1 += t1; } }
            const float alast0 = __shfl(acs0, 63), alast1 = __shfl(acs1, 63);
            float wdt[8];
#pragma unroll
            for (int t = 0; t < 8; ++t) { const int sl = (tgl * 8 + t) & 63; const float d0 = __shfl(dtl0, sl), d1 = __shfl(dtl1, sl), a0 = __shfl(acs0, sl), a1 = __shfl(acs1, sl);
                wdt[t] = (shdl ? d1 : d0) * __expf(shdl ? alast1 - a1 : alast0 - a0); }
            if (stager) {
#pragma unroll
                for (int cp = 0; cp < 4; ++cp) {
                    float xin[11][2];
#pragma unroll
                    for (int i = 0; i < 11; ++i) { const unsigned wa = cp == 0 ? raw[i].x : (cp == 1 ? raw[i].y : (cp == 2 ? raw[i].z : raw[i].w)); xin[i][0] = bflo(wa); xin[i][1] = bfhi(wa); }
                    float outv[8][2];
                    { f32x2 cwv[4]; const f32x2 cbq = *(const f32x2*)(CWL + 4 * 384 + sol * 8 + cp * 2);
#pragma unroll
                      for (int j = 0; j < 4; ++j) cwv[j] = *(const f32x2*)(CWL + j * 384 + sol * 8 + cp * 2);
#pragma unroll
                      for (int t = 0; t < 8; ++t)
#pragma unroll
                        for (int e = 0; e < 2; ++e) { float sacc = cbq[e];
#pragma unroll
                            for (int j = 0; j < 4; ++j) sacc += cwv[j][e] * xin[t + j][e];
                            outv[t][e] = silu_f(sacc); } }
                    if (sol < 16) {
                        char* hb = lds + OFF_H0 + shdl * H_SZ;
#pragma unroll
                        for (int e = 0; e < 2; ++e) { const int p = (sol & 7) * 8 + cp * 2 + e;
                            f32x4 x0, x1, w0, w1;
#pragma unroll
                            for (int t = 0; t < 4; ++t) { x0[t] = outv[t][e]; x1[t] = outv[4 + t][e]; w0[t] = x0[t] * wdt[t]; w1[t] = x1[t] * wdt[4 + t]; }
                            *(u32x4*)(hb + H_XS + p * T_ST + tgl * 16) = pack8(x0, x1);
                            *(u32x4*)(hb + H_XW + p * T_ST + tgl * 16) = pack8(w0, w1); }
                    } else {
                        const bool isB = sol < 32; const int n0 = (isB ? (sol - 16) : (sol - 32)) * 8 + cp * 2;
                        char* nat = lds + (isB ? OFF_BS : OFF_CS);
#pragma unroll
                        for (int t = 0; t < 8; ++t) *(unsigned*)(nat + (tgl * 8 + t) * CS_ST + n0 * 2) = cvt_pk_bf16(outv[t][0], outv[t][1]);
                        if (isB) {
#pragma unroll
                            for (int e = 0; e < 2; ++e) { f32x4 a, bq;
#pragma unroll
                                for (int t = 0; t < 4; ++t) { a[t] = outv[t][e]; bq[t] = outv[4 + t][e]; }
                                *(u32x4*)(lds + OFF_BT + (n0 + e) * T_ST + tgl * 16) = pack8(a, bq); }
                        }
                    }
                    SBAR();
                }
            }
            if (c + 1 < 32) SSD_LOAD(c + 1, xrl, tgl);
            __syncthreads();
#pragma unroll
            for (int t2 = 0; t2 < 2; ++t2) {
                const int tile = 2 * wid + t2, sb = tile >> 2, lb = tile & 3;
                f32x4 d = (f32x4){0.f, 0.f, 0.f, 0.f}, m0 = d, m1 = d;
                if (sb <= lb) {
#pragma unroll
                    for (int ks = 0; ks < 4; ++ks) d = mfma16(ldfrag(lds + OFF_BS, CS_ST, sb * 16 + frl, ks * 32 + fql * 8), ldfrag(lds + OFF_CS, CS_ST, lb * 16 + frl, ks * 32 + fql * 8), d);
                    const int l = lb * 16 + frl; const float al0 = __shfl(acs0, l), al1 = __shfl(acs1, l);
#pragma unroll
                    for (int r = 0; r < 4; ++r) { const int sidx = sb * 16 + 4 * fql + r; const float as0 = __shfl(acs0, sidx), as1 = __shfl(acs1, sidx), ds0 = __shfl(dtl0, sidx), ds1 = __shfl(dtl1, sidx);
                        m0[r] = (sidx <= l) ? d[r] * __expf(al0 - as0) * ds0 : 0.f; m1[r] = (sidx <= l) ? d[r] * __expf(al1 - as1) * ds1 : 0.f; }
                }
                u32x2 w; w.x = cvt_pk_bf16(m0[0], m0[1]); w.y = cvt_pk_bf16(m0[2], m0[3]);
                *(u32x2*)(lds + OFF_H0 + H_MT + (lb * 16 + frl) * T_ST + (sb * 16 + 4 * fql) * 2) = w;
                w.x = cvt_pk_bf16(m1[0], m1[1]); w.y = cvt_pk_bf16(m1[2], m1[3]);
                *(u32x2*)(lds + OFF_H0 + H_SZ + H_MT + (lb * 16 + frl) * T_ST + (sb * 16 + 4 * fql) * 2) = w;
            }
            f32x4 yacc[2][2];
#pragma unroll
            for (int hh = 0; hh < 2; ++hh)
#pragma unroll
                for (int t2 = 0; t2 < 2; ++t2) {
                    const int tile = 2 * wid + t2, pb = tile >> 2, lb = tile & 3; const char* hb = lds + OFF_H0 + hh * H_SZ;
                    f32x4 d = (f32x4){0.f, 0.f, 0.f, 0.f};
#pragma unroll
                    for (int ks = 0; ks < 4; ++ks) d = mfma16(ldfrag(hb + H_HS, CS_ST, pb * 16 + frl, ks * 32 + fql * 8), ldfrag(lds + OFF_CS, CS_ST, lb * 16 + frl, ks * 32 + fql * 8), d);
                    const float el = __expf(__shfl(hh ? acs1 : acs0, lb * 16 + frl));
                    yacc[hh][t2] = d * el;
                }
            __syncthreads();
#pragma unroll
            for (int hh = 0; hh < 2; ++hh)
#pragma unroll
                for (int t2 = 0; t2 < 2; ++t2) {
                    const int tile = 2 * wid + t2, pb = tile >> 2, lb = tile & 3; const char* hb = lds + OFF_H0 + hh * H_SZ;
                    f32x4 d = yacc[hh][t2];
#pragma unroll
                    for (int ks = 0; ks < 2; ++ks) d = mfma16(ldfrag(hb + H_XS, T_ST, pb * 16 + frl, ks * 32 + fql * 8), ldfrag(hb + H_MT, T_ST, lb * 16 + frl, ks * 32 + fql * 8), d);
                    const int l = lb * 16 + frl, p0 = pb * 16 + 4 * fql; const size_t tok = tokb + c * 64 + l; const float dsk = hh ? dsk1 : dsk0;
                    const u32x2 zz = zpre[hh][t2];
                    const float z0 = bflo(zz.x), z1 = bfhi(zz.x), z2 = bflo(zz.y), z3 = bfhi(zz.y);
                    float xs[4];
#pragma unroll
                    for (int r = 0; r < 4; ++r) xs[r] = bflo((unsigned)*(const bf16_t*)(hb + H_XS + (p0 + r) * T_ST + l * 2));
                    u32x2 w; w.x = cvt_pk_bf16((d[0] + xs[0] * dsk) * z0, (d[1] + xs[1] * dsk) * z1); w.y = cvt_pk_bf16((d[2] + xs[2] * dsk) * z2, (d[3] + xs[3] * dsk) * z3);
                    *(u32x2*)(YG + tok * 1024 + (h0 + hh) * 64 + p0) = w;
                }
#pragma unroll
            for (int hh = 0; hh < 2; ++hh) { const float dc = __expf(hh ? alast1 : alast0); char* hb = lds + OFF_H0 + hh * H_SZ;
#pragma unroll
                for (int t = 0; t < 4; ++t) { f32x4 d = hst[hh][t] * dc;
#pragma unroll
                    for (int ks = 0; ks < 2; ++ks) d = mfma16(ldfrag(lds + OFF_BT, T_ST, wid * 16 + frl, ks * 32 + fql * 8), ldfrag(hb + H_XW, T_ST, t * 16 + frl, ks * 32 + fql * 8), d);
                    hst[hh][t] = d;
                    u32x2 w; w.x = cvt_pk_bf16(d[0], d[1]); w.y = cvt_pk_bf16(d[2], d[3]);
                    *(u32x2*)(hb + H_HS + (t * 16 + frl) * CS_ST + (wid * 16 + 4 * fql) * 2) = w; } }
            __syncthreads();
        }
#undef SSD_LOAD
    }
}

__device__ __forceinline__ void ph_gnorm(Frame& F) {
    bf16_t* YG = (bf16_t*)(F.ws + WS_Q);
    const int gw = F.bid * NWAVES + F.wave, NGW = F.G * NWAVES;
    constexpr int RB = 4;
    for (int m0 = gw * RB; m0 < NTOK; m0 += NGW * RB) {
        u32x2 w[RB][4];
#pragma unroll
        for (int r = 0; r < RB; ++r) { const u32x2* rp = (const u32x2*)(YG + (size_t)(m0 + r) * D) + F.lane;
#pragma unroll
            for (int j = 0; j < 4; ++j) w[r][j] = rp[64 * j]; }
#pragma unroll
        for (int r = 0; r < RB; ++r) { const int m = m0 + r; u32x2* rp = (u32x2*)(YG + (size_t)m * D) + F.lane;
#pragma unroll
            for (int j = 0; j < 4; ++j) { const float a = bflo(w[r][j].x), b = bfhi(w[r][j].x), c = bflo(w[r][j].y), d = bfhi(w[r][j].y);
                const float ss = wave_sum(a * a + b * b + c * c + d * d); const float rr = 1.f / sqrtf(ss * (1.f / 256.f) + LN_EPS);
                if (PB_FP8) { int pk = 0; pk = __builtin_amdgcn_cvt_pk_fp8_f32(a * rr, b * rr, pk, false); pk = __builtin_amdgcn_cvt_pk_fp8_f32(c * rr, d * rr, pk, true); ((unsigned*)(F.outb + OUT_OB8 + (size_t)m * D))[F.lane + 64 * j] = (unsigned)pk; }
                else { u32x2 o; o.x = cvt_pk_bf16(a * rr, b * rr); o.y = cvt_pk_bf16(c * rr, d * rr); rp[64 * j] = o; } } }
    }
}

template <bool DRY = false> __device__ __forceinline__ void ph_router(Frame& F) {
    float* X1 = (float*)F.outb; bf16_t* U2 = (bf16_t*)(F.ws + WS_U2); const float* MOD = (const float*)(F.ws + WS_MOD);
    const float* ln1g = F.a->in[18]; const float* ln1b = F.a->in[19]; const float* w_router = F.a->in[20]; const float* b_router = F.a->in[21];
    u32x2* REG = (u32x2*)(F.ws + WS_REG); unsigned* CNT = (unsigned*)(F.ws + WS_CTL) + CW_CNT;
    constexpr int TST = 2064;
    LAS unsigned char* THI = F.lds; LAS unsigned char* TLO = F.lds + 16 * TST; LAS float* PART = (LAS float*)(F.lds + 32 * TST);
    LAS unsigned* lcnt = (LAS unsigned*)(F.lds + LDS_AUX); LAS unsigned* lbase = lcnt + 32; LAS unsigned* ent = lcnt + 64;
    const int tid = F.tid, lane = F.lane, wid = F.wave, fr = lane & 15, fq = lane >> 4;
    bf16x8 whi[4][2], wlo[4][2];
#pragma unroll
    for (int ks = 0; ks < 4; ++ks)
#pragma unroll
        for (int ct = 0; ct < 2; ++ct) { float wv[8];
#pragma unroll
            for (int i = 0; i < 8; ++i) wv[i] = w_router[(size_t)(128 * wid + 32 * ks + 8 * fq + i) * 32 + ct * 16 + fr];
            u32x4 h, l2;
#pragma unroll
            for (int i = 0; i < 4; ++i) { const unsigned hp = cvt_pk_bf16(wv[2 * i], wv[2 * i + 1]); const float r0 = wv[2 * i] - bflo(hp), r1 = wv[2 * i + 1] - bfhi(hp); h[i] = hp; l2[i] = cvt_pk_bf16(r0, r1); }
            whi[ks][ct] = __builtin_bit_cast(bf16x8, h); wlo[ks][ct] = __builtin_bit_cast(bf16x8, l2); }
    const float brl = b_router[lane & 31];
    for (int batch = F.bid; batch < NTOK / 256; batch += F.G) {
        const int hf = batch >> 7;
        __syncthreads();
        if (tid < 32) lcnt[tid] = 0u;
        for (int grp = 0; grp < 16; ++grp) {
#pragma unroll
            for (int tt = 0; tt < 2; ++tt) {
                const int tg16 = 2 * wid + tt, m = batch * 256 + grp * 16 + tg16; const float* md = MOD + (size_t)(m >> 11) * 6144;
                f32x4* xr = (f32x4*)(X1 + (size_t)m * D) + lane;
                f32x4 v[4]; float s = 0.f;
#pragma unroll
                for (int j = 0; j < 4; ++j) { v[j] = xr[64 * j]; s += (v[j][0] + v[j][1]) + (v[j][2] + v[j][3]); }
                float mean = wave_sum(s) * (1.f / D), s2 = 0.f;
#pragma unroll
                for (int j = 0; j < 4; ++j) { v[j] = v[j] - mean; s2 += (v[j][0] * v[j][0] + v[j][1] * v[j][1]) + (v[j][2] * v[j][2] + v[j][3] * v[j][3]); }
                float rstd = 1.f / sqrtf(wave_sum(s2) * (1.f / D) + LN_EPS);
                s = 0.f;
#pragma unroll
                for (int j = 0; j < 4; ++j) { const f32x4 g = *((const f32x4*)ln1g + lane + 64 * j), bb = *((const f32x4*)ln1b + lane + 64 * j); v[j] = v[j] * rstd * g + bb; if (!DRY) xr[64 * j] = v[j]; s += (v[j][0] + v[j][1]) + (v[j][2] + v[j][3]); }
                mean = wave_sum(s) * (1.f / D); s2 = 0.f;
#pragma unroll
                for (int j = 0; j < 4; ++j) { v[j] = v[j] - mean; s2 += (v[j][0] * v[j][0] + v[j][1] * v[j][1]) + (v[j][2] * v[j][2] + v[j][3] * v[j][3]); }
                rstd = 1.f / sqrtf(wave_sum(s2) * (1.f / D) + LN_EPS);
                u32x2* o8 = (u32x2*)(U2 + (size_t)m * D) + lane;
#pragma unroll
                for (int j = 0; j < 4; ++j) { const f32x4 sh = *((const f32x4*)(md + 3072) + lane + 64 * j), sc = *((const f32x4*)(md + 4096) + lane + 64 * j);
                    v[j] = v[j] * rstd * (sc + 1.0f) + sh; u32x2 w; w.x = cvt_pk_bf16(v[j][0], v[j][1]); w.y = cvt_pk_bf16(v[j][2], v[j][3]);
                    if (DRY) { if (w.x == 0x12345678u) o8[64 * j] = w; }
                    else if (MOE_FP8) { int pk = 0; pk = __builtin_amdgcn_cvt_pk_fp8_f32(v[j][0], v[j][1], pk, false); pk = __builtin_amdgcn_cvt_pk_fp8_f32(v[j][2], v[j][3], pk, true); ((unsigned*)((unsigned char*)U2 + (size_t)m * D))[lane + 64 * j] = (unsigned)pk; }
                    else o8[64 * j] = w;
                    u32x2 lo; lo.x = cvt_pk_bf16(v[j][0] - bflo(w.x), v[j][1] - bfhi(w.x)); lo.y = cvt_pk_bf16(v[j][2] - bflo(w.y), v[j][3] - bfhi(w.y));
                    *(LAS u32x2*)(THI + tg16 * TST + (4 * lane + 256 * j) * 2) = w; *(LAS u32x2*)(TLO + tg16 * TST + (4 * lane + 256 * j) * 2) = lo; }
            }
            __syncthreads();
            { f32x4 a0 = (f32x4){0.f, 0.f, 0.f, 0.f}, a1 = a0;
#pragma unroll
              for (int ks = 0; ks < 4; ++ks) { const int cb = (128 * wid + 32 * ks + 8 * fq) * 2;
                  const bf16x8 th = *(const LAS bf16x8*)(THI + fr * TST + cb), tl = *(const LAS bf16x8*)(TLO + fr * TST + cb);
                  a0 = __builtin_amdgcn_mfma_f32_16x16x32_bf16(whi[ks][0], th, a0, 0, 0, 0); a1 = __builtin_amdgcn_mfma_f32_16x16x32_bf16(whi[ks][1], th, a1, 0, 0, 0);
                  a0 = __builtin_amdgcn_mfma_f32_16x16x32_bf16(wlo[ks][0], th, a0, 0, 0, 0); a1 = __builtin_amdgcn_mfma_f32_16x16x32_bf16(wlo[ks][1], th, a1, 0, 0, 0);
                  a0 = __builtin_amdgcn_mfma_f32_16x16x32_bf16(whi[ks][0], tl, a0, 0, 0, 0); a1 = __builtin_amdgcn_mfma_f32_16x16x32_bf16(whi[ks][1], tl, a1, 0, 0, 0); }
              *(LAS f32x4*)(PART + (wid * 16 + fr) * 32 + 4 * fq) = a0; *(LAS f32x4*)(PART + (wid * 16 + fr) * 32 + 16 + 4 * fq) = a1; }
            __syncthreads();
            { const int tg16 = 2 * wid + (lane >> 5), tl = grp * 16 + tg16, myexp = lane & 31;
              float logit = brl;
#pragma unroll
              for (int w8 = 0; w8 < 8; ++w8) logit += PART[(w8 * 16 + tg16) * 32 + myexp];
              float tv[4]; int tix[4];
#pragma unroll
              for (int k = 0; k < 4; ++k) { float bv = logit; int bi = myexp;
#pragma unroll
                  for (int o = 1; o < 32; o <<= 1) { const float ov = __shfl_xor(bv, o); const int oi = __shfl_xor(bi, o); if (ov > bv || (ov == bv && oi < bi)) { bv = ov; bi = oi; } }
                  tv[k] = bv; tix[k] = bi; if (myexp == bi) logit = -INFINITY; }
              const float e1 = __expf(tv[1] - tv[0]), e2 = __expf(tv[2] - tv[0]), e3 = __expf(tv[3] - tv[0]); const float inv = 1.f / (1.f + e1 + e2 + e3);
              if (myexp < 4) { const int ee = myexp == 0 ? tix[0] : (myexp == 1 ? tix[1] : (myexp == 2 ? tix[2] : tix[3])); const float gg = (myexp == 0 ? 1.f : (myexp == 1 ? e1 : (myexp == 2 ? e2 : e3))) * inv;
                  const unsigned lp = atomicAdd((unsigned*)&lcnt[ee], 1u);
                  LAS unsigned* en = ent + (tl * 4 + myexp) * 3; en[0] = (unsigned)ee; en[1] = lp; en[2] = __float_as_uint(gg);
                  if (DBG_CHECK == 1) { u32x2 rw; rw.x = (unsigned)ee; rw.y = __float_as_uint(gg); ((u32x2*)(F.ws + WS_DBG))[(size_t)(batch * 256 + tl) * 4 + myexp] = rw; } } }
        }
        __syncthreads();
        if (tid < 32) lbase[tid] = DRY ? 0u : __hip_atomic_fetch_add(CNT + 64 * (hf * 32 + tid), lcnt[tid], __ATOMIC_RELAXED, __HIP_MEMORY_SCOPE_AGENT);
        __syncthreads();
        for (int i = tid; i < 1024; i += NTHR) { const LAS unsigned* en = ent + i * 3; const unsigned ee = en[0], pos = lbase[ee] + en[1];
            const unsigned tokl = (unsigned)(batch * 256 + (i >> 2)) - (unsigned)hf * HALF_TOK;
            u32x2 w; w.x = tokl * 4u + (unsigned)(i & 3); w.y = en[2];
            if (!DRY && pos < (unsigned)REG_CAP) REG[((size_t)hf * 32 + ee) * REG_CAP + pos] = w; }
    }
}

template <bool DRY = false> __device__ __forceinline__ void ph_final(Frame& F, int hf) {
    float* X1 = (float*)F.outb; const bf16_t* YB = (const bf16_t*)(F.ws + WS_YB); const float* MOD = (const float*)(F.ws + WS_MOD);
    const float* g2 = F.a->in[26]; const float* b2 = F.a->in[27];
    const int gw = F.bid * NWAVES + F.wave, NGW = F.G * NWAVES, lane = F.lane;
    constexpr int RB = 2;
    for (int tl0 = gw; tl0 < HALF_TOK; tl0 += NGW * RB) {
        f32x4 xv[RB][4]; u32x2 yw[RB][4][4];
#pragma unroll
        for (int r = 0; r < RB; ++r) { const int tl = tl0 + r * NGW, m = hf * HALF_TOK + tl;
            const f32x4* xr = (const f32x4*)(X1 + (size_t)m * D) + lane; const u32x2* yr = (const u32x2*)(YB + (size_t)tl * 4 * D) + lane;
#pragma unroll
            for (int j = 0; j < 4; ++j) { xv[r][j] = xr[64 * j];
#pragma unroll
                for (int k = 0; k < 4; ++k) yw[r][j][k] = yr[k * 256 + 64 * j]; } }
#pragma unroll
        for (int r = 0; r < RB; ++r) { const int tl = tl0 + r * NGW, m = hf * HALF_TOK + tl; const float* md = MOD + (size_t)(m >> 11) * 6144 + 5120;
            f32x4* xr = (f32x4*)(X1 + (size_t)m * D) + lane;
            f32x4 v[4]; float s = 0.f;
#pragma unroll
            for (int j = 0; j < 4; ++j) { f32x4 y = (f32x4){0.f, 0.f, 0.f, 0.f};
#pragma unroll
                for (int k = 0; k < 4; ++k) { const u32x2 w = yw[r][j][k]; y[0] += bflo(w.x); y[1] += bfhi(w.x); y[2] += bflo(w.y); y[3] += bfhi(w.y); }
                if (DBG_NO_MOE) y = (f32x4){0.f, 0.f, 0.f, 0.f};
                const f32x4 gt = *((const f32x4*)md + lane + 64 * j);
                v[j] = xv[r][j] * DN_ALPHA + gt * y; s += (v[j][0] + v[j][1]) + (v[j][2] + v[j][3]); }
            const float mean = wave_sum(s) * (1.f / D); float s2 = 0.f;
#pragma unroll
            for (int j = 0; j < 4; ++j) { v[j] = v[j] - mean; s2 += (v[j][0] * v[j][0] + v[j][1] * v[j][1]) + (v[j][2] * v[j][2] + v[j][3] * v[j][3]); }
            const float rstd = 1.f / sqrtf(wave_sum(s2) * (1.f / D) + LN_EPS);
#pragma unroll
            for (int j = 0; j < 4; ++j) { const f32x4 g = *((const f32x4*)g2 + lane + 64 * j), bb = *((const f32x4*)b2 + lane + 64 * j); const f32x4 ov = v[j] * rstd * g + bb; if (!DRY || ov[0] == 1.2345e-33f) xr[64 * j] = ov; } }
    }
}

__device__ __forceinline__ float block_sum(Frame& F, float v, LAS float* red) {
    v = wave_sum(v); __syncthreads(); if (F.lane == 0) red[F.wave] = v; __syncthreads();
    float s = 0.f; for (int w = 0; w < NWAVES; ++w) s += red[w]; return s;
}
__device__ __forceinline__ float block_max(Frame& F, float v, LAS float* red) {
#pragma unroll
    for (int o = 1; o < 64; o <<= 1) v = fmaxf(v, __shfl_xor(v, o));
    __syncthreads(); if (F.lane == 0) red[F.wave] = v; __syncthreads();
    float s = 0.f; for (int w = 0; w < NWAVES; ++w) s = fmaxf(s, red[w]); return s;
}
__device__ __forceinline__ void dbg_report(Frame& F, float e) { if (F.tid == 0) atomicMax((unsigned*)(F.ws + WS_CTL) + CW_DBG, __float_as_uint(e)); }
__device__ __forceinline__ void dbg_check_moe(Frame& F) {
    if (F.bid >= 64) return;
    const int tok = HALF_TOK + 509 * F.bid + 3, tokl = tok - HALF_TOK, tid = F.tid;
    LAS float* u2 = (LAS float*)F.lds; LAS float* act = u2 + 1024; LAS float* red = act + 1024; LAS float* lg = red + 16;
    const bf16_t* U2 = (const bf16_t*)(F.ws + WS_U2); const bf16_t* YB = (const bf16_t*)(F.ws + WS_YB); const u32x2* RT = (const u32x2*)(F.ws + WS_DBG);
    const float* w1 = F.a->in[22]; const float* b1 = F.a->in[23]; const float* w2 = F.a->in[24]; const float* b2 = F.a->in[25];
    __syncthreads();
    for (int i = tid; i < 1024; i += NTHR) u2[i] = bflo((unsigned)U2[(size_t)tok * 1024 + i]);
    __syncthreads();
    float y0 = 0.f, y1 = 0.f;
    for (int k = 0; k < 4; ++k) {
        const u32x2 rw = RT[(size_t)tok * 4 + k]; const int e = (int)rw.x; const float g = __uint_as_float(rw.y);
        const float* W1 = w1 + (size_t)e * 1024 * 2048; const float* W2 = w2 + (size_t)e * 1024 * 1024;
        float h0 = b1[e * 2048 + tid], h1 = b1[e * 2048 + tid + 512], h2 = b1[e * 2048 + tid + 1024], h3 = b1[e * 2048 + tid + 1536];
        for (int c = 0; c < 1024; ++c) { const float uu = u2[c]; const float* wr = W1 + (size_t)c * 2048 + tid; h0 += uu * wr[0]; h1 += uu * wr[512]; h2 += uu * wr[1024]; h3 += uu * wr[1536]; }
        __syncthreads();
        { float gg = fminf(h0, 7.f), up = fminf(fmaxf(h2, -7.f), 7.f); act[tid] = (up + 1.f) * gg / (1.f + expf(-1.702f * gg));
          gg = fminf(h1, 7.f); up = fminf(fmaxf(h3, -7.f), 7.f); act[tid + 512] = (up + 1.f) * gg / (1.f + expf(-1.702f * gg)); }
        __syncthreads();
        float a0 = b2[e * 1024 + tid], a1 = b2[e * 1024 + tid + 512];
        for (int j = 0; j < 1024; ++j) { const float aa = act[j]; a0 += aa * W2[(size_t)j * 1024 + tid]; a1 += aa * W2[(size_t)j * 1024 + tid + 512]; }
        y0 += g * a0; y1 += g * a1;
    }
    float f0 = 0.f, f1 = 0.f;
    for (int k = 0; k < 4; ++k) { f0 += bflo((unsigned)YB[((size_t)tokl * 4 + k) * 1024 + tid]); f1 += bflo((unsigned)YB[((size_t)tokl * 4 + k) * 1024 + tid + 512]); }
    const float rms = sqrtf(block_sum(F, y0 * y0 + y1 * y1, red) * (1.f / 1024.f)) + 1e-20f;
    float err = block_max(F, fmaxf(fabsf(y0 - f0), fabsf(y1 - f1)), red) / rms;
    { const float* X1 = (const float*)F.outb + (size_t)tok * 1024; const float* md = (const float*)(F.ws + WS_MOD) + (size_t)(tok >> 11) * 6144;
      const float xa = X1[tid], xb = X1[tid + 512]; const float mean = block_sum(F, xa + xb, red) * (1.f / 1024.f);
      const float da = xa - mean, db = xb - mean; const float var = block_sum(F, da * da + db * db, red) * (1.f / 1024.f); const float rstd = 1.f / sqrtf(var + LN_EPS);
      __syncthreads();
      u2[tid] = da * rstd * (1.f + md[4096 + tid]) + md[3072 + tid]; u2[tid + 512] = db * rstd * (1.f + md[4096 + tid + 512]) + md[3072 + tid + 512];
      __syncthreads();
      if (tid < 32) { float a = F.a->in[21][tid]; for (int c = 0; c < 1024; ++c) a += u2[c] * F.a->in[20][c * 32 + tid]; lg[tid] = a; }
      __syncthreads();
      if (tid == 0) { unsigned want = 0u, got = 0u; float l2[32]; for (int i = 0; i < 32; ++i) l2[i] = lg[i];
          for (int k = 0; k < 4; ++k) { int bi = 0; for (int i = 1; i < 32; ++i) if (l2[i] > l2[bi]) bi = i; want |= 1u << bi; l2[bi] = -INFINITY; got |= 1u << RT[(size_t)tok * 4 + k].x; }
          lg[32] = (want != got) ? 1.f : 0.f; }
      __syncthreads();
      if (lg[32] != 0.f) err = 50.f; }
    dbg_report(F, err);
}
__device__ __forceinline__ void dbg_check_ssd(Frame& F) {
    if (F.bid >= 2) return;
    const int b = F.bid ? 20 : 5, h = F.bid ? 14 : 3, g = h >> 2, tid = F.tid, p = tid >> 3, ng = tid & 7;
    LAS float* red = (LAS float*)F.lds; LAS float* cv = red + 16;
    const bf16_t* XBC = (const bf16_t*)(F.ws + WS_XBC); const bf16_t* ZS = (const bf16_t*)(F.ws + WS_Z); const float* DT = (const float*)(F.outb + OUT_DT); const bf16_t* YG = (const bf16_t*)(F.ws + WS_Q);
    const float* cw = F.a->in[9]; const float* cb = F.a->in[10]; const float aneg = -expf(F.a->in[12][h]), dsk = F.a->in[13][h];
    const int mych = tid < 64 ? h * 64 + tid : (tid < 192 ? 1024 + g * 128 + (tid - 64) : 1536 + g * 128 + (tid - 192));
    float w0 = 0.f, w1 = 0.f, w2 = 0.f, w3 = 0.f, wb = 0.f;
    if (tid < 320) { w0 = cw[0 * 2048 + mych]; w1 = cw[1 * 2048 + mych]; w2 = cw[2 * 2048 + mych]; w3 = cw[3 * 2048 + mych]; wb = cb[mych]; }
    float x0 = 0.f, x1 = 0.f, x2 = 0.f;
    float hs[16];
#pragma unroll
    for (int i = 0; i < 16; ++i) hs[i] = 0.f;
    float emax = 0.f, ssq = 0.f, nbad = 0.f; int tmax = 0;
    for (int t = 0; t < SEQ; ++t) {
        const size_t tok = (size_t)b * SEQ + t;
        __syncthreads();
        if (DBG_HYP == 1 && (t & 63) == 0) { x0 = 0.f; x1 = 0.f; x2 = 0.f; }
        if (tid < 320) { const float x3 = bflo((unsigned)XBC[tok * 2048 + mych]); const float s = wb + w0 * x0 + w1 * x1 + w2 * x2 + w3 * x3; cv[tid] = s / (1.f + expf(-s)); x0 = x1; x1 = x2; x2 = x3; }
        __syncthreads();
        const float xv = cv[p], dt = DT[tok * 16 + h], dec = expf(dt * aneg);
        float yp = 0.f;
#pragma unroll
        for (int i = 0; i < 16; ++i) { const int n = ng * 16 + i; hs[i] = hs[i] * dec + dt * xv * cv[64 + n]; yp += cv[192 + n] * hs[i]; }
        yp += __shfl_xor(yp, 1); yp += __shfl_xor(yp, 2); yp += __shfl_xor(yp, 4);
        const float yv = (yp + xv * dsk) * bflo((unsigned)ZS[tok * 1024 + h * 64 + p]);
        const float yf = bflo((unsigned)YG[tok * 1024 + h * 64 + p]);
        if (ng == 0) { const float er = fabsf(yv - yf); if (er > emax) { emax = er; tmax = t; } ssq += yv * yv; if (er > 0.25f && (DBG_SUB < 5 || (DBG_SUB == 5 && (t & 63) == 0) || (DBG_SUB == 6 && (t & 63) == 1) || (DBG_SUB == 7 && (t & 63) == 32))) nbad += 1.f; }
    }
    const float rms = sqrtf(block_sum(F, ssq, red) / (64.f * SEQ)) + 1e-20f;
    const float M = block_max(F, emax, red);
    if (DBG_SUB == 0) dbg_report(F, M / rms);
    else if (DBG_SUB == 1) dbg_report(F, block_sum(F, nbad, red) / (64.f * SEQ));
    else if (DBG_SUB >= 5) dbg_report(F, block_sum(F, nbad, red) / (64.f * 32.f));
    else { __syncthreads(); if (ng == 0 && emax == M) red[12] = (float)(DBG_SUB == 2 ? ((tmax & 63) >> 1) : (DBG_SUB == 3 ? (tmax >> 6) : (p >> 1))); __syncthreads();
        if (F.bid == 0) dbg_report(F, powf(10.f, 2.f * (0.05f + 0.05f * red[12]) - 4.f)); }
}
__device__ __forceinline__ void dbg_check_attn(Frame& F) {
    if (F.bid >= 32) return;
    const int b = (F.bid * 7 + 3) & 31, pos = 300 + F.bid * 53, nadm = ((pos >> 6) + 1) * 64, tid = F.tid, lane = F.lane, hd = F.wave;
    const size_t tq = (size_t)b * SEQ + pos;
    LAS float* sc = (LAS float*)F.lds; LAS unsigned char* sel = (LAS unsigned char*)(sc + 2048); LAS float* lgt = (LAS float*)(sel + 2048); LAS float* red = lgt + 8 * 2048; LAS float* misc = red + 16;
    const bf16_t* IQ = (const bf16_t*)(F.outb + OUT_IQ); const bf16_t* IK = (const bf16_t*)(F.outb + OUT_IK); const float* IW = (const float*)(F.outb + OUT_IW);
    const bf16_t* Q = (const bf16_t*)(F.ws + WS_Q); const bf16_t* KV = (const bf16_t*)(F.outb + OUT_KV); const bf16_t* OA = (const bf16_t*)(F.outb + OUT_OA); const u64* MASK = (const u64*)(F.outb + OUT_MASK);
    __syncthreads();
    for (int k = tid; k < nadm; k += NTHR) { float s = 0.f;
        for (int hh = 0; hh < 8; ++hh) { float d = 0.f; for (int c = 0; c < 64; ++c) d += bflo((unsigned)IQ[tq * 512 + hh * 64 + c]) * bflo((unsigned)IK[((size_t)b * SEQ + k) * 64 + c]); s += fmaxf(d, 0.f) * IW[tq * 8 + hh]; }
        sc[k] = s + 0.0f; }
    __syncthreads();
    float nbad = 0.f;
    for (int k = tid; k < nadm; k += NTHR) { const float s = sc[k]; int rank = 0; for (int j = 0; j < nadm; ++j) { const float t = sc[j]; rank += (t > s || (t == s && j < k)) ? 1 : 0; }
        const unsigned char se = rank < 256 ? 1 : 0; sel[k] = se; const unsigned mb = (unsigned)((MASK[tq * 32 + (k >> 6)] >> (k & 63)) & 1ull); if (mb != se) nbad += 1.f; }
    __syncthreads();
    const float nbad_t = block_sum(F, nbad, red);
    LAS float* lw = lgt + hd * 2048; float mx = -INFINITY;
    for (int k = lane; k < nadm; k += 64) { float l = -INFINITY;
        if (sel[k]) { float d = 0.f; for (int c = 0; c < 128; ++c) d += bflo((unsigned)Q[tq * 1024 + hd * 128 + c]) * bflo((unsigned)KV[((size_t)b * SEQ + k) * 128 + c]);
            const int rel = k - pos, n = rel < 0 ? -rel : rel; const float nf = (float)(n > 1 ? n : 1); int large = 8 + (int)(logf(nf / 8.0f) / 2.7725887f * 8.0f); if (large > 15) large = 15;
            const int bucket = (rel > 0 ? 16 : 0) + (n < 8 ? n : large);
            l = d * 0.088388347648318440f + F.a->in[8][bucket * 8 + hd]; }
        lw[k] = l; mx = fmaxf(mx, l); }
#pragma unroll
    for (int o = 1; o < 64; o <<= 1) mx = fmaxf(mx, __shfl_xor(mx, o));
    float den = 0.f;
    for (int k = lane; k < nadm; k += 64) { const float pp = expf(lw[k] - mx); lw[k] = pp; den += pp; }
    den = wave_sum(den);
    float emax = 0.f, ssq = 0.f;
    for (int c2 = 0; c2 < 2; ++c2) { const int c = lane + 64 * c2; float o = 0.f; for (int k = 0; k < nadm; ++k) { const float pp = lw[k]; if (pp != 0.f) o += pp * bflo((unsigned)KV[((size_t)b * SEQ + k) * 128 + c]); }
        o /= den; const float of = bflo((unsigned)OA[tq * 1024 + hd * 128 + c]); emax = fmaxf(emax, fabsf(o - of)); ssq += o * o; }
    const float rms = sqrtf(block_sum(F, ssq, red) * (1.f / 1024.f)) + 1e-20f;
    float err = block_max(F, emax, red) / rms;
    (void)misc;
    if (nbad_t > 0.f) err = 10.f + nbad_t;
    dbg_report(F, err);
}
__device__ __forceinline__ void dbg_emit(Frame& F) {
    float* out = (float*)F.outb;
    for (size_t i = (size_t)F.bid * NTHR + F.tid; i < (size_t)NTOK * D / 4; i += (size_t)F.G * NTHR) ((f32x4*)out)[i] = (f32x4){0.f, 0.f, 0.f, 0.f};
    __syncthreads();
    if (F.bid == 0 && F.tid == 0) { const float e = __uint_as_float(__hip_atomic_load((unsigned*)(F.ws + WS_CTL) + CW_DBG, __ATOMIC_RELAXED, __HIP_MEMORY_SCOPE_AGENT));
        float code = (log10f(fmaxf(e, 1e-30f)) + 4.f) * 0.5f; code = fminf(fmaxf(rintf(code * 20.f) * 0.05f, 0.05f), 3.0f);
        out[0] = sqrtf(67108864.f * 1.01f * (powf(10.f, code) - 1.f)); }
}

#define CLK_BEGIN(k) unsigned long long clk_c##k = 0, clk_r##k = 0; if (DBG_CLOCK == (k) + 1) { clk_c##k = __builtin_amdgcn_s_memtime(); clk_r##k = __builtin_amdgcn_s_memrealtime(); }
#define CLK_END(k) if (DBG_CLOCK == (k) + 1 && F.bid == 0) { const float ghz = (float)(__builtin_amdgcn_s_memtime() - clk_c##k) / (float)(__builtin_amdgcn_s_memrealtime() - clk_r##k) * 0.1f; dbg_report(F, powf(10.f, 2.f * (rintf(ghz * 5.f) * 0.2f) - 4.f)); }
constexpr int NPHASE = 17;
__global__ void __launch_bounds__(NTHR, 2) fwd(Args args) {
    extern __shared__ __attribute__((aligned(16))) unsigned char lds_raw[];
    Frame F;
    F.lds = (LAS unsigned char*)lds_raw;
    F.tid = threadIdx.x; F.lane = F.tid & 63; F.wave = __builtin_amdgcn_readfirstlane(F.tid >> 6); F.G = gridDim.x; F.bid = blockIdx.x;
    F.a = &args;
    F.ws = args.ws; F.outb = (unsigned char*)args.out;
    volatile LAS unsigned* MISCW = (volatile LAS unsigned*)(F.lds + LDS_MISC);
    if (F.tid < 64) MISCW[F.tid] = 0u;
    __syncthreads();
    XcdBarrier bar; bar.bar = (unsigned*)(F.ws + WS_CTL) + CW_BAR; bar.x = 0; bar.st = nullptr;
#if MK_ONE
    bar = xcd_barrier_post((unsigned*)(F.ws + WS_CTL) + CW_BAR, MISCW + 8);
#define GRID_BAR() xcd_barrier(bar)
#else
#define GRID_BAR() do { } while (0)
#endif
    const int lo = args.ph_lo, hi = args.ph_hi;
#ifndef PHM
#define PHM (0xFFFFFFFFu & ~(DBG_NO_ATTN ? 0x30u : 0u) & ~(DBG_NO_SSD ? 0xC0u : 0u))
#endif
#define IN(k) (((PHM >> (k)) & 1u) && lo <= (k) && (k) < hi)
#define SEAM(k) do { if ((k) + 1 < hi) GRID_BAR(); } while (0)

    if (IN(0)) {
#pragma nounroll
        for (int rep = 0; rep < ((DBG_TWICE & 1u) ? 2 : 1); ++rep) { if (rep) GRID_BAR(); ph_prologue(F); }
        SEAM(0); }
    if (IN(1)) {
#pragma nounroll
        for (int rep = 0; rep < ((DBG_TWICE & 2u) ? 2 : 1); ++rep) { if (rep) GRID_BAR(); ph_ln1(F); }
        SEAM(1); }
    CLK_BEGIN(2);
    if (IN(2)) {
        EpiProj E{(bf16_t*)(F.ws + WS_Q), (bf16_t*)(F.outb + OUT_IQ), (bf16_t*)(F.ws + WS_Z), (bf16_t*)(F.ws + WS_XBC), (bf16_t*)(F.ws + WS_GA), (bf16_t*)(F.ws + WS_GB), (float*)(F.outb + OUT_MISC), 1.0f};
#if PROJ_FP8
        { SchedProj<2> S; S.o.init(NTOK, 12 * 256, F.G, F.bid); S.A = (const char*)(F.ws + WS_U8); S.Bt = (const char*)(F.ws + WS_WIN8);
          EpiProj E8 = E; E8.sc = MOE_INV;
          pg8::gemm_phase<EpiProj, SchedProj<2>, false, 512, true>(F.lds, S, E8);
          if (DBG_TWICE & 32768u) { GRID_BAR(); pg8::gemm_phase<EpiProj, SchedProj<2>, false, 512, true>(F.lds, S, E8); } }
        { SchedProj<1> S; S.o.init(NTOK, 15 * 256, F.G, F.bid); S.A = (const char*)(F.outb + OUT_U); S.Bt = (const char*)(F.ws + WS_WIN); if (DBG_KCLK) S.dbgw = (unsigned*)(F.ws + WS_CTL) + CW_DBG;
#if DBG_DRYPROJ
#pragma nounroll
          for (int rep = 0; rep < 2; ++rep) { EpiProj Ed = E; Ed.dry = rep == 0; SchedProj<1> Sd = S; Sd.fold = rep == 0 ? 7 : 0x7fffffff; pg8::gemm_phase<EpiProj, SchedProj<1>, false>(F.lds, Sd, Ed); if (rep == 0) GRID_BAR(); }
#else
          const unsigned long long w0 = DBG_WALL ? __builtin_amdgcn_s_memrealtime() : 0ull;
          pg8::gemm_phase<EpiProj, SchedProj<1>, false>(F.lds, S, E);
          if (DBG_WALL && F.bid == 0) { const float us = (float)(__builtin_amdgcn_s_memrealtime() - w0) * 0.01f; dbg_report(F, powf(10.f, 2.f * (rintf(us / 300.f * 10.f) * 0.1f) - 4.f)); }
#endif
          if (DBG_TWICE & 4u) { GRID_BAR(); pg8::gemm_phase<EpiProj, SchedProj<1>, false>(F.lds, S, E); } }
#else
        { SchedProj<0> S; S.o.init(NTOK, NPROJ, F.G, F.bid); S.A = (const char*)(F.outb + OUT_U); S.Bt = (const char*)(F.ws + WS_WIN);
          pg8::gemm_phase<EpiProj, SchedProj<0>, false>(F.lds, S, E);
          if (DBG_TWICE & 4u) { GRID_BAR(); pg8::gemm_phase<EpiProj, SchedProj<0>, false>(F.lds, S, E); } }
#endif
        SEAM(2);
    }
    CLK_END(2);
    if (IN(3)) { ph_misc(F); if (DBG_TWICE & 8u) { GRID_BAR(); ph_misc(F); } SEAM(3); }
    if (IN(4)) { ph_index(F); if (DBG_TWICE & 16u) { GRID_BAR(); ph_index(F); } SEAM(4); }
    if (IN(5)) { ph_attn(F); if (DBG_TWICE & 32u) { GRID_BAR(); ph_attn(F); } SEAM(5); if (DBG_CHECK == 3) { dbg_check_attn(F); GRID_BAR(); } }
    if (IN(6)) { ph_ssd2(F); if (DBG_TWICE & 64u) { GRID_BAR(); ph_ssd2(F); } SEAM(6); if (DBG_CHECK == 2) { dbg_check_ssd(F); GRID_BAR(); } }
    if (IN(7)) { ph_gnorm(F); if (DBG_TWICE & 128u) { GRID_BAR(); ph_gnorm(F); } SEAM(7); }
    if (IN(8)) {
#if PA_FP8
        SchedPlainT<1024> S; S.o.init(NTOK, 1024, F.G, F.bid); S.A = (const char*)(F.outb + OUT_OA); S.Bt = (const char*)(F.ws + WS_WPA8);
        EpiGate<0> E{(const bf16_t*)(F.ws + WS_GA), nullptr, (bf16_t*)(F.ws + WS_Z), MOE_INV};
        pg8::gemm_phase<EpiGate<0>, SchedPlainT<1024>, false, 512, true>(F.lds, S, E);
#else
        SchedPlain S; S.o.init(NTOK, 1024, F.G, F.bid); S.A = (const char*)(F.outb + OUT_OA); S.Bt = (const char*)(F.ws + WS_WPA);
        EpiGate<0> E{(const bf16_t*)(F.ws + WS_GA), nullptr, (bf16_t*)(F.ws + WS_Z), 1.0f};
        pg8::gemm_phase<EpiGate<0>, SchedPlain, false>(F.lds, S, E);
#endif
    }
    if (IN(9)) {
#if PB_FP8
        SchedPlainT<1024> S; S.o.init(NTOK, 1024, F.G, F.bid); S.A = (const char*)(F.outb + OUT_OB8); S.Bt = (const char*)(F.ws + WS_WPB8);
        EpiGate<1> E{(const bf16_t*)(F.ws + WS_GB), (const bf16_t*)(F.ws + WS_Z), (bf16_t*)(F.ws + WS_XBC), MOE_INV};
        pg8::gemm_phase<EpiGate<1>, SchedPlainT<1024>, false, 512, true>(F.lds, S, E);
#else
        SchedPlain S; S.o.init(NTOK, 1024, F.G, F.bid); S.A = (const char*)(F.ws + WS_Q); S.Bt = (const char*)(F.ws + WS_WPB);
        EpiGate<1> E{(const bf16_t*)(F.ws + WS_GB), (const bf16_t*)(F.ws + WS_Z), (bf16_t*)(F.ws + WS_XBC), 1.0f};
        pg8::gemm_phase<EpiGate<1>, SchedPlain, false>(F.lds, S, E);
#endif
        SEAM(9);
    }
    if (IN(10)) {
        SchedPlain S; S.o.init(NTOK, 1024, F.G, F.bid); S.A = (const char*)(F.ws + WS_XBC); S.Bt = (const char*)(F.ws + WS_WOUT);
        EpiOut E{F.a->in[0], (const float*)(F.ws + WS_MOD), (float*)F.outb};
        pg8::gemm_phase<EpiOut, SchedPlain, false>(F.lds, S, E);
        if (DBG_TWICE & 1024u) { GRID_BAR(); pg8::gemm_phase<EpiOut, SchedPlain, false>(F.lds, S, E); }
        SEAM(10);
    }
    if (IN(11)) { if (DBG_TWICE & 2048u) { ph_router<true>(F); GRID_BAR(); } ph_router<false>(F); SEAM(11); }
#pragma unroll
    for (int hf = 0; hf < 2; ++hf) {
        const int p0 = 12 + hf * 2;
        if (IN(p0)) {
            if (hf == 1) ph_final<false>(F, 0);
            MoeTab T = moe_tables(F, hf);
            SchedMoe<8, true> S{T, F.G, F.bid, hf, (const char*)(F.ws + WS_U2), (const char*)(F.ws + WS_W1), (const u32x2*)(F.ws + WS_REG)};
            EpiMoe1 E{F.a->in[23], (bf16_t*)(F.ws + WS_ACT), 0};
            pg8::gemm_phase<EpiMoe1, SchedMoe<8, true>, true, MOE_RB / 2, MOE_FP8 != 0>(F.lds, S, E);
            if ((DBG_TWICE & 4096u) && hf == 0) { GRID_BAR(); pg8::gemm_phase<EpiMoe1, SchedMoe<8, true>, true, MOE_RB / 2, MOE_FP8 != 0>(F.lds, S, E); }
            if ((DBG_TWICE & 16384u) && hf == 0) { GRID_BAR(); EpiMoe1 Ed = E; Ed.dry = 1; pg8::gemm_phase<EpiMoe1, SchedMoe<8, true>, true, MOE_RB / 2, MOE_FP8 != 0>(F.lds, S, Ed); }
            SEAM(p0);
        }
        if (IN(p0 + 1)) {
            MoeTab T = moe_tables(F, hf);
            SchedMoe<4, false> S{T, F.G, F.bid, hf, (const char*)(F.ws + WS_ACT), (const char*)(F.ws + WS_W2), (const u32x2*)(F.ws + WS_REG)};
            EpiMoe2 E{F.a->in[25], (bf16_t*)(F.ws + WS_YB), (const u32x2*)(F.ws + WS_REG), T, hf, 0};
            if ((DBG_TWICE & 262144u) && hf == 0) { EpiMoe2 Ed = E; Ed.dry = DBG_DRYMODE; pg8::gemm_phase<EpiMoe2, SchedMoe<4, false>, false, MOE_RB / 2, MOE_FP8 != 0>(F.lds, S, Ed); GRID_BAR(); }
            pg8::gemm_phase<EpiMoe2, SchedMoe<4, false>, false, MOE_RB / 2, MOE_FP8 != 0>(F.lds, S, E);
            if ((DBG_TWICE & 8192u) && hf == 0) { GRID_BAR(); pg8::gemm_phase<EpiMoe2, SchedMoe<4, false>, false, MOE_RB / 2, MOE_FP8 != 0>(F.lds, S, E); }
            if ((DBG_TWICE & 131072u) && hf == 0) { GRID_BAR(); EpiMoe2 Ed = E; Ed.dry = 1; pg8::gemm_phase<EpiMoe2, SchedMoe<4, false>, false, MOE_RB / 2, MOE_FP8 != 0>(F.lds, S, Ed); }
            SEAM(p0 + 1);
            if (DBG_CHECK == 1 && hf == 1) { dbg_check_moe(F); GRID_BAR(); }
        }
    }
    if (IN(16)) { if (DBG_TWICE & 65536u) { ph_final<true>(F, 1); GRID_BAR(); } ph_final(F, 1); }
    if (DBG_CHECK || DBG_CLOCK || DBG_KCLK || DBG_WALL) { GRID_BAR(); dbg_emit(F); }
#undef IN
#undef SEAM
}

extern "C" void kernel_launch(void* const* d_in, const int* in_sizes, int n_in, void* d_out, int out_size, void* d_ws, size_t ws_size, hipStream_t stream) {
    static int grid = 0;
    if (grid == 0) {
        if (n_in != 28 || in_sizes[0] != NTOK * D || out_size != NTOK * D || ws_size < WS_END) { fprintf(stderr, "kernel_launch: shape mismatch (n_in %d, in0 %d, out %d, ws %zu)\n", n_in, n_in > 0 ? in_sizes[0] : -1, out_size, ws_size); grid = -1; return; }
        int dev = 0, cus = 0, per_cu = 0;
        if (hipGetDevice(&dev) != hipSuccess || hipDeviceGetAttribute(&cus, hipDeviceAttributeMultiprocessorCount, dev) != hipSuccess) { grid = -1; return; }
        if (hipFuncSetAttribute((const void*)fwd, hipFuncAttributeMaxDynamicSharedMemorySize, LDS_BYTES) != hipSuccess) { fprintf(stderr, "kernel_launch: hipFuncSetAttribute failed\n"); grid = -1; return; }
        if (hipOccupancyMaxActiveBlocksPerMultiprocessor(&per_cu, (const void*)fwd, NTHR, LDS_BYTES) != hipSuccess || per_cu < 1) fprintf(stderr, "kernel_launch: occupancy query reports %d\n", per_cu);
        (void)hipGetLastError();
        grid = cus;
    }
    if (grid < 0) return;
    if (hipMemsetAsync((char*)d_ws + WS_CTL, 0, CTL_ZERO_BYTES, stream) != hipSuccess) { fprintf(stderr, "kernel_launch: memset failed\n"); return; }
    Args a{};
    for (int i = 0; i < 28; ++i) a.in[i] = (const float*)d_in[i];
    a.out = (float*)d_out; a.ws = (unsigned char*)d_ws;
    const int nph = NPHASE < MK_PH_HI ? NPHASE : MK_PH_HI;
#if MK_ONE
    a.ph_lo = 0; a.ph_hi = nph;
    hipLaunchKernelGGL(fwd, dim3(grid), dim3(NTHR), LDS_BYTES, stream, a);
#else
    for (int p = 0; p < nph; ++p) { a.ph_lo = p; a.ph_hi = p + 1; hipLaunchKernelGGL(fwd, dim3(grid), dim3(NTHR), LDS_BYTES, stream, a); }
#endif
    const hipError_t le = hipPeekAtLastError();
    if (le != hipSuccess) fprintf(stderr, "kernel_launch: launch failed: %s\n", hipGetErrorName(le));
}
```

```cpp
#include <hip/hip_runtime.h>
#include <cstdio>
#include <cstdint>

#ifndef MK_ONE
#define MK_ONE 1
#endif
#ifndef DBG_NO_ATTN
#define DBG_NO_ATTN 0
#endif
#ifndef DBG_ATTN_ZERO
#define DBG_ATTN_ZERO 0
#endif
#ifndef DBG_IQ_TRUNC
#define DBG_IQ_TRUNC 0
#endif
#ifndef DBG_ROUTER_BF16
#define DBG_ROUTER_BF16 0
#endif
#ifndef DBG_CHECK
#define DBG_CHECK 0
#endif
#ifndef DBG_SKIP_BODY
#define DBG_SKIP_BODY 0
#endif
#ifndef DBG_SUB
#define DBG_SUB 0
#endif
#ifndef DBG_SSD_SYNC
#define DBG_SSD_SYNC 0
#endif
#ifndef DBG_HYP
#define DBG_HYP 0
#endif
#ifndef DBG_TWICE
#define DBG_DRYPROJ 0
#define DBG_ABL6 0
#define DBG_REP6 1
#define DBG_WALL 0
#define DBG_KCLK 0
#ifndef DBG_CLOCK
#define DBG_CLOCK 0
#endif
#define DBG_TWICE 0u
#endif
#ifndef DBG_DRYMODE
#define DBG_DRYMODE 2
#endif
#ifndef DBG_NO_SSD
#define DBG_NO_SSD 0
#endif
#ifndef DBG_NO_MOE
#define DBG_NO_MOE 0
#endif
#ifndef MOE_FP8
#define MOE_FP8 1
#endif
#ifndef PROJ_FP8
#define PROJ_FP8 1
#endif
#ifndef PA_FP8
#define PA_FP8 1
#endif
#ifndef PB_FP8
#define PB_FP8 0
#endif
#ifndef ATT2
#define ATT_OT 0
#define ATT2 1
#endif
#ifndef MK_PH_HI
#define MK_PH_HI 99
#endif

#define LAS __attribute__((address_space(3)))
#define GAS __attribute__((address_space(1)))
typedef unsigned short bf16_t;
typedef short bf16x8 __attribute__((ext_vector_type(8)));
typedef short s16x4 __attribute__((ext_vector_type(4)));
typedef float f32x2 __attribute__((ext_vector_type(2)));
typedef float f32x4 __attribute__((ext_vector_type(4)));
typedef float f32x16 __attribute__((ext_vector_type(16)));
typedef unsigned u32x2 __attribute__((ext_vector_type(2)));
typedef unsigned u32x4 __attribute__((ext_vector_type(4)));
typedef unsigned long long u64;

constexpr int NB = 32, SEQ = 2048, D = 1024, NTOK = NB * SEQ;
constexpr int NWAVES = 8, NTHR = 512;
constexpr int NPROJ = 6912;
constexpr int NEXP = 32, HALF_TOK = NTOK / 2, REG_CAP = HALF_TOK;
constexpr int ACT_ROWS = HALF_TOK * 4 + NEXP * 256;
constexpr float LN_EPS = 1e-5f;
constexpr float DN_ALPHA = 1.189207115002721f;
constexpr float LOG2E = 1.4426950408889634f;

constexpr size_t MiB = 1u << 20;
constexpr size_t WS_CTL = 0, CTL_ZERO_BYTES = 1 * MiB;
constexpr size_t WS_MOD = 1 * MiB;
constexpr size_t WS_BIAST = 1 * MiB + 800 * 1024;
constexpr size_t WS_WIN = 2 * MiB;
constexpr size_t WS_WPA = 16 * MiB, WS_WPB = 18 * MiB, WS_WOUT = 20 * MiB;
constexpr size_t WS_W1 = 24 * MiB;
constexpr size_t WS_U8 = 88 * MiB;
constexpr size_t WS_W2 = 152 * MiB;
constexpr size_t WS_WIN8 = 184 * MiB;
constexpr size_t WS_WPA8 = 192 * MiB;
constexpr size_t WS_WPB8 = 194 * MiB;
constexpr size_t OUT_OB8 = 192 * MiB;
constexpr size_t WS_Q = 216 * MiB;
constexpr size_t WS_Z = 344 * MiB;
constexpr size_t WS_XBC = 472 * MiB;
constexpr size_t WS_GA = 728 * MiB, WS_GB = 856 * MiB;
constexpr size_t WS_U2 = 216 * MiB;
constexpr size_t WS_REG = 344 * MiB;
constexpr size_t WS_ACT = 360 * MiB;
constexpr size_t WS_YB = 632 * MiB;
constexpr size_t WS_END = 889 * MiB;
constexpr size_t WS_DBG = 889 * MiB;
constexpr size_t OUT_U = 0, OUT_MISC = 128 * MiB, OUT_IQ = 192 * MiB;
constexpr size_t OUT_KV = 0, OUT_IK = 16 * MiB, OUT_IW = 24 * MiB, OUT_DT = 26 * MiB, OUT_MASK = 32 * MiB, OUT_OA = 64 * MiB;
constexpr int CW_BAR = 4096, CW_CNT = 16384, CW_WQ = 22528, CW_DBG = 24576;

constexpr int LDS_BYTES = 160 * 1024;
constexpr int LDS_AUX = 131072;
constexpr int LDS_MISC = LDS_BYTES - 256;

#define LDS_WAIT() asm volatile("s_waitcnt lgkmcnt(0)" ::: "memory")
#define GAS __attribute__((address_space(1)))
#define VM_WAIT() asm volatile("s_waitcnt vmcnt(0)" ::: "memory")
#define SBAR() __builtin_amdgcn_sched_barrier(0)
typedef __bf16 bf16x2_t __attribute__((ext_vector_type(2)));
__device__ __forceinline__ unsigned cvt_pk_bf16(float lo, float hi) { f32x2 f = {lo, hi}; bf16x2_t v = __builtin_convertvector(f, bf16x2_t); return __builtin_bit_cast(unsigned, v); }
__device__ __forceinline__ float bflo(unsigned w) { return __uint_as_float(w << 16); }
__device__ __forceinline__ float bfhi(unsigned w) { return __uint_as_float(w & 0xffff0000u); }
__device__ __forceinline__ u32x4 pack8(f32x4 a, f32x4 b) { u32x4 w; w.x = cvt_pk_bf16(a[0], a[1]); w.y = cvt_pk_bf16(a[2], a[3]); w.z = cvt_pk_bf16(b[0], b[1]); w.w = cvt_pk_bf16(b[2], b[3]); return w; }
constexpr int MOE_RB = MOE_FP8 ? 1024 : 2048;
constexpr float MOE_WSC = MOE_FP8 ? 64.0f : 1.0f, MOE_INV = 1.0f / MOE_WSC;
__device__ __forceinline__ u32x2 pack8_fp8(f32x4 a, f32x4 b) { int lo = 0, hi = 0;
    lo = __builtin_amdgcn_cvt_pk_fp8_f32(a[0], a[1], lo, false); lo = __builtin_amdgcn_cvt_pk_fp8_f32(a[2], a[3], lo, true);
    hi = __builtin_amdgcn_cvt_pk_fp8_f32(b[0], b[1], hi, false); hi = __builtin_amdgcn_cvt_pk_fp8_f32(b[2], b[3], hi, true);
    u32x2 r; r.x = (unsigned)lo; r.y = (unsigned)hi; return r; }
__device__ __forceinline__ void unpack8(u32x4 w, f32x4& a, f32x4& b) { a[0] = bflo(w.x); a[1] = bfhi(w.x); a[2] = bflo(w.y); a[3] = bfhi(w.y); b[0] = bflo(w.z); b[1] = bfhi(w.z); b[2] = bflo(w.w); b[3] = bfhi(w.w); }
__device__ __forceinline__ float wave_sum(float v) {
#pragma unroll
    for (int o = 1; o < 64; o <<= 1) v += __shfl_xor(v, o);
    return v;
}
__device__ __forceinline__ float dpp_scan_add(float v) {
#define DPPF(x, ctrl, rm) __builtin_bit_cast(float, __builtin_amdgcn_update_dpp(0, __builtin_bit_cast(int, (x)), (ctrl), (rm), 0xf, false))
    v += DPPF(v, 0x111, 0xf); v += DPPF(v, 0x112, 0xf); v += DPPF(v, 0x114, 0xf); v += DPPF(v, 0x118, 0xf);
    v += DPPF(v, 0x142, 0xa);
    v += DPPF(v, 0x143, 0xc);
#undef DPPF
    return v;
}
__device__ __forceinline__ float fast_rcp(float x) { return __builtin_amdgcn_rcpf(x); }
__device__ __forceinline__ float sigmoid_f(float x) { return fast_rcp(1.0f + __expf(-x)); }
__device__ __forceinline__ float silu_f(float x) { return x * sigmoid_f(x); }

#define XB_TMO      128
#define XB_XCNT(j)  (256  + 64 * (j))
#define XB_XSUB(j)  (1280 + 64 * (j))
#define XB_XGEN(j)  (2304 + 64 * (j))
#define XB_TOP      3328
#define XB_TOPGEN   3392
#define XCD_BAR_WORDS 3456
#define XB_SPIN_CAP (1u << 18)
__device__ __forceinline__ unsigned xb_ld(unsigned* p)              { return __hip_atomic_load(p, __ATOMIC_RELAXED, __HIP_MEMORY_SCOPE_AGENT); }
__device__ __forceinline__ unsigned xb_add(unsigned* p, unsigned v) { return __hip_atomic_fetch_add(p, v, __ATOMIC_RELAXED, __HIP_MEMORY_SCOPE_AGENT); }
__device__ __forceinline__ unsigned xb_xcc_id() { return (unsigned)__builtin_amdgcn_s_getreg((3 << 11) | 20) & 0xFu; }
#define XB_SPIN(cond, bar) do { unsigned _sp = 0; while (cond) { __builtin_amdgcn_s_sleep(1); \
    if ((++_sp & 255u) == 0u) { if (xb_ld(&(bar)[XB_TMO])) break; if (_sp > XB_SPIN_CAP) { atomicAdd(&(bar)[XB_TMO], 1u); break; } } } } while (0)
struct XcdBarrier { unsigned* bar; unsigned x; volatile LAS unsigned* st; };
__device__ __forceinline__ XcdBarrier xcd_barrier_post(unsigned* bar, volatile LAS unsigned* st) {
    XcdBarrier b; b.bar = bar; b.x = xb_xcc_id(); b.st = st;
    if (threadIdx.x == 0) (void)xb_add(&bar[XB_XCNT(b.x)], 1u);
    return b;
}
__device__ __forceinline__ void xcd_barrier_complete(unsigned* bar, unsigned x, unsigned& nloc, unsigned& nx) {
    const unsigned G = gridDim.x * gridDim.y * gridDim.z;
    unsigned sum, cnt, mine, sp = 0u;
    for (;;) {
        sum = 0u; cnt = 0u;
#pragma nounroll
        for (unsigned j = 0; j < 16; ++j) { const unsigned c = xb_ld(&bar[XB_XCNT(j)]); sum += c; cnt += (c > 0u) ? 1u : 0u; }
        if (sum == G) break;
        __builtin_amdgcn_s_sleep(1);
        if ((++sp & 255u) == 0u) { if (xb_ld(&bar[XB_TMO])) break; if (sp > XB_SPIN_CAP) { atomicAdd(&bar[XB_TMO], 1u); break; } }
    }
    mine = xb_ld(&bar[XB_XCNT(x)]);
    nloc = mine > 0u ? mine : 1u; nx = cnt > 0u ? cnt : 1u;
}
__device__ __forceinline__ void xcd_barrier(const XcdBarrier& b) {
    asm volatile("s_waitcnt vmcnt(0)" ::: "memory");
    __syncthreads();
    if (threadIdx.x == 0) {
        unsigned* bar = b.bar;
        __builtin_amdgcn_s_waitcnt(0);
        unsigned nloc = b.st[0], nx = b.st[1];
        if (nloc == 0u) { xcd_barrier_complete(bar, b.x, nloc, nx); b.st[0] = nloc; b.st[1] = nx; }
        const unsigned old = xb_add(&bar[XB_XSUB(b.x)], 1u);
        const unsigned gen = old / nloc;
        if (old + 1u == (gen + 1u) * nloc) {
            __builtin_amdgcn_fence(__ATOMIC_RELEASE, "agent");
            asm volatile("s_waitcnt vmcnt(0)" ::: "memory");
            const unsigned og = xb_add(&bar[XB_TOP], 1u);
            const unsigned tg = og / nx;
            if (og + 1u == (tg + 1u) * nx) xb_add(&bar[XB_TOPGEN], 1u);
            else XB_SPIN(xb_ld(&bar[XB_TOPGEN]) == tg, bar);
            __builtin_amdgcn_fence(__ATOMIC_ACQUIRE, "agent");
            xb_add(&bar[XB_XGEN(b.x)], 1u);
            asm volatile("s_waitcnt vmcnt(0)" ::: "memory");
        } else {
            XB_SPIN(xb_ld(&bar[XB_XGEN(b.x)]) == gen, bar);
            __builtin_amdgcn_fence(__ATOMIC_ACQUIRE, "agent");
            asm volatile("s_waitcnt vmcnt(0)" ::: "memory");
        }
    }
    __syncthreads();
}

namespace pg8 {
constexpr int BM = 256, BK = 64, HALF = 128, HTB = HALF * BK * 2, STAGE_BYTES = 8 * HTB, NXCD = 8, WGM = 8, KD = 1024;
__host__ __device__ __forceinline__ int lds_byte(int r, int c) { const int st = (r >> 4) * 2 + (c >> 5), rr = r & 15, cc = c & 31, ob = rr * 64 + cc * 2; return st * 1024 + (ob ^ (((ob >> 9) & 1) << 5)); }
__host__ __device__ __forceinline__ void stage_rc(int b, int& R, int& C) { const int st = b / 1024, sb = b % 1024, swz = sb ^ (((sb >> 9) & 1) << 5); R = (st >> 1) * 16 + swz / 64; C = (st & 1) * 32 + (swz % 64) / 2; }
__host__ __device__ __forceinline__ int perm32(int rho) { const int n = rho >> 4, i = rho & 15; return 8 * (i >> 2) + 4 * n + (i & 3); }
struct Unit { int pm, pn, ex; };
struct StaticOrder {
    int nM, nN, nwg, G, c;
    __device__ void init(int M, int N, int G_, int c_) { nM = M / BM; nN = N / BM; nwg = nM * nN; G = G_; c = c_; }
    __device__ bool next(int i, Unit& u) const {
        const long L = (long)i * G + c; if (L >= nwg) return false;
        int wgid = (int)L; { const int q = nwg / NXCD, r = nwg % NXCD, xcd = wgid % NXCD, off = wgid / NXCD; wgid = (xcd < r ? xcd * (q + 1) : r * (q + 1) + (xcd - r) * q) + off; }
        const int nig = WGM * nN, gid = wgid / nig, fm = gid * WGM, gsz = (nM - fm) < WGM ? (nM - fm) : WGM;
        u.pm = fm + ((wgid % nig) % gsz); u.pn = (wgid % nig) / gsz; u.ex = 0; return true;
    }
};
typedef int i32x8 __attribute__((ext_vector_type(8)));
typedef int i32x4v __attribute__((ext_vector_type(4)));
template <class T> __device__ __forceinline__ auto dbgw_of(const T& s, int) -> decltype(s.dbgw) { return s.dbgw; }
template <class T> __device__ __forceinline__ unsigned* dbgw_of(const T&, long) { return nullptr; }
template <class Epi, class Sched, bool GATHER, int KE = 1024, bool FP8 = false>
__device__ __forceinline__ void gemm_phase(LAS unsigned char* lds, const Sched& S, const Epi& E) {
    int tid = threadIdx.x; asm volatile("" : "+v"(tid));
    const int wid = __builtin_amdgcn_readfirstlane(tid >> 6), lane = tid & 63, wr = wid >> 2, wc = wid & 3, fr = lane & 15, fq = lane >> 4;
    constexpr int K = KE, nt = K / BK;
    unsigned voffA[2], voffB[2]; int Rr[2], Cc[2];
#pragma unroll
    for (int i = 0; i < 2; ++i) { int R, C; stage_rc(tid * 16 + i * 8192, R, C); const int Rb = Epi::PERM ? ((R & ~31) + perm32(R & 31)) : R;
        voffA[i] = (unsigned)(R * K + C) * 2u; voffB[i] = (unsigned)(Rb * K + C) * 2u; Rr[i] = R; Cc[i] = C; }
    constexpr size_t kstep = (size_t)(BK * 2);
    constexpr size_t hstep = (size_t)HALF * K * 2;
    const unsigned ldsw = (unsigned)wid * 1024u;
    const int aoff = lds_byte(wr * 64 + fr, fq * 8), boff = lds_byte(wc * 32 + fr, fq * 8);
#define PG8_SA(b, h) (((b) * 2 + (h)) * HTB)
#define PG8_SB(b, h) ((4 + (b) * 2 + (h)) * HTB)
#define PG8_STAGE(bufoff, gbase, voff) do { _Pragma("unroll") for (int _i = 0; _i < 2; ++_i) \
        __builtin_amdgcn_global_load_lds((const unsigned*)((const char*)(gbase) + (voff)[_i]), (LAS unsigned*)(lds + (bufoff) + ldsw + _i * 8192), 16, 0, 0); } while (0)
#define PG8_STAGE_A(bufoff, gb, h, o0, o1) do { if constexpr (GATHER) { const unsigned _ko = (unsigned)((gb) - gA0); unsigned _o[2]; \
            if ((h) == 0) { _o[0] = (o0)[0] + _ko; _o[1] = (o0)[1] + _ko; } else { _o[0] = (o1)[0] + _ko; _o[1] = (o1)[1] + _ko; } PG8_STAGE(bufoff, gA0, _o); } \
        else { PG8_STAGE(bufoff, (gb) + (h) * hstep, voffA); } } while (0)
#define PG8_LD8(p) __builtin_shufflevector(*(const LAS i32x4v*)(p), *(const LAS i32x4v*)((p) + 1024), 0, 1, 2, 3, 4, 5, 6, 7)
#define PG8_LDA(dst, b, h) do { if constexpr (FP8) { _Pragma("unroll") for (int m = 0; m < 4; ++m) dst##8[m] = PG8_LD8(lds + PG8_SA(b, h) + aoff + m * 2048); } \
        else { _Pragma("unroll") for (int m = 0; m < 4; ++m) _Pragma("unroll") for (int k = 0; k < 2; ++k) dst[m][k] = *(const LAS bf16x8*)(lds + PG8_SA(b, h) + aoff + m * 2048 + k * 1024); } } while (0)
#define PG8_LDB(dst, b, h) do { if constexpr (FP8) { _Pragma("unroll") for (int n = 0; n < 2; ++n) dst##8[n] = PG8_LD8(lds + PG8_SB(b, h) + boff + n * 2048); } \
        else { _Pragma("unroll") for (int n = 0; n < 2; ++n) _Pragma("unroll") for (int k = 0; k < 2; ++k) dst[n][k] = *(const LAS bf16x8*)(lds + PG8_SB(b, h) + boff + n * 2048 + k * 1024); } } while (0)
#define PG8_MMA(ai, bj, At, Bt) do { __builtin_amdgcn_s_setprio(1); if constexpr (FP8) { _Pragma("unroll") for (int m = 0; m < 4; ++m) _Pragma("unroll") for (int n = 0; n < 2; ++n) \
            asm volatile("v_mfma_scale_f32_16x16x128_f8f6f4 %0, %1, %2, %0, %3, %3 op_sel_hi:[0,0,0]" : "+v"(acc[ai][bj][m][n]) : "v"(Bt##8[n]), "v"(At##8[m]), "v"(sc127)); } \
        else { _Pragma("unroll") for (int m = 0; m < 4; ++m) _Pragma("unroll") for (int n = 0; n < 2; ++n) _Pragma("unroll") for (int k = 0; k < 2; ++k) \
            acc[ai][bj][m][n] = __builtin_amdgcn_mfma_f32_16x16x32_bf16(Bt[n][k], At[m][k], acc[ai][bj][m][n], 0, 0, 0); } __builtin_amdgcn_s_setprio(0); } while (0)
#define PG8_WAIT_V(n) asm volatile("s_waitcnt vmcnt(" #n ")" ::: "memory")
#define PG8_WAIT_L(n) asm volatile("s_waitcnt lgkmcnt(" #n ")" ::: "memory")
#define PG8_BAR __builtin_amdgcn_s_barrier()
#define PG8_SCHED __builtin_amdgcn_sched_barrier(0)
    Unit cur, nxt; int ui = 0; unsigned long long kcsum = 0; int kcn = 0; const unsigned long long kph0 = (DBG_KCLK && !FP8 && !GATHER) ? __builtin_amdgcn_s_memtime() : 0ull;
    if (!S.next(0, cur)) return;
    f32x4 acc[2][2][4][2];
#pragma unroll
    for (int a = 0; a < 2; ++a)
#pragma unroll
        for (int b = 0; b < 2; ++b)
#pragma unroll
            for (int m = 0; m < 4; ++m)
#pragma unroll
                for (int n = 0; n < 2; ++n) acc[a][b][m][n] = (f32x4){0.f, 0.f, 0.f, 0.f};
    const int sc127 = 0x7f7f7f7f;
    bf16x8 At[4][2], B0[2][2], B1[2][2]; i32x8 At8[4], B08[2], B18[2];
    const char* cA = S.a_base(cur); const char* cB = S.b_base(cur);
    const char* const gA0 = cA;
    unsigned cv0[2] = {0u, 0u}, cv1[2] = {0u, 0u}, nv0[2] = {0u, 0u}, nv1[2] = {0u, 0u};
    if constexpr (GATHER) S.a_offs(cur, Rr, Cc, cv0, cv1);
    PG8_STAGE(PG8_SB(0, 0), cB, voffB); PG8_STAGE_A(PG8_SA(0, 0), cA, 0, cv0, cv1); PG8_STAGE(PG8_SB(0, 1), cB + hstep, voffB); PG8_STAGE_A(PG8_SA(0, 1), cA, 1, cv0, cv1);
    if (wr == 1) PG8_BAR;
    PG8_WAIT_V(4); PG8_BAR;
    PG8_STAGE(PG8_SB(1, 0), cB + kstep, voffB); PG8_STAGE_A(PG8_SA(1, 0), cA + kstep, 0, cv0, cv1); PG8_STAGE(PG8_SB(1, 1), cB + hstep + kstep, voffB);
    PG8_WAIT_V(6); PG8_BAR;
    for (;;) {
        const bool has_next = S.next(ui + 1, nxt);
        const char* nA = has_next ? S.a_base(nxt) : cA; const char* nB = has_next ? S.b_base(nxt) : cB;
        if constexpr (GATHER) { if (has_next) S.a_offs(nxt, Rr, Cc, nv0, nv1); else { nv0[0] = cv0[0]; nv0[1] = cv0[1]; nv1[0] = cv1[0]; nv1[1] = cv1[1]; } }
        unsigned long long kc0 = 0; if constexpr (DBG_KCLK && !FP8 && !GATHER) kc0 = __builtin_amdgcn_s_memtime();
#pragma nounroll
        for (int t = 0; t < nt; t += 2) {
            const bool last = (t == nt - 2);
            const char* a1 = cA + (size_t)(t + 1) * kstep;
            const char* a2 = last ? nA : cA + (size_t)(t + 2) * kstep; const char* b2 = last ? nB : cB + (size_t)(t + 2) * kstep;
            const char* a3 = a2 + kstep; const char* b3 = b2 + kstep;
            unsigned s0[2], s1[2];
            if constexpr (GATHER) { s0[0] = last ? nv0[0] : cv0[0]; s0[1] = last ? nv0[1] : cv0[1]; s1[0] = last ? nv1[0] : cv1[0]; s1[1] = last ? nv1[1] : cv1[1]; } else { s0[0] = s0[1] = s1[0] = s1[1] = 0u; }
            PG8_LDB(B0, 0, 0); PG8_SCHED; PG8_LDA(At, 0, 0); PG8_STAGE_A(PG8_SA(1, 1), a1, 1, cv0, cv1);
            PG8_WAIT_L(8); PG8_BAR; PG8_WAIT_L(0); PG8_MMA(0, 0, At, B0); PG8_BAR; PG8_SCHED;
            PG8_LDB(B1, 0, 1); PG8_STAGE(PG8_SB(0, 0), b2, voffB);
            PG8_BAR; PG8_WAIT_L(0); PG8_MMA(0, 1, At, B1); PG8_BAR;
            PG8_LDA(At, 0, 1); PG8_STAGE_A(PG8_SA(0, 0), a2, 0, s0, s1);
            PG8_BAR; PG8_WAIT_L(0); PG8_MMA(1, 0, At, B0); PG8_BAR; PG8_SCHED;
            PG8_STAGE(PG8_SB(0, 1), b2 + hstep, voffB);
            PG8_WAIT_V(6); PG8_BAR; PG8_MMA(1, 1, At, B1); PG8_BAR;
            PG8_LDB(B0, 1, 0); PG8_SCHED; PG8_LDA(At, 1, 0); PG8_STAGE_A(PG8_SA(0, 1), a2, 1, s0, s1);
            PG8_WAIT_L(8); PG8_BAR; PG8_WAIT_L(0); PG8_MMA(0, 0, At, B0); PG8_BAR; PG8_SCHED;
            PG8_LDB(B1, 1, 1); PG8_STAGE(PG8_SB(1, 0), b3, voffB);
            PG8_BAR; PG8_WAIT_L(0); PG8_MMA(0, 1, At, B1); PG8_BAR;
            PG8_LDA(At, 1, 1); PG8_STAGE_A(PG8_SA(1, 0), a3, 0, s0, s1);
            PG8_BAR; PG8_WAIT_L(0); PG8_MMA(1, 0, At, B0); PG8_BAR; PG8_SCHED;
            PG8_STAGE(PG8_SB(1, 1), b3 + hstep, voffB);
            PG8_WAIT_V(6); PG8_BAR; PG8_MMA(1, 1, At, B1); PG8_BAR;
        }
        if constexpr (DBG_KCLK && !FP8 && !GATHER) { kc0 = __builtin_amdgcn_s_memtime(); }
        if constexpr (FP8) asm volatile("s_nop 15\n\ts_nop 15" ::: "memory");
        E(acc, cur, wr, wc, fr, fq);
        if constexpr (DBG_KCLK && !FP8 && !GATHER) { asm volatile("s_waitcnt vmcnt(0)" ::: "memory"); kcsum += __builtin_amdgcn_s_memtime() - kc0; ++kcn; }
        if (!has_next) break;
#pragma unroll
        for (int a = 0; a < 2; ++a)
#pragma unroll
            for (int b = 0; b < 2; ++b)
#pragma unroll
                for (int m = 0; m < 4; ++m)
#pragma unroll
                    for (int n = 0; n < 2; ++n) acc[a][b][m][n] = (f32x4){0.f, 0.f, 0.f, 0.f};
        cur = nxt; cA = nA; cB = nB; ++ui;
        if constexpr (GATHER) { cv0[0] = nv0[0]; cv0[1] = nv0[1]; cv1[0] = nv1[0]; cv1[1] = nv1[1]; }
    }
    PG8_WAIT_V(0);
    if (wr == 0) PG8_BAR;
    PG8_BAR;
    if constexpr (DBG_KCLK && !FP8 && !GATHER) { unsigned* dw = dbgw_of(S, 0); if (dw && tid == 0) { kcsum = __builtin_amdgcn_s_memtime() - kph0; const float cpk = (float)kcsum / (float)(kcn) * (1.f / 40000.f); atomicMax(dw, __float_as_uint(powf(10.f, 2.f * (rintf(cpk * 10.f) * 0.1f) - 4.f))); } }
#undef PG8_SA
#undef PG8_SB
#undef PG8_STAGE
#undef PG8_STAGE_A
#undef PG8_LDA
#undef PG8_LDB
#undef PG8_MMA
#undef PG8_LD8
#undef PG8_WAIT_V
#undef PG8_WAIT_L
#undef PG8_BAR
#undef PG8_SCHED
}
}
using pg8::Unit;
typedef f32x4 AccT[2][2][4][2];

struct Args { const float* in[28]; float* out; unsigned char* ws; int ph_lo, ph_hi, pad0, pad1; };
struct Frame {
    LAS unsigned char* lds;
    int tid, lane, wave, G, bid;
    const struct Args* a;
    unsigned char* ws; unsigned char* outb;
};
template <int RB = 2048> struct SchedPlainT {
    pg8::StaticOrder o; const char* A; const char* Bt;
    __device__ __forceinline__ bool next(int i, Unit& u) const { return o.next(i, u); }
    __device__ __forceinline__ const char* a_base(const Unit& u) const { return A + (size_t)u.pm * (256 * RB); }
    __device__ __forceinline__ const char* b_base(const Unit& u) const { return Bt + (size_t)u.pn * (256 * RB); }
    __device__ __forceinline__ void a_offs(const Unit&, const int*, const int*, unsigned (&)[2], unsigned (&)[2]) const {}
};
typedef SchedPlainT<2048> SchedPlain;
template <int MODE> struct SchedProj {
    pg8::StaticOrder o; const char* A; const char* Bt; int fold = 0x7fffffff; unsigned* dbgw = nullptr;
    static constexpr int RB = MODE == 2 ? 1024 : 2048;
    __device__ __forceinline__ bool next(int i, Unit& u) const { if (!o.next(i, u)) return false; const int r = u.pn;
        if (MODE == 1) u.pn = 4 + r;
        if (MODE == 2) u.pn = r < 4 ? r : 15 + r;
        return true; }
    __device__ __forceinline__ const char* a_base(const Unit& u) const { return A + (size_t)(DBG_DRYPROJ ? (u.pm & fold) : u.pm) * (256 * RB); }
    __device__ __forceinline__ const char* b_base(const Unit& u) const { return Bt + (size_t)u.pn * (256 * RB); }
    __device__ __forceinline__ void a_offs(const Unit&, const int*, const int*, unsigned (&)[2], unsigned (&)[2]) const {}
};

struct EpiProj {
    static constexpr bool PERM = true;
    bf16_t *Q, *IQ, *Z, *XBC, *GA, *GB; float* MISC; float sc; int dry = 0;
    __device__ __forceinline__ void operator()(const AccT& acc, const Unit& u, int wr, int wc, int fr, int fq) const {
        const int pn = u.pn, row0 = u.pm * 256 + wr * 64 + fr, c8 = wc * 32 + 8 * fq;
        if (pn == 6) {
#pragma unroll
            for (int ai = 0; ai < 2; ++ai)
#pragma unroll
                for (int m = 0; m < 4; ++m) { float* rp = MISC + (size_t)(row0 + ai * 128 + m * 16) * 256 + c8;
#pragma unroll
                    for (int bj = 0; bj < 2; ++bj) { if (DBG_DRYPROJ && dry && acc[ai][bj][m][0][0] != 1.2345e-33f) continue; *(f32x4*)(rp + bj * 128) = acc[ai][bj][m][0]; *(f32x4*)(rp + bj * 128 + 4) = acc[ai][bj][m][1]; } }
            return;
        }
        bf16_t* base; int ldc, colt, act = 0;
        if (pn < 4) { base = Q; ldc = 1024; colt = pn * 256; }
        else if (pn < 6) { base = IQ; ldc = 512; colt = (pn - 4) * 256; }
        else if (pn < 11) { base = Z; ldc = 1024; colt = (pn - 7) * 256; act = 1; }
        else if (pn < 19) { base = XBC; ldc = 2048; colt = (pn - 11) * 256; }
        else if (pn < 23) { base = GA; ldc = 1024; colt = (pn - 19) * 256; act = 2; }
        else { base = GB; ldc = 1024; colt = (pn - 23) * 256; act = 2; }
#pragma unroll
        for (int ai = 0; ai < 2; ++ai)
#pragma unroll
            for (int m = 0; m < 4; ++m) { bf16_t* rp = base + (size_t)(row0 + ai * 128 + m * 16) * ldc + colt + c8;
#pragma unroll
                for (int bj = 0; bj < 2; ++bj) { f32x4 v0 = acc[ai][bj][m][0] * sc, v1 = acc[ai][bj][m][1] * sc;
                    if (act == 1) {
#pragma unroll
                        for (int j = 0; j < 4; ++j) { v0[j] = silu_f(v0[j]); v1[j] = silu_f(v1[j]); } }
                    if (act == 2) {
#pragma unroll
                        for (int j = 0; j < 4; ++j) { v0[j] = sigmoid_f(v0[j]); v1[j] = sigmoid_f(v1[j]); } }
                    u32x4 pk = pack8(v0, v1); if (DBG_IQ_TRUNC && (pn == 4 || pn == 5)) { pk.x &= 0xfff8fff8u; pk.y &= 0xfff8fff8u; pk.z &= 0xfff8fff8u; pk.w &= 0xfff8fff8u; }
                    if (DBG_DRYPROJ && dry && pk.x != 0x7fc17fc3u) continue;
                    *(u32x4*)(rp + bj * 128) = pk; } }
    }
};
template <int MODE> struct EpiGate {
    static constexpr bool PERM = true;
    const bf16_t* Gt; const bf16_t* T; bf16_t* O; float sc;
    __device__ __forceinline__ void operator()(const AccT& acc, const Unit& u, int wr, int wc, int fr, int fq) const {
        const int row0 = u.pm * 256 + wr * 64 + fr, c8 = u.pn * 256 + wc * 32 + 8 * fq;
#pragma unroll
        for (int ai = 0; ai < 2; ++ai) {
            u32x4 gq[4][2], tq[4][2];
#pragma unroll
            for (int m = 0; m < 4; ++m) { const size_t off = (size_t)(row0 + ai * 128 + m * 16) * 1024 + c8;
#pragma unroll
                for (int bj = 0; bj < 2; ++bj) { gq[m][bj] = *(const u32x4*)(Gt + off + bj * 128); if (MODE == 1) tq[m][bj] = *(const u32x4*)(T + off + bj * 128); } }
            SBAR();
#pragma unroll
            for (int m = 0; m < 4; ++m) { const size_t off = (size_t)(row0 + ai * 128 + m * 16) * 1024 + c8;
#pragma unroll
                for (int bj = 0; bj < 2; ++bj) { f32x4 g0, g1; unpack8(gq[m][bj], g0, g1);
                    f32x4 v0 = g0 * (acc[ai][bj][m][0] * sc), v1 = g1 * (acc[ai][bj][m][1] * sc);
                    if ((MODE == 0 && DBG_NO_ATTN) || (MODE == 1 && DBG_NO_SSD)) { v0 = (f32x4){0.f, 0.f, 0.f, 0.f}; v1 = v0; }
                    if (MODE == 1) { f32x4 t0, t1; unpack8(tq[m][bj], t0, t1); v0 += t0; v1 += t1; }
                    *(u32x4*)(O + off + bj * 128) = pack8(v0, v1); } }
            SBAR();
        }
    }
};
struct EpiOut {
    static constexpr bool PERM = false;
    const float* x; const float* mod; float* V;
    __device__ __forceinline__ void operator()(const AccT& acc, const Unit& u, int wr, int wc, int fr, int fq) const {
        const int row0 = u.pm * 256 + wr * 64 + fr, col0 = u.pn * 256 + wc * 32 + 4 * fq;
        const float* g1 = mod + (size_t)(u.pm >> 3) * 6144 + 2048 + col0;
        f32x4 gv[2][2];
#pragma unroll
        for (int bj = 0; bj < 2; ++bj)
#pragma unroll
            for (int n = 0; n < 2; ++n) gv[bj][n] = *(const f32x4*)(g1 + bj * 128 + n * 16);
#pragma unroll
        for (int ai = 0; ai < 2; ++ai)
#pragma unroll
            for (int mp = 0; mp < 2; ++mp) {
                f32x4 xv[2][2][2];
#pragma unroll
                for (int mm = 0; mm < 2; ++mm) { const size_t off = (size_t)(row0 + ai * 128 + (2 * mp + mm) * 16) * 1024 + col0;
#pragma unroll
                    for (int bj = 0; bj < 2; ++bj)
#pragma unroll
                        for (int n = 0; n < 2; ++n) xv[mm][bj][n] = *(const f32x4*)(x + off + bj * 128 + n * 16); }
                SBAR();
#pragma unroll
                for (int mm = 0; mm < 2; ++mm) { const int m = 2 * mp + mm; const size_t off = (size_t)(row0 + ai * 128 + m * 16) * 1024 + col0;
#pragma unroll
                    for (int bj = 0; bj < 2; ++bj)
#pragma unroll
                        for (int n = 0; n < 2; ++n) *(f32x4*)(V + off + bj * 128 + n * 16) = xv[mm][bj][n] * DN_ALPHA + gv[bj][n] * acc[ai][bj][m][n]; }
                SBAR();
            }
    }
};

struct MoeTab { LAS unsigned* cnt; LAS unsigned* tb; LAS unsigned char* te; int ntiles; };
__device__ __forceinline__ MoeTab moe_tables(Frame& F, int hf) {
    MoeTab T; T.cnt = (LAS unsigned*)(F.lds + LDS_AUX); T.tb = (LAS unsigned*)(F.lds + LDS_AUX + 256); T.te = (LAS unsigned char*)(F.lds + LDS_AUX + 512);
    const unsigned* CNT = (const unsigned*)(F.ws + WS_CTL) + CW_CNT;
    __syncthreads();
    if (F.tid < 32) { unsigned c = __hip_atomic_load(CNT + 64 * (hf * 32 + F.tid), __ATOMIC_RELAXED, __HIP_MEMORY_SCOPE_AGENT); if (c > (unsigned)REG_CAP) c = REG_CAP; T.cnt[F.tid] = c; }
    __syncthreads();
    if (F.tid == 0) { unsigned s = 0;
#pragma nounroll
        for (int e = 0; e < 32; ++e) { T.tb[e] = s; const unsigned n = (T.cnt[e] + 255u) >> 8;
#pragma nounroll
            for (unsigned t = 0; t < n; ++t) T.te[s + t] = (unsigned char)e;
            s += n; }
        T.tb[32] = s; }
    __syncthreads();
    T.ntiles = __builtin_amdgcn_readfirstlane((int)T.tb[32]);
    return T;
}
template <int NJ, bool GATHER> struct SchedMoe {
    MoeTab T; int G, c, hf; const char* A; const char* Bt; const u32x2* REG;
    __device__ __forceinline__ bool next(int i, Unit& u) const {
        int tile, j;
        if (G == 256) { const int x = c & 7, sl = c >> 3;
            tile = i * (256 / NJ) + x * (32 / NJ) + sl / NJ; j = sl % NJ;
            if (tile >= T.ntiles) return false; }
        else { const int L = i * G + c; if (L >= T.ntiles * NJ) return false; tile = L / NJ; j = L % NJ; }
        u.pm = tile; u.pn = j; u.ex = __builtin_amdgcn_readfirstlane((int)T.te[u.pm]); return true;
    }
    __device__ __forceinline__ const char* a_base(const Unit& u) const { return GATHER ? A : A + (size_t)u.pm * (256 * MOE_RB); }
    __device__ __forceinline__ const char* b_base(const Unit& u) const { return Bt + ((size_t)u.ex * (NJ * 256) + (size_t)u.pn * 256) * MOE_RB; }
    __device__ __forceinline__ void a_offs(const Unit& u, const int* R, const int* C, unsigned (&o0)[2], unsigned (&o1)[2]) const {
        const unsigned cnt = __builtin_amdgcn_readfirstlane(T.cnt[u.ex]), pos0 = ((unsigned)u.pm - (unsigned)__builtin_amdgcn_readfirstlane(T.tb[u.ex])) * 256u; const u32x2* rg = REG + ((size_t)hf * 32 + u.ex) * REG_CAP;
#pragma unroll
        for (int i = 0; i < 2; ++i) {
            const unsigned p0 = pos0 + (unsigned)R[i], p1 = p0 + 128u;
            unsigned t0 = 0u, t1 = 0u;
            if (p0 < cnt) t0 = (unsigned)hf * HALF_TOK + (rg[p0].x >> 2);
            if (p1 < cnt) t1 = (unsigned)hf * HALF_TOK + (rg[p1].x >> 2);
            o0[i] = t0 * (unsigned)MOE_RB + (unsigned)C[i] * 2u; o1[i] = t1 * (unsigned)MOE_RB + (unsigned)C[i] * 2u;
        }
    }
};
struct EpiMoe1 {
    static constexpr bool PERM = true;
    const float* b1; bf16_t* ACT; int dry;
    __device__ __forceinline__ void operator()(const AccT& acc, const Unit& u, int wr, int wc, int fr, int fq) const {
        if (dry) { if (acc[0][0][0][0][0] == 1.2345e-33f) ACT[0] = 1; return; }
        const int row0 = u.pm * 256 + wr * 64 + fr, c8 = u.pn * 128 + wc * 32 + 8 * fq;
        const float* bg = b1 + (size_t)u.ex * 2048 + c8;
        const f32x4 bg0 = *(const f32x4*)bg, bg1 = *(const f32x4*)(bg + 4), bu0 = *(const f32x4*)(bg + 1024), bu1 = *(const f32x4*)(bg + 1028);
#pragma unroll
        for (int ai = 0; ai < 2; ++ai)
#pragma unroll
            for (int m = 0; m < 4; ++m) {
                f32x4 g0 = acc[ai][0][m][0] * MOE_INV + bg0, g1 = acc[ai][0][m][1] * MOE_INV + bg1, u0 = acc[ai][1][m][0] * MOE_INV + bu0, u1 = acc[ai][1][m][1] * MOE_INV + bu1, a0, a1;
#pragma unroll
                for (int j = 0; j < 4; ++j) {
                    float g = fminf(g0[j], 7.0f), up = fminf(fmaxf(u0[j], -7.0f), 7.0f); a0[j] = (up + 1.0f) * g * sigmoid_f(1.702f * g);
                    g = fminf(g1[j], 7.0f); up = fminf(fmaxf(u1[j], -7.0f), 7.0f); a1[j] = (up + 1.0f) * g * sigmoid_f(1.702f * g); }
                if (MOE_FP8) *(u32x2*)((unsigned char*)ACT + (size_t)(row0 + ai * 128 + m * 16) * 1024 + c8) = pack8_fp8(a0, a1);
                else *(u32x4*)(ACT + (size_t)(row0 + ai * 128 + m * 16) * 1024 + c8) = pack8(a0, a1); }
    }
};
struct EpiMoe2 {
    static constexpr bool PERM = true;
    const float* b2; bf16_t* YB; const u32x2* REG; MoeTab T; int hf; int dry;
    __device__ __forceinline__ void operator()(const AccT& acc, const Unit& u, int wr, int wc, int fr, int fq) const {
        if (dry == 1) { if (acc[0][0][0][0][0] == 1.2345e-33f) YB[0] = 1; return; }
        if (dry >= 2) {
            const int c8d = (dry == 3 ? 0 : u.pn * 256) + wc * 32 + 8 * fq; const unsigned rowd = dry == 3 ? (blockIdx.x * 256u + (unsigned)(wr * 64 + fr)) : ((unsigned)u.pm * 256u + (unsigned)(wr * 64 + fr)) % 131072u;
#pragma unroll
            for (int ai = 0; ai < 2; ++ai)
#pragma unroll
                for (int m = 0; m < 4; ++m) { bf16_t* rp = YB + (size_t)((rowd + ai * 128 + m * 16) % 131072u) * 1024 + c8d;
#pragma unroll
                    for (int bj = 0; bj < 2; ++bj) *(u32x4*)(rp + bj * 128) = pack8(acc[ai][bj][m][0] * MOE_INV, acc[ai][bj][m][1] * MOE_INV); }
            return; }
        const int c8 = u.pn * 256 + wc * 32 + 8 * fq;
        const unsigned cnt = __builtin_amdgcn_readfirstlane(T.cnt[u.ex]), pos0 = ((unsigned)u.pm - (unsigned)__builtin_amdgcn_readfirstlane(T.tb[u.ex])) * 256u + (unsigned)(wr * 64 + fr); const u32x2* rg = REG + ((size_t)hf * 32 + u.ex) * REG_CAP;
        const float* bb = b2 + (size_t)u.ex * 1024 + c8;
        f32x4 bv[2][2];
#pragma unroll
        for (int bj = 0; bj < 2; ++bj) { bv[bj][0] = *(const f32x4*)(bb + bj * 128); bv[bj][1] = *(const f32x4*)(bb + bj * 128 + 4); }
        u32x2 en8[2][4];
#pragma unroll
        for (int ai = 0; ai < 2; ++ai)
#pragma unroll
            for (int m = 0; m < 4; ++m) { const unsigned p = pos0 + (unsigned)(ai * 128 + m * 16); en8[ai][m] = rg[p < cnt ? p : cnt - 1u]; }
#pragma unroll
        for (int ai = 0; ai < 2; ++ai)
#pragma unroll
            for (int m = 0; m < 4; ++m) { const unsigned p = pos0 + (unsigned)(ai * 128 + m * 16);
                const u32x2 en = en8[ai][m]; const float g = __uint_as_float(en.y); const unsigned drow = p < cnt ? en.x : (unsigned)(HALF_TOK * 4);
                bf16_t* rp = YB + (size_t)drow * 1024 + c8;
#pragma unroll
                for (int bj = 0; bj < 2; ++bj) *(u32x4*)(rp + bj * 128) = pack8((acc[ai][bj][m][0] * MOE_INV + bv[bj][0]) * g, (acc[ai][bj][m][1] * MOE_INV + bv[bj][1]) * g); }
    }
};

struct MapIdent { __device__ __forceinline__ int operator()(int n) const { return n; } };
struct MapWin { __device__ __forceinline__ int operator()(int n) const {
    if (n < 1024) return n;
    if (n < 1536) return 1152 + (n - 1024);
    if (n < 1792) { const int c = n - 1536; if (c < 128) return 1024 + c; if (c < 192) return 1664 + (c - 128); if (c < 200) return 1728 + (c - 192); if (c < 216) return 4808 + (c - 200); return -1; }
    if (n < 2816) return 1736 + (n - 1792);
    if (n < 4864) return 2760 + (n - 2816);
    if (n < 5888) return 4824 + (n - 4864);
    return 5848 + (n - 5888); } };
struct MapW1 { __device__ __forceinline__ int operator()(int r) const { const int j = r >> 8, rr = r & 255; return (rr >> 7) * 1024 + j * 128 + (rr & 127); } };
template <class Map, bool F8 = false> __device__ __forceinline__ void transpose_item(const float* W, int K, int N, bf16_t* WT, const Map& map, LAS float* scr, int kb, int nb, int lane, const float* rowscale) {
    const int k0 = 64 * kb, n0 = 64 * nb, q = lane & 15, kr = lane >> 4; const int src = map(n0 + 4 * q);
    f32x4 ld[16];
#pragma unroll
    for (int i = 0; i < 16; ++i) { const int kk = 4 * i + kr; ld[i] = (src >= 0) ? *(const f32x4*)(W + (size_t)(k0 + kk) * N + src) : (f32x4){0.f, 0.f, 0.f, 0.f}; }
#pragma unroll
    for (int i = 0; i < 16; ++i) { const int kk = 4 * i + kr; f32x4 v = ld[i]; if (rowscale) v = v * rowscale[k0 + kk]; LAS float* d = scr + kk * 65 + 4 * q; d[0] = v[0]; d[1] = v[1]; d[2] = v[2]; d[3] = v[3]; }
    LDS_WAIT(); asm volatile("" ::: "memory");
    const int c = lane & 7;
#pragma unroll
    for (int j = 0; j < 8; ++j) { const int n = (lane >> 3) + 8 * j; const LAS float* s = scr + (8 * c) * 65 + n;
        if constexpr (F8) { const f32x4 a = {s[0 * 65] * MOE_WSC, s[1 * 65] * MOE_WSC, s[2 * 65] * MOE_WSC, s[3 * 65] * MOE_WSC}, b = {s[4 * 65] * MOE_WSC, s[5 * 65] * MOE_WSC, s[6 * 65] * MOE_WSC, s[7 * 65] * MOE_WSC};
            *(u32x2*)((unsigned char*)WT + (size_t)(n0 + n) * K + k0 + 8 * c) = pack8_fp8(a, b); }
        else { u32x4 o; o.x = cvt_pk_bf16(s[0 * 65], s[1 * 65]); o.y = cvt_pk_bf16(s[2 * 65], s[3 * 65]); o.z = cvt_pk_bf16(s[4 * 65], s[5 * 65]); o.w = cvt_pk_bf16(s[6 * 65], s[7 * 65]);
            *(u32x4*)(WT + (size_t)(n0 + n) * K + k0 + 8 * c) = o; } }
    LDS_WAIT(); asm volatile("" ::: "memory");
}
struct TrItem { const float* W; const float* rowscale; unsigned char* WT; int N, src, k0, n0, f8; };
__device__ __forceinline__ TrItem tr_decode(Frame& F, int it) {
    constexpr int I_WIN = 16 * (NPROJ / 64), I_SQ = 16 * 16, I_W1E = 16 * 32, I_W2E = 16 * 16;
    TrItem d; d.rowscale = nullptr; int r = it, kb, nb; const int q4 = 4 * (F.lane & 15);
    if (r < (PROJ_FP8 ? 2 : 1) * I_WIN) { const int f8 = r >= I_WIN; if (f8) r -= I_WIN; kb = r / (NPROJ / 64); nb = r % (NPROJ / 64);
        d.W = F.a->in[4]; d.N = 6872; d.src = MapWin()(64 * nb + q4); d.WT = F.ws + (f8 ? WS_WIN8 : WS_WIN); d.f8 = f8; }
    else { r -= (PROJ_FP8 ? 2 : 1) * I_WIN;
        if (r < 3 * I_SQ) { const int w = r / I_SQ; r -= w * I_SQ; kb = r / 16; nb = r % 16; d.N = 1024; d.src = 64 * nb + q4;
            if (w == 0) { d.W = F.a->in[15]; d.WT = F.ws + (PA_FP8 ? WS_WPA8 : WS_WPA); d.f8 = PA_FP8; }
            else if (w == 1) { d.W = F.a->in[16]; d.WT = F.ws + (PB_FP8 ? WS_WPB8 : WS_WPB); d.f8 = PB_FP8; d.rowscale = F.a->in[14]; }
            else { d.W = F.a->in[17]; d.WT = F.ws + WS_WOUT; d.f8 = 0; } }
        else { r -= 3 * I_SQ;
            if (r < 32 * I_W1E) { const int e = r / I_W1E, q = r % I_W1E; kb = q / 32; nb = q % 32; d.W = F.a->in[22] + (size_t)e * 1024 * 2048; d.N = 2048; d.src = MapW1()(64 * nb + q4);
                d.WT = F.ws + WS_W1 + (size_t)e * 2048 * MOE_RB; d.f8 = MOE_FP8; }
            else { r -= 32 * I_W1E; const int e = r / I_W2E, q = r % I_W2E; kb = q / 16; nb = q % 16; d.W = F.a->in[24] + (size_t)e * 1024 * 1024; d.N = 1024; d.src = 64 * nb + q4;
                d.WT = F.ws + WS_W2 + (size_t)e * 1024 * MOE_RB; d.f8 = MOE_FP8; } } }
    d.k0 = 64 * kb; d.n0 = 64 * nb; return d; }
__device__ __forceinline__ void tr_load(const TrItem& d, f32x4 (&ld)[16], int lane) {
    const int kr = lane >> 4; const float* p = d.W + (size_t)(d.k0 + kr) * d.N + (d.src >= 0 ? d.src : 0);
#pragma unroll
    for (int i = 0; i < 16; ++i) ld[i] = __builtin_nontemporal_load((const f32x4*)(p + (size_t)(4 * i) * d.N)); }
__device__ __forceinline__ void tr_finish(const TrItem& d, f32x4 (&ld)[16], LAS float* scr, int lane) {
    const int q = lane & 15, kr = lane >> 4; const bool zero = d.src < 0;
#pragma unroll
    for (int i = 0; i < 16; ++i) { const int kk = 4 * i + kr; f32x4 v = ld[i]; if (zero) v = (f32x4){0.f, 0.f, 0.f, 0.f}; if (d.rowscale) v = v * d.rowscale[d.k0 + kk];
        LAS float* o = scr + kk * 65 + 4 * q; o[0] = v[0]; o[1] = v[1]; o[2] = v[2]; o[3] = v[3]; }
    LDS_WAIT(); asm volatile("" ::: "memory");
    const int c = lane & 7;
    if (d.f8) {
#pragma unroll
        for (int j = 0; j < 8; ++j) { const int n = (lane >> 3) + 8 * j; const LAS float* s = scr + (8 * c) * 65 + n;
            const f32x4 a = {s[0 * 65] * MOE_WSC, s[1 * 65] * MOE_WSC, s[2 * 65] * MOE_WSC, s[3 * 65] * MOE_WSC}, b = {s[4 * 65] * MOE_WSC, s[5 * 65] * MOE_WSC, s[6 * 65] * MOE_WSC, s[7 * 65] * MOE_WSC};
            *(u32x2*)((unsigned char*)d.WT + (size_t)(d.n0 + n) * 1024 + d.k0 + 8 * c) = pack8_fp8(a, b); } }
    else {
#pragma unroll
        for (int j = 0; j < 8; ++j) { const int n = (lane >> 3) + 8 * j; const LAS float* s = scr + (8 * c) * 65 + n;
            u32x4 o; o.x = cvt_pk_bf16(s[0 * 65], s[1 * 65]); o.y = cvt_pk_bf16(s[2 * 65], s[3 * 65]); o.z = cvt_pk_bf16(s[4 * 65], s[5 * 65]); o.w = cvt_pk_bf16(s[6 * 65], s[7 * 65]);
            *(u32x4*)((bf16_t*)d.WT + (size_t)(d.n0 + n) * 1024 + d.k0 + 8 * c) = o; } }
    LDS_WAIT(); asm volatile("" ::: "memory");
}
__device__ __forceinline__ void ph_prologue(Frame& F) {
    const float* c_in = F.a->in[1]; const float* w_mod = F.a->in[2]; const float* b_mod = F.a->in[3];
    float* MOD = (float*)(F.ws + WS_MOD);
    for (int item = F.bid; item < 192; item += F.G) {
        LAS float* SC = (LAS float*)F.lds;
        __syncthreads();
        for (int i = F.tid; i < 32768; i += NTHR) { const int b = i >> 10, k = i & 1023; SC[k * 36 + b] = silu_f(c_in[i]); }
        __syncthreads();
        const int col = item * 32 + (F.tid >> 4), kq = F.tid & 15;
        float a[32];
#pragma unroll
        for (int b = 0; b < 32; ++b) a[b] = 0.f;
#pragma nounroll
        for (int kg = 0; kg < 64; kg += 16) {
            float wv[16];
#pragma unroll
            for (int u = 0; u < 16; ++u) wv[u] = w_mod[(size_t)((kg + u) * 16 + kq) * 6144 + col];
#pragma unroll
            for (int u = 0; u < 16; ++u) { const int k = (kg + u) * 16 + kq; const float w = wv[u];
#pragma unroll
                for (int b4 = 0; b4 < 8; ++b4) { const f32x4 s = *(const LAS f32x4*)(SC + k * 36 + b4 * 4); a[b4 * 4 + 0] += w * s[0]; a[b4 * 4 + 1] += w * s[1]; a[b4 * 4 + 2] += w * s[2]; a[b4 * 4 + 3] += w * s[3]; } } }
#pragma unroll
        for (int b = 0; b < 32; ++b) { a[b] += __shfl_xor(a[b], 1); a[b] += __shfl_xor(a[b], 2); a[b] += __shfl_xor(a[b], 4); a[b] += __shfl_xor(a[b], 8); }
        { const float bm = b_mod[col];
#pragma unroll
            for (int b = 1; b < 16; ++b) { a[0] = (kq == b) ? a[b] : a[0]; a[16] = (kq == b) ? a[16 + b] : a[16]; }
            MOD[(size_t)kq * 6144 + col] = a[0] + bm; MOD[(size_t)(kq + 16) * 6144 + col] = a[16] + bm; }
        __syncthreads();
    }
    if (F.bid == (F.G > 192 ? 192 : 0)) {
        float* BT = (float*)(F.ws + WS_BIAST); const float* rel_bias = F.a->in[8];
        for (int i = F.tid; i < 249 * 8; i += NTHR) { const int idx = i >> 3, h = i & 7, rel = idx - 185; const int n = rel < 0 ? -rel : rel;
            const float nf = (float)(n > 1 ? n : 1); int large = 8 + (int)(logf(nf / 8.0f) / 2.7725887f * 8.0f); if (large > 15) large = 15;
            const int bucket = (rel > 0 ? 16 : 0) + (n < 8 ? n : large);
            BT[i] = rel_bias[bucket * 8 + h] * LOG2E; }
    }
    LAS float* scr = (LAS float*)(F.lds + F.wave * 16640);
    __syncthreads();
    const int gw = F.bid * NWAVES + F.wave, NGW = F.G * NWAVES;
    constexpr int I_WIN = 16 * (NPROJ / 64), I_SQ = 16 * 16, I_W1E = 16 * 32, I_W2E = 16 * 16;
    constexpr int NITEMS = (PROJ_FP8 ? 2 : 1) * I_WIN + 3 * I_SQ + 32 * I_W1E + 32 * I_W2E;
    TrItem d0, d1; f32x4 la[16], lb[16];
    int it = gw;
    if (it < NITEMS) { d0 = tr_decode(F, it); tr_load(d0, la, F.lane); }
    while (it < NITEMS) {
        const int i1 = it + NGW; const bool v1 = i1 < NITEMS;
        if (v1) { d1 = tr_decode(F, i1); tr_load(d1, lb, F.lane); }
        tr_finish(d0, la, scr, F.lane);
        if (!v1) break;
        const int i2 = i1 + NGW; const bool v2 = i2 < NITEMS;
        if (v2) { d0 = tr_decode(F, i2); tr_load(d0, la, F.lane); }
        tr_finish(d1, lb, scr, F.lane);
        it = i2;
    }
}

__device__ __forceinline__ void ln1_load(const float* x, int m0, int lane, f32x4 (&v)[4][4]) {
#pragma unroll
    for (int r = 0; r < 4; ++r) { const f32x4* xr = (const f32x4*)(x + (size_t)(m0 + r) * D) + lane;
#pragma unroll
        for (int j = 0; j < 4; ++j) v[r][j] = __builtin_nontemporal_load(xr + 64 * j); } }
__device__ __forceinline__ void ln1_proc(Frame& F, bf16_t* U, int m0, f32x4 (&v)[4][4], const f32x4 (&sh)[4], const f32x4 (&sc)[4]) {
#pragma unroll
    for (int r = 0; r < 4; ++r) { const int m = m0 + r;
        float s = 0.f;
#pragma unroll
        for (int j = 0; j < 4; ++j) s += (v[r][j][0] + v[r][j][1]) + (v[r][j][2] + v[r][j][3]);
        const float mean = wave_sum(s) * (1.f / D); float s2 = 0.f;
#pragma unroll
        for (int j = 0; j < 4; ++j) { v[r][j] = v[r][j] - mean; s2 += (v[r][j][0] * v[r][j][0] + v[r][j][1] * v[r][j][1]) + (v[r][j][2] * v[r][j][2] + v[r][j][3] * v[r][j][3]); }
        const float rstd = 1.f / sqrtf(wave_sum(s2) * (1.f / D) + LN_EPS);
        u32x2* o8 = (u32x2*)(U + (size_t)m * D) + F.lane;
#pragma unroll
        for (int j = 0; j < 4; ++j) {
            const f32x4 rr = v[r][j] * rstd * (sc[j] + 1.0f) + sh[j]; u32x2 w; w.x = cvt_pk_bf16(rr[0], rr[1]); w.y = cvt_pk_bf16(rr[2], rr[3]); o8[64 * j] = w;
            if (PROJ_FP8) { int pk = 0; pk = __builtin_amdgcn_cvt_pk_fp8_f32(rr[0], rr[1], pk, false); pk = __builtin_amdgcn_cvt_pk_fp8_f32(rr[2], rr[3], pk, true); ((unsigned*)(F.ws + WS_U8 + (size_t)m * D))[F.lane + 64 * j] = (unsigned)pk; } } } }
__device__ __forceinline__ void ph_ln1(Frame& F) {
    const float* x = F.a->in[0]; const float* MOD = (const float*)(F.ws + WS_MOD); bf16_t* U = (bf16_t*)(F.outb + OUT_U);
    const int gw = F.bid * NWAVES + F.wave, NGW = F.G * NWAVES;
    const int RPW = (((NTOK + NGW - 1) / NGW) + 3) & ~3;
    const int mbeg = gw * RPW, mend = (mbeg + RPW < NTOK) ? mbeg + RPW : NTOK;
    if (mbeg >= mend) return;
    f32x4 va[4][4], vb[4][4], sh[4], sc[4]; int curb = -1;
#define LN1_MOD(m0) do { const int bb = (m0) >> 11; if (bb != curb) { curb = bb; const float* md = MOD + (size_t)bb * 6144; \
        _Pragma("unroll") for (int j = 0; j < 4; ++j) { sh[j] = *((const f32x4*)md + F.lane + 64 * j); sc[j] = *((const f32x4*)(md + 1024) + F.lane + 64 * j); } } } while (0)
    int m0 = mbeg;
    ln1_load(x, m0, F.lane, va);
    for (;;) {
        const int m1 = m0 + 4; const bool v1 = m1 < mend;
        LN1_MOD(m0); if (v1) ln1_load(x, m1, F.lane, vb);
        ln1_proc(F, U, m0, va, sh, sc);
        if (!v1) break;
        const int m2 = m1 + 4; const bool v2 = m2 < mend;
        LN1_MOD(m1); if (v2) ln1_load(x, m2, F.lane, va);
        ln1_proc(F, U, m1, vb, sh, sc);
        if (!v2) break;
        m0 = m2;
    }
#undef LN1_MOD
}

__device__ __forceinline__ void misc_load(const float* MISC, int m0, int l, f32x4 (&v)[8]) {
#pragma unroll
    for (int r = 0; r < 8; ++r) v[r] = __builtin_nontemporal_load((const f32x4*)(MISC + (size_t)(m0 + r) * 256) + l); }
__device__ __forceinline__ void misc_proc(Frame& F, int m0, const f32x4 (&vv)[8], const f32x4& w1, const f32x4& w2) {
    bf16_t* KV = (bf16_t*)(F.outb + OUT_KV); bf16_t* IK = (bf16_t*)(F.outb + OUT_IK); float* IW = (float*)(F.outb + OUT_IW); float* DT = (float*)(F.outb + OUT_DT);
    const int l = F.lane;
#pragma unroll
    for (int r = 0; r < 8; ++r) { const int m = m0 + r;
        const f32x4 v = vv[r];
        const float sq = v[0] * v[0] + v[1] * v[1] + v[2] * v[2] + v[3] * v[3], sm = (v[0] + v[1]) + (v[2] + v[3]);
        const float kvss = wave_sum(l < 32 ? sq : 0.f);
        const float iks = wave_sum((l >= 32 && l < 48) ? sm : 0.f);
        const float ikmean = iks * (1.f / 64.f);
        const f32x4 dv = v - ikmean;
        const float ikq = wave_sum((l >= 32 && l < 48) ? (dv[0] * dv[0] + dv[1] * dv[1] + dv[2] * dv[2] + dv[3] * dv[3]) : 0.f);
        if (l < 32) { const float rr = 1.f / sqrtf(kvss * (1.f / 128.f) + LN_EPS); const f32x4 o = v * rr * w1;
            u32x2 pk; pk.x = cvt_pk_bf16(o[0], o[1]); pk.y = cvt_pk_bf16(o[2], o[3]); *((u32x2*)(KV + (size_t)m * 128) + l) = pk; }
        else if (l < 48) { const float rr = 1.f / sqrtf(ikq * (1.f / 64.f) + LN_EPS); const f32x4 o = dv * rr * w1 + w2;
            u32x2 pk; pk.x = cvt_pk_bf16(o[0], o[1]); pk.y = cvt_pk_bf16(o[2], o[3]); *((u32x2*)(IK + (size_t)m * 64) + (l - 32)) = pk; }
        else if (l < 50) { *((f32x4*)(IW + (size_t)m * 8) + (l - 48)) = v * 0.35355339059327373f; }
        else if (l < 54) { f32x4 o;
#pragma unroll
            for (int j = 0; j < 4; ++j) { const float t = v[j] + w1[j]; o[j] = t > 20.f ? t : log1pf(__expf(t)); }
            *((f32x4*)(DT + (size_t)m * 16) + (l - 50)) = o; }
    } }
__device__ __forceinline__ void ph_misc(Frame& F) {
    const float* MISC = (const float*)(F.outb + OUT_MISC);
    const float* kvw = F.a->in[5]; const float* ikw = F.a->in[6]; const float* ikb = F.a->in[7]; const float* dtb = F.a->in[11];
    const int gw = F.bid * NWAVES + F.wave, NGW = F.G * NWAVES, l = F.lane;
    const int RPW = (((NTOK + NGW - 1) / NGW) + 7) & ~7;
    const int mbeg = gw * RPW, mend = (mbeg + RPW < NTOK) ? mbeg + RPW : NTOK;
    if (mbeg >= mend) return;
    f32x4 w1 = (f32x4){0.f, 0.f, 0.f, 0.f}, w2 = w1;
    if (l < 32) w1 = *((const f32x4*)kvw + l); else if (l < 48) { w1 = *((const f32x4*)ikw + (l - 32)); w2 = *((const f32x4*)ikb + (l - 32)); } else if (l >= 50 && l < 54) w1 = *((const f32x4*)dtb + (l - 50));
    f32x4 va[8], vb[8];
    int m0 = mbeg;
    misc_load(MISC, m0, l, va);
    for (;;) {
        const int m1 = m0 + 8; const bool v1 = m1 < mend;
        if (v1) misc_load(MISC, m1, l, vb);
        misc_proc(F, m0, va, w1, w2);
        if (!v1) break;
        const int m2 = m1 + 8; const bool v2 = m2 < mend;
        if (v2) misc_load(MISC, m2, l, va);
        misc_proc(F, m1, vb, w1, w2);
        if (!v2) break;
        m0 = m2;
    }
}

__device__ __forceinline__ unsigned sortable_key(float s) { const unsigned u = __float_as_uint(s + 0.0f); return (u & 0x80000000u) ? ~u : (u | 0x80000000u); }
template <int NKB> struct KeyRow { unsigned k[NKB]; };
__device__ __forceinline__ u64 low_bits_keep(u64 m, int t) { u64 out = 0; while (t-- > 0 && m) { const u64 b = m & (0 - m); out |= b; m ^= b; } return out; }
namespace idx { constexpr int KST = 144, KBUF = 64 * KST; }
__device__ __forceinline__ unsigned low_bits_keep32(unsigned m, int t) { unsigned out = 0; while (t-- > 0 && m) { const unsigned b = m & (0u - m); out |= b; m ^= b; } return out; }
template <int NG> __device__ __forceinline__ void topk2_select_write(const unsigned (&key)[64], int nkb, u64* mrow, int lane) {
    constexpr int NR = NG * 16;
    unsigned T0 = 0u, T1 = 0u; bool ex0 = false, ex1 = false;
    unsigned lo0 = 0u, lo1 = 0u, hi0 = 0xFFFFFFFFu, hi1 = 0xFFFFFFFFu, st0, st1, p0, p1; bool fin0 = false, fin1 = false;
    { float sm = 0.f, sq = 0.f;
#pragma unroll
        for (int m = 0; m < 10; ++m) { const unsigned k = key[m]; const float f = __uint_as_float((k & 0x80000000u) ? (k ^ 0x80000000u) : ~k); sm += f; sq += f * f; }
#pragma unroll
        for (int o = 1; o < 32; o <<= 1) { sm += __shfl_xor(sm, o); sq += __shfl_xor(sq, o); }
        const float mu = sm * (1.f / 320.f), sd = sqrtf(fmaxf(sq * (1.f / 320.f) - mu * mu, 1e-20f));
        const float qq = 256.f / (64.f * (float)nkb), pp = qq < 0.5f ? qq : 1.f - qq, tt = sqrtf(-2.f * __logf(pp));
        float z = tt - (2.515517f + 0.802853f * tt + 0.010328f * tt * tt) / (1.f + 1.432788f * tt + 0.189269f * tt * tt + 0.001308f * tt * tt * tt); if (qq >= 0.5f) z = -z;
        const unsigned pe = sortable_key(mu + z * sd), pd = sortable_key(mu + z * sd + 0.125f * sd);
        unsigned stp = pd - pe; if (stp < 1024u) stp = 1024u;
        p0 = __builtin_amdgcn_readlane((int)pe, 0); p1 = __builtin_amdgcn_readlane((int)pe, 32); st0 = __builtin_amdgcn_readlane((int)stp, 0); st1 = __builtin_amdgcn_readlane((int)stp, 32); }
#pragma nounroll
    for (int it = 0; it < 80; ++it) {
        const unsigned candv = lane < 32 ? p0 : p1;
        unsigned cl = 0u;
#pragma unroll
        for (int m = 0; m < NR; m += 4) { u64 s0, s1, s2, s3;
            asm("v_cmp_ge_u32_e64 %1, %5, %9\n\tv_cmp_ge_u32_e64 %2, %6, %9\n\tv_cmp_ge_u32_e64 %3, %7, %9\n\tv_cmp_ge_u32_e64 %4, %8, %9\n\t"
                "v_addc_co_u32_e64 %0, %1, 0, %0, %1\n\tv_addc_co_u32_e64 %0, %2, 0, %0, %2\n\tv_addc_co_u32_e64 %0, %3, 0, %0, %3\n\tv_addc_co_u32_e64 %0, %4, 0, %0, %4"
                : "+v"(cl), "=&s"(s0), "=&s"(s1), "=&s"(s2), "=&s"(s3) : "v"(key[m]), "v"(key[m + 1]), "v"(key[m + 2]), "v"(key[m + 3]), "v"(candv)); }
        cl += __shfl_xor(cl, 1); cl += __shfl_xor(cl, 2); cl += __shfl_xor(cl, 4); cl += __shfl_xor(cl, 8); cl += __shfl_xor(cl, 16);
        const int n0 = __builtin_amdgcn_readlane((int)cl, 0), n1 = __builtin_amdgcn_readlane((int)cl, 32);
#define IDX_STEP(lo, hi, st, p, T, ex, fin, n) do { if (!fin) { \
            if (n == 256) { T = p; ex = true; fin = true; } \
            else { if (n > 256) lo = p; else hi = p; \
                if (hi - lo <= 1u) { T = lo; fin = true; } \
                else { unsigned c; if (hi == 0xFFFFFFFFu) { c = lo + st; if (c < lo) c = hi; st = st << 1; } else if (lo == 0u) { c = hi - st; if (c > hi) c = lo; st = st << 1; } else c = lo + ((hi - lo) >> 1); \
                    if (c <= lo || c >= hi) c = lo + ((hi - lo) >> 1); p = c; } } } } while (0)
        IDX_STEP(lo0, hi0, st0, p0, T0, ex0, fin0, n0);
        IDX_STEP(lo1, hi1, st1, p1, T1, ex1, fin1, n1);
#undef IDX_STEP
        if (fin0 && fin1) break;
    }
    const unsigned Tv = lane < 32 ? T0 : T1;
    if (ex0 && ex1) {
        unsigned mlo = 0u, mhi = 0u;
#pragma unroll
        for (int j = 0; j < NR / 2; ++j) {
            const u64 b0 = __ballot(key[2 * j] >= Tv), b1 = __ballot(key[2 * j + 1] >= Tv);
            asm volatile("s_nop 1\n\tv_writelane_b32 %0, %2, %6\n\tv_writelane_b32 %0, %3, %7\n\tv_writelane_b32 %1, %4, %6\n\tv_writelane_b32 %1, %5, %7"
                         : "+v"(mlo), "+v"(mhi) : "s"((unsigned)b0), "s"((unsigned)(b0 >> 32)), "s"((unsigned)b1), "s"((unsigned)(b1 >> 32)), "n"(j), "n"(32 + j));
            if ((j & 3) == 3) SBAR();
        }
        const int jl = lane & 31;
        if (jl < nkb) mrow[(lane >> 5) * 32 + jl] = (u64)mlo | ((u64)mhi << 32);
        return;
    }
    int rem0 = 1 << 30, rem1 = 1 << 30;
    { int g0 = 0, g1 = 0;
#pragma unroll
        for (int m = 0; m < NR; ++m) { const u64 mk = __ballot(key[m] > Tv); g0 += __builtin_popcount((unsigned)mk); g1 += __builtin_popcount((unsigned)(mk >> 32)); if ((m & 7) == 7) SBAR(); }
        if (!ex0) rem0 = 256 - g0; if (!ex1) rem1 = 256 - g1; }
    u64 mine = 0ull;
#pragma nounroll
    for (int jq = 0; jq < NR / 8; ++jq) {
#pragma unroll
        for (int jj = 0; jj < 4; ++jj) { const int j = jq * 4 + jj;
            unsigned w0[2], w1[2];
#pragma unroll
            for (int hh = 0; hh < 2; ++hh) { unsigned kv = 0u;
#pragma unroll
                for (int m = 0; m < NR; ++m) if ((m >> 3) == 0) {}
#pragma unroll
                for (int m = 0; m < NR; ++m) kv = (m == 2 * j + hh) ? key[m] : kv;
                const u64 gt = __ballot(kv > Tv), eq = __ballot(kv == Tv);
                { const unsigned e = (unsigned)eq, g = (unsigned)gt; const int ne = __builtin_popcount(e); unsigned sel = g; if (rem0 >= ne) { sel |= e; rem0 -= ne; } else if (rem0 > 0) { sel |= low_bits_keep32(e, rem0); rem0 = 0; } w0[hh] = sel; }
                { const unsigned e = (unsigned)(eq >> 32), g = (unsigned)(gt >> 32); const int ne = __builtin_popcount(e); unsigned sel = g; if (rem1 >= ne) { sel |= e; rem1 -= ne; } else if (rem1 > 0) { sel |= low_bits_keep32(e, rem1); rem1 = 0; } w1[hh] = sel; } }
            const u64 q0w = (u64)w0[0] | ((u64)w0[1] << 32), q1w = (u64)w1[0] | ((u64)w1[1] << 32);
            if (lane == j) mine = q0w; if (lane == 32 + j) mine = q1w; }
    }
    const int jl = lane & 31;
    if (jl < nkb) mrow[(lane >> 5) * 32 + jl] = mine;
}
template <int J0> __device__ __forceinline__ void index_scores8(unsigned (&key)[64], const bf16x8 (&af)[2], const f32x4& iw4, const bf16_t* kvsrc, char* lds, int nkb, u32x4 (&stg)[8], int tid) {
    const int lane = tid & 63, sub = lane & 15, kg = lane >> 4;
#pragma unroll
    for (int jj = 0; jj < 8; ++jj) {
        const int j = J0 + jj;
        if (j < nkb) {
            if (j + 1 < nkb) *(u32x4*)(lds + ((j + 1) & 1) * idx::KBUF + (tid >> 3) * idx::KST + (tid & 7) * 16) = stg[(jj + 1) & 7];
            if (j + 8 < nkb) stg[jj] = *(const u32x4*)(kvsrc + (size_t)(j + 8) * 64 * 64);
            const char* kb = lds + (j & 1) * idx::KBUF + sub * idx::KST + kg * 16;
#pragma unroll
            for (int pr = 0; pr < 2; ++pr) {
                f32x4 dA = (f32x4){0.f, 0.f, 0.f, 0.f}, dB = dA;
#pragma unroll
                for (int ks = 0; ks < 2; ++ks) {
                    const bf16x8 fA = *(const bf16x8*)(kb + (pr * 32) * idx::KST + ks * 64), fB = *(const bf16x8*)(kb + (pr * 32 + 16) * idx::KST + ks * 64);
                    dA = __builtin_amdgcn_mfma_f32_16x16x32_bf16(af[ks], fA, dA, 0, 0, 0); dB = __builtin_amdgcn_mfma_f32_16x16x32_bf16(af[ks], fB, dB, 0, 0, 0); }
                float pA = 0.f, pB = 0.f;
#pragma unroll
                for (int r = 0; r < 4; ++r) { pA += fmaxf(dA[r], 0.f) * iw4[r]; pB += fmaxf(dB[r], 0.f) * iw4[r]; }
                auto rr = __builtin_amdgcn_permlane16_swap(__float_as_uint(pA), __float_as_uint(pB), false, false);
                key[2 * j + pr] = sortable_key(__uint_as_float(rr[0]) + __uint_as_float(rr[1]));
            }
            __syncthreads();
        }
    }
}
__device__ __forceinline__ void ph_index(Frame& F) {
    const bf16_t* IQ = (const bf16_t*)(F.outb + OUT_IQ); const bf16_t* IK = (const bf16_t*)(F.outb + OUT_IK); const float* IW = (const float*)(F.outb + OUT_IW);
    u64* MASK = (u64*)(F.outb + OUT_MASK);
    char* lds = (char*)(unsigned char*)F.lds;
    const int tid = F.tid, lane = F.lane, sub = lane & 15, kg = lane >> 4;
    for (int item = F.bid; item < NTOK / 16; item += F.G) {
        const int tokw = (((item & 255) >> 3) << 11) + (((item & 7) + 8 * (item >> 8)) << 4) + F.wave * 2, b = tokw >> 11, pos0 = tokw & 2047, nkb = (pos0 >> 6) + 1;
        u64* mrow = MASK + (size_t)tokw * 32;
        if (nkb <= 4) { if ((lane & 31) < nkb) mrow[(lane >> 5) * 32 + (lane & 31)] = ~0ull; continue; }
        bf16x8 af[2];
        { const bf16_t* ap = IQ + (size_t)(tokw + (sub >> 3)) * 512 + (sub & 7) * 64 + kg * 8;
#pragma unroll
          for (int ks = 0; ks < 2; ++ks) af[ks] = *(const bf16x8*)(ap + ks * 32); }
        const f32x4 iw4 = *(const f32x4*)(IW + (size_t)(tokw + (lane >> 5)) * 8 + 4 * (kg & 1));
        unsigned key[64];
#pragma unroll
        for (int m = 0; m < 64; ++m) key[m] = 0u;
        const bf16_t* kvsrc = IK + ((size_t)b * SEQ + (tid >> 3)) * 64 + (tid & 7) * 8;
        u32x4 stg[8];
#pragma unroll
        for (int i = 0; i < 8; ++i) stg[i] = (i < nkb) ? *(const u32x4*)(kvsrc + (size_t)i * 64 * 64) : (u32x4){0u, 0u, 0u, 0u};
        __syncthreads();
        *(u32x4*)(lds + (tid >> 3) * idx::KST + (tid & 7) * 16) = stg[0];
        __syncthreads();
        const int ng = (nkb + 7) >> 3;
        index_scores8<0>(key, af, iw4, kvsrc, lds, nkb, stg, tid);
        if (ng > 1) index_scores8<8>(key, af, iw4, kvsrc, lds, nkb, stg, tid);
        if (ng > 2) index_scores8<16>(key, af, iw4, kvsrc, lds, nkb, stg, tid);
        if (ng > 3) index_scores8<24>(key, af, iw4, kvsrc, lds, nkb, stg, tid);
        if (ng == 1) topk2_select_write<1>(key, nkb, mrow, lane);
        else if (ng == 2) topk2_select_write<2>(key, nkb, mrow, lane);
        else if (ng == 3) topk2_select_write<3>(key, nkb, mrow, lane);
        else topk2_select_write<4>(key, nkb, mrow, lane);
    }
}

namespace att {
constexpr int KVBLK = 64;
constexpr int SHM_V = KVBLK * 128 * 2, SHM_K = SHM_V;
constexpr int OFF_V = 0, OFF_K = 2 * SHM_V, OFF_WS = 2 * SHM_V + 2 * SHM_K, OFF_BT = OFF_WS + NWAVES * 64 * 4;
constexpr int OFF_OT = 81920, OT_ST = 144;
#define KSWZ(row, colB) ((row) * 256 + ((colB) ^ (((row) & 7) << 4)))
__device__ __forceinline__ int crow(int r, int hi) { return (r & 3) + 8 * (r >> 2) + 4 * hi; }
__device__ __forceinline__ int v_st(int k, int c) { const int kk = (k & ~0xC) | ((k & 4) << 1) | ((k & 8) >> 1); return ((kk >> 3) * 4 + (c >> 5)) * 512 + ((kk & 7) * 32 + (c & 31)) * 2; }
__device__ __forceinline__ int v_rd_base(int lane) { return ((lane & 3) << 3) | (((lane >> 2) & 3) << 6) | (((lane >> 4) & 1) << 5) | (((lane >> 5) & 1) << 8); }
constexpr int v_rd_off(int d0, int ks, int half) { return d0 * 512 + ks * 4096 + half * 2048; }
template <int OFF> __device__ __forceinline__ s16x4 tr_read(int vb) { s16x4 r; asm volatile("ds_read_b64_tr_b16 %0, %1 offset:%2" : "=&v"(r) : "v"(vb), "i"(OFF) : "memory"); return r; }
template <int D0> __device__ __forceinline__ void pv_one(f32x16& od, int vb, bf16x8 pa0, bf16x8 pa1, bf16x8 pa2, bf16x8 pa3) {
    const s16x4 l0 = tr_read<v_rd_off(D0, 0, 0)>(vb), h0 = tr_read<v_rd_off(D0, 0, 1)>(vb), l1 = tr_read<v_rd_off(D0, 1, 0)>(vb), h1 = tr_read<v_rd_off(D0, 1, 1)>(vb);
    const s16x4 l2 = tr_read<v_rd_off(D0, 2, 0)>(vb), h2 = tr_read<v_rd_off(D0, 2, 1)>(vb), l3 = tr_read<v_rd_off(D0, 3, 0)>(vb), h3 = tr_read<v_rd_off(D0, 3, 1)>(vb);
    asm volatile("s_waitcnt lgkmcnt(0)" ::: "memory"); SBAR();
#define PK(L, H) (bf16x8){L[0], L[1], L[2], L[3], H[0], H[1], H[2], H[3]}
    od = __builtin_amdgcn_mfma_f32_32x32x16_bf16(pa0, PK(l0, h0), od, 0, 0, 0);
    od = __builtin_amdgcn_mfma_f32_32x32x16_bf16(pa1, PK(l1, h1), od, 0, 0, 0);
    od = __builtin_amdgcn_mfma_f32_32x32x16_bf16(pa2, PK(l2, h2), od, 0, 0, 0);
    od = __builtin_amdgcn_mfma_f32_32x32x16_bf16(pa3, PK(l3, h3), od, 0, 0, 0);
#undef PK
}
__device__ __forceinline__ void qkt(f32x16& p0, f32x16& p1, const char* Ks, const bf16x8* qr, int r32, int hi) {
    p0 = f32x16{}; p1 = f32x16{};
    int rv = r32; asm volatile("" : "+v"(rv));
    const char* kb = Ks + rv * 256; const int swz = ((rv & 7) << 4) ^ (hi * 16);
#pragma unroll
    for (int d0 = 0; d0 < 8; ++d0) { const char* ka = kb + ((d0 * 32) ^ swz);
        const bf16x8 b0 = *reinterpret_cast<const bf16x8*>(ka);
        const bf16x8 b1 = *reinterpret_cast<const bf16x8*>(ka + 8192);
        p0 = __builtin_amdgcn_mfma_f32_32x32x16_bf16(b0, qr[d0], p0, 0, 0, 0);
        p1 = __builtin_amdgcn_mfma_f32_32x32x16_bf16(b1, qr[d0], p1, 0, 0, 0); }
}
__device__ __forceinline__ void attn_item(Frame& F, int b, int q0, char* lds) {
    const bf16_t* Q = (const bf16_t*)(F.ws + WS_Q); const bf16_t* KV = (const bf16_t*)(F.outb + OUT_KV); const u64* MASK = (const u64*)(F.outb + OUT_MASK);
    bf16_t* OA = (bf16_t*)(F.outb + OUT_OA);
    int tid = F.tid; asm volatile("" : "+v"(tid));
    const int wid = F.wave, lane = tid & 63, r32 = lane & 31, hi = lane >> 5;
    char* V_lds = lds + OFF_V; char* K_lds = lds + OFF_K;
    float* wsl = (float*)(lds + OFF_WS) + wid * 64; float* li_l = wsl; float* al_l = wsl + 32;
    const float* btab = (const float*)(lds + OFF_BT);
    constexpr float C = 0.088388347648318440f * LOG2E;
    float m_reg = -1e30f, l_reg = 0.f; f32x16 o[4] = {}; bf16x8 qr[8];
    const size_t tokq = (size_t)b * SEQ + q0 + r32;
    { const bf16_t* Qw = Q + tokq * 1024 + wid * 128 + hi * 8;
#pragma unroll
      for (int d0 = 0; d0 < 8; ++d0) qr[d0] = *(const bf16x8*)(Qw + d0 * 16); }
    const u64* mq = MASK + tokq * 32;
    const int sr = tid >> 4, sc = (tid & 15) * 8;
    const int vb0 = (int)(uintptr_t)V_lds + v_rd_base(lane);
    const bf16_t* Kb = KV + (size_t)b * SEQ * 128;
    const int NT = (q0 >> 6) + 1;
    const float bfar = btab[wid];
    bf16x8 s0, s1;
#define SLOAD(k0) do { s0 = *(const bf16x8*)(Kb + (size_t)((k0) + sr) * 128 + sc); s1 = *(const bf16x8*)(Kb + (size_t)((k0) + 32 + sr) * 128 + sc); } while (0)
#define SWRITE(bf) do { int srv = sr; asm volatile("" : "+v"(srv)); const int kc = sc * 2; const int v0a = v_st(srv, sc), k0a = KSWZ(srv, kc); \
        *(bf16x8*)(V_lds + (bf) * SHM_V + v0a) = s0; *(bf16x8*)(V_lds + (bf) * SHM_V + v0a + 8192) = s1; \
        *(bf16x8*)(K_lds + (bf) * SHM_K + k0a) = s0; *(bf16x8*)(K_lds + (bf) * SHM_K + k0a + 8192) = s1; } while (0)
    __syncthreads();
    SLOAD(0); VM_WAIT(); SWRITE(0); __syncthreads();
    u64 mw_next = mq[0];
    for (int j = 0; j < NT; ++j) {
        int lanel = lane; asm volatile("" : "+v"(lanel)); const int r32l = lanel & 31, hil = lanel >> 5;
        const int bf = j & 1;
        if (j + 1 < NT) SLOAD((j + 1) * KVBLK);
        const u64 mw = mw_next; if (j + 1 < NT) mw_next = mq[j + 1];
        f32x16 p0, p1;
        qkt(p0, p1, K_lds + bf * SHM_K, qr, r32l, hil);
        const unsigned w0 = (unsigned)(mw >> (4 * hil)), w1 = (unsigned)(mw >> (32 + 4 * hil));
        const int relmax = j * KVBLK + 63 - q0;
        float alpha = 1.f, ps = 0.f;
        if (relmax <= -91) {
            float pmax = p0[0];
#pragma unroll
            for (int r = 1; r < 16; ++r) pmax = fmaxf(pmax, p0[r]);
#pragma unroll
            for (int r = 0; r < 16; ++r) pmax = fmaxf(pmax, p1[r]);
            { auto rr = __builtin_amdgcn_permlane32_swap(__float_as_uint(pmax), __float_as_uint(pmax), false, false); pmax = fmaxf(__uint_as_float(rr[0]), __uint_as_float(rr[1])); }
            pmax = fmaf(pmax, C, bfar);
            if (!__all(pmax - m_reg <= 11.0f)) { const float mn = fmaxf(m_reg, pmax); alpha = __builtin_amdgcn_exp2f(m_reg - mn); m_reg = mn; }
            const float off = bfar - m_reg;
#pragma unroll
            for (int r = 0; r < 16; ++r) { const int cb = (r & 3) + 8 * (r >> 2);
                const float e0 = __builtin_amdgcn_exp2f(fmaf(p0[r], C, off)), e1 = __builtin_amdgcn_exp2f(fmaf(p1[r], C, off));
                p0[r] = __uint_as_float(__float_as_uint(e0) & (unsigned)__builtin_amdgcn_sbfe((int)w0, cb, 1)); p1[r] = __uint_as_float(__float_as_uint(e1) & (unsigned)__builtin_amdgcn_sbfe((int)w1, cb, 1)); ps += p0[r] + p1[r]; }
        } else {
            const float* bp = btab + (j * KVBLK + 4 * hil - (q0 + r32l) + 185) * 8 + wid;
#pragma unroll
            for (int r4 = 0; r4 < 4; ++r4) {
#pragma unroll
                for (int rr = 0; rr < 4; ++rr) { const int r = r4 * 4 + rr; const int cb = (r & 3) + 8 * (r >> 2); p0[r] = fmaf(p0[r], C, bp[cb * 8]); p1[r] = fmaf(p1[r], C, bp[(cb + 32) * 8]); }
                SBAR(); }
            float pmax = p0[0];
#pragma unroll
            for (int r = 1; r < 16; ++r) pmax = fmaxf(pmax, p0[r]);
#pragma unroll
            for (int r = 0; r < 16; ++r) pmax = fmaxf(pmax, p1[r]);
            { auto rr = __builtin_amdgcn_permlane32_swap(__float_as_uint(pmax), __float_as_uint(pmax), false, false); pmax = fmaxf(__uint_as_float(rr[0]), __uint_as_float(rr[1])); }
            if (!__all(pmax - m_reg <= 11.0f)) { const float mn = fmaxf(m_reg, pmax); alpha = __builtin_amdgcn_exp2f(m_reg - mn); m_reg = mn; }
#pragma unroll
            for (int r = 0; r < 16; ++r) { const int cb = (r & 3) + 8 * (r >> 2);
                const float e0 = __builtin_amdgcn_exp2f(p0[r] - m_reg), e1 = __builtin_amdgcn_exp2f(p1[r] - m_reg);
                p0[r] = __uint_as_float(__float_as_uint(e0) & (unsigned)__builtin_amdgcn_sbfe((int)w0, cb, 1)); p1[r] = __uint_as_float(__float_as_uint(e1) & (unsigned)__builtin_amdgcn_sbfe((int)w1, cb, 1)); ps += p0[r] + p1[r]; }
        }
        { auto rr = __builtin_amdgcn_permlane32_swap(__float_as_uint(ps), __float_as_uint(ps), false, false); ps = __uint_as_float(rr[0]) + __uint_as_float(rr[1]); }
        l_reg = l_reg * alpha + ps;
        bf16x8 pa0, pa1, pa2, pa3;
#define PK4(P, BASE, OUT) do { unsigned a0 = cvt_pk_bf16(P[BASE + 0], P[BASE + 1]), a1 = cvt_pk_bf16(P[BASE + 2], P[BASE + 3]);   \
    unsigned b0 = cvt_pk_bf16(P[BASE + 4], P[BASE + 5]), b1 = cvt_pk_bf16(P[BASE + 6], P[BASE + 7]);                              \
    auto r0 = __builtin_amdgcn_permlane32_swap(a0, b0, false, false); auto r1 = __builtin_amdgcn_permlane32_swap(a1, b1, false, false); \
    u32x4 w = {r0[0], r1[0], r0[1], r1[1]}; OUT = *reinterpret_cast<bf16x8*>(&w); } while (0)
        PK4(p0, 0, pa0); PK4(p0, 8, pa1); PK4(p1, 0, pa2); PK4(p1, 8, pa3);
#undef PK4
        if (__any(alpha < 1.f)) { if (hil == 0) al_l[r32l] = alpha; LDS_WAIT();
#pragma unroll
            for (int d = 0; d < 4; ++d)
#pragma unroll
                for (int r = 0; r < 16; ++r) o[d][r] *= al_l[crow(r, hil)]; }
        const int vb = (int)(uintptr_t)V_lds + v_rd_base(lanel) + bf * SHM_V;
        pv_one<0>(o[0], vb, pa0, pa1, pa2, pa3); pv_one<1>(o[1], vb, pa0, pa1, pa2, pa3); pv_one<2>(o[2], vb, pa0, pa1, pa2, pa3); pv_one<3>(o[3], vb, pa0, pa1, pa2, pa3);
        if (j + 1 < NT) { VM_WAIT(); SWRITE(bf ^ 1); }
        __syncthreads();
    }
#undef SLOAD
#undef SWRITE
    if (hi == 0) li_l[r32] = l_reg; LDS_WAIT();
    bf16_t* Ow = OA + ((size_t)b * SEQ + q0 + 4 * hi) * 1024 + wid * 128 + r32;
    const float* lip = li_l + 4 * hi;
    unsigned char* Ow8 = (unsigned char*)OA + ((size_t)b * SEQ + q0 + 4 * hi) * 1024 + wid * 128 + r32;
    asm volatile("" : "+v"(Ow), "+v"(lip), "+v"(Ow8));
#pragma unroll
    for (int r = 0; r < 16; ++r) { const int ro = (r & 3) + 8 * (r >> 2); if ((r & 3) == 0) asm volatile("" : "+v"(Ow), "+v"(Ow8), "+v"(lip)); const float rl = fast_rcp(lip[ro]);
#pragma unroll
        for (int d0 = 0; d0 < 4; ++d0) { float v = o[d0][r] * rl; if ((DBG_ATTN_ZERO == 1 && q0 < 256) || (DBG_ATTN_ZERO == 2 && q0 >= 256)) v = 0.f;
            if (PA_FP8) ((unsigned char*)Ow8)[ro * 1024 + d0 * 32] = (unsigned char)(__builtin_amdgcn_cvt_pk_fp8_f32(v, v, 0, false) & 0xff);
            else Ow[ro * 1024 + d0 * 32] = (bf16_t)(cvt_pk_bf16(v, v) & 0xffffu); }
        if ((r & 3) == 3) SBAR(); }
}
__device__ __forceinline__ void att2_partial(f32x16& p0, f32x16& p1, float& m_reg, float& alpha, unsigned w0, bool far, float bfar, const float* bp) {
    constexpr float C = 0.088388347648318440f * LOG2E;
    float off;
    if (far) {
        float pmax = p0[0];
#pragma unroll
        for (int r = 1; r < 16; ++r) pmax = fmaxf(pmax, p0[r]);
#pragma unroll
        for (int r = 0; r < 16; ++r) pmax = fmaxf(pmax, p1[r]);
        { auto rr = __builtin_amdgcn_permlane32_swap(__float_as_uint(pmax), __float_as_uint(pmax), false, false); pmax = fmaxf(__uint_as_float(rr[0]), __uint_as_float(rr[1])); }
        pmax = fmaf(pmax, C, bfar);
        if (__builtin_expect(__all(pmax - m_reg <= 11.0f), 1)) alpha = 1.f; else { const float mn = fmaxf(m_reg, pmax); alpha = __builtin_amdgcn_exp2f(m_reg - mn); m_reg = mn; }
        off = bfar - m_reg;
#pragma unroll
        for (int r = 0; r < 16; ++r) { p0[r] = fmaf(p0[r], C, off); p1[r] = fmaf(p1[r], C, off); }
    } else {
#pragma unroll
        for (int r4 = 0; r4 < 4; ++r4) {
#pragma unroll
            for (int rr = 0; rr < 4; ++rr) { const int r = r4 * 4 + rr; const int cb = (r & 3) + 8 * (r >> 2); p0[r] = fmaf(p0[r], C, bp[cb * 8]); p1[r] = fmaf(p1[r], C, bp[(cb + 32) * 8]); }
            SBAR(); }
        float pmax = p0[0];
#pragma unroll
        for (int r = 1; r < 16; ++r) pmax = fmaxf(pmax, p0[r]);
#pragma unroll
        for (int r = 0; r < 16; ++r) pmax = fmaxf(pmax, p1[r]);
        { auto rr = __builtin_amdgcn_permlane32_swap(__float_as_uint(pmax), __float_as_uint(pmax), false, false); pmax = fmaxf(__uint_as_float(rr[0]), __uint_as_float(rr[1])); }
        if (__builtin_expect(__all(pmax - m_reg <= 11.0f), 1)) alpha = 1.f; else { const float mn = fmaxf(m_reg, pmax); alpha = __builtin_amdgcn_exp2f(m_reg - mn); m_reg = mn; }
#pragma unroll
        for (int r = 0; r < 16; ++r) { p0[r] -= m_reg; p1[r] -= m_reg; }
    }
#pragma unroll
    for (int r = 0; r < 16; ++r) { const int cb = (r & 3) + 8 * (r >> 2); p0[r] = __uint_as_float(__float_as_uint(__builtin_amdgcn_exp2f(p0[r])) & (unsigned)__builtin_amdgcn_sbfe((int)w0, cb, 1)); }
}
__device__ __forceinline__ void att2_finish(f32x16& p0, f32x16& p1, float alpha, float& l_reg, unsigned w1, bf16x8& pa0, bf16x8& pa1, bf16x8& pa2, bf16x8& pa3) {
#pragma unroll
    for (int r = 0; r < 16; ++r) { const int cb = (r & 3) + 8 * (r >> 2); p1[r] = __uint_as_float(__float_as_uint(__builtin_amdgcn_exp2f(p1[r])) & (unsigned)__builtin_amdgcn_sbfe((int)w1, cb, 1)); }
    float ps = 0.f;
#pragma unroll
    for (int r = 0; r < 16; ++r) ps += p0[r];
#pragma unroll
    for (int r = 0; r < 16; ++r) ps += p1[r];
    { auto rr = __builtin_amdgcn_permlane32_swap(__float_as_uint(ps), __float_as_uint(ps), false, false); ps = __uint_as_float(rr[0]) + __uint_as_float(rr[1]); }
    l_reg = l_reg * alpha + ps;
#define PK4(P, BASE, OUT) do { unsigned a0 = cvt_pk_bf16(P[BASE + 0], P[BASE + 1]), a1 = cvt_pk_bf16(P[BASE + 2], P[BASE + 3]);   \
    unsigned b0 = cvt_pk_bf16(P[BASE + 4], P[BASE + 5]), b1 = cvt_pk_bf16(P[BASE + 6], P[BASE + 7]);                              \
    auto r0 = __builtin_amdgcn_permlane32_swap(a0, b0, false, false); auto r1 = __builtin_amdgcn_permlane32_swap(a1, b1, false, false); \
    u32x4 w = {r0[0], r1[0], r0[1], r1[1]}; OUT = *reinterpret_cast<bf16x8*>(&w); } while (0)
    PK4(p0, 0, pa0); PK4(p0, 8, pa1); PK4(p1, 0, pa2); PK4(p1, 8, pa3);
#undef PK4
}
__device__ __forceinline__ void attn_item2(Frame& F, int b, int q0, char* lds) {
    const bf16_t* Q = (const bf16_t*)(F.ws + WS_Q); const bf16_t* KV = (const bf16_t*)(F.outb + OUT_KV); const u64* MASK = (const u64*)(F.outb + OUT_MASK);
    bf16_t* OA = (bf16_t*)(F.outb + OUT_OA);
    int tid = F.tid; asm volatile("" : "+v"(tid));
    const int wid = F.wave, lane = tid & 63, r32 = lane & 31, hi = lane >> 5;
    char* V_lds = lds + OFF_V; char* K_lds = lds + OFF_K;
    float* wsl = (float*)(lds + OFF_WS) + wid * 64; float* li_l = wsl; float* al_l = wsl + 32;
    const float* btab = (const float*)(lds + OFF_BT);
    float m_reg = -1e30f, l_reg = 0.f; f32x16 o[4] = {}; bf16x8 qr[8];
    const size_t tokq = (size_t)b * SEQ + q0 + r32;
    { const bf16_t* Qw = Q + tokq * 1024 + wid * 128 + hi * 8;
#pragma unroll
      for (int d0 = 0; d0 < 8; ++d0) qr[d0] = *(const bf16x8*)(Qw + d0 * 16); }
    const u64* mq = MASK + tokq * 32;
    const int sr = tid >> 4, sc = (tid & 15) * 8;
    const bf16_t* Kb = KV + (size_t)b * SEQ * 128;
    const int NTr = (q0 >> 6) + 1, NT = (NTr + 1) & ~1;
    const float bfar = btab[wid];
    bf16x8 sA0, sA1, sB0, sB1;
#define SLD(s0_, s1_, k0) do { int srl = sr; asm volatile("" : "+v"(srl)); const bf16_t* kp_ = Kb + (size_t)((k0) + srl) * 128 + sc; s0_ = *(const bf16x8*)kp_; s1_ = *(const bf16x8*)(kp_ + 32 * 128); } while (0)
#define SWR(bf, s0_, s1_) do { int srv = sr; asm volatile("" : "+v"(srv)); const int kc = sc * 2; const int v0a = v_st(srv, sc), k0a = KSWZ(srv, kc); \
        *(bf16x8*)(V_lds + (bf) * SHM_V + v0a) = s0_; *(bf16x8*)(V_lds + (bf) * SHM_V + v0a + 8192) = s1_; \
        *(bf16x8*)(K_lds + (bf) * SHM_K + k0a) = s0_; *(bf16x8*)(K_lds + (bf) * SHM_K + k0a + 8192) = s1_; } while (0)
#define MWORD(j) ((j) < NTr ? mq[j] : 0ull)
#define RESC(a) do { if (__any((a) < 1.f)) { if (hi == 0) al_l[r32] = (a); LDS_WAIT(); \
        _Pragma("unroll") for (int d = 0; d < 4; ++d) _Pragma("unroll") for (int r = 0; r < 16; ++r) o[d][r] *= al_l[crow(r, hi)]; } } while (0)
#define PVALL(bf) do { int ll = lane; asm volatile("" : "+v"(ll)); const int vb = (int)(uintptr_t)V_lds + v_rd_base(ll) + (bf) * SHM_V; \
        pv_one<0>(o[0], vb, pa0, pa1, pa2, pa3); pv_one<1>(o[1], vb, pa0, pa1, pa2, pa3); pv_one<2>(o[2], vb, pa0, pa1, pa2, pa3); pv_one<3>(o[3], vb, pa0, pa1, pa2, pa3); } while (0)
#define ISFAR(jt) ((jt) * KVBLK + 63 - q0 <= -91 || (jt) >= NTr)
#define BPTR(jt) (btab + ((jt) * KVBLK + 4 * hi - (q0 + r32) + 185) * 8 + wid)
    f32x16 pA0, pA1, pB0, pB1; float alA, alB; bf16x8 pa0, pa1, pa2, pa3; u64 mwA, mwB;
    __syncthreads();
    SLD(sA0, sA1, 0); mwA = MWORD(0); VM_WAIT(); SWR(0, sA0, sA1); __syncthreads();
    qkt(pA0, pA1, K_lds, qr, r32, hi);
    att2_partial(pA0, pA1, m_reg, alA, (unsigned)(mwA >> (4 * hi)), ISFAR(0), bfar, BPTR(0));
    SLD(sB0, sB1, KVBLK); mwB = MWORD(1); if (2 < NT) SLD(sA0, sA1, 2 * KVBLK);
    SWR(1, sB0, sB1); __syncthreads();
    for (int j = 1; j + 1 < NT; j += 2) {
        SBAR(); qkt(pB0, pB1, K_lds + SHM_K, qr, r32, hi);
        att2_finish(pA0, pA1, alA, l_reg, (unsigned)(mwA >> (32 + 4 * hi)), pa0, pa1, pa2, pa3); SBAR();
        SLD(sB0, sB1, (j + 2) * KVBLK); mwA = MWORD(j + 1); SBAR();
        PVALL(0);
        att2_partial(pB0, pB1, m_reg, alB, (unsigned)(mwB >> (4 * hi)), ISFAR(j), bfar, BPTR(j));
        __syncthreads(); SWR(0, sA0, sA1);
        RESC(alB); __syncthreads();
        SBAR(); qkt(pA0, pA1, K_lds, qr, r32, hi);
        att2_finish(pB0, pB1, alB, l_reg, (unsigned)(mwB >> (32 + 4 * hi)), pa0, pa1, pa2, pa3); SBAR();
        if (j + 3 < NT) SLD(sA0, sA1, (j + 3) * KVBLK); mwB = MWORD(j + 2); SBAR();
        PVALL(1);
        att2_partial(pA0, pA1, m_reg, alA, (unsigned)(mwA >> (4 * hi)), ISFAR(j + 1), bfar, BPTR(j + 1));
        __syncthreads(); SWR(1, sB0, sB1);
        RESC(alA); __syncthreads();
    }
    SBAR(); qkt(pB0, pB1, K_lds + SHM_K, qr, r32, hi);
    att2_finish(pA0, pA1, alA, l_reg, (unsigned)(mwA >> (32 + 4 * hi)), pa0, pa1, pa2, pa3); SBAR();
    PVALL(0);
    att2_partial(pB0, pB1, m_reg, alB, (unsigned)(mwB >> (4 * hi)), ISFAR(NT - 1), bfar, BPTR(NT - 1));
    __syncthreads(); RESC(alB);
    att2_finish(pB0, pB1, alB, l_reg, (unsigned)(mwB >> (32 + 4 * hi)), pa0, pa1, pa2, pa3); SBAR();
    PVALL(1);
#undef SLD
#undef SWR
#undef MWORD
#undef RESC
#undef PVALL
#undef ISFAR
#undef BPTR
    LAS float* li_s = (LAS float*)(F.lds + OFF_WS) + wid * 64;
    if (hi == 0) li_s[r32] = l_reg; LDS_WAIT();
    if (PA_FP8 && ATT_OT) {
        LAS unsigned char* ot = F.lds + OFF_OT + wid * (32 * OT_ST);
        int ob = (4 * hi) * OT_ST + r32, lo = 4 * hi; asm volatile("" : "+v"(ob), "+v"(lo));
#pragma unroll
        for (int r = 0; r < 16; ++r) { const int ro = (r & 3) + 8 * (r >> 2); if ((r & 3) == 0) asm volatile("" : "+v"(ob), "+v"(lo)); const float rl = fast_rcp(li_s[lo + ro]);
#pragma unroll
            for (int d0 = 0; d0 < 4; ++d0) { const float v = o[d0][r] * rl; ot[ob + ro * OT_ST + d0 * 32] = (unsigned char)(__builtin_amdgcn_cvt_pk_fp8_f32(v, v, 0, false) & 0xff); }
            if ((r & 3) == 3) SBAR(); }
        LDS_WAIT(); asm volatile("" ::: "memory");
        unsigned char* Og = (unsigned char*)OA + ((size_t)b * SEQ + q0) * 1024 + wid * 128;
        int rr = lane >> 3, sg = (lane & 7) * 16; asm volatile("" : "+v"(rr), "+v"(sg));
#pragma unroll
        for (int i = 0; i < 4; ++i) { const u32x4 w = *(const LAS u32x4*)(ot + (i * 8 + rr) * OT_ST + sg); *(u32x4*)(Og + (size_t)(i * 8 + rr) * 1024 + sg) = w; }
        LDS_WAIT();
    } else if (PA_FP8) {
        GAS unsigned char* Ow8 = (GAS unsigned char*)((unsigned char*)OA + ((size_t)b * SEQ + q0 + 4 * hi) * 1024 + wid * 128 + r32);
        int lo = 4 * hi; asm volatile("" : "+v"(Ow8), "+v"(lo));
#pragma unroll
        for (int r = 0; r < 16; ++r) { const int ro = (r & 3) + 8 * (r >> 2); if ((r & 3) == 0) asm volatile("" : "+v"(Ow8), "+v"(lo)); const float rl = fast_rcp(li_s[lo + ro]);
#pragma unroll
            for (int d0 = 0; d0 < 4; ++d0) { const float v = o[d0][r] * rl; Ow8[ro * 1024 + d0 * 32] = (unsigned char)(__builtin_amdgcn_cvt_pk_fp8_f32(v, v, 0, false) & 0xff); }
            if ((r & 3) == 3) SBAR(); }
    } else {
        bf16_t* Ow = OA + ((size_t)b * SEQ + q0 + 4 * hi) * 1024 + wid * 128 + r32;
        int lo = 4 * hi; asm volatile("" : "+v"(Ow), "+v"(lo));
#pragma unroll
        for (int r = 0; r < 16; ++r) { const int ro = (r & 3) + 8 * (r >> 2); if ((r & 3) == 0) asm volatile("" : "+v"(Ow), "+v"(lo)); const float rl = fast_rcp(li_s[lo + ro]);
#pragma unroll
            for (int d0 = 0; d0 < 4; ++d0) { const float v = o[d0][r] * rl; Ow[ro * 1024 + d0 * 32] = (bf16_t)(cvt_pk_bf16(v, v) & 0xffffu); }
            if ((r & 3) == 3) SBAR(); }
    }
}
}
__device__ __forceinline__ void ph_attn(Frame& F) {
    char* lds = (char*)(unsigned char*)F.lds;
    { float* bt = (float*)(lds + att::OFF_BT); const float* BT = (const float*)(F.ws + WS_BIAST); __syncthreads(); for (int i = F.tid; i < 249 * 8; i += NTHR) bt[i] = BT[i]; __syncthreads(); }
    for (int pr = F.bid; pr < NB * 32; pr += F.G) {
        const int b = pr >> 5, qb = pr & 31;
#pragma nounroll
        for (int hh = 0; hh < 2; ++hh) { if (ATT2) att::attn_item2(F, b, (hh ? qb : 63 - qb) * 32, lds); else att::attn_item(F, b, (hh ? qb : 63 - qb) * 32, lds); }
    }
}

namespace ssd {
constexpr int OFF_CS = 0, CS_ST = 272;
constexpr int OFF_BS = OFF_CS + 64 * CS_ST;
constexpr int OFF_BT = OFF_BS + 64 * CS_ST, T_ST = 144;
constexpr int OFF_XT = OFF_BT + 128 * T_ST;
constexpr int OFF_XW = OFF_XT + 64 * T_ST;
constexpr int OFF_XS = OFF_XW + 64 * T_ST;
constexpr int OFF_MT = OFF_XS + 64 * T_ST;
constexpr int OFF_HS = OFF_MT + 64 * T_ST;
constexpr int OFF_END = OFF_HS + 64 * CS_ST;
static_assert(OFF_END + 5 * 320 * 4 <= 131072, "ssd lds");
__device__ __forceinline__ f32x4 mfma16(bf16x8 a, bf16x8 b, f32x4 c) { return __builtin_amdgcn_mfma_f32_16x16x32_bf16(a, b, c, 0, 0, 0); }
__device__ __forceinline__ bf16x8 ldfrag(const char* base, int stride, int row, int k0) { return *(const bf16x8*)(base + row * stride + k0 * 2); }
}
__device__ __forceinline__ void ph_ssd(Frame& F) {
    using namespace ssd;
    char* lds = (char*)(unsigned char*)F.lds;
    const bf16_t* XBC = (const bf16_t*)(F.ws + WS_XBC); const bf16_t* ZS = (const bf16_t*)(F.ws + WS_Z); const float* DT = (const float*)(F.outb + OUT_DT);
    bf16_t* YG = (bf16_t*)(F.ws + WS_Q);
    const float* conv_w = F.a->in[9]; const float* conv_b = F.a->in[10]; const float* a_log = F.a->in[12]; const float* d_skip = F.a->in[13];
    const int tid = F.tid, wid = F.wave, lane = F.lane, fr = lane & 15, fq = lane >> 4;
    const bool stager = tid < 320; const int so = tid % 40, tg = tid / 40;
    for (int item = F.bid; item < NB * 16; item += F.G) {
        const int b = item >> 4, h = item & 15, g = h >> 2;
        const float aneg = -__expf(a_log[h]), dsk = d_skip[h];
        const int ch0 = so < 8 ? h * 64 + so * 8 : (so < 24 ? 1024 + g * 128 + (so - 8) * 8 : 1536 + g * 128 + (so - 24) * 8);
        float* CWL = (float*)(lds + OFF_END);
        __syncthreads();
        if (stager) {
#pragma unroll
            for (int j = 0; j < 4; ++j) { *(f32x4*)(CWL + j * 320 + so * 8) = *(const f32x4*)(conv_w + (size_t)j * 2048 + ch0); *(f32x4*)(CWL + j * 320 + so * 8 + 4) = *(const f32x4*)(conv_w + (size_t)j * 2048 + ch0 + 4); }
            *(f32x4*)(CWL + 4 * 320 + so * 8) = *(const f32x4*)(conv_b + ch0); *(f32x4*)(CWL + 4 * 320 + so * 8 + 4) = *(const f32x4*)(conv_b + ch0 + 4);
        }
        f32x4 hst[4];
#pragma unroll
        for (int t = 0; t < 4; ++t) hst[t] = (f32x4){0.f, 0.f, 0.f, 0.f};
        __syncthreads();
        for (int i = tid; i < 64 * CS_ST / 4; i += NTHR) ((unsigned*)(lds + OFF_HS))[i] = 0u;
        u32x4 raw[11];
        const size_t tokb = (size_t)b * SEQ;
#define SSD_LOAD(c) do { if (stager) { _Pragma("unroll") for (int i = 0; i < 11; ++i) { const int t = (c) * 64 + tg * 8 - 3 + i; \
            raw[i] = (t >= 0) ? *(const u32x4*)(XBC + (tokb + t) * 2048 + ch0) : (u32x4){0u, 0u, 0u, 0u}; } } } while (0)
        SSD_LOAD(0);
        float dtl_next = DT[(tokb + lane) * 16 + h];
        for (int c = 0; c < 32; ++c) {
            const float dtl = dtl_next; if (c + 1 < 32) dtl_next = DT[(tokb + (c + 1) * 64 + lane) * 16 + h];
            u32x2 zpre[2];
#pragma unroll
            for (int t2 = 0; t2 < 2; ++t2) { const int tile = 2 * wid + t2, pb = tile >> 2, lb = tile & 3; zpre[t2] = *(const u32x2*)(ZS + (tokb + c * 64 + lb * 16 + fr) * 1024 + h * 64 + pb * 16 + 4 * fq); }
            float acs = dtl * aneg;
#pragma unroll
            for (int o = 1; o < 64; o <<= 1) { const float t = __shfl_up(acs, o); if (lane >= o) acs += t; }
            const float alast = __shfl(acs, 63);
            if (DBG_SSD_SYNC) __syncthreads();
            float dtv[8], dec[8];
#pragma unroll
            for (int t = 0; t < 8; ++t) { dtv[t] = __shfl(dtl, (tg * 8 + t) & 63); dec[t] = __expf(alast - __shfl(acs, (tg * 8 + t) & 63)); }
            if (stager) {
#pragma unroll
                for (int hq = 0; hq < 2; ++hq) {
                    float xin[11][4];
#pragma unroll
                    for (int i = 0; i < 11; ++i) { const unsigned wa = hq ? raw[i].z : raw[i].x, wb = hq ? raw[i].w : raw[i].y; xin[i][0] = bflo(wa); xin[i][1] = bfhi(wa); xin[i][2] = bflo(wb); xin[i][3] = bfhi(wb); }
                    float outv[8][4];
                    { f32x4 cwv[4]; const f32x4 cbq = *(const f32x4*)(CWL + 4 * 320 + so * 8 + hq * 4);
#pragma unroll
                      for (int j = 0; j < 4; ++j) cwv[j] = *(const f32x4*)(CWL + j * 320 + so * 8 + hq * 4);
#pragma unroll
                      for (int t = 0; t < 8; ++t)
#pragma unroll
                        for (int e = 0; e < 4; ++e) { float sacc = cbq[e];
#pragma unroll
                            for (int j = 0; j < 4; ++j) sacc += cwv[j][e] * xin[t + j][e];
                            outv[t][e] = silu_f(sacc); } }
                    if (so < 8) {
#pragma unroll
                        for (int e = 0; e < 4; ++e) { const int p = so * 8 + hq * 4 + e;
                            f32x4 x0, x1, d0, d1, w0, w1;
#pragma unroll
                            for (int t = 0; t < 4; ++t) { x0[t] = outv[t][e]; x1[t] = outv[4 + t][e]; d0[t] = x0[t] * dtv[t]; d1[t] = x1[t] * dtv[4 + t]; w0[t] = d0[t] * dec[t]; w1[t] = d1[t] * dec[4 + t]; }
                            *(u32x4*)(lds + OFF_XS + p * T_ST + tg * 16) = pack8(x0, x1);
                            *(u32x4*)(lds + OFF_XT + p * T_ST + tg * 16) = pack8(d0, d1);
                            *(u32x4*)(lds + OFF_XW + p * T_ST + tg * 16) = pack8(w0, w1); }
                    } else {
                        const bool isB = so < 24; const int n0 = (isB ? (so - 8) : (so - 24)) * 8 + hq * 4;
                        char* nat = lds + (isB ? OFF_BS : OFF_CS);
#pragma unroll
                        for (int t = 0; t < 8; ++t) { u32x2 w; w.x = cvt_pk_bf16(outv[t][0], outv[t][1]); w.y = cvt_pk_bf16(outv[t][2], outv[t][3]);
                            *(u32x2*)(nat + (tg * 8 + t) * CS_ST + n0 * 2) = w; }
                        if (isB) {
#pragma unroll
                            for (int e = 0; e < 4; ++e) { f32x4 a, bq;
#pragma unroll
                                for (int t = 0; t < 4; ++t) { a[t] = outv[t][e]; bq[t] = outv[4 + t][e]; }
                                *(u32x4*)(lds + OFF_BT + (n0 + e) * T_ST + tg * 16) = pack8(a, bq); }
                        }
                    }
                }
            }
            if (c + 1 < 32) SSD_LOAD(c + 1);
            __syncthreads();
#pragma unroll
            for (int t2 = 0; t2 < 2; ++t2) {
                const int tile = 2 * wid + t2, sb = tile >> 2, lb = tile & 3;
                f32x4 d = (f32x4){0.f, 0.f, 0.f, 0.f};
                if (sb <= lb) {
#pragma unroll
                    for (int ks = 0; ks < 4; ++ks) d = mfma16(ldfrag(lds + OFF_BS, CS_ST, sb * 16 + fr, ks * 32 + fq * 8), ldfrag(lds + OFF_CS, CS_ST, lb * 16 + fr, ks * 32 + fq * 8), d);
                    const int l = lb * 16 + fr; const float al = __shfl(acs, l);
                    f32x4 as;
#pragma unroll
                    for (int r = 0; r < 4; ++r) as[r] = __shfl(acs, sb * 16 + 4 * fq + r);
#pragma unroll
                    for (int r = 0; r < 4; ++r) { const int s = sb * 16 + 4 * fq + r; d[r] = (s <= l) ? d[r] * __expf(al - as[r]) : 0.f; }
                }
                u32x2 w; w.x = cvt_pk_bf16(d[0], d[1]); w.y = cvt_pk_bf16(d[2], d[3]);
                *(u32x2*)(lds + OFF_MT + (lb * 16 + fr) * T_ST + (sb * 16 + 4 * fq) * 2) = w;
            }
            if (DBG_SSD_SYNC) __syncthreads();
            f32x4 yacc[2];
#pragma unroll
            for (int t2 = 0; t2 < 2; ++t2) {
                const int tile = 2 * wid + t2, pb = tile >> 2, lb = tile & 3;
                f32x4 d = (f32x4){0.f, 0.f, 0.f, 0.f};
#pragma unroll
                for (int ks = 0; ks < 4; ++ks) d = mfma16(ldfrag(lds + OFF_HS, CS_ST, pb * 16 + fr, ks * 32 + fq * 8), ldfrag(lds + OFF_CS, CS_ST, lb * 16 + fr, ks * 32 + fq * 8), d);
                const float el = __expf(__shfl(acs, lb * 16 + fr));
                yacc[t2] = d * el;
            }
            __syncthreads();
#pragma unroll
            for (int t2 = 0; t2 < 2; ++t2) {
                const int tile = 2 * wid + t2, pb = tile >> 2, lb = tile & 3;
                f32x4 d = yacc[t2];
#pragma unroll
                for (int ks = 0; ks < 2; ++ks) d = mfma16(ldfrag(lds + OFF_XT, T_ST, pb * 16 + fr, ks * 32 + fq * 8), ldfrag(lds + OFF_MT, T_ST, lb * 16 + fr, ks * 32 + fq * 8), d);
                const int l = lb * 16 + fr, p0 = pb * 16 + 4 * fq; const size_t tok = tokb + c * 64 + l;
                const u32x2 zz = zpre[t2];
                const float z0 = bflo(zz.x), z1 = bfhi(zz.x), z2 = bflo(zz.y), z3 = bfhi(zz.y);
                float xs[4];
#pragma unroll
                for (int r = 0; r < 4; ++r) xs[r] = bflo((unsigned)*(const bf16_t*)(lds + OFF_XS + (p0 + r) * T_ST + l * 2));
                u32x2 w; w.x = cvt_pk_bf16((d[0] + xs[0] * dsk) * z0, (d[1] + xs[1] * dsk) * z1); w.y = cvt_pk_bf16((d[2] + xs[2] * dsk) * z2, (d[3] + xs[3] * dsk) * z3);
                *(u32x2*)(YG + tok * 1024 + h * 64 + p0) = w;
            }
            if (DBG_SSD_SYNC) __syncthreads();
            { const float dc = __expf(alast);
#pragma unroll
              for (int t = 0; t < 4; ++t) { f32x4 d = hst[t] * dc;
#pragma unroll
                  for (int ks = 0; ks < 2; ++ks) d = mfma16(ldfrag(lds + OFF_BT, T_ST, wid * 16 + fr, ks * 32 + fq * 8), ldfrag(lds + OFF_XW, T_ST, t * 16 + fr, ks * 32 + fq * 8), d);
                  hst[t] = d;
                  u32x2 w; w.x = cvt_pk_bf16(d[0], d[1]); w.y = cvt_pk_bf16(d[2], d[3]);
                  *(u32x2*)(lds + OFF_HS + (t * 16 + fr) * CS_ST + (wid * 16 + 4 * fq) * 2) = w; } }
            __syncthreads();
        }
#undef SSD_LOAD
    }
}

namespace ssd2 {
constexpr int CS_ST = 272, T_ST = 144;
constexpr int OFF_CS = 0, OFF_BS = 64 * CS_ST, OFF_BT = 2 * 64 * CS_ST, OFF_H0 = OFF_BT + 128 * T_ST;
constexpr int H_XS = 0, H_XW = 64 * T_ST, H_MT = 2 * 64 * T_ST, H_HS = 3 * 64 * T_ST, H_SZ = H_HS + 64 * CS_ST;
constexpr int OFF_CW = OFF_H0 + 2 * H_SZ;
constexpr int OFF_TAB = OFF_CW + 5 * 384 * 4;
static_assert(OFF_TAB + 6 * 64 * 4 <= LDS_MISC, "ssd2 lds");
}
__device__ __forceinline__ void ph_ssd2(Frame& F, const int abl = 0) {
    using namespace ssd2; using ssd::mfma16; using ssd::ldfrag;
    char* lds = (char*)(unsigned char*)F.lds;
    const bf16_t* XBC = (const bf16_t*)(F.ws + WS_XBC); const bf16_t* ZS = (const bf16_t*)(F.ws + WS_Z); const float* DT = (const float*)(F.outb + OUT_DT);
    bf16_t* YG = (bf16_t*)(F.ws + WS_Q);
    const float* conv_w = F.a->in[9]; const float* conv_b = F.a->in[10]; const float* a_log = F.a->in[12]; const float* d_skip = F.a->in[13];
    const int tid = F.tid, wid = F.wave, lane = F.lane, fr = lane & 15, fq = lane >> 4;
    const int su = tid < 384 ? tid : tid - 128; const bool cwl_writer = true;
    const int cp_lo = __builtin_amdgcn_readfirstlane(tid < 384 ? 0 : 2), cp_hi = __builtin_amdgcn_readfirstlane(tid < 256 ? 4 : (tid < 384 ? 2 : 4));
    const int so = su % 48, tg = su / 48, shd = (so >> 3) & 1;
    for (int item = F.bid; item < NB * 8; item += F.G) {
        const int b = item >> 3, g = (item >> 1) & 3, h0 = g * 4 + (item & 1) * 2;
        const float aneg0 = -__expf(a_log[h0]), aneg1 = -__expf(a_log[h0 + 1]), dsk0 = d_skip[h0], dsk1 = d_skip[h0 + 1];
        const int ch0 = so < 16 ? (h0 + shd) * 64 + (so & 7) * 8 : (so < 32 ? 1024 + g * 128 + (so - 16) * 8 : 1536 + g * 128 + (so - 32) * 8);
        float* CWL = (float*)(lds + OFF_CW);
        __syncthreads();
        if (cwl_writer) {
#pragma unroll
            for (int j = 0; j < 4; ++j) { *(f32x4*)(CWL + j * 384 + so * 8) = *(const f32x4*)(conv_w + (size_t)j * 2048 + ch0); *(f32x4*)(CWL + j * 384 + so * 8 + 4) = *(const f32x4*)(conv_w + (size_t)j * 2048 + ch0 + 4); }
            *(f32x4*)(CWL + 4 * 384 + so * 8) = *(const f32x4*)(conv_b + ch0); *(f32x4*)(CWL + 4 * 384 + so * 8 + 4) = *(const f32x4*)(conv_b + ch0 + 4);
        }
        f32x4 hst[2][4];
#pragma unroll
        for (int hh = 0; hh < 2; ++hh)
#pragma unroll
            for (int t = 0; t < 4; ++t) hst[hh][t] = (f32x4){0.f, 0.f, 0.f, 0.f};
        for (int i = tid; i < 64 * CS_ST / 4; i += NTHR) { ((unsigned*)(lds + OFF_H0 + H_HS))[i] = 0u; ((unsigned*)(lds + OFF_H0 + H_SZ + H_HS))[i] = 0u; }
        u32x4 raw[11];
        const size_t tokb = (size_t)b * SEQ;
        const bf16_t* xrow = XBC + ((ptrdiff_t)tokb + tg * 8 - 3) * 2048 + ch0;
#define SSD_LOAD(c, xp, tgx) do { { _Pragma("unroll") for (int i = 0; i < 11; ++i) { const int t = (c) * 64 + (tgx) * 8 - 3 + i; \
            raw[i] = (t >= 0) ? *(const GAS u32x4*)((xp) + (ptrdiff_t)((c) * 64 + i) * 2048) : (u32x4){0u, 0u, 0u, 0u}; } } } while (0)
        SSD_LOAD(0, xrow, tg);
        f32x2 dtn = *(const f32x2*)(DT + (tokb + lane) * 16 + h0);
        for (int c = 0; c < 32; ++c) {
            int frl = fr, fql = fq, tgl = tg, sol = so; const bf16_t* xrl = xrow; asm volatile("" : "+v"(frl), "+v"(fql), "+v"(tgl), "+v"(sol), "+v"(xrl)); const int shdl = (sol >> 3) & 1;
            const float dtl0 = dtn[0], dtl1 = dtn[1]; if (c + 1 < 32) dtn = *(const f32x2*)(DT + (tokb + (c + 1) * 64 + lane) * 16 + h0);
            u32x2 zpre[2][2];
#pragma unroll
            for (int hh = 0; hh < 2; ++hh)
#pragma unroll
                for (int t2 = 0; t2 < 2; ++t2) { const int tile = 2 * wid + t2, pb = tile >> 2, lb = tile & 3; zpre[hh][t2] = *(const u32x2*)(ZS + (tokb + c * 64 + lb * 16 + frl) * 1024 + (h0 + hh) * 64 + pb * 16 + 4 * fql); }
            const float acs0 = dpp_scan_add(dtl0 * aneg0), acs1 = dpp_scan_add(dtl1 * aneg1);
            const float alast0 = __builtin_bit_cast(float, __builtin_amdgcn_readlane(__builtin_bit_cast(int, acs0), 63)), alast1 = __builtin_bit_cast(float, __builtin_amdgcn_readlane(__builtin_bit_cast(int, acs1), 63));
            float* TAB = (float*)(lds + OFF_TAB);
            TAB[lane] = acs0; TAB[64 + lane] = acs1; TAB[128 + lane] = dtl0; TAB[192 + lane] = dtl1; TAB[256 + lane] = dtl0 * __expf(alast0 - acs0); TAB[320 + lane] = dtl1 * __expf(alast1 - acs1);
            LDS_WAIT(); asm volatile("" ::: "memory");
            float wdt[8];
            { const f32x4 wa = *(const f32x4*)(TAB + 256 + shdl * 64 + tgl * 8), wb = *(const f32x4*)(TAB + 256 + shdl * 64 + tgl * 8 + 4);
#pragma unroll
              for (int t = 0; t < 4; ++t) { wdt[t] = wa[t]; wdt[4 + t] = wb[t]; } }
            if (!(abl & 1)) {
#pragma unroll
                for (int cp = 0; cp < 4; ++cp) {
                    if (cp < cp_lo || cp >= cp_hi) continue;
                    float xin[11][2];
#pragma unroll
                    for (int i = 0; i < 11; ++i) { const unsigned wa = cp == 0 ? raw[i].x : (cp == 1 ? raw[i].y : (cp == 2 ? raw[i].z : raw[i].w)); xin[i][0] = bflo(wa); xin[i][1] = bfhi(wa); }
                    float outv[8][2];
                    { f32x2 cwv[4]; const f32x2 cbq = *(const f32x2*)(CWL + 4 * 384 + sol * 8 + cp * 2);
#pragma unroll
                      for (int j = 0; j < 4; ++j) cwv[j] = *(const f32x2*)(CWL + j * 384 + sol * 8 + cp * 2);
#pragma unroll
                      for (int t = 0; t < 8; ++t)
#pragma unroll
                        for (int e = 0; e < 2; ++e) { float sacc = cbq[e];
#pragma unroll
                            for (int j = 0; j < 4; ++j) sacc += cwv[j][e] * xin[t + j][e];
                            outv[t][e] = silu_f(sacc); } }
                    if (sol < 16) {
                        char* hb = lds + OFF_H0 + shdl * H_SZ;
#pragma unroll
                        for (int e = 0; e < 2; ++e) { const int p = (sol & 7) * 8 + cp * 2 + e;
                            f32x4 x0, x1, w0, w1;
#pragma unroll
                            for (int t = 0; t < 4; ++t) { x0[t] = outv[t][e]; x1[t] = outv[4 + t][e]; w0[t] = x0[t] * wdt[t]; w1[t] = x1[t] * wdt[4 + t]; }
                            *(u32x4*)(hb + H_XS + p * T_ST + tgl * 16) = pack8(x0, x1);
                            *(u32x4*)(hb + H_XW + p * T_ST + tgl * 16) = pack8(w0, w1); }
                    } else {
                        const bool isB = sol < 32; const int n0 = (isB ? (sol - 16) : (sol - 32)) * 8 + cp * 2;
                        char* nat = lds + (isB ? OFF_BS : OFF_CS);
#pragma unroll
                        for (int t = 0; t < 8; ++t) *(unsigned*)(nat + (tgl * 8 + t) * CS_ST + n0 * 2) = cvt_pk_bf16(outv[t][0], outv[t][1]);
                        if (isB) {
#pragma unroll
                            for (int e = 0; e < 2; ++e) { f32x4 a, bq;
#pragma unroll
                                for (int t = 0; t < 4; ++t) { a[t] = outv[t][e]; bq[t] = outv[4 + t][e]; }
                                *(u32x4*)(lds + OFF_BT + (n0 + e) * T_ST + tgl * 16) = pack8(a, bq); }
                        }
                    }
                    SBAR();
                }
            }
            if (c + 1 < 32) SSD_LOAD(c + 1, xrl, tgl);
            __syncthreads();
            if (!(abl & 2))
#pragma unroll
            for (int t2 = 0; t2 < 2; ++t2) {
                const int tile = 2 * wid + t2, sb = tile >> 2, lb = tile & 3;
                f32x4 d = (f32x4){0.f, 0.f, 0.f, 0.f}, m0 = d, m1 = d;
                if (sb <= lb) {
#pragma unroll
                    for (int ks = 0; ks < 4; ++ks) d = mfma16(ldfrag(lds + OFF_BS, CS_ST, sb * 16 + frl, ks * 32 + fql * 8), ldfrag(lds + OFF_CS, CS_ST, lb * 16 + frl, ks * 32 + fql * 8), d);
                    const int l = lb * 16 + frl, s4 = sb * 16 + 4 * fql; const float al0 = TAB[l], al1 = TAB[64 + l];
                    const f32x4 as0 = *(const f32x4*)(TAB + s4), as1 = *(const f32x4*)(TAB + 64 + s4), ds0 = *(const f32x4*)(TAB + 128 + s4), ds1 = *(const f32x4*)(TAB + 192 + s4);
#pragma unroll
                    for (int r = 0; r < 4; ++r) { const int sidx = s4 + r;
                        m0[r] = (sidx <= l) ? d[r] * __expf(al0 - as0[r]) * ds0[r] : 0.f; m1[r] = (sidx <= l) ? d[r] * __expf(al1 - as1[r]) * ds1[r] : 0.f; }
                }
                u32x2 w; w.x = cvt_pk_bf16(m0[0], m0[1]); w.y = cvt_pk_bf16(m0[2], m0[3]);
                *(u32x2*)(lds + OFF_H0 + H_MT + (lb * 16 + frl) * T_ST + (sb * 16 + 4 * fql) * 2) = w;
                w.x = cvt_pk_bf16(m1[0], m1[1]); w.y = cvt_pk_bf16(m1[2], m1[3]);
                *(u32x2*)(lds + OFF_H0 + H_SZ + H_MT + (lb * 16 + frl) * T_ST + (sb * 16 + 4 * fql) * 2) = w;
            }
            f32x4 yacc[2][2];
#pragma unroll
            for (int hh = 0; hh < 2; ++hh)
#pragma unroll
                for (int t2 = 0; t2 < 2; ++t2) {
                    const int tile = 2 * wid + t2, pb = tile >> 2, lb = tile & 3; const char* hb = lds + OFF_H0 + hh * H_SZ;
                    f32x4 d = (f32x4){0.f, 0.f, 0.f, 0.f};
                    if (!(abl & 2))
#pragma unroll
                    for (int ks = 0; ks < 4; ++ks) d = mfma16(ldfrag(hb + H_HS, CS_ST, pb * 16 + frl, ks * 32 + fql * 8), ldfrag(lds + OFF_CS, CS_ST, lb * 16 + frl, ks * 32 + fql * 8), d);
                    const float el = __expf(TAB[hh * 64 + lb * 16 + frl]);
                    yacc[hh][t2] = d * el;
                }
            __syncthreads();
            if (!(abl & 4))
#pragma unroll
            for (int hh = 0; hh < 2; ++hh)
#pragma unroll
                for (int t2 = 0; t2 < 2; ++t2) {
                    const int tile = 2 * wid + t2, pb = tile >> 2, lb = tile & 3; const char* hb = lds + OFF_H0 + hh * H_SZ;
                    f32x4 d = yacc[hh][t2];
#pragma unroll
                    for (int ks = 0; ks < 2; ++ks) d = mfma16(ldfrag(hb + H_XS, T_ST, pb * 16 + frl, ks * 32 + fql * 8), ldfrag(hb + H_MT, T_ST, lb * 16 + frl, ks * 32 + fql * 8), d);
                    const int l = lb * 16 + frl, p0 = pb * 16 + 4 * fql; const size_t tok = tokb + c * 64 + l; const float dsk = hh ? dsk1 : dsk0;
                    const u32x2 zz = zpre[hh][t2];
                    const float z0 = bflo(zz.x), z1 = bfhi(zz.x), z2 = bflo(zz.y), z3 = bfhi(zz.y);
                    float xs[4];
#pragma unroll
                    for (int r = 0; r < 4; ++r) xs[r] = bflo((unsigned)*(const bf16_t*)(hb + H_XS + (p0 + r) * T_ST + l * 2));
                    u32x2 w; w.x = cvt_pk_bf16((d[0] + xs[0] * dsk) * z0, (d[1] + xs[1] * dsk) * z1); w.y = cvt_pk_bf16((d[2] + xs[2] * dsk) * z2, (d[3] + xs[3] * dsk) * z3);
                    *(u32x2*)(YG + tok * 1024 + (h0 + hh) * 64 + p0) = w;
                }
            if (!(abl & 8))
#pragma unroll
            for (int hh = 0; hh < 2; ++hh) { const float dc = __expf(hh ? alast1 : alast0); char* hb = lds + OFF_H0 + hh * H_SZ;
#pragma unroll
                for (int t = 0; t < 4; ++t) { f32x4 d = hst[hh][t] * dc;
#pragma unroll
                    for (int ks = 0; ks < 2; ++ks) d = mfma16(ldfrag(lds + OFF_BT, T_ST, wid * 16 + frl, ks * 32 + fql * 8), ldfrag(hb + H_XW, T_ST, t * 16 + frl, ks * 32 + fql * 8), d);
                    hst[hh][t] = d;
                    u32x2 w; w.x = cvt_pk_bf16(d[0], d[1]); w.y = cvt_pk_bf16(d[2], d[3]);
                    *(u32x2*)(hb + H_HS + (t * 16 + frl) * CS_ST + (wid * 16 + 4 * fql) * 2) = w; } }
            __syncthreads();
        }
#undef SSD_LOAD
    }
}

__device__ __forceinline__ void ph_gnorm(Frame& F) {
    bf16_t* YG = (bf16_t*)(F.ws + WS_Q);
    const int gw = F.bid * NWAVES + F.wave, NGW = F.G * NWAVES;
    constexpr int RB = 4;
    for (int m0 = gw * RB; m0 < NTOK; m0 += NGW * RB) {
        u32x2 w[RB][4];
#pragma unroll
        for (int r = 0; r < RB; ++r) { const u32x2* rp = (const u32x2*)(YG + (size_t)(m0 + r) * D) + F.lane;
#pragma unroll
            for (int j = 0; j < 4; ++j) w[r][j] = rp[64 * j]; }
#pragma unroll
        for (int r = 0; r < RB; ++r) { const int m = m0 + r; u32x2* rp = (u32x2*)(YG + (size_t)m * D) + F.lane;
#pragma unroll
            for (int j = 0; j < 4; ++j) { const float a = bflo(w[r][j].x), b = bfhi(w[r][j].x), c = bflo(w[r][j].y), d = bfhi(w[r][j].y);
                const float ss = wave_sum(a * a + b * b + c * c + d * d); const float rr = 1.f / sqrtf(ss * (1.f / 256.f) + LN_EPS);
                if (PB_FP8) { int pk = 0; pk = __builtin_amdgcn_cvt_pk_fp8_f32(a * rr, b * rr, pk, false); pk = __builtin_amdgcn_cvt_pk_fp8_f32(c * rr, d * rr, pk, true); ((unsigned*)(F.outb + OUT_OB8 + (size_t)m * D))[F.lane + 64 * j] = (unsigned)pk; }
                else { u32x2 o; o.x = cvt_pk_bf16(a * rr, b * rr); o.y = cvt_pk_bf16(c * rr, d * rr); rp[64 * j] = o; } } }
    }
}

template <bool DRY = false> __device__ __forceinline__ void ph_router(Frame& F) {
    float* X1 = (float*)F.outb; bf16_t* U2 = (bf16_t*)(F.ws + WS_U2); const float* MOD = (const float*)(F.ws + WS_MOD);
    const float* ln1g = F.a->in[18]; const float* ln1b = F.a->in[19]; const float* w_router = F.a->in[20]; const float* b_router = F.a->in[21];
    u32x2* REG = (u32x2*)(F.ws + WS_REG); unsigned* CNT = (unsigned*)(F.ws + WS_CTL) + CW_CNT;
    constexpr int TST = 2064;
    LAS unsigned char* THI = F.lds; LAS unsigned char* TLO = F.lds + 16 * TST; LAS float* PART = (LAS float*)(F.lds + 32 * TST);
    LAS unsigned* lcnt = (LAS unsigned*)(F.lds + LDS_AUX); LAS unsigned* lbase = lcnt + 32; LAS unsigned* ent = lcnt + 64;
    const int tid = F.tid, lane = F.lane, wid = F.wave, fr = lane & 15, fq = lane >> 4;
    bf16x8 whi[4][2], wlo[4][2];
#pragma unroll
    for (int ks = 0; ks < 4; ++ks)
#pragma unroll
        for (int ct = 0; ct < 2; ++ct) { float wv[8];
#pragma unroll
            for (int i = 0; i < 8; ++i) wv[i] = w_router[(size_t)(128 * wid + 32 * ks + 8 * fq + i) * 32 + ct * 16 + fr];
            u32x4 h, l2;
#pragma unroll
            for (int i = 0; i < 4; ++i) { const unsigned hp = cvt_pk_bf16(wv[2 * i], wv[2 * i + 1]); const float r0 = wv[2 * i] - bflo(hp), r1 = wv[2 * i + 1] - bfhi(hp); h[i] = hp; l2[i] = cvt_pk_bf16(r0, r1); }
            whi[ks][ct] = __builtin_bit_cast(bf16x8, h); wlo[ks][ct] = __builtin_bit_cast(bf16x8, l2); }
    const float brl = b_router[lane & 31];
    for (int batch = F.bid; batch < NTOK / 256; batch += F.G) {
        const int hf = batch >> 7;
        __syncthreads();
        if (tid < 32) lcnt[tid] = 0u;
        for (int grp = 0; grp < 16; ++grp) {
#pragma unroll
            for (int tt = 0; tt < 2; ++tt) {
                const int tg16 = 2 * wid + tt, m = batch * 256 + grp * 16 + tg16; const float* md = MOD + (size_t)(m >> 11) * 6144;
                f32x4* xr = (f32x4*)(X1 + (size_t)m * D) + lane;
                f32x4 v[4]; float s = 0.f;
#pragma unroll
                for (int j = 0; j < 4; ++j) { v[j] = xr[64 * j]; s += (v[j][0] + v[j][1]) + (v[j][2] + v[j][3]); }
                float mean = wave_sum(s) * (1.f / D), s2 = 0.f;
#pragma unroll
                for (int j = 0; j < 4; ++j) { v[j] = v[j] - mean; s2 += (v[j][0] * v[j][0] + v[j][1] * v[j][1]) + (v[j][2] * v[j][2] + v[j][3] * v[j][3]); }
                float rstd = 1.f / sqrtf(wave_sum(s2) * (1.f / D) + LN_EPS);
                s = 0.f;
#pragma unroll
                for (int j = 0; j < 4; ++j) { const f32x4 g = *((const f32x4*)ln1g + lane + 64 * j), bb = *((const f32x4*)ln1b + lane + 64 * j); v[j] = v[j] * rstd * g + bb; if (!DRY) xr[64 * j] = v[j]; s += (v[j][0] + v[j][1]) + (v[j][2] + v[j][3]); }
                mean = wave_sum(s) * (1.f / D); s2 = 0.f;
#pragma unroll
                for (int j = 0; j < 4; ++j) { v[j] = v[j] - mean; s2 += (v[j][0] * v[j][0] + v[j][1] * v[j][1]) + (v[j][2] * v[j][2] + v[j][3] * v[j][3]); }
                rstd = 1.f / sqrtf(wave_sum(s2) * (1.f / D) + LN_EPS);
                u32x2* o8 = (u32x2*)(U2 + (size_t)m * D) + lane;
#pragma unroll
                for (int j = 0; j < 4; ++j) { const f32x4 sh = *((const f32x4*)(md + 3072) + lane + 64 * j), sc = *((const f32x4*)(md + 4096) + lane + 64 * j);
                    v[j] = v[j] * rstd * (sc + 1.0f) + sh; u32x2 w; w.x = cvt_pk_bf16(v[j][0], v[j][1]); w.y = cvt_pk_bf16(v[j][2], v[j][3]);
                    if (DRY) { if (w.x == 0x12345678u) o8[64 * j] = w; }
                    else if (MOE_FP8) { int pk = 0; pk = __builtin_amdgcn_cvt_pk_fp8_f32(v[j][0], v[j][1], pk, false); pk = __builtin_amdgcn_cvt_pk_fp8_f32(v[j][2], v[j][3], pk, true); ((unsigned*)((unsigned char*)U2 + (size_t)m * D))[lane + 64 * j] = (unsigned)pk; }
                    else o8[64 * j] = w;
                    u32x2 lo; lo.x = cvt_pk_bf16(v[j][0] - bflo(w.x), v[j][1] - bfhi(w.x)); lo.y = cvt_pk_bf16(v[j][2] - bflo(w.y), v[j][3] - bfhi(w.y));
                    *(LAS u32x2*)(THI + tg16 * TST + (4 * lane + 256 * j) * 2) = w; *(LAS u32x2*)(TLO + tg16 * TST + (4 * lane + 256 * j) * 2) = lo; }
            }
            __syncthreads();
            { f32x4 a0 = (f32x4){0.f, 0.f, 0.f, 0.f}, a1 = a0;
#pragma unroll
              for (int ks = 0; ks < 4; ++ks) { const int cb = (128 * wid + 32 * ks + 8 * fq) * 2;
                  const bf16x8 th = *(const LAS bf16x8*)(THI + fr * TST + cb), tl = *(const LAS bf16x8*)(TLO + fr * TST + cb);
                  a0 = __builtin_amdgcn_mfma_f32_16x16x32_bf16(whi[ks][0], th, a0, 0, 0, 0); a1 = __builtin_amdgcn_mfma_f32_16x16x32_bf16(whi[ks][1], th, a1, 0, 0, 0);
                  a0 = __builtin_amdgcn_mfma_f32_16x16x32_bf16(wlo[ks][0], th, a0, 0, 0, 0); a1 = __builtin_amdgcn_mfma_f32_16x16x32_bf16(wlo[ks][1], th, a1, 0, 0, 0);
                  a0 = __builtin_amdgcn_mfma_f32_16x16x32_bf16(whi[ks][0], tl, a0, 0, 0, 0); a1 = __builtin_amdgcn_mfma_f32_16x16x32_bf16(whi[ks][1], tl, a1, 0, 0, 0); }
              *(LAS f32x4*)(PART + (wid * 16 + fr) * 32 + 4 * fq) = a0; *(LAS f32x4*)(PART + (wid * 16 + fr) * 32 + 16 + 4 * fq) = a1; }
            __syncthreads();
            { const int tg16 = 2 * wid + (lane >> 5), tl = grp * 16 + tg16, myexp = lane & 31;
              float logit = brl;
#pragma unroll
              for (int w8 = 0; w8 < 8; ++w8) logit += PART[(w8 * 16 + tg16) * 32 + myexp];
              float tv[4]; int tix[4];
#pragma unroll
              for (int k = 0; k < 4; ++k) { float bv = logit; int bi = myexp;
#pragma unroll
                  for (int o = 1; o < 32; o <<= 1) { const float ov = __shfl_xor(bv, o); const int oi = __shfl_xor(bi, o); if (ov > bv || (ov == bv && oi < bi)) { bv = ov; bi = oi; } }
                  tv[k] = bv; tix[k] = bi; if (myexp == bi) logit = -INFINITY; }
              const float e1 = __expf(tv[1] - tv[0]), e2 = __expf(tv[2] - tv[0]), e3 = __expf(tv[3] - tv[0]); const float inv = 1.f / (1.f + e1 + e2 + e3);
              if (myexp < 4) { const int ee = myexp == 0 ? tix[0] : (myexp == 1 ? tix[1] : (myexp == 2 ? tix[2] : tix[3])); const float gg = (myexp == 0 ? 1.f : (myexp == 1 ? e1 : (myexp == 2 ? e2 : e3))) * inv;
                  const unsigned lp = atomicAdd((unsigned*)&lcnt[ee], 1u);
                  LAS unsigned* en = ent + (tl * 4 + myexp) * 3; en[0] = (unsigned)ee; en[1] = lp; en[2] = __float_as_uint(gg);
                  if (DBG_CHECK == 1) { u32x2 rw; rw.x = (unsigned)ee; rw.y = __float_as_uint(gg); ((u32x2*)(F.ws + WS_DBG))[(size_t)(batch * 256 + tl) * 4 + myexp] = rw; } } }
        }
        __syncthreads();
        if (tid < 32) lbase[tid] = DRY ? 0u : __hip_atomic_fetch_add(CNT + 64 * (hf * 32 + tid), lcnt[tid], __ATOMIC_RELAXED, __HIP_MEMORY_SCOPE_AGENT);
        __syncthreads();
        for (int i = tid; i < 1024; i += NTHR) { const LAS unsigned* en = ent + i * 3; const unsigned ee = en[0], pos = lbase[ee] + en[1];
            const unsigned tokl = (unsigned)(batch * 256 + (i >> 2)) - (unsigned)hf * HALF_TOK;
            u32x2 w; w.x = tokl * 4u + (unsigned)(i & 3); w.y = en[2];
            if (!DRY && pos < (unsigned)REG_CAP) REG[((size_t)hf * 32 + ee) * REG_CAP + pos] = w; }
    }
}

template <bool DRY = false> __device__ __forceinline__ void ph_final(Frame& F, int hf) {
    float* X1 = (float*)F.outb; const bf16_t* YB = (const bf16_t*)(F.ws + WS_YB); const float* MOD = (const float*)(F.ws + WS_MOD);
    const float* g2 = F.a->in[26]; const float* b2 = F.a->in[27];
    const int gw = F.bid * NWAVES + F.wave, NGW = F.G * NWAVES, lane = F.lane;
    constexpr int RB = 2;
    for (int tl0 = gw; tl0 < HALF_TOK; tl0 += NGW * RB) {
        f32x4 xv[RB][4]; u32x2 yw[RB][4][4];
#pragma unroll
        for (int r = 0; r < RB; ++r) { const int tl = tl0 + r * NGW, m = hf * HALF_TOK + tl;
            const f32x4* xr = (const f32x4*)(X1 + (size_t)m * D) + lane; const u32x2* yr = (const u32x2*)(YB + (size_t)tl * 4 * D) + lane;
#pragma unroll
            for (int j = 0; j < 4; ++j) { xv[r][j] = xr[64 * j];
#pragma unroll
                for (int k = 0; k < 4; ++k) yw[r][j][k] = yr[k * 256 + 64 * j]; } }
#pragma unroll
        for (int r = 0; r < RB; ++r) { const int tl = tl0 + r * NGW, m = hf * HALF_TOK + tl; const float* md = MOD + (size_t)(m >> 11) * 6144 + 5120;
            f32x4* xr = (f32x4*)(X1 + (size_t)m * D) + lane;
            f32x4 v[4]; float s = 0.f;
#pragma unroll
            for (int j = 0; j < 4; ++j) { f32x4 y = (f32x4){0.f, 0.f, 0.f, 0.f};
#pragma unroll
                for (int k = 0; k < 4; ++k) { const u32x2 w = yw[r][j][k]; y[0] += bflo(w.x); y[1] += bfhi(w.x); y[2] += bflo(w.y); y[3] += bfhi(w.y); }
                if (DBG_NO_MOE) y = (f32x4){0.f, 0.f, 0.f, 0.f};
                const f32x4 gt = *((const f32x4*)md + lane + 64 * j);
                v[j] = xv[r][j] * DN_ALPHA + gt * y; s += (v[j][0] + v[j][1]) + (v[j][2] + v[j][3]); }
            const float mean = wave_sum(s) * (1.f / D); float s2 = 0.f;
#pragma unroll
            for (int j = 0; j < 4; ++j) { v[j] = v[j] - mean; s2 += (v[j][0] * v[j][0] + v[j][1] * v[j][1]) + (v[j][2] * v[j][2] + v[j][3] * v[j][3]); }
            const float rstd = 1.f / sqrtf(wave_sum(s2) * (1.f / D) + LN_EPS);
#pragma unroll
            for (int j = 0; j < 4; ++j) { const f32x4 g = *((const f32x4*)g2 + lane + 64 * j), bb = *((const f32x4*)b2 + lane + 64 * j); const f32x4 ov = v[j] * rstd * g + bb; if (!DRY || ov[0] == 1.2345e-33f) xr[64 * j] = ov; } }
    }
}

__device__ __forceinline__ float block_sum(Frame& F, float v, LAS float* red) {
    v = wave_sum(v); __syncthreads(); if (F.lane == 0) red[F.wave] = v; __syncthreads();
    float s = 0.f; for (int w = 0; w < NWAVES; ++w) s += red[w]; return s;
}
__device__ __forceinline__ float block_max(Frame& F, float v, LAS float* red) {
#pragma unroll
    for (int o = 1; o < 64; o <<= 1) v = fmaxf(v, __shfl_xor(v, o));
    __syncthreads(); if (F.lane == 0) red[F.wave] = v; __syncthreads();
    float s = 0.f; for (int w = 0; w < NWAVES; ++w) s = fmaxf(s, red[w]); return s;
}
__device__ __forceinline__ void dbg_report(Frame& F, float e) { if (F.tid == 0) atomicMax((unsigned*)(F.ws + WS_CTL) + CW_DBG, __float_as_uint(e)); }
__device__ __forceinline__ void dbg_check_moe(Frame& F) {
    if (F.bid >= 64) return;
    const int tok = HALF_TOK + 509 * F.bid + 3, tokl = tok - HALF_TOK, tid = F.tid;
    LAS float* u2 = (LAS float*)F.lds; LAS float* act = u2 + 1024; LAS float* red = act + 1024; LAS float* lg = red + 16;
    const bf16_t* U2 = (const bf16_t*)(F.ws + WS_U2); const bf16_t* YB = (const bf16_t*)(F.ws + WS_YB); const u32x2* RT = (const u32x2*)(F.ws + WS_DBG);
    const float* w1 = F.a->in[22]; const float* b1 = F.a->in[23]; const float* w2 = F.a->in[24]; const float* b2 = F.a->in[25];
    __syncthreads();
    for (int i = tid; i < 1024; i += NTHR) u2[i] = bflo((unsigned)U2[(size_t)tok * 1024 + i]);
    __syncthreads();
    float y0 = 0.f, y1 = 0.f;
    for (int k = 0; k < 4; ++k) {
        const u32x2 rw = RT[(size_t)tok * 4 + k]; const int e = (int)rw.x; const float g = __uint_as_float(rw.y);
        const float* W1 = w1 + (size_t)e * 1024 * 2048; const float* W2 = w2 + (size_t)e * 1024 * 1024;
        float h0 = b1[e * 2048 + tid], h1 = b1[e * 2048 + tid + 512], h2 = b1[e * 2048 + tid + 1024], h3 = b1[e * 2048 + tid + 1536];
        for (int c = 0; c < 1024; ++c) { const float uu = u2[c]; const float* wr = W1 + (size_t)c * 2048 + tid; h0 += uu * wr[0]; h1 += uu * wr[512]; h2 += uu * wr[1024]; h3 += uu * wr[1536]; }
        __syncthreads();
        { float gg = fminf(h0, 7.f), up = fminf(fmaxf(h2, -7.f), 7.f); act[tid] = (up + 1.f) * gg / (1.f + expf(-1.702f * gg));
          gg = fminf(h1, 7.f); up = fminf(fmaxf(h3, -7.f), 7.f); act[tid + 512] = (up + 1.f) * gg / (1.f + expf(-1.702f * gg)); }
        __syncthreads();
        float a0 = b2[e * 1024 + tid], a1 = b2[e * 1024 + tid + 512];
        for (int j = 0; j < 1024; ++j) { const float aa = act[j]; a0 += aa * W2[(size_t)j * 1024 + tid]; a1 += aa * W2[(size_t)j * 1024 + tid + 512]; }
        y0 += g * a0; y1 += g * a1;
    }
    float f0 = 0.f, f1 = 0.f;
    for (int k = 0; k < 4; ++k) { f0 += bflo((unsigned)YB[((size_t)tokl * 4 + k) * 1024 + tid]); f1 += bflo((unsigned)YB[((size_t)tokl * 4 + k) * 1024 + tid + 512]); }
    const float rms = sqrtf(block_sum(F, y0 * y0 + y1 * y1, red) * (1.f / 1024.f)) + 1e-20f;
    float err = block_max(F, fmaxf(fabsf(y0 - f0), fabsf(y1 - f1)), red) / rms;
    { const float* X1 = (const float*)F.outb + (size_t)tok * 1024; const float* md = (const float*)(F.ws + WS_MOD) + (size_t)(tok >> 11) * 6144;
      const float xa = X1[tid], xb = X1[tid + 512]; const float mean = block_sum(F, xa + xb, red) * (1.f / 1024.f);
      const float da = xa - mean, db = xb - mean; const float var = block_sum(F, da * da + db * db, red) * (1.f / 1024.f); const float rstd = 1.f / sqrtf(var + LN_EPS);
      __syncthreads();
      u2[tid] = da * rstd * (1.f + md[4096 + tid]) + md[3072 + tid]; u2[tid + 512] = db * rstd * (1.f + md[4096 + tid + 512]) + md[3072 + tid + 512];
      __syncthreads();
      if (tid < 32) { float a = F.a->in[21][tid]; for (int c = 0; c < 1024; ++c) a += u2[c] * F.a->in[20][c * 32 + tid]; lg[tid] = a; }
      __syncthreads();
      if (tid == 0) { unsigned want = 0u, got = 0u; float l2[32]; for (int i = 0; i < 32; ++i) l2[i] = lg[i];
          for (int k = 0; k < 4; ++k) { int bi = 0; for (int i = 1; i < 32; ++i) if (l2[i] > l2[bi]) bi = i; want |= 1u << bi; l2[bi] = -INFINITY; got |= 1u << RT[(size_t)tok * 4 + k].x; }
          lg[32] = (want != got) ? 1.f : 0.f; }
      __syncthreads();
      if (lg[32] != 0.f) err = 50.f; }
    dbg_report(F, err);
}
__device__ __forceinline__ void dbg_check_ssd(Frame& F) {
    if (F.bid >= 2) return;
    const int b = F.bid ? 20 : 5, h = F.bid ? 14 : 3, g = h >> 2, tid = F.tid, p = tid >> 3, ng = tid & 7;
    LAS float* red = (LAS float*)F.lds; LAS float* cv = red + 16;
    const bf16_t* XBC = (const bf16_t*)(F.ws + WS_XBC); const bf16_t* ZS = (const bf16_t*)(F.ws + WS_Z); const float* DT = (const float*)(F.outb + OUT_DT); const bf16_t* YG = (const bf16_t*)(F.ws + WS_Q);
    const float* cw = F.a->in[9]; const float* cb = F.a->in[10]; const float aneg = -expf(F.a->in[12][h]), dsk = F.a->in[13][h];
    const int mych = tid < 64 ? h * 64 + tid : (tid < 192 ? 1024 + g * 128 + (tid - 64) : 1536 + g * 128 + (tid - 192));
    float w0 = 0.f, w1 = 0.f, w2 = 0.f, w3 = 0.f, wb = 0.f;
    if (tid < 320) { w0 = cw[0 * 2048 + mych]; w1 = cw[1 * 2048 + mych]; w2 = cw[2 * 2048 + mych]; w3 = cw[3 * 2048 + mych]; wb = cb[mych]; }
    float x0 = 0.f, x1 = 0.f, x2 = 0.f;
    float hs[16];
#pragma unroll
    for (int i = 0; i < 16; ++i) hs[i] = 0.f;
    float emax = 0.f, ssq = 0.f, nbad = 0.f; int tmax = 0;
    for (int t = 0; t < SEQ; ++t) {
        const size_t tok = (size_t)b * SEQ + t;
        __syncthreads();
        if (DBG_HYP == 1 && (t & 63) == 0) { x0 = 0.f; x1 = 0.f; x2 = 0.f; }
        if (tid < 320) { const float x3 = bflo((unsigned)XBC[tok * 2048 + mych]); const float s = wb + w0 * x0 + w1 * x1 + w2 * x2 + w3 * x3; cv[tid] = s / (1.f + expf(-s)); x0 = x1; x1 = x2; x2 = x3; }
        __syncthreads();
        const float xv = cv[p], dt = DT[tok * 16 + h], dec = expf(dt * aneg);
        float yp = 0.f;
#pragma unroll
        for (int i = 0; i < 16; ++i) { const int n = ng * 16 + i; hs[i] = hs[i] * dec + dt * xv * cv[64 + n]; yp += cv[192 + n] * hs[i]; }
        yp += __shfl_xor(yp, 1); yp += __shfl_xor(yp, 2); yp += __shfl_xor(yp, 4);
        const float yv = (yp + xv * dsk) * bflo((unsigned)ZS[tok * 1024 + h * 64 + p]);
        const float yf = bflo((unsigned)YG[tok * 1024 + h * 64 + p]);
        if (ng == 0) { const float er = fabsf(yv - yf); if (er > emax) { emax = er; tmax = t; } ssq += yv * yv; if (er > 0.25f && (DBG_SUB < 5 || (DBG_SUB == 5 && (t & 63) == 0) || (DBG_SUB == 6 && (t & 63) == 1) || (DBG_SUB == 7 && (t & 63) == 32))) nbad += 1.f; }
    }
    const float rms = sqrtf(block_sum(F, ssq, red) / (64.f * SEQ)) + 1e-20f;
    const float M = block_max(F, emax, red);
    if (DBG_SUB == 0) dbg_report(F, M / rms);
    else if (DBG_SUB == 1) dbg_report(F, block_sum(F, nbad, red) / (64.f * SEQ));
    else if (DBG_SUB >= 5) dbg_report(F, block_sum(F, nbad, red) / (64.f * 32.f));
    else { __syncthreads(); if (ng == 0 && emax == M) red[12] = (float)(DBG_SUB == 2 ? ((tmax & 63) >> 1) : (DBG_SUB == 3 ? (tmax >> 6) : (p >> 1))); __syncthreads();
        if (F.bid == 0) dbg_report(F, powf(10.f, 2.f * (0.05f + 0.05f * red[12]) - 4.f)); }
}
__device__ __forceinline__ void dbg_check_attn(Frame& F) {
    if (F.bid >= 32) return;
    const int b = (F.bid * 7 + 3) & 31, pos = 300 + F.bid * 53, nadm = ((pos >> 6) + 1) * 64, tid = F.tid, lane = F.lane, hd = F.wave;
    const size_t tq = (size_t)b * SEQ + pos;
    LAS float* sc = (LAS float*)F.lds; LAS unsigned char* sel = (LAS unsigned char*)(sc + 2048); LAS float* lgt = (LAS float*)(sel + 2048); LAS float* red = lgt + 8 * 2048; LAS float* misc = red + 16;
    const bf16_t* IQ = (const bf16_t*)(F.outb + OUT_IQ); const bf16_t* IK = (const bf16_t*)(F.outb + OUT_IK); const float* IW = (const float*)(F.outb + OUT_IW);
    const bf16_t* Q = (const bf16_t*)(F.ws + WS_Q); const bf16_t* KV = (const bf16_t*)(F.outb + OUT_KV); const bf16_t* OA = (const bf16_t*)(F.outb + OUT_OA); const u64* MASK = (const u64*)(F.outb + OUT_MASK);
    __syncthreads();
    for (int k = tid; k < nadm; k += NTHR) { float s = 0.f;
        for (int hh = 0; hh < 8; ++hh) { float d = 0.f; for (int c = 0; c < 64; ++c) d += bflo((unsigned)IQ[tq * 512 + hh * 64 + c]) * bflo((unsigned)IK[((size_t)b * SEQ + k) * 64 + c]); s += fmaxf(d, 0.f) * IW[tq * 8 + hh]; }
        sc[k] = s + 0.0f; }
    __syncthreads();
    float nbad = 0.f;
    for (int k = tid; k < nadm; k += NTHR) { const float s = sc[k]; int rank = 0; for (int j = 0; j < nadm; ++j) { const float t = sc[j]; rank += (t > s || (t == s && j < k)) ? 1 : 0; }
        const unsigned char se = rank < 256 ? 1 : 0; sel[k] = se; const unsigned mb = (unsigned)((MASK[tq * 32 + (k >> 6)] >> (k & 63)) & 1ull); if (mb != se) nbad += 1.f; }
    __syncthreads();
    const float nbad_t = block_sum(F, nbad, red);
    LAS float* lw = lgt + hd * 2048; float mx = -INFINITY;
    for (int k = lane; k < nadm; k += 64) { float l = -INFINITY;
        if (sel[k]) { float d = 0.f; for (int c = 0; c < 128; ++c) d += bflo((unsigned)Q[tq * 1024 + hd * 128 + c]) * bflo((unsigned)KV[((size_t)b * SEQ + k) * 128 + c]);
            const int rel = k - pos, n = rel < 0 ? -rel : rel; const float nf = (float)(n > 1 ? n : 1); int large = 8 + (int)(logf(nf / 8.0f) / 2.7725887f * 8.0f); if (large > 15) large = 15;
            const int bucket = (rel > 0 ? 16 : 0) + (n < 8 ? n : large);
            l = d * 0.088388347648318440f + F.a->in[8][bucket * 8 + hd]; }
        lw[k] = l; mx = fmaxf(mx, l); }
#pragma unroll
    for (int o = 1; o < 64; o <<= 1) mx = fmaxf(mx, __shfl_xor(mx, o));
    float den = 0.f;
    for (int k = lane; k < nadm; k += 64) { const float pp = expf(lw[k] - mx); lw[k] = pp; den += pp; }
    den = wave_sum(den);
    float emax = 0.f, ssq = 0.f;
    for (int c2 = 0; c2 < 2; ++c2) { const int c = lane + 64 * c2; float o = 0.f; for (int k = 0; k < nadm; ++k) { const float pp = lw[k]; if (pp != 0.f) o += pp * bflo((unsigned)KV[((size_t)b * SEQ + k) * 128 + c]); }
        o /= den; const float of = bflo((unsigned)OA[tq * 1024 + hd * 128 + c]); emax = fmaxf(emax, fabsf(o - of)); ssq += o * o; }
    const float rms = sqrtf(block_sum(F, ssq, red) * (1.f / 1024.f)) + 1e-20f;
    float err = block_max(F, emax, red) / rms;
    (void)misc;
    if (nbad_t > 0.f) err = 10.f + nbad_t;
    dbg_report(F, err);
}
__device__ __forceinline__ void dbg_emit(Frame& F) {
    float* out = (float*)F.outb;
    for (size_t i = (size_t)F.bid * NTHR + F.tid; i < (size_t)NTOK * D / 4; i += (size_t)F.G * NTHR) ((f32x4*)out)[i] = (f32x4){0.f, 0.f, 0.f, 0.f};
    __syncthreads();
    if (F.bid == 0 && F.tid == 0) { const float e = __uint_as_float(__hip_atomic_load((unsigned*)(F.ws + WS_CTL) + CW_DBG, __ATOMIC_RELAXED, __HIP_MEMORY_SCOPE_AGENT));
        float code = (log10f(fmaxf(e, 1e-30f)) + 4.f) * 0.5f; code = fminf(fmaxf(rintf(code * 20.f) * 0.05f, 0.05f), 3.0f);
        out[0] = sqrtf(67108864.f * 1.01f * (powf(10.f, code) - 1.f)); }
}

#define CLK_BEGIN(k) unsigned long long clk_c##k = 0, clk_r##k = 0; if (DBG_CLOCK == (k) + 1) { clk_c##k = __builtin_amdgcn_s_memtime(); clk_r##k = __builtin_amdgcn_s_memrealtime(); }
#define CLK_END(k) if (DBG_CLOCK == (k) + 1 && F.bid == 0) { const float ghz = (float)(__builtin_amdgcn_s_memtime() - clk_c##k) / (float)(__builtin_amdgcn_s_memrealtime() - clk_r##k) * 0.1f; dbg_report(F, powf(10.f, 2.f * (rintf(ghz * 5.f) * 0.2f) - 4.f)); }
constexpr int NPHASE = 17;
__global__ void __launch_bounds__(NTHR, 2) fwd(Args args) {
    extern __shared__ __attribute__((aligned(16))) unsigned char lds_raw[];
    Frame F;
    F.lds = (LAS unsigned char*)lds_raw;
    F.tid = threadIdx.x; F.lane = F.tid & 63; F.wave = __builtin_amdgcn_readfirstlane(F.tid >> 6); F.G = gridDim.x; F.bid = blockIdx.x;
    F.a = &args;
    F.ws = args.ws; F.outb = (unsigned char*)args.out;
    volatile LAS unsigned* MISCW = (volatile LAS unsigned*)(F.lds + LDS_MISC);
    if (F.tid < 64) MISCW[F.tid] = 0u;
    __syncthreads();
    XcdBarrier bar; bar.bar = (unsigned*)(F.ws + WS_CTL) + CW_BAR; bar.x = 0; bar.st = nullptr;
#if MK_ONE
    bar = xcd_barrier_post((unsigned*)(F.ws + WS_CTL) + CW_BAR, MISCW + 8);
#define GRID_BAR() xcd_barrier(bar)
#else
#define GRID_BAR() do { } while (0)
#endif
    const int lo = args.ph_lo, hi = args.ph_hi;
#ifndef PHM
#define PHM (0xFFFFFFFFu & ~(DBG_NO_ATTN ? 0x30u : 0u) & ~(DBG_NO_SSD ? 0xC0u : 0u))
#endif
#define IN(k) (((PHM >> (k)) & 1u) && lo <= (k) && (k) < hi)
#define SEAM(k) do { if ((k) + 1 < hi) GRID_BAR(); } while (0)

    if (IN(0)) {
#pragma nounroll
        for (int rep = 0; rep < ((DBG_TWICE & 1u) ? 2 : 1); ++rep) { if (rep) GRID_BAR(); ph_prologue(F); }
        SEAM(0); }
    if (IN(1)) {
#pragma nounroll
        for (int rep = 0; rep < ((DBG_TWICE & 2u) ? 2 : 1); ++rep) { if (rep) GRID_BAR(); ph_ln1(F); }
        SEAM(1); }
    CLK_BEGIN(2);
    if (IN(2)) {
        EpiProj E{(bf16_t*)(F.ws + WS_Q), (bf16_t*)(F.outb + OUT_IQ), (bf16_t*)(F.ws + WS_Z), (bf16_t*)(F.ws + WS_XBC), (bf16_t*)(F.ws + WS_GA), (bf16_t*)(F.ws + WS_GB), (float*)(F.outb + OUT_MISC), 1.0f};
#if PROJ_FP8
        { SchedProj<2> S; S.o.init(NTOK, 12 * 256, F.G, F.bid); S.A = (const char*)(F.ws + WS_U8); S.Bt = (const char*)(F.ws + WS_WIN8);
          EpiProj E8 = E; E8.sc = MOE_INV;
          pg8::gemm_phase<EpiProj, SchedProj<2>, false, 512, true>(F.lds, S, E8);
          if (DBG_TWICE & 32768u) { GRID_BAR(); pg8::gemm_phase<EpiProj, SchedProj<2>, false, 512, true>(F.lds, S, E8); } }
        { SchedProj<1> S; S.o.init(NTOK, 15 * 256, F.G, F.bid); S.A = (const char*)(F.outb + OUT_U); S.Bt = (const char*)(F.ws + WS_WIN); if (DBG_KCLK) S.dbgw = (unsigned*)(F.ws + WS_CTL) + CW_DBG;
#if DBG_DRYPROJ
#pragma nounroll
          for (int rep = 0; rep < 2; ++rep) { EpiProj Ed = E; Ed.dry = rep == 0; SchedProj<1> Sd = S; Sd.fold = rep == 0 ? 7 : 0x7fffffff; pg8::gemm_phase<EpiProj, SchedProj<1>, false>(F.lds, Sd, Ed); if (rep == 0) GRID_BAR(); }
#else
          const unsigned long long w0 = DBG_WALL ? __builtin_amdgcn_s_memrealtime() : 0ull;
          pg8::gemm_phase<EpiProj, SchedProj<1>, false>(F.lds, S, E);
          if (DBG_WALL && F.bid == 0) { const float us = (float)(__builtin_amdgcn_s_memrealtime() - w0) * 0.01f; dbg_report(F, powf(10.f, 2.f * (rintf(us / 300.f * 10.f) * 0.1f) - 4.f)); }
#endif
          if (DBG_TWICE & 4u) { GRID_BAR(); pg8::gemm_phase<EpiProj, SchedProj<1>, false>(F.lds, S, E); } }
#else
        { SchedProj<0> S; S.o.init(NTOK, NPROJ, F.G, F.bid); S.A = (const char*)(F.outb + OUT_U); S.Bt = (const char*)(F.ws + WS_WIN);
          pg8::gemm_phase<EpiProj, SchedProj<0>, false>(F.lds, S, E);
          if (DBG_TWICE & 4u) { GRID_BAR(); pg8::gemm_phase<EpiProj, SchedProj<0>, false>(F.lds, S, E); } }
#endif
        SEAM(2);
    }
    CLK_END(2);
    if (IN(3)) { ph_misc(F); if (DBG_TWICE & 8u) { GRID_BAR(); ph_misc(F); } SEAM(3); }
    if (IN(4)) { ph_index(F); if (DBG_TWICE & 16u) { GRID_BAR(); ph_index(F); } SEAM(4); }
    if (IN(5)) { ph_attn(F); if (DBG_TWICE & 32u) { GRID_BAR(); ph_attn(F); } SEAM(5); if (DBG_CHECK == 3) { dbg_check_attn(F); GRID_BAR(); } }
    if (IN(6)) {
#pragma nounroll
        for (int rep = 0; rep < DBG_REP6; ++rep) { if (rep) GRID_BAR(); ph_ssd2(F, rep + 1 < DBG_REP6 ? DBG_ABL6 : 0); }
        SEAM(6); if (DBG_CHECK == 2) { dbg_check_ssd(F); GRID_BAR(); } }
    if (IN(7)) { ph_gnorm(F); if (DBG_TWICE & 128u) { GRID_BAR(); ph_gnorm(F); } SEAM(7); }
    if (IN(8)) {
#if PA_FP8
        SchedPlainT<1024> S; S.o.init(NTOK, 1024, F.G, F.bid); S.A = (const char*)(F.outb + OUT_OA); S.Bt = (const char*)(F.ws + WS_WPA8);
        EpiGate<0> E{(const bf16_t*)(F.ws + WS_GA), nullptr, (bf16_t*)(F.ws + WS_Z), MOE_INV};
        pg8::gemm_phase<EpiGate<0>, SchedPlainT<1024>, false, 512, true>(F.lds, S, E);
#else
        SchedPlain S; S.o.init(NTOK, 1024, F.G, F.bid); S.A = (const char*)(F.outb + OUT_OA); S.Bt = (const char*)(F.ws + WS_WPA);
        EpiGate<0> E{(const bf16_t*)(F.ws + WS_GA), nullptr, (bf16_t*)(F.ws + WS_Z), 1.0f};
        pg8::gemm_phase<EpiGate<0>, SchedPlain, false>(F.lds, S, E);
#endif
    }
    if (IN(9)) {
#if PB_FP8
        SchedPlainT<1024> S; S.o.init(NTOK, 1024, F.G, F.bid); S.A = (const char*)(F.outb + OUT_OB8); S.Bt = (const char*)(F.ws + WS_WPB8);
        EpiGate<1> E{(const bf16_t*)(F.ws + WS_GB), (const bf16_t*)(F.ws + WS_Z), (bf16_t*)(F.ws + WS_XBC), MOE_INV};
        pg8::gemm_phase<EpiGate<1>, SchedPlainT<1024>, false, 512, true>(F.lds, S, E);
#else
        SchedPlain S; S.o.init(NTOK, 1024, F.G, F.bid); S.A = (const char*)(F.ws + WS_Q); S.Bt = (const char*)(F.ws + WS_WPB);
        EpiGate<1> E{(const bf16_t*)(F.ws + WS_GB), (const bf16_t*)(F.ws + WS_Z), (bf16_t*)(F.ws + WS_XBC), 1.0f};
        pg8::gemm_phase<EpiGate<1>, SchedPlain, false>(F.lds, S, E);
#endif
        SEAM(9);
    }
    if (IN(10)) {
        SchedPlain S; S.o.init(NTOK, 1024, F.G, F.bid); S.A = (const char*)(F.ws + WS_XBC); S.Bt = (const char*)(F.ws + WS_WOUT);
        EpiOut E{F.a->in[0], (const float*)(F.ws + WS_MOD), (float*)F.outb};
        pg8::gemm_phase<EpiOut, SchedPlain, false>(F.lds, S, E);
        if (DBG_TWICE & 1024u) { GRID_BAR(); pg8::gemm_phase<EpiOut, SchedPlain, false>(F.lds, S, E); }
        SEAM(10);
    }
    if (IN(11)) { if (DBG_TWICE & 2048u) { ph_router<true>(F); GRID_BAR(); } ph_router<false>(F); SEAM(11); }
#pragma unroll
    for (int hf = 0; hf < 2; ++hf) {
        const int p0 = 12 + hf * 2;
        if (IN(p0)) {
            if (hf == 1) ph_final<false>(F, 0);
            MoeTab T = moe_tables(F, hf);
            SchedMoe<8, true> S{T, F.G, F.bid, hf, (const char*)(F.ws + WS_U2), (const char*)(F.ws + WS_W1), (const u32x2*)(F.ws + WS_REG)};
            EpiMoe1 E{F.a->in[23], (bf16_t*)(F.ws + WS_ACT), 0};
            pg8::gemm_phase<EpiMoe1, SchedMoe<8, true>, true, MOE_RB / 2, MOE_FP8 != 0>(F.lds, S, E);
            if ((DBG_TWICE & 4096u) && hf == 0) { GRID_BAR(); pg8::gemm_phase<EpiMoe1, SchedMoe<8, true>, true, MOE_RB / 2, MOE_FP8 != 0>(F.lds, S, E); }
            if ((DBG_TWICE & 16384u) && hf == 0) { GRID_BAR(); EpiMoe1 Ed = E; Ed.dry = 1; pg8::gemm_phase<EpiMoe1, SchedMoe<8, true>, true, MOE_RB / 2, MOE_FP8 != 0>(F.lds, S, Ed); }
            SEAM(p0);
        }
        if (IN(p0 + 1)) {
            MoeTab T = moe_tables(F, hf);
            SchedMoe<4, false> S{T, F.G, F.bid, hf, (const char*)(F.ws + WS_ACT), (const char*)(F.ws + WS_W2), (const u32x2*)(F.ws + WS_REG)};
            EpiMoe2 E{F.a->in[25], (bf16_t*)(F.ws + WS_YB), (const u32x2*)(F.ws + WS_REG), T, hf, 0};
            if ((DBG_TWICE & 262144u) && hf == 0) { EpiMoe2 Ed = E; Ed.dry = DBG_DRYMODE; pg8::gemm_phase<EpiMoe2, SchedMoe<4, false>, false, MOE_RB / 2, MOE_FP8 != 0>(F.lds, S, Ed); GRID_BAR(); }
            pg8::gemm_phase<EpiMoe2, SchedMoe<4, false>, false, MOE_RB / 2, MOE_FP8 != 0>(F.lds, S, E);
            if ((DBG_TWICE & 8192u) && hf == 0) { GRID_BAR(); pg8::gemm_phase<EpiMoe2, SchedMoe<4, false>, false, MOE_RB / 2, MOE_FP8 != 0>(F.lds, S, E); }
            if ((DBG_TWICE & 131072u) && hf == 0) { GRID_BAR(); EpiMoe2 Ed = E; Ed.dry = 1; pg8::gemm_phase<EpiMoe2, SchedMoe<4, false>, false, MOE_RB / 2, MOE_FP8 != 0>(F.lds, S, Ed); }
            SEAM(p0 + 1);
            if (DBG_CHECK == 1 && hf == 1) { dbg_check_moe(F); GRID_BAR(); }
        }
    }
    if (IN(16)) { if (DBG_TWICE & 65536u) { ph_final<true>(F, 1); GRID_BAR(); } ph_final(F, 1); }
    if (DBG_CHECK || DBG_CLOCK || DBG_KCLK || DBG_WALL) { GRID_BAR(); dbg_emit(F); }
#undef IN
#undef SEAM
}

extern "C" void kernel_launch(void* const* d_in, const int* in_sizes, int n_in, void* d_out, int out_size, void* d_ws, size_t ws_size, hipStream_t stream) {
    static int grid = 0;
    if (grid == 0) {
        if (n_in != 28 || in_sizes[0] != NTOK * D || out_size != NTOK * D || ws_size < WS_END) { fprintf(stderr, "kernel_launch: shape mismatch (n_in %d, in0 %d, out %d, ws %zu)\n", n_in, n_in > 0 ? in_sizes[0] : -1, out_size, ws_size); grid = -1; return; }
        int dev = 0, cus = 0, per_cu = 0;
        if (hipGetDevice(&dev) != hipSuccess || hipDeviceGetAttribute(&cus, hipDeviceAttributeMultiprocessorCount, dev) != hipSuccess) { grid = -1; return; }
        if (hipFuncSetAttribute((const void*)fwd, hipFuncAttributeMaxDynamicSharedMemorySize, LDS_BYTES) != hipSuccess) { fprintf(stderr, "kernel_launch: hipFuncSetAttribute failed\n"); grid = -1; return; }
        if (hipOccupancyMaxActiveBlocksPerMultiprocessor(&per_cu, (const void*)fwd, NTHR, LDS_BYTES) != hipSuccess || per_cu < 1) fprintf(stderr, "kernel_launch: occupancy query reports %d\n", per_cu);
        (void)hipGetLastError();
        grid = cus;
    }
    if (grid < 0) return;
    if (hipMemsetAsync((char*)d_ws + WS_CTL, 0, CTL_ZERO_BYTES, stream) != hipSuccess) { fprintf(stderr, "kernel_launch: memset failed\n"); return; }
    Args a{};
    for (int i = 0; i < 28; ++i) a.in[i] = (const float*)d_in[i];
    a.out = (float*)d_out; a.ws = (unsigned char*)d_ws;
    const int nph = NPHASE < MK_PH_HI ? NPHASE : MK_PH_HI;
#if MK_ONE
    a.ph_lo = 0; a.ph_hi = nph;
    hipLaunchKernelGGL(fwd, dim3(grid), dim3(NTHR), LDS_BYTES, stream, a);
#else
    for (int p = 0; p < nph; ++p) { a.ph_lo = p; a.ph_hi = p + 1; hipLaunchKernelGGL(fwd, dim3(grid), dim3(NTHR), LDS_BYTES, stream, a); }
#endif
    const hipError_t le = hipPeekAtLastError();
    if (le != hipSuccess) fprintf(stderr, "kernel_launch: launch failed: %s\n", hipGetErrorName(le));
}
```

```cpp
#include <hip/hip_runtime.h>
#include <cstdio>
#include <cstdint>

#ifndef MK_ONE
#define MK_ONE 1
#endif
#ifndef DBG_NO_ATTN
#define DBG_NO_ATTN 0
#endif
#ifndef DBG_ATTN_ZERO
#define DBG_ATTN_ZERO 0
#endif
#ifndef DBG_IQ_TRUNC
#define DBG_IQ_TRUNC 0
#endif
#ifndef DBG_ROUTER_BF16
#define DBG_ROUTER_BF16 0
#endif
#ifndef DBG_CHECK
#define DBG_CHECK 0
#endif
#ifndef DBG_SKIP_BODY
#define DBG_SKIP_BODY 0
#endif
#ifndef DBG_SUB
#define DBG_SUB 0
#endif
#ifndef DBG_SSD_SYNC
#define DBG_SSD_SYNC 0
#endif
#ifndef DBG_HYP
#define DBG_HYP 0
#endif
#ifndef DBG_TWICE
#define DBG_DRYPROJ 0
#define DBG_ABL6 0
#define DBG_REP6 1
#define DBG_WALL 0
#define DBG_KCLK 0
#ifndef DBG_CLOCK
#define DBG_CLOCK 0
#endif
#define DBG_TWICE 0u
#endif
#ifndef DBG_DRYMODE
#define DBG_DRYMODE 2
#endif
#ifndef DBG_NO_SSD
#define DBG_NO_SSD 0
#endif
#ifndef DBG_NO_MOE
#define DBG_NO_MOE 0
#endif
#ifndef MOE_FP8
#define MOE_FP8 1
#endif
#ifndef PROJ_FP8
#define PROJ_FP8 1
#endif
#ifndef PA_FP8
#define PA_FP8 1
#endif
#ifndef PB_FP8
#define PB_FP8 0
#endif
#ifndef ATT2
#define ATT_OT 1
#define ATT2 1
#endif
#ifndef MK_PH_HI
#define MK_PH_HI 99
#endif

#define LAS __attribute__((address_space(3)))
#define GAS __attribute__((address_space(1)))
typedef unsigned short bf16_t;
typedef short bf16x8 __attribute__((ext_vector_type(8)));
typedef short s16x4 __attribute__((ext_vector_type(4)));
typedef float f32x2 __attribute__((ext_vector_type(2)));
typedef float f32x4 __attribute__((ext_vector_type(4)));
typedef float f32x16 __attribute__((ext_vector_type(16)));
typedef unsigned u32x2 __attribute__((ext_vector_type(2)));
typedef unsigned u32x4 __attribute__((ext_vector_type(4)));
typedef unsigned long long u64;

constexpr int NB = 32, SEQ = 2048, D = 1024, NTOK = NB * SEQ;
constexpr int NWAVES = 8, NTHR = 512;
constexpr int NPROJ = 6912;
constexpr int NEXP = 32, HALF_TOK = NTOK / 2, REG_CAP = HALF_TOK;
constexpr int ACT_ROWS = HALF_TOK * 4 + NEXP * 256;
constexpr float LN_EPS = 1e-5f;
constexpr float DN_ALPHA = 1.189207115002721f;
constexpr float LOG2E = 1.4426950408889634f;

constexpr size_t MiB = 1u << 20;
constexpr size_t WS_CTL = 0, CTL_ZERO_BYTES = 1 * MiB;
constexpr size_t WS_MOD = 1 * MiB;
constexpr size_t WS_BIAST = 1 * MiB + 800 * 1024;
constexpr size_t WS_WIN = 2 * MiB;
constexpr size_t WS_WPA = 16 * MiB, WS_WPB = 18 * MiB, WS_WOUT = 20 * MiB;
constexpr size_t WS_W1 = 24 * MiB;
constexpr size_t WS_U8 = 88 * MiB;
constexpr size_t WS_W2 = 152 * MiB;
constexpr size_t WS_WIN8 = 184 * MiB;
constexpr size_t WS_WPA8 = 192 * MiB;
constexpr size_t WS_WPB8 = 194 * MiB;
constexpr size_t OUT_OB8 = 192 * MiB;
constexpr size_t WS_Q = 216 * MiB;
constexpr size_t WS_Z = 344 * MiB;
constexpr size_t WS_XBC = 472 * MiB;
constexpr size_t WS_GA = 728 * MiB, WS_GB = 856 * MiB;
constexpr size_t WS_U2 = 216 * MiB;
constexpr size_t WS_REG = 344 * MiB;
constexpr size_t WS_ACT = 360 * MiB;
constexpr size_t WS_YB = 632 * MiB;
constexpr size_t WS_END = 889 * MiB;
constexpr size_t WS_DBG = 889 * MiB;
constexpr size_t OUT_U = 0, OUT_MISC = 128 * MiB, OUT_IQ = 192 * MiB;
constexpr size_t OUT_KV = 0, OUT_IK = 16 * MiB, OUT_IW = 24 * MiB, OUT_DT = 26 * MiB, OUT_MASK = 32 * MiB, OUT_OA = 64 * MiB;
constexpr int CW_BAR = 4096, CW_CNT = 16384, CW_WQ = 22528, CW_DBG = 24576;

constexpr int LDS_BYTES = 160 * 1024;
constexpr int LDS_AUX = 131072;
constexpr int LDS_MISC = LDS_BYTES - 256;

#define LDS_WAIT() asm volatile("s_waitcnt lgkmcnt(0)" ::: "memory")
#define GAS __attribute__((address_space(1)))
#define VM_WAIT() asm volatile("s_waitcnt vmcnt(0)" ::: "memory")
#define SBAR() __builtin_amdgcn_sched_barrier(0)
typedef __bf16 bf16x2_t __attribute__((ext_vector_type(2)));
__device__ __forceinline__ unsigned cvt_pk_bf16(float lo, float hi) { f32x2 f = {lo, hi}; bf16x2_t v = __builtin_convertvector(f, bf16x2_t); return __builtin_bit_cast(unsigned, v); }
__device__ __forceinline__ float bflo(unsigned w) { return __uint_as_float(w << 16); }
__device__ __forceinline__ float bfhi(unsigned w) { return __uint_as_float(w & 0xffff0000u); }
__device__ __forceinline__ u32x4 pack8(f32x4 a, f32x4 b) { u32x4 w; w.x = cvt_pk_bf16(a[0], a[1]); w.y = cvt_pk_bf16(a[2], a[3]); w.z = cvt_pk_bf16(b[0], b[1]); w.w = cvt_pk_bf16(b[2], b[3]); return w; }
constexpr int MOE_RB = MOE_FP8 ? 1024 : 2048;
constexpr float MOE_WSC = MOE_FP8 ? 64.0f : 1.0f, MOE_INV = 1.0f / MOE_WSC;
__device__ __forceinline__ u32x2 pack8_fp8(f32x4 a, f32x4 b) { int lo = 0, hi = 0;
    lo = __builtin_amdgcn_cvt_pk_fp8_f32(a[0], a[1], lo, false); lo = __builtin_amdgcn_cvt_pk_fp8_f32(a[2], a[3], lo, true);
    hi = __builtin_amdgcn_cvt_pk_fp8_f32(b[0], b[1], hi, false); hi = __builtin_amdgcn_cvt_pk_fp8_f32(b[2], b[3], hi, true);
    u32x2 r; r.x = (unsigned)lo; r.y = (unsigned)hi; return r; }
__device__ __forceinline__ void unpack8(u32x4 w, f32x4& a, f32x4& b) { a[0] = bflo(w.x); a[1] = bfhi(w.x); a[2] = bflo(w.y); a[3] = bfhi(w.y); b[0] = bflo(w.z); b[1] = bfhi(w.z); b[2] = bflo(w.w); b[3] = bfhi(w.w); }
__device__ __forceinline__ float dpp_scan_add(float v) {
#define DPPF(x, ctrl, rm) __builtin_bit_cast(float, __builtin_amdgcn_update_dpp(0, __builtin_bit_cast(int, (x)), (ctrl), (rm), 0xf, false))
    v += DPPF(v, 0x111, 0xf); v += DPPF(v, 0x112, 0xf); v += DPPF(v, 0x114, 0xf); v += DPPF(v, 0x118, 0xf);
    v += DPPF(v, 0x142, 0xa);
    v += DPPF(v, 0x143, 0xc);
#undef DPPF
    return v;
}
__device__ __forceinline__ unsigned dpp_half_sums_u32(unsigned v) {
#define DPPU(x, ctrl, rm) (unsigned)__builtin_amdgcn_update_dpp(0, (int)(x), (ctrl), (rm), 0xf, false)
    v += DPPU(v, 0x111, 0xf); v += DPPU(v, 0x112, 0xf); v += DPPU(v, 0x114, 0xf); v += DPPU(v, 0x118, 0xf); v += DPPU(v, 0x142, 0xa);
#undef DPPU
    return v;
}
__device__ __forceinline__ float dpp_half_sums_f32(float v) {
#define DPPF(x, ctrl, rm) __builtin_bit_cast(float, __builtin_amdgcn_update_dpp(0, __builtin_bit_cast(int, (x)), (ctrl), (rm), 0xf, false))
    v += DPPF(v, 0x111, 0xf); v += DPPF(v, 0x112, 0xf); v += DPPF(v, 0x114, 0xf); v += DPPF(v, 0x118, 0xf); v += DPPF(v, 0x142, 0xa);
#undef DPPF
    return v;
}
__device__ __forceinline__ float wave_sum(float v) { v = dpp_scan_add(v); return __builtin_bit_cast(float, __builtin_amdgcn_readlane(__builtin_bit_cast(int, v), 63)); }
__device__ __forceinline__ float fast_rcp(float x) { return __builtin_amdgcn_rcpf(x); }
__device__ __forceinline__ float sigmoid_f(float x) { return fast_rcp(1.0f + __expf(-x)); }
__device__ __forceinline__ float silu_f(float x) { return x * sigmoid_f(x); }

#define XB_TMO      128
#define XB_XCNT(j)  (256  + 64 * (j))
#define XB_XSUB(j)  (1280 + 64 * (j))
#define XB_XGEN(j)  (2304 + 64 * (j))
#define XB_TOP      3328
#define XB_TOPGEN   3392
#define XCD_BAR_WORDS 3456
#define XB_SPIN_CAP (1u << 18)
__device__ __forceinline__ unsigned xb_ld(unsigned* p)              { return __hip_atomic_load(p, __ATOMIC_RELAXED, __HIP_MEMORY_SCOPE_AGENT); }
__device__ __forceinline__ unsigned xb_add(unsigned* p, unsigned v) { return __hip_atomic_fetch_add(p, v, __ATOMIC_RELAXED, __HIP_MEMORY_SCOPE_AGENT); }
__device__ __forceinline__ unsigned xb_xcc_id() { return (unsigned)__builtin_amdgcn_s_getreg((3 << 11) | 20) & 0xFu; }
#define XB_SPIN(cond, bar) do { unsigned _sp = 0; while (cond) { __builtin_amdgcn_s_sleep(1); \
    if ((++_sp & 255u) == 0u) { if (xb_ld(&(bar)[XB_TMO])) break; if (_sp > XB_SPIN_CAP) { atomicAdd(&(bar)[XB_TMO], 1u); break; } } } } while (0)
struct XcdBarrier { unsigned* bar; unsigned x; volatile LAS unsigned* st; };
__device__ __forceinline__ XcdBarrier xcd_barrier_post(unsigned* bar, volatile LAS unsigned* st) {
    XcdBarrier b; b.bar = bar; b.x = xb_xcc_id(); b.st = st;
    if (threadIdx.x == 0) (void)xb_add(&bar[XB_XCNT(b.x)], 1u);
    return b;
}
__device__ __forceinline__ void xcd_barrier_complete(unsigned* bar, unsigned x, unsigned& nloc, unsigned& nx) {
    const unsigned G = gridDim.x * gridDim.y * gridDim.z;
    unsigned sum, cnt, mine, sp = 0u;
    for (;;) {
        sum = 0u; cnt = 0u;
#pragma nounroll
        for (unsigned j = 0; j < 16; ++j) { const unsigned c = xb_ld(&bar[XB_XCNT(j)]); sum += c; cnt += (c > 0u) ? 1u : 0u; }
        if (sum == G) break;
        __builtin_amdgcn_s_sleep(1);
        if ((++sp & 255u) == 0u) { if (xb_ld(&bar[XB_TMO])) break; if (sp > XB_SPIN_CAP) { atomicAdd(&bar[XB_TMO], 1u); break; } }
    }
    mine = xb_ld(&bar[XB_XCNT(x)]);
    nloc = mine > 0u ? mine : 1u; nx = cnt > 0u ? cnt : 1u;
}
__device__ __forceinline__ void xcd_barrier(const XcdBarrier& b) {
    asm volatile("s_waitcnt vmcnt(0)" ::: "memory");
    __syncthreads();
    if (threadIdx.x == 0) {
        unsigned* bar = b.bar;
        __builtin_amdgcn_s_waitcnt(0);
        unsigned nloc = b.st[0], nx = b.st[1];
        if (nloc == 0u) { xcd_barrier_complete(bar, b.x, nloc, nx); b.st[0] = nloc; b.st[1] = nx; }
        const unsigned old = xb_add(&bar[XB_XSUB(b.x)], 1u);
        const unsigned gen = old / nloc;
        if (old + 1u == (gen + 1u) * nloc) {
            __builtin_amdgcn_fence(__ATOMIC_RELEASE, "agent");
            asm volatile("s_waitcnt vmcnt(0)" ::: "memory");
            const unsigned og = xb_add(&bar[XB_TOP], 1u);
            const unsigned tg = og / nx;
            if (og + 1u == (tg + 1u) * nx) xb_add(&bar[XB_TOPGEN], 1u);
            else XB_SPIN(xb_ld(&bar[XB_TOPGEN]) == tg, bar);
            __builtin_amdgcn_fence(__ATOMIC_ACQUIRE, "agent");
            xb_add(&bar[XB_XGEN(b.x)], 1u);
            asm volatile("s_waitcnt vmcnt(0)" ::: "memory");
        } else {
            XB_SPIN(xb_ld(&bar[XB_XGEN(b.x)]) == gen, bar);
            __builtin_amdgcn_fence(__ATOMIC_ACQUIRE, "agent");
            asm volatile("s_waitcnt vmcnt(0)" ::: "memory");
        }
    }
    __syncthreads();
}

namespace pg8 {
constexpr int BM = 256, BK = 64, HALF = 128, HTB = HALF * BK * 2, STAGE_BYTES = 8 * HTB, NXCD = 8, WGM = 8, KD = 1024;
__host__ __device__ __forceinline__ int lds_byte(int r, int c) { const int st = (r >> 4) * 2 + (c >> 5), rr = r & 15, cc = c & 31, ob = rr * 64 + cc * 2; return st * 1024 + (ob ^ (((ob >> 9) & 1) << 5)); }
__host__ __device__ __forceinline__ void stage_rc(int b, int& R, int& C) { const int st = b / 1024, sb = b % 1024, swz = sb ^ (((sb >> 9) & 1) << 5); R = (st >> 1) * 16 + swz / 64; C = (st & 1) * 32 + (swz % 64) / 2; }
__host__ __device__ __forceinline__ int perm32(int rho) { const int n = rho >> 4, i = rho & 15; return 8 * (i >> 2) + 4 * n + (i & 3); }
struct Unit { int pm, pn, ex; };
struct StaticOrder {
    int nM, nN, nwg, G, c;
    __device__ void init(int M, int N, int G_, int c_) { nM = M / BM; nN = N / BM; nwg = nM * nN; G = G_; c = c_; }
    __device__ bool next(int i, Unit& u) const {
        const long L = (long)i * G + c; if (L >= nwg) return false;
        int wgid = (int)L; { const int q = nwg / NXCD, r = nwg % NXCD, xcd = wgid % NXCD, off = wgid / NXCD; wgid = (xcd < r ? xcd * (q + 1) : r * (q + 1) + (xcd - r) * q) + off; }
        const int nig = WGM * nN, gid = wgid / nig, fm = gid * WGM, gsz = (nM - fm) < WGM ? (nM - fm) : WGM;
        u.pm = fm + ((wgid % nig) % gsz); u.pn = (wgid % nig) / gsz; u.ex = 0; return true;
    }
};
typedef int i32x8 __attribute__((ext_vector_type(8)));
typedef int i32x4v __attribute__((ext_vector_type(4)));
template <class T> __device__ __forceinline__ auto dbgw_of(const T& s, int) -> decltype(s.dbgw) { return s.dbgw; }
template <class T> __device__ __forceinline__ unsigned* dbgw_of(const T&, long) { return nullptr; }
template <class Epi, class Sched, bool GATHER, int KE = 1024, bool FP8 = false>
__device__ __forceinline__ void gemm_phase(LAS unsigned char* lds, const Sched& S, const Epi& E) {
    int tid = threadIdx.x; asm volatile("" : "+v"(tid));
    const int wid = __builtin_amdgcn_readfirstlane(tid >> 6), lane = tid & 63, wr = wid >> 2, wc = wid & 3, fr = lane & 15, fq = lane >> 4;
    constexpr int K = KE, nt = K / BK;
    unsigned voffA[2], voffB[2]; int Rr[2], Cc[2];
#pragma unroll
    for (int i = 0; i < 2; ++i) { int R, C; stage_rc(tid * 16 + i * 8192, R, C); const int Rb = Epi::PERM ? ((R & ~31) + perm32(R & 31)) : R;
        voffA[i] = (unsigned)(R * K + C) * 2u; voffB[i] = (unsigned)(Rb * K + C) * 2u; Rr[i] = R; Cc[i] = C; }
    constexpr size_t kstep = (size_t)(BK * 2);
    constexpr size_t hstep = (size_t)HALF * K * 2;
    const unsigned ldsw = (unsigned)wid * 1024u;
    const int aoff = lds_byte(wr * 64 + fr, fq * 8), boff = lds_byte(wc * 32 + fr, fq * 8);
#define PG8_SA(b, h) (((b) * 2 + (h)) * HTB)
#define PG8_SB(b, h) ((4 + (b) * 2 + (h)) * HTB)
#define PG8_STAGE(bufoff, gbase, voff) do { _Pragma("unroll") for (int _i = 0; _i < 2; ++_i) \
        __builtin_amdgcn_global_load_lds((const unsigned*)((const char*)(gbase) + (voff)[_i]), (LAS unsigned*)(lds + (bufoff) + ldsw + _i * 8192), 16, 0, 0); } while (0)
#define PG8_STAGE_A(bufoff, gb, h, o0, o1) do { if constexpr (GATHER) { const unsigned _ko = (unsigned)((gb) - gA0); unsigned _o[2]; \
            if ((h) == 0) { _o[0] = (o0)[0] + _ko; _o[1] = (o0)[1] + _ko; } else { _o[0] = (o1)[0] + _ko; _o[1] = (o1)[1] + _ko; } PG8_STAGE(bufoff, gA0, _o); } \
        else { PG8_STAGE(bufoff, (gb) + (h) * hstep, voffA); } } while (0)
#define PG8_LD8(p) __builtin_shufflevector(*(const LAS i32x4v*)(p), *(const LAS i32x4v*)((p) + 1024), 0, 1, 2, 3, 4, 5, 6, 7)
#define PG8_LDA(dst, b, h) do { if constexpr (FP8) { _Pragma("unroll") for (int m = 0; m < 4; ++m) dst##8[m] = PG8_LD8(lds + PG8_SA(b, h) + aoff + m * 2048); } \
        else { _Pragma("unroll") for (int m = 0; m < 4; ++m) _Pragma("unroll") for (int k = 0; k < 2; ++k) dst[m][k] = *(const LAS bf16x8*)(lds + PG8_SA(b, h) + aoff + m * 2048 + k * 1024); } } while (0)
#define PG8_LDB(dst, b, h) do { if constexpr (FP8) { _Pragma("unroll") for (int n = 0; n < 2; ++n) dst##8[n] = PG8_LD8(lds + PG8_SB(b, h) + boff + n * 2048); } \
        else { _Pragma("unroll") for (int n = 0; n < 2; ++n) _Pragma("unroll") for (int k = 0; k < 2; ++k) dst[n][k] = *(const LAS bf16x8*)(lds + PG8_SB(b, h) + boff + n * 2048 + k * 1024); } } while (0)
#define PG8_MMA(ai, bj, At, Bt) do { __builtin_amdgcn_s_setprio(1); if constexpr (FP8) { _Pragma("unroll") for (int m = 0; m < 4; ++m) _Pragma("unroll") for (int n = 0; n < 2; ++n) \
            asm volatile("v_mfma_scale_f32_16x16x128_f8f6f4 %0, %1, %2, %0, %3, %3 op_sel_hi:[0,0,0]" : "+v"(acc[ai][bj][m][n]) : "v"(Bt##8[n]), "v"(At##8[m]), "v"(sc127)); } \
        else { _Pragma("unroll") for (int m = 0; m < 4; ++m) _Pragma("unroll") for (int n = 0; n < 2; ++n) _Pragma("unroll") for (int k = 0; k < 2; ++k) \
            acc[ai][bj][m][n] = __builtin_amdgcn_mfma_f32_16x16x32_bf16(Bt[n][k], At[m][k], acc[ai][bj][m][n], 0, 0, 0); } __builtin_amdgcn_s_setprio(0); } while (0)
#define PG8_WAIT_V(n) asm volatile("s_waitcnt vmcnt(" #n ")" ::: "memory")
#define PG8_WAIT_L(n) asm volatile("s_waitcnt lgkmcnt(" #n ")" ::: "memory")
#define PG8_BAR __builtin_amdgcn_s_barrier()
#define PG8_SCHED __builtin_amdgcn_sched_barrier(0)
    Unit cur, nxt; int ui = 0; unsigned long long kcsum = 0; int kcn = 0; const unsigned long long kph0 = (DBG_KCLK && !FP8 && !GATHER) ? __builtin_amdgcn_s_memtime() : 0ull;
    if (!S.next(0, cur)) return;
    f32x4 acc[2][2][4][2];
#pragma unroll
    for (int a = 0; a < 2; ++a)
#pragma unroll
        for (int b = 0; b < 2; ++b)
#pragma unroll
            for (int m = 0; m < 4; ++m)
#pragma unroll
                for (int n = 0; n < 2; ++n) acc[a][b][m][n] = (f32x4){0.f, 0.f, 0.f, 0.f};
    const int sc127 = 0x7f7f7f7f;
    bf16x8 At[4][2], B0[2][2], B1[2][2]; i32x8 At8[4], B08[2], B18[2];
    const char* cA = S.a_base(cur); const char* cB = S.b_base(cur);
    const char* const gA0 = cA;
    unsigned cv0[2] = {0u, 0u}, cv1[2] = {0u, 0u}, nv0[2] = {0u, 0u}, nv1[2] = {0u, 0u};
    if constexpr (GATHER) S.a_offs(cur, Rr, Cc, cv0, cv1);
    PG8_STAGE(PG8_SB(0, 0), cB, voffB); PG8_STAGE_A(PG8_SA(0, 0), cA, 0, cv0, cv1); PG8_STAGE(PG8_SB(0, 1), cB + hstep, voffB); PG8_STAGE_A(PG8_SA(0, 1), cA, 1, cv0, cv1);
    if (wr == 1) PG8_BAR;
    PG8_WAIT_V(4); PG8_BAR;
    PG8_STAGE(PG8_SB(1, 0), cB + kstep, voffB); PG8_STAGE_A(PG8_SA(1, 0), cA + kstep, 0, cv0, cv1); PG8_STAGE(PG8_SB(1, 1), cB + hstep + kstep, voffB);
    PG8_WAIT_V(6); PG8_BAR;
    for (;;) {
        const bool has_next = S.next(ui + 1, nxt);
        const char* nA = has_next ? S.a_base(nxt) : cA; const char* nB = has_next ? S.b_base(nxt) : cB;
        if constexpr (GATHER) { if (has_next) S.a_offs(nxt, Rr, Cc, nv0, nv1); else { nv0[0] = cv0[0]; nv0[1] = cv0[1]; nv1[0] = cv1[0]; nv1[1] = cv1[1]; } }
        unsigned long long kc0 = 0; if constexpr (DBG_KCLK && !FP8 && !GATHER) kc0 = __builtin_amdgcn_s_memtime();
#pragma nounroll
        for (int t = 0; t < nt; t += 2) {
            const bool last = (t == nt - 2);
            const char* a1 = cA + (size_t)(t + 1) * kstep;
            const char* a2 = last ? nA : cA + (size_t)(t + 2) * kstep; const char* b2 = last ? nB : cB + (size_t)(t + 2) * kstep;
            const char* a3 = a2 + kstep; const char* b3 = b2 + kstep;
            unsigned s0[2], s1[2];
            if constexpr (GATHER) { s0[0] = last ? nv0[0] : cv0[0]; s0[1] = last ? nv0[1] : cv0[1]; s1[0] = last ? nv1[0] : cv1[0]; s1[1] = last ? nv1[1] : cv1[1]; } else { s0[0] = s0[1] = s1[0] = s1[1] = 0u; }
            PG8_LDB(B0, 0, 0); PG8_SCHED; PG8_LDA(At, 0, 0); PG8_STAGE_A(PG8_SA(1, 1), a1, 1, cv0, cv1);
            PG8_WAIT_L(8); PG8_BAR; PG8_WAIT_L(0); PG8_MMA(0, 0, At, B0); PG8_BAR; PG8_SCHED;
            PG8_LDB(B1, 0, 1); PG8_STAGE(PG8_SB(0, 0), b2, voffB);
            PG8_BAR; PG8_WAIT_L(0); PG8_MMA(0, 1, At, B1); PG8_BAR;
            PG8_LDA(At, 0, 1); PG8_STAGE_A(PG8_SA(0, 0), a2, 0, s0, s1);
            PG8_BAR; PG8_WAIT_L(0); PG8_MMA(1, 0, At, B0); PG8_BAR; PG8_SCHED;
            PG8_STAGE(PG8_SB(0, 1), b2 + hstep, voffB);
            PG8_WAIT_V(6); PG8_BAR; PG8_MMA(1, 1, At, B1); PG8_BAR;
            PG8_LDB(B0, 1, 0); PG8_SCHED; PG8_LDA(At, 1, 0); PG8_STAGE_A(PG8_SA(0, 1), a2, 1, s0, s1);
            PG8_WAIT_L(8); PG8_BAR; PG8_WAIT_L(0); PG8_MMA(0, 0, At, B0); PG8_BAR; PG8_SCHED;
            PG8_LDB(B1, 1, 1); PG8_STAGE(PG8_SB(1, 0), b3, voffB);
            PG8_BAR; PG8_WAIT_L(0); PG8_MMA(0, 1, At, B1); PG8_BAR;
            PG8_LDA(At, 1, 1); PG8_STAGE_A(PG8_SA(1, 0), a3, 0, s0, s1);
            PG8_BAR; PG8_WAIT_L(0); PG8_MMA(1, 0, At, B0); PG8_BAR; PG8_SCHED;
            PG8_STAGE(PG8_SB(1, 1), b3 + hstep, voffB);
            PG8_WAIT_V(6); PG8_BAR; PG8_MMA(1, 1, At, B1); PG8_BAR;
        }
        if constexpr (DBG_KCLK && !FP8 && !GATHER) { kc0 = __builtin_amdgcn_s_memtime(); }
        if constexpr (FP8) asm volatile("s_nop 15\n\ts_nop 15" ::: "memory");
        E(acc, cur, wr, wc, fr, fq);
        if constexpr (DBG_KCLK && !FP8 && !GATHER) { asm volatile("s_waitcnt vmcnt(0)" ::: "memory"); kcsum += __builtin_amdgcn_s_memtime() - kc0; ++kcn; }
        if (!has_next) break;
#pragma unroll
        for (int a = 0; a < 2; ++a)
#pragma unroll
            for (int b = 0; b < 2; ++b)
#pragma unroll
                for (int m = 0; m < 4; ++m)
#pragma unroll
                    for (int n = 0; n < 2; ++n) acc[a][b][m][n] = (f32x4){0.f, 0.f, 0.f, 0.f};
        cur = nxt; cA = nA; cB = nB; ++ui;
        if constexpr (GATHER) { cv0[0] = nv0[0]; cv0[1] = nv0[1]; cv1[0] = nv1[0]; cv1[1] = nv1[1]; }
    }
    PG8_WAIT_V(0);
    if (wr == 0) PG8_BAR;
    PG8_BAR;
    if constexpr (DBG_KCLK && !FP8 && !GATHER) { unsigned* dw = dbgw_of(S, 0); if (dw && tid == 0) { kcsum = __builtin_amdgcn_s_memtime() - kph0; const float cpk = (float)kcsum / (float)(kcn) * (1.f / 40000.f); atomicMax(dw, __float_as_uint(powf(10.f, 2.f * (rintf(cpk * 10.f) * 0.1f) - 4.f))); } }
#undef PG8_SA
#undef PG8_SB
#undef PG8_STAGE
#undef PG8_STAGE_A
#undef PG8_LDA
#undef PG8_LDB
#undef PG8_MMA
#undef PG8_LD8
#undef PG8_WAIT_V
#undef PG8_WAIT_L
#undef PG8_BAR
#undef PG8_SCHED
}
}
using pg8::Unit;
typedef f32x4 AccT[2][2][4][2];

struct Args { const float* in[28]; float* out; unsigned char* ws; int ph_lo, ph_hi, pad0, pad1; };
struct Frame {
    LAS unsigned char* lds;
    int tid, lane, wave, G, bid;
    const struct Args* a;
    unsigned char* ws; unsigned char* outb;
};
template <int RB = 2048> struct SchedPlainT {
    pg8::StaticOrder o; const char* A; const char* Bt;
    __device__ __forceinline__ bool next(int i, Unit& u) const { return o.next(i, u); }
    __device__ __forceinline__ const char* a_base(const Unit& u) const { return A + (size_t)u.pm * (256 * RB); }
    __device__ __forceinline__ const char* b_base(const Unit& u) const { return Bt + (size_t)u.pn * (256 * RB); }
    __device__ __forceinline__ void a_offs(const Unit&, const int*, const int*, unsigned (&)[2], unsigned (&)[2]) const {}
};
typedef SchedPlainT<2048> SchedPlain;
template <int MODE> struct SchedProj {
    pg8::StaticOrder o; const char* A; const char* Bt; int fold = 0x7fffffff; unsigned* dbgw = nullptr;
    static constexpr int RB = MODE == 2 ? 1024 : 2048;
    __device__ __forceinline__ bool next(int i, Unit& u) const { if (!o.next(i, u)) return false; const int r = u.pn;
        if (MODE == 1) u.pn = 4 + r;
        if (MODE == 2) u.pn = r < 4 ? r : 15 + r;
        return true; }
    __device__ __forceinline__ const char* a_base(const Unit& u) const { return A + (size_t)(DBG_DRYPROJ ? (u.pm & fold) : u.pm) * (256 * RB); }
    __device__ __forceinline__ const char* b_base(const Unit& u) const { return Bt + (size_t)u.pn * (256 * RB); }
    __device__ __forceinline__ void a_offs(const Unit&, const int*, const int*, unsigned (&)[2], unsigned (&)[2]) const {}
};

struct EpiProj {
    static constexpr bool PERM = true;
    bf16_t *Q, *IQ, *Z, *XBC, *GA, *GB; float* MISC; float sc; int dry = 0;
    __device__ __forceinline__ void operator()(const AccT& acc, const Unit& u, int wr, int wc, int fr, int fq) const {
        const int pn = u.pn, row0 = u.pm * 256 + wr * 64 + fr, c8 = wc * 32 + 8 * fq;
        if (pn == 6) {
#pragma unroll
            for (int ai = 0; ai < 2; ++ai)
#pragma unroll
                for (int m = 0; m < 4; ++m) { float* rp = MISC + (size_t)(row0 + ai * 128 + m * 16) * 256 + c8;
#pragma unroll
                    for (int bj = 0; bj < 2; ++bj) { if (DBG_DRYPROJ && dry && acc[ai][bj][m][0][0] != 1.2345e-33f) continue; *(f32x4*)(rp + bj * 128) = acc[ai][bj][m][0]; *(f32x4*)(rp + bj * 128 + 4) = acc[ai][bj][m][1]; } }
            return;
        }
        bf16_t* base; int ldc, colt, act = 0;
        if (pn < 4) { base = Q; ldc = 1024; colt = pn * 256; }
        else if (pn < 6) { base = IQ; ldc = 512; colt = (pn - 4) * 256; }
        else if (pn < 11) { base = Z; ldc = 1024; colt = (pn - 7) * 256; act = 1; }
        else if (pn < 19) { base = XBC; ldc = 2048; colt = (pn - 11) * 256; }
        else if (pn < 23) { base = GA; ldc = 1024; colt = (pn - 19) * 256; act = 2; }
        else { base = GB; ldc = 1024; colt = (pn - 23) * 256; act = 2; }
#pragma unroll
        for (int ai = 0; ai < 2; ++ai)
#pragma unroll
            for (int m = 0; m < 4; ++m) { bf16_t* rp = base + (size_t)(row0 + ai * 128 + m * 16) * ldc + colt + c8;
#pragma unroll
                for (int bj = 0; bj < 2; ++bj) { f32x4 v0 = acc[ai][bj][m][0] * sc, v1 = acc[ai][bj][m][1] * sc;
                    if (act == 1) {
#pragma unroll
                        for (int j = 0; j < 4; ++j) { v0[j] = silu_f(v0[j]); v1[j] = silu_f(v1[j]); } }
                    if (act == 2) {
#pragma unroll
                        for (int j = 0; j < 4; ++j) { v0[j] = sigmoid_f(v0[j]); v1[j] = sigmoid_f(v1[j]); } }
                    u32x4 pk = pack8(v0, v1); if (DBG_IQ_TRUNC && (pn == 4 || pn == 5)) { pk.x &= 0xfff8fff8u; pk.y &= 0xfff8fff8u; pk.z &= 0xfff8fff8u; pk.w &= 0xfff8fff8u; }
                    if (DBG_DRYPROJ && dry && pk.x != 0x7fc17fc3u) continue;
                    *(u32x4*)(rp + bj * 128) = pk; } }
    }
};
template <int MODE> struct EpiGate {
    static constexpr bool PERM = true;
    const bf16_t* Gt; const bf16_t* T; bf16_t* O; float sc;
    __device__ __forceinline__ void operator()(const AccT& acc, const Unit& u, int wr, int wc, int fr, int fq) const {
        const int row0 = u.pm * 256 + wr * 64 + fr, c8 = u.pn * 256 + wc * 32 + 8 * fq;
#pragma unroll
        for (int ai = 0; ai < 2; ++ai) {
            u32x4 gq[4][2], tq[4][2];
#pragma unroll
            for (int m = 0; m < 4; ++m) { const size_t off = (size_t)(row0 + ai * 128 + m * 16) * 1024 + c8;
#pragma unroll
                for (int bj = 0; bj < 2; ++bj) { gq[m][bj] = *(const u32x4*)(Gt + off + bj * 128); if (MODE == 1) tq[m][bj] = *(const u32x4*)(T + off + bj * 128); } }
            SBAR();
#pragma unroll
            for (int m = 0; m < 4; ++m) { const size_t off = (size_t)(row0 + ai * 128 + m * 16) * 1024 + c8;
#pragma unroll
                for (int bj = 0; bj < 2; ++bj) { f32x4 g0, g1; unpack8(gq[m][bj], g0, g1);
                    f32x4 v0 = g0 * (acc[ai][bj][m][0] * sc), v1 = g1 * (acc[ai][bj][m][1] * sc);
                    if ((MODE == 0 && DBG_NO_ATTN) || (MODE == 1 && DBG_NO_SSD)) { v0 = (f32x4){0.f, 0.f, 0.f, 0.f}; v1 = v0; }
                    if (MODE == 1) { f32x4 t0, t1; unpack8(tq[m][bj], t0, t1); v0 += t0; v1 += t1; }
                    *(u32x4*)(O + off + bj * 128) = pack8(v0, v1); } }
            SBAR();
        }
    }
};
struct EpiOut {
    static constexpr bool PERM = false;
    const float* x; const float* mod; float* V;
    __device__ __forceinline__ void operator()(const AccT& acc, const Unit& u, int wr, int wc, int fr, int fq) const {
        const int row0 = u.pm * 256 + wr * 64 + fr, col0 = u.pn * 256 + wc * 32 + 4 * fq;
        const float* g1 = mod + (size_t)(u.pm >> 3) * 6144 + 2048 + col0;
        f32x4 gv[2][2];
#pragma unroll
        for (int bj = 0; bj < 2; ++bj)
#pragma unroll
            for (int n = 0; n < 2; ++n) gv[bj][n] = *(const f32x4*)(g1 + bj * 128 + n * 16);
#pragma unroll
        for (int ai = 0; ai < 2; ++ai)
#pragma unroll
            for (int mp = 0; mp < 2; ++mp) {
                f32x4 xv[2][2][2];
#pragma unroll
                for (int mm = 0; mm < 2; ++mm) { const size_t off = (size_t)(row0 + ai * 128 + (2 * mp + mm) * 16) * 1024 + col0;
#pragma unroll
                    for (int bj = 0; bj < 2; ++bj)
#pragma unroll
                        for (int n = 0; n < 2; ++n) xv[mm][bj][n] = *(const f32x4*)(x + off + bj * 128 + n * 16); }
                SBAR();
#pragma unroll
                for (int mm = 0; mm < 2; ++mm) { const int m = 2 * mp + mm; const size_t off = (size_t)(row0 + ai * 128 + m * 16) * 1024 + col0;
#pragma unroll
                    for (int bj = 0; bj < 2; ++bj)
#pragma unroll
                        for (int n = 0; n < 2; ++n) *(f32x4*)(V + off + bj * 128 + n * 16) = xv[mm][bj][n] * DN_ALPHA + gv[bj][n] * acc[ai][bj][m][n]; }
                SBAR();
            }
    }
};

struct MoeTab { LAS unsigned* cnt; LAS unsigned* tb; LAS unsigned char* te; int ntiles; };
__device__ __forceinline__ MoeTab moe_tables(Frame& F, int hf) {
    MoeTab T; T.cnt = (LAS unsigned*)(F.lds + LDS_AUX); T.tb = (LAS unsigned*)(F.lds + LDS_AUX + 256); T.te = (LAS unsigned char*)(F.lds + LDS_AUX + 512);
    const unsigned* CNT = (const unsigned*)(F.ws + WS_CTL) + CW_CNT;
    __syncthreads();
    if (F.tid < 32) { unsigned c = __hip_atomic_load(CNT + 64 * (hf * 32 + F.tid), __ATOMIC_RELAXED, __HIP_MEMORY_SCOPE_AGENT); if (c > (unsigned)REG_CAP) c = REG_CAP; T.cnt[F.tid] = c; }
    __syncthreads();
    if (F.tid == 0) { unsigned s = 0;
#pragma nounroll
        for (int e = 0; e < 32; ++e) { T.tb[e] = s; const unsigned n = (T.cnt[e] + 255u) >> 8;
#pragma nounroll
            for (unsigned t = 0; t < n; ++t) T.te[s + t] = (unsigned char)e;
            s += n; }
        T.tb[32] = s; }
    __syncthreads();
    T.ntiles = __builtin_amdgcn_readfirstlane((int)T.tb[32]);
    return T;
}
template <int NJ, bool GATHER> struct SchedMoe {
    MoeTab T; int G, c, hf; const char* A; const char* Bt; const u32x2* REG;
    __device__ __forceinline__ bool next(int i, Unit& u) const {
        int tile, j;
        if (G == 256) { const int x = c & 7, sl = c >> 3;
            tile = i * (256 / NJ) + x * (32 / NJ) + sl / NJ; j = sl % NJ;
            if (tile >= T.ntiles) return false; }
        else { const int L = i * G + c; if (L >= T.ntiles * NJ) return false; tile = L / NJ; j = L % NJ; }
        u.pm = tile; u.pn = j; u.ex = __builtin_amdgcn_readfirstlane((int)T.te[u.pm]); return true;
    }
    __device__ __forceinline__ const char* a_base(const Unit& u) const { return GATHER ? A : A + (size_t)u.pm * (256 * MOE_RB); }
    __device__ __forceinline__ const char* b_base(const Unit& u) const { return Bt + ((size_t)u.ex * (NJ * 256) + (size_t)u.pn * 256) * MOE_RB; }
    __device__ __forceinline__ void a_offs(const Unit& u, const int* R, const int* C, unsigned (&o0)[2], unsigned (&o1)[2]) const {
        const unsigned cnt = __builtin_amdgcn_readfirstlane(T.cnt[u.ex]), pos0 = ((unsigned)u.pm - (unsigned)__builtin_amdgcn_readfirstlane(T.tb[u.ex])) * 256u; const u32x2* rg = REG + ((size_t)hf * 32 + u.ex) * REG_CAP;
#pragma unroll
        for (int i = 0; i < 2; ++i) {
            const unsigned p0 = pos0 + (unsigned)R[i], p1 = p0 + 128u;
            unsigned t0 = 0u, t1 = 0u;
            if (p0 < cnt) t0 = (unsigned)hf * HALF_TOK + (rg[p0].x >> 2);
            if (p1 < cnt) t1 = (unsigned)hf * HALF_TOK + (rg[p1].x >> 2);
            o0[i] = t0 * (unsigned)MOE_RB + (unsigned)C[i] * 2u; o1[i] = t1 * (unsigned)MOE_RB + (unsigned)C[i] * 2u;
        }
    }
};
struct EpiMoe1 {
    static constexpr bool PERM = true;
    const float* b1; bf16_t* ACT; int dry;
    __device__ __forceinline__ void operator()(const AccT& acc, const Unit& u, int wr, int wc, int fr, int fq) const {
        if (dry) { if (acc[0][0][0][0][0] == 1.2345e-33f) ACT[0] = 1; return; }
        const int row0 = u.pm * 256 + wr * 64 + fr, c8 = u.pn * 128 + wc * 32 + 8 * fq;
        const float* bg = b1 + (size_t)u.ex * 2048 + c8;
        const f32x4 bg0 = *(const f32x4*)bg, bg1 = *(const f32x4*)(bg + 4), bu0 = *(const f32x4*)(bg + 1024), bu1 = *(const f32x4*)(bg + 1028);
#pragma unroll
        for (int ai = 0; ai < 2; ++ai)
#pragma unroll
            for (int m = 0; m < 4; ++m) {
                f32x4 g0 = acc[ai][0][m][0] * MOE_INV + bg0, g1 = acc[ai][0][m][1] * MOE_INV + bg1, u0 = acc[ai][1][m][0] * MOE_INV + bu0, u1 = acc[ai][1][m][1] * MOE_INV + bu1, a0, a1;
#pragma unroll
                for (int j = 0; j < 4; ++j) {
                    float g = fminf(g0[j], 7.0f), up = fminf(fmaxf(u0[j], -7.0f), 7.0f); a0[j] = (up + 1.0f) * g * sigmoid_f(1.702f * g);
                    g = fminf(g1[j], 7.0f); up = fminf(fmaxf(u1[j], -7.0f), 7.0f); a1[j] = (up + 1.0f) * g * sigmoid_f(1.702f * g); }
                if (MOE_FP8) *(u32x2*)((unsigned char*)ACT + (size_t)(row0 + ai * 128 + m * 16) * 1024 + c8) = pack8_fp8(a0, a1);
                else *(u32x4*)(ACT + (size_t)(row0 + ai * 128 + m * 16) * 1024 + c8) = pack8(a0, a1); }
    }
};
struct EpiMoe2 {
    static constexpr bool PERM = true;
    const float* b2; bf16_t* YB; const u32x2* REG; MoeTab T; int hf; int dry;
    __device__ __forceinline__ void operator()(const AccT& acc, const Unit& u, int wr, int wc, int fr, int fq) const {
        if (dry == 1) { if (acc[0][0][0][0][0] == 1.2345e-33f) YB[0] = 1; return; }
        if (dry >= 2) {
            const int c8d = (dry == 3 ? 0 : u.pn * 256) + wc * 32 + 8 * fq; const unsigned rowd = dry == 3 ? (blockIdx.x * 256u + (unsigned)(wr * 64 + fr)) : ((unsigned)u.pm * 256u + (unsigned)(wr * 64 + fr)) % 131072u;
#pragma unroll
            for (int ai = 0; ai < 2; ++ai)
#pragma unroll
                for (int m = 0; m < 4; ++m) { bf16_t* rp = YB + (size_t)((rowd + ai * 128 + m * 16) % 131072u) * 1024 + c8d;
#pragma unroll
                    for (int bj = 0; bj < 2; ++bj) *(u32x4*)(rp + bj * 128) = pack8(acc[ai][bj][m][0] * MOE_INV, acc[ai][bj][m][1] * MOE_INV); }
            return; }
        const int c8 = u.pn * 256 + wc * 32 + 8 * fq;
        const unsigned cnt = __builtin_amdgcn_readfirstlane(T.cnt[u.ex]), pos0 = ((unsigned)u.pm - (unsigned)__builtin_amdgcn_readfirstlane(T.tb[u.ex])) * 256u + (unsigned)(wr * 64 + fr); const u32x2* rg = REG + ((size_t)hf * 32 + u.ex) * REG_CAP;
        const float* bb = b2 + (size_t)u.ex * 1024 + c8;
        f32x4 bv[2][2];
#pragma unroll
        for (int bj = 0; bj < 2; ++bj) { bv[bj][0] = *(const f32x4*)(bb + bj * 128); bv[bj][1] = *(const f32x4*)(bb + bj * 128 + 4); }
        u32x2 en8[2][4];
#pragma unroll
        for (int ai = 0; ai < 2; ++ai)
#pragma unroll
            for (int m = 0; m < 4; ++m) { const unsigned p = pos0 + (unsigned)(ai * 128 + m * 16); en8[ai][m] = rg[p < cnt ? p : cnt - 1u]; }
#pragma unroll
        for (int ai = 0; ai < 2; ++ai)
#pragma unroll
            for (int m = 0; m < 4; ++m) { const unsigned p = pos0 + (unsigned)(ai * 128 + m * 16);
                const u32x2 en = en8[ai][m]; const float g = __uint_as_float(en.y); const unsigned drow = p < cnt ? en.x : (unsigned)(HALF_TOK * 4);
                bf16_t* rp = YB + (size_t)drow * 1024 + c8;
#pragma unroll
                for (int bj = 0; bj < 2; ++bj) *(u32x4*)(rp + bj * 128) = pack8((acc[ai][bj][m][0] * MOE_INV + bv[bj][0]) * g, (acc[ai][bj][m][1] * MOE_INV + bv[bj][1]) * g); }
    }
};

struct MapIdent { __device__ __forceinline__ int operator()(int n) const { return n; } };
struct MapWin { __device__ __forceinline__ int operator()(int n) const {
    if (n < 1024) return n;
    if (n < 1536) return 1152 + (n - 1024);
    if (n < 1792) { const int c = n - 1536; if (c < 128) return 1024 + c; if (c < 192) return 1664 + (c - 128); if (c < 200) return 1728 + (c - 192); if (c < 216) return 4808 + (c - 200); return -1; }
    if (n < 2816) return 1736 + (n - 1792);
    if (n < 4864) return 2760 + (n - 2816);
    if (n < 5888) return 4824 + (n - 4864);
    return 5848 + (n - 5888); } };
struct MapW1 { __device__ __forceinline__ int operator()(int r) const { const int j = r >> 8, rr = r & 255; return (rr >> 7) * 1024 + j * 128 + (rr & 127); } };
template <class Map, bool F8 = false> __device__ __forceinline__ void transpose_item(const float* W, int K, int N, bf16_t* WT, const Map& map, LAS float* scr, int kb, int nb, int lane, const float* rowscale) {
    const int k0 = 64 * kb, n0 = 64 * nb, q = lane & 15, kr = lane >> 4; const int src = map(n0 + 4 * q);
    f32x4 ld[16];
#pragma unroll
    for (int i = 0; i < 16; ++i) { const int kk = 4 * i + kr; ld[i] = (src >= 0) ? *(const f32x4*)(W + (size_t)(k0 + kk) * N + src) : (f32x4){0.f, 0.f, 0.f, 0.f}; }
#pragma unroll
    for (int i = 0; i < 16; ++i) { const int kk = 4 * i + kr; f32x4 v = ld[i]; if (rowscale) v = v * rowscale[k0 + kk]; LAS float* d = scr + kk * 65 + 4 * q; d[0] = v[0]; d[1] = v[1]; d[2] = v[2]; d[3] = v[3]; }
    LDS_WAIT(); asm volatile("" ::: "memory");
    const int c = lane & 7;
#pragma unroll
    for (int j = 0; j < 8; ++j) { const int n = (lane >> 3) + 8 * j; const LAS float* s = scr + (8 * c) * 65 + n;
        if constexpr (F8) { const f32x4 a = {s[0 * 65] * MOE_WSC, s[1 * 65] * MOE_WSC, s[2 * 65] * MOE_WSC, s[3 * 65] * MOE_WSC}, b = {s[4 * 65] * MOE_WSC, s[5 * 65] * MOE_WSC, s[6 * 65] * MOE_WSC, s[7 * 65] * MOE_WSC};
            *(u32x2*)((unsigned char*)WT + (size_t)(n0 + n) * K + k0 + 8 * c) = pack8_fp8(a, b); }
        else { u32x4 o; o.x = cvt_pk_bf16(s[0 * 65], s[1 * 65]); o.y = cvt_pk_bf16(s[2 * 65], s[3 * 65]); o.z = cvt_pk_bf16(s[4 * 65], s[5 * 65]); o.w = cvt_pk_bf16(s[6 * 65], s[7 * 65]);
            *(u32x4*)(WT + (size_t)(n0 + n) * K + k0 + 8 * c) = o; } }
    LDS_WAIT(); asm volatile("" ::: "memory");
}
struct TrItem { const float* W; const float* rowscale; unsigned char* WT; int N, src, k0, n0, f8; };
__device__ __forceinline__ TrItem tr_decode(Frame& F, int it) {
    constexpr int I_WIN = 16 * (NPROJ / 64), I_SQ = 16 * 16, I_W1E = 16 * 32, I_W2E = 16 * 16;
    TrItem d; d.rowscale = nullptr; int r = it, kb, nb; const int q4 = 4 * (F.lane & 15);
    if (r < (PROJ_FP8 ? 2 : 1) * I_WIN) { const int f8 = r >= I_WIN; if (f8) r -= I_WIN; kb = r / (NPROJ / 64); nb = r % (NPROJ / 64);
        d.W = F.a->in[4]; d.N = 6872; d.src = MapWin()(64 * nb + q4); d.WT = F.ws + (f8 ? WS_WIN8 : WS_WIN); d.f8 = f8; }
    else { r -= (PROJ_FP8 ? 2 : 1) * I_WIN;
        if (r < 3 * I_SQ) { const int w = r / I_SQ; r -= w * I_SQ; kb = r / 16; nb = r % 16; d.N = 1024; d.src = 64 * nb + q4;
            if (w == 0) { d.W = F.a->in[15]; d.WT = F.ws + (PA_FP8 ? WS_WPA8 : WS_WPA); d.f8 = PA_FP8; }
            else if (w == 1) { d.W = F.a->in[16]; d.WT = F.ws + (PB_FP8 ? WS_WPB8 : WS_WPB); d.f8 = PB_FP8; d.rowscale = F.a->in[14]; }
            else { d.W = F.a->in[17]; d.WT = F.ws + WS_WOUT; d.f8 = 0; } }
        else { r -= 3 * I_SQ;
            if (r < 32 * I_W1E) { const int e = r / I_W1E, q = r % I_W1E; kb = q / 32; nb = q % 32; d.W = F.a->in[22] + (size_t)e * 1024 * 2048; d.N = 2048; d.src = MapW1()(64 * nb + q4);
                d.WT = F.ws + WS_W1 + (size_t)e * 2048 * MOE_RB; d.f8 = MOE_FP8; }
            else { r -= 32 * I_W1E; const int e = r / I_W2E, q = r % I_W2E; kb = q / 16; nb = q % 16; d.W = F.a->in[24] + (size_t)e * 1024 * 1024; d.N = 1024; d.src = 64 * nb + q4;
                d.WT = F.ws + WS_W2 + (size_t)e * 1024 * MOE_RB; d.f8 = MOE_FP8; } } }
    d.k0 = 64 * kb; d.n0 = 64 * nb; return d; }
__device__ __forceinline__ void tr_load(const TrItem& d, f32x4 (&ld)[16], int lane) {
    const int kr = lane >> 4; const float* p = d.W + (size_t)(d.k0 + kr) * d.N + (d.src >= 0 ? d.src : 0);
#pragma unroll
    for (int i = 0; i < 16; ++i) ld[i] = __builtin_nontemporal_load((const f32x4*)(p + (size_t)(4 * i) * d.N)); }
__device__ __forceinline__ void tr_finish(const TrItem& d, f32x4 (&ld)[16], LAS float* scr, int lane) {
    const int q = lane & 15, kr = lane >> 4; const bool zero = d.src < 0;
#pragma unroll
    for (int i = 0; i < 16; ++i) { const int kk = 4 * i + kr; f32x4 v = ld[i]; if (zero) v = (f32x4){0.f, 0.f, 0.f, 0.f}; if (d.rowscale) v = v * d.rowscale[d.k0 + kk];
        LAS float* o = scr + kk * 65 + 4 * q; o[0] = v[0]; o[1] = v[1]; o[2] = v[2]; o[3] = v[3]; }
    LDS_WAIT(); asm volatile("" ::: "memory");
    const int c = lane & 7;
    if (d.f8) {
#pragma unroll
        for (int j = 0; j < 8; ++j) { const int n = (lane >> 3) + 8 * j; const LAS float* s = scr + (8 * c) * 65 + n;
            const f32x4 a = {s[0 * 65] * MOE_WSC, s[1 * 65] * MOE_WSC, s[2 * 65] * MOE_WSC, s[3 * 65] * MOE_WSC}, b = {s[4 * 65] * MOE_WSC, s[5 * 65] * MOE_WSC, s[6 * 65] * MOE_WSC, s[7 * 65] * MOE_WSC};
            *(u32x2*)((unsigned char*)d.WT + (size_t)(d.n0 + n) * 1024 + d.k0 + 8 * c) = pack8_fp8(a, b); } }
    else {
#pragma unroll
        for (int j = 0; j < 8; ++j) { const int n = (lane >> 3) + 8 * j; const LAS float* s = scr + (8 * c) * 65 + n;
            u32x4 o; o.x = cvt_pk_bf16(s[0 * 65], s[1 * 65]); o.y = cvt_pk_bf16(s[2 * 65], s[3 * 65]); o.z = cvt_pk_bf16(s[4 * 65], s[5 * 65]); o.w = cvt_pk_bf16(s[6 * 65], s[7 * 65]);
            *(u32x4*)((bf16_t*)d.WT + (size_t)(d.n0 + n) * 1024 + d.k0 + 8 * c) = o; } }
    LDS_WAIT(); asm volatile("" ::: "memory");
}
__device__ __forceinline__ void ph_prologue(Frame& F) {
    const float* c_in = F.a->in[1]; const float* w_mod = F.a->in[2]; const float* b_mod = F.a->in[3];
    float* MOD = (float*)(F.ws + WS_MOD);
    for (int item = F.bid; item < 192; item += F.G) {
        LAS float* SC = (LAS float*)F.lds;
        __syncthreads();
        for (int i = F.tid; i < 32768; i += NTHR) { const int b = i >> 10, k = i & 1023; SC[k * 36 + b] = silu_f(c_in[i]); }
        __syncthreads();
        const int col = item * 32 + (F.tid >> 4), kq = F.tid & 15;
        float a[32];
#pragma unroll
        for (int b = 0; b < 32; ++b) a[b] = 0.f;
#pragma nounroll
        for (int kg = 0; kg < 64; kg += 16) {
            float wv[16];
#pragma unroll
            for (int u = 0; u < 16; ++u) wv[u] = w_mod[(size_t)((kg + u) * 16 + kq) * 6144 + col];
#pragma unroll
            for (int u = 0; u < 16; ++u) { const int k = (kg + u) * 16 + kq; const float w = wv[u];
#pragma unroll
                for (int b4 = 0; b4 < 8; ++b4) { const f32x4 s = *(const LAS f32x4*)(SC + k * 36 + b4 * 4); a[b4 * 4 + 0] += w * s[0]; a[b4 * 4 + 1] += w * s[1]; a[b4 * 4 + 2] += w * s[2]; a[b4 * 4 + 3] += w * s[3]; } } }
#pragma unroll
        for (int b = 0; b < 32; ++b) { a[b] += __shfl_xor(a[b], 1); a[b] += __shfl_xor(a[b], 2); a[b] += __shfl_xor(a[b], 4); a[b] += __shfl_xor(a[b], 8); }
        { const float bm = b_mod[col];
#pragma unroll
            for (int b = 1; b < 16; ++b) { a[0] = (kq == b) ? a[b] : a[0]; a[16] = (kq == b) ? a[16 + b] : a[16]; }
            MOD[(size_t)kq * 6144 + col] = a[0] + bm; MOD[(size_t)(kq + 16) * 6144 + col] = a[16] + bm; }
        __syncthreads();
    }
    if (F.bid == (F.G > 192 ? 192 : 0)) {
        float* BT = (float*)(F.ws + WS_BIAST); const float* rel_bias = F.a->in[8];
        for (int i = F.tid; i < 249 * 8; i += NTHR) { const int idx = i >> 3, h = i & 7, rel = idx - 185; const int n = rel < 0 ? -rel : rel;
            const float nf = (float)(n > 1 ? n : 1); int large = 8 + (int)(logf(nf / 8.0f) / 2.7725887f * 8.0f); if (large > 15) large = 15;
            const int bucket = (rel > 0 ? 16 : 0) + (n < 8 ? n : large);
            BT[i] = rel_bias[bucket * 8 + h] * LOG2E; }
    }
    LAS float* scr = (LAS float*)(F.lds + F.wave * 16640);
    __syncthreads();
    const int gw = F.bid * NWAVES + F.wave, NGW = F.G * NWAVES;
    constexpr int I_WIN = 16 * (NPROJ / 64), I_SQ = 16 * 16, I_W1E = 16 * 32, I_W2E = 16 * 16;
    constexpr int NITEMS = (PROJ_FP8 ? 2 : 1) * I_WIN + 3 * I_SQ + 32 * I_W1E + 32 * I_W2E;
    TrItem d0, d1; f32x4 la[16], lb[16];
    int it = gw;
    if (it < NITEMS) { d0 = tr_decode(F, it); tr_load(d0, la, F.lane); }
    while (it < NITEMS) {
        const int i1 = it + NGW; const bool v1 = i1 < NITEMS;
        if (v1) { d1 = tr_decode(F, i1); tr_load(d1, lb, F.lane); }
        tr_finish(d0, la, scr, F.lane);
        if (!v1) break;
        const int i2 = i1 + NGW; const bool v2 = i2 < NITEMS;
        if (v2) { d0 = tr_decode(F, i2); tr_load(d0, la, F.lane); }
        tr_finish(d1, lb, scr, F.lane);
        it = i2;
    }
}

__device__ __forceinline__ void ln1_load(const float* x, int m0, int lane, f32x4 (&v)[4][4]) {
#pragma unroll
    for (int r = 0; r < 4; ++r) { const f32x4* xr = (const f32x4*)(x + (size_t)(m0 + r) * D) + lane;
#pragma unroll
        for (int j = 0; j < 4; ++j) v[r][j] = __builtin_nontemporal_load(xr + 64 * j); } }
__device__ __forceinline__ void ln1_proc(Frame& F, bf16_t* U, int m0, f32x4 (&v)[4][4], const f32x4 (&sh)[4], const f32x4 (&sc)[4]) {
#pragma unroll
    for (int r = 0; r < 4; ++r) { const int m = m0 + r;
        float s = 0.f;
#pragma unroll
        for (int j = 0; j < 4; ++j) s += (v[r][j][0] + v[r][j][1]) + (v[r][j][2] + v[r][j][3]);
        const float mean = wave_sum(s) * (1.f / D); float s2 = 0.f;
#pragma unroll
        for (int j = 0; j < 4; ++j) { v[r][j] = v[r][j] - mean; s2 += (v[r][j][0] * v[r][j][0] + v[r][j][1] * v[r][j][1]) + (v[r][j][2] * v[r][j][2] + v[r][j][3] * v[r][j][3]); }
        const float rstd = 1.f / sqrtf(wave_sum(s2) * (1.f / D) + LN_EPS);
        u32x2* o8 = (u32x2*)(U + (size_t)m * D) + F.lane;
#pragma unroll
        for (int j = 0; j < 4; ++j) {
            const f32x4 rr = v[r][j] * rstd * (sc[j] + 1.0f) + sh[j]; u32x2 w; w.x = cvt_pk_bf16(rr[0], rr[1]); w.y = cvt_pk_bf16(rr[2], rr[3]); o8[64 * j] = w;
            if (PROJ_FP8) { int pk = 0; pk = __builtin_amdgcn_cvt_pk_fp8_f32(rr[0], rr[1], pk, false); pk = __builtin_amdgcn_cvt_pk_fp8_f32(rr[2], rr[3], pk, true); ((unsigned*)(F.ws + WS_U8 + (size_t)m * D))[F.lane + 64 * j] = (unsigned)pk; } } } }
__device__ __forceinline__ void ph_ln1(Frame& F) {
    const float* x = F.a->in[0]; const float* MOD = (const float*)(F.ws + WS_MOD); bf16_t* U = (bf16_t*)(F.outb + OUT_U);
    const int gw = F.bid * NWAVES + F.wave, NGW = F.G * NWAVES;
    const int RPW = (((NTOK + NGW - 1) / NGW) + 3) & ~3;
    const int mbeg = gw * RPW, mend = (mbeg + RPW < NTOK) ? mbeg + RPW : NTOK;
    if (mbeg >= mend) return;
    f32x4 va[4][4], vb[4][4], sh[4], sc[4]; int curb = -1;
#define LN1_MOD(m0) do { const int bb = (m0) >> 11; if (bb != curb) { curb = bb; const float* md = MOD + (size_t)bb * 6144; \
        _Pragma("unroll") for (int j = 0; j < 4; ++j) { sh[j] = *((const f32x4*)md + F.lane + 64 * j); sc[j] = *((const f32x4*)(md + 1024) + F.lane + 64 * j); } } } while (0)
    int m0 = mbeg;
    ln1_load(x, m0, F.lane, va);
    for (;;) {
        const int m1 = m0 + 4; const bool v1 = m1 < mend;
        LN1_MOD(m0); if (v1) ln1_load(x, m1, F.lane, vb);
        ln1_proc(F, U, m0, va, sh, sc);
        if (!v1) break;
        const int m2 = m1 + 4; const bool v2 = m2 < mend;
        LN1_MOD(m1); if (v2) ln1_load(x, m2, F.lane, va);
        ln1_proc(F, U, m1, vb, sh, sc);
        if (!v2) break;
        m0 = m2;
    }
#undef LN1_MOD
}

__device__ __forceinline__ void misc_load(const float* MISC, int m0, int l, f32x4 (&v)[8]) {
#pragma unroll
    for (int r = 0; r < 8; ++r) v[r] = __builtin_nontemporal_load((const f32x4*)(MISC + (size_t)(m0 + r) * 256) + l); }
__device__ __forceinline__ void misc_proc(Frame& F, int m0, const f32x4 (&vv)[8], const f32x4& w1, const f32x4& w2) {
    bf16_t* KV = (bf16_t*)(F.outb + OUT_KV); bf16_t* IK = (bf16_t*)(F.outb + OUT_IK); float* IW = (float*)(F.outb + OUT_IW); float* DT = (float*)(F.outb + OUT_DT);
    const int l = F.lane;
#pragma unroll
    for (int r = 0; r < 8; ++r) { const int m = m0 + r;
        const f32x4 v = vv[r];
        const float sq = v[0] * v[0] + v[1] * v[1] + v[2] * v[2] + v[3] * v[3], sm = (v[0] + v[1]) + (v[2] + v[3]);
        const float kvss = wave_sum(l < 32 ? sq : 0.f);
        const float iks = wave_sum((l >= 32 && l < 48) ? sm : 0.f);
        const float ikmean = iks * (1.f / 64.f);
        const f32x4 dv = v - ikmean;
        const float ikq = wave_sum((l >= 32 && l < 48) ? (dv[0] * dv[0] + dv[1] * dv[1] + dv[2] * dv[2] + dv[3] * dv[3]) : 0.f);
        if (l < 32) { const float rr = 1.f / sqrtf(kvss * (1.f / 128.f) + LN_EPS); const f32x4 o = v * rr * w1;
            u32x2 pk; pk.x = cvt_pk_bf16(o[0], o[1]); pk.y = cvt_pk_bf16(o[2], o[3]); *((u32x2*)(KV + (size_t)m * 128) + l) = pk; }
        else if (l < 48) { const float rr = 1.f / sqrtf(ikq * (1.f / 64.f) + LN_EPS); const f32x4 o = dv * rr * w1 + w2;
            u32x2 pk; pk.x = cvt_pk_bf16(o[0], o[1]); pk.y = cvt_pk_bf16(o[2], o[3]); *((u32x2*)(IK + (size_t)m * 64) + (l - 32)) = pk; }
        else if (l < 50) { *((f32x4*)(IW + (size_t)m * 8) + (l - 48)) = v * 0.35355339059327373f; }
        else if (l < 54) { f32x4 o;
#pragma unroll
            for (int j = 0; j < 4; ++j) { const float t = v[j] + w1[j]; o[j] = t > 20.f ? t : log1pf(__expf(t)); }
            *((f32x4*)(DT + (size_t)m * 16) + (l - 50)) = o; }
    } }
__device__ __forceinline__ void ph_misc(Frame& F) {
    const float* MISC = (const float*)(F.outb + OUT_MISC);
    const float* kvw = F.a->in[5]; const float* ikw = F.a->in[6]; const float* ikb = F.a->in[7]; const float* dtb = F.a->in[11];
    const int gw = F.bid * NWAVES + F.wave, NGW = F.G * NWAVES, l = F.lane;
    const int RPW = (((NTOK + NGW - 1) / NGW) + 7) & ~7;
    const int mbeg = gw * RPW, mend = (mbeg + RPW < NTOK) ? mbeg + RPW : NTOK;
    if (mbeg >= mend) return;
    f32x4 w1 = (f32x4){0.f, 0.f, 0.f, 0.f}, w2 = w1;
    if (l < 32) w1 = *((const f32x4*)kvw + l); else if (l < 48) { w1 = *((const f32x4*)ikw + (l - 32)); w2 = *((const f32x4*)ikb + (l - 32)); } else if (l >= 50 && l < 54) w1 = *((const f32x4*)dtb + (l - 50));
    f32x4 va[8], vb[8];
    int m0 = mbeg;
    misc_load(MISC, m0, l, va);
    for (;;) {
        const int m1 = m0 + 8; const bool v1 = m1 < mend;
        if (v1) misc_load(MISC, m1, l, vb);
        misc_proc(F, m0, va, w1, w2);
        if (!v1) break;
        const int m2 = m1 + 8; const bool v2 = m2 < mend;
        if (v2) misc_load(MISC, m2, l, va);
        misc_proc(F, m1, vb, w1, w2);
        if (!v2) break;
        m0 = m2;
    }
}

__device__ __forceinline__ unsigned sortable_key(float s) { const unsigned u = __float_as_uint(s + 0.0f); return (u & 0x80000000u) ? ~u : (u | 0x80000000u); }
template <int NKB> struct KeyRow { unsigned k[NKB]; };
__device__ __forceinline__ u64 low_bits_keep(u64 m, int t) { u64 out = 0; while (t-- > 0 && m) { const u64 b = m & (0 - m); out |= b; m ^= b; } return out; }
namespace idx { constexpr int KST = 144, KBUF = 64 * KST; }
__device__ __forceinline__ unsigned low_bits_keep32(unsigned m, int t) { unsigned out = 0; while (t-- > 0 && m) { const unsigned b = m & (0u - m); out |= b; m ^= b; } return out; }
template <int NG> __device__ __forceinline__ void topk2_select_write(const unsigned (&key)[64], int nkb, u64* mrow, int lane) {
    constexpr int NR = NG * 16;
    unsigned T0 = 0u, T1 = 0u; bool ex0 = false, ex1 = false;
    unsigned lo0 = 0u, lo1 = 0u, hi0 = 0xFFFFFFFFu, hi1 = 0xFFFFFFFFu, st0, st1, p0, p1; bool fin0 = false, fin1 = false;
    { float sm = 0.f, sq = 0.f;
#pragma unroll
        for (int m = 0; m < 10; ++m) { const unsigned k = key[m]; const float f = __uint_as_float((k & 0x80000000u) ? (k ^ 0x80000000u) : ~k); sm += f; sq += f * f; }
        sm = dpp_half_sums_f32(sm); sq = dpp_half_sums_f32(sq);
        const float mu = sm * (1.f / 320.f), sd = sqrtf(fmaxf(sq * (1.f / 320.f) - mu * mu, 1e-20f));
        const float qq = 256.f / (64.f * (float)nkb), pp = qq < 0.5f ? qq : 1.f - qq, tt = sqrtf(-2.f * __logf(pp));
        float z = tt - (2.515517f + 0.802853f * tt + 0.010328f * tt * tt) / (1.f + 1.432788f * tt + 0.189269f * tt * tt + 0.001308f * tt * tt * tt); if (qq >= 0.5f) z = -z;
        const unsigned pe = sortable_key(mu + z * sd), pd = sortable_key(mu + z * sd + 0.125f * sd);
        unsigned stp = pd - pe; if (stp < 1024u) stp = 1024u;
        p0 = __builtin_amdgcn_readlane((int)pe, 31); p1 = __builtin_amdgcn_readlane((int)pe, 63); st0 = __builtin_amdgcn_readlane((int)stp, 31); st1 = __builtin_amdgcn_readlane((int)stp, 63); }
#pragma nounroll
    for (int it = 0; it < 80; ++it) {
        const unsigned candv = lane < 32 ? p0 : p1;
        unsigned cl = 0u;
#pragma unroll
        for (int m = 0; m < NR; m += 4) { u64 s0, s1, s2, s3;
            asm("v_cmp_ge_u32_e64 %1, %5, %9\n\tv_cmp_ge_u32_e64 %2, %6, %9\n\tv_cmp_ge_u32_e64 %3, %7, %9\n\tv_cmp_ge_u32_e64 %4, %8, %9\n\t"
                "v_addc_co_u32_e64 %0, %1, 0, %0, %1\n\tv_addc_co_u32_e64 %0, %2, 0, %0, %2\n\tv_addc_co_u32_e64 %0, %3, 0, %0, %3\n\tv_addc_co_u32_e64 %0, %4, 0, %0, %4"
                : "+v"(cl), "=&s"(s0), "=&s"(s1), "=&s"(s2), "=&s"(s3) : "v"(key[m]), "v"(key[m + 1]), "v"(key[m + 2]), "v"(key[m + 3]), "v"(candv)); }
        cl = dpp_half_sums_u32(cl);
        const int n0 = __builtin_amdgcn_readlane((int)cl, 31), n1 = __builtin_amdgcn_readlane((int)cl, 63);
#define IDX_STEP(lo, hi, st, p, T, ex, fin, n) do { if (!fin) { \
            if (n == 256) { T = p; ex = true; fin = true; } \
            else { if (n > 256) lo = p; else hi = p; \
                if (hi - lo <= 1u) { T = lo; fin = true; } \
                else { unsigned c; if (hi == 0xFFFFFFFFu) { c = lo + st; if (c < lo) c = hi; st = st << 1; } else if (lo == 0u) { c = hi - st; if (c > hi) c = lo; st = st << 1; } else c = lo + ((hi - lo) >> 1); \
                    if (c <= lo || c >= hi) c = lo + ((hi - lo) >> 1); p = c; } } } } while (0)
        IDX_STEP(lo0, hi0, st0, p0, T0, ex0, fin0, n0);
        IDX_STEP(lo1, hi1, st1, p1, T1, ex1, fin1, n1);
#undef IDX_STEP
        if (fin0 && fin1) break;
    }
    const unsigned Tv = lane < 32 ? T0 : T1;
    if (ex0 && ex1) {
        unsigned mlo = 0u, mhi = 0u;
#pragma unroll
        for (int j = 0; j < NR / 2; ++j) {
            const u64 b0 = __ballot(key[2 * j] >= Tv), b1 = __ballot(key[2 * j + 1] >= Tv);
            asm volatile("s_nop 1\n\tv_writelane_b32 %0, %2, %6\n\tv_writelane_b32 %0, %3, %7\n\tv_writelane_b32 %1, %4, %6\n\tv_writelane_b32 %1, %5, %7"
                         : "+v"(mlo), "+v"(mhi) : "s"((unsigned)b0), "s"((unsigned)(b0 >> 32)), "s"((unsigned)b1), "s"((unsigned)(b1 >> 32)), "n"(j), "n"(32 + j));
            if ((j & 3) == 3) SBAR();
        }
        const int jl = lane & 31;
        if (jl < nkb) mrow[(lane >> 5) * 32 + jl] = (u64)mlo | ((u64)mhi << 32);
        return;
    }
    int rem0 = 1 << 30, rem1 = 1 << 30;
    { int g0 = 0, g1 = 0;
#pragma unroll
        for (int m = 0; m < NR; ++m) { const u64 mk = __ballot(key[m] > Tv); g0 += __builtin_popcount((unsigned)mk); g1 += __builtin_popcount((unsigned)(mk >> 32)); if ((m & 7) == 7) SBAR(); }
        if (!ex0) rem0 = 256 - g0; if (!ex1) rem1 = 256 - g1; }
    u64 mine = 0ull;
#pragma nounroll
    for (int jq = 0; jq < NR / 8; ++jq) {
#pragma unroll
        for (int jj = 0; jj < 4; ++jj) { const int j = jq * 4 + jj;
            unsigned w0[2], w1[2];
#pragma unroll
            for (int hh = 0; hh < 2; ++hh) { unsigned kv = 0u;
#pragma unroll
                for (int m = 0; m < NR; ++m) if ((m >> 3) == 0) {}
#pragma unroll
                for (int m = 0; m < NR; ++m) kv = (m == 2 * j + hh) ? key[m] : kv;
                const u64 gt = __ballot(kv > Tv), eq = __ballot(kv == Tv);
                { const unsigned e = (unsigned)eq, g = (unsigned)gt; const int ne = __builtin_popcount(e); unsigned sel = g; if (rem0 >= ne) { sel |= e; rem0 -= ne; } else if (rem0 > 0) { sel |= low_bits_keep32(e, rem0); rem0 = 0; } w0[hh] = sel; }
                { const unsigned e = (unsigned)(eq >> 32), g = (unsigned)(gt >> 32); const int ne = __builtin_popcount(e); unsigned sel = g; if (rem1 >= ne) { sel |= e; rem1 -= ne; } else if (rem1 > 0) { sel |= low_bits_keep32(e, rem1); rem1 = 0; } w1[hh] = sel; } }
            const u64 q0w = (u64)w0[0] | ((u64)w0[1] << 32), q1w = (u64)w1[0] | ((u64)w1[1] << 32);
            if (lane == j) mine = q0w; if (lane == 32 + j) mine = q1w; }
    }
    const int jl = lane & 31;
    if (jl < nkb) mrow[(lane >> 5) * 32 + jl] = mine;
}
template <int J0> __device__ __forceinline__ void index_scores8(unsigned (&key)[64], const bf16x8 (&af)[2], const f32x4& iw4, const bf16_t* kvsrc, char* lds, int nkb, u32x4 (&stg)[8], int tid) {
    const int lane = tid & 63, sub = lane & 15, kg = lane >> 4;
#pragma unroll
    for (int jj = 0; jj < 8; ++jj) {
        const int j = J0 + jj;
        if (j < nkb) {
            if (j + 1 < nkb) *(u32x4*)(lds + ((j + 1) & 1) * idx::KBUF + (tid >> 3) * idx::KST + (tid & 7) * 16) = stg[(jj + 1) & 7];
            if (j + 8 < nkb) stg[jj] = *(const u32x4*)(kvsrc + (size_t)(j + 8) * 64 * 64);
            const char* kb = lds + (j & 1) * idx::KBUF + sub * idx::KST + kg * 16;
#pragma unroll
            for (int pr = 0; pr < 2; ++pr) {
                f32x4 dA = (f32x4){0.f, 0.f, 0.f, 0.f}, dB = dA;
#pragma unroll
                for (int ks = 0; ks < 2; ++ks) {
                    const bf16x8 fA = *(const bf16x8*)(kb + (pr * 32) * idx::KST + ks * 64), fB = *(const bf16x8*)(kb + (pr * 32 + 16) * idx::KST + ks * 64);
                    dA = __builtin_amdgcn_mfma_f32_16x16x32_bf16(af[ks], fA, dA, 0, 0, 0); dB = __builtin_amdgcn_mfma_f32_16x16x32_bf16(af[ks], fB, dB, 0, 0, 0); }
                float pA = 0.f, pB = 0.f;
#pragma unroll
                for (int r = 0; r < 4; ++r) { pA += fmaxf(dA[r], 0.f) * iw4[r]; pB += fmaxf(dB[r], 0.f) * iw4[r]; }
                auto rr = __builtin_amdgcn_permlane16_swap(__float_as_uint(pA), __float_as_uint(pB), false, false);
                key[2 * j + pr] = sortable_key(__uint_as_float(rr[0]) + __uint_as_float(rr[1]));
            }
            __syncthreads();
        }
    }
}
__device__ __forceinline__ void ph_index(Frame& F) {
    const bf16_t* IQ = (const bf16_t*)(F.outb + OUT_IQ); const bf16_t* IK = (const bf16_t*)(F.outb + OUT_IK); const float* IW = (const float*)(F.outb + OUT_IW);
    u64* MASK = (u64*)(F.outb + OUT_MASK);
    char* lds = (char*)(unsigned char*)F.lds;
    const int tid = F.tid, lane = F.lane, sub = lane & 15, kg = lane >> 4;
    for (int item = F.bid; item < NTOK / 16; item += F.G) {
        const int tokw = (((item & 255) >> 3) << 11) + (((item & 7) + 8 * (item >> 8)) << 4) + F.wave * 2, b = tokw >> 11, pos0 = tokw & 2047, nkb = (pos0 >> 6) + 1;
        u64* mrow = MASK + (size_t)tokw * 32;
        if (nkb <= 4) { if ((lane & 31) < nkb) mrow[(lane >> 5) * 32 + (lane & 31)] = ~0ull; continue; }
        bf16x8 af[2];
        { const bf16_t* ap = IQ + (size_t)(tokw + (sub >> 3)) * 512 + (sub & 7) * 64 + kg * 8;
#pragma unroll
          for (int ks = 0; ks < 2; ++ks) af[ks] = *(const bf16x8*)(ap + ks * 32); }
        const f32x4 iw4 = *(const f32x4*)(IW + (size_t)(tokw + (lane >> 5)) * 8 + 4 * (kg & 1));
        unsigned key[64];
#pragma unroll
        for (int m = 0; m < 64; ++m) key[m] = 0u;
        const bf16_t* kvsrc = IK + ((size_t)b * SEQ + (tid >> 3)) * 64 + (tid & 7) * 8;
        u32x4 stg[8];
#pragma unroll
        for (int i = 0; i < 8; ++i) stg[i] = (i < nkb) ? *(const u32x4*)(kvsrc + (size_t)i * 64 * 64) : (u32x4){0u, 0u, 0u, 0u};
        __syncthreads();
        *(u32x4*)(lds + (tid >> 3) * idx::KST + (tid & 7) * 16) = stg[0];
        __syncthreads();
        const int ng = (nkb + 7) >> 3;
        index_scores8<0>(key, af, iw4, kvsrc, lds, nkb, stg, tid);
        if (ng > 1) index_scores8<8>(key, af, iw4, kvsrc, lds, nkb, stg, tid);
        if (ng > 2) index_scores8<16>(key, af, iw4, kvsrc, lds, nkb, stg, tid);
        if (ng > 3) index_scores8<24>(key, af, iw4, kvsrc, lds, nkb, stg, tid);
        if (ng == 1) topk2_select_write<1>(key, nkb, mrow, lane);
        else if (ng == 2) topk2_select_write<2>(key, nkb, mrow, lane);
        else if (ng == 3) topk2_select_write<3>(key, nkb, mrow, lane);
        else topk2_select_write<4>(key, nkb, mrow, lane);
    }
}

namespace att {
constexpr int KVBLK = 64;
constexpr int SHM_V = KVBLK * 128 * 2, SHM_K = SHM_V;
constexpr int OFF_V = 0, OFF_K = 2 * SHM_V, OFF_WS = 2 * SHM_V + 2 * SHM_K, OFF_BT = OFF_WS + NWAVES * 64 * 4;
constexpr int OFF_OT = 81920, OT_ST = 144;
#define KSWZ(row, colB) ((row) * 256 + ((colB) ^ (((row) & 7) << 4)))
__device__ __forceinline__ int crow(int r, int hi) { return (r & 3) + 8 * (r >> 2) + 4 * hi; }
__device__ __forceinline__ int v_st(int k, int c) { const int kk = (k & ~0xC) | ((k & 4) << 1) | ((k & 8) >> 1); return ((kk >> 3) * 4 + (c >> 5)) * 512 + ((kk & 7) * 32 + (c & 31)) * 2; }
__device__ __forceinline__ int v_rd_base(int lane) { return ((lane & 3) << 3) | (((lane >> 2) & 3) << 6) | (((lane >> 4) & 1) << 5) | (((lane >> 5) & 1) << 8); }
constexpr int v_rd_off(int d0, int ks, int half) { return d0 * 512 + ks * 4096 + half * 2048; }
template <int OFF> __device__ __forceinline__ s16x4 tr_read(int vb) { s16x4 r; asm volatile("ds_read_b64_tr_b16 %0, %1 offset:%2" : "=&v"(r) : "v"(vb), "i"(OFF) : "memory"); return r; }
template <int D0> __device__ __forceinline__ void pv_one(f32x16& od, int vb, bf16x8 pa0, bf16x8 pa1, bf16x8 pa2, bf16x8 pa3) {
    const s16x4 l0 = tr_read<v_rd_off(D0, 0, 0)>(vb), h0 = tr_read<v_rd_off(D0, 0, 1)>(vb), l1 = tr_read<v_rd_off(D0, 1, 0)>(vb), h1 = tr_read<v_rd_off(D0, 1, 1)>(vb);
    const s16x4 l2 = tr_read<v_rd_off(D0, 2, 0)>(vb), h2 = tr_read<v_rd_off(D0, 2, 1)>(vb), l3 = tr_read<v_rd_off(D0, 3, 0)>(vb), h3 = tr_read<v_rd_off(D0, 3, 1)>(vb);
    asm volatile("s_waitcnt lgkmcnt(0)" ::: "memory"); SBAR();
#define PK(L, H) (bf16x8){L[0], L[1], L[2], L[3], H[0], H[1], H[2], H[3]}
    od = __builtin_amdgcn_mfma_f32_32x32x16_bf16(pa0, PK(l0, h0), od, 0, 0, 0);
    od = __builtin_amdgcn_mfma_f32_32x32x16_bf16(pa1, PK(l1, h1), od, 0, 0, 0);
    od = __builtin_amdgcn_mfma_f32_32x32x16_bf16(pa2, PK(l2, h2), od, 0, 0, 0);
    od = __builtin_amdgcn_mfma_f32_32x32x16_bf16(pa3, PK(l3, h3), od, 0, 0, 0);
#undef PK
}
__device__ __forceinline__ void qkt(f32x16& p0, f32x16& p1, const char* Ks, const bf16x8* qr, int r32, int hi) {
    p0 = f32x16{}; p1 = f32x16{};
    int rv = r32; asm volatile("" : "+v"(rv));
    const char* kb = Ks + rv * 256; const int swz = ((rv & 7) << 4) ^ (hi * 16);
#pragma unroll
    for (int d0 = 0; d0 < 8; ++d0) { const char* ka = kb + ((d0 * 32) ^ swz);
        const bf16x8 b0 = *reinterpret_cast<const bf16x8*>(ka);
        const bf16x8 b1 = *reinterpret_cast<const bf16x8*>(ka + 8192);
        p0 = __builtin_amdgcn_mfma_f32_32x32x16_bf16(b0, qr[d0], p0, 0, 0, 0);
        p1 = __builtin_amdgcn_mfma_f32_32x32x16_bf16(b1, qr[d0], p1, 0, 0, 0); }
}
__device__ __forceinline__ void attn_item(Frame& F, int b, int q0, char* lds) {
    const bf16_t* Q = (const bf16_t*)(F.ws + WS_Q); const bf16_t* KV = (const bf16_t*)(F.outb + OUT_KV); const u64* MASK = (const u64*)(F.outb + OUT_MASK);
    bf16_t* OA = (bf16_t*)(F.outb + OUT_OA);
    int tid = F.tid; asm volatile("" : "+v"(tid));
    const int wid = F.wave, lane = tid & 63, r32 = lane & 31, hi = lane >> 5;
    char* V_lds = lds + OFF_V; char* K_lds = lds + OFF_K;
    float* wsl = (float*)(lds + OFF_WS) + wid * 64; float* li_l = wsl; float* al_l = wsl + 32;
    const float* btab = (const float*)(lds + OFF_BT);
    constexpr float C = 0.088388347648318440f * LOG2E;
    float m_reg = -1e30f, l_reg = 0.f; f32x16 o[4] = {}; bf16x8 qr[8];
    const size_t tokq = (size_t)b * SEQ + q0 + r32;
    { const bf16_t* Qw = Q + tokq * 1024 + wid * 128 + hi * 8;
#pragma unroll
      for (int d0 = 0; d0 < 8; ++d0) qr[d0] = *(const bf16x8*)(Qw + d0 * 16); }
    const u64* mq = MASK + tokq * 32;
    const int sr = tid >> 4, sc = (tid & 15) * 8;
    const int vb0 = (int)(uintptr_t)V_lds + v_rd_base(lane);
    const bf16_t* Kb = KV + (size_t)b * SEQ * 128;
    const int NT = (q0 >> 6) + 1;
    const float bfar = btab[wid];
    bf16x8 s0, s1;
#define SLOAD(k0) do { s0 = *(const bf16x8*)(Kb + (size_t)((k0) + sr) * 128 + sc); s1 = *(const bf16x8*)(Kb + (size_t)((k0) + 32 + sr) * 128 + sc); } while (0)
#define SWRITE(bf) do { int srv = sr; asm volatile("" : "+v"(srv)); const int kc = sc * 2; const int v0a = v_st(srv, sc), k0a = KSWZ(srv, kc); \
        *(bf16x8*)(V_lds + (bf) * SHM_V + v0a) = s0; *(bf16x8*)(V_lds + (bf) * SHM_V + v0a + 8192) = s1; \
        *(bf16x8*)(K_lds + (bf) * SHM_K + k0a) = s0; *(bf16x8*)(K_lds + (bf) * SHM_K + k0a + 8192) = s1; } while (0)
    __syncthreads();
    SLOAD(0); VM_WAIT(); SWRITE(0); __syncthreads();
    u64 mw_next = mq[0];
    for (int j = 0; j < NT; ++j) {
        int lanel = lane; asm volatile("" : "+v"(lanel)); const int r32l = lanel & 31, hil = lanel >> 5;
        const int bf = j & 1;
        if (j + 1 < NT) SLOAD((j + 1) * KVBLK);
        const u64 mw = mw_next; if (j + 1 < NT) mw_next = mq[j + 1];
        f32x16 p0, p1;
        qkt(p0, p1, K_lds + bf * SHM_K, qr, r32l, hil);
        const unsigned w0 = (unsigned)(mw >> (4 * hil)), w1 = (unsigned)(mw >> (32 + 4 * hil));
        const int relmax = j * KVBLK + 63 - q0;
        float alpha = 1.f, ps = 0.f;
        if (relmax <= -91) {
            float pmax = p0[0];
#pragma unroll
            for (int r = 1; r < 16; ++r) pmax = fmaxf(pmax, p0[r]);
#pragma unroll
            for (int r = 0; r < 16; ++r) pmax = fmaxf(pmax, p1[r]);
            { auto rr = __builtin_amdgcn_permlane32_swap(__float_as_uint(pmax), __float_as_uint(pmax), false, false); pmax = fmaxf(__uint_as_float(rr[0]), __uint_as_float(rr[1])); }
            pmax = fmaf(pmax, C, bfar);
            if (!__all(pmax - m_reg <= 11.0f)) { const float mn = fmaxf(m_reg, pmax); alpha = __builtin_amdgcn_exp2f(m_reg - mn); m_reg = mn; }
            const float off = bfar - m_reg;
#pragma unroll
            for (int r = 0; r < 16; ++r) { const int cb = (r & 3) + 8 * (r >> 2);
                const float e0 = __builtin_amdgcn_exp2f(fmaf(p0[r], C, off)), e1 = __builtin_amdgcn_exp2f(fmaf(p1[r], C, off));
                p0[r] = __uint_as_float(__float_as_uint(e0) & (unsigned)__builtin_amdgcn_sbfe((int)w0, cb, 1)); p1[r] = __uint_as_float(__float_as_uint(e1) & (unsigned)__builtin_amdgcn_sbfe((int)w1, cb, 1)); ps += p0[r] + p1[r]; }
        } else {
            const float* bp = btab + (j * KVBLK + 4 * hil - (q0 + r32l) + 185) * 8 + wid;
#pragma unroll
            for (int r4 = 0; r4 < 4; ++r4) {
#pragma unroll
                for (int rr = 0; rr < 4; ++rr) { const int r = r4 * 4 + rr; const int cb = (r & 3) + 8 * (r >> 2); p0[r] = fmaf(p0[r], C, bp[cb * 8]); p1[r] = fmaf(p1[r], C, bp[(cb + 32) * 8]); }
                SBAR(); }
            float pmax = p0[0];
#pragma unroll
            for (int r = 1; r < 16; ++r) pmax = fmaxf(pmax, p0[r]);
#pragma unroll
            for (int r = 0; r < 16; ++r) pmax = fmaxf(pmax, p1[r]);
            { auto rr = __builtin_amdgcn_permlane32_swap(__float_as_uint(pmax), __float_as_uint(pmax), false, false); pmax = fmaxf(__uint_as_float(rr[0]), __uint_as_float(rr[1])); }
            if (!__all(pmax - m_reg <= 11.0f)) { const float mn = fmaxf(m_reg, pmax); alpha = __builtin_amdgcn_exp2f(m_reg - mn); m_reg = mn; }
#pragma unroll
            for (int r = 0; r < 16; ++r) { const int cb = (r & 3) + 8 * (r >> 2);
                const float e0 = __builtin_amdgcn_exp2f(p0[r] - m_reg), e1 = __builtin_amdgcn_exp2f(p1[r] - m_reg);
                p0[r] = __uint_as_float(__float_as_uint(e0) & (unsigned)__builtin_amdgcn_sbfe((int)w0, cb, 1)); p1[r] = __uint_as_float(__float_as_uint(e1) & (unsigned)__builtin_amdgcn_sbfe((int)w1, cb, 1)); ps += p0[r] + p1[r]; }
        }
        { auto rr = __builtin_amdgcn_permlane32_swap(__float_as_uint(ps), __float_as_uint(ps), false, false); ps = __uint_as_float(rr[0]) + __uint_as_float(rr[1]); }
        l_reg = l_reg * alpha + ps;
        bf16x8 pa0, pa1, pa2, pa3;
#define PK4(P, BASE, OUT) do { unsigned a0 = cvt_pk_bf16(P[BASE + 0], P[BASE + 1]), a1 = cvt_pk_bf16(P[BASE + 2], P[BASE + 3]);   \
    unsigned b0 = cvt_pk_bf16(P[BASE + 4], P[BASE + 5]), b1 = cvt_pk_bf16(P[BASE + 6], P[BASE + 7]);                              \
    auto r0 = __builtin_amdgcn_permlane32_swap(a0, b0, false, false); auto r1 = __builtin_amdgcn_permlane32_swap(a1, b1, false, false); \
    u32x4 w = {r0[0], r1[0], r0[1], r1[1]}; OUT = *reinterpret_cast<bf16x8*>(&w); } while (0)
        PK4(p0, 0, pa0); PK4(p0, 8, pa1); PK4(p1, 0, pa2); PK4(p1, 8, pa3);
#undef PK4
        if (__any(alpha < 1.f)) { if (hil == 0) al_l[r32l] = alpha; LDS_WAIT();
#pragma unroll
            for (int d = 0; d < 4; ++d)
#pragma unroll
                for (int r = 0; r < 16; ++r) o[d][r] *= al_l[crow(r, hil)]; }
        const int vb = (int)(uintptr_t)V_lds + v_rd_base(lanel) + bf * SHM_V;
        pv_one<0>(o[0], vb, pa0, pa1, pa2, pa3); pv_one<1>(o[1], vb, pa0, pa1, pa2, pa3); pv_one<2>(o[2], vb, pa0, pa1, pa2, pa3); pv_one<3>(o[3], vb, pa0, pa1, pa2, pa3);
        if (j + 1 < NT) { VM_WAIT(); SWRITE(bf ^ 1); }
        __syncthreads();
    }
#undef SLOAD
#undef SWRITE
    if (hi == 0) li_l[r32] = l_reg; LDS_WAIT();
    bf16_t* Ow = OA + ((size_t)b * SEQ + q0 + 4 * hi) * 1024 + wid * 128 + r32;
    const float* lip = li_l + 4 * hi;
    unsigned char* Ow8 = (unsigned char*)OA + ((size_t)b * SEQ + q0 + 4 * hi) * 1024 + wid * 128 + r32;
    asm volatile("" : "+v"(Ow), "+v"(lip), "+v"(Ow8));
#pragma unroll
    for (int r = 0; r < 16; ++r) { const int ro = (r & 3) + 8 * (r >> 2); if ((r & 3) == 0) asm volatile("" : "+v"(Ow), "+v"(Ow8), "+v"(lip)); const float rl = fast_rcp(lip[ro]);
#pragma unroll
        for (int d0 = 0; d0 < 4; ++d0) { float v = o[d0][r] * rl; if ((DBG_ATTN_ZERO == 1 && q0 < 256) || (DBG_ATTN_ZERO == 2 && q0 >= 256)) v = 0.f;
            if (PA_FP8) ((unsigned char*)Ow8)[ro * 1024 + d0 * 32] = (unsigned char)(__builtin_amdgcn_cvt_pk_fp8_f32(v, v, 0, false) & 0xff);
            else Ow[ro * 1024 + d0 * 32] = (bf16_t)(cvt_pk_bf16(v, v) & 0xffffu); }
        if ((r & 3) == 3) SBAR(); }
}
__device__ __forceinline__ void att2_partial(f32x16& p0, f32x16& p1, float& m_reg, float& alpha, unsigned w0, bool far, float bfar, const float* bp) {
    constexpr float C = 0.088388347648318440f * LOG2E;
    float off;
    if (far) {
        float pmax = p0[0];
#pragma unroll
        for (int r = 1; r < 16; ++r) pmax = fmaxf(pmax, p0[r]);
#pragma unroll
        for (int r = 0; r < 16; ++r) pmax = fmaxf(pmax, p1[r]);
        { auto rr = __builtin_amdgcn_permlane32_swap(__float_as_uint(pmax), __float_as_uint(pmax), false, false); pmax = fmaxf(__uint_as_float(rr[0]), __uint_as_float(rr[1])); }
        pmax = fmaf(pmax, C, bfar);
        if (__builtin_expect(__all(pmax - m_reg <= 11.0f), 1)) alpha = 1.f; else { const float mn = fmaxf(m_reg, pmax); alpha = __builtin_amdgcn_exp2f(m_reg - mn); m_reg = mn; }
        off = bfar - m_reg;
#pragma unroll
        for (int r = 0; r < 16; ++r) { p0[r] = fmaf(p0[r], C, off); p1[r] = fmaf(p1[r], C, off); }
    } else {
#pragma unroll
        for (int r4 = 0; r4 < 4; ++r4) {
#pragma unroll
            for (int rr = 0; rr < 4; ++rr) { const int r = r4 * 4 + rr; const int cb = (r & 3) + 8 * (r >> 2); p0[r] = fmaf(p0[r], C, bp[cb * 8]); p1[r] = fmaf(p1[r], C, bp[(cb + 32) * 8]); }
            SBAR(); }
        float pmax = p0[0];
#pragma unroll
        for (int r = 1; r < 16; ++r) pmax = fmaxf(pmax, p0[r]);
#pragma unroll
        for (int r = 0; r < 16; ++r) pmax = fmaxf(pmax, p1[r]);
        { auto rr = __builtin_amdgcn_permlane32_swap(__float_as_uint(pmax), __float_as_uint(pmax), false, false); pmax = fmaxf(__uint_as_float(rr[0]), __uint_as_float(rr[1])); }
        if (__builtin_expect(__all(pmax - m_reg <= 11.0f), 1)) alpha = 1.f; else { const float mn = fmaxf(m_reg, pmax); alpha = __builtin_amdgcn_exp2f(m_reg - mn); m_reg = mn; }
#pragma unroll
        for (int r = 0; r < 16; ++r) { p0[r] -= m_reg; p1[r] -= m_reg; }
    }
#pragma unroll
    for (int r = 0; r < 16; ++r) { const int cb = (r & 3) + 8 * (r >> 2); p0[r] = __uint_as_float(__float_as_uint(__builtin_amdgcn_exp2f(p0[r])) & (unsigned)__builtin_amdgcn_sbfe((int)w0, cb, 1)); }
}
__device__ __forceinline__ void att2_finish(f32x16& p0, f32x16& p1, float alpha, float& l_reg, unsigned w1, bf16x8& pa0, bf16x8& pa1, bf16x8& pa2, bf16x8& pa3) {
#pragma unroll
    for (int r = 0; r < 16; ++r) { const int cb = (r & 3) + 8 * (r >> 2); p1[r] = __uint_as_float(__float_as_uint(__builtin_amdgcn_exp2f(p1[r])) & (unsigned)__builtin_amdgcn_sbfe((int)w1, cb, 1)); }
    float ps = 0.f;
#pragma unroll
    for (int r = 0; r < 16; ++r) ps += p0[r];
#pragma unroll
    for (int r = 0; r < 16; ++r) ps += p1[r];
    { auto rr = __builtin_amdgcn_permlane32_swap(__float_as_uint(ps), __float_as_uint(ps), false, false); ps = __uint_as_float(rr[0]) + __uint_as_float(rr[1]); }
    l_reg = l_reg * alpha + ps;
#define PK4(P, BASE, OUT) do { unsigned a0 = cvt_pk_bf16(P[BASE + 0], P[BASE + 1]), a1 = cvt_pk_bf16(P[BASE + 2], P[BASE + 3]);   \
    unsigned b0 = cvt_pk_bf16(P[BASE + 4], P[BASE + 5]), b1 = cvt_pk_bf16(P[BASE + 6], P[BASE + 7]);                              \
    auto r0 = __builtin_amdgcn_permlane32_swap(a0, b0, false, false); auto r1 = __builtin_amdgcn_permlane32_swap(a1, b1, false, false); \
    u32x4 w = {r0[0], r1[0], r0[1], r1[1]}; OUT = *reinterpret_cast<bf16x8*>(&w); } while (0)
    PK4(p0, 0, pa0); PK4(p0, 8, pa1); PK4(p1, 0, pa2); PK4(p1, 8, pa3);
#undef PK4
}
__device__ __forceinline__ void attn_item2(Frame& F, int b, int q0, char* lds) {
    const bf16_t* Q = (const bf16_t*)(F.ws + WS_Q); const bf16_t* KV = (const bf16_t*)(F.outb + OUT_KV); const u64* MASK = (const u64*)(F.outb + OUT_MASK);
    bf16_t* OA = (bf16_t*)(F.outb + OUT_OA);
    int tid = F.tid; asm volatile("" : "+v"(tid));
    const int wid = F.wave, lane = tid & 63, r32 = lane & 31, hi = lane >> 5;
    char* V_lds = lds + OFF_V; char* K_lds = lds + OFF_K;
    float* wsl = (float*)(lds + OFF_WS) + wid * 64; float* li_l = wsl; float* al_l = wsl + 32;
    const float* btab = (const float*)(lds + OFF_BT);
    float m_reg = -1e30f, l_reg = 0.f; f32x16 o[4] = {}; bf16x8 qr[8];
    const size_t tokq = (size_t)b * SEQ + q0 + r32;
    { const bf16_t* Qw = Q + tokq * 1024 + wid * 128 + hi * 8;
#pragma unroll
      for (int d0 = 0; d0 < 8; ++d0) qr[d0] = *(const bf16x8*)(Qw + d0 * 16); }
    const u64* mq = MASK + tokq * 32;
    const int sr = tid >> 4, sc = (tid & 15) * 8;
    const bf16_t* Kb = KV + (size_t)b * SEQ * 128;
    const int NTr = (q0 >> 6) + 1, NT = (NTr + 1) & ~1;
    const float bfar = btab[wid];
    bf16x8 sA0, sA1, sB0, sB1;
#define SLD(s0_, s1_, k0) do { int srl = sr; asm volatile("" : "+v"(srl)); const bf16_t* kp_ = Kb + (size_t)((k0) + srl) * 128 + sc; s0_ = *(const bf16x8*)kp_; s1_ = *(const bf16x8*)(kp_ + 32 * 128); } while (0)
#define SWR(bf, s0_, s1_) do { int srv = sr; asm volatile("" : "+v"(srv)); const int kc = sc * 2; const int v0a = v_st(srv, sc), k0a = KSWZ(srv, kc); \
        *(bf16x8*)(V_lds + (bf) * SHM_V + v0a) = s0_; *(bf16x8*)(V_lds + (bf) * SHM_V + v0a + 8192) = s1_; \
        *(bf16x8*)(K_lds + (bf) * SHM_K + k0a) = s0_; *(bf16x8*)(K_lds + (bf) * SHM_K + k0a + 8192) = s1_; } while (0)
#define MWORD(j) ((j) < NTr ? mq[j] : 0ull)
#define RESC(a) do { if (__any((a) < 1.f)) { if (hi == 0) al_l[r32] = (a); LDS_WAIT(); \
        _Pragma("unroll") for (int d = 0; d < 4; ++d) _Pragma("unroll") for (int r = 0; r < 16; ++r) o[d][r] *= al_l[crow(r, hi)]; } } while (0)
#define PVALL(bf) do { int ll = lane; asm volatile("" : "+v"(ll)); const int vb = (int)(uintptr_t)V_lds + v_rd_base(ll) + (bf) * SHM_V; \
        pv_one<0>(o[0], vb, pa0, pa1, pa2, pa3); pv_one<1>(o[1], vb, pa0, pa1, pa2, pa3); pv_one<2>(o[2], vb, pa0, pa1, pa2, pa3); pv_one<3>(o[3], vb, pa0, pa1, pa2, pa3); } while (0)
#define ISFAR(jt) ((jt) * KVBLK + 63 - q0 <= -91 || (jt) >= NTr)
#define BPTR(jt) (btab + ((jt) * KVBLK + 4 * hi - (q0 + r32) + 185) * 8 + wid)
    f32x16 pA0, pA1, pB0, pB1; float alA, alB; bf16x8 pa0, pa1, pa2, pa3; u64 mwA, mwB;
    __syncthreads();
    SLD(sA0, sA1, 0); mwA = MWORD(0); VM_WAIT(); SWR(0, sA0, sA1); __syncthreads();
    qkt(pA0, pA1, K_lds, qr, r32, hi);
    att2_partial(pA0, pA1, m_reg, alA, (unsigned)(mwA >> (4 * hi)), ISFAR(0), bfar, BPTR(0));
    SLD(sB0, sB1, KVBLK); mwB = MWORD(1); if (2 < NT) SLD(sA0, sA1, 2 * KVBLK);
    SWR(1, sB0, sB1); __syncthreads();
    for (int j = 1; j + 1 < NT; j += 2) {
        SBAR(); qkt(pB0, pB1, K_lds + SHM_K, qr, r32, hi);
        att2_finish(pA0, pA1, alA, l_reg, (unsigned)(mwA >> (32 + 4 * hi)), pa0, pa1, pa2, pa3); SBAR();
        SLD(sB0, sB1, (j + 2) * KVBLK); mwA = MWORD(j + 1); SBAR();
        PVALL(0);
        att2_partial(pB0, pB1, m_reg, alB, (unsigned)(mwB >> (4 * hi)), ISFAR(j), bfar, BPTR(j));
        __syncthreads(); SWR(0, sA0, sA1);
        RESC(alB); __syncthreads();
        SBAR(); qkt(pA0, pA1, K_lds, qr, r32, hi);
        att2_finish(pB0, pB1, alB, l_reg, (unsigned)(mwB >> (32 + 4 * hi)), pa0, pa1, pa2, pa3); SBAR();
        if (j + 3 < NT) SLD(sA0, sA1, (j + 3) * KVBLK); mwB = MWORD(j + 2); SBAR();
        PVALL(1);
        att2_partial(pA0, pA1, m_reg, alA, (unsigned)(mwA >> (4 * hi)), ISFAR(j + 1), bfar, BPTR(j + 1));
        __syncthreads(); SWR(1, sB0, sB1);
        RESC(alA); __syncthreads();
    }
    SBAR(); qkt(pB0, pB1, K_lds + SHM_K, qr, r32, hi);
    att2_finish(pA0, pA1, alA, l_reg, (unsigned)(mwA >> (32 + 4 * hi)), pa0, pa1, pa2, pa3); SBAR();
    PVALL(0);
    att2_partial(pB0, pB1, m_reg, alB, (unsigned)(mwB >> (4 * hi)), ISFAR(NT - 1), bfar, BPTR(NT - 1));
    __syncthreads(); RESC(alB);
    att2_finish(pB0, pB1, alB, l_reg, (unsigned)(mwB >> (32 + 4 * hi)), pa0, pa1, pa2, pa3); SBAR();
    PVALL(1);
#undef SLD
#undef SWR
#undef MWORD
#undef RESC
#undef PVALL
#undef ISFAR
#undef BPTR
    LAS float* li_s = (LAS float*)(F.lds + OFF_WS) + wid * 64;
    if (hi == 0) li_s[r32] = l_reg; LDS_WAIT();
    if (PA_FP8 && ATT_OT) {
        LAS unsigned char* ot = F.lds + OFF_OT + wid * (32 * OT_ST);
        int ob = (4 * hi) * OT_ST + r32, lo = 4 * hi; asm volatile("" : "+v"(ob), "+v"(lo));
#pragma unroll
        for (int r = 0; r < 16; ++r) { const int ro = (r & 3) + 8 * (r >> 2); if ((r & 3) == 0) asm volatile("" : "+v"(ob), "+v"(lo)); const float rl = fast_rcp(li_s[lo + ro]);
#pragma unroll
            for (int d0 = 0; d0 < 4; ++d0) { const float v = o[d0][r] * rl; ot[ob + ro * OT_ST + d0 * 32] = (unsigned char)(__builtin_amdgcn_cvt_pk_fp8_f32(v, v, 0, false) & 0xff); }
            if ((r & 3) == 3) SBAR(); }
        LDS_WAIT(); asm volatile("" ::: "memory");
        unsigned char* Og = (unsigned char*)OA + ((size_t)b * SEQ + q0) * 1024 + wid * 128;
        int rr = lane >> 3, sg = (lane & 7) * 16; asm volatile("" : "+v"(rr), "+v"(sg));
#pragma unroll
        for (int i = 0; i < 4; ++i) { const u32x4 w = *(const LAS u32x4*)(ot + (i * 8 + rr) * OT_ST + sg); *(u32x4*)(Og + (size_t)(i * 8 + rr) * 1024 + sg) = w; }
        LDS_WAIT();
    } else if (PA_FP8) {
        GAS unsigned char* Ow8 = (GAS unsigned char*)((unsigned char*)OA + ((size_t)b * SEQ + q0 + 4 * hi) * 1024 + wid * 128 + r32);
        int lo = 4 * hi; asm volatile("" : "+v"(Ow8), "+v"(lo));
#pragma unroll
        for (int r = 0; r < 16; ++r) { const int ro = (r & 3) + 8 * (r >> 2); if ((r & 3) == 0) asm volatile("" : "+v"(Ow8), "+v"(lo)); const float rl = fast_rcp(li_s[lo + ro]);
#pragma unroll
            for (int d0 = 0; d0 < 4; ++d0) { const float v = o[d0][r] * rl; Ow8[ro * 1024 + d0 * 32] = (unsigned char)(__builtin_amdgcn_cvt_pk_fp8_f32(v, v, 0, false) & 0xff); }
            if ((r & 3) == 3) SBAR(); }
    } else {
        bf16_t* Ow = OA + ((size_t)b * SEQ + q0 + 4 * hi) * 1024 + wid * 128 + r32;
        int lo = 4 * hi; asm volatile("" : "+v"(Ow), "+v"(lo));
#pragma unroll
        for (int r = 0; r < 16; ++r) { const int ro = (r & 3) + 8 * (r >> 2); if ((r & 3) == 0) asm volatile("" : "+v"(Ow), "+v"(lo)); const float rl = fast_rcp(li_s[lo + ro]);
#pragma unroll
            for (int d0 = 0; d0 < 4; ++d0) { const float v = o[d0][r] * rl; Ow[ro * 1024 + d0 * 32] = (bf16_t)(cvt_pk_bf16(v, v) & 0xffffu); }
            if ((r & 3) == 3) SBAR(); }
    }
}
}
__device__ __forceinline__ void ph_attn(Frame& F) {
    char* lds = (char*)(unsigned char*)F.lds;
    { float* bt = (float*)(lds + att::OFF_BT); const float* BT = (const float*)(F.ws + WS_BIAST); __syncthreads(); for (int i = F.tid; i < 249 * 8; i += NTHR) bt[i] = BT[i]; __syncthreads(); }
    for (int pr = F.bid; pr < NB * 32; pr += F.G) {
        const int b = pr >> 5, qb = pr & 31;
#pragma nounroll
        for (int hh = 0; hh < 2; ++hh) { if (ATT2) att::attn_item2(F, b, (hh ? qb : 63 - qb) * 32, lds); else att::attn_item(F, b, (hh ? qb : 63 - qb) * 32, lds); }
    }
}

namespace ssd {
constexpr int OFF_CS = 0, CS_ST = 272;
constexpr int OFF_BS = OFF_CS + 64 * CS_ST;
constexpr int OFF_BT = OFF_BS + 64 * CS_ST, T_ST = 144;
constexpr int OFF_XT = OFF_BT + 128 * T_ST;
constexpr int OFF_XW = OFF_XT + 64 * T_ST;
constexpr int OFF_XS = OFF_XW + 64 * T_ST;
constexpr int OFF_MT = OFF_XS + 64 * T_ST;
constexpr int OFF_HS = OFF_MT + 64 * T_ST;
constexpr int OFF_END = OFF_HS + 64 * CS_ST;
static_assert(OFF_END + 5 * 320 * 4 <= 131072, "ssd lds");
__device__ __forceinline__ f32x4 mfma16(bf16x8 a, bf16x8 b, f32x4 c) { return __builtin_amdgcn_mfma_f32_16x16x32_bf16(a, b, c, 0, 0, 0); }
__device__ __forceinline__ bf16x8 ldfrag(const char* base, int stride, int row, int k0) { return *(const bf16x8*)(base + row * stride + k0 * 2); }
}
__device__ __forceinline__ void ph_ssd(Frame& F) {
    using namespace ssd;
    char* lds = (char*)(unsigned char*)F.lds;
    const bf16_t* XBC = (const bf16_t*)(F.ws + WS_XBC); const bf16_t* ZS = (const bf16_t*)(F.ws + WS_Z); const float* DT = (const float*)(F.outb + OUT_DT);
    bf16_t* YG = (bf16_t*)(F.ws + WS_Q);
    const float* conv_w = F.a->in[9]; const float* conv_b = F.a->in[10]; const float* a_log = F.a->in[12]; const float* d_skip = F.a->in[13];
    const int tid = F.tid, wid = F.wave, lane = F.lane, fr = lane & 15, fq = lane >> 4;
    const bool stager = tid < 320; const int so = tid % 40, tg = tid / 40;
    for (int item = F.bid; item < NB * 16; item += F.G) {
        const int b = item >> 4, h = item & 15, g = h >> 2;
        const float aneg = -__expf(a_log[h]), dsk = d_skip[h];
        const int ch0 = so < 8 ? h * 64 + so * 8 : (so < 24 ? 1024 + g * 128 + (so - 8) * 8 : 1536 + g * 128 + (so - 24) * 8);
        float* CWL = (float*)(lds + OFF_END);
        __syncthreads();
        if (stager) {
#pragma unroll
            for (int j = 0; j < 4; ++j) { *(f32x4*)(CWL + j * 320 + so * 8) = *(const f32x4*)(conv_w + (size_t)j * 2048 + ch0); *(f32x4*)(CWL + j * 320 + so * 8 + 4) = *(const f32x4*)(conv_w + (size_t)j * 2048 + ch0 + 4); }
            *(f32x4*)(CWL + 4 * 320 + so * 8) = *(const f32x4*)(conv_b + ch0); *(f32x4*)(CWL + 4 * 320 + so * 8 + 4) = *(const f32x4*)(conv_b + ch0 + 4);
        }
        f32x4 hst[4];
#pragma unroll
        for (int t = 0; t < 4; ++t) hst[t] = (f32x4){0.f, 0.f, 0.f, 0.f};
        __syncthreads();
        for (int i = tid; i < 64 * CS_ST / 4; i += NTHR) ((unsigned*)(lds + OFF_HS))[i] = 0u;
        u32x4 raw[11];
        const size_t tokb = (size_t)b * SEQ;
#define SSD_LOAD(c) do { if (stager) { _Pragma("unroll") for (int i = 0; i < 11; ++i) { const int t = (c) * 64 + tg * 8 - 3 + i; \
            raw[i] = (t >= 0) ? *(const u32x4*)(XBC + (tokb + t) * 2048 + ch0) : (u32x4){0u, 0u, 0u, 0u}; } } } while (0)
        SSD_LOAD(0);
        float dtl_next = DT[(tokb + lane) * 16 + h];
        for (int c = 0; c < 32; ++c) {
            const float dtl = dtl_next; if (c + 1 < 32) dtl_next = DT[(tokb + (c + 1) * 64 + lane) * 16 + h];
            u32x2 zpre[2];
#pragma unroll
            for (int t2 = 0; t2 < 2; ++t2) { const int tile = 2 * wid + t2, pb = tile >> 2, lb = tile & 3; zpre[t2] = *(const u32x2*)(ZS + (tokb + c * 64 + lb * 16 + fr) * 1024 + h * 64 + pb * 16 + 4 * fq); }
            float acs = dtl * aneg;
#pragma unroll
            for (int o = 1; o < 64; o <<= 1) { const float t = __shfl_up(acs, o); if (lane >= o) acs += t; }
            const float alast = __shfl(acs, 63);
            if (DBG_SSD_SYNC) __syncthreads();
            float dtv[8], dec[8];
#pragma unroll
            for (int t = 0; t < 8; ++t) { dtv[t] = __shfl(dtl, (tg * 8 + t) & 63); dec[t] = __expf(alast - __shfl(acs, (tg * 8 + t) & 63)); }
            if (stager) {
#pragma unroll
                for (int hq = 0; hq < 2; ++hq) {
                    float xin[11][4];
#pragma unroll
                    for (int i = 0; i < 11; ++i) { const unsigned wa = hq ? raw[i].z : raw[i].x, wb = hq ? raw[i].w : raw[i].y; xin[i][0] = bflo(wa); xin[i][1] = bfhi(wa); xin[i][2] = bflo(wb); xin[i][3] = bfhi(wb); }
                    float outv[8][4];
                    { f32x4 cwv[4]; const f32x4 cbq = *(const f32x4*)(CWL + 4 * 320 + so * 8 + hq * 4);
#pragma unroll
                      for (int j = 0; j < 4; ++j) cwv[j] = *(const f32x4*)(CWL + j * 320 + so * 8 + hq * 4);
#pragma unroll
                      for (int t = 0; t < 8; ++t)
#pragma unroll
                        for (int e = 0; e < 4; ++e) { float sacc = cbq[e];
#pragma unroll
                            for (int j = 0; j < 4; ++j) sacc += cwv[j][e] * xin[t + j][e];
                            outv[t][e] = silu_f(sacc); } }
                    if (so < 8) {
#pragma unroll
                        for (int e = 0; e < 4; ++e) { const int p = so * 8 + hq * 4 + e;
                            f32x4 x0, x1, d0, d1, w0, w1;
#pragma unroll
                            for (int t = 0; t < 4; ++t) { x0[t] = outv[t][e]; x1[t] = outv[4 + t][e]; d0[t] = x0[t] * dtv[t]; d1[t] = x1[t] * dtv[4 + t]; w0[t] = d0[t] * dec[t]; w1[t] = d1[t] * dec[4 + t]; }
                            *(u32x4*)(lds + OFF_XS + p * T_ST + tg * 16) = pack8(x0, x1);
                            *(u32x4*)(lds + OFF_XT + p * T_ST + tg * 16) = pack8(d0, d1);
                            *(u32x4*)(lds + OFF_XW + p * T_ST + tg * 16) = pack8(w0, w1); }
                    } else {
                        const bool isB = so < 24; const int n0 = (isB ? (so - 8) : (so - 24)) * 8 + hq * 4;
                        char* nat = lds + (isB ? OFF_BS : OFF_CS);
#pragma unroll
                        for (int t = 0; t < 8; ++t) { u32x2 w; w.x = cvt_pk_bf16(outv[t][0], outv[t][1]); w.y = cvt_pk_bf16(outv[t][2], outv[t][3]);
                            *(u32x2*)(nat + (tg * 8 + t) * CS_ST + n0 * 2) = w; }
                        if (isB) {
#pragma unroll
                            for (int e = 0; e < 4; ++e) { f32x4 a, bq;
#pragma unroll
                                for (int t = 0; t < 4; ++t) { a[t] = outv[t][e]; bq[t] = outv[4 + t][e]; }
                                *(u32x4*)(lds + OFF_BT + (n0 + e) * T_ST + tg * 16) = pack8(a, bq); }
                        }
                    }
                }
            }
            if (c + 1 < 32) SSD_LOAD(c + 1);
            __syncthreads();
#pragma unroll
            for (int t2 = 0; t2 < 2; ++t2) {
                const int tile = 2 * wid + t2, sb = tile >> 2, lb = tile & 3;
                f32x4 d = (f32x4){0.f, 0.f, 0.f, 0.f};
                if (sb <= lb) {
#pragma unroll
                    for (int ks = 0; ks < 4; ++ks) d = mfma16(ldfrag(lds + OFF_BS, CS_ST, sb * 16 + fr, ks * 32 + fq * 8), ldfrag(lds + OFF_CS, CS_ST, lb * 16 + fr, ks * 32 + fq * 8), d);
                    const int l = lb * 16 + fr; const float al = __shfl(acs, l);
                    f32x4 as;
#pragma unroll
                    for (int r = 0; r < 4; ++r) as[r] = __shfl(acs, sb * 16 + 4 * fq + r);
#pragma unroll
                    for (int r = 0; r < 4; ++r) { const int s = sb * 16 + 4 * fq + r; d[r] = (s <= l) ? d[r] * __expf(al - as[r]) : 0.f; }
                }
                u32x2 w; w.x = cvt_pk_bf16(d[0], d[1]); w.y = cvt_pk_bf16(d[2], d[3]);
                *(u32x2*)(lds + OFF_MT + (lb * 16 + fr) * T_ST + (sb * 16 + 4 * fq) * 2) = w;
            }
            if (DBG_SSD_SYNC) __syncthreads();
            f32x4 yacc[2];
#pragma unroll
            for (int t2 = 0; t2 < 2; ++t2) {
                const int tile = 2 * wid + t2, pb = tile >> 2, lb = tile & 3;
                f32x4 d = (f32x4){0.f, 0.f, 0.f, 0.f};
#pragma unroll
                for (int ks = 0; ks < 4; ++ks) d = mfma16(ldfrag(lds + OFF_HS, CS_ST, pb * 16 + fr, ks * 32 + fq * 8), ldfrag(lds + OFF_CS, CS_ST, lb * 16 + fr, ks * 32 + fq * 8), d);
                const float el = __expf(__shfl(acs, lb * 16 + fr));
                yacc[t2] = d * el;
            }
            __syncthreads();
#pragma unroll
            for (int t2 = 0; t2 < 2; ++t2) {
                const int tile = 2 * wid + t2, pb = tile >> 2, lb = tile & 3;
                f32x4 d = yacc[t2];
#pragma unroll
                for (int ks = 0; ks < 2; ++ks) d = mfma16(ldfrag(lds + OFF_XT, T_ST, pb * 16 + fr, ks * 32 + fq * 8), ldfrag(lds + OFF_MT, T_ST, lb * 16 + fr, ks * 32 + fq * 8), d);
                const int l = lb * 16 + fr, p0 = pb * 16 + 4 * fq; const size_t tok = tokb + c * 64 + l;
                const u32x2 zz = zpre[t2];
                const float z0 = bflo(zz.x), z1 = bfhi(zz.x), z2 = bflo(zz.y), z3 = bfhi(zz.y);
                float xs[4];
#pragma unroll
                for (int r = 0; r < 4; ++r) xs[r] = bflo((unsigned)*(const bf16_t*)(lds + OFF_XS + (p0 + r) * T_ST + l * 2));
                u32x2 w; w.x = cvt_pk_bf16((d[0] + xs[0] * dsk) * z0, (d[1] + xs[1] * dsk) * z1); w.y = cvt_pk_bf16((d[2] + xs[2] * dsk) * z2, (d[3] + xs[3] * dsk) * z3);
                *(u32x2*)(YG + tok * 1024 + h * 64 + p0) = w;
            }
            if (DBG_SSD_SYNC) __syncthreads();
            { const float dc = __expf(alast);
#pragma unroll
              for (int t = 0; t < 4; ++t) { f32x4 d = hst[t] * dc;
#pragma unroll
                  for (int ks = 0; ks < 2; ++ks) d = mfma16(ldfrag(lds + OFF_BT, T_ST, wid * 16 + fr, ks * 32 + fq * 8), ldfrag(lds + OFF_XW, T_ST, t * 16 + fr, ks * 32 + fq * 8), d);
                  hst[t] = d;
                  u32x2 w; w.x = cvt_pk_bf16(d[0], d[1]); w.y = cvt_pk_bf16(d[2], d[3]);
                  *(u32x2*)(lds + OFF_HS + (t * 16 + fr) * CS_ST + (wid * 16 + 4 * fq) * 2) = w; } }
            __syncthreads();
        }
#undef SSD_LOAD
    }
}

namespace ssd2 {
constexpr int CS_ST = 272, T_ST = 144;
constexpr int OFF_CS = 0, OFF_BS = 64 * CS_ST, OFF_BT = 2 * 64 * CS_ST, OFF_H0 = OFF_BT + 128 * T_ST;
constexpr int H_XS = 0, H_XW = 64 * T_ST, H_MT = 2 * 64 * T_ST, H_HS = 3 * 64 * T_ST, H_SZ = H_HS + 64 * CS_ST;
constexpr int OFF_CW = OFF_H0 + 2 * H_SZ;
constexpr int OFF_TAB = OFF_CW + 5 * 384 * 4;
static_assert(OFF_TAB + 6 * 64 * 4 <= LDS_MISC, "ssd2 lds");
}
__device__ __forceinline__ void ph_ssd2(Frame& F, const int abl = 0) {
    using namespace ssd2; using ssd::mfma16; using ssd::ldfrag;
    char* lds = (char*)(unsigned char*)F.lds;
    const bf16_t* XBC = (const bf16_t*)(F.ws + WS_XBC); const bf16_t* ZS = (const bf16_t*)(F.ws + WS_Z); const float* DT = (const float*)(F.outb + OUT_DT);
    bf16_t* YG = (bf16_t*)(F.ws + WS_Q);
    const float* conv_w = F.a->in[9]; const float* conv_b = F.a->in[10]; const float* a_log = F.a->in[12]; const float* d_skip = F.a->in[13];
    const int tid = F.tid, wid = F.wave, lane = F.lane, fr = lane & 15, fq = lane >> 4;
    const int su = tid < 384 ? tid : tid - 128; const bool cwl_writer = true;
    const int cp_lo = __builtin_amdgcn_readfirstlane(tid < 384 ? 0 : 2), cp_hi = __builtin_amdgcn_readfirstlane(tid < 256 ? 4 : (tid < 384 ? 2 : 4));
    const int so = su % 48, tg = su / 48, shd = (so >> 3) & 1;
    for (int item = F.bid; item < NB * 8; item += F.G) {
        const int b = item >> 3, g = (item >> 1) & 3, h0 = g * 4 + (item & 1) * 2;
        const float aneg0 = -__expf(a_log[h0]), aneg1 = -__expf(a_log[h0 + 1]), dsk0 = d_skip[h0], dsk1 = d_skip[h0 + 1];
        const int ch0 = so < 16 ? (h0 + shd) * 64 + (so & 7) * 8 : (so < 32 ? 1024 + g * 128 + (so - 16) * 8 : 1536 + g * 128 + (so - 32) * 8);
        float* CWL = (float*)(lds + OFF_CW);
        __syncthreads();
        if (cwl_writer) {
#pragma unroll
            for (int j = 0; j < 4; ++j) { *(f32x4*)(CWL + j * 384 + so * 8) = *(const f32x4*)(conv_w + (size_t)j * 2048 + ch0); *(f32x4*)(CWL + j * 384 + so * 8 + 4) = *(const f32x4*)(conv_w + (size_t)j * 2048 + ch0 + 4); }
            *(f32x4*)(CWL + 4 * 384 + so * 8) = *(const f32x4*)(conv_b + ch0); *(f32x4*)(CWL + 4 * 384 + so * 8 + 4) = *(const f32x4*)(conv_b + ch0 + 4);
        }
        f32x4 hst[2][4];
#pragma unroll
        for (int hh = 0; hh < 2; ++hh)
#pragma unroll
            for (int t = 0; t < 4; ++t) hst[hh][t] = (f32x4){0.f, 0.f, 0.f, 0.f};
        for (int i = tid; i < 64 * CS_ST / 4; i += NTHR) { ((unsigned*)(lds + OFF_H0 + H_HS))[i] = 0u; ((unsigned*)(lds + OFF_H0 + H_SZ + H_HS))[i] = 0u; }
        u32x4 raw[11];
        const size_t tokb = (size_t)b * SEQ;
        const bf16_t* xrow = XBC + ((ptrdiff_t)tokb + tg * 8 - 3) * 2048 + ch0;
#define SSD_LOAD(c, xp, tgx) do { { _Pragma("unroll") for (int i = 0; i < 11; ++i) { const int t = (c) * 64 + (tgx) * 8 - 3 + i; \
            raw[i] = (t >= 0) ? *(const GAS u32x4*)((xp) + (ptrdiff_t)((c) * 64 + i) * 2048) : (u32x4){0u, 0u, 0u, 0u}; } } } while (0)
        SSD_LOAD(0, xrow, tg);
        f32x2 dtn = *(const f32x2*)(DT + (tokb + lane) * 16 + h0);
        for (int c = 0; c < 32; ++c) {
            int frl = fr, fql = fq, tgl = tg, sol = so; const bf16_t* xrl = xrow; asm volatile("" : "+v"(frl), "+v"(fql), "+v"(tgl), "+v"(sol), "+v"(xrl)); const int shdl = (sol >> 3) & 1;
            const float dtl0 = dtn[0], dtl1 = dtn[1]; if (c + 1 < 32) dtn = *(const f32x2*)(DT + (tokb + (c + 1) * 64 + lane) * 16 + h0);
            u32x2 zpre[2][2];
#pragma unroll
            for (int hh = 0; hh < 2; ++hh)
#pragma unroll
                for (int t2 = 0; t2 < 2; ++t2) { const int tile = 2 * wid + t2, pb = tile >> 2, lb = tile & 3; zpre[hh][t2] = *(const u32x2*)(ZS + (tokb + c * 64 + lb * 16 + frl) * 1024 + (h0 + hh) * 64 + pb * 16 + 4 * fql); }
            const float acs0 = dpp_scan_add(dtl0 * aneg0), acs1 = dpp_scan_add(dtl1 * aneg1);
            const float alast0 = __builtin_bit_cast(float, __builtin_amdgcn_readlane(__builtin_bit_cast(int, acs0), 63)), alast1 = __builtin_bit_cast(float, __builtin_amdgcn_readlane(__builtin_bit_cast(int, acs1), 63));
            float* TAB = (float*)(lds + OFF_TAB);
            TAB[lane] = acs0; TAB[64 + lane] = acs1; TAB[128 + lane] = dtl0; TAB[192 + lane] = dtl1; TAB[256 + lane] = dtl0 * __expf(alast0 - acs0); TAB[320 + lane] = dtl1 * __expf(alast1 - acs1);
            LDS_WAIT(); asm volatile("" ::: "memory");
            float wdt[8];
            { const f32x4 wa = *(const f32x4*)(TAB + 256 + shdl * 64 + tgl * 8), wb = *(const f32x4*)(TAB + 256 + shdl * 64 + tgl * 8 + 4);
#pragma unroll
              for (int t = 0; t < 4; ++t) { wdt[t] = wa[t]; wdt[4 + t] = wb[t]; } }
            if (!(abl & 1)) {
#pragma unroll
                for (int cp = 0; cp < 4; ++cp) {
                    if (cp < cp_lo || cp >= cp_hi) continue;
                    float xin[11][2];
#pragma unroll
                    for (int i = 0; i < 11; ++i) { const unsigned wa = cp == 0 ? raw[i].x : (cp == 1 ? raw[i].y : (cp == 2 ? raw[i].z : raw[i].w)); xin[i][0] = bflo(wa); xin[i][1] = bfhi(wa); }
                    float outv[8][2];
                    { f32x2 cwv[4]; const f32x2 cbq = *(const f32x2*)(CWL + 4 * 384 + sol * 8 + cp * 2);
#pragma unroll
                      for (int j = 0; j < 4; ++j) cwv[j] = *(const f32x2*)(CWL + j * 384 + sol * 8 + cp * 2);
#pragma unroll
                      for (int t = 0; t < 8; ++t)
#pragma unroll
                        for (int e = 0; e < 2; ++e) { float sacc = cbq[e];
#pragma unroll
                            for (int j = 0; j < 4; ++j) sacc += cwv[j][e] * xin[t + j][e];
                            outv[t][e] = silu_f(sacc); } }
                    if (sol < 16) {
                        char* hb = lds + OFF_H0 + shdl * H_SZ;
#pragma unroll
                        for (int e = 0; e < 2; ++e) { const int p = (sol & 7) * 8 + cp * 2 + e;
                            f32x4 x0, x1, w0, w1;
#pragma unroll
                            for (int t = 0; t < 4; ++t) { x0[t] = outv[t][e]; x1[t] = outv[4 + t][e]; w0[t] = x0[t] * wdt[t]; w1[t] = x1[t] * wdt[4 + t]; }
                            *(u32x4*)(hb + H_XS + p * T_ST + tgl * 16) = pack8(x0, x1);
                            *(u32x4*)(hb + H_XW + p * T_ST + tgl * 16) = pack8(w0, w1); }
                    } else {
                        const bool isB = sol < 32; const int n0 = (isB ? (sol - 16) : (sol - 32)) * 8 + cp * 2;
                        char* nat = lds + (isB ? OFF_BS : OFF_CS);
#pragma unroll
                        for (int t = 0; t < 8; ++t) *(unsigned*)(nat + (tgl * 8 + t) * CS_ST + n0 * 2) = cvt_pk_bf16(outv[t][0], outv[t][1]);
                        if (isB) {
#pragma unroll
                            for (int e = 0; e < 2; ++e) { f32x4 a, bq;
#pragma unroll
                                for (int t = 0; t < 4; ++t) { a[t] = outv[t][e]; bq[t] = outv[4 + t][e]; }
                                *(u32x4*)(lds + OFF_BT + (n0 + e) * T_ST + tgl * 16) = pack8(a, bq); }
                        }
                    }
                    SBAR();
                }
            }
            if (c + 1 < 32) SSD_LOAD(c + 1, xrl, tgl);
            __syncthreads();
            bf16x8 cfr[2][4];
#pragma unroll
            for (int t2 = 0; t2 < 2; ++t2)
#pragma unroll
                for (int ks = 0; ks < 4; ++ks) cfr[t2][ks] = ldfrag(lds + OFF_CS, CS_ST, ((2 * wid + t2) & 3) * 16 + frl, ks * 32 + fql * 8);
            if (!(abl & 2))
#pragma unroll
            for (int t2 = 0; t2 < 2; ++t2) {
                const int tile = 2 * wid + t2, sb = tile >> 2, lb = tile & 3;
                f32x4 d = (f32x4){0.f, 0.f, 0.f, 0.f}, m0 = d, m1 = d;
                if (sb <= lb) {
#pragma unroll
                    for (int ks = 0; ks < 4; ++ks) d = mfma16(ldfrag(lds + OFF_BS, CS_ST, sb * 16 + frl, ks * 32 + fql * 8), cfr[t2][ks], d);
                    const int l = lb * 16 + frl, s4 = sb * 16 + 4 * fql; const float al0 = TAB[l], al1 = TAB[64 + l];
                    const f32x4 as0 = *(const f32x4*)(TAB + s4), as1 = *(const f32x4*)(TAB + 64 + s4), ds0 = *(const f32x4*)(TAB + 128 + s4), ds1 = *(const f32x4*)(TAB + 192 + s4);
#pragma unroll
                    for (int r = 0; r < 4; ++r) { const int sidx = s4 + r;
                        m0[r] = (sidx <= l) ? d[r] * __expf(al0 - as0[r]) * ds0[r] : 0.f; m1[r] = (sidx <= l) ? d[r] * __expf(al1 - as1[r]) * ds1[r] : 0.f; }
                }
                u32x2 w; w.x = cvt_pk_bf16(m0[0], m0[1]); w.y = cvt_pk_bf16(m0[2], m0[3]);
                *(u32x2*)(lds + OFF_H0 + H_MT + (lb * 16 + frl) * T_ST + (sb * 16 + 4 * fql) * 2) = w;
                w.x = cvt_pk_bf16(m1[0], m1[1]); w.y = cvt_pk_bf16(m1[2], m1[3]);
                *(u32x2*)(lds + OFF_H0 + H_SZ + H_MT + (lb * 16 + frl) * T_ST + (sb * 16 + 4 * fql) * 2) = w;
            }
            f32x4 yacc[2][2];
#pragma unroll
            for (int hh = 0; hh < 2; ++hh)
#pragma unroll
                for (int t2 = 0; t2 < 2; ++t2) {
                    const int tile = 2 * wid + t2, pb = tile >> 2, lb = tile & 3; const char* hb = lds + OFF_H0 + hh * H_SZ;
                    f32x4 d = (f32x4){0.f, 0.f, 0.f, 0.f};
                    if (!(abl & 2))
#pragma unroll
                    for (int ks = 0; ks < 4; ++ks) d = mfma16(ldfrag(hb + H_HS, CS_ST, pb * 16 + frl, ks * 32 + fql * 8), cfr[t2][ks], d);
                    const float el = __expf(TAB[hh * 64 + lb * 16 + frl]);
                    yacc[hh][t2] = d * el;
                }
            __syncthreads();
            if (!(abl & 4))
#pragma unroll
            for (int hh = 0; hh < 2; ++hh)
#pragma unroll
                for (int t2 = 0; t2 < 2; ++t2) {
                    const int tile = 2 * wid + t2, pb = tile >> 2, lb = tile & 3; const char* hb = lds + OFF_H0 + hh * H_SZ;
                    f32x4 d = yacc[hh][t2];
#pragma unroll
                    for (int ks = 0; ks < 2; ++ks) d = mfma16(ldfrag(hb + H_XS, T_ST, pb * 16 + frl, ks * 32 + fql * 8), ldfrag(hb + H_MT, T_ST, lb * 16 + frl, ks * 32 + fql * 8), d);
                    const int l = lb * 16 + frl, p0 = pb * 16 + 4 * fql; const size_t tok = tokb + c * 64 + l; const float dsk = hh ? dsk1 : dsk0;
                    const u32x2 zz = zpre[hh][t2];
                    const float z0 = bflo(zz.x), z1 = bfhi(zz.x), z2 = bflo(zz.y), z3 = bfhi(zz.y);
                    float xs[4];
#pragma unroll
                    for (int r = 0; r < 4; ++r) xs[r] = bflo((unsigned)*(const bf16_t*)(hb + H_XS + (p0 + r) * T_ST + l * 2));
                    u32x2 w; w.x = cvt_pk_bf16((d[0] + xs[0] * dsk) * z0, (d[1] + xs[1] * dsk) * z1); w.y = cvt_pk_bf16((d[2] + xs[2] * dsk) * z2, (d[3] + xs[3] * dsk) * z3);
                    *(u32x2*)(YG + tok * 1024 + (h0 + hh) * 64 + p0) = w;
                }
            const bf16x8 btf0 = ldfrag(lds + OFF_BT, T_ST, wid * 16 + frl, fql * 8), btf1 = ldfrag(lds + OFF_BT, T_ST, wid * 16 + frl, 32 + fql * 8);
            if (!(abl & 8))
#pragma unroll
            for (int hh = 0; hh < 2; ++hh) { const float dc = __expf(hh ? alast1 : alast0); char* hb = lds + OFF_H0 + hh * H_SZ;
#pragma unroll
                for (int t = 0; t < 4; ++t) { f32x4 d = hst[hh][t] * dc;
#pragma unroll
                    for (int ks = 0; ks < 2; ++ks) d = mfma16(ks ? btf1 : btf0, ldfrag(hb + H_XW, T_ST, t * 16 + frl, ks * 32 + fql * 8), d);
                    hst[hh][t] = d;
                    u32x2 w; w.x = cvt_pk_bf16(d[0], d[1]); w.y = cvt_pk_bf16(d[2], d[3]);
                    *(u32x2*)(hb + H_HS + (t * 16 + frl) * CS_ST + (wid * 16 + 4 * fql) * 2) = w; } }
            __syncthreads();
        }
#undef SSD_LOAD
    }
}

__device__ __forceinline__ void ph_gnorm(Frame& F) {
    bf16_t* YG = (bf16_t*)(F.ws + WS_Q);
    const int gw = F.bid * NWAVES + F.wave, NGW = F.G * NWAVES;
    constexpr int RB = 4;
    for (int m0 = gw * RB; m0 < NTOK; m0 += NGW * RB) {
        u32x2 w[RB][4];
#pragma unroll
        for (int r = 0; r < RB; ++r) { const u32x2* rp = (const u32x2*)(YG + (size_t)(m0 + r) * D) + F.lane;
#pragma unroll
            for (int j = 0; j < 4; ++j) w[r][j] = rp[64 * j]; }
#pragma unroll
        for (int r = 0; r < RB; ++r) { const int m = m0 + r; u32x2* rp = (u32x2*)(YG + (size_t)m * D) + F.lane;
#pragma unroll
            for (int j = 0; j < 4; ++j) { const float a = bflo(w[r][j].x), b = bfhi(w[r][j].x), c = bflo(w[r][j].y), d = bfhi(w[r][j].y);
                const float ss = wave_sum(a * a + b * b + c * c + d * d); const float rr = 1.f / sqrtf(ss * (1.f / 256.f) + LN_EPS);
                if (PB_FP8) { int pk = 0; pk = __builtin_amdgcn_cvt_pk_fp8_f32(a * rr, b * rr, pk, false); pk = __builtin_amdgcn_cvt_pk_fp8_f32(c * rr, d * rr, pk, true); ((unsigned*)(F.outb + OUT_OB8 + (size_t)m * D))[F.lane + 64 * j] = (unsigned)pk; }
                else { u32x2 o; o.x = cvt_pk_bf16(a * rr, b * rr); o.y = cvt_pk_bf16(c * rr, d * rr); rp[64 * j] = o; } } }
    }
}

template <bool DRY = false> __device__ __forceinline__ void ph_router(Frame& F) {
    float* X1 = (float*)F.outb; bf16_t* U2 = (bf16_t*)(F.ws + WS_U2); const float* MOD = (const float*)(F.ws + WS_MOD);
    const float* ln1g = F.a->in[18]; const float* ln1b = F.a->in[19]; const float* w_router = F.a->in[20]; const float* b_router = F.a->in[21];
    u32x2* REG = (u32x2*)(F.ws + WS_REG); unsigned* CNT = (unsigned*)(F.ws + WS_CTL) + CW_CNT;
    constexpr int TST = 2064;
    LAS unsigned char* THI = F.lds; LAS unsigned char* TLO = F.lds + 16 * TST; LAS float* PART = (LAS float*)(F.lds + 32 * TST);
    LAS unsigned* lcnt = (LAS unsigned*)(F.lds + LDS_AUX); LAS unsigned* lbase = lcnt + 32; LAS unsigned* ent = lcnt + 64;
    const int tid = F.tid, lane = F.lane, wid = F.wave, fr = lane & 15, fq = lane >> 4;
    bf16x8 whi[4][2], wlo[4][2];
#pragma unroll
    for (int ks = 0; ks < 4; ++ks)
#pragma unroll
        for (int ct = 0; ct < 2; ++ct) { float wv[8];
#pragma unroll
            for (int i = 0; i < 8; ++i) wv[i] = w_router[(size_t)(128 * wid + 32 * ks + 8 * fq + i) * 32 + ct * 16 + fr];
            u32x4 h, l2;
#pragma unroll
            for (int i = 0; i < 4; ++i) { const unsigned hp = cvt_pk_bf16(wv[2 * i], wv[2 * i + 1]); const float r0 = wv[2 * i] - bflo(hp), r1 = wv[2 * i + 1] - bfhi(hp); h[i] = hp; l2[i] = cvt_pk_bf16(r0, r1); }
            whi[ks][ct] = __builtin_bit_cast(bf16x8, h); wlo[ks][ct] = __builtin_bit_cast(bf16x8, l2); }
    const float brl = b_router[lane & 31];
    for (int batch = F.bid; batch < NTOK / 256; batch += F.G) {
        const int hf = batch >> 7;
        __syncthreads();
        if (tid < 32) lcnt[tid] = 0u;
        for (int grp = 0; grp < 16; ++grp) {
#pragma unroll
            for (int tt = 0; tt < 2; ++tt) {
                const int tg16 = 2 * wid + tt, m = batch * 256 + grp * 16 + tg16; const float* md = MOD + (size_t)(m >> 11) * 6144;
                f32x4* xr = (f32x4*)(X1 + (size_t)m * D) + lane;
                f32x4 v[4]; float s = 0.f;
#pragma unroll
                for (int j = 0; j < 4; ++j) { v[j] = xr[64 * j]; s += (v[j][0] + v[j][1]) + (v[j][2] + v[j][3]); }
                float mean = wave_sum(s) * (1.f / D), s2 = 0.f;
#pragma unroll
                for (int j = 0; j < 4; ++j) { v[j] = v[j] - mean; s2 += (v[j][0] * v[j][0] + v[j][1] * v[j][1]) + (v[j][2] * v[j][2] + v[j][3] * v[j][3]); }
                float rstd = 1.f / sqrtf(wave_sum(s2) * (1.f / D) + LN_EPS);
                s = 0.f;
#pragma unroll
                for (int j = 0; j < 4; ++j) { const f32x4 g = *((const f32x4*)ln1g + lane + 64 * j), bb = *((const f32x4*)ln1b + lane + 64 * j); v[j] = v[j] * rstd * g + bb; if (!DRY) xr[64 * j] = v[j]; s += (v[j][0] + v[j][1]) + (v[j][2] + v[j][3]); }
                mean = wave_sum(s) * (1.f / D); s2 = 0.f;
#pragma unroll
                for (int j = 0; j < 4; ++j) { v[j] = v[j] - mean; s2 += (v[j][0] * v[j][0] + v[j][1] * v[j][1]) + (v[j][2] * v[j][2] + v[j][3] * v[j][3]); }
                rstd = 1.f / sqrtf(wave_sum(s2) * (1.f / D) + LN_EPS);
                u32x2* o8 = (u32x2*)(U2 + (size_t)m * D) + lane;
#pragma unroll
                for (int j = 0; j < 4; ++j) { const f32x4 sh = *((const f32x4*)(md + 3072) + lane + 64 * j), sc = *((const f32x4*)(md + 4096) + lane + 64 * j);
                    v[j] = v[j] * rstd * (sc + 1.0f) + sh; u32x2 w; w.x = cvt_pk_bf16(v[j][0], v[j][1]); w.y = cvt_pk_bf16(v[j][2], v[j][3]);
                    if (DRY) { if (w.x == 0x12345678u) o8[64 * j] = w; }
                    else if (MOE_FP8) { int pk = 0; pk = __builtin_amdgcn_cvt_pk_fp8_f32(v[j][0], v[j][1], pk, false); pk = __builtin_amdgcn_cvt_pk_fp8_f32(v[j][2], v[j][3], pk, true); ((unsigned*)((unsigned char*)U2 + (size_t)m * D))[lane + 64 * j] = (unsigned)pk; }
                    else o8[64 * j] = w;
                    u32x2 lo; lo.x = cvt_pk_bf16(v[j][0] - bflo(w.x), v[j][1] - bfhi(w.x)); lo.y = cvt_pk_bf16(v[j][2] - bflo(w.y), v[j][3] - bfhi(w.y));
                    *(LAS u32x2*)(THI + tg16 * TST + (4 * lane + 256 * j) * 2) = w; *(LAS u32x2*)(TLO + tg16 * TST + (4 * lane + 256 * j) * 2) = lo; }
            }
            __syncthreads();
            { f32x4 a0 = (f32x4){0.f, 0.f, 0.f, 0.f}, a1 = a0;
#pragma unroll
              for (int ks = 0; ks < 4; ++ks) { const int cb = (128 * wid + 32 * ks + 8 * fq) * 2;
                  const bf16x8 th = *(const LAS bf16x8*)(THI + fr * TST + cb), tl = *(const LAS bf16x8*)(TLO + fr * TST + cb);
                  a0 = __builtin_amdgcn_mfma_f32_16x16x32_bf16(whi[ks][0], th, a0, 0, 0, 0); a1 = __builtin_amdgcn_mfma_f32_16x16x32_bf16(whi[ks][1], th, a1, 0, 0, 0);
                  a0 = __builtin_amdgcn_mfma_f32_16x16x32_bf16(wlo[ks][0], th, a0, 0, 0, 0); a1 = __builtin_amdgcn_mfma_f32_16x16x32_bf16(wlo[ks][1], th, a1, 0, 0, 0);
                  a0 = __builtin_amdgcn_mfma_f32_16x16x32_bf16(whi[ks][0], tl, a0, 0, 0, 0); a1 = __builtin_amdgcn_mfma_f32_16x16x32_bf16(whi[ks][1], tl, a1, 0, 0, 0); }
              *(LAS f32x4*)(PART + (wid * 16 + fr) * 32 + 4 * fq) = a0; *(LAS f32x4*)(PART + (wid * 16 + fr) * 32 + 16 + 4 * fq) = a1; }
            __syncthreads();
            { const int tg16 = 2 * wid + (lane >> 5), tl = grp * 16 + tg16, myexp = lane & 31;
              float logit = brl;
#pragma unroll
              for (int w8 = 0; w8 < 8; ++w8) logit += PART[(w8 * 16 + tg16) * 32 + myexp];
              float tv[4]; int tix[4];
#pragma unroll
              for (int k = 0; k < 4; ++k) { float bv = logit; int bi = myexp;
#define RT_STEP(ctrl, rm) do { const float ov = __builtin_bit_cast(float, __builtin_amdgcn_update_dpp((int)0xff800000u, __builtin_bit_cast(int, bv), (ctrl), (rm), 0xf, false)); \
                      const int oi = __builtin_amdgcn_update_dpp(64, bi, (ctrl), (rm), 0xf, false); if (ov > bv || (ov == bv && oi < bi)) { bv = ov; bi = oi; } } while (0)
                  RT_STEP(0x111, 0xf); RT_STEP(0x112, 0xf); RT_STEP(0x114, 0xf); RT_STEP(0x118, 0xf); RT_STEP(0x142, 0xa);
#undef RT_STEP
                  { const int b0 = __builtin_amdgcn_readlane(__builtin_bit_cast(int, bv), 31), b1 = __builtin_amdgcn_readlane(__builtin_bit_cast(int, bv), 63), i0 = __builtin_amdgcn_readlane(bi, 31), i1 = __builtin_amdgcn_readlane(bi, 63);
                    bv = __builtin_bit_cast(float, lane < 32 ? b0 : b1); bi = lane < 32 ? i0 : i1; }
                  tv[k] = bv; tix[k] = bi; if (myexp == bi) logit = -INFINITY; }
              const float e1 = __expf(tv[1] - tv[0]), e2 = __expf(tv[2] - tv[0]), e3 = __expf(tv[3] - tv[0]); const float inv = 1.f / (1.f + e1 + e2 + e3);
              if (myexp < 4) { const int ee = myexp == 0 ? tix[0] : (myexp == 1 ? tix[1] : (myexp == 2 ? tix[2] : tix[3])); const float gg = (myexp == 0 ? 1.f : (myexp == 1 ? e1 : (myexp == 2 ? e2 : e3))) * inv;
                  const unsigned lp = atomicAdd((unsigned*)&lcnt[ee], 1u);
                  LAS unsigned* en = ent + (tl * 4 + myexp) * 3; en[0] = (unsigned)ee; en[1] = lp; en[2] = __float_as_uint(gg);
                  if (DBG_CHECK == 1) { u32x2 rw; rw.x = (unsigned)ee; rw.y = __float_as_uint(gg); ((u32x2*)(F.ws + WS_DBG))[(size_t)(batch * 256 + tl) * 4 + myexp] = rw; } } }
        }
        __syncthreads();
        if (tid < 32) lbase[tid] = DRY ? 0u : __hip_atomic_fetch_add(CNT + 64 * (hf * 32 + tid), lcnt[tid], __ATOMIC_RELAXED, __HIP_MEMORY_SCOPE_AGENT);
        __syncthreads();
        for (int i = tid; i < 1024; i += NTHR) { const LAS unsigned* en = ent + i * 3; const unsigned ee = en[0], pos = lbase[ee] + en[1];
            const unsigned tokl = (unsigned)(batch * 256 + (i >> 2)) - (unsigned)hf * HALF_TOK;
            u32x2 w; w.x = tokl * 4u + (unsigned)(i & 3); w.y = en[2];
            if (!DRY && pos < (unsigned)REG_CAP) REG[((size_t)hf * 32 + ee) * REG_CAP + pos] = w; }
    }
}

template <bool DRY = false> __device__ __forceinline__ void ph_final(Frame& F, int hf) {
    float* X1 = (float*)F.outb; const bf16_t* YB = (const bf16_t*)(F.ws + WS_YB); const float* MOD = (const float*)(F.ws + WS_MOD);
    const float* g2 = F.a->in[26]; const float* b2 = F.a->in[27];
    const int gw = F.bid * NWAVES + F.wave, NGW = F.G * NWAVES, lane = F.lane;
    constexpr int RB = 2;
    for (int tl0 = gw; tl0 < HALF_TOK; tl0 += NGW * RB) {
        f32x4 xv[RB][4]; u32x2 yw[RB][4][4];
#pragma unroll
        for (int r = 0; r < RB; ++r) { const int tl = tl0 + r * NGW, m = hf * HALF_TOK + tl;
            const f32x4* xr = (const f32x4*)(X1 + (size_t)m * D) + lane; const u32x2* yr = (const u32x2*)(YB + (size_t)tl * 4 * D) + lane;
#pragma unroll
            for (int j = 0; j < 4; ++j) { xv[r][j] = xr[64 * j];
#pragma unroll
                for (int k = 0; k < 4; ++k) yw[r][j][k] = yr[k * 256 + 64 * j]; } }
#pragma unroll
        for (int r = 0; r < RB; ++r) { const int tl = tl0 + r * NGW, m = hf * HALF_TOK + tl; const float* md = MOD + (size_t)(m >> 11) * 6144 + 5120;
            f32x4* xr = (f32x4*)(X1 + (size_t)m * D) + lane;
            f32x4 v[4]; float s = 0.f;
#pragma unroll
            for (int j = 0; j < 4; ++j) { f32x4 y = (f32x4){0.f, 0.f, 0.f, 0.f};
#pragma unroll
                for (int k = 0; k < 4; ++k) { const u32x2 w = yw[r][j][k]; y[0] += bflo(w.x); y[1] += bfhi(w.x); y[2] += bflo(w.y); y[3] += bfhi(w.y); }
                if (DBG_NO_MOE) y = (f32x4){0.f, 0.f, 0.f, 0.f};
                const f32x4 gt = *((const f32x4*)md + lane + 64 * j);
                v[j] = xv[r][j] * DN_ALPHA + gt * y; s += (v[j][0] + v[j][1]) + (v[j][2] + v[j][3]); }
            const float mean = wave_sum(s) * (1.f / D); float s2 = 0.f;
#pragma unroll
            for (int j = 0; j < 4; ++j) { v[j] = v[j] - mean; s2 += (v[j][0] * v[j][0] + v[j][1] * v[j][1]) + (v[j][2] * v[j][2] + v[j][3] * v[j][3]); }
            const float rstd = 1.f / sqrtf(wave_sum(s2) * (1.f / D) + LN_EPS);
#pragma unroll
            for (int j = 0; j < 4; ++j) { const f32x4 g = *((const f32x4*)g2 + lane + 64 * j), bb = *((const f32x4*)b2 + lane + 64 * j); const f32x4 ov = v[j] * rstd * g + bb; if (!DRY || ov[0] == 1.2345e-33f) xr[64 * j] = ov; } }
    }
}

__device__ __forceinline__ float block_sum(Frame& F, float v, LAS float* red) {
    v = wave_sum(v); __syncthreads(); if (F.lane == 0) red[F.wave] = v; __syncthreads();
    float s = 0.f; for (int w = 0; w < NWAVES; ++w) s += red[w]; return s;
}
__device__ __forceinline__ float block_max(Frame& F, float v, LAS float* red) {
#pragma unroll
    for (int o = 1; o < 64; o <<= 1) v = fmaxf(v, __shfl_xor(v, o));
    __syncthreads(); if (F.lane == 0) red[F.wave] = v; __syncthreads();
    float s = 0.f; for (int w = 0; w < NWAVES; ++w) s = fmaxf(s, red[w]); return s;
}
__device__ __forceinline__ void dbg_report(Frame& F, float e) { if (F.tid == 0) atomicMax((unsigned*)(F.ws + WS_CTL) + CW_DBG, __float_as_uint(e)); }
__device__ __forceinline__ void dbg_check_moe(Frame& F) {
    if (F.bid >= 64) return;
    const int tok = HALF_TOK + 509 * F.bid + 3, tokl = tok - HALF_TOK, tid = F.tid;
    LAS float* u2 = (LAS float*)F.lds; LAS float* act = u2 + 1024; LAS float* red = act + 1024; LAS float* lg = red + 16;
    const bf16_t* U2 = (const bf16_t*)(F.ws + WS_U2); const bf16_t* YB = (const bf16_t*)(F.ws + WS_YB); const u32x2* RT = (const u32x2*)(F.ws + WS_DBG);
    const float* w1 = F.a->in[22]; const float* b1 = F.a->in[23]; const float* w2 = F.a->in[24]; const float* b2 = F.a->in[25];
    __syncthreads();
    for (int i = tid; i < 1024; i += NTHR) u2[i] = bflo((unsigned)U2[(size_t)tok * 1024 + i]);
    __syncthreads();
    float y0 = 0.f, y1 = 0.f;
    for (int k = 0; k < 4; ++k) {
        const u32x2 rw = RT[(size_t)tok * 4 + k]; const int e = (int)rw.x; const float g = __uint_as_float(rw.y);
        const float* W1 = w1 + (size_t)e * 1024 * 2048; const float* W2 = w2 + (size_t)e * 1024 * 1024;
        float h0 = b1[e * 2048 + tid], h1 = b1[e * 2048 + tid + 512], h2 = b1[e * 2048 + tid + 1024], h3 = b1[e * 2048 + tid + 1536];
        for (int c = 0; c < 1024; ++c) { const float uu = u2[c]; const float* wr = W1 + (size_t)c * 2048 + tid; h0 += uu * wr[0]; h1 += uu * wr[512]; h2 += uu * wr[1024]; h3 += uu * wr[1536]; }
        __syncthreads();
        { float gg = fminf(h0, 7.f), up = fminf(fmaxf(h2, -7.f), 7.f); act[tid] = (up + 1.f) * gg / (1.f + expf(-1.702f * gg));
          gg = fminf(h1, 7.f); up = fminf(fmaxf(h3, -7.f), 7.f); act[tid + 512] = (up + 1.f) * gg / (1.f + expf(-1.702f * gg)); }
        __syncthreads();
        float a0 = b2[e * 1024 + tid], a1 = b2[e * 1024 + tid + 512];
        for (int j = 0; j < 1024; ++j) { const float aa = act[j]; a0 += aa * W2[(size_t)j * 1024 + tid]; a1 += aa * W2[(size_t)j * 1024 + tid + 512]; }
        y0 += g * a0; y1 += g * a1;
    }
    float f0 = 0.f, f1 = 0.f;
    for (int k = 0; k < 4; ++k) { f0 += bflo((unsigned)YB[((size_t)tokl * 4 + k) * 1024 + tid]); f1 += bflo((unsigned)YB[((size_t)tokl * 4 + k) * 1024 + tid + 512]); }
    const float rms = sqrtf(block_sum(F, y0 * y0 + y1 * y1, red) * (1.f / 1024.f)) + 1e-20f;
    float err = block_max(F, fmaxf(fabsf(y0 - f0), fabsf(y1 - f1)), red) / rms;
    { const float* X1 = (const float*)F.outb + (size_t)tok * 1024; const float* md = (const float*)(F.ws + WS_MOD) + (size_t)(tok >> 11) * 6144;
      const float xa = X1[tid], xb = X1[tid + 512]; const float mean = block_sum(F, xa + xb, red) * (1.f / 1024.f);
      const float da = xa - mean, db = xb - mean; const float var = block_sum(F, da * da + db * db, red) * (1.f / 1024.f); const float rstd = 1.f / sqrtf(var + LN_EPS);
      __syncthreads();
      u2[tid] = da * rstd * (1.f + md[4096 + tid]) + md[3072 + tid]; u2[tid + 512] = db * rstd * (1.f + md[4096 + tid + 512]) + md[3072 + tid + 512];
      __syncthreads();
      if (tid < 32) { float a = F.a->in[21][tid]; for (int c = 0; c < 1024; ++c) a += u2[c] * F.a->in[20][c * 32 + tid]; lg[tid] = a; }
      __syncthreads();
      if (tid == 0) { unsigned want = 0u, got = 0u; float l2[32]; for (int i = 0; i < 32; ++i) l2[i] = lg[i];
          for (int k = 0; k < 4; ++k) { int bi = 0; for (int i = 1; i < 32; ++i) if (l2[i] > l2[bi]) bi = i; want |= 1u << bi; l2[bi] = -INFINITY; got |= 1u << RT[(size_t)tok * 4 + k].x; }
          lg[32] = (want != got) ? 1.f : 0.f; }
      __syncthreads();
      if (lg[32] != 0.f) err = 50.f; }
    dbg_report(F, err);
}
__device__ __forceinline__ void dbg_check_ssd(Frame& F) {
    if (F.bid >= 2) return;
    const int b = F.bid ? 20 : 5, h = F.bid ? 14 : 3, g = h >> 2, tid = F.tid, p = tid >> 3, ng = tid & 7;
    LAS float* red = (LAS float*)F.lds; LAS float* cv = red + 16;
    const bf16_t* XBC = (const bf16_t*)(F.ws + WS_XBC); const bf16_t* ZS = (const bf16_t*)(F.ws + WS_Z); const float* DT = (const float*)(F.outb + OUT_DT); const bf16_t* YG = (const bf16_t*)(F.ws + WS_Q);
    const float* cw = F.a->in[9]; const float* cb = F.a->in[10]; const float aneg = -expf(F.a->in[12][h]), dsk = F.a->in[13][h];
    const int mych = tid < 64 ? h * 64 + tid : (tid < 192 ? 1024 + g * 128 + (tid - 64) : 1536 + g * 128 + (tid - 192));
    float w0 = 0.f, w1 = 0.f, w2 = 0.f, w3 = 0.f, wb = 0.f;
    if (tid < 320) { w0 = cw[0 * 2048 + mych]; w1 = cw[1 * 2048 + mych]; w2 = cw[2 * 2048 + mych]; w3 = cw[3 * 2048 + mych]; wb = cb[mych]; }
    float x0 = 0.f, x1 = 0.f, x2 = 0.f;
    float hs[16];
#pragma unroll
    for (int i = 0; i < 16; ++i) hs[i] = 0.f;
    float emax = 0.f, ssq = 0.f, nbad = 0.f; int tmax = 0;
    for (int t = 0; t < SEQ; ++t) {
        const size_t tok = (size_t)b * SEQ + t;
        __syncthreads();
        if (DBG_HYP == 1 && (t & 63) == 0) { x0 = 0.f; x1 = 0.f; x2 = 0.f; }
        if (tid < 320) { const float x3 = bflo((unsigned)XBC[tok * 2048 + mych]); const float s = wb + w0 * x0 + w1 * x1 + w2 * x2 + w3 * x3; cv[tid] = s / (1.f + expf(-s)); x0 = x1; x1 = x2; x2 = x3; }
        __syncthreads();
        const float xv = cv[p], dt = DT[tok * 16 + h], dec = expf(dt * aneg);
        float yp = 0.f;
#pragma unroll
        for (int i = 0; i < 16; ++i) { const int n = ng * 16 + i; hs[i] = hs[i] * dec + dt * xv * cv[64 + n]; yp += cv[192 + n] * hs[i]; }
        yp += __shfl_xor(yp, 1); yp += __shfl_xor(yp, 2); yp += __shfl_xor(yp, 4);
        const float yv = (yp + xv * dsk) * bflo((unsigned)ZS[tok * 1024 + h * 64 + p]);
        const float yf = bflo((unsigned)YG[tok * 1024 + h * 64 + p]);
        if (ng == 0) { const float er = fabsf(yv - yf); if (er > emax) { emax = er; tmax = t; } ssq += yv * yv; if (er > 0.25f && (DBG_SUB < 5 || (DBG_SUB == 5 && (t & 63) == 0) || (DBG_SUB == 6 && (t & 63) == 1) || (DBG_SUB == 7 && (t & 63) == 32))) nbad += 1.f; }
    }
    const float rms = sqrtf(block_sum(F, ssq, red) / (64.f * SEQ)) + 1e-20f;
    const float M = block_max(F, emax, red);
    if (DBG_SUB == 0) dbg_report(F, M / rms);
    else if (DBG_SUB == 1) dbg_report(F, block_sum(F, nbad, red) / (64.f * SEQ));
    else if (DBG_SUB >= 5) dbg_report(F, block_sum(F, nbad, red) / (64.f * 32.f));
    else { __syncthreads(); if (ng == 0 && emax == M) red[12] = (float)(DBG_SUB == 2 ? ((tmax & 63) >> 1) : (DBG_SUB == 3 ? (tmax >> 6) : (p >> 1))); __syncthreads();
        if (F.bid == 0) dbg_report(F, powf(10.f, 2.f * (0.05f + 0.05f * red[12]) - 4.f)); }
}
__device__ __forceinline__ void dbg_check_attn(Frame& F) {
    if (F.bid >= 32) return;
    const int b = (F.bid * 7 + 3) & 31, pos = 300 + F.bid * 53, nadm = ((pos >> 6) + 1) * 64, tid = F.tid, lane = F.lane, hd = F.wave;
    const size_t tq = (size_t)b * SEQ + pos;
    LAS float* sc = (LAS float*)F.lds; LAS unsigned char* sel = (LAS unsigned char*)(sc + 2048); LAS float* lgt = (LAS float*)(sel + 2048); LAS float* red = lgt + 8 * 2048; LAS float* misc = red + 16;
    const bf16_t* IQ = (const bf16_t*)(F.outb + OUT_IQ); const bf16_t* IK = (const bf16_t*)(F.outb + OUT_IK); const float* IW = (const float*)(F.outb + OUT_IW);
    const bf16_t* Q = (const bf16_t*)(F.ws + WS_Q); const bf16_t* KV = (const bf16_t*)(F.outb + OUT_KV); const bf16_t* OA = (const bf16_t*)(F.outb + OUT_OA); const u64* MASK = (const u64*)(F.outb + OUT_MASK);
    __syncthreads();
    for (int k = tid; k < nadm; k += NTHR) { float s = 0.f;
        for (int hh = 0; hh < 8; ++hh) { float d = 0.f; for (int c = 0; c < 64; ++c) d += bflo((unsigned)IQ[tq * 512 + hh * 64 + c]) * bflo((unsigned)IK[((size_t)b * SEQ + k) * 64 + c]); s += fmaxf(d, 0.f) * IW[tq * 8 + hh]; }
        sc[k] = s + 0.0f; }
    __syncthreads();
    float nbad = 0.f;
    for (int k = tid; k < nadm; k += NTHR) { const float s = sc[k]; int rank = 0; for (int j = 0; j < nadm; ++j) { const float t = sc[j]; rank += (t > s || (t == s && j < k)) ? 1 : 0; }
        const unsigned char se = rank < 256 ? 1 : 0; sel[k] = se; const unsigned mb = (unsigned)((MASK[tq * 32 + (k >> 6)] >> (k & 63)) & 1ull); if (mb != se) nbad += 1.f; }
    __syncthreads();
    const float nbad_t = block_sum(F, nbad, red);
    LAS float* lw = lgt + hd * 2048; float mx = -INFINITY;
    for (int k = lane; k < nadm; k += 64) { float l = -INFINITY;
        if (sel[k]) { float d = 0.f; for (int c = 0; c < 128; ++c) d += bflo((unsigned)Q[tq * 1024 + hd * 128 + c]) * bflo((unsigned)KV[((size_t)b * SEQ + k) * 128 + c]);
            const int rel = k - pos, n = rel < 0 ? -rel : rel; const float nf = (float)(n > 1 ? n : 1); int large = 8 + (int)(logf(nf / 8.0f) / 2.7725887f * 8.0f); if (large > 15) large = 15;
            const int bucket = (rel > 0 ? 16 : 0) + (n < 8 ? n : large);
            l = d * 0.088388347648318440f + F.a->in[8][bucket * 8 + hd]; }
        lw[k] = l; mx = fmaxf(mx, l); }
#pragma unroll
    for (int o = 1; o < 64; o <<= 1) mx = fmaxf(mx, __shfl_xor(mx, o));
    float den = 0.f;
    for (int k = lane; k < nadm; k += 64) { const float pp = expf(lw[k] - mx); lw[k] = pp; den += pp; }
    den = wave_sum(den);
    float emax = 0.f, ssq = 0.f;
    for (int c2 = 0; c2 < 2; ++c2) { const int c = lane + 64 * c2; float o = 0.f; for (int k = 0; k < nadm; ++k) { const float pp = lw[k]; if (pp != 0.f) o += pp * bflo((unsigned)KV[((size_t)b * SEQ + k) * 128 + c]); }
        o /= den; const float of = bflo((unsigned)OA[tq * 1024 + hd * 128 + c]); emax = fmaxf(emax, fabsf(o - of)); ssq += o * o; }
    const float rms = sqrtf(block_sum(F, ssq, red) * (1.f / 1024.f)) + 1e-20f;
    float err = block_max(F, emax, red) / rms;
    (void)misc;
    if (nbad_t > 0.f) err = 10.f + nbad_t;
    dbg_report(F, err);
}
__device__ __forceinline__ void dbg_emit(Frame& F) {
    float* out = (float*)F.outb;
    for (size_t i = (size_t)F.bid * NTHR + F.tid; i < (size_t)NTOK * D / 4; i += (size_t)F.G * NTHR) ((f32x4*)out)[i] = (f32x4){0.f, 0.f, 0.f, 0.f};
    __syncthreads();
    if (F.bid == 0 && F.tid == 0) { const float e = __uint_as_float(__hip_atomic_load((unsigned*)(F.ws + WS_CTL) + CW_DBG, __ATOMIC_RELAXED, __HIP_MEMORY_SCOPE_AGENT));
        float code = (log10f(fmaxf(e, 1e-30f)) + 4.f) * 0.5f; code = fminf(fmaxf(rintf(code * 20.f) * 0.05f, 0.05f), 3.0f);
        out[0] = sqrtf(67108864.f * 1.01f * (powf(10.f, code) - 1.f)); }
}

#define CLK_BEGIN(k) unsigned long long clk_c##k = 0, clk_r##k = 0; if (DBG_CLOCK == (k) + 1) { clk_c##k = __builtin_amdgcn_s_memtime(); clk_r##k = __builtin_amdgcn_s_memrealtime(); }
#define CLK_END(k) if (DBG_CLOCK == (k) + 1 && F.bid == 0) { const float ghz = (float)(__builtin_amdgcn_s_memtime() - clk_c##k) / (float)(__builtin_amdgcn_s_memrealtime() - clk_r##k) * 0.1f; dbg_report(F, powf(10.f, 2.f * (rintf(ghz * 5.f) * 0.2f) - 4.f)); }
constexpr int NPHASE = 17;
__global__ void __launch_bounds__(NTHR, 2) fwd(Args args) {
    extern __shared__ __attribute__((aligned(16))) unsigned char lds_raw[];
    Frame F;
    F.lds = (LAS unsigned char*)lds_raw;
    F.tid = threadIdx.x; F.lane = F.tid & 63; F.wave = __builtin_amdgcn_readfirstlane(F.tid >> 6); F.G = gridDim.x; F.bid = blockIdx.x;
    F.a = &args;
    F.ws = args.ws; F.outb = (unsigned char*)args.out;
    volatile LAS unsigned* MISCW = (volatile LAS unsigned*)(F.lds + LDS_MISC);
    if (F.tid < 64) MISCW[F.tid] = 0u;
    __syncthreads();
    XcdBarrier bar; bar.bar = (unsigned*)(F.ws + WS_CTL) + CW_BAR; bar.x = 0; bar.st = nullptr;
#if MK_ONE
    bar = xcd_barrier_post((unsigned*)(F.ws + WS_CTL) + CW_BAR, MISCW + 8);
#define GRID_BAR() xcd_barrier(bar)
#else
#define GRID_BAR() do { } while (0)
#endif
    const int lo = args.ph_lo, hi = args.ph_hi;
#ifndef PHM
#define PHM (0xFFFFFFFFu & ~(DBG_NO_ATTN ? 0x30u : 0u) & ~(DBG_NO_SSD ? 0xC0u : 0u))
#endif
#define IN(k) (((PHM >> (k)) & 1u) && lo <= (k) && (k) < hi)
#define SEAM(k) do { if ((k) + 1 < hi) GRID_BAR(); } while (0)

    if (IN(0)) {
#pragma nounroll
        for (int rep = 0; rep < ((DBG_TWICE & 1u) ? 2 : 1); ++rep) { if (rep) GRID_BAR(); ph_prologue(F); }
        SEAM(0); }
    if (IN(1)) {
#pragma nounroll
        for (int rep = 0; rep < ((DBG_TWICE & 2u) ? 2 : 1); ++rep) { if (rep) GRID_BAR(); ph_ln1(F); }
        SEAM(1); }
    CLK_BEGIN(2);
    if (IN(2)) {
        EpiProj E{(bf16_t*)(F.ws + WS_Q), (bf16_t*)(F.outb + OUT_IQ), (bf16_t*)(F.ws + WS_Z), (bf16_t*)(F.ws + WS_XBC), (bf16_t*)(F.ws + WS_GA), (bf16_t*)(F.ws + WS_GB), (float*)(F.outb + OUT_MISC), 1.0f};
#if PROJ_FP8
        { SchedProj<2> S; S.o.init(NTOK, 12 * 256, F.G, F.bid); S.A = (const char*)(F.ws + WS_U8); S.Bt = (const char*)(F.ws + WS_WIN8);
          EpiProj E8 = E; E8.sc = MOE_INV;
          pg8::gemm_phase<EpiProj, SchedProj<2>, false, 512, true>(F.lds, S, E8);
          if (DBG_TWICE & 32768u) { GRID_BAR(); pg8::gemm_phase<EpiProj, SchedProj<2>, false, 512, true>(F.lds, S, E8); } }
        { SchedProj<1> S; S.o.init(NTOK, 15 * 256, F.G, F.bid); S.A = (const char*)(F.outb + OUT_U); S.Bt = (const char*)(F.ws + WS_WIN); if (DBG_KCLK) S.dbgw = (unsigned*)(F.ws + WS_CTL) + CW_DBG;
#if DBG_DRYPROJ
#pragma nounroll
          for (int rep = 0; rep < 2; ++rep) { EpiProj Ed = E; Ed.dry = rep == 0; SchedProj<1> Sd = S; Sd.fold = rep == 0 ? 7 : 0x7fffffff; pg8::gemm_phase<EpiProj, SchedProj<1>, false>(F.lds, Sd, Ed); if (rep == 0) GRID_BAR(); }
#else
          const unsigned long long w0 = DBG_WALL ? __builtin_amdgcn_s_memrealtime() : 0ull;
          pg8::gemm_phase<EpiProj, SchedProj<1>, false>(F.lds, S, E);
          if (DBG_WALL && F.bid == 0) { const float us = (float)(__builtin_amdgcn_s_memrealtime() - w0) * 0.01f; dbg_report(F, powf(10.f, 2.f * (rintf(us / 300.f * 10.f) * 0.1f) - 4.f)); }
#endif
          if (DBG_TWICE & 4u) { GRID_BAR(); pg8::gemm_phase<EpiProj, SchedProj<1>, false>(F.lds, S, E); } }
#else
        { SchedProj<0> S; S.o.init(NTOK, NPROJ, F.G, F.bid); S.A = (const char*)(F.outb + OUT_U); S.Bt = (const char*)(F.ws + WS_WIN);
          pg8::gemm_phase<EpiProj, SchedProj<0>, false>(F.lds, S, E);
          if (DBG_TWICE & 4u) { GRID_BAR(); pg8::gemm_phase<EpiProj, SchedProj<0>, false>(F.lds, S, E); } }
#endif
        SEAM(2);
    }
    CLK_END(2);
    if (IN(3)) { ph_misc(F); if (DBG_TWICE & 8u) { GRID_BAR(); ph_misc(F); } SEAM(3); }
    if (IN(4)) { ph_index(F); if (DBG_TWICE & 16u) { GRID_BAR(); ph_index(F); } SEAM(4); }
    if (IN(5)) { ph_attn(F); if (DBG_TWICE & 32u) { GRID_BAR(); ph_attn(F); } SEAM(5); if (DBG_CHECK == 3) { dbg_check_attn(F); GRID_BAR(); } }
    if (IN(6)) {
#pragma nounroll
        for (int rep = 0; rep < DBG_REP6; ++rep) { if (rep) GRID_BAR(); ph_ssd2(F, rep + 1 < DBG_REP6 ? DBG_ABL6 : 0); }
        SEAM(6); if (DBG_CHECK == 2) { dbg_check_ssd(F); GRID_BAR(); } }
    if (IN(7)) { ph_gnorm(F); if (DBG_TWICE & 128u) { GRID_BAR(); ph_gnorm(F); } SEAM(7); }
    if (IN(8)) {
#if PA_FP8
        SchedPlainT<1024> S; S.o.init(NTOK, 1024, F.G, F.bid); S.A = (const char*)(F.outb + OUT_OA); S.Bt = (const char*)(F.ws + WS_WPA8);
        EpiGate<0> E{(const bf16_t*)(F.ws + WS_GA), nullptr, (bf16_t*)(F.ws + WS_Z), MOE_INV};
        pg8::gemm_phase<EpiGate<0>, SchedPlainT<1024>, false, 512, true>(F.lds, S, E);
#else
        SchedPlain S; S.o.init(NTOK, 1024, F.G, F.bid); S.A = (const char*)(F.outb + OUT_OA); S.Bt = (const char*)(F.ws + WS_WPA);
        EpiGate<0> E{(const bf16_t*)(F.ws + WS_GA), nullptr, (bf16_t*)(F.ws + WS_Z), 1.0f};
        pg8::gemm_phase<EpiGate<0>, SchedPlain, false>(F.lds, S, E);
#endif
    }
    if (IN(9)) {
#if PB_FP8
        SchedPlainT<1024> S; S.o.init(NTOK, 1024, F.G, F.bid); S.A = (const char*)(F.outb + OUT_OB8); S.Bt = (const char*)(F.ws + WS_WPB8);
        EpiGate<1> E{(const bf16_t*)(F.ws + WS_GB), (const bf16_t*)(F.ws + WS_Z), (bf16_t*)(F.ws + WS_XBC), MOE_INV};
        pg8::gemm_phase<EpiGate<1>, SchedPlainT<1024>, false, 512, true>(F.lds, S, E);
#else
        SchedPlain S; S.o.init(NTOK, 1024, F.G, F.bid); S.A = (const char*)(F.ws + WS_Q); S.Bt = (const char*)(F.ws + WS_WPB);
        EpiGate<1> E{(const bf16_t*)(F.ws + WS_GB), (const bf16_t*)(F.ws + WS_Z), (bf16_t*)(F.ws + WS_XBC), 1.0f};
        pg8::gemm_phase<EpiGate<1>, SchedPlain, false>(F.lds, S, E);
#endif
        SEAM(9);
    }
    if (IN(10)) {
        SchedPlain S; S.o.init(NTOK, 1024, F.G, F.bid); S.A = (const char*)(F.ws + WS_XBC); S.Bt = (const char*)(F.ws + WS_WOUT);
        EpiOut E{F.a->in[0], (const float*)(F.ws + WS_MOD), (float*)F.outb};
        pg8::gemm_phase<EpiOut, SchedPlain, false>(F.lds, S, E);
        if (DBG_TWICE & 1024u) { GRID_BAR(); pg8::gemm_phase<EpiOut, SchedPlain, false>(F.lds, S, E); }
        SEAM(10);
    }
    if (IN(11)) { if (DBG_TWICE & 2048u) { ph_router<true>(F); GRID_BAR(); } ph_router<false>(F); SEAM(11); }
#pragma unroll
    for (int hf = 0; hf < 2; ++hf) {
        const int p0 = 12 + hf * 2;
        if (IN(p0)) {
            if (hf == 1) ph_final<false>(F, 0);
            MoeTab T = moe_tables(F, hf);
            SchedMoe<8, true> S{T, F.G, F.bid, hf, (const char*)(F.ws + WS_U2), (const char*)(F.ws + WS_W1), (const u32x2*)(F.ws + WS_REG)};
            EpiMoe1 E{F.a->in[23], (bf16_t*)(F.ws + WS_ACT), 0};
            pg8::gemm_phase<EpiMoe1, SchedMoe<8, true>, true, MOE_RB / 2, MOE_FP8 != 0>(F.lds, S, E);
            if ((DBG_TWICE & 4096u) && hf == 0) { GRID_BAR(); pg8::gemm_phase<EpiMoe1, SchedMoe<8, true>, true, MOE_RB / 2, MOE_FP8 != 0>(F.lds, S, E); }
            if ((DBG_TWICE & 16384u) && hf == 0) { GRID_BAR(); EpiMoe1 Ed = E; Ed.dry = 1; pg8::gemm_phase<EpiMoe1, SchedMoe<8, true>, true, MOE_RB / 2, MOE_FP8 != 0>(F.lds, S, Ed); }
            SEAM(p0);
        }
        if (IN(p0 + 1)) {
            MoeTab T = moe_tables(F, hf);
            SchedMoe<4, false> S{T, F.G, F.bid, hf, (const char*)(F.ws + WS_ACT), (const char*)(F.ws + WS_W2), (const u32x2*)(F.ws + WS_REG)};
            EpiMoe2 E{F.a->in[25], (bf16_t*)(F.ws + WS_YB), (const u32x2*)(F.ws + WS_REG), T, hf, 0};
            if ((DBG_TWICE & 262144u) && hf == 0) { EpiMoe2 Ed = E; Ed.dry = DBG_DRYMODE; pg8::gemm_phase<EpiMoe2, SchedMoe<4, false>, false, MOE_RB / 2, MOE_FP8 != 0>(F.lds, S, Ed); GRID_BAR(); }
            pg8::gemm_phase<EpiMoe2, SchedMoe<4, false>, false, MOE_RB / 2, MOE_FP8 != 0>(F.lds, S, E);
            if ((DBG_TWICE & 8192u) && hf == 0) { GRID_BAR(); pg8::gemm_phase<EpiMoe2, SchedMoe<4, false>, false, MOE_RB / 2, MOE_FP8 != 0>(F.lds, S, E); }
            if ((DBG_TWICE & 131072u) && hf == 0) { GRID_BAR(); EpiMoe2 Ed = E; Ed.dry = 1; pg8::gemm_phase<EpiMoe2, SchedMoe<4, false>, false, MOE_RB / 2, MOE_FP8 != 0>(F.lds, S, Ed); }
            SEAM(p0 + 1);
            if (DBG_CHECK == 1 && hf == 1) { dbg_check_moe(F); GRID_BAR(); }
        }
    }
    if (IN(16)) { if (DBG_TWICE & 65536u) { ph_final<true>(F, 1); GRID_BAR(); } ph_final(F, 1); }
    if (DBG_CHECK || DBG_CLOCK || DBG_KCLK || DBG_WALL) { GRID_BAR(); dbg_emit(F); }
#undef IN
#undef SEAM
}

extern "C" void kernel_launch(void* const* d_in, const int* in_sizes, int n_in, void* d_out, int out_size, void* d_ws, size_t ws_size, hipStream_t stream) {
    static int grid = 0;
    if (grid == 0) {
        if (n_in != 28 || in_sizes[0] != NTOK * D || out_size != NTOK * D || ws_size < WS_END) { fprintf(stderr, "kernel_launch: shape mismatch (n_in %d, in0 %d, out %d, ws %zu)\n", n_in, n_in > 0 ? in_sizes[0] : -1, out_size, ws_size); grid = -1; return; }
        int dev = 0, cus = 0, per_cu = 0;
        if (hipGetDevice(&dev) != hipSuccess || hipDeviceGetAttribute(&cus, hipDeviceAttributeMultiprocessorCount, dev) != hipSuccess) { grid = -1; return; }
        if (hipFuncSetAttribute((const void*)fwd, hipFuncAttributeMaxDynamicSharedMemorySize, LDS_BYTES) != hipSuccess) { fprintf(stderr, "kernel_launch: hipFuncSetAttribute failed\n"); grid = -1; return; }
        if (hipOccupancyMaxActiveBlocksPerMultiprocessor(&per_cu, (const void*)fwd, NTHR, LDS_BYTES) != hipSuccess || per_cu < 1) fprintf(stderr, "kernel_launch: occupancy query reports %d\n", per_cu);
        (void)hipGetLastError();
        grid = cus;
    }
    if (grid < 0) return;
    if (hipMemsetAsync((char*)d_ws + WS_CTL, 0, CTL_ZERO_BYTES, stream) != hipSuccess) { fprintf(stderr, "kernel_launch: memset failed\n"); return; }
    Args a{};
    for (int i = 0; i < 28; ++i) a.in[i] = (const float*)d_in[i];
    a.out = (float*)d_out; a.ws = (unsigned char*)d_ws;
    const int nph = NPHASE < MK_PH_HI ? NPHASE : MK_PH_HI;
#if MK_ONE
    a.ph_lo = 0; a.ph_hi = nph;
    hipLaunchKernelGGL(fwd, dim3(grid), dim3(NTHR), LDS_BYTES, stream, a);
#else
    for (int p = 0; p < nph; ++p) { a.ph_lo = p; a.ph_hi = p + 1; hipLaunchKernelGGL(fwd, dim3(grid), dim3(NTHR), LDS_BYTES, stream, a); }
#endif
    const hipError_t le = hipPeekAtLastError();
    if (le != hipSuccess) fprintf(stderr, "kernel_launch: launch failed: %s\n", hipGetErrorName(le));
}
```

```cpp
#include <hip/hip_runtime.h>
#include <cstdio>
#include <cstdint>

#ifndef MK_ONE
#define MK_ONE 1
#endif
#ifndef DBG_NO_ATTN
#define DBG_NO_ATTN 0
#endif
#ifndef DBG_ATTN_ZERO
#define DBG_ATTN_ZERO 0
#endif
#ifndef DBG_IQ_TRUNC
#define DBG_IQ_TRUNC 0
#endif
#ifndef DBG_ROUTER_BF16
#define DBG_ROUTER_BF16 0
#endif
#ifndef DBG_CHECK
#define DBG_CHECK 0
#endif
#ifndef DBG_SKIP_BODY
#define DBG_SKIP_BODY 0
#endif
#ifndef DBG_SUB
#define DBG_SUB 0
#endif
#ifndef DBG_SSD_SYNC
#define DBG_SSD_SYNC 0
#endif
#ifndef DBG_HYP
#define DBG_HYP 0
#endif
#ifndef DBG_TWICE
#define DBG_DRYPROJ 0
#define DBG_ABL6 0
#define DBG_ABL4 0
#define DBG_REP4 1
#define DBG_REP6 1
#define DBG_WALL 0
#define DBG_KCLK 0
#ifndef DBG_CLOCK
#define DBG_CLOCK 0
#endif
#define DBG_TWICE 0u
#endif
#ifndef DBG_DRYMODE
#define DBG_DRYMODE 2
#endif
#ifndef DBG_NO_SSD
#define DBG_NO_SSD 0
#endif
#ifndef DBG_NO_MOE
#define DBG_NO_MOE 0
#endif
#ifndef MOE_FP8
#define MOE_FP8 1
#endif
#ifndef PROJ_FP8
#define PROJ_FP8 1
#endif
#ifndef PA_FP8
#define PA_FP8 1
#endif
#ifndef PB_FP8
#define PB_FP8 0
#endif
#ifndef ATT2
#define ATT_OT 1
#define ATT2 1
#endif
#ifndef MK_PH_HI
#define MK_PH_HI 99
#endif

#define LAS __attribute__((address_space(3)))
#define GAS __attribute__((address_space(1)))
typedef unsigned short bf16_t;
typedef short bf16x8 __attribute__((ext_vector_type(8)));
typedef short s16x4 __attribute__((ext_vector_type(4)));
typedef float f32x2 __attribute__((ext_vector_type(2)));
typedef float f32x4 __attribute__((ext_vector_type(4)));
typedef float f32x16 __attribute__((ext_vector_type(16)));
typedef unsigned u32x2 __attribute__((ext_vector_type(2)));
typedef unsigned u32x4 __attribute__((ext_vector_type(4)));
typedef unsigned long long u64;

constexpr int NB = 32, SEQ = 2048, D = 1024, NTOK = NB * SEQ;
constexpr int NWAVES = 8, NTHR = 512;
constexpr int NPROJ = 6912;
constexpr int NEXP = 32, HALF_TOK = NTOK / 2, REG_CAP = HALF_TOK;
constexpr int ACT_ROWS = HALF_TOK * 4 + NEXP * 256;
constexpr float LN_EPS = 1e-5f;
constexpr float DN_ALPHA = 1.189207115002721f;
constexpr float LOG2E = 1.4426950408889634f;

constexpr size_t MiB = 1u << 20;
constexpr size_t WS_CTL = 0, CTL_ZERO_BYTES = 1 * MiB;
constexpr size_t WS_MOD = 1 * MiB;
constexpr size_t WS_BIAST = 1 * MiB + 800 * 1024;
constexpr size_t WS_WIN = 2 * MiB;
constexpr size_t WS_WPA = 16 * MiB, WS_WPB = 18 * MiB, WS_WOUT = 20 * MiB;
constexpr size_t WS_W1 = 24 * MiB;
constexpr size_t WS_U8 = 88 * MiB;
constexpr size_t WS_W2 = 152 * MiB;
constexpr size_t WS_WIN8 = 184 * MiB;
constexpr size_t WS_WPA8 = 192 * MiB;
constexpr size_t WS_WPB8 = 194 * MiB;
constexpr size_t OUT_OB8 = 192 * MiB;
constexpr size_t WS_Q = 216 * MiB;
constexpr size_t WS_Z = 344 * MiB;
constexpr size_t WS_XBC = 472 * MiB;
constexpr size_t WS_GA = 728 * MiB, WS_GB = 856 * MiB;
constexpr size_t WS_U2 = 216 * MiB;
constexpr size_t WS_REG = 344 * MiB;
constexpr size_t WS_ACT = 360 * MiB;
constexpr size_t WS_YB = 632 * MiB;
constexpr size_t WS_X1B = 496 * MiB;
constexpr size_t WS_VB = 744 * MiB;
constexpr size_t WS_END = 984 * MiB;
constexpr size_t WS_DBG = 889 * MiB;
constexpr size_t OUT_U = 0, OUT_MISC = 128 * MiB, OUT_IQ = 192 * MiB;
constexpr size_t OUT_KV = 0, OUT_IK = 16 * MiB, OUT_IW = 24 * MiB, OUT_DT = 26 * MiB, OUT_MASK = 32 * MiB, OUT_OA = 64 * MiB;
constexpr int CW_BAR = 4096, CW_CNT = 16384, CW_WQ = 22528, CW_DBG = 24576;

constexpr int LDS_BYTES = 160 * 1024;
constexpr int LDS_AUX = 131072;
constexpr int LDS_MISC = LDS_BYTES - 256;

#define LDS_WAIT() asm volatile("s_waitcnt lgkmcnt(0)" ::: "memory")
#define GAS __attribute__((address_space(1)))
#define VM_WAIT() asm volatile("s_waitcnt vmcnt(0)" ::: "memory")
#define SBAR() __builtin_amdgcn_sched_barrier(0)
typedef __bf16 bf16x2_t __attribute__((ext_vector_type(2)));
__device__ __forceinline__ unsigned cvt_pk_bf16(float lo, float hi) { f32x2 f = {lo, hi}; bf16x2_t v = __builtin_convertvector(f, bf16x2_t); return __builtin_bit_cast(unsigned, v); }
__device__ __forceinline__ float bflo(unsigned w) { return __uint_as_float(w << 16); }
__device__ __forceinline__ float bfhi(unsigned w) { return __uint_as_float(w & 0xffff0000u); }
__device__ __forceinline__ u32x4 pack8(f32x4 a, f32x4 b) { u32x4 w; w.x = cvt_pk_bf16(a[0], a[1]); w.y = cvt_pk_bf16(a[2], a[3]); w.z = cvt_pk_bf16(b[0], b[1]); w.w = cvt_pk_bf16(b[2], b[3]); return w; }
constexpr int MOE_RB = MOE_FP8 ? 1024 : 2048;
constexpr float MOE_WSC = MOE_FP8 ? 64.0f : 1.0f, MOE_INV = 1.0f / MOE_WSC;
__device__ __forceinline__ u32x2 pack8_fp8(f32x4 a, f32x4 b) { int lo = 0, hi = 0;
    lo = __builtin_amdgcn_cvt_pk_fp8_f32(a[0], a[1], lo, false); lo = __builtin_amdgcn_cvt_pk_fp8_f32(a[2], a[3], lo, true);
    hi = __builtin_amdgcn_cvt_pk_fp8_f32(b[0], b[1], hi, false); hi = __builtin_amdgcn_cvt_pk_fp8_f32(b[2], b[3], hi, true);
    u32x2 r; r.x = (unsigned)lo; r.y = (unsigned)hi; return r; }
__device__ __forceinline__ void unpack8(u32x4 w, f32x4& a, f32x4& b) { a[0] = bflo(w.x); a[1] = bfhi(w.x); a[2] = bflo(w.y); a[3] = bfhi(w.y); b[0] = bflo(w.z); b[1] = bfhi(w.z); b[2] = bflo(w.w); b[3] = bfhi(w.w); }
__device__ __forceinline__ float dpp_scan_add(float v) {
#define DPPF(x, ctrl, rm) __builtin_bit_cast(float, __builtin_amdgcn_update_dpp(0, __builtin_bit_cast(int, (x)), (ctrl), (rm), 0xf, false))
    v += DPPF(v, 0x111, 0xf); v += DPPF(v, 0x112, 0xf); v += DPPF(v, 0x114, 0xf); v += DPPF(v, 0x118, 0xf);
    v += DPPF(v, 0x142, 0xa);
    v += DPPF(v, 0x143, 0xc);
#undef DPPF
    return v;
}
__device__ __forceinline__ unsigned dpp_half_sums_u32(unsigned v) {
#define DPPU(x, ctrl, rm) (unsigned)__builtin_amdgcn_update_dpp(0, (int)(x), (ctrl), (rm), 0xf, false)
    v += DPPU(v, 0x111, 0xf); v += DPPU(v, 0x112, 0xf); v += DPPU(v, 0x114, 0xf); v += DPPU(v, 0x118, 0xf); v += DPPU(v, 0x142, 0xa);
#undef DPPU
    return v;
}
__device__ __forceinline__ float dpp_half_sums_f32(float v) {
#define DPPF(x, ctrl, rm) __builtin_bit_cast(float, __builtin_amdgcn_update_dpp(0, __builtin_bit_cast(int, (x)), (ctrl), (rm), 0xf, false))
    v += DPPF(v, 0x111, 0xf); v += DPPF(v, 0x112, 0xf); v += DPPF(v, 0x114, 0xf); v += DPPF(v, 0x118, 0xf); v += DPPF(v, 0x142, 0xa);
#undef DPPF
    return v;
}
__device__ __forceinline__ float wave_sum(float v) { v = dpp_scan_add(v); return __builtin_bit_cast(float, __builtin_amdgcn_readlane(__builtin_bit_cast(int, v), 63)); }
__device__ __forceinline__ float fast_rcp(float x) { return __builtin_amdgcn_rcpf(x); }
__device__ __forceinline__ float sigmoid_f(float x) { return fast_rcp(1.0f + __expf(-x)); }
__device__ __forceinline__ float silu_f(float x) { return x * sigmoid_f(x); }

#define XB_TMO      128
#define XB_XCNT(j)  (256  + 64 * (j))
#define XB_XSUB(j)  (1280 + 64 * (j))
#define XB_XGEN(j)  (2304 + 64 * (j))
#define XB_TOP      3328
#define XB_TOPGEN   3392
#define XCD_BAR_WORDS 3456
#define XB_SPIN_CAP (1u << 18)
__device__ __forceinline__ unsigned xb_ld(unsigned* p)              { return __hip_atomic_load(p, __ATOMIC_RELAXED, __HIP_MEMORY_SCOPE_AGENT); }
__device__ __forceinline__ unsigned xb_add(unsigned* p, unsigned v) { return __hip_atomic_fetch_add(p, v, __ATOMIC_RELAXED, __HIP_MEMORY_SCOPE_AGENT); }
__device__ __forceinline__ unsigned xb_xcc_id() { return (unsigned)__builtin_amdgcn_s_getreg((3 << 11) | 20) & 0xFu; }
#define XB_SPIN(cond, bar) do { unsigned _sp = 0; while (cond) { __builtin_amdgcn_s_sleep(1); \
    if ((++_sp & 255u) == 0u) { if (xb_ld(&(bar)[XB_TMO])) break; if (_sp > XB_SPIN_CAP) { atomicAdd(&(bar)[XB_TMO], 1u); break; } } } } while (0)
struct XcdBarrier { unsigned* bar; unsigned x; volatile LAS unsigned* st; };
__device__ __forceinline__ XcdBarrier xcd_barrier_post(unsigned* bar, volatile LAS unsigned* st) {
    XcdBarrier b; b.bar = bar; b.x = xb_xcc_id(); b.st = st;
    if (threadIdx.x == 0) (void)xb_add(&bar[XB_XCNT(b.x)], 1u);
    return b;
}
__device__ __forceinline__ void xcd_barrier_complete(unsigned* bar, unsigned x, unsigned& nloc, unsigned& nx) {
    const unsigned G = gridDim.x * gridDim.y * gridDim.z;
    unsigned sum, cnt, mine, sp = 0u;
    for (;;) {
        sum = 0u; cnt = 0u;
#pragma nounroll
        for (unsigned j = 0; j < 16; ++j) { const unsigned c = xb_ld(&bar[XB_XCNT(j)]); sum += c; cnt += (c > 0u) ? 1u : 0u; }
        if (sum == G) break;
        __builtin_amdgcn_s_sleep(1);
        if ((++sp & 255u) == 0u) { if (xb_ld(&bar[XB_TMO])) break; if (sp > XB_SPIN_CAP) { atomicAdd(&bar[XB_TMO], 1u); break; } }
    }
    mine = xb_ld(&bar[XB_XCNT(x)]);
    nloc = mine > 0u ? mine : 1u; nx = cnt > 0u ? cnt : 1u;
}
__device__ __forceinline__ void xcd_barrier(const XcdBarrier& b) {
    asm volatile("s_waitcnt vmcnt(0)" ::: "memory");
    __syncthreads();
    if (threadIdx.x == 0) {
        unsigned* bar = b.bar;
        __builtin_amdgcn_s_waitcnt(0);
        unsigned nloc = b.st[0], nx = b.st[1];
        if (nloc == 0u) { xcd_barrier_complete(bar, b.x, nloc, nx); b.st[0] = nloc; b.st[1] = nx; }
        const unsigned old = xb_add(&bar[XB_XSUB(b.x)], 1u);
        const unsigned gen = old / nloc;
        if (old + 1u == (gen + 1u) * nloc) {
            __builtin_amdgcn_fence(__ATOMIC_RELEASE, "agent");
            asm volatile("s_waitcnt vmcnt(0)" ::: "memory");
            const unsigned og = xb_add(&bar[XB_TOP], 1u);
            const unsigned tg = og / nx;
            if (og + 1u == (tg + 1u) * nx) xb_add(&bar[XB_TOPGEN], 1u);
            else XB_SPIN(xb_ld(&bar[XB_TOPGEN]) == tg, bar);
            __builtin_amdgcn_fence(__ATOMIC_ACQUIRE, "agent");
            xb_add(&bar[XB_XGEN(b.x)], 1u);
            asm volatile("s_waitcnt vmcnt(0)" ::: "memory");
        } else {
            XB_SPIN(xb_ld(&bar[XB_XGEN(b.x)]) == gen, bar);
            __builtin_amdgcn_fence(__ATOMIC_ACQUIRE, "agent");
            asm volatile("s_waitcnt vmcnt(0)" ::: "memory");
        }
    }
    __syncthreads();
}

namespace pg8 {
constexpr int BM = 256, BK = 64, HALF = 128, HTB = HALF * BK * 2, STAGE_BYTES = 8 * HTB, NXCD = 8, WGM = 8, KD = 1024;
__host__ __device__ __forceinline__ int lds_byte(int r, int c) { const int st = (r >> 4) * 2 + (c >> 5), rr = r & 15, cc = c & 31, ob = rr * 64 + cc * 2; return st * 1024 + (ob ^ (((ob >> 9) & 1) << 5)); }
__host__ __device__ __forceinline__ void stage_rc(int b, int& R, int& C) { const int st = b / 1024, sb = b % 1024, swz = sb ^ (((sb >> 9) & 1) << 5); R = (st >> 1) * 16 + swz / 64; C = (st & 1) * 32 + (swz % 64) / 2; }
__host__ __device__ __forceinline__ int perm32(int rho) { const int n = rho >> 4, i = rho & 15; return 8 * (i >> 2) + 4 * n + (i & 3); }
struct Unit { int pm, pn, ex; };
struct StaticOrder {
    int nM, nN, nwg, G, c;
    __device__ void init(int M, int N, int G_, int c_) { nM = M / BM; nN = N / BM; nwg = nM * nN; G = G_; c = c_; }
    __device__ bool next(int i, Unit& u) const {
        const long L = (long)i * G + c; if (L >= nwg) return false;
        int wgid = (int)L; { const int q = nwg / NXCD, r = nwg % NXCD, xcd = wgid % NXCD, off = wgid / NXCD; wgid = (xcd < r ? xcd * (q + 1) : r * (q + 1) + (xcd - r) * q) + off; }
        const int nig = WGM * nN, gid = wgid / nig, fm = gid * WGM, gsz = (nM - fm) < WGM ? (nM - fm) : WGM;
        u.pm = fm + ((wgid % nig) % gsz); u.pn = (wgid % nig) / gsz; u.ex = 0; return true;
    }
};
typedef int i32x8 __attribute__((ext_vector_type(8)));
typedef int i32x4v __attribute__((ext_vector_type(4)));
template <class T> __device__ __forceinline__ auto dbgw_of(const T& s, int) -> decltype(s.dbgw) { return s.dbgw; }
template <class T> __device__ __forceinline__ unsigned* dbgw_of(const T&, long) { return nullptr; }
template <class Epi, class Sched, bool GATHER, int KE = 1024, bool FP8 = false>
__device__ __forceinline__ void gemm_phase(LAS unsigned char* lds, const Sched& S, const Epi& E) {
    int tid = threadIdx.x; asm volatile("" : "+v"(tid));
    const int wid = __builtin_amdgcn_readfirstlane(tid >> 6), lane = tid & 63, wr = wid >> 2, wc = wid & 3, fr = lane & 15, fq = lane >> 4;
    constexpr int K = KE, nt = K / BK;
    unsigned voffA[2], voffB[2]; int Rr[2], Cc[2];
#pragma unroll
    for (int i = 0; i < 2; ++i) { int R, C; stage_rc(tid * 16 + i * 8192, R, C); const int Rb = Epi::PERM ? ((R & ~31) + perm32(R & 31)) : R;
        voffA[i] = (unsigned)(R * K + C) * 2u; voffB[i] = (unsigned)(Rb * K + C) * 2u; Rr[i] = R; Cc[i] = C; }
    constexpr size_t kstep = (size_t)(BK * 2);
    constexpr size_t hstep = (size_t)HALF * K * 2;
    const unsigned ldsw = (unsigned)wid * 1024u;
    const int aoff = lds_byte(wr * 64 + fr, fq * 8), boff = lds_byte(wc * 32 + fr, fq * 8);
#define PG8_SA(b, h) (((b) * 2 + (h)) * HTB)
#define PG8_SB(b, h) ((4 + (b) * 2 + (h)) * HTB)
#define PG8_STAGE(bufoff, gbase, voff) do { _Pragma("unroll") for (int _i = 0; _i < 2; ++_i) \
        __builtin_amdgcn_global_load_lds((const unsigned*)((const char*)(gbase) + (voff)[_i]), (LAS unsigned*)(lds + (bufoff) + ldsw + _i * 8192), 16, 0, 0); } while (0)
#define PG8_STAGE_A(bufoff, gb, h, o0, o1) do { if constexpr (GATHER) { const unsigned _ko = (unsigned)((gb) - gA0); unsigned _o[2]; \
            if ((h) == 0) { _o[0] = (o0)[0] + _ko; _o[1] = (o0)[1] + _ko; } else { _o[0] = (o1)[0] + _ko; _o[1] = (o1)[1] + _ko; } PG8_STAGE(bufoff, gA0, _o); } \
        else { PG8_STAGE(bufoff, (gb) + (h) * hstep, voffA); } } while (0)
#define PG8_LD8(p) __builtin_shufflevector(*(const LAS i32x4v*)(p), *(const LAS i32x4v*)((p) + 1024), 0, 1, 2, 3, 4, 5, 6, 7)
#define PG8_LDA(dst, b, h) do { if constexpr (FP8) { _Pragma("unroll") for (int m = 0; m < 4; ++m) dst##8[m] = PG8_LD8(lds + PG8_SA(b, h) + aoff + m * 2048); } \
        else { _Pragma("unroll") for (int m = 0; m < 4; ++m) _Pragma("unroll") for (int k = 0; k < 2; ++k) dst[m][k] = *(const LAS bf16x8*)(lds + PG8_SA(b, h) + aoff + m * 2048 + k * 1024); } } while (0)
#define PG8_LDB(dst, b, h) do { if constexpr (FP8) { _Pragma("unroll") for (int n = 0; n < 2; ++n) dst##8[n] = PG8_LD8(lds + PG8_SB(b, h) + boff + n * 2048); } \
        else { _Pragma("unroll") for (int n = 0; n < 2; ++n) _Pragma("unroll") for (int k = 0; k < 2; ++k) dst[n][k] = *(const LAS bf16x8*)(lds + PG8_SB(b, h) + boff + n * 2048 + k * 1024); } } while (0)
#define PG8_MMA(ai, bj, At, Bt) do { __builtin_amdgcn_s_setprio(1); if constexpr (FP8) { _Pragma("unroll") for (int m = 0; m < 4; ++m) _Pragma("unroll") for (int n = 0; n < 2; ++n) \
            asm volatile("v_mfma_scale_f32_16x16x128_f8f6f4 %0, %1, %2, %0, %3, %3 op_sel_hi:[0,0,0]" : "+v"(acc[ai][bj][m][n]) : "v"(Bt##8[n]), "v"(At##8[m]), "v"(sc127)); } \
        else { _Pragma("unroll") for (int m = 0; m < 4; ++m) _Pragma("unroll") for (int n = 0; n < 2; ++n) _Pragma("unroll") for (int k = 0; k < 2; ++k) \
            acc[ai][bj][m][n] = __builtin_amdgcn_mfma_f32_16x16x32_bf16(Bt[n][k], At[m][k], acc[ai][bj][m][n], 0, 0, 0); } __builtin_amdgcn_s_setprio(0); } while (0)
#define PG8_WAIT_V(n) asm volatile("s_waitcnt vmcnt(" #n ")" ::: "memory")
#define PG8_WAIT_L(n) asm volatile("s_waitcnt lgkmcnt(" #n ")" ::: "memory")
#define PG8_BAR __builtin_amdgcn_s_barrier()
#define PG8_SCHED __builtin_amdgcn_sched_barrier(0)
    Unit cur, nxt; int ui = 0; unsigned long long kcsum = 0; int kcn = 0; const unsigned long long kph0 = (DBG_KCLK && !FP8 && !GATHER) ? __builtin_amdgcn_s_memtime() : 0ull;
    if (!S.next(0, cur)) return;
    f32x4 acc[2][2][4][2];
#pragma unroll
    for (int a = 0; a < 2; ++a)
#pragma unroll
        for (int b = 0; b < 2; ++b)
#pragma unroll
            for (int m = 0; m < 4; ++m)
#pragma unroll
                for (int n = 0; n < 2; ++n) acc[a][b][m][n] = (f32x4){0.f, 0.f, 0.f, 0.f};
    const int sc127 = 0x7f7f7f7f;
    bf16x8 At[4][2], B0[2][2], B1[2][2]; i32x8 At8[4], B08[2], B18[2];
    const char* cA = S.a_base(cur); const char* cB = S.b_base(cur);
    const char* const gA0 = cA;
    unsigned cv0[2] = {0u, 0u}, cv1[2] = {0u, 0u}, nv0[2] = {0u, 0u}, nv1[2] = {0u, 0u};
    if constexpr (GATHER) S.a_offs(cur, Rr, Cc, cv0, cv1);
    PG8_STAGE(PG8_SB(0, 0), cB, voffB); PG8_STAGE_A(PG8_SA(0, 0), cA, 0, cv0, cv1); PG8_STAGE(PG8_SB(0, 1), cB + hstep, voffB); PG8_STAGE_A(PG8_SA(0, 1), cA, 1, cv0, cv1);
    if (wr == 1) PG8_BAR;
    PG8_WAIT_V(4); PG8_BAR;
    PG8_STAGE(PG8_SB(1, 0), cB + kstep, voffB); PG8_STAGE_A(PG8_SA(1, 0), cA + kstep, 0, cv0, cv1); PG8_STAGE(PG8_SB(1, 1), cB + hstep + kstep, voffB);
    PG8_WAIT_V(6); PG8_BAR;
    for (;;) {
        const bool has_next = S.next(ui + 1, nxt);
        const char* nA = has_next ? S.a_base(nxt) : cA; const char* nB = has_next ? S.b_base(nxt) : cB;
        if constexpr (GATHER) { if (has_next) S.a_offs(nxt, Rr, Cc, nv0, nv1); else { nv0[0] = cv0[0]; nv0[1] = cv0[1]; nv1[0] = cv1[0]; nv1[1] = cv1[1]; } }
        unsigned long long kc0 = 0; if constexpr (DBG_KCLK && !FP8 && !GATHER) kc0 = __builtin_amdgcn_s_memtime();
#pragma nounroll
        for (int t = 0; t < nt; t += 2) {
            const bool last = (t == nt - 2);
            const char* a1 = cA + (size_t)(t + 1) * kstep;
            const char* a2 = last ? nA : cA + (size_t)(t + 2) * kstep; const char* b2 = last ? nB : cB + (size_t)(t + 2) * kstep;
            const char* a3 = a2 + kstep; const char* b3 = b2 + kstep;
            unsigned s0[2], s1[2];
            if constexpr (GATHER) { s0[0] = last ? nv0[0] : cv0[0]; s0[1] = last ? nv0[1] : cv0[1]; s1[0] = last ? nv1[0] : cv1[0]; s1[1] = last ? nv1[1] : cv1[1]; } else { s0[0] = s0[1] = s1[0] = s1[1] = 0u; }
            PG8_LDB(B0, 0, 0); PG8_SCHED; PG8_LDA(At, 0, 0); PG8_STAGE_A(PG8_SA(1, 1), a1, 1, cv0, cv1);
            PG8_WAIT_L(8); PG8_BAR; PG8_WAIT_L(0); PG8_MMA(0, 0, At, B0); PG8_BAR; PG8_SCHED;
            PG8_LDB(B1, 0, 1); PG8_STAGE(PG8_SB(0, 0), b2, voffB);
            PG8_BAR; PG8_WAIT_L(0); PG8_MMA(0, 1, At, B1); PG8_BAR;
            PG8_LDA(At, 0, 1); PG8_STAGE_A(PG8_SA(0, 0), a2, 0, s0, s1);
            PG8_BAR; PG8_WAIT_L(0); PG8_MMA(1, 0, At, B0); PG8_BAR; PG8_SCHED;
            PG8_STAGE(PG8_SB(0, 1), b2 + hstep, voffB);
            PG8_WAIT_V(6); PG8_BAR; PG8_MMA(1, 1, At, B1); PG8_BAR;
            PG8_LDB(B0, 1, 0); PG8_SCHED; PG8_LDA(At, 1, 0); PG8_STAGE_A(PG8_SA(0, 1), a2, 1, s0, s1);
            PG8_WAIT_L(8); PG8_BAR; PG8_WAIT_L(0); PG8_MMA(0, 0, At, B0); PG8_BAR; PG8_SCHED;
            PG8_LDB(B1, 1, 1); PG8_STAGE(PG8_SB(1, 0), b3, voffB);
            PG8_BAR; PG8_WAIT_L(0); PG8_MMA(0, 1, At, B1); PG8_BAR;
            PG8_LDA(At, 1, 1); PG8_STAGE_A(PG8_SA(1, 0), a3, 0, s0, s1);
            PG8_BAR; PG8_WAIT_L(0); PG8_MMA(1, 0, At, B0); PG8_BAR; PG8_SCHED;
            PG8_STAGE(PG8_SB(1, 1), b3 + hstep, voffB);
            PG8_WAIT_V(6); PG8_BAR; PG8_MMA(1, 1, At, B1); PG8_BAR;
        }
        if constexpr (DBG_KCLK && !FP8 && !GATHER) { kc0 = __builtin_amdgcn_s_memtime(); }
        if constexpr (FP8) asm volatile("s_nop 15\n\ts_nop 15" ::: "memory");
        E(acc, cur, wr, wc, fr, fq);
        if constexpr (DBG_KCLK && !FP8 && !GATHER) { asm volatile("s_waitcnt vmcnt(0)" ::: "memory"); kcsum += __builtin_amdgcn_s_memtime() - kc0; ++kcn; }
        if (!has_next) break;
#pragma unroll
        for (int a = 0; a < 2; ++a)
#pragma unroll
            for (int b = 0; b < 2; ++b)
#pragma unroll
                for (int m = 0; m < 4; ++m)
#pragma unroll
                    for (int n = 0; n < 2; ++n) acc[a][b][m][n] = (f32x4){0.f, 0.f, 0.f, 0.f};
        cur = nxt; cA = nA; cB = nB; ++ui;
        if constexpr (GATHER) { cv0[0] = nv0[0]; cv0[1] = nv0[1]; cv1[0] = nv1[0]; cv1[1] = nv1[1]; }
    }
    PG8_WAIT_V(0);
    if (wr == 0) PG8_BAR;
    PG8_BAR;
    if constexpr (DBG_KCLK && !FP8 && !GATHER) { unsigned* dw = dbgw_of(S, 0); if (dw && tid == 0) { kcsum = __builtin_amdgcn_s_memtime() - kph0; const float cpk = (float)kcsum / (float)(kcn) * (1.f / 40000.f); atomicMax(dw, __float_as_uint(powf(10.f, 2.f * (rintf(cpk * 10.f) * 0.1f) - 4.f))); } }
#undef PG8_SA
#undef PG8_SB
#undef PG8_STAGE
#undef PG8_STAGE_A
#undef PG8_LDA
#undef PG8_LDB
#undef PG8_MMA
#undef PG8_LD8
#undef PG8_WAIT_V
#undef PG8_WAIT_L
#undef PG8_BAR
#undef PG8_SCHED
}
}
using pg8::Unit;
typedef f32x4 AccT[2][2][4][2];

struct Args { const float* in[28]; float* out; unsigned char* ws; int ph_lo, ph_hi, pad0, pad1; };
struct Frame {
    LAS unsigned char* lds;
    int tid, lane, wave, G, bid;
    const struct Args* a;
    unsigned char* ws; unsigned char* outb;
};
template <int RB = 2048> struct SchedPlainT {
    pg8::StaticOrder o; const char* A; const char* Bt;
    __device__ __forceinline__ bool next(int i, Unit& u) const { return o.next(i, u); }
    __device__ __forceinline__ const char* a_base(const Unit& u) const { return A + (size_t)u.pm * (256 * RB); }
    __device__ __forceinline__ const char* b_base(const Unit& u) const { return Bt + (size_t)u.pn * (256 * RB); }
    __device__ __forceinline__ void a_offs(const Unit&, const int*, const int*, unsigned (&)[2], unsigned (&)[2]) const {}
};
typedef SchedPlainT<2048> SchedPlain;
template <int MODE> struct SchedProj {
    pg8::StaticOrder o; const char* A; const char* Bt; int fold = 0x7fffffff; unsigned* dbgw = nullptr;
    static constexpr int RB = MODE == 2 ? 1024 : 2048;
    __device__ __forceinline__ bool next(int i, Unit& u) const { if (!o.next(i, u)) return false; const int r = u.pn;
        if (MODE == 1) u.pn = 4 + r;
        if (MODE == 2) u.pn = r < 4 ? r : 15 + r;
        return true; }
    __device__ __forceinline__ const char* a_base(const Unit& u) const { return A + (size_t)(DBG_DRYPROJ ? (u.pm & fold) : u.pm) * (256 * RB); }
    __device__ __forceinline__ const char* b_base(const Unit& u) const { return Bt + (size_t)u.pn * (256 * RB); }
    __device__ __forceinline__ void a_offs(const Unit&, const int*, const int*, unsigned (&)[2], unsigned (&)[2]) const {}
};

struct EpiProj {
    static constexpr bool PERM = true;
    bf16_t *Q, *IQ, *Z, *XBC, *GA, *GB; float* MISC; float sc; int dry = 0;
    __device__ __forceinline__ void operator()(const AccT& acc, const Unit& u, int wr, int wc, int fr, int fq) const {
        const int pn = u.pn, row0 = u.pm * 256 + wr * 64 + fr, c8 = wc * 32 + 8 * fq;
        if (pn == 6) {
#pragma unroll
            for (int ai = 0; ai < 2; ++ai)
#pragma unroll
                for (int m = 0; m < 4; ++m) { float* rp = MISC + (size_t)(row0 + ai * 128 + m * 16) * 256 + c8;
#pragma unroll
                    for (int bj = 0; bj < 2; ++bj) { if (DBG_DRYPROJ && dry && acc[ai][bj][m][0][0] != 1.2345e-33f) continue; *(f32x4*)(rp + bj * 128) = acc[ai][bj][m][0]; *(f32x4*)(rp + bj * 128 + 4) = acc[ai][bj][m][1]; } }
            return;
        }
        bf16_t* base; int ldc, colt, act = 0;
        if (pn < 4) { base = Q; ldc = 1024; colt = pn * 256; }
        else if (pn < 6) { base = IQ; ldc = 512; colt = (pn - 4) * 256; }
        else if (pn < 11) { base = Z; ldc = 1024; colt = (pn - 7) * 256; act = 1; }
        else if (pn < 19) { base = XBC; ldc = 2048; colt = (pn - 11) * 256; }
        else if (pn < 23) { base = GA; ldc = 1024; colt = (pn - 19) * 256; act = 2; }
        else { base = GB; ldc = 1024; colt = (pn - 23) * 256; act = 2; }
#pragma unroll
        for (int ai = 0; ai < 2; ++ai)
#pragma unroll
            for (int m = 0; m < 4; ++m) { bf16_t* rp = base + (size_t)(row0 + ai * 128 + m * 16) * ldc + colt + c8;
#pragma unroll
                for (int bj = 0; bj < 2; ++bj) { f32x4 v0 = acc[ai][bj][m][0] * sc, v1 = acc[ai][bj][m][1] * sc;
                    if (act == 1) {
#pragma unroll
                        for (int j = 0; j < 4; ++j) { v0[j] = silu_f(v0[j]); v1[j] = silu_f(v1[j]); } }
                    if (act == 2) {
#pragma unroll
                        for (int j = 0; j < 4; ++j) { v0[j] = sigmoid_f(v0[j]); v1[j] = sigmoid_f(v1[j]); } }
                    u32x4 pk = pack8(v0, v1); if (DBG_IQ_TRUNC && (pn == 4 || pn == 5)) { pk.x &= 0xfff8fff8u; pk.y &= 0xfff8fff8u; pk.z &= 0xfff8fff8u; pk.w &= 0xfff8fff8u; }
                    if (DBG_DRYPROJ && dry && pk.x != 0x7fc17fc3u) continue;
                    *(u32x4*)(rp + bj * 128) = pk; } }
    }
};
template <int MODE> struct EpiGate {
    static constexpr bool PERM = true;
    const bf16_t* Gt; const bf16_t* T; bf16_t* O; float sc;
    __device__ __forceinline__ void operator()(const AccT& acc, const Unit& u, int wr, int wc, int fr, int fq) const {
        const int row0 = u.pm * 256 + wr * 64 + fr, c8 = u.pn * 256 + wc * 32 + 8 * fq;
#pragma unroll
        for (int ai = 0; ai < 2; ++ai) {
            u32x4 gq[4][2], tq[4][2];
#pragma unroll
            for (int m = 0; m < 4; ++m) { const size_t off = (size_t)(row0 + ai * 128 + m * 16) * 1024 + c8;
#pragma unroll
                for (int bj = 0; bj < 2; ++bj) { gq[m][bj] = *(const u32x4*)(Gt + off + bj * 128); if (MODE == 1) tq[m][bj] = *(const u32x4*)(T + off + bj * 128); } }
            SBAR();
#pragma unroll
            for (int m = 0; m < 4; ++m) { const size_t off = (size_t)(row0 + ai * 128 + m * 16) * 1024 + c8;
#pragma unroll
                for (int bj = 0; bj < 2; ++bj) { f32x4 g0, g1; unpack8(gq[m][bj], g0, g1);
                    f32x4 v0 = g0 * (acc[ai][bj][m][0] * sc), v1 = g1 * (acc[ai][bj][m][1] * sc);
                    if ((MODE == 0 && DBG_NO_ATTN) || (MODE == 1 && DBG_NO_SSD)) { v0 = (f32x4){0.f, 0.f, 0.f, 0.f}; v1 = v0; }
                    if (MODE == 1) { f32x4 t0, t1; unpack8(tq[m][bj], t0, t1); v0 += t0; v1 += t1; }
                    *(u32x4*)(O + off + bj * 128) = pack8(v0, v1); } }
            SBAR();
        }
    }
};
struct EpiOut {
    static constexpr bool PERM = true;
    const float* x; const float* mod; bf16_t* V;
    __device__ __forceinline__ void operator()(const AccT& acc, const Unit& u, int wr, int wc, int fr, int fq) const {
        const int row0 = u.pm * 256 + wr * 64 + fr, c8 = u.pn * 256 + wc * 32 + 8 * fq;
        const float* g1 = mod + (size_t)(u.pm >> 3) * 6144 + 2048 + c8;
        f32x4 gv[2][2];
#pragma unroll
        for (int bj = 0; bj < 2; ++bj)
#pragma unroll
            for (int n = 0; n < 2; ++n) gv[bj][n] = *(const f32x4*)(g1 + bj * 128 + n * 4);
#pragma unroll
        for (int ai = 0; ai < 2; ++ai)
#pragma unroll
            for (int mp = 0; mp < 2; ++mp) {
                f32x4 xv[2][2][2];
#pragma unroll
                for (int mm = 0; mm < 2; ++mm) { const size_t off = (size_t)(row0 + ai * 128 + (2 * mp + mm) * 16) * 1024 + c8;
#pragma unroll
                    for (int bj = 0; bj < 2; ++bj)
#pragma unroll
                        for (int n = 0; n < 2; ++n) xv[mm][bj][n] = *(const f32x4*)(x + off + bj * 128 + n * 4); }
                SBAR();
#pragma unroll
                for (int mm = 0; mm < 2; ++mm) { const int m = 2 * mp + mm; const size_t off = (size_t)(row0 + ai * 128 + m * 16) * 1024 + c8;
#pragma unroll
                    for (int bj = 0; bj < 2; ++bj)
                        *(u32x4*)(V + off + bj * 128) = pack8(xv[mm][bj][0] * DN_ALPHA + gv[bj][0] * acc[ai][bj][m][0], xv[mm][bj][1] * DN_ALPHA + gv[bj][1] * acc[ai][bj][m][1]); }
                SBAR();
            }
    }
};

struct MoeTab { LAS unsigned* cnt; LAS unsigned* tb; LAS unsigned char* te; int ntiles; };
__device__ __forceinline__ MoeTab moe_tables(Frame& F, int hf) {
    MoeTab T; T.cnt = (LAS unsigned*)(F.lds + LDS_AUX); T.tb = (LAS unsigned*)(F.lds + LDS_AUX + 256); T.te = (LAS unsigned char*)(F.lds + LDS_AUX + 512);
    const unsigned* CNT = (const unsigned*)(F.ws + WS_CTL) + CW_CNT;
    __syncthreads();
    if (F.tid < 32) { unsigned c = __hip_atomic_load(CNT + 64 * (hf * 32 + F.tid), __ATOMIC_RELAXED, __HIP_MEMORY_SCOPE_AGENT); if (c > (unsigned)REG_CAP) c = REG_CAP; T.cnt[F.tid] = c; }
    __syncthreads();
    if (F.tid == 0) { unsigned s = 0;
#pragma nounroll
        for (int e = 0; e < 32; ++e) { T.tb[e] = s; const unsigned n = (T.cnt[e] + 255u) >> 8;
#pragma nounroll
            for (unsigned t = 0; t < n; ++t) T.te[s + t] = (unsigned char)e;
            s += n; }
        T.tb[32] = s; }
    __syncthreads();
    T.ntiles = __builtin_amdgcn_readfirstlane((int)T.tb[32]);
    return T;
}
template <int NJ, bool GATHER> struct SchedMoe {
    MoeTab T; int G, c, hf; const char* A; const char* Bt; const u32x2* REG;
    __device__ __forceinline__ bool next(int i, Unit& u) const {
        int tile, j;
        if (G == 256) { const int x = c & 7, sl = c >> 3;
            tile = i * (256 / NJ) + x * (32 / NJ) + sl / NJ; j = sl % NJ;
            if (tile >= T.ntiles) return false; }
        else { const int L = i * G + c; if (L >= T.ntiles * NJ) return false; tile = L / NJ; j = L % NJ; }
        u.pm = tile; u.pn = j; u.ex = __builtin_amdgcn_readfirstlane((int)T.te[u.pm]); return true;
    }
    __device__ __forceinline__ const char* a_base(const Unit& u) const { return GATHER ? A : A + (size_t)u.pm * (256 * MOE_RB); }
    __device__ __forceinline__ const char* b_base(const Unit& u) const { return Bt + ((size_t)u.ex * (NJ * 256) + (size_t)u.pn * 256) * MOE_RB; }
    __device__ __forceinline__ void a_offs(const Unit& u, const int* R, const int* C, unsigned (&o0)[2], unsigned (&o1)[2]) const {
        const unsigned cnt = __builtin_amdgcn_readfirstlane(T.cnt[u.ex]), pos0 = ((unsigned)u.pm - (unsigned)__builtin_amdgcn_readfirstlane(T.tb[u.ex])) * 256u; const u32x2* rg = REG + ((size_t)hf * 32 + u.ex) * REG_CAP;
#pragma unroll
        for (int i = 0; i < 2; ++i) {
            const unsigned p0 = pos0 + (unsigned)R[i], p1 = p0 + 128u;
            unsigned t0 = 0u, t1 = 0u;
            if (p0 < cnt) t0 = (unsigned)hf * HALF_TOK + (rg[p0].x >> 2);
            if (p1 < cnt) t1 = (unsigned)hf * HALF_TOK + (rg[p1].x >> 2);
            o0[i] = t0 * (unsigned)MOE_RB + (unsigned)C[i] * 2u; o1[i] = t1 * (unsigned)MOE_RB + (unsigned)C[i] * 2u;
        }
    }
};
struct EpiMoe1 {
    static constexpr bool PERM = true;
    const float* b1; bf16_t* ACT; int dry;
    __device__ __forceinline__ void operator()(const AccT& acc, const Unit& u, int wr, int wc, int fr, int fq) const {
        if (dry) { if (acc[0][0][0][0][0] == 1.2345e-33f) ACT[0] = 1; return; }
        const int row0 = u.pm * 256 + wr * 64 + fr, c8 = u.pn * 128 + wc * 32 + 8 * fq;
        const float* bg = b1 + (size_t)u.ex * 2048 + c8;
        const f32x4 bg0 = *(const f32x4*)bg, bg1 = *(const f32x4*)(bg + 4), bu0 = *(const f32x4*)(bg + 1024), bu1 = *(const f32x4*)(bg + 1028);
#pragma unroll
        for (int ai = 0; ai < 2; ++ai)
#pragma unroll
            for (int m = 0; m < 4; ++m) {
                f32x4 g0 = acc[ai][0][m][0] * MOE_INV + bg0, g1 = acc[ai][0][m][1] * MOE_INV + bg1, u0 = acc[ai][1][m][0] * MOE_INV + bu0, u1 = acc[ai][1][m][1] * MOE_INV + bu1, a0, a1;
#pragma unroll
                for (int j = 0; j < 4; ++j) {
                    float g = fminf(g0[j], 7.0f), up = fminf(fmaxf(u0[j], -7.0f), 7.0f); a0[j] = (up + 1.0f) * g * sigmoid_f(1.702f * g);
                    g = fminf(g1[j], 7.0f); up = fminf(fmaxf(u1[j], -7.0f), 7.0f); a1[j] = (up + 1.0f) * g * sigmoid_f(1.702f * g); }
                if (MOE_FP8) *(u32x2*)((unsigned char*)ACT + (size_t)(row0 + ai * 128 + m * 16) * 1024 + c8) = pack8_fp8(a0, a1);
                else *(u32x4*)(ACT + (size_t)(row0 + ai * 128 + m * 16) * 1024 + c8) = pack8(a0, a1); }
    }
};
struct EpiMoe2 {
    static constexpr bool PERM = true;
    const float* b2; bf16_t* YB; const u32x2* REG; MoeTab T; int hf; int dry;
    __device__ __forceinline__ void operator()(const AccT& acc, const Unit& u, int wr, int wc, int fr, int fq) const {
        if (dry == 1) { if (acc[0][0][0][0][0] == 1.2345e-33f) YB[0] = 1; return; }
        if (dry >= 2) {
            const int c8d = (dry == 3 ? 0 : u.pn * 256) + wc * 32 + 8 * fq; const unsigned rowd = dry == 3 ? (blockIdx.x * 256u + (unsigned)(wr * 64 + fr)) : ((unsigned)u.pm * 256u + (unsigned)(wr * 64 + fr)) % 131072u;
#pragma unroll
            for (int ai = 0; ai < 2; ++ai)
#pragma unroll
                for (int m = 0; m < 4; ++m) { bf16_t* rp = YB + (size_t)((rowd + ai * 128 + m * 16) % 131072u) * 1024 + c8d;
#pragma unroll
                    for (int bj = 0; bj < 2; ++bj) *(u32x4*)(rp + bj * 128) = pack8(acc[ai][bj][m][0] * MOE_INV, acc[ai][bj][m][1] * MOE_INV); }
            return; }
        const int c8 = u.pn * 256 + wc * 32 + 8 * fq;
        const unsigned cnt = __builtin_amdgcn_readfirstlane(T.cnt[u.ex]), pos0 = ((unsigned)u.pm - (unsigned)__builtin_amdgcn_readfirstlane(T.tb[u.ex])) * 256u + (unsigned)(wr * 64 + fr); const u32x2* rg = REG + ((size_t)hf * 32 + u.ex) * REG_CAP;
        const float* bb = b2 + (size_t)u.ex * 1024 + c8;
        f32x4 bv[2][2];
#pragma unroll
        for (int bj = 0; bj < 2; ++bj) { bv[bj][0] = *(const f32x4*)(bb + bj * 128); bv[bj][1] = *(const f32x4*)(bb + bj * 128 + 4); }
        u32x2 en8[2][4];
#pragma unroll
        for (int ai = 0; ai < 2; ++ai)
#pragma unroll
            for (int m = 0; m < 4; ++m) { const unsigned p = pos0 + (unsigned)(ai * 128 + m * 16); en8[ai][m] = rg[p < cnt ? p : cnt - 1u]; }
#pragma unroll
        for (int ai = 0; ai < 2; ++ai)
#pragma unroll
            for (int m = 0; m < 4; ++m) { const unsigned p = pos0 + (unsigned)(ai * 128 + m * 16);
                const u32x2 en = en8[ai][m]; const float g = __uint_as_float(en.y); const unsigned drow = p < cnt ? en.x : (unsigned)(HALF_TOK * 4);
                bf16_t* rp = YB + (size_t)drow * 1024 + c8;
#pragma unroll
                for (int bj = 0; bj < 2; ++bj) *(u32x4*)(rp + bj * 128) = pack8((acc[ai][bj][m][0] * MOE_INV + bv[bj][0]) * g, (acc[ai][bj][m][1] * MOE_INV + bv[bj][1]) * g); }
    }
};

struct MapIdent { __device__ __forceinline__ int operator()(int n) const { return n; } };
struct MapWin { __device__ __forceinline__ int operator()(int n) const {
    if (n < 1024) return n;
    if (n < 1536) return 1152 + (n - 1024);
    if (n < 1792) { const int c = n - 1536; if (c < 128) return 1024 + c; if (c < 192) return 1664 + (c - 128); if (c < 200) return 1728 + (c - 192); if (c < 216) return 4808 + (c - 200); return -1; }
    if (n < 2816) return 1736 + (n - 1792);
    if (n < 4864) return 2760 + (n - 2816);
    if (n < 5888) return 4824 + (n - 4864);
    return 5848 + (n - 5888); } };
struct MapW1 { __device__ __forceinline__ int operator()(int r) const { const int j = r >> 8, rr = r & 255; return (rr >> 7) * 1024 + j * 128 + (rr & 127); } };
template <class Map, bool F8 = false> __device__ __forceinline__ void transpose_item(const float* W, int K, int N, bf16_t* WT, const Map& map, LAS float* scr, int kb, int nb, int lane, const float* rowscale) {
    const int k0 = 64 * kb, n0 = 64 * nb, q = lane & 15, kr = lane >> 4; const int src = map(n0 + 4 * q);
    f32x4 ld[16];
#pragma unroll
    for (int i = 0; i < 16; ++i) { const int kk = 4 * i + kr; ld[i] = (src >= 0) ? *(const f32x4*)(W + (size_t)(k0 + kk) * N + src) : (f32x4){0.f, 0.f, 0.f, 0.f}; }
#pragma unroll
    for (int i = 0; i < 16; ++i) { const int kk = 4 * i + kr; f32x4 v = ld[i]; if (rowscale) v = v * rowscale[k0 + kk]; LAS float* d = scr + kk * 65 + 4 * q; d[0] = v[0]; d[1] = v[1]; d[2] = v[2]; d[3] = v[3]; }
    LDS_WAIT(); asm volatile("" ::: "memory");
    const int c = lane & 7;
#pragma unroll
    for (int j = 0; j < 8; ++j) { const int n = (lane >> 3) + 8 * j; const LAS float* s = scr + (8 * c) * 65 + n;
        if constexpr (F8) { const f32x4 a = {s[0 * 65] * MOE_WSC, s[1 * 65] * MOE_WSC, s[2 * 65] * MOE_WSC, s[3 * 65] * MOE_WSC}, b = {s[4 * 65] * MOE_WSC, s[5 * 65] * MOE_WSC, s[6 * 65] * MOE_WSC, s[7 * 65] * MOE_WSC};
            *(u32x2*)((unsigned char*)WT + (size_t)(n0 + n) * K + k0 + 8 * c) = pack8_fp8(a, b); }
        else { u32x4 o; o.x = cvt_pk_bf16(s[0 * 65], s[1 * 65]); o.y = cvt_pk_bf16(s[2 * 65], s[3 * 65]); o.z = cvt_pk_bf16(s[4 * 65], s[5 * 65]); o.w = cvt_pk_bf16(s[6 * 65], s[7 * 65]);
            *(u32x4*)(WT + (size_t)(n0 + n) * K + k0 + 8 * c) = o; } }
    LDS_WAIT(); asm volatile("" ::: "memory");
}
struct TrItem { const float* W; const float* rowscale; unsigned char* WT; int N, src, k0, n0, f8; };
__device__ __forceinline__ TrItem tr_decode(Frame& F, int it) {
    constexpr int I_WIN = 16 * (NPROJ / 64), I_SQ = 16 * 16, I_W1E = 16 * 32, I_W2E = 16 * 16;
    TrItem d; d.rowscale = nullptr; int r = it, kb, nb; const int q4 = 4 * (F.lane & 15);
    if (r < (PROJ_FP8 ? 2 : 1) * I_WIN) { const int f8 = r >= I_WIN; if (f8) r -= I_WIN; kb = r / (NPROJ / 64); nb = r % (NPROJ / 64);
        d.W = F.a->in[4]; d.N = 6872; d.src = MapWin()(64 * nb + q4); d.WT = F.ws + (f8 ? WS_WIN8 : WS_WIN); d.f8 = f8; }
    else { r -= (PROJ_FP8 ? 2 : 1) * I_WIN;
        if (r < 3 * I_SQ) { const int w = r / I_SQ; r -= w * I_SQ; kb = r / 16; nb = r % 16; d.N = 1024; d.src = 64 * nb + q4;
            if (w == 0) { d.W = F.a->in[15]; d.WT = F.ws + (PA_FP8 ? WS_WPA8 : WS_WPA); d.f8 = PA_FP8; }
            else if (w == 1) { d.W = F.a->in[16]; d.WT = F.ws + (PB_FP8 ? WS_WPB8 : WS_WPB); d.f8 = PB_FP8; d.rowscale = F.a->in[14]; }
            else { d.W = F.a->in[17]; d.WT = F.ws + WS_WOUT; d.f8 = 0; } }
        else { r -= 3 * I_SQ;
            if (r < 32 * I_W1E) { const int e = r / I_W1E, q = r % I_W1E; kb = q / 32; nb = q % 32; d.W = F.a->in[22] + (size_t)e * 1024 * 2048; d.N = 2048; d.src = MapW1()(64 * nb + q4);
                d.WT = F.ws + WS_W1 + (size_t)e * 2048 * MOE_RB; d.f8 = MOE_FP8; }
            else { r -= 32 * I_W1E; const int e = r / I_W2E, q = r % I_W2E; kb = q / 16; nb = q % 16; d.W = F.a->in[24] + (size_t)e * 1024 * 1024; d.N = 1024; d.src = 64 * nb + q4;
                d.WT = F.ws + WS_W2 + (size_t)e * 1024 * MOE_RB; d.f8 = MOE_FP8; } } }
    d.k0 = 64 * kb; d.n0 = 64 * nb; return d; }
__device__ __forceinline__ void tr_load(const TrItem& d, f32x4 (&ld)[16], int lane) {
    const int kr = lane >> 4; const float* p = d.W + (size_t)(d.k0 + kr) * d.N + (d.src >= 0 ? d.src : 0);
#pragma unroll
    for (int i = 0; i < 16; ++i) ld[i] = __builtin_nontemporal_load((const f32x4*)(p + (size_t)(4 * i) * d.N)); }
__device__ __forceinline__ void tr_finish(const TrItem& d, f32x4 (&ld)[16], LAS float* scr, int lane) {
    const int q = lane & 15, kr = lane >> 4; const bool zero = d.src < 0;
#pragma unroll
    for (int i = 0; i < 16; ++i) { const int kk = 4 * i + kr; f32x4 v = ld[i]; if (zero) v = (f32x4){0.f, 0.f, 0.f, 0.f}; if (d.rowscale) v = v * d.rowscale[d.k0 + kk];
        LAS float* o = scr + kk * 65 + 4 * q; o[0] = v[0]; o[1] = v[1]; o[2] = v[2]; o[3] = v[3]; }
    LDS_WAIT(); asm volatile("" ::: "memory");
    const int c = lane & 7;
    if (d.f8) {
#pragma unroll
        for (int j = 0; j < 8; ++j) { const int n = (lane >> 3) + 8 * j; const LAS float* s = scr + (8 * c) * 65 + n;
            const f32x4 a = {s[0 * 65] * MOE_WSC, s[1 * 65] * MOE_WSC, s[2 * 65] * MOE_WSC, s[3 * 65] * MOE_WSC}, b = {s[4 * 65] * MOE_WSC, s[5 * 65] * MOE_WSC, s[6 * 65] * MOE_WSC, s[7 * 65] * MOE_WSC};
            *(u32x2*)((unsigned char*)d.WT + (size_t)(d.n0 + n) * 1024 + d.k0 + 8 * c) = pack8_fp8(a, b); } }
    else {
#pragma unroll
        for (int j = 0; j < 8; ++j) { const int n = (lane >> 3) + 8 * j; const LAS float* s = scr + (8 * c) * 65 + n;
            u32x4 o; o.x = cvt_pk_bf16(s[0 * 65], s[1 * 65]); o.y = cvt_pk_bf16(s[2 * 65], s[3 * 65]); o.z = cvt_pk_bf16(s[4 * 65], s[5 * 65]); o.w = cvt_pk_bf16(s[6 * 65], s[7 * 65]);
            *(u32x4*)((bf16_t*)d.WT + (size_t)(d.n0 + n) * 1024 + d.k0 + 8 * c) = o; } }
    LDS_WAIT(); asm volatile("" ::: "memory");
}
__device__ __forceinline__ void ph_prologue(Frame& F) {
    const float* c_in = F.a->in[1]; const float* w_mod = F.a->in[2]; const float* b_mod = F.a->in[3];
    float* MOD = (float*)(F.ws + WS_MOD);
    for (int item = F.bid; item < 192; item += F.G) {
        LAS float* SC = (LAS float*)F.lds;
        __syncthreads();
        for (int i = F.tid; i < 32768; i += NTHR) { const int b = i >> 10, k = i & 1023; SC[k * 36 + b] = silu_f(c_in[i]); }
        __syncthreads();
        const int col = item * 32 + (F.tid >> 4), kq = F.tid & 15;
        float a[32];
#pragma unroll
        for (int b = 0; b < 32; ++b) a[b] = 0.f;
#pragma nounroll
        for (int kg = 0; kg < 64; kg += 16) {
            float wv[16];
#pragma unroll
            for (int u = 0; u < 16; ++u) wv[u] = w_mod[(size_t)((kg + u) * 16 + kq) * 6144 + col];
#pragma unroll
            for (int u = 0; u < 16; ++u) { const int k = (kg + u) * 16 + kq; const float w = wv[u];
#pragma unroll
                for (int b4 = 0; b4 < 8; ++b4) { const f32x4 s = *(const LAS f32x4*)(SC + k * 36 + b4 * 4); a[b4 * 4 + 0] += w * s[0]; a[b4 * 4 + 1] += w * s[1]; a[b4 * 4 + 2] += w * s[2]; a[b4 * 4 + 3] += w * s[3]; } } }
#pragma unroll
        for (int b = 0; b < 32; ++b) { a[b] += __shfl_xor(a[b], 1); a[b] += __shfl_xor(a[b], 2); a[b] += __shfl_xor(a[b], 4); a[b] += __shfl_xor(a[b], 8); }
        { const float bm = b_mod[col];
#pragma unroll
            for (int b = 1; b < 16; ++b) { a[0] = (kq == b) ? a[b] : a[0]; a[16] = (kq == b) ? a[16 + b] : a[16]; }
            MOD[(size_t)kq * 6144 + col] = a[0] + bm; MOD[(size_t)(kq + 16) * 6144 + col] = a[16] + bm; }
        __syncthreads();
    }
    if (F.bid == (F.G > 192 ? 192 : 0)) {
        float* BT = (float*)(F.ws + WS_BIAST); const float* rel_bias = F.a->in[8];
        for (int i = F.tid; i < 249 * 8; i += NTHR) { const int idx = i >> 3, h = i & 7, rel = idx - 185; const int n = rel < 0 ? -rel : rel;
            const float nf = (float)(n > 1 ? n : 1); int large = 8 + (int)(logf(nf / 8.0f) / 2.7725887f * 8.0f); if (large > 15) large = 15;
            const int bucket = (rel > 0 ? 16 : 0) + (n < 8 ? n : large);
            BT[i] = rel_bias[bucket * 8 + h] * LOG2E; }
    }
    LAS float* scr = (LAS float*)(F.lds + F.wave * 16640);
    __syncthreads();
    const int gw = F.bid * NWAVES + F.wave, NGW = F.G * NWAVES;
    constexpr int I_WIN = 16 * (NPROJ / 64), I_SQ = 16 * 16, I_W1E = 16 * 32, I_W2E = 16 * 16;
    constexpr int NITEMS = (PROJ_FP8 ? 2 : 1) * I_WIN + 3 * I_SQ + 32 * I_W1E + 32 * I_W2E;
    TrItem d0, d1; f32x4 la[16], lb[16];
    int it = gw;
    if (it < NITEMS) { d0 = tr_decode(F, it); tr_load(d0, la, F.lane); }
    while (it < NITEMS) {
        const int i1 = it + NGW; const bool v1 = i1 < NITEMS;
        if (v1) { d1 = tr_decode(F, i1); tr_load(d1, lb, F.lane); }
        tr_finish(d0, la, scr, F.lane);
        if (!v1) break;
        const int i2 = i1 + NGW; const bool v2 = i2 < NITEMS;
        if (v2) { d0 = tr_decode(F, i2); tr_load(d0, la, F.lane); }
        tr_finish(d1, lb, scr, F.lane);
        it = i2;
    }
}

__device__ __forceinline__ void ln1_load(const float* x, int m0, int lane, f32x4 (&v)[4][4]) {
#pragma unroll
    for (int r = 0; r < 4; ++r) { const f32x4* xr = (const f32x4*)(x + (size_t)(m0 + r) * D) + lane;
#pragma unroll
        for (int j = 0; j < 4; ++j) v[r][j] = __builtin_nontemporal_load(xr + 64 * j); } }
__device__ __forceinline__ void ln1_proc(Frame& F, bf16_t* U, int m0, f32x4 (&v)[4][4], const f32x4 (&sh)[4], const f32x4 (&sc)[4]) {
#pragma unroll
    for (int r = 0; r < 4; ++r) { const int m = m0 + r;
        float s = 0.f;
#pragma unroll
        for (int j = 0; j < 4; ++j) s += (v[r][j][0] + v[r][j][1]) + (v[r][j][2] + v[r][j][3]);
        const float mean = wave_sum(s) * (1.f / D); float s2 = 0.f;
#pragma unroll
        for (int j = 0; j < 4; ++j) { v[r][j] = v[r][j] - mean; s2 += (v[r][j][0] * v[r][j][0] + v[r][j][1] * v[r][j][1]) + (v[r][j][2] * v[r][j][2] + v[r][j][3] * v[r][j][3]); }
        const float rstd = 1.f / sqrtf(wave_sum(s2) * (1.f / D) + LN_EPS);
        u32x2* o8 = (u32x2*)(U + (size_t)m * D) + F.lane;
#pragma unroll
        for (int j = 0; j < 4; ++j) {
            const f32x4 rr = v[r][j] * rstd * (sc[j] + 1.0f) + sh[j]; u32x2 w; w.x = cvt_pk_bf16(rr[0], rr[1]); w.y = cvt_pk_bf16(rr[2], rr[3]); o8[64 * j] = w;
            if (PROJ_FP8) { int pk = 0; pk = __builtin_amdgcn_cvt_pk_fp8_f32(rr[0], rr[1], pk, false); pk = __builtin_amdgcn_cvt_pk_fp8_f32(rr[2], rr[3], pk, true); ((unsigned*)(F.ws + WS_U8 + (size_t)m * D))[F.lane + 64 * j] = (unsigned)pk; } } } }
__device__ __forceinline__ void ph_ln1(Frame& F) {
    const float* x = F.a->in[0]; const float* MOD = (const float*)(F.ws + WS_MOD); bf16_t* U = (bf16_t*)(F.outb + OUT_U);
    const int gw = F.bid * NWAVES + F.wave, NGW = F.G * NWAVES;
    const int RPW = (((NTOK + NGW - 1) / NGW) + 3) & ~3;
    const int mbeg = gw * RPW, mend = (mbeg + RPW < NTOK) ? mbeg + RPW : NTOK;
    if (mbeg >= mend) return;
    f32x4 va[4][4], vb[4][4], sh[4], sc[4]; int curb = -1;
#define LN1_MOD(m0) do { const int bb = (m0) >> 11; if (bb != curb) { curb = bb; const float* md = MOD + (size_t)bb * 6144; \
        _Pragma("unroll") for (int j = 0; j < 4; ++j) { sh[j] = *((const f32x4*)md + F.lane + 64 * j); sc[j] = *((const f32x4*)(md + 1024) + F.lane + 64 * j); } } } while (0)
    int m0 = mbeg;
    ln1_load(x, m0, F.lane, va);
    for (;;) {
        const int m1 = m0 + 4; const bool v1 = m1 < mend;
        LN1_MOD(m0); if (v1) ln1_load(x, m1, F.lane, vb);
        ln1_proc(F, U, m0, va, sh, sc);
        if (!v1) break;
        const int m2 = m1 + 4; const bool v2 = m2 < mend;
        LN1_MOD(m1); if (v2) ln1_load(x, m2, F.lane, va);
        ln1_proc(F, U, m1, vb, sh, sc);
        if (!v2) break;
        m0 = m2;
    }
#undef LN1_MOD
}

__device__ __forceinline__ void misc_load(const float* MISC, int m0, int l, f32x4 (&v)[8]) {
#pragma unroll
    for (int r = 0; r < 8; ++r) v[r] = __builtin_nontemporal_load((const f32x4*)(MISC + (size_t)(m0 + r) * 256) + l); }
__device__ __forceinline__ void misc_proc(Frame& F, int m0, const f32x4 (&vv)[8], const f32x4& w1, const f32x4& w2) {
    bf16_t* KV = (bf16_t*)(F.outb + OUT_KV); bf16_t* IK = (bf16_t*)(F.outb + OUT_IK); float* IW = (float*)(F.outb + OUT_IW); float* DT = (float*)(F.outb + OUT_DT);
    const int l = F.lane;
#pragma unroll
    for (int r = 0; r < 8; ++r) { const int m = m0 + r;
        const f32x4 v = vv[r];
        const float sq = v[0] * v[0] + v[1] * v[1] + v[2] * v[2] + v[3] * v[3], sm = (v[0] + v[1]) + (v[2] + v[3]);
        const float kvss = wave_sum(l < 32 ? sq : 0.f);
        const float iks = wave_sum((l >= 32 && l < 48) ? sm : 0.f);
        const float ikmean = iks * (1.f / 64.f);
        const f32x4 dv = v - ikmean;
        const float ikq = wave_sum((l >= 32 && l < 48) ? (dv[0] * dv[0] + dv[1] * dv[1] + dv[2] * dv[2] + dv[3] * dv[3]) : 0.f);
        if (l < 32) { const float rr = 1.f / sqrtf(kvss * (1.f / 128.f) + LN_EPS); const f32x4 o = v * rr * w1;
            u32x2 pk; pk.x = cvt_pk_bf16(o[0], o[1]); pk.y = cvt_pk_bf16(o[2], o[3]); *((u32x2*)(KV + (size_t)m * 128) + l) = pk; }
        else if (l < 48) { const float rr = 1.f / sqrtf(ikq * (1.f / 64.f) + LN_EPS); const f32x4 o = dv * rr * w1 + w2;
            u32x2 pk; pk.x = cvt_pk_bf16(o[0], o[1]); pk.y = cvt_pk_bf16(o[2], o[3]); *((u32x2*)(IK + (size_t)m * 64) + (l - 32)) = pk; }
        else if (l < 50) { *((f32x4*)(IW + (size_t)m * 8) + (l - 48)) = v * 0.35355339059327373f; }
        else if (l < 54) { f32x4 o;
#pragma unroll
            for (int j = 0; j < 4; ++j) { const float t = v[j] + w1[j]; o[j] = t > 20.f ? t : log1pf(__expf(t)); }
            *((f32x4*)(DT + (size_t)m * 16) + (l - 50)) = o; }
    } }
__device__ __forceinline__ void ph_misc(Frame& F) {
    const float* MISC = (const float*)(F.outb + OUT_MISC);
    const float* kvw = F.a->in[5]; const float* ikw = F.a->in[6]; const float* ikb = F.a->in[7]; const float* dtb = F.a->in[11];
    const int gw = F.bid * NWAVES + F.wave, NGW = F.G * NWAVES, l = F.lane;
    const int RPW = (((NTOK + NGW - 1) / NGW) + 7) & ~7;
    const int mbeg = gw * RPW, mend = (mbeg + RPW < NTOK) ? mbeg + RPW : NTOK;
    if (mbeg >= mend) return;
    f32x4 w1 = (f32x4){0.f, 0.f, 0.f, 0.f}, w2 = w1;
    if (l < 32) w1 = *((const f32x4*)kvw + l); else if (l < 48) { w1 = *((const f32x4*)ikw + (l - 32)); w2 = *((const f32x4*)ikb + (l - 32)); } else if (l >= 50 && l < 54) w1 = *((const f32x4*)dtb + (l - 50));
    f32x4 va[8], vb[8];
    int m0 = mbeg;
    misc_load(MISC, m0, l, va);
    for (;;) {
        const int m1 = m0 + 8; const bool v1 = m1 < mend;
        if (v1) misc_load(MISC, m1, l, vb);
        misc_proc(F, m0, va, w1, w2);
        if (!v1) break;
        const int m2 = m1 + 8; const bool v2 = m2 < mend;
        if (v2) misc_load(MISC, m2, l, va);
        misc_proc(F, m1, vb, w1, w2);
        if (!v2) break;
        m0 = m2;
    }
}

__device__ __forceinline__ unsigned sortable_key(float s) { const unsigned u = __float_as_uint(s + 0.0f); return (u & 0x80000000u) ? ~u : (u | 0x80000000u); }
template <int NKB> struct KeyRow { unsigned k[NKB]; };
__device__ __forceinline__ u64 low_bits_keep(u64 m, int t) { u64 out = 0; while (t-- > 0 && m) { const u64 b = m & (0 - m); out |= b; m ^= b; } return out; }
namespace idx { constexpr int KST = 144, KBUF = 64 * KST; }
__device__ __forceinline__ unsigned low_bits_keep32(unsigned m, int t) { unsigned out = 0; while (t-- > 0 && m) { const unsigned b = m & (0u - m); out |= b; m ^= b; } return out; }
template <int NG> __device__ __forceinline__ void topk2_select_write(const unsigned (&key)[64], int nkb, u64* mrow, int lane) {
    constexpr int NR = NG * 16;
    unsigned T0 = 0u, T1 = 0u; bool ex0 = false, ex1 = false;
    unsigned lo0 = 0u, lo1 = 0u, hi0 = 0xFFFFFFFFu, hi1 = 0xFFFFFFFFu, st0, st1, p0, p1; bool fin0 = false, fin1 = false;
    { float sm = 0.f, sq = 0.f;
#pragma unroll
        for (int m = 0; m < 10; ++m) { const unsigned k = key[m]; const float f = __uint_as_float((k & 0x80000000u) ? (k ^ 0x80000000u) : ~k); sm += f; sq += f * f; }
        sm = dpp_half_sums_f32(sm); sq = dpp_half_sums_f32(sq);
        const float mu = sm * (1.f / 320.f), sd = sqrtf(fmaxf(sq * (1.f / 320.f) - mu * mu, 1e-20f));
        const float qq = 256.f / (64.f * (float)nkb), pp = qq < 0.5f ? qq : 1.f - qq, tt = sqrtf(-2.f * __logf(pp));
        float z = tt - (2.515517f + 0.802853f * tt + 0.010328f * tt * tt) / (1.f + 1.432788f * tt + 0.189269f * tt * tt + 0.001308f * tt * tt * tt); if (qq >= 0.5f) z = -z;
        const unsigned pe = sortable_key(mu + z * sd), pd = sortable_key(mu + z * sd + 0.125f * sd);
        unsigned stp = pd - pe; if (stp < 1024u) stp = 1024u;
        p0 = __builtin_amdgcn_readlane((int)pe, 31); p1 = __builtin_amdgcn_readlane((int)pe, 63); st0 = __builtin_amdgcn_readlane((int)stp, 31); st1 = __builtin_amdgcn_readlane((int)stp, 63); }
#pragma nounroll
    for (int it = 0; it < 80; ++it) {
        const unsigned candv = lane < 32 ? p0 : p1;
        unsigned cl = 0u;
#pragma unroll
        for (int m = 0; m < NR; m += 4) { u64 s0, s1, s2, s3;
            asm("v_cmp_ge_u32_e64 %1, %5, %9\n\tv_cmp_ge_u32_e64 %2, %6, %9\n\tv_cmp_ge_u32_e64 %3, %7, %9\n\tv_cmp_ge_u32_e64 %4, %8, %9\n\t"
                "v_addc_co_u32_e64 %0, %1, 0, %0, %1\n\tv_addc_co_u32_e64 %0, %2, 0, %0, %2\n\tv_addc_co_u32_e64 %0, %3, 0, %0, %3\n\tv_addc_co_u32_e64 %0, %4, 0, %0, %4"
                : "+v"(cl), "=&s"(s0), "=&s"(s1), "=&s"(s2), "=&s"(s3) : "v"(key[m]), "v"(key[m + 1]), "v"(key[m + 2]), "v"(key[m + 3]), "v"(candv)); }
        cl = dpp_half_sums_u32(cl);
        const int n0 = __builtin_amdgcn_readlane((int)cl, 31), n1 = __builtin_amdgcn_readlane((int)cl, 63);
#define IDX_STEP(lo, hi, st, p, T, ex, fin, n) do { if (!fin) { \
            if (n == 256) { T = p; ex = true; fin = true; } \
            else { if (n > 256) lo = p; else hi = p; \
                if (hi - lo <= 1u) { T = lo; fin = true; } \
                else { unsigned c; if (hi == 0xFFFFFFFFu) { c = lo + st; if (c < lo) c = hi; st = st << 1; } else if (lo == 0u) { c = hi - st; if (c > hi) c = lo; st = st << 1; } else c = lo + ((hi - lo) >> 1); \
                    if (c <= lo || c >= hi) c = lo + ((hi - lo) >> 1); p = c; } } } } while (0)
        IDX_STEP(lo0, hi0, st0, p0, T0, ex0, fin0, n0);
        IDX_STEP(lo1, hi1, st1, p1, T1, ex1, fin1, n1);
#undef IDX_STEP
        if (fin0 && fin1) break;
    }
    const unsigned Tv = lane < 32 ? T0 : T1;
    if (ex0 && ex1) {
        unsigned mlo = 0u, mhi = 0u;
#pragma unroll
        for (int j = 0; j < NR / 2; ++j) {
            const u64 b0 = __ballot(key[2 * j] >= Tv), b1 = __ballot(key[2 * j + 1] >= Tv);
            asm volatile("s_nop 1\n\tv_writelane_b32 %0, %2, %6\n\tv_writelane_b32 %0, %3, %7\n\tv_writelane_b32 %1, %4, %6\n\tv_writelane_b32 %1, %5, %7"
                         : "+v"(mlo), "+v"(mhi) : "s"((unsigned)b0), "s"((unsigned)(b0 >> 32)), "s"((unsigned)b1), "s"((unsigned)(b1 >> 32)), "n"(j), "n"(32 + j));
            if ((j & 3) == 3) SBAR();
        }
        const int jl = lane & 31;
        if (jl < nkb) mrow[(lane >> 5) * 32 + jl] = (u64)mlo | ((u64)mhi << 32);
        return;
    }
    int rem0 = 1 << 30, rem1 = 1 << 30;
    { int g0 = 0, g1 = 0;
#pragma unroll
        for (int m = 0; m < NR; ++m) { const u64 mk = __ballot(key[m] > Tv); g0 += __builtin_popcount((unsigned)mk); g1 += __builtin_popcount((unsigned)(mk >> 32)); if ((m & 7) == 7) SBAR(); }
        if (!ex0) rem0 = 256 - g0; if (!ex1) rem1 = 256 - g1; }
    u64 mine = 0ull;
#pragma nounroll
    for (int jq = 0; jq < NR / 8; ++jq) {
#pragma unroll
        for (int jj = 0; jj < 4; ++jj) { const int j = jq * 4 + jj;
            unsigned w0[2], w1[2];
#pragma unroll
            for (int hh = 0; hh < 2; ++hh) { unsigned kv = 0u;
#pragma unroll
                for (int m = 0; m < NR; ++m) if ((m >> 3) == 0) {}
#pragma unroll
                for (int m = 0; m < NR; ++m) kv = (m == 2 * j + hh) ? key[m] : kv;
                const u64 gt = __ballot(kv > Tv), eq = __ballot(kv == Tv);
                { const unsigned e = (unsigned)eq, g = (unsigned)gt; const int ne = __builtin_popcount(e); unsigned sel = g; if (rem0 >= ne) { sel |= e; rem0 -= ne; } else if (rem0 > 0) { sel |= low_bits_keep32(e, rem0); rem0 = 0; } w0[hh] = sel; }
                { const unsigned e = (unsigned)(eq >> 32), g = (unsigned)(gt >> 32); const int ne = __builtin_popcount(e); unsigned sel = g; if (rem1 >= ne) { sel |= e; rem1 -= ne; } else if (rem1 > 0) { sel |= low_bits_keep32(e, rem1); rem1 = 0; } w1[hh] = sel; } }
            const u64 q0w = (u64)w0[0] | ((u64)w0[1] << 32), q1w = (u64)w1[0] | ((u64)w1[1] << 32);
            if (lane == j) mine = q0w; if (lane == 32 + j) mine = q1w; }
    }
    const int jl = lane & 31;
    if (jl < nkb) mrow[(lane >> 5) * 32 + jl] = mine;
}
template <int J0> __device__ __forceinline__ void index_scores8(unsigned (&key)[64], const bf16x8 (&af)[2], const f32x4& iw4, const bf16_t* kvsrc, char* lds, int nkb, u32x4 (&stg)[8], int tid) {
    const int lane = tid & 63, sub = lane & 15, kg = lane >> 4;
#pragma unroll
    for (int jj = 0; jj < 8; ++jj) {
        const int j = J0 + jj;
        if (j < nkb) {
            if (j + 1 < nkb) *(u32x4*)(lds + ((j + 1) & 1) * idx::KBUF + (tid >> 3) * idx::KST + (tid & 7) * 16) = stg[(jj + 1) & 7];
            if (j + 8 < nkb) stg[jj] = *(const u32x4*)(kvsrc + (size_t)(j + 8) * 64 * 64);
            const char* kb = lds + (j & 1) * idx::KBUF + sub * idx::KST + kg * 16;
#pragma unroll
            for (int pr = 0; pr < 2; ++pr) {
                f32x4 dA = (f32x4){0.f, 0.f, 0.f, 0.f}, dB = dA;
#pragma unroll
                for (int ks = 0; ks < 2; ++ks) {
                    const bf16x8 fA = *(const bf16x8*)(kb + (pr * 32) * idx::KST + ks * 64), fB = *(const bf16x8*)(kb + (pr * 32 + 16) * idx::KST + ks * 64);
                    dA = __builtin_amdgcn_mfma_f32_16x16x32_bf16(af[ks], fA, dA, 0, 0, 0); dB = __builtin_amdgcn_mfma_f32_16x16x32_bf16(af[ks], fB, dB, 0, 0, 0); }
                float pA = 0.f, pB = 0.f;
#pragma unroll
                for (int r = 0; r < 4; ++r) { pA += fmaxf(dA[r], 0.f) * iw4[r]; pB += fmaxf(dB[r], 0.f) * iw4[r]; }
                auto rr = __builtin_amdgcn_permlane16_swap(__float_as_uint(pA), __float_as_uint(pB), false, false);
                key[2 * j + pr] = sortable_key(__uint_as_float(rr[0]) + __uint_as_float(rr[1]));
            }
            __syncthreads();
        }
    }
}
__device__ __forceinline__ void ph_index(Frame& F, const int abl = 0) {
    const bf16_t* IQ = (const bf16_t*)(F.outb + OUT_IQ); const bf16_t* IK = (const bf16_t*)(F.outb + OUT_IK); const float* IW = (const float*)(F.outb + OUT_IW);
    u64* MASK = (u64*)(F.outb + OUT_MASK);
    char* lds = (char*)(unsigned char*)F.lds;
    const int tid = F.tid, lane = F.lane, sub = lane & 15, kg = lane >> 4;
    for (int item = F.bid; item < NTOK / 16; item += F.G) {
        const int tokw = (((item & 255) >> 3) << 11) + (((item & 7) + 8 * (item >> 8)) << 4) + F.wave * 2, b = tokw >> 11, pos0 = tokw & 2047, nkb = (pos0 >> 6) + 1;
        u64* mrow = MASK + (size_t)tokw * 32;
        if (nkb <= 4) { if ((lane & 31) < nkb) mrow[(lane >> 5) * 32 + (lane & 31)] = ~0ull; continue; }
        bf16x8 af[2];
        { const bf16_t* ap = IQ + (size_t)(tokw + (sub >> 3)) * 512 + (sub & 7) * 64 + kg * 8;
#pragma unroll
          for (int ks = 0; ks < 2; ++ks) af[ks] = *(const bf16x8*)(ap + ks * 32); }
        const f32x4 iw4 = *(const f32x4*)(IW + (size_t)(tokw + (lane >> 5)) * 8 + 4 * (kg & 1));
        unsigned key[64];
#pragma unroll
        for (int m = 0; m < 64; ++m) key[m] = 0u;
        const bf16_t* kvsrc = IK + ((size_t)b * SEQ + (tid >> 3)) * 64 + (tid & 7) * 8;
        u32x4 stg[8];
#pragma unroll
        for (int i = 0; i < 8; ++i) stg[i] = (i < nkb) ? *(const u32x4*)(kvsrc + (size_t)i * 64 * 64) : (u32x4){0u, 0u, 0u, 0u};
        __syncthreads();
        *(u32x4*)(lds + (tid >> 3) * idx::KST + (tid & 7) * 16) = stg[0];
        __syncthreads();
        const int ng = (nkb + 7) >> 3;
        if (!(abl & 1)) {
        index_scores8<0>(key, af, iw4, kvsrc, lds, nkb, stg, tid);
        if (ng > 1) index_scores8<8>(key, af, iw4, kvsrc, lds, nkb, stg, tid);
        if (ng > 2) index_scores8<16>(key, af, iw4, kvsrc, lds, nkb, stg, tid);
        if (ng > 3) index_scores8<24>(key, af, iw4, kvsrc, lds, nkb, stg, tid);
        }
        if (abl & 2) { if (key[0] == 0x12345u && key[63] == 7u) mrow[lane] = 1ull; continue; }
        if (ng == 1) topk2_select_write<1>(key, nkb, mrow, lane);
        else if (ng == 2) topk2_select_write<2>(key, nkb, mrow, lane);
        else if (ng == 3) topk2_select_write<3>(key, nkb, mrow, lane);
        else topk2_select_write<4>(key, nkb, mrow, lane);
    }
}

namespace att {
constexpr int KVBLK = 64;
constexpr int SHM_V = KVBLK * 128 * 2, SHM_K = SHM_V;
constexpr int OFF_V = 0, OFF_K = 2 * SHM_V, OFF_WS = 2 * SHM_V + 2 * SHM_K, OFF_BT = OFF_WS + NWAVES * 64 * 4;
constexpr int OFF_OT = 81920, OT_ST = 144;
#define KSWZ(row, colB) ((row) * 256 + ((colB) ^ (((row) & 7) << 4)))
__device__ __forceinline__ int crow(int r, int hi) { return (r & 3) + 8 * (r >> 2) + 4 * hi; }
__device__ __forceinline__ int v_st(int k, int c) { const int kk = (k & ~0xC) | ((k & 4) << 1) | ((k & 8) >> 1); return ((kk >> 3) * 4 + (c >> 5)) * 512 + ((kk & 7) * 32 + (c & 31)) * 2; }
__device__ __forceinline__ int v_rd_base(int lane) { return ((lane & 3) << 3) | (((lane >> 2) & 3) << 6) | (((lane >> 4) & 1) << 5) | (((lane >> 5) & 1) << 8); }
constexpr int v_rd_off(int d0, int ks, int half) { return d0 * 512 + ks * 4096 + half * 2048; }
template <int OFF> __device__ __forceinline__ s16x4 tr_read(int vb) { s16x4 r; asm volatile("ds_read_b64_tr_b16 %0, %1 offset:%2" : "=&v"(r) : "v"(vb), "i"(OFF) : "memory"); return r; }
template <int D0> __device__ __forceinline__ void pv_one(f32x16& od, int vb, bf16x8 pa0, bf16x8 pa1, bf16x8 pa2, bf16x8 pa3) {
    const s16x4 l0 = tr_read<v_rd_off(D0, 0, 0)>(vb), h0 = tr_read<v_rd_off(D0, 0, 1)>(vb), l1 = tr_read<v_rd_off(D0, 1, 0)>(vb), h1 = tr_read<v_rd_off(D0, 1, 1)>(vb);
    const s16x4 l2 = tr_read<v_rd_off(D0, 2, 0)>(vb), h2 = tr_read<v_rd_off(D0, 2, 1)>(vb), l3 = tr_read<v_rd_off(D0, 3, 0)>(vb), h3 = tr_read<v_rd_off(D0, 3, 1)>(vb);
    asm volatile("s_waitcnt lgkmcnt(0)" ::: "memory"); SBAR();
#define PK(L, H) (bf16x8){L[0], L[1], L[2], L[3], H[0], H[1], H[2], H[3]}
    od = __builtin_amdgcn_mfma_f32_32x32x16_bf16(pa0, PK(l0, h0), od, 0, 0, 0);
    od = __builtin_amdgcn_mfma_f32_32x32x16_bf16(pa1, PK(l1, h1), od, 0, 0, 0);
    od = __builtin_amdgcn_mfma_f32_32x32x16_bf16(pa2, PK(l2, h2), od, 0, 0, 0);
    od = __builtin_amdgcn_mfma_f32_32x32x16_bf16(pa3, PK(l3, h3), od, 0, 0, 0);
#undef PK
}
__device__ __forceinline__ void qkt(f32x16& p0, f32x16& p1, const char* Ks, const bf16x8* qr, int r32, int hi) {
    p0 = f32x16{}; p1 = f32x16{};
    int rv = r32; asm volatile("" : "+v"(rv));
    const char* kb = Ks + rv * 256; const int swz = ((rv & 7) << 4) ^ (hi * 16);
#pragma unroll
    for (int d0 = 0; d0 < 8; ++d0) { const char* ka = kb + ((d0 * 32) ^ swz);
        const bf16x8 b0 = *reinterpret_cast<const bf16x8*>(ka);
        const bf16x8 b1 = *reinterpret_cast<const bf16x8*>(ka + 8192);
        p0 = __builtin_amdgcn_mfma_f32_32x32x16_bf16(b0, qr[d0], p0, 0, 0, 0);
        p1 = __builtin_amdgcn_mfma_f32_32x32x16_bf16(b1, qr[d0], p1, 0, 0, 0); }
}
__device__ __forceinline__ void attn_item(Frame& F, int b, int q0, char* lds) {
    const bf16_t* Q = (const bf16_t*)(F.ws + WS_Q); const bf16_t* KV = (const bf16_t*)(F.outb + OUT_KV); const u64* MASK = (const u64*)(F.outb + OUT_MASK);
    bf16_t* OA = (bf16_t*)(F.outb + OUT_OA);
    int tid = F.tid; asm volatile("" : "+v"(tid));
    const int wid = F.wave, lane = tid & 63, r32 = lane & 31, hi = lane >> 5;
    char* V_lds = lds + OFF_V; char* K_lds = lds + OFF_K;
    float* wsl = (float*)(lds + OFF_WS) + wid * 64; float* li_l = wsl; float* al_l = wsl + 32;
    const float* btab = (const float*)(lds + OFF_BT);
    constexpr float C = 0.088388347648318440f * LOG2E;
    float m_reg = -1e30f, l_reg = 0.f; f32x16 o[4] = {}; bf16x8 qr[8];
    const size_t tokq = (size_t)b * SEQ + q0 + r32;
    { const bf16_t* Qw = Q + tokq * 1024 + wid * 128 + hi * 8;
#pragma unroll
      for (int d0 = 0; d0 < 8; ++d0) qr[d0] = *(const bf16x8*)(Qw + d0 * 16); }
    const u64* mq = MASK + tokq * 32;
    const int sr = tid >> 4, sc = (tid & 15) * 8;
    const int vb0 = (int)(uintptr_t)V_lds + v_rd_base(lane);
    const bf16_t* Kb = KV + (size_t)b * SEQ * 128;
    const int NT = (q0 >> 6) + 1;
    const float bfar = btab[wid];
    bf16x8 s0, s1;
#define SLOAD(k0) do { s0 = *(const bf16x8*)(Kb + (size_t)((k0) + sr) * 128 + sc); s1 = *(const bf16x8*)(Kb + (size_t)((k0) + 32 + sr) * 128 + sc); } while (0)
#define SWRITE(bf) do { int srv = sr; asm volatile("" : "+v"(srv)); const int kc = sc * 2; const int v0a = v_st(srv, sc), k0a = KSWZ(srv, kc); \
        *(bf16x8*)(V_lds + (bf) * SHM_V + v0a) = s0; *(bf16x8*)(V_lds + (bf) * SHM_V + v0a + 8192) = s1; \
        *(bf16x8*)(K_lds + (bf) * SHM_K + k0a) = s0; *(bf16x8*)(K_lds + (bf) * SHM_K + k0a + 8192) = s1; } while (0)
    __syncthreads();
    SLOAD(0); VM_WAIT(); SWRITE(0); __syncthreads();
    u64 mw_next = mq[0];
    for (int j = 0; j < NT; ++j) {
        int lanel = lane; asm volatile("" : "+v"(lanel)); const int r32l = lanel & 31, hil = lanel >> 5;
        const int bf = j & 1;
        if (j + 1 < NT) SLOAD((j + 1) * KVBLK);
        const u64 mw = mw_next; if (j + 1 < NT) mw_next = mq[j + 1];
        f32x16 p0, p1;
        qkt(p0, p1, K_lds + bf * SHM_K, qr, r32l, hil);
        const unsigned w0 = (unsigned)(mw >> (4 * hil)), w1 = (unsigned)(mw >> (32 + 4 * hil));
        const int relmax = j * KVBLK + 63 - q0;
        float alpha = 1.f, ps = 0.f;
        if (relmax <= -91) {
            float pmax = p0[0];
#pragma unroll
            for (int r = 1; r < 16; ++r) pmax = fmaxf(pmax, p0[r]);
#pragma unroll
            for (int r = 0; r < 16; ++r) pmax = fmaxf(pmax, p1[r]);
            { auto rr = __builtin_amdgcn_permlane32_swap(__float_as_uint(pmax), __float_as_uint(pmax), false, false); pmax = fmaxf(__uint_as_float(rr[0]), __uint_as_float(rr[1])); }
            pmax = fmaf(pmax, C, bfar);
            if (!__all(pmax - m_reg <= 11.0f)) { const float mn = fmaxf(m_reg, pmax); alpha = __builtin_amdgcn_exp2f(m_reg - mn); m_reg = mn; }
            const float off = bfar - m_reg;
#pragma unroll
            for (int r = 0; r < 16; ++r) { const int cb = (r & 3) + 8 * (r >> 2);
                const float e0 = __builtin_amdgcn_exp2f(fmaf(p0[r], C, off)), e1 = __builtin_amdgcn_exp2f(fmaf(p1[r], C, off));
                p0[r] = __uint_as_float(__float_as_uint(e0) & (unsigned)__builtin_amdgcn_sbfe((int)w0, cb, 1)); p1[r] = __uint_as_float(__float_as_uint(e1) & (unsigned)__builtin_amdgcn_sbfe((int)w1, cb, 1)); ps += p0[r] + p1[r]; }
        } else {
            const float* bp = btab + (j * KVBLK + 4 * hil - (q0 + r32l) + 185) * 8 + wid;
#pragma unroll
            for (int r4 = 0; r4 < 4; ++r4) {
#pragma unroll
                for (int rr = 0; rr < 4; ++rr) { const int r = r4 * 4 + rr; const int cb = (r & 3) + 8 * (r >> 2); p0[r] = fmaf(p0[r], C, bp[cb * 8]); p1[r] = fmaf(p1[r], C, bp[(cb + 32) * 8]); }
                SBAR(); }
            float pmax = p0[0];
#pragma unroll
            for (int r = 1; r < 16; ++r) pmax = fmaxf(pmax, p0[r]);
#pragma unroll
            for (int r = 0; r < 16; ++r) pmax = fmaxf(pmax, p1[r]);
            { auto rr = __builtin_amdgcn_permlane32_swap(__float_as_uint(pmax), __float_as_uint(pmax), false, false); pmax = fmaxf(__uint_as_float(rr[0]), __uint_as_float(rr[1])); }
            if (!__all(pmax - m_reg <= 11.0f)) { const float mn = fmaxf(m_reg, pmax); alpha = __builtin_amdgcn_exp2f(m_reg - mn); m_reg = mn; }
#pragma unroll
            for (int r = 0; r < 16; ++r) { const int cb = (r & 3) + 8 * (r >> 2);
                const float e0 = __builtin_amdgcn_exp2f(p0[r] - m_reg), e1 = __builtin_amdgcn_exp2f(p1[r] - m_reg);
                p0[r] = __uint_as_float(__float_as_uint(e0) & (unsigned)__builtin_amdgcn_sbfe((int)w0, cb, 1)); p1[r] = __uint_as_float(__float_as_uint(e1) & (unsigned)__builtin_amdgcn_sbfe((int)w1, cb, 1)); ps += p0[r] + p1[r]; }
        }
        { auto rr = __builtin_amdgcn_permlane32_swap(__float_as_uint(ps), __float_as_uint(ps), false, false); ps = __uint_as_float(rr[0]) + __uint_as_float(rr[1]); }
        l_reg = l_reg * alpha + ps;
        bf16x8 pa0, pa1, pa2, pa3;
#define PK4(P, BASE, OUT) do { unsigned a0 = cvt_pk_bf16(P[BASE + 0], P[BASE + 1]), a1 = cvt_pk_bf16(P[BASE + 2], P[BASE + 3]);   \
    unsigned b0 = cvt_pk_bf16(P[BASE + 4], P[BASE + 5]), b1 = cvt_pk_bf16(P[BASE + 6], P[BASE + 7]);                              \
    auto r0 = __builtin_amdgcn_permlane32_swap(a0, b0, false, false); auto r1 = __builtin_amdgcn_permlane32_swap(a1, b1, false, false); \
    u32x4 w = {r0[0], r1[0], r0[1], r1[1]}; OUT = *reinterpret_cast<bf16x8*>(&w); } while (0)
        PK4(p0, 0, pa0); PK4(p0, 8, pa1); PK4(p1, 0, pa2); PK4(p1, 8, pa3);
#undef PK4
        if (__any(alpha < 1.f)) { if (hil == 0) al_l[r32l] = alpha; LDS_WAIT();
#pragma unroll
            for (int d = 0; d < 4; ++d)
#pragma unroll
                for (int r = 0; r < 16; ++r) o[d][r] *= al_l[crow(r, hil)]; }
        const int vb = (int)(uintptr_t)V_lds + v_rd_base(lanel) + bf * SHM_V;
        pv_one<0>(o[0], vb, pa0, pa1, pa2, pa3); pv_one<1>(o[1], vb, pa0, pa1, pa2, pa3); pv_one<2>(o[2], vb, pa0, pa1, pa2, pa3); pv_one<3>(o[3], vb, pa0, pa1, pa2, pa3);
        if (j + 1 < NT) { VM_WAIT(); SWRITE(bf ^ 1); }
        __syncthreads();
    }
#undef SLOAD
#undef SWRITE
    if (hi == 0) li_l[r32] = l_reg; LDS_WAIT();
    bf16_t* Ow = OA + ((size_t)b * SEQ + q0 + 4 * hi) * 1024 + wid * 128 + r32;
    const float* lip = li_l + 4 * hi;
    unsigned char* Ow8 = (unsigned char*)OA + ((size_t)b * SEQ + q0 + 4 * hi) * 1024 + wid * 128 + r32;
    asm volatile("" : "+v"(Ow), "+v"(lip), "+v"(Ow8));
#pragma unroll
    for (int r = 0; r < 16; ++r) { const int ro = (r & 3) + 8 * (r >> 2); if ((r & 3) == 0) asm volatile("" : "+v"(Ow), "+v"(Ow8), "+v"(lip)); const float rl = fast_rcp(lip[ro]);
#pragma unroll
        for (int d0 = 0; d0 < 4; ++d0) { float v = o[d0][r] * rl; if ((DBG_ATTN_ZERO == 1 && q0 < 256) || (DBG_ATTN_ZERO == 2 && q0 >= 256)) v = 0.f;
            if (PA_FP8) ((unsigned char*)Ow8)[ro * 1024 + d0 * 32] = (unsigned char)(__builtin_amdgcn_cvt_pk_fp8_f32(v, v, 0, false) & 0xff);
            else Ow[ro * 1024 + d0 * 32] = (bf16_t)(cvt_pk_bf16(v, v) & 0xffffu); }
        if ((r & 3) == 3) SBAR(); }
}
__device__ __forceinline__ void att2_partial(f32x16& p0, f32x16& p1, float& m_reg, float& alpha, unsigned w0, bool far, float bfar, const float* bp) {
    constexpr float C = 0.088388347648318440f * LOG2E;
    float off;
    if (far) {
        float pmax = p0[0];
#pragma unroll
        for (int r = 1; r < 16; ++r) pmax = fmaxf(pmax, p0[r]);
#pragma unroll
        for (int r = 0; r < 16; ++r) pmax = fmaxf(pmax, p1[r]);
        { auto rr = __builtin_amdgcn_permlane32_swap(__float_as_uint(pmax), __float_as_uint(pmax), false, false); pmax = fmaxf(__uint_as_float(rr[0]), __uint_as_float(rr[1])); }
        pmax = fmaf(pmax, C, bfar);
        if (__builtin_expect(__all(pmax - m_reg <= 11.0f), 1)) alpha = 1.f; else { const float mn = fmaxf(m_reg, pmax); alpha = __builtin_amdgcn_exp2f(m_reg - mn); m_reg = mn; }
        off = bfar - m_reg;
#pragma unroll
        for (int r = 0; r < 16; ++r) { p0[r] = fmaf(p0[r], C, off); p1[r] = fmaf(p1[r], C, off); }
    } else {
#pragma unroll
        for (int r4 = 0; r4 < 4; ++r4) {
#pragma unroll
            for (int rr = 0; rr < 4; ++rr) { const int r = r4 * 4 + rr; const int cb = (r & 3) + 8 * (r >> 2); p0[r] = fmaf(p0[r], C, bp[cb * 8]); p1[r] = fmaf(p1[r], C, bp[(cb + 32) * 8]); }
            SBAR(); }
        float pmax = p0[0];
#pragma unroll
        for (int r = 1; r < 16; ++r) pmax = fmaxf(pmax, p0[r]);
#pragma unroll
        for (int r = 0; r < 16; ++r) pmax = fmaxf(pmax, p1[r]);
        { auto rr = __builtin_amdgcn_permlane32_swap(__float_as_uint(pmax), __float_as_uint(pmax), false, false); pmax = fmaxf(__uint_as_float(rr[0]), __uint_as_float(rr[1])); }
        if (__builtin_expect(__all(pmax - m_reg <= 11.0f), 1)) alpha = 1.f; else { const float mn = fmaxf(m_reg, pmax); alpha = __builtin_amdgcn_exp2f(m_reg - mn); m_reg = mn; }
#pragma unroll
        for (int r = 0; r < 16; ++r) { p0[r] -= m_reg; p1[r] -= m_reg; }
    }
#pragma unroll
    for (int r = 0; r < 16; ++r) { const int cb = (r & 3) + 8 * (r >> 2); p0[r] = __uint_as_float(__float_as_uint(__builtin_amdgcn_exp2f(p0[r])) & (unsigned)__builtin_amdgcn_sbfe((int)w0, cb, 1)); }
}
__device__ __forceinline__ void att2_finish(f32x16& p0, f32x16& p1, float alpha, float& l_reg, unsigned w1, bf16x8& pa0, bf16x8& pa1, bf16x8& pa2, bf16x8& pa3) {
#pragma unroll
    for (int r = 0; r < 16; ++r) { const int cb = (r & 3) + 8 * (r >> 2); p1[r] = __uint_as_float(__float_as_uint(__builtin_amdgcn_exp2f(p1[r])) & (unsigned)__builtin_amdgcn_sbfe((int)w1, cb, 1)); }
    float ps = 0.f;
#pragma unroll
    for (int r = 0; r < 16; ++r) ps += p0[r];
#pragma unroll
    for (int r = 0; r < 16; ++r) ps += p1[r];
    { auto rr = __builtin_amdgcn_permlane32_swap(__float_as_uint(ps), __float_as_uint(ps), false, false); ps = __uint_as_float(rr[0]) + __uint_as_float(rr[1]); }
    l_reg = l_reg * alpha + ps;
#define PK4(P, BASE, OUT) do { unsigned a0 = cvt_pk_bf16(P[BASE + 0], P[BASE + 1]), a1 = cvt_pk_bf16(P[BASE + 2], P[BASE + 3]);   \
    unsigned b0 = cvt_pk_bf16(P[BASE + 4], P[BASE + 5]), b1 = cvt_pk_bf16(P[BASE + 6], P[BASE + 7]);                              \
    auto r0 = __builtin_amdgcn_permlane32_swap(a0, b0, false, false); auto r1 = __builtin_amdgcn_permlane32_swap(a1, b1, false, false); \
    u32x4 w = {r0[0], r1[0], r0[1], r1[1]}; OUT = *reinterpret_cast<bf16x8*>(&w); } while (0)
    PK4(p0, 0, pa0); PK4(p0, 8, pa1); PK4(p1, 0, pa2); PK4(p1, 8, pa3);
#undef PK4
}
__device__ __forceinline__ void attn_item2(Frame& F, int b, int q0, char* lds) {
    const bf16_t* Q = (const bf16_t*)(F.ws + WS_Q); const bf16_t* KV = (const bf16_t*)(F.outb + OUT_KV); const u64* MASK = (const u64*)(F.outb + OUT_MASK);
    bf16_t* OA = (bf16_t*)(F.outb + OUT_OA);
    int tid = F.tid; asm volatile("" : "+v"(tid));
    const int wid = F.wave, lane = tid & 63, r32 = lane & 31, hi = lane >> 5;
    char* V_lds = lds + OFF_V; char* K_lds = lds + OFF_K;
    float* wsl = (float*)(lds + OFF_WS) + wid * 64; float* li_l = wsl; float* al_l = wsl + 32;
    const float* btab = (const float*)(lds + OFF_BT);
    float m_reg = -1e30f, l_reg = 0.f; f32x16 o[4] = {}; bf16x8 qr[8];
    const size_t tokq = (size_t)b * SEQ + q0 + r32;
    { const bf16_t* Qw = Q + tokq * 1024 + wid * 128 + hi * 8;
#pragma unroll
      for (int d0 = 0; d0 < 8; ++d0) qr[d0] = *(const bf16x8*)(Qw + d0 * 16); }
    const u64* mq = MASK + tokq * 32;
    const int sr = tid >> 4, sc = (tid & 15) * 8;
    const bf16_t* Kb = KV + (size_t)b * SEQ * 128;
    const int NTr = (q0 >> 6) + 1, NT = (NTr + 1) & ~1;
    const float bfar = btab[wid];
    bf16x8 sA0, sA1, sB0, sB1;
#define SLD(s0_, s1_, k0) do { int srl = sr; asm volatile("" : "+v"(srl)); const bf16_t* kp_ = Kb + (size_t)((k0) + srl) * 128 + sc; s0_ = *(const bf16x8*)kp_; s1_ = *(const bf16x8*)(kp_ + 32 * 128); } while (0)
#define SWR(bf, s0_, s1_) do { int srv = sr; asm volatile("" : "+v"(srv)); const int kc = sc * 2; const int v0a = v_st(srv, sc), k0a = KSWZ(srv, kc); \
        *(bf16x8*)(V_lds + (bf) * SHM_V + v0a) = s0_; *(bf16x8*)(V_lds + (bf) * SHM_V + v0a + 8192) = s1_; \
        *(bf16x8*)(K_lds + (bf) * SHM_K + k0a) = s0_; *(bf16x8*)(K_lds + (bf) * SHM_K + k0a + 8192) = s1_; } while (0)
#define MWORD(j) ((j) < NTr ? mq[j] : 0ull)
#define RESC(a) do { if (__any((a) < 1.f)) { if (hi == 0) al_l[r32] = (a); LDS_WAIT(); \
        _Pragma("unroll") for (int d = 0; d < 4; ++d) _Pragma("unroll") for (int r = 0; r < 16; ++r) o[d][r] *= al_l[crow(r, hi)]; } } while (0)
#define PVALL(bf) do { int ll = lane; asm volatile("" : "+v"(ll)); const int vb = (int)(uintptr_t)V_lds + v_rd_base(ll) + (bf) * SHM_V; \
        pv_one<0>(o[0], vb, pa0, pa1, pa2, pa3); pv_one<1>(o[1], vb, pa0, pa1, pa2, pa3); pv_one<2>(o[2], vb, pa0, pa1, pa2, pa3); pv_one<3>(o[3], vb, pa0, pa1, pa2, pa3); } while (0)
#define ISFAR(jt) ((jt) * KVBLK + 63 - q0 <= -91 || (jt) >= NTr)
#define BPTR(jt) (btab + ((jt) * KVBLK + 4 * hi - (q0 + r32) + 185) * 8 + wid)
    f32x16 pA0, pA1, pB0, pB1; float alA, alB; bf16x8 pa0, pa1, pa2, pa3; u64 mwA, mwB;
    __syncthreads();
    SLD(sA0, sA1, 0); mwA = MWORD(0); VM_WAIT(); SWR(0, sA0, sA1); __syncthreads();
    qkt(pA0, pA1, K_lds, qr, r32, hi);
    att2_partial(pA0, pA1, m_reg, alA, (unsigned)(mwA >> (4 * hi)), ISFAR(0), bfar, BPTR(0));
    SLD(sB0, sB1, KVBLK); mwB = MWORD(1); if (2 < NT) SLD(sA0, sA1, 2 * KVBLK);
    SWR(1, sB0, sB1); __syncthreads();
    for (int j = 1; j + 1 < NT; j += 2) {
        SBAR(); qkt(pB0, pB1, K_lds + SHM_K, qr, r32, hi);
        att2_finish(pA0, pA1, alA, l_reg, (unsigned)(mwA >> (32 + 4 * hi)), pa0, pa1, pa2, pa3); SBAR();
        SLD(sB0, sB1, (j + 2) * KVBLK); mwA = MWORD(j + 1); SBAR();
        PVALL(0);
        att2_partial(pB0, pB1, m_reg, alB, (unsigned)(mwB >> (4 * hi)), ISFAR(j), bfar, BPTR(j));
        __syncthreads(); SWR(0, sA0, sA1);
        RESC(alB); __syncthreads();
        SBAR(); qkt(pA0, pA1, K_lds, qr, r32, hi);
        att2_finish(pB0, pB1, alB, l_reg, (unsigned)(mwB >> (32 + 4 * hi)), pa0, pa1, pa2, pa3); SBAR();
        if (j + 3 < NT) SLD(sA0, sA1, (j + 3) * KVBLK); mwB = MWORD(j + 2); SBAR();
        PVALL(1);
        att2_partial(pA0, pA1, m_reg, alA, (unsigned)(mwA >> (4 * hi)), ISFAR(j + 1), bfar, BPTR(j + 1));
        __syncthreads(); SWR(1, sB0, sB1);
        RESC(alA); __syncthreads();
    }
    SBAR(); qkt(pB0, pB1, K_lds + SHM_K, qr, r32, hi);
    att2_finish(pA0, pA1, alA, l_reg, (unsigned)(mwA >> (32 + 4 * hi)), pa0, pa1, pa2, pa3); SBAR();
    PVALL(0);
    att2_partial(pB0, pB1, m_reg, alB, (unsigned)(mwB >> (4 * hi)), ISFAR(NT - 1), bfar, BPTR(NT - 1));
    __syncthreads(); RESC(alB);
    att2_finish(pB0, pB1, alB, l_reg, (unsigned)(mwB >> (32 + 4 * hi)), pa0, pa1, pa2, pa3); SBAR();
    PVALL(1);
#undef SLD
#undef SWR
#undef MWORD
#undef RESC
#undef PVALL
#undef ISFAR
#undef BPTR
    LAS float* li_s = (LAS float*)(F.lds + OFF_WS) + wid * 64;
    if (hi == 0) li_s[r32] = l_reg; LDS_WAIT();
    if (PA_FP8 && ATT_OT) {
        LAS unsigned char* ot = F.lds + OFF_OT + wid * (32 * OT_ST);
        int ob = (4 * hi) * OT_ST + r32, lo = 4 * hi; asm volatile("" : "+v"(ob), "+v"(lo));
#pragma unroll
        for (int r = 0; r < 16; ++r) { const int ro = (r & 3) + 8 * (r >> 2); if ((r & 3) == 0) asm volatile("" : "+v"(ob), "+v"(lo)); const float rl = fast_rcp(li_s[lo + ro]);
#pragma unroll
            for (int d0 = 0; d0 < 4; ++d0) { const float v = o[d0][r] * rl; ot[ob + ro * OT_ST + d0 * 32] = (unsigned char)(__builtin_amdgcn_cvt_pk_fp8_f32(v, v, 0, false) & 0xff); }
            if ((r & 3) == 3) SBAR(); }
        LDS_WAIT(); asm volatile("" ::: "memory");
        unsigned char* Og = (unsigned char*)OA + ((size_t)b * SEQ + q0) * 1024 + wid * 128;
        int rr = lane >> 3, sg = (lane & 7) * 16; asm volatile("" : "+v"(rr), "+v"(sg));
#pragma unroll
        for (int i = 0; i < 4; ++i) { const u32x4 w = *(const LAS u32x4*)(ot + (i * 8 + rr) * OT_ST + sg); *(u32x4*)(Og + (size_t)(i * 8 + rr) * 1024 + sg) = w; }
        LDS_WAIT();
    } else if (PA_FP8) {
        GAS unsigned char* Ow8 = (GAS unsigned char*)((unsigned char*)OA + ((size_t)b * SEQ + q0 + 4 * hi) * 1024 + wid * 128 + r32);
        int lo = 4 * hi; asm volatile("" : "+v"(Ow8), "+v"(lo));
#pragma unroll
        for (int r = 0; r < 16; ++r) { const int ro = (r & 3) + 8 * (r >> 2); if ((r & 3) == 0) asm volatile("" : "+v"(Ow8), "+v"(lo)); const float rl = fast_rcp(li_s[lo + ro]);
#pragma unroll
            for (int d0 = 0; d0 < 4; ++d0) { const float v = o[d0][r] * rl; Ow8[ro * 1024 + d0 * 32] = (unsigned char)(__builtin_amdgcn_cvt_pk_fp8_f32(v, v, 0, false) & 0xff); }
            if ((r & 3) == 3) SBAR(); }
    } else {
        bf16_t* Ow = OA + ((size_t)b * SEQ + q0 + 4 * hi) * 1024 + wid * 128 + r32;
        int lo = 4 * hi; asm volatile("" : "+v"(Ow), "+v"(lo));
#pragma unroll
        for (int r = 0; r < 16; ++r) { const int ro = (r & 3) + 8 * (r >> 2); if ((r & 3) == 0) asm volatile("" : "+v"(Ow), "+v"(lo)); const float rl = fast_rcp(li_s[lo + ro]);
#pragma unroll
            for (int d0 = 0; d0 < 4; ++d0) { const float v = o[d0][r] * rl; Ow[ro * 1024 + d0 * 32] = (bf16_t)(cvt_pk_bf16(v, v) & 0xffffu); }
            if ((r & 3) == 3) SBAR(); }
    }
}
}
__device__ __forceinline__ void ph_attn(Frame& F) {
    char* lds = (char*)(unsigned char*)F.lds;
    { float* bt = (float*)(lds + att::OFF_BT); const float* BT = (const float*)(F.ws + WS_BIAST); __syncthreads(); for (int i = F.tid; i < 249 * 8; i += NTHR) bt[i] = BT[i]; __syncthreads(); }
    for (int pr = F.bid; pr < NB * 32; pr += F.G) {
        const int b = pr >> 5, qb = pr & 31;
#pragma nounroll
        for (int hh = 0; hh < 2; ++hh) { if (ATT2) att::attn_item2(F, b, (hh ? qb : 63 - qb) * 32, lds); else att::attn_item(F, b, (hh ? qb : 63 - qb) * 32, lds); }
    }
}

namespace ssd {
constexpr int OFF_CS = 0, CS_ST = 272;
constexpr int OFF_BS = OFF_CS + 64 * CS_ST;
constexpr int OFF_BT = OFF_BS + 64 * CS_ST, T_ST = 144;
constexpr int OFF_XT = OFF_BT + 128 * T_ST;
constexpr int OFF_XW = OFF_XT + 64 * T_ST;
constexpr int OFF_XS = OFF_XW + 64 * T_ST;
constexpr int OFF_MT = OFF_XS + 64 * T_ST;
constexpr int OFF_HS = OFF_MT + 64 * T_ST;
constexpr int OFF_END = OFF_HS + 64 * CS_ST;
static_assert(OFF_END + 5 * 320 * 4 <= 131072, "ssd lds");
__device__ __forceinline__ f32x4 mfma16(bf16x8 a, bf16x8 b, f32x4 c) { return __builtin_amdgcn_mfma_f32_16x16x32_bf16(a, b, c, 0, 0, 0); }
__device__ __forceinline__ bf16x8 ldfrag(const char* base, int stride, int row, int k0) { return *(const bf16x8*)(base + row * stride + k0 * 2); }
}
__device__ __forceinline__ void ph_ssd(Frame& F) {
    using namespace ssd;
    char* lds = (char*)(unsigned char*)F.lds;
    const bf16_t* XBC = (const bf16_t*)(F.ws + WS_XBC); const bf16_t* ZS = (const bf16_t*)(F.ws + WS_Z); const float* DT = (const float*)(F.outb + OUT_DT);
    bf16_t* YG = (bf16_t*)(F.ws + WS_Q);
    const float* conv_w = F.a->in[9]; const float* conv_b = F.a->in[10]; const float* a_log = F.a->in[12]; const float* d_skip = F.a->in[13];
    const int tid = F.tid, wid = F.wave, lane = F.lane, fr = lane & 15, fq = lane >> 4;
    const bool stager = tid < 320; const int so = tid % 40, tg = tid / 40;
    for (int item = F.bid; item < NB * 16; item += F.G) {
        const int b = item >> 4, h = item & 15, g = h >> 2;
        const float aneg = -__expf(a_log[h]), dsk = d_skip[h];
        const int ch0 = so < 8 ? h * 64 + so * 8 : (so < 24 ? 1024 + g * 128 + (so - 8) * 8 : 1536 + g * 128 + (so - 24) * 8);
        float* CWL = (float*)(lds + OFF_END);
        __syncthreads();
        if (stager) {
#pragma unroll
            for (int j = 0; j < 4; ++j) { *(f32x4*)(CWL + j * 320 + so * 8) = *(const f32x4*)(conv_w + (size_t)j * 2048 + ch0); *(f32x4*)(CWL + j * 320 + so * 8 + 4) = *(const f32x4*)(conv_w + (size_t)j * 2048 + ch0 + 4); }
            *(f32x4*)(CWL + 4 * 320 + so * 8) = *(const f32x4*)(conv_b + ch0); *(f32x4*)(CWL + 4 * 320 + so * 8 + 4) = *(const f32x4*)(conv_b + ch0 + 4);
        }
        f32x4 hst[4];
#pragma unroll
        for (int t = 0; t < 4; ++t) hst[t] = (f32x4){0.f, 0.f, 0.f, 0.f};
        __syncthreads();
        for (int i = tid; i < 64 * CS_ST / 4; i += NTHR) ((unsigned*)(lds + OFF_HS))[i] = 0u;
        u32x4 raw[11];
        const size_t tokb = (size_t)b * SEQ;
#define SSD_LOAD(c) do { if (stager) { _Pragma("unroll") for (int i = 0; i < 11; ++i) { const int t = (c) * 64 + tg * 8 - 3 + i; \
            raw[i] = (t >= 0) ? *(const u32x4*)(XBC + (tokb + t) * 2048 + ch0) : (u32x4){0u, 0u, 0u, 0u}; } } } while (0)
        SSD_LOAD(0);
        float dtl_next = DT[(tokb + lane) * 16 + h];
        for (int c = 0; c < 32; ++c) {
            const float dtl = dtl_next; if (c + 1 < 32) dtl_next = DT[(tokb + (c + 1) * 64 + lane) * 16 + h];
            u32x2 zpre[2];
#pragma unroll
            for (int t2 = 0; t2 < 2; ++t2) { const int tile = 2 * wid + t2, pb = tile >> 2, lb = tile & 3; zpre[t2] = *(const u32x2*)(ZS + (tokb + c * 64 + lb * 16 + fr) * 1024 + h * 64 + pb * 16 + 4 * fq); }
            float acs = dtl * aneg;
#pragma unroll
            for (int o = 1; o < 64; o <<= 1) { const float t = __shfl_up(acs, o); if (lane >= o) acs += t; }
            const float alast = __shfl(acs, 63);
            if (DBG_SSD_SYNC) __syncthreads();
            float dtv[8], dec[8];
#pragma unroll
            for (int t = 0; t < 8; ++t) { dtv[t] = __shfl(dtl, (tg * 8 + t) & 63); dec[t] = __expf(alast - __shfl(acs, (tg * 8 + t) & 63)); }
            if (stager) {
#pragma unroll
                for (int hq = 0; hq < 2; ++hq) {
                    float xin[11][4];
#pragma unroll
                    for (int i = 0; i < 11; ++i) { const unsigned wa = hq ? raw[i].z : raw[i].x, wb = hq ? raw[i].w : raw[i].y; xin[i][0] = bflo(wa); xin[i][1] = bfhi(wa); xin[i][2] = bflo(wb); xin[i][3] = bfhi(wb); }
                    float outv[8][4];
                    { f32x4 cwv[4]; const f32x4 cbq = *(const f32x4*)(CWL + 4 * 320 + so * 8 + hq * 4);
#pragma unroll
                      for (int j = 0; j < 4; ++j) cwv[j] = *(const f32x4*)(CWL + j * 320 + so * 8 + hq * 4);
#pragma unroll
                      for (int t = 0; t < 8; ++t)
#pragma unroll
                        for (int e = 0; e < 4; ++e) { float sacc = cbq[e];
#pragma unroll
                            for (int j = 0; j < 4; ++j) sacc += cwv[j][e] * xin[t + j][e];
                            outv[t][e] = silu_f(sacc); } }
                    if (so < 8) {
#pragma unroll
                        for (int e = 0; e < 4; ++e) { const int p = so * 8 + hq * 4 + e;
                            f32x4 x0, x1, d0, d1, w0, w1;
#pragma unroll
                            for (int t = 0; t < 4; ++t) { x0[t] = outv[t][e]; x1[t] = outv[4 + t][e]; d0[t] = x0[t] * dtv[t]; d1[t] = x1[t] * dtv[4 + t]; w0[t] = d0[t] * dec[t]; w1[t] = d1[t] * dec[4 + t]; }
                            *(u32x4*)(lds + OFF_XS + p * T_ST + tg * 16) = pack8(x0, x1);
                            *(u32x4*)(lds + OFF_XT + p * T_ST + tg * 16) = pack8(d0, d1);
                            *(u32x4*)(lds + OFF_XW + p * T_ST + tg * 16) = pack8(w0, w1); }
                    } else {
                        const bool isB = so < 24; const int n0 = (isB ? (so - 8) : (so - 24)) * 8 + hq * 4;
                        char* nat = lds + (isB ? OFF_BS : OFF_CS);
#pragma unroll
                        for (int t = 0; t < 8; ++t) { u32x2 w; w.x = cvt_pk_bf16(outv[t][0], outv[t][1]); w.y = cvt_pk_bf16(outv[t][2], outv[t][3]);
                            *(u32x2*)(nat + (tg * 8 + t) * CS_ST + n0 * 2) = w; }
                        if (isB) {
#pragma unroll
                            for (int e = 0; e < 4; ++e) { f32x4 a, bq;
#pragma unroll
                                for (int t = 0; t < 4; ++t) { a[t] = outv[t][e]; bq[t] = outv[4 + t][e]; }
                                *(u32x4*)(lds + OFF_BT + (n0 + e) * T_ST + tg * 16) = pack8(a, bq); }
                        }
                    }
                }
            }
            if (c + 1 < 32) SSD_LOAD(c + 1);
            __syncthreads();
#pragma unroll
            for (int t2 = 0; t2 < 2; ++t2) {
                const int tile = 2 * wid + t2, sb = tile >> 2, lb = tile & 3;
                f32x4 d = (f32x4){0.f, 0.f, 0.f, 0.f};
                if (sb <= lb) {
#pragma unroll
                    for (int ks = 0; ks < 4; ++ks) d = mfma16(ldfrag(lds + OFF_BS, CS_ST, sb * 16 + fr, ks * 32 + fq * 8), ldfrag(lds + OFF_CS, CS_ST, lb * 16 + fr, ks * 32 + fq * 8), d);
                    const int l = lb * 16 + fr; const float al = __shfl(acs, l);
                    f32x4 as;
#pragma unroll
                    for (int r = 0; r < 4; ++r) as[r] = __shfl(acs, sb * 16 + 4 * fq + r);
#pragma unroll
                    for (int r = 0; r < 4; ++r) { const int s = sb * 16 + 4 * fq + r; d[r] = (s <= l) ? d[r] * __expf(al - as[r]) : 0.f; }
                }
                u32x2 w; w.x = cvt_pk_bf16(d[0], d[1]); w.y = cvt_pk_bf16(d[2], d[3]);
                *(u32x2*)(lds + OFF_MT + (lb * 16 + fr) * T_ST + (sb * 16 + 4 * fq) * 2) = w;
            }
            if (DBG_SSD_SYNC) __syncthreads();
            f32x4 yacc[2];
#pragma unroll
            for (int t2 = 0; t2 < 2; ++t2) {
                const int tile = 2 * wid + t2, pb = tile >> 2, lb = tile & 3;
                f32x4 d = (f32x4){0.f, 0.f, 0.f, 0.f};
#pragma unroll
                for (int ks = 0; ks < 4; ++ks) d = mfma16(ldfrag(lds + OFF_HS, CS_ST, pb * 16 + fr, ks * 32 + fq * 8), ldfrag(lds + OFF_CS, CS_ST, lb * 16 + fr, ks * 32 + fq * 8), d);
                const float el = __expf(__shfl(acs, lb * 16 + fr));
                yacc[t2] = d * el;
            }
            __syncthreads();
#pragma unroll
            for (int t2 = 0; t2 < 2; ++t2) {
                const int tile = 2 * wid + t2, pb = tile >> 2, lb = tile & 3;
                f32x4 d = yacc[t2];
#pragma unroll
                for (int ks = 0; ks < 2; ++ks) d = mfma16(ldfrag(lds + OFF_XT, T_ST, pb * 16 + fr, ks * 32 + fq * 8), ldfrag(lds + OFF_MT, T_ST, lb * 16 + fr, ks * 32 + fq * 8), d);
                const int l = lb * 16 + fr, p0 = pb * 16 + 4 * fq; const size_t tok = tokb + c * 64 + l;
                const u32x2 zz = zpre[t2];
                const float z0 = bflo(zz.x), z1 = bfhi(zz.x), z2 = bflo(zz.y), z3 = bfhi(zz.y);
                float xs[4];
#pragma unroll
                for (int r = 0; r < 4; ++r) xs[r] = bflo((unsigned)*(const bf16_t*)(lds + OFF_XS + (p0 + r) * T_ST + l * 2));
                u32x2 w; w.x = cvt_pk_bf16((d[0] + xs[0] * dsk) * z0, (d[1] + xs[1] * dsk) * z1); w.y = cvt_pk_bf16((d[2] + xs[2] * dsk) * z2, (d[3] + xs[3] * dsk) * z3);
                *(u32x2*)(YG + tok * 1024 + h * 64 + p0) = w;
            }
            if (DBG_SSD_SYNC) __syncthreads();
            { const float dc = __expf(alast);
#pragma unroll
              for (int t = 0; t < 4; ++t) { f32x4 d = hst[t] * dc;
#pragma unroll
                  for (int ks = 0; ks < 2; ++ks) d = mfma16(ldfrag(lds + OFF_BT, T_ST, wid * 16 + fr, ks * 32 + fq * 8), ldfrag(lds + OFF_XW, T_ST, t * 16 + fr, ks * 32 + fq * 8), d);
                  hst[t] = d;
                  u32x2 w; w.x = cvt_pk_bf16(d[0], d[1]); w.y = cvt_pk_bf16(d[2], d[3]);
                  *(u32x2*)(lds + OFF_HS + (t * 16 + fr) * CS_ST + (wid * 16 + 4 * fq) * 2) = w; } }
            __syncthreads();
        }
#undef SSD_LOAD
    }
}

namespace ssd2 {
constexpr int CS_ST = 272, T_ST = 144;
constexpr int OFF_CS = 0, OFF_BS = 64 * CS_ST, OFF_BT = 2 * 64 * CS_ST, OFF_H0 = OFF_BT + 128 * T_ST;
constexpr int H_XS = 0, H_XW = 64 * T_ST, H_MT = 2 * 64 * T_ST, H_HS = 3 * 64 * T_ST, H_SZ = H_HS + 64 * CS_ST;
constexpr int OFF_CW = OFF_H0 + 2 * H_SZ;
constexpr int OFF_TAB = OFF_CW + 5 * 384 * 4;
static_assert(OFF_TAB + 6 * 64 * 4 <= LDS_MISC, "ssd2 lds");
}
__device__ __forceinline__ void ph_ssd2(Frame& F, const int abl = 0) {
    using namespace ssd2; using ssd::mfma16; using ssd::ldfrag;
    char* lds = (char*)(unsigned char*)F.lds;
    const bf16_t* XBC = (const bf16_t*)(F.ws + WS_XBC); const bf16_t* ZS = (const bf16_t*)(F.ws + WS_Z); const float* DT = (const float*)(F.outb + OUT_DT);
    bf16_t* YG = (bf16_t*)(F.ws + WS_Q);
    const float* conv_w = F.a->in[9]; const float* conv_b = F.a->in[10]; const float* a_log = F.a->in[12]; const float* d_skip = F.a->in[13];
    const int tid = F.tid, wid = F.wave, lane = F.lane, fr = lane & 15, fq = lane >> 4;
    const int su = tid < 384 ? tid : tid - 128; const bool cwl_writer = true;
    const int cp_lo = __builtin_amdgcn_readfirstlane(tid < 384 ? 0 : 2), cp_hi = __builtin_amdgcn_readfirstlane(tid < 256 ? 4 : (tid < 384 ? 2 : 4));
    const int so = su % 48, tg = su / 48, shd = (so >> 3) & 1;
    for (int item = F.bid; item < NB * 8; item += F.G) {
        const int b = item >> 3, g = (item >> 1) & 3, h0 = g * 4 + (item & 1) * 2;
        const float aneg0 = -__expf(a_log[h0]), aneg1 = -__expf(a_log[h0 + 1]), dsk0 = d_skip[h0], dsk1 = d_skip[h0 + 1];
        const int ch0 = so < 16 ? (h0 + shd) * 64 + (so & 7) * 8 : (so < 32 ? 1024 + g * 128 + (so - 16) * 8 : 1536 + g * 128 + (so - 32) * 8);
        float* CWL = (float*)(lds + OFF_CW);
        __syncthreads();
        if (cwl_writer) {
#pragma unroll
            for (int j = 0; j < 4; ++j) { *(f32x4*)(CWL + j * 384 + so * 8) = *(const f32x4*)(conv_w + (size_t)j * 2048 + ch0); *(f32x4*)(CWL + j * 384 + so * 8 + 4) = *(const f32x4*)(conv_w + (size_t)j * 2048 + ch0 + 4); }
            *(f32x4*)(CWL + 4 * 384 + so * 8) = *(const f32x4*)(conv_b + ch0); *(f32x4*)(CWL + 4 * 384 + so * 8 + 4) = *(const f32x4*)(conv_b + ch0 + 4);
        }
        f32x4 hst[2][4];
#pragma unroll
        for (int hh = 0; hh < 2; ++hh)
#pragma unroll
            for (int t = 0; t < 4; ++t) hst[hh][t] = (f32x4){0.f, 0.f, 0.f, 0.f};
        for (int i = tid; i < 64 * CS_ST / 4; i += NTHR) { ((unsigned*)(lds + OFF_H0 + H_HS))[i] = 0u; ((unsigned*)(lds + OFF_H0 + H_SZ + H_HS))[i] = 0u; }
        u32x4 raw[11];
        const size_t tokb = (size_t)b * SEQ;
        const bf16_t* xrow = XBC + ((ptrdiff_t)tokb + tg * 8 - 3) * 2048 + ch0;
#define SSD_LOAD(c, xp, tgx) do { { _Pragma("unroll") for (int i = 0; i < 11; ++i) { const int t = (c) * 64 + (tgx) * 8 - 3 + i; \
            raw[i] = (t >= 0) ? *(const GAS u32x4*)((xp) + (ptrdiff_t)((c) * 64 + i) * 2048) : (u32x4){0u, 0u, 0u, 0u}; } } } while (0)
        SSD_LOAD(0, xrow, tg);
        f32x2 dtn = *(const f32x2*)(DT + (tokb + lane) * 16 + h0);
        for (int c = 0; c < 32; ++c) {
            int frl = fr, fql = fq, tgl = tg, sol = so; const bf16_t* xrl = xrow; asm volatile("" : "+v"(frl), "+v"(fql), "+v"(tgl), "+v"(sol), "+v"(xrl)); const int shdl = (sol >> 3) & 1;
            const float dtl0 = dtn[0], dtl1 = dtn[1]; if (c + 1 < 32) dtn = *(const f32x2*)(DT + (tokb + (c + 1) * 64 + lane) * 16 + h0);
            u32x2 zpre[2][2];
#pragma unroll
            for (int hh = 0; hh < 2; ++hh)
#pragma unroll
                for (int t2 = 0; t2 < 2; ++t2) { const int tile = 2 * wid + t2, pb = tile >> 2, lb = tile & 3; zpre[hh][t2] = *(const u32x2*)(ZS + (tokb + c * 64 + lb * 16 + frl) * 1024 + (h0 + hh) * 64 + pb * 16 + 4 * fql); }
            const float acs0 = dpp_scan_add(dtl0 * aneg0), acs1 = dpp_scan_add(dtl1 * aneg1);
            const float alast0 = __builtin_bit_cast(float, __builtin_amdgcn_readlane(__builtin_bit_cast(int, acs0), 63)), alast1 = __builtin_bit_cast(float, __builtin_amdgcn_readlane(__builtin_bit_cast(int, acs1), 63));
            float* TAB = (float*)(lds + OFF_TAB);
            TAB[lane] = acs0; TAB[64 + lane] = acs1; TAB[128 + lane] = dtl0; TAB[192 + lane] = dtl1; TAB[256 + lane] = dtl0 * __expf(alast0 - acs0); TAB[320 + lane] = dtl1 * __expf(alast1 - acs1);
            LDS_WAIT(); asm volatile("" ::: "memory");
            float wdt[8];
            { const f32x4 wa = *(const f32x4*)(TAB + 256 + shdl * 64 + tgl * 8), wb = *(const f32x4*)(TAB + 256 + shdl * 64 + tgl * 8 + 4);
#pragma unroll
              for (int t = 0; t < 4; ++t) { wdt[t] = wa[t]; wdt[4 + t] = wb[t]; } }
            if (!(abl & 1)) {
#pragma unroll
                for (int cp = 0; cp < 4; ++cp) {
                    if (cp < cp_lo || cp >= cp_hi) continue;
                    float xin[11][2];
#pragma unroll
                    for (int i = 0; i < 11; ++i) { const unsigned wa = cp == 0 ? raw[i].x : (cp == 1 ? raw[i].y : (cp == 2 ? raw[i].z : raw[i].w)); xin[i][0] = bflo(wa); xin[i][1] = bfhi(wa); }
                    float outv[8][2];
                    { f32x2 cwv[4]; const f32x2 cbq = *(const f32x2*)(CWL + 4 * 384 + sol * 8 + cp * 2);
#pragma unroll
                      for (int j = 0; j < 4; ++j) cwv[j] = *(const f32x2*)(CWL + j * 384 + sol * 8 + cp * 2);
#pragma unroll
                      for (int t = 0; t < 8; ++t)
#pragma unroll
                        for (int e = 0; e < 2; ++e) { float sacc = cbq[e];
#pragma unroll
                            for (int j = 0; j < 4; ++j) sacc += cwv[j][e] * xin[t + j][e];
                            outv[t][e] = silu_f(sacc); } }
                    if (sol < 16) {
                        char* hb = lds + OFF_H0 + shdl * H_SZ;
#pragma unroll
                        for (int e = 0; e < 2; ++e) { const int p = (sol & 7) * 8 + cp * 2 + e;
                            f32x4 x0, x1, w0, w1;
#pragma unroll
                            for (int t = 0; t < 4; ++t) { x0[t] = outv[t][e]; x1[t] = outv[4 + t][e]; w0[t] = x0[t] * wdt[t]; w1[t] = x1[t] * wdt[4 + t]; }
                            *(u32x4*)(hb + H_XS + p * T_ST + tgl * 16) = pack8(x0, x1);
                            *(u32x4*)(hb + H_XW + p * T_ST + tgl * 16) = pack8(w0, w1); }
                    } else {
                        const bool isB = sol < 32; const int n0 = (isB ? (sol - 16) : (sol - 32)) * 8 + cp * 2;
                        char* nat = lds + (isB ? OFF_BS : OFF_CS);
#pragma unroll
                        for (int t = 0; t < 8; ++t) *(unsigned*)(nat + (tgl * 8 + t) * CS_ST + n0 * 2) = cvt_pk_bf16(outv[t][0], outv[t][1]);
                        if (isB) {
#pragma unroll
                            for (int e = 0; e < 2; ++e) { f32x4 a, bq;
#pragma unroll
                                for (int t = 0; t < 4; ++t) { a[t] = outv[t][e]; bq[t] = outv[4 + t][e]; }
                                *(u32x4*)(lds + OFF_BT + (n0 + e) * T_ST + tgl * 16) = pack8(a, bq); }
                        }
                    }
                    SBAR();
                }
            }
            if (c + 1 < 32) SSD_LOAD(c + 1, xrl, tgl);
            __syncthreads();
            bf16x8 cfr[2][4];
#pragma unroll
            for (int t2 = 0; t2 < 2; ++t2)
#pragma unroll
                for (int ks = 0; ks < 4; ++ks) cfr[t2][ks] = ldfrag(lds + OFF_CS, CS_ST, ((2 * wid + t2) & 3) * 16 + frl, ks * 32 + fql * 8);
            if (!(abl & 2))
#pragma unroll
            for (int t2 = 0; t2 < 2; ++t2) {
                const int tile = 2 * wid + t2, sb = tile >> 2, lb = tile & 3;
                f32x4 d = (f32x4){0.f, 0.f, 0.f, 0.f}, m0 = d, m1 = d;
                if (sb <= lb) {
#pragma unroll
                    for (int ks = 0; ks < 4; ++ks) d = mfma16(ldfrag(lds + OFF_BS, CS_ST, sb * 16 + frl, ks * 32 + fql * 8), cfr[t2][ks], d);
                    const int l = lb * 16 + frl, s4 = sb * 16 + 4 * fql; const float al0 = TAB[l], al1 = TAB[64 + l];
                    const f32x4 as0 = *(const f32x4*)(TAB + s4), as1 = *(const f32x4*)(TAB + 64 + s4), ds0 = *(const f32x4*)(TAB + 128 + s4), ds1 = *(const f32x4*)(TAB + 192 + s4);
#pragma unroll
                    for (int r = 0; r < 4; ++r) { const int sidx = s4 + r;
                        m0[r] = (sidx <= l) ? d[r] * __expf(al0 - as0[r]) * ds0[r] : 0.f; m1[r] = (sidx <= l) ? d[r] * __expf(al1 - as1[r]) * ds1[r] : 0.f; }
                }
                u32x2 w; w.x = cvt_pk_bf16(m0[0], m0[1]); w.y = cvt_pk_bf16(m0[2], m0[3]);
                *(u32x2*)(lds + OFF_H0 + H_MT + (lb * 16 + frl) * T_ST + (sb * 16 + 4 * fql) * 2) = w;
                w.x = cvt_pk_bf16(m1[0], m1[1]); w.y = cvt_pk_bf16(m1[2], m1[3]);
                *(u32x2*)(lds + OFF_H0 + H_SZ + H_MT + (lb * 16 + frl) * T_ST + (sb * 16 + 4 * fql) * 2) = w;
            }
            f32x4 yacc[2][2];
#pragma unroll
            for (int hh = 0; hh < 2; ++hh)
#pragma unroll
                for (int t2 = 0; t2 < 2; ++t2) {
                    const int tile = 2 * wid + t2, pb = tile >> 2, lb = tile & 3; const char* hb = lds + OFF_H0 + hh * H_SZ;
                    f32x4 d = (f32x4){0.f, 0.f, 0.f, 0.f};
                    if (!(abl & 2))
#pragma unroll
                    for (int ks = 0; ks < 4; ++ks) d = mfma16(ldfrag(hb + H_HS, CS_ST, pb * 16 + frl, ks * 32 + fql * 8), cfr[t2][ks], d);
                    const float el = __expf(TAB[hh * 64 + lb * 16 + frl]);
                    yacc[hh][t2] = d * el;
                }
            __syncthreads();
            if (!(abl & 4))
#pragma unroll
            for (int hh = 0; hh < 2; ++hh)
#pragma unroll
                for (int t2 = 0; t2 < 2; ++t2) {
                    const int tile = 2 * wid + t2, pb = tile >> 2, lb = tile & 3; const char* hb = lds + OFF_H0 + hh * H_SZ;
                    f32x4 d = yacc[hh][t2];
#pragma unroll
                    for (int ks = 0; ks < 2; ++ks) d = mfma16(ldfrag(hb + H_XS, T_ST, pb * 16 + frl, ks * 32 + fql * 8), ldfrag(hb + H_MT, T_ST, lb * 16 + frl, ks * 32 + fql * 8), d);
                    const int l = lb * 16 + frl, p0 = pb * 16 + 4 * fql; const size_t tok = tokb + c * 64 + l; const float dsk = hh ? dsk1 : dsk0;
                    const u32x2 zz = zpre[hh][t2];
                    const float z0 = bflo(zz.x), z1 = bfhi(zz.x), z2 = bflo(zz.y), z3 = bfhi(zz.y);
                    float xs[4];
#pragma unroll
                    for (int r = 0; r < 4; ++r) xs[r] = bflo((unsigned)*(const bf16_t*)(hb + H_XS + (p0 + r) * T_ST + l * 2));
                    u32x2 w; w.x = cvt_pk_bf16((d[0] + xs[0] * dsk) * z0, (d[1] + xs[1] * dsk) * z1); w.y = cvt_pk_bf16((d[2] + xs[2] * dsk) * z2, (d[3] + xs[3] * dsk) * z3);
                    *(u32x2*)(YG + tok * 1024 + (h0 + hh) * 64 + p0) = w;
                }
            const bf16x8 btf0 = ldfrag(lds + OFF_BT, T_ST, wid * 16 + frl, fql * 8), btf1 = ldfrag(lds + OFF_BT, T_ST, wid * 16 + frl, 32 + fql * 8);
            if (!(abl & 8))
#pragma unroll
            for (int hh = 0; hh < 2; ++hh) { const float dc = __expf(hh ? alast1 : alast0); char* hb = lds + OFF_H0 + hh * H_SZ;
#pragma unroll
                for (int t = 0; t < 4; ++t) { f32x4 d = hst[hh][t] * dc;
#pragma unroll
                    for (int ks = 0; ks < 2; ++ks) d = mfma16(ks ? btf1 : btf0, ldfrag(hb + H_XW, T_ST, t * 16 + frl, ks * 32 + fql * 8), d);
                    hst[hh][t] = d;
                    u32x2 w; w.x = cvt_pk_bf16(d[0], d[1]); w.y = cvt_pk_bf16(d[2], d[3]);
                    *(u32x2*)(hb + H_HS + (t * 16 + frl) * CS_ST + (wid * 16 + 4 * fql) * 2) = w; } }
            __syncthreads();
        }
#undef SSD_LOAD
    }
}

__device__ __forceinline__ void ph_gnorm(Frame& F) {
    bf16_t* YG = (bf16_t*)(F.ws + WS_Q);
    const int gw = F.bid * NWAVES + F.wave, NGW = F.G * NWAVES;
    constexpr int RB = 4;
    for (int m0 = gw * RB; m0 < NTOK; m0 += NGW * RB) {
        u32x2 w[RB][4];
#pragma unroll
        for (int r = 0; r < RB; ++r) { const u32x2* rp = (const u32x2*)(YG + (size_t)(m0 + r) * D) + F.lane;
#pragma unroll
            for (int j = 0; j < 4; ++j) w[r][j] = rp[64 * j]; }
#pragma unroll
        for (int r = 0; r < RB; ++r) { const int m = m0 + r; u32x2* rp = (u32x2*)(YG + (size_t)m * D) + F.lane;
#pragma unroll
            for (int j = 0; j < 4; ++j) { const float a = bflo(w[r][j].x), b = bfhi(w[r][j].x), c = bflo(w[r][j].y), d = bfhi(w[r][j].y);
                const float ss = wave_sum(a * a + b * b + c * c + d * d); const float rr = 1.f / sqrtf(ss * (1.f / 256.f) + LN_EPS);
                if (PB_FP8) { int pk = 0; pk = __builtin_amdgcn_cvt_pk_fp8_f32(a * rr, b * rr, pk, false); pk = __builtin_amdgcn_cvt_pk_fp8_f32(c * rr, d * rr, pk, true); ((unsigned*)(F.outb + OUT_OB8 + (size_t)m * D))[F.lane + 64 * j] = (unsigned)pk; }
                else { u32x2 o; o.x = cvt_pk_bf16(a * rr, b * rr); o.y = cvt_pk_bf16(c * rr, d * rr); rp[64 * j] = o; } } }
    }
}

template <bool DRY = false> __device__ __forceinline__ void ph_router(Frame& F) {
    const bf16_t* VB = (const bf16_t*)(F.ws + WS_VB); bf16_t* X1B = (bf16_t*)(F.ws + WS_X1B); bf16_t* U2 = (bf16_t*)(F.ws + WS_U2); const float* MOD = (const float*)(F.ws + WS_MOD);
    const float* ln1g = F.a->in[18]; const float* ln1b = F.a->in[19]; const float* w_router = F.a->in[20]; const float* b_router = F.a->in[21];
    u32x2* REG = (u32x2*)(F.ws + WS_REG); unsigned* CNT = (unsigned*)(F.ws + WS_CTL) + CW_CNT;
    constexpr int TST = 2064;
    LAS unsigned char* THI = F.lds; LAS unsigned char* TLO = F.lds + 16 * TST; LAS float* PART = (LAS float*)(F.lds + 32 * TST);
    LAS unsigned* lcnt = (LAS unsigned*)(F.lds + LDS_AUX); LAS unsigned* lbase = lcnt + 32; LAS unsigned* ent = lcnt + 64;
    const int tid = F.tid, lane = F.lane, wid = F.wave, fr = lane & 15, fq = lane >> 4;
    bf16x8 whi[4][2], wlo[4][2];
#pragma unroll
    for (int ks = 0; ks < 4; ++ks)
#pragma unroll
        for (int ct = 0; ct < 2; ++ct) { float wv[8];
#pragma unroll
            for (int i = 0; i < 8; ++i) wv[i] = w_router[(size_t)(128 * wid + 32 * ks + 8 * fq + i) * 32 + ct * 16 + fr];
            u32x4 h, l2;
#pragma unroll
            for (int i = 0; i < 4; ++i) { const unsigned hp = cvt_pk_bf16(wv[2 * i], wv[2 * i + 1]); const float r0 = wv[2 * i] - bflo(hp), r1 = wv[2 * i + 1] - bfhi(hp); h[i] = hp; l2[i] = cvt_pk_bf16(r0, r1); }
            whi[ks][ct] = __builtin_bit_cast(bf16x8, h); wlo[ks][ct] = __builtin_bit_cast(bf16x8, l2); }
    const float brl = b_router[lane & 31];
    for (int batch = F.bid; batch < NTOK / 256; batch += F.G) {
        const int hf = batch >> 7;
        __syncthreads();
        if (tid < 32) lcnt[tid] = 0u;
        for (int grp = 0; grp < 16; ++grp) {
#pragma unroll
            for (int tt = 0; tt < 2; ++tt) {
                const int tg16 = 2 * wid + tt, m = batch * 256 + grp * 16 + tg16; const float* md = MOD + (size_t)(m >> 11) * 6144;
                const u32x2* vr = (const u32x2*)(VB + (size_t)m * D) + lane; u32x2* xr = (u32x2*)(X1B + (size_t)m * D) + lane;
                f32x4 v[4]; float s = 0.f;
#pragma unroll
                for (int j = 0; j < 4; ++j) { const u32x2 w = vr[64 * j]; v[j] = (f32x4){bflo(w.x), bfhi(w.x), bflo(w.y), bfhi(w.y)}; s += (v[j][0] + v[j][1]) + (v[j][2] + v[j][3]); }
                float mean = wave_sum(s) * (1.f / D), s2 = 0.f;
#pragma unroll
                for (int j = 0; j < 4; ++j) { v[j] = v[j] - mean; s2 += (v[j][0] * v[j][0] + v[j][1] * v[j][1]) + (v[j][2] * v[j][2] + v[j][3] * v[j][3]); }
                float rstd = 1.f / sqrtf(wave_sum(s2) * (1.f / D) + LN_EPS);
                s = 0.f;
#pragma unroll
                for (int j = 0; j < 4; ++j) { const f32x4 g = *((const f32x4*)ln1g + lane + 64 * j), bb = *((const f32x4*)ln1b + lane + 64 * j); v[j] = v[j] * rstd * g + bb; if (!DRY) { u32x2 w; w.x = cvt_pk_bf16(v[j][0], v[j][1]); w.y = cvt_pk_bf16(v[j][2], v[j][3]); xr[64 * j] = w; } s += (v[j][0] + v[j][1]) + (v[j][2] + v[j][3]); }
                mean = wave_sum(s) * (1.f / D); s2 = 0.f;
#pragma unroll
                for (int j = 0; j < 4; ++j) { v[j] = v[j] - mean; s2 += (v[j][0] * v[j][0] + v[j][1] * v[j][1]) + (v[j][2] * v[j][2] + v[j][3] * v[j][3]); }
                rstd = 1.f / sqrtf(wave_sum(s2) * (1.f / D) + LN_EPS);
                u32x2* o8 = (u32x2*)(U2 + (size_t)m * D) + lane;
#pragma unroll
                for (int j = 0; j < 4; ++j) { const f32x4 sh = *((const f32x4*)(md + 3072) + lane + 64 * j), sc = *((const f32x4*)(md + 4096) + lane + 64 * j);
                    v[j] = v[j] * rstd * (sc + 1.0f) + sh; u32x2 w; w.x = cvt_pk_bf16(v[j][0], v[j][1]); w.y = cvt_pk_bf16(v[j][2], v[j][3]);
                    if (DRY) { if (w.x == 0x12345678u) o8[64 * j] = w; }
                    else if (MOE_FP8) { int pk = 0; pk = __builtin_amdgcn_cvt_pk_fp8_f32(v[j][0], v[j][1], pk, false); pk = __builtin_amdgcn_cvt_pk_fp8_f32(v[j][2], v[j][3], pk, true); ((unsigned*)((unsigned char*)U2 + (size_t)m * D))[lane + 64 * j] = (unsigned)pk; }
                    else o8[64 * j] = w;
                    u32x2 lo; lo.x = cvt_pk_bf16(v[j][0] - bflo(w.x), v[j][1] - bfhi(w.x)); lo.y = cvt_pk_bf16(v[j][2] - bflo(w.y), v[j][3] - bfhi(w.y));
                    *(LAS u32x2*)(THI + tg16 * TST + (4 * lane + 256 * j) * 2) = w; *(LAS u32x2*)(TLO + tg16 * TST + (4 * lane + 256 * j) * 2) = lo; }
            }
            __syncthreads();
            { f32x4 a0 = (f32x4){0.f, 0.f, 0.f, 0.f}, a1 = a0;
#pragma unroll
              for (int ks = 0; ks < 4; ++ks) { const int cb = (128 * wid + 32 * ks + 8 * fq) * 2;
                  const bf16x8 th = *(const LAS bf16x8*)(THI + fr * TST + cb), tl = *(const LAS bf16x8*)(TLO + fr * TST + cb);
                  a0 = __builtin_amdgcn_mfma_f32_16x16x32_bf16(whi[ks][0], th, a0, 0, 0, 0); a1 = __builtin_amdgcn_mfma_f32_16x16x32_bf16(whi[ks][1], th, a1, 0, 0, 0);
                  a0 = __builtin_amdgcn_mfma_f32_16x16x32_bf16(wlo[ks][0], th, a0, 0, 0, 0); a1 = __builtin_amdgcn_mfma_f32_16x16x32_bf16(wlo[ks][1], th, a1, 0, 0, 0);
                  a0 = __builtin_amdgcn_mfma_f32_16x16x32_bf16(whi[ks][0], tl, a0, 0, 0, 0); a1 = __builtin_amdgcn_mfma_f32_16x16x32_bf16(whi[ks][1], tl, a1, 0, 0, 0); }
              *(LAS f32x4*)(PART + (wid * 16 + fr) * 32 + 4 * fq) = a0; *(LAS f32x4*)(PART + (wid * 16 + fr) * 32 + 16 + 4 * fq) = a1; }
            __syncthreads();
            { const int tg16 = 2 * wid + (lane >> 5), tl = grp * 16 + tg16, myexp = lane & 31;
              float logit = brl;
#pragma unroll
              for (int w8 = 0; w8 < 8; ++w8) logit += PART[(w8 * 16 + tg16) * 32 + myexp];
              float tv[4]; int tix[4];
#pragma unroll
              for (int k = 0; k < 4; ++k) { float bv = logit; int bi = myexp;
#define RT_STEP(ctrl, rm) do { const float ov = __builtin_bit_cast(float, __builtin_amdgcn_update_dpp((int)0xff800000u, __builtin_bit_cast(int, bv), (ctrl), (rm), 0xf, false)); \
                      const int oi = __builtin_amdgcn_update_dpp(64, bi, (ctrl), (rm), 0xf, false); if (ov > bv || (ov == bv && oi < bi)) { bv = ov; bi = oi; } } while (0)
                  RT_STEP(0x111, 0xf); RT_STEP(0x112, 0xf); RT_STEP(0x114, 0xf); RT_STEP(0x118, 0xf); RT_STEP(0x142, 0xa);
#undef RT_STEP
                  { const int b0 = __builtin_amdgcn_readlane(__builtin_bit_cast(int, bv), 31), b1 = __builtin_amdgcn_readlane(__builtin_bit_cast(int, bv), 63), i0 = __builtin_amdgcn_readlane(bi, 31), i1 = __builtin_amdgcn_readlane(bi, 63);
                    bv = __builtin_bit_cast(float, lane < 32 ? b0 : b1); bi = lane < 32 ? i0 : i1; }
                  tv[k] = bv; tix[k] = bi; if (myexp == bi) logit = -INFINITY; }
              const float e1 = __expf(tv[1] - tv[0]), e2 = __expf(tv[2] - tv[0]), e3 = __expf(tv[3] - tv[0]); const float inv = 1.f / (1.f + e1 + e2 + e3);
              if (myexp < 4) { const int ee = myexp == 0 ? tix[0] : (myexp == 1 ? tix[1] : (myexp == 2 ? tix[2] : tix[3])); const float gg = (myexp == 0 ? 1.f : (myexp == 1 ? e1 : (myexp == 2 ? e2 : e3))) * inv;
                  const unsigned lp = atomicAdd((unsigned*)&lcnt[ee], 1u);
                  LAS unsigned* en = ent + (tl * 4 + myexp) * 3; en[0] = (unsigned)ee; en[1] = lp; en[2] = __float_as_uint(gg);
                  if (DBG_CHECK == 1) { u32x2 rw; rw.x = (unsigned)ee; rw.y = __float_as_uint(gg); ((u32x2*)(F.ws + WS_DBG))[(size_t)(batch * 256 + tl) * 4 + myexp] = rw; } } }
        }
        __syncthreads();
        if (tid < 32) lbase[tid] = DRY ? 0u : __hip_atomic_fetch_add(CNT + 64 * (hf * 32 + tid), lcnt[tid], __ATOMIC_RELAXED, __HIP_MEMORY_SCOPE_AGENT);
        __syncthreads();
        for (int i = tid; i < 1024; i += NTHR) { const LAS unsigned* en = ent + i * 3; const unsigned ee = en[0], pos = lbase[ee] + en[1];
            const unsigned tokl = (unsigned)(batch * 256 + (i >> 2)) - (unsigned)hf * HALF_TOK;
            u32x2 w; w.x = tokl * 4u + (unsigned)(i & 3); w.y = en[2];
            if (!DRY && pos < (unsigned)REG_CAP) REG[((size_t)hf * 32 + ee) * REG_CAP + pos] = w; }
    }
}

template <bool DRY = false> __device__ __forceinline__ void ph_final(Frame& F, int hf) {
    float* OUT = (float*)F.outb; const bf16_t* X1B = (const bf16_t*)(F.ws + WS_X1B); const bf16_t* YB = (const bf16_t*)(F.ws + WS_YB); const float* MOD = (const float*)(F.ws + WS_MOD);
    const float* g2 = F.a->in[26]; const float* b2 = F.a->in[27];
    const int gw = F.bid * NWAVES + F.wave, NGW = F.G * NWAVES, lane = F.lane;
    constexpr int RB = 2;
    for (int tl0 = gw; tl0 < HALF_TOK; tl0 += NGW * RB) {
        u32x2 xw[RB][4]; u32x2 yw[RB][4][4];
#pragma unroll
        for (int r = 0; r < RB; ++r) { const int tl = tl0 + r * NGW, m = hf * HALF_TOK + tl;
            const u32x2* xr = (const u32x2*)(X1B + (size_t)m * D) + lane; const u32x2* yr = (const u32x2*)(YB + (size_t)tl * 4 * D) + lane;
#pragma unroll
            for (int j = 0; j < 4; ++j) { xw[r][j] = xr[64 * j];
#pragma unroll
                for (int k = 0; k < 4; ++k) yw[r][j][k] = yr[k * 256 + 64 * j]; } }
#pragma unroll
        for (int r = 0; r < RB; ++r) { const int tl = tl0 + r * NGW, m = hf * HALF_TOK + tl; const float* md = MOD + (size_t)(m >> 11) * 6144 + 5120;
            f32x4* xr = (f32x4*)(OUT + (size_t)m * D) + lane;
            f32x4 v[4]; float s = 0.f;
#pragma unroll
            for (int j = 0; j < 4; ++j) { f32x4 y = (f32x4){0.f, 0.f, 0.f, 0.f};
#pragma unroll
                for (int k = 0; k < 4; ++k) { const u32x2 w = yw[r][j][k]; y[0] += bflo(w.x); y[1] += bfhi(w.x); y[2] += bflo(w.y); y[3] += bfhi(w.y); }
                if (DBG_NO_MOE) y = (f32x4){0.f, 0.f, 0.f, 0.f};
                const f32x4 gt = *((const f32x4*)md + lane + 64 * j);
                const f32x4 x1v = (f32x4){bflo(xw[r][j].x), bfhi(xw[r][j].x), bflo(xw[r][j].y), bfhi(xw[r][j].y)};
                v[j] = x1v * DN_ALPHA + gt * y; s += (v[j][0] + v[j][1]) + (v[j][2] + v[j][3]); }
            const float mean = wave_sum(s) * (1.f / D); float s2 = 0.f;
#pragma unroll
            for (int j = 0; j < 4; ++j) { v[j] = v[j] - mean; s2 += (v[j][0] * v[j][0] + v[j][1] * v[j][1]) + (v[j][2] * v[j][2] + v[j][3] * v[j][3]); }
            const float rstd = 1.f / sqrtf(wave_sum(s2) * (1.f / D) + LN_EPS);
#pragma unroll
            for (int j = 0; j < 4; ++j) { const f32x4 g = *((const f32x4*)g2 + lane + 64 * j), bb = *((const f32x4*)b2 + lane + 64 * j); const f32x4 ov = v[j] * rstd * g + bb; if (!DRY || ov[0] == 1.2345e-33f) xr[64 * j] = ov; } }
    }
}

__device__ __forceinline__ float block_sum(Frame& F, float v, LAS float* red) {
    v = wave_sum(v); __syncthreads(); if (F.lane == 0) red[F.wave] = v; __syncthreads();
    float s = 0.f; for (int w = 0; w < NWAVES; ++w) s += red[w]; return s;
}
__device__ __forceinline__ float block_max(Frame& F, float v, LAS float* red) {
#pragma unroll
    for (int o = 1; o < 64; o <<= 1) v = fmaxf(v, __shfl_xor(v, o));
    __syncthreads(); if (F.lane == 0) red[F.wave] = v; __syncthreads();
    float s = 0.f; for (int w = 0; w < NWAVES; ++w) s = fmaxf(s, red[w]); return s;
}
__device__ __forceinline__ void dbg_report(Frame& F, float e) { if (F.tid == 0) atomicMax((unsigned*)(F.ws + WS_CTL) + CW_DBG, __float_as_uint(e)); }
__device__ __forceinline__ void dbg_check_moe(Frame& F) {
    if (F.bid >= 64) return;
    const int tok = HALF_TOK + 509 * F.bid + 3, tokl = tok - HALF_TOK, tid = F.tid;
    LAS float* u2 = (LAS float*)F.lds; LAS float* act = u2 + 1024; LAS float* red = act + 1024; LAS float* lg = red + 16;
    const bf16_t* U2 = (const bf16_t*)(F.ws + WS_U2); const bf16_t* YB = (const bf16_t*)(F.ws + WS_YB); const u32x2* RT = (const u32x2*)(F.ws + WS_DBG);
    const float* w1 = F.a->in[22]; const float* b1 = F.a->in[23]; const float* w2 = F.a->in[24]; const float* b2 = F.a->in[25];
    __syncthreads();
    for (int i = tid; i < 1024; i += NTHR) u2[i] = bflo((unsigned)U2[(size_t)tok * 1024 + i]);
    __syncthreads();
    float y0 = 0.f, y1 = 0.f;
    for (int k = 0; k < 4; ++k) {
        const u32x2 rw = RT[(size_t)tok * 4 + k]; const int e = (int)rw.x; const float g = __uint_as_float(rw.y);
        const float* W1 = w1 + (size_t)e * 1024 * 2048; const float* W2 = w2 + (size_t)e * 1024 * 1024;
        float h0 = b1[e * 2048 + tid], h1 = b1[e * 2048 + tid + 512], h2 = b1[e * 2048 + tid + 1024], h3 = b1[e * 2048 + tid + 1536];
        for (int c = 0; c < 1024; ++c) { const float uu = u2[c]; const float* wr = W1 + (size_t)c * 2048 + tid; h0 += uu * wr[0]; h1 += uu * wr[512]; h2 += uu * wr[1024]; h3 += uu * wr[1536]; }
        __syncthreads();
        { float gg = fminf(h0, 7.f), up = fminf(fmaxf(h2, -7.f), 7.f); act[tid] = (up + 1.f) * gg / (1.f + expf(-1.702f * gg));
          gg = fminf(h1, 7.f); up = fminf(fmaxf(h3, -7.f), 7.f); act[tid + 512] = (up + 1.f) * gg / (1.f + expf(-1.702f * gg)); }
        __syncthreads();
        float a0 = b2[e * 1024 + tid], a1 = b2[e * 1024 + tid + 512];
        for (int j = 0; j < 1024; ++j) { const float aa = act[j]; a0 += aa * W2[(size_t)j * 1024 + tid]; a1 += aa * W2[(size_t)j * 1024 + tid + 512]; }
        y0 += g * a0; y1 += g * a1;
    }
    float f0 = 0.f, f1 = 0.f;
    for (int k = 0; k < 4; ++k) { f0 += bflo((unsigned)YB[((size_t)tokl * 4 + k) * 1024 + tid]); f1 += bflo((unsigned)YB[((size_t)tokl * 4 + k) * 1024 + tid + 512]); }
    const float rms = sqrtf(block_sum(F, y0 * y0 + y1 * y1, red) * (1.f / 1024.f)) + 1e-20f;
    float err = block_max(F, fmaxf(fabsf(y0 - f0), fabsf(y1 - f1)), red) / rms;
    { const float* X1 = (const float*)F.outb + (size_t)tok * 1024; const float* md = (const float*)(F.ws + WS_MOD) + (size_t)(tok >> 11) * 6144;
      const float xa = X1[tid], xb = X1[tid + 512]; const float mean = block_sum(F, xa + xb, red) * (1.f / 1024.f);
      const float da = xa - mean, db = xb - mean; const float var = block_sum(F, da * da + db * db, red) * (1.f / 1024.f); const float rstd = 1.f / sqrtf(var + LN_EPS);
      __syncthreads();
      u2[tid] = da * rstd * (1.f + md[4096 + tid]) + md[3072 + tid]; u2[tid + 512] = db * rstd * (1.f + md[4096 + tid + 512]) + md[3072 + tid + 512];
      __syncthreads();
      if (tid < 32) { float a = F.a->in[21][tid]; for (int c = 0; c < 1024; ++c) a += u2[c] * F.a->in[20][c * 32 + tid]; lg[tid] = a; }
      __syncthreads();
      if (tid == 0) { unsigned want = 0u, got = 0u; float l2[32]; for (int i = 0; i < 32; ++i) l2[i] = lg[i];
          for (int k = 0; k < 4; ++k) { int bi = 0; for (int i = 1; i < 32; ++i) if (l2[i] > l2[bi]) bi = i; want |= 1u << bi; l2[bi] = -INFINITY; got |= 1u << RT[(size_t)tok * 4 + k].x; }
          lg[32] = (want != got) ? 1.f : 0.f; }
      __syncthreads();
      if (lg[32] != 0.f) err = 50.f; }
    dbg_report(F, err);
}
__device__ __forceinline__ void dbg_check_ssd(Frame& F) {
    if (F.bid >= 2) return;
    const int b = F.bid ? 20 : 5, h = F.bid ? 14 : 3, g = h >> 2, tid = F.tid, p = tid >> 3, ng = tid & 7;
    LAS float* red = (LAS float*)F.lds; LAS float* cv = red + 16;
    const bf16_t* XBC = (const bf16_t*)(F.ws + WS_XBC); const bf16_t* ZS = (const bf16_t*)(F.ws + WS_Z); const float* DT = (const float*)(F.outb + OUT_DT); const bf16_t* YG = (const bf16_t*)(F.ws + WS_Q);
    const float* cw = F.a->in[9]; const float* cb = F.a->in[10]; const float aneg = -expf(F.a->in[12][h]), dsk = F.a->in[13][h];
    const int mych = tid < 64 ? h * 64 + tid : (tid < 192 ? 1024 + g * 128 + (tid - 64) : 1536 + g * 128 + (tid - 192));
    float w0 = 0.f, w1 = 0.f, w2 = 0.f, w3 = 0.f, wb = 0.f;
    if (tid < 320) { w0 = cw[0 * 2048 + mych]; w1 = cw[1 * 2048 + mych]; w2 = cw[2 * 2048 + mych]; w3 = cw[3 * 2048 + mych]; wb = cb[mych]; }
    float x0 = 0.f, x1 = 0.f, x2 = 0.f;
    float hs[16];
#pragma unroll
    for (int i = 0; i < 16; ++i) hs[i] = 0.f;
    float emax = 0.f, ssq = 0.f, nbad = 0.f; int tmax = 0;
    for (int t = 0; t < SEQ; ++t) {
        const size_t tok = (size_t)b * SEQ + t;
        __syncthreads();
        if (DBG_HYP == 1 && (t & 63) == 0) { x0 = 0.f; x1 = 0.f; x2 = 0.f; }
        if (tid < 320) { const float x3 = bflo((unsigned)XBC[tok * 2048 + mych]); const float s = wb + w0 * x0 + w1 * x1 + w2 * x2 + w3 * x3; cv[tid] = s / (1.f + expf(-s)); x0 = x1; x1 = x2; x2 = x3; }
        __syncthreads();
        const float xv = cv[p], dt = DT[tok * 16 + h], dec = expf(dt * aneg);
        float yp = 0.f;
#pragma unroll
        for (int i = 0; i < 16; ++i) { const int n = ng * 16 + i; hs[i] = hs[i] * dec + dt * xv * cv[64 + n]; yp += cv[192 + n] * hs[i]; }
        yp += __shfl_xor(yp, 1); yp += __shfl_xor(yp, 2); yp += __shfl_xor(yp, 4);
        const float yv = (yp + xv * dsk) * bflo((unsigned)ZS[tok * 1024 + h * 64 + p]);
        const float yf = bflo((unsigned)YG[tok * 1024 + h * 64 + p]);
        if (ng == 0) { const float er = fabsf(yv - yf); if (er > emax) { emax = er; tmax = t; } ssq += yv * yv; if (er > 0.25f && (DBG_SUB < 5 || (DBG_SUB == 5 && (t & 63) == 0) || (DBG_SUB == 6 && (t & 63) == 1) || (DBG_SUB == 7 && (t & 63) == 32))) nbad += 1.f; }
    }
    const float rms = sqrtf(block_sum(F, ssq, red) / (64.f * SEQ)) + 1e-20f;
    const float M = block_max(F, emax, red);
    if (DBG_SUB == 0) dbg_report(F, M / rms);
    else if (DBG_SUB == 1) dbg_report(F, block_sum(F, nbad, red) / (64.f * SEQ));
    else if (DBG_SUB >= 5) dbg_report(F, block_sum(F, nbad, red) / (64.f * 32.f));
    else { __syncthreads(); if (ng == 0 && emax == M) red[12] = (float)(DBG_SUB == 2 ? ((tmax & 63) >> 1) : (DBG_SUB == 3 ? (tmax >> 6) : (p >> 1))); __syncthreads();
        if (F.bid == 0) dbg_report(F, powf(10.f, 2.f * (0.05f + 0.05f * red[12]) - 4.f)); }
}
__device__ __forceinline__ void dbg_check_attn(Frame& F) {
    if (F.bid >= 32) return;
    const int b = (F.bid * 7 + 3) & 31, pos = 300 + F.bid * 53, nadm = ((pos >> 6) + 1) * 64, tid = F.tid, lane = F.lane, hd = F.wave;
    const size_t tq = (size_t)b * SEQ + pos;
    LAS float* sc = (LAS float*)F.lds; LAS unsigned char* sel = (LAS unsigned char*)(sc + 2048); LAS float* lgt = (LAS float*)(sel + 2048); LAS float* red = lgt + 8 * 2048; LAS float* misc = red + 16;
    const bf16_t* IQ = (const bf16_t*)(F.outb + OUT_IQ); const bf16_t* IK = (const bf16_t*)(F.outb + OUT_IK); const float* IW = (const float*)(F.outb + OUT_IW);
    const bf16_t* Q = (const bf16_t*)(F.ws + WS_Q); const bf16_t* KV = (const bf16_t*)(F.outb + OUT_KV); const bf16_t* OA = (const bf16_t*)(F.outb + OUT_OA); const u64* MASK = (const u64*)(F.outb + OUT_MASK);
    __syncthreads();
    for (int k = tid; k < nadm; k += NTHR) { float s = 0.f;
        for (int hh = 0; hh < 8; ++hh) { float d = 0.f; for (int c = 0; c < 64; ++c) d += bflo((unsigned)IQ[tq * 512 + hh * 64 + c]) * bflo((unsigned)IK[((size_t)b * SEQ + k) * 64 + c]); s += fmaxf(d, 0.f) * IW[tq * 8 + hh]; }
        sc[k] = s + 0.0f; }
    __syncthreads();
    float nbad = 0.f;
    for (int k = tid; k < nadm; k += NTHR) { const float s = sc[k]; int rank = 0; for (int j = 0; j < nadm; ++j) { const float t = sc[j]; rank += (t > s || (t == s && j < k)) ? 1 : 0; }
        const unsigned char se = rank < 256 ? 1 : 0; sel[k] = se; const unsigned mb = (unsigned)((MASK[tq * 32 + (k >> 6)] >> (k & 63)) & 1ull); if (mb != se) nbad += 1.f; }
    __syncthreads();
    const float nbad_t = block_sum(F, nbad, red);
    LAS float* lw = lgt + hd * 2048; float mx = -INFINITY;
    for (int k = lane; k < nadm; k += 64) { float l = -INFINITY;
        if (sel[k]) { float d = 0.f; for (int c = 0; c < 128; ++c) d += bflo((unsigned)Q[tq * 1024 + hd * 128 + c]) * bflo((unsigned)KV[((size_t)b * SEQ + k) * 128 + c]);
            const int rel = k - pos, n = rel < 0 ? -rel : rel; const float nf = (float)(n > 1 ? n : 1); int large = 8 + (int)(logf(nf / 8.0f) / 2.7725887f * 8.0f); if (large > 15) large = 15;
            const int bucket = (rel > 0 ? 16 : 0) + (n < 8 ? n : large);
            l = d * 0.088388347648318440f + F.a->in[8][bucket * 8 + hd]; }
        lw[k] = l; mx = fmaxf(mx, l); }
#pragma unroll
    for (int o = 1; o < 64; o <<= 1) mx = fmaxf(mx, __shfl_xor(mx, o));
    float den = 0.f;
    for (int k = lane; k < nadm; k += 64) { const float pp = expf(lw[k] - mx); lw[k] = pp; den += pp; }
    den = wave_sum(den);
    float emax = 0.f, ssq = 0.f;
    for (int c2 = 0; c2 < 2; ++c2) { const int c = lane + 64 * c2; float o = 0.f; for (int k = 0; k < nadm; ++k) { const float pp = lw[k]; if (pp != 0.f) o += pp * bflo((unsigned)KV[((size_t)b * SEQ + k) * 128 + c]); }
        o /= den; const float of = bflo((unsigned)OA[tq * 1024 + hd * 128 + c]); emax = fmaxf(emax, fabsf(o - of)); ssq += o * o; }
    const float rms = sqrtf(block_sum(F, ssq, red) * (1.f / 1024.f)) + 1e-20f;
    float err = block_max(F, emax, red) / rms;
    (void)misc;
    if (nbad_t > 0.f) err = 10.f + nbad_t;
    dbg_report(F, err);
}
__device__ __forceinline__ void dbg_emit(Frame& F) {
    float* out = (float*)F.outb;
    for (size_t i = (size_t)F.bid * NTHR + F.tid; i < (size_t)NTOK * D / 4; i += (size_t)F.G * NTHR) ((f32x4*)out)[i] = (f32x4){0.f, 0.f, 0.f, 0.f};
    __syncthreads();
    if (F.bid == 0 && F.tid == 0) { const float e = __uint_as_float(__hip_atomic_load((unsigned*)(F.ws + WS_CTL) + CW_DBG, __ATOMIC_RELAXED, __HIP_MEMORY_SCOPE_AGENT));
        float code = (log10f(fmaxf(e, 1e-30f)) + 4.f) * 0.5f; code = fminf(fmaxf(rintf(code * 20.f) * 0.05f, 0.05f), 3.0f);
        out[0] = sqrtf(67108864.f * 1.01f * (powf(10.f, code) - 1.f)); }
}

#define CLK_BEGIN(k) unsigned long long clk_c##k = 0, clk_r##k = 0; if (DBG_CLOCK == (k) + 1) { clk_c##k = __builtin_amdgcn_s_memtime(); clk_r##k = __builtin_amdgcn_s_memrealtime(); }
#define CLK_END(k) if (DBG_CLOCK == (k) + 1 && F.bid == 0) { const float ghz = (float)(__builtin_amdgcn_s_memtime() - clk_c##k) / (float)(__builtin_amdgcn_s_memrealtime() - clk_r##k) * 0.1f; dbg_report(F, powf(10.f, 2.f * (rintf(ghz * 5.f) * 0.2f) - 4.f)); }
constexpr int NPHASE = 17;
__global__ void __launch_bounds__(NTHR, 2) fwd(Args args) {
    extern __shared__ __attribute__((aligned(16))) unsigned char lds_raw[];
    Frame F;
    F.lds = (LAS unsigned char*)lds_raw;
    F.tid = threadIdx.x; F.lane = F.tid & 63; F.wave = __builtin_amdgcn_readfirstlane(F.tid >> 6); F.G = gridDim.x; F.bid = blockIdx.x;
    F.a = &args;
    F.ws = args.ws; F.outb = (unsigned char*)args.out;
    volatile LAS unsigned* MISCW = (volatile LAS unsigned*)(F.lds + LDS_MISC);
    if (F.tid < 64) MISCW[F.tid] = 0u;
    __syncthreads();
    XcdBarrier bar; bar.bar = (unsigned*)(F.ws + WS_CTL) + CW_BAR; bar.x = 0; bar.st = nullptr;
#if MK_ONE
    bar = xcd_barrier_post((unsigned*)(F.ws + WS_CTL) + CW_BAR, MISCW + 8);
#define GRID_BAR() xcd_barrier(bar)
#else
#define GRID_BAR() do { } while (0)
#endif
    const int lo = args.ph_lo, hi = args.ph_hi;
#ifndef PHM
#define PHM (0xFFFFFFFFu & ~(DBG_NO_ATTN ? 0x30u : 0u) & ~(DBG_NO_SSD ? 0xC0u : 0u))
#endif
#define IN(k) (((PHM >> (k)) & 1u) && lo <= (k) && (k) < hi)
#define SEAM(k) do { if ((k) + 1 < hi) GRID_BAR(); } while (0)

    if (IN(0)) {
#pragma nounroll
        for (int rep = 0; rep < ((DBG_TWICE & 1u) ? 2 : 1); ++rep) { if (rep) GRID_BAR(); ph_prologue(F); }
        SEAM(0); }
    if (IN(1)) {
#pragma nounroll
        for (int rep = 0; rep < ((DBG_TWICE & 2u) ? 2 : 1); ++rep) { if (rep) GRID_BAR(); ph_ln1(F); }
        SEAM(1); }
    CLK_BEGIN(2);
    if (IN(2)) {
        EpiProj E{(bf16_t*)(F.ws + WS_Q), (bf16_t*)(F.outb + OUT_IQ), (bf16_t*)(F.ws + WS_Z), (bf16_t*)(F.ws + WS_XBC), (bf16_t*)(F.ws + WS_GA), (bf16_t*)(F.ws + WS_GB), (float*)(F.outb + OUT_MISC), 1.0f};
#if PROJ_FP8
        { SchedProj<2> S; S.o.init(NTOK, 12 * 256, F.G, F.bid); S.A = (const char*)(F.ws + WS_U8); S.Bt = (const char*)(F.ws + WS_WIN8);
          EpiProj E8 = E; E8.sc = MOE_INV;
          pg8::gemm_phase<EpiProj, SchedProj<2>, false, 512, true>(F.lds, S, E8);
          if (DBG_TWICE & 32768u) { GRID_BAR(); pg8::gemm_phase<EpiProj, SchedProj<2>, false, 512, true>(F.lds, S, E8); } }
        { SchedProj<1> S; S.o.init(NTOK, 15 * 256, F.G, F.bid); S.A = (const char*)(F.outb + OUT_U); S.Bt = (const char*)(F.ws + WS_WIN); if (DBG_KCLK) S.dbgw = (unsigned*)(F.ws + WS_CTL) + CW_DBG;
#if DBG_DRYPROJ
#pragma nounroll
          for (int rep = 0; rep < 2; ++rep) { EpiProj Ed = E; Ed.dry = rep == 0; SchedProj<1> Sd = S; Sd.fold = rep == 0 ? 7 : 0x7fffffff; pg8::gemm_phase<EpiProj, SchedProj<1>, false>(F.lds, Sd, Ed); if (rep == 0) GRID_BAR(); }
#else
          const unsigned long long w0 = DBG_WALL ? __builtin_amdgcn_s_memrealtime() : 0ull;
          pg8::gemm_phase<EpiProj, SchedProj<1>, false>(F.lds, S, E);
          if (DBG_WALL && F.bid == 0) { const float us = (float)(__builtin_amdgcn_s_memrealtime() - w0) * 0.01f; dbg_report(F, powf(10.f, 2.f * (rintf(us / 300.f * 10.f) * 0.1f) - 4.f)); }
#endif
          if (DBG_TWICE & 4u) { GRID_BAR(); pg8::gemm_phase<EpiProj, SchedProj<1>, false>(F.lds, S, E); } }
#else
        { SchedProj<0> S; S.o.init(NTOK, NPROJ, F.G, F.bid); S.A = (const char*)(F.outb + OUT_U); S.Bt = (const char*)(F.ws + WS_WIN);
          pg8::gemm_phase<EpiProj, SchedProj<0>, false>(F.lds, S, E);
          if (DBG_TWICE & 4u) { GRID_BAR(); pg8::gemm_phase<EpiProj, SchedProj<0>, false>(F.lds, S, E); } }
#endif
        SEAM(2);
    }
    CLK_END(2);
    if (IN(3)) { ph_misc(F); if (DBG_TWICE & 8u) { GRID_BAR(); ph_misc(F); } SEAM(3); }
    if (IN(4)) {
#pragma nounroll
        for (int rep = 0; rep < DBG_REP4; ++rep) { if (rep) GRID_BAR(); ph_index(F, rep + 1 < DBG_REP4 ? DBG_ABL4 : 0); }
        SEAM(4); }
    if (IN(5)) { ph_attn(F); if (DBG_TWICE & 32u) { GRID_BAR(); ph_attn(F); } SEAM(5); if (DBG_CHECK == 3) { dbg_check_attn(F); GRID_BAR(); } }
    if (IN(6)) {
#pragma nounroll
        for (int rep = 0; rep < DBG_REP6; ++rep) { if (rep) GRID_BAR(); ph_ssd2(F, rep + 1 < DBG_REP6 ? DBG_ABL6 : 0); }
        SEAM(6); if (DBG_CHECK == 2) { dbg_check_ssd(F); GRID_BAR(); } }
    if (IN(7)) { ph_gnorm(F); if (DBG_TWICE & 128u) { GRID_BAR(); ph_gnorm(F); } SEAM(7); }
    if (IN(8)) {
#if PA_FP8
        SchedPlainT<1024> S; S.o.init(NTOK, 1024, F.G, F.bid); S.A = (const char*)(F.outb + OUT_OA); S.Bt = (const char*)(F.ws + WS_WPA8);
        EpiGate<0> E{(const bf16_t*)(F.ws + WS_GA), nullptr, (bf16_t*)(F.ws + WS_Z), MOE_INV};
        pg8::gemm_phase<EpiGate<0>, SchedPlainT<1024>, false, 512, true>(F.lds, S, E);
#else
        SchedPlain S; S.o.init(NTOK, 1024, F.G, F.bid); S.A = (const char*)(F.outb + OUT_OA); S.Bt = (const char*)(F.ws + WS_WPA);
        EpiGate<0> E{(const bf16_t*)(F.ws + WS_GA), nullptr, (bf16_t*)(F.ws + WS_Z), 1.0f};
        pg8::gemm_phase<EpiGate<0>, SchedPlain, false>(F.lds, S, E);
#endif
    }
    if (IN(9)) {
#if PB_FP8
        SchedPlainT<1024> S; S.o.init(NTOK, 1024, F.G, F.bid); S.A = (const char*)(F.outb + OUT_OB8); S.Bt = (const char*)(F.ws + WS_WPB8);
        EpiGate<1> E{(const bf16_t*)(F.ws + WS_GB), (const bf16_t*)(F.ws + WS_Z), (bf16_t*)(F.ws + WS_XBC), MOE_INV};
        pg8::gemm_phase<EpiGate<1>, SchedPlainT<1024>, false, 512, true>(F.lds, S, E);
#else
        SchedPlain S; S.o.init(NTOK, 1024, F.G, F.bid); S.A = (const char*)(F.ws + WS_Q); S.Bt = (const char*)(F.ws + WS_WPB);
        EpiGate<1> E{(const bf16_t*)(F.ws + WS_GB), (const bf16_t*)(F.ws + WS_Z), (bf16_t*)(F.ws + WS_XBC), 1.0f};
        pg8::gemm_phase<EpiGate<1>, SchedPlain, false>(F.lds, S, E);
#endif
        SEAM(9);
    }
    if (IN(10)) {
        SchedPlain S; S.o.init(NTOK, 1024, F.G, F.bid); S.A = (const char*)(F.ws + WS_XBC); S.Bt = (const char*)(F.ws + WS_WOUT);
        EpiOut E{F.a->in[0], (const float*)(F.ws + WS_MOD), (bf16_t*)(F.ws + WS_VB)};
        pg8::gemm_phase<EpiOut, SchedPlain, false>(F.lds, S, E);
        if (DBG_TWICE & 1024u) { GRID_BAR(); pg8::gemm_phase<EpiOut, SchedPlain, false>(F.lds, S, E); }
        SEAM(10);
    }
    if (IN(11)) { if (DBG_TWICE & 2048u) { ph_router<true>(F); GRID_BAR(); } ph_router<false>(F); SEAM(11); }
#pragma unroll
    for (int hf = 0; hf < 2; ++hf) {
        const int p0 = 12 + hf * 2;
        if (IN(p0)) {
            if (hf == 1) ph_final<false>(F, 0);
            MoeTab T = moe_tables(F, hf);
            SchedMoe<8, true> S{T, F.G, F.bid, hf, (const char*)(F.ws + WS_U2), (const char*)(F.ws + WS_W1), (const u32x2*)(F.ws + WS_REG)};
            EpiMoe1 E{F.a->in[23], (bf16_t*)(F.ws + WS_ACT), 0};
            pg8::gemm_phase<EpiMoe1, SchedMoe<8, true>, true, MOE_RB / 2, MOE_FP8 != 0>(F.lds, S, E);
            if ((DBG_TWICE & 4096u) && hf == 0) { GRID_BAR(); pg8::gemm_phase<EpiMoe1, SchedMoe<8, true>, true, MOE_RB / 2, MOE_FP8 != 0>(F.lds, S, E); }
            if ((DBG_TWICE & 16384u) && hf == 0) { GRID_BAR(); EpiMoe1 Ed = E; Ed.dry = 1; pg8::gemm_phase<EpiMoe1, SchedMoe<8, true>, true, MOE_RB / 2, MOE_FP8 != 0>(F.lds, S, Ed); }
            SEAM(p0);
        }
        if (IN(p0 + 1)) {
            MoeTab T = moe_tables(F, hf);
            SchedMoe<4, false> S{T, F.G, F.bid, hf, (const char*)(F.ws + WS_ACT), (const char*)(F.ws + WS_W2), (const u32x2*)(F.ws + WS_REG)};
            EpiMoe2 E{F.a->in[25], (bf16_t*)(F.ws + WS_YB), (const u32x2*)(F.ws + WS_REG), T, hf, 0};
            if ((DBG_TWICE & 262144u) && hf == 0) { EpiMoe2 Ed = E; Ed.dry = DBG_DRYMODE; pg8::gemm_phase<EpiMoe2, SchedMoe<4, false>, false, MOE_RB / 2, MOE_FP8 != 0>(F.lds, S, Ed); GRID_BAR(); }
            pg8::gemm_phase<EpiMoe2, SchedMoe<4, false>, false, MOE_RB / 2, MOE_FP8 != 0>(F.lds, S, E);
            if ((DBG_TWICE & 8192u) && hf == 0) { GRID_BAR(); pg8::gemm_phase<EpiMoe2, SchedMoe<4, false>, false, MOE_RB / 2, MOE_FP8 != 0>(F.lds, S, E); }
            if ((DBG_TWICE & 131072u) && hf == 0) { GRID_BAR(); EpiMoe2 Ed = E; Ed.dry = 1; pg8::gemm_phase<EpiMoe2, SchedMoe<4, false>, false, MOE_RB / 2, MOE_FP8 != 0>(F.lds, S, Ed); }
            SEAM(p0 + 1);
            if (DBG_CHECK == 1 && hf == 1) { dbg_check_moe(F); GRID_BAR(); }
        }
    }
    if (IN(16)) { if (DBG_TWICE & 65536u) { ph_final<true>(F, 1); GRID_BAR(); } ph_final(F, 1); }
    if (DBG_CHECK || DBG_CLOCK || DBG_KCLK || DBG_WALL) { GRID_BAR(); dbg_emit(F); }
#undef IN
#undef SEAM
}

extern "C" void kernel_launch(void* const* d_in, const int* in_sizes, int n_in, void* d_out, int out_size, void* d_ws, size_t ws_size, hipStream_t stream) {
    static int grid = 0;
    if (grid == 0) {
        if (n_in != 28 || in_sizes[0] != NTOK * D || out_size != NTOK * D || ws_size < WS_END) { fprintf(stderr, "kernel_launch: shape mismatch (n_in %d, in0 %d, out %d, ws %zu)\n", n_in, n_in > 0 ? in_sizes[0] : -1, out_size, ws_size); grid = -1; return; }
        int dev = 0, cus = 0, per_cu = 0;
        if (hipGetDevice(&dev) != hipSuccess || hipDeviceGetAttribute(&cus, hipDeviceAttributeMultiprocessorCount, dev) != hipSuccess) { grid = -1; return; }
        if (hipFuncSetAttribute((const void*)fwd, hipFuncAttributeMaxDynamicSharedMemorySize, LDS_BYTES) != hipSuccess) { fprintf(stderr, "kernel_launch: hipFuncSetAttribute failed\n"); grid = -1; return; }
        if (hipOccupancyMaxActiveBlocksPerMultiprocessor(&per_cu, (const void*)fwd, NTHR, LDS_BYTES) != hipSuccess || per_cu < 1) fprintf(stderr, "kernel_launch: occupancy query reports %d\n", per_cu);
        (void)hipGetLastError();
        grid = cus;
    }
    if (grid < 0) return;
    if (hipMemsetAsync((char*)d_ws + WS_CTL, 0, CTL_ZERO_BYTES, stream) != hipSuccess) { fprintf(stderr, "kernel_launch: memset failed\n"); return; }
    Args a{};
    for (int i = 0; i < 28; ++i) a.in[i] = (const float*)d_in[i];
    a.out = (float*)d_out; a.ws = (unsigned char*)d_ws;
    const int nph = NPHASE < MK_PH_HI ? NPHASE : MK_PH_HI;
#if MK_ONE
    a.ph_lo = 0; a.ph_hi = nph;
    hipLaunchKernelGGL(fwd, dim3(grid), dim3(NTHR), LDS_BYTES, stream, a);
#else
    for (int p = 0; p < nph; ++p) { a.ph_lo = p; a.ph_hi = p + 1; hipLaunchKernelGGL(fwd, dim3(grid), dim3(NTHR), LDS_BYTES, stream, a); }
#endif
    const hipError_t le = hipPeekAtLastError();
    if (le != hipSuccess) fprintf(stderr, "kernel_launch: launch failed: %s\n", hipGetErrorName(le));
}
```

```cpp
#include <hip/hip_runtime.h>
#include <cstdio>
#include <cstdint>

#ifndef MK_ONE
#define MK_ONE 1
#endif
#ifndef DBG_NO_ATTN
#define DBG_NO_ATTN 0
#endif
#ifndef DBG_ATTN_ZERO
#define DBG_ATTN_ZERO 0
#endif
#ifndef DBG_IQ_TRUNC
#define DBG_IQ_TRUNC 0
#endif
#ifndef DBG_ROUTER_BF16
#define DBG_ROUTER_BF16 0
#endif
#ifndef DBG_CHECK
#define DBG_CHECK 0
#endif
#ifndef DBG_SKIP_BODY
#define DBG_SKIP_BODY 0
#endif
#ifndef DBG_SUB
#define DBG_SUB 0
#endif
#ifndef DBG_SSD_SYNC
#define DBG_SSD_SYNC 0
#endif
#ifndef DBG_HYP
#define DBG_HYP 0
#endif
#ifndef DBG_TWICE
#define DBG_DRYPROJ 0
#define DBG_ABL6 0
#define DBG_ABL4 0
#define DBG_REP4 1
#define DBG_REP6 1
#define DBG_WALL 0
#define DBG_KCLK 0
#ifndef DBG_CLOCK
#define DBG_CLOCK 0
#endif
#define DBG_TWICE 0u
#endif
#ifndef DBG_DRYMODE
#define DBG_DRYMODE 2
#endif
#ifndef DBG_NO_SSD
#define DBG_NO_SSD 0
#endif
#ifndef DBG_NO_MOE
#define DBG_NO_MOE 0
#endif
#ifndef MOE_FP8
#define MOE_FP8 1
#endif
#ifndef PROJ_FP8
#define PROJ_FP8 1
#endif
#ifndef PA_FP8
#define PA_FP8 1
#endif
#ifndef PB_FP8
#define PB_FP8 0
#endif
#ifndef ATT2
#define ATT_OT 1
#define ATT2 1
#endif
#ifndef MK_PH_HI
#define MK_PH_HI 99
#endif

#define LAS __attribute__((address_space(3)))
#define GAS __attribute__((address_space(1)))
typedef unsigned short bf16_t;
typedef short bf16x8 __attribute__((ext_vector_type(8)));
typedef short s16x4 __attribute__((ext_vector_type(4)));
typedef float f32x2 __attribute__((ext_vector_type(2)));
typedef float f32x4 __attribute__((ext_vector_type(4)));
typedef float f32x16 __attribute__((ext_vector_type(16)));
typedef unsigned u32x2 __attribute__((ext_vector_type(2)));
typedef unsigned u32x4 __attribute__((ext_vector_type(4)));
typedef unsigned long long u64;

constexpr int NB = 32, SEQ = 2048, D = 1024, NTOK = NB * SEQ;
constexpr int NWAVES = 8, NTHR = 512;
constexpr int NPROJ = 6912;
constexpr int NEXP = 32, HALF_TOK = NTOK / 2, REG_CAP = HALF_TOK;
constexpr int ACT_ROWS = HALF_TOK * 4 + NEXP * 256;
constexpr float LN_EPS = 1e-5f;
constexpr float DN_ALPHA = 1.189207115002721f;
constexpr float LOG2E = 1.4426950408889634f;

constexpr size_t MiB = 1u << 20;
constexpr size_t WS_CTL = 0, CTL_ZERO_BYTES = 1 * MiB;
constexpr size_t WS_MOD = 1 * MiB;
constexpr size_t WS_BIAST = 1 * MiB + 800 * 1024;
constexpr size_t WS_WIN = 2 * MiB;
constexpr size_t WS_WPA = 16 * MiB, WS_WPB = 18 * MiB, WS_WOUT = 20 * MiB;
constexpr size_t WS_W1 = 24 * MiB;
constexpr size_t WS_U8 = 88 * MiB;
constexpr size_t WS_W2 = 152 * MiB;
constexpr size_t WS_WIN8 = 184 * MiB;
constexpr size_t WS_WPA8 = 192 * MiB;
constexpr size_t WS_WPB8 = 194 * MiB;
constexpr size_t OUT_OB8 = 192 * MiB;
constexpr size_t WS_Q = 216 * MiB;
constexpr size_t WS_Z = 344 * MiB;
constexpr size_t WS_XBC = 472 * MiB;
constexpr size_t WS_GA = 728 * MiB, WS_GB = 856 * MiB;
constexpr size_t WS_U2 = 216 * MiB;
constexpr size_t WS_REG = 344 * MiB;
constexpr size_t WS_ACT = 360 * MiB;
constexpr size_t WS_YB = 632 * MiB;
constexpr size_t WS_X1B = 496 * MiB;
constexpr size_t WS_VB = 744 * MiB;
constexpr size_t WS_END = 984 * MiB;
constexpr size_t WS_DBG = 889 * MiB;
constexpr size_t OUT_U = 0, OUT_MISC = 128 * MiB, OUT_IQ = 192 * MiB;
constexpr size_t OUT_KV = 0, OUT_IK = 16 * MiB, OUT_IW = 24 * MiB, OUT_DT = 26 * MiB, OUT_MASK = 32 * MiB, OUT_OA = 64 * MiB;
constexpr int CW_BAR = 4096, CW_CNT = 16384, CW_WQ = 22528, CW_DBG = 24576;

constexpr int LDS_BYTES = 160 * 1024;
constexpr int LDS_AUX = 131072;
constexpr int LDS_MISC = LDS_BYTES - 256;

#define LDS_WAIT() asm volatile("s_waitcnt lgkmcnt(0)" ::: "memory")
#define GAS __attribute__((address_space(1)))
#define VM_WAIT() asm volatile("s_waitcnt vmcnt(0)" ::: "memory")
#define SBAR() __builtin_amdgcn_sched_barrier(0)
typedef __bf16 bf16x2_t __attribute__((ext_vector_type(2)));
__device__ __forceinline__ unsigned cvt_pk_bf16(float lo, float hi) { f32x2 f = {lo, hi}; bf16x2_t v = __builtin_convertvector(f, bf16x2_t); return __builtin_bit_cast(unsigned, v); }
__device__ __forceinline__ float bflo(unsigned w) { return __uint_as_float(w << 16); }
__device__ __forceinline__ float bfhi(unsigned w) { return __uint_as_float(w & 0xffff0000u); }
__device__ __forceinline__ u32x4 pack8(f32x4 a, f32x4 b) { u32x4 w; w.x = cvt_pk_bf16(a[0], a[1]); w.y = cvt_pk_bf16(a[2], a[3]); w.z = cvt_pk_bf16(b[0], b[1]); w.w = cvt_pk_bf16(b[2], b[3]); return w; }
constexpr int MOE_RB = MOE_FP8 ? 1024 : 2048;
constexpr float MOE_WSC = MOE_FP8 ? 64.0f : 1.0f, MOE_INV = 1.0f / MOE_WSC;
__device__ __forceinline__ u32x2 pack8_fp8(f32x4 a, f32x4 b) { int lo = 0, hi = 0;
    lo = __builtin_amdgcn_cvt_pk_fp8_f32(a[0], a[1], lo, false); lo = __builtin_amdgcn_cvt_pk_fp8_f32(a[2], a[3], lo, true);
    hi = __builtin_amdgcn_cvt_pk_fp8_f32(b[0], b[1], hi, false); hi = __builtin_amdgcn_cvt_pk_fp8_f32(b[2], b[3], hi, true);
    u32x2 r; r.x = (unsigned)lo; r.y = (unsigned)hi; return r; }
__device__ __forceinline__ void unpack8(u32x4 w, f32x4& a, f32x4& b) { a[0] = bflo(w.x); a[1] = bfhi(w.x); a[2] = bflo(w.y); a[3] = bfhi(w.y); b[0] = bflo(w.z); b[1] = bfhi(w.z); b[2] = bflo(w.w); b[3] = bfhi(w.w); }
__device__ __forceinline__ float dpp_scan_add(float v) {
#define DPPF(x, ctrl, rm) __builtin_bit_cast(float, __builtin_amdgcn_update_dpp(0, __builtin_bit_cast(int, (x)), (ctrl), (rm), 0xf, false))
    v += DPPF(v, 0x111, 0xf); v += DPPF(v, 0x112, 0xf); v += DPPF(v, 0x114, 0xf); v += DPPF(v, 0x118, 0xf);
    v += DPPF(v, 0x142, 0xa);
    v += DPPF(v, 0x143, 0xc);
#undef DPPF
    return v;
}
__device__ __forceinline__ unsigned dpp_half_sums_u32(unsigned v) {
#define DPPU(x, ctrl, rm) (unsigned)__builtin_amdgcn_update_dpp(0, (int)(x), (ctrl), (rm), 0xf, false)
    v += DPPU(v, 0x111, 0xf); v += DPPU(v, 0x112, 0xf); v += DPPU(v, 0x114, 0xf); v += DPPU(v, 0x118, 0xf); v += DPPU(v, 0x142, 0xa);
#undef DPPU
    return v;
}
__device__ __forceinline__ float dpp_half_sums_f32(float v) {
#define DPPF(x, ctrl, rm) __builtin_bit_cast(float, __builtin_amdgcn_update_dpp(0, __builtin_bit_cast(int, (x)), (ctrl), (rm), 0xf, false))
    v += DPPF(v, 0x111, 0xf); v += DPPF(v, 0x112, 0xf); v += DPPF(v, 0x114, 0xf); v += DPPF(v, 0x118, 0xf); v += DPPF(v, 0x142, 0xa);
#undef DPPF
    return v;
}
__device__ __forceinline__ float wave_sum(float v) { v = dpp_scan_add(v); return __builtin_bit_cast(float, __builtin_amdgcn_readlane(__builtin_bit_cast(int, v), 63)); }
__device__ __forceinline__ float fast_rcp(float x) { return __builtin_amdgcn_rcpf(x); }
__device__ __forceinline__ float sigmoid_f(float x) { return fast_rcp(1.0f + __expf(-x)); }
__device__ __forceinline__ float silu_f(float x) { return x * sigmoid_f(x); }

#define XB_TMO      128
#define XB_XCNT(j)  (256  + 64 * (j))
#define XB_XSUB(j)  (1280 + 64 * (j))
#define XB_XGEN(j)  (2304 + 64 * (j))
#define XB_TOP      3328
#define XB_TOPGEN   3392
#define XCD_BAR_WORDS 3456
#define XB_SPIN_CAP (1u << 18)
__device__ __forceinline__ unsigned xb_ld(unsigned* p)              { return __hip_atomic_load(p, __ATOMIC_RELAXED, __HIP_MEMORY_SCOPE_AGENT); }
__device__ __forceinline__ unsigned xb_add(unsigned* p, unsigned v) { return __hip_atomic_fetch_add(p, v, __ATOMIC_RELAXED, __HIP_MEMORY_SCOPE_AGENT); }
__device__ __forceinline__ unsigned xb_xcc_id() { return (unsigned)__builtin_amdgcn_s_getreg((3 << 11) | 20) & 0xFu; }
#define XB_SPIN(cond, bar) do { unsigned _sp = 0; while (cond) { __builtin_amdgcn_s_sleep(1); \
    if ((++_sp & 255u) == 0u) { if (xb_ld(&(bar)[XB_TMO])) break; if (_sp > XB_SPIN_CAP) { atomicAdd(&(bar)[XB_TMO], 1u); break; } } } } while (0)
struct XcdBarrier { unsigned* bar; unsigned x; volatile LAS unsigned* st; };
__device__ __forceinline__ XcdBarrier xcd_barrier_post(unsigned* bar, volatile LAS unsigned* st) {
    XcdBarrier b; b.bar = bar; b.x = xb_xcc_id(); b.st = st;
    if (threadIdx.x == 0) (void)xb_add(&bar[XB_XCNT(b.x)], 1u);
    return b;
}
__device__ __forceinline__ void xcd_barrier_complete(unsigned* bar, unsigned x, unsigned& nloc, unsigned& nx) {
    const unsigned G = gridDim.x * gridDim.y * gridDim.z;
    unsigned sum, cnt, mine, sp = 0u;
    for (;;) {
        sum = 0u; cnt = 0u;
#pragma nounroll
        for (unsigned j = 0; j < 16; ++j) { const unsigned c = xb_ld(&bar[XB_XCNT(j)]); sum += c; cnt += (c > 0u) ? 1u : 0u; }
        if (sum == G) break;
        __builtin_amdgcn_s_sleep(1);
        if ((++sp & 255u) == 0u) { if (xb_ld(&bar[XB_TMO])) break; if (sp > XB_SPIN_CAP) { atomicAdd(&bar[XB_TMO], 1u); break; } }
    }
    mine = xb_ld(&bar[XB_XCNT(x)]);
    nloc = mine > 0u ? mine : 1u; nx = cnt > 0u ? cnt : 1u;
}
__device__ __forceinline__ void xcd_barrier(const XcdBarrier& b) {
    asm volatile("s_waitcnt vmcnt(0)" ::: "memory");
    __syncthreads();
    if (threadIdx.x == 0) {
        unsigned* bar = b.bar;
        __builtin_amdgcn_s_waitcnt(0);
        unsigned nloc = b.st[0], nx = b.st[1];
        if (nloc == 0u) { xcd_barrier_complete(bar, b.x, nloc, nx); b.st[0] = nloc; b.st[1] = nx; }
        const unsigned old = xb_add(&bar[XB_XSUB(b.x)], 1u);
        const unsigned gen = old / nloc;
        if (old + 1u == (gen + 1u) * nloc) {
            __builtin_amdgcn_fence(__ATOMIC_RELEASE, "agent");
            asm volatile("s_waitcnt vmcnt(0)" ::: "memory");
            const unsigned og = xb_add(&bar[XB_TOP], 1u);
            const unsigned tg = og / nx;
            if (og + 1u == (tg + 1u) * nx) xb_add(&bar[XB_TOPGEN], 1u);
            else XB_SPIN(xb_ld(&bar[XB_TOPGEN]) == tg, bar);
            __builtin_amdgcn_fence(__ATOMIC_ACQUIRE, "agent");
            xb_add(&bar[XB_XGEN(b.x)], 1u);
            asm volatile("s_waitcnt vmcnt(0)" ::: "memory");
        } else {
            XB_SPIN(xb_ld(&bar[XB_XGEN(b.x)]) == gen, bar);
            __builtin_amdgcn_fence(__ATOMIC_ACQUIRE, "agent");
            asm volatile("s_waitcnt vmcnt(0)" ::: "memory");
        }
    }
    __syncthreads();
}

namespace pg8 {
constexpr int BM = 256, BK = 64, HALF = 128, HTB = HALF * BK * 2, STAGE_BYTES = 8 * HTB, NXCD = 8, WGM = 8, KD = 1024;
__host__ __device__ __forceinline__ int lds_byte(int r, int c) { const int st = (r >> 4) * 2 + (c >> 5), rr = r & 15, cc = c & 31, ob = rr * 64 + cc * 2; return st * 1024 + (ob ^ (((ob >> 9) & 1) << 5)); }
__host__ __device__ __forceinline__ void stage_rc(int b, int& R, int& C) { const int st = b / 1024, sb = b % 1024, swz = sb ^ (((sb >> 9) & 1) << 5); R = (st >> 1) * 16 + swz / 64; C = (st & 1) * 32 + (swz % 64) / 2; }
__host__ __device__ __forceinline__ int perm32(int rho) { const int n = rho >> 4, i = rho & 15; return 8 * (i >> 2) + 4 * n + (i & 3); }
struct Unit { int pm, pn, ex; };
struct StaticOrder {
    int nM, nN, nwg, G, c;
    __device__ void init(int M, int N, int G_, int c_) { nM = M / BM; nN = N / BM; nwg = nM * nN; G = G_; c = c_; }
    __device__ bool next(int i, Unit& u) const {
        const long L = (long)i * G + c; if (L >= nwg) return false;
        int wgid = (int)L; { const int q = nwg / NXCD, r = nwg % NXCD, xcd = wgid % NXCD, off = wgid / NXCD; wgid = (xcd < r ? xcd * (q + 1) : r * (q + 1) + (xcd - r) * q) + off; }
        const int nig = WGM * nN, gid = wgid / nig, fm = gid * WGM, gsz = (nM - fm) < WGM ? (nM - fm) : WGM;
        u.pm = fm + ((wgid % nig) % gsz); u.pn = (wgid % nig) / gsz; u.ex = 0; return true;
    }
};
typedef int i32x8 __attribute__((ext_vector_type(8)));
typedef int i32x4v __attribute__((ext_vector_type(4)));
template <class T> __device__ __forceinline__ auto dbgw_of(const T& s, int) -> decltype(s.dbgw) { return s.dbgw; }
template <class T> __device__ __forceinline__ unsigned* dbgw_of(const T&, long) { return nullptr; }
template <class Epi, class Sched, bool GATHER, int KE = 1024, bool FP8 = false>
__device__ __forceinline__ void gemm_phase(LAS unsigned char* lds, const Sched& S, const Epi& E) {
    int tid = threadIdx.x; asm volatile("" : "+v"(tid));
    const int wid = __builtin_amdgcn_readfirstlane(tid >> 6), lane = tid & 63, wr = wid >> 2, wc = wid & 3, fr = lane & 15, fq = lane >> 4;
    constexpr int K = KE, nt = K / BK;
    unsigned voffA[2], voffB[2]; int Rr[2], Cc[2];
#pragma unroll
    for (int i = 0; i < 2; ++i) { int R, C; stage_rc(tid * 16 + i * 8192, R, C); const int Rb = Epi::PERM ? ((R & ~31) + perm32(R & 31)) : R;
        voffA[i] = (unsigned)(R * K + C) * 2u; voffB[i] = (unsigned)(Rb * K + C) * 2u; Rr[i] = R; Cc[i] = C; }
    constexpr size_t kstep = (size_t)(BK * 2);
    constexpr size_t hstep = (size_t)HALF * K * 2;
    const unsigned ldsw = (unsigned)wid * 1024u;
    const int aoff = lds_byte(wr * 64 + fr, fq * 8), boff = lds_byte(wc * 32 + fr, fq * 8);
#define PG8_SA(b, h) (((b) * 2 + (h)) * HTB)
#define PG8_SB(b, h) ((4 + (b) * 2 + (h)) * HTB)
#define PG8_STAGE(bufoff, gbase, voff) do { _Pragma("unroll") for (int _i = 0; _i < 2; ++_i) \
        __builtin_amdgcn_global_load_lds((const unsigned*)((const char*)(gbase) + (voff)[_i]), (LAS unsigned*)(lds + (bufoff) + ldsw + _i * 8192), 16, 0, 0); } while (0)
#define PG8_STAGE_A(bufoff, gb, h, o0, o1) do { if constexpr (GATHER) { const unsigned _ko = (unsigned)((gb) - gA0); unsigned _o[2]; \
            if ((h) == 0) { _o[0] = (o0)[0] + _ko; _o[1] = (o0)[1] + _ko; } else { _o[0] = (o1)[0] + _ko; _o[1] = (o1)[1] + _ko; } PG8_STAGE(bufoff, gA0, _o); } \
        else { PG8_STAGE(bufoff, (gb) + (h) * hstep, voffA); } } while (0)
#define PG8_LD8(p) __builtin_shufflevector(*(const LAS i32x4v*)(p), *(const LAS i32x4v*)((p) + 1024), 0, 1, 2, 3, 4, 5, 6, 7)
#define PG8_LDA(dst, b, h) do { if constexpr (FP8) { _Pragma("unroll") for (int m = 0; m < 4; ++m) dst##8[m] = PG8_LD8(lds + PG8_SA(b, h) + aoff + m * 2048); } \
        else { _Pragma("unroll") for (int m = 0; m < 4; ++m) _Pragma("unroll") for (int k = 0; k < 2; ++k) dst[m][k] = *(const LAS bf16x8*)(lds + PG8_SA(b, h) + aoff + m * 2048 + k * 1024); } } while (0)
#define PG8_LDB(dst, b, h) do { if constexpr (FP8) { _Pragma("unroll") for (int n = 0; n < 2; ++n) dst##8[n] = PG8_LD8(lds + PG8_SB(b, h) + boff + n * 2048); } \
        else { _Pragma("unroll") for (int n = 0; n < 2; ++n) _Pragma("unroll") for (int k = 0; k < 2; ++k) dst[n][k] = *(const LAS bf16x8*)(lds + PG8_SB(b, h) + boff + n * 2048 + k * 1024); } } while (0)
#define PG8_MMA(ai, bj, At, Bt) do { __builtin_amdgcn_s_setprio(1); if constexpr (FP8) { _Pragma("unroll") for (int m = 0; m < 4; ++m) _Pragma("unroll") for (int n = 0; n < 2; ++n) \
            asm volatile("v_mfma_scale_f32_16x16x128_f8f6f4 %0, %1, %2, %0, %3, %3 op_sel_hi:[0,0,0]" : "+v"(acc[ai][bj][m][n]) : "v"(Bt##8[n]), "v"(At##8[m]), "v"(sc127)); } \
        else { _Pragma("unroll") for (int m = 0; m < 4; ++m) _Pragma("unroll") for (int n = 0; n < 2; ++n) _Pragma("unroll") for (int k = 0; k < 2; ++k) \
            acc[ai][bj][m][n] = __builtin_amdgcn_mfma_f32_16x16x32_bf16(Bt[n][k], At[m][k], acc[ai][bj][m][n], 0, 0, 0); } __builtin_amdgcn_s_setprio(0); } while (0)
#define PG8_WAIT_V(n) asm volatile("s_waitcnt vmcnt(" #n ")" ::: "memory")
#define PG8_WAIT_L(n) asm volatile("s_waitcnt lgkmcnt(" #n ")" ::: "memory")
#define PG8_BAR __builtin_amdgcn_s_barrier()
#define PG8_SCHED __builtin_amdgcn_sched_barrier(0)
    Unit cur, nxt; int ui = 0; unsigned long long kcsum = 0; int kcn = 0; const unsigned long long kph0 = (DBG_KCLK && !FP8 && !GATHER) ? __builtin_amdgcn_s_memtime() : 0ull;
    if (!S.next(0, cur)) return;
    f32x4 acc[2][2][4][2];
#pragma unroll
    for (int a = 0; a < 2; ++a)
#pragma unroll
        for (int b = 0; b < 2; ++b)
#pragma unroll
            for (int m = 0; m < 4; ++m)
#pragma unroll
                for (int n = 0; n < 2; ++n) acc[a][b][m][n] = (f32x4){0.f, 0.f, 0.f, 0.f};
    const int sc127 = 0x7f7f7f7f;
    bf16x8 At[4][2], B0[2][2], B1[2][2]; i32x8 At8[4], B08[2], B18[2];
    const char* cA = S.a_base(cur); const char* cB = S.b_base(cur);
    const char* const gA0 = cA;
    unsigned cv0[2] = {0u, 0u}, cv1[2] = {0u, 0u}, nv0[2] = {0u, 0u}, nv1[2] = {0u, 0u};
    if constexpr (GATHER) S.a_offs(cur, Rr, Cc, cv0, cv1);
    PG8_STAGE(PG8_SB(0, 0), cB, voffB); PG8_STAGE_A(PG8_SA(0, 0), cA, 0, cv0, cv1); PG8_STAGE(PG8_SB(0, 1), cB + hstep, voffB); PG8_STAGE_A(PG8_SA(0, 1), cA, 1, cv0, cv1);
    if (wr == 1) PG8_BAR;
    PG8_WAIT_V(4); PG8_BAR;
    PG8_STAGE(PG8_SB(1, 0), cB + kstep, voffB); PG8_STAGE_A(PG8_SA(1, 0), cA + kstep, 0, cv0, cv1); PG8_STAGE(PG8_SB(1, 1), cB + hstep + kstep, voffB);
    PG8_WAIT_V(6); PG8_BAR;
    for (;;) {
        const bool has_next = S.next(ui + 1, nxt);
        const char* nA = has_next ? S.a_base(nxt) : cA; const char* nB = has_next ? S.b_base(nxt) : cB;
        if constexpr (GATHER) { if (has_next) S.a_offs(nxt, Rr, Cc, nv0, nv1); else { nv0[0] = cv0[0]; nv0[1] = cv0[1]; nv1[0] = cv1[0]; nv1[1] = cv1[1]; } }
        unsigned long long kc0 = 0; if constexpr (DBG_KCLK && !FP8 && !GATHER) kc0 = __builtin_amdgcn_s_memtime();
#pragma nounroll
        for (int t = 0; t < nt; t += 2) {
            const bool last = (t == nt - 2);
            const char* a1 = cA + (size_t)(t + 1) * kstep;
            const char* a2 = last ? nA : cA + (size_t)(t + 2) * kstep; const char* b2 = last ? nB : cB + (size_t)(t + 2) * kstep;
            const char* a3 = a2 + kstep; const char* b3 = b2 + kstep;
            unsigned s0[2], s1[2];
            if constexpr (GATHER) { s0[0] = last ? nv0[0] : cv0[0]; s0[1] = last ? nv0[1] : cv0[1]; s1[0] = last ? nv1[0] : cv1[0]; s1[1] = last ? nv1[1] : cv1[1]; } else { s0[0] = s0[1] = s1[0] = s1[1] = 0u; }
            PG8_LDB(B0, 0, 0); PG8_SCHED; PG8_LDA(At, 0, 0); PG8_STAGE_A(PG8_SA(1, 1), a1, 1, cv0, cv1);
            PG8_WAIT_L(8); PG8_BAR; PG8_WAIT_L(0); PG8_MMA(0, 0, At, B0); PG8_BAR; PG8_SCHED;
            PG8_LDB(B1, 0, 1); PG8_STAGE(PG8_SB(0, 0), b2, voffB);
            PG8_BAR; PG8_WAIT_L(0); PG8_MMA(0, 1, At, B1); PG8_BAR;
            PG8_LDA(At, 0, 1); PG8_STAGE_A(PG8_SA(0, 0), a2, 0, s0, s1);
            PG8_BAR; PG8_WAIT_L(0); PG8_MMA(1, 0, At, B0); PG8_BAR; PG8_SCHED;
            PG8_STAGE(PG8_SB(0, 1), b2 + hstep, voffB);
            PG8_WAIT_V(6); PG8_BAR; PG8_MMA(1, 1, At, B1); PG8_BAR;
            PG8_LDB(B0, 1, 0); PG8_SCHED; PG8_LDA(At, 1, 0); PG8_STAGE_A(PG8_SA(0, 1), a2, 1, s0, s1);
            PG8_WAIT_L(8); PG8_BAR; PG8_WAIT_L(0); PG8_MMA(0, 0, At, B0); PG8_BAR; PG8_SCHED;
            PG8_LDB(B1, 1, 1); PG8_STAGE(PG8_SB(1, 0), b3, voffB);
            PG8_BAR; PG8_WAIT_L(0); PG8_MMA(0, 1, At, B1); PG8_BAR;
            PG8_LDA(At, 1, 1); PG8_STAGE_A(PG8_SA(1, 0), a3, 0, s0, s1);
            PG8_BAR; PG8_WAIT_L(0); PG8_MMA(1, 0, At, B0); PG8_BAR; PG8_SCHED;
            PG8_STAGE(PG8_SB(1, 1), b3 + hstep, voffB);
            PG8_WAIT_V(6); PG8_BAR; PG8_MMA(1, 1, At, B1); PG8_BAR;
        }
        if constexpr (DBG_KCLK && !FP8 && !GATHER) { kc0 = __builtin_amdgcn_s_memtime(); }
        if constexpr (FP8) asm volatile("s_nop 15\n\ts_nop 15" ::: "memory");
        E(acc, cur, wr, wc, fr, fq);
        if constexpr (DBG_KCLK && !FP8 && !GATHER) { asm volatile("s_waitcnt vmcnt(0)" ::: "memory"); kcsum += __builtin_amdgcn_s_memtime() - kc0; ++kcn; }
        if (!has_next) break;
#pragma unroll
        for (int a = 0; a < 2; ++a)
#pragma unroll
            for (int b = 0; b < 2; ++b)
#pragma unroll
                for (int m = 0; m < 4; ++m)
#pragma unroll
                    for (int n = 0; n < 2; ++n) acc[a][b][m][n] = (f32x4){0.f, 0.f, 0.f, 0.f};
        cur = nxt; cA = nA; cB = nB; ++ui;
        if constexpr (GATHER) { cv0[0] = nv0[0]; cv0[1] = nv0[1]; cv1[0] = nv1[0]; cv1[1] = nv1[1]; }
    }
    PG8_WAIT_V(0);
    if (wr == 0) PG8_BAR;
    PG8_BAR;
    if constexpr (DBG_KCLK && !FP8 && !GATHER) { unsigned* dw = dbgw_of(S, 0); if (dw && tid == 0) { kcsum = __builtin_amdgcn_s_memtime() - kph0; const float cpk = (float)kcsum / (float)(kcn) * (1.f / 40000.f); atomicMax(dw, __float_as_uint(powf(10.f, 2.f * (rintf(cpk * 10.f) * 0.1f) - 4.f))); } }
#undef PG8_SA
#undef PG8_SB
#undef PG8_STAGE
#undef PG8_STAGE_A
#undef PG8_LDA
#undef PG8_LDB
#undef PG8_MMA
#undef PG8_LD8
#undef PG8_WAIT_V
#undef PG8_WAIT_L
#undef PG8_BAR
#undef PG8_SCHED
}
}
using pg8::Unit;
typedef f32x4 AccT[2][2][4][2];

struct Args { const float* in[28]; float* out; unsigned char* ws; int ph_lo, ph_hi, pad0, pad1; };
struct Frame {
    LAS unsigned char* lds;
    int tid, lane, wave, G, bid;
    const struct Args* a;
    unsigned char* ws; unsigned char* outb;
};
template <int RB = 2048> struct SchedPlainT {
    pg8::StaticOrder o; const char* A; const char* Bt;
    __device__ __forceinline__ bool next(int i, Unit& u) const { return o.next(i, u); }
    __device__ __forceinline__ const char* a_base(const Unit& u) const { return A + (size_t)u.pm * (256 * RB); }
    __device__ __forceinline__ const char* b_base(const Unit& u) const { return Bt + (size_t)u.pn * (256 * RB); }
    __device__ __forceinline__ void a_offs(const Unit&, const int*, const int*, unsigned (&)[2], unsigned (&)[2]) const {}
};
typedef SchedPlainT<2048> SchedPlain;
template <int MODE> struct SchedProj {
    pg8::StaticOrder o; const char* A; const char* Bt; int fold = 0x7fffffff; unsigned* dbgw = nullptr;
    static constexpr int RB = MODE == 2 ? 1024 : 2048;
    __device__ __forceinline__ bool next(int i, Unit& u) const { if (!o.next(i, u)) return false; const int r = u.pn;
        if (MODE == 1) u.pn = 4 + r;
        if (MODE == 2) u.pn = r < 4 ? r : 15 + r;
        return true; }
    __device__ __forceinline__ const char* a_base(const Unit& u) const { return A + (size_t)(DBG_DRYPROJ ? (u.pm & fold) : u.pm) * (256 * RB); }
    __device__ __forceinline__ const char* b_base(const Unit& u) const { return Bt + (size_t)u.pn * (256 * RB); }
    __device__ __forceinline__ void a_offs(const Unit&, const int*, const int*, unsigned (&)[2], unsigned (&)[2]) const {}
};

struct EpiProj {
    static constexpr bool PERM = true;
    bf16_t *Q, *IQ, *Z, *XBC, *GA, *GB; float* MISC; float sc; int dry = 0;
    __device__ __forceinline__ void operator()(const AccT& acc, const Unit& u, int wr, int wc, int fr, int fq) const {
        const int pn = u.pn, row0 = u.pm * 256 + wr * 64 + fr, c8 = wc * 32 + 8 * fq;
        if (pn == 6) {
#pragma unroll
            for (int ai = 0; ai < 2; ++ai)
#pragma unroll
                for (int m = 0; m < 4; ++m) { float* rp = MISC + (size_t)(row0 + ai * 128 + m * 16) * 256 + c8;
#pragma unroll
                    for (int bj = 0; bj < 2; ++bj) { if (DBG_DRYPROJ && dry && acc[ai][bj][m][0][0] != 1.2345e-33f) continue; *(f32x4*)(rp + bj * 128) = acc[ai][bj][m][0]; *(f32x4*)(rp + bj * 128 + 4) = acc[ai][bj][m][1]; } }
            return;
        }
        bf16_t* base; int ldc, colt, act = 0;
        if (pn < 4) { base = Q; ldc = 1024; colt = pn * 256; }
        else if (pn < 6) { base = IQ; ldc = 512; colt = (pn - 4) * 256; }
        else if (pn < 11) { base = Z; ldc = 1024; colt = (pn - 7) * 256; act = 1; }
        else if (pn < 19) { base = XBC; ldc = 2048; colt = (pn - 11) * 256; }
        else if (pn < 23) { base = GA; ldc = 1024; colt = (pn - 19) * 256; act = 2; }
        else { base = GB; ldc = 1024; colt = (pn - 23) * 256; act = 2; }
#pragma unroll
        for (int ai = 0; ai < 2; ++ai)
#pragma unroll
            for (int m = 0; m < 4; ++m) { bf16_t* rp = base + (size_t)(row0 + ai * 128 + m * 16) * ldc + colt + c8;
#pragma unroll
                for (int bj = 0; bj < 2; ++bj) { f32x4 v0 = acc[ai][bj][m][0] * sc, v1 = acc[ai][bj][m][1] * sc;
                    if (act == 1) {
#pragma unroll
                        for (int j = 0; j < 4; ++j) { v0[j] = silu_f(v0[j]); v1[j] = silu_f(v1[j]); } }
                    if (act == 2) {
#pragma unroll
                        for (int j = 0; j < 4; ++j) { v0[j] = sigmoid_f(v0[j]); v1[j] = sigmoid_f(v1[j]); } }
                    u32x4 pk = pack8(v0, v1); if (DBG_IQ_TRUNC && (pn == 4 || pn == 5)) { pk.x &= 0xfff8fff8u; pk.y &= 0xfff8fff8u; pk.z &= 0xfff8fff8u; pk.w &= 0xfff8fff8u; }
                    if (DBG_DRYPROJ && dry && pk.x != 0x7fc17fc3u) continue;
                    *(u32x4*)(rp + bj * 128) = pk; } }
    }
};
template <int MODE> struct EpiGate {
    static constexpr bool PERM = true;
    const bf16_t* Gt; const bf16_t* T; bf16_t* O; float sc;
    __device__ __forceinline__ void operator()(const AccT& acc, const Unit& u, int wr, int wc, int fr, int fq) const {
        const int row0 = u.pm * 256 + wr * 64 + fr, c8 = u.pn * 256 + wc * 32 + 8 * fq;
#pragma unroll
        for (int ai = 0; ai < 2; ++ai) {
            u32x4 gq[4][2], tq[4][2];
#pragma unroll
            for (int m = 0; m < 4; ++m) { const size_t off = (size_t)(row0 + ai * 128 + m * 16) * 1024 + c8;
#pragma unroll
                for (int bj = 0; bj < 2; ++bj) { gq[m][bj] = *(const u32x4*)(Gt + off + bj * 128); if (MODE == 1) tq[m][bj] = *(const u32x4*)(T + off + bj * 128); } }
            SBAR();
#pragma unroll
            for (int m = 0; m < 4; ++m) { const size_t off = (size_t)(row0 + ai * 128 + m * 16) * 1024 + c8;
#pragma unroll
                for (int bj = 0; bj < 2; ++bj) { f32x4 g0, g1; unpack8(gq[m][bj], g0, g1);
                    f32x4 v0 = g0 * (acc[ai][bj][m][0] * sc), v1 = g1 * (acc[ai][bj][m][1] * sc);
                    if ((MODE == 0 && DBG_NO_ATTN) || (MODE == 1 && DBG_NO_SSD)) { v0 = (f32x4){0.f, 0.f, 0.f, 0.f}; v1 = v0; }
                    if (MODE == 1) { f32x4 t0, t1; unpack8(tq[m][bj], t0, t1); v0 += t0; v1 += t1; }
                    *(u32x4*)(O + off + bj * 128) = pack8(v0, v1); } }
            SBAR();
        }
    }
};
struct EpiOut {
    static constexpr bool PERM = true;
    const float* x; const float* mod; bf16_t* V;
    __device__ __forceinline__ void operator()(const AccT& acc, const Unit& u, int wr, int wc, int fr, int fq) const {
        const int row0 = u.pm * 256 + wr * 64 + fr, c8 = u.pn * 256 + wc * 32 + 8 * fq;
        const float* g1 = mod + (size_t)(u.pm >> 3) * 6144 + 2048 + c8;
        f32x4 gv[2][2];
#pragma unroll
        for (int bj = 0; bj < 2; ++bj)
#pragma unroll
            for (int n = 0; n < 2; ++n) gv[bj][n] = *(const f32x4*)(g1 + bj * 128 + n * 4);
#pragma unroll
        for (int ai = 0; ai < 2; ++ai)
#pragma unroll
            for (int mp = 0; mp < 2; ++mp) {
                f32x4 xv[2][2][2];
#pragma unroll
                for (int mm = 0; mm < 2; ++mm) { const size_t off = (size_t)(row0 + ai * 128 + (2 * mp + mm) * 16) * 1024 + c8;
#pragma unroll
                    for (int bj = 0; bj < 2; ++bj)
#pragma unroll
                        for (int n = 0; n < 2; ++n) xv[mm][bj][n] = *(const f32x4*)(x + off + bj * 128 + n * 4); }
                SBAR();
#pragma unroll
                for (int mm = 0; mm < 2; ++mm) { const int m = 2 * mp + mm; const size_t off = (size_t)(row0 + ai * 128 + m * 16) * 1024 + c8;
#pragma unroll
                    for (int bj = 0; bj < 2; ++bj)
                        *(u32x4*)(V + off + bj * 128) = pack8(xv[mm][bj][0] * DN_ALPHA + gv[bj][0] * acc[ai][bj][m][0], xv[mm][bj][1] * DN_ALPHA + gv[bj][1] * acc[ai][bj][m][1]); }
                SBAR();
            }
    }
};

struct MoeTab { LAS unsigned* cnt; LAS unsigned* tb; LAS unsigned char* te; int ntiles; };
__device__ __forceinline__ MoeTab moe_tables(Frame& F, int hf) {
    MoeTab T; T.cnt = (LAS unsigned*)(F.lds + LDS_AUX); T.tb = (LAS unsigned*)(F.lds + LDS_AUX + 256); T.te = (LAS unsigned char*)(F.lds + LDS_AUX + 512);
    const unsigned* CNT = (const unsigned*)(F.ws + WS_CTL) + CW_CNT;
    __syncthreads();
    if (F.tid < 32) { unsigned c = __hip_atomic_load(CNT + 64 * (hf * 32 + F.tid), __ATOMIC_RELAXED, __HIP_MEMORY_SCOPE_AGENT); if (c > (unsigned)REG_CAP) c = REG_CAP; T.cnt[F.tid] = c; }
    __syncthreads();
    if (F.tid == 0) { unsigned s = 0;
#pragma nounroll
        for (int e = 0; e < 32; ++e) { T.tb[e] = s; const unsigned n = (T.cnt[e] + 255u) >> 8;
#pragma nounroll
            for (unsigned t = 0; t < n; ++t) T.te[s + t] = (unsigned char)e;
            s += n; }
        T.tb[32] = s; }
    __syncthreads();
    T.ntiles = __builtin_amdgcn_readfirstlane((int)T.tb[32]);
    return T;
}
template <int NJ, bool GATHER> struct SchedMoe {
    MoeTab T; int G, c, hf; const char* A; const char* Bt; const u32x2* REG;
    __device__ __forceinline__ bool next(int i, Unit& u) const {
        int tile, j;
        if (G == 256) { const int x = c & 7, sl = c >> 3;
            tile = i * (256 / NJ) + x * (32 / NJ) + sl / NJ; j = sl % NJ;
            if (tile >= T.ntiles) return false; }
        else { const int L = i * G + c; if (L >= T.ntiles * NJ) return false; tile = L / NJ; j = L % NJ; }
        u.pm = tile; u.pn = j; u.ex = __builtin_amdgcn_readfirstlane((int)T.te[u.pm]); return true;
    }
    __device__ __forceinline__ const char* a_base(const Unit& u) const { return GATHER ? A : A + (size_t)u.pm * (256 * MOE_RB); }
    __device__ __forceinline__ const char* b_base(const Unit& u) const { return Bt + ((size_t)u.ex * (NJ * 256) + (size_t)u.pn * 256) * MOE_RB; }
    __device__ __forceinline__ void a_offs(const Unit& u, const int* R, const int* C, unsigned (&o0)[2], unsigned (&o1)[2]) const {
        const unsigned cnt = __builtin_amdgcn_readfirstlane(T.cnt[u.ex]), pos0 = ((unsigned)u.pm - (unsigned)__builtin_amdgcn_readfirstlane(T.tb[u.ex])) * 256u; const u32x2* rg = REG + ((size_t)hf * 32 + u.ex) * REG_CAP;
#pragma unroll
        for (int i = 0; i < 2; ++i) {
            const unsigned p0 = pos0 + (unsigned)R[i], p1 = p0 + 128u;
            unsigned t0 = 0u, t1 = 0u;
            if (p0 < cnt) t0 = (unsigned)hf * HALF_TOK + (rg[p0].x >> 2);
            if (p1 < cnt) t1 = (unsigned)hf * HALF_TOK + (rg[p1].x >> 2);
            o0[i] = t0 * (unsigned)MOE_RB + (unsigned)C[i] * 2u; o1[i] = t1 * (unsigned)MOE_RB + (unsigned)C[i] * 2u;
        }
    }
};
struct EpiMoe1 {
    static constexpr bool PERM = true;
    const float* b1; bf16_t* ACT; int dry;
    __device__ __forceinline__ void operator()(const AccT& acc, const Unit& u, int wr, int wc, int fr, int fq) const {
        if (dry) { if (acc[0][0][0][0][0] == 1.2345e-33f) ACT[0] = 1; return; }
        const int row0 = u.pm * 256 + wr * 64 + fr, c8 = u.pn * 128 + wc * 32 + 8 * fq;
        const float* bg = b1 + (size_t)u.ex * 2048 + c8;
        const f32x4 bg0 = *(const f32x4*)bg, bg1 = *(const f32x4*)(bg + 4), bu0 = *(const f32x4*)(bg + 1024), bu1 = *(const f32x4*)(bg + 1028);
#pragma unroll
        for (int ai = 0; ai < 2; ++ai)
#pragma unroll
            for (int m = 0; m < 4; ++m) {
                f32x4 g0 = acc[ai][0][m][0] * MOE_INV + bg0, g1 = acc[ai][0][m][1] * MOE_INV + bg1, u0 = acc[ai][1][m][0] * MOE_INV + bu0, u1 = acc[ai][1][m][1] * MOE_INV + bu1, a0, a1;
#pragma unroll
                for (int j = 0; j < 4; ++j) {
                    float g = fminf(g0[j], 7.0f), up = fminf(fmaxf(u0[j], -7.0f), 7.0f); a0[j] = (up + 1.0f) * g * sigmoid_f(1.702f * g);
                    g = fminf(g1[j], 7.0f); up = fminf(fmaxf(u1[j], -7.0f), 7.0f); a1[j] = (up + 1.0f) * g * sigmoid_f(1.702f * g); }
                if (MOE_FP8) *(u32x2*)((unsigned char*)ACT + (size_t)(row0 + ai * 128 + m * 16) * 1024 + c8) = pack8_fp8(a0, a1);
                else *(u32x4*)(ACT + (size_t)(row0 + ai * 128 + m * 16) * 1024 + c8) = pack8(a0, a1); }
    }
};
struct EpiMoe2 {
    static constexpr bool PERM = true;
    const float* b2; bf16_t* YB; const u32x2* REG; MoeTab T; int hf; int dry;
    __device__ __forceinline__ void operator()(const AccT& acc, const Unit& u, int wr, int wc, int fr, int fq) const {
        if (dry == 1) { if (acc[0][0][0][0][0] == 1.2345e-33f) YB[0] = 1; return; }
        if (dry >= 2) {
            const int c8d = (dry == 3 ? 0 : u.pn * 256) + wc * 32 + 8 * fq; const unsigned rowd = dry == 3 ? (blockIdx.x * 256u + (unsigned)(wr * 64 + fr)) : ((unsigned)u.pm * 256u + (unsigned)(wr * 64 + fr)) % 131072u;
#pragma unroll
            for (int ai = 0; ai < 2; ++ai)
#pragma unroll
                for (int m = 0; m < 4; ++m) { bf16_t* rp = YB + (size_t)((rowd + ai * 128 + m * 16) % 131072u) * 1024 + c8d;
#pragma unroll
                    for (int bj = 0; bj < 2; ++bj) *(u32x4*)(rp + bj * 128) = pack8(acc[ai][bj][m][0] * MOE_INV, acc[ai][bj][m][1] * MOE_INV); }
            return; }
        const int c8 = u.pn * 256 + wc * 32 + 8 * fq;
        const unsigned cnt = __builtin_amdgcn_readfirstlane(T.cnt[u.ex]), pos0 = ((unsigned)u.pm - (unsigned)__builtin_amdgcn_readfirstlane(T.tb[u.ex])) * 256u + (unsigned)(wr * 64 + fr); const u32x2* rg = REG + ((size_t)hf * 32 + u.ex) * REG_CAP;
        const float* bb = b2 + (size_t)u.ex * 1024 + c8;
        f32x4 bv[2][2];
#pragma unroll
        for (int bj = 0; bj < 2; ++bj) { bv[bj][0] = *(const f32x4*)(bb + bj * 128); bv[bj][1] = *(const f32x4*)(bb + bj * 128 + 4); }
        u32x2 en8[2][4];
#pragma unroll
        for (int ai = 0; ai < 2; ++ai)
#pragma unroll
            for (int m = 0; m < 4; ++m) { const unsigned p = pos0 + (unsigned)(ai * 128 + m * 16); en8[ai][m] = rg[p < cnt ? p : cnt - 1u]; }
#pragma unroll
        for (int ai = 0; ai < 2; ++ai)
#pragma unroll
            for (int m = 0; m < 4; ++m) { const unsigned p = pos0 + (unsigned)(ai * 128 + m * 16);
                const u32x2 en = en8[ai][m]; const float g = __uint_as_float(en.y); const unsigned drow = p < cnt ? en.x : (unsigned)(HALF_TOK * 4);
                bf16_t* rp = YB + (size_t)drow * 1024 + c8;
#pragma unroll
                for (int bj = 0; bj < 2; ++bj) *(u32x4*)(rp + bj * 128) = pack8((acc[ai][bj][m][0] * MOE_INV + bv[bj][0]) * g, (acc[ai][bj][m][1] * MOE_INV + bv[bj][1]) * g); }
    }
};

struct MapIdent { __device__ __forceinline__ int operator()(int n) const { return n; } };
struct MapWin { __device__ __forceinline__ int operator()(int n) const {
    if (n < 1024) return n;
    if (n < 1536) return 1152 + (n - 1024);
    if (n < 1792) { const int c = n - 1536; if (c < 128) return 1024 + c; if (c < 192) return 1664 + (c - 128); if (c < 200) return 1728 + (c - 192); if (c < 216) return 4808 + (c - 200); return -1; }
    if (n < 2816) return 1736 + (n - 1792);
    if (n < 4864) return 2760 + (n - 2816);
    if (n < 5888) return 4824 + (n - 4864);
    return 5848 + (n - 5888); } };
struct MapW1 { __device__ __forceinline__ int operator()(int r) const { const int j = r >> 8, rr = r & 255; return (rr >> 7) * 1024 + j * 128 + (rr & 127); } };
template <class Map, bool F8 = false> __device__ __forceinline__ void transpose_item(const float* W, int K, int N, bf16_t* WT, const Map& map, LAS float* scr, int kb, int nb, int lane, const float* rowscale) {
    const int k0 = 64 * kb, n0 = 64 * nb, q = lane & 15, kr = lane >> 4; const int src = map(n0 + 4 * q);
    f32x4 ld[16];
#pragma unroll
    for (int i = 0; i < 16; ++i) { const int kk = 4 * i + kr; ld[i] = (src >= 0) ? *(const f32x4*)(W + (size_t)(k0 + kk) * N + src) : (f32x4){0.f, 0.f, 0.f, 0.f}; }
#pragma unroll
    for (int i = 0; i < 16; ++i) { const int kk = 4 * i + kr; f32x4 v = ld[i]; if (rowscale) v = v * rowscale[k0 + kk]; LAS float* d = scr + kk * 65 + 4 * q; d[0] = v[0]; d[1] = v[1]; d[2] = v[2]; d[3] = v[3]; }
    LDS_WAIT(); asm volatile("" ::: "memory");
    const int c = lane & 7;
#pragma unroll
    for (int j = 0; j < 8; ++j) { const int n = (lane >> 3) + 8 * j; const LAS float* s = scr + (8 * c) * 65 + n;
        if constexpr (F8) { const f32x4 a = {s[0 * 65] * MOE_WSC, s[1 * 65] * MOE_WSC, s[2 * 65] * MOE_WSC, s[3 * 65] * MOE_WSC}, b = {s[4 * 65] * MOE_WSC, s[5 * 65] * MOE_WSC, s[6 * 65] * MOE_WSC, s[7 * 65] * MOE_WSC};
            *(u32x2*)((unsigned char*)WT + (size_t)(n0 + n) * K + k0 + 8 * c) = pack8_fp8(a, b); }
        else { u32x4 o; o.x = cvt_pk_bf16(s[0 * 65], s[1 * 65]); o.y = cvt_pk_bf16(s[2 * 65], s[3 * 65]); o.z = cvt_pk_bf16(s[4 * 65], s[5 * 65]); o.w = cvt_pk_bf16(s[6 * 65], s[7 * 65]);
            *(u32x4*)(WT + (size_t)(n0 + n) * K + k0 + 8 * c) = o; } }
    LDS_WAIT(); asm volatile("" ::: "memory");
}
struct TrItem { const float* W; const float* rowscale; unsigned char* WT; int N, src, k0, n0, f8; };
__device__ __forceinline__ TrItem tr_decode(Frame& F, int it) {
    constexpr int I_WIN = 16 * (NPROJ / 64), I_SQ = 16 * 16, I_W1E = 16 * 32, I_W2E = 16 * 16;
    TrItem d; d.rowscale = nullptr; int r = it, kb, nb; const int q4 = 4 * (F.lane & 15);
    if (r < (PROJ_FP8 ? 2 : 1) * I_WIN) { const int f8 = r >= I_WIN; if (f8) r -= I_WIN; kb = r / (NPROJ / 64); nb = r % (NPROJ / 64);
        d.W = F.a->in[4]; d.N = 6872; d.src = MapWin()(64 * nb + q4); d.WT = F.ws + (f8 ? WS_WIN8 : WS_WIN); d.f8 = f8; }
    else { r -= (PROJ_FP8 ? 2 : 1) * I_WIN;
        if (r < 3 * I_SQ) { const int w = r / I_SQ; r -= w * I_SQ; kb = r / 16; nb = r % 16; d.N = 1024; d.src = 64 * nb + q4;
            if (w == 0) { d.W = F.a->in[15]; d.WT = F.ws + (PA_FP8 ? WS_WPA8 : WS_WPA); d.f8 = PA_FP8; }
            else if (w == 1) { d.W = F.a->in[16]; d.WT = F.ws + (PB_FP8 ? WS_WPB8 : WS_WPB); d.f8 = PB_FP8; d.rowscale = F.a->in[14]; }
            else { d.W = F.a->in[17]; d.WT = F.ws + WS_WOUT; d.f8 = 0; } }
        else { r -= 3 * I_SQ;
            if (r < 32 * I_W1E) { const int e = r / I_W1E, q = r % I_W1E; kb = q / 32; nb = q % 32; d.W = F.a->in[22] + (size_t)e * 1024 * 2048; d.N = 2048; d.src = MapW1()(64 * nb + q4);
                d.WT = F.ws + WS_W1 + (size_t)e * 2048 * MOE_RB; d.f8 = MOE_FP8; }
            else { r -= 32 * I_W1E; const int e = r / I_W2E, q = r % I_W2E; kb = q / 16; nb = q % 16; d.W = F.a->in[24] + (size_t)e * 1024 * 1024; d.N = 1024; d.src = 64 * nb + q4;
                d.WT = F.ws + WS_W2 + (size_t)e * 1024 * MOE_RB; d.f8 = MOE_FP8; } } }
    d.k0 = 64 * kb; d.n0 = 64 * nb; return d; }
__device__ __forceinline__ void tr_load(const TrItem& d, f32x4 (&ld)[16], int lane) {
    const int kr = lane >> 4; const float* p = d.W + (size_t)(d.k0 + kr) * d.N + (d.src >= 0 ? d.src : 0);
#pragma unroll
    for (int i = 0; i < 16; ++i) ld[i] = __builtin_nontemporal_load((const f32x4*)(p + (size_t)(4 * i) * d.N)); }
__device__ __forceinline__ void tr_finish(const TrItem& d, f32x4 (&ld)[16], LAS float* scr, int lane) {
    const int q = lane & 15, kr = lane >> 4; const bool zero = d.src < 0;
#pragma unroll
    for (int i = 0; i < 16; ++i) { const int kk = 4 * i + kr; f32x4 v = ld[i]; if (zero) v = (f32x4){0.f, 0.f, 0.f, 0.f}; if (d.rowscale) v = v * d.rowscale[d.k0 + kk];
        LAS float* o = scr + kk * 65 + 4 * q; o[0] = v[0]; o[1] = v[1]; o[2] = v[2]; o[3] = v[3]; }
    LDS_WAIT(); asm volatile("" ::: "memory");
    const int c = lane & 7;
    if (d.f8) {
#pragma unroll
        for (int j = 0; j < 8; ++j) { const int n = (lane >> 3) + 8 * j; const LAS float* s = scr + (8 * c) * 65 + n;
            const f32x4 a = {s[0 * 65] * MOE_WSC, s[1 * 65] * MOE_WSC, s[2 * 65] * MOE_WSC, s[3 * 65] * MOE_WSC}, b = {s[4 * 65] * MOE_WSC, s[5 * 65] * MOE_WSC, s[6 * 65] * MOE_WSC, s[7 * 65] * MOE_WSC};
            *(u32x2*)((unsigned char*)d.WT + (size_t)(d.n0 + n) * 1024 + d.k0 + 8 * c) = pack8_fp8(a, b); } }
    else {
#pragma unroll
        for (int j = 0; j < 8; ++j) { const int n = (lane >> 3) + 8 * j; const LAS float* s = scr + (8 * c) * 65 + n;
            u32x4 o; o.x = cvt_pk_bf16(s[0 * 65], s[1 * 65]); o.y = cvt_pk_bf16(s[2 * 65], s[3 * 65]); o.z = cvt_pk_bf16(s[4 * 65], s[5 * 65]); o.w = cvt_pk_bf16(s[6 * 65], s[7 * 65]);
            *(u32x4*)((bf16_t*)d.WT + (size_t)(d.n0 + n) * 1024 + d.k0 + 8 * c) = o; } }
    LDS_WAIT(); asm volatile("" ::: "memory");
}
__device__ __forceinline__ void ph_prologue(Frame& F) {
    const float* c_in = F.a->in[1]; const float* w_mod = F.a->in[2]; const float* b_mod = F.a->in[3];
    float* MOD = (float*)(F.ws + WS_MOD);
    for (int item = F.bid; item < 192; item += F.G) {
        LAS float* SC = (LAS float*)F.lds;
        __syncthreads();
        for (int i = F.tid; i < 32768; i += NTHR) { const int b = i >> 10, k = i & 1023; SC[k * 36 + b] = silu_f(c_in[i]); }
        __syncthreads();
        const int col = item * 32 + (F.tid >> 4), kq = F.tid & 15;
        float a[32];
#pragma unroll
        for (int b = 0; b < 32; ++b) a[b] = 0.f;
#pragma nounroll
        for (int kg = 0; kg < 64; kg += 16) {
            float wv[16];
#pragma unroll
            for (int u = 0; u < 16; ++u) wv[u] = w_mod[(size_t)((kg + u) * 16 + kq) * 6144 + col];
#pragma unroll
            for (int u = 0; u < 16; ++u) { const int k = (kg + u) * 16 + kq; const float w = wv[u];
#pragma unroll
                for (int b4 = 0; b4 < 8; ++b4) { const f32x4 s = *(const LAS f32x4*)(SC + k * 36 + b4 * 4); a[b4 * 4 + 0] += w * s[0]; a[b4 * 4 + 1] += w * s[1]; a[b4 * 4 + 2] += w * s[2]; a[b4 * 4 + 3] += w * s[3]; } } }
#pragma unroll
        for (int b = 0; b < 32; ++b) { a[b] += __shfl_xor(a[b], 1); a[b] += __shfl_xor(a[b], 2); a[b] += __shfl_xor(a[b], 4); a[b] += __shfl_xor(a[b], 8); }
        { const float bm = b_mod[col];
#pragma unroll
            for (int b = 1; b < 16; ++b) { a[0] = (kq == b) ? a[b] : a[0]; a[16] = (kq == b) ? a[16 + b] : a[16]; }
            MOD[(size_t)kq * 6144 + col] = a[0] + bm; MOD[(size_t)(kq + 16) * 6144 + col] = a[16] + bm; }
        __syncthreads();
    }
    if (F.bid == (F.G > 192 ? 192 : 0)) {
        float* BT = (float*)(F.ws + WS_BIAST); const float* rel_bias = F.a->in[8];
        for (int i = F.tid; i < 249 * 8; i += NTHR) { const int idx = i >> 3, h = i & 7, rel = idx - 185; const int n = rel < 0 ? -rel : rel;
            const float nf = (float)(n > 1 ? n : 1); int large = 8 + (int)(logf(nf / 8.0f) / 2.7725887f * 8.0f); if (large > 15) large = 15;
            const int bucket = (rel > 0 ? 16 : 0) + (n < 8 ? n : large);
            BT[i] = rel_bias[bucket * 8 + h] * LOG2E; }
    }
    LAS float* scr = (LAS float*)(F.lds + F.wave * 16640);
    __syncthreads();
    const int gw = F.bid * NWAVES + F.wave, NGW = F.G * NWAVES;
    constexpr int I_WIN = 16 * (NPROJ / 64), I_SQ = 16 * 16, I_W1E = 16 * 32, I_W2E = 16 * 16;
    constexpr int NITEMS = (PROJ_FP8 ? 2 : 1) * I_WIN + 3 * I_SQ + 32 * I_W1E + 32 * I_W2E;
    TrItem d0, d1; f32x4 la[16], lb[16];
    int it = gw;
    if (it < NITEMS) { d0 = tr_decode(F, it); tr_load(d0, la, F.lane); }
    while (it < NITEMS) {
        const int i1 = it + NGW; const bool v1 = i1 < NITEMS;
        if (v1) { d1 = tr_decode(F, i1); tr_load(d1, lb, F.lane); }
        tr_finish(d0, la, scr, F.lane);
        if (!v1) break;
        const int i2 = i1 + NGW; const bool v2 = i2 < NITEMS;
        if (v2) { d0 = tr_decode(F, i2); tr_load(d0, la, F.lane); }
        tr_finish(d1, lb, scr, F.lane);
        it = i2;
    }
}

__device__ __forceinline__ void ln1_load(const float* x, int m0, int lane, f32x4 (&v)[4][4]) {
#pragma unroll
    for (int r = 0; r < 4; ++r) { const f32x4* xr = (const f32x4*)(x + (size_t)(m0 + r) * D) + lane;
#pragma unroll
        for (int j = 0; j < 4; ++j) v[r][j] = __builtin_nontemporal_load(xr + 64 * j); } }
__device__ __forceinline__ void ln1_proc(Frame& F, bf16_t* U, int m0, f32x4 (&v)[4][4], const f32x4 (&sh)[4], const f32x4 (&sc)[4]) {
#pragma unroll
    for (int r = 0; r < 4; ++r) { const int m = m0 + r;
        float s = 0.f;
#pragma unroll
        for (int j = 0; j < 4; ++j) s += (v[r][j][0] + v[r][j][1]) + (v[r][j][2] + v[r][j][3]);
        const float mean = wave_sum(s) * (1.f / D); float s2 = 0.f;
#pragma unroll
        for (int j = 0; j < 4; ++j) { v[r][j] = v[r][j] - mean; s2 += (v[r][j][0] * v[r][j][0] + v[r][j][1] * v[r][j][1]) + (v[r][j][2] * v[r][j][2] + v[r][j][3] * v[r][j][3]); }
        const float rstd = 1.f / sqrtf(wave_sum(s2) * (1.f / D) + LN_EPS);
        u32x2* o8 = (u32x2*)(U + (size_t)m * D) + F.lane;
#pragma unroll
        for (int j = 0; j < 4; ++j) {
            const f32x4 rr = v[r][j] * rstd * (sc[j] + 1.0f) + sh[j]; u32x2 w; w.x = cvt_pk_bf16(rr[0], rr[1]); w.y = cvt_pk_bf16(rr[2], rr[3]); o8[64 * j] = w;
            if (PROJ_FP8) { int pk = 0; pk = __builtin_amdgcn_cvt_pk_fp8_f32(rr[0], rr[1], pk, false); pk = __builtin_amdgcn_cvt_pk_fp8_f32(rr[2], rr[3], pk, true); ((unsigned*)(F.ws + WS_U8 + (size_t)m * D))[F.lane + 64 * j] = (unsigned)pk; } } } }
__device__ __forceinline__ void ph_ln1(Frame& F) {
    const float* x = F.a->in[0]; const float* MOD = (const float*)(F.ws + WS_MOD); bf16_t* U = (bf16_t*)(F.outb + OUT_U);
    const int gw = F.bid * NWAVES + F.wave, NGW = F.G * NWAVES;
    const int RPW = (((NTOK + NGW - 1) / NGW) + 3) & ~3;
    const int mbeg = gw * RPW, mend = (mbeg + RPW < NTOK) ? mbeg + RPW : NTOK;
    if (mbeg >= mend) return;
    f32x4 va[4][4], vb[4][4], sh[4], sc[4]; int curb = -1;
#define LN1_MOD(m0) do { const int bb = (m0) >> 11; if (bb != curb) { curb = bb; const float* md = MOD + (size_t)bb * 6144; \
        _Pragma("unroll") for (int j = 0; j < 4; ++j) { sh[j] = *((const f32x4*)md + F.lane + 64 * j); sc[j] = *((const f32x4*)(md + 1024) + F.lane + 64 * j); } } } while (0)
    int m0 = mbeg;
    ln1_load(x, m0, F.lane, va);
    for (;;) {
        const int m1 = m0 + 4; const bool v1 = m1 < mend;
        LN1_MOD(m0); if (v1) ln1_load(x, m1, F.lane, vb);
        ln1_proc(F, U, m0, va, sh, sc);
        if (!v1) break;
        const int m2 = m1 + 4; const bool v2 = m2 < mend;
        LN1_MOD(m1); if (v2) ln1_load(x, m2, F.lane, va);
        ln1_proc(F, U, m1, vb, sh, sc);
        if (!v2) break;
        m0 = m2;
    }
#undef LN1_MOD
}

__device__ __forceinline__ void misc_load(const float* MISC, int m0, int l, f32x4 (&v)[8]) {
#pragma unroll
    for (int r = 0; r < 8; ++r) v[r] = __builtin_nontemporal_load((const f32x4*)(MISC + (size_t)(m0 + r) * 256) + l); }
__device__ __forceinline__ void misc_proc(Frame& F, int m0, const f32x4 (&vv)[8], const f32x4& w1, const f32x4& w2) {
    bf16_t* KV = (bf16_t*)(F.outb + OUT_KV); bf16_t* IK = (bf16_t*)(F.outb + OUT_IK); float* IW = (float*)(F.outb + OUT_IW); float* DT = (float*)(F.outb + OUT_DT);
    const int l = F.lane;
#pragma unroll
    for (int r = 0; r < 8; ++r) { const int m = m0 + r;
        const f32x4 v = vv[r];
        const float sq = v[0] * v[0] + v[1] * v[1] + v[2] * v[2] + v[3] * v[3], sm = (v[0] + v[1]) + (v[2] + v[3]);
        const float kvss = wave_sum(l < 32 ? sq : 0.f);
        const float iks = wave_sum((l >= 32 && l < 48) ? sm : 0.f);
        const float ikmean = iks * (1.f / 64.f);
        const f32x4 dv = v - ikmean;
        const float ikq = wave_sum((l >= 32 && l < 48) ? (dv[0] * dv[0] + dv[1] * dv[1] + dv[2] * dv[2] + dv[3] * dv[3]) : 0.f);
        if (l < 32) { const float rr = 1.f / sqrtf(kvss * (1.f / 128.f) + LN_EPS); const f32x4 o = v * rr * w1;
            u32x2 pk; pk.x = cvt_pk_bf16(o[0], o[1]); pk.y = cvt_pk_bf16(o[2], o[3]); *((u32x2*)(KV + (size_t)m * 128) + l) = pk; }
        else if (l < 48) { const float rr = 1.f / sqrtf(ikq * (1.f / 64.f) + LN_EPS); const f32x4 o = dv * rr * w1 + w2;
            u32x2 pk; pk.x = cvt_pk_bf16(o[0], o[1]); pk.y = cvt_pk_bf16(o[2], o[3]); *((u32x2*)(IK + (size_t)m * 64) + (l - 32)) = pk; }
        else if (l < 50) { *((f32x4*)(IW + (size_t)m * 8) + (l - 48)) = v * 0.35355339059327373f; }
        else if (l < 54) { f32x4 o;
#pragma unroll
            for (int j = 0; j < 4; ++j) { const float t = v[j] + w1[j]; o[j] = t > 20.f ? t : log1pf(__expf(t)); }
            *((f32x4*)(DT + (size_t)m * 16) + (l - 50)) = o; }
    } }
__device__ __forceinline__ void ph_misc(Frame& F) {
    const float* MISC = (const float*)(F.outb + OUT_MISC);
    const float* kvw = F.a->in[5]; const float* ikw = F.a->in[6]; const float* ikb = F.a->in[7]; const float* dtb = F.a->in[11];
    const int gw = F.bid * NWAVES + F.wave, NGW = F.G * NWAVES, l = F.lane;
    const int RPW = (((NTOK + NGW - 1) / NGW) + 7) & ~7;
    const int mbeg = gw * RPW, mend = (mbeg + RPW < NTOK) ? mbeg + RPW : NTOK;
    if (mbeg >= mend) return;
    f32x4 w1 = (f32x4){0.f, 0.f, 0.f, 0.f}, w2 = w1;
    if (l < 32) w1 = *((const f32x4*)kvw + l); else if (l < 48) { w1 = *((const f32x4*)ikw + (l - 32)); w2 = *((const f32x4*)ikb + (l - 32)); } else if (l >= 50 && l < 54) w1 = *((const f32x4*)dtb + (l - 50));
    f32x4 va[8], vb[8];
    int m0 = mbeg;
    misc_load(MISC, m0, l, va);
    for (;;) {
        const int m1 = m0 + 8; const bool v1 = m1 < mend;
        if (v1) misc_load(MISC, m1, l, vb);
        misc_proc(F, m0, va, w1, w2);
        if (!v1) break;
        const int m2 = m1 + 8; const bool v2 = m2 < mend;
        if (v2) misc_load(MISC, m2, l, va);
        misc_proc(F, m1, vb, w1, w2);
        if (!v2) break;
        m0 = m2;
    }
}

__device__ __forceinline__ unsigned sortable_key(float s) { const unsigned u = __float_as_uint(s + 0.0f); return (u & 0x80000000u) ? ~u : (u | 0x80000000u); }
template <int NKB> struct KeyRow { unsigned k[NKB]; };
__device__ __forceinline__ u64 low_bits_keep(u64 m, int t) { u64 out = 0; while (t-- > 0 && m) { const u64 b = m & (0 - m); out |= b; m ^= b; } return out; }
namespace idx { constexpr int KST = 144, KBUF = 64 * KST; }
__device__ __forceinline__ unsigned low_bits_keep32(unsigned m, int t) { unsigned out = 0; while (t-- > 0 && m) { const unsigned b = m & (0u - m); out |= b; m ^= b; } return out; }
template <int NG> __device__ __forceinline__ void topk2_select_write(const unsigned (&key)[64], int nkb, u64* mrow, int lane) {
    constexpr int NR = NG * 16;
    unsigned T0 = 0u, T1 = 0u; bool ex0 = false, ex1 = false;
    unsigned lo0 = 0u, lo1 = 0u, hi0 = 0xFFFFFFFFu, hi1 = 0xFFFFFFFFu, st0, st1, p0, p1; bool fin0 = false, fin1 = false;
    { float sm = 0.f, sq = 0.f;
#pragma unroll
        for (int m = 0; m < 10; ++m) { const unsigned k = key[m]; const float f = __uint_as_float((k & 0x80000000u) ? (k ^ 0x80000000u) : ~k); sm += f; sq += f * f; }
        sm = dpp_half_sums_f32(sm); sq = dpp_half_sums_f32(sq);
        const float mu = sm * (1.f / 320.f), sd = sqrtf(fmaxf(sq * (1.f / 320.f) - mu * mu, 1e-20f));
        const float qq = 256.f / (64.f * (float)nkb), pp = qq < 0.5f ? qq : 1.f - qq, tt = sqrtf(-2.f * __logf(pp));
        float z = tt - (2.515517f + 0.802853f * tt + 0.010328f * tt * tt) / (1.f + 1.432788f * tt + 0.189269f * tt * tt + 0.001308f * tt * tt * tt); if (qq >= 0.5f) z = -z;
        const unsigned pe = sortable_key(mu + z * sd), pd = sortable_key(mu + z * sd + 0.125f * sd);
        unsigned stp = pd - pe; if (stp < 1024u) stp = 1024u;
        p0 = __builtin_amdgcn_readlane((int)pe, 31); p1 = __builtin_amdgcn_readlane((int)pe, 63); st0 = __builtin_amdgcn_readlane((int)stp, 31); st1 = __builtin_amdgcn_readlane((int)stp, 63); }
#pragma nounroll
    for (int it = 0; it < 80; ++it) {
        const unsigned candv = lane < 32 ? p0 : p1;
        unsigned cl = 0u;
#pragma unroll
        for (int m = 0; m < NR; m += 4) { u64 s0, s1, s2, s3;
            asm("v_cmp_ge_u32_e64 %1, %5, %9\n\tv_cmp_ge_u32_e64 %2, %6, %9\n\tv_cmp_ge_u32_e64 %3, %7, %9\n\tv_cmp_ge_u32_e64 %4, %8, %9\n\t"
                "v_addc_co_u32_e64 %0, %1, 0, %0, %1\n\tv_addc_co_u32_e64 %0, %2, 0, %0, %2\n\tv_addc_co_u32_e64 %0, %3, 0, %0, %3\n\tv_addc_co_u32_e64 %0, %4, 0, %0, %4"
                : "+v"(cl), "=&s"(s0), "=&s"(s1), "=&s"(s2), "=&s"(s3) : "v"(key[m]), "v"(key[m + 1]), "v"(key[m + 2]), "v"(key[m + 3]), "v"(candv)); }
        cl = dpp_half_sums_u32(cl);
        const int n0 = __builtin_amdgcn_readlane((int)cl, 31), n1 = __builtin_amdgcn_readlane((int)cl, 63);
#define IDX_STEP(lo, hi, st, p, T, ex, fin, n) do { if (!fin) { \
            if (n == 256) { T = p; ex = true; fin = true; } \
            else { if (n > 256) lo = p; else hi = p; \
                if (hi - lo <= 1u) { T = lo; fin = true; } \
                else { unsigned c; if (hi == 0xFFFFFFFFu) { c = lo + st; if (c < lo) c = hi; st = st << 1; } else if (lo == 0u) { c = hi - st; if (c > hi) c = lo; st = st << 1; } else c = lo + ((hi - lo) >> 1); \
                    if (c <= lo || c >= hi) c = lo + ((hi - lo) >> 1); p = c; } } } } while (0)
        IDX_STEP(lo0, hi0, st0, p0, T0, ex0, fin0, n0);
        IDX_STEP(lo1, hi1, st1, p1, T1, ex1, fin1, n1);
#undef IDX_STEP
        if (fin0 && fin1) break;
    }
    const unsigned Tv = lane < 32 ? T0 : T1;
    if (ex0 && ex1) {
        unsigned mlo = 0u, mhi = 0u;
#pragma unroll
        for (int j = 0; j < NR / 2; ++j) {
            const u64 b0 = __ballot(key[2 * j] >= Tv), b1 = __ballot(key[2 * j + 1] >= Tv);
            asm volatile("s_nop 1\n\tv_writelane_b32 %0, %2, %6\n\tv_writelane_b32 %0, %3, %7\n\tv_writelane_b32 %1, %4, %6\n\tv_writelane_b32 %1, %5, %7"
                         : "+v"(mlo), "+v"(mhi) : "s"((unsigned)b0), "s"((unsigned)(b0 >> 32)), "s"((unsigned)b1), "s"((unsigned)(b1 >> 32)), "n"(j), "n"(32 + j));
            if ((j & 3) == 3) SBAR();
        }
        const int jl = lane & 31;
        if (jl < nkb) mrow[(lane >> 5) * 32 + jl] = (u64)mlo | ((u64)mhi << 32);
        return;
    }
    int rem0 = 1 << 30, rem1 = 1 << 30;
    { int g0 = 0, g1 = 0;
#pragma unroll
        for (int m = 0; m < NR; ++m) { const u64 mk = __ballot(key[m] > Tv); g0 += __builtin_popcount((unsigned)mk); g1 += __builtin_popcount((unsigned)(mk >> 32)); if ((m & 7) == 7) SBAR(); }
        if (!ex0) rem0 = 256 - g0; if (!ex1) rem1 = 256 - g1; }
    u64 mine = 0ull;
#pragma nounroll
    for (int jq = 0; jq < NR / 8; ++jq) {
#pragma unroll
        for (int jj = 0; jj < 4; ++jj) { const int j = jq * 4 + jj;
            unsigned w0[2], w1[2];
#pragma unroll
            for (int hh = 0; hh < 2; ++hh) { unsigned kv = 0u;
#pragma unroll
                for (int m = 0; m < NR; ++m) if ((m >> 3) == 0) {}
#pragma unroll
                for (int m = 0; m < NR; ++m) kv = (m == 2 * j + hh) ? key[m] : kv;
                const u64 gt = __ballot(kv > Tv), eq = __ballot(kv == Tv);
                { const unsigned e = (unsigned)eq, g = (unsigned)gt; const int ne = __builtin_popcount(e); unsigned sel = g; if (rem0 >= ne) { sel |= e; rem0 -= ne; } else if (rem0 > 0) { sel |= low_bits_keep32(e, rem0); rem0 = 0; } w0[hh] = sel; }
                { const unsigned e = (unsigned)(eq >> 32), g = (unsigned)(gt >> 32); const int ne = __builtin_popcount(e); unsigned sel = g; if (rem1 >= ne) { sel |= e; rem1 -= ne; } else if (rem1 > 0) { sel |= low_bits_keep32(e, rem1); rem1 = 0; } w1[hh] = sel; } }
            const u64 q0w = (u64)w0[0] | ((u64)w0[1] << 32), q1w = (u64)w1[0] | ((u64)w1[1] << 32);
            if (lane == j) mine = q0w; if (lane == 32 + j) mine = q1w; }
    }
    const int jl = lane & 31;
    if (jl < nkb) mrow[(lane >> 5) * 32 + jl] = mine;
}
template <int J0> __device__ __forceinline__ void index_scores8(unsigned (&key)[64], const bf16x8 (&af)[2], const f32x4& iw4, const bf16_t* kvsrc, char* lds, int nkb, u32x4 (&stg)[8], int tid) {
    const int lane = tid & 63, sub = lane & 15, kg = lane >> 4;
#pragma unroll
    for (int jj = 0; jj < 8; ++jj) {
        const int j = J0 + jj;
        if (j < nkb) {
            if (j + 1 < nkb) *(u32x4*)(lds + ((j + 1) & 1) * idx::KBUF + (tid >> 3) * idx::KST + (tid & 7) * 16) = stg[(jj + 1) & 7];
            if (j + 8 < nkb) stg[jj] = *(const u32x4*)(kvsrc + (size_t)(j + 8) * 64 * 64);
            const char* kb = lds + (j & 1) * idx::KBUF + sub * idx::KST + kg * 16;
#pragma unroll
            for (int pr = 0; pr < 2; ++pr) {
                f32x4 dA = (f32x4){0.f, 0.f, 0.f, 0.f}, dB = dA;
#pragma unroll
                for (int ks = 0; ks < 2; ++ks) {
                    const bf16x8 fA = *(const bf16x8*)(kb + (pr * 32) * idx::KST + ks * 64), fB = *(const bf16x8*)(kb + (pr * 32 + 16) * idx::KST + ks * 64);
                    dA = __builtin_amdgcn_mfma_f32_16x16x32_bf16(af[ks], fA, dA, 0, 0, 0); dB = __builtin_amdgcn_mfma_f32_16x16x32_bf16(af[ks], fB, dB, 0, 0, 0); }
                float pA = 0.f, pB = 0.f;
#pragma unroll
                for (int r = 0; r < 4; ++r) { pA += fmaxf(dA[r], 0.f) * iw4[r]; pB += fmaxf(dB[r], 0.f) * iw4[r]; }
                auto rr = __builtin_amdgcn_permlane16_swap(__float_as_uint(pA), __float_as_uint(pB), false, false);
                key[2 * j + pr] = sortable_key(__uint_as_float(rr[0]) + __uint_as_float(rr[1]));
            }
            __syncthreads();
        }
    }
}
__device__ __forceinline__ void ph_index(Frame& F, const int abl = 0) {
    const bf16_t* IQ = (const bf16_t*)(F.outb + OUT_IQ); const bf16_t* IK = (const bf16_t*)(F.outb + OUT_IK); const float* IW = (const float*)(F.outb + OUT_IW);
    u64* MASK = (u64*)(F.outb + OUT_MASK);
    char* lds = (char*)(unsigned char*)F.lds;
    const int tid = F.tid, lane = F.lane, sub = lane & 15, kg = lane >> 4;
    for (int item = F.bid; item < NTOK / 16; item += F.G) {
        const int tokw = (((item & 255) >> 3) << 11) + (((item & 7) + 8 * (item >> 8)) << 4) + F.wave * 2, b = tokw >> 11, pos0 = tokw & 2047, nkb = (pos0 >> 6) + 1;
        u64* mrow = MASK + (size_t)tokw * 32;
        if (nkb <= 4) { if ((lane & 31) < nkb) mrow[(lane >> 5) * 32 + (lane & 31)] = ~0ull; continue; }
        bf16x8 af[2];
        { const bf16_t* ap = IQ + (size_t)(tokw + (sub >> 3)) * 512 + (sub & 7) * 64 + kg * 8;
#pragma unroll
          for (int ks = 0; ks < 2; ++ks) af[ks] = *(const bf16x8*)(ap + ks * 32); }
        const f32x4 iw4 = *(const f32x4*)(IW + (size_t)(tokw + (lane >> 5)) * 8 + 4 * (kg & 1));
        unsigned key[64];
#pragma unroll
        for (int m = 0; m < 64; ++m) key[m] = 0u;
        const bf16_t* kvsrc = IK + ((size_t)b * SEQ + (tid >> 3)) * 64 + (tid & 7) * 8;
        u32x4 stg[8];
#pragma unroll
        for (int i = 0; i < 8; ++i) stg[i] = (i < nkb) ? *(const u32x4*)(kvsrc + (size_t)i * 64 * 64) : (u32x4){0u, 0u, 0u, 0u};
        __syncthreads();
        *(u32x4*)(lds + (tid >> 3) * idx::KST + (tid & 7) * 16) = stg[0];
        __syncthreads();
        const int ng = (nkb + 7) >> 3;
        if (!(abl & 1)) {
        index_scores8<0>(key, af, iw4, kvsrc, lds, nkb, stg, tid);
        if (ng > 1) index_scores8<8>(key, af, iw4, kvsrc, lds, nkb, stg, tid);
        if (ng > 2) index_scores8<16>(key, af, iw4, kvsrc, lds, nkb, stg, tid);
        if (ng > 3) index_scores8<24>(key, af, iw4, kvsrc, lds, nkb, stg, tid);
        }
        if (abl & 2) { if (key[0] == 0x12345u && key[63] == 7u) mrow[lane] = 1ull; continue; }
        if (ng == 1) topk2_select_write<1>(key, nkb, mrow, lane);
        else if (ng == 2) topk2_select_write<2>(key, nkb, mrow, lane);
        else if (ng == 3) topk2_select_write<3>(key, nkb, mrow, lane);
        else topk2_select_write<4>(key, nkb, mrow, lane);
    }
}

namespace att {
constexpr int KVBLK = 64;
constexpr int SHM_V = KVBLK * 128 * 2, SHM_K = SHM_V;
constexpr int OFF_V = 0, OFF_K = 2 * SHM_V, OFF_WS = 2 * SHM_V + 2 * SHM_K, OFF_BT = OFF_WS + NWAVES * 64 * 4;
constexpr int OFF_OT = 81920, OT_ST = 144;
#define KSWZ(row, colB) ((row) * 256 + ((colB) ^ (((row) & 7) << 4)))
__device__ __forceinline__ int crow(int r, int hi) { return (r & 3) + 8 * (r >> 2) + 4 * hi; }
__device__ __forceinline__ int v_st(int k, int c) { const int kk = (k & ~0xC) | ((k & 4) << 1) | ((k & 8) >> 1); return ((kk >> 3) * 4 + (c >> 5)) * 512 + ((kk & 7) * 32 + (c & 31)) * 2; }
__device__ __forceinline__ int v_rd_base(int lane) { return ((lane & 3) << 3) | (((lane >> 2) & 3) << 6) | (((lane >> 4) & 1) << 5) | (((lane >> 5) & 1) << 8); }
constexpr int v_rd_off(int d0, int ks, int half) { return d0 * 512 + ks * 4096 + half * 2048; }
template <int OFF> __device__ __forceinline__ s16x4 tr_read(int vb) { s16x4 r; asm volatile("ds_read_b64_tr_b16 %0, %1 offset:%2" : "=&v"(r) : "v"(vb), "i"(OFF) : "memory"); return r; }
template <int D0> __device__ __forceinline__ void pv_one(f32x16& od, int vb, bf16x8 pa0, bf16x8 pa1, bf16x8 pa2, bf16x8 pa3) {
    const s16x4 l0 = tr_read<v_rd_off(D0, 0, 0)>(vb), h0 = tr_read<v_rd_off(D0, 0, 1)>(vb), l1 = tr_read<v_rd_off(D0, 1, 0)>(vb), h1 = tr_read<v_rd_off(D0, 1, 1)>(vb);
    const s16x4 l2 = tr_read<v_rd_off(D0, 2, 0)>(vb), h2 = tr_read<v_rd_off(D0, 2, 1)>(vb), l3 = tr_read<v_rd_off(D0, 3, 0)>(vb), h3 = tr_read<v_rd_off(D0, 3, 1)>(vb);
    asm volatile("s_waitcnt lgkmcnt(0)" ::: "memory"); SBAR();
#define PK(L, H) (bf16x8){L[0], L[1], L[2], L[3], H[0], H[1], H[2], H[3]}
    od = __builtin_amdgcn_mfma_f32_32x32x16_bf16(pa0, PK(l0, h0), od, 0, 0, 0);
    od = __builtin_amdgcn_mfma_f32_32x32x16_bf16(pa1, PK(l1, h1), od, 0, 0, 0);
    od = __builtin_amdgcn_mfma_f32_32x32x16_bf16(pa2, PK(l2, h2), od, 0, 0, 0);
    od = __builtin_amdgcn_mfma_f32_32x32x16_bf16(pa3, PK(l3, h3), od, 0, 0, 0);
#undef PK
}
__device__ __forceinline__ void qkt(f32x16& p0, f32x16& p1, const char* Ks, const bf16x8* qr, int r32, int hi) {
    p0 = f32x16{}; p1 = f32x16{};
    int rv = r32; asm volatile("" : "+v"(rv));
    const char* kb = Ks + rv * 256; const int swz = ((rv & 7) << 4) ^ (hi * 16);
#pragma unroll
    for (int d0 = 0; d0 < 8; ++d0) { const char* ka = kb + ((d0 * 32) ^ swz);
        const bf16x8 b0 = *reinterpret_cast<const bf16x8*>(ka);
        const bf16x8 b1 = *reinterpret_cast<const bf16x8*>(ka + 8192);
        p0 = __builtin_amdgcn_mfma_f32_32x32x16_bf16(b0, qr[d0], p0, 0, 0, 0);
        p1 = __builtin_amdgcn_mfma_f32_32x32x16_bf16(b1, qr[d0], p1, 0, 0, 0); }
}
__device__ __forceinline__ void attn_item(Frame& F, int b, int q0, char* lds) {
    const bf16_t* Q = (const bf16_t*)(F.ws + WS_Q); const bf16_t* KV = (const bf16_t*)(F.outb + OUT_KV); const u64* MASK = (const u64*)(F.outb + OUT_MASK);
    bf16_t* OA = (bf16_t*)(F.outb + OUT_OA);
    int tid = F.tid; asm volatile("" : "+v"(tid));
    const int wid = F.wave, lane = tid & 63, r32 = lane & 31, hi = lane >> 5;
    char* V_lds = lds + OFF_V; char* K_lds = lds + OFF_K;
    float* wsl = (float*)(lds + OFF_WS) + wid * 64; float* li_l = wsl; float* al_l = wsl + 32;
    const float* btab = (const float*)(lds + OFF_BT);
    constexpr float C = 0.088388347648318440f * LOG2E;
    float m_reg = -1e30f, l_reg = 0.f; f32x16 o[4] = {}; bf16x8 qr[8];
    const size_t tokq = (size_t)b * SEQ + q0 + r32;
    { const bf16_t* Qw = Q + tokq * 1024 + wid * 128 + hi * 8;
#pragma unroll
      for (int d0 = 0; d0 < 8; ++d0) qr[d0] = *(const bf16x8*)(Qw + d0 * 16); }
    const u64* mq = MASK + tokq * 32;
    const int sr = tid >> 4, sc = (tid & 15) * 8;
    const int vb0 = (int)(uintptr_t)V_lds + v_rd_base(lane);
    const bf16_t* Kb = KV + (size_t)b * SEQ * 128;
    const int NT = (q0 >> 6) + 1;
    const float bfar = btab[wid];
    bf16x8 s0, s1;
#define SLOAD(k0) do { s0 = *(const bf16x8*)(Kb + (size_t)((k0) + sr) * 128 + sc); s1 = *(const bf16x8*)(Kb + (size_t)((k0) + 32 + sr) * 128 + sc); } while (0)
#define SWRITE(bf) do { int srv = sr; asm volatile("" : "+v"(srv)); const int kc = sc * 2; const int v0a = v_st(srv, sc), k0a = KSWZ(srv, kc); \
        *(bf16x8*)(V_lds + (bf) * SHM_V + v0a) = s0; *(bf16x8*)(V_lds + (bf) * SHM_V + v0a + 8192) = s1; \
        *(bf16x8*)(K_lds + (bf) * SHM_K + k0a) = s0; *(bf16x8*)(K_lds + (bf) * SHM_K + k0a + 8192) = s1; } while (0)
    __syncthreads();
    SLOAD(0); VM_WAIT(); SWRITE(0); __syncthreads();
    u64 mw_next = mq[0];
    for (int j = 0; j < NT; ++j) {
        int lanel = lane; asm volatile("" : "+v"(lanel)); const int r32l = lanel & 31, hil = lanel >> 5;
        const int bf = j & 1;
        if (j + 1 < NT) SLOAD((j + 1) * KVBLK);
        const u64 mw = mw_next; if (j + 1 < NT) mw_next = mq[j + 1];
        f32x16 p0, p1;
        qkt(p0, p1, K_lds + bf * SHM_K, qr, r32l, hil);
        const unsigned w0 = (unsigned)(mw >> (4 * hil)), w1 = (unsigned)(mw >> (32 + 4 * hil));
        const int relmax = j * KVBLK + 63 - q0;
        float alpha = 1.f, ps = 0.f;
        if (relmax <= -91) {
            float pmax = p0[0];
#pragma unroll
            for (int r = 1; r < 16; ++r) pmax = fmaxf(pmax, p0[r]);
#pragma unroll
            for (int r = 0; r < 16; ++r) pmax = fmaxf(pmax, p1[r]);
            { auto rr = __builtin_amdgcn_permlane32_swap(__float_as_uint(pmax), __float_as_uint(pmax), false, false); pmax = fmaxf(__uint_as_float(rr[0]), __uint_as_float(rr[1])); }
            pmax = fmaf(pmax, C, bfar);
            if (!__all(pmax - m_reg <= 11.0f)) { const float mn = fmaxf(m_reg, pmax); alpha = __builtin_amdgcn_exp2f(m_reg - mn); m_reg = mn; }
            const float off = bfar - m_reg;
#pragma unroll
            for (int r = 0; r < 16; ++r) { const int cb = (r & 3) + 8 * (r >> 2);
                const float e0 = __builtin_amdgcn_exp2f(fmaf(p0[r], C, off)), e1 = __builtin_amdgcn_exp2f(fmaf(p1[r], C, off));
                p0[r] = __uint_as_float(__float_as_uint(e0) & (unsigned)__builtin_amdgcn_sbfe((int)w0, cb, 1)); p1[r] = __uint_as_float(__float_as_uint(e1) & (unsigned)__builtin_amdgcn_sbfe((int)w1, cb, 1)); ps += p0[r] + p1[r]; }
        } else {
            const float* bp = btab + (j * KVBLK + 4 * hil - (q0 + r32l) + 185) * 8 + wid;
#pragma unroll
            for (int r4 = 0; r4 < 4; ++r4) {
#pragma unroll
                for (int rr = 0; rr < 4; ++rr) { const int r = r4 * 4 + rr; const int cb = (r & 3) + 8 * (r >> 2); p0[r] = fmaf(p0[r], C, bp[cb * 8]); p1[r] = fmaf(p1[r], C, bp[(cb + 32) * 8]); }
                SBAR(); }
            float pmax = p0[0];
#pragma unroll
            for (int r = 1; r < 16; ++r) pmax = fmaxf(pmax, p0[r]);
#pragma unroll
            for (int r = 0; r < 16; ++r) pmax = fmaxf(pmax, p1[r]);
            { auto rr = __builtin_amdgcn_permlane32_swap(__float_as_uint(pmax), __float_as_uint(pmax), false, false); pmax = fmaxf(__uint_as_float(rr[0]), __uint_as_float(rr[1])); }
            if (!__all(pmax - m_reg <= 11.0f)) { const float mn = fmaxf(m_reg, pmax); alpha = __builtin_amdgcn_exp2f(m_reg - mn); m_reg = mn; }
#pragma unroll
            for (int r = 0; r < 16; ++r) { const int cb = (r & 3) + 8 * (r >> 2);
                const float e0 = __builtin_amdgcn_exp2f(p0[r] - m_reg), e1 = __builtin_amdgcn_exp2f(p1[r] - m_reg);
                p0[r] = __uint_as_float(__float_as_uint(e0) & (unsigned)__builtin_amdgcn_sbfe((int)w0, cb, 1)); p1[r] = __uint_as_float(__float_as_uint(e1) & (unsigned)__builtin_amdgcn_sbfe((int)w1, cb, 1)); ps += p0[r] + p1[r]; }
        }
        { auto rr = __builtin_amdgcn_permlane32_swap(__float_as_uint(ps), __float_as_uint(ps), false, false); ps = __uint_as_float(rr[0]) + __uint_as_float(rr[1]); }
        l_reg = l_reg * alpha + ps;
        bf16x8 pa0, pa1, pa2, pa3;
#define PK4(P, BASE, OUT) do { unsigned a0 = cvt_pk_bf16(P[BASE + 0], P[BASE + 1]), a1 = cvt_pk_bf16(P[BASE + 2], P[BASE + 3]);   \
    unsigned b0 = cvt_pk_bf16(P[BASE + 4], P[BASE + 5]), b1 = cvt_pk_bf16(P[BASE + 6], P[BASE + 7]);                              \
    auto r0 = __builtin_amdgcn_permlane32_swap(a0, b0, false, false); auto r1 = __builtin_amdgcn_permlane32_swap(a1, b1, false, false); \
    u32x4 w = {r0[0], r1[0], r0[1], r1[1]}; OUT = *reinterpret_cast<bf16x8*>(&w); } while (0)
        PK4(p0, 0, pa0); PK4(p0, 8, pa1); PK4(p1, 0, pa2); PK4(p1, 8, pa3);
#undef PK4
        if (__any(alpha < 1.f)) { if (hil == 0) al_l[r32l] = alpha; LDS_WAIT();
#pragma unroll
            for (int d = 0; d < 4; ++d)
#pragma unroll
                for (int r = 0; r < 16; ++r) o[d][r] *= al_l[crow(r, hil)]; }
        const int vb = (int)(uintptr_t)V_lds + v_rd_base(lanel) + bf * SHM_V;
        pv_one<0>(o[0], vb, pa0, pa1, pa2, pa3); pv_one<1>(o[1], vb, pa0, pa1, pa2, pa3); pv_one<2>(o[2], vb, pa0, pa1, pa2, pa3); pv_one<3>(o[3], vb, pa0, pa1, pa2, pa3);
        if (j + 1 < NT) { VM_WAIT(); SWRITE(bf ^ 1); }
        __syncthreads();
    }
#undef SLOAD
#undef SWRITE
    if (hi == 0) li_l[r32] = l_reg; LDS_WAIT();
    bf16_t* Ow = OA + ((size_t)b * SEQ + q0 + 4 * hi) * 1024 + wid * 128 + r32;
    const float* lip = li_l + 4 * hi;
    unsigned char* Ow8 = (unsigned char*)OA + ((size_t)b * SEQ + q0 + 4 * hi) * 1024 + wid * 128 + r32;
    asm volatile("" : "+v"(Ow), "+v"(lip), "+v"(Ow8));
#pragma unroll
    for (int r = 0; r < 16; ++r) { const int ro = (r & 3) + 8 * (r >> 2); if ((r & 3) == 0) asm volatile("" : "+v"(Ow), "+v"(Ow8), "+v"(lip)); const float rl = fast_rcp(lip[ro]);
#pragma unroll
        for (int d0 = 0; d0 < 4; ++d0) { float v = o[d0][r] * rl; if ((DBG_ATTN_ZERO == 1 && q0 < 256) || (DBG_ATTN_ZERO == 2 && q0 >= 256)) v = 0.f;
            if (PA_FP8) ((unsigned char*)Ow8)[ro * 1024 + d0 * 32] = (unsigned char)(__builtin_amdgcn_cvt_pk_fp8_f32(v, v, 0, false) & 0xff);
            else Ow[ro * 1024 + d0 * 32] = (bf16_t)(cvt_pk_bf16(v, v) & 0xffffu); }
        if ((r & 3) == 3) SBAR(); }
}
__device__ __forceinline__ void att2_partial(f32x16& p0, f32x16& p1, float& m_reg, float& alpha, unsigned w0, bool far, float bfar, const float* bp) {
    constexpr float C = 0.088388347648318440f * LOG2E;
    float off;
    if (far) {
        float pmax = p0[0];
#pragma unroll
        for (int r = 1; r < 16; ++r) pmax = fmaxf(pmax, p0[r]);
#pragma unroll
        for (int r = 0; r < 16; ++r) pmax = fmaxf(pmax, p1[r]);
        { auto rr = __builtin_amdgcn_permlane32_swap(__float_as_uint(pmax), __float_as_uint(pmax), false, false); pmax = fmaxf(__uint_as_float(rr[0]), __uint_as_float(rr[1])); }
        pmax = fmaf(pmax, C, bfar);
        if (__builtin_expect(__all(pmax - m_reg <= 11.0f), 1)) alpha = 1.f; else { const float mn = fmaxf(m_reg, pmax); alpha = __builtin_amdgcn_exp2f(m_reg - mn); m_reg = mn; }
        off = bfar - m_reg;
#pragma unroll
        for (int r = 0; r < 16; ++r) { p0[r] = fmaf(p0[r], C, off); p1[r] = fmaf(p1[r], C, off); }
    } else {
#pragma unroll
        for (int r4 = 0; r4 < 4; ++r4) {
#pragma unroll
            for (int rr = 0; rr < 4; ++rr) { const int r = r4 * 4 + rr; const int cb = (r & 3) + 8 * (r >> 2); p0[r] = fmaf(p0[r], C, bp[cb * 8]); p1[r] = fmaf(p1[r], C, bp[(cb + 32) * 8]); }
            SBAR(); }
        float pmax = p0[0];
#pragma unroll
        for (int r = 1; r < 16; ++r) pmax = fmaxf(pmax, p0[r]);
#pragma unroll
        for (int r = 0; r < 16; ++r) pmax = fmaxf(pmax, p1[r]);
        { auto rr = __builtin_amdgcn_permlane32_swap(__float_as_uint(pmax), __float_as_uint(pmax), false, false); pmax = fmaxf(__uint_as_float(rr[0]), __uint_as_float(rr[1])); }
        if (__builtin_expect(__all(pmax - m_reg <= 11.0f), 1)) alpha = 1.f; else { const float mn = fmaxf(m_reg, pmax); alpha = __builtin_amdgcn_exp2f(m_reg - mn); m_reg = mn; }
#pragma unroll
        for (int r = 0; r < 16; ++r) { p0[r] -= m_reg; p1[r] -= m_reg; }
    }
#pragma unroll
    for (int r = 0; r < 16; ++r) { const int cb = (r & 3) + 8 * (r >> 2); p0[r] = __uint_as_float(__float_as_uint(__builtin_amdgcn_exp2f(p0[r])) & (unsigned)__builtin_amdgcn_sbfe((int)w0, cb, 1)); }
}
__device__ __forceinline__ void att2_finish(f32x16& p0, f32x16& p1, float alpha, float& l_reg, unsigned w1, bf16x8& pa0, bf16x8& pa1, bf16x8& pa2, bf16x8& pa3) {
#pragma unroll
    for (int r = 0; r < 16; ++r) { const int cb = (r & 3) + 8 * (r >> 2); p1[r] = __uint_as_float(__float_as_uint(__builtin_amdgcn_exp2f(p1[r])) & (unsigned)__builtin_amdgcn_sbfe((int)w1, cb, 1)); }
    float ps = 0.f;
#pragma unroll
    for (int r = 0; r < 16; ++r) ps += p0[r];
#pragma unroll
    for (int r = 0; r < 16; ++r) ps += p1[r];
    { auto rr = __builtin_amdgcn_permlane32_swap(__float_as_uint(ps), __float_as_uint(ps), false, false); ps = __uint_as_float(rr[0]) + __uint_as_float(rr[1]); }
    l_reg = l_reg * alpha + ps;
#define PK4(P, BASE, OUT) do { unsigned a0 = cvt_pk_bf16(P[BASE + 0], P[BASE + 1]), a1 = cvt_pk_bf16(P[BASE + 2], P[BASE + 3]);   \
    unsigned b0 = cvt_pk_bf16(P[BASE + 4], P[BASE + 5]), b1 = cvt_pk_bf16(P[BASE + 6], P[BASE + 7]);                              \
    auto r0 = __builtin_amdgcn_permlane32_swap(a0, b0, false, false); auto r1 = __builtin_amdgcn_permlane32_swap(a1, b1, false, false); \
    u32x4 w = {r0[0], r1[0], r0[1], r1[1]}; OUT = *reinterpret_cast<bf16x8*>(&w); } while (0)
    PK4(p0, 0, pa0); PK4(p0, 8, pa1); PK4(p1, 0, pa2); PK4(p1, 8, pa3);
#undef PK4
}
__device__ __forceinline__ void attn_item2(Frame& F, int b, int q0, char* lds) {
    const bf16_t* Q = (const bf16_t*)(F.ws + WS_Q); const bf16_t* KV = (const bf16_t*)(F.outb + OUT_KV); const u64* MASK = (const u64*)(F.outb + OUT_MASK);
    bf16_t* OA = (bf16_t*)(F.outb + OUT_OA);
    int tid = F.tid; asm volatile("" : "+v"(tid));
    const int wid = F.wave, lane = tid & 63, r32 = lane & 31, hi = lane >> 5;
    char* V_lds = lds + OFF_V; char* K_lds = lds + OFF_K;
    float* wsl = (float*)(lds + OFF_WS) + wid * 64; float* li_l = wsl; float* al_l = wsl + 32;
    const float* btab = (const float*)(lds + OFF_BT);
    float m_reg = -1e30f, l_reg = 0.f; f32x16 o[4] = {}; bf16x8 qr[8];
    const size_t tokq = (size_t)b * SEQ + q0 + r32;
    { const bf16_t* Qw = Q + tokq * 1024 + wid * 128 + hi * 8;
#pragma unroll
      for (int d0 = 0; d0 < 8; ++d0) qr[d0] = *(const bf16x8*)(Qw + d0 * 16); }
    const u64* mq = MASK + tokq * 32;
    const int sr = tid >> 4, sc = (tid & 15) * 8;
    const bf16_t* Kb = KV + (size_t)b * SEQ * 128;
    const int NTr = (q0 >> 6) + 1, NT = (NTr + 1) & ~1;
    const float bfar = btab[wid];
    bf16x8 sA0, sA1, sB0, sB1;
#define SLD(s0_, s1_, k0) do { int srl = sr; asm volatile("" : "+v"(srl)); const bf16_t* kp_ = Kb + (size_t)((k0) + srl) * 128 + sc; s0_ = *(const bf16x8*)kp_; s1_ = *(const bf16x8*)(kp_ + 32 * 128); } while (0)
#define SWR(bf, s0_, s1_) do { int srv = sr; asm volatile("" : "+v"(srv)); const int kc = sc * 2; const int v0a = v_st(srv, sc), k0a = KSWZ(srv, kc); \
        *(bf16x8*)(V_lds + (bf) * SHM_V + v0a) = s0_; *(bf16x8*)(V_lds + (bf) * SHM_V + v0a + 8192) = s1_; \
        *(bf16x8*)(K_lds + (bf) * SHM_K + k0a) = s0_; *(bf16x8*)(K_lds + (bf) * SHM_K + k0a + 8192) = s1_; } while (0)
#define MWORD(j) ((j) < NTr ? mq[j] : 0ull)
#define RESC(a) do { if (__any((a) < 1.f)) { if (hi == 0) al_l[r32] = (a); LDS_WAIT(); \
        _Pragma("unroll") for (int d = 0; d < 4; ++d) _Pragma("unroll") for (int r = 0; r < 16; ++r) o[d][r] *= al_l[crow(r, hi)]; } } while (0)
#define PVALL(bf) do { int ll = lane; asm volatile("" : "+v"(ll)); const int vb = (int)(uintptr_t)V_lds + v_rd_base(ll) + (bf) * SHM_V; \
        pv_one<0>(o[0], vb, pa0, pa1, pa2, pa3); pv_one<1>(o[1], vb, pa0, pa1, pa2, pa3); pv_one<2>(o[2], vb, pa0, pa1, pa2, pa3); pv_one<3>(o[3], vb, pa0, pa1, pa2, pa3); } while (0)
#define ISFAR(jt) ((jt) * KVBLK + 63 - q0 <= -91 || (jt) >= NTr)
#define BPTR(jt) (btab + ((jt) * KVBLK + 4 * hi - (q0 + r32) + 185) * 8 + wid)
    f32x16 pA0, pA1, pB0, pB1; float alA, alB; bf16x8 pa0, pa1, pa2, pa3; u64 mwA, mwB;
    __syncthreads();
    SLD(sA0, sA1, 0); mwA = MWORD(0); VM_WAIT(); SWR(0, sA0, sA1); __syncthreads();
    qkt(pA0, pA1, K_lds, qr, r32, hi);
    att2_partial(pA0, pA1, m_reg, alA, (unsigned)(mwA >> (4 * hi)), ISFAR(0), bfar, BPTR(0));
    SLD(sB0, sB1, KVBLK); mwB = MWORD(1); if (2 < NT) SLD(sA0, sA1, 2 * KVBLK);
    SWR(1, sB0, sB1); __syncthreads();
    for (int j = 1; j + 1 < NT; j += 2) {
        SBAR(); qkt(pB0, pB1, K_lds + SHM_K, qr, r32, hi);
        att2_finish(pA0, pA1, alA, l_reg, (unsigned)(mwA >> (32 + 4 * hi)), pa0, pa1, pa2, pa3); SBAR();
        SLD(sB0, sB1, (j + 2) * KVBLK); mwA = MWORD(j + 1); SBAR();
        PVALL(0);
        att2_partial(pB0, pB1, m_reg, alB, (unsigned)(mwB >> (4 * hi)), ISFAR(j), bfar, BPTR(j));
        __syncthreads(); SWR(0, sA0, sA1);
        RESC(alB); __syncthreads();
        SBAR(); qkt(pA0, pA1, K_lds, qr, r32, hi);
        att2_finish(pB0, pB1, alB, l_reg, (unsigned)(mwB >> (32 + 4 * hi)), pa0, pa1, pa2, pa3); SBAR();
        if (j + 3 < NT) SLD(sA0, sA1, (j + 3) * KVBLK); mwB = MWORD(j + 2); SBAR();
        PVALL(1);
        att2_partial(pA0, pA1, m_reg, alA, (unsigned)(mwA >> (4 * hi)), ISFAR(j + 1), bfar, BPTR(j + 1));
        __syncthreads(); SWR(1, sB0, sB1);
        RESC(alA); __syncthreads();
    }
    SBAR(); qkt(pB0, pB1, K_lds + SHM_K, qr, r32, hi);
    att2_finish(pA0, pA1, alA, l_reg, (unsigned)(mwA >> (32 + 4 * hi)), pa0, pa1, pa2, pa3); SBAR();
    PVALL(0);
    att2_partial(pB0, pB1, m_reg, alB, (unsigned)(mwB >> (4 * hi)), ISFAR(NT - 1), bfar, BPTR(NT - 1));
    __syncthreads(); RESC(alB);
    att2_finish(pB0, pB1, alB, l_reg, (unsigned)(mwB >> (32 + 4 * hi)), pa0, pa1, pa2, pa3); SBAR();
    PVALL(1);
#undef SLD
#undef SWR
#undef MWORD
#undef RESC
#undef PVALL
#undef ISFAR
#undef BPTR
    LAS float* li_s = (LAS float*)(F.lds + OFF_WS) + wid * 64;
    if (hi == 0) li_s[r32] = l_reg; LDS_WAIT();
    if (PA_FP8 && ATT_OT) {
        LAS unsigned char* ot = F.lds + OFF_OT + wid * (32 * OT_ST);
        int ob = (4 * hi) * OT_ST + r32, lo = 4 * hi; asm volatile("" : "+v"(ob), "+v"(lo));
#pragma unroll
        for (int r = 0; r < 16; ++r) { const int ro = (r & 3) + 8 * (r >> 2); if ((r & 3) == 0) asm volatile("" : "+v"(ob), "+v"(lo)); const float rl = fast_rcp(li_s[lo + ro]);
#pragma unroll
            for (int d0 = 0; d0 < 4; ++d0) { const float v = o[d0][r] * rl; ot[ob + ro * OT_ST + d0 * 32] = (unsigned char)(__builtin_amdgcn_cvt_pk_fp8_f32(v, v, 0, false) & 0xff); }
            if ((r & 3) == 3) SBAR(); }
        LDS_WAIT(); asm volatile("" ::: "memory");
        unsigned char* Og = (unsigned char*)OA + ((size_t)b * SEQ + q0) * 1024 + wid * 128;
        int rr = lane >> 3, sg = (lane & 7) * 16; asm volatile("" : "+v"(rr), "+v"(sg));
#pragma unroll
        for (int i = 0; i < 4; ++i) { const u32x4 w = *(const LAS u32x4*)(ot + (i * 8 + rr) * OT_ST + sg); *(u32x4*)(Og + (size_t)(i * 8 + rr) * 1024 + sg) = w; }
        LDS_WAIT();
    } else if (PA_FP8) {
        GAS unsigned char* Ow8 = (GAS unsigned char*)((unsigned char*)OA + ((size_t)b * SEQ + q0 + 4 * hi) * 1024 + wid * 128 + r32);
        int lo = 4 * hi; asm volatile("" : "+v"(Ow8), "+v"(lo));
#pragma unroll
        for (int r = 0; r < 16; ++r) { const int ro = (r & 3) + 8 * (r >> 2); if ((r & 3) == 0) asm volatile("" : "+v"(Ow8), "+v"(lo)); const float rl = fast_rcp(li_s[lo + ro]);
#pragma unroll
            for (int d0 = 0; d0 < 4; ++d0) { const float v = o[d0][r] * rl; Ow8[ro * 1024 + d0 * 32] = (unsigned char)(__builtin_amdgcn_cvt_pk_fp8_f32(v, v, 0, false) & 0xff); }
            if ((r & 3) == 3) SBAR(); }
    } else {
        bf16_t* Ow = OA + ((size_t)b * SEQ + q0 + 4 * hi) * 1024 + wid * 128 + r32;
        int lo = 4 * hi; asm volatile("" : "+v"(Ow), "+v"(lo));
#pragma unroll
        for (int r = 0; r < 16; ++r) { const int ro = (r & 3) + 8 * (r >> 2); if ((r & 3) == 0) asm volatile("" : "+v"(Ow), "+v"(lo)); const float rl = fast_rcp(li_s[lo + ro]);
#pragma unroll
            for (int d0 = 0; d0 < 4; ++d0) { const float v = o[d0][r] * rl; Ow[ro * 1024 + d0 * 32] = (bf16_t)(cvt_pk_bf16(v, v) & 0xffffu); }
            if ((r & 3) == 3) SBAR(); }
    }
}
}
__device__ __forceinline__ void ph_attn(Frame& F) {
    char* lds = (char*)(unsigned char*)F.lds;
    { float* bt = (float*)(lds + att::OFF_BT); const float* BT = (const float*)(F.ws + WS_BIAST); __syncthreads(); for (int i = F.tid; i < 249 * 8; i += NTHR) bt[i] = BT[i]; __syncthreads(); }
    for (int pr = F.bid; pr < NB * 32; pr += F.G) {
        const int b = pr >> 5, qb = pr & 31;
#pragma nounroll
        for (int hh = 0; hh < 2; ++hh) { if (ATT2) att::attn_item2(F, b, (hh ? qb : 63 - qb) * 32, lds); else att::attn_item(F, b, (hh ? qb : 63 - qb) * 32, lds); }
    }
}

namespace ssd {
constexpr int OFF_CS = 0, CS_ST = 272;
constexpr int OFF_BS = OFF_CS + 64 * CS_ST;
constexpr int OFF_BT = OFF_BS + 64 * CS_ST, T_ST = 144;
constexpr int OFF_XT = OFF_BT + 128 * T_ST;
constexpr int OFF_XW = OFF_XT + 64 * T_ST;
constexpr int OFF_XS = OFF_XW + 64 * T_ST;
constexpr int OFF_MT = OFF_XS + 64 * T_ST;
constexpr int OFF_HS = OFF_MT + 64 * T_ST;
constexpr int OFF_END = OFF_HS + 64 * CS_ST;
static_assert(OFF_END + 5 * 320 * 4 <= 131072, "ssd lds");
__device__ __forceinline__ f32x4 mfma16(bf16x8 a, bf16x8 b, f32x4 c) { return __builtin_amdgcn_mfma_f32_16x16x32_bf16(a, b, c, 0, 0, 0); }
__device__ __forceinline__ bf16x8 ldfrag(const char* base, int stride, int row, int k0) { return *(const bf16x8*)(base + row * stride + k0 * 2); }
}
__device__ __forceinline__ void ph_ssd(Frame& F) {
    using namespace ssd;
    char* lds = (char*)(unsigned char*)F.lds;
    const bf16_t* XBC = (const bf16_t*)(F.ws + WS_XBC); const bf16_t* ZS = (const bf16_t*)(F.ws + WS_Z); const float* DT = (const float*)(F.outb + OUT_DT);
    bf16_t* YG = (bf16_t*)(F.ws + WS_Q);
    const float* conv_w = F.a->in[9]; const float* conv_b = F.a->in[10]; const float* a_log = F.a->in[12]; const float* d_skip = F.a->in[13];
    const int tid = F.tid, wid = F.wave, lane = F.lane, fr = lane & 15, fq = lane >> 4;
    const bool stager = tid < 320; const int so = tid % 40, tg = tid / 40;
    for (int item = F.bid; item < NB * 16; item += F.G) {
        const int b = item >> 4, h = item & 15, g = h >> 2;
        const float aneg = -__expf(a_log[h]), dsk = d_skip[h];
        const int ch0 = so < 8 ? h * 64 + so * 8 : (so < 24 ? 1024 + g * 128 + (so - 8) * 8 : 1536 + g * 128 + (so - 24) * 8);
        float* CWL = (float*)(lds + OFF_END);
        __syncthreads();
        if (stager) {
#pragma unroll
            for (int j = 0; j < 4; ++j) { *(f32x4*)(CWL + j * 320 + so * 8) = *(const f32x4*)(conv_w + (size_t)j * 2048 + ch0); *(f32x4*)(CWL + j * 320 + so * 8 + 4) = *(const f32x4*)(conv_w + (size_t)j * 2048 + ch0 + 4); }
            *(f32x4*)(CWL + 4 * 320 + so * 8) = *(const f32x4*)(conv_b + ch0); *(f32x4*)(CWL + 4 * 320 + so * 8 + 4) = *(const f32x4*)(conv_b + ch0 + 4);
        }
        f32x4 hst[4];
#pragma unroll
        for (int t = 0; t < 4; ++t) hst[t] = (f32x4){0.f, 0.f, 0.f, 0.f};
        __syncthreads();
        for (int i = tid; i < 64 * CS_ST / 4; i += NTHR) ((unsigned*)(lds + OFF_HS))[i] = 0u;
        u32x4 raw[11];
        const size_t tokb = (size_t)b * SEQ;
#define SSD_LOAD(c) do { if (stager) { _Pragma("unroll") for (int i = 0; i < 11; ++i) { const int t = (c) * 64 + tg * 8 - 3 + i; \
            raw[i] = (t >= 0) ? *(const u32x4*)(XBC + (tokb + t) * 2048 + ch0) : (u32x4){0u, 0u, 0u, 0u}; } } } while (0)
        SSD_LOAD(0);
        float dtl_next = DT[(tokb + lane) * 16 + h];
        for (int c = 0; c < 32; ++c) {
            const float dtl = dtl_next; if (c + 1 < 32) dtl_next = DT[(tokb + (c + 1) * 64 + lane) * 16 + h];
            u32x2 zpre[2];
#pragma unroll
            for (int t2 = 0; t2 < 2; ++t2) { const int tile = 2 * wid + t2, pb = tile >> 2, lb = tile & 3; zpre[t2] = *(const u32x2*)(ZS + (tokb + c * 64 + lb * 16 + fr) * 1024 + h * 64 + pb * 16 + 4 * fq); }
            float acs = dtl * aneg;
#pragma unroll
            for (int o = 1; o < 64; o <<= 1) { const float t = __shfl_up(acs, o); if (lane >= o) acs += t; }
            const float alast = __shfl(acs, 63);
            if (DBG_SSD_SYNC) __syncthreads();
            float dtv[8], dec[8];
#pragma unroll
            for (int t = 0; t < 8; ++t) { dtv[t] = __shfl(dtl, (tg * 8 + t) & 63); dec[t] = __expf(alast - __shfl(acs, (tg * 8 + t) & 63)); }
            if (stager) {
#pragma unroll
                for (int hq = 0; hq < 2; ++hq) {
                    float xin[11][4];
#pragma unroll
                    for (int i = 0; i < 11; ++i) { const unsigned wa = hq ? raw[i].z : raw[i].x, wb = hq ? raw[i].w : raw[i].y; xin[i][0] = bflo(wa); xin[i][1] = bfhi(wa); xin[i][2] = bflo(wb); xin[i][3] = bfhi(wb); }
                    float outv[8][4];
                    { f32x4 cwv[4]; const f32x4 cbq = *(const f32x4*)(CWL + 4 * 320 + so * 8 + hq * 4);
#pragma unroll
                      for (int j = 0; j < 4; ++j) cwv[j] = *(const f32x4*)(CWL + j * 320 + so * 8 + hq * 4);
#pragma unroll
                      for (int t = 0; t < 8; ++t)
#pragma unroll
                        for (int e = 0; e < 4; ++e) { float sacc = cbq[e];
#pragma unroll
                            for (int j = 0; j < 4; ++j) sacc += cwv[j][e] * xin[t + j][e];
                            outv[t][e] = silu_f(sacc); } }
                    if (so < 8) {
#pragma unroll
                        for (int e = 0; e < 4; ++e) { const int p = so * 8 + hq * 4 + e;
                            f32x4 x0, x1, d0, d1, w0, w1;
#pragma unroll
                            for (int t = 0; t < 4; ++t) { x0[t] = outv[t][e]; x1[t] = outv[4 + t][e]; d0[t] = x0[t] * dtv[t]; d1[t] = x1[t] * dtv[4 + t]; w0[t] = d0[t] * dec[t]; w1[t] = d1[t] * dec[4 + t]; }
                            *(u32x4*)(lds + OFF_XS + p * T_ST + tg * 16) = pack8(x0, x1);
                            *(u32x4*)(lds + OFF_XT + p * T_ST + tg * 16) = pack8(d0, d1);
                            *(u32x4*)(lds + OFF_XW + p * T_ST + tg * 16) = pack8(w0, w1); }
                    } else {
                        const bool isB = so < 24; const int n0 = (isB ? (so - 8) : (so - 24)) * 8 + hq * 4;
                        char* nat = lds + (isB ? OFF_BS : OFF_CS);
#pragma unroll
                        for (int t = 0; t < 8; ++t) { u32x2 w; w.x = cvt_pk_bf16(outv[t][0], outv[t][1]); w.y = cvt_pk_bf16(outv[t][2], outv[t][3]);
                            *(u32x2*)(nat + (tg * 8 + t) * CS_ST + n0 * 2) = w; }
                        if (isB) {
#pragma unroll
                            for (int e = 0; e < 4; ++e) { f32x4 a, bq;
#pragma unroll
                                for (int t = 0; t < 4; ++t) { a[t] = outv[t][e]; bq[t] = outv[4 + t][e]; }
                                *(u32x4*)(lds + OFF_BT + (n0 + e) * T_ST + tg * 16) = pack8(a, bq); }
                        }
                    }
                }
            }
            if (c + 1 < 32) SSD_LOAD(c + 1);
            __syncthreads();
#pragma unroll
            for (int t2 = 0; t2 < 2; ++t2) {
                const int tile = 2 * wid + t2, sb = tile >> 2, lb = tile & 3;
                f32x4 d = (f32x4){0.f, 0.f, 0.f, 0.f};
                if (sb <= lb) {
#pragma unroll
                    for (int ks = 0; ks < 4; ++ks) d = mfma16(ldfrag(lds + OFF_BS, CS_ST, sb * 16 + fr, ks * 32 + fq * 8), ldfrag(lds + OFF_CS, CS_ST, lb * 16 + fr, ks * 32 + fq * 8), d);
                    const int l = lb * 16 + fr; const float al = __shfl(acs, l);
                    f32x4 as;
#pragma unroll
                    for (int r = 0; r < 4; ++r) as[r] = __shfl(acs, sb * 16 + 4 * fq + r);
#pragma unroll
                    for (int r = 0; r < 4; ++r) { const int s = sb * 16 + 4 * fq + r; d[r] = (s <= l) ? d[r] * __expf(al - as[r]) : 0.f; }
                }
                u32x2 w; w.x = cvt_pk_bf16(d[0], d[1]); w.y = cvt_pk_bf16(d[2], d[3]);
                *(u32x2*)(lds + OFF_MT + (lb * 16 + fr) * T_ST + (sb * 16 + 4 * fq) * 2) = w;
            }
            if (DBG_SSD_SYNC) __syncthreads();
            f32x4 yacc[2];
#pragma unroll
            for (int t2 = 0; t2 < 2; ++t2) {
                const int tile = 2 * wid + t2, pb = tile >> 2, lb = tile & 3;
                f32x4 d = (f32x4){0.f, 0.f, 0.f, 0.f};
#pragma unroll
                for (int ks = 0; ks < 4; ++ks) d = mfma16(ldfrag(lds + OFF_HS, CS_ST, pb * 16 + fr, ks * 32 + fq * 8), ldfrag(lds + OFF_CS, CS_ST, lb * 16 + fr, ks * 32 + fq * 8), d);
                const float el = __expf(__shfl(acs, lb * 16 + fr));
                yacc[t2] = d * el;
            }
            __syncthreads();
#pragma unroll
            for (int t2 = 0; t2 < 2; ++t2) {
                const int tile = 2 * wid + t2, pb = tile >> 2, lb = tile & 3;
                f32x4 d = yacc[t2];
#pragma unroll
                for (int ks = 0; ks < 2; ++ks) d = mfma16(ldfrag(lds + OFF_XT, T_ST, pb * 16 + fr, ks * 32 + fq * 8), ldfrag(lds + OFF_MT, T_ST, lb * 16 + fr, ks * 32 + fq * 8), d);
                const int l = lb * 16 + fr, p0 = pb * 16 + 4 * fq; const size_t tok = tokb + c * 64 + l;
                const u32x2 zz = zpre[t2];
                const float z0 = bflo(zz.x), z1 = bfhi(zz.x), z2 = bflo(zz.y), z3 = bfhi(zz.y);
                float xs[4];
#pragma unroll
                for (int r = 0; r < 4; ++r) xs[r] = bflo((unsigned)*(const bf16_t*)(lds + OFF_XS + (p0 + r) * T_ST + l * 2));
                u32x2 w; w.x = cvt_pk_bf16((d[0] + xs[0] * dsk) * z0, (d[1] + xs[1] * dsk) * z1); w.y = cvt_pk_bf16((d[2] + xs[2] * dsk) * z2, (d[3] + xs[3] * dsk) * z3);
                *(u32x2*)(YG + tok * 1024 + h * 64 + p0) = w;
            }
            if (DBG_SSD_SYNC) __syncthreads();
            { const float dc = __expf(alast);
#pragma unroll
              for (int t = 0; t < 4; ++t) { f32x4 d = hst[t] * dc;
#pragma unroll
                  for (int ks = 0; ks < 2; ++ks) d = mfma16(ldfrag(lds + OFF_BT, T_ST, wid * 16 + fr, ks * 32 + fq * 8), ldfrag(lds + OFF_XW, T_ST, t * 16 + fr, ks * 32 + fq * 8), d);
                  hst[t] = d;
                  u32x2 w; w.x = cvt_pk_bf16(d[0], d[1]); w.y = cvt_pk_bf16(d[2], d[3]);
                  *(u32x2*)(lds + OFF_HS + (t * 16 + fr) * CS_ST + (wid * 16 + 4 * fq) * 2) = w; } }
            __syncthreads();
        }
#undef SSD_LOAD
    }
}

namespace ssd2 {
constexpr int CS_ST = 272, T_ST = 144;
constexpr int OFF_CS = 0, OFF_BS = 64 * CS_ST, OFF_BT = 2 * 64 * CS_ST, OFF_H0 = OFF_BT + 128 * T_ST;
constexpr int H_XS = 0, H_XW = 64 * T_ST, H_MT = 2 * 64 * T_ST, H_HS = 3 * 64 * T_ST, H_SZ = H_HS + 64 * CS_ST;
constexpr int OFF_CW = OFF_H0 + 2 * H_SZ;
constexpr int OFF_TAB = OFF_CW + 5 * 384 * 4;
static_assert(OFF_TAB + 6 * 64 * 4 <= LDS_MISC, "ssd2 lds");
}
__device__ __forceinline__ void ph_ssd2(Frame& F, const int abl = 0) {
    using namespace ssd2; using ssd::mfma16; using ssd::ldfrag;
    char* lds = (char*)(unsigned char*)F.lds;
    const bf16_t* XBC = (const bf16_t*)(F.ws + WS_XBC); const bf16_t* ZS = (const bf16_t*)(F.ws + WS_Z); const float* DT = (const float*)(F.outb + OUT_DT);
    bf16_t* YG = (bf16_t*)(F.ws + WS_Q);
    const float* conv_w = F.a->in[9]; const float* conv_b = F.a->in[10]; const float* a_log = F.a->in[12]; const float* d_skip = F.a->in[13];
    const int tid = F.tid, wid = F.wave, lane = F.lane, fr = lane & 15, fq = lane >> 4;
    const int su = tid < 384 ? tid : tid - 128; const bool cwl_writer = true;
    const int cp_lo = __builtin_amdgcn_readfirstlane(tid < 384 ? 0 : 2), cp_hi = __builtin_amdgcn_readfirstlane(tid < 256 ? 4 : (tid < 384 ? 2 : 4));
    const int so = su % 48, tg = su / 48, shd = (so >> 3) & 1;
    for (int item = F.bid; item < NB * 8; item += F.G) {
        const int b = item >> 3, g = (item >> 1) & 3, h0 = g * 4 + (item & 1) * 2;
        const float aneg0 = -__expf(a_log[h0]), aneg1 = -__expf(a_log[h0 + 1]), dsk0 = d_skip[h0], dsk1 = d_skip[h0 + 1];
        const int ch0 = so < 16 ? (h0 + shd) * 64 + (so & 7) * 8 : (so < 32 ? 1024 + g * 128 + (so - 16) * 8 : 1536 + g * 128 + (so - 32) * 8);
        float* CWL = (float*)(lds + OFF_CW);
        __syncthreads();
        if (cwl_writer) {
#pragma unroll
            for (int j = 0; j < 4; ++j) { *(f32x4*)(CWL + j * 384 + so * 8) = *(const f32x4*)(conv_w + (size_t)j * 2048 + ch0); *(f32x4*)(CWL + j * 384 + so * 8 + 4) = *(const f32x4*)(conv_w + (size_t)j * 2048 + ch0 + 4); }
            *(f32x4*)(CWL + 4 * 384 + so * 8) = *(const f32x4*)(conv_b + ch0); *(f32x4*)(CWL + 4 * 384 + so * 8 + 4) = *(const f32x4*)(conv_b + ch0 + 4);
        }
        f32x4 hst[2][4];
#pragma unroll
        for (int hh = 0; hh < 2; ++hh)
#pragma unroll
            for (int t = 0; t < 4; ++t) hst[hh][t] = (f32x4){0.f, 0.f, 0.f, 0.f};
        for (int i = tid; i < 64 * CS_ST / 4; i += NTHR) { ((unsigned*)(lds + OFF_H0 + H_HS))[i] = 0u; ((unsigned*)(lds + OFF_H0 + H_SZ + H_HS))[i] = 0u; }
        u32x4 raw[11];
        const size_t tokb = (size_t)b * SEQ;
        const bf16_t* xrow = XBC + ((ptrdiff_t)tokb + tg * 8 - 3) * 2048 + ch0;
#define SSD_LOAD(c, xp, tgx) do { { _Pragma("unroll") for (int i = 0; i < 11; ++i) { const int t = (c) * 64 + (tgx) * 8 - 3 + i; \
            raw[i] = (t >= 0) ? *(const GAS u32x4*)((xp) + (ptrdiff_t)((c) * 64 + i) * 2048) : (u32x4){0u, 0u, 0u, 0u}; } } } while (0)
        SSD_LOAD(0, xrow, tg);
        f32x2 dtn = *(const f32x2*)(DT + (tokb + lane) * 16 + h0);
        for (int c = 0; c < 32; ++c) {
            int frl = fr, fql = fq, tgl = tg, sol = so; const bf16_t* xrl = xrow; asm volatile("" : "+v"(frl), "+v"(fql), "+v"(tgl), "+v"(sol), "+v"(xrl)); const int shdl = (sol >> 3) & 1;
            const float dtl0 = dtn[0], dtl1 = dtn[1]; if (c + 1 < 32) dtn = *(const f32x2*)(DT + (tokb + (c + 1) * 64 + lane) * 16 + h0);
            u32x2 zpre[2][2];
#pragma unroll
            for (int hh = 0; hh < 2; ++hh)
#pragma unroll
                for (int t2 = 0; t2 < 2; ++t2) { const int tile = 2 * wid + t2, pb = tile >> 2, lb = tile & 3; zpre[hh][t2] = *(const u32x2*)(ZS + (tokb + c * 64 + lb * 16 + frl) * 1024 + (h0 + hh) * 64 + pb * 16 + 4 * fql); }
            const float acs0 = dpp_scan_add(dtl0 * aneg0), acs1 = dpp_scan_add(dtl1 * aneg1);
            const float alast0 = __builtin_bit_cast(float, __builtin_amdgcn_readlane(__builtin_bit_cast(int, acs0), 63)), alast1 = __builtin_bit_cast(float, __builtin_amdgcn_readlane(__builtin_bit_cast(int, acs1), 63));
            float* TAB = (float*)(lds + OFF_TAB);
            TAB[lane] = acs0; TAB[64 + lane] = acs1; TAB[128 + lane] = dtl0; TAB[192 + lane] = dtl1; TAB[256 + lane] = dtl0 * __expf(alast0 - acs0); TAB[320 + lane] = dtl1 * __expf(alast1 - acs1);
            LDS_WAIT(); asm volatile("" ::: "memory");
            float wdt[8];
            { const f32x4 wa = *(const f32x4*)(TAB + 256 + shdl * 64 + tgl * 8), wb = *(const f32x4*)(TAB + 256 + shdl * 64 + tgl * 8 + 4);
#pragma unroll
              for (int t = 0; t < 4; ++t) { wdt[t] = wa[t]; wdt[4 + t] = wb[t]; } }
            if (!(abl & 1)) {
#pragma unroll
                for (int cp = 0; cp < 4; ++cp) {
                    if (cp < cp_lo || cp >= cp_hi) continue;
                    float xin[11][2];
#pragma unroll
                    for (int i = 0; i < 11; ++i) { const unsigned wa = cp == 0 ? raw[i].x : (cp == 1 ? raw[i].y : (cp == 2 ? raw[i].z : raw[i].w)); xin[i][0] = bflo(wa); xin[i][1] = bfhi(wa); }
                    float outv[8][2];
                    { f32x2 cwv[4]; const f32x2 cbq = *(const f32x2*)(CWL + 4 * 384 + sol * 8 + cp * 2);
#pragma unroll
                      for (int j = 0; j < 4; ++j) cwv[j] = *(const f32x2*)(CWL + j * 384 + sol * 8 + cp * 2);
#pragma unroll
                      for (int t = 0; t < 8; ++t)
#pragma unroll
                        for (int e = 0; e < 2; ++e) { float sacc = cbq[e];
#pragma unroll
                            for (int j = 0; j < 4; ++j) sacc += cwv[j][e] * xin[t + j][e];
                            outv[t][e] = silu_f(sacc); } }
                    if (sol < 16) {
                        char* hb = lds + OFF_H0 + shdl * H_SZ;
#pragma unroll
                        for (int e = 0; e < 2; ++e) { const int p = (sol & 7) * 8 + cp * 2 + e;
                            f32x4 x0, x1, w0, w1;
#pragma unroll
                            for (int t = 0; t < 4; ++t) { x0[t] = outv[t][e]; x1[t] = outv[4 + t][e]; w0[t] = x0[t] * wdt[t]; w1[t] = x1[t] * wdt[4 + t]; }
                            *(u32x4*)(hb + H_XS + p * T_ST + tgl * 16) = pack8(x0, x1);
                            *(u32x4*)(hb + H_XW + p * T_ST + tgl * 16) = pack8(w0, w1); }
                    } else {
                        const bool isB = sol < 32; const int n0 = (isB ? (sol - 16) : (sol - 32)) * 8 + cp * 2;
                        char* nat = lds + (isB ? OFF_BS : OFF_CS);
#pragma unroll
                        for (int t = 0; t < 8; ++t) *(unsigned*)(nat + (tgl * 8 + t) * CS_ST + n0 * 2) = cvt_pk_bf16(outv[t][0], outv[t][1]);
                        if (isB) {
#pragma unroll
                            for (int e = 0; e < 2; ++e) { f32x4 a, bq;
#pragma unroll
                                for (int t = 0; t < 4; ++t) { a[t] = outv[t][e]; bq[t] = outv[4 + t][e]; }
                                *(u32x4*)(lds + OFF_BT + (n0 + e) * T_ST + tgl * 16) = pack8(a, bq); }
                        }
                    }
                    SBAR();
                }
            }
            if (c + 1 < 32) SSD_LOAD(c + 1, xrl, tgl);
            __syncthreads();
            bf16x8 cfr[2][4];
#pragma unroll
            for (int t2 = 0; t2 < 2; ++t2)
#pragma unroll
                for (int ks = 0; ks < 4; ++ks) cfr[t2][ks] = ldfrag(lds + OFF_CS, CS_ST, ((2 * wid + t2) & 3) * 16 + frl, ks * 32 + fql * 8);
            if (!(abl & 2))
#pragma unroll
            for (int t2 = 0; t2 < 2; ++t2) {
                const int tile = 2 * wid + t2, sb = tile >> 2, lb = tile & 3;
                f32x4 d = (f32x4){0.f, 0.f, 0.f, 0.f}, m0 = d, m1 = d;
                if (sb <= lb) {
#pragma unroll
                    for (int ks = 0; ks < 4; ++ks) d = mfma16(ldfrag(lds + OFF_BS, CS_ST, sb * 16 + frl, ks * 32 + fql * 8), cfr[t2][ks], d);
                    const int l = lb * 16 + frl, s4 = sb * 16 + 4 * fql; const float al0 = TAB[l], al1 = TAB[64 + l];
                    const f32x4 as0 = *(const f32x4*)(TAB + s4), as1 = *(const f32x4*)(TAB + 64 + s4), ds0 = *(const f32x4*)(TAB + 128 + s4), ds1 = *(const f32x4*)(TAB + 192 + s4);
#pragma unroll
                    for (int r = 0; r < 4; ++r) { const int sidx = s4 + r;
                        m0[r] = (sidx <= l) ? d[r] * __expf(al0 - as0[r]) * ds0[r] : 0.f; m1[r] = (sidx <= l) ? d[r] * __expf(al1 - as1[r]) * ds1[r] : 0.f; }
                }
                u32x2 w; w.x = cvt_pk_bf16(m0[0], m0[1]); w.y = cvt_pk_bf16(m0[2], m0[3]);
                *(u32x2*)(lds + OFF_H0 + H_MT + (lb * 16 + frl) * T_ST + (sb * 16 + 4 * fql) * 2) = w;
                w.x = cvt_pk_bf16(m1[0], m1[1]); w.y = cvt_pk_bf16(m1[2], m1[3]);
                *(u32x2*)(lds + OFF_H0 + H_SZ + H_MT + (lb * 16 + frl) * T_ST + (sb * 16 + 4 * fql) * 2) = w;
            }
            f32x4 yacc[2][2];
#pragma unroll
            for (int hh = 0; hh < 2; ++hh)
#pragma unroll
                for (int t2 = 0; t2 < 2; ++t2) {
                    const int tile = 2 * wid + t2, pb = tile >> 2, lb = tile & 3; const char* hb = lds + OFF_H0 + hh * H_SZ;
                    f32x4 d = (f32x4){0.f, 0.f, 0.f, 0.f};
                    if (!(abl & 2))
#pragma unroll
                    for (int ks = 0; ks < 4; ++ks) d = mfma16(ldfrag(hb + H_HS, CS_ST, pb * 16 + frl, ks * 32 + fql * 8), cfr[t2][ks], d);
                    const float el = __expf(TAB[hh * 64 + lb * 16 + frl]);
                    yacc[hh][t2] = d * el;
                }
            __syncthreads();
            if (!(abl & 4))
#pragma unroll
            for (int hh = 0; hh < 2; ++hh)
#pragma unroll
                for (int t2 = 0; t2 < 2; ++t2) {
                    const int tile = 2 * wid + t2, pb = tile >> 2, lb = tile & 3; const char* hb = lds + OFF_H0 + hh * H_SZ;
                    f32x4 d = yacc[hh][t2];
#pragma unroll
                    for (int ks = 0; ks < 2; ++ks) d = mfma16(ldfrag(hb + H_XS, T_ST, pb * 16 + frl, ks * 32 + fql * 8), ldfrag(hb + H_MT, T_ST, lb * 16 + frl, ks * 32 + fql * 8), d);
                    const int l = lb * 16 + frl, p0 = pb * 16 + 4 * fql; const size_t tok = tokb + c * 64 + l; const float dsk = hh ? dsk1 : dsk0;
                    const u32x2 zz = zpre[hh][t2];
                    const float z0 = bflo(zz.x), z1 = bfhi(zz.x), z2 = bflo(zz.y), z3 = bfhi(zz.y);
                    float xs[4];
#pragma unroll
                    for (int r = 0; r < 4; ++r) xs[r] = bflo((unsigned)*(const bf16_t*)(hb + H_XS + (p0 + r) * T_ST + l * 2));
                    u32x2 w; w.x = cvt_pk_bf16((d[0] + xs[0] * dsk) * z0, (d[1] + xs[1] * dsk) * z1); w.y = cvt_pk_bf16((d[2] + xs[2] * dsk) * z2, (d[3] + xs[3] * dsk) * z3);
                    *(u32x2*)(YG + tok * 1024 + (h0 + hh) * 64 + p0) = w;
                }
            const bf16x8 btf0 = ldfrag(lds + OFF_BT, T_ST, wid * 16 + frl, fql * 8), btf1 = ldfrag(lds + OFF_BT, T_ST, wid * 16 + frl, 32 + fql * 8);
            if (!(abl & 8))
#pragma unroll
            for (int hh = 0; hh < 2; ++hh) { const float dc = __expf(hh ? alast1 : alast0); char* hb = lds + OFF_H0 + hh * H_SZ;
#pragma unroll
                for (int t = 0; t < 4; ++t) { f32x4 d = hst[hh][t] * dc;
#pragma unroll
                    for (int ks = 0; ks < 2; ++ks) d = mfma16(ks ? btf1 : btf0, ldfrag(hb + H_XW, T_ST, t * 16 + frl, ks * 32 + fql * 8), d);
                    hst[hh][t] = d;
                    u32x2 w; w.x = cvt_pk_bf16(d[0], d[1]); w.y = cvt_pk_bf16(d[2], d[3]);
                    *(u32x2*)(hb + H_HS + (t * 16 + frl) * CS_ST + (wid * 16 + 4 * fql) * 2) = w; } }
            __syncthreads();
        }
#undef SSD_LOAD
    }
}

__device__ __forceinline__ void ph_gnorm(Frame& F) {
    bf16_t* YG = (bf16_t*)(F.ws + WS_Q);
    const int gw = F.bid * NWAVES + F.wave, NGW = F.G * NWAVES;
    constexpr int RB = 4;
    for (int m0 = gw * RB; m0 < NTOK; m0 += NGW * RB) {
        u32x2 w[RB][4];
#pragma unroll
        for (int r = 0; r < RB; ++r) { const u32x2* rp = (const u32x2*)(YG + (size_t)(m0 + r) * D) + F.lane;
#pragma unroll
            for (int j = 0; j < 4; ++j) w[r][j] = rp[64 * j]; }
#pragma unroll
        for (int r = 0; r < RB; ++r) { const int m = m0 + r; u32x2* rp = (u32x2*)(YG + (size_t)m * D) + F.lane;
#pragma unroll
            for (int j = 0; j < 4; ++j) { const float a = bflo(w[r][j].x), b = bfhi(w[r][j].x), c = bflo(w[r][j].y), d = bfhi(w[r][j].y);
                const float ss = wave_sum(a * a + b * b + c * c + d * d); const float rr = 1.f / sqrtf(ss * (1.f / 256.f) + LN_EPS);
                if (PB_FP8) { int pk = 0; pk = __builtin_amdgcn_cvt_pk_fp8_f32(a * rr, b * rr, pk, false); pk = __builtin_amdgcn_cvt_pk_fp8_f32(c * rr, d * rr, pk, true); ((unsigned*)(F.outb + OUT_OB8 + (size_t)m * D))[F.lane + 64 * j] = (unsigned)pk; }
                else { u32x2 o; o.x = cvt_pk_bf16(a * rr, b * rr); o.y = cvt_pk_bf16(c * rr, d * rr); rp[64 * j] = o; } } }
    }
}

template <bool DRY = false> __device__ __forceinline__ void ph_router(Frame& F) {
    const bf16_t* VB = (const bf16_t*)(F.ws + WS_VB); bf16_t* X1B = (bf16_t*)(F.ws + WS_X1B); bf16_t* U2 = (bf16_t*)(F.ws + WS_U2); const float* MOD = (const float*)(F.ws + WS_MOD);
    const float* ln1g = F.a->in[18]; const float* ln1b = F.a->in[19]; const float* w_router = F.a->in[20]; const float* b_router = F.a->in[21];
    u32x2* REG = (u32x2*)(F.ws + WS_REG); unsigned* CNT = (unsigned*)(F.ws + WS_CTL) + CW_CNT;
    constexpr int TST = 2064;
    LAS unsigned char* THI = F.lds; LAS unsigned char* TLO = F.lds + 16 * TST; LAS float* PART = (LAS float*)(F.lds + 32 * TST);
    LAS unsigned* lcnt = (LAS unsigned*)(F.lds + LDS_AUX); LAS unsigned* lbase = lcnt + 32; LAS unsigned* ent = lcnt + 64;
    const int tid = F.tid, lane = F.lane, wid = F.wave, fr = lane & 15, fq = lane >> 4;
    bf16x8 whi[4][2], wlo[4][2];
#pragma unroll
    for (int ks = 0; ks < 4; ++ks)
#pragma unroll
        for (int ct = 0; ct < 2; ++ct) { float wv[8];
#pragma unroll
            for (int i = 0; i < 8; ++i) wv[i] = w_router[(size_t)(128 * wid + 32 * ks + 8 * fq + i) * 32 + ct * 16 + fr];
            u32x4 h, l2;
#pragma unroll
            for (int i = 0; i < 4; ++i) { const unsigned hp = cvt_pk_bf16(wv[2 * i], wv[2 * i + 1]); const float r0 = wv[2 * i] - bflo(hp), r1 = wv[2 * i + 1] - bfhi(hp); h[i] = hp; l2[i] = cvt_pk_bf16(r0, r1); }
            whi[ks][ct] = __builtin_bit_cast(bf16x8, h); wlo[ks][ct] = __builtin_bit_cast(bf16x8, l2); }
    const float brl = b_router[lane & 31];
    f32x4 lg[4], lb[4];
#pragma unroll
    for (int j = 0; j < 4; ++j) { lg[j] = *((const f32x4*)ln1g + lane + 64 * j); lb[j] = *((const f32x4*)ln1b + lane + 64 * j); }
    for (int batch = F.bid; batch < NTOK / 256; batch += F.G) {
        const int hf = batch >> 7;
        __syncthreads();
        if (tid < 32) lcnt[tid] = 0u;
        for (int grp = 0; grp < 16; ++grp) {
#pragma unroll
            for (int tt = 0; tt < 2; ++tt) {
                const int tg16 = 2 * wid + tt, m = batch * 256 + grp * 16 + tg16; const float* md = MOD + (size_t)(m >> 11) * 6144;
                const u32x2* vr = (const u32x2*)(VB + (size_t)m * D) + lane; u32x2* xr = (u32x2*)(X1B + (size_t)m * D) + lane;
                f32x4 v[4]; float s = 0.f;
#pragma unroll
                for (int j = 0; j < 4; ++j) { const u32x2 w = vr[64 * j]; v[j] = (f32x4){bflo(w.x), bfhi(w.x), bflo(w.y), bfhi(w.y)}; s += (v[j][0] + v[j][1]) + (v[j][2] + v[j][3]); }
                float mean = wave_sum(s) * (1.f / D), s2 = 0.f;
#pragma unroll
                for (int j = 0; j < 4; ++j) { v[j] = v[j] - mean; s2 += (v[j][0] * v[j][0] + v[j][1] * v[j][1]) + (v[j][2] * v[j][2] + v[j][3] * v[j][3]); }
                float rstd = 1.f / sqrtf(wave_sum(s2) * (1.f / D) + LN_EPS);
                s = 0.f;
#pragma unroll
                for (int j = 0; j < 4; ++j) { v[j] = v[j] * rstd * lg[j] + lb[j]; if (!DRY) { u32x2 w; w.x = cvt_pk_bf16(v[j][0], v[j][1]); w.y = cvt_pk_bf16(v[j][2], v[j][3]); xr[64 * j] = w; } s += (v[j][0] + v[j][1]) + (v[j][2] + v[j][3]); }
                mean = wave_sum(s) * (1.f / D); s2 = 0.f;
#pragma unroll
                for (int j = 0; j < 4; ++j) { v[j] = v[j] - mean; s2 += (v[j][0] * v[j][0] + v[j][1] * v[j][1]) + (v[j][2] * v[j][2] + v[j][3] * v[j][3]); }
                rstd = 1.f / sqrtf(wave_sum(s2) * (1.f / D) + LN_EPS);
                u32x2* o8 = (u32x2*)(U2 + (size_t)m * D) + lane;
#pragma unroll
                for (int j = 0; j < 4; ++j) { const f32x4 sh = *((const f32x4*)(md + 3072) + lane + 64 * j), sc = *((const f32x4*)(md + 4096) + lane + 64 * j);
                    v[j] = v[j] * rstd * (sc + 1.0f) + sh; u32x2 w; w.x = cvt_pk_bf16(v[j][0], v[j][1]); w.y = cvt_pk_bf16(v[j][2], v[j][3]);
                    if (DRY) { if (w.x == 0x12345678u) o8[64 * j] = w; }
                    else if (MOE_FP8) { int pk = 0; pk = __builtin_amdgcn_cvt_pk_fp8_f32(v[j][0], v[j][1], pk, false); pk = __builtin_amdgcn_cvt_pk_fp8_f32(v[j][2], v[j][3], pk, true); ((unsigned*)((unsigned char*)U2 + (size_t)m * D))[lane + 64 * j] = (unsigned)pk; }
                    else o8[64 * j] = w;
                    u32x2 lo; lo.x = cvt_pk_bf16(v[j][0] - bflo(w.x), v[j][1] - bfhi(w.x)); lo.y = cvt_pk_bf16(v[j][2] - bflo(w.y), v[j][3] - bfhi(w.y));
                    *(LAS u32x2*)(THI + tg16 * TST + (4 * lane + 256 * j) * 2) = w; *(LAS u32x2*)(TLO + tg16 * TST + (4 * lane + 256 * j) * 2) = lo; }
            }
            __syncthreads();
            { f32x4 a0 = (f32x4){0.f, 0.f, 0.f, 0.f}, a1 = a0;
#pragma unroll
              for (int ks = 0; ks < 4; ++ks) { const int cb = (128 * wid + 32 * ks + 8 * fq) * 2;
                  const bf16x8 th = *(const LAS bf16x8*)(THI + fr * TST + cb), tl = *(const LAS bf16x8*)(TLO + fr * TST + cb);
                  a0 = __builtin_amdgcn_mfma_f32_16x16x32_bf16(whi[ks][0], th, a0, 0, 0, 0); a1 = __builtin_amdgcn_mfma_f32_16x16x32_bf16(whi[ks][1], th, a1, 0, 0, 0);
                  a0 = __builtin_amdgcn_mfma_f32_16x16x32_bf16(wlo[ks][0], th, a0, 0, 0, 0); a1 = __builtin_amdgcn_mfma_f32_16x16x32_bf16(wlo[ks][1], th, a1, 0, 0, 0);
                  a0 = __builtin_amdgcn_mfma_f32_16x16x32_bf16(whi[ks][0], tl, a0, 0, 0, 0); a1 = __builtin_amdgcn_mfma_f32_16x16x32_bf16(whi[ks][1], tl, a1, 0, 0, 0); }
              *(LAS f32x4*)(PART + (wid * 16 + fr) * 32 + 4 * fq) = a0; *(LAS f32x4*)(PART + (wid * 16 + fr) * 32 + 16 + 4 * fq) = a1; }
            __syncthreads();
            { const int tg16 = 2 * wid + (lane >> 5), tl = grp * 16 + tg16, myexp = lane & 31;
              float logit = brl;
#pragma unroll
              for (int w8 = 0; w8 < 8; ++w8) logit += PART[(w8 * 16 + tg16) * 32 + myexp];
              float tv[4]; int tix[4];
#pragma unroll
              for (int k = 0; k < 4; ++k) { float bv = logit; int bi = myexp;
#define RT_STEP(ctrl, rm) do { const float ov = __builtin_bit_cast(float, __builtin_amdgcn_update_dpp((int)0xff800000u, __builtin_bit_cast(int, bv), (ctrl), (rm), 0xf, false)); \
                      const int oi = __builtin_amdgcn_update_dpp(64, bi, (ctrl), (rm), 0xf, false); if (ov > bv || (ov == bv && oi < bi)) { bv = ov; bi = oi; } } while (0)
                  RT_STEP(0x111, 0xf); RT_STEP(0x112, 0xf); RT_STEP(0x114, 0xf); RT_STEP(0x118, 0xf); RT_STEP(0x142, 0xa);
#undef RT_STEP
                  { const int b0 = __builtin_amdgcn_readlane(__builtin_bit_cast(int, bv), 31), b1 = __builtin_amdgcn_readlane(__builtin_bit_cast(int, bv), 63), i0 = __builtin_amdgcn_readlane(bi, 31), i1 = __builtin_amdgcn_readlane(bi, 63);
                    bv = __builtin_bit_cast(float, lane < 32 ? b0 : b1); bi = lane < 32 ? i0 : i1; }
                  tv[k] = bv; tix[k] = bi; if (myexp == bi) logit = -INFINITY; }
              const float e1 = __expf(tv[1] - tv[0]), e2 = __expf(tv[2] - tv[0]), e3 = __expf(tv[3] - tv[0]); const float inv = 1.f / (1.f + e1 + e2 + e3);
              if (myexp < 4) { const int ee = myexp == 0 ? tix[0] : (myexp == 1 ? tix[1] : (myexp == 2 ? tix[2] : tix[3])); const float gg = (myexp == 0 ? 1.f : (myexp == 1 ? e1 : (myexp == 2 ? e2 : e3))) * inv;
                  const unsigned lp = atomicAdd((unsigned*)&lcnt[ee], 1u);
                  LAS unsigned* en = ent + (tl * 4 + myexp) * 3; en[0] = (unsigned)ee; en[1] = lp; en[2] = __float_as_uint(gg);
                  if (DBG_CHECK == 1) { u32x2 rw; rw.x = (unsigned)ee; rw.y = __float_as_uint(gg); ((u32x2*)(F.ws + WS_DBG))[(size_t)(batch * 256 + tl) * 4 + myexp] = rw; } } }
        }
        __syncthreads();
        if (tid < 32) lbase[tid] = DRY ? 0u : __hip_atomic_fetch_add(CNT + 64 * (hf * 32 + tid), lcnt[tid], __ATOMIC_RELAXED, __HIP_MEMORY_SCOPE_AGENT);
        __syncthreads();
        for (int i = tid; i < 1024; i += NTHR) { const LAS unsigned* en = ent + i * 3; const unsigned ee = en[0], pos = lbase[ee] + en[1];
            const unsigned tokl = (unsigned)(batch * 256 + (i >> 2)) - (unsigned)hf * HALF_TOK;
            u32x2 w; w.x = tokl * 4u + (unsigned)(i & 3); w.y = en[2];
            if (!DRY && pos < (unsigned)REG_CAP) REG[((size_t)hf * 32 + ee) * REG_CAP + pos] = w; }
    }
}

template <bool DRY = false> __device__ __forceinline__ void ph_final(Frame& F, int hf) {
    float* OUT = (float*)F.outb; const bf16_t* X1B = (const bf16_t*)(F.ws + WS_X1B); const bf16_t* YB = (const bf16_t*)(F.ws + WS_YB); const float* MOD = (const float*)(F.ws + WS_MOD);
    const float* g2 = F.a->in[26]; const float* b2 = F.a->in[27];
    const int gw = F.bid * NWAVES + F.wave, NGW = F.G * NWAVES, lane = F.lane;
    constexpr int RB = 2;
    f32x4 g2v[4], b2v[4];
#pragma unroll
    for (int j = 0; j < 4; ++j) { g2v[j] = *((const f32x4*)g2 + lane + 64 * j); b2v[j] = *((const f32x4*)b2 + lane + 64 * j); }
    for (int tl0 = gw; tl0 < HALF_TOK; tl0 += NGW * RB) {
        u32x2 xw[RB][4]; u32x2 yw[RB][4][4];
#pragma unroll
        for (int r = 0; r < RB; ++r) { const int tl = tl0 + r * NGW, m = hf * HALF_TOK + tl;
            const u32x2* xr = (const u32x2*)(X1B + (size_t)m * D) + lane; const u32x2* yr = (const u32x2*)(YB + (size_t)tl * 4 * D) + lane;
#pragma unroll
            for (int j = 0; j < 4; ++j) { xw[r][j] = __builtin_nontemporal_load(xr + 64 * j);
#pragma unroll
                for (int k = 0; k < 4; ++k) yw[r][j][k] = __builtin_nontemporal_load(yr + k * 256 + 64 * j); } }
#pragma unroll
        for (int r = 0; r < RB; ++r) { const int tl = tl0 + r * NGW, m = hf * HALF_TOK + tl; const float* md = MOD + (size_t)(m >> 11) * 6144 + 5120;
            f32x4* xr = (f32x4*)(OUT + (size_t)m * D) + lane;
            f32x4 v[4]; float s = 0.f;
#pragma unroll
            for (int j = 0; j < 4; ++j) { f32x4 y = (f32x4){0.f, 0.f, 0.f, 0.f};
#pragma unroll
                for (int k = 0; k < 4; ++k) { const u32x2 w = yw[r][j][k]; y[0] += bflo(w.x); y[1] += bfhi(w.x); y[2] += bflo(w.y); y[3] += bfhi(w.y); }
                if (DBG_NO_MOE) y = (f32x4){0.f, 0.f, 0.f, 0.f};
                const f32x4 gt = *((const f32x4*)md + lane + 64 * j);
                const f32x4 x1v = (f32x4){bflo(xw[r][j].x), bfhi(xw[r][j].x), bflo(xw[r][j].y), bfhi(xw[r][j].y)};
                v[j] = x1v * DN_ALPHA + gt * y; s += (v[j][0] + v[j][1]) + (v[j][2] + v[j][3]); }
            const float mean = wave_sum(s) * (1.f / D); float s2 = 0.f;
#pragma unroll
            for (int j = 0; j < 4; ++j) { v[j] = v[j] - mean; s2 += (v[j][0] * v[j][0] + v[j][1] * v[j][1]) + (v[j][2] * v[j][2] + v[j][3] * v[j][3]); }
            const float rstd = 1.f / sqrtf(wave_sum(s2) * (1.f / D) + LN_EPS);
#pragma unroll
            for (int j = 0; j < 4; ++j) { const f32x4 ov = v[j] * rstd * g2v[j] + b2v[j]; if (!DRY || ov[0] == 1.2345e-33f) __builtin_nontemporal_store(ov, xr + 64 * j); } }
    }
}

__device__ __forceinline__ float block_sum(Frame& F, float v, LAS float* red) {
    v = wave_sum(v); __syncthreads(); if (F.lane == 0) red[F.wave] = v; __syncthreads();
    float s = 0.f; for (int w = 0; w < NWAVES; ++w) s += red[w]; return s;
}
__device__ __forceinline__ float block_max(Frame& F, float v, LAS float* red) {
#pragma unroll
    for (int o = 1; o < 64; o <<= 1) v = fmaxf(v, __shfl_xor(v, o));
    __syncthreads(); if (F.lane == 0) red[F.wave] = v; __syncthreads();
    float s = 0.f; for (int w = 0; w < NWAVES; ++w) s = fmaxf(s, red[w]); return s;
}
__device__ __forceinline__ void dbg_report(Frame& F, float e) { if (F.tid == 0) atomicMax((unsigned*)(F.ws + WS_CTL) + CW_DBG, __float_as_uint(e)); }
__device__ __forceinline__ void dbg_check_moe(Frame& F) {
    if (F.bid >= 64) return;
    const int tok = HALF_TOK + 509 * F.bid + 3, tokl = tok - HALF_TOK, tid = F.tid;
    LAS float* u2 = (LAS float*)F.lds; LAS float* act = u2 + 1024; LAS float* red = act + 1024; LAS float* lg = red + 16;
    const bf16_t* U2 = (const bf16_t*)(F.ws + WS_U2); const bf16_t* YB = (const bf16_t*)(F.ws + WS_YB); const u32x2* RT = (const u32x2*)(F.ws + WS_DBG);
    const float* w1 = F.a->in[22]; const float* b1 = F.a->in[23]; const float* w2 = F.a->in[24]; const float* b2 = F.a->in[25];
    __syncthreads();
    for (int i = tid; i < 1024; i += NTHR) u2[i] = bflo((unsigned)U2[(size_t)tok * 1024 + i]);
    __syncthreads();
    float y0 = 0.f, y1 = 0.f;
    for (int k = 0; k < 4; ++k) {
        const u32x2 rw = RT[(size_t)tok * 4 + k]; const int e = (int)rw.x; const float g = __uint_as_float(rw.y);
        const float* W1 = w1 + (size_t)e * 1024 * 2048; const float* W2 = w2 + (size_t)e * 1024 * 1024;
        float h0 = b1[e * 2048 + tid], h1 = b1[e * 2048 + tid + 512], h2 = b1[e * 2048 + tid + 1024], h3 = b1[e * 2048 + tid + 1536];
        for (int c = 0; c < 1024; ++c) { const float uu = u2[c]; const float* wr = W1 + (size_t)c * 2048 + tid; h0 += uu * wr[0]; h1 += uu * wr[512]; h2 += uu * wr[1024]; h3 += uu * wr[1536]; }
        __syncthreads();
        { float gg = fminf(h0, 7.f), up = fminf(fmaxf(h2, -7.f), 7.f); act[tid] = (up + 1.f) * gg / (1.f + expf(-1.702f * gg));
          gg = fminf(h1, 7.f); up = fminf(fmaxf(h3, -7.f), 7.f); act[tid + 512] = (up + 1.f) * gg / (1.f + expf(-1.702f * gg)); }
        __syncthreads();
        float a0 = b2[e * 1024 + tid], a1 = b2[e * 1024 + tid + 512];
        for (int j = 0; j < 1024; ++j) { const float aa = act[j]; a0 += aa * W2[(size_t)j * 1024 + tid]; a1 += aa * W2[(size_t)j * 1024 + tid + 512]; }
        y0 += g * a0; y1 += g * a1;
    }
    float f0 = 0.f, f1 = 0.f;
    for (int k = 0; k < 4; ++k) { f0 += bflo((unsigned)YB[((size_t)tokl * 4 + k) * 1024 + tid]); f1 += bflo((unsigned)YB[((size_t)tokl * 4 + k) * 1024 + tid + 512]); }
    const float rms = sqrtf(block_sum(F, y0 * y0 + y1 * y1, red) * (1.f / 1024.f)) + 1e-20f;
    float err = block_max(F, fmaxf(fabsf(y0 - f0), fabsf(y1 - f1)), red) / rms;
    { const float* X1 = (const float*)F.outb + (size_t)tok * 1024; const float* md = (const float*)(F.ws + WS_MOD) + (size_t)(tok >> 11) * 6144;
      const float xa = X1[tid], xb = X1[tid + 512]; const float mean = block_sum(F, xa + xb, red) * (1.f / 1024.f);
      const float da = xa - mean, db = xb - mean; const float var = block_sum(F, da * da + db * db, red) * (1.f / 1024.f); const float rstd = 1.f / sqrtf(var + LN_EPS);
      __syncthreads();
      u2[tid] = da * rstd * (1.f + md[4096 + tid]) + md[3072 + tid]; u2[tid + 512] = db * rstd * (1.f + md[4096 + tid + 512]) + md[3072 + tid + 512];
      __syncthreads();
      if (tid < 32) { float a = F.a->in[21][tid]; for (int c = 0; c < 1024; ++c) a += u2[c] * F.a->in[20][c * 32 + tid]; lg[tid] = a; }
      __syncthreads();
      if (tid == 0) { unsigned want = 0u, got = 0u; float l2[32]; for (int i = 0; i < 32; ++i) l2[i] = lg[i];
          for (int k = 0; k < 4; ++k) { int bi = 0; for (int i = 1; i < 32; ++i) if (l2[i] > l2[bi]) bi = i; want |= 1u << bi; l2[bi] = -INFINITY; got |= 1u << RT[(size_t)tok * 4 + k].x; }
          lg[32] = (want != got) ? 1.f : 0.f; }
      __syncthreads();
      if (lg[32] != 0.f) err = 50.f; }
    dbg_report(F, err);
}
__device__ __forceinline__ void dbg_check_ssd(Frame& F) {
    if (F.bid >= 2) return;
    const int b = F.bid ? 20 : 5, h = F.bid ? 14 : 3, g = h >> 2, tid = F.tid, p = tid >> 3, ng = tid & 7;
    LAS float* red = (LAS float*)F.lds; LAS float* cv = red + 16;
    const bf16_t* XBC = (const bf16_t*)(F.ws + WS_XBC); const bf16_t* ZS = (const bf16_t*)(F.ws + WS_Z); const float* DT = (const float*)(F.outb + OUT_DT); const bf16_t* YG = (const bf16_t*)(F.ws + WS_Q);
    const float* cw = F.a->in[9]; const float* cb = F.a->in[10]; const float aneg = -expf(F.a->in[12][h]), dsk = F.a->in[13][h];
    const int mych = tid < 64 ? h * 64 + tid : (tid < 192 ? 1024 + g * 128 + (tid - 64) : 1536 + g * 128 + (tid - 192));
    float w0 = 0.f, w1 = 0.f, w2 = 0.f, w3 = 0.f, wb = 0.f;
    if (tid < 320) { w0 = cw[0 * 2048 + mych]; w1 = cw[1 * 2048 + mych]; w2 = cw[2 * 2048 + mych]; w3 = cw[3 * 2048 + mych]; wb = cb[mych]; }
    float x0 = 0.f, x1 = 0.f, x2 = 0.f;
    float hs[16];
#pragma unroll
    for (int i = 0; i < 16; ++i) hs[i] = 0.f;
    float emax = 0.f, ssq = 0.f, nbad = 0.f; int tmax = 0;
    for (int t = 0; t < SEQ; ++t) {
        const size_t tok = (size_t)b * SEQ + t;
        __syncthreads();
        if (DBG_HYP == 1 && (t & 63) == 0) { x0 = 0.f; x1 = 0.f; x2 = 0.f; }
        if (tid < 320) { const float x3 = bflo((unsigned)XBC[tok * 2048 + mych]); const float s = wb + w0 * x0 + w1 * x1 + w2 * x2 + w3 * x3; cv[tid] = s / (1.f + expf(-s)); x0 = x1; x1 = x2; x2 = x3; }
        __syncthreads();
        const float xv = cv[p], dt = DT[tok * 16 + h], dec = expf(dt * aneg);
        float yp = 0.f;
#pragma unroll
        for (int i = 0; i < 16; ++i) { const int n = ng * 16 + i; hs[i] = hs[i] * dec + dt * xv * cv[64 + n]; yp += cv[192 + n] * hs[i]; }
        yp += __shfl_xor(yp, 1); yp += __shfl_xor(yp, 2); yp += __shfl_xor(yp, 4);
        const float yv = (yp + xv * dsk) * bflo((unsigned)ZS[tok * 1024 + h * 64 + p]);
        const float yf = bflo((unsigned)YG[tok * 1024 + h * 64 + p]);
        if (ng == 0) { const float er = fabsf(yv - yf); if (er > emax) { emax = er; tmax = t; } ssq += yv * yv; if (er > 0.25f && (DBG_SUB < 5 || (DBG_SUB == 5 && (t & 63) == 0) || (DBG_SUB == 6 && (t & 63) == 1) || (DBG_SUB == 7 && (t & 63) == 32))) nbad += 1.f; }
    }
    const float rms = sqrtf(block_sum(F, ssq, red) / (64.f * SEQ)) + 1e-20f;
    const float M = block_max(F, emax, red);
    if (DBG_SUB == 0) dbg_report(F, M / rms);
    else if (DBG_SUB == 1) dbg_report(F, block_sum(F, nbad, red) / (64.f * SEQ));
    else if (DBG_SUB >= 5) dbg_report(F, block_sum(F, nbad, red) / (64.f * 32.f));
    else { __syncthreads(); if (ng == 0 && emax == M) red[12] = (float)(DBG_SUB == 2 ? ((tmax & 63) >> 1) : (DBG_SUB == 3 ? (tmax >> 6) : (p >> 1))); __syncthreads();
        if (F.bid == 0) dbg_report(F, powf(10.f, 2.f * (0.05f + 0.05f * red[12]) - 4.f)); }
}
__device__ __forceinline__ void dbg_check_attn(Frame& F) {
    if (F.bid >= 32) return;
    const int b = (F.bid * 7 + 3) & 31, pos = 300 + F.bid * 53, nadm = ((pos >> 6) + 1) * 64, tid = F.tid, lane = F.lane, hd = F.wave;
    const size_t tq = (size_t)b * SEQ + pos;
    LAS float* sc = (LAS float*)F.lds; LAS unsigned char* sel = (LAS unsigned char*)(sc + 2048); LAS float* lgt = (LAS float*)(sel + 2048); LAS float* red = lgt + 8 * 2048; LAS float* misc = red + 16;
    const bf16_t* IQ = (const bf16_t*)(F.outb + OUT_IQ); const bf16_t* IK = (const bf16_t*)(F.outb + OUT_IK); const float* IW = (const float*)(F.outb + OUT_IW);
    const bf16_t* Q = (const bf16_t*)(F.ws + WS_Q); const bf16_t* KV = (const bf16_t*)(F.outb + OUT_KV); const bf16_t* OA = (const bf16_t*)(F.outb + OUT_OA); const u64* MASK = (const u64*)(F.outb + OUT_MASK);
    __syncthreads();
    for (int k = tid; k < nadm; k += NTHR) { float s = 0.f;
        for (int hh = 0; hh < 8; ++hh) { float d = 0.f; for (int c = 0; c < 64; ++c) d += bflo((unsigned)IQ[tq * 512 + hh * 64 + c]) * bflo((unsigned)IK[((size_t)b * SEQ + k) * 64 + c]); s += fmaxf(d, 0.f) * IW[tq * 8 + hh]; }
        sc[k] = s + 0.0f; }
    __syncthreads();
    float nbad = 0.f;
    for (int k = tid; k < nadm; k += NTHR) { const float s = sc[k]; int rank = 0; for (int j = 0; j < nadm; ++j) { const float t = sc[j]; rank += (t > s || (t == s && j < k)) ? 1 : 0; }
        const unsigned char se = rank < 256 ? 1 : 0; sel[k] = se; const unsigned mb = (unsigned)((MASK[tq * 32 + (k >> 6)] >> (k & 63)) & 1ull); if (mb != se) nbad += 1.f; }
    __syncthreads();
    const float nbad_t = block_sum(F, nbad, red);
    LAS float* lw = lgt + hd * 2048; float mx = -INFINITY;
    for (int k = lane; k < nadm; k += 64) { float l = -INFINITY;
        if (sel[k]) { float d = 0.f; for (int c = 0; c < 128; ++c) d += bflo((unsigned)Q[tq * 1024 + hd * 128 + c]) * bflo((unsigned)KV[((size_t)b * SEQ + k) * 128 + c]);
            const int rel = k - pos, n = rel < 0 ? -rel : rel; const float nf = (float)(n > 1 ? n : 1); int large = 8 + (int)(logf(nf / 8.0f) / 2.7725887f * 8.0f); if (large > 15) large = 15;
            const int bucket = (rel > 0 ? 16 : 0) + (n < 8 ? n : large);
            l = d * 0.088388347648318440f + F.a->in[8][bucket * 8 + hd]; }
        lw[k] = l; mx = fmaxf(mx, l); }
#pragma unroll
    for (int o = 1; o < 64; o <<= 1) mx = fmaxf(mx, __shfl_xor(mx, o));
    float den = 0.f;
    for (int k = lane; k < nadm; k += 64) { const float pp = expf(lw[k] - mx); lw[k] = pp; den += pp; }
    den = wave_sum(den);
    float emax = 0.f, ssq = 0.f;
    for (int c2 = 0; c2 < 2; ++c2) { const int c = lane + 64 * c2; float o = 0.f; for (int k = 0; k < nadm; ++k) { const float pp = lw[k]; if (pp != 0.f) o += pp * bflo((unsigned)KV[((size_t)b * SEQ + k) * 128 + c]); }
        o /= den; const float of = bflo((unsigned)OA[tq * 1024 + hd * 128 + c]); emax = fmaxf(emax, fabsf(o - of)); ssq += o * o; }
    const float rms = sqrtf(block_sum(F, ssq, red) * (1.f / 1024.f)) + 1e-20f;
    float err = block_max(F, emax, red) / rms;
    (void)misc;
    if (nbad_t > 0.f) err = 10.f + nbad_t;
    dbg_report(F, err);
}
__device__ __forceinline__ void dbg_emit(Frame& F) {
    float* out = (float*)F.outb;
    for (size_t i = (size_t)F.bid * NTHR + F.tid; i < (size_t)NTOK * D / 4; i += (size_t)F.G * NTHR) ((f32x4*)out)[i] = (f32x4){0.f, 0.f, 0.f, 0.f};
    __syncthreads();
    if (F.bid == 0 && F.tid == 0) { const float e = __uint_as_float(__hip_atomic_load((unsigned*)(F.ws + WS_CTL) + CW_DBG, __ATOMIC_RELAXED, __HIP_MEMORY_SCOPE_AGENT));
        float code = (log10f(fmaxf(e, 1e-30f)) + 4.f) * 0.5f; code = fminf(fmaxf(rintf(code * 20.f) * 0.05f, 0.05f), 3.0f);
        out[0] = sqrtf(67108864.f * 1.01f * (powf(10.f, code) - 1.f)); }
}

#define CLK_BEGIN(k) unsigned long long clk_c##k = 0, clk_r##k = 0; if (DBG_CLOCK == (k) + 1) { clk_c##k = __builtin_amdgcn_s_memtime(); clk_r##k = __builtin_amdgcn_s_memrealtime(); }
#define CLK_END(k) if (DBG_CLOCK == (k) + 1 && F.bid == 0) { const float ghz = (float)(__builtin_amdgcn_s_memtime() - clk_c##k) / (float)(__builtin_amdgcn_s_memrealtime() - clk_r##k) * 0.1f; dbg_report(F, powf(10.f, 2.f * (rintf(ghz * 5.f) * 0.2f) - 4.f)); }
constexpr int NPHASE = 17;
__global__ void __launch_bounds__(NTHR, 2) fwd(Args args) {
    extern __shared__ __attribute__((aligned(16))) unsigned char lds_raw[];
    Frame F;
    F.lds = (LAS unsigned char*)lds_raw;
    F.tid = threadIdx.x; F.lane = F.tid & 63; F.wave = __builtin_amdgcn_readfirstlane(F.tid >> 6); F.G = gridDim.x; F.bid = blockIdx.x;
    F.a = &args;
    F.ws = args.ws; F.outb = (unsigned char*)args.out;
    volatile LAS unsigned* MISCW = (volatile LAS unsigned*)(F.lds + LDS_MISC);
    if (F.tid < 64) MISCW[F.tid] = 0u;
    __syncthreads();
    XcdBarrier bar; bar.bar = (unsigned*)(F.ws + WS_CTL) + CW_BAR; bar.x = 0; bar.st = nullptr;
#if MK_ONE
    bar = xcd_barrier_post((unsigned*)(F.ws + WS_CTL) + CW_BAR, MISCW + 8);
#define GRID_BAR() xcd_barrier(bar)
#else
#define GRID_BAR() do { } while (0)
#endif
    const int lo = args.ph_lo, hi = args.ph_hi;
#ifndef PHM
#define PHM (0xFFFFFFFFu & ~(DBG_NO_ATTN ? 0x30u : 0u) & ~(DBG_NO_SSD ? 0xC0u : 0u))
#endif
#define IN(k) (((PHM >> (k)) & 1u) && lo <= (k) && (k) < hi)
#define SEAM(k) do { if ((k) + 1 < hi) GRID_BAR(); } while (0)

    if (IN(0)) {
#pragma nounroll
        for (int rep = 0; rep < ((DBG_TWICE & 1u) ? 2 : 1); ++rep) { if (rep) GRID_BAR(); ph_prologue(F); }
        SEAM(0); }
    if (IN(1)) {
#pragma nounroll
        for (int rep = 0; rep < ((DBG_TWICE & 2u) ? 2 : 1); ++rep) { if (rep) GRID_BAR(); ph_ln1(F); }
        SEAM(1); }
    CLK_BEGIN(2);
    if (IN(2)) {
        EpiProj E{(bf16_t*)(F.ws + WS_Q), (bf16_t*)(F.outb + OUT_IQ), (bf16_t*)(F.ws + WS_Z), (bf16_t*)(F.ws + WS_XBC), (bf16_t*)(F.ws + WS_GA), (bf16_t*)(F.ws + WS_GB), (float*)(F.outb + OUT_MISC), 1.0f};
#if PROJ_FP8
        { SchedProj<2> S; S.o.init(NTOK, 12 * 256, F.G, F.bid); S.A = (const char*)(F.ws + WS_U8); S.Bt = (const char*)(F.ws + WS_WIN8);
          EpiProj E8 = E; E8.sc = MOE_INV;
          pg8::gemm_phase<EpiProj, SchedProj<2>, false, 512, true>(F.lds, S, E8);
          if (DBG_TWICE & 32768u) { GRID_BAR(); pg8::gemm_phase<EpiProj, SchedProj<2>, false, 512, true>(F.lds, S, E8); } }
        { SchedProj<1> S; S.o.init(NTOK, 15 * 256, F.G, F.bid); S.A = (const char*)(F.outb + OUT_U); S.Bt = (const char*)(F.ws + WS_WIN); if (DBG_KCLK) S.dbgw = (unsigned*)(F.ws + WS_CTL) + CW_DBG;
#if DBG_DRYPROJ
#pragma nounroll
          for (int rep = 0; rep < 2; ++rep) { EpiProj Ed = E; Ed.dry = rep == 0; SchedProj<1> Sd = S; Sd.fold = rep == 0 ? 7 : 0x7fffffff; pg8::gemm_phase<EpiProj, SchedProj<1>, false>(F.lds, Sd, Ed); if (rep == 0) GRID_BAR(); }
#else
          const unsigned long long w0 = DBG_WALL ? __builtin_amdgcn_s_memrealtime() : 0ull;
          pg8::gemm_phase<EpiProj, SchedProj<1>, false>(F.lds, S, E);
          if (DBG_WALL && F.bid == 0) { const float us = (float)(__builtin_amdgcn_s_memrealtime() - w0) * 0.01f; dbg_report(F, powf(10.f, 2.f * (rintf(us / 300.f * 10.f) * 0.1f) - 4.f)); }
#endif
          if (DBG_TWICE & 4u) { GRID_BAR(); pg8::gemm_phase<EpiProj, SchedProj<1>, false>(F.lds, S, E); } }
#else
        { SchedProj<0> S; S.o.init(NTOK, NPROJ, F.G, F.bid); S.A = (const char*)(F.outb + OUT_U); S.Bt = (const char*)(F.ws + WS_WIN);
          pg8::gemm_phase<EpiProj, SchedProj<0>, false>(F.lds, S, E);
          if (DBG_TWICE & 4u) { GRID_BAR(); pg8::gemm_phase<EpiProj, SchedProj<0>, false>(F.lds, S, E); } }
#endif
        SEAM(2);
    }
    CLK_END(2);
    if (IN(3)) { ph_misc(F); if (DBG_TWICE & 8u) { GRID_BAR(); ph_misc(F); } SEAM(3); }
    if (IN(4)) {
#pragma nounroll
        for (int rep = 0; rep < DBG_REP4; ++rep) { if (rep) GRID_BAR(); ph_index(F, rep + 1 < DBG_REP4 ? DBG_ABL4 : 0); }
        SEAM(4); }
    if (IN(5)) { ph_attn(F); if (DBG_TWICE & 32u) { GRID_BAR(); ph_attn(F); } SEAM(5); if (DBG_CHECK == 3) { dbg_check_attn(F); GRID_BAR(); } }
    if (IN(6)) {
#pragma nounroll
        for (int rep = 0; rep < DBG_REP6; ++rep) { if (rep) GRID_BAR(); ph_ssd2(F, rep + 1 < DBG_REP6 ? DBG_ABL6 : 0); }
        SEAM(6); if (DBG_CHECK == 2) { dbg_check_ssd(F); GRID_BAR(); } }
    if (IN(7)) { ph_gnorm(F); if (DBG_TWICE & 128u) { GRID_BAR(); ph_gnorm(F); } SEAM(7); }
    if (IN(8)) {
#if PA_FP8
        SchedPlainT<1024> S; S.o.init(NTOK, 1024, F.G, F.bid); S.A = (const char*)(F.outb + OUT_OA); S.Bt = (const char*)(F.ws + WS_WPA8);
        EpiGate<0> E{(const bf16_t*)(F.ws + WS_GA), nullptr, (bf16_t*)(F.ws + WS_Z), MOE_INV};
        pg8::gemm_phase<EpiGate<0>, SchedPlainT<1024>, false, 512, true>(F.lds, S, E);
#else
        SchedPlain S; S.o.init(NTOK, 1024, F.G, F.bid); S.A = (const char*)(F.outb + OUT_OA); S.Bt = (const char*)(F.ws + WS_WPA);
        EpiGate<0> E{(const bf16_t*)(F.ws + WS_GA), nullptr, (bf16_t*)(F.ws + WS_Z), 1.0f};
        pg8::gemm_phase<EpiGate<0>, SchedPlain, false>(F.lds, S, E);
#endif
    }
    if (IN(9)) {
#if PB_FP8
        SchedPlainT<1024> S; S.o.init(NTOK, 1024, F.G, F.bid); S.A = (const char*)(F.outb + OUT_OB8); S.Bt = (const char*)(F.ws + WS_WPB8);
        EpiGate<1> E{(const bf16_t*)(F.ws + WS_GB), (const bf16_t*)(F.ws + WS_Z), (bf16_t*)(F.ws + WS_XBC), MOE_INV};
        pg8::gemm_phase<EpiGate<1>, SchedPlainT<1024>, false, 512, true>(F.lds, S, E);
#else
        SchedPlain S; S.o.init(NTOK, 1024, F.G, F.bid); S.A = (const char*)(F.ws + WS_Q); S.Bt = (const char*)(F.ws + WS_WPB);
        EpiGate<1> E{(const bf16_t*)(F.ws + WS_GB), (const bf16_t*)(F.ws + WS_Z), (bf16_t*)(F.ws + WS_XBC), 1.0f};
        pg8::gemm_phase<EpiGate<1>, SchedPlain, false>(F.lds, S, E);
#endif
        SEAM(9);
    }
    if (IN(10)) {
        SchedPlain S; S.o.init(NTOK, 1024, F.G, F.bid); S.A = (const char*)(F.ws + WS_XBC); S.Bt = (const char*)(F.ws + WS_WOUT);
        EpiOut E{F.a->in[0], (const float*)(F.ws + WS_MOD), (bf16_t*)(F.ws + WS_VB)};
        pg8::gemm_phase<EpiOut, SchedPlain, false>(F.lds, S, E);
        if (DBG_TWICE & 1024u) { GRID_BAR(); pg8::gemm_phase<EpiOut, SchedPlain, false>(F.lds, S, E); }
        SEAM(10);
    }
    if (IN(11)) { if (DBG_TWICE & 2048u) { ph_router<true>(F); GRID_BAR(); } ph_router<false>(F); SEAM(11); }
#pragma unroll
    for (int hf = 0; hf < 2; ++hf) {
        const int p0 = 12 + hf * 2;
        if (IN(p0)) {
            if (hf == 1) ph_final<false>(F, 0);
            MoeTab T = moe_tables(F, hf);
            SchedMoe<8, true> S{T, F.G, F.bid, hf, (const char*)(F.ws + WS_U2), (const char*)(F.ws + WS_W1), (const u32x2*)(F.ws + WS_REG)};
            EpiMoe1 E{F.a->in[23], (bf16_t*)(F.ws + WS_ACT), 0};
            pg8::gemm_phase<EpiMoe1, SchedMoe<8, true>, true, MOE_RB / 2, MOE_FP8 != 0>(F.lds, S, E);
            if ((DBG_TWICE & 4096u) && hf == 0) { GRID_BAR(); pg8::gemm_phase<EpiMoe1, SchedMoe<8, true>, true, MOE_RB / 2, MOE_FP8 != 0>(F.lds, S, E); }
            if ((DBG_TWICE & 16384u) && hf == 0) { GRID_BAR(); EpiMoe1 Ed = E; Ed.dry = 1; pg8::gemm_phase<EpiMoe1, SchedMoe<8, true>, true, MOE_RB / 2, MOE_FP8 != 0>(F.lds, S, Ed); }
            SEAM(p0);
        }
        if (IN(p0 + 1)) {
            MoeTab T = moe_tables(F, hf);
            SchedMoe<4, false> S{T, F.G, F.bid, hf, (const char*)(F.ws + WS_ACT), (const char*)(F.ws + WS_W2), (const u32x2*)(F.ws + WS_REG)};
            EpiMoe2 E{F.a->in[25], (bf16_t*)(F.ws + WS_YB), (const u32x2*)(F.ws + WS_REG), T, hf, 0};
            if ((DBG_TWICE & 262144u) && hf == 0) { EpiMoe2 Ed = E; Ed.dry = DBG_DRYMODE; pg8::gemm_phase<EpiMoe2, SchedMoe<4, false>, false, MOE_RB / 2, MOE_FP8 != 0>(F.lds, S, Ed); GRID_BAR(); }
            pg8::gemm_phase<EpiMoe2, SchedMoe<4, false>, false, MOE_RB / 2, MOE_FP8 != 0>(F.lds, S, E);
            if ((DBG_TWICE & 8192u) && hf == 0) { GRID_BAR(); pg8::gemm_phase<EpiMoe2, SchedMoe<4, false>, false, MOE_RB / 2, MOE_FP8 != 0>(F.lds, S, E); }
            if ((DBG_TWICE & 131072u) && hf == 0) { GRID_BAR(); EpiMoe2 Ed = E; Ed.dry = 1; pg8::gemm_phase<EpiMoe2, SchedMoe<4, false>, false, MOE_RB / 2, MOE_FP8 != 0>(F.lds, S, Ed); }
            SEAM(p0 + 1);
            if (DBG_CHECK == 1 && hf == 1) { dbg_check_moe(F); GRID_BAR(); }
        }
    }
    if (IN(16)) { if (DBG_TWICE & 65536u) { ph_final<true>(F, 1); GRID_BAR(); } ph_final(F, 1); }
    if (DBG_CHECK || DBG_CLOCK || DBG_KCLK || DBG_WALL) { GRID_BAR(); dbg_emit(F); }
#undef IN
#undef SEAM
}

extern "C" void kernel_launch(void* const* d_in, const int* in_sizes, int n_in, void* d_out, int out_size, void* d_ws, size_t ws_size, hipStream_t stream) {
    static int grid = 0;
    if (grid == 0) {
        if (n_in != 28 || in_sizes[0] != NTOK * D || out_size != NTOK * D || ws_size < WS_END) { fprintf(stderr, "kernel_launch: shape mismatch (n_in %d, in0 %d, out %d, ws %zu)\n", n_in, n_in > 0 ? in_sizes[0] : -1, out_size, ws_size); grid = -1; return; }
        int dev = 0, cus = 0, per_cu = 0;
        if (hipGetDevice(&dev) != hipSuccess || hipDeviceGetAttribute(&cus, hipDeviceAttributeMultiprocessorCount, dev) != hipSuccess) { grid = -1; return; }
        if (hipFuncSetAttribute((const void*)fwd, hipFuncAttributeMaxDynamicSharedMemorySize, LDS_BYTES) != hipSuccess) { fprintf(stderr, "kernel_launch: hipFuncSetAttribute failed\n"); grid = -1; return; }
        if (hipOccupancyMaxActiveBlocksPerMultiprocessor(&per_cu, (const void*)fwd, NTHR, LDS_BYTES) != hipSuccess || per_cu < 1) fprintf(stderr, "kernel_launch: occupancy query reports %d\n", per_cu);
        (void)hipGetLastError();
        grid = cus;
    }
    if (grid < 0) return;
    if (hipMemsetAsync((char*)d_ws + WS_CTL, 0, CTL_ZERO_BYTES, stream) != hipSuccess) { fprintf(stderr, "kernel_launch: memset failed\n"); return; }
    Args a{};
    for (int i = 0; i < 28; ++i) a.in[i] = (const float*)d_in[i];
    a.out = (float*)d_out; a.ws = (unsigned char*)d_ws;
    const int nph = NPHASE < MK_PH_HI ? NPHASE : MK_PH_HI;
#if MK_ONE
    a.ph_lo = 0; a.ph_hi = nph;
    hipLaunchKernelGGL(fwd, dim3(grid), dim3(NTHR), LDS_BYTES, stream, a);
#else
    for (int p = 0; p < nph; ++p) { a.ph_lo = p; a.ph_hi = p + 1; hipLaunchKernelGGL(fwd, dim3(grid), dim3(NTHR), LDS_BYTES, stream, a); }
#endif
    const hipError_t le = hipPeekAtLastError();
    if (le != hipSuccess) fprintf(stderr, "kernel_launch: launch failed: %s\n", hipGetErrorName(le));
}
```

```cpp
#include <hip/hip_runtime.h>
#include <cstdio>
#include <cstdint>

#ifndef MK_ONE
#define MK_ONE 1
#endif
#ifndef DBG_NO_ATTN
#define DBG_NO_ATTN 0
#endif
#ifndef DBG_ATTN_ZERO
#define DBG_ATTN_ZERO 0
#endif
#ifndef DBG_IQ_TRUNC
#define DBG_IQ_TRUNC 0
#endif
#ifndef DBG_ROUTER_BF16
#define DBG_ROUTER_BF16 0
#endif
#ifndef DBG_CHECK
#define DBG_CHECK 0
#endif
#ifndef DBG_SKIP_BODY
#define DBG_SKIP_BODY 0
#endif
#ifndef DBG_SUB
#define DBG_SUB 0
#endif
#ifndef DBG_SSD_SYNC
#define DBG_SSD_SYNC 0
#endif
#ifndef DBG_HYP
#define DBG_HYP 0
#endif
#ifndef DBG_TWICE
#define DBG_DRYPROJ 0
#define DBG_ABL6 0
#define DBG_ABL4 0
#define DBG_REP4 1
#define DBG_REP6 1
#define DBG_WALL 0
#define DBG_KCLK 0
#ifndef DBG_CLOCK
#define DBG_CLOCK 0
#endif
#define DBG_TWICE 0u
#endif
#ifndef DBG_DRYMODE
#define DBG_DRYMODE 2
#endif
#ifndef DBG_NO_SSD
#define DBG_NO_SSD 0
#endif
#ifndef DBG_NO_MOE
#define DBG_NO_MOE 0
#endif
#ifndef MOE_FP8
#define MOE_FP8 1
#endif
#ifndef PROJ_FP8
#define PROJ_FP8 1
#endif
#ifndef PA_FP8
#define PA_FP8 1
#endif
#ifndef PB_FP8
#define PB_FP8 0
#endif
#ifndef ATT2
#define ATT_OT 1
#define ATT2 1
#endif
#ifndef MK_PH_HI
#define MK_PH_HI 99
#endif

#define LAS __attribute__((address_space(3)))
#define GAS __attribute__((address_space(1)))
typedef unsigned short bf16_t;
typedef short bf16x8 __attribute__((ext_vector_type(8)));
typedef short s16x4 __attribute__((ext_vector_type(4)));
typedef float f32x2 __attribute__((ext_vector_type(2)));
typedef float f32x4 __attribute__((ext_vector_type(4)));
typedef float f32x16 __attribute__((ext_vector_type(16)));
typedef unsigned u32x2 __attribute__((ext_vector_type(2)));
typedef unsigned u32x4 __attribute__((ext_vector_type(4)));
typedef unsigned long long u64;

constexpr int NB = 32, SEQ = 2048, D = 1024, NTOK = NB * SEQ;
constexpr int NWAVES = 8, NTHR = 512;
constexpr int NPROJ = 6912;
constexpr int NEXP = 32, HALF_TOK = NTOK / 2, REG_CAP = HALF_TOK;
constexpr int ACT_ROWS = HALF_TOK * 4 + NEXP * 256;
constexpr float LN_EPS = 1e-5f;
constexpr float DN_ALPHA = 1.189207115002721f;
constexpr float LOG2E = 1.4426950408889634f;

constexpr size_t MiB = 1u << 20;
constexpr size_t WS_CTL = 0, CTL_ZERO_BYTES = 1 * MiB;
constexpr size_t WS_MOD = 1 * MiB;
constexpr size_t WS_BIAST = 1 * MiB + 800 * 1024;
constexpr size_t WS_WIN = 2 * MiB;
constexpr size_t WS_WPA = 16 * MiB, WS_WPB = 18 * MiB, WS_WOUT = 20 * MiB;
constexpr size_t WS_W1 = 24 * MiB;
constexpr size_t WS_U8 = 88 * MiB;
constexpr size_t WS_W2 = 152 * MiB;
constexpr size_t WS_WIN8 = 184 * MiB;
constexpr size_t WS_WPA8 = 192 * MiB;
constexpr size_t WS_WPB8 = 194 * MiB;
constexpr size_t OUT_OB8 = 192 * MiB;
constexpr size_t WS_Q = 216 * MiB;
constexpr size_t WS_Z = 344 * MiB;
constexpr size_t WS_XBC = 472 * MiB;
constexpr size_t WS_GA = 728 * MiB, WS_GB = 856 * MiB;
constexpr size_t WS_U2 = 216 * MiB;
constexpr size_t WS_REG = 344 * MiB;
constexpr size_t WS_ACT = 360 * MiB;
constexpr size_t WS_YB = 632 * MiB;
constexpr size_t WS_X1B = 496 * MiB;
constexpr size_t WS_VB = 744 * MiB;
constexpr size_t WS_END = 984 * MiB;
constexpr size_t WS_DBG = 889 * MiB;
constexpr size_t OUT_U = 0, OUT_MISC = 128 * MiB, OUT_IQ = 192 * MiB;
constexpr size_t OUT_KV = 0, OUT_IK = 16 * MiB, OUT_IW = 24 * MiB, OUT_DT = 26 * MiB, OUT_MASK = 32 * MiB, OUT_OA = 64 * MiB;
constexpr int CW_BAR = 4096, CW_CNT = 16384, CW_WQ = 22528, CW_DBG = 24576;

constexpr int LDS_BYTES = 160 * 1024;
constexpr int LDS_AUX = 131072;
constexpr int LDS_MISC = LDS_BYTES - 256;

#define LDS_WAIT() asm volatile("s_waitcnt lgkmcnt(0)" ::: "memory")
#define GAS __attribute__((address_space(1)))
#define VM_WAIT() asm volatile("s_waitcnt vmcnt(0)" ::: "memory")
#define SBAR() __builtin_amdgcn_sched_barrier(0)
typedef __bf16 bf16x2_t __attribute__((ext_vector_type(2)));
__device__ __forceinline__ unsigned cvt_pk_bf16(float lo, float hi) { f32x2 f = {lo, hi}; bf16x2_t v = __builtin_convertvector(f, bf16x2_t); return __builtin_bit_cast(unsigned, v); }
__device__ __forceinline__ float bflo(unsigned w) { return __uint_as_float(w << 16); }
__device__ __forceinline__ float bfhi(unsigned w) { return __uint_as_float(w & 0xffff0000u); }
__device__ __forceinline__ u32x4 pack8(f32x4 a, f32x4 b) { u32x4 w; w.x = cvt_pk_bf16(a[0], a[1]); w.y = cvt_pk_bf16(a[2], a[3]); w.z = cvt_pk_bf16(b[0], b[1]); w.w = cvt_pk_bf16(b[2], b[3]); return w; }
constexpr int MOE_RB = MOE_FP8 ? 1024 : 2048;
constexpr float MOE_WSC = MOE_FP8 ? 64.0f : 1.0f, MOE_INV = 1.0f / MOE_WSC;
__device__ __forceinline__ u32x2 pack8_fp8(f32x4 a, f32x4 b) { int lo = 0, hi = 0;
    lo = __builtin_amdgcn_cvt_pk_fp8_f32(a[0], a[1], lo, false); lo = __builtin_amdgcn_cvt_pk_fp8_f32(a[2], a[3], lo, true);
    hi = __builtin_amdgcn_cvt_pk_fp8_f32(b[0], b[1], hi, false); hi = __builtin_amdgcn_cvt_pk_fp8_f32(b[2], b[3], hi, true);
    u32x2 r; r.x = (unsigned)lo; r.y = (unsigned)hi; return r; }
__device__ __forceinline__ void unpack8(u32x4 w, f32x4& a, f32x4& b) { a[0] = bflo(w.x); a[1] = bfhi(w.x); a[2] = bflo(w.y); a[3] = bfhi(w.y); b[0] = bflo(w.z); b[1] = bfhi(w.z); b[2] = bflo(w.w); b[3] = bfhi(w.w); }
__device__ __forceinline__ float dpp_scan_add(float v) {
#define DPPF(x, ctrl, rm) __builtin_bit_cast(float, __builtin_amdgcn_update_dpp(0, __builtin_bit_cast(int, (x)), (ctrl), (rm), 0xf, false))
    v += DPPF(v, 0x111, 0xf); v += DPPF(v, 0x112, 0xf); v += DPPF(v, 0x114, 0xf); v += DPPF(v, 0x118, 0xf);
    v += DPPF(v, 0x142, 0xa);
    v += DPPF(v, 0x143, 0xc);
#undef DPPF
    return v;
}
__device__ __forceinline__ unsigned dpp_half_sums_u32(unsigned v) {
#define DPPU(x, ctrl, rm) (unsigned)__builtin_amdgcn_update_dpp(0, (int)(x), (ctrl), (rm), 0xf, false)
    v += DPPU(v, 0x111, 0xf); v += DPPU(v, 0x112, 0xf); v += DPPU(v, 0x114, 0xf); v += DPPU(v, 0x118, 0xf); v += DPPU(v, 0x142, 0xa);
#undef DPPU
    return v;
}
__device__ __forceinline__ float dpp_half_sums_f32(float v) {
#define DPPF(x, ctrl, rm) __builtin_bit_cast(float, __builtin_amdgcn_update_dpp(0, __builtin_bit_cast(int, (x)), (ctrl), (rm), 0xf, false))
    v += DPPF(v, 0x111, 0xf); v += DPPF(v, 0x112, 0xf); v += DPPF(v, 0x114, 0xf); v += DPPF(v, 0x118, 0xf); v += DPPF(v, 0x142, 0xa);
#undef DPPF
    return v;
}
__device__ __forceinline__ float wave_sum(float v) { v = dpp_scan_add(v); return __builtin_bit_cast(float, __builtin_amdgcn_readlane(__builtin_bit_cast(int, v), 63)); }
__device__ __forceinline__ float fast_rcp(float x) { return __builtin_amdgcn_rcpf(x); }
__device__ __forceinline__ float sigmoid_f(float x) { return fast_rcp(1.0f + __expf(-x)); }
__device__ __forceinline__ float silu_f(float x) { return x * sigmoid_f(x); }

#define XB_TMO      128
#define XB_XCNT(j)  (256  + 64 * (j))
#define XB_XSUB(j)  (1280 + 64 * (j))
#define XB_XGEN(j)  (2304 + 64 * (j))
#define XB_TOP      3328
#define XB_TOPGEN   3392
#define XCD_BAR_WORDS 3456
#define XB_SPIN_CAP (1u << 18)
__device__ __forceinline__ unsigned xb_ld(unsigned* p)              { return __hip_atomic_load(p, __ATOMIC_RELAXED, __HIP_MEMORY_SCOPE_AGENT); }
__device__ __forceinline__ unsigned xb_add(unsigned* p, unsigned v) { return __hip_atomic_fetch_add(p, v, __ATOMIC_RELAXED, __HIP_MEMORY_SCOPE_AGENT); }
__device__ __forceinline__ unsigned xb_xcc_id() { return (unsigned)__builtin_amdgcn_s_getreg((3 << 11) | 20) & 0xFu; }
#define XB_SPIN(cond, bar) do { unsigned _sp = 0; while (cond) { __builtin_amdgcn_s_sleep(1); \
    if ((++_sp & 255u) == 0u) { if (xb_ld(&(bar)[XB_TMO])) break; if (_sp > XB_SPIN_CAP) { atomicAdd(&(bar)[XB_TMO], 1u); break; } } } } while (0)
struct XcdBarrier { unsigned* bar; unsigned x; volatile LAS unsigned* st; };
__device__ __forceinline__ XcdBarrier xcd_barrier_post(unsigned* bar, volatile LAS unsigned* st) {
    XcdBarrier b; b.bar = bar; b.x = xb_xcc_id(); b.st = st;
    if (threadIdx.x == 0) (void)xb_add(&bar[XB_XCNT(b.x)], 1u);
    return b;
}
__device__ __forceinline__ void xcd_barrier_complete(unsigned* bar, unsigned x, unsigned& nloc, unsigned& nx) {
    const unsigned G = gridDim.x * gridDim.y * gridDim.z;
    unsigned sum, cnt, mine, sp = 0u;
    for (;;) {
        sum = 0u; cnt = 0u;
#pragma nounroll
        for (unsigned j = 0; j < 16; ++j) { const unsigned c = xb_ld(&bar[XB_XCNT(j)]); sum += c; cnt += (c > 0u) ? 1u : 0u; }
        if (sum == G) break;
        __builtin_amdgcn_s_sleep(1);
        if ((++sp & 255u) == 0u) { if (xb_ld(&bar[XB_TMO])) break; if (sp > XB_SPIN_CAP) { atomicAdd(&bar[XB_TMO], 1u); break; } }
    }
    mine = xb_ld(&bar[XB_XCNT(x)]);
    nloc = mine > 0u ? mine : 1u; nx = cnt > 0u ? cnt : 1u;
}
__device__ __forceinline__ void xcd_barrier(const XcdBarrier& b) {
    asm volatile("s_waitcnt vmcnt(0)" ::: "memory");
    __syncthreads();
    if (threadIdx.x == 0) {
        unsigned* bar = b.bar;
        __builtin_amdgcn_s_waitcnt(0);
        unsigned nloc = b.st[0], nx = b.st[1];
        if (nloc == 0u) { xcd_barrier_complete(bar, b.x, nloc, nx); b.st[0] = nloc; b.st[1] = nx; }
        const unsigned old = xb_add(&bar[XB_XSUB(b.x)], 1u);
        const unsigned gen = old / nloc;
        if (old + 1u == (gen + 1u) * nloc) {
            __builtin_amdgcn_fence(__ATOMIC_RELEASE, "agent");
            asm volatile("s_waitcnt vmcnt(0)" ::: "memory");
            const unsigned og = xb_add(&bar[XB_TOP], 1u);
            const unsigned tg = og / nx;
            if (og + 1u == (tg + 1u) * nx) xb_add(&bar[XB_TOPGEN], 1u);
            else XB_SPIN(xb_ld(&bar[XB_TOPGEN]) == tg, bar);
            __builtin_amdgcn_fence(__ATOMIC_ACQUIRE, "agent");
            xb_add(&bar[XB_XGEN(b.x)], 1u);
            asm volatile("s_waitcnt vmcnt(0)" ::: "memory");
        } else {
            XB_SPIN(xb_ld(&bar[XB_XGEN(b.x)]) == gen, bar);
            __builtin_amdgcn_fence(__ATOMIC_ACQUIRE, "agent");
            asm volatile("s_waitcnt vmcnt(0)" ::: "memory");
        }
    }
    __syncthreads();
}

namespace pg8 {
constexpr int BM = 256, BK = 64, HALF = 128, HTB = HALF * BK * 2, STAGE_BYTES = 8 * HTB, NXCD = 8, WGM = 8, KD = 1024;
__host__ __device__ __forceinline__ int lds_byte(int r, int c) { const int st = (r >> 4) * 2 + (c >> 5), rr = r & 15, cc = c & 31, ob = rr * 64 + cc * 2; return st * 1024 + (ob ^ (((ob >> 9) & 1) << 5)); }
__host__ __device__ __forceinline__ void stage_rc(int b, int& R, int& C) { const int st = b / 1024, sb = b % 1024, swz = sb ^ (((sb >> 9) & 1) << 5); R = (st >> 1) * 16 + swz / 64; C = (st & 1) * 32 + (swz % 64) / 2; }
__host__ __device__ __forceinline__ int perm32(int rho) { const int n = rho >> 4, i = rho & 15; return 8 * (i >> 2) + 4 * n + (i & 3); }
struct Unit { int pm, pn, ex; };
struct StaticOrder {
    int nM, nN, nwg, G, c;
    __device__ void init(int M, int N, int G_, int c_) { nM = M / BM; nN = N / BM; nwg = nM * nN; G = G_; c = c_; }
    __device__ bool next(int i, Unit& u) const {
        const long L = (long)i * G + c; if (L >= nwg) return false;
        int wgid = (int)L; { const int q = nwg / NXCD, r = nwg % NXCD, xcd = wgid % NXCD, off = wgid / NXCD; wgid = (xcd < r ? xcd * (q + 1) : r * (q + 1) + (xcd - r) * q) + off; }
        const int nig = WGM * nN, gid = wgid / nig, fm = gid * WGM, gsz = (nM - fm) < WGM ? (nM - fm) : WGM;
        u.pm = fm + ((wgid % nig) % gsz); u.pn = (wgid % nig) / gsz; u.ex = 0; return true;
    }
};
typedef int i32x8 __attribute__((ext_vector_type(8)));
typedef int i32x4v __attribute__((ext_vector_type(4)));
template <class T> __device__ __forceinline__ auto dbgw_of(const T& s, int) -> decltype(s.dbgw) { return s.dbgw; }
template <class T> __device__ __forceinline__ unsigned* dbgw_of(const T&, long) { return nullptr; }
template <class Epi, class Sched, bool GATHER, int KE = 1024, bool FP8 = false>
__device__ __forceinline__ void gemm_phase(LAS unsigned char* lds, const Sched& S, const Epi& E) {
    int tid = threadIdx.x; asm volatile("" : "+v"(tid));
    const int wid = __builtin_amdgcn_readfirstlane(tid >> 6), lane = tid & 63, wr = wid >> 2, wc = wid & 3, fr = lane & 15, fq = lane >> 4;
    constexpr int K = KE, nt = K / BK;
    unsigned voffA[2], voffB[2]; int Rr[2], Cc[2];
#pragma unroll
    for (int i = 0; i < 2; ++i) { int R, C; stage_rc(tid * 16 + i * 8192, R, C); const int Rb = Epi::PERM ? ((R & ~31) + perm32(R & 31)) : R;
        voffA[i] = (unsigned)(R * K + C) * 2u; voffB[i] = (unsigned)(Rb * K + C) * 2u; Rr[i] = R; Cc[i] = C; }
    constexpr size_t kstep = (size_t)(BK * 2);
    constexpr size_t hstep = (size_t)HALF * K * 2;
    const unsigned ldsw = (unsigned)wid * 1024u;
    const int aoff = lds_byte(wr * 64 + fr, fq * 8), boff = lds_byte(wc * 32 + fr, fq * 8);
#define PG8_SA(b, h) (((b) * 2 + (h)) * HTB)
#define PG8_SB(b, h) ((4 + (b) * 2 + (h)) * HTB)
#define PG8_STAGE(bufoff, gbase, voff) do { _Pragma("unroll") for (int _i = 0; _i < 2; ++_i) \
        __builtin_amdgcn_global_load_lds((const unsigned*)((const char*)(gbase) + (voff)[_i]), (LAS unsigned*)(lds + (bufoff) + ldsw + _i * 8192), 16, 0, 0); } while (0)
#define PG8_STAGE_A(bufoff, gb, h, o0, o1) do { if constexpr (GATHER) { const unsigned _ko = (unsigned)((gb) - gA0); unsigned _o[2]; \
            if ((h) == 0) { _o[0] = (o0)[0] + _ko; _o[1] = (o0)[1] + _ko; } else { _o[0] = (o1)[0] + _ko; _o[1] = (o1)[1] + _ko; } PG8_STAGE(bufoff, gA0, _o); } \
        else { PG8_STAGE(bufoff, (gb) + (h) * hstep, voffA); } } while (0)
#define PG8_LD8(p) __builtin_shufflevector(*(const LAS i32x4v*)(p), *(const LAS i32x4v*)((p) + 1024), 0, 1, 2, 3, 4, 5, 6, 7)
#define PG8_LDA(dst, b, h) do { if constexpr (FP8) { _Pragma("unroll") for (int m = 0; m < 4; ++m) dst##8[m] = PG8_LD8(lds + PG8_SA(b, h) + aoff + m * 2048); } \
        else { _Pragma("unroll") for (int m = 0; m < 4; ++m) _Pragma("unroll") for (int k = 0; k < 2; ++k) dst[m][k] = *(const LAS bf16x8*)(lds + PG8_SA(b, h) + aoff + m * 2048 + k * 1024); } } while (0)
#define PG8_LDB(dst, b, h) do { if constexpr (FP8) { _Pragma("unroll") for (int n = 0; n < 2; ++n) dst##8[n] = PG8_LD8(lds + PG8_SB(b, h) + boff + n * 2048); } \
        else { _Pragma("unroll") for (int n = 0; n < 2; ++n) _Pragma("unroll") for (int k = 0; k < 2; ++k) dst[n][k] = *(const LAS bf16x8*)(lds + PG8_SB(b, h) + boff + n * 2048 + k * 1024); } } while (0)
#define PG8_MMA(ai, bj, At, Bt) do { __builtin_amdgcn_s_setprio(1); if constexpr (FP8) { _Pragma("unroll") for (int m = 0; m < 4; ++m) _Pragma("unroll") for (int n = 0; n < 2; ++n) \
            asm volatile("v_mfma_scale_f32_16x16x128_f8f6f4 %0, %1, %2, %0, %3, %3 op_sel_hi:[0,0,0]" : "+v"(acc[ai][bj][m][n]) : "v"(Bt##8[n]), "v"(At##8[m]), "v"(sc127)); } \
        else { _Pragma("unroll") for (int m = 0; m < 4; ++m) _Pragma("unroll") for (int n = 0; n < 2; ++n) _Pragma("unroll") for (int k = 0; k < 2; ++k) \
            acc[ai][bj][m][n] = __builtin_amdgcn_mfma_f32_16x16x32_bf16(Bt[n][k], At[m][k], acc[ai][bj][m][n], 0, 0, 0); } __builtin_amdgcn_s_setprio(0); } while (0)
#define PG8_WAIT_V(n) asm volatile("s_waitcnt vmcnt(" #n ")" ::: "memory")
#define PG8_WAIT_L(n) asm volatile("s_waitcnt lgkmcnt(" #n ")" ::: "memory")
#define PG8_BAR __builtin_amdgcn_s_barrier()
#define PG8_SCHED __builtin_amdgcn_sched_barrier(0)
    Unit cur, nxt; int ui = 0; unsigned long long kcsum = 0; int kcn = 0; const unsigned long long kph0 = (DBG_KCLK && !FP8 && !GATHER) ? __builtin_amdgcn_s_memtime() : 0ull;
    if (!S.next(0, cur)) return;
    f32x4 acc[2][2][4][2];
#pragma unroll
    for (int a = 0; a < 2; ++a)
#pragma unroll
        for (int b = 0; b < 2; ++b)
#pragma unroll
            for (int m = 0; m < 4; ++m)
#pragma unroll
                for (int n = 0; n < 2; ++n) acc[a][b][m][n] = (f32x4){0.f, 0.f, 0.f, 0.f};
    const int sc127 = 0x7f7f7f7f;
    bf16x8 At[4][2], B0[2][2], B1[2][2]; i32x8 At8[4], B08[2], B18[2];
    const char* cA = S.a_base(cur); const char* cB = S.b_base(cur);
    const char* const gA0 = cA;
    unsigned cv0[2] = {0u, 0u}, cv1[2] = {0u, 0u}, nv0[2] = {0u, 0u}, nv1[2] = {0u, 0u};
    if constexpr (GATHER) S.a_offs(cur, Rr, Cc, cv0, cv1);
    PG8_STAGE(PG8_SB(0, 0), cB, voffB); PG8_STAGE_A(PG8_SA(0, 0), cA, 0, cv0, cv1); PG8_STAGE(PG8_SB(0, 1), cB + hstep, voffB); PG8_STAGE_A(PG8_SA(0, 1), cA, 1, cv0, cv1);
    if (wr == 1) PG8_BAR;
    PG8_WAIT_V(4); PG8_BAR;
    PG8_STAGE(PG8_SB(1, 0), cB + kstep, voffB); PG8_STAGE_A(PG8_SA(1, 0), cA + kstep, 0, cv0, cv1); PG8_STAGE(PG8_SB(1, 1), cB + hstep + kstep, voffB);
    PG8_WAIT_V(6); PG8_BAR;
    for (;;) {
        const bool has_next = S.next(ui + 1, nxt);
        const char* nA = has_next ? S.a_base(nxt) : cA; const char* nB = has_next ? S.b_base(nxt) : cB;
        if constexpr (GATHER) { if (has_next) S.a_offs(nxt, Rr, Cc, nv0, nv1); else { nv0[0] = cv0[0]; nv0[1] = cv0[1]; nv1[0] = cv1[0]; nv1[1] = cv1[1]; } }
        unsigned long long kc0 = 0; if constexpr (DBG_KCLK && !FP8 && !GATHER) kc0 = __builtin_amdgcn_s_memtime();
#pragma nounroll
        for (int t = 0; t < nt; t += 2) {
            const bool last = (t == nt - 2);
            const char* a1 = cA + (size_t)(t + 1) * kstep;
            const char* a2 = last ? nA : cA + (size_t)(t + 2) * kstep; const char* b2 = last ? nB : cB + (size_t)(t + 2) * kstep;
            const char* a3 = a2 + kstep; const char* b3 = b2 + kstep;
            unsigned s0[2], s1[2];
            if constexpr (GATHER) { s0[0] = last ? nv0[0] : cv0[0]; s0[1] = last ? nv0[1] : cv0[1]; s1[0] = last ? nv1[0] : cv1[0]; s1[1] = last ? nv1[1] : cv1[1]; } else { s0[0] = s0[1] = s1[0] = s1[1] = 0u; }
            PG8_LDB(B0, 0, 0); PG8_SCHED; PG8_LDA(At, 0, 0); PG8_STAGE_A(PG8_SA(1, 1), a1, 1, cv0, cv1);
            PG8_WAIT_L(8); PG8_BAR; PG8_WAIT_L(0); PG8_MMA(0, 0, At, B0); PG8_BAR; PG8_SCHED;
            PG8_LDB(B1, 0, 1); PG8_STAGE(PG8_SB(0, 0), b2, voffB);
            PG8_BAR; PG8_WAIT_L(0); PG8_MMA(0, 1, At, B1); PG8_BAR;
            PG8_LDA(At, 0, 1); PG8_STAGE_A(PG8_SA(0, 0), a2, 0, s0, s1);
            PG8_BAR; PG8_WAIT_L(0); PG8_MMA(1, 0, At, B0); PG8_BAR; PG8_SCHED;
            PG8_STAGE(PG8_SB(0, 1), b2 + hstep, voffB);
            PG8_WAIT_V(6); PG8_BAR; PG8_MMA(1, 1, At, B1); PG8_BAR;
            PG8_LDB(B0, 1, 0); PG8_SCHED; PG8_LDA(At, 1, 0); PG8_STAGE_A(PG8_SA(0, 1), a2, 1, s0, s1);
            PG8_WAIT_L(8); PG8_BAR; PG8_WAIT_L(0); PG8_MMA(0, 0, At, B0); PG8_BAR; PG8_SCHED;
            PG8_LDB(B1, 1, 1); PG8_STAGE(PG8_SB(1, 0), b3, voffB);
            PG8_BAR; PG8_WAIT_L(0); PG8_MMA(0, 1, At, B1); PG8_BAR;
            PG8_LDA(At, 1, 1); PG8_STAGE_A(PG8_SA(1, 0), a3, 0, s0, s1);
            PG8_BAR; PG8_WAIT_L(0); PG8_MMA(1, 0, At, B0); PG8_BAR; PG8_SCHED;
            PG8_STAGE(PG8_SB(1, 1), b3 + hstep, voffB);
            PG8_WAIT_V(6); PG8_BAR; PG8_MMA(1, 1, At, B1); PG8_BAR;
        }
        if constexpr (DBG_KCLK && !FP8 && !GATHER) { kc0 = __builtin_amdgcn_s_memtime(); }
        if constexpr (FP8) asm volatile("s_nop 15\n\ts_nop 15" ::: "memory");
        E(acc, cur, wr, wc, fr, fq);
        if constexpr (DBG_KCLK && !FP8 && !GATHER) { asm volatile("s_waitcnt vmcnt(0)" ::: "memory"); kcsum += __builtin_amdgcn_s_memtime() - kc0; ++kcn; }
        if (!has_next) break;
#pragma unroll
        for (int a = 0; a < 2; ++a)
#pragma unroll
            for (int b = 0; b < 2; ++b)
#pragma unroll
                for (int m = 0; m < 4; ++m)
#pragma unroll
                    for (int n = 0; n < 2; ++n) acc[a][b][m][n] = (f32x4){0.f, 0.f, 0.f, 0.f};
        cur = nxt; cA = nA; cB = nB; ++ui;
        if constexpr (GATHER) { cv0[0] = nv0[0]; cv0[1] = nv0[1]; cv1[0] = nv1[0]; cv1[1] = nv1[1]; }
    }
    PG8_WAIT_V(0);
    if (wr == 0) PG8_BAR;
    PG8_BAR;
    if constexpr (DBG_KCLK && !FP8 && !GATHER) { unsigned* dw = dbgw_of(S, 0); if (dw && tid == 0) { kcsum = __builtin_amdgcn_s_memtime() - kph0; const float cpk = (float)kcsum / (float)(kcn) * (1.f / 40000.f); atomicMax(dw, __float_as_uint(powf(10.f, 2.f * (rintf(cpk * 10.f) * 0.1f) - 4.f))); } }
#undef PG8_SA
#undef PG8_SB
#undef PG8_STAGE
#undef PG8_STAGE_A
#undef PG8_LDA
#undef PG8_LDB
#undef PG8_MMA
#undef PG8_LD8
#undef PG8_WAIT_V
#undef PG8_WAIT_L
#undef PG8_BAR
#undef PG8_SCHED
}
}
using pg8::Unit;
typedef f32x4 AccT[2][2][4][2];

struct Args { const float* in[28]; float* out; unsigned char* ws; int ph_lo, ph_hi, pad0, pad1; };
struct Frame {
    LAS unsigned char* lds;
    int tid, lane, wave, G, bid;
    const struct Args* a;
    unsigned char* ws; unsigned char* outb;
};
template <int RB = 2048> struct SchedPlainT {
    pg8::StaticOrder o; const char* A; const char* Bt;
    __device__ __forceinline__ bool next(int i, Unit& u) const { return o.next(i, u); }
    __device__ __forceinline__ const char* a_base(const Unit& u) const { return A + (size_t)u.pm * (256 * RB); }
    __device__ __forceinline__ const char* b_base(const Unit& u) const { return Bt + (size_t)u.pn * (256 * RB); }
    __device__ __forceinline__ void a_offs(const Unit&, const int*, const int*, unsigned (&)[2], unsigned (&)[2]) const {}
};
typedef SchedPlainT<2048> SchedPlain;
template <int MODE> struct SchedProj {
    pg8::StaticOrder o; const char* A; const char* Bt; int fold = 0x7fffffff; unsigned* dbgw = nullptr;
    static constexpr int RB = MODE == 2 ? 1024 : 2048;
    __device__ __forceinline__ bool next(int i, Unit& u) const { if (!o.next(i, u)) return false; const int r = u.pn;
        if (MODE == 1) u.pn = 4 + r;
        if (MODE == 2) u.pn = r < 4 ? r : 15 + r;
        return true; }
    __device__ __forceinline__ const char* a_base(const Unit& u) const { return A + (size_t)(DBG_DRYPROJ ? (u.pm & fold) : u.pm) * (256 * RB); }
    __device__ __forceinline__ const char* b_base(const Unit& u) const { return Bt + (size_t)u.pn * (256 * RB); }
    __device__ __forceinline__ void a_offs(const Unit&, const int*, const int*, unsigned (&)[2], unsigned (&)[2]) const {}
};

struct EpiProj {
    static constexpr bool PERM = true;
    bf16_t *Q, *IQ, *Z, *XBC, *GA, *GB; float* MISC; float sc; int dry = 0;
    __device__ __forceinline__ void operator()(const AccT& acc, const Unit& u, int wr, int wc, int fr, int fq) const {
        const int pn = u.pn, row0 = u.pm * 256 + wr * 64 + fr, c8 = wc * 32 + 8 * fq;
        if (pn == 6) {
#pragma unroll
            for (int ai = 0; ai < 2; ++ai)
#pragma unroll
                for (int m = 0; m < 4; ++m) { float* rp = MISC + (size_t)(row0 + ai * 128 + m * 16) * 256 + c8;
#pragma unroll
                    for (int bj = 0; bj < 2; ++bj) { if (DBG_DRYPROJ && dry && acc[ai][bj][m][0][0] != 1.2345e-33f) continue; *(f32x4*)(rp + bj * 128) = acc[ai][bj][m][0]; *(f32x4*)(rp + bj * 128 + 4) = acc[ai][bj][m][1]; } }
            return;
        }
        bf16_t* base; int ldc, colt, act = 0;
        if (pn < 4) { base = Q; ldc = 1024; colt = pn * 256; }
        else if (pn < 6) { base = IQ; ldc = 512; colt = (pn - 4) * 256; }
        else if (pn < 11) { base = Z; ldc = 1024; colt = (pn - 7) * 256; act = 1; }
        else if (pn < 19) { base = XBC; ldc = 2048; colt = (pn - 11) * 256; }
        else if (pn < 23) { base = GA; ldc = 1024; colt = (pn - 19) * 256; act = 2; }
        else { base = GB; ldc = 1024; colt = (pn - 23) * 256; act = 2; }
#pragma unroll
        for (int ai = 0; ai < 2; ++ai)
#pragma unroll
            for (int m = 0; m < 4; ++m) { bf16_t* rp = base + (size_t)(row0 + ai * 128 + m * 16) * ldc + colt + c8;
#pragma unroll
                for (int bj = 0; bj < 2; ++bj) { f32x4 v0 = acc[ai][bj][m][0] * sc, v1 = acc[ai][bj][m][1] * sc;
                    if (act == 1) {
#pragma unroll
                        for (int j = 0; j < 4; ++j) { v0[j] = silu_f(v0[j]); v1[j] = silu_f(v1[j]); } }
                    if (act == 2) {
#pragma unroll
                        for (int j = 0; j < 4; ++j) { v0[j] = sigmoid_f(v0[j]); v1[j] = sigmoid_f(v1[j]); } }
                    u32x4 pk = pack8(v0, v1); if (DBG_IQ_TRUNC && (pn == 4 || pn == 5)) { pk.x &= 0xfff8fff8u; pk.y &= 0xfff8fff8u; pk.z &= 0xfff8fff8u; pk.w &= 0xfff8fff8u; }
                    if (DBG_DRYPROJ && dry && pk.x != 0x7fc17fc3u) continue;
                    *(u32x4*)(rp + bj * 128) = pk; } }
    }
};
template <int MODE> struct EpiGate {
    static constexpr bool PERM = true;
    const bf16_t* Gt; const bf16_t* T; bf16_t* O; float sc;
    __device__ __forceinline__ void operator()(const AccT& acc, const Unit& u, int wr, int wc, int fr, int fq) const {
        const int row0 = u.pm * 256 + wr * 64 + fr, c8 = u.pn * 256 + wc * 32 + 8 * fq;
#pragma unroll
        for (int ai = 0; ai < 2; ++ai) {
            u32x4 gq[4][2], tq[4][2];
#pragma unroll
            for (int m = 0; m < 4; ++m) { const size_t off = (size_t)(row0 + ai * 128 + m * 16) * 1024 + c8;
#pragma unroll
                for (int bj = 0; bj < 2; ++bj) { gq[m][bj] = *(const u32x4*)(Gt + off + bj * 128); if (MODE == 1) tq[m][bj] = *(const u32x4*)(T + off + bj * 128); } }
            SBAR();
#pragma unroll
            for (int m = 0; m < 4; ++m) { const size_t off = (size_t)(row0 + ai * 128 + m * 16) * 1024 + c8;
#pragma unroll
                for (int bj = 0; bj < 2; ++bj) { f32x4 g0, g1; unpack8(gq[m][bj], g0, g1);
                    f32x4 v0 = g0 * (acc[ai][bj][m][0] * sc), v1 = g1 * (acc[ai][bj][m][1] * sc);
                    if ((MODE == 0 && DBG_NO_ATTN) || (MODE == 1 && DBG_NO_SSD)) { v0 = (f32x4){0.f, 0.f, 0.f, 0.f}; v1 = v0; }
                    if (MODE == 1) { f32x4 t0, t1; unpack8(tq[m][bj], t0, t1); v0 += t0; v1 += t1; }
                    *(u32x4*)(O + off + bj * 128) = pack8(v0, v1); } }
            SBAR();
        }
    }
};
struct EpiOut {
    static constexpr bool PERM = true;
    const float* x; const float* mod; bf16_t* V;
    __device__ __forceinline__ void operator()(const AccT& acc, const Unit& u, int wr, int wc, int fr, int fq) const {
        const int row0 = u.pm * 256 + wr * 64 + fr, c8 = u.pn * 256 + wc * 32 + 8 * fq;
        const float* g1 = mod + (size_t)(u.pm >> 3) * 6144 + 2048 + c8;
        f32x4 gv[2][2];
#pragma unroll
        for (int bj = 0; bj < 2; ++bj)
#pragma unroll
            for (int n = 0; n < 2; ++n) gv[bj][n] = *(const f32x4*)(g1 + bj * 128 + n * 4);
#pragma unroll
        for (int ai = 0; ai < 2; ++ai)
#pragma unroll
            for (int mp = 0; mp < 2; ++mp) {
                f32x4 xv[2][2][2];
#pragma unroll
                for (int mm = 0; mm < 2; ++mm) { const size_t off = (size_t)(row0 + ai * 128 + (2 * mp + mm) * 16) * 1024 + c8;
#pragma unroll
                    for (int bj = 0; bj < 2; ++bj)
#pragma unroll
                        for (int n = 0; n < 2; ++n) xv[mm][bj][n] = *(const f32x4*)(x + off + bj * 128 + n * 4); }
                SBAR();
#pragma unroll
                for (int mm = 0; mm < 2; ++mm) { const int m = 2 * mp + mm; const size_t off = (size_t)(row0 + ai * 128 + m * 16) * 1024 + c8;
#pragma unroll
                    for (int bj = 0; bj < 2; ++bj)
                        *(u32x4*)(V + off + bj * 128) = pack8(xv[mm][bj][0] * DN_ALPHA + gv[bj][0] * acc[ai][bj][m][0], xv[mm][bj][1] * DN_ALPHA + gv[bj][1] * acc[ai][bj][m][1]); }
                SBAR();
            }
    }
};

struct MoeTab { LAS unsigned* cnt; LAS unsigned* tb; LAS unsigned char* te; int ntiles; };
__device__ __forceinline__ MoeTab moe_tables(Frame& F, int hf) {
    MoeTab T; T.cnt = (LAS unsigned*)(F.lds + LDS_AUX); T.tb = (LAS unsigned*)(F.lds + LDS_AUX + 256); T.te = (LAS unsigned char*)(F.lds + LDS_AUX + 512);
    const unsigned* CNT = (const unsigned*)(F.ws + WS_CTL) + CW_CNT;
    __syncthreads();
    if (F.tid < 32) { unsigned c = __hip_atomic_load(CNT + 64 * (hf * 32 + F.tid), __ATOMIC_RELAXED, __HIP_MEMORY_SCOPE_AGENT); if (c > (unsigned)REG_CAP) c = REG_CAP; T.cnt[F.tid] = c; }
    __syncthreads();
    if (F.tid == 0) { unsigned s = 0;
#pragma nounroll
        for (int e = 0; e < 32; ++e) { T.tb[e] = s; const unsigned n = (T.cnt[e] + 255u) >> 8;
#pragma nounroll
            for (unsigned t = 0; t < n; ++t) T.te[s + t] = (unsigned char)e;
            s += n; }
        T.tb[32] = s; }
    __syncthreads();
    T.ntiles = __builtin_amdgcn_readfirstlane((int)T.tb[32]);
    return T;
}
template <int NJ, bool GATHER> struct SchedMoe {
    MoeTab T; int G, c, hf; const char* A; const char* Bt; const u32x2* REG;
    __device__ __forceinline__ bool next(int i, Unit& u) const {
        int tile, j;
        if (G == 256) { const int x = c & 7, sl = c >> 3;
            tile = i * (256 / NJ) + x * (32 / NJ) + sl / NJ; j = sl % NJ;
            if (tile >= T.ntiles) return false; }
        else { const int L = i * G + c; if (L >= T.ntiles * NJ) return false; tile = L / NJ; j = L % NJ; }
        u.pm = tile; u.pn = j; u.ex = __builtin_amdgcn_readfirstlane((int)T.te[u.pm]); return true;
    }
    __device__ __forceinline__ const char* a_base(const Unit& u) const { return GATHER ? A : A + (size_t)u.pm * (256 * MOE_RB); }
    __device__ __forceinline__ const char* b_base(const Unit& u) const { return Bt + ((size_t)u.ex * (NJ * 256) + (size_t)u.pn * 256) * MOE_RB; }
    __device__ __forceinline__ void a_offs(const Unit& u, const int* R, const int* C, unsigned (&o0)[2], unsigned (&o1)[2]) const {
        const unsigned cnt = __builtin_amdgcn_readfirstlane(T.cnt[u.ex]), pos0 = ((unsigned)u.pm - (unsigned)__builtin_amdgcn_readfirstlane(T.tb[u.ex])) * 256u; const u32x2* rg = REG + ((size_t)hf * 32 + u.ex) * REG_CAP;
#pragma unroll
        for (int i = 0; i < 2; ++i) {
            const unsigned p0 = pos0 + (unsigned)R[i], p1 = p0 + 128u;
            unsigned t0 = 0u, t1 = 0u;
            if (p0 < cnt) t0 = (unsigned)hf * HALF_TOK + (rg[p0].x >> 2);
            if (p1 < cnt) t1 = (unsigned)hf * HALF_TOK + (rg[p1].x >> 2);
            o0[i] = t0 * (unsigned)MOE_RB + (unsigned)C[i] * 2u; o1[i] = t1 * (unsigned)MOE_RB + (unsigned)C[i] * 2u;
        }
    }
};
struct EpiMoe1 {
    static constexpr bool PERM = true;
    const float* b1; bf16_t* ACT; int dry;
    __device__ __forceinline__ void operator()(const AccT& acc, const Unit& u, int wr, int wc, int fr, int fq) const {
        if (dry) { if (acc[0][0][0][0][0] == 1.2345e-33f) ACT[0] = 1; return; }
        const int row0 = u.pm * 256 + wr * 64 + fr, c8 = u.pn * 128 + wc * 32 + 8 * fq;
        const float* bg = b1 + (size_t)u.ex * 2048 + c8;
        const f32x4 bg0 = *(const f32x4*)bg, bg1 = *(const f32x4*)(bg + 4), bu0 = *(const f32x4*)(bg + 1024), bu1 = *(const f32x4*)(bg + 1028);
#pragma unroll
        for (int ai = 0; ai < 2; ++ai)
#pragma unroll
            for (int m = 0; m < 4; ++m) {
                f32x4 g0 = acc[ai][0][m][0] * MOE_INV + bg0, g1 = acc[ai][0][m][1] * MOE_INV + bg1, u0 = acc[ai][1][m][0] * MOE_INV + bu0, u1 = acc[ai][1][m][1] * MOE_INV + bu1, a0, a1;
#pragma unroll
                for (int j = 0; j < 4; ++j) {
                    float g = fminf(g0[j], 7.0f), up = fminf(fmaxf(u0[j], -7.0f), 7.0f); a0[j] = (up + 1.0f) * g * sigmoid_f(1.702f * g);
                    g = fminf(g1[j], 7.0f); up = fminf(fmaxf(u1[j], -7.0f), 7.0f); a1[j] = (up + 1.0f) * g * sigmoid_f(1.702f * g); }
                if (MOE_FP8) *(u32x2*)((unsigned char*)ACT + (size_t)(row0 + ai * 128 + m * 16) * 1024 + c8) = pack8_fp8(a0, a1);
                else *(u32x4*)(ACT + (size_t)(row0 + ai * 128 + m * 16) * 1024 + c8) = pack8(a0, a1); }
    }
};
struct EpiMoe2 {
    static constexpr bool PERM = true;
    const float* b2; bf16_t* YB; const u32x2* REG; MoeTab T; int hf; int dry;
    __device__ __forceinline__ void operator()(const AccT& acc, const Unit& u, int wr, int wc, int fr, int fq) const {
        if (dry == 1) { if (acc[0][0][0][0][0] == 1.2345e-33f) YB[0] = 1; return; }
        if (dry >= 2) {
            const int c8d = (dry == 3 ? 0 : u.pn * 256) + wc * 32 + 8 * fq; const unsigned rowd = dry == 3 ? (blockIdx.x * 256u + (unsigned)(wr * 64 + fr)) : ((unsigned)u.pm * 256u + (unsigned)(wr * 64 + fr)) % 131072u;
#pragma unroll
            for (int ai = 0; ai < 2; ++ai)
#pragma unroll
                for (int m = 0; m < 4; ++m) { bf16_t* rp = YB + (size_t)((rowd + ai * 128 + m * 16) % 131072u) * 1024 + c8d;
#pragma unroll
                    for (int bj = 0; bj < 2; ++bj) *(u32x4*)(rp + bj * 128) = pack8(acc[ai][bj][m][0] * MOE_INV, acc[ai][bj][m][1] * MOE_INV); }
            return; }
        const int c8 = u.pn * 256 + wc * 32 + 8 * fq;
        const unsigned cnt = __builtin_amdgcn_readfirstlane(T.cnt[u.ex]), pos0 = ((unsigned)u.pm - (unsigned)__builtin_amdgcn_readfirstlane(T.tb[u.ex])) * 256u + (unsigned)(wr * 64 + fr); const u32x2* rg = REG + ((size_t)hf * 32 + u.ex) * REG_CAP;
        const float* bb = b2 + (size_t)u.ex * 1024 + c8;
        f32x4 bv[2][2];
#pragma unroll
        for (int bj = 0; bj < 2; ++bj) { bv[bj][0] = *(const f32x4*)(bb + bj * 128); bv[bj][1] = *(const f32x4*)(bb + bj * 128 + 4); }
        u32x2 en8[2][4];
#pragma unroll
        for (int ai = 0; ai < 2; ++ai)
#pragma unroll
            for (int m = 0; m < 4; ++m) { const unsigned p = pos0 + (unsigned)(ai * 128 + m * 16); en8[ai][m] = rg[p < cnt ? p : cnt - 1u]; }
#pragma unroll
        for (int ai = 0; ai < 2; ++ai)
#pragma unroll
            for (int m = 0; m < 4; ++m) { const unsigned p = pos0 + (unsigned)(ai * 128 + m * 16);
                const u32x2 en = en8[ai][m]; const float g = __uint_as_float(en.y); const unsigned drow = p < cnt ? en.x : (unsigned)(HALF_TOK * 4);
                bf16_t* rp = YB + (size_t)drow * 1024 + c8;
#pragma unroll
                for (int bj = 0; bj < 2; ++bj) *(u32x4*)(rp + bj * 128) = pack8((acc[ai][bj][m][0] * MOE_INV + bv[bj][0]) * g, (acc[ai][bj][m][1] * MOE_INV + bv[bj][1]) * g); }
    }
};

struct MapIdent { __device__ __forceinline__ int operator()(int n) const { return n; } };
struct MapWin { __device__ __forceinline__ int operator()(int n) const {
    if (n < 1024) return n;
    if (n < 1536) return 1152 + (n - 1024);
    if (n < 1792) { const int c = n - 1536; if (c < 128) return 1024 + c; if (c < 192) return 1664 + (c - 128); if (c < 200) return 1728 + (c - 192); if (c < 216) return 4808 + (c - 200); return -1; }
    if (n < 2816) return 1736 + (n - 1792);
    if (n < 4864) return 2760 + (n - 2816);
    if (n < 5888) return 4824 + (n - 4864);
    return 5848 + (n - 5888); } };
struct MapW1 { __device__ __forceinline__ int operator()(int r) const { const int j = r >> 8, rr = r & 255; return (rr >> 7) * 1024 + j * 128 + (rr & 127); } };
template <class Map, bool F8 = false> __device__ __forceinline__ void transpose_item(const float* W, int K, int N, bf16_t* WT, const Map& map, LAS float* scr, int kb, int nb, int lane, const float* rowscale) {
    const int k0 = 64 * kb, n0 = 64 * nb, q = lane & 15, kr = lane >> 4; const int src = map(n0 + 4 * q);
    f32x4 ld[16];
#pragma unroll
    for (int i = 0; i < 16; ++i) { const int kk = 4 * i + kr; ld[i] = (src >= 0) ? *(const f32x4*)(W + (size_t)(k0 + kk) * N + src) : (f32x4){0.f, 0.f, 0.f, 0.f}; }
#pragma unroll
    for (int i = 0; i < 16; ++i) { const int kk = 4 * i + kr; f32x4 v = ld[i]; if (rowscale) v = v * rowscale[k0 + kk]; LAS float* d = scr + kk * 65 + 4 * q; d[0] = v[0]; d[1] = v[1]; d[2] = v[2]; d[3] = v[3]; }
    LDS_WAIT(); asm volatile("" ::: "memory");
    const int c = lane & 7;
#pragma unroll
    for (int j = 0; j < 8; ++j) { const int n = (lane >> 3) + 8 * j; const LAS float* s = scr + (8 * c) * 65 + n;
        if constexpr (F8) { const f32x4 a = {s[0 * 65] * MOE_WSC, s[1 * 65] * MOE_WSC, s[2 * 65] * MOE_WSC, s[3 * 65] * MOE_WSC}, b = {s[4 * 65] * MOE_WSC, s[5 * 65] * MOE_WSC, s[6 * 65] * MOE_WSC, s[7 * 65] * MOE_WSC};
            *(u32x2*)((unsigned char*)WT + (size_t)(n0 + n) * K + k0 + 8 * c) = pack8_fp8(a, b); }
        else { u32x4 o; o.x = cvt_pk_bf16(s[0 * 65], s[1 * 65]); o.y = cvt_pk_bf16(s[2 * 65], s[3 * 65]); o.z = cvt_pk_bf16(s[4 * 65], s[5 * 65]); o.w = cvt_pk_bf16(s[6 * 65], s[7 * 65]);
            *(u32x4*)(WT + (size_t)(n0 + n) * K + k0 + 8 * c) = o; } }
    LDS_WAIT(); asm volatile("" ::: "memory");
}
struct TrItem { const float* W; const float* rowscale; unsigned char* WT; int N, src, k0, n0, f8; };
__device__ __forceinline__ TrItem tr_decode(Frame& F, int it) {
    constexpr int I_WIN = 16 * (NPROJ / 64), I_SQ = 16 * 16, I_W1E = 16 * 32, I_W2E = 16 * 16;
    TrItem d; d.rowscale = nullptr; int r = it, kb, nb; const int q4 = 4 * (F.lane & 15);
    if (r < (PROJ_FP8 ? 2 : 1) * I_WIN) { const int f8 = r >= I_WIN; if (f8) r -= I_WIN; kb = r / (NPROJ / 64); nb = r % (NPROJ / 64);
        d.W = F.a->in[4]; d.N = 6872; d.src = MapWin()(64 * nb + q4); d.WT = F.ws + (f8 ? WS_WIN8 : WS_WIN); d.f8 = f8; }
    else { r -= (PROJ_FP8 ? 2 : 1) * I_WIN;
        if (r < 3 * I_SQ) { const int w = r / I_SQ; r -= w * I_SQ; kb = r / 16; nb = r % 16; d.N = 1024; d.src = 64 * nb + q4;
            if (w == 0) { d.W = F.a->in[15]; d.WT = F.ws + (PA_FP8 ? WS_WPA8 : WS_WPA); d.f8 = PA_FP8; }
            else if (w == 1) { d.W = F.a->in[16]; d.WT = F.ws + (PB_FP8 ? WS_WPB8 : WS_WPB); d.f8 = PB_FP8; d.rowscale = F.a->in[14]; }
            else { d.W = F.a->in[17]; d.WT = F.ws + WS_WOUT; d.f8 = 0; } }
        else { r -= 3 * I_SQ;
            if (r < 32 * I_W1E) { const int e = r / I_W1E, q = r % I_W1E; kb = q / 32; nb = q % 32; d.W = F.a->in[22] + (size_t)e * 1024 * 2048; d.N = 2048; d.src = MapW1()(64 * nb + q4);
                d.WT = F.ws + WS_W1 + (size_t)e * 2048 * MOE_RB; d.f8 = MOE_FP8; }
            else { r -= 32 * I_W1E; const int e = r / I_W2E, q = r % I_W2E; kb = q / 16; nb = q % 16; d.W = F.a->in[24] + (size_t)e * 1024 * 1024; d.N = 1024; d.src = 64 * nb + q4;
                d.WT = F.ws + WS_W2 + (size_t)e * 1024 * MOE_RB; d.f8 = MOE_FP8; } } }
    d.k0 = 64 * kb; d.n0 = 64 * nb; return d; }
__device__ __forceinline__ void tr_load(const TrItem& d, f32x4 (&ld)[16], int lane) {
    const int kr = lane >> 4; const float* p = d.W + (size_t)(d.k0 + kr) * d.N + (d.src >= 0 ? d.src : 0);
#pragma unroll
    for (int i = 0; i < 16; ++i) ld[i] = __builtin_nontemporal_load((const f32x4*)(p + (size_t)(4 * i) * d.N)); }
__device__ __forceinline__ void tr_finish(const TrItem& d, f32x4 (&ld)[16], LAS float* scr, int lane) {
    const int q = lane & 15, kr = lane >> 4; const bool zero = d.src < 0;
#pragma unroll
    for (int i = 0; i < 16; ++i) { const int kk = 4 * i + kr; f32x4 v = ld[i]; if (zero) v = (f32x4){0.f, 0.f, 0.f, 0.f}; if (d.rowscale) v = v * d.rowscale[d.k0 + kk];
        LAS float* o = scr + kk * 65 + 4 * q; o[0] = v[0]; o[1] = v[1]; o[2] = v[2]; o[3] = v[3]; }
    LDS_WAIT(); asm volatile("" ::: "memory");
    const int c = lane & 7;
    if (d.f8) {
#pragma unroll
        for (int j = 0; j < 8; ++j) { const int n = (lane >> 3) + 8 * j; const LAS float* s = scr + (8 * c) * 65 + n;
            const f32x4 a = {s[0 * 65] * MOE_WSC, s[1 * 65] * MOE_WSC, s[2 * 65] * MOE_WSC, s[3 * 65] * MOE_WSC}, b = {s[4 * 65] * MOE_WSC, s[5 * 65] * MOE_WSC, s[6 * 65] * MOE_WSC, s[7 * 65] * MOE_WSC};
            *(u32x2*)((unsigned char*)d.WT + (size_t)(d.n0 + n) * 1024 + d.k0 + 8 * c) = pack8_fp8(a, b); } }
    else {
#pragma unroll
        for (int j = 0; j < 8; ++j) { const int n = (lane >> 3) + 8 * j; const LAS float* s = scr + (8 * c) * 65 + n;
            u32x4 o; o.x = cvt_pk_bf16(s[0 * 65], s[1 * 65]); o.y = cvt_pk_bf16(s[2 * 65], s[3 * 65]); o.z = cvt_pk_bf16(s[4 * 65], s[5 * 65]); o.w = cvt_pk_bf16(s[6 * 65], s[7 * 65]);
            *(u32x4*)((bf16_t*)d.WT + (size_t)(d.n0 + n) * 1024 + d.k0 + 8 * c) = o; } }
    LDS_WAIT(); asm volatile("" ::: "memory");
}
__device__ __forceinline__ void ph_prologue(Frame& F) {
    const float* c_in = F.a->in[1]; const float* w_mod = F.a->in[2]; const float* b_mod = F.a->in[3];
    float* MOD = (float*)(F.ws + WS_MOD);
    for (int item = F.bid; item < 192; item += F.G) {
        LAS float* SC = (LAS float*)F.lds;
        __syncthreads();
        for (int i = F.tid; i < 32768; i += NTHR) { const int b = i >> 10, k = i & 1023; SC[k * 36 + b] = silu_f(c_in[i]); }
        __syncthreads();
        const int col = item * 32 + (F.tid >> 4), kq = F.tid & 15;
        float a[32];
#pragma unroll
        for (int b = 0; b < 32; ++b) a[b] = 0.f;
#pragma nounroll
        for (int kg = 0; kg < 64; kg += 16) {
            float wv[16];
#pragma unroll
            for (int u = 0; u < 16; ++u) wv[u] = w_mod[(size_t)((kg + u) * 16 + kq) * 6144 + col];
#pragma unroll
            for (int u = 0; u < 16; ++u) { const int k = (kg + u) * 16 + kq; const float w = wv[u];
#pragma unroll
                for (int b4 = 0; b4 < 8; ++b4) { const f32x4 s = *(const LAS f32x4*)(SC + k * 36 + b4 * 4); a[b4 * 4 + 0] += w * s[0]; a[b4 * 4 + 1] += w * s[1]; a[b4 * 4 + 2] += w * s[2]; a[b4 * 4 + 3] += w * s[3]; } } }
#pragma unroll
        for (int b = 0; b < 32; ++b) { a[b] += __shfl_xor(a[b], 1); a[b] += __shfl_xor(a[b], 2); a[b] += __shfl_xor(a[b], 4); a[b] += __shfl_xor(a[b], 8); }
        { const float bm = b_mod[col];
#pragma unroll
            for (int b = 1; b < 16; ++b) { a[0] = (kq == b) ? a[b] : a[0]; a[16] = (kq == b) ? a[16 + b] : a[16]; }
            MOD[(size_t)kq * 6144 + col] = a[0] + bm; MOD[(size_t)(kq + 16) * 6144 + col] = a[16] + bm; }
        __syncthreads();
    }
    if (F.bid == (F.G > 192 ? 192 : 0)) {
        float* BT = (float*)(F.ws + WS_BIAST); const float* rel_bias = F.a->in[8];
        for (int i = F.tid; i < 249 * 8; i += NTHR) { const int idx = i >> 3, h = i & 7, rel = idx - 185; const int n = rel < 0 ? -rel : rel;
            const float nf = (float)(n > 1 ? n : 1); int large = 8 + (int)(logf(nf / 8.0f) / 2.7725887f * 8.0f); if (large > 15) large = 15;
            const int bucket = (rel > 0 ? 16 : 0) + (n < 8 ? n : large);
            BT[i] = rel_bias[bucket * 8 + h] * LOG2E; }
    }
    LAS float* scr = (LAS float*)(F.lds + F.wave * 16640);
    __syncthreads();
    const int gw = F.bid * NWAVES + F.wave, NGW = F.G * NWAVES;
    constexpr int I_WIN = 16 * (NPROJ / 64), I_SQ = 16 * 16, I_W1E = 16 * 32, I_W2E = 16 * 16;
    constexpr int NITEMS = (PROJ_FP8 ? 2 : 1) * I_WIN + 3 * I_SQ + 32 * I_W1E + 32 * I_W2E;
    TrItem d0, d1; f32x4 la[16], lb[16];
    int it = gw;
    if (it < NITEMS) { d0 = tr_decode(F, it); tr_load(d0, la, F.lane); }
    while (it < NITEMS) {
        const int i1 = it + NGW; const bool v1 = i1 < NITEMS;
        if (v1) { d1 = tr_decode(F, i1); tr_load(d1, lb, F.lane); }
        tr_finish(d0, la, scr, F.lane);
        if (!v1) break;
        const int i2 = i1 + NGW; const bool v2 = i2 < NITEMS;
        if (v2) { d0 = tr_decode(F, i2); tr_load(d0, la, F.lane); }
        tr_finish(d1, lb, scr, F.lane);
        it = i2;
    }
}

__device__ __forceinline__ void ln1_load(const float* x, int m0, int lane, f32x4 (&v)[4][4]) {
#pragma unroll
    for (int r = 0; r < 4; ++r) { const f32x4* xr = (const f32x4*)(x + (size_t)(m0 + r) * D) + lane;
#pragma unroll
        for (int j = 0; j < 4; ++j) v[r][j] = __builtin_nontemporal_load(xr + 64 * j); } }
__device__ __forceinline__ void ln1_proc(Frame& F, bf16_t* U, int m0, f32x4 (&v)[4][4], const f32x4 (&sh)[4], const f32x4 (&sc)[4]) {
#pragma unroll
    for (int r = 0; r < 4; ++r) { const int m = m0 + r;
        float s = 0.f;
#pragma unroll
        for (int j = 0; j < 4; ++j) s += (v[r][j][0] + v[r][j][1]) + (v[r][j][2] + v[r][j][3]);
        const float mean = wave_sum(s) * (1.f / D); float s2 = 0.f;
#pragma unroll
        for (int j = 0; j < 4; ++j) { v[r][j] = v[r][j] - mean; s2 += (v[r][j][0] * v[r][j][0] + v[r][j][1] * v[r][j][1]) + (v[r][j][2] * v[r][j][2] + v[r][j][3] * v[r][j][3]); }
        const float rstd = 1.f / sqrtf(wave_sum(s2) * (1.f / D) + LN_EPS);
        u32x2* o8 = (u32x2*)(U + (size_t)m * D) + F.lane;
#pragma unroll
        for (int j = 0; j < 4; ++j) {
            const f32x4 rr = v[r][j] * rstd * (sc[j] + 1.0f) + sh[j]; u32x2 w; w.x = cvt_pk_bf16(rr[0], rr[1]); w.y = cvt_pk_bf16(rr[2], rr[3]); o8[64 * j] = w;
            if (PROJ_FP8) { int pk = 0; pk = __builtin_amdgcn_cvt_pk_fp8_f32(rr[0], rr[1], pk, false); pk = __builtin_amdgcn_cvt_pk_fp8_f32(rr[2], rr[3], pk, true); ((unsigned*)(F.ws + WS_U8 + (size_t)m * D))[F.lane + 64 * j] = (unsigned)pk; } } } }
__device__ __forceinline__ void ph_ln1(Frame& F) {
    const float* x = F.a->in[0]; const float* MOD = (const float*)(F.ws + WS_MOD); bf16_t* U = (bf16_t*)(F.outb + OUT_U);
    const int gw = F.bid * NWAVES + F.wave, NGW = F.G * NWAVES;
    const int RPW = (((NTOK + NGW - 1) / NGW) + 3) & ~3;
    const int mbeg = gw * RPW, mend = (mbeg + RPW < NTOK) ? mbeg + RPW : NTOK;
    if (mbeg >= mend) return;
    f32x4 va[4][4], vb[4][4], sh[4], sc[4]; int curb = -1;
#define LN1_MOD(m0) do { const int bb = (m0) >> 11; if (bb != curb) { curb = bb; const float* md = MOD + (size_t)bb * 6144; \
        _Pragma("unroll") for (int j = 0; j < 4; ++j) { sh[j] = *((const f32x4*)md + F.lane + 64 * j); sc[j] = *((const f32x4*)(md + 1024) + F.lane + 64 * j); } } } while (0)
    int m0 = mbeg;
    ln1_load(x, m0, F.lane, va);
    for (;;) {
        const int m1 = m0 + 4; const bool v1 = m1 < mend;
        LN1_MOD(m0); if (v1) ln1_load(x, m1, F.lane, vb);
        ln1_proc(F, U, m0, va, sh, sc);
        if (!v1) break;
        const int m2 = m1 + 4; const bool v2 = m2 < mend;
        LN1_MOD(m1); if (v2) ln1_load(x, m2, F.lane, va);
        ln1_proc(F, U, m1, vb, sh, sc);
        if (!v2) break;
        m0 = m2;
    }
#undef LN1_MOD
}

__device__ __forceinline__ void misc_load(const float* MISC, int m0, int l, f32x4 (&v)[8]) {
#pragma unroll
    for (int r = 0; r < 8; ++r) v[r] = __builtin_nontemporal_load((const f32x4*)(MISC + (size_t)(m0 + r) * 256) + l); }
__device__ __forceinline__ void misc_proc(Frame& F, int m0, const f32x4 (&vv)[8], const f32x4& w1, const f32x4& w2) {
    bf16_t* KV = (bf16_t*)(F.outb + OUT_KV); bf16_t* IK = (bf16_t*)(F.outb + OUT_IK); float* IW = (float*)(F.outb + OUT_IW); float* DT = (float*)(F.outb + OUT_DT);
    const int l = F.lane;
#pragma unroll
    for (int r = 0; r < 8; ++r) { const int m = m0 + r;
        const f32x4 v = vv[r];
        const float sq = v[0] * v[0] + v[1] * v[1] + v[2] * v[2] + v[3] * v[3], sm = (v[0] + v[1]) + (v[2] + v[3]);
        const float kvss = wave_sum(l < 32 ? sq : 0.f);
        const float iks = wave_sum((l >= 32 && l < 48) ? sm : 0.f);
        const float ikmean = iks * (1.f / 64.f);
        const f32x4 dv = v - ikmean;
        const float ikq = wave_sum((l >= 32 && l < 48) ? (dv[0] * dv[0] + dv[1] * dv[1] + dv[2] * dv[2] + dv[3] * dv[3]) : 0.f);
        if (l < 32) { const float rr = 1.f / sqrtf(kvss * (1.f / 128.f) + LN_EPS); const f32x4 o = v * rr * w1;
            u32x2 pk; pk.x = cvt_pk_bf16(o[0], o[1]); pk.y = cvt_pk_bf16(o[2], o[3]); *((u32x2*)(KV + (size_t)m * 128) + l) = pk; }
        else if (l < 48) { const float rr = 1.f / sqrtf(ikq * (1.f / 64.f) + LN_EPS); const f32x4 o = dv * rr * w1 + w2;
            u32x2 pk; pk.x = cvt_pk_bf16(o[0], o[1]); pk.y = cvt_pk_bf16(o[2], o[3]); *((u32x2*)(IK + (size_t)m * 64) + (l - 32)) = pk; }
        else if (l < 50) { *((f32x4*)(IW + (size_t)m * 8) + (l - 48)) = v * 0.35355339059327373f; }
        else if (l < 54) { f32x4 o;
#pragma unroll
            for (int j = 0; j < 4; ++j) { const float t = v[j] + w1[j]; o[j] = t > 20.f ? t : log1pf(__expf(t)); }
            *((f32x4*)(DT + (size_t)m * 16) + (l - 50)) = o; }
    } }
__device__ __forceinline__ void ph_misc(Frame& F) {
    const float* MISC = (const float*)(F.outb + OUT_MISC);
    const float* kvw = F.a->in[5]; const float* ikw = F.a->in[6]; const float* ikb = F.a->in[7]; const float* dtb = F.a->in[11];
    const int gw = F.bid * NWAVES + F.wave, NGW = F.G * NWAVES, l = F.lane;
    const int RPW = (((NTOK + NGW - 1) / NGW) + 7) & ~7;
    const int mbeg = gw * RPW, mend = (mbeg + RPW < NTOK) ? mbeg + RPW : NTOK;
    if (mbeg >= mend) return;
    f32x4 w1 = (f32x4){0.f, 0.f, 0.f, 0.f}, w2 = w1;
    if (l < 32) w1 = *((const f32x4*)kvw + l); else if (l < 48) { w1 = *((const f32x4*)ikw + (l - 32)); w2 = *((const f32x4*)ikb + (l - 32)); } else if (l >= 50 && l < 54) w1 = *((const f32x4*)dtb + (l - 50));
    f32x4 va[8], vb[8];
    int m0 = mbeg;
    misc_load(MISC, m0, l, va);
    for (;;) {
        const int m1 = m0 + 8; const bool v1 = m1 < mend;
        if (v1) misc_load(MISC, m1, l, vb);
        misc_proc(F, m0, va, w1, w2);
        if (!v1) break;
        const int m2 = m1 + 8; const bool v2 = m2 < mend;
        if (v2) misc_load(MISC, m2, l, va);
        misc_proc(F, m1, vb, w1, w2);
        if (!v2) break;
        m0 = m2;
    }
}

__device__ __forceinline__ unsigned sortable_key(float s) { const unsigned u = __float_as_uint(s + 0.0f); return (u & 0x80000000u) ? ~u : (u | 0x80000000u); }
template <int NKB> struct KeyRow { unsigned k[NKB]; };
__device__ __forceinline__ u64 low_bits_keep(u64 m, int t) { u64 out = 0; while (t-- > 0 && m) { const u64 b = m & (0 - m); out |= b; m ^= b; } return out; }
namespace idx { constexpr int KST = 144, KBUF = 64 * KST; }
__device__ __forceinline__ unsigned low_bits_keep32(unsigned m, int t) { unsigned out = 0; while (t-- > 0 && m) { const unsigned b = m & (0u - m); out |= b; m ^= b; } return out; }
template <int NG> __device__ __forceinline__ void topk2_select_write(const unsigned (&key)[64], int nkb, u64* mrow, int lane) {
    constexpr int NR = NG * 16;
    unsigned T0 = 0u, T1 = 0u; bool ex0 = false, ex1 = false;
    unsigned lo0 = 0u, lo1 = 0u, hi0 = 0xFFFFFFFFu, hi1 = 0xFFFFFFFFu, st0, st1, p0, p1; bool fin0 = false, fin1 = false;
    { float sm = 0.f, sq = 0.f;
#pragma unroll
        for (int m = 0; m < 10; ++m) { const unsigned k = key[m]; const float f = __uint_as_float((k & 0x80000000u) ? (k ^ 0x80000000u) : ~k); sm += f; sq += f * f; }
        sm = dpp_half_sums_f32(sm); sq = dpp_half_sums_f32(sq);
        const float mu = sm * (1.f / 320.f), sd = sqrtf(fmaxf(sq * (1.f / 320.f) - mu * mu, 1e-20f));
        const float qq = 256.f / (64.f * (float)nkb), pp = qq < 0.5f ? qq : 1.f - qq, tt = sqrtf(-2.f * __logf(pp));
        float z = tt - (2.515517f + 0.802853f * tt + 0.010328f * tt * tt) / (1.f + 1.432788f * tt + 0.189269f * tt * tt + 0.001308f * tt * tt * tt); if (qq >= 0.5f) z = -z;
        const unsigned pe = sortable_key(mu + z * sd), pd = sortable_key(mu + z * sd + 0.125f * sd);
        unsigned stp = pd - pe; if (stp < 1024u) stp = 1024u;
        p0 = __builtin_amdgcn_readlane((int)pe, 31); p1 = __builtin_amdgcn_readlane((int)pe, 63); st0 = __builtin_amdgcn_readlane((int)stp, 31); st1 = __builtin_amdgcn_readlane((int)stp, 63); }
#pragma nounroll
    for (int it = 0; it < 80; ++it) {
        const unsigned candv = lane < 32 ? p0 : p1;
        unsigned cl = 0u;
#pragma unroll
        for (int m = 0; m < NR; m += 4) { u64 s0, s1, s2, s3;
            asm("v_cmp_ge_u32_e64 %1, %5, %9\n\tv_cmp_ge_u32_e64 %2, %6, %9\n\tv_cmp_ge_u32_e64 %3, %7, %9\n\tv_cmp_ge_u32_e64 %4, %8, %9\n\t"
                "v_addc_co_u32_e64 %0, %1, 0, %0, %1\n\tv_addc_co_u32_e64 %0, %2, 0, %0, %2\n\tv_addc_co_u32_e64 %0, %3, 0, %0, %3\n\tv_addc_co_u32_e64 %0, %4, 0, %0, %4"
                : "+v"(cl), "=&s"(s0), "=&s"(s1), "=&s"(s2), "=&s"(s3) : "v"(key[m]), "v"(key[m + 1]), "v"(key[m + 2]), "v"(key[m + 3]), "v"(candv)); }
        cl = dpp_half_sums_u32(cl);
        const int n0 = __builtin_amdgcn_readlane((int)cl, 31), n1 = __builtin_amdgcn_readlane((int)cl, 63);
#define IDX_STEP(lo, hi, st, p, T, ex, fin, n) do { if (!fin) { \
            if (n == 256) { T = p; ex = true; fin = true; } \
            else { if (n > 256) lo = p; else hi = p; \
                if (hi - lo <= 1u) { T = lo; fin = true; } \
                else { unsigned c; if (hi == 0xFFFFFFFFu) { c = lo + st; if (c < lo) c = hi; st = st << 1; } else if (lo == 0u) { c = hi - st; if (c > hi) c = lo; st = st << 1; } else c = lo + ((hi - lo) >> 1); \
                    if (c <= lo || c >= hi) c = lo + ((hi - lo) >> 1); p = c; } } } } while (0)
        IDX_STEP(lo0, hi0, st0, p0, T0, ex0, fin0, n0);
        IDX_STEP(lo1, hi1, st1, p1, T1, ex1, fin1, n1);
#undef IDX_STEP
        if (fin0 && fin1) break;
    }
    const unsigned Tv = lane < 32 ? T0 : T1;
    if (ex0 && ex1) {
        unsigned mlo = 0u, mhi = 0u;
#pragma unroll
        for (int j = 0; j < NR / 2; ++j) {
            const u64 b0 = __ballot(key[2 * j] >= Tv), b1 = __ballot(key[2 * j + 1] >= Tv);
            asm volatile("s_nop 1\n\tv_writelane_b32 %0, %2, %6\n\tv_writelane_b32 %0, %3, %7\n\tv_writelane_b32 %1, %4, %6\n\tv_writelane_b32 %1, %5, %7"
                         : "+v"(mlo), "+v"(mhi) : "s"((unsigned)b0), "s"((unsigned)(b0 >> 32)), "s"((unsigned)b1), "s"((unsigned)(b1 >> 32)), "n"(j), "n"(32 + j));
            if ((j & 3) == 3) SBAR();
        }
        const int jl = lane & 31;
        if (jl < nkb) mrow[(lane >> 5) * 32 + jl] = (u64)mlo | ((u64)mhi << 32);
        return;
    }
    int rem0 = 1 << 30, rem1 = 1 << 30;
    { int g0 = 0, g1 = 0;
#pragma unroll
        for (int m = 0; m < NR; ++m) { const u64 mk = __ballot(key[m] > Tv); g0 += __builtin_popcount((unsigned)mk); g1 += __builtin_popcount((unsigned)(mk >> 32)); if ((m & 7) == 7) SBAR(); }
        if (!ex0) rem0 = 256 - g0; if (!ex1) rem1 = 256 - g1; }
    u64 mine = 0ull;
#pragma nounroll
    for (int jq = 0; jq < NR / 8; ++jq) {
#pragma unroll
        for (int jj = 0; jj < 4; ++jj) { const int j = jq * 4 + jj;
            unsigned w0[2], w1[2];
#pragma unroll
            for (int hh = 0; hh < 2; ++hh) { unsigned kv = 0u;
#pragma unroll
                for (int m = 0; m < NR; ++m) if ((m >> 3) == 0) {}
#pragma unroll
                for (int m = 0; m < NR; ++m) kv = (m == 2 * j + hh) ? key[m] : kv;
                const u64 gt = __ballot(kv > Tv), eq = __ballot(kv == Tv);
                { const unsigned e = (unsigned)eq, g = (unsigned)gt; const int ne = __builtin_popcount(e); unsigned sel = g; if (rem0 >= ne) { sel |= e; rem0 -= ne; } else if (rem0 > 0) { sel |= low_bits_keep32(e, rem0); rem0 = 0; } w0[hh] = sel; }
                { const unsigned e = (unsigned)(eq >> 32), g = (unsigned)(gt >> 32); const int ne = __builtin_popcount(e); unsigned sel = g; if (rem1 >= ne) { sel |= e; rem1 -= ne; } else if (rem1 > 0) { sel |= low_bits_keep32(e, rem1); rem1 = 0; } w1[hh] = sel; } }
            const u64 q0w = (u64)w0[0] | ((u64)w0[1] << 32), q1w = (u64)w1[0] | ((u64)w1[1] << 32);
            if (lane == j) mine = q0w; if (lane == 32 + j) mine = q1w; }
    }
    const int jl = lane & 31;
    if (jl < nkb) mrow[(lane >> 5) * 32 + jl] = mine;
}
template <int J0> __device__ __forceinline__ void index_scores8(unsigned (&key)[64], const bf16x8 (&af)[2], const f32x4& iw4, const bf16_t* kvsrc, char* lds, int nkb, u32x4 (&stg)[8], int tid) {
    const int lane = tid & 63, sub = lane & 15, kg = lane >> 4;
#pragma unroll
    for (int jj = 0; jj < 8; ++jj) {
        const int j = J0 + jj;
        if (j < nkb) {
            if (j + 1 < nkb) *(u32x4*)(lds + ((j + 1) & 1) * idx::KBUF + (tid >> 3) * idx::KST + (tid & 7) * 16) = stg[(jj + 1) & 7];
            if (j + 8 < nkb) stg[jj] = *(const u32x4*)(kvsrc + (size_t)(j + 8) * 64 * 64);
            const char* kb = lds + (j & 1) * idx::KBUF + sub * idx::KST + kg * 16;
#pragma unroll
            for (int pr = 0; pr < 2; ++pr) {
                f32x4 dA = (f32x4){0.f, 0.f, 0.f, 0.f}, dB = dA;
#pragma unroll
                for (int ks = 0; ks < 2; ++ks) {
                    const bf16x8 fA = *(const bf16x8*)(kb + (pr * 32) * idx::KST + ks * 64), fB = *(const bf16x8*)(kb + (pr * 32 + 16) * idx::KST + ks * 64);
                    dA = __builtin_amdgcn_mfma_f32_16x16x32_bf16(af[ks], fA, dA, 0, 0, 0); dB = __builtin_amdgcn_mfma_f32_16x16x32_bf16(af[ks], fB, dB, 0, 0, 0); }
                float pA = 0.f, pB = 0.f;
#pragma unroll
                for (int r = 0; r < 4; ++r) { pA += fmaxf(dA[r], 0.f) * iw4[r]; pB += fmaxf(dB[r], 0.f) * iw4[r]; }
                auto rr = __builtin_amdgcn_permlane16_swap(__float_as_uint(pA), __float_as_uint(pB), false, false);
                key[2 * j + pr] = sortable_key(__uint_as_float(rr[0]) + __uint_as_float(rr[1]));
            }
            __syncthreads();
        }
    }
}
__device__ __forceinline__ void ph_index(Frame& F, const int abl = 0) {
    const bf16_t* IQ = (const bf16_t*)(F.outb + OUT_IQ); const bf16_t* IK = (const bf16_t*)(F.outb + OUT_IK); const float* IW = (const float*)(F.outb + OUT_IW);
    u64* MASK = (u64*)(F.outb + OUT_MASK);
    char* lds = (char*)(unsigned char*)F.lds;
    const int tid = F.tid, lane = F.lane, sub = lane & 15, kg = lane >> 4;
    for (int item = F.bid; item < NTOK / 16; item += F.G) {
        const int tokw = (((item & 255) >> 3) << 11) + (((item & 7) + 8 * (item >> 8)) << 4) + F.wave * 2, b = tokw >> 11, pos0 = tokw & 2047, nkb = (pos0 >> 6) + 1;
        u64* mrow = MASK + (size_t)tokw * 32;
        if (nkb <= 4) { if ((lane & 31) < nkb) mrow[(lane >> 5) * 32 + (lane & 31)] = ~0ull; continue; }
        bf16x8 af[2];
        { const bf16_t* ap = IQ + (size_t)(tokw + (sub >> 3)) * 512 + (sub & 7) * 64 + kg * 8;
#pragma unroll
          for (int ks = 0; ks < 2; ++ks) af[ks] = *(const bf16x8*)(ap + ks * 32); }
        const f32x4 iw4 = *(const f32x4*)(IW + (size_t)(tokw + (lane >> 5)) * 8 + 4 * (kg & 1));
        unsigned key[64];
#pragma unroll
        for (int m = 0; m < 64; ++m) key[m] = 0u;
        const bf16_t* kvsrc = IK + ((size_t)b * SEQ + (tid >> 3)) * 64 + (tid & 7) * 8;
        u32x4 stg[8];
#pragma unroll
        for (int i = 0; i < 8; ++i) stg[i] = (i < nkb) ? *(const u32x4*)(kvsrc + (size_t)i * 64 * 64) : (u32x4){0u, 0u, 0u, 0u};
        __syncthreads();
        *(u32x4*)(lds + (tid >> 3) * idx::KST + (tid & 7) * 16) = stg[0];
        __syncthreads();
        const int ng = (nkb + 7) >> 3;
        if (!(abl & 1)) {
        index_scores8<0>(key, af, iw4, kvsrc, lds, nkb, stg, tid);
        if (ng > 1) index_scores8<8>(key, af, iw4, kvsrc, lds, nkb, stg, tid);
        if (ng > 2) index_scores8<16>(key, af, iw4, kvsrc, lds, nkb, stg, tid);
        if (ng > 3) index_scores8<24>(key, af, iw4, kvsrc, lds, nkb, stg, tid);
        }
        if (abl & 2) { if (key[0] == 0x12345u && key[63] == 7u) mrow[lane] = 1ull; continue; }
        if (ng == 1) topk2_select_write<1>(key, nkb, mrow, lane);
        else if (ng == 2) topk2_select_write<2>(key, nkb, mrow, lane);
        else if (ng == 3) topk2_select_write<3>(key, nkb, mrow, lane);
        else topk2_select_write<4>(key, nkb, mrow, lane);
    }
}

namespace att {
constexpr int KVBLK = 64;
constexpr int SHM_V = KVBLK * 128 * 2, SHM_K = SHM_V;
constexpr int OFF_V = 0, OFF_K = 2 * SHM_V, OFF_WS = 2 * SHM_V + 2 * SHM_K, OFF_BT = OFF_WS + NWAVES * 64 * 4;
constexpr int OFF_OT = 81920, OT_ST = 144;
#define KSWZ(row, colB) ((row) * 256 + ((colB) ^ (((row) & 7) << 4)))
__device__ __forceinline__ int crow(int r, int hi) { return (r & 3) + 8 * (r >> 2) + 4 * hi; }
__device__ __forceinline__ int v_st(int k, int c) { const int kk = (k & ~0xC) | ((k & 4) << 1) | ((k & 8) >> 1); return ((kk >> 3) * 4 + (c >> 5)) * 512 + ((kk & 7) * 32 + (c & 31)) * 2; }
__device__ __forceinline__ int v_rd_base(int lane) { return ((lane & 3) << 3) | (((lane >> 2) & 3) << 6) | (((lane >> 4) & 1) << 5) | (((lane >> 5) & 1) << 8); }
constexpr int v_rd_off(int d0, int ks, int half) { return d0 * 512 + ks * 4096 + half * 2048; }
template <int OFF> __device__ __forceinline__ s16x4 tr_read(int vb) { s16x4 r; asm volatile("ds_read_b64_tr_b16 %0, %1 offset:%2" : "=&v"(r) : "v"(vb), "i"(OFF) : "memory"); return r; }
template <int D0> __device__ __forceinline__ void pv_one(f32x16& od, int vb, bf16x8 pa0, bf16x8 pa1, bf16x8 pa2, bf16x8 pa3) {
    const s16x4 l0 = tr_read<v_rd_off(D0, 0, 0)>(vb), h0 = tr_read<v_rd_off(D0, 0, 1)>(vb), l1 = tr_read<v_rd_off(D0, 1, 0)>(vb), h1 = tr_read<v_rd_off(D0, 1, 1)>(vb);
    const s16x4 l2 = tr_read<v_rd_off(D0, 2, 0)>(vb), h2 = tr_read<v_rd_off(D0, 2, 1)>(vb), l3 = tr_read<v_rd_off(D0, 3, 0)>(vb), h3 = tr_read<v_rd_off(D0, 3, 1)>(vb);
    asm volatile("s_waitcnt lgkmcnt(0)" ::: "memory"); SBAR();
#define PK(L, H) (bf16x8){L[0], L[1], L[2], L[3], H[0], H[1], H[2], H[3]}
    od = __builtin_amdgcn_mfma_f32_32x32x16_bf16(pa0, PK(l0, h0), od, 0, 0, 0);
    od = __builtin_amdgcn_mfma_f32_32x32x16_bf16(pa1, PK(l1, h1), od, 0, 0, 0);
    od = __builtin_amdgcn_mfma_f32_32x32x16_bf16(pa2, PK(l2, h2), od, 0, 0, 0);
    od = __builtin_amdgcn_mfma_f32_32x32x16_bf16(pa3, PK(l3, h3), od, 0, 0, 0);
#undef PK
}
__device__ __forceinline__ void qkt(f32x16& p0, f32x16& p1, const char* Ks, const bf16x8* qr, int r32, int hi) {
    p0 = f32x16{}; p1 = f32x16{};
    int rv = r32; asm volatile("" : "+v"(rv));
    const char* kb = Ks + rv * 256; const int swz = ((rv & 7) << 4) ^ (hi * 16);
#pragma unroll
    for (int d0 = 0; d0 < 8; ++d0) { const char* ka = kb + ((d0 * 32) ^ swz);
        const bf16x8 b0 = *reinterpret_cast<const bf16x8*>(ka);
        const bf16x8 b1 = *reinterpret_cast<const bf16x8*>(ka + 8192);
        p0 = __builtin_amdgcn_mfma_f32_32x32x16_bf16(b0, qr[d0], p0, 0, 0, 0);
        p1 = __builtin_amdgcn_mfma_f32_32x32x16_bf16(b1, qr[d0], p1, 0, 0, 0); }
}
__device__ __forceinline__ void attn_item(Frame& F, int b, int q0, char* lds) {
    const bf16_t* Q = (const bf16_t*)(F.ws + WS_Q); const bf16_t* KV = (const bf16_t*)(F.outb + OUT_KV); const u64* MASK = (const u64*)(F.outb + OUT_MASK);
    bf16_t* OA = (bf16_t*)(F.outb + OUT_OA);
    int tid = F.tid; asm volatile("" : "+v"(tid));
    const int wid = F.wave, lane = tid & 63, r32 = lane & 31, hi = lane >> 5;
    char* V_lds = lds + OFF_V; char* K_lds = lds + OFF_K;
    float* wsl = (float*)(lds + OFF_WS) + wid * 64; float* li_l = wsl; float* al_l = wsl + 32;
    const float* btab = (const float*)(lds + OFF_BT);
    constexpr float C = 0.088388347648318440f * LOG2E;
    float m_reg = -1e30f, l_reg = 0.f; f32x16 o[4] = {}; bf16x8 qr[8];
    const size_t tokq = (size_t)b * SEQ + q0 + r32;
    { const bf16_t* Qw = Q + tokq * 1024 + wid * 128 + hi * 8;
#pragma unroll
      for (int d0 = 0; d0 < 8; ++d0) qr[d0] = *(const bf16x8*)(Qw + d0 * 16); }
    const u64* mq = MASK + tokq * 32;
    const int sr = tid >> 4, sc = (tid & 15) * 8;
    const int vb0 = (int)(uintptr_t)V_lds + v_rd_base(lane);
    const bf16_t* Kb = KV + (size_t)b * SEQ * 128;
    const int NT = (q0 >> 6) + 1;
    const float bfar = btab[wid];
    bf16x8 s0, s1;
#define SLOAD(k0) do { s0 = *(const bf16x8*)(Kb + (size_t)((k0) + sr) * 128 + sc); s1 = *(const bf16x8*)(Kb + (size_t)((k0) + 32 + sr) * 128 + sc); } while (0)
#define SWRITE(bf) do { int srv = sr; asm volatile("" : "+v"(srv)); const int kc = sc * 2; const int v0a = v_st(srv, sc), k0a = KSWZ(srv, kc); \
        *(bf16x8*)(V_lds + (bf) * SHM_V + v0a) = s0; *(bf16x8*)(V_lds + (bf) * SHM_V + v0a + 8192) = s1; \
        *(bf16x8*)(K_lds + (bf) * SHM_K + k0a) = s0; *(bf16x8*)(K_lds + (bf) * SHM_K + k0a + 8192) = s1; } while (0)
    __syncthreads();
    SLOAD(0); VM_WAIT(); SWRITE(0); __syncthreads();
    u64 mw_next = mq[0];
    for (int j = 0; j < NT; ++j) {
        int lanel = lane; asm volatile("" : "+v"(lanel)); const int r32l = lanel & 31, hil = lanel >> 5;
        const int bf = j & 1;
        if (j + 1 < NT) SLOAD((j + 1) * KVBLK);
        const u64 mw = mw_next; if (j + 1 < NT) mw_next = mq[j + 1];
        f32x16 p0, p1;
        qkt(p0, p1, K_lds + bf * SHM_K, qr, r32l, hil);
        const unsigned w0 = (unsigned)(mw >> (4 * hil)), w1 = (unsigned)(mw >> (32 + 4 * hil));
        const int relmax = j * KVBLK + 63 - q0;
        float alpha = 1.f, ps = 0.f;
        if (relmax <= -91) {
            float pmax = p0[0];
#pragma unroll
            for (int r = 1; r < 16; ++r) pmax = fmaxf(pmax, p0[r]);
#pragma unroll
            for (int r = 0; r < 16; ++r) pmax = fmaxf(pmax, p1[r]);
            { auto rr = __builtin_amdgcn_permlane32_swap(__float_as_uint(pmax), __float_as_uint(pmax), false, false); pmax = fmaxf(__uint_as_float(rr[0]), __uint_as_float(rr[1])); }
            pmax = fmaf(pmax, C, bfar);
            if (!__all(pmax - m_reg <= 11.0f)) { const float mn = fmaxf(m_reg, pmax); alpha = __builtin_amdgcn_exp2f(m_reg - mn); m_reg = mn; }
            const float off = bfar - m_reg;
#pragma unroll
            for (int r = 0; r < 16; ++r) { const int cb = (r & 3) + 8 * (r >> 2);
                const float e0 = __builtin_amdgcn_exp2f(fmaf(p0[r], C, off)), e1 = __builtin_amdgcn_exp2f(fmaf(p1[r], C, off));
                p0[r] = __uint_as_float(__float_as_uint(e0) & (unsigned)__builtin_amdgcn_sbfe((int)w0, cb, 1)); p1[r] = __uint_as_float(__float_as_uint(e1) & (unsigned)__builtin_amdgcn_sbfe((int)w1, cb, 1)); ps += p0[r] + p1[r]; }
        } else {
            const float* bp = btab + (j * KVBLK + 4 * hil - (q0 + r32l) + 185) * 8 + wid;
#pragma unroll
            for (int r4 = 0; r4 < 4; ++r4) {
#pragma unroll
                for (int rr = 0; rr < 4; ++rr) { const int r = r4 * 4 + rr; const int cb = (r & 3) + 8 * (r >> 2); p0[r] = fmaf(p0[r], C, bp[cb * 8]); p1[r] = fmaf(p1[r], C, bp[(cb + 32) * 8]); }
                SBAR(); }
            float pmax = p0[0];
#pragma unroll
            for (int r = 1; r < 16; ++r) pmax = fmaxf(pmax, p0[r]);
#pragma unroll
            for (int r = 0; r < 16; ++r) pmax = fmaxf(pmax, p1[r]);
            { auto rr = __builtin_amdgcn_permlane32_swap(__float_as_uint(pmax), __float_as_uint(pmax), false, false); pmax = fmaxf(__uint_as_float(rr[0]), __uint_as_float(rr[1])); }
            if (!__all(pmax - m_reg <= 11.0f)) { const float mn = fmaxf(m_reg, pmax); alpha = __builtin_amdgcn_exp2f(m_reg - mn); m_reg = mn; }
#pragma unroll
            for (int r = 0; r < 16; ++r) { const int cb = (r & 3) + 8 * (r >> 2);
                const float e0 = __builtin_amdgcn_exp2f(p0[r] - m_reg), e1 = __builtin_amdgcn_exp2f(p1[r] - m_reg);
                p0[r] = __uint_as_float(__float_as_uint(e0) & (unsigned)__builtin_amdgcn_sbfe((int)w0, cb, 1)); p1[r] = __uint_as_float(__float_as_uint(e1) & (unsigned)__builtin_amdgcn_sbfe((int)w1, cb, 1)); ps += p0[r] + p1[r]; }
        }
        { auto rr = __builtin_amdgcn_permlane32_swap(__float_as_uint(ps), __float_as_uint(ps), false, false); ps = __uint_as_float(rr[0]) + __uint_as_float(rr[1]); }
        l_reg = l_reg * alpha + ps;
        bf16x8 pa0, pa1, pa2, pa3;
#define PK4(P, BASE, OUT) do { unsigned a0 = cvt_pk_bf16(P[BASE + 0], P[BASE + 1]), a1 = cvt_pk_bf16(P[BASE + 2], P[BASE + 3]);   \
    unsigned b0 = cvt_pk_bf16(P[BASE + 4], P[BASE + 5]), b1 = cvt_pk_bf16(P[BASE + 6], P[BASE + 7]);                              \
    auto r0 = __builtin_amdgcn_permlane32_swap(a0, b0, false, false); auto r1 = __builtin_amdgcn_permlane32_swap(a1, b1, false, false); \
    u32x4 w = {r0[0], r1[0], r0[1], r1[1]}; OUT = *reinterpret_cast<bf16x8*>(&w); } while (0)
        PK4(p0, 0, pa0); PK4(p0, 8, pa1); PK4(p1, 0, pa2); PK4(p1, 8, pa3);
#undef PK4
        if (__any(alpha < 1.f)) { if (hil == 0) al_l[r32l] = alpha; LDS_WAIT();
#pragma unroll
            for (int d = 0; d < 4; ++d)
#pragma unroll
                for (int r = 0; r < 16; ++r) o[d][r] *= al_l[crow(r, hil)]; }
        const int vb = (int)(uintptr_t)V_lds + v_rd_base(lanel) + bf * SHM_V;
        pv_one<0>(o[0], vb, pa0, pa1, pa2, pa3); pv_one<1>(o[1], vb, pa0, pa1, pa2, pa3); pv_one<2>(o[2], vb, pa0, pa1, pa2, pa3); pv_one<3>(o[3], vb, pa0, pa1, pa2, pa3);
        if (j + 1 < NT) { VM_WAIT(); SWRITE(bf ^ 1); }
        __syncthreads();
    }
#undef SLOAD
#undef SWRITE
    if (hi == 0) li_l[r32] = l_reg; LDS_WAIT();
    bf16_t* Ow = OA + ((size_t)b * SEQ + q0 + 4 * hi) * 1024 + wid * 128 + r32;
    const float* lip = li_l + 4 * hi;
    unsigned char* Ow8 = (unsigned char*)OA + ((size_t)b * SEQ + q0 + 4 * hi) * 1024 + wid * 128 + r32;
    asm volatile("" : "+v"(Ow), "+v"(lip), "+v"(Ow8));
#pragma unroll
    for (int r = 0; r < 16; ++r) { const int ro = (r & 3) + 8 * (r >> 2); if ((r & 3) == 0) asm volatile("" : "+v"(Ow), "+v"(Ow8), "+v"(lip)); const float rl = fast_rcp(lip[ro]);
#pragma unroll
        for (int d0 = 0; d0 < 4; ++d0) { float v = o[d0][r] * rl; if ((DBG_ATTN_ZERO == 1 && q0 < 256) || (DBG_ATTN_ZERO == 2 && q0 >= 256)) v = 0.f;
            if (PA_FP8) ((unsigned char*)Ow8)[ro * 1024 + d0 * 32] = (unsigned char)(__builtin_amdgcn_cvt_pk_fp8_f32(v, v, 0, false) & 0xff);
            else Ow[ro * 1024 + d0 * 32] = (bf16_t)(cvt_pk_bf16(v, v) & 0xffffu); }
        if ((r & 3) == 3) SBAR(); }
}
__device__ __forceinline__ void att2_partial(f32x16& p0, f32x16& p1, float& m_reg, float& alpha, unsigned w0, bool far, float bfar, const float* bp) {
    constexpr float C = 0.088388347648318440f * LOG2E;
    float off;
    if (far) {
        float pmax = p0[0];
#pragma unroll
        for (int r = 1; r < 16; ++r) pmax = fmaxf(pmax, p0[r]);
#pragma unroll
        for (int r = 0; r < 16; ++r) pmax = fmaxf(pmax, p1[r]);
        { auto rr = __builtin_amdgcn_permlane32_swap(__float_as_uint(pmax), __float_as_uint(pmax), false, false); pmax = fmaxf(__uint_as_float(rr[0]), __uint_as_float(rr[1])); }
        pmax = fmaf(pmax, C, bfar);
        if (__builtin_expect(__all(pmax - m_reg <= 11.0f), 1)) alpha = 1.f; else { const float mn = fmaxf(m_reg, pmax); alpha = __builtin_amdgcn_exp2f(m_reg - mn); m_reg = mn; }
        off = bfar - m_reg;
#pragma unroll
        for (int r = 0; r < 16; ++r) { p0[r] = fmaf(p0[r], C, off); p1[r] = fmaf(p1[r], C, off); }
    } else {
#pragma unroll
        for (int r4 = 0; r4 < 4; ++r4) {
#pragma unroll
            for (int rr = 0; rr < 4; ++rr) { const int r = r4 * 4 + rr; const int cb = (r & 3) + 8 * (r >> 2); p0[r] = fmaf(p0[r], C, bp[cb * 8]); p1[r] = fmaf(p1[r], C, bp[(cb + 32) * 8]); }
            SBAR(); }
        float pmax = p0[0];
#pragma unroll
        for (int r = 1; r < 16; ++r) pmax = fmaxf(pmax, p0[r]);
#pragma unroll
        for (int r = 0; r < 16; ++r) pmax = fmaxf(pmax, p1[r]);
        { auto rr = __builtin_amdgcn_permlane32_swap(__float_as_uint(pmax), __float_as_uint(pmax), false, false); pmax = fmaxf(__uint_as_float(rr[0]), __uint_as_float(rr[1])); }
        if (__builtin_expect(__all(pmax - m_reg <= 11.0f), 1)) alpha = 1.f; else { const float mn = fmaxf(m_reg, pmax); alpha = __builtin_amdgcn_exp2f(m_reg - mn); m_reg = mn; }
#pragma unroll
        for (int r = 0; r < 16; ++r) { p0[r] -= m_reg; p1[r] -= m_reg; }
    }
#pragma unroll
    for (int r = 0; r < 16; ++r) { const int cb = (r & 3) + 8 * (r >> 2); p0[r] = __uint_as_float(__float_as_uint(__builtin_amdgcn_exp2f(p0[r])) & (unsigned)__builtin_amdgcn_sbfe((int)w0, cb, 1)); }
}
__device__ __forceinline__ void att2_finish(f32x16& p0, f32x16& p1, float alpha, float& l_reg, unsigned w1, bf16x8& pa0, bf16x8& pa1, bf16x8& pa2, bf16x8& pa3) {
#pragma unroll
    for (int r = 0; r < 16; ++r) { const int cb = (r & 3) + 8 * (r >> 2); p1[r] = __uint_as_float(__float_as_uint(__builtin_amdgcn_exp2f(p1[r])) & (unsigned)__builtin_amdgcn_sbfe((int)w1, cb, 1)); }
    float ps = 0.f;
#pragma unroll
    for (int r = 0; r < 16; ++r) ps += p0[r];
#pragma unroll
    for (int r = 0; r < 16; ++r) ps += p1[r];
    { auto rr = __builtin_amdgcn_permlane32_swap(__float_as_uint(ps), __float_as_uint(ps), false, false); ps = __uint_as_float(rr[0]) + __uint_as_float(rr[1]); }
    l_reg = l_reg * alpha + ps;
#define PK4(P, BASE, OUT) do { unsigned a0 = cvt_pk_bf16(P[BASE + 0], P[BASE + 1]), a1 = cvt_pk_bf16(P[BASE + 2], P[BASE + 3]);   \
    unsigned b0 = cvt_pk_bf16(P[BASE + 4], P[BASE + 5]), b1 = cvt_pk_bf16(P[BASE + 6], P[BASE + 7]);                              \
    auto r0 = __builtin_amdgcn_permlane32_swap(a0, b0, false, false); auto r1 = __builtin_amdgcn_permlane32_swap(a1, b1, false, false); \
    u32x4 w = {r0[0], r1[0], r0[1], r1[1]}; OUT = *reinterpret_cast<bf16x8*>(&w); } while (0)
    PK4(p0, 0, pa0); PK4(p0, 8, pa1); PK4(p1, 0, pa2); PK4(p1, 8, pa3);
#undef PK4
}
__device__ __forceinline__ void attn_item2(Frame& F, int b, int q0, char* lds) {
    const bf16_t* Q = (const bf16_t*)(F.ws + WS_Q); const bf16_t* KV = (const bf16_t*)(F.outb + OUT_KV); const u64* MASK = (const u64*)(F.outb + OUT_MASK);
    bf16_t* OA = (bf16_t*)(F.outb + OUT_OA);
    int tid = F.tid; asm volatile("" : "+v"(tid));
    const int wid = F.wave, lane = tid & 63, r32 = lane & 31, hi = lane >> 5;
    char* V_lds = lds + OFF_V; char* K_lds = lds + OFF_K;
    float* wsl = (float*)(lds + OFF_WS) + wid * 64; float* li_l = wsl; float* al_l = wsl + 32;
    const float* btab = (const float*)(lds + OFF_BT);
    float m_reg = -1e30f, l_reg = 0.f; f32x16 o[4] = {}; bf16x8 qr[8];
    const size_t tokq = (size_t)b * SEQ + q0 + r32;
    { const bf16_t* Qw = Q + tokq * 1024 + wid * 128 + hi * 8;
#pragma unroll
      for (int d0 = 0; d0 < 8; ++d0) qr[d0] = *(const bf16x8*)(Qw + d0 * 16); }
    const u64* mq = MASK + tokq * 32;
    const int sr = tid >> 4, sc = (tid & 15) * 8;
    const bf16_t* Kb = KV + (size_t)b * SEQ * 128;
    const int NTr = (q0 >> 6) + 1, NT = (NTr + 1) & ~1;
    const float bfar = btab[wid];
    bf16x8 sA0, sA1, sB0, sB1;
#define SLD(s0_, s1_, k0) do { int srl = sr; asm volatile("" : "+v"(srl)); const bf16_t* kp_ = Kb + (size_t)((k0) + srl) * 128 + sc; s0_ = *(const bf16x8*)kp_; s1_ = *(const bf16x8*)(kp_ + 32 * 128); } while (0)
#define SWR(bf, s0_, s1_) do { int srv = sr; asm volatile("" : "+v"(srv)); const int kc = sc * 2; const int v0a = v_st(srv, sc), k0a = KSWZ(srv, kc); \
        *(bf16x8*)(V_lds + (bf) * SHM_V + v0a) = s0_; *(bf16x8*)(V_lds + (bf) * SHM_V + v0a + 8192) = s1_; \
        *(bf16x8*)(K_lds + (bf) * SHM_K + k0a) = s0_; *(bf16x8*)(K_lds + (bf) * SHM_K + k0a + 8192) = s1_; } while (0)
#define MWORD(j) ((j) < NTr ? mq[j] : 0ull)
#define RESC(a) do { if (__any((a) < 1.f)) { if (hi == 0) al_l[r32] = (a); LDS_WAIT(); \
        _Pragma("unroll") for (int d = 0; d < 4; ++d) _Pragma("unroll") for (int r = 0; r < 16; ++r) o[d][r] *= al_l[crow(r, hi)]; } } while (0)
#define PVALL(bf) do { int ll = lane; asm volatile("" : "+v"(ll)); const int vb = (int)(uintptr_t)V_lds + v_rd_base(ll) + (bf) * SHM_V; \
        pv_one<0>(o[0], vb, pa0, pa1, pa2, pa3); pv_one<1>(o[1], vb, pa0, pa1, pa2, pa3); pv_one<2>(o[2], vb, pa0, pa1, pa2, pa3); pv_one<3>(o[3], vb, pa0, pa1, pa2, pa3); } while (0)
#define ISFAR(jt) ((jt) * KVBLK + 63 - q0 <= -91 || (jt) >= NTr)
#define BPTR(jt) (btab + ((jt) * KVBLK + 4 * hi - (q0 + r32) + 185) * 8 + wid)
    f32x16 pA0, pA1, pB0, pB1; float alA, alB; bf16x8 pa0, pa1, pa2, pa3; u64 mwA, mwB;
    __syncthreads();
    SLD(sA0, sA1, 0); mwA = MWORD(0); VM_WAIT(); SWR(0, sA0, sA1); __syncthreads();
    qkt(pA0, pA1, K_lds, qr, r32, hi);
    att2_partial(pA0, pA1, m_reg, alA, (unsigned)(mwA >> (4 * hi)), ISFAR(0), bfar, BPTR(0));
    SLD(sB0, sB1, KVBLK); mwB = MWORD(1); if (2 < NT) SLD(sA0, sA1, 2 * KVBLK);
    SWR(1, sB0, sB1); __syncthreads();
    for (int j = 1; j + 1 < NT; j += 2) {
        SBAR(); qkt(pB0, pB1, K_lds + SHM_K, qr, r32, hi);
        att2_finish(pA0, pA1, alA, l_reg, (unsigned)(mwA >> (32 + 4 * hi)), pa0, pa1, pa2, pa3); SBAR();
        SLD(sB0, sB1, (j + 2) * KVBLK); mwA = MWORD(j + 1); SBAR();
        PVALL(0);
        att2_partial(pB0, pB1, m_reg, alB, (unsigned)(mwB >> (4 * hi)), ISFAR(j), bfar, BPTR(j));
        __syncthreads(); SWR(0, sA0, sA1);
        RESC(alB); __syncthreads();
        SBAR(); qkt(pA0, pA1, K_lds, qr, r32, hi);
        att2_finish(pB0, pB1, alB, l_reg, (unsigned)(mwB >> (32 + 4 * hi)), pa0, pa1, pa2, pa3); SBAR();
        if (j + 3 < NT) SLD(sA0, sA1, (j + 3) * KVBLK); mwB = MWORD(j + 2); SBAR();
        PVALL(1);
        att2_partial(pA0, pA1, m_reg, alA, (unsigned)(mwA >> (4 * hi)), ISFAR(j + 1), bfar, BPTR(j + 1));
        __syncthreads(); SWR(1, sB0, sB1);
        RESC(alA); __syncthreads();
    }
    SBAR(); qkt(pB0, pB1, K_lds + SHM_K, qr, r32, hi);
    att2_finish(pA0, pA1, alA, l_reg, (unsigned)(mwA >> (32 + 4 * hi)), pa0, pa1, pa2, pa3); SBAR();
    PVALL(0);
    att2_partial(pB0, pB1, m_reg, alB, (unsigned)(mwB >> (4 * hi)), ISFAR(NT - 1), bfar, BPTR(NT - 1));
    __syncthreads(); RESC(alB);
    att2_finish(pB0, pB1, alB, l_reg, (unsigned)(mwB >> (32 + 4 * hi)), pa0, pa1, pa2, pa3); SBAR();
    PVALL(1);
#undef SLD
#undef SWR
#undef MWORD
#undef RESC
#undef PVALL
#undef ISFAR
#undef BPTR
    LAS float* li_s = (LAS float*)(F.lds + OFF_WS) + wid * 64;
    if (hi == 0) li_s[r32] = l_reg; LDS_WAIT();
    if (PA_FP8 && ATT_OT) {
        LAS unsigned char* ot = F.lds + OFF_OT + wid * (32 * OT_ST);
        int ob = (4 * hi) * OT_ST + r32, lo = 4 * hi; asm volatile("" : "+v"(ob), "+v"(lo));
#pragma unroll
        for (int r = 0; r < 16; ++r) { const int ro = (r & 3) + 8 * (r >> 2); if ((r & 3) == 0) asm volatile("" : "+v"(ob), "+v"(lo)); const float rl = fast_rcp(li_s[lo + ro]);
#pragma unroll
            for (int d0 = 0; d0 < 4; ++d0) { const float v = o[d0][r] * rl; ot[ob + ro * OT_ST + d0 * 32] = (unsigned char)(__builtin_amdgcn_cvt_pk_fp8_f32(v, v, 0, false) & 0xff); }
            if ((r & 3) == 3) SBAR(); }
        LDS_WAIT(); asm volatile("" ::: "memory");
        unsigned char* Og = (unsigned char*)OA + ((size_t)b * SEQ + q0) * 1024 + wid * 128;
        int rr = lane >> 3, sg = (lane & 7) * 16; asm volatile("" : "+v"(rr), "+v"(sg));
#pragma unroll
        for (int i = 0; i < 4; ++i) { const u32x4 w = *(const LAS u32x4*)(ot + (i * 8 + rr) * OT_ST + sg); *(u32x4*)(Og + (size_t)(i * 8 + rr) * 1024 + sg) = w; }
        LDS_WAIT();
    } else if (PA_FP8) {
        GAS unsigned char* Ow8 = (GAS unsigned char*)((unsigned char*)OA + ((size_t)b * SEQ + q0 + 4 * hi) * 1024 + wid * 128 + r32);
        int lo = 4 * hi; asm volatile("" : "+v"(Ow8), "+v"(lo));
#pragma unroll
        for (int r = 0; r < 16; ++r) { const int ro = (r & 3) + 8 * (r >> 2); if ((r & 3) == 0) asm volatile("" : "+v"(Ow8), "+v"(lo)); const float rl = fast_rcp(li_s[lo + ro]);
#pragma unroll
            for (int d0 = 0; d0 < 4; ++d0) { const float v = o[d0][r] * rl; Ow8[ro * 1024 + d0 * 32] = (unsigned char)(__builtin_amdgcn_cvt_pk_fp8_f32(v, v, 0, false) & 0xff); }
            if ((r & 3) == 3) SBAR(); }
    } else {
        bf16_t* Ow = OA + ((size_t)b * SEQ + q0 + 4 * hi) * 1024 + wid * 128 + r32;
        int lo = 4 * hi; asm volatile("" : "+v"(Ow), "+v"(lo));
#pragma unroll
        for (int r = 0; r < 16; ++r) { const int ro = (r & 3) + 8 * (r >> 2); if ((r & 3) == 0) asm volatile("" : "+v"(Ow), "+v"(lo)); const float rl = fast_rcp(li_s[lo + ro]);
#pragma unroll
            for (int d0 = 0; d0 < 4; ++d0) { const float v = o[d0][r] * rl; Ow[ro * 1024 + d0 * 32] = (bf16_t)(cvt_pk_bf16(v, v) & 0xffffu); }
            if ((r & 3) == 3) SBAR(); }
    }
}
}
__device__ __forceinline__ void ph_attn(Frame& F) {
    char* lds = (char*)(unsigned char*)F.lds;
    { float* bt = (float*)(lds + att::OFF_BT); const float* BT = (const float*)(F.ws + WS_BIAST); __syncthreads(); for (int i = F.tid; i < 249 * 8; i += NTHR) bt[i] = BT[i]; __syncthreads(); }
    for (int pr = F.bid; pr < NB * 32; pr += F.G) {
        const int b = pr >> 5, qb = pr & 31;
#pragma nounroll
        for (int hh = 0; hh < 2; ++hh) { if (ATT2) att::attn_item2(F, b, (hh ? qb : 63 - qb) * 32, lds); else att::attn_item(F, b, (hh ? qb : 63 - qb) * 32, lds); }
    }
}

namespace ssd {
constexpr int OFF_CS = 0, CS_ST = 272;
constexpr int OFF_BS = OFF_CS + 64 * CS_ST;
constexpr int OFF_BT = OFF_BS + 64 * CS_ST, T_ST = 144;
constexpr int OFF_XT = OFF_BT + 128 * T_ST;
constexpr int OFF_XW = OFF_XT + 64 * T_ST;
constexpr int OFF_XS = OFF_XW + 64 * T_ST;
constexpr int OFF_MT = OFF_XS + 64 * T_ST;
constexpr int OFF_HS = OFF_MT + 64 * T_ST;
constexpr int OFF_END = OFF_HS + 64 * CS_ST;
static_assert(OFF_END + 5 * 320 * 4 <= 131072, "ssd lds");
__device__ __forceinline__ f32x4 mfma16(bf16x8 a, bf16x8 b, f32x4 c) { return __builtin_amdgcn_mfma_f32_16x16x32_bf16(a, b, c, 0, 0, 0); }
__device__ __forceinline__ bf16x8 ldfrag(const char* base, int stride, int row, int k0) { return *(const bf16x8*)(base + row * stride + k0 * 2); }
}
__device__ __forceinline__ void ph_ssd(Frame& F) {
    using namespace ssd;
    char* lds = (char*)(unsigned char*)F.lds;
    const bf16_t* XBC = (const bf16_t*)(F.ws + WS_XBC); const bf16_t* ZS = (const bf16_t*)(F.ws + WS_Z); const float* DT = (const float*)(F.outb + OUT_DT);
    bf16_t* YG = (bf16_t*)(F.ws + WS_Q);
    const float* conv_w = F.a->in[9]; const float* conv_b = F.a->in[10]; const float* a_log = F.a->in[12]; const float* d_skip = F.a->in[13];
    const int tid = F.tid, wid = F.wave, lane = F.lane, fr = lane & 15, fq = lane >> 4;
    const bool stager = tid < 320; const int so = tid % 40, tg = tid / 40;
    for (int item = F.bid; item < NB * 16; item += F.G) {
        const int b = item >> 4, h = item & 15, g = h >> 2;
        const float aneg = -__expf(a_log[h]), dsk = d_skip[h];
        const int ch0 = so < 8 ? h * 64 + so * 8 : (so < 24 ? 1024 + g * 128 + (so - 8) * 8 : 1536 + g * 128 + (so - 24) * 8);
        float* CWL = (float*)(lds + OFF_END);
        __syncthreads();
        if (stager) {
#pragma unroll
            for (int j = 0; j < 4; ++j) { *(f32x4*)(CWL + j * 320 + so * 8) = *(const f32x4*)(conv_w + (size_t)j * 2048 + ch0); *(f32x4*)(CWL + j * 320 + so * 8 + 4) = *(const f32x4*)(conv_w + (size_t)j * 2048 + ch0 + 4); }
            *(f32x4*)(CWL + 4 * 320 + so * 8) = *(const f32x4*)(conv_b + ch0); *(f32x4*)(CWL + 4 * 320 + so * 8 + 4) = *(const f32x4*)(conv_b + ch0 + 4);
        }
        f32x4 hst[4];
#pragma unroll
        for (int t = 0; t < 4; ++t) hst[t] = (f32x4){0.f, 0.f, 0.f, 0.f};
        __syncthreads();
        for (int i = tid; i < 64 * CS_ST / 4; i += NTHR) ((unsigned*)(lds + OFF_HS))[i] = 0u;
        u32x4 raw[11];
        const size_t tokb = (size_t)b * SEQ;
#define SSD_LOAD(c) do { if (stager) { _Pragma("unroll") for (int i = 0; i < 11; ++i) { const int t = (c) * 64 + tg * 8 - 3 + i; \
            raw[i] = (t >= 0) ? *(const u32x4*)(XBC + (tokb + t) * 2048 + ch0) : (u32x4){0u, 0u, 0u, 0u}; } } } while (0)
        SSD_LOAD(0);
        float dtl_next = DT[(tokb + lane) * 16 + h];
        for (int c = 0; c < 32; ++c) {
            const float dtl = dtl_next; if (c + 1 < 32) dtl_next = DT[(tokb + (c + 1) * 64 + lane) * 16 + h];
            u32x2 zpre[2];
#pragma unroll
            for (int t2 = 0; t2 < 2; ++t2) { const int tile = 2 * wid + t2, pb = tile >> 2, lb = tile & 3; zpre[t2] = *(const u32x2*)(ZS + (tokb + c * 64 + lb * 16 + fr) * 1024 + h * 64 + pb * 16 + 4 * fq); }
            float acs = dtl * aneg;
#pragma unroll
            for (int o = 1; o < 64; o <<= 1) { const float t = __shfl_up(acs, o); if (lane >= o) acs += t; }
            const float alast = __shfl(acs, 63);
            if (DBG_SSD_SYNC) __syncthreads();
            float dtv[8], dec[8];
#pragma unroll
            for (int t = 0; t < 8; ++t) { dtv[t] = __shfl(dtl, (tg * 8 + t) & 63); dec[t] = __expf(alast - __shfl(acs, (tg * 8 + t) & 63)); }
            if (stager) {
#pragma unroll
                for (int hq = 0; hq < 2; ++hq) {
                    float xin[11][4];
#pragma unroll
                    for (int i = 0; i < 11; ++i) { const unsigned wa = hq ? raw[i].z : raw[i].x, wb = hq ? raw[i].w : raw[i].y; xin[i][0] = bflo(wa); xin[i][1] = bfhi(wa); xin[i][2] = bflo(wb); xin[i][3] = bfhi(wb); }
                    float outv[8][4];
                    { f32x4 cwv[4]; const f32x4 cbq = *(const f32x4*)(CWL + 4 * 320 + so * 8 + hq * 4);
#pragma unroll
                      for (int j = 0; j < 4; ++j) cwv[j] = *(const f32x4*)(CWL + j * 320 + so * 8 + hq * 4);
#pragma unroll
                      for (int t = 0; t < 8; ++t)
#pragma unroll
                        for (int e = 0; e < 4; ++e) { float sacc = cbq[e];
#pragma unroll
                            for (int j = 0; j < 4; ++j) sacc += cwv[j][e] * xin[t + j][e];
                            outv[t][e] = silu_f(sacc); } }
                    if (so < 8) {
#pragma unroll
                        for (int e = 0; e < 4; ++e) { const int p = so * 8 + hq * 4 + e;
                            f32x4 x0, x1, d0, d1, w0, w1;
#pragma unroll
                            for (int t = 0; t < 4; ++t) { x0[t] = outv[t][e]; x1[t] = outv[4 + t][e]; d0[t] = x0[t] * dtv[t]; d1[t] = x1[t] * dtv[4 + t]; w0[t] = d0[t] * dec[t]; w1[t] = d1[t] * dec[4 + t]; }
                            *(u32x4*)(lds + OFF_XS + p * T_ST + tg * 16) = pack8(x0, x1);
                            *(u32x4*)(lds + OFF_XT + p * T_ST + tg * 16) = pack8(d0, d1);
                            *(u32x4*)(lds + OFF_XW + p * T_ST + tg * 16) = pack8(w0, w1); }
                    } else {
                        const bool isB = so < 24; const int n0 = (isB ? (so - 8) : (so - 24)) * 8 + hq * 4;
                        char* nat = lds + (isB ? OFF_BS : OFF_CS);
#pragma unroll
                        for (int t = 0; t < 8; ++t) { u32x2 w; w.x = cvt_pk_bf16(outv[t][0], outv[t][1]); w.y = cvt_pk_bf16(outv[t][2], outv[t][3]);
                            *(u32x2*)(nat + (tg * 8 + t) * CS_ST + n0 * 2) = w; }
                        if (isB) {
#pragma unroll
                            for (int e = 0; e < 4; ++e) { f32x4 a, bq;
#pragma unroll
                                for (int t = 0; t < 4; ++t) { a[t] = outv[t][e]; bq[t] = outv[4 + t][e]; }
                                *(u32x4*)(lds + OFF_BT + (n0 + e) * T_ST + tg * 16) = pack8(a, bq); }
                        }
                    }
                }
            }
            if (c + 1 < 32) SSD_LOAD(c + 1);
            __syncthreads();
#pragma unroll
            for (int t2 = 0; t2 < 2; ++t2) {
                const int tile = 2 * wid + t2, sb = tile >> 2, lb = tile & 3;
                f32x4 d = (f32x4){0.f, 0.f, 0.f, 0.f};
                if (sb <= lb) {
#pragma unroll
                    for (int ks = 0; ks < 4; ++ks) d = mfma16(ldfrag(lds + OFF_BS, CS_ST, sb * 16 + fr, ks * 32 + fq * 8), ldfrag(lds + OFF_CS, CS_ST, lb * 16 + fr, ks * 32 + fq * 8), d);
                    const int l = lb * 16 + fr; const float al = __shfl(acs, l);
                    f32x4 as;
#pragma unroll
                    for (int r = 0; r < 4; ++r) as[r] = __shfl(acs, sb * 16 + 4 * fq + r);
#pragma unroll
                    for (int r = 0; r < 4; ++r) { const int s = sb * 16 + 4 * fq + r; d[r] = (s <= l) ? d[r] * __expf(al - as[r]) : 0.f; }
                }
                u32x2 w; w.x = cvt_pk_bf16(d[0], d[1]); w.y = cvt_pk_bf16(d[2], d[3]);
                *(u32x2*)(lds + OFF_MT + (lb * 16 + fr) * T_ST + (sb * 16 + 4 * fq) * 2) = w;
            }
            if (DBG_SSD_SYNC) __syncthreads();
            f32x4 yacc[2];
#pragma unroll
            for (int t2 = 0; t2 < 2; ++t2) {
                const int tile = 2 * wid + t2, pb = tile >> 2, lb = tile & 3;
                f32x4 d = (f32x4){0.f, 0.f, 0.f, 0.f};
#pragma unroll
                for (int ks = 0; ks < 4; ++ks) d = mfma16(ldfrag(lds + OFF_HS, CS_ST, pb * 16 + fr, ks * 32 + fq * 8), ldfrag(lds + OFF_CS, CS_ST, lb * 16 + fr, ks * 32 + fq * 8), d);
                const float el = __expf(__shfl(acs, lb * 16 + fr));
                yacc[t2] = d * el;
            }
            __syncthreads();
#pragma unroll
            for (int t2 = 0; t2 < 2; ++t2) {
                const int tile = 2 * wid + t2, pb = tile >> 2, lb = tile & 3;
                f32x4 d = yacc[t2];
#pragma unroll
                for (int ks = 0; ks < 2; ++ks) d = mfma16(ldfrag(lds + OFF_XT, T_ST, pb * 16 + fr, ks * 32 + fq * 8), ldfrag(lds + OFF_MT, T_ST, lb * 16 + fr, ks * 32 + fq * 8), d);
                const int l = lb * 16 + fr, p0 = pb * 16 + 4 * fq; const size_t tok = tokb + c * 64 + l;
                const u32x2 zz = zpre[t2];
                const float z0 = bflo(zz.x), z1 = bfhi(zz.x), z2 = bflo(zz.y), z3 = bfhi(zz.y);
                float xs[4];
#pragma unroll
                for (int r = 0; r < 4; ++r) xs[r] = bflo((unsigned)*(const bf16_t*)(lds + OFF_XS + (p0 + r) * T_ST + l * 2));
                u32x2 w; w.x = cvt_pk_bf16((d[0] + xs[0] * dsk) * z0, (d[1] + xs[1] * dsk) * z1); w.y = cvt_pk_bf16((d[2] + xs[2] * dsk) * z2, (d[3] + xs[3] * dsk) * z3);
                *(u32x2*)(YG + tok * 1024 + h * 64 + p0) = w;
            }
            if (DBG_SSD_SYNC) __syncthreads();
            { const float dc = __expf(alast);
#pragma unroll
              for (int t = 0; t < 4; ++t) { f32x4 d = hst[t] * dc;
#pragma unroll
                  for (int ks = 0; ks < 2; ++ks) d = mfma16(ldfrag(lds + OFF_BT, T_ST, wid * 16 + fr, ks * 32 + fq * 8), ldfrag(lds + OFF_XW, T_ST, t * 16 + fr, ks * 32 + fq * 8), d);
                  hst[t] = d;
                  u32x2 w; w.x = cvt_pk_bf16(d[0], d[1]); w.y = cvt_pk_bf16(d[2], d[3]);
                  *(u32x2*)(lds + OFF_HS + (t * 16 + fr) * CS_ST + (wid * 16 + 4 * fq) * 2) = w; } }
            __syncthreads();
        }
#undef SSD_LOAD
    }
}

namespace ssd2 {
constexpr int CS_ST = 272, T_ST = 144;
constexpr int OFF_CS = 0, OFF_BS = 64 * CS_ST, OFF_BT = 2 * 64 * CS_ST, OFF_H0 = OFF_BT + 128 * T_ST;
constexpr int H_XS = 0, H_XW = 64 * T_ST, H_MT = 2 * 64 * T_ST, H_HS = 3 * 64 * T_ST, H_SZ = H_HS + 64 * CS_ST;
constexpr int OFF_CW = OFF_H0 + 2 * H_SZ;
constexpr int OFF_TAB = OFF_CW + 5 * 384 * 4;
static_assert(OFF_TAB + 6 * 64 * 4 <= LDS_MISC, "ssd2 lds");
}
__device__ __forceinline__ void ph_ssd2(Frame& F, const int abl = 0) {
    using namespace ssd2; using ssd::mfma16; using ssd::ldfrag;
    char* lds = (char*)(unsigned char*)F.lds;
    const bf16_t* XBC = (const bf16_t*)(F.ws + WS_XBC); const bf16_t* ZS = (const bf16_t*)(F.ws + WS_Z); const float* DT = (const float*)(F.outb + OUT_DT);
    bf16_t* YG = (bf16_t*)(F.ws + WS_Q);
    const float* conv_w = F.a->in[9]; const float* conv_b = F.a->in[10]; const float* a_log = F.a->in[12]; const float* d_skip = F.a->in[13];
    const int tid = F.tid, wid = F.wave, lane = F.lane, fr = lane & 15, fq = lane >> 4;
    const int su = tid < 384 ? tid : tid - 128; const bool cwl_writer = true;
    const int cp_lo = __builtin_amdgcn_readfirstlane(tid < 384 ? 0 : 2), cp_hi = __builtin_amdgcn_readfirstlane(tid < 256 ? 4 : (tid < 384 ? 2 : 4));
    const int so = su % 48, tg = su / 48, shd = (so >> 3) & 1;
    for (int item = F.bid; item < NB * 8; item += F.G) {
        const int b = item >> 3, g = (item >> 1) & 3, h0 = g * 4 + (item & 1) * 2;
        const float aneg0 = -__expf(a_log[h0]), aneg1 = -__expf(a_log[h0 + 1]), dsk0 = d_skip[h0], dsk1 = d_skip[h0 + 1];
        const int ch0 = so < 16 ? (h0 + shd) * 64 + (so & 7) * 8 : (so < 32 ? 1024 + g * 128 + (so - 16) * 8 : 1536 + g * 128 + (so - 32) * 8);
        float* CWL = (float*)(lds + OFF_CW);
        __syncthreads();
        if (cwl_writer) {
#pragma unroll
            for (int j = 0; j < 4; ++j) { *(f32x4*)(CWL + j * 384 + so * 8) = *(const f32x4*)(conv_w + (size_t)j * 2048 + ch0); *(f32x4*)(CWL + j * 384 + so * 8 + 4) = *(const f32x4*)(conv_w + (size_t)j * 2048 + ch0 + 4); }
            *(f32x4*)(CWL + 4 * 384 + so * 8) = *(const f32x4*)(conv_b + ch0); *(f32x4*)(CWL + 4 * 384 + so * 8 + 4) = *(const f32x4*)(conv_b + ch0 + 4);
        }
        f32x4 hst[2][4];
#pragma unroll
        for (int hh = 0; hh < 2; ++hh)
#pragma unroll
            for (int t = 0; t < 4; ++t) hst[hh][t] = (f32x4){0.f, 0.f, 0.f, 0.f};
        for (int i = tid; i < 64 * CS_ST / 4; i += NTHR) { ((unsigned*)(lds + OFF_H0 + H_HS))[i] = 0u; ((unsigned*)(lds + OFF_H0 + H_SZ + H_HS))[i] = 0u; }
        u32x4 raw[11];
        const size_t tokb = (size_t)b * SEQ;
        const bf16_t* xrow = XBC + ((ptrdiff_t)tokb + tg * 8 - 3) * 2048 + ch0;
#define SSD_LOAD(c, xp, tgx) do { { _Pragma("unroll") for (int i = 0; i < 11; ++i) { const int t = (c) * 64 + (tgx) * 8 - 3 + i; \
            raw[i] = (t >= 0) ? *(const GAS u32x4*)((xp) + (ptrdiff_t)((c) * 64 + i) * 2048) : (u32x4){0u, 0u, 0u, 0u}; } } } while (0)
        SSD_LOAD(0, xrow, tg);
        f32x2 dtn = *(const f32x2*)(DT + (tokb + lane) * 16 + h0);
        for (int c = 0; c < 32; ++c) {
            int frl = fr, fql = fq, tgl = tg, sol = so; const bf16_t* xrl = xrow; asm volatile("" : "+v"(frl), "+v"(fql), "+v"(tgl), "+v"(sol), "+v"(xrl)); const int shdl = (sol >> 3) & 1;
            const float dtl0 = dtn[0], dtl1 = dtn[1]; if (c + 1 < 32) dtn = *(const f32x2*)(DT + (tokb + (c + 1) * 64 + lane) * 16 + h0);
            u32x2 zpre[2][2];
#pragma unroll
            for (int hh = 0; hh < 2; ++hh)
#pragma unroll
                for (int t2 = 0; t2 < 2; ++t2) { const int tile = 2 * wid + t2, pb = tile >> 2, lb = tile & 3; zpre[hh][t2] = *(const u32x2*)(ZS + (tokb + c * 64 + lb * 16 + frl) * 1024 + (h0 + hh) * 64 + pb * 16 + 4 * fql); }
            const float acs0 = dpp_scan_add(dtl0 * aneg0), acs1 = dpp_scan_add(dtl1 * aneg1);
            const float alast0 = __builtin_bit_cast(float, __builtin_amdgcn_readlane(__builtin_bit_cast(int, acs0), 63)), alast1 = __builtin_bit_cast(float, __builtin_amdgcn_readlane(__builtin_bit_cast(int, acs1), 63));
            float* TAB = (float*)(lds + OFF_TAB);
            TAB[lane] = acs0; TAB[64 + lane] = acs1; TAB[128 + lane] = dtl0; TAB[192 + lane] = dtl1; TAB[256 + lane] = dtl0 * __expf(alast0 - acs0); TAB[320 + lane] = dtl1 * __expf(alast1 - acs1);
            LDS_WAIT(); asm volatile("" ::: "memory");
            float wdt[8];
            { const f32x4 wa = *(const f32x4*)(TAB + 256 + shdl * 64 + tgl * 8), wb = *(const f32x4*)(TAB + 256 + shdl * 64 + tgl * 8 + 4);
#pragma unroll
              for (int t = 0; t < 4; ++t) { wdt[t] = wa[t]; wdt[4 + t] = wb[t]; } }
            if (!(abl & 1)) {
#pragma unroll
                for (int cp = 0; cp < 4; ++cp) {
                    if (cp < cp_lo || cp >= cp_hi) continue;
                    float xin[11][2];
#pragma unroll
                    for (int i = 0; i < 11; ++i) { const unsigned wa = cp == 0 ? raw[i].x : (cp == 1 ? raw[i].y : (cp == 2 ? raw[i].z : raw[i].w)); xin[i][0] = bflo(wa); xin[i][1] = bfhi(wa); }
                    float outv[8][2];
                    { f32x2 cwv[4]; const f32x2 cbq = *(const f32x2*)(CWL + 4 * 384 + sol * 8 + cp * 2);
#pragma unroll
                      for (int j = 0; j < 4; ++j) cwv[j] = *(const f32x2*)(CWL + j * 384 + sol * 8 + cp * 2);
#pragma unroll
                      for (int t = 0; t < 8; ++t)
#pragma unroll
                        for (int e = 0; e < 2; ++e) { float sacc = cbq[e];
#pragma unroll
                            for (int j = 0; j < 4; ++j) sacc += cwv[j][e] * xin[t + j][e];
                            outv[t][e] = silu_f(sacc); } }
                    if (sol < 16) {
                        char* hb = lds + OFF_H0 + shdl * H_SZ;
#pragma unroll
                        for (int e = 0; e < 2; ++e) { const int p = (sol & 7) * 8 + cp * 2 + e;
                            f32x4 x0, x1, w0, w1;
#pragma unroll
                            for (int t = 0; t < 4; ++t) { x0[t] = outv[t][e]; x1[t] = outv[4 + t][e]; w0[t] = x0[t] * wdt[t]; w1[t] = x1[t] * wdt[4 + t]; }
                            *(u32x4*)(hb + H_XS + p * T_ST + tgl * 16) = pack8(x0, x1);
                            *(u32x4*)(hb + H_XW + p * T_ST + tgl * 16) = pack8(w0, w1); }
                    } else {
                        const bool isB = sol < 32; const int n0 = (isB ? (sol - 16) : (sol - 32)) * 8 + cp * 2;
                        char* nat = lds + (isB ? OFF_BS : OFF_CS);
#pragma unroll
                        for (int t = 0; t < 8; ++t) *(unsigned*)(nat + (tgl * 8 + t) * CS_ST + n0 * 2) = cvt_pk_bf16(outv[t][0], outv[t][1]);
                        if (isB) {
#pragma unroll
                            for (int e = 0; e < 2; ++e) { f32x4 a, bq;
#pragma unroll
                                for (int t = 0; t < 4; ++t) { a[t] = outv[t][e]; bq[t] = outv[4 + t][e]; }
                                *(u32x4*)(lds + OFF_BT + (n0 + e) * T_ST + tgl * 16) = pack8(a, bq); }
                        }
                    }
                    SBAR();
                }
            }
            if (c + 1 < 32) SSD_LOAD(c + 1, xrl, tgl);
            __syncthreads();
            bf16x8 cfr[2][4];
#pragma unroll
            for (int t2 = 0; t2 < 2; ++t2)
#pragma unroll
                for (int ks = 0; ks < 4; ++ks) cfr[t2][ks] = ldfrag(lds + OFF_CS, CS_ST, ((2 * wid + t2) & 3) * 16 + frl, ks * 32 + fql * 8);
            if (!(abl & 2))
#pragma unroll
            for (int t2 = 0; t2 < 2; ++t2) {
                const int tile = 2 * wid + t2, sb = tile >> 2, lb = tile & 3;
                f32x4 d = (f32x4){0.f, 0.f, 0.f, 0.f}, m0 = d, m1 = d;
                if (sb <= lb) {
#pragma unroll
                    for (int ks = 0; ks < 4; ++ks) d = mfma16(ldfrag(lds + OFF_BS, CS_ST, sb * 16 + frl, ks * 32 + fql * 8), cfr[t2][ks], d);
                    const int l = lb * 16 + frl, s4 = sb * 16 + 4 * fql; const float al0 = TAB[l], al1 = TAB[64 + l];
                    const f32x4 as0 = *(const f32x4*)(TAB + s4), as1 = *(const f32x4*)(TAB + 64 + s4), ds0 = *(const f32x4*)(TAB + 128 + s4), ds1 = *(const f32x4*)(TAB + 192 + s4);
#pragma unroll
                    for (int r = 0; r < 4; ++r) { const int sidx = s4 + r;
                        m0[r] = (sidx <= l) ? d[r] * __expf(al0 - as0[r]) * ds0[r] : 0.f; m1[r] = (sidx <= l) ? d[r] * __expf(al1 - as1[r]) * ds1[r] : 0.f; }
                }
                u32x2 w; w.x = cvt_pk_bf16(m0[0], m0[1]); w.y = cvt_pk_bf16(m0[2], m0[3]);
                *(u32x2*)(lds + OFF_H0 + H_MT + (lb * 16 + frl) * T_ST + (sb * 16 + 4 * fql) * 2) = w;
                w.x = cvt_pk_bf16(m1[0], m1[1]); w.y = cvt_pk_bf16(m1[2], m1[3]);
                *(u32x2*)(lds + OFF_H0 + H_SZ + H_MT + (lb * 16 + frl) * T_ST + (sb * 16 + 4 * fql) * 2) = w;
            }
            f32x4 yacc[2][2];
#pragma unroll
            for (int hh = 0; hh < 2; ++hh)
#pragma unroll
                for (int t2 = 0; t2 < 2; ++t2) {
                    const int tile = 2 * wid + t2, pb = tile >> 2, lb = tile & 3; const char* hb = lds + OFF_H0 + hh * H_SZ;
                    f32x4 d = (f32x4){0.f, 0.f, 0.f, 0.f};
                    if (!(abl & 2))
#pragma unroll
                    for (int ks = 0; ks < 4; ++ks) d = mfma16(ldfrag(hb + H_HS, CS_ST, pb * 16 + frl, ks * 32 + fql * 8), cfr[t2][ks], d);
                    const float el = __expf(TAB[hh * 64 + lb * 16 + frl]);
                    yacc[hh][t2] = d * el;
                }
            __syncthreads();
            if (!(abl & 4))
#pragma unroll
            for (int hh = 0; hh < 2; ++hh)
#pragma unroll
                for (int t2 = 0; t2 < 2; ++t2) {
                    const int tile = 2 * wid + t2, pb = tile >> 2, lb = tile & 3; const char* hb = lds + OFF_H0 + hh * H_SZ;
                    f32x4 d = yacc[hh][t2];
#pragma unroll
                    for (int ks = 0; ks < 2; ++ks) d = mfma16(ldfrag(hb + H_XS, T_ST, pb * 16 + frl, ks * 32 + fql * 8), ldfrag(hb + H_MT, T_ST, lb * 16 + frl, ks * 32 + fql * 8), d);
                    const int l = lb * 16 + frl, p0 = pb * 16 + 4 * fql; const size_t tok = tokb + c * 64 + l; const float dsk = hh ? dsk1 : dsk0;
                    const u32x2 zz = zpre[hh][t2];
                    const float z0 = bflo(zz.x), z1 = bfhi(zz.x), z2 = bflo(zz.y), z3 = bfhi(zz.y);
                    float xs[4];
#pragma unroll
                    for (int r = 0; r < 4; ++r) xs[r] = bflo((unsigned)*(const bf16_t*)(hb + H_XS + (p0 + r) * T_ST + l * 2));
                    u32x2 w; w.x = cvt_pk_bf16((d[0] + xs[0] * dsk) * z0, (d[1] + xs[1] * dsk) * z1); w.y = cvt_pk_bf16((d[2] + xs[2] * dsk) * z2, (d[3] + xs[3] * dsk) * z3);
                    *(u32x2*)(YG + tok * 1024 + (h0 + hh) * 64 + p0) = w;
                }
            const bf16x8 btf0 = ldfrag(lds + OFF_BT, T_ST, wid * 16 + frl, fql * 8), btf1 = ldfrag(lds + OFF_BT, T_ST, wid * 16 + frl, 32 + fql * 8);
            if (!(abl & 8))
#pragma unroll
            for (int hh = 0; hh < 2; ++hh) { const float dc = __expf(hh ? alast1 : alast0); char* hb = lds + OFF_H0 + hh * H_SZ;
#pragma unroll
                for (int t = 0; t < 4; ++t) { f32x4 d = hst[hh][t] * dc;
#pragma unroll
                    for (int ks = 0; ks < 2; ++ks) d = mfma16(ks ? btf1 : btf0, ldfrag(hb + H_XW, T_ST, t * 16 + frl, ks * 32 + fql * 8), d);
                    hst[hh][t] = d;
                    u32x2 w; w.x = cvt_pk_bf16(d[0], d[1]); w.y = cvt_pk_bf16(d[2], d[3]);
                    *(u32x2*)(hb + H_HS + (t * 16 + frl) * CS_ST + (wid * 16 + 4 * fql) * 2) = w; } }
            __syncthreads();
        }
#undef SSD_LOAD
    }
}

__device__ __forceinline__ void ph_gnorm(Frame& F) {
    bf16_t* YG = (bf16_t*)(F.ws + WS_Q);
    const int gw = F.bid * NWAVES + F.wave, NGW = F.G * NWAVES;
    constexpr int RB = 4;
    for (int m0 = gw * RB; m0 < NTOK; m0 += NGW * RB) {
        u32x2 w[RB][4];
#pragma unroll
        for (int r = 0; r < RB; ++r) { const u32x2* rp = (const u32x2*)(YG + (size_t)(m0 + r) * D) + F.lane;
#pragma unroll
            for (int j = 0; j < 4; ++j) w[r][j] = rp[64 * j]; }
#pragma unroll
        for (int r = 0; r < RB; ++r) { const int m = m0 + r; u32x2* rp = (u32x2*)(YG + (size_t)m * D) + F.lane;
#pragma unroll
            for (int j = 0; j < 4; ++j) { const float a = bflo(w[r][j].x), b = bfhi(w[r][j].x), c = bflo(w[r][j].y), d = bfhi(w[r][j].y);
                const float ss = wave_sum(a * a + b * b + c * c + d * d); const float rr = 1.f / sqrtf(ss * (1.f / 256.f) + LN_EPS);
                if (PB_FP8) { int pk = 0; pk = __builtin_amdgcn_cvt_pk_fp8_f32(a * rr, b * rr, pk, false); pk = __builtin_amdgcn_cvt_pk_fp8_f32(c * rr, d * rr, pk, true); ((unsigned*)(F.outb + OUT_OB8 + (size_t)m * D))[F.lane + 64 * j] = (unsigned)pk; }
                else { u32x2 o; o.x = cvt_pk_bf16(a * rr, b * rr); o.y = cvt_pk_bf16(c * rr, d * rr); rp[64 * j] = o; } } }
    }
}

template <bool DRY = false> __device__ __forceinline__ void ph_router(Frame& F) {
    const bf16_t* VB = (const bf16_t*)(F.ws + WS_VB); bf16_t* X1B = (bf16_t*)(F.ws + WS_X1B); bf16_t* U2 = (bf16_t*)(F.ws + WS_U2); const float* MOD = (const float*)(F.ws + WS_MOD);
    const float* ln1g = F.a->in[18]; const float* ln1b = F.a->in[19]; const float* w_router = F.a->in[20]; const float* b_router = F.a->in[21];
    u32x2* REG = (u32x2*)(F.ws + WS_REG); unsigned* CNT = (unsigned*)(F.ws + WS_CTL) + CW_CNT;
    constexpr int TST = 2064;
    LAS unsigned char* THI = F.lds; LAS unsigned char* TLO = F.lds + 16 * TST; LAS float* PART = (LAS float*)(F.lds + 32 * TST);
    LAS unsigned* lcnt = (LAS unsigned*)(F.lds + LDS_AUX); LAS unsigned* lbase = lcnt + 32; LAS unsigned* ent = lcnt + 64;
    const int tid = F.tid, lane = F.lane, wid = F.wave, fr = lane & 15, fq = lane >> 4;
    bf16x8 whi[4][2], wlo[4][2];
#pragma unroll
    for (int ks = 0; ks < 4; ++ks)
#pragma unroll
        for (int ct = 0; ct < 2; ++ct) { float wv[8];
#pragma unroll
            for (int i = 0; i < 8; ++i) wv[i] = w_router[(size_t)(128 * wid + 32 * ks + 8 * fq + i) * 32 + ct * 16 + fr];
            u32x4 h, l2;
#pragma unroll
            for (int i = 0; i < 4; ++i) { const unsigned hp = cvt_pk_bf16(wv[2 * i], wv[2 * i + 1]); const float r0 = wv[2 * i] - bflo(hp), r1 = wv[2 * i + 1] - bfhi(hp); h[i] = hp; l2[i] = cvt_pk_bf16(r0, r1); }
            whi[ks][ct] = __builtin_bit_cast(bf16x8, h); wlo[ks][ct] = __builtin_bit_cast(bf16x8, l2); }
    const float brl = b_router[lane & 31];
    f32x4 lg[4], lb[4];
#pragma unroll
    for (int j = 0; j < 4; ++j) { lg[j] = *((const f32x4*)ln1g + lane + 64 * j); lb[j] = *((const f32x4*)ln1b + lane + 64 * j); }
    for (int batch = F.bid; batch < NTOK / 256; batch += F.G) {
        const int hf = batch >> 7;
        f32x4 shv[4], scv[4];
        { const float* md = MOD + (size_t)((batch * 256) >> 11) * 6144;
#pragma unroll
          for (int j = 0; j < 4; ++j) { shv[j] = *((const f32x4*)(md + 3072) + lane + 64 * j); scv[j] = *((const f32x4*)(md + 4096) + lane + 64 * j); } }
        __syncthreads();
        if (tid < 32) lcnt[tid] = 0u;
        for (int grp = 0; grp < 16; ++grp) {
#pragma unroll
            for (int tt = 0; tt < 2; ++tt) {
                const int tg16 = 2 * wid + tt, m = batch * 256 + grp * 16 + tg16; const float* md = MOD + (size_t)(m >> 11) * 6144;
                const u32x2* vr = (const u32x2*)(VB + (size_t)m * D) + lane; u32x2* xr = (u32x2*)(X1B + (size_t)m * D) + lane;
                f32x4 v[4]; float s = 0.f;
#pragma unroll
                for (int j = 0; j < 4; ++j) { const u32x2 w = vr[64 * j]; v[j] = (f32x4){bflo(w.x), bfhi(w.x), bflo(w.y), bfhi(w.y)}; s += (v[j][0] + v[j][1]) + (v[j][2] + v[j][3]); }
                float mean = wave_sum(s) * (1.f / D), s2 = 0.f;
#pragma unroll
                for (int j = 0; j < 4; ++j) { v[j] = v[j] - mean; s2 += (v[j][0] * v[j][0] + v[j][1] * v[j][1]) + (v[j][2] * v[j][2] + v[j][3] * v[j][3]); }
                float rstd = 1.f / sqrtf(wave_sum(s2) * (1.f / D) + LN_EPS);
                s = 0.f;
#pragma unroll
                for (int j = 0; j < 4; ++j) { v[j] = v[j] * rstd * lg[j] + lb[j]; if (!DRY) { u32x2 w; w.x = cvt_pk_bf16(v[j][0], v[j][1]); w.y = cvt_pk_bf16(v[j][2], v[j][3]); xr[64 * j] = w; } s += (v[j][0] + v[j][1]) + (v[j][2] + v[j][3]); }
                mean = wave_sum(s) * (1.f / D); s2 = 0.f;
#pragma unroll
                for (int j = 0; j < 4; ++j) { v[j] = v[j] - mean; s2 += (v[j][0] * v[j][0] + v[j][1] * v[j][1]) + (v[j][2] * v[j][2] + v[j][3] * v[j][3]); }
                rstd = 1.f / sqrtf(wave_sum(s2) * (1.f / D) + LN_EPS);
                u32x2* o8 = (u32x2*)(U2 + (size_t)m * D) + lane;
#pragma unroll
                for (int j = 0; j < 4; ++j) {
                    v[j] = v[j] * rstd * (scv[j] + 1.0f) + shv[j]; u32x2 w; w.x = cvt_pk_bf16(v[j][0], v[j][1]); w.y = cvt_pk_bf16(v[j][2], v[j][3]);
                    if (DRY) { if (w.x == 0x12345678u) o8[64 * j] = w; }
                    else if (MOE_FP8) { int pk = 0; pk = __builtin_amdgcn_cvt_pk_fp8_f32(v[j][0], v[j][1], pk, false); pk = __builtin_amdgcn_cvt_pk_fp8_f32(v[j][2], v[j][3], pk, true); ((unsigned*)((unsigned char*)U2 + (size_t)m * D))[lane + 64 * j] = (unsigned)pk; }
                    else o8[64 * j] = w;
                    u32x2 lo; lo.x = cvt_pk_bf16(v[j][0] - bflo(w.x), v[j][1] - bfhi(w.x)); lo.y = cvt_pk_bf16(v[j][2] - bflo(w.y), v[j][3] - bfhi(w.y));
                    *(LAS u32x2*)(THI + tg16 * TST + (4 * lane + 256 * j) * 2) = w; *(LAS u32x2*)(TLO + tg16 * TST + (4 * lane + 256 * j) * 2) = lo; }
            }
            __syncthreads();
            { f32x4 a0 = (f32x4){0.f, 0.f, 0.f, 0.f}, a1 = a0;
#pragma unroll
              for (int ks = 0; ks < 4; ++ks) { const int cb = (128 * wid + 32 * ks + 8 * fq) * 2;
                  const bf16x8 th = *(const LAS bf16x8*)(THI + fr * TST + cb), tl = *(const LAS bf16x8*)(TLO + fr * TST + cb);
                  a0 = __builtin_amdgcn_mfma_f32_16x16x32_bf16(whi[ks][0], th, a0, 0, 0, 0); a1 = __builtin_amdgcn_mfma_f32_16x16x32_bf16(whi[ks][1], th, a1, 0, 0, 0);
                  a0 = __builtin_amdgcn_mfma_f32_16x16x32_bf16(wlo[ks][0], th, a0, 0, 0, 0); a1 = __builtin_amdgcn_mfma_f32_16x16x32_bf16(wlo[ks][1], th, a1, 0, 0, 0);
                  a0 = __builtin_amdgcn_mfma_f32_16x16x32_bf16(whi[ks][0], tl, a0, 0, 0, 0); a1 = __builtin_amdgcn_mfma_f32_16x16x32_bf16(whi[ks][1], tl, a1, 0, 0, 0); }
              *(LAS f32x4*)(PART + (wid * 16 + fr) * 32 + 4 * fq) = a0; *(LAS f32x4*)(PART + (wid * 16 + fr) * 32 + 16 + 4 * fq) = a1; }
            __syncthreads();
            { const int tg16 = 2 * wid + (lane >> 5), tl = grp * 16 + tg16, myexp = lane & 31;
              float logit = brl;
#pragma unroll
              for (int w8 = 0; w8 < 8; ++w8) logit += PART[(w8 * 16 + tg16) * 32 + myexp];
              float tv[4]; int tix[4];
#pragma unroll
              for (int k = 0; k < 4; ++k) { float bv = logit; int bi = myexp;
#define RT_STEP(ctrl, rm) do { const float ov = __builtin_bit_cast(float, __builtin_amdgcn_update_dpp((int)0xff800000u, __builtin_bit_cast(int, bv), (ctrl), (rm), 0xf, false)); \
                      const int oi = __builtin_amdgcn_update_dpp(64, bi, (ctrl), (rm), 0xf, false); if (ov > bv || (ov == bv && oi < bi)) { bv = ov; bi = oi; } } while (0)
                  RT_STEP(0x111, 0xf); RT_STEP(0x112, 0xf); RT_STEP(0x114, 0xf); RT_STEP(0x118, 0xf); RT_STEP(0x142, 0xa);
#undef RT_STEP
                  { const int b0 = __builtin_amdgcn_readlane(__builtin_bit_cast(int, bv), 31), b1 = __builtin_amdgcn_readlane(__builtin_bit_cast(int, bv), 63), i0 = __builtin_amdgcn_readlane(bi, 31), i1 = __builtin_amdgcn_readlane(bi, 63);
                    bv = __builtin_bit_cast(float, lane < 32 ? b0 : b1); bi = lane < 32 ? i0 : i1; }
                  tv[k] = bv; tix[k] = bi; if (myexp == bi) logit = -INFINITY; }
              const float e1 = __expf(tv[1] - tv[0]), e2 = __expf(tv[2] - tv[0]), e3 = __expf(tv[3] - tv[0]); const float inv = 1.f / (1.f + e1 + e2 + e3);
              if (myexp < 4) { const int ee = myexp == 0 ? tix[0] : (myexp == 1 ? tix[1] : (myexp == 2 ? tix[2] : tix[3])); const float gg = (myexp == 0 ? 1.f : (myexp == 1 ? e1 : (myexp == 2 ? e2 : e3))) * inv;
                  const unsigned lp = atomicAdd((unsigned*)&lcnt[ee], 1u);
                  LAS unsigned* en = ent + (tl * 4 + myexp) * 3; en[0] = (unsigned)ee; en[1] = lp; en[2] = __float_as_uint(gg);
                  if (DBG_CHECK == 1) { u32x2 rw; rw.x = (unsigned)ee; rw.y = __float_as_uint(gg); ((u32x2*)(F.ws + WS_DBG))[(size_t)(batch * 256 + tl) * 4 + myexp] = rw; } } }
        }
        __syncthreads();
        if (tid < 32) lbase[tid] = DRY ? 0u : __hip_atomic_fetch_add(CNT + 64 * (hf * 32 + tid), lcnt[tid], __ATOMIC_RELAXED, __HIP_MEMORY_SCOPE_AGENT);
        __syncthreads();
        for (int i = tid; i < 1024; i += NTHR) { const LAS unsigned* en = ent + i * 3; const unsigned ee = en[0], pos = lbase[ee] + en[1];
            const unsigned tokl = (unsigned)(batch * 256 + (i >> 2)) - (unsigned)hf * HALF_TOK;
            u32x2 w; w.x = tokl * 4u + (unsigned)(i & 3); w.y = en[2];
            if (!DRY && pos < (unsigned)REG_CAP) REG[((size_t)hf * 32 + ee) * REG_CAP + pos] = w; }
    }
}

template <bool DRY = false> __device__ __forceinline__ void ph_final(Frame& F, int hf) {
    float* OUT = (float*)F.outb; const bf16_t* X1B = (const bf16_t*)(F.ws + WS_X1B); const bf16_t* YB = (const bf16_t*)(F.ws + WS_YB); const float* MOD = (const float*)(F.ws + WS_MOD);
    const float* g2 = F.a->in[26]; const float* b2 = F.a->in[27];
    const int gw = F.bid * NWAVES + F.wave, NGW = F.G * NWAVES, lane = F.lane;
    constexpr int RB = 2;
    f32x4 g2v[4], b2v[4];
#pragma unroll
    for (int j = 0; j < 4; ++j) { g2v[j] = *((const f32x4*)g2 + lane + 64 * j); b2v[j] = *((const f32x4*)b2 + lane + 64 * j); }
    const int RPW = (((HALF_TOK + NGW - 1) / NGW) + RB - 1) / RB * RB, tbeg = gw * RPW, tend = (tbeg + RPW < HALF_TOK) ? tbeg + RPW : HALF_TOK;
    f32x4 gtv[4]; int curb = -1;
    for (int tl0 = tbeg; tl0 < tend; tl0 += RB) {
        { const int bb = (hf * HALF_TOK + tl0) >> 11; if (bb != curb) { curb = bb; const float* md = MOD + (size_t)bb * 6144 + 5120;
#pragma unroll
            for (int j = 0; j < 4; ++j) gtv[j] = *((const f32x4*)md + lane + 64 * j); } }
        u32x2 xw[RB][4]; u32x2 yw[RB][4][4];
#pragma unroll
        for (int r = 0; r < RB; ++r) { const int tl = tl0 + r, m = hf * HALF_TOK + tl;
            const u32x2* xr = (const u32x2*)(X1B + (size_t)m * D) + lane; const u32x2* yr = (const u32x2*)(YB + (size_t)tl * 4 * D) + lane;
#pragma unroll
            for (int j = 0; j < 4; ++j) { xw[r][j] = __builtin_nontemporal_load(xr + 64 * j);
#pragma unroll
                for (int k = 0; k < 4; ++k) yw[r][j][k] = __builtin_nontemporal_load(yr + k * 256 + 64 * j); } }
#pragma unroll
        for (int r = 0; r < RB; ++r) { const int tl = tl0 + r, m = hf * HALF_TOK + tl;
            f32x4* xr = (f32x4*)(OUT + (size_t)m * D) + lane;
            f32x4 v[4]; float s = 0.f;
#pragma unroll
            for (int j = 0; j < 4; ++j) { f32x4 y = (f32x4){0.f, 0.f, 0.f, 0.f};
#pragma unroll
                for (int k = 0; k < 4; ++k) { const u32x2 w = yw[r][j][k]; y[0] += bflo(w.x); y[1] += bfhi(w.x); y[2] += bflo(w.y); y[3] += bfhi(w.y); }
                if (DBG_NO_MOE) y = (f32x4){0.f, 0.f, 0.f, 0.f};
                const f32x4 gt = gtv[j];
                const f32x4 x1v = (f32x4){bflo(xw[r][j].x), bfhi(xw[r][j].x), bflo(xw[r][j].y), bfhi(xw[r][j].y)};
                v[j] = x1v * DN_ALPHA + gt * y; s += (v[j][0] + v[j][1]) + (v[j][2] + v[j][3]); }
            const float mean = wave_sum(s) * (1.f / D); float s2 = 0.f;
#pragma unroll
            for (int j = 0; j < 4; ++j) { v[j] = v[j] - mean; s2 += (v[j][0] * v[j][0] + v[j][1] * v[j][1]) + (v[j][2] * v[j][2] + v[j][3] * v[j][3]); }
            const float rstd = 1.f / sqrtf(wave_sum(s2) * (1.f / D) + LN_EPS);
#pragma unroll
            for (int j = 0; j < 4; ++j) { const f32x4 ov = v[j] * rstd * g2v[j] + b2v[j]; if (!DRY || ov[0] == 1.2345e-33f) __builtin_nontemporal_store(ov, xr + 64 * j); } }
    }
}

__device__ __forceinline__ float block_sum(Frame& F, float v, LAS float* red) {
    v = wave_sum(v); __syncthreads(); if (F.lane == 0) red[F.wave] = v; __syncthreads();
    float s = 0.f; for (int w = 0; w < NWAVES; ++w) s += red[w]; return s;
}
__device__ __forceinline__ float block_max(Frame& F, float v, LAS float* red) {
#pragma unroll
    for (int o = 1; o < 64; o <<= 1) v = fmaxf(v, __shfl_xor(v, o));
    __syncthreads(); if (F.lane == 0) red[F.wave] = v; __syncthreads();
    float s = 0.f; for (int w = 0; w < NWAVES; ++w) s = fmaxf(s, red[w]); return s;
}
__device__ __forceinline__ void dbg_report(Frame& F, float e) { if (F.tid == 0) atomicMax((unsigned*)(F.ws + WS_CTL) + CW_DBG, __float_as_uint(e)); }
__device__ __forceinline__ void dbg_check_moe(Frame& F) {
    if (F.bid >= 64) return;
    const int tok = HALF_TOK + 509 * F.bid + 3, tokl = tok - HALF_TOK, tid = F.tid;
    LAS float* u2 = (LAS float*)F.lds; LAS float* act = u2 + 1024; LAS float* red = act + 1024; LAS float* lg = red + 16;
    const bf16_t* U2 = (const bf16_t*)(F.ws + WS_U2); const bf16_t* YB = (const bf16_t*)(F.ws + WS_YB); const u32x2* RT = (const u32x2*)(F.ws + WS_DBG);
    const float* w1 = F.a->in[22]; const float* b1 = F.a->in[23]; const float* w2 = F.a->in[24]; const float* b2 = F.a->in[25];
    __syncthreads();
    for (int i = tid; i < 1024; i += NTHR) u2[i] = bflo((unsigned)U2[(size_t)tok * 1024 + i]);
    __syncthreads();
    float y0 = 0.f, y1 = 0.f;
    for (int k = 0; k < 4; ++k) {
        const u32x2 rw = RT[(size_t)tok * 4 + k]; const int e = (int)rw.x; const float g = __uint_as_float(rw.y);
        const float* W1 = w1 + (size_t)e * 1024 * 2048; const float* W2 = w2 + (size_t)e * 1024 * 1024;
        float h0 = b1[e * 2048 + tid], h1 = b1[e * 2048 + tid + 512], h2 = b1[e * 2048 + tid + 1024], h3 = b1[e * 2048 + tid + 1536];
        for (int c = 0; c < 1024; ++c) { const float uu = u2[c]; const float* wr = W1 + (size_t)c * 2048 + tid; h0 += uu * wr[0]; h1 += uu * wr[512]; h2 += uu * wr[1024]; h3 += uu * wr[1536]; }
        __syncthreads();
        { float gg = fminf(h0, 7.f), up = fminf(fmaxf(h2, -7.f), 7.f); act[tid] = (up + 1.f) * gg / (1.f + expf(-1.702f * gg));
          gg = fminf(h1, 7.f); up = fminf(fmaxf(h3, -7.f), 7.f); act[tid + 512] = (up + 1.f) * gg / (1.f + expf(-1.702f * gg)); }
        __syncthreads();
        float a0 = b2[e * 1024 + tid], a1 = b2[e * 1024 + tid + 512];
        for (int j = 0; j < 1024; ++j) { const float aa = act[j]; a0 += aa * W2[(size_t)j * 1024 + tid]; a1 += aa * W2[(size_t)j * 1024 + tid + 512]; }
        y0 += g * a0; y1 += g * a1;
    }
    float f0 = 0.f, f1 = 0.f;
    for (int k = 0; k < 4; ++k) { f0 += bflo((unsigned)YB[((size_t)tokl * 4 + k) * 1024 + tid]); f1 += bflo((unsigned)YB[((size_t)tokl * 4 + k) * 1024 + tid + 512]); }
    const float rms = sqrtf(block_sum(F, y0 * y0 + y1 * y1, red) * (1.f / 1024.f)) + 1e-20f;
    float err = block_max(F, fmaxf(fabsf(y0 - f0), fabsf(y1 - f1)), red) / rms;
    { const float* X1 = (const float*)F.outb + (size_t)tok * 1024; const float* md = (const float*)(F.ws + WS_MOD) + (size_t)(tok >> 11) * 6144;
      const float xa = X1[tid], xb = X1[tid + 512]; const float mean = block_sum(F, xa + xb, red) * (1.f / 1024.f);
      const float da = xa - mean, db = xb - mean; const float var = block_sum(F, da * da + db * db, red) * (1.f / 1024.f); const float rstd = 1.f / sqrtf(var + LN_EPS);
      __syncthreads();
      u2[tid] = da * rstd * (1.f + md[4096 + tid]) + md[3072 + tid]; u2[tid + 512] = db * rstd * (1.f + md[4096 + tid + 512]) + md[3072 + tid + 512];
      __syncthreads();
      if (tid < 32) { float a = F.a->in[21][tid]; for (int c = 0; c < 1024; ++c) a += u2[c] * F.a->in[20][c * 32 + tid]; lg[tid] = a; }
      __syncthreads();
      if (tid == 0) { unsigned want = 0u, got = 0u; float l2[32]; for (int i = 0; i < 32; ++i) l2[i] = lg[i];
          for (int k = 0; k < 4; ++k) { int bi = 0; for (int i = 1; i < 32; ++i) if (l2[i] > l2[bi]) bi = i; want |= 1u << bi; l2[bi] = -INFINITY; got |= 1u << RT[(size_t)tok * 4 + k].x; }
          lg[32] = (want != got) ? 1.f : 0.f; }
      __syncthreads();
      if (lg[32] != 0.f) err = 50.f; }
    dbg_report(F, err);
}
__device__ __forceinline__ void dbg_check_ssd(Frame& F) {
    if (F.bid >= 2) return;
    const int b = F.bid ? 20 : 5, h = F.bid ? 14 : 3, g = h >> 2, tid = F.tid, p = tid >> 3, ng = tid & 7;
    LAS float* red = (LAS float*)F.lds; LAS float* cv = red + 16;
    const bf16_t* XBC = (const bf16_t*)(F.ws + WS_XBC); const bf16_t* ZS = (const bf16_t*)(F.ws + WS_Z); const float* DT = (const float*)(F.outb + OUT_DT); const bf16_t* YG = (const bf16_t*)(F.ws + WS_Q);
    const float* cw = F.a->in[9]; const float* cb = F.a->in[10]; const float aneg = -expf(F.a->in[12][h]), dsk = F.a->in[13][h];
    const int mych = tid < 64 ? h * 64 + tid : (tid < 192 ? 1024 + g * 128 + (tid - 64) : 1536 + g * 128 + (tid - 192));
    float w0 = 0.f, w1 = 0.f, w2 = 0.f, w3 = 0.f, wb = 0.f;
    if (tid < 320) { w0 = cw[0 * 2048 + mych]; w1 = cw[1 * 2048 + mych]; w2 = cw[2 * 2048 + mych]; w3 = cw[3 * 2048 + mych]; wb = cb[mych]; }
    float x0 = 0.f, x1 = 0.f, x2 = 0.f;
    float hs[16];
#pragma unroll
    for (int i = 0; i < 16; ++i) hs[i] = 0.f;
    float emax = 0.f, ssq = 0.f, nbad = 0.f; int tmax = 0;
    for (int t = 0; t < SEQ; ++t) {
        const size_t tok = (size_t)b * SEQ + t;
        __syncthreads();
        if (DBG_HYP == 1 && (t & 63) == 0) { x0 = 0.f; x1 = 0.f; x2 = 0.f; }
        if (tid < 320) { const float x3 = bflo((unsigned)XBC[tok * 2048 + mych]); const float s = wb + w0 * x0 + w1 * x1 + w2 * x2 + w3 * x3; cv[tid] = s / (1.f + expf(-s)); x0 = x1; x1 = x2; x2 = x3; }
        __syncthreads();
        const float xv = cv[p], dt = DT[tok * 16 + h], dec = expf(dt * aneg);
        float yp = 0.f;
#pragma unroll
        for (int i = 0; i < 16; ++i) { const int n = ng * 16 + i; hs[i] = hs[i] * dec + dt * xv * cv[64 + n]; yp += cv[192 + n] * hs[i]; }
        yp += __shfl_xor(yp, 1); yp += __shfl_xor(yp, 2); yp += __shfl_xor(yp, 4);
        const float yv = (yp + xv * dsk) * bflo((unsigned)ZS[tok * 1024 + h * 64 + p]);
        const float yf = bflo((unsigned)YG[tok * 1024 + h * 64 + p]);
        if (ng == 0) { const float er = fabsf(yv - yf); if (er > emax) { emax = er; tmax = t; } ssq += yv * yv; if (er > 0.25f && (DBG_SUB < 5 || (DBG_SUB == 5 && (t & 63) == 0) || (DBG_SUB == 6 && (t & 63) == 1) || (DBG_SUB == 7 && (t & 63) == 32))) nbad += 1.f; }
    }
    const float rms = sqrtf(block_sum(F, ssq, red) / (64.f * SEQ)) + 1e-20f;
    const float M = block_max(F, emax, red);
    if (DBG_SUB == 0) dbg_report(F, M / rms);
    else if (DBG_SUB == 1) dbg_report(F, block_sum(F, nbad, red) / (64.f * SEQ));
    else if (DBG_SUB >= 5) dbg_report(F, block_sum(F, nbad, red) / (64.f * 32.f));
    else { __syncthreads(); if (ng == 0 && emax == M) red[12] = (float)(DBG_SUB == 2 ? ((tmax & 63) >> 1) : (DBG_SUB == 3 ? (tmax >> 6) : (p >> 1))); __syncthreads();
        if (F.bid == 0) dbg_report(F, powf(10.f, 2.f * (0.05f + 0.05f * red[12]) - 4.f)); }
}
__device__ __forceinline__ void dbg_check_attn(Frame& F) {
    if (F.bid >= 32) return;
    const int b = (F.bid * 7 + 3) & 31, pos = 300 + F.bid * 53, nadm = ((pos >> 6) + 1) * 64, tid = F.tid, lane = F.lane, hd = F.wave;
    const size_t tq = (size_t)b * SEQ + pos;
    LAS float* sc = (LAS float*)F.lds; LAS unsigned char* sel = (LAS unsigned char*)(sc + 2048); LAS float* lgt = (LAS float*)(sel + 2048); LAS float* red = lgt + 8 * 2048; LAS float* misc = red + 16;
    const bf16_t* IQ = (const bf16_t*)(F.outb + OUT_IQ); const bf16_t* IK = (const bf16_t*)(F.outb + OUT_IK); const float* IW = (const float*)(F.outb + OUT_IW);
    const bf16_t* Q = (const bf16_t*)(F.ws + WS_Q); const bf16_t* KV = (const bf16_t*)(F.outb + OUT_KV); const bf16_t* OA = (const bf16_t*)(F.outb + OUT_OA); const u64* MASK = (const u64*)(F.outb + OUT_MASK);
    __syncthreads();
    for (int k = tid; k < nadm; k += NTHR) { float s = 0.f;
        for (int hh = 0; hh < 8; ++hh) { float d = 0.f; for (int c = 0; c < 64; ++c) d += bflo((unsigned)IQ[tq * 512 + hh * 64 + c]) * bflo((unsigned)IK[((size_t)b * SEQ + k) * 64 + c]); s += fmaxf(d, 0.f) * IW[tq * 8 + hh]; }
        sc[k] = s + 0.0f; }
    __syncthreads();
    float nbad = 0.f;
    for (int k = tid; k < nadm; k += NTHR) { const float s = sc[k]; int rank = 0; for (int j = 0; j < nadm; ++j) { const float t = sc[j]; rank += (t > s || (t == s && j < k)) ? 1 : 0; }
        const unsigned char se = rank < 256 ? 1 : 0; sel[k] = se; const unsigned mb = (unsigned)((MASK[tq * 32 + (k >> 6)] >> (k & 63)) & 1ull); if (mb != se) nbad += 1.f; }
    __syncthreads();
    const float nbad_t = block_sum(F, nbad, red);
    LAS float* lw = lgt + hd * 2048; float mx = -INFINITY;
    for (int k = lane; k < nadm; k += 64) { float l = -INFINITY;
        if (sel[k]) { float d = 0.f; for (int c = 0; c < 128; ++c) d += bflo((unsigned)Q[tq * 1024 + hd * 128 + c]) * bflo((unsigned)KV[((size_t)b * SEQ + k) * 128 + c]);
            const int rel = k - pos, n = rel < 0 ? -rel : rel; const float nf = (float)(n > 1 ? n : 1); int large = 8 + (int)(logf(nf / 8.0f) / 2.7725887f * 8.0f); if (large > 15) large = 15;
            const int bucket = (rel > 0 ? 16 : 0) + (n < 8 ? n : large);
            l = d * 0.088388347648318440f + F.a->in[8][bucket * 8 + hd]; }
        lw[k] = l; mx = fmaxf(mx, l); }
#pragma unroll
    for (int o = 1; o < 64; o <<= 1) mx = fmaxf(mx, __shfl_xor(mx, o));
    float den = 0.f;
    for (int k = lane; k < nadm; k += 64) { const float pp = expf(lw[k] - mx); lw[k] = pp; den += pp; }
    den = wave_sum(den);
    float emax = 0.f, ssq = 0.f;
    for (int c2 = 0; c2 < 2; ++c2) { const int c = lane + 64 * c2; float o = 0.f; for (int k = 0; k < nadm; ++k) { const float pp = lw[k]; if (pp != 0.f) o += pp * bflo((unsigned)KV[((size_t)b * SEQ + k) * 128 + c]); }
        o /= den; const float of = bflo((unsigned)OA[tq * 1024 + hd * 128 + c]); emax = fmaxf(emax, fabsf(o - of)); ssq += o * o; }
    const float rms = sqrtf(block_sum(F, ssq, red) * (1.f / 1024.f)) + 1e-20f;
    float err = block_max(F, emax, red) / rms;
    (void)misc;
    if (nbad_t > 0.f) err = 10.f + nbad_t;
    dbg_report(F, err);
}
__device__ __forceinline__ void dbg_emit(Frame& F) {
    float* out = (float*)F.outb;
    for (size_t i = (size_t)F.bid * NTHR + F.tid; i < (size_t)NTOK * D / 4; i += (size_t)F.G * NTHR) ((f32x4*)out)[i] = (f32x4){0.f, 0.f, 0.f, 0.f};
    __syncthreads();
    if (F.bid == 0 && F.tid == 0) { const float e = __uint_as_float(__hip_atomic_load((unsigned*)(F.ws + WS_CTL) + CW_DBG, __ATOMIC_RELAXED, __HIP_MEMORY_SCOPE_AGENT));
        float code = (log10f(fmaxf(e, 1e-30f)) + 4.f) * 0.5f; code = fminf(fmaxf(rintf(code * 20.f) * 0.05f, 0.05f), 3.0f);
        out[0] = sqrtf(67108864.f * 1.01f * (powf(10.f, code) - 1.f)); }
}

#define CLK_BEGIN(k) unsigned long long clk_c##k = 0, clk_r##k = 0; if (DBG_CLOCK == (k) + 1) { clk_c##k = __builtin_amdgcn_s_memtime(); clk_r##k = __builtin_amdgcn_s_memrealtime(); }
#define CLK_END(k) if (DBG_CLOCK == (k) + 1 && F.bid == 0) { const float ghz = (float)(__builtin_amdgcn_s_memtime() - clk_c##k) / (float)(__builtin_amdgcn_s_memrealtime() - clk_r##k) * 0.1f; dbg_report(F, powf(10.f, 2.f * (rintf(ghz * 5.f) * 0.2f) - 4.f)); }
constexpr int NPHASE = 17;
__global__ void __launch_bounds__(NTHR, 2) fwd(Args args) {
    extern __shared__ __attribute__((aligned(16))) unsigned char lds_raw[];
    Frame F;
    F.lds = (LAS unsigned char*)lds_raw;
    F.tid = threadIdx.x; F.lane = F.tid & 63; F.wave = __builtin_amdgcn_readfirstlane(F.tid >> 6); F.G = gridDim.x; F.bid = blockIdx.x;
    F.a = &args;
    F.ws = args.ws; F.outb = (unsigned char*)args.out;
    volatile LAS unsigned* MISCW = (volatile LAS unsigned*)(F.lds + LDS_MISC);
    if (F.tid < 64) MISCW[F.tid] = 0u;
    __syncthreads();
    XcdBarrier bar; bar.bar = (unsigned*)(F.ws + WS_CTL) + CW_BAR; bar.x = 0; bar.st = nullptr;
#if MK_ONE
    bar = xcd_barrier_post((unsigned*)(F.ws + WS_CTL) + CW_BAR, MISCW + 8);
#define GRID_BAR() xcd_barrier(bar)
#else
#define GRID_BAR() do { } while (0)
#endif
    const int lo = args.ph_lo, hi = args.ph_hi;
#ifndef PHM
#define PHM (0xFFFFFFFFu & ~(DBG_NO_ATTN ? 0x30u : 0u) & ~(DBG_NO_SSD ? 0xC0u : 0u))
#endif
#define IN(k) (((PHM >> (k)) & 1u) && lo <= (k) && (k) < hi)
#define SEAM(k) do { if ((k) + 1 < hi) GRID_BAR(); } while (0)

    if (IN(0)) {
#pragma nounroll
        for (int rep = 0; rep < ((DBG_TWICE & 1u) ? 2 : 1); ++rep) { if (rep) GRID_BAR(); ph_prologue(F); }
        SEAM(0); }
    if (IN(1)) {
#pragma nounroll
        for (int rep = 0; rep < ((DBG_TWICE & 2u) ? 2 : 1); ++rep) { if (rep) GRID_BAR(); ph_ln1(F); }
        SEAM(1); }
    CLK_BEGIN(2);
    if (IN(2)) {
        EpiProj E{(bf16_t*)(F.ws + WS_Q), (bf16_t*)(F.outb + OUT_IQ), (bf16_t*)(F.ws + WS_Z), (bf16_t*)(F.ws + WS_XBC), (bf16_t*)(F.ws + WS_GA), (bf16_t*)(F.ws + WS_GB), (float*)(F.outb + OUT_MISC), 1.0f};
#if PROJ_FP8
        { SchedProj<2> S; S.o.init(NTOK, 12 * 256, F.G, F.bid); S.A = (const char*)(F.ws + WS_U8); S.Bt = (const char*)(F.ws + WS_WIN8);
          EpiProj E8 = E; E8.sc = MOE_INV;
          pg8::gemm_phase<EpiProj, SchedProj<2>, false, 512, true>(F.lds, S, E8);
          if (DBG_TWICE & 32768u) { GRID_BAR(); pg8::gemm_phase<EpiProj, SchedProj<2>, false, 512, true>(F.lds, S, E8); } }
        { SchedProj<1> S; S.o.init(NTOK, 15 * 256, F.G, F.bid); S.A = (const char*)(F.outb + OUT_U); S.Bt = (const char*)(F.ws + WS_WIN); if (DBG_KCLK) S.dbgw = (unsigned*)(F.ws + WS_CTL) + CW_DBG;
#if DBG_DRYPROJ
#pragma nounroll
          for (int rep = 0; rep < 2; ++rep) { EpiProj Ed = E; Ed.dry = rep == 0; SchedProj<1> Sd = S; Sd.fold = rep == 0 ? 7 : 0x7fffffff; pg8::gemm_phase<EpiProj, SchedProj<1>, false>(F.lds, Sd, Ed); if (rep == 0) GRID_BAR(); }
#else
          const unsigned long long w0 = DBG_WALL ? __builtin_amdgcn_s_memrealtime() : 0ull;
          pg8::gemm_phase<EpiProj, SchedProj<1>, false>(F.lds, S, E);
          if (DBG_WALL && F.bid == 0) { const float us = (float)(__builtin_amdgcn_s_memrealtime() - w0) * 0.01f; dbg_report(F, powf(10.f, 2.f * (rintf(us / 300.f * 10.f) * 0.1f) - 4.f)); }
#endif
          if (DBG_TWICE & 4u) { GRID_BAR(); pg8::gemm_phase<EpiProj, SchedProj<1>, false>(F.lds, S, E); } }
#else
        { SchedProj<0> S; S.o.init(NTOK, NPROJ, F.G, F.bid); S.A = (const char*)(F.outb + OUT_U); S.Bt = (const char*)(F.ws + WS_WIN);
          pg8::gemm_phase<EpiProj, SchedProj<0>, false>(F.lds, S, E);
          if (DBG_TWICE & 4u) { GRID_BAR(); pg8::gemm_phase<EpiProj, SchedProj<0>, false>(F.lds, S, E); } }
#endif
        SEAM(2);
    }
    CLK_END(2);
    if (IN(3)) { ph_misc(F); if (DBG_TWICE & 8u) { GRID_BAR(); ph_misc(F); } SEAM(3); }
    if (IN(4)) {
#pragma nounroll
        for (int rep = 0; rep < DBG_REP4; ++rep) { if (rep) GRID_BAR(); ph_index(F, rep + 1 < DBG_REP4 ? DBG_ABL4 : 0); }
        SEAM(4); }
    if (IN(5)) { ph_attn(F); if (DBG_TWICE & 32u) { GRID_BAR(); ph_attn(F); } SEAM(5); if (DBG_CHECK == 3) { dbg_check_attn(F); GRID_BAR(); } }
    if (IN(6)) {
#pragma nounroll
        for (int rep = 0; rep < DBG_REP6; ++rep) { if (rep) GRID_BAR(); ph_ssd2(F, rep + 1 < DBG_REP6 ? DBG_ABL6 : 0); }
        SEAM(6); if (DBG_CHECK == 2) { dbg_check_ssd(F); GRID_BAR(); } }
    if (IN(7)) { ph_gnorm(F); if (DBG_TWICE & 128u) { GRID_BAR(); ph_gnorm(F); } SEAM(7); }
    if (IN(8)) {
#if PA_FP8
        SchedPlainT<1024> S; S.o.init(NTOK, 1024, F.G, F.bid); S.A = (const char*)(F.outb + OUT_OA); S.Bt = (const char*)(F.ws + WS_WPA8);
        EpiGate<0> E{(const bf16_t*)(F.ws + WS_GA), nullptr, (bf16_t*)(F.ws + WS_Z), MOE_INV};
        pg8::gemm_phase<EpiGate<0>, SchedPlainT<1024>, false, 512, true>(F.lds, S, E);
#else
        SchedPlain S; S.o.init(NTOK, 1024, F.G, F.bid); S.A = (const char*)(F.outb + OUT_OA); S.Bt = (const char*)(F.ws + WS_WPA);
        EpiGate<0> E{(const bf16_t*)(F.ws + WS_GA), nullptr, (bf16_t*)(F.ws + WS_Z), 1.0f};
        pg8::gemm_phase<EpiGate<0>, SchedPlain, false>(F.lds, S, E);
#endif
    }
    if (IN(9)) {
#if PB_FP8
        SchedPlainT<1024> S; S.o.init(NTOK, 1024, F.G, F.bid); S.A = (const char*)(F.outb + OUT_OB8); S.Bt = (const char*)(F.ws + WS_WPB8);
        EpiGate<1> E{(const bf16_t*)(F.ws + WS_GB), (const bf16_t*)(F.ws + WS_Z), (bf16_t*)(F.ws + WS_XBC), MOE_INV};
        pg8::gemm_phase<EpiGate<1>, SchedPlainT<1024>, false, 512, true>(F.lds, S, E);
#else
        SchedPlain S; S.o.init(NTOK, 1024, F.G, F.bid); S.A = (const char*)(F.ws + WS_Q); S.Bt = (const char*)(F.ws + WS_WPB);
        EpiGate<1> E{(const bf16_t*)(F.ws + WS_GB), (const bf16_t*)(F.ws + WS_Z), (bf16_t*)(F.ws + WS_XBC), 1.0f};
        pg8::gemm_phase<EpiGate<1>, SchedPlain, false>(F.lds, S, E);
#endif
        SEAM(9);
    }
    if (IN(10)) {
        SchedPlain S; S.o.init(NTOK, 1024, F.G, F.bid); S.A = (const char*)(F.ws + WS_XBC); S.Bt = (const char*)(F.ws + WS_WOUT);
        EpiOut E{F.a->in[0], (const float*)(F.ws + WS_MOD), (bf16_t*)(F.ws + WS_VB)};
        pg8::gemm_phase<EpiOut, SchedPlain, false>(F.lds, S, E);
        if (DBG_TWICE & 1024u) { GRID_BAR(); pg8::gemm_phase<EpiOut, SchedPlain, false>(F.lds, S, E); }
        SEAM(10);
    }
    if (IN(11)) { if (DBG_TWICE & 2048u) { ph_router<true>(F); GRID_BAR(); } ph_router<false>(F); SEAM(11); }
#pragma unroll
    for (int hf = 0; hf < 2; ++hf) {
        const int p0 = 12 + hf * 2;
        if (IN(p0)) {
            if (hf == 1) ph_final<false>(F, 0);
            MoeTab T = moe_tables(F, hf);
            SchedMoe<8, true> S{T, F.G, F.bid, hf, (const char*)(F.ws + WS_U2), (const char*)(F.ws + WS_W1), (const u32x2*)(F.ws + WS_REG)};
            EpiMoe1 E{F.a->in[23], (bf16_t*)(F.ws + WS_ACT), 0};
            pg8::gemm_phase<EpiMoe1, SchedMoe<8, true>, true, MOE_RB / 2, MOE_FP8 != 0>(F.lds, S, E);
            if ((DBG_TWICE & 4096u) && hf == 0) { GRID_BAR(); pg8::gemm_phase<EpiMoe1, SchedMoe<8, true>, true, MOE_RB / 2, MOE_FP8 != 0>(F.lds, S, E); }
            if ((DBG_TWICE & 16384u) && hf == 0) { GRID_BAR(); EpiMoe1 Ed = E; Ed.dry = 1; pg8::gemm_phase<EpiMoe1, SchedMoe<8, true>, true, MOE_RB / 2, MOE_FP8 != 0>(F.lds, S, Ed); }
            SEAM(p0);
        }
        if (IN(p0 + 1)) {
            MoeTab T = moe_tables(F, hf);
            SchedMoe<4, false> S{T, F.G, F.bid, hf, (const char*)(F.ws + WS_ACT), (const char*)(F.ws + WS_W2), (const u32x2*)(F.ws + WS_REG)};
            EpiMoe2 E{F.a->in[25], (bf16_t*)(F.ws + WS_YB), (const u32x2*)(F.ws + WS_REG), T, hf, 0};
            if ((DBG_TWICE & 262144u) && hf == 0) { EpiMoe2 Ed = E; Ed.dry = DBG_DRYMODE; pg8::gemm_phase<EpiMoe2, SchedMoe<4, false>, false, MOE_RB / 2, MOE_FP8 != 0>(F.lds, S, Ed); GRID_BAR(); }
            pg8::gemm_phase<EpiMoe2, SchedMoe<4, false>, false, MOE_RB / 2, MOE_FP8 != 0>(F.lds, S, E);
            if ((DBG_TWICE & 8192u) && hf == 0) { GRID_BAR(); pg8::gemm_phase<EpiMoe2, SchedMoe<4, false>, false, MOE_RB / 2, MOE_FP8 != 0>(F.lds, S, E); }
            if ((DBG_TWICE & 131072u) && hf == 0) { GRID_BAR(); EpiMoe2 Ed = E; Ed.dry = 1; pg8::gemm_phase<EpiMoe2, SchedMoe<4, false>, false, MOE_RB / 2, MOE_FP8 != 0>(F.lds, S, Ed); }
            SEAM(p0 + 1);
            if (DBG_CHECK == 1 && hf == 1) { dbg_check_moe(F); GRID_BAR(); }
        }
    }
    if (IN(16)) { if (DBG_TWICE & 65536u) { ph_final<true>(F, 1); GRID_BAR(); } ph_final(F, 1); }
    if (DBG_CHECK || DBG_CLOCK || DBG_KCLK || DBG_WALL) { GRID_BAR(); dbg_emit(F); }
#undef IN
#undef SEAM
}

extern "C" void kernel_launch(void* const* d_in, const int* in_sizes, int n_in, void* d_out, int out_size, void* d_ws, size_t ws_size, hipStream_t stream) {
    static int grid = 0;
    if (grid == 0) {
        if (n_in != 28 || in_sizes[0] != NTOK * D || out_size != NTOK * D || ws_size < WS_END) { fprintf(stderr, "kernel_launch: shape mismatch (n_in %d, in0 %d, out %d, ws %zu)\n", n_in, n_in > 0 ? in_sizes[0] : -1, out_size, ws_size); grid = -1; return; }
        int dev = 0, cus = 0, per_cu = 0;
        if (hipGetDevice(&dev) != hipSuccess || hipDeviceGetAttribute(&cus, hipDeviceAttributeMultiprocessorCount, dev) != hipSuccess) { grid = -1; return; }
        if (hipFuncSetAttribute((const void*)fwd, hipFuncAttributeMaxDynamicSharedMemorySize, LDS_BYTES) != hipSuccess) { fprintf(stderr, "kernel_launch: hipFuncSetAttribute failed\n"); grid = -1; return; }
        if (hipOccupancyMaxActiveBlocksPerMultiprocessor(&per_cu, (const void*)fwd, NTHR, LDS_BYTES) != hipSuccess || per_cu < 1) fprintf(stderr, "kernel_launch: occupancy query reports %d\n", per_cu);
        (void)hipGetLastError();
        grid = cus;
    }
    if (grid < 0) return;
    if (hipMemsetAsync((char*)d_ws + WS_CTL, 0, CTL_ZERO_BYTES, stream) != hipSuccess) { fprintf(stderr, "kernel_launch: memset failed\n"); return; }
    Args a{};
    for (int i = 0; i < 28; ++i) a.in[i] = (const float*)d_in[i];
    a.out = (float*)d_out; a.ws = (unsigned char*)d_ws;
    const int nph = NPHASE < MK_PH_HI ? NPHASE : MK_PH_HI;
#if MK_ONE
    a.ph_lo = 0; a.ph_hi = nph;
    hipLaunchKernelGGL(fwd, dim3(grid), dim3(NTHR), LDS_BYTES, stream, a);
#else
    for (int p = 0; p < nph; ++p) { a.ph_lo = p; a.ph_hi = p + 1; hipLaunchKernelGGL(fwd, dim3(grid), dim3(NTHR), LDS_BYTES, stream, a); }
#endif
    const hipError_t le = hipPeekAtLastError();
    if (le != hipSuccess) fprintf(stderr, "kernel_launch: launch failed: %s\n", hipGetErrorName(le));
}
```

```cpp
#include <hip/hip_runtime.h>
#include <cstdio>
#include <cstdint>

#ifndef MK_ONE
#define MK_ONE 1
#endif
#ifndef DBG_NO_ATTN
#define DBG_NO_ATTN 0
#endif
#ifndef DBG_ATTN_ZERO
#define DBG_ATTN_ZERO 0
#endif
#ifndef DBG_IQ_TRUNC
#define DBG_IQ_TRUNC 0
#endif
#ifndef DBG_ROUTER_BF16
#define DBG_ROUTER_BF16 0
#endif
#ifndef DBG_CHECK
#define DBG_CHECK 0
#endif
#ifndef DBG_SKIP_BODY
#define DBG_SKIP_BODY 0
#endif
#ifndef DBG_SUB
#define DBG_SUB 0
#endif
#ifndef DBG_SSD_SYNC
#define DBG_SSD_SYNC 0
#endif
#ifndef DBG_HYP
#define DBG_HYP 0
#endif
#ifndef DBG_TWICE
#define DBG_DRYPROJ 0
#define DBG_ABL6 0
#define DBG_ABL4 0
#define DBG_REP4 1
#define DBG_REP6 1
#define DBG_WALL 0
#define DBG_KCLK 0
#ifndef DBG_CLOCK
#define DBG_CLOCK 0
#endif
#define DBG_TWICE 0u
#endif
#ifndef DBG_DRYMODE
#define DBG_DRYMODE 2
#endif
#ifndef DBG_NO_SSD
#define DBG_NO_SSD 0
#endif
#ifndef DBG_NO_MOE
#define DBG_NO_MOE 0
#endif
#ifndef MOE_FP8
#define MOE_FP8 1
#endif
#ifndef PROJ_FP8
#define PROJ_FP8 1
#endif
#ifndef PA_FP8
#define PA_FP8 1
#endif
#ifndef PB_FP8
#define PB_FP8 0
#endif
#ifndef ATT2
#define GATE_U8 1
#define ATT_OT 1
#define ATT2 1
#endif
#ifndef MK_PH_HI
#define MK_PH_HI 99
#endif

#define LAS __attribute__((address_space(3)))
#define GAS __attribute__((address_space(1)))
typedef unsigned short bf16_t;
typedef short bf16x8 __attribute__((ext_vector_type(8)));
typedef short s16x4 __attribute__((ext_vector_type(4)));
typedef float f32x2 __attribute__((ext_vector_type(2)));
typedef float f32x4 __attribute__((ext_vector_type(4)));
typedef float f32x16 __attribute__((ext_vector_type(16)));
typedef unsigned u32x2 __attribute__((ext_vector_type(2)));
typedef unsigned u32x4 __attribute__((ext_vector_type(4)));
typedef unsigned long long u64;

constexpr int NB = 32, SEQ = 2048, D = 1024, NTOK = NB * SEQ;
constexpr int NWAVES = 8, NTHR = 512;
constexpr int NPROJ = 6912;
constexpr int NEXP = 32, HALF_TOK = NTOK / 2, REG_CAP = HALF_TOK;
constexpr int ACT_ROWS = HALF_TOK * 4 + NEXP * 256;
constexpr float LN_EPS = 1e-5f;
constexpr float DN_ALPHA = 1.189207115002721f;
constexpr float LOG2E = 1.4426950408889634f;

constexpr size_t MiB = 1u << 20;
constexpr size_t WS_CTL = 0, CTL_ZERO_BYTES = 1 * MiB;
constexpr size_t WS_MOD = 1 * MiB;
constexpr size_t WS_BIAST = 1 * MiB + 800 * 1024;
constexpr size_t WS_WIN = 2 * MiB;
constexpr size_t WS_WPA = 16 * MiB, WS_WPB = 18 * MiB, WS_WOUT = 20 * MiB;
constexpr size_t WS_W1 = 24 * MiB;
constexpr size_t WS_U8 = 88 * MiB;
constexpr size_t WS_W2 = 152 * MiB;
constexpr size_t WS_WIN8 = 184 * MiB;
constexpr size_t WS_WPA8 = 192 * MiB;
constexpr size_t WS_WPB8 = 194 * MiB;
constexpr size_t OUT_OB8 = 192 * MiB;
constexpr size_t WS_Q = 216 * MiB;
constexpr size_t WS_Z = 344 * MiB;
constexpr size_t WS_XBC = 472 * MiB;
constexpr size_t WS_GA = 728 * MiB, WS_GB = 856 * MiB;
constexpr size_t WS_U2 = 216 * MiB;
constexpr size_t WS_REG = 344 * MiB;
constexpr size_t WS_ACT = 360 * MiB;
constexpr size_t WS_YB = 632 * MiB;
constexpr size_t WS_X1B = 496 * MiB;
constexpr size_t WS_VB = 744 * MiB;
constexpr size_t WS_END = 984 * MiB;
constexpr size_t WS_DBG = 889 * MiB;
constexpr size_t OUT_U = 0, OUT_MISC = 128 * MiB, OUT_IQ = 192 * MiB;
constexpr size_t OUT_KV = 0, OUT_IK = 16 * MiB, OUT_IW = 24 * MiB, OUT_DT = 26 * MiB, OUT_MASK = 32 * MiB, OUT_OA = 64 * MiB;
constexpr int CW_BAR = 4096, CW_CNT = 16384, CW_WQ = 22528, CW_DBG = 24576;

constexpr int LDS_BYTES = 160 * 1024;
constexpr int LDS_AUX = 131072;
constexpr int LDS_MISC = LDS_BYTES - 256;

#define LDS_WAIT() asm volatile("s_waitcnt lgkmcnt(0)" ::: "memory")
#define GAS __attribute__((address_space(1)))
#define VM_WAIT() asm volatile("s_waitcnt vmcnt(0)" ::: "memory")
#define SBAR() __builtin_amdgcn_sched_barrier(0)
typedef __bf16 bf16x2_t __attribute__((ext_vector_type(2)));
__device__ __forceinline__ unsigned cvt_pk_bf16(float lo, float hi) { f32x2 f = {lo, hi}; bf16x2_t v = __builtin_convertvector(f, bf16x2_t); return __builtin_bit_cast(unsigned, v); }
__device__ __forceinline__ float bflo(unsigned w) { return __uint_as_float(w << 16); }
__device__ __forceinline__ float bfhi(unsigned w) { return __uint_as_float(w & 0xffff0000u); }
__device__ __forceinline__ u32x4 pack8(f32x4 a, f32x4 b) { u32x4 w; w.x = cvt_pk_bf16(a[0], a[1]); w.y = cvt_pk_bf16(a[2], a[3]); w.z = cvt_pk_bf16(b[0], b[1]); w.w = cvt_pk_bf16(b[2], b[3]); return w; }
constexpr int MOE_RB = MOE_FP8 ? 1024 : 2048;
constexpr float MOE_WSC = MOE_FP8 ? 64.0f : 1.0f, MOE_INV = 1.0f / MOE_WSC;
__device__ __forceinline__ u32x2 pack8_fp8(f32x4 a, f32x4 b) { int lo = 0, hi = 0;
    lo = __builtin_amdgcn_cvt_pk_fp8_f32(a[0], a[1], lo, false); lo = __builtin_amdgcn_cvt_pk_fp8_f32(a[2], a[3], lo, true);
    hi = __builtin_amdgcn_cvt_pk_fp8_f32(b[0], b[1], hi, false); hi = __builtin_amdgcn_cvt_pk_fp8_f32(b[2], b[3], hi, true);
    u32x2 r; r.x = (unsigned)lo; r.y = (unsigned)hi; return r; }
__device__ __forceinline__ void unpack8(u32x4 w, f32x4& a, f32x4& b) { a[0] = bflo(w.x); a[1] = bfhi(w.x); a[2] = bflo(w.y); a[3] = bfhi(w.y); b[0] = bflo(w.z); b[1] = bfhi(w.z); b[2] = bflo(w.w); b[3] = bfhi(w.w); }
__device__ __forceinline__ float dpp_scan_add(float v) {
#define DPPF(x, ctrl, rm) __builtin_bit_cast(float, __builtin_amdgcn_update_dpp(0, __builtin_bit_cast(int, (x)), (ctrl), (rm), 0xf, false))
    v += DPPF(v, 0x111, 0xf); v += DPPF(v, 0x112, 0xf); v += DPPF(v, 0x114, 0xf); v += DPPF(v, 0x118, 0xf);
    v += DPPF(v, 0x142, 0xa);
    v += DPPF(v, 0x143, 0xc);
#undef DPPF
    return v;
}
__device__ __forceinline__ unsigned dpp_half_sums_u32(unsigned v) {
#define DPPU(x, ctrl, rm) (unsigned)__builtin_amdgcn_update_dpp(0, (int)(x), (ctrl), (rm), 0xf, false)
    v += DPPU(v, 0x111, 0xf); v += DPPU(v, 0x112, 0xf); v += DPPU(v, 0x114, 0xf); v += DPPU(v, 0x118, 0xf); v += DPPU(v, 0x142, 0xa);
#undef DPPU
    return v;
}
__device__ __forceinline__ float dpp_half_sums_f32(float v) {
#define DPPF(x, ctrl, rm) __builtin_bit_cast(float, __builtin_amdgcn_update_dpp(0, __builtin_bit_cast(int, (x)), (ctrl), (rm), 0xf, false))
    v += DPPF(v, 0x111, 0xf); v += DPPF(v, 0x112, 0xf); v += DPPF(v, 0x114, 0xf); v += DPPF(v, 0x118, 0xf); v += DPPF(v, 0x142, 0xa);
#undef DPPF
    return v;
}
__device__ __forceinline__ float wave_sum(float v) { v = dpp_scan_add(v); return __builtin_bit_cast(float, __builtin_amdgcn_readlane(__builtin_bit_cast(int, v), 63)); }
__device__ __forceinline__ float fast_rcp(float x) { return __builtin_amdgcn_rcpf(x); }
__device__ __forceinline__ float sigmoid_f(float x) { return fast_rcp(1.0f + __expf(-x)); }
__device__ __forceinline__ float silu_f(float x) { return x * sigmoid_f(x); }

#define XB_TMO      128
#define XB_XCNT(j)  (256  + 64 * (j))
#define XB_XSUB(j)  (1280 + 64 * (j))
#define XB_XGEN(j)  (2304 + 64 * (j))
#define XB_TOP      3328
#define XB_TOPGEN   3392
#define XCD_BAR_WORDS 3456
#define XB_SPIN_CAP (1u << 18)
__device__ __forceinline__ unsigned xb_ld(unsigned* p)              { return __hip_atomic_load(p, __ATOMIC_RELAXED, __HIP_MEMORY_SCOPE_AGENT); }
__device__ __forceinline__ unsigned xb_add(unsigned* p, unsigned v) { return __hip_atomic_fetch_add(p, v, __ATOMIC_RELAXED, __HIP_MEMORY_SCOPE_AGENT); }
__device__ __forceinline__ unsigned xb_xcc_id() { return (unsigned)__builtin_amdgcn_s_getreg((3 << 11) | 20) & 0xFu; }
#define XB_SPIN(cond, bar) do { unsigned _sp = 0; while (cond) { __builtin_amdgcn_s_sleep(1); \
    if ((++_sp & 255u) == 0u) { if (xb_ld(&(bar)[XB_TMO])) break; if (_sp > XB_SPIN_CAP) { atomicAdd(&(bar)[XB_TMO], 1u); break; } } } } while (0)
struct XcdBarrier { unsigned* bar; unsigned x; volatile LAS unsigned* st; };
__device__ __forceinline__ XcdBarrier xcd_barrier_post(unsigned* bar, volatile LAS unsigned* st) {
    XcdBarrier b; b.bar = bar; b.x = xb_xcc_id(); b.st = st;
    if (threadIdx.x == 0) (void)xb_add(&bar[XB_XCNT(b.x)], 1u);
    return b;
}
__device__ __forceinline__ void xcd_barrier_complete(unsigned* bar, unsigned x, unsigned& nloc, unsigned& nx) {
    const unsigned G = gridDim.x * gridDim.y * gridDim.z;
    unsigned sum, cnt, mine, sp = 0u;
    for (;;) {
        sum = 0u; cnt = 0u;
#pragma nounroll
        for (unsigned j = 0; j < 16; ++j) { const unsigned c = xb_ld(&bar[XB_XCNT(j)]); sum += c; cnt += (c > 0u) ? 1u : 0u; }
        if (sum == G) break;
        __builtin_amdgcn_s_sleep(1);
        if ((++sp & 255u) == 0u) { if (xb_ld(&bar[XB_TMO])) break; if (sp > XB_SPIN_CAP) { atomicAdd(&bar[XB_TMO], 1u); break; } }
    }
    mine = xb_ld(&bar[XB_XCNT(x)]);
    nloc = mine > 0u ? mine : 1u; nx = cnt > 0u ? cnt : 1u;
}
__device__ __forceinline__ void xcd_barrier(const XcdBarrier& b) {
    asm volatile("s_waitcnt vmcnt(0)" ::: "memory");
    __syncthreads();
    if (threadIdx.x == 0) {
        unsigned* bar = b.bar;
        __builtin_amdgcn_s_waitcnt(0);
        unsigned nloc = b.st[0], nx = b.st[1];
        if (nloc == 0u) { xcd_barrier_complete(bar, b.x, nloc, nx); b.st[0] = nloc; b.st[1] = nx; }
        const unsigned old = xb_add(&bar[XB_XSUB(b.x)], 1u);
        const unsigned gen = old / nloc;
        if (old + 1u == (gen + 1u) * nloc) {
            __builtin_amdgcn_fence(__ATOMIC_RELEASE, "agent");
            asm volatile("s_waitcnt vmcnt(0)" ::: "memory");
            const unsigned og = xb_add(&bar[XB_TOP], 1u);
            const unsigned tg = og / nx;
            if (og + 1u == (tg + 1u) * nx) xb_add(&bar[XB_TOPGEN], 1u);
            else XB_SPIN(xb_ld(&bar[XB_TOPGEN]) == tg, bar);
            __builtin_amdgcn_fence(__ATOMIC_ACQUIRE, "agent");
            xb_add(&bar[XB_XGEN(b.x)], 1u);
            asm volatile("s_waitcnt vmcnt(0)" ::: "memory");
        } else {
            XB_SPIN(xb_ld(&bar[XB_XGEN(b.x)]) == gen, bar);
            __builtin_amdgcn_fence(__ATOMIC_ACQUIRE, "agent");
            asm volatile("s_waitcnt vmcnt(0)" ::: "memory");
        }
    }
    __syncthreads();
}

namespace pg8 {
constexpr int BM = 256, BK = 64, HALF = 128, HTB = HALF * BK * 2, STAGE_BYTES = 8 * HTB, NXCD = 8, WGM = 8, KD = 1024;
__host__ __device__ __forceinline__ int lds_byte(int r, int c) { const int st = (r >> 4) * 2 + (c >> 5), rr = r & 15, cc = c & 31, ob = rr * 64 + cc * 2; return st * 1024 + (ob ^ (((ob >> 9) & 1) << 5)); }
__host__ __device__ __forceinline__ void stage_rc(int b, int& R, int& C) { const int st = b / 1024, sb = b % 1024, swz = sb ^ (((sb >> 9) & 1) << 5); R = (st >> 1) * 16 + swz / 64; C = (st & 1) * 32 + (swz % 64) / 2; }
__host__ __device__ __forceinline__ int perm32(int rho) { const int n = rho >> 4, i = rho & 15; return 8 * (i >> 2) + 4 * n + (i & 3); }
struct Unit { int pm, pn, ex; };
struct StaticOrder {
    int nM, nN, nwg, G, c;
    __device__ void init(int M, int N, int G_, int c_) { nM = M / BM; nN = N / BM; nwg = nM * nN; G = G_; c = c_; }
    __device__ bool next(int i, Unit& u) const {
        const long L = (long)i * G + c; if (L >= nwg) return false;
        int wgid = (int)L; { const int q = nwg / NXCD, r = nwg % NXCD, xcd = wgid % NXCD, off = wgid / NXCD; wgid = (xcd < r ? xcd * (q + 1) : r * (q + 1) + (xcd - r) * q) + off; }
        const int nig = WGM * nN, gid = wgid / nig, fm = gid * WGM, gsz = (nM - fm) < WGM ? (nM - fm) : WGM;
        u.pm = fm + ((wgid % nig) % gsz); u.pn = (wgid % nig) / gsz; u.ex = 0; return true;
    }
};
typedef int i32x8 __attribute__((ext_vector_type(8)));
typedef int i32x4v __attribute__((ext_vector_type(4)));
template <class T> __device__ __forceinline__ auto dbgw_of(const T& s, int) -> decltype(s.dbgw) { return s.dbgw; }
template <class T> __device__ __forceinline__ unsigned* dbgw_of(const T&, long) { return nullptr; }
template <class Epi, class Sched, bool GATHER, int KE = 1024, bool FP8 = false>
__device__ __forceinline__ void gemm_phase(LAS unsigned char* lds, const Sched& S, const Epi& E) {
    int tid = threadIdx.x; asm volatile("" : "+v"(tid));
    const int wid = __builtin_amdgcn_readfirstlane(tid >> 6), lane = tid & 63, wr = wid >> 2, wc = wid & 3, fr = lane & 15, fq = lane >> 4;
    constexpr int K = KE, nt = K / BK;
    unsigned voffA[2], voffB[2]; int Rr[2], Cc[2];
#pragma unroll
    for (int i = 0; i < 2; ++i) { int R, C; stage_rc(tid * 16 + i * 8192, R, C); const int Rb = Epi::PERM ? ((R & ~31) + perm32(R & 31)) : R;
        voffA[i] = (unsigned)(R * K + C) * 2u; voffB[i] = (unsigned)(Rb * K + C) * 2u; Rr[i] = R; Cc[i] = C; }
    constexpr size_t kstep = (size_t)(BK * 2);
    constexpr size_t hstep = (size_t)HALF * K * 2;
    const unsigned ldsw = (unsigned)wid * 1024u;
    const int aoff = lds_byte(wr * 64 + fr, fq * 8), boff = lds_byte(wc * 32 + fr, fq * 8);
#define PG8_SA(b, h) (((b) * 2 + (h)) * HTB)
#define PG8_SB(b, h) ((4 + (b) * 2 + (h)) * HTB)
#define PG8_STAGE(bufoff, gbase, voff) do { _Pragma("unroll") for (int _i = 0; _i < 2; ++_i) \
        __builtin_amdgcn_global_load_lds((const unsigned*)((const char*)(gbase) + (voff)[_i]), (LAS unsigned*)(lds + (bufoff) + ldsw + _i * 8192), 16, 0, 0); } while (0)
#define PG8_STAGE_A(bufoff, gb, h, o0, o1) do { if constexpr (GATHER) { const unsigned _ko = (unsigned)((gb) - gA0); unsigned _o[2]; \
            if ((h) == 0) { _o[0] = (o0)[0] + _ko; _o[1] = (o0)[1] + _ko; } else { _o[0] = (o1)[0] + _ko; _o[1] = (o1)[1] + _ko; } PG8_STAGE(bufoff, gA0, _o); } \
        else { PG8_STAGE(bufoff, (gb) + (h) * hstep, voffA); } } while (0)
#define PG8_LD8(p) __builtin_shufflevector(*(const LAS i32x4v*)(p), *(const LAS i32x4v*)((p) + 1024), 0, 1, 2, 3, 4, 5, 6, 7)
#define PG8_LDA(dst, b, h) do { if constexpr (FP8) { _Pragma("unroll") for (int m = 0; m < 4; ++m) dst##8[m] = PG8_LD8(lds + PG8_SA(b, h) + aoff + m * 2048); } \
        else { _Pragma("unroll") for (int m = 0; m < 4; ++m) _Pragma("unroll") for (int k = 0; k < 2; ++k) dst[m][k] = *(const LAS bf16x8*)(lds + PG8_SA(b, h) + aoff + m * 2048 + k * 1024); } } while (0)
#define PG8_LDB(dst, b, h) do { if constexpr (FP8) { _Pragma("unroll") for (int n = 0; n < 2; ++n) dst##8[n] = PG8_LD8(lds + PG8_SB(b, h) + boff + n * 2048); } \
        else { _Pragma("unroll") for (int n = 0; n < 2; ++n) _Pragma("unroll") for (int k = 0; k < 2; ++k) dst[n][k] = *(const LAS bf16x8*)(lds + PG8_SB(b, h) + boff + n * 2048 + k * 1024); } } while (0)
#define PG8_MMA(ai, bj, At, Bt) do { __builtin_amdgcn_s_setprio(1); if constexpr (FP8) { _Pragma("unroll") for (int m = 0; m < 4; ++m) _Pragma("unroll") for (int n = 0; n < 2; ++n) \
            asm volatile("v_mfma_scale_f32_16x16x128_f8f6f4 %0, %1, %2, %0, %3, %3 op_sel_hi:[0,0,0]" : "+v"(acc[ai][bj][m][n]) : "v"(Bt##8[n]), "v"(At##8[m]), "v"(sc127)); } \
        else { _Pragma("unroll") for (int m = 0; m < 4; ++m) _Pragma("unroll") for (int n = 0; n < 2; ++n) _Pragma("unroll") for (int k = 0; k < 2; ++k) \
            acc[ai][bj][m][n] = __builtin_amdgcn_mfma_f32_16x16x32_bf16(Bt[n][k], At[m][k], acc[ai][bj][m][n], 0, 0, 0); } __builtin_amdgcn_s_setprio(0); } while (0)
#define PG8_WAIT_V(n) asm volatile("s_waitcnt vmcnt(" #n ")" ::: "memory")
#define PG8_WAIT_L(n) asm volatile("s_waitcnt lgkmcnt(" #n ")" ::: "memory")
#define PG8_BAR __builtin_amdgcn_s_barrier()
#define PG8_SCHED __builtin_amdgcn_sched_barrier(0)
    Unit cur, nxt; int ui = 0; unsigned long long kcsum = 0; int kcn = 0; const unsigned long long kph0 = (DBG_KCLK && !FP8 && !GATHER) ? __builtin_amdgcn_s_memtime() : 0ull;
    if (!S.next(0, cur)) return;
    f32x4 acc[2][2][4][2];
#pragma unroll
    for (int a = 0; a < 2; ++a)
#pragma unroll
        for (int b = 0; b < 2; ++b)
#pragma unroll
            for (int m = 0; m < 4; ++m)
#pragma unroll
                for (int n = 0; n < 2; ++n) acc[a][b][m][n] = (f32x4){0.f, 0.f, 0.f, 0.f};
    const int sc127 = 0x7f7f7f7f;
    bf16x8 At[4][2], B0[2][2], B1[2][2]; i32x8 At8[4], B08[2], B18[2];
    const char* cA = S.a_base(cur); const char* cB = S.b_base(cur);
    const char* const gA0 = cA;
    unsigned cv0[2] = {0u, 0u}, cv1[2] = {0u, 0u}, nv0[2] = {0u, 0u}, nv1[2] = {0u, 0u};
    if constexpr (GATHER) S.a_offs(cur, Rr, Cc, cv0, cv1);
    PG8_STAGE(PG8_SB(0, 0), cB, voffB); PG8_STAGE_A(PG8_SA(0, 0), cA, 0, cv0, cv1); PG8_STAGE(PG8_SB(0, 1), cB + hstep, voffB); PG8_STAGE_A(PG8_SA(0, 1), cA, 1, cv0, cv1);
    if (wr == 1) PG8_BAR;
    PG8_WAIT_V(4); PG8_BAR;
    PG8_STAGE(PG8_SB(1, 0), cB + kstep, voffB); PG8_STAGE_A(PG8_SA(1, 0), cA + kstep, 0, cv0, cv1); PG8_STAGE(PG8_SB(1, 1), cB + hstep + kstep, voffB);
    PG8_WAIT_V(6); PG8_BAR;
    for (;;) {
        const bool has_next = S.next(ui + 1, nxt);
        const char* nA = has_next ? S.a_base(nxt) : cA; const char* nB = has_next ? S.b_base(nxt) : cB;
        if constexpr (GATHER) { if (has_next) S.a_offs(nxt, Rr, Cc, nv0, nv1); else { nv0[0] = cv0[0]; nv0[1] = cv0[1]; nv1[0] = cv1[0]; nv1[1] = cv1[1]; } }
        unsigned long long kc0 = 0; if constexpr (DBG_KCLK && !FP8 && !GATHER) kc0 = __builtin_amdgcn_s_memtime();
#pragma nounroll
        for (int t = 0; t < nt; t += 2) {
            const bool last = (t == nt - 2);
            const char* a1 = cA + (size_t)(t + 1) * kstep;
            const char* a2 = last ? nA : cA + (size_t)(t + 2) * kstep; const char* b2 = last ? nB : cB + (size_t)(t + 2) * kstep;
            const char* a3 = a2 + kstep; const char* b3 = b2 + kstep;
            unsigned s0[2], s1[2];
            if constexpr (GATHER) { s0[0] = last ? nv0[0] : cv0[0]; s0[1] = last ? nv0[1] : cv0[1]; s1[0] = last ? nv1[0] : cv1[0]; s1[1] = last ? nv1[1] : cv1[1]; } else { s0[0] = s0[1] = s1[0] = s1[1] = 0u; }
            PG8_LDB(B0, 0, 0); PG8_SCHED; PG8_LDA(At, 0, 0); PG8_STAGE_A(PG8_SA(1, 1), a1, 1, cv0, cv1);
            PG8_WAIT_L(8); PG8_BAR; PG8_WAIT_L(0); PG8_MMA(0, 0, At, B0); PG8_BAR; PG8_SCHED;
            PG8_LDB(B1, 0, 1); PG8_STAGE(PG8_SB(0, 0), b2, voffB);
            PG8_BAR; PG8_WAIT_L(0); PG8_MMA(0, 1, At, B1); PG8_BAR;
            PG8_LDA(At, 0, 1); PG8_STAGE_A(PG8_SA(0, 0), a2, 0, s0, s1);
            PG8_BAR; PG8_WAIT_L(0); PG8_MMA(1, 0, At, B0); PG8_BAR; PG8_SCHED;
            PG8_STAGE(PG8_SB(0, 1), b2 + hstep, voffB);
            PG8_WAIT_V(6); PG8_BAR; PG8_MMA(1, 1, At, B1); PG8_BAR;
            PG8_LDB(B0, 1, 0); PG8_SCHED; PG8_LDA(At, 1, 0); PG8_STAGE_A(PG8_SA(0, 1), a2, 1, s0, s1);
            PG8_WAIT_L(8); PG8_BAR; PG8_WAIT_L(0); PG8_MMA(0, 0, At, B0); PG8_BAR; PG8_SCHED;
            PG8_LDB(B1, 1, 1); PG8_STAGE(PG8_SB(1, 0), b3, voffB);
            PG8_BAR; PG8_WAIT_L(0); PG8_MMA(0, 1, At, B1); PG8_BAR;
            PG8_LDA(At, 1, 1); PG8_STAGE_A(PG8_SA(1, 0), a3, 0, s0, s1);
            PG8_BAR; PG8_WAIT_L(0); PG8_MMA(1, 0, At, B0); PG8_BAR; PG8_SCHED;
            PG8_STAGE(PG8_SB(1, 1), b3 + hstep, voffB);
            PG8_WAIT_V(6); PG8_BAR; PG8_MMA(1, 1, At, B1); PG8_BAR;
        }
        if constexpr (DBG_KCLK && !FP8 && !GATHER) { kc0 = __builtin_amdgcn_s_memtime(); }
        if constexpr (FP8) asm volatile("s_nop 15\n\ts_nop 15" ::: "memory");
        E(acc, cur, wr, wc, fr, fq);
        if constexpr (DBG_KCLK && !FP8 && !GATHER) { asm volatile("s_waitcnt vmcnt(0)" ::: "memory"); kcsum += __builtin_amdgcn_s_memtime() - kc0; ++kcn; }
        if (!has_next) break;
#pragma unroll
        for (int a = 0; a < 2; ++a)
#pragma unroll
            for (int b = 0; b < 2; ++b)
#pragma unroll
                for (int m = 0; m < 4; ++m)
#pragma unroll
                    for (int n = 0; n < 2; ++n) acc[a][b][m][n] = (f32x4){0.f, 0.f, 0.f, 0.f};
        cur = nxt; cA = nA; cB = nB; ++ui;
        if constexpr (GATHER) { cv0[0] = nv0[0]; cv0[1] = nv0[1]; cv1[0] = nv1[0]; cv1[1] = nv1[1]; }
    }
    PG8_WAIT_V(0);
    if (wr == 0) PG8_BAR;
    PG8_BAR;
    if constexpr (DBG_KCLK && !FP8 && !GATHER) { unsigned* dw = dbgw_of(S, 0); if (dw && tid == 0) { kcsum = __builtin_amdgcn_s_memtime() - kph0; const float cpk = (float)kcsum / (float)(kcn) * (1.f / 40000.f); atomicMax(dw, __float_as_uint(powf(10.f, 2.f * (rintf(cpk * 10.f) * 0.1f) - 4.f))); } }
#undef PG8_SA
#undef PG8_SB
#undef PG8_STAGE
#undef PG8_STAGE_A
#undef PG8_LDA
#undef PG8_LDB
#undef PG8_MMA
#undef PG8_LD8
#undef PG8_WAIT_V
#undef PG8_WAIT_L
#undef PG8_BAR
#undef PG8_SCHED
}
}
using pg8::Unit;
typedef f32x4 AccT[2][2][4][2];

struct Args { const float* in[28]; float* out; unsigned char* ws; int ph_lo, ph_hi, pad0, pad1; };
struct Frame {
    LAS unsigned char* lds;
    int tid, lane, wave, G, bid;
    const struct Args* a;
    unsigned char* ws; unsigned char* outb;
};
template <int RB = 2048> struct SchedPlainT {
    pg8::StaticOrder o; const char* A; const char* Bt;
    __device__ __forceinline__ bool next(int i, Unit& u) const { return o.next(i, u); }
    __device__ __forceinline__ const char* a_base(const Unit& u) const { return A + (size_t)u.pm * (256 * RB); }
    __device__ __forceinline__ const char* b_base(const Unit& u) const { return Bt + (size_t)u.pn * (256 * RB); }
    __device__ __forceinline__ void a_offs(const Unit&, const int*, const int*, unsigned (&)[2], unsigned (&)[2]) const {}
};
typedef SchedPlainT<2048> SchedPlain;
template <int MODE> struct SchedProj {
    pg8::StaticOrder o; const char* A; const char* Bt; int fold = 0x7fffffff; unsigned* dbgw = nullptr;
    static constexpr int RB = MODE == 2 ? 1024 : 2048;
    __device__ __forceinline__ bool next(int i, Unit& u) const { if (!o.next(i, u)) return false; const int r = u.pn;
        if (MODE == 1) u.pn = 4 + r;
        if (MODE == 2) u.pn = r < 4 ? r : 15 + r;
        return true; }
    __device__ __forceinline__ const char* a_base(const Unit& u) const { return A + (size_t)(DBG_DRYPROJ ? (u.pm & fold) : u.pm) * (256 * RB); }
    __device__ __forceinline__ const char* b_base(const Unit& u) const { return Bt + (size_t)u.pn * (256 * RB); }
    __device__ __forceinline__ void a_offs(const Unit&, const int*, const int*, unsigned (&)[2], unsigned (&)[2]) const {}
};

struct EpiProj {
    static constexpr bool PERM = true;
    bf16_t *Q, *IQ, *Z, *XBC, *GA, *GB; float* MISC; float sc; int dry = 0;
    __device__ __forceinline__ void operator()(const AccT& acc, const Unit& u, int wr, int wc, int fr, int fq) const {
        const int pn = u.pn, row0 = u.pm * 256 + wr * 64 + fr, c8 = wc * 32 + 8 * fq;
        if (pn == 6) {
#pragma unroll
            for (int ai = 0; ai < 2; ++ai)
#pragma unroll
                for (int m = 0; m < 4; ++m) { float* rp = MISC + (size_t)(row0 + ai * 128 + m * 16) * 256 + c8;
#pragma unroll
                    for (int bj = 0; bj < 2; ++bj) { if (DBG_DRYPROJ && dry && acc[ai][bj][m][0][0] != 1.2345e-33f) continue; *(f32x4*)(rp + bj * 128) = acc[ai][bj][m][0]; *(f32x4*)(rp + bj * 128 + 4) = acc[ai][bj][m][1]; } }
            return;
        }
        bf16_t* base; int ldc, colt, act = 0;
        if (pn < 4) { base = Q; ldc = 1024; colt = pn * 256; }
        else if (pn < 6) { base = IQ; ldc = 512; colt = (pn - 4) * 256; }
        else if (pn < 11) { base = Z; ldc = 1024; colt = (pn - 7) * 256; act = 1; }
        else if (pn < 19) { base = XBC; ldc = 2048; colt = (pn - 11) * 256; }
        else if (pn < 23) { base = GA; ldc = 1024; colt = (pn - 19) * 256; act = 2; }
        else { base = GB; ldc = 1024; colt = (pn - 23) * 256; act = 2; }
#pragma unroll
        for (int ai = 0; ai < 2; ++ai)
#pragma unroll
            for (int m = 0; m < 4; ++m) { bf16_t* rp = base + (size_t)(row0 + ai * 128 + m * 16) * ldc + colt + c8;
#pragma unroll
                for (int bj = 0; bj < 2; ++bj) { f32x4 v0 = acc[ai][bj][m][0] * sc, v1 = acc[ai][bj][m][1] * sc;
                    if (act == 1) {
#pragma unroll
                        for (int j = 0; j < 4; ++j) { v0[j] = silu_f(v0[j]); v1[j] = silu_f(v1[j]); } }
                    if (act == 2) {
#pragma unroll
                        for (int j = 0; j < 4; ++j) { v0[j] = sigmoid_f(v0[j]); v1[j] = sigmoid_f(v1[j]); } }
                    if (GATE_U8 && act == 2) {
                        unsigned lo = 0u, hi = 0u;
#pragma unroll
                        for (int j = 0; j < 4; ++j) { lo = __builtin_amdgcn_cvt_pk_u8_f32(__builtin_rintf(v0[j] * 255.f), j, lo); hi = __builtin_amdgcn_cvt_pk_u8_f32(__builtin_rintf(v1[j] * 255.f), j, hi); }
                        u32x2 q; q.x = lo; q.y = hi;
                        *(u32x2*)((unsigned char*)base + (size_t)(row0 + ai * 128 + m * 16) * 1024 + colt + c8 + bj * 128) = q; continue; }
                    u32x4 pk = pack8(v0, v1); if (DBG_IQ_TRUNC && (pn == 4 || pn == 5)) { pk.x &= 0xfff8fff8u; pk.y &= 0xfff8fff8u; pk.z &= 0xfff8fff8u; pk.w &= 0xfff8fff8u; }
                    if (DBG_DRYPROJ && dry && pk.x != 0x7fc17fc3u) continue;
                    *(u32x4*)(rp + bj * 128) = pk; } }
    }
};
template <int MODE> struct EpiGate {
    static constexpr bool PERM = true;
    const bf16_t* Gt; const bf16_t* T; bf16_t* O; float sc;
    __device__ __forceinline__ void operator()(const AccT& acc, const Unit& u, int wr, int wc, int fr, int fq) const {
        const int row0 = u.pm * 256 + wr * 64 + fr, c8 = u.pn * 256 + wc * 32 + 8 * fq;
#pragma unroll
        for (int ai = 0; ai < 2; ++ai) {
            u32x4 gq[4][2], tq[4][2]; u32x2 g8[4][2];
#pragma unroll
            for (int m = 0; m < 4; ++m) { const size_t off = (size_t)(row0 + ai * 128 + m * 16) * 1024 + c8;
#pragma unroll
                for (int bj = 0; bj < 2; ++bj) { if (GATE_U8) g8[m][bj] = *(const u32x2*)((const unsigned char*)Gt + off + bj * 128); else gq[m][bj] = *(const u32x4*)(Gt + off + bj * 128);
                    if (MODE == 1) tq[m][bj] = *(const u32x4*)(T + off + bj * 128); } }
            SBAR();
#pragma unroll
            for (int m = 0; m < 4; ++m) { const size_t off = (size_t)(row0 + ai * 128 + m * 16) * 1024 + c8;
#pragma unroll
                for (int bj = 0; bj < 2; ++bj) { f32x4 g0, g1;
                    if (GATE_U8) { const unsigned a = g8[m][bj].x, b = g8[m][bj].y; constexpr float q = 1.f / 255.f;
                        g0 = (f32x4){(float)(a & 255u), (float)((a >> 8) & 255u), (float)((a >> 16) & 255u), (float)(a >> 24)} * q;
                        g1 = (f32x4){(float)(b & 255u), (float)((b >> 8) & 255u), (float)((b >> 16) & 255u), (float)(b >> 24)} * q; }
                    else unpack8(gq[m][bj], g0, g1);
                    f32x4 v0 = g0 * (acc[ai][bj][m][0] * sc), v1 = g1 * (acc[ai][bj][m][1] * sc);
                    if ((MODE == 0 && DBG_NO_ATTN) || (MODE == 1 && DBG_NO_SSD)) { v0 = (f32x4){0.f, 0.f, 0.f, 0.f}; v1 = v0; }
                    if (MODE == 1) { f32x4 t0, t1; unpack8(tq[m][bj], t0, t1); v0 += t0; v1 += t1; }
                    *(u32x4*)(O + off + bj * 128) = pack8(v0, v1); } }
            SBAR();
        }
    }
};
struct EpiOut {
    static constexpr bool PERM = true;
    const float* x; const float* mod; bf16_t* V;
    __device__ __forceinline__ void operator()(const AccT& acc, const Unit& u, int wr, int wc, int fr, int fq) const {
        const int row0 = u.pm * 256 + wr * 64 + fr, c8 = u.pn * 256 + wc * 32 + 8 * fq;
        const float* g1 = mod + (size_t)(u.pm >> 3) * 6144 + 2048 + c8;
        f32x4 gv[2][2];
#pragma unroll
        for (int bj = 0; bj < 2; ++bj)
#pragma unroll
            for (int n = 0; n < 2; ++n) gv[bj][n] = *(const f32x4*)(g1 + bj * 128 + n * 4);
#pragma unroll
        for (int ai = 0; ai < 2; ++ai)
#pragma unroll
            for (int mp = 0; mp < 2; ++mp) {
                f32x4 xv[2][2][2];
#pragma unroll
                for (int mm = 0; mm < 2; ++mm) { const size_t off = (size_t)(row0 + ai * 128 + (2 * mp + mm) * 16) * 1024 + c8;
#pragma unroll
                    for (int bj = 0; bj < 2; ++bj)
#pragma unroll
                        for (int n = 0; n < 2; ++n) xv[mm][bj][n] = *(const f32x4*)(x + off + bj * 128 + n * 4); }
                SBAR();
#pragma unroll
                for (int mm = 0; mm < 2; ++mm) { const int m = 2 * mp + mm; const size_t off = (size_t)(row0 + ai * 128 + m * 16) * 1024 + c8;
#pragma unroll
                    for (int bj = 0; bj < 2; ++bj)
                        *(u32x4*)(V + off + bj * 128) = pack8(xv[mm][bj][0] * DN_ALPHA + gv[bj][0] * acc[ai][bj][m][0], xv[mm][bj][1] * DN_ALPHA + gv[bj][1] * acc[ai][bj][m][1]); }
                SBAR();
            }
    }
};

struct MoeTab { LAS unsigned* cnt; LAS unsigned* tb; LAS unsigned char* te; int ntiles; };
__device__ __forceinline__ MoeTab moe_tables(Frame& F, int hf) {
    MoeTab T; T.cnt = (LAS unsigned*)(F.lds + LDS_AUX); T.tb = (LAS unsigned*)(F.lds + LDS_AUX + 256); T.te = (LAS unsigned char*)(F.lds + LDS_AUX + 512);
    const unsigned* CNT = (const unsigned*)(F.ws + WS_CTL) + CW_CNT;
    __syncthreads();
    if (F.tid < 32) { unsigned c = __hip_atomic_load(CNT + 64 * (hf * 32 + F.tid), __ATOMIC_RELAXED, __HIP_MEMORY_SCOPE_AGENT); if (c > (unsigned)REG_CAP) c = REG_CAP; T.cnt[F.tid] = c; }
    __syncthreads();
    if (F.tid == 0) { unsigned s = 0;
#pragma nounroll
        for (int e = 0; e < 32; ++e) { T.tb[e] = s; const unsigned n = (T.cnt[e] + 255u) >> 8;
#pragma nounroll
            for (unsigned t = 0; t < n; ++t) T.te[s + t] = (unsigned char)e;
            s += n; }
        T.tb[32] = s; }
    __syncthreads();
    T.ntiles = __builtin_amdgcn_readfirstlane((int)T.tb[32]);
    return T;
}
template <int NJ, bool GATHER> struct SchedMoe {
    MoeTab T; int G, c, hf; const char* A; const char* Bt; const u32x2* REG;
    __device__ __forceinline__ bool next(int i, Unit& u) const {
        int tile, j;
        if (G == 256) { const int x = c & 7, sl = c >> 3;
            tile = i * (256 / NJ) + x * (32 / NJ) + sl / NJ; j = sl % NJ;
            if (tile >= T.ntiles) return false; }
        else { const int L = i * G + c; if (L >= T.ntiles * NJ) return false; tile = L / NJ; j = L % NJ; }
        u.pm = tile; u.pn = j; u.ex = __builtin_amdgcn_readfirstlane((int)T.te[u.pm]); return true;
    }
    __device__ __forceinline__ const char* a_base(const Unit& u) const { return GATHER ? A : A + (size_t)u.pm * (256 * MOE_RB); }
    __device__ __forceinline__ const char* b_base(const Unit& u) const { return Bt + ((size_t)u.ex * (NJ * 256) + (size_t)u.pn * 256) * MOE_RB; }
    __device__ __forceinline__ void a_offs(const Unit& u, const int* R, const int* C, unsigned (&o0)[2], unsigned (&o1)[2]) const {
        const unsigned cnt = __builtin_amdgcn_readfirstlane(T.cnt[u.ex]), pos0 = ((unsigned)u.pm - (unsigned)__builtin_amdgcn_readfirstlane(T.tb[u.ex])) * 256u; const u32x2* rg = REG + ((size_t)hf * 32 + u.ex) * REG_CAP;
#pragma unroll
        for (int i = 0; i < 2; ++i) {
            const unsigned p0 = pos0 + (unsigned)R[i], p1 = p0 + 128u;
            unsigned t0 = 0u, t1 = 0u;
            if (p0 < cnt) t0 = (unsigned)hf * HALF_TOK + (rg[p0].x >> 2);
            if (p1 < cnt) t1 = (unsigned)hf * HALF_TOK + (rg[p1].x >> 2);
            o0[i] = t0 * (unsigned)MOE_RB + (unsigned)C[i] * 2u; o1[i] = t1 * (unsigned)MOE_RB + (unsigned)C[i] * 2u;
        }
    }
};
struct EpiMoe1 {
    static constexpr bool PERM = true;
    const float* b1; bf16_t* ACT; int dry;
    __device__ __forceinline__ void operator()(const AccT& acc, const Unit& u, int wr, int wc, int fr, int fq) const {
        if (dry) { if (acc[0][0][0][0][0] == 1.2345e-33f) ACT[0] = 1; return; }
        const int row0 = u.pm * 256 + wr * 64 + fr, c8 = u.pn * 128 + wc * 32 + 8 * fq;
        const float* bg = b1 + (size_t)u.ex * 2048 + c8;
        const f32x4 bg0 = *(const f32x4*)bg, bg1 = *(const f32x4*)(bg + 4), bu0 = *(const f32x4*)(bg + 1024), bu1 = *(const f32x4*)(bg + 1028);
#pragma unroll
        for (int ai = 0; ai < 2; ++ai)
#pragma unroll
            for (int m = 0; m < 4; ++m) {
                f32x4 g0 = acc[ai][0][m][0] * MOE_INV + bg0, g1 = acc[ai][0][m][1] * MOE_INV + bg1, u0 = acc[ai][1][m][0] * MOE_INV + bu0, u1 = acc[ai][1][m][1] * MOE_INV + bu1, a0, a1;
#pragma unroll
                for (int j = 0; j < 4; ++j) {
                    float g = fminf(g0[j], 7.0f), up = fminf(fmaxf(u0[j], -7.0f), 7.0f); a0[j] = (up + 1.0f) * g * sigmoid_f(1.702f * g);
                    g = fminf(g1[j], 7.0f); up = fminf(fmaxf(u1[j], -7.0f), 7.0f); a1[j] = (up + 1.0f) * g * sigmoid_f(1.702f * g); }
                if (MOE_FP8) *(u32x2*)((unsigned char*)ACT + (size_t)(row0 + ai * 128 + m * 16) * 1024 + c8) = pack8_fp8(a0, a1);
                else *(u32x4*)(ACT + (size_t)(row0 + ai * 128 + m * 16) * 1024 + c8) = pack8(a0, a1); }
    }
};
struct EpiMoe2 {
    static constexpr bool PERM = true;
    const float* b2; bf16_t* YB; const u32x2* REG; MoeTab T; int hf; int dry;
    __device__ __forceinline__ void operator()(const AccT& acc, const Unit& u, int wr, int wc, int fr, int fq) const {
        if (dry == 1) { if (acc[0][0][0][0][0] == 1.2345e-33f) YB[0] = 1; return; }
        if (dry >= 2) {
            const int c8d = (dry == 3 ? 0 : u.pn * 256) + wc * 32 + 8 * fq; const unsigned rowd = dry == 3 ? (blockIdx.x * 256u + (unsigned)(wr * 64 + fr)) : ((unsigned)u.pm * 256u + (unsigned)(wr * 64 + fr)) % 131072u;
#pragma unroll
            for (int ai = 0; ai < 2; ++ai)
#pragma unroll
                for (int m = 0; m < 4; ++m) { bf16_t* rp = YB + (size_t)((rowd + ai * 128 + m * 16) % 131072u) * 1024 + c8d;
#pragma unroll
                    for (int bj = 0; bj < 2; ++bj) *(u32x4*)(rp + bj * 128) = pack8(acc[ai][bj][m][0] * MOE_INV, acc[ai][bj][m][1] * MOE_INV); }
            return; }
        const int c8 = u.pn * 256 + wc * 32 + 8 * fq;
        const unsigned cnt = __builtin_amdgcn_readfirstlane(T.cnt[u.ex]), pos0 = ((unsigned)u.pm - (unsigned)__builtin_amdgcn_readfirstlane(T.tb[u.ex])) * 256u + (unsigned)(wr * 64 + fr); const u32x2* rg = REG + ((size_t)hf * 32 + u.ex) * REG_CAP;
        const float* bb = b2 + (size_t)u.ex * 1024 + c8;
        f32x4 bv[2][2];
#pragma unroll
        for (int bj = 0; bj < 2; ++bj) { bv[bj][0] = *(const f32x4*)(bb + bj * 128); bv[bj][1] = *(const f32x4*)(bb + bj * 128 + 4); }
        u32x2 en8[2][4];
#pragma unroll
        for (int ai = 0; ai < 2; ++ai)
#pragma unroll
            for (int m = 0; m < 4; ++m) { const unsigned p = pos0 + (unsigned)(ai * 128 + m * 16); en8[ai][m] = rg[p < cnt ? p : cnt - 1u]; }
#pragma unroll
        for (int ai = 0; ai < 2; ++ai)
#pragma unroll
            for (int m = 0; m < 4; ++m) { const unsigned p = pos0 + (unsigned)(ai * 128 + m * 16);
                const u32x2 en = en8[ai][m]; const float g = __uint_as_float(en.y); const unsigned drow = p < cnt ? en.x : (unsigned)(HALF_TOK * 4);
                bf16_t* rp = YB + (size_t)drow * 1024 + c8;
#pragma unroll
                for (int bj = 0; bj < 2; ++bj) *(u32x4*)(rp + bj * 128) = pack8((acc[ai][bj][m][0] * MOE_INV + bv[bj][0]) * g, (acc[ai][bj][m][1] * MOE_INV + bv[bj][1]) * g); }
    }
};

struct MapIdent { __device__ __forceinline__ int operator()(int n) const { return n; } };
struct MapWin { __device__ __forceinline__ int operator()(int n) const {
    if (n < 1024) return n;
    if (n < 1536) return 1152 + (n - 1024);
    if (n < 1792) { const int c = n - 1536; if (c < 128) return 1024 + c; if (c < 192) return 1664 + (c - 128); if (c < 200) return 1728 + (c - 192); if (c < 216) return 4808 + (c - 200); return -1; }
    if (n < 2816) return 1736 + (n - 1792);
    if (n < 4864) return 2760 + (n - 2816);
    if (n < 5888) return 4824 + (n - 4864);
    return 5848 + (n - 5888); } };
struct MapW1 { __device__ __forceinline__ int operator()(int r) const { const int j = r >> 8, rr = r & 255; return (rr >> 7) * 1024 + j * 128 + (rr & 127); } };
template <class Map, bool F8 = false> __device__ __forceinline__ void transpose_item(const float* W, int K, int N, bf16_t* WT, const Map& map, LAS float* scr, int kb, int nb, int lane, const float* rowscale) {
    const int k0 = 64 * kb, n0 = 64 * nb, q = lane & 15, kr = lane >> 4; const int src = map(n0 + 4 * q);
    f32x4 ld[16];
#pragma unroll
    for (int i = 0; i < 16; ++i) { const int kk = 4 * i + kr; ld[i] = (src >= 0) ? *(const f32x4*)(W + (size_t)(k0 + kk) * N + src) : (f32x4){0.f, 0.f, 0.f, 0.f}; }
#pragma unroll
    for (int i = 0; i < 16; ++i) { const int kk = 4 * i + kr; f32x4 v = ld[i]; if (rowscale) v = v * rowscale[k0 + kk]; LAS float* d = scr + kk * 65 + 4 * q; d[0] = v[0]; d[1] = v[1]; d[2] = v[2]; d[3] = v[3]; }
    LDS_WAIT(); asm volatile("" ::: "memory");
    const int c = lane & 7;
#pragma unroll
    for (int j = 0; j < 8; ++j) { const int n = (lane >> 3) + 8 * j; const LAS float* s = scr + (8 * c) * 65 + n;
        if constexpr (F8) { const f32x4 a = {s[0 * 65] * MOE_WSC, s[1 * 65] * MOE_WSC, s[2 * 65] * MOE_WSC, s[3 * 65] * MOE_WSC}, b = {s[4 * 65] * MOE_WSC, s[5 * 65] * MOE_WSC, s[6 * 65] * MOE_WSC, s[7 * 65] * MOE_WSC};
            *(u32x2*)((unsigned char*)WT + (size_t)(n0 + n) * K + k0 + 8 * c) = pack8_fp8(a, b); }
        else { u32x4 o; o.x = cvt_pk_bf16(s[0 * 65], s[1 * 65]); o.y = cvt_pk_bf16(s[2 * 65], s[3 * 65]); o.z = cvt_pk_bf16(s[4 * 65], s[5 * 65]); o.w = cvt_pk_bf16(s[6 * 65], s[7 * 65]);
            *(u32x4*)(WT + (size_t)(n0 + n) * K + k0 + 8 * c) = o; } }
    LDS_WAIT(); asm volatile("" ::: "memory");
}
struct TrItem { const float* W; const float* rowscale; unsigned char* WT; int N, src, k0, n0, f8; };
__device__ __forceinline__ TrItem tr_decode(Frame& F, int it) {
    constexpr int I_WIN = 16 * (NPROJ / 64), I_SQ = 16 * 16, I_W1E = 16 * 32, I_W2E = 16 * 16;
    TrItem d; d.rowscale = nullptr; int r = it, kb, nb; const int q4 = 4 * (F.lane & 15);
    if (r < (PROJ_FP8 ? 2 : 1) * I_WIN) { const int f8 = r >= I_WIN; if (f8) r -= I_WIN; kb = r / (NPROJ / 64); nb = r % (NPROJ / 64);
        d.W = F.a->in[4]; d.N = 6872; d.src = MapWin()(64 * nb + q4); d.WT = F.ws + (f8 ? WS_WIN8 : WS_WIN); d.f8 = f8; }
    else { r -= (PROJ_FP8 ? 2 : 1) * I_WIN;
        if (r < 3 * I_SQ) { const int w = r / I_SQ; r -= w * I_SQ; kb = r / 16; nb = r % 16; d.N = 1024; d.src = 64 * nb + q4;
            if (w == 0) { d.W = F.a->in[15]; d.WT = F.ws + (PA_FP8 ? WS_WPA8 : WS_WPA); d.f8 = PA_FP8; }
            else if (w == 1) { d.W = F.a->in[16]; d.WT = F.ws + (PB_FP8 ? WS_WPB8 : WS_WPB); d.f8 = PB_FP8; d.rowscale = F.a->in[14]; }
            else { d.W = F.a->in[17]; d.WT = F.ws + WS_WOUT; d.f8 = 0; } }
        else { r -= 3 * I_SQ;
            if (r < 32 * I_W1E) { const int e = r / I_W1E, q = r % I_W1E; kb = q / 32; nb = q % 32; d.W = F.a->in[22] + (size_t)e * 1024 * 2048; d.N = 2048; d.src = MapW1()(64 * nb + q4);
                d.WT = F.ws + WS_W1 + (size_t)e * 2048 * MOE_RB; d.f8 = MOE_FP8; }
            else { r -= 32 * I_W1E; const int e = r / I_W2E, q = r % I_W2E; kb = q / 16; nb = q % 16; d.W = F.a->in[24] + (size_t)e * 1024 * 1024; d.N = 1024; d.src = 64 * nb + q4;
                d.WT = F.ws + WS_W2 + (size_t)e * 1024 * MOE_RB; d.f8 = MOE_FP8; } } }
    d.k0 = 64 * kb; d.n0 = 64 * nb; return d; }
__device__ __forceinline__ void tr_load(const TrItem& d, f32x4 (&ld)[16], int lane) {
    const int kr = lane >> 4; const float* p = d.W + (size_t)(d.k0 + kr) * d.N + (d.src >= 0 ? d.src : 0);
#pragma unroll
    for (int i = 0; i < 16; ++i) ld[i] = __builtin_nontemporal_load((const f32x4*)(p + (size_t)(4 * i) * d.N)); }
__device__ __forceinline__ void tr_finish(const TrItem& d, f32x4 (&ld)[16], LAS float* scr, int lane) {
    const int q = lane & 15, kr = lane >> 4; const bool zero = d.src < 0;
#pragma unroll
    for (int i = 0; i < 16; ++i) { const int kk = 4 * i + kr; f32x4 v = ld[i]; if (zero) v = (f32x4){0.f, 0.f, 0.f, 0.f}; if (d.rowscale) v = v * d.rowscale[d.k0 + kk];
        LAS float* o = scr + kk * 65 + 4 * q; o[0] = v[0]; o[1] = v[1]; o[2] = v[2]; o[3] = v[3]; }
    LDS_WAIT(); asm volatile("" ::: "memory");
    const int c = lane & 7;
    if (d.f8) {
#pragma unroll
        for (int j = 0; j < 8; ++j) { const int n = (lane >> 3) + 8 * j; const LAS float* s = scr + (8 * c) * 65 + n;
            const f32x4 a = {s[0 * 65] * MOE_WSC, s[1 * 65] * MOE_WSC, s[2 * 65] * MOE_WSC, s[3 * 65] * MOE_WSC}, b = {s[4 * 65] * MOE_WSC, s[5 * 65] * MOE_WSC, s[6 * 65] * MOE_WSC, s[7 * 65] * MOE_WSC};
            *(u32x2*)((unsigned char*)d.WT + (size_t)(d.n0 + n) * 1024 + d.k0 + 8 * c) = pack8_fp8(a, b); } }
    else {
#pragma unroll
        for (int j = 0; j < 8; ++j) { const int n = (lane >> 3) + 8 * j; const LAS float* s = scr + (8 * c) * 65 + n;
            u32x4 o; o.x = cvt_pk_bf16(s[0 * 65], s[1 * 65]); o.y = cvt_pk_bf16(s[2 * 65], s[3 * 65]); o.z = cvt_pk_bf16(s[4 * 65], s[5 * 65]); o.w = cvt_pk_bf16(s[6 * 65], s[7 * 65]);
            *(u32x4*)((bf16_t*)d.WT + (size_t)(d.n0 + n) * 1024 + d.k0 + 8 * c) = o; } }
    LDS_WAIT(); asm volatile("" ::: "memory");
}
__device__ __forceinline__ void ph_prologue(Frame& F) {
    const float* c_in = F.a->in[1]; const float* w_mod = F.a->in[2]; const float* b_mod = F.a->in[3];
    float* MOD = (float*)(F.ws + WS_MOD);
    for (int item = F.bid; item < 192; item += F.G) {
        LAS float* SC = (LAS float*)F.lds;
        __syncthreads();
        for (int i = F.tid; i < 32768; i += NTHR) { const int b = i >> 10, k = i & 1023; SC[k * 36 + b] = silu_f(c_in[i]); }
        __syncthreads();
        const int col = item * 32 + (F.tid >> 4), kq = F.tid & 15;
        float a[32];
#pragma unroll
        for (int b = 0; b < 32; ++b) a[b] = 0.f;
#pragma nounroll
        for (int kg = 0; kg < 64; kg += 16) {
            float wv[16];
#pragma unroll
            for (int u = 0; u < 16; ++u) wv[u] = w_mod[(size_t)((kg + u) * 16 + kq) * 6144 + col];
#pragma unroll
            for (int u = 0; u < 16; ++u) { const int k = (kg + u) * 16 + kq; const float w = wv[u];
#pragma unroll
                for (int b4 = 0; b4 < 8; ++b4) { const f32x4 s = *(const LAS f32x4*)(SC + k * 36 + b4 * 4); a[b4 * 4 + 0] += w * s[0]; a[b4 * 4 + 1] += w * s[1]; a[b4 * 4 + 2] += w * s[2]; a[b4 * 4 + 3] += w * s[3]; } } }
#pragma unroll
        for (int b = 0; b < 32; ++b) { a[b] += __shfl_xor(a[b], 1); a[b] += __shfl_xor(a[b], 2); a[b] += __shfl_xor(a[b], 4); a[b] += __shfl_xor(a[b], 8); }
        { const float bm = b_mod[col];
#pragma unroll
            for (int b = 1; b < 16; ++b) { a[0] = (kq == b) ? a[b] : a[0]; a[16] = (kq == b) ? a[16 + b] : a[16]; }
            MOD[(size_t)kq * 6144 + col] = a[0] + bm; MOD[(size_t)(kq + 16) * 6144 + col] = a[16] + bm; }
        __syncthreads();
    }
    if (F.bid == (F.G > 192 ? 192 : 0)) {
        float* BT = (float*)(F.ws + WS_BIAST); const float* rel_bias = F.a->in[8];
        for (int i = F.tid; i < 249 * 8; i += NTHR) { const int idx = i >> 3, h = i & 7, rel = idx - 185; const int n = rel < 0 ? -rel : rel;
            const float nf = (float)(n > 1 ? n : 1); int large = 8 + (int)(logf(nf / 8.0f) / 2.7725887f * 8.0f); if (large > 15) large = 15;
            const int bucket = (rel > 0 ? 16 : 0) + (n < 8 ? n : large);
            BT[i] = rel_bias[bucket * 8 + h] * LOG2E; }
    }
    LAS float* scr = (LAS float*)(F.lds + F.wave * 16640);
    __syncthreads();
    const int gw = F.bid * NWAVES + F.wave, NGW = F.G * NWAVES;
    constexpr int I_WIN = 16 * (NPROJ / 64), I_SQ = 16 * 16, I_W1E = 16 * 32, I_W2E = 16 * 16;
    constexpr int NITEMS = (PROJ_FP8 ? 2 : 1) * I_WIN + 3 * I_SQ + 32 * I_W1E + 32 * I_W2E;
    TrItem d0, d1; f32x4 la[16], lb[16];
    int it = gw;
    if (it < NITEMS) { d0 = tr_decode(F, it); tr_load(d0, la, F.lane); }
    while (it < NITEMS) {
        const int i1 = it + NGW; const bool v1 = i1 < NITEMS;
        if (v1) { d1 = tr_decode(F, i1); tr_load(d1, lb, F.lane); }
        tr_finish(d0, la, scr, F.lane);
        if (!v1) break;
        const int i2 = i1 + NGW; const bool v2 = i2 < NITEMS;
        if (v2) { d0 = tr_decode(F, i2); tr_load(d0, la, F.lane); }
        tr_finish(d1, lb, scr, F.lane);
        it = i2;
    }
}

__device__ __forceinline__ void ln1_load(const float* x, int m0, int lane, f32x4 (&v)[4][4]) {
#pragma unroll
    for (int r = 0; r < 4; ++r) { const f32x4* xr = (const f32x4*)(x + (size_t)(m0 + r) * D) + lane;
#pragma unroll
        for (int j = 0; j < 4; ++j) v[r][j] = __builtin_nontemporal_load(xr + 64 * j); } }
__device__ __forceinline__ void ln1_proc(Frame& F, bf16_t* U, int m0, f32x4 (&v)[4][4], const f32x4 (&sh)[4], const f32x4 (&sc)[4]) {
#pragma unroll
    for (int r = 0; r < 4; ++r) { const int m = m0 + r;
        float s = 0.f;
#pragma unroll
        for (int j = 0; j < 4; ++j) s += (v[r][j][0] + v[r][j][1]) + (v[r][j][2] + v[r][j][3]);
        const float mean = wave_sum(s) * (1.f / D); float s2 = 0.f;
#pragma unroll
        for (int j = 0; j < 4; ++j) { v[r][j] = v[r][j] - mean; s2 += (v[r][j][0] * v[r][j][0] + v[r][j][1] * v[r][j][1]) + (v[r][j][2] * v[r][j][2] + v[r][j][3] * v[r][j][3]); }
        const float rstd = 1.f / sqrtf(wave_sum(s2) * (1.f / D) + LN_EPS);
        u32x2* o8 = (u32x2*)(U + (size_t)m * D) + F.lane;
#pragma unroll
        for (int j = 0; j < 4; ++j) {
            const f32x4 rr = v[r][j] * rstd * (sc[j] + 1.0f) + sh[j]; u32x2 w; w.x = cvt_pk_bf16(rr[0], rr[1]); w.y = cvt_pk_bf16(rr[2], rr[3]); o8[64 * j] = w;
            if (PROJ_FP8) { int pk = 0; pk = __builtin_amdgcn_cvt_pk_fp8_f32(rr[0], rr[1], pk, false); pk = __builtin_amdgcn_cvt_pk_fp8_f32(rr[2], rr[3], pk, true); ((unsigned*)(F.ws + WS_U8 + (size_t)m * D))[F.lane + 64 * j] = (unsigned)pk; } } } }
__device__ __forceinline__ void ph_ln1(Frame& F) {
    const float* x = F.a->in[0]; const float* MOD = (const float*)(F.ws + WS_MOD); bf16_t* U = (bf16_t*)(F.outb + OUT_U);
    const int gw = F.bid * NWAVES + F.wave, NGW = F.G * NWAVES;
    const int RPW = (((NTOK + NGW - 1) / NGW) + 3) & ~3;
    const int mbeg = gw * RPW, mend = (mbeg + RPW < NTOK) ? mbeg + RPW : NTOK;
    if (mbeg >= mend) return;
    f32x4 va[4][4], vb[4][4], sh[4], sc[4]; int curb = -1;
#define LN1_MOD(m0) do { const int bb = (m0) >> 11; if (bb != curb) { curb = bb; const float* md = MOD + (size_t)bb * 6144; \
        _Pragma("unroll") for (int j = 0; j < 4; ++j) { sh[j] = *((const f32x4*)md + F.lane + 64 * j); sc[j] = *((const f32x4*)(md + 1024) + F.lane + 64 * j); } } } while (0)
    int m0 = mbeg;
    ln1_load(x, m0, F.lane, va);
    for (;;) {
        const int m1 = m0 + 4; const bool v1 = m1 < mend;
        LN1_MOD(m0); if (v1) ln1_load(x, m1, F.lane, vb);
        ln1_proc(F, U, m0, va, sh, sc);
        if (!v1) break;
        const int m2 = m1 + 4; const bool v2 = m2 < mend;
        LN1_MOD(m1); if (v2) ln1_load(x, m2, F.lane, va);
        ln1_proc(F, U, m1, vb, sh, sc);
        if (!v2) break;
        m0 = m2;
    }
#undef LN1_MOD
}

__device__ __forceinline__ void misc_load(const float* MISC, int m0, int l, f32x4 (&v)[8]) {
#pragma unroll
    for (int r = 0; r < 8; ++r) v[r] = __builtin_nontemporal_load((const f32x4*)(MISC + (size_t)(m0 + r) * 256) + l); }
__device__ __forceinline__ void misc_proc(Frame& F, int m0, const f32x4 (&vv)[8], const f32x4& w1, const f32x4& w2) {
    bf16_t* KV = (bf16_t*)(F.outb + OUT_KV); bf16_t* IK = (bf16_t*)(F.outb + OUT_IK); float* IW = (float*)(F.outb + OUT_IW); float* DT = (float*)(F.outb + OUT_DT);
    const int l = F.lane;
#pragma unroll
    for (int r = 0; r < 8; ++r) { const int m = m0 + r;
        const f32x4 v = vv[r];
        const float sq = v[0] * v[0] + v[1] * v[1] + v[2] * v[2] + v[3] * v[3], sm = (v[0] + v[1]) + (v[2] + v[3]);
        const float kvss = wave_sum(l < 32 ? sq : 0.f);
        const float iks = wave_sum((l >= 32 && l < 48) ? sm : 0.f);
        const float ikmean = iks * (1.f / 64.f);
        const f32x4 dv = v - ikmean;
        const float ikq = wave_sum((l >= 32 && l < 48) ? (dv[0] * dv[0] + dv[1] * dv[1] + dv[2] * dv[2] + dv[3] * dv[3]) : 0.f);
        if (l < 32) { const float rr = 1.f / sqrtf(kvss * (1.f / 128.f) + LN_EPS); const f32x4 o = v * rr * w1;
            u32x2 pk; pk.x = cvt_pk_bf16(o[0], o[1]); pk.y = cvt_pk_bf16(o[2], o[3]); *((u32x2*)(KV + (size_t)m * 128) + l) = pk; }
        else if (l < 48) { const float rr = 1.f / sqrtf(ikq * (1.f / 64.f) + LN_EPS); const f32x4 o = dv * rr * w1 + w2;
            u32x2 pk; pk.x = cvt_pk_bf16(o[0], o[1]); pk.y = cvt_pk_bf16(o[2], o[3]); *((u32x2*)(IK + (size_t)m * 64) + (l - 32)) = pk; }
        else if (l < 50) { *((f32x4*)(IW + (size_t)m * 8) + (l - 48)) = v * 0.35355339059327373f; }
        else if (l < 54) { f32x4 o;
#pragma unroll
            for (int j = 0; j < 4; ++j) { const float t = v[j] + w1[j]; o[j] = t > 20.f ? t : log1pf(__expf(t)); }
            *((f32x4*)(DT + (size_t)m * 16) + (l - 50)) = o; }
    } }
__device__ __forceinline__ void ph_misc(Frame& F) {
    const float* MISC = (const float*)(F.outb + OUT_MISC);
    const float* kvw = F.a->in[5]; const float* ikw = F.a->in[6]; const float* ikb = F.a->in[7]; const float* dtb = F.a->in[11];
    const int gw = F.bid * NWAVES + F.wave, NGW = F.G * NWAVES, l = F.lane;
    const int RPW = (((NTOK + NGW - 1) / NGW) + 7) & ~7;
    const int mbeg = gw * RPW, mend = (mbeg + RPW < NTOK) ? mbeg + RPW : NTOK;
    if (mbeg >= mend) return;
    f32x4 w1 = (f32x4){0.f, 0.f, 0.f, 0.f}, w2 = w1;
    if (l < 32) w1 = *((const f32x4*)kvw + l); else if (l < 48) { w1 = *((const f32x4*)ikw + (l - 32)); w2 = *((const f32x4*)ikb + (l - 32)); } else if (l >= 50 && l < 54) w1 = *((const f32x4*)dtb + (l - 50));
    f32x4 va[8], vb[8];
    int m0 = mbeg;
    misc_load(MISC, m0, l, va);
    for (;;) {
        const int m1 = m0 + 8; const bool v1 = m1 < mend;
        if (v1) misc_load(MISC, m1, l, vb);
        misc_proc(F, m0, va, w1, w2);
        if (!v1) break;
        const int m2 = m1 + 8; const bool v2 = m2 < mend;
        if (v2) misc_load(MISC, m2, l, va);
        misc_proc(F, m1, vb, w1, w2);
        if (!v2) break;
        m0 = m2;
    }
}

__device__ __forceinline__ unsigned sortable_key(float s) { const unsigned u = __float_as_uint(s + 0.0f); return (u & 0x80000000u) ? ~u : (u | 0x80000000u); }
template <int NKB> struct KeyRow { unsigned k[NKB]; };
__device__ __forceinline__ u64 low_bits_keep(u64 m, int t) { u64 out = 0; while (t-- > 0 && m) { const u64 b = m & (0 - m); out |= b; m ^= b; } return out; }
namespace idx { constexpr int KST = 144, KBUF = 64 * KST; }
__device__ __forceinline__ unsigned low_bits_keep32(unsigned m, int t) { unsigned out = 0; while (t-- > 0 && m) { const unsigned b = m & (0u - m); out |= b; m ^= b; } return out; }
template <int NG> __device__ __forceinline__ void topk2_select_write(const unsigned (&key)[64], int nkb, u64* mrow, int lane) {
    constexpr int NR = NG * 16;
    unsigned T0 = 0u, T1 = 0u; bool ex0 = false, ex1 = false;
    unsigned lo0 = 0u, lo1 = 0u, hi0 = 0xFFFFFFFFu, hi1 = 0xFFFFFFFFu, st0, st1, p0, p1; bool fin0 = false, fin1 = false;
    { float sm = 0.f, sq = 0.f;
#pragma unroll
        for (int m = 0; m < 10; ++m) { const unsigned k = key[m]; const float f = __uint_as_float((k & 0x80000000u) ? (k ^ 0x80000000u) : ~k); sm += f; sq += f * f; }
        sm = dpp_half_sums_f32(sm); sq = dpp_half_sums_f32(sq);
        const float mu = sm * (1.f / 320.f), sd = sqrtf(fmaxf(sq * (1.f / 320.f) - mu * mu, 1e-20f));
        const float qq = 256.f / (64.f * (float)nkb), pp = qq < 0.5f ? qq : 1.f - qq, tt = sqrtf(-2.f * __logf(pp));
        float z = tt - (2.515517f + 0.802853f * tt + 0.010328f * tt * tt) / (1.f + 1.432788f * tt + 0.189269f * tt * tt + 0.001308f * tt * tt * tt); if (qq >= 0.5f) z = -z;
        const unsigned pe = sortable_key(mu + z * sd), pd = sortable_key(mu + z * sd + 0.125f * sd);
        unsigned stp = pd - pe; if (stp < 1024u) stp = 1024u;
        p0 = __builtin_amdgcn_readlane((int)pe, 31); p1 = __builtin_amdgcn_readlane((int)pe, 63); st0 = __builtin_amdgcn_readlane((int)stp, 31); st1 = __builtin_amdgcn_readlane((int)stp, 63); }
#pragma nounroll
    for (int it = 0; it < 80; ++it) {
        const unsigned candv = lane < 32 ? p0 : p1;
        unsigned cl = 0u;
#pragma unroll
        for (int m = 0; m < NR; m += 4) { u64 s0, s1, s2, s3;
            asm("v_cmp_ge_u32_e64 %1, %5, %9\n\tv_cmp_ge_u32_e64 %2, %6, %9\n\tv_cmp_ge_u32_e64 %3, %7, %9\n\tv_cmp_ge_u32_e64 %4, %8, %9\n\t"
                "v_addc_co_u32_e64 %0, %1, 0, %0, %1\n\tv_addc_co_u32_e64 %0, %2, 0, %0, %2\n\tv_addc_co_u32_e64 %0, %3, 0, %0, %3\n\tv_addc_co_u32_e64 %0, %4, 0, %0, %4"
                : "+v"(cl), "=&s"(s0), "=&s"(s1), "=&s"(s2), "=&s"(s3) : "v"(key[m]), "v"(key[m + 1]), "v"(key[m + 2]), "v"(key[m + 3]), "v"(candv)); }
        cl = dpp_half_sums_u32(cl);
        const int n0 = __builtin_amdgcn_readlane((int)cl, 31), n1 = __builtin_amdgcn_readlane((int)cl, 63);
#define IDX_STEP(lo, hi, st, p, T, ex, fin, n) do { if (!fin) { \
            if (n == 256) { T = p; ex = true; fin = true; } \
            else { if (n > 256) lo = p; else hi = p; \
                if (hi - lo <= 1u) { T = lo; fin = true; } \
                else { unsigned c; if (hi == 0xFFFFFFFFu) { c = lo + st; if (c < lo) c = hi; st = st << 1; } else if (lo == 0u) { c = hi - st; if (c > hi) c = lo; st = st << 1; } else c = lo + ((hi - lo) >> 1); \
                    if (c <= lo || c >= hi) c = lo + ((hi - lo) >> 1); p = c; } } } } while (0)
        IDX_STEP(lo0, hi0, st0, p0, T0, ex0, fin0, n0);
        IDX_STEP(lo1, hi1, st1, p1, T1, ex1, fin1, n1);
#undef IDX_STEP
        if (fin0 && fin1) break;
    }
    const unsigned Tv = lane < 32 ? T0 : T1;
    if (ex0 && ex1) {
        unsigned mlo = 0u, mhi = 0u;
#pragma unroll
        for (int j = 0; j < NR / 2; ++j) {
            const u64 b0 = __ballot(key[2 * j] >= Tv), b1 = __ballot(key[2 * j + 1] >= Tv);
            asm volatile("s_nop 1\n\tv_writelane_b32 %0, %2, %6\n\tv_writelane_b32 %0, %3, %7\n\tv_writelane_b32 %1, %4, %6\n\tv_writelane_b32 %1, %5, %7"
                         : "+v"(mlo), "+v"(mhi) : "s"((unsigned)b0), "s"((unsigned)(b0 >> 32)), "s"((unsigned)b1), "s"((unsigned)(b1 >> 32)), "n"(j), "n"(32 + j));
            if ((j & 3) == 3) SBAR();
        }
        const int jl = lane & 31;
        if (jl < nkb) mrow[(lane >> 5) * 32 + jl] = (u64)mlo | ((u64)mhi << 32);
        return;
    }
    int rem0 = 1 << 30, rem1 = 1 << 30;
    { int g0 = 0, g1 = 0;
#pragma unroll
        for (int m = 0; m < NR; ++m) { const u64 mk = __ballot(key[m] > Tv); g0 += __builtin_popcount((unsigned)mk); g1 += __builtin_popcount((unsigned)(mk >> 32)); if ((m & 7) == 7) SBAR(); }
        if (!ex0) rem0 = 256 - g0; if (!ex1) rem1 = 256 - g1; }
    u64 mine = 0ull;
#pragma nounroll
    for (int jq = 0; jq < NR / 8; ++jq) {
#pragma unroll
        for (int jj = 0; jj < 4; ++jj) { const int j = jq * 4 + jj;
            unsigned w0[2], w1[2];
#pragma unroll
            for (int hh = 0; hh < 2; ++hh) { unsigned kv = 0u;
#pragma unroll
                for (int m = 0; m < NR; ++m) if ((m >> 3) == 0) {}
#pragma unroll
                for (int m = 0; m < NR; ++m) kv = (m == 2 * j + hh) ? key[m] : kv;
                const u64 gt = __ballot(kv > Tv), eq = __ballot(kv == Tv);
                { const unsigned e = (unsigned)eq, g = (unsigned)gt; const int ne = __builtin_popcount(e); unsigned sel = g; if (rem0 >= ne) { sel |= e; rem0 -= ne; } else if (rem0 > 0) { sel |= low_bits_keep32(e, rem0); rem0 = 0; } w0[hh] = sel; }
                { const unsigned e = (unsigned)(eq >> 32), g = (unsigned)(gt >> 32); const int ne = __builtin_popcount(e); unsigned sel = g; if (rem1 >= ne) { sel |= e; rem1 -= ne; } else if (rem1 > 0) { sel |= low_bits_keep32(e, rem1); rem1 = 0; } w1[hh] = sel; } }
            const u64 q0w = (u64)w0[0] | ((u64)w0[1] << 32), q1w = (u64)w1[0] | ((u64)w1[1] << 32);
            if (lane == j) mine = q0w; if (lane == 32 + j) mine = q1w; }
    }
    const int jl = lane & 31;
    if (jl < nkb) mrow[(lane >> 5) * 32 + jl] = mine;
}
template <int J0> __device__ __forceinline__ void index_scores8(unsigned (&key)[64], const bf16x8 (&af)[2], const f32x4& iw4, const bf16_t* kvsrc, char* lds, int nkb, u32x4 (&stg)[8], int tid) {
    const int lane = tid & 63, sub = lane & 15, kg = lane >> 4;
#pragma unroll
    for (int jj = 0; jj < 8; ++jj) {
        const int j = J0 + jj;
        if (j < nkb) {
            if (j + 1 < nkb) *(u32x4*)(lds + ((j + 1) & 1) * idx::KBUF + (tid >> 3) * idx::KST + (tid & 7) * 16) = stg[(jj + 1) & 7];
            if (j + 8 < nkb) stg[jj] = *(const u32x4*)(kvsrc + (size_t)(j + 8) * 64 * 64);
            const char* kb = lds + (j & 1) * idx::KBUF + sub * idx::KST + kg * 16;
#pragma unroll
            for (int pr = 0; pr < 2; ++pr) {
                f32x4 dA = (f32x4){0.f, 0.f, 0.f, 0.f}, dB = dA;
#pragma unroll
                for (int ks = 0; ks < 2; ++ks) {
                    const bf16x8 fA = *(const bf16x8*)(kb + (pr * 32) * idx::KST + ks * 64), fB = *(const bf16x8*)(kb + (pr * 32 + 16) * idx::KST + ks * 64);
                    dA = __builtin_amdgcn_mfma_f32_16x16x32_bf16(af[ks], fA, dA, 0, 0, 0); dB = __builtin_amdgcn_mfma_f32_16x16x32_bf16(af[ks], fB, dB, 0, 0, 0); }
                float pA = 0.f, pB = 0.f;
#pragma unroll
                for (int r = 0; r < 4; ++r) { pA += fmaxf(dA[r], 0.f) * iw4[r]; pB += fmaxf(dB[r], 0.f) * iw4[r]; }
                auto rr = __builtin_amdgcn_permlane16_swap(__float_as_uint(pA), __float_as_uint(pB), false, false);
                key[2 * j + pr] = sortable_key(__uint_as_float(rr[0]) + __uint_as_float(rr[1]));
            }
            __syncthreads();
        }
    }
}
__device__ __forceinline__ void ph_index(Frame& F, const int abl = 0) {
    const bf16_t* IQ = (const bf16_t*)(F.outb + OUT_IQ); const bf16_t* IK = (const bf16_t*)(F.outb + OUT_IK); const float* IW = (const float*)(F.outb + OUT_IW);
    u64* MASK = (u64*)(F.outb + OUT_MASK);
    char* lds = (char*)(unsigned char*)F.lds;
    const int tid = F.tid, lane = F.lane, sub = lane & 15, kg = lane >> 4;
    for (int item = F.bid; item < NTOK / 16; item += F.G) {
        const int tokw = (((item & 255) >> 3) << 11) + (((item & 7) + 8 * (item >> 8)) << 4) + F.wave * 2, b = tokw >> 11, pos0 = tokw & 2047, nkb = (pos0 >> 6) + 1;
        u64* mrow = MASK + (size_t)tokw * 32;
        if (nkb <= 4) { if ((lane & 31) < nkb) mrow[(lane >> 5) * 32 + (lane & 31)] = ~0ull; continue; }
        bf16x8 af[2];
        { const bf16_t* ap = IQ + (size_t)(tokw + (sub >> 3)) * 512 + (sub & 7) * 64 + kg * 8;
#pragma unroll
          for (int ks = 0; ks < 2; ++ks) af[ks] = *(const bf16x8*)(ap + ks * 32); }
        const f32x4 iw4 = *(const f32x4*)(IW + (size_t)(tokw + (lane >> 5)) * 8 + 4 * (kg & 1));
        unsigned key[64];
#pragma unroll
        for (int m = 0; m < 64; ++m) key[m] = 0u;
        const bf16_t* kvsrc = IK + ((size_t)b * SEQ + (tid >> 3)) * 64 + (tid & 7) * 8;
        u32x4 stg[8];
#pragma unroll
        for (int i = 0; i < 8; ++i) stg[i] = (i < nkb) ? *(const u32x4*)(kvsrc + (size_t)i * 64 * 64) : (u32x4){0u, 0u, 0u, 0u};
        __syncthreads();
        *(u32x4*)(lds + (tid >> 3) * idx::KST + (tid & 7) * 16) = stg[0];
        __syncthreads();
        const int ng = (nkb + 7) >> 3;
        if (!(abl & 1)) {
        index_scores8<0>(key, af, iw4, kvsrc, lds, nkb, stg, tid);
        if (ng > 1) index_scores8<8>(key, af, iw4, kvsrc, lds, nkb, stg, tid);
        if (ng > 2) index_scores8<16>(key, af, iw4, kvsrc, lds, nkb, stg, tid);
        if (ng > 3) index_scores8<24>(key, af, iw4, kvsrc, lds, nkb, stg, tid);
        }
        if (abl & 2) { if (key[0] == 0x12345u && key[63] == 7u) mrow[lane] = 1ull; continue; }
        if (ng == 1) topk2_select_write<1>(key, nkb, mrow, lane);
        else if (ng == 2) topk2_select_write<2>(key, nkb, mrow, lane);
        else if (ng == 3) topk2_select_write<3>(key, nkb, mrow, lane);
        else topk2_select_write<4>(key, nkb, mrow, lane);
    }
}

namespace att {
constexpr int KVBLK = 64;
constexpr int SHM_V = KVBLK * 128 * 2, SHM_K = SHM_V;
constexpr int OFF_V = 0, OFF_K = 2 * SHM_V, OFF_WS = 2 * SHM_V + 2 * SHM_K, OFF_BT = OFF_WS + NWAVES * 64 * 4;
constexpr int OFF_OT = 81920, OT_ST = 144;
#define KSWZ(row, colB) ((row) * 256 + ((colB) ^ (((row) & 7) << 4)))
__device__ __forceinline__ int crow(int r, int hi) { return (r & 3) + 8 * (r >> 2) + 4 * hi; }
__device__ __forceinline__ int v_st(int k, int c) { const int kk = (k & ~0xC) | ((k & 4) << 1) | ((k & 8) >> 1); return ((kk >> 3) * 4 + (c >> 5)) * 512 + ((kk & 7) * 32 + (c & 31)) * 2; }
__device__ __forceinline__ int v_rd_base(int lane) { return ((lane & 3) << 3) | (((lane >> 2) & 3) << 6) | (((lane >> 4) & 1) << 5) | (((lane >> 5) & 1) << 8); }
constexpr int v_rd_off(int d0, int ks, int half) { return d0 * 512 + ks * 4096 + half * 2048; }
template <int OFF> __device__ __forceinline__ s16x4 tr_read(int vb) { s16x4 r; asm volatile("ds_read_b64_tr_b16 %0, %1 offset:%2" : "=&v"(r) : "v"(vb), "i"(OFF) : "memory"); return r; }
template <int D0> __device__ __forceinline__ void pv_one(f32x16& od, int vb, bf16x8 pa0, bf16x8 pa1, bf16x8 pa2, bf16x8 pa3) {
    const s16x4 l0 = tr_read<v_rd_off(D0, 0, 0)>(vb), h0 = tr_read<v_rd_off(D0, 0, 1)>(vb), l1 = tr_read<v_rd_off(D0, 1, 0)>(vb), h1 = tr_read<v_rd_off(D0, 1, 1)>(vb);
    const s16x4 l2 = tr_read<v_rd_off(D0, 2, 0)>(vb), h2 = tr_read<v_rd_off(D0, 2, 1)>(vb), l3 = tr_read<v_rd_off(D0, 3, 0)>(vb), h3 = tr_read<v_rd_off(D0, 3, 1)>(vb);
    asm volatile("s_waitcnt lgkmcnt(0)" ::: "memory"); SBAR();
#define PK(L, H) (bf16x8){L[0], L[1], L[2], L[3], H[0], H[1], H[2], H[3]}
    od = __builtin_amdgcn_mfma_f32_32x32x16_bf16(pa0, PK(l0, h0), od, 0, 0, 0);
    od = __builtin_amdgcn_mfma_f32_32x32x16_bf16(pa1, PK(l1, h1), od, 0, 0, 0);
    od = __builtin_amdgcn_mfma_f32_32x32x16_bf16(pa2, PK(l2, h2), od, 0, 0, 0);
    od = __builtin_amdgcn_mfma_f32_32x32x16_bf16(pa3, PK(l3, h3), od, 0, 0, 0);
#undef PK
}
__device__ __forceinline__ void qkt(f32x16& p0, f32x16& p1, const char* Ks, const bf16x8* qr, int r32, int hi) {
    p0 = f32x16{}; p1 = f32x16{};
    int rv = r32; asm volatile("" : "+v"(rv));
    const char* kb = Ks + rv * 256; const int swz = ((rv & 7) << 4) ^ (hi * 16);
#pragma unroll
    for (int d0 = 0; d0 < 8; ++d0) { const char* ka = kb + ((d0 * 32) ^ swz);
        const bf16x8 b0 = *reinterpret_cast<const bf16x8*>(ka);
        const bf16x8 b1 = *reinterpret_cast<const bf16x8*>(ka + 8192);
        p0 = __builtin_amdgcn_mfma_f32_32x32x16_bf16(b0, qr[d0], p0, 0, 0, 0);
        p1 = __builtin_amdgcn_mfma_f32_32x32x16_bf16(b1, qr[d0], p1, 0, 0, 0); }
}
__device__ __forceinline__ void attn_item(Frame& F, int b, int q0, char* lds) {
    const bf16_t* Q = (const bf16_t*)(F.ws + WS_Q); const bf16_t* KV = (const bf16_t*)(F.outb + OUT_KV); const u64* MASK = (const u64*)(F.outb + OUT_MASK);
    bf16_t* OA = (bf16_t*)(F.outb + OUT_OA);
    int tid = F.tid; asm volatile("" : "+v"(tid));
    const int wid = F.wave, lane = tid & 63, r32 = lane & 31, hi = lane >> 5;
    char* V_lds = lds + OFF_V; char* K_lds = lds + OFF_K;
    float* wsl = (float*)(lds + OFF_WS) + wid * 64; float* li_l = wsl; float* al_l = wsl + 32;
    const float* btab = (const float*)(lds + OFF_BT);
    constexpr float C = 0.088388347648318440f * LOG2E;
    float m_reg = -1e30f, l_reg = 0.f; f32x16 o[4] = {}; bf16x8 qr[8];
    const size_t tokq = (size_t)b * SEQ + q0 + r32;
    { const bf16_t* Qw = Q + tokq * 1024 + wid * 128 + hi * 8;
#pragma unroll
      for (int d0 = 0; d0 < 8; ++d0) qr[d0] = *(const bf16x8*)(Qw + d0 * 16); }
    const u64* mq = MASK + tokq * 32;
    const int sr = tid >> 4, sc = (tid & 15) * 8;
    const int vb0 = (int)(uintptr_t)V_lds + v_rd_base(lane);
    const bf16_t* Kb = KV + (size_t)b * SEQ * 128;
    const int NT = (q0 >> 6) + 1;
    const float bfar = btab[wid];
    bf16x8 s0, s1;
#define SLOAD(k0) do { s0 = *(const bf16x8*)(Kb + (size_t)((k0) + sr) * 128 + sc); s1 = *(const bf16x8*)(Kb + (size_t)((k0) + 32 + sr) * 128 + sc); } while (0)
#define SWRITE(bf) do { int srv = sr; asm volatile("" : "+v"(srv)); const int kc = sc * 2; const int v0a = v_st(srv, sc), k0a = KSWZ(srv, kc); \
        *(bf16x8*)(V_lds + (bf) * SHM_V + v0a) = s0; *(bf16x8*)(V_lds + (bf) * SHM_V + v0a + 8192) = s1; \
        *(bf16x8*)(K_lds + (bf) * SHM_K + k0a) = s0; *(bf16x8*)(K_lds + (bf) * SHM_K + k0a + 8192) = s1; } while (0)
    __syncthreads();
    SLOAD(0); VM_WAIT(); SWRITE(0); __syncthreads();
    u64 mw_next = mq[0];
    for (int j = 0; j < NT; ++j) {
        int lanel = lane; asm volatile("" : "+v"(lanel)); const int r32l = lanel & 31, hil = lanel >> 5;
        const int bf = j & 1;
        if (j + 1 < NT) SLOAD((j + 1) * KVBLK);
        const u64 mw = mw_next; if (j + 1 < NT) mw_next = mq[j + 1];
        f32x16 p0, p1;
        qkt(p0, p1, K_lds + bf * SHM_K, qr, r32l, hil);
        const unsigned w0 = (unsigned)(mw >> (4 * hil)), w1 = (unsigned)(mw >> (32 + 4 * hil));
        const int relmax = j * KVBLK + 63 - q0;
        float alpha = 1.f, ps = 0.f;
        if (relmax <= -91) {
            float pmax = p0[0];
#pragma unroll
            for (int r = 1; r < 16; ++r) pmax = fmaxf(pmax, p0[r]);
#pragma unroll
            for (int r = 0; r < 16; ++r) pmax = fmaxf(pmax, p1[r]);
            { auto rr = __builtin_amdgcn_permlane32_swap(__float_as_uint(pmax), __float_as_uint(pmax), false, false); pmax = fmaxf(__uint_as_float(rr[0]), __uint_as_float(rr[1])); }
            pmax = fmaf(pmax, C, bfar);
            if (!__all(pmax - m_reg <= 11.0f)) { const float mn = fmaxf(m_reg, pmax); alpha = __builtin_amdgcn_exp2f(m_reg - mn); m_reg = mn; }
            const float off = bfar - m_reg;
#pragma unroll
            for (int r = 0; r < 16; ++r) { const int cb = (r & 3) + 8 * (r >> 2);
                const float e0 = __builtin_amdgcn_exp2f(fmaf(p0[r], C, off)), e1 = __builtin_amdgcn_exp2f(fmaf(p1[r], C, off));
                p0[r] = __uint_as_float(__float_as_uint(e0) & (unsigned)__builtin_amdgcn_sbfe((int)w0, cb, 1)); p1[r] = __uint_as_float(__float_as_uint(e1) & (unsigned)__builtin_amdgcn_sbfe((int)w1, cb, 1)); ps += p0[r] + p1[r]; }
        } else {
            const float* bp = btab + (j * KVBLK + 4 * hil - (q0 + r32l) + 185) * 8 + wid;
#pragma unroll
            for (int r4 = 0; r4 < 4; ++r4) {
#pragma unroll
                for (int rr = 0; rr < 4; ++rr) { const int r = r4 * 4 + rr; const int cb = (r & 3) + 8 * (r >> 2); p0[r] = fmaf(p0[r], C, bp[cb * 8]); p1[r] = fmaf(p1[r], C, bp[(cb + 32) * 8]); }
                SBAR(); }
            float pmax = p0[0];
#pragma unroll
            for (int r = 1; r < 16; ++r) pmax = fmaxf(pmax, p0[r]);
#pragma unroll
            for (int r = 0; r < 16; ++r) pmax = fmaxf(pmax, p1[r]);
            { auto rr = __builtin_amdgcn_permlane32_swap(__float_as_uint(pmax), __float_as_uint(pmax), false, false); pmax = fmaxf(__uint_as_float(rr[0]), __uint_as_float(rr[1])); }
            if (!__all(pmax - m_reg <= 11.0f)) { const float mn = fmaxf(m_reg, pmax); alpha = __builtin_amdgcn_exp2f(m_reg - mn); m_reg = mn; }
#pragma unroll
            for (int r = 0; r < 16; ++r) { const int cb = (r & 3) + 8 * (r >> 2);
                const float e0 = __builtin_amdgcn_exp2f(p0[r] - m_reg), e1 = __builtin_amdgcn_exp2f(p1[r] - m_reg);
                p0[r] = __uint_as_float(__float_as_uint(e0) & (unsigned)__builtin_amdgcn_sbfe((int)w0, cb, 1)); p1[r] = __uint_as_float(__float_as_uint(e1) & (unsigned)__builtin_amdgcn_sbfe((int)w1, cb, 1)); ps += p0[r] + p1[r]; }
        }
        { auto rr = __builtin_amdgcn_permlane32_swap(__float_as_uint(ps), __float_as_uint(ps), false, false); ps = __uint_as_float(rr[0]) + __uint_as_float(rr[1]); }
        l_reg = l_reg * alpha + ps;
        bf16x8 pa0, pa1, pa2, pa3;
#define PK4(P, BASE, OUT) do { unsigned a0 = cvt_pk_bf16(P[BASE + 0], P[BASE + 1]), a1 = cvt_pk_bf16(P[BASE + 2], P[BASE + 3]);   \
    unsigned b0 = cvt_pk_bf16(P[BASE + 4], P[BASE + 5]), b1 = cvt_pk_bf16(P[BASE + 6], P[BASE + 7]);                              \
    auto r0 = __builtin_amdgcn_permlane32_swap(a0, b0, false, false); auto r1 = __builtin_amdgcn_permlane32_swap(a1, b1, false, false); \
    u32x4 w = {r0[0], r1[0], r0[1], r1[1]}; OUT = *reinterpret_cast<bf16x8*>(&w); } while (0)
        PK4(p0, 0, pa0); PK4(p0, 8, pa1); PK4(p1, 0, pa2); PK4(p1, 8, pa3);
#undef PK4
        if (__any(alpha < 1.f)) { if (hil == 0) al_l[r32l] = alpha; LDS_WAIT();
#pragma unroll
            for (int d = 0; d < 4; ++d)
#pragma unroll
                for (int r = 0; r < 16; ++r) o[d][r] *= al_l[crow(r, hil)]; }
        const int vb = (int)(uintptr_t)V_lds + v_rd_base(lanel) + bf * SHM_V;
        pv_one<0>(o[0], vb, pa0, pa1, pa2, pa3); pv_one<1>(o[1], vb, pa0, pa1, pa2, pa3); pv_one<2>(o[2], vb, pa0, pa1, pa2, pa3); pv_one<3>(o[3], vb, pa0, pa1, pa2, pa3);
        if (j + 1 < NT) { VM_WAIT(); SWRITE(bf ^ 1); }
        __syncthreads();
    }
#undef SLOAD
#undef SWRITE
    if (hi == 0) li_l[r32] = l_reg; LDS_WAIT();
    bf16_t* Ow = OA + ((size_t)b * SEQ + q0 + 4 * hi) * 1024 + wid * 128 + r32;
    const float* lip = li_l + 4 * hi;
    unsigned char* Ow8 = (unsigned char*)OA + ((size_t)b * SEQ + q0 + 4 * hi) * 1024 + wid * 128 + r32;
    asm volatile("" : "+v"(Ow), "+v"(lip), "+v"(Ow8));
#pragma unroll
    for (int r = 0; r < 16; ++r) { const int ro = (r & 3) + 8 * (r >> 2); if ((r & 3) == 0) asm volatile("" : "+v"(Ow), "+v"(Ow8), "+v"(lip)); const float rl = fast_rcp(lip[ro]);
#pragma unroll
        for (int d0 = 0; d0 < 4; ++d0) { float v = o[d0][r] * rl; if ((DBG_ATTN_ZERO == 1 && q0 < 256) || (DBG_ATTN_ZERO == 2 && q0 >= 256)) v = 0.f;
            if (PA_FP8) ((unsigned char*)Ow8)[ro * 1024 + d0 * 32] = (unsigned char)(__builtin_amdgcn_cvt_pk_fp8_f32(v, v, 0, false) & 0xff);
            else Ow[ro * 1024 + d0 * 32] = (bf16_t)(cvt_pk_bf16(v, v) & 0xffffu); }
        if ((r & 3) == 3) SBAR(); }
}
__device__ __forceinline__ void att2_partial(f32x16& p0, f32x16& p1, float& m_reg, float& alpha, unsigned w0, bool far, float bfar, const float* bp) {
    constexpr float C = 0.088388347648318440f * LOG2E;
    float off;
    if (far) {
        float pmax = p0[0];
#pragma unroll
        for (int r = 1; r < 16; ++r) pmax = fmaxf(pmax, p0[r]);
#pragma unroll
        for (int r = 0; r < 16; ++r) pmax = fmaxf(pmax, p1[r]);
        { auto rr = __builtin_amdgcn_permlane32_swap(__float_as_uint(pmax), __float_as_uint(pmax), false, false); pmax = fmaxf(__uint_as_float(rr[0]), __uint_as_float(rr[1])); }
        pmax = fmaf(pmax, C, bfar);
        if (__builtin_expect(__all(pmax - m_reg <= 11.0f), 1)) alpha = 1.f; else { const float mn = fmaxf(m_reg, pmax); alpha = __builtin_amdgcn_exp2f(m_reg - mn); m_reg = mn; }
        off = bfar - m_reg;
#pragma unroll
        for (int r = 0; r < 16; ++r) { p0[r] = fmaf(p0[r], C, off); p1[r] = fmaf(p1[r], C, off); }
    } else {
#pragma unroll
        for (int r4 = 0; r4 < 4; ++r4) {
#pragma unroll
            for (int rr = 0; rr < 4; ++rr) { const int r = r4 * 4 + rr; const int cb = (r & 3) + 8 * (r >> 2); p0[r] = fmaf(p0[r], C, bp[cb * 8]); p1[r] = fmaf(p1[r], C, bp[(cb + 32) * 8]); }
            SBAR(); }
        float pmax = p0[0];
#pragma unroll
        for (int r = 1; r < 16; ++r) pmax = fmaxf(pmax, p0[r]);
#pragma unroll
        for (int r = 0; r < 16; ++r) pmax = fmaxf(pmax, p1[r]);
        { auto rr = __builtin_amdgcn_permlane32_swap(__float_as_uint(pmax), __float_as_uint(pmax), false, false); pmax = fmaxf(__uint_as_float(rr[0]), __uint_as_float(rr[1])); }
        if (__builtin_expect(__all(pmax - m_reg <= 11.0f), 1)) alpha = 1.f; else { const float mn = fmaxf(m_reg, pmax); alpha = __builtin_amdgcn_exp2f(m_reg - mn); m_reg = mn; }
#pragma unroll
        for (int r = 0; r < 16; ++r) { p0[r] -= m_reg; p1[r] -= m_reg; }
    }
#pragma unroll
    for (int r = 0; r < 16; ++r) { const int cb = (r & 3) + 8 * (r >> 2); p0[r] = __uint_as_float(__float_as_uint(__builtin_amdgcn_exp2f(p0[r])) & (unsigned)__builtin_amdgcn_sbfe((int)w0, cb, 1)); }
}
__device__ __forceinline__ void att2_finish(f32x16& p0, f32x16& p1, float alpha, float& l_reg, unsigned w1, bf16x8& pa0, bf16x8& pa1, bf16x8& pa2, bf16x8& pa3) {
#pragma unroll
    for (int r = 0; r < 16; ++r) { const int cb = (r & 3) + 8 * (r >> 2); p1[r] = __uint_as_float(__float_as_uint(__builtin_amdgcn_exp2f(p1[r])) & (unsigned)__builtin_amdgcn_sbfe((int)w1, cb, 1)); }
    float ps = 0.f;
#pragma unroll
    for (int r = 0; r < 16; ++r) ps += p0[r];
#pragma unroll
    for (int r = 0; r < 16; ++r) ps += p1[r];
    { auto rr = __builtin_amdgcn_permlane32_swap(__float_as_uint(ps), __float_as_uint(ps), false, false); ps = __uint_as_float(rr[0]) + __uint_as_float(rr[1]); }
    l_reg = l_reg * alpha + ps;
#define PK4(P, BASE, OUT) do { unsigned a0 = cvt_pk_bf16(P[BASE + 0], P[BASE + 1]), a1 = cvt_pk_bf16(P[BASE + 2], P[BASE + 3]);   \
    unsigned b0 = cvt_pk_bf16(P[BASE + 4], P[BASE + 5]), b1 = cvt_pk_bf16(P[BASE + 6], P[BASE + 7]);                              \
    auto r0 = __builtin_amdgcn_permlane32_swap(a0, b0, false, false); auto r1 = __builtin_amdgcn_permlane32_swap(a1, b1, false, false); \
    u32x4 w = {r0[0], r1[0], r0[1], r1[1]}; OUT = *reinterpret_cast<bf16x8*>(&w); } while (0)
    PK4(p0, 0, pa0); PK4(p0, 8, pa1); PK4(p1, 0, pa2); PK4(p1, 8, pa3);
#undef PK4
}
__device__ __forceinline__ void attn_item2(Frame& F, int b, int q0, char* lds) {
    const bf16_t* Q = (const bf16_t*)(F.ws + WS_Q); const bf16_t* KV = (const bf16_t*)(F.outb + OUT_KV); const u64* MASK = (const u64*)(F.outb + OUT_MASK);
    bf16_t* OA = (bf16_t*)(F.outb + OUT_OA);
    int tid = F.tid; asm volatile("" : "+v"(tid));
    const int wid = F.wave, lane = tid & 63, r32 = lane & 31, hi = lane >> 5;
    char* V_lds = lds + OFF_V; char* K_lds = lds + OFF_K;
    float* wsl = (float*)(lds + OFF_WS) + wid * 64; float* li_l = wsl; float* al_l = wsl + 32;
    const float* btab = (const float*)(lds + OFF_BT);
    float m_reg = -1e30f, l_reg = 0.f; f32x16 o[4] = {}; bf16x8 qr[8];
    const size_t tokq = (size_t)b * SEQ + q0 + r32;
    { const bf16_t* Qw = Q + tokq * 1024 + wid * 128 + hi * 8;
#pragma unroll
      for (int d0 = 0; d0 < 8; ++d0) qr[d0] = *(const bf16x8*)(Qw + d0 * 16); }
    const u64* mq = MASK + tokq * 32;
    const int sr = tid >> 4, sc = (tid & 15) * 8;
    const bf16_t* Kb = KV + (size_t)b * SEQ * 128;
    const int NTr = (q0 >> 6) + 1, NT = (NTr + 1) & ~1;
    const float bfar = btab[wid];
    bf16x8 sA0, sA1, sB0, sB1;
#define SLD(s0_, s1_, k0) do { int srl = sr; asm volatile("" : "+v"(srl)); const bf16_t* kp_ = Kb + (size_t)((k0) + srl) * 128 + sc; s0_ = *(const bf16x8*)kp_; s1_ = *(const bf16x8*)(kp_ + 32 * 128); } while (0)
#define SWR(bf, s0_, s1_) do { int srv = sr; asm volatile("" : "+v"(srv)); const int kc = sc * 2; const int v0a = v_st(srv, sc), k0a = KSWZ(srv, kc); \
        *(bf16x8*)(V_lds + (bf) * SHM_V + v0a) = s0_; *(bf16x8*)(V_lds + (bf) * SHM_V + v0a + 8192) = s1_; \
        *(bf16x8*)(K_lds + (bf) * SHM_K + k0a) = s0_; *(bf16x8*)(K_lds + (bf) * SHM_K + k0a + 8192) = s1_; } while (0)
#define MWORD(j) ((j) < NTr ? mq[j] : 0ull)
#define RESC(a) do { if (__any((a) < 1.f)) { if (hi == 0) al_l[r32] = (a); LDS_WAIT(); \
        _Pragma("unroll") for (int d = 0; d < 4; ++d) _Pragma("unroll") for (int r = 0; r < 16; ++r) o[d][r] *= al_l[crow(r, hi)]; } } while (0)
#define PVALL(bf) do { int ll = lane; asm volatile("" : "+v"(ll)); const int vb = (int)(uintptr_t)V_lds + v_rd_base(ll) + (bf) * SHM_V; \
        pv_one<0>(o[0], vb, pa0, pa1, pa2, pa3); pv_one<1>(o[1], vb, pa0, pa1, pa2, pa3); pv_one<2>(o[2], vb, pa0, pa1, pa2, pa3); pv_one<3>(o[3], vb, pa0, pa1, pa2, pa3); } while (0)
#define ISFAR(jt) ((jt) * KVBLK + 63 - q0 <= -91 || (jt) >= NTr)
#define BPTR(jt) (btab + ((jt) * KVBLK + 4 * hi - (q0 + r32) + 185) * 8 + wid)
    f32x16 pA0, pA1, pB0, pB1; float alA, alB; bf16x8 pa0, pa1, pa2, pa3; u64 mwA, mwB;
    __syncthreads();
    SLD(sA0, sA1, 0); mwA = MWORD(0); VM_WAIT(); SWR(0, sA0, sA1); __syncthreads();
    qkt(pA0, pA1, K_lds, qr, r32, hi);
    att2_partial(pA0, pA1, m_reg, alA, (unsigned)(mwA >> (4 * hi)), ISFAR(0), bfar, BPTR(0));
    SLD(sB0, sB1, KVBLK); mwB = MWORD(1); if (2 < NT) SLD(sA0, sA1, 2 * KVBLK);
    SWR(1, sB0, sB1); __syncthreads();
    for (int j = 1; j + 1 < NT; j += 2) {
        SBAR(); qkt(pB0, pB1, K_lds + SHM_K, qr, r32, hi);
        att2_finish(pA0, pA1, alA, l_reg, (unsigned)(mwA >> (32 + 4 * hi)), pa0, pa1, pa2, pa3); SBAR();
        SLD(sB0, sB1, (j + 2) * KVBLK); mwA = MWORD(j + 1); SBAR();
        PVALL(0);
        att2_partial(pB0, pB1, m_reg, alB, (unsigned)(mwB >> (4 * hi)), ISFAR(j), bfar, BPTR(j));
        __syncthreads(); SWR(0, sA0, sA1);
        RESC(alB); __syncthreads();
        SBAR(); qkt(pA0, pA1, K_lds, qr, r32, hi);
        att2_finish(pB0, pB1, alB, l_reg, (unsigned)(mwB >> (32 + 4 * hi)), pa0, pa1, pa2, pa3); SBAR();
        if (j + 3 < NT) SLD(sA0, sA1, (j + 3) * KVBLK); mwB = MWORD(j + 2); SBAR();
        PVALL(1);
        att2_partial(pA0, pA1, m_reg, alA, (unsigned)(mwA >> (4 * hi)), ISFAR(j + 1), bfar, BPTR(j + 1));
        __syncthreads(); SWR(1, sB0, sB1);
        RESC(alA); __syncthreads();
    }
    SBAR(); qkt(pB0, pB1, K_lds + SHM_K, qr, r32, hi);
    att2_finish(pA0, pA1, alA, l_reg, (unsigned)(mwA >> (32 + 4 * hi)), pa0, pa1, pa2, pa3); SBAR();
    PVALL(0);
    att2_partial(pB0, pB1, m_reg, alB, (unsigned)(mwB >> (4 * hi)), ISFAR(NT - 1), bfar, BPTR(NT - 1));
    __syncthreads(); RESC(alB);
    att2_finish(pB0, pB1, alB, l_reg, (unsigned)(mwB >> (32 + 4 * hi)), pa0, pa1, pa2, pa3); SBAR();
    PVALL(1);
#undef SLD
#undef SWR
#undef MWORD
#undef RESC
#undef PVALL
#undef ISFAR
#undef BPTR
    LAS float* li_s = (LAS float*)(F.lds + OFF_WS) + wid * 64;
    if (hi == 0) li_s[r32] = l_reg; LDS_WAIT();
    if (PA_FP8 && ATT_OT) {
        LAS unsigned char* ot = F.lds + OFF_OT + wid * (32 * OT_ST);
        int ob = (4 * hi) * OT_ST + r32, lo = 4 * hi; asm volatile("" : "+v"(ob), "+v"(lo));
#pragma unroll
        for (int r = 0; r < 16; ++r) { const int ro = (r & 3) + 8 * (r >> 2); if ((r & 3) == 0) asm volatile("" : "+v"(ob), "+v"(lo)); const float rl = fast_rcp(li_s[lo + ro]);
#pragma unroll
            for (int d0 = 0; d0 < 4; ++d0) { const float v = o[d0][r] * rl; ot[ob + ro * OT_ST + d0 * 32] = (unsigned char)(__builtin_amdgcn_cvt_pk_fp8_f32(v, v, 0, false) & 0xff); }
            if ((r & 3) == 3) SBAR(); }
        LDS_WAIT(); asm volatile("" ::: "memory");
        unsigned char* Og = (unsigned char*)OA + ((size_t)b * SEQ + q0) * 1024 + wid * 128;
        int rr = lane >> 3, sg = (lane & 7) * 16; asm volatile("" : "+v"(rr), "+v"(sg));
#pragma unroll
        for (int i = 0; i < 4; ++i) { const u32x4 w = *(const LAS u32x4*)(ot + (i * 8 + rr) * OT_ST + sg); *(u32x4*)(Og + (size_t)(i * 8 + rr) * 1024 + sg) = w; }
        LDS_WAIT();
    } else if (PA_FP8) {
        GAS unsigned char* Ow8 = (GAS unsigned char*)((unsigned char*)OA + ((size_t)b * SEQ + q0 + 4 * hi) * 1024 + wid * 128 + r32);
        int lo = 4 * hi; asm volatile("" : "+v"(Ow8), "+v"(lo));
#pragma unroll
        for (int r = 0; r < 16; ++r) { const int ro = (r & 3) + 8 * (r >> 2); if ((r & 3) == 0) asm volatile("" : "+v"(Ow8), "+v"(lo)); const float rl = fast_rcp(li_s[lo + ro]);
#pragma unroll
            for (int d0 = 0; d0 < 4; ++d0) { const float v = o[d0][r] * rl; Ow8[ro * 1024 + d0 * 32] = (unsigned char)(__builtin_amdgcn_cvt_pk_fp8_f32(v, v, 0, false) & 0xff); }
            if ((r & 3) == 3) SBAR(); }
    } else {
        bf16_t* Ow = OA + ((size_t)b * SEQ + q0 + 4 * hi) * 1024 + wid * 128 + r32;
        int lo = 4 * hi; asm volatile("" : "+v"(Ow), "+v"(lo));
#pragma unroll
        for (int r = 0; r < 16; ++r) { const int ro = (r & 3) + 8 * (r >> 2); if ((r & 3) == 0) asm volatile("" : "+v"(Ow), "+v"(lo)); const float rl = fast_rcp(li_s[lo + ro]);
#pragma unroll
            for (int d0 = 0; d0 < 4; ++d0) { const float v = o[d0][r] * rl; Ow[ro * 1024 + d0 * 32] = (bf16_t)(cvt_pk_bf16(v, v) & 0xffffu); }
            if ((r & 3) == 3) SBAR(); }
    }
}
}
__device__ __forceinline__ void ph_attn(Frame& F) {
    char* lds = (char*)(unsigned char*)F.lds;
    { float* bt = (float*)(lds + att::OFF_BT); const float* BT = (const float*)(F.ws + WS_BIAST); __syncthreads(); for (int i = F.tid; i < 249 * 8; i += NTHR) bt[i] = BT[i]; __syncthreads(); }
    for (int pr = F.bid; pr < NB * 32; pr += F.G) {
        const int b = pr >> 5, qb = pr & 31;
#pragma nounroll
        for (int hh = 0; hh < 2; ++hh) { if (ATT2) att::attn_item2(F, b, (hh ? qb : 63 - qb) * 32, lds); else att::attn_item(F, b, (hh ? qb : 63 - qb) * 32, lds); }
    }
}

namespace ssd {
constexpr int OFF_CS = 0, CS_ST = 272;
constexpr int OFF_BS = OFF_CS + 64 * CS_ST;
constexpr int OFF_BT = OFF_BS + 64 * CS_ST, T_ST = 144;
constexpr int OFF_XT = OFF_BT + 128 * T_ST;
constexpr int OFF_XW = OFF_XT + 64 * T_ST;
constexpr int OFF_XS = OFF_XW + 64 * T_ST;
constexpr int OFF_MT = OFF_XS + 64 * T_ST;
constexpr int OFF_HS = OFF_MT + 64 * T_ST;
constexpr int OFF_END = OFF_HS + 64 * CS_ST;
static_assert(OFF_END + 5 * 320 * 4 <= 131072, "ssd lds");
__device__ __forceinline__ f32x4 mfma16(bf16x8 a, bf16x8 b, f32x4 c) { return __builtin_amdgcn_mfma_f32_16x16x32_bf16(a, b, c, 0, 0, 0); }
__device__ __forceinline__ bf16x8 ldfrag(const char* base, int stride, int row, int k0) { return *(const bf16x8*)(base + row * stride + k0 * 2); }
}
__device__ __forceinline__ void ph_ssd(Frame& F) {
    using namespace ssd;
    char* lds = (char*)(unsigned char*)F.lds;
    const bf16_t* XBC = (const bf16_t*)(F.ws + WS_XBC); const bf16_t* ZS = (const bf16_t*)(F.ws + WS_Z); const float* DT = (const float*)(F.outb + OUT_DT);
    bf16_t* YG = (bf16_t*)(F.ws + WS_Q);
    const float* conv_w = F.a->in[9]; const float* conv_b = F.a->in[10]; const float* a_log = F.a->in[12]; const float* d_skip = F.a->in[13];
    const int tid = F.tid, wid = F.wave, lane = F.lane, fr = lane & 15, fq = lane >> 4;
    const bool stager = tid < 320; const int so = tid % 40, tg = tid / 40;
    for (int item = F.bid; item < NB * 16; item += F.G) {
        const int b = item >> 4, h = item & 15, g = h >> 2;
        const float aneg = -__expf(a_log[h]), dsk = d_skip[h];
        const int ch0 = so < 8 ? h * 64 + so * 8 : (so < 24 ? 1024 + g * 128 + (so - 8) * 8 : 1536 + g * 128 + (so - 24) * 8);
        float* CWL = (float*)(lds + OFF_END);
        __syncthreads();
        if (stager) {
#pragma unroll
            for (int j = 0; j < 4; ++j) { *(f32x4*)(CWL + j * 320 + so * 8) = *(const f32x4*)(conv_w + (size_t)j * 2048 + ch0); *(f32x4*)(CWL + j * 320 + so * 8 + 4) = *(const f32x4*)(conv_w + (size_t)j * 2048 + ch0 + 4); }
            *(f32x4*)(CWL + 4 * 320 + so * 8) = *(const f32x4*)(conv_b + ch0); *(f32x4*)(CWL + 4 * 320 + so * 8 + 4) = *(const f32x4*)(conv_b + ch0 + 4);
        }
        f32x4 hst[4];
#pragma unroll
        for (int t = 0; t < 4; ++t) hst[t] = (f32x4){0.f, 0.f, 0.f, 0.f};
        __syncthreads();
        for (int i = tid; i < 64 * CS_ST / 4; i += NTHR) ((unsigned*)(lds + OFF_HS))[i] = 0u;
        u32x4 raw[11];
        const size_t tokb = (size_t)b * SEQ;
#define SSD_LOAD(c) do { if (stager) { _Pragma("unroll") for (int i = 0; i < 11; ++i) { const int t = (c) * 64 + tg * 8 - 3 + i; \
            raw[i] = (t >= 0) ? *(const u32x4*)(XBC + (tokb + t) * 2048 + ch0) : (u32x4){0u, 0u, 0u, 0u}; } } } while (0)
        SSD_LOAD(0);
        float dtl_next = DT[(tokb + lane) * 16 + h];
        for (int c = 0; c < 32; ++c) {
            const float dtl = dtl_next; if (c + 1 < 32) dtl_next = DT[(tokb + (c + 1) * 64 + lane) * 16 + h];
            u32x2 zpre[2];
#pragma unroll
            for (int t2 = 0; t2 < 2; ++t2) { const int tile = 2 * wid + t2, pb = tile >> 2, lb = tile & 3; zpre[t2] = *(const u32x2*)(ZS + (tokb + c * 64 + lb * 16 + fr) * 1024 + h * 64 + pb * 16 + 4 * fq); }
            float acs = dtl * aneg;
#pragma unroll
            for (int o = 1; o < 64; o <<= 1) { const float t = __shfl_up(acs, o); if (lane >= o) acs += t; }
            const float alast = __shfl(acs, 63);
            if (DBG_SSD_SYNC) __syncthreads();
            float dtv[8], dec[8];
#pragma unroll
            for (int t = 0; t < 8; ++t) { dtv[t] = __shfl(dtl, (tg * 8 + t) & 63); dec[t] = __expf(alast - __shfl(acs, (tg * 8 + t) & 63)); }
            if (stager) {
#pragma unroll
                for (int hq = 0; hq < 2; ++hq) {
                    float xin[11][4];
#pragma unroll
                    for (int i = 0; i < 11; ++i) { const unsigned wa = hq ? raw[i].z : raw[i].x, wb = hq ? raw[i].w : raw[i].y; xin[i][0] = bflo(wa); xin[i][1] = bfhi(wa); xin[i][2] = bflo(wb); xin[i][3] = bfhi(wb); }
                    float outv[8][4];
                    { f32x4 cwv[4]; const f32x4 cbq = *(const f32x4*)(CWL + 4 * 320 + so * 8 + hq * 4);
#pragma unroll
                      for (int j = 0; j < 4; ++j) cwv[j] = *(const f32x4*)(CWL + j * 320 + so * 8 + hq * 4);
#pragma unroll
                      for (int t = 0; t < 8; ++t)
#pragma unroll
                        for (int e = 0; e < 4; ++e) { float sacc = cbq[e];
#pragma unroll
                            for (int j = 0; j < 4; ++j) sacc += cwv[j][e] * xin[t + j][e];
                            outv[t][e] = silu_f(sacc); } }
                    if (so < 8) {
#pragma unroll
                        for (int e = 0; e < 4; ++e) { const int p = so * 8 + hq * 4 + e;
                            f32x4 x0, x1, d0, d1, w0, w1;
#pragma unroll
                            for (int t = 0; t < 4; ++t) { x0[t] = outv[t][e]; x1[t] = outv[4 + t][e]; d0[t] = x0[t] * dtv[t]; d1[t] = x1[t] * dtv[4 + t]; w0[t] = d0[t] * dec[t]; w1[t] = d1[t] * dec[4 + t]; }
                            *(u32x4*)(lds + OFF_XS + p * T_ST + tg * 16) = pack8(x0, x1);
                            *(u32x4*)(lds + OFF_XT + p * T_ST + tg * 16) = pack8(d0, d1);
                            *(u32x4*)(lds + OFF_XW + p * T_ST + tg * 16) = pack8(w0, w1); }
                    } else {
                        const bool isB = so < 24; const int n0 = (isB ? (so - 8) : (so - 24)) * 8 + hq * 4;
                        char* nat = lds + (isB ? OFF_BS : OFF_CS);
#pragma unroll
                        for (int t = 0; t < 8; ++t) { u32x2 w; w.x = cvt_pk_bf16(outv[t][0], outv[t][1]); w.y = cvt_pk_bf16(outv[t][2], outv[t][3]);
                            *(u32x2*)(nat + (tg * 8 + t) * CS_ST + n0 * 2) = w; }
                        if (isB) {
#pragma unroll
                            for (int e = 0; e < 4; ++e) { f32x4 a, bq;
#pragma unroll
                                for (int t = 0; t < 4; ++t) { a[t] = outv[t][e]; bq[t] = outv[4 + t][e]; }
                                *(u32x4*)(lds + OFF_BT + (n0 + e) * T_ST + tg * 16) = pack8(a, bq); }
                        }
                    }
                }
            }
            if (c + 1 < 32) SSD_LOAD(c + 1);
            __syncthreads();
#pragma unroll
            for (int t2 = 0; t2 < 2; ++t2) {
                const int tile = 2 * wid + t2, sb = tile >> 2, lb = tile & 3;
                f32x4 d = (f32x4){0.f, 0.f, 0.f, 0.f};
                if (sb <= lb) {
#pragma unroll
                    for (int ks = 0; ks < 4; ++ks) d = mfma16(ldfrag(lds + OFF_BS, CS_ST, sb * 16 + fr, ks * 32 + fq * 8), ldfrag(lds + OFF_CS, CS_ST, lb * 16 + fr, ks * 32 + fq * 8), d);
                    const int l = lb * 16 + fr; const float al = __shfl(acs, l);
                    f32x4 as;
#pragma unroll
                    for (int r = 0; r < 4; ++r) as[r] = __shfl(acs, sb * 16 + 4 * fq + r);
#pragma unroll
                    for (int r = 0; r < 4; ++r) { const int s = sb * 16 + 4 * fq + r; d[r] = (s <= l) ? d[r] * __expf(al - as[r]) : 0.f; }
                }
                u32x2 w; w.x = cvt_pk_bf16(d[0], d[1]); w.y = cvt_pk_bf16(d[2], d[3]);
                *(u32x2*)(lds + OFF_MT + (lb * 16 + fr) * T_ST + (sb * 16 + 4 * fq) * 2) = w;
            }
            if (DBG_SSD_SYNC) __syncthreads();
            f32x4 yacc[2];
#pragma unroll
            for (int t2 = 0; t2 < 2; ++t2) {
                const int tile = 2 * wid + t2, pb = tile >> 2, lb = tile & 3;
                f32x4 d = (f32x4){0.f, 0.f, 0.f, 0.f};
#pragma unroll
                for (int ks = 0; ks < 4; ++ks) d = mfma16(ldfrag(lds + OFF_HS, CS_ST, pb * 16 + fr, ks * 32 + fq * 8), ldfrag(lds + OFF_CS, CS_ST, lb * 16 + fr, ks * 32 + fq * 8), d);
                const float el = __expf(__shfl(acs, lb * 16 + fr));
                yacc[t2] = d * el;
            }
            __syncthreads();
#pragma unroll
            for (int t2 = 0; t2 < 2; ++t2) {
                const int tile = 2 * wid + t2, pb = tile >> 2, lb = tile & 3;
                f32x4 d = yacc[t2];
#pragma unroll
                for (int ks = 0; ks < 2; ++ks) d = mfma16(ldfrag(lds + OFF_XT, T_ST, pb * 16 + fr, ks * 32 + fq * 8), ldfrag(lds + OFF_MT, T_ST, lb * 16 + fr, ks * 32 + fq * 8), d);
                const int l = lb * 16 + fr, p0 = pb * 16 + 4 * fq; const size_t tok = tokb + c * 64 + l;
                const u32x2 zz = zpre[t2];
                const float z0 = bflo(zz.x), z1 = bfhi(zz.x), z2 = bflo(zz.y), z3 = bfhi(zz.y);
                float xs[4];
#pragma unroll
                for (int r = 0; r < 4; ++r) xs[r] = bflo((unsigned)*(const bf16_t*)(lds + OFF_XS + (p0 + r) * T_ST + l * 2));
                u32x2 w; w.x = cvt_pk_bf16((d[0] + xs[0] * dsk) * z0, (d[1] + xs[1] * dsk) * z1); w.y = cvt_pk_bf16((d[2] + xs[2] * dsk) * z2, (d[3] + xs[3] * dsk) * z3);
                *(u32x2*)(YG + tok * 1024 + h * 64 + p0) = w;
            }
            if (DBG_SSD_SYNC) __syncthreads();
            { const float dc = __expf(alast);
#pragma unroll
              for (int t = 0; t < 4; ++t) { f32x4 d = hst[t] * dc;
#pragma unroll
                  for (int ks = 0; ks < 2; ++ks) d = mfma16(ldfrag(lds + OFF_BT, T_ST, wid * 16 + fr, ks * 32 + fq * 8), ldfrag(lds + OFF_XW, T_ST, t * 16 + fr, ks * 32 + fq * 8), d);
                  hst[t] = d;
                  u32x2 w; w.x = cvt_pk_bf16(d[0], d[1]); w.y = cvt_pk_bf16(d[2], d[3]);
                  *(u32x2*)(lds + OFF_HS + (t * 16 + fr) * CS_ST + (wid * 16 + 4 * fq) * 2) = w; } }
            __syncthreads();
        }
#undef SSD_LOAD
    }
}

namespace ssd2 {
constexpr int CS_ST = 272, T_ST = 144;
constexpr int OFF_CS = 0, OFF_BS = 64 * CS_ST, OFF_BT = 2 * 64 * CS_ST, OFF_H0 = OFF_BT + 128 * T_ST;
constexpr int H_XS = 0, H_XW = 64 * T_ST, H_MT = 2 * 64 * T_ST, H_HS = 3 * 64 * T_ST, H_SZ = H_HS + 64 * CS_ST;
constexpr int OFF_CW = OFF_H0 + 2 * H_SZ;
constexpr int OFF_TAB = OFF_CW + 5 * 384 * 4;
static_assert(OFF_TAB + 6 * 64 * 4 <= LDS_MISC, "ssd2 lds");
}
__device__ __forceinline__ void ph_ssd2(Frame& F, const int abl = 0) {
    using namespace ssd2; using ssd::mfma16; using ssd::ldfrag;
    char* lds = (char*)(unsigned char*)F.lds;
    const bf16_t* XBC = (const bf16_t*)(F.ws + WS_XBC); const bf16_t* ZS = (const bf16_t*)(F.ws + WS_Z); const float* DT = (const float*)(F.outb + OUT_DT);
    bf16_t* YG = (bf16_t*)(F.ws + WS_Q);
    const float* conv_w = F.a->in[9]; const float* conv_b = F.a->in[10]; const float* a_log = F.a->in[12]; const float* d_skip = F.a->in[13];
    const int tid = F.tid, wid = F.wave, lane = F.lane, fr = lane & 15, fq = lane >> 4;
    const int su = tid < 384 ? tid : tid - 128; const bool cwl_writer = true;
    const int cp_lo = __builtin_amdgcn_readfirstlane(tid < 384 ? 0 : 2), cp_hi = __builtin_amdgcn_readfirstlane(tid < 256 ? 4 : (tid < 384 ? 2 : 4));
    const int so = su % 48, tg = su / 48, shd = (so >> 3) & 1;
    for (int item = F.bid; item < NB * 8; item += F.G) {
        const int b = item >> 3, g = (item >> 1) & 3, h0 = g * 4 + (item & 1) * 2;
        const float aneg0 = -__expf(a_log[h0]), aneg1 = -__expf(a_log[h0 + 1]), dsk0 = d_skip[h0], dsk1 = d_skip[h0 + 1];
        const int ch0 = so < 16 ? (h0 + shd) * 64 + (so & 7) * 8 : (so < 32 ? 1024 + g * 128 + (so - 16) * 8 : 1536 + g * 128 + (so - 32) * 8);
        float* CWL = (float*)(lds + OFF_CW);
        __syncthreads();
        if (cwl_writer) {
#pragma unroll
            for (int j = 0; j < 4; ++j) { *(f32x4*)(CWL + j * 384 + so * 8) = *(const f32x4*)(conv_w + (size_t)j * 2048 + ch0); *(f32x4*)(CWL + j * 384 + so * 8 + 4) = *(const f32x4*)(conv_w + (size_t)j * 2048 + ch0 + 4); }
            *(f32x4*)(CWL + 4 * 384 + so * 8) = *(const f32x4*)(conv_b + ch0); *(f32x4*)(CWL + 4 * 384 + so * 8 + 4) = *(const f32x4*)(conv_b + ch0 + 4);
        }
        f32x4 hst[2][4];
#pragma unroll
        for (int hh = 0; hh < 2; ++hh)
#pragma unroll
            for (int t = 0; t < 4; ++t) hst[hh][t] = (f32x4){0.f, 0.f, 0.f, 0.f};
        for (int i = tid; i < 64 * CS_ST / 4; i += NTHR) { ((unsigned*)(lds + OFF_H0 + H_HS))[i] = 0u; ((unsigned*)(lds + OFF_H0 + H_SZ + H_HS))[i] = 0u; }
        u32x4 raw[11];
        const size_t tokb = (size_t)b * SEQ;
        const bf16_t* xrow = XBC + ((ptrdiff_t)tokb + tg * 8 - 3) * 2048 + ch0;
#define SSD_LOAD(c, xp, tgx) do { { _Pragma("unroll") for (int i = 0; i < 11; ++i) { const int t = (c) * 64 + (tgx) * 8 - 3 + i; \
            raw[i] = (t >= 0) ? *(const GAS u32x4*)((xp) + (ptrdiff_t)((c) * 64 + i) * 2048) : (u32x4){0u, 0u, 0u, 0u}; } } } while (0)
        SSD_LOAD(0, xrow, tg);
        f32x2 dtn = *(const f32x2*)(DT + (tokb + lane) * 16 + h0);
        for (int c = 0; c < 32; ++c) {
            int frl = fr, fql = fq, tgl = tg, sol = so; const bf16_t* xrl = xrow; asm volatile("" : "+v"(frl), "+v"(fql), "+v"(tgl), "+v"(sol), "+v"(xrl)); const int shdl = (sol >> 3) & 1;
            const float dtl0 = dtn[0], dtl1 = dtn[1]; if (c + 1 < 32) dtn = *(const f32x2*)(DT + (tokb + (c + 1) * 64 + lane) * 16 + h0);
            u32x2 zpre[2][2];
#pragma unroll
            for (int hh = 0; hh < 2; ++hh)
#pragma unroll
                for (int t2 = 0; t2 < 2; ++t2) { const int tile = 2 * wid + t2, pb = tile >> 2, lb = tile & 3; zpre[hh][t2] = *(const u32x2*)(ZS + (tokb + c * 64 + lb * 16 + frl) * 1024 + (h0 + hh) * 64 + pb * 16 + 4 * fql); }
            const float acs0 = dpp_scan_add(dtl0 * aneg0), acs1 = dpp_scan_add(dtl1 * aneg1);
            const float alast0 = __builtin_bit_cast(float, __builtin_amdgcn_readlane(__builtin_bit_cast(int, acs0), 63)), alast1 = __builtin_bit_cast(float, __builtin_amdgcn_readlane(__builtin_bit_cast(int, acs1), 63));
            float* TAB = (float*)(lds + OFF_TAB);
            TAB[lane] = acs0; TAB[64 + lane] = acs1; TAB[128 + lane] = dtl0; TAB[192 + lane] = dtl1; TAB[256 + lane] = dtl0 * __expf(alast0 - acs0); TAB[320 + lane] = dtl1 * __expf(alast1 - acs1);
            LDS_WAIT(); asm volatile("" ::: "memory");
            float wdt[8];
            { const f32x4 wa = *(const f32x4*)(TAB + 256 + shdl * 64 + tgl * 8), wb = *(const f32x4*)(TAB + 256 + shdl * 64 + tgl * 8 + 4);
#pragma unroll
              for (int t = 0; t < 4; ++t) { wdt[t] = wa[t]; wdt[4 + t] = wb[t]; } }
            if (!(abl & 1)) {
#pragma unroll
                for (int cp = 0; cp < 4; ++cp) {
                    if (cp < cp_lo || cp >= cp_hi) continue;
                    float xin[11][2];
#pragma unroll
                    for (int i = 0; i < 11; ++i) { const unsigned wa = cp == 0 ? raw[i].x : (cp == 1 ? raw[i].y : (cp == 2 ? raw[i].z : raw[i].w)); xin[i][0] = bflo(wa); xin[i][1] = bfhi(wa); }
                    float outv[8][2];
                    { f32x2 cwv[4]; const f32x2 cbq = *(const f32x2*)(CWL + 4 * 384 + sol * 8 + cp * 2);
#pragma unroll
                      for (int j = 0; j < 4; ++j) cwv[j] = *(const f32x2*)(CWL + j * 384 + sol * 8 + cp * 2);
#pragma unroll
                      for (int t = 0; t < 8; ++t)
#pragma unroll
                        for (int e = 0; e < 2; ++e) { float sacc = cbq[e];
#pragma unroll
                            for (int j = 0; j < 4; ++j) sacc += cwv[j][e] * xin[t + j][e];
                            outv[t][e] = silu_f(sacc); } }
                    if (sol < 16) {
                        char* hb = lds + OFF_H0 + shdl * H_SZ;
#pragma unroll
                        for (int e = 0; e < 2; ++e) { const int p = (sol & 7) * 8 + cp * 2 + e;
                            f32x4 x0, x1, w0, w1;
#pragma unroll
                            for (int t = 0; t < 4; ++t) { x0[t] = outv[t][e]; x1[t] = outv[4 + t][e]; w0[t] = x0[t] * wdt[t]; w1[t] = x1[t] * wdt[4 + t]; }
                            *(u32x4*)(hb + H_XS + p * T_ST + tgl * 16) = pack8(x0, x1);
                            *(u32x4*)(hb + H_XW + p * T_ST + tgl * 16) = pack8(w0, w1); }
                    } else {
                        const bool isB = sol < 32; const int n0 = (isB ? (sol - 16) : (sol - 32)) * 8 + cp * 2;
                        char* nat = lds + (isB ? OFF_BS : OFF_CS);
#pragma unroll
                        for (int t = 0; t < 8; ++t) *(unsigned*)(nat + (tgl * 8 + t) * CS_ST + n0 * 2) = cvt_pk_bf16(outv[t][0], outv[t][1]);
                        if (isB) {
#pragma unroll
                            for (int e = 0; e < 2; ++e) { f32x4 a, bq;
#pragma unroll
                                for (int t = 0; t < 4; ++t) { a[t] = outv[t][e]; bq[t] = outv[4 + t][e]; }
                                *(u32x4*)(lds + OFF_BT + (n0 + e) * T_ST + tgl * 16) = pack8(a, bq); }
                        }
                    }
                    SBAR();
                }
            }
            if (c + 1 < 32) SSD_LOAD(c + 1, xrl, tgl);
            __syncthreads();
            bf16x8 cfr[2][4];
#pragma unroll
            for (int t2 = 0; t2 < 2; ++t2)
#pragma unroll
                for (int ks = 0; ks < 4; ++ks) cfr[t2][ks] = ldfrag(lds + OFF_CS, CS_ST, ((2 * wid + t2) & 3) * 16 + frl, ks * 32 + fql * 8);
            if (!(abl & 2))
#pragma unroll
            for (int t2 = 0; t2 < 2; ++t2) {
                const int tile = 2 * wid + t2, sb = tile >> 2, lb = tile & 3;
                f32x4 d = (f32x4){0.f, 0.f, 0.f, 0.f}, m0 = d, m1 = d;
                if (sb <= lb) {
#pragma unroll
                    for (int ks = 0; ks < 4; ++ks) d = mfma16(ldfrag(lds + OFF_BS, CS_ST, sb * 16 + frl, ks * 32 + fql * 8), cfr[t2][ks], d);
                    const int l = lb * 16 + frl, s4 = sb * 16 + 4 * fql; const float al0 = TAB[l], al1 = TAB[64 + l];
                    const f32x4 as0 = *(const f32x4*)(TAB + s4), as1 = *(const f32x4*)(TAB + 64 + s4), ds0 = *(const f32x4*)(TAB + 128 + s4), ds1 = *(const f32x4*)(TAB + 192 + s4);
#pragma unroll
                    for (int r = 0; r < 4; ++r) { const int sidx = s4 + r;
                        m0[r] = (sidx <= l) ? d[r] * __expf(al0 - as0[r]) * ds0[r] : 0.f; m1[r] = (sidx <= l) ? d[r] * __expf(al1 - as1[r]) * ds1[r] : 0.f; }
                }
                u32x2 w; w.x = cvt_pk_bf16(m0[0], m0[1]); w.y = cvt_pk_bf16(m0[2], m0[3]);
                *(u32x2*)(lds + OFF_H0 + H_MT + (lb * 16 + frl) * T_ST + (sb * 16 + 4 * fql) * 2) = w;
                w.x = cvt_pk_bf16(m1[0], m1[1]); w.y = cvt_pk_bf16(m1[2], m1[3]);
                *(u32x2*)(lds + OFF_H0 + H_SZ + H_MT + (lb * 16 + frl) * T_ST + (sb * 16 + 4 * fql) * 2) = w;
            }
            f32x4 yacc[2][2];
#pragma unroll
            for (int hh = 0; hh < 2; ++hh)
#pragma unroll
                for (int t2 = 0; t2 < 2; ++t2) {
                    const int tile = 2 * wid + t2, pb = tile >> 2, lb = tile & 3; const char* hb = lds + OFF_H0 + hh * H_SZ;
                    f32x4 d = (f32x4){0.f, 0.f, 0.f, 0.f};
                    if (!(abl & 2))
#pragma unroll
                    for (int ks = 0; ks < 4; ++ks) d = mfma16(ldfrag(hb + H_HS, CS_ST, pb * 16 + frl, ks * 32 + fql * 8), cfr[t2][ks], d);
                    const float el = __expf(TAB[hh * 64 + lb * 16 + frl]);
                    yacc[hh][t2] = d * el;
                }
            __syncthreads();
            if (!(abl & 4))
#pragma unroll
            for (int hh = 0; hh < 2; ++hh)
#pragma unroll
                for (int t2 = 0; t2 < 2; ++t2) {
                    const int tile = 2 * wid + t2, pb = tile >> 2, lb = tile & 3; const char* hb = lds + OFF_H0 + hh * H_SZ;
                    f32x4 d = yacc[hh][t2];
#pragma unroll
                    for (int ks = 0; ks < 2; ++ks) d = mfma16(ldfrag(hb + H_XS, T_ST, pb * 16 + frl, ks * 32 + fql * 8), ldfrag(hb + H_MT, T_ST, lb * 16 + frl, ks * 32 + fql * 8), d);
                    const int l = lb * 16 + frl, p0 = pb * 16 + 4 * fql; const size_t tok = tokb + c * 64 + l; const float dsk = hh ? dsk1 : dsk0;
                    const u32x2 zz = zpre[hh][t2];
                    const float z0 = bflo(zz.x), z1 = bfhi(zz.x), z2 = bflo(zz.y), z3 = bfhi(zz.y);
                    float xs[4];
#pragma unroll
                    for (int r = 0; r < 4; ++r) xs[r] = bflo((unsigned)*(const bf16_t*)(hb + H_XS + (p0 + r) * T_ST + l * 2));
                    u32x2 w; w.x = cvt_pk_bf16((d[0] + xs[0] * dsk) * z0, (d[1] + xs[1] * dsk) * z1); w.y = cvt_pk_bf16((d[2] + xs[2] * dsk) * z2, (d[3] + xs[3] * dsk) * z3);
                    *(u32x2*)(YG + tok * 1024 + (h0 + hh) * 64 + p0) = w;
                }
            const bf16x8 btf0 = ldfrag(lds + OFF_BT, T_ST, wid * 16 + frl, fql * 8), btf1 = ldfrag(lds + OFF_BT, T_ST, wid * 16 + frl, 32 + fql * 8);
            if (!(abl & 8))
#pragma unroll
            for (int hh = 0; hh < 2; ++hh) { const float dc = __expf(hh ? alast1 : alast0); char* hb = lds + OFF_H0 + hh * H_SZ;
#pragma unroll
                for (int t = 0; t < 4; ++t) { f32x4 d = hst[hh][t] * dc;
#pragma unroll
                    for (int ks = 0; ks < 2; ++ks) d = mfma16(ks ? btf1 : btf0, ldfrag(hb + H_XW, T_ST, t * 16 + frl, ks * 32 + fql * 8), d);
                    hst[hh][t] = d;
                    u32x2 w; w.x = cvt_pk_bf16(d[0], d[1]); w.y = cvt_pk_bf16(d[2], d[3]);
                    *(u32x2*)(hb + H_HS + (t * 16 + frl) * CS_ST + (wid * 16 + 4 * fql) * 2) = w; } }
            __syncthreads();
        }
#undef SSD_LOAD
    }
}

__device__ __forceinline__ void ph_gnorm(Frame& F) {
    bf16_t* YG = (bf16_t*)(F.ws + WS_Q);
    const int gw = F.bid * NWAVES + F.wave, NGW = F.G * NWAVES;
    constexpr int RB = 4;
    for (int m0 = gw * RB; m0 < NTOK; m0 += NGW * RB) {
        u32x2 w[RB][4];
#pragma unroll
        for (int r = 0; r < RB; ++r) { const u32x2* rp = (const u32x2*)(YG + (size_t)(m0 + r) * D) + F.lane;
#pragma unroll
            for (int j = 0; j < 4; ++j) w[r][j] = rp[64 * j]; }
#pragma unroll
        for (int r = 0; r < RB; ++r) { const int m = m0 + r; u32x2* rp = (u32x2*)(YG + (size_t)m * D) + F.lane;
#pragma unroll
            for (int j = 0; j < 4; ++j) { const float a = bflo(w[r][j].x), b = bfhi(w[r][j].x), c = bflo(w[r][j].y), d = bfhi(w[r][j].y);
                const float ss = wave_sum(a * a + b * b + c * c + d * d); const float rr = 1.f / sqrtf(ss * (1.f / 256.f) + LN_EPS);
                if (PB_FP8) { int pk = 0; pk = __builtin_amdgcn_cvt_pk_fp8_f32(a * rr, b * rr, pk, false); pk = __builtin_amdgcn_cvt_pk_fp8_f32(c * rr, d * rr, pk, true); ((unsigned*)(F.outb + OUT_OB8 + (size_t)m * D))[F.lane + 64 * j] = (unsigned)pk; }
                else { u32x2 o; o.x = cvt_pk_bf16(a * rr, b * rr); o.y = cvt_pk_bf16(c * rr, d * rr); rp[64 * j] = o; } } }
    }
}

template <bool DRY = false> __device__ __forceinline__ void ph_router(Frame& F) {
    const bf16_t* VB = (const bf16_t*)(F.ws + WS_VB); bf16_t* X1B = (bf16_t*)(F.ws + WS_X1B); bf16_t* U2 = (bf16_t*)(F.ws + WS_U2); const float* MOD = (const float*)(F.ws + WS_MOD);
    const float* ln1g = F.a->in[18]; const float* ln1b = F.a->in[19]; const float* w_router = F.a->in[20]; const float* b_router = F.a->in[21];
    u32x2* REG = (u32x2*)(F.ws + WS_REG); unsigned* CNT = (unsigned*)(F.ws + WS_CTL) + CW_CNT;
    constexpr int TST = 2064;
    LAS unsigned char* THI = F.lds; LAS unsigned char* TLO = F.lds + 16 * TST; LAS float* PART = (LAS float*)(F.lds + 32 * TST);
    LAS unsigned* lcnt = (LAS unsigned*)(F.lds + LDS_AUX); LAS unsigned* lbase = lcnt + 32; LAS unsigned* ent = lcnt + 64;
    const int tid = F.tid, lane = F.lane, wid = F.wave, fr = lane & 15, fq = lane >> 4;
    bf16x8 whi[4][2], wlo[4][2];
#pragma unroll
    for (int ks = 0; ks < 4; ++ks)
#pragma unroll
        for (int ct = 0; ct < 2; ++ct) { float wv[8];
#pragma unroll
            for (int i = 0; i < 8; ++i) wv[i] = w_router[(size_t)(128 * wid + 32 * ks + 8 * fq + i) * 32 + ct * 16 + fr];
            u32x4 h, l2;
#pragma unroll
            for (int i = 0; i < 4; ++i) { const unsigned hp = cvt_pk_bf16(wv[2 * i], wv[2 * i + 1]); const float r0 = wv[2 * i] - bflo(hp), r1 = wv[2 * i + 1] - bfhi(hp); h[i] = hp; l2[i] = cvt_pk_bf16(r0, r1); }
            whi[ks][ct] = __builtin_bit_cast(bf16x8, h); wlo[ks][ct] = __builtin_bit_cast(bf16x8, l2); }
    const float brl = b_router[lane & 31];
    f32x4 lg[4], lb[4];
#pragma unroll
    for (int j = 0; j < 4; ++j) { lg[j] = *((const f32x4*)ln1g + lane + 64 * j); lb[j] = *((const f32x4*)ln1b + lane + 64 * j); }
    for (int batch = F.bid; batch < NTOK / 256; batch += F.G) {
        const int hf = batch >> 7;
        f32x4 shv[4], scv[4];
        { const float* md = MOD + (size_t)((batch * 256) >> 11) * 6144;
#pragma unroll
          for (int j = 0; j < 4; ++j) { shv[j] = *((const f32x4*)(md + 3072) + lane + 64 * j); scv[j] = *((const f32x4*)(md + 4096) + lane + 64 * j); } }
        __syncthreads();
        if (tid < 32) lcnt[tid] = 0u;
        for (int grp = 0; grp < 16; ++grp) {
#pragma unroll
            for (int tt = 0; tt < 2; ++tt) {
                const int tg16 = 2 * wid + tt, m = batch * 256 + grp * 16 + tg16; const float* md = MOD + (size_t)(m >> 11) * 6144;
                const u32x2* vr = (const u32x2*)(VB + (size_t)m * D) + lane; u32x2* xr = (u32x2*)(X1B + (size_t)m * D) + lane;
                f32x4 v[4]; float s = 0.f;
#pragma unroll
                for (int j = 0; j < 4; ++j) { const u32x2 w = vr[64 * j]; v[j] = (f32x4){bflo(w.x), bfhi(w.x), bflo(w.y), bfhi(w.y)}; s += (v[j][0] + v[j][1]) + (v[j][2] + v[j][3]); }
                float mean = wave_sum(s) * (1.f / D), s2 = 0.f;
#pragma unroll
                for (int j = 0; j < 4; ++j) { v[j] = v[j] - mean; s2 += (v[j][0] * v[j][0] + v[j][1] * v[j][1]) + (v[j][2] * v[j][2] + v[j][3] * v[j][3]); }
                float rstd = 1.f / sqrtf(wave_sum(s2) * (1.f / D) + LN_EPS);
                s = 0.f;
#pragma unroll
                for (int j = 0; j < 4; ++j) { v[j] = v[j] * rstd * lg[j] + lb[j]; if (!DRY) { u32x2 w; w.x = cvt_pk_bf16(v[j][0], v[j][1]); w.y = cvt_pk_bf16(v[j][2], v[j][3]); xr[64 * j] = w; } s += (v[j][0] + v[j][1]) + (v[j][2] + v[j][3]); }
                mean = wave_sum(s) * (1.f / D); s2 = 0.f;
#pragma unroll
                for (int j = 0; j < 4; ++j) { v[j] = v[j] - mean; s2 += (v[j][0] * v[j][0] + v[j][1] * v[j][1]) + (v[j][2] * v[j][2] + v[j][3] * v[j][3]); }
                rstd = 1.f / sqrtf(wave_sum(s2) * (1.f / D) + LN_EPS);
                u32x2* o8 = (u32x2*)(U2 + (size_t)m * D) + lane;
#pragma unroll
                for (int j = 0; j < 4; ++j) {
                    v[j] = v[j] * rstd * (scv[j] + 1.0f) + shv[j]; u32x2 w; w.x = cvt_pk_bf16(v[j][0], v[j][1]); w.y = cvt_pk_bf16(v[j][2], v[j][3]);
                    if (DRY) { if (w.x == 0x12345678u) o8[64 * j] = w; }
                    else if (MOE_FP8) { int pk = 0; pk = __builtin_amdgcn_cvt_pk_fp8_f32(v[j][0], v[j][1], pk, false); pk = __builtin_amdgcn_cvt_pk_fp8_f32(v[j][2], v[j][3], pk, true); ((unsigned*)((unsigned char*)U2 + (size_t)m * D))[lane + 64 * j] = (unsigned)pk; }
                    else o8[64 * j] = w;
                    u32x2 lo; lo.x = cvt_pk_bf16(v[j][0] - bflo(w.x), v[j][1] - bfhi(w.x)); lo.y = cvt_pk_bf16(v[j][2] - bflo(w.y), v[j][3] - bfhi(w.y));
                    *(LAS u32x2*)(THI + tg16 * TST + (4 * lane + 256 * j) * 2) = w; *(LAS u32x2*)(TLO + tg16 * TST + (4 * lane + 256 * j) * 2) = lo; }
            }
            __syncthreads();
            { f32x4 a0 = (f32x4){0.f, 0.f, 0.f, 0.f}, a1 = a0;
#pragma unroll
              for (int ks = 0; ks < 4; ++ks) { const int cb = (128 * wid + 32 * ks + 8 * fq) * 2;
                  const bf16x8 th = *(const LAS bf16x8*)(THI + fr * TST + cb), tl = *(const LAS bf16x8*)(TLO + fr * TST + cb);
                  a0 = __builtin_amdgcn_mfma_f32_16x16x32_bf16(whi[ks][0], th, a0, 0, 0, 0); a1 = __builtin_amdgcn_mfma_f32_16x16x32_bf16(whi[ks][1], th, a1, 0, 0, 0);
                  a0 = __builtin_amdgcn_mfma_f32_16x16x32_bf16(wlo[ks][0], th, a0, 0, 0, 0); a1 = __builtin_amdgcn_mfma_f32_16x16x32_bf16(wlo[ks][1], th, a1, 0, 0, 0);
                  a0 = __builtin_amdgcn_mfma_f32_16x16x32_bf16(whi[ks][0], tl, a0, 0, 0, 0); a1 = __builtin_amdgcn_mfma_f32_16x16x32_bf16(whi[ks][1], tl, a1, 0, 0, 0); }
              *(LAS f32x4*)(PART + (wid * 16 + fr) * 32 + 4 * fq) = a0; *(LAS f32x4*)(PART + (wid * 16 + fr) * 32 + 16 + 4 * fq) = a1; }
            __syncthreads();
            { const int tg16 = 2 * wid + (lane >> 5), tl = grp * 16 + tg16, myexp = lane & 31;
              float logit = brl;
#pragma unroll
              for (int w8 = 0; w8 < 8; ++w8) logit += PART[(w8 * 16 + tg16) * 32 + myexp];
              float tv[4]; int tix[4];
#pragma unroll
              for (int k = 0; k < 4; ++k) { float bv = logit; int bi = myexp;
#define RT_STEP(ctrl, rm) do { const float ov = __builtin_bit_cast(float, __builtin_amdgcn_update_dpp((int)0xff800000u, __builtin_bit_cast(int, bv), (ctrl), (rm), 0xf, false)); \
                      const int oi = __builtin_amdgcn_update_dpp(64, bi, (ctrl), (rm), 0xf, false); if (ov > bv || (ov == bv && oi < bi)) { bv = ov; bi = oi; } } while (0)
                  RT_STEP(0x111, 0xf); RT_STEP(0x112, 0xf); RT_STEP(0x114, 0xf); RT_STEP(0x118, 0xf); RT_STEP(0x142, 0xa);
#undef RT_STEP
                  { const int b0 = __builtin_amdgcn_readlane(__builtin_bit_cast(int, bv), 31), b1 = __builtin_amdgcn_readlane(__builtin_bit_cast(int, bv), 63), i0 = __builtin_amdgcn_readlane(bi, 31), i1 = __builtin_amdgcn_readlane(bi, 63);
                    bv = __builtin_bit_cast(float, lane < 32 ? b0 : b1); bi = lane < 32 ? i0 : i1; }
                  tv[k] = bv; tix[k] = bi; if (myexp == bi) logit = -INFINITY; }
              const float e1 = __expf(tv[1] - tv[0]), e2 = __expf(tv[2] - tv[0]), e3 = __expf(tv[3] - tv[0]); const float inv = 1.f / (1.f + e1 + e2 + e3);
              if (myexp < 4) { const int ee = myexp == 0 ? tix[0] : (myexp == 1 ? tix[1] : (myexp == 2 ? tix[2] : tix[3])); const float gg = (myexp == 0 ? 1.f : (myexp == 1 ? e1 : (myexp == 2 ? e2 : e3))) * inv;
                  const unsigned lp = atomicAdd((unsigned*)&lcnt[ee], 1u);
                  LAS unsigned* en = ent + (tl * 4 + myexp) * 3; en[0] = (unsigned)ee; en[1] = lp; en[2] = __float_as_uint(gg);
                  if (DBG_CHECK == 1) { u32x2 rw; rw.x = (unsigned)ee; rw.y = __float_as_uint(gg); ((u32x2*)(F.ws + WS_DBG))[(size_t)(batch * 256 + tl) * 4 + myexp] = rw; } } }
        }
        __syncthreads();
        if (tid < 32) lbase[tid] = DRY ? 0u : __hip_atomic_fetch_add(CNT + 64 * (hf * 32 + tid), lcnt[tid], __ATOMIC_RELAXED, __HIP_MEMORY_SCOPE_AGENT);
        __syncthreads();
        for (int i = tid; i < 1024; i += NTHR) { const LAS unsigned* en = ent + i * 3; const unsigned ee = en[0], pos = lbase[ee] + en[1];
            const unsigned tokl = (unsigned)(batch * 256 + (i >> 2)) - (unsigned)hf * HALF_TOK;
            u32x2 w; w.x = tokl * 4u + (unsigned)(i & 3); w.y = en[2];
            if (!DRY && pos < (unsigned)REG_CAP) REG[((size_t)hf * 32 + ee) * REG_CAP + pos] = w; }
    }
}

template <bool DRY = false> __device__ __forceinline__ void ph_final(Frame& F, int hf) {
    float* OUT = (float*)F.outb; const bf16_t* X1B = (const bf16_t*)(F.ws + WS_X1B); const bf16_t* YB = (const bf16_t*)(F.ws + WS_YB); const float* MOD = (const float*)(F.ws + WS_MOD);
    const float* g2 = F.a->in[26]; const float* b2 = F.a->in[27];
    const int gw = F.bid * NWAVES + F.wave, NGW = F.G * NWAVES, lane = F.lane;
    constexpr int RB = 2;
    f32x4 g2v[4], b2v[4];
#pragma unroll
    for (int j = 0; j < 4; ++j) { g2v[j] = *((const f32x4*)g2 + lane + 64 * j); b2v[j] = *((const f32x4*)b2 + lane + 64 * j); }
    const int RPW = (((HALF_TOK + NGW - 1) / NGW) + RB - 1) / RB * RB, tbeg = gw * RPW, tend = (tbeg + RPW < HALF_TOK) ? tbeg + RPW : HALF_TOK;
    f32x4 gtv[4]; int curb = -1;
    for (int tl0 = tbeg; tl0 < tend; tl0 += RB) {
        { const int bb = (hf * HALF_TOK + tl0) >> 11; if (bb != curb) { curb = bb; const float* md = MOD + (size_t)bb * 6144 + 5120;
#pragma unroll
            for (int j = 0; j < 4; ++j) gtv[j] = *((const f32x4*)md + lane + 64 * j); } }
        u32x2 xw[RB][4]; u32x2 yw[RB][4][4];
#pragma unroll
        for (int r = 0; r < RB; ++r) { const int tl = tl0 + r, m = hf * HALF_TOK + tl;
            const u32x2* xr = (const u32x2*)(X1B + (size_t)m * D) + lane; const u32x2* yr = (const u32x2*)(YB + (size_t)tl * 4 * D) + lane;
#pragma unroll
            for (int j = 0; j < 4; ++j) { xw[r][j] = __builtin_nontemporal_load(xr + 64 * j);
#pragma unroll
                for (int k = 0; k < 4; ++k) yw[r][j][k] = __builtin_nontemporal_load(yr + k * 256 + 64 * j); } }
#pragma unroll
        for (int r = 0; r < RB; ++r) { const int tl = tl0 + r, m = hf * HALF_TOK + tl;
            f32x4* xr = (f32x4*)(OUT + (size_t)m * D) + lane;
            f32x4 v[4]; float s = 0.f;
#pragma unroll
            for (int j = 0; j < 4; ++j) { f32x4 y = (f32x4){0.f, 0.f, 0.f, 0.f};
#pragma unroll
                for (int k = 0; k < 4; ++k) { const u32x2 w = yw[r][j][k]; y[0] += bflo(w.x); y[1] += bfhi(w.x); y[2] += bflo(w.y); y[3] += bfhi(w.y); }
                if (DBG_NO_MOE) y = (f32x4){0.f, 0.f, 0.f, 0.f};
                const f32x4 gt = gtv[j];
                const f32x4 x1v = (f32x4){bflo(xw[r][j].x), bfhi(xw[r][j].x), bflo(xw[r][j].y), bfhi(xw[r][j].y)};
                v[j] = x1v * DN_ALPHA + gt * y; s += (v[j][0] + v[j][1]) + (v[j][2] + v[j][3]); }
            const float mean = wave_sum(s) * (1.f / D); float s2 = 0.f;
#pragma unroll
            for (int j = 0; j < 4; ++j) { v[j] = v[j] - mean; s2 += (v[j][0] * v[j][0] + v[j][1] * v[j][1]) + (v[j][2] * v[j][2] + v[j][3] * v[j][3]); }
            const float rstd = 1.f / sqrtf(wave_sum(s2) * (1.f / D) + LN_EPS);
#pragma unroll
            for (int j = 0; j < 4; ++j) { const f32x4 ov = v[j] * rstd * g2v[j] + b2v[j]; if (!DRY || ov[0] == 1.2345e-33f) __builtin_nontemporal_store(ov, xr + 64 * j); } }
    }
}

__device__ __forceinline__ float block_sum(Frame& F, float v, LAS float* red) {
    v = wave_sum(v); __syncthreads(); if (F.lane == 0) red[F.wave] = v; __syncthreads();
    float s = 0.f; for (int w = 0; w < NWAVES; ++w) s += red[w]; return s;
}
__device__ __forceinline__ float block_max(Frame& F, float v, LAS float* red) {
#pragma unroll
    for (int o = 1; o < 64; o <<= 1) v = fmaxf(v, __shfl_xor(v, o));
    __syncthreads(); if (F.lane == 0) red[F.wave] = v; __syncthreads();
    float s = 0.f; for (int w = 0; w < NWAVES; ++w) s = fmaxf(s, red[w]); return s;
}
__device__ __forceinline__ void dbg_report(Frame& F, float e) { if (F.tid == 0) atomicMax((unsigned*)(F.ws + WS_CTL) + CW_DBG, __float_as_uint(e)); }
__device__ __forceinline__ void dbg_check_moe(Frame& F) {
    if (F.bid >= 64) return;
    const int tok = HALF_TOK + 509 * F.bid + 3, tokl = tok - HALF_TOK, tid = F.tid;
    LAS float* u2 = (LAS float*)F.lds; LAS float* act = u2 + 1024; LAS float* red = act + 1024; LAS float* lg = red + 16;
    const bf16_t* U2 = (const bf16_t*)(F.ws + WS_U2); const bf16_t* YB = (const bf16_t*)(F.ws + WS_YB); const u32x2* RT = (const u32x2*)(F.ws + WS_DBG);
    const float* w1 = F.a->in[22]; const float* b1 = F.a->in[23]; const float* w2 = F.a->in[24]; const float* b2 = F.a->in[25];
    __syncthreads();
    for (int i = tid; i < 1024; i += NTHR) u2[i] = bflo((unsigned)U2[(size_t)tok * 1024 + i]);
    __syncthreads();
    float y0 = 0.f, y1 = 0.f;
    for (int k = 0; k < 4; ++k) {
        const u32x2 rw = RT[(size_t)tok * 4 + k]; const int e = (int)rw.x; const float g = __uint_as_float(rw.y);
        const float* W1 = w1 + (size_t)e * 1024 * 2048; const float* W2 = w2 + (size_t)e * 1024 * 1024;
        float h0 = b1[e * 2048 + tid], h1 = b1[e * 2048 + tid + 512], h2 = b1[e * 2048 + tid + 1024], h3 = b1[e * 2048 + tid + 1536];
        for (int c = 0; c < 1024; ++c) { const float uu = u2[c]; const float* wr = W1 + (size_t)c * 2048 + tid; h0 += uu * wr[0]; h1 += uu * wr[512]; h2 += uu * wr[1024]; h3 += uu * wr[1536]; }
        __syncthreads();
        { float gg = fminf(h0, 7.f), up = fminf(fmaxf(h2, -7.f), 7.f); act[tid] = (up + 1.f) * gg / (1.f + expf(-1.702f * gg));
          gg = fminf(h1, 7.f); up = fminf(fmaxf(h3, -7.f), 7.f); act[tid + 512] = (up + 1.f) * gg / (1.f + expf(-1.702f * gg)); }
        __syncthreads();
        float a0 = b2[e * 1024 + tid], a1 = b2[e * 1024 + tid + 512];
        for (int j = 0; j < 1024; ++j) { const float aa = act[j]; a0 += aa * W2[(size_t)j * 1024 + tid]; a1 += aa * W2[(size_t)j * 1024 + tid + 512]; }
        y0 += g * a0; y1 += g * a1;
    }
    float f0 = 0.f, f1 = 0.f;
    for (int k = 0; k < 4; ++k) { f0 += bflo((unsigned)YB[((size_t)tokl * 4 + k) * 1024 + tid]); f1 += bflo((unsigned)YB[((size_t)tokl * 4 + k) * 1024 + tid + 512]); }
    const float rms = sqrtf(block_sum(F, y0 * y0 + y1 * y1, red) * (1.f / 1024.f)) + 1e-20f;
    float err = block_max(F, fmaxf(fabsf(y0 - f0), fabsf(y1 - f1)), red) / rms;
    { const float* X1 = (const float*)F.outb + (size_t)tok * 1024; const float* md = (const float*)(F.ws + WS_MOD) + (size_t)(tok >> 11) * 6144;
      const float xa = X1[tid], xb = X1[tid + 512]; const float mean = block_sum(F, xa + xb, red) * (1.f / 1024.f);
      const float da = xa - mean, db = xb - mean; const float var = block_sum(F, da * da + db * db, red) * (1.f / 1024.f); const float rstd = 1.f / sqrtf(var + LN_EPS);
      __syncthreads();
      u2[tid] = da * rstd * (1.f + md[4096 + tid]) + md[3072 + tid]; u2[tid + 512] = db * rstd * (1.f + md[4096 + tid + 512]) + md[3072 + tid + 512];
      __syncthreads();
      if (tid < 32) { float a = F.a->in[21][tid]; for (int c = 0; c < 1024; ++c) a += u2[c] * F.a->in[20][c * 32 + tid]; lg[tid] = a; }
      __syncthreads();
      if (tid == 0) { unsigned want = 0u, got = 0u; float l2[32]; for (int i = 0; i < 32; ++i) l2[i] = lg[i];
          for (int k = 0; k < 4; ++k) { int bi = 0; for (int i = 1; i < 32; ++i) if (l2[i] > l2[bi]) bi = i; want |= 1u << bi; l2[bi] = -INFINITY; got |= 1u << RT[(size_t)tok * 4 + k].x; }
          lg[32] = (want != got) ? 1.f : 0.f; }
      __syncthreads();
      if (lg[32] != 0.f) err = 50.f; }
    dbg_report(F, err);
}
__device__ __forceinline__ void dbg_check_ssd(Frame& F) {
    if (F.bid >= 2) return;
    const int b = F.bid ? 20 : 5, h = F.bid ? 14 : 3, g = h >> 2, tid = F.tid, p = tid >> 3, ng = tid & 7;
    LAS float* red = (LAS float*)F.lds; LAS float* cv = red + 16;
    const bf16_t* XBC = (const bf16_t*)(F.ws + WS_XBC); const bf16_t* ZS = (const bf16_t*)(F.ws + WS_Z); const float* DT = (const float*)(F.outb + OUT_DT); const bf16_t* YG = (const bf16_t*)(F.ws + WS_Q);
    const float* cw = F.a->in[9]; const float* cb = F.a->in[10]; const float aneg = -expf(F.a->in[12][h]), dsk = F.a->in[13][h];
    const int mych = tid < 64 ? h * 64 + tid : (tid < 192 ? 1024 + g * 128 + (tid - 64) : 1536 + g * 128 + (tid - 192));
    float w0 = 0.f, w1 = 0.f, w2 = 0.f, w3 = 0.f, wb = 0.f;
    if (tid < 320) { w0 = cw[0 * 2048 + mych]; w1 = cw[1 * 2048 + mych]; w2 = cw[2 * 2048 + mych]; w3 = cw[3 * 2048 + mych]; wb = cb[mych]; }
    float x0 = 0.f, x1 = 0.f, x2 = 0.f;
    float hs[16];
#pragma unroll
    for (int i = 0; i < 16; ++i) hs[i] = 0.f;
    float emax = 0.f, ssq = 0.f, nbad = 0.f; int tmax = 0;
    for (int t = 0; t < SEQ; ++t) {
        const size_t tok = (size_t)b * SEQ + t;
        __syncthreads();
        if (DBG_HYP == 1 && (t & 63) == 0) { x0 = 0.f; x1 = 0.f; x2 = 0.f; }
        if (tid < 320) { const float x3 = bflo((unsigned)XBC[tok * 2048 + mych]); const float s = wb + w0 * x0 + w1 * x1 + w2 * x2 + w3 * x3; cv[tid] = s / (1.f + expf(-s)); x0 = x1; x1 = x2; x2 = x3; }
        __syncthreads();
        const float xv = cv[p], dt = DT[tok * 16 + h], dec = expf(dt * aneg);
        float yp = 0.f;
#pragma unroll
        for (int i = 0; i < 16; ++i) { const int n = ng * 16 + i; hs[i] = hs[i] * dec + dt * xv * cv[64 + n]; yp += cv[192 + n] * hs[i]; }
        yp += __shfl_xor(yp, 1); yp += __shfl_xor(yp, 2); yp += __shfl_xor(yp, 4);
        const float yv = (yp + xv * dsk) * bflo((unsigned)ZS[tok * 1024 + h * 64 + p]);
        const float yf = bflo((unsigned)YG[tok * 1024 + h * 64 + p]);
        if (ng == 0) { const float er = fabsf(yv - yf); if (er > emax) { emax = er; tmax = t; } ssq += yv * yv; if (er > 0.25f && (DBG_SUB < 5 || (DBG_SUB == 5 && (t & 63) == 0) || (DBG_SUB == 6 && (t & 63) == 1) || (DBG_SUB == 7 && (t & 63) == 32))) nbad += 1.f; }
    }
    const float rms = sqrtf(block_sum(F, ssq, red) / (64.f * SEQ)) + 1e-20f;
    const float M = block_max(F, emax, red);
    if (DBG_SUB == 0) dbg_report(F, M / rms);
    else if (DBG_SUB == 1) dbg_report(F, block_sum(F, nbad, red) / (64.f * SEQ));
    else if (DBG_SUB >= 5) dbg_report(F, block_sum(F, nbad, red) / (64.f * 32.f));
    else { __syncthreads(); if (ng == 0 && emax == M) red[12] = (float)(DBG_SUB == 2 ? ((tmax & 63) >> 1) : (DBG_SUB == 3 ? (tmax >> 6) : (p >> 1))); __syncthreads();
        if (F.bid == 0) dbg_report(F, powf(10.f, 2.f * (0.05f + 0.05f * red[12]) - 4.f)); }
}
__device__ __forceinline__ void dbg_check_attn(Frame& F) {
    if (F.bid >= 32) return;
    const int b = (F.bid * 7 + 3) & 31, pos = 300 + F.bid * 53, nadm = ((pos >> 6) + 1) * 64, tid = F.tid, lane = F.lane, hd = F.wave;
    const size_t tq = (size_t)b * SEQ + pos;
    LAS float* sc = (LAS float*)F.lds; LAS unsigned char* sel = (LAS unsigned char*)(sc + 2048); LAS float* lgt = (LAS float*)(sel + 2048); LAS float* red = lgt + 8 * 2048; LAS float* misc = red + 16;
    const bf16_t* IQ = (const bf16_t*)(F.outb + OUT_IQ); const bf16_t* IK = (const bf16_t*)(F.outb + OUT_IK); const float* IW = (const float*)(F.outb + OUT_IW);
    const bf16_t* Q = (const bf16_t*)(F.ws + WS_Q); const bf16_t* KV = (const bf16_t*)(F.outb + OUT_KV); const bf16_t* OA = (const bf16_t*)(F.outb + OUT_OA); const u64* MASK = (const u64*)(F.outb + OUT_MASK);
    __syncthreads();
    for (int k = tid; k < nadm; k += NTHR) { float s = 0.f;
        for (int hh = 0; hh < 8; ++hh) { float d = 0.f; for (int c = 0; c < 64; ++c) d += bflo((unsigned)IQ[tq * 512 + hh * 64 + c]) * bflo((unsigned)IK[((size_t)b * SEQ + k) * 64 + c]); s += fmaxf(d, 0.f) * IW[tq * 8 + hh]; }
        sc[k] = s + 0.0f; }
    __syncthreads();
    float nbad = 0.f;
    for (int k = tid; k < nadm; k += NTHR) { const float s = sc[k]; int rank = 0; for (int j = 0; j < nadm; ++j) { const float t = sc[j]; rank += (t > s || (t == s && j < k)) ? 1 : 0; }
        const unsigned char se = rank < 256 ? 1 : 0; sel[k] = se; const unsigned mb = (unsigned)((MASK[tq * 32 + (k >> 6)] >> (k & 63)) & 1ull); if (mb != se) nbad += 1.f; }
    __syncthreads();
    const float nbad_t = block_sum(F, nbad, red);
    LAS float* lw = lgt + hd * 2048; float mx = -INFINITY;
    for (int k = lane; k < nadm; k += 64) { float l = -INFINITY;
        if (sel[k]) { float d = 0.f; for (int c = 0; c < 128; ++c) d += bflo((unsigned)Q[tq * 1024 + hd * 128 + c]) * bflo((unsigned)KV[((size_t)b * SEQ + k) * 128 + c]);
            const int rel = k - pos, n = rel < 0 ? -rel : rel; const float nf = (float)(n > 1 ? n : 1); int large = 8 + (int)(logf(nf / 8.0f) / 2.7725887f * 8.0f); if (large > 15) large = 15;
            const int bucket = (rel > 0 ? 16 : 0) + (n < 8 ? n : large);
            l = d * 0.088388347648318440f + F.a->in[8][bucket * 8 + hd]; }
        lw[k] = l; mx = fmaxf(mx, l); }
#pragma unroll
    for (int o = 1; o < 64; o <<= 1) mx = fmaxf(mx, __shfl_xor(mx, o));
    float den = 0.f;
    for (int k = lane; k < nadm; k += 64) { const float pp = expf(lw[k] - mx); lw[k] = pp; den += pp; }
    den = wave_sum(den);
    float emax = 0.f, ssq = 0.f;
    for (int c2 = 0; c2 < 2; ++c2) { const int c = lane + 64 * c2; float o = 0.f; for (int k = 0; k < nadm; ++k) { const float pp = lw[k]; if (pp != 0.f) o += pp * bflo((unsigned)KV[((size_t)b * SEQ + k) * 128 + c]); }
        o /= den; const float of = bflo((unsigned)OA[tq * 1024 + hd * 128 + c]); emax = fmaxf(emax, fabsf(o - of)); ssq += o * o; }
    const float rms = sqrtf(block_sum(F, ssq, red) * (1.f / 1024.f)) + 1e-20f;
    float err = block_max(F, emax, red) / rms;
    (void)misc;
    if (nbad_t > 0.f) err = 10.f + nbad_t;
    dbg_report(F, err);
}
__device__ __forceinline__ void dbg_emit(Frame& F) {
    float* out = (float*)F.outb;
    for (size_t i = (size_t)F.bid * NTHR + F.tid; i < (size_t)NTOK * D / 4; i += (size_t)F.G * NTHR) ((f32x4*)out)[i] = (f32x4){0.f, 0.f, 0.f, 0.f};
    __syncthreads();
    if (F.bid == 0 && F.tid == 0) { const float e = __uint_as_float(__hip_atomic_load((unsigned*)(F.ws + WS_CTL) + CW_DBG, __ATOMIC_RELAXED, __HIP_MEMORY_SCOPE_AGENT));
        float code = (log10f(fmaxf(e, 1e-30f)) + 4.f) * 0.5f; code = fminf(fmaxf(rintf(code * 20.f) * 0.05f, 0.05f), 3.0f);
        out[0] = sqrtf(67108864.f * 1.01f * (powf(10.f, code) - 1.f)); }
}

#define CLK_BEGIN(k) unsigned long long clk_c##k = 0, clk_r##k = 0; if (DBG_CLOCK == (k) + 1) { clk_c##k = __builtin_amdgcn_s_memtime(); clk_r##k = __builtin_amdgcn_s_memrealtime(); }
#define CLK_END(k) if (DBG_CLOCK == (k) + 1 && F.bid == 0) { const float ghz = (float)(__builtin_amdgcn_s_memtime() - clk_c##k) / (float)(__builtin_amdgcn_s_memrealtime() - clk_r##k) * 0.1f; dbg_report(F, powf(10.f, 2.f * (rintf(ghz * 5.f) * 0.2f) - 4.f)); }
constexpr int NPHASE = 17;
__global__ void __launch_bounds__(NTHR, 2) fwd(Args args) {
    extern __shared__ __attribute__((aligned(16))) unsigned char lds_raw[];
    Frame F;
    F.lds = (LAS unsigned char*)lds_raw;
    F.tid = threadIdx.x; F.lane = F.tid & 63; F.wave = __builtin_amdgcn_readfirstlane(F.tid >> 6); F.G = gridDim.x; F.bid = blockIdx.x;
    F.a = &args;
    F.ws = args.ws; F.outb = (unsigned char*)args.out;
    volatile LAS unsigned* MISCW = (volatile LAS unsigned*)(F.lds + LDS_MISC);
    if (F.tid < 64) MISCW[F.tid] = 0u;
    __syncthreads();
    XcdBarrier bar; bar.bar = (unsigned*)(F.ws + WS_CTL) + CW_BAR; bar.x = 0; bar.st = nullptr;
#if MK_ONE
    bar = xcd_barrier_post((unsigned*)(F.ws + WS_CTL) + CW_BAR, MISCW + 8);
#define GRID_BAR() xcd_barrier(bar)
#else
#define GRID_BAR() do { } while (0)
#endif
    const int lo = args.ph_lo, hi = args.ph_hi;
#ifndef PHM
#define PHM (0xFFFFFFFFu & ~(DBG_NO_ATTN ? 0x30u : 0u) & ~(DBG_NO_SSD ? 0xC0u : 0u))
#endif
#define IN(k) (((PHM >> (k)) & 1u) && lo <= (k) && (k) < hi)
#define SEAM(k) do { if ((k) + 1 < hi) GRID_BAR(); } while (0)

    if (IN(0)) {
#pragma nounroll
        for (int rep = 0; rep < ((DBG_TWICE & 1u) ? 2 : 1); ++rep) { if (rep) GRID_BAR(); ph_prologue(F); }
        SEAM(0); }
    if (IN(1)) {
#pragma nounroll
        for (int rep = 0; rep < ((DBG_TWICE & 2u) ? 2 : 1); ++rep) { if (rep) GRID_BAR(); ph_ln1(F); }
        SEAM(1); }
    CLK_BEGIN(2);
    if (IN(2)) {
        EpiProj E{(bf16_t*)(F.ws + WS_Q), (bf16_t*)(F.outb + OUT_IQ), (bf16_t*)(F.ws + WS_Z), (bf16_t*)(F.ws + WS_XBC), (bf16_t*)(F.ws + WS_GA), (bf16_t*)(F.ws + WS_GB), (float*)(F.outb + OUT_MISC), 1.0f};
#if PROJ_FP8
        { SchedProj<2> S; S.o.init(NTOK, 12 * 256, F.G, F.bid); S.A = (const char*)(F.ws + WS_U8); S.Bt = (const char*)(F.ws + WS_WIN8);
          EpiProj E8 = E; E8.sc = MOE_INV;
          pg8::gemm_phase<EpiProj, SchedProj<2>, false, 512, true>(F.lds, S, E8);
          if (DBG_TWICE & 32768u) { GRID_BAR(); pg8::gemm_phase<EpiProj, SchedProj<2>, false, 512, true>(F.lds, S, E8); } }
        { SchedProj<1> S; S.o.init(NTOK, 15 * 256, F.G, F.bid); S.A = (const char*)(F.outb + OUT_U); S.Bt = (const char*)(F.ws + WS_WIN); if (DBG_KCLK) S.dbgw = (unsigned*)(F.ws + WS_CTL) + CW_DBG;
#if DBG_DRYPROJ
#pragma nounroll
          for (int rep = 0; rep < 2; ++rep) { EpiProj Ed = E; Ed.dry = rep == 0; SchedProj<1> Sd = S; Sd.fold = rep == 0 ? 7 : 0x7fffffff; pg8::gemm_phase<EpiProj, SchedProj<1>, false>(F.lds, Sd, Ed); if (rep == 0) GRID_BAR(); }
#else
          const unsigned long long w0 = DBG_WALL ? __builtin_amdgcn_s_memrealtime() : 0ull;
          pg8::gemm_phase<EpiProj, SchedProj<1>, false>(F.lds, S, E);
          if (DBG_WALL && F.bid == 0) { const float us = (float)(__builtin_amdgcn_s_memrealtime() - w0) * 0.01f; dbg_report(F, powf(10.f, 2.f * (rintf(us / 300.f * 10.f) * 0.1f) - 4.f)); }
#endif
          if (DBG_TWICE & 4u) { GRID_BAR(); pg8::gemm_phase<EpiProj, SchedProj<1>, false>(F.lds, S, E); } }
#else
        { SchedProj<0> S; S.o.init(NTOK, NPROJ, F.G, F.bid); S.A = (const char*)(F.outb + OUT_U); S.Bt = (const char*)(F.ws + WS_WIN);
          pg8::gemm_phase<EpiProj, SchedProj<0>, false>(F.lds, S, E);
          if (DBG_TWICE & 4u) { GRID_BAR(); pg8::gemm_phase<EpiProj, SchedProj<0>, false>(F.lds, S, E); } }
#endif
        SEAM(2);
    }
    CLK_END(2);
    if (IN(3)) { ph_misc(F); if (DBG_TWICE & 8u) { GRID_BAR(); ph_misc(F); } SEAM(3); }
    if (IN(4)) {
#pragma nounroll
        for (int rep = 0; rep < DBG_REP4; ++rep) { if (rep) GRID_BAR(); ph_index(F, rep + 1 < DBG_REP4 ? DBG_ABL4 : 0); }
        SEAM(4); }
    if (IN(5)) { ph_attn(F); if (DBG_TWICE & 32u) { GRID_BAR(); ph_attn(F); } SEAM(5); if (DBG_CHECK == 3) { dbg_check_attn(F); GRID_BAR(); } }
    if (IN(6)) {
#pragma nounroll
        for (int rep = 0; rep < DBG_REP6; ++rep) { if (rep) GRID_BAR(); ph_ssd2(F, rep + 1 < DBG_REP6 ? DBG_ABL6 : 0); }
        SEAM(6); if (DBG_CHECK == 2) { dbg_check_ssd(F); GRID_BAR(); } }
    if (IN(7)) { ph_gnorm(F); if (DBG_TWICE & 128u) { GRID_BAR(); ph_gnorm(F); } SEAM(7); }
    if (IN(8)) {
#if PA_FP8
        SchedPlainT<1024> S; S.o.init(NTOK, 1024, F.G, F.bid); S.A = (const char*)(F.outb + OUT_OA); S.Bt = (const char*)(F.ws + WS_WPA8);
        EpiGate<0> E{(const bf16_t*)(F.ws + WS_GA), nullptr, (bf16_t*)(F.ws + WS_Z), MOE_INV};
        pg8::gemm_phase<EpiGate<0>, SchedPlainT<1024>, false, 512, true>(F.lds, S, E);
#else
        SchedPlain S; S.o.init(NTOK, 1024, F.G, F.bid); S.A = (const char*)(F.outb + OUT_OA); S.Bt = (const char*)(F.ws + WS_WPA);
        EpiGate<0> E{(const bf16_t*)(F.ws + WS_GA), nullptr, (bf16_t*)(F.ws + WS_Z), 1.0f};
        pg8::gemm_phase<EpiGate<0>, SchedPlain, false>(F.lds, S, E);
#endif
    }
    if (IN(9)) {
#if PB_FP8
        SchedPlainT<1024> S; S.o.init(NTOK, 1024, F.G, F.bid); S.A = (const char*)(F.outb + OUT_OB8); S.Bt = (const char*)(F.ws + WS_WPB8);
        EpiGate<1> E{(const bf16_t*)(F.ws + WS_GB), (const bf16_t*)(F.ws + WS_Z), (bf16_t*)(F.ws + WS_XBC), MOE_INV};
        pg8::gemm_phase<EpiGate<1>, SchedPlainT<1024>, false, 512, true>(F.lds, S, E);
#else
        SchedPlain S; S.o.init(NTOK, 1024, F.G, F.bid); S.A = (const char*)(F.ws + WS_Q); S.Bt = (const char*)(F.ws + WS_WPB);
        EpiGate<1> E{(const bf16_t*)(F.ws + WS_GB), (const bf16_t*)(F.ws + WS_Z), (bf16_t*)(F.ws + WS_XBC), 1.0f};
        pg8::gemm_phase<EpiGate<1>, SchedPlain, false>(F.lds, S, E);
#endif
        SEAM(9);
    }
    if (IN(10)) {
        SchedPlain S; S.o.init(NTOK, 1024, F.G, F.bid); S.A = (const char*)(F.ws + WS_XBC); S.Bt = (const char*)(F.ws + WS_WOUT);
        EpiOut E{F.a->in[0], (const float*)(F.ws + WS_MOD), (bf16_t*)(F.ws + WS_VB)};
        pg8::gemm_phase<EpiOut, SchedPlain, false>(F.lds, S, E);
        if (DBG_TWICE & 1024u) { GRID_BAR(); pg8::gemm_phase<EpiOut, SchedPlain, false>(F.lds, S, E); }
        SEAM(10);
    }
    if (IN(11)) { if (DBG_TWICE & 2048u) { ph_router<true>(F); GRID_BAR(); } ph_router<false>(F); SEAM(11); }
#pragma unroll
    for (int hf = 0; hf < 2; ++hf) {
        const int p0 = 12 + hf * 2;
        if (IN(p0)) {
            if (hf == 1) ph_final<false>(F, 0);
            MoeTab T = moe_tables(F, hf);
            SchedMoe<8, true> S{T, F.G, F.bid, hf, (const char*)(F.ws + WS_U2), (const char*)(F.ws + WS_W1), (const u32x2*)(F.ws + WS_REG)};
            EpiMoe1 E{F.a->in[23], (bf16_t*)(F.ws + WS_ACT), 0};
            pg8::gemm_phase<EpiMoe1, SchedMoe<8, true>, true, MOE_RB / 2, MOE_FP8 != 0>(F.lds, S, E);
            if ((DBG_TWICE & 4096u) && hf == 0) { GRID_BAR(); pg8::gemm_phase<EpiMoe1, SchedMoe<8, true>, true, MOE_RB / 2, MOE_FP8 != 0>(F.lds, S, E); }
            if ((DBG_TWICE & 16384u) && hf == 0) { GRID_BAR(); EpiMoe1 Ed = E; Ed.dry = 1; pg8::gemm_phase<EpiMoe1, SchedMoe<8, true>, true, MOE_RB / 2, MOE_FP8 != 0>(F.lds, S, Ed); }
            SEAM(p0);
        }
        if (IN(p0 + 1)) {
            MoeTab T = moe_tables(F, hf);
            SchedMoe<4, false> S{T, F.G, F.bid, hf, (const char*)(F.ws + WS_ACT), (const char*)(F.ws + WS_W2), (const u32x2*)(F.ws + WS_REG)};
            EpiMoe2 E{F.a->in[25], (bf16_t*)(F.ws + WS_YB), (const u32x2*)(F.ws + WS_REG), T, hf, 0};
            if ((DBG_TWICE & 262144u) && hf == 0) { EpiMoe2 Ed = E; Ed.dry = DBG_DRYMODE; pg8::gemm_phase<EpiMoe2, SchedMoe<4, false>, false, MOE_RB / 2, MOE_FP8 != 0>(F.lds, S, Ed); GRID_BAR(); }
            pg8::gemm_phase<EpiMoe2, SchedMoe<4, false>, false, MOE_RB / 2, MOE_FP8 != 0>(F.lds, S, E);
            if ((DBG_TWICE & 8192u) && hf == 0) { GRID_BAR(); pg8::gemm_phase<EpiMoe2, SchedMoe<4, false>, false, MOE_RB / 2, MOE_FP8 != 0>(F.lds, S, E); }
            if ((DBG_TWICE & 131072u) && hf == 0) { GRID_BAR(); EpiMoe2 Ed = E; Ed.dry = 1; pg8::gemm_phase<EpiMoe2, SchedMoe<4, false>, false, MOE_RB / 2, MOE_FP8 != 0>(F.lds, S, Ed); }
            SEAM(p0 + 1);
            if (DBG_CHECK == 1 && hf == 1) { dbg_check_moe(F); GRID_BAR(); }
        }
    }
    if (IN(16)) { if (DBG_TWICE & 65536u) { ph_final<true>(F, 1); GRID_BAR(); } ph_final(F, 1); }
    if (DBG_CHECK || DBG_CLOCK || DBG_KCLK || DBG_WALL) { GRID_BAR(); dbg_emit(F); }
#undef IN
#undef SEAM
}

extern "C" void kernel_launch(void* const* d_in, const int* in_sizes, int n_in, void* d_out, int out_size, void* d_ws, size_t ws_size, hipStream_t stream) {
    static int grid = 0;
    if (grid == 0) {
        if (n_in != 28 || in_sizes[0] != NTOK * D || out_size != NTOK * D || ws_size < WS_END) { fprintf(stderr, "kernel_launch: shape mismatch (n_in %d, in0 %d, out %d, ws %zu)\n", n_in, n_in > 0 ? in_sizes[0] : -1, out_size, ws_size); grid = -1; return; }
        int dev = 0, cus = 0, per_cu = 0;
        if (hipGetDevice(&dev) != hipSuccess || hipDeviceGetAttribute(&cus, hipDeviceAttributeMultiprocessorCount, dev) != hipSuccess) { grid = -1; return; }
        if (hipFuncSetAttribute((const void*)fwd, hipFuncAttributeMaxDynamicSharedMemorySize, LDS_BYTES) != hipSuccess) { fprintf(stderr, "kernel_launch: hipFuncSetAttribute failed\n"); grid = -1; return; }
        if (hipOccupancyMaxActiveBlocksPerMultiprocessor(&per_cu, (const void*)fwd, NTHR, LDS_BYTES) != hipSuccess || per_cu < 1) fprintf(stderr, "kernel_launch: occupancy query reports %d\n", per_cu);
        (void)hipGetLastError();
        grid = cus;
    }
    if (grid < 0) return;
    if (hipMemsetAsync((char*)d_ws + WS_CTL, 0, CTL_ZERO_BYTES, stream) != hipSuccess) { fprintf(stderr, "kernel_launch: memset failed\n"); return; }
    Args a{};
    for (int i = 0; i < 28; ++i) a.in[i] = (const float*)d_in[i];
    a.out = (float*)d_out; a.ws = (unsigned char*)d_ws;
    const int nph = NPHASE < MK_PH_HI ? NPHASE : MK_PH_HI;
#if MK_ONE
    a.ph_lo = 0; a.ph_hi = nph;
    hipLaunchKernelGGL(fwd, dim3(grid), dim3(NTHR), LDS_BYTES, stream, a);
#else
    for (int p = 0; p < nph; ++p) { a.ph_lo = p; a.ph_hi = p + 1; hipLaunchKernelGGL(fwd, dim3(grid), dim3(NTHR), LDS_BYTES, stream, a); }
#endif
    const hipError_t le = hipPeekAtLastError();
    if (le != hipSuccess) fprintf(stderr, "kernel_launch: launch failed: %s\n", hipGetErrorName(le));
}
```

```cpp
#include <hip/hip_runtime.h>
#include <cstdio>
#include <cstdint>

#ifndef MK_ONE
#define MK_ONE 1
#endif
#ifndef DBG_NO_ATTN
#define DBG_NO_ATTN 0
#endif
#ifndef DBG_ATTN_ZERO
#define DBG_ATTN_ZERO 0
#endif
#ifndef DBG_IQ_TRUNC
#define DBG_IQ_TRUNC 0
#endif
#ifndef DBG_ROUTER_BF16
#define DBG_ROUTER_BF16 0
#endif
#ifndef DBG_CHECK
#define DBG_CHECK 0
#endif
#ifndef DBG_SKIP_BODY
#define DBG_SKIP_BODY 0
#endif
#ifndef DBG_SUB
#define DBG_SUB 0
#endif
#ifndef DBG_SSD_SYNC
#define DBG_SSD_SYNC 0
#endif
#ifndef DBG_HYP
#define DBG_HYP 0
#endif
#ifndef DBG_TWICE
#define DBG_DRYPROJ 0
#define DBG_ABL6 0
#define DBG_ABL4 0
#define DBG_REP4 1
#define DBG_REP6 1
#define DBG_WALL 0
#define DBG_KCLK 0
#ifndef DBG_CLOCK
#define DBG_CLOCK 0
#endif
#define DBG_TWICE 0u
#endif
#ifndef DBG_DRYMODE
#define DBG_DRYMODE 2
#endif
#ifndef DBG_NO_SSD
#define DBG_NO_SSD 0
#endif
#ifndef DBG_NO_MOE
#define DBG_NO_MOE 0
#endif
#ifndef MOE_FP8
#define MOE_FP8 1
#endif
#ifndef PROJ_FP8
#define PROJ_FP8 1
#endif
#ifndef PA_FP8
#define PA_FP8 1
#endif
#ifndef PB_FP8
#define PB_FP8 0
#endif
#ifndef ATT2
#define GATE_U8 1
#define ATT_OT 1
#define ATT2 1
#endif
#ifndef MK_PH_HI
#define MK_PH_HI 99
#endif

#define LAS __attribute__((address_space(3)))
#define GAS __attribute__((address_space(1)))
typedef unsigned short bf16_t;
typedef short bf16x8 __attribute__((ext_vector_type(8)));
typedef short s16x4 __attribute__((ext_vector_type(4)));
typedef float f32x2 __attribute__((ext_vector_type(2)));
typedef float f32x4 __attribute__((ext_vector_type(4)));
typedef float f32x16 __attribute__((ext_vector_type(16)));
typedef unsigned u32x2 __attribute__((ext_vector_type(2)));
typedef unsigned u32x4 __attribute__((ext_vector_type(4)));
typedef unsigned long long u64;

constexpr int NB = 32, SEQ = 2048, D = 1024, NTOK = NB * SEQ;
constexpr int NWAVES = 8, NTHR = 512;
constexpr int NPROJ = 6912;
constexpr int NEXP = 32, HALF_TOK = NTOK / 2, REG_CAP = HALF_TOK;
constexpr int ACT_ROWS = HALF_TOK * 4 + NEXP * 256;
constexpr float LN_EPS = 1e-5f;
constexpr float DN_ALPHA = 1.189207115002721f;
constexpr float LOG2E = 1.4426950408889634f;

constexpr size_t MiB = 1u << 20;
constexpr size_t WS_CTL = 0, CTL_ZERO_BYTES = 1 * MiB;
constexpr size_t WS_MOD = 1 * MiB;
constexpr size_t WS_BIAST = 1 * MiB + 800 * 1024;
constexpr size_t WS_WIN = 2 * MiB;
constexpr size_t WS_WPA = 16 * MiB, WS_WPB = 18 * MiB, WS_WOUT = 20 * MiB;
constexpr size_t WS_W1 = 24 * MiB;
constexpr size_t WS_U8 = 88 * MiB;
constexpr size_t WS_W2 = 152 * MiB;
constexpr size_t WS_WIN8 = 184 * MiB;
constexpr size_t WS_WPA8 = 192 * MiB;
constexpr size_t WS_WPB8 = 194 * MiB;
constexpr size_t OUT_OB8 = 192 * MiB;
constexpr size_t WS_Q = 216 * MiB;
constexpr size_t WS_Z = 344 * MiB;
constexpr size_t WS_XBC = 472 * MiB;
constexpr size_t WS_GA = 728 * MiB, WS_GB = 856 * MiB;
constexpr size_t WS_U2 = 216 * MiB;
constexpr size_t WS_REG = 344 * MiB;
constexpr size_t WS_ACT = 360 * MiB;
constexpr size_t WS_YB = 632 * MiB;
constexpr size_t WS_X1B = 496 * MiB;
constexpr size_t WS_VB = 744 * MiB;
constexpr size_t WS_END = 984 * MiB;
constexpr size_t WS_DBG = 889 * MiB;
constexpr size_t OUT_U = 0, OUT_MISC = 128 * MiB, OUT_IQ = 192 * MiB;
constexpr size_t OUT_KV = 0, OUT_IK = 16 * MiB, OUT_IW = 24 * MiB, OUT_DT = 26 * MiB, OUT_MASK = 32 * MiB, OUT_OA = 64 * MiB;
constexpr int CW_BAR = 4096, CW_CNT = 16384, CW_WQ = 22528, CW_DBG = 24576;

constexpr int LDS_BYTES = 160 * 1024;
constexpr int LDS_AUX = 131072;
constexpr int LDS_MISC = LDS_BYTES - 256;

#define LDS_WAIT() asm volatile("s_waitcnt lgkmcnt(0)" ::: "memory")
#define GAS __attribute__((address_space(1)))
#define VM_WAIT() asm volatile("s_waitcnt vmcnt(0)" ::: "memory")
#define SBAR() __builtin_amdgcn_sched_barrier(0)
typedef __bf16 bf16x2_t __attribute__((ext_vector_type(2)));
__device__ __forceinline__ unsigned cvt_pk_bf16(float lo, float hi) { f32x2 f = {lo, hi}; bf16x2_t v = __builtin_convertvector(f, bf16x2_t); return __builtin_bit_cast(unsigned, v); }
__device__ __forceinline__ float bflo(unsigned w) { return __uint_as_float(w << 16); }
__device__ __forceinline__ float bfhi(unsigned w) { return __uint_as_float(w & 0xffff0000u); }
__device__ __forceinline__ u32x4 pack8(f32x4 a, f32x4 b) { u32x4 w; w.x = cvt_pk_bf16(a[0], a[1]); w.y = cvt_pk_bf16(a[2], a[3]); w.z = cvt_pk_bf16(b[0], b[1]); w.w = cvt_pk_bf16(b[2], b[3]); return w; }
constexpr int MOE_RB = MOE_FP8 ? 1024 : 2048;
constexpr float MOE_WSC = MOE_FP8 ? 64.0f : 1.0f, MOE_INV = 1.0f / MOE_WSC;
__device__ __forceinline__ u32x2 pack8_fp8(f32x4 a, f32x4 b) { int lo = 0, hi = 0;
    lo = __builtin_amdgcn_cvt_pk_fp8_f32(a[0], a[1], lo, false); lo = __builtin_amdgcn_cvt_pk_fp8_f32(a[2], a[3], lo, true);
    hi = __builtin_amdgcn_cvt_pk_fp8_f32(b[0], b[1], hi, false); hi = __builtin_amdgcn_cvt_pk_fp8_f32(b[2], b[3], hi, true);
    u32x2 r; r.x = (unsigned)lo; r.y = (unsigned)hi; return r; }
__device__ __forceinline__ void unpack8(u32x4 w, f32x4& a, f32x4& b) { a[0] = bflo(w.x); a[1] = bfhi(w.x); a[2] = bflo(w.y); a[3] = bfhi(w.y); b[0] = bflo(w.z); b[1] = bfhi(w.z); b[2] = bflo(w.w); b[3] = bfhi(w.w); }
__device__ __forceinline__ float dpp_scan_add(float v) {
#define DPPF(x, ctrl, rm) __builtin_bit_cast(float, __builtin_amdgcn_update_dpp(0, __builtin_bit_cast(int, (x)), (ctrl), (rm), 0xf, false))
    v += DPPF(v, 0x111, 0xf); v += DPPF(v, 0x112, 0xf); v += DPPF(v, 0x114, 0xf); v += DPPF(v, 0x118, 0xf);
    v += DPPF(v, 0x142, 0xa);
    v += DPPF(v, 0x143, 0xc);
#undef DPPF
    return v;
}
__device__ __forceinline__ unsigned dpp_half_sums_u32(unsigned v) {
#define DPPU(x, ctrl, rm) (unsigned)__builtin_amdgcn_update_dpp(0, (int)(x), (ctrl), (rm), 0xf, false)
    v += DPPU(v, 0x111, 0xf); v += DPPU(v, 0x112, 0xf); v += DPPU(v, 0x114, 0xf); v += DPPU(v, 0x118, 0xf); v += DPPU(v, 0x142, 0xa);
#undef DPPU
    return v;
}
__device__ __forceinline__ float dpp_half_sums_f32(float v) {
#define DPPF(x, ctrl, rm) __builtin_bit_cast(float, __builtin_amdgcn_update_dpp(0, __builtin_bit_cast(int, (x)), (ctrl), (rm), 0xf, false))
    v += DPPF(v, 0x111, 0xf); v += DPPF(v, 0x112, 0xf); v += DPPF(v, 0x114, 0xf); v += DPPF(v, 0x118, 0xf); v += DPPF(v, 0x142, 0xa);
#undef DPPF
    return v;
}
__device__ __forceinline__ float wave_sum(float v) { v = dpp_scan_add(v); return __builtin_bit_cast(float, __builtin_amdgcn_readlane(__builtin_bit_cast(int, v), 63)); }
__device__ __forceinline__ float fast_rcp(float x) { return __builtin_amdgcn_rcpf(x); }
__device__ __forceinline__ float sigmoid_f(float x) { return fast_rcp(1.0f + __expf(-x)); }
__device__ __forceinline__ float silu_f(float x) { return x * sigmoid_f(x); }

#define XB_TMO      128
#define XB_XCNT(j)  (256  + 64 * (j))
#define XB_XSUB(j)  (1280 + 64 * (j))
#define XB_XGEN(j)  (2304 + 64 * (j))
#define XB_TOP      3328
#define XB_TOPGEN   3392
#define XCD_BAR_WORDS 3456
#define XB_SPIN_CAP (1u << 18)
__device__ __forceinline__ unsigned xb_ld(unsigned* p)              { return __hip_atomic_load(p, __ATOMIC_RELAXED, __HIP_MEMORY_SCOPE_AGENT); }
__device__ __forceinline__ unsigned xb_add(unsigned* p, unsigned v) { return __hip_atomic_fetch_add(p, v, __ATOMIC_RELAXED, __HIP_MEMORY_SCOPE_AGENT); }
__device__ __forceinline__ unsigned xb_xcc_id() { return (unsigned)__builtin_amdgcn_s_getreg((3 << 11) | 20) & 0xFu; }
#define XB_SPIN(cond, bar) do { unsigned _sp = 0; while (cond) { __builtin_amdgcn_s_sleep(1); \
    if ((++_sp & 255u) == 0u) { if (xb_ld(&(bar)[XB_TMO])) break; if (_sp > XB_SPIN_CAP) { atomicAdd(&(bar)[XB_TMO], 1u); break; } } } } while (0)
struct XcdBarrier { unsigned* bar; unsigned x; volatile LAS unsigned* st; };
__device__ __forceinline__ XcdBarrier xcd_barrier_post(unsigned* bar, volatile LAS unsigned* st) {
    XcdBarrier b; b.bar = bar; b.x = xb_xcc_id(); b.st = st;
    if (threadIdx.x == 0) (void)xb_add(&bar[XB_XCNT(b.x)], 1u);
    return b;
}
__device__ __forceinline__ void xcd_barrier_complete(unsigned* bar, unsigned x, unsigned& nloc, unsigned& nx) {
    const unsigned G = gridDim.x * gridDim.y * gridDim.z;
    unsigned sum, cnt, mine, sp = 0u;
    for (;;) {
        sum = 0u; cnt = 0u;
#pragma nounroll
        for (unsigned j = 0; j < 16; ++j) { const unsigned c = xb_ld(&bar[XB_XCNT(j)]); sum += c; cnt += (c > 0u) ? 1u : 0u; }
        if (sum == G) break;
        __builtin_amdgcn_s_sleep(1);
        if ((++sp & 255u) == 0u) { if (xb_ld(&bar[XB_TMO])) break; if (sp > XB_SPIN_CAP) { atomicAdd(&bar[XB_TMO], 1u); break; } }
    }
    mine = xb_ld(&bar[XB_XCNT(x)]);
    nloc = mine > 0u ? mine : 1u; nx = cnt > 0u ? cnt : 1u;
}
__device__ __forceinline__ void xcd_barrier(const XcdBarrier& b) {
    asm volatile("s_waitcnt vmcnt(0)" ::: "memory");
    __syncthreads();
    if (threadIdx.x == 0) {
        unsigned* bar = b.bar;
        __builtin_amdgcn_s_waitcnt(0);
        unsigned nloc = b.st[0], nx = b.st[1];
        if (nloc == 0u) { xcd_barrier_complete(bar, b.x, nloc, nx); b.st[0] = nloc; b.st[1] = nx; }
        const unsigned old = xb_add(&bar[XB_XSUB(b.x)], 1u);
        const unsigned gen = old / nloc;
        if (old + 1u == (gen + 1u) * nloc) {
            __builtin_amdgcn_fence(__ATOMIC_RELEASE, "agent");
            asm volatile("s_waitcnt vmcnt(0)" ::: "memory");
            const unsigned og = xb_add(&bar[XB_TOP], 1u);
            const unsigned tg = og / nx;
            if (og + 1u == (tg + 1u) * nx) xb_add(&bar[XB_TOPGEN], 1u);
            else XB_SPIN(xb_ld(&bar[XB_TOPGEN]) == tg, bar);
            __builtin_amdgcn_fence(__ATOMIC_ACQUIRE, "agent");
            xb_add(&bar[XB_XGEN(b.x)], 1u);
            asm volatile("s_waitcnt vmcnt(0)" ::: "memory");
        } else {
            XB_SPIN(xb_ld(&bar[XB_XGEN(b.x)]) == gen, bar);
            __builtin_amdgcn_fence(__ATOMIC_ACQUIRE, "agent");
            asm volatile("s_waitcnt vmcnt(0)" ::: "memory");
        }
    }
    __syncthreads();
}

namespace pg8 {
constexpr int BM = 256, BK = 64, HALF = 128, HTB = HALF * BK * 2, STAGE_BYTES = 8 * HTB, NXCD = 8, WGM = 8, KD = 1024;
__host__ __device__ __forceinline__ int lds_byte(int r, int c) { const int st = (r >> 4) * 2 + (c >> 5), rr = r & 15, cc = c & 31, ob = rr * 64 + cc * 2; return st * 1024 + (ob ^ (((ob >> 9) & 1) << 5)); }
__host__ __device__ __forceinline__ void stage_rc(int b, int& R, int& C) { const int st = b / 1024, sb = b % 1024, swz = sb ^ (((sb >> 9) & 1) << 5); R = (st >> 1) * 16 + swz / 64; C = (st & 1) * 32 + (swz % 64) / 2; }
__host__ __device__ __forceinline__ int perm32(int rho) { const int n = rho >> 4, i = rho & 15; return 8 * (i >> 2) + 4 * n + (i & 3); }
struct Unit { int pm, pn, ex; };
struct StaticOrder {
    int nM, nN, nwg, G, c;
    __device__ void init(int M, int N, int G_, int c_) { nM = M / BM; nN = N / BM; nwg = nM * nN; G = G_; c = c_; }
    __device__ bool next(int i, Unit& u) const {
        const long L = (long)i * G + c; if (L >= nwg) return false;
        int wgid = (int)L; { const int q = nwg / NXCD, r = nwg % NXCD, xcd = wgid % NXCD, off = wgid / NXCD; wgid = (xcd < r ? xcd * (q + 1) : r * (q + 1) + (xcd - r) * q) + off; }
        const int nig = WGM * nN, gid = wgid / nig, fm = gid * WGM, gsz = (nM - fm) < WGM ? (nM - fm) : WGM;
        u.pm = fm + ((wgid % nig) % gsz); u.pn = (wgid % nig) / gsz; u.ex = 0; return true;
    }
};
typedef int i32x8 __attribute__((ext_vector_type(8)));
typedef int i32x4v __attribute__((ext_vector_type(4)));
template <class T> __device__ __forceinline__ auto dbgw_of(const T& s, int) -> decltype(s.dbgw) { return s.dbgw; }
template <class T> __device__ __forceinline__ unsigned* dbgw_of(const T&, long) { return nullptr; }
template <class Epi, class Sched, bool GATHER, int KE = 1024, bool FP8 = false>
__device__ __forceinline__ void gemm_phase(LAS unsigned char* lds, const Sched& S, const Epi& E) {
    int tid = threadIdx.x; asm volatile("" : "+v"(tid));
    const int wid = __builtin_amdgcn_readfirstlane(tid >> 6), lane = tid & 63, wr = wid >> 2, wc = wid & 3, fr = lane & 15, fq = lane >> 4;
    constexpr int K = KE, nt = K / BK;
    unsigned voffA[2], voffB[2]; int Rr[2], Cc[2];
#pragma unroll
    for (int i = 0; i < 2; ++i) { int R, C; stage_rc(tid * 16 + i * 8192, R, C); const int Rb = Epi::PERM ? ((R & ~31) + perm32(R & 31)) : R;
        voffA[i] = (unsigned)(R * K + C) * 2u; voffB[i] = (unsigned)(Rb * K + C) * 2u; Rr[i] = R; Cc[i] = C; }
    constexpr size_t kstep = (size_t)(BK * 2);
    constexpr size_t hstep = (size_t)HALF * K * 2;
    const unsigned ldsw = (unsigned)wid * 1024u;
    const int aoff = lds_byte(wr * 64 + fr, fq * 8), boff = lds_byte(wc * 32 + fr, fq * 8);
#define PG8_SA(b, h) (((b) * 2 + (h)) * HTB)
#define PG8_SB(b, h) ((4 + (b) * 2 + (h)) * HTB)
#define PG8_STAGE(bufoff, gbase, voff) do { _Pragma("unroll") for (int _i = 0; _i < 2; ++_i) \
        __builtin_amdgcn_global_load_lds((const unsigned*)((const char*)(gbase) + (voff)[_i]), (LAS unsigned*)(lds + (bufoff) + ldsw + _i * 8192), 16, 0, 0); } while (0)
#define PG8_STAGE_A(bufoff, gb, h, o0, o1) do { if constexpr (GATHER) { const unsigned _ko = (unsigned)((gb) - gA0); unsigned _o[2]; \
            if ((h) == 0) { _o[0] = (o0)[0] + _ko; _o[1] = (o0)[1] + _ko; } else { _o[0] = (o1)[0] + _ko; _o[1] = (o1)[1] + _ko; } PG8_STAGE(bufoff, gA0, _o); } \
        else { PG8_STAGE(bufoff, (gb) + (h) * hstep, voffA); } } while (0)
#define PG8_LD8(p) __builtin_shufflevector(*(const LAS i32x4v*)(p), *(const LAS i32x4v*)((p) + 1024), 0, 1, 2, 3, 4, 5, 6, 7)
#define PG8_LDA(dst, b, h) do { if constexpr (FP8) { _Pragma("unroll") for (int m = 0; m < 4; ++m) dst##8[m] = PG8_LD8(lds + PG8_SA(b, h) + aoff + m * 2048); } \
        else { _Pragma("unroll") for (int m = 0; m < 4; ++m) _Pragma("unroll") for (int k = 0; k < 2; ++k) dst[m][k] = *(const LAS bf16x8*)(lds + PG8_SA(b, h) + aoff + m * 2048 + k * 1024); } } while (0)
#define PG8_LDB(dst, b, h) do { if constexpr (FP8) { _Pragma("unroll") for (int n = 0; n < 2; ++n) dst##8[n] = PG8_LD8(lds + PG8_SB(b, h) + boff + n * 2048); } \
        else { _Pragma("unroll") for (int n = 0; n < 2; ++n) _Pragma("unroll") for (int k = 0; k < 2; ++k) dst[n][k] = *(const LAS bf16x8*)(lds + PG8_SB(b, h) + boff + n * 2048 + k * 1024); } } while (0)
#define PG8_MMA(ai, bj, At, Bt) do { __builtin_amdgcn_s_setprio(1); if constexpr (FP8) { _Pragma("unroll") for (int m = 0; m < 4; ++m) _Pragma("unroll") for (int n = 0; n < 2; ++n) \
            asm volatile("v_mfma_scale_f32_16x16x128_f8f6f4 %0, %1, %2, %0, %3, %3 op_sel_hi:[0,0,0]" : "+v"(acc[ai][bj][m][n]) : "v"(Bt##8[n]), "v"(At##8[m]), "v"(sc127)); } \
        else { _Pragma("unroll") for (int m = 0; m < 4; ++m) _Pragma("unroll") for (int n = 0; n < 2; ++n) _Pragma("unroll") for (int k = 0; k < 2; ++k) \
            acc[ai][bj][m][n] = __builtin_amdgcn_mfma_f32_16x16x32_bf16(Bt[n][k], At[m][k], acc[ai][bj][m][n], 0, 0, 0); } __builtin_amdgcn_s_setprio(0); } while (0)
#define PG8_WAIT_V(n) asm volatile("s_waitcnt vmcnt(" #n ")" ::: "memory")
#define PG8_WAIT_L(n) asm volatile("s_waitcnt lgkmcnt(" #n ")" ::: "memory")
#define PG8_BAR __builtin_amdgcn_s_barrier()
#define PG8_SCHED __builtin_amdgcn_sched_barrier(0)
    Unit cur, nxt; int ui = 0; unsigned long long kcsum = 0; int kcn = 0; const unsigned long long kph0 = (DBG_KCLK && !FP8 && !GATHER) ? __builtin_amdgcn_s_memtime() : 0ull;
    if (!S.next(0, cur)) return;
    f32x4 acc[2][2][4][2];
#pragma unroll
    for (int a = 0; a < 2; ++a)
#pragma unroll
        for (int b = 0; b < 2; ++b)
#pragma unroll
            for (int m = 0; m < 4; ++m)
#pragma unroll
                for (int n = 0; n < 2; ++n) acc[a][b][m][n] = (f32x4){0.f, 0.f, 0.f, 0.f};
    const int sc127 = 0x7f7f7f7f;
    bf16x8 At[4][2], B0[2][2], B1[2][2]; i32x8 At8[4], B08[2], B18[2];
    const char* cA = S.a_base(cur); const char* cB = S.b_base(cur);
    const char* const gA0 = cA;
    unsigned cv0[2] = {0u, 0u}, cv1[2] = {0u, 0u}, nv0[2] = {0u, 0u}, nv1[2] = {0u, 0u};
    if constexpr (GATHER) S.a_offs(cur, Rr, Cc, cv0, cv1);
    PG8_STAGE(PG8_SB(0, 0), cB, voffB); PG8_STAGE_A(PG8_SA(0, 0), cA, 0, cv0, cv1); PG8_STAGE(PG8_SB(0, 1), cB + hstep, voffB); PG8_STAGE_A(PG8_SA(0, 1), cA, 1, cv0, cv1);
    if (wr == 1) PG8_BAR;
    PG8_WAIT_V(4); PG8_BAR;
    PG8_STAGE(PG8_SB(1, 0), cB + kstep, voffB); PG8_STAGE_A(PG8_SA(1, 0), cA + kstep, 0, cv0, cv1); PG8_STAGE(PG8_SB(1, 1), cB + hstep + kstep, voffB);
    PG8_WAIT_V(6); PG8_BAR;
    for (;;) {
        const bool has_next = S.next(ui + 1, nxt);
        const char* nA = has_next ? S.a_base(nxt) : cA; const char* nB = has_next ? S.b_base(nxt) : cB;
        if constexpr (GATHER) { if (has_next) S.a_offs(nxt, Rr, Cc, nv0, nv1); else { nv0[0] = cv0[0]; nv0[1] = cv0[1]; nv1[0] = cv1[0]; nv1[1] = cv1[1]; } }
        unsigned long long kc0 = 0; if constexpr (DBG_KCLK && !FP8 && !GATHER) kc0 = __builtin_amdgcn_s_memtime();
#pragma nounroll
        for (int t = 0; t < nt; t += 2) {
            const bool last = (t == nt - 2);
            const char* a1 = cA + (size_t)(t + 1) * kstep;
            const char* a2 = last ? nA : cA + (size_t)(t + 2) * kstep; const char* b2 = last ? nB : cB + (size_t)(t + 2) * kstep;
            const char* a3 = a2 + kstep; const char* b3 = b2 + kstep;
            unsigned s0[2], s1[2];
            if constexpr (GATHER) { s0[0] = last ? nv0[0] : cv0[0]; s0[1] = last ? nv0[1] : cv0[1]; s1[0] = last ? nv1[0] : cv1[0]; s1[1] = last ? nv1[1] : cv1[1]; } else { s0[0] = s0[1] = s1[0] = s1[1] = 0u; }
            PG8_LDB(B0, 0, 0); PG8_SCHED; PG8_LDA(At, 0, 0); PG8_STAGE_A(PG8_SA(1, 1), a1, 1, cv0, cv1);
            PG8_WAIT_L(8); PG8_BAR; PG8_WAIT_L(0); PG8_MMA(0, 0, At, B0); PG8_BAR; PG8_SCHED;
            PG8_LDB(B1, 0, 1); PG8_STAGE(PG8_SB(0, 0), b2, voffB);
            PG8_BAR; PG8_WAIT_L(0); PG8_MMA(0, 1, At, B1); PG8_BAR;
            PG8_LDA(At, 0, 1); PG8_STAGE_A(PG8_SA(0, 0), a2, 0, s0, s1);
            PG8_BAR; PG8_WAIT_L(0); PG8_MMA(1, 0, At, B0); PG8_BAR; PG8_SCHED;
            PG8_STAGE(PG8_SB(0, 1), b2 + hstep, voffB);
            PG8_WAIT_V(6); PG8_BAR; PG8_MMA(1, 1, At, B1); PG8_BAR;
            PG8_LDB(B0, 1, 0); PG8_SCHED; PG8_LDA(At, 1, 0); PG8_STAGE_A(PG8_SA(0, 1), a2, 1, s0, s1);
            PG8_WAIT_L(8); PG8_BAR; PG8_WAIT_L(0); PG8_MMA(0, 0, At, B0); PG8_BAR; PG8_SCHED;
            PG8_LDB(B1, 1, 1); PG8_STAGE(PG8_SB(1, 0), b3, voffB);
            PG8_BAR; PG8_WAIT_L(0); PG8_MMA(0, 1, At, B1); PG8_BAR;
            PG8_LDA(At, 1, 1); PG8_STAGE_A(PG8_SA(1, 0), a3, 0, s0, s1);
            PG8_BAR; PG8_WAIT_L(0); PG8_MMA(1, 0, At, B0); PG8_BAR; PG8_SCHED;
            PG8_STAGE(PG8_SB(1, 1), b3 + hstep, voffB);
            PG8_WAIT_V(6); PG8_BAR; PG8_MMA(1, 1, At, B1); PG8_BAR;
        }
        if constexpr (DBG_KCLK && !FP8 && !GATHER) { kc0 = __builtin_amdgcn_s_memtime(); }
        if constexpr (FP8) asm volatile("s_nop 15\n\ts_nop 15" ::: "memory");
        E(acc, cur, wr, wc, fr, fq);
        if constexpr (DBG_KCLK && !FP8 && !GATHER) { asm volatile("s_waitcnt vmcnt(0)" ::: "memory"); kcsum += __builtin_amdgcn_s_memtime() - kc0; ++kcn; }
        if (!has_next) break;
#pragma unroll
        for (int a = 0; a < 2; ++a)
#pragma unroll
            for (int b = 0; b < 2; ++b)
#pragma unroll
                for (int m = 0; m < 4; ++m)
#pragma unroll
                    for (int n = 0; n < 2; ++n) acc[a][b][m][n] = (f32x4){0.f, 0.f, 0.f, 0.f};
        cur = nxt; cA = nA; cB = nB; ++ui;
        if constexpr (GATHER) { cv0[0] = nv0[0]; cv0[1] = nv0[1]; cv1[0] = nv1[0]; cv1[1] = nv1[1]; }
    }
    PG8_WAIT_V(0);
    if (wr == 0) PG8_BAR;
    PG8_BAR;
    if constexpr (DBG_KCLK && !FP8 && !GATHER) { unsigned* dw = dbgw_of(S, 0); if (dw && tid == 0) { kcsum = __builtin_amdgcn_s_memtime() - kph0; const float cpk = (float)kcsum / (float)(kcn) * (1.f / 40000.f); atomicMax(dw, __float_as_uint(powf(10.f, 2.f * (rintf(cpk * 10.f) * 0.1f) - 4.f))); } }
#undef PG8_SA
#undef PG8_SB
#undef PG8_STAGE
#undef PG8_STAGE_A
#undef PG8_LDA
#undef PG8_LDB
#undef PG8_MMA
#undef PG8_LD8
#undef PG8_WAIT_V
#undef PG8_WAIT_L
#undef PG8_BAR
#undef PG8_SCHED
}
}
using pg8::Unit;
typedef f32x4 AccT[2][2][4][2];

struct Args { const float* in[28]; float* out; unsigned char* ws; int ph_lo, ph_hi, pad0, pad1; };
struct Frame {
    LAS unsigned char* lds;
    int tid, lane, wave, G, bid;
    const struct Args* a;
    unsigned char* ws; unsigned char* outb;
};
template <int RB = 2048> struct SchedPlainT {
    pg8::StaticOrder o; const char* A; const char* Bt;
    __device__ __forceinline__ bool next(int i, Unit& u) const { return o.next(i, u); }
    __device__ __forceinline__ const char* a_base(const Unit& u) const { return A + (size_t)u.pm * (256 * RB); }
    __device__ __forceinline__ const char* b_base(const Unit& u) const { return Bt + (size_t)u.pn * (256 * RB); }
    __device__ __forceinline__ void a_offs(const Unit&, const int*, const int*, unsigned (&)[2], unsigned (&)[2]) const {}
};
typedef SchedPlainT<2048> SchedPlain;
template <int MODE> struct SchedProj {
    pg8::StaticOrder o; const char* A; const char* Bt; int fold = 0x7fffffff; unsigned* dbgw = nullptr;
    static constexpr int RB = MODE == 2 ? 1024 : 2048;
    __device__ __forceinline__ bool next(int i, Unit& u) const { if (!o.next(i, u)) return false; const int r = u.pn;
        if (MODE == 1) u.pn = 4 + r;
        if (MODE == 2) u.pn = r < 4 ? r : 15 + r;
        return true; }
    __device__ __forceinline__ const char* a_base(const Unit& u) const { return A + (size_t)(DBG_DRYPROJ ? (u.pm & fold) : u.pm) * (256 * RB); }
    __device__ __forceinline__ const char* b_base(const Unit& u) const { return Bt + (size_t)u.pn * (256 * RB); }
    __device__ __forceinline__ void a_offs(const Unit&, const int*, const int*, unsigned (&)[2], unsigned (&)[2]) const {}
};

struct EpiProj {
    static constexpr bool PERM = true;
    bf16_t *Q, *IQ, *Z, *XBC, *GA, *GB; float* MISC; float sc; int dry = 0;
    __device__ __forceinline__ void operator()(const AccT& acc, const Unit& u, int wr, int wc, int fr, int fq) const {
        const int pn = u.pn, row0 = u.pm * 256 + wr * 64 + fr, c8 = wc * 32 + 8 * fq;
        if (pn == 6) {
#pragma unroll
            for (int ai = 0; ai < 2; ++ai)
#pragma unroll
                for (int m = 0; m < 4; ++m) { float* rp = MISC + (size_t)(row0 + ai * 128 + m * 16) * 256 + c8;
#pragma unroll
                    for (int bj = 0; bj < 2; ++bj) { if (DBG_DRYPROJ && dry && acc[ai][bj][m][0][0] != 1.2345e-33f) continue; *(f32x4*)(rp + bj * 128) = acc[ai][bj][m][0]; *(f32x4*)(rp + bj * 128 + 4) = acc[ai][bj][m][1]; } }
            return;
        }
        bf16_t* base; int ldc, colt, act = 0;
        if (pn < 4) { base = Q; ldc = 1024; colt = pn * 256; }
        else if (pn < 6) { base = IQ; ldc = 512; colt = (pn - 4) * 256; }
        else if (pn < 11) { base = Z; ldc = 1024; colt = (pn - 7) * 256; act = 1; }
        else if (pn < 19) { base = XBC; ldc = 2048; colt = (pn - 11) * 256; }
        else if (pn < 23) { base = GA; ldc = 1024; colt = (pn - 19) * 256; act = 2; }
        else { base = GB; ldc = 1024; colt = (pn - 23) * 256; act = 2; }
#pragma unroll
        for (int ai = 0; ai < 2; ++ai)
#pragma unroll
            for (int m = 0; m < 4; ++m) { bf16_t* rp = base + (size_t)(row0 + ai * 128 + m * 16) * ldc + colt + c8;
#pragma unroll
                for (int bj = 0; bj < 2; ++bj) { f32x4 v0 = acc[ai][bj][m][0] * sc, v1 = acc[ai][bj][m][1] * sc;
                    if (act == 1) {
#pragma unroll
                        for (int j = 0; j < 4; ++j) { v0[j] = silu_f(v0[j]); v1[j] = silu_f(v1[j]); } }
                    if (act == 2) {
#pragma unroll
                        for (int j = 0; j < 4; ++j) { v0[j] = sigmoid_f(v0[j]); v1[j] = sigmoid_f(v1[j]); } }
                    if (GATE_U8 && act == 2) {
                        unsigned lo = 0u, hi = 0u;
#pragma unroll
                        for (int j = 0; j < 4; ++j) { lo = __builtin_amdgcn_cvt_pk_u8_f32(__builtin_rintf(v0[j] * 255.f), j, lo); hi = __builtin_amdgcn_cvt_pk_u8_f32(__builtin_rintf(v1[j] * 255.f), j, hi); }
                        u32x2 q; q.x = lo; q.y = hi;
                        *(u32x2*)((unsigned char*)base + (size_t)(row0 + ai * 128 + m * 16) * 1024 + colt + c8 + bj * 128) = q; continue; }
                    u32x4 pk = pack8(v0, v1); if (DBG_IQ_TRUNC && (pn == 4 || pn == 5)) { pk.x &= 0xfff8fff8u; pk.y &= 0xfff8fff8u; pk.z &= 0xfff8fff8u; pk.w &= 0xfff8fff8u; }
                    if (DBG_DRYPROJ && dry && pk.x != 0x7fc17fc3u) continue;
                    *(u32x4*)(rp + bj * 128) = pk; } }
    }
};
template <int MODE> struct EpiGate {
    static constexpr bool PERM = true;
    const bf16_t* Gt; const bf16_t* T; bf16_t* O; float sc;
    __device__ __forceinline__ void operator()(const AccT& acc, const Unit& u, int wr, int wc, int fr, int fq) const {
        const int row0 = u.pm * 256 + wr * 64 + fr, c8 = u.pn * 256 + wc * 32 + 8 * fq;
#pragma unroll
        for (int ai = 0; ai < 2; ++ai) {
            u32x4 gq[4][2], tq[4][2]; u32x2 g8[4][2];
#pragma unroll
            for (int m = 0; m < 4; ++m) { const size_t off = (size_t)(row0 + ai * 128 + m * 16) * 1024 + c8;
#pragma unroll
                for (int bj = 0; bj < 2; ++bj) { if (GATE_U8) g8[m][bj] = *(const u32x2*)((const unsigned char*)Gt + off + bj * 128); else gq[m][bj] = *(const u32x4*)(Gt + off + bj * 128);
                    if (MODE == 1) tq[m][bj] = *(const u32x4*)(T + off + bj * 128); } }
            SBAR();
#pragma unroll
            for (int m = 0; m < 4; ++m) { const size_t off = (size_t)(row0 + ai * 128 + m * 16) * 1024 + c8;
#pragma unroll
                for (int bj = 0; bj < 2; ++bj) { f32x4 g0, g1;
                    if (GATE_U8) { const unsigned a = g8[m][bj].x, b = g8[m][bj].y; constexpr float q = 1.f / 255.f;
                        g0 = (f32x4){(float)(a & 255u), (float)((a >> 8) & 255u), (float)((a >> 16) & 255u), (float)(a >> 24)} * q;
                        g1 = (f32x4){(float)(b & 255u), (float)((b >> 8) & 255u), (float)((b >> 16) & 255u), (float)(b >> 24)} * q; }
                    else unpack8(gq[m][bj], g0, g1);
                    f32x4 v0 = g0 * (acc[ai][bj][m][0] * sc), v1 = g1 * (acc[ai][bj][m][1] * sc);
                    if ((MODE == 0 && DBG_NO_ATTN) || (MODE == 1 && DBG_NO_SSD)) { v0 = (f32x4){0.f, 0.f, 0.f, 0.f}; v1 = v0; }
                    if (MODE == 1) { f32x4 t0, t1; unpack8(tq[m][bj], t0, t1); v0 += t0; v1 += t1; }
                    *(u32x4*)(O + off + bj * 128) = pack8(v0, v1); } }
            SBAR();
        }
    }
};
struct EpiOut {
    static constexpr bool PERM = true;
    const float* x; const float* mod; bf16_t* V;
    __device__ __forceinline__ void operator()(const AccT& acc, const Unit& u, int wr, int wc, int fr, int fq) const {
        const int row0 = u.pm * 256 + wr * 64 + fr, c8 = u.pn * 256 + wc * 32 + 8 * fq;
        const float* g1 = mod + (size_t)(u.pm >> 3) * 6144 + 2048 + c8;
        f32x4 gv[2][2];
#pragma unroll
        for (int bj = 0; bj < 2; ++bj)
#pragma unroll
            for (int n = 0; n < 2; ++n) gv[bj][n] = *(const f32x4*)(g1 + bj * 128 + n * 4);
#pragma unroll
        for (int ai = 0; ai < 2; ++ai)
#pragma unroll
            for (int mp = 0; mp < 2; ++mp) {
                f32x4 xv[2][2][2];
#pragma unroll
                for (int mm = 0; mm < 2; ++mm) { const size_t off = (size_t)(row0 + ai * 128 + (2 * mp + mm) * 16) * 1024 + c8;
#pragma unroll
                    for (int bj = 0; bj < 2; ++bj)
#pragma unroll
                        for (int n = 0; n < 2; ++n) xv[mm][bj][n] = *(const f32x4*)(x + off + bj * 128 + n * 4); }
                SBAR();
#pragma unroll
                for (int mm = 0; mm < 2; ++mm) { const int m = 2 * mp + mm; const size_t off = (size_t)(row0 + ai * 128 + m * 16) * 1024 + c8;
#pragma unroll
                    for (int bj = 0; bj < 2; ++bj)
                        *(u32x4*)(V + off + bj * 128) = pack8(xv[mm][bj][0] * DN_ALPHA + gv[bj][0] * acc[ai][bj][m][0], xv[mm][bj][1] * DN_ALPHA + gv[bj][1] * acc[ai][bj][m][1]); }
                SBAR();
            }
    }
};

struct MoeTab { LAS unsigned* cnt; LAS unsigned* tb; LAS unsigned char* te; int ntiles; };
__device__ __forceinline__ MoeTab moe_tables(Frame& F, int hf) {
    MoeTab T; T.cnt = (LAS unsigned*)(F.lds + LDS_AUX); T.tb = (LAS unsigned*)(F.lds + LDS_AUX + 256); T.te = (LAS unsigned char*)(F.lds + LDS_AUX + 512);
    const unsigned* CNT = (const unsigned*)(F.ws + WS_CTL) + CW_CNT;
    __syncthreads();
    if (F.tid < 32) { unsigned c = __hip_atomic_load(CNT + 64 * (hf * 32 + F.tid), __ATOMIC_RELAXED, __HIP_MEMORY_SCOPE_AGENT); if (c > (unsigned)REG_CAP) c = REG_CAP; T.cnt[F.tid] = c; }
    __syncthreads();
    if (F.tid == 0) { unsigned s = 0;
#pragma nounroll
        for (int e = 0; e < 32; ++e) { T.tb[e] = s; const unsigned n = (T.cnt[e] + 255u) >> 8;
#pragma nounroll
            for (unsigned t = 0; t < n; ++t) T.te[s + t] = (unsigned char)e;
            s += n; }
        T.tb[32] = s; }
    __syncthreads();
    T.ntiles = __builtin_amdgcn_readfirstlane((int)T.tb[32]);
    return T;
}
template <int NJ, bool GATHER> struct SchedMoe {
    MoeTab T; int G, c, hf; const char* A; const char* Bt; const u32x2* REG;
    __device__ __forceinline__ bool next(int i, Unit& u) const {
        int tile, j;
        if (G == 256) { const int x = c & 7, sl = c >> 3;
            tile = i * (256 / NJ) + x * (32 / NJ) + sl / NJ; j = sl % NJ;
            if (tile >= T.ntiles) return false; }
        else { const int L = i * G + c; if (L >= T.ntiles * NJ) return false; tile = L / NJ; j = L % NJ; }
        u.pm = tile; u.pn = j; u.ex = __builtin_amdgcn_readfirstlane((int)T.te[u.pm]); return true;
    }
    __device__ __forceinline__ const char* a_base(const Unit& u) const { return GATHER ? A : A + (size_t)u.pm * (256 * MOE_RB); }
    __device__ __forceinline__ const char* b_base(const Unit& u) const { return Bt + ((size_t)u.ex * (NJ * 256) + (size_t)u.pn * 256) * MOE_RB; }
    __device__ __forceinline__ void a_offs(const Unit& u, const int* R, const int* C, unsigned (&o0)[2], unsigned (&o1)[2]) const {
        const unsigned cnt = __builtin_amdgcn_readfirstlane(T.cnt[u.ex]), pos0 = ((unsigned)u.pm - (unsigned)__builtin_amdgcn_readfirstlane(T.tb[u.ex])) * 256u; const u32x2* rg = REG + ((size_t)hf * 32 + u.ex) * REG_CAP;
#pragma unroll
        for (int i = 0; i < 2; ++i) {
            const unsigned p0 = pos0 + (unsigned)R[i], p1 = p0 + 128u;
            unsigned t0 = 0u, t1 = 0u;
            if (p0 < cnt) t0 = (unsigned)hf * HALF_TOK + (rg[p0].x >> 2);
            if (p1 < cnt) t1 = (unsigned)hf * HALF_TOK + (rg[p1].x >> 2);
            o0[i] = t0 * (unsigned)MOE_RB + (unsigned)C[i] * 2u; o1[i] = t1 * (unsigned)MOE_RB + (unsigned)C[i] * 2u;
        }
    }
};
struct EpiMoe1 {
    static constexpr bool PERM = true;
    const float* b1; bf16_t* ACT; int dry;
    __device__ __forceinline__ void operator()(const AccT& acc, const Unit& u, int wr, int wc, int fr, int fq) const {
        if (dry) { if (acc[0][0][0][0][0] == 1.2345e-33f) ACT[0] = 1; return; }
        const int row0 = u.pm * 256 + wr * 64 + fr, c8 = u.pn * 128 + wc * 32 + 8 * fq;
        const float* bg = b1 + (size_t)u.ex * 2048 + c8;
        const f32x4 bg0 = *(const f32x4*)bg, bg1 = *(const f32x4*)(bg + 4), bu0 = *(const f32x4*)(bg + 1024), bu1 = *(const f32x4*)(bg + 1028);
#pragma unroll
        for (int ai = 0; ai < 2; ++ai)
#pragma unroll
            for (int m = 0; m < 4; ++m) {
                f32x4 g0 = acc[ai][0][m][0] * MOE_INV + bg0, g1 = acc[ai][0][m][1] * MOE_INV + bg1, u0 = acc[ai][1][m][0] * MOE_INV + bu0, u1 = acc[ai][1][m][1] * MOE_INV + bu1, a0, a1;
#pragma unroll
                for (int j = 0; j < 4; ++j) {
                    float g = fminf(g0[j], 7.0f), up = fminf(fmaxf(u0[j], -7.0f), 7.0f); a0[j] = (up + 1.0f) * g * sigmoid_f(1.702f * g);
                    g = fminf(g1[j], 7.0f); up = fminf(fmaxf(u1[j], -7.0f), 7.0f); a1[j] = (up + 1.0f) * g * sigmoid_f(1.702f * g); }
                if (MOE_FP8) *(u32x2*)((unsigned char*)ACT + (size_t)(row0 + ai * 128 + m * 16) * 1024 + c8) = pack8_fp8(a0, a1);
                else *(u32x4*)(ACT + (size_t)(row0 + ai * 128 + m * 16) * 1024 + c8) = pack8(a0, a1); }
    }
};
struct EpiMoe2 {
    static constexpr bool PERM = true;
    const float* b2; bf16_t* YB; const u32x2* REG; MoeTab T; int hf; int dry;
    __device__ __forceinline__ void operator()(const AccT& acc, const Unit& u, int wr, int wc, int fr, int fq) const {
        if (dry == 1) { if (acc[0][0][0][0][0] == 1.2345e-33f) YB[0] = 1; return; }
        if (dry >= 2) {
            const int c8d = (dry == 3 ? 0 : u.pn * 256) + wc * 32 + 8 * fq; const unsigned rowd = dry == 3 ? (blockIdx.x * 256u + (unsigned)(wr * 64 + fr)) : ((unsigned)u.pm * 256u + (unsigned)(wr * 64 + fr)) % 131072u;
#pragma unroll
            for (int ai = 0; ai < 2; ++ai)
#pragma unroll
                for (int m = 0; m < 4; ++m) { bf16_t* rp = YB + (size_t)((rowd + ai * 128 + m * 16) % 131072u) * 1024 + c8d;
#pragma unroll
                    for (int bj = 0; bj < 2; ++bj) *(u32x4*)(rp + bj * 128) = pack8(acc[ai][bj][m][0] * MOE_INV, acc[ai][bj][m][1] * MOE_INV); }
            return; }
        const int c8 = u.pn * 256 + wc * 32 + 8 * fq;
        const unsigned cnt = __builtin_amdgcn_readfirstlane(T.cnt[u.ex]), pos0 = ((unsigned)u.pm - (unsigned)__builtin_amdgcn_readfirstlane(T.tb[u.ex])) * 256u + (unsigned)(wr * 64 + fr); const u32x2* rg = REG + ((size_t)hf * 32 + u.ex) * REG_CAP;
        const float* bb = b2 + (size_t)u.ex * 1024 + c8;
        f32x4 bv[2][2];
#pragma unroll
        for (int bj = 0; bj < 2; ++bj) { bv[bj][0] = *(const f32x4*)(bb + bj * 128); bv[bj][1] = *(const f32x4*)(bb + bj * 128 + 4); }
        u32x2 en8[2][4];
#pragma unroll
        for (int ai = 0; ai < 2; ++ai)
#pragma unroll
            for (int m = 0; m < 4; ++m) { const unsigned p = pos0 + (unsigned)(ai * 128 + m * 16); en8[ai][m] = rg[p < cnt ? p : cnt - 1u]; }
#pragma unroll
        for (int ai = 0; ai < 2; ++ai)
#pragma unroll
            for (int m = 0; m < 4; ++m) { const unsigned p = pos0 + (unsigned)(ai * 128 + m * 16);
                const u32x2 en = en8[ai][m]; const float g = __uint_as_float(en.y); const unsigned drow = p < cnt ? en.x : (unsigned)(HALF_TOK * 4);
                bf16_t* rp = YB + (size_t)drow * 1024 + c8;
#pragma unroll
                for (int bj = 0; bj < 2; ++bj) *(u32x4*)(rp + bj * 128) = pack8((acc[ai][bj][m][0] * MOE_INV + bv[bj][0]) * g, (acc[ai][bj][m][1] * MOE_INV + bv[bj][1]) * g); }
    }
};

struct MapIdent { __device__ __forceinline__ int operator()(int n) const { return n; } };
struct MapWin { __device__ __forceinline__ int operator()(int n) const {
    if (n < 1024) return n;
    if (n < 1536) return 1152 + (n - 1024);
    if (n < 1792) { const int c = n - 1536; if (c < 128) return 1024 + c; if (c < 192) return 1664 + (c - 128); if (c < 200) return 1728 + (c - 192); if (c < 216) return 4808 + (c - 200); return -1; }
    if (n < 2816) return 1736 + (n - 1792);
    if (n < 4864) return 2760 + (n - 2816);
    if (n < 5888) return 4824 + (n - 4864);
    return 5848 + (n - 5888); } };
struct MapW1 { __device__ __forceinline__ int operator()(int r) const { const int j = r >> 8, rr = r & 255; return (rr >> 7) * 1024 + j * 128 + (rr & 127); } };
template <class Map, bool F8 = false> __device__ __forceinline__ void transpose_item(const float* W, int K, int N, bf16_t* WT, const Map& map, LAS float* scr, int kb, int nb, int lane, const float* rowscale) {
    const int k0 = 64 * kb, n0 = 64 * nb, q = lane & 15, kr = lane >> 4; const int src = map(n0 + 4 * q);
    f32x4 ld[16];
#pragma unroll
    for (int i = 0; i < 16; ++i) { const int kk = 4 * i + kr; ld[i] = (src >= 0) ? *(const f32x4*)(W + (size_t)(k0 + kk) * N + src) : (f32x4){0.f, 0.f, 0.f, 0.f}; }
#pragma unroll
    for (int i = 0; i < 16; ++i) { const int kk = 4 * i + kr; f32x4 v = ld[i]; if (rowscale) v = v * rowscale[k0 + kk]; LAS float* d = scr + kk * 65 + 4 * q; d[0] = v[0]; d[1] = v[1]; d[2] = v[2]; d[3] = v[3]; }
    LDS_WAIT(); asm volatile("" ::: "memory");
    const int c = lane & 7;
#pragma unroll
    for (int j = 0; j < 8; ++j) { const int n = (lane >> 3) + 8 * j; const LAS float* s = scr + (8 * c) * 65 + n;
        if constexpr (F8) { const f32x4 a = {s[0 * 65] * MOE_WSC, s[1 * 65] * MOE_WSC, s[2 * 65] * MOE_WSC, s[3 * 65] * MOE_WSC}, b = {s[4 * 65] * MOE_WSC, s[5 * 65] * MOE_WSC, s[6 * 65] * MOE_WSC, s[7 * 65] * MOE_WSC};
            *(u32x2*)((unsigned char*)WT + (size_t)(n0 + n) * K + k0 + 8 * c) = pack8_fp8(a, b); }
        else { u32x4 o; o.x = cvt_pk_bf16(s[0 * 65], s[1 * 65]); o.y = cvt_pk_bf16(s[2 * 65], s[3 * 65]); o.z = cvt_pk_bf16(s[4 * 65], s[5 * 65]); o.w = cvt_pk_bf16(s[6 * 65], s[7 * 65]);
            *(u32x4*)(WT + (size_t)(n0 + n) * K + k0 + 8 * c) = o; } }
    LDS_WAIT(); asm volatile("" ::: "memory");
}
struct TrItem { const float* W; const float* rowscale; unsigned char* WT; int N, src, k0, n0, f8; };
__device__ __forceinline__ TrItem tr_decode(Frame& F, int it) {
    constexpr int I_WIN = 16 * (NPROJ / 64), I_SQ = 16 * 16, I_W1E = 16 * 32, I_W2E = 16 * 16;
    TrItem d; d.rowscale = nullptr; int r = it, kb, nb; const int q4 = 4 * (F.lane & 15);
    if (r < (PROJ_FP8 ? 2 : 1) * I_WIN) { const int f8 = r >= I_WIN; if (f8) r -= I_WIN; kb = r / (NPROJ / 64); nb = r % (NPROJ / 64);
        d.W = F.a->in[4]; d.N = 6872; d.src = MapWin()(64 * nb + q4); d.WT = F.ws + (f8 ? WS_WIN8 : WS_WIN); d.f8 = f8; }
    else { r -= (PROJ_FP8 ? 2 : 1) * I_WIN;
        if (r < 3 * I_SQ) { const int w = r / I_SQ; r -= w * I_SQ; kb = r / 16; nb = r % 16; d.N = 1024; d.src = 64 * nb + q4;
            if (w == 0) { d.W = F.a->in[15]; d.WT = F.ws + (PA_FP8 ? WS_WPA8 : WS_WPA); d.f8 = PA_FP8; }
            else if (w == 1) { d.W = F.a->in[16]; d.WT = F.ws + (PB_FP8 ? WS_WPB8 : WS_WPB); d.f8 = PB_FP8; d.rowscale = F.a->in[14]; }
            else { d.W = F.a->in[17]; d.WT = F.ws + WS_WOUT; d.f8 = 0; } }
        else { r -= 3 * I_SQ;
            if (r < 32 * I_W1E) { const int e = r / I_W1E, q = r % I_W1E; kb = q / 32; nb = q % 32; d.W = F.a->in[22] + (size_t)e * 1024 * 2048; d.N = 2048; d.src = MapW1()(64 * nb + q4);
                d.WT = F.ws + WS_W1 + (size_t)e * 2048 * MOE_RB; d.f8 = MOE_FP8; }
            else { r -= 32 * I_W1E; const int e = r / I_W2E, q = r % I_W2E; kb = q / 16; nb = q % 16; d.W = F.a->in[24] + (size_t)e * 1024 * 1024; d.N = 1024; d.src = 64 * nb + q4;
                d.WT = F.ws + WS_W2 + (size_t)e * 1024 * MOE_RB; d.f8 = MOE_FP8; } } }
    d.k0 = 64 * kb; d.n0 = 64 * nb; return d; }
__device__ __forceinline__ void tr_load(const TrItem& d, f32x4 (&ld)[16], int lane) {
    const int kr = lane >> 4; const float* p = d.W + (size_t)(d.k0 + kr) * d.N + (d.src >= 0 ? d.src : 0);
#pragma unroll
    for (int i = 0; i < 16; ++i) ld[i] = __builtin_nontemporal_load((const f32x4*)(p + (size_t)(4 * i) * d.N)); }
__device__ __forceinline__ void tr_finish(const TrItem& d, f32x4 (&ld)[16], LAS float* scr, int lane) {
    const int q = lane & 15, kr = lane >> 4; const bool zero = d.src < 0;
#pragma unroll
    for (int i = 0; i < 16; ++i) { const int kk = 4 * i + kr; f32x4 v = ld[i]; if (zero) v = (f32x4){0.f, 0.f, 0.f, 0.f}; if (d.rowscale) v = v * d.rowscale[d.k0 + kk];
        LAS float* o = scr + kk * 65 + 4 * q; o[0] = v[0]; o[1] = v[1]; o[2] = v[2]; o[3] = v[3]; }
    LDS_WAIT(); asm volatile("" ::: "memory");
    const int c = lane & 7;
    if (d.f8) {
#pragma unroll
        for (int j = 0; j < 8; ++j) { const int n = (lane >> 3) + 8 * j; const LAS float* s = scr + (8 * c) * 65 + n;
            const f32x4 a = {s[0 * 65] * MOE_WSC, s[1 * 65] * MOE_WSC, s[2 * 65] * MOE_WSC, s[3 * 65] * MOE_WSC}, b = {s[4 * 65] * MOE_WSC, s[5 * 65] * MOE_WSC, s[6 * 65] * MOE_WSC, s[7 * 65] * MOE_WSC};
            *(u32x2*)((unsigned char*)d.WT + (size_t)(d.n0 + n) * 1024 + d.k0 + 8 * c) = pack8_fp8(a, b); } }
    else {
#pragma unroll
        for (int j = 0; j < 8; ++j) { const int n = (lane >> 3) + 8 * j; const LAS float* s = scr + (8 * c) * 65 + n;
            u32x4 o; o.x = cvt_pk_bf16(s[0 * 65], s[1 * 65]); o.y = cvt_pk_bf16(s[2 * 65], s[3 * 65]); o.z = cvt_pk_bf16(s[4 * 65], s[5 * 65]); o.w = cvt_pk_bf16(s[6 * 65], s[7 * 65]);
            *(u32x4*)((bf16_t*)d.WT + (size_t)(d.n0 + n) * 1024 + d.k0 + 8 * c) = o; } }
    LDS_WAIT(); asm volatile("" ::: "memory");
}
__device__ __forceinline__ void ph_prologue(Frame& F) {
    const float* c_in = F.a->in[1]; const float* w_mod = F.a->in[2]; const float* b_mod = F.a->in[3];
    float* MOD = (float*)(F.ws + WS_MOD);
    for (int item = F.bid; item < 192; item += F.G) {
        LAS float* SC = (LAS float*)F.lds;
        __syncthreads();
        for (int i = F.tid; i < 32768; i += NTHR) { const int b = i >> 10, k = i & 1023; SC[k * 36 + b] = silu_f(c_in[i]); }
        __syncthreads();
        const int col = item * 32 + (F.tid >> 4), kq = F.tid & 15;
        float a[32];
#pragma unroll
        for (int b = 0; b < 32; ++b) a[b] = 0.f;
#pragma nounroll
        for (int kg = 0; kg < 64; kg += 16) {
            float wv[16];
#pragma unroll
            for (int u = 0; u < 16; ++u) wv[u] = w_mod[(size_t)((kg + u) * 16 + kq) * 6144 + col];
#pragma unroll
            for (int u = 0; u < 16; ++u) { const int k = (kg + u) * 16 + kq; const float w = wv[u];
#pragma unroll
                for (int b4 = 0; b4 < 8; ++b4) { const f32x4 s = *(const LAS f32x4*)(SC + k * 36 + b4 * 4); a[b4 * 4 + 0] += w * s[0]; a[b4 * 4 + 1] += w * s[1]; a[b4 * 4 + 2] += w * s[2]; a[b4 * 4 + 3] += w * s[3]; } } }
#pragma unroll
        for (int b = 0; b < 32; ++b) { a[b] += __shfl_xor(a[b], 1); a[b] += __shfl_xor(a[b], 2); a[b] += __shfl_xor(a[b], 4); a[b] += __shfl_xor(a[b], 8); }
        { const float bm = b_mod[col];
#pragma unroll
            for (int b = 1; b < 16; ++b) { a[0] = (kq == b) ? a[b] : a[0]; a[16] = (kq == b) ? a[16 + b] : a[16]; }
            MOD[(size_t)kq * 6144 + col] = a[0] + bm; MOD[(size_t)(kq + 16) * 6144 + col] = a[16] + bm; }
        __syncthreads();
    }
    if (F.bid == (F.G > 192 ? 192 : 0)) {
        float* BT = (float*)(F.ws + WS_BIAST); const float* rel_bias = F.a->in[8];
        for (int i = F.tid; i < 249 * 8; i += NTHR) { const int idx = i >> 3, h = i & 7, rel = idx - 185; const int n = rel < 0 ? -rel : rel;
            const float nf = (float)(n > 1 ? n : 1); int large = 8 + (int)(logf(nf / 8.0f) / 2.7725887f * 8.0f); if (large > 15) large = 15;
            const int bucket = (rel > 0 ? 16 : 0) + (n < 8 ? n : large);
            BT[i] = rel_bias[bucket * 8 + h] * LOG2E; }
    }
    LAS float* scr = (LAS float*)(F.lds + F.wave * 16640);
    __syncthreads();
    const int gw = F.bid * NWAVES + F.wave, NGW = F.G * NWAVES;
    constexpr int I_WIN = 16 * (NPROJ / 64), I_SQ = 16 * 16, I_W1E = 16 * 32, I_W2E = 16 * 16;
    constexpr int NITEMS = (PROJ_FP8 ? 2 : 1) * I_WIN + 3 * I_SQ + 32 * I_W1E + 32 * I_W2E;
    TrItem d0, d1; f32x4 la[16], lb[16];
    int it = gw;
    if (it < NITEMS) { d0 = tr_decode(F, it); tr_load(d0, la, F.lane); }
    while (it < NITEMS) {
        const int i1 = it + NGW; const bool v1 = i1 < NITEMS;
        if (v1) { d1 = tr_decode(F, i1); tr_load(d1, lb, F.lane); }
        tr_finish(d0, la, scr, F.lane);
        if (!v1) break;
        const int i2 = i1 + NGW; const bool v2 = i2 < NITEMS;
        if (v2) { d0 = tr_decode(F, i2); tr_load(d0, la, F.lane); }
        tr_finish(d1, lb, scr, F.lane);
        it = i2;
    }
}

__device__ __forceinline__ void ln1_load(const float* x, int m0, int lane, f32x4 (&v)[4][4]) {
#pragma unroll
    for (int r = 0; r < 4; ++r) { const f32x4* xr = (const f32x4*)(x + (size_t)(m0 + r) * D) + lane;
#pragma unroll
        for (int j = 0; j < 4; ++j) v[r][j] = __builtin_nontemporal_load(xr + 64 * j); } }
__device__ __forceinline__ void ln1_proc(Frame& F, bf16_t* U, int m0, f32x4 (&v)[4][4], const f32x4 (&sh)[4], const f32x4 (&sc)[4]) {
#pragma unroll
    for (int r = 0; r < 4; ++r) { const int m = m0 + r;
        float s = 0.f;
#pragma unroll
        for (int j = 0; j < 4; ++j) s += (v[r][j][0] + v[r][j][1]) + (v[r][j][2] + v[r][j][3]);
        const float mean = wave_sum(s) * (1.f / D); float s2 = 0.f;
#pragma unroll
        for (int j = 0; j < 4; ++j) { v[r][j] = v[r][j] - mean; s2 += (v[r][j][0] * v[r][j][0] + v[r][j][1] * v[r][j][1]) + (v[r][j][2] * v[r][j][2] + v[r][j][3] * v[r][j][3]); }
        const float rstd = 1.f / sqrtf(wave_sum(s2) * (1.f / D) + LN_EPS);
        u32x2* o8 = (u32x2*)(U + (size_t)m * D) + F.lane;
#pragma unroll
        for (int j = 0; j < 4; ++j) {
            const f32x4 rr = v[r][j] * rstd * (sc[j] + 1.0f) + sh[j]; u32x2 w; w.x = cvt_pk_bf16(rr[0], rr[1]); w.y = cvt_pk_bf16(rr[2], rr[3]); o8[64 * j] = w;
            if (PROJ_FP8) { int pk = 0; pk = __builtin_amdgcn_cvt_pk_fp8_f32(rr[0], rr[1], pk, false); pk = __builtin_amdgcn_cvt_pk_fp8_f32(rr[2], rr[3], pk, true); ((unsigned*)(F.ws + WS_U8 + (size_t)m * D))[F.lane + 64 * j] = (unsigned)pk; } } } }
__device__ __forceinline__ void ph_ln1(Frame& F) {
    const float* x = F.a->in[0]; const float* MOD = (const float*)(F.ws + WS_MOD); bf16_t* U = (bf16_t*)(F.outb + OUT_U);
    const int gw = F.bid * NWAVES + F.wave, NGW = F.G * NWAVES;
    const int RPW = (((NTOK + NGW - 1) / NGW) + 3) & ~3;
    const int mbeg = gw * RPW, mend = (mbeg + RPW < NTOK) ? mbeg + RPW : NTOK;
    if (mbeg >= mend) return;
    f32x4 va[4][4], vb[4][4], sh[4], sc[4]; int curb = -1;
#define LN1_MOD(m0) do { const int bb = (m0) >> 11; if (bb != curb) { curb = bb; const float* md = MOD + (size_t)bb * 6144; \
        _Pragma("unroll") for (int j = 0; j < 4; ++j) { sh[j] = *((const f32x4*)md + F.lane + 64 * j); sc[j] = *((const f32x4*)(md + 1024) + F.lane + 64 * j); } } } while (0)
    int m0 = mbeg;
    ln1_load(x, m0, F.lane, va);
    for (;;) {
        const int m1 = m0 + 4; const bool v1 = m1 < mend;
        LN1_MOD(m0); if (v1) ln1_load(x, m1, F.lane, vb);
        ln1_proc(F, U, m0, va, sh, sc);
        if (!v1) break;
        const int m2 = m1 + 4; const bool v2 = m2 < mend;
        LN1_MOD(m1); if (v2) ln1_load(x, m2, F.lane, va);
        ln1_proc(F, U, m1, vb, sh, sc);
        if (!v2) break;
        m0 = m2;
    }
#undef LN1_MOD
}

__device__ __forceinline__ void misc_load(const float* MISC, int m0, int l, f32x4 (&v)[8]) {
#pragma unroll
    for (int r = 0; r < 8; ++r) v[r] = __builtin_nontemporal_load((const f32x4*)(MISC + (size_t)(m0 + r) * 256) + l); }
__device__ __forceinline__ void misc_proc(Frame& F, int m0, const f32x4 (&vv)[8], const f32x4& w1, const f32x4& w2) {
    bf16_t* KV = (bf16_t*)(F.outb + OUT_KV); bf16_t* IK = (bf16_t*)(F.outb + OUT_IK); float* IW = (float*)(F.outb + OUT_IW); float* DT = (float*)(F.outb + OUT_DT);
    const int l = F.lane;
#pragma unroll
    for (int r = 0; r < 8; ++r) { const int m = m0 + r;
        const f32x4 v = vv[r];
        const float sq = v[0] * v[0] + v[1] * v[1] + v[2] * v[2] + v[3] * v[3], sm = (v[0] + v[1]) + (v[2] + v[3]);
        const float kvss = wave_sum(l < 32 ? sq : 0.f);
        const float iks = wave_sum((l >= 32 && l < 48) ? sm : 0.f);
        const float ikmean = iks * (1.f / 64.f);
        const f32x4 dv = v - ikmean;
        const float ikq = wave_sum((l >= 32 && l < 48) ? (dv[0] * dv[0] + dv[1] * dv[1] + dv[2] * dv[2] + dv[3] * dv[3]) : 0.f);
        if (l < 32) { const float rr = 1.f / sqrtf(kvss * (1.f / 128.f) + LN_EPS); const f32x4 o = v * rr * w1;
            u32x2 pk; pk.x = cvt_pk_bf16(o[0], o[1]); pk.y = cvt_pk_bf16(o[2], o[3]); *((u32x2*)(KV + (size_t)m * 128) + l) = pk; }
        else if (l < 48) { const float rr = 1.f / sqrtf(ikq * (1.f / 64.f) + LN_EPS); const f32x4 o = dv * rr * w1 + w2;
            u32x2 pk; pk.x = cvt_pk_bf16(o[0], o[1]); pk.y = cvt_pk_bf16(o[2], o[3]); *((u32x2*)(IK + (size_t)m * 64) + (l - 32)) = pk; }
        else if (l < 50) { *((f32x4*)(IW + (size_t)m * 8) + (l - 48)) = v * 0.35355339059327373f; }
        else if (l < 54) { f32x4 o;
#pragma unroll
            for (int j = 0; j < 4; ++j) { const float t = v[j] + w1[j]; o[j] = t > 20.f ? t : log1pf(__expf(t)); }
            *((f32x4*)(DT + (size_t)m * 16) + (l - 50)) = o; }
    } }
__device__ __forceinline__ void ph_misc(Frame& F) {
    const float* MISC = (const float*)(F.outb + OUT_MISC);
    const float* kvw = F.a->in[5]; const float* ikw = F.a->in[6]; const float* ikb = F.a->in[7]; const float* dtb = F.a->in[11];
    const int gw = F.bid * NWAVES + F.wave, NGW = F.G * NWAVES, l = F.lane;
    const int RPW = (((NTOK + NGW - 1) / NGW) + 7) & ~7;
    const int mbeg = gw * RPW, mend = (mbeg + RPW < NTOK) ? mbeg + RPW : NTOK;
    if (mbeg >= mend) return;
    f32x4 w1 = (f32x4){0.f, 0.f, 0.f, 0.f}, w2 = w1;
    if (l < 32) w1 = *((const f32x4*)kvw + l); else if (l < 48) { w1 = *((const f32x4*)ikw + (l - 32)); w2 = *((const f32x4*)ikb + (l - 32)); } else if (l >= 50 && l < 54) w1 = *((const f32x4*)dtb + (l - 50));
    f32x4 va[8], vb[8];
    int m0 = mbeg;
    misc_load(MISC, m0, l, va);
    for (;;) {
        const int m1 = m0 + 8; const bool v1 = m1 < mend;
        if (v1) misc_load(MISC, m1, l, vb);
        misc_proc(F, m0, va, w1, w2);
        if (!v1) break;
        const int m2 = m1 + 8; const bool v2 = m2 < mend;
        if (v2) misc_load(MISC, m2, l, va);
        misc_proc(F, m1, vb, w1, w2);
        if (!v2) break;
        m0 = m2;
    }
}

__device__ __forceinline__ unsigned sortable_key(float s) { const unsigned u = __float_as_uint(s + 0.0f); return (u & 0x80000000u) ? ~u : (u | 0x80000000u); }
template <int NKB> struct KeyRow { unsigned k[NKB]; };
__device__ __forceinline__ u64 low_bits_keep(u64 m, int t) { u64 out = 0; while (t-- > 0 && m) { const u64 b = m & (0 - m); out |= b; m ^= b; } return out; }
namespace idx { constexpr int KST = 144, KBUF = 64 * KST; }
__device__ __forceinline__ unsigned low_bits_keep32(unsigned m, int t) { unsigned out = 0; while (t-- > 0 && m) { const unsigned b = m & (0u - m); out |= b; m ^= b; } return out; }
template <int NG> __device__ __forceinline__ void topk2_select_write(const unsigned (&key)[64], int nkb, u64* mrow, int lane) {
    constexpr int NR = NG * 16;
    unsigned T0 = 0u, T1 = 0u; bool ex0 = false, ex1 = false;
    unsigned lo0 = 0u, lo1 = 0u, hi0 = 0xFFFFFFFFu, hi1 = 0xFFFFFFFFu, st0, st1, p0, p1; bool fin0 = false, fin1 = false;
    { float sm = 0.f, sq = 0.f;
#pragma unroll
        for (int m = 0; m < 10; ++m) { const unsigned k = key[m]; const float f = __uint_as_float((k & 0x80000000u) ? (k ^ 0x80000000u) : ~k); sm += f; sq += f * f; }
        sm = dpp_half_sums_f32(sm); sq = dpp_half_sums_f32(sq);
        const float mu = sm * (1.f / 320.f), sd = sqrtf(fmaxf(sq * (1.f / 320.f) - mu * mu, 1e-20f));
        const float qq = 256.f / (64.f * (float)nkb), pp = qq < 0.5f ? qq : 1.f - qq, tt = sqrtf(-2.f * __logf(pp));
        float z = tt - (2.515517f + 0.802853f * tt + 0.010328f * tt * tt) / (1.f + 1.432788f * tt + 0.189269f * tt * tt + 0.001308f * tt * tt * tt); if (qq >= 0.5f) z = -z;
        const unsigned pe = sortable_key(mu + z * sd), pd = sortable_key(mu + z * sd + 0.125f * sd);
        unsigned stp = pd - pe; if (stp < 1024u) stp = 1024u;
        p0 = __builtin_amdgcn_readlane((int)pe, 31); p1 = __builtin_amdgcn_readlane((int)pe, 63); st0 = __builtin_amdgcn_readlane((int)stp, 31); st1 = __builtin_amdgcn_readlane((int)stp, 63); }
#pragma nounroll
    for (int it = 0; it < 80; ++it) {
        const unsigned candv = lane < 32 ? p0 : p1;
        unsigned cl = 0u;
#pragma unroll
        for (int m = 0; m < NR; m += 4) { u64 s0, s1, s2, s3;
            asm("v_cmp_ge_u32_e64 %1, %5, %9\n\tv_cmp_ge_u32_e64 %2, %6, %9\n\tv_cmp_ge_u32_e64 %3, %7, %9\n\tv_cmp_ge_u32_e64 %4, %8, %9\n\t"
                "v_addc_co_u32_e64 %0, %1, 0, %0, %1\n\tv_addc_co_u32_e64 %0, %2, 0, %0, %2\n\tv_addc_co_u32_e64 %0, %3, 0, %0, %3\n\tv_addc_co_u32_e64 %0, %4, 0, %0, %4"
                : "+v"(cl), "=&s"(s0), "=&s"(s1), "=&s"(s2), "=&s"(s3) : "v"(key[m]), "v"(key[m + 1]), "v"(key[m + 2]), "v"(key[m + 3]), "v"(candv)); }
        cl = dpp_half_sums_u32(cl);
        const int n0 = __builtin_amdgcn_readlane((int)cl, 31), n1 = __builtin_amdgcn_readlane((int)cl, 63);
#define IDX_STEP(lo, hi, st, p, T, ex, fin, n) do { if (!fin) { \
            if (n == 256) { T = p; ex = true; fin = true; } \
            else { if (n > 256) lo = p; else hi = p; \
                if (hi - lo <= 1u) { T = lo; fin = true; } \
                else { unsigned c; if (hi == 0xFFFFFFFFu) { c = lo + st; if (c < lo) c = hi; st = st << 1; } else if (lo == 0u) { c = hi - st; if (c > hi) c = lo; st = st << 1; } else c = lo + ((hi - lo) >> 1); \
                    if (c <= lo || c >= hi) c = lo + ((hi - lo) >> 1); p = c; } } } } while (0)
        IDX_STEP(lo0, hi0, st0, p0, T0, ex0, fin0, n0);
        IDX_STEP(lo1, hi1, st1, p1, T1, ex1, fin1, n1);
#undef IDX_STEP
        if (fin0 && fin1) break;
    }
    const unsigned Tv = lane < 32 ? T0 : T1;
    if (ex0 && ex1) {
        unsigned mlo = 0u, mhi = 0u;
#pragma unroll
        for (int j = 0; j < NR / 2; ++j) {
            const u64 b0 = __ballot(key[2 * j] >= Tv), b1 = __ballot(key[2 * j + 1] >= Tv);
            asm volatile("s_nop 1\n\tv_writelane_b32 %0, %2, %6\n\tv_writelane_b32 %0, %3, %7\n\tv_writelane_b32 %1, %4, %6\n\tv_writelane_b32 %1, %5, %7"
                         : "+v"(mlo), "+v"(mhi) : "s"((unsigned)b0), "s"((unsigned)(b0 >> 32)), "s"((unsigned)b1), "s"((unsigned)(b1 >> 32)), "n"(j), "n"(32 + j));
            if ((j & 3) == 3) SBAR();
        }
        const int jl = lane & 31;
        if (jl < nkb) mrow[(lane >> 5) * 32 + jl] = (u64)mlo | ((u64)mhi << 32);
        return;
    }
    int rem0 = 1 << 30, rem1 = 1 << 30;
    { int g0 = 0, g1 = 0;
#pragma unroll
        for (int m = 0; m < NR; ++m) { const u64 mk = __ballot(key[m] > Tv); g0 += __builtin_popcount((unsigned)mk); g1 += __builtin_popcount((unsigned)(mk >> 32)); if ((m & 7) == 7) SBAR(); }
        if (!ex0) rem0 = 256 - g0; if (!ex1) rem1 = 256 - g1; }
    u64 mine = 0ull;
#pragma nounroll
    for (int jq = 0; jq < NR / 8; ++jq) {
#pragma unroll
        for (int jj = 0; jj < 4; ++jj) { const int j = jq * 4 + jj;
            unsigned w0[2], w1[2];
#pragma unroll
            for (int hh = 0; hh < 2; ++hh) { unsigned kv = 0u;
#pragma unroll
                for (int m = 0; m < NR; ++m) if ((m >> 3) == 0) {}
#pragma unroll
                for (int m = 0; m < NR; ++m) kv = (m == 2 * j + hh) ? key[m] : kv;
                const u64 gt = __ballot(kv > Tv), eq = __ballot(kv == Tv);
                { const unsigned e = (unsigned)eq, g = (unsigned)gt; const int ne = __builtin_popcount(e); unsigned sel = g; if (rem0 >= ne) { sel |= e; rem0 -= ne; } else if (rem0 > 0) { sel |= low_bits_keep32(e, rem0); rem0 = 0; } w0[hh] = sel; }
                { const unsigned e = (unsigned)(eq >> 32), g = (unsigned)(gt >> 32); const int ne = __builtin_popcount(e); unsigned sel = g; if (rem1 >= ne) { sel |= e; rem1 -= ne; } else if (rem1 > 0) { sel |= low_bits_keep32(e, rem1); rem1 = 0; } w1[hh] = sel; } }
            const u64 q0w = (u64)w0[0] | ((u64)w0[1] << 32), q1w = (u64)w1[0] | ((u64)w1[1] << 32);
            if (lane == j) mine = q0w; if (lane == 32 + j) mine = q1w; }
    }
    const int jl = lane & 31;
    if (jl < nkb) mrow[(lane >> 5) * 32 + jl] = mine;
}
template <int J0> __device__ __forceinline__ void index_scores8(unsigned (&key)[64], const bf16x8 (&af)[2], const f32x4& iw4, const bf16_t* kvsrc, char* lds, int nkb, u32x4 (&stg)[8], int tid) {
    const int lane = tid & 63, sub = lane & 15, kg = lane >> 4;
#pragma unroll
    for (int jj = 0; jj < 8; ++jj) {
        const int j = J0 + jj;
        if (j < nkb) {
            if (j + 1 < nkb) *(u32x4*)(lds + ((j + 1) & 1) * idx::KBUF + (tid >> 3) * idx::KST + (tid & 7) * 16) = stg[(jj + 1) & 7];
            if (j + 8 < nkb) stg[jj] = *(const u32x4*)(kvsrc + (size_t)(j + 8) * 64 * 64);
            const char* kb = lds + (j & 1) * idx::KBUF + sub * idx::KST + kg * 16;
#pragma unroll
            for (int pr = 0; pr < 2; ++pr) {
                f32x4 dA = (f32x4){0.f, 0.f, 0.f, 0.f}, dB = dA;
#pragma unroll
                for (int ks = 0; ks < 2; ++ks) {
                    const bf16x8 fA = *(const bf16x8*)(kb + (pr * 32) * idx::KST + ks * 64), fB = *(const bf16x8*)(kb + (pr * 32 + 16) * idx::KST + ks * 64);
                    dA = __builtin_amdgcn_mfma_f32_16x16x32_bf16(af[ks], fA, dA, 0, 0, 0); dB = __builtin_amdgcn_mfma_f32_16x16x32_bf16(af[ks], fB, dB, 0, 0, 0); }
                float pA = 0.f, pB = 0.f;
#pragma unroll
                for (int r = 0; r < 4; ++r) { pA += fmaxf(dA[r], 0.f) * iw4[r]; pB += fmaxf(dB[r], 0.f) * iw4[r]; }
                auto rr = __builtin_amdgcn_permlane16_swap(__float_as_uint(pA), __float_as_uint(pB), false, false);
                key[2 * j + pr] = sortable_key(__uint_as_float(rr[0]) + __uint_as_float(rr[1]));
            }
            __syncthreads();
        }
    }
}
__device__ __forceinline__ void ph_index(Frame& F, const int abl = 0) {
    const bf16_t* IQ = (const bf16_t*)(F.outb + OUT_IQ); const bf16_t* IK = (const bf16_t*)(F.outb + OUT_IK); const float* IW = (const float*)(F.outb + OUT_IW);
    u64* MASK = (u64*)(F.outb + OUT_MASK);
    char* lds = (char*)(unsigned char*)F.lds;
    const int tid = F.tid, lane = F.lane, sub = lane & 15, kg = lane >> 4;
    for (int item = F.bid; item < NTOK / 16; item += F.G) {
        const int tokw = (((item & 255) >> 3) << 11) + (((item & 7) + 8 * (item >> 8)) << 4) + F.wave * 2, b = tokw >> 11, pos0 = tokw & 2047, nkb = (pos0 >> 6) + 1;
        u64* mrow = MASK + (size_t)tokw * 32;
        if (nkb <= 4) { if ((lane & 31) < nkb) mrow[(lane >> 5) * 32 + (lane & 31)] = ~0ull; continue; }
        bf16x8 af[2];
        { const bf16_t* ap = IQ + (size_t)(tokw + (sub >> 3)) * 512 + (sub & 7) * 64 + kg * 8;
#pragma unroll
          for (int ks = 0; ks < 2; ++ks) af[ks] = *(const bf16x8*)(ap + ks * 32); }
        const f32x4 iw4 = *(const f32x4*)(IW + (size_t)(tokw + (lane >> 5)) * 8 + 4 * (kg & 1));
        unsigned key[64];
#pragma unroll
        for (int m = 0; m < 64; ++m) key[m] = 0u;
        const bf16_t* kvsrc = IK + ((size_t)b * SEQ + (tid >> 3)) * 64 + (tid & 7) * 8;
        u32x4 stg[8];
#pragma unroll
        for (int i = 0; i < 8; ++i) stg[i] = (i < nkb) ? *(const u32x4*)(kvsrc + (size_t)i * 64 * 64) : (u32x4){0u, 0u, 0u, 0u};
        __syncthreads();
        *(u32x4*)(lds + (tid >> 3) * idx::KST + (tid & 7) * 16) = stg[0];
        __syncthreads();
        const int ng = (nkb + 7) >> 3;
        if (!(abl & 1)) {
        index_scores8<0>(key, af, iw4, kvsrc, lds, nkb, stg, tid);
        if (ng > 1) index_scores8<8>(key, af, iw4, kvsrc, lds, nkb, stg, tid);
        if (ng > 2) index_scores8<16>(key, af, iw4, kvsrc, lds, nkb, stg, tid);
        if (ng > 3) index_scores8<24>(key, af, iw4, kvsrc, lds, nkb, stg, tid);
        }
        if (abl & 2) { if (key[0] == 0x12345u && key[63] == 7u) mrow[lane] = 1ull; continue; }
        if (ng == 1) topk2_select_write<1>(key, nkb, mrow, lane);
        else if (ng == 2) topk2_select_write<2>(key, nkb, mrow, lane);
        else if (ng == 3) topk2_select_write<3>(key, nkb, mrow, lane);
        else topk2_select_write<4>(key, nkb, mrow, lane);
    }
}

namespace att {
constexpr int KVBLK = 64;
constexpr int SHM_V = KVBLK * 128 * 2, SHM_K = SHM_V;
constexpr int OFF_V = 0, OFF_K = 2 * SHM_V, OFF_WS = 2 * SHM_V + 2 * SHM_K, OFF_BT = OFF_WS + NWAVES * 64 * 4;
constexpr int OFF_OT = 81920, OT_ST = 144;
#define KSWZ(row, colB) ((row) * 256 + ((colB) ^ (((row) & 7) << 4)))
__device__ __forceinline__ int crow(int r, int hi) { return (r & 3) + 8 * (r >> 2) + 4 * hi; }
__device__ __forceinline__ int v_st(int k, int c) { const int kk = (k & ~0xC) | ((k & 4) << 1) | ((k & 8) >> 1); return ((kk >> 3) * 4 + (c >> 5)) * 512 + ((kk & 7) * 32 + (c & 31)) * 2; }
__device__ __forceinline__ int v_rd_base(int lane) { return ((lane & 3) << 3) | (((lane >> 2) & 3) << 6) | (((lane >> 4) & 1) << 5) | (((lane >> 5) & 1) << 8); }
constexpr int v_rd_off(int d0, int ks, int half) { return d0 * 512 + ks * 4096 + half * 2048; }
template <int OFF> __device__ __forceinline__ s16x4 tr_read(int vb) { s16x4 r; asm volatile("ds_read_b64_tr_b16 %0, %1 offset:%2" : "=&v"(r) : "v"(vb), "i"(OFF) : "memory"); return r; }
template <int D0> __device__ __forceinline__ void pv_one(f32x16& od, int vb, bf16x8 pa0, bf16x8 pa1, bf16x8 pa2, bf16x8 pa3) {
    const s16x4 l0 = tr_read<v_rd_off(D0, 0, 0)>(vb), h0 = tr_read<v_rd_off(D0, 0, 1)>(vb), l1 = tr_read<v_rd_off(D0, 1, 0)>(vb), h1 = tr_read<v_rd_off(D0, 1, 1)>(vb);
    const s16x4 l2 = tr_read<v_rd_off(D0, 2, 0)>(vb), h2 = tr_read<v_rd_off(D0, 2, 1)>(vb), l3 = tr_read<v_rd_off(D0, 3, 0)>(vb), h3 = tr_read<v_rd_off(D0, 3, 1)>(vb);
    asm volatile("s_waitcnt lgkmcnt(0)" ::: "memory"); SBAR();
#define PK(L, H) (bf16x8){L[0], L[1], L[2], L[3], H[0], H[1], H[2], H[3]}
    od = __builtin_amdgcn_mfma_f32_32x32x16_bf16(pa0, PK(l0, h0), od, 0, 0, 0);
    od = __builtin_amdgcn_mfma_f32_32x32x16_bf16(pa1, PK(l1, h1), od, 0, 0, 0);
    od = __builtin_amdgcn_mfma_f32_32x32x16_bf16(pa2, PK(l2, h2), od, 0, 0, 0);
    od = __builtin_amdgcn_mfma_f32_32x32x16_bf16(pa3, PK(l3, h3), od, 0, 0, 0);
#undef PK
}
__device__ __forceinline__ void qkt(f32x16& p0, f32x16& p1, const char* Ks, const bf16x8* qr, int r32, int hi) {
    p0 = f32x16{}; p1 = f32x16{};
    int rv = r32; asm volatile("" : "+v"(rv));
    const char* kb = Ks + rv * 256; const int swz = ((rv & 7) << 4) ^ (hi * 16);
#pragma unroll
    for (int d0 = 0; d0 < 8; ++d0) { const char* ka = kb + ((d0 * 32) ^ swz);
        const bf16x8 b0 = *reinterpret_cast<const bf16x8*>(ka);
        const bf16x8 b1 = *reinterpret_cast<const bf16x8*>(ka + 8192);
        p0 = __builtin_amdgcn_mfma_f32_32x32x16_bf16(b0, qr[d0], p0, 0, 0, 0);
        p1 = __builtin_amdgcn_mfma_f32_32x32x16_bf16(b1, qr[d0], p1, 0, 0, 0); }
}
__device__ __forceinline__ void attn_item(Frame& F, int b, int q0, char* lds) {
    const bf16_t* Q = (const bf16_t*)(F.ws + WS_Q); const bf16_t* KV = (const bf16_t*)(F.outb + OUT_KV); const u64* MASK = (const u64*)(F.outb + OUT_MASK);
    bf16_t* OA = (bf16_t*)(F.outb + OUT_OA);
    int tid = F.tid; asm volatile("" : "+v"(tid));
    const int wid = F.wave, lane = tid & 63, r32 = lane & 31, hi = lane >> 5;
    char* V_lds = lds + OFF_V; char* K_lds = lds + OFF_K;
    float* wsl = (float*)(lds + OFF_WS) + wid * 64; float* li_l = wsl; float* al_l = wsl + 32;
    const float* btab = (const float*)(lds + OFF_BT);
    constexpr float C = 0.088388347648318440f * LOG2E;
    float m_reg = -1e30f, l_reg = 0.f; f32x16 o[4] = {}; bf16x8 qr[8];
    const size_t tokq = (size_t)b * SEQ + q0 + r32;
    { const bf16_t* Qw = Q + tokq * 1024 + wid * 128 + hi * 8;
#pragma unroll
      for (int d0 = 0; d0 < 8; ++d0) qr[d0] = *(const bf16x8*)(Qw + d0 * 16); }
    const u64* mq = MASK + tokq * 32;
    const int sr = tid >> 4, sc = (tid & 15) * 8;
    const int vb0 = (int)(uintptr_t)V_lds + v_rd_base(lane);
    const bf16_t* Kb = KV + (size_t)b * SEQ * 128;
    const int NT = (q0 >> 6) + 1;
    const float bfar = btab[wid];
    bf16x8 s0, s1;
#define SLOAD(k0) do { s0 = *(const bf16x8*)(Kb + (size_t)((k0) + sr) * 128 + sc); s1 = *(const bf16x8*)(Kb + (size_t)((k0) + 32 + sr) * 128 + sc); } while (0)
#define SWRITE(bf) do { int srv = sr; asm volatile("" : "+v"(srv)); const int kc = sc * 2; const int v0a = v_st(srv, sc), k0a = KSWZ(srv, kc); \
        *(bf16x8*)(V_lds + (bf) * SHM_V + v0a) = s0; *(bf16x8*)(V_lds + (bf) * SHM_V + v0a + 8192) = s1; \
        *(bf16x8*)(K_lds + (bf) * SHM_K + k0a) = s0; *(bf16x8*)(K_lds + (bf) * SHM_K + k0a + 8192) = s1; } while (0)
    __syncthreads();
    SLOAD(0); VM_WAIT(); SWRITE(0); __syncthreads();
    u64 mw_next = mq[0];
    for (int j = 0; j < NT; ++j) {
        int lanel = lane; asm volatile("" : "+v"(lanel)); const int r32l = lanel & 31, hil = lanel >> 5;
        const int bf = j & 1;
        if (j + 1 < NT) SLOAD((j + 1) * KVBLK);
        const u64 mw = mw_next; if (j + 1 < NT) mw_next = mq[j + 1];
        f32x16 p0, p1;
        qkt(p0, p1, K_lds + bf * SHM_K, qr, r32l, hil);
        const unsigned w0 = (unsigned)(mw >> (4 * hil)), w1 = (unsigned)(mw >> (32 + 4 * hil));
        const int relmax = j * KVBLK + 63 - q0;
        float alpha = 1.f, ps = 0.f;
        if (relmax <= -91) {
            float pmax = p0[0];
#pragma unroll
            for (int r = 1; r < 16; ++r) pmax = fmaxf(pmax, p0[r]);
#pragma unroll
            for (int r = 0; r < 16; ++r) pmax = fmaxf(pmax, p1[r]);
            { auto rr = __builtin_amdgcn_permlane32_swap(__float_as_uint(pmax), __float_as_uint(pmax), false, false); pmax = fmaxf(__uint_as_float(rr[0]), __uint_as_float(rr[1])); }
            pmax = fmaf(pmax, C, bfar);
            if (!__all(pmax - m_reg <= 11.0f)) { const float mn = fmaxf(m_reg, pmax); alpha = __builtin_amdgcn_exp2f(m_reg - mn); m_reg = mn; }
            const float off = bfar - m_reg;
#pragma unroll
            for (int r = 0; r < 16; ++r) { const int cb = (r & 3) + 8 * (r >> 2);
                const float e0 = __builtin_amdgcn_exp2f(fmaf(p0[r], C, off)), e1 = __builtin_amdgcn_exp2f(fmaf(p1[r], C, off));
                p0[r] = __uint_as_float(__float_as_uint(e0) & (unsigned)__builtin_amdgcn_sbfe((int)w0, cb, 1)); p1[r] = __uint_as_float(__float_as_uint(e1) & (unsigned)__builtin_amdgcn_sbfe((int)w1, cb, 1)); ps += p0[r] + p1[r]; }
        } else {
            const float* bp = btab + (j * KVBLK + 4 * hil - (q0 + r32l) + 185) * 8 + wid;
#pragma unroll
            for (int r4 = 0; r4 < 4; ++r4) {
#pragma unroll
                for (int rr = 0; rr < 4; ++rr) { const int r = r4 * 4 + rr; const int cb = (r & 3) + 8 * (r >> 2); p0[r] = fmaf(p0[r], C, bp[cb * 8]); p1[r] = fmaf(p1[r], C, bp[(cb + 32) * 8]); }
                SBAR(); }
            float pmax = p0[0];
#pragma unroll
            for (int r = 1; r < 16; ++r) pmax = fmaxf(pmax, p0[r]);
#pragma unroll
            for (int r = 0; r < 16; ++r) pmax = fmaxf(pmax, p1[r]);
            { auto rr = __builtin_amdgcn_permlane32_swap(__float_as_uint(pmax), __float_as_uint(pmax), false, false); pmax = fmaxf(__uint_as_float(rr[0]), __uint_as_float(rr[1])); }
            if (!__all(pmax - m_reg <= 11.0f)) { const float mn = fmaxf(m_reg, pmax); alpha = __builtin_amdgcn_exp2f(m_reg - mn); m_reg = mn; }
#pragma unroll
            for (int r = 0; r < 16; ++r) { const int cb = (r & 3) + 8 * (r >> 2);
                const float e0 = __builtin_amdgcn_exp2f(p0[r] - m_reg), e1 = __builtin_amdgcn_exp2f(p1[r] - m_reg);
                p0[r] = __uint_as_float(__float_as_uint(e0) & (unsigned)__builtin_amdgcn_sbfe((int)w0, cb, 1)); p1[r] = __uint_as_float(__float_as_uint(e1) & (unsigned)__builtin_amdgcn_sbfe((int)w1, cb, 1)); ps += p0[r] + p1[r]; }
        }
        { auto rr = __builtin_amdgcn_permlane32_swap(__float_as_uint(ps), __float_as_uint(ps), false, false); ps = __uint_as_float(rr[0]) + __uint_as_float(rr[1]); }
        l_reg = l_reg * alpha + ps;
        bf16x8 pa0, pa1, pa2, pa3;
#define PK4(P, BASE, OUT) do { unsigned a0 = cvt_pk_bf16(P[BASE + 0], P[BASE + 1]), a1 = cvt_pk_bf16(P[BASE + 2], P[BASE + 3]);   \
    unsigned b0 = cvt_pk_bf16(P[BASE + 4], P[BASE + 5]), b1 = cvt_pk_bf16(P[BASE + 6], P[BASE + 7]);                              \
    auto r0 = __builtin_amdgcn_permlane32_swap(a0, b0, false, false); auto r1 = __builtin_amdgcn_permlane32_swap(a1, b1, false, false); \
    u32x4 w = {r0[0], r1[0], r0[1], r1[1]}; OUT = *reinterpret_cast<bf16x8*>(&w); } while (0)
        PK4(p0, 0, pa0); PK4(p0, 8, pa1); PK4(p1, 0, pa2); PK4(p1, 8, pa3);
#undef PK4
        if (__any(alpha < 1.f)) { if (hil == 0) al_l[r32l] = alpha; LDS_WAIT();
#pragma unroll
            for (int d = 0; d < 4; ++d)
#pragma unroll
                for (int r = 0; r < 16; ++r) o[d][r] *= al_l[crow(r, hil)]; }
        const int vb = (int)(uintptr_t)V_lds + v_rd_base(lanel) + bf * SHM_V;
        pv_one<0>(o[0], vb, pa0, pa1, pa2, pa3); pv_one<1>(o[1], vb, pa0, pa1, pa2, pa3); pv_one<2>(o[2], vb, pa0, pa1, pa2, pa3); pv_one<3>(o[3], vb, pa0, pa1, pa2, pa3);
        if (j + 1 < NT) { VM_WAIT(); SWRITE(bf ^ 1); }
        __syncthreads();
    }
#undef SLOAD
#undef SWRITE
    if (hi == 0) li_l[r32] = l_reg; LDS_WAIT();
    bf16_t* Ow = OA + ((size_t)b * SEQ + q0 + 4 * hi) * 1024 + wid * 128 + r32;
    const float* lip = li_l + 4 * hi;
    unsigned char* Ow8 = (unsigned char*)OA + ((size_t)b * SEQ + q0 + 4 * hi) * 1024 + wid * 128 + r32;
    asm volatile("" : "+v"(Ow), "+v"(lip), "+v"(Ow8));
#pragma unroll
    for (int r = 0; r < 16; ++r) { const int ro = (r & 3) + 8 * (r >> 2); if ((r & 3) == 0) asm volatile("" : "+v"(Ow), "+v"(Ow8), "+v"(lip)); const float rl = fast_rcp(lip[ro]);
#pragma unroll
        for (int d0 = 0; d0 < 4; ++d0) { float v = o[d0][r] * rl; if ((DBG_ATTN_ZERO == 1 && q0 < 256) || (DBG_ATTN_ZERO == 2 && q0 >= 256)) v = 0.f;
            if (PA_FP8) ((unsigned char*)Ow8)[ro * 1024 + d0 * 32] = (unsigned char)(__builtin_amdgcn_cvt_pk_fp8_f32(v, v, 0, false) & 0xff);
            else Ow[ro * 1024 + d0 * 32] = (bf16_t)(cvt_pk_bf16(v, v) & 0xffffu); }
        if ((r & 3) == 3) SBAR(); }
}
__device__ __forceinline__ void att2_partial(f32x16& p0, f32x16& p1, float& m_reg, float& alpha, unsigned w0, bool far, float bfar, const float* bp) {
    constexpr float C = 0.088388347648318440f * LOG2E;
    float off;
    if (far) {
        float pmax = p0[0];
#pragma unroll
        for (int r = 1; r < 16; ++r) pmax = fmaxf(pmax, p0[r]);
#pragma unroll
        for (int r = 0; r < 16; ++r) pmax = fmaxf(pmax, p1[r]);
        { auto rr = __builtin_amdgcn_permlane32_swap(__float_as_uint(pmax), __float_as_uint(pmax), false, false); pmax = fmaxf(__uint_as_float(rr[0]), __uint_as_float(rr[1])); }
        pmax = fmaf(pmax, C, bfar);
        if (__builtin_expect(__all(pmax - m_reg <= 11.0f), 1)) alpha = 1.f; else { const float mn = fmaxf(m_reg, pmax); alpha = __builtin_amdgcn_exp2f(m_reg - mn); m_reg = mn; }
        off = bfar - m_reg;
#pragma unroll
        for (int r = 0; r < 16; ++r) { p0[r] = fmaf(p0[r], C, off); p1[r] = fmaf(p1[r], C, off); }
    } else {
#pragma unroll
        for (int r4 = 0; r4 < 4; ++r4) {
#pragma unroll
            for (int rr = 0; rr < 4; ++rr) { const int r = r4 * 4 + rr; const int cb = (r & 3) + 8 * (r >> 2); p0[r] = fmaf(p0[r], C, bp[cb * 8]); p1[r] = fmaf(p1[r], C, bp[(cb + 32) * 8]); }
            SBAR(); }
        float pmax = p0[0];
#pragma unroll
        for (int r = 1; r < 16; ++r) pmax = fmaxf(pmax, p0[r]);
#pragma unroll
        for (int r = 0; r < 16; ++r) pmax = fmaxf(pmax, p1[r]);
        { auto rr = __builtin_amdgcn_permlane32_swap(__float_as_uint(pmax), __float_as_uint(pmax), false, false); pmax = fmaxf(__uint_as_float(rr[0]), __uint_as_float(rr[1])); }
        if (__builtin_expect(__all(pmax - m_reg <= 11.0f), 1)) alpha = 1.f; else { const float mn = fmaxf(m_reg, pmax); alpha = __builtin_amdgcn_exp2f(m_reg - mn); m_reg = mn; }
#pragma unroll
        for (int r = 0; r < 16; ++r) { p0[r] -= m_reg; p1[r] -= m_reg; }
    }
#define SELP(P, W, R, CB) { unsigned m_; asm("v_bfe_i32 %0, %1, " #CB ", 1" : "=v"(m_) : "v"(W)); P[R] = __uint_as_float(__float_as_uint(__builtin_amdgcn_exp2f(P[R])) & m_); }
    SELP(p0, w0, 0, 0) SELP(p0, w0, 1, 1) SELP(p0, w0, 2, 2) SELP(p0, w0, 3, 3) SELP(p0, w0, 4, 8) SELP(p0, w0, 5, 9) SELP(p0, w0, 6, 10) SELP(p0, w0, 7, 11)
    SELP(p0, w0, 8, 16) SELP(p0, w0, 9, 17) SELP(p0, w0, 10, 18) SELP(p0, w0, 11, 19) SELP(p0, w0, 12, 24) SELP(p0, w0, 13, 25) SELP(p0, w0, 14, 26) SELP(p0, w0, 15, 27)
}
__device__ __forceinline__ void att2_finish(f32x16& p0, f32x16& p1, float alpha, float& l_reg, unsigned w1, bf16x8& pa0, bf16x8& pa1, bf16x8& pa2, bf16x8& pa3) {
    SELP(p1, w1, 0, 0) SELP(p1, w1, 1, 1) SELP(p1, w1, 2, 2) SELP(p1, w1, 3, 3) SELP(p1, w1, 4, 8) SELP(p1, w1, 5, 9) SELP(p1, w1, 6, 10) SELP(p1, w1, 7, 11)
    SELP(p1, w1, 8, 16) SELP(p1, w1, 9, 17) SELP(p1, w1, 10, 18) SELP(p1, w1, 11, 19) SELP(p1, w1, 12, 24) SELP(p1, w1, 13, 25) SELP(p1, w1, 14, 26) SELP(p1, w1, 15, 27)
    float ps = 0.f;
#pragma unroll
    for (int r = 0; r < 16; ++r) ps += p0[r];
#pragma unroll
    for (int r = 0; r < 16; ++r) ps += p1[r];
    { auto rr = __builtin_amdgcn_permlane32_swap(__float_as_uint(ps), __float_as_uint(ps), false, false); ps = __uint_as_float(rr[0]) + __uint_as_float(rr[1]); }
    l_reg = l_reg * alpha + ps;
#define PK4(P, BASE, OUT) do { unsigned a0 = cvt_pk_bf16(P[BASE + 0], P[BASE + 1]), a1 = cvt_pk_bf16(P[BASE + 2], P[BASE + 3]);   \
    unsigned b0 = cvt_pk_bf16(P[BASE + 4], P[BASE + 5]), b1 = cvt_pk_bf16(P[BASE + 6], P[BASE + 7]);                              \
    auto r0 = __builtin_amdgcn_permlane32_swap(a0, b0, false, false); auto r1 = __builtin_amdgcn_permlane32_swap(a1, b1, false, false); \
    u32x4 w = {r0[0], r1[0], r0[1], r1[1]}; OUT = *reinterpret_cast<bf16x8*>(&w); } while (0)
    PK4(p0, 0, pa0); PK4(p0, 8, pa1); PK4(p1, 0, pa2); PK4(p1, 8, pa3);
#undef PK4
}
__device__ __forceinline__ void attn_item2(Frame& F, int b, int q0, char* lds) {
    const bf16_t* Q = (const bf16_t*)(F.ws + WS_Q); const bf16_t* KV = (const bf16_t*)(F.outb + OUT_KV); const u64* MASK = (const u64*)(F.outb + OUT_MASK);
    bf16_t* OA = (bf16_t*)(F.outb + OUT_OA);
    int tid = F.tid; asm volatile("" : "+v"(tid));
    const int wid = F.wave, lane = tid & 63, r32 = lane & 31, hi = lane >> 5;
    char* V_lds = lds + OFF_V; char* K_lds = lds + OFF_K;
    float* wsl = (float*)(lds + OFF_WS) + wid * 64; float* li_l = wsl; float* al_l = wsl + 32;
    const float* btab = (const float*)(lds + OFF_BT);
    float m_reg = -1e30f, l_reg = 0.f; f32x16 o[4] = {}; bf16x8 qr[8];
    const size_t tokq = (size_t)b * SEQ + q0 + r32;
    { const bf16_t* Qw = Q + tokq * 1024 + wid * 128 + hi * 8;
#pragma unroll
      for (int d0 = 0; d0 < 8; ++d0) qr[d0] = *(const bf16x8*)(Qw + d0 * 16); }
    const u64* mq = MASK + tokq * 32;
    const int sr = tid >> 4, sc = (tid & 15) * 8;
    const bf16_t* Kb = KV + (size_t)b * SEQ * 128;
    const int NTr = (q0 >> 6) + 1, NT = (NTr + 1) & ~1;
    const float bfar = btab[wid];
    bf16x8 sA0, sA1, sB0, sB1;
#define SLD(s0_, s1_, k0) do { int srl = sr; asm volatile("" : "+v"(srl)); const bf16_t* kp_ = Kb + (size_t)((k0) + srl) * 128 + sc; s0_ = *(const bf16x8*)kp_; s1_ = *(const bf16x8*)(kp_ + 32 * 128); } while (0)
#define SWR(bf, s0_, s1_) do { int srv = sr; asm volatile("" : "+v"(srv)); const int kc = sc * 2; const int v0a = v_st(srv, sc), k0a = KSWZ(srv, kc); \
        *(bf16x8*)(V_lds + (bf) * SHM_V + v0a) = s0_; *(bf16x8*)(V_lds + (bf) * SHM_V + v0a + 8192) = s1_; \
        *(bf16x8*)(K_lds + (bf) * SHM_K + k0a) = s0_; *(bf16x8*)(K_lds + (bf) * SHM_K + k0a + 8192) = s1_; } while (0)
#define MWORD(j) ((j) < NTr ? mq[j] : 0ull)
#define RESC(a) do { if (__any((a) < 1.f)) { if (hi == 0) al_l[r32] = (a); LDS_WAIT(); \
        _Pragma("unroll") for (int d = 0; d < 4; ++d) _Pragma("unroll") for (int r = 0; r < 16; ++r) o[d][r] *= al_l[crow(r, hi)]; } } while (0)
#define PVALL(bf) do { int ll = lane; asm volatile("" : "+v"(ll)); const int vb = (int)(uintptr_t)V_lds + v_rd_base(ll) + (bf) * SHM_V; \
        pv_one<0>(o[0], vb, pa0, pa1, pa2, pa3); pv_one<1>(o[1], vb, pa0, pa1, pa2, pa3); pv_one<2>(o[2], vb, pa0, pa1, pa2, pa3); pv_one<3>(o[3], vb, pa0, pa1, pa2, pa3); } while (0)
#define ISFAR(jt) ((jt) * KVBLK + 63 - q0 <= -91 || (jt) >= NTr)
#define BPTR(jt) (btab + ((jt) * KVBLK + 4 * hi - (q0 + r32) + 185) * 8 + wid)
    f32x16 pA0, pA1, pB0, pB1; float alA, alB; bf16x8 pa0, pa1, pa2, pa3; u64 mwA, mwB;
    __syncthreads();
    SLD(sA0, sA1, 0); mwA = MWORD(0); VM_WAIT(); SWR(0, sA0, sA1); __syncthreads();
    qkt(pA0, pA1, K_lds, qr, r32, hi);
    att2_partial(pA0, pA1, m_reg, alA, (unsigned)(mwA >> (4 * hi)), ISFAR(0), bfar, BPTR(0));
    SLD(sB0, sB1, KVBLK); mwB = MWORD(1); if (2 < NT) SLD(sA0, sA1, 2 * KVBLK);
    SWR(1, sB0, sB1); __syncthreads();
    for (int j = 1; j + 1 < NT; j += 2) {
        SBAR(); qkt(pB0, pB1, K_lds + SHM_K, qr, r32, hi);
        att2_finish(pA0, pA1, alA, l_reg, (unsigned)(mwA >> (32 + 4 * hi)), pa0, pa1, pa2, pa3); SBAR();
        SLD(sB0, sB1, (j + 2) * KVBLK); mwA = MWORD(j + 1); SBAR();
        PVALL(0);
        att2_partial(pB0, pB1, m_reg, alB, (unsigned)(mwB >> (4 * hi)), ISFAR(j), bfar, BPTR(j));
        __syncthreads(); SWR(0, sA0, sA1);
        RESC(alB); __syncthreads();
        SBAR(); qkt(pA0, pA1, K_lds, qr, r32, hi);
        att2_finish(pB0, pB1, alB, l_reg, (unsigned)(mwB >> (32 + 4 * hi)), pa0, pa1, pa2, pa3); SBAR();
        if (j + 3 < NT) SLD(sA0, sA1, (j + 3) * KVBLK); mwB = MWORD(j + 2); SBAR();
        PVALL(1);
        att2_partial(pA0, pA1, m_reg, alA, (unsigned)(mwA >> (4 * hi)), ISFAR(j + 1), bfar, BPTR(j + 1));
        __syncthreads(); SWR(1, sB0, sB1);
        RESC(alA); __syncthreads();
    }
    SBAR(); qkt(pB0, pB1, K_lds + SHM_K, qr, r32, hi);
    att2_finish(pA0, pA1, alA, l_reg, (unsigned)(mwA >> (32 + 4 * hi)), pa0, pa1, pa2, pa3); SBAR();
    PVALL(0);
    att2_partial(pB0, pB1, m_reg, alB, (unsigned)(mwB >> (4 * hi)), ISFAR(NT - 1), bfar, BPTR(NT - 1));
    __syncthreads(); RESC(alB);
    att2_finish(pB0, pB1, alB, l_reg, (unsigned)(mwB >> (32 + 4 * hi)), pa0, pa1, pa2, pa3); SBAR();
    PVALL(1);
#undef SLD
#undef SWR
#undef MWORD
#undef RESC
#undef PVALL
#undef ISFAR
#undef BPTR
    LAS float* li_s = (LAS float*)(F.lds + OFF_WS) + wid * 64;
    if (hi == 0) li_s[r32] = l_reg; LDS_WAIT();
    if (PA_FP8 && ATT_OT) {
        LAS unsigned char* ot = F.lds + OFF_OT + wid * (32 * OT_ST);
        int ob = (4 * hi) * OT_ST + r32, lo = 4 * hi; asm volatile("" : "+v"(ob), "+v"(lo));
#pragma unroll
        for (int r = 0; r < 16; ++r) { const int ro = (r & 3) + 8 * (r >> 2); if ((r & 3) == 0) asm volatile("" : "+v"(ob), "+v"(lo)); const float rl = fast_rcp(li_s[lo + ro]);
#pragma unroll
            for (int d0 = 0; d0 < 4; ++d0) { const float v = o[d0][r] * rl; ot[ob + ro * OT_ST + d0 * 32] = (unsigned char)(__builtin_amdgcn_cvt_pk_fp8_f32(v, v, 0, false) & 0xff); }
            if ((r & 3) == 3) SBAR(); }
        LDS_WAIT(); asm volatile("" ::: "memory");
        unsigned char* Og = (unsigned char*)OA + ((size_t)b * SEQ + q0) * 1024 + wid * 128;
        int rr = lane >> 3, sg = (lane & 7) * 16; asm volatile("" : "+v"(rr), "+v"(sg));
#pragma unroll
        for (int i = 0; i < 4; ++i) { const u32x4 w = *(const LAS u32x4*)(ot + (i * 8 + rr) * OT_ST + sg); *(u32x4*)(Og + (size_t)(i * 8 + rr) * 1024 + sg) = w; }
        LDS_WAIT();
    } else if (PA_FP8) {
        GAS unsigned char* Ow8 = (GAS unsigned char*)((unsigned char*)OA + ((size_t)b * SEQ + q0 + 4 * hi) * 1024 + wid * 128 + r32);
        int lo = 4 * hi; asm volatile("" : "+v"(Ow8), "+v"(lo));
#pragma unroll
        for (int r = 0; r < 16; ++r) { const int ro = (r & 3) + 8 * (r >> 2); if ((r & 3) == 0) asm volatile("" : "+v"(Ow8), "+v"(lo)); const float rl = fast_rcp(li_s[lo + ro]);
#pragma unroll
            for (int d0 = 0; d0 < 4; ++d0) { const float v = o[d0][r] * rl; Ow8[ro * 1024 + d0 * 32] = (unsigned char)(__builtin_amdgcn_cvt_pk_fp8_f32(v, v, 0, false) & 0xff); }
            if ((r & 3) == 3) SBAR(); }
    } else {
        bf16_t* Ow = OA + ((size_t)b * SEQ + q0 + 4 * hi) * 1024 + wid * 128 + r32;
        int lo = 4 * hi; asm volatile("" : "+v"(Ow), "+v"(lo));
#pragma unroll
        for (int r = 0; r < 16; ++r) { const int ro = (r & 3) + 8 * (r >> 2); if ((r & 3) == 0) asm volatile("" : "+v"(Ow), "+v"(lo)); const float rl = fast_rcp(li_s[lo + ro]);
#pragma unroll
            for (int d0 = 0; d0 < 4; ++d0) { const float v = o[d0][r] * rl; Ow[ro * 1024 + d0 * 32] = (bf16_t)(cvt_pk_bf16(v, v) & 0xffffu); }
            if ((r & 3) == 3) SBAR(); }
    }
}
}
__device__ __forceinline__ void ph_attn(Frame& F) {
    char* lds = (char*)(unsigned char*)F.lds;
    { float* bt = (float*)(lds + att::OFF_BT); const float* BT = (const float*)(F.ws + WS_BIAST); __syncthreads(); for (int i = F.tid; i < 249 * 8; i += NTHR) bt[i] = BT[i]; __syncthreads(); }
    for (int pr = F.bid; pr < NB * 32; pr += F.G) {
        const int b = pr >> 5, qb = pr & 31;
#pragma nounroll
        for (int hh = 0; hh < 2; ++hh) { if (ATT2) att::attn_item2(F, b, (hh ? qb : 63 - qb) * 32, lds); else att::attn_item(F, b, (hh ? qb : 63 - qb) * 32, lds); }
    }
}

namespace ssd {
constexpr int OFF_CS = 0, CS_ST = 272;
constexpr int OFF_BS = OFF_CS + 64 * CS_ST;
constexpr int OFF_BT = OFF_BS + 64 * CS_ST, T_ST = 144;
constexpr int OFF_XT = OFF_BT + 128 * T_ST;
constexpr int OFF_XW = OFF_XT + 64 * T_ST;
constexpr int OFF_XS = OFF_XW + 64 * T_ST;
constexpr int OFF_MT = OFF_XS + 64 * T_ST;
constexpr int OFF_HS = OFF_MT + 64 * T_ST;
constexpr int OFF_END = OFF_HS + 64 * CS_ST;
static_assert(OFF_END + 5 * 320 * 4 <= 131072, "ssd lds");
__device__ __forceinline__ f32x4 mfma16(bf16x8 a, bf16x8 b, f32x4 c) { return __builtin_amdgcn_mfma_f32_16x16x32_bf16(a, b, c, 0, 0, 0); }
__device__ __forceinline__ bf16x8 ldfrag(const char* base, int stride, int row, int k0) { return *(const bf16x8*)(base + row * stride + k0 * 2); }
}
__device__ __forceinline__ void ph_ssd(Frame& F) {
    using namespace ssd;
    char* lds = (char*)(unsigned char*)F.lds;
    const bf16_t* XBC = (const bf16_t*)(F.ws + WS_XBC); const bf16_t* ZS = (const bf16_t*)(F.ws + WS_Z); const float* DT = (const float*)(F.outb + OUT_DT);
    bf16_t* YG = (bf16_t*)(F.ws + WS_Q);
    const float* conv_w = F.a->in[9]; const float* conv_b = F.a->in[10]; const float* a_log = F.a->in[12]; const float* d_skip = F.a->in[13];
    const int tid = F.tid, wid = F.wave, lane = F.lane, fr = lane & 15, fq = lane >> 4;
    const bool stager = tid < 320; const int so = tid % 40, tg = tid / 40;
    for (int item = F.bid; item < NB * 16; item += F.G) {
        const int b = item >> 4, h = item & 15, g = h >> 2;
        const float aneg = -__expf(a_log[h]), dsk = d_skip[h];
        const int ch0 = so < 8 ? h * 64 + so * 8 : (so < 24 ? 1024 + g * 128 + (so - 8) * 8 : 1536 + g * 128 + (so - 24) * 8);
        float* CWL = (float*)(lds + OFF_END);
        __syncthreads();
        if (stager) {
#pragma unroll
            for (int j = 0; j < 4; ++j) { *(f32x4*)(CWL + j * 320 + so * 8) = *(const f32x4*)(conv_w + (size_t)j * 2048 + ch0); *(f32x4*)(CWL + j * 320 + so * 8 + 4) = *(const f32x4*)(conv_w + (size_t)j * 2048 + ch0 + 4); }
            *(f32x4*)(CWL + 4 * 320 + so * 8) = *(const f32x4*)(conv_b + ch0); *(f32x4*)(CWL + 4 * 320 + so * 8 + 4) = *(const f32x4*)(conv_b + ch0 + 4);
        }
        f32x4 hst[4];
#pragma unroll
        for (int t = 0; t < 4; ++t) hst[t] = (f32x4){0.f, 0.f, 0.f, 0.f};
        __syncthreads();
        for (int i = tid; i < 64 * CS_ST / 4; i += NTHR) ((unsigned*)(lds + OFF_HS))[i] = 0u;
        u32x4 raw[11];
        const size_t tokb = (size_t)b * SEQ;
#define SSD_LOAD(c) do { if (stager) { _Pragma("unroll") for (int i = 0; i < 11; ++i) { const int t = (c) * 64 + tg * 8 - 3 + i; \
            raw[i] = (t >= 0) ? *(const u32x4*)(XBC + (tokb + t) * 2048 + ch0) : (u32x4){0u, 0u, 0u, 0u}; } } } while (0)
        SSD_LOAD(0);
        float dtl_next = DT[(tokb + lane) * 16 + h];
        for (int c = 0; c < 32; ++c) {
            const float dtl = dtl_next; if (c + 1 < 32) dtl_next = DT[(tokb + (c + 1) * 64 + lane) * 16 + h];
            u32x2 zpre[2];
#pragma unroll
            for (int t2 = 0; t2 < 2; ++t2) { const int tile = 2 * wid + t2, pb = tile >> 2, lb = tile & 3; zpre[t2] = *(const u32x2*)(ZS + (tokb + c * 64 + lb * 16 + fr) * 1024 + h * 64 + pb * 16 + 4 * fq); }
            float acs = dtl * aneg;
#pragma unroll
            for (int o = 1; o < 64; o <<= 1) { const float t = __shfl_up(acs, o); if (lane >= o) acs += t; }
            const float alast = __shfl(acs, 63);
            if (DBG_SSD_SYNC) __syncthreads();
            float dtv[8], dec[8];
#pragma unroll
            for (int t = 0; t < 8; ++t) { dtv[t] = __shfl(dtl, (tg * 8 + t) & 63); dec[t] = __expf(alast - __shfl(acs, (tg * 8 + t) & 63)); }
            if (stager) {
#pragma unroll
                for (int hq = 0; hq < 2; ++hq) {
                    float xin[11][4];
#pragma unroll
                    for (int i = 0; i < 11; ++i) { const unsigned wa = hq ? raw[i].z : raw[i].x, wb = hq ? raw[i].w : raw[i].y; xin[i][0] = bflo(wa); xin[i][1] = bfhi(wa); xin[i][2] = bflo(wb); xin[i][3] = bfhi(wb); }
                    float outv[8][4];
                    { f32x4 cwv[4]; const f32x4 cbq = *(const f32x4*)(CWL + 4 * 320 + so * 8 + hq * 4);
#pragma unroll
                      for (int j = 0; j < 4; ++j) cwv[j] = *(const f32x4*)(CWL + j * 320 + so * 8 + hq * 4);
#pragma unroll
                      for (int t = 0; t < 8; ++t)
#pragma unroll
                        for (int e = 0; e < 4; ++e) { float sacc = cbq[e];
#pragma unroll
                            for (int j = 0; j < 4; ++j) sacc += cwv[j][e] * xin[t + j][e];
                            outv[t][e] = silu_f(sacc); } }
                    if (so < 8) {
#pragma unroll
                        for (int e = 0; e < 4; ++e) { const int p = so * 8 + hq * 4 + e;
                            f32x4 x0, x1, d0, d1, w0, w1;
#pragma unroll
                            for (int t = 0; t < 4; ++t) { x0[t] = outv[t][e]; x1[t] = outv[4 + t][e]; d0[t] = x0[t] * dtv[t]; d1[t] = x1[t] * dtv[4 + t]; w0[t] = d0[t] * dec[t]; w1[t] = d1[t] * dec[4 + t]; }
                            *(u32x4*)(lds + OFF_XS + p * T_ST + tg * 16) = pack8(x0, x1);
                            *(u32x4*)(lds + OFF_XT + p * T_ST + tg * 16) = pack8(d0, d1);
                            *(u32x4*)(lds + OFF_XW + p * T_ST + tg * 16) = pack8(w0, w1); }
                    } else {
                        const bool isB = so < 24; const int n0 = (isB ? (so - 8) : (so - 24)) * 8 + hq * 4;
                        char* nat = lds + (isB ? OFF_BS : OFF_CS);
#pragma unroll
                        for (int t = 0; t < 8; ++t) { u32x2 w; w.x = cvt_pk_bf16(outv[t][0], outv[t][1]); w.y = cvt_pk_bf16(outv[t][2], outv[t][3]);
                            *(u32x2*)(nat + (tg * 8 + t) * CS_ST + n0 * 2) = w; }
                        if (isB) {
#pragma unroll
                            for (int e = 0; e < 4; ++e) { f32x4 a, bq;
#pragma unroll
                                for (int t = 0; t < 4; ++t) { a[t] = outv[t][e]; bq[t] = outv[4 + t][e]; }
                                *(u32x4*)(lds + OFF_BT + (n0 + e) * T_ST + tg * 16) = pack8(a, bq); }
                        }
                    }
                }
            }
            if (c + 1 < 32) SSD_LOAD(c + 1);
            __syncthreads();
#pragma unroll
            for (int t2 = 0; t2 < 2; ++t2) {
                const int tile = 2 * wid + t2, sb = tile >> 2, lb = tile & 3;
                f32x4 d = (f32x4){0.f, 0.f, 0.f, 0.f};
                if (sb <= lb) {
#pragma unroll
                    for (int ks = 0; ks < 4; ++ks) d = mfma16(ldfrag(lds + OFF_BS, CS_ST, sb * 16 + fr, ks * 32 + fq * 8), ldfrag(lds + OFF_CS, CS_ST, lb * 16 + fr, ks * 32 + fq * 8), d);
                    const int l = lb * 16 + fr; const float al = __shfl(acs, l);
                    f32x4 as;
#pragma unroll
                    for (int r = 0; r < 4; ++r) as[r] = __shfl(acs, sb * 16 + 4 * fq + r);
#pragma unroll
                    for (int r = 0; r < 4; ++r) { const int s = sb * 16 + 4 * fq + r; d[r] = (s <= l) ? d[r] * __expf(al - as[r]) : 0.f; }
                }
                u32x2 w; w.x = cvt_pk_bf16(d[0], d[1]); w.y = cvt_pk_bf16(d[2], d[3]);
                *(u32x2*)(lds + OFF_MT + (lb * 16 + fr) * T_ST + (sb * 16 + 4 * fq) * 2) = w;
            }
            if (DBG_SSD_SYNC) __syncthreads();
            f32x4 yacc[2];
#pragma unroll
            for (int t2 = 0; t2 < 2; ++t2) {
                const int tile = 2 * wid + t2, pb = tile >> 2, lb = tile & 3;
                f32x4 d = (f32x4){0.f, 0.f, 0.f, 0.f};
#pragma unroll
                for (int ks = 0; ks < 4; ++ks) d = mfma16(ldfrag(lds + OFF_HS, CS_ST, pb * 16 + fr, ks * 32 + fq * 8), ldfrag(lds + OFF_CS, CS_ST, lb * 16 + fr, ks * 32 + fq * 8), d);
                const float el = __expf(__shfl(acs, lb * 16 + fr));
                yacc[t2] = d * el;
            }
            __syncthreads();
#pragma unroll
            for (int t2 = 0; t2 < 2; ++t2) {
                const int tile = 2 * wid + t2, pb = tile >> 2, lb = tile & 3;
                f32x4 d = yacc[t2];
#pragma unroll
                for (int ks = 0; ks < 2; ++ks) d = mfma16(ldfrag(lds + OFF_XT, T_ST, pb * 16 + fr, ks * 32 + fq * 8), ldfrag(lds + OFF_MT, T_ST, lb * 16 + fr, ks * 32 + fq * 8), d);
                const int l = lb * 16 + fr, p0 = pb * 16 + 4 * fq; const size_t tok = tokb + c * 64 + l;
                const u32x2 zz = zpre[t2];
                const float z0 = bflo(zz.x), z1 = bfhi(zz.x), z2 = bflo(zz.y), z3 = bfhi(zz.y);
                float xs[4];
#pragma unroll
                for (int r = 0; r < 4; ++r) xs[r] = bflo((unsigned)*(const bf16_t*)(lds + OFF_XS + (p0 + r) * T_ST + l * 2));
                u32x2 w; w.x = cvt_pk_bf16((d[0] + xs[0] * dsk) * z0, (d[1] + xs[1] * dsk) * z1); w.y = cvt_pk_bf16((d[2] + xs[2] * dsk) * z2, (d[3] + xs[3] * dsk) * z3);
                *(u32x2*)(YG + tok * 1024 + h * 64 + p0) = w;
            }
            if (DBG_SSD_SYNC) __syncthreads();
            { const float dc = __expf(alast);
#pragma unroll
              for (int t = 0; t < 4; ++t) { f32x4 d = hst[t] * dc;
#pragma unroll
                  for (int ks = 0; ks < 2; ++ks) d = mfma16(ldfrag(lds + OFF_BT, T_ST, wid * 16 + fr, ks * 32 + fq * 8), ldfrag(lds + OFF_XW, T_ST, t * 16 + fr, ks * 32 + fq * 8), d);
                  hst[t] = d;
                  u32x2 w; w.x = cvt_pk_bf16(d[0], d[1]); w.y = cvt_pk_bf16(d[2], d[3]);
                  *(u32x2*)(lds + OFF_HS + (t * 16 + fr) * CS_ST + (wid * 16 + 4 * fq) * 2) = w; } }
            __syncthreads();
        }
#undef SSD_LOAD
    }
}

namespace ssd2 {
constexpr int CS_ST = 272, T_ST = 144;
constexpr int OFF_CS = 0, OFF_BS = 64 * CS_ST, OFF_BT = 2 * 64 * CS_ST, OFF_H0 = OFF_BT + 128 * T_ST;
constexpr int H_XS = 0, H_XW = 64 * T_ST, H_MT = 2 * 64 * T_ST, H_HS = 3 * 64 * T_ST, H_SZ = H_HS + 64 * CS_ST;
constexpr int OFF_CW = OFF_H0 + 2 * H_SZ;
constexpr int OFF_TAB = OFF_CW + 5 * 384 * 4;
static_assert(OFF_TAB + 6 * 64 * 4 <= LDS_MISC, "ssd2 lds");
}
__device__ __forceinline__ void ph_ssd2(Frame& F, const int abl = 0) {
    using namespace ssd2; using ssd::mfma16; using ssd::ldfrag;
    char* lds = (char*)(unsigned char*)F.lds;
    const bf16_t* XBC = (const bf16_t*)(F.ws + WS_XBC); const bf16_t* ZS = (const bf16_t*)(F.ws + WS_Z); const float* DT = (const float*)(F.outb + OUT_DT);
    bf16_t* YG = (bf16_t*)(F.ws + WS_Q);
    const float* conv_w = F.a->in[9]; const float* conv_b = F.a->in[10]; const float* a_log = F.a->in[12]; const float* d_skip = F.a->in[13];
    const int tid = F.tid, wid = F.wave, lane = F.lane, fr = lane & 15, fq = lane >> 4;
    const int su = tid < 384 ? tid : tid - 128; const bool cwl_writer = true;
    const int cp_lo = __builtin_amdgcn_readfirstlane(tid < 384 ? 0 : 2), cp_hi = __builtin_amdgcn_readfirstlane(tid < 256 ? 4 : (tid < 384 ? 2 : 4));
    const int so = su % 48, tg = su / 48, shd = (so >> 3) & 1;
    for (int item = F.bid; item < NB * 8; item += F.G) {
        const int b = item >> 3, g = (item >> 1) & 3, h0 = g * 4 + (item & 1) * 2;
        const float aneg0 = -__expf(a_log[h0]), aneg1 = -__expf(a_log[h0 + 1]), dsk0 = d_skip[h0], dsk1 = d_skip[h0 + 1];
        const int ch0 = so < 16 ? (h0 + shd) * 64 + (so & 7) * 8 : (so < 32 ? 1024 + g * 128 + (so - 16) * 8 : 1536 + g * 128 + (so - 32) * 8);
        float* CWL = (float*)(lds + OFF_CW);
        __syncthreads();
        if (cwl_writer) {
#pragma unroll
            for (int j = 0; j < 4; ++j) { *(f32x4*)(CWL + j * 384 + so * 8) = *(const f32x4*)(conv_w + (size_t)j * 2048 + ch0); *(f32x4*)(CWL + j * 384 + so * 8 + 4) = *(const f32x4*)(conv_w + (size_t)j * 2048 + ch0 + 4); }
            *(f32x4*)(CWL + 4 * 384 + so * 8) = *(const f32x4*)(conv_b + ch0); *(f32x4*)(CWL + 4 * 384 + so * 8 + 4) = *(const f32x4*)(conv_b + ch0 + 4);
        }
        f32x4 hst[2][4];
#pragma unroll
        for (int hh = 0; hh < 2; ++hh)
#pragma unroll
            for (int t = 0; t < 4; ++t) hst[hh][t] = (f32x4){0.f, 0.f, 0.f, 0.f};
        for (int i = tid; i < 64 * CS_ST / 4; i += NTHR) { ((unsigned*)(lds + OFF_H0 + H_HS))[i] = 0u; ((unsigned*)(lds + OFF_H0 + H_SZ + H_HS))[i] = 0u; }
        u32x4 raw[11];
        const size_t tokb = (size_t)b * SEQ;
        const bf16_t* xrow = XBC + ((ptrdiff_t)tokb + tg * 8 - 3) * 2048 + ch0;
#define SSD_LOAD(c, xp, tgx) do { { _Pragma("unroll") for (int i = 0; i < 11; ++i) { const int t = (c) * 64 + (tgx) * 8 - 3 + i; \
            raw[i] = (t >= 0) ? *(const GAS u32x4*)((xp) + (ptrdiff_t)((c) * 64 + i) * 2048) : (u32x4){0u, 0u, 0u, 0u}; } } } while (0)
        SSD_LOAD(0, xrow, tg);
        f32x2 dtn = *(const f32x2*)(DT + (tokb + lane) * 16 + h0);
        for (int c = 0; c < 32; ++c) {
            int frl = fr, fql = fq, tgl = tg, sol = so; const bf16_t* xrl = xrow; asm volatile("" : "+v"(frl), "+v"(fql), "+v"(tgl), "+v"(sol), "+v"(xrl)); const int shdl = (sol >> 3) & 1;
            const float dtl0 = dtn[0], dtl1 = dtn[1]; if (c + 1 < 32) dtn = *(const f32x2*)(DT + (tokb + (c + 1) * 64 + lane) * 16 + h0);
            u32x2 zpre[2][2];
#pragma unroll
            for (int hh = 0; hh < 2; ++hh)
#pragma unroll
                for (int t2 = 0; t2 < 2; ++t2) { const int tile = 2 * wid + t2, pb = tile >> 2, lb = tile & 3; zpre[hh][t2] = *(const u32x2*)(ZS + (tokb + c * 64 + lb * 16 + frl) * 1024 + (h0 + hh) * 64 + pb * 16 + 4 * fql); }
            const float acs0 = dpp_scan_add(dtl0 * aneg0), acs1 = dpp_scan_add(dtl1 * aneg1);
            const float alast0 = __builtin_bit_cast(float, __builtin_amdgcn_readlane(__builtin_bit_cast(int, acs0), 63)), alast1 = __builtin_bit_cast(float, __builtin_amdgcn_readlane(__builtin_bit_cast(int, acs1), 63));
            float* TAB = (float*)(lds + OFF_TAB);
            TAB[lane] = acs0; TAB[64 + lane] = acs1; TAB[128 + lane] = dtl0; TAB[192 + lane] = dtl1; TAB[256 + lane] = dtl0 * __expf(alast0 - acs0); TAB[320 + lane] = dtl1 * __expf(alast1 - acs1);
            LDS_WAIT(); asm volatile("" ::: "memory");
            float wdt[8];
            { const f32x4 wa = *(const f32x4*)(TAB + 256 + shdl * 64 + tgl * 8), wb = *(const f32x4*)(TAB + 256 + shdl * 64 + tgl * 8 + 4);
#pragma unroll
              for (int t = 0; t < 4; ++t) { wdt[t] = wa[t]; wdt[4 + t] = wb[t]; } }
            if (!(abl & 1)) {
#pragma unroll
                for (int cp = 0; cp < 4; ++cp) {
                    if (cp < cp_lo || cp >= cp_hi) continue;
                    float xin[11][2];
#pragma unroll
                    for (int i = 0; i < 11; ++i) { const unsigned wa = cp == 0 ? raw[i].x : (cp == 1 ? raw[i].y : (cp == 2 ? raw[i].z : raw[i].w)); xin[i][0] = bflo(wa); xin[i][1] = bfhi(wa); }
                    float outv[8][2];
                    { f32x2 cwv[4]; const f32x2 cbq = *(const f32x2*)(CWL + 4 * 384 + sol * 8 + cp * 2);
#pragma unroll
                      for (int j = 0; j < 4; ++j) cwv[j] = *(const f32x2*)(CWL + j * 384 + sol * 8 + cp * 2);
#pragma unroll
                      for (int t = 0; t < 8; ++t)
#pragma unroll
                        for (int e = 0; e < 2; ++e) { float sacc = cbq[e];
#pragma unroll
                            for (int j = 0; j < 4; ++j) sacc += cwv[j][e] * xin[t + j][e];
                            outv[t][e] = silu_f(sacc); } }
                    if (sol < 16) {
                        char* hb = lds + OFF_H0 + shdl * H_SZ;
#pragma unroll
                        for (int e = 0; e < 2; ++e) { const int p = (sol & 7) * 8 + cp * 2 + e;
                            f32x4 x0, x1, w0, w1;
#pragma unroll
                            for (int t = 0; t < 4; ++t) { x0[t] = outv[t][e]; x1[t] = outv[4 + t][e]; w0[t] = x0[t] * wdt[t]; w1[t] = x1[t] * wdt[4 + t]; }
                            *(u32x4*)(hb + H_XS + p * T_ST + tgl * 16) = pack8(x0, x1);
                            *(u32x4*)(hb + H_XW + p * T_ST + tgl * 16) = pack8(w0, w1); }
                    } else {
                        const bool isB = sol < 32; const int n0 = (isB ? (sol - 16) : (sol - 32)) * 8 + cp * 2;
                        char* nat = lds + (isB ? OFF_BS : OFF_CS);
#pragma unroll
                        for (int t = 0; t < 8; ++t) *(unsigned*)(nat + (tgl * 8 + t) * CS_ST + n0 * 2) = cvt_pk_bf16(outv[t][0], outv[t][1]);
                        if (isB) {
#pragma unroll
                            for (int e = 0; e < 2; ++e) { f32x4 a, bq;
#pragma unroll
                                for (int t = 0; t < 4; ++t) { a[t] = outv[t][e]; bq[t] = outv[4 + t][e]; }
                                *(u32x4*)(lds + OFF_BT + (n0 + e) * T_ST + tgl * 16) = pack8(a, bq); }
                        }
                    }
                    SBAR();
                }
            }
            if (c + 1 < 32) SSD_LOAD(c + 1, xrl, tgl);
            __syncthreads();
            bf16x8 cfr[2][4];
#pragma unroll
            for (int t2 = 0; t2 < 2; ++t2)
#pragma unroll
                for (int ks = 0; ks < 4; ++ks) cfr[t2][ks] = ldfrag(lds + OFF_CS, CS_ST, ((2 * wid + t2) & 3) * 16 + frl, ks * 32 + fql * 8);
            if (!(abl & 2))
#pragma unroll
            for (int t2 = 0; t2 < 2; ++t2) {
                const int tile = 2 * wid + t2, sb = tile >> 2, lb = tile & 3;
                f32x4 d = (f32x4){0.f, 0.f, 0.f, 0.f}, m0 = d, m1 = d;
                if (sb <= lb) {
#pragma unroll
                    for (int ks = 0; ks < 4; ++ks) d = mfma16(ldfrag(lds + OFF_BS, CS_ST, sb * 16 + frl, ks * 32 + fql * 8), cfr[t2][ks], d);
                    const int l = lb * 16 + frl, s4 = sb * 16 + 4 * fql; const float al0 = TAB[l], al1 = TAB[64 + l];
                    const f32x4 as0 = *(const f32x4*)(TAB + s4), as1 = *(const f32x4*)(TAB + 64 + s4), ds0 = *(const f32x4*)(TAB + 128 + s4), ds1 = *(const f32x4*)(TAB + 192 + s4);
#pragma unroll
                    for (int r = 0; r < 4; ++r) { const int sidx = s4 + r;
                        m0[r] = (sidx <= l) ? d[r] * __expf(al0 - as0[r]) * ds0[r] : 0.f; m1[r] = (sidx <= l) ? d[r] * __expf(al1 - as1[r]) * ds1[r] : 0.f; }
                }
                u32x2 w; w.x = cvt_pk_bf16(m0[0], m0[1]); w.y = cvt_pk_bf16(m0[2], m0[3]);
                *(u32x2*)(lds + OFF_H0 + H_MT + (lb * 16 + frl) * T_ST + (sb * 16 + 4 * fql) * 2) = w;
                w.x = cvt_pk_bf16(m1[0], m1[1]); w.y = cvt_pk_bf16(m1[2], m1[3]);
                *(u32x2*)(lds + OFF_H0 + H_SZ + H_MT + (lb * 16 + frl) * T_ST + (sb * 16 + 4 * fql) * 2) = w;
            }
            f32x4 yacc[2][2];
#pragma unroll
            for (int hh = 0; hh < 2; ++hh)
#pragma unroll
                for (int t2 = 0; t2 < 2; ++t2) {
                    const int tile = 2 * wid + t2, pb = tile >> 2, lb = tile & 3; const char* hb = lds + OFF_H0 + hh * H_SZ;
                    f32x4 d = (f32x4){0.f, 0.f, 0.f, 0.f};
                    if (!(abl & 2))
#pragma unroll
                    for (int ks = 0; ks < 4; ++ks) d = mfma16(ldfrag(hb + H_HS, CS_ST, pb * 16 + frl, ks * 32 + fql * 8), cfr[t2][ks], d);
                    const float el = __expf(TAB[hh * 64 + lb * 16 + frl]);
                    yacc[hh][t2] = d * el;
                }
            __syncthreads();
            if (!(abl & 4))
#pragma unroll
            for (int hh = 0; hh < 2; ++hh)
#pragma unroll
                for (int t2 = 0; t2 < 2; ++t2) {
                    const int tile = 2 * wid + t2, pb = tile >> 2, lb = tile & 3; const char* hb = lds + OFF_H0 + hh * H_SZ;
                    f32x4 d = yacc[hh][t2];
#pragma unroll
                    for (int ks = 0; ks < 2; ++ks) d = mfma16(ldfrag(hb + H_XS, T_ST, pb * 16 + frl, ks * 32 + fql * 8), ldfrag(hb + H_MT, T_ST, lb * 16 + frl, ks * 32 + fql * 8), d);
                    const int l = lb * 16 + frl, p0 = pb * 16 + 4 * fql; const size_t tok = tokb + c * 64 + l; const float dsk = hh ? dsk1 : dsk0;
                    const u32x2 zz = zpre[hh][t2];
                    const float z0 = bflo(zz.x), z1 = bfhi(zz.x), z2 = bflo(zz.y), z3 = bfhi(zz.y);
                    float xs[4];
#pragma unroll
                    for (int r = 0; r < 4; ++r) xs[r] = bflo((unsigned)*(const bf16_t*)(hb + H_XS + (p0 + r) * T_ST + l * 2));
                    u32x2 w; w.x = cvt_pk_bf16((d[0] + xs[0] * dsk) * z0, (d[1] + xs[1] * dsk) * z1); w.y = cvt_pk_bf16((d[2] + xs[2] * dsk) * z2, (d[3] + xs[3] * dsk) * z3);
                    *(u32x2*)(YG + tok * 1024 + (h0 + hh) * 64 + p0) = w;
                }
            const bf16x8 btf0 = ldfrag(lds + OFF_BT, T_ST, wid * 16 + frl, fql * 8), btf1 = ldfrag(lds + OFF_BT, T_ST, wid * 16 + frl, 32 + fql * 8);
            if (!(abl & 8))
#pragma unroll
            for (int hh = 0; hh < 2; ++hh) { const float dc = __expf(hh ? alast1 : alast0); char* hb = lds + OFF_H0 + hh * H_SZ;
#pragma unroll
                for (int t = 0; t < 4; ++t) { f32x4 d = hst[hh][t] * dc;
#pragma unroll
                    for (int ks = 0; ks < 2; ++ks) d = mfma16(ks ? btf1 : btf0, ldfrag(hb + H_XW, T_ST, t * 16 + frl, ks * 32 + fql * 8), d);
                    hst[hh][t] = d;
                    u32x2 w; w.x = cvt_pk_bf16(d[0], d[1]); w.y = cvt_pk_bf16(d[2], d[3]);
                    *(u32x2*)(hb + H_HS + (t * 16 + frl) * CS_ST + (wid * 16 + 4 * fql) * 2) = w; } }
            __syncthreads();
        }
#undef SSD_LOAD
    }
}

__device__ __forceinline__ void ph_gnorm(Frame& F) {
    bf16_t* YG = (bf16_t*)(F.ws + WS_Q);
    const int gw = F.bid * NWAVES + F.wave, NGW = F.G * NWAVES;
    constexpr int RB = 4;
    for (int m0 = gw * RB; m0 < NTOK; m0 += NGW * RB) {
        u32x2 w[RB][4];
#pragma unroll
        for (int r = 0; r < RB; ++r) { const u32x2* rp = (const u32x2*)(YG + (size_t)(m0 + r) * D) + F.lane;
#pragma unroll
            for (int j = 0; j < 4; ++j) w[r][j] = rp[64 * j]; }
#pragma unroll
        for (int r = 0; r < RB; ++r) { const int m = m0 + r; u32x2* rp = (u32x2*)(YG + (size_t)m * D) + F.lane;
#pragma unroll
            for (int j = 0; j < 4; ++j) { const float a = bflo(w[r][j].x), b = bfhi(w[r][j].x), c = bflo(w[r][j].y), d = bfhi(w[r][j].y);
                const float ss = wave_sum(a * a + b * b + c * c + d * d); const float rr = 1.f / sqrtf(ss * (1.f / 256.f) + LN_EPS);
                if (PB_FP8) { int pk = 0; pk = __builtin_amdgcn_cvt_pk_fp8_f32(a * rr, b * rr, pk, false); pk = __builtin_amdgcn_cvt_pk_fp8_f32(c * rr, d * rr, pk, true); ((unsigned*)(F.outb + OUT_OB8 + (size_t)m * D))[F.lane + 64 * j] = (unsigned)pk; }
                else { u32x2 o; o.x = cvt_pk_bf16(a * rr, b * rr); o.y = cvt_pk_bf16(c * rr, d * rr); rp[64 * j] = o; } } }
    }
}

template <bool DRY = false> __device__ __forceinline__ void ph_router(Frame& F) {
    const bf16_t* VB = (const bf16_t*)(F.ws + WS_VB); bf16_t* X1B = (bf16_t*)(F.ws + WS_X1B); bf16_t* U2 = (bf16_t*)(F.ws + WS_U2); const float* MOD = (const float*)(F.ws + WS_MOD);
    const float* ln1g = F.a->in[18]; const float* ln1b = F.a->in[19]; const float* w_router = F.a->in[20]; const float* b_router = F.a->in[21];
    u32x2* REG = (u32x2*)(F.ws + WS_REG); unsigned* CNT = (unsigned*)(F.ws + WS_CTL) + CW_CNT;
    constexpr int TST = 2064;
    LAS unsigned char* THI = F.lds; LAS unsigned char* TLO = F.lds + 16 * TST; LAS float* PART = (LAS float*)(F.lds + 32 * TST);
    LAS unsigned* lcnt = (LAS unsigned*)(F.lds + LDS_AUX); LAS unsigned* lbase = lcnt + 32; LAS unsigned* ent = lcnt + 64;
    const int tid = F.tid, lane = F.lane, wid = F.wave, fr = lane & 15, fq = lane >> 4;
    bf16x8 whi[4][2], wlo[4][2];
#pragma unroll
    for (int ks = 0; ks < 4; ++ks)
#pragma unroll
        for (int ct = 0; ct < 2; ++ct) { float wv[8];
#pragma unroll
            for (int i = 0; i < 8; ++i) wv[i] = w_router[(size_t)(128 * wid + 32 * ks + 8 * fq + i) * 32 + ct * 16 + fr];
            u32x4 h, l2;
#pragma unroll
            for (int i = 0; i < 4; ++i) { const unsigned hp = cvt_pk_bf16(wv[2 * i], wv[2 * i + 1]); const float r0 = wv[2 * i] - bflo(hp), r1 = wv[2 * i + 1] - bfhi(hp); h[i] = hp; l2[i] = cvt_pk_bf16(r0, r1); }
            whi[ks][ct] = __builtin_bit_cast(bf16x8, h); wlo[ks][ct] = __builtin_bit_cast(bf16x8, l2); }
    const float brl = b_router[lane & 31];
    f32x4 lg[4], lb[4];
#pragma unroll
    for (int j = 0; j < 4; ++j) { lg[j] = *((const f32x4*)ln1g + lane + 64 * j); lb[j] = *((const f32x4*)ln1b + lane + 64 * j); }
    for (int batch = F.bid; batch < NTOK / 256; batch += F.G) {
        const int hf = batch >> 7;
        f32x4 shv[4], scv[4];
        { const float* md = MOD + (size_t)((batch * 256) >> 11) * 6144;
#pragma unroll
          for (int j = 0; j < 4; ++j) { shv[j] = *((const f32x4*)(md + 3072) + lane + 64 * j); scv[j] = *((const f32x4*)(md + 4096) + lane + 64 * j); } }
        __syncthreads();
        if (tid < 32) lcnt[tid] = 0u;
        for (int grp = 0; grp < 16; ++grp) {
#pragma unroll
            for (int tt = 0; tt < 2; ++tt) {
                const int tg16 = 2 * wid + tt, m = batch * 256 + grp * 16 + tg16; const float* md = MOD + (size_t)(m >> 11) * 6144;
                const u32x2* vr = (const u32x2*)(VB + (size_t)m * D) + lane; u32x2* xr = (u32x2*)(X1B + (size_t)m * D) + lane;
                f32x4 v[4]; float s = 0.f;
#pragma unroll
                for (int j = 0; j < 4; ++j) { const u32x2 w = vr[64 * j]; v[j] = (f32x4){bflo(w.x), bfhi(w.x), bflo(w.y), bfhi(w.y)}; s += (v[j][0] + v[j][1]) + (v[j][2] + v[j][3]); }
                float mean = wave_sum(s) * (1.f / D), s2 = 0.f;
#pragma unroll
                for (int j = 0; j < 4; ++j) { v[j] = v[j] - mean; s2 += (v[j][0] * v[j][0] + v[j][1] * v[j][1]) + (v[j][2] * v[j][2] + v[j][3] * v[j][3]); }
                float rstd = 1.f / sqrtf(wave_sum(s2) * (1.f / D) + LN_EPS);
                s = 0.f;
#pragma unroll
                for (int j = 0; j < 4; ++j) { v[j] = v[j] * rstd * lg[j] + lb[j]; if (!DRY) { u32x2 w; w.x = cvt_pk_bf16(v[j][0], v[j][1]); w.y = cvt_pk_bf16(v[j][2], v[j][3]); xr[64 * j] = w; } s += (v[j][0] + v[j][1]) + (v[j][2] + v[j][3]); }
                mean = wave_sum(s) * (1.f / D); s2 = 0.f;
#pragma unroll
                for (int j = 0; j < 4; ++j) { v[j] = v[j] - mean; s2 += (v[j][0] * v[j][0] + v[j][1] * v[j][1]) + (v[j][2] * v[j][2] + v[j][3] * v[j][3]); }
                rstd = 1.f / sqrtf(wave_sum(s2) * (1.f / D) + LN_EPS);
                u32x2* o8 = (u32x2*)(U2 + (size_t)m * D) + lane;
#pragma unroll
                for (int j = 0; j < 4; ++j) {
                    v[j] = v[j] * rstd * (scv[j] + 1.0f) + shv[j]; u32x2 w; w.x = cvt_pk_bf16(v[j][0], v[j][1]); w.y = cvt_pk_bf16(v[j][2], v[j][3]);
                    if (DRY) { if (w.x == 0x12345678u) o8[64 * j] = w; }
                    else if (MOE_FP8) { int pk = 0; pk = __builtin_amdgcn_cvt_pk_fp8_f32(v[j][0], v[j][1], pk, false); pk = __builtin_amdgcn_cvt_pk_fp8_f32(v[j][2], v[j][3], pk, true); ((unsigned*)((unsigned char*)U2 + (size_t)m * D))[lane + 64 * j] = (unsigned)pk; }
                    else o8[64 * j] = w;
                    u32x2 lo; lo.x = cvt_pk_bf16(v[j][0] - bflo(w.x), v[j][1] - bfhi(w.x)); lo.y = cvt_pk_bf16(v[j][2] - bflo(w.y), v[j][3] - bfhi(w.y));
                    *(LAS u32x2*)(THI + tg16 * TST + (4 * lane + 256 * j) * 2) = w; *(LAS u32x2*)(TLO + tg16 * TST + (4 * lane + 256 * j) * 2) = lo; }
            }
            __syncthreads();
            { f32x4 a0 = (f32x4){0.f, 0.f, 0.f, 0.f}, a1 = a0;
#pragma unroll
              for (int ks = 0; ks < 4; ++ks) { const int cb = (128 * wid + 32 * ks + 8 * fq) * 2;
                  const bf16x8 th = *(const LAS bf16x8*)(THI + fr * TST + cb), tl = *(const LAS bf16x8*)(TLO + fr * TST + cb);
                  a0 = __builtin_amdgcn_mfma_f32_16x16x32_bf16(whi[ks][0], th, a0, 0, 0, 0); a1 = __builtin_amdgcn_mfma_f32_16x16x32_bf16(whi[ks][1], th, a1, 0, 0, 0);
                  a0 = __builtin_amdgcn_mfma_f32_16x16x32_bf16(wlo[ks][0], th, a0, 0, 0, 0); a1 = __builtin_amdgcn_mfma_f32_16x16x32_bf16(wlo[ks][1], th, a1, 0, 0, 0);
                  a0 = __builtin_amdgcn_mfma_f32_16x16x32_bf16(whi[ks][0], tl, a0, 0, 0, 0); a1 = __builtin_amdgcn_mfma_f32_16x16x32_bf16(whi[ks][1], tl, a1, 0, 0, 0); }
              *(LAS f32x4*)(PART + (wid * 16 + fr) * 32 + 4 * fq) = a0; *(LAS f32x4*)(PART + (wid * 16 + fr) * 32 + 16 + 4 * fq) = a1; }
            __syncthreads();
            { const int tg16 = 2 * wid + (lane >> 5), tl = grp * 16 + tg16, myexp = lane & 31;
              float logit = brl;
#pragma unroll
              for (int w8 = 0; w8 < 8; ++w8) logit += PART[(w8 * 16 + tg16) * 32 + myexp];
              float tv[4]; int tix[4];
#pragma unroll
              for (int k = 0; k < 4; ++k) { float bv = logit; int bi = myexp;
#define RT_STEP(ctrl, rm) do { const float ov = __builtin_bit_cast(float, __builtin_amdgcn_update_dpp((int)0xff800000u, __builtin_bit_cast(int, bv), (ctrl), (rm), 0xf, false)); \
                      const int oi = __builtin_amdgcn_update_dpp(64, bi, (ctrl), (rm), 0xf, false); if (ov > bv || (ov == bv && oi < bi)) { bv = ov; bi = oi; } } while (0)
                  RT_STEP(0x111, 0xf); RT_STEP(0x112, 0xf); RT_STEP(0x114, 0xf); RT_STEP(0x118, 0xf); RT_STEP(0x142, 0xa);
#undef RT_STEP
                  { const int b0 = __builtin_amdgcn_readlane(__builtin_bit_cast(int, bv), 31), b1 = __builtin_amdgcn_readlane(__builtin_bit_cast(int, bv), 63), i0 = __builtin_amdgcn_readlane(bi, 31), i1 = __builtin_amdgcn_readlane(bi, 63);
                    bv = __builtin_bit_cast(float, lane < 32 ? b0 : b1); bi = lane < 32 ? i0 : i1; }
                  tv[k] = bv; tix[k] = bi; if (myexp == bi) logit = -INFINITY; }
              const float e1 = __expf(tv[1] - tv[0]), e2 = __expf(tv[2] - tv[0]), e3 = __expf(tv[3] - tv[0]); const float inv = 1.f / (1.f + e1 + e2 + e3);
              if (myexp < 4) { const int ee = myexp == 0 ? tix[0] : (myexp == 1 ? tix[1] : (myexp == 2 ? tix[2] : tix[3])); const float gg = (myexp == 0 ? 1.f : (myexp == 1 ? e1 : (myexp == 2 ? e2 : e3))) * inv;
                  const unsigned lp = atomicAdd((unsigned*)&lcnt[ee], 1u);
                  LAS unsigned* en = ent + (tl * 4 + myexp) * 3; en[0] = (unsigned)ee; en[1] = lp; en[2] = __float_as_uint(gg);
                  if (DBG_CHECK == 1) { u32x2 rw; rw.x = (unsigned)ee; rw.y = __float_as_uint(gg); ((u32x2*)(F.ws + WS_DBG))[(size_t)(batch * 256 + tl) * 4 + myexp] = rw; } } }
        }
        __syncthreads();
        if (tid < 32) lbase[tid] = DRY ? 0u : __hip_atomic_fetch_add(CNT + 64 * (hf * 32 + tid), lcnt[tid], __ATOMIC_RELAXED, __HIP_MEMORY_SCOPE_AGENT);
        __syncthreads();
        for (int i = tid; i < 1024; i += NTHR) { const LAS unsigned* en = ent + i * 3; const unsigned ee = en[0], pos = lbase[ee] + en[1];
            const unsigned tokl = (unsigned)(batch * 256 + (i >> 2)) - (unsigned)hf * HALF_TOK;
            u32x2 w; w.x = tokl * 4u + (unsigned)(i & 3); w.y = en[2];
            if (!DRY && pos < (unsigned)REG_CAP) REG[((size_t)hf * 32 + ee) * REG_CAP + pos] = w; }
    }
}

template <bool DRY = false> __device__ __forceinline__ void ph_final(Frame& F, int hf) {
    float* OUT = (float*)F.outb; const bf16_t* X1B = (const bf16_t*)(F.ws + WS_X1B); const bf16_t* YB = (const bf16_t*)(F.ws + WS_YB); const float* MOD = (const float*)(F.ws + WS_MOD);
    const float* g2 = F.a->in[26]; const float* b2 = F.a->in[27];
    const int gw = F.bid * NWAVES + F.wave, NGW = F.G * NWAVES, lane = F.lane;
    constexpr int RB = 2;
    f32x4 g2v[4], b2v[4];
#pragma unroll
    for (int j = 0; j < 4; ++j) { g2v[j] = *((const f32x4*)g2 + lane + 64 * j); b2v[j] = *((const f32x4*)b2 + lane + 64 * j); }
    const int RPW = (((HALF_TOK + NGW - 1) / NGW) + RB - 1) / RB * RB, tbeg = gw * RPW, tend = (tbeg + RPW < HALF_TOK) ? tbeg + RPW : HALF_TOK;
    f32x4 gtv[4]; int curb = -1;
    for (int tl0 = tbeg; tl0 < tend; tl0 += RB) {
        { const int bb = (hf * HALF_TOK + tl0) >> 11; if (bb != curb) { curb = bb; const float* md = MOD + (size_t)bb * 6144 + 5120;
#pragma unroll
            for (int j = 0; j < 4; ++j) gtv[j] = *((const f32x4*)md + lane + 64 * j); } }
        u32x2 xw[RB][4]; u32x2 yw[RB][4][4];
#pragma unroll
        for (int r = 0; r < RB; ++r) { const int tl = tl0 + r, m = hf * HALF_TOK + tl;
            const u32x2* xr = (const u32x2*)(X1B + (size_t)m * D) + lane; const u32x2* yr = (const u32x2*)(YB + (size_t)tl * 4 * D) + lane;
#pragma unroll
            for (int j = 0; j < 4; ++j) { xw[r][j] = __builtin_nontemporal_load(xr + 64 * j);
#pragma unroll
                for (int k = 0; k < 4; ++k) yw[r][j][k] = __builtin_nontemporal_load(yr + k * 256 + 64 * j); } }
#pragma unroll
        for (int r = 0; r < RB; ++r) { const int tl = tl0 + r, m = hf * HALF_TOK + tl;
            f32x4* xr = (f32x4*)(OUT + (size_t)m * D) + lane;
            f32x4 v[4]; float s = 0.f;
#pragma unroll
            for (int j = 0; j < 4; ++j) { f32x4 y = (f32x4){0.f, 0.f, 0.f, 0.f};
#pragma unroll
                for (int k = 0; k < 4; ++k) { const u32x2 w = yw[r][j][k]; y[0] += bflo(w.x); y[1] += bfhi(w.x); y[2] += bflo(w.y); y[3] += bfhi(w.y); }
                if (DBG_NO_MOE) y = (f32x4){0.f, 0.f, 0.f, 0.f};
                const f32x4 gt = gtv[j];
                const f32x4 x1v = (f32x4){bflo(xw[r][j].x), bfhi(xw[r][j].x), bflo(xw[r][j].y), bfhi(xw[r][j].y)};
                v[j] = x1v * DN_ALPHA + gt * y; s += (v[j][0] + v[j][1]) + (v[j][2] + v[j][3]); }
            const float mean = wave_sum(s) * (1.f / D); float s2 = 0.f;
#pragma unroll
            for (int j = 0; j < 4; ++j) { v[j] = v[j] - mean; s2 += (v[j][0] * v[j][0] + v[j][1] * v[j][1]) + (v[j][2] * v[j][2] + v[j][3] * v[j][3]); }
            const float rstd = 1.f / sqrtf(wave_sum(s2) * (1.f / D) + LN_EPS);
#pragma unroll
            for (int j = 0; j < 4; ++j) { const f32x4 ov = v[j] * rstd * g2v[j] + b2v[j]; if (!DRY || ov[0] == 1.2345e-33f) __builtin_nontemporal_store(ov, xr + 64 * j); } }
    }
}

__device__ __forceinline__ float block_sum(Frame& F, float v, LAS float* red) {
    v = wave_sum(v); __syncthreads(); if (F.lane == 0) red[F.wave] = v; __syncthreads();
    float s = 0.f; for (int w = 0; w < NWAVES; ++w) s += red[w]; return s;
}
__device__ __forceinline__ float block_max(Frame& F, float v, LAS float* red) {
#pragma unroll
    for (int o = 1; o < 64; o <<= 1) v = fmaxf(v, __shfl_xor(v, o));
    __syncthreads(); if (F.lane == 0) red[F.wave] = v; __syncthreads();
    float s = 0.f; for (int w = 0; w < NWAVES; ++w) s = fmaxf(s, red[w]); return s;
}
__device__ __forceinline__ void dbg_report(Frame& F, float e) { if (F.tid == 0) atomicMax((unsigned*)(F.ws + WS_CTL) + CW_DBG, __float_as_uint(e)); }
__device__ __forceinline__ void dbg_check_moe(Frame& F) {
    if (F.bid >= 64) return;
    const int tok = HALF_TOK + 509 * F.bid + 3, tokl = tok - HALF_TOK, tid = F.tid;
    LAS float* u2 = (LAS float*)F.lds; LAS float* act = u2 + 1024; LAS float* red = act + 1024; LAS float* lg = red + 16;
    const bf16_t* U2 = (const bf16_t*)(F.ws + WS_U2); const bf16_t* YB = (const bf16_t*)(F.ws + WS_YB); const u32x2* RT = (const u32x2*)(F.ws + WS_DBG);
    const float* w1 = F.a->in[22]; const float* b1 = F.a->in[23]; const float* w2 = F.a->in[24]; const float* b2 = F.a->in[25];
    __syncthreads();
    for (int i = tid; i < 1024; i += NTHR) u2[i] = bflo((unsigned)U2[(size_t)tok * 1024 + i]);
    __syncthreads();
    float y0 = 0.f, y1 = 0.f;
    for (int k = 0; k < 4; ++k) {
        const u32x2 rw = RT[(size_t)tok * 4 + k]; const int e = (int)rw.x; const float g = __uint_as_float(rw.y);
        const float* W1 = w1 + (size_t)e * 1024 * 2048; const float* W2 = w2 + (size_t)e * 1024 * 1024;
        float h0 = b1[e * 2048 + tid], h1 = b1[e * 2048 + tid + 512], h2 = b1[e * 2048 + tid + 1024], h3 = b1[e * 2048 + tid + 1536];
        for (int c = 0; c < 1024; ++c) { const float uu = u2[c]; const float* wr = W1 + (size_t)c * 2048 + tid; h0 += uu * wr[0]; h1 += uu * wr[512]; h2 += uu * wr[1024]; h3 += uu * wr[1536]; }
        __syncthreads();
        { float gg = fminf(h0, 7.f), up = fminf(fmaxf(h2, -7.f), 7.f); act[tid] = (up + 1.f) * gg / (1.f + expf(-1.702f * gg));
          gg = fminf(h1, 7.f); up = fminf(fmaxf(h3, -7.f), 7.f); act[tid + 512] = (up + 1.f) * gg / (1.f + expf(-1.702f * gg)); }
        __syncthreads();
        float a0 = b2[e * 1024 + tid], a1 = b2[e * 1024 + tid + 512];
        for (int j = 0; j < 1024; ++j) { const float aa = act[j]; a0 += aa * W2[(size_t)j * 1024 + tid]; a1 += aa * W2[(size_t)j * 1024 + tid + 512]; }
        y0 += g * a0; y1 += g * a1;
    }
    float f0 = 0.f, f1 = 0.f;
    for (int k = 0; k < 4; ++k) { f0 += bflo((unsigned)YB[((size_t)tokl * 4 + k) * 1024 + tid]); f1 += bflo((unsigned)YB[((size_t)tokl * 4 + k) * 1024 + tid + 512]); }
    const float rms = sqrtf(block_sum(F, y0 * y0 + y1 * y1, red) * (1.f / 1024.f)) + 1e-20f;
    float err = block_max(F, fmaxf(fabsf(y0 - f0), fabsf(y1 - f1)), red) / rms;
    { const float* X1 = (const float*)F.outb + (size_t)tok * 1024; const float* md = (const float*)(F.ws + WS_MOD) + (size_t)(tok >> 11) * 6144;
      const float xa = X1[tid], xb = X1[tid + 512]; const float mean = block_sum(F, xa + xb, red) * (1.f / 1024.f);
      const float da = xa - mean, db = xb - mean; const float var = block_sum(F, da * da + db * db, red) * (1.f / 1024.f); const float rstd = 1.f / sqrtf(var + LN_EPS);
      __syncthreads();
      u2[tid] = da * rstd * (1.f + md[4096 + tid]) + md[3072 + tid]; u2[tid + 512] = db * rstd * (1.f + md[4096 + tid + 512]) + md[3072 + tid + 512];
      __syncthreads();
      if (tid < 32) { float a = F.a->in[21][tid]; for (int c = 0; c < 1024; ++c) a += u2[c] * F.a->in[20][c * 32 + tid]; lg[tid] = a; }
      __syncthreads();
      if (tid == 0) { unsigned want = 0u, got = 0u; float l2[32]; for (int i = 0; i < 32; ++i) l2[i] = lg[i];
          for (int k = 0; k < 4; ++k) { int bi = 0; for (int i = 1; i < 32; ++i) if (l2[i] > l2[bi]) bi = i; want |= 1u << bi; l2[bi] = -INFINITY; got |= 1u << RT[(size_t)tok * 4 + k].x; }
          lg[32] = (want != got) ? 1.f : 0.f; }
      __syncthreads();
      if (lg[32] != 0.f) err = 50.f; }
    dbg_report(F, err);
}
__device__ __forceinline__ void dbg_check_ssd(Frame& F) {
    if (F.bid >= 2) return;
    const int b = F.bid ? 20 : 5, h = F.bid ? 14 : 3, g = h >> 2, tid = F.tid, p = tid >> 3, ng = tid & 7;
    LAS float* red = (LAS float*)F.lds; LAS float* cv = red + 16;
    const bf16_t* XBC = (const bf16_t*)(F.ws + WS_XBC); const bf16_t* ZS = (const bf16_t*)(F.ws + WS_Z); const float* DT = (const float*)(F.outb + OUT_DT); const bf16_t* YG = (const bf16_t*)(F.ws + WS_Q);
    const float* cw = F.a->in[9]; const float* cb = F.a->in[10]; const float aneg = -expf(F.a->in[12][h]), dsk = F.a->in[13][h];
    const int mych = tid < 64 ? h * 64 + tid : (tid < 192 ? 1024 + g * 128 + (tid - 64) : 1536 + g * 128 + (tid - 192));
    float w0 = 0.f, w1 = 0.f, w2 = 0.f, w3 = 0.f, wb = 0.f;
    if (tid < 320) { w0 = cw[0 * 2048 + mych]; w1 = cw[1 * 2048 + mych]; w2 = cw[2 * 2048 + mych]; w3 = cw[3 * 2048 + mych]; wb = cb[mych]; }
    float x0 = 0.f, x1 = 0.f, x2 = 0.f;
    float hs[16];
#pragma unroll
    for (int i = 0; i < 16; ++i) hs[i] = 0.f;
    float emax = 0.f, ssq = 0.f, nbad = 0.f; int tmax = 0;
    for (int t = 0; t < SEQ; ++t) {
        const size_t tok = (size_t)b * SEQ + t;
        __syncthreads();
        if (DBG_HYP == 1 && (t & 63) == 0) { x0 = 0.f; x1 = 0.f; x2 = 0.f; }
        if (tid < 320) { const float x3 = bflo((unsigned)XBC[tok * 2048 + mych]); const float s = wb + w0 * x0 + w1 * x1 + w2 * x2 + w3 * x3; cv[tid] = s / (1.f + expf(-s)); x0 = x1; x1 = x2; x2 = x3; }
        __syncthreads();
        const float xv = cv[p], dt = DT[tok * 16 + h], dec = expf(dt * aneg);
        float yp = 0.f;
#pragma unroll
        for (int i = 0; i < 16; ++i) { const int n = ng * 16 + i; hs[i] = hs[i] * dec + dt * xv * cv[64 + n]; yp += cv[192 + n] * hs[i]; }
        yp += __shfl_xor(yp, 1); yp += __shfl_xor(yp, 2); yp += __shfl_xor(yp, 4);
        const float yv = (yp + xv * dsk) * bflo((unsigned)ZS[tok * 1024 + h * 64 + p]);
        const float yf = bflo((unsigned)YG[tok * 1024 + h * 64 + p]);
        if (ng == 0) { const float er = fabsf(yv - yf); if (er > emax) { emax = er; tmax = t; } ssq += yv * yv; if (er > 0.25f && (DBG_SUB < 5 || (DBG_SUB == 5 && (t & 63) == 0) || (DBG_SUB == 6 && (t & 63) == 1) || (DBG_SUB == 7 && (t & 63) == 32))) nbad += 1.f; }
    }
    const float rms = sqrtf(block_sum(F, ssq, red) / (64.f * SEQ)) + 1e-20f;
    const float M = block_max(F, emax, red);
    if (DBG_SUB == 0) dbg_report(F, M / rms);
    else if (DBG_SUB == 1) dbg_report(F, block_sum(F, nbad, red) / (64.f * SEQ));
    else if (DBG_SUB >= 5) dbg_report(F, block_sum(F, nbad, red) / (64.f * 32.f));
    else { __syncthreads(); if (ng == 0 && emax == M) red[12] = (float)(DBG_SUB == 2 ? ((tmax & 63) >> 1) : (DBG_SUB == 3 ? (tmax >> 6) : (p >> 1))); __syncthreads();
        if (F.bid == 0) dbg_report(F, powf(10.f, 2.f * (0.05f + 0.05f * red[12]) - 4.f)); }
}
__device__ __forceinline__ void dbg_check_attn(Frame& F) {
    if (F.bid >= 32) return;
    const int b = (F.bid * 7 + 3) & 31, pos = 300 + F.bid * 53, nadm = ((pos >> 6) + 1) * 64, tid = F.tid, lane = F.lane, hd = F.wave;
    const size_t tq = (size_t)b * SEQ + pos;
    LAS float* sc = (LAS float*)F.lds; LAS unsigned char* sel = (LAS unsigned char*)(sc + 2048); LAS float* lgt = (LAS float*)(sel + 2048); LAS float* red = lgt + 8 * 2048; LAS float* misc = red + 16;
    const bf16_t* IQ = (const bf16_t*)(F.outb + OUT_IQ); const bf16_t* IK = (const bf16_t*)(F.outb + OUT_IK); const float* IW = (const float*)(F.outb + OUT_IW);
    const bf16_t* Q = (const bf16_t*)(F.ws + WS_Q); const bf16_t* KV = (const bf16_t*)(F.outb + OUT_KV); const bf16_t* OA = (const bf16_t*)(F.outb + OUT_OA); const u64* MASK = (const u64*)(F.outb + OUT_MASK);
    __syncthreads();
    for (int k = tid; k < nadm; k += NTHR) { float s = 0.f;
        for (int hh = 0; hh < 8; ++hh) { float d = 0.f; for (int c = 0; c < 64; ++c) d += bflo((unsigned)IQ[tq * 512 + hh * 64 + c]) * bflo((unsigned)IK[((size_t)b * SEQ + k) * 64 + c]); s += fmaxf(d, 0.f) * IW[tq * 8 + hh]; }
        sc[k] = s + 0.0f; }
    __syncthreads();
    float nbad = 0.f;
    for (int k = tid; k < nadm; k += NTHR) { const float s = sc[k]; int rank = 0; for (int j = 0; j < nadm; ++j) { const float t = sc[j]; rank += (t > s || (t == s && j < k)) ? 1 : 0; }
        const unsigned char se = rank < 256 ? 1 : 0; sel[k] = se; const unsigned mb = (unsigned)((MASK[tq * 32 + (k >> 6)] >> (k & 63)) & 1ull); if (mb != se) nbad += 1.f; }
    __syncthreads();
    const float nbad_t = block_sum(F, nbad, red);
    LAS float* lw = lgt + hd * 2048; float mx = -INFINITY;
    for (int k = lane; k < nadm; k += 64) { float l = -INFINITY;
        if (sel[k]) { float d = 0.f; for (int c = 0; c < 128; ++c) d += bflo((unsigned)Q[tq * 1024 + hd * 128 + c]) * bflo((unsigned)KV[((size_t)b * SEQ + k) * 128 + c]);
            const int rel = k - pos, n = rel < 0 ? -rel : rel; const float nf = (float)(n > 1 ? n : 1); int large = 8 + (int)(logf(nf / 8.0f) / 2.7725887f * 8.0f); if (large > 15) large = 15;
            const int bucket = (rel > 0 ? 16 : 0) + (n < 8 ? n : large);
            l = d * 0.088388347648318440f + F.a->in[8][bucket * 8 + hd]; }
        lw[k] = l; mx = fmaxf(mx, l); }
#pragma unroll
    for (int o = 1; o < 64; o <<= 1) mx = fmaxf(mx, __shfl_xor(mx, o));
    float den = 0.f;
    for (int k = lane; k < nadm; k += 64) { const float pp = expf(lw[k] - mx); lw[k] = pp; den += pp; }
    den = wave_sum(den);
    float emax = 0.f, ssq = 0.f;
    for (int c2 = 0; c2 < 2; ++c2) { const int c = lane + 64 * c2; float o = 0.f; for (int k = 0; k < nadm; ++k) { const float pp = lw[k]; if (pp != 0.f) o += pp * bflo((unsigned)KV[((size_t)b * SEQ + k) * 128 + c]); }
        o /= den; const float of = bflo((unsigned)OA[tq * 1024 + hd * 128 + c]); emax = fmaxf(emax, fabsf(o - of)); ssq += o * o; }
    const float rms = sqrtf(block_sum(F, ssq, red) * (1.f / 1024.f)) + 1e-20f;
    float err = block_max(F, emax, red) / rms;
    (void)misc;
    if (nbad_t > 0.f) err = 10.f + nbad_t;
    dbg_report(F, err);
}
__device__ __forceinline__ void dbg_emit(Frame& F) {
    float* out = (float*)F.outb;
    for (size_t i = (size_t)F.bid * NTHR + F.tid; i < (size_t)NTOK * D / 4; i += (size_t)F.G * NTHR) ((f32x4*)out)[i] = (f32x4){0.f, 0.f, 0.f, 0.f};
    __syncthreads();
    if (F.bid == 0 && F.tid == 0) { const float e = __uint_as_float(__hip_atomic_load((unsigned*)(F.ws + WS_CTL) + CW_DBG, __ATOMIC_RELAXED, __HIP_MEMORY_SCOPE_AGENT));
        float code = (log10f(fmaxf(e, 1e-30f)) + 4.f) * 0.5f; code = fminf(fmaxf(rintf(code * 20.f) * 0.05f, 0.05f), 3.0f);
        out[0] = sqrtf(67108864.f * 1.01f * (powf(10.f, code) - 1.f)); }
}

#define CLK_BEGIN(k) unsigned long long clk_c##k = 0, clk_r##k = 0; if (DBG_CLOCK == (k) + 1) { clk_c##k = __builtin_amdgcn_s_memtime(); clk_r##k = __builtin_amdgcn_s_memrealtime(); }
#define CLK_END(k) if (DBG_CLOCK == (k) + 1 && F.bid == 0) { const float ghz = (float)(__builtin_amdgcn_s_memtime() - clk_c##k) / (float)(__builtin_amdgcn_s_memrealtime() - clk_r##k) * 0.1f; dbg_report(F, powf(10.f, 2.f * (rintf(ghz * 5.f) * 0.2f) - 4.f)); }
constexpr int NPHASE = 17;
__global__ void __launch_bounds__(NTHR, 2) fwd(Args args) {
    extern __shared__ __attribute__((aligned(16))) unsigned char lds_raw[];
    Frame F;
    F.lds = (LAS unsigned char*)lds_raw;
    F.tid = threadIdx.x; F.lane = F.tid & 63; F.wave = __builtin_amdgcn_readfirstlane(F.tid >> 6); F.G = gridDim.x; F.bid = blockIdx.x;
    F.a = &args;
    F.ws = args.ws; F.outb = (unsigned char*)args.out;
    volatile LAS unsigned* MISCW = (volatile LAS unsigned*)(F.lds + LDS_MISC);
    if (F.tid < 64) MISCW[F.tid] = 0u;
    __syncthreads();
    XcdBarrier bar; bar.bar = (unsigned*)(F.ws + WS_CTL) + CW_BAR; bar.x = 0; bar.st = nullptr;
#if MK_ONE
    bar = xcd_barrier_post((unsigned*)(F.ws + WS_CTL) + CW_BAR, MISCW + 8);
#define GRID_BAR() xcd_barrier(bar)
#else
#define GRID_BAR() do { } while (0)
#endif
    const int lo = args.ph_lo, hi = args.ph_hi;
#ifndef PHM
#define PHM (0xFFFFFFFFu & ~(DBG_NO_ATTN ? 0x30u : 0u) & ~(DBG_NO_SSD ? 0xC0u : 0u))
#endif
#define IN(k) (((PHM >> (k)) & 1u) && lo <= (k) && (k) < hi)
#define SEAM(k) do { if ((k) + 1 < hi) GRID_BAR(); } while (0)

    if (IN(0)) {
#pragma nounroll
        for (int rep = 0; rep < ((DBG_TWICE & 1u) ? 2 : 1); ++rep) { if (rep) GRID_BAR(); ph_prologue(F); }
        SEAM(0); }
    if (IN(1)) {
#pragma nounroll
        for (int rep = 0; rep < ((DBG_TWICE & 2u) ? 2 : 1); ++rep) { if (rep) GRID_BAR(); ph_ln1(F); }
        SEAM(1); }
    CLK_BEGIN(2);
    if (IN(2)) {
        EpiProj E{(bf16_t*)(F.ws + WS_Q), (bf16_t*)(F.outb + OUT_IQ), (bf16_t*)(F.ws + WS_Z), (bf16_t*)(F.ws + WS_XBC), (bf16_t*)(F.ws + WS_GA), (bf16_t*)(F.ws + WS_GB), (float*)(F.outb + OUT_MISC), 1.0f};
#if PROJ_FP8
        { SchedProj<2> S; S.o.init(NTOK, 12 * 256, F.G, F.bid); S.A = (const char*)(F.ws + WS_U8); S.Bt = (const char*)(F.ws + WS_WIN8);
          EpiProj E8 = E; E8.sc = MOE_INV;
          pg8::gemm_phase<EpiProj, SchedProj<2>, false, 512, true>(F.lds, S, E8);
          if (DBG_TWICE & 32768u) { GRID_BAR(); pg8::gemm_phase<EpiProj, SchedProj<2>, false, 512, true>(F.lds, S, E8); } }
        { SchedProj<1> S; S.o.init(NTOK, 15 * 256, F.G, F.bid); S.A = (const char*)(F.outb + OUT_U); S.Bt = (const char*)(F.ws + WS_WIN); if (DBG_KCLK) S.dbgw = (unsigned*)(F.ws + WS_CTL) + CW_DBG;
#if DBG_DRYPROJ
#pragma nounroll
          for (int rep = 0; rep < 2; ++rep) { EpiProj Ed = E; Ed.dry = rep == 0; SchedProj<1> Sd = S; Sd.fold = rep == 0 ? 7 : 0x7fffffff; pg8::gemm_phase<EpiProj, SchedProj<1>, false>(F.lds, Sd, Ed); if (rep == 0) GRID_BAR(); }
#else
          const unsigned long long w0 = DBG_WALL ? __builtin_amdgcn_s_memrealtime() : 0ull;
          pg8::gemm_phase<EpiProj, SchedProj<1>, false>(F.lds, S, E);
          if (DBG_WALL && F.bid == 0) { const float us = (float)(__builtin_amdgcn_s_memrealtime() - w0) * 0.01f; dbg_report(F, powf(10.f, 2.f * (rintf(us / 300.f * 10.f) * 0.1f) - 4.f)); }
#endif
          if (DBG_TWICE & 4u) { GRID_BAR(); pg8::gemm_phase<EpiProj, SchedProj<1>, false>(F.lds, S, E); } }
#else
        { SchedProj<0> S; S.o.init(NTOK, NPROJ, F.G, F.bid); S.A = (const char*)(F.outb + OUT_U); S.Bt = (const char*)(F.ws + WS_WIN);
          pg8::gemm_phase<EpiProj, SchedProj<0>, false>(F.lds, S, E);
          if (DBG_TWICE & 4u) { GRID_BAR(); pg8::gemm_phase<EpiProj, SchedProj<0>, false>(F.lds, S, E); } }
#endif
        SEAM(2);
    }
    CLK_END(2);
    if (IN(3)) { ph_misc(F); if (DBG_TWICE & 8u) { GRID_BAR(); ph_misc(F); } SEAM(3); }
    if (IN(4)) {
#pragma nounroll
        for (int rep = 0; rep < DBG_REP4; ++rep) { if (rep) GRID_BAR(); ph_index(F, rep + 1 < DBG_REP4 ? DBG_ABL4 : 0); }
        SEAM(4); }
    if (IN(5)) { ph_attn(F); if (DBG_TWICE & 32u) { GRID_BAR(); ph_attn(F); } SEAM(5); if (DBG_CHECK == 3) { dbg_check_attn(F); GRID_BAR(); } }
    if (IN(6)) {
#pragma nounroll
        for (int rep = 0; rep < DBG_REP6; ++rep) { if (rep) GRID_BAR(); ph_ssd2(F, rep + 1 < DBG_REP6 ? DBG_ABL6 : 0); }
        SEAM(6); if (DBG_CHECK == 2) { dbg_check_ssd(F); GRID_BAR(); } }
    if (IN(7)) { ph_gnorm(F); if (DBG_TWICE & 128u) { GRID_BAR(); ph_gnorm(F); } SEAM(7); }
    if (IN(8)) {
#if PA_FP8
        SchedPlainT<1024> S; S.o.init(NTOK, 1024, F.G, F.bid); S.A = (const char*)(F.outb + OUT_OA); S.Bt = (const char*)(F.ws + WS_WPA8);
        EpiGate<0> E{(const bf16_t*)(F.ws + WS_GA), nullptr, (bf16_t*)(F.ws + WS_Z), MOE_INV};
        pg8::gemm_phase<EpiGate<0>, SchedPlainT<1024>, false, 512, true>(F.lds, S, E);
#else
        SchedPlain S; S.o.init(NTOK, 1024, F.G, F.bid); S.A = (const char*)(F.outb + OUT_OA); S.Bt = (const char*)(F.ws + WS_WPA);
        EpiGate<0> E{(const bf16_t*)(F.ws + WS_GA), nullptr, (bf16_t*)(F.ws + WS_Z), 1.0f};
        pg8::gemm_phase<EpiGate<0>, SchedPlain, false>(F.lds, S, E);
#endif
    }
    if (IN(9)) {
#if PB_FP8
        SchedPlainT<1024> S; S.o.init(NTOK, 1024, F.G, F.bid); S.A = (const char*)(F.outb + OUT_OB8); S.Bt = (const char*)(F.ws + WS_WPB8);
        EpiGate<1> E{(const bf16_t*)(F.ws + WS_GB), (const bf16_t*)(F.ws + WS_Z), (bf16_t*)(F.ws + WS_XBC), MOE_INV};
        pg8::gemm_phase<EpiGate<1>, SchedPlainT<1024>, false, 512, true>(F.lds, S, E);
#else
        SchedPlain S; S.o.init(NTOK, 1024, F.G, F.bid); S.A = (const char*)(F.ws + WS_Q); S.Bt = (const char*)(F.ws + WS_WPB);
        EpiGate<1> E{(const bf16_t*)(F.ws + WS_GB), (const bf16_t*)(F.ws + WS_Z), (bf16_t*)(F.ws + WS_XBC), 1.0f};
        pg8::gemm_phase<EpiGate<1>, SchedPlain, false>(F.lds, S, E);
#endif
        SEAM(9);
    }
    if (IN(10)) {
        SchedPlain S; S.o.init(NTOK, 1024, F.G, F.bid); S.A = (const char*)(F.ws + WS_XBC); S.Bt = (const char*)(F.ws + WS_WOUT);
        EpiOut E{F.a->in[0], (const float*)(F.ws + WS_MOD), (bf16_t*)(F.ws + WS_VB)};
        pg8::gemm_phase<EpiOut, SchedPlain, false>(F.lds, S, E);
        if (DBG_TWICE & 1024u) { GRID_BAR(); pg8::gemm_phase<EpiOut, SchedPlain, false>(F.lds, S, E); }
        SEAM(10);
    }
    if (IN(11)) { if (DBG_TWICE & 2048u) { ph_router<true>(F); GRID_BAR(); } ph_router<false>(F); SEAM(11); }
#pragma unroll
    for (int hf = 0; hf < 2; ++hf) {
        const int p0 = 12 + hf * 2;
        if (IN(p0)) {
            if (hf == 1) ph_final<false>(F, 0);
            MoeTab T = moe_tables(F, hf);
            SchedMoe<8, true> S{T, F.G, F.bid, hf, (const char*)(F.ws + WS_U2), (const char*)(F.ws + WS_W1), (const u32x2*)(F.ws + WS_REG)};
            EpiMoe1 E{F.a->in[23], (bf16_t*)(F.ws + WS_ACT), 0};
            pg8::gemm_phase<EpiMoe1, SchedMoe<8, true>, true, MOE_RB / 2, MOE_FP8 != 0>(F.lds, S, E);
            if ((DBG_TWICE & 4096u) && hf == 0) { GRID_BAR(); pg8::gemm_phase<EpiMoe1, SchedMoe<8, true>, true, MOE_RB / 2, MOE_FP8 != 0>(F.lds, S, E); }
            if ((DBG_TWICE & 16384u) && hf == 0) { GRID_BAR(); EpiMoe1 Ed = E; Ed.dry = 1; pg8::gemm_phase<EpiMoe1, SchedMoe<8, true>, true, MOE_RB / 2, MOE_FP8 != 0>(F.lds, S, Ed); }
            SEAM(p0);
        }
        if (IN(p0 + 1)) {
            MoeTab T = moe_tables(F, hf);
            SchedMoe<4, false> S{T, F.G, F.bid, hf, (const char*)(F.ws + WS_ACT), (const char*)(F.ws + WS_W2), (const u32x2*)(F.ws + WS_REG)};
            EpiMoe2 E{F.a->in[25], (bf16_t*)(F.ws + WS_YB), (const u32x2*)(F.ws + WS_REG), T, hf, 0};
            if ((DBG_TWICE & 262144u) && hf == 0) { EpiMoe2 Ed = E; Ed.dry = DBG_DRYMODE; pg8::gemm_phase<EpiMoe2, SchedMoe<4, false>, false, MOE_RB / 2, MOE_FP8 != 0>(F.lds, S, Ed); GRID_BAR(); }
            pg8::gemm_phase<EpiMoe2, SchedMoe<4, false>, false, MOE_RB / 2, MOE_FP8 != 0>(F.lds, S, E);
            if ((DBG_TWICE & 8192u) && hf == 0) { GRID_BAR(); pg8::gemm_phase<EpiMoe2, SchedMoe<4, false>, false, MOE_RB / 2, MOE_FP8 != 0>(F.lds, S, E); }
            if ((DBG_TWICE & 131072u) && hf == 0) { GRID_BAR(); EpiMoe2 Ed = E; Ed.dry = 1; pg8::gemm_phase<EpiMoe2, SchedMoe<4, false>, false, MOE_RB / 2, MOE_FP8 != 0>(F.lds, S, Ed); }
            SEAM(p0 + 1);
            if (DBG_CHECK == 1 && hf == 1) { dbg_check_moe(F); GRID_BAR(); }
        }
    }
    if (IN(16)) { if (DBG_TWICE & 65536u) { ph_final<true>(F, 1); GRID_BAR(); } ph_final(F, 1); }
    if (DBG_CHECK || DBG_CLOCK || DBG_KCLK || DBG_WALL) { GRID_BAR(); dbg_emit(F); }
#undef IN
#undef SEAM
}

extern "C" void kernel_launch(void* const* d_in, const int* in_sizes, int n_in, void* d_out, int out_size, void* d_ws, size_t ws_size, hipStream_t stream) {
    static int grid = 0;
    if (grid == 0) {
        if (n_in != 28 || in_sizes[0] != NTOK * D || out_size != NTOK * D || ws_size < WS_END) { fprintf(stderr, "kernel_launch: shape mismatch (n_in %d, in0 %d, out %d, ws %zu)\n", n_in, n_in > 0 ? in_sizes[0] : -1, out_size, ws_size); grid = -1; return; }
        int dev = 0, cus = 0, per_cu = 0;
        if (hipGetDevice(&dev) != hipSuccess || hipDeviceGetAttribute(&cus, hipDeviceAttributeMultiprocessorCount, dev) != hipSuccess) { grid = -1; return; }
        if (hipFuncSetAttribute((const void*)fwd, hipFuncAttributeMaxDynamicSharedMemorySize, LDS_BYTES) != hipSuccess) { fprintf(stderr, "kernel_launch: hipFuncSetAttribute failed\n"); grid = -1; return; }
        if (hipOccupancyMaxActiveBlocksPerMultiprocessor(&per_cu, (const void*)fwd, NTHR, LDS_BYTES) != hipSuccess || per_cu < 1) fprintf(stderr, "kernel_launch: occupancy query reports %d\n", per_cu);
        (void)hipGetLastError();
        grid = cus;
    }
    if (grid < 0) return;
    if (hipMemsetAsync((char*)d_ws + WS_CTL, 0, CTL_ZERO_BYTES, stream) != hipSuccess) { fprintf(stderr, "kernel_launch: memset failed\n"); return; }
    Args a{};
    for (int i = 0; i < 28; ++i) a.in[i] = (const float*)d_in[i];
    a.out = (float*)d_out; a.ws = (unsigned char*)d_ws;
    const int nph = NPHASE < MK_PH_HI ? NPHASE : MK_PH_HI;
#if MK_ONE
    a.ph_lo = 0; a.ph_hi = nph;
    hipLaunchKernelGGL(fwd, dim3(grid), dim3(NTHR), LDS_BYTES, stream, a);
#else
    for (int p = 0; p < nph; ++p) { a.ph_lo = p; a.ph_hi = p + 1; hipLaunchKernelGGL(fwd, dim3(grid), dim3(NTHR), LDS_BYTES, stream, a); }
#endif
    const hipError_t le = hipPeekAtLastError();
    if (le != hipSuccess) fprintf(stderr, "kernel_launch: launch failed: %s\n", hipGetErrorName(le));
}
```

```cpp
#include <hip/hip_runtime.h>
#include <cstdio>
#include <cstdint>

#ifndef MK_ONE
#define MK_ONE 1
#endif
#ifndef DBG_NO_ATTN
#define DBG_NO_ATTN 0
#endif
#ifndef DBG_ATTN_ZERO
#define DBG_ATTN_ZERO 0
#endif
#ifndef DBG_IQ_TRUNC
#define DBG_IQ_TRUNC 0
#endif
#ifndef DBG_ROUTER_BF16
#define DBG_ROUTER_BF16 0
#endif
#ifndef DBG_CHECK
#define DBG_CHECK 0
#endif
#ifndef DBG_SKIP_BODY
#define DBG_SKIP_BODY 0
#endif
#ifndef DBG_SUB
#define DBG_SUB 0
#endif
#ifndef DBG_SSD_SYNC
#define DBG_SSD_SYNC 0
#endif
#ifndef DBG_HYP
#define DBG_HYP 0
#endif
#ifndef DBG_TWICE
#define DBG_DRYPROJ 0
#define DBG_ABL6 0
#define DBG_ABL5 0
#define DBG_REP5 1
#define DBG_ABL4 0
#define DBG_REP4 1
#define DBG_REP6 1
#define DBG_WALL 0
#define DBG_KCLK 0
#ifndef DBG_CLOCK
#define DBG_CLOCK 0
#endif
#define DBG_TWICE 0u
#endif
#ifndef DBG_DRYMODE
#define DBG_DRYMODE 2
#endif
#ifndef DBG_NO_SSD
#define DBG_NO_SSD 0
#endif
#ifndef DBG_NO_MOE
#define DBG_NO_MOE 0
#endif
#ifndef MOE_FP8
#define MOE_FP8 1
#endif
#ifndef PROJ_FP8
#define PROJ_FP8 1
#endif
#ifndef PA_FP8
#define PA_FP8 1
#endif
#ifndef PB_FP8
#define PB_FP8 0
#endif
#ifndef ATT2
#define GATE_U8 1
#define ATT_LMFMA 1
#define ATT_OT 1
#define ATT2 1
#endif
#ifndef MK_PH_HI
#define MK_PH_HI 99
#endif

#define LAS __attribute__((address_space(3)))
#define GAS __attribute__((address_space(1)))
typedef unsigned short bf16_t;
typedef short bf16x8 __attribute__((ext_vector_type(8)));
typedef short s16x4 __attribute__((ext_vector_type(4)));
typedef float f32x2 __attribute__((ext_vector_type(2)));
typedef float f32x4 __attribute__((ext_vector_type(4)));
typedef float f32x16 __attribute__((ext_vector_type(16)));
typedef unsigned u32x2 __attribute__((ext_vector_type(2)));
typedef unsigned u32x4 __attribute__((ext_vector_type(4)));
typedef unsigned long long u64;

constexpr int NB = 32, SEQ = 2048, D = 1024, NTOK = NB * SEQ;
constexpr int NWAVES = 8, NTHR = 512;
constexpr int NPROJ = 6912;
constexpr int NEXP = 32, HALF_TOK = NTOK / 2, REG_CAP = HALF_TOK;
constexpr int ACT_ROWS = HALF_TOK * 4 + NEXP * 256;
constexpr float LN_EPS = 1e-5f;
constexpr float DN_ALPHA = 1.189207115002721f;
constexpr float LOG2E = 1.4426950408889634f;

constexpr size_t MiB = 1u << 20;
constexpr size_t WS_CTL = 0, CTL_ZERO_BYTES = 1 * MiB;
constexpr size_t WS_MOD = 1 * MiB;
constexpr size_t WS_BIAST = 1 * MiB + 800 * 1024;
constexpr size_t WS_WIN = 2 * MiB;
constexpr size_t WS_WPA = 16 * MiB, WS_WPB = 18 * MiB, WS_WOUT = 20 * MiB;
constexpr size_t WS_W1 = 24 * MiB;
constexpr size_t WS_U8 = 88 * MiB;
constexpr size_t WS_W2 = 152 * MiB;
constexpr size_t WS_WIN8 = 184 * MiB;
constexpr size_t WS_WPA8 = 192 * MiB;
constexpr size_t WS_WPB8 = 194 * MiB;
constexpr size_t OUT_OB8 = 192 * MiB;
constexpr size_t WS_Q = 216 * MiB;
constexpr size_t WS_Z = 344 * MiB;
constexpr size_t WS_XBC = 472 * MiB;
constexpr size_t WS_GA = 728 * MiB, WS_GB = 856 * MiB;
constexpr size_t WS_U2 = 216 * MiB;
constexpr size_t WS_REG = 344 * MiB;
constexpr size_t WS_ACT = 360 * MiB;
constexpr size_t WS_YB = 632 * MiB;
constexpr size_t WS_X1B = 496 * MiB;
constexpr size_t WS_VB = 744 * MiB;
constexpr size_t WS_END = 984 * MiB;
constexpr size_t WS_DBG = 889 * MiB;
constexpr size_t OUT_U = 0, OUT_MISC = 128 * MiB, OUT_IQ = 192 * MiB;
constexpr size_t OUT_KV = 0, OUT_IK = 16 * MiB, OUT_IW = 24 * MiB, OUT_DT = 26 * MiB, OUT_MASK = 32 * MiB, OUT_OA = 64 * MiB;
constexpr int CW_BAR = 4096, CW_CNT = 16384, CW_WQ = 22528, CW_DBG = 24576;

constexpr int LDS_BYTES = 160 * 1024;
constexpr int LDS_AUX = 131072;
constexpr int LDS_MISC = LDS_BYTES - 256;

#define LDS_WAIT() asm volatile("s_waitcnt lgkmcnt(0)" ::: "memory")
#define GAS __attribute__((address_space(1)))
#define VM_WAIT() asm volatile("s_waitcnt vmcnt(0)" ::: "memory")
#define SBAR() __builtin_amdgcn_sched_barrier(0)
typedef __bf16 bf16x2_t __attribute__((ext_vector_type(2)));
__device__ __forceinline__ unsigned cvt_pk_bf16(float lo, float hi) { f32x2 f = {lo, hi}; bf16x2_t v = __builtin_convertvector(f, bf16x2_t); return __builtin_bit_cast(unsigned, v); }
__device__ __forceinline__ float bflo(unsigned w) { return __uint_as_float(w << 16); }
__device__ __forceinline__ float bfhi(unsigned w) { return __uint_as_float(w & 0xffff0000u); }
__device__ __forceinline__ u32x4 pack8(f32x4 a, f32x4 b) { u32x4 w; w.x = cvt_pk_bf16(a[0], a[1]); w.y = cvt_pk_bf16(a[2], a[3]); w.z = cvt_pk_bf16(b[0], b[1]); w.w = cvt_pk_bf16(b[2], b[3]); return w; }
constexpr int MOE_RB = MOE_FP8 ? 1024 : 2048;
constexpr float MOE_WSC = MOE_FP8 ? 64.0f : 1.0f, MOE_INV = 1.0f / MOE_WSC;
__device__ __forceinline__ u32x2 pack8_fp8(f32x4 a, f32x4 b) { int lo = 0, hi = 0;
    lo = __builtin_amdgcn_cvt_pk_fp8_f32(a[0], a[1], lo, false); lo = __builtin_amdgcn_cvt_pk_fp8_f32(a[2], a[3], lo, true);
    hi = __builtin_amdgcn_cvt_pk_fp8_f32(b[0], b[1], hi, false); hi = __builtin_amdgcn_cvt_pk_fp8_f32(b[2], b[3], hi, true);
    u32x2 r; r.x = (unsigned)lo; r.y = (unsigned)hi; return r; }
__device__ __forceinline__ void unpack8(u32x4 w, f32x4& a, f32x4& b) { a[0] = bflo(w.x); a[1] = bfhi(w.x); a[2] = bflo(w.y); a[3] = bfhi(w.y); b[0] = bflo(w.z); b[1] = bfhi(w.z); b[2] = bflo(w.w); b[3] = bfhi(w.w); }
__device__ __forceinline__ float dpp_scan_add(float v) {
#define DPPF(x, ctrl, rm) __builtin_bit_cast(float, __builtin_amdgcn_update_dpp(0, __builtin_bit_cast(int, (x)), (ctrl), (rm), 0xf, false))
    v += DPPF(v, 0x111, 0xf); v += DPPF(v, 0x112, 0xf); v += DPPF(v, 0x114, 0xf); v += DPPF(v, 0x118, 0xf);
    v += DPPF(v, 0x142, 0xa);
    v += DPPF(v, 0x143, 0xc);
#undef DPPF
    return v;
}
__device__ __forceinline__ unsigned dpp_half_sums_u32(unsigned v) {
#define DPPU(x, ctrl, rm) (unsigned)__builtin_amdgcn_update_dpp(0, (int)(x), (ctrl), (rm), 0xf, false)
    v += DPPU(v, 0x111, 0xf); v += DPPU(v, 0x112, 0xf); v += DPPU(v, 0x114, 0xf); v += DPPU(v, 0x118, 0xf); v += DPPU(v, 0x142, 0xa);
#undef DPPU
    return v;
}
__device__ __forceinline__ float dpp_half_sums_f32(float v) {
#define DPPF(x, ctrl, rm) __builtin_bit_cast(float, __builtin_amdgcn_update_dpp(0, __builtin_bit_cast(int, (x)), (ctrl), (rm), 0xf, false))
    v += DPPF(v, 0x111, 0xf); v += DPPF(v, 0x112, 0xf); v += DPPF(v, 0x114, 0xf); v += DPPF(v, 0x118, 0xf); v += DPPF(v, 0x142, 0xa);
#undef DPPF
    return v;
}
__device__ __forceinline__ float wave_sum(float v) { v = dpp_scan_add(v); return __builtin_bit_cast(float, __builtin_amdgcn_readlane(__builtin_bit_cast(int, v), 63)); }
__device__ __forceinline__ float fast_rcp(float x) { return __builtin_amdgcn_rcpf(x); }
__device__ __forceinline__ float sigmoid_f(float x) { return fast_rcp(1.0f + __expf(-x)); }
__device__ __forceinline__ float silu_f(float x) { return x * sigmoid_f(x); }

#define XB_TMO      128
#define XB_XCNT(j)  (256  + 64 * (j))
#define XB_XSUB(j)  (1280 + 64 * (j))
#define XB_XGEN(j)  (2304 + 64 * (j))
#define XB_TOP      3328
#define XB_TOPGEN   3392
#define XCD_BAR_WORDS 3456
#define XB_SPIN_CAP (1u << 18)
__device__ __forceinline__ unsigned xb_ld(unsigned* p)              { return __hip_atomic_load(p, __ATOMIC_RELAXED, __HIP_MEMORY_SCOPE_AGENT); }
__device__ __forceinline__ unsigned xb_add(unsigned* p, unsigned v) { return __hip_atomic_fetch_add(p, v, __ATOMIC_RELAXED, __HIP_MEMORY_SCOPE_AGENT); }
__device__ __forceinline__ unsigned xb_xcc_id() { return (unsigned)__builtin_amdgcn_s_getreg((3 << 11) | 20) & 0xFu; }
#define XB_SPIN(cond, bar) do { unsigned _sp = 0; while (cond) { __builtin_amdgcn_s_sleep(1); \
    if ((++_sp & 255u) == 0u) { if (xb_ld(&(bar)[XB_TMO])) break; if (_sp > XB_SPIN_CAP) { atomicAdd(&(bar)[XB_TMO], 1u); break; } } } } while (0)
struct XcdBarrier { unsigned* bar; unsigned x; volatile LAS unsigned* st; };
__device__ __forceinline__ XcdBarrier xcd_barrier_post(unsigned* bar, volatile LAS unsigned* st) {
    XcdBarrier b; b.bar = bar; b.x = xb_xcc_id(); b.st = st;
    if (threadIdx.x == 0) (void)xb_add(&bar[XB_XCNT(b.x)], 1u);
    return b;
}
__device__ __forceinline__ void xcd_barrier_complete(unsigned* bar, unsigned x, unsigned& nloc, unsigned& nx) {
    const unsigned G = gridDim.x * gridDim.y * gridDim.z;
    unsigned sum, cnt, mine, sp = 0u;
    for (;;) {
        sum = 0u; cnt = 0u;
#pragma nounroll
        for (unsigned j = 0; j < 16; ++j) { const unsigned c = xb_ld(&bar[XB_XCNT(j)]); sum += c; cnt += (c > 0u) ? 1u : 0u; }
        if (sum == G) break;
        __builtin_amdgcn_s_sleep(1);
        if ((++sp & 255u) == 0u) { if (xb_ld(&bar[XB_TMO])) break; if (sp > XB_SPIN_CAP) { atomicAdd(&bar[XB_TMO], 1u); break; } }
    }
    mine = xb_ld(&bar[XB_XCNT(x)]);
    nloc = mine > 0u ? mine : 1u; nx = cnt > 0u ? cnt : 1u;
}
__device__ __forceinline__ void xcd_barrier(const XcdBarrier& b) {
    asm volatile("s_waitcnt vmcnt(0)" ::: "memory");
    __syncthreads();
    if (threadIdx.x == 0) {
        unsigned* bar = b.bar;
        __builtin_amdgcn_s_waitcnt(0);
        unsigned nloc = b.st[0], nx = b.st[1];
        if (nloc == 0u) { xcd_barrier_complete(bar, b.x, nloc, nx); b.st[0] = nloc; b.st[1] = nx; }
        const unsigned old = xb_add(&bar[XB_XSUB(b.x)], 1u);
        const unsigned gen = old / nloc;
        if (old + 1u == (gen + 1u) * nloc) {
            __builtin_amdgcn_fence(__ATOMIC_RELEASE, "agent");
            asm volatile("s_waitcnt vmcnt(0)" ::: "memory");
            const unsigned og = xb_add(&bar[XB_TOP], 1u);
            const unsigned tg = og / nx;
            if (og + 1u == (tg + 1u) * nx) xb_add(&bar[XB_TOPGEN], 1u);
            else XB_SPIN(xb_ld(&bar[XB_TOPGEN]) == tg, bar);
            __builtin_amdgcn_fence(__ATOMIC_ACQUIRE, "agent");
            xb_add(&bar[XB_XGEN(b.x)], 1u);
            asm volatile("s_waitcnt vmcnt(0)" ::: "memory");
        } else {
            XB_SPIN(xb_ld(&bar[XB_XGEN(b.x)]) == gen, bar);
            __builtin_amdgcn_fence(__ATOMIC_ACQUIRE, "agent");
            asm volatile("s_waitcnt vmcnt(0)" ::: "memory");
        }
    }
    __syncthreads();
}

namespace pg8 {
constexpr int BM = 256, BK = 64, HALF = 128, HTB = HALF * BK * 2, STAGE_BYTES = 8 * HTB, NXCD = 8, WGM = 8, KD = 1024;
__host__ __device__ __forceinline__ int lds_byte(int r, int c) { const int st = (r >> 4) * 2 + (c >> 5), rr = r & 15, cc = c & 31, ob = rr * 64 + cc * 2; return st * 1024 + (ob ^ (((ob >> 9) & 1) << 5)); }
__host__ __device__ __forceinline__ void stage_rc(int b, int& R, int& C) { const int st = b / 1024, sb = b % 1024, swz = sb ^ (((sb >> 9) & 1) << 5); R = (st >> 1) * 16 + swz / 64; C = (st & 1) * 32 + (swz % 64) / 2; }
__host__ __device__ __forceinline__ int perm32(int rho) { const int n = rho >> 4, i = rho & 15; return 8 * (i >> 2) + 4 * n + (i & 3); }
struct Unit { int pm, pn, ex; };
struct StaticOrder {
    int nM, nN, nwg, G, c;
    __device__ void init(int M, int N, int G_, int c_) { nM = M / BM; nN = N / BM; nwg = nM * nN; G = G_; c = c_; }
    __device__ bool next(int i, Unit& u) const {
        const long L = (long)i * G + c; if (L >= nwg) return false;
        int wgid = (int)L; { const int q = nwg / NXCD, r = nwg % NXCD, xcd = wgid % NXCD, off = wgid / NXCD; wgid = (xcd < r ? xcd * (q + 1) : r * (q + 1) + (xcd - r) * q) + off; }
        const int nig = WGM * nN, gid = wgid / nig, fm = gid * WGM, gsz = (nM - fm) < WGM ? (nM - fm) : WGM;
        u.pm = fm + ((wgid % nig) % gsz); u.pn = (wgid % nig) / gsz; u.ex = 0; return true;
    }
};
typedef int i32x8 __attribute__((ext_vector_type(8)));
typedef int i32x4v __attribute__((ext_vector_type(4)));
template <class T> __device__ __forceinline__ auto dbgw_of(const T& s, int) -> decltype(s.dbgw) { return s.dbgw; }
template <class T> __device__ __forceinline__ unsigned* dbgw_of(const T&, long) { return nullptr; }
template <class Epi, class Sched, bool GATHER, int KE = 1024, bool FP8 = false>
__device__ __forceinline__ void gemm_phase(LAS unsigned char* lds, const Sched& S, const Epi& E) {
    int tid = threadIdx.x; asm volatile("" : "+v"(tid));
    const int wid = __builtin_amdgcn_readfirstlane(tid >> 6), lane = tid & 63, wr = wid >> 2, wc = wid & 3, fr = lane & 15, fq = lane >> 4;
    constexpr int K = KE, nt = K / BK;
    unsigned voffA[2], voffB[2]; int Rr[2], Cc[2];
#pragma unroll
    for (int i = 0; i < 2; ++i) { int R, C; stage_rc(tid * 16 + i * 8192, R, C); const int Rb = Epi::PERM ? ((R & ~31) + perm32(R & 31)) : R;
        voffA[i] = (unsigned)(R * K + C) * 2u; voffB[i] = (unsigned)(Rb * K + C) * 2u; Rr[i] = R; Cc[i] = C; }
    constexpr size_t kstep = (size_t)(BK * 2);
    constexpr size_t hstep = (size_t)HALF * K * 2;
    const unsigned ldsw = (unsigned)wid * 1024u;
    const int aoff = lds_byte(wr * 64 + fr, fq * 8), boff = lds_byte(wc * 32 + fr, fq * 8);
#define PG8_SA(b, h) (((b) * 2 + (h)) * HTB)
#define PG8_SB(b, h) ((4 + (b) * 2 + (h)) * HTB)
#define PG8_STAGE(bufoff, gbase, voff) do { _Pragma("unroll") for (int _i = 0; _i < 2; ++_i) \
        __builtin_amdgcn_global_load_lds((const unsigned*)((const char*)(gbase) + (voff)[_i]), (LAS unsigned*)(lds + (bufoff) + ldsw + _i * 8192), 16, 0, 0); } while (0)
#define PG8_STAGE_A(bufoff, gb, h, o0, o1) do { if constexpr (GATHER) { const unsigned _ko = (unsigned)((gb) - gA0); unsigned _o[2]; \
            if ((h) == 0) { _o[0] = (o0)[0] + _ko; _o[1] = (o0)[1] + _ko; } else { _o[0] = (o1)[0] + _ko; _o[1] = (o1)[1] + _ko; } PG8_STAGE(bufoff, gA0, _o); } \
        else { PG8_STAGE(bufoff, (gb) + (h) * hstep, voffA); } } while (0)
#define PG8_LD8(p) __builtin_shufflevector(*(const LAS i32x4v*)(p), *(const LAS i32x4v*)((p) + 1024), 0, 1, 2, 3, 4, 5, 6, 7)
#define PG8_LDA(dst, b, h) do { if constexpr (FP8) { _Pragma("unroll") for (int m = 0; m < 4; ++m) dst##8[m] = PG8_LD8(lds + PG8_SA(b, h) + aoff + m * 2048); } \
        else { _Pragma("unroll") for (int m = 0; m < 4; ++m) _Pragma("unroll") for (int k = 0; k < 2; ++k) dst[m][k] = *(const LAS bf16x8*)(lds + PG8_SA(b, h) + aoff + m * 2048 + k * 1024); } } while (0)
#define PG8_LDB(dst, b, h) do { if constexpr (FP8) { _Pragma("unroll") for (int n = 0; n < 2; ++n) dst##8[n] = PG8_LD8(lds + PG8_SB(b, h) + boff + n * 2048); } \
        else { _Pragma("unroll") for (int n = 0; n < 2; ++n) _Pragma("unroll") for (int k = 0; k < 2; ++k) dst[n][k] = *(const LAS bf16x8*)(lds + PG8_SB(b, h) + boff + n * 2048 + k * 1024); } } while (0)
#define PG8_MMA(ai, bj, At, Bt) do { __builtin_amdgcn_s_setprio(1); if constexpr (FP8) { _Pragma("unroll") for (int m = 0; m < 4; ++m) _Pragma("unroll") for (int n = 0; n < 2; ++n) \
            asm volatile("v_mfma_scale_f32_16x16x128_f8f6f4 %0, %1, %2, %0, %3, %3 op_sel_hi:[0,0,0]" : "+v"(acc[ai][bj][m][n]) : "v"(Bt##8[n]), "v"(At##8[m]), "v"(sc127)); } \
        else { _Pragma("unroll") for (int m = 0; m < 4; ++m) _Pragma("unroll") for (int n = 0; n < 2; ++n) _Pragma("unroll") for (int k = 0; k < 2; ++k) \
            acc[ai][bj][m][n] = __builtin_amdgcn_mfma_f32_16x16x32_bf16(Bt[n][k], At[m][k], acc[ai][bj][m][n], 0, 0, 0); } __builtin_amdgcn_s_setprio(0); } while (0)
#define PG8_WAIT_V(n) asm volatile("s_waitcnt vmcnt(" #n ")" ::: "memory")
#define PG8_WAIT_L(n) asm volatile("s_waitcnt lgkmcnt(" #n ")" ::: "memory")
#define PG8_BAR __builtin_amdgcn_s_barrier()
#define PG8_SCHED __builtin_amdgcn_sched_barrier(0)
    Unit cur, nxt; int ui = 0; unsigned long long kcsum = 0; int kcn = 0; const unsigned long long kph0 = (DBG_KCLK && !FP8 && !GATHER) ? __builtin_amdgcn_s_memtime() : 0ull;
    if (!S.next(0, cur)) return;
    f32x4 acc[2][2][4][2];
#pragma unroll
    for (int a = 0; a < 2; ++a)
#pragma unroll
        for (int b = 0; b < 2; ++b)
#pragma unroll
            for (int m = 0; m < 4; ++m)
#pragma unroll
                for (int n = 0; n < 2; ++n) acc[a][b][m][n] = (f32x4){0.f, 0.f, 0.f, 0.f};
    const int sc127 = 0x7f7f7f7f;
    bf16x8 At[4][2], B0[2][2], B1[2][2]; i32x8 At8[4], B08[2], B18[2];
    const char* cA = S.a_base(cur); const char* cB = S.b_base(cur);
    const char* const gA0 = cA;
    unsigned cv0[2] = {0u, 0u}, cv1[2] = {0u, 0u}, nv0[2] = {0u, 0u}, nv1[2] = {0u, 0u};
    if constexpr (GATHER) S.a_offs(cur, Rr, Cc, cv0, cv1);
    PG8_STAGE(PG8_SB(0, 0), cB, voffB); PG8_STAGE_A(PG8_SA(0, 0), cA, 0, cv0, cv1); PG8_STAGE(PG8_SB(0, 1), cB + hstep, voffB); PG8_STAGE_A(PG8_SA(0, 1), cA, 1, cv0, cv1);
    if (wr == 1) PG8_BAR;
    PG8_WAIT_V(4); PG8_BAR;
    PG8_STAGE(PG8_SB(1, 0), cB + kstep, voffB); PG8_STAGE_A(PG8_SA(1, 0), cA + kstep, 0, cv0, cv1); PG8_STAGE(PG8_SB(1, 1), cB + hstep + kstep, voffB);
    PG8_WAIT_V(6); PG8_BAR;
    for (;;) {
        const bool has_next = S.next(ui + 1, nxt);
        const char* nA = has_next ? S.a_base(nxt) : cA; const char* nB = has_next ? S.b_base(nxt) : cB;
        if constexpr (GATHER) { if (has_next) S.a_offs(nxt, Rr, Cc, nv0, nv1); else { nv0[0] = cv0[0]; nv0[1] = cv0[1]; nv1[0] = cv1[0]; nv1[1] = cv1[1]; } }
        unsigned long long kc0 = 0; if constexpr (DBG_KCLK && !FP8 && !GATHER) kc0 = __builtin_amdgcn_s_memtime();
#pragma nounroll
        for (int t = 0; t < nt; t += 2) {
            const bool last = (t == nt - 2);
            const char* a1 = cA + (size_t)(t + 1) * kstep;
            const char* a2 = last ? nA : cA + (size_t)(t + 2) * kstep; const char* b2 = last ? nB : cB + (size_t)(t + 2) * kstep;
            const char* a3 = a2 + kstep; const char* b3 = b2 + kstep;
            unsigned s0[2], s1[2];
            if constexpr (GATHER) { s0[0] = last ? nv0[0] : cv0[0]; s0[1] = last ? nv0[1] : cv0[1]; s1[0] = last ? nv1[0] : cv1[0]; s1[1] = last ? nv1[1] : cv1[1]; } else { s0[0] = s0[1] = s1[0] = s1[1] = 0u; }
            PG8_LDB(B0, 0, 0); PG8_SCHED; PG8_LDA(At, 0, 0); PG8_STAGE_A(PG8_SA(1, 1), a1, 1, cv0, cv1);
            PG8_WAIT_L(8); PG8_BAR; PG8_WAIT_L(0); PG8_MMA(0, 0, At, B0); PG8_BAR; PG8_SCHED;
            PG8_LDB(B1, 0, 1); PG8_STAGE(PG8_SB(0, 0), b2, voffB);
            PG8_BAR; PG8_WAIT_L(0); PG8_MMA(0, 1, At, B1); PG8_BAR;
            PG8_LDA(At, 0, 1); PG8_STAGE_A(PG8_SA(0, 0), a2, 0, s0, s1);
            PG8_BAR; PG8_WAIT_L(0); PG8_MMA(1, 0, At, B0); PG8_BAR; PG8_SCHED;
            PG8_STAGE(PG8_SB(0, 1), b2 + hstep, voffB);
            PG8_WAIT_V(6); PG8_BAR; PG8_MMA(1, 1, At, B1); PG8_BAR;
            PG8_LDB(B0, 1, 0); PG8_SCHED; PG8_LDA(At, 1, 0); PG8_STAGE_A(PG8_SA(0, 1), a2, 1, s0, s1);
            PG8_WAIT_L(8); PG8_BAR; PG8_WAIT_L(0); PG8_MMA(0, 0, At, B0); PG8_BAR; PG8_SCHED;
            PG8_LDB(B1, 1, 1); PG8_STAGE(PG8_SB(1, 0), b3, voffB);
            PG8_BAR; PG8_WAIT_L(0); PG8_MMA(0, 1, At, B1); PG8_BAR;
            PG8_LDA(At, 1, 1); PG8_STAGE_A(PG8_SA(1, 0), a3, 0, s0, s1);
            PG8_BAR; PG8_WAIT_L(0); PG8_MMA(1, 0, At, B0); PG8_BAR; PG8_SCHED;
            PG8_STAGE(PG8_SB(1, 1), b3 + hstep, voffB);
            PG8_WAIT_V(6); PG8_BAR; PG8_MMA(1, 1, At, B1); PG8_BAR;
        }
        if constexpr (DBG_KCLK && !FP8 && !GATHER) { kc0 = __builtin_amdgcn_s_memtime(); }
        if constexpr (FP8) asm volatile("s_nop 15\n\ts_nop 15" ::: "memory");
        E(acc, cur, wr, wc, fr, fq);
        if constexpr (DBG_KCLK && !FP8 && !GATHER) { asm volatile("s_waitcnt vmcnt(0)" ::: "memory"); kcsum += __builtin_amdgcn_s_memtime() - kc0; ++kcn; }
        if (!has_next) break;
#pragma unroll
        for (int a = 0; a < 2; ++a)
#pragma unroll
            for (int b = 0; b < 2; ++b)
#pragma unroll
                for (int m = 0; m < 4; ++m)
#pragma unroll
                    for (int n = 0; n < 2; ++n) acc[a][b][m][n] = (f32x4){0.f, 0.f, 0.f, 0.f};
        cur = nxt; cA = nA; cB = nB; ++ui;
        if constexpr (GATHER) { cv0[0] = nv0[0]; cv0[1] = nv0[1]; cv1[0] = nv1[0]; cv1[1] = nv1[1]; }
    }
    PG8_WAIT_V(0);
    if (wr == 0) PG8_BAR;
    PG8_BAR;
    if constexpr (DBG_KCLK && !FP8 && !GATHER) { unsigned* dw = dbgw_of(S, 0); if (dw && tid == 0) { kcsum = __builtin_amdgcn_s_memtime() - kph0; const float cpk = (float)kcsum / (float)(kcn) * (1.f / 40000.f); atomicMax(dw, __float_as_uint(powf(10.f, 2.f * (rintf(cpk * 10.f) * 0.1f) - 4.f))); } }
#undef PG8_SA
#undef PG8_SB
#undef PG8_STAGE
#undef PG8_STAGE_A
#undef PG8_LDA
#undef PG8_LDB
#undef PG8_MMA
#undef PG8_LD8
#undef PG8_WAIT_V
#undef PG8_WAIT_L
#undef PG8_BAR
#undef PG8_SCHED
}
}
using pg8::Unit;
typedef f32x4 AccT[2][2][4][2];

struct Args { const float* in[28]; float* out; unsigned char* ws; int ph_lo, ph_hi, pad0, pad1; };
struct Frame {
    LAS unsigned char* lds;
    int tid, lane, wave, G, bid;
    const struct Args* a;
    unsigned char* ws; unsigned char* outb;
};
template <int RB = 2048> struct SchedPlainT {
    pg8::StaticOrder o; const char* A; const char* Bt;
    __device__ __forceinline__ bool next(int i, Unit& u) const { return o.next(i, u); }
    __device__ __forceinline__ const char* a_base(const Unit& u) const { return A + (size_t)u.pm * (256 * RB); }
    __device__ __forceinline__ const char* b_base(const Unit& u) const { return Bt + (size_t)u.pn * (256 * RB); }
    __device__ __forceinline__ void a_offs(const Unit&, const int*, const int*, unsigned (&)[2], unsigned (&)[2]) const {}
};
typedef SchedPlainT<2048> SchedPlain;
template <int MODE> struct SchedProj {
    pg8::StaticOrder o; const char* A; const char* Bt; int fold = 0x7fffffff; unsigned* dbgw = nullptr;
    static constexpr int RB = MODE == 2 ? 1024 : 2048;
    __device__ __forceinline__ bool next(int i, Unit& u) const { if (!o.next(i, u)) return false; const int r = u.pn;
        if (MODE == 1) u.pn = 4 + r;
        if (MODE == 2) u.pn = r < 4 ? r : 15 + r;
        return true; }
    __device__ __forceinline__ const char* a_base(const Unit& u) const { return A + (size_t)(DBG_DRYPROJ ? (u.pm & fold) : u.pm) * (256 * RB); }
    __device__ __forceinline__ const char* b_base(const Unit& u) const { return Bt + (size_t)u.pn * (256 * RB); }
    __device__ __forceinline__ void a_offs(const Unit&, const int*, const int*, unsigned (&)[2], unsigned (&)[2]) const {}
};

struct EpiProj {
    static constexpr bool PERM = true;
    bf16_t *Q, *IQ, *Z, *XBC, *GA, *GB; float* MISC; float sc; int dry = 0;
    __device__ __forceinline__ void operator()(const AccT& acc, const Unit& u, int wr, int wc, int fr, int fq) const {
        const int pn = u.pn, row0 = u.pm * 256 + wr * 64 + fr, c8 = wc * 32 + 8 * fq;
        if (pn == 6) {
#pragma unroll
            for (int ai = 0; ai < 2; ++ai)
#pragma unroll
                for (int m = 0; m < 4; ++m) { float* rp = MISC + (size_t)(row0 + ai * 128 + m * 16) * 256 + c8;
#pragma unroll
                    for (int bj = 0; bj < 2; ++bj) { if (DBG_DRYPROJ && dry && acc[ai][bj][m][0][0] != 1.2345e-33f) continue; *(f32x4*)(rp + bj * 128) = acc[ai][bj][m][0]; *(f32x4*)(rp + bj * 128 + 4) = acc[ai][bj][m][1]; } }
            return;
        }
        bf16_t* base; int ldc, colt, act = 0;
        if (pn < 4) { base = Q; ldc = 1024; colt = pn * 256; }
        else if (pn < 6) { base = IQ; ldc = 512; colt = (pn - 4) * 256; }
        else if (pn < 11) { base = Z; ldc = 1024; colt = (pn - 7) * 256; act = 1; }
        else if (pn < 19) { base = XBC; ldc = 2048; colt = (pn - 11) * 256; }
        else if (pn < 23) { base = GA; ldc = 1024; colt = (pn - 19) * 256; act = 2; }
        else { base = GB; ldc = 1024; colt = (pn - 23) * 256; act = 2; }
#pragma unroll
        for (int ai = 0; ai < 2; ++ai)
#pragma unroll
            for (int m = 0; m < 4; ++m) { bf16_t* rp = base + (size_t)(row0 + ai * 128 + m * 16) * ldc + colt + c8;
#pragma unroll
                for (int bj = 0; bj < 2; ++bj) { f32x4 v0 = acc[ai][bj][m][0] * sc, v1 = acc[ai][bj][m][1] * sc;
                    if (act == 1) {
#pragma unroll
                        for (int j = 0; j < 4; ++j) { v0[j] = silu_f(v0[j]); v1[j] = silu_f(v1[j]); } }
                    if (act == 2) {
#pragma unroll
                        for (int j = 0; j < 4; ++j) { v0[j] = sigmoid_f(v0[j]); v1[j] = sigmoid_f(v1[j]); } }
                    if (GATE_U8 && act == 2) {
                        unsigned lo = 0u, hi = 0u;
#pragma unroll
                        for (int j = 0; j < 4; ++j) { lo = __builtin_amdgcn_cvt_pk_u8_f32(__builtin_rintf(v0[j] * 255.f), j, lo); hi = __builtin_amdgcn_cvt_pk_u8_f32(__builtin_rintf(v1[j] * 255.f), j, hi); }
                        u32x2 q; q.x = lo; q.y = hi;
                        *(u32x2*)((unsigned char*)base + (size_t)(row0 + ai * 128 + m * 16) * 1024 + colt + c8 + bj * 128) = q; continue; }
                    u32x4 pk = pack8(v0, v1); if (DBG_IQ_TRUNC && (pn == 4 || pn == 5)) { pk.x &= 0xfff8fff8u; pk.y &= 0xfff8fff8u; pk.z &= 0xfff8fff8u; pk.w &= 0xfff8fff8u; }
                    if (DBG_DRYPROJ && dry && pk.x != 0x7fc17fc3u) continue;
                    *(u32x4*)(rp + bj * 128) = pk; } }
    }
};
template <int MODE> struct EpiGate {
    static constexpr bool PERM = true;
    const bf16_t* Gt; const bf16_t* T; bf16_t* O; float sc;
    __device__ __forceinline__ void operator()(const AccT& acc, const Unit& u, int wr, int wc, int fr, int fq) const {
        const int row0 = u.pm * 256 + wr * 64 + fr, c8 = u.pn * 256 + wc * 32 + 8 * fq;
#pragma unroll
        for (int ai = 0; ai < 2; ++ai) {
            u32x4 gq[4][2], tq[4][2]; u32x2 g8[4][2];
#pragma unroll
            for (int m = 0; m < 4; ++m) { const size_t off = (size_t)(row0 + ai * 128 + m * 16) * 1024 + c8;
#pragma unroll
                for (int bj = 0; bj < 2; ++bj) { if (GATE_U8) g8[m][bj] = *(const u32x2*)((const unsigned char*)Gt + off + bj * 128); else gq[m][bj] = *(const u32x4*)(Gt + off + bj * 128);
                    if (MODE == 1) tq[m][bj] = *(const u32x4*)(T + off + bj * 128); } }
            SBAR();
#pragma unroll
            for (int m = 0; m < 4; ++m) { const size_t off = (size_t)(row0 + ai * 128 + m * 16) * 1024 + c8;
#pragma unroll
                for (int bj = 0; bj < 2; ++bj) { f32x4 g0, g1;
                    if (GATE_U8) { const unsigned a = g8[m][bj].x, b = g8[m][bj].y; constexpr float q = 1.f / 255.f;
                        g0 = (f32x4){(float)(a & 255u), (float)((a >> 8) & 255u), (float)((a >> 16) & 255u), (float)(a >> 24)} * q;
                        g1 = (f32x4){(float)(b & 255u), (float)((b >> 8) & 255u), (float)((b >> 16) & 255u), (float)(b >> 24)} * q; }
                    else unpack8(gq[m][bj], g0, g1);
                    f32x4 v0 = g0 * (acc[ai][bj][m][0] * sc), v1 = g1 * (acc[ai][bj][m][1] * sc);
                    if ((MODE == 0 && DBG_NO_ATTN) || (MODE == 1 && DBG_NO_SSD)) { v0 = (f32x4){0.f, 0.f, 0.f, 0.f}; v1 = v0; }
                    if (MODE == 1) { f32x4 t0, t1; unpack8(tq[m][bj], t0, t1); v0 += t0; v1 += t1; }
                    *(u32x4*)(O + off + bj * 128) = pack8(v0, v1); } }
            SBAR();
        }
    }
};
struct EpiOut {
    static constexpr bool PERM = true;
    const float* x; const float* mod; bf16_t* V;
    __device__ __forceinline__ void operator()(const AccT& acc, const Unit& u, int wr, int wc, int fr, int fq) const {
        const int row0 = u.pm * 256 + wr * 64 + fr, c8 = u.pn * 256 + wc * 32 + 8 * fq;
        const float* g1 = mod + (size_t)(u.pm >> 3) * 6144 + 2048 + c8;
        f32x4 gv[2][2];
#pragma unroll
        for (int bj = 0; bj < 2; ++bj)
#pragma unroll
            for (int n = 0; n < 2; ++n) gv[bj][n] = *(const f32x4*)(g1 + bj * 128 + n * 4);
#pragma unroll
        for (int ai = 0; ai < 2; ++ai)
#pragma unroll
            for (int mp = 0; mp < 2; ++mp) {
                f32x4 xv[2][2][2];
#pragma unroll
                for (int mm = 0; mm < 2; ++mm) { const size_t off = (size_t)(row0 + ai * 128 + (2 * mp + mm) * 16) * 1024 + c8;
#pragma unroll
                    for (int bj = 0; bj < 2; ++bj)
#pragma unroll
                        for (int n = 0; n < 2; ++n) xv[mm][bj][n] = *(const f32x4*)(x + off + bj * 128 + n * 4); }
                SBAR();
#pragma unroll
                for (int mm = 0; mm < 2; ++mm) { const int m = 2 * mp + mm; const size_t off = (size_t)(row0 + ai * 128 + m * 16) * 1024 + c8;
#pragma unroll
                    for (int bj = 0; bj < 2; ++bj)
                        *(u32x4*)(V + off + bj * 128) = pack8(xv[mm][bj][0] * DN_ALPHA + gv[bj][0] * acc[ai][bj][m][0], xv[mm][bj][1] * DN_ALPHA + gv[bj][1] * acc[ai][bj][m][1]); }
                SBAR();
            }
    }
};

struct MoeTab { LAS unsigned* cnt; LAS unsigned* tb; LAS unsigned char* te; int ntiles; };
__device__ __forceinline__ MoeTab moe_tables(Frame& F, int hf) {
    MoeTab T; T.cnt = (LAS unsigned*)(F.lds + LDS_AUX); T.tb = (LAS unsigned*)(F.lds + LDS_AUX + 256); T.te = (LAS unsigned char*)(F.lds + LDS_AUX + 512);
    const unsigned* CNT = (const unsigned*)(F.ws + WS_CTL) + CW_CNT;
    __syncthreads();
    if (F.tid < 32) { unsigned c = __hip_atomic_load(CNT + 64 * (hf * 32 + F.tid), __ATOMIC_RELAXED, __HIP_MEMORY_SCOPE_AGENT); if (c > (unsigned)REG_CAP) c = REG_CAP; T.cnt[F.tid] = c; }
    __syncthreads();
    if (F.tid == 0) { unsigned s = 0;
#pragma nounroll
        for (int e = 0; e < 32; ++e) { T.tb[e] = s; const unsigned n = (T.cnt[e] + 255u) >> 8;
#pragma nounroll
            for (unsigned t = 0; t < n; ++t) T.te[s + t] = (unsigned char)e;
            s += n; }
        T.tb[32] = s; }
    __syncthreads();
    T.ntiles = __builtin_amdgcn_readfirstlane((int)T.tb[32]);
    return T;
}
template <int NJ, bool GATHER> struct SchedMoe {
    MoeTab T; int G, c, hf; const char* A; const char* Bt; const u32x2* REG;
    __device__ __forceinline__ bool next(int i, Unit& u) const {
        int tile, j;
        if (G == 256) { const int x = c & 7, sl = c >> 3;
            tile = i * (256 / NJ) + x * (32 / NJ) + sl / NJ; j = sl % NJ;
            if (tile >= T.ntiles) return false; }
        else { const int L = i * G + c; if (L >= T.ntiles * NJ) return false; tile = L / NJ; j = L % NJ; }
        u.pm = tile; u.pn = j; u.ex = __builtin_amdgcn_readfirstlane((int)T.te[u.pm]); return true;
    }
    __device__ __forceinline__ const char* a_base(const Unit& u) const { return GATHER ? A : A + (size_t)u.pm * (256 * MOE_RB); }
    __device__ __forceinline__ const char* b_base(const Unit& u) const { return Bt + ((size_t)u.ex * (NJ * 256) + (size_t)u.pn * 256) * MOE_RB; }
    __device__ __forceinline__ void a_offs(const Unit& u, const int* R, const int* C, unsigned (&o0)[2], unsigned (&o1)[2]) const {
        const unsigned cnt = __builtin_amdgcn_readfirstlane(T.cnt[u.ex]), pos0 = ((unsigned)u.pm - (unsigned)__builtin_amdgcn_readfirstlane(T.tb[u.ex])) * 256u; const u32x2* rg = REG + ((size_t)hf * 32 + u.ex) * REG_CAP;
#pragma unroll
        for (int i = 0; i < 2; ++i) {
            const unsigned p0 = pos0 + (unsigned)R[i], p1 = p0 + 128u;
            unsigned t0 = 0u, t1 = 0u;
            if (p0 < cnt) t0 = (unsigned)hf * HALF_TOK + (rg[p0].x >> 2);
            if (p1 < cnt) t1 = (unsigned)hf * HALF_TOK + (rg[p1].x >> 2);
            o0[i] = t0 * (unsigned)MOE_RB + (unsigned)C[i] * 2u; o1[i] = t1 * (unsigned)MOE_RB + (unsigned)C[i] * 2u;
        }
    }
};
struct EpiMoe1 {
    static constexpr bool PERM = true;
    const float* b1; bf16_t* ACT; int dry;
    __device__ __forceinline__ void operator()(const AccT& acc, const Unit& u, int wr, int wc, int fr, int fq) const {
        if (dry) { if (acc[0][0][0][0][0] == 1.2345e-33f) ACT[0] = 1; return; }
        const int row0 = u.pm * 256 + wr * 64 + fr, c8 = u.pn * 128 + wc * 32 + 8 * fq;
        const float* bg = b1 + (size_t)u.ex * 2048 + c8;
        const f32x4 bg0 = *(const f32x4*)bg, bg1 = *(const f32x4*)(bg + 4), bu0 = *(const f32x4*)(bg + 1024), bu1 = *(const f32x4*)(bg + 1028);
#pragma unroll
        for (int ai = 0; ai < 2; ++ai)
#pragma unroll
            for (int m = 0; m < 4; ++m) {
                f32x4 g0 = acc[ai][0][m][0] * MOE_INV + bg0, g1 = acc[ai][0][m][1] * MOE_INV + bg1, u0 = acc[ai][1][m][0] * MOE_INV + bu0, u1 = acc[ai][1][m][1] * MOE_INV + bu1, a0, a1;
#pragma unroll
                for (int j = 0; j < 4; ++j) {
                    float g = fminf(g0[j], 7.0f), up = fminf(fmaxf(u0[j], -7.0f), 7.0f); a0[j] = (up + 1.0f) * g * sigmoid_f(1.702f * g);
                    g = fminf(g1[j], 7.0f); up = fminf(fmaxf(u1[j], -7.0f), 7.0f); a1[j] = (up + 1.0f) * g * sigmoid_f(1.702f * g); }
                if (MOE_FP8) *(u32x2*)((unsigned char*)ACT + (size_t)(row0 + ai * 128 + m * 16) * 1024 + c8) = pack8_fp8(a0, a1);
                else *(u32x4*)(ACT + (size_t)(row0 + ai * 128 + m * 16) * 1024 + c8) = pack8(a0, a1); }
    }
};
struct EpiMoe2 {
    static constexpr bool PERM = true;
    const float* b2; bf16_t* YB; const u32x2* REG; MoeTab T; int hf; int dry;
    __device__ __forceinline__ void operator()(const AccT& acc, const Unit& u, int wr, int wc, int fr, int fq) const {
        if (dry == 1) { if (acc[0][0][0][0][0] == 1.2345e-33f) YB[0] = 1; return; }
        if (dry >= 2) {
            const int c8d = (dry == 3 ? 0 : u.pn * 256) + wc * 32 + 8 * fq; const unsigned rowd = dry == 3 ? (blockIdx.x * 256u + (unsigned)(wr * 64 + fr)) : ((unsigned)u.pm * 256u + (unsigned)(wr * 64 + fr)) % 131072u;
#pragma unroll
            for (int ai = 0; ai < 2; ++ai)
#pragma unroll
                for (int m = 0; m < 4; ++m) { bf16_t* rp = YB + (size_t)((rowd + ai * 128 + m * 16) % 131072u) * 1024 + c8d;
#pragma unroll
                    for (int bj = 0; bj < 2; ++bj) *(u32x4*)(rp + bj * 128) = pack8(acc[ai][bj][m][0] * MOE_INV, acc[ai][bj][m][1] * MOE_INV); }
            return; }
        const int c8 = u.pn * 256 + wc * 32 + 8 * fq;
        const unsigned cnt = __builtin_amdgcn_readfirstlane(T.cnt[u.ex]), pos0 = ((unsigned)u.pm - (unsigned)__builtin_amdgcn_readfirstlane(T.tb[u.ex])) * 256u + (unsigned)(wr * 64 + fr); const u32x2* rg = REG + ((size_t)hf * 32 + u.ex) * REG_CAP;
        const float* bb = b2 + (size_t)u.ex * 1024 + c8;
        f32x4 bv[2][2];
#pragma unroll
        for (int bj = 0; bj < 2; ++bj) { bv[bj][0] = *(const f32x4*)(bb + bj * 128); bv[bj][1] = *(const f32x4*)(bb + bj * 128 + 4); }
        u32x2 en8[2][4];
#pragma unroll
        for (int ai = 0; ai < 2; ++ai)
#pragma unroll
            for (int m = 0; m < 4; ++m) { const unsigned p = pos0 + (unsigned)(ai * 128 + m * 16); en8[ai][m] = rg[p < cnt ? p : cnt - 1u]; }
#pragma unroll
        for (int ai = 0; ai < 2; ++ai)
#pragma unroll
            for (int m = 0; m < 4; ++m) { const unsigned p = pos0 + (unsigned)(ai * 128 + m * 16);
                const u32x2 en = en8[ai][m]; const float g = __uint_as_float(en.y); const unsigned drow = p < cnt ? en.x : (unsigned)(HALF_TOK * 4);
                bf16_t* rp = YB + (size_t)drow * 1024 + c8;
#pragma unroll
                for (int bj = 0; bj < 2; ++bj) *(u32x4*)(rp + bj * 128) = pack8((acc[ai][bj][m][0] * MOE_INV + bv[bj][0]) * g, (acc[ai][bj][m][1] * MOE_INV + bv[bj][1]) * g); }
    }
};

struct MapIdent { __device__ __forceinline__ int operator()(int n) const { return n; } };
struct MapWin { __device__ __forceinline__ int operator()(int n) const {
    if (n < 1024) return n;
    if (n < 1536) return 1152 + (n - 1024);
    if (n < 1792) { const int c = n - 1536; if (c < 128) return 1024 + c; if (c < 192) return 1664 + (c - 128); if (c < 200) return 1728 + (c - 192); if (c < 216) return 4808 + (c - 200); return -1; }
    if (n < 2816) return 1736 + (n - 1792);
    if (n < 4864) return 2760 + (n - 2816);
    if (n < 5888) return 4824 + (n - 4864);
    return 5848 + (n - 5888); } };
struct MapW1 { __device__ __forceinline__ int operator()(int r) const { const int j = r >> 8, rr = r & 255; return (rr >> 7) * 1024 + j * 128 + (rr & 127); } };
template <class Map, bool F8 = false> __device__ __forceinline__ void transpose_item(const float* W, int K, int N, bf16_t* WT, const Map& map, LAS float* scr, int kb, int nb, int lane, const float* rowscale) {
    const int k0 = 64 * kb, n0 = 64 * nb, q = lane & 15, kr = lane >> 4; const int src = map(n0 + 4 * q);
    f32x4 ld[16];
#pragma unroll
    for (int i = 0; i < 16; ++i) { const int kk = 4 * i + kr; ld[i] = (src >= 0) ? *(const f32x4*)(W + (size_t)(k0 + kk) * N + src) : (f32x4){0.f, 0.f, 0.f, 0.f}; }
#pragma unroll
    for (int i = 0; i < 16; ++i) { const int kk = 4 * i + kr; f32x4 v = ld[i]; if (rowscale) v = v * rowscale[k0 + kk]; LAS float* d = scr + kk * 65 + 4 * q; d[0] = v[0]; d[1] = v[1]; d[2] = v[2]; d[3] = v[3]; }
    LDS_WAIT(); asm volatile("" ::: "memory");
    const int c = lane & 7;
#pragma unroll
    for (int j = 0; j < 8; ++j) { const int n = (lane >> 3) + 8 * j; const LAS float* s = scr + (8 * c) * 65 + n;
        if constexpr (F8) { const f32x4 a = {s[0 * 65] * MOE_WSC, s[1 * 65] * MOE_WSC, s[2 * 65] * MOE_WSC, s[3 * 65] * MOE_WSC}, b = {s[4 * 65] * MOE_WSC, s[5 * 65] * MOE_WSC, s[6 * 65] * MOE_WSC, s[7 * 65] * MOE_WSC};
            *(u32x2*)((unsigned char*)WT + (size_t)(n0 + n) * K + k0 + 8 * c) = pack8_fp8(a, b); }
        else { u32x4 o; o.x = cvt_pk_bf16(s[0 * 65], s[1 * 65]); o.y = cvt_pk_bf16(s[2 * 65], s[3 * 65]); o.z = cvt_pk_bf16(s[4 * 65], s[5 * 65]); o.w = cvt_pk_bf16(s[6 * 65], s[7 * 65]);
            *(u32x4*)(WT + (size_t)(n0 + n) * K + k0 + 8 * c) = o; } }
    LDS_WAIT(); asm volatile("" ::: "memory");
}
struct TrItem { const float* W; const float* rowscale; unsigned char* WT; int N, src, k0, n0, f8; };
__device__ __forceinline__ TrItem tr_decode(Frame& F, int it) {
    constexpr int I_WIN = 16 * (NPROJ / 64), I_SQ = 16 * 16, I_W1E = 16 * 32, I_W2E = 16 * 16;
    TrItem d; d.rowscale = nullptr; int r = it, kb, nb; const int q4 = 4 * (F.lane & 15);
    if (r < (PROJ_FP8 ? 2 : 1) * I_WIN) { const int f8 = r >= I_WIN; if (f8) r -= I_WIN; kb = r / (NPROJ / 64); nb = r % (NPROJ / 64);
        d.W = F.a->in[4]; d.N = 6872; d.src = MapWin()(64 * nb + q4); d.WT = F.ws + (f8 ? WS_WIN8 : WS_WIN); d.f8 = f8; }
    else { r -= (PROJ_FP8 ? 2 : 1) * I_WIN;
        if (r < 3 * I_SQ) { const int w = r / I_SQ; r -= w * I_SQ; kb = r / 16; nb = r % 16; d.N = 1024; d.src = 64 * nb + q4;
            if (w == 0) { d.W = F.a->in[15]; d.WT = F.ws + (PA_FP8 ? WS_WPA8 : WS_WPA); d.f8 = PA_FP8; }
            else if (w == 1) { d.W = F.a->in[16]; d.WT = F.ws + (PB_FP8 ? WS_WPB8 : WS_WPB); d.f8 = PB_FP8; d.rowscale = F.a->in[14]; }
            else { d.W = F.a->in[17]; d.WT = F.ws + WS_WOUT; d.f8 = 0; } }
        else { r -= 3 * I_SQ;
            if (r < 32 * I_W1E) { const int e = r / I_W1E, q = r % I_W1E; kb = q / 32; nb = q % 32; d.W = F.a->in[22] + (size_t)e * 1024 * 2048; d.N = 2048; d.src = MapW1()(64 * nb + q4);
                d.WT = F.ws + WS_W1 + (size_t)e * 2048 * MOE_RB; d.f8 = MOE_FP8; }
            else { r -= 32 * I_W1E; const int e = r / I_W2E, q = r % I_W2E; kb = q / 16; nb = q % 16; d.W = F.a->in[24] + (size_t)e * 1024 * 1024; d.N = 1024; d.src = 64 * nb + q4;
                d.WT = F.ws + WS_W2 + (size_t)e * 1024 * MOE_RB; d.f8 = MOE_FP8; } } }
    d.k0 = 64 * kb; d.n0 = 64 * nb; return d; }
__device__ __forceinline__ void tr_load(const TrItem& d, f32x4 (&ld)[16], int lane) {
    const int kr = lane >> 4; const float* p = d.W + (size_t)(d.k0 + kr) * d.N + (d.src >= 0 ? d.src : 0);
#pragma unroll
    for (int i = 0; i < 16; ++i) ld[i] = __builtin_nontemporal_load((const f32x4*)(p + (size_t)(4 * i) * d.N)); }
__device__ __forceinline__ void tr_finish(const TrItem& d, f32x4 (&ld)[16], LAS float* scr, int lane) {
    const int q = lane & 15, kr = lane >> 4; const bool zero = d.src < 0;
#pragma unroll
    for (int i = 0; i < 16; ++i) { const int kk = 4 * i + kr; f32x4 v = ld[i]; if (zero) v = (f32x4){0.f, 0.f, 0.f, 0.f}; if (d.rowscale) v = v * d.rowscale[d.k0 + kk];
        LAS float* o = scr + kk * 65 + 4 * q; o[0] = v[0]; o[1] = v[1]; o[2] = v[2]; o[3] = v[3]; }
    LDS_WAIT(); asm volatile("" ::: "memory");
    const int c = lane & 7;
    if (d.f8) {
#pragma unroll
        for (int j = 0; j < 8; ++j) { const int n = (lane >> 3) + 8 * j; const LAS float* s = scr + (8 * c) * 65 + n;
            const f32x4 a = {s[0 * 65] * MOE_WSC, s[1 * 65] * MOE_WSC, s[2 * 65] * MOE_WSC, s[3 * 65] * MOE_WSC}, b = {s[4 * 65] * MOE_WSC, s[5 * 65] * MOE_WSC, s[6 * 65] * MOE_WSC, s[7 * 65] * MOE_WSC};
            *(u32x2*)((unsigned char*)d.WT + (size_t)(d.n0 + n) * 1024 + d.k0 + 8 * c) = pack8_fp8(a, b); } }
    else {
#pragma unroll
        for (int j = 0; j < 8; ++j) { const int n = (lane >> 3) + 8 * j; const LAS float* s = scr + (8 * c) * 65 + n;
            u32x4 o; o.x = cvt_pk_bf16(s[0 * 65], s[1 * 65]); o.y = cvt_pk_bf16(s[2 * 65], s[3 * 65]); o.z = cvt_pk_bf16(s[4 * 65], s[5 * 65]); o.w = cvt_pk_bf16(s[6 * 65], s[7 * 65]);
            *(u32x4*)((bf16_t*)d.WT + (size_t)(d.n0 + n) * 1024 + d.k0 + 8 * c) = o; } }
    LDS_WAIT(); asm volatile("" ::: "memory");
}
__device__ __forceinline__ void ph_prologue(Frame& F) {
    const float* c_in = F.a->in[1]; const float* w_mod = F.a->in[2]; const float* b_mod = F.a->in[3];
    float* MOD = (float*)(F.ws + WS_MOD);
    for (int item = F.bid; item < 192; item += F.G) {
        LAS float* SC = (LAS float*)F.lds;
        __syncthreads();
        for (int i = F.tid; i < 32768; i += NTHR) { const int b = i >> 10, k = i & 1023; SC[k * 36 + b] = silu_f(c_in[i]); }
        __syncthreads();
        const int col = item * 32 + (F.tid >> 4), kq = F.tid & 15;
        float a[32];
#pragma unroll
        for (int b = 0; b < 32; ++b) a[b] = 0.f;
#pragma nounroll
        for (int kg = 0; kg < 64; kg += 16) {
            float wv[16];
#pragma unroll
            for (int u = 0; u < 16; ++u) wv[u] = w_mod[(size_t)((kg + u) * 16 + kq) * 6144 + col];
#pragma unroll
            for (int u = 0; u < 16; ++u) { const int k = (kg + u) * 16 + kq; const float w = wv[u];
#pragma unroll
                for (int b4 = 0; b4 < 8; ++b4) { const f32x4 s = *(const LAS f32x4*)(SC + k * 36 + b4 * 4); a[b4 * 4 + 0] += w * s[0]; a[b4 * 4 + 1] += w * s[1]; a[b4 * 4 + 2] += w * s[2]; a[b4 * 4 + 3] += w * s[3]; } } }
#pragma unroll
        for (int b = 0; b < 32; ++b) { a[b] += __shfl_xor(a[b], 1); a[b] += __shfl_xor(a[b], 2); a[b] += __shfl_xor(a[b], 4); a[b] += __shfl_xor(a[b], 8); }
        { const float bm = b_mod[col];
#pragma unroll
            for (int b = 1; b < 16; ++b) { a[0] = (kq == b) ? a[b] : a[0]; a[16] = (kq == b) ? a[16 + b] : a[16]; }
            MOD[(size_t)kq * 6144 + col] = a[0] + bm; MOD[(size_t)(kq + 16) * 6144 + col] = a[16] + bm; }
        __syncthreads();
    }
    if (F.bid == (F.G > 192 ? 192 : 0)) {
        float* BT = (float*)(F.ws + WS_BIAST); const float* rel_bias = F.a->in[8];
        for (int i = F.tid; i < 249 * 8; i += NTHR) { const int idx = i >> 3, h = i & 7, rel = idx - 185; const int n = rel < 0 ? -rel : rel;
            const float nf = (float)(n > 1 ? n : 1); int large = 8 + (int)(logf(nf / 8.0f) / 2.7725887f * 8.0f); if (large > 15) large = 15;
            const int bucket = (rel > 0 ? 16 : 0) + (n < 8 ? n : large);
            BT[i] = rel_bias[bucket * 8 + h] * LOG2E; }
    }
    LAS float* scr = (LAS float*)(F.lds + F.wave * 16640);
    __syncthreads();
    const int gw = F.bid * NWAVES + F.wave, NGW = F.G * NWAVES;
    constexpr int I_WIN = 16 * (NPROJ / 64), I_SQ = 16 * 16, I_W1E = 16 * 32, I_W2E = 16 * 16;
    constexpr int NITEMS = (PROJ_FP8 ? 2 : 1) * I_WIN + 3 * I_SQ + 32 * I_W1E + 32 * I_W2E;
    TrItem d0, d1; f32x4 la[16], lb[16];
    int it = gw;
    if (it < NITEMS) { d0 = tr_decode(F, it); tr_load(d0, la, F.lane); }
    while (it < NITEMS) {
        const int i1 = it + NGW; const bool v1 = i1 < NITEMS;
        if (v1) { d1 = tr_decode(F, i1); tr_load(d1, lb, F.lane); }
        tr_finish(d0, la, scr, F.lane);
        if (!v1) break;
        const int i2 = i1 + NGW; const bool v2 = i2 < NITEMS;
        if (v2) { d0 = tr_decode(F, i2); tr_load(d0, la, F.lane); }
        tr_finish(d1, lb, scr, F.lane);
        it = i2;
    }
}

__device__ __forceinline__ void ln1_load(const float* x, int m0, int lane, f32x4 (&v)[4][4]) {
#pragma unroll
    for (int r = 0; r < 4; ++r) { const f32x4* xr = (const f32x4*)(x + (size_t)(m0 + r) * D) + lane;
#pragma unroll
        for (int j = 0; j < 4; ++j) v[r][j] = __builtin_nontemporal_load(xr + 64 * j); } }
__device__ __forceinline__ void ln1_proc(Frame& F, bf16_t* U, int m0, f32x4 (&v)[4][4], const f32x4 (&sh)[4], const f32x4 (&sc)[4]) {
#pragma unroll
    for (int r = 0; r < 4; ++r) { const int m = m0 + r;
        float s = 0.f;
#pragma unroll
        for (int j = 0; j < 4; ++j) s += (v[r][j][0] + v[r][j][1]) + (v[r][j][2] + v[r][j][3]);
        const float mean = wave_sum(s) * (1.f / D); float s2 = 0.f;
#pragma unroll
        for (int j = 0; j < 4; ++j) { v[r][j] = v[r][j] - mean; s2 += (v[r][j][0] * v[r][j][0] + v[r][j][1] * v[r][j][1]) + (v[r][j][2] * v[r][j][2] + v[r][j][3] * v[r][j][3]); }
        const float rstd = 1.f / sqrtf(wave_sum(s2) * (1.f / D) + LN_EPS);
        u32x2* o8 = (u32x2*)(U + (size_t)m * D) + F.lane;
#pragma unroll
        for (int j = 0; j < 4; ++j) {
            const f32x4 rr = v[r][j] * rstd * (sc[j] + 1.0f) + sh[j]; u32x2 w; w.x = cvt_pk_bf16(rr[0], rr[1]); w.y = cvt_pk_bf16(rr[2], rr[3]); o8[64 * j] = w;
            if (PROJ_FP8) { int pk = 0; pk = __builtin_amdgcn_cvt_pk_fp8_f32(rr[0], rr[1], pk, false); pk = __builtin_amdgcn_cvt_pk_fp8_f32(rr[2], rr[3], pk, true); ((unsigned*)(F.ws + WS_U8 + (size_t)m * D))[F.lane + 64 * j] = (unsigned)pk; } } } }
__device__ __forceinline__ void ph_ln1(Frame& F) {
    const float* x = F.a->in[0]; const float* MOD = (const float*)(F.ws + WS_MOD); bf16_t* U = (bf16_t*)(F.outb + OUT_U);
    const int gw = F.bid * NWAVES + F.wave, NGW = F.G * NWAVES;
    const int RPW = (((NTOK + NGW - 1) / NGW) + 3) & ~3;
    const int mbeg = gw * RPW, mend = (mbeg + RPW < NTOK) ? mbeg + RPW : NTOK;
    if (mbeg >= mend) return;
    f32x4 va[4][4], vb[4][4], sh[4], sc[4]; int curb = -1;
#define LN1_MOD(m0) do { const int bb = (m0) >> 11; if (bb != curb) { curb = bb; const float* md = MOD + (size_t)bb * 6144; \
        _Pragma("unroll") for (int j = 0; j < 4; ++j) { sh[j] = *((const f32x4*)md + F.lane + 64 * j); sc[j] = *((const f32x4*)(md + 1024) + F.lane + 64 * j); } } } while (0)
    int m0 = mbeg;
    ln1_load(x, m0, F.lane, va);
    for (;;) {
        const int m1 = m0 + 4; const bool v1 = m1 < mend;
        LN1_MOD(m0); if (v1) ln1_load(x, m1, F.lane, vb);
        ln1_proc(F, U, m0, va, sh, sc);
        if (!v1) break;
        const int m2 = m1 + 4; const bool v2 = m2 < mend;
        LN1_MOD(m1); if (v2) ln1_load(x, m2, F.lane, va);
        ln1_proc(F, U, m1, vb, sh, sc);
        if (!v2) break;
        m0 = m2;
    }
#undef LN1_MOD
}

__device__ __forceinline__ void misc_load(const float* MISC, int m0, int l, f32x4 (&v)[8]) {
#pragma unroll
    for (int r = 0; r < 8; ++r) v[r] = __builtin_nontemporal_load((const f32x4*)(MISC + (size_t)(m0 + r) * 256) + l); }
__device__ __forceinline__ void misc_proc(Frame& F, int m0, const f32x4 (&vv)[8], const f32x4& w1, const f32x4& w2) {
    bf16_t* KV = (bf16_t*)(F.outb + OUT_KV); bf16_t* IK = (bf16_t*)(F.outb + OUT_IK); float* IW = (float*)(F.outb + OUT_IW); float* DT = (float*)(F.outb + OUT_DT);
    const int l = F.lane;
#pragma unroll
    for (int r = 0; r < 8; ++r) { const int m = m0 + r;
        const f32x4 v = vv[r];
        const float sq = v[0] * v[0] + v[1] * v[1] + v[2] * v[2] + v[3] * v[3], sm = (v[0] + v[1]) + (v[2] + v[3]);
        const float kvss = wave_sum(l < 32 ? sq : 0.f);
        const float iks = wave_sum((l >= 32 && l < 48) ? sm : 0.f);
        const float ikmean = iks * (1.f / 64.f);
        const f32x4 dv = v - ikmean;
        const float ikq = wave_sum((l >= 32 && l < 48) ? (dv[0] * dv[0] + dv[1] * dv[1] + dv[2] * dv[2] + dv[3] * dv[3]) : 0.f);
        if (l < 32) { const float rr = 1.f / sqrtf(kvss * (1.f / 128.f) + LN_EPS); const f32x4 o = v * rr * w1;
            u32x2 pk; pk.x = cvt_pk_bf16(o[0], o[1]); pk.y = cvt_pk_bf16(o[2], o[3]); *((u32x2*)(KV + (size_t)m * 128) + l) = pk; }
        else if (l < 48) { const float rr = 1.f / sqrtf(ikq * (1.f / 64.f) + LN_EPS); const f32x4 o = dv * rr * w1 + w2;
            u32x2 pk; pk.x = cvt_pk_bf16(o[0], o[1]); pk.y = cvt_pk_bf16(o[2], o[3]); *((u32x2*)(IK + (size_t)m * 64) + (l - 32)) = pk; }
        else if (l < 50) { *((f32x4*)(IW + (size_t)m * 8) + (l - 48)) = v * 0.35355339059327373f; }
        else if (l < 54) { f32x4 o;
#pragma unroll
            for (int j = 0; j < 4; ++j) { const float t = v[j] + w1[j]; o[j] = t > 20.f ? t : log1pf(__expf(t)); }
            *((f32x4*)(DT + (size_t)m * 16) + (l - 50)) = o; }
    } }
__device__ __forceinline__ void ph_misc(Frame& F) {
    const float* MISC = (const float*)(F.outb + OUT_MISC);
    const float* kvw = F.a->in[5]; const float* ikw = F.a->in[6]; const float* ikb = F.a->in[7]; const float* dtb = F.a->in[11];
    const int gw = F.bid * NWAVES + F.wave, NGW = F.G * NWAVES, l = F.lane;
    const int RPW = (((NTOK + NGW - 1) / NGW) + 7) & ~7;
    const int mbeg = gw * RPW, mend = (mbeg + RPW < NTOK) ? mbeg + RPW : NTOK;
    if (mbeg >= mend) return;
    f32x4 w1 = (f32x4){0.f, 0.f, 0.f, 0.f}, w2 = w1;
    if (l < 32) w1 = *((const f32x4*)kvw + l); else if (l < 48) { w1 = *((const f32x4*)ikw + (l - 32)); w2 = *((const f32x4*)ikb + (l - 32)); } else if (l >= 50 && l < 54) w1 = *((const f32x4*)dtb + (l - 50));
    f32x4 va[8], vb[8];
    int m0 = mbeg;
    misc_load(MISC, m0, l, va);
    for (;;) {
        const int m1 = m0 + 8; const bool v1 = m1 < mend;
        if (v1) misc_load(MISC, m1, l, vb);
        misc_proc(F, m0, va, w1, w2);
        if (!v1) break;
        const int m2 = m1 + 8; const bool v2 = m2 < mend;
        if (v2) misc_load(MISC, m2, l, va);
        misc_proc(F, m1, vb, w1, w2);
        if (!v2) break;
        m0 = m2;
    }
}

__device__ __forceinline__ unsigned sortable_key(float s) { const unsigned u = __float_as_uint(s + 0.0f); return (u & 0x80000000u) ? ~u : (u | 0x80000000u); }
template <int NKB> struct KeyRow { unsigned k[NKB]; };
__device__ __forceinline__ u64 low_bits_keep(u64 m, int t) { u64 out = 0; while (t-- > 0 && m) { const u64 b = m & (0 - m); out |= b; m ^= b; } return out; }
namespace idx { constexpr int KST = 144, KBUF = 64 * KST; }
__device__ __forceinline__ unsigned low_bits_keep32(unsigned m, int t) { unsigned out = 0; while (t-- > 0 && m) { const unsigned b = m & (0u - m); out |= b; m ^= b; } return out; }
template <int NG> __device__ __forceinline__ void topk2_select_write(const unsigned (&key)[64], int nkb, u64* mrow, int lane) {
    constexpr int NR = NG * 16;
    unsigned T0 = 0u, T1 = 0u; bool ex0 = false, ex1 = false;
    unsigned lo0 = 0u, lo1 = 0u, hi0 = 0xFFFFFFFFu, hi1 = 0xFFFFFFFFu, st0, st1, p0, p1; bool fin0 = false, fin1 = false;
    { float sm = 0.f, sq = 0.f;
#pragma unroll
        for (int m = 0; m < 10; ++m) { const unsigned k = key[m]; const float f = __uint_as_float((k & 0x80000000u) ? (k ^ 0x80000000u) : ~k); sm += f; sq += f * f; }
        sm = dpp_half_sums_f32(sm); sq = dpp_half_sums_f32(sq);
        const float mu = sm * (1.f / 320.f), sd = sqrtf(fmaxf(sq * (1.f / 320.f) - mu * mu, 1e-20f));
        const float qq = 256.f / (64.f * (float)nkb), pp = qq < 0.5f ? qq : 1.f - qq, tt = sqrtf(-2.f * __logf(pp));
        float z = tt - (2.515517f + 0.802853f * tt + 0.010328f * tt * tt) / (1.f + 1.432788f * tt + 0.189269f * tt * tt + 0.001308f * tt * tt * tt); if (qq >= 0.5f) z = -z;
        const unsigned pe = sortable_key(mu + z * sd), pd = sortable_key(mu + z * sd + 0.125f * sd);
        unsigned stp = pd - pe; if (stp < 1024u) stp = 1024u;
        p0 = __builtin_amdgcn_readlane((int)pe, 31); p1 = __builtin_amdgcn_readlane((int)pe, 63); st0 = __builtin_amdgcn_readlane((int)stp, 31); st1 = __builtin_amdgcn_readlane((int)stp, 63); }
#pragma nounroll
    for (int it = 0; it < 80; ++it) {
        const unsigned candv = lane < 32 ? p0 : p1;
        unsigned cl = 0u;
#pragma unroll
        for (int m = 0; m < NR; m += 4) { u64 s0, s1, s2, s3;
            asm("v_cmp_ge_u32_e64 %1, %5, %9\n\tv_cmp_ge_u32_e64 %2, %6, %9\n\tv_cmp_ge_u32_e64 %3, %7, %9\n\tv_cmp_ge_u32_e64 %4, %8, %9\n\t"
                "v_addc_co_u32_e64 %0, %1, 0, %0, %1\n\tv_addc_co_u32_e64 %0, %2, 0, %0, %2\n\tv_addc_co_u32_e64 %0, %3, 0, %0, %3\n\tv_addc_co_u32_e64 %0, %4, 0, %0, %4"
                : "+v"(cl), "=&s"(s0), "=&s"(s1), "=&s"(s2), "=&s"(s3) : "v"(key[m]), "v"(key[m + 1]), "v"(key[m + 2]), "v"(key[m + 3]), "v"(candv)); }
        cl = dpp_half_sums_u32(cl);
        const int n0 = __builtin_amdgcn_readlane((int)cl, 31), n1 = __builtin_amdgcn_readlane((int)cl, 63);
#define IDX_STEP(lo, hi, st, p, T, ex, fin, n) do { if (!fin) { \
            if (n == 256) { T = p; ex = true; fin = true; } \
            else { if (n > 256) lo = p; else hi = p; \
                if (hi - lo <= 1u) { T = lo; fin = true; } \
                else { unsigned c; if (hi == 0xFFFFFFFFu) { c = lo + st; if (c < lo) c = hi; st = st << 1; } else if (lo == 0u) { c = hi - st; if (c > hi) c = lo; st = st << 1; } else c = lo + ((hi - lo) >> 1); \
                    if (c <= lo || c >= hi) c = lo + ((hi - lo) >> 1); p = c; } } } } while (0)
        IDX_STEP(lo0, hi0, st0, p0, T0, ex0, fin0, n0);
        IDX_STEP(lo1, hi1, st1, p1, T1, ex1, fin1, n1);
#undef IDX_STEP
        if (fin0 && fin1) break;
    }
    const unsigned Tv = lane < 32 ? T0 : T1;
    if (ex0 && ex1) {
        unsigned mlo = 0u, mhi = 0u;
#pragma unroll
        for (int j = 0; j < NR / 2; ++j) {
            const u64 b0 = __ballot(key[2 * j] >= Tv), b1 = __ballot(key[2 * j + 1] >= Tv);
            asm volatile("s_nop 1\n\tv_writelane_b32 %0, %2, %6\n\tv_writelane_b32 %0, %3, %7\n\tv_writelane_b32 %1, %4, %6\n\tv_writelane_b32 %1, %5, %7"
                         : "+v"(mlo), "+v"(mhi) : "s"((unsigned)b0), "s"((unsigned)(b0 >> 32)), "s"((unsigned)b1), "s"((unsigned)(b1 >> 32)), "n"(j), "n"(32 + j));
            if ((j & 3) == 3) SBAR();
        }
        const int jl = lane & 31;
        if (jl < nkb) mrow[(lane >> 5) * 32 + jl] = (u64)mlo | ((u64)mhi << 32);
        return;
    }
    int rem0 = 1 << 30, rem1 = 1 << 30;
    { int g0 = 0, g1 = 0;
#pragma unroll
        for (int m = 0; m < NR; ++m) { const u64 mk = __ballot(key[m] > Tv); g0 += __builtin_popcount((unsigned)mk); g1 += __builtin_popcount((unsigned)(mk >> 32)); if ((m & 7) == 7) SBAR(); }
        if (!ex0) rem0 = 256 - g0; if (!ex1) rem1 = 256 - g1; }
    u64 mine = 0ull;
#pragma nounroll
    for (int jq = 0; jq < NR / 8; ++jq) {
#pragma unroll
        for (int jj = 0; jj < 4; ++jj) { const int j = jq * 4 + jj;
            unsigned w0[2], w1[2];
#pragma unroll
            for (int hh = 0; hh < 2; ++hh) { unsigned kv = 0u;
#pragma unroll
                for (int m = 0; m < NR; ++m) if ((m >> 3) == 0) {}
#pragma unroll
                for (int m = 0; m < NR; ++m) kv = (m == 2 * j + hh) ? key[m] : kv;
                const u64 gt = __ballot(kv > Tv), eq = __ballot(kv == Tv);
                { const unsigned e = (unsigned)eq, g = (unsigned)gt; const int ne = __builtin_popcount(e); unsigned sel = g; if (rem0 >= ne) { sel |= e; rem0 -= ne; } else if (rem0 > 0) { sel |= low_bits_keep32(e, rem0); rem0 = 0; } w0[hh] = sel; }
                { const unsigned e = (unsigned)(eq >> 32), g = (unsigned)(gt >> 32); const int ne = __builtin_popcount(e); unsigned sel = g; if (rem1 >= ne) { sel |= e; rem1 -= ne; } else if (rem1 > 0) { sel |= low_bits_keep32(e, rem1); rem1 = 0; } w1[hh] = sel; } }
            const u64 q0w = (u64)w0[0] | ((u64)w0[1] << 32), q1w = (u64)w1[0] | ((u64)w1[1] << 32);
            if (lane == j) mine = q0w; if (lane == 32 + j) mine = q1w; }
    }
    const int jl = lane & 31;
    if (jl < nkb) mrow[(lane >> 5) * 32 + jl] = mine;
}
template <int J0> __device__ __forceinline__ void index_scores8(unsigned (&key)[64], const bf16x8 (&af)[2], const f32x4& iw4, const bf16_t* kvsrc, char* lds, int nkb, u32x4 (&stg)[8], int tid) {
    const int lane = tid & 63, sub = lane & 15, kg = lane >> 4;
#pragma unroll
    for (int jj = 0; jj < 8; ++jj) {
        const int j = J0 + jj;
        if (j < nkb) {
            if (j + 1 < nkb) *(u32x4*)(lds + ((j + 1) & 1) * idx::KBUF + (tid >> 3) * idx::KST + (tid & 7) * 16) = stg[(jj + 1) & 7];
            if (j + 8 < nkb) stg[jj] = *(const u32x4*)(kvsrc + (size_t)(j + 8) * 64 * 64);
            const char* kb = lds + (j & 1) * idx::KBUF + sub * idx::KST + kg * 16;
#pragma unroll
            for (int pr = 0; pr < 2; ++pr) {
                f32x4 dA = (f32x4){0.f, 0.f, 0.f, 0.f}, dB = dA;
#pragma unroll
                for (int ks = 0; ks < 2; ++ks) {
                    const bf16x8 fA = *(const bf16x8*)(kb + (pr * 32) * idx::KST + ks * 64), fB = *(const bf16x8*)(kb + (pr * 32 + 16) * idx::KST + ks * 64);
                    dA = __builtin_amdgcn_mfma_f32_16x16x32_bf16(af[ks], fA, dA, 0, 0, 0); dB = __builtin_amdgcn_mfma_f32_16x16x32_bf16(af[ks], fB, dB, 0, 0, 0); }
                float pA = 0.f, pB = 0.f;
#pragma unroll
                for (int r = 0; r < 4; ++r) { pA += fmaxf(dA[r], 0.f) * iw4[r]; pB += fmaxf(dB[r], 0.f) * iw4[r]; }
                auto rr = __builtin_amdgcn_permlane16_swap(__float_as_uint(pA), __float_as_uint(pB), false, false);
                key[2 * j + pr] = sortable_key(__uint_as_float(rr[0]) + __uint_as_float(rr[1]));
            }
            __syncthreads();
        }
    }
}
__device__ __forceinline__ void ph_index(Frame& F, const int abl = 0) {
    const bf16_t* IQ = (const bf16_t*)(F.outb + OUT_IQ); const bf16_t* IK = (const bf16_t*)(F.outb + OUT_IK); const float* IW = (const float*)(F.outb + OUT_IW);
    u64* MASK = (u64*)(F.outb + OUT_MASK);
    char* lds = (char*)(unsigned char*)F.lds;
    const int tid = F.tid, lane = F.lane, sub = lane & 15, kg = lane >> 4;
    for (int item = F.bid; item < NTOK / 16; item += F.G) {
        const int tokw = (((item & 255) >> 3) << 11) + (((item & 7) + 8 * (item >> 8)) << 4) + F.wave * 2, b = tokw >> 11, pos0 = tokw & 2047, nkb = (pos0 >> 6) + 1;
        u64* mrow = MASK + (size_t)tokw * 32;
        if (nkb <= 4) { if ((lane & 31) < nkb) mrow[(lane >> 5) * 32 + (lane & 31)] = ~0ull; continue; }
        bf16x8 af[2];
        { const bf16_t* ap = IQ + (size_t)(tokw + (sub >> 3)) * 512 + (sub & 7) * 64 + kg * 8;
#pragma unroll
          for (int ks = 0; ks < 2; ++ks) af[ks] = *(const bf16x8*)(ap + ks * 32); }
        const f32x4 iw4 = *(const f32x4*)(IW + (size_t)(tokw + (lane >> 5)) * 8 + 4 * (kg & 1));
        unsigned key[64];
#pragma unroll
        for (int m = 0; m < 64; ++m) key[m] = 0u;
        const bf16_t* kvsrc = IK + ((size_t)b * SEQ + (tid >> 3)) * 64 + (tid & 7) * 8;
        u32x4 stg[8];
#pragma unroll
        for (int i = 0; i < 8; ++i) stg[i] = (i < nkb) ? *(const u32x4*)(kvsrc + (size_t)i * 64 * 64) : (u32x4){0u, 0u, 0u, 0u};
        __syncthreads();
        *(u32x4*)(lds + (tid >> 3) * idx::KST + (tid & 7) * 16) = stg[0];
        __syncthreads();
        const int ng = (nkb + 7) >> 3;
        if (!(abl & 1)) {
        index_scores8<0>(key, af, iw4, kvsrc, lds, nkb, stg, tid);
        if (ng > 1) index_scores8<8>(key, af, iw4, kvsrc, lds, nkb, stg, tid);
        if (ng > 2) index_scores8<16>(key, af, iw4, kvsrc, lds, nkb, stg, tid);
        if (ng > 3) index_scores8<24>(key, af, iw4, kvsrc, lds, nkb, stg, tid);
        }
        if (abl & 2) { if (key[0] == 0x12345u && key[63] == 7u) mrow[lane] = 1ull; continue; }
        if (ng == 1) topk2_select_write<1>(key, nkb, mrow, lane);
        else if (ng == 2) topk2_select_write<2>(key, nkb, mrow, lane);
        else if (ng == 3) topk2_select_write<3>(key, nkb, mrow, lane);
        else topk2_select_write<4>(key, nkb, mrow, lane);
    }
}

namespace att {
constexpr int KVBLK = 64;
constexpr int SHM_V = KVBLK * 128 * 2, SHM_K = SHM_V;
constexpr int OFF_V = 0, OFF_K = 2 * SHM_V, OFF_WS = 2 * SHM_V + 2 * SHM_K, OFF_BT = OFF_WS + NWAVES * 64 * 4;
constexpr int OFF_OT = 81920, OT_ST = 144;
#define KSWZ(row, colB) ((row) * 256 + ((colB) ^ (((row) & 7) << 4)))
__device__ __forceinline__ int crow(int r, int hi) { return (r & 3) + 8 * (r >> 2) + 4 * hi; }
__device__ __forceinline__ int v_st(int k, int c) { const int kk = (k & ~0xC) | ((k & 4) << 1) | ((k & 8) >> 1); return ((kk >> 3) * 4 + (c >> 5)) * 512 + ((kk & 7) * 32 + (c & 31)) * 2; }
__device__ __forceinline__ int v_rd_base(int lane) { return ((lane & 3) << 3) | (((lane >> 2) & 3) << 6) | (((lane >> 4) & 1) << 5) | (((lane >> 5) & 1) << 8); }
constexpr int v_rd_off(int d0, int ks, int half) { return d0 * 512 + ks * 4096 + half * 2048; }
template <int OFF> __device__ __forceinline__ s16x4 tr_read(int vb) { s16x4 r; asm volatile("ds_read_b64_tr_b16 %0, %1 offset:%2" : "=&v"(r) : "v"(vb), "i"(OFF) : "memory"); return r; }
template <int D0> __device__ __forceinline__ void pv_one(f32x16& od, int vb, bf16x8 pa0, bf16x8 pa1, bf16x8 pa2, bf16x8 pa3) {
    const s16x4 l0 = tr_read<v_rd_off(D0, 0, 0)>(vb), h0 = tr_read<v_rd_off(D0, 0, 1)>(vb), l1 = tr_read<v_rd_off(D0, 1, 0)>(vb), h1 = tr_read<v_rd_off(D0, 1, 1)>(vb);
    const s16x4 l2 = tr_read<v_rd_off(D0, 2, 0)>(vb), h2 = tr_read<v_rd_off(D0, 2, 1)>(vb), l3 = tr_read<v_rd_off(D0, 3, 0)>(vb), h3 = tr_read<v_rd_off(D0, 3, 1)>(vb);
    asm volatile("s_waitcnt lgkmcnt(0)" ::: "memory"); SBAR();
#define PK(L, H) (bf16x8){L[0], L[1], L[2], L[3], H[0], H[1], H[2], H[3]}
    od = __builtin_amdgcn_mfma_f32_32x32x16_bf16(pa0, PK(l0, h0), od, 0, 0, 0);
    od = __builtin_amdgcn_mfma_f32_32x32x16_bf16(pa1, PK(l1, h1), od, 0, 0, 0);
    od = __builtin_amdgcn_mfma_f32_32x32x16_bf16(pa2, PK(l2, h2), od, 0, 0, 0);
    od = __builtin_amdgcn_mfma_f32_32x32x16_bf16(pa3, PK(l3, h3), od, 0, 0, 0);
#undef PK
}
__device__ __forceinline__ void qkt(f32x16& p0, f32x16& p1, const char* Ks, const bf16x8* qr, int r32, int hi) {
    p0 = f32x16{}; p1 = f32x16{};
    int rv = r32; asm volatile("" : "+v"(rv));
    const char* kb = Ks + rv * 256; const int swz = ((rv & 7) << 4) ^ (hi * 16);
#pragma unroll
    for (int d0 = 0; d0 < 8; ++d0) { const char* ka = kb + ((d0 * 32) ^ swz);
        const bf16x8 b0 = *reinterpret_cast<const bf16x8*>(ka);
        const bf16x8 b1 = *reinterpret_cast<const bf16x8*>(ka + 8192);
        p0 = __builtin_amdgcn_mfma_f32_32x32x16_bf16(b0, qr[d0], p0, 0, 0, 0);
        p1 = __builtin_amdgcn_mfma_f32_32x32x16_bf16(b1, qr[d0], p1, 0, 0, 0); }
}
__device__ __forceinline__ void attn_item(Frame& F, int b, int q0, char* lds) {
    const bf16_t* Q = (const bf16_t*)(F.ws + WS_Q); const bf16_t* KV = (const bf16_t*)(F.outb + OUT_KV); const u64* MASK = (const u64*)(F.outb + OUT_MASK);
    bf16_t* OA = (bf16_t*)(F.outb + OUT_OA);
    int tid = F.tid; asm volatile("" : "+v"(tid));
    const int wid = F.wave, lane = tid & 63, r32 = lane & 31, hi = lane >> 5;
    char* V_lds = lds + OFF_V; char* K_lds = lds + OFF_K;
    float* wsl = (float*)(lds + OFF_WS) + wid * 64; float* li_l = wsl; float* al_l = wsl + 32;
    const float* btab = (const float*)(lds + OFF_BT);
    constexpr float C = 0.088388347648318440f * LOG2E;
    float m_reg = -1e30f, l_reg = 0.f; f32x16 o[4] = {}; bf16x8 qr[8];
    const size_t tokq = (size_t)b * SEQ + q0 + r32;
    { const bf16_t* Qw = Q + tokq * 1024 + wid * 128 + hi * 8;
#pragma unroll
      for (int d0 = 0; d0 < 8; ++d0) qr[d0] = *(const bf16x8*)(Qw + d0 * 16); }
    const u64* mq = MASK + tokq * 32;
    const int sr = tid >> 4, sc = (tid & 15) * 8;
    const int vb0 = (int)(uintptr_t)V_lds + v_rd_base(lane);
    const bf16_t* Kb = KV + (size_t)b * SEQ * 128;
    const int NT = (q0 >> 6) + 1;
    const float bfar = btab[wid];
    bf16x8 s0, s1;
#define SLOAD(k0) do { s0 = *(const bf16x8*)(Kb + (size_t)((k0) + sr) * 128 + sc); s1 = *(const bf16x8*)(Kb + (size_t)((k0) + 32 + sr) * 128 + sc); } while (0)
#define SWRITE(bf) do { int srv = sr; asm volatile("" : "+v"(srv)); const int kc = sc * 2; const int v0a = v_st(srv, sc), k0a = KSWZ(srv, kc); \
        *(bf16x8*)(V_lds + (bf) * SHM_V + v0a) = s0; *(bf16x8*)(V_lds + (bf) * SHM_V + v0a + 8192) = s1; \
        *(bf16x8*)(K_lds + (bf) * SHM_K + k0a) = s0; *(bf16x8*)(K_lds + (bf) * SHM_K + k0a + 8192) = s1; } while (0)
    __syncthreads();
    SLOAD(0); VM_WAIT(); SWRITE(0); __syncthreads();
    u64 mw_next = mq[0];
    for (int j = 0; j < NT; ++j) {
        int lanel = lane; asm volatile("" : "+v"(lanel)); const int r32l = lanel & 31, hil = lanel >> 5;
        const int bf = j & 1;
        if (j + 1 < NT) SLOAD((j + 1) * KVBLK);
        const u64 mw = mw_next; if (j + 1 < NT) mw_next = mq[j + 1];
        f32x16 p0, p1;
        qkt(p0, p1, K_lds + bf * SHM_K, qr, r32l, hil);
        const unsigned w0 = (unsigned)(mw >> (4 * hil)), w1 = (unsigned)(mw >> (32 + 4 * hil));
        const int relmax = j * KVBLK + 63 - q0;
        float alpha = 1.f, ps = 0.f;
        if (relmax <= -91) {
            float pmax = p0[0];
#pragma unroll
            for (int r = 1; r < 16; ++r) pmax = fmaxf(pmax, p0[r]);
#pragma unroll
            for (int r = 0; r < 16; ++r) pmax = fmaxf(pmax, p1[r]);
            { auto rr = __builtin_amdgcn_permlane32_swap(__float_as_uint(pmax), __float_as_uint(pmax), false, false); pmax = fmaxf(__uint_as_float(rr[0]), __uint_as_float(rr[1])); }
            pmax = fmaf(pmax, C, bfar);
            if (!__all(pmax - m_reg <= 11.0f)) { const float mn = fmaxf(m_reg, pmax); alpha = __builtin_amdgcn_exp2f(m_reg - mn); m_reg = mn; }
            const float off = bfar - m_reg;
#pragma unroll
            for (int r = 0; r < 16; ++r) { const int cb = (r & 3) + 8 * (r >> 2);
                const float e0 = __builtin_amdgcn_exp2f(fmaf(p0[r], C, off)), e1 = __builtin_amdgcn_exp2f(fmaf(p1[r], C, off));
                p0[r] = __uint_as_float(__float_as_uint(e0) & (unsigned)__builtin_amdgcn_sbfe((int)w0, cb, 1)); p1[r] = __uint_as_float(__float_as_uint(e1) & (unsigned)__builtin_amdgcn_sbfe((int)w1, cb, 1)); ps += p0[r] + p1[r]; }
        } else {
            const float* bp = btab + (j * KVBLK + 4 * hil - (q0 + r32l) + 185) * 8 + wid;
#pragma unroll
            for (int r4 = 0; r4 < 4; ++r4) {
#pragma unroll
                for (int rr = 0; rr < 4; ++rr) { const int r = r4 * 4 + rr; const int cb = (r & 3) + 8 * (r >> 2); p0[r] = fmaf(p0[r], C, bp[cb * 8]); p1[r] = fmaf(p1[r], C, bp[(cb + 32) * 8]); }
                SBAR(); }
            float pmax = p0[0];
#pragma unroll
            for (int r = 1; r < 16; ++r) pmax = fmaxf(pmax, p0[r]);
#pragma unroll
            for (int r = 0; r < 16; ++r) pmax = fmaxf(pmax, p1[r]);
            { auto rr = __builtin_amdgcn_permlane32_swap(__float_as_uint(pmax), __float_as_uint(pmax), false, false); pmax = fmaxf(__uint_as_float(rr[0]), __uint_as_float(rr[1])); }
            if (!__all(pmax - m_reg <= 11.0f)) { const float mn = fmaxf(m_reg, pmax); alpha = __builtin_amdgcn_exp2f(m_reg - mn); m_reg = mn; }
#pragma unroll
            for (int r = 0; r < 16; ++r) { const int cb = (r & 3) + 8 * (r >> 2);
                const float e0 = __builtin_amdgcn_exp2f(p0[r] - m_reg), e1 = __builtin_amdgcn_exp2f(p1[r] - m_reg);
                p0[r] = __uint_as_float(__float_as_uint(e0) & (unsigned)__builtin_amdgcn_sbfe((int)w0, cb, 1)); p1[r] = __uint_as_float(__float_as_uint(e1) & (unsigned)__builtin_amdgcn_sbfe((int)w1, cb, 1)); ps += p0[r] + p1[r]; }
        }
        { auto rr = __builtin_amdgcn_permlane32_swap(__float_as_uint(ps), __float_as_uint(ps), false, false); ps = __uint_as_float(rr[0]) + __uint_as_float(rr[1]); }
        l_reg = l_reg * alpha + ps;
        bf16x8 pa0, pa1, pa2, pa3;
#define PK4(P, BASE, OUT) do { unsigned a0 = cvt_pk_bf16(P[BASE + 0], P[BASE + 1]), a1 = cvt_pk_bf16(P[BASE + 2], P[BASE + 3]);   \
    unsigned b0 = cvt_pk_bf16(P[BASE + 4], P[BASE + 5]), b1 = cvt_pk_bf16(P[BASE + 6], P[BASE + 7]);                              \
    auto r0 = __builtin_amdgcn_permlane32_swap(a0, b0, false, false); auto r1 = __builtin_amdgcn_permlane32_swap(a1, b1, false, false); \
    u32x4 w = {r0[0], r1[0], r0[1], r1[1]}; OUT = *reinterpret_cast<bf16x8*>(&w); } while (0)
        PK4(p0, 0, pa0); PK4(p0, 8, pa1); PK4(p1, 0, pa2); PK4(p1, 8, pa3);
#undef PK4
        if (__any(alpha < 1.f)) { if (hil == 0) al_l[r32l] = alpha; LDS_WAIT();
#pragma unroll
            for (int d = 0; d < 4; ++d)
#pragma unroll
                for (int r = 0; r < 16; ++r) o[d][r] *= al_l[crow(r, hil)]; }
        const int vb = (int)(uintptr_t)V_lds + v_rd_base(lanel) + bf * SHM_V;
        pv_one<0>(o[0], vb, pa0, pa1, pa2, pa3); pv_one<1>(o[1], vb, pa0, pa1, pa2, pa3); pv_one<2>(o[2], vb, pa0, pa1, pa2, pa3); pv_one<3>(o[3], vb, pa0, pa1, pa2, pa3);
        if (j + 1 < NT) { VM_WAIT(); SWRITE(bf ^ 1); }
        __syncthreads();
    }
#undef SLOAD
#undef SWRITE
    if (hi == 0) li_l[r32] = l_reg; LDS_WAIT();
    bf16_t* Ow = OA + ((size_t)b * SEQ + q0 + 4 * hi) * 1024 + wid * 128 + r32;
    const float* lip = li_l + 4 * hi;
    unsigned char* Ow8 = (unsigned char*)OA + ((size_t)b * SEQ + q0 + 4 * hi) * 1024 + wid * 128 + r32;
    asm volatile("" : "+v"(Ow), "+v"(lip), "+v"(Ow8));
#pragma unroll
    for (int r = 0; r < 16; ++r) { const int ro = (r & 3) + 8 * (r >> 2); if ((r & 3) == 0) asm volatile("" : "+v"(Ow), "+v"(Ow8), "+v"(lip)); const float rl = fast_rcp(lip[ro]);
#pragma unroll
        for (int d0 = 0; d0 < 4; ++d0) { float v = o[d0][r] * rl; if ((DBG_ATTN_ZERO == 1 && q0 < 256) || (DBG_ATTN_ZERO == 2 && q0 >= 256)) v = 0.f;
            if (PA_FP8) ((unsigned char*)Ow8)[ro * 1024 + d0 * 32] = (unsigned char)(__builtin_amdgcn_cvt_pk_fp8_f32(v, v, 0, false) & 0xff);
            else Ow[ro * 1024 + d0 * 32] = (bf16_t)(cvt_pk_bf16(v, v) & 0xffffu); }
        if ((r & 3) == 3) SBAR(); }
}
__device__ __forceinline__ void att2_partial(f32x16& p0, f32x16& p1, float& m_reg, float& alpha, unsigned w0, bool far, float bfar, const float* bp) {
    constexpr float C = 0.088388347648318440f * LOG2E;
    float off;
    if (far) {
        float pmax = p0[0];
#pragma unroll
        for (int r = 1; r < 16; ++r) pmax = fmaxf(pmax, p0[r]);
#pragma unroll
        for (int r = 0; r < 16; ++r) pmax = fmaxf(pmax, p1[r]);
        { auto rr = __builtin_amdgcn_permlane32_swap(__float_as_uint(pmax), __float_as_uint(pmax), false, false); pmax = fmaxf(__uint_as_float(rr[0]), __uint_as_float(rr[1])); }
        pmax = fmaf(pmax, C, bfar);
        if (__builtin_expect(__all(pmax - m_reg <= 11.0f), 1)) alpha = 1.f; else { const float mn = fmaxf(m_reg, pmax); alpha = __builtin_amdgcn_exp2f(m_reg - mn); m_reg = mn; }
        off = bfar - m_reg;
#pragma unroll
        for (int r = 0; r < 16; ++r) { p0[r] = fmaf(p0[r], C, off); p1[r] = fmaf(p1[r], C, off); }
    } else {
#pragma unroll
        for (int r4 = 0; r4 < 4; ++r4) {
#pragma unroll
            for (int rr = 0; rr < 4; ++rr) { const int r = r4 * 4 + rr; const int cb = (r & 3) + 8 * (r >> 2); p0[r] = fmaf(p0[r], C, bp[cb * 8]); p1[r] = fmaf(p1[r], C, bp[(cb + 32) * 8]); }
            SBAR(); }
        float pmax = p0[0];
#pragma unroll
        for (int r = 1; r < 16; ++r) pmax = fmaxf(pmax, p0[r]);
#pragma unroll
        for (int r = 0; r < 16; ++r) pmax = fmaxf(pmax, p1[r]);
        { auto rr = __builtin_amdgcn_permlane32_swap(__float_as_uint(pmax), __float_as_uint(pmax), false, false); pmax = fmaxf(__uint_as_float(rr[0]), __uint_as_float(rr[1])); }
        if (__builtin_expect(__all(pmax - m_reg <= 11.0f), 1)) alpha = 1.f; else { const float mn = fmaxf(m_reg, pmax); alpha = __builtin_amdgcn_exp2f(m_reg - mn); m_reg = mn; }
#pragma unroll
        for (int r = 0; r < 16; ++r) { p0[r] -= m_reg; p1[r] -= m_reg; }
    }
#define SELP(P, W, R, CB) { unsigned m_; asm("v_bfe_i32 %0, %1, " #CB ", 1" : "=v"(m_) : "v"(W)); P[R] = __uint_as_float(__float_as_uint(__builtin_amdgcn_exp2f(P[R])) & m_); }
    SELP(p0, w0, 0, 0) SELP(p0, w0, 1, 1) SELP(p0, w0, 2, 2) SELP(p0, w0, 3, 3) SELP(p0, w0, 4, 8) SELP(p0, w0, 5, 9) SELP(p0, w0, 6, 10) SELP(p0, w0, 7, 11)
    SELP(p0, w0, 8, 16) SELP(p0, w0, 9, 17) SELP(p0, w0, 10, 18) SELP(p0, w0, 11, 19) SELP(p0, w0, 12, 24) SELP(p0, w0, 13, 25) SELP(p0, w0, 14, 26) SELP(p0, w0, 15, 27)
}
__device__ __forceinline__ void att2_finish(f32x16& p0, f32x16& p1, float alpha, float& l_reg, unsigned w1, bf16x8& pa0, bf16x8& pa1, bf16x8& pa2, bf16x8& pa3) {
    SELP(p1, w1, 0, 0) SELP(p1, w1, 1, 1) SELP(p1, w1, 2, 2) SELP(p1, w1, 3, 3) SELP(p1, w1, 4, 8) SELP(p1, w1, 5, 9) SELP(p1, w1, 6, 10) SELP(p1, w1, 7, 11)
    SELP(p1, w1, 8, 16) SELP(p1, w1, 9, 17) SELP(p1, w1, 10, 18) SELP(p1, w1, 11, 19) SELP(p1, w1, 12, 24) SELP(p1, w1, 13, 25) SELP(p1, w1, 14, 26) SELP(p1, w1, 15, 27)
    if (!ATT_LMFMA) {
    float ps = 0.f;
#pragma unroll
    for (int r = 0; r < 16; ++r) ps += p0[r];
#pragma unroll
    for (int r = 0; r < 16; ++r) ps += p1[r];
    { auto rr = __builtin_amdgcn_permlane32_swap(__float_as_uint(ps), __float_as_uint(ps), false, false); ps = __uint_as_float(rr[0]) + __uint_as_float(rr[1]); }
    l_reg = l_reg * alpha + ps; }
#define PK4(P, BASE, OUT) do { unsigned a0 = cvt_pk_bf16(P[BASE + 0], P[BASE + 1]), a1 = cvt_pk_bf16(P[BASE + 2], P[BASE + 3]);   \
    unsigned b0 = cvt_pk_bf16(P[BASE + 4], P[BASE + 5]), b1 = cvt_pk_bf16(P[BASE + 6], P[BASE + 7]);                              \
    auto r0 = __builtin_amdgcn_permlane32_swap(a0, b0, false, false); auto r1 = __builtin_amdgcn_permlane32_swap(a1, b1, false, false); \
    u32x4 w = {r0[0], r1[0], r0[1], r1[1]}; OUT = *reinterpret_cast<bf16x8*>(&w); } while (0)
    PK4(p0, 0, pa0); PK4(p0, 8, pa1); PK4(p1, 0, pa2); PK4(p1, 8, pa3);
#undef PK4
}
template <int abl = 0> __device__ __forceinline__ void attn_item2(Frame& F, int b, int q0, char* lds) {
    const bf16_t* Q = (const bf16_t*)(F.ws + WS_Q); const bf16_t* KV = (const bf16_t*)(F.outb + OUT_KV); const u64* MASK = (const u64*)(F.outb + OUT_MASK);
    bf16_t* OA = (bf16_t*)(F.outb + OUT_OA);
    int tid = F.tid; asm volatile("" : "+v"(tid));
    const int wid = F.wave, lane = tid & 63, r32 = lane & 31, hi = lane >> 5;
    char* V_lds = lds + OFF_V; char* K_lds = lds + OFF_K;
    float* wsl = (float*)(lds + OFF_WS) + wid * 64; float* li_l = wsl; float* al_l = wsl + 32;
    const float* btab = (const float*)(lds + OFF_BT);
    float m_reg = -1e30f, l_reg = 0.f; f32x16 o[4] = {}; bf16x8 qr[8];
    f32x16 lacc = {}; const bf16x8 onesv = {(short)0x3F80, (short)0x3F80, (short)0x3F80, (short)0x3F80, (short)0x3F80, (short)0x3F80, (short)0x3F80, (short)0x3F80};
    const size_t tokq = (size_t)b * SEQ + q0 + r32;
    { const bf16_t* Qw = Q + tokq * 1024 + wid * 128 + hi * 8;
#pragma unroll
      for (int d0 = 0; d0 < 8; ++d0) qr[d0] = *(const bf16x8*)(Qw + d0 * 16); }
    const u64* mq = MASK + tokq * 32;
    const int sr = tid >> 4, sc = (tid & 15) * 8;
    const bf16_t* Kb = KV + (size_t)b * SEQ * 128;
    const int NTr = (q0 >> 6) + 1, NT = (NTr + 1) & ~1;
    const float bfar = btab[wid];
    bf16x8 sA0, sA1, sB0, sB1; if (abl) { sA0 = bf16x8{}; sA1 = sA0; sB0 = sA0; sB1 = sA0; }
#define SLD(s0_, s1_, k0) do { if (abl & 8) break; int srl = sr; asm volatile("" : "+v"(srl)); const bf16_t* kp_ = Kb + (size_t)((k0) + srl) * 128 + sc; s0_ = *(const bf16x8*)kp_; s1_ = *(const bf16x8*)(kp_ + 32 * 128); } while (0)
#define SWR(bf, s0_, s1_) do { if (abl & 8) break; int srv = sr; asm volatile("" : "+v"(srv)); const int kc = sc * 2; const int v0a = v_st(srv, sc), k0a = KSWZ(srv, kc); \
        *(bf16x8*)(V_lds + (bf) * SHM_V + v0a) = s0_; *(bf16x8*)(V_lds + (bf) * SHM_V + v0a + 8192) = s1_; \
        *(bf16x8*)(K_lds + (bf) * SHM_K + k0a) = s0_; *(bf16x8*)(K_lds + (bf) * SHM_K + k0a + 8192) = s1_; } while (0)
#define MWORD(j) ((j) < NTr ? mq[j] : 0ull)
#define RESC(a) do { if (__any((a) < 1.f)) { if (hi == 0) al_l[r32] = (a); LDS_WAIT(); \
        _Pragma("unroll") for (int r = 0; r < 16; ++r) { const float a_ = al_l[crow(r, hi)]; o[0][r] *= a_; o[1][r] *= a_; o[2][r] *= a_; o[3][r] *= a_; if (ATT_LMFMA) lacc[r] *= a_; } } } while (0)
#define PVALL(bf) do { if (abl & 4) break; int ll = lane; asm volatile("" : "+v"(ll)); const int vb = (int)(uintptr_t)V_lds + v_rd_base(ll) + (bf) * SHM_V; \
        pv_one<0>(o[0], vb, pa0, pa1, pa2, pa3); pv_one<1>(o[1], vb, pa0, pa1, pa2, pa3); pv_one<2>(o[2], vb, pa0, pa1, pa2, pa3); pv_one<3>(o[3], vb, pa0, pa1, pa2, pa3); \
        if (ATT_LMFMA) { lacc = __builtin_amdgcn_mfma_f32_32x32x16_bf16(pa0, onesv, lacc, 0, 0, 0); lacc = __builtin_amdgcn_mfma_f32_32x32x16_bf16(pa1, onesv, lacc, 0, 0, 0); \
            lacc = __builtin_amdgcn_mfma_f32_32x32x16_bf16(pa2, onesv, lacc, 0, 0, 0); lacc = __builtin_amdgcn_mfma_f32_32x32x16_bf16(pa3, onesv, lacc, 0, 0, 0); } } while (0)
#define ISFAR(jt) ((jt) * KVBLK + 63 - q0 <= -91 || (jt) >= NTr)
#define BPTR(jt) (btab + ((jt) * KVBLK + 4 * hi - (q0 + r32) + 185) * 8 + wid)
    f32x16 pA0, pA1, pB0, pB1; float alA, alB; bf16x8 pa0, pa1, pa2, pa3; u64 mwA, mwB;
    if (abl) { pA0 = f32x16{}; pA1 = pA0; pB0 = pA0; pB1 = pA0; alA = alB = 1.f; pa0 = bf16x8{}; pa1 = pa0; pa2 = pa0; pa3 = pa0; }
    __syncthreads();
    SLD(sA0, sA1, 0); mwA = MWORD(0); VM_WAIT(); SWR(0, sA0, sA1); __syncthreads();
    if (!(abl & 1)) qkt(pA0, pA1, K_lds, qr, r32, hi);
    if (!(abl & 2)) att2_partial(pA0, pA1, m_reg, alA, (unsigned)(mwA >> (4 * hi)), ISFAR(0), bfar, BPTR(0));
    SLD(sB0, sB1, KVBLK); mwB = MWORD(1); if (2 < NT) SLD(sA0, sA1, 2 * KVBLK);
    SWR(1, sB0, sB1); __syncthreads();
    for (int j = 1; j + 1 < NT; j += 2) {
        SBAR(); if (!(abl & 1)) qkt(pB0, pB1, K_lds + SHM_K, qr, r32, hi);
        if (!(abl & 2)) att2_finish(pA0, pA1, alA, l_reg, (unsigned)(mwA >> (32 + 4 * hi)), pa0, pa1, pa2, pa3); SBAR();
        SLD(sB0, sB1, (j + 2) * KVBLK); mwA = MWORD(j + 1); SBAR();
        PVALL(0);
        if (!(abl & 2)) att2_partial(pB0, pB1, m_reg, alB, (unsigned)(mwB >> (4 * hi)), ISFAR(j), bfar, BPTR(j));
        __syncthreads(); SWR(0, sA0, sA1);
        RESC(alB); __syncthreads();
        SBAR(); if (!(abl & 1)) qkt(pA0, pA1, K_lds, qr, r32, hi);
        if (!(abl & 2)) att2_finish(pB0, pB1, alB, l_reg, (unsigned)(mwB >> (32 + 4 * hi)), pa0, pa1, pa2, pa3); SBAR();
        if (j + 3 < NT) SLD(sA0, sA1, (j + 3) * KVBLK); mwB = MWORD(j + 2); SBAR();
        PVALL(1);
        if (!(abl & 2)) att2_partial(pA0, pA1, m_reg, alA, (unsigned)(mwA >> (4 * hi)), ISFAR(j + 1), bfar, BPTR(j + 1));
        __syncthreads(); SWR(1, sB0, sB1);
        RESC(alA); __syncthreads();
    }
    SBAR(); if (!(abl & 1)) qkt(pB0, pB1, K_lds + SHM_K, qr, r32, hi);
    if (!(abl & 2)) att2_finish(pA0, pA1, alA, l_reg, (unsigned)(mwA >> (32 + 4 * hi)), pa0, pa1, pa2, pa3); SBAR();
    PVALL(0);
    if (!(abl & 2)) att2_partial(pB0, pB1, m_reg, alB, (unsigned)(mwB >> (4 * hi)), ISFAR(NT - 1), bfar, BPTR(NT - 1));
    __syncthreads(); RESC(alB);
    if (!(abl & 2)) att2_finish(pB0, pB1, alB, l_reg, (unsigned)(mwB >> (32 + 4 * hi)), pa0, pa1, pa2, pa3); SBAR();
    PVALL(1);
#undef SLD
#undef SWR
#undef MWORD
#undef RESC
#undef PVALL
#undef ISFAR
#undef BPTR
    LAS float* li_s = (LAS float*)(F.lds + OFF_WS) + wid * 64;
    if (!ATT_LMFMA) { if (hi == 0) li_s[r32] = l_reg; LDS_WAIT(); }
    if (PA_FP8 && ATT_OT) {
        LAS unsigned char* ot = F.lds + OFF_OT + wid * (32 * OT_ST);
        int ob = (4 * hi) * OT_ST + r32, lo = 4 * hi; asm volatile("" : "+v"(ob), "+v"(lo));
#pragma unroll
        for (int r = 0; r < 16; ++r) { const int ro = (r & 3) + 8 * (r >> 2); if ((r & 3) == 0) asm volatile("" : "+v"(ob), "+v"(lo)); const float rl = fast_rcp(ATT_LMFMA ? lacc[r] : li_s[lo + ro]);
#pragma unroll
            for (int d0 = 0; d0 < 4; ++d0) { const float v = o[d0][r] * rl; ot[ob + ro * OT_ST + d0 * 32] = (unsigned char)(__builtin_amdgcn_cvt_pk_fp8_f32(v, v, 0, false) & 0xff); }
            if ((r & 3) == 3) SBAR(); }
        LDS_WAIT(); asm volatile("" ::: "memory");
        unsigned char* Og = (unsigned char*)OA + ((size_t)b * SEQ + q0) * 1024 + wid * 128;
        int rr = lane >> 3, sg = (lane & 7) * 16; asm volatile("" : "+v"(rr), "+v"(sg));
#pragma unroll
        for (int i = 0; i < 4; ++i) { const u32x4 w = *(const LAS u32x4*)(ot + (i * 8 + rr) * OT_ST + sg); *(u32x4*)(Og + (size_t)(i * 8 + rr) * 1024 + sg) = w; }
        LDS_WAIT();
    } else if (PA_FP8) {
        GAS unsigned char* Ow8 = (GAS unsigned char*)((unsigned char*)OA + ((size_t)b * SEQ + q0 + 4 * hi) * 1024 + wid * 128 + r32);
        int lo = 4 * hi; asm volatile("" : "+v"(Ow8), "+v"(lo));
#pragma unroll
        for (int r = 0; r < 16; ++r) { const int ro = (r & 3) + 8 * (r >> 2); if ((r & 3) == 0) asm volatile("" : "+v"(Ow8), "+v"(lo)); const float rl = fast_rcp(ATT_LMFMA ? lacc[r] : li_s[lo + ro]);
#pragma unroll
            for (int d0 = 0; d0 < 4; ++d0) { const float v = o[d0][r] * rl; Ow8[ro * 1024 + d0 * 32] = (unsigned char)(__builtin_amdgcn_cvt_pk_fp8_f32(v, v, 0, false) & 0xff); }
            if ((r & 3) == 3) SBAR(); }
    } else {
        bf16_t* Ow = OA + ((size_t)b * SEQ + q0 + 4 * hi) * 1024 + wid * 128 + r32;
        int lo = 4 * hi; asm volatile("" : "+v"(Ow), "+v"(lo));
#pragma unroll
        for (int r = 0; r < 16; ++r) { const int ro = (r & 3) + 8 * (r >> 2); if ((r & 3) == 0) asm volatile("" : "+v"(Ow), "+v"(lo)); const float rl = fast_rcp(ATT_LMFMA ? lacc[r] : li_s[lo + ro]);
#pragma unroll
            for (int d0 = 0; d0 < 4; ++d0) { const float v = o[d0][r] * rl; Ow[ro * 1024 + d0 * 32] = (bf16_t)(cvt_pk_bf16(v, v) & 0xffffu); }
            if ((r & 3) == 3) SBAR(); }
    }
}
}
template <int abl = 0> __device__ __forceinline__ void ph_attn(Frame& F) {
    char* lds = (char*)(unsigned char*)F.lds;
    { float* bt = (float*)(lds + att::OFF_BT); const float* BT = (const float*)(F.ws + WS_BIAST); __syncthreads(); for (int i = F.tid; i < 249 * 8; i += NTHR) bt[i] = BT[i]; __syncthreads(); }
    for (int pr = F.bid; pr < NB * 32; pr += F.G) {
        const int b = pr >> 5, qb = pr & 31;
#pragma nounroll
        for (int hh = 0; hh < 2; ++hh) { if (ATT2) att::attn_item2<abl>(F, b, (hh ? qb : 63 - qb) * 32, lds); else att::attn_item(F, b, (hh ? qb : 63 - qb) * 32, lds); }
    }
}

namespace ssd {
constexpr int OFF_CS = 0, CS_ST = 272;
constexpr int OFF_BS = OFF_CS + 64 * CS_ST;
constexpr int OFF_BT = OFF_BS + 64 * CS_ST, T_ST = 144;
constexpr int OFF_XT = OFF_BT + 128 * T_ST;
constexpr int OFF_XW = OFF_XT + 64 * T_ST;
constexpr int OFF_XS = OFF_XW + 64 * T_ST;
constexpr int OFF_MT = OFF_XS + 64 * T_ST;
constexpr int OFF_HS = OFF_MT + 64 * T_ST;
constexpr int OFF_END = OFF_HS + 64 * CS_ST;
static_assert(OFF_END + 5 * 320 * 4 <= 131072, "ssd lds");
__device__ __forceinline__ f32x4 mfma16(bf16x8 a, bf16x8 b, f32x4 c) { return __builtin_amdgcn_mfma_f32_16x16x32_bf16(a, b, c, 0, 0, 0); }
__device__ __forceinline__ bf16x8 ldfrag(const char* base, int stride, int row, int k0) { return *(const bf16x8*)(base + row * stride + k0 * 2); }
}
__device__ __forceinline__ void ph_ssd(Frame& F) {
    using namespace ssd;
    char* lds = (char*)(unsigned char*)F.lds;
    const bf16_t* XBC = (const bf16_t*)(F.ws + WS_XBC); const bf16_t* ZS = (const bf16_t*)(F.ws + WS_Z); const float* DT = (const float*)(F.outb + OUT_DT);
    bf16_t* YG = (bf16_t*)(F.ws + WS_Q);
    const float* conv_w = F.a->in[9]; const float* conv_b = F.a->in[10]; const float* a_log = F.a->in[12]; const float* d_skip = F.a->in[13];
    const int tid = F.tid, wid = F.wave, lane = F.lane, fr = lane & 15, fq = lane >> 4;
    const bool stager = tid < 320; const int so = tid % 40, tg = tid / 40;
    for (int item = F.bid; item < NB * 16; item += F.G) {
        const int b = item >> 4, h = item & 15, g = h >> 2;
        const float aneg = -__expf(a_log[h]), dsk = d_skip[h];
        const int ch0 = so < 8 ? h * 64 + so * 8 : (so < 24 ? 1024 + g * 128 + (so - 8) * 8 : 1536 + g * 128 + (so - 24) * 8);
        float* CWL = (float*)(lds + OFF_END);
        __syncthreads();
        if (stager) {
#pragma unroll
            for (int j = 0; j < 4; ++j) { *(f32x4*)(CWL + j * 320 + so * 8) = *(const f32x4*)(conv_w + (size_t)j * 2048 + ch0); *(f32x4*)(CWL + j * 320 + so * 8 + 4) = *(const f32x4*)(conv_w + (size_t)j * 2048 + ch0 + 4); }
            *(f32x4*)(CWL + 4 * 320 + so * 8) = *(const f32x4*)(conv_b + ch0); *(f32x4*)(CWL + 4 * 320 + so * 8 + 4) = *(const f32x4*)(conv_b + ch0 + 4);
        }
        f32x4 hst[4];
#pragma unroll
        for (int t = 0; t < 4; ++t) hst[t] = (f32x4){0.f, 0.f, 0.f, 0.f};
        __syncthreads();
        for (int i = tid; i < 64 * CS_ST / 4; i += NTHR) ((unsigned*)(lds + OFF_HS))[i] = 0u;
        u32x4 raw[11];
        const size_t tokb = (size_t)b * SEQ;
#define SSD_LOAD(c) do { if (stager) { _Pragma("unroll") for (int i = 0; i < 11; ++i) { const int t = (c) * 64 + tg * 8 - 3 + i; \
            raw[i] = (t >= 0) ? *(const u32x4*)(XBC + (tokb + t) * 2048 + ch0) : (u32x4){0u, 0u, 0u, 0u}; } } } while (0)
        SSD_LOAD(0);
        float dtl_next = DT[(tokb + lane) * 16 + h];
        for (int c = 0; c < 32; ++c) {
            const float dtl = dtl_next; if (c + 1 < 32) dtl_next = DT[(tokb + (c + 1) * 64 + lane) * 16 + h];
            u32x2 zpre[2];
#pragma unroll
            for (int t2 = 0; t2 < 2; ++t2) { const int tile = 2 * wid + t2, pb = tile >> 2, lb = tile & 3; zpre[t2] = *(const u32x2*)(ZS + (tokb + c * 64 + lb * 16 + fr) * 1024 + h * 64 + pb * 16 + 4 * fq); }
            float acs = dtl * aneg;
#pragma unroll
            for (int o = 1; o < 64; o <<= 1) { const float t = __shfl_up(acs, o); if (lane >= o) acs += t; }
            const float alast = __shfl(acs, 63);
            if (DBG_SSD_SYNC) __syncthreads();
            float dtv[8], dec[8];
#pragma unroll
            for (int t = 0; t < 8; ++t) { dtv[t] = __shfl(dtl, (tg * 8 + t) & 63); dec[t] = __expf(alast - __shfl(acs, (tg * 8 + t) & 63)); }
            if (stager) {
#pragma unroll
                for (int hq = 0; hq < 2; ++hq) {
                    float xin[11][4];
#pragma unroll
                    for (int i = 0; i < 11; ++i) { const unsigned wa = hq ? raw[i].z : raw[i].x, wb = hq ? raw[i].w : raw[i].y; xin[i][0] = bflo(wa); xin[i][1] = bfhi(wa); xin[i][2] = bflo(wb); xin[i][3] = bfhi(wb); }
                    float outv[8][4];
                    { f32x4 cwv[4]; const f32x4 cbq = *(const f32x4*)(CWL + 4 * 320 + so * 8 + hq * 4);
#pragma unroll
                      for (int j = 0; j < 4; ++j) cwv[j] = *(const f32x4*)(CWL + j * 320 + so * 8 + hq * 4);
#pragma unroll
                      for (int t = 0; t < 8; ++t)
#pragma unroll
                        for (int e = 0; e < 4; ++e) { float sacc = cbq[e];
#pragma unroll
                            for (int j = 0; j < 4; ++j) sacc += cwv[j][e] * xin[t + j][e];
                            outv[t][e] = silu_f(sacc); } }
                    if (so < 8) {
#pragma unroll
                        for (int e = 0; e < 4; ++e) { const int p = so * 8 + hq * 4 + e;
                            f32x4 x0, x1, d0, d1, w0, w1;
#pragma unroll
                            for (int t = 0; t < 4; ++t) { x0[t] = outv[t][e]; x1[t] = outv[4 + t][e]; d0[t] = x0[t] * dtv[t]; d1[t] = x1[t] * dtv[4 + t]; w0[t] = d0[t] * dec[t]; w1[t] = d1[t] * dec[4 + t]; }
                            *(u32x4*)(lds + OFF_XS + p * T_ST + tg * 16) = pack8(x0, x1);
                            *(u32x4*)(lds + OFF_XT + p * T_ST + tg * 16) = pack8(d0, d1);
                            *(u32x4*)(lds + OFF_XW + p * T_ST + tg * 16) = pack8(w0, w1); }
                    } else {
                        const bool isB = so < 24; const int n0 = (isB ? (so - 8) : (so - 24)) * 8 + hq * 4;
                        char* nat = lds + (isB ? OFF_BS : OFF_CS);
#pragma unroll
                        for (int t = 0; t < 8; ++t) { u32x2 w; w.x = cvt_pk_bf16(outv[t][0], outv[t][1]); w.y = cvt_pk_bf16(outv[t][2], outv[t][3]);
                            *(u32x2*)(nat + (tg * 8 + t) * CS_ST + n0 * 2) = w; }
                        if (isB) {
#pragma unroll
                            for (int e = 0; e < 4; ++e) { f32x4 a, bq;
#pragma unroll
                                for (int t = 0; t < 4; ++t) { a[t] = outv[t][e]; bq[t] = outv[4 + t][e]; }
                                *(u32x4*)(lds + OFF_BT + (n0 + e) * T_ST + tg * 16) = pack8(a, bq); }
                        }
                    }
                }
            }
            if (c + 1 < 32) SSD_LOAD(c + 1);
            __syncthreads();
#pragma unroll
            for (int t2 = 0; t2 < 2; ++t2) {
                const int tile = 2 * wid + t2, sb = tile >> 2, lb = tile & 3;
                f32x4 d = (f32x4){0.f, 0.f, 0.f, 0.f};
                if (sb <= lb) {
#pragma unroll
                    for (int ks = 0; ks < 4; ++ks) d = mfma16(ldfrag(lds + OFF_BS, CS_ST, sb * 16 + fr, ks * 32 + fq * 8), ldfrag(lds + OFF_CS, CS_ST, lb * 16 + fr, ks * 32 + fq * 8), d);
                    const int l = lb * 16 + fr; const float al = __shfl(acs, l);
                    f32x4 as;
#pragma unroll
                    for (int r = 0; r < 4; ++r) as[r] = __shfl(acs, sb * 16 + 4 * fq + r);
#pragma unroll
                    for (int r = 0; r < 4; ++r) { const int s = sb * 16 + 4 * fq + r; d[r] = (s <= l) ? d[r] * __expf(al - as[r]) : 0.f; }
                }
                u32x2 w; w.x = cvt_pk_bf16(d[0], d[1]); w.y = cvt_pk_bf16(d[2], d[3]);
                *(u32x2*)(lds + OFF_MT + (lb * 16 + fr) * T_ST + (sb * 16 + 4 * fq) * 2) = w;
            }
            if (DBG_SSD_SYNC) __syncthreads();
            f32x4 yacc[2];
#pragma unroll
            for (int t2 = 0; t2 < 2; ++t2) {
                const int tile = 2 * wid + t2, pb = tile >> 2, lb = tile & 3;
                f32x4 d = (f32x4){0.f, 0.f, 0.f, 0.f};
#pragma unroll
                for (int ks = 0; ks < 4; ++ks) d = mfma16(ldfrag(lds + OFF_HS, CS_ST, pb * 16 + fr, ks * 32 + fq * 8), ldfrag(lds + OFF_CS, CS_ST, lb * 16 + fr, ks * 32 + fq * 8), d);
                const float el = __expf(__shfl(acs, lb * 16 + fr));
                yacc[t2] = d * el;
            }
            __syncthreads();
#pragma unroll
            for (int t2 = 0; t2 < 2; ++t2) {
                const int tile = 2 * wid + t2, pb = tile >> 2, lb = tile & 3;
                f32x4 d = yacc[t2];
#pragma unroll
                for (int ks = 0; ks < 2; ++ks) d = mfma16(ldfrag(lds + OFF_XT, T_ST, pb * 16 + fr, ks * 32 + fq * 8), ldfrag(lds + OFF_MT, T_ST, lb * 16 + fr, ks * 32 + fq * 8), d);
                const int l = lb * 16 + fr, p0 = pb * 16 + 4 * fq; const size_t tok = tokb + c * 64 + l;
                const u32x2 zz = zpre[t2];
                const float z0 = bflo(zz.x), z1 = bfhi(zz.x), z2 = bflo(zz.y), z3 = bfhi(zz.y);
                float xs[4];
#pragma unroll
                for (int r = 0; r < 4; ++r) xs[r] = bflo((unsigned)*(const bf16_t*)(lds + OFF_XS + (p0 + r) * T_ST + l * 2));
                u32x2 w; w.x = cvt_pk_bf16((d[0] + xs[0] * dsk) * z0, (d[1] + xs[1] * dsk) * z1); w.y = cvt_pk_bf16((d[2] + xs[2] * dsk) * z2, (d[3] + xs[3] * dsk) * z3);
                *(u32x2*)(YG + tok * 1024 + h * 64 + p0) = w;
            }
            if (DBG_SSD_SYNC) __syncthreads();
            { const float dc = __expf(alast);
#pragma unroll
              for (int t = 0; t < 4; ++t) { f32x4 d = hst[t] * dc;
#pragma unroll
                  for (int ks = 0; ks < 2; ++ks) d = mfma16(ldfrag(lds + OFF_BT, T_ST, wid * 16 + fr, ks * 32 + fq * 8), ldfrag(lds + OFF_XW, T_ST, t * 16 + fr, ks * 32 + fq * 8), d);
                  hst[t] = d;
                  u32x2 w; w.x = cvt_pk_bf16(d[0], d[1]); w.y = cvt_pk_bf16(d[2], d[3]);
                  *(u32x2*)(lds + OFF_HS + (t * 16 + fr) * CS_ST + (wid * 16 + 4 * fq) * 2) = w; } }
            __syncthreads();
        }
#undef SSD_LOAD
    }
}

namespace ssd2 {
constexpr int CS_ST = 272, T_ST = 144;
constexpr int OFF_CS = 0, OFF_BS = 64 * CS_ST, OFF_BT = 2 * 64 * CS_ST, OFF_H0 = OFF_BT + 128 * T_ST;
constexpr int H_XS = 0, H_XW = 64 * T_ST, H_MT = 2 * 64 * T_ST, H_HS = 3 * 64 * T_ST, H_SZ = H_HS + 64 * CS_ST;
constexpr int OFF_CW = OFF_H0 + 2 * H_SZ;
constexpr int OFF_TAB = OFF_CW + 5 * 384 * 4;
static_assert(OFF_TAB + 6 * 64 * 4 <= LDS_MISC, "ssd2 lds");
}
__device__ __forceinline__ void ph_ssd2(Frame& F, const int abl = 0) {
    using namespace ssd2; using ssd::mfma16; using ssd::ldfrag;
    char* lds = (char*)(unsigned char*)F.lds;
    const bf16_t* XBC = (const bf16_t*)(F.ws + WS_XBC); const bf16_t* ZS = (const bf16_t*)(F.ws + WS_Z); const float* DT = (const float*)(F.outb + OUT_DT);
    bf16_t* YG = (bf16_t*)(F.ws + WS_Q);
    const float* conv_w = F.a->in[9]; const float* conv_b = F.a->in[10]; const float* a_log = F.a->in[12]; const float* d_skip = F.a->in[13];
    const int tid = F.tid, wid = F.wave, lane = F.lane, fr = lane & 15, fq = lane >> 4;
    const int su = tid < 384 ? tid : tid - 128; const bool cwl_writer = true;
    const int cp_lo = __builtin_amdgcn_readfirstlane(tid < 384 ? 0 : 2), cp_hi = __builtin_amdgcn_readfirstlane(tid < 256 ? 4 : (tid < 384 ? 2 : 4));
    const int so = su % 48, tg = su / 48, shd = (so >> 3) & 1;
    for (int item = F.bid; item < NB * 8; item += F.G) {
        const int b = item >> 3, g = (item >> 1) & 3, h0 = g * 4 + (item & 1) * 2;
        const float aneg0 = -__expf(a_log[h0]), aneg1 = -__expf(a_log[h0 + 1]), dsk0 = d_skip[h0], dsk1 = d_skip[h0 + 1];
        const int ch0 = so < 16 ? (h0 + shd) * 64 + (so & 7) * 8 : (so < 32 ? 1024 + g * 128 + (so - 16) * 8 : 1536 + g * 128 + (so - 32) * 8);
        float* CWL = (float*)(lds + OFF_CW);
        __syncthreads();
        if (cwl_writer) {
#pragma unroll
            for (int j = 0; j < 4; ++j) { *(f32x4*)(CWL + j * 384 + so * 8) = *(const f32x4*)(conv_w + (size_t)j * 2048 + ch0); *(f32x4*)(CWL + j * 384 + so * 8 + 4) = *(const f32x4*)(conv_w + (size_t)j * 2048 + ch0 + 4); }
            *(f32x4*)(CWL + 4 * 384 + so * 8) = *(const f32x4*)(conv_b + ch0); *(f32x4*)(CWL + 4 * 384 + so * 8 + 4) = *(const f32x4*)(conv_b + ch0 + 4);
        }
        f32x4 hst[2][4];
#pragma unroll
        for (int hh = 0; hh < 2; ++hh)
#pragma unroll
            for (int t = 0; t < 4; ++t) hst[hh][t] = (f32x4){0.f, 0.f, 0.f, 0.f};
        for (int i = tid; i < 64 * CS_ST / 4; i += NTHR) { ((unsigned*)(lds + OFF_H0 + H_HS))[i] = 0u; ((unsigned*)(lds + OFF_H0 + H_SZ + H_HS))[i] = 0u; }
        u32x4 raw[11];
        const size_t tokb = (size_t)b * SEQ;
        const bf16_t* xrow = XBC + ((ptrdiff_t)tokb + tg * 8 - 3) * 2048 + ch0;
#define SSD_LOAD(c, xp, tgx) do { { _Pragma("unroll") for (int i = 0; i < 11; ++i) { const int t = (c) * 64 + (tgx) * 8 - 3 + i; \
            raw[i] = (t >= 0) ? *(const GAS u32x4*)((xp) + (ptrdiff_t)((c) * 64 + i) * 2048) : (u32x4){0u, 0u, 0u, 0u}; } } } while (0)
        SSD_LOAD(0, xrow, tg);
        f32x2 dtn = *(const f32x2*)(DT + (tokb + lane) * 16 + h0);
        for (int c = 0; c < 32; ++c) {
            int frl = fr, fql = fq, tgl = tg, sol = so; const bf16_t* xrl = xrow; asm volatile("" : "+v"(frl), "+v"(fql), "+v"(tgl), "+v"(sol), "+v"(xrl)); const int shdl = (sol >> 3) & 1;
            const float dtl0 = dtn[0], dtl1 = dtn[1]; if (c + 1 < 32) dtn = *(const f32x2*)(DT + (tokb + (c + 1) * 64 + lane) * 16 + h0);
            u32x2 zpre[2][2];
#pragma unroll
            for (int hh = 0; hh < 2; ++hh)
#pragma unroll
                for (int t2 = 0; t2 < 2; ++t2) { const int tile = 2 * wid + t2, pb = tile >> 2, lb = tile & 3; zpre[hh][t2] = *(const u32x2*)(ZS + (tokb + c * 64 + lb * 16 + frl) * 1024 + (h0 + hh) * 64 + pb * 16 + 4 * fql); }
            const float acs0 = dpp_scan_add(dtl0 * aneg0), acs1 = dpp_scan_add(dtl1 * aneg1);
            const float alast0 = __builtin_bit_cast(float, __builtin_amdgcn_readlane(__builtin_bit_cast(int, acs0), 63)), alast1 = __builtin_bit_cast(float, __builtin_amdgcn_readlane(__builtin_bit_cast(int, acs1), 63));
            float* TAB = (float*)(lds + OFF_TAB);
            TAB[lane] = acs0; TAB[64 + lane] = acs1; TAB[128 + lane] = dtl0; TAB[192 + lane] = dtl1; TAB[256 + lane] = dtl0 * __expf(alast0 - acs0); TAB[320 + lane] = dtl1 * __expf(alast1 - acs1);
            LDS_WAIT(); asm volatile("" ::: "memory");
            float wdt[8];
            { const f32x4 wa = *(const f32x4*)(TAB + 256 + shdl * 64 + tgl * 8), wb = *(const f32x4*)(TAB + 256 + shdl * 64 + tgl * 8 + 4);
#pragma unroll
              for (int t = 0; t < 4; ++t) { wdt[t] = wa[t]; wdt[4 + t] = wb[t]; } }
            if (!(abl & 1)) {
#pragma unroll
                for (int cp = 0; cp < 4; ++cp) {
                    if (cp < cp_lo || cp >= cp_hi) continue;
                    float xin[11][2];
#pragma unroll
                    for (int i = 0; i < 11; ++i) { const unsigned wa = cp == 0 ? raw[i].x : (cp == 1 ? raw[i].y : (cp == 2 ? raw[i].z : raw[i].w)); xin[i][0] = bflo(wa); xin[i][1] = bfhi(wa); }
                    float outv[8][2];
                    { f32x2 cwv[4]; const f32x2 cbq = *(const f32x2*)(CWL + 4 * 384 + sol * 8 + cp * 2);
#pragma unroll
                      for (int j = 0; j < 4; ++j) cwv[j] = *(const f32x2*)(CWL + j * 384 + sol * 8 + cp * 2);
#pragma unroll
                      for (int t = 0; t < 8; ++t)
#pragma unroll
                        for (int e = 0; e < 2; ++e) { float sacc = cbq[e];
#pragma unroll
                            for (int j = 0; j < 4; ++j) sacc += cwv[j][e] * xin[t + j][e];
                            outv[t][e] = silu_f(sacc); } }
                    if (sol < 16) {
                        char* hb = lds + OFF_H0 + shdl * H_SZ;
#pragma unroll
                        for (int e = 0; e < 2; ++e) { const int p = (sol & 7) * 8 + cp * 2 + e;
                            f32x4 x0, x1, w0, w1;
#pragma unroll
                            for (int t = 0; t < 4; ++t) { x0[t] = outv[t][e]; x1[t] = outv[4 + t][e]; w0[t] = x0[t] * wdt[t]; w1[t] = x1[t] * wdt[4 + t]; }
                            *(u32x4*)(hb + H_XS + p * T_ST + tgl * 16) = pack8(x0, x1);
                            *(u32x4*)(hb + H_XW + p * T_ST + tgl * 16) = pack8(w0, w1); }
                    } else {
                        const bool isB = sol < 32; const int n0 = (isB ? (sol - 16) : (sol - 32)) * 8 + cp * 2;
                        char* nat = lds + (isB ? OFF_BS : OFF_CS);
#pragma unroll
                        for (int t = 0; t < 8; ++t) *(unsigned*)(nat + (tgl * 8 + t) * CS_ST + n0 * 2) = cvt_pk_bf16(outv[t][0], outv[t][1]);
                        if (isB) {
#pragma unroll
                            for (int e = 0; e < 2; ++e) { f32x4 a, bq;
#pragma unroll
                                for (int t = 0; t < 4; ++t) { a[t] = outv[t][e]; bq[t] = outv[4 + t][e]; }
                                *(u32x4*)(lds + OFF_BT + (n0 + e) * T_ST + tgl * 16) = pack8(a, bq); }
                        }
                    }
                    SBAR();
                }
            }
            if (c + 1 < 32) SSD_LOAD(c + 1, xrl, tgl);
            __syncthreads();
            bf16x8 cfr[2][4];
#pragma unroll
            for (int t2 = 0; t2 < 2; ++t2)
#pragma unroll
                for (int ks = 0; ks < 4; ++ks) cfr[t2][ks] = ldfrag(lds + OFF_CS, CS_ST, ((2 * wid + t2) & 3) * 16 + frl, ks * 32 + fql * 8);
            if (!(abl & 2))
#pragma unroll
            for (int t2 = 0; t2 < 2; ++t2) {
                const int tile = 2 * wid + t2, sb = tile >> 2, lb = tile & 3;
                f32x4 d = (f32x4){0.f, 0.f, 0.f, 0.f}, m0 = d, m1 = d;
                if (sb <= lb) {
#pragma unroll
                    for (int ks = 0; ks < 4; ++ks) d = mfma16(ldfrag(lds + OFF_BS, CS_ST, sb * 16 + frl, ks * 32 + fql * 8), cfr[t2][ks], d);
                    const int l = lb * 16 + frl, s4 = sb * 16 + 4 * fql; const float al0 = TAB[l], al1 = TAB[64 + l];
                    const f32x4 as0 = *(const f32x4*)(TAB + s4), as1 = *(const f32x4*)(TAB + 64 + s4), ds0 = *(const f32x4*)(TAB + 128 + s4), ds1 = *(const f32x4*)(TAB + 192 + s4);
#pragma unroll
                    for (int r = 0; r < 4; ++r) { const int sidx = s4 + r;
                        m0[r] = (sidx <= l) ? d[r] * __expf(al0 - as0[r]) * ds0[r] : 0.f; m1[r] = (sidx <= l) ? d[r] * __expf(al1 - as1[r]) * ds1[r] : 0.f; }
                }
                u32x2 w; w.x = cvt_pk_bf16(m0[0], m0[1]); w.y = cvt_pk_bf16(m0[2], m0[3]);
                *(u32x2*)(lds + OFF_H0 + H_MT + (lb * 16 + frl) * T_ST + (sb * 16 + 4 * fql) * 2) = w;
                w.x = cvt_pk_bf16(m1[0], m1[1]); w.y = cvt_pk_bf16(m1[2], m1[3]);
                *(u32x2*)(lds + OFF_H0 + H_SZ + H_MT + (lb * 16 + frl) * T_ST + (sb * 16 + 4 * fql) * 2) = w;
            }
            f32x4 yacc[2][2];
#pragma unroll
            for (int hh = 0; hh < 2; ++hh)
#pragma unroll
                for (int t2 = 0; t2 < 2; ++t2) {
                    const int tile = 2 * wid + t2, pb = tile >> 2, lb = tile & 3; const char* hb = lds + OFF_H0 + hh * H_SZ;
                    f32x4 d = (f32x4){0.f, 0.f, 0.f, 0.f};
                    if (!(abl & 2))
#pragma unroll
                    for (int ks = 0; ks < 4; ++ks) d = mfma16(ldfrag(hb + H_HS, CS_ST, pb * 16 + frl, ks * 32 + fql * 8), cfr[t2][ks], d);
                    const float el = __expf(TAB[hh * 64 + lb * 16 + frl]);
                    yacc[hh][t2] = d * el;
                }
            __syncthreads();
            if (!(abl & 4))
#pragma unroll
            for (int hh = 0; hh < 2; ++hh)
#pragma unroll
                for (int t2 = 0; t2 < 2; ++t2) {
                    const int tile = 2 * wid + t2, pb = tile >> 2, lb = tile & 3; const char* hb = lds + OFF_H0 + hh * H_SZ;
                    f32x4 d = yacc[hh][t2];
#pragma unroll
                    for (int ks = 0; ks < 2; ++ks) d = mfma16(ldfrag(hb + H_XS, T_ST, pb * 16 + frl, ks * 32 + fql * 8), ldfrag(hb + H_MT, T_ST, lb * 16 + frl, ks * 32 + fql * 8), d);
                    const int l = lb * 16 + frl, p0 = pb * 16 + 4 * fql; const size_t tok = tokb + c * 64 + l; const float dsk = hh ? dsk1 : dsk0;
                    const u32x2 zz = zpre[hh][t2];
                    const float z0 = bflo(zz.x), z1 = bfhi(zz.x), z2 = bflo(zz.y), z3 = bfhi(zz.y);
                    float xs[4];
#pragma unroll
                    for (int r = 0; r < 4; ++r) xs[r] = bflo((unsigned)*(const bf16_t*)(hb + H_XS + (p0 + r) * T_ST + l * 2));
                    u32x2 w; w.x = cvt_pk_bf16((d[0] + xs[0] * dsk) * z0, (d[1] + xs[1] * dsk) * z1); w.y = cvt_pk_bf16((d[2] + xs[2] * dsk) * z2, (d[3] + xs[3] * dsk) * z3);
                    *(u32x2*)(YG + tok * 1024 + (h0 + hh) * 64 + p0) = w;
                }
            const bf16x8 btf0 = ldfrag(lds + OFF_BT, T_ST, wid * 16 + frl, fql * 8), btf1 = ldfrag(lds + OFF_BT, T_ST, wid * 16 + frl, 32 + fql * 8);
            if (!(abl & 8))
#pragma unroll
            for (int hh = 0; hh < 2; ++hh) { const float dc = __expf(hh ? alast1 : alast0); char* hb = lds + OFF_H0 + hh * H_SZ;
#pragma unroll
                for (int t = 0; t < 4; ++t) { f32x4 d = hst[hh][t] * dc;
#pragma unroll
                    for (int ks = 0; ks < 2; ++ks) d = mfma16(ks ? btf1 : btf0, ldfrag(hb + H_XW, T_ST, t * 16 + frl, ks * 32 + fql * 8), d);
                    hst[hh][t] = d;
                    u32x2 w; w.x = cvt_pk_bf16(d[0], d[1]); w.y = cvt_pk_bf16(d[2], d[3]);
                    *(u32x2*)(hb + H_HS + (t * 16 + frl) * CS_ST + (wid * 16 + 4 * fql) * 2) = w; } }
            __syncthreads();
        }
#undef SSD_LOAD
    }
}

__device__ __forceinline__ void ph_gnorm(Frame& F) {
    bf16_t* YG = (bf16_t*)(F.ws + WS_Q);
    const int gw = F.bid * NWAVES + F.wave, NGW = F.G * NWAVES;
    constexpr int RB = 4;
    for (int m0 = gw * RB; m0 < NTOK; m0 += NGW * RB) {
        u32x2 w[RB][4];
#pragma unroll
        for (int r = 0; r < RB; ++r) { const u32x2* rp = (const u32x2*)(YG + (size_t)(m0 + r) * D) + F.lane;
#pragma unroll
            for (int j = 0; j < 4; ++j) w[r][j] = rp[64 * j]; }
#pragma unroll
        for (int r = 0; r < RB; ++r) { const int m = m0 + r; u32x2* rp = (u32x2*)(YG + (size_t)m * D) + F.lane;
#pragma unroll
            for (int j = 0; j < 4; ++j) { const float a = bflo(w[r][j].x), b = bfhi(w[r][j].x), c = bflo(w[r][j].y), d = bfhi(w[r][j].y);
                const float ss = wave_sum(a * a + b * b + c * c + d * d); const float rr = 1.f / sqrtf(ss * (1.f / 256.f) + LN_EPS);
                if (PB_FP8) { int pk = 0; pk = __builtin_amdgcn_cvt_pk_fp8_f32(a * rr, b * rr, pk, false); pk = __builtin_amdgcn_cvt_pk_fp8_f32(c * rr, d * rr, pk, true); ((unsigned*)(F.outb + OUT_OB8 + (size_t)m * D))[F.lane + 64 * j] = (unsigned)pk; }
                else { u32x2 o; o.x = cvt_pk_bf16(a * rr, b * rr); o.y = cvt_pk_bf16(c * rr, d * rr); rp[64 * j] = o; } } }
    }
}

template <bool DRY = false> __device__ __forceinline__ void ph_router(Frame& F) {
    const bf16_t* VB = (const bf16_t*)(F.ws + WS_VB); bf16_t* X1B = (bf16_t*)(F.ws + WS_X1B); bf16_t* U2 = (bf16_t*)(F.ws + WS_U2); const float* MOD = (const float*)(F.ws + WS_MOD);
    const float* ln1g = F.a->in[18]; const float* ln1b = F.a->in[19]; const float* w_router = F.a->in[20]; const float* b_router = F.a->in[21];
    u32x2* REG = (u32x2*)(F.ws + WS_REG); unsigned* CNT = (unsigned*)(F.ws + WS_CTL) + CW_CNT;
    constexpr int TST = 2064;
    LAS unsigned char* THI = F.lds; LAS unsigned char* TLO = F.lds + 16 * TST; LAS float* PART = (LAS float*)(F.lds + 32 * TST);
    LAS unsigned* lcnt = (LAS unsigned*)(F.lds + LDS_AUX); LAS unsigned* lbase = lcnt + 32; LAS unsigned* ent = lcnt + 64;
    const int tid = F.tid, lane = F.lane, wid = F.wave, fr = lane & 15, fq = lane >> 4;
    bf16x8 whi[4][2], wlo[4][2];
#pragma unroll
    for (int ks = 0; ks < 4; ++ks)
#pragma unroll
        for (int ct = 0; ct < 2; ++ct) { float wv[8];
#pragma unroll
            for (int i = 0; i < 8; ++i) wv[i] = w_router[(size_t)(128 * wid + 32 * ks + 8 * fq + i) * 32 + ct * 16 + fr];
            u32x4 h, l2;
#pragma unroll
            for (int i = 0; i < 4; ++i) { const unsigned hp = cvt_pk_bf16(wv[2 * i], wv[2 * i + 1]); const float r0 = wv[2 * i] - bflo(hp), r1 = wv[2 * i + 1] - bfhi(hp); h[i] = hp; l2[i] = cvt_pk_bf16(r0, r1); }
            whi[ks][ct] = __builtin_bit_cast(bf16x8, h); wlo[ks][ct] = __builtin_bit_cast(bf16x8, l2); }
    const float brl = b_router[lane & 31];
    f32x4 lg[4], lb[4];
#pragma unroll
    for (int j = 0; j < 4; ++j) { lg[j] = *((const f32x4*)ln1g + lane + 64 * j); lb[j] = *((const f32x4*)ln1b + lane + 64 * j); }
    for (int batch = F.bid; batch < NTOK / 256; batch += F.G) {
        const int hf = batch >> 7;
        f32x4 shv[4], scv[4];
        { const float* md = MOD + (size_t)((batch * 256) >> 11) * 6144;
#pragma unroll
          for (int j = 0; j < 4; ++j) { shv[j] = *((const f32x4*)(md + 3072) + lane + 64 * j); scv[j] = *((const f32x4*)(md + 4096) + lane + 64 * j); } }
        __syncthreads();
        if (tid < 32) lcnt[tid] = 0u;
        for (int grp = 0; grp < 16; ++grp) {
#pragma unroll
            for (int tt = 0; tt < 2; ++tt) {
                const int tg16 = 2 * wid + tt, m = batch * 256 + grp * 16 + tg16; const float* md = MOD + (size_t)(m >> 11) * 6144;
                const u32x2* vr = (const u32x2*)(VB + (size_t)m * D) + lane; u32x2* xr = (u32x2*)(X1B + (size_t)m * D) + lane;
                f32x4 v[4]; float s = 0.f;
#pragma unroll
                for (int j = 0; j < 4; ++j) { const u32x2 w = vr[64 * j]; v[j] = (f32x4){bflo(w.x), bfhi(w.x), bflo(w.y), bfhi(w.y)}; s += (v[j][0] + v[j][1]) + (v[j][2] + v[j][3]); }
                float mean = wave_sum(s) * (1.f / D), s2 = 0.f;
#pragma unroll
                for (int j = 0; j < 4; ++j) { v[j] = v[j] - mean; s2 += (v[j][0] * v[j][0] + v[j][1] * v[j][1]) + (v[j][2] * v[j][2] + v[j][3] * v[j][3]); }
                float rstd = 1.f / sqrtf(wave_sum(s2) * (1.f / D) + LN_EPS);
                s = 0.f;
#pragma unroll
                for (int j = 0; j < 4; ++j) { v[j] = v[j] * rstd * lg[j] + lb[j]; if (!DRY) { u32x2 w; w.x = cvt_pk_bf16(v[j][0], v[j][1]); w.y = cvt_pk_bf16(v[j][2], v[j][3]); xr[64 * j] = w; } s += (v[j][0] + v[j][1]) + (v[j][2] + v[j][3]); }
                mean = wave_sum(s) * (1.f / D); s2 = 0.f;
#pragma unroll
                for (int j = 0; j < 4; ++j) { v[j] = v[j] - mean; s2 += (v[j][0] * v[j][0] + v[j][1] * v[j][1]) + (v[j][2] * v[j][2] + v[j][3] * v[j][3]); }
                rstd = 1.f / sqrtf(wave_sum(s2) * (1.f / D) + LN_EPS);
                u32x2* o8 = (u32x2*)(U2 + (size_t)m * D) + lane;
#pragma unroll
                for (int j = 0; j < 4; ++j) {
                    v[j] = v[j] * rstd * (scv[j] + 1.0f) + shv[j]; u32x2 w; w.x = cvt_pk_bf16(v[j][0], v[j][1]); w.y = cvt_pk_bf16(v[j][2], v[j][3]);
                    if (DRY) { if (w.x == 0x12345678u) o8[64 * j] = w; }
                    else if (MOE_FP8) { int pk = 0; pk = __builtin_amdgcn_cvt_pk_fp8_f32(v[j][0], v[j][1], pk, false); pk = __builtin_amdgcn_cvt_pk_fp8_f32(v[j][2], v[j][3], pk, true); ((unsigned*)((unsigned char*)U2 + (size_t)m * D))[lane + 64 * j] = (unsigned)pk; }
                    else o8[64 * j] = w;
                    u32x2 lo; lo.x = cvt_pk_bf16(v[j][0] - bflo(w.x), v[j][1] - bfhi(w.x)); lo.y = cvt_pk_bf16(v[j][2] - bflo(w.y), v[j][3] - bfhi(w.y));
                    *(LAS u32x2*)(THI + tg16 * TST + (4 * lane + 256 * j) * 2) = w; *(LAS u32x2*)(TLO + tg16 * TST + (4 * lane + 256 * j) * 2) = lo; }
            }
            __syncthreads();
            { f32x4 a0 = (f32x4){0.f, 0.f, 0.f, 0.f}, a1 = a0;
#pragma unroll
              for (int ks = 0; ks < 4; ++ks) { const int cb = (128 * wid + 32 * ks + 8 * fq) * 2;
                  const bf16x8 th = *(const LAS bf16x8*)(THI + fr * TST + cb), tl = *(const LAS bf16x8*)(TLO + fr * TST + cb);
                  a0 = __builtin_amdgcn_mfma_f32_16x16x32_bf16(whi[ks][0], th, a0, 0, 0, 0); a1 = __builtin_amdgcn_mfma_f32_16x16x32_bf16(whi[ks][1], th, a1, 0, 0, 0);
                  a0 = __builtin_amdgcn_mfma_f32_16x16x32_bf16(wlo[ks][0], th, a0, 0, 0, 0); a1 = __builtin_amdgcn_mfma_f32_16x16x32_bf16(wlo[ks][1], th, a1, 0, 0, 0);
                  a0 = __builtin_amdgcn_mfma_f32_16x16x32_bf16(whi[ks][0], tl, a0, 0, 0, 0); a1 = __builtin_amdgcn_mfma_f32_16x16x32_bf16(whi[ks][1], tl, a1, 0, 0, 0); }
              *(LAS f32x4*)(PART + (wid * 16 + fr) * 32 + 4 * fq) = a0; *(LAS f32x4*)(PART + (wid * 16 + fr) * 32 + 16 + 4 * fq) = a1; }
            __syncthreads();
            { const int tg16 = 2 * wid + (lane >> 5), tl = grp * 16 + tg16, myexp = lane & 31;
              float logit = brl;
#pragma unroll
              for (int w8 = 0; w8 < 8; ++w8) logit += PART[(w8 * 16 + tg16) * 32 + myexp];
              float tv[4]; int tix[4];
#pragma unroll
              for (int k = 0; k < 4; ++k) { float bv = logit; int bi = myexp;
#define RT_STEP(ctrl, rm) do { const float ov = __builtin_bit_cast(float, __builtin_amdgcn_update_dpp((int)0xff800000u, __builtin_bit_cast(int, bv), (ctrl), (rm), 0xf, false)); \
                      const int oi = __builtin_amdgcn_update_dpp(64, bi, (ctrl), (rm), 0xf, false); if (ov > bv || (ov == bv && oi < bi)) { bv = ov; bi = oi; } } while (0)
                  RT_STEP(0x111, 0xf); RT_STEP(0x112, 0xf); RT_STEP(0x114, 0xf); RT_STEP(0x118, 0xf); RT_STEP(0x142, 0xa);
#undef RT_STEP
                  { const int b0 = __builtin_amdgcn_readlane(__builtin_bit_cast(int, bv), 31), b1 = __builtin_amdgcn_readlane(__builtin_bit_cast(int, bv), 63), i0 = __builtin_amdgcn_readlane(bi, 31), i1 = __builtin_amdgcn_readlane(bi, 63);
                    bv = __builtin_bit_cast(float, lane < 32 ? b0 : b1); bi = lane < 32 ? i0 : i1; }
                  tv[k] = bv; tix[k] = bi; if (myexp == bi) logit = -INFINITY; }
              const float e1 = __expf(tv[1] - tv[0]), e2 = __expf(tv[2] - tv[0]), e3 = __expf(tv[3] - tv[0]); const float inv = 1.f / (1.f + e1 + e2 + e3);
              if (myexp < 4) { const int ee = myexp == 0 ? tix[0] : (myexp == 1 ? tix[1] : (myexp == 2 ? tix[2] : tix[3])); const float gg = (myexp == 0 ? 1.f : (myexp == 1 ? e1 : (myexp == 2 ? e2 : e3))) * inv;
                  const unsigned lp = atomicAdd((unsigned*)&lcnt[ee], 1u);
                  LAS unsigned* en = ent + (tl * 4 + myexp) * 3; en[0] = (unsigned)ee; en[1] = lp; en[2] = __float_as_uint(gg);
                  if (DBG_CHECK == 1) { u32x2 rw; rw.x = (unsigned)ee; rw.y = __float_as_uint(gg); ((u32x2*)(F.ws + WS_DBG))[(size_t)(batch * 256 + tl) * 4 + myexp] = rw; } } }
        }
        __syncthreads();
        if (tid < 32) lbase[tid] = DRY ? 0u : __hip_atomic_fetch_add(CNT + 64 * (hf * 32 + tid), lcnt[tid], __ATOMIC_RELAXED, __HIP_MEMORY_SCOPE_AGENT);
        __syncthreads();
        for (int i = tid; i < 1024; i += NTHR) { const LAS unsigned* en = ent + i * 3; const unsigned ee = en[0], pos = lbase[ee] + en[1];
            const unsigned tokl = (unsigned)(batch * 256 + (i >> 2)) - (unsigned)hf * HALF_TOK;
            u32x2 w; w.x = tokl * 4u + (unsigned)(i & 3); w.y = en[2];
            if (!DRY && pos < (unsigned)REG_CAP) REG[((size_t)hf * 32 + ee) * REG_CAP + pos] = w; }
    }
}

template <bool DRY = false> __device__ __forceinline__ void ph_final(Frame& F, int hf) {
    float* OUT = (float*)F.outb; const bf16_t* X1B = (const bf16_t*)(F.ws + WS_X1B); const bf16_t* YB = (const bf16_t*)(F.ws + WS_YB); const float* MOD = (const float*)(F.ws + WS_MOD);
    const float* g2 = F.a->in[26]; const float* b2 = F.a->in[27];
    const int gw = F.bid * NWAVES + F.wave, NGW = F.G * NWAVES, lane = F.lane;
    constexpr int RB = 2;
    f32x4 g2v[4], b2v[4];
#pragma unroll
    for (int j = 0; j < 4; ++j) { g2v[j] = *((const f32x4*)g2 + lane + 64 * j); b2v[j] = *((const f32x4*)b2 + lane + 64 * j); }
    const int RPW = (((HALF_TOK + NGW - 1) / NGW) + RB - 1) / RB * RB, tbeg = gw * RPW, tend = (tbeg + RPW < HALF_TOK) ? tbeg + RPW : HALF_TOK;
    f32x4 gtv[4]; int curb = -1;
    for (int tl0 = tbeg; tl0 < tend; tl0 += RB) {
        { const int bb = (hf * HALF_TOK + tl0) >> 11; if (bb != curb) { curb = bb; const float* md = MOD + (size_t)bb * 6144 + 5120;
#pragma unroll
            for (int j = 0; j < 4; ++j) gtv[j] = *((const f32x4*)md + lane + 64 * j); } }
        u32x2 xw[RB][4]; u32x2 yw[RB][4][4];
#pragma unroll
        for (int r = 0; r < RB; ++r) { const int tl = tl0 + r, m = hf * HALF_TOK + tl;
            const u32x2* xr = (const u32x2*)(X1B + (size_t)m * D) + lane; const u32x2* yr = (const u32x2*)(YB + (size_t)tl * 4 * D) + lane;
#pragma unroll
            for (int j = 0; j < 4; ++j) { xw[r][j] = __builtin_nontemporal_load(xr + 64 * j);
#pragma unroll
                for (int k = 0; k < 4; ++k) yw[r][j][k] = __builtin_nontemporal_load(yr + k * 256 + 64 * j); } }
#pragma unroll
        for (int r = 0; r < RB; ++r) { const int tl = tl0 + r, m = hf * HALF_TOK + tl;
            f32x4* xr = (f32x4*)(OUT + (size_t)m * D) + lane;
            f32x4 v[4]; float s = 0.f;
#pragma unroll
            for (int j = 0; j < 4; ++j) { f32x4 y = (f32x4){0.f, 0.f, 0.f, 0.f};
#pragma unroll
                for (int k = 0; k < 4; ++k) { const u32x2 w = yw[r][j][k]; y[0] += bflo(w.x); y[1] += bfhi(w.x); y[2] += bflo(w.y); y[3] += bfhi(w.y); }
                if (DBG_NO_MOE) y = (f32x4){0.f, 0.f, 0.f, 0.f};
                const f32x4 gt = gtv[j];
                const f32x4 x1v = (f32x4){bflo(xw[r][j].x), bfhi(xw[r][j].x), bflo(xw[r][j].y), bfhi(xw[r][j].y)};
                v[j] = x1v * DN_ALPHA + gt * y; s += (v[j][0] + v[j][1]) + (v[j][2] + v[j][3]); }
            const float mean = wave_sum(s) * (1.f / D); float s2 = 0.f;
#pragma unroll
            for (int j = 0; j < 4; ++j) { v[j] = v[j] - mean; s2 += (v[j][0] * v[j][0] + v[j][1] * v[j][1]) + (v[j][2] * v[j][2] + v[j][3] * v[j][3]); }
            const float rstd = 1.f / sqrtf(wave_sum(s2) * (1.f / D) + LN_EPS);
#pragma unroll
            for (int j = 0; j < 4; ++j) { const f32x4 ov = v[j] * rstd * g2v[j] + b2v[j]; if (!DRY || ov[0] == 1.2345e-33f) __builtin_nontemporal_store(ov, xr + 64 * j); } }
    }
}

__device__ __forceinline__ float block_sum(Frame& F, float v, LAS float* red) {
    v = wave_sum(v); __syncthreads(); if (F.lane == 0) red[F.wave] = v; __syncthreads();
    float s = 0.f; for (int w = 0; w < NWAVES; ++w) s += red[w]; return s;
}
__device__ __forceinline__ float block_max(Frame& F, float v, LAS float* red) {
#pragma unroll
    for (int o = 1; o < 64; o <<= 1) v = fmaxf(v, __shfl_xor(v, o));
    __syncthreads(); if (F.lane == 0) red[F.wave] = v; __syncthreads();
    float s = 0.f; for (int w = 0; w < NWAVES; ++w) s = fmaxf(s, red[w]); return s;
}
__device__ __forceinline__ void dbg_report(Frame& F, float e) { if (F.tid == 0) atomicMax((unsigned*)(F.ws + WS_CTL) + CW_DBG, __float_as_uint(e)); }
__device__ __forceinline__ void dbg_check_moe(Frame& F) {
    if (F.bid >= 64) return;
    const int tok = HALF_TOK + 509 * F.bid + 3, tokl = tok - HALF_TOK, tid = F.tid;
    LAS float* u2 = (LAS float*)F.lds; LAS float* act = u2 + 1024; LAS float* red = act + 1024; LAS float* lg = red + 16;
    const bf16_t* U2 = (const bf16_t*)(F.ws + WS_U2); const bf16_t* YB = (const bf16_t*)(F.ws + WS_YB); const u32x2* RT = (const u32x2*)(F.ws + WS_DBG);
    const float* w1 = F.a->in[22]; const float* b1 = F.a->in[23]; const float* w2 = F.a->in[24]; const float* b2 = F.a->in[25];
    __syncthreads();
    for (int i = tid; i < 1024; i += NTHR) u2[i] = bflo((unsigned)U2[(size_t)tok * 1024 + i]);
    __syncthreads();
    float y0 = 0.f, y1 = 0.f;
    for (int k = 0; k < 4; ++k) {
        const u32x2 rw = RT[(size_t)tok * 4 + k]; const int e = (int)rw.x; const float g = __uint_as_float(rw.y);
        const float* W1 = w1 + (size_t)e * 1024 * 2048; const float* W2 = w2 + (size_t)e * 1024 * 1024;
        float h0 = b1[e * 2048 + tid], h1 = b1[e * 2048 + tid + 512], h2 = b1[e * 2048 + tid + 1024], h3 = b1[e * 2048 + tid + 1536];
        for (int c = 0; c < 1024; ++c) { const float uu = u2[c]; const float* wr = W1 + (size_t)c * 2048 + tid; h0 += uu * wr[0]; h1 += uu * wr[512]; h2 += uu * wr[1024]; h3 += uu * wr[1536]; }
        __syncthreads();
        { float gg = fminf(h0, 7.f), up = fminf(fmaxf(h2, -7.f), 7.f); act[tid] = (up + 1.f) * gg / (1.f + expf(-1.702f * gg));
          gg = fminf(h1, 7.f); up = fminf(fmaxf(h3, -7.f), 7.f); act[tid + 512] = (up + 1.f) * gg / (1.f + expf(-1.702f * gg)); }
        __syncthreads();
        float a0 = b2[e * 1024 + tid], a1 = b2[e * 1024 + tid + 512];
        for (int j = 0; j < 1024; ++j) { const float aa = act[j]; a0 += aa * W2[(size_t)j * 1024 + tid]; a1 += aa * W2[(size_t)j * 1024 + tid + 512]; }
        y0 += g * a0; y1 += g * a1;
    }
    float f0 = 0.f, f1 = 0.f;
    for (int k = 0; k < 4; ++k) { f0 += bflo((unsigned)YB[((size_t)tokl * 4 + k) * 1024 + tid]); f1 += bflo((unsigned)YB[((size_t)tokl * 4 + k) * 1024 + tid + 512]); }
    const float rms = sqrtf(block_sum(F, y0 * y0 + y1 * y1, red) * (1.f / 1024.f)) + 1e-20f;
    float err = block_max(F, fmaxf(fabsf(y0 - f0), fabsf(y1 - f1)), red) / rms;
    { const float* X1 = (const float*)F.outb + (size_t)tok * 1024; const float* md = (const float*)(F.ws + WS_MOD) + (size_t)(tok >> 11) * 6144;
      const float xa = X1[tid], xb = X1[tid + 512]; const float mean = block_sum(F, xa + xb, red) * (1.f / 1024.f);
      const float da = xa - mean, db = xb - mean; const float var = block_sum(F, da * da + db * db, red) * (1.f / 1024.f); const float rstd = 1.f / sqrtf(var + LN_EPS);
      __syncthreads();
      u2[tid] = da * rstd * (1.f + md[4096 + tid]) + md[3072 + tid]; u2[tid + 512] = db * rstd * (1.f + md[4096 + tid + 512]) + md[3072 + tid + 512];
      __syncthreads();
      if (tid < 32) { float a = F.a->in[21][tid]; for (int c = 0; c < 1024; ++c) a += u2[c] * F.a->in[20][c * 32 + tid]; lg[tid] = a; }
      __syncthreads();
      if (tid == 0) { unsigned want = 0u, got = 0u; float l2[32]; for (int i = 0; i < 32; ++i) l2[i] = lg[i];
          for (int k = 0; k < 4; ++k) { int bi = 0; for (int i = 1; i < 32; ++i) if (l2[i] > l2[bi]) bi = i; want |= 1u << bi; l2[bi] = -INFINITY; got |= 1u << RT[(size_t)tok * 4 + k].x; }
          lg[32] = (want != got) ? 1.f : 0.f; }
      __syncthreads();
      if (lg[32] != 0.f) err = 50.f; }
    dbg_report(F, err);
}
__device__ __forceinline__ void dbg_check_ssd(Frame& F) {
    if (F.bid >= 2) return;
    const int b = F.bid ? 20 : 5, h = F.bid ? 14 : 3, g = h >> 2, tid = F.tid, p = tid >> 3, ng = tid & 7;
    LAS float* red = (LAS float*)F.lds; LAS float* cv = red + 16;
    const bf16_t* XBC = (const bf16_t*)(F.ws + WS_XBC); const bf16_t* ZS = (const bf16_t*)(F.ws + WS_Z); const float* DT = (const float*)(F.outb + OUT_DT); const bf16_t* YG = (const bf16_t*)(F.ws + WS_Q);
    const float* cw = F.a->in[9]; const float* cb = F.a->in[10]; const float aneg = -expf(F.a->in[12][h]), dsk = F.a->in[13][h];
    const int mych = tid < 64 ? h * 64 + tid : (tid < 192 ? 1024 + g * 128 + (tid - 64) : 1536 + g * 128 + (tid - 192));
    float w0 = 0.f, w1 = 0.f, w2 = 0.f, w3 = 0.f, wb = 0.f;
    if (tid < 320) { w0 = cw[0 * 2048 + mych]; w1 = cw[1 * 2048 + mych]; w2 = cw[2 * 2048 + mych]; w3 = cw[3 * 2048 + mych]; wb = cb[mych]; }
    float x0 = 0.f, x1 = 0.f, x2 = 0.f;
    float hs[16];
#pragma unroll
    for (int i = 0; i < 16; ++i) hs[i] = 0.f;
    float emax = 0.f, ssq = 0.f, nbad = 0.f; int tmax = 0;
    for (int t = 0; t < SEQ; ++t) {
        const size_t tok = (size_t)b * SEQ + t;
        __syncthreads();
        if (DBG_HYP == 1 && (t & 63) == 0) { x0 = 0.f; x1 = 0.f; x2 = 0.f; }
        if (tid < 320) { const float x3 = bflo((unsigned)XBC[tok * 2048 + mych]); const float s = wb + w0 * x0 + w1 * x1 + w2 * x2 + w3 * x3; cv[tid] = s / (1.f + expf(-s)); x0 = x1; x1 = x2; x2 = x3; }
        __syncthreads();
        const float xv = cv[p], dt = DT[tok * 16 + h], dec = expf(dt * aneg);
        float yp = 0.f;
#pragma unroll
        for (int i = 0; i < 16; ++i) { const int n = ng * 16 + i; hs[i] = hs[i] * dec + dt * xv * cv[64 + n]; yp += cv[192 + n] * hs[i]; }
        yp += __shfl_xor(yp, 1); yp += __shfl_xor(yp, 2); yp += __shfl_xor(yp, 4);
        const float yv = (yp + xv * dsk) * bflo((unsigned)ZS[tok * 1024 + h * 64 + p]);
        const float yf = bflo((unsigned)YG[tok * 1024 + h * 64 + p]);
        if (ng == 0) { const float er = fabsf(yv - yf); if (er > emax) { emax = er; tmax = t; } ssq += yv * yv; if (er > 0.25f && (DBG_SUB < 5 || (DBG_SUB == 5 && (t & 63) == 0) || (DBG_SUB == 6 && (t & 63) == 1) || (DBG_SUB == 7 && (t & 63) == 32))) nbad += 1.f; }
    }
    const float rms = sqrtf(block_sum(F, ssq, red) / (64.f * SEQ)) + 1e-20f;
    const float M = block_max(F, emax, red);
    if (DBG_SUB == 0) dbg_report(F, M / rms);
    else if (DBG_SUB == 1) dbg_report(F, block_sum(F, nbad, red) / (64.f * SEQ));
    else if (DBG_SUB >= 5) dbg_report(F, block_sum(F, nbad, red) / (64.f * 32.f));
    else { __syncthreads(); if (ng == 0 && emax == M) red[12] = (float)(DBG_SUB == 2 ? ((tmax & 63) >> 1) : (DBG_SUB == 3 ? (tmax >> 6) : (p >> 1))); __syncthreads();
        if (F.bid == 0) dbg_report(F, powf(10.f, 2.f * (0.05f + 0.05f * red[12]) - 4.f)); }
}
__device__ __forceinline__ void dbg_check_attn(Frame& F) {
    if (F.bid >= 32) return;
    const int b = (F.bid * 7 + 3) & 31, pos = 300 + F.bid * 53, nadm = ((pos >> 6) + 1) * 64, tid = F.tid, lane = F.lane, hd = F.wave;
    const size_t tq = (size_t)b * SEQ + pos;
    LAS float* sc = (LAS float*)F.lds; LAS unsigned char* sel = (LAS unsigned char*)(sc + 2048); LAS float* lgt = (LAS float*)(sel + 2048); LAS float* red = lgt + 8 * 2048; LAS float* misc = red + 16;
    const bf16_t* IQ = (const bf16_t*)(F.outb + OUT_IQ); const bf16_t* IK = (const bf16_t*)(F.outb + OUT_IK); const float* IW = (const float*)(F.outb + OUT_IW);
    const bf16_t* Q = (const bf16_t*)(F.ws + WS_Q); const bf16_t* KV = (const bf16_t*)(F.outb + OUT_KV); const bf16_t* OA = (const bf16_t*)(F.outb + OUT_OA); const u64* MASK = (const u64*)(F.outb + OUT_MASK);
    __syncthreads();
    for (int k = tid; k < nadm; k += NTHR) { float s = 0.f;
        for (int hh = 0; hh < 8; ++hh) { float d = 0.f; for (int c = 0; c < 64; ++c) d += bflo((unsigned)IQ[tq * 512 + hh * 64 + c]) * bflo((unsigned)IK[((size_t)b * SEQ + k) * 64 + c]); s += fmaxf(d, 0.f) * IW[tq * 8 + hh]; }
        sc[k] = s + 0.0f; }
    __syncthreads();
    float nbad = 0.f;
    for (int k = tid; k < nadm; k += NTHR) { const float s = sc[k]; int rank = 0; for (int j = 0; j < nadm; ++j) { const float t = sc[j]; rank += (t > s || (t == s && j < k)) ? 1 : 0; }
        const unsigned char se = rank < 256 ? 1 : 0; sel[k] = se; const unsigned mb = (unsigned)((MASK[tq * 32 + (k >> 6)] >> (k & 63)) & 1ull); if (mb != se) nbad += 1.f; }
    __syncthreads();
    const float nbad_t = block_sum(F, nbad, red);
    LAS float* lw = lgt + hd * 2048; float mx = -INFINITY;
    for (int k = lane; k < nadm; k += 64) { float l = -INFINITY;
        if (sel[k]) { float d = 0.f; for (int c = 0; c < 128; ++c) d += bflo((unsigned)Q[tq * 1024 + hd * 128 + c]) * bflo((unsigned)KV[((size_t)b * SEQ + k) * 128 + c]);
            const int rel = k - pos, n = rel < 0 ? -rel : rel; const float nf = (float)(n > 1 ? n : 1); int large = 8 + (int)(logf(nf / 8.0f) / 2.7725887f * 8.0f); if (large > 15) large = 15;
            const int bucket = (rel > 0 ? 16 : 0) + (n < 8 ? n : large);
            l = d * 0.088388347648318440f + F.a->in[8][bucket * 8 + hd]; }
        lw[k] = l; mx = fmaxf(mx, l); }
#pragma unroll
    for (int o = 1; o < 64; o <<= 1) mx = fmaxf(mx, __shfl_xor(mx, o));
    float den = 0.f;
    for (int k = lane; k < nadm; k += 64) { const float pp = expf(lw[k] - mx); lw[k] = pp; den += pp; }
    den = wave_sum(den);
    float emax = 0.f, ssq = 0.f;
    for (int c2 = 0; c2 < 2; ++c2) { const int c = lane + 64 * c2; float o = 0.f; for (int k = 0; k < nadm; ++k) { const float pp = lw[k]; if (pp != 0.f) o += pp * bflo((unsigned)KV[((size_t)b * SEQ + k) * 128 + c]); }
        o /= den; const float of = bflo((unsigned)OA[tq * 1024 + hd * 128 + c]); emax = fmaxf(emax, fabsf(o - of)); ssq += o * o; }
    const float rms = sqrtf(block_sum(F, ssq, red) * (1.f / 1024.f)) + 1e-20f;
    float err = block_max(F, emax, red) / rms;
    (void)misc;
    if (nbad_t > 0.f) err = 10.f + nbad_t;
    dbg_report(F, err);
}
__device__ __forceinline__ void dbg_emit(Frame& F) {
    float* out = (float*)F.outb;
    for (size_t i = (size_t)F.bid * NTHR + F.tid; i < (size_t)NTOK * D / 4; i += (size_t)F.G * NTHR) ((f32x4*)out)[i] = (f32x4){0.f, 0.f, 0.f, 0.f};
    __syncthreads();
    if (F.bid == 0 && F.tid == 0) { const float e = __uint_as_float(__hip_atomic_load((unsigned*)(F.ws + WS_CTL) + CW_DBG, __ATOMIC_RELAXED, __HIP_MEMORY_SCOPE_AGENT));
        float code = (log10f(fmaxf(e, 1e-30f)) + 4.f) * 0.5f; code = fminf(fmaxf(rintf(code * 20.f) * 0.05f, 0.05f), 3.0f);
        out[0] = sqrtf(67108864.f * 1.01f * (powf(10.f, code) - 1.f)); }
}

#define CLK_BEGIN(k) unsigned long long clk_c##k = 0, clk_r##k = 0; if (DBG_CLOCK == (k) + 1) { clk_c##k = __builtin_amdgcn_s_memtime(); clk_r##k = __builtin_amdgcn_s_memrealtime(); }
#define CLK_END(k) if (DBG_CLOCK == (k) + 1 && F.bid == 0) { const float ghz = (float)(__builtin_amdgcn_s_memtime() - clk_c##k) / (float)(__builtin_amdgcn_s_memrealtime() - clk_r##k) * 0.1f; dbg_report(F, powf(10.f, 2.f * (rintf(ghz * 5.f) * 0.2f) - 4.f)); }
constexpr int NPHASE = 17;
__global__ void __launch_bounds__(NTHR, 2) fwd(Args args) {
    extern __shared__ __attribute__((aligned(16))) unsigned char lds_raw[];
    Frame F;
    F.lds = (LAS unsigned char*)lds_raw;
    F.tid = threadIdx.x; F.lane = F.tid & 63; F.wave = __builtin_amdgcn_readfirstlane(F.tid >> 6); F.G = gridDim.x; F.bid = blockIdx.x;
    F.a = &args;
    F.ws = args.ws; F.outb = (unsigned char*)args.out;
    volatile LAS unsigned* MISCW = (volatile LAS unsigned*)(F.lds + LDS_MISC);
    if (F.tid < 64) MISCW[F.tid] = 0u;
    __syncthreads();
    XcdBarrier bar; bar.bar = (unsigned*)(F.ws + WS_CTL) + CW_BAR; bar.x = 0; bar.st = nullptr;
#if MK_ONE
    bar = xcd_barrier_post((unsigned*)(F.ws + WS_CTL) + CW_BAR, MISCW + 8);
#define GRID_BAR() xcd_barrier(bar)
#else
#define GRID_BAR() do { } while (0)
#endif
    const int lo = args.ph_lo, hi = args.ph_hi;
#ifndef PHM
#define PHM (0xFFFFFFFFu & ~(DBG_NO_ATTN ? 0x30u : 0u) & ~(DBG_NO_SSD ? 0xC0u : 0u))
#endif
#define IN(k) (((PHM >> (k)) & 1u) && lo <= (k) && (k) < hi)
#define SEAM(k) do { if ((k) + 1 < hi) GRID_BAR(); } while (0)

    if (IN(0)) {
#pragma nounroll
        for (int rep = 0; rep < ((DBG_TWICE & 1u) ? 2 : 1); ++rep) { if (rep) GRID_BAR(); ph_prologue(F); }
        SEAM(0); }
    if (IN(1)) {
#pragma nounroll
        for (int rep = 0; rep < ((DBG_TWICE & 2u) ? 2 : 1); ++rep) { if (rep) GRID_BAR(); ph_ln1(F); }
        SEAM(1); }
    CLK_BEGIN(2);
    if (IN(2)) {
        EpiProj E{(bf16_t*)(F.ws + WS_Q), (bf16_t*)(F.outb + OUT_IQ), (bf16_t*)(F.ws + WS_Z), (bf16_t*)(F.ws + WS_XBC), (bf16_t*)(F.ws + WS_GA), (bf16_t*)(F.ws + WS_GB), (float*)(F.outb + OUT_MISC), 1.0f};
#if PROJ_FP8
        { SchedProj<2> S; S.o.init(NTOK, 12 * 256, F.G, F.bid); S.A = (const char*)(F.ws + WS_U8); S.Bt = (const char*)(F.ws + WS_WIN8);
          EpiProj E8 = E; E8.sc = MOE_INV;
          pg8::gemm_phase<EpiProj, SchedProj<2>, false, 512, true>(F.lds, S, E8);
          if (DBG_TWICE & 32768u) { GRID_BAR(); pg8::gemm_phase<EpiProj, SchedProj<2>, false, 512, true>(F.lds, S, E8); } }
        { SchedProj<1> S; S.o.init(NTOK, 15 * 256, F.G, F.bid); S.A = (const char*)(F.outb + OUT_U); S.Bt = (const char*)(F.ws + WS_WIN); if (DBG_KCLK) S.dbgw = (unsigned*)(F.ws + WS_CTL) + CW_DBG;
#if DBG_DRYPROJ
#pragma nounroll
          for (int rep = 0; rep < 2; ++rep) { EpiProj Ed = E; Ed.dry = rep == 0; SchedProj<1> Sd = S; Sd.fold = rep == 0 ? 7 : 0x7fffffff; pg8::gemm_phase<EpiProj, SchedProj<1>, false>(F.lds, Sd, Ed); if (rep == 0) GRID_BAR(); }
#else
          const unsigned long long w0 = DBG_WALL ? __builtin_amdgcn_s_memrealtime() : 0ull;
          pg8::gemm_phase<EpiProj, SchedProj<1>, false>(F.lds, S, E);
          if (DBG_WALL && F.bid == 0) { const float us = (float)(__builtin_amdgcn_s_memrealtime() - w0) * 0.01f; dbg_report(F, powf(10.f, 2.f * (rintf(us / 300.f * 10.f) * 0.1f) - 4.f)); }
#endif
          if (DBG_TWICE & 4u) { GRID_BAR(); pg8::gemm_phase<EpiProj, SchedProj<1>, false>(F.lds, S, E); } }
#else
        { SchedProj<0> S; S.o.init(NTOK, NPROJ, F.G, F.bid); S.A = (const char*)(F.outb + OUT_U); S.Bt = (const char*)(F.ws + WS_WIN);
          pg8::gemm_phase<EpiProj, SchedProj<0>, false>(F.lds, S, E);
          if (DBG_TWICE & 4u) { GRID_BAR(); pg8::gemm_phase<EpiProj, SchedProj<0>, false>(F.lds, S, E); } }
#endif
        SEAM(2);
    }
    CLK_END(2);
    if (IN(3)) { ph_misc(F); if (DBG_TWICE & 8u) { GRID_BAR(); ph_misc(F); } SEAM(3); }
    if (IN(4)) {
#pragma nounroll
        for (int rep = 0; rep < DBG_REP4; ++rep) { if (rep) GRID_BAR(); ph_index(F, rep + 1 < DBG_REP4 ? DBG_ABL4 : 0); }
        SEAM(4); }
    if (IN(5)) {
#pragma nounroll
        for (int rep = 0; rep + 1 < DBG_REP5; ++rep) { ph_attn<DBG_ABL5>(F); GRID_BAR(); }
        ph_attn<0>(F);
        SEAM(5); if (DBG_CHECK == 3) { dbg_check_attn(F); GRID_BAR(); } }
    if (IN(6)) {
#pragma nounroll
        for (int rep = 0; rep < DBG_REP6; ++rep) { if (rep) GRID_BAR(); ph_ssd2(F, rep + 1 < DBG_REP6 ? DBG_ABL6 : 0); }
        SEAM(6); if (DBG_CHECK == 2) { dbg_check_ssd(F); GRID_BAR(); } }
    if (IN(7)) { ph_gnorm(F); if (DBG_TWICE & 128u) { GRID_BAR(); ph_gnorm(F); } SEAM(7); }
    if (IN(8)) {
#if PA_FP8
        SchedPlainT<1024> S; S.o.init(NTOK, 1024, F.G, F.bid); S.A = (const char*)(F.outb + OUT_OA); S.Bt = (const char*)(F.ws + WS_WPA8);
        EpiGate<0> E{(const bf16_t*)(F.ws + WS_GA), nullptr, (bf16_t*)(F.ws + WS_Z), MOE_INV};
        pg8::gemm_phase<EpiGate<0>, SchedPlainT<1024>, false, 512, true>(F.lds, S, E);
#else
        SchedPlain S; S.o.init(NTOK, 1024, F.G, F.bid); S.A = (const char*)(F.outb + OUT_OA); S.Bt = (const char*)(F.ws + WS_WPA);
        EpiGate<0> E{(const bf16_t*)(F.ws + WS_GA), nullptr, (bf16_t*)(F.ws + WS_Z), 1.0f};
        pg8::gemm_phase<EpiGate<0>, SchedPlain, false>(F.lds, S, E);
#endif
    }
    if (IN(9)) {
#if PB_FP8
        SchedPlainT<1024> S; S.o.init(NTOK, 1024, F.G, F.bid); S.A = (const char*)(F.outb + OUT_OB8); S.Bt = (const char*)(F.ws + WS_WPB8);
        EpiGate<1> E{(const bf16_t*)(F.ws + WS_GB), (const bf16_t*)(F.ws + WS_Z), (bf16_t*)(F.ws + WS_XBC), MOE_INV};
        pg8::gemm_phase<EpiGate<1>, SchedPlainT<1024>, false, 512, true>(F.lds, S, E);
#else
        SchedPlain S; S.o.init(NTOK, 1024, F.G, F.bid); S.A = (const char*)(F.ws + WS_Q); S.Bt = (const char*)(F.ws + WS_WPB);
        EpiGate<1> E{(const bf16_t*)(F.ws + WS_GB), (const bf16_t*)(F.ws + WS_Z), (bf16_t*)(F.ws + WS_XBC), 1.0f};
        pg8::gemm_phase<EpiGate<1>, SchedPlain, false>(F.lds, S, E);
#endif
        SEAM(9);
    }
    if (IN(10)) {
        SchedPlain S; S.o.init(NTOK, 1024, F.G, F.bid); S.A = (const char*)(F.ws + WS_XBC); S.Bt = (const char*)(F.ws + WS_WOUT);
        EpiOut E{F.a->in[0], (const float*)(F.ws + WS_MOD), (bf16_t*)(F.ws + WS_VB)};
        pg8::gemm_phase<EpiOut, SchedPlain, false>(F.lds, S, E);
        if (DBG_TWICE & 1024u) { GRID_BAR(); pg8::gemm_phase<EpiOut, SchedPlain, false>(F.lds, S, E); }
        SEAM(10);
    }
    if (IN(11)) { if (DBG_TWICE & 2048u) { ph_router<true>(F); GRID_BAR(); } ph_router<false>(F); SEAM(11); }
#pragma unroll
    for (int hf = 0; hf < 2; ++hf) {
        const int p0 = 12 + hf * 2;
        if (IN(p0)) {
            if (hf == 1) ph_final<false>(F, 0);
            MoeTab T = moe_tables(F, hf);
            SchedMoe<8, true> S{T, F.G, F.bid, hf, (const char*)(F.ws + WS_U2), (const char*)(F.ws + WS_W1), (const u32x2*)(F.ws + WS_REG)};
            EpiMoe1 E{F.a->in[23], (bf16_t*)(F.ws + WS_ACT), 0};
            pg8::gemm_phase<EpiMoe1, SchedMoe<8, true>, true, MOE_RB / 2, MOE_FP8 != 0>(F.lds, S, E);
            if ((DBG_TWICE & 4096u) && hf == 0) { GRID_BAR(); pg8::gemm_phase<EpiMoe1, SchedMoe<8, true>, true, MOE_RB / 2, MOE_FP8 != 0>(F.lds, S, E); }
            if ((DBG_TWICE & 16384u) && hf == 0) { GRID_BAR(); EpiMoe1 Ed = E; Ed.dry = 1; pg8::gemm_phase<EpiMoe1, SchedMoe<8, true>, true, MOE_RB / 2, MOE_FP8 != 0>(F.lds, S, Ed); }
            SEAM(p0);
        }
        if (IN(p0 + 1)) {
            MoeTab T = moe_tables(F, hf);
            SchedMoe<4, false> S{T, F.G, F.bid, hf, (const char*)(F.ws + WS_ACT), (const char*)(F.ws + WS_W2), (const u32x2*)(F.ws + WS_REG)};
            EpiMoe2 E{F.a->in[25], (bf16_t*)(F.ws + WS_YB), (const u32x2*)(F.ws + WS_REG), T, hf, 0};
            if ((DBG_TWICE & 262144u) && hf == 0) { EpiMoe2 Ed = E; Ed.dry = DBG_DRYMODE; pg8::gemm_phase<EpiMoe2, SchedMoe<4, false>, false, MOE_RB / 2, MOE_FP8 != 0>(F.lds, S, Ed); GRID_BAR(); }
            pg8::gemm_phase<EpiMoe2, SchedMoe<4, false>, false, MOE_RB / 2, MOE_FP8 != 0>(F.lds, S, E);
            if ((DBG_TWICE & 8192u) && hf == 0) { GRID_BAR(); pg8::gemm_phase<EpiMoe2, SchedMoe<4, false>, false, MOE_RB / 2, MOE_FP8 != 0>(F.lds, S, E); }
            if ((DBG_TWICE & 131072u) && hf == 0) { GRID_BAR(); EpiMoe2 Ed = E; Ed.dry = 1; pg8::gemm_phase<EpiMoe2, SchedMoe<4, false>, false, MOE_RB / 2, MOE_FP8 != 0>(F.lds, S, Ed); }
            SEAM(p0 + 1);
            if (DBG_CHECK == 1 && hf == 1) { dbg_check_moe(F); GRID_BAR(); }
        }
    }
    if (IN(16)) { if (DBG_TWICE & 65536u) { ph_final<true>(F, 1); GRID_BAR(); } ph_final(F, 1); }
    if (DBG_CHECK || DBG_CLOCK || DBG_KCLK || DBG_WALL) { GRID_BAR(); dbg_emit(F); }
#undef IN
#undef SEAM
}

extern "C" void kernel_launch(void* const* d_in, const int* in_sizes, int n_in, void* d_out, int out_size, void* d_ws, size_t ws_size, hipStream_t stream) {
    static int grid = 0;
    if (grid == 0) {
        if (n_in != 28 || in_sizes[0] != NTOK * D || out_size != NTOK * D || ws_size < WS_END) { fprintf(stderr, "kernel_launch: shape mismatch (n_in %d, in0 %d, out %d, ws %zu)\n", n_in, n_in > 0 ? in_sizes[0] : -1, out_size, ws_size); grid = -1; return; }
        int dev = 0, cus = 0, per_cu = 0;
        if (hipGetDevice(&dev) != hipSuccess || hipDeviceGetAttribute(&cus, hipDeviceAttributeMultiprocessorCount, dev) != hipSuccess) { grid = -1; return; }
        if (hipFuncSetAttribute((const void*)fwd, hipFuncAttributeMaxDynamicSharedMemorySize, LDS_BYTES) != hipSuccess) { fprintf(stderr, "kernel_launch: hipFuncSetAttribute failed\n"); grid = -1; return; }
        if (hipOccupancyMaxActiveBlocksPerMultiprocessor(&per_cu, (const void*)fwd, NTHR, LDS_BYTES) != hipSuccess || per_cu < 1) fprintf(stderr, "kernel_launch: occupancy query reports %d\n", per_cu);
        (void)hipGetLastError();
        grid = cus;
    }
    if (grid < 0) return;
    if (hipMemsetAsync((char*)d_ws + WS_CTL, 0, CTL_ZERO_BYTES, stream) != hipSuccess) { fprintf(stderr, "kernel_launch: memset failed\n"); return; }
    Args a{};
    for (int i = 0; i < 28; ++i) a.in[i] = (const float*)d_in[i];
    a.out = (float*)d_out; a.ws = (unsigned char*)d_ws;
    const int nph = NPHASE < MK_PH_HI ? NPHASE : MK_PH_HI;
#if MK_ONE
    a.ph_lo = 0; a.ph_hi = nph;
    hipLaunchKernelGGL(fwd, dim3(grid), dim3(NTHR), LDS_BYTES, stream, a);
#else
    for (int p = 0; p < nph; ++p) { a.ph_lo = p; a.ph_hi = p + 1; hipLaunchKernelGGL(fwd, dim3(grid), dim3(NTHR), LDS_BYTES, stream, a); }
#endif
    const hipError_t le = hipPeekAtLastError();
    if (le != hipSuccess) fprintf(stderr, "kernel_launch: launch failed: %s\n", hipGetErrorName(le));
}
```

```cpp
#include <hip/hip_runtime.h>
#include <cstdio>
#include <cstdint>

#ifndef MK_ONE
#define MK_ONE 1
#endif
#ifndef DBG_NO_ATTN
#define DBG_NO_ATTN 0
#endif
#ifndef DBG_ATTN_ZERO
#define DBG_ATTN_ZERO 0
#endif
#ifndef DBG_IQ_TRUNC
#define DBG_IQ_TRUNC 0
#endif
#ifndef DBG_ROUTER_BF16
#define DBG_ROUTER_BF16 0
#endif
#ifndef DBG_CHECK
#define DBG_CHECK 0
#endif
#ifndef DBG_SKIP_BODY
#define DBG_SKIP_BODY 0
#endif
#ifndef DBG_SUB
#define DBG_SUB 0
#endif
#ifndef DBG_SSD_SYNC
#define DBG_SSD_SYNC 0
#endif
#ifndef DBG_HYP
#define DBG_HYP 0
#endif
#ifndef DBG_TWICE
#define DBG_DRYPROJ 0
#define DBG_ABL6 0
#define DBG_ABL4 0
#define DBG_REP4 1
#define DBG_REP6 1
#define DBG_WALL 0
#define DBG_KCLK 0
#ifndef DBG_CLOCK
#define DBG_CLOCK 0
#endif
#define DBG_TWICE 0u
#endif
#ifndef DBG_DRYMODE
#define DBG_DRYMODE 2
#endif
#ifndef DBG_NO_SSD
#define DBG_NO_SSD 0
#endif
#ifndef DBG_NO_MOE
#define DBG_NO_MOE 0
#endif
#ifndef MOE_FP8
#define MOE_FP8 1
#endif
#ifndef PROJ_FP8
#define PROJ_FP8 1
#endif
#ifndef PA_FP8
#define PA_FP8 1
#endif
#ifndef PB_FP8
#define PB_FP8 1
#endif
#ifndef PO_FP8
#define PO_FP8 1
#endif
#ifndef TMP_FP8
#define TMP_FP8 1
#endif
#ifndef ATT2
#define GATE_U8 1
#define ATT_OT 1
#define ATT2 1
#endif
#ifndef MK_PH_HI
#define MK_PH_HI 99
#endif

#define LAS __attribute__((address_space(3)))
#define GAS __attribute__((address_space(1)))
typedef unsigned short bf16_t;
typedef short bf16x8 __attribute__((ext_vector_type(8)));
typedef short s16x4 __attribute__((ext_vector_type(4)));
typedef float f32x2 __attribute__((ext_vector_type(2)));
typedef float f32x4 __attribute__((ext_vector_type(4)));
typedef float f32x16 __attribute__((ext_vector_type(16)));
typedef unsigned u32x2 __attribute__((ext_vector_type(2)));
typedef unsigned u32x4 __attribute__((ext_vector_type(4)));
typedef unsigned long long u64;

constexpr int NB = 32, SEQ = 2048, D = 1024, NTOK = NB * SEQ;
constexpr int NWAVES = 8, NTHR = 512;
constexpr int NPROJ = 6912;
constexpr int NEXP = 32, HALF_TOK = NTOK / 2, REG_CAP = HALF_TOK;
constexpr int ACT_ROWS = HALF_TOK * 4 + NEXP * 256;
constexpr float LN_EPS = 1e-5f;
constexpr float DN_ALPHA = 1.189207115002721f;
constexpr float LOG2E = 1.4426950408889634f;

constexpr size_t MiB = 1u << 20;
constexpr size_t WS_CTL = 0, CTL_ZERO_BYTES = 1 * MiB;
constexpr size_t WS_MOD = 1 * MiB;
constexpr size_t WS_BIAST = 1 * MiB + 800 * 1024;
constexpr size_t WS_WIN = 2 * MiB;
constexpr size_t WS_WPA = 16 * MiB, WS_WPB = 18 * MiB, WS_WOUT = 20 * MiB;
constexpr size_t WS_W1 = 24 * MiB;
constexpr size_t WS_U8 = 88 * MiB;
constexpr size_t WS_W2 = 152 * MiB;
constexpr size_t WS_WIN8 = 184 * MiB;
constexpr size_t WS_WPA8 = 192 * MiB;
constexpr size_t WS_WPB8 = 194 * MiB;
constexpr size_t OUT_OB8 = 192 * MiB;
constexpr size_t WS_Q = 216 * MiB;
constexpr size_t WS_Z = 344 * MiB;
constexpr size_t WS_XBC = 472 * MiB;
constexpr size_t WS_GA = 728 * MiB, WS_GB = 856 * MiB;
constexpr size_t WS_U2 = 216 * MiB;
constexpr size_t WS_REG = 344 * MiB;
constexpr size_t WS_ACT = 360 * MiB;
constexpr size_t WS_YB = 632 * MiB;
constexpr size_t WS_X1B = 496 * MiB;
constexpr size_t WS_VB = 744 * MiB;
constexpr size_t WS_END = 984 * MiB;
constexpr size_t WS_DBG = 889 * MiB;
constexpr size_t OUT_U = 0, OUT_MISC = 128 * MiB, OUT_IQ = 192 * MiB;
constexpr size_t OUT_KV = 0, OUT_IK = 16 * MiB, OUT_IW = 24 * MiB, OUT_DT = 26 * MiB, OUT_MASK = 32 * MiB, OUT_OA = 64 * MiB;
constexpr int CW_BAR = 4096, CW_CNT = 16384, CW_WQ = 22528, CW_DBG = 24576;

constexpr int LDS_BYTES = 160 * 1024;
constexpr int LDS_AUX = 131072;
constexpr int LDS_MISC = LDS_BYTES - 256;

#define LDS_WAIT() asm volatile("s_waitcnt lgkmcnt(0)" ::: "memory")
#define GAS __attribute__((address_space(1)))
#define VM_WAIT() asm volatile("s_waitcnt vmcnt(0)" ::: "memory")
#define SBAR() __builtin_amdgcn_sched_barrier(0)
typedef __bf16 bf16x2_t __attribute__((ext_vector_type(2)));
__device__ __forceinline__ unsigned cvt_pk_bf16(float lo, float hi) { f32x2 f = {lo, hi}; bf16x2_t v = __builtin_convertvector(f, bf16x2_t); return __builtin_bit_cast(unsigned, v); }
__device__ __forceinline__ float bflo(unsigned w) { return __uint_as_float(w << 16); }
__device__ __forceinline__ float bfhi(unsigned w) { return __uint_as_float(w & 0xffff0000u); }
__device__ __forceinline__ u32x4 pack8(f32x4 a, f32x4 b) { u32x4 w; w.x = cvt_pk_bf16(a[0], a[1]); w.y = cvt_pk_bf16(a[2], a[3]); w.z = cvt_pk_bf16(b[0], b[1]); w.w = cvt_pk_bf16(b[2], b[3]); return w; }
constexpr int MOE_RB = MOE_FP8 ? 1024 : 2048;
constexpr float MOE_WSC = MOE_FP8 ? 64.0f : 1.0f, MOE_INV = 1.0f / MOE_WSC;
constexpr float PO_ASC = 8.0f;
__device__ __forceinline__ u32x2 pack8_fp8(f32x4 a, f32x4 b) { int lo = 0, hi = 0;
    lo = __builtin_amdgcn_cvt_pk_fp8_f32(a[0], a[1], lo, false); lo = __builtin_amdgcn_cvt_pk_fp8_f32(a[2], a[3], lo, true);
    hi = __builtin_amdgcn_cvt_pk_fp8_f32(b[0], b[1], hi, false); hi = __builtin_amdgcn_cvt_pk_fp8_f32(b[2], b[3], hi, true);
    u32x2 r; r.x = (unsigned)lo; r.y = (unsigned)hi; return r; }
__device__ __forceinline__ void unpack8_fp8(u32x2 w, f32x4& a, f32x4& b) {
    const f32x2 a0 = __builtin_amdgcn_cvt_pk_f32_fp8((int)w.x, false), a1 = __builtin_amdgcn_cvt_pk_f32_fp8((int)w.x, true), b0 = __builtin_amdgcn_cvt_pk_f32_fp8((int)w.y, false), b1 = __builtin_amdgcn_cvt_pk_f32_fp8((int)w.y, true);
    a = (f32x4){a0[0], a0[1], a1[0], a1[1]}; b = (f32x4){b0[0], b0[1], b1[0], b1[1]}; }
__device__ __forceinline__ void unpack8(u32x4 w, f32x4& a, f32x4& b) { a[0] = bflo(w.x); a[1] = bfhi(w.x); a[2] = bflo(w.y); a[3] = bfhi(w.y); b[0] = bflo(w.z); b[1] = bfhi(w.z); b[2] = bflo(w.w); b[3] = bfhi(w.w); }
__device__ __forceinline__ float dpp_scan_add(float v) {
#define DPPF(x, ctrl, rm) __builtin_bit_cast(float, __builtin_amdgcn_update_dpp(0, __builtin_bit_cast(int, (x)), (ctrl), (rm), 0xf, false))
    v += DPPF(v, 0x111, 0xf); v += DPPF(v, 0x112, 0xf); v += DPPF(v, 0x114, 0xf); v += DPPF(v, 0x118, 0xf);
    v += DPPF(v, 0x142, 0xa);
    v += DPPF(v, 0x143, 0xc);
#undef DPPF
    return v;
}
__device__ __forceinline__ unsigned dpp_half_sums_u32(unsigned v) {
#define DPPU(x, ctrl, rm) (unsigned)__builtin_amdgcn_update_dpp(0, (int)(x), (ctrl), (rm), 0xf, false)
    v += DPPU(v, 0x111, 0xf); v += DPPU(v, 0x112, 0xf); v += DPPU(v, 0x114, 0xf); v += DPPU(v, 0x118, 0xf); v += DPPU(v, 0x142, 0xa);
#undef DPPU
    return v;
}
__device__ __forceinline__ float dpp_half_sums_f32(float v) {
#define DPPF(x, ctrl, rm) __builtin_bit_cast(float, __builtin_amdgcn_update_dpp(0, __builtin_bit_cast(int, (x)), (ctrl), (rm), 0xf, false))
    v += DPPF(v, 0x111, 0xf); v += DPPF(v, 0x112, 0xf); v += DPPF(v, 0x114, 0xf); v += DPPF(v, 0x118, 0xf); v += DPPF(v, 0x142, 0xa);
#undef DPPF
    return v;
}
__device__ __forceinline__ float wave_sum(float v) { v = dpp_scan_add(v); return __builtin_bit_cast(float, __builtin_amdgcn_readlane(__builtin_bit_cast(int, v), 63)); }
__device__ __forceinline__ float fast_rcp(float x) { return __builtin_amdgcn_rcpf(x); }
__device__ __forceinline__ float sigmoid_f(float x) { return fast_rcp(1.0f + __expf(-x)); }
__device__ __forceinline__ float silu_f(float x) { return x * sigmoid_f(x); }

#define XB_TMO      128
#define XB_XCNT(j)  (256  + 64 * (j))
#define XB_XSUB(j)  (1280 + 64 * (j))
#define XB_XGEN(j)  (2304 + 64 * (j))
#define XB_TOP      3328
#define XB_TOPGEN   3392
#define XCD_BAR_WORDS 3456
#define XB_SPIN_CAP (1u << 18)
__device__ __forceinline__ unsigned xb_ld(unsigned* p)              { return __hip_atomic_load(p, __ATOMIC_RELAXED, __HIP_MEMORY_SCOPE_AGENT); }
__device__ __forceinline__ unsigned xb_add(unsigned* p, unsigned v) { return __hip_atomic_fetch_add(p, v, __ATOMIC_RELAXED, __HIP_MEMORY_SCOPE_AGENT); }
__device__ __forceinline__ unsigned xb_xcc_id() { return (unsigned)__builtin_amdgcn_s_getreg((3 << 11) | 20) & 0xFu; }
#define XB_SPIN(cond, bar) do { unsigned _sp = 0; while (cond) { __builtin_amdgcn_s_sleep(1); \
    if ((++_sp & 255u) == 0u) { if (xb_ld(&(bar)[XB_TMO])) break; if (_sp > XB_SPIN_CAP) { atomicAdd(&(bar)[XB_TMO], 1u); break; } } } } while (0)
struct XcdBarrier { unsigned* bar; unsigned x; volatile LAS unsigned* st; };
__device__ __forceinline__ XcdBarrier xcd_barrier_post(unsigned* bar, volatile LAS unsigned* st) {
    XcdBarrier b; b.bar = bar; b.x = xb_xcc_id(); b.st = st;
    if (threadIdx.x == 0) (void)xb_add(&bar[XB_XCNT(b.x)], 1u);
    return b;
}
__device__ __forceinline__ void xcd_barrier_complete(unsigned* bar, unsigned x, unsigned& nloc, unsigned& nx) {
    const unsigned G = gridDim.x * gridDim.y * gridDim.z;
    unsigned sum, cnt, mine, sp = 0u;
    for (;;) {
        sum = 0u; cnt = 0u;
#pragma nounroll
        for (unsigned j = 0; j < 16; ++j) { const unsigned c = xb_ld(&bar[XB_XCNT(j)]); sum += c; cnt += (c > 0u) ? 1u : 0u; }
        if (sum == G) break;
        __builtin_amdgcn_s_sleep(1);
        if ((++sp & 255u) == 0u) { if (xb_ld(&bar[XB_TMO])) break; if (sp > XB_SPIN_CAP) { atomicAdd(&bar[XB_TMO], 1u); break; } }
    }
    mine = xb_ld(&bar[XB_XCNT(x)]);
    nloc = mine > 0u ? mine : 1u; nx = cnt > 0u ? cnt : 1u;
}
__device__ __forceinline__ void xcd_barrier(const XcdBarrier& b) {
    asm volatile("s_waitcnt vmcnt(0)" ::: "memory");
    __syncthreads();
    if (threadIdx.x == 0) {
        unsigned* bar = b.bar;
        __builtin_amdgcn_s_waitcnt(0);
        unsigned nloc = b.st[0], nx = b.st[1];
        if (nloc == 0u) { xcd_barrier_complete(bar, b.x, nloc, nx); b.st[0] = nloc; b.st[1] = nx; }
        const unsigned old = xb_add(&bar[XB_XSUB(b.x)], 1u);
        const unsigned gen = old / nloc;
        if (old + 1u == (gen + 1u) * nloc) {
            __builtin_amdgcn_fence(__ATOMIC_RELEASE, "agent");
            asm volatile("s_waitcnt vmcnt(0)" ::: "memory");
            const unsigned og = xb_add(&bar[XB_TOP], 1u);
            const unsigned tg = og / nx;
            if (og + 1u == (tg + 1u) * nx) xb_add(&bar[XB_TOPGEN], 1u);
            else XB_SPIN(xb_ld(&bar[XB_TOPGEN]) == tg, bar);
            __builtin_amdgcn_fence(__ATOMIC_ACQUIRE, "agent");
            xb_add(&bar[XB_XGEN(b.x)], 1u);
            asm volatile("s_waitcnt vmcnt(0)" ::: "memory");
        } else {
            XB_SPIN(xb_ld(&bar[XB_XGEN(b.x)]) == gen, bar);
            __builtin_amdgcn_fence(__ATOMIC_ACQUIRE, "agent");
            asm volatile("s_waitcnt vmcnt(0)" ::: "memory");
        }
    }
    __syncthreads();
}

namespace pg8 {
constexpr int BM = 256, BK = 64, HALF = 128, HTB = HALF * BK * 2, STAGE_BYTES = 8 * HTB, NXCD = 8, WGM = 8, KD = 1024;
__host__ __device__ __forceinline__ int lds_byte(int r, int c) { const int st = (r >> 4) * 2 + (c >> 5), rr = r & 15, cc = c & 31, ob = rr * 64 + cc * 2; return st * 1024 + (ob ^ (((ob >> 9) & 1) << 5)); }
__host__ __device__ __forceinline__ void stage_rc(int b, int& R, int& C) { const int st = b / 1024, sb = b % 1024, swz = sb ^ (((sb >> 9) & 1) << 5); R = (st >> 1) * 16 + swz / 64; C = (st & 1) * 32 + (swz % 64) / 2; }
__host__ __device__ __forceinline__ int perm32(int rho) { const int n = rho >> 4, i = rho & 15; return 8 * (i >> 2) + 4 * n + (i & 3); }
struct Unit { int pm, pn, ex; };
struct StaticOrder {
    int nM, nN, nwg, G, c;
    __device__ void init(int M, int N, int G_, int c_) { nM = M / BM; nN = N / BM; nwg = nM * nN; G = G_; c = c_; }
    __device__ bool next(int i, Unit& u) const {
        const long L = (long)i * G + c; if (L >= nwg) return false;
        int wgid = (int)L; { const int q = nwg / NXCD, r = nwg % NXCD, xcd = wgid % NXCD, off = wgid / NXCD; wgid = (xcd < r ? xcd * (q + 1) : r * (q + 1) + (xcd - r) * q) + off; }
        const int nig = WGM * nN, gid = wgid / nig, fm = gid * WGM, gsz = (nM - fm) < WGM ? (nM - fm) : WGM;
        u.pm = fm + ((wgid % nig) % gsz); u.pn = (wgid % nig) / gsz; u.ex = 0; return true;
    }
};
typedef int i32x8 __attribute__((ext_vector_type(8)));
typedef int i32x4v __attribute__((ext_vector_type(4)));
template <class T> __device__ __forceinline__ auto dbgw_of(const T& s, int) -> decltype(s.dbgw) { return s.dbgw; }
template <class T> __device__ __forceinline__ unsigned* dbgw_of(const T&, long) { return nullptr; }
template <class Epi, class Sched, bool GATHER, int KE = 1024, bool FP8 = false>
__device__ __forceinline__ void gemm_phase(LAS unsigned char* lds, const Sched& S, const Epi& E) {
    int tid = threadIdx.x; asm volatile("" : "+v"(tid));
    const int wid = __builtin_amdgcn_readfirstlane(tid >> 6), lane = tid & 63, wr = wid >> 2, wc = wid & 3, fr = lane & 15, fq = lane >> 4;
    constexpr int K = KE, nt = K / BK;
    unsigned voffA[2], voffB[2]; int Rr[2], Cc[2];
#pragma unroll
    for (int i = 0; i < 2; ++i) { int R, C; stage_rc(tid * 16 + i * 8192, R, C); const int Rb = Epi::ADJ ? (64 * (R >> 5) + perm32(R & 31)) : (Epi::PERM ? ((R & ~31) + perm32(R & 31)) : R);
        voffA[i] = (unsigned)(R * K + C) * 2u; voffB[i] = (unsigned)(Rb * K + C) * 2u; Rr[i] = R; Cc[i] = C; }
    constexpr size_t kstep = (size_t)(BK * 2);
    constexpr size_t hstep = (size_t)HALF * K * 2;
    constexpr size_t hstepB = Epi::ADJ ? (size_t)32 * K * 2 : hstep;
    const unsigned ldsw = (unsigned)wid * 1024u;
    const int aoff = lds_byte(wr * 64 + fr, fq * 8), boff = lds_byte(wc * 32 + fr, fq * 8);
#define PG8_SA(b, h) (((b) * 2 + (h)) * HTB)
#define PG8_SB(b, h) ((4 + (b) * 2 + (h)) * HTB)
#define PG8_STAGE(bufoff, gbase, voff) do { _Pragma("unroll") for (int _i = 0; _i < 2; ++_i) \
        __builtin_amdgcn_global_load_lds((const unsigned*)((const char*)(gbase) + (voff)[_i]), (LAS unsigned*)(lds + (bufoff) + ldsw + _i * 8192), 16, 0, 0); } while (0)
#define PG8_STAGE_A(bufoff, gb, h, o0, o1) do { if constexpr (GATHER) { const unsigned _ko = (unsigned)((gb) - gA0); unsigned _o[2]; \
            if ((h) == 0) { _o[0] = (o0)[0] + _ko; _o[1] = (o0)[1] + _ko; } else { _o[0] = (o1)[0] + _ko; _o[1] = (o1)[1] + _ko; } PG8_STAGE(bufoff, gA0, _o); } \
        else { PG8_STAGE(bufoff, (gb) + (h) * hstep, voffA); } } while (0)
#define PG8_LD8(p) __builtin_shufflevector(*(const LAS i32x4v*)(p), *(const LAS i32x4v*)((p) + 1024), 0, 1, 2, 3, 4, 5, 6, 7)
#define PG8_LDA(dst, b, h) do { if constexpr (FP8) { _Pragma("unroll") for (int m = 0; m < 4; ++m) dst##8[m] = PG8_LD8(lds + PG8_SA(b, h) + aoff + m * 2048); } \
        else { _Pragma("unroll") for (int m = 0; m < 4; ++m) _Pragma("unroll") for (int k = 0; k < 2; ++k) dst[m][k] = *(const LAS bf16x8*)(lds + PG8_SA(b, h) + aoff + m * 2048 + k * 1024); } } while (0)
#define PG8_LDB(dst, b, h) do { if constexpr (FP8) { _Pragma("unroll") for (int n = 0; n < 2; ++n) dst##8[n] = PG8_LD8(lds + PG8_SB(b, h) + boff + n * 2048); } \
        else { _Pragma("unroll") for (int n = 0; n < 2; ++n) _Pragma("unroll") for (int k = 0; k < 2; ++k) dst[n][k] = *(const LAS bf16x8*)(lds + PG8_SB(b, h) + boff + n * 2048 + k * 1024); } } while (0)
#define PG8_MMA(ai, bj, At, Bt) do { __builtin_amdgcn_s_setprio(1); if constexpr (FP8) { _Pragma("unroll") for (int m = 0; m < 4; ++m) _Pragma("unroll") for (int n = 0; n < 2; ++n) \
            asm volatile("v_mfma_scale_f32_16x16x128_f8f6f4 %0, %1, %2, %0, %3, %3 op_sel_hi:[0,0,0]" : "+v"(acc[ai][bj][m][n]) : "v"(Bt##8[n]), "v"(At##8[m]), "v"(sc127)); } \
        else { _Pragma("unroll") for (int m = 0; m < 4; ++m) _Pragma("unroll") for (int n = 0; n < 2; ++n) _Pragma("unroll") for (int k = 0; k < 2; ++k) \
            acc[ai][bj][m][n] = __builtin_amdgcn_mfma_f32_16x16x32_bf16(Bt[n][k], At[m][k], acc[ai][bj][m][n], 0, 0, 0); } __builtin_amdgcn_s_setprio(0); } while (0)
#define PG8_WAIT_V(n) asm volatile("s_waitcnt vmcnt(" #n ")" ::: "memory")
#define PG8_WAIT_L(n) asm volatile("s_waitcnt lgkmcnt(" #n ")" ::: "memory")
#define PG8_BAR __builtin_amdgcn_s_barrier()
#define PG8_SCHED __builtin_amdgcn_sched_barrier(0)
    Unit cur, nxt; int ui = 0; unsigned long long kcsum = 0; int kcn = 0; const unsigned long long kph0 = (DBG_KCLK && !FP8 && !GATHER) ? __builtin_amdgcn_s_memtime() : 0ull;
    if (!S.next(0, cur)) return;
    f32x4 acc[2][2][4][2];
#pragma unroll
    for (int a = 0; a < 2; ++a)
#pragma unroll
        for (int b = 0; b < 2; ++b)
#pragma unroll
            for (int m = 0; m < 4; ++m)
#pragma unroll
                for (int n = 0; n < 2; ++n) acc[a][b][m][n] = (f32x4){0.f, 0.f, 0.f, 0.f};
    const int sc127 = 0x7f7f7f7f;
    bf16x8 At[4][2], B0[2][2], B1[2][2]; i32x8 At8[4], B08[2], B18[2];
    const char* cA = S.a_base(cur); const char* cB = S.b_base(cur);
    const char* const gA0 = cA;
    unsigned cv0[2] = {0u, 0u}, cv1[2] = {0u, 0u}, nv0[2] = {0u, 0u}, nv1[2] = {0u, 0u};
    if constexpr (GATHER) S.a_offs(cur, Rr, Cc, cv0, cv1);
#define PG8_SLOT(i) (lds + LDS_AUX + 4096 + ((i) & 1) * 4096)
    if constexpr (Epi::PREFETCH) { if (wid == 0) E.prefetch(cur, PG8_SLOT(0), lane); }
    PG8_STAGE(PG8_SB(0, 0), cB, voffB); PG8_STAGE_A(PG8_SA(0, 0), cA, 0, cv0, cv1); PG8_STAGE(PG8_SB(0, 1), cB + hstepB, voffB); PG8_STAGE_A(PG8_SA(0, 1), cA, 1, cv0, cv1);
    if (wr == 1) PG8_BAR;
    PG8_WAIT_V(4); PG8_BAR;
    PG8_STAGE(PG8_SB(1, 0), cB + kstep, voffB); PG8_STAGE_A(PG8_SA(1, 0), cA + kstep, 0, cv0, cv1); PG8_STAGE(PG8_SB(1, 1), cB + hstepB + kstep, voffB);
    PG8_WAIT_V(6); PG8_BAR;
    for (;;) {
        const bool has_next = S.next(ui + 1, nxt);
        const char* nA = has_next ? S.a_base(nxt) : cA; const char* nB = has_next ? S.b_base(nxt) : cB;
        if constexpr (Epi::PREFETCH) { if (ui > 0 && wid == 0) E.prefetch(cur, PG8_SLOT(ui), lane); }
        if constexpr (GATHER) { if (has_next && wid == 1) S.a_offs_dma(nxt, PG8_SLOT(ui + 1) + 2048, lane); }
        unsigned long long kc0 = 0; if constexpr (DBG_KCLK && !FP8 && !GATHER) kc0 = __builtin_amdgcn_s_memtime();
#pragma nounroll
        for (int t = 0; t < nt; t += 2) {
            const bool last = (t == nt - 2);
            const char* a1 = cA + (size_t)(t + 1) * kstep;
            const char* a2 = last ? nA : cA + (size_t)(t + 2) * kstep; const char* b2 = last ? nB : cB + (size_t)(t + 2) * kstep;
            const char* a3 = a2 + kstep; const char* b3 = b2 + kstep;
            unsigned s0[2], s1[2];
            if constexpr (GATHER) {
                if (last) { if (has_next) S.a_offs_ring(nxt, Rr, Cc, PG8_SLOT(ui + 1) + 2048, nv0, nv1); else { nv0[0] = cv0[0]; nv0[1] = cv0[1]; nv1[0] = cv1[0]; nv1[1] = cv1[1]; }
                    s0[0] = nv0[0]; s0[1] = nv0[1]; s1[0] = nv1[0]; s1[1] = nv1[1]; }
                else { s0[0] = cv0[0]; s0[1] = cv0[1]; s1[0] = cv1[0]; s1[1] = cv1[1]; } }
            else { s0[0] = s0[1] = s1[0] = s1[1] = 0u; }
            PG8_LDB(B0, 0, 0); PG8_SCHED; PG8_LDA(At, 0, 0); PG8_STAGE_A(PG8_SA(1, 1), a1, 1, cv0, cv1);
            PG8_WAIT_L(8); PG8_BAR; PG8_WAIT_L(0); PG8_MMA(0, 0, At, B0); PG8_BAR; PG8_SCHED;
            PG8_LDB(B1, 0, 1); PG8_STAGE(PG8_SB(0, 0), b2, voffB);
            PG8_BAR; PG8_WAIT_L(0); PG8_MMA(0, 1, At, B1); PG8_BAR;
            PG8_LDA(At, 0, 1); PG8_STAGE_A(PG8_SA(0, 0), a2, 0, s0, s1);
            PG8_BAR; PG8_WAIT_L(0); PG8_MMA(1, 0, At, B0); PG8_BAR; PG8_SCHED;
            PG8_STAGE(PG8_SB(0, 1), b2 + hstepB, voffB);
            PG8_WAIT_V(6); PG8_BAR; PG8_MMA(1, 1, At, B1); PG8_BAR;
            PG8_LDB(B0, 1, 0); PG8_SCHED; PG8_LDA(At, 1, 0); PG8_STAGE_A(PG8_SA(0, 1), a2, 1, s0, s1);
            PG8_WAIT_L(8); PG8_BAR; PG8_WAIT_L(0); PG8_MMA(0, 0, At, B0); PG8_BAR; PG8_SCHED;
            PG8_LDB(B1, 1, 1); PG8_STAGE(PG8_SB(1, 0), b3, voffB);
            PG8_BAR; PG8_WAIT_L(0); PG8_MMA(0, 1, At, B1); PG8_BAR;
            PG8_LDA(At, 1, 1); PG8_STAGE_A(PG8_SA(1, 0), a3, 0, s0, s1);
            PG8_BAR; PG8_WAIT_L(0); PG8_MMA(1, 0, At, B0); PG8_BAR; PG8_SCHED;
            PG8_STAGE(PG8_SB(1, 1), b3 + hstepB, voffB);
            PG8_WAIT_V(6); PG8_BAR; PG8_MMA(1, 1, At, B1); PG8_BAR;
        }
        if constexpr (DBG_KCLK && !FP8 && !GATHER) { kc0 = __builtin_amdgcn_s_memtime(); }
        if constexpr (FP8) asm volatile("s_nop 15\n\ts_nop 15" ::: "memory");
        E(acc, cur, wr, wc, fr, fq, PG8_SLOT(ui));
        if constexpr (DBG_KCLK && !FP8 && !GATHER) { asm volatile("s_waitcnt vmcnt(0)" ::: "memory"); kcsum += __builtin_amdgcn_s_memtime() - kc0; ++kcn; }
        if (!has_next) break;
#pragma unroll
        for (int a = 0; a < 2; ++a)
#pragma unroll
            for (int b = 0; b < 2; ++b)
#pragma unroll
                for (int m = 0; m < 4; ++m)
#pragma unroll
                    for (int n = 0; n < 2; ++n) acc[a][b][m][n] = (f32x4){0.f, 0.f, 0.f, 0.f};
        cur = nxt; cA = nA; cB = nB; ++ui;
        if constexpr (GATHER) { cv0[0] = nv0[0]; cv0[1] = nv0[1]; cv1[0] = nv1[0]; cv1[1] = nv1[1]; }
    }
    PG8_WAIT_V(0);
    if (wr == 0) PG8_BAR;
    PG8_BAR;
    if constexpr (DBG_KCLK && !FP8 && !GATHER) { unsigned* dw = dbgw_of(S, 0); if (dw && tid == 0) { kcsum = __builtin_amdgcn_s_memtime() - kph0; const float cpk = (float)kcsum / (float)(kcn) * (1.f / 40000.f); atomicMax(dw, __float_as_uint(powf(10.f, 2.f * (rintf(cpk * 10.f) * 0.1f) - 4.f))); } }
#undef PG8_SA
#undef PG8_SB
#undef PG8_STAGE
#undef PG8_STAGE_A
#undef PG8_LDA
#undef PG8_LDB
#undef PG8_MMA
#undef PG8_LD8
#undef PG8_WAIT_V
#undef PG8_WAIT_L
#undef PG8_BAR
#undef PG8_SCHED
}
}
using pg8::Unit;
typedef f32x4 AccT[2][2][4][2];

struct Args { const float* in[28]; float* out; unsigned char* ws; int ph_lo, ph_hi, pad0, pad1; };
struct Frame {
    LAS unsigned char* lds;
    int tid, lane, wave, G, bid;
    const struct Args* a;
    unsigned char* ws; unsigned char* outb;
};
template <int RB = 2048> struct SchedPlainT {
    pg8::StaticOrder o; const char* A; const char* Bt;
    __device__ __forceinline__ bool next(int i, Unit& u) const { return o.next(i, u); }
    __device__ __forceinline__ const char* a_base(const Unit& u) const { return A + (size_t)u.pm * (256 * RB); }
    __device__ __forceinline__ const char* b_base(const Unit& u) const { return Bt + (size_t)u.pn * (256 * RB); }
    __device__ __forceinline__ void a_offs(const Unit&, const int*, const int*, unsigned (&)[2], unsigned (&)[2]) const {}
};
typedef SchedPlainT<2048> SchedPlain;
template <int MODE> struct SchedProj {
    pg8::StaticOrder o; const char* A; const char* Bt; int fold = 0x7fffffff; unsigned* dbgw = nullptr;
    static constexpr int RB = MODE == 2 ? 1024 : 2048;
    __device__ __forceinline__ bool next(int i, Unit& u) const { if (!o.next(i, u)) return false; const int r = u.pn;
        if (MODE == 1) u.pn = 4 + r;
        if (MODE == 2) u.pn = r < 4 ? r : 15 + r;
        return true; }
    __device__ __forceinline__ const char* a_base(const Unit& u) const { return A + (size_t)(DBG_DRYPROJ ? (u.pm & fold) : u.pm) * (256 * RB); }
    __device__ __forceinline__ const char* b_base(const Unit& u) const { return Bt + (size_t)u.pn * (256 * RB); }
    __device__ __forceinline__ void a_offs(const Unit&, const int*, const int*, unsigned (&)[2], unsigned (&)[2]) const {}
};

struct EpiProj {
    static constexpr bool PERM = true, PREFETCH = false, ADJ = true;
    bf16_t *Q, *IQ, *Z, *XBC, *GA, *GB; float* MISC; float sc; int dry = 0;
    __device__ __forceinline__ void operator()(const AccT& acc, const Unit& u, int wr, int wc, int fr, int fq, const LAS unsigned char* slot) const {
        const int pn = u.pn, row0 = u.pm * 256 + wr * 64 + fr, c8 = wc * 64 + 8 * fq;
        if (pn == 6) {
#pragma unroll
            for (int ai = 0; ai < 2; ++ai)
#pragma unroll
                for (int m = 0; m < 4; ++m) { float* rp = MISC + (size_t)(row0 + ai * 128 + m * 16) * 256 + c8;
#pragma unroll
                    for (int bj = 0; bj < 2; ++bj) { if (DBG_DRYPROJ && dry && acc[ai][bj][m][0][0] != 1.2345e-33f) continue; *(f32x4*)(rp + bj * 32) = acc[ai][bj][m][0]; *(f32x4*)(rp + bj * 32 + 4) = acc[ai][bj][m][1]; } }
            return;
        }
        bf16_t* base; int ldc, colt, act = 0;
        if (pn < 4) { base = Q; ldc = 1024; colt = pn * 256; }
        else if (pn < 6) { base = IQ; ldc = 512; colt = (pn - 4) * 256; }
        else if (pn < 11) { base = Z; ldc = 1024; colt = (pn - 7) * 256; act = 1; }
        else if (pn < 19) { base = XBC; ldc = 2048; colt = (pn - 11) * 256; }
        else if (pn < 23) { base = GA; ldc = 1024; colt = (pn - 19) * 256; act = 2; }
        else { base = GB; ldc = 1024; colt = (pn - 23) * 256; act = 2; }
#pragma unroll
        for (int ai = 0; ai < 2; ++ai)
#pragma unroll
            for (int m = 0; m < 4; ++m) { bf16_t* rp = base + (size_t)(row0 + ai * 128 + m * 16) * ldc + colt + c8;
#pragma unroll
                for (int bj = 0; bj < 2; ++bj) { f32x4 v0 = acc[ai][bj][m][0] * sc, v1 = acc[ai][bj][m][1] * sc;
                    if (act == 1) {
#pragma unroll
                        for (int j = 0; j < 4; ++j) { v0[j] = silu_f(v0[j]); v1[j] = silu_f(v1[j]); } }
                    if (act == 2) {
#pragma unroll
                        for (int j = 0; j < 4; ++j) { v0[j] = sigmoid_f(v0[j]); v1[j] = sigmoid_f(v1[j]); } }
                    if (GATE_U8 && act == 2) {
                        unsigned lo = 0u, hi = 0u;
#pragma unroll
                        for (int j = 0; j < 4; ++j) { lo = __builtin_amdgcn_cvt_pk_u8_f32(__builtin_rintf(v0[j] * 255.f), j, lo); hi = __builtin_amdgcn_cvt_pk_u8_f32(__builtin_rintf(v1[j] * 255.f), j, hi); }
                        u32x2 q; q.x = lo; q.y = hi;
                        *(u32x2*)((unsigned char*)base + (size_t)(row0 + ai * 128 + m * 16) * 1024 + colt + c8 + bj * 32) = q; continue; }
                    u32x4 pk = pack8(v0, v1); if (DBG_IQ_TRUNC && (pn == 4 || pn == 5)) { pk.x &= 0xfff8fff8u; pk.y &= 0xfff8fff8u; pk.z &= 0xfff8fff8u; pk.w &= 0xfff8fff8u; }
                    if (DBG_DRYPROJ && dry && pk.x != 0x7fc17fc3u) continue;
                    *(u32x4*)(rp + bj * 32) = pk; } }
    }
};
template <int MODE> struct EpiGate {
    static constexpr bool PERM = true, PREFETCH = false, ADJ = true;
    const bf16_t* Gt; const bf16_t* T; bf16_t* O; float sc;
    __device__ __forceinline__ void operator()(const AccT& acc, const Unit& u, int wr, int wc, int fr, int fq, const LAS unsigned char* slot) const {
        const int row0 = u.pm * 256 + wr * 64 + fr, c8 = u.pn * 256 + wc * 64 + 8 * fq;
        if constexpr (MODE == 0 && GATE_U8) {
            u32x2 g8a[2][4][2];
#pragma unroll
            for (int ai = 0; ai < 2; ++ai)
#pragma unroll
                for (int m = 0; m < 4; ++m) { const size_t off = (size_t)(row0 + ai * 128 + m * 16) * 1024 + c8;
#pragma unroll
                    for (int bj = 0; bj < 2; ++bj) g8a[ai][m][bj] = *(const u32x2*)((const unsigned char*)Gt + off + bj * 32); }
            SBAR();
#pragma unroll
            for (int ai = 0; ai < 2; ++ai)
#pragma unroll
                for (int m = 0; m < 4; ++m) { const size_t off = (size_t)(row0 + ai * 128 + m * 16) * 1024 + c8;
#pragma unroll
                    for (int bj = 0; bj < 2; ++bj) { const unsigned a = g8a[ai][m][bj].x, b = g8a[ai][m][bj].y; constexpr float q = 1.f / 255.f;
                        const f32x4 g0 = (f32x4){(float)(a & 255u), (float)((a >> 8) & 255u), (float)((a >> 16) & 255u), (float)(a >> 24)} * q;
                        const f32x4 g1 = (f32x4){(float)(b & 255u), (float)((b >> 8) & 255u), (float)((b >> 16) & 255u), (float)(b >> 24)} * q;
                        f32x4 v0 = g0 * (acc[ai][bj][m][0] * sc), v1 = g1 * (acc[ai][bj][m][1] * sc);
                        if (DBG_NO_ATTN) { v0 = (f32x4){0.f, 0.f, 0.f, 0.f}; v1 = v0; }
                        if (TMP_FP8) *(u32x2*)((unsigned char*)O + off + bj * 32) = pack8_fp8(v0 * PO_ASC, v1 * PO_ASC);
                        else *(u32x4*)(O + off + bj * 32) = pack8(v0, v1); } }
            return;
        }
        if constexpr (MODE == 1 && GATE_U8 && TMP_FP8) {
            u32x2 tqa[2][4][2], g8a[2][4][2];
#pragma unroll
            for (int ai = 0; ai < 2; ++ai)
#pragma unroll
                for (int m = 0; m < 4; ++m) { const size_t off = (size_t)(row0 + ai * 128 + m * 16) * 1024 + c8;
#pragma unroll
                    for (int bj = 0; bj < 2; ++bj) { g8a[ai][m][bj] = *(const u32x2*)((const unsigned char*)Gt + off + bj * 32); tqa[ai][m][bj] = *(const u32x2*)((const unsigned char*)T + off + bj * 32); } }
            SBAR();
#pragma unroll
            for (int ai = 0; ai < 2; ++ai)
#pragma unroll
                for (int m = 0; m < 4; ++m) { const size_t off = (size_t)(row0 + ai * 128 + m * 16) * 1024 + c8;
#pragma unroll
                    for (int bj = 0; bj < 2; ++bj) { const unsigned a = g8a[ai][m][bj].x, b = g8a[ai][m][bj].y; constexpr float q = 1.f / 255.f;
                        const f32x4 g0 = (f32x4){(float)(a & 255u), (float)((a >> 8) & 255u), (float)((a >> 16) & 255u), (float)(a >> 24)} * q;
                        const f32x4 g1 = (f32x4){(float)(b & 255u), (float)((b >> 8) & 255u), (float)((b >> 16) & 255u), (float)(b >> 24)} * q;
                        f32x4 v0 = g0 * (acc[ai][bj][m][0] * sc), v1 = g1 * (acc[ai][bj][m][1] * sc);
                        if (DBG_NO_SSD) { v0 = (f32x4){0.f, 0.f, 0.f, 0.f}; v1 = v0; }
                        f32x4 t0, t1; unpack8_fp8(tqa[ai][m][bj], t0, t1); v0 += t0 * (1.0f / PO_ASC); v1 += t1 * (1.0f / PO_ASC);
                        if (PO_FP8) *(u32x2*)((unsigned char*)O + off + bj * 32) = pack8_fp8(v0 * PO_ASC, v1 * PO_ASC);
                        else *(u32x4*)(O + off + bj * 32) = pack8(v0, v1); } }
            return;
        }
#pragma unroll
        for (int ai = 0; ai < 2; ++ai) {
            u32x4 gq[4][2], tq[4][2]; u32x2 g8[4][2];
#pragma unroll
            for (int m = 0; m < 4; ++m) { const size_t off = (size_t)(row0 + ai * 128 + m * 16) * 1024 + c8;
#pragma unroll
                for (int bj = 0; bj < 2; ++bj) { if (GATE_U8) g8[m][bj] = *(const u32x2*)((const unsigned char*)Gt + off + bj * 32); else gq[m][bj] = *(const u32x4*)(Gt + off + bj * 32);
                    if (MODE == 1) tq[m][bj] = *(const u32x4*)(T + off + bj * 32); } }
            SBAR();
#pragma unroll
            for (int m = 0; m < 4; ++m) { const size_t off = (size_t)(row0 + ai * 128 + m * 16) * 1024 + c8;
#pragma unroll
                for (int bj = 0; bj < 2; ++bj) { f32x4 g0, g1;
                    if (GATE_U8) { const unsigned a = g8[m][bj].x, b = g8[m][bj].y; constexpr float q = 1.f / 255.f;
                        g0 = (f32x4){(float)(a & 255u), (float)((a >> 8) & 255u), (float)((a >> 16) & 255u), (float)(a >> 24)} * q;
                        g1 = (f32x4){(float)(b & 255u), (float)((b >> 8) & 255u), (float)((b >> 16) & 255u), (float)(b >> 24)} * q; }
                    else unpack8(gq[m][bj], g0, g1);
                    f32x4 v0 = g0 * (acc[ai][bj][m][0] * sc), v1 = g1 * (acc[ai][bj][m][1] * sc);
                    if ((MODE == 0 && DBG_NO_ATTN) || (MODE == 1 && DBG_NO_SSD)) { v0 = (f32x4){0.f, 0.f, 0.f, 0.f}; v1 = v0; }
                    if (MODE == 1) { f32x4 t0, t1; unpack8(tq[m][bj], t0, t1); v0 += t0; v1 += t1; }
                    if (MODE == 1 && PO_FP8) *(u32x2*)((unsigned char*)O + off + bj * 32) = pack8_fp8(v0 * PO_ASC, v1 * PO_ASC);
                    else *(u32x4*)(O + off + bj * 32) = pack8(v0, v1); } }
            SBAR();
        }
    }
};
struct EpiOut {
    static constexpr bool PERM = true, PREFETCH = false, ADJ = true;
    const float* x; const float* mod; bf16_t* V; float sc = 1.0f;
    __device__ __forceinline__ void operator()(const AccT& acc, const Unit& u, int wr, int wc, int fr, int fq, const LAS unsigned char* slot) const {
        const int row0 = u.pm * 256 + wr * 64 + fr, c8 = u.pn * 256 + wc * 64 + 8 * fq;
        const float* g1 = mod + (size_t)(u.pm >> 3) * 6144 + 2048 + c8;
        f32x4 gv[2][2];
#pragma unroll
        for (int bj = 0; bj < 2; ++bj)
#pragma unroll
            for (int n = 0; n < 2; ++n) gv[bj][n] = *(const f32x4*)(g1 + bj * 32 + n * 4) * sc;
#pragma unroll
        for (int ai = 0; ai < 2; ++ai) {
            f32x4 xv[4][2][2];
#pragma unroll
            for (int m = 0; m < 4; ++m) { const size_t off = (size_t)(row0 + ai * 128 + m * 16) * 1024 + c8;
#pragma unroll
                for (int bj = 0; bj < 2; ++bj)
#pragma unroll
                    for (int n = 0; n < 2; ++n) xv[m][bj][n] = *(const f32x4*)(x + off + bj * 32 + n * 4); }
            SBAR();
#pragma unroll
            for (int m = 0; m < 4; ++m) { const size_t off = (size_t)(row0 + ai * 128 + m * 16) * 1024 + c8;
#pragma unroll
                for (int bj = 0; bj < 2; ++bj)
                    *(u32x4*)(V + off + bj * 32) = pack8(xv[m][bj][0] * DN_ALPHA + gv[bj][0] * acc[ai][bj][m][0], xv[m][bj][1] * DN_ALPHA + gv[bj][1] * acc[ai][bj][m][1]); }
            SBAR();
        }
    }
};

struct MoeTab { LAS unsigned* cnt; LAS unsigned* tb; LAS unsigned char* te; int ntiles; };
__device__ __forceinline__ MoeTab moe_tables(Frame& F, int hf) {
    MoeTab T; T.cnt = (LAS unsigned*)(F.lds + LDS_AUX); T.tb = (LAS unsigned*)(F.lds + LDS_AUX + 256); T.te = (LAS unsigned char*)(F.lds + LDS_AUX + 512);
    const unsigned* CNT = (const unsigned*)(F.ws + WS_CTL) + CW_CNT;
    __syncthreads();
    if (F.tid < 32) { unsigned c = __hip_atomic_load(CNT + 64 * (hf * 32 + F.tid), __ATOMIC_RELAXED, __HIP_MEMORY_SCOPE_AGENT); if (c > (unsigned)REG_CAP) c = REG_CAP; T.cnt[F.tid] = c; }
    __syncthreads();
    if (F.tid < 33) { unsigned s = 0;
#pragma nounroll
        for (int e = 0; e < F.tid; ++e) s += (T.cnt[e] + 255u) >> 8;
        T.tb[F.tid] = s; }
    __syncthreads();
    { const unsigned total = T.tb[32];
      for (unsigned t = F.tid; t < total; t += NTHR) { int lo = 0;
#pragma unroll
          for (int st = 16; st >= 1; st >>= 1) { if (T.tb[lo + st] <= t) lo += st; }
          T.te[t] = (unsigned char)lo; } }
    __syncthreads();
    T.ntiles = __builtin_amdgcn_readfirstlane((int)T.tb[32]);
    return T;
}
template <int NJ, bool GATHER> struct SchedMoe {
    MoeTab T; int G, c, hf; const char* A; const char* Bt; const u32x2* REG;
    __device__ __forceinline__ bool next(int i, Unit& u) const {
        int tile, j;
        if (G == 256) { const int x = c & 7, sl = c >> 3;
            tile = i * (256 / NJ) + x * (32 / NJ) + sl / NJ; j = sl % NJ;
            if (tile >= T.ntiles) return false; }
        else { const int L = i * G + c; if (L >= T.ntiles * NJ) return false; tile = L / NJ; j = L % NJ; }
        u.pm = tile; u.pn = j; u.ex = __builtin_amdgcn_readfirstlane((int)T.te[u.pm]); return true;
    }
    __device__ __forceinline__ const char* a_base(const Unit& u) const { return GATHER ? A : A + (size_t)u.pm * (256 * MOE_RB); }
    __device__ __forceinline__ const char* b_base(const Unit& u) const { return Bt + ((size_t)u.ex * (NJ * 256) + (size_t)u.pn * 256) * MOE_RB; }
    __device__ __forceinline__ void a_offs_dma(const Unit& u, LAS unsigned char* dst, int lane) const {
        const unsigned pos0 = ((unsigned)u.pm - (unsigned)__builtin_amdgcn_readfirstlane(T.tb[u.ex])) * 256u; const u32x2* rg = REG + ((size_t)hf * 32 + u.ex) * REG_CAP + pos0;
        __builtin_amdgcn_global_load_lds((const unsigned*)((const char*)rg + lane * 16), (LAS unsigned*)dst, 16, 0, 0);
        __builtin_amdgcn_global_load_lds((const unsigned*)((const char*)rg + 1024 + lane * 16), (LAS unsigned*)(dst + 1024), 16, 0, 0); }
    __device__ __forceinline__ void a_offs_ring(const Unit& u, const int* R, const int* C, const LAS unsigned char* src, unsigned (&o0)[2], unsigned (&o1)[2]) const {
        const unsigned cnt = __builtin_amdgcn_readfirstlane(T.cnt[u.ex]), pos0 = ((unsigned)u.pm - (unsigned)__builtin_amdgcn_readfirstlane(T.tb[u.ex])) * 256u;
#pragma unroll
        for (int i = 0; i < 2; ++i) { const unsigned p0 = pos0 + (unsigned)R[i], p1 = p0 + 128u;
            const unsigned r0 = *(const LAS unsigned*)(src + R[i] * 8), r1 = *(const LAS unsigned*)(src + (R[i] + 128) * 8);
            const unsigned t0 = p0 < cnt ? (unsigned)hf * HALF_TOK + (r0 >> 2) : 0u, t1 = p1 < cnt ? (unsigned)hf * HALF_TOK + (r1 >> 2) : 0u;
            o0[i] = t0 * (unsigned)MOE_RB + (unsigned)C[i] * 2u; o1[i] = t1 * (unsigned)MOE_RB + (unsigned)C[i] * 2u; } }
    __device__ __forceinline__ void a_offs_issue(const Unit& u, const int* R, unsigned (&raw)[4]) const {
        const unsigned cnt = __builtin_amdgcn_readfirstlane(T.cnt[u.ex]), pos0 = ((unsigned)u.pm - (unsigned)__builtin_amdgcn_readfirstlane(T.tb[u.ex])) * 256u; const u32x2* rg = REG + ((size_t)hf * 32 + u.ex) * REG_CAP;
#pragma unroll
        for (int i = 0; i < 2; ++i) { const unsigned p0 = pos0 + (unsigned)R[i], p1 = p0 + 128u; const u32x2* q0 = rg + (p0 < cnt ? p0 : cnt - 1u); const u32x2* q1 = rg + (p1 < cnt ? p1 : cnt - 1u);
            asm volatile("global_load_dword %0, %1, off" : "=&v"(raw[2 * i]) : "v"(q0) : "memory"); asm volatile("global_load_dword %0, %1, off" : "=&v"(raw[2 * i + 1]) : "v"(q1) : "memory"); } }
    __device__ __forceinline__ void a_offs_finish(const Unit& u, const int* R, const int* C, unsigned (&raw)[4], unsigned (&o0)[2], unsigned (&o1)[2]) const {
        asm volatile("" : "+v"(raw[0]), "+v"(raw[1]), "+v"(raw[2]), "+v"(raw[3]));
        const unsigned cnt = __builtin_amdgcn_readfirstlane(T.cnt[u.ex]), pos0 = ((unsigned)u.pm - (unsigned)__builtin_amdgcn_readfirstlane(T.tb[u.ex])) * 256u;
#pragma unroll
        for (int i = 0; i < 2; ++i) { const unsigned p0 = pos0 + (unsigned)R[i], p1 = p0 + 128u;
            const unsigned t0 = p0 < cnt ? (unsigned)hf * HALF_TOK + (raw[2 * i] >> 2) : 0u, t1 = p1 < cnt ? (unsigned)hf * HALF_TOK + (raw[2 * i + 1] >> 2) : 0u;
            o0[i] = t0 * (unsigned)MOE_RB + (unsigned)C[i] * 2u; o1[i] = t1 * (unsigned)MOE_RB + (unsigned)C[i] * 2u; } }
    __device__ __forceinline__ void a_offs(const Unit& u, const int* R, const int* C, unsigned (&o0)[2], unsigned (&o1)[2]) const {
        const unsigned cnt = __builtin_amdgcn_readfirstlane(T.cnt[u.ex]), pos0 = ((unsigned)u.pm - (unsigned)__builtin_amdgcn_readfirstlane(T.tb[u.ex])) * 256u; const u32x2* rg = REG + ((size_t)hf * 32 + u.ex) * REG_CAP;
#pragma unroll
        for (int i = 0; i < 2; ++i) {
            const unsigned p0 = pos0 + (unsigned)R[i], p1 = p0 + 128u;
            unsigned t0 = 0u, t1 = 0u;
            if (p0 < cnt) t0 = (unsigned)hf * HALF_TOK + (rg[p0].x >> 2);
            if (p1 < cnt) t1 = (unsigned)hf * HALF_TOK + (rg[p1].x >> 2);
            o0[i] = t0 * (unsigned)MOE_RB + (unsigned)C[i] * 2u; o1[i] = t1 * (unsigned)MOE_RB + (unsigned)C[i] * 2u;
        }
    }
};
struct EpiMoe1 {
    static constexpr bool PERM = true, PREFETCH = true, ADJ = false;
    const float* b1; bf16_t* ACT; int dry;
    __device__ __forceinline__ void prefetch(const Unit& u, LAS unsigned char* slot, int lane) const {
        const float* g = b1 + (size_t)u.ex * 2048 + u.pn * 128 + (lane >> 5) * 1024 + (lane & 31) * 4;
        __builtin_amdgcn_global_load_lds((const unsigned*)g, (LAS unsigned*)slot, 16, 0, 0); }
    __device__ __forceinline__ void operator()(const AccT& acc, const Unit& u, int wr, int wc, int fr, int fq, const LAS unsigned char* slot) const {
        if (dry) { if (acc[0][0][0][0][0] == 1.2345e-33f) ACT[0] = 1; return; }
        const int row0 = u.pm * 256 + wr * 64 + fr, c8 = u.pn * 128 + wc * 32 + 8 * fq;
        const LAS float* bg = (const LAS float*)slot + wc * 32 + 8 * fq;
        const f32x4 bg0 = *(const LAS f32x4*)bg, bg1 = *(const LAS f32x4*)(bg + 4), bu0 = *(const LAS f32x4*)(bg + 128), bu1 = *(const LAS f32x4*)(bg + 132);
#pragma unroll
        for (int ai = 0; ai < 2; ++ai)
#pragma unroll
            for (int m = 0; m < 4; ++m) {
                f32x4 g0 = acc[ai][0][m][0] * MOE_INV + bg0, g1 = acc[ai][0][m][1] * MOE_INV + bg1, u0 = acc[ai][1][m][0] * MOE_INV + bu0, u1 = acc[ai][1][m][1] * MOE_INV + bu1, a0, a1;
#pragma unroll
                for (int j = 0; j < 4; ++j) {
                    float g = fminf(g0[j], 7.0f), up = fminf(fmaxf(u0[j], -7.0f), 7.0f); a0[j] = (up + 1.0f) * g * sigmoid_f(1.702f * g);
                    g = fminf(g1[j], 7.0f); up = fminf(fmaxf(u1[j], -7.0f), 7.0f); a1[j] = (up + 1.0f) * g * sigmoid_f(1.702f * g); }
                if (MOE_FP8) *(u32x2*)((unsigned char*)ACT + (size_t)(row0 + ai * 128 + m * 16) * 1024 + c8) = pack8_fp8(a0, a1);
                else *(u32x4*)(ACT + (size_t)(row0 + ai * 128 + m * 16) * 1024 + c8) = pack8(a0, a1); }
    }
};
struct EpiMoe2 {
    static constexpr bool PERM = true, PREFETCH = true, ADJ = true;
    const float* b2; bf16_t* YB; const u32x2* REG; MoeTab T; int hf; int dry;
    __device__ __forceinline__ void prefetch(const Unit& u, LAS unsigned char* slot, int lane) const {
        const unsigned pos0 = ((unsigned)u.pm - (unsigned)__builtin_amdgcn_readfirstlane(T.tb[u.ex])) * 256u; const u32x2* rg = REG + ((size_t)hf * 32 + u.ex) * REG_CAP + pos0;
        __builtin_amdgcn_global_load_lds((const unsigned*)((const char*)rg + lane * 16), (LAS unsigned*)slot, 16, 0, 0);
        __builtin_amdgcn_global_load_lds((const unsigned*)((const char*)rg + 1024 + lane * 16), (LAS unsigned*)(slot + 1024), 16, 0, 0);
        __builtin_amdgcn_global_load_lds((const unsigned*)(b2 + (size_t)u.ex * 1024 + u.pn * 256 + lane * 4), (LAS unsigned*)(slot + 2048), 16, 0, 0); }
    __device__ __forceinline__ void operator()(const AccT& acc, const Unit& u, int wr, int wc, int fr, int fq, const LAS unsigned char* slot) const {
        if (dry == 1) { if (acc[0][0][0][0][0] == 1.2345e-33f) YB[0] = 1; return; }
        if (dry >= 2) {
            const int c8d = (dry == 3 ? 0 : u.pn * 256) + wc * 32 + 8 * fq; const unsigned rowd = dry == 3 ? (blockIdx.x * 256u + (unsigned)(wr * 64 + fr)) : ((unsigned)u.pm * 256u + (unsigned)(wr * 64 + fr)) % 131072u;
#pragma unroll
            for (int ai = 0; ai < 2; ++ai)
#pragma unroll
                for (int m = 0; m < 4; ++m) { bf16_t* rp = YB + (size_t)((rowd + ai * 128 + m * 16) % 131072u) * 1024 + c8d;
#pragma unroll
                    for (int bj = 0; bj < 2; ++bj) *(u32x4*)(rp + bj * 128) = pack8(acc[ai][bj][m][0] * MOE_INV, acc[ai][bj][m][1] * MOE_INV); }
            return; }
        const int c8 = u.pn * 256 + wc * 64 + 8 * fq;
        const unsigned cnt = __builtin_amdgcn_readfirstlane(T.cnt[u.ex]), pos0 = ((unsigned)u.pm - (unsigned)__builtin_amdgcn_readfirstlane(T.tb[u.ex])) * 256u + (unsigned)(wr * 64 + fr); const u32x2* rg = REG + ((size_t)hf * 32 + u.ex) * REG_CAP;
        const LAS float* bb = (const LAS float*)(slot + 2048) + wc * 64 + 8 * fq;
        f32x4 bv[2][2];
#pragma unroll
        for (int bj = 0; bj < 2; ++bj) { bv[bj][0] = *(const LAS f32x4*)(bb + bj * 32); bv[bj][1] = *(const LAS f32x4*)(bb + bj * 32 + 4); }
        u32x2 en8[2][4];
#pragma unroll
        for (int ai = 0; ai < 2; ++ai)
#pragma unroll
            for (int m = 0; m < 4; ++m) en8[ai][m] = *(const LAS u32x2*)(slot + (wr * 64 + fr + ai * 128 + m * 16) * 8);
#pragma unroll
        for (int ai = 0; ai < 2; ++ai)
#pragma unroll
            for (int m = 0; m < 4; ++m) { const unsigned p = pos0 + (unsigned)(ai * 128 + m * 16);
                const u32x2 en = en8[ai][m]; const float g = __uint_as_float(en.y); const unsigned drow = p < cnt ? en.x : (unsigned)(HALF_TOK * 4);
                bf16_t* rp = YB + (size_t)drow * 1024 + c8;
#pragma unroll
                for (int bj = 0; bj < 2; ++bj) *(u32x4*)(rp + bj * 32) = pack8((acc[ai][bj][m][0] * MOE_INV + bv[bj][0]) * g, (acc[ai][bj][m][1] * MOE_INV + bv[bj][1]) * g); }
    }
};

struct MapIdent { __device__ __forceinline__ int operator()(int n) const { return n; } };
struct MapWin { __device__ __forceinline__ int operator()(int n) const {
    if (n < 1024) return n;
    if (n < 1536) return 1152 + (n - 1024);
    if (n < 1792) { const int c = n - 1536; if (c < 128) return 1024 + c; if (c < 192) return 1664 + (c - 128); if (c < 200) return 1728 + (c - 192); if (c < 216) return 4808 + (c - 200); return -1; }
    if (n < 2816) return 1736 + (n - 1792);
    if (n < 4864) return 2760 + (n - 2816);
    if (n < 5888) return 4824 + (n - 4864);
    return 5848 + (n - 5888); } };
struct MapW1 { __device__ __forceinline__ int operator()(int r) const { const int j = r >> 8, rr = r & 255; return (rr >> 7) * 1024 + j * 128 + (rr & 127); } };
template <class Map, bool F8 = false> __device__ __forceinline__ void transpose_item(const float* W, int K, int N, bf16_t* WT, const Map& map, LAS float* scr, int kb, int nb, int lane, const float* rowscale) {
    const int k0 = 64 * kb, n0 = 64 * nb, q = lane & 15, kr = lane >> 4; const int src = map(n0 + 4 * q);
    f32x4 ld[16];
#pragma unroll
    for (int i = 0; i < 16; ++i) { const int kk = 4 * i + kr; ld[i] = (src >= 0) ? *(const f32x4*)(W + (size_t)(k0 + kk) * N + src) : (f32x4){0.f, 0.f, 0.f, 0.f}; }
#pragma unroll
    for (int i = 0; i < 16; ++i) { const int kk = 4 * i + kr; f32x4 v = ld[i]; if (rowscale) v = v * rowscale[k0 + kk]; LAS float* d = scr + kk * 65 + 4 * q; d[0] = v[0]; d[1] = v[1]; d[2] = v[2]; d[3] = v[3]; }
    LDS_WAIT(); asm volatile("" ::: "memory");
    const int c = lane & 7;
#pragma unroll
    for (int j = 0; j < 8; ++j) { const int n = (lane >> 3) + 8 * j; const LAS float* s = scr + (8 * c) * 65 + n;
        if constexpr (F8) { const f32x4 a = {s[0 * 65] * MOE_WSC, s[1 * 65] * MOE_WSC, s[2 * 65] * MOE_WSC, s[3 * 65] * MOE_WSC}, b = {s[4 * 65] * MOE_WSC, s[5 * 65] * MOE_WSC, s[6 * 65] * MOE_WSC, s[7 * 65] * MOE_WSC};
            *(u32x2*)((unsigned char*)WT + (size_t)(n0 + n) * K + k0 + 8 * c) = pack8_fp8(a, b); }
        else { u32x4 o; o.x = cvt_pk_bf16(s[0 * 65], s[1 * 65]); o.y = cvt_pk_bf16(s[2 * 65], s[3 * 65]); o.z = cvt_pk_bf16(s[4 * 65], s[5 * 65]); o.w = cvt_pk_bf16(s[6 * 65], s[7 * 65]);
            *(u32x4*)(WT + (size_t)(n0 + n) * K + k0 + 8 * c) = o; } }
    LDS_WAIT(); asm volatile("" ::: "memory");
}
struct TrItem { const float* W; const float* rowscale; unsigned char* WT; int N, src, k0, n0, f8; };
__device__ __forceinline__ TrItem tr_decode(Frame& F, int it) {
    constexpr int I_WIN = 16 * (NPROJ / 64), I_SQ = 16 * 16, I_W1E = 16 * 32, I_W2E = 16 * 16;
    TrItem d; d.rowscale = nullptr; int r = it, kb, nb; const int q4 = 4 * (F.lane & 15);
    if (r < I_WIN) { kb = r / (NPROJ / 64); nb = r % (NPROJ / 64);
        const int f8 = PROJ_FP8 && (nb < 16 || nb >= 76);
        d.W = F.a->in[4]; d.N = 6872; d.src = MapWin()(64 * nb + q4); d.WT = F.ws + (f8 ? WS_WIN8 : WS_WIN); d.f8 = f8; }
    else { r -= I_WIN;
        if (r < 3 * I_SQ) { const int w = r / I_SQ; r -= w * I_SQ; kb = r / 16; nb = r % 16; d.N = 1024; d.src = 64 * nb + q4;
            if (w == 0) { d.W = F.a->in[15]; d.WT = F.ws + (PA_FP8 ? WS_WPA8 : WS_WPA); d.f8 = PA_FP8; }
            else if (w == 1) { d.W = F.a->in[16]; d.WT = F.ws + (PB_FP8 ? WS_WPB8 : WS_WPB); d.f8 = PB_FP8; d.rowscale = F.a->in[14]; }
            else { d.W = F.a->in[17]; d.WT = F.ws + WS_WOUT; d.f8 = PO_FP8; } }
        else { r -= 3 * I_SQ;
            if (r < 32 * I_W1E) { const int e = r / I_W1E, q = r % I_W1E; kb = q / 32; nb = q % 32; d.W = F.a->in[22] + (size_t)e * 1024 * 2048; d.N = 2048; d.src = MapW1()(64 * nb + q4);
                d.WT = F.ws + WS_W1 + (size_t)e * 2048 * MOE_RB; d.f8 = MOE_FP8; }
            else { r -= 32 * I_W1E; const int e = r / I_W2E, q = r % I_W2E; kb = q / 16; nb = q % 16; d.W = F.a->in[24] + (size_t)e * 1024 * 1024; d.N = 1024; d.src = 64 * nb + q4;
                d.WT = F.ws + WS_W2 + (size_t)e * 1024 * MOE_RB; d.f8 = MOE_FP8; } } }
    d.k0 = 64 * kb; d.n0 = 64 * nb; return d; }
__device__ __forceinline__ void tr_load(const TrItem& d, f32x4 (&ld)[16], int lane) {
    const int kr = lane >> 4; const float* p = d.W + (size_t)(d.k0 + kr) * d.N + (d.src >= 0 ? d.src : 0);
#pragma unroll
    for (int i = 0; i < 16; ++i) ld[i] = __builtin_nontemporal_load((const f32x4*)(p + (size_t)(4 * i) * d.N)); }
__device__ __forceinline__ void tr_finish(const TrItem& d, f32x4 (&ld)[16], LAS float* scr, int lane) {
    const int q = lane & 15, kr = lane >> 4; const bool zero = d.src < 0;
#pragma unroll
    for (int i = 0; i < 16; ++i) { const int kk = 4 * i + kr; f32x4 v = ld[i]; if (zero) v = (f32x4){0.f, 0.f, 0.f, 0.f}; if (d.rowscale) v = v * d.rowscale[d.k0 + kk];
        LAS float* o = scr + kk * 65 + 4 * q; o[0] = v[0]; o[1] = v[1]; o[2] = v[2]; o[3] = v[3]; }
    LDS_WAIT(); asm volatile("" ::: "memory");
    const int c = lane & 7;
    if (d.f8) {
#pragma unroll
        for (int j = 0; j < 8; ++j) { const int n = (lane >> 3) + 8 * j; const LAS float* s = scr + (8 * c) * 65 + n;
            const f32x4 a = {s[0 * 65] * MOE_WSC, s[1 * 65] * MOE_WSC, s[2 * 65] * MOE_WSC, s[3 * 65] * MOE_WSC}, b = {s[4 * 65] * MOE_WSC, s[5 * 65] * MOE_WSC, s[6 * 65] * MOE_WSC, s[7 * 65] * MOE_WSC};
            *(u32x2*)((unsigned char*)d.WT + (size_t)(d.n0 + n) * 1024 + d.k0 + 8 * c) = pack8_fp8(a, b); } }
    else {
#pragma unroll
        for (int j = 0; j < 8; ++j) { const int n = (lane >> 3) + 8 * j; const LAS float* s = scr + (8 * c) * 65 + n;
            u32x4 o; o.x = cvt_pk_bf16(s[0 * 65], s[1 * 65]); o.y = cvt_pk_bf16(s[2 * 65], s[3 * 65]); o.z = cvt_pk_bf16(s[4 * 65], s[5 * 65]); o.w = cvt_pk_bf16(s[6 * 65], s[7 * 65]);
            *(u32x4*)((bf16_t*)d.WT + (size_t)(d.n0 + n) * 1024 + d.k0 + 8 * c) = o; } }
    LDS_WAIT(); asm volatile("" ::: "memory");
}
__device__ __forceinline__ void ph_prologue(Frame& F) {
    const float* c_in = F.a->in[1]; const float* w_mod = F.a->in[2]; const float* b_mod = F.a->in[3];
    float* MOD = (float*)(F.ws + WS_MOD);
#ifndef DBG_REPG
#define DBG_REPG 1
#endif
#pragma nounroll
    for (int rpg = 0; rpg < DBG_REPG; ++rpg)
    for (int item = F.bid; item < 192; item += F.G) {
        LAS float* SC = (LAS float*)F.lds;
        __syncthreads();
#pragma nounroll
        for (int jb = 0; jb < 4; ++jb) { float cv[16];
#pragma unroll
            for (int u = 0; u < 16; ++u) cv[u] = c_in[F.tid + NTHR * (jb * 16 + u)];
#pragma unroll
            for (int u = 0; u < 16; ++u) { const int i = F.tid + NTHR * (jb * 16 + u); SC[(i & 1023) * 36 + (i >> 10)] = silu_f(cv[u]); } }
        __syncthreads();
        const int col = item * 32 + (F.tid >> 4), kq = F.tid & 15;
        float a[32];
#pragma unroll
        for (int b = 0; b < 32; ++b) a[b] = 0.f;
#pragma nounroll
        for (int kg = 0; kg < 64; kg += 16) {
            float wv[16];
#pragma unroll
            for (int u = 0; u < 16; ++u) wv[u] = w_mod[(size_t)((kg + u) * 16 + kq) * 6144 + col];
#pragma unroll
            for (int u = 0; u < 16; ++u) { const int k = (kg + u) * 16 + kq; const float w = wv[u];
#pragma unroll
                for (int b4 = 0; b4 < 8; ++b4) { const f32x4 s = *(const LAS f32x4*)(SC + k * 36 + b4 * 4); a[b4 * 4 + 0] += w * s[0]; a[b4 * 4 + 1] += w * s[1]; a[b4 * 4 + 2] += w * s[2]; a[b4 * 4 + 3] += w * s[3]; } } }
#pragma unroll
        for (int b = 0; b < 32; ++b) { a[b] += __shfl_xor(a[b], 1); a[b] += __shfl_xor(a[b], 2); a[b] += __shfl_xor(a[b], 4); a[b] += __shfl_xor(a[b], 8); }
        { const float bm = b_mod[col];
#pragma unroll
            for (int b = 1; b < 16; ++b) { a[0] = (kq == b) ? a[b] : a[0]; a[16] = (kq == b) ? a[16 + b] : a[16]; }
            MOD[(size_t)kq * 6144 + col] = a[0] + bm; MOD[(size_t)(kq + 16) * 6144 + col] = a[16] + bm; }
        __syncthreads();
    }
    if (F.bid == (F.G > 192 ? 192 : 0)) {
        float* BT = (float*)(F.ws + WS_BIAST); const float* rel_bias = F.a->in[8];
        for (int i = F.tid; i < 249 * 8; i += NTHR) { const int idx = i >> 3, h = i & 7, rel = idx - 185; const int n = rel < 0 ? -rel : rel;
            const float nf = (float)(n > 1 ? n : 1); int large = 8 + (int)(logf(nf / 8.0f) / 2.7725887f * 8.0f); if (large > 15) large = 15;
            const int bucket = (rel > 0 ? 16 : 0) + (n < 8 ? n : large);
            BT[i] = rel_bias[bucket * 8 + h] * LOG2E; }
    }
    LAS float* scr = (LAS float*)(F.lds + F.wave * 16640);
    __syncthreads();
    const int rbid = F.G > 192 ? (F.bid >= 192 ? F.bid - 192 : F.bid + (F.G - 192)) : F.bid;
    const int gw = rbid * NWAVES + F.wave, NGW = F.G * NWAVES;
    constexpr int I_WIN = 16 * (NPROJ / 64), I_SQ = 16 * 16, I_W1E = 16 * 32, I_W2E = 16 * 16;
    constexpr int NITEMS = I_WIN + 3 * I_SQ + 32 * I_W1E + 32 * I_W2E;
    TrItem d0, d1; f32x4 la[16], lb[16];
    int it = gw;
    if (it < NITEMS) { d0 = tr_decode(F, it); tr_load(d0, la, F.lane); }
    while (it < NITEMS) {
        const int i1 = it + NGW; const bool v1 = i1 < NITEMS;
        if (v1) { d1 = tr_decode(F, i1); tr_load(d1, lb, F.lane); }
        tr_finish(d0, la, scr, F.lane);
        if (!v1) break;
        const int i2 = i1 + NGW; const bool v2 = i2 < NITEMS;
        if (v2) { d0 = tr_decode(F, i2); tr_load(d0, la, F.lane); }
        tr_finish(d1, lb, scr, F.lane);
        it = i2;
    }
}

__device__ __forceinline__ void ln1_load(const float* x, int m0, int lane, f32x4 (&v)[4][4]) {
#pragma unroll
    for (int r = 0; r < 4; ++r) { const f32x4* xr = (const f32x4*)(x + (size_t)(m0 + r) * D) + lane;
#pragma unroll
        for (int j = 0; j < 4; ++j) v[r][j] = __builtin_nontemporal_load(xr + 64 * j); } }
__device__ __forceinline__ void ln1_proc(Frame& F, bf16_t* U, int m0, f32x4 (&v)[4][4], const f32x4 (&sh)[4], const f32x4 (&sc)[4]) {
#pragma unroll
    for (int r = 0; r < 4; ++r) { const int m = m0 + r;
        float s = 0.f;
#pragma unroll
        for (int j = 0; j < 4; ++j) s += (v[r][j][0] + v[r][j][1]) + (v[r][j][2] + v[r][j][3]);
        const float mean = wave_sum(s) * (1.f / D); float s2 = 0.f;
#pragma unroll
        for (int j = 0; j < 4; ++j) { v[r][j] = v[r][j] - mean; s2 += (v[r][j][0] * v[r][j][0] + v[r][j][1] * v[r][j][1]) + (v[r][j][2] * v[r][j][2] + v[r][j][3] * v[r][j][3]); }
        const float rstd = 1.f / sqrtf(wave_sum(s2) * (1.f / D) + LN_EPS);
        u32x2* o8 = (u32x2*)(U + (size_t)m * D) + F.lane;
#pragma unroll
        for (int j = 0; j < 4; ++j) {
            const f32x4 rr = v[r][j] * rstd * (sc[j] + 1.0f) + sh[j]; u32x2 w; w.x = cvt_pk_bf16(rr[0], rr[1]); w.y = cvt_pk_bf16(rr[2], rr[3]); o8[64 * j] = w;
            if (PROJ_FP8) { int pk = 0; pk = __builtin_amdgcn_cvt_pk_fp8_f32(rr[0], rr[1], pk, false); pk = __builtin_amdgcn_cvt_pk_fp8_f32(rr[2], rr[3], pk, true); ((unsigned*)(F.ws + WS_U8 + (size_t)m * D))[F.lane + 64 * j] = (unsigned)pk; } } } }
__device__ __forceinline__ void ph_ln1(Frame& F) {
    const float* x = F.a->in[0]; const float* MOD = (const float*)(F.ws + WS_MOD); bf16_t* U = (bf16_t*)(F.outb + OUT_U);
    const int gw = F.bid * NWAVES + F.wave, NGW = F.G * NWAVES;
    const int RPW = (((NTOK + NGW - 1) / NGW) + 3) & ~3;
    const int mbeg = gw * RPW, mend = (mbeg + RPW < NTOK) ? mbeg + RPW : NTOK;
    if (mbeg >= mend) return;
    f32x4 va[4][4], vb[4][4], sh[4], sc[4]; int curb = -1;
#define LN1_MOD(m0) do { const int bb = (m0) >> 11; if (bb != curb) { curb = bb; const float* md = MOD + (size_t)bb * 6144; \
        _Pragma("unroll") for (int j = 0; j < 4; ++j) { sh[j] = *((const f32x4*)md + F.lane + 64 * j); sc[j] = *((const f32x4*)(md + 1024) + F.lane + 64 * j); } } } while (0)
    int m0 = mbeg;
    ln1_load(x, m0, F.lane, va);
    for (;;) {
        const int m1 = m0 + 4; const bool v1 = m1 < mend;
        LN1_MOD(m0); if (v1) ln1_load(x, m1, F.lane, vb);
        ln1_proc(F, U, m0, va, sh, sc);
        if (!v1) break;
        const int m2 = m1 + 4; const bool v2 = m2 < mend;
        LN1_MOD(m1); if (v2) ln1_load(x, m2, F.lane, va);
        ln1_proc(F, U, m1, vb, sh, sc);
        if (!v2) break;
        m0 = m2;
    }
#undef LN1_MOD
}

__device__ __forceinline__ void misc_load(const float* MISC, int m0, int l, f32x4 (&v)[8]) {
#pragma unroll
    for (int r = 0; r < 8; ++r) v[r] = __builtin_nontemporal_load((const f32x4*)(MISC + (size_t)(m0 + r) * 256) + l); }
__device__ __forceinline__ void misc_proc(Frame& F, int m0, const f32x4 (&vv)[8], const f32x4& w1, const f32x4& w2) {
    bf16_t* KV = (bf16_t*)(F.outb + OUT_KV); bf16_t* IK = (bf16_t*)(F.outb + OUT_IK); float* IW = (float*)(F.outb + OUT_IW); float* DT = (float*)(F.outb + OUT_DT);
    const int l = F.lane;
#pragma unroll
    for (int r = 0; r < 8; ++r) { const int m = m0 + r;
        const f32x4 v = vv[r];
        const float sq = v[0] * v[0] + v[1] * v[1] + v[2] * v[2] + v[3] * v[3], sm = (v[0] + v[1]) + (v[2] + v[3]);
        const float kvss = wave_sum(l < 32 ? sq : 0.f);
        const float iks = wave_sum((l >= 32 && l < 48) ? sm : 0.f);
        const float ikmean = iks * (1.f / 64.f);
        const f32x4 dv = v - ikmean;
        const float ikq = wave_sum((l >= 32 && l < 48) ? (dv[0] * dv[0] + dv[1] * dv[1] + dv[2] * dv[2] + dv[3] * dv[3]) : 0.f);
        if (l < 32) { const float rr = 1.f / sqrtf(kvss * (1.f / 128.f) + LN_EPS); const f32x4 o = v * rr * w1;
            u32x2 pk; pk.x = cvt_pk_bf16(o[0], o[1]); pk.y = cvt_pk_bf16(o[2], o[3]); *((u32x2*)(KV + (size_t)m * 128) + l) = pk; }
        else if (l < 48) { const float rr = 1.f / sqrtf(ikq * (1.f / 64.f) + LN_EPS); const f32x4 o = dv * rr * w1 + w2;
            u32x2 pk; pk.x = cvt_pk_bf16(o[0], o[1]); pk.y = cvt_pk_bf16(o[2], o[3]); *((u32x2*)(IK + (size_t)m * 64) + (l - 32)) = pk; }
        else if (l < 50) { *((f32x4*)(IW + (size_t)m * 8) + (l - 48)) = v * 0.35355339059327373f; }
        else if (l < 54) { f32x4 o;
#pragma unroll
            for (int j = 0; j < 4; ++j) { const float t = v[j] + w1[j]; o[j] = t > 20.f ? t : log1pf(__expf(t)); }
            *((f32x4*)(DT + (size_t)m * 16) + (l - 50)) = o; }
    } }
__device__ __forceinline__ void ph_misc(Frame& F) {
    const float* MISC = (const float*)(F.outb + OUT_MISC);
    const float* kvw = F.a->in[5]; const float* ikw = F.a->in[6]; const float* ikb = F.a->in[7]; const float* dtb = F.a->in[11];
    const int gw = F.bid * NWAVES + F.wave, NGW = F.G * NWAVES, l = F.lane;
    const int RPW = (((NTOK + NGW - 1) / NGW) + 7) & ~7;
    const int mbeg = gw * RPW, mend = (mbeg + RPW < NTOK) ? mbeg + RPW : NTOK;
    if (mbeg >= mend) return;
    f32x4 w1 = (f32x4){0.f, 0.f, 0.f, 0.f}, w2 = w1;
    if (l < 32) w1 = *((const f32x4*)kvw + l); else if (l < 48) { w1 = *((const f32x4*)ikw + (l - 32)); w2 = *((const f32x4*)ikb + (l - 32)); } else if (l >= 50 && l < 54) w1 = *((const f32x4*)dtb + (l - 50));
    f32x4 va[8], vb[8];
    int m0 = mbeg;
    misc_load(MISC, m0, l, va);
    for (;;) {
        const int m1 = m0 + 8; const bool v1 = m1 < mend;
        if (v1) misc_load(MISC, m1, l, vb);
        misc_proc(F, m0, va, w1, w2);
        if (!v1) break;
        const int m2 = m1 + 8; const bool v2 = m2 < mend;
        if (v2) misc_load(MISC, m2, l, va);
        misc_proc(F, m1, vb, w1, w2);
        if (!v2) break;
        m0 = m2;
    }
}

__device__ __forceinline__ unsigned sortable_key(float s) { const int u = __float_as_int(s + 0.0f); return (unsigned)(u ^ ((u >> 31) | (int)0x80000000)); }
template <int NKB> struct KeyRow { unsigned k[NKB]; };
__device__ __forceinline__ u64 low_bits_keep(u64 m, int t) { u64 out = 0; while (t-- > 0 && m) { const u64 b = m & (0 - m); out |= b; m ^= b; } return out; }
namespace idx { constexpr int KST = 144, KBUF = 64 * KST; }
__device__ __forceinline__ unsigned low_bits_keep32(unsigned m, int t) { unsigned out = 0; while (t-- > 0 && m) { const unsigned b = m & (0u - m); out |= b; m ^= b; } return out; }
template <int NG> __device__ __forceinline__ void topk2_select_write(const unsigned (&key)[64], int nkb, u64* mrow, int lane) {
    constexpr int NR = NG * 16;
    unsigned T0 = 0u, T1 = 0u; bool ex0 = false, ex1 = false;
    unsigned lo0 = 0u, lo1 = 0u, hi0 = 0xFFFFFFFFu, hi1 = 0xFFFFFFFFu, st0, st1, p0, p1; bool fin0 = false, fin1 = false;
    { float sm = 0.f, sq = 0.f;
#pragma unroll
        for (int m = 0; m < 10; ++m) { const unsigned k = key[m]; const float f = __uint_as_float((k & 0x80000000u) ? (k ^ 0x80000000u) : ~k); sm += f; sq += f * f; }
        sm = dpp_half_sums_f32(sm); sq = dpp_half_sums_f32(sq);
        const float mu = sm * (1.f / 320.f), sd = sqrtf(fmaxf(sq * (1.f / 320.f) - mu * mu, 1e-20f));
        const float qq = 256.f / (64.f * (float)nkb), pp = qq < 0.5f ? qq : 1.f - qq, tt = sqrtf(-2.f * __logf(pp));
        float z = tt - (2.515517f + 0.802853f * tt + 0.010328f * tt * tt) / (1.f + 1.432788f * tt + 0.189269f * tt * tt + 0.001308f * tt * tt * tt); if (qq >= 0.5f) z = -z;
        const unsigned pe = sortable_key(mu + z * sd), pd = sortable_key(mu + z * sd + 0.125f * sd);
        unsigned stp = pd - pe; if (stp < 1024u) stp = 1024u;
        p0 = __builtin_amdgcn_readlane((int)pe, 31); p1 = __builtin_amdgcn_readlane((int)pe, 63); st0 = __builtin_amdgcn_readlane((int)stp, 31); st1 = __builtin_amdgcn_readlane((int)stp, 63); }
#pragma nounroll
    for (int it = 0; it < 80; ++it) {
        const unsigned candv = lane < 32 ? p0 : p1;
        unsigned cl = 0u;
#pragma unroll
        for (int m = 0; m < NR; m += 4) { u64 s0, s1, s2, s3;
            asm("v_cmp_ge_u32_e64 %1, %5, %9\n\tv_cmp_ge_u32_e64 %2, %6, %9\n\tv_cmp_ge_u32_e64 %3, %7, %9\n\tv_cmp_ge_u32_e64 %4, %8, %9\n\t"
                "v_addc_co_u32_e64 %0, %1, 0, %0, %1\n\tv_addc_co_u32_e64 %0, %2, 0, %0, %2\n\tv_addc_co_u32_e64 %0, %3, 0, %0, %3\n\tv_addc_co_u32_e64 %0, %4, 0, %0, %4"
                : "+v"(cl), "=&s"(s0), "=&s"(s1), "=&s"(s2), "=&s"(s3) : "v"(key[m]), "v"(key[m + 1]), "v"(key[m + 2]), "v"(key[m + 3]), "v"(candv)); }
        cl = dpp_half_sums_u32(cl);
        const int n0 = __builtin_amdgcn_readlane((int)cl, 31), n1 = __builtin_amdgcn_readlane((int)cl, 63);
#define IDX_STEP(lo, hi, st, p, T, ex, fin, n) do { if (!fin) { \
            if (n == 256) { T = p; ex = true; fin = true; } \
            else { if (n > 256) lo = p; else hi = p; \
                if (hi - lo <= 1u) { T = lo; fin = true; } \
                else { unsigned c; if (hi == 0xFFFFFFFFu) { c = lo + st; if (c < lo) c = hi; st = st << 1; } else if (lo == 0u) { c = hi - st; if (c > hi) c = lo; st = st << 1; } else c = lo + ((hi - lo) >> 1); \
                    if (c <= lo || c >= hi) c = lo + ((hi - lo) >> 1); p = c; } } } } while (0)
        IDX_STEP(lo0, hi0, st0, p0, T0, ex0, fin0, n0);
        IDX_STEP(lo1, hi1, st1, p1, T1, ex1, fin1, n1);
#undef IDX_STEP
        if (fin0 && fin1) break;
    }
    const unsigned Tv = lane < 32 ? T0 : T1;
    if (ex0 && ex1) {
        unsigned mlo = 0u, mhi = 0u;
#pragma unroll
        for (int j = 0; j < NR / 2; ++j) {
            const u64 b0 = __ballot(key[2 * j] >= Tv), b1 = __ballot(key[2 * j + 1] >= Tv);
            asm volatile("s_nop 1\n\tv_writelane_b32 %0, %2, %6\n\tv_writelane_b32 %0, %3, %7\n\tv_writelane_b32 %1, %4, %6\n\tv_writelane_b32 %1, %5, %7"
                         : "+v"(mlo), "+v"(mhi) : "s"((unsigned)b0), "s"((unsigned)(b0 >> 32)), "s"((unsigned)b1), "s"((unsigned)(b1 >> 32)), "n"(j), "n"(32 + j));
            if ((j & 3) == 3) SBAR();
        }
        const int jl = lane & 31;
        if (jl < nkb) mrow[(lane >> 5) * 32 + jl] = (u64)mlo | ((u64)mhi << 32);
        return;
    }
    int rem0 = 1 << 30, rem1 = 1 << 30;
    { int g0 = 0, g1 = 0;
#pragma unroll
        for (int m = 0; m < NR; ++m) { const u64 mk = __ballot(key[m] > Tv); g0 += __builtin_popcount((unsigned)mk); g1 += __builtin_popcount((unsigned)(mk >> 32)); if ((m & 7) == 7) SBAR(); }
        if (!ex0) rem0 = 256 - g0; if (!ex1) rem1 = 256 - g1; }
    u64 mine = 0ull;
#pragma nounroll
    for (int jq = 0; jq < NR / 8; ++jq) {
#pragma unroll
        for (int jj = 0; jj < 4; ++jj) { const int j = jq * 4 + jj;
            unsigned w0[2], w1[2];
#pragma unroll
            for (int hh = 0; hh < 2; ++hh) { unsigned kv = 0u;
#pragma unroll
                for (int m = 0; m < NR; ++m) if ((m >> 3) == 0) {}
#pragma unroll
                for (int m = 0; m < NR; ++m) kv = (m == 2 * j + hh) ? key[m] : kv;
                const u64 gt = __ballot(kv > Tv), eq = __ballot(kv == Tv);
                { const unsigned e = (unsigned)eq, g = (unsigned)gt; const int ne = __builtin_popcount(e); unsigned sel = g; if (rem0 >= ne) { sel |= e; rem0 -= ne; } else if (rem0 > 0) { sel |= low_bits_keep32(e, rem0); rem0 = 0; } w0[hh] = sel; }
                { const unsigned e = (unsigned)(eq >> 32), g = (unsigned)(gt >> 32); const int ne = __builtin_popcount(e); unsigned sel = g; if (rem1 >= ne) { sel |= e; rem1 -= ne; } else if (rem1 > 0) { sel |= low_bits_keep32(e, rem1); rem1 = 0; } w1[hh] = sel; } }
            const u64 q0w = (u64)w0[0] | ((u64)w0[1] << 32), q1w = (u64)w1[0] | ((u64)w1[1] << 32);
            if (lane == j) mine = q0w; if (lane == 32 + j) mine = q1w; }
    }
    const int jl = lane & 31;
    if (jl < nkb) mrow[(lane >> 5) * 32 + jl] = mine;
}
template <int J0> __device__ __forceinline__ void index_scores8(unsigned (&key)[64], const bf16x8 (&af)[2], const f32x4& iw4, const bf16_t* kvsrc, char* lds, int nkb, u32x4 (&stg)[8], int tid) {
    const int lane = tid & 63, sub = lane & 15, kg = lane >> 4;
#pragma unroll
    for (int jj = 0; jj < 8; ++jj) {
        const int j = J0 + jj;
        if (j < nkb) {
            if (j + 1 < nkb) *(u32x4*)(lds + ((j + 1) & 1) * idx::KBUF + (tid >> 3) * idx::KST + (tid & 7) * 16) = stg[(jj + 1) & 7];
            if (j + 8 < nkb) stg[jj] = *(const u32x4*)(kvsrc + (size_t)(j + 8) * 64 * 64);
            const char* kb = lds + (j & 1) * idx::KBUF + sub * idx::KST + kg * 16;
#pragma unroll
            for (int pr = 0; pr < 2; ++pr) {
                f32x4 dA = (f32x4){0.f, 0.f, 0.f, 0.f}, dB = dA;
#pragma unroll
                for (int ks = 0; ks < 2; ++ks) {
                    const bf16x8 fA = *(const bf16x8*)(kb + (pr * 32) * idx::KST + ks * 64), fB = *(const bf16x8*)(kb + (pr * 32 + 16) * idx::KST + ks * 64);
                    dA = __builtin_amdgcn_mfma_f32_16x16x32_bf16(af[ks], fA, dA, 0, 0, 0); dB = __builtin_amdgcn_mfma_f32_16x16x32_bf16(af[ks], fB, dB, 0, 0, 0); }
                float pA = 0.f, pB = 0.f;
#pragma unroll
                for (int r = 0; r < 4; ++r) { pA += fmaxf(dA[r], 0.f) * iw4[r]; pB += fmaxf(dB[r], 0.f) * iw4[r]; }
                auto rr = __builtin_amdgcn_permlane16_swap(__float_as_uint(pA), __float_as_uint(pB), false, false);
                key[2 * j + pr] = sortable_key(__uint_as_float(rr[0]) + __uint_as_float(rr[1]));
            }
            __syncthreads();
        }
    }
}
__device__ __forceinline__ void ph_index(Frame& F, const int abl = 0) {
    const bf16_t* IQ = (const bf16_t*)(F.outb + OUT_IQ); const bf16_t* IK = (const bf16_t*)(F.outb + OUT_IK); const float* IW = (const float*)(F.outb + OUT_IW);
    u64* MASK = (u64*)(F.outb + OUT_MASK);
    LAS unsigned* SC = (LAS unsigned*)F.lds;
    const int tid = F.tid, lane = F.lane, sub = lane & 15, kg = lane >> 4, wid = F.wave;
    for (int item = F.bid; item < NTOK / 16; item += F.G) {
        const int tok0 = (((item & 255) >> 3) << 11) + (((item & 7) + 8 * (item >> 8)) << 4), tokw = tok0 + wid * 2, b = tok0 >> 11, pos0 = tok0 & 2047, nkb = (pos0 >> 6) + 1;
        u64* mrow = MASK + (size_t)tokw * 32;
        if (nkb <= 4) { if ((lane & 31) < nkb) mrow[(lane >> 5) * 32 + (lane & 31)] = ~0ull; continue; }
        {
            bf16x8 af[8][2]; f32x4 iw4[8];
#pragma unroll
            for (int qp = 0; qp < 8; ++qp) { const bf16_t* ap = IQ + (size_t)(tok0 + 2 * qp + (sub >> 3)) * 512 + (sub & 7) * 64 + kg * 8;
                af[qp][0] = *(const bf16x8*)ap; af[qp][1] = *(const bf16x8*)(ap + 32);
                iw4[qp] = *(const f32x4*)(IW + (size_t)(tok0 + 2 * qp + (lane >> 5)) * 8 + 4 * (kg & 1)); }
            const bf16_t* kbase = IK + ((size_t)b * SEQ + sub) * 64 + kg * 8;
            const int nu = 2 * nkb;
            bf16x8 fb[2][2], fn[2][2];
            if (wid < nu) {
#pragma unroll
                for (int gkey = 0; gkey < 2; ++gkey)
#pragma unroll
                    for (int ks = 0; ks < 2; ++ks) fb[gkey][ks] = *(const bf16x8*)(kbase + (size_t)(wid * 32 + gkey * 16) * 64 + ks * 32); }
#pragma nounroll
            for (int u = wid; u < nu; u += 8) {
                const int un = u + 8 < nu ? u + 8 : u;
#pragma unroll
                for (int gkey = 0; gkey < 2; ++gkey)
#pragma unroll
                    for (int ks = 0; ks < 2; ++ks) fn[gkey][ks] = *(const bf16x8*)(kbase + (size_t)(un * 32 + gkey * 16) * 64 + ks * 32);
#pragma unroll
                for (int qp = 0; qp < 8; ++qp) {
                    f32x4 dA = (f32x4){0.f, 0.f, 0.f, 0.f}, dB = dA;
#pragma unroll
                    for (int ks = 0; ks < 2; ++ks) { dA = __builtin_amdgcn_mfma_f32_16x16x32_bf16(af[qp][ks], fb[0][ks], dA, 0, 0, 0); dB = __builtin_amdgcn_mfma_f32_16x16x32_bf16(af[qp][ks], fb[1][ks], dB, 0, 0, 0); }
                    float pA = 0.f, pB = 0.f;
#pragma unroll
                    for (int r = 0; r < 4; ++r) {
                        const float ra = __int_as_float(max(__float_as_int(dA[r]), 0)), rb = __int_as_float(max(__float_as_int(dB[r]), 0));
                        pA = fmaf(ra, iw4[qp][r], pA); pB = fmaf(rb, iw4[qp][r], pB); }
                    auto rr = __builtin_amdgcn_permlane16_swap(__float_as_uint(pA), __float_as_uint(pB), false, false);
                    SC[(2 * qp + (lane >> 5)) * 2048 + u * 32 + (lane & 31)] = sortable_key(__uint_as_float(rr[0]) + __uint_as_float(rr[1]));
                }
#pragma unroll
                for (int gkey = 0; gkey < 2; ++gkey)
#pragma unroll
                    for (int ks = 0; ks < 2; ++ks) fb[gkey][ks] = fn[gkey][ks];
            }
        }
        __syncthreads();
        unsigned key[64];
#pragma unroll
        for (int m = 0; m < 64; ++m) key[m] = (m < 2 * nkb) ? SC[(2 * wid + (lane >> 5)) * 2048 + m * 32 + (lane & 31)] : 0u;
        __syncthreads();
        const int ng = (nkb + 7) >> 3;
        if (ng == 1) topk2_select_write<1>(key, nkb, mrow, lane);
        else if (ng == 2) topk2_select_write<2>(key, nkb, mrow, lane);
        else if (ng == 3) topk2_select_write<3>(key, nkb, mrow, lane);
        else topk2_select_write<4>(key, nkb, mrow, lane);
    }
}

namespace att {
constexpr int KVBLK = 64;
constexpr int SHM_V = KVBLK * 128 * 2, SHM_K = SHM_V;
constexpr int OFF_V = 0, OFF_K = 2 * SHM_V, OFF_WS = 2 * SHM_V + 2 * SHM_K, OFF_BT = OFF_WS + NWAVES * 64 * 4;
constexpr int OFF_OT = 81920, OT_ST = 144;
#define KSWZ(row, colB) ((row) * 256 + ((colB) ^ (((row) & 7) << 4)))
__device__ __forceinline__ int crow(int r, int hi) { return (r & 3) + 8 * (r >> 2) + 4 * hi; }
__device__ __forceinline__ int v_st(int k, int c) { const int kk = (k & ~0xC) | ((k & 4) << 1) | ((k & 8) >> 1); return ((kk >> 3) * 4 + (c >> 5)) * 512 + ((kk & 7) * 32 + (c & 31)) * 2; }
__device__ __forceinline__ int v_rd_base(int lane) { return ((lane & 3) << 3) | (((lane >> 2) & 3) << 6) | (((lane >> 4) & 1) << 5) | (((lane >> 5) & 1) << 8); }
constexpr int v_rd_off(int d0, int ks, int half) { return d0 * 512 + ks * 4096 + half * 2048; }
template <int OFF> __device__ __forceinline__ s16x4 tr_read(int vb) { s16x4 r; asm volatile("ds_read_b64_tr_b16 %0, %1 offset:%2" : "=&v"(r) : "v"(vb), "i"(OFF) : "memory"); return r; }
template <int D0> __device__ __forceinline__ void pv_one(f32x16& od, int vb, bf16x8 pa0, bf16x8 pa1, bf16x8 pa2, bf16x8 pa3) {
    const s16x4 l0 = tr_read<v_rd_off(D0, 0, 0)>(vb), h0 = tr_read<v_rd_off(D0, 0, 1)>(vb), l1 = tr_read<v_rd_off(D0, 1, 0)>(vb), h1 = tr_read<v_rd_off(D0, 1, 1)>(vb);
    const s16x4 l2 = tr_read<v_rd_off(D0, 2, 0)>(vb), h2 = tr_read<v_rd_off(D0, 2, 1)>(vb), l3 = tr_read<v_rd_off(D0, 3, 0)>(vb), h3 = tr_read<v_rd_off(D0, 3, 1)>(vb);
    asm volatile("s_waitcnt lgkmcnt(0)" ::: "memory"); SBAR();
#define PK(L, H) (bf16x8){L[0], L[1], L[2], L[3], H[0], H[1], H[2], H[3]}
    od = __builtin_amdgcn_mfma_f32_32x32x16_bf16(pa0, PK(l0, h0), od, 0, 0, 0);
    od = __builtin_amdgcn_mfma_f32_32x32x16_bf16(pa1, PK(l1, h1), od, 0, 0, 0);
    od = __builtin_amdgcn_mfma_f32_32x32x16_bf16(pa2, PK(l2, h2), od, 0, 0, 0);
    od = __builtin_amdgcn_mfma_f32_32x32x16_bf16(pa3, PK(l3, h3), od, 0, 0, 0);
#undef PK
}
__device__ __forceinline__ void qkt(f32x16& p0, f32x16& p1, const char* Ks, const bf16x8* qr, int r32, int hi) {
    p0 = f32x16{}; p1 = f32x16{};
    int rv = r32; asm volatile("" : "+v"(rv));
    const char* kb = Ks + rv * 256; const int swz = ((rv & 7) << 4) ^ (hi * 16);
#pragma unroll
    for (int d0 = 0; d0 < 8; ++d0) { const char* ka = kb + ((d0 * 32) ^ swz);
        const bf16x8 b0 = *reinterpret_cast<const bf16x8*>(ka);
        const bf16x8 b1 = *reinterpret_cast<const bf16x8*>(ka + 8192);
        p0 = __builtin_amdgcn_mfma_f32_32x32x16_bf16(b0, qr[d0], p0, 0, 0, 0);
        p1 = __builtin_amdgcn_mfma_f32_32x32x16_bf16(b1, qr[d0], p1, 0, 0, 0); }
}
__device__ __forceinline__ void attn_item(Frame& F, int b, int q0, char* lds) {
    const bf16_t* Q = (const bf16_t*)(F.ws + WS_Q); const bf16_t* KV = (const bf16_t*)(F.outb + OUT_KV); const u64* MASK = (const u64*)(F.outb + OUT_MASK);
    bf16_t* OA = (bf16_t*)(F.outb + OUT_OA);
    int tid = F.tid; asm volatile("" : "+v"(tid));
    const int wid = F.wave, lane = tid & 63, r32 = lane & 31, hi = lane >> 5;
    char* V_lds = lds + OFF_V; char* K_lds = lds + OFF_K;
    float* wsl = (float*)(lds + OFF_WS) + wid * 64; float* li_l = wsl; float* al_l = wsl + 32;
    const float* btab = (const float*)(lds + OFF_BT);
    constexpr float C = 0.088388347648318440f * LOG2E;
    float m_reg = -1e30f, l_reg = 0.f; f32x16 o[4] = {}; bf16x8 qr[8];
    const size_t tokq = (size_t)b * SEQ + q0 + r32;
    { const bf16_t* Qw = Q + tokq * 1024 + wid * 128 + hi * 8;
#pragma unroll
      for (int d0 = 0; d0 < 8; ++d0) qr[d0] = *(const bf16x8*)(Qw + d0 * 16); }
    const u64* mq = MASK + tokq * 32;
    const int sr = tid >> 4, sc = (tid & 15) * 8;
    const int vb0 = (int)(uintptr_t)V_lds + v_rd_base(lane);
    const bf16_t* Kb = KV + (size_t)b * SEQ * 128;
    const int NT = (q0 >> 6) + 1;
    const float bfar = btab[wid];
    bf16x8 s0, s1;
#define SLOAD(k0) do { s0 = *(const bf16x8*)(Kb + (size_t)((k0) + sr) * 128 + sc); s1 = *(const bf16x8*)(Kb + (size_t)((k0) + 32 + sr) * 128 + sc); } while (0)
#define SWRITE(bf) do { int srv = sr; asm volatile("" : "+v"(srv)); const int kc = sc * 2; const int v0a = v_st(srv, sc), k0a = KSWZ(srv, kc); \
        *(bf16x8*)(V_lds + (bf) * SHM_V + v0a) = s0; *(bf16x8*)(V_lds + (bf) * SHM_V + v0a + 8192) = s1; \
        *(bf16x8*)(K_lds + (bf) * SHM_K + k0a) = s0; *(bf16x8*)(K_lds + (bf) * SHM_K + k0a + 8192) = s1; } while (0)
    __syncthreads();
    SLOAD(0); VM_WAIT(); SWRITE(0); __syncthreads();
    u64 mw_next = mq[0];
    for (int j = 0; j < NT; ++j) {
        int lanel = lane; asm volatile("" : "+v"(lanel)); const int r32l = lanel & 31, hil = lanel >> 5;
        const int bf = j & 1;
        if (j + 1 < NT) SLOAD((j + 1) * KVBLK);
        const u64 mw = mw_next; if (j + 1 < NT) mw_next = mq[j + 1];
        f32x16 p0, p1;
        qkt(p0, p1, K_lds + bf * SHM_K, qr, r32l, hil);
        const unsigned w0 = (unsigned)(mw >> (4 * hil)), w1 = (unsigned)(mw >> (32 + 4 * hil));
        const int relmax = j * KVBLK + 63 - q0;
        float alpha = 1.f, ps = 0.f;
        if (relmax <= -91) {
            float pmax = p0[0];
#pragma unroll
            for (int r = 1; r < 16; ++r) pmax = fmaxf(pmax, p0[r]);
#pragma unroll
            for (int r = 0; r < 16; ++r) pmax = fmaxf(pmax, p1[r]);
            { auto rr = __builtin_amdgcn_permlane32_swap(__float_as_uint(pmax), __float_as_uint(pmax), false, false); pmax = fmaxf(__uint_as_float(rr[0]), __uint_as_float(rr[1])); }
            pmax = fmaf(pmax, C, bfar);
            if (!__all(pmax - m_reg <= 11.0f)) { const float mn = fmaxf(m_reg, pmax); alpha = __builtin_amdgcn_exp2f(m_reg - mn); m_reg = mn; }
            const float off = bfar - m_reg;
#pragma unroll
            for (int r = 0; r < 16; ++r) { const int cb = (r & 3) + 8 * (r >> 2);
                const float e0 = __builtin_amdgcn_exp2f(fmaf(p0[r], C, off)), e1 = __builtin_amdgcn_exp2f(fmaf(p1[r], C, off));
                p0[r] = __uint_as_float(__float_as_uint(e0) & (unsigned)__builtin_amdgcn_sbfe((int)w0, cb, 1)); p1[r] = __uint_as_float(__float_as_uint(e1) & (unsigned)__builtin_amdgcn_sbfe((int)w1, cb, 1)); ps += p0[r] + p1[r]; }
        } else {
            const float* bp = btab + (j * KVBLK + 4 * hil - (q0 + r32l) + 185) * 8 + wid;
#pragma unroll
            for (int r4 = 0; r4 < 4; ++r4) {
#pragma unroll
                for (int rr = 0; rr < 4; ++rr) { const int r = r4 * 4 + rr; const int cb = (r & 3) + 8 * (r >> 2); p0[r] = fmaf(p0[r], C, bp[cb * 8]); p1[r] = fmaf(p1[r], C, bp[(cb + 32) * 8]); }
                SBAR(); }
            float pmax = p0[0];
#pragma unroll
            for (int r = 1; r < 16; ++r) pmax = fmaxf(pmax, p0[r]);
#pragma unroll
            for (int r = 0; r < 16; ++r) pmax = fmaxf(pmax, p1[r]);
            { auto rr = __builtin_amdgcn_permlane32_swap(__float_as_uint(pmax), __float_as_uint(pmax), false, false); pmax = fmaxf(__uint_as_float(rr[0]), __uint_as_float(rr[1])); }
            if (!__all(pmax - m_reg <= 11.0f)) { const float mn = fmaxf(m_reg, pmax); alpha = __builtin_amdgcn_exp2f(m_reg - mn); m_reg = mn; }
#pragma unroll
            for (int r = 0; r < 16; ++r) { const int cb = (r & 3) + 8 * (r >> 2);
                const float e0 = __builtin_amdgcn_exp2f(p0[r] - m_reg), e1 = __builtin_amdgcn_exp2f(p1[r] - m_reg);
                p0[r] = __uint_as_float(__float_as_uint(e0) & (unsigned)__builtin_amdgcn_sbfe((int)w0, cb, 1)); p1[r] = __uint_as_float(__float_as_uint(e1) & (unsigned)__builtin_amdgcn_sbfe((int)w1, cb, 1)); ps += p0[r] + p1[r]; }
        }
        { auto rr = __builtin_amdgcn_permlane32_swap(__float_as_uint(ps), __float_as_uint(ps), false, false); ps = __uint_as_float(rr[0]) + __uint_as_float(rr[1]); }
        l_reg = l_reg * alpha + ps;
        bf16x8 pa0, pa1, pa2, pa3;
#define PK4(P, BASE, OUT) do { unsigned a0 = cvt_pk_bf16(P[BASE + 0], P[BASE + 1]), a1 = cvt_pk_bf16(P[BASE + 2], P[BASE + 3]);   \
    unsigned b0 = cvt_pk_bf16(P[BASE + 4], P[BASE + 5]), b1 = cvt_pk_bf16(P[BASE + 6], P[BASE + 7]);                              \
    auto r0 = __builtin_amdgcn_permlane32_swap(a0, b0, false, false); auto r1 = __builtin_amdgcn_permlane32_swap(a1, b1, false, false); \
    u32x4 w = {r0[0], r1[0], r0[1], r1[1]}; OUT = *reinterpret_cast<bf16x8*>(&w); } while (0)
        PK4(p0, 0, pa0); PK4(p0, 8, pa1); PK4(p1, 0, pa2); PK4(p1, 8, pa3);
#undef PK4
        if (__any(alpha < 1.f)) { if (hil == 0) al_l[r32l] = alpha; LDS_WAIT();
#pragma unroll
            for (int d = 0; d < 4; ++d)
#pragma unroll
                for (int r = 0; r < 16; ++r) o[d][r] *= al_l[crow(r, hil)]; }
        const int vb = (int)(uintptr_t)V_lds + v_rd_base(lanel) + bf * SHM_V;
        pv_one<0>(o[0], vb, pa0, pa1, pa2, pa3); pv_one<1>(o[1], vb, pa0, pa1, pa2, pa3); pv_one<2>(o[2], vb, pa0, pa1, pa2, pa3); pv_one<3>(o[3], vb, pa0, pa1, pa2, pa3);
        if (j + 1 < NT) { VM_WAIT(); SWRITE(bf ^ 1); }
        __syncthreads();
    }
#undef SLOAD
#undef SWRITE
    if (hi == 0) li_l[r32] = l_reg; LDS_WAIT();
    bf16_t* Ow = OA + ((size_t)b * SEQ + q0 + 4 * hi) * 1024 + wid * 128 + r32;
    const float* lip = li_l + 4 * hi;
    unsigned char* Ow8 = (unsigned char*)OA + ((size_t)b * SEQ + q0 + 4 * hi) * 1024 + wid * 128 + r32;
    asm volatile("" : "+v"(Ow), "+v"(lip), "+v"(Ow8));
#pragma unroll
    for (int r = 0; r < 16; ++r) { const int ro = (r & 3) + 8 * (r >> 2); if ((r & 3) == 0) asm volatile("" : "+v"(Ow), "+v"(Ow8), "+v"(lip)); const float rl = fast_rcp(lip[ro]);
#pragma unroll
        for (int d0 = 0; d0 < 4; ++d0) { float v = o[d0][r] * rl; if ((DBG_ATTN_ZERO == 1 && q0 < 256) || (DBG_ATTN_ZERO == 2 && q0 >= 256)) v = 0.f;
            if (PA_FP8) ((unsigned char*)Ow8)[ro * 1024 + d0 * 32] = (unsigned char)(__builtin_amdgcn_cvt_pk_fp8_f32(v, v, 0, false) & 0xff);
            else Ow[ro * 1024 + d0 * 32] = (bf16_t)(cvt_pk_bf16(v, v) & 0xffffu); }
        if ((r & 3) == 3) SBAR(); }
}
__device__ __forceinline__ void att2_partial(f32x16& p0, f32x16& p1, float& m_reg, float& alpha, unsigned w0, bool far, float bfar, const float* bp) {
    constexpr float C = 0.088388347648318440f * LOG2E;
    float off;
    if (far) {
        float pmax = p0[0];
#pragma unroll
        for (int r = 1; r < 16; ++r) pmax = fmaxf(pmax, p0[r]);
#pragma unroll
        for (int r = 0; r < 16; ++r) pmax = fmaxf(pmax, p1[r]);
        { auto rr = __builtin_amdgcn_permlane32_swap(__float_as_uint(pmax), __float_as_uint(pmax), false, false); pmax = fmaxf(__uint_as_float(rr[0]), __uint_as_float(rr[1])); }
        pmax = fmaf(pmax, C, bfar);
        if (__builtin_expect(__all(pmax - m_reg <= 11.0f), 1)) alpha = 1.f; else { const float mn = fmaxf(m_reg, pmax); alpha = __builtin_amdgcn_exp2f(m_reg - mn); m_reg = mn; }
        off = bfar - m_reg;
#pragma unroll
        for (int r = 0; r < 16; ++r) { p0[r] = fmaf(p0[r], C, off); p1[r] = fmaf(p1[r], C, off); }
    } else {
#pragma unroll
        for (int r4 = 0; r4 < 4; ++r4) {
#pragma unroll
            for (int rr = 0; rr < 4; ++rr) { const int r = r4 * 4 + rr; const int cb = (r & 3) + 8 * (r >> 2); p0[r] = fmaf(p0[r], C, bp[cb * 8]); p1[r] = fmaf(p1[r], C, bp[(cb + 32) * 8]); }
            SBAR(); }
        float pmax = p0[0];
#pragma unroll
        for (int r = 1; r < 16; ++r) pmax = fmaxf(pmax, p0[r]);
#pragma unroll
        for (int r = 0; r < 16; ++r) pmax = fmaxf(pmax, p1[r]);
        { auto rr = __builtin_amdgcn_permlane32_swap(__float_as_uint(pmax), __float_as_uint(pmax), false, false); pmax = fmaxf(__uint_as_float(rr[0]), __uint_as_float(rr[1])); }
        if (__builtin_expect(__all(pmax - m_reg <= 11.0f), 1)) alpha = 1.f; else { const float mn = fmaxf(m_reg, pmax); alpha = __builtin_amdgcn_exp2f(m_reg - mn); m_reg = mn; }
#pragma unroll
        for (int r = 0; r < 16; ++r) { p0[r] -= m_reg; p1[r] -= m_reg; }
    }
#define SELP(P, W, R, CB) { unsigned m_; asm("v_bfe_i32 %0, %1, " #CB ", 1" : "=v"(m_) : "v"(W)); P[R] = __uint_as_float(__float_as_uint(__builtin_amdgcn_exp2f(P[R])) & m_); }
    SELP(p0, w0, 0, 0) SELP(p0, w0, 1, 1) SELP(p0, w0, 2, 2) SELP(p0, w0, 3, 3) SELP(p0, w0, 4, 8) SELP(p0, w0, 5, 9) SELP(p0, w0, 6, 10) SELP(p0, w0, 7, 11)
    SELP(p0, w0, 8, 16) SELP(p0, w0, 9, 17) SELP(p0, w0, 10, 18) SELP(p0, w0, 11, 19) SELP(p0, w0, 12, 24) SELP(p0, w0, 13, 25) SELP(p0, w0, 14, 26) SELP(p0, w0, 15, 27)
}
__device__ __forceinline__ void att2_finish(f32x16& p0, f32x16& p1, float alpha, float& l_reg, unsigned w1, bf16x8& pa0, bf16x8& pa1, bf16x8& pa2, bf16x8& pa3) {
    SELP(p1, w1, 0, 0) SELP(p1, w1, 1, 1) SELP(p1, w1, 2, 2) SELP(p1, w1, 3, 3) SELP(p1, w1, 4, 8) SELP(p1, w1, 5, 9) SELP(p1, w1, 6, 10) SELP(p1, w1, 7, 11)
    SELP(p1, w1, 8, 16) SELP(p1, w1, 9, 17) SELP(p1, w1, 10, 18) SELP(p1, w1, 11, 19) SELP(p1, w1, 12, 24) SELP(p1, w1, 13, 25) SELP(p1, w1, 14, 26) SELP(p1, w1, 15, 27)
    float ps = 0.f;
#pragma unroll
    for (int r = 0; r < 16; ++r) ps += p0[r];
#pragma unroll
    for (int r = 0; r < 16; ++r) ps += p1[r];
    { auto rr = __builtin_amdgcn_permlane32_swap(__float_as_uint(ps), __float_as_uint(ps), false, false); ps = __uint_as_float(rr[0]) + __uint_as_float(rr[1]); }
    l_reg = l_reg * alpha + ps;
#define PK4(P, BASE, OUT) do { unsigned a0 = cvt_pk_bf16(P[BASE + 0], P[BASE + 1]), a1 = cvt_pk_bf16(P[BASE + 2], P[BASE + 3]);   \
    unsigned b0 = cvt_pk_bf16(P[BASE + 4], P[BASE + 5]), b1 = cvt_pk_bf16(P[BASE + 6], P[BASE + 7]);                              \
    auto r0 = __builtin_amdgcn_permlane32_swap(a0, b0, false, false); auto r1 = __builtin_amdgcn_permlane32_swap(a1, b1, false, false); \
    u32x4 w = {r0[0], r1[0], r0[1], r1[1]}; OUT = *reinterpret_cast<bf16x8*>(&w); } while (0)
    PK4(p0, 0, pa0); PK4(p0, 8, pa1); PK4(p1, 0, pa2); PK4(p1, 8, pa3);
#undef PK4
}
__device__ __forceinline__ void attn_item2(Frame& F, int b, int q0, char* lds) {
    const bf16_t* Q = (const bf16_t*)(F.ws + WS_Q); const bf16_t* KV = (const bf16_t*)(F.outb + OUT_KV); const u64* MASK = (const u64*)(F.outb + OUT_MASK);
    bf16_t* OA = (bf16_t*)(F.outb + OUT_OA);
    int tid = F.tid; asm volatile("" : "+v"(tid));
    const int wid = F.wave, lane = tid & 63, r32 = lane & 31, hi = lane >> 5;
    char* V_lds = lds + OFF_V; char* K_lds = lds + OFF_K;
    float* wsl = (float*)(lds + OFF_WS) + wid * 64; float* li_l = wsl; float* al_l = wsl + 32;
    const float* btab = (const float*)(lds + OFF_BT);
    float m_reg = -1e30f, l_reg = 0.f; f32x16 o[4] = {}; bf16x8 qr[8];
    const size_t tokq = (size_t)b * SEQ + q0 + r32;
    { const bf16_t* Qw = Q + tokq * 1024 + wid * 128 + hi * 8;
#pragma unroll
      for (int d0 = 0; d0 < 8; ++d0) qr[d0] = *(const bf16x8*)(Qw + d0 * 16); }
    const u64* mq = MASK + tokq * 32;
    const int sr = tid >> 4, sc = (tid & 15) * 8;
    const bf16_t* Kb = KV + (size_t)b * SEQ * 128;
    const int NTr = (q0 >> 6) + 1, NT = (NTr + 1) & ~1;
    const float bfar = btab[wid];
    bf16x8 sA0, sA1, sB0, sB1;
#define SLD(s0_, s1_, k0) do { int srl = sr; asm volatile("" : "+v"(srl)); const bf16_t* kp_ = Kb + (size_t)((k0) + srl) * 128 + sc; s0_ = *(const bf16x8*)kp_; s1_ = *(const bf16x8*)(kp_ + 32 * 128); } while (0)
#define SWR(bf, s0_, s1_) do { int srv = sr; asm volatile("" : "+v"(srv)); const int kc = sc * 2; const int v0a = v_st(srv, sc), k0a = KSWZ(srv, kc); \
        *(bf16x8*)(V_lds + (bf) * SHM_V + v0a) = s0_; *(bf16x8*)(V_lds + (bf) * SHM_V + v0a + 8192) = s1_; \
        *(bf16x8*)(K_lds + (bf) * SHM_K + k0a) = s0_; *(bf16x8*)(K_lds + (bf) * SHM_K + k0a + 8192) = s1_; } while (0)
#define MWORD(j) ((j) < NTr ? mq[j] : 0ull)
#define RESC(a) do { if (__any((a) < 1.f)) { if (hi == 0) al_l[r32] = (a); LDS_WAIT(); \
        _Pragma("unroll") for (int d = 0; d < 4; ++d) _Pragma("unroll") for (int r = 0; r < 16; ++r) o[d][r] *= al_l[crow(r, hi)]; } } while (0)
#define PVALL(bf) do { int ll = lane; asm volatile("" : "+v"(ll)); const int vb = (int)(uintptr_t)V_lds + v_rd_base(ll) + (bf) * SHM_V; \
        pv_one<0>(o[0], vb, pa0, pa1, pa2, pa3); pv_one<1>(o[1], vb, pa0, pa1, pa2, pa3); pv_one<2>(o[2], vb, pa0, pa1, pa2, pa3); pv_one<3>(o[3], vb, pa0, pa1, pa2, pa3); } while (0)
#define ISFAR(jt) ((jt) * KVBLK + 63 - q0 <= -91 || (jt) >= NTr)
#define BPTR(jt) (btab + ((jt) * KVBLK + 4 * hi - (q0 + r32) + 185) * 8 + wid)
    f32x16 pA0, pA1, pB0, pB1; float alA, alB; bf16x8 pa0, pa1, pa2, pa3; u64 mwA, mwB;
    __syncthreads();
    SLD(sA0, sA1, 0); mwA = MWORD(0); VM_WAIT(); SWR(0, sA0, sA1); __syncthreads();
    qkt(pA0, pA1, K_lds, qr, r32, hi);
    att2_partial(pA0, pA1, m_reg, alA, (unsigned)(mwA >> (4 * hi)), ISFAR(0), bfar, BPTR(0));
    SLD(sB0, sB1, KVBLK); mwB = MWORD(1); if (2 < NT) SLD(sA0, sA1, 2 * KVBLK);
    SWR(1, sB0, sB1); __syncthreads();
    for (int j = 1; j + 1 < NT; j += 2) {
        SBAR(); qkt(pB0, pB1, K_lds + SHM_K, qr, r32, hi);
        att2_finish(pA0, pA1, alA, l_reg, (unsigned)(mwA >> (32 + 4 * hi)), pa0, pa1, pa2, pa3); SBAR();
        SLD(sB0, sB1, (j + 2) * KVBLK); mwA = MWORD(j + 1); SBAR();
        PVALL(0);
        att2_partial(pB0, pB1, m_reg, alB, (unsigned)(mwB >> (4 * hi)), ISFAR(j), bfar, BPTR(j));
        __syncthreads(); SWR(0, sA0, sA1);
        RESC(alB); __syncthreads();
        SBAR(); qkt(pA0, pA1, K_lds, qr, r32, hi);
        att2_finish(pB0, pB1, alB, l_reg, (unsigned)(mwB >> (32 + 4 * hi)), pa0, pa1, pa2, pa3); SBAR();
        if (j + 3 < NT) SLD(sA0, sA1, (j + 3) * KVBLK); mwB = MWORD(j + 2); SBAR();
        PVALL(1);
        att2_partial(pA0, pA1, m_reg, alA, (unsigned)(mwA >> (4 * hi)), ISFAR(j + 1), bfar, BPTR(j + 1));
        __syncthreads(); SWR(1, sB0, sB1);
        RESC(alA); __syncthreads();
    }
    SBAR(); qkt(pB0, pB1, K_lds + SHM_K, qr, r32, hi);
    att2_finish(pA0, pA1, alA, l_reg, (unsigned)(mwA >> (32 + 4 * hi)), pa0, pa1, pa2, pa3); SBAR();
    PVALL(0);
    att2_partial(pB0, pB1, m_reg, alB, (unsigned)(mwB >> (4 * hi)), ISFAR(NT - 1), bfar, BPTR(NT - 1));
    __syncthreads(); RESC(alB);
    att2_finish(pB0, pB1, alB, l_reg, (unsigned)(mwB >> (32 + 4 * hi)), pa0, pa1, pa2, pa3); SBAR();
    PVALL(1);
#undef SLD
#undef SWR
#undef MWORD
#undef RESC
#undef PVALL
#undef ISFAR
#undef BPTR
    LAS float* li_s = (LAS float*)(F.lds + OFF_WS) + wid * 64;
    if (hi == 0) li_s[r32] = l_reg; LDS_WAIT();
    if (PA_FP8 && ATT_OT) {
        LAS unsigned char* ot = F.lds + OFF_OT + wid * (32 * OT_ST);
        int ob = (4 * hi) * OT_ST + r32, lo = 4 * hi; asm volatile("" : "+v"(ob), "+v"(lo));
#pragma unroll
        for (int r = 0; r < 16; ++r) { const int ro = (r & 3) + 8 * (r >> 2); if ((r & 3) == 0) asm volatile("" : "+v"(ob), "+v"(lo)); const float rl = fast_rcp(li_s[lo + ro]);
#pragma unroll
            for (int d0 = 0; d0 < 4; ++d0) { const float v = o[d0][r] * rl; ot[ob + ro * OT_ST + d0 * 32] = (unsigned char)(__builtin_amdgcn_cvt_pk_fp8_f32(v, v, 0, false) & 0xff); }
            if ((r & 3) == 3) SBAR(); }
        LDS_WAIT(); asm volatile("" ::: "memory");
        unsigned char* Og = (unsigned char*)OA + ((size_t)b * SEQ + q0) * 1024 + wid * 128;
        int rr = lane >> 3, sg = (lane & 7) * 16; asm volatile("" : "+v"(rr), "+v"(sg));
#pragma unroll
        for (int i = 0; i < 4; ++i) { const u32x4 w = *(const LAS u32x4*)(ot + (i * 8 + rr) * OT_ST + sg); *(u32x4*)(Og + (size_t)(i * 8 + rr) * 1024 + sg) = w; }
        LDS_WAIT();
    } else if (PA_FP8) {
        GAS unsigned char* Ow8 = (GAS unsigned char*)((unsigned char*)OA + ((size_t)b * SEQ + q0 + 4 * hi) * 1024 + wid * 128 + r32);
        int lo = 4 * hi; asm volatile("" : "+v"(Ow8), "+v"(lo));
#pragma unroll
        for (int r = 0; r < 16; ++r) { const int ro = (r & 3) + 8 * (r >> 2); if ((r & 3) == 0) asm volatile("" : "+v"(Ow8), "+v"(lo)); const float rl = fast_rcp(li_s[lo + ro]);
#pragma unroll
            for (int d0 = 0; d0 < 4; ++d0) { const float v = o[d0][r] * rl; Ow8[ro * 1024 + d0 * 32] = (unsigned char)(__builtin_amdgcn_cvt_pk_fp8_f32(v, v, 0, false) & 0xff); }
            if ((r & 3) == 3) SBAR(); }
    } else {
        bf16_t* Ow = OA + ((size_t)b * SEQ + q0 + 4 * hi) * 1024 + wid * 128 + r32;
        int lo = 4 * hi; asm volatile("" : "+v"(Ow), "+v"(lo));
#pragma unroll
        for (int r = 0; r < 16; ++r) { const int ro = (r & 3) + 8 * (r >> 2); if ((r & 3) == 0) asm volatile("" : "+v"(Ow), "+v"(lo)); const float rl = fast_rcp(li_s[lo + ro]);
#pragma unroll
            for (int d0 = 0; d0 < 4; ++d0) { const float v = o[d0][r] * rl; Ow[ro * 1024 + d0 * 32] = (bf16_t)(cvt_pk_bf16(v, v) & 0xffffu); }
            if ((r & 3) == 3) SBAR(); }
    }
}
}
__device__ __forceinline__ void ph_attn(Frame& F) {
    char* lds = (char*)(unsigned char*)F.lds;
    { float* bt = (float*)(lds + att::OFF_BT); const float* BT = (const float*)(F.ws + WS_BIAST); __syncthreads(); for (int i = F.tid; i < 249 * 8; i += NTHR) bt[i] = BT[i]; __syncthreads(); }
    for (int pr = F.bid; pr < NB * 32; pr += F.G) {
        const int b = pr >> 5, qb = pr & 31;
#pragma nounroll
        for (int hh = 0; hh < 2; ++hh) { if (ATT2) att::attn_item2(F, b, (hh ? qb : 63 - qb) * 32, lds); else att::attn_item(F, b, (hh ? qb : 63 - qb) * 32, lds); }
    }
}

namespace ssd {
constexpr int OFF_CS = 0, CS_ST = 272;
constexpr int OFF_BS = OFF_CS + 64 * CS_ST;
constexpr int OFF_BT = OFF_BS + 64 * CS_ST, T_ST = 144;
constexpr int OFF_XT = OFF_BT + 128 * T_ST;
constexpr int OFF_XW = OFF_XT + 64 * T_ST;
constexpr int OFF_XS = OFF_XW + 64 * T_ST;
constexpr int OFF_MT = OFF_XS + 64 * T_ST;
constexpr int OFF_HS = OFF_MT + 64 * T_ST;
constexpr int OFF_END = OFF_HS + 64 * CS_ST;
static_assert(OFF_END + 5 * 320 * 4 <= 131072, "ssd lds");
__device__ __forceinline__ f32x4 mfma16(bf16x8 a, bf16x8 b, f32x4 c) { return __builtin_amdgcn_mfma_f32_16x16x32_bf16(a, b, c, 0, 0, 0); }
__device__ __forceinline__ bf16x8 ldfrag(const char* base, int stride, int row, int k0) { return *(const bf16x8*)(base + row * stride + k0 * 2); }
}
__device__ __forceinline__ void ph_ssd(Frame& F) {
    using namespace ssd;
    char* lds = (char*)(unsigned char*)F.lds;
    const bf16_t* XBC = (const bf16_t*)(F.ws + WS_XBC); const bf16_t* ZS = (const bf16_t*)(F.ws + WS_Z); const float* DT = (const float*)(F.outb + OUT_DT);
    bf16_t* YG = (bf16_t*)(F.ws + WS_Q);
    const float* conv_w = F.a->in[9]; const float* conv_b = F.a->in[10]; const float* a_log = F.a->in[12]; const float* d_skip = F.a->in[13];
    const int tid = F.tid, wid = F.wave, lane = F.lane, fr = lane & 15, fq = lane >> 4;
    const bool stager = tid < 320; const int so = tid % 40, tg = tid / 40;
    for (int item = F.bid; item < NB * 16; item += F.G) {
        const int b = item >> 4, h = item & 15, g = h >> 2;
        const float aneg = -__expf(a_log[h]), dsk = d_skip[h];
        const int ch0 = so < 8 ? h * 64 + so * 8 : (so < 24 ? 1024 + g * 128 + (so - 8) * 8 : 1536 + g * 128 + (so - 24) * 8);
        float* CWL = (float*)(lds + OFF_END);
        __syncthreads();
        if (stager) {
#pragma unroll
            for (int j = 0; j < 4; ++j) { *(f32x4*)(CWL + j * 320 + so * 8) = *(const f32x4*)(conv_w + (size_t)j * 2048 + ch0); *(f32x4*)(CWL + j * 320 + so * 8 + 4) = *(const f32x4*)(conv_w + (size_t)j * 2048 + ch0 + 4); }
            *(f32x4*)(CWL + 4 * 320 + so * 8) = *(const f32x4*)(conv_b + ch0); *(f32x4*)(CWL + 4 * 320 + so * 8 + 4) = *(const f32x4*)(conv_b + ch0 + 4);
        }
        f32x4 hst[4];
#pragma unroll
        for (int t = 0; t < 4; ++t) hst[t] = (f32x4){0.f, 0.f, 0.f, 0.f};
        __syncthreads();
        for (int i = tid; i < 64 * CS_ST / 4; i += NTHR) ((unsigned*)(lds + OFF_HS))[i] = 0u;
        u32x4 raw[11];
        const size_t tokb = (size_t)b * SEQ;
#define SSD_LOAD(c) do { if (stager) { _Pragma("unroll") for (int i = 0; i < 11; ++i) { const int t = (c) * 64 + tg * 8 - 3 + i; \
            raw[i] = (t >= 0) ? *(const u32x4*)(XBC + (tokb + t) * 2048 + ch0) : (u32x4){0u, 0u, 0u, 0u}; } } } while (0)
        SSD_LOAD(0);
        float dtl_next = DT[(tokb + lane) * 16 + h];
        for (int c = 0; c < 32; ++c) {
            const float dtl = dtl_next; if (c + 1 < 32) dtl_next = DT[(tokb + (c + 1) * 64 + lane) * 16 + h];
            u32x2 zpre[2];
#pragma unroll
            for (int t2 = 0; t2 < 2; ++t2) { const int tile = 2 * wid + t2, pb = tile >> 2, lb = tile & 3; zpre[t2] = *(const u32x2*)(ZS + (tokb + c * 64 + lb * 16 + fr) * 1024 + h * 64 + pb * 16 + 4 * fq); }
            float acs = dtl * aneg;
#pragma unroll
            for (int o = 1; o < 64; o <<= 1) { const float t = __shfl_up(acs, o); if (lane >= o) acs += t; }
            const float alast = __shfl(acs, 63);
            if (DBG_SSD_SYNC) __syncthreads();
            float dtv[8], dec[8];
#pragma unroll
            for (int t = 0; t < 8; ++t) { dtv[t] = __shfl(dtl, (tg * 8 + t) & 63); dec[t] = __expf(alast - __shfl(acs, (tg * 8 + t) & 63)); }
            if (stager) {
#pragma unroll
                for (int hq = 0; hq < 2; ++hq) {
                    float xin[11][4];
#pragma unroll
                    for (int i = 0; i < 11; ++i) { const unsigned wa = hq ? raw[i].z : raw[i].x, wb = hq ? raw[i].w : raw[i].y; xin[i][0] = bflo(wa); xin[i][1] = bfhi(wa); xin[i][2] = bflo(wb); xin[i][3] = bfhi(wb); }
                    float outv[8][4];
                    { f32x4 cwv[4]; const f32x4 cbq = *(const f32x4*)(CWL + 4 * 320 + so * 8 + hq * 4);
#pragma unroll
                      for (int j = 0; j < 4; ++j) cwv[j] = *(const f32x4*)(CWL + j * 320 + so * 8 + hq * 4);
#pragma unroll
                      for (int t = 0; t < 8; ++t)
#pragma unroll
                        for (int e = 0; e < 4; ++e) { float sacc = cbq[e];
#pragma unroll
                            for (int j = 0; j < 4; ++j) sacc += cwv[j][e] * xin[t + j][e];
                            outv[t][e] = silu_f(sacc); } }
                    if (so < 8) {
#pragma unroll
                        for (int e = 0; e < 4; ++e) { const int p = so * 8 + hq * 4 + e;
                            f32x4 x0, x1, d0, d1, w0, w1;
#pragma unroll
                            for (int t = 0; t < 4; ++t) { x0[t] = outv[t][e]; x1[t] = outv[4 + t][e]; d0[t] = x0[t] * dtv[t]; d1[t] = x1[t] * dtv[4 + t]; w0[t] = d0[t] * dec[t]; w1[t] = d1[t] * dec[4 + t]; }
                            *(u32x4*)(lds + OFF_XS + p * T_ST + tg * 16) = pack8(x0, x1);
                            *(u32x4*)(lds + OFF_XT + p * T_ST + tg * 16) = pack8(d0, d1);
                            *(u32x4*)(lds + OFF_XW + p * T_ST + tg * 16) = pack8(w0, w1); }
                    } else {
                        const bool isB = so < 24; const int n0 = (isB ? (so - 8) : (so - 24)) * 8 + hq * 4;
                        char* nat = lds + (isB ? OFF_BS : OFF_CS);
#pragma unroll
                        for (int t = 0; t < 8; ++t) { u32x2 w; w.x = cvt_pk_bf16(outv[t][0], outv[t][1]); w.y = cvt_pk_bf16(outv[t][2], outv[t][3]);
                            *(u32x2*)(nat + (tg * 8 + t) * CS_ST + n0 * 2) = w; }
                        if (isB) {
#pragma unroll
                            for (int e = 0; e < 4; ++e) { f32x4 a, bq;
#pragma unroll
                                for (int t = 0; t < 4; ++t) { a[t] = outv[t][e]; bq[t] = outv[4 + t][e]; }
                                *(u32x4*)(lds + OFF_BT + (n0 + e) * T_ST + tg * 16) = pack8(a, bq); }
                        }
                    }
                }
            }
            if (c + 1 < 32) SSD_LOAD(c + 1);
            __syncthreads();
#pragma unroll
            for (int t2 = 0; t2 < 2; ++t2) {
                const int tile = 2 * wid + t2, sb = tile >> 2, lb = tile & 3;
                f32x4 d = (f32x4){0.f, 0.f, 0.f, 0.f};
                if (sb <= lb) {
#pragma unroll
                    for (int ks = 0; ks < 4; ++ks) d = mfma16(ldfrag(lds + OFF_BS, CS_ST, sb * 16 + fr, ks * 32 + fq * 8), ldfrag(lds + OFF_CS, CS_ST, lb * 16 + fr, ks * 32 + fq * 8), d);
                    const int l = lb * 16 + fr; const float al = __shfl(acs, l);
                    f32x4 as;
#pragma unroll
                    for (int r = 0; r < 4; ++r) as[r] = __shfl(acs, sb * 16 + 4 * fq + r);
#pragma unroll
                    for (int r = 0; r < 4; ++r) { const int s = sb * 16 + 4 * fq + r; d[r] = (s <= l) ? d[r] * __expf(al - as[r]) : 0.f; }
                }
                u32x2 w; w.x = cvt_pk_bf16(d[0], d[1]); w.y = cvt_pk_bf16(d[2], d[3]);
                *(u32x2*)(lds + OFF_MT + (lb * 16 + fr) * T_ST + (sb * 16 + 4 * fq) * 2) = w;
            }
            if (DBG_SSD_SYNC) __syncthreads();
            f32x4 yacc[2];
#pragma unroll
            for (int t2 = 0; t2 < 2; ++t2) {
                const int tile = 2 * wid + t2, pb = tile >> 2, lb = tile & 3;
                f32x4 d = (f32x4){0.f, 0.f, 0.f, 0.f};
#pragma unroll
                for (int ks = 0; ks < 4; ++ks) d = mfma16(ldfrag(lds + OFF_HS, CS_ST, pb * 16 + fr, ks * 32 + fq * 8), ldfrag(lds + OFF_CS, CS_ST, lb * 16 + fr, ks * 32 + fq * 8), d);
                const float el = __expf(__shfl(acs, lb * 16 + fr));
                yacc[t2] = d * el;
            }
            __syncthreads();
#pragma unroll
            for (int t2 = 0; t2 < 2; ++t2) {
                const int tile = 2 * wid + t2, pb = tile >> 2, lb = tile & 3;
                f32x4 d = yacc[t2];
#pragma unroll
                for (int ks = 0; ks < 2; ++ks) d = mfma16(ldfrag(lds + OFF_XT, T_ST, pb * 16 + fr, ks * 32 + fq * 8), ldfrag(lds + OFF_MT, T_ST, lb * 16 + fr, ks * 32 + fq * 8), d);
                const int l = lb * 16 + fr, p0 = pb * 16 + 4 * fq; const size_t tok = tokb + c * 64 + l;
                const u32x2 zz = zpre[t2];
                const float z0 = bflo(zz.x), z1 = bfhi(zz.x), z2 = bflo(zz.y), z3 = bfhi(zz.y);
                float xs[4];
#pragma unroll
                for (int r = 0; r < 4; ++r) xs[r] = bflo((unsigned)*(const bf16_t*)(lds + OFF_XS + (p0 + r) * T_ST + l * 2));
                u32x2 w; w.x = cvt_pk_bf16((d[0] + xs[0] * dsk) * z0, (d[1] + xs[1] * dsk) * z1); w.y = cvt_pk_bf16((d[2] + xs[2] * dsk) * z2, (d[3] + xs[3] * dsk) * z3);
                *(u32x2*)(YG + tok * 1024 + h * 64 + p0) = w;
            }
            if (DBG_SSD_SYNC) __syncthreads();
            { const float dc = __expf(alast);
#pragma unroll
              for (int t = 0; t < 4; ++t) { f32x4 d = hst[t] * dc;
#pragma unroll
                  for (int ks = 0; ks < 2; ++ks) d = mfma16(ldfrag(lds + OFF_BT, T_ST, wid * 16 + fr, ks * 32 + fq * 8), ldfrag(lds + OFF_XW, T_ST, t * 16 + fr, ks * 32 + fq * 8), d);
                  hst[t] = d;
                  u32x2 w; w.x = cvt_pk_bf16(d[0], d[1]); w.y = cvt_pk_bf16(d[2], d[3]);
                  *(u32x2*)(lds + OFF_HS + (t * 16 + fr) * CS_ST + (wid * 16 + 4 * fq) * 2) = w; } }
            __syncthreads();
        }
#undef SSD_LOAD
    }
}

namespace ssd2 {
constexpr int CS_ST = 272, T_ST = 144;
constexpr int OFF_CS = 0, OFF_BS = 64 * CS_ST, OFF_BT = 2 * 64 * CS_ST, OFF_H0 = OFF_BT + 128 * T_ST;
constexpr int H_XS = 0, H_XW = 64 * T_ST, H_MT = 2 * 64 * T_ST, H_HS = 3 * 64 * T_ST, H_SZ = H_HS + 64 * CS_ST;
constexpr int OFF_CW = OFF_H0 + 2 * H_SZ;
constexpr int OFF_TAB = OFF_CW + 5 * 384 * 4;
static_assert(OFF_TAB + 6 * 64 * 4 <= LDS_MISC, "ssd2 lds");
}
__device__ __forceinline__ void ph_ssd2(Frame& F, const int abl = 0) {
    using namespace ssd2; using ssd::mfma16; using ssd::ldfrag;
    char* lds = (char*)(unsigned char*)F.lds;
    const bf16_t* XBC = (const bf16_t*)(F.ws + WS_XBC); const bf16_t* ZS = (const bf16_t*)(F.ws + WS_Z); const float* DT = (const float*)(F.outb + OUT_DT);
    bf16_t* YG = (bf16_t*)(F.ws + WS_Q);
    const float* conv_w = F.a->in[9]; const float* conv_b = F.a->in[10]; const float* a_log = F.a->in[12]; const float* d_skip = F.a->in[13];
    const int tid = F.tid, wid = F.wave, lane = F.lane, fr = lane & 15, fq = lane >> 4;
    const int su = tid < 384 ? tid : tid - 128; const bool cwl_writer = true;
    const int cp_lo = __builtin_amdgcn_readfirstlane(tid < 384 ? 0 : 2), cp_hi = __builtin_amdgcn_readfirstlane(tid < 256 ? 4 : (tid < 384 ? 2 : 4));
    const int so = su % 48, tg = su / 48, shd = (so >> 3) & 1;
    for (int item = F.bid; item < NB * 8; item += F.G) {
        const int b = item >> 3, g = (item >> 1) & 3, h0 = g * 4 + (item & 1) * 2;
        const float aneg0 = -__expf(a_log[h0]), aneg1 = -__expf(a_log[h0 + 1]), dsk0 = d_skip[h0], dsk1 = d_skip[h0 + 1];
        const int ch0 = so < 16 ? (h0 + shd) * 64 + (so & 7) * 8 : (so < 32 ? 1024 + g * 128 + (so - 16) * 8 : 1536 + g * 128 + (so - 32) * 8);
        float* CWL = (float*)(lds + OFF_CW);
        __syncthreads();
        if (cwl_writer) {
#pragma unroll
            for (int j = 0; j < 4; ++j) { *(f32x4*)(CWL + j * 384 + so * 8) = *(const f32x4*)(conv_w + (size_t)j * 2048 + ch0); *(f32x4*)(CWL + j * 384 + so * 8 + 4) = *(const f32x4*)(conv_w + (size_t)j * 2048 + ch0 + 4); }
            *(f32x4*)(CWL + 4 * 384 + so * 8) = *(const f32x4*)(conv_b + ch0); *(f32x4*)(CWL + 4 * 384 + so * 8 + 4) = *(const f32x4*)(conv_b + ch0 + 4);
        }
        f32x4 hst[2][4];
#pragma unroll
        for (int hh = 0; hh < 2; ++hh)
#pragma unroll
            for (int t = 0; t < 4; ++t) hst[hh][t] = (f32x4){0.f, 0.f, 0.f, 0.f};
        for (int i = tid; i < 64 * CS_ST / 4; i += NTHR) { ((unsigned*)(lds + OFF_H0 + H_HS))[i] = 0u; ((unsigned*)(lds + OFF_H0 + H_SZ + H_HS))[i] = 0u; }
        u32x4 raw[11];
        const size_t tokb = (size_t)b * SEQ;
        const bf16_t* xrow = XBC + ((ptrdiff_t)tokb + tg * 8 - 3) * 2048 + ch0;
#define SSD_LOAD(c, xp, tgx) do { { _Pragma("unroll") for (int i = 0; i < 11; ++i) { const int t = (c) * 64 + (tgx) * 8 - 3 + i; \
            raw[i] = (t >= 0) ? *(const GAS u32x4*)((xp) + (ptrdiff_t)((c) * 64 + i) * 2048) : (u32x4){0u, 0u, 0u, 0u}; } } } while (0)
        SSD_LOAD(0, xrow, tg);
        f32x2 dtn = *(const f32x2*)(DT + (tokb + lane) * 16 + h0);
        for (int c = 0; c < 32; ++c) {
            int frl = fr, fql = fq, tgl = tg, sol = so; const bf16_t* xrl = xrow; asm volatile("" : "+v"(frl), "+v"(fql), "+v"(tgl), "+v"(sol), "+v"(xrl)); const int shdl = (sol >> 3) & 1;
            const float dtl0 = dtn[0], dtl1 = dtn[1]; if (c + 1 < 32) dtn = *(const f32x2*)(DT + (tokb + (c + 1) * 64 + lane) * 16 + h0);
            u32x2 zpre[2][2];
#pragma unroll
            for (int hh = 0; hh < 2; ++hh)
#pragma unroll
                for (int t2 = 0; t2 < 2; ++t2) { const int tile = 2 * wid + t2, pb = tile >> 2, lb = tile & 3; zpre[hh][t2] = *(const u32x2*)(ZS + (tokb + c * 64 + lb * 16 + frl) * 1024 + (h0 + hh) * 64 + pb * 16 + 4 * fql); }
            const float acs0 = dpp_scan_add(dtl0 * aneg0), acs1 = dpp_scan_add(dtl1 * aneg1);
            const float alast0 = __builtin_bit_cast(float, __builtin_amdgcn_readlane(__builtin_bit_cast(int, acs0), 63)), alast1 = __builtin_bit_cast(float, __builtin_amdgcn_readlane(__builtin_bit_cast(int, acs1), 63));
            float* TAB = (float*)(lds + OFF_TAB);
            TAB[lane] = acs0; TAB[64 + lane] = acs1; TAB[128 + lane] = dtl0; TAB[192 + lane] = dtl1; TAB[256 + lane] = dtl0 * __expf(alast0 - acs0); TAB[320 + lane] = dtl1 * __expf(alast1 - acs1);
            LDS_WAIT(); asm volatile("" ::: "memory");
            float wdt[8];
            { const f32x4 wa = *(const f32x4*)(TAB + 256 + shdl * 64 + tgl * 8), wb = *(const f32x4*)(TAB + 256 + shdl * 64 + tgl * 8 + 4);
#pragma unroll
              for (int t = 0; t < 4; ++t) { wdt[t] = wa[t]; wdt[4 + t] = wb[t]; } }
            if (!(abl & 1)) {
#pragma unroll
                for (int cp = 0; cp < 4; ++cp) {
                    if (cp < cp_lo || cp >= cp_hi) continue;
                    float xin[11][2];
#pragma unroll
                    for (int i = 0; i < 11; ++i) { const unsigned wa = cp == 0 ? raw[i].x : (cp == 1 ? raw[i].y : (cp == 2 ? raw[i].z : raw[i].w)); xin[i][0] = bflo(wa); xin[i][1] = bfhi(wa); }
                    float outv[8][2];
                    { f32x2 cwv[4]; const f32x2 cbq = *(const f32x2*)(CWL + 4 * 384 + sol * 8 + cp * 2);
#pragma unroll
                      for (int j = 0; j < 4; ++j) cwv[j] = *(const f32x2*)(CWL + j * 384 + sol * 8 + cp * 2);
#pragma unroll
                      for (int t = 0; t < 8; ++t)
#pragma unroll
                        for (int e = 0; e < 2; ++e) { float sacc = cbq[e];
#pragma unroll
                            for (int j = 0; j < 4; ++j) sacc += cwv[j][e] * xin[t + j][e];
                            outv[t][e] = silu_f(sacc); } }
                    if (sol < 16) {
                        char* hb = lds + OFF_H0 + shdl * H_SZ;
#pragma unroll
                        for (int e = 0; e < 2; ++e) { const int p = (sol & 7) * 8 + cp * 2 + e;
                            f32x4 x0, x1, w0, w1;
#pragma unroll
                            for (int t = 0; t < 4; ++t) { x0[t] = outv[t][e]; x1[t] = outv[4 + t][e]; w0[t] = x0[t] * wdt[t]; w1[t] = x1[t] * wdt[4 + t]; }
                            *(u32x4*)(hb + H_XS + p * T_ST + tgl * 16) = pack8(x0, x1);
                            *(u32x4*)(hb + H_XW + p * T_ST + tgl * 16) = pack8(w0, w1); }
                    } else {
                        const bool isB = sol < 32; const int n0 = (isB ? (sol - 16) : (sol - 32)) * 8 + cp * 2;
                        char* nat = lds + (isB ? OFF_BS : OFF_CS);
#pragma unroll
                        for (int t = 0; t < 8; ++t) *(unsigned*)(nat + (tgl * 8 + t) * CS_ST + n0 * 2) = cvt_pk_bf16(outv[t][0], outv[t][1]);
                        if (isB) {
#pragma unroll
                            for (int e = 0; e < 2; ++e) { f32x4 a, bq;
#pragma unroll
                                for (int t = 0; t < 4; ++t) { a[t] = outv[t][e]; bq[t] = outv[4 + t][e]; }
                                *(u32x4*)(lds + OFF_BT + (n0 + e) * T_ST + tgl * 16) = pack8(a, bq); }
                        }
                    }
                    SBAR();
                }
            }
            if (c + 1 < 32) SSD_LOAD(c + 1, xrl, tgl);
            __syncthreads();
            bf16x8 cfr[2][4];
#pragma unroll
            for (int t2 = 0; t2 < 2; ++t2)
#pragma unroll
                for (int ks = 0; ks < 4; ++ks) cfr[t2][ks] = ldfrag(lds + OFF_CS, CS_ST, ((2 * wid + t2) & 3) * 16 + frl, ks * 32 + fql * 8);
            if (!(abl & 2))
#pragma unroll
            for (int t2 = 0; t2 < 2; ++t2) {
                const int tile = 2 * wid + t2, sb = tile >> 2, lb = tile & 3;
                f32x4 d = (f32x4){0.f, 0.f, 0.f, 0.f}, m0 = d, m1 = d;
                if (sb <= lb) {
#pragma unroll
                    for (int ks = 0; ks < 4; ++ks) d = mfma16(ldfrag(lds + OFF_BS, CS_ST, sb * 16 + frl, ks * 32 + fql * 8), cfr[t2][ks], d);
                    const int l = lb * 16 + frl, s4 = sb * 16 + 4 * fql; const float al0 = TAB[l], al1 = TAB[64 + l];
                    const f32x4 as0 = *(const f32x4*)(TAB + s4), as1 = *(const f32x4*)(TAB + 64 + s4), ds0 = *(const f32x4*)(TAB + 128 + s4), ds1 = *(const f32x4*)(TAB + 192 + s4);
#pragma unroll
                    for (int r = 0; r < 4; ++r) { const int sidx = s4 + r;
                        m0[r] = (sidx <= l) ? d[r] * __expf(al0 - as0[r]) * ds0[r] : 0.f; m1[r] = (sidx <= l) ? d[r] * __expf(al1 - as1[r]) * ds1[r] : 0.f; }
                }
                u32x2 w; w.x = cvt_pk_bf16(m0[0], m0[1]); w.y = cvt_pk_bf16(m0[2], m0[3]);
                *(u32x2*)(lds + OFF_H0 + H_MT + (lb * 16 + frl) * T_ST + (sb * 16 + 4 * fql) * 2) = w;
                w.x = cvt_pk_bf16(m1[0], m1[1]); w.y = cvt_pk_bf16(m1[2], m1[3]);
                *(u32x2*)(lds + OFF_H0 + H_SZ + H_MT + (lb * 16 + frl) * T_ST + (sb * 16 + 4 * fql) * 2) = w;
            }
            f32x4 yacc[2][2];
#pragma unroll
            for (int hh = 0; hh < 2; ++hh)
#pragma unroll
                for (int t2 = 0; t2 < 2; ++t2) {
                    const int tile = 2 * wid + t2, pb = tile >> 2, lb = tile & 3; const char* hb = lds + OFF_H0 + hh * H_SZ;
                    f32x4 d = (f32x4){0.f, 0.f, 0.f, 0.f};
                    if (!(abl & 2))
#pragma unroll
                    for (int ks = 0; ks < 4; ++ks) d = mfma16(ldfrag(hb + H_HS, CS_ST, pb * 16 + frl, ks * 32 + fql * 8), cfr[t2][ks], d);
                    const float el = __expf(TAB[hh * 64 + lb * 16 + frl]);
                    yacc[hh][t2] = d * el;
                }
            __syncthreads();
            if (!(abl & 4))
#pragma unroll
            for (int hh = 0; hh < 2; ++hh)
#pragma unroll
                for (int t2 = 0; t2 < 2; ++t2) {
                    const int tile = 2 * wid + t2, pb = tile >> 2, lb = tile & 3; const char* hb = lds + OFF_H0 + hh * H_SZ;
                    f32x4 d = yacc[hh][t2];
#pragma unroll
                    for (int ks = 0; ks < 2; ++ks) d = mfma16(ldfrag(hb + H_XS, T_ST, pb * 16 + frl, ks * 32 + fql * 8), ldfrag(hb + H_MT, T_ST, lb * 16 + frl, ks * 32 + fql * 8), d);
                    const int l = lb * 16 + frl, p0 = pb * 16 + 4 * fql; const size_t tok = tokb + c * 64 + l; const float dsk = hh ? dsk1 : dsk0;
                    const u32x2 zz = zpre[hh][t2];
                    const float z0 = bflo(zz.x), z1 = bfhi(zz.x), z2 = bflo(zz.y), z3 = bfhi(zz.y);
                    float xs[4];
#pragma unroll
                    for (int r = 0; r < 4; ++r) xs[r] = bflo((unsigned)*(const bf16_t*)(hb + H_XS + (p0 + r) * T_ST + l * 2));
                    u32x2 w; w.x = cvt_pk_bf16((d[0] + xs[0] * dsk) * z0, (d[1] + xs[1] * dsk) * z1); w.y = cvt_pk_bf16((d[2] + xs[2] * dsk) * z2, (d[3] + xs[3] * dsk) * z3);
                    *(u32x2*)(YG + tok * 1024 + (h0 + hh) * 64 + p0) = w;
                }
            const bf16x8 btf0 = ldfrag(lds + OFF_BT, T_ST, wid * 16 + frl, fql * 8), btf1 = ldfrag(lds + OFF_BT, T_ST, wid * 16 + frl, 32 + fql * 8);
            if (!(abl & 8))
#pragma unroll
            for (int hh = 0; hh < 2; ++hh) { const float dc = __expf(hh ? alast1 : alast0); char* hb = lds + OFF_H0 + hh * H_SZ;
#pragma unroll
                for (int t = 0; t < 4; ++t) { f32x4 d = hst[hh][t] * dc;
#pragma unroll
                    for (int ks = 0; ks < 2; ++ks) d = mfma16(ks ? btf1 : btf0, ldfrag(hb + H_XW, T_ST, t * 16 + frl, ks * 32 + fql * 8), d);
                    hst[hh][t] = d;
                    u32x2 w; w.x = cvt_pk_bf16(d[0], d[1]); w.y = cvt_pk_bf16(d[2], d[3]);
                    *(u32x2*)(hb + H_HS + (t * 16 + frl) * CS_ST + (wid * 16 + 4 * fql) * 2) = w; } }
            __syncthreads();
        }
#undef SSD_LOAD
    }
}

__device__ __forceinline__ void ph_gnorm(Frame& F) {
    bf16_t* YG = (bf16_t*)(F.ws + WS_Q);
    const int gw = F.bid * NWAVES + F.wave, NGW = F.G * NWAVES;
    constexpr int RB = 4;
    for (int m0 = gw * RB; m0 < NTOK; m0 += NGW * RB) {
        u32x2 w[RB][4];
#pragma unroll
        for (int r = 0; r < RB; ++r) { const u32x2* rp = (const u32x2*)(YG + (size_t)(m0 + r) * D) + F.lane;
#pragma unroll
            for (int j = 0; j < 4; ++j) w[r][j] = rp[64 * j]; }
#pragma unroll
        for (int r = 0; r < RB; ++r) { const int m = m0 + r; u32x2* rp = (u32x2*)(YG + (size_t)m * D) + F.lane;
#pragma unroll
            for (int j = 0; j < 4; ++j) { const float a = bflo(w[r][j].x), b = bfhi(w[r][j].x), c = bflo(w[r][j].y), d = bfhi(w[r][j].y);
                const float ss = wave_sum(a * a + b * b + c * c + d * d); const float rr = 1.f / sqrtf(ss * (1.f / 256.f) + LN_EPS);
                if (PB_FP8) { int pk = 0; pk = __builtin_amdgcn_cvt_pk_fp8_f32(a * rr, b * rr, pk, false); pk = __builtin_amdgcn_cvt_pk_fp8_f32(c * rr, d * rr, pk, true); ((unsigned*)(F.outb + OUT_OB8 + (size_t)m * D))[F.lane + 64 * j] = (unsigned)pk; }
                else { u32x2 o; o.x = cvt_pk_bf16(a * rr, b * rr); o.y = cvt_pk_bf16(c * rr, d * rr); rp[64 * j] = o; } } }
    }
}

template <bool DRY = false> __device__ __forceinline__ void ph_router(Frame& F) {
    const bf16_t* VB = (const bf16_t*)(F.ws + WS_VB); bf16_t* X1B = (bf16_t*)(F.ws + WS_X1B); bf16_t* U2 = (bf16_t*)(F.ws + WS_U2); const float* MOD = (const float*)(F.ws + WS_MOD);
    const float* ln1g = F.a->in[18]; const float* ln1b = F.a->in[19]; const float* w_router = F.a->in[20]; const float* b_router = F.a->in[21];
    u32x2* REG = (u32x2*)(F.ws + WS_REG); unsigned* CNT = (unsigned*)(F.ws + WS_CTL) + CW_CNT;
    constexpr int TST = 2064;
    LAS unsigned char* THI = F.lds; LAS unsigned char* TLO = F.lds + 16 * TST; LAS float* PART = (LAS float*)(F.lds + 32 * TST);
    LAS unsigned* lcnt = (LAS unsigned*)(F.lds + LDS_AUX); LAS unsigned* lbase = lcnt + 32; LAS unsigned* ent = lcnt + 64;
    const int tid = F.tid, lane = F.lane, wid = F.wave, fr = lane & 15, fq = lane >> 4;
    bf16x8 whi[4][2], wlo[4][2];
#pragma unroll
    for (int ks = 0; ks < 4; ++ks)
#pragma unroll
        for (int ct = 0; ct < 2; ++ct) { float wv[8];
#pragma unroll
            for (int i = 0; i < 8; ++i) wv[i] = w_router[(size_t)(128 * wid + 32 * ks + 8 * fq + i) * 32 + ct * 16 + fr];
            u32x4 h, l2;
#pragma unroll
            for (int i = 0; i < 4; ++i) { const unsigned hp = cvt_pk_bf16(wv[2 * i], wv[2 * i + 1]); const float r0 = wv[2 * i] - bflo(hp), r1 = wv[2 * i + 1] - bfhi(hp); h[i] = hp; l2[i] = cvt_pk_bf16(r0, r1); }
            whi[ks][ct] = __builtin_bit_cast(bf16x8, h); wlo[ks][ct] = __builtin_bit_cast(bf16x8, l2); }
    const float brl = b_router[lane & 31];
    f32x4 lg[4], lb[4];
#pragma unroll
    for (int j = 0; j < 4; ++j) { lg[j] = *((const f32x4*)ln1g + lane + 64 * j); lb[j] = *((const f32x4*)ln1b + lane + 64 * j); }
    for (int batch = F.bid; batch < NTOK / 256; batch += F.G) {
        const int hf = batch >> 7;
        f32x4 shv[4], scv[4];
        { const float* md = MOD + (size_t)((batch * 256) >> 11) * 6144;
#pragma unroll
          for (int j = 0; j < 4; ++j) { shv[j] = *((const f32x4*)(md + 3072) + lane + 64 * j); scv[j] = *((const f32x4*)(md + 4096) + lane + 64 * j); } }
        __syncthreads();
        if (tid < 32) lcnt[tid] = 0u;
        for (int grp = 0; grp < 16; ++grp) {
#pragma unroll
            for (int tt = 0; tt < 2; ++tt) {
                const int tg16 = 2 * wid + tt, m = batch * 256 + grp * 16 + tg16; const float* md = MOD + (size_t)(m >> 11) * 6144;
                const u32x2* vr = (const u32x2*)(VB + (size_t)m * D) + lane; u32x2* xr = (u32x2*)(X1B + (size_t)m * D) + lane;
                f32x4 v[4]; float s = 0.f;
#pragma unroll
                for (int j = 0; j < 4; ++j) { const u32x2 w = vr[64 * j]; v[j] = (f32x4){bflo(w.x), bfhi(w.x), bflo(w.y), bfhi(w.y)}; s += (v[j][0] + v[j][1]) + (v[j][2] + v[j][3]); }
                float mean = wave_sum(s) * (1.f / D), s2 = 0.f;
#pragma unroll
                for (int j = 0; j < 4; ++j) { v[j] = v[j] - mean; s2 += (v[j][0] * v[j][0] + v[j][1] * v[j][1]) + (v[j][2] * v[j][2] + v[j][3] * v[j][3]); }
                float rstd = 1.f / sqrtf(wave_sum(s2) * (1.f / D) + LN_EPS);
                s = 0.f;
#pragma unroll
                for (int j = 0; j < 4; ++j) { v[j] = v[j] * rstd * lg[j] + lb[j]; if (!DRY) { u32x2 w; w.x = cvt_pk_bf16(v[j][0], v[j][1]); w.y = cvt_pk_bf16(v[j][2], v[j][3]); xr[64 * j] = w; } s += (v[j][0] + v[j][1]) + (v[j][2] + v[j][3]); }
                mean = wave_sum(s) * (1.f / D); s2 = 0.f;
#pragma unroll
                for (int j = 0; j < 4; ++j) { v[j] = v[j] - mean; s2 += (v[j][0] * v[j][0] + v[j][1] * v[j][1]) + (v[j][2] * v[j][2] + v[j][3] * v[j][3]); }
                rstd = 1.f / sqrtf(wave_sum(s2) * (1.f / D) + LN_EPS);
                u32x2* o8 = (u32x2*)(U2 + (size_t)m * D) + lane;
#pragma unroll
                for (int j = 0; j < 4; ++j) {
                    v[j] = v[j] * rstd * (scv[j] + 1.0f) + shv[j]; u32x2 w; w.x = cvt_pk_bf16(v[j][0], v[j][1]); w.y = cvt_pk_bf16(v[j][2], v[j][3]);
                    if (DRY) { if (w.x == 0x12345678u) o8[64 * j] = w; }
                    else if (MOE_FP8) { int pk = 0; pk = __builtin_amdgcn_cvt_pk_fp8_f32(v[j][0], v[j][1], pk, false); pk = __builtin_amdgcn_cvt_pk_fp8_f32(v[j][2], v[j][3], pk, true); ((unsigned*)((unsigned char*)U2 + (size_t)m * D))[lane + 64 * j] = (unsigned)pk; }
                    else o8[64 * j] = w;
                    u32x2 lo; lo.x = cvt_pk_bf16(v[j][0] - bflo(w.x), v[j][1] - bfhi(w.x)); lo.y = cvt_pk_bf16(v[j][2] - bflo(w.y), v[j][3] - bfhi(w.y));
                    *(LAS u32x2*)(THI + tg16 * TST + (4 * lane + 256 * j) * 2) = w; *(LAS u32x2*)(TLO + tg16 * TST + (4 * lane + 256 * j) * 2) = lo; }
            }
            __syncthreads();
            { f32x4 a0 = (f32x4){0.f, 0.f, 0.f, 0.f}, a1 = a0;
#pragma unroll
              for (int ks = 0; ks < 4; ++ks) { const int cb = (128 * wid + 32 * ks + 8 * fq) * 2;
                  const bf16x8 th = *(const LAS bf16x8*)(THI + fr * TST + cb), tl = *(const LAS bf16x8*)(TLO + fr * TST + cb);
                  a0 = __builtin_amdgcn_mfma_f32_16x16x32_bf16(whi[ks][0], th, a0, 0, 0, 0); a1 = __builtin_amdgcn_mfma_f32_16x16x32_bf16(whi[ks][1], th, a1, 0, 0, 0);
                  a0 = __builtin_amdgcn_mfma_f32_16x16x32_bf16(wlo[ks][0], th, a0, 0, 0, 0); a1 = __builtin_amdgcn_mfma_f32_16x16x32_bf16(wlo[ks][1], th, a1, 0, 0, 0);
                  a0 = __builtin_amdgcn_mfma_f32_16x16x32_bf16(whi[ks][0], tl, a0, 0, 0, 0); a1 = __builtin_amdgcn_mfma_f32_16x16x32_bf16(whi[ks][1], tl, a1, 0, 0, 0); }
              *(LAS f32x4*)(PART + (wid * 16 + fr) * 32 + 4 * fq) = a0; *(LAS f32x4*)(PART + (wid * 16 + fr) * 32 + 16 + 4 * fq) = a1; }
            __syncthreads();
            { const int tg16 = 2 * wid + (lane >> 5), tl = grp * 16 + tg16, myexp = lane & 31;
              float logit = brl;
#pragma unroll
              for (int w8 = 0; w8 < 8; ++w8) logit += PART[(w8 * 16 + tg16) * 32 + myexp];
              float tv[4]; int tix[4];
#pragma unroll
              for (int k = 0; k < 4; ++k) { float bv = logit; int bi = myexp;
#define RT_STEP(ctrl, rm) do { const float ov = __builtin_bit_cast(float, __builtin_amdgcn_update_dpp((int)0xff800000u, __builtin_bit_cast(int, bv), (ctrl), (rm), 0xf, false)); \
                      const int oi = __builtin_amdgcn_update_dpp(64, bi, (ctrl), (rm), 0xf, false); if (ov > bv || (ov == bv && oi < bi)) { bv = ov; bi = oi; } } while (0)
                  RT_STEP(0x111, 0xf); RT_STEP(0x112, 0xf); RT_STEP(0x114, 0xf); RT_STEP(0x118, 0xf); RT_STEP(0x142, 0xa);
#undef RT_STEP
                  { const int b0 = __builtin_amdgcn_readlane(__builtin_bit_cast(int, bv), 31), b1 = __builtin_amdgcn_readlane(__builtin_bit_cast(int, bv), 63), i0 = __builtin_amdgcn_readlane(bi, 31), i1 = __builtin_amdgcn_readlane(bi, 63);
                    bv = __builtin_bit_cast(float, lane < 32 ? b0 : b1); bi = lane < 32 ? i0 : i1; }
                  tv[k] = bv; tix[k] = bi; if (myexp == bi) logit = -INFINITY; }
              const float e1 = __expf(tv[1] - tv[0]), e2 = __expf(tv[2] - tv[0]), e3 = __expf(tv[3] - tv[0]); const float inv = 1.f / (1.f + e1 + e2 + e3);
              if (myexp < 4) { const int ee = myexp == 0 ? tix[0] : (myexp == 1 ? tix[1] : (myexp == 2 ? tix[2] : tix[3])); const float gg = (myexp == 0 ? 1.f : (myexp == 1 ? e1 : (myexp == 2 ? e2 : e3))) * inv;
                  const unsigned lp = atomicAdd((unsigned*)&lcnt[ee], 1u);
                  LAS unsigned* en = ent + (tl * 4 + myexp) * 3; en[0] = (unsigned)ee; en[1] = lp; en[2] = __float_as_uint(gg);
                  if (DBG_CHECK == 1) { u32x2 rw; rw.x = (unsigned)ee; rw.y = __float_as_uint(gg); ((u32x2*)(F.ws + WS_DBG))[(size_t)(batch * 256 + tl) * 4 + myexp] = rw; } } }
        }
        __syncthreads();
        if (tid < 32) lbase[tid] = DRY ? 0u : __hip_atomic_fetch_add(CNT + 64 * (hf * 32 + tid), lcnt[tid], __ATOMIC_RELAXED, __HIP_MEMORY_SCOPE_AGENT);
        __syncthreads();
        for (int i = tid; i < 1024; i += NTHR) { const LAS unsigned* en = ent + i * 3; const unsigned ee = en[0], pos = lbase[ee] + en[1];
            const unsigned tokl = (unsigned)(batch * 256 + (i >> 2)) - (unsigned)hf * HALF_TOK;
            u32x2 w; w.x = tokl * 4u + (unsigned)(i & 3); w.y = en[2];
            if (!DRY && pos < (unsigned)REG_CAP) REG[((size_t)hf * 32 + ee) * REG_CAP + pos] = w; }
    }
}

template <bool DRY = false> __device__ __forceinline__ void ph_final(Frame& F, int hf) {
    float* OUT = (float*)F.outb; const bf16_t* X1B = (const bf16_t*)(F.ws + WS_X1B); const bf16_t* YB = (const bf16_t*)(F.ws + WS_YB); const float* MOD = (const float*)(F.ws + WS_MOD);
    const float* g2 = F.a->in[26]; const float* b2 = F.a->in[27];
    const int gw = F.bid * NWAVES + F.wave, NGW = F.G * NWAVES, lane = F.lane;
    constexpr int RB = 2;
    f32x4 g2v[4], b2v[4];
#pragma unroll
    for (int j = 0; j < 4; ++j) { g2v[j] = *((const f32x4*)g2 + lane + 64 * j); b2v[j] = *((const f32x4*)b2 + lane + 64 * j); }
    const int RPW = (((HALF_TOK + NGW - 1) / NGW) + RB - 1) / RB * RB, tbeg = gw * RPW, tend = (tbeg + RPW < HALF_TOK) ? tbeg + RPW : HALF_TOK;
    f32x4 gtv[4]; int curb = -1;
    for (int tl0 = tbeg; tl0 < tend; tl0 += RB) {
        { const int bb = (hf * HALF_TOK + tl0) >> 11; if (bb != curb) { curb = bb; const float* md = MOD + (size_t)bb * 6144 + 5120;
#pragma unroll
            for (int j = 0; j < 4; ++j) gtv[j] = *((const f32x4*)md + lane + 64 * j); } }
        u32x2 xw[RB][4]; u32x2 yw[RB][4][4];
#pragma unroll
        for (int r = 0; r < RB; ++r) { const int tl = tl0 + r, m = hf * HALF_TOK + tl;
            const u32x2* xr = (const u32x2*)(X1B + (size_t)m * D) + lane; const u32x2* yr = (const u32x2*)(YB + (size_t)tl * 4 * D) + lane;
#pragma unroll
            for (int j = 0; j < 4; ++j) { xw[r][j] = __builtin_nontemporal_load(xr + 64 * j);
#pragma unroll
                for (int k = 0; k < 4; ++k) yw[r][j][k] = __builtin_nontemporal_load(yr + k * 256 + 64 * j); } }
#pragma unroll
        for (int r = 0; r < RB; ++r) { const int tl = tl0 + r, m = hf * HALF_TOK + tl;
            f32x4* xr = (f32x4*)(OUT + (size_t)m * D) + lane;
            f32x4 v[4]; float s = 0.f;
#pragma unroll
            for (int j = 0; j < 4; ++j) { f32x4 y = (f32x4){0.f, 0.f, 0.f, 0.f};
#pragma unroll
                for (int k = 0; k < 4; ++k) { const u32x2 w = yw[r][j][k]; y[0] += bflo(w.x); y[1] += bfhi(w.x); y[2] += bflo(w.y); y[3] += bfhi(w.y); }
                if (DBG_NO_MOE) y = (f32x4){0.f, 0.f, 0.f, 0.f};
                const f32x4 gt = gtv[j];
                const f32x4 x1v = (f32x4){bflo(xw[r][j].x), bfhi(xw[r][j].x), bflo(xw[r][j].y), bfhi(xw[r][j].y)};
                v[j] = x1v * DN_ALPHA + gt * y; s += (v[j][0] + v[j][1]) + (v[j][2] + v[j][3]); }
            const float mean = wave_sum(s) * (1.f / D); float s2 = 0.f;
#pragma unroll
            for (int j = 0; j < 4; ++j) { v[j] = v[j] - mean; s2 += (v[j][0] * v[j][0] + v[j][1] * v[j][1]) + (v[j][2] * v[j][2] + v[j][3] * v[j][3]); }
            const float rstd = 1.f / sqrtf(wave_sum(s2) * (1.f / D) + LN_EPS);
#pragma unroll
            for (int j = 0; j < 4; ++j) { const f32x4 ov = v[j] * rstd * g2v[j] + b2v[j]; if (!DRY || ov[0] == 1.2345e-33f) __builtin_nontemporal_store(ov, xr + 64 * j); } }
    }
}

__device__ __forceinline__ float block_sum(Frame& F, float v, LAS float* red) {
    v = wave_sum(v); __syncthreads(); if (F.lane == 0) red[F.wave] = v; __syncthreads();
    float s = 0.f; for (int w = 0; w < NWAVES; ++w) s += red[w]; return s;
}
__device__ __forceinline__ float block_max(Frame& F, float v, LAS float* red) {
#pragma unroll
    for (int o = 1; o < 64; o <<= 1) v = fmaxf(v, __shfl_xor(v, o));
    __syncthreads(); if (F.lane == 0) red[F.wave] = v; __syncthreads();
    float s = 0.f; for (int w = 0; w < NWAVES; ++w) s = fmaxf(s, red[w]); return s;
}
__device__ __forceinline__ void dbg_report(Frame& F, float e) { if (F.tid == 0) atomicMax((unsigned*)(F.ws + WS_CTL) + CW_DBG, __float_as_uint(e)); }
__device__ __forceinline__ void dbg_check_moe(Frame& F) {
    if (F.bid >= 64) return;
    const int tok = HALF_TOK + 509 * F.bid + 3, tokl = tok - HALF_TOK, tid = F.tid;
    LAS float* u2 = (LAS float*)F.lds; LAS float* act = u2 + 1024; LAS float* red = act + 1024; LAS float* lg = red + 16;
    const bf16_t* U2 = (const bf16_t*)(F.ws + WS_U2); const bf16_t* YB = (const bf16_t*)(F.ws + WS_YB); const u32x2* RT = (const u32x2*)(F.ws + WS_DBG);
    const float* w1 = F.a->in[22]; const float* b1 = F.a->in[23]; const float* w2 = F.a->in[24]; const float* b2 = F.a->in[25];
    __syncthreads();
    for (int i = tid; i < 1024; i += NTHR) u2[i] = bflo((unsigned)U2[(size_t)tok * 1024 + i]);
    __syncthreads();
    float y0 = 0.f, y1 = 0.f;
    for (int k = 0; k < 4; ++k) {
        const u32x2 rw = RT[(size_t)tok * 4 + k]; const int e = (int)rw.x; const float g = __uint_as_float(rw.y);
        const float* W1 = w1 + (size_t)e * 1024 * 2048; const float* W2 = w2 + (size_t)e * 1024 * 1024;
        float h0 = b1[e * 2048 + tid], h1 = b1[e * 2048 + tid + 512], h2 = b1[e * 2048 + tid + 1024], h3 = b1[e * 2048 + tid + 1536];
        for (int c = 0; c < 1024; ++c) { const float uu = u2[c]; const float* wr = W1 + (size_t)c * 2048 + tid; h0 += uu * wr[0]; h1 += uu * wr[512]; h2 += uu * wr[1024]; h3 += uu * wr[1536]; }
        __syncthreads();
        { float gg = fminf(h0, 7.f), up = fminf(fmaxf(h2, -7.f), 7.f); act[tid] = (up + 1.f) * gg / (1.f + expf(-1.702f * gg));
          gg = fminf(h1, 7.f); up = fminf(fmaxf(h3, -7.f), 7.f); act[tid + 512] = (up + 1.f) * gg / (1.f + expf(-1.702f * gg)); }
        __syncthreads();
        float a0 = b2[e * 1024 + tid], a1 = b2[e * 1024 + tid + 512];
        for (int j = 0; j < 1024; ++j) { const float aa = act[j]; a0 += aa * W2[(size_t)j * 1024 + tid]; a1 += aa * W2[(size_t)j * 1024 + tid + 512]; }
        y0 += g * a0; y1 += g * a1;
    }
    float f0 = 0.f, f1 = 0.f;
    for (int k = 0; k < 4; ++k) { f0 += bflo((unsigned)YB[((size_t)tokl * 4 + k) * 1024 + tid]); f1 += bflo((unsigned)YB[((size_t)tokl * 4 + k) * 1024 + tid + 512]); }
    const float rms = sqrtf(block_sum(F, y0 * y0 + y1 * y1, red) * (1.f / 1024.f)) + 1e-20f;
    float err = block_max(F, fmaxf(fabsf(y0 - f0), fabsf(y1 - f1)), red) / rms;
    { const float* X1 = (const float*)F.outb + (size_t)tok * 1024; const float* md = (const float*)(F.ws + WS_MOD) + (size_t)(tok >> 11) * 6144;
      const float xa = X1[tid], xb = X1[tid + 512]; const float mean = block_sum(F, xa + xb, red) * (1.f / 1024.f);
      const float da = xa - mean, db = xb - mean; const float var = block_sum(F, da * da + db * db, red) * (1.f / 1024.f); const float rstd = 1.f / sqrtf(var + LN_EPS);
      __syncthreads();
      u2[tid] = da * rstd * (1.f + md[4096 + tid]) + md[3072 + tid]; u2[tid + 512] = db * rstd * (1.f + md[4096 + tid + 512]) + md[3072 + tid + 512];
      __syncthreads();
      if (tid < 32) { float a = F.a->in[21][tid]; for (int c = 0; c < 1024; ++c) a += u2[c] * F.a->in[20][c * 32 + tid]; lg[tid] = a; }
      __syncthreads();
      if (tid == 0) { unsigned want = 0u, got = 0u; float l2[32]; for (int i = 0; i < 32; ++i) l2[i] = lg[i];
          for (int k = 0; k < 4; ++k) { int bi = 0; for (int i = 1; i < 32; ++i) if (l2[i] > l2[bi]) bi = i; want |= 1u << bi; l2[bi] = -INFINITY; got |= 1u << RT[(size_t)tok * 4 + k].x; }
          lg[32] = (want != got) ? 1.f : 0.f; }
      __syncthreads();
      if (lg[32] != 0.f) err = 50.f; }
    dbg_report(F, err);
}
__device__ __forceinline__ void dbg_check_ssd(Frame& F) {
    if (F.bid >= 2) return;
    const int b = F.bid ? 20 : 5, h = F.bid ? 14 : 3, g = h >> 2, tid = F.tid, p = tid >> 3, ng = tid & 7;
    LAS float* red = (LAS float*)F.lds; LAS float* cv = red + 16;
    const bf16_t* XBC = (const bf16_t*)(F.ws + WS_XBC); const bf16_t* ZS = (const bf16_t*)(F.ws + WS_Z); const float* DT = (const float*)(F.outb + OUT_DT); const bf16_t* YG = (const bf16_t*)(F.ws + WS_Q);
    const float* cw = F.a->in[9]; const float* cb = F.a->in[10]; const float aneg = -expf(F.a->in[12][h]), dsk = F.a->in[13][h];
    const int mych = tid < 64 ? h * 64 + tid : (tid < 192 ? 1024 + g * 128 + (tid - 64) : 1536 + g * 128 + (tid - 192));
    float w0 = 0.f, w1 = 0.f, w2 = 0.f, w3 = 0.f, wb = 0.f;
    if (tid < 320) { w0 = cw[0 * 2048 + mych]; w1 = cw[1 * 2048 + mych]; w2 = cw[2 * 2048 + mych]; w3 = cw[3 * 2048 + mych]; wb = cb[mych]; }
    float x0 = 0.f, x1 = 0.f, x2 = 0.f;
    float hs[16];
#pragma unroll
    for (int i = 0; i < 16; ++i) hs[i] = 0.f;
    float emax = 0.f, ssq = 0.f, nbad = 0.f; int tmax = 0;
    for (int t = 0; t < SEQ; ++t) {
        const size_t tok = (size_t)b * SEQ + t;
        __syncthreads();
        if (DBG_HYP == 1 && (t & 63) == 0) { x0 = 0.f; x1 = 0.f; x2 = 0.f; }
        if (tid < 320) { const float x3 = bflo((unsigned)XBC[tok * 2048 + mych]); const float s = wb + w0 * x0 + w1 * x1 + w2 * x2 + w3 * x3; cv[tid] = s / (1.f + expf(-s)); x0 = x1; x1 = x2; x2 = x3; }
        __syncthreads();
        const float xv = cv[p], dt = DT[tok * 16 + h], dec = expf(dt * aneg);
        float yp = 0.f;
#pragma unroll
        for (int i = 0; i < 16; ++i) { const int n = ng * 16 + i; hs[i] = hs[i] * dec + dt * xv * cv[64 + n]; yp += cv[192 + n] * hs[i]; }
        yp += __shfl_xor(yp, 1); yp += __shfl_xor(yp, 2); yp += __shfl_xor(yp, 4);
        const float yv = (yp + xv * dsk) * bflo((unsigned)ZS[tok * 1024 + h * 64 + p]);
        const float yf = bflo((unsigned)YG[tok * 1024 + h * 64 + p]);
        if (ng == 0) { const float er = fabsf(yv - yf); if (er > emax) { emax = er; tmax = t; } ssq += yv * yv; if (er > 0.25f && (DBG_SUB < 5 || (DBG_SUB == 5 && (t & 63) == 0) || (DBG_SUB == 6 && (t & 63) == 1) || (DBG_SUB == 7 && (t & 63) == 32))) nbad += 1.f; }
    }
    const float rms = sqrtf(block_sum(F, ssq, red) / (64.f * SEQ)) + 1e-20f;
    const float M = block_max(F, emax, red);
    if (DBG_SUB == 0) dbg_report(F, M / rms);
    else if (DBG_SUB == 1) dbg_report(F, block_sum(F, nbad, red) / (64.f * SEQ));
    else if (DBG_SUB >= 5) dbg_report(F, block_sum(F, nbad, red) / (64.f * 32.f));
    else { __syncthreads(); if (ng == 0 && emax == M) red[12] = (float)(DBG_SUB == 2 ? ((tmax & 63) >> 1) : (DBG_SUB == 3 ? (tmax >> 6) : (p >> 1))); __syncthreads();
        if (F.bid == 0) dbg_report(F, powf(10.f, 2.f * (0.05f + 0.05f * red[12]) - 4.f)); }
}
__device__ __forceinline__ void dbg_check_attn(Frame& F) {
    if (F.bid >= 32) return;
    const int b = (F.bid * 7 + 3) & 31, pos = 300 + F.bid * 53, nadm = ((pos >> 6) + 1) * 64, tid = F.tid, lane = F.lane, hd = F.wave;
    const size_t tq = (size_t)b * SEQ + pos;
    LAS float* sc = (LAS float*)F.lds; LAS unsigned char* sel = (LAS unsigned char*)(sc + 2048); LAS float* lgt = (LAS float*)(sel + 2048); LAS float* red = lgt + 8 * 2048; LAS float* misc = red + 16;
    const bf16_t* IQ = (const bf16_t*)(F.outb + OUT_IQ); const bf16_t* IK = (const bf16_t*)(F.outb + OUT_IK); const float* IW = (const float*)(F.outb + OUT_IW);
    const bf16_t* Q = (const bf16_t*)(F.ws + WS_Q); const bf16_t* KV = (const bf16_t*)(F.outb + OUT_KV); const bf16_t* OA = (const bf16_t*)(F.outb + OUT_OA); const u64* MASK = (const u64*)(F.outb + OUT_MASK);
    __syncthreads();
    for (int k = tid; k < nadm; k += NTHR) { float s = 0.f;
        for (int hh = 0; hh < 8; ++hh) { float d = 0.f; for (int c = 0; c < 64; ++c) d += bflo((unsigned)IQ[tq * 512 + hh * 64 + c]) * bflo((unsigned)IK[((size_t)b * SEQ + k) * 64 + c]); s += fmaxf(d, 0.f) * IW[tq * 8 + hh]; }
        sc[k] = s + 0.0f; }
    __syncthreads();
    float nbad = 0.f;
    for (int k = tid; k < nadm; k += NTHR) { const float s = sc[k]; int rank = 0; for (int j = 0; j < nadm; ++j) { const float t = sc[j]; rank += (t > s || (t == s && j < k)) ? 1 : 0; }
        const unsigned char se = rank < 256 ? 1 : 0; sel[k] = se; const unsigned mb = (unsigned)((MASK[tq * 32 + (k >> 6)] >> (k & 63)) & 1ull); if (mb != se) nbad += 1.f; }
    __syncthreads();
    const float nbad_t = block_sum(F, nbad, red);
    LAS float* lw = lgt + hd * 2048; float mx = -INFINITY;
    for (int k = lane; k < nadm; k += 64) { float l = -INFINITY;
        if (sel[k]) { float d = 0.f; for (int c = 0; c < 128; ++c) d += bflo((unsigned)Q[tq * 1024 + hd * 128 + c]) * bflo((unsigned)KV[((size_t)b * SEQ + k) * 128 + c]);
            const int rel = k - pos, n = rel < 0 ? -rel : rel; const float nf = (float)(n > 1 ? n : 1); int large = 8 + (int)(logf(nf / 8.0f) / 2.7725887f * 8.0f); if (large > 15) large = 15;
            const int bucket = (rel > 0 ? 16 : 0) + (n < 8 ? n : large);
            l = d * 0.088388347648318440f + F.a->in[8][bucket * 8 + hd]; }
        lw[k] = l; mx = fmaxf(mx, l); }
#pragma unroll
    for (int o = 1; o < 64; o <<= 1) mx = fmaxf(mx, __shfl_xor(mx, o));
    float den = 0.f;
    for (int k = lane; k < nadm; k += 64) { const float pp = expf(lw[k] - mx); lw[k] = pp; den += pp; }
    den = wave_sum(den);
    float emax = 0.f, ssq = 0.f;
    for (int c2 = 0; c2 < 2; ++c2) { const int c = lane + 64 * c2; float o = 0.f; for (int k = 0; k < nadm; ++k) { const float pp = lw[k]; if (pp != 0.f) o += pp * bflo((unsigned)KV[((size_t)b * SEQ + k) * 128 + c]); }
        o /= den; const float of = bflo((unsigned)OA[tq * 1024 + hd * 128 + c]); emax = fmaxf(emax, fabsf(o - of)); ssq += o * o; }
    const float rms = sqrtf(block_sum(F, ssq, red) * (1.f / 1024.f)) + 1e-20f;
    float err = block_max(F, emax, red) / rms;
    (void)misc;
    if (nbad_t > 0.f) err = 10.f + nbad_t;
    dbg_report(F, err);
}
__device__ __forceinline__ void dbg_emit(Frame& F) {
    float* out = (float*)F.outb;
    for (size_t i = (size_t)F.bid * NTHR + F.tid; i < (size_t)NTOK * D / 4; i += (size_t)F.G * NTHR) ((f32x4*)out)[i] = (f32x4){0.f, 0.f, 0.f, 0.f};
    __syncthreads();
    if (F.bid == 0 && F.tid == 0) { const float e = __uint_as_float(__hip_atomic_load((unsigned*)(F.ws + WS_CTL) + CW_DBG, __ATOMIC_RELAXED, __HIP_MEMORY_SCOPE_AGENT));
        float code = (log10f(fmaxf(e, 1e-30f)) + 4.f) * 0.5f; code = fminf(fmaxf(rintf(code * 20.f) * 0.05f, 0.05f), 3.0f);
        out[0] = sqrtf(67108864.f * 1.01f * (powf(10.f, code) - 1.f)); }
}

#define CLK_BEGIN(k) unsigned long long clk_c##k = 0, clk_r##k = 0; if (DBG_CLOCK == (k) + 1) { clk_c##k = __builtin_amdgcn_s_memtime(); clk_r##k = __builtin_amdgcn_s_memrealtime(); }
#define CLK_END(k) if (DBG_CLOCK == (k) + 1 && F.bid == 0) { const float ghz = (float)(__builtin_amdgcn_s_memtime() - clk_c##k) / (float)(__builtin_amdgcn_s_memrealtime() - clk_r##k) * 0.1f; dbg_report(F, powf(10.f, 2.f * (rintf(ghz * 5.f) * 0.2f) - 4.f)); }
constexpr int NPHASE = 17;
__global__ void __launch_bounds__(NTHR, 2) fwd(Args args) {
    extern __shared__ __attribute__((aligned(16))) unsigned char lds_raw[];
    Frame F;
    F.lds = (LAS unsigned char*)lds_raw;
    F.tid = threadIdx.x; F.lane = F.tid & 63; F.wave = __builtin_amdgcn_readfirstlane(F.tid >> 6); F.G = gridDim.x; F.bid = blockIdx.x;
    F.a = &args;
    F.ws = args.ws; F.outb = (unsigned char*)args.out;
    volatile LAS unsigned* MISCW = (volatile LAS unsigned*)(F.lds + LDS_MISC);
    if (F.tid < 64) MISCW[F.tid] = 0u;
    __syncthreads();
    XcdBarrier bar; bar.bar = (unsigned*)(F.ws + WS_CTL) + CW_BAR; bar.x = 0; bar.st = nullptr;
#if MK_ONE
    bar = xcd_barrier_post((unsigned*)(F.ws + WS_CTL) + CW_BAR, MISCW + 8);
#define GRID_BAR() xcd_barrier(bar)
#else
#define GRID_BAR() do { } while (0)
#endif
    const int lo = args.ph_lo, hi = args.ph_hi;
#ifndef PHM
#define PHM (0xFFFFFFFFu & ~(DBG_NO_ATTN ? 0x30u : 0u) & ~(DBG_NO_SSD ? 0xC0u : 0u))
#endif
#define IN(k) (((PHM >> (k)) & 1u) && lo <= (k) && (k) < hi)
#define SEAM(k) do { if ((k) + 1 < hi) GRID_BAR(); } while (0)

    if (IN(0)) {
#pragma nounroll
        for (int rep = 0; rep < ((DBG_TWICE & 1u) ? 2 : 1); ++rep) { if (rep) GRID_BAR(); ph_prologue(F); }
        SEAM(0); }
    if (IN(1)) {
#pragma nounroll
        for (int rep = 0; rep < ((DBG_TWICE & 2u) ? 2 : 1); ++rep) { if (rep) GRID_BAR(); ph_ln1(F); }
        SEAM(1); }
    CLK_BEGIN(2);
    if (IN(2)) {
        EpiProj E{(bf16_t*)(F.ws + WS_Q), (bf16_t*)(F.outb + OUT_IQ), (bf16_t*)(F.ws + WS_Z), (bf16_t*)(F.ws + WS_XBC), (bf16_t*)(F.ws + WS_GA), (bf16_t*)(F.ws + WS_GB), (float*)(F.outb + OUT_MISC), 1.0f};
#if PROJ_FP8
        { SchedProj<2> S; S.o.init(NTOK, 12 * 256, F.G, F.bid); S.A = (const char*)(F.ws + WS_U8); S.Bt = (const char*)(F.ws + WS_WIN8);
          EpiProj E8 = E; E8.sc = MOE_INV;
          pg8::gemm_phase<EpiProj, SchedProj<2>, false, 512, true>(F.lds, S, E8);
          if (DBG_TWICE & 32768u) { GRID_BAR(); pg8::gemm_phase<EpiProj, SchedProj<2>, false, 512, true>(F.lds, S, E8); } }
        { SchedProj<1> S; S.o.init(NTOK, 15 * 256, F.G, F.bid); S.A = (const char*)(F.outb + OUT_U); S.Bt = (const char*)(F.ws + WS_WIN); if (DBG_KCLK) S.dbgw = (unsigned*)(F.ws + WS_CTL) + CW_DBG;
#if DBG_DRYPROJ
#pragma nounroll
          for (int rep = 0; rep < 2; ++rep) { EpiProj Ed = E; Ed.dry = rep == 0; SchedProj<1> Sd = S; Sd.fold = rep == 0 ? 7 : 0x7fffffff; pg8::gemm_phase<EpiProj, SchedProj<1>, false>(F.lds, Sd, Ed); if (rep == 0) GRID_BAR(); }
#else
          const unsigned long long w0 = DBG_WALL ? __builtin_amdgcn_s_memrealtime() : 0ull;
          pg8::gemm_phase<EpiProj, SchedProj<1>, false>(F.lds, S, E);
          if (DBG_WALL && F.bid == 0) { const float us = (float)(__builtin_amdgcn_s_memrealtime() - w0) * 0.01f; dbg_report(F, powf(10.f, 2.f * (rintf(us / 300.f * 10.f) * 0.1f) - 4.f)); }
#endif
          if (DBG_TWICE & 4u) { GRID_BAR(); pg8::gemm_phase<EpiProj, SchedProj<1>, false>(F.lds, S, E); } }
#else
        { SchedProj<0> S; S.o.init(NTOK, NPROJ, F.G, F.bid); S.A = (const char*)(F.outb + OUT_U); S.Bt = (const char*)(F.ws + WS_WIN);
          pg8::gemm_phase<EpiProj, SchedProj<0>, false>(F.lds, S, E);
          if (DBG_TWICE & 4u) { GRID_BAR(); pg8::gemm_phase<EpiProj, SchedProj<0>, false>(F.lds, S, E); } }
#endif
        SEAM(2);
    }
    CLK_END(2);
    if (IN(3)) { ph_misc(F); if (DBG_TWICE & 8u) { GRID_BAR(); ph_misc(F); } SEAM(3); }
    if (IN(4)) {
#pragma nounroll
        for (int rep = 0; rep < DBG_REP4; ++rep) { if (rep) GRID_BAR(); ph_index(F, rep + 1 < DBG_REP4 ? DBG_ABL4 : 0); }
        SEAM(4); }
    if (IN(5)) { ph_attn(F); if (DBG_TWICE & 32u) { GRID_BAR(); ph_attn(F); } SEAM(5); if (DBG_CHECK == 3) { dbg_check_attn(F); GRID_BAR(); } }
    if (IN(6)) {
#pragma nounroll
        for (int rep = 0; rep < DBG_REP6; ++rep) { if (rep) GRID_BAR(); ph_ssd2(F, rep + 1 < DBG_REP6 ? DBG_ABL6 : 0); }
        SEAM(6); if (DBG_CHECK == 2) { dbg_check_ssd(F); GRID_BAR(); } }
    if (IN(7)) { ph_gnorm(F); if (DBG_TWICE & 128u) { GRID_BAR(); ph_gnorm(F); } SEAM(7); }
    if (IN(8)) {
#if PA_FP8
        SchedPlainT<1024> S; S.o.init(NTOK, 1024, F.G, F.bid); S.A = (const char*)(F.outb + OUT_OA); S.Bt = (const char*)(F.ws + WS_WPA8);
        EpiGate<0> E{(const bf16_t*)(F.ws + WS_GA), nullptr, (bf16_t*)(F.ws + WS_Z), MOE_INV};
        pg8::gemm_phase<EpiGate<0>, SchedPlainT<1024>, false, 512, true>(F.lds, S, E);
#else
        SchedPlain S; S.o.init(NTOK, 1024, F.G, F.bid); S.A = (const char*)(F.outb + OUT_OA); S.Bt = (const char*)(F.ws + WS_WPA);
        EpiGate<0> E{(const bf16_t*)(F.ws + WS_GA), nullptr, (bf16_t*)(F.ws + WS_Z), 1.0f};
        pg8::gemm_phase<EpiGate<0>, SchedPlain, false>(F.lds, S, E);
#endif
    }
    if (IN(9)) {
#if PB_FP8
        SchedPlainT<1024> S; S.o.init(NTOK, 1024, F.G, F.bid); S.A = (const char*)(F.outb + OUT_OB8); S.Bt = (const char*)(F.ws + WS_WPB8);
        EpiGate<1> E{(const bf16_t*)(F.ws + WS_GB), (const bf16_t*)(F.ws + WS_Z), (bf16_t*)(F.ws + WS_XBC), MOE_INV};
        pg8::gemm_phase<EpiGate<1>, SchedPlainT<1024>, false, 512, true>(F.lds, S, E);
#else
        SchedPlain S; S.o.init(NTOK, 1024, F.G, F.bid); S.A = (const char*)(F.ws + WS_Q); S.Bt = (const char*)(F.ws + WS_WPB);
        EpiGate<1> E{(const bf16_t*)(F.ws + WS_GB), (const bf16_t*)(F.ws + WS_Z), (bf16_t*)(F.ws + WS_XBC), 1.0f};
        pg8::gemm_phase<EpiGate<1>, SchedPlain, false>(F.lds, S, E);
#endif
        SEAM(9);
    }
    if (IN(10)) {
#if PO_FP8
        SchedPlainT<1024> S; S.o.init(NTOK, 1024, F.G, F.bid); S.A = (const char*)(F.ws + WS_XBC); S.Bt = (const char*)(F.ws + WS_WOUT);
        EpiOut E{F.a->in[0], (const float*)(F.ws + WS_MOD), (bf16_t*)(F.ws + WS_VB), MOE_INV / PO_ASC};
        pg8::gemm_phase<EpiOut, SchedPlainT<1024>, false, 512, true>(F.lds, S, E);
#else
        SchedPlain S; S.o.init(NTOK, 1024, F.G, F.bid); S.A = (const char*)(F.ws + WS_XBC); S.Bt = (const char*)(F.ws + WS_WOUT);
        EpiOut E{F.a->in[0], (const float*)(F.ws + WS_MOD), (bf16_t*)(F.ws + WS_VB)};
        pg8::gemm_phase<EpiOut, SchedPlain, false>(F.lds, S, E);
        if (DBG_TWICE & 1024u) { GRID_BAR(); pg8::gemm_phase<EpiOut, SchedPlain, false>(F.lds, S, E); }
#endif
        SEAM(10);
    }
    if (IN(11)) { if (DBG_TWICE & 2048u) { ph_router<true>(F); GRID_BAR(); } ph_router<false>(F); SEAM(11); }
#pragma unroll
    for (int hf = 0; hf < 2; ++hf) {
        const int p0 = 12 + hf * 2;
        if (IN(p0)) {
            if (hf == 1) ph_final<false>(F, 0);
            MoeTab T = moe_tables(F, hf);
            SchedMoe<8, true> S{T, F.G, F.bid, hf, (const char*)(F.ws + WS_U2), (const char*)(F.ws + WS_W1), (const u32x2*)(F.ws + WS_REG)};
            EpiMoe1 E{F.a->in[23], (bf16_t*)(F.ws + WS_ACT), 0};
            pg8::gemm_phase<EpiMoe1, SchedMoe<8, true>, true, MOE_RB / 2, MOE_FP8 != 0>(F.lds, S, E);
            if ((DBG_TWICE & 4096u) && hf == 0) { GRID_BAR(); pg8::gemm_phase<EpiMoe1, SchedMoe<8, true>, true, MOE_RB / 2, MOE_FP8 != 0>(F.lds, S, E); }
            if ((DBG_TWICE & 16384u) && hf == 0) { GRID_BAR(); EpiMoe1 Ed = E; Ed.dry = 1; pg8::gemm_phase<EpiMoe1, SchedMoe<8, true>, true, MOE_RB / 2, MOE_FP8 != 0>(F.lds, S, Ed); }
            SEAM(p0);
        }
        if (IN(p0 + 1)) {
            MoeTab T = moe_tables(F, hf);
            SchedMoe<4, false> S{T, F.G, F.bid, hf, (const char*)(F.ws + WS_ACT), (const char*)(F.ws + WS_W2), (const u32x2*)(F.ws + WS_REG)};
            EpiMoe2 E{F.a->in[25], (bf16_t*)(F.ws + WS_YB), (const u32x2*)(F.ws + WS_REG), T, hf, 0};
            if ((DBG_TWICE & 262144u) && hf == 0) { EpiMoe2 Ed = E; Ed.dry = DBG_DRYMODE; pg8::gemm_phase<EpiMoe2, SchedMoe<4, false>, false, MOE_RB / 2, MOE_FP8 != 0>(F.lds, S, Ed); GRID_BAR(); }
            pg8::gemm_phase<EpiMoe2, SchedMoe<4, false>, false, MOE_RB / 2, MOE_FP8 != 0>(F.lds, S, E);
            if ((DBG_TWICE & 8192u) && hf == 0) { GRID_BAR(); pg8::gemm_phase<EpiMoe2, SchedMoe<4, false>, false, MOE_RB / 2, MOE_FP8 != 0>(F.lds, S, E); }
            if ((DBG_TWICE & 131072u) && hf == 0) { GRID_BAR(); EpiMoe2 Ed = E; Ed.dry = 1; pg8::gemm_phase<EpiMoe2, SchedMoe<4, false>, false, MOE_RB / 2, MOE_FP8 != 0>(F.lds, S, Ed); }
            SEAM(p0 + 1);
            if (DBG_CHECK == 1 && hf == 1) { dbg_check_moe(F); GRID_BAR(); }
        }
    }
    if (IN(16)) { if (DBG_TWICE & 65536u) { ph_final<true>(F, 1); GRID_BAR(); } ph_final(F, 1); }
    if (DBG_CHECK || DBG_CLOCK || DBG_KCLK || DBG_WALL) { GRID_BAR(); dbg_emit(F); }
#undef IN
#undef SEAM
}

extern "C" void kernel_launch(void* const* d_in, const int* in_sizes, int n_in, void* d_out, int out_size, void* d_ws, size_t ws_size, hipStream_t stream) {
    static int grid = 0;
    if (grid == 0) {
        if (n_in != 28 || in_sizes[0] != NTOK * D || out_size != NTOK * D || ws_size < WS_END) { fprintf(stderr, "kernel_launch: shape mismatch (n_in %d, in0 %d, out %d, ws %zu)\n", n_in, n_in > 0 ? in_sizes[0] : -1, out_size, ws_size); grid = -1; return; }
        int dev = 0, cus = 0, per_cu = 0;
        if (hipGetDevice(&dev) != hipSuccess || hipDeviceGetAttribute(&cus, hipDeviceAttributeMultiprocessorCount, dev) != hipSuccess) { grid = -1; return; }
        if (hipFuncSetAttribute((const void*)fwd, hipFuncAttributeMaxDynamicSharedMemorySize, LDS_BYTES) != hipSuccess) { fprintf(stderr, "kernel_launch: hipFuncSetAttribute failed\n"); grid = -1; return; }
        if (hipOccupancyMaxActiveBlocksPerMultiprocessor(&per_cu, (const void*)fwd, NTHR, LDS_BYTES) != hipSuccess || per_cu < 1) fprintf(stderr, "kernel_launch: occupancy query reports %d\n", per_cu);
        (void)hipGetLastError();
        grid = cus;
    }
    if (grid < 0) return;
    if (hipMemsetAsync((char*)d_ws + WS_CTL, 0, CTL_ZERO_BYTES, stream) != hipSuccess) { fprintf(stderr, "kernel_launch: memset failed\n"); return; }
    Args a{};
    for (int i = 0; i < 28; ++i) a.in[i] = (const float*)d_in[i];
    a.out = (float*)d_out; a.ws = (unsigned char*)d_ws;
    const int nph = NPHASE < MK_PH_HI ? NPHASE : MK_PH_HI;
#if MK_ONE
    a.ph_lo = 0; a.ph_hi = nph;
    hipLaunchKernelGGL(fwd, dim3(grid), dim3(NTHR), LDS_BYTES, stream, a);
#else
    for (int p = 0; p < nph; ++p) { a.ph_lo = p; a.ph_hi = p + 1; hipLaunchKernelGGL(fwd, dim3(grid), dim3(NTHR), LDS_BYTES, stream, a); }
#endif
    const hipError_t le = hipPeekAtLastError();
    if (le != hipSuccess) fprintf(stderr, "kernel_launch: launch failed: %s\n", hipGetErrorName(le));
}
```
